# Optimizing an MI355X kernel written in HIP

```python
import math
import jax
import jax.numpy as jnp
from jax import lax
import numpy as np

D_MODEL = 2048
BATCH = 2
SEQ = 8192
DEPTH = 4

GRID_W = 64
CTX_LEN = 256
N_MIXERS = 3
ALPHA = (2.0 * DEPTH) ** 0.25
BETA = (8.0 * DEPTH) ** -0.25
LN_EPS = 1e-6
Q_BLOCK = 128
ROPE_DIM = 64
ROPE_BASE = 10000.0
GM_CHUNK = 128
GM_DIM = D_MODEL
GM_GROUPS = GM_DIM // 128
GM_GDIM = GM_DIM // GM_GROUPS
MLA_HEADS = D_MODEL // 128
MLA_Q_RANK = D_MODEL // 4
MLA_KV_RANK = D_MODEL // 4
MLA_NOPE = 128
MLA_ROPE = ROPE_DIM
MLA_V = 128
MLA_SCALE = (MLA_NOPE + MLA_ROPE) ** -0.5
DA_HEAD = ROPE_DIM
DA_HEADS = D_MODEL // (2 * DA_HEAD)
DA_SCALE = DA_HEAD ** -0.5
PEER_HEADS = 8
PEER_TOPK = 16
PEER_NKEYS = 128
PEER_EXPERTS = PEER_NKEYS * PEER_NKEYS
PEER_DK = 256
PEER_CHUNK = 128
N_LAYERS_A = len(range(0, DEPTH, N_MIXERS))
N_LAYERS_B = len(range(1, DEPTH, N_MIXERS))
N_LAYERS_C = len(range(2, DEPTH, N_MIXERS))

kernel_name = 'hybrid_dit_gmlp_mla_diffattn_peer'


def _layer_norm(x):
    xf = x.astype(jnp.float32)
    mu = jnp.mean(xf, axis=-1, keepdims=True)
    var = jnp.mean(jnp.square(xf - mu), axis=-1, keepdims=True)
    return ((xf - mu) * lax.rsqrt(var + LN_EPS)).astype(x.dtype)


def _rms_norm(x):
    xf = x.astype(jnp.float32)
    return (xf * lax.rsqrt(jnp.mean(jnp.square(xf), axis=-1, keepdims=True) + LN_EPS)).astype(x.dtype)


def _modulate(x, shift, scale):
    return _layer_norm(x) * (1.0 + scale) + shift


def _post_norm(x, y, g, b):
    return _layer_norm(ALPHA * x + y) * g + b


def axial_rope_tables(n_tokens):
    rows = n_tokens // GRID_W
    row = jnp.repeat(jnp.arange(rows, dtype=jnp.float32), GRID_W)
    col = jnp.tile(jnp.arange(GRID_W, dtype=jnp.float32), rows)
    nf = ROPE_DIM // 4
    inv = ROPE_BASE ** (-jnp.arange(nf, dtype=jnp.float32) / nf)
    ang_r = row[:, None] * inv
    ang_c = col[:, None] * inv
    return (jnp.cos(ang_r), jnp.sin(ang_r), jnp.cos(ang_c), jnp.sin(ang_c))


def _rope_half(x, cos, sin):
    x1, x2 = jnp.split(x, 2, axis=-1)
    return jnp.concatenate([x1 * cos - x2 * sin, x1 * sin + x2 * cos], axis=-1)


def axial_rope(x, rope):
    cos_r, sin_r, cos_c, sin_c = rope
    xf = x.astype(jnp.float32)
    xr, xc = jnp.split(xf, 2, axis=-1)
    out = jnp.concatenate([_rope_half(xr, cos_r, sin_r), _rope_half(xc, cos_c, sin_c)], axis=-1)
    return out.astype(x.dtype)


def _merge_heads(o):
    B, H, T, dv = o.shape
    return o.transpose(0, 2, 1, 3).reshape(B, T, H * dv)


def _over_query_blocks(fn, qs):
    B, H, S, _ = qs[0].shape
    nb = S // Q_BLOCK
    blocks = tuple(q.reshape(B, H, nb, Q_BLOCK, q.shape[-1]).transpose(2, 0, 1, 3, 4) for q in qs)
    o = lax.map(fn, blocks)
    return o.transpose(1, 2, 0, 3, 4).reshape(B, H, S, o.shape[-1])


def softmax_attention(q, k, v, scale):
    def blk(qs):
        (qb,) = qs
        s = jnp.einsum('bhqd,bhkd->bhqk', qb, k) * scale
        p = jax.nn.softmax(s.astype(jnp.float32), axis=-1)
        return jnp.einsum('bhqk,bhkd->bhqd', p.astype(v.dtype), v)
    return _over_query_blocks(blk, (q,))


def diff_attention(q1, q2, k1, k2, v, lam, scale):
    def blk(qs):
        a, b = qs
        p1 = jax.nn.softmax((jnp.einsum('bhqd,bhkd->bhqk', a, k1) * scale).astype(jnp.float32), axis=-1)
        p2 = jax.nn.softmax((jnp.einsum('bhqd,bhkd->bhqk', b, k2) * scale).astype(jnp.float32), axis=-1)
        return jnp.einsum('bhqk,bhkd->bhqd', (p1 - lam * p2).astype(v.dtype), v)
    return _over_query_blocks(blk, (q1, q2))


def gmlp_mixer(hl, hc, w_in, ln_g, ln_b, ws, bs, w_out):
    def mix(h):
        B, T, _ = h.shape
        z = jax.nn.gelu(h @ w_in)
        u, v = jnp.split(z, 2, axis=-1)
        v = _layer_norm(v) * ln_g + ln_b
        v = v.reshape(B, T // GM_CHUNK, GM_CHUNK, GM_GROUPS, GM_GDIM)
        sv = jnp.einsum('gpq,bnqgd->bnpgd', ws, v) + bs.T[:, :, None]
        return (u * sv.reshape(B, T, GM_DIM)) @ w_out
    return mix(hl), (mix(hc) if hc is not None else None)


def mla_mixer(hl, hc, rope, w_in, q_norm, kv_norm, w_uq, w_ukv, w_out, ctx_out):
    def down(h):
        return jnp.split(h @ w_in, [MLA_Q_RANK, MLA_Q_RANK + MLA_KV_RANK], axis=-1)

    def up_q(cq):
        B, T, _ = cq.shape
        q = (_rms_norm(cq) * q_norm) @ w_uq
        q = q.reshape(B, T, MLA_HEADS, MLA_NOPE + MLA_ROPE).transpose(0, 2, 1, 3)
        return jnp.split(q, [MLA_NOPE], axis=-1)

    def up_kv(ckv, k_rope):
        B, T, _ = ckv.shape
        kv = (_rms_norm(ckv) * kv_norm) @ w_ukv
        kv = kv.reshape(B, T, MLA_HEADS, MLA_NOPE + MLA_V).transpose(0, 2, 1, 3)
        k_nope, v = jnp.split(kv, [MLA_NOPE], axis=-1)
        k_rope = jnp.broadcast_to(k_rope, k_nope.shape[:-1] + (MLA_ROPE,))
        return jnp.concatenate([k_nope, k_rope], axis=-1), v

    cq_l, ckv_l, kr_l = down(hl)
    cq_c, ckv_c, kr_c = down(hc)
    qn_l, qr_l = up_q(cq_l)
    q_l = jnp.concatenate([qn_l, axial_rope(qr_l, rope)], axis=-1)
    k_l, v_l = up_kv(ckv_l, axial_rope(kr_l[:, None], rope))
    k_c, v_c = up_kv(ckv_c, kr_c[:, None])
    o_l = softmax_attention(q_l, jnp.concatenate([k_c, k_l], axis=2), jnp.concatenate([v_c, v_l], axis=2), MLA_SCALE)
    y_l = _merge_heads(o_l) @ w_out
    if ctx_out:
        q_c = jnp.concatenate(up_q(cq_c), axis=-1)
        y_c = _merge_heads(softmax_attention(q_c, k_c, v_c, MLA_SCALE)) @ w_out
    else:
        y_c = None
    return y_l, y_c


def diff_attn_mixer(hl, hc, rope, w_in, lam_p, subln, w_out, lam_init, ctx_out):
    def proj(h):
        B, T, _ = h.shape
        q, k, v = jnp.split(h @ w_in, 3, axis=-1)
        q = q.reshape(B, T, DA_HEADS, 2, DA_HEAD).transpose(3, 0, 2, 1, 4)
        k = k.reshape(B, T, DA_HEADS, 2, DA_HEAD).transpose(3, 0, 2, 1, 4)
        v = v.reshape(B, T, DA_HEADS, 2 * DA_HEAD).transpose(0, 2, 1, 3)
        return q, k, v

    lp = lam_p.astype(jnp.float32)
    lam = jnp.exp(jnp.sum(lp[0] * lp[1])) - jnp.exp(jnp.sum(lp[2] * lp[3])) + lam_init

    def out(o):
        o = _rms_norm(o) * subln * (1.0 - lam_init)
        return _merge_heads(o) @ w_out

    q_l, k_l, v_l = proj(hl)
    q_l = axial_rope(q_l, rope)
    k_l = axial_rope(k_l, rope)
    q_c, k_c, v_c = proj(hc)
    k_all = jnp.concatenate([k_c, k_l], axis=3)
    v_all = jnp.concatenate([v_c, v_l], axis=2)
    y_l = out(diff_attention(q_l[0], q_l[1], k_all[0], k_all[1], v_all, lam, DA_SCALE))
    y_c = out(diff_attention(q_c[0], q_c[1], k_c[0], k_c[1], v_c, lam, DA_SCALE)) if ctx_out else None
    return y_l, y_c


def peer_ffn(h, wq, k1, k2, u_tab, v_tab):
    B, T, D = h.shape
    q = (h @ wq).reshape(B, T, PEER_HEADS, 2, PEER_DK // 2)
    s1 = jnp.einsum('bthd,nd->bthn', q[..., 0, :], k1)
    s2 = jnp.einsum('bthd,nd->bthn', q[..., 1, :], k2)
    v1, i1 = lax.top_k(s1, PEER_TOPK)
    v2, i2 = lax.top_k(s2, PEER_TOPK)
    cand = (v1[..., :, None] + v2[..., None, :]).reshape(B, T, PEER_HEADS, PEER_TOPK * PEER_TOPK)
    cidx = (i1[..., :, None] * PEER_NKEYS + i2[..., None, :]).reshape(B, T, PEER_HEADS, PEER_TOPK * PEER_TOPK)
    best, sel = lax.top_k(cand, PEER_TOPK)
    eidx = jnp.take_along_axis(cidx, sel, axis=-1)
    gate = jax.nn.softmax(best.astype(jnp.float32), axis=-1).astype(h.dtype)
    n = (B * T) // PEER_CHUNK
    kk = PEER_HEADS * PEER_TOPK

    def chunk(args):
        hc, ec, gc = args
        act = jax.nn.gelu(jnp.einsum('ckd,cd->ck', u_tab[ec], hc))
        return jnp.einsum('ck,ckd->cd', gc * act, v_tab[ec])

    y = lax.map(chunk, (h.reshape(n, PEER_CHUNK, D), eidx.reshape(n, PEER_CHUNK, kk), gate.reshape(n, PEER_CHUNK, kk)))
    return y.reshape(B, T, D)


def setup_inputs(seed: int = 0) -> dict:
    key = jax.random.key(seed)
    keys = iter(jax.random.split(key, 32))

    def nrm(shape, std):
        return jax.random.normal(next(keys), shape, jnp.float32) * std

    D = D_MODEL
    return {
        'x': nrm((BATCH, SEQ, D), 1.0),
        'c': nrm((BATCH, D), 1.0),
        'ctx': nrm((BATCH, CTX_LEN, D), 1.0),
        'c_ctx': nrm((D,), 1.0),
        'mod_w': nrm((DEPTH, D, 6 * D), 0.5 * D ** -0.5),
        'mod_b': nrm((DEPTH, 6 * D), 0.02),
        'ln_g': 1.0 + nrm((DEPTH, 2, D), 0.02),
        'ln_b': nrm((DEPTH, 2, D), 0.02),
        'peer_wq': nrm((DEPTH, D, PEER_HEADS * PEER_DK), D ** -0.5),
        'peer_k1': nrm((DEPTH, PEER_NKEYS, PEER_DK // 2), (PEER_DK // 2) ** -0.5),
        'peer_k2': nrm((DEPTH, PEER_NKEYS, PEER_DK // 2), (PEER_DK // 2) ** -0.5),
        'peer_u': nrm((DEPTH, PEER_EXPERTS, D), D ** -0.5),
        'peer_v': nrm((DEPTH, PEER_EXPERTS, D), BETA),
        'gm_w_in': nrm((N_LAYERS_A, D, 2 * GM_DIM), D ** -0.5),
        'gm_ln_g': 1.0 + nrm((N_LAYERS_A, GM_DIM), 0.02),
        'gm_ln_b': nrm((N_LAYERS_A, GM_DIM), 0.02),
        'gm_ws': nrm((N_LAYERS_A, GM_GROUPS, GM_CHUNK, GM_CHUNK), GM_CHUNK ** -0.5),
        'gm_bs': 1.0 + nrm((N_LAYERS_A, GM_GROUPS, GM_CHUNK), 0.1),
        'gm_w_out': nrm((N_LAYERS_A, GM_DIM, D), BETA * GM_DIM ** -0.5),
        'mla_w_in': nrm((N_LAYERS_B, D, MLA_Q_RANK + MLA_KV_RANK + MLA_ROPE), D ** -0.5),
        'mla_q_norm': 1.0 + nrm((N_LAYERS_B, MLA_Q_RANK), 0.02),
        'mla_kv_norm': 1.0 + nrm((N_LAYERS_B, MLA_KV_RANK), 0.02),
        'mla_w_uq': nrm((N_LAYERS_B, MLA_Q_RANK, MLA_HEADS * (MLA_NOPE + MLA_ROPE)), MLA_Q_RANK ** -0.5),
        'mla_w_ukv': nrm((N_LAYERS_B, MLA_KV_RANK, MLA_HEADS * (MLA_NOPE + MLA_V)), MLA_KV_RANK ** -0.5),
        'mla_w_out': nrm((N_LAYERS_B, MLA_HEADS * MLA_V, D), BETA * (MLA_HEADS * MLA_V) ** -0.5),
        'da_w_in': nrm((N_LAYERS_C, D, 3 * D), D ** -0.5),
        'da_lambda': nrm((N_LAYERS_C, 4, DA_HEAD), 0.1),
        'da_subln': 1.0 + nrm((N_LAYERS_C, 2 * DA_HEAD), 0.02),
        'da_w_out': nrm((N_LAYERS_C, D, D), BETA * D ** -0.5),
    }


def reference(x, c, ctx, c_ctx, mod_w, mod_b, ln_g, ln_b,
              peer_wq, peer_k1, peer_k2, peer_u, peer_v,
              gm_w_in, gm_ln_g, gm_ln_b, gm_ws, gm_bs, gm_w_out,
              mla_w_in, mla_q_norm, mla_kv_norm, mla_w_uq, mla_w_ukv, mla_w_out,
              da_w_in, da_lambda, da_subln, da_w_out):
    n_tokens = x.shape[1]
    rope = axial_rope_tables(n_tokens)
    silu_c = jax.nn.silu(c)
    silu_cc = jax.nn.silu(c_ctx)
    xl, xc = x, ctx
    for i in range(DEPTH):
        kind = i % N_MIXERS
        j = i // N_MIXERS
        last = i == DEPTH - 1
        mod_l = silu_c @ mod_w[i] + mod_b[i]
        mod_c = silu_cc @ mod_w[i] + mod_b[i]
        sh1, sc1, g1, sh2, sc2, g2 = jnp.split(mod_l[:, None, :], 6, axis=-1)
        csh1, csc1, cg1, csh2, csc2, cg2 = jnp.split(mod_c, 6, axis=-1)
        hl = _modulate(xl, sh1, sc1)
        need_ctx_in = (not last) or kind != 0
        hc = _modulate(xc, csh1, csc1) if need_ctx_in else None
        if kind == 0:
            yl, yc = gmlp_mixer(hl, hc, gm_w_in[j], gm_ln_g[j], gm_ln_b[j], gm_ws[j], gm_bs[j], gm_w_out[j])
        elif kind == 1:
            yl, yc = mla_mixer(hl, hc, rope, mla_w_in[j], mla_q_norm[j], mla_kv_norm[j],
                               mla_w_uq[j], mla_w_ukv[j], mla_w_out[j], not last)
        else:
            lam_init = 0.8 - 0.6 * math.exp(-0.3 * i)
            yl, yc = diff_attn_mixer(hl, hc, rope, da_w_in[j], da_lambda[j], da_subln[j],
                                     da_w_out[j], lam_init, not last)
        xl = _post_norm(xl, g1 * yl, ln_g[i, 0], ln_b[i, 0])
        yl = peer_ffn(_modulate(xl, sh2, sc2), peer_wq[i], peer_k1[i], peer_k2[i], peer_u[i], peer_v[i])
        xl = _post_norm(xl, g2 * yl, ln_g[i, 1], ln_b[i, 1])
        if not last:
            xc = _post_norm(xc, cg1 * yc, ln_g[i, 0], ln_b[i, 0])
            yc = peer_ffn(_modulate(xc, csh2, csc2), peer_wq[i], peer_k1[i], peer_k2[i], peer_u[i], peer_v[i])
            xc = _post_norm(xc, cg2 * yc, ln_g[i, 1], ln_b[i, 1])
    return xl
```

```cpp
#include <hip/hip_runtime.h>
#include <cstdio>
#include <cstdint>
#ifndef MK_ONE_LAUNCH
#define MK_ONE_LAUNCH 1
#endif
__device__ __forceinline__ int launder_v(int v) { asm volatile("" : "+v"(v)); return v; }
namespace pg8 {
#define PG8_LAS __attribute__((address_space(3)))
typedef unsigned short bf16_t;
typedef short bf16x8 __attribute__((ext_vector_type(8)));
typedef float f32x4 __attribute__((ext_vector_type(4)));
typedef unsigned u32x4 __attribute__((ext_vector_type(4)));
constexpr int BM = 256, BK = 64, HALF = 128, HTB = HALF * BK * 2  , STAGE_BYTES = 8 * HTB, NXCD = 8, WGM = 8;

__host__ __device__ __forceinline__ int lds_byte(int r, int c) { const int st = (r >> 4) * 2 + (c >> 5), rr = r & 15, cc = c & 31, ob = rr * 64 + cc * 2; return st * 1024 + (ob ^ (((ob >> 9) & 1) << 5)); }
__host__ __device__ __forceinline__ void stage_rc(int b, int& R, int& C) { const int st = b / 1024, sb = b % 1024, swz = sb ^ (((sb >> 9) & 1) << 5); R = (st >> 1) * 16 + swz / 64; C = (st & 1) * 32 + (swz % 64) / 2; }
__host__ __device__ __forceinline__ int perm32(int rho) { const int n = rho >> 4, i = rho & 15; return 8 * (i >> 2) + 4 * n + (i & 3); }

struct Unit { int pm, pn; };
struct Gemm { const bf16_t* A; const bf16_t* Bt; int M, N, K; };

struct StaticOrder {
    int nM, nN, nwg, G, c;
    __host__ __device__ void init(int M, int N, int G_, int c_) { nM = M / BM; nN = N / BM; nwg = nM * nN; G = G_; c = c_; }
    __host__ __device__ bool next(int i, Unit& u) const {
        const long L = (long)i * G + c; if (L >= nwg) return false;
        int wgid = (int)L; { const int q = nwg / NXCD, r = nwg % NXCD, xcd = wgid % NXCD, off = wgid / NXCD; wgid = (xcd < r ? xcd * (q + 1) : r * (q + 1) + (xcd - r) * q) + off; }
        const int nig = WGM * nN, gid = wgid / nig, fm = gid * WGM, gsz = (nM - fm) < WGM ? (nM - fm) : WGM;
        u.pm = fm + ((wgid % nig) % gsz); u.pn = (wgid % nig) / gsz; return true;
    }
    __device__ __forceinline__ void a_ready(const Unit&) const {}
    __device__ __forceinline__ void done(const Unit&) const {}
};

__device__ __forceinline__ unsigned cvt_pk_bf16(float lo, float hi) { unsigned r; asm volatile("v_cvt_pk_bf16_f32 %0, %1, %2" : "=v"(r) : "v"(lo), "v"(hi)); return r; }
typedef float f32x2 __attribute__((ext_vector_type(2)));
__device__ __forceinline__ f32x2 gelu_pk(f32x2 v) {
    const f32x2 av = __builtin_elementwise_abs(v), d = av * 0.2316418882f + 1.0f;
    f32x2 t; t.x = __builtin_amdgcn_rcpf(d.x); t.y = __builtin_amdgcn_rcpf(d.y);
    f32x2 q = t * 0.5307027145f + (-0.7265760135f); q = q * t + 0.7107068705f; q = q * t + (-0.142248368f); q = q * t + 0.127414796f; q = q * t;
    const f32x2 s = (v * v) * (-0.72134752044f);
    f32x2 e; e.x = __builtin_amdgcn_exp2f(s.x); e.y = __builtin_amdgcn_exp2f(s.y);
    const f32x2 m = v * (q * e), r = v - m;
    f32x2 o; o.x = v.x < 0.f ? m.x : r.x; o.y = v.y < 0.f ? m.y : r.y; return o;
}

template <int ACT  > struct EpiBf16 {
    static constexpr bool PERM = true, AFTER_DRAIN = false; static_assert(ACT == 0 || ACT == 1, "EpiBf16: ACT is 0 (none) or 1 (gelu_pk)");
    bf16_t* O; int ldc; const float* bias; int split_cols; size_t split_stride; float scale0;
    __device__ __forceinline__ void operator()(const f32x4 (&acc)[2][2][4][2], const Unit& u, int wr, int wc, int fr, int fq) const {
        const int row0 = u.pm * BM + wr * 64 + fr; int colt = u.pn * BM; bf16_t* base = O;
        float sc = 1.f; if (split_cols) { const int t = colt / split_cols; base += (size_t)t * split_stride; colt -= t * split_cols; if (t == 0) sc = scale0; }
        const int col0 = colt + wc * 32 + 8 * fq, bcol0 = u.pn * BM + wc * 32 + 8 * fq;
        f32x4 bv[2][2];
#pragma unroll
        for (int bj = 0; bj < 2; ++bj)
#pragma unroll
            for (int n = 0; n < 2; ++n) bv[bj][n] = bias ? *(const f32x4*)(bias + bcol0 + bj * HALF + 4 * n) : (f32x4){0.f, 0.f, 0.f, 0.f};
#pragma unroll
        for (int ai = 0; ai < 2; ++ai)
#pragma unroll
            for (int m = 0; m < 4; ++m) { bf16_t* rowp = base + (size_t)(row0 + ai * HALF + m * 16) * ldc + col0;
#pragma unroll
                for (int bj = 0; bj < 2; ++bj) { f32x4 v0 = acc[ai][bj][m][0] + bv[bj][0], v1 = acc[ai][bj][m][1] + bv[bj][1];
                    if (ACT == 1) { f32x2 a = gelu_pk((f32x2){v0[0], v0[1]}), b = gelu_pk((f32x2){v0[2], v0[3]}), c = gelu_pk((f32x2){v1[0], v1[1]}), d = gelu_pk((f32x2){v1[2], v1[3]});
                        v0 = (f32x4){a.x, a.y, b.x, b.y}; v1 = (f32x4){c.x, c.y, d.x, d.y}; }
                    v0 = v0 * sc; v1 = v1 * sc; u32x4 w; w.x = cvt_pk_bf16(v0[0], v0[1]); w.y = cvt_pk_bf16(v0[2], v0[3]); w.z = cvt_pk_bf16(v1[0], v1[1]); w.w = cvt_pk_bf16(v1[2], v1[3]);
                    *(u32x4*)(rowp + bj * HALF) = w; } }
    }
};
template <class Epi, class Sched, bool ALIGN_EPI = false, bool SP2 = false>
__device__ __forceinline__ void gemm_phase(PG8_LAS unsigned char* lds, const Gemm g, const Sched& S, const Epi& E) {
    const int tid = launder_v(threadIdx.x), wid = __builtin_amdgcn_readfirstlane(tid >> 6), lane = tid & 63, wr = wid >> 2, wc = wid & 3, fr = lane & 15, fq = lane >> 4;
    const int K = g.K, nt = K / BK;
    unsigned voffA[2], voffB[2];
#pragma unroll
    for (int i = 0; i < 2; ++i) { int R, C; stage_rc(tid * 16 + i * 8192, R, C); const int Rb = Epi::PERM ? ((R & ~31) + perm32(R & 31)) : R;
        voffA[i] = (unsigned)(R * K + C) * 2u; voffB[i] = (unsigned)(Rb * K + C) * 2u; }
    const size_t kstep = (size_t)(BK * 2);
    const size_t hstep = (size_t)HALF * K * 2;
    const size_t tstep = 2 * hstep;
    const unsigned ldsw = (unsigned)wid * 1024u;
    const int aoff = lds_byte(wr * 64 + fr, fq * 8), boff = lds_byte(wc * 32 + fr, fq * 8);
#define PG8_SA(b, h) (((b) * 2 + (h)) * HTB)
#define PG8_SB(b, h) ((4 + (b) * 2 + (h)) * HTB)
#define PG8_STAGE(bufoff, gbase, voff) do { _Pragma("unroll") for (int _i = 0; _i < 2; ++_i) \
        __builtin_amdgcn_global_load_lds((const unsigned*)((const char*)(gbase) + (voff)[_i]), (PG8_LAS unsigned*)(lds + (bufoff) + ldsw + _i * 8192), 16, 0, 0); } while (0)
#define PG8_LDA(dst, b, h) do { _Pragma("unroll") for (int m = 0; m < 4; ++m) _Pragma("unroll") for (int k = 0; k < 2; ++k) dst[m][k] = *(const PG8_LAS bf16x8*)(lds + PG8_SA(b, h) + aoff + m * 2048 + k * 1024); } while (0)
#define PG8_LDB(dst, b, h) do { _Pragma("unroll") for (int n = 0; n < 2; ++n) _Pragma("unroll") for (int k = 0; k < 2; ++k) dst[n][k] = *(const PG8_LAS bf16x8*)(lds + PG8_SB(b, h) + boff + n * 2048 + k * 1024); } while (0)
#define PG8_MMA(ai, bj, At, Bt) do { __builtin_amdgcn_s_setprio(1); _Pragma("unroll") for (int m = 0; m < 4; ++m) _Pragma("unroll") for (int n = 0; n < 2; ++n) _Pragma("unroll") for (int k = 0; k < 2; ++k) \
        acc[ai][bj][m][n] = __builtin_amdgcn_mfma_f32_16x16x32_bf16(Bt[n][k], At[m][k], acc[ai][bj][m][n], 0, 0, 0); __builtin_amdgcn_s_setprio(0); } while (0)
#define PG8_WAIT_V(n) asm volatile("s_waitcnt vmcnt(" #n ")" ::: "memory")
#define PG8_WAIT_L(n) asm volatile("s_waitcnt lgkmcnt(" #n ")" ::: "memory")
#define PG8_BAR __builtin_amdgcn_s_barrier()
#define PG8_SCHED __builtin_amdgcn_sched_barrier(0)
    Unit cur, nxt; int ui = 0;
    if (!S.next(0, cur)) return;
    f32x4 acc[2][2][4][2];
#pragma unroll
    for (int a = 0; a < 2; ++a)
#pragma unroll
        for (int b = 0; b < 2; ++b)
#pragma unroll
            for (int m = 0; m < 4; ++m)
#pragma unroll
                for (int n = 0; n < 2; ++n) acc[a][b][m][n] = (f32x4){0.f, 0.f, 0.f, 0.f};
    bf16x8 At[4][2], B0[2][2], B1[2][2];
    const char* cA = (const char*)g.A + (size_t)cur.pm * tstep; const char* cB = (const char*)g.Bt + (size_t)cur.pn * tstep;
    S.a_ready(cur);
    if constexpr (SP2) {
        PG8_STAGE(PG8_SB(0, 0), cB, voffB); PG8_STAGE(PG8_SB(0, 1), cB + hstep, voffB); PG8_STAGE(PG8_SA(0, 0), cA, voffA); PG8_STAGE(PG8_SA(0, 1), cA + hstep, voffA);
        if (wr == 1) PG8_BAR;
        PG8_WAIT_V(2); PG8_BAR;
        PG8_STAGE(PG8_SB(1, 0), cB + kstep, voffB); PG8_STAGE(PG8_SA(1, 0), cA + kstep, voffA); PG8_STAGE(PG8_SB(1, 1), cB + hstep + kstep, voffB);
        PG8_WAIT_V(6); PG8_BAR;
    } else {
        PG8_STAGE(PG8_SB(0, 0), cB, voffB); PG8_STAGE(PG8_SA(0, 0), cA, voffA); PG8_STAGE(PG8_SB(0, 1), cB + hstep, voffB); PG8_STAGE(PG8_SA(0, 1), cA + hstep, voffA);
        if (wr == 1) PG8_BAR;
        PG8_WAIT_V(4); PG8_BAR;
        PG8_STAGE(PG8_SB(1, 0), cB + kstep, voffB); PG8_STAGE(PG8_SA(1, 0), cA + kstep, voffA); PG8_STAGE(PG8_SB(1, 1), cB + hstep + kstep, voffB);
        PG8_WAIT_V(6); PG8_BAR;
    }
    for (;;) {
        const bool has_next = S.next(ui + 1, nxt);
        const char* nA = has_next ? (const char*)g.A + (size_t)nxt.pm * tstep : cA; const char* nB = has_next ? (const char*)g.Bt + (size_t)nxt.pn * tstep : cB;
        for (int t = 0; t < nt; t += 2) {
            const bool last = (t == nt - 2);
            const char* a1 = cA + (size_t)(t + 1) * kstep;
            const char* a2 = last ? nA : cA + (size_t)(t + 2) * kstep; const char* b2 = last ? nB : cB + (size_t)(t + 2) * kstep;
            const char* a3 = a2 + kstep; const char* b3 = b2 + kstep;
            if (last && has_next) S.a_ready(nxt);
            if constexpr (SP2) {
            PG8_LDB(B0, 0, 0); PG8_LDB(B1, 0, 1); PG8_SCHED; PG8_LDA(At, 0, 0); PG8_STAGE(PG8_SA(1, 1), a1 + hstep, voffA);
            PG8_WAIT_V(8); PG8_WAIT_L(0); PG8_BAR; PG8_MMA(0, 0, At, B0); PG8_MMA(0, 1, At, B1); PG8_BAR; PG8_SCHED;
            PG8_LDA(At, 0, 1); PG8_STAGE(PG8_SB(0, 0), b2, voffB); PG8_STAGE(PG8_SB(0, 1), b2 + hstep, voffB); PG8_STAGE(PG8_SA(0, 0), a2, voffA);
            PG8_WAIT_V(8); PG8_WAIT_L(0); PG8_BAR; PG8_MMA(1, 0, At, B0); PG8_MMA(1, 1, At, B1); PG8_BAR; PG8_SCHED;
            PG8_LDB(B0, 1, 0); PG8_LDB(B1, 1, 1); PG8_SCHED; PG8_LDA(At, 1, 0); PG8_STAGE(PG8_SA(0, 1), a2 + hstep, voffA);
            PG8_WAIT_V(8); PG8_WAIT_L(0); PG8_BAR; PG8_MMA(0, 0, At, B0); PG8_MMA(0, 1, At, B1); PG8_BAR; PG8_SCHED;
            PG8_LDA(At, 1, 1); PG8_STAGE(PG8_SB(1, 0), b3, voffB); PG8_STAGE(PG8_SB(1, 1), b3 + hstep, voffB); PG8_STAGE(PG8_SA(1, 0), a3, voffA);
            PG8_WAIT_V(8); PG8_WAIT_L(0); PG8_BAR; PG8_MMA(1, 0, At, B0); PG8_MMA(1, 1, At, B1); PG8_BAR; PG8_SCHED;
            } else {
            PG8_LDB(B0, 0, 0); PG8_SCHED; PG8_LDA(At, 0, 0); PG8_STAGE(PG8_SA(1, 1), a1 + hstep, voffA);
            PG8_WAIT_L(8); PG8_BAR; PG8_WAIT_L(0); PG8_MMA(0, 0, At, B0); PG8_BAR; PG8_SCHED;
            PG8_LDB(B1, 0, 1); PG8_STAGE(PG8_SB(0, 0), b2, voffB);
            PG8_BAR; PG8_WAIT_L(0); PG8_MMA(0, 1, At, B1); PG8_BAR;
            PG8_LDA(At, 0, 1); PG8_STAGE(PG8_SA(0, 0), a2, voffA);
            PG8_BAR; PG8_WAIT_L(0); PG8_MMA(1, 0, At, B0); PG8_BAR; PG8_SCHED;
            PG8_STAGE(PG8_SB(0, 1), b2 + hstep, voffB);
            PG8_WAIT_V(6); PG8_BAR; PG8_MMA(1, 1, At, B1); PG8_BAR;
            PG8_LDB(B0, 1, 0); PG8_SCHED; PG8_LDA(At, 1, 0); PG8_STAGE(PG8_SA(0, 1), a2 + hstep, voffA);
            PG8_WAIT_L(8); PG8_BAR; PG8_WAIT_L(0); PG8_MMA(0, 0, At, B0); PG8_BAR; PG8_SCHED;
            PG8_LDB(B1, 1, 1); PG8_STAGE(PG8_SB(1, 0), b3, voffB);
            PG8_BAR; PG8_WAIT_L(0); PG8_MMA(0, 1, At, B1); PG8_BAR;
            PG8_LDA(At, 1, 1); PG8_STAGE(PG8_SA(1, 0), a3, voffA);
            PG8_BAR; PG8_WAIT_L(0); PG8_MMA(1, 0, At, B0); PG8_BAR; PG8_SCHED;
            PG8_STAGE(PG8_SB(1, 1), b3 + hstep, voffB);
            PG8_WAIT_V(6); PG8_BAR; PG8_MMA(1, 1, At, B1); PG8_BAR;
            }
        }
        if constexpr (ALIGN_EPI) { if (wr == 0) PG8_BAR; }
        if constexpr (!Epi::AFTER_DRAIN) { E(acc, cur, wr, wc, fr, fq); S.done(cur); }
        if (!has_next) break;
#pragma unroll
        for (int a = 0; a < 2; ++a)
#pragma unroll
            for (int b = 0; b < 2; ++b)
#pragma unroll
                for (int m = 0; m < 4; ++m)
#pragma unroll
                    for (int n = 0; n < 2; ++n) acc[a][b][m][n] = (f32x4){0.f, 0.f, 0.f, 0.f};
        cur = nxt; cA = nA; cB = nB; ++ui;
        if constexpr (ALIGN_EPI) { if (wr == 1) PG8_BAR; }
    }
    PG8_WAIT_V(0);
    if constexpr (!ALIGN_EPI) { if (wr == 0) PG8_BAR; }
    PG8_BAR;
    if constexpr (Epi::AFTER_DRAIN) { E.fused(acc, cur, wr, wc, fr, fq, lds, wid, lane); S.done(cur); }
#undef PG8_SA
#undef PG8_SB
#undef PG8_STAGE
#undef PG8_LDA
#undef PG8_LDB
#undef PG8_MMA
#undef PG8_WAIT_V
#undef PG8_WAIT_L
#undef PG8_BAR
#undef PG8_SCHED
}
}

namespace pg8 {
__device__ __forceinline__ float gelu_tanh(float x) {
    const float t = x * (1.5957691216057308f + 0.07135481627f * x * x);
    const float e = __builtin_amdgcn_exp2f(-1.4426950408889634f * t);
    return x * __builtin_amdgcn_rcpf(1.0f + e);
}
template <int ACT> struct EpiT {
    static constexpr bool PERM = true, AFTER_DRAIN = false;
    bf16_t* O; int ldc;
    __device__ __forceinline__ void operator()(const f32x4 (&acc)[2][2][4][2], const Unit& u, int wr, int wc, int fr, int fq) const {
        const int row0 = u.pm * BM + wr * 64 + fr; const int col0 = u.pn * BM + wc * 32 + 8 * fq;
#pragma unroll
        for (int ai = 0; ai < 2; ++ai)
#pragma unroll
            for (int m = 0; m < 4; ++m) { bf16_t* rowp = O + (size_t)(row0 + ai * HALF + m * 16) * ldc + col0;
#pragma unroll
                for (int bj = 0; bj < 2; ++bj) { f32x4 v0 = acc[ai][bj][m][0], v1 = acc[ai][bj][m][1];
                    if (ACT == 2) { v0 = (f32x4){gelu_tanh(v0[0]), gelu_tanh(v0[1]), gelu_tanh(v0[2]), gelu_tanh(v0[3])}; v1 = (f32x4){gelu_tanh(v1[0]), gelu_tanh(v1[1]), gelu_tanh(v1[2]), gelu_tanh(v1[3])}; }
                    u32x4 w; w.x = cvt_pk_bf16(v0[0], v0[1]); w.y = cvt_pk_bf16(v0[2], v0[3]); w.z = cvt_pk_bf16(v1[0], v1[1]); w.w = cvt_pk_bf16(v1[2], v1[3]);
                    *(u32x4*)(rowp + bj * HALF) = w; } }
    }
};
struct EpiR {
    static constexpr bool PERM = true, AFTER_DRAIN = false;
    bf16_t* O; int ldc; int act;
    __device__ __forceinline__ void operator()(const f32x4 (&acc)[2][2][4][2], const Unit& u, int wr, int wc, int fr, int fq) const {
        const int row0 = u.pm * BM + wr * 64 + fr; const int col0 = u.pn * BM + wc * 32 + 8 * fq;
#pragma unroll
        for (int ai = 0; ai < 2; ++ai)
#pragma unroll
            for (int m = 0; m < 4; ++m) { bf16_t* rowp = O + (size_t)(row0 + ai * HALF + m * 16) * ldc + col0;
#pragma unroll
                for (int bj = 0; bj < 2; ++bj) { f32x4 v0 = acc[ai][bj][m][0], v1 = acc[ai][bj][m][1];
                    if (act) { v0 = (f32x4){gelu_tanh(v0[0]), gelu_tanh(v0[1]), gelu_tanh(v0[2]), gelu_tanh(v0[3])}; v1 = (f32x4){gelu_tanh(v1[0]), gelu_tanh(v1[1]), gelu_tanh(v1[2]), gelu_tanh(v1[3])}; }
                    u32x4 w; w.x = cvt_pk_bf16(v0[0], v0[1]); w.y = cvt_pk_bf16(v0[2], v0[3]); w.z = cvt_pk_bf16(v1[0], v1[1]); w.w = cvt_pk_bf16(v1[2], v1[3]);
                    *(u32x4*)(rowp + bj * HALF) = w; } }
    }
};
}

constexpr int DM = 2048, NBATCH = 2, SEQ = 8192, CTXL = 256;
constexpr int ML = NBATCH * SEQ;
constexpr int MC = NBATCH * CTXL;
constexpr int MT = ML + MC;
constexpr int NLAYER = 4;
constexpr float ALPHA = 1.6817928305074290f, LN_EPS = 1e-6f;
constexpr int NWAVES = 8;
constexpr int NPH = 36;

constexpr size_t MiB = 1ull << 20;
constexpr size_t WS_CTL = 0, CTL_ZERO_BYTES = 1 * MiB;
constexpr int    CW_BAR = 4096;
constexpr size_t WS_MOD = 128 * 1024;
constexpr size_t WS_VST = 1 * MiB;
constexpr size_t WS_GMWIN = 2 * MiB;
constexpr size_t WS_GMWOUT = WS_GMWIN + 32 * MiB;
constexpr size_t WS_GMWS = WS_GMWOUT + 16 * MiB;
constexpr size_t WS_PWQ = WS_GMWS + 1 * MiB;
constexpr size_t WS_PK1 = WS_PWQ + 32 * MiB;
constexpr size_t WS_PK2 = WS_PK1 + 512 * 1024;
constexpr size_t WS_MLAIN = WS_PK1 + 1 * MiB;
constexpr size_t WS_MLAUQ = WS_MLAIN + 5 * MiB;
constexpr size_t WS_MLAUKV = WS_MLAUQ + 3 * MiB;
constexpr size_t WS_MLAOUT = WS_MLAUKV + 4 * MiB;
constexpr size_t WS_DAIN = WS_MLAOUT + 8 * MiB;
constexpr size_t WS_DAOUT = WS_DAIN + 24 * MiB;
constexpr size_t WS_PU = WS_DAOUT + 8 * MiB;
constexpr size_t WS_PV = WS_PU + 256 * MiB;
constexpr size_t WS_X = WS_PV + 256 * MiB;
constexpr size_t WS_H = WS_X + 66 * MiB;
constexpr size_t WS_G = WS_H + 66 * MiB;
constexpr size_t WS_Y = WS_G + 66 * MiB;
constexpr size_t WS_QP = WS_Y + 66 * MiB;
constexpr size_t WS_Z = WS_QP + 66 * MiB;
constexpr size_t WS_C = WS_Z + 198 * MiB;
constexpr size_t WS_CQN = WS_C + 42 * MiB;
constexpr size_t WS_CKVN = WS_CQN + 17 * MiB;
constexpr size_t WS_KR = WS_CKVN + 17 * MiB;
constexpr size_t WS_QM = WS_KR + 3 * MiB;
constexpr size_t WS_KV = WS_QM + 99 * MiB;
constexpr size_t WS_ROUTE = WS_KV + 132 * MiB;
constexpr size_t WS_END = WS_ROUTE + 17 * MiB;
static_assert((size_t)MT * DM * 2 == 66 * MiB, "row buffer size");

constexpr int RING_BYTES = 143360, MISC_OFF = RING_BYTES + 320, LDS_BYTES = 147456;

#define GAS __attribute__((address_space(1)))
#define LAS __attribute__((address_space(3)))
typedef unsigned short bf16;
typedef unsigned u32x4 __attribute__((ext_vector_type(4)));
typedef unsigned u32x2 __attribute__((ext_vector_type(2)));
typedef float f32x4 __attribute__((ext_vector_type(4)));
typedef float f32x16 __attribute__((ext_vector_type(16)));
typedef short bf16x8 __attribute__((ext_vector_type(8)));
typedef short s16x4 __attribute__((ext_vector_type(4)));
#define LDS_WAIT() asm volatile("s_waitcnt lgkmcnt(0)" ::: "memory")

__device__ __forceinline__ unsigned cvtpk(float lo, float hi) { unsigned r; asm("v_cvt_pk_bf16_f32 %0, %1, %2" : "=v"(r) : "v"(lo), "v"(hi)); return r; }
__device__ __forceinline__ float bflo(unsigned w) { return __uint_as_float(w << 16); }
__device__ __forceinline__ float bfhi(unsigned w) { return __uint_as_float(w & 0xffff0000u); }
__device__ __forceinline__ float bf1(bf16 b) { return __uint_as_float((unsigned)b << 16); }
__device__ __forceinline__ bf16 tobf1(float f) { return (bf16)(cvtpk(f, 0.f) & 0xffffu); }
__device__ __forceinline__ float wave_sum(float v) {
#pragma unroll
    for (int o = 32; o > 0; o >>= 1) v += __shfl_xor(v, o);
    return v;
}
__device__ __forceinline__ float gelu_tanh(float x) { return pg8::gelu_tanh(x); }

__device__ __forceinline__ void load_row_bf16(const bf16* row, int lane, float (&v)[32]) {
#pragma unroll
    for (int j = 0; j < 4; ++j) { const u32x4 w = ((const u32x4*)row)[64 * j + lane];
        v[8 * j + 0] = bflo(w.x); v[8 * j + 1] = bfhi(w.x); v[8 * j + 2] = bflo(w.y); v[8 * j + 3] = bfhi(w.y);
        v[8 * j + 4] = bflo(w.z); v[8 * j + 5] = bfhi(w.z); v[8 * j + 6] = bflo(w.w); v[8 * j + 7] = bfhi(w.w); }
}
__device__ __forceinline__ void store_row_bf16(bf16* row, int lane, const float (&v)[32]) {
#pragma unroll
    for (int j = 0; j < 4; ++j) { u32x4 w; w.x = cvtpk(v[8 * j + 0], v[8 * j + 1]); w.y = cvtpk(v[8 * j + 2], v[8 * j + 3]); w.z = cvtpk(v[8 * j + 4], v[8 * j + 5]); w.w = cvtpk(v[8 * j + 6], v[8 * j + 7]);
        ((u32x4*)row)[64 * j + lane] = w; }
}
__device__ __forceinline__ void load_row_f32(const float* row, int lane, float (&v)[32]) {
#pragma unroll
    for (int j = 0; j < 4; ++j) { const f32x4 a = ((const f32x4*)row)[128 * j + 2 * lane], b = ((const f32x4*)row)[128 * j + 2 * lane + 1];
        v[8 * j + 0] = a.x; v[8 * j + 1] = a.y; v[8 * j + 2] = a.z; v[8 * j + 3] = a.w; v[8 * j + 4] = b.x; v[8 * j + 5] = b.y; v[8 * j + 6] = b.z; v[8 * j + 7] = b.w; }
}
__device__ __forceinline__ void store_row_f32(float* row, int lane, const float (&v)[32]) {
#pragma unroll
    for (int j = 0; j < 4; ++j) { ((f32x4*)row)[128 * j + 2 * lane] = (f32x4){v[8 * j + 0], v[8 * j + 1], v[8 * j + 2], v[8 * j + 3]};
        ((f32x4*)row)[128 * j + 2 * lane + 1] = (f32x4){v[8 * j + 4], v[8 * j + 5], v[8 * j + 6], v[8 * j + 7]}; }
}
__device__ __forceinline__ void ln_stats(const float (&v)[32], float& mean, float& rstd) {
    float s = 0.f;
#pragma unroll
    for (int i = 0; i < 32; ++i) s += v[i];
    mean = wave_sum(s) * (1.0f / DM);
    float q = 0.f;
#pragma unroll
    for (int i = 0; i < 32; ++i) { const float d = v[i] - mean; q += d * d; }
    rstd = 1.0f / sqrtf(wave_sum(q) * (1.0f / DM) + LN_EPS);
}
__device__ __forceinline__ void finish_row(float (&z)[32], const float* lng, const float* lnb, bf16* Xrow, const float* sh, const float* sc, bf16* Hrow, float* Orow, int lane) {
    float mean, rstd; ln_stats(z, mean, rstd);
    { float g[32], b[32]; load_row_f32(lng, lane, g); load_row_f32(lnb, lane, b);
#pragma unroll
      for (int i = 0; i < 32; ++i) z[i] = (z[i] - mean) * rstd * g[i] + b[i]; }
    if (Xrow) store_row_bf16(Xrow, lane, z);
    if (Orow) store_row_f32(Orow, lane, z);
    if (Hrow) {
        ln_stats(z, mean, rstd);
        float a[32], s[32]; load_row_f32(sc, lane, a); load_row_f32(sh, lane, s);
#pragma unroll
        for (int i = 0; i < 32; ++i) a[i] = (z[i] - mean) * rstd * (1.0f + a[i]) + s[i];
        store_row_bf16(Hrow, lane, a);
    }
}
__device__ __forceinline__ int row_slot(int row) { return row < ML ? (row >> 13) : 2; }

__device__ __forceinline__ unsigned f2bf_rne(float f) { unsigned u = __float_as_uint(f); return (u + 0x7fffu + ((u >> 16) & 1u)) >> 16; }
__device__ __forceinline__ unsigned pk2(float lo, float hi) { return f2bf_rne(lo) | (f2bf_rne(hi) << 16); }
__device__ __forceinline__ void p0_transpose_item(const float* W, int K, int N, bf16* WT, LAS float* scr, int item, int lane) {
    const int nblk = N / 32, kb = item / nblk, nb = item % nblk, k0 = 64 * kb, n0 = 32 * nb;
#pragma unroll 8
    for (int i = 0; i < 32; ++i) { const int kk = 2 * i + (lane >> 5); scr[kk * 33 + (lane & 31)] = W[(size_t)(k0 + kk) * N + n0 + (lane & 31)]; }
    LDS_WAIT(); asm volatile("" ::: "memory");
    const int c = lane & 7;
#pragma unroll
    for (int j = 0; j < 4; ++j) { const int n = (lane >> 3) + 8 * j; const LAS float* s = scr + (8 * c) * 33 + n;
        u32x4 o; o.x = pk2(s[0 * 33], s[1 * 33]); o.y = pk2(s[2 * 33], s[3 * 33]); o.z = pk2(s[4 * 33], s[5 * 33]); o.w = pk2(s[6 * 33], s[7 * 33]);
        *(u32x4*)(WT + (size_t)(n0 + n) * K + k0 + 8 * c) = o; }
    LDS_WAIT(); asm volatile("" ::: "memory");
}
__device__ __forceinline__ void cvt_range(const float* src, bf16* dst, size_t n8, size_t gtid, size_t gthreads) {
#pragma unroll 4
    for (size_t i = gtid; i < n8; i += gthreads) { const f32x4 a = ((const f32x4*)src)[2 * i], b = ((const f32x4*)src)[2 * i + 1];
        u32x4 w; w.x = cvtpk(a.x, a.y); w.y = cvtpk(a.z, a.w); w.z = cvtpk(b.x, b.y); w.w = cvtpk(b.z, b.w); ((u32x4*)dst)[i] = w; }
}
__device__ __forceinline__ float silu(float x) { return x / (1.0f + __expf(-x)); }

struct Params { const float* in[29]; float* out; unsigned char* ws; int ph_lo, ph_hi; };
typedef const __attribute__((address_space(4))) Params* CP;

__device__ __forceinline__ void p0_prologue(CP P, LAS unsigned char* lds, int tid, int lane, int wid, int gw, int NGW) {
    unsigned char* ws = P->ws;
    LAS float* scr = (LAS float*)(lds + wid * 16384);
    {
        constexpr int I_GMIN = (2048 / 64) * (4096 / 32), I_SQ = (2048 / 64) * (2048 / 32), I_MIN = (2048 / 64) * (1088 / 32), I_UQ = (512 / 64) * (3072 / 32), I_UKV = (512 / 64) * (4096 / 32), I_DIN = (2048 / 64) * (6144 / 32);
        constexpr int NIT = 2 * I_GMIN + 2 * I_SQ + 4 * I_SQ + I_MIN + I_UQ + I_UKV + I_SQ + I_DIN + I_SQ;
        for (int it = gw; it < NIT; it += NGW) {
            int r = it;
            if (r < 2 * I_GMIN) { const int j = r / I_GMIN; p0_transpose_item(P->in[13] + (size_t)j * 2048 * 4096, 2048, 4096, (bf16*)(ws + WS_GMWIN) + (size_t)j * 4096 * 2048, scr, r % I_GMIN, lane); continue; } r -= 2 * I_GMIN;
            if (r < 2 * I_SQ) { const int j = r / I_SQ; p0_transpose_item(P->in[18] + (size_t)j * 2048 * 2048, 2048, 2048, (bf16*)(ws + WS_GMWOUT) + (size_t)j * 2048 * 2048, scr, r % I_SQ, lane); continue; } r -= 2 * I_SQ;
            if (r < 4 * I_SQ) { const int j = r / I_SQ; p0_transpose_item(P->in[8] + (size_t)j * 2048 * 2048, 2048, 2048, (bf16*)(ws + WS_PWQ) + (size_t)j * 2048 * 2048, scr, r % I_SQ, lane); continue; } r -= 4 * I_SQ;
            if (r < I_MIN) { p0_transpose_item(P->in[19], 2048, 1088, (bf16*)(ws + WS_MLAIN), scr, r, lane); continue; } r -= I_MIN;
            if (r < I_UQ) { p0_transpose_item(P->in[22], 512, 3072, (bf16*)(ws + WS_MLAUQ), scr, r, lane); continue; } r -= I_UQ;
            if (r < I_UKV) { p0_transpose_item(P->in[23], 512, 4096, (bf16*)(ws + WS_MLAUKV), scr, r, lane); continue; } r -= I_UKV;
            if (r < I_SQ) { p0_transpose_item(P->in[24], 2048, 2048, (bf16*)(ws + WS_MLAOUT), scr, r, lane); continue; } r -= I_SQ;
            if (r < I_DIN) { p0_transpose_item(P->in[25], 2048, 6144, (bf16*)(ws + WS_DAIN), scr, r, lane); continue; } r -= I_DIN;
            p0_transpose_item(P->in[28], 2048, 2048, (bf16*)(ws + WS_DAOUT), scr, r, lane);
        }
    }
    const size_t gtid = (size_t)gw * 64 + lane, gthreads = (size_t)NGW * 64;
    { u32x4* z = (u32x4*)((bf16*)(ws + WS_MLAIN) + (size_t)1088 * 2048); const size_t n = (size_t)192 * 2048 / 8;
      for (size_t i = gtid; i < n; i += gthreads) z[i] = (u32x4){0u, 0u, 0u, 0u}; }
    cvt_range(P->in[16], (bf16*)(ws + WS_GMWS), (size_t)2 * 16 * 128 * 128 / 8, gtid, gthreads);
    cvt_range(P->in[9], (bf16*)(ws + WS_PK1), (size_t)4 * 128 * 128 / 8, gtid, gthreads);
    cvt_range(P->in[10], (bf16*)(ws + WS_PK2), (size_t)4 * 128 * 128 / 8, gtid, gthreads);
    cvt_range(P->in[11], (bf16*)(ws + WS_PU), (size_t)4 * 16384 * 2048 / 8, gtid, gthreads);
    cvt_range(P->in[12], (bf16*)(ws + WS_PV), (size_t)4 * 16384 * 2048 / 8, gtid, gthreads);
    {
        const float* cv = P->in[1]; const float* cc = P->in[3]; const float* mw = P->in[4]; const float* mb = P->in[5]; float* MOD = (float*)(ws + WS_MOD);
        for (int item = gw; item < 4 * 192; item += NGW) {
            const int L = item / 192, n = (item % 192) * 64 + lane;
            const float* W = mw + (size_t)L * 2048 * 12288 + n;
            float a0 = 0.f, a1 = 0.f, a2 = 0.f;
#pragma unroll 16
            for (int k = 0; k < 2048; ++k) { const float s0 = silu(cv[k]), s1 = silu(cv[2048 + k]), s2 = silu(cc[k]);
                const float w = W[(size_t)k * 12288]; a0 += s0 * w; a1 += s1 * w; a2 += s2 * w; }
            const float bb = mb[(size_t)L * 12288 + n];
            float* o = MOD + (size_t)(L * 3) * 12288 + n;
            o[0] = a0 + bb; o[12288] = a1 + bb; o[24576] = a2 + bb;
        }
    }
}

__device__ __forceinline__ void first_row_pass(CP P, int lane, int gw, int NGW) {
    const float* MOD = (const float*)(P->ws + WS_MOD); bf16* X = (bf16*)(P->ws + WS_X); bf16* H = (bf16*)(P->ws + WS_H);
    for (int row = gw; row < MT; row += NGW) {
        const float* src = row < ML ? P->in[0] + (size_t)row * DM : P->in[2] + (size_t)(row - ML) * DM;
        float v[32]; load_row_f32(src, lane, v);
        store_row_bf16(X + (size_t)row * DM, lane, v);
        const float* mod = MOD + (size_t)row_slot(row) * 12288;
        float mean, rstd; ln_stats(v, mean, rstd);
        float a[32], s[32]; load_row_f32(mod + 2048, lane, a); load_row_f32(mod, lane, s);
#pragma unroll
        for (int i = 0; i < 32; ++i) a[i] = (v[i] - mean) * rstd * (1.0f + a[i]) + s[i];
        store_row_bf16(H + (size_t)row * DM, lane, a);
    }
}
__device__ __forceinline__ void post_mixer_pass(CP P, int L, int Mrows, int lane, int gw, int NGW) {
    const float* MOD = (const float*)(P->ws + WS_MOD); bf16* X = (bf16*)(P->ws + WS_X); bf16* H = (bf16*)(P->ws + WS_H); const bf16* Y = (const bf16*)(P->ws + WS_Y);
    const float* lng = P->in[6] + (size_t)(L * 2 + 0) * DM; const float* lnb = P->in[7] + (size_t)(L * 2 + 0) * DM;
    for (int row = gw; row < Mrows; row += NGW) {
        const float* mod = MOD + (size_t)(L * 3 + row_slot(row)) * 12288;
        float z[32], y[32], g[32]; load_row_bf16(X + (size_t)row * DM, lane, z); load_row_bf16(Y + (size_t)row * DM, lane, y); load_row_f32(mod + 2 * 2048, lane, g);
#pragma unroll
        for (int i = 0; i < 32; ++i) z[i] = ALPHA * z[i] + g[i] * y[i];
        finish_row(z, lng, lnb, X + (size_t)row * DM, mod + 3 * 2048, mod + 4 * 2048, H + (size_t)row * DM, nullptr, lane);
    }
}
__device__ __forceinline__ void vstats_pass(CP P, int Mrows, int lane, int gw, int NGW) {
    const bf16* Z = (const bf16*)(P->ws + WS_Z); float* VST = (float*)(P->ws + WS_VST);
    for (int row = gw; row < Mrows; row += NGW) {
        float v[32]; load_row_bf16(Z + (size_t)row * 4096 + 2048, lane, v);
        float mean, rstd; ln_stats(v, mean, rstd);
        if (lane == 0) { VST[2 * row] = mean; VST[2 * row + 1] = rstd; }
    }
}
#define XB_TMO      128
#define XB_XCNT(j)  (256  + 64 * (j))
#define XB_XSUB(j)  (1280 + 64 * (j))
#define XB_XGEN(j)  (2304 + 64 * (j))
#define XB_TOP      3328
#define XB_TOPGEN   3392
#define XCD_BAR_WORDS 3456
#define XB_SPIN_CAP (1u << 18)

__device__ __forceinline__ unsigned xb_ld(unsigned* p)              { return __hip_atomic_load(p, __ATOMIC_RELAXED, __HIP_MEMORY_SCOPE_AGENT); }
__device__ __forceinline__ unsigned xb_add(unsigned* p, unsigned v) { return __hip_atomic_fetch_add(p, v, __ATOMIC_RELAXED, __HIP_MEMORY_SCOPE_AGENT); }
__device__ __forceinline__ unsigned xb_xcc_id() { return (unsigned)__builtin_amdgcn_s_getreg((3 << 11) | 20) & 0xFu; }
#define XB_SPIN(cond, bar) do { unsigned _sp = 0; while (cond) { __builtin_amdgcn_s_sleep(1); \
    if ((++_sp & 255u) == 0u) { if (xb_ld(&(bar)[XB_TMO])) break; if (_sp > XB_SPIN_CAP) { atomicAdd(&(bar)[XB_TMO], 1u); break; } } } } while (0)

struct XcdBarrier {
    unsigned* bar; unsigned x;
    volatile LAS unsigned* st;
};

__device__ __forceinline__ XcdBarrier xcd_barrier_post(unsigned* bar, volatile LAS unsigned* st) {
    XcdBarrier b; b.bar = bar; b.x = xb_xcc_id(); b.st = st;
    if (threadIdx.x == 0) (void)xb_add(&bar[XB_XCNT(b.x)], 1u);
    return b;
}
__device__ __forceinline__ void xcd_barrier_complete(unsigned* bar, unsigned x, unsigned& nloc, unsigned& nx) {
    const unsigned G = gridDim.x * gridDim.y * gridDim.z;
    unsigned sum, cnt, mine, sp = 0u;
    for (;;) {
        sum = 0u; cnt = 0u; mine = 0u;
#pragma unroll
        for (unsigned j = 0; j < 16; ++j) { const unsigned c = xb_ld(&bar[XB_XCNT(j)]); sum += c; cnt += (c > 0u) ? 1u : 0u; mine = (j == x) ? c : mine; }
        if (sum == G) break;
        __builtin_amdgcn_s_sleep(1);
        if ((++sp & 255u) == 0u) { if (xb_ld(&bar[XB_TMO])) break; if (sp > XB_SPIN_CAP) { atomicAdd(&bar[XB_TMO], 1u); break; } }
    }
    nloc = mine > 0u ? mine : 1u; nx = cnt > 0u ? cnt : 1u;
}

__device__ __attribute__((noinline)) void xcd_barrier(const XcdBarrier b) {
    asm volatile("s_waitcnt vmcnt(0)" ::: "memory");
    __syncthreads();
    if (threadIdx.x == 0) {
        unsigned* bar = b.bar;
        __builtin_amdgcn_s_waitcnt(0);
        unsigned nloc = b.st[0], nx = b.st[1];
        if (nloc == 0u) { xcd_barrier_complete(bar, b.x, nloc, nx); b.st[0] = nloc; b.st[1] = nx; }
        const unsigned old = xb_add(&bar[XB_XSUB(b.x)], 1u);
        const unsigned gen = old / nloc;
        if (old + 1u == (gen + 1u) * nloc) {
            __builtin_amdgcn_fence(__ATOMIC_RELEASE, "agent");
            asm volatile("s_waitcnt vmcnt(0)" ::: "memory");
            const unsigned og = xb_add(&bar[XB_TOP], 1u);
            const unsigned tg = og / nx;
            if (og + 1u == (tg + 1u) * nx) xb_add(&bar[XB_TOPGEN], 1u);
            else XB_SPIN(xb_ld(&bar[XB_TOPGEN]) == tg, bar);
            __builtin_amdgcn_fence(__ATOMIC_ACQUIRE, "agent");
            xb_add(&bar[XB_XGEN(b.x)], 1u);
            asm volatile("s_waitcnt vmcnt(0)" ::: "memory");
        } else {
            XB_SPIN(xb_ld(&bar[XB_XGEN(b.x)]) == gen, bar);
            __builtin_amdgcn_fence(__ATOMIC_ACQUIRE, "agent");
            asm volatile("s_waitcnt vmcnt(0)" ::: "memory");
        }
    }
    __syncthreads();
}

__device__ __forceinline__ void spatial_phase(CP P, int j, int Mrows, LAS unsigned char* lds_, int tid, int lane, int wid) {
    const bf16* Z = (const bf16*)(P->ws + WS_Z); const float* VST = (const float*)(P->ws + WS_VST); bf16* Gb = (bf16*)(P->ws + WS_G);
    const bf16* WS = (const bf16*)(P->ws + WS_GMWS) + (size_t)j * 16 * 128 * 128;
    const float* lng = P->in[14] + (size_t)j * DM; const float* lnb = P->in[15] + (size_t)j * DM; const float* bs = P->in[17] + (size_t)j * 16 * 128;
    LAS bf16* Vt = (LAS bf16*)(LAS unsigned char*)lds_;
    constexpr int VP = 136;
    const int nunits = (Mrows / 128) * 16;
    for (int u = blockIdx.x; u < nunits; u += gridDim.x) {
        const int c = u >> 4, g = u & 15;
        __syncthreads();
        {
            const int q = tid >> 2, dq = (tid & 3) * 32; const int row = c * 128 + q;
            const float mean = VST[2 * row], rstd = VST[2 * row + 1];
            const bf16* src = Z + (size_t)row * 4096 + 2048 + g * 128 + dq;
#pragma unroll
            for (int t = 0; t < 4; ++t) { const u32x4 w = *(const u32x4*)(src + 8 * t);
                float v[8] = {bflo(w.x), bfhi(w.x), bflo(w.y), bfhi(w.y), bflo(w.z), bfhi(w.z), bflo(w.w), bfhi(w.w)};
                const float* gp = lng + g * 128 + dq + 8 * t; const float* bp = lnb + g * 128 + dq + 8 * t;
#pragma unroll
                for (int i = 0; i < 8; ++i) { const float vn = (v[i] - mean) * rstd * gp[i] + bp[i]; Vt[(dq + 8 * t + i) * VP + q] = tobf1(vn); } }
        }
        __syncthreads();
        const int fr = lane & 15, fq = lane >> 4;
        bf16x8 a[4];
        const bf16* wrow = WS + (size_t)g * 128 * 128 + (size_t)(16 * wid + fr) * 128 + 8 * fq;
#pragma unroll
        for (int ks = 0; ks < 4; ++ks) a[ks] = *(const bf16x8*)(wrow + 32 * ks);
#pragma unroll
        for (int nb = 0; nb < 8; ++nb) {
            f32x4 acc = {0.f, 0.f, 0.f, 0.f};
#pragma unroll
            for (int ks = 0; ks < 4; ++ks) { const bf16x8 b = *(const LAS bf16x8*)(Vt + (16 * nb + fr) * VP + 32 * ks + 8 * fq);
                acc = __builtin_amdgcn_mfma_f32_16x16x32_bf16(a[ks], b, acc, 0, 0, 0); }
#pragma unroll
            for (int r = 0; r < 4; ++r) { const int p = 16 * wid + fq * 4 + r, d = 16 * nb + fr; const size_t grow = (size_t)(c * 128 + p);
                const float sv = acc[r] + bs[g * 128 + p];
                const float uu = bf1(Z[grow * 4096 + g * 128 + d]);
                Gb[grow * 2048 + g * 128 + d] = tobf1(uu * sv); }
        }
    }
}

__device__ __forceinline__ void rope_cs(int row, int l, float& cs, float& sn) {
    const int t = row & (SEQ - 1); const int pos = (l & 32) ? (t & 63) : (t >> 6);
    const float inv = powf(10000.0f, -(float)(l & 15) * (1.0f / 16.0f));
    const float ang = (float)pos * inv; sincosf(ang, &sn, &cs);
}
__device__ __forceinline__ float rope_apply(float x, int l, float cs, float sn) {
    const float p = __shfl_xor(x, 16);
    return (l & 16) ? (p * sn + x * cs) : (x * cs - p * sn);
}
__device__ __forceinline__ void mla_norm_pass(CP P, int lane, int gw, int NGW) {
    const bf16* C = (const bf16*)(P->ws + WS_C); bf16* CQN = (bf16*)(P->ws + WS_CQN); bf16* CKVN = (bf16*)(P->ws + WS_CKVN); bf16* KR = (bf16*)(P->ws + WS_KR);
    const float* qn = P->in[20]; const float* kvn = P->in[21];
    for (int row = gw; row < MT; row += NGW) {
        const bf16* c = C + (size_t)row * 1280;
#pragma unroll
        for (int part = 0; part < 2; ++part) {
            const u32x4 w = *(const u32x4*)(c + part * 512 + 8 * lane);
            float v[8] = {bflo(w.x), bfhi(w.x), bflo(w.y), bfhi(w.y), bflo(w.z), bfhi(w.z), bflo(w.w), bfhi(w.w)};
            float ss = 0.f;
#pragma unroll
            for (int i = 0; i < 8; ++i) ss += v[i] * v[i];
            const float r = 1.0f / sqrtf(wave_sum(ss) * (1.0f / 512.0f) + LN_EPS);
            const float* nw = (part ? kvn : qn) + 8 * lane;
            u32x4 o; o.x = cvtpk(v[0] * r * nw[0], v[1] * r * nw[1]); o.y = cvtpk(v[2] * r * nw[2], v[3] * r * nw[3]); o.z = cvtpk(v[4] * r * nw[4], v[5] * r * nw[5]); o.w = cvtpk(v[6] * r * nw[6], v[7] * r * nw[7]);
            *(u32x4*)((part ? CKVN : CQN) + (size_t)row * 512 + 8 * lane) = o;
        }
        float x = bf1(c[1024 + lane]);
        if (row < ML) { float cs, sn; rope_cs(row, lane, cs, sn); x = rope_apply(x, lane, cs, sn); }
        KR[(size_t)row * 64 + lane] = tobf1(x);
    }
}
__device__ __forceinline__ void rope_pass(bf16* buf, int ld, int col0, int nchunks, int cstride, int lane, int gw, int NGW) {
    for (int row = gw; row < ML; row += NGW) {
        float cs, sn; rope_cs(row, lane, cs, sn);
        bf16* r = buf + (size_t)row * ld + col0 + lane;
#pragma unroll 4
        for (int k = 0; k < nchunks; ++k) { const float x = bf1(r[k * cstride]); r[k * cstride] = tobf1(rope_apply(x, lane, cs, sn)); }
    }
}

namespace att {
#define SBAR() __builtin_amdgcn_sched_barrier(0)
__device__ __forceinline__ int crow(int r, int hi) { return (r & 3) + 8 * (r >> 2) + 4 * hi; }
__device__ __forceinline__ unsigned cvtpkv(float lo, float hi) { unsigned r; asm volatile("v_cvt_pk_bf16_f32 %0, %1, %2" : "=v"(r) : "v"(lo), "v"(hi)); return r; }

__device__ __forceinline__ void partialSM(f32x16& p0, f32x16& p1, float& m_reg, float& mn, float& alpha, const float C, const float THRS) {
  float pmax = p0[0];
#pragma unroll
  for (int r = 1; r < 16; ++r) pmax = fmaxf(pmax, p0[r]);
#pragma unroll
  for (int r = 0; r < 16; ++r) pmax = fmaxf(pmax, p1[r]);
  { auto rr = __builtin_amdgcn_permlane32_swap(__float_as_uint(pmax), __float_as_uint(pmax), false, false);
    pmax = fmaxf(__uint_as_float(rr[0]), __uint_as_float(rr[1])); }
  if (__builtin_expect(__all(pmax - m_reg <= THRS), 1)) { mn = m_reg; alpha = 1.f; }
  else { mn = fmaxf(m_reg, pmax); alpha = __builtin_amdgcn_exp2f((m_reg - mn) * C); m_reg = mn; }
  const float mnC = -mn * C;
#pragma unroll
  for (int r = 0; r < 16; ++r) p0[r] = fmaf(p0[r], C, mnC);
#pragma unroll
  for (int r = 0; r < 16; ++r) p1[r] = fmaf(p1[r], C, mnC);
#pragma unroll
  for (int r = 0; r < 16; ++r) p0[r] = __builtin_amdgcn_exp2f(p0[r]);
}
__device__ __forceinline__ void finishSM(f32x16& p0, f32x16& p1, float alpha, float& l_reg, bf16x8& pa0, bf16x8& pa1, bf16x8& pa2, bf16x8& pa3) {
#pragma unroll
  for (int r = 0; r < 16; ++r) p1[r] = __builtin_amdgcn_exp2f(p1[r]);
  float ps = 0;
#pragma unroll
  for (int r = 0; r < 16; ++r) ps += p0[r];
#pragma unroll
  for (int r = 0; r < 16; ++r) ps += p1[r];
  { auto rr = __builtin_amdgcn_permlane32_swap(__float_as_uint(ps), __float_as_uint(ps), false, false);
    ps = __uint_as_float(rr[0]) + __uint_as_float(rr[1]); }
  l_reg = l_reg * alpha + ps;
#define PK4(P, BASE, OUT) do { unsigned a0 = cvtpkv(P[BASE + 0], P[BASE + 1]), a1 = cvtpkv(P[BASE + 2], P[BASE + 3]);   \
    unsigned b0 = cvtpkv(P[BASE + 4], P[BASE + 5]), b1 = cvtpkv(P[BASE + 6], P[BASE + 7]);                              \
    auto r0 = __builtin_amdgcn_permlane32_swap(a0, b0, false, false); auto r1 = __builtin_amdgcn_permlane32_swap(a1, b1, false, false); \
    u32x4 w = {r0[0], r1[0], r0[1], r1[1]}; OUT = *reinterpret_cast<bf16x8*>(&w); } while (0)
  PK4(p0, 0, pa0); PK4(p0, 8, pa1); PK4(p1, 0, pa2); PK4(p1, 8, pa3);
#undef PK4
}
template <int PITCH> __device__ __forceinline__ int kswz(int r) { return PITCH == 256 ? (r & 15) : ((r >> 1) & 7); }
template <int NQF, int NQR, int PITCH> __device__ __forceinline__ void qkt(f32x16& p0, f32x16& p1, const LAS char* Ks, int chunk0, const bf16x8* qr, const LAS char* ql, int r32, int hi) {
  p0 = f32x16{}; p1 = f32x16{};
  const int sw = kswz<PITCH>(r32);
#pragma unroll
  for (int d0 = 0; d0 < NQF; ++d0) { const int off = ((chunk0 + d0 * 2 + hi) ^ sw) * 16;
    const bf16x8 b0 = *(const LAS bf16x8*)(Ks + r32 * PITCH + off);
    const bf16x8 b1 = *(const LAS bf16x8*)(Ks + (32 + r32) * PITCH + off);
    const bf16x8 q = d0 < NQR ? qr[d0 < NQR ? d0 : 0] : *(const LAS bf16x8*)(ql + (d0 - NQR) * 1024);
    p0 = __builtin_amdgcn_mfma_f32_32x32x16_bf16(b0, q, p0, 0, 0, 0);
    p1 = __builtin_amdgcn_mfma_f32_32x32x16_bf16(b1, q, p1, 0, 0, 0); }
}
__device__ __forceinline__ int v_st(int k, int c) { const int kk = (k & ~0xC) | ((k & 4) << 1) | ((k & 8) >> 1); return ((kk >> 3) * 4 + (c >> 5)) * 512 + ((kk & 7) * 32 + (c & 31)) * 2; }
__device__ __forceinline__ int v_rd_base(int lane) { return ((lane & 3) << 3) | (((lane >> 2) & 3) << 6) | (((lane >> 4) & 1) << 5) | (((lane >> 5) & 1) << 8); }
constexpr int v_rd_off(int d0, int ks, int half) { return d0 * 512 + ks * 4096 + half * 2048; }
template <int OFF> __device__ __forceinline__ s16x4 tr_read(int vb) {
  s16x4 r; asm volatile("ds_read_b64_tr_b16 %0, %1 offset:%2" : "=&v"(r) : "v"(vb), "i"(OFF) : "memory"); return r;
}
template <int D0> __device__ __forceinline__ void pv_one(f32x16& od, int vb, bf16x8 pa0, bf16x8 pa1, bf16x8 pa2, bf16x8 pa3) {
  const s16x4 l0 = tr_read<v_rd_off(D0, 0, 0)>(vb), h0 = tr_read<v_rd_off(D0, 0, 1)>(vb), l1 = tr_read<v_rd_off(D0, 1, 0)>(vb), h1 = tr_read<v_rd_off(D0, 1, 1)>(vb);
  const s16x4 l2 = tr_read<v_rd_off(D0, 2, 0)>(vb), h2 = tr_read<v_rd_off(D0, 2, 1)>(vb), l3 = tr_read<v_rd_off(D0, 3, 0)>(vb), h3 = tr_read<v_rd_off(D0, 3, 1)>(vb);
  asm volatile("s_waitcnt lgkmcnt(0)" ::: "memory"); SBAR();
#define PK(L, H) (bf16x8){L[0], L[1], L[2], L[3], H[0], H[1], H[2], H[3]}
  od = __builtin_amdgcn_mfma_f32_32x32x16_bf16(pa0, PK(l0, h0), od, 0, 0, 0);
  od = __builtin_amdgcn_mfma_f32_32x32x16_bf16(pa1, PK(l1, h1), od, 0, 0, 0);
  od = __builtin_amdgcn_mfma_f32_32x32x16_bf16(pa2, PK(l2, h2), od, 0, 0, 0);
  od = __builtin_amdgcn_mfma_f32_32x32x16_bf16(pa3, PK(l3, h3), od, 0, 0, 0);
#undef PK
}
__device__ __forceinline__ void pv_d0(f32x16* o, int vb, bf16x8 pa0, bf16x8 pa1, bf16x8 pa2, bf16x8 pa3) {
  pv_one<0>(o[0], vb, pa0, pa1, pa2, pa3); pv_one<1>(o[1], vb, pa0, pa1, pa2, pa3); pv_one<2>(o[2], vb, pa0, pa1, pa2, pa3); pv_one<3>(o[3], vb, pa0, pa1, pa2, pa3);
}
__device__ __forceinline__ bf16x8 ld8(const bf16* p) { return *reinterpret_cast<const bf16x8*>(p); }

template <int MODE>
__device__ __forceinline__ void attn_unit(const bf16* __restrict__ Qrow0, int ldq, const bf16* __restrict__ Kb, const bf16* __restrict__ Vb, int ldk, const bf16* __restrict__ KRb,
                                          int b, int nct, int NT, bf16* __restrict__ Ob, float lam, const float* __restrict__ subln, float oscale, LAS unsigned char* lds_) {
  constexpr int NQF = MODE == 0 ? 12 : 4, NQR = MODE == 0 ? 6 : 4, PITCH = MODE == 0 ? 384 : 256, SHM_V = 16384, SHM_K = 64 * PITCH, SDEPTH = MODE == 0 ? 1 : 2;
  const float SCALE = MODE == 0 ? 0.07216878364870323f : 0.125f;
  const float C = SCALE * 1.4426950408889634f, THRS = 8.f / SCALE;
  const int tid = launder_v(threadIdx.x), wid = tid >> 6, lane = tid & 63, r32 = lane & 31, hi = lane >> 5;
  LAS char* lds = (LAS char*)(LAS unsigned char*)lds_;
  LAS char* V_lds = lds; LAS char* K_lds = lds + 2 * SHM_V;
  LAS float* wsf = (LAS float*)(lds + 2 * SHM_V + 2 * SHM_K) + wid * 64; LAS float* li_l = wsf; LAS float* al_l = wsf + 32;
  const int wq = MODE == 0 ? wid : (wid & 3), sgrp = MODE == 0 ? 0 : (wid >> 2);
  float m_reg = -1e30f, l_reg = 0; f32x16 o[4] = {}; bf16x8 qr[NQR];
  LAS char* ql = lds + 2 * SHM_V + 2 * SHM_K + 2048 + wid * 6144 + lane * 16;
  const bf16* Qw = Qrow0 + (size_t)(wq * 32 + r32) * ldq + sgrp * 64 + hi * 8;
#pragma unroll
  for (int d0 = 0; d0 < NQR; ++d0) qr[d0] = ld8(Qw + d0 * 16);
#pragma unroll
  for (int d0 = NQR; d0 < NQF; ++d0) *(LAS bf16x8*)(ql + (d0 - NQR) * 1024) = ld8(Qw + d0 * 16);
  const int sr = tid >> 4, sc = (tid & 15) * 8, vst0 = v_st(sr, sc), vst1 = v_st(32 + sr, sc);
  const int kst0 = sr * PITCH + (((tid & 15) ^ kswz<PITCH>(sr)) * 16), kst1 = kst0 + 32 * PITCH;
  const int rrow = tid >> 3, krs = rrow * PITCH + (((16 + (tid & 7)) ^ kswz<PITCH>(rrow)) * 16);
  const int chunk0 = sgrp * 8;
  const int vb0 = (int)(uintptr_t)V_lds + v_rd_base(lane);
  struct Slot { bf16x8 vs0, vs1, ks0, ks1, kr; } sr_[SDEPTH];
#define KROW(jt) ((jt) < nct ? (ML + b * CTXL + (jt) * 64) : (b * SEQ + ((jt) - nct) * 64))
#define SLOAD(i, jt) do { const int k0_ = KROW(jt); sr_[i].vs0 = ld8(Vb + (size_t)(k0_ + sr) * ldk + sc); sr_[i].vs1 = ld8(Vb + (size_t)(k0_ + 32 + sr) * ldk + sc); \
    sr_[i].ks0 = ld8(Kb + (size_t)(k0_ + sr) * ldk + sc); sr_[i].ks1 = ld8(Kb + (size_t)(k0_ + 32 + sr) * ldk + sc); \
    if (MODE == 0) sr_[i].kr = ld8(KRb + (size_t)(k0_ + rrow) * 64 + (tid & 7) * 8); } while (0)
#define SWRITE(bf, i) do { *(LAS bf16x8*)(V_lds + (bf) * SHM_V + vst0) = sr_[i].vs0; *(LAS bf16x8*)(V_lds + (bf) * SHM_V + vst1) = sr_[i].vs1; \
    *(LAS bf16x8*)(K_lds + (bf) * SHM_K + kst0) = sr_[i].ks0; *(LAS bf16x8*)(K_lds + (bf) * SHM_K + kst1) = sr_[i].ks1; \
    if (MODE == 0) *(LAS bf16x8*)(K_lds + (bf) * SHM_K + krs) = sr_[i].kr; } while (0)
#define SWAIT() do { if constexpr (SDEPTH == 2) asm volatile("s_waitcnt vmcnt(4)" ::: "memory"); else asm volatile("s_waitcnt vmcnt(0)" ::: "memory"); } while (0)
#define RESC(a) do { if (__any((a) < 1.f)) { if (hi == 0) al_l[r32] = (a); asm volatile("s_waitcnt lgkmcnt(0)" ::: "memory"); \
    _Pragma("unroll") for (int d = 0; d < 4; ++d) _Pragma("unroll") for (int r = 0; r < 16; ++r) o[d][r] *= al_l[crow(r, hi)]; } } while (0)
  f32x16 pA0, pA1, pB0, pB1; float mnA, mnB, alA, alB; bf16x8 pa0, pa1, pa2, pa3;
  constexpr int SE = 0, SO = SDEPTH - 1;
  SLOAD(SE, 0); asm volatile("s_waitcnt vmcnt(0)" ::: "memory"); SWRITE(0, SE); __syncthreads();
  qkt<NQF, NQR, PITCH>(pA0, pA1, K_lds, chunk0, qr, ql, r32, hi); partialSM(pA0, pA1, m_reg, mnA, alA, C, THRS);
  SLOAD(SO, 1); if constexpr (SDEPTH == 2) { if (2 < NT) SLOAD(SE, 2); }
  SWAIT(); SWRITE(1, SO); __syncthreads();
  for (int j = 1; j + 1 < NT; j += 2) {
    SBAR(); qkt<NQF, NQR, PITCH>(pB0, pB1, K_lds + SHM_K, chunk0, qr, ql, r32, hi);
    finishSM(pA0, pA1, alA, l_reg, pa0, pa1, pa2, pa3); SBAR();
    SLOAD(SO, j + SDEPTH); SBAR();
    pv_d0(o, vb0, pa0, pa1, pa2, pa3); partialSM(pB0, pB1, m_reg, mnB, alB, C, THRS);
    __syncthreads(); SWAIT(); SWRITE(0, SE);
    RESC(alB); __syncthreads();
    SBAR(); qkt<NQF, NQR, PITCH>(pA0, pA1, K_lds, chunk0, qr, ql, r32, hi);
    finishSM(pB0, pB1, alB, l_reg, pa0, pa1, pa2, pa3); SBAR();
    if (SDEPTH == 1 || j + 3 < NT) SLOAD(SE, j + 1 + SDEPTH); SBAR();
    pv_d0(o, vb0 + SHM_V, pa0, pa1, pa2, pa3); partialSM(pA0, pA1, m_reg, mnA, alA, C, THRS);
    __syncthreads(); SWAIT(); SWRITE(1, SO);
    RESC(alA); __syncthreads();
  }
  SBAR(); qkt<NQF, NQR, PITCH>(pB0, pB1, K_lds + SHM_K, chunk0, qr, ql, r32, hi);
  finishSM(pA0, pA1, alA, l_reg, pa0, pa1, pa2, pa3); SBAR();
  pv_d0(o, vb0, pa0, pa1, pa2, pa3); partialSM(pB0, pB1, m_reg, mnB, alB, C, THRS);
  __syncthreads(); RESC(alB);
  finishSM(pB0, pB1, alB, l_reg, pa0, pa1, pa2, pa3); SBAR();
  pv_d0(o, vb0 + SHM_V, pa0, pa1, pa2, pa3);
  if (hi == 0) li_l[r32] = l_reg; asm volatile("s_waitcnt lgkmcnt(0)" ::: "memory");
  float rli[16];
#pragma unroll
  for (int r = 0; r < 16; ++r) rli[r] = __builtin_amdgcn_rcpf(li_l[crow(r, hi)]);
  bf16* Ow = Ob + (size_t)(wq * 32) * DM;
  if constexpr (MODE == 0) {
#pragma unroll
    for (int r = 0; r < 16; ++r) { const int orow = crow(r, hi);
#pragma unroll
      for (int d0 = 0; d0 < 4; ++d0) Ow[(size_t)orow * DM + d0 * 32 + r32] = tobf1(o[d0][r] * rli[r]); }
    __syncthreads();
  } else {
    LAS float* ex = (LAS float*)lds;
    __syncthreads();
    if (sgrp == 1) {
#pragma unroll
      for (int r = 0; r < 16; ++r)
#pragma unroll
        for (int d0 = 0; d0 < 4; ++d0) ex[(wq * 32 + crow(r, hi)) * 128 + d0 * 32 + r32] = o[d0][r] * rli[r];
    }
    __syncthreads();
    if (sgrp == 0) {
#pragma unroll
      for (int r = 0; r < 16; ++r) { const int orow = crow(r, hi); float dd[4]; float ss = 0.f;
#pragma unroll
        for (int d0 = 0; d0 < 4; ++d0) { dd[d0] = o[d0][r] * rli[r] - lam * ex[(wq * 32 + orow) * 128 + d0 * 32 + r32]; ss += dd[d0] * dd[d0]; }
#pragma unroll
        for (int off = 1; off < 32; off <<= 1) ss += __shfl_xor(ss, off);
        const float rs = oscale / sqrtf(ss * (1.0f / 128.0f) + LN_EPS);
#pragma unroll
        for (int d0 = 0; d0 < 4; ++d0) Ow[(size_t)orow * DM + d0 * 32 + r32] = tobf1(dd[d0] * rs * subln[d0 * 32 + r32]); }
    }
    __syncthreads();
  }
#undef KROW
#undef SLOAD
#undef SWRITE
#undef SWAIT
#undef RESC
}
}

__device__ __forceinline__ void mla_attn_phase(CP P, LAS unsigned char* lds) {
    const bf16* QM = (const bf16*)(P->ws + WS_QM); const bf16* KV = (const bf16*)(P->ws + WS_KV); const bf16* KR = (const bf16*)(P->ws + WS_KR); bf16* Gb = (bf16*)(P->ws + WS_G);
    const int c = blockIdx.x, G = gridDim.x;
    for (int u = c; u < 1024 + 32; u += G) {
        int b, h, qrow0, NT;
        if (u < 1024) { const int i = u >> 8, cc = u & 255; const int bh = (cc & 7) + 8 * i, qb = cc >> 3; b = bh >> 4; h = bh & 15; qrow0 = b * SEQ + qb * 256; NT = 4 + 128; }
        else { const int bh = u - 1024; b = bh >> 4; h = bh & 15; qrow0 = ML + b * CTXL; NT = 4; }
        att::attn_unit<0>(QM + (size_t)qrow0 * 3072 + h * 192, 3072, KV + h * 256, KV + h * 256 + 128, 4096, KR, b, 4, NT, Gb + (size_t)qrow0 * DM + h * 128, 0.f, nullptr, 1.f, lds);
    }
}
__device__ __forceinline__ void da_attn_phase(CP P, float lam, float oscale, LAS unsigned char* lds) {
    const bf16* Z = (const bf16*)(P->ws + WS_Z); bf16* Gb = (bf16*)(P->ws + WS_G); const float* subln = P->in[27];
    const int c = blockIdx.x, G = gridDim.x;
    for (int u = c; u < 2048 + 64; u += G) {
        int b, h, qrow0, NT;
        if (u < 2048) { const int i = u >> 8, cc = u & 255; const int bh = (cc & 7) + 8 * (i >> 1), qb = (cc >> 3) + 32 * (i & 1); b = bh >> 4; h = bh & 15; qrow0 = b * SEQ + qb * 128; NT = 4 + 128; }
        else { const int v = u - 2048; const int bh = v >> 1; b = bh >> 4; h = bh & 15; qrow0 = ML + b * CTXL + (v & 1) * 128; NT = 4; }
        att::attn_unit<1>(Z + (size_t)qrow0 * 6144 + h * 128, 6144, Z + 2048 + h * 128, Z + 4096 + h * 128, 6144, nullptr, b, 4, NT, Gb + (size_t)qrow0 * DM + h * 128, lam, subln, oscale, lds);
    }
}

__device__ __forceinline__ unsigned f2ord(float f) { const unsigned u = __float_as_uint(f); return u ^ ((unsigned)((int)u >> 31) | 0x80000000u); }
__device__ __forceinline__ float ord2f(unsigned k) { return __uint_as_float((k & 0x80000000u) ? (k ^ 0x80000000u) : ~k); }
__device__ __forceinline__ void ce_desc(unsigned& a, unsigned& b) { const unsigned mx = a > b ? a : b, mn = a > b ? b : a; a = mx; b = mn; }
template <int N, bool DESC> __device__ __forceinline__ void bitonic_merge(unsigned* a) {
#pragma unroll
    for (int j = N / 2; j > 0; j >>= 1)
#pragma unroll
        for (int i = 0; i < N; ++i) { const int l = i ^ j; if (l > i) { if (DESC) ce_desc(a[i], a[l]); else ce_desc(a[l], a[i]); } }
}
template <int N, bool DESC> __device__ __forceinline__ void bitonic_sort(unsigned* a) {
#pragma unroll
    for (int k = 2; k <= N; k <<= 1)
#pragma unroll
        for (int j = k >> 1; j > 0; j >>= 1)
#pragma unroll
            for (int i = 0; i < N; ++i) { const int l = i ^ j; if (l > i) { const bool up = ((i & k) == 0); if (up == DESC) ce_desc(a[i], a[l]); else ce_desc(a[l], a[i]); } }
}
__device__ __forceinline__ void top16_of_64(unsigned (&a)[64]) {
    bitonic_sort<16, true>(a); bitonic_sort<16, false>(a + 16); bitonic_sort<16, true>(a + 32); bitonic_sort<16, false>(a + 48);
#pragma unroll
    for (int i = 0; i < 16; ++i) a[i] = a[i] > a[16 + i] ? a[i] : a[16 + i];
    bitonic_merge<16, true>(a);
#pragma unroll
    for (int i = 0; i < 16; ++i) a[32 + i] = a[32 + i] > a[48 + i] ? a[32 + i] : a[48 + i];
    bitonic_merge<16, false>(a + 32);
#pragma unroll
    for (int i = 0; i < 16; ++i) a[i] = a[i] > a[32 + i] ? a[i] : a[32 + i];
    bitonic_merge<16, true>(a);
}
template <int PASS> __device__ __forceinline__ void route_pass(const bf16* QP, const LAS char* lds, int tok, int head, int r32, int hi, unsigned (&top)[16]) {
    f32x16 acc[4] = {};
    const bf16* qp = QP + (size_t)tok * DM + head * 256 + PASS * 128 + hi * 8;
    bf16x8 qf[8];
#pragma unroll
    for (int ks = 0; ks < 8; ++ks) qf[ks] = *(const bf16x8*)(qp + ks * 16);
    const LAS char* Kl = lds + PASS * 32768;
#pragma unroll
    for (int kb = 0; kb < 4; ++kb)
#pragma unroll
        for (int ks = 0; ks < 8; ++ks) { const bf16x8 a = *(const LAS bf16x8*)(Kl + (kb * 32 + r32) * 256 + (((ks * 2 + hi) ^ (r32 & 15)) * 16));
            acc[kb] = __builtin_amdgcn_mfma_f32_32x32x16_bf16(a, qf[ks], acc[kb], 0, 0, 0); }
    unsigned key[64]; const unsigned base = 127u - 4u * (unsigned)hi;
#pragma unroll
    for (int kb = 0; kb < 4; ++kb)
#pragma unroll
        for (int r = 0; r < 16; ++r) key[kb * 16 + r] = (f2ord(acc[kb][r]) & ~127u) | (base - (unsigned)(kb * 32 + (r & 3) + 8 * (r >> 2)));
    top16_of_64(key);
    unsigned pr[16];
#pragma unroll
    for (int i = 0; i < 16; ++i) pr[i] = (unsigned)__shfl_xor((int)key[15 - i], 32);
#pragma unroll
    for (int i = 0; i < 16; ++i) key[i] = key[i] > pr[i] ? key[i] : pr[i];
    bitonic_merge<16, true>(key);
#pragma unroll
    for (int i = 0; i < 16; ++i) top[i] = key[i];
}
__device__ __forceinline__ void route_phase(CP P, int L, int Mrows, LAS unsigned char* lds_, int tid, int lane, int wid, int gw, int NGW) {
    const bf16* QP = (const bf16*)(P->ws + WS_QP); unsigned* ROUTE = (unsigned*)(P->ws + WS_ROUTE);
    LAS char* lds = (LAS char*)(LAS unsigned char*)lds_;
    __syncthreads();
    {
        const bf16* K1 = (const bf16*)(P->ws + WS_PK1) + (size_t)L * 128 * 128; const bf16* K2 = (const bf16*)(P->ws + WS_PK2) + (size_t)L * 128 * 128;
        for (int c16 = tid; c16 < 2 * 128 * 16; c16 += NWAVES * 64) { const int mat = c16 >> 11, row = (c16 >> 4) & 127, ch = c16 & 15;
            const u32x4 w = *(const u32x4*)((mat ? K2 : K1) + row * 128 + ch * 8);
            *(LAS u32x4*)(lds + mat * 32768 + row * 256 + ((ch ^ (row & 15)) * 16)) = w; }
    }
    __syncthreads();
    LAS unsigned* sc = (LAS unsigned*)(lds + 65536) + wid * 2048;
    const int r32 = lane & 31, hi = lane >> 5;
    for (int item = gw; item < Mrows / 4; item += NGW) {
        const int tok = item * 4 + (r32 >> 3), head = r32 & 7;
        unsigned top0[16], top1[16];
        route_pass<0>(QP, lds, tok, head, r32, hi, top0);
        route_pass<1>(QP, lds, tok, head, r32, hi, top1);
        float v1[16], v2[16];
#pragma unroll
        for (int i = 0; i < 16; ++i) { v1[i] = ord2f(top0[i] & ~127u); v2[i] = ord2f(top1[i] & ~127u);
            sc[i * 64 + lane] = 127u - (top0[i] & 127u); sc[(16 + i) * 64 + lane] = 127u - (top1[i] & 127u); }
        unsigned ck[64]; int n = 0;
#pragma unroll
        for (int i = 0; i < 16; ++i)
#pragma unroll
            for (int j = 0; j < 16; ++j) if ((i + 1) * (j + 1) <= 16) { ck[n] = (f2ord(v1[i] + v2[j]) & ~255u) | (unsigned)(i * 16 + j); ++n; }
#pragma unroll
        for (int i = 50; i < 64; ++i) ck[i] = 0u;
        top16_of_64(ck);
        float ev[16]; float sum = 0.f; const float mx = ord2f(ck[0] & ~255u);
#pragma unroll
        for (int k = 0; k < 16; ++k) { ev[k] = __expf(ord2f(ck[k] & ~255u) - mx); sum += ev[k]; }
        const float inv = 1.0f / sum;
        unsigned ee[16];
#pragma unroll
        for (int k = 0; k < 16; ++k) { const unsigned pc = ck[k] & 255u; const unsigned i1 = sc[(pc >> 4) * 64 + lane], i2 = sc[(16 + (pc & 15u)) * 64 + lane]; ee[k] = i1 * 128u + i2; ev[k] *= inv; }
        u32x4* outp = (u32x4*)(ROUTE + ((size_t)tok * 128 + head * 16 + hi * 8) * 2);
#pragma unroll
        for (int k = 0; k < 8; k += 2) { u32x4 w;
            const unsigned eL0 = ee[k], eH0 = ee[k + 8], eL1 = ee[k + 1], eH1 = ee[k + 9]; const float gL0 = ev[k], gH0 = ev[k + 8], gL1 = ev[k + 1], gH1 = ev[k + 9];
            w.x = hi ? eH0 : eL0; w.y = __float_as_uint(hi ? gH0 : gL0); w.z = hi ? eH1 : eL1; w.w = __float_as_uint(hi ? gH1 : gL1);
            outp[k >> 1] = w; }
    }
}

__device__ __forceinline__ void gather_phase(CP P, int L, int Mrows, int lane, int gw, int NGW) {
    const bf16* U = (const bf16*)(P->ws + WS_PU) + (size_t)L * 16384 * 2048; const bf16* V = (const bf16*)(P->ws + WS_PV) + (size_t)L * 16384 * 2048;
    const unsigned* ROUTE = (const unsigned*)(P->ws + WS_ROUTE); const float* MOD = (const float*)(P->ws + WS_MOD);
    bf16* X = (bf16*)(P->ws + WS_X); bf16* H = (bf16*)(P->ws + WS_H);
    const float* lng = P->in[6] + (size_t)(L * 2 + 1) * DM; const float* lnb = P->in[7] + (size_t)(L * 2 + 1) * DM;
    for (int row = gw; row < Mrows; row += NGW) {
        const u32x2 ea = ((const u32x2*)(ROUTE + (size_t)row * 256))[lane], eb = ((const u32x2*)(ROUTE + (size_t)row * 256))[64 + lane];
        float hf[32]; load_row_bf16(H + (size_t)row * DM, lane, hf);
        float y[32];
#pragma unroll
        for (int i = 0; i < 32; ++i) y[i] = 0.f;
#pragma unroll 1
        for (int half = 0; half < 2; ++half) {
            const unsigned evv = half ? eb.x : ea.x, gvv = half ? eb.y : ea.y;
#pragma unroll 1
            for (int k = 0; k < 64; k += 2) {
                const unsigned e0 = (unsigned)__builtin_amdgcn_readlane((int)evv, k), e1 = (unsigned)__builtin_amdgcn_readlane((int)evv, k + 1);
                const float g0 = __uint_as_float((unsigned)__builtin_amdgcn_readlane((int)gvv, k)), g1 = __uint_as_float((unsigned)__builtin_amdgcn_readlane((int)gvv, k + 1));
                const u32x4* u0 = (const u32x4*)(U + (size_t)e0 * DM) + lane; const u32x4* u1 = (const u32x4*)(U + (size_t)e1 * DM) + lane;
                const u32x4* v0 = (const u32x4*)(V + (size_t)e0 * DM) + lane; const u32x4* v1 = (const u32x4*)(V + (size_t)e1 * DM) + lane;
                u32x4 a0[4], a1[4], b0[4], b1[4];
#pragma unroll
                for (int j = 0; j < 4; ++j) { a0[j] = u0[64 * j]; a1[j] = u1[64 * j]; }
#pragma unroll
                for (int j = 0; j < 4; ++j) { b0[j] = v0[64 * j]; b1[j] = v1[64 * j]; }
                float d0 = 0.f, d1 = 0.f;
#pragma unroll
                for (int j = 0; j < 4; ++j) {
                    d0 += hf[8 * j + 0] * bflo(a0[j].x) + hf[8 * j + 1] * bfhi(a0[j].x) + hf[8 * j + 2] * bflo(a0[j].y) + hf[8 * j + 3] * bfhi(a0[j].y)
                        + hf[8 * j + 4] * bflo(a0[j].z) + hf[8 * j + 5] * bfhi(a0[j].z) + hf[8 * j + 6] * bflo(a0[j].w) + hf[8 * j + 7] * bfhi(a0[j].w);
                    d1 += hf[8 * j + 0] * bflo(a1[j].x) + hf[8 * j + 1] * bfhi(a1[j].x) + hf[8 * j + 2] * bflo(a1[j].y) + hf[8 * j + 3] * bfhi(a1[j].y)
                        + hf[8 * j + 4] * bflo(a1[j].z) + hf[8 * j + 5] * bfhi(a1[j].z) + hf[8 * j + 6] * bflo(a1[j].w) + hf[8 * j + 7] * bfhi(a1[j].w); }
                d0 = wave_sum(d0); d1 = wave_sum(d1);
                const float w0 = g0 * gelu_tanh(d0), w1 = g1 * gelu_tanh(d1);
#pragma unroll
                for (int j = 0; j < 4; ++j) {
                    y[8 * j + 0] += w0 * bflo(b0[j].x) + w1 * bflo(b1[j].x); y[8 * j + 1] += w0 * bfhi(b0[j].x) + w1 * bfhi(b1[j].x);
                    y[8 * j + 2] += w0 * bflo(b0[j].y) + w1 * bflo(b1[j].y); y[8 * j + 3] += w0 * bfhi(b0[j].y) + w1 * bfhi(b1[j].y);
                    y[8 * j + 4] += w0 * bflo(b0[j].z) + w1 * bflo(b1[j].z); y[8 * j + 5] += w0 * bfhi(b0[j].z) + w1 * bfhi(b1[j].z);
                    y[8 * j + 6] += w0 * bflo(b0[j].w) + w1 * bflo(b1[j].w); y[8 * j + 7] += w0 * bfhi(b0[j].w) + w1 * bfhi(b1[j].w); }
            }
        }
        const int slot = row_slot(row);
        const float* mod = MOD + (size_t)(L * 3 + slot) * 12288;
        { float xx[32], g[32]; load_row_bf16(X + (size_t)row * DM, lane, xx); load_row_f32(mod + 5 * 2048, lane, g);
#pragma unroll
          for (int i = 0; i < 32; ++i) y[i] = ALPHA * xx[i] + g[i] * y[i]; }
        if (L < NLAYER - 1) { const float* modn = MOD + (size_t)((L + 1) * 3 + slot) * 12288;
            finish_row(y, lng, lnb, X + (size_t)row * DM, modn, modn + 2048, H + (size_t)row * DM, nullptr, lane); }
        else finish_row(y, lng, lnb, nullptr, nullptr, nullptr, nullptr, P->out + (size_t)row * DM, lane);
    }
}

#define NOINL __forceinline__
__device__ __forceinline__ CP launder_cp(CP p) { asm volatile("" : "+s"(p)); return p; }
#define GETP() launder_cp((CP)__builtin_amdgcn_kernarg_segment_ptr())
__device__ __forceinline__ int uni(int v) { return __builtin_amdgcn_readfirstlane(v); }
__device__ __forceinline__ LAS unsigned char* uni_lds(LAS unsigned char* p) { return (LAS unsigned char*)(unsigned)__builtin_amdgcn_readfirstlane((int)(unsigned)(uintptr_t)p); }
#define PH_IDS const int tid = launder_v(threadIdx.x), lane = tid & 63, wid = __builtin_amdgcn_readfirstlane(tid >> 6); const int gw = blockIdx.x * NWAVES + wid, NGW = gridDim.x * NWAVES; (void)lane; (void)gw; (void)NGW;

__device__ NOINL void ph_prologue(LAS unsigned char* lds_) { CP P = GETP(); LAS unsigned char* lds = uni_lds(lds_); PH_IDS p0_prologue(P, lds, tid, lane, wid, gw, NGW); }
__device__ NOINL void ph_first() { CP P = GETP(); PH_IDS first_row_pass(P, lane, gw, NGW); }
__device__ NOINL void ph_postmix(int L_, int M_) { CP P = GETP(); const int L = uni(L_), Mrows = uni(M_); PH_IDS post_mixer_pass(P, L, Mrows, lane, gw, NGW); }
__device__ NOINL void ph_vstats(int M_) { CP P = GETP(); const int Mrows = uni(M_); PH_IDS vstats_pass(P, Mrows, lane, gw, NGW); }
__device__ NOINL void ph_spatial(LAS unsigned char* lds_, int j_, int M_) { CP P = GETP(); LAS unsigned char* lds = uni_lds(lds_); const int j = uni(j_), Mrows = uni(M_); PH_IDS spatial_phase(P, j, Mrows, lds, tid, lane, wid); }
__device__ NOINL void ph_mla_norm() { CP P = GETP(); PH_IDS mla_norm_pass(P, lane, gw, NGW); }
__device__ NOINL void ph_rope(int which_) { CP P = GETP(); const int which = uni(which_); PH_IDS
    if (which == 0) rope_pass((bf16*)(P->ws + WS_QM), 3072, 128, 16, 192, lane, gw, NGW);
    else rope_pass((bf16*)(P->ws + WS_Z), 6144, 0, 64, 64, lane, gw, NGW); }
__device__ NOINL void ph_attn_mla(LAS unsigned char* lds_) { CP P = GETP(); LAS unsigned char* lds = uni_lds(lds_); mla_attn_phase(P, lds); }
__device__ NOINL void ph_attn_da(LAS unsigned char* lds_, int L_) { CP P = GETP(); LAS unsigned char* lds = uni_lds(lds_); const int L = uni(L_); const int lane = launder_v(threadIdx.x) & 63;
    const float* lp = P->in[26];
    const float s01 = wave_sum(lp[lane] * lp[64 + lane]), s23 = wave_sum(lp[128 + lane] * lp[192 + lane]);
    const float lam_init = 0.8f - 0.6f * expf(-0.3f * (float)L);
    const float lam = expf(s01) - expf(s23) + lam_init;
    da_attn_phase(P, lam, 1.0f - lam_init, lds); }
__device__ NOINL void ph_route(LAS unsigned char* lds_, int L_, int M_) { CP P = GETP(); LAS unsigned char* lds = uni_lds(lds_); const int L = uni(L_), Mrows = uni(M_); PH_IDS route_phase(P, L, Mrows, lds, tid, lane, wid, gw, NGW); }
__device__ NOINL void ph_gather(int L_, int M_) { CP P = GETP(); const int L = uni(L_), Mrows = uni(M_); PH_IDS gather_phase(P, L, Mrows, lane, gw, NGW); }

enum GemmId { G_GM_IN = 0, G_GM_OUT, G_MLA_IN, G_MLA_UQ, G_MLA_UKV, G_MLA_OUT, G_DA_IN, G_DA_OUT, G_PEER_Q };
__device__ NOINL void ph_gemm(LAS unsigned char* lds_, int id_, int L_, int M_) {
    CP P = GETP(); LAS unsigned char* lds = uni_lds(lds_); const int id = uni(id_), L = uni(L_), Mrows = uni(M_);
    unsigned char* ws = P->ws; const int jj = L / 3;
    size_t a = WS_H, b = 0, o = 0; int M = MT, N = 2048, K = 2048, act = 0;
    switch (id) {
        case G_GM_IN:   a = WS_H;    b = WS_GMWIN + (size_t)jj * 4096 * 2048 * 2;  o = WS_Z;  M = Mrows; N = 4096; K = 2048; act = 1; break;
        case G_GM_OUT:  a = WS_G;    b = WS_GMWOUT + (size_t)jj * 2048 * 2048 * 2; o = WS_Y;  M = Mrows; N = 2048; K = 2048; break;
        case G_MLA_IN:  a = WS_H;    b = WS_MLAIN;  o = WS_C;  N = 1280; K = 2048; break;
        case G_MLA_UQ:  a = WS_CQN;  b = WS_MLAUQ;  o = WS_QM; N = 3072; K = 512;  break;
        case G_MLA_UKV: a = WS_CKVN; b = WS_MLAUKV; o = WS_KV; N = 4096; K = 512;  break;
        case G_MLA_OUT: a = WS_G;    b = WS_MLAOUT; o = WS_Y;  N = 2048; K = 2048; break;
        case G_DA_IN:   a = WS_H;    b = WS_DAIN;   o = WS_Z;  N = 6144; K = 2048; break;
        case G_DA_OUT:  a = WS_G;    b = WS_DAOUT;  o = WS_Y;  N = 2048; K = 2048; break;
        default:        a = WS_H;    b = WS_PWQ + (size_t)L * 2048 * 2048 * 2;     o = WS_QP; M = Mrows; N = 2048; K = 2048; break;
    }
    pg8::Gemm g{(const pg8::bf16_t*)(ws + a), (const pg8::bf16_t*)(ws + b), M, N, K}; pg8::StaticOrder S; S.init(M, N, (int)gridDim.x, (int)blockIdx.x);
    pg8::EpiR E{(pg8::bf16_t*)(ws + o), N, act};
    pg8::gemm_phase<pg8::EpiR, pg8::StaticOrder, true, true>((PG8_LAS unsigned char*)lds, g, S, E);
}

__global__ void __launch_bounds__(NWAVES * 64, 2) mk_fwd(Params Pv) {
    extern __shared__ __attribute__((aligned(16))) unsigned char lds_g[];
    LAS unsigned char* lds = (LAS unsigned char*)lds_g;
    const int tid = threadIdx.x;
    for (int u = tid; u < (LDS_BYTES - RING_BYTES) / 4; u += NWAVES * 64) ((LAS unsigned*)(lds + RING_BYTES))[u] = 0u;
    __syncthreads();
    const int lo = Pv.ph_lo, hi = Pv.ph_hi;
    unsigned* barw = (unsigned*)(Pv.ws + WS_CTL) + CW_BAR;
    XcdBarrier bar; bar.bar = barw; bar.x = 0; bar.st = nullptr;
    if (hi - lo > 1) bar = xcd_barrier_post(barw, (volatile LAS unsigned*)(lds + MISC_OFF) + 8);
    int ph = 0;
#ifndef SEL
#define SELP(k) true
#else
#define SELP(k) ((k) == SEL)
#endif
    enum { RUN_BASE = __COUNTER__ + 1 };
#define RUN(call) do { if (SELP(__COUNTER__ - RUN_BASE) && ph >= lo && ph < hi) { call; } if (ph >= lo && ph + 1 < hi) xcd_barrier(bar); ++ph; } while (0)
    RUN(ph_prologue(lds));
    RUN(ph_first());
    for (int L = 0; L < NLAYER; ++L) {
        const int kind = L % 3, jj = L / 3;
        const int Mrows = (L == NLAYER - 1) ? ML : MT;
        if (kind == 0) {
            RUN(ph_gemm(lds, G_GM_IN, L, Mrows));
            RUN(ph_vstats(Mrows));
            RUN(ph_spatial(lds, jj, Mrows));
            RUN(ph_gemm(lds, G_GM_OUT, L, Mrows));
        } else if (kind == 1) {
            RUN(ph_gemm(lds, G_MLA_IN, L, Mrows));
            RUN(ph_mla_norm());
            RUN(ph_gemm(lds, G_MLA_UQ, L, Mrows); ph_gemm(lds, G_MLA_UKV, L, Mrows));
            RUN(ph_rope(0));
            RUN(ph_attn_mla(lds));
            RUN(ph_gemm(lds, G_MLA_OUT, L, Mrows));
        } else {
            RUN(ph_gemm(lds, G_DA_IN, L, Mrows));
            RUN(ph_rope(1));
            RUN(ph_attn_da(lds, L));
            RUN(ph_gemm(lds, G_DA_OUT, L, Mrows));
        }
        RUN(ph_postmix(L, Mrows));
        RUN(ph_gemm(lds, G_PEER_Q, L, Mrows));
        RUN(ph_route(lds, L, Mrows));
        RUN(ph_gather(L, Mrows));
    }
#undef RUN
}

extern "C" void kernel_launch(void* const* d_in, const int* in_sizes, int n_in, void* d_out, int out_size, void* d_ws, size_t ws_size, hipStream_t stream) {
    static int grid = 0;
    if (grid == 0) {
        if (n_in != 29 || in_sizes[0] != ML * DM || out_size != ML * DM || ws_size < WS_END) {
            fprintf(stderr, "kernel_launch: shape mismatch: n_in %d in0 %d out %d ws %zu (need %zu); nothing launched\n", n_in, n_in > 0 ? in_sizes[0] : -1, out_size, ws_size, (size_t)WS_END); grid = -1; return; }
        int dev = 0, cus = 0, per_cu = 0;
        if (hipGetDevice(&dev) != hipSuccess || hipDeviceGetAttribute(&cus, hipDeviceAttributeMultiprocessorCount, dev) != hipSuccess) { fprintf(stderr, "kernel_launch: device query failed\n"); grid = -1; return; }
        if (hipFuncSetAttribute((const void*)mk_fwd, hipFuncAttributeMaxDynamicSharedMemorySize, LDS_BYTES) != hipSuccess) { fprintf(stderr, "kernel_launch: hipFuncSetAttribute failed\n"); grid = -1; return; }
        if (hipOccupancyMaxActiveBlocksPerMultiprocessor(&per_cu, (const void*)mk_fwd, NWAVES * 64, LDS_BYTES) != hipSuccess || per_cu < 1)
            fprintf(stderr, "kernel_launch: note: occupancy query reports %d workgroups per CU\n", per_cu);
        (void)hipGetLastError();
        grid = cus;
    }
    if (grid < 0) return;
    if (hipMemsetAsync((char*)d_ws + WS_CTL, 0, CTL_ZERO_BYTES, stream) != hipSuccess) { fprintf(stderr, "kernel_launch: memset failed\n"); return; }
    Params p{};
    for (int i = 0; i < 29; ++i) p.in[i] = (const float*)d_in[i];
    p.out = (float*)d_out; p.ws = (unsigned char*)d_ws;
#if MK_ONE_LAUNCH
    p.ph_lo = 0; p.ph_hi = NPH;
    hipLaunchKernelGGL(mk_fwd, dim3(grid), dim3(NWAVES * 64), LDS_BYTES, stream, p);
#else
    for (int li = 0; li < NPH; ++li) { p.ph_lo = li; p.ph_hi = li + 1; hipLaunchKernelGGL(mk_fwd, dim3(grid), dim3(NWAVES * 64), LDS_BYTES, stream, p); }
#endif
    const hipError_t le = hipPeekAtLastError();
    if (le != hipSuccess) fprintf(stderr, "kernel_launch: launch failed: %s\n", hipGetErrorName(le));
}
```

```cpp
#include <hip/hip_runtime.h>
#include <cstdio>
#include <cstdint>
#ifndef MK_ONE_LAUNCH
#define MK_ONE_LAUNCH 1
#endif
__device__ __forceinline__ int launder_v(int v) { asm volatile("" : "+v"(v)); return v; }
namespace pg8 {
#define PG8_LAS __attribute__((address_space(3)))
typedef unsigned short bf16_t;
typedef short bf16x8 __attribute__((ext_vector_type(8)));
typedef float f32x4 __attribute__((ext_vector_type(4)));
typedef unsigned u32x4 __attribute__((ext_vector_type(4)));
constexpr int BM = 256, BK = 64, HALF = 128, HTB = HALF * BK * 2  , STAGE_BYTES = 8 * HTB, NXCD = 8, WGM = 8;

__host__ __device__ __forceinline__ int lds_byte(int r, int c) { const int st = (r >> 4) * 2 + (c >> 5), rr = r & 15, cc = c & 31, ob = rr * 64 + cc * 2; return st * 1024 + (ob ^ (((ob >> 9) & 1) << 5)); }
__host__ __device__ __forceinline__ void stage_rc(int b, int& R, int& C) { const int st = b / 1024, sb = b % 1024, swz = sb ^ (((sb >> 9) & 1) << 5); R = (st >> 1) * 16 + swz / 64; C = (st & 1) * 32 + (swz % 64) / 2; }
__host__ __device__ __forceinline__ int perm32(int rho) { const int n = rho >> 4, i = rho & 15; return 8 * (i >> 2) + 4 * n + (i & 3); }

struct Unit { int pm, pn; };
struct Gemm { const bf16_t* A; const bf16_t* Bt; int M, N, K; };

struct StaticOrder {
    int nM, nN, nwg, G, c;
    __host__ __device__ void init(int M, int N, int G_, int c_) { nM = M / BM; nN = N / BM; nwg = nM * nN; G = G_; c = c_; }
    __host__ __device__ bool next(int i, Unit& u) const {
        const long L = (long)i * G + c; if (L >= nwg) return false;
        int wgid = (int)L; { const int q = nwg / NXCD, r = nwg % NXCD, xcd = wgid % NXCD, off = wgid / NXCD; wgid = (xcd < r ? xcd * (q + 1) : r * (q + 1) + (xcd - r) * q) + off; }
        const int nig = WGM * nN, gid = wgid / nig, fm = gid * WGM, gsz = (nM - fm) < WGM ? (nM - fm) : WGM;
        u.pm = fm + ((wgid % nig) % gsz); u.pn = (wgid % nig) / gsz; return true;
    }
    __device__ __forceinline__ void a_ready(const Unit&) const {}
    __device__ __forceinline__ void done(const Unit&) const {}
};

__device__ __forceinline__ unsigned cvt_pk_bf16(float lo, float hi) { unsigned r; asm volatile("v_cvt_pk_bf16_f32 %0, %1, %2" : "=v"(r) : "v"(lo), "v"(hi)); return r; }
typedef float f32x2 __attribute__((ext_vector_type(2)));
__device__ __forceinline__ f32x2 gelu_pk(f32x2 v) {
    const f32x2 av = __builtin_elementwise_abs(v), d = av * 0.2316418882f + 1.0f;
    f32x2 t; t.x = __builtin_amdgcn_rcpf(d.x); t.y = __builtin_amdgcn_rcpf(d.y);
    f32x2 q = t * 0.5307027145f + (-0.7265760135f); q = q * t + 0.7107068705f; q = q * t + (-0.142248368f); q = q * t + 0.127414796f; q = q * t;
    const f32x2 s = (v * v) * (-0.72134752044f);
    f32x2 e; e.x = __builtin_amdgcn_exp2f(s.x); e.y = __builtin_amdgcn_exp2f(s.y);
    const f32x2 m = v * (q * e), r = v - m;
    f32x2 o; o.x = v.x < 0.f ? m.x : r.x; o.y = v.y < 0.f ? m.y : r.y; return o;
}

template <int ACT  > struct EpiBf16 {
    static constexpr bool PERM = true, AFTER_DRAIN = false; static_assert(ACT == 0 || ACT == 1, "EpiBf16: ACT is 0 (none) or 1 (gelu_pk)");
    bf16_t* O; int ldc; const float* bias; int split_cols; size_t split_stride; float scale0;
    __device__ __forceinline__ void operator()(const f32x4 (&acc)[2][2][4][2], const Unit& u, int wr, int wc, int fr, int fq) const {
        const int row0 = u.pm * BM + wr * 64 + fr; int colt = u.pn * BM; bf16_t* base = O;
        float sc = 1.f; if (split_cols) { const int t = colt / split_cols; base += (size_t)t * split_stride; colt -= t * split_cols; if (t == 0) sc = scale0; }
        const int col0 = colt + wc * 32 + 8 * fq, bcol0 = u.pn * BM + wc * 32 + 8 * fq;
        f32x4 bv[2][2];
#pragma unroll
        for (int bj = 0; bj < 2; ++bj)
#pragma unroll
            for (int n = 0; n < 2; ++n) bv[bj][n] = bias ? *(const f32x4*)(bias + bcol0 + bj * HALF + 4 * n) : (f32x4){0.f, 0.f, 0.f, 0.f};
#pragma unroll
        for (int ai = 0; ai < 2; ++ai)
#pragma unroll
            for (int m = 0; m < 4; ++m) { bf16_t* rowp = base + (size_t)(row0 + ai * HALF + m * 16) * ldc + col0;
#pragma unroll
                for (int bj = 0; bj < 2; ++bj) { f32x4 v0 = acc[ai][bj][m][0] + bv[bj][0], v1 = acc[ai][bj][m][1] + bv[bj][1];
                    if (ACT == 1) { f32x2 a = gelu_pk((f32x2){v0[0], v0[1]}), b = gelu_pk((f32x2){v0[2], v0[3]}), c = gelu_pk((f32x2){v1[0], v1[1]}), d = gelu_pk((f32x2){v1[2], v1[3]});
                        v0 = (f32x4){a.x, a.y, b.x, b.y}; v1 = (f32x4){c.x, c.y, d.x, d.y}; }
                    v0 = v0 * sc; v1 = v1 * sc; u32x4 w; w.x = cvt_pk_bf16(v0[0], v0[1]); w.y = cvt_pk_bf16(v0[2], v0[3]); w.z = cvt_pk_bf16(v1[0], v1[1]); w.w = cvt_pk_bf16(v1[2], v1[3]);
                    *(u32x4*)(rowp + bj * HALF) = w; } }
    }
};
template <class Epi, class Sched, bool ALIGN_EPI = false, bool SP2 = false>
__device__ __forceinline__ void gemm_phase(PG8_LAS unsigned char* lds, const Gemm g, const Sched& S, const Epi& E) {
    const int tid = launder_v(threadIdx.x), wid = __builtin_amdgcn_readfirstlane(tid >> 6), lane = tid & 63, wr = wid >> 2, wc = wid & 3, fr = lane & 15, fq = lane >> 4;
    const int K = g.K, nt = K / BK;
    unsigned voffA[2], voffB[2];
#pragma unroll
    for (int i = 0; i < 2; ++i) { int R, C; stage_rc(tid * 16 + i * 8192, R, C); const int Rb = Epi::PERM ? ((R & ~31) + perm32(R & 31)) : R;
        voffA[i] = (unsigned)(R * K + C) * 2u; voffB[i] = (unsigned)(Rb * K + C) * 2u; }
    const size_t kstep = (size_t)(BK * 2);
    const size_t hstep = (size_t)HALF * K * 2;
    const size_t tstep = 2 * hstep;
    const unsigned ldsw = (unsigned)wid * 1024u;
    const int aoff = lds_byte(wr * 64 + fr, fq * 8), boff = lds_byte(wc * 32 + fr, fq * 8);
#define PG8_SA(b, h) (((b) * 2 + (h)) * HTB)
#define PG8_SB(b, h) ((4 + (b) * 2 + (h)) * HTB)
#define PG8_STAGE(bufoff, gbase, voff) do { _Pragma("unroll") for (int _i = 0; _i < 2; ++_i) \
        __builtin_amdgcn_global_load_lds((const unsigned*)((const char*)(gbase) + (voff)[_i]), (PG8_LAS unsigned*)(lds + (bufoff) + ldsw + _i * 8192), 16, 0, 0); } while (0)
#define PG8_LDA(dst, b, h) do { _Pragma("unroll") for (int m = 0; m < 4; ++m) _Pragma("unroll") for (int k = 0; k < 2; ++k) dst[m][k] = *(const PG8_LAS bf16x8*)(lds + PG8_SA(b, h) + aoff + m * 2048 + k * 1024); } while (0)
#define PG8_LDB(dst, b, h) do { _Pragma("unroll") for (int n = 0; n < 2; ++n) _Pragma("unroll") for (int k = 0; k < 2; ++k) dst[n][k] = *(const PG8_LAS bf16x8*)(lds + PG8_SB(b, h) + boff + n * 2048 + k * 1024); } while (0)
#define PG8_MMA(ai, bj, At, Bt) do { __builtin_amdgcn_s_setprio(1); _Pragma("unroll") for (int m = 0; m < 4; ++m) _Pragma("unroll") for (int n = 0; n < 2; ++n) _Pragma("unroll") for (int k = 0; k < 2; ++k) \
        acc[ai][bj][m][n] = __builtin_amdgcn_mfma_f32_16x16x32_bf16(Bt[n][k], At[m][k], acc[ai][bj][m][n], 0, 0, 0); __builtin_amdgcn_s_setprio(0); } while (0)
#define PG8_WAIT_V(n) asm volatile("s_waitcnt vmcnt(" #n ")" ::: "memory")
#define PG8_WAIT_L(n) asm volatile("s_waitcnt lgkmcnt(" #n ")" ::: "memory")
#define PG8_BAR __builtin_amdgcn_s_barrier()
#define PG8_SCHED __builtin_amdgcn_sched_barrier(0)
    Unit cur, nxt; int ui = 0;
    if (!S.next(0, cur)) return;
    f32x4 acc[2][2][4][2];
#pragma unroll
    for (int a = 0; a < 2; ++a)
#pragma unroll
        for (int b = 0; b < 2; ++b)
#pragma unroll
            for (int m = 0; m < 4; ++m)
#pragma unroll
                for (int n = 0; n < 2; ++n) acc[a][b][m][n] = (f32x4){0.f, 0.f, 0.f, 0.f};
    bf16x8 At[4][2], B0[2][2], B1[2][2];
    const char* cA = (const char*)g.A + (size_t)cur.pm * tstep; const char* cB = (const char*)g.Bt + (size_t)cur.pn * tstep;
    S.a_ready(cur);
    if constexpr (SP2) {
        PG8_STAGE(PG8_SB(0, 0), cB, voffB); PG8_STAGE(PG8_SB(0, 1), cB + hstep, voffB); PG8_STAGE(PG8_SA(0, 0), cA, voffA); PG8_STAGE(PG8_SA(0, 1), cA + hstep, voffA);
        if (wr == 1) PG8_BAR;
        PG8_WAIT_V(2); PG8_BAR;
        PG8_STAGE(PG8_SB(1, 0), cB + kstep, voffB); PG8_STAGE(PG8_SA(1, 0), cA + kstep, voffA); PG8_STAGE(PG8_SB(1, 1), cB + hstep + kstep, voffB);
        PG8_WAIT_V(6); PG8_BAR;
    } else {
        PG8_STAGE(PG8_SB(0, 0), cB, voffB); PG8_STAGE(PG8_SA(0, 0), cA, voffA); PG8_STAGE(PG8_SB(0, 1), cB + hstep, voffB); PG8_STAGE(PG8_SA(0, 1), cA + hstep, voffA);
        if (wr == 1) PG8_BAR;
        PG8_WAIT_V(4); PG8_BAR;
        PG8_STAGE(PG8_SB(1, 0), cB + kstep, voffB); PG8_STAGE(PG8_SA(1, 0), cA + kstep, voffA); PG8_STAGE(PG8_SB(1, 1), cB + hstep + kstep, voffB);
        PG8_WAIT_V(6); PG8_BAR;
    }
    for (;;) {
        const bool has_next = S.next(ui + 1, nxt);
        const char* nA = has_next ? (const char*)g.A + (size_t)nxt.pm * tstep : cA; const char* nB = has_next ? (const char*)g.Bt + (size_t)nxt.pn * tstep : cB;
        for (int t = 0; t < nt; t += 2) {
            const bool last = (t == nt - 2);
            const char* a1 = cA + (size_t)(t + 1) * kstep;
            const char* a2 = last ? nA : cA + (size_t)(t + 2) * kstep; const char* b2 = last ? nB : cB + (size_t)(t + 2) * kstep;
            const char* a3 = a2 + kstep; const char* b3 = b2 + kstep;
            if (last && has_next) S.a_ready(nxt);
            if constexpr (SP2) {
            PG8_LDB(B0, 0, 0); PG8_LDB(B1, 0, 1); PG8_SCHED; PG8_LDA(At, 0, 0); PG8_STAGE(PG8_SA(1, 1), a1 + hstep, voffA);
            PG8_WAIT_V(8); PG8_WAIT_L(0); PG8_BAR; PG8_MMA(0, 0, At, B0); PG8_MMA(0, 1, At, B1); PG8_BAR; PG8_SCHED;
            PG8_LDA(At, 0, 1); PG8_STAGE(PG8_SB(0, 0), b2, voffB); PG8_STAGE(PG8_SB(0, 1), b2 + hstep, voffB); PG8_STAGE(PG8_SA(0, 0), a2, voffA);
            PG8_WAIT_V(8); PG8_WAIT_L(0); PG8_BAR; PG8_MMA(1, 0, At, B0); PG8_MMA(1, 1, At, B1); PG8_BAR; PG8_SCHED;
            PG8_LDB(B0, 1, 0); PG8_LDB(B1, 1, 1); PG8_SCHED; PG8_LDA(At, 1, 0); PG8_STAGE(PG8_SA(0, 1), a2 + hstep, voffA);
            PG8_WAIT_V(8); PG8_WAIT_L(0); PG8_BAR; PG8_MMA(0, 0, At, B0); PG8_MMA(0, 1, At, B1); PG8_BAR; PG8_SCHED;
            PG8_LDA(At, 1, 1); PG8_STAGE(PG8_SB(1, 0), b3, voffB); PG8_STAGE(PG8_SB(1, 1), b3 + hstep, voffB); PG8_STAGE(PG8_SA(1, 0), a3, voffA);
            PG8_WAIT_V(8); PG8_WAIT_L(0); PG8_BAR; PG8_MMA(1, 0, At, B0); PG8_MMA(1, 1, At, B1); PG8_BAR; PG8_SCHED;
            } else {
            PG8_LDB(B0, 0, 0); PG8_SCHED; PG8_LDA(At, 0, 0); PG8_STAGE(PG8_SA(1, 1), a1 + hstep, voffA);
            PG8_WAIT_L(8); PG8_BAR; PG8_WAIT_L(0); PG8_MMA(0, 0, At, B0); PG8_BAR; PG8_SCHED;
            PG8_LDB(B1, 0, 1); PG8_STAGE(PG8_SB(0, 0), b2, voffB);
            PG8_BAR; PG8_WAIT_L(0); PG8_MMA(0, 1, At, B1); PG8_BAR;
            PG8_LDA(At, 0, 1); PG8_STAGE(PG8_SA(0, 0), a2, voffA);
            PG8_BAR; PG8_WAIT_L(0); PG8_MMA(1, 0, At, B0); PG8_BAR; PG8_SCHED;
            PG8_STAGE(PG8_SB(0, 1), b2 + hstep, voffB);
            PG8_WAIT_V(6); PG8_BAR; PG8_MMA(1, 1, At, B1); PG8_BAR;
            PG8_LDB(B0, 1, 0); PG8_SCHED; PG8_LDA(At, 1, 0); PG8_STAGE(PG8_SA(0, 1), a2 + hstep, voffA);
            PG8_WAIT_L(8); PG8_BAR; PG8_WAIT_L(0); PG8_MMA(0, 0, At, B0); PG8_BAR; PG8_SCHED;
            PG8_LDB(B1, 1, 1); PG8_STAGE(PG8_SB(1, 0), b3, voffB);
            PG8_BAR; PG8_WAIT_L(0); PG8_MMA(0, 1, At, B1); PG8_BAR;
            PG8_LDA(At, 1, 1); PG8_STAGE(PG8_SA(1, 0), a3, voffA);
            PG8_BAR; PG8_WAIT_L(0); PG8_MMA(1, 0, At, B0); PG8_BAR; PG8_SCHED;
            PG8_STAGE(PG8_SB(1, 1), b3 + hstep, voffB);
            PG8_WAIT_V(6); PG8_BAR; PG8_MMA(1, 1, At, B1); PG8_BAR;
            }
        }
        if constexpr (ALIGN_EPI) { if (wr == 0) PG8_BAR; }
        if constexpr (!Epi::AFTER_DRAIN) { E(acc, cur, wr, wc, fr, fq); S.done(cur); }
        if (!has_next) break;
#pragma unroll
        for (int a = 0; a < 2; ++a)
#pragma unroll
            for (int b = 0; b < 2; ++b)
#pragma unroll
                for (int m = 0; m < 4; ++m)
#pragma unroll
                    for (int n = 0; n < 2; ++n) acc[a][b][m][n] = (f32x4){0.f, 0.f, 0.f, 0.f};
        cur = nxt; cA = nA; cB = nB; ++ui;
        if constexpr (ALIGN_EPI) { if (wr == 1) PG8_BAR; }
    }
    PG8_WAIT_V(0);
    if constexpr (!ALIGN_EPI) { if (wr == 0) PG8_BAR; }
    PG8_BAR;
    if constexpr (Epi::AFTER_DRAIN) { E.fused(acc, cur, wr, wc, fr, fq, lds, wid, lane); S.done(cur); }
#undef PG8_SA
#undef PG8_SB
#undef PG8_STAGE
#undef PG8_LDA
#undef PG8_LDB
#undef PG8_MMA
#undef PG8_WAIT_V
#undef PG8_WAIT_L
#undef PG8_BAR
#undef PG8_SCHED
}
}

namespace pg8 {
__device__ __forceinline__ float gelu_tanh(float x) {
    const float t = x * (1.5957691216057308f + 0.07135481627f * x * x);
    const float e = __builtin_amdgcn_exp2f(-1.4426950408889634f * t);
    return x * __builtin_amdgcn_rcpf(1.0f + e);
}
template <int ACT> struct EpiT {
    static constexpr bool PERM = true, AFTER_DRAIN = false;
    bf16_t* O; int ldc;
    __device__ __forceinline__ void operator()(const f32x4 (&acc)[2][2][4][2], const Unit& u, int wr, int wc, int fr, int fq) const {
        const int row0 = u.pm * BM + wr * 64 + fr; const int col0 = u.pn * BM + wc * 32 + 8 * fq;
#pragma unroll
        for (int ai = 0; ai < 2; ++ai)
#pragma unroll
            for (int m = 0; m < 4; ++m) { bf16_t* rowp = O + (size_t)(row0 + ai * HALF + m * 16) * ldc + col0;
#pragma unroll
                for (int bj = 0; bj < 2; ++bj) { f32x4 v0 = acc[ai][bj][m][0], v1 = acc[ai][bj][m][1];
                    if (ACT == 2) { v0 = (f32x4){gelu_tanh(v0[0]), gelu_tanh(v0[1]), gelu_tanh(v0[2]), gelu_tanh(v0[3])}; v1 = (f32x4){gelu_tanh(v1[0]), gelu_tanh(v1[1]), gelu_tanh(v1[2]), gelu_tanh(v1[3])}; }
                    u32x4 w; w.x = cvt_pk_bf16(v0[0], v0[1]); w.y = cvt_pk_bf16(v0[2], v0[3]); w.z = cvt_pk_bf16(v1[0], v1[1]); w.w = cvt_pk_bf16(v1[2], v1[3]);
                    *(u32x4*)(rowp + bj * HALF) = w; } }
    }
};
struct EpiR {
    static constexpr bool PERM = true, AFTER_DRAIN = false;
    bf16_t* O; int ldc; int act;
    __device__ __forceinline__ void operator()(const f32x4 (&acc)[2][2][4][2], const Unit& u, int wr, int wc, int fr, int fq) const {
        const int row0 = u.pm * BM + wr * 64 + fr; const int col0 = u.pn * BM + wc * 32 + 8 * fq;
#pragma unroll
        for (int ai = 0; ai < 2; ++ai)
#pragma unroll
            for (int m = 0; m < 4; ++m) { bf16_t* rowp = O + (size_t)(row0 + ai * HALF + m * 16) * ldc + col0;
#pragma unroll
                for (int bj = 0; bj < 2; ++bj) { f32x4 v0 = acc[ai][bj][m][0], v1 = acc[ai][bj][m][1];
                    if (act) { v0 = (f32x4){gelu_tanh(v0[0]), gelu_tanh(v0[1]), gelu_tanh(v0[2]), gelu_tanh(v0[3])}; v1 = (f32x4){gelu_tanh(v1[0]), gelu_tanh(v1[1]), gelu_tanh(v1[2]), gelu_tanh(v1[3])}; }
                    u32x4 w; w.x = cvt_pk_bf16(v0[0], v0[1]); w.y = cvt_pk_bf16(v0[2], v0[3]); w.z = cvt_pk_bf16(v1[0], v1[1]); w.w = cvt_pk_bf16(v1[2], v1[3]);
                    *(u32x4*)(rowp + bj * HALF) = w; } }
    }
};
}

constexpr int DM = 2048, NBATCH = 2, SEQ = 8192, CTXL = 256;
constexpr int ML = NBATCH * SEQ;
constexpr int MC = NBATCH * CTXL;
constexpr int MT = ML + MC;
constexpr int NLAYER = 4;
constexpr float ALPHA = 1.6817928305074290f, LN_EPS = 1e-6f;
constexpr int NWAVES = 8;
constexpr float U_SCALE = 512.0f, V_SCALE = 32.0f;
constexpr int NPH = 36;

constexpr size_t MiB = 1ull << 20;
constexpr size_t WS_CTL = 0, CTL_ZERO_BYTES = 1 * MiB;
constexpr int    CW_BAR = 4096;
constexpr size_t WS_MOD = 128 * 1024;
constexpr size_t WS_VST = 1 * MiB;
constexpr size_t WS_GMWIN = 2 * MiB;
constexpr size_t WS_GMWOUT = WS_GMWIN + 32 * MiB;
constexpr size_t WS_GMWS = WS_GMWOUT + 16 * MiB;
constexpr size_t WS_PWQ = WS_GMWS + 1 * MiB;
constexpr size_t WS_PK1 = WS_PWQ + 32 * MiB;
constexpr size_t WS_PK2 = WS_PK1 + 512 * 1024;
constexpr size_t WS_MLAIN = WS_PK1 + 1 * MiB;
constexpr size_t WS_MLAUQ = WS_MLAIN + 5 * MiB;
constexpr size_t WS_MLAUKV = WS_MLAUQ + 3 * MiB;
constexpr size_t WS_MLAOUT = WS_MLAUKV + 4 * MiB;
constexpr size_t WS_DAIN = WS_MLAOUT + 8 * MiB;
constexpr size_t WS_DAOUT = WS_DAIN + 24 * MiB;
constexpr size_t WS_PU = WS_DAOUT + 8 * MiB;
constexpr size_t WS_PV = WS_PU + 128 * MiB;
constexpr size_t WS_X = WS_PV + 128 * MiB;
constexpr size_t WS_H = WS_X + 66 * MiB;
constexpr size_t WS_G = WS_H + 66 * MiB;
constexpr size_t WS_Y = WS_G + 66 * MiB;
constexpr size_t WS_QP = WS_Y + 66 * MiB;
constexpr size_t WS_Z = WS_QP + 66 * MiB;
constexpr size_t WS_C = WS_Z + 198 * MiB;
constexpr size_t WS_CQN = WS_C + 42 * MiB;
constexpr size_t WS_CKVN = WS_CQN + 17 * MiB;
constexpr size_t WS_KR = WS_CKVN + 17 * MiB;
constexpr size_t WS_QM = WS_KR + 3 * MiB;
constexpr size_t WS_KV = WS_QM + 99 * MiB;
constexpr size_t WS_ROUTE = WS_KV + 132 * MiB;
constexpr size_t WS_END = WS_ROUTE + 17 * MiB;
static_assert((size_t)MT * DM * 2 == 66 * MiB, "row buffer size");

constexpr int RING_BYTES = 143360, MISC_OFF = RING_BYTES + 320, LDS_BYTES = 147456;

#define GAS __attribute__((address_space(1)))
#define LAS __attribute__((address_space(3)))
typedef unsigned short bf16;
typedef unsigned u32x4 __attribute__((ext_vector_type(4)));
typedef unsigned u32x2 __attribute__((ext_vector_type(2)));
typedef float f32x4 __attribute__((ext_vector_type(4)));
typedef float f32x16 __attribute__((ext_vector_type(16)));
typedef short bf16x8 __attribute__((ext_vector_type(8)));
typedef short s16x4 __attribute__((ext_vector_type(4)));
#define LDS_WAIT() asm volatile("s_waitcnt lgkmcnt(0)" ::: "memory")

__device__ __forceinline__ unsigned cvtpk(float lo, float hi) { unsigned r; asm("v_cvt_pk_bf16_f32 %0, %1, %2" : "=v"(r) : "v"(lo), "v"(hi)); return r; }
__device__ __forceinline__ float bflo(unsigned w) { return __uint_as_float(w << 16); }
__device__ __forceinline__ float bfhi(unsigned w) { return __uint_as_float(w & 0xffff0000u); }
__device__ __forceinline__ float bf1(bf16 b) { return __uint_as_float((unsigned)b << 16); }
__device__ __forceinline__ bf16 tobf1(float f) { return (bf16)(cvtpk(f, 0.f) & 0xffffu); }
#define DPP_F(v, ctrl) __int_as_float(__builtin_amdgcn_mov_dpp(__float_as_int(v), (ctrl), 0xF, 0xF, true))
__device__ __forceinline__ float row_sum16(float v) { v += DPP_F(v, 0xB1); v += DPP_F(v, 0x4E); v += DPP_F(v, 0x141); v += DPP_F(v, 0x140); return v; }
__device__ __forceinline__ float sum_xor16(float v) { const auto r = __builtin_amdgcn_permlane16_swap(__float_as_uint(v), __float_as_uint(v), false, false); return __uint_as_float(r[0]) + __uint_as_float(r[1]); }
__device__ __forceinline__ float sum_xor32(float v) { const auto r = __builtin_amdgcn_permlane32_swap(__float_as_uint(v), __float_as_uint(v), false, false); return __uint_as_float(r[0]) + __uint_as_float(r[1]); }
__device__ __forceinline__ float wave_sum(float v) { return sum_xor32(sum_xor16(row_sum16(v))); }
__device__ __forceinline__ float half_sum32(float v) { return sum_xor16(row_sum16(v)); }
__device__ __forceinline__ float lane_xor16(float v, int lane) { const auto r = __builtin_amdgcn_permlane16_swap(__float_as_uint(v), __float_as_uint(v), false, false); return __uint_as_float((lane & 16) ? r[0] : r[1]); }
__device__ __forceinline__ unsigned lane_xor32(unsigned v, int lane) { const auto r = __builtin_amdgcn_permlane32_swap(v, v, false, false); return (lane & 32) ? r[0] : r[1]; }
__device__ __forceinline__ float gelu_tanh(float x) { return pg8::gelu_tanh(x); }

__device__ __forceinline__ void load_row_bf16(const bf16* row, int lane, float (&v)[32]) {
#pragma unroll
    for (int j = 0; j < 4; ++j) { const u32x4 w = ((const u32x4*)row)[64 * j + lane];
        v[8 * j + 0] = bflo(w.x); v[8 * j + 1] = bfhi(w.x); v[8 * j + 2] = bflo(w.y); v[8 * j + 3] = bfhi(w.y);
        v[8 * j + 4] = bflo(w.z); v[8 * j + 5] = bfhi(w.z); v[8 * j + 6] = bflo(w.w); v[8 * j + 7] = bfhi(w.w); }
}
__device__ __forceinline__ void store_row_bf16(bf16* row, int lane, const float (&v)[32]) {
#pragma unroll
    for (int j = 0; j < 4; ++j) { u32x4 w; w.x = cvtpk(v[8 * j + 0], v[8 * j + 1]); w.y = cvtpk(v[8 * j + 2], v[8 * j + 3]); w.z = cvtpk(v[8 * j + 4], v[8 * j + 5]); w.w = cvtpk(v[8 * j + 6], v[8 * j + 7]);
        ((u32x4*)row)[64 * j + lane] = w; }
}
__device__ __forceinline__ void load_row_f32(const float* row, int lane, float (&v)[32]) {
#pragma unroll
    for (int j = 0; j < 4; ++j) { const f32x4 a = ((const f32x4*)row)[128 * j + 2 * lane], b = ((const f32x4*)row)[128 * j + 2 * lane + 1];
        v[8 * j + 0] = a.x; v[8 * j + 1] = a.y; v[8 * j + 2] = a.z; v[8 * j + 3] = a.w; v[8 * j + 4] = b.x; v[8 * j + 5] = b.y; v[8 * j + 6] = b.z; v[8 * j + 7] = b.w; }
}
__device__ __forceinline__ void store_row_f32(float* row, int lane, const float (&v)[32]) {
#pragma unroll
    for (int j = 0; j < 4; ++j) { ((f32x4*)row)[128 * j + 2 * lane] = (f32x4){v[8 * j + 0], v[8 * j + 1], v[8 * j + 2], v[8 * j + 3]};
        ((f32x4*)row)[128 * j + 2 * lane + 1] = (f32x4){v[8 * j + 4], v[8 * j + 5], v[8 * j + 6], v[8 * j + 7]}; }
}
__device__ __forceinline__ void load_row_bf16_b(const bf16* row, int lane, float (&v)[32]) {
#pragma unroll
    for (int j = 0; j < 4; ++j) { const u32x4 w = ((const u32x4*)row)[128 * (j >> 1) + 2 * lane + (j & 1)];
        v[8 * j + 0] = bflo(w.x); v[8 * j + 1] = bfhi(w.x); v[8 * j + 2] = bflo(w.y); v[8 * j + 3] = bfhi(w.y);
        v[8 * j + 4] = bflo(w.z); v[8 * j + 5] = bfhi(w.z); v[8 * j + 6] = bflo(w.w); v[8 * j + 7] = bfhi(w.w); }
}
__device__ __forceinline__ void store_row_bf16_b(bf16* row, int lane, const float (&v)[32]) {
#pragma unroll
    for (int j = 0; j < 4; ++j) { u32x4 w; w.x = cvtpk(v[8 * j + 0], v[8 * j + 1]); w.y = cvtpk(v[8 * j + 2], v[8 * j + 3]); w.z = cvtpk(v[8 * j + 4], v[8 * j + 5]); w.w = cvtpk(v[8 * j + 6], v[8 * j + 7]);
        ((u32x4*)row)[128 * (j >> 1) + 2 * lane + (j & 1)] = w; }
}
__device__ __forceinline__ void load_row_f32_b(const float* row, int lane, float (&v)[32]) {
#pragma unroll
    for (int q = 0; q < 8; ++q) { const f32x4 a = ((const f32x4*)row)[256 * (q >> 2) + 4 * lane + (q & 3)];
        v[4 * q + 0] = a.x; v[4 * q + 1] = a.y; v[4 * q + 2] = a.z; v[4 * q + 3] = a.w; }
}
__device__ __forceinline__ void store_row_f32_b(float* row, int lane, const float (&v)[32]) {
#pragma unroll
    for (int q = 0; q < 8; ++q) ((f32x4*)row)[256 * (q >> 2) + 4 * lane + (q & 3)] = (f32x4){v[4 * q + 0], v[4 * q + 1], v[4 * q + 2], v[4 * q + 3]};
}
__device__ __forceinline__ void ln_stats(const float (&v)[32], float& mean, float& rstd) {
    float s = 0.f;
#pragma unroll
    for (int i = 0; i < 32; ++i) s += v[i];
    mean = wave_sum(s) * (1.0f / DM);
    float q = 0.f;
#pragma unroll
    for (int i = 0; i < 32; ++i) { const float d = v[i] - mean; q += d * d; }
    rstd = 1.0f / sqrtf(wave_sum(q) * (1.0f / DM) + LN_EPS);
}
template <bool LAYB>
__device__ __forceinline__ void finish_row(float (&z)[32], const float* lng, const float* lnb, bf16* Xrow, const float* sh, const float* sc, bf16* Hrow, float* Orow, int lane) {
    float mean, rstd; ln_stats(z, mean, rstd);
    { float g[32], b[32]; if (LAYB) { load_row_f32_b(lng, lane, g); load_row_f32_b(lnb, lane, b); } else { load_row_f32(lng, lane, g); load_row_f32(lnb, lane, b); }
#pragma unroll
      for (int i = 0; i < 32; ++i) z[i] = (z[i] - mean) * rstd * g[i] + b[i]; }
    if (Xrow) { if (LAYB) store_row_bf16_b(Xrow, lane, z); else store_row_bf16(Xrow, lane, z); }
    if (Orow) { if (LAYB) store_row_f32_b(Orow, lane, z); else store_row_f32(Orow, lane, z); }
    if (Hrow) {
        ln_stats(z, mean, rstd);
        float a[32], s[32]; if (LAYB) { load_row_f32_b(sc, lane, a); load_row_f32_b(sh, lane, s); } else { load_row_f32(sc, lane, a); load_row_f32(sh, lane, s); }
#pragma unroll
        for (int i = 0; i < 32; ++i) a[i] = (z[i] - mean) * rstd * (1.0f + a[i]) + s[i];
        if (LAYB) store_row_bf16_b(Hrow, lane, a); else store_row_bf16(Hrow, lane, a);
    }
}
__device__ __forceinline__ int row_slot(int row) { return row < ML ? (row >> 13) : 2; }

__device__ __forceinline__ unsigned f2bf_rne(float f) { unsigned u = __float_as_uint(f); return (u + 0x7fffu + ((u >> 16) & 1u)) >> 16; }
__device__ __forceinline__ unsigned pk2(float lo, float hi) { return f2bf_rne(lo) | (f2bf_rne(hi) << 16); }
__device__ __forceinline__ void p0_transpose_item(const float* W, int K, int N, bf16* WT, LAS float* scr, int item, int lane) {
    const int nblk = N / 32, kb = item / nblk, nb = item % nblk, k0 = 64 * kb, n0 = 32 * nb;
#pragma unroll 8
    for (int i = 0; i < 32; ++i) { const int kk = 2 * i + (lane >> 5); scr[kk * 33 + (lane & 31)] = W[(size_t)(k0 + kk) * N + n0 + (lane & 31)]; }
    LDS_WAIT(); asm volatile("" ::: "memory");
    const int c = lane & 7;
#pragma unroll
    for (int j = 0; j < 4; ++j) { const int n = (lane >> 3) + 8 * j; const LAS float* s = scr + (8 * c) * 33 + n;
        u32x4 o; o.x = pk2(s[0 * 33], s[1 * 33]); o.y = pk2(s[2 * 33], s[3 * 33]); o.z = pk2(s[4 * 33], s[5 * 33]); o.w = pk2(s[6 * 33], s[7 * 33]);
        *(u32x4*)(WT + (size_t)(n0 + n) * K + k0 + 8 * c) = o; }
    LDS_WAIT(); asm volatile("" ::: "memory");
}
__device__ __forceinline__ void cvt_range(const float* src, bf16* dst, size_t n8, size_t gtid, size_t gthreads) {
#pragma unroll 4
    for (size_t i = gtid; i < n8; i += gthreads) { const f32x4 a = ((const f32x4*)src)[2 * i], b = ((const f32x4*)src)[2 * i + 1];
        u32x4 w; w.x = cvtpk(a.x, a.y); w.y = cvtpk(a.z, a.w); w.z = cvtpk(b.x, b.y); w.w = cvtpk(b.z, b.w); ((u32x4*)dst)[i] = w; }
}
__device__ __forceinline__ void cvt_range_fp8(const float* src, unsigned char* dst, size_t n16, float scale, size_t gtid, size_t gthreads) {
#pragma unroll 2
    for (size_t i = gtid; i < n16; i += gthreads) { u32x4 w;
#pragma unroll
        for (int q = 0; q < 4; ++q) { const f32x4 a = ((const f32x4*)src)[4 * i + q] * scale;
            int p = __builtin_amdgcn_cvt_pk_fp8_f32(a.x, a.y, 0, false); p = __builtin_amdgcn_cvt_pk_fp8_f32(a.z, a.w, p, true); w[q] = (unsigned)p; }
        ((u32x4*)dst)[i] = w; }
}
__device__ __forceinline__ float silu(float x) { return x / (1.0f + __expf(-x)); }

struct Params { const float* in[29]; float* out; unsigned char* ws; int ph_lo, ph_hi; };
typedef const __attribute__((address_space(4))) Params* CP;

__device__ __forceinline__ void p0_prologue(CP P, LAS unsigned char* lds, int tid, int lane, int wid, int gw, int NGW) {
    unsigned char* ws = P->ws;
    LAS float* scr = (LAS float*)(lds + wid * 16384);
    {
        constexpr int I_GMIN = (2048 / 64) * (4096 / 32), I_SQ = (2048 / 64) * (2048 / 32), I_MIN = (2048 / 64) * (1088 / 32), I_UQ = (512 / 64) * (3072 / 32), I_UKV = (512 / 64) * (4096 / 32), I_DIN = (2048 / 64) * (6144 / 32);
        constexpr int NIT = 2 * I_GMIN + 2 * I_SQ + 4 * I_SQ + I_MIN + I_UQ + I_UKV + I_SQ + I_DIN + I_SQ;
        for (int it = gw; it < NIT; it += NGW) {
            int r = it;
            if (r < 2 * I_GMIN) { const int j = r / I_GMIN; p0_transpose_item(P->in[13] + (size_t)j * 2048 * 4096, 2048, 4096, (bf16*)(ws + WS_GMWIN) + (size_t)j * 4096 * 2048, scr, r % I_GMIN, lane); continue; } r -= 2 * I_GMIN;
            if (r < 2 * I_SQ) { const int j = r / I_SQ; p0_transpose_item(P->in[18] + (size_t)j * 2048 * 2048, 2048, 2048, (bf16*)(ws + WS_GMWOUT) + (size_t)j * 2048 * 2048, scr, r % I_SQ, lane); continue; } r -= 2 * I_SQ;
            if (r < 4 * I_SQ) { const int j = r / I_SQ; p0_transpose_item(P->in[8] + (size_t)j * 2048 * 2048, 2048, 2048, (bf16*)(ws + WS_PWQ) + (size_t)j * 2048 * 2048, scr, r % I_SQ, lane); continue; } r -= 4 * I_SQ;
            if (r < I_MIN) { p0_transpose_item(P->in[19], 2048, 1088, (bf16*)(ws + WS_MLAIN), scr, r, lane); continue; } r -= I_MIN;
            if (r < I_UQ) { p0_transpose_item(P->in[22], 512, 3072, (bf16*)(ws + WS_MLAUQ), scr, r, lane); continue; } r -= I_UQ;
            if (r < I_UKV) { p0_transpose_item(P->in[23], 512, 4096, (bf16*)(ws + WS_MLAUKV), scr, r, lane); continue; } r -= I_UKV;
            if (r < I_SQ) { p0_transpose_item(P->in[24], 2048, 2048, (bf16*)(ws + WS_MLAOUT), scr, r, lane); continue; } r -= I_SQ;
            if (r < I_DIN) { p0_transpose_item(P->in[25], 2048, 6144, (bf16*)(ws + WS_DAIN), scr, r, lane); continue; } r -= I_DIN;
            p0_transpose_item(P->in[28], 2048, 2048, (bf16*)(ws + WS_DAOUT), scr, r, lane);
        }
    }
    const size_t gtid = (size_t)gw * 64 + lane, gthreads = (size_t)NGW * 64;
    { u32x4* z = (u32x4*)((bf16*)(ws + WS_MLAIN) + (size_t)1088 * 2048); const size_t n = (size_t)192 * 2048 / 8;
      for (size_t i = gtid; i < n; i += gthreads) z[i] = (u32x4){0u, 0u, 0u, 0u}; }
    cvt_range(P->in[16], (bf16*)(ws + WS_GMWS), (size_t)2 * 16 * 128 * 128 / 8, gtid, gthreads);
    cvt_range(P->in[9], (bf16*)(ws + WS_PK1), (size_t)4 * 128 * 128 / 8, gtid, gthreads);
    cvt_range(P->in[10], (bf16*)(ws + WS_PK2), (size_t)4 * 128 * 128 / 8, gtid, gthreads);
    cvt_range_fp8(P->in[11], ws + WS_PU, (size_t)4 * 16384 * 2048 / 16, U_SCALE, gtid, gthreads);
    cvt_range_fp8(P->in[12], ws + WS_PV, (size_t)4 * 16384 * 2048 / 16, V_SCALE, gtid, gthreads);
    {
        const float* cv = P->in[1]; const float* cc = P->in[3]; const float* mw = P->in[4]; const float* mb = P->in[5]; float* MOD = (float*)(ws + WS_MOD);
        for (int item = gw; item < 4 * 192; item += NGW) {
            const int L = item / 192, n = (item % 192) * 64 + lane;
            const float* W = mw + (size_t)L * 2048 * 12288 + n;
            float a0 = 0.f, a1 = 0.f, a2 = 0.f;
#pragma unroll 16
            for (int k = 0; k < 2048; ++k) { const float s0 = silu(cv[k]), s1 = silu(cv[2048 + k]), s2 = silu(cc[k]);
                const float w = W[(size_t)k * 12288]; a0 += s0 * w; a1 += s1 * w; a2 += s2 * w; }
            const float bb = mb[(size_t)L * 12288 + n];
            float* o = MOD + (size_t)(L * 3) * 12288 + n;
            o[0] = a0 + bb; o[12288] = a1 + bb; o[24576] = a2 + bb;
        }
    }
}

__device__ __forceinline__ void first_row_pass(CP P, int lane, int gw, int NGW) {
    const float* MOD = (const float*)(P->ws + WS_MOD); bf16* X = (bf16*)(P->ws + WS_X); bf16* H = (bf16*)(P->ws + WS_H);
    for (int row = gw; row < MT; row += NGW) {
        const float* src = row < ML ? P->in[0] + (size_t)row * DM : P->in[2] + (size_t)(row - ML) * DM;
        float v[32]; load_row_f32(src, lane, v);
        store_row_bf16(X + (size_t)row * DM, lane, v);
        const float* mod = MOD + (size_t)row_slot(row) * 12288;
        float mean, rstd; ln_stats(v, mean, rstd);
        float a[32], s[32]; load_row_f32(mod + 2048, lane, a); load_row_f32(mod, lane, s);
#pragma unroll
        for (int i = 0; i < 32; ++i) a[i] = (v[i] - mean) * rstd * (1.0f + a[i]) + s[i];
        store_row_bf16(H + (size_t)row * DM, lane, a);
    }
}
__device__ __forceinline__ void post_mixer_pass(CP P, int L, int Mrows, int lane, int gw, int NGW) {
    const float* MOD = (const float*)(P->ws + WS_MOD); bf16* X = (bf16*)(P->ws + WS_X); bf16* H = (bf16*)(P->ws + WS_H); const bf16* Y = (const bf16*)(P->ws + WS_Y);
    const float* lng = P->in[6] + (size_t)(L * 2 + 0) * DM; const float* lnb = P->in[7] + (size_t)(L * 2 + 0) * DM;
    for (int row = gw; row < Mrows; row += NGW) {
        const float* mod = MOD + (size_t)(L * 3 + row_slot(row)) * 12288;
        float z[32], y[32], g[32]; load_row_bf16(X + (size_t)row * DM, lane, z); load_row_bf16(Y + (size_t)row * DM, lane, y); load_row_f32(mod + 2 * 2048, lane, g);
#pragma unroll
        for (int i = 0; i < 32; ++i) z[i] = ALPHA * z[i] + g[i] * y[i];
        finish_row<false>(z, lng, lnb, X + (size_t)row * DM, mod + 3 * 2048, mod + 4 * 2048, H + (size_t)row * DM, nullptr, lane);
    }
}
__device__ __forceinline__ void vstats_pass(CP P, int Mrows, int lane, int gw, int NGW) {
    const bf16* Z = (const bf16*)(P->ws + WS_Z); float* VST = (float*)(P->ws + WS_VST);
    for (int row = gw; row < Mrows; row += NGW) {
        float v[32]; load_row_bf16(Z + (size_t)row * 4096 + 2048, lane, v);
        float mean, rstd; ln_stats(v, mean, rstd);
        if (lane == 0) { VST[2 * row] = mean; VST[2 * row + 1] = rstd; }
    }
}
#define XB_TMO      128
#define XB_XCNT(j)  (256  + 64 * (j))
#define XB_XSUB(j)  (1280 + 64 * (j))
#define XB_XGEN(j)  (2304 + 64 * (j))
#define XB_TOP      3328
#define XB_TOPGEN   3392
#define XCD_BAR_WORDS 3456
#define XB_SPIN_CAP (1u << 18)

__device__ __forceinline__ unsigned xb_ld(unsigned* p)              { return __hip_atomic_load(p, __ATOMIC_RELAXED, __HIP_MEMORY_SCOPE_AGENT); }
__device__ __forceinline__ unsigned xb_add(unsigned* p, unsigned v) { return __hip_atomic_fetch_add(p, v, __ATOMIC_RELAXED, __HIP_MEMORY_SCOPE_AGENT); }
__device__ __forceinline__ unsigned xb_xcc_id() { return (unsigned)__builtin_amdgcn_s_getreg((3 << 11) | 20) & 0xFu; }
#define XB_SPIN(cond, bar) do { unsigned _sp = 0; while (cond) { __builtin_amdgcn_s_sleep(1); \
    if ((++_sp & 255u) == 0u) { if (xb_ld(&(bar)[XB_TMO])) break; if (_sp > XB_SPIN_CAP) { atomicAdd(&(bar)[XB_TMO], 1u); break; } } } } while (0)

struct XcdBarrier {
    unsigned* bar; unsigned x;
    volatile LAS unsigned* st;
};

__device__ __forceinline__ XcdBarrier xcd_barrier_post(unsigned* bar, volatile LAS unsigned* st) {
    XcdBarrier b; b.bar = bar; b.x = xb_xcc_id(); b.st = st;
    if (threadIdx.x == 0) (void)xb_add(&bar[XB_XCNT(b.x)], 1u);
    return b;
}
__device__ __forceinline__ void xcd_barrier_complete(unsigned* bar, unsigned x, unsigned& nloc, unsigned& nx) {
    const unsigned G = gridDim.x * gridDim.y * gridDim.z;
    unsigned sum, cnt, mine, sp = 0u;
    for (;;) {
        sum = 0u; cnt = 0u; mine = 0u;
#pragma unroll
        for (unsigned j = 0; j < 16; ++j) { const unsigned c = xb_ld(&bar[XB_XCNT(j)]); sum += c; cnt += (c > 0u) ? 1u : 0u; mine = (j == x) ? c : mine; }
        if (sum == G) break;
        __builtin_amdgcn_s_sleep(1);
        if ((++sp & 255u) == 0u) { if (xb_ld(&bar[XB_TMO])) break; if (sp > XB_SPIN_CAP) { atomicAdd(&bar[XB_TMO], 1u); break; } }
    }
    nloc = mine > 0u ? mine : 1u; nx = cnt > 0u ? cnt : 1u;
}

__device__ __attribute__((noinline)) void xcd_barrier(const XcdBarrier b) {
    asm volatile("s_waitcnt vmcnt(0)" ::: "memory");
    __syncthreads();
    if (threadIdx.x == 0) {
        unsigned* bar = b.bar;
        __builtin_amdgcn_s_waitcnt(0);
        unsigned nloc = b.st[0], nx = b.st[1];
        if (nloc == 0u) { xcd_barrier_complete(bar, b.x, nloc, nx); b.st[0] = nloc; b.st[1] = nx; }
        const unsigned old = xb_add(&bar[XB_XSUB(b.x)], 1u);
        const unsigned gen = old / nloc;
        if (old + 1u == (gen + 1u) * nloc) {
            __builtin_amdgcn_fence(__ATOMIC_RELEASE, "agent");
            asm volatile("s_waitcnt vmcnt(0)" ::: "memory");
            const unsigned og = xb_add(&bar[XB_TOP], 1u);
            const unsigned tg = og / nx;
            if (og + 1u == (tg + 1u) * nx) xb_add(&bar[XB_TOPGEN], 1u);
            else XB_SPIN(xb_ld(&bar[XB_TOPGEN]) == tg, bar);
            __builtin_amdgcn_fence(__ATOMIC_ACQUIRE, "agent");
            xb_add(&bar[XB_XGEN(b.x)], 1u);
            asm volatile("s_waitcnt vmcnt(0)" ::: "memory");
        } else {
            XB_SPIN(xb_ld(&bar[XB_XGEN(b.x)]) == gen, bar);
            __builtin_amdgcn_fence(__ATOMIC_ACQUIRE, "agent");
            asm volatile("s_waitcnt vmcnt(0)" ::: "memory");
        }
    }
    __syncthreads();
}

__device__ __forceinline__ void spatial_phase(CP P, int j, int Mrows, LAS unsigned char* lds_, int tid, int lane, int wid) {
    const bf16* Z = (const bf16*)(P->ws + WS_Z); const float* VST = (const float*)(P->ws + WS_VST); bf16* Gb = (bf16*)(P->ws + WS_G);
    const bf16* WS = (const bf16*)(P->ws + WS_GMWS) + (size_t)j * 16 * 128 * 128;
    const float* lng = P->in[14] + (size_t)j * DM; const float* lnb = P->in[15] + (size_t)j * DM; const float* bs = P->in[17] + (size_t)j * 16 * 128;
    LAS bf16* Vt = (LAS bf16*)(LAS unsigned char*)lds_;
    constexpr int VP = 136;
    const int nunits = (Mrows / 128) * 16;
    for (int u = blockIdx.x; u < nunits; u += gridDim.x) {
        const int c = u >> 4, g = u & 15;
        __syncthreads();
        {
            const int q = tid >> 2, dq = (tid & 3) * 32; const int row = c * 128 + q;
            const float mean = VST[2 * row], rstd = VST[2 * row + 1];
            const bf16* src = Z + (size_t)row * 4096 + 2048 + g * 128 + dq;
#pragma unroll
            for (int t = 0; t < 4; ++t) { const u32x4 w = *(const u32x4*)(src + 8 * t);
                float v[8] = {bflo(w.x), bfhi(w.x), bflo(w.y), bfhi(w.y), bflo(w.z), bfhi(w.z), bflo(w.w), bfhi(w.w)};
                const float* gp = lng + g * 128 + dq + 8 * t; const float* bp = lnb + g * 128 + dq + 8 * t;
#pragma unroll
                for (int i = 0; i < 8; ++i) { const float vn = (v[i] - mean) * rstd * gp[i] + bp[i]; Vt[(dq + 8 * t + i) * VP + q] = tobf1(vn); } }
        }
        __syncthreads();
        const int fr = lane & 15, fq = lane >> 4;
        bf16x8 a[4];
        const bf16* wrow = WS + (size_t)g * 128 * 128 + (size_t)(16 * wid + fr) * 128 + 8 * fq;
#pragma unroll
        for (int ks = 0; ks < 4; ++ks) a[ks] = *(const bf16x8*)(wrow + 32 * ks);
#pragma unroll
        for (int nb = 0; nb < 8; ++nb) {
            f32x4 acc = {0.f, 0.f, 0.f, 0.f};
#pragma unroll
            for (int ks = 0; ks < 4; ++ks) { const bf16x8 b = *(const LAS bf16x8*)(Vt + (16 * nb + fr) * VP + 32 * ks + 8 * fq);
                acc = __builtin_amdgcn_mfma_f32_16x16x32_bf16(a[ks], b, acc, 0, 0, 0); }
#pragma unroll
            for (int r = 0; r < 4; ++r) { const int p = 16 * wid + fq * 4 + r, d = 16 * nb + fr; const size_t grow = (size_t)(c * 128 + p);
                const float sv = acc[r] + bs[g * 128 + p];
                const float uu = bf1(Z[grow * 4096 + g * 128 + d]);
                Gb[grow * 2048 + g * 128 + d] = tobf1(uu * sv); }
        }
    }
}

__device__ __forceinline__ void rope_cs(int row, int l, float& cs, float& sn) {
    const int t = row & (SEQ - 1); const int pos = (l & 32) ? (t & 63) : (t >> 6);
    const float inv = powf(10000.0f, -(float)(l & 15) * (1.0f / 16.0f));
    const float ang = (float)pos * inv; sincosf(ang, &sn, &cs);
}
__device__ __forceinline__ float rope_apply(float x, int l, float cs, float sn) {
    const float p = lane_xor16(x, l);
    return (l & 16) ? (p * sn + x * cs) : (x * cs - p * sn);
}
__device__ __forceinline__ void mla_norm_pass(CP P, int lane, int gw, int NGW) {
    const bf16* C = (const bf16*)(P->ws + WS_C); bf16* CQN = (bf16*)(P->ws + WS_CQN); bf16* CKVN = (bf16*)(P->ws + WS_CKVN); bf16* KR = (bf16*)(P->ws + WS_KR);
    const float* qn = P->in[20]; const float* kvn = P->in[21];
    for (int row = gw; row < MT; row += NGW) {
        const bf16* c = C + (size_t)row * 1280;
#pragma unroll
        for (int part = 0; part < 2; ++part) {
            const u32x4 w = *(const u32x4*)(c + part * 512 + 8 * lane);
            float v[8] = {bflo(w.x), bfhi(w.x), bflo(w.y), bfhi(w.y), bflo(w.z), bfhi(w.z), bflo(w.w), bfhi(w.w)};
            float ss = 0.f;
#pragma unroll
            for (int i = 0; i < 8; ++i) ss += v[i] * v[i];
            const float r = 1.0f / sqrtf(wave_sum(ss) * (1.0f / 512.0f) + LN_EPS);
            const float* nw = (part ? kvn : qn) + 8 * lane;
            u32x4 o; o.x = cvtpk(v[0] * r * nw[0], v[1] * r * nw[1]); o.y = cvtpk(v[2] * r * nw[2], v[3] * r * nw[3]); o.z = cvtpk(v[4] * r * nw[4], v[5] * r * nw[5]); o.w = cvtpk(v[6] * r * nw[6], v[7] * r * nw[7]);
            *(u32x4*)((part ? CKVN : CQN) + (size_t)row * 512 + 8 * lane) = o;
        }
        float x = bf1(c[1024 + lane]);
        if (row < ML) { float cs, sn; rope_cs(row, lane, cs, sn); x = rope_apply(x, lane, cs, sn); }
        KR[(size_t)row * 64 + lane] = tobf1(x);
    }
}
__device__ __forceinline__ void rope_pass(bf16* buf, int ld, int col0, int nchunks, int cstride, int lane, int gw, int NGW) {
    for (int row = gw; row < ML; row += NGW) {
        float cs, sn; rope_cs(row, lane, cs, sn);
        bf16* r = buf + (size_t)row * ld + col0 + lane;
#pragma unroll 4
        for (int k = 0; k < nchunks; ++k) { const float x = bf1(r[k * cstride]); r[k * cstride] = tobf1(rope_apply(x, lane, cs, sn)); }
    }
}

namespace att {
#define SBAR() __builtin_amdgcn_sched_barrier(0)
__device__ __forceinline__ int crow(int r, int hi) { return (r & 3) + 8 * (r >> 2) + 4 * hi; }
__device__ __forceinline__ unsigned cvtpkv(float lo, float hi) { unsigned r; asm volatile("v_cvt_pk_bf16_f32 %0, %1, %2" : "=v"(r) : "v"(lo), "v"(hi)); return r; }

__device__ __forceinline__ void partialSM(f32x16& p0, f32x16& p1, float& m_reg, float& mn, float& alpha, const float C, const float THRS) {
  float pmax = p0[0];
#pragma unroll
  for (int r = 1; r < 16; ++r) pmax = fmaxf(pmax, p0[r]);
#pragma unroll
  for (int r = 0; r < 16; ++r) pmax = fmaxf(pmax, p1[r]);
  { auto rr = __builtin_amdgcn_permlane32_swap(__float_as_uint(pmax), __float_as_uint(pmax), false, false);
    pmax = fmaxf(__uint_as_float(rr[0]), __uint_as_float(rr[1])); }
  if (__builtin_expect(__all(pmax - m_reg <= THRS), 1)) { mn = m_reg; alpha = 1.f; }
  else { mn = fmaxf(m_reg, pmax); alpha = __builtin_amdgcn_exp2f((m_reg - mn) * C); m_reg = mn; }
  const float mnC = -mn * C;
#pragma unroll
  for (int r = 0; r < 16; ++r) p0[r] = fmaf(p0[r], C, mnC);
#pragma unroll
  for (int r = 0; r < 16; ++r) p1[r] = fmaf(p1[r], C, mnC);
#pragma unroll
  for (int r = 0; r < 16; ++r) p0[r] = __builtin_amdgcn_exp2f(p0[r]);
}
__device__ __forceinline__ void finishSM(f32x16& p0, f32x16& p1, float alpha, float& l_reg, bf16x8& pa0, bf16x8& pa1, bf16x8& pa2, bf16x8& pa3) {
#pragma unroll
  for (int r = 0; r < 16; ++r) p1[r] = __builtin_amdgcn_exp2f(p1[r]);
  float ps = 0;
#pragma unroll
  for (int r = 0; r < 16; ++r) ps += p0[r];
#pragma unroll
  for (int r = 0; r < 16; ++r) ps += p1[r];
  { auto rr = __builtin_amdgcn_permlane32_swap(__float_as_uint(ps), __float_as_uint(ps), false, false);
    ps = __uint_as_float(rr[0]) + __uint_as_float(rr[1]); }
  l_reg = l_reg * alpha + ps;
#define PK4(P, BASE, OUT) do { unsigned a0 = cvtpkv(P[BASE + 0], P[BASE + 1]), a1 = cvtpkv(P[BASE + 2], P[BASE + 3]);   \
    unsigned b0 = cvtpkv(P[BASE + 4], P[BASE + 5]), b1 = cvtpkv(P[BASE + 6], P[BASE + 7]);                              \
    auto r0 = __builtin_amdgcn_permlane32_swap(a0, b0, false, false); auto r1 = __builtin_amdgcn_permlane32_swap(a1, b1, false, false); \
    u32x4 w = {r0[0], r1[0], r0[1], r1[1]}; OUT = *reinterpret_cast<bf16x8*>(&w); } while (0)
  PK4(p0, 0, pa0); PK4(p0, 8, pa1); PK4(p1, 0, pa2); PK4(p1, 8, pa3);
#undef PK4
}
template <int PITCH> __device__ __forceinline__ int kswz(int r) { return PITCH == 256 ? (r & 15) : ((r >> 1) & 7); }
template <int NQF, int NQR, int PITCH> __device__ __forceinline__ void qkt(f32x16& p0, f32x16& p1, const LAS char* Ks, int chunk0, const bf16x8* qr, const LAS char* ql, int r32, int hi) {
  p0 = f32x16{}; p1 = f32x16{};
  const int sw = kswz<PITCH>(r32);
#pragma unroll
  for (int d0 = 0; d0 < NQF; ++d0) { const int off = ((chunk0 + d0 * 2 + hi) ^ sw) * 16;
    const bf16x8 b0 = *(const LAS bf16x8*)(Ks + r32 * PITCH + off);
    const bf16x8 b1 = *(const LAS bf16x8*)(Ks + (32 + r32) * PITCH + off);
    const bf16x8 q = d0 < NQR ? qr[d0 < NQR ? d0 : 0] : *(const LAS bf16x8*)(ql + (d0 - NQR) * 1024);
    p0 = __builtin_amdgcn_mfma_f32_32x32x16_bf16(b0, q, p0, 0, 0, 0);
    p1 = __builtin_amdgcn_mfma_f32_32x32x16_bf16(b1, q, p1, 0, 0, 0); }
}
__device__ __forceinline__ int v_st(int k, int c) { const int kk = (k & ~0xC) | ((k & 4) << 1) | ((k & 8) >> 1); return ((kk >> 3) * 4 + (c >> 5)) * 512 + ((kk & 7) * 32 + (c & 31)) * 2; }
__device__ __forceinline__ int v_rd_base(int lane) { return ((lane & 3) << 3) | (((lane >> 2) & 3) << 6) | (((lane >> 4) & 1) << 5) | (((lane >> 5) & 1) << 8); }
constexpr int v_rd_off(int d0, int ks, int half) { return d0 * 512 + ks * 4096 + half * 2048; }
template <int OFF> __device__ __forceinline__ s16x4 tr_read(int vb) {
  s16x4 r; asm volatile("ds_read_b64_tr_b16 %0, %1 offset:%2" : "=&v"(r) : "v"(vb), "i"(OFF) : "memory"); return r;
}
template <int D0> __device__ __forceinline__ void pv_one(f32x16& od, int vb, bf16x8 pa0, bf16x8 pa1, bf16x8 pa2, bf16x8 pa3) {
  const s16x4 l0 = tr_read<v_rd_off(D0, 0, 0)>(vb), h0 = tr_read<v_rd_off(D0, 0, 1)>(vb), l1 = tr_read<v_rd_off(D0, 1, 0)>(vb), h1 = tr_read<v_rd_off(D0, 1, 1)>(vb);
  const s16x4 l2 = tr_read<v_rd_off(D0, 2, 0)>(vb), h2 = tr_read<v_rd_off(D0, 2, 1)>(vb), l3 = tr_read<v_rd_off(D0, 3, 0)>(vb), h3 = tr_read<v_rd_off(D0, 3, 1)>(vb);
  asm volatile("s_waitcnt lgkmcnt(0)" ::: "memory"); SBAR();
#define PK(L, H) (bf16x8){L[0], L[1], L[2], L[3], H[0], H[1], H[2], H[3]}
  od = __builtin_amdgcn_mfma_f32_32x32x16_bf16(pa0, PK(l0, h0), od, 0, 0, 0);
  od = __builtin_amdgcn_mfma_f32_32x32x16_bf16(pa1, PK(l1, h1), od, 0, 0, 0);
  od = __builtin_amdgcn_mfma_f32_32x32x16_bf16(pa2, PK(l2, h2), od, 0, 0, 0);
  od = __builtin_amdgcn_mfma_f32_32x32x16_bf16(pa3, PK(l3, h3), od, 0, 0, 0);
#undef PK
}
__device__ __forceinline__ void pv_d0(f32x16* o, int vb, bf16x8 pa0, bf16x8 pa1, bf16x8 pa2, bf16x8 pa3) {
  pv_one<0>(o[0], vb, pa0, pa1, pa2, pa3); pv_one<1>(o[1], vb, pa0, pa1, pa2, pa3); pv_one<2>(o[2], vb, pa0, pa1, pa2, pa3); pv_one<3>(o[3], vb, pa0, pa1, pa2, pa3);
}
__device__ __forceinline__ bf16x8 ld8(const bf16* p) { return *reinterpret_cast<const bf16x8*>(p); }

template <int MODE>
__device__ __forceinline__ void attn_unit(const bf16* __restrict__ Qrow0, int ldq, const bf16* __restrict__ Kb, const bf16* __restrict__ Vb, int ldk, const bf16* __restrict__ KRb,
                                          int b, int nct, int NT, bf16* __restrict__ Ob, float lam, const float* __restrict__ subln, float oscale, LAS unsigned char* lds_) {
  constexpr int NQF = MODE == 0 ? 12 : 4, NQR = MODE == 0 ? 6 : 4, PITCH = MODE == 0 ? 384 : 256, SHM_V = 16384, SHM_K = 64 * PITCH, SDEPTH = MODE == 0 ? 1 : 2;
  const float SCALE = MODE == 0 ? 0.07216878364870323f : 0.125f;
  const float C = SCALE * 1.4426950408889634f, THRS = 8.f / SCALE;
  const int tid = launder_v(threadIdx.x), wid = tid >> 6, lane = tid & 63, r32 = lane & 31, hi = lane >> 5;
  LAS char* lds = (LAS char*)(LAS unsigned char*)lds_;
  LAS char* V_lds = lds; LAS char* K_lds = lds + 2 * SHM_V;
  LAS float* wsf = (LAS float*)(lds + 2 * SHM_V + 2 * SHM_K) + wid * 64; LAS float* li_l = wsf; LAS float* al_l = wsf + 32;
  const int wq = MODE == 0 ? wid : (wid & 3), sgrp = MODE == 0 ? 0 : (wid >> 2);
  float m_reg = -1e30f, l_reg = 0; f32x16 o[4] = {}; bf16x8 qr[NQR];
  LAS char* ql = lds + 2 * SHM_V + 2 * SHM_K + 2048 + wid * 6144 + lane * 16;
  const bf16* Qw = Qrow0 + (size_t)(wq * 32 + r32) * ldq + sgrp * 64 + hi * 8;
#pragma unroll
  for (int d0 = 0; d0 < NQR; ++d0) qr[d0] = ld8(Qw + d0 * 16);
#pragma unroll
  for (int d0 = NQR; d0 < NQF; ++d0) *(LAS bf16x8*)(ql + (d0 - NQR) * 1024) = ld8(Qw + d0 * 16);
  const int sr = tid >> 4, sc = (tid & 15) * 8, vst0 = v_st(sr, sc), vst1 = v_st(32 + sr, sc);
  const int kst0 = sr * PITCH + (((tid & 15) ^ kswz<PITCH>(sr)) * 16), kst1 = kst0 + 32 * PITCH;
  const int rrow = tid >> 3, krs = rrow * PITCH + (((16 + (tid & 7)) ^ kswz<PITCH>(rrow)) * 16);
  const int chunk0 = sgrp * 8;
  const int vb0 = (int)(uintptr_t)V_lds + v_rd_base(lane);
  struct Slot { bf16x8 vs0, vs1, ks0, ks1, kr; } sr_[SDEPTH];
#define KROW(jt) ((jt) < nct ? (ML + b * CTXL + (jt) * 64) : (b * SEQ + ((jt) - nct) * 64))
#define SLOAD(i, jt) do { const int k0_ = KROW(jt); sr_[i].vs0 = ld8(Vb + (size_t)(k0_ + sr) * ldk + sc); sr_[i].vs1 = ld8(Vb + (size_t)(k0_ + 32 + sr) * ldk + sc); \
    sr_[i].ks0 = ld8(Kb + (size_t)(k0_ + sr) * ldk + sc); sr_[i].ks1 = ld8(Kb + (size_t)(k0_ + 32 + sr) * ldk + sc); \
    if (MODE == 0) sr_[i].kr = ld8(KRb + (size_t)(k0_ + rrow) * 64 + (tid & 7) * 8); } while (0)
#define SWRITE(bf, i) do { *(LAS bf16x8*)(V_lds + (bf) * SHM_V + vst0) = sr_[i].vs0; *(LAS bf16x8*)(V_lds + (bf) * SHM_V + vst1) = sr_[i].vs1; \
    *(LAS bf16x8*)(K_lds + (bf) * SHM_K + kst0) = sr_[i].ks0; *(LAS bf16x8*)(K_lds + (bf) * SHM_K + kst1) = sr_[i].ks1; \
    if (MODE == 0) *(LAS bf16x8*)(K_lds + (bf) * SHM_K + krs) = sr_[i].kr; } while (0)
#define SWAIT() do { if constexpr (SDEPTH == 2) asm volatile("s_waitcnt vmcnt(4)" ::: "memory"); else asm volatile("s_waitcnt vmcnt(0)" ::: "memory"); } while (0)
#define RESC(a) do { if (__any((a) < 1.f)) { if (hi == 0) al_l[r32] = (a); asm volatile("s_waitcnt lgkmcnt(0)" ::: "memory"); \
    _Pragma("unroll") for (int d = 0; d < 4; ++d) _Pragma("unroll") for (int r = 0; r < 16; ++r) o[d][r] *= al_l[crow(r, hi)]; } } while (0)
  f32x16 pA0, pA1, pB0, pB1; float mnA, mnB, alA, alB; bf16x8 pa0, pa1, pa2, pa3;
  constexpr int SE = 0, SO = SDEPTH - 1;
  SLOAD(SE, 0); asm volatile("s_waitcnt vmcnt(0)" ::: "memory"); SWRITE(0, SE); __syncthreads();
  qkt<NQF, NQR, PITCH>(pA0, pA1, K_lds, chunk0, qr, ql, r32, hi); partialSM(pA0, pA1, m_reg, mnA, alA, C, THRS);
  SLOAD(SO, 1); if constexpr (SDEPTH == 2) { if (2 < NT) SLOAD(SE, 2); }
  SWAIT(); SWRITE(1, SO); __syncthreads();
  for (int j = 1; j + 1 < NT; j += 2) {
    SBAR(); qkt<NQF, NQR, PITCH>(pB0, pB1, K_lds + SHM_K, chunk0, qr, ql, r32, hi);
    finishSM(pA0, pA1, alA, l_reg, pa0, pa1, pa2, pa3); SBAR();
    SLOAD(SO, j + SDEPTH); SBAR();
    pv_d0(o, vb0, pa0, pa1, pa2, pa3); partialSM(pB0, pB1, m_reg, mnB, alB, C, THRS);
    __syncthreads(); SWAIT(); SWRITE(0, SE);
    RESC(alB); __syncthreads();
    SBAR(); qkt<NQF, NQR, PITCH>(pA0, pA1, K_lds, chunk0, qr, ql, r32, hi);
    finishSM(pB0, pB1, alB, l_reg, pa0, pa1, pa2, pa3); SBAR();
    if (SDEPTH == 1 || j + 3 < NT) SLOAD(SE, j + 1 + SDEPTH); SBAR();
    pv_d0(o, vb0 + SHM_V, pa0, pa1, pa2, pa3); partialSM(pA0, pA1, m_reg, mnA, alA, C, THRS);
    __syncthreads(); SWAIT(); SWRITE(1, SO);
    RESC(alA); __syncthreads();
  }
  SBAR(); qkt<NQF, NQR, PITCH>(pB0, pB1, K_lds + SHM_K, chunk0, qr, ql, r32, hi);
  finishSM(pA0, pA1, alA, l_reg, pa0, pa1, pa2, pa3); SBAR();
  pv_d0(o, vb0, pa0, pa1, pa2, pa3); partialSM(pB0, pB1, m_reg, mnB, alB, C, THRS);
  __syncthreads(); RESC(alB);
  finishSM(pB0, pB1, alB, l_reg, pa0, pa1, pa2, pa3); SBAR();
  pv_d0(o, vb0 + SHM_V, pa0, pa1, pa2, pa3);
  if (hi == 0) li_l[r32] = l_reg; asm volatile("s_waitcnt lgkmcnt(0)" ::: "memory");
  float rli[16];
#pragma unroll
  for (int r = 0; r < 16; ++r) rli[r] = __builtin_amdgcn_rcpf(li_l[crow(r, hi)]);
  bf16* Ow = Ob + (size_t)(wq * 32) * DM;
  if constexpr (MODE == 0) {
#pragma unroll
    for (int r = 0; r < 16; ++r) { const int orow = crow(r, hi);
#pragma unroll
      for (int d0 = 0; d0 < 4; ++d0) Ow[(size_t)orow * DM + d0 * 32 + r32] = tobf1(o[d0][r] * rli[r]); }
    __syncthreads();
  } else {
    LAS float* ex = (LAS float*)lds;
    __syncthreads();
    if (sgrp == 1) {
#pragma unroll
      for (int r = 0; r < 16; ++r)
#pragma unroll
        for (int d0 = 0; d0 < 4; ++d0) ex[(wq * 32 + crow(r, hi)) * 128 + d0 * 32 + r32] = o[d0][r] * rli[r];
    }
    __syncthreads();
    if (sgrp == 0) {
#pragma unroll
      for (int r = 0; r < 16; ++r) { const int orow = crow(r, hi); float dd[4]; float ss = 0.f;
#pragma unroll
        for (int d0 = 0; d0 < 4; ++d0) { dd[d0] = o[d0][r] * rli[r] - lam * ex[(wq * 32 + orow) * 128 + d0 * 32 + r32]; ss += dd[d0] * dd[d0]; }
        ss = half_sum32(ss);
        const float rs = oscale / sqrtf(ss * (1.0f / 128.0f) + LN_EPS);
#pragma unroll
        for (int d0 = 0; d0 < 4; ++d0) Ow[(size_t)orow * DM + d0 * 32 + r32] = tobf1(dd[d0] * rs * subln[d0 * 32 + r32]); }
    }
    __syncthreads();
  }
#undef KROW
#undef SLOAD
#undef SWRITE
#undef SWAIT
#undef RESC
}
}

__device__ __forceinline__ void mla_attn_phase(CP P, LAS unsigned char* lds) {
    const bf16* QM = (const bf16*)(P->ws + WS_QM); const bf16* KV = (const bf16*)(P->ws + WS_KV); const bf16* KR = (const bf16*)(P->ws + WS_KR); bf16* Gb = (bf16*)(P->ws + WS_G);
    const int c = blockIdx.x, G = gridDim.x;
    for (int u = c; u < 1024 + 32; u += G) {
        int b, h, qrow0, NT;
        if (u < 1024) { const int i = u >> 8, cc = u & 255; const int bh = (cc & 7) + 8 * i, qb = cc >> 3; b = bh >> 4; h = bh & 15; qrow0 = b * SEQ + qb * 256; NT = 4 + 128; }
        else { const int bh = u - 1024; b = bh >> 4; h = bh & 15; qrow0 = ML + b * CTXL; NT = 4; }
        att::attn_unit<0>(QM + (size_t)qrow0 * 3072 + h * 192, 3072, KV + h * 256, KV + h * 256 + 128, 4096, KR, b, 4, NT, Gb + (size_t)qrow0 * DM + h * 128, 0.f, nullptr, 1.f, lds);
    }
}
__device__ __forceinline__ void da_attn_phase(CP P, float lam, float oscale, LAS unsigned char* lds) {
    const bf16* Z = (const bf16*)(P->ws + WS_Z); bf16* Gb = (bf16*)(P->ws + WS_G); const float* subln = P->in[27];
    const int c = blockIdx.x, G = gridDim.x;
    for (int u = c; u < 2048 + 64; u += G) {
        int b, h, qrow0, NT;
        if (u < 2048) { const int i = u >> 8, cc = u & 255; const int bh = (cc & 7) + 8 * (i >> 1), qb = (cc >> 3) + 32 * (i & 1); b = bh >> 4; h = bh & 15; qrow0 = b * SEQ + qb * 128; NT = 4 + 128; }
        else { const int v = u - 2048; const int bh = v >> 1; b = bh >> 4; h = bh & 15; qrow0 = ML + b * CTXL + (v & 1) * 128; NT = 4; }
        att::attn_unit<1>(Z + (size_t)qrow0 * 6144 + h * 128, 6144, Z + 2048 + h * 128, Z + 4096 + h * 128, 6144, nullptr, b, 4, NT, Gb + (size_t)qrow0 * DM + h * 128, lam, subln, oscale, lds);
    }
}

__device__ __forceinline__ unsigned f2ord(float f) { const unsigned u = __float_as_uint(f); return u ^ ((unsigned)((int)u >> 31) | 0x80000000u); }
__device__ __forceinline__ float ord2f(unsigned k) { return __uint_as_float((k & 0x80000000u) ? (k ^ 0x80000000u) : ~k); }
__device__ __forceinline__ void ce_desc(unsigned& a, unsigned& b) { const unsigned mx = a > b ? a : b, mn = a > b ? b : a; a = mx; b = mn; }
template <int N, bool DESC> __device__ __forceinline__ void bitonic_merge(unsigned* a) {
#pragma unroll
    for (int j = N / 2; j > 0; j >>= 1)
#pragma unroll
        for (int i = 0; i < N; ++i) { const int l = i ^ j; if (l > i) { if (DESC) ce_desc(a[i], a[l]); else ce_desc(a[l], a[i]); } }
}
template <int N, bool DESC> __device__ __forceinline__ void bitonic_sort(unsigned* a) {
#pragma unroll
    for (int k = 2; k <= N; k <<= 1)
#pragma unroll
        for (int j = k >> 1; j > 0; j >>= 1)
#pragma unroll
            for (int i = 0; i < N; ++i) { const int l = i ^ j; if (l > i) { const bool up = ((i & k) == 0); if (up == DESC) ce_desc(a[i], a[l]); else ce_desc(a[l], a[i]); } }
}
__device__ __forceinline__ void top16_of_64(unsigned (&a)[64]) {
    bitonic_sort<16, true>(a); bitonic_sort<16, false>(a + 16); bitonic_sort<16, true>(a + 32); bitonic_sort<16, false>(a + 48);
#pragma unroll
    for (int i = 0; i < 16; ++i) a[i] = a[i] > a[16 + i] ? a[i] : a[16 + i];
    bitonic_merge<16, true>(a);
#pragma unroll
    for (int i = 0; i < 16; ++i) a[32 + i] = a[32 + i] > a[48 + i] ? a[32 + i] : a[48 + i];
    bitonic_merge<16, false>(a + 32);
#pragma unroll
    for (int i = 0; i < 16; ++i) a[i] = a[i] > a[32 + i] ? a[i] : a[32 + i];
    bitonic_merge<16, true>(a);
}
template <int PASS> __device__ __forceinline__ void route_pass(const bf16* QP, const LAS char* lds, int tok, int head, int r32, int hi, unsigned (&top)[16]) {
    f32x16 acc[4] = {};
    const bf16* qp = QP + (size_t)tok * DM + head * 256 + PASS * 128 + hi * 8;
    bf16x8 qf[8];
#pragma unroll
    for (int ks = 0; ks < 8; ++ks) qf[ks] = *(const bf16x8*)(qp + ks * 16);
    const LAS char* Kl = lds + PASS * 32768;
#pragma unroll
    for (int kb = 0; kb < 4; ++kb)
#pragma unroll
        for (int ks = 0; ks < 8; ++ks) { const bf16x8 a = *(const LAS bf16x8*)(Kl + (kb * 32 + r32) * 256 + (((ks * 2 + hi) ^ (r32 & 15)) * 16));
            acc[kb] = __builtin_amdgcn_mfma_f32_32x32x16_bf16(a, qf[ks], acc[kb], 0, 0, 0); }
    unsigned key[64]; const unsigned base = 127u - 4u * (unsigned)hi;
#pragma unroll
    for (int kb = 0; kb < 4; ++kb)
#pragma unroll
        for (int r = 0; r < 16; ++r) key[kb * 16 + r] = (f2ord(acc[kb][r]) & ~127u) | (base - (unsigned)(kb * 32 + (r & 3) + 8 * (r >> 2)));
    top16_of_64(key);
    unsigned pr[16];
#pragma unroll
    for (int i = 0; i < 16; ++i) pr[i] = lane_xor32(key[15 - i], hi << 5);
#pragma unroll
    for (int i = 0; i < 16; ++i) key[i] = key[i] > pr[i] ? key[i] : pr[i];
    bitonic_merge<16, true>(key);
#pragma unroll
    for (int i = 0; i < 16; ++i) top[i] = key[i];
}
__device__ __forceinline__ void route_phase(CP P, int L, int Mrows, LAS unsigned char* lds_, int tid, int lane, int wid, int gw, int NGW) {
    const bf16* QP = (const bf16*)(P->ws + WS_QP); unsigned* ROUTE = (unsigned*)(P->ws + WS_ROUTE);
    LAS char* lds = (LAS char*)(LAS unsigned char*)lds_;
    __syncthreads();
    {
        const bf16* K1 = (const bf16*)(P->ws + WS_PK1) + (size_t)L * 128 * 128; const bf16* K2 = (const bf16*)(P->ws + WS_PK2) + (size_t)L * 128 * 128;
        for (int c16 = tid; c16 < 2 * 128 * 16; c16 += NWAVES * 64) { const int mat = c16 >> 11, row = (c16 >> 4) & 127, ch = c16 & 15;
            const u32x4 w = *(const u32x4*)((mat ? K2 : K1) + row * 128 + ch * 8);
            *(LAS u32x4*)(lds + mat * 32768 + row * 256 + ((ch ^ (row & 15)) * 16)) = w; }
    }
    __syncthreads();
    LAS unsigned* sc = (LAS unsigned*)(lds + 65536) + wid * 2048;
    const int r32 = lane & 31, hi = lane >> 5;
    for (int item = gw; item < Mrows / 4; item += NGW) {
        const int tok = item * 4 + (r32 >> 3), head = r32 & 7;
        unsigned top0[16], top1[16];
        route_pass<0>(QP, lds, tok, head, r32, hi, top0);
        route_pass<1>(QP, lds, tok, head, r32, hi, top1);
        float v1[16], v2[16];
#pragma unroll
        for (int i = 0; i < 16; ++i) { v1[i] = ord2f(top0[i] & ~127u); v2[i] = ord2f(top1[i] & ~127u);
            sc[i * 64 + lane] = 127u - (top0[i] & 127u); sc[(16 + i) * 64 + lane] = 127u - (top1[i] & 127u); }
        unsigned ck[64]; int n = 0;
#pragma unroll
        for (int i = 0; i < 16; ++i)
#pragma unroll
            for (int j = 0; j < 16; ++j) if ((i + 1) * (j + 1) <= 16) { ck[n] = (f2ord(v1[i] + v2[j]) & ~255u) | (unsigned)(i * 16 + j); ++n; }
#pragma unroll
        for (int i = 50; i < 64; ++i) ck[i] = 0u;
        top16_of_64(ck);
        float ev[16]; float sum = 0.f; const float mx = ord2f(ck[0] & ~255u);
#pragma unroll
        for (int k = 0; k < 16; ++k) { ev[k] = __expf(ord2f(ck[k] & ~255u) - mx); sum += ev[k]; }
        const float inv = 1.0f / sum;
        unsigned ee[16];
#pragma unroll
        for (int k = 0; k < 16; ++k) { const unsigned pc = ck[k] & 255u; const unsigned i1 = sc[(pc >> 4) * 64 + lane], i2 = sc[(16 + (pc & 15u)) * 64 + lane]; ee[k] = i1 * 128u + i2; ev[k] *= inv; }
        u32x4* outp = (u32x4*)(ROUTE + ((size_t)tok * 128 + head * 16 + hi * 8) * 2);
#pragma unroll
        for (int k = 0; k < 8; k += 2) { u32x4 w;
            const unsigned eL0 = ee[k], eH0 = ee[k + 8], eL1 = ee[k + 1], eH1 = ee[k + 9]; const float gL0 = ev[k], gH0 = ev[k + 8], gL1 = ev[k + 1], gH1 = ev[k + 9];
            w.x = hi ? eH0 : eL0; w.y = __float_as_uint(hi ? gH0 : gL0); w.z = hi ? eH1 : eL1; w.w = __float_as_uint(hi ? gH1 : gL1);
            outp[k >> 1] = w; }
    }
}

typedef float f32x2 __attribute__((ext_vector_type(2)));
typedef __bf16 bf16x2_t __attribute__((ext_vector_type(2)));
struct GBuf { u32x4 u[2][2], v[2][2]; };
__device__ __forceinline__ void gather_phase(CP P, int L, int Mrows, int lane, int gw, int NGW) {
    const unsigned char* U = P->ws + WS_PU + (size_t)L * 16384 * 2048; const unsigned char* V = P->ws + WS_PV + (size_t)L * 16384 * 2048;
    const unsigned* ROUTE = (const unsigned*)(P->ws + WS_ROUTE); const float* MOD = (const float*)(P->ws + WS_MOD);
    bf16* X = (bf16*)(P->ws + WS_X); bf16* H = (bf16*)(P->ws + WS_H);
    const float* lng = P->in[6] + (size_t)(L * 2 + 1) * DM; const float* lnb = P->in[7] + (size_t)(L * 2 + 1) * DM;
    for (int row = gw; row < Mrows; row += NGW) {
        const u32x2 ea = ((const u32x2*)(ROUTE + (size_t)row * 256))[lane], eb = ((const u32x2*)(ROUTE + (size_t)row * 256))[64 + lane];
        u32x4 hw[4];
#pragma unroll
        for (int j = 0; j < 4; ++j) hw[j] = ((const u32x4*)(H + (size_t)row * DM))[128 * (j >> 1) + 2 * lane + (j & 1)];
        float y[32];
#pragma unroll
        for (int i = 0; i < 32; ++i) y[i] = 0.f;
        GBuf A, B, C;
#define GLOAD(buf, g) do { const int kb_ = ((g) & 31) * 2; const unsigned evv_ = (g) < 32 ? ea.x : eb.x; \
        _Pragma("unroll") for (int t = 0; t < 2; ++t) { const unsigned e_ = (unsigned)__builtin_amdgcn_readlane((int)evv_, kb_ + t); \
            const u32x4* up_ = (const u32x4*)(U + (size_t)e_ * 2048) + lane; const u32x4* vp_ = (const u32x4*)(V + (size_t)e_ * 2048) + lane; \
            buf.u[t][0] = up_[0]; buf.u[t][1] = up_[64]; buf.v[t][0] = vp_[0]; buf.v[t][1] = vp_[64]; } } while (0)
#define GCOMP(buf, g) do { const int kb_ = ((g) & 31) * 2; const unsigned gvv_ = (g) < 32 ? ea.y : eb.y; \
        _Pragma("unroll") for (int t = 0; t < 2; ++t) { float acc_ = 0.f; \
            _Pragma("unroll") for (int j = 0; j < 2; ++j) _Pragma("unroll") for (int c = 0; c < 4; ++c) { const int wd_ = (int)buf.u[t][j][c]; \
                const bf16x2_t lo_ = __builtin_convertvector(__builtin_amdgcn_cvt_pk_f32_fp8(wd_, false), bf16x2_t), hi_ = __builtin_convertvector(__builtin_amdgcn_cvt_pk_f32_fp8(wd_, true), bf16x2_t); \
                const unsigned h0_ = hw[2 * j + (c >> 1)][2 * (c & 1)], h1_ = hw[2 * j + (c >> 1)][2 * (c & 1) + 1]; acc_ = __builtin_amdgcn_fdot2_f32_bf16(__builtin_bit_cast(bf16x2_t, h0_), lo_, acc_, false); \
                acc_ = __builtin_amdgcn_fdot2_f32_bf16(__builtin_bit_cast(bf16x2_t, h1_), hi_, acc_, false); } \
            const float d_ = wave_sum(acc_) * (1.0f / U_SCALE); \
            const float w_ = __uint_as_float((unsigned)__builtin_amdgcn_readlane((int)gvv_, kb_ + t)) * gelu_tanh(d_) * (1.0f / V_SCALE); \
            __builtin_amdgcn_sched_barrier(0); \
            _Pragma("unroll") for (int j = 0; j < 2; ++j) _Pragma("unroll") for (int c = 0; c < 4; ++c) { const int wd_ = (int)buf.v[t][j][c]; \
                const f32x2 lo_ = __builtin_amdgcn_cvt_pk_f32_fp8(wd_, false), hi_ = __builtin_amdgcn_cvt_pk_f32_fp8(wd_, true); \
                y[16 * j + 4 * c + 0] += w_ * lo_.x; y[16 * j + 4 * c + 1] += w_ * lo_.y; y[16 * j + 4 * c + 2] += w_ * hi_.x; y[16 * j + 4 * c + 3] += w_ * hi_.y; } \
            __builtin_amdgcn_sched_barrier(0); } } while (0)
        GLOAD(A, 0); GLOAD(B, 1);
#pragma unroll 1
        for (int g = 0; g < 63; g += 3) {
            GLOAD(C, g + 2); GCOMP(A, g);
            GLOAD(A, g + 3); GCOMP(B, g + 1);
            if (g + 4 < 64) GLOAD(B, g + 4);
            GCOMP(C, g + 2);
        }
        GCOMP(A, 63);
#undef GLOAD
#undef GCOMP
        const int slot = row_slot(row);
        const float* mod = MOD + (size_t)(L * 3 + slot) * 12288;
        const int le = launder_v(lane);
        { float xx[32], gg[32]; load_row_bf16_b(X + (size_t)row * DM, le, xx); load_row_f32_b(mod + 5 * 2048, le, gg);
#pragma unroll
          for (int i = 0; i < 32; ++i) y[i] = ALPHA * xx[i] + gg[i] * y[i]; }
        if (L < NLAYER - 1) { const float* modn = MOD + (size_t)((L + 1) * 3 + slot) * 12288;
            finish_row<true>(y, lng, lnb, X + (size_t)row * DM, modn, modn + 2048, H + (size_t)row * DM, nullptr, le); }
        else finish_row<true>(y, lng, lnb, nullptr, nullptr, nullptr, nullptr, P->out + (size_t)row * DM, le);
    }
}

#define NOINL __forceinline__
__device__ __forceinline__ CP launder_cp(CP p) { asm volatile("" : "+s"(p)); return p; }
#define GETP() launder_cp((CP)__builtin_amdgcn_kernarg_segment_ptr())
__device__ __forceinline__ int uni(int v) { return __builtin_amdgcn_readfirstlane(v); }
__device__ __forceinline__ LAS unsigned char* uni_lds(LAS unsigned char* p) { return (LAS unsigned char*)(unsigned)__builtin_amdgcn_readfirstlane((int)(unsigned)(uintptr_t)p); }
#define PH_IDS const int tid = launder_v(threadIdx.x), lane = tid & 63, wid = __builtin_amdgcn_readfirstlane(tid >> 6); const int gw = blockIdx.x * NWAVES + wid, NGW = gridDim.x * NWAVES; (void)lane; (void)gw; (void)NGW;

__device__ NOINL void ph_prologue(LAS unsigned char* lds_) { CP P = GETP(); LAS unsigned char* lds = uni_lds(lds_); PH_IDS p0_prologue(P, lds, tid, lane, wid, gw, NGW); }
__device__ NOINL void ph_first() { CP P = GETP(); PH_IDS first_row_pass(P, lane, gw, NGW); }
__device__ NOINL void ph_postmix(int L_, int M_) { CP P = GETP(); const int L = uni(L_), Mrows = uni(M_); PH_IDS post_mixer_pass(P, L, Mrows, lane, gw, NGW); }
__device__ NOINL void ph_vstats(int M_) { CP P = GETP(); const int Mrows = uni(M_); PH_IDS vstats_pass(P, Mrows, lane, gw, NGW); }
__device__ NOINL void ph_spatial(LAS unsigned char* lds_, int j_, int M_) { CP P = GETP(); LAS unsigned char* lds = uni_lds(lds_); const int j = uni(j_), Mrows = uni(M_); PH_IDS spatial_phase(P, j, Mrows, lds, tid, lane, wid); }
__device__ NOINL void ph_mla_norm() { CP P = GETP(); PH_IDS mla_norm_pass(P, lane, gw, NGW); }
__device__ NOINL void ph_rope(int which_) { CP P = GETP(); const int which = uni(which_); PH_IDS
    if (which == 0) rope_pass((bf16*)(P->ws + WS_QM), 3072, 128, 16, 192, lane, gw, NGW);
    else rope_pass((bf16*)(P->ws + WS_Z), 6144, 0, 64, 64, lane, gw, NGW); }
__device__ NOINL void ph_attn_mla(LAS unsigned char* lds_) { CP P = GETP(); LAS unsigned char* lds = uni_lds(lds_); mla_attn_phase(P, lds); }
__device__ NOINL void ph_attn_da(LAS unsigned char* lds_, int L_) { CP P = GETP(); LAS unsigned char* lds = uni_lds(lds_); const int L = uni(L_); const int lane = launder_v(threadIdx.x) & 63;
    const float* lp = P->in[26];
    const float s01 = wave_sum(lp[lane] * lp[64 + lane]), s23 = wave_sum(lp[128 + lane] * lp[192 + lane]);
    const float lam_init = 0.8f - 0.6f * expf(-0.3f * (float)L);
    const float lam = expf(s01) - expf(s23) + lam_init;
    da_attn_phase(P, lam, 1.0f - lam_init, lds); }
__device__ NOINL void ph_route(LAS unsigned char* lds_, int L_, int M_) { CP P = GETP(); LAS unsigned char* lds = uni_lds(lds_); const int L = uni(L_), Mrows = uni(M_); PH_IDS route_phase(P, L, Mrows, lds, tid, lane, wid, gw, NGW); }
__device__ NOINL void ph_gather(int L_, int M_) { CP P = GETP(); const int L = uni(L_), Mrows = uni(M_); PH_IDS gather_phase(P, L, Mrows, lane, gw, NGW); }

enum GemmId { G_GM_IN = 0, G_GM_OUT, G_MLA_IN, G_MLA_UQ, G_MLA_UKV, G_MLA_OUT, G_DA_IN, G_DA_OUT, G_PEER_Q };
__device__ NOINL void ph_gemm(LAS unsigned char* lds_, int id_, int L_, int M_) {
    CP P = GETP(); LAS unsigned char* lds = uni_lds(lds_); const int id = uni(id_), L = uni(L_), Mrows = uni(M_);
    unsigned char* ws = P->ws; const int jj = L / 3;
    size_t a = WS_H, b = 0, o = 0; int M = MT, N = 2048, K = 2048, act = 0;
    switch (id) {
        case G_GM_IN:   a = WS_H;    b = WS_GMWIN + (size_t)jj * 4096 * 2048 * 2;  o = WS_Z;  M = Mrows; N = 4096; K = 2048; act = 1; break;
        case G_GM_OUT:  a = WS_G;    b = WS_GMWOUT + (size_t)jj * 2048 * 2048 * 2; o = WS_Y;  M = Mrows; N = 2048; K = 2048; break;
        case G_MLA_IN:  a = WS_H;    b = WS_MLAIN;  o = WS_C;  N = 1280; K = 2048; break;
        case G_MLA_UQ:  a = WS_CQN;  b = WS_MLAUQ;  o = WS_QM; N = 3072; K = 512;  break;
        case G_MLA_UKV: a = WS_CKVN; b = WS_MLAUKV; o = WS_KV; N = 4096; K = 512;  break;
        case G_MLA_OUT: a = WS_G;    b = WS_MLAOUT; o = WS_Y;  N = 2048; K = 2048; break;
        case G_DA_IN:   a = WS_H;    b = WS_DAIN;   o = WS_Z;  N = 6144; K = 2048; break;
        case G_DA_OUT:  a = WS_G;    b = WS_DAOUT;  o = WS_Y;  N = 2048; K = 2048; break;
        default:        a = WS_H;    b = WS_PWQ + (size_t)L * 2048 * 2048 * 2;     o = WS_QP; M = Mrows; N = 2048; K = 2048; break;
    }
    pg8::Gemm g{(const pg8::bf16_t*)(ws + a), (const pg8::bf16_t*)(ws + b), M, N, K}; pg8::StaticOrder S; S.init(M, N, (int)gridDim.x, (int)blockIdx.x);
    pg8::EpiR E{(pg8::bf16_t*)(ws + o), N, act};
    pg8::gemm_phase<pg8::EpiR, pg8::StaticOrder, true, true>((PG8_LAS unsigned char*)lds, g, S, E);
}

__global__ void __launch_bounds__(NWAVES * 64, 2) mk_fwd(Params Pv) {
    extern __shared__ __attribute__((aligned(16))) unsigned char lds_g[];
    LAS unsigned char* lds = (LAS unsigned char*)lds_g;
    const int tid = threadIdx.x;
    for (int u = tid; u < (LDS_BYTES - RING_BYTES) / 4; u += NWAVES * 64) ((LAS unsigned*)(lds + RING_BYTES))[u] = 0u;
    __syncthreads();
    const int lo = Pv.ph_lo, hi = Pv.ph_hi;
    unsigned* barw = (unsigned*)(Pv.ws + WS_CTL) + CW_BAR;
    XcdBarrier bar; bar.bar = barw; bar.x = 0; bar.st = nullptr;
    if (hi - lo > 1) bar = xcd_barrier_post(barw, (volatile LAS unsigned*)(lds + MISC_OFF) + 8);
    int ph = 0;
#ifndef SEL
#define SELP(k) true
#else
#define SELP(k) ((k) == SEL)
#endif
    enum { RUN_BASE = __COUNTER__ + 1 };
#define RUN(call) do { if (SELP(__COUNTER__ - RUN_BASE) && ph >= lo && ph < hi) { call; } if (ph >= lo && ph + 1 < hi) xcd_barrier(bar); ++ph; } while (0)
    RUN(ph_prologue(lds));
    RUN(ph_first());
    for (int L = 0; L < NLAYER; ++L) {
        const int kind = L % 3, jj = L / 3;
        const int Mrows = (L == NLAYER - 1) ? ML : MT;
        if (kind == 0) {
            RUN(ph_gemm(lds, G_GM_IN, L, Mrows));
            RUN(ph_vstats(Mrows));
            RUN(ph_spatial(lds, jj, Mrows));
            RUN(ph_gemm(lds, G_GM_OUT, L, Mrows));
        } else if (kind == 1) {
            RUN(ph_gemm(lds, G_MLA_IN, L, Mrows));
            RUN(ph_mla_norm());
            RUN(ph_gemm(lds, G_MLA_UQ, L, Mrows); ph_gemm(lds, G_MLA_UKV, L, Mrows));
            RUN(ph_rope(0));
            RUN(ph_attn_mla(lds));
            RUN(ph_gemm(lds, G_MLA_OUT, L, Mrows));
        } else {
            RUN(ph_gemm(lds, G_DA_IN, L, Mrows));
            RUN(ph_rope(1));
            RUN(ph_attn_da(lds, L));
            RUN(ph_gemm(lds, G_DA_OUT, L, Mrows));
        }
        RUN(ph_postmix(L, Mrows));
        RUN(ph_gemm(lds, G_PEER_Q, L, Mrows));
        RUN(ph_route(lds, L, Mrows));
        RUN(ph_gather(L, Mrows));
    }
#undef RUN
}

extern "C" void kernel_launch(void* const* d_in, const int* in_sizes, int n_in, void* d_out, int out_size, void* d_ws, size_t ws_size, hipStream_t stream) {
    static int grid = 0;
    if (grid == 0) {
        if (n_in != 29 || in_sizes[0] != ML * DM || out_size != ML * DM || ws_size < WS_END) {
            fprintf(stderr, "kernel_launch: shape mismatch: n_in %d in0 %d out %d ws %zu (need %zu); nothing launched\n", n_in, n_in > 0 ? in_sizes[0] : -1, out_size, ws_size, (size_t)WS_END); grid = -1; return; }
        int dev = 0, cus = 0, per_cu = 0;
        if (hipGetDevice(&dev) != hipSuccess || hipDeviceGetAttribute(&cus, hipDeviceAttributeMultiprocessorCount, dev) != hipSuccess) { fprintf(stderr, "kernel_launch: device query failed\n"); grid = -1; return; }
        if (hipFuncSetAttribute((const void*)mk_fwd, hipFuncAttributeMaxDynamicSharedMemorySize, LDS_BYTES) != hipSuccess) { fprintf(stderr, "kernel_launch: hipFuncSetAttribute failed\n"); grid = -1; return; }
        if (hipOccupancyMaxActiveBlocksPerMultiprocessor(&per_cu, (const void*)mk_fwd, NWAVES * 64, LDS_BYTES) != hipSuccess || per_cu < 1)
            fprintf(stderr, "kernel_launch: note: occupancy query reports %d workgroups per CU\n", per_cu);
        (void)hipGetLastError();
        grid = cus;
    }
    if (grid < 0) return;
    if (hipMemsetAsync((char*)d_ws + WS_CTL, 0, CTL_ZERO_BYTES, stream) != hipSuccess) { fprintf(stderr, "kernel_launch: memset failed\n"); return; }
    Params p{};
    for (int i = 0; i < 29; ++i) p.in[i] = (const float*)d_in[i];
    p.out = (float*)d_out; p.ws = (unsigned char*)d_ws;
#if MK_ONE_LAUNCH
    p.ph_lo = 0; p.ph_hi = NPH;
    hipLaunchKernelGGL(mk_fwd, dim3(grid), dim3(NWAVES * 64), LDS_BYTES, stream, p);
#else
    for (int li = 0; li < NPH; ++li) { p.ph_lo = li; p.ph_hi = li + 1; hipLaunchKernelGGL(mk_fwd, dim3(grid), dim3(NWAVES * 64), LDS_BYTES, stream, p); }
#endif
    const hipError_t le = hipPeekAtLastError();
    if (le != hipSuccess) fprintf(stderr, "kernel_launch: launch failed: %s\n", hipGetErrorName(le));
}
```

```cpp
#include <hip/hip_runtime.h>
#include <cstdio>
#include <cstdint>
#ifndef MK_ONE_LAUNCH
#define MK_ONE_LAUNCH 1
#endif
__device__ __forceinline__ int launder_v(int v) { asm volatile("" : "+v"(v)); return v; }
namespace pg8 {
#define PG8_LAS __attribute__((address_space(3)))
typedef unsigned short bf16_t;
typedef short bf16x8 __attribute__((ext_vector_type(8)));
typedef float f32x4 __attribute__((ext_vector_type(4)));
typedef unsigned u32x4 __attribute__((ext_vector_type(4)));
constexpr int BM = 256, BK = 64, HALF = 128, HTB = HALF * BK * 2  , STAGE_BYTES = 8 * HTB, NXCD = 8, WGM = 8;

__host__ __device__ __forceinline__ int lds_byte(int r, int c) { const int st = (r >> 4) * 2 + (c >> 5), rr = r & 15, cc = c & 31, ob = rr * 64 + cc * 2; return st * 1024 + (ob ^ (((ob >> 9) & 1) << 5)); }
__host__ __device__ __forceinline__ void stage_rc(int b, int& R, int& C) { const int st = b / 1024, sb = b % 1024, swz = sb ^ (((sb >> 9) & 1) << 5); R = (st >> 1) * 16 + swz / 64; C = (st & 1) * 32 + (swz % 64) / 2; }
__host__ __device__ __forceinline__ int perm32(int rho) { const int n = rho >> 4, i = rho & 15; return 8 * (i >> 2) + 4 * n + (i & 3); }

struct Unit { int pm, pn; };
struct Gemm { const bf16_t* A; const bf16_t* Bt; int M, N, K; };

struct StaticOrder {
    int nM, nN, nwg, G, c;
    __host__ __device__ void init(int M, int N, int G_, int c_) { nM = M / BM; nN = N / BM; nwg = nM * nN; G = G_; c = c_; }
    __host__ __device__ bool next(int i, Unit& u) const {
        const long L = (long)i * G + c; if (L >= nwg) return false;
        int wgid = (int)L; { const int q = nwg / NXCD, r = nwg % NXCD, xcd = wgid % NXCD, off = wgid / NXCD; wgid = (xcd < r ? xcd * (q + 1) : r * (q + 1) + (xcd - r) * q) + off; }
        const int nig = WGM * nN, gid = wgid / nig, fm = gid * WGM, gsz = (nM - fm) < WGM ? (nM - fm) : WGM;
        u.pm = fm + ((wgid % nig) % gsz); u.pn = (wgid % nig) / gsz; return true;
    }
    __device__ __forceinline__ void a_ready(const Unit&) const {}
    __device__ __forceinline__ void done(const Unit&) const {}
};

__device__ __forceinline__ unsigned cvt_pk_bf16(float lo, float hi) { unsigned r; asm volatile("v_cvt_pk_bf16_f32 %0, %1, %2" : "=v"(r) : "v"(lo), "v"(hi)); return r; }
typedef float f32x2 __attribute__((ext_vector_type(2)));
__device__ __forceinline__ f32x2 gelu_pk(f32x2 v) {
    const f32x2 av = __builtin_elementwise_abs(v), d = av * 0.2316418882f + 1.0f;
    f32x2 t; t.x = __builtin_amdgcn_rcpf(d.x); t.y = __builtin_amdgcn_rcpf(d.y);
    f32x2 q = t * 0.5307027145f + (-0.7265760135f); q = q * t + 0.7107068705f; q = q * t + (-0.142248368f); q = q * t + 0.127414796f; q = q * t;
    const f32x2 s = (v * v) * (-0.72134752044f);
    f32x2 e; e.x = __builtin_amdgcn_exp2f(s.x); e.y = __builtin_amdgcn_exp2f(s.y);
    const f32x2 m = v * (q * e), r = v - m;
    f32x2 o; o.x = v.x < 0.f ? m.x : r.x; o.y = v.y < 0.f ? m.y : r.y; return o;
}

template <int ACT  > struct EpiBf16 {
    static constexpr bool PERM = true, AFTER_DRAIN = false; static_assert(ACT == 0 || ACT == 1, "EpiBf16: ACT is 0 (none) or 1 (gelu_pk)");
    bf16_t* O; int ldc; const float* bias; int split_cols; size_t split_stride; float scale0;
    __device__ __forceinline__ void operator()(const f32x4 (&acc)[2][2][4][2], const Unit& u, int wr, int wc, int fr, int fq) const {
        const int row0 = u.pm * BM + wr * 64 + fr; int colt = u.pn * BM; bf16_t* base = O;
        float sc = 1.f; if (split_cols) { const int t = colt / split_cols; base += (size_t)t * split_stride; colt -= t * split_cols; if (t == 0) sc = scale0; }
        const int col0 = colt + wc * 32 + 8 * fq, bcol0 = u.pn * BM + wc * 32 + 8 * fq;
        f32x4 bv[2][2];
#pragma unroll
        for (int bj = 0; bj < 2; ++bj)
#pragma unroll
            for (int n = 0; n < 2; ++n) bv[bj][n] = bias ? *(const f32x4*)(bias + bcol0 + bj * HALF + 4 * n) : (f32x4){0.f, 0.f, 0.f, 0.f};
#pragma unroll
        for (int ai = 0; ai < 2; ++ai)
#pragma unroll
            for (int m = 0; m < 4; ++m) { bf16_t* rowp = base + (size_t)(row0 + ai * HALF + m * 16) * ldc + col0;
#pragma unroll
                for (int bj = 0; bj < 2; ++bj) { f32x4 v0 = acc[ai][bj][m][0] + bv[bj][0], v1 = acc[ai][bj][m][1] + bv[bj][1];
                    if (ACT == 1) { f32x2 a = gelu_pk((f32x2){v0[0], v0[1]}), b = gelu_pk((f32x2){v0[2], v0[3]}), c = gelu_pk((f32x2){v1[0], v1[1]}), d = gelu_pk((f32x2){v1[2], v1[3]});
                        v0 = (f32x4){a.x, a.y, b.x, b.y}; v1 = (f32x4){c.x, c.y, d.x, d.y}; }
                    v0 = v0 * sc; v1 = v1 * sc; u32x4 w; w.x = cvt_pk_bf16(v0[0], v0[1]); w.y = cvt_pk_bf16(v0[2], v0[3]); w.z = cvt_pk_bf16(v1[0], v1[1]); w.w = cvt_pk_bf16(v1[2], v1[3]);
                    *(u32x4*)(rowp + bj * HALF) = w; } }
    }
};
template <class Epi, class Sched, bool ALIGN_EPI = false, bool SP2 = false>
__device__ __forceinline__ void gemm_phase(PG8_LAS unsigned char* lds, const Gemm g, const Sched& S, const Epi& E) {
    const int tid = launder_v(threadIdx.x), wid = __builtin_amdgcn_readfirstlane(tid >> 6), lane = tid & 63, wr = wid >> 2, wc = wid & 3, fr = lane & 15, fq = lane >> 4;
    const int K = g.K, nt = K / BK;
    unsigned voffA[2], voffB[2];
#pragma unroll
    for (int i = 0; i < 2; ++i) { int R, C; stage_rc(tid * 16 + i * 8192, R, C); const int Rb = Epi::PERM ? ((R & ~31) + perm32(R & 31)) : R;
        voffA[i] = (unsigned)(R * K + C) * 2u; voffB[i] = (unsigned)(Rb * K + C) * 2u; }
    const size_t kstep = (size_t)(BK * 2);
    const size_t hstep = (size_t)HALF * K * 2;
    const size_t tstep = 2 * hstep;
    const unsigned ldsw = (unsigned)wid * 1024u;
    const int aoff = lds_byte(wr * 64 + fr, fq * 8), boff = lds_byte(wc * 32 + fr, fq * 8);
#define PG8_SA(b, h) (((b) * 2 + (h)) * HTB)
#define PG8_SB(b, h) ((4 + (b) * 2 + (h)) * HTB)
#define PG8_STAGE(bufoff, gbase, voff) do { _Pragma("unroll") for (int _i = 0; _i < 2; ++_i) \
        __builtin_amdgcn_global_load_lds((const unsigned*)((const char*)(gbase) + (voff)[_i]), (PG8_LAS unsigned*)(lds + (bufoff) + ldsw + _i * 8192), 16, 0, 0); } while (0)
#define PG8_LDA(dst, b, h) do { _Pragma("unroll") for (int m = 0; m < 4; ++m) _Pragma("unroll") for (int k = 0; k < 2; ++k) dst[m][k] = *(const PG8_LAS bf16x8*)(lds + PG8_SA(b, h) + aoff + m * 2048 + k * 1024); } while (0)
#define PG8_LDB(dst, b, h) do { _Pragma("unroll") for (int n = 0; n < 2; ++n) _Pragma("unroll") for (int k = 0; k < 2; ++k) dst[n][k] = *(const PG8_LAS bf16x8*)(lds + PG8_SB(b, h) + boff + n * 2048 + k * 1024); } while (0)
#define PG8_MMA(ai, bj, At, Bt) do { __builtin_amdgcn_s_setprio(1); _Pragma("unroll") for (int m = 0; m < 4; ++m) _Pragma("unroll") for (int n = 0; n < 2; ++n) _Pragma("unroll") for (int k = 0; k < 2; ++k) \
        acc[ai][bj][m][n] = __builtin_amdgcn_mfma_f32_16x16x32_bf16(Bt[n][k], At[m][k], acc[ai][bj][m][n], 0, 0, 0); __builtin_amdgcn_s_setprio(0); } while (0)
#define PG8_WAIT_V(n) asm volatile("s_waitcnt vmcnt(" #n ")" ::: "memory")
#define PG8_WAIT_L(n) asm volatile("s_waitcnt lgkmcnt(" #n ")" ::: "memory")
#define PG8_BAR __builtin_amdgcn_s_barrier()
#define PG8_SCHED __builtin_amdgcn_sched_barrier(0)
    Unit cur, nxt; int ui = 0;
    if (!S.next(0, cur)) return;
    f32x4 acc[2][2][4][2];
#pragma unroll
    for (int a = 0; a < 2; ++a)
#pragma unroll
        for (int b = 0; b < 2; ++b)
#pragma unroll
            for (int m = 0; m < 4; ++m)
#pragma unroll
                for (int n = 0; n < 2; ++n) acc[a][b][m][n] = (f32x4){0.f, 0.f, 0.f, 0.f};
    bf16x8 At[4][2], B0[2][2], B1[2][2];
    const char* cA = (const char*)g.A + (size_t)cur.pm * tstep; const char* cB = (const char*)g.Bt + (size_t)cur.pn * tstep;
    S.a_ready(cur);
    if constexpr (SP2) {
        PG8_STAGE(PG8_SB(0, 0), cB, voffB); PG8_STAGE(PG8_SB(0, 1), cB + hstep, voffB); PG8_STAGE(PG8_SA(0, 0), cA, voffA); PG8_STAGE(PG8_SA(0, 1), cA + hstep, voffA);
        if (wr == 1) PG8_BAR;
        PG8_WAIT_V(2); PG8_BAR;
        PG8_STAGE(PG8_SB(1, 0), cB + kstep, voffB); PG8_STAGE(PG8_SA(1, 0), cA + kstep, voffA); PG8_STAGE(PG8_SB(1, 1), cB + hstep + kstep, voffB);
        PG8_WAIT_V(6); PG8_BAR;
    } else {
        PG8_STAGE(PG8_SB(0, 0), cB, voffB); PG8_STAGE(PG8_SA(0, 0), cA, voffA); PG8_STAGE(PG8_SB(0, 1), cB + hstep, voffB); PG8_STAGE(PG8_SA(0, 1), cA + hstep, voffA);
        if (wr == 1) PG8_BAR;
        PG8_WAIT_V(4); PG8_BAR;
        PG8_STAGE(PG8_SB(1, 0), cB + kstep, voffB); PG8_STAGE(PG8_SA(1, 0), cA + kstep, voffA); PG8_STAGE(PG8_SB(1, 1), cB + hstep + kstep, voffB);
        PG8_WAIT_V(6); PG8_BAR;
    }
    for (;;) {
        const bool has_next = S.next(ui + 1, nxt);
        const char* nA = has_next ? (const char*)g.A + (size_t)nxt.pm * tstep : cA; const char* nB = has_next ? (const char*)g.Bt + (size_t)nxt.pn * tstep : cB;
        for (int t = 0; t < nt; t += 2) {
            const bool last = (t == nt - 2);
            const char* a1 = cA + (size_t)(t + 1) * kstep;
            const char* a2 = last ? nA : cA + (size_t)(t + 2) * kstep; const char* b2 = last ? nB : cB + (size_t)(t + 2) * kstep;
            const char* a3 = a2 + kstep; const char* b3 = b2 + kstep;
            if (last && has_next) S.a_ready(nxt);
            if constexpr (SP2) {
            PG8_LDB(B0, 0, 0); PG8_LDB(B1, 0, 1); PG8_SCHED; PG8_LDA(At, 0, 0); PG8_STAGE(PG8_SA(1, 1), a1 + hstep, voffA);
            PG8_WAIT_V(8); PG8_WAIT_L(0); PG8_BAR; PG8_MMA(0, 0, At, B0); PG8_MMA(0, 1, At, B1); PG8_BAR; PG8_SCHED;
            PG8_LDA(At, 0, 1); PG8_STAGE(PG8_SB(0, 0), b2, voffB); PG8_STAGE(PG8_SB(0, 1), b2 + hstep, voffB); PG8_STAGE(PG8_SA(0, 0), a2, voffA);
            PG8_WAIT_V(8); PG8_WAIT_L(0); PG8_BAR; PG8_MMA(1, 0, At, B0); PG8_MMA(1, 1, At, B1); PG8_BAR; PG8_SCHED;
            PG8_LDB(B0, 1, 0); PG8_LDB(B1, 1, 1); PG8_SCHED; PG8_LDA(At, 1, 0); PG8_STAGE(PG8_SA(0, 1), a2 + hstep, voffA);
            PG8_WAIT_V(8); PG8_WAIT_L(0); PG8_BAR; PG8_MMA(0, 0, At, B0); PG8_MMA(0, 1, At, B1); PG8_BAR; PG8_SCHED;
            PG8_LDA(At, 1, 1); PG8_STAGE(PG8_SB(1, 0), b3, voffB); PG8_STAGE(PG8_SB(1, 1), b3 + hstep, voffB); PG8_STAGE(PG8_SA(1, 0), a3, voffA);
            PG8_WAIT_V(8); PG8_WAIT_L(0); PG8_BAR; PG8_MMA(1, 0, At, B0); PG8_MMA(1, 1, At, B1); PG8_BAR; PG8_SCHED;
            } else {
            PG8_LDB(B0, 0, 0); PG8_SCHED; PG8_LDA(At, 0, 0); PG8_STAGE(PG8_SA(1, 1), a1 + hstep, voffA);
            PG8_WAIT_L(8); PG8_BAR; PG8_WAIT_L(0); PG8_MMA(0, 0, At, B0); PG8_BAR; PG8_SCHED;
            PG8_LDB(B1, 0, 1); PG8_STAGE(PG8_SB(0, 0), b2, voffB);
            PG8_BAR; PG8_WAIT_L(0); PG8_MMA(0, 1, At, B1); PG8_BAR;
            PG8_LDA(At, 0, 1); PG8_STAGE(PG8_SA(0, 0), a2, voffA);
            PG8_BAR; PG8_WAIT_L(0); PG8_MMA(1, 0, At, B0); PG8_BAR; PG8_SCHED;
            PG8_STAGE(PG8_SB(0, 1), b2 + hstep, voffB);
            PG8_WAIT_V(6); PG8_BAR; PG8_MMA(1, 1, At, B1); PG8_BAR;
            PG8_LDB(B0, 1, 0); PG8_SCHED; PG8_LDA(At, 1, 0); PG8_STAGE(PG8_SA(0, 1), a2 + hstep, voffA);
            PG8_WAIT_L(8); PG8_BAR; PG8_WAIT_L(0); PG8_MMA(0, 0, At, B0); PG8_BAR; PG8_SCHED;
            PG8_LDB(B1, 1, 1); PG8_STAGE(PG8_SB(1, 0), b3, voffB);
            PG8_BAR; PG8_WAIT_L(0); PG8_MMA(0, 1, At, B1); PG8_BAR;
            PG8_LDA(At, 1, 1); PG8_STAGE(PG8_SA(1, 0), a3, voffA);
            PG8_BAR; PG8_WAIT_L(0); PG8_MMA(1, 0, At, B0); PG8_BAR; PG8_SCHED;
            PG8_STAGE(PG8_SB(1, 1), b3 + hstep, voffB);
            PG8_WAIT_V(6); PG8_BAR; PG8_MMA(1, 1, At, B1); PG8_BAR;
            }
        }
        if constexpr (ALIGN_EPI) { if (wr == 0) PG8_BAR; }
        if constexpr (!Epi::AFTER_DRAIN) { E(acc, cur, wr, wc, fr, fq); S.done(cur); }
        if (!has_next) break;
#pragma unroll
        for (int a = 0; a < 2; ++a)
#pragma unroll
            for (int b = 0; b < 2; ++b)
#pragma unroll
                for (int m = 0; m < 4; ++m)
#pragma unroll
                    for (int n = 0; n < 2; ++n) acc[a][b][m][n] = (f32x4){0.f, 0.f, 0.f, 0.f};
        cur = nxt; cA = nA; cB = nB; ++ui;
        if constexpr (ALIGN_EPI) { if (wr == 1) PG8_BAR; }
    }
    PG8_WAIT_V(0);
    if constexpr (!ALIGN_EPI) { if (wr == 0) PG8_BAR; }
    PG8_BAR;
    if constexpr (Epi::AFTER_DRAIN) { E.fused(acc, cur, wr, wc, fr, fq, lds, wid, lane); S.done(cur); }
#undef PG8_SA
#undef PG8_SB
#undef PG8_STAGE
#undef PG8_LDA
#undef PG8_LDB
#undef PG8_MMA
#undef PG8_WAIT_V
#undef PG8_WAIT_L
#undef PG8_BAR
#undef PG8_SCHED
}
}

namespace pg8 {
__device__ __forceinline__ float gelu_tanh(float x) {
    const float t = x * (1.5957691216057308f + 0.07135481627f * x * x);
    const float e = __builtin_amdgcn_exp2f(-1.4426950408889634f * t);
    return x * __builtin_amdgcn_rcpf(1.0f + e);
}
template <int ACT> struct EpiT {
    static constexpr bool PERM = true, AFTER_DRAIN = false;
    bf16_t* O; int ldc;
    __device__ __forceinline__ void operator()(const f32x4 (&acc)[2][2][4][2], const Unit& u, int wr, int wc, int fr, int fq) const {
        const int row0 = u.pm * BM + wr * 64 + fr; const int col0 = u.pn * BM + wc * 32 + 8 * fq;
#pragma unroll
        for (int ai = 0; ai < 2; ++ai)
#pragma unroll
            for (int m = 0; m < 4; ++m) { bf16_t* rowp = O + (size_t)(row0 + ai * HALF + m * 16) * ldc + col0;
#pragma unroll
                for (int bj = 0; bj < 2; ++bj) { f32x4 v0 = acc[ai][bj][m][0], v1 = acc[ai][bj][m][1];
                    if (ACT == 2) { v0 = (f32x4){gelu_tanh(v0[0]), gelu_tanh(v0[1]), gelu_tanh(v0[2]), gelu_tanh(v0[3])}; v1 = (f32x4){gelu_tanh(v1[0]), gelu_tanh(v1[1]), gelu_tanh(v1[2]), gelu_tanh(v1[3])}; }
                    u32x4 w; w.x = cvt_pk_bf16(v0[0], v0[1]); w.y = cvt_pk_bf16(v0[2], v0[3]); w.z = cvt_pk_bf16(v1[0], v1[1]); w.w = cvt_pk_bf16(v1[2], v1[3]);
                    *(u32x4*)(rowp + bj * HALF) = w; } }
    }
};
struct EpiR {
    static constexpr bool PERM = true, AFTER_DRAIN = false;
    bf16_t* O; int ldc; int act;
    __device__ __forceinline__ void operator()(const f32x4 (&acc)[2][2][4][2], const Unit& u, int wr, int wc, int fr, int fq) const {
        const int row0 = u.pm * BM + wr * 64 + fr; const int col0 = u.pn * BM + wc * 32 + 8 * fq;
#pragma unroll
        for (int ai = 0; ai < 2; ++ai)
#pragma unroll
            for (int m = 0; m < 4; ++m) { bf16_t* rowp = O + (size_t)(row0 + ai * HALF + m * 16) * ldc + col0;
#pragma unroll
                for (int bj = 0; bj < 2; ++bj) { f32x4 v0 = acc[ai][bj][m][0], v1 = acc[ai][bj][m][1];
                    if (act) { v0 = (f32x4){gelu_tanh(v0[0]), gelu_tanh(v0[1]), gelu_tanh(v0[2]), gelu_tanh(v0[3])}; v1 = (f32x4){gelu_tanh(v1[0]), gelu_tanh(v1[1]), gelu_tanh(v1[2]), gelu_tanh(v1[3])}; }
                    u32x4 w; w.x = cvt_pk_bf16(v0[0], v0[1]); w.y = cvt_pk_bf16(v0[2], v0[3]); w.z = cvt_pk_bf16(v1[0], v1[1]); w.w = cvt_pk_bf16(v1[2], v1[3]);
                    *(u32x4*)(rowp + bj * HALF) = w; } }
    }
};
}

constexpr int DM = 2048, NBATCH = 2, SEQ = 8192, CTXL = 256;
constexpr int ML = NBATCH * SEQ;
constexpr int MC = NBATCH * CTXL;
constexpr int MT = ML + MC;
constexpr int NLAYER = 4;
constexpr float ALPHA = 1.6817928305074290f, LN_EPS = 1e-6f;
constexpr int NWAVES = 8;
constexpr float U_SCALE = 64.0f, V_SCALE = 4.0f;
constexpr int PROW = 1536;
constexpr int NPH = 37;

constexpr size_t MiB = 1ull << 20;
constexpr size_t WS_CTL = 0, CTL_ZERO_BYTES = 1 * MiB;
constexpr int    CW_BAR = 4096;
constexpr size_t WS_MOD = 128 * 1024;
constexpr size_t WS_VST = 1 * MiB;
constexpr size_t WS_MODP = 1 * MiB + 256 * 1024;
constexpr size_t WS_GMWIN = 6 * MiB;
constexpr size_t WS_GMWOUT = WS_GMWIN + 32 * MiB;
constexpr size_t WS_GMWS = WS_GMWOUT + 16 * MiB;
constexpr size_t WS_PWQ = WS_GMWS + 1 * MiB;
constexpr size_t WS_PK1 = WS_PWQ + 32 * MiB;
constexpr size_t WS_PK2 = WS_PK1 + 512 * 1024;
constexpr size_t WS_MLAIN = WS_PK1 + 1 * MiB;
constexpr size_t WS_MLAUQ = WS_MLAIN + 5 * MiB;
constexpr size_t WS_MLAUKV = WS_MLAUQ + 3 * MiB;
constexpr size_t WS_MLAOUT = WS_MLAUKV + 4 * MiB;
constexpr size_t WS_DAIN = WS_MLAOUT + 8 * MiB;
constexpr size_t WS_DAOUT = WS_DAIN + 24 * MiB;
constexpr size_t WS_PU = WS_DAOUT + 8 * MiB;
constexpr size_t WS_PV = WS_PU + 96 * MiB;
constexpr size_t WS_X = WS_PV + 96 * MiB;
constexpr size_t WS_H = WS_X + 66 * MiB;
constexpr size_t WS_G = WS_H + 66 * MiB;
constexpr size_t WS_Y = WS_G + 66 * MiB;
constexpr size_t WS_QP = WS_Y + 66 * MiB;
constexpr size_t WS_Z = WS_QP + 66 * MiB;
constexpr size_t WS_C = WS_Z + 198 * MiB;
constexpr size_t WS_CQN = WS_C + 42 * MiB;
constexpr size_t WS_CKVN = WS_CQN + 17 * MiB;
constexpr size_t WS_KR = WS_CKVN + 17 * MiB;
constexpr size_t WS_QM = WS_KR + 3 * MiB;
constexpr size_t WS_KV = WS_QM + 99 * MiB;
constexpr size_t WS_ROUTE = WS_KV + 132 * MiB;
constexpr size_t WS_END = WS_ROUTE + 17 * MiB;
static_assert((size_t)MT * DM * 2 == 66 * MiB, "row buffer size");

constexpr int RING_BYTES = 155648, MISC_OFF = RING_BYTES + 320, LDS_BYTES = 159744;

#define GAS __attribute__((address_space(1)))
#define LAS __attribute__((address_space(3)))
typedef unsigned short bf16;
typedef unsigned u32x4 __attribute__((ext_vector_type(4)));
typedef unsigned u32x2 __attribute__((ext_vector_type(2)));
typedef float f32x4 __attribute__((ext_vector_type(4)));
typedef float f32x16 __attribute__((ext_vector_type(16)));
typedef short bf16x8 __attribute__((ext_vector_type(8)));
typedef short s16x4 __attribute__((ext_vector_type(4)));
#define LDS_WAIT() asm volatile("s_waitcnt lgkmcnt(0)" ::: "memory")

__device__ __forceinline__ unsigned cvtpk(float lo, float hi) { unsigned r; asm("v_cvt_pk_bf16_f32 %0, %1, %2" : "=v"(r) : "v"(lo), "v"(hi)); return r; }
__device__ __forceinline__ float bflo(unsigned w) { return __uint_as_float(w << 16); }
__device__ __forceinline__ float bfhi(unsigned w) { return __uint_as_float(w & 0xffff0000u); }
__device__ __forceinline__ float bf1(bf16 b) { return __uint_as_float((unsigned)b << 16); }
__device__ __forceinline__ bf16 tobf1(float f) { return (bf16)(cvtpk(f, 0.f) & 0xffffu); }
#define DPP_F(v, ctrl) __int_as_float(__builtin_amdgcn_mov_dpp(__float_as_int(v), (ctrl), 0xF, 0xF, true))
__device__ __forceinline__ float row_sum16(float v) { v += DPP_F(v, 0xB1); v += DPP_F(v, 0x4E); v += DPP_F(v, 0x141); v += DPP_F(v, 0x140); return v; }
__device__ __forceinline__ float sum_xor16(float v) { const auto r = __builtin_amdgcn_permlane16_swap(__float_as_uint(v), __float_as_uint(v), false, false); return __uint_as_float(r[0]) + __uint_as_float(r[1]); }
__device__ __forceinline__ float sum_xor32(float v) { const auto r = __builtin_amdgcn_permlane32_swap(__float_as_uint(v), __float_as_uint(v), false, false); return __uint_as_float(r[0]) + __uint_as_float(r[1]); }
__device__ __forceinline__ float wave_sum(float v) { return sum_xor32(sum_xor16(row_sum16(v))); }
__device__ __forceinline__ float half_sum32(float v) { return sum_xor16(row_sum16(v)); }
__device__ __forceinline__ float lane_xor16(float v, int lane) { const auto r = __builtin_amdgcn_permlane16_swap(__float_as_uint(v), __float_as_uint(v), false, false); return __uint_as_float((lane & 16) ? r[0] : r[1]); }
__device__ __forceinline__ unsigned lane_xor32(unsigned v, int lane) { const auto r = __builtin_amdgcn_permlane32_swap(v, v, false, false); return (lane & 32) ? r[0] : r[1]; }
__device__ __forceinline__ float gelu_tanh(float x) { return pg8::gelu_tanh(x); }

__device__ __forceinline__ void load_row_bf16(const bf16* row, int lane, float (&v)[32]) {
#pragma unroll
    for (int j = 0; j < 4; ++j) { const u32x4 w = ((const u32x4*)row)[64 * j + lane];
        v[8 * j + 0] = bflo(w.x); v[8 * j + 1] = bfhi(w.x); v[8 * j + 2] = bflo(w.y); v[8 * j + 3] = bfhi(w.y);
        v[8 * j + 4] = bflo(w.z); v[8 * j + 5] = bfhi(w.z); v[8 * j + 6] = bflo(w.w); v[8 * j + 7] = bfhi(w.w); }
}
__device__ __forceinline__ void store_row_bf16(bf16* row, int lane, const float (&v)[32]) {
#pragma unroll
    for (int j = 0; j < 4; ++j) { u32x4 w; w.x = cvtpk(v[8 * j + 0], v[8 * j + 1]); w.y = cvtpk(v[8 * j + 2], v[8 * j + 3]); w.z = cvtpk(v[8 * j + 4], v[8 * j + 5]); w.w = cvtpk(v[8 * j + 6], v[8 * j + 7]);
        ((u32x4*)row)[64 * j + lane] = w; }
}
__device__ __forceinline__ void load_row_f32(const float* row, int lane, float (&v)[32]) {
#pragma unroll
    for (int j = 0; j < 4; ++j) { const f32x4 a = ((const f32x4*)row)[128 * j + 2 * lane], b = ((const f32x4*)row)[128 * j + 2 * lane + 1];
        v[8 * j + 0] = a.x; v[8 * j + 1] = a.y; v[8 * j + 2] = a.z; v[8 * j + 3] = a.w; v[8 * j + 4] = b.x; v[8 * j + 5] = b.y; v[8 * j + 6] = b.z; v[8 * j + 7] = b.w; }
}
__device__ __forceinline__ void store_row_f32(float* row, int lane, const float (&v)[32]) {
#pragma unroll
    for (int j = 0; j < 4; ++j) { ((f32x4*)row)[128 * j + 2 * lane] = (f32x4){v[8 * j + 0], v[8 * j + 1], v[8 * j + 2], v[8 * j + 3]};
        ((f32x4*)row)[128 * j + 2 * lane + 1] = (f32x4){v[8 * j + 4], v[8 * j + 5], v[8 * j + 6], v[8 * j + 7]}; }
}
__device__ __forceinline__ void load_row_bf16_b(const bf16* row, int lane, float (&v)[32]) {
#pragma unroll
    for (int j = 0; j < 4; ++j) { const u32x4 w = ((const u32x4*)row)[4 * lane + j];
        v[8 * j + 0] = bflo(w.x); v[8 * j + 1] = bfhi(w.x); v[8 * j + 2] = bflo(w.y); v[8 * j + 3] = bfhi(w.y);
        v[8 * j + 4] = bflo(w.z); v[8 * j + 5] = bfhi(w.z); v[8 * j + 6] = bflo(w.w); v[8 * j + 7] = bfhi(w.w); }
}
__device__ __forceinline__ void store_row_bf16_b(bf16* row, int lane, const float (&v)[32]) {
#pragma unroll
    for (int j = 0; j < 4; ++j) { u32x4 w; w.x = cvtpk(v[8 * j + 0], v[8 * j + 1]); w.y = cvtpk(v[8 * j + 2], v[8 * j + 3]); w.z = cvtpk(v[8 * j + 4], v[8 * j + 5]); w.w = cvtpk(v[8 * j + 6], v[8 * j + 7]);
        ((u32x4*)row)[4 * lane + j] = w; }
}
__device__ __forceinline__ void load_row_f32_b(const float* row, int lane, float (&v)[32]) {
#pragma unroll
    for (int q = 0; q < 8; ++q) { const f32x4 a = ((const f32x4*)row)[8 * lane + q];
        v[4 * q + 0] = a.x; v[4 * q + 1] = a.y; v[4 * q + 2] = a.z; v[4 * q + 3] = a.w; }
}
__device__ __forceinline__ void store_row_f32_b(float* row, int lane, const float (&v)[32]) {
#pragma unroll
    for (int q = 0; q < 8; ++q) ((f32x4*)row)[8 * lane + q] = (f32x4){v[4 * q + 0], v[4 * q + 1], v[4 * q + 2], v[4 * q + 3]};
}
__device__ __forceinline__ void ln_stats(const float (&v)[32], float& mean, float& rstd) {
    float s = 0.f;
#pragma unroll
    for (int i = 0; i < 32; ++i) s += v[i];
    mean = wave_sum(s) * (1.0f / DM);
    float q = 0.f;
#pragma unroll
    for (int i = 0; i < 32; ++i) { const float d = v[i] - mean; q += d * d; }
    rstd = 1.0f / sqrtf(wave_sum(q) * (1.0f / DM) + LN_EPS);
}
template <bool LAYB>
__device__ __forceinline__ void finish_row(float (&z)[32], const float* lng, const float* lnb, bf16* Xrow, const float* sh, const float* sc, bf16* Hrow, float* Orow, int lane) {
    float mean, rstd; ln_stats(z, mean, rstd);
    { float g[32], b[32]; if (LAYB) { load_row_f32_b(lng, lane, g); load_row_f32_b(lnb, lane, b); } else { load_row_f32(lng, lane, g); load_row_f32(lnb, lane, b); }
#pragma unroll
      for (int i = 0; i < 32; ++i) z[i] = (z[i] - mean) * rstd * g[i] + b[i]; }
    if (Xrow) { if (LAYB) store_row_bf16_b(Xrow, lane, z); else store_row_bf16(Xrow, lane, z); }
    if (Orow) { if (LAYB) store_row_f32_b(Orow, lane, z); else store_row_f32(Orow, lane, z); }
    if (Hrow) {
        ln_stats(z, mean, rstd);
        float a[32], s[32]; if (LAYB) { load_row_f32_b(sc, lane, a); load_row_f32_b(sh, lane, s); } else { load_row_f32(sc, lane, a); load_row_f32(sh, lane, s); }
#pragma unroll
        for (int i = 0; i < 32; ++i) a[i] = (z[i] - mean) * rstd * (1.0f + a[i]) + s[i];
        if (LAYB) store_row_bf16_b(Hrow, lane, a); else store_row_bf16(Hrow, lane, a);
    }
}
__device__ __forceinline__ int row_slot(int row) { return row < ML ? (row >> 13) : 2; }

__device__ __forceinline__ unsigned f2bf_rne(float f) { unsigned u = __float_as_uint(f); return (u + 0x7fffu + ((u >> 16) & 1u)) >> 16; }
__device__ __forceinline__ unsigned pk2(float lo, float hi) { return f2bf_rne(lo) | (f2bf_rne(hi) << 16); }
__device__ __forceinline__ void p0_transpose_item(const float* W, int K, int N, bf16* WT, LAS float* scr, int item, int lane) {
    const int nblk = N / 32, kb = item / nblk, nb = item % nblk, k0 = 64 * kb, n0 = 32 * nb;
#pragma unroll 8
    for (int i = 0; i < 32; ++i) { const int kk = 2 * i + (lane >> 5); scr[kk * 33 + (lane & 31)] = W[(size_t)(k0 + kk) * N + n0 + (lane & 31)]; }
    LDS_WAIT(); asm volatile("" ::: "memory");
    const int c = lane & 7;
#pragma unroll
    for (int j = 0; j < 4; ++j) { const int n = (lane >> 3) + 8 * j; const LAS float* s = scr + (8 * c) * 33 + n;
        u32x4 o; o.x = pk2(s[0 * 33], s[1 * 33]); o.y = pk2(s[2 * 33], s[3 * 33]); o.z = pk2(s[4 * 33], s[5 * 33]); o.w = pk2(s[6 * 33], s[7 * 33]);
        *(u32x4*)(WT + (size_t)(n0 + n) * K + k0 + 8 * c) = o; }
    LDS_WAIT(); asm volatile("" ::: "memory");
}
__device__ __forceinline__ void cvt_range(const float* src, bf16* dst, size_t n8, size_t gtid, size_t gthreads) {
#pragma unroll 4
    for (size_t i = gtid; i < n8; i += gthreads) { const f32x4 a = ((const f32x4*)src)[2 * i], b = ((const f32x4*)src)[2 * i + 1];
        u32x4 w; w.x = cvtpk(a.x, a.y); w.y = cvtpk(a.z, a.w); w.z = cvtpk(b.x, b.y); w.w = cvtpk(b.z, b.w); ((u32x4*)dst)[i] = w; }
}
__device__ __forceinline__ unsigned enc_e2m3(float x) {
    const unsigned sgn = (__float_as_uint(x) >> 26) & 32u;
    const float ax = fminf(fabsf(x), 7.5f);
    unsigned u = __float_as_uint(ax); u += 0x7FFFFu + ((u >> 20) & 1u);
    const unsigned cn = (u >> 20) - ((127u - 1u) << 3);
    const unsigned cs = (unsigned)__builtin_rintf(ax * 8.0f);
    return sgn | (ax < 1.0f ? cs : cn);
}
typedef float f32x16v __attribute__((ext_vector_type(16)));
typedef float f32x32v __attribute__((ext_vector_type(32)));
typedef unsigned u32x6v __attribute__((ext_vector_type(6)));
__device__ __forceinline__ u32x6v pack_fp6_32(const float (&e)[32], bool interleaved) {
    f32x16v s0, s1;
    if (interleaved) {
#pragma unroll
        for (int i = 0; i < 16; ++i) { s0[i] = e[2 * i]; s1[i] = e[2 * i + 1]; }
    } else {
#pragma unroll
        for (int i = 0; i < 16; ++i) { s0[i] = e[i]; s1[i] = e[16 + i]; }
    }
    return __builtin_amdgcn_cvt_scalef32_2xpk16_fp6_f32(s0, s1, 1.0f);
}
__device__ __forceinline__ void cvt_table_fp6(const float* src, unsigned char* dst, int nrows, float scale, LAS float* scr  , int lane, int gw, int NGW) {
    bool interleaved;
    {
        float t[32];
#pragma unroll
        for (int k = 0; k < 32; ++k) t[k] = k < 16 ? 0.125f * k : (k < 24 ? 2.0f + 0.25f * (k - 16) : 4.0f + 0.5f * (k - 24));
        float tt[32];
#pragma unroll
        for (int k = 0; k < 32; ++k) { tt[k] = t[k]; asm volatile("" : "+v"(tt[k])); }
        const u32x6v p = pack_fp6_32(tt, true);
        const f32x32v o = __builtin_amdgcn_cvt_scalef32_pk32_f32_fp6(p, 1.0f);
        interleaved = (o[1] == t[1]) && (o[2] == t[2]) && (o[17] == t[17]);
        interleaved = __all(interleaved);
    }
    for (int row = gw; row < nrows; row += NGW) {
        const f32x4* s4 = (const f32x4*)(src + (size_t)row * 2048);
#pragma unroll
        for (int q = 0; q < 8; ++q) { const int s = 64 * q + lane; const f32x4 a = s4[s] * scale; *(LAS f32x4*)(scr + 4 * (s ^ ((s >> 4) & 7))) = a; }
        float e[32];
#pragma unroll
        for (int j = 0; j < 8; ++j) { const int s = 8 * lane + j; const f32x4 a = *(const LAS f32x4*)(scr + 4 * (s ^ ((s >> 4) & 7)));
            e[4 * j + 0] = __builtin_amdgcn_fmed3f(a.x, -7.5f, 7.5f); e[4 * j + 1] = __builtin_amdgcn_fmed3f(a.y, -7.5f, 7.5f); e[4 * j + 2] = __builtin_amdgcn_fmed3f(a.z, -7.5f, 7.5f); e[4 * j + 3] = __builtin_amdgcn_fmed3f(a.w, -7.5f, 7.5f); }
        const u32x6v p = pack_fp6_32(e, interleaved);
        unsigned char* rowp = dst + (size_t)row * PROW;
        *(u32x4*)(rowp + 16 * lane) = (u32x4){p[0], p[1], p[2], p[3]}; *(u32x2*)(rowp + 1024 + 8 * lane) = (u32x2){p[4], p[5]};
    }
}
__device__ __forceinline__ float silu(float x) { return x / (1.0f + __expf(-x)); }

struct Params { const float* in[29]; float* out; unsigned char* ws; int ph_lo, ph_hi; };
typedef const __attribute__((address_space(4))) Params* CP;

__device__ __forceinline__ void p0_prologue(CP P, LAS unsigned char* lds, int tid, int lane, int wid, int gw, int NGW) {
    unsigned char* ws = P->ws;
    LAS float* scr = (LAS float*)(lds + wid * 16384);
    {
        constexpr int I_GMIN = (2048 / 64) * (4096 / 32), I_SQ = (2048 / 64) * (2048 / 32), I_MIN = (2048 / 64) * (1088 / 32), I_UQ = (512 / 64) * (3072 / 32), I_UKV = (512 / 64) * (4096 / 32), I_DIN = (2048 / 64) * (6144 / 32);
        constexpr int NIT = 2 * I_GMIN + 2 * I_SQ + 4 * I_SQ + I_MIN + I_UQ + I_UKV + I_SQ + I_DIN + I_SQ;
        for (int it = gw; it < NIT; it += NGW) {
            int r = it;
            if (r < 2 * I_GMIN) { const int j = r / I_GMIN; p0_transpose_item(P->in[13] + (size_t)j * 2048 * 4096, 2048, 4096, (bf16*)(ws + WS_GMWIN) + (size_t)j * 4096 * 2048, scr, r % I_GMIN, lane); continue; } r -= 2 * I_GMIN;
            if (r < 2 * I_SQ) { const int j = r / I_SQ; p0_transpose_item(P->in[18] + (size_t)j * 2048 * 2048, 2048, 2048, (bf16*)(ws + WS_GMWOUT) + (size_t)j * 2048 * 2048, scr, r % I_SQ, lane); continue; } r -= 2 * I_SQ;
            if (r < 4 * I_SQ) { const int j = r / I_SQ; p0_transpose_item(P->in[8] + (size_t)j * 2048 * 2048, 2048, 2048, (bf16*)(ws + WS_PWQ) + (size_t)j * 2048 * 2048, scr, r % I_SQ, lane); continue; } r -= 4 * I_SQ;
            if (r < I_MIN) { p0_transpose_item(P->in[19], 2048, 1088, (bf16*)(ws + WS_MLAIN), scr, r, lane); continue; } r -= I_MIN;
            if (r < I_UQ) { p0_transpose_item(P->in[22], 512, 3072, (bf16*)(ws + WS_MLAUQ), scr, r, lane); continue; } r -= I_UQ;
            if (r < I_UKV) { p0_transpose_item(P->in[23], 512, 4096, (bf16*)(ws + WS_MLAUKV), scr, r, lane); continue; } r -= I_UKV;
            if (r < I_SQ) { p0_transpose_item(P->in[24], 2048, 2048, (bf16*)(ws + WS_MLAOUT), scr, r, lane); continue; } r -= I_SQ;
            if (r < I_DIN) { p0_transpose_item(P->in[25], 2048, 6144, (bf16*)(ws + WS_DAIN), scr, r, lane); continue; } r -= I_DIN;
            p0_transpose_item(P->in[28], 2048, 2048, (bf16*)(ws + WS_DAOUT), scr, r, lane);
        }
    }
    const size_t gtid = (size_t)gw * 64 + lane, gthreads = (size_t)NGW * 64;
    { u32x4* z = (u32x4*)((bf16*)(ws + WS_MLAIN) + (size_t)1088 * 2048); const size_t n = (size_t)192 * 2048 / 8;
      for (size_t i = gtid; i < n; i += gthreads) z[i] = (u32x4){0u, 0u, 0u, 0u}; }
    cvt_range(P->in[16], (bf16*)(ws + WS_GMWS), (size_t)2 * 16 * 128 * 128 / 8, gtid, gthreads);
    cvt_range(P->in[9], (bf16*)(ws + WS_PK1), (size_t)4 * 128 * 128 / 8, gtid, gthreads);
    cvt_range(P->in[10], (bf16*)(ws + WS_PK2), (size_t)4 * 128 * 128 / 8, gtid, gthreads);
    cvt_table_fp6(P->in[11], ws + WS_PU, 4 * 16384, U_SCALE, scr, lane, gw, NGW);
    cvt_table_fp6(P->in[12], ws + WS_PV, 4 * 16384, V_SCALE, scr, lane, gw, NGW);
    {
        const float* cv = P->in[1]; const float* cc = P->in[3]; const float* mw = P->in[4]; float* PART = (float*)(ws + WS_MODP);
        for (int item = gw; item < 4 * 192 * 8; item += NGW) {
            const int ks = item & 7, r = item >> 3, L = r / 192, n = (r % 192) * 64 + lane;
            const float* W = mw + (size_t)L * 2048 * 12288 + (size_t)(ks * 256) * 12288 + n;
            float a0 = 0.f, a1 = 0.f, a2 = 0.f;
#pragma unroll 32
            for (int k = 0; k < 256; ++k) { const int kk = ks * 256 + k; const float s0 = silu(cv[kk]), s1 = silu(cv[2048 + kk]), s2 = silu(cc[kk]);
                const float w = W[(size_t)k * 12288]; a0 += s0 * w; a1 += s1 * w; a2 += s2 * w; }
            float* o = PART + ((size_t)ks * 4 + L) * 3 * 12288 + n;
            o[0] = a0; o[12288] = a1; o[24576] = a2;
        }
    }
}
__device__ __forceinline__ void mod_reduce(CP P, int gw, int lane, int NGW) {
    const float* PART = (const float*)(P->ws + WS_MODP); float* MOD = (float*)(P->ws + WS_MOD); const float* mb = P->in[5];
    for (int i = gw * 64 + lane; i < 4 * 3 * 12288; i += NGW * 64) {
        const int L = i / (3 * 12288), n = i % 12288;
        float s = mb[(size_t)L * 12288 + n];
#pragma unroll
        for (int ks = 0; ks < 8; ++ks) s += PART[(size_t)ks * 4 * 3 * 12288 + i];
        MOD[i] = s;
    }
}

__device__ __forceinline__ void first_row_pass(CP P, int lane, int gw, int NGW) {
    const float* MOD = (const float*)(P->ws + WS_MOD); bf16* X = (bf16*)(P->ws + WS_X); bf16* H = (bf16*)(P->ws + WS_H);
    for (int row = gw; row < MT; row += NGW) {
        const float* src = row < ML ? P->in[0] + (size_t)row * DM : P->in[2] + (size_t)(row - ML) * DM;
        float v[32]; load_row_f32(src, lane, v);
        store_row_bf16(X + (size_t)row * DM, lane, v);
        const float* mod = MOD + (size_t)row_slot(row) * 12288;
        float mean, rstd; ln_stats(v, mean, rstd);
        float a[32], s[32]; load_row_f32(mod + 2048, lane, a); load_row_f32(mod, lane, s);
#pragma unroll
        for (int i = 0; i < 32; ++i) a[i] = (v[i] - mean) * rstd * (1.0f + a[i]) + s[i];
        store_row_bf16(H + (size_t)row * DM, lane, a);
    }
}
__device__ __forceinline__ void post_mixer_pass(CP P, int L, int Mrows, int lane, int gw, int NGW) {
    const float* MOD = (const float*)(P->ws + WS_MOD); bf16* X = (bf16*)(P->ws + WS_X); bf16* H = (bf16*)(P->ws + WS_H); const bf16* Y = (const bf16*)(P->ws + WS_Y);
    const float* lng = P->in[6] + (size_t)(L * 2 + 0) * DM; const float* lnb = P->in[7] + (size_t)(L * 2 + 0) * DM;
    for (int row = gw; row < Mrows; row += NGW) {
        const float* mod = MOD + (size_t)(L * 3 + row_slot(row)) * 12288;
        float z[32], y[32], g[32]; load_row_bf16(X + (size_t)row * DM, lane, z); load_row_bf16(Y + (size_t)row * DM, lane, y); load_row_f32(mod + 2 * 2048, lane, g);
#pragma unroll
        for (int i = 0; i < 32; ++i) z[i] = ALPHA * z[i] + g[i] * y[i];
        finish_row<false>(z, lng, lnb, X + (size_t)row * DM, mod + 3 * 2048, mod + 4 * 2048, H + (size_t)row * DM, nullptr, lane);
    }
}
__device__ __forceinline__ void vstats_pass(CP P, int Mrows, int lane, int gw, int NGW) {
    const bf16* Z = (const bf16*)(P->ws + WS_Z); float* VST = (float*)(P->ws + WS_VST);
    for (int row = gw; row < Mrows; row += NGW) {
        float v[32]; load_row_bf16(Z + (size_t)row * 4096 + 2048, lane, v);
        float mean, rstd; ln_stats(v, mean, rstd);
        if (lane == 0) { VST[2 * row] = mean; VST[2 * row + 1] = rstd; }
    }
}
#define XB_TMO      128
#define XB_XCNT(j)  (256  + 64 * (j))
#define XB_XSUB(j)  (1280 + 64 * (j))
#define XB_XGEN(j)  (2304 + 64 * (j))
#define XB_TOP      3328
#define XB_TOPGEN   3392
#define XCD_BAR_WORDS 3456
#define XB_SPIN_CAP (1u << 18)

__device__ __forceinline__ unsigned xb_ld(unsigned* p)              { return __hip_atomic_load(p, __ATOMIC_RELAXED, __HIP_MEMORY_SCOPE_AGENT); }
__device__ __forceinline__ unsigned xb_add(unsigned* p, unsigned v) { return __hip_atomic_fetch_add(p, v, __ATOMIC_RELAXED, __HIP_MEMORY_SCOPE_AGENT); }
__device__ __forceinline__ unsigned xb_xcc_id() { return (unsigned)__builtin_amdgcn_s_getreg((3 << 11) | 20) & 0xFu; }
#define XB_SPIN(cond, bar) do { unsigned _sp = 0; while (cond) { __builtin_amdgcn_s_sleep(1); \
    if ((++_sp & 255u) == 0u) { if (xb_ld(&(bar)[XB_TMO])) break; if (_sp > XB_SPIN_CAP) { atomicAdd(&(bar)[XB_TMO], 1u); break; } } } } while (0)

struct XcdBarrier {
    unsigned* bar; unsigned x;
    volatile LAS unsigned* st;
};

__device__ __forceinline__ XcdBarrier xcd_barrier_post(unsigned* bar, volatile LAS unsigned* st) {
    XcdBarrier b; b.bar = bar; b.x = xb_xcc_id(); b.st = st;
    if (threadIdx.x == 0) (void)xb_add(&bar[XB_XCNT(b.x)], 1u);
    return b;
}
__device__ __forceinline__ void xcd_barrier_complete(unsigned* bar, unsigned x, unsigned& nloc, unsigned& nx) {
    const unsigned G = gridDim.x * gridDim.y * gridDim.z;
    unsigned sum, cnt, mine, sp = 0u;
    for (;;) {
        sum = 0u; cnt = 0u; mine = 0u;
#pragma unroll
        for (unsigned j = 0; j < 16; ++j) { const unsigned c = xb_ld(&bar[XB_XCNT(j)]); sum += c; cnt += (c > 0u) ? 1u : 0u; mine = (j == x) ? c : mine; }
        if (sum == G) break;
        __builtin_amdgcn_s_sleep(1);
        if ((++sp & 255u) == 0u) { if (xb_ld(&bar[XB_TMO])) break; if (sp > XB_SPIN_CAP) { atomicAdd(&bar[XB_TMO], 1u); break; } }
    }
    nloc = mine > 0u ? mine : 1u; nx = cnt > 0u ? cnt : 1u;
}

__device__ __attribute__((noinline)) void xcd_barrier(const XcdBarrier b) {
    asm volatile("s_waitcnt vmcnt(0)" ::: "memory");
    __syncthreads();
    if (threadIdx.x == 0) {
        unsigned* bar = b.bar;
        __builtin_amdgcn_s_waitcnt(0);
        unsigned nloc = b.st[0], nx = b.st[1];
        if (nloc == 0u) { xcd_barrier_complete(bar, b.x, nloc, nx); b.st[0] = nloc; b.st[1] = nx; }
        const unsigned old = xb_add(&bar[XB_XSUB(b.x)], 1u);
        const unsigned gen = old / nloc;
        if (old + 1u == (gen + 1u) * nloc) {
            __builtin_amdgcn_fence(__ATOMIC_RELEASE, "agent");
            asm volatile("s_waitcnt vmcnt(0)" ::: "memory");
            const unsigned og = xb_add(&bar[XB_TOP], 1u);
            const unsigned tg = og / nx;
            if (og + 1u == (tg + 1u) * nx) xb_add(&bar[XB_TOPGEN], 1u);
            else XB_SPIN(xb_ld(&bar[XB_TOPGEN]) == tg, bar);
            __builtin_amdgcn_fence(__ATOMIC_ACQUIRE, "agent");
            xb_add(&bar[XB_XGEN(b.x)], 1u);
            asm volatile("s_waitcnt vmcnt(0)" ::: "memory");
        } else {
            XB_SPIN(xb_ld(&bar[XB_XGEN(b.x)]) == gen, bar);
            __builtin_amdgcn_fence(__ATOMIC_ACQUIRE, "agent");
            asm volatile("s_waitcnt vmcnt(0)" ::: "memory");
        }
    }
    __syncthreads();
}

__device__ __forceinline__ void spatial_phase(CP P, int j, int Mrows, LAS unsigned char* lds_, int tid, int lane, int wid) {
    const bf16* Z = (const bf16*)(P->ws + WS_Z); const float* VST = (const float*)(P->ws + WS_VST); bf16* Gb = (bf16*)(P->ws + WS_G);
    const bf16* WS = (const bf16*)(P->ws + WS_GMWS) + (size_t)j * 16 * 128 * 128;
    const float* lng = P->in[14] + (size_t)j * DM; const float* lnb = P->in[15] + (size_t)j * DM; const float* bs = P->in[17] + (size_t)j * 16 * 128;
    LAS bf16* Vt = (LAS bf16*)(LAS unsigned char*)lds_;
    constexpr int VP = 136;
    const int nunits = (Mrows / 128) * 16;
    for (int u = blockIdx.x; u < nunits; u += gridDim.x) {
        const int c = u >> 4, g = u & 15;
        __syncthreads();
        {
            const int q = tid >> 2, dq = (tid & 3) * 32; const int row = c * 128 + q;
            const float mean = VST[2 * row], rstd = VST[2 * row + 1];
            const bf16* src = Z + (size_t)row * 4096 + 2048 + g * 128 + dq;
#pragma unroll
            for (int t = 0; t < 4; ++t) { const u32x4 w = *(const u32x4*)(src + 8 * t);
                float v[8] = {bflo(w.x), bfhi(w.x), bflo(w.y), bfhi(w.y), bflo(w.z), bfhi(w.z), bflo(w.w), bfhi(w.w)};
                const float* gp = lng + g * 128 + dq + 8 * t; const float* bp = lnb + g * 128 + dq + 8 * t;
#pragma unroll
                for (int i = 0; i < 8; ++i) { const float vn = (v[i] - mean) * rstd * gp[i] + bp[i]; Vt[(dq + 8 * t + i) * VP + q] = tobf1(vn); } }
        }
        __syncthreads();
        const int fr = lane & 15, fq = lane >> 4;
        bf16x8 a[4];
        const bf16* wrow = WS + (size_t)g * 128 * 128 + (size_t)(16 * wid + fr) * 128 + 8 * fq;
#pragma unroll
        for (int ks = 0; ks < 4; ++ks) a[ks] = *(const bf16x8*)(wrow + 32 * ks);
#pragma unroll
        for (int nb = 0; nb < 8; ++nb) {
            f32x4 acc = {0.f, 0.f, 0.f, 0.f};
#pragma unroll
            for (int ks = 0; ks < 4; ++ks) { const bf16x8 b = *(const LAS bf16x8*)(Vt + (16 * nb + fr) * VP + 32 * ks + 8 * fq);
                acc = __builtin_amdgcn_mfma_f32_16x16x32_bf16(a[ks], b, acc, 0, 0, 0); }
#pragma unroll
            for (int r = 0; r < 4; ++r) { const int p = 16 * wid + fq * 4 + r, d = 16 * nb + fr; const size_t grow = (size_t)(c * 128 + p);
                const float sv = acc[r] + bs[g * 128 + p];
                const float uu = bf1(Z[grow * 4096 + g * 128 + d]);
                Gb[grow * 2048 + g * 128 + d] = tobf1(uu * sv); }
        }
    }
}

__device__ __forceinline__ void rope_cs(int row, int l, float& cs, float& sn) {
    const int t = row & (SEQ - 1); const int pos = (l & 32) ? (t & 63) : (t >> 6);
    const float inv = powf(10000.0f, -(float)(l & 15) * (1.0f / 16.0f));
    const float ang = (float)pos * inv; sincosf(ang, &sn, &cs);
}
__device__ __forceinline__ float rope_apply(float x, int l, float cs, float sn) {
    const float p = lane_xor16(x, l);
    return (l & 16) ? (p * sn + x * cs) : (x * cs - p * sn);
}
__device__ __forceinline__ void mla_norm_pass(CP P, int lane, int gw, int NGW) {
    const bf16* C = (const bf16*)(P->ws + WS_C); bf16* CQN = (bf16*)(P->ws + WS_CQN); bf16* CKVN = (bf16*)(P->ws + WS_CKVN); bf16* KR = (bf16*)(P->ws + WS_KR);
    const float* qn = P->in[20]; const float* kvn = P->in[21];
    for (int row = gw; row < MT; row += NGW) {
        const bf16* c = C + (size_t)row * 1280;
#pragma unroll
        for (int part = 0; part < 2; ++part) {
            const u32x4 w = *(const u32x4*)(c + part * 512 + 8 * lane);
            float v[8] = {bflo(w.x), bfhi(w.x), bflo(w.y), bfhi(w.y), bflo(w.z), bfhi(w.z), bflo(w.w), bfhi(w.w)};
            float ss = 0.f;
#pragma unroll
            for (int i = 0; i < 8; ++i) ss += v[i] * v[i];
            const float r = 1.0f / sqrtf(wave_sum(ss) * (1.0f / 512.0f) + LN_EPS);
            const float* nw = (part ? kvn : qn) + 8 * lane;
            u32x4 o; o.x = cvtpk(v[0] * r * nw[0], v[1] * r * nw[1]); o.y = cvtpk(v[2] * r * nw[2], v[3] * r * nw[3]); o.z = cvtpk(v[4] * r * nw[4], v[5] * r * nw[5]); o.w = cvtpk(v[6] * r * nw[6], v[7] * r * nw[7]);
            *(u32x4*)((part ? CKVN : CQN) + (size_t)row * 512 + 8 * lane) = o;
        }
        float x = bf1(c[1024 + lane]);
        if (row < ML) { float cs, sn; rope_cs(row, lane, cs, sn); x = rope_apply(x, lane, cs, sn); }
        KR[(size_t)row * 64 + lane] = tobf1(x);
    }
}
__device__ __forceinline__ void rope_pass(bf16* buf, int ld, int col0, int nchunks, int cstride, int lane, int gw, int NGW) {
    for (int row = gw; row < ML; row += NGW) {
        float cs, sn; rope_cs(row, lane, cs, sn);
        bf16* r = buf + (size_t)row * ld + col0 + lane;
#pragma unroll 4
        for (int k = 0; k < nchunks; ++k) { const float x = bf1(r[k * cstride]); r[k * cstride] = tobf1(rope_apply(x, lane, cs, sn)); }
    }
}

namespace att {
#define SBAR() __builtin_amdgcn_sched_barrier(0)
__device__ __forceinline__ int crow(int r, int hi) { return (r & 3) + 8 * (r >> 2) + 4 * hi; }
__device__ __forceinline__ unsigned cvtpkv(float lo, float hi) { unsigned r; asm volatile("v_cvt_pk_bf16_f32 %0, %1, %2" : "=v"(r) : "v"(lo), "v"(hi)); return r; }

__device__ __forceinline__ void partialSM(f32x16& p0, f32x16& p1, float& m_reg, float& mn, float& alpha, const float C, const float THRS) {
  float pmax = p0[0];
#pragma unroll
  for (int r = 1; r < 16; ++r) pmax = fmaxf(pmax, p0[r]);
#pragma unroll
  for (int r = 0; r < 16; ++r) pmax = fmaxf(pmax, p1[r]);
  { auto rr = __builtin_amdgcn_permlane32_swap(__float_as_uint(pmax), __float_as_uint(pmax), false, false);
    pmax = fmaxf(__uint_as_float(rr[0]), __uint_as_float(rr[1])); }
  if (__builtin_expect(__all(pmax - m_reg <= THRS), 1)) { mn = m_reg; alpha = 1.f; }
  else { mn = fmaxf(m_reg, pmax); alpha = __builtin_amdgcn_exp2f((m_reg - mn) * C); m_reg = mn; }
  const float mnC = -mn * C;
#pragma unroll
  for (int r = 0; r < 16; ++r) p0[r] = fmaf(p0[r], C, mnC);
#pragma unroll
  for (int r = 0; r < 16; ++r) p1[r] = fmaf(p1[r], C, mnC);
#pragma unroll
  for (int r = 0; r < 16; ++r) p0[r] = __builtin_amdgcn_exp2f(p0[r]);
}
__device__ __forceinline__ void finishSM(f32x16& p0, f32x16& p1, float alpha, float& l_reg, bf16x8& pa0, bf16x8& pa1, bf16x8& pa2, bf16x8& pa3) {
#pragma unroll
  for (int r = 0; r < 16; ++r) p1[r] = __builtin_amdgcn_exp2f(p1[r]);
  float ps = 0;
#pragma unroll
  for (int r = 0; r < 16; ++r) ps += p0[r];
#pragma unroll
  for (int r = 0; r < 16; ++r) ps += p1[r];
  { auto rr = __builtin_amdgcn_permlane32_swap(__float_as_uint(ps), __float_as_uint(ps), false, false);
    ps = __uint_as_float(rr[0]) + __uint_as_float(rr[1]); }
  l_reg = l_reg * alpha + ps;
#define PK4(P, BASE, OUT) do { unsigned a0 = cvtpkv(P[BASE + 0], P[BASE + 1]), a1 = cvtpkv(P[BASE + 2], P[BASE + 3]);   \
    unsigned b0 = cvtpkv(P[BASE + 4], P[BASE + 5]), b1 = cvtpkv(P[BASE + 6], P[BASE + 7]);                              \
    auto r0 = __builtin_amdgcn_permlane32_swap(a0, b0, false, false); auto r1 = __builtin_amdgcn_permlane32_swap(a1, b1, false, false); \
    u32x4 w = {r0[0], r1[0], r0[1], r1[1]}; OUT = *reinterpret_cast<bf16x8*>(&w); } while (0)
  PK4(p0, 0, pa0); PK4(p0, 8, pa1); PK4(p1, 0, pa2); PK4(p1, 8, pa3);
#undef PK4
}
template <int PITCH> __device__ __forceinline__ int kswz(int r) { return PITCH == 256 ? (r & 15) : ((r >> 1) & 7); }
template <int NQF, int NQR, int PITCH> __device__ __forceinline__ void qkt(f32x16& p0, f32x16& p1, const LAS char* Ks, int chunk0, const bf16x8* qr, const LAS char* ql, int r32, int hi) {
  p0 = f32x16{}; p1 = f32x16{};
  const int sw = kswz<PITCH>(r32);
#pragma unroll
  for (int d0 = 0; d0 < NQF; ++d0) { const int off = ((chunk0 + d0 * 2 + hi) ^ sw) * 16;
    const bf16x8 b0 = *(const LAS bf16x8*)(Ks + r32 * PITCH + off);
    const bf16x8 b1 = *(const LAS bf16x8*)(Ks + (32 + r32) * PITCH + off);
    const bf16x8 q = d0 < NQR ? qr[d0 < NQR ? d0 : 0] : *(const LAS bf16x8*)(ql + (d0 - NQR) * 1024);
    p0 = __builtin_amdgcn_mfma_f32_32x32x16_bf16(b0, q, p0, 0, 0, 0);
    p1 = __builtin_amdgcn_mfma_f32_32x32x16_bf16(b1, q, p1, 0, 0, 0); }
}
__device__ __forceinline__ int v_st(int k, int c) { const int kk = (k & ~0xC) | ((k & 4) << 1) | ((k & 8) >> 1); return ((kk >> 3) * 4 + (c >> 5)) * 512 + ((kk & 7) * 32 + (c & 31)) * 2; }
__device__ __forceinline__ int v_rd_base(int lane) { return ((lane & 3) << 3) | (((lane >> 2) & 3) << 6) | (((lane >> 4) & 1) << 5) | (((lane >> 5) & 1) << 8); }
constexpr int v_rd_off(int d0, int ks, int half) { return d0 * 512 + ks * 4096 + half * 2048; }
template <int OFF> __device__ __forceinline__ s16x4 tr_read(int vb) {
  s16x4 r; asm volatile("ds_read_b64_tr_b16 %0, %1 offset:%2" : "=&v"(r) : "v"(vb), "i"(OFF) : "memory"); return r;
}
template <int D0> __device__ __forceinline__ void pv_one(f32x16& od, int vb, bf16x8 pa0, bf16x8 pa1, bf16x8 pa2, bf16x8 pa3) {
  const s16x4 l0 = tr_read<v_rd_off(D0, 0, 0)>(vb), h0 = tr_read<v_rd_off(D0, 0, 1)>(vb), l1 = tr_read<v_rd_off(D0, 1, 0)>(vb), h1 = tr_read<v_rd_off(D0, 1, 1)>(vb);
  const s16x4 l2 = tr_read<v_rd_off(D0, 2, 0)>(vb), h2 = tr_read<v_rd_off(D0, 2, 1)>(vb), l3 = tr_read<v_rd_off(D0, 3, 0)>(vb), h3 = tr_read<v_rd_off(D0, 3, 1)>(vb);
  asm volatile("s_waitcnt lgkmcnt(0)" ::: "memory"); SBAR();
#define PK(L, H) (bf16x8){L[0], L[1], L[2], L[3], H[0], H[1], H[2], H[3]}
  od = __builtin_amdgcn_mfma_f32_32x32x16_bf16(pa0, PK(l0, h0), od, 0, 0, 0);
  od = __builtin_amdgcn_mfma_f32_32x32x16_bf16(pa1, PK(l1, h1), od, 0, 0, 0);
  od = __builtin_amdgcn_mfma_f32_32x32x16_bf16(pa2, PK(l2, h2), od, 0, 0, 0);
  od = __builtin_amdgcn_mfma_f32_32x32x16_bf16(pa3, PK(l3, h3), od, 0, 0, 0);
#undef PK
}
__device__ __forceinline__ void pv_d0(f32x16* o, int vb, bf16x8 pa0, bf16x8 pa1, bf16x8 pa2, bf16x8 pa3) {
  pv_one<0>(o[0], vb, pa0, pa1, pa2, pa3); pv_one<1>(o[1], vb, pa0, pa1, pa2, pa3); pv_one<2>(o[2], vb, pa0, pa1, pa2, pa3); pv_one<3>(o[3], vb, pa0, pa1, pa2, pa3);
}
__device__ __forceinline__ bf16x8 ld8(const bf16* p) { return *reinterpret_cast<const bf16x8*>(p); }

template <int MODE>
__device__ __forceinline__ void attn_unit(const bf16* __restrict__ Qrow0, int ldq, const bf16* __restrict__ Kb, const bf16* __restrict__ Vb, int ldk, const bf16* __restrict__ KRb,
                                          int b, int nct, int NT, bf16* __restrict__ Ob, float lam, const float* __restrict__ subln, float oscale, LAS unsigned char* lds_) {
  constexpr int NQF = MODE == 0 ? 12 : 4, NQR = MODE == 0 ? 6 : 4, PITCH = MODE == 0 ? 384 : 256, SHM_V = 16384, SHM_K = 64 * PITCH, SDEPTH = MODE == 0 ? 1 : 2;
  const float SCALE = MODE == 0 ? 0.07216878364870323f : 0.125f;
  const float C = SCALE * 1.4426950408889634f, THRS = 8.f / SCALE;
  const int tid = launder_v(threadIdx.x), wid = tid >> 6, lane = tid & 63, r32 = lane & 31, hi = lane >> 5;
  LAS char* lds = (LAS char*)(LAS unsigned char*)lds_;
  LAS char* V_lds = lds; LAS char* K_lds = lds + 2 * SHM_V;
  LAS float* wsf = (LAS float*)(lds + 2 * SHM_V + 2 * SHM_K) + wid * 64; LAS float* li_l = wsf; LAS float* al_l = wsf + 32;
  const int wq = MODE == 0 ? wid : (wid & 3), sgrp = MODE == 0 ? 0 : (wid >> 2);
  float m_reg = -1e30f, l_reg = 0; f32x16 o[4] = {}; bf16x8 qr[NQR];
  LAS char* ql = lds + 2 * SHM_V + 2 * SHM_K + 2048 + wid * 6144 + lane * 16;
  const bf16* Qw = Qrow0 + (size_t)(wq * 32 + r32) * ldq + sgrp * 64 + hi * 8;
#pragma unroll
  for (int d0 = 0; d0 < NQR; ++d0) qr[d0] = ld8(Qw + d0 * 16);
#pragma unroll
  for (int d0 = NQR; d0 < NQF; ++d0) *(LAS bf16x8*)(ql + (d0 - NQR) * 1024) = ld8(Qw + d0 * 16);
  const int sr = tid >> 4, sc = (tid & 15) * 8, vst0 = v_st(sr, sc), vst1 = v_st(32 + sr, sc);
  const int kst0 = sr * PITCH + (((tid & 15) ^ kswz<PITCH>(sr)) * 16), kst1 = kst0 + 32 * PITCH;
  const int rrow = tid >> 3, krs = rrow * PITCH + (((16 + (tid & 7)) ^ kswz<PITCH>(rrow)) * 16);
  const int chunk0 = sgrp * 8;
  const int vb0 = (int)(uintptr_t)V_lds + v_rd_base(lane);
  struct Slot { bf16x8 vs0, vs1, ks0, ks1, kr; } sr_[SDEPTH];
#define KROW(jt) ((jt) < nct ? (ML + b * CTXL + (jt) * 64) : (b * SEQ + ((jt) - nct) * 64))
#define SLOAD(i, jt) do { const int k0_ = KROW(jt); sr_[i].vs0 = ld8(Vb + (size_t)(k0_ + sr) * ldk + sc); sr_[i].vs1 = ld8(Vb + (size_t)(k0_ + 32 + sr) * ldk + sc); \
    sr_[i].ks0 = ld8(Kb + (size_t)(k0_ + sr) * ldk + sc); sr_[i].ks1 = ld8(Kb + (size_t)(k0_ + 32 + sr) * ldk + sc); \
    if (MODE == 0) sr_[i].kr = ld8(KRb + (size_t)(k0_ + rrow) * 64 + (tid & 7) * 8); } while (0)
#define SWRITE(bf, i) do { *(LAS bf16x8*)(V_lds + (bf) * SHM_V + vst0) = sr_[i].vs0; *(LAS bf16x8*)(V_lds + (bf) * SHM_V + vst1) = sr_[i].vs1; \
    *(LAS bf16x8*)(K_lds + (bf) * SHM_K + kst0) = sr_[i].ks0; *(LAS bf16x8*)(K_lds + (bf) * SHM_K + kst1) = sr_[i].ks1; \
    if (MODE == 0) *(LAS bf16x8*)(K_lds + (bf) * SHM_K + krs) = sr_[i].kr; } while (0)
#define SWAIT() do { if constexpr (SDEPTH == 2) asm volatile("s_waitcnt vmcnt(4)" ::: "memory"); else asm volatile("s_waitcnt vmcnt(0)" ::: "memory"); } while (0)
#define RESC(a) do { if (__any((a) < 1.f)) { if (hi == 0) al_l[r32] = (a); asm volatile("s_waitcnt lgkmcnt(0)" ::: "memory"); \
    _Pragma("unroll") for (int d = 0; d < 4; ++d) _Pragma("unroll") for (int r = 0; r < 16; ++r) o[d][r] *= al_l[crow(r, hi)]; } } while (0)
  f32x16 pA0, pA1, pB0, pB1; float mnA, mnB, alA, alB; bf16x8 pa0, pa1, pa2, pa3;
  constexpr int SE = 0, SO = SDEPTH - 1;
  SLOAD(SE, 0); asm volatile("s_waitcnt vmcnt(0)" ::: "memory"); SWRITE(0, SE); __syncthreads();
  qkt<NQF, NQR, PITCH>(pA0, pA1, K_lds, chunk0, qr, ql, r32, hi); partialSM(pA0, pA1, m_reg, mnA, alA, C, THRS);
  SLOAD(SO, 1); if constexpr (SDEPTH == 2) { if (2 < NT) SLOAD(SE, 2); }
  SWAIT(); SWRITE(1, SO); __syncthreads();
  for (int j = 1; j + 1 < NT; j += 2) {
    SBAR(); qkt<NQF, NQR, PITCH>(pB0, pB1, K_lds + SHM_K, chunk0, qr, ql, r32, hi);
    finishSM(pA0, pA1, alA, l_reg, pa0, pa1, pa2, pa3); SBAR();
    SLOAD(SO, j + SDEPTH); SBAR();
    pv_d0(o, vb0, pa0, pa1, pa2, pa3); partialSM(pB0, pB1, m_reg, mnB, alB, C, THRS);
    __syncthreads(); SWAIT(); SWRITE(0, SE);
    RESC(alB); __syncthreads();
    SBAR(); qkt<NQF, NQR, PITCH>(pA0, pA1, K_lds, chunk0, qr, ql, r32, hi);
    finishSM(pB0, pB1, alB, l_reg, pa0, pa1, pa2, pa3); SBAR();
    if (SDEPTH == 1 || j + 3 < NT) SLOAD(SE, j + 1 + SDEPTH); SBAR();
    pv_d0(o, vb0 + SHM_V, pa0, pa1, pa2, pa3); partialSM(pA0, pA1, m_reg, mnA, alA, C, THRS);
    __syncthreads(); SWAIT(); SWRITE(1, SO);
    RESC(alA); __syncthreads();
  }
  SBAR(); qkt<NQF, NQR, PITCH>(pB0, pB1, K_lds + SHM_K, chunk0, qr, ql, r32, hi);
  finishSM(pA0, pA1, alA, l_reg, pa0, pa1, pa2, pa3); SBAR();
  pv_d0(o, vb0, pa0, pa1, pa2, pa3); partialSM(pB0, pB1, m_reg, mnB, alB, C, THRS);
  __syncthreads(); RESC(alB);
  finishSM(pB0, pB1, alB, l_reg, pa0, pa1, pa2, pa3); SBAR();
  pv_d0(o, vb0 + SHM_V, pa0, pa1, pa2, pa3);
  if (hi == 0) li_l[r32] = l_reg; asm volatile("s_waitcnt lgkmcnt(0)" ::: "memory");
  float rli[16];
#pragma unroll
  for (int r = 0; r < 16; ++r) rli[r] = __builtin_amdgcn_rcpf(li_l[crow(r, hi)]);
  bf16* Ow = Ob + (size_t)(wq * 32) * DM;
  if constexpr (MODE == 0) {
#pragma unroll
    for (int r = 0; r < 16; ++r) { const int orow = crow(r, hi);
#pragma unroll
      for (int d0 = 0; d0 < 4; ++d0) Ow[(size_t)orow * DM + d0 * 32 + r32] = tobf1(o[d0][r] * rli[r]); }
    __syncthreads();
  } else {
    LAS float* ex = (LAS float*)lds;
    __syncthreads();
    if (sgrp == 1) {
#pragma unroll
      for (int r = 0; r < 16; ++r)
#pragma unroll
        for (int d0 = 0; d0 < 4; ++d0) ex[(wq * 32 + crow(r, hi)) * 128 + d0 * 32 + r32] = o[d0][r] * rli[r];
    }
    __syncthreads();
    if (sgrp == 0) {
#pragma unroll
      for (int r = 0; r < 16; ++r) { const int orow = crow(r, hi); float dd[4]; float ss = 0.f;
#pragma unroll
        for (int d0 = 0; d0 < 4; ++d0) { dd[d0] = o[d0][r] * rli[r] - lam * ex[(wq * 32 + orow) * 128 + d0 * 32 + r32]; ss += dd[d0] * dd[d0]; }
        ss = half_sum32(ss);
        const float rs = oscale / sqrtf(ss * (1.0f / 128.0f) + LN_EPS);
#pragma unroll
        for (int d0 = 0; d0 < 4; ++d0) Ow[(size_t)orow * DM + d0 * 32 + r32] = tobf1(dd[d0] * rs * subln[d0 * 32 + r32]); }
    }
    __syncthreads();
  }
#undef KROW
#undef SLOAD
#undef SWRITE
#undef SWAIT
#undef RESC
}
}

__device__ __forceinline__ void mla_attn_phase(CP P, LAS unsigned char* lds) {
    const bf16* QM = (const bf16*)(P->ws + WS_QM); const bf16* KV = (const bf16*)(P->ws + WS_KV); const bf16* KR = (const bf16*)(P->ws + WS_KR); bf16* Gb = (bf16*)(P->ws + WS_G);
    const int c = blockIdx.x, G = gridDim.x;
    for (int u = c; u < 1024 + 32; u += G) {
        int b, h, qrow0, NT;
        if (u < 1024) { const int i = u >> 8, cc = u & 255; const int bh = (cc & 7) + 8 * i, qb = cc >> 3; b = bh >> 4; h = bh & 15; qrow0 = b * SEQ + qb * 256; NT = 4 + 128; }
        else { const int bh = u - 1024; b = bh >> 4; h = bh & 15; qrow0 = ML + b * CTXL; NT = 4; }
        att::attn_unit<0>(QM + (size_t)qrow0 * 3072 + h * 192, 3072, KV + h * 256, KV + h * 256 + 128, 4096, KR, b, 4, NT, Gb + (size_t)qrow0 * DM + h * 128, 0.f, nullptr, 1.f, lds);
    }
}
__device__ __forceinline__ void da_attn_phase(CP P, float lam, float oscale, LAS unsigned char* lds) {
    const bf16* Z = (const bf16*)(P->ws + WS_Z); bf16* Gb = (bf16*)(P->ws + WS_G); const float* subln = P->in[27];
    const int c = blockIdx.x, G = gridDim.x;
    for (int u = c; u < 2048 + 64; u += G) {
        int b, h, qrow0, NT;
        if (u < 2048) { const int i = u >> 8, cc = u & 255; const int bh = (cc & 7) + 8 * (i >> 1), qb = (cc >> 3) + 32 * (i & 1); b = bh >> 4; h = bh & 15; qrow0 = b * SEQ + qb * 128; NT = 4 + 128; }
        else { const int v = u - 2048; const int bh = v >> 1; b = bh >> 4; h = bh & 15; qrow0 = ML + b * CTXL + (v & 1) * 128; NT = 4; }
        att::attn_unit<1>(Z + (size_t)qrow0 * 6144 + h * 128, 6144, Z + 2048 + h * 128, Z + 4096 + h * 128, 6144, nullptr, b, 4, NT, Gb + (size_t)qrow0 * DM + h * 128, lam, subln, oscale, lds);
    }
}

__device__ __forceinline__ unsigned f2ord(float f) { const unsigned u = __float_as_uint(f); return u ^ ((unsigned)((int)u >> 31) | 0x80000000u); }
__device__ __forceinline__ float ord2f(unsigned k) { return __uint_as_float((k & 0x80000000u) ? (k ^ 0x80000000u) : ~k); }
__device__ __forceinline__ void ce_desc(unsigned& a, unsigned& b) { const unsigned mx = a > b ? a : b, mn = a > b ? b : a; a = mx; b = mn; }
template <int N, bool DESC> __device__ __forceinline__ void bitonic_merge(unsigned* a) {
#pragma unroll
    for (int j = N / 2; j > 0; j >>= 1)
#pragma unroll
        for (int i = 0; i < N; ++i) { const int l = i ^ j; if (l > i) { if (DESC) ce_desc(a[i], a[l]); else ce_desc(a[l], a[i]); } }
}
template <int N, bool DESC> __device__ __forceinline__ void bitonic_sort(unsigned* a) {
#pragma unroll
    for (int k = 2; k <= N; k <<= 1)
#pragma unroll
        for (int j = k >> 1; j > 0; j >>= 1)
#pragma unroll
            for (int i = 0; i < N; ++i) { const int l = i ^ j; if (l > i) { const bool up = ((i & k) == 0); if (up == DESC) ce_desc(a[i], a[l]); else ce_desc(a[l], a[i]); } }
}
__device__ __forceinline__ void top16_of_64(unsigned (&a)[64]) {
    bitonic_sort<16, true>(a); bitonic_sort<16, false>(a + 16); bitonic_sort<16, true>(a + 32); bitonic_sort<16, false>(a + 48);
#pragma unroll
    for (int i = 0; i < 16; ++i) a[i] = a[i] > a[16 + i] ? a[i] : a[16 + i];
    bitonic_merge<16, true>(a);
#pragma unroll
    for (int i = 0; i < 16; ++i) a[32 + i] = a[32 + i] > a[48 + i] ? a[32 + i] : a[48 + i];
    bitonic_merge<16, false>(a + 32);
#pragma unroll
    for (int i = 0; i < 16; ++i) a[i] = a[i] > a[32 + i] ? a[i] : a[32 + i];
    bitonic_merge<16, true>(a);
}
template <int PASS> __device__ __forceinline__ void route_pass(const bf16* QP, const LAS char* lds, int tok, int head, int r32, int hi, unsigned (&top)[16]) {
    f32x16 acc[4] = {};
    const bf16* qp = QP + (size_t)tok * DM + head * 256 + PASS * 128 + hi * 8;
    bf16x8 qf[8];
#pragma unroll
    for (int ks = 0; ks < 8; ++ks) qf[ks] = *(const bf16x8*)(qp + ks * 16);
    const LAS char* Kl = lds + PASS * 32768;
#pragma unroll
    for (int kb = 0; kb < 4; ++kb)
#pragma unroll
        for (int ks = 0; ks < 8; ++ks) { const bf16x8 a = *(const LAS bf16x8*)(Kl + (kb * 32 + r32) * 256 + (((ks * 2 + hi) ^ (r32 & 15)) * 16));
            acc[kb] = __builtin_amdgcn_mfma_f32_32x32x16_bf16(a, qf[ks], acc[kb], 0, 0, 0); }
    unsigned key[64]; const unsigned base = 127u - 4u * (unsigned)hi;
#pragma unroll
    for (int kb = 0; kb < 4; ++kb)
#pragma unroll
        for (int r = 0; r < 16; ++r) key[kb * 16 + r] = (f2ord(acc[kb][r]) & ~127u) | (base - (unsigned)(kb * 32 + (r & 3) + 8 * (r >> 2)));
    top16_of_64(key);
    unsigned pr[16];
#pragma unroll
    for (int i = 0; i < 16; ++i) pr[i] = lane_xor32(key[15 - i], hi << 5);
#pragma unroll
    for (int i = 0; i < 16; ++i) key[i] = key[i] > pr[i] ? key[i] : pr[i];
    bitonic_merge<16, true>(key);
#pragma unroll
    for (int i = 0; i < 16; ++i) top[i] = key[i];
}
__device__ __forceinline__ void route_phase(CP P, int L, int Mrows, LAS unsigned char* lds_, int tid, int lane, int wid, int gw, int NGW) {
    const bf16* QP = (const bf16*)(P->ws + WS_QP); unsigned* ROUTE = (unsigned*)(P->ws + WS_ROUTE);
    LAS char* lds = (LAS char*)(LAS unsigned char*)lds_;
    __syncthreads();
    {
        const bf16* K1 = (const bf16*)(P->ws + WS_PK1) + (size_t)L * 128 * 128; const bf16* K2 = (const bf16*)(P->ws + WS_PK2) + (size_t)L * 128 * 128;
        for (int c16 = tid; c16 < 2 * 128 * 16; c16 += NWAVES * 64) { const int mat = c16 >> 11, row = (c16 >> 4) & 127, ch = c16 & 15;
            const u32x4 w = *(const u32x4*)((mat ? K2 : K1) + row * 128 + ch * 8);
            *(LAS u32x4*)(lds + mat * 32768 + row * 256 + ((ch ^ (row & 15)) * 16)) = w; }
    }
    __syncthreads();
    LAS unsigned* sc = (LAS unsigned*)(lds + 65536) + wid * 2048;
    const int r32 = lane & 31, hi = lane >> 5;
    for (int item = gw; item < Mrows / 4; item += NGW) {
        const int tok = item * 4 + (r32 >> 3), head = r32 & 7;
        unsigned top0[16], top1[16];
        route_pass<0>(QP, lds, tok, head, r32, hi, top0);
        route_pass<1>(QP, lds, tok, head, r32, hi, top1);
        float v1[16], v2[16];
#pragma unroll
        for (int i = 0; i < 16; ++i) { v1[i] = ord2f(top0[i] & ~127u); v2[i] = ord2f(top1[i] & ~127u);
            sc[i * 64 + lane] = 127u - (top0[i] & 127u); sc[(16 + i) * 64 + lane] = 127u - (top1[i] & 127u); }
        unsigned ck[64]; int n = 0;
#pragma unroll
        for (int i = 0; i < 16; ++i)
#pragma unroll
            for (int j = 0; j < 16; ++j) if ((i + 1) * (j + 1) <= 16) { ck[n] = (f2ord(v1[i] + v2[j]) & ~255u) | (unsigned)(i * 16 + j); ++n; }
#pragma unroll
        for (int i = 50; i < 64; ++i) ck[i] = 0u;
        top16_of_64(ck);
        float ev[16]; float sum = 0.f; const float mx = ord2f(ck[0] & ~255u);
#pragma unroll
        for (int k = 0; k < 16; ++k) { ev[k] = __expf(ord2f(ck[k] & ~255u) - mx); sum += ev[k]; }
        const float inv = 1.0f / sum;
        unsigned ee[16];
#pragma unroll
        for (int k = 0; k < 16; ++k) { const unsigned pc = ck[k] & 255u; const unsigned i1 = sc[(pc >> 4) * 64 + lane], i2 = sc[(16 + (pc & 15u)) * 64 + lane]; ee[k] = i1 * 128u + i2; ev[k] *= inv; }
        u32x4* outp = (u32x4*)(ROUTE + ((size_t)tok * 128 + head * 16 + hi * 8) * 2);
#pragma unroll
        for (int k = 0; k < 8; k += 2) { u32x4 w;
            const unsigned eL0 = ee[k], eH0 = ee[k + 8], eL1 = ee[k + 1], eH1 = ee[k + 9]; const float gL0 = ev[k], gH0 = ev[k + 8], gL1 = ev[k + 1], gH1 = ev[k + 9];
            w.x = hi ? eH0 : eL0; w.y = __float_as_uint(hi ? gH0 : gL0); w.z = hi ? eH1 : eL1; w.w = __float_as_uint(hi ? gH1 : gL1);
            outp[k >> 1] = w; }
    }
}

typedef float f32x2 __attribute__((ext_vector_type(2)));
typedef float f32x32 __attribute__((ext_vector_type(32)));
typedef unsigned u32x6 __attribute__((ext_vector_type(6)));
typedef __bf16 bf16x32 __attribute__((ext_vector_type(32)));
typedef unsigned u32x16 __attribute__((ext_vector_type(16)));
typedef __bf16 bf16x2_t __attribute__((ext_vector_type(2)));
constexpr int GS = 6, GSLOT = 2 * PROW;
__device__ __forceinline__ void glds16(const void* gsrc, unsigned lds_dst) { unsigned keep;
  asm volatile("s_mov_b32 %0, m0\n\ts_mov_b32 m0, %2\n\ts_nop 0\n\tglobal_load_lds_dwordx4 %1, off\n\ts_mov_b32 m0, %0" : "=&s"(keep) : "v"(gsrc), "s"(lds_dst) : "memory"); }
template <int GMODE = 0>
__device__ __forceinline__ void gather_phase(CP P, int L, int Mrows, LAS unsigned char* lds, int wid, int lane_, int gw, int NGW, bool dry = false) {
    const unsigned char* U = P->ws + WS_PU + (size_t)L * 16384 * PROW; const unsigned char* V = P->ws + WS_PV + (size_t)L * 16384 * PROW;
    const unsigned* ROUTE = (const unsigned*)(P->ws + WS_ROUTE); const float* MOD = (const float*)(P->ws + WS_MOD);
    bf16* X = (bf16*)(P->ws + WS_X); bf16* H = (bf16*)(P->ws + WS_H); bf16* Xo = dry ? (bf16*)(P->ws + WS_Y) : X; bf16* Ho = dry ? (bf16*)(P->ws + WS_G) : H;
    const float* lng = P->in[6] + (size_t)(L * 2 + 1) * DM; const float* lnb = P->in[7] + (size_t)(L * 2 + 1) * DM;
    const unsigned ring = (unsigned)(uintptr_t)lds + (unsigned)wid * (GS * GSLOT);
    for (int row = gw; row < Mrows; row += NGW) {
        const int lane = launder_v(lane_);
        const u32x2 ea = ((const u32x2*)(ROUTE + (size_t)row * 256))[lane], eb = ((const u32x2*)(ROUTE + (size_t)row * 256))[64 + lane];
        unsigned eax, eay, ebx, eby;
        unsigned hw[16];
#pragma unroll
        for (int j = 0; j < 4; ++j) { const u32x4 w = ((const u32x4*)(H + (size_t)row * DM))[4 * lane + j]; hw[4 * j] = w.x; hw[4 * j + 1] = w.y; hw[4 * j + 2] = w.z; hw[4 * j + 3] = w.w; }
        float y[32];
#pragma unroll
        for (int i = 0; i < 32; ++i) y[i] = 0.f;
        { unsigned e0 = ea.x, e1 = ea.y, e2 = eb.x, e3 = eb.y;
          asm volatile("" : "+v"(e0), "+v"(e1), "+v"(e2), "+v"(e3), "+v"(hw[0]), "+v"(hw[1]), "+v"(hw[2]), "+v"(hw[3]), "+v"(hw[4]), "+v"(hw[5]), "+v"(hw[6]), "+v"(hw[7]),
                       "+v"(hw[8]), "+v"(hw[9]), "+v"(hw[10]), "+v"(hw[11]), "+v"(hw[12]), "+v"(hw[13]), "+v"(hw[14]), "+v"(hw[15]) :: "memory");
          eax = e0; eay = e1; ebx = e2; eby = e3; }
        const unsigned rd_a = ring + 16u * (unsigned)lane, rd_b = ring + 1024u + 8u * (unsigned)lane;
#define G_ISSUE(k) do { const int k_ = (k); const unsigned e_ = (unsigned)__builtin_amdgcn_readlane((int)(k_ < 64 ? eax : ebx), k_ & 63); \
        const unsigned char* up_ = U + (size_t)e_ * PROW + 16 * lane; const unsigned char* vp_ = V + (size_t)e_ * PROW + 16 * lane; const unsigned sb_ = ring + (unsigned)(k_ % GS) * GSLOT; \
        if (GMODE != 2) { glds16(up_, sb_); glds16(vp_, sb_ + PROW); if (lane < 32) { glds16(up_ + 1024, sb_ + 1024); glds16(vp_ + 1024, sb_ + PROW + 1024); } } else { asm volatile("" :: "v"(up_), "v"(vp_), "s"(sb_)); } } while (0)
#pragma unroll
        for (int k = 0; k < 4; ++k) G_ISSUE(k);
#define G_READ(k, ua, ub, va, vb) do { const unsigned so_ = (unsigned)((k) % GS) * GSLOT; \
        asm volatile("ds_read_b128 %0, %4\n\tds_read_b64 %1, %5\n\tds_read_b128 %2, %4 offset:1536\n\tds_read_b64 %3, %5 offset:1536" \
                     : "=&v"(ua), "=&v"(ub), "=&v"(va), "=&v"(vb) : "v"(rd_a + so_), "v"(rd_b + so_) : "memory"); } while (0)
#pragma unroll 1
        for (int k = 0; k < 128; k += 2) {
            if (k + 4 < 128) { G_ISSUE(k + 4); G_ISSUE(k + 5); asm volatile("s_waitcnt vmcnt(16)" ::: "memory"); }
            else if (k == 124) asm volatile("s_waitcnt vmcnt(8)" ::: "memory");
            else asm volatile("s_waitcnt vmcnt(0)" ::: "memory");
            u32x4 uaA, vaA, uaB, vaB; u32x2 ubA, vbA, ubB, vbB;
            G_READ(k, uaA, ubA, vaA, vbA); G_READ(k + 1, uaB, ubB, vaB, vbB);
            asm volatile("s_waitcnt lgkmcnt(0)" : "+v"(uaA), "+v"(ubA), "+v"(vaA), "+v"(vbA), "+v"(uaB), "+v"(ubB), "+v"(vaB), "+v"(vbB) :: "memory");
            if (GMODE == 1) continue;
            const u32x6 u6A = {uaA.x, uaA.y, uaA.z, uaA.w, ubA.x, ubA.y}, u6B = {uaB.x, uaB.y, uaB.z, uaB.w, ubB.x, ubB.y};
            const u32x16 ubfA = __builtin_bit_cast(u32x16, __builtin_amdgcn_cvt_scalef32_pk32_bf16_fp6(u6A, 1.0f));
            const u32x16 ubfB = __builtin_bit_cast(u32x16, __builtin_amdgcn_cvt_scalef32_pk32_bf16_fp6(u6B, 1.0f));
            float a0 = 0.f, a1 = 0.f, b0 = 0.f, b1 = 0.f;
#pragma unroll
            for (int q = 0; q < 16; q += 2) { const unsigned h0_ = hw[q], h1_ = hw[q + 1], x0_ = ubfA[q], x1_ = ubfA[q + 1], z0_ = ubfB[q], z1_ = ubfB[q + 1];
                a0 = __builtin_amdgcn_fdot2_f32_bf16(__builtin_bit_cast(bf16x2_t, h0_), __builtin_bit_cast(bf16x2_t, x0_), a0, false);
                a1 = __builtin_amdgcn_fdot2_f32_bf16(__builtin_bit_cast(bf16x2_t, h1_), __builtin_bit_cast(bf16x2_t, x1_), a1, false);
                b0 = __builtin_amdgcn_fdot2_f32_bf16(__builtin_bit_cast(bf16x2_t, h0_), __builtin_bit_cast(bf16x2_t, z0_), b0, false);
                b1 = __builtin_amdgcn_fdot2_f32_bf16(__builtin_bit_cast(bf16x2_t, h1_), __builtin_bit_cast(bf16x2_t, z1_), b1, false); }
            const float dA = wave_sum(a0 + a1) * (1.0f / U_SCALE), dB = wave_sum(b0 + b1) * (1.0f / U_SCALE);
            const unsigned gsel = k < 64 ? eay : eby;
            const float wA = __uint_as_float((unsigned)__builtin_amdgcn_readlane((int)gsel, k & 63)) * gelu_tanh(dA) * (1.0f / V_SCALE);
            const float wB = __uint_as_float((unsigned)__builtin_amdgcn_readlane((int)gsel, (k & 63) + 1)) * gelu_tanh(dB) * (1.0f / V_SCALE);
            const u32x6 v6A = {vaA.x, vaA.y, vaA.z, vaA.w, vbA.x, vbA.y};
            const f32x32 vfA = __builtin_amdgcn_cvt_scalef32_pk32_f32_fp6(v6A, 1.0f);
#pragma unroll
            for (int i = 0; i < 32; ++i) y[i] += wA * vfA[i];
            const u32x6 v6B = {vaB.x, vaB.y, vaB.z, vaB.w, vbB.x, vbB.y};
            const f32x32 vfB = __builtin_amdgcn_cvt_scalef32_pk32_f32_fp6(v6B, 1.0f);
#pragma unroll
            for (int i = 0; i < 32; ++i) y[i] += wB * vfB[i];
        }
#undef G_READ
#undef G_ISSUE
        const int slot = row_slot(row);
        const float* mod = MOD + (size_t)(L * 3 + slot) * 12288;
        const int le = launder_v(lane);
        { float xx[32], gg[32]; load_row_bf16_b(X + (size_t)row * DM, le, xx); load_row_f32_b(mod + 5 * 2048, le, gg);
#pragma unroll
          for (int i = 0; i < 32; ++i) y[i] = ALPHA * xx[i] + gg[i] * y[i]; }
        if (L < NLAYER - 1) { const float* modn = MOD + (size_t)((L + 1) * 3 + slot) * 12288;
            finish_row<true>(y, lng, lnb, Xo + (size_t)row * DM, modn, modn + 2048, Ho + (size_t)row * DM, nullptr, le); }
        else finish_row<true>(y, lng, lnb, nullptr, nullptr, nullptr, nullptr, P->out + (size_t)row * DM, le);
        asm volatile("s_waitcnt vmcnt(0)" ::: "memory");
    }
}

#ifndef PROBE_DUP
#define PROBE_DUP 0
#endif
#define NOINL __forceinline__
__device__ __forceinline__ CP launder_cp(CP p) { asm volatile("" : "+s"(p)); return p; }
#define GETP() launder_cp((CP)__builtin_amdgcn_kernarg_segment_ptr())
__device__ __forceinline__ int uni(int v) { return __builtin_amdgcn_readfirstlane(v); }
__device__ __forceinline__ LAS unsigned char* uni_lds(LAS unsigned char* p) { return (LAS unsigned char*)(unsigned)__builtin_amdgcn_readfirstlane((int)(unsigned)(uintptr_t)p); }
#define PH_IDS const int tid = launder_v(threadIdx.x), lane = tid & 63, wid = __builtin_amdgcn_readfirstlane(tid >> 6); const int gw = blockIdx.x * NWAVES + wid, NGW = gridDim.x * NWAVES; (void)lane; (void)gw; (void)NGW;

__device__ NOINL void ph_prologue(LAS unsigned char* lds_) { CP P = GETP(); LAS unsigned char* lds = uni_lds(lds_); PH_IDS p0_prologue(P, lds, tid, lane, wid, gw, NGW); if (PROBE_DUP == 5) p0_prologue(P, lds, tid, lane, wid, gw, NGW); }
__device__ NOINL void ph_modreduce() { CP P = GETP(); PH_IDS mod_reduce(P, gw, lane, NGW); }
__device__ NOINL void ph_first() { CP P = GETP(); PH_IDS
#pragma unroll 1
    for (int rep = 0; rep < (PROBE_DUP == 6 ? 2 : 1); ++rep) first_row_pass(P, lane, gw, NGW); }
__device__ NOINL void ph_postmix(int L_, int M_) { CP P = GETP(); const int L = uni(L_), Mrows = uni(M_); PH_IDS post_mixer_pass(P, L, Mrows, lane, gw, NGW); }
__device__ NOINL void ph_vstats(int M_) { CP P = GETP(); const int Mrows = uni(M_); PH_IDS
#pragma unroll 1
    for (int rep = 0; rep < (PROBE_DUP == 6 ? 2 : 1); ++rep) vstats_pass(P, Mrows, lane, gw, NGW); }
__device__ NOINL void ph_spatial(LAS unsigned char* lds_, int j_, int M_) { CP P = GETP(); LAS unsigned char* lds = uni_lds(lds_); const int j = uni(j_), Mrows = uni(M_); PH_IDS
#pragma unroll 1
    for (int rep = 0; rep < (PROBE_DUP == 6 ? 2 : 1); ++rep) spatial_phase(P, j, Mrows, lds, tid, lane, wid); }
__device__ NOINL void ph_mla_norm() { CP P = GETP(); PH_IDS
#pragma unroll 1
    for (int rep = 0; rep < (PROBE_DUP == 6 ? 2 : 1); ++rep) mla_norm_pass(P, lane, gw, NGW); }
__device__ NOINL void ph_rope(int which_) { CP P = GETP(); const int which = uni(which_); PH_IDS
    if (which == 0) rope_pass((bf16*)(P->ws + WS_QM), 3072, 128, 16, 192, lane, gw, NGW);
    else rope_pass((bf16*)(P->ws + WS_Z), 6144, 0, 64, 64, lane, gw, NGW); }
__device__ NOINL void ph_attn_mla(LAS unsigned char* lds_) { CP P = GETP(); LAS unsigned char* lds = uni_lds(lds_); mla_attn_phase(P, lds); if (PROBE_DUP == 2) mla_attn_phase(P, lds); }
__device__ NOINL void ph_attn_da(LAS unsigned char* lds_, int L_) { CP P = GETP(); LAS unsigned char* lds = uni_lds(lds_); const int L = uni(L_); const int lane = launder_v(threadIdx.x) & 63;
    const float* lp = P->in[26];
    const float s01 = wave_sum(lp[lane] * lp[64 + lane]), s23 = wave_sum(lp[128 + lane] * lp[192 + lane]);
    const float lam_init = 0.8f - 0.6f * expf(-0.3f * (float)L);
    const float lam = expf(s01) - expf(s23) + lam_init;
    da_attn_phase(P, lam, 1.0f - lam_init, lds); if (PROBE_DUP == 2) da_attn_phase(P, lam, 1.0f - lam_init, lds); }
__device__ NOINL void ph_route(LAS unsigned char* lds_, int L_, int M_) { CP P = GETP(); LAS unsigned char* lds = uni_lds(lds_); const int L = uni(L_), Mrows = uni(M_); PH_IDS
#pragma unroll 1
    for (int rep = 0; rep < (PROBE_DUP == 4 ? 2 : 1); ++rep) route_phase(P, L, Mrows, lds, tid, lane, wid, gw, NGW); }
__device__ NOINL void ph_gather(LAS unsigned char* lds_, int L_, int M_) { CP P = GETP(); LAS unsigned char* lds = uni_lds(lds_); const int L = uni(L_), Mrows = uni(M_); PH_IDS
    if (PROBE_DUP == 3) { gather_phase<0>(P, L, Mrows, lds, wid, lane, gw, NGW, true); }
    if (PROBE_DUP == 7) { gather_phase<1>(P, L, Mrows, lds, wid, lane, gw, NGW, true); }
    if (PROBE_DUP == 8) { gather_phase<2>(P, L, Mrows, lds, wid, lane, gw, NGW, true); }
    gather_phase<0>(P, L, Mrows, lds, wid, lane, gw, NGW); }

enum GemmId { G_GM_IN = 0, G_GM_OUT, G_MLA_IN, G_MLA_UQ, G_MLA_UKV, G_MLA_OUT, G_DA_IN, G_DA_OUT, G_PEER_Q };
__device__ NOINL void ph_gemm(LAS unsigned char* lds_, int id_, int L_, int M_) {
    CP P = GETP(); LAS unsigned char* lds = uni_lds(lds_); const int id = uni(id_), L = uni(L_), Mrows = uni(M_);
    unsigned char* ws = P->ws; const int jj = L / 3;
    size_t a = WS_H, b = 0, o = 0; int M = MT, N = 2048, K = 2048, act = 0;
    switch (id) {
        case G_GM_IN:   a = WS_H;    b = WS_GMWIN + (size_t)jj * 4096 * 2048 * 2;  o = WS_Z;  M = Mrows; N = 4096; K = 2048; act = 1; break;
        case G_GM_OUT:  a = WS_G;    b = WS_GMWOUT + (size_t)jj * 2048 * 2048 * 2; o = WS_Y;  M = Mrows; N = 2048; K = 2048; break;
        case G_MLA_IN:  a = WS_H;    b = WS_MLAIN;  o = WS_C;  N = 1280; K = 2048; break;
        case G_MLA_UQ:  a = WS_CQN;  b = WS_MLAUQ;  o = WS_QM; N = 3072; K = 512;  break;
        case G_MLA_UKV: a = WS_CKVN; b = WS_MLAUKV; o = WS_KV; N = 4096; K = 512;  break;
        case G_MLA_OUT: a = WS_G;    b = WS_MLAOUT; o = WS_Y;  N = 2048; K = 2048; break;
        case G_DA_IN:   a = WS_H;    b = WS_DAIN;   o = WS_Z;  N = 6144; K = 2048; break;
        case G_DA_OUT:  a = WS_G;    b = WS_DAOUT;  o = WS_Y;  N = 2048; K = 2048; break;
        default:        a = WS_H;    b = WS_PWQ + (size_t)L * 2048 * 2048 * 2;     o = WS_QP; M = Mrows; N = 2048; K = 2048; break;
    }
    pg8::Gemm g{(const pg8::bf16_t*)(ws + a), (const pg8::bf16_t*)(ws + b), M, N, K}; pg8::StaticOrder S; S.init(M, N, (int)gridDim.x, (int)blockIdx.x);
    pg8::EpiR E{(pg8::bf16_t*)(ws + o), N, act};
#pragma unroll 1
    for (int rep = 0; rep < (PROBE_DUP == 1 ? 2 : 1); ++rep) { pg8::gemm_phase<pg8::EpiR, pg8::StaticOrder, true, true>((PG8_LAS unsigned char*)lds, g, S, E); __syncthreads(); }
}

__global__ void __launch_bounds__(NWAVES * 64, 2) mk_fwd(Params Pv) {
    extern __shared__ __attribute__((aligned(16))) unsigned char lds_g[];
    LAS unsigned char* lds = (LAS unsigned char*)lds_g;
    const int tid = threadIdx.x;
    for (int u = tid; u < (LDS_BYTES - RING_BYTES) / 4; u += NWAVES * 64) ((LAS unsigned*)(lds + RING_BYTES))[u] = 0u;
    __syncthreads();
    const int lo = Pv.ph_lo, hi = Pv.ph_hi;
    unsigned* barw = (unsigned*)(Pv.ws + WS_CTL) + CW_BAR;
    XcdBarrier bar; bar.bar = barw; bar.x = 0; bar.st = nullptr;
    if (hi - lo > 1) bar = xcd_barrier_post(barw, (volatile LAS unsigned*)(lds + MISC_OFF) + 8);
    int ph = 0;
#ifndef SEL
#define SELP(k) true
#else
#define SELP(k) ((k) == SEL)
#endif
    enum { RUN_BASE = __COUNTER__ + 1 };
#define RUN(call) do { if (SELP(__COUNTER__ - RUN_BASE) && ph >= lo && ph < hi) { call; } if (ph >= lo && ph + 1 < hi) xcd_barrier(bar); ++ph; } while (0)
    RUN(ph_prologue(lds));
    RUN(ph_modreduce());
    RUN(ph_first());
    for (int L = 0; L < NLAYER; ++L) {
        const int kind = L % 3, jj = L / 3;
        const int Mrows = (L == NLAYER - 1) ? ML : MT;
        if (kind == 0) {
            RUN(ph_gemm(lds, G_GM_IN, L, Mrows));
            RUN(ph_vstats(Mrows));
            RUN(ph_spatial(lds, jj, Mrows));
            RUN(ph_gemm(lds, G_GM_OUT, L, Mrows));
        } else if (kind == 1) {
            RUN(ph_gemm(lds, G_MLA_IN, L, Mrows));
            RUN(ph_mla_norm());
            RUN(ph_gemm(lds, G_MLA_UQ, L, Mrows); ph_gemm(lds, G_MLA_UKV, L, Mrows));
            RUN(ph_rope(0));
            RUN(ph_attn_mla(lds));
            RUN(ph_gemm(lds, G_MLA_OUT, L, Mrows));
        } else {
            RUN(ph_gemm(lds, G_DA_IN, L, Mrows));
            RUN(ph_rope(1));
            RUN(ph_attn_da(lds, L));
            RUN(ph_gemm(lds, G_DA_OUT, L, Mrows));
        }
        RUN(ph_postmix(L, Mrows));
        RUN(ph_gemm(lds, G_PEER_Q, L, Mrows));
        RUN(ph_route(lds, L, Mrows));
        RUN(ph_gather(lds, L, Mrows));
    }
#undef RUN
}

extern "C" void kernel_launch(void* const* d_in, const int* in_sizes, int n_in, void* d_out, int out_size, void* d_ws, size_t ws_size, hipStream_t stream) {
    static int grid = 0;
    if (grid == 0) {
        if (n_in != 29 || in_sizes[0] != ML * DM || out_size != ML * DM || ws_size < WS_END) {
            fprintf(stderr, "kernel_launch: shape mismatch: n_in %d in0 %d out %d ws %zu (need %zu); nothing launched\n", n_in, n_in > 0 ? in_sizes[0] : -1, out_size, ws_size, (size_t)WS_END); grid = -1; return; }
        int dev = 0, cus = 0, per_cu = 0;
        if (hipGetDevice(&dev) != hipSuccess || hipDeviceGetAttribute(&cus, hipDeviceAttributeMultiprocessorCount, dev) != hipSuccess) { fprintf(stderr, "kernel_launch: device query failed\n"); grid = -1; return; }
        if (hipFuncSetAttribute((const void*)mk_fwd, hipFuncAttributeMaxDynamicSharedMemorySize, LDS_BYTES) != hipSuccess) { fprintf(stderr, "kernel_launch: hipFuncSetAttribute failed\n"); grid = -1; return; }
        if (hipOccupancyMaxActiveBlocksPerMultiprocessor(&per_cu, (const void*)mk_fwd, NWAVES * 64, LDS_BYTES) != hipSuccess || per_cu < 1)
            fprintf(stderr, "kernel_launch: note: occupancy query reports %d workgroups per CU\n", per_cu);
        (void)hipGetLastError();
        grid = cus;
    }
    if (grid < 0) return;
    if (hipMemsetAsync((char*)d_ws + WS_CTL, 0, CTL_ZERO_BYTES, stream) != hipSuccess) { fprintf(stderr, "kernel_launch: memset failed\n"); return; }
    Params p{};
    for (int i = 0; i < 29; ++i) p.in[i] = (const float*)d_in[i];
    p.out = (float*)d_out; p.ws = (unsigned char*)d_ws;
#if MK_ONE_LAUNCH
    p.ph_lo = 0; p.ph_hi = NPH;
    hipLaunchKernelGGL(mk_fwd, dim3(grid), dim3(NWAVES * 64), LDS_BYTES, stream, p);
#else
    for (int li = 0; li < NPH; ++li) { p.ph_lo = li; p.ph_hi = li + 1; hipLaunchKernelGGL(mk_fwd, dim3(grid), dim3(NWAVES * 64), LDS_BYTES, stream, p); }
#endif
    const hipError_t le = hipPeekAtLastError();
    if (le != hipSuccess) fprintf(stderr, "kernel_launch: launch failed: %s\n", hipGetErrorName(le));
}
```

```cpp
#include <hip/hip_runtime.h>
#include <cstdio>
#include <cstdint>
#ifndef MK_ONE_LAUNCH
#define MK_ONE_LAUNCH 1
#endif
__device__ __forceinline__ int launder_v(int v) { asm volatile("" : "+v"(v)); return v; }
__device__ __forceinline__ int lane_id_fresh() { unsigned m = ~0u; asm volatile("" : "+s"(m)); return (int)__builtin_amdgcn_mbcnt_hi(m, __builtin_amdgcn_mbcnt_lo(m, 0u)); }
namespace pg8 {
#define PG8_LAS __attribute__((address_space(3)))
typedef unsigned short bf16_t;
typedef short bf16x8 __attribute__((ext_vector_type(8)));
typedef float f32x4 __attribute__((ext_vector_type(4)));
typedef unsigned u32x4 __attribute__((ext_vector_type(4)));
constexpr int BM = 256, BK = 64, HALF = 128, HTB = HALF * BK * 2  , STAGE_BYTES = 8 * HTB, NXCD = 8, WGM = 8;

__host__ __device__ __forceinline__ int lds_byte(int r, int c) { const int st = (r >> 4) * 2 + (c >> 5), rr = r & 15, cc = c & 31, ob = rr * 64 + cc * 2; return st * 1024 + (ob ^ (((ob >> 9) & 1) << 5)); }
__host__ __device__ __forceinline__ void stage_rc(int b, int& R, int& C) { const int st = b / 1024, sb = b % 1024, swz = sb ^ (((sb >> 9) & 1) << 5); R = (st >> 1) * 16 + swz / 64; C = (st & 1) * 32 + (swz % 64) / 2; }
__host__ __device__ __forceinline__ int perm32(int rho) { const int n = rho >> 4, i = rho & 15; return 8 * (i >> 2) + 4 * n + (i & 3); }

struct Unit { int pm, pn; };
struct Gemm { const bf16_t* A; const bf16_t* Bt; int M, N, K; };

struct StaticOrder {
    int nM, nN, nwg, G, c;
    __host__ __device__ void init(int M, int N, int G_, int c_) { nM = M / BM; nN = N / BM; nwg = nM * nN; G = G_; c = c_; }
    __host__ __device__ bool next(int i, Unit& u) const {
        const long L = (long)i * G + c; if (L >= nwg) return false;
        int wgid = (int)L; { const int q = nwg / NXCD, r = nwg % NXCD, xcd = wgid % NXCD, off = wgid / NXCD; wgid = (xcd < r ? xcd * (q + 1) : r * (q + 1) + (xcd - r) * q) + off; }
        const int nig = WGM * nN, gid = wgid / nig, fm = gid * WGM, gsz = (nM - fm) < WGM ? (nM - fm) : WGM;
        u.pm = fm + ((wgid % nig) % gsz); u.pn = (wgid % nig) / gsz; return true;
    }
    __device__ __forceinline__ void a_ready(const Unit&) const {}
    __device__ __forceinline__ void done(const Unit&) const {}
};

__device__ __forceinline__ unsigned cvt_pk_bf16(float lo, float hi) { unsigned r; asm volatile("v_cvt_pk_bf16_f32 %0, %1, %2" : "=v"(r) : "v"(lo), "v"(hi)); return r; }
typedef float f32x2 __attribute__((ext_vector_type(2)));
__device__ __forceinline__ f32x2 gelu_pk(f32x2 v) {
    const f32x2 av = __builtin_elementwise_abs(v), d = av * 0.2316418882f + 1.0f;
    f32x2 t; t.x = __builtin_amdgcn_rcpf(d.x); t.y = __builtin_amdgcn_rcpf(d.y);
    f32x2 q = t * 0.5307027145f + (-0.7265760135f); q = q * t + 0.7107068705f; q = q * t + (-0.142248368f); q = q * t + 0.127414796f; q = q * t;
    const f32x2 s = (v * v) * (-0.72134752044f);
    f32x2 e; e.x = __builtin_amdgcn_exp2f(s.x); e.y = __builtin_amdgcn_exp2f(s.y);
    const f32x2 m = v * (q * e), r = v - m;
    f32x2 o; o.x = v.x < 0.f ? m.x : r.x; o.y = v.y < 0.f ? m.y : r.y; return o;
}

template <int ACT  > struct EpiBf16 {
    static constexpr bool PERM = true, AFTER_DRAIN = false; static_assert(ACT == 0 || ACT == 1, "EpiBf16: ACT is 0 (none) or 1 (gelu_pk)");
    bf16_t* O; int ldc; const float* bias; int split_cols; size_t split_stride; float scale0;
    __device__ __forceinline__ void operator()(const f32x4 (&acc)[2][2][4][2], const Unit& u, int wr, int wc, int fr, int fq) const {
        const int row0 = u.pm * BM + wr * 64 + fr; int colt = u.pn * BM; bf16_t* base = O;
        float sc = 1.f; if (split_cols) { const int t = colt / split_cols; base += (size_t)t * split_stride; colt -= t * split_cols; if (t == 0) sc = scale0; }
        const int col0 = colt + wc * 32 + 8 * fq, bcol0 = u.pn * BM + wc * 32 + 8 * fq;
        f32x4 bv[2][2];
#pragma unroll
        for (int bj = 0; bj < 2; ++bj)
#pragma unroll
            for (int n = 0; n < 2; ++n) bv[bj][n] = bias ? *(const f32x4*)(bias + bcol0 + bj * HALF + 4 * n) : (f32x4){0.f, 0.f, 0.f, 0.f};
#pragma unroll
        for (int ai = 0; ai < 2; ++ai)
#pragma unroll
            for (int m = 0; m < 4; ++m) { bf16_t* rowp = base + (size_t)(row0 + ai * HALF + m * 16) * ldc + col0;
#pragma unroll
                for (int bj = 0; bj < 2; ++bj) { f32x4 v0 = acc[ai][bj][m][0] + bv[bj][0], v1 = acc[ai][bj][m][1] + bv[bj][1];
                    if (ACT == 1) { f32x2 a = gelu_pk((f32x2){v0[0], v0[1]}), b = gelu_pk((f32x2){v0[2], v0[3]}), c = gelu_pk((f32x2){v1[0], v1[1]}), d = gelu_pk((f32x2){v1[2], v1[3]});
                        v0 = (f32x4){a.x, a.y, b.x, b.y}; v1 = (f32x4){c.x, c.y, d.x, d.y}; }
                    v0 = v0 * sc; v1 = v1 * sc; u32x4 w; w.x = cvt_pk_bf16(v0[0], v0[1]); w.y = cvt_pk_bf16(v0[2], v0[3]); w.z = cvt_pk_bf16(v1[0], v1[1]); w.w = cvt_pk_bf16(v1[2], v1[3]);
                    *(u32x4*)(rowp + bj * HALF) = w; } }
    }
};
template <class Epi, class Sched, bool ALIGN_EPI = false, bool SP2 = false>
__device__ __forceinline__ void gemm_phase(PG8_LAS unsigned char* lds, const Gemm g, const Sched& S, const Epi& E, const int tid_in) {
    const int tid = launder_v(tid_in) & 511, wid = __builtin_amdgcn_readfirstlane(tid >> 6), lane = tid & 63, wr = wid >> 2, wc = wid & 3, fr = lane & 15, fq = lane >> 4;
    const int K = g.K, nt = K / BK;
    unsigned voffA[2], voffB[2];
#pragma unroll
    for (int i = 0; i < 2; ++i) { int R, C; stage_rc(tid * 16 + i * 8192, R, C); const int Rb = Epi::PERM ? ((R & ~31) + perm32(R & 31)) : R;
        voffA[i] = (unsigned)(R * K + C) * 2u; voffB[i] = (unsigned)(Rb * K + C) * 2u; }
    const size_t kstep = (size_t)(BK * 2);
    const size_t hstep = (size_t)HALF * K * 2;
    const size_t tstep = 2 * hstep;
    const unsigned ldsw = (unsigned)wid * 1024u;
    const int aoff = lds_byte(wr * 64 + fr, fq * 8), boff = lds_byte(wc * 32 + fr, fq * 8);
#define PG8_SA(b, h) (((b) * 2 + (h)) * HTB)
#define PG8_SB(b, h) ((4 + (b) * 2 + (h)) * HTB)
#define PG8_STAGE(bufoff, gbase, voff) do { _Pragma("unroll") for (int _i = 0; _i < 2; ++_i) \
        __builtin_amdgcn_global_load_lds((const unsigned*)((const char*)(gbase) + (voff)[_i]), (PG8_LAS unsigned*)(lds + (bufoff) + ldsw + _i * 8192), 16, 0, 0); } while (0)
#define PG8_LDA(dst, b, h) do { _Pragma("unroll") for (int m = 0; m < 4; ++m) _Pragma("unroll") for (int k = 0; k < 2; ++k) dst[m][k] = *(const PG8_LAS bf16x8*)(lds + PG8_SA(b, h) + aoff + m * 2048 + k * 1024); } while (0)
#define PG8_LDB(dst, b, h) do { _Pragma("unroll") for (int n = 0; n < 2; ++n) _Pragma("unroll") for (int k = 0; k < 2; ++k) dst[n][k] = *(const PG8_LAS bf16x8*)(lds + PG8_SB(b, h) + boff + n * 2048 + k * 1024); } while (0)
#define PG8_MMA(ai, bj, At, Bt) do { __builtin_amdgcn_s_setprio(1); _Pragma("unroll") for (int m = 0; m < 4; ++m) _Pragma("unroll") for (int n = 0; n < 2; ++n) _Pragma("unroll") for (int k = 0; k < 2; ++k) \
        acc[ai][bj][m][n] = __builtin_amdgcn_mfma_f32_16x16x32_bf16(Bt[n][k], At[m][k], acc[ai][bj][m][n], 0, 0, 0); __builtin_amdgcn_s_setprio(0); } while (0)
#define PG8_WAIT_V(n) asm volatile("s_waitcnt vmcnt(" #n ")" ::: "memory")
#define PG8_WAIT_L(n) asm volatile("s_waitcnt lgkmcnt(" #n ")" ::: "memory")
#define PG8_BAR __builtin_amdgcn_s_barrier()
#define PG8_SCHED __builtin_amdgcn_sched_barrier(0)
    Unit cur, nxt; int ui = 0;
    if (!S.next(0, cur)) return;
    f32x4 acc[2][2][4][2];
#pragma unroll
    for (int a = 0; a < 2; ++a)
#pragma unroll
        for (int b = 0; b < 2; ++b)
#pragma unroll
            for (int m = 0; m < 4; ++m)
#pragma unroll
                for (int n = 0; n < 2; ++n) acc[a][b][m][n] = (f32x4){0.f, 0.f, 0.f, 0.f};
    bf16x8 At[4][2], B0[2][2], B1[2][2];
    const char* cA = (const char*)g.A + (size_t)cur.pm * tstep; const char* cB = (const char*)g.Bt + (size_t)cur.pn * tstep;
    S.a_ready(cur);
    if constexpr (SP2) {
        PG8_STAGE(PG8_SB(0, 0), cB, voffB); PG8_STAGE(PG8_SB(0, 1), cB + hstep, voffB); PG8_STAGE(PG8_SA(0, 0), cA, voffA); PG8_STAGE(PG8_SA(0, 1), cA + hstep, voffA);
        if (wr == 1) PG8_BAR;
        PG8_WAIT_V(2); PG8_BAR;
        PG8_STAGE(PG8_SB(1, 0), cB + kstep, voffB); PG8_STAGE(PG8_SA(1, 0), cA + kstep, voffA); PG8_STAGE(PG8_SB(1, 1), cB + hstep + kstep, voffB);
        PG8_WAIT_V(6); PG8_BAR;
    } else {
        PG8_STAGE(PG8_SB(0, 0), cB, voffB); PG8_STAGE(PG8_SA(0, 0), cA, voffA); PG8_STAGE(PG8_SB(0, 1), cB + hstep, voffB); PG8_STAGE(PG8_SA(0, 1), cA + hstep, voffA);
        if (wr == 1) PG8_BAR;
        PG8_WAIT_V(4); PG8_BAR;
        PG8_STAGE(PG8_SB(1, 0), cB + kstep, voffB); PG8_STAGE(PG8_SA(1, 0), cA + kstep, voffA); PG8_STAGE(PG8_SB(1, 1), cB + hstep + kstep, voffB);
        PG8_WAIT_V(6); PG8_BAR;
    }
    for (;;) {
        const bool has_next = S.next(ui + 1, nxt);
        const char* nA = has_next ? (const char*)g.A + (size_t)nxt.pm * tstep : cA; const char* nB = has_next ? (const char*)g.Bt + (size_t)nxt.pn * tstep : cB;
        for (int t = 0; t < nt; t += 2) {
            const bool last = (t == nt - 2);
            const char* a1 = cA + (size_t)(t + 1) * kstep;
            const char* a2 = last ? nA : cA + (size_t)(t + 2) * kstep; const char* b2 = last ? nB : cB + (size_t)(t + 2) * kstep;
            const char* a3 = a2 + kstep; const char* b3 = b2 + kstep;
            if (last && has_next) S.a_ready(nxt);
            if constexpr (SP2) {
            PG8_LDB(B0, 0, 0); PG8_LDB(B1, 0, 1); PG8_SCHED; PG8_LDA(At, 0, 0); PG8_STAGE(PG8_SA(1, 1), a1 + hstep, voffA);
            PG8_WAIT_V(8); PG8_WAIT_L(0); PG8_BAR; PG8_MMA(0, 0, At, B0); PG8_MMA(0, 1, At, B1); PG8_BAR; PG8_SCHED;
            PG8_LDA(At, 0, 1); PG8_STAGE(PG8_SB(0, 0), b2, voffB); PG8_STAGE(PG8_SB(0, 1), b2 + hstep, voffB); PG8_STAGE(PG8_SA(0, 0), a2, voffA);
            PG8_WAIT_V(8); PG8_WAIT_L(0); PG8_BAR; PG8_MMA(1, 0, At, B0); PG8_MMA(1, 1, At, B1); PG8_BAR; PG8_SCHED;
            PG8_LDB(B0, 1, 0); PG8_LDB(B1, 1, 1); PG8_SCHED; PG8_LDA(At, 1, 0); PG8_STAGE(PG8_SA(0, 1), a2 + hstep, voffA);
            PG8_WAIT_V(8); PG8_WAIT_L(0); PG8_BAR; PG8_MMA(0, 0, At, B0); PG8_MMA(0, 1, At, B1); PG8_BAR; PG8_SCHED;
            PG8_LDA(At, 1, 1); PG8_STAGE(PG8_SB(1, 0), b3, voffB); PG8_STAGE(PG8_SB(1, 1), b3 + hstep, voffB); PG8_STAGE(PG8_SA(1, 0), a3, voffA);
            PG8_WAIT_V(8); PG8_WAIT_L(0); PG8_BAR; PG8_MMA(1, 0, At, B0); PG8_MMA(1, 1, At, B1); PG8_BAR; PG8_SCHED;
            } else {
            PG8_LDB(B0, 0, 0); PG8_SCHED; PG8_LDA(At, 0, 0); PG8_STAGE(PG8_SA(1, 1), a1 + hstep, voffA);
            PG8_WAIT_L(8); PG8_BAR; PG8_WAIT_L(0); PG8_MMA(0, 0, At, B0); PG8_BAR; PG8_SCHED;
            PG8_LDB(B1, 0, 1); PG8_STAGE(PG8_SB(0, 0), b2, voffB);
            PG8_BAR; PG8_WAIT_L(0); PG8_MMA(0, 1, At, B1); PG8_BAR;
            PG8_LDA(At, 0, 1); PG8_STAGE(PG8_SA(0, 0), a2, voffA);
            PG8_BAR; PG8_WAIT_L(0); PG8_MMA(1, 0, At, B0); PG8_BAR; PG8_SCHED;
            PG8_STAGE(PG8_SB(0, 1), b2 + hstep, voffB);
            PG8_WAIT_V(6); PG8_BAR; PG8_MMA(1, 1, At, B1); PG8_BAR;
            PG8_LDB(B0, 1, 0); PG8_SCHED; PG8_LDA(At, 1, 0); PG8_STAGE(PG8_SA(0, 1), a2 + hstep, voffA);
            PG8_WAIT_L(8); PG8_BAR; PG8_WAIT_L(0); PG8_MMA(0, 0, At, B0); PG8_BAR; PG8_SCHED;
            PG8_LDB(B1, 1, 1); PG8_STAGE(PG8_SB(1, 0), b3, voffB);
            PG8_BAR; PG8_WAIT_L(0); PG8_MMA(0, 1, At, B1); PG8_BAR;
            PG8_LDA(At, 1, 1); PG8_STAGE(PG8_SA(1, 0), a3, voffA);
            PG8_BAR; PG8_WAIT_L(0); PG8_MMA(1, 0, At, B0); PG8_BAR; PG8_SCHED;
            PG8_STAGE(PG8_SB(1, 1), b3 + hstep, voffB);
            PG8_WAIT_V(6); PG8_BAR; PG8_MMA(1, 1, At, B1); PG8_BAR;
            }
        }
        if constexpr (ALIGN_EPI) { if (wr == 0) PG8_BAR; }
        if constexpr (!Epi::AFTER_DRAIN) { E(acc, cur, wr, wc, fr, fq); S.done(cur); }
        if (!has_next) break;
#pragma unroll
        for (int a = 0; a < 2; ++a)
#pragma unroll
            for (int b = 0; b < 2; ++b)
#pragma unroll
                for (int m = 0; m < 4; ++m)
#pragma unroll
                    for (int n = 0; n < 2; ++n) acc[a][b][m][n] = (f32x4){0.f, 0.f, 0.f, 0.f};
        cur = nxt; cA = nA; cB = nB; ++ui;
        if constexpr (ALIGN_EPI) { if (wr == 1) PG8_BAR; }
    }
    PG8_WAIT_V(0);
    if constexpr (!ALIGN_EPI) { if (wr == 0) PG8_BAR; }
    PG8_BAR;
    if constexpr (Epi::AFTER_DRAIN) { E.fused(acc, cur, wr, wc, fr, fq, lds, wid, lane); S.done(cur); }
#undef PG8_SA
#undef PG8_SB
#undef PG8_STAGE
#undef PG8_LDA
#undef PG8_LDB
#undef PG8_MMA
#undef PG8_WAIT_V
#undef PG8_WAIT_L
#undef PG8_BAR
#undef PG8_SCHED
}
}

namespace pg8 {
__device__ __forceinline__ float gelu_tanh(float x) {
    const float t = x * (1.5957691216057308f + 0.07135481627f * x * x);
    const float e = __builtin_amdgcn_exp2f(-1.4426950408889634f * t);
    return x * __builtin_amdgcn_rcpf(1.0f + e);
}
template <int ACT> struct EpiT {
    static constexpr bool PERM = true, AFTER_DRAIN = false;
    bf16_t* O; int ldc;
    __device__ __forceinline__ void operator()(const f32x4 (&acc)[2][2][4][2], const Unit& u, int wr, int wc, int fr, int fq) const {
        const int row0 = u.pm * BM + wr * 64 + fr; const int col0 = u.pn * BM + wc * 32 + 8 * fq;
#pragma unroll
        for (int ai = 0; ai < 2; ++ai)
#pragma unroll
            for (int m = 0; m < 4; ++m) { bf16_t* rowp = O + (size_t)(row0 + ai * HALF + m * 16) * ldc + col0;
#pragma unroll
                for (int bj = 0; bj < 2; ++bj) { f32x4 v0 = acc[ai][bj][m][0], v1 = acc[ai][bj][m][1];
                    if (ACT == 2) { v0 = (f32x4){gelu_tanh(v0[0]), gelu_tanh(v0[1]), gelu_tanh(v0[2]), gelu_tanh(v0[3])}; v1 = (f32x4){gelu_tanh(v1[0]), gelu_tanh(v1[1]), gelu_tanh(v1[2]), gelu_tanh(v1[3])}; }
                    u32x4 w; w.x = cvt_pk_bf16(v0[0], v0[1]); w.y = cvt_pk_bf16(v0[2], v0[3]); w.z = cvt_pk_bf16(v1[0], v1[1]); w.w = cvt_pk_bf16(v1[2], v1[3]);
                    *(u32x4*)(rowp + bj * HALF) = w; } }
    }
};
struct EpiR {
    static constexpr bool PERM = true, AFTER_DRAIN = false;
    bf16_t* O; int ldc; int act; int rope; const float* ropet;
    __device__ __forceinline__ void operator()(const f32x4 (&acc)[2][2][4][2], const Unit& u, int wr, int wc, int fr, int fq) const {
        const int row0 = u.pm * BM + wr * 64 + fr; const int col0 = u.pn * BM + wc * 32 + 8 * fq;
        const bool rrows = rope != 0 && u.pm < 64;
#pragma unroll
        for (int ai = 0; ai < 2; ++ai)
#pragma unroll
            for (int m = 0; m < 4; ++m) { const int grow = row0 + ai * HALF + m * 16; bf16_t* rowp = O + (size_t)grow * ldc + col0;
#pragma unroll
                for (int bj = 0; bj < 2; ++bj) { f32x4 v0 = acc[ai][bj][m][0], v1 = acc[ai][bj][m][1];
                    if (act) { v0 = (f32x4){gelu_tanh(v0[0]), gelu_tanh(v0[1]), gelu_tanh(v0[2]), gelu_tanh(v0[3])}; v1 = (f32x4){gelu_tanh(v1[0]), gelu_tanh(v1[1]), gelu_tanh(v1[2]), gelu_tanh(v1[3])}; }
                    if (rrows) { const int blk = u.pn * 8 + bj * 4 + wc; const int b6 = blk % 6; const bool on = rope == 1 ? (blk < 128) : (b6 >= 4); const int half = rope == 1 ? (blk & 1) : (b6 - 4);
                        if (on) { const int t = grow & 8191; const int pos = half ? (t & 63) : (t >> 6);
                            const float* cp = ropet + pos * 16 + 8 * (fq & 1); const f32x4 c0 = *(const f32x4*)cp, c1 = *(const f32x4*)(cp + 4), s0 = *(const f32x4*)(cp + 2048), s1 = *(const f32x4*)(cp + 2052);
                            f32x4 p0, p1;
#pragma unroll
                            for (int i = 0; i < 4; ++i) { const float a_ = v0[i], b_ = v1[i];
                                const auto r0 = __builtin_amdgcn_permlane32_swap(__float_as_uint(a_), __float_as_uint(a_), false, false);
                                const auto r1 = __builtin_amdgcn_permlane32_swap(__float_as_uint(b_), __float_as_uint(b_), false, false);
                                const unsigned x0_ = (fq & 2) ? r0[0] : r0[1], x1_ = (fq & 2) ? r1[0] : r1[1]; p0[i] = __uint_as_float(x0_); p1[i] = __uint_as_float(x1_); }
                            if (fq & 2) { v0 = p0 * s0 + v0 * c0; v1 = p1 * s1 + v1 * c1; } else { v0 = v0 * c0 - p0 * s0; v1 = v1 * c1 - p1 * s1; } } }
                    u32x4 w; w.x = cvt_pk_bf16(v0[0], v0[1]); w.y = cvt_pk_bf16(v0[2], v0[3]); w.z = cvt_pk_bf16(v1[0], v1[1]); w.w = cvt_pk_bf16(v1[2], v1[3]);
                    *(u32x4*)(rowp + bj * HALF) = w; } }
    }
};
}

constexpr int DM = 2048, NBATCH = 2, SEQ = 8192, CTXL = 256;
constexpr int ML = NBATCH * SEQ;
constexpr int MC = NBATCH * CTXL;
constexpr int MT = ML + MC;
constexpr int NLAYER = 4;
constexpr float ALPHA = 1.6817928305074290f, LN_EPS = 1e-6f;
constexpr int NWAVES = 8;
constexpr float U_SCALE = 64.0f, V_SCALE = 4.0f;
constexpr int PROW = 1536;
constexpr int NPH = 35;

constexpr size_t MiB = 1ull << 20;
constexpr size_t WS_CTL = 0, CTL_ZERO_BYTES = 1 * MiB;
constexpr int    CW_BAR = 4096;
constexpr size_t WS_MOD = 128 * 1024;
constexpr size_t WS_VST = 1 * MiB;
constexpr size_t WS_ROPE = 1 * MiB + 160 * 1024;
constexpr size_t WS_MODP = 1 * MiB + 256 * 1024;
constexpr size_t WS_GMWIN = 6 * MiB;
constexpr size_t WS_GMWOUT = WS_GMWIN + 32 * MiB;
constexpr size_t WS_GMWS = WS_GMWOUT + 16 * MiB;
constexpr size_t WS_PWQ = WS_GMWS + 1 * MiB;
constexpr size_t WS_PK1 = WS_PWQ + 32 * MiB;
constexpr size_t WS_PK2 = WS_PK1 + 512 * 1024;
constexpr size_t WS_MLAIN = WS_PK1 + 1 * MiB;
constexpr size_t WS_MLAUQ = WS_MLAIN + 5 * MiB;
constexpr size_t WS_MLAUKV = WS_MLAUQ + 3 * MiB;
constexpr size_t WS_MLAOUT = WS_MLAUKV + 4 * MiB;
constexpr size_t WS_DAIN = WS_MLAOUT + 8 * MiB;
constexpr size_t WS_DAOUT = WS_DAIN + 24 * MiB;
constexpr size_t WS_PU = WS_DAOUT + 8 * MiB;
constexpr size_t WS_PV = WS_PU + 96 * MiB;
constexpr size_t WS_X = WS_PV + 96 * MiB;
constexpr size_t WS_H = WS_X + 66 * MiB;
constexpr size_t WS_G = WS_H + 66 * MiB;
constexpr size_t WS_Y = WS_G + 66 * MiB;
constexpr size_t WS_QP = WS_Y + 66 * MiB;
constexpr size_t WS_Z = WS_QP + 66 * MiB;
constexpr size_t WS_C = WS_Z + 198 * MiB;
constexpr size_t WS_CQN = WS_C + 42 * MiB;
constexpr size_t WS_CKVN = WS_CQN + 17 * MiB;
constexpr size_t WS_KR = WS_CKVN + 17 * MiB;
constexpr size_t WS_QM = WS_KR + 3 * MiB;
constexpr size_t WS_KV = WS_QM + 99 * MiB;
constexpr size_t WS_ROUTE = WS_KV + 132 * MiB;
constexpr size_t WS_END = WS_ROUTE + 17 * MiB;
static_assert((size_t)MT * DM * 2 == 66 * MiB, "row buffer size");

constexpr int RING_BYTES = 155648, MISC_OFF = RING_BYTES + 320, LDS_BYTES = 159744;

#define GAS __attribute__((address_space(1)))
#define LAS __attribute__((address_space(3)))
typedef unsigned short bf16;
typedef unsigned u32x4 __attribute__((ext_vector_type(4)));
typedef unsigned u32x2 __attribute__((ext_vector_type(2)));
typedef float f32x4 __attribute__((ext_vector_type(4)));
typedef float f32x16 __attribute__((ext_vector_type(16)));
typedef short bf16x8 __attribute__((ext_vector_type(8)));
typedef short s16x4 __attribute__((ext_vector_type(4)));
#define LDS_WAIT() asm volatile("s_waitcnt lgkmcnt(0)" ::: "memory")

__device__ __forceinline__ unsigned cvtpk(float lo, float hi) { unsigned r; asm("v_cvt_pk_bf16_f32 %0, %1, %2" : "=v"(r) : "v"(lo), "v"(hi)); return r; }
__device__ __forceinline__ float bflo(unsigned w) { return __uint_as_float(w << 16); }
__device__ __forceinline__ float bfhi(unsigned w) { return __uint_as_float(w & 0xffff0000u); }
__device__ __forceinline__ float bf1(bf16 b) { return __uint_as_float((unsigned)b << 16); }
__device__ __forceinline__ bf16 tobf1(float f) { return (bf16)(cvtpk(f, 0.f) & 0xffffu); }
#define DPP_F(v, ctrl) __int_as_float(__builtin_amdgcn_mov_dpp(__float_as_int(v), (ctrl), 0xF, 0xF, true))
__device__ __forceinline__ float row_sum16(float v) { v += DPP_F(v, 0xB1); v += DPP_F(v, 0x4E); v += DPP_F(v, 0x141); v += DPP_F(v, 0x140); return v; }
__device__ __forceinline__ float sum_xor16(float v) { const auto r = __builtin_amdgcn_permlane16_swap(__float_as_uint(v), __float_as_uint(v), false, false); return __uint_as_float(r[0]) + __uint_as_float(r[1]); }
__device__ __forceinline__ float sum_xor32(float v) { const auto r = __builtin_amdgcn_permlane32_swap(__float_as_uint(v), __float_as_uint(v), false, false); return __uint_as_float(r[0]) + __uint_as_float(r[1]); }
__device__ __forceinline__ float wave_sum(float v) { return sum_xor32(sum_xor16(row_sum16(v))); }
__device__ __forceinline__ float half_sum32(float v) { return sum_xor16(row_sum16(v)); }
__device__ __forceinline__ float lane_xor16(float v, int lane) { const auto r = __builtin_amdgcn_permlane16_swap(__float_as_uint(v), __float_as_uint(v), false, false); return __uint_as_float((lane & 16) ? r[0] : r[1]); }
__device__ __forceinline__ unsigned lane_xor32(unsigned v, int lane) { const auto r = __builtin_amdgcn_permlane32_swap(v, v, false, false); return (lane & 32) ? r[0] : r[1]; }
__device__ __forceinline__ float gelu_tanh(float x) { return pg8::gelu_tanh(x); }

__device__ __forceinline__ void load_row_bf16(const bf16* row, int lane, float (&v)[32]) {
#pragma unroll
    for (int j = 0; j < 4; ++j) { const u32x4 w = ((const u32x4*)row)[64 * j + lane];
        v[8 * j + 0] = bflo(w.x); v[8 * j + 1] = bfhi(w.x); v[8 * j + 2] = bflo(w.y); v[8 * j + 3] = bfhi(w.y);
        v[8 * j + 4] = bflo(w.z); v[8 * j + 5] = bfhi(w.z); v[8 * j + 6] = bflo(w.w); v[8 * j + 7] = bfhi(w.w); }
}
__device__ __forceinline__ void store_row_bf16(bf16* row, int lane, const float (&v)[32]) {
#pragma unroll
    for (int j = 0; j < 4; ++j) { u32x4 w; w.x = cvtpk(v[8 * j + 0], v[8 * j + 1]); w.y = cvtpk(v[8 * j + 2], v[8 * j + 3]); w.z = cvtpk(v[8 * j + 4], v[8 * j + 5]); w.w = cvtpk(v[8 * j + 6], v[8 * j + 7]);
        ((u32x4*)row)[64 * j + lane] = w; }
}
__device__ __forceinline__ void load_row_f32(const float* row, int lane, float (&v)[32]) {
#pragma unroll
    for (int j = 0; j < 4; ++j) { const f32x4 a = ((const f32x4*)row)[128 * j + 2 * lane], b = ((const f32x4*)row)[128 * j + 2 * lane + 1];
        v[8 * j + 0] = a.x; v[8 * j + 1] = a.y; v[8 * j + 2] = a.z; v[8 * j + 3] = a.w; v[8 * j + 4] = b.x; v[8 * j + 5] = b.y; v[8 * j + 6] = b.z; v[8 * j + 7] = b.w; }
}
__device__ __forceinline__ void store_row_f32(float* row, int lane, const float (&v)[32]) {
#pragma unroll
    for (int j = 0; j < 4; ++j) { ((f32x4*)row)[128 * j + 2 * lane] = (f32x4){v[8 * j + 0], v[8 * j + 1], v[8 * j + 2], v[8 * j + 3]};
        ((f32x4*)row)[128 * j + 2 * lane + 1] = (f32x4){v[8 * j + 4], v[8 * j + 5], v[8 * j + 6], v[8 * j + 7]}; }
}
__device__ __forceinline__ void load_row_bf16_b(const bf16* row, int lane, float (&v)[32]) {
#pragma unroll
    for (int j = 0; j < 4; ++j) { const u32x4 w = ((const u32x4*)row)[4 * lane + j];
        v[8 * j + 0] = bflo(w.x); v[8 * j + 1] = bfhi(w.x); v[8 * j + 2] = bflo(w.y); v[8 * j + 3] = bfhi(w.y);
        v[8 * j + 4] = bflo(w.z); v[8 * j + 5] = bfhi(w.z); v[8 * j + 6] = bflo(w.w); v[8 * j + 7] = bfhi(w.w); }
}
__device__ __forceinline__ void store_row_bf16_b(bf16* row, int lane, const float (&v)[32]) {
#pragma unroll
    for (int j = 0; j < 4; ++j) { u32x4 w; w.x = cvtpk(v[8 * j + 0], v[8 * j + 1]); w.y = cvtpk(v[8 * j + 2], v[8 * j + 3]); w.z = cvtpk(v[8 * j + 4], v[8 * j + 5]); w.w = cvtpk(v[8 * j + 6], v[8 * j + 7]);
        ((u32x4*)row)[4 * lane + j] = w; }
}
__device__ __forceinline__ void load_row_f32_b(const float* row, int lane, float (&v)[32]) {
#pragma unroll
    for (int q = 0; q < 8; ++q) { const f32x4 a = ((const f32x4*)row)[8 * lane + q];
        v[4 * q + 0] = a.x; v[4 * q + 1] = a.y; v[4 * q + 2] = a.z; v[4 * q + 3] = a.w; }
}
__device__ __forceinline__ void store_row_f32_b(float* row, int lane, const float (&v)[32]) {
#pragma unroll
    for (int q = 0; q < 8; ++q) ((f32x4*)row)[8 * lane + q] = (f32x4){v[4 * q + 0], v[4 * q + 1], v[4 * q + 2], v[4 * q + 3]};
}
__device__ __forceinline__ void ln_stats(const float (&v)[32], float& mean, float& rstd) {
    float s = 0.f;
#pragma unroll
    for (int i = 0; i < 32; ++i) s += v[i];
    mean = wave_sum(s) * (1.0f / DM);
    float q = 0.f;
#pragma unroll
    for (int i = 0; i < 32; ++i) { const float d = v[i] - mean; q += d * d; }
    rstd = 1.0f / sqrtf(wave_sum(q) * (1.0f / DM) + LN_EPS);
}
template <bool LAYB>
__device__ __forceinline__ void finish_row(float (&z)[32], const float* lng, const float* lnb, bf16* Xrow, const float* sh, const float* sc, bf16* Hrow, float* Orow, int lane) {
    float mean, rstd; ln_stats(z, mean, rstd);
    { float g[32], b[32]; if (LAYB) { load_row_f32_b(lng, lane, g); load_row_f32_b(lnb, lane, b); } else { load_row_f32(lng, lane, g); load_row_f32(lnb, lane, b); }
#pragma unroll
      for (int i = 0; i < 32; ++i) z[i] = (z[i] - mean) * rstd * g[i] + b[i]; }
    if (Xrow) { if (LAYB) store_row_bf16_b(Xrow, lane, z); else store_row_bf16(Xrow, lane, z); }
    if (Orow) { if (LAYB) store_row_f32_b(Orow, lane, z); else store_row_f32(Orow, lane, z); }
    if (Hrow) {
        ln_stats(z, mean, rstd);
        float a[32], s[32]; if (LAYB) { load_row_f32_b(sc, lane, a); load_row_f32_b(sh, lane, s); } else { load_row_f32(sc, lane, a); load_row_f32(sh, lane, s); }
#pragma unroll
        for (int i = 0; i < 32; ++i) a[i] = (z[i] - mean) * rstd * (1.0f + a[i]) + s[i];
        if (LAYB) store_row_bf16_b(Hrow, lane, a); else store_row_bf16(Hrow, lane, a);
    }
}
__device__ __forceinline__ int row_slot(int row) { return row < ML ? (row >> 13) : 2; }

__device__ __forceinline__ unsigned f2bf_rne(float f) { unsigned u = __float_as_uint(f); return (u + 0x7fffu + ((u >> 16) & 1u)) >> 16; }
__device__ __forceinline__ unsigned pk2(float lo, float hi) { return f2bf_rne(lo) | (f2bf_rne(hi) << 16); }
__device__ __forceinline__ void p0_transpose_item(const float* W, int K, int N, bf16* WT, LAS float* scr, int item, int lane) {
    const int nblk = N / 32, kb = item / nblk, nb = item % nblk, k0 = 64 * kb, n0 = 32 * nb;
#pragma unroll 8
    for (int i = 0; i < 32; ++i) { const int kk = 2 * i + (lane >> 5); scr[kk * 33 + (lane & 31)] = W[(size_t)(k0 + kk) * N + n0 + (lane & 31)]; }
    LDS_WAIT(); asm volatile("" ::: "memory");
    const int c = lane & 7;
#pragma unroll
    for (int j = 0; j < 4; ++j) { const int n = (lane >> 3) + 8 * j; const LAS float* s = scr + (8 * c) * 33 + n;
        u32x4 o; o.x = pk2(s[0 * 33], s[1 * 33]); o.y = pk2(s[2 * 33], s[3 * 33]); o.z = pk2(s[4 * 33], s[5 * 33]); o.w = pk2(s[6 * 33], s[7 * 33]);
        *(u32x4*)(WT + (size_t)(n0 + n) * K + k0 + 8 * c) = o; }
    LDS_WAIT(); asm volatile("" ::: "memory");
}
__device__ __forceinline__ void cvt_range(const float* src, bf16* dst, size_t n8, size_t gtid, size_t gthreads) {
#pragma unroll 4
    for (size_t i = gtid; i < n8; i += gthreads) { const f32x4 a = ((const f32x4*)src)[2 * i], b = ((const f32x4*)src)[2 * i + 1];
        u32x4 w; w.x = cvtpk(a.x, a.y); w.y = cvtpk(a.z, a.w); w.z = cvtpk(b.x, b.y); w.w = cvtpk(b.z, b.w); ((u32x4*)dst)[i] = w; }
}
__device__ __forceinline__ unsigned enc_e2m3(float x) {
    const unsigned sgn = (__float_as_uint(x) >> 26) & 32u;
    const float ax = fminf(fabsf(x), 7.5f);
    unsigned u = __float_as_uint(ax); u += 0x7FFFFu + ((u >> 20) & 1u);
    const unsigned cn = (u >> 20) - ((127u - 1u) << 3);
    const unsigned cs = (unsigned)__builtin_rintf(ax * 8.0f);
    return sgn | (ax < 1.0f ? cs : cn);
}
typedef float f32x16v __attribute__((ext_vector_type(16)));
typedef float f32x32v __attribute__((ext_vector_type(32)));
typedef unsigned u32x6v __attribute__((ext_vector_type(6)));
__device__ __forceinline__ u32x6v pack_fp6_32(const float (&e)[32], bool interleaved) {
    f32x16v s0, s1;
    if (interleaved) {
#pragma unroll
        for (int i = 0; i < 16; ++i) { s0[i] = e[2 * i]; s1[i] = e[2 * i + 1]; }
    } else {
#pragma unroll
        for (int i = 0; i < 16; ++i) { s0[i] = e[i]; s1[i] = e[16 + i]; }
    }
    return __builtin_amdgcn_cvt_scalef32_2xpk16_fp6_f32(s0, s1, 1.0f);
}
__device__ __forceinline__ void cvt_table_fp6(const float* src, unsigned char* dst, int nrows, float scale, LAS float* scr  , int lane, int gw, int NGW) {
    bool interleaved;
    {
        float t[32];
#pragma unroll
        for (int k = 0; k < 32; ++k) t[k] = k < 16 ? 0.125f * k : (k < 24 ? 2.0f + 0.25f * (k - 16) : 4.0f + 0.5f * (k - 24));
        float tt[32];
#pragma unroll
        for (int k = 0; k < 32; ++k) { tt[k] = t[k]; asm volatile("" : "+v"(tt[k])); }
        const u32x6v p = pack_fp6_32(tt, true);
        const f32x32v o = __builtin_amdgcn_cvt_scalef32_pk32_f32_fp6(p, 1.0f);
        interleaved = (o[1] == t[1]) && (o[2] == t[2]) && (o[17] == t[17]);
        interleaved = __all(interleaved);
    }
    for (int row = gw; row < nrows; row += NGW) {
        const f32x4* s4 = (const f32x4*)(src + (size_t)row * 2048);
#pragma unroll
        for (int q = 0; q < 8; ++q) { const int s = 64 * q + lane; const f32x4 a = s4[s] * scale; *(LAS f32x4*)(scr + 4 * (s ^ ((s >> 4) & 7))) = a; }
        float e[32];
#pragma unroll
        for (int j = 0; j < 8; ++j) { const int s = 8 * lane + j; const f32x4 a = *(const LAS f32x4*)(scr + 4 * (s ^ ((s >> 4) & 7)));
            e[4 * j + 0] = __builtin_amdgcn_fmed3f(a.x, -7.5f, 7.5f); e[4 * j + 1] = __builtin_amdgcn_fmed3f(a.y, -7.5f, 7.5f); e[4 * j + 2] = __builtin_amdgcn_fmed3f(a.z, -7.5f, 7.5f); e[4 * j + 3] = __builtin_amdgcn_fmed3f(a.w, -7.5f, 7.5f); }
        const u32x6v p = pack_fp6_32(e, interleaved);
        unsigned char* rowp = dst + (size_t)row * PROW;
        *(u32x4*)(rowp + 16 * lane) = (u32x4){p[0], p[1], p[2], p[3]}; *(u32x2*)(rowp + 1024 + 8 * lane) = (u32x2){p[4], p[5]};
    }
}
__device__ __forceinline__ float silu(float x) { return x / (1.0f + __expf(-x)); }

struct Params { const float* in[29]; float* out; unsigned char* ws; int ph_lo, ph_hi; };
typedef const __attribute__((address_space(4))) Params* CP;

__device__ __forceinline__ void p0_prologue(CP P, LAS unsigned char* lds, int tid, int lane, int wid, int gw, int NGW) {
    unsigned char* ws = P->ws;
    LAS float* scr = (LAS float*)(lds + wid * 16384);
    {
        constexpr int I_GMIN = (2048 / 64) * (4096 / 32), I_SQ = (2048 / 64) * (2048 / 32), I_MIN = (2048 / 64) * (1088 / 32), I_UQ = (512 / 64) * (3072 / 32), I_UKV = (512 / 64) * (4096 / 32), I_DIN = (2048 / 64) * (6144 / 32);
        constexpr int NIT = 2 * I_GMIN + 2 * I_SQ + 4 * I_SQ + I_MIN + I_UQ + I_UKV + I_SQ + I_DIN + I_SQ;
        for (int it = gw; it < NIT; it += NGW) {
            int r = it;
            if (r < 2 * I_GMIN) { const int j = r / I_GMIN; p0_transpose_item(P->in[13] + (size_t)j * 2048 * 4096, 2048, 4096, (bf16*)(ws + WS_GMWIN) + (size_t)j * 4096 * 2048, scr, r % I_GMIN, lane); continue; } r -= 2 * I_GMIN;
            if (r < 2 * I_SQ) { const int j = r / I_SQ; p0_transpose_item(P->in[18] + (size_t)j * 2048 * 2048, 2048, 2048, (bf16*)(ws + WS_GMWOUT) + (size_t)j * 2048 * 2048, scr, r % I_SQ, lane); continue; } r -= 2 * I_SQ;
            if (r < 4 * I_SQ) { const int j = r / I_SQ; p0_transpose_item(P->in[8] + (size_t)j * 2048 * 2048, 2048, 2048, (bf16*)(ws + WS_PWQ) + (size_t)j * 2048 * 2048, scr, r % I_SQ, lane); continue; } r -= 4 * I_SQ;
            if (r < I_MIN) { p0_transpose_item(P->in[19], 2048, 1088, (bf16*)(ws + WS_MLAIN), scr, r, lane); continue; } r -= I_MIN;
            if (r < I_UQ) { p0_transpose_item(P->in[22], 512, 3072, (bf16*)(ws + WS_MLAUQ), scr, r, lane); continue; } r -= I_UQ;
            if (r < I_UKV) { p0_transpose_item(P->in[23], 512, 4096, (bf16*)(ws + WS_MLAUKV), scr, r, lane); continue; } r -= I_UKV;
            if (r < I_SQ) { p0_transpose_item(P->in[24], 2048, 2048, (bf16*)(ws + WS_MLAOUT), scr, r, lane); continue; } r -= I_SQ;
            if (r < I_DIN) { p0_transpose_item(P->in[25], 2048, 6144, (bf16*)(ws + WS_DAIN), scr, r, lane); continue; } r -= I_DIN;
            p0_transpose_item(P->in[28], 2048, 2048, (bf16*)(ws + WS_DAOUT), scr, r, lane);
        }
    }
    const size_t gtid = (size_t)gw * 64 + lane, gthreads = (size_t)NGW * 64;
    { u32x4* z = (u32x4*)((bf16*)(ws + WS_MLAIN) + (size_t)1088 * 2048); const size_t n = (size_t)192 * 2048 / 8;
      for (size_t i = gtid; i < n; i += gthreads) z[i] = (u32x4){0u, 0u, 0u, 0u}; }
    cvt_range(P->in[16], (bf16*)(ws + WS_GMWS), (size_t)2 * 16 * 128 * 128 / 8, gtid, gthreads);
    cvt_range(P->in[9], (bf16*)(ws + WS_PK1), (size_t)4 * 128 * 128 / 8, gtid, gthreads);
    cvt_range(P->in[10], (bf16*)(ws + WS_PK2), (size_t)4 * 128 * 128 / 8, gtid, gthreads);
    cvt_table_fp6(P->in[11], ws + WS_PU, 4 * 16384, U_SCALE, scr, lane, gw, NGW);
    cvt_table_fp6(P->in[12], ws + WS_PV, 4 * 16384, V_SCALE, scr, lane, gw, NGW);
    if (gtid < 2048) { const int pos = (int)gtid >> 4, f = (int)gtid & 15; const float inv = powf(10000.0f, -(float)f * (1.0f / 16.0f)); float sn, cs; sincosf((float)pos * inv, &sn, &cs);
        float* rt = (float*)(ws + WS_ROPE); rt[gtid] = cs; rt[2048 + gtid] = sn; }
    {
        const float* cv = P->in[1]; const float* cc = P->in[3]; const float* mw = P->in[4]; float* PART = (float*)(ws + WS_MODP);
        for (int item = gw; item < 4 * 192 * 8; item += NGW) {
            const int ks = item & 7, r = item >> 3, L = r / 192, n = (r % 192) * 64 + lane;
            const float* W = mw + (size_t)L * 2048 * 12288 + (size_t)(ks * 256) * 12288 + n;
            float a0 = 0.f, a1 = 0.f, a2 = 0.f;
#pragma unroll 32
            for (int k = 0; k < 256; ++k) { const int kk = ks * 256 + k; const float s0 = silu(cv[kk]), s1 = silu(cv[2048 + kk]), s2 = silu(cc[kk]);
                const float w = W[(size_t)k * 12288]; a0 += s0 * w; a1 += s1 * w; a2 += s2 * w; }
            float* o = PART + ((size_t)ks * 4 + L) * 3 * 12288 + n;
            o[0] = a0; o[12288] = a1; o[24576] = a2;
        }
    }
}
__device__ __forceinline__ void mod_reduce(CP P, int gw, int lane, int NGW) {
    const float* PART = (const float*)(P->ws + WS_MODP); float* MOD = (float*)(P->ws + WS_MOD); const float* mb = P->in[5];
    for (int i = gw * 64 + lane; i < 4 * 3 * 12288; i += NGW * 64) {
        const int L = i / (3 * 12288), n = i % 12288;
        float s = mb[(size_t)L * 12288 + n];
#pragma unroll
        for (int ks = 0; ks < 8; ++ks) s += PART[(size_t)ks * 4 * 3 * 12288 + i];
        MOD[i] = s;
    }
}

__device__ __forceinline__ void first_row_pass(CP P, int lane, int gw, int NGW) {
    const float* MOD = (const float*)(P->ws + WS_MOD); bf16* X = (bf16*)(P->ws + WS_X); bf16* H = (bf16*)(P->ws + WS_H);
    for (int row = gw; row < MT; row += NGW) {
        const float* src = row < ML ? P->in[0] + (size_t)row * DM : P->in[2] + (size_t)(row - ML) * DM;
        float v[32]; load_row_f32(src, lane, v);
        store_row_bf16(X + (size_t)row * DM, lane, v);
        const float* mod = MOD + (size_t)row_slot(row) * 12288;
        float mean, rstd; ln_stats(v, mean, rstd);
        float a[32], s[32]; load_row_f32(mod + 2048, lane, a); load_row_f32(mod, lane, s);
#pragma unroll
        for (int i = 0; i < 32; ++i) a[i] = (v[i] - mean) * rstd * (1.0f + a[i]) + s[i];
        store_row_bf16(H + (size_t)row * DM, lane, a);
    }
}
__device__ __forceinline__ void post_mixer_pass(CP P, int L, int Mrows, int lane, int gw, int NGW) {
    const float* MOD = (const float*)(P->ws + WS_MOD); bf16* X = (bf16*)(P->ws + WS_X); bf16* H = (bf16*)(P->ws + WS_H); const bf16* Y = (const bf16*)(P->ws + WS_Y);
    const float* lng = P->in[6] + (size_t)(L * 2 + 0) * DM; const float* lnb = P->in[7] + (size_t)(L * 2 + 0) * DM;
    for (int row = gw; row < Mrows; row += NGW) {
        const float* mod = MOD + (size_t)(L * 3 + row_slot(row)) * 12288;
        float z[32], y[32], g[32]; load_row_bf16(X + (size_t)row * DM, lane, z); load_row_bf16(Y + (size_t)row * DM, lane, y); load_row_f32(mod + 2 * 2048, lane, g);
#pragma unroll
        for (int i = 0; i < 32; ++i) z[i] = ALPHA * z[i] + g[i] * y[i];
        finish_row<false>(z, lng, lnb, X + (size_t)row * DM, mod + 3 * 2048, mod + 4 * 2048, H + (size_t)row * DM, nullptr, lane);
    }
}
__device__ __forceinline__ void vstats_pass(CP P, int Mrows, int lane, int gw, int NGW) {
    const bf16* Z = (const bf16*)(P->ws + WS_Z); float* VST = (float*)(P->ws + WS_VST);
    for (int row = gw; row < Mrows; row += NGW) {
        float v[32]; load_row_bf16(Z + (size_t)row * 4096 + 2048, lane, v);
        float mean, rstd; ln_stats(v, mean, rstd);
        if (lane == 0) { VST[2 * row] = mean; VST[2 * row + 1] = rstd; }
    }
}
#define XB_TMO      128
#define XB_XCNT(j)  (256  + 64 * (j))
#define XB_XSUB(j)  (1280 + 64 * (j))
#define XB_XGEN(j)  (2304 + 64 * (j))
#define XB_TOP      3328
#define XB_TOPGEN   3392
#define XCD_BAR_WORDS 3456
#define XB_SPIN_CAP (1u << 18)

__device__ __forceinline__ unsigned xb_ld(unsigned* p)              { return __hip_atomic_load(p, __ATOMIC_RELAXED, __HIP_MEMORY_SCOPE_AGENT); }
__device__ __forceinline__ unsigned xb_add(unsigned* p, unsigned v) { return __hip_atomic_fetch_add(p, v, __ATOMIC_RELAXED, __HIP_MEMORY_SCOPE_AGENT); }
__device__ __forceinline__ unsigned xb_xcc_id() { return (unsigned)__builtin_amdgcn_s_getreg((3 << 11) | 20) & 0xFu; }
#define XB_SPIN(cond, bar) do { unsigned _sp = 0; while (cond) { __builtin_amdgcn_s_sleep(1); \
    if ((++_sp & 255u) == 0u) { if (xb_ld(&(bar)[XB_TMO])) break; if (_sp > XB_SPIN_CAP) { atomicAdd(&(bar)[XB_TMO], 1u); break; } } } } while (0)

struct XcdBarrier {
    unsigned* bar; unsigned x;
    volatile LAS unsigned* st;
};

__device__ __forceinline__ XcdBarrier xcd_barrier_post(unsigned* bar, volatile LAS unsigned* st, const bool t0) {
    XcdBarrier b; b.bar = bar; b.x = xb_xcc_id(); b.st = st;
    if (t0) (void)xb_add(&bar[XB_XCNT(b.x)], 1u);
    return b;
}
__device__ __forceinline__ void xcd_barrier_complete(unsigned* bar, unsigned x, unsigned& nloc, unsigned& nx) {
    const unsigned G = gridDim.x * gridDim.y * gridDim.z;
    unsigned sum, cnt, mine, sp = 0u;
    for (;;) {
        sum = 0u; cnt = 0u; mine = 0u;
#pragma unroll
        for (unsigned j = 0; j < 16; ++j) { const unsigned c = xb_ld(&bar[XB_XCNT(j)]); sum += c; cnt += (c > 0u) ? 1u : 0u; mine = (j == x) ? c : mine; }
        if (sum == G) break;
        __builtin_amdgcn_s_sleep(1);
        if ((++sp & 255u) == 0u) { if (xb_ld(&bar[XB_TMO])) break; if (sp > XB_SPIN_CAP) { atomicAdd(&bar[XB_TMO], 1u); break; } }
    }
    nloc = mine > 0u ? mine : 1u; nx = cnt > 0u ? cnt : 1u;
}

__device__ __attribute__((noinline)) void xcd_barrier(const XcdBarrier b, const bool t0) {
    asm volatile("s_waitcnt vmcnt(0)" ::: "memory");
    __syncthreads();
    if (t0) {
        unsigned* bar = b.bar;
        __builtin_amdgcn_s_waitcnt(0);
        unsigned nloc = b.st[0], nx = b.st[1];
        if (nloc == 0u) { xcd_barrier_complete(bar, b.x, nloc, nx); b.st[0] = nloc; b.st[1] = nx; }
        const unsigned old = xb_add(&bar[XB_XSUB(b.x)], 1u);
        const unsigned gen = old / nloc;
        if (old + 1u == (gen + 1u) * nloc) {
            __builtin_amdgcn_fence(__ATOMIC_RELEASE, "agent");
            asm volatile("s_waitcnt vmcnt(0)" ::: "memory");
            const unsigned og = xb_add(&bar[XB_TOP], 1u);
            const unsigned tg = og / nx;
            if (og + 1u == (tg + 1u) * nx) xb_add(&bar[XB_TOPGEN], 1u);
            else XB_SPIN(xb_ld(&bar[XB_TOPGEN]) == tg, bar);
            __builtin_amdgcn_fence(__ATOMIC_ACQUIRE, "agent");
            xb_add(&bar[XB_XGEN(b.x)], 1u);
            asm volatile("s_waitcnt vmcnt(0)" ::: "memory");
        } else {
            XB_SPIN(xb_ld(&bar[XB_XGEN(b.x)]) == gen, bar);
            __builtin_amdgcn_fence(__ATOMIC_ACQUIRE, "agent");
            asm volatile("s_waitcnt vmcnt(0)" ::: "memory");
        }
    }
    __syncthreads();
}

__device__ __forceinline__ void spatial_phase(CP P, int j, int Mrows, LAS unsigned char* lds_, int tid, int lane, int wid) {
    const bf16* Z = (const bf16*)(P->ws + WS_Z); const float* VST = (const float*)(P->ws + WS_VST); bf16* Gb = (bf16*)(P->ws + WS_G);
    const bf16* WS = (const bf16*)(P->ws + WS_GMWS) + (size_t)j * 16 * 128 * 128;
    const float* lng = P->in[14] + (size_t)j * DM; const float* lnb = P->in[15] + (size_t)j * DM; const float* bs = P->in[17] + (size_t)j * 16 * 128;
    LAS bf16* Vt = (LAS bf16*)(LAS unsigned char*)lds_;
    constexpr int VP = 136;
    const int nunits = (Mrows / 128) * 16;
    for (int u = blockIdx.x; u < nunits; u += gridDim.x) {
        const int c = u >> 4, g = u & 15;
        __syncthreads();
        {
            const int q = tid >> 2, dq = (tid & 3) * 32; const int row = c * 128 + q;
            const float mean = VST[2 * row], rstd = VST[2 * row + 1];
            const bf16* src = Z + (size_t)row * 4096 + 2048 + g * 128 + dq;
#pragma unroll
            for (int t = 0; t < 4; ++t) { const u32x4 w = *(const u32x4*)(src + 8 * t);
                float v[8] = {bflo(w.x), bfhi(w.x), bflo(w.y), bfhi(w.y), bflo(w.z), bfhi(w.z), bflo(w.w), bfhi(w.w)};
                const float* gp = lng + g * 128 + dq + 8 * t; const float* bp = lnb + g * 128 + dq + 8 * t;
#pragma unroll
                for (int i = 0; i < 8; ++i) { const float vn = (v[i] - mean) * rstd * gp[i] + bp[i]; Vt[(dq + 8 * t + i) * VP + q] = tobf1(vn); } }
        }
        __syncthreads();
        const int fr = lane & 15, fq = lane >> 4;
        bf16x8 a[4];
        const bf16* wrow = WS + (size_t)g * 128 * 128 + (size_t)(16 * wid + fr) * 128 + 8 * fq;
#pragma unroll
        for (int ks = 0; ks < 4; ++ks) a[ks] = *(const bf16x8*)(wrow + 32 * ks);
#pragma unroll
        for (int nb = 0; nb < 8; ++nb) {
            f32x4 acc = {0.f, 0.f, 0.f, 0.f};
#pragma unroll
            for (int ks = 0; ks < 4; ++ks) { const bf16x8 b = *(const LAS bf16x8*)(Vt + (16 * nb + fr) * VP + 32 * ks + 8 * fq);
                acc = __builtin_amdgcn_mfma_f32_16x16x32_bf16(a[ks], b, acc, 0, 0, 0); }
#pragma unroll
            for (int r = 0; r < 4; ++r) { const int p = 16 * wid + fq * 4 + r, d = 16 * nb + fr; const size_t grow = (size_t)(c * 128 + p);
                const float sv = acc[r] + bs[g * 128 + p];
                const float uu = bf1(Z[grow * 4096 + g * 128 + d]);
                Gb[grow * 2048 + g * 128 + d] = tobf1(uu * sv); }
        }
    }
}

__device__ __forceinline__ void rope_cs(int row, int l, float& cs, float& sn) {
    const int t = row & (SEQ - 1); const int pos = (l & 32) ? (t & 63) : (t >> 6);
    const float inv = powf(10000.0f, -(float)(l & 15) * (1.0f / 16.0f));
    const float ang = (float)pos * inv; sincosf(ang, &sn, &cs);
}
__device__ __forceinline__ float rope_apply(float x, int l, float cs, float sn) {
    const float p = lane_xor16(x, l);
    return (l & 16) ? (p * sn + x * cs) : (x * cs - p * sn);
}
__device__ __forceinline__ void mla_norm_pass(CP P, int lane, int gw, int NGW) {
    const bf16* C = (const bf16*)(P->ws + WS_C); bf16* CQN = (bf16*)(P->ws + WS_CQN); bf16* CKVN = (bf16*)(P->ws + WS_CKVN); bf16* KR = (bf16*)(P->ws + WS_KR);
    const float* qn = P->in[20]; const float* kvn = P->in[21];
    for (int row = gw; row < MT; row += NGW) {
        const bf16* c = C + (size_t)row * 1280;
#pragma unroll
        for (int part = 0; part < 2; ++part) {
            const u32x4 w = *(const u32x4*)(c + part * 512 + 8 * lane);
            float v[8] = {bflo(w.x), bfhi(w.x), bflo(w.y), bfhi(w.y), bflo(w.z), bfhi(w.z), bflo(w.w), bfhi(w.w)};
            float ss = 0.f;
#pragma unroll
            for (int i = 0; i < 8; ++i) ss += v[i] * v[i];
            const float r = 1.0f / sqrtf(wave_sum(ss) * (1.0f / 512.0f) + LN_EPS);
            const float* nw = (part ? kvn : qn) + 8 * lane;
            u32x4 o; o.x = cvtpk(v[0] * r * nw[0], v[1] * r * nw[1]); o.y = cvtpk(v[2] * r * nw[2], v[3] * r * nw[3]); o.z = cvtpk(v[4] * r * nw[4], v[5] * r * nw[5]); o.w = cvtpk(v[6] * r * nw[6], v[7] * r * nw[7]);
            *(u32x4*)((part ? CKVN : CQN) + (size_t)row * 512 + 8 * lane) = o;
        }
        float x = bf1(c[1024 + lane]);
        if (row < ML) { float cs, sn; rope_cs(row, lane, cs, sn); x = rope_apply(x, lane, cs, sn); }
        KR[(size_t)row * 64 + lane] = tobf1(x);
    }
}
__device__ __forceinline__ void rope_pass(bf16* buf, int ld, int col0, int nchunks, int cstride, int lane, int gw, int NGW) {
    for (int row = gw; row < ML; row += NGW) {
        float cs, sn; rope_cs(row, lane, cs, sn);
        bf16* r = buf + (size_t)row * ld + col0 + lane;
#pragma unroll 4
        for (int k = 0; k < nchunks; ++k) { const float x = bf1(r[k * cstride]); r[k * cstride] = tobf1(rope_apply(x, lane, cs, sn)); }
    }
}

namespace att {
#define SBAR() __builtin_amdgcn_sched_barrier(0)
__device__ __forceinline__ int crow(int r, int hi) { return (r & 3) + 8 * (r >> 2) + 4 * hi; }
__device__ __forceinline__ unsigned cvtpkv(float lo, float hi) { unsigned r; asm volatile("v_cvt_pk_bf16_f32 %0, %1, %2" : "=v"(r) : "v"(lo), "v"(hi)); return r; }

__device__ __forceinline__ void partialSM(f32x16& p0, f32x16& p1, float& m_reg, float& mn, float& alpha, const float C, const float THRS) {
  float pmax = p0[0];
#pragma unroll
  for (int r = 1; r < 16; ++r) pmax = fmaxf(pmax, p0[r]);
#pragma unroll
  for (int r = 0; r < 16; ++r) pmax = fmaxf(pmax, p1[r]);
  { auto rr = __builtin_amdgcn_permlane32_swap(__float_as_uint(pmax), __float_as_uint(pmax), false, false);
    pmax = fmaxf(__uint_as_float(rr[0]), __uint_as_float(rr[1])); }
  if (__builtin_expect(__all(pmax - m_reg <= THRS), 1)) { mn = m_reg; alpha = 1.f; }
  else { mn = fmaxf(m_reg, pmax); alpha = __builtin_amdgcn_exp2f((m_reg - mn) * C); m_reg = mn; }
  const float mnC = -mn * C;
#pragma unroll
  for (int r = 0; r < 16; ++r) p0[r] = fmaf(p0[r], C, mnC);
#pragma unroll
  for (int r = 0; r < 16; ++r) p1[r] = fmaf(p1[r], C, mnC);
#pragma unroll
  for (int r = 0; r < 16; ++r) p0[r] = __builtin_amdgcn_exp2f(p0[r]);
}
__device__ __forceinline__ void finishSM(f32x16& p0, f32x16& p1, float alpha, float& l_reg, bf16x8& pa0, bf16x8& pa1, bf16x8& pa2, bf16x8& pa3) {
#pragma unroll
  for (int r = 0; r < 16; ++r) p1[r] = __builtin_amdgcn_exp2f(p1[r]);
  float ps = 0;
#pragma unroll
  for (int r = 0; r < 16; ++r) ps += p0[r];
#pragma unroll
  for (int r = 0; r < 16; ++r) ps += p1[r];
  { auto rr = __builtin_amdgcn_permlane32_swap(__float_as_uint(ps), __float_as_uint(ps), false, false);
    ps = __uint_as_float(rr[0]) + __uint_as_float(rr[1]); }
  l_reg = l_reg * alpha + ps;
#define PK4(P, BASE, OUT) do { unsigned a0 = cvtpkv(P[BASE + 0], P[BASE + 1]), a1 = cvtpkv(P[BASE + 2], P[BASE + 3]);   \
    unsigned b0 = cvtpkv(P[BASE + 4], P[BASE + 5]), b1 = cvtpkv(P[BASE + 6], P[BASE + 7]);                              \
    auto r0 = __builtin_amdgcn_permlane32_swap(a0, b0, false, false); auto r1 = __builtin_amdgcn_permlane32_swap(a1, b1, false, false); \
    u32x4 w = {r0[0], r1[0], r0[1], r1[1]}; OUT = *reinterpret_cast<bf16x8*>(&w); } while (0)
  PK4(p0, 0, pa0); PK4(p0, 8, pa1); PK4(p1, 0, pa2); PK4(p1, 8, pa3);
#undef PK4
}
template <int PITCH> __device__ __forceinline__ int kswz(int r) { return PITCH == 256 ? (r & 15) : ((r >> 1) & 7); }
template <int NQF, int NQR, int PITCH> __device__ __forceinline__ void qkt(f32x16& p0, f32x16& p1, const LAS char* Ks, int chunk0, const bf16x8* qr, const LAS char* ql, int r32, int hi) {
  p0 = f32x16{}; p1 = f32x16{};
  const int sw = kswz<PITCH>(r32);
#pragma unroll
  for (int d0 = 0; d0 < NQF; ++d0) { const int off = ((chunk0 + d0 * 2 + hi) ^ sw) * 16;
    const bf16x8 b0 = *(const LAS bf16x8*)(Ks + r32 * PITCH + off);
    const bf16x8 b1 = *(const LAS bf16x8*)(Ks + (32 + r32) * PITCH + off);
    const bf16x8 q = d0 < NQR ? qr[d0 < NQR ? d0 : 0] : *(const LAS bf16x8*)(ql + (d0 - NQR) * 1024);
    p0 = __builtin_amdgcn_mfma_f32_32x32x16_bf16(b0, q, p0, 0, 0, 0);
    p1 = __builtin_amdgcn_mfma_f32_32x32x16_bf16(b1, q, p1, 0, 0, 0); }
}
__device__ __forceinline__ int v_st(int k, int c) { const int kk = (k & ~0xC) | ((k & 4) << 1) | ((k & 8) >> 1); return ((kk >> 3) * 4 + (c >> 5)) * 512 + ((kk & 7) * 32 + (c & 31)) * 2; }
__device__ __forceinline__ int v_rd_base(int lane) { return ((lane & 3) << 3) | (((lane >> 2) & 3) << 6) | (((lane >> 4) & 1) << 5) | (((lane >> 5) & 1) << 8); }
constexpr int v_rd_off(int d0, int ks, int half) { return d0 * 512 + ks * 4096 + half * 2048; }
template <int OFF> __device__ __forceinline__ s16x4 tr_read(int vb) {
  s16x4 r; asm volatile("ds_read_b64_tr_b16 %0, %1 offset:%2" : "=&v"(r) : "v"(vb), "i"(OFF) : "memory"); return r;
}
template <int D0> __device__ __forceinline__ void pv_one(f32x16& od, int vb, bf16x8 pa0, bf16x8 pa1, bf16x8 pa2, bf16x8 pa3) {
  const s16x4 l0 = tr_read<v_rd_off(D0, 0, 0)>(vb), h0 = tr_read<v_rd_off(D0, 0, 1)>(vb), l1 = tr_read<v_rd_off(D0, 1, 0)>(vb), h1 = tr_read<v_rd_off(D0, 1, 1)>(vb);
  const s16x4 l2 = tr_read<v_rd_off(D0, 2, 0)>(vb), h2 = tr_read<v_rd_off(D0, 2, 1)>(vb), l3 = tr_read<v_rd_off(D0, 3, 0)>(vb), h3 = tr_read<v_rd_off(D0, 3, 1)>(vb);
  asm volatile("s_waitcnt lgkmcnt(0)" ::: "memory"); SBAR();
#define PK(L, H) (bf16x8){L[0], L[1], L[2], L[3], H[0], H[1], H[2], H[3]}
  od = __builtin_amdgcn_mfma_f32_32x32x16_bf16(pa0, PK(l0, h0), od, 0, 0, 0);
  od = __builtin_amdgcn_mfma_f32_32x32x16_bf16(pa1, PK(l1, h1), od, 0, 0, 0);
  od = __builtin_amdgcn_mfma_f32_32x32x16_bf16(pa2, PK(l2, h2), od, 0, 0, 0);
  od = __builtin_amdgcn_mfma_f32_32x32x16_bf16(pa3, PK(l3, h3), od, 0, 0, 0);
#undef PK
}
__device__ __forceinline__ void pv_d0(f32x16* o, int vb, bf16x8 pa0, bf16x8 pa1, bf16x8 pa2, bf16x8 pa3) {
  pv_one<0>(o[0], vb, pa0, pa1, pa2, pa3); pv_one<1>(o[1], vb, pa0, pa1, pa2, pa3); pv_one<2>(o[2], vb, pa0, pa1, pa2, pa3); pv_one<3>(o[3], vb, pa0, pa1, pa2, pa3);
}
__device__ __forceinline__ bf16x8 ld8(const bf16* p) { return *reinterpret_cast<const bf16x8*>(p); }

template <int MODE>
__device__ __forceinline__ void attn_unit(const bf16* __restrict__ Qrow0, int ldq, const bf16* __restrict__ Kb, const bf16* __restrict__ Vb, int ldk, const bf16* __restrict__ KRb,
                                          int b, int nct, int NT, bf16* __restrict__ Ob, float lam, const float* __restrict__ subln, float oscale, LAS unsigned char* lds_, const int tid_in) {
  constexpr int NQF = MODE == 0 ? 12 : 4, NQR = MODE == 0 ? 4 : 4, PITCH = MODE == 0 ? 384 : 256, SHM_V = 16384, SHM_K = 64 * PITCH, SDEPTH = MODE == 0 ? 1 : 2;
  const float SCALE = MODE == 0 ? 0.07216878364870323f : 0.125f;
  const float C = SCALE * 1.4426950408889634f, THRS = 8.f / SCALE;
  const int tid = launder_v(tid_in) & 511, wid = tid >> 6, lane = tid & 63, r32 = lane & 31, hi = lane >> 5;
  LAS char* lds = (LAS char*)(LAS unsigned char*)lds_;
  LAS char* V_lds = lds; LAS char* K_lds = lds + 2 * SHM_V;
  LAS float* wsf = (LAS float*)(lds + 2 * SHM_V + 2 * SHM_K) + wid * 64; LAS float* li_l = wsf; LAS float* al_l = wsf + 32;
  const int wq = MODE == 0 ? wid : (wid & 3), sgrp = MODE == 0 ? 0 : (wid >> 2);
  float m_reg = -1e30f, l_reg = 0; f32x16 o[4] = {}; bf16x8 qr[NQR];
  LAS char* ql = lds + 2 * SHM_V + 2 * SHM_K + 2048 + wid * 8192 + lane * 16;
  const bf16* Qw = Qrow0 + (size_t)(wq * 32 + r32) * ldq + sgrp * 64 + hi * 8;
#pragma unroll
  for (int d0 = 0; d0 < NQR; ++d0) qr[d0] = ld8(Qw + d0 * 16);
#pragma unroll
  for (int d0 = NQR; d0 < NQF; ++d0) *(LAS bf16x8*)(ql + (d0 - NQR) * 1024) = ld8(Qw + d0 * 16);
  const int sr = tid >> 4, sc = (tid & 15) * 8, vst0 = v_st(sr, sc), vst1 = v_st(32 + sr, sc);
  const int kst0 = sr * PITCH + (((tid & 15) ^ kswz<PITCH>(sr)) * 16), kst1 = kst0 + 32 * PITCH;
  const int rrow = tid >> 3, krs = rrow * PITCH + (((16 + (tid & 7)) ^ kswz<PITCH>(rrow)) * 16);
  const int chunk0 = sgrp * 8;
  const int vb0 = (int)(uintptr_t)V_lds + v_rd_base(lane);
  struct Slot { bf16x8 vs0, vs1, ks0, ks1, kr; } sr_[SDEPTH];
#define KROW(jt) ((jt) < nct ? (ML + b * CTXL + (jt) * 64) : (b * SEQ + ((jt) - nct) * 64))
#define SLOAD(i, jt) do { const int k0_ = KROW(jt); sr_[i].vs0 = ld8(Vb + (size_t)(k0_ + sr) * ldk + sc); sr_[i].vs1 = ld8(Vb + (size_t)(k0_ + 32 + sr) * ldk + sc); \
    sr_[i].ks0 = ld8(Kb + (size_t)(k0_ + sr) * ldk + sc); sr_[i].ks1 = ld8(Kb + (size_t)(k0_ + 32 + sr) * ldk + sc); \
    if (MODE == 0) sr_[i].kr = ld8(KRb + (size_t)(k0_ + rrow) * 64 + (tid & 7) * 8); } while (0)
#define SWRITE(bf, i) do { *(LAS bf16x8*)(V_lds + (bf) * SHM_V + vst0) = sr_[i].vs0; *(LAS bf16x8*)(V_lds + (bf) * SHM_V + vst1) = sr_[i].vs1; \
    *(LAS bf16x8*)(K_lds + (bf) * SHM_K + kst0) = sr_[i].ks0; *(LAS bf16x8*)(K_lds + (bf) * SHM_K + kst1) = sr_[i].ks1; \
    if (MODE == 0) *(LAS bf16x8*)(K_lds + (bf) * SHM_K + krs) = sr_[i].kr; } while (0)
#define SWAIT() do { if constexpr (SDEPTH == 2) asm volatile("s_waitcnt vmcnt(4)" ::: "memory"); else asm volatile("s_waitcnt vmcnt(0)" ::: "memory"); } while (0)
#define RESC(a) do { if (__any((a) < 1.f)) { if (hi == 0) al_l[r32] = (a); asm volatile("s_waitcnt lgkmcnt(0)" ::: "memory"); \
    _Pragma("unroll") for (int d = 0; d < 4; ++d) _Pragma("unroll") for (int r = 0; r < 16; ++r) o[d][r] *= al_l[crow(r, hi)]; } } while (0)
  f32x16 pA0, pA1, pB0, pB1; float mnA, mnB, alA, alB; bf16x8 pa0, pa1, pa2, pa3;
  constexpr int SE = 0, SO = SDEPTH - 1;
  SLOAD(SE, 0); asm volatile("s_waitcnt vmcnt(0)" ::: "memory"); SWRITE(0, SE); __syncthreads();
  qkt<NQF, NQR, PITCH>(pA0, pA1, K_lds, chunk0, qr, ql, r32, hi); partialSM(pA0, pA1, m_reg, mnA, alA, C, THRS);
  SLOAD(SO, 1); if constexpr (SDEPTH == 2) { if (2 < NT) SLOAD(SE, 2); }
  SWAIT(); SWRITE(1, SO); __syncthreads();
  for (int j = 1; j + 1 < NT; j += 2) {
    SBAR(); qkt<NQF, NQR, PITCH>(pB0, pB1, K_lds + SHM_K, chunk0, qr, ql, r32, hi);
    finishSM(pA0, pA1, alA, l_reg, pa0, pa1, pa2, pa3); SBAR();
    SLOAD(SO, j + SDEPTH); SBAR();
    pv_d0(o, vb0, pa0, pa1, pa2, pa3); partialSM(pB0, pB1, m_reg, mnB, alB, C, THRS);
    __syncthreads(); SWAIT(); SWRITE(0, SE);
    RESC(alB); __syncthreads();
    SBAR(); qkt<NQF, NQR, PITCH>(pA0, pA1, K_lds, chunk0, qr, ql, r32, hi);
    finishSM(pB0, pB1, alB, l_reg, pa0, pa1, pa2, pa3); SBAR();
    if (SDEPTH == 1 || j + 3 < NT) SLOAD(SE, j + 1 + SDEPTH); SBAR();
    pv_d0(o, vb0 + SHM_V, pa0, pa1, pa2, pa3); partialSM(pA0, pA1, m_reg, mnA, alA, C, THRS);
    __syncthreads(); SWAIT(); SWRITE(1, SO);
    RESC(alA); __syncthreads();
  }
  SBAR(); qkt<NQF, NQR, PITCH>(pB0, pB1, K_lds + SHM_K, chunk0, qr, ql, r32, hi);
  finishSM(pA0, pA1, alA, l_reg, pa0, pa1, pa2, pa3); SBAR();
  pv_d0(o, vb0, pa0, pa1, pa2, pa3); partialSM(pB0, pB1, m_reg, mnB, alB, C, THRS);
  __syncthreads(); RESC(alB);
  finishSM(pB0, pB1, alB, l_reg, pa0, pa1, pa2, pa3); SBAR();
  pv_d0(o, vb0 + SHM_V, pa0, pa1, pa2, pa3);
  if (hi == 0) li_l[r32] = l_reg; asm volatile("s_waitcnt lgkmcnt(0)" ::: "memory");
  float rli[16];
#pragma unroll
  for (int r = 0; r < 16; ++r) rli[r] = __builtin_amdgcn_rcpf(li_l[crow(r, hi)]);
  bf16* Ow = Ob + (size_t)(wq * 32) * DM;
  if constexpr (MODE == 0) {
#pragma unroll
    for (int r = 0; r < 16; ++r) { const int orow = crow(r, hi);
#pragma unroll
      for (int d0 = 0; d0 < 4; ++d0) Ow[(size_t)orow * DM + d0 * 32 + r32] = tobf1(o[d0][r] * rli[r]); }
    __syncthreads();
  } else {
    LAS float* ex = (LAS float*)lds;
    __syncthreads();
    if (sgrp == 1) {
#pragma unroll
      for (int r = 0; r < 16; ++r)
#pragma unroll
        for (int d0 = 0; d0 < 4; ++d0) ex[(wq * 32 + crow(r, hi)) * 128 + d0 * 32 + r32] = o[d0][r] * rli[r];
    }
    __syncthreads();
    if (sgrp == 0) {
#pragma unroll
      for (int r = 0; r < 16; ++r) { const int orow = crow(r, hi); float dd[4]; float ss = 0.f;
#pragma unroll
        for (int d0 = 0; d0 < 4; ++d0) { dd[d0] = o[d0][r] * rli[r] - lam * ex[(wq * 32 + orow) * 128 + d0 * 32 + r32]; ss += dd[d0] * dd[d0]; }
        ss = half_sum32(ss);
        const float rs = oscale / sqrtf(ss * (1.0f / 128.0f) + LN_EPS);
#pragma unroll
        for (int d0 = 0; d0 < 4; ++d0) Ow[(size_t)orow * DM + d0 * 32 + r32] = tobf1(dd[d0] * rs * subln[d0 * 32 + r32]); }
    }
    __syncthreads();
  }
#undef KROW
#undef SLOAD
#undef SWRITE
#undef SWAIT
#undef RESC
}
}

__device__ __forceinline__ void mla_attn_phase(CP P, LAS unsigned char* lds, const int tid) {
    const bf16* QM = (const bf16*)(P->ws + WS_QM); const bf16* KV = (const bf16*)(P->ws + WS_KV); const bf16* KR = (const bf16*)(P->ws + WS_KR); bf16* Gb = (bf16*)(P->ws + WS_G);
    const int c = blockIdx.x, G = gridDim.x;
    for (int u = c; u < 1024 + 32; u += G) {
        int b, h, qrow0, NT;
        if (u < 1024) { const int i = u >> 8, cc = u & 255; const int bh = (cc & 7) + 8 * i, qb = cc >> 3; b = bh >> 4; h = bh & 15; qrow0 = b * SEQ + qb * 256; NT = 4 + 128; }
        else { const int bh = u - 1024; b = bh >> 4; h = bh & 15; qrow0 = ML + b * CTXL; NT = 4; }
        att::attn_unit<0>(QM + (size_t)qrow0 * 3072 + h * 192, 3072, KV + h * 256, KV + h * 256 + 128, 4096, KR, b, 4, NT, Gb + (size_t)qrow0 * DM + h * 128, 0.f, nullptr, 1.f, lds, tid);
    }
}
__device__ __forceinline__ void da_attn_phase(CP P, float lam, float oscale, LAS unsigned char* lds, const int tid) {
    const bf16* Z = (const bf16*)(P->ws + WS_Z); bf16* Gb = (bf16*)(P->ws + WS_G); const float* subln = P->in[27];
    const int c = blockIdx.x, G = gridDim.x;
    for (int u = c; u < 2048 + 64; u += G) {
        int b, h, qrow0, NT;
        if (u < 2048) { const int i = u >> 8, cc = u & 255; const int bh = (cc & 7) + 8 * (i >> 1), qb = (cc >> 3) + 32 * (i & 1); b = bh >> 4; h = bh & 15; qrow0 = b * SEQ + qb * 128; NT = 4 + 128; }
        else { const int v = u - 2048; const int bh = v >> 1; b = bh >> 4; h = bh & 15; qrow0 = ML + b * CTXL + (v & 1) * 128; NT = 4; }
        att::attn_unit<1>(Z + (size_t)qrow0 * 6144 + h * 128, 6144, Z + 2048 + h * 128, Z + 4096 + h * 128, 6144, nullptr, b, 4, NT, Gb + (size_t)qrow0 * DM + h * 128, lam, subln, oscale, lds, tid);
    }
}

__device__ __forceinline__ unsigned f2ord(float f) { const unsigned u = __float_as_uint(f); return u ^ ((unsigned)((int)u >> 31) | 0x80000000u); }
__device__ __forceinline__ float ord2f(unsigned k) { return __uint_as_float((k & 0x80000000u) ? (k ^ 0x80000000u) : ~k); }
__device__ __forceinline__ void ce_desc(unsigned& a, unsigned& b) { const unsigned mx = a > b ? a : b, mn = a > b ? b : a; a = mx; b = mn; }
template <int N, bool DESC> __device__ __forceinline__ void bitonic_merge(unsigned* a) {
#pragma unroll
    for (int j = N / 2; j > 0; j >>= 1)
#pragma unroll
        for (int i = 0; i < N; ++i) { const int l = i ^ j; if (l > i) { if (DESC) ce_desc(a[i], a[l]); else ce_desc(a[l], a[i]); } }
}
template <int N, bool DESC> __device__ __forceinline__ void bitonic_sort(unsigned* a) {
#pragma unroll
    for (int k = 2; k <= N; k <<= 1)
#pragma unroll
        for (int j = k >> 1; j > 0; j >>= 1)
#pragma unroll
            for (int i = 0; i < N; ++i) { const int l = i ^ j; if (l > i) { const bool up = ((i & k) == 0); if (up == DESC) ce_desc(a[i], a[l]); else ce_desc(a[l], a[i]); } }
}
__device__ __forceinline__ void top16_of_64(unsigned (&a)[64]) {
    bitonic_sort<16, true>(a); bitonic_sort<16, false>(a + 16); bitonic_sort<16, true>(a + 32); bitonic_sort<16, false>(a + 48);
#pragma unroll
    for (int i = 0; i < 16; ++i) a[i] = a[i] > a[16 + i] ? a[i] : a[16 + i];
    bitonic_merge<16, true>(a);
#pragma unroll
    for (int i = 0; i < 16; ++i) a[32 + i] = a[32 + i] > a[48 + i] ? a[32 + i] : a[48 + i];
    bitonic_merge<16, false>(a + 32);
#pragma unroll
    for (int i = 0; i < 16; ++i) a[i] = a[i] > a[32 + i] ? a[i] : a[32 + i];
    bitonic_merge<16, true>(a);
}
template <int PASS> __device__ __forceinline__ void route_pass(const bf16* QP, const LAS char* lds, int tok, int head, int r32, int hi, unsigned (&top)[16]) {
    f32x16 acc[4] = {};
    const bf16* qp = QP + (size_t)tok * DM + head * 256 + PASS * 128 + hi * 8;
    bf16x8 qf[8];
#pragma unroll
    for (int ks = 0; ks < 8; ++ks) qf[ks] = *(const bf16x8*)(qp + ks * 16);
    const LAS char* Kl = lds + PASS * 32768;
#pragma unroll
    for (int kb = 0; kb < 4; ++kb)
#pragma unroll
        for (int ks = 0; ks < 8; ++ks) { const bf16x8 a = *(const LAS bf16x8*)(Kl + (kb * 32 + r32) * 256 + (((ks * 2 + hi) ^ (r32 & 15)) * 16));
            acc[kb] = __builtin_amdgcn_mfma_f32_32x32x16_bf16(a, qf[ks], acc[kb], 0, 0, 0); }
    unsigned key[64]; const unsigned base = 127u - 4u * (unsigned)hi;
#pragma unroll
    for (int kb = 0; kb < 4; ++kb)
#pragma unroll
        for (int r = 0; r < 16; ++r) key[kb * 16 + r] = (f2ord(acc[kb][r]) & ~127u) | (base - (unsigned)(kb * 32 + (r & 3) + 8 * (r >> 2)));
    top16_of_64(key);
    unsigned pr[16];
#pragma unroll
    for (int i = 0; i < 16; ++i) pr[i] = lane_xor32(key[15 - i], hi << 5);
#pragma unroll
    for (int i = 0; i < 16; ++i) key[i] = key[i] > pr[i] ? key[i] : pr[i];
    bitonic_merge<16, true>(key);
#pragma unroll
    for (int i = 0; i < 16; ++i) top[i] = key[i];
}
__device__ __forceinline__ void route_phase(CP P, int L, int Mrows, LAS unsigned char* lds_, int tid, int lane, int wid, int gw, int NGW) {
    const bf16* QP = (const bf16*)(P->ws + WS_QP); unsigned* ROUTE = (unsigned*)(P->ws + WS_ROUTE);
    LAS char* lds = (LAS char*)(LAS unsigned char*)lds_;
    __syncthreads();
    {
        const bf16* K1 = (const bf16*)(P->ws + WS_PK1) + (size_t)L * 128 * 128; const bf16* K2 = (const bf16*)(P->ws + WS_PK2) + (size_t)L * 128 * 128;
        for (int c16 = tid; c16 < 2 * 128 * 16; c16 += NWAVES * 64) { const int mat = c16 >> 11, row = (c16 >> 4) & 127, ch = c16 & 15;
            const u32x4 w = *(const u32x4*)((mat ? K2 : K1) + row * 128 + ch * 8);
            *(LAS u32x4*)(lds + mat * 32768 + row * 256 + ((ch ^ (row & 15)) * 16)) = w; }
    }
    __syncthreads();
    LAS unsigned* sc = (LAS unsigned*)(lds + 65536) + wid * 2048;
    const int r32 = lane & 31, hi = lane >> 5;
    for (int item = gw; item < Mrows / 4; item += NGW) {
        const int tok = item * 4 + (r32 >> 3), head = r32 & 7;
        unsigned top0[16], top1[16];
        route_pass<0>(QP, lds, tok, head, r32, hi, top0);
        route_pass<1>(QP, lds, tok, head, r32, hi, top1);
        float v1[16], v2[16];
#pragma unroll
        for (int i = 0; i < 16; ++i) { v1[i] = ord2f(top0[i] & ~127u); v2[i] = ord2f(top1[i] & ~127u);
            sc[i * 64 + lane] = 127u - (top0[i] & 127u); sc[(16 + i) * 64 + lane] = 127u - (top1[i] & 127u); }
        unsigned ck[64]; int n = 0;
#pragma unroll
        for (int i = 0; i < 16; ++i)
#pragma unroll
            for (int j = 0; j < 16; ++j) if ((i + 1) * (j + 1) <= 16) { ck[n] = (f2ord(v1[i] + v2[j]) & ~255u) | (unsigned)(i * 16 + j); ++n; }
#pragma unroll
        for (int i = 50; i < 64; ++i) ck[i] = 0u;
        top16_of_64(ck);
        float ev[16]; float sum = 0.f; const float mx = ord2f(ck[0] & ~255u);
#pragma unroll
        for (int k = 0; k < 16; ++k) { ev[k] = __expf(ord2f(ck[k] & ~255u) - mx); sum += ev[k]; }
        const float inv = 1.0f / sum;
        unsigned ee[16];
#pragma unroll
        for (int k = 0; k < 16; ++k) { const unsigned pc = ck[k] & 255u; const unsigned i1 = sc[(pc >> 4) * 64 + lane], i2 = sc[(16 + (pc & 15u)) * 64 + lane]; ee[k] = i1 * 128u + i2; ev[k] *= inv; }
        u32x4* outp = (u32x4*)(ROUTE + ((size_t)tok * 128 + head * 16 + hi * 8) * 2);
#pragma unroll
        for (int k = 0; k < 8; k += 2) { u32x4 w;
            const unsigned eL0 = ee[k], eH0 = ee[k + 8], eL1 = ee[k + 1], eH1 = ee[k + 9]; const float gL0 = ev[k], gH0 = ev[k + 8], gL1 = ev[k + 1], gH1 = ev[k + 9];
            w.x = hi ? eH0 : eL0; w.y = __float_as_uint(hi ? gH0 : gL0); w.z = hi ? eH1 : eL1; w.w = __float_as_uint(hi ? gH1 : gL1);
            outp[k >> 1] = w; }
    }
}

typedef float f32x2 __attribute__((ext_vector_type(2)));
typedef float f32x32 __attribute__((ext_vector_type(32)));
typedef unsigned u32x6 __attribute__((ext_vector_type(6)));
typedef __bf16 bf16x32 __attribute__((ext_vector_type(32)));
typedef unsigned u32x16 __attribute__((ext_vector_type(16)));
typedef __bf16 bf16x2_t __attribute__((ext_vector_type(2)));
constexpr int GS = 6, GSLOT = 2 * PROW;
__device__ __forceinline__ void glds16(const void* gsrc, unsigned lds_dst) { unsigned keep;
  asm volatile("s_mov_b32 %0, m0\n\ts_mov_b32 m0, %2\n\ts_nop 0\n\tglobal_load_lds_dwordx4 %1, off\n\ts_mov_b32 m0, %0" : "=&s"(keep) : "v"(gsrc), "s"(lds_dst) : "memory"); }
template <int GMODE = 0>
__device__ __forceinline__ void gather_phase(CP P, int L, int Mrows, LAS unsigned char* lds, int wid, int lane_, int gw, int NGW, bool dry = false) {
    const unsigned char* U = P->ws + WS_PU + (size_t)L * 16384 * PROW; const unsigned char* V = P->ws + WS_PV + (size_t)L * 16384 * PROW;
    const unsigned* ROUTE = (const unsigned*)(P->ws + WS_ROUTE); const float* MOD = (const float*)(P->ws + WS_MOD);
    bf16* X = (bf16*)(P->ws + WS_X); bf16* H = (bf16*)(P->ws + WS_H); bf16* Xo = dry ? (bf16*)(P->ws + WS_Y) : X; bf16* Ho = dry ? (bf16*)(P->ws + WS_G) : H;
    const float* lng = P->in[6] + (size_t)(L * 2 + 1) * DM; const float* lnb = P->in[7] + (size_t)(L * 2 + 1) * DM;
    const unsigned ring = (unsigned)(uintptr_t)lds + (unsigned)wid * (GS * GSLOT);
    for (int row = gw; row < Mrows; row += NGW) {
        const int lane = launder_v(lane_);
        const u32x2 ea = ((const u32x2*)(ROUTE + (size_t)row * 256))[lane], eb = ((const u32x2*)(ROUTE + (size_t)row * 256))[64 + lane];
        unsigned eax, eay, ebx, eby;
        unsigned hw[16];
#pragma unroll
        for (int j = 0; j < 4; ++j) { const u32x4 w = ((const u32x4*)(H + (size_t)row * DM))[4 * lane + j]; hw[4 * j] = w.x; hw[4 * j + 1] = w.y; hw[4 * j + 2] = w.z; hw[4 * j + 3] = w.w; }
        float y[32];
#pragma unroll
        for (int i = 0; i < 32; ++i) y[i] = 0.f;
        { unsigned e0 = ea.x, e1 = ea.y, e2 = eb.x, e3 = eb.y;
          asm volatile("" : "+v"(e0), "+v"(e1), "+v"(e2), "+v"(e3), "+v"(hw[0]), "+v"(hw[1]), "+v"(hw[2]), "+v"(hw[3]), "+v"(hw[4]), "+v"(hw[5]), "+v"(hw[6]), "+v"(hw[7]),
                       "+v"(hw[8]), "+v"(hw[9]), "+v"(hw[10]), "+v"(hw[11]), "+v"(hw[12]), "+v"(hw[13]), "+v"(hw[14]), "+v"(hw[15]) :: "memory");
          eax = e0; eay = e1; ebx = e2; eby = e3; }
        const unsigned rd_a = ring + 16u * (unsigned)lane, rd_b = ring + 1024u + 8u * (unsigned)lane;
#define G_ISSUE(k) do { const int k_ = (k); const unsigned e_ = (unsigned)__builtin_amdgcn_readlane((int)(k_ < 64 ? eax : ebx), k_ & 63); \
        const unsigned char* up_ = U + (size_t)e_ * PROW + 16 * lane; const unsigned char* vp_ = V + (size_t)e_ * PROW + 16 * lane; const unsigned sb_ = ring + (unsigned)(k_ % GS) * GSLOT; \
        if (GMODE != 2) { glds16(up_, sb_); glds16(vp_, sb_ + PROW); if (lane < 32) { glds16(up_ + 1024, sb_ + 1024); glds16(vp_ + 1024, sb_ + PROW + 1024); } } else { asm volatile("" :: "v"(up_), "v"(vp_), "s"(sb_)); } } while (0)
#pragma unroll
        for (int k = 0; k < 4; ++k) G_ISSUE(k);
#define G_READ(k, ua, ub, va, vb) do { const unsigned so_ = (unsigned)((k) % GS) * GSLOT; \
        asm volatile("ds_read_b128 %0, %4\n\tds_read_b64 %1, %5\n\tds_read_b128 %2, %4 offset:1536\n\tds_read_b64 %3, %5 offset:1536" \
                     : "=&v"(ua), "=&v"(ub), "=&v"(va), "=&v"(vb) : "v"(rd_a + so_), "v"(rd_b + so_) : "memory"); } while (0)
#pragma unroll 1
        for (int k = 0; k < 128; k += 2) {
            if (k + 4 < 128) { G_ISSUE(k + 4); G_ISSUE(k + 5); asm volatile("s_waitcnt vmcnt(16)" ::: "memory"); }
            else if (k == 124) asm volatile("s_waitcnt vmcnt(8)" ::: "memory");
            else asm volatile("s_waitcnt vmcnt(0)" ::: "memory");
            u32x4 uaA, vaA, uaB, vaB; u32x2 ubA, vbA, ubB, vbB;
            G_READ(k, uaA, ubA, vaA, vbA); G_READ(k + 1, uaB, ubB, vaB, vbB);
            asm volatile("s_waitcnt lgkmcnt(0)" : "+v"(uaA), "+v"(ubA), "+v"(vaA), "+v"(vbA), "+v"(uaB), "+v"(ubB), "+v"(vaB), "+v"(vbB) :: "memory");
            if (GMODE == 1) continue;
            const u32x6 u6A = {uaA.x, uaA.y, uaA.z, uaA.w, ubA.x, ubA.y}, u6B = {uaB.x, uaB.y, uaB.z, uaB.w, ubB.x, ubB.y};
            const u32x16 ubfA = __builtin_bit_cast(u32x16, __builtin_amdgcn_cvt_scalef32_pk32_bf16_fp6(u6A, 1.0f));
            const u32x16 ubfB = __builtin_bit_cast(u32x16, __builtin_amdgcn_cvt_scalef32_pk32_bf16_fp6(u6B, 1.0f));
            float a0 = 0.f, a1 = 0.f, b0 = 0.f, b1 = 0.f;
#pragma unroll
            for (int q = 0; q < 16; q += 2) { const unsigned h0_ = hw[q], h1_ = hw[q + 1], x0_ = ubfA[q], x1_ = ubfA[q + 1], z0_ = ubfB[q], z1_ = ubfB[q + 1];
                a0 = __builtin_amdgcn_fdot2_f32_bf16(__builtin_bit_cast(bf16x2_t, h0_), __builtin_bit_cast(bf16x2_t, x0_), a0, false);
                a1 = __builtin_amdgcn_fdot2_f32_bf16(__builtin_bit_cast(bf16x2_t, h1_), __builtin_bit_cast(bf16x2_t, x1_), a1, false);
                b0 = __builtin_amdgcn_fdot2_f32_bf16(__builtin_bit_cast(bf16x2_t, h0_), __builtin_bit_cast(bf16x2_t, z0_), b0, false);
                b1 = __builtin_amdgcn_fdot2_f32_bf16(__builtin_bit_cast(bf16x2_t, h1_), __builtin_bit_cast(bf16x2_t, z1_), b1, false); }
            const float dA = wave_sum(a0 + a1) * (1.0f / U_SCALE), dB = wave_sum(b0 + b1) * (1.0f / U_SCALE);
            const unsigned gsel = k < 64 ? eay : eby;
            const float wA = __uint_as_float((unsigned)__builtin_amdgcn_readlane((int)gsel, k & 63)) * gelu_tanh(dA) * (1.0f / V_SCALE);
            const float wB = __uint_as_float((unsigned)__builtin_amdgcn_readlane((int)gsel, (k & 63) + 1)) * gelu_tanh(dB) * (1.0f / V_SCALE);
            const u32x6 v6A = {vaA.x, vaA.y, vaA.z, vaA.w, vbA.x, vbA.y};
            const f32x32 vfA = __builtin_amdgcn_cvt_scalef32_pk32_f32_fp6(v6A, 1.0f);
#pragma unroll
            for (int i = 0; i < 32; ++i) y[i] += wA * vfA[i];
            const u32x6 v6B = {vaB.x, vaB.y, vaB.z, vaB.w, vbB.x, vbB.y};
            const f32x32 vfB = __builtin_amdgcn_cvt_scalef32_pk32_f32_fp6(v6B, 1.0f);
#pragma unroll
            for (int i = 0; i < 32; ++i) y[i] += wB * vfB[i];
        }
#undef G_READ
#undef G_ISSUE
        const int slot = row_slot(row);
        const float* mod = MOD + (size_t)(L * 3 + slot) * 12288;
        const int le = launder_v(lane);
        { float xx[32], gg[32]; load_row_bf16_b(X + (size_t)row * DM, le, xx); load_row_f32_b(mod + 5 * 2048, le, gg);
#pragma unroll
          for (int i = 0; i < 32; ++i) y[i] = ALPHA * xx[i] + gg[i] * y[i]; }
        if (L < NLAYER - 1) { const float* modn = MOD + (size_t)((L + 1) * 3 + slot) * 12288;
            finish_row<true>(y, lng, lnb, Xo + (size_t)row * DM, modn, modn + 2048, Ho + (size_t)row * DM, nullptr, le); }
        else finish_row<true>(y, lng, lnb, nullptr, nullptr, nullptr, nullptr, P->out + (size_t)row * DM, le);
        asm volatile("s_waitcnt vmcnt(0)" ::: "memory");
    }
}

#ifndef ROPE_TEST
#define ROPE_TEST 0
#endif
#ifndef PROBE_DUP
#define PROBE_DUP 0
#endif
#define NOINL __forceinline__
__device__ __forceinline__ CP launder_cp(CP p) { asm volatile("" : "+s"(p)); return p; }
#define GETP() launder_cp((CP)__builtin_amdgcn_kernarg_segment_ptr())
__device__ __forceinline__ int uni(int v) { return __builtin_amdgcn_readfirstlane(v); }
__device__ __forceinline__ LAS unsigned char* uni_lds(LAS unsigned char* p) { return (LAS unsigned char*)(unsigned)__builtin_amdgcn_readfirstlane((int)(unsigned)(uintptr_t)p); }
#define PH_IDS const int wid = uni(wv_), lane = launder_v(lane_id_fresh()) & 63, tid = (wid & 7) * 64 + lane; const int gw = blockIdx.x * NWAVES + wid, NGW = gridDim.x * NWAVES; (void)lane; (void)gw; (void)NGW; (void)tid;

__device__ NOINL void ph_prologue(int wv_, LAS unsigned char* lds_) { CP P = GETP(); LAS unsigned char* lds = uni_lds(lds_); PH_IDS p0_prologue(P, lds, tid, lane, wid, gw, NGW); if (PROBE_DUP == 5) p0_prologue(P, lds, tid, lane, wid, gw, NGW); }
__device__ NOINL void ph_modreduce(int wv_) { CP P = GETP(); PH_IDS mod_reduce(P, gw, lane, NGW); }
__device__ NOINL void ph_first(int wv_) { CP P = GETP(); PH_IDS
#pragma unroll 1
    for (int rep = 0; rep < (PROBE_DUP == 6 ? 2 : 1); ++rep) first_row_pass(P, lane, gw, NGW); }
__device__ NOINL void ph_postmix(int wv_, int L_, int M_) { CP P = GETP(); const int L = uni(L_), Mrows = uni(M_); PH_IDS post_mixer_pass(P, L, Mrows, lane, gw, NGW); }
__device__ NOINL void ph_vstats(int wv_, int M_) { CP P = GETP(); const int Mrows = uni(M_); PH_IDS
#pragma unroll 1
    for (int rep = 0; rep < (PROBE_DUP == 6 ? 2 : 1); ++rep) vstats_pass(P, Mrows, lane, gw, NGW); }
__device__ NOINL void ph_spatial(int wv_, LAS unsigned char* lds_, int j_, int M_) { CP P = GETP(); LAS unsigned char* lds = uni_lds(lds_); const int j = uni(j_), Mrows = uni(M_); PH_IDS
#pragma unroll 1
    for (int rep = 0; rep < (PROBE_DUP == 6 ? 2 : 1); ++rep) spatial_phase(P, j, Mrows, lds, tid, lane, wid); }
__device__ NOINL void ph_mla_norm(int wv_) { CP P = GETP(); PH_IDS
#pragma unroll 1
    for (int rep = 0; rep < (PROBE_DUP == 6 ? 2 : 1); ++rep) mla_norm_pass(P, lane, gw, NGW); }
__device__ NOINL void ph_rope(int wv_, int which_) { CP P = GETP(); const int which = uni(which_); PH_IDS
    if (which == 0) rope_pass((bf16*)(P->ws + WS_QM), 3072, 128, 16, 192, lane, gw, NGW);
    else rope_pass((bf16*)(P->ws + WS_Z), 6144, 0, 64, 64, lane, gw, NGW); }
__device__ NOINL void ph_attn_mla(int wv_, LAS unsigned char* lds_) { CP P = GETP(); LAS unsigned char* lds = uni_lds(lds_); PH_IDS mla_attn_phase(P, lds, tid); if (PROBE_DUP == 2) mla_attn_phase(P, lds, tid); }
__device__ NOINL void ph_attn_da(int wv_, LAS unsigned char* lds_, int L_) { CP P = GETP(); LAS unsigned char* lds = uni_lds(lds_); const int L = uni(L_); PH_IDS
    const float* lp = P->in[26];
    const float s01 = wave_sum(lp[lane] * lp[64 + lane]), s23 = wave_sum(lp[128 + lane] * lp[192 + lane]);
    const float lam_init = 0.8f - 0.6f * expf(-0.3f * (float)L);
    const float lam = expf(s01) - expf(s23) + lam_init;
    da_attn_phase(P, lam, 1.0f - lam_init, lds, tid); if (PROBE_DUP == 2) da_attn_phase(P, lam, 1.0f - lam_init, lds, tid); }
__device__ NOINL void ph_route(int wv_, LAS unsigned char* lds_, int L_, int M_) { CP P = GETP(); LAS unsigned char* lds = uni_lds(lds_); const int L = uni(L_), Mrows = uni(M_); PH_IDS
#pragma unroll 1
    for (int rep = 0; rep < (PROBE_DUP == 4 ? 2 : 1); ++rep) route_phase(P, L, Mrows, lds, tid, lane, wid, gw, NGW); }
__device__ NOINL void ph_gather(int wv_, LAS unsigned char* lds_, int L_, int M_) { CP P = GETP(); LAS unsigned char* lds = uni_lds(lds_); const int L = uni(L_), Mrows = uni(M_); PH_IDS
    if (PROBE_DUP == 3) { gather_phase<0>(P, L, Mrows, lds, wid, lane, gw, NGW, true); }
    if (PROBE_DUP == 7) { gather_phase<1>(P, L, Mrows, lds, wid, lane, gw, NGW, true); }
    if (PROBE_DUP == 8) { gather_phase<2>(P, L, Mrows, lds, wid, lane, gw, NGW, true); }
    gather_phase<0>(P, L, Mrows, lds, wid, lane, gw, NGW); }

enum GemmId { G_GM_IN = 0, G_GM_OUT, G_MLA_IN, G_MLA_UQ, G_MLA_UKV, G_MLA_OUT, G_DA_IN, G_DA_OUT, G_PEER_Q };
__device__ NOINL void ph_gemm(int wv_, LAS unsigned char* lds_, int id_, int L_, int M_) {
    CP P = GETP(); LAS unsigned char* lds = uni_lds(lds_); const int id = uni(id_), L = uni(L_), Mrows = uni(M_); PH_IDS
    unsigned char* ws = P->ws; const int jj = L / 3;
    size_t a = WS_H, b = 0, o = 0; int M = MT, N = 2048, K = 2048, act = 0, rope = 0;
    switch (id) {
        case G_GM_IN:   a = WS_H;    b = WS_GMWIN + (size_t)jj * 4096 * 2048 * 2;  o = WS_Z;  M = Mrows; N = 4096; K = 2048; act = 1; break;
        case G_GM_OUT:  a = WS_G;    b = WS_GMWOUT + (size_t)jj * 2048 * 2048 * 2; o = WS_Y;  M = Mrows; N = 2048; K = 2048; break;
        case G_MLA_IN:  a = WS_H;    b = WS_MLAIN;  o = WS_C;  N = 1280; K = 2048; break;
        case G_MLA_UQ:  a = WS_CQN;  b = WS_MLAUQ;  o = WS_QM; N = 3072; K = 512;  rope = (ROPE_TEST == 2) ? 0 : 2; break;
        case G_MLA_UKV: a = WS_CKVN; b = WS_MLAUKV; o = WS_KV; N = 4096; K = 512;  break;
        case G_MLA_OUT: a = WS_G;    b = WS_MLAOUT; o = WS_Y;  N = 2048; K = 2048; break;
        case G_DA_IN:   a = WS_H;    b = WS_DAIN;   o = WS_Z;  N = 6144; K = 2048; rope = (ROPE_TEST == 1) ? 0 : 1; break;
        case G_DA_OUT:  a = WS_G;    b = WS_DAOUT;  o = WS_Y;  N = 2048; K = 2048; break;
        default:        a = WS_H;    b = WS_PWQ + (size_t)L * 2048 * 2048 * 2;     o = WS_QP; M = Mrows; N = 2048; K = 2048; break;
    }
    pg8::Gemm g{(const pg8::bf16_t*)(ws + a), (const pg8::bf16_t*)(ws + b), M, N, K}; pg8::StaticOrder S; S.init(M, N, (int)gridDim.x, (int)blockIdx.x);
    pg8::EpiR E{(pg8::bf16_t*)(ws + o), N, act, rope, (const float*)(ws + WS_ROPE)};
#pragma unroll 1
    for (int rep = 0; rep < (PROBE_DUP == 1 ? 2 : 1); ++rep) { pg8::gemm_phase<pg8::EpiR, pg8::StaticOrder, true, true>((PG8_LAS unsigned char*)lds, g, S, E, tid); __syncthreads(); }
}

__global__ void __launch_bounds__(NWAVES * 64, 2) mk_fwd(Params Pv) {
    extern __shared__ __attribute__((aligned(16))) unsigned char lds_g[];
    LAS unsigned char* lds = (LAS unsigned char*)lds_g;
    const int wv = __builtin_amdgcn_readfirstlane((int)threadIdx.x >> 6);
    const int tid = wv * 64 + lane_id_fresh();
    for (int u = tid; u < (LDS_BYTES - RING_BYTES) / 4; u += NWAVES * 64) ((LAS unsigned*)(lds + RING_BYTES))[u] = 0u;
    __syncthreads();
    const int lo = Pv.ph_lo, hi = Pv.ph_hi;
    unsigned* barw = (unsigned*)(Pv.ws + WS_CTL) + CW_BAR;
    XcdBarrier bar; bar.bar = barw; bar.x = 0; bar.st = nullptr;
    if (hi - lo > 1) bar = xcd_barrier_post(barw, (volatile LAS unsigned*)(lds + MISC_OFF) + 8, tid == 0);
    int ph = 0;
#ifndef SEL
#define SELP(k) true
#else
#define SELP(k) ((k) == SEL)
#endif
    enum { RUN_BASE = __COUNTER__ + 1 };
#define RUN(call) do { if (SELP(__COUNTER__ - RUN_BASE) && ph >= lo && ph < hi) { call; } if (ph >= lo && ph + 1 < hi) xcd_barrier(bar, wv == 0 && lane_id_fresh() == 0); ++ph; } while (0)
    RUN(ph_prologue(wv, lds));
    RUN(ph_modreduce(wv));
    RUN(ph_first(wv));
#define LAYER(LL) do { constexpr int L = (LL); constexpr int kind = L % 3, jj = L / 3; constexpr int Mrows = (L == NLAYER - 1) ? ML : MT;     \
        if (kind == 0) {                          \
            RUN(ph_gemm(wv, lds, G_GM_IN, L, Mrows)); \
            RUN(ph_vstats(wv, Mrows)); \
            RUN(ph_spatial(wv, lds, jj, Mrows)); \
            RUN(ph_gemm(wv, lds, G_GM_OUT, L, Mrows)); \
        } else if (kind == 1) {                   \
            RUN(ph_gemm(wv, lds, G_MLA_IN, L, Mrows)); \
            RUN(ph_mla_norm(wv)); \
            RUN(ph_gemm(wv, lds, G_MLA_UQ, L, Mrows); ph_gemm(wv, lds, G_MLA_UKV, L, Mrows)); \
            if (ROPE_TEST == 2) { RUN(ph_rope(wv, 0)); } \
            RUN(ph_attn_mla(wv, lds)); \
            RUN(ph_gemm(wv, lds, G_MLA_OUT, L, Mrows)); \
        } else {                                  \
            RUN(ph_gemm(wv, lds, G_DA_IN, L, Mrows); if (ROPE_TEST == 1) { __syncthreads(); } ); \
            if (ROPE_TEST == 1) { RUN(ph_rope(wv, 1)); } \
            RUN(ph_attn_da(wv, lds, L)); \
            RUN(ph_gemm(wv, lds, G_DA_OUT, L, Mrows)); \
        } \
        RUN(ph_postmix(wv, L, Mrows));                \
        RUN(ph_gemm(wv, lds, G_PEER_Q, L, Mrows));    \
        RUN(ph_route(wv, lds, L, Mrows));             \
        RUN(ph_gather(wv, lds, L, Mrows));            \
    } while (0)
    LAYER(0); LAYER(1); LAYER(2); LAYER(3);
#undef LAYER
#undef RUN
}

extern "C" void kernel_launch(void* const* d_in, const int* in_sizes, int n_in, void* d_out, int out_size, void* d_ws, size_t ws_size, hipStream_t stream) {
    static int grid = 0;
    if (grid == 0) {
        if (n_in != 29 || in_sizes[0] != ML * DM || out_size != ML * DM || ws_size < WS_END) {
            fprintf(stderr, "kernel_launch: shape mismatch: n_in %d in0 %d out %d ws %zu (need %zu); nothing launched\n", n_in, n_in > 0 ? in_sizes[0] : -1, out_size, ws_size, (size_t)WS_END); grid = -1; return; }
        int dev = 0, cus = 0, per_cu = 0;
        if (hipGetDevice(&dev) != hipSuccess || hipDeviceGetAttribute(&cus, hipDeviceAttributeMultiprocessorCount, dev) != hipSuccess) { fprintf(stderr, "kernel_launch: device query failed\n"); grid = -1; return; }
        if (hipFuncSetAttribute((const void*)mk_fwd, hipFuncAttributeMaxDynamicSharedMemorySize, LDS_BYTES) != hipSuccess) { fprintf(stderr, "kernel_launch: hipFuncSetAttribute failed\n"); grid = -1; return; }
        if (hipOccupancyMaxActiveBlocksPerMultiprocessor(&per_cu, (const void*)mk_fwd, NWAVES * 64, LDS_BYTES) != hipSuccess || per_cu < 1)
            fprintf(stderr, "kernel_launch: note: occupancy query reports %d workgroups per CU\n", per_cu);
        (void)hipGetLastError();
        grid = cus;
    }
    if (grid < 0) return;
    if (hipMemsetAsync((char*)d_ws + WS_CTL, 0, CTL_ZERO_BYTES, stream) != hipSuccess) { fprintf(stderr, "kernel_launch: memset failed\n"); return; }
    Params p{};
    for (int i = 0; i < 29; ++i) p.in[i] = (const float*)d_in[i];
    p.out = (float*)d_out; p.ws = (unsigned char*)d_ws;
#if MK_ONE_LAUNCH
    p.ph_lo = 0; p.ph_hi = NPH;
    hipLaunchKernelGGL(mk_fwd, dim3(grid), dim3(NWAVES * 64), LDS_BYTES, stream, p);
#else
    for (int li = 0; li < NPH; ++li) { p.ph_lo = li; p.ph_hi = li + 1; hipLaunchKernelGGL(mk_fwd, dim3(grid), dim3(NWAVES * 64), LDS_BYTES, stream, p); }
#endif
    const hipError_t le = hipPeekAtLastError();
    if (le != hipSuccess) fprintf(stderr, "kernel_launch: launch failed: %s\n", hipGetErrorName(le));
}
```

```cpp
#include <hip/hip_runtime.h>
#include <cstdio>
#include <cstdint>
#ifndef MK_ONE_LAUNCH
#define MK_ONE_LAUNCH 1
#endif
__device__ __forceinline__ int launder_v(int v) { asm volatile("" : "+v"(v)); return v; }
__device__ __forceinline__ int lane_id_fresh() { unsigned m = ~0u; asm volatile("" : "+s"(m)); return (int)__builtin_amdgcn_mbcnt_hi(m, __builtin_amdgcn_mbcnt_lo(m, 0u)); }
namespace pg8 {
#define PG8_LAS __attribute__((address_space(3)))
typedef unsigned short bf16_t;
typedef short bf16x8 __attribute__((ext_vector_type(8)));
typedef float f32x4 __attribute__((ext_vector_type(4)));
typedef unsigned u32x4 __attribute__((ext_vector_type(4)));
constexpr int BM = 256, BK = 64, HALF = 128, HTB = HALF * BK * 2  , STAGE_BYTES = 8 * HTB, NXCD = 8, WGM = 8;

__host__ __device__ __forceinline__ int lds_byte(int r, int c) { const int st = (r >> 4) * 2 + (c >> 5), rr = r & 15, cc = c & 31, ob = rr * 64 + cc * 2; return st * 1024 + (ob ^ (((ob >> 9) & 1) << 5)); }
__host__ __device__ __forceinline__ void stage_rc(int b, int& R, int& C) { const int st = b / 1024, sb = b % 1024, swz = sb ^ (((sb >> 9) & 1) << 5); R = (st >> 1) * 16 + swz / 64; C = (st & 1) * 32 + (swz % 64) / 2; }
__host__ __device__ __forceinline__ int perm32(int rho) { const int n = rho >> 4, i = rho & 15; return 8 * (i >> 2) + 4 * n + (i & 3); }

struct Unit { int pm, pn; };
struct Gemm { const bf16_t* A; const bf16_t* Bt; int M, N, K; };

struct StaticOrder {
    int nM, nN, nwg, G, c;
    __host__ __device__ void init(int M, int N, int G_, int c_) { nM = M / BM; nN = N / BM; nwg = nM * nN; G = G_; c = c_; }
    __host__ __device__ bool next(int i, Unit& u) const {
        const long L = (long)i * G + c; if (L >= nwg) return false;
        int wgid = (int)L; { const int q = nwg / NXCD, r = nwg % NXCD, xcd = wgid % NXCD, off = wgid / NXCD; wgid = (xcd < r ? xcd * (q + 1) : r * (q + 1) + (xcd - r) * q) + off; }
        const int nig = WGM * nN, gid = wgid / nig, fm = gid * WGM, gsz = (nM - fm) < WGM ? (nM - fm) : WGM;
        u.pm = fm + ((wgid % nig) % gsz); u.pn = (wgid % nig) / gsz; return true;
    }
    __device__ __forceinline__ void a_ready(const Unit&) const {}
    __device__ __forceinline__ void done(const Unit&) const {}
};

__device__ __forceinline__ unsigned cvt_pk_bf16(float lo, float hi) { unsigned r; asm volatile("v_cvt_pk_bf16_f32 %0, %1, %2" : "=v"(r) : "v"(lo), "v"(hi)); return r; }
typedef float f32x2 __attribute__((ext_vector_type(2)));
__device__ __forceinline__ f32x2 gelu_pk(f32x2 v) {
    const f32x2 av = __builtin_elementwise_abs(v), d = av * 0.2316418882f + 1.0f;
    f32x2 t; t.x = __builtin_amdgcn_rcpf(d.x); t.y = __builtin_amdgcn_rcpf(d.y);
    f32x2 q = t * 0.5307027145f + (-0.7265760135f); q = q * t + 0.7107068705f; q = q * t + (-0.142248368f); q = q * t + 0.127414796f; q = q * t;
    const f32x2 s = (v * v) * (-0.72134752044f);
    f32x2 e; e.x = __builtin_amdgcn_exp2f(s.x); e.y = __builtin_amdgcn_exp2f(s.y);
    const f32x2 m = v * (q * e), r = v - m;
    f32x2 o; o.x = v.x < 0.f ? m.x : r.x; o.y = v.y < 0.f ? m.y : r.y; return o;
}

template <int ACT  > struct EpiBf16 {
    static constexpr bool PERM = true, AFTER_DRAIN = false; static_assert(ACT == 0 || ACT == 1, "EpiBf16: ACT is 0 (none) or 1 (gelu_pk)");
    bf16_t* O; int ldc; const float* bias; int split_cols; size_t split_stride; float scale0;
    __device__ __forceinline__ void operator()(const f32x4 (&acc)[2][2][4][2], const Unit& u, int wr, int wc, int fr, int fq) const {
        const int row0 = u.pm * BM + wr * 64 + fr; int colt = u.pn * BM; bf16_t* base = O;
        float sc = 1.f; if (split_cols) { const int t = colt / split_cols; base += (size_t)t * split_stride; colt -= t * split_cols; if (t == 0) sc = scale0; }
        const int col0 = colt + wc * 32 + 8 * fq, bcol0 = u.pn * BM + wc * 32 + 8 * fq;
        f32x4 bv[2][2];
#pragma unroll
        for (int bj = 0; bj < 2; ++bj)
#pragma unroll
            for (int n = 0; n < 2; ++n) bv[bj][n] = bias ? *(const f32x4*)(bias + bcol0 + bj * HALF + 4 * n) : (f32x4){0.f, 0.f, 0.f, 0.f};
#pragma unroll
        for (int ai = 0; ai < 2; ++ai)
#pragma unroll
            for (int m = 0; m < 4; ++m) { bf16_t* rowp = base + (size_t)(row0 + ai * HALF + m * 16) * ldc + col0;
#pragma unroll
                for (int bj = 0; bj < 2; ++bj) { f32x4 v0 = acc[ai][bj][m][0] + bv[bj][0], v1 = acc[ai][bj][m][1] + bv[bj][1];
                    if (ACT == 1) { f32x2 a = gelu_pk((f32x2){v0[0], v0[1]}), b = gelu_pk((f32x2){v0[2], v0[3]}), c = gelu_pk((f32x2){v1[0], v1[1]}), d = gelu_pk((f32x2){v1[2], v1[3]});
                        v0 = (f32x4){a.x, a.y, b.x, b.y}; v1 = (f32x4){c.x, c.y, d.x, d.y}; }
                    v0 = v0 * sc; v1 = v1 * sc; u32x4 w; w.x = cvt_pk_bf16(v0[0], v0[1]); w.y = cvt_pk_bf16(v0[2], v0[3]); w.z = cvt_pk_bf16(v1[0], v1[1]); w.w = cvt_pk_bf16(v1[2], v1[3]);
                    *(u32x4*)(rowp + bj * HALF) = w; } }
    }
};
template <class Epi, class Sched, bool ALIGN_EPI = false, bool SP2 = false>
__device__ __forceinline__ void gemm_phase(PG8_LAS unsigned char* lds, const Gemm g, const Sched& S, const Epi& E, const int tid_in) {
    const int tid = launder_v(tid_in) & 511, wid = __builtin_amdgcn_readfirstlane(tid >> 6), lane = tid & 63, wr = wid >> 2, wc = wid & 3, fr = lane & 15, fq = lane >> 4;
    const int K = g.K, nt = K / BK;
    unsigned voffA[2], voffB[2];
#pragma unroll
    for (int i = 0; i < 2; ++i) { int R, C; stage_rc(tid * 16 + i * 8192, R, C); const int Rb = Epi::PERM ? ((R & ~31) + perm32(R & 31)) : R;
        voffA[i] = (unsigned)(R * K + C) * 2u; voffB[i] = (unsigned)(Rb * K + C) * 2u; }
    const size_t kstep = (size_t)(BK * 2);
    const size_t hstep = (size_t)HALF * K * 2;
    const size_t tstep = 2 * hstep;
    const unsigned ldsw = (unsigned)wid * 1024u;
    const int aoff = lds_byte(wr * 64 + fr, fq * 8), boff = lds_byte(wc * 32 + fr, fq * 8);
#define PG8_SA(b, h) (((b) * 2 + (h)) * HTB)
#define PG8_SB(b, h) ((4 + (b) * 2 + (h)) * HTB)
#define PG8_STAGE(bufoff, gbase, voff) do { _Pragma("unroll") for (int _i = 0; _i < 2; ++_i) \
        __builtin_amdgcn_global_load_lds((const unsigned*)((const char*)(gbase) + (voff)[_i]), (PG8_LAS unsigned*)(lds + (bufoff) + ldsw + _i * 8192), 16, 0, 0); } while (0)
#define PG8_LDA(dst, b, h) do { _Pragma("unroll") for (int m = 0; m < 4; ++m) _Pragma("unroll") for (int k = 0; k < 2; ++k) dst[m][k] = *(const PG8_LAS bf16x8*)(lds + PG8_SA(b, h) + aoff + m * 2048 + k * 1024); } while (0)
#define PG8_LDB(dst, b, h) do { _Pragma("unroll") for (int n = 0; n < 2; ++n) _Pragma("unroll") for (int k = 0; k < 2; ++k) dst[n][k] = *(const PG8_LAS bf16x8*)(lds + PG8_SB(b, h) + boff + n * 2048 + k * 1024); } while (0)
#define PG8_MMA(ai, bj, At, Bt) do { __builtin_amdgcn_s_setprio(1); _Pragma("unroll") for (int m = 0; m < 4; ++m) _Pragma("unroll") for (int n = 0; n < 2; ++n) _Pragma("unroll") for (int k = 0; k < 2; ++k) \
        acc[ai][bj][m][n] = __builtin_amdgcn_mfma_f32_16x16x32_bf16(Bt[n][k], At[m][k], acc[ai][bj][m][n], 0, 0, 0); __builtin_amdgcn_s_setprio(0); } while (0)
#define PG8_WAIT_V(n) asm volatile("s_waitcnt vmcnt(" #n ")" ::: "memory")
#define PG8_WAIT_L(n) asm volatile("s_waitcnt lgkmcnt(" #n ")" ::: "memory")
#define PG8_BAR __builtin_amdgcn_s_barrier()
#define PG8_SCHED __builtin_amdgcn_sched_barrier(0)
    Unit cur, nxt; int ui = 0;
    if (!S.next(0, cur)) return;
    f32x4 acc[2][2][4][2];
#pragma unroll
    for (int a = 0; a < 2; ++a)
#pragma unroll
        for (int b = 0; b < 2; ++b)
#pragma unroll
            for (int m = 0; m < 4; ++m)
#pragma unroll
                for (int n = 0; n < 2; ++n) acc[a][b][m][n] = (f32x4){0.f, 0.f, 0.f, 0.f};
    bf16x8 At[4][2], B0[2][2], B1[2][2];
    const char* cA = (const char*)g.A + (size_t)cur.pm * tstep; const char* cB = (const char*)g.Bt + (size_t)cur.pn * tstep;
    S.a_ready(cur);
    if constexpr (SP2) {
        PG8_STAGE(PG8_SB(0, 0), cB, voffB); PG8_STAGE(PG8_SB(0, 1), cB + hstep, voffB); PG8_STAGE(PG8_SA(0, 0), cA, voffA); PG8_STAGE(PG8_SA(0, 1), cA + hstep, voffA);
        if (wr == 1) PG8_BAR;
        PG8_WAIT_V(2); PG8_BAR;
        PG8_STAGE(PG8_SB(1, 0), cB + kstep, voffB); PG8_STAGE(PG8_SA(1, 0), cA + kstep, voffA); PG8_STAGE(PG8_SB(1, 1), cB + hstep + kstep, voffB);
        PG8_WAIT_V(6); PG8_BAR;
    } else {
        PG8_STAGE(PG8_SB(0, 0), cB, voffB); PG8_STAGE(PG8_SA(0, 0), cA, voffA); PG8_STAGE(PG8_SB(0, 1), cB + hstep, voffB); PG8_STAGE(PG8_SA(0, 1), cA + hstep, voffA);
        if (wr == 1) PG8_BAR;
        PG8_WAIT_V(4); PG8_BAR;
        PG8_STAGE(PG8_SB(1, 0), cB + kstep, voffB); PG8_STAGE(PG8_SA(1, 0), cA + kstep, voffA); PG8_STAGE(PG8_SB(1, 1), cB + hstep + kstep, voffB);
        PG8_WAIT_V(6); PG8_BAR;
    }
    for (;;) {
        const bool has_next = S.next(ui + 1, nxt);
        const char* nA = has_next ? (const char*)g.A + (size_t)nxt.pm * tstep : cA; const char* nB = has_next ? (const char*)g.Bt + (size_t)nxt.pn * tstep : cB;
        for (int t = 0; t < nt; t += 2) {
            const bool last = (t == nt - 2);
            const char* a1 = cA + (size_t)(t + 1) * kstep;
            const char* a2 = last ? nA : cA + (size_t)(t + 2) * kstep; const char* b2 = last ? nB : cB + (size_t)(t + 2) * kstep;
            const char* a3 = a2 + kstep; const char* b3 = b2 + kstep;
            if (last && has_next) S.a_ready(nxt);
            if constexpr (SP2) {
            PG8_LDB(B0, 0, 0); PG8_LDB(B1, 0, 1); PG8_SCHED; PG8_LDA(At, 0, 0); PG8_STAGE(PG8_SA(1, 1), a1 + hstep, voffA);
            PG8_WAIT_V(8); PG8_WAIT_L(0); PG8_BAR; PG8_MMA(0, 0, At, B0); PG8_MMA(0, 1, At, B1); PG8_BAR; PG8_SCHED;
            PG8_LDA(At, 0, 1); PG8_STAGE(PG8_SB(0, 0), b2, voffB); PG8_STAGE(PG8_SB(0, 1), b2 + hstep, voffB); PG8_STAGE(PG8_SA(0, 0), a2, voffA);
            PG8_WAIT_V(8); PG8_WAIT_L(0); PG8_BAR; PG8_MMA(1, 0, At, B0); PG8_MMA(1, 1, At, B1); PG8_BAR; PG8_SCHED;
            PG8_LDB(B0, 1, 0); PG8_LDB(B1, 1, 1); PG8_SCHED; PG8_LDA(At, 1, 0); PG8_STAGE(PG8_SA(0, 1), a2 + hstep, voffA);
            PG8_WAIT_V(8); PG8_WAIT_L(0); PG8_BAR; PG8_MMA(0, 0, At, B0); PG8_MMA(0, 1, At, B1); PG8_BAR; PG8_SCHED;
            PG8_LDA(At, 1, 1); PG8_STAGE(PG8_SB(1, 0), b3, voffB); PG8_STAGE(PG8_SB(1, 1), b3 + hstep, voffB); PG8_STAGE(PG8_SA(1, 0), a3, voffA);
            PG8_WAIT_V(8); PG8_WAIT_L(0); PG8_BAR; PG8_MMA(1, 0, At, B0); PG8_MMA(1, 1, At, B1); PG8_BAR; PG8_SCHED;
            } else {
            PG8_LDB(B0, 0, 0); PG8_SCHED; PG8_LDA(At, 0, 0); PG8_STAGE(PG8_SA(1, 1), a1 + hstep, voffA);
            PG8_WAIT_L(8); PG8_BAR; PG8_WAIT_L(0); PG8_MMA(0, 0, At, B0); PG8_BAR; PG8_SCHED;
            PG8_LDB(B1, 0, 1); PG8_STAGE(PG8_SB(0, 0), b2, voffB);
            PG8_BAR; PG8_WAIT_L(0); PG8_MMA(0, 1, At, B1); PG8_BAR;
            PG8_LDA(At, 0, 1); PG8_STAGE(PG8_SA(0, 0), a2, voffA);
            PG8_BAR; PG8_WAIT_L(0); PG8_MMA(1, 0, At, B0); PG8_BAR; PG8_SCHED;
            PG8_STAGE(PG8_SB(0, 1), b2 + hstep, voffB);
            PG8_WAIT_V(6); PG8_BAR; PG8_MMA(1, 1, At, B1); PG8_BAR;
            PG8_LDB(B0, 1, 0); PG8_SCHED; PG8_LDA(At, 1, 0); PG8_STAGE(PG8_SA(0, 1), a2 + hstep, voffA);
            PG8_WAIT_L(8); PG8_BAR; PG8_WAIT_L(0); PG8_MMA(0, 0, At, B0); PG8_BAR; PG8_SCHED;
            PG8_LDB(B1, 1, 1); PG8_STAGE(PG8_SB(1, 0), b3, voffB);
            PG8_BAR; PG8_WAIT_L(0); PG8_MMA(0, 1, At, B1); PG8_BAR;
            PG8_LDA(At, 1, 1); PG8_STAGE(PG8_SA(1, 0), a3, voffA);
            PG8_BAR; PG8_WAIT_L(0); PG8_MMA(1, 0, At, B0); PG8_BAR; PG8_SCHED;
            PG8_STAGE(PG8_SB(1, 1), b3 + hstep, voffB);
            PG8_WAIT_V(6); PG8_BAR; PG8_MMA(1, 1, At, B1); PG8_BAR;
            }
        }
        if constexpr (ALIGN_EPI) { if (wr == 0) PG8_BAR; }
        if constexpr (!Epi::AFTER_DRAIN) { E(acc, cur, wr, wc, fr, fq); S.done(cur); }
        if (!has_next) break;
#pragma unroll
        for (int a = 0; a < 2; ++a)
#pragma unroll
            for (int b = 0; b < 2; ++b)
#pragma unroll
                for (int m = 0; m < 4; ++m)
#pragma unroll
                    for (int n = 0; n < 2; ++n) acc[a][b][m][n] = (f32x4){0.f, 0.f, 0.f, 0.f};
        cur = nxt; cA = nA; cB = nB; ++ui;
        if constexpr (ALIGN_EPI) { if (wr == 1) PG8_BAR; }
    }
    PG8_WAIT_V(0);
    if constexpr (!ALIGN_EPI) { if (wr == 0) PG8_BAR; }
    PG8_BAR;
    if constexpr (Epi::AFTER_DRAIN) { E.fused(acc, cur, wr, wc, fr, fq, lds, wid, lane); S.done(cur); }
#undef PG8_SA
#undef PG8_SB
#undef PG8_STAGE
#undef PG8_LDA
#undef PG8_LDB
#undef PG8_MMA
#undef PG8_WAIT_V
#undef PG8_WAIT_L
#undef PG8_BAR
#undef PG8_SCHED
}
}

namespace pg8 {
__device__ __forceinline__ float gelu_tanh(float x) {
    const float t = x * (1.5957691216057308f + 0.07135481627f * x * x);
    const float e = __builtin_amdgcn_exp2f(-1.4426950408889634f * t);
    return x * __builtin_amdgcn_rcpf(1.0f + e);
}
template <int ACT> struct EpiT {
    static constexpr bool PERM = true, AFTER_DRAIN = false;
    bf16_t* O; int ldc;
    __device__ __forceinline__ void operator()(const f32x4 (&acc)[2][2][4][2], const Unit& u, int wr, int wc, int fr, int fq) const {
        const int row0 = u.pm * BM + wr * 64 + fr; const int col0 = u.pn * BM + wc * 32 + 8 * fq;
#pragma unroll
        for (int ai = 0; ai < 2; ++ai)
#pragma unroll
            for (int m = 0; m < 4; ++m) { bf16_t* rowp = O + (size_t)(row0 + ai * HALF + m * 16) * ldc + col0;
#pragma unroll
                for (int bj = 0; bj < 2; ++bj) { f32x4 v0 = acc[ai][bj][m][0], v1 = acc[ai][bj][m][1];
                    if (ACT == 2) { v0 = (f32x4){gelu_tanh(v0[0]), gelu_tanh(v0[1]), gelu_tanh(v0[2]), gelu_tanh(v0[3])}; v1 = (f32x4){gelu_tanh(v1[0]), gelu_tanh(v1[1]), gelu_tanh(v1[2]), gelu_tanh(v1[3])}; }
                    u32x4 w; w.x = cvt_pk_bf16(v0[0], v0[1]); w.y = cvt_pk_bf16(v0[2], v0[3]); w.z = cvt_pk_bf16(v1[0], v1[1]); w.w = cvt_pk_bf16(v1[2], v1[3]);
                    *(u32x4*)(rowp + bj * HALF) = w; } }
    }
};
struct EpiR {
    static constexpr bool PERM = true, AFTER_DRAIN = false;
    bf16_t* O; int ldc; int act; int rope; const float* ropet;
    __device__ __forceinline__ void operator()(const f32x4 (&acc)[2][2][4][2], const Unit& u, int wr, int wc, int fr, int fq) const {
        const int row0 = u.pm * BM + wr * 64 + fr; const int col0 = u.pn * BM + wc * 32 + 8 * fq;
        const bool rrows = rope != 0 && u.pm < 64;
#pragma unroll
        for (int ai = 0; ai < 2; ++ai)
#pragma unroll
            for (int m = 0; m < 4; ++m) { const int grow = row0 + ai * HALF + m * 16; bf16_t* rowp = O + (size_t)grow * ldc + col0;
#pragma unroll
                for (int bj = 0; bj < 2; ++bj) { f32x4 v0 = acc[ai][bj][m][0], v1 = acc[ai][bj][m][1];
                    if (act) { v0 = (f32x4){gelu_tanh(v0[0]), gelu_tanh(v0[1]), gelu_tanh(v0[2]), gelu_tanh(v0[3])}; v1 = (f32x4){gelu_tanh(v1[0]), gelu_tanh(v1[1]), gelu_tanh(v1[2]), gelu_tanh(v1[3])}; }
                    if (rrows) { const int blk = u.pn * 8 + bj * 4 + wc; const int b6 = blk % 6; const bool on = rope == 1 ? (blk < 128) : (b6 >= 4); const int half = rope == 1 ? (blk & 1) : (b6 - 4);
                        if (on) { const int t = grow & 8191; const int pos = half ? (t & 63) : (t >> 6);
                            const float* cp = ropet + pos * 16 + 8 * (fq & 1); const f32x4 c0 = *(const f32x4*)cp, c1 = *(const f32x4*)(cp + 4), s0 = *(const f32x4*)(cp + 2048), s1 = *(const f32x4*)(cp + 2052);
                            f32x4 p0, p1;
#pragma unroll
                            for (int i = 0; i < 4; ++i) { const float a_ = v0[i], b_ = v1[i];
                                const auto r0 = __builtin_amdgcn_permlane32_swap(__float_as_uint(a_), __float_as_uint(a_), false, false);
                                const auto r1 = __builtin_amdgcn_permlane32_swap(__float_as_uint(b_), __float_as_uint(b_), false, false);
                                const unsigned x0_ = (fq & 2) ? r0[0] : r0[1], x1_ = (fq & 2) ? r1[0] : r1[1]; p0[i] = __uint_as_float(x0_); p1[i] = __uint_as_float(x1_); }
                            if (fq & 2) { v0 = p0 * s0 + v0 * c0; v1 = p1 * s1 + v1 * c1; } else { v0 = v0 * c0 - p0 * s0; v1 = v1 * c1 - p1 * s1; } } }
                    u32x4 w; w.x = cvt_pk_bf16(v0[0], v0[1]); w.y = cvt_pk_bf16(v0[2], v0[3]); w.z = cvt_pk_bf16(v1[0], v1[1]); w.w = cvt_pk_bf16(v1[2], v1[3]);
                    *(u32x4*)(rowp + bj * HALF) = w; } }
    }
};
}

constexpr int DM = 2048, NBATCH = 2, SEQ = 8192, CTXL = 256;
constexpr int ML = NBATCH * SEQ;
constexpr int MC = NBATCH * CTXL;
constexpr int MT = ML + MC;
constexpr int NLAYER = 4;
constexpr float ALPHA = 1.6817928305074290f, LN_EPS = 1e-6f;
constexpr int NWAVES = 8;
constexpr float U_SCALE = 64.0f, V_SCALE = 4.0f;
constexpr int PROW = 1536;
constexpr int NPH = 35;

constexpr size_t MiB = 1ull << 20;
constexpr size_t WS_CTL = 0, CTL_ZERO_BYTES = 1 * MiB;
constexpr int    CW_BAR = 4096;
constexpr size_t WS_MOD = 128 * 1024;
constexpr size_t WS_VST = 1 * MiB;
constexpr size_t WS_ROPE = 1 * MiB + 160 * 1024;
constexpr size_t WS_MODP = 1 * MiB + 256 * 1024;
constexpr size_t WS_GMWIN = 6 * MiB;
constexpr size_t WS_GMWOUT = WS_GMWIN + 32 * MiB;
constexpr size_t WS_GMWS = WS_GMWOUT + 16 * MiB;
constexpr size_t WS_PWQ = WS_GMWS + 1 * MiB;
constexpr size_t WS_PK1 = WS_PWQ + 32 * MiB;
constexpr size_t WS_PK2 = WS_PK1 + 512 * 1024;
constexpr size_t WS_MLAIN = WS_PK1 + 1 * MiB;
constexpr size_t WS_MLAUQ = WS_MLAIN + 5 * MiB;
constexpr size_t WS_MLAUKV = WS_MLAUQ + 3 * MiB;
constexpr size_t WS_MLAOUT = WS_MLAUKV + 4 * MiB;
constexpr size_t WS_DAIN = WS_MLAOUT + 8 * MiB;
constexpr size_t WS_DAOUT = WS_DAIN + 24 * MiB;
constexpr size_t WS_PU = WS_DAOUT + 8 * MiB;
constexpr size_t WS_PV = WS_PU + 96 * MiB;
constexpr size_t WS_X = WS_PV + 96 * MiB;
constexpr size_t WS_H = WS_X + 66 * MiB;
constexpr size_t WS_G = WS_H + 66 * MiB;
constexpr size_t WS_Y = WS_G + 66 * MiB;
constexpr size_t WS_QP = WS_Y + 66 * MiB;
constexpr size_t WS_Z = WS_QP + 66 * MiB;
constexpr size_t WS_C = WS_Z + 198 * MiB;
constexpr size_t WS_CQN = WS_C + 42 * MiB;
constexpr size_t WS_CKVN = WS_CQN + 17 * MiB;
constexpr size_t WS_KR = WS_CKVN + 17 * MiB;
constexpr size_t WS_QM = WS_KR + 3 * MiB;
constexpr size_t WS_KV = WS_QM + 99 * MiB;
constexpr size_t WS_ROUTE = WS_KV + 132 * MiB;
constexpr size_t WS_END = WS_ROUTE + 17 * MiB;
static_assert((size_t)MT * DM * 2 == 66 * MiB, "row buffer size");

constexpr int RING_BYTES = 155648, MISC_OFF = RING_BYTES + 320, LDS_BYTES = 159744;

#define GAS __attribute__((address_space(1)))
#define LAS __attribute__((address_space(3)))
typedef unsigned short bf16;
typedef unsigned u32x4 __attribute__((ext_vector_type(4)));
typedef unsigned u32x2 __attribute__((ext_vector_type(2)));
typedef float f32x4 __attribute__((ext_vector_type(4)));
typedef float f32x16 __attribute__((ext_vector_type(16)));
typedef short bf16x8 __attribute__((ext_vector_type(8)));
typedef short s16x4 __attribute__((ext_vector_type(4)));
#define LDS_WAIT() asm volatile("s_waitcnt lgkmcnt(0)" ::: "memory")

__device__ __forceinline__ unsigned cvtpk(float lo, float hi) { unsigned r; asm("v_cvt_pk_bf16_f32 %0, %1, %2" : "=v"(r) : "v"(lo), "v"(hi)); return r; }
__device__ __forceinline__ float bflo(unsigned w) { return __uint_as_float(w << 16); }
__device__ __forceinline__ float bfhi(unsigned w) { return __uint_as_float(w & 0xffff0000u); }
__device__ __forceinline__ float bf1(bf16 b) { return __uint_as_float((unsigned)b << 16); }
__device__ __forceinline__ bf16 tobf1(float f) { return (bf16)(cvtpk(f, 0.f) & 0xffffu); }
#define DPP_F(v, ctrl) __int_as_float(__builtin_amdgcn_mov_dpp(__float_as_int(v), (ctrl), 0xF, 0xF, true))
__device__ __forceinline__ float row_sum16(float v) { v += DPP_F(v, 0xB1); v += DPP_F(v, 0x4E); v += DPP_F(v, 0x141); v += DPP_F(v, 0x140); return v; }
__device__ __forceinline__ float sum_xor16(float v) { const auto r = __builtin_amdgcn_permlane16_swap(__float_as_uint(v), __float_as_uint(v), false, false); return __uint_as_float(r[0]) + __uint_as_float(r[1]); }
__device__ __forceinline__ float sum_xor32(float v) { const auto r = __builtin_amdgcn_permlane32_swap(__float_as_uint(v), __float_as_uint(v), false, false); return __uint_as_float(r[0]) + __uint_as_float(r[1]); }
__device__ __forceinline__ float wave_sum(float v) { return sum_xor32(sum_xor16(row_sum16(v))); }
__device__ __forceinline__ float half_sum32(float v) { return sum_xor16(row_sum16(v)); }
__device__ __forceinline__ float lane_xor16(float v, int lane) { const auto r = __builtin_amdgcn_permlane16_swap(__float_as_uint(v), __float_as_uint(v), false, false); return __uint_as_float((lane & 16) ? r[0] : r[1]); }
__device__ __forceinline__ unsigned lane_xor32(unsigned v, int lane) { const auto r = __builtin_amdgcn_permlane32_swap(v, v, false, false); return (lane & 32) ? r[0] : r[1]; }
__device__ __forceinline__ float gelu_tanh(float x) { return pg8::gelu_tanh(x); }

__device__ __forceinline__ void load_row_bf16(const bf16* row, int lane, float (&v)[32]) {
#pragma unroll
    for (int j = 0; j < 4; ++j) { const u32x4 w = ((const u32x4*)row)[64 * j + lane];
        v[8 * j + 0] = bflo(w.x); v[8 * j + 1] = bfhi(w.x); v[8 * j + 2] = bflo(w.y); v[8 * j + 3] = bfhi(w.y);
        v[8 * j + 4] = bflo(w.z); v[8 * j + 5] = bfhi(w.z); v[8 * j + 6] = bflo(w.w); v[8 * j + 7] = bfhi(w.w); }
}
__device__ __forceinline__ void store_row_bf16(bf16* row, int lane, const float (&v)[32]) {
#pragma unroll
    for (int j = 0; j < 4; ++j) { u32x4 w; w.x = cvtpk(v[8 * j + 0], v[8 * j + 1]); w.y = cvtpk(v[8 * j + 2], v[8 * j + 3]); w.z = cvtpk(v[8 * j + 4], v[8 * j + 5]); w.w = cvtpk(v[8 * j + 6], v[8 * j + 7]);
        ((u32x4*)row)[64 * j + lane] = w; }
}
__device__ __forceinline__ void load_row_f32(const float* row, int lane, float (&v)[32]) {
#pragma unroll
    for (int j = 0; j < 4; ++j) { const f32x4 a = ((const f32x4*)row)[128 * j + 2 * lane], b = ((const f32x4*)row)[128 * j + 2 * lane + 1];
        v[8 * j + 0] = a.x; v[8 * j + 1] = a.y; v[8 * j + 2] = a.z; v[8 * j + 3] = a.w; v[8 * j + 4] = b.x; v[8 * j + 5] = b.y; v[8 * j + 6] = b.z; v[8 * j + 7] = b.w; }
}
__device__ __forceinline__ void store_row_f32(float* row, int lane, const float (&v)[32]) {
#pragma unroll
    for (int j = 0; j < 4; ++j) { ((f32x4*)row)[128 * j + 2 * lane] = (f32x4){v[8 * j + 0], v[8 * j + 1], v[8 * j + 2], v[8 * j + 3]};
        ((f32x4*)row)[128 * j + 2 * lane + 1] = (f32x4){v[8 * j + 4], v[8 * j + 5], v[8 * j + 6], v[8 * j + 7]}; }
}
__device__ __forceinline__ void load_row_bf16_b(const bf16* row, int lane, float (&v)[32]) {
#pragma unroll
    for (int j = 0; j < 4; ++j) { const u32x4 w = ((const u32x4*)row)[4 * lane + j];
        v[8 * j + 0] = bflo(w.x); v[8 * j + 1] = bfhi(w.x); v[8 * j + 2] = bflo(w.y); v[8 * j + 3] = bfhi(w.y);
        v[8 * j + 4] = bflo(w.z); v[8 * j + 5] = bfhi(w.z); v[8 * j + 6] = bflo(w.w); v[8 * j + 7] = bfhi(w.w); }
}
__device__ __forceinline__ void store_row_bf16_b(bf16* row, int lane, const float (&v)[32]) {
#pragma unroll
    for (int j = 0; j < 4; ++j) { u32x4 w; w.x = cvtpk(v[8 * j + 0], v[8 * j + 1]); w.y = cvtpk(v[8 * j + 2], v[8 * j + 3]); w.z = cvtpk(v[8 * j + 4], v[8 * j + 5]); w.w = cvtpk(v[8 * j + 6], v[8 * j + 7]);
        ((u32x4*)row)[4 * lane + j] = w; }
}
__device__ __forceinline__ void load_row_f32_b(const float* row, int lane, float (&v)[32]) {
#pragma unroll
    for (int q = 0; q < 8; ++q) { const f32x4 a = ((const f32x4*)row)[8 * lane + q];
        v[4 * q + 0] = a.x; v[4 * q + 1] = a.y; v[4 * q + 2] = a.z; v[4 * q + 3] = a.w; }
}
__device__ __forceinline__ void store_row_f32_b(float* row, int lane, const float (&v)[32]) {
#pragma unroll
    for (int q = 0; q < 8; ++q) ((f32x4*)row)[8 * lane + q] = (f32x4){v[4 * q + 0], v[4 * q + 1], v[4 * q + 2], v[4 * q + 3]};
}
__device__ __forceinline__ void ln_stats(const float (&v)[32], float& mean, float& rstd) {
    float s = 0.f;
#pragma unroll
    for (int i = 0; i < 32; ++i) s += v[i];
    mean = wave_sum(s) * (1.0f / DM);
    float q = 0.f;
#pragma unroll
    for (int i = 0; i < 32; ++i) { const float d = v[i] - mean; q += d * d; }
    rstd = 1.0f / sqrtf(wave_sum(q) * (1.0f / DM) + LN_EPS);
}
template <bool LAYB>
__device__ __forceinline__ void finish_row(float (&z)[32], const float* lng, const float* lnb, bf16* Xrow, const float* sh, const float* sc, bf16* Hrow, float* Orow, int lane) {
    float mean, rstd; ln_stats(z, mean, rstd);
    { float g[32], b[32]; if (LAYB) { load_row_f32_b(lng, lane, g); load_row_f32_b(lnb, lane, b); } else { load_row_f32(lng, lane, g); load_row_f32(lnb, lane, b); }
#pragma unroll
      for (int i = 0; i < 32; ++i) z[i] = (z[i] - mean) * rstd * g[i] + b[i]; }
    if (Xrow) { if (LAYB) store_row_bf16_b(Xrow, lane, z); else store_row_bf16(Xrow, lane, z); }
    if (Orow) { if (LAYB) store_row_f32_b(Orow, lane, z); else store_row_f32(Orow, lane, z); }
    if (Hrow) {
        ln_stats(z, mean, rstd);
        float a[32], s[32]; if (LAYB) { load_row_f32_b(sc, lane, a); load_row_f32_b(sh, lane, s); } else { load_row_f32(sc, lane, a); load_row_f32(sh, lane, s); }
#pragma unroll
        for (int i = 0; i < 32; ++i) a[i] = (z[i] - mean) * rstd * (1.0f + a[i]) + s[i];
        if (LAYB) store_row_bf16_b(Hrow, lane, a); else store_row_bf16(Hrow, lane, a);
    }
}
__device__ __forceinline__ int row_slot(int row) { return row < ML ? (row >> 13) : 2; }

__device__ __forceinline__ unsigned f2bf_rne(float f) { unsigned u = __float_as_uint(f); return (u + 0x7fffu + ((u >> 16) & 1u)) >> 16; }
__device__ __forceinline__ unsigned pk2(float lo, float hi) { return f2bf_rne(lo) | (f2bf_rne(hi) << 16); }
__device__ __forceinline__ void p0_transpose_item(const float* W, int K, int N, bf16* WT, LAS float* scr, int item, int lane) {
    const int nblk = N / 32, kb = item / nblk, nb = item % nblk, k0 = 64 * kb, n0 = 32 * nb;
    f32x4 t[8];
#pragma unroll
    for (int i = 0; i < 8; ++i) t[i] = *(const f32x4*)(W + (size_t)(k0 + 8 * i + (lane >> 3)) * N + n0 + 4 * (lane & 7));
#pragma unroll
    for (int i = 0; i < 8; ++i) { LAS float* d = scr + (8 * i + (lane >> 3)) * 33 + 4 * (lane & 7); d[0] = t[i].x; d[1] = t[i].y; d[2] = t[i].z; d[3] = t[i].w; }
    LDS_WAIT(); asm volatile("" ::: "memory");
    const int c = lane & 7;
#pragma unroll
    for (int j = 0; j < 4; ++j) { const int n = (lane >> 3) + 8 * j; const LAS float* s = scr + (8 * c) * 33 + n;
        u32x4 o; o.x = pk2(s[0 * 33], s[1 * 33]); o.y = pk2(s[2 * 33], s[3 * 33]); o.z = pk2(s[4 * 33], s[5 * 33]); o.w = pk2(s[6 * 33], s[7 * 33]);
        *(u32x4*)(WT + (size_t)(n0 + n) * K + k0 + 8 * c) = o; }
    LDS_WAIT(); asm volatile("" ::: "memory");
}
__device__ __forceinline__ void cvt_range(const float* src, bf16* dst, size_t n8, size_t gtid, size_t gthreads) {
#pragma unroll 4
    for (size_t i = gtid; i < n8; i += gthreads) { const f32x4 a = ((const f32x4*)src)[2 * i], b = ((const f32x4*)src)[2 * i + 1];
        u32x4 w; w.x = cvtpk(a.x, a.y); w.y = cvtpk(a.z, a.w); w.z = cvtpk(b.x, b.y); w.w = cvtpk(b.z, b.w); ((u32x4*)dst)[i] = w; }
}
__device__ __forceinline__ unsigned enc_e2m3(float x) {
    const unsigned sgn = (__float_as_uint(x) >> 26) & 32u;
    const float ax = fminf(fabsf(x), 7.5f);
    unsigned u = __float_as_uint(ax); u += 0x7FFFFu + ((u >> 20) & 1u);
    const unsigned cn = (u >> 20) - ((127u - 1u) << 3);
    const unsigned cs = (unsigned)__builtin_rintf(ax * 8.0f);
    return sgn | (ax < 1.0f ? cs : cn);
}
typedef float f32x16v __attribute__((ext_vector_type(16)));
typedef float f32x32v __attribute__((ext_vector_type(32)));
typedef unsigned u32x6v __attribute__((ext_vector_type(6)));
__device__ __forceinline__ u32x6v pack_fp6_32(const float (&e)[32], bool interleaved) {
    f32x16v s0, s1;
    if (interleaved) {
#pragma unroll
        for (int i = 0; i < 16; ++i) { s0[i] = e[2 * i]; s1[i] = e[2 * i + 1]; }
    } else {
#pragma unroll
        for (int i = 0; i < 16; ++i) { s0[i] = e[i]; s1[i] = e[16 + i]; }
    }
    return __builtin_amdgcn_cvt_scalef32_2xpk16_fp6_f32(s0, s1, 1.0f);
}
__device__ __forceinline__ void cvt_table_fp6(const float* src, unsigned char* dst, int nrows, float scale, LAS float* scr  , int lane, int gw, int NGW) {
    bool interleaved;
    {
        float t[32];
#pragma unroll
        for (int k = 0; k < 32; ++k) t[k] = k < 16 ? 0.125f * k : (k < 24 ? 2.0f + 0.25f * (k - 16) : 4.0f + 0.5f * (k - 24));
        float tt[32];
#pragma unroll
        for (int k = 0; k < 32; ++k) { tt[k] = t[k]; asm volatile("" : "+v"(tt[k])); }
        const u32x6v p = pack_fp6_32(tt, true);
        const f32x32v o = __builtin_amdgcn_cvt_scalef32_pk32_f32_fp6(p, 1.0f);
        interleaved = (o[1] == t[1]) && (o[2] == t[2]) && (o[17] == t[17]);
        interleaved = __all(interleaved);
    }
    for (int row = gw; row < nrows; row += NGW) {
        const f32x4* s4 = (const f32x4*)(src + (size_t)row * 2048);
#pragma unroll
        for (int q = 0; q < 8; ++q) { const int s = 64 * q + lane; const f32x4 a = s4[s] * scale; *(LAS f32x4*)(scr + 4 * (s ^ ((s >> 4) & 7))) = a; }
        float e[32];
#pragma unroll
        for (int j = 0; j < 8; ++j) { const int s = 8 * lane + j; const f32x4 a = *(const LAS f32x4*)(scr + 4 * (s ^ ((s >> 4) & 7)));
            e[4 * j + 0] = __builtin_amdgcn_fmed3f(a.x, -7.5f, 7.5f); e[4 * j + 1] = __builtin_amdgcn_fmed3f(a.y, -7.5f, 7.5f); e[4 * j + 2] = __builtin_amdgcn_fmed3f(a.z, -7.5f, 7.5f); e[4 * j + 3] = __builtin_amdgcn_fmed3f(a.w, -7.5f, 7.5f); }
        const u32x6v p = pack_fp6_32(e, interleaved);
        unsigned char* rowp = dst + (size_t)row * PROW;
        *(u32x4*)(rowp + 16 * lane) = (u32x4){p[0], p[1], p[2], p[3]}; *(u32x2*)(rowp + 1024 + 8 * lane) = (u32x2){p[4], p[5]};
    }
}
__device__ __forceinline__ float silu(float x) { return x / (1.0f + __expf(-x)); }

struct Params { const float* in[29]; float* out; unsigned char* ws; int ph_lo, ph_hi; };
typedef const __attribute__((address_space(4))) Params* CP;

__device__ __forceinline__ void p0_prologue(CP P, LAS unsigned char* lds, int tid, int lane, int wid, int gw, int NGW) {
    unsigned char* ws = P->ws;
    LAS float* scr = (LAS float*)(lds + wid * 16384);
    {
        constexpr int I_GMIN = (2048 / 64) * (4096 / 32), I_SQ = (2048 / 64) * (2048 / 32), I_MIN = (2048 / 64) * (1088 / 32), I_UQ = (512 / 64) * (3072 / 32), I_UKV = (512 / 64) * (4096 / 32), I_DIN = (2048 / 64) * (6144 / 32);
        constexpr int NIT = 2 * I_GMIN + 2 * I_SQ + 4 * I_SQ + I_MIN + I_UQ + I_UKV + I_SQ + I_DIN + I_SQ;
        for (int it = gw; it < NIT; it += NGW) {
            int r = it;
            if (r < 2 * I_GMIN) { const int j = r / I_GMIN; p0_transpose_item(P->in[13] + (size_t)j * 2048 * 4096, 2048, 4096, (bf16*)(ws + WS_GMWIN) + (size_t)j * 4096 * 2048, scr, r % I_GMIN, lane); continue; } r -= 2 * I_GMIN;
            if (r < 2 * I_SQ) { const int j = r / I_SQ; p0_transpose_item(P->in[18] + (size_t)j * 2048 * 2048, 2048, 2048, (bf16*)(ws + WS_GMWOUT) + (size_t)j * 2048 * 2048, scr, r % I_SQ, lane); continue; } r -= 2 * I_SQ;
            if (r < 4 * I_SQ) { const int j = r / I_SQ; p0_transpose_item(P->in[8] + (size_t)j * 2048 * 2048, 2048, 2048, (bf16*)(ws + WS_PWQ) + (size_t)j * 2048 * 2048, scr, r % I_SQ, lane); continue; } r -= 4 * I_SQ;
            if (r < I_MIN) { p0_transpose_item(P->in[19], 2048, 1088, (bf16*)(ws + WS_MLAIN), scr, r, lane); continue; } r -= I_MIN;
            if (r < I_UQ) { p0_transpose_item(P->in[22], 512, 3072, (bf16*)(ws + WS_MLAUQ), scr, r, lane); continue; } r -= I_UQ;
            if (r < I_UKV) { p0_transpose_item(P->in[23], 512, 4096, (bf16*)(ws + WS_MLAUKV), scr, r, lane); continue; } r -= I_UKV;
            if (r < I_SQ) { p0_transpose_item(P->in[24], 2048, 2048, (bf16*)(ws + WS_MLAOUT), scr, r, lane); continue; } r -= I_SQ;
            if (r < I_DIN) { p0_transpose_item(P->in[25], 2048, 6144, (bf16*)(ws + WS_DAIN), scr, r, lane); continue; } r -= I_DIN;
            p0_transpose_item(P->in[28], 2048, 2048, (bf16*)(ws + WS_DAOUT), scr, r, lane);
        }
    }
    const size_t gtid = (size_t)gw * 64 + lane, gthreads = (size_t)NGW * 64;
    { u32x4* z = (u32x4*)((bf16*)(ws + WS_MLAIN) + (size_t)1088 * 2048); const size_t n = (size_t)192 * 2048 / 8;
      for (size_t i = gtid; i < n; i += gthreads) z[i] = (u32x4){0u, 0u, 0u, 0u}; }
    cvt_range(P->in[16], (bf16*)(ws + WS_GMWS), (size_t)2 * 16 * 128 * 128 / 8, gtid, gthreads);
    cvt_range(P->in[9], (bf16*)(ws + WS_PK1), (size_t)4 * 128 * 128 / 8, gtid, gthreads);
    cvt_range(P->in[10], (bf16*)(ws + WS_PK2), (size_t)4 * 128 * 128 / 8, gtid, gthreads);
    cvt_table_fp6(P->in[11], ws + WS_PU, 16384, U_SCALE, scr, lane, gw, NGW);
    cvt_table_fp6(P->in[12], ws + WS_PV, 16384, V_SCALE, scr, lane, gw, NGW);
    if (gtid < 2048) { const int pos = (int)gtid >> 4, f = (int)gtid & 15; const float inv = powf(10000.0f, -(float)f * (1.0f / 16.0f)); float sn, cs; sincosf((float)pos * inv, &sn, &cs);
        float* rt = (float*)(ws + WS_ROPE); rt[gtid] = cs; rt[2048 + gtid] = sn; }
    {
        const float* cv = P->in[1]; const float* cc = P->in[3]; const float* mw = P->in[4]; float* PART = (float*)(ws + WS_MODP);
        for (int item = gw; item < 4 * 192 * 8; item += NGW) {
            const int ks = item & 7, r = item >> 3, L = r / 192, n = (r % 192) * 64 + lane;
            const float* W = mw + (size_t)L * 2048 * 12288 + (size_t)(ks * 256) * 12288 + n;
            float a0 = 0.f, a1 = 0.f, a2 = 0.f;
#pragma unroll 32
            for (int k = 0; k < 256; ++k) { const int kk = ks * 256 + k; const float s0 = silu(cv[kk]), s1 = silu(cv[2048 + kk]), s2 = silu(cc[kk]);
                const float w = W[(size_t)k * 12288]; a0 += s0 * w; a1 += s1 * w; a2 += s2 * w; }
            float* o = PART + ((size_t)ks * 4 + L) * 3 * 12288 + n;
            o[0] = a0; o[12288] = a1; o[24576] = a2;
        }
    }
}
__device__ __forceinline__ void mod_reduce(CP P, int gw, int lane, int NGW) {
    const float* PART = (const float*)(P->ws + WS_MODP); float* MOD = (float*)(P->ws + WS_MOD); const float* mb = P->in[5];
    for (int i = gw * 64 + lane; i < 4 * 3 * 12288; i += NGW * 64) {
        const int L = i / (3 * 12288), n = i % 12288;
        float s = mb[(size_t)L * 12288 + n];
#pragma unroll
        for (int ks = 0; ks < 8; ++ks) s += PART[(size_t)ks * 4 * 3 * 12288 + i];
        MOD[i] = s;
    }
}

__device__ __forceinline__ void first_row_pass(CP P, int lane, int gw, int NGW) {
    const float* MOD = (const float*)(P->ws + WS_MOD); bf16* X = (bf16*)(P->ws + WS_X); bf16* H = (bf16*)(P->ws + WS_H);
    for (int row = gw; row < MT; row += NGW) {
        const float* src = row < ML ? P->in[0] + (size_t)row * DM : P->in[2] + (size_t)(row - ML) * DM;
        float v[32]; load_row_f32(src, lane, v);
        store_row_bf16(X + (size_t)row * DM, lane, v);
        const float* mod = MOD + (size_t)row_slot(row) * 12288;
        float mean, rstd; ln_stats(v, mean, rstd);
        float a[32], s[32]; load_row_f32(mod + 2048, lane, a); load_row_f32(mod, lane, s);
#pragma unroll
        for (int i = 0; i < 32; ++i) a[i] = (v[i] - mean) * rstd * (1.0f + a[i]) + s[i];
        store_row_bf16(H + (size_t)row * DM, lane, a);
    }
}
__device__ __forceinline__ void post_mixer_pass(CP P, int L, int Mrows, int lane, int gw, int NGW) {
    const float* MOD = (const float*)(P->ws + WS_MOD); bf16* X = (bf16*)(P->ws + WS_X); bf16* H = (bf16*)(P->ws + WS_H); const bf16* Y = (const bf16*)(P->ws + WS_Y);
    const float* lng = P->in[6] + (size_t)(L * 2 + 0) * DM; const float* lnb = P->in[7] + (size_t)(L * 2 + 0) * DM;
    for (int row = gw; row < Mrows; row += NGW) {
        const float* mod = MOD + (size_t)(L * 3 + row_slot(row)) * 12288;
        float z[32], y[32], g[32]; load_row_bf16(X + (size_t)row * DM, lane, z); load_row_bf16(Y + (size_t)row * DM, lane, y); load_row_f32(mod + 2 * 2048, lane, g);
#pragma unroll
        for (int i = 0; i < 32; ++i) z[i] = ALPHA * z[i] + g[i] * y[i];
        finish_row<false>(z, lng, lnb, X + (size_t)row * DM, mod + 3 * 2048, mod + 4 * 2048, H + (size_t)row * DM, nullptr, lane);
    }
}
__device__ __forceinline__ void vstats_pass(CP P, int Mrows, int lane, int gw, int NGW) {
    const bf16* Z = (const bf16*)(P->ws + WS_Z); float* VST = (float*)(P->ws + WS_VST);
    for (int row = gw; row < Mrows; row += NGW) {
        float v[32]; load_row_bf16(Z + (size_t)row * 4096 + 2048, lane, v);
        float mean, rstd; ln_stats(v, mean, rstd);
        if (lane == 0) { VST[2 * row] = mean; VST[2 * row + 1] = rstd; }
    }
}
#define XB_TMO      128
#define XB_XCNT(j)  (256  + 64 * (j))
#define XB_XSUB(j)  (1280 + 64 * (j))
#define XB_XGEN(j)  (2304 + 64 * (j))
#define XB_TOP      3328
#define XB_TOPGEN   3392
#define XCD_BAR_WORDS 3456
#define XB_SPIN_CAP (1u << 18)

__device__ __forceinline__ unsigned xb_ld(unsigned* p)              { return __hip_atomic_load(p, __ATOMIC_RELAXED, __HIP_MEMORY_SCOPE_AGENT); }
__device__ __forceinline__ unsigned xb_add(unsigned* p, unsigned v) { return __hip_atomic_fetch_add(p, v, __ATOMIC_RELAXED, __HIP_MEMORY_SCOPE_AGENT); }
__device__ __forceinline__ unsigned xb_xcc_id() { return (unsigned)__builtin_amdgcn_s_getreg((3 << 11) | 20) & 0xFu; }
#define XB_SPIN(cond, bar) do { unsigned _sp = 0; while (cond) { __builtin_amdgcn_s_sleep(1); \
    if ((++_sp & 255u) == 0u) { if (xb_ld(&(bar)[XB_TMO])) break; if (_sp > XB_SPIN_CAP) { atomicAdd(&(bar)[XB_TMO], 1u); break; } } } } while (0)

struct XcdBarrier {
    unsigned* bar; unsigned x;
    volatile LAS unsigned* st;
};

__device__ __forceinline__ XcdBarrier xcd_barrier_post(unsigned* bar, volatile LAS unsigned* st, const bool t0) {
    XcdBarrier b; b.bar = bar; b.x = xb_xcc_id(); b.st = st;
    if (t0) (void)xb_add(&bar[XB_XCNT(b.x)], 1u);
    return b;
}
__device__ __forceinline__ void xcd_barrier_complete(unsigned* bar, unsigned x, unsigned& nloc, unsigned& nx) {
    const unsigned G = gridDim.x * gridDim.y * gridDim.z;
    unsigned sum, cnt, mine, sp = 0u;
    for (;;) {
        sum = 0u; cnt = 0u; mine = 0u;
#pragma unroll
        for (unsigned j = 0; j < 16; ++j) { const unsigned c = xb_ld(&bar[XB_XCNT(j)]); sum += c; cnt += (c > 0u) ? 1u : 0u; mine = (j == x) ? c : mine; }
        if (sum == G) break;
        __builtin_amdgcn_s_sleep(1);
        if ((++sp & 255u) == 0u) { if (xb_ld(&bar[XB_TMO])) break; if (sp > XB_SPIN_CAP) { atomicAdd(&bar[XB_TMO], 1u); break; } }
    }
    nloc = mine > 0u ? mine : 1u; nx = cnt > 0u ? cnt : 1u;
}

__device__ __attribute__((noinline)) void xcd_barrier(const XcdBarrier b, const bool t0) {
    asm volatile("s_waitcnt vmcnt(0)" ::: "memory");
    __syncthreads();
    if (t0) {
        unsigned* bar = b.bar;
        __builtin_amdgcn_s_waitcnt(0);
        unsigned nloc = b.st[0], nx = b.st[1];
        if (nloc == 0u) { xcd_barrier_complete(bar, b.x, nloc, nx); b.st[0] = nloc; b.st[1] = nx; }
        const unsigned old = xb_add(&bar[XB_XSUB(b.x)], 1u);
        const unsigned gen = old / nloc;
        if (old + 1u == (gen + 1u) * nloc) {
            __builtin_amdgcn_fence(__ATOMIC_RELEASE, "agent");
            asm volatile("s_waitcnt vmcnt(0)" ::: "memory");
            const unsigned og = xb_add(&bar[XB_TOP], 1u);
            const unsigned tg = og / nx;
            if (og + 1u == (tg + 1u) * nx) xb_add(&bar[XB_TOPGEN], 1u);
            else XB_SPIN(xb_ld(&bar[XB_TOPGEN]) == tg, bar);
            __builtin_amdgcn_fence(__ATOMIC_ACQUIRE, "agent");
            xb_add(&bar[XB_XGEN(b.x)], 1u);
            asm volatile("s_waitcnt vmcnt(0)" ::: "memory");
        } else {
            XB_SPIN(xb_ld(&bar[XB_XGEN(b.x)]) == gen, bar);
            __builtin_amdgcn_fence(__ATOMIC_ACQUIRE, "agent");
            asm volatile("s_waitcnt vmcnt(0)" ::: "memory");
        }
    }
    __syncthreads();
}

__device__ __forceinline__ void spatial_phase(CP P, int j, int Mrows, LAS unsigned char* lds_, int tid, int lane, int wid) {
    const bf16* Z = (const bf16*)(P->ws + WS_Z); const float* VST = (const float*)(P->ws + WS_VST); bf16* Gb = (bf16*)(P->ws + WS_G);
    const bf16* WS = (const bf16*)(P->ws + WS_GMWS) + (size_t)j * 16 * 128 * 128;
    const float* lng = P->in[14] + (size_t)j * DM; const float* lnb = P->in[15] + (size_t)j * DM; const float* bs = P->in[17] + (size_t)j * 16 * 128;
    LAS bf16* Vt = (LAS bf16*)(LAS unsigned char*)lds_;
    constexpr int VP = 136;
    const int nunits = (Mrows / 128) * 16;
    for (int u = blockIdx.x; u < nunits; u += gridDim.x) {
        const int c = u >> 4, g = u & 15;
        __syncthreads();
        {
            const int q = tid >> 2, dq = (tid & 3) * 32; const int row = c * 128 + q;
            const float mean = VST[2 * row], rstd = VST[2 * row + 1];
            const bf16* src = Z + (size_t)row * 4096 + 2048 + g * 128 + dq;
#pragma unroll
            for (int t = 0; t < 4; ++t) { const u32x4 w = *(const u32x4*)(src + 8 * t);
                float v[8] = {bflo(w.x), bfhi(w.x), bflo(w.y), bfhi(w.y), bflo(w.z), bfhi(w.z), bflo(w.w), bfhi(w.w)};
                const float* gp = lng + g * 128 + dq + 8 * t; const float* bp = lnb + g * 128 + dq + 8 * t;
#pragma unroll
                for (int i = 0; i < 8; ++i) { const float vn = (v[i] - mean) * rstd * gp[i] + bp[i]; Vt[(dq + 8 * t + i) * VP + q] = tobf1(vn); } }
        }
        __syncthreads();
        const int fr = lane & 15, fq = lane >> 4;
        bf16x8 a[4];
        const bf16* wrow = WS + (size_t)g * 128 * 128 + (size_t)(16 * wid + fr) * 128 + 8 * fq;
#pragma unroll
        for (int ks = 0; ks < 4; ++ks) a[ks] = *(const bf16x8*)(wrow + 32 * ks);
#pragma unroll
        for (int nb = 0; nb < 8; ++nb) {
            f32x4 acc = {0.f, 0.f, 0.f, 0.f};
#pragma unroll
            for (int ks = 0; ks < 4; ++ks) { const bf16x8 b = *(const LAS bf16x8*)(Vt + (16 * nb + fr) * VP + 32 * ks + 8 * fq);
                acc = __builtin_amdgcn_mfma_f32_16x16x32_bf16(a[ks], b, acc, 0, 0, 0); }
#pragma unroll
            for (int r = 0; r < 4; ++r) { const int p = 16 * wid + fq * 4 + r, d = 16 * nb + fr; const size_t grow = (size_t)(c * 128 + p);
                const float sv = acc[r] + bs[g * 128 + p];
                const float uu = bf1(Z[grow * 4096 + g * 128 + d]);
                Gb[grow * 2048 + g * 128 + d] = tobf1(uu * sv); }
        }
    }
}

__device__ __forceinline__ void rope_cs(int row, int l, float& cs, float& sn) {
    const int t = row & (SEQ - 1); const int pos = (l & 32) ? (t & 63) : (t >> 6);
    const float inv = powf(10000.0f, -(float)(l & 15) * (1.0f / 16.0f));
    const float ang = (float)pos * inv; sincosf(ang, &sn, &cs);
}
__device__ __forceinline__ float rope_apply(float x, int l, float cs, float sn) {
    const float p = lane_xor16(x, l);
    return (l & 16) ? (p * sn + x * cs) : (x * cs - p * sn);
}
__device__ __forceinline__ void mla_norm_pass(CP P, int lane, int gw, int NGW) {
    const bf16* C = (const bf16*)(P->ws + WS_C); bf16* CQN = (bf16*)(P->ws + WS_CQN); bf16* CKVN = (bf16*)(P->ws + WS_CKVN); bf16* KR = (bf16*)(P->ws + WS_KR);
    const float* qn = P->in[20]; const float* kvn = P->in[21];
    for (int row = gw; row < MT; row += NGW) {
        const bf16* c = C + (size_t)row * 1280;
#pragma unroll
        for (int part = 0; part < 2; ++part) {
            const u32x4 w = *(const u32x4*)(c + part * 512 + 8 * lane);
            float v[8] = {bflo(w.x), bfhi(w.x), bflo(w.y), bfhi(w.y), bflo(w.z), bfhi(w.z), bflo(w.w), bfhi(w.w)};
            float ss = 0.f;
#pragma unroll
            for (int i = 0; i < 8; ++i) ss += v[i] * v[i];
            const float r = 1.0f / sqrtf(wave_sum(ss) * (1.0f / 512.0f) + LN_EPS);
            const float* nw = (part ? kvn : qn) + 8 * lane;
            u32x4 o; o.x = cvtpk(v[0] * r * nw[0], v[1] * r * nw[1]); o.y = cvtpk(v[2] * r * nw[2], v[3] * r * nw[3]); o.z = cvtpk(v[4] * r * nw[4], v[5] * r * nw[5]); o.w = cvtpk(v[6] * r * nw[6], v[7] * r * nw[7]);
            *(u32x4*)((part ? CKVN : CQN) + (size_t)row * 512 + 8 * lane) = o;
        }
        float x = bf1(c[1024 + lane]);
        if (row < ML) { float cs, sn; rope_cs(row, lane, cs, sn); x = rope_apply(x, lane, cs, sn); }
        KR[(size_t)row * 64 + lane] = tobf1(x);
    }
}
__device__ __forceinline__ void rope_pass(bf16* buf, int ld, int col0, int nchunks, int cstride, int lane, int gw, int NGW) {
    for (int row = gw; row < ML; row += NGW) {
        float cs, sn; rope_cs(row, lane, cs, sn);
        bf16* r = buf + (size_t)row * ld + col0 + lane;
#pragma unroll 4
        for (int k = 0; k < nchunks; ++k) { const float x = bf1(r[k * cstride]); r[k * cstride] = tobf1(rope_apply(x, lane, cs, sn)); }
    }
}

namespace att {
#define SBAR() __builtin_amdgcn_sched_barrier(0)
__device__ __forceinline__ int crow(int r, int hi) { return (r & 3) + 8 * (r >> 2) + 4 * hi; }
__device__ __forceinline__ unsigned cvtpkv(float lo, float hi) { unsigned r; asm volatile("v_cvt_pk_bf16_f32 %0, %1, %2" : "=v"(r) : "v"(lo), "v"(hi)); return r; }

__device__ __forceinline__ void partialSM(f32x16& p0, f32x16& p1, float& m_reg, float& mn, float& alpha, const float C, const float THRS) {
  float pmax = p0[0];
#pragma unroll
  for (int r = 1; r < 16; ++r) pmax = fmaxf(pmax, p0[r]);
#pragma unroll
  for (int r = 0; r < 16; ++r) pmax = fmaxf(pmax, p1[r]);
  { auto rr = __builtin_amdgcn_permlane32_swap(__float_as_uint(pmax), __float_as_uint(pmax), false, false);
    pmax = fmaxf(__uint_as_float(rr[0]), __uint_as_float(rr[1])); }
  if (__builtin_expect(__all(pmax - m_reg <= THRS), 1)) { mn = m_reg; alpha = 1.f; }
  else { mn = fmaxf(m_reg, pmax); alpha = __builtin_amdgcn_exp2f((m_reg - mn) * C); m_reg = mn; }
  const float mnC = -mn * C;
#pragma unroll
  for (int r = 0; r < 16; ++r) p0[r] = fmaf(p0[r], C, mnC);
#pragma unroll
  for (int r = 0; r < 16; ++r) p1[r] = fmaf(p1[r], C, mnC);
#pragma unroll
  for (int r = 0; r < 16; ++r) p0[r] = __builtin_amdgcn_exp2f(p0[r]);
}
__device__ __forceinline__ void finishSM(f32x16& p0, f32x16& p1, float alpha, float& l_reg, bf16x8& pa0, bf16x8& pa1, bf16x8& pa2, bf16x8& pa3) {
#pragma unroll
  for (int r = 0; r < 16; ++r) p1[r] = __builtin_amdgcn_exp2f(p1[r]);
  float ps = 0;
#pragma unroll
  for (int r = 0; r < 16; ++r) ps += p0[r];
#pragma unroll
  for (int r = 0; r < 16; ++r) ps += p1[r];
  { auto rr = __builtin_amdgcn_permlane32_swap(__float_as_uint(ps), __float_as_uint(ps), false, false);
    ps = __uint_as_float(rr[0]) + __uint_as_float(rr[1]); }
  l_reg = l_reg * alpha + ps;
#define PK4(P, BASE, OUT) do { unsigned a0 = cvtpkv(P[BASE + 0], P[BASE + 1]), a1 = cvtpkv(P[BASE + 2], P[BASE + 3]);   \
    unsigned b0 = cvtpkv(P[BASE + 4], P[BASE + 5]), b1 = cvtpkv(P[BASE + 6], P[BASE + 7]);                              \
    auto r0 = __builtin_amdgcn_permlane32_swap(a0, b0, false, false); auto r1 = __builtin_amdgcn_permlane32_swap(a1, b1, false, false); \
    u32x4 w = {r0[0], r1[0], r0[1], r1[1]}; OUT = *reinterpret_cast<bf16x8*>(&w); } while (0)
  PK4(p0, 0, pa0); PK4(p0, 8, pa1); PK4(p1, 0, pa2); PK4(p1, 8, pa3);
#undef PK4
}
template <int PITCH> __device__ __forceinline__ int kswz(int r) { return PITCH == 256 ? (r & 15) : ((r >> 1) & 7); }
template <int NQF, int NQR, int PITCH> __device__ __forceinline__ void qkt(f32x16& p0, f32x16& p1, const LAS char* Ks, int chunk0, const bf16x8* qr, const LAS char* ql, int r32, int hi) {
  p0 = f32x16{}; p1 = f32x16{};
  const int sw = kswz<PITCH>(r32);
#pragma unroll
  for (int d0 = 0; d0 < NQF; ++d0) { const int off = ((chunk0 + d0 * 2 + hi) ^ sw) * 16;
    const bf16x8 b0 = *(const LAS bf16x8*)(Ks + r32 * PITCH + off);
    const bf16x8 b1 = *(const LAS bf16x8*)(Ks + (32 + r32) * PITCH + off);
    const bf16x8 q = d0 < NQR ? qr[d0 < NQR ? d0 : 0] : *(const LAS bf16x8*)(ql + (d0 - NQR) * 1024);
    p0 = __builtin_amdgcn_mfma_f32_32x32x16_bf16(b0, q, p0, 0, 0, 0);
    p1 = __builtin_amdgcn_mfma_f32_32x32x16_bf16(b1, q, p1, 0, 0, 0); }
}
__device__ __forceinline__ int v_st(int k, int c) { const int kk = (k & ~0xC) | ((k & 4) << 1) | ((k & 8) >> 1); return ((kk >> 3) * 4 + (c >> 5)) * 512 + ((kk & 7) * 32 + (c & 31)) * 2; }
__device__ __forceinline__ int v_rd_base(int lane) { return ((lane & 3) << 3) | (((lane >> 2) & 3) << 6) | (((lane >> 4) & 1) << 5) | (((lane >> 5) & 1) << 8); }
constexpr int v_rd_off(int d0, int ks, int half) { return d0 * 512 + ks * 4096 + half * 2048; }
template <int OFF> __device__ __forceinline__ s16x4 tr_read(int vb) {
  s16x4 r; asm volatile("ds_read_b64_tr_b16 %0, %1 offset:%2" : "=&v"(r) : "v"(vb), "i"(OFF) : "memory"); return r;
}
template <int D0> __device__ __forceinline__ void pv_one(f32x16& od, int vb, bf16x8 pa0, bf16x8 pa1, bf16x8 pa2, bf16x8 pa3) {
  const s16x4 l0 = tr_read<v_rd_off(D0, 0, 0)>(vb), h0 = tr_read<v_rd_off(D0, 0, 1)>(vb), l1 = tr_read<v_rd_off(D0, 1, 0)>(vb), h1 = tr_read<v_rd_off(D0, 1, 1)>(vb);
  const s16x4 l2 = tr_read<v_rd_off(D0, 2, 0)>(vb), h2 = tr_read<v_rd_off(D0, 2, 1)>(vb), l3 = tr_read<v_rd_off(D0, 3, 0)>(vb), h3 = tr_read<v_rd_off(D0, 3, 1)>(vb);
  asm volatile("s_waitcnt lgkmcnt(0)" ::: "memory"); SBAR();
#define PK(L, H) (bf16x8){L[0], L[1], L[2], L[3], H[0], H[1], H[2], H[3]}
  od = __builtin_amdgcn_mfma_f32_32x32x16_bf16(pa0, PK(l0, h0), od, 0, 0, 0);
  od = __builtin_amdgcn_mfma_f32_32x32x16_bf16(pa1, PK(l1, h1), od, 0, 0, 0);
  od = __builtin_amdgcn_mfma_f32_32x32x16_bf16(pa2, PK(l2, h2), od, 0, 0, 0);
  od = __builtin_amdgcn_mfma_f32_32x32x16_bf16(pa3, PK(l3, h3), od, 0, 0, 0);
#undef PK
}
__device__ __forceinline__ void pv_d0(f32x16* o, int vb, bf16x8 pa0, bf16x8 pa1, bf16x8 pa2, bf16x8 pa3) {
  pv_one<0>(o[0], vb, pa0, pa1, pa2, pa3); pv_one<1>(o[1], vb, pa0, pa1, pa2, pa3); pv_one<2>(o[2], vb, pa0, pa1, pa2, pa3); pv_one<3>(o[3], vb, pa0, pa1, pa2, pa3);
}
__device__ __forceinline__ bf16x8 ld8(const bf16* p) { return *reinterpret_cast<const bf16x8*>(p); }

template <int MODE>
__device__ __forceinline__ void attn_unit(const bf16* __restrict__ Qrow0, int ldq, const bf16* __restrict__ Kb, const bf16* __restrict__ Vb, int ldk, const bf16* __restrict__ KRb,
                                          int b, int nct, int NT, bf16* __restrict__ Ob, float lam, const float* __restrict__ subln, float oscale, LAS unsigned char* lds_, const int tid_in) {
  constexpr int NQF = MODE == 0 ? 12 : 4, NQR = MODE == 0 ? 4 : 4, PITCH = MODE == 0 ? 384 : 256, SHM_V = 16384, SHM_K = 64 * PITCH, SDEPTH = MODE == 0 ? 1 : 2;
  const float SCALE = MODE == 0 ? 0.07216878364870323f : 0.125f;
  const float C = SCALE * 1.4426950408889634f, THRS = 8.f / SCALE;
  const int tid = launder_v(tid_in) & 511, wid = tid >> 6, lane = tid & 63, r32 = lane & 31, hi = lane >> 5;
  LAS char* lds = (LAS char*)(LAS unsigned char*)lds_;
  LAS char* V_lds = lds; LAS char* K_lds = lds + 2 * SHM_V;
  LAS float* wsf = (LAS float*)(lds + 2 * SHM_V + 2 * SHM_K) + wid * 64; LAS float* li_l = wsf; LAS float* al_l = wsf + 32;
  const int wq = MODE == 0 ? wid : (wid & 3), sgrp = MODE == 0 ? 0 : (wid >> 2);
  float m_reg = -1e30f, l_reg = 0; f32x16 o[4] = {}; bf16x8 qr[NQR];
  LAS char* ql = lds + 2 * SHM_V + 2 * SHM_K + 2048 + wid * 8192 + lane * 16;
  const bf16* Qw = Qrow0 + (size_t)(wq * 32 + r32) * ldq + sgrp * 64 + hi * 8;
#pragma unroll
  for (int d0 = 0; d0 < NQR; ++d0) qr[d0] = ld8(Qw + d0 * 16);
#pragma unroll
  for (int d0 = NQR; d0 < NQF; ++d0) *(LAS bf16x8*)(ql + (d0 - NQR) * 1024) = ld8(Qw + d0 * 16);
  const int sr = tid >> 4, sc = (tid & 15) * 8, vst0 = v_st(sr, sc), vst1 = v_st(32 + sr, sc);
  const int kst0 = sr * PITCH + (((tid & 15) ^ kswz<PITCH>(sr)) * 16), kst1 = kst0 + 32 * PITCH;
  const int rrow = tid >> 3, krs = rrow * PITCH + (((16 + (tid & 7)) ^ kswz<PITCH>(rrow)) * 16);
  const int chunk0 = sgrp * 8;
  const int vb0 = (int)(uintptr_t)V_lds + v_rd_base(lane);
  struct Slot { bf16x8 vs0, vs1, ks0, ks1, kr; } sr_[SDEPTH];
#define KROW(jt) ((jt) < nct ? (ML + b * CTXL + (jt) * 64) : (b * SEQ + ((jt) - nct) * 64))
#define SLOAD(i, jt) do { const int k0_ = KROW(jt); sr_[i].vs0 = ld8(Vb + (size_t)(k0_ + sr) * ldk + sc); sr_[i].vs1 = ld8(Vb + (size_t)(k0_ + 32 + sr) * ldk + sc); \
    sr_[i].ks0 = ld8(Kb + (size_t)(k0_ + sr) * ldk + sc); sr_[i].ks1 = ld8(Kb + (size_t)(k0_ + 32 + sr) * ldk + sc); \
    if (MODE == 0) sr_[i].kr = ld8(KRb + (size_t)(k0_ + rrow) * 64 + (tid & 7) * 8); } while (0)
#define SWRITE(bf, i) do { *(LAS bf16x8*)(V_lds + (bf) * SHM_V + vst0) = sr_[i].vs0; *(LAS bf16x8*)(V_lds + (bf) * SHM_V + vst1) = sr_[i].vs1; \
    *(LAS bf16x8*)(K_lds + (bf) * SHM_K + kst0) = sr_[i].ks0; *(LAS bf16x8*)(K_lds + (bf) * SHM_K + kst1) = sr_[i].ks1; \
    if (MODE == 0) *(LAS bf16x8*)(K_lds + (bf) * SHM_K + krs) = sr_[i].kr; } while (0)
#define SWAIT() do { if constexpr (SDEPTH == 2) asm volatile("s_waitcnt vmcnt(4)" ::: "memory"); else asm volatile("s_waitcnt vmcnt(0)" ::: "memory"); } while (0)
#define RESC(a) do { if (__any((a) < 1.f)) { if (hi == 0) al_l[r32] = (a); asm volatile("s_waitcnt lgkmcnt(0)" ::: "memory"); \
    _Pragma("unroll") for (int d = 0; d < 4; ++d) _Pragma("unroll") for (int r = 0; r < 16; ++r) o[d][r] *= al_l[crow(r, hi)]; } } while (0)
  f32x16 pA0, pA1, pB0, pB1; float mnA, mnB, alA, alB; bf16x8 pa0, pa1, pa2, pa3;
  constexpr int SE = 0, SO = SDEPTH - 1;
  SLOAD(SE, 0); asm volatile("s_waitcnt vmcnt(0)" ::: "memory"); SWRITE(0, SE); __syncthreads();
  qkt<NQF, NQR, PITCH>(pA0, pA1, K_lds, chunk0, qr, ql, r32, hi); partialSM(pA0, pA1, m_reg, mnA, alA, C, THRS);
  SLOAD(SO, 1); if constexpr (SDEPTH == 2) { if (2 < NT) SLOAD(SE, 2); }
  SWAIT(); SWRITE(1, SO); __syncthreads();
  for (int j = 1; j + 1 < NT; j += 2) {
    SBAR(); qkt<NQF, NQR, PITCH>(pB0, pB1, K_lds + SHM_K, chunk0, qr, ql, r32, hi);
    finishSM(pA0, pA1, alA, l_reg, pa0, pa1, pa2, pa3); SBAR();
    SLOAD(SO, j + SDEPTH); SBAR();
    pv_d0(o, vb0, pa0, pa1, pa2, pa3); partialSM(pB0, pB1, m_reg, mnB, alB, C, THRS);
    __syncthreads(); SWAIT(); SWRITE(0, SE);
    RESC(alB); __syncthreads();
    SBAR(); qkt<NQF, NQR, PITCH>(pA0, pA1, K_lds, chunk0, qr, ql, r32, hi);
    finishSM(pB0, pB1, alB, l_reg, pa0, pa1, pa2, pa3); SBAR();
    if (SDEPTH == 1 || j + 3 < NT) SLOAD(SE, j + 1 + SDEPTH); SBAR();
    pv_d0(o, vb0 + SHM_V, pa0, pa1, pa2, pa3); partialSM(pA0, pA1, m_reg, mnA, alA, C, THRS);
    __syncthreads(); SWAIT(); SWRITE(1, SO);
    RESC(alA); __syncthreads();
  }
  SBAR(); qkt<NQF, NQR, PITCH>(pB0, pB1, K_lds + SHM_K, chunk0, qr, ql, r32, hi);
  finishSM(pA0, pA1, alA, l_reg, pa0, pa1, pa2, pa3); SBAR();
  pv_d0(o, vb0, pa0, pa1, pa2, pa3); partialSM(pB0, pB1, m_reg, mnB, alB, C, THRS);
  __syncthreads(); RESC(alB);
  finishSM(pB0, pB1, alB, l_reg, pa0, pa1, pa2, pa3); SBAR();
  pv_d0(o, vb0 + SHM_V, pa0, pa1, pa2, pa3);
  if (hi == 0) li_l[r32] = l_reg; asm volatile("s_waitcnt lgkmcnt(0)" ::: "memory");
  float rli[16];
#pragma unroll
  for (int r = 0; r < 16; ++r) rli[r] = __builtin_amdgcn_rcpf(li_l[crow(r, hi)]);
  bf16* Ow = Ob + (size_t)(wq * 32) * DM;
  if constexpr (MODE == 0) {
#pragma unroll
    for (int r = 0; r < 16; ++r) { const int orow = crow(r, hi);
#pragma unroll
      for (int d0 = 0; d0 < 4; ++d0) Ow[(size_t)orow * DM + d0 * 32 + r32] = tobf1(o[d0][r] * rli[r]); }
    __syncthreads();
  } else {
    LAS float* ex = (LAS float*)lds;
    __syncthreads();
    if (sgrp == 1) {
#pragma unroll
      for (int r = 0; r < 16; ++r)
#pragma unroll
        for (int d0 = 0; d0 < 4; ++d0) ex[(wq * 32 + crow(r, hi)) * 128 + d0 * 32 + r32] = o[d0][r] * rli[r];
    }
    __syncthreads();
    if (sgrp == 0) {
#pragma unroll
      for (int r = 0; r < 16; ++r) { const int orow = crow(r, hi); float dd[4]; float ss = 0.f;
#pragma unroll
        for (int d0 = 0; d0 < 4; ++d0) { dd[d0] = o[d0][r] * rli[r] - lam * ex[(wq * 32 + orow) * 128 + d0 * 32 + r32]; ss += dd[d0] * dd[d0]; }
        ss = half_sum32(ss);
        const float rs = oscale / sqrtf(ss * (1.0f / 128.0f) + LN_EPS);
#pragma unroll
        for (int d0 = 0; d0 < 4; ++d0) Ow[(size_t)orow * DM + d0 * 32 + r32] = tobf1(dd[d0] * rs * subln[d0 * 32 + r32]); }
    }
    __syncthreads();
  }
#undef KROW
#undef SLOAD
#undef SWRITE
#undef SWAIT
#undef RESC
}
}

__device__ __forceinline__ void mla_attn_phase(CP P, LAS unsigned char* lds, const int tid) {
    const bf16* QM = (const bf16*)(P->ws + WS_QM); const bf16* KV = (const bf16*)(P->ws + WS_KV); const bf16* KR = (const bf16*)(P->ws + WS_KR); bf16* Gb = (bf16*)(P->ws + WS_G);
    const int c = blockIdx.x, G = gridDim.x;
    for (int u = c; u < 1024 + 32; u += G) {
        int b, h, qrow0, NT;
        if (u < 1024) { const int i = u >> 8, cc = u & 255; const int bh = (cc & 7) + 8 * i, qb = cc >> 3; b = bh >> 4; h = bh & 15; qrow0 = b * SEQ + qb * 256; NT = 4 + 128; }
        else { const int bh = u - 1024; b = bh >> 4; h = bh & 15; qrow0 = ML + b * CTXL; NT = 4; }
        att::attn_unit<0>(QM + (size_t)qrow0 * 3072 + h * 192, 3072, KV + h * 256, KV + h * 256 + 128, 4096, KR, b, 4, NT, Gb + (size_t)qrow0 * DM + h * 128, 0.f, nullptr, 1.f, lds, tid);
    }
}
__device__ __forceinline__ void da_attn_phase(CP P, float lam, float oscale, LAS unsigned char* lds, const int tid) {
    const bf16* Z = (const bf16*)(P->ws + WS_Z); bf16* Gb = (bf16*)(P->ws + WS_G); const float* subln = P->in[27];
    const int c = blockIdx.x, G = gridDim.x;
    for (int u = c; u < 2048 + 64; u += G) {
        int b, h, qrow0, NT;
        if (u < 2048) { const int i = u >> 8, cc = u & 255; const int bh = (cc & 7) + 8 * (i >> 1), qb = (cc >> 3) + 32 * (i & 1); b = bh >> 4; h = bh & 15; qrow0 = b * SEQ + qb * 128; NT = 4 + 128; }
        else { const int v = u - 2048; const int bh = v >> 1; b = bh >> 4; h = bh & 15; qrow0 = ML + b * CTXL + (v & 1) * 128; NT = 4; }
        att::attn_unit<1>(Z + (size_t)qrow0 * 6144 + h * 128, 6144, Z + 2048 + h * 128, Z + 4096 + h * 128, 6144, nullptr, b, 4, NT, Gb + (size_t)qrow0 * DM + h * 128, lam, subln, oscale, lds, tid);
    }
}

__device__ __forceinline__ unsigned f2ord(float f) { const unsigned u = __float_as_uint(f); return u ^ ((unsigned)((int)u >> 31) | 0x80000000u); }
__device__ __forceinline__ float ord2f(unsigned k) { return __uint_as_float((k & 0x80000000u) ? (k ^ 0x80000000u) : ~k); }
__device__ __forceinline__ void ce_desc(unsigned& a, unsigned& b) { const unsigned mx = a > b ? a : b, mn = a > b ? b : a; a = mx; b = mn; }
template <int N, bool DESC> __device__ __forceinline__ void bitonic_merge(unsigned* a) {
#pragma unroll
    for (int j = N / 2; j > 0; j >>= 1)
#pragma unroll
        for (int i = 0; i < N; ++i) { const int l = i ^ j; if (l > i) { if (DESC) ce_desc(a[i], a[l]); else ce_desc(a[l], a[i]); } }
}
template <int N, bool DESC> __device__ __forceinline__ void bitonic_sort(unsigned* a) {
#pragma unroll
    for (int k = 2; k <= N; k <<= 1)
#pragma unroll
        for (int j = k >> 1; j > 0; j >>= 1)
#pragma unroll
            for (int i = 0; i < N; ++i) { const int l = i ^ j; if (l > i) { const bool up = ((i & k) == 0); if (up == DESC) ce_desc(a[i], a[l]); else ce_desc(a[l], a[i]); } }
}
__device__ __forceinline__ void top16_of_64(unsigned (&a)[64]) {
    bitonic_sort<16, true>(a); bitonic_sort<16, false>(a + 16); bitonic_sort<16, true>(a + 32); bitonic_sort<16, false>(a + 48);
#pragma unroll
    for (int i = 0; i < 16; ++i) a[i] = a[i] > a[16 + i] ? a[i] : a[16 + i];
    bitonic_merge<16, true>(a);
#pragma unroll
    for (int i = 0; i < 16; ++i) a[32 + i] = a[32 + i] > a[48 + i] ? a[32 + i] : a[48 + i];
    bitonic_merge<16, false>(a + 32);
#pragma unroll
    for (int i = 0; i < 16; ++i) a[i] = a[i] > a[32 + i] ? a[i] : a[32 + i];
    bitonic_merge<16, true>(a);
}
template <int PASS> __device__ __forceinline__ void route_pass(const bf16* QP, const LAS char* lds, int tok, int head, int r32, int hi, unsigned (&top)[16]) {
    f32x16 acc[4] = {};
    const bf16* qp = QP + (size_t)tok * DM + head * 256 + PASS * 128 + hi * 8;
    bf16x8 qf[8];
#pragma unroll
    for (int ks = 0; ks < 8; ++ks) qf[ks] = *(const bf16x8*)(qp + ks * 16);
    const LAS char* Kl = lds + PASS * 32768;
#pragma unroll
    for (int kb = 0; kb < 4; ++kb)
#pragma unroll
        for (int ks = 0; ks < 8; ++ks) { const bf16x8 a = *(const LAS bf16x8*)(Kl + (kb * 32 + r32) * 256 + (((ks * 2 + hi) ^ (r32 & 15)) * 16));
            acc[kb] = __builtin_amdgcn_mfma_f32_32x32x16_bf16(a, qf[ks], acc[kb], 0, 0, 0); }
    unsigned key[64]; const unsigned base = 127u - 4u * (unsigned)hi;
#pragma unroll
    for (int kb = 0; kb < 4; ++kb)
#pragma unroll
        for (int r = 0; r < 16; ++r) key[kb * 16 + r] = (f2ord(acc[kb][r]) & ~127u) | (base - (unsigned)(kb * 32 + (r & 3) + 8 * (r >> 2)));
    top16_of_64(key);
    unsigned pr[16];
#pragma unroll
    for (int i = 0; i < 16; ++i) pr[i] = lane_xor32(key[15 - i], hi << 5);
#pragma unroll
    for (int i = 0; i < 16; ++i) key[i] = key[i] > pr[i] ? key[i] : pr[i];
    bitonic_merge<16, true>(key);
#pragma unroll
    for (int i = 0; i < 16; ++i) top[i] = key[i];
}
__device__ __forceinline__ void route_phase(CP P, int L, int Mrows, LAS unsigned char* lds_, int tid, int lane, int wid, int gw, int NGW) {
    const bf16* QP = (const bf16*)(P->ws + WS_QP); unsigned* ROUTE = (unsigned*)(P->ws + WS_ROUTE);
    LAS char* lds = (LAS char*)(LAS unsigned char*)lds_;
    __syncthreads();
    {
        const bf16* K1 = (const bf16*)(P->ws + WS_PK1) + (size_t)L * 128 * 128; const bf16* K2 = (const bf16*)(P->ws + WS_PK2) + (size_t)L * 128 * 128;
        for (int c16 = tid; c16 < 2 * 128 * 16; c16 += NWAVES * 64) { const int mat = c16 >> 11, row = (c16 >> 4) & 127, ch = c16 & 15;
            const u32x4 w = *(const u32x4*)((mat ? K2 : K1) + row * 128 + ch * 8);
            *(LAS u32x4*)(lds + mat * 32768 + row * 256 + ((ch ^ (row & 15)) * 16)) = w; }
    }
    __syncthreads();
    LAS unsigned* sc = (LAS unsigned*)(lds + 65536) + wid * 2048;
    const int r32 = lane & 31, hi = lane >> 5;
    for (int item = gw; item < Mrows / 4; item += NGW) {
        const int tok = item * 4 + (r32 >> 3), head = r32 & 7;
        unsigned top0[16], top1[16];
        route_pass<0>(QP, lds, tok, head, r32, hi, top0);
        route_pass<1>(QP, lds, tok, head, r32, hi, top1);
        float v1[16], v2[16];
#pragma unroll
        for (int i = 0; i < 16; ++i) { v1[i] = ord2f(top0[i] & ~127u); v2[i] = ord2f(top1[i] & ~127u);
            sc[i * 64 + lane] = 127u - (top0[i] & 127u); sc[(16 + i) * 64 + lane] = 127u - (top1[i] & 127u); }
        unsigned ck[64]; int n = 0;
#pragma unroll
        for (int i = 0; i < 16; ++i)
#pragma unroll
            for (int j = 0; j < 16; ++j) if ((i + 1) * (j + 1) <= 16) { ck[n] = (f2ord(v1[i] + v2[j]) & ~255u) | (unsigned)(i * 16 + j); ++n; }
#pragma unroll
        for (int i = 50; i < 64; ++i) ck[i] = 0u;
        top16_of_64(ck);
        float ev[16]; float sum = 0.f; const float mx = ord2f(ck[0] & ~255u);
#pragma unroll
        for (int k = 0; k < 16; ++k) { ev[k] = __expf(ord2f(ck[k] & ~255u) - mx); sum += ev[k]; }
        const float inv = 1.0f / sum;
        unsigned ee[16];
#pragma unroll
        for (int k = 0; k < 16; ++k) { const unsigned pc = ck[k] & 255u; const unsigned i1 = sc[(pc >> 4) * 64 + lane], i2 = sc[(16 + (pc & 15u)) * 64 + lane]; ee[k] = i1 * 128u + i2; ev[k] *= inv; }
        u32x4* outp = (u32x4*)(ROUTE + ((size_t)tok * 128 + head * 16 + hi * 8) * 2);
#pragma unroll
        for (int k = 0; k < 8; k += 2) { u32x4 w;
            const unsigned eL0 = ee[k], eH0 = ee[k + 8], eL1 = ee[k + 1], eH1 = ee[k + 9]; const float gL0 = ev[k], gH0 = ev[k + 8], gL1 = ev[k + 1], gH1 = ev[k + 9];
            w.x = hi ? eH0 : eL0; w.y = __float_as_uint(hi ? gH0 : gL0); w.z = hi ? eH1 : eL1; w.w = __float_as_uint(hi ? gH1 : gL1);
            outp[k >> 1] = w; }
    }
}

typedef float f32x2 __attribute__((ext_vector_type(2)));
typedef float f32x32 __attribute__((ext_vector_type(32)));
typedef unsigned u32x6 __attribute__((ext_vector_type(6)));
typedef __bf16 bf16x32 __attribute__((ext_vector_type(32)));
typedef unsigned u32x16 __attribute__((ext_vector_type(16)));
typedef __bf16 bf16x2_t __attribute__((ext_vector_type(2)));
constexpr int GS = 6, GSLOT = 2 * PROW;
__device__ __forceinline__ void glds16(const void* gsrc, unsigned lds_dst) { unsigned keep;
  asm volatile("s_mov_b32 %0, m0\n\ts_mov_b32 m0, %2\n\ts_nop 0\n\tglobal_load_lds_dwordx4 %1, off\n\ts_mov_b32 m0, %0" : "=&s"(keep) : "v"(gsrc), "s"(lds_dst) : "memory"); }
template <int GMODE = 0>
__device__ __forceinline__ void gather_phase(CP P, int L, int Mrows, LAS unsigned char* lds, int wid, int lane_, int gw, int NGW, bool dry = false) {
    const unsigned char* U = P->ws + WS_PU + (size_t)L * 16384 * PROW; const unsigned char* V = P->ws + WS_PV + (size_t)L * 16384 * PROW;
    const unsigned* ROUTE = (const unsigned*)(P->ws + WS_ROUTE); const float* MOD = (const float*)(P->ws + WS_MOD);
    bf16* X = (bf16*)(P->ws + WS_X); bf16* H = (bf16*)(P->ws + WS_H); bf16* Xo = dry ? (bf16*)(P->ws + WS_Y) : X; bf16* Ho = dry ? (bf16*)(P->ws + WS_G) : H;
    const float* lng = P->in[6] + (size_t)(L * 2 + 1) * DM; const float* lnb = P->in[7] + (size_t)(L * 2 + 1) * DM;
    const unsigned ring = (unsigned)(uintptr_t)lds + (unsigned)wid * (GS * GSLOT);
    for (int row = gw; row < Mrows; row += NGW) {
        const int lane = launder_v(lane_);
        const u32x2 ea = ((const u32x2*)(ROUTE + (size_t)row * 256))[lane], eb = ((const u32x2*)(ROUTE + (size_t)row * 256))[64 + lane];
        unsigned eax, eay, ebx, eby;
        unsigned hw[16];
#pragma unroll
        for (int j = 0; j < 4; ++j) { const u32x4 w = ((const u32x4*)(H + (size_t)row * DM))[4 * lane + j]; hw[4 * j] = w.x; hw[4 * j + 1] = w.y; hw[4 * j + 2] = w.z; hw[4 * j + 3] = w.w; }
        float y[32];
#pragma unroll
        for (int i = 0; i < 32; ++i) y[i] = 0.f;
        { unsigned e0 = ea.x, e1 = ea.y, e2 = eb.x, e3 = eb.y;
          asm volatile("" : "+v"(e0), "+v"(e1), "+v"(e2), "+v"(e3), "+v"(hw[0]), "+v"(hw[1]), "+v"(hw[2]), "+v"(hw[3]), "+v"(hw[4]), "+v"(hw[5]), "+v"(hw[6]), "+v"(hw[7]),
                       "+v"(hw[8]), "+v"(hw[9]), "+v"(hw[10]), "+v"(hw[11]), "+v"(hw[12]), "+v"(hw[13]), "+v"(hw[14]), "+v"(hw[15]) :: "memory");
          eax = e0; eay = e1; ebx = e2; eby = e3; }
        const unsigned rd_a = ring + 16u * (unsigned)lane, rd_b = ring + 1024u + 8u * (unsigned)lane;
#define G_ISSUE(k) do { const int k_ = (k); const unsigned e_ = (unsigned)__builtin_amdgcn_readlane((int)(k_ < 64 ? eax : ebx), k_ & 63); \
        const unsigned char* up_ = U + (size_t)e_ * PROW + 16 * lane; const unsigned char* vp_ = V + (size_t)e_ * PROW + 16 * lane; const unsigned sb_ = ring + (unsigned)(k_ % GS) * GSLOT; \
        if (GMODE != 2) { glds16(up_, sb_); glds16(vp_, sb_ + PROW); if (lane < 32) { glds16(up_ + 1024, sb_ + 1024); glds16(vp_ + 1024, sb_ + PROW + 1024); } } else { asm volatile("" :: "v"(up_), "v"(vp_), "s"(sb_)); } } while (0)
#pragma unroll
        for (int k = 0; k < 4; ++k) G_ISSUE(k);
#define G_READ(k, ua, ub, va, vb) do { const unsigned so_ = (unsigned)((k) % GS) * GSLOT; \
        asm volatile("ds_read_b128 %0, %4\n\tds_read_b64 %1, %5\n\tds_read_b128 %2, %4 offset:1536\n\tds_read_b64 %3, %5 offset:1536" \
                     : "=&v"(ua), "=&v"(ub), "=&v"(va), "=&v"(vb) : "v"(rd_a + so_), "v"(rd_b + so_) : "memory"); } while (0)
#pragma unroll 1
        for (int k = 0; k < 128; k += 2) {
            if (k + 4 < 128) { G_ISSUE(k + 4); G_ISSUE(k + 5); asm volatile("s_waitcnt vmcnt(16)" ::: "memory"); }
            else if (k == 124) asm volatile("s_waitcnt vmcnt(8)" ::: "memory");
            else asm volatile("s_waitcnt vmcnt(0)" ::: "memory");
            u32x4 uaA, vaA, uaB, vaB; u32x2 ubA, vbA, ubB, vbB;
            G_READ(k, uaA, ubA, vaA, vbA); G_READ(k + 1, uaB, ubB, vaB, vbB);
            asm volatile("s_waitcnt lgkmcnt(0)" : "+v"(uaA), "+v"(ubA), "+v"(vaA), "+v"(vbA), "+v"(uaB), "+v"(ubB), "+v"(vaB), "+v"(vbB) :: "memory");
            if (GMODE == 1) continue;
            const u32x6 u6A = {uaA.x, uaA.y, uaA.z, uaA.w, ubA.x, ubA.y}, u6B = {uaB.x, uaB.y, uaB.z, uaB.w, ubB.x, ubB.y};
            const u32x16 ubfA = __builtin_bit_cast(u32x16, __builtin_amdgcn_cvt_scalef32_pk32_bf16_fp6(u6A, 1.0f));
            const u32x16 ubfB = __builtin_bit_cast(u32x16, __builtin_amdgcn_cvt_scalef32_pk32_bf16_fp6(u6B, 1.0f));
            float a0 = 0.f, a1 = 0.f, b0 = 0.f, b1 = 0.f;
#pragma unroll
            for (int q = 0; q < 16; q += 2) { const unsigned h0_ = hw[q], h1_ = hw[q + 1], x0_ = ubfA[q], x1_ = ubfA[q + 1], z0_ = ubfB[q], z1_ = ubfB[q + 1];
                a0 = __builtin_amdgcn_fdot2_f32_bf16(__builtin_bit_cast(bf16x2_t, h0_), __builtin_bit_cast(bf16x2_t, x0_), a0, false);
                a1 = __builtin_amdgcn_fdot2_f32_bf16(__builtin_bit_cast(bf16x2_t, h1_), __builtin_bit_cast(bf16x2_t, x1_), a1, false);
                b0 = __builtin_amdgcn_fdot2_f32_bf16(__builtin_bit_cast(bf16x2_t, h0_), __builtin_bit_cast(bf16x2_t, z0_), b0, false);
                b1 = __builtin_amdgcn_fdot2_f32_bf16(__builtin_bit_cast(bf16x2_t, h1_), __builtin_bit_cast(bf16x2_t, z1_), b1, false); }
            const float dA = wave_sum(a0 + a1) * (1.0f / U_SCALE), dB = wave_sum(b0 + b1) * (1.0f / U_SCALE);
            const unsigned gsel = k < 64 ? eay : eby;
            const float wA = __uint_as_float((unsigned)__builtin_amdgcn_readlane((int)gsel, k & 63)) * gelu_tanh(dA) * (1.0f / V_SCALE);
            const float wB = __uint_as_float((unsigned)__builtin_amdgcn_readlane((int)gsel, (k & 63) + 1)) * gelu_tanh(dB) * (1.0f / V_SCALE);
            const u32x6 v6A = {vaA.x, vaA.y, vaA.z, vaA.w, vbA.x, vbA.y};
            const f32x32 vfA = __builtin_amdgcn_cvt_scalef32_pk32_f32_fp6(v6A, 1.0f);
#pragma unroll
            for (int i = 0; i < 32; ++i) y[i] += wA * vfA[i];
            const u32x6 v6B = {vaB.x, vaB.y, vaB.z, vaB.w, vbB.x, vbB.y};
            const f32x32 vfB = __builtin_amdgcn_cvt_scalef32_pk32_f32_fp6(v6B, 1.0f);
#pragma unroll
            for (int i = 0; i < 32; ++i) y[i] += wB * vfB[i];
        }
#undef G_READ
#undef G_ISSUE
        const int slot = row_slot(row);
        const float* mod = MOD + (size_t)(L * 3 + slot) * 12288;
        const int le = launder_v(lane);
        { float xx[32], gg[32]; load_row_bf16_b(X + (size_t)row * DM, le, xx); load_row_f32_b(mod + 5 * 2048, le, gg);
#pragma unroll
          for (int i = 0; i < 32; ++i) y[i] = ALPHA * xx[i] + gg[i] * y[i]; }
        if (L < NLAYER - 1) { const float* modn = MOD + (size_t)((L + 1) * 3 + slot) * 12288;
            finish_row<true>(y, lng, lnb, Xo + (size_t)row * DM, modn, modn + 2048, Ho + (size_t)row * DM, nullptr, le); }
        else finish_row<true>(y, lng, lnb, nullptr, nullptr, nullptr, nullptr, P->out + (size_t)row * DM, le);
        asm volatile("s_waitcnt vmcnt(0)" ::: "memory");
    }
}

#ifndef ROPE_TEST
#define ROPE_TEST 0
#endif
#ifndef PROBE_DUP
#define PROBE_DUP 0
#endif
#define NOINL __forceinline__
__device__ __forceinline__ CP launder_cp(CP p) { asm volatile("" : "+s"(p)); return p; }
#define GETP() launder_cp((CP)__builtin_amdgcn_kernarg_segment_ptr())
__device__ __forceinline__ int uni(int v) { return __builtin_amdgcn_readfirstlane(v); }
__device__ __forceinline__ LAS unsigned char* uni_lds(LAS unsigned char* p) { return (LAS unsigned char*)(unsigned)__builtin_amdgcn_readfirstlane((int)(unsigned)(uintptr_t)p); }
#define PH_IDS const int wid = uni(wv_), lane = launder_v(lane_id_fresh()) & 63, tid = (wid & 7) * 64 + lane; const int gw = blockIdx.x * NWAVES + wid, NGW = gridDim.x * NWAVES; (void)lane; (void)gw; (void)NGW; (void)tid;

__device__ NOINL void ph_prologue(int wv_, LAS unsigned char* lds_) { CP P = GETP(); LAS unsigned char* lds = uni_lds(lds_); PH_IDS p0_prologue(P, lds, tid, lane, wid, gw, NGW); if (PROBE_DUP == 5) p0_prologue(P, lds, tid, lane, wid, gw, NGW); }
__device__ NOINL void ph_modreduce(int wv_) { CP P = GETP(); PH_IDS mod_reduce(P, gw, lane, NGW); }
__device__ NOINL void ph_first(int wv_) { CP P = GETP(); PH_IDS
#pragma unroll 1
    for (int rep = 0; rep < (PROBE_DUP == 6 ? 2 : 1); ++rep) first_row_pass(P, lane, gw, NGW); }
__device__ NOINL void ph_postmix(int wv_, int L_, int M_) { CP P = GETP(); const int L = uni(L_), Mrows = uni(M_); PH_IDS post_mixer_pass(P, L, Mrows, lane, gw, NGW); }
__device__ NOINL void ph_vstats(int wv_, int M_) { CP P = GETP(); const int Mrows = uni(M_); PH_IDS
#pragma unroll 1
    for (int rep = 0; rep < (PROBE_DUP == 6 ? 2 : 1); ++rep) vstats_pass(P, Mrows, lane, gw, NGW); }
__device__ NOINL void ph_spatial(int wv_, LAS unsigned char* lds_, int j_, int M_) { CP P = GETP(); LAS unsigned char* lds = uni_lds(lds_); const int j = uni(j_), Mrows = uni(M_); PH_IDS
#pragma unroll 1
    for (int rep = 0; rep < (PROBE_DUP == 6 ? 2 : 1); ++rep) spatial_phase(P, j, Mrows, lds, tid, lane, wid); }
__device__ NOINL void ph_mla_norm(int wv_) { CP P = GETP(); PH_IDS
#pragma unroll 1
    for (int rep = 0; rep < (PROBE_DUP == 6 ? 2 : 1); ++rep) mla_norm_pass(P, lane, gw, NGW); }
__device__ NOINL void ph_rope(int wv_, int which_) { CP P = GETP(); const int which = uni(which_); PH_IDS
    if (which == 0) rope_pass((bf16*)(P->ws + WS_QM), 3072, 128, 16, 192, lane, gw, NGW);
    else rope_pass((bf16*)(P->ws + WS_Z), 6144, 0, 64, 64, lane, gw, NGW); }
__device__ NOINL void ph_attn_mla(int wv_, LAS unsigned char* lds_) { CP P = GETP(); LAS unsigned char* lds = uni_lds(lds_); PH_IDS mla_attn_phase(P, lds, tid); if (PROBE_DUP == 2) mla_attn_phase(P, lds, tid); }
__device__ NOINL void ph_attn_da(int wv_, LAS unsigned char* lds_, int L_) { CP P = GETP(); LAS unsigned char* lds = uni_lds(lds_); const int L = uni(L_); PH_IDS
    const float* lp = P->in[26];
    const float s01 = wave_sum(lp[lane] * lp[64 + lane]), s23 = wave_sum(lp[128 + lane] * lp[192 + lane]);
    const float lam_init = 0.8f - 0.6f * expf(-0.3f * (float)L);
    const float lam = expf(s01) - expf(s23) + lam_init;
    da_attn_phase(P, lam, 1.0f - lam_init, lds, tid); if (PROBE_DUP == 2) da_attn_phase(P, lam, 1.0f - lam_init, lds, tid); }
__device__ NOINL void ph_route(int wv_, LAS unsigned char* lds_, int L_, int M_) { CP P = GETP(); LAS unsigned char* lds = uni_lds(lds_); const int L = uni(L_), Mrows = uni(M_); PH_IDS
#pragma unroll 1
    for (int rep = 0; rep < (PROBE_DUP == 4 ? 2 : 1); ++rep) route_phase(P, L, Mrows, lds, tid, lane, wid, gw, NGW); }
__device__ NOINL void ph_gather(int wv_, LAS unsigned char* lds_, int L_, int M_) { CP P = GETP(); LAS unsigned char* lds = uni_lds(lds_); const int L = uni(L_), Mrows = uni(M_); PH_IDS
    if (PROBE_DUP == 3) { gather_phase<0>(P, L, Mrows, lds, wid, lane, gw, NGW, true); }
    if (PROBE_DUP == 7) { gather_phase<1>(P, L, Mrows, lds, wid, lane, gw, NGW, true); }
    if (PROBE_DUP == 8) { gather_phase<2>(P, L, Mrows, lds, wid, lane, gw, NGW, true); }
    gather_phase<0>(P, L, Mrows, lds, wid, lane, gw, NGW); }

enum GemmId { G_GM_IN = 0, G_GM_OUT, G_MLA_IN, G_MLA_UQ, G_MLA_UKV, G_MLA_OUT, G_DA_IN, G_DA_OUT, G_PEER_Q };
__device__ NOINL void ph_gemm(int wv_, LAS unsigned char* lds_, int id_, int L_, int M_) {
    CP P = GETP(); LAS unsigned char* lds = uni_lds(lds_); const int id = uni(id_), L = uni(L_), Mrows = uni(M_); PH_IDS
    unsigned char* ws = P->ws; const int jj = L / 3;
    size_t a = WS_H, b = 0, o = 0; int M = MT, N = 2048, K = 2048, act = 0, rope = 0;
    switch (id) {
        case G_GM_IN:   a = WS_H;    b = WS_GMWIN + (size_t)jj * 4096 * 2048 * 2;  o = WS_Z;  M = Mrows; N = 4096; K = 2048; act = 1; break;
        case G_GM_OUT:  a = WS_G;    b = WS_GMWOUT + (size_t)jj * 2048 * 2048 * 2; o = WS_Y;  M = Mrows; N = 2048; K = 2048; break;
        case G_MLA_IN:  a = WS_H;    b = WS_MLAIN;  o = WS_C;  N = 1280; K = 2048; break;
        case G_MLA_UQ:  a = WS_CQN;  b = WS_MLAUQ;  o = WS_QM; N = 3072; K = 512;  rope = (ROPE_TEST == 2) ? 0 : 2; break;
        case G_MLA_UKV: a = WS_CKVN; b = WS_MLAUKV; o = WS_KV; N = 4096; K = 512;  break;
        case G_MLA_OUT: a = WS_G;    b = WS_MLAOUT; o = WS_Y;  N = 2048; K = 2048; break;
        case G_DA_IN:   a = WS_H;    b = WS_DAIN;   o = WS_Z;  N = 6144; K = 2048; rope = (ROPE_TEST == 1) ? 0 : 1; break;
        case G_DA_OUT:  a = WS_G;    b = WS_DAOUT;  o = WS_Y;  N = 2048; K = 2048; break;
        default:        a = WS_H;    b = WS_PWQ + (size_t)L * 2048 * 2048 * 2;     o = WS_QP; M = Mrows; N = 2048; K = 2048; break;
    }
    pg8::Gemm g{(const pg8::bf16_t*)(ws + a), (const pg8::bf16_t*)(ws + b), M, N, K}; pg8::StaticOrder S; S.init(M, N, (int)gridDim.x, (int)blockIdx.x);
    pg8::EpiR E{(pg8::bf16_t*)(ws + o), N, act, rope, (const float*)(ws + WS_ROPE)};
#pragma unroll 1
    for (int rep = 0; rep < (PROBE_DUP == 1 ? 2 : 1); ++rep) { pg8::gemm_phase<pg8::EpiR, pg8::StaticOrder, true, true>((PG8_LAS unsigned char*)lds, g, S, E, tid); __syncthreads(); }
    const bool tail_u = (id == G_GM_OUT || id == G_MLA_OUT || id == G_DA_OUT), tail_v = (id == G_PEER_Q);
    if ((tail_u || tail_v) && L + 1 < NLAYER) {
        const int units = (M / 256) * (N / 256), G = (int)gridDim.x, tail = units % G, c = (int)blockIdx.x;
        const float* src = (tail_u ? P->in[11] : P->in[12]) + (size_t)(L + 1) * 16384 * 2048; unsigned char* dst = ws + (tail_u ? WS_PU : WS_PV) + (size_t)(L + 1) * 16384 * PROW;
        LAS float* scr = (LAS float*)(lds + wid * 16384);
        if (tail != 0 && c >= tail) cvt_table_fp6(src, dst, 16384, tail_u ? U_SCALE : V_SCALE, scr, lane, (c - tail) * NWAVES + wid, (G - tail) * NWAVES);
        else if (tail == 0) cvt_table_fp6(src, dst, 16384, tail_u ? U_SCALE : V_SCALE, scr, lane, gw, NGW);
    }
}

__global__ void __launch_bounds__(NWAVES * 64, 2) mk_fwd(Params Pv) {
    extern __shared__ __attribute__((aligned(16))) unsigned char lds_g[];
    LAS unsigned char* lds = (LAS unsigned char*)lds_g;
    const int wv = __builtin_amdgcn_readfirstlane((int)threadIdx.x >> 6);
    const int tid = wv * 64 + lane_id_fresh();
    for (int u = tid; u < (LDS_BYTES - RING_BYTES) / 4; u += NWAVES * 64) ((LAS unsigned*)(lds + RING_BYTES))[u] = 0u;
    __syncthreads();
    const int lo = Pv.ph_lo, hi = Pv.ph_hi;
    unsigned* barw = (unsigned*)(Pv.ws + WS_CTL) + CW_BAR;
    XcdBarrier bar; bar.bar = barw; bar.x = 0; bar.st = nullptr;
    if (hi - lo > 1) bar = xcd_barrier_post(barw, (volatile LAS unsigned*)(lds + MISC_OFF) + 8, tid == 0);
    int ph = 0;
#ifndef SEL
#define SELP(k) true
#else
#define SELP(k) ((k) == SEL)
#endif
    enum { RUN_BASE = __COUNTER__ + 1 };
#define RUN(call) do { if (SELP(__COUNTER__ - RUN_BASE) && ph >= lo && ph < hi) { call; } if (ph >= lo && ph + 1 < hi) xcd_barrier(bar, wv == 0 && lane_id_fresh() == 0); ++ph; } while (0)
    RUN(ph_prologue(wv, lds));
    RUN(ph_modreduce(wv));
    RUN(ph_first(wv));
#define LAYER(LL) do { constexpr int L = (LL); constexpr int kind = L % 3, jj = L / 3; constexpr int Mrows = (L == NLAYER - 1) ? ML : MT;     \
        if (kind == 0) {                          \
            RUN(ph_gemm(wv, lds, G_GM_IN, L, Mrows)); \
            RUN(ph_vstats(wv, Mrows)); \
            RUN(ph_spatial(wv, lds, jj, Mrows)); \
            RUN(ph_gemm(wv, lds, G_GM_OUT, L, Mrows)); \
        } else if (kind == 1) {                   \
            RUN(ph_gemm(wv, lds, G_MLA_IN, L, Mrows)); \
            RUN(ph_mla_norm(wv)); \
            RUN(ph_gemm(wv, lds, G_MLA_UQ, L, Mrows); ph_gemm(wv, lds, G_MLA_UKV, L, Mrows)); \
            if (ROPE_TEST == 2) { RUN(ph_rope(wv, 0)); } \
            RUN(ph_attn_mla(wv, lds)); \
            RUN(ph_gemm(wv, lds, G_MLA_OUT, L, Mrows)); \
        } else {                                  \
            RUN(ph_gemm(wv, lds, G_DA_IN, L, Mrows); if (ROPE_TEST == 1) { __syncthreads(); } ); \
            if (ROPE_TEST == 1) { RUN(ph_rope(wv, 1)); } \
            RUN(ph_attn_da(wv, lds, L)); \
            RUN(ph_gemm(wv, lds, G_DA_OUT, L, Mrows)); \
        } \
        RUN(ph_postmix(wv, L, Mrows));                \
        RUN(ph_gemm(wv, lds, G_PEER_Q, L, Mrows));    \
        RUN(ph_route(wv, lds, L, Mrows));             \
        RUN(ph_gather(wv, lds, L, Mrows));            \
    } while (0)
    LAYER(0); LAYER(1); LAYER(2); LAYER(3);
#undef LAYER
#undef RUN
}

extern "C" void kernel_launch(void* const* d_in, const int* in_sizes, int n_in, void* d_out, int out_size, void* d_ws, size_t ws_size, hipStream_t stream) {
    static int grid = 0;
    if (grid == 0) {
        if (n_in != 29 || in_sizes[0] != ML * DM || out_size != ML * DM || ws_size < WS_END) {
            fprintf(stderr, "kernel_launch: shape mismatch: n_in %d in0 %d out %d ws %zu (need %zu); nothing launched\n", n_in, n_in > 0 ? in_sizes[0] : -1, out_size, ws_size, (size_t)WS_END); grid = -1; return; }
        int dev = 0, cus = 0, per_cu = 0;
        if (hipGetDevice(&dev) != hipSuccess || hipDeviceGetAttribute(&cus, hipDeviceAttributeMultiprocessorCount, dev) != hipSuccess) { fprintf(stderr, "kernel_launch: device query failed\n"); grid = -1; return; }
        if (hipFuncSetAttribute((const void*)mk_fwd, hipFuncAttributeMaxDynamicSharedMemorySize, LDS_BYTES) != hipSuccess) { fprintf(stderr, "kernel_launch: hipFuncSetAttribute failed\n"); grid = -1; return; }
        if (hipOccupancyMaxActiveBlocksPerMultiprocessor(&per_cu, (const void*)mk_fwd, NWAVES * 64, LDS_BYTES) != hipSuccess || per_cu < 1)
            fprintf(stderr, "kernel_launch: note: occupancy query reports %d workgroups per CU\n", per_cu);
        (void)hipGetLastError();
        grid = cus;
    }
    if (grid < 0) return;
    if (hipMemsetAsync((char*)d_ws + WS_CTL, 0, CTL_ZERO_BYTES, stream) != hipSuccess) { fprintf(stderr, "kernel_launch: memset failed\n"); return; }
    Params p{};
    for (int i = 0; i < 29; ++i) p.in[i] = (const float*)d_in[i];
    p.out = (float*)d_out; p.ws = (unsigned char*)d_ws;
#if MK_ONE_LAUNCH
    p.ph_lo = 0; p.ph_hi = NPH;
    hipLaunchKernelGGL(mk_fwd, dim3(grid), dim3(NWAVES * 64), LDS_BYTES, stream, p);
#else
    for (int li = 0; li < NPH; ++li) { p.ph_lo = li; p.ph_hi = li + 1; hipLaunchKernelGGL(mk_fwd, dim3(grid), dim3(NWAVES * 64), LDS_BYTES, stream, p); }
#endif
    const hipError_t le = hipPeekAtLastError();
    if (le != hipSuccess) fprintf(stderr, "kernel_launch: launch failed: %s\n", hipGetErrorName(le));
}
```

```cpp
#include <hip/hip_runtime.h>
#include <cstdio>
#include <cstdint>
#ifndef MK_ONE_LAUNCH
#define MK_ONE_LAUNCH 1
#endif
__device__ __forceinline__ int launder_v(int v) { asm volatile("" : "+v"(v)); return v; }
__device__ __forceinline__ int lane_id_fresh() { unsigned m = ~0u; asm volatile("" : "+s"(m)); return (int)__builtin_amdgcn_mbcnt_hi(m, __builtin_amdgcn_mbcnt_lo(m, 0u)); }
namespace pg8 {
#define PG8_LAS __attribute__((address_space(3)))
typedef unsigned short bf16_t;
typedef short bf16x8 __attribute__((ext_vector_type(8)));
typedef float f32x4 __attribute__((ext_vector_type(4)));
typedef unsigned u32x4 __attribute__((ext_vector_type(4)));
constexpr int BM = 256, BK = 64, HALF = 128, HTB = HALF * BK * 2  , STAGE_BYTES = 8 * HTB, NXCD = 8, WGM = 8;

__host__ __device__ __forceinline__ int lds_byte(int r, int c) { const int st = (r >> 4) * 2 + (c >> 5), rr = r & 15, cc = c & 31, ob = rr * 64 + cc * 2; return st * 1024 + (ob ^ (((ob >> 9) & 1) << 5)); }
__host__ __device__ __forceinline__ void stage_rc(int b, int& R, int& C) { const int st = b / 1024, sb = b % 1024, swz = sb ^ (((sb >> 9) & 1) << 5); R = (st >> 1) * 16 + swz / 64; C = (st & 1) * 32 + (swz % 64) / 2; }
__host__ __device__ __forceinline__ int perm32(int rho) { const int n = rho >> 4, i = rho & 15; return 8 * (i >> 2) + 4 * n + (i & 3); }

struct Unit { int pm, pn; };
struct Gemm { const bf16_t* A; const bf16_t* Bt; int M, N, K; };

struct StaticOrder {
    int nM, nN, nwg, G, c;
    __host__ __device__ void init(int M, int N, int G_, int c_) { nM = M / BM; nN = N / BM; nwg = nM * nN; G = G_; c = c_; }
    __host__ __device__ bool next(int i, Unit& u) const {
        const long L = (long)i * G + c; if (L >= nwg) return false;
        int wgid = (int)L; { const int q = nwg / NXCD, r = nwg % NXCD, xcd = wgid % NXCD, off = wgid / NXCD; wgid = (xcd < r ? xcd * (q + 1) : r * (q + 1) + (xcd - r) * q) + off; }
        const int nig = WGM * nN, gid = wgid / nig, fm = gid * WGM, gsz = (nM - fm) < WGM ? (nM - fm) : WGM;
        u.pm = fm + ((wgid % nig) % gsz); u.pn = (wgid % nig) / gsz; return true;
    }
    __device__ __forceinline__ void a_ready(const Unit&) const {}
    __device__ __forceinline__ void done(const Unit&) const {}
};

__device__ __forceinline__ unsigned cvt_pk_bf16(float lo, float hi) { unsigned r; asm volatile("v_cvt_pk_bf16_f32 %0, %1, %2" : "=v"(r) : "v"(lo), "v"(hi)); return r; }
typedef float f32x2 __attribute__((ext_vector_type(2)));
__device__ __forceinline__ f32x2 gelu_pk(f32x2 v) {
    const f32x2 av = __builtin_elementwise_abs(v), d = av * 0.2316418882f + 1.0f;
    f32x2 t; t.x = __builtin_amdgcn_rcpf(d.x); t.y = __builtin_amdgcn_rcpf(d.y);
    f32x2 q = t * 0.5307027145f + (-0.7265760135f); q = q * t + 0.7107068705f; q = q * t + (-0.142248368f); q = q * t + 0.127414796f; q = q * t;
    const f32x2 s = (v * v) * (-0.72134752044f);
    f32x2 e; e.x = __builtin_amdgcn_exp2f(s.x); e.y = __builtin_amdgcn_exp2f(s.y);
    const f32x2 m = v * (q * e), r = v - m;
    f32x2 o; o.x = v.x < 0.f ? m.x : r.x; o.y = v.y < 0.f ? m.y : r.y; return o;
}

template <int ACT  > struct EpiBf16 {
    static constexpr bool PERM = true, AFTER_DRAIN = false; static_assert(ACT == 0 || ACT == 1, "EpiBf16: ACT is 0 (none) or 1 (gelu_pk)");
    bf16_t* O; int ldc; const float* bias; int split_cols; size_t split_stride; float scale0;
    __device__ __forceinline__ void operator()(const f32x4 (&acc)[2][2][4][2], const Unit& u, int wr, int wc, int fr, int fq) const {
        const int row0 = u.pm * BM + wr * 64 + fr; int colt = u.pn * BM; bf16_t* base = O;
        float sc = 1.f; if (split_cols) { const int t = colt / split_cols; base += (size_t)t * split_stride; colt -= t * split_cols; if (t == 0) sc = scale0; }
        const int col0 = colt + wc * 32 + 8 * fq, bcol0 = u.pn * BM + wc * 32 + 8 * fq;
        f32x4 bv[2][2];
#pragma unroll
        for (int bj = 0; bj < 2; ++bj)
#pragma unroll
            for (int n = 0; n < 2; ++n) bv[bj][n] = bias ? *(const f32x4*)(bias + bcol0 + bj * HALF + 4 * n) : (f32x4){0.f, 0.f, 0.f, 0.f};
#pragma unroll
        for (int ai = 0; ai < 2; ++ai)
#pragma unroll
            for (int m = 0; m < 4; ++m) { bf16_t* rowp = base + (size_t)(row0 + ai * HALF + m * 16) * ldc + col0;
#pragma unroll
                for (int bj = 0; bj < 2; ++bj) { f32x4 v0 = acc[ai][bj][m][0] + bv[bj][0], v1 = acc[ai][bj][m][1] + bv[bj][1];
                    if (ACT == 1) { f32x2 a = gelu_pk((f32x2){v0[0], v0[1]}), b = gelu_pk((f32x2){v0[2], v0[3]}), c = gelu_pk((f32x2){v1[0], v1[1]}), d = gelu_pk((f32x2){v1[2], v1[3]});
                        v0 = (f32x4){a.x, a.y, b.x, b.y}; v1 = (f32x4){c.x, c.y, d.x, d.y}; }
                    v0 = v0 * sc; v1 = v1 * sc; u32x4 w; w.x = cvt_pk_bf16(v0[0], v0[1]); w.y = cvt_pk_bf16(v0[2], v0[3]); w.z = cvt_pk_bf16(v1[0], v1[1]); w.w = cvt_pk_bf16(v1[2], v1[3]);
                    *(u32x4*)(rowp + bj * HALF) = w; } }
    }
};
template <class Epi, class Sched, bool ALIGN_EPI = false, bool SP2 = false>
__device__ __forceinline__ void gemm_phase(PG8_LAS unsigned char* lds, const Gemm g, const Sched& S, const Epi& E, const int tid_in) {
    const int tid = launder_v(tid_in) & 511, wid = __builtin_amdgcn_readfirstlane(tid >> 6), lane = tid & 63, wr = wid >> 2, wc = wid & 3, fr = lane & 15, fq = lane >> 4;
    const int K = g.K, nt = K / BK;
    unsigned voffA[2], voffB[2];
#pragma unroll
    for (int i = 0; i < 2; ++i) { int R, C; stage_rc(tid * 16 + i * 8192, R, C); const int Rb = Epi::PERM ? ((R & ~31) + perm32(R & 31)) : R;
        voffA[i] = (unsigned)(R * K + C) * 2u; voffB[i] = (unsigned)(Rb * K + C) * 2u; }
    const size_t kstep = (size_t)(BK * 2);
    const size_t hstep = (size_t)HALF * K * 2;
    const size_t tstep = 2 * hstep;
    const unsigned ldsw = (unsigned)wid * 1024u;
    const int aoff = lds_byte(wr * 64 + fr, fq * 8), boff = lds_byte(wc * 32 + fr, fq * 8);
#define PG8_SA(b, h) (((b) * 2 + (h)) * HTB)
#define PG8_SB(b, h) ((4 + (b) * 2 + (h)) * HTB)
#define PG8_STAGE(bufoff, gbase, voff) do { _Pragma("unroll") for (int _i = 0; _i < 2; ++_i) \
        __builtin_amdgcn_global_load_lds((const unsigned*)((const char*)(gbase) + (voff)[_i]), (PG8_LAS unsigned*)(lds + (bufoff) + ldsw + _i * 8192), 16, 0, 0); } while (0)
#define PG8_LDA(dst, b, h) do { _Pragma("unroll") for (int m = 0; m < 4; ++m) _Pragma("unroll") for (int k = 0; k < 2; ++k) dst[m][k] = *(const PG8_LAS bf16x8*)(lds + PG8_SA(b, h) + aoff + m * 2048 + k * 1024); } while (0)
#define PG8_LDB(dst, b, h) do { _Pragma("unroll") for (int n = 0; n < 2; ++n) _Pragma("unroll") for (int k = 0; k < 2; ++k) dst[n][k] = *(const PG8_LAS bf16x8*)(lds + PG8_SB(b, h) + boff + n * 2048 + k * 1024); } while (0)
#define PG8_MMA(ai, bj, At, Bt) do { __builtin_amdgcn_s_setprio(1); _Pragma("unroll") for (int m = 0; m < 4; ++m) _Pragma("unroll") for (int n = 0; n < 2; ++n) _Pragma("unroll") for (int k = 0; k < 2; ++k) \
        acc[ai][bj][m][n] = __builtin_amdgcn_mfma_f32_16x16x32_bf16(Bt[n][k], At[m][k], acc[ai][bj][m][n], 0, 0, 0); __builtin_amdgcn_s_setprio(0); } while (0)
#define PG8_WAIT_V(n) asm volatile("s_waitcnt vmcnt(" #n ")" ::: "memory")
#define PG8_WAIT_L(n) asm volatile("s_waitcnt lgkmcnt(" #n ")" ::: "memory")
#define PG8_BAR __builtin_amdgcn_s_barrier()
#define PG8_SCHED __builtin_amdgcn_sched_barrier(0)
    Unit cur, nxt; int ui = 0;
    if (!S.next(0, cur)) return;
    f32x4 acc[2][2][4][2];
#pragma unroll
    for (int a = 0; a < 2; ++a)
#pragma unroll
        for (int b = 0; b < 2; ++b)
#pragma unroll
            for (int m = 0; m < 4; ++m)
#pragma unroll
                for (int n = 0; n < 2; ++n) acc[a][b][m][n] = (f32x4){0.f, 0.f, 0.f, 0.f};
    bf16x8 At[4][2], B0[2][2], B1[2][2];
    const char* cA = (const char*)g.A + (size_t)cur.pm * tstep; const char* cB = (const char*)g.Bt + (size_t)cur.pn * tstep;
    S.a_ready(cur);
    if constexpr (SP2) {
        PG8_STAGE(PG8_SB(0, 0), cB, voffB); PG8_STAGE(PG8_SB(0, 1), cB + hstep, voffB); PG8_STAGE(PG8_SA(0, 0), cA, voffA); PG8_STAGE(PG8_SA(0, 1), cA + hstep, voffA);
        if (wr == 1) PG8_BAR;
        PG8_WAIT_V(2); PG8_BAR;
        PG8_STAGE(PG8_SB(1, 0), cB + kstep, voffB); PG8_STAGE(PG8_SA(1, 0), cA + kstep, voffA); PG8_STAGE(PG8_SB(1, 1), cB + hstep + kstep, voffB);
        PG8_WAIT_V(6); PG8_BAR;
    } else {
        PG8_STAGE(PG8_SB(0, 0), cB, voffB); PG8_STAGE(PG8_SA(0, 0), cA, voffA); PG8_STAGE(PG8_SB(0, 1), cB + hstep, voffB); PG8_STAGE(PG8_SA(0, 1), cA + hstep, voffA);
        if (wr == 1) PG8_BAR;
        PG8_WAIT_V(4); PG8_BAR;
        PG8_STAGE(PG8_SB(1, 0), cB + kstep, voffB); PG8_STAGE(PG8_SA(1, 0), cA + kstep, voffA); PG8_STAGE(PG8_SB(1, 1), cB + hstep + kstep, voffB);
        PG8_WAIT_V(6); PG8_BAR;
    }
    for (;;) {
        const bool has_next = S.next(ui + 1, nxt);
        const char* nA = has_next ? (const char*)g.A + (size_t)nxt.pm * tstep : cA; const char* nB = has_next ? (const char*)g.Bt + (size_t)nxt.pn * tstep : cB;
        for (int t = 0; t < nt; t += 2) {
            const bool last = (t == nt - 2);
            const char* a1 = cA + (size_t)(t + 1) * kstep;
            const char* a2 = last ? nA : cA + (size_t)(t + 2) * kstep; const char* b2 = last ? nB : cB + (size_t)(t + 2) * kstep;
            const char* a3 = a2 + kstep; const char* b3 = b2 + kstep;
            if (last && has_next) S.a_ready(nxt);
            if constexpr (SP2) {
            PG8_LDB(B0, 0, 0); PG8_LDB(B1, 0, 1); PG8_SCHED; PG8_LDA(At, 0, 0); PG8_STAGE(PG8_SA(1, 1), a1 + hstep, voffA);
            PG8_WAIT_V(8); PG8_WAIT_L(0); PG8_BAR; PG8_MMA(0, 0, At, B0); PG8_MMA(0, 1, At, B1); PG8_BAR; PG8_SCHED;
            PG8_LDA(At, 0, 1); PG8_STAGE(PG8_SB(0, 0), b2, voffB); PG8_STAGE(PG8_SB(0, 1), b2 + hstep, voffB); PG8_STAGE(PG8_SA(0, 0), a2, voffA);
            PG8_WAIT_V(8); PG8_WAIT_L(0); PG8_BAR; PG8_MMA(1, 0, At, B0); PG8_MMA(1, 1, At, B1); PG8_BAR; PG8_SCHED;
            PG8_LDB(B0, 1, 0); PG8_LDB(B1, 1, 1); PG8_SCHED; PG8_LDA(At, 1, 0); PG8_STAGE(PG8_SA(0, 1), a2 + hstep, voffA);
            PG8_WAIT_V(8); PG8_WAIT_L(0); PG8_BAR; PG8_MMA(0, 0, At, B0); PG8_MMA(0, 1, At, B1); PG8_BAR; PG8_SCHED;
            PG8_LDA(At, 1, 1); PG8_STAGE(PG8_SB(1, 0), b3, voffB); PG8_STAGE(PG8_SB(1, 1), b3 + hstep, voffB); PG8_STAGE(PG8_SA(1, 0), a3, voffA);
            PG8_WAIT_V(8); PG8_WAIT_L(0); PG8_BAR; PG8_MMA(1, 0, At, B0); PG8_MMA(1, 1, At, B1); PG8_BAR; PG8_SCHED;
            } else {
            PG8_LDB(B0, 0, 0); PG8_SCHED; PG8_LDA(At, 0, 0); PG8_STAGE(PG8_SA(1, 1), a1 + hstep, voffA);
            PG8_WAIT_L(8); PG8_BAR; PG8_WAIT_L(0); PG8_MMA(0, 0, At, B0); PG8_BAR; PG8_SCHED;
            PG8_LDB(B1, 0, 1); PG8_STAGE(PG8_SB(0, 0), b2, voffB);
            PG8_BAR; PG8_WAIT_L(0); PG8_MMA(0, 1, At, B1); PG8_BAR;
            PG8_LDA(At, 0, 1); PG8_STAGE(PG8_SA(0, 0), a2, voffA);
            PG8_BAR; PG8_WAIT_L(0); PG8_MMA(1, 0, At, B0); PG8_BAR; PG8_SCHED;
            PG8_STAGE(PG8_SB(0, 1), b2 + hstep, voffB);
            PG8_WAIT_V(6); PG8_BAR; PG8_MMA(1, 1, At, B1); PG8_BAR;
            PG8_LDB(B0, 1, 0); PG8_SCHED; PG8_LDA(At, 1, 0); PG8_STAGE(PG8_SA(0, 1), a2 + hstep, voffA);
            PG8_WAIT_L(8); PG8_BAR; PG8_WAIT_L(0); PG8_MMA(0, 0, At, B0); PG8_BAR; PG8_SCHED;
            PG8_LDB(B1, 1, 1); PG8_STAGE(PG8_SB(1, 0), b3, voffB);
            PG8_BAR; PG8_WAIT_L(0); PG8_MMA(0, 1, At, B1); PG8_BAR;
            PG8_LDA(At, 1, 1); PG8_STAGE(PG8_SA(1, 0), a3, voffA);
            PG8_BAR; PG8_WAIT_L(0); PG8_MMA(1, 0, At, B0); PG8_BAR; PG8_SCHED;
            PG8_STAGE(PG8_SB(1, 1), b3 + hstep, voffB);
            PG8_WAIT_V(6); PG8_BAR; PG8_MMA(1, 1, At, B1); PG8_BAR;
            }
        }
        if constexpr (ALIGN_EPI) { if (wr == 0) PG8_BAR; }
        if constexpr (!Epi::AFTER_DRAIN) { E(acc, cur, wr, wc, fr, fq); S.done(cur); }
        if (!has_next) break;
#pragma unroll
        for (int a = 0; a < 2; ++a)
#pragma unroll
            for (int b = 0; b < 2; ++b)
#pragma unroll
                for (int m = 0; m < 4; ++m)
#pragma unroll
                    for (int n = 0; n < 2; ++n) acc[a][b][m][n] = (f32x4){0.f, 0.f, 0.f, 0.f};
        cur = nxt; cA = nA; cB = nB; ++ui;
        if constexpr (ALIGN_EPI) { if (wr == 1) PG8_BAR; }
    }
    PG8_WAIT_V(0);
    if constexpr (!ALIGN_EPI) { if (wr == 0) PG8_BAR; }
    PG8_BAR;
    if constexpr (Epi::AFTER_DRAIN) { E.fused(acc, cur, wr, wc, fr, fq, lds, wid, lane); S.done(cur); }
#undef PG8_SA
#undef PG8_SB
#undef PG8_STAGE
#undef PG8_LDA
#undef PG8_LDB
#undef PG8_MMA
#undef PG8_WAIT_V
#undef PG8_WAIT_L
#undef PG8_BAR
#undef PG8_SCHED
}
}

namespace pg8 {
__device__ __forceinline__ float gelu_tanh(float x) {
    const float t = x * (1.5957691216057308f + 0.07135481627f * x * x);
    const float e = __builtin_amdgcn_exp2f(-1.4426950408889634f * t);
    return x * __builtin_amdgcn_rcpf(1.0f + e);
}
template <int ACT> struct EpiT {
    static constexpr bool PERM = true, AFTER_DRAIN = false;
    bf16_t* O; int ldc;
    __device__ __forceinline__ void operator()(const f32x4 (&acc)[2][2][4][2], const Unit& u, int wr, int wc, int fr, int fq) const {
        const int row0 = u.pm * BM + wr * 64 + fr; const int col0 = u.pn * BM + wc * 32 + 8 * fq;
#pragma unroll
        for (int ai = 0; ai < 2; ++ai)
#pragma unroll
            for (int m = 0; m < 4; ++m) { bf16_t* rowp = O + (size_t)(row0 + ai * HALF + m * 16) * ldc + col0;
#pragma unroll
                for (int bj = 0; bj < 2; ++bj) { f32x4 v0 = acc[ai][bj][m][0], v1 = acc[ai][bj][m][1];
                    if (ACT == 2) { v0 = (f32x4){gelu_tanh(v0[0]), gelu_tanh(v0[1]), gelu_tanh(v0[2]), gelu_tanh(v0[3])}; v1 = (f32x4){gelu_tanh(v1[0]), gelu_tanh(v1[1]), gelu_tanh(v1[2]), gelu_tanh(v1[3])}; }
                    u32x4 w; w.x = cvt_pk_bf16(v0[0], v0[1]); w.y = cvt_pk_bf16(v0[2], v0[3]); w.z = cvt_pk_bf16(v1[0], v1[1]); w.w = cvt_pk_bf16(v1[2], v1[3]);
                    *(u32x4*)(rowp + bj * HALF) = w; } }
    }
};
struct EpiR {
    static constexpr bool PERM = true, AFTER_DRAIN = false;
    bf16_t* O; int ldc; int act; int rope; const float* ropet;
    __device__ __forceinline__ void operator()(const f32x4 (&acc)[2][2][4][2], const Unit& u, int wr, int wc, int fr, int fq) const {
        const int row0 = u.pm * BM + wr * 64 + fr; const int col0 = u.pn * BM + wc * 32 + 8 * fq;
        const bool rrows = rope != 0 && u.pm < 64;
#pragma unroll
        for (int ai = 0; ai < 2; ++ai)
#pragma unroll
            for (int m = 0; m < 4; ++m) { const int grow = row0 + ai * HALF + m * 16; bf16_t* rowp = O + (size_t)grow * ldc + col0;
#pragma unroll
                for (int bj = 0; bj < 2; ++bj) { f32x4 v0 = acc[ai][bj][m][0], v1 = acc[ai][bj][m][1];
                    if (act) { v0 = (f32x4){gelu_tanh(v0[0]), gelu_tanh(v0[1]), gelu_tanh(v0[2]), gelu_tanh(v0[3])}; v1 = (f32x4){gelu_tanh(v1[0]), gelu_tanh(v1[1]), gelu_tanh(v1[2]), gelu_tanh(v1[3])}; }
                    if (rrows) { const int blk = u.pn * 8 + bj * 4 + wc; const int b6 = blk % 6; const bool on = rope == 1 ? (blk < 128) : (b6 >= 4); const int half = rope == 1 ? (blk & 1) : (b6 - 4);
                        if (on) { const int t = grow & 8191; const int pos = half ? (t & 63) : (t >> 6);
                            const float* cp = ropet + pos * 16 + 8 * (fq & 1); const f32x4 c0 = *(const f32x4*)cp, c1 = *(const f32x4*)(cp + 4), s0 = *(const f32x4*)(cp + 2048), s1 = *(const f32x4*)(cp + 2052);
                            f32x4 p0, p1;
#pragma unroll
                            for (int i = 0; i < 4; ++i) { const float a_ = v0[i], b_ = v1[i];
                                const auto r0 = __builtin_amdgcn_permlane32_swap(__float_as_uint(a_), __float_as_uint(a_), false, false);
                                const auto r1 = __builtin_amdgcn_permlane32_swap(__float_as_uint(b_), __float_as_uint(b_), false, false);
                                const unsigned x0_ = (fq & 2) ? r0[0] : r0[1], x1_ = (fq & 2) ? r1[0] : r1[1]; p0[i] = __uint_as_float(x0_); p1[i] = __uint_as_float(x1_); }
                            if (fq & 2) { v0 = p0 * s0 + v0 * c0; v1 = p1 * s1 + v1 * c1; } else { v0 = v0 * c0 - p0 * s0; v1 = v1 * c1 - p1 * s1; } } }
                    u32x4 w; w.x = cvt_pk_bf16(v0[0], v0[1]); w.y = cvt_pk_bf16(v0[2], v0[3]); w.z = cvt_pk_bf16(v1[0], v1[1]); w.w = cvt_pk_bf16(v1[2], v1[3]);
                    *(u32x4*)(rowp + bj * HALF) = w; } }
    }
};
}

constexpr int DM = 2048, NBATCH = 2, SEQ = 8192, CTXL = 256;
constexpr int ML = NBATCH * SEQ;
constexpr int MC = NBATCH * CTXL;
constexpr int MT = ML + MC;
constexpr int NLAYER = 4;
constexpr float ALPHA = 1.6817928305074290f, LN_EPS = 1e-6f;
constexpr int NWAVES = 8;
constexpr float U_SCALE = 64.0f, V_SCALE = 4.0f;
constexpr int PROW = 1536;
constexpr int NPH = 35;

constexpr size_t MiB = 1ull << 20;
constexpr size_t WS_CTL = 0, CTL_ZERO_BYTES = 1 * MiB;
constexpr int    CW_BAR = 4096;
constexpr size_t WS_MOD = 128 * 1024;
constexpr size_t WS_VST = 1 * MiB;
constexpr size_t WS_ROPE = 1 * MiB + 160 * 1024;
constexpr size_t WS_MODP = 1 * MiB + 256 * 1024;
constexpr size_t WS_GMWIN = 6 * MiB;
constexpr size_t WS_GMWOUT = WS_GMWIN + 32 * MiB;
constexpr size_t WS_GMWS = WS_GMWOUT + 16 * MiB;
constexpr size_t WS_PWQ = WS_GMWS + 1 * MiB;
constexpr size_t WS_PK1 = WS_PWQ + 32 * MiB;
constexpr size_t WS_PK2 = WS_PK1 + 512 * 1024;
constexpr size_t WS_MLAIN = WS_PK1 + 1 * MiB;
constexpr size_t WS_MLAUQ = WS_MLAIN + 5 * MiB;
constexpr size_t WS_MLAUKV = WS_MLAUQ + 3 * MiB;
constexpr size_t WS_MLAOUT = WS_MLAUKV + 4 * MiB;
constexpr size_t WS_DAIN = WS_MLAOUT + 8 * MiB;
constexpr size_t WS_DAOUT = WS_DAIN + 24 * MiB;
constexpr size_t WS_PU = WS_DAOUT + 8 * MiB;
constexpr size_t WS_PV = WS_PU + 96 * MiB;
constexpr size_t WS_X = WS_PV + 96 * MiB;
constexpr size_t WS_H = WS_X + 66 * MiB;
constexpr size_t WS_G = WS_H + 66 * MiB;
constexpr size_t WS_Y = WS_G + 66 * MiB;
constexpr size_t WS_QP = WS_Y + 66 * MiB;
constexpr size_t WS_Z = WS_QP + 66 * MiB;
constexpr size_t WS_C = WS_Z + 198 * MiB;
constexpr size_t WS_CQN = WS_C + 42 * MiB;
constexpr size_t WS_CKVN = WS_CQN + 17 * MiB;
constexpr size_t WS_KR = WS_CKVN + 17 * MiB;
constexpr size_t WS_QM = WS_KR + 3 * MiB;
constexpr size_t WS_KV = WS_QM + 99 * MiB;
constexpr size_t WS_ROUTE = WS_KV + 132 * MiB;
constexpr size_t WS_END = WS_ROUTE + 17 * MiB;
static_assert((size_t)MT * DM * 2 == 66 * MiB, "row buffer size");

constexpr int RING_BYTES = 155648, MISC_OFF = RING_BYTES + 320, LDS_BYTES = 159744;

#define GAS __attribute__((address_space(1)))
#define LAS __attribute__((address_space(3)))
typedef unsigned short bf16;
typedef unsigned u32x4 __attribute__((ext_vector_type(4)));
typedef unsigned u32x2 __attribute__((ext_vector_type(2)));
typedef float f32x4 __attribute__((ext_vector_type(4)));
typedef float f32x16 __attribute__((ext_vector_type(16)));
typedef short bf16x8 __attribute__((ext_vector_type(8)));
typedef short s16x4 __attribute__((ext_vector_type(4)));
#define LDS_WAIT() asm volatile("s_waitcnt lgkmcnt(0)" ::: "memory")

__device__ __forceinline__ unsigned cvtpk(float lo, float hi) { unsigned r; asm("v_cvt_pk_bf16_f32 %0, %1, %2" : "=v"(r) : "v"(lo), "v"(hi)); return r; }
__device__ __forceinline__ float bflo(unsigned w) { return __uint_as_float(w << 16); }
__device__ __forceinline__ float bfhi(unsigned w) { return __uint_as_float(w & 0xffff0000u); }
__device__ __forceinline__ float bf1(bf16 b) { return __uint_as_float((unsigned)b << 16); }
__device__ __forceinline__ bf16 tobf1(float f) { return (bf16)(cvtpk(f, 0.f) & 0xffffu); }
#define DPP_F(v, ctrl) __int_as_float(__builtin_amdgcn_mov_dpp(__float_as_int(v), (ctrl), 0xF, 0xF, true))
__device__ __forceinline__ float row_sum16(float v) { v += DPP_F(v, 0xB1); v += DPP_F(v, 0x4E); v += DPP_F(v, 0x141); v += DPP_F(v, 0x140); return v; }
__device__ __forceinline__ float sum_xor16(float v) { const auto r = __builtin_amdgcn_permlane16_swap(__float_as_uint(v), __float_as_uint(v), false, false); return __uint_as_float(r[0]) + __uint_as_float(r[1]); }
__device__ __forceinline__ float sum_xor32(float v) { const auto r = __builtin_amdgcn_permlane32_swap(__float_as_uint(v), __float_as_uint(v), false, false); return __uint_as_float(r[0]) + __uint_as_float(r[1]); }
__device__ __forceinline__ float wave_sum(float v) { return sum_xor32(sum_xor16(row_sum16(v))); }
__device__ __forceinline__ float half_sum32(float v) { return sum_xor16(row_sum16(v)); }
__device__ __forceinline__ float lane_xor16(float v, int lane) { const auto r = __builtin_amdgcn_permlane16_swap(__float_as_uint(v), __float_as_uint(v), false, false); return __uint_as_float((lane & 16) ? r[0] : r[1]); }
__device__ __forceinline__ unsigned lane_xor32(unsigned v, int lane) { const auto r = __builtin_amdgcn_permlane32_swap(v, v, false, false); return (lane & 32) ? r[0] : r[1]; }
__device__ __forceinline__ float gelu_tanh(float x) { return pg8::gelu_tanh(x); }

__device__ __forceinline__ void load_row_bf16(const bf16* row, int lane, float (&v)[32]) {
#pragma unroll
    for (int j = 0; j < 4; ++j) { const u32x4 w = ((const u32x4*)row)[64 * j + lane];
        v[8 * j + 0] = bflo(w.x); v[8 * j + 1] = bfhi(w.x); v[8 * j + 2] = bflo(w.y); v[8 * j + 3] = bfhi(w.y);
        v[8 * j + 4] = bflo(w.z); v[8 * j + 5] = bfhi(w.z); v[8 * j + 6] = bflo(w.w); v[8 * j + 7] = bfhi(w.w); }
}
__device__ __forceinline__ void store_row_bf16(bf16* row, int lane, const float (&v)[32]) {
#pragma unroll
    for (int j = 0; j < 4; ++j) { u32x4 w; w.x = cvtpk(v[8 * j + 0], v[8 * j + 1]); w.y = cvtpk(v[8 * j + 2], v[8 * j + 3]); w.z = cvtpk(v[8 * j + 4], v[8 * j + 5]); w.w = cvtpk(v[8 * j + 6], v[8 * j + 7]);
        ((u32x4*)row)[64 * j + lane] = w; }
}
__device__ __forceinline__ void load_row_f32(const float* row, int lane, float (&v)[32]) {
#pragma unroll
    for (int j = 0; j < 4; ++j) { const f32x4 a = ((const f32x4*)row)[128 * j + 2 * lane], b = ((const f32x4*)row)[128 * j + 2 * lane + 1];
        v[8 * j + 0] = a.x; v[8 * j + 1] = a.y; v[8 * j + 2] = a.z; v[8 * j + 3] = a.w; v[8 * j + 4] = b.x; v[8 * j + 5] = b.y; v[8 * j + 6] = b.z; v[8 * j + 7] = b.w; }
}
__device__ __forceinline__ void store_row_f32(float* row, int lane, const float (&v)[32]) {
#pragma unroll
    for (int j = 0; j < 4; ++j) { ((f32x4*)row)[128 * j + 2 * lane] = (f32x4){v[8 * j + 0], v[8 * j + 1], v[8 * j + 2], v[8 * j + 3]};
        ((f32x4*)row)[128 * j + 2 * lane + 1] = (f32x4){v[8 * j + 4], v[8 * j + 5], v[8 * j + 6], v[8 * j + 7]}; }
}
__device__ __forceinline__ void load_row_bf16_b(const bf16* row, int lane, float (&v)[32]) {
#pragma unroll
    for (int j = 0; j < 4; ++j) { const u32x4 w = ((const u32x4*)row)[4 * lane + j];
        v[8 * j + 0] = bflo(w.x); v[8 * j + 1] = bfhi(w.x); v[8 * j + 2] = bflo(w.y); v[8 * j + 3] = bfhi(w.y);
        v[8 * j + 4] = bflo(w.z); v[8 * j + 5] = bfhi(w.z); v[8 * j + 6] = bflo(w.w); v[8 * j + 7] = bfhi(w.w); }
}
__device__ __forceinline__ void store_row_bf16_b(bf16* row, int lane, const float (&v)[32]) {
#pragma unroll
    for (int j = 0; j < 4; ++j) { u32x4 w; w.x = cvtpk(v[8 * j + 0], v[8 * j + 1]); w.y = cvtpk(v[8 * j + 2], v[8 * j + 3]); w.z = cvtpk(v[8 * j + 4], v[8 * j + 5]); w.w = cvtpk(v[8 * j + 6], v[8 * j + 7]);
        ((u32x4*)row)[4 * lane + j] = w; }
}
__device__ __forceinline__ void load_row_f32_b(const float* row, int lane, float (&v)[32]) {
#pragma unroll
    for (int q = 0; q < 8; ++q) { const f32x4 a = ((const f32x4*)row)[8 * lane + q];
        v[4 * q + 0] = a.x; v[4 * q + 1] = a.y; v[4 * q + 2] = a.z; v[4 * q + 3] = a.w; }
}
__device__ __forceinline__ void store_row_f32_b(float* row, int lane, const float (&v)[32]) {
#pragma unroll
    for (int q = 0; q < 8; ++q) ((f32x4*)row)[8 * lane + q] = (f32x4){v[4 * q + 0], v[4 * q + 1], v[4 * q + 2], v[4 * q + 3]};
}
__device__ __forceinline__ void ln_stats(const float (&v)[32], float& mean, float& rstd) {
    float s = 0.f;
#pragma unroll
    for (int i = 0; i < 32; ++i) s += v[i];
    mean = wave_sum(s) * (1.0f / DM);
    float q = 0.f;
#pragma unroll
    for (int i = 0; i < 32; ++i) { const float d = v[i] - mean; q += d * d; }
    rstd = 1.0f / sqrtf(wave_sum(q) * (1.0f / DM) + LN_EPS);
}
template <bool LAYB>
__device__ __forceinline__ void finish_row(float (&z)[32], const float* lng, const float* lnb, bf16* Xrow, const float* sh, const float* sc, bf16* Hrow, float* Orow, int lane) {
    float mean, rstd; ln_stats(z, mean, rstd);
    { float g[32], b[32]; if (LAYB) { load_row_f32_b(lng, lane, g); load_row_f32_b(lnb, lane, b); } else { load_row_f32(lng, lane, g); load_row_f32(lnb, lane, b); }
#pragma unroll
      for (int i = 0; i < 32; ++i) z[i] = (z[i] - mean) * rstd * g[i] + b[i]; }
    if (Xrow) { if (LAYB) store_row_bf16_b(Xrow, lane, z); else store_row_bf16(Xrow, lane, z); }
    if (Orow) { if (LAYB) store_row_f32_b(Orow, lane, z); else store_row_f32(Orow, lane, z); }
    if (Hrow) {
        ln_stats(z, mean, rstd);
        float a[32], s[32]; if (LAYB) { load_row_f32_b(sc, lane, a); load_row_f32_b(sh, lane, s); } else { load_row_f32(sc, lane, a); load_row_f32(sh, lane, s); }
#pragma unroll
        for (int i = 0; i < 32; ++i) a[i] = (z[i] - mean) * rstd * (1.0f + a[i]) + s[i];
        if (LAYB) store_row_bf16_b(Hrow, lane, a); else store_row_bf16(Hrow, lane, a);
    }
}
__device__ __forceinline__ int row_slot(int row) { return row < ML ? (row >> 13) : 2; }

__device__ __forceinline__ unsigned f2bf_rne(float f) { unsigned u = __float_as_uint(f); return (u + 0x7fffu + ((u >> 16) & 1u)) >> 16; }
__device__ __forceinline__ unsigned pk2(float lo, float hi) { return f2bf_rne(lo) | (f2bf_rne(hi) << 16); }
__device__ __forceinline__ void p0_transpose_item(const float* W, int K, int N, bf16* WT, LAS float* scr, int item, int lane) {
    const int nblk = N / 32, kb = item / nblk, nb = item % nblk, k0 = 64 * kb, n0 = 32 * nb;
    f32x4 t[8];
#pragma unroll
    for (int i = 0; i < 8; ++i) t[i] = *(const f32x4*)(W + (size_t)(k0 + 8 * i + (lane >> 3)) * N + n0 + 4 * (lane & 7));
#pragma unroll
    for (int i = 0; i < 8; ++i) { LAS float* d = scr + (8 * i + (lane >> 3)) * 33 + 4 * (lane & 7); d[0] = t[i].x; d[1] = t[i].y; d[2] = t[i].z; d[3] = t[i].w; }
    LDS_WAIT(); asm volatile("" ::: "memory");
    const int c = lane & 7;
#pragma unroll
    for (int j = 0; j < 4; ++j) { const int n = (lane >> 3) + 8 * j; const LAS float* s = scr + (8 * c) * 33 + n;
        u32x4 o; o.x = pk2(s[0 * 33], s[1 * 33]); o.y = pk2(s[2 * 33], s[3 * 33]); o.z = pk2(s[4 * 33], s[5 * 33]); o.w = pk2(s[6 * 33], s[7 * 33]);
        *(u32x4*)(WT + (size_t)(n0 + n) * K + k0 + 8 * c) = o; }
    LDS_WAIT(); asm volatile("" ::: "memory");
}
__device__ __forceinline__ void cvt_range(const float* src, bf16* dst, size_t n8, size_t gtid, size_t gthreads) {
#pragma unroll 4
    for (size_t i = gtid; i < n8; i += gthreads) { const f32x4 a = ((const f32x4*)src)[2 * i], b = ((const f32x4*)src)[2 * i + 1];
        u32x4 w; w.x = cvtpk(a.x, a.y); w.y = cvtpk(a.z, a.w); w.z = cvtpk(b.x, b.y); w.w = cvtpk(b.z, b.w); ((u32x4*)dst)[i] = w; }
}
__device__ __forceinline__ unsigned enc_e2m3(float x) {
    const unsigned sgn = (__float_as_uint(x) >> 26) & 32u;
    const float ax = fminf(fabsf(x), 7.5f);
    unsigned u = __float_as_uint(ax); u += 0x7FFFFu + ((u >> 20) & 1u);
    const unsigned cn = (u >> 20) - ((127u - 1u) << 3);
    const unsigned cs = (unsigned)__builtin_rintf(ax * 8.0f);
    return sgn | (ax < 1.0f ? cs : cn);
}
typedef float f32x16v __attribute__((ext_vector_type(16)));
typedef float f32x32v __attribute__((ext_vector_type(32)));
typedef unsigned u32x6v __attribute__((ext_vector_type(6)));
__device__ __forceinline__ u32x6v pack_fp6_32(const float (&e)[32], bool interleaved) {
    f32x16v s0, s1;
    if (interleaved) {
#pragma unroll
        for (int i = 0; i < 16; ++i) { s0[i] = e[2 * i]; s1[i] = e[2 * i + 1]; }
    } else {
#pragma unroll
        for (int i = 0; i < 16; ++i) { s0[i] = e[i]; s1[i] = e[16 + i]; }
    }
    return __builtin_amdgcn_cvt_scalef32_2xpk16_fp6_f32(s0, s1, 1.0f);
}
__device__ __forceinline__ void cvt_table_fp6(const float* src, unsigned char* dst, int nrows, float scale, LAS float* scr  , int lane, int gw, int NGW) {
    bool interleaved;
    {
        float t[32];
#pragma unroll
        for (int k = 0; k < 32; ++k) t[k] = k < 16 ? 0.125f * k : (k < 24 ? 2.0f + 0.25f * (k - 16) : 4.0f + 0.5f * (k - 24));
        float tt[32];
#pragma unroll
        for (int k = 0; k < 32; ++k) { tt[k] = t[k]; asm volatile("" : "+v"(tt[k])); }
        const u32x6v p = pack_fp6_32(tt, true);
        const f32x32v o = __builtin_amdgcn_cvt_scalef32_pk32_f32_fp6(p, 1.0f);
        interleaved = (o[1] == t[1]) && (o[2] == t[2]) && (o[17] == t[17]);
        interleaved = __all(interleaved);
    }
    for (int row = gw; row < nrows; row += NGW) {
        const f32x4* s4 = (const f32x4*)(src + (size_t)row * 2048);
#pragma unroll
        for (int q = 0; q < 8; ++q) { const int s = 64 * q + lane; const f32x4 a = s4[s] * scale; *(LAS f32x4*)(scr + 4 * (s ^ ((s >> 4) & 7))) = a; }
        float e[32];
#pragma unroll
        for (int j = 0; j < 8; ++j) { const int s = 8 * lane + j; const f32x4 a = *(const LAS f32x4*)(scr + 4 * (s ^ ((s >> 4) & 7)));
            e[4 * j + 0] = __builtin_amdgcn_fmed3f(a.x, -7.5f, 7.5f); e[4 * j + 1] = __builtin_amdgcn_fmed3f(a.y, -7.5f, 7.5f); e[4 * j + 2] = __builtin_amdgcn_fmed3f(a.z, -7.5f, 7.5f); e[4 * j + 3] = __builtin_amdgcn_fmed3f(a.w, -7.5f, 7.5f); }
        const u32x6v p = pack_fp6_32(e, interleaved);
        unsigned char* rowp = dst + (size_t)row * PROW;
        *(u32x4*)(rowp + 16 * lane) = (u32x4){p[0], p[1], p[2], p[3]}; *(u32x2*)(rowp + 1024 + 8 * lane) = (u32x2){p[4], p[5]};
    }
}
__device__ __forceinline__ float silu(float x) { return x / (1.0f + __expf(-x)); }

struct Params { const float* in[29]; float* out; unsigned char* ws; int ph_lo, ph_hi; };
typedef const __attribute__((address_space(4))) Params* CP;

__device__ __forceinline__ void p0_prologue(CP P, LAS unsigned char* lds, int tid, int lane, int wid, int gw, int NGW) {
    unsigned char* ws = P->ws;
    LAS float* scr = (LAS float*)(lds + wid * 16384);
    {
        constexpr int I_GMIN = (2048 / 64) * (4096 / 32), I_SQ = (2048 / 64) * (2048 / 32), I_MIN = (2048 / 64) * (1088 / 32), I_UQ = (512 / 64) * (3072 / 32), I_UKV = (512 / 64) * (4096 / 32), I_DIN = (2048 / 64) * (6144 / 32);
        constexpr int NIT = 2 * I_GMIN + 2 * I_SQ + 4 * I_SQ + I_MIN + I_UQ + I_UKV + I_SQ + I_DIN + I_SQ;
        for (int it = gw; it < NIT; it += NGW) {
            int r = it;
            if (r < 2 * I_GMIN) { const int j = r / I_GMIN; p0_transpose_item(P->in[13] + (size_t)j * 2048 * 4096, 2048, 4096, (bf16*)(ws + WS_GMWIN) + (size_t)j * 4096 * 2048, scr, r % I_GMIN, lane); continue; } r -= 2 * I_GMIN;
            if (r < 2 * I_SQ) { const int j = r / I_SQ; p0_transpose_item(P->in[18] + (size_t)j * 2048 * 2048, 2048, 2048, (bf16*)(ws + WS_GMWOUT) + (size_t)j * 2048 * 2048, scr, r % I_SQ, lane); continue; } r -= 2 * I_SQ;
            if (r < 4 * I_SQ) { const int j = r / I_SQ; p0_transpose_item(P->in[8] + (size_t)j * 2048 * 2048, 2048, 2048, (bf16*)(ws + WS_PWQ) + (size_t)j * 2048 * 2048, scr, r % I_SQ, lane); continue; } r -= 4 * I_SQ;
            if (r < I_MIN) { p0_transpose_item(P->in[19], 2048, 1088, (bf16*)(ws + WS_MLAIN), scr, r, lane); continue; } r -= I_MIN;
            if (r < I_UQ) { p0_transpose_item(P->in[22], 512, 3072, (bf16*)(ws + WS_MLAUQ), scr, r, lane); continue; } r -= I_UQ;
            if (r < I_UKV) { p0_transpose_item(P->in[23], 512, 4096, (bf16*)(ws + WS_MLAUKV), scr, r, lane); continue; } r -= I_UKV;
            if (r < I_SQ) { p0_transpose_item(P->in[24], 2048, 2048, (bf16*)(ws + WS_MLAOUT), scr, r, lane); continue; } r -= I_SQ;
            if (r < I_DIN) { p0_transpose_item(P->in[25], 2048, 6144, (bf16*)(ws + WS_DAIN), scr, r, lane); continue; } r -= I_DIN;
            p0_transpose_item(P->in[28], 2048, 2048, (bf16*)(ws + WS_DAOUT), scr, r, lane);
        }
    }
    const size_t gtid = (size_t)gw * 64 + lane, gthreads = (size_t)NGW * 64;
    { u32x4* z = (u32x4*)((bf16*)(ws + WS_MLAIN) + (size_t)1088 * 2048); const size_t n = (size_t)192 * 2048 / 8;
      for (size_t i = gtid; i < n; i += gthreads) z[i] = (u32x4){0u, 0u, 0u, 0u}; }
    cvt_range(P->in[16], (bf16*)(ws + WS_GMWS), (size_t)2 * 16 * 128 * 128 / 8, gtid, gthreads);
    cvt_range(P->in[9], (bf16*)(ws + WS_PK1), (size_t)4 * 128 * 128 / 8, gtid, gthreads);
    cvt_range(P->in[10], (bf16*)(ws + WS_PK2), (size_t)4 * 128 * 128 / 8, gtid, gthreads);
    cvt_table_fp6(P->in[11], ws + WS_PU, 16384, U_SCALE, scr, lane, gw, NGW);
    cvt_table_fp6(P->in[12], ws + WS_PV, 16384, V_SCALE, scr, lane, gw, NGW);
    if (gtid < 2048) { const int pos = (int)gtid >> 4, f = (int)gtid & 15; const float inv = powf(10000.0f, -(float)f * (1.0f / 16.0f)); float sn, cs; sincosf((float)pos * inv, &sn, &cs);
        float* rt = (float*)(ws + WS_ROPE); rt[gtid] = cs; rt[2048 + gtid] = sn; }
    {
        const float* cv = P->in[1]; const float* cc = P->in[3]; const float* mw = P->in[4]; float* PART = (float*)(ws + WS_MODP);
        for (int item = gw; item < 4 * 192 * 8; item += NGW) {
            const int ks = item & 7, r = item >> 3, L = r / 192, n = (r % 192) * 64 + lane;
            const float* W = mw + (size_t)L * 2048 * 12288 + (size_t)(ks * 256) * 12288 + n;
            float a0 = 0.f, a1 = 0.f, a2 = 0.f;
#pragma unroll 32
            for (int k = 0; k < 256; ++k) { const int kk = ks * 256 + k; const float s0 = silu(cv[kk]), s1 = silu(cv[2048 + kk]), s2 = silu(cc[kk]);
                const float w = W[(size_t)k * 12288]; a0 += s0 * w; a1 += s1 * w; a2 += s2 * w; }
            float* o = PART + ((size_t)ks * 4 + L) * 3 * 12288 + n;
            o[0] = a0; o[12288] = a1; o[24576] = a2;
        }
    }
}
__device__ __forceinline__ void mod_reduce(CP P, int gw, int lane, int NGW) {
    const float* PART = (const float*)(P->ws + WS_MODP); float* MOD = (float*)(P->ws + WS_MOD); const float* mb = P->in[5];
    for (int i = gw * 64 + lane; i < 4 * 3 * 12288; i += NGW * 64) {
        const int L = i / (3 * 12288), n = i % 12288;
        float s = mb[(size_t)L * 12288 + n];
#pragma unroll
        for (int ks = 0; ks < 8; ++ks) s += PART[(size_t)ks * 4 * 3 * 12288 + i];
        MOD[i] = s;
    }
}

__device__ __forceinline__ void first_row_pass(CP P, int lane, int gw, int NGW) {
    const float* MOD = (const float*)(P->ws + WS_MOD); bf16* X = (bf16*)(P->ws + WS_X); bf16* H = (bf16*)(P->ws + WS_H);
    for (int row = gw; row < MT; row += NGW) {
        const float* src = row < ML ? P->in[0] + (size_t)row * DM : P->in[2] + (size_t)(row - ML) * DM;
        float v[32]; load_row_f32(src, lane, v);
        store_row_bf16(X + (size_t)row * DM, lane, v);
        const float* mod = MOD + (size_t)row_slot(row) * 12288;
        float mean, rstd; ln_stats(v, mean, rstd);
        float a[32], s[32]; load_row_f32(mod + 2048, lane, a); load_row_f32(mod, lane, s);
#pragma unroll
        for (int i = 0; i < 32; ++i) a[i] = (v[i] - mean) * rstd * (1.0f + a[i]) + s[i];
        store_row_bf16(H + (size_t)row * DM, lane, a);
    }
}
__device__ __forceinline__ void post_mixer_pass(CP P, int L, int Mrows, int lane, int gw, int NGW) {
    const float* MOD = (const float*)(P->ws + WS_MOD); bf16* X = (bf16*)(P->ws + WS_X); bf16* H = (bf16*)(P->ws + WS_H); const bf16* Y = (const bf16*)(P->ws + WS_Y);
    const float* lng = P->in[6] + (size_t)(L * 2 + 0) * DM; const float* lnb = P->in[7] + (size_t)(L * 2 + 0) * DM;
    for (int row = gw; row < Mrows; row += NGW) {
        const float* mod = MOD + (size_t)(L * 3 + row_slot(row)) * 12288;
        float z[32], y[32], g[32]; load_row_bf16(X + (size_t)row * DM, lane, z); load_row_bf16(Y + (size_t)row * DM, lane, y); load_row_f32(mod + 2 * 2048, lane, g);
#pragma unroll
        for (int i = 0; i < 32; ++i) z[i] = ALPHA * z[i] + g[i] * y[i];
        finish_row<false>(z, lng, lnb, X + (size_t)row * DM, mod + 3 * 2048, mod + 4 * 2048, H + (size_t)row * DM, nullptr, lane);
    }
}
__device__ __forceinline__ void vstats_pass(CP P, int Mrows, int lane, int gw, int NGW) {
    const bf16* Z = (const bf16*)(P->ws + WS_Z); float* VST = (float*)(P->ws + WS_VST);
    for (int row = gw; row < Mrows; row += NGW) {
        float v[32]; load_row_bf16(Z + (size_t)row * 4096 + 2048, lane, v);
        float mean, rstd; ln_stats(v, mean, rstd);
        if (lane == 0) { VST[2 * row] = mean; VST[2 * row + 1] = rstd; }
    }
}
#define XB_TMO      128
#define XB_XCNT(j)  (256  + 64 * (j))
#define XB_XSUB(j)  (1280 + 64 * (j))
#define XB_XGEN(j)  (2304 + 64 * (j))
#define XB_TOP      3328
#define XB_TOPGEN   3392
#define XCD_BAR_WORDS 3456
#define XB_SPIN_CAP (1u << 18)

__device__ __forceinline__ unsigned xb_ld(unsigned* p)              { return __hip_atomic_load(p, __ATOMIC_RELAXED, __HIP_MEMORY_SCOPE_AGENT); }
__device__ __forceinline__ unsigned xb_add(unsigned* p, unsigned v) { return __hip_atomic_fetch_add(p, v, __ATOMIC_RELAXED, __HIP_MEMORY_SCOPE_AGENT); }
__device__ __forceinline__ unsigned xb_xcc_id() { return (unsigned)__builtin_amdgcn_s_getreg((3 << 11) | 20) & 0xFu; }
#define XB_SPIN(cond, bar) do { unsigned _sp = 0; while (cond) { __builtin_amdgcn_s_sleep(1); \
    if ((++_sp & 255u) == 0u) { if (xb_ld(&(bar)[XB_TMO])) break; if (_sp > XB_SPIN_CAP) { atomicAdd(&(bar)[XB_TMO], 1u); break; } } } } while (0)

struct XcdBarrier {
    unsigned* bar; unsigned x;
    volatile LAS unsigned* st;
};

__device__ __forceinline__ XcdBarrier xcd_barrier_post(unsigned* bar, volatile LAS unsigned* st, const bool t0) {
    XcdBarrier b; b.bar = bar; b.x = xb_xcc_id(); b.st = st;
    if (t0) (void)xb_add(&bar[XB_XCNT(b.x)], 1u);
    return b;
}
__device__ __forceinline__ void xcd_barrier_complete(unsigned* bar, unsigned x, unsigned& nloc, unsigned& nx) {
    const unsigned G = gridDim.x * gridDim.y * gridDim.z;
    unsigned sum, cnt, mine, sp = 0u;
    for (;;) {
        sum = 0u; cnt = 0u; mine = 0u;
#pragma unroll
        for (unsigned j = 0; j < 16; ++j) { const unsigned c = xb_ld(&bar[XB_XCNT(j)]); sum += c; cnt += (c > 0u) ? 1u : 0u; mine = (j == x) ? c : mine; }
        if (sum == G) break;
        __builtin_amdgcn_s_sleep(1);
        if ((++sp & 255u) == 0u) { if (xb_ld(&bar[XB_TMO])) break; if (sp > XB_SPIN_CAP) { atomicAdd(&bar[XB_TMO], 1u); break; } }
    }
    nloc = mine > 0u ? mine : 1u; nx = cnt > 0u ? cnt : 1u;
}

__device__ __attribute__((noinline)) void xcd_barrier(const XcdBarrier b, const bool t0) {
    asm volatile("s_waitcnt vmcnt(0)" ::: "memory");
    __syncthreads();
    if (t0) {
        unsigned* bar = b.bar;
        __builtin_amdgcn_s_waitcnt(0);
        unsigned nloc = b.st[0], nx = b.st[1];
        if (nloc == 0u) { xcd_barrier_complete(bar, b.x, nloc, nx); b.st[0] = nloc; b.st[1] = nx; }
        const unsigned old = xb_add(&bar[XB_XSUB(b.x)], 1u);
        const unsigned gen = old / nloc;
        if (old + 1u == (gen + 1u) * nloc) {
            __builtin_amdgcn_fence(__ATOMIC_RELEASE, "agent");
            asm volatile("s_waitcnt vmcnt(0)" ::: "memory");
            const unsigned og = xb_add(&bar[XB_TOP], 1u);
            const unsigned tg = og / nx;
            if (og + 1u == (tg + 1u) * nx) xb_add(&bar[XB_TOPGEN], 1u);
            else XB_SPIN(xb_ld(&bar[XB_TOPGEN]) == tg, bar);
            __builtin_amdgcn_fence(__ATOMIC_ACQUIRE, "agent");
            xb_add(&bar[XB_XGEN(b.x)], 1u);
            asm volatile("s_waitcnt vmcnt(0)" ::: "memory");
        } else {
            XB_SPIN(xb_ld(&bar[XB_XGEN(b.x)]) == gen, bar);
            __builtin_amdgcn_fence(__ATOMIC_ACQUIRE, "agent");
            asm volatile("s_waitcnt vmcnt(0)" ::: "memory");
        }
    }
    __syncthreads();
}

__device__ __forceinline__ void spatial_phase(CP P, int j, int Mrows, LAS unsigned char* lds_, int tid, int lane, int wid) {
    const bf16* Z = (const bf16*)(P->ws + WS_Z); const float* VST = (const float*)(P->ws + WS_VST); bf16* Gb = (bf16*)(P->ws + WS_G);
    const bf16* WS = (const bf16*)(P->ws + WS_GMWS) + (size_t)j * 16 * 128 * 128;
    const float* lng = P->in[14] + (size_t)j * DM; const float* lnb = P->in[15] + (size_t)j * DM; const float* bs = P->in[17] + (size_t)j * 16 * 128;
    LAS bf16* Vt = (LAS bf16*)(LAS unsigned char*)lds_;
    constexpr int VP = 136;
    const int nunits = (Mrows / 128) * 16;
    for (int u = blockIdx.x; u < nunits; u += gridDim.x) {
        const int c = u >> 4, g = u & 15;
        __syncthreads();
        {
            const int q = tid >> 2, dq = (tid & 3) * 32; const int row = c * 128 + q;
            const float mean = VST[2 * row], rstd = VST[2 * row + 1];
            const bf16* src = Z + (size_t)row * 4096 + 2048 + g * 128 + dq;
#pragma unroll
            for (int t = 0; t < 4; ++t) { const u32x4 w = *(const u32x4*)(src + 8 * t);
                float v[8] = {bflo(w.x), bfhi(w.x), bflo(w.y), bfhi(w.y), bflo(w.z), bfhi(w.z), bflo(w.w), bfhi(w.w)};
                const float* gp = lng + g * 128 + dq + 8 * t; const float* bp = lnb + g * 128 + dq + 8 * t;
#pragma unroll
                for (int i = 0; i < 8; ++i) { const float vn = (v[i] - mean) * rstd * gp[i] + bp[i]; Vt[(dq + 8 * t + i) * VP + q] = tobf1(vn); } }
        }
        __syncthreads();
        const int fr = lane & 15, fq = lane >> 4;
        bf16x8 a[4];
        const bf16* wrow = WS + (size_t)g * 128 * 128 + (size_t)(16 * wid + fr) * 128 + 8 * fq;
#pragma unroll
        for (int ks = 0; ks < 4; ++ks) a[ks] = *(const bf16x8*)(wrow + 32 * ks);
#pragma unroll
        for (int nb = 0; nb < 8; ++nb) {
            f32x4 acc = {0.f, 0.f, 0.f, 0.f};
#pragma unroll
            for (int ks = 0; ks < 4; ++ks) { const bf16x8 b = *(const LAS bf16x8*)(Vt + (16 * nb + fr) * VP + 32 * ks + 8 * fq);
                acc = __builtin_amdgcn_mfma_f32_16x16x32_bf16(a[ks], b, acc, 0, 0, 0); }
#pragma unroll
            for (int r = 0; r < 4; ++r) { const int p = 16 * wid + fq * 4 + r, d = 16 * nb + fr; const size_t grow = (size_t)(c * 128 + p);
                const float sv = acc[r] + bs[g * 128 + p];
                const float uu = bf1(Z[grow * 4096 + g * 128 + d]);
                Gb[grow * 2048 + g * 128 + d] = tobf1(uu * sv); }
        }
    }
}

__device__ __forceinline__ void rope_cs(int row, int l, float& cs, float& sn) {
    const int t = row & (SEQ - 1); const int pos = (l & 32) ? (t & 63) : (t >> 6);
    const float inv = powf(10000.0f, -(float)(l & 15) * (1.0f / 16.0f));
    const float ang = (float)pos * inv; sincosf(ang, &sn, &cs);
}
__device__ __forceinline__ float rope_apply(float x, int l, float cs, float sn) {
    const float p = lane_xor16(x, l);
    return (l & 16) ? (p * sn + x * cs) : (x * cs - p * sn);
}
__device__ __forceinline__ void mla_norm_pass(CP P, int lane, int gw, int NGW) {
    const bf16* C = (const bf16*)(P->ws + WS_C); bf16* CQN = (bf16*)(P->ws + WS_CQN); bf16* CKVN = (bf16*)(P->ws + WS_CKVN); bf16* KR = (bf16*)(P->ws + WS_KR);
    const float* qn = P->in[20]; const float* kvn = P->in[21];
    for (int row = gw; row < MT; row += NGW) {
        const bf16* c = C + (size_t)row * 1280;
#pragma unroll
        for (int part = 0; part < 2; ++part) {
            const u32x4 w = *(const u32x4*)(c + part * 512 + 8 * lane);
            float v[8] = {bflo(w.x), bfhi(w.x), bflo(w.y), bfhi(w.y), bflo(w.z), bfhi(w.z), bflo(w.w), bfhi(w.w)};
            float ss = 0.f;
#pragma unroll
            for (int i = 0; i < 8; ++i) ss += v[i] * v[i];
            const float r = 1.0f / sqrtf(wave_sum(ss) * (1.0f / 512.0f) + LN_EPS);
            const float* nw = (part ? kvn : qn) + 8 * lane;
            u32x4 o; o.x = cvtpk(v[0] * r * nw[0], v[1] * r * nw[1]); o.y = cvtpk(v[2] * r * nw[2], v[3] * r * nw[3]); o.z = cvtpk(v[4] * r * nw[4], v[5] * r * nw[5]); o.w = cvtpk(v[6] * r * nw[6], v[7] * r * nw[7]);
            *(u32x4*)((part ? CKVN : CQN) + (size_t)row * 512 + 8 * lane) = o;
        }
        float x = bf1(c[1024 + lane]);
        if (row < ML) { float cs, sn; rope_cs(row, lane, cs, sn); x = rope_apply(x, lane, cs, sn); }
        KR[(size_t)row * 64 + lane] = tobf1(x);
    }
}
__device__ __forceinline__ void rope_pass(bf16* buf, int ld, int col0, int nchunks, int cstride, int lane, int gw, int NGW) {
    for (int row = gw; row < ML; row += NGW) {
        float cs, sn; rope_cs(row, lane, cs, sn);
        bf16* r = buf + (size_t)row * ld + col0 + lane;
#pragma unroll 4
        for (int k = 0; k < nchunks; ++k) { const float x = bf1(r[k * cstride]); r[k * cstride] = tobf1(rope_apply(x, lane, cs, sn)); }
    }
}

namespace att {
#ifndef ATT_SDEPTH
#define ATT_SDEPTH(MODE) ((MODE) == 0 ? 1 : 2)
#endif
#ifndef ATT_PVPIPE
#define ATT_PVPIPE(MODE) ((MODE) == 1)
#endif
#define SBAR() __builtin_amdgcn_sched_barrier(0)
__device__ __forceinline__ int crow(int r, int hi) { return (r & 3) + 8 * (r >> 2) + 4 * hi; }
__device__ __forceinline__ unsigned cvtpkv(float lo, float hi) { unsigned r; asm volatile("v_cvt_pk_bf16_f32 %0, %1, %2" : "=v"(r) : "v"(lo), "v"(hi)); return r; }

__device__ __forceinline__ void partialSM(f32x16& p0, f32x16& p1, float& m_reg, float& mn, float& alpha, const float C, const float THRS) {
  float pmax = p0[0];
#pragma unroll
  for (int r = 1; r < 16; ++r) pmax = fmaxf(pmax, p0[r]);
#pragma unroll
  for (int r = 0; r < 16; ++r) pmax = fmaxf(pmax, p1[r]);
  { auto rr = __builtin_amdgcn_permlane32_swap(__float_as_uint(pmax), __float_as_uint(pmax), false, false);
    pmax = fmaxf(__uint_as_float(rr[0]), __uint_as_float(rr[1])); }
  if (__builtin_expect(__all(pmax - m_reg <= THRS), 1)) { mn = m_reg; alpha = 1.f; }
  else { mn = fmaxf(m_reg, pmax); alpha = __builtin_amdgcn_exp2f((m_reg - mn) * C); m_reg = mn; }
  const float mnC = -mn * C;
#pragma unroll
  for (int r = 0; r < 16; ++r) p0[r] = fmaf(p0[r], C, mnC);
#pragma unroll
  for (int r = 0; r < 16; ++r) p1[r] = fmaf(p1[r], C, mnC);
#pragma unroll
  for (int r = 0; r < 16; ++r) p0[r] = __builtin_amdgcn_exp2f(p0[r]);
}
__device__ __forceinline__ void finishSM(f32x16& p0, f32x16& p1, float alpha, float& l_reg, bf16x8& pa0, bf16x8& pa1, bf16x8& pa2, bf16x8& pa3) {
#pragma unroll
  for (int r = 0; r < 16; ++r) p1[r] = __builtin_amdgcn_exp2f(p1[r]);
  float ps = 0;
#pragma unroll
  for (int r = 0; r < 16; ++r) ps += p0[r];
#pragma unroll
  for (int r = 0; r < 16; ++r) ps += p1[r];
  { auto rr = __builtin_amdgcn_permlane32_swap(__float_as_uint(ps), __float_as_uint(ps), false, false);
    ps = __uint_as_float(rr[0]) + __uint_as_float(rr[1]); }
  l_reg = l_reg * alpha + ps;
#define PK4(P, BASE, OUT) do { unsigned a0 = cvtpkv(P[BASE + 0], P[BASE + 1]), a1 = cvtpkv(P[BASE + 2], P[BASE + 3]);   \
    unsigned b0 = cvtpkv(P[BASE + 4], P[BASE + 5]), b1 = cvtpkv(P[BASE + 6], P[BASE + 7]);                              \
    auto r0 = __builtin_amdgcn_permlane32_swap(a0, b0, false, false); auto r1 = __builtin_amdgcn_permlane32_swap(a1, b1, false, false); \
    u32x4 w = {r0[0], r1[0], r0[1], r1[1]}; OUT = *reinterpret_cast<bf16x8*>(&w); } while (0)
  PK4(p0, 0, pa0); PK4(p0, 8, pa1); PK4(p1, 0, pa2); PK4(p1, 8, pa3);
#undef PK4
}
template <int PITCH> __device__ __forceinline__ int kswz(int r) { return PITCH == 256 ? (r & 15) : ((r >> 1) & 7); }
template <int NQF, int NQR, int PITCH> __device__ __forceinline__ void qkt(f32x16& p0, f32x16& p1, const LAS char* Ks, int chunk0, const bf16x8* qr, const LAS char* ql, int r32, int hi) {
  p0 = f32x16{}; p1 = f32x16{};
  const int sw = kswz<PITCH>(r32);
#pragma unroll
  for (int d0 = 0; d0 < NQF; ++d0) { const int off = ((chunk0 + d0 * 2 + hi) ^ sw) * 16;
    const bf16x8 b0 = *(const LAS bf16x8*)(Ks + r32 * PITCH + off);
    const bf16x8 b1 = *(const LAS bf16x8*)(Ks + (32 + r32) * PITCH + off);
    const bf16x8 q = d0 < NQR ? qr[d0 < NQR ? d0 : 0] : *(const LAS bf16x8*)(ql + (d0 - NQR) * 1024);
    p0 = __builtin_amdgcn_mfma_f32_32x32x16_bf16(b0, q, p0, 0, 0, 0);
    p1 = __builtin_amdgcn_mfma_f32_32x32x16_bf16(b1, q, p1, 0, 0, 0); }
}
__device__ __forceinline__ int v_st(int k, int c) { const int kk = (k & ~0xC) | ((k & 4) << 1) | ((k & 8) >> 1); return ((kk >> 3) * 4 + (c >> 5)) * 512 + ((kk & 7) * 32 + (c & 31)) * 2; }
__device__ __forceinline__ int v_rd_base(int lane) { return ((lane & 3) << 3) | (((lane >> 2) & 3) << 6) | (((lane >> 4) & 1) << 5) | (((lane >> 5) & 1) << 8); }
constexpr int v_rd_off(int d0, int ks, int half) { return d0 * 512 + ks * 4096 + half * 2048; }
template <int OFF> __device__ __forceinline__ s16x4 tr_read(int vb) {
  s16x4 r; asm volatile("ds_read_b64_tr_b16 %0, %1 offset:%2" : "=&v"(r) : "v"(vb), "i"(OFF) : "memory"); return r;
}
template <int D0> __device__ __forceinline__ void pv_one(f32x16& od, int vb, bf16x8 pa0, bf16x8 pa1, bf16x8 pa2, bf16x8 pa3) {
  const s16x4 l0 = tr_read<v_rd_off(D0, 0, 0)>(vb), h0 = tr_read<v_rd_off(D0, 0, 1)>(vb), l1 = tr_read<v_rd_off(D0, 1, 0)>(vb), h1 = tr_read<v_rd_off(D0, 1, 1)>(vb);
  const s16x4 l2 = tr_read<v_rd_off(D0, 2, 0)>(vb), h2 = tr_read<v_rd_off(D0, 2, 1)>(vb), l3 = tr_read<v_rd_off(D0, 3, 0)>(vb), h3 = tr_read<v_rd_off(D0, 3, 1)>(vb);
  asm volatile("s_waitcnt lgkmcnt(0)" ::: "memory"); SBAR();
#define PK(L, H) (bf16x8){L[0], L[1], L[2], L[3], H[0], H[1], H[2], H[3]}
  od = __builtin_amdgcn_mfma_f32_32x32x16_bf16(pa0, PK(l0, h0), od, 0, 0, 0);
  od = __builtin_amdgcn_mfma_f32_32x32x16_bf16(pa1, PK(l1, h1), od, 0, 0, 0);
  od = __builtin_amdgcn_mfma_f32_32x32x16_bf16(pa2, PK(l2, h2), od, 0, 0, 0);
  od = __builtin_amdgcn_mfma_f32_32x32x16_bf16(pa3, PK(l3, h3), od, 0, 0, 0);
#undef PK
}
__device__ __forceinline__ void pv_d0(f32x16* o, int vb, bf16x8 pa0, bf16x8 pa1, bf16x8 pa2, bf16x8 pa3) {
  pv_one<0>(o[0], vb, pa0, pa1, pa2, pa3); pv_one<1>(o[1], vb, pa0, pa1, pa2, pa3); pv_one<2>(o[2], vb, pa0, pa1, pa2, pa3); pv_one<3>(o[3], vb, pa0, pa1, pa2, pa3);
}
struct VFrag { s16x4 l0, h0, l1, h1, l2, h2, l3, h3; };
template <int D0> __device__ __forceinline__ void tr8(VFrag& f, int vb) {
  f.l0 = tr_read<v_rd_off(D0, 0, 0)>(vb); f.h0 = tr_read<v_rd_off(D0, 0, 1)>(vb); f.l1 = tr_read<v_rd_off(D0, 1, 0)>(vb); f.h1 = tr_read<v_rd_off(D0, 1, 1)>(vb);
  f.l2 = tr_read<v_rd_off(D0, 2, 0)>(vb); f.h2 = tr_read<v_rd_off(D0, 2, 1)>(vb); f.l3 = tr_read<v_rd_off(D0, 3, 0)>(vb); f.h3 = tr_read<v_rd_off(D0, 3, 1)>(vb);
}
__device__ __forceinline__ void mfma4(f32x16& od, VFrag& f, bf16x8 pa0, bf16x8 pa1, bf16x8 pa2, bf16x8 pa3) {
#define PK(L, H) (bf16x8){L[0], L[1], L[2], L[3], H[0], H[1], H[2], H[3]}
  od = __builtin_amdgcn_mfma_f32_32x32x16_bf16(pa0, PK(f.l0, f.h0), od, 0, 0, 0);
  od = __builtin_amdgcn_mfma_f32_32x32x16_bf16(pa1, PK(f.l1, f.h1), od, 0, 0, 0);
  od = __builtin_amdgcn_mfma_f32_32x32x16_bf16(pa2, PK(f.l2, f.h2), od, 0, 0, 0);
  od = __builtin_amdgcn_mfma_f32_32x32x16_bf16(pa3, PK(f.l3, f.h3), od, 0, 0, 0);
#undef PK
}
#define VF_TIE(f) "+v"(f.l0), "+v"(f.h0), "+v"(f.l1), "+v"(f.h1), "+v"(f.l2), "+v"(f.h2), "+v"(f.l3), "+v"(f.h3)
__device__ __forceinline__ void pv_pipe(f32x16* o, int vb, bf16x8 pa0, bf16x8 pa1, bf16x8 pa2, bf16x8 pa3) {
  VFrag A, B;
  asm volatile("s_waitcnt lgkmcnt(0)" ::: "memory");
  tr8<0>(A, vb); tr8<1>(B, vb);
  asm volatile("s_waitcnt lgkmcnt(8)" : VF_TIE(A) :: "memory"); SBAR();
  mfma4(o[0], A, pa0, pa1, pa2, pa3); SBAR();
  tr8<2>(A, vb);
  asm volatile("s_waitcnt lgkmcnt(8)" : VF_TIE(B) :: "memory"); SBAR();
  mfma4(o[1], B, pa0, pa1, pa2, pa3); SBAR();
  tr8<3>(B, vb);
  asm volatile("s_waitcnt lgkmcnt(8)" : VF_TIE(A) :: "memory"); SBAR();
  mfma4(o[2], A, pa0, pa1, pa2, pa3); SBAR();
  asm volatile("s_waitcnt lgkmcnt(0)" : VF_TIE(B) :: "memory"); SBAR();
  mfma4(o[3], B, pa0, pa1, pa2, pa3);
}
__device__ __forceinline__ bf16x8 ld8(const bf16* p) { return *reinterpret_cast<const bf16x8*>(p); }

template <int MODE>
__device__ __forceinline__ void attn_unit(const bf16* __restrict__ Qrow0, int ldq, const bf16* __restrict__ Kb, const bf16* __restrict__ Vb, int ldk, const bf16* __restrict__ KRb,
                                          int b, int nct, int NT, bf16* __restrict__ Ob, float lam, const float* __restrict__ subln, float oscale, LAS unsigned char* lds_, const int tid_in) {
  constexpr int NQF = MODE == 0 ? 12 : 4, NQR = MODE == 0 ? 4 : 4, PITCH = MODE == 0 ? 384 : 256, SHM_V = 16384, SHM_K = 64 * PITCH, SDEPTH = ATT_SDEPTH(MODE); constexpr bool PVPIPE = ATT_PVPIPE(MODE);
  const float SCALE = MODE == 0 ? 0.07216878364870323f : 0.125f;
  const float C = SCALE * 1.4426950408889634f, THRS = 8.f / SCALE;
  const int tid = launder_v(tid_in) & 511, wid = tid >> 6, lane = tid & 63, r32 = lane & 31, hi = lane >> 5;
  LAS char* lds = (LAS char*)(LAS unsigned char*)lds_;
  LAS char* V_lds = lds; LAS char* K_lds = lds + 2 * SHM_V;
  LAS float* wsf = (LAS float*)(lds + 2 * SHM_V + 2 * SHM_K) + wid * 64; LAS float* li_l = wsf; LAS float* al_l = wsf + 32;
  const int wq = MODE == 0 ? wid : (wid & 3), sgrp = MODE == 0 ? 0 : (wid >> 2);
  float m_reg = -1e30f, l_reg = 0; f32x16 o[4] = {}; bf16x8 qr[NQR];
  LAS char* ql = lds + 2 * SHM_V + 2 * SHM_K + 2048 + wid * 8192 + lane * 16;
  const bf16* Qw = Qrow0 + (size_t)(wq * 32 + r32) * ldq + sgrp * 64 + hi * 8;
#pragma unroll
  for (int d0 = 0; d0 < NQR; ++d0) qr[d0] = ld8(Qw + d0 * 16);
#pragma unroll
  for (int d0 = NQR; d0 < NQF; ++d0) *(LAS bf16x8*)(ql + (d0 - NQR) * 1024) = ld8(Qw + d0 * 16);
  const int sr = tid >> 4, sc = (tid & 15) * 8, vst0 = v_st(sr, sc), vst1 = v_st(32 + sr, sc);
  const int kst0 = sr * PITCH + (((tid & 15) ^ kswz<PITCH>(sr)) * 16), kst1 = kst0 + 32 * PITCH;
  const int rrow = tid >> 3, krs = rrow * PITCH + (((16 + (tid & 7)) ^ kswz<PITCH>(rrow)) * 16);
  const int chunk0 = sgrp * 8;
  const int vb0 = (int)(uintptr_t)V_lds + v_rd_base(lane);
  struct Slot { bf16x8 vs0, vs1, ks0, ks1, kr; } sr_[SDEPTH];
#define KROW(jt) ((jt) < nct ? (ML + b * CTXL + (jt) * 64) : (b * SEQ + ((jt) - nct) * 64))
#define SLOAD(i, jt) do { const int k0_ = KROW(jt); sr_[i].vs0 = ld8(Vb + (size_t)(k0_ + sr) * ldk + sc); sr_[i].vs1 = ld8(Vb + (size_t)(k0_ + 32 + sr) * ldk + sc); \
    sr_[i].ks0 = ld8(Kb + (size_t)(k0_ + sr) * ldk + sc); sr_[i].ks1 = ld8(Kb + (size_t)(k0_ + 32 + sr) * ldk + sc); \
    if (MODE == 0) sr_[i].kr = ld8(KRb + (size_t)(k0_ + rrow) * 64 + (tid & 7) * 8); } while (0)
#define SWRITE(bf, i) do { *(LAS bf16x8*)(V_lds + (bf) * SHM_V + vst0) = sr_[i].vs0; *(LAS bf16x8*)(V_lds + (bf) * SHM_V + vst1) = sr_[i].vs1; \
    *(LAS bf16x8*)(K_lds + (bf) * SHM_K + kst0) = sr_[i].ks0; *(LAS bf16x8*)(K_lds + (bf) * SHM_K + kst1) = sr_[i].ks1; \
    if (MODE == 0) *(LAS bf16x8*)(K_lds + (bf) * SHM_K + krs) = sr_[i].kr; } while (0)
#define SWAIT() do { if constexpr (SDEPTH == 2) asm volatile("s_waitcnt vmcnt(4)" ::: "memory"); else asm volatile("s_waitcnt vmcnt(0)" ::: "memory"); } while (0)
#define RESC(a) do { if (__any((a) < 1.f)) { if (hi == 0) al_l[r32] = (a); asm volatile("s_waitcnt lgkmcnt(0)" ::: "memory"); \
    _Pragma("unroll") for (int d = 0; d < 4; ++d) _Pragma("unroll") for (int r = 0; r < 16; ++r) o[d][r] *= al_l[crow(r, hi)]; } } while (0)
#define PV(vb_) do { if constexpr (PVPIPE) pv_pipe(o, (vb_), pa0, pa1, pa2, pa3); else pv_d0(o, (vb_), pa0, pa1, pa2, pa3); } while (0)
  f32x16 pA0, pA1, pB0, pB1; float mnA, mnB, alA, alB; bf16x8 pa0, pa1, pa2, pa3;
  constexpr int SE = 0, SO = SDEPTH - 1;
  SLOAD(SE, 0); asm volatile("s_waitcnt vmcnt(0)" ::: "memory"); SWRITE(0, SE); __syncthreads();
  qkt<NQF, NQR, PITCH>(pA0, pA1, K_lds, chunk0, qr, ql, r32, hi); partialSM(pA0, pA1, m_reg, mnA, alA, C, THRS);
  SLOAD(SO, 1); if constexpr (SDEPTH == 2) { if (2 < NT) SLOAD(SE, 2); }
  SWAIT(); SWRITE(1, SO); __syncthreads();
  for (int j = 1; j + 1 < NT; j += 2) {
    SBAR(); qkt<NQF, NQR, PITCH>(pB0, pB1, K_lds + SHM_K, chunk0, qr, ql, r32, hi);
    finishSM(pA0, pA1, alA, l_reg, pa0, pa1, pa2, pa3); SBAR();
    SLOAD(SO, j + SDEPTH); SBAR();
    PV(vb0); partialSM(pB0, pB1, m_reg, mnB, alB, C, THRS);
    __syncthreads(); SWAIT(); SWRITE(0, SE);
    RESC(alB); __syncthreads();
    SBAR(); qkt<NQF, NQR, PITCH>(pA0, pA1, K_lds, chunk0, qr, ql, r32, hi);
    finishSM(pB0, pB1, alB, l_reg, pa0, pa1, pa2, pa3); SBAR();
    if (SDEPTH == 1 || j + 3 < NT) SLOAD(SE, j + 1 + SDEPTH); SBAR();
    PV(vb0 + SHM_V); partialSM(pA0, pA1, m_reg, mnA, alA, C, THRS);
    __syncthreads(); SWAIT(); SWRITE(1, SO);
    RESC(alA); __syncthreads();
  }
  SBAR(); qkt<NQF, NQR, PITCH>(pB0, pB1, K_lds + SHM_K, chunk0, qr, ql, r32, hi);
  finishSM(pA0, pA1, alA, l_reg, pa0, pa1, pa2, pa3); SBAR();
  PV(vb0); partialSM(pB0, pB1, m_reg, mnB, alB, C, THRS);
  __syncthreads(); RESC(alB);
  finishSM(pB0, pB1, alB, l_reg, pa0, pa1, pa2, pa3); SBAR();
  PV(vb0 + SHM_V);
  if (hi == 0) li_l[r32] = l_reg; asm volatile("s_waitcnt lgkmcnt(0)" ::: "memory");
  float rli[16];
#pragma unroll
  for (int r = 0; r < 16; ++r) rli[r] = __builtin_amdgcn_rcpf(li_l[crow(r, hi)]);
  bf16* Ow = Ob + (size_t)(wq * 32) * DM;
  if constexpr (MODE == 0) {
#pragma unroll
    for (int r = 0; r < 16; ++r) { const int orow = crow(r, hi);
#pragma unroll
      for (int d0 = 0; d0 < 4; ++d0) Ow[(size_t)orow * DM + d0 * 32 + r32] = tobf1(o[d0][r] * rli[r]); }
    __syncthreads();
  } else {
    LAS float* ex = (LAS float*)lds;
    __syncthreads();
    if (sgrp == 1) {
#pragma unroll
      for (int r = 0; r < 16; ++r)
#pragma unroll
        for (int d0 = 0; d0 < 4; ++d0) ex[(wq * 32 + crow(r, hi)) * 128 + d0 * 32 + r32] = o[d0][r] * rli[r];
    }
    __syncthreads();
    if (sgrp == 0) {
#pragma unroll
      for (int r = 0; r < 16; ++r) { const int orow = crow(r, hi); float dd[4]; float ss = 0.f;
#pragma unroll
        for (int d0 = 0; d0 < 4; ++d0) { dd[d0] = o[d0][r] * rli[r] - lam * ex[(wq * 32 + orow) * 128 + d0 * 32 + r32]; ss += dd[d0] * dd[d0]; }
        ss = half_sum32(ss);
        const float rs = oscale / sqrtf(ss * (1.0f / 128.0f) + LN_EPS);
#pragma unroll
        for (int d0 = 0; d0 < 4; ++d0) Ow[(size_t)orow * DM + d0 * 32 + r32] = tobf1(dd[d0] * rs * subln[d0 * 32 + r32]); }
    }
    __syncthreads();
  }
#undef PV
#undef KROW
#undef SLOAD
#undef SWRITE
#undef SWAIT
#undef RESC
}
}

__device__ __forceinline__ void mla_attn_phase(CP P, LAS unsigned char* lds, const int tid) {
    const bf16* QM = (const bf16*)(P->ws + WS_QM); const bf16* KV = (const bf16*)(P->ws + WS_KV); const bf16* KR = (const bf16*)(P->ws + WS_KR); bf16* Gb = (bf16*)(P->ws + WS_G);
    const int c = blockIdx.x, G = gridDim.x;
    for (int u = c; u < 1024 + 32; u += G) {
        int b, h, qrow0, NT;
        if (u < 1024) { const int i = u >> 8, cc = u & 255; const int bh = (cc & 7) + 8 * i, qb = cc >> 3; b = bh >> 4; h = bh & 15; qrow0 = b * SEQ + qb * 256; NT = 4 + 128; }
        else { const int bh = u - 1024; b = bh >> 4; h = bh & 15; qrow0 = ML + b * CTXL; NT = 4; }
        att::attn_unit<0>(QM + (size_t)qrow0 * 3072 + h * 192, 3072, KV + h * 256, KV + h * 256 + 128, 4096, KR, b, 4, NT, Gb + (size_t)qrow0 * DM + h * 128, 0.f, nullptr, 1.f, lds, tid);
    }
}
__device__ __forceinline__ void da_attn_phase(CP P, float lam, float oscale, LAS unsigned char* lds, const int tid, const bool ctx_q) {
    const bf16* Z = (const bf16*)(P->ws + WS_Z); bf16* Gb = (bf16*)(P->ws + WS_G); const float* subln = P->in[27];
    const int c = blockIdx.x, G = gridDim.x;
    for (int u = c; u < 2048 + (ctx_q ? 64 : 0); u += G) {
        int b, h, qrow0, NT;
        if (u < 2048) { const int i = u >> 8, cc = u & 255; const int bh = (cc & 7) + 8 * (i >> 1), qb = (cc >> 3) + 32 * (i & 1); b = bh >> 4; h = bh & 15; qrow0 = b * SEQ + qb * 128; NT = 4 + 128; }
        else { const int v = u - 2048; const int bh = v >> 1; b = bh >> 4; h = bh & 15; qrow0 = ML + b * CTXL + (v & 1) * 128; NT = 4; }
        att::attn_unit<1>(Z + (size_t)qrow0 * 6144 + h * 128, 6144, Z + 2048 + h * 128, Z + 4096 + h * 128, 6144, nullptr, b, 4, NT, Gb + (size_t)qrow0 * DM + h * 128, lam, subln, oscale, lds, tid);
    }
}

__device__ __forceinline__ unsigned f2ord(float f) { const unsigned u = __float_as_uint(f); return u ^ ((unsigned)((int)u >> 31) | 0x80000000u); }
__device__ __forceinline__ float ord2f(unsigned k) { return __uint_as_float((k & 0x80000000u) ? (k ^ 0x80000000u) : ~k); }
__device__ __forceinline__ void ce_desc(unsigned& a, unsigned& b) { const unsigned mx = a > b ? a : b, mn = a > b ? b : a; a = mx; b = mn; }
template <int N, bool DESC> __device__ __forceinline__ void bitonic_merge(unsigned* a) {
#pragma unroll
    for (int j = N / 2; j > 0; j >>= 1)
#pragma unroll
        for (int i = 0; i < N; ++i) { const int l = i ^ j; if (l > i) { if (DESC) ce_desc(a[i], a[l]); else ce_desc(a[l], a[i]); } }
}
template <int N, bool DESC> __device__ __forceinline__ void bitonic_sort(unsigned* a) {
#pragma unroll
    for (int k = 2; k <= N; k <<= 1)
#pragma unroll
        for (int j = k >> 1; j > 0; j >>= 1)
#pragma unroll
            for (int i = 0; i < N; ++i) { const int l = i ^ j; if (l > i) { const bool up = ((i & k) == 0); if (up == DESC) ce_desc(a[i], a[l]); else ce_desc(a[l], a[i]); } }
}
__device__ __forceinline__ void top16_of_64(unsigned (&a)[64]) {
    bitonic_sort<16, true>(a); bitonic_sort<16, false>(a + 16); bitonic_sort<16, true>(a + 32); bitonic_sort<16, false>(a + 48);
#pragma unroll
    for (int i = 0; i < 16; ++i) a[i] = a[i] > a[16 + i] ? a[i] : a[16 + i];
    bitonic_merge<16, true>(a);
#pragma unroll
    for (int i = 0; i < 16; ++i) a[32 + i] = a[32 + i] > a[48 + i] ? a[32 + i] : a[48 + i];
    bitonic_merge<16, false>(a + 32);
#pragma unroll
    for (int i = 0; i < 16; ++i) a[i] = a[i] > a[32 + i] ? a[i] : a[32 + i];
    bitonic_merge<16, true>(a);
}
template <int PASS> __device__ __forceinline__ void route_pass(const bf16* QP, const LAS char* lds, int tok, int head, int r32, int hi, unsigned (&top)[16]) {
    f32x16 acc[4] = {};
    const bf16* qp = QP + (size_t)tok * DM + head * 256 + PASS * 128 + hi * 8;
    bf16x8 qf[8];
#pragma unroll
    for (int ks = 0; ks < 8; ++ks) qf[ks] = *(const bf16x8*)(qp + ks * 16);
    const LAS char* Kl = lds + PASS * 32768;
#pragma unroll
    for (int kb = 0; kb < 4; ++kb)
#pragma unroll
        for (int ks = 0; ks < 8; ++ks) { const bf16x8 a = *(const LAS bf16x8*)(Kl + (kb * 32 + r32) * 256 + (((ks * 2 + hi) ^ (r32 & 15)) * 16));
            acc[kb] = __builtin_amdgcn_mfma_f32_32x32x16_bf16(a, qf[ks], acc[kb], 0, 0, 0); }
    unsigned key[64]; const unsigned base = 127u - 4u * (unsigned)hi;
#pragma unroll
    for (int kb = 0; kb < 4; ++kb)
#pragma unroll
        for (int r = 0; r < 16; ++r) key[kb * 16 + r] = (f2ord(acc[kb][r]) & ~127u) | (base - (unsigned)(kb * 32 + (r & 3) + 8 * (r >> 2)));
    top16_of_64(key);
    unsigned pr[16];
#pragma unroll
    for (int i = 0; i < 16; ++i) pr[i] = lane_xor32(key[15 - i], hi << 5);
#pragma unroll
    for (int i = 0; i < 16; ++i) key[i] = key[i] > pr[i] ? key[i] : pr[i];
    bitonic_merge<16, true>(key);
#pragma unroll
    for (int i = 0; i < 16; ++i) top[i] = key[i];
}
__device__ __forceinline__ void route_phase(CP P, int L, int Mrows, LAS unsigned char* lds_, int tid, int lane, int wid, int gw, int NGW) {
    const bf16* QP = (const bf16*)(P->ws + WS_QP); unsigned* ROUTE = (unsigned*)(P->ws + WS_ROUTE);
    LAS char* lds = (LAS char*)(LAS unsigned char*)lds_;
    __syncthreads();
    {
        const bf16* K1 = (const bf16*)(P->ws + WS_PK1) + (size_t)L * 128 * 128; const bf16* K2 = (const bf16*)(P->ws + WS_PK2) + (size_t)L * 128 * 128;
        for (int c16 = tid; c16 < 2 * 128 * 16; c16 += NWAVES * 64) { const int mat = c16 >> 11, row = (c16 >> 4) & 127, ch = c16 & 15;
            const u32x4 w = *(const u32x4*)((mat ? K2 : K1) + row * 128 + ch * 8);
            *(LAS u32x4*)(lds + mat * 32768 + row * 256 + ((ch ^ (row & 15)) * 16)) = w; }
    }
    __syncthreads();
    LAS unsigned* sc = (LAS unsigned*)(lds + 65536) + wid * 2048;
    const int r32 = lane & 31, hi = lane >> 5;
    for (int item = gw; item < Mrows / 4; item += NGW) {
        const int tok = item * 4 + (r32 >> 3), head = r32 & 7;
        unsigned top0[16], top1[16];
        route_pass<0>(QP, lds, tok, head, r32, hi, top0);
        route_pass<1>(QP, lds, tok, head, r32, hi, top1);
        float v1[16], v2[16];
#pragma unroll
        for (int i = 0; i < 16; ++i) { v1[i] = ord2f(top0[i] & ~127u); v2[i] = ord2f(top1[i] & ~127u);
            sc[i * 64 + lane] = 127u - (top0[i] & 127u); sc[(16 + i) * 64 + lane] = 127u - (top1[i] & 127u); }
        unsigned ck[64]; int n = 0;
#pragma unroll
        for (int i = 0; i < 16; ++i)
#pragma unroll
            for (int j = 0; j < 16; ++j) if ((i + 1) * (j + 1) <= 16) { ck[n] = (f2ord(v1[i] + v2[j]) & ~255u) | (unsigned)(i * 16 + j); ++n; }
#pragma unroll
        for (int i = 50; i < 64; ++i) ck[i] = 0u;
        top16_of_64(ck);
        float ev[16]; float sum = 0.f; const float mx = ord2f(ck[0] & ~255u);
#pragma unroll
        for (int k = 0; k < 16; ++k) { ev[k] = __expf(ord2f(ck[k] & ~255u) - mx); sum += ev[k]; }
        const float inv = 1.0f / sum;
        unsigned ee[16];
#pragma unroll
        for (int k = 0; k < 16; ++k) { const unsigned pc = ck[k] & 255u; const unsigned i1 = sc[(pc >> 4) * 64 + lane], i2 = sc[(16 + (pc & 15u)) * 64 + lane]; ee[k] = i1 * 128u + i2; ev[k] *= inv; }
        u32x4* outp = (u32x4*)(ROUTE + ((size_t)tok * 128 + head * 16 + hi * 8) * 2);
#pragma unroll
        for (int k = 0; k < 8; k += 2) { u32x4 w;
            const unsigned eL0 = ee[k], eH0 = ee[k + 8], eL1 = ee[k + 1], eH1 = ee[k + 9]; const float gL0 = ev[k], gH0 = ev[k + 8], gL1 = ev[k + 1], gH1 = ev[k + 9];
            w.x = hi ? eH0 : eL0; w.y = __float_as_uint(hi ? gH0 : gL0); w.z = hi ? eH1 : eL1; w.w = __float_as_uint(hi ? gH1 : gL1);
            outp[k >> 1] = w; }
    }
}

typedef float f32x2 __attribute__((ext_vector_type(2)));
typedef float f32x32 __attribute__((ext_vector_type(32)));
typedef unsigned u32x6 __attribute__((ext_vector_type(6)));
typedef __bf16 bf16x32 __attribute__((ext_vector_type(32)));
typedef unsigned u32x16 __attribute__((ext_vector_type(16)));
typedef __bf16 bf16x2_t __attribute__((ext_vector_type(2)));
constexpr int GS = 6, GSLOT = 2 * PROW;
__device__ __forceinline__ void glds16(const void* gsrc, unsigned lds_dst) { unsigned keep;
  asm volatile("s_mov_b32 %0, m0\n\ts_mov_b32 m0, %2\n\ts_nop 0\n\tglobal_load_lds_dwordx4 %1, off\n\ts_mov_b32 m0, %0" : "=&s"(keep) : "v"(gsrc), "s"(lds_dst) : "memory"); }
template <int GMODE = 0>
__device__ __forceinline__ void gather_phase(CP P, int L, int Mrows, LAS unsigned char* lds, int wid, int lane_, int gw, int NGW, bool dry = false) {
    const unsigned char* U = P->ws + WS_PU + (size_t)L * 16384 * PROW; const unsigned char* V = P->ws + WS_PV + (size_t)L * 16384 * PROW;
    const unsigned* ROUTE = (const unsigned*)(P->ws + WS_ROUTE); const float* MOD = (const float*)(P->ws + WS_MOD);
    bf16* X = (bf16*)(P->ws + WS_X); bf16* H = (bf16*)(P->ws + WS_H); bf16* Xo = dry ? (bf16*)(P->ws + WS_Y) : X; bf16* Ho = dry ? (bf16*)(P->ws + WS_G) : H;
    const float* lng = P->in[6] + (size_t)(L * 2 + 1) * DM; const float* lnb = P->in[7] + (size_t)(L * 2 + 1) * DM;
    const unsigned ring = (unsigned)(uintptr_t)lds + (unsigned)wid * (GS * GSLOT);
    for (int row = gw; row < Mrows; row += NGW) {
        const int lane = launder_v(lane_);
        const u32x2 ea = ((const u32x2*)(ROUTE + (size_t)row * 256))[lane], eb = ((const u32x2*)(ROUTE + (size_t)row * 256))[64 + lane];
        unsigned eax, eay, ebx, eby;
        unsigned hw[16];
#pragma unroll
        for (int j = 0; j < 4; ++j) { const u32x4 w = ((const u32x4*)(H + (size_t)row * DM))[4 * lane + j]; hw[4 * j] = w.x; hw[4 * j + 1] = w.y; hw[4 * j + 2] = w.z; hw[4 * j + 3] = w.w; }
        float y[32];
#pragma unroll
        for (int i = 0; i < 32; ++i) y[i] = 0.f;
        { unsigned e0 = ea.x, e1 = ea.y, e2 = eb.x, e3 = eb.y;
          asm volatile("" : "+v"(e0), "+v"(e1), "+v"(e2), "+v"(e3), "+v"(hw[0]), "+v"(hw[1]), "+v"(hw[2]), "+v"(hw[3]), "+v"(hw[4]), "+v"(hw[5]), "+v"(hw[6]), "+v"(hw[7]),
                       "+v"(hw[8]), "+v"(hw[9]), "+v"(hw[10]), "+v"(hw[11]), "+v"(hw[12]), "+v"(hw[13]), "+v"(hw[14]), "+v"(hw[15]) :: "memory");
          eax = e0; eay = e1; ebx = e2; eby = e3; }
        const unsigned rd_a = ring + 16u * (unsigned)lane, rd_b = ring + 1024u + 8u * (unsigned)lane;
#define G_ISSUE(k) do { const int k_ = (k); const unsigned e_ = (unsigned)__builtin_amdgcn_readlane((int)(k_ < 64 ? eax : ebx), k_ & 63); \
        const unsigned char* up_ = U + (size_t)e_ * PROW + 16 * lane; const unsigned char* vp_ = V + (size_t)e_ * PROW + 16 * lane; const unsigned sb_ = ring + (unsigned)(k_ % GS) * GSLOT; \
        if (GMODE != 2) { glds16(up_, sb_); glds16(vp_, sb_ + PROW); if (lane < 32) { glds16(up_ + 1024, sb_ + 1024); glds16(vp_ + 1024, sb_ + PROW + 1024); } } else { asm volatile("" :: "v"(up_), "v"(vp_), "s"(sb_)); } } while (0)
#pragma unroll
        for (int k = 0; k < 4; ++k) G_ISSUE(k);
#define G_READ(k, ua, ub, va, vb) do { const unsigned so_ = (unsigned)((k) % GS) * GSLOT; \
        asm volatile("ds_read_b128 %0, %4\n\tds_read_b64 %1, %5\n\tds_read_b128 %2, %4 offset:1536\n\tds_read_b64 %3, %5 offset:1536" \
                     : "=&v"(ua), "=&v"(ub), "=&v"(va), "=&v"(vb) : "v"(rd_a + so_), "v"(rd_b + so_) : "memory"); } while (0)
#pragma unroll 1
        for (int k = 0; k < 128; k += 2) {
            if (k + 4 < 128) { G_ISSUE(k + 4); G_ISSUE(k + 5); asm volatile("s_waitcnt vmcnt(16)" ::: "memory"); }
            else if (k == 124) asm volatile("s_waitcnt vmcnt(8)" ::: "memory");
            else asm volatile("s_waitcnt vmcnt(0)" ::: "memory");
            u32x4 uaA, vaA, uaB, vaB; u32x2 ubA, vbA, ubB, vbB;
            G_READ(k, uaA, ubA, vaA, vbA); G_READ(k + 1, uaB, ubB, vaB, vbB);
            asm volatile("s_waitcnt lgkmcnt(0)" : "+v"(uaA), "+v"(ubA), "+v"(vaA), "+v"(vbA), "+v"(uaB), "+v"(ubB), "+v"(vaB), "+v"(vbB) :: "memory");
            if (GMODE == 1) continue;
            const u32x6 u6A = {uaA.x, uaA.y, uaA.z, uaA.w, ubA.x, ubA.y}, u6B = {uaB.x, uaB.y, uaB.z, uaB.w, ubB.x, ubB.y};
            const u32x16 ubfA = __builtin_bit_cast(u32x16, __builtin_amdgcn_cvt_scalef32_pk32_bf16_fp6(u6A, 1.0f));
            const u32x16 ubfB = __builtin_bit_cast(u32x16, __builtin_amdgcn_cvt_scalef32_pk32_bf16_fp6(u6B, 1.0f));
            float a0 = 0.f, a1 = 0.f, b0 = 0.f, b1 = 0.f;
#pragma unroll
            for (int q = 0; q < 16; q += 2) { const unsigned h0_ = hw[q], h1_ = hw[q + 1], x0_ = ubfA[q], x1_ = ubfA[q + 1], z0_ = ubfB[q], z1_ = ubfB[q + 1];
                a0 = __builtin_amdgcn_fdot2_f32_bf16(__builtin_bit_cast(bf16x2_t, h0_), __builtin_bit_cast(bf16x2_t, x0_), a0, false);
                a1 = __builtin_amdgcn_fdot2_f32_bf16(__builtin_bit_cast(bf16x2_t, h1_), __builtin_bit_cast(bf16x2_t, x1_), a1, false);
                b0 = __builtin_amdgcn_fdot2_f32_bf16(__builtin_bit_cast(bf16x2_t, h0_), __builtin_bit_cast(bf16x2_t, z0_), b0, false);
                b1 = __builtin_amdgcn_fdot2_f32_bf16(__builtin_bit_cast(bf16x2_t, h1_), __builtin_bit_cast(bf16x2_t, z1_), b1, false); }
            const float dA = wave_sum(a0 + a1) * (1.0f / U_SCALE), dB = wave_sum(b0 + b1) * (1.0f / U_SCALE);
            const unsigned gsel = k < 64 ? eay : eby;
            const float wA = __uint_as_float((unsigned)__builtin_amdgcn_readlane((int)gsel, k & 63)) * gelu_tanh(dA) * (1.0f / V_SCALE);
            const float wB = __uint_as_float((unsigned)__builtin_amdgcn_readlane((int)gsel, (k & 63) + 1)) * gelu_tanh(dB) * (1.0f / V_SCALE);
            const u32x6 v6A = {vaA.x, vaA.y, vaA.z, vaA.w, vbA.x, vbA.y};
            const f32x32 vfA = __builtin_amdgcn_cvt_scalef32_pk32_f32_fp6(v6A, 1.0f);
#pragma unroll
            for (int i = 0; i < 32; ++i) y[i] += wA * vfA[i];
            const u32x6 v6B = {vaB.x, vaB.y, vaB.z, vaB.w, vbB.x, vbB.y};
            const f32x32 vfB = __builtin_amdgcn_cvt_scalef32_pk32_f32_fp6(v6B, 1.0f);
#pragma unroll
            for (int i = 0; i < 32; ++i) y[i] += wB * vfB[i];
        }
#undef G_READ
#undef G_ISSUE
        const int slot = row_slot(row);
        const float* mod = MOD + (size_t)(L * 3 + slot) * 12288;
        const int le = launder_v(lane);
        { float xx[32], gg[32]; load_row_bf16_b(X + (size_t)row * DM, le, xx); load_row_f32_b(mod + 5 * 2048, le, gg);
#pragma unroll
          for (int i = 0; i < 32; ++i) y[i] = ALPHA * xx[i] + gg[i] * y[i]; }
        if (L < NLAYER - 1) { const float* modn = MOD + (size_t)((L + 1) * 3 + slot) * 12288;
            finish_row<true>(y, lng, lnb, Xo + (size_t)row * DM, modn, modn + 2048, Ho + (size_t)row * DM, nullptr, le); }
        else finish_row<true>(y, lng, lnb, nullptr, nullptr, nullptr, nullptr, P->out + (size_t)row * DM, le);
        asm volatile("s_waitcnt vmcnt(0)" ::: "memory");
    }
}

#ifndef ROPE_TEST
#define ROPE_TEST 0
#endif
#ifndef PROBE_DUP
#define PROBE_DUP 0
#endif
#define NOINL __forceinline__
__device__ __forceinline__ CP launder_cp(CP p) { asm volatile("" : "+s"(p)); return p; }
#define GETP() launder_cp((CP)__builtin_amdgcn_kernarg_segment_ptr())
__device__ __forceinline__ int uni(int v) { return __builtin_amdgcn_readfirstlane(v); }
__device__ __forceinline__ LAS unsigned char* uni_lds(LAS unsigned char* p) { return (LAS unsigned char*)(unsigned)__builtin_amdgcn_readfirstlane((int)(unsigned)(uintptr_t)p); }
#define PH_IDS const int wid = uni(wv_), lane = launder_v(lane_id_fresh()) & 63, tid = (wid & 7) * 64 + lane; const int gw = blockIdx.x * NWAVES + wid, NGW = gridDim.x * NWAVES; (void)lane; (void)gw; (void)NGW; (void)tid;

__device__ NOINL void ph_prologue(int wv_, LAS unsigned char* lds_) { CP P = GETP(); LAS unsigned char* lds = uni_lds(lds_); PH_IDS p0_prologue(P, lds, tid, lane, wid, gw, NGW); if (PROBE_DUP == 5) p0_prologue(P, lds, tid, lane, wid, gw, NGW); }
__device__ NOINL void ph_modreduce(int wv_) { CP P = GETP(); PH_IDS mod_reduce(P, gw, lane, NGW); }
__device__ NOINL void ph_first(int wv_) { CP P = GETP(); PH_IDS
#pragma unroll 1
    for (int rep = 0; rep < (PROBE_DUP == 6 ? 2 : 1); ++rep) first_row_pass(P, lane, gw, NGW); }
__device__ NOINL void ph_postmix(int wv_, int L_, int M_) { CP P = GETP(); const int L = uni(L_), Mrows = uni(M_); PH_IDS post_mixer_pass(P, L, Mrows, lane, gw, NGW); }
__device__ NOINL void ph_vstats(int wv_, int M_) { CP P = GETP(); const int Mrows = uni(M_); PH_IDS
#pragma unroll 1
    for (int rep = 0; rep < (PROBE_DUP == 6 ? 2 : 1); ++rep) vstats_pass(P, Mrows, lane, gw, NGW); }
__device__ NOINL void ph_spatial(int wv_, LAS unsigned char* lds_, int j_, int M_) { CP P = GETP(); LAS unsigned char* lds = uni_lds(lds_); const int j = uni(j_), Mrows = uni(M_); PH_IDS
#pragma unroll 1
    for (int rep = 0; rep < (PROBE_DUP == 6 ? 2 : 1); ++rep) spatial_phase(P, j, Mrows, lds, tid, lane, wid); }
__device__ NOINL void ph_mla_norm(int wv_) { CP P = GETP(); PH_IDS
#pragma unroll 1
    for (int rep = 0; rep < (PROBE_DUP == 6 ? 2 : 1); ++rep) mla_norm_pass(P, lane, gw, NGW); }
__device__ NOINL void ph_rope(int wv_, int which_) { CP P = GETP(); const int which = uni(which_); PH_IDS
    if (which == 0) rope_pass((bf16*)(P->ws + WS_QM), 3072, 128, 16, 192, lane, gw, NGW);
    else rope_pass((bf16*)(P->ws + WS_Z), 6144, 0, 64, 64, lane, gw, NGW); }
__device__ NOINL void ph_attn_mla(int wv_, LAS unsigned char* lds_) { CP P = GETP(); LAS unsigned char* lds = uni_lds(lds_); PH_IDS mla_attn_phase(P, lds, tid); if (PROBE_DUP == 2) mla_attn_phase(P, lds, tid); }
__device__ NOINL void ph_attn_da(int wv_, LAS unsigned char* lds_, int L_, bool ctx_q) { CP P = GETP(); LAS unsigned char* lds = uni_lds(lds_); const int L = uni(L_); PH_IDS
    const float* lp = P->in[26];
    const float s01 = wave_sum(lp[lane] * lp[64 + lane]), s23 = wave_sum(lp[128 + lane] * lp[192 + lane]);
    const float lam_init = 0.8f - 0.6f * expf(-0.3f * (float)L);
    const float lam = expf(s01) - expf(s23) + lam_init;
    da_attn_phase(P, lam, 1.0f - lam_init, lds, tid, ctx_q); if (PROBE_DUP == 2) da_attn_phase(P, lam, 1.0f - lam_init, lds, tid, ctx_q); }
__device__ NOINL void ph_route(int wv_, LAS unsigned char* lds_, int L_, int M_) { CP P = GETP(); LAS unsigned char* lds = uni_lds(lds_); const int L = uni(L_), Mrows = uni(M_); PH_IDS
#pragma unroll 1
    for (int rep = 0; rep < (PROBE_DUP == 4 ? 2 : 1); ++rep) route_phase(P, L, Mrows, lds, tid, lane, wid, gw, NGW); }
__device__ NOINL void ph_gather(int wv_, LAS unsigned char* lds_, int L_, int M_) { CP P = GETP(); LAS unsigned char* lds = uni_lds(lds_); const int L = uni(L_), Mrows = uni(M_); PH_IDS
    if (PROBE_DUP == 3) { gather_phase<0>(P, L, Mrows, lds, wid, lane, gw, NGW, true); }
    if (PROBE_DUP == 7) { gather_phase<1>(P, L, Mrows, lds, wid, lane, gw, NGW, true); }
    if (PROBE_DUP == 8) { gather_phase<2>(P, L, Mrows, lds, wid, lane, gw, NGW, true); }
    gather_phase<0>(P, L, Mrows, lds, wid, lane, gw, NGW); }

enum GemmId { G_GM_IN = 0, G_GM_OUT, G_MLA_IN, G_MLA_UQ, G_MLA_UKV, G_MLA_OUT, G_DA_IN, G_DA_OUT, G_PEER_Q };
__device__ NOINL void ph_gemm(int wv_, LAS unsigned char* lds_, int id_, int L_, int M_) {
    CP P = GETP(); LAS unsigned char* lds = uni_lds(lds_); const int id = uni(id_), L = uni(L_), Mrows = uni(M_); PH_IDS
    unsigned char* ws = P->ws; const int jj = L / 3;
    size_t a = WS_H, b = 0, o = 0; int M = MT, N = 2048, K = 2048, act = 0, rope = 0;
    switch (id) {
        case G_GM_IN:   a = WS_H;    b = WS_GMWIN + (size_t)jj * 4096 * 2048 * 2;  o = WS_Z;  M = Mrows; N = 4096; K = 2048; act = 1; break;
        case G_GM_OUT:  a = WS_G;    b = WS_GMWOUT + (size_t)jj * 2048 * 2048 * 2; o = WS_Y;  M = Mrows; N = 2048; K = 2048; break;
        case G_MLA_IN:  a = WS_H;    b = WS_MLAIN;  o = WS_C;  N = 1280; K = 2048; break;
        case G_MLA_UQ:  a = WS_CQN;  b = WS_MLAUQ;  o = WS_QM; N = 3072; K = 512;  rope = (ROPE_TEST == 2) ? 0 : 2; break;
        case G_MLA_UKV: a = WS_CKVN; b = WS_MLAUKV; o = WS_KV; N = 4096; K = 512;  break;
        case G_MLA_OUT: a = WS_G;    b = WS_MLAOUT; o = WS_Y;  N = 2048; K = 2048; break;
        case G_DA_IN:   a = WS_H;    b = WS_DAIN;   o = WS_Z;  N = 6144; K = 2048; rope = (ROPE_TEST == 1) ? 0 : 1; break;
        case G_DA_OUT:  a = WS_G;    b = WS_DAOUT;  o = WS_Y;  M = Mrows; N = 2048; K = 2048; break;
        default:        a = WS_H;    b = WS_PWQ + (size_t)L * 2048 * 2048 * 2;     o = WS_QP; M = Mrows; N = 2048; K = 2048; break;
    }
    pg8::Gemm g{(const pg8::bf16_t*)(ws + a), (const pg8::bf16_t*)(ws + b), M, N, K}; pg8::StaticOrder S; S.init(M, N, (int)gridDim.x, (int)blockIdx.x);
    pg8::EpiR E{(pg8::bf16_t*)(ws + o), N, act, rope, (const float*)(ws + WS_ROPE)};
#pragma unroll 1
    for (int rep = 0; rep < (PROBE_DUP == 1 ? 2 : 1); ++rep) { pg8::gemm_phase<pg8::EpiR, pg8::StaticOrder, true, true>((PG8_LAS unsigned char*)lds, g, S, E, tid); __syncthreads(); }
    const bool tail_u = (id == G_GM_OUT || id == G_MLA_OUT || id == G_DA_OUT), tail_v = (id == G_PEER_Q);
    if ((tail_u || tail_v) && L + 1 < NLAYER) {
        const int units = (M / 256) * (N / 256), G = (int)gridDim.x, tail = units % G, c = (int)blockIdx.x;
        const float* src = (tail_u ? P->in[11] : P->in[12]) + (size_t)(L + 1) * 16384 * 2048; unsigned char* dst = ws + (tail_u ? WS_PU : WS_PV) + (size_t)(L + 1) * 16384 * PROW;
        LAS float* scr = (LAS float*)(lds + wid * 16384);
        if (tail != 0 && c >= tail) cvt_table_fp6(src, dst, 16384, tail_u ? U_SCALE : V_SCALE, scr, lane, (c - tail) * NWAVES + wid, (G - tail) * NWAVES);
        else if (tail == 0) cvt_table_fp6(src, dst, 16384, tail_u ? U_SCALE : V_SCALE, scr, lane, gw, NGW);
    }
}

__global__ void __launch_bounds__(NWAVES * 64, 2) mk_fwd(Params Pv) {
    extern __shared__ __attribute__((aligned(16))) unsigned char lds_g[];
    LAS unsigned char* lds = (LAS unsigned char*)lds_g;
    const int wv = __builtin_amdgcn_readfirstlane((int)threadIdx.x >> 6);
    const int tid = wv * 64 + lane_id_fresh();
    for (int u = tid; u < (LDS_BYTES - RING_BYTES) / 4; u += NWAVES * 64) ((LAS unsigned*)(lds + RING_BYTES))[u] = 0u;
    __syncthreads();
    const int lo = Pv.ph_lo, hi = Pv.ph_hi;
    unsigned* barw = (unsigned*)(Pv.ws + WS_CTL) + CW_BAR;
    XcdBarrier bar; bar.bar = barw; bar.x = 0; bar.st = nullptr;
    if (hi - lo > 1) bar = xcd_barrier_post(barw, (volatile LAS unsigned*)(lds + MISC_OFF) + 8, tid == 0);
    int ph = 0;
#ifndef SEL
#define SELP(k) true
#else
#define SELP(k) ((k) == SEL)
#endif
    enum { RUN_BASE = __COUNTER__ + 1 };
#define RUN(call) do { if (SELP(__COUNTER__ - RUN_BASE) && ph >= lo && ph < hi) { call; } if (ph >= lo && ph + 1 < hi) xcd_barrier(bar, wv == 0 && lane_id_fresh() == 0); ++ph; } while (0)
    RUN(ph_prologue(wv, lds));
    RUN(ph_modreduce(wv));
    RUN(ph_first(wv));
#define LAYER(LL) do { constexpr int L = (LL); constexpr int kind = L % 3, jj = L / 3; constexpr int Mrows = (L == NLAYER - 1) ? ML : MT; \
        constexpr bool ctx_dead = (L == NLAYER - 2) && ((NLAYER - 1) % 3 == 0) && (kind != 0); constexpr int Mlive = ctx_dead ? ML : Mrows; \
        if (kind == 0) {                          \
            RUN(ph_gemm(wv, lds, G_GM_IN, L, Mrows)); \
            RUN(ph_vstats(wv, Mrows)); \
            RUN(ph_spatial(wv, lds, jj, Mrows)); \
            RUN(ph_gemm(wv, lds, G_GM_OUT, L, Mrows)); \
        } else if (kind == 1) {                   \
            RUN(ph_gemm(wv, lds, G_MLA_IN, L, Mrows)); \
            RUN(ph_mla_norm(wv)); \
            RUN(ph_gemm(wv, lds, G_MLA_UQ, L, Mrows); ph_gemm(wv, lds, G_MLA_UKV, L, Mrows)); \
            if (ROPE_TEST == 2) { RUN(ph_rope(wv, 0)); } \
            RUN(ph_attn_mla(wv, lds)); \
            RUN(ph_gemm(wv, lds, G_MLA_OUT, L, Mrows)); \
        } else {                                  \
            RUN(ph_gemm(wv, lds, G_DA_IN, L, Mrows); if (ROPE_TEST == 1) { __syncthreads(); } ); \
            if (ROPE_TEST == 1) { RUN(ph_rope(wv, 1)); } \
            RUN(ph_attn_da(wv, lds, L, !ctx_dead)); \
            RUN(ph_gemm(wv, lds, G_DA_OUT, L, Mlive)); \
        } \
        RUN(ph_postmix(wv, L, Mlive));                \
        RUN(ph_gemm(wv, lds, G_PEER_Q, L, Mlive));    \
        RUN(ph_route(wv, lds, L, Mlive));             \
        RUN(ph_gather(wv, lds, L, Mlive));            \
    } while (0)
    LAYER(0); LAYER(1); LAYER(2); LAYER(3);
#undef LAYER
#undef RUN
}

extern "C" void kernel_launch(void* const* d_in, const int* in_sizes, int n_in, void* d_out, int out_size, void* d_ws, size_t ws_size, hipStream_t stream) {
    static int grid = 0;
    if (grid == 0) {
        if (n_in != 29 || in_sizes[0] != ML * DM || out_size != ML * DM || ws_size < WS_END) {
            fprintf(stderr, "kernel_launch: shape mismatch: n_in %d in0 %d out %d ws %zu (need %zu); nothing launched\n", n_in, n_in > 0 ? in_sizes[0] : -1, out_size, ws_size, (size_t)WS_END); grid = -1; return; }
        int dev = 0, cus = 0, per_cu = 0;
        if (hipGetDevice(&dev) != hipSuccess || hipDeviceGetAttribute(&cus, hipDeviceAttributeMultiprocessorCount, dev) != hipSuccess) { fprintf(stderr, "kernel_launch: device query failed\n"); grid = -1; return; }
        if (hipFuncSetAttribute((const void*)mk_fwd, hipFuncAttributeMaxDynamicSharedMemorySize, LDS_BYTES) != hipSuccess) { fprintf(stderr, "kernel_launch: hipFuncSetAttribute failed\n"); grid = -1; return; }
        if (hipOccupancyMaxActiveBlocksPerMultiprocessor(&per_cu, (const void*)mk_fwd, NWAVES * 64, LDS_BYTES) != hipSuccess || per_cu < 1)
            fprintf(stderr, "kernel_launch: note: occupancy query reports %d workgroups per CU\n", per_cu);
        (void)hipGetLastError();
        grid = cus;
    }
    if (grid < 0) return;
    if (hipMemsetAsync((char*)d_ws + WS_CTL, 0, CTL_ZERO_BYTES, stream) != hipSuccess) { fprintf(stderr, "kernel_launch: memset failed\n"); return; }
    Params p{};
    for (int i = 0; i < 29; ++i) p.in[i] = (const float*)d_in[i];
    p.out = (float*)d_out; p.ws = (unsigned char*)d_ws;
#if MK_ONE_LAUNCH
    p.ph_lo = 0; p.ph_hi = NPH;
    hipLaunchKernelGGL(mk_fwd, dim3(grid), dim3(NWAVES * 64), LDS_BYTES, stream, p);
#else
    for (int li = 0; li < NPH; ++li) { p.ph_lo = li; p.ph_hi = li + 1; hipLaunchKernelGGL(mk_fwd, dim3(grid), dim3(NWAVES * 64), LDS_BYTES, stream, p); }
#endif
    const hipError_t le = hipPeekAtLastError();
    if (le != hipSuccess) fprintf(stderr, "kernel_launch: launch failed: %s\n", hipGetErrorName(le));
}
```

```cpp
#include <hip/hip_runtime.h>
#include <cstdio>
#include <cstdint>
#ifndef MK_ONE_LAUNCH
#define MK_ONE_LAUNCH 1
#endif
__device__ __forceinline__ int launder_v(int v) { asm volatile("" : "+v"(v)); return v; }
__device__ __forceinline__ int lane_id_fresh() { unsigned m = ~0u; asm volatile("" : "+s"(m)); return (int)__builtin_amdgcn_mbcnt_hi(m, __builtin_amdgcn_mbcnt_lo(m, 0u)); }
namespace pg8 {
#define PG8_LAS __attribute__((address_space(3)))
typedef unsigned short bf16_t;
typedef short bf16x8 __attribute__((ext_vector_type(8)));
typedef float f32x4 __attribute__((ext_vector_type(4)));
typedef unsigned u32x4 __attribute__((ext_vector_type(4)));
constexpr int BM = 256, BK = 64, HALF = 128, HTB = HALF * BK * 2  , STAGE_BYTES = 8 * HTB, NXCD = 8, WGM = 8;

__host__ __device__ __forceinline__ int lds_byte(int r, int c) { const int st = (r >> 4) * 2 + (c >> 5), rr = r & 15, cc = c & 31, ob = rr * 64 + cc * 2; return st * 1024 + (ob ^ (((ob >> 9) & 1) << 5)); }
__host__ __device__ __forceinline__ void stage_rc(int b, int& R, int& C) { const int st = b / 1024, sb = b % 1024, swz = sb ^ (((sb >> 9) & 1) << 5); R = (st >> 1) * 16 + swz / 64; C = (st & 1) * 32 + (swz % 64) / 2; }
__host__ __device__ __forceinline__ int perm32(int rho) { const int n = rho >> 4, i = rho & 15; return 8 * (i >> 2) + 4 * n + (i & 3); }

struct Unit { int pm, pn; };
struct Gemm { const bf16_t* A; const bf16_t* Bt; int M, N, K; };

struct StaticOrder {
    int nM, nN, nwg, G, c;
    __host__ __device__ void init(int M, int N, int G_, int c_) { nM = M / BM; nN = N / BM; nwg = nM * nN; G = G_; c = c_; }
    __host__ __device__ bool next(int i, Unit& u) const {
        const long L = (long)i * G + c; if (L >= nwg) return false;
        int wgid = (int)L; { const int q = nwg / NXCD, r = nwg % NXCD, xcd = wgid % NXCD, off = wgid / NXCD; wgid = (xcd < r ? xcd * (q + 1) : r * (q + 1) + (xcd - r) * q) + off; }
        const int nig = WGM * nN, gid = wgid / nig, fm = gid * WGM, gsz = (nM - fm) < WGM ? (nM - fm) : WGM;
        u.pm = fm + ((wgid % nig) % gsz); u.pn = (wgid % nig) / gsz; return true;
    }
    __device__ __forceinline__ void a_ready(const Unit&) const {}
    __device__ __forceinline__ void done(const Unit&) const {}
};

__device__ __forceinline__ unsigned cvt_pk_bf16(float lo, float hi) { unsigned r; asm volatile("v_cvt_pk_bf16_f32 %0, %1, %2" : "=v"(r) : "v"(lo), "v"(hi)); return r; }
typedef float f32x2 __attribute__((ext_vector_type(2)));
__device__ __forceinline__ f32x2 gelu_pk(f32x2 v) {
    const f32x2 av = __builtin_elementwise_abs(v), d = av * 0.2316418882f + 1.0f;
    f32x2 t; t.x = __builtin_amdgcn_rcpf(d.x); t.y = __builtin_amdgcn_rcpf(d.y);
    f32x2 q = t * 0.5307027145f + (-0.7265760135f); q = q * t + 0.7107068705f; q = q * t + (-0.142248368f); q = q * t + 0.127414796f; q = q * t;
    const f32x2 s = (v * v) * (-0.72134752044f);
    f32x2 e; e.x = __builtin_amdgcn_exp2f(s.x); e.y = __builtin_amdgcn_exp2f(s.y);
    const f32x2 m = v * (q * e), r = v - m;
    f32x2 o; o.x = v.x < 0.f ? m.x : r.x; o.y = v.y < 0.f ? m.y : r.y; return o;
}

template <int ACT  > struct EpiBf16 {
    static constexpr bool PERM = true, AFTER_DRAIN = false; static_assert(ACT == 0 || ACT == 1, "EpiBf16: ACT is 0 (none) or 1 (gelu_pk)");
    bf16_t* O; int ldc; const float* bias; int split_cols; size_t split_stride; float scale0;
    __device__ __forceinline__ void operator()(const f32x4 (&acc)[2][2][4][2], const Unit& u, int wr, int wc, int fr, int fq) const {
        const int row0 = u.pm * BM + wr * 64 + fr; int colt = u.pn * BM; bf16_t* base = O;
        float sc = 1.f; if (split_cols) { const int t = colt / split_cols; base += (size_t)t * split_stride; colt -= t * split_cols; if (t == 0) sc = scale0; }
        const int col0 = colt + wc * 32 + 8 * fq, bcol0 = u.pn * BM + wc * 32 + 8 * fq;
        f32x4 bv[2][2];
#pragma unroll
        for (int bj = 0; bj < 2; ++bj)
#pragma unroll
            for (int n = 0; n < 2; ++n) bv[bj][n] = bias ? *(const f32x4*)(bias + bcol0 + bj * HALF + 4 * n) : (f32x4){0.f, 0.f, 0.f, 0.f};
#pragma unroll
        for (int ai = 0; ai < 2; ++ai)
#pragma unroll
            for (int m = 0; m < 4; ++m) { bf16_t* rowp = base + (size_t)(row0 + ai * HALF + m * 16) * ldc + col0;
#pragma unroll
                for (int bj = 0; bj < 2; ++bj) { f32x4 v0 = acc[ai][bj][m][0] + bv[bj][0], v1 = acc[ai][bj][m][1] + bv[bj][1];
                    if (ACT == 1) { f32x2 a = gelu_pk((f32x2){v0[0], v0[1]}), b = gelu_pk((f32x2){v0[2], v0[3]}), c = gelu_pk((f32x2){v1[0], v1[1]}), d = gelu_pk((f32x2){v1[2], v1[3]});
                        v0 = (f32x4){a.x, a.y, b.x, b.y}; v1 = (f32x4){c.x, c.y, d.x, d.y}; }
                    v0 = v0 * sc; v1 = v1 * sc; u32x4 w; w.x = cvt_pk_bf16(v0[0], v0[1]); w.y = cvt_pk_bf16(v0[2], v0[3]); w.z = cvt_pk_bf16(v1[0], v1[1]); w.w = cvt_pk_bf16(v1[2], v1[3]);
                    *(u32x4*)(rowp + bj * HALF) = w; } }
    }
};
template <class Epi, class Sched, bool ALIGN_EPI = false, bool SP2 = false>
__device__ __forceinline__ void gemm_phase(PG8_LAS unsigned char* lds, const Gemm g, const Sched& S, const Epi& E, const int tid_in) {
    const int tid = launder_v(tid_in) & 511, wid = __builtin_amdgcn_readfirstlane(tid >> 6), lane = tid & 63, wr = wid >> 2, wc = wid & 3, fr = lane & 15, fq = lane >> 4;
    const int K = g.K, nt = K / BK;
    unsigned voffA[2], voffB[2];
#pragma unroll
    for (int i = 0; i < 2; ++i) { int R, C; stage_rc(tid * 16 + i * 8192, R, C); const int Rb = Epi::PERM ? ((R & ~31) + perm32(R & 31)) : R;
        voffA[i] = (unsigned)(R * K + C) * 2u; voffB[i] = (unsigned)(Rb * K + C) * 2u; }
    const size_t kstep = (size_t)(BK * 2);
    const size_t hstep = (size_t)HALF * K * 2;
    const size_t tstep = 2 * hstep;
    const unsigned ldsw = (unsigned)wid * 1024u;
    const int aoff = lds_byte(wr * 64 + fr, fq * 8), boff = lds_byte(wc * 32 + fr, fq * 8);
#define PG8_SA(b, h) (((b) * 2 + (h)) * HTB)
#define PG8_SB(b, h) ((4 + (b) * 2 + (h)) * HTB)
#define PG8_STAGE(bufoff, gbase, voff) do { _Pragma("unroll") for (int _i = 0; _i < 2; ++_i) \
        __builtin_amdgcn_global_load_lds((const unsigned*)((const char*)(gbase) + (voff)[_i]), (PG8_LAS unsigned*)(lds + (bufoff) + ldsw + _i * 8192), 16, 0, 0); } while (0)
#define PG8_LDA(dst, b, h) do { _Pragma("unroll") for (int m = 0; m < 4; ++m) _Pragma("unroll") for (int k = 0; k < 2; ++k) dst[m][k] = *(const PG8_LAS bf16x8*)(lds + PG8_SA(b, h) + aoff + m * 2048 + k * 1024); } while (0)
#define PG8_LDB(dst, b, h) do { _Pragma("unroll") for (int n = 0; n < 2; ++n) _Pragma("unroll") for (int k = 0; k < 2; ++k) dst[n][k] = *(const PG8_LAS bf16x8*)(lds + PG8_SB(b, h) + boff + n * 2048 + k * 1024); } while (0)
#define PG8_MMA(ai, bj, At, Bt) do { __builtin_amdgcn_s_setprio(1); _Pragma("unroll") for (int m = 0; m < 4; ++m) _Pragma("unroll") for (int n = 0; n < 2; ++n) _Pragma("unroll") for (int k = 0; k < 2; ++k) \
        acc[ai][bj][m][n] = __builtin_amdgcn_mfma_f32_16x16x32_bf16(Bt[n][k], At[m][k], acc[ai][bj][m][n], 0, 0, 0); __builtin_amdgcn_s_setprio(0); } while (0)
#define PG8_WAIT_V(n) asm volatile("s_waitcnt vmcnt(" #n ")" ::: "memory")
#define PG8_WAIT_L(n) asm volatile("s_waitcnt lgkmcnt(" #n ")" ::: "memory")
#define PG8_BAR __builtin_amdgcn_s_barrier()
#define PG8_SCHED __builtin_amdgcn_sched_barrier(0)
    Unit cur, nxt; int ui = 0;
    if (!S.next(0, cur)) return;
    f32x4 acc[2][2][4][2];
#pragma unroll
    for (int a = 0; a < 2; ++a)
#pragma unroll
        for (int b = 0; b < 2; ++b)
#pragma unroll
            for (int m = 0; m < 4; ++m)
#pragma unroll
                for (int n = 0; n < 2; ++n) acc[a][b][m][n] = (f32x4){0.f, 0.f, 0.f, 0.f};
    bf16x8 At[4][2], B0[2][2], B1[2][2];
    const char* cA = (const char*)g.A + (size_t)cur.pm * tstep; const char* cB = (const char*)g.Bt + (size_t)cur.pn * tstep;
    S.a_ready(cur);
    if constexpr (SP2) {
        PG8_STAGE(PG8_SB(0, 0), cB, voffB); PG8_STAGE(PG8_SB(0, 1), cB + hstep, voffB); PG8_STAGE(PG8_SA(0, 0), cA, voffA); PG8_STAGE(PG8_SA(0, 1), cA + hstep, voffA);
        if (wr == 1) PG8_BAR;
        PG8_WAIT_V(2); PG8_BAR;
        PG8_STAGE(PG8_SB(1, 0), cB + kstep, voffB); PG8_STAGE(PG8_SA(1, 0), cA + kstep, voffA); PG8_STAGE(PG8_SB(1, 1), cB + hstep + kstep, voffB);
        PG8_WAIT_V(6); PG8_BAR;
    } else {
        PG8_STAGE(PG8_SB(0, 0), cB, voffB); PG8_STAGE(PG8_SA(0, 0), cA, voffA); PG8_STAGE(PG8_SB(0, 1), cB + hstep, voffB); PG8_STAGE(PG8_SA(0, 1), cA + hstep, voffA);
        if (wr == 1) PG8_BAR;
        PG8_WAIT_V(4); PG8_BAR;
        PG8_STAGE(PG8_SB(1, 0), cB + kstep, voffB); PG8_STAGE(PG8_SA(1, 0), cA + kstep, voffA); PG8_STAGE(PG8_SB(1, 1), cB + hstep + kstep, voffB);
        PG8_WAIT_V(6); PG8_BAR;
    }
    for (;;) {
        const bool has_next = S.next(ui + 1, nxt);
        const char* nA = has_next ? (const char*)g.A + (size_t)nxt.pm * tstep : cA; const char* nB = has_next ? (const char*)g.Bt + (size_t)nxt.pn * tstep : cB;
        for (int t = 0; t < nt; t += 2) {
            const bool last = (t == nt - 2);
            const char* a1 = cA + (size_t)(t + 1) * kstep;
            const char* a2 = last ? nA : cA + (size_t)(t + 2) * kstep; const char* b2 = last ? nB : cB + (size_t)(t + 2) * kstep;
            const char* a3 = a2 + kstep; const char* b3 = b2 + kstep;
            if (last && has_next) S.a_ready(nxt);
            if constexpr (SP2) {
            PG8_LDB(B0, 0, 0); PG8_LDB(B1, 0, 1); PG8_SCHED; PG8_LDA(At, 0, 0); PG8_STAGE(PG8_SA(1, 1), a1 + hstep, voffA);
            PG8_WAIT_V(8); PG8_WAIT_L(0); PG8_BAR; PG8_MMA(0, 0, At, B0); PG8_MMA(0, 1, At, B1); PG8_BAR; PG8_SCHED;
            PG8_LDA(At, 0, 1); PG8_STAGE(PG8_SB(0, 0), b2, voffB); PG8_STAGE(PG8_SB(0, 1), b2 + hstep, voffB); PG8_STAGE(PG8_SA(0, 0), a2, voffA);
            PG8_WAIT_V(8); PG8_WAIT_L(0); PG8_BAR; PG8_MMA(1, 0, At, B0); PG8_MMA(1, 1, At, B1); PG8_BAR; PG8_SCHED;
            PG8_LDB(B0, 1, 0); PG8_LDB(B1, 1, 1); PG8_SCHED; PG8_LDA(At, 1, 0); PG8_STAGE(PG8_SA(0, 1), a2 + hstep, voffA);
            PG8_WAIT_V(8); PG8_WAIT_L(0); PG8_BAR; PG8_MMA(0, 0, At, B0); PG8_MMA(0, 1, At, B1); PG8_BAR; PG8_SCHED;
            PG8_LDA(At, 1, 1); PG8_STAGE(PG8_SB(1, 0), b3, voffB); PG8_STAGE(PG8_SB(1, 1), b3 + hstep, voffB); PG8_STAGE(PG8_SA(1, 0), a3, voffA);
            PG8_WAIT_V(8); PG8_WAIT_L(0); PG8_BAR; PG8_MMA(1, 0, At, B0); PG8_MMA(1, 1, At, B1); PG8_BAR; PG8_SCHED;
            } else {
            PG8_LDB(B0, 0, 0); PG8_SCHED; PG8_LDA(At, 0, 0); PG8_STAGE(PG8_SA(1, 1), a1 + hstep, voffA);
            PG8_WAIT_L(8); PG8_BAR; PG8_WAIT_L(0); PG8_MMA(0, 0, At, B0); PG8_BAR; PG8_SCHED;
            PG8_LDB(B1, 0, 1); PG8_STAGE(PG8_SB(0, 0), b2, voffB);
            PG8_BAR; PG8_WAIT_L(0); PG8_MMA(0, 1, At, B1); PG8_BAR;
            PG8_LDA(At, 0, 1); PG8_STAGE(PG8_SA(0, 0), a2, voffA);
            PG8_BAR; PG8_WAIT_L(0); PG8_MMA(1, 0, At, B0); PG8_BAR; PG8_SCHED;
            PG8_STAGE(PG8_SB(0, 1), b2 + hstep, voffB);
            PG8_WAIT_V(6); PG8_BAR; PG8_MMA(1, 1, At, B1); PG8_BAR;
            PG8_LDB(B0, 1, 0); PG8_SCHED; PG8_LDA(At, 1, 0); PG8_STAGE(PG8_SA(0, 1), a2 + hstep, voffA);
            PG8_WAIT_L(8); PG8_BAR; PG8_WAIT_L(0); PG8_MMA(0, 0, At, B0); PG8_BAR; PG8_SCHED;
            PG8_LDB(B1, 1, 1); PG8_STAGE(PG8_SB(1, 0), b3, voffB);
            PG8_BAR; PG8_WAIT_L(0); PG8_MMA(0, 1, At, B1); PG8_BAR;
            PG8_LDA(At, 1, 1); PG8_STAGE(PG8_SA(1, 0), a3, voffA);
            PG8_BAR; PG8_WAIT_L(0); PG8_MMA(1, 0, At, B0); PG8_BAR; PG8_SCHED;
            PG8_STAGE(PG8_SB(1, 1), b3 + hstep, voffB);
            PG8_WAIT_V(6); PG8_BAR; PG8_MMA(1, 1, At, B1); PG8_BAR;
            }
        }
        if constexpr (ALIGN_EPI) { if (wr == 0) PG8_BAR; }
        if constexpr (!Epi::AFTER_DRAIN) { E(acc, cur, wr, wc, fr, fq); S.done(cur); }
        if (!has_next) break;
#pragma unroll
        for (int a = 0; a < 2; ++a)
#pragma unroll
            for (int b = 0; b < 2; ++b)
#pragma unroll
                for (int m = 0; m < 4; ++m)
#pragma unroll
                    for (int n = 0; n < 2; ++n) acc[a][b][m][n] = (f32x4){0.f, 0.f, 0.f, 0.f};
        cur = nxt; cA = nA; cB = nB; ++ui;
        if constexpr (ALIGN_EPI) { if (wr == 1) PG8_BAR; }
    }
    PG8_WAIT_V(0);
    if constexpr (!ALIGN_EPI) { if (wr == 0) PG8_BAR; }
    PG8_BAR;
    if constexpr (Epi::AFTER_DRAIN) { E.fused(acc, cur, wr, wc, fr, fq, lds, wid, lane); S.done(cur); }
#undef PG8_SA
#undef PG8_SB
#undef PG8_STAGE
#undef PG8_LDA
#undef PG8_LDB
#undef PG8_MMA
#undef PG8_WAIT_V
#undef PG8_WAIT_L
#undef PG8_BAR
#undef PG8_SCHED
}
}

namespace pg8 {
__device__ __forceinline__ float gelu_tanh(float x) {
    const float t = x * (1.5957691216057308f + 0.07135481627f * x * x);
    const float e = __builtin_amdgcn_exp2f(-1.4426950408889634f * t);
    return x * __builtin_amdgcn_rcpf(1.0f + e);
}
template <int ACT> struct EpiT {
    static constexpr bool PERM = true, AFTER_DRAIN = false;
    bf16_t* O; int ldc;
    __device__ __forceinline__ void operator()(const f32x4 (&acc)[2][2][4][2], const Unit& u, int wr, int wc, int fr, int fq) const {
        const int row0 = u.pm * BM + wr * 64 + fr; const int col0 = u.pn * BM + wc * 32 + 8 * fq;
#pragma unroll
        for (int ai = 0; ai < 2; ++ai)
#pragma unroll
            for (int m = 0; m < 4; ++m) { bf16_t* rowp = O + (size_t)(row0 + ai * HALF + m * 16) * ldc + col0;
#pragma unroll
                for (int bj = 0; bj < 2; ++bj) { f32x4 v0 = acc[ai][bj][m][0], v1 = acc[ai][bj][m][1];
                    if (ACT == 2) { v0 = (f32x4){gelu_tanh(v0[0]), gelu_tanh(v0[1]), gelu_tanh(v0[2]), gelu_tanh(v0[3])}; v1 = (f32x4){gelu_tanh(v1[0]), gelu_tanh(v1[1]), gelu_tanh(v1[2]), gelu_tanh(v1[3])}; }
                    u32x4 w; w.x = cvt_pk_bf16(v0[0], v0[1]); w.y = cvt_pk_bf16(v0[2], v0[3]); w.z = cvt_pk_bf16(v1[0], v1[1]); w.w = cvt_pk_bf16(v1[2], v1[3]);
                    *(u32x4*)(rowp + bj * HALF) = w; } }
    }
};
struct EpiR {
    static constexpr bool PERM = true, AFTER_DRAIN = false;
    bf16_t* O; int ldc; int act; int rope; const float* ropet;
    __device__ __forceinline__ void operator()(const f32x4 (&acc)[2][2][4][2], const Unit& u, int wr, int wc, int fr, int fq) const {
        const int row0 = u.pm * BM + wr * 64 + fr; const int col0 = u.pn * BM + wc * 32 + 8 * fq;
        const bool rrows = rope != 0 && u.pm < 64;
#pragma unroll
        for (int ai = 0; ai < 2; ++ai)
#pragma unroll
            for (int m = 0; m < 4; ++m) { const int grow = row0 + ai * HALF + m * 16; bf16_t* rowp = O + (size_t)grow * ldc + col0;
#pragma unroll
                for (int bj = 0; bj < 2; ++bj) { f32x4 v0 = acc[ai][bj][m][0], v1 = acc[ai][bj][m][1];
                    if (act) { v0 = (f32x4){gelu_tanh(v0[0]), gelu_tanh(v0[1]), gelu_tanh(v0[2]), gelu_tanh(v0[3])}; v1 = (f32x4){gelu_tanh(v1[0]), gelu_tanh(v1[1]), gelu_tanh(v1[2]), gelu_tanh(v1[3])}; }
                    if (rrows) { const int blk = u.pn * 8 + bj * 4 + wc; const int b6 = blk % 6; const bool on = rope == 1 ? (blk < 128) : (b6 >= 4); const int half = rope == 1 ? (blk & 1) : (b6 - 4);
                        if (on) { const int t = grow & 8191; const int pos = half ? (t & 63) : (t >> 6);
                            const float* cp = ropet + pos * 16 + 8 * (fq & 1); const f32x4 c0 = *(const f32x4*)cp, c1 = *(const f32x4*)(cp + 4), s0 = *(const f32x4*)(cp + 2048), s1 = *(const f32x4*)(cp + 2052);
                            f32x4 p0, p1;
#pragma unroll
                            for (int i = 0; i < 4; ++i) { const float a_ = v0[i], b_ = v1[i];
                                const auto r0 = __builtin_amdgcn_permlane32_swap(__float_as_uint(a_), __float_as_uint(a_), false, false);
                                const auto r1 = __builtin_amdgcn_permlane32_swap(__float_as_uint(b_), __float_as_uint(b_), false, false);
                                const unsigned x0_ = (fq & 2) ? r0[0] : r0[1], x1_ = (fq & 2) ? r1[0] : r1[1]; p0[i] = __uint_as_float(x0_); p1[i] = __uint_as_float(x1_); }
                            if (fq & 2) { v0 = p0 * s0 + v0 * c0; v1 = p1 * s1 + v1 * c1; } else { v0 = v0 * c0 - p0 * s0; v1 = v1 * c1 - p1 * s1; } } }
                    u32x4 w; w.x = cvt_pk_bf16(v0[0], v0[1]); w.y = cvt_pk_bf16(v0[2], v0[3]); w.z = cvt_pk_bf16(v1[0], v1[1]); w.w = cvt_pk_bf16(v1[2], v1[3]);
                    *(u32x4*)(rowp + bj * HALF) = w; } }
    }
};
}

constexpr int DM = 2048, NBATCH = 2, SEQ = 8192, CTXL = 256;
constexpr int ML = NBATCH * SEQ;
constexpr int MC = NBATCH * CTXL;
constexpr int MT = ML + MC;
constexpr int NLAYER = 4;
constexpr float ALPHA = 1.6817928305074290f, LN_EPS = 1e-6f;
constexpr int NWAVES = 8;
constexpr float U_SCALE = 64.0f, V_SCALE = 4.0f;
constexpr int PROW = 1536;
constexpr int PREC = 2 * PROW;
constexpr int NPH = 35;

constexpr size_t MiB = 1ull << 20;
constexpr size_t WS_CTL = 0, CTL_ZERO_BYTES = 1 * MiB;
constexpr int    CW_BAR = 4096;
constexpr size_t WS_MOD = 128 * 1024;
constexpr size_t WS_VST = 1 * MiB;
constexpr size_t WS_ROPE = 1 * MiB + 160 * 1024;
constexpr size_t WS_MODP = 1 * MiB + 256 * 1024;
constexpr size_t WS_GMWIN = 6 * MiB;
constexpr size_t WS_GMWOUT = WS_GMWIN + 32 * MiB;
constexpr size_t WS_GMWS = WS_GMWOUT + 16 * MiB;
constexpr size_t WS_PWQ = WS_GMWS + 1 * MiB;
constexpr size_t WS_PK1 = WS_PWQ + 32 * MiB;
constexpr size_t WS_PK2 = WS_PK1 + 512 * 1024;
constexpr size_t WS_MLAIN = WS_PK1 + 1 * MiB;
constexpr size_t WS_MLAUQ = WS_MLAIN + 5 * MiB;
constexpr size_t WS_MLAUKV = WS_MLAUQ + 3 * MiB;
constexpr size_t WS_MLAOUT = WS_MLAUKV + 4 * MiB;
constexpr size_t WS_DAIN = WS_MLAOUT + 8 * MiB;
constexpr size_t WS_DAOUT = WS_DAIN + 24 * MiB;
constexpr size_t WS_PU = WS_DAOUT + 8 * MiB;
constexpr size_t WS_PV = WS_PU + 96 * MiB;
constexpr size_t WS_X = WS_PV + 96 * MiB;
constexpr size_t WS_H = WS_X + 66 * MiB;
constexpr size_t WS_G = WS_H + 66 * MiB;
constexpr size_t WS_Y = WS_G + 66 * MiB;
constexpr size_t WS_QP = WS_Y + 66 * MiB;
constexpr size_t WS_Z = WS_QP + 66 * MiB;
constexpr size_t WS_C = WS_Z + 198 * MiB;
constexpr size_t WS_CQN = WS_C + 42 * MiB;
constexpr size_t WS_CKVN = WS_CQN + 17 * MiB;
constexpr size_t WS_KR = WS_CKVN + 17 * MiB;
constexpr size_t WS_QM = WS_KR + 3 * MiB;
constexpr size_t WS_KV = WS_QM + 99 * MiB;
constexpr size_t WS_ROUTE = WS_KV + 132 * MiB;
constexpr size_t WS_END = WS_ROUTE + 17 * MiB;
static_assert((size_t)MT * DM * 2 == 66 * MiB, "row buffer size");

constexpr int RING_BYTES = 155648, MISC_OFF = RING_BYTES + 320, LDS_BYTES = 159744;

#define GAS __attribute__((address_space(1)))
#define LAS __attribute__((address_space(3)))
typedef unsigned short bf16;
typedef unsigned u32x4 __attribute__((ext_vector_type(4)));
typedef unsigned u32x2 __attribute__((ext_vector_type(2)));
typedef float f32x4 __attribute__((ext_vector_type(4)));
typedef float f32x16 __attribute__((ext_vector_type(16)));
typedef short bf16x8 __attribute__((ext_vector_type(8)));
typedef short s16x4 __attribute__((ext_vector_type(4)));
#define LDS_WAIT() asm volatile("s_waitcnt lgkmcnt(0)" ::: "memory")

__device__ __forceinline__ unsigned cvtpk(float lo, float hi) { unsigned r; asm("v_cvt_pk_bf16_f32 %0, %1, %2" : "=v"(r) : "v"(lo), "v"(hi)); return r; }
__device__ __forceinline__ float bflo(unsigned w) { return __uint_as_float(w << 16); }
__device__ __forceinline__ float bfhi(unsigned w) { return __uint_as_float(w & 0xffff0000u); }
__device__ __forceinline__ float bf1(bf16 b) { return __uint_as_float((unsigned)b << 16); }
__device__ __forceinline__ bf16 tobf1(float f) { return (bf16)(cvtpk(f, 0.f) & 0xffffu); }
#define DPP_F(v, ctrl) __int_as_float(__builtin_amdgcn_mov_dpp(__float_as_int(v), (ctrl), 0xF, 0xF, true))
__device__ __forceinline__ float row_sum16(float v) { v += DPP_F(v, 0xB1); v += DPP_F(v, 0x4E); v += DPP_F(v, 0x141); v += DPP_F(v, 0x140); return v; }
__device__ __forceinline__ float sum_xor16(float v) { const auto r = __builtin_amdgcn_permlane16_swap(__float_as_uint(v), __float_as_uint(v), false, false); return __uint_as_float(r[0]) + __uint_as_float(r[1]); }
__device__ __forceinline__ float sum_xor32(float v) { const auto r = __builtin_amdgcn_permlane32_swap(__float_as_uint(v), __float_as_uint(v), false, false); return __uint_as_float(r[0]) + __uint_as_float(r[1]); }
__device__ __forceinline__ float wave_sum(float v) { return sum_xor32(sum_xor16(row_sum16(v))); }
__device__ __forceinline__ float half_sum32(float v) { return sum_xor16(row_sum16(v)); }
__device__ __forceinline__ float lane_xor16(float v, int lane) { const auto r = __builtin_amdgcn_permlane16_swap(__float_as_uint(v), __float_as_uint(v), false, false); return __uint_as_float((lane & 16) ? r[0] : r[1]); }
__device__ __forceinline__ unsigned lane_xor32(unsigned v, int lane) { const auto r = __builtin_amdgcn_permlane32_swap(v, v, false, false); return (lane & 32) ? r[0] : r[1]; }
__device__ __forceinline__ float gelu_tanh(float x) { return pg8::gelu_tanh(x); }

__device__ __forceinline__ void load_row_bf16(const bf16* row, int lane, float (&v)[32]) {
#pragma unroll
    for (int j = 0; j < 4; ++j) { const u32x4 w = ((const u32x4*)row)[64 * j + lane];
        v[8 * j + 0] = bflo(w.x); v[8 * j + 1] = bfhi(w.x); v[8 * j + 2] = bflo(w.y); v[8 * j + 3] = bfhi(w.y);
        v[8 * j + 4] = bflo(w.z); v[8 * j + 5] = bfhi(w.z); v[8 * j + 6] = bflo(w.w); v[8 * j + 7] = bfhi(w.w); }
}
__device__ __forceinline__ void store_row_bf16(bf16* row, int lane, const float (&v)[32]) {
#pragma unroll
    for (int j = 0; j < 4; ++j) { u32x4 w; w.x = cvtpk(v[8 * j + 0], v[8 * j + 1]); w.y = cvtpk(v[8 * j + 2], v[8 * j + 3]); w.z = cvtpk(v[8 * j + 4], v[8 * j + 5]); w.w = cvtpk(v[8 * j + 6], v[8 * j + 7]);
        ((u32x4*)row)[64 * j + lane] = w; }
}
__device__ __forceinline__ void load_row_f32(const float* row, int lane, float (&v)[32]) {
#pragma unroll
    for (int j = 0; j < 4; ++j) { const f32x4 a = ((const f32x4*)row)[128 * j + 2 * lane], b = ((const f32x4*)row)[128 * j + 2 * lane + 1];
        v[8 * j + 0] = a.x; v[8 * j + 1] = a.y; v[8 * j + 2] = a.z; v[8 * j + 3] = a.w; v[8 * j + 4] = b.x; v[8 * j + 5] = b.y; v[8 * j + 6] = b.z; v[8 * j + 7] = b.w; }
}
__device__ __forceinline__ void store_row_f32(float* row, int lane, const float (&v)[32]) {
#pragma unroll
    for (int j = 0; j < 4; ++j) { ((f32x4*)row)[128 * j + 2 * lane] = (f32x4){v[8 * j + 0], v[8 * j + 1], v[8 * j + 2], v[8 * j + 3]};
        ((f32x4*)row)[128 * j + 2 * lane + 1] = (f32x4){v[8 * j + 4], v[8 * j + 5], v[8 * j + 6], v[8 * j + 7]}; }
}
__device__ __forceinline__ void load_row_bf16_b(const bf16* row, int lane, float (&v)[32]) {
#pragma unroll
    for (int j = 0; j < 4; ++j) { const u32x4 w = ((const u32x4*)row)[4 * lane + j];
        v[8 * j + 0] = bflo(w.x); v[8 * j + 1] = bfhi(w.x); v[8 * j + 2] = bflo(w.y); v[8 * j + 3] = bfhi(w.y);
        v[8 * j + 4] = bflo(w.z); v[8 * j + 5] = bfhi(w.z); v[8 * j + 6] = bflo(w.w); v[8 * j + 7] = bfhi(w.w); }
}
__device__ __forceinline__ void store_row_bf16_b(bf16* row, int lane, const float (&v)[32]) {
#pragma unroll
    for (int j = 0; j < 4; ++j) { u32x4 w; w.x = cvtpk(v[8 * j + 0], v[8 * j + 1]); w.y = cvtpk(v[8 * j + 2], v[8 * j + 3]); w.z = cvtpk(v[8 * j + 4], v[8 * j + 5]); w.w = cvtpk(v[8 * j + 6], v[8 * j + 7]);
        ((u32x4*)row)[4 * lane + j] = w; }
}
__device__ __forceinline__ void load_row_f32_b(const float* row, int lane, float (&v)[32]) {
#pragma unroll
    for (int q = 0; q < 8; ++q) { const f32x4 a = ((const f32x4*)row)[8 * lane + q];
        v[4 * q + 0] = a.x; v[4 * q + 1] = a.y; v[4 * q + 2] = a.z; v[4 * q + 3] = a.w; }
}
__device__ __forceinline__ void store_row_f32_b(float* row, int lane, const float (&v)[32]) {
#pragma unroll
    for (int q = 0; q < 8; ++q) ((f32x4*)row)[8 * lane + q] = (f32x4){v[4 * q + 0], v[4 * q + 1], v[4 * q + 2], v[4 * q + 3]};
}
__device__ __forceinline__ void ln_stats(const float (&v)[32], float& mean, float& rstd) {
    float s = 0.f;
#pragma unroll
    for (int i = 0; i < 32; ++i) s += v[i];
    mean = wave_sum(s) * (1.0f / DM);
    float q = 0.f;
#pragma unroll
    for (int i = 0; i < 32; ++i) { const float d = v[i] - mean; q += d * d; }
    rstd = 1.0f / sqrtf(wave_sum(q) * (1.0f / DM) + LN_EPS);
}
template <bool LAYB>
__device__ __forceinline__ void finish_row(float (&z)[32], const float* lng, const float* lnb, bf16* Xrow, const float* sh, const float* sc, bf16* Hrow, float* Orow, int lane) {
    float mean, rstd; ln_stats(z, mean, rstd);
    { float g[32], b[32]; if (LAYB) { load_row_f32_b(lng, lane, g); load_row_f32_b(lnb, lane, b); } else { load_row_f32(lng, lane, g); load_row_f32(lnb, lane, b); }
#pragma unroll
      for (int i = 0; i < 32; ++i) z[i] = (z[i] - mean) * rstd * g[i] + b[i]; }
    if (Xrow) { if (LAYB) store_row_bf16_b(Xrow, lane, z); else store_row_bf16(Xrow, lane, z); }
    if (Orow) { if (LAYB) store_row_f32_b(Orow, lane, z); else store_row_f32(Orow, lane, z); }
    if (Hrow) {
        ln_stats(z, mean, rstd);
        float a[32], s[32]; if (LAYB) { load_row_f32_b(sc, lane, a); load_row_f32_b(sh, lane, s); } else { load_row_f32(sc, lane, a); load_row_f32(sh, lane, s); }
#pragma unroll
        for (int i = 0; i < 32; ++i) a[i] = (z[i] - mean) * rstd * (1.0f + a[i]) + s[i];
        if (LAYB) store_row_bf16_b(Hrow, lane, a); else store_row_bf16(Hrow, lane, a);
    }
}
__device__ __forceinline__ int row_slot(int row) { return row < ML ? (row >> 13) : 2; }

__device__ __forceinline__ unsigned f2bf_rne(float f) { unsigned u = __float_as_uint(f); return (u + 0x7fffu + ((u >> 16) & 1u)) >> 16; }
__device__ __forceinline__ unsigned pk2(float lo, float hi) { return f2bf_rne(lo) | (f2bf_rne(hi) << 16); }
__device__ __forceinline__ void p0_transpose_item(const float* W, int K, int N, bf16* WT, LAS float* scr, int item, int lane) {
    const int nblk = N / 32, kb = item / nblk, nb = item % nblk, k0 = 64 * kb, n0 = 32 * nb;
    f32x4 t[8];
#pragma unroll
    for (int i = 0; i < 8; ++i) t[i] = *(const f32x4*)(W + (size_t)(k0 + 8 * i + (lane >> 3)) * N + n0 + 4 * (lane & 7));
#pragma unroll
    for (int i = 0; i < 8; ++i) { LAS float* d = scr + (8 * i + (lane >> 3)) * 33 + 4 * (lane & 7); d[0] = t[i].x; d[1] = t[i].y; d[2] = t[i].z; d[3] = t[i].w; }
    LDS_WAIT(); asm volatile("" ::: "memory");
    const int c = lane & 7;
#pragma unroll
    for (int j = 0; j < 4; ++j) { const int n = (lane >> 3) + 8 * j; const LAS float* s = scr + (8 * c) * 33 + n;
        u32x4 o; o.x = pk2(s[0 * 33], s[1 * 33]); o.y = pk2(s[2 * 33], s[3 * 33]); o.z = pk2(s[4 * 33], s[5 * 33]); o.w = pk2(s[6 * 33], s[7 * 33]);
        *(u32x4*)(WT + (size_t)(n0 + n) * K + k0 + 8 * c) = o; }
    LDS_WAIT(); asm volatile("" ::: "memory");
}
__device__ __forceinline__ void cvt_range(const float* src, bf16* dst, size_t n8, size_t gtid, size_t gthreads) {
#pragma unroll 4
    for (size_t i = gtid; i < n8; i += gthreads) { const f32x4 a = ((const f32x4*)src)[2 * i], b = ((const f32x4*)src)[2 * i + 1];
        u32x4 w; w.x = cvtpk(a.x, a.y); w.y = cvtpk(a.z, a.w); w.z = cvtpk(b.x, b.y); w.w = cvtpk(b.z, b.w); ((u32x4*)dst)[i] = w; }
}
__device__ __forceinline__ unsigned enc_e2m3(float x) {
    const unsigned sgn = (__float_as_uint(x) >> 26) & 32u;
    const float ax = fminf(fabsf(x), 7.5f);
    unsigned u = __float_as_uint(ax); u += 0x7FFFFu + ((u >> 20) & 1u);
    const unsigned cn = (u >> 20) - ((127u - 1u) << 3);
    const unsigned cs = (unsigned)__builtin_rintf(ax * 8.0f);
    return sgn | (ax < 1.0f ? cs : cn);
}
typedef float f32x16v __attribute__((ext_vector_type(16)));
typedef float f32x32v __attribute__((ext_vector_type(32)));
typedef unsigned u32x6v __attribute__((ext_vector_type(6)));
__device__ __forceinline__ u32x6v pack_fp6_32(const float (&e)[32], bool interleaved) {
    f32x16v s0, s1;
    if (interleaved) {
#pragma unroll
        for (int i = 0; i < 16; ++i) { s0[i] = e[2 * i]; s1[i] = e[2 * i + 1]; }
    } else {
#pragma unroll
        for (int i = 0; i < 16; ++i) { s0[i] = e[i]; s1[i] = e[16 + i]; }
    }
    return __builtin_amdgcn_cvt_scalef32_2xpk16_fp6_f32(s0, s1, 1.0f);
}
__device__ __forceinline__ void cvt_table_fp6(const float* src, unsigned char* dst, int nrows, float scale, LAS float* scr  , int lane, int gw, int NGW, const int isv) {
    bool interleaved;
    {
        float t[32];
#pragma unroll
        for (int k = 0; k < 32; ++k) t[k] = k < 16 ? 0.125f * k : (k < 24 ? 2.0f + 0.25f * (k - 16) : 4.0f + 0.5f * (k - 24));
        float tt[32];
#pragma unroll
        for (int k = 0; k < 32; ++k) { tt[k] = t[k]; asm volatile("" : "+v"(tt[k])); }
        const u32x6v p = pack_fp6_32(tt, true);
        const f32x32v o = __builtin_amdgcn_cvt_scalef32_pk32_f32_fp6(p, 1.0f);
        interleaved = (o[1] == t[1]) && (o[2] == t[2]) && (o[17] == t[17]);
        interleaved = __all(interleaved);
    }
    for (int row = gw; row < nrows; row += NGW) {
        const f32x4* s4 = (const f32x4*)(src + (size_t)row * 2048);
#pragma unroll
        for (int q = 0; q < 8; ++q) { const int s = 64 * q + lane; const f32x4 a = s4[s] * scale; *(LAS f32x4*)(scr + 4 * (s ^ ((s >> 4) & 7))) = a; }
        float e[32];
#pragma unroll
        for (int j = 0; j < 8; ++j) { const int s = 8 * lane + j; const f32x4 a = *(const LAS f32x4*)(scr + 4 * (s ^ ((s >> 4) & 7)));
            e[4 * j + 0] = __builtin_amdgcn_fmed3f(a.x, -7.5f, 7.5f); e[4 * j + 1] = __builtin_amdgcn_fmed3f(a.y, -7.5f, 7.5f); e[4 * j + 2] = __builtin_amdgcn_fmed3f(a.z, -7.5f, 7.5f); e[4 * j + 3] = __builtin_amdgcn_fmed3f(a.w, -7.5f, 7.5f); }
        const u32x6v p = pack_fp6_32(e, interleaved);
        unsigned char* rowp = dst + (size_t)row * PREC;
        *(u32x4*)(rowp + 1024 * isv + 16 * lane) = (u32x4){p[0], p[1], p[2], p[3]}; *(u32x2*)(rowp + 2048 + 512 * isv + 8 * lane) = (u32x2){p[4], p[5]};
    }
}
__device__ __forceinline__ float silu(float x) { return x / (1.0f + __expf(-x)); }

struct Params { const float* in[29]; float* out; unsigned char* ws; int ph_lo, ph_hi; };
typedef const __attribute__((address_space(4))) Params* CP;

__device__ __forceinline__ void p0_prologue(CP P, LAS unsigned char* lds, int tid, int lane, int wid, int gw, int NGW) {
    unsigned char* ws = P->ws;
    LAS float* scr = (LAS float*)(lds + wid * 16384);
    {
        constexpr int I_GMIN = (2048 / 64) * (4096 / 32), I_SQ = (2048 / 64) * (2048 / 32), I_MIN = (2048 / 64) * (1088 / 32), I_UQ = (512 / 64) * (3072 / 32), I_UKV = (512 / 64) * (4096 / 32), I_DIN = (2048 / 64) * (6144 / 32);
        constexpr int NIT = 2 * I_GMIN + 2 * I_SQ + 4 * I_SQ + I_MIN + I_UQ + I_UKV + I_SQ + I_DIN + I_SQ;
        for (int it = gw; it < NIT; it += NGW) {
            int r = it;
            if (r < 2 * I_GMIN) { const int j = r / I_GMIN; p0_transpose_item(P->in[13] + (size_t)j * 2048 * 4096, 2048, 4096, (bf16*)(ws + WS_GMWIN) + (size_t)j * 4096 * 2048, scr, r % I_GMIN, lane); continue; } r -= 2 * I_GMIN;
            if (r < 2 * I_SQ) { const int j = r / I_SQ; p0_transpose_item(P->in[18] + (size_t)j * 2048 * 2048, 2048, 2048, (bf16*)(ws + WS_GMWOUT) + (size_t)j * 2048 * 2048, scr, r % I_SQ, lane); continue; } r -= 2 * I_SQ;
            if (r < 4 * I_SQ) { const int j = r / I_SQ; p0_transpose_item(P->in[8] + (size_t)j * 2048 * 2048, 2048, 2048, (bf16*)(ws + WS_PWQ) + (size_t)j * 2048 * 2048, scr, r % I_SQ, lane); continue; } r -= 4 * I_SQ;
            if (r < I_MIN) { p0_transpose_item(P->in[19], 2048, 1088, (bf16*)(ws + WS_MLAIN), scr, r, lane); continue; } r -= I_MIN;
            if (r < I_UQ) { p0_transpose_item(P->in[22], 512, 3072, (bf16*)(ws + WS_MLAUQ), scr, r, lane); continue; } r -= I_UQ;
            if (r < I_UKV) { p0_transpose_item(P->in[23], 512, 4096, (bf16*)(ws + WS_MLAUKV), scr, r, lane); continue; } r -= I_UKV;
            if (r < I_SQ) { p0_transpose_item(P->in[24], 2048, 2048, (bf16*)(ws + WS_MLAOUT), scr, r, lane); continue; } r -= I_SQ;
            if (r < I_DIN) { p0_transpose_item(P->in[25], 2048, 6144, (bf16*)(ws + WS_DAIN), scr, r, lane); continue; } r -= I_DIN;
            p0_transpose_item(P->in[28], 2048, 2048, (bf16*)(ws + WS_DAOUT), scr, r, lane);
        }
    }
    const size_t gtid = (size_t)gw * 64 + lane, gthreads = (size_t)NGW * 64;
    { u32x4* z = (u32x4*)((bf16*)(ws + WS_MLAIN) + (size_t)1088 * 2048); const size_t n = (size_t)192 * 2048 / 8;
      for (size_t i = gtid; i < n; i += gthreads) z[i] = (u32x4){0u, 0u, 0u, 0u}; }
    cvt_range(P->in[16], (bf16*)(ws + WS_GMWS), (size_t)2 * 16 * 128 * 128 / 8, gtid, gthreads);
    cvt_range(P->in[9], (bf16*)(ws + WS_PK1), (size_t)4 * 128 * 128 / 8, gtid, gthreads);
    cvt_range(P->in[10], (bf16*)(ws + WS_PK2), (size_t)4 * 128 * 128 / 8, gtid, gthreads);
    cvt_table_fp6(P->in[11], ws + WS_PU, 16384, U_SCALE, scr, lane, gw, NGW, 0);
    cvt_table_fp6(P->in[12], ws + WS_PU, 16384, V_SCALE, scr, lane, gw, NGW, 1);
    if (gtid < 2048) { const int pos = (int)gtid >> 4, f = (int)gtid & 15; const float inv = powf(10000.0f, -(float)f * (1.0f / 16.0f)); float sn, cs; sincosf((float)pos * inv, &sn, &cs);
        float* rt = (float*)(ws + WS_ROPE); rt[gtid] = cs; rt[2048 + gtid] = sn; }
    {
        const float* cv = P->in[1]; const float* cc = P->in[3]; const float* mw = P->in[4]; float* PART = (float*)(ws + WS_MODP);
        for (int item = gw; item < 4 * 192 * 8; item += NGW) {
            const int ks = item & 7, r = item >> 3, L = r / 192, n = (r % 192) * 64 + lane;
            const float* W = mw + (size_t)L * 2048 * 12288 + (size_t)(ks * 256) * 12288 + n;
            float a0 = 0.f, a1 = 0.f, a2 = 0.f;
#pragma unroll 32
            for (int k = 0; k < 256; ++k) { const int kk = ks * 256 + k; const float s0 = silu(cv[kk]), s1 = silu(cv[2048 + kk]), s2 = silu(cc[kk]);
                const float w = W[(size_t)k * 12288]; a0 += s0 * w; a1 += s1 * w; a2 += s2 * w; }
            float* o = PART + ((size_t)ks * 4 + L) * 3 * 12288 + n;
            o[0] = a0; o[12288] = a1; o[24576] = a2;
        }
    }
}
__device__ __forceinline__ void mod_reduce(CP P, int gw, int lane, int NGW) {
    const float* PART = (const float*)(P->ws + WS_MODP); float* MOD = (float*)(P->ws + WS_MOD); const float* mb = P->in[5];
    for (int i = gw * 64 + lane; i < 4 * 3 * 12288; i += NGW * 64) {
        const int L = i / (3 * 12288), n = i % 12288;
        float s = mb[(size_t)L * 12288 + n];
#pragma unroll
        for (int ks = 0; ks < 8; ++ks) s += PART[(size_t)ks * 4 * 3 * 12288 + i];
        MOD[i] = s;
    }
}

__device__ __forceinline__ void first_row_pass(CP P, int lane, int gw, int NGW) {
    const float* MOD = (const float*)(P->ws + WS_MOD); bf16* X = (bf16*)(P->ws + WS_X); bf16* H = (bf16*)(P->ws + WS_H);
    for (int row = gw; row < MT; row += NGW) {
        const float* src = row < ML ? P->in[0] + (size_t)row * DM : P->in[2] + (size_t)(row - ML) * DM;
        float v[32]; load_row_f32(src, lane, v);
        store_row_bf16(X + (size_t)row * DM, lane, v);
        const float* mod = MOD + (size_t)row_slot(row) * 12288;
        float mean, rstd; ln_stats(v, mean, rstd);
        float a[32], s[32]; load_row_f32(mod + 2048, lane, a); load_row_f32(mod, lane, s);
#pragma unroll
        for (int i = 0; i < 32; ++i) a[i] = (v[i] - mean) * rstd * (1.0f + a[i]) + s[i];
        store_row_bf16(H + (size_t)row * DM, lane, a);
    }
}
__device__ __forceinline__ void post_mixer_pass(CP P, int L, int Mrows, int lane, int gw, int NGW) {
    const float* MOD = (const float*)(P->ws + WS_MOD); bf16* X = (bf16*)(P->ws + WS_X); bf16* H = (bf16*)(P->ws + WS_H); const bf16* Y = (const bf16*)(P->ws + WS_Y);
    const float* lng = P->in[6] + (size_t)(L * 2 + 0) * DM; const float* lnb = P->in[7] + (size_t)(L * 2 + 0) * DM;
    for (int row = gw; row < Mrows; row += NGW) {
        const float* mod = MOD + (size_t)(L * 3 + row_slot(row)) * 12288;
        float z[32], y[32], g[32]; load_row_bf16(X + (size_t)row * DM, lane, z); load_row_bf16(Y + (size_t)row * DM, lane, y); load_row_f32(mod + 2 * 2048, lane, g);
#pragma unroll
        for (int i = 0; i < 32; ++i) z[i] = ALPHA * z[i] + g[i] * y[i];
        finish_row<false>(z, lng, lnb, X + (size_t)row * DM, mod + 3 * 2048, mod + 4 * 2048, H + (size_t)row * DM, nullptr, lane);
    }
}
__device__ __forceinline__ void vstats_pass(CP P, int Mrows, int lane, int gw, int NGW) {
    const bf16* Z = (const bf16*)(P->ws + WS_Z); float* VST = (float*)(P->ws + WS_VST);
    for (int row = gw; row < Mrows; row += NGW) {
        float v[32]; load_row_bf16(Z + (size_t)row * 4096 + 2048, lane, v);
        float mean, rstd; ln_stats(v, mean, rstd);
        if (lane == 0) { VST[2 * row] = mean; VST[2 * row + 1] = rstd; }
    }
}
#define XB_TMO      128
#define XB_XCNT(j)  (256  + 64 * (j))
#define XB_XSUB(j)  (1280 + 64 * (j))
#define XB_XGEN(j)  (2304 + 64 * (j))
#define XB_TOP      3328
#define XB_TOPGEN   3392
#define XCD_BAR_WORDS 3456
#define XB_SPIN_CAP (1u << 18)

__device__ __forceinline__ unsigned xb_ld(unsigned* p)              { return __hip_atomic_load(p, __ATOMIC_RELAXED, __HIP_MEMORY_SCOPE_AGENT); }
__device__ __forceinline__ unsigned xb_add(unsigned* p, unsigned v) { return __hip_atomic_fetch_add(p, v, __ATOMIC_RELAXED, __HIP_MEMORY_SCOPE_AGENT); }
__device__ __forceinline__ unsigned xb_xcc_id() { return (unsigned)__builtin_amdgcn_s_getreg((3 << 11) | 20) & 0xFu; }
#define XB_SPIN(cond, bar) do { unsigned _sp = 0; while (cond) { __builtin_amdgcn_s_sleep(1); \
    if ((++_sp & 255u) == 0u) { if (xb_ld(&(bar)[XB_TMO])) break; if (_sp > XB_SPIN_CAP) { atomicAdd(&(bar)[XB_TMO], 1u); break; } } } } while (0)

struct XcdBarrier {
    unsigned* bar; unsigned x;
    volatile LAS unsigned* st;
};

__device__ __forceinline__ XcdBarrier xcd_barrier_post(unsigned* bar, volatile LAS unsigned* st, const bool t0) {
    XcdBarrier b; b.bar = bar; b.x = xb_xcc_id(); b.st = st;
    if (t0) (void)xb_add(&bar[XB_XCNT(b.x)], 1u);
    return b;
}
__device__ __forceinline__ void xcd_barrier_complete(unsigned* bar, unsigned x, unsigned& nloc, unsigned& nx) {
    const unsigned G = gridDim.x * gridDim.y * gridDim.z;
    unsigned sum, cnt, mine, sp = 0u;
    for (;;) {
        sum = 0u; cnt = 0u; mine = 0u;
#pragma unroll
        for (unsigned j = 0; j < 16; ++j) { const unsigned c = xb_ld(&bar[XB_XCNT(j)]); sum += c; cnt += (c > 0u) ? 1u : 0u; mine = (j == x) ? c : mine; }
        if (sum == G) break;
        __builtin_amdgcn_s_sleep(1);
        if ((++sp & 255u) == 0u) { if (xb_ld(&bar[XB_TMO])) break; if (sp > XB_SPIN_CAP) { atomicAdd(&bar[XB_TMO], 1u); break; } }
    }
    nloc = mine > 0u ? mine : 1u; nx = cnt > 0u ? cnt : 1u;
}

__device__ __attribute__((noinline)) void xcd_barrier(const XcdBarrier b, const bool t0) {
    asm volatile("s_waitcnt vmcnt(0)" ::: "memory");
    __syncthreads();
    if (t0) {
        unsigned* bar = b.bar;
        __builtin_amdgcn_s_waitcnt(0);
        unsigned nloc = b.st[0], nx = b.st[1];
        if (nloc == 0u) { xcd_barrier_complete(bar, b.x, nloc, nx); b.st[0] = nloc; b.st[1] = nx; }
        const unsigned old = xb_add(&bar[XB_XSUB(b.x)], 1u);
        const unsigned gen = old / nloc;
        if (old + 1u == (gen + 1u) * nloc) {
            __builtin_amdgcn_fence(__ATOMIC_RELEASE, "agent");
            asm volatile("s_waitcnt vmcnt(0)" ::: "memory");
            const unsigned og = xb_add(&bar[XB_TOP], 1u);
            const unsigned tg = og / nx;
            if (og + 1u == (tg + 1u) * nx) xb_add(&bar[XB_TOPGEN], 1u);
            else XB_SPIN(xb_ld(&bar[XB_TOPGEN]) == tg, bar);
            __builtin_amdgcn_fence(__ATOMIC_ACQUIRE, "agent");
            xb_add(&bar[XB_XGEN(b.x)], 1u);
            asm volatile("s_waitcnt vmcnt(0)" ::: "memory");
        } else {
            XB_SPIN(xb_ld(&bar[XB_XGEN(b.x)]) == gen, bar);
            __builtin_amdgcn_fence(__ATOMIC_ACQUIRE, "agent");
            asm volatile("s_waitcnt vmcnt(0)" ::: "memory");
        }
    }
    __syncthreads();
}

__device__ __forceinline__ void spatial_phase(CP P, int j, int Mrows, LAS unsigned char* lds_, int tid, int lane, int wid) {
    const bf16* Z = (const bf16*)(P->ws + WS_Z); const float* VST = (const float*)(P->ws + WS_VST); bf16* Gb = (bf16*)(P->ws + WS_G);
    const bf16* WS = (const bf16*)(P->ws + WS_GMWS) + (size_t)j * 16 * 128 * 128;
    const float* lng = P->in[14] + (size_t)j * DM; const float* lnb = P->in[15] + (size_t)j * DM; const float* bs = P->in[17] + (size_t)j * 16 * 128;
    LAS bf16* Vt = (LAS bf16*)(LAS unsigned char*)lds_;
    constexpr int VP = 136;
    const int nunits = (Mrows / 128) * 16;
    for (int u = blockIdx.x; u < nunits; u += gridDim.x) {
        const int c = u >> 4, g = u & 15;
        __syncthreads();
        {
            const int q = tid >> 2, dq = (tid & 3) * 32; const int row = c * 128 + q;
            const float mean = VST[2 * row], rstd = VST[2 * row + 1];
            const bf16* src = Z + (size_t)row * 4096 + 2048 + g * 128 + dq;
#pragma unroll
            for (int t = 0; t < 4; ++t) { const u32x4 w = *(const u32x4*)(src + 8 * t);
                float v[8] = {bflo(w.x), bfhi(w.x), bflo(w.y), bfhi(w.y), bflo(w.z), bfhi(w.z), bflo(w.w), bfhi(w.w)};
                const float* gp = lng + g * 128 + dq + 8 * t; const float* bp = lnb + g * 128 + dq + 8 * t;
#pragma unroll
                for (int i = 0; i < 8; ++i) { const float vn = (v[i] - mean) * rstd * gp[i] + bp[i]; Vt[(dq + 8 * t + i) * VP + q] = tobf1(vn); } }
        }
        __syncthreads();
        const int fr = lane & 15, fq = lane >> 4;
        bf16x8 a[4];
        const bf16* wrow = WS + (size_t)g * 128 * 128 + (size_t)(16 * wid + fr) * 128 + 8 * fq;
#pragma unroll
        for (int ks = 0; ks < 4; ++ks) a[ks] = *(const bf16x8*)(wrow + 32 * ks);
#pragma unroll
        for (int nb = 0; nb < 8; ++nb) {
            f32x4 acc = {0.f, 0.f, 0.f, 0.f};
#pragma unroll
            for (int ks = 0; ks < 4; ++ks) { const bf16x8 b = *(const LAS bf16x8*)(Vt + (16 * nb + fr) * VP + 32 * ks + 8 * fq);
                acc = __builtin_amdgcn_mfma_f32_16x16x32_bf16(a[ks], b, acc, 0, 0, 0); }
#pragma unroll
            for (int r = 0; r < 4; ++r) { const int p = 16 * wid + fq * 4 + r, d = 16 * nb + fr; const size_t grow = (size_t)(c * 128 + p);
                const float sv = acc[r] + bs[g * 128 + p];
                const float uu = bf1(Z[grow * 4096 + g * 128 + d]);
                Gb[grow * 2048 + g * 128 + d] = tobf1(uu * sv); }
        }
    }
}

__device__ __forceinline__ void rope_cs(int row, int l, float& cs, float& sn) {
    const int t = row & (SEQ - 1); const int pos = (l & 32) ? (t & 63) : (t >> 6);
    const float inv = powf(10000.0f, -(float)(l & 15) * (1.0f / 16.0f));
    const float ang = (float)pos * inv; sincosf(ang, &sn, &cs);
}
__device__ __forceinline__ float rope_apply(float x, int l, float cs, float sn) {
    const float p = lane_xor16(x, l);
    return (l & 16) ? (p * sn + x * cs) : (x * cs - p * sn);
}
__device__ __forceinline__ void mla_norm_pass(CP P, int lane, int gw, int NGW) {
    const bf16* C = (const bf16*)(P->ws + WS_C); bf16* CQN = (bf16*)(P->ws + WS_CQN); bf16* CKVN = (bf16*)(P->ws + WS_CKVN); bf16* KR = (bf16*)(P->ws + WS_KR);
    const float* qn = P->in[20]; const float* kvn = P->in[21];
    for (int row = gw; row < MT; row += NGW) {
        const bf16* c = C + (size_t)row * 1280;
#pragma unroll
        for (int part = 0; part < 2; ++part) {
            const u32x4 w = *(const u32x4*)(c + part * 512 + 8 * lane);
            float v[8] = {bflo(w.x), bfhi(w.x), bflo(w.y), bfhi(w.y), bflo(w.z), bfhi(w.z), bflo(w.w), bfhi(w.w)};
            float ss = 0.f;
#pragma unroll
            for (int i = 0; i < 8; ++i) ss += v[i] * v[i];
            const float r = 1.0f / sqrtf(wave_sum(ss) * (1.0f / 512.0f) + LN_EPS);
            const float* nw = (part ? kvn : qn) + 8 * lane;
            u32x4 o; o.x = cvtpk(v[0] * r * nw[0], v[1] * r * nw[1]); o.y = cvtpk(v[2] * r * nw[2], v[3] * r * nw[3]); o.z = cvtpk(v[4] * r * nw[4], v[5] * r * nw[5]); o.w = cvtpk(v[6] * r * nw[6], v[7] * r * nw[7]);
            *(u32x4*)((part ? CKVN : CQN) + (size_t)row * 512 + 8 * lane) = o;
        }
        float x = bf1(c[1024 + lane]);
        if (row < ML) { float cs, sn; rope_cs(row, lane, cs, sn); x = rope_apply(x, lane, cs, sn); }
        KR[(size_t)row * 64 + lane] = tobf1(x);
    }
}
__device__ __forceinline__ void rope_pass(bf16* buf, int ld, int col0, int nchunks, int cstride, int lane, int gw, int NGW) {
    for (int row = gw; row < ML; row += NGW) {
        float cs, sn; rope_cs(row, lane, cs, sn);
        bf16* r = buf + (size_t)row * ld + col0 + lane;
#pragma unroll 4
        for (int k = 0; k < nchunks; ++k) { const float x = bf1(r[k * cstride]); r[k * cstride] = tobf1(rope_apply(x, lane, cs, sn)); }
    }
}

namespace att {
#ifndef ATT_LEAN
#define ATT_LEAN 1
#endif
#ifndef ATT_3STAGE
#define ATT_3STAGE 0
#endif
#ifndef ATT_SDEPTH
#define ATT_SDEPTH(MODE) ((MODE) == 0 ? 1 : 1)
#endif
#ifndef ATT_PVPIPE
#define ATT_PVPIPE(MODE) false
#endif
#define SBAR() __builtin_amdgcn_sched_barrier(0)
__device__ __forceinline__ int crow(int r, int hi) { return (r & 3) + 8 * (r >> 2) + 4 * hi; }
__device__ __forceinline__ unsigned cvtpkv(float lo, float hi) { unsigned r; asm volatile("v_cvt_pk_bf16_f32 %0, %1, %2" : "=v"(r) : "v"(lo), "v"(hi)); return r; }

__device__ __forceinline__ void partialSM(f32x16& p0, f32x16& p1, float& m_reg, float& mn, float& alpha, const float C, const float THRS) {
  float pmax = p0[0];
#pragma unroll
  for (int r = 1; r < 16; ++r) pmax = fmaxf(pmax, p0[r]);
#pragma unroll
  for (int r = 0; r < 16; ++r) pmax = fmaxf(pmax, p1[r]);
  { auto rr = __builtin_amdgcn_permlane32_swap(__float_as_uint(pmax), __float_as_uint(pmax), false, false);
    pmax = fmaxf(__uint_as_float(rr[0]), __uint_as_float(rr[1])); }
  if (__builtin_expect(__all(pmax - m_reg <= THRS), 1)) { mn = m_reg; alpha = 1.f; }
  else { mn = fmaxf(m_reg, pmax); alpha = __builtin_amdgcn_exp2f((m_reg - mn) * C); m_reg = mn; }
  const float mnC = -mn * C;
#pragma unroll
  for (int r = 0; r < 16; ++r) p0[r] = fmaf(p0[r], C, mnC);
#pragma unroll
  for (int r = 0; r < 16; ++r) p1[r] = fmaf(p1[r], C, mnC);
#pragma unroll
  for (int r = 0; r < 16; ++r) p0[r] = __builtin_amdgcn_exp2f(p0[r]);
}
__device__ __forceinline__ void finishSM(f32x16& p0, f32x16& p1, float alpha, float& l_reg, bf16x8& pa0, bf16x8& pa1, bf16x8& pa2, bf16x8& pa3) {
#pragma unroll
  for (int r = 0; r < 16; ++r) p1[r] = __builtin_amdgcn_exp2f(p1[r]);
  float ps = 0;
#pragma unroll
  for (int r = 0; r < 16; ++r) ps += p0[r];
#pragma unroll
  for (int r = 0; r < 16; ++r) ps += p1[r];
  { auto rr = __builtin_amdgcn_permlane32_swap(__float_as_uint(ps), __float_as_uint(ps), false, false);
    ps = __uint_as_float(rr[0]) + __uint_as_float(rr[1]); }
  l_reg = l_reg * alpha + ps;
#define PK4(P, BASE, OUT) do { unsigned a0 = cvtpkv(P[BASE + 0], P[BASE + 1]), a1 = cvtpkv(P[BASE + 2], P[BASE + 3]);   \
    unsigned b0 = cvtpkv(P[BASE + 4], P[BASE + 5]), b1 = cvtpkv(P[BASE + 6], P[BASE + 7]);                              \
    auto r0 = __builtin_amdgcn_permlane32_swap(a0, b0, false, false); auto r1 = __builtin_amdgcn_permlane32_swap(a1, b1, false, false); \
    u32x4 w = {r0[0], r1[0], r0[1], r1[1]}; OUT = *reinterpret_cast<bf16x8*>(&w); } while (0)
  PK4(p0, 0, pa0); PK4(p0, 8, pa1); PK4(p1, 0, pa2); PK4(p1, 8, pa3);
#undef PK4
}
__device__ __forceinline__ void partialSM_lean(f32x16& p0, f32x16& p1, f32x16& nm, float& alpha, const bool first) {
  constexpr float THR2 = 11.541560327111707f;
  float dmax = p0[0];
#pragma unroll
  for (int r = 1; r < 16; ++r) dmax = fmaxf(dmax, p0[r]);
#pragma unroll
  for (int r = 0; r < 16; ++r) dmax = fmaxf(dmax, p1[r]);
  { auto rr = __builtin_amdgcn_permlane32_swap(__float_as_uint(dmax), __float_as_uint(dmax), false, false);
    dmax = fmaxf(__uint_as_float(rr[0]), __uint_as_float(rr[1])); }
  alpha = 1.f;
  if (first || !__all(dmax <= THR2)) {
    const float delta = first ? dmax : (dmax > THR2 ? dmax : 0.f);
    if (!first) alpha = __builtin_amdgcn_exp2f(-delta);
#pragma unroll
    for (int r = 0; r < 16; ++r) { p0[r] -= delta; p1[r] -= delta; nm[r] -= delta; }
  }
#pragma unroll
  for (int r = 0; r < 16; ++r) p0[r] = __builtin_amdgcn_exp2f(p0[r]);
}
__device__ __forceinline__ void finishSM_lean(f32x16& p0, f32x16& p1, bf16x8& pa0, bf16x8& pa1, bf16x8& pa2, bf16x8& pa3) {
#pragma unroll
  for (int r = 0; r < 16; ++r) p1[r] = __builtin_amdgcn_exp2f(p1[r]);
#define PK4(P, BASE, OUT) do { unsigned a0 = cvtpkv(P[BASE + 0], P[BASE + 1]), a1 = cvtpkv(P[BASE + 2], P[BASE + 3]);   \
    unsigned b0 = cvtpkv(P[BASE + 4], P[BASE + 5]), b1 = cvtpkv(P[BASE + 6], P[BASE + 7]);                              \
    auto r0 = __builtin_amdgcn_permlane32_swap(a0, b0, false, false); auto r1 = __builtin_amdgcn_permlane32_swap(a1, b1, false, false); \
    u32x4 w = {r0[0], r1[0], r0[1], r1[1]}; OUT = *reinterpret_cast<bf16x8*>(&w); } while (0)
  PK4(p0, 0, pa0); PK4(p0, 8, pa1); PK4(p1, 0, pa2); PK4(p1, 8, pa3);
#undef PK4
}
__device__ __forceinline__ bf16x8 scale_bf16x8(bf16x8 v, float c) {
  const u32x4 w = *reinterpret_cast<u32x4*>(&v); u32x4 o;
  o.x = cvtpk(bflo(w.x) * c, bfhi(w.x) * c); o.y = cvtpk(bflo(w.y) * c, bfhi(w.y) * c); o.z = cvtpk(bflo(w.z) * c, bfhi(w.z) * c); o.w = cvtpk(bflo(w.w) * c, bfhi(w.w) * c);
  return *reinterpret_cast<bf16x8*>(&o);
}
template <int PITCH> __device__ __forceinline__ int kswz(int r) { return PITCH == 256 ? (r & 15) : ((r >> 1) & 7); }
template <int NQF, int NQR, int PITCH> __device__ __forceinline__ void qkt(f32x16& p0, f32x16& p1, const LAS char* Ks, int chunk0, const bf16x8* qr, const LAS char* ql, int r32, int hi, const f32x16 init = f32x16{}) {
  p0 = init; p1 = init;
  const int sw = kswz<PITCH>(r32);
#pragma unroll
  for (int d0 = 0; d0 < NQF; ++d0) { const int off = ((chunk0 + d0 * 2 + hi) ^ sw) * 16;
    const bf16x8 b0 = *(const LAS bf16x8*)(Ks + r32 * PITCH + off);
    const bf16x8 b1 = *(const LAS bf16x8*)(Ks + (32 + r32) * PITCH + off);
    const bf16x8 q = d0 < NQR ? qr[d0 < NQR ? d0 : 0] : *(const LAS bf16x8*)(ql + (d0 - NQR < 0 ? 0 : d0 - NQR) * 1024);
    p0 = __builtin_amdgcn_mfma_f32_32x32x16_bf16(b0, q, p0, 0, 0, 0);
    p1 = __builtin_amdgcn_mfma_f32_32x32x16_bf16(b1, q, p1, 0, 0, 0); }
}
__device__ __forceinline__ int v_st(int k, int c) { const int kk = (k & ~0xC) | ((k & 4) << 1) | ((k & 8) >> 1); return ((kk >> 3) * 4 + (c >> 5)) * 512 + ((kk & 7) * 32 + (c & 31)) * 2; }
__device__ __forceinline__ int v_rd_base(int lane) { return ((lane & 3) << 3) | (((lane >> 2) & 3) << 6) | (((lane >> 4) & 1) << 5) | (((lane >> 5) & 1) << 8); }
constexpr int v_rd_off(int d0, int ks, int half) { return d0 * 512 + ks * 4096 + half * 2048; }
template <int OFF> __device__ __forceinline__ s16x4 tr_read(int vb) {
  s16x4 r; asm volatile("ds_read_b64_tr_b16 %0, %1 offset:%2" : "=&v"(r) : "v"(vb), "i"(OFF) : "memory"); return r;
}
template <int D0> __device__ __forceinline__ void pv_one(f32x16& od, int vb, bf16x8 pa0, bf16x8 pa1, bf16x8 pa2, bf16x8 pa3) {
  const s16x4 l0 = tr_read<v_rd_off(D0, 0, 0)>(vb), h0 = tr_read<v_rd_off(D0, 0, 1)>(vb), l1 = tr_read<v_rd_off(D0, 1, 0)>(vb), h1 = tr_read<v_rd_off(D0, 1, 1)>(vb);
  const s16x4 l2 = tr_read<v_rd_off(D0, 2, 0)>(vb), h2 = tr_read<v_rd_off(D0, 2, 1)>(vb), l3 = tr_read<v_rd_off(D0, 3, 0)>(vb), h3 = tr_read<v_rd_off(D0, 3, 1)>(vb);
  asm volatile("s_waitcnt lgkmcnt(0)" ::: "memory"); SBAR();
#define PK(L, H) (bf16x8){L[0], L[1], L[2], L[3], H[0], H[1], H[2], H[3]}
  od = __builtin_amdgcn_mfma_f32_32x32x16_bf16(pa0, PK(l0, h0), od, 0, 0, 0);
  od = __builtin_amdgcn_mfma_f32_32x32x16_bf16(pa1, PK(l1, h1), od, 0, 0, 0);
  od = __builtin_amdgcn_mfma_f32_32x32x16_bf16(pa2, PK(l2, h2), od, 0, 0, 0);
  od = __builtin_amdgcn_mfma_f32_32x32x16_bf16(pa3, PK(l3, h3), od, 0, 0, 0);
#undef PK
}
__device__ __forceinline__ void pv_d0(f32x16* o, int vb, bf16x8 pa0, bf16x8 pa1, bf16x8 pa2, bf16x8 pa3) {
  pv_one<0>(o[0], vb, pa0, pa1, pa2, pa3); pv_one<1>(o[1], vb, pa0, pa1, pa2, pa3); pv_one<2>(o[2], vb, pa0, pa1, pa2, pa3); pv_one<3>(o[3], vb, pa0, pa1, pa2, pa3);
}
struct VFrag { s16x4 l0, h0, l1, h1, l2, h2, l3, h3; };
template <int D0> __device__ __forceinline__ void tr8(VFrag& f, int vb) {
  f.l0 = tr_read<v_rd_off(D0, 0, 0)>(vb); f.h0 = tr_read<v_rd_off(D0, 0, 1)>(vb); f.l1 = tr_read<v_rd_off(D0, 1, 0)>(vb); f.h1 = tr_read<v_rd_off(D0, 1, 1)>(vb);
  f.l2 = tr_read<v_rd_off(D0, 2, 0)>(vb); f.h2 = tr_read<v_rd_off(D0, 2, 1)>(vb); f.l3 = tr_read<v_rd_off(D0, 3, 0)>(vb); f.h3 = tr_read<v_rd_off(D0, 3, 1)>(vb);
}
__device__ __forceinline__ void mfma4(f32x16& od, VFrag& f, bf16x8 pa0, bf16x8 pa1, bf16x8 pa2, bf16x8 pa3) {
#define PK(L, H) (bf16x8){L[0], L[1], L[2], L[3], H[0], H[1], H[2], H[3]}
  od = __builtin_amdgcn_mfma_f32_32x32x16_bf16(pa0, PK(f.l0, f.h0), od, 0, 0, 0);
  od = __builtin_amdgcn_mfma_f32_32x32x16_bf16(pa1, PK(f.l1, f.h1), od, 0, 0, 0);
  od = __builtin_amdgcn_mfma_f32_32x32x16_bf16(pa2, PK(f.l2, f.h2), od, 0, 0, 0);
  od = __builtin_amdgcn_mfma_f32_32x32x16_bf16(pa3, PK(f.l3, f.h3), od, 0, 0, 0);
#undef PK
}
#define VF_TIE(f) "+v"(f.l0), "+v"(f.h0), "+v"(f.l1), "+v"(f.h1), "+v"(f.l2), "+v"(f.h2), "+v"(f.l3), "+v"(f.h3)
__device__ __forceinline__ void pv_pipe(f32x16* o, int vb, bf16x8 pa0, bf16x8 pa1, bf16x8 pa2, bf16x8 pa3) {
  VFrag A, B;
  asm volatile("s_waitcnt lgkmcnt(0)" ::: "memory");
  tr8<0>(A, vb); tr8<1>(B, vb);
  asm volatile("s_waitcnt lgkmcnt(8)" : VF_TIE(A) :: "memory"); SBAR();
  mfma4(o[0], A, pa0, pa1, pa2, pa3); SBAR();
  tr8<2>(A, vb);
  asm volatile("s_waitcnt lgkmcnt(8)" : VF_TIE(B) :: "memory"); SBAR();
  mfma4(o[1], B, pa0, pa1, pa2, pa3); SBAR();
  tr8<3>(B, vb);
  asm volatile("s_waitcnt lgkmcnt(8)" : VF_TIE(A) :: "memory"); SBAR();
  mfma4(o[2], A, pa0, pa1, pa2, pa3); SBAR();
  asm volatile("s_waitcnt lgkmcnt(0)" : VF_TIE(B) :: "memory"); SBAR();
  mfma4(o[3], B, pa0, pa1, pa2, pa3);
}
__device__ __forceinline__ bf16x8 ld8(const bf16* p) { return *reinterpret_cast<const bf16x8*>(p); }

template <int MODE>
__device__ __forceinline__ void attn_unit(const bf16* __restrict__ Qrow0, int ldq, const bf16* __restrict__ Kb, const bf16* __restrict__ Vb, int ldk, const bf16* __restrict__ KRb,
                                          int b, int nct, int NT, bf16* __restrict__ Ob, float lam, const float* __restrict__ subln, float oscale, LAS unsigned char* lds_, const int tid_in) {
  constexpr bool LEAN = (MODE == 1) && ATT_LEAN; constexpr int NQF = MODE == 0 ? 12 : 4, NQR = MODE == 0 ? 4 : 0, NOB = LEAN ? 5 : 4, PITCH = MODE == 0 ? 384 : 256, SHM_V = 16384, SHM_K = 64 * PITCH, SDEPTH = ATT_SDEPTH(MODE); constexpr bool PVPIPE = ATT_PVPIPE(MODE);
  const float SCALE = MODE == 0 ? 0.07216878364870323f : 0.125f;
  const float C = SCALE * 1.4426950408889634f, THRS = 8.f / SCALE;
  const int tid = launder_v(tid_in) & 511, wid = tid >> 6, lane = tid & 63, r32 = lane & 31, hi = lane >> 5;
  LAS char* lds = (LAS char*)(LAS unsigned char*)lds_;
  constexpr bool THREE = (MODE == 1) && ATT_3STAGE; constexpr int NSTG = THREE ? 3 : 2, STG = SHM_V + SHM_K, SCR0 = NSTG * STG;
#define VOFF(s) (!THREE ? (s) * SHM_V : (s) * STG)
#define KOFF(s) (!THREE ? 2 * SHM_V + (s) * SHM_K : (s) * STG + SHM_V)
  LAS char* V_lds = lds; LAS char* K_lds = lds;
  LAS float* wsf = (LAS float*)(lds + NSTG * (SHM_V + SHM_K)) + wid * 64; LAS float* li_l = wsf; LAS float* al_l = wsf + 32;
  const int wq = MODE == 0 ? wid : (wid & 3), sgrp = MODE == 0 ? 0 : (wid >> 2);
  float m_reg = -1e30f, l_reg = 0; f32x16 o[NOB] = {}; bf16x8 qr[NQR > 0 ? NQR : 1]; f32x16 nm = {};
  LAS char* ql = lds + SCR0 + 2048 + wid * (MODE == 0 ? 8192 : 4096) + lane * 16;
  const bf16* Qw = Qrow0 + (size_t)(wq * 32 + r32) * ldq + sgrp * 64 + hi * 8;
#pragma unroll
  for (int d0 = 0; d0 < NQR; ++d0) qr[d0] = ld8(Qw + d0 * 16);
#pragma unroll
  for (int d0 = NQR; d0 < NQF; ++d0) { bf16x8 qv = ld8(Qw + d0 * 16); if (LEAN) qv = scale_bf16x8(qv, C); *(LAS bf16x8*)(ql + (d0 - NQR) * 1024) = qv; }
  const int sr = tid >> 4, sc = (tid & 15) * 8, vst0 = v_st(sr, sc), vst1 = v_st(32 + sr, sc);
  const int kst0 = sr * PITCH + (((tid & 15) ^ kswz<PITCH>(sr)) * 16), kst1 = kst0 + 32 * PITCH;
  const int rrow = tid >> 3, krs = rrow * PITCH + (((16 + (tid & 7)) ^ kswz<PITCH>(rrow)) * 16);
  const int chunk0 = sgrp * 8;
  const int vb0 = (int)(uintptr_t)V_lds + v_rd_base(lane);
  struct Slot { bf16x8 vs0, vs1, ks0, ks1, kr; } sr_[SDEPTH];
#define KROW(jt) ((jt) < nct ? (ML + b * CTXL + (jt) * 64) : (b * SEQ + ((jt) - nct) * 64))
#define SLOAD(i, jt) do { const int k0_ = KROW(jt); sr_[i].vs0 = ld8(Vb + (size_t)(k0_ + sr) * ldk + sc); sr_[i].vs1 = ld8(Vb + (size_t)(k0_ + 32 + sr) * ldk + sc); \
    sr_[i].ks0 = ld8(Kb + (size_t)(k0_ + sr) * ldk + sc); sr_[i].ks1 = ld8(Kb + (size_t)(k0_ + 32 + sr) * ldk + sc); \
    if (MODE == 0) sr_[i].kr = ld8(KRb + (size_t)(k0_ + rrow) * 64 + (tid & 7) * 8); } while (0)
#define SWRITE(bf, i) do { *(LAS bf16x8*)(V_lds + VOFF(bf) + vst0) = sr_[i].vs0; *(LAS bf16x8*)(V_lds + VOFF(bf) + vst1) = sr_[i].vs1; \
    *(LAS bf16x8*)(K_lds + KOFF(bf) + kst0) = sr_[i].ks0; *(LAS bf16x8*)(K_lds + KOFF(bf) + kst1) = sr_[i].ks1; \
    if (MODE == 0) *(LAS bf16x8*)(K_lds + KOFF(bf) + krs) = sr_[i].kr; } while (0)
#define SWAIT() do { if constexpr (SDEPTH == 2) asm volatile("s_waitcnt vmcnt(4)" ::: "memory"); else asm volatile("s_waitcnt vmcnt(0)" ::: "memory"); } while (0)
#define RESC(a) do { if (__any((a) < 1.f)) { if (hi == 0) al_l[r32] = (a); asm volatile("s_waitcnt lgkmcnt(0)" ::: "memory"); \
    _Pragma("unroll") for (int d = 0; d < NOB; ++d) _Pragma("unroll") for (int r = 0; r < 16; ++r) o[d][r] *= al_l[crow(r, hi)]; } } while (0)
#define PV(vb_) do { if constexpr (PVPIPE) pv_pipe(o, (vb_), pa0, pa1, pa2, pa3); else pv_d0(o, (vb_), pa0, pa1, pa2, pa3); \
    if constexpr (LEAN) { const bf16x8 one8 = {0x3F80, 0x3F80, 0x3F80, 0x3F80, 0x3F80, 0x3F80, 0x3F80, 0x3F80};     \
        o[NOB - 1] = __builtin_amdgcn_mfma_f32_32x32x16_bf16(pa0, one8, o[NOB - 1], 0, 0, 0); o[NOB - 1] = __builtin_amdgcn_mfma_f32_32x32x16_bf16(pa1, one8, o[NOB - 1], 0, 0, 0); \
        o[NOB - 1] = __builtin_amdgcn_mfma_f32_32x32x16_bf16(pa2, one8, o[NOB - 1], 0, 0, 0); o[NOB - 1] = __builtin_amdgcn_mfma_f32_32x32x16_bf16(pa3, one8, o[NOB - 1], 0, 0, 0); } } while (0)
#define PSM(p0_, p1_, mn_, al_, first_) do { if constexpr (LEAN) partialSM_lean(p0_, p1_, nm, al_, first_); else partialSM(p0_, p1_, m_reg, mn_, al_, C, THRS); } while (0)
#define FSM(p0_, p1_, al_) do { if constexpr (LEAN) finishSM_lean(p0_, p1_, pa0, pa1, pa2, pa3); else finishSM(p0_, p1_, al_, l_reg, pa0, pa1, pa2, pa3); } while (0)
#define QKT(p0_, p1_, Kp_) do { if constexpr (LEAN) qkt<NQF, NQR, PITCH>(p0_, p1_, Kp_, chunk0, qr, ql, r32, hi, nm); else qkt<NQF, NQR, PITCH>(p0_, p1_, Kp_, chunk0, qr, ql, r32, hi); } while (0)
  f32x16 pA0, pA1, pB0, pB1; float mnA, mnB, alA, alB; bf16x8 pa0, pa1, pa2, pa3;
  if constexpr (!THREE) {
  constexpr int SE = 0, SO = SDEPTH - 1;
  SLOAD(SE, 0); asm volatile("s_waitcnt vmcnt(0)" ::: "memory"); SWRITE(0, SE); __syncthreads();
  QKT(pA0, pA1, K_lds + KOFF(0)); PSM(pA0, pA1, mnA, alA, true);
  SLOAD(SO, 1); if constexpr (SDEPTH == 2) { if (2 < NT) SLOAD(SE, 2); }
  SWAIT(); SWRITE(1, SO); __syncthreads();
  for (int j = 1; j + 1 < NT; j += 2) {
    SBAR(); QKT(pB0, pB1, K_lds + KOFF(1));
    FSM(pA0, pA1, alA); SBAR();
    SLOAD(SO, j + SDEPTH); SBAR();
    PV(vb0); PSM(pB0, pB1, mnB, alB, false);
    __syncthreads(); SWAIT(); SWRITE(0, SE);
    RESC(alB); __syncthreads();
    SBAR(); QKT(pA0, pA1, K_lds + KOFF(0));
    FSM(pB0, pB1, alB); SBAR();
    if (SDEPTH == 1 || j + 3 < NT) SLOAD(SE, j + 1 + SDEPTH); SBAR();
    PV(vb0 + VOFF(1)); PSM(pA0, pA1, mnA, alA, false);
    __syncthreads(); SWAIT(); SWRITE(1, SO);
    RESC(alA); __syncthreads();
  }
  SBAR(); QKT(pB0, pB1, K_lds + KOFF(1));
  FSM(pA0, pA1, alA); SBAR();
  PV(vb0); PSM(pB0, pB1, mnB, alB, false);
  __syncthreads(); RESC(alB);
  FSM(pB0, pB1, alB); SBAR();
  PV(vb0 + VOFF(1));
  } else {
#define STEP(PC0, PC1, ALC, PP0, PP1, ALP, jj, SP, SC, SN) do { const int j_ = (jj); \
      if (j_ + 1 < NT) { asm volatile("s_waitcnt vmcnt(0)" ::: "memory"); SWRITE(SN, 0); if (j_ + 2 < NT) SLOAD(0, j_ + 2); } \
      SBAR(); QKT(PC0, PC1, K_lds + KOFF(SC)); FSM(PP0, PP1, ALP); SBAR(); \
      PV(vb0 + VOFF(SP)); PSM(PC0, PC1, mnA, ALC, false); \
      RESC(ALC); __syncthreads(); } while (0)
    SLOAD(0, 0); asm volatile("s_waitcnt vmcnt(0)" ::: "memory"); SWRITE(0, 0);
    SLOAD(0, 1); asm volatile("s_waitcnt vmcnt(0)" ::: "memory"); SWRITE(1, 0);
    SLOAD(0, 2); __syncthreads();
    QKT(pA0, pA1, K_lds + KOFF(0)); PSM(pA0, pA1, mnA, alA, true);
    STEP(pB0, pB1, alB, pA0, pA1, alA, 1, 0, 1, 2);
    int j = 2;
    for (; j + 5 < NT; j += 6) {
      STEP(pA0, pA1, alA, pB0, pB1, alB, j, 1, 2, 0);
      STEP(pB0, pB1, alB, pA0, pA1, alA, j + 1, 2, 0, 1);
      STEP(pA0, pA1, alA, pB0, pB1, alB, j + 2, 0, 1, 2);
      STEP(pB0, pB1, alB, pA0, pA1, alA, j + 3, 1, 2, 0);
      STEP(pA0, pA1, alA, pB0, pB1, alB, j + 4, 2, 0, 1);
      STEP(pB0, pB1, alB, pA0, pA1, alA, j + 5, 0, 1, 2);
    }
    if (j < NT) { STEP(pA0, pA1, alA, pB0, pB1, alB, j, 1, 2, 0); STEP(pB0, pB1, alB, pA0, pA1, alA, j + 1, 2, 0, 1); j += 2; }
    if (j < NT) { STEP(pA0, pA1, alA, pB0, pB1, alB, j, 0, 1, 2); STEP(pB0, pB1, alB, pA0, pA1, alA, j + 1, 1, 2, 0); j += 2; }
    FSM(pB0, pB1, alB); SBAR();
    { const int sl = (NT - 1) % 3; PV(vb0 + VOFF(sl)); }
#undef STEP
  }
  float rli[16];
  if constexpr (LEAN) {
#pragma unroll
    for (int r = 0; r < 16; ++r) rli[r] = __builtin_amdgcn_rcpf(o[NOB - 1][r]);
  } else {
    if (hi == 0) li_l[r32] = l_reg; asm volatile("s_waitcnt lgkmcnt(0)" ::: "memory");
#pragma unroll
    for (int r = 0; r < 16; ++r) rli[r] = __builtin_amdgcn_rcpf(li_l[crow(r, hi)]);
  }
  bf16* Ow = Ob + (size_t)(wq * 32) * DM;
  if constexpr (MODE == 0) {
#pragma unroll
    for (int r = 0; r < 16; ++r) { const int orow = crow(r, hi);
#pragma unroll
      for (int d0 = 0; d0 < 4; ++d0) Ow[(size_t)orow * DM + d0 * 32 + r32] = tobf1(o[d0][r] * rli[r]); }
    __syncthreads();
  } else {
    LAS float* ex = (LAS float*)lds;
    __syncthreads();
    if (sgrp == 1) {
#pragma unroll
      for (int r = 0; r < 16; ++r)
#pragma unroll
        for (int d0 = 0; d0 < 4; ++d0) ex[(wq * 32 + crow(r, hi)) * 128 + d0 * 32 + r32] = o[d0][r] * rli[r];
    }
    __syncthreads();
    if (sgrp == 0) {
#pragma unroll
      for (int r = 0; r < 16; ++r) { const int orow = crow(r, hi); float dd[4]; float ss = 0.f;
#pragma unroll
        for (int d0 = 0; d0 < 4; ++d0) { dd[d0] = o[d0][r] * rli[r] - lam * ex[(wq * 32 + orow) * 128 + d0 * 32 + r32]; ss += dd[d0] * dd[d0]; }
        ss = half_sum32(ss);
        const float rs = oscale / sqrtf(ss * (1.0f / 128.0f) + LN_EPS);
#pragma unroll
        for (int d0 = 0; d0 < 4; ++d0) Ow[(size_t)orow * DM + d0 * 32 + r32] = tobf1(dd[d0] * rs * subln[d0 * 32 + r32]); }
    }
    __syncthreads();
  }
#undef VOFF
#undef KOFF
#undef PV
#undef PSM
#undef FSM
#undef QKT
#undef KROW
#undef SLOAD
#undef SWRITE
#undef SWAIT
#undef RESC
}
}

__device__ __forceinline__ void mla_attn_phase(CP P, LAS unsigned char* lds, const int tid) {
    const bf16* QM = (const bf16*)(P->ws + WS_QM); const bf16* KV = (const bf16*)(P->ws + WS_KV); const bf16* KR = (const bf16*)(P->ws + WS_KR); bf16* Gb = (bf16*)(P->ws + WS_G);
    const int c = blockIdx.x, G = gridDim.x;
    for (int u = c; u < 1024 + 32; u += G) {
        int b, h, qrow0, NT;
        if (u < 1024) { const int i = u >> 8, cc = u & 255; const int bh = (cc & 7) + 8 * i, qb = cc >> 3; b = bh >> 4; h = bh & 15; qrow0 = b * SEQ + qb * 256; NT = 4 + 128; }
        else { const int bh = u - 1024; b = bh >> 4; h = bh & 15; qrow0 = ML + b * CTXL; NT = 4; }
        att::attn_unit<0>(QM + (size_t)qrow0 * 3072 + h * 192, 3072, KV + h * 256, KV + h * 256 + 128, 4096, KR, b, 4, NT, Gb + (size_t)qrow0 * DM + h * 128, 0.f, nullptr, 1.f, lds, tid);
    }
}
__device__ __forceinline__ void da_attn_phase(CP P, float lam, float oscale, LAS unsigned char* lds, const int tid, const bool ctx_q) {
    const bf16* Z = (const bf16*)(P->ws + WS_Z); bf16* Gb = (bf16*)(P->ws + WS_G); const float* subln = P->in[27];
    const int c = blockIdx.x, G = gridDim.x;
    for (int u = c; u < 2048 + (ctx_q ? 64 : 0); u += G) {
        int b, h, qrow0, NT;
        if (u < 2048) { const int i = u >> 8, cc = u & 255; const int bh = (cc & 7) + 8 * (i >> 1), qb = (cc >> 3) + 32 * (i & 1); b = bh >> 4; h = bh & 15; qrow0 = b * SEQ + qb * 128; NT = 4 + 128; }
        else { const int v = u - 2048; const int bh = v >> 1; b = bh >> 4; h = bh & 15; qrow0 = ML + b * CTXL + (v & 1) * 128; NT = 4; }
        att::attn_unit<1>(Z + (size_t)qrow0 * 6144 + h * 128, 6144, Z + 2048 + h * 128, Z + 4096 + h * 128, 6144, nullptr, b, 4, NT, Gb + (size_t)qrow0 * DM + h * 128, lam, subln, oscale, lds, tid);
    }
}

__device__ __forceinline__ unsigned f2ord(float f) { const unsigned u = __float_as_uint(f); return u ^ ((unsigned)((int)u >> 31) | 0x80000000u); }
__device__ __forceinline__ float ord2f(unsigned k) { return __uint_as_float((k & 0x80000000u) ? (k ^ 0x80000000u) : ~k); }
__device__ __forceinline__ void ce_desc(unsigned& a, unsigned& b) { const unsigned mx = a > b ? a : b, mn = a > b ? b : a; a = mx; b = mn; }
template <int N, bool DESC> __device__ __forceinline__ void bitonic_merge(unsigned* a) {
#pragma unroll
    for (int j = N / 2; j > 0; j >>= 1)
#pragma unroll
        for (int i = 0; i < N; ++i) { const int l = i ^ j; if (l > i) { if (DESC) ce_desc(a[i], a[l]); else ce_desc(a[l], a[i]); } }
}
template <int N, bool DESC> __device__ __forceinline__ void bitonic_sort(unsigned* a) {
#pragma unroll
    for (int k = 2; k <= N; k <<= 1)
#pragma unroll
        for (int j = k >> 1; j > 0; j >>= 1)
#pragma unroll
            for (int i = 0; i < N; ++i) { const int l = i ^ j; if (l > i) { const bool up = ((i & k) == 0); if (up == DESC) ce_desc(a[i], a[l]); else ce_desc(a[l], a[i]); } }
}
__device__ __forceinline__ void top16_of_64(unsigned (&a)[64]) {
    bitonic_sort<16, true>(a); bitonic_sort<16, false>(a + 16); bitonic_sort<16, true>(a + 32); bitonic_sort<16, false>(a + 48);
#pragma unroll
    for (int i = 0; i < 16; ++i) a[i] = a[i] > a[16 + i] ? a[i] : a[16 + i];
    bitonic_merge<16, true>(a);
#pragma unroll
    for (int i = 0; i < 16; ++i) a[32 + i] = a[32 + i] > a[48 + i] ? a[32 + i] : a[48 + i];
    bitonic_merge<16, false>(a + 32);
#pragma unroll
    for (int i = 0; i < 16; ++i) a[i] = a[i] > a[32 + i] ? a[i] : a[32 + i];
    bitonic_merge<16, true>(a);
}
template <int PASS> __device__ __forceinline__ void route_pass(const bf16* QP, const LAS char* lds, int tok, int head, int r32, int hi, unsigned (&top)[16]) {
    f32x16 acc[4] = {};
    const bf16* qp = QP + (size_t)tok * DM + head * 256 + PASS * 128 + hi * 8;
    bf16x8 qf[8];
#pragma unroll
    for (int ks = 0; ks < 8; ++ks) qf[ks] = *(const bf16x8*)(qp + ks * 16);
    const LAS char* Kl = lds + PASS * 32768;
#pragma unroll
    for (int kb = 0; kb < 4; ++kb)
#pragma unroll
        for (int ks = 0; ks < 8; ++ks) { const bf16x8 a = *(const LAS bf16x8*)(Kl + (kb * 32 + r32) * 256 + (((ks * 2 + hi) ^ (r32 & 15)) * 16));
            acc[kb] = __builtin_amdgcn_mfma_f32_32x32x16_bf16(a, qf[ks], acc[kb], 0, 0, 0); }
    unsigned key[64]; const unsigned base = 127u - 4u * (unsigned)hi;
#pragma unroll
    for (int kb = 0; kb < 4; ++kb)
#pragma unroll
        for (int r = 0; r < 16; ++r) key[kb * 16 + r] = (f2ord(acc[kb][r]) & ~127u) | (base - (unsigned)(kb * 32 + (r & 3) + 8 * (r >> 2)));
    top16_of_64(key);
    unsigned pr[16];
#pragma unroll
    for (int i = 0; i < 16; ++i) pr[i] = lane_xor32(key[15 - i], hi << 5);
#pragma unroll
    for (int i = 0; i < 16; ++i) key[i] = key[i] > pr[i] ? key[i] : pr[i];
    bitonic_merge<16, true>(key);
#pragma unroll
    for (int i = 0; i < 16; ++i) top[i] = key[i];
}
__device__ __forceinline__ void route_phase(CP P, int L, int Mrows, LAS unsigned char* lds_, int tid, int lane, int wid, int gw, int NGW) {
    const bf16* QP = (const bf16*)(P->ws + WS_QP); unsigned* ROUTE = (unsigned*)(P->ws + WS_ROUTE);
    LAS char* lds = (LAS char*)(LAS unsigned char*)lds_;
    __syncthreads();
    {
        const bf16* K1 = (const bf16*)(P->ws + WS_PK1) + (size_t)L * 128 * 128; const bf16* K2 = (const bf16*)(P->ws + WS_PK2) + (size_t)L * 128 * 128;
        for (int c16 = tid; c16 < 2 * 128 * 16; c16 += NWAVES * 64) { const int mat = c16 >> 11, row = (c16 >> 4) & 127, ch = c16 & 15;
            const u32x4 w = *(const u32x4*)((mat ? K2 : K1) + row * 128 + ch * 8);
            *(LAS u32x4*)(lds + mat * 32768 + row * 256 + ((ch ^ (row & 15)) * 16)) = w; }
    }
    __syncthreads();
    LAS unsigned* sc = (LAS unsigned*)(lds + 65536) + wid * 2048;
    const int r32 = lane & 31, hi = lane >> 5;
    for (int item = gw; item < Mrows / 4; item += NGW) {
        const int tok = item * 4 + (r32 >> 3), head = r32 & 7;
        unsigned top0[16], top1[16];
        route_pass<0>(QP, lds, tok, head, r32, hi, top0);
        route_pass<1>(QP, lds, tok, head, r32, hi, top1);
        float v1[16], v2[16];
#pragma unroll
        for (int i = 0; i < 16; ++i) { v1[i] = ord2f(top0[i] & ~127u); v2[i] = ord2f(top1[i] & ~127u);
            sc[i * 64 + lane] = 127u - (top0[i] & 127u); sc[(16 + i) * 64 + lane] = 127u - (top1[i] & 127u); }
        unsigned ck[64]; int n = 0;
#pragma unroll
        for (int i = 0; i < 16; ++i)
#pragma unroll
            for (int j = 0; j < 16; ++j) if ((i + 1) * (j + 1) <= 16) { ck[n] = (f2ord(v1[i] + v2[j]) & ~255u) | (unsigned)(i * 16 + j); ++n; }
#pragma unroll
        for (int i = 50; i < 64; ++i) ck[i] = 0u;
        top16_of_64(ck);
        float ev[16]; float sum = 0.f; const float mx = ord2f(ck[0] & ~255u);
#pragma unroll
        for (int k = 0; k < 16; ++k) { ev[k] = __expf(ord2f(ck[k] & ~255u) - mx); sum += ev[k]; }
        const float inv = 1.0f / sum;
        unsigned ee[16];
#pragma unroll
        for (int k = 0; k < 16; ++k) { const unsigned pc = ck[k] & 255u; const unsigned i1 = sc[(pc >> 4) * 64 + lane], i2 = sc[(16 + (pc & 15u)) * 64 + lane]; ee[k] = i1 * 128u + i2; ev[k] *= inv; }
        u32x4* outp = (u32x4*)(ROUTE + ((size_t)tok * 128 + head * 16 + hi * 8) * 2);
#pragma unroll
        for (int k = 0; k < 8; k += 2) { u32x4 w;
            const unsigned eL0 = ee[k], eH0 = ee[k + 8], eL1 = ee[k + 1], eH1 = ee[k + 9]; const float gL0 = ev[k], gH0 = ev[k + 8], gL1 = ev[k + 1], gH1 = ev[k + 9];
            w.x = hi ? eH0 : eL0; w.y = __float_as_uint(hi ? gH0 : gL0); w.z = hi ? eH1 : eL1; w.w = __float_as_uint(hi ? gH1 : gL1);
            outp[k >> 1] = w; }
    }
}

typedef float f32x2 __attribute__((ext_vector_type(2)));
typedef float f32x32 __attribute__((ext_vector_type(32)));
typedef unsigned u32x6 __attribute__((ext_vector_type(6)));
typedef __bf16 bf16x32 __attribute__((ext_vector_type(32)));
typedef unsigned u32x16 __attribute__((ext_vector_type(16)));
typedef __bf16 bf16x2_t __attribute__((ext_vector_type(2)));
constexpr int GS = 6, GSLOT = 2 * PROW;
__device__ __forceinline__ void glds16(const void* gsrc, unsigned lds_dst) { unsigned keep;
  asm volatile("s_mov_b32 %0, m0\n\ts_mov_b32 m0, %2\n\ts_nop 0\n\tglobal_load_lds_dwordx4 %1, off\n\ts_mov_b32 m0, %0" : "=&s"(keep) : "v"(gsrc), "s"(lds_dst) : "memory"); }
template <int GMODE = 0>
__device__ __forceinline__ void gather_phase(CP P, int L, int Mrows, LAS unsigned char* lds, int wid, int lane_, int gw, int NGW, bool dry = false) {
    const unsigned char* UV = P->ws + WS_PU + (size_t)L * 16384 * PREC;
    const unsigned* ROUTE = (const unsigned*)(P->ws + WS_ROUTE); const float* MOD = (const float*)(P->ws + WS_MOD);
    bf16* X = (bf16*)(P->ws + WS_X); bf16* H = (bf16*)(P->ws + WS_H); bf16* Xo = dry ? (bf16*)(P->ws + WS_Y) : X; bf16* Ho = dry ? (bf16*)(P->ws + WS_G) : H;
    const float* lng = P->in[6] + (size_t)(L * 2 + 1) * DM; const float* lnb = P->in[7] + (size_t)(L * 2 + 1) * DM;
    const unsigned ring = (unsigned)(uintptr_t)lds + (unsigned)wid * (GS * GSLOT);
    for (int row = gw; row < Mrows; row += NGW) {
        const int lane = launder_v(lane_);
        const u32x2 ea = ((const u32x2*)(ROUTE + (size_t)row * 256))[lane], eb = ((const u32x2*)(ROUTE + (size_t)row * 256))[64 + lane];
        unsigned eax, eay, ebx, eby;
        unsigned hw[16];
#pragma unroll
        for (int j = 0; j < 4; ++j) { const u32x4 w = ((const u32x4*)(H + (size_t)row * DM))[4 * lane + j]; hw[4 * j] = w.x; hw[4 * j + 1] = w.y; hw[4 * j + 2] = w.z; hw[4 * j + 3] = w.w; }
        float y[32];
#pragma unroll
        for (int i = 0; i < 32; ++i) y[i] = 0.f;
        { unsigned e0 = ea.x, e1 = ea.y, e2 = eb.x, e3 = eb.y;
          asm volatile("" : "+v"(e0), "+v"(e1), "+v"(e2), "+v"(e3), "+v"(hw[0]), "+v"(hw[1]), "+v"(hw[2]), "+v"(hw[3]), "+v"(hw[4]), "+v"(hw[5]), "+v"(hw[6]), "+v"(hw[7]),
                       "+v"(hw[8]), "+v"(hw[9]), "+v"(hw[10]), "+v"(hw[11]), "+v"(hw[12]), "+v"(hw[13]), "+v"(hw[14]), "+v"(hw[15]) :: "memory");
          eax = e0; eay = e1; ebx = e2; eby = e3; }
        const unsigned rd_a = ring + 16u * (unsigned)lane, rd_b = ring + 2048u + 8u * (unsigned)lane;
#define G_ISSUE(k) do { const int k_ = (k); const unsigned e_ = (unsigned)__builtin_amdgcn_readlane((int)(k_ < 64 ? eax : ebx), k_ & 63); \
        const unsigned char* rp_ = UV + (size_t)e_ * PREC + 16 * lane; const unsigned sb_ = ring + (unsigned)(k_ % GS) * GSLOT; \
        if (GMODE != 2) { glds16(rp_, sb_); glds16(rp_ + 1024, sb_ + 1024); glds16(rp_ + 2048, sb_ + 2048); } else { asm volatile("" :: "v"(rp_), "s"(sb_)); } } while (0)
#pragma unroll
        for (int k = 0; k < 4; ++k) G_ISSUE(k);
#define G_READ(k, ua, ub, va, vb) do { const unsigned so_ = (unsigned)((k) % GS) * GSLOT; \
        asm volatile("ds_read_b128 %0, %4\n\tds_read_b64 %1, %5\n\tds_read_b128 %2, %4 offset:1024\n\tds_read_b64 %3, %5 offset:512" \
                     : "=&v"(ua), "=&v"(ub), "=&v"(va), "=&v"(vb) : "v"(rd_a + so_), "v"(rd_b + so_) : "memory"); } while (0)
#pragma unroll 1
        for (int k = 0; k < 128; k += 2) {
            if (k + 4 < 128) { G_ISSUE(k + 4); G_ISSUE(k + 5); asm volatile("s_waitcnt vmcnt(12)" ::: "memory"); }
            else if (k == 124) asm volatile("s_waitcnt vmcnt(6)" ::: "memory");
            else asm volatile("s_waitcnt vmcnt(0)" ::: "memory");
            u32x4 uaA, vaA, uaB, vaB; u32x2 ubA, vbA, ubB, vbB;
            G_READ(k, uaA, ubA, vaA, vbA); G_READ(k + 1, uaB, ubB, vaB, vbB);
            asm volatile("s_waitcnt lgkmcnt(0)" : "+v"(uaA), "+v"(ubA), "+v"(vaA), "+v"(vbA), "+v"(uaB), "+v"(ubB), "+v"(vaB), "+v"(vbB) :: "memory");
            if (GMODE == 1) continue;
            const u32x6 u6A = {uaA.x, uaA.y, uaA.z, uaA.w, ubA.x, ubA.y}, u6B = {uaB.x, uaB.y, uaB.z, uaB.w, ubB.x, ubB.y};
            const u32x16 ubfA = __builtin_bit_cast(u32x16, __builtin_amdgcn_cvt_scalef32_pk32_bf16_fp6(u6A, 1.0f));
            const u32x16 ubfB = __builtin_bit_cast(u32x16, __builtin_amdgcn_cvt_scalef32_pk32_bf16_fp6(u6B, 1.0f));
            float a0 = 0.f, a1 = 0.f, b0 = 0.f, b1 = 0.f;
#pragma unroll
            for (int q = 0; q < 16; q += 2) { const unsigned h0_ = hw[q], h1_ = hw[q + 1], x0_ = ubfA[q], x1_ = ubfA[q + 1], z0_ = ubfB[q], z1_ = ubfB[q + 1];
                a0 = __builtin_amdgcn_fdot2_f32_bf16(__builtin_bit_cast(bf16x2_t, h0_), __builtin_bit_cast(bf16x2_t, x0_), a0, false);
                a1 = __builtin_amdgcn_fdot2_f32_bf16(__builtin_bit_cast(bf16x2_t, h1_), __builtin_bit_cast(bf16x2_t, x1_), a1, false);
                b0 = __builtin_amdgcn_fdot2_f32_bf16(__builtin_bit_cast(bf16x2_t, h0_), __builtin_bit_cast(bf16x2_t, z0_), b0, false);
                b1 = __builtin_amdgcn_fdot2_f32_bf16(__builtin_bit_cast(bf16x2_t, h1_), __builtin_bit_cast(bf16x2_t, z1_), b1, false); }
            const float dA = wave_sum(a0 + a1) * (1.0f / U_SCALE), dB = wave_sum(b0 + b1) * (1.0f / U_SCALE);
            const unsigned gsel = k < 64 ? eay : eby;
            const float wA = __uint_as_float((unsigned)__builtin_amdgcn_readlane((int)gsel, k & 63)) * gelu_tanh(dA) * (1.0f / V_SCALE);
            const float wB = __uint_as_float((unsigned)__builtin_amdgcn_readlane((int)gsel, (k & 63) + 1)) * gelu_tanh(dB) * (1.0f / V_SCALE);
            const u32x6 v6A = {vaA.x, vaA.y, vaA.z, vaA.w, vbA.x, vbA.y};
            const f32x32 vfA = __builtin_amdgcn_cvt_scalef32_pk32_f32_fp6(v6A, 1.0f);
#pragma unroll
            for (int i = 0; i < 32; ++i) y[i] += wA * vfA[i];
            const u32x6 v6B = {vaB.x, vaB.y, vaB.z, vaB.w, vbB.x, vbB.y};
            const f32x32 vfB = __builtin_amdgcn_cvt_scalef32_pk32_f32_fp6(v6B, 1.0f);
#pragma unroll
            for (int i = 0; i < 32; ++i) y[i] += wB * vfB[i];
        }
#undef G_READ
#undef G_ISSUE
        const int slot = row_slot(row);
        const float* mod = MOD + (size_t)(L * 3 + slot) * 12288;
        const int le = launder_v(lane);
        { float xx[32], gg[32]; load_row_bf16_b(X + (size_t)row * DM, le, xx); load_row_f32_b(mod + 5 * 2048, le, gg);
#pragma unroll
          for (int i = 0; i < 32; ++i) y[i] = ALPHA * xx[i] + gg[i] * y[i]; }
        if (L < NLAYER - 1) { const float* modn = MOD + (size_t)((L + 1) * 3 + slot) * 12288;
            finish_row<true>(y, lng, lnb, Xo + (size_t)row * DM, modn, modn + 2048, Ho + (size_t)row * DM, nullptr, le); }
        else finish_row<true>(y, lng, lnb, nullptr, nullptr, nullptr, nullptr, P->out + (size_t)row * DM, le);
        asm volatile("s_waitcnt vmcnt(0)" ::: "memory");
    }
}

#ifndef ROPE_TEST
#define ROPE_TEST 0
#endif
#ifndef PROBE_DUP
#define PROBE_DUP 0
#endif
#define NOINL __forceinline__
__device__ __forceinline__ CP launder_cp(CP p) { asm volatile("" : "+s"(p)); return p; }
#define GETP() launder_cp((CP)__builtin_amdgcn_kernarg_segment_ptr())
__device__ __forceinline__ int uni(int v) { return __builtin_amdgcn_readfirstlane(v); }
__device__ __forceinline__ LAS unsigned char* uni_lds(LAS unsigned char* p) { return (LAS unsigned char*)(unsigned)__builtin_amdgcn_readfirstlane((int)(unsigned)(uintptr_t)p); }
#define PH_IDS const int wid = uni(wv_), lane = launder_v(lane_id_fresh()) & 63, tid = (wid & 7) * 64 + lane; const int gw = blockIdx.x * NWAVES + wid, NGW = gridDim.x * NWAVES; (void)lane; (void)gw; (void)NGW; (void)tid;

__device__ NOINL void ph_prologue(int wv_, LAS unsigned char* lds_) { CP P = GETP(); LAS unsigned char* lds = uni_lds(lds_); PH_IDS p0_prologue(P, lds, tid, lane, wid, gw, NGW); if (PROBE_DUP == 5) p0_prologue(P, lds, tid, lane, wid, gw, NGW); }
__device__ NOINL void ph_modreduce(int wv_) { CP P = GETP(); PH_IDS mod_reduce(P, gw, lane, NGW); }
__device__ NOINL void ph_first(int wv_) { CP P = GETP(); PH_IDS
#pragma unroll 1
    for (int rep = 0; rep < (PROBE_DUP == 6 ? 2 : 1); ++rep) first_row_pass(P, lane, gw, NGW); }
__device__ NOINL void ph_postmix(int wv_, int L_, int M_) { CP P = GETP(); const int L = uni(L_), Mrows = uni(M_); PH_IDS post_mixer_pass(P, L, Mrows, lane, gw, NGW); }
__device__ NOINL void ph_vstats(int wv_, int M_) { CP P = GETP(); const int Mrows = uni(M_); PH_IDS
#pragma unroll 1
    for (int rep = 0; rep < (PROBE_DUP == 6 ? 2 : 1); ++rep) vstats_pass(P, Mrows, lane, gw, NGW); }
__device__ NOINL void ph_spatial(int wv_, LAS unsigned char* lds_, int j_, int M_) { CP P = GETP(); LAS unsigned char* lds = uni_lds(lds_); const int j = uni(j_), Mrows = uni(M_); PH_IDS
#pragma unroll 1
    for (int rep = 0; rep < (PROBE_DUP == 6 ? 2 : 1); ++rep) spatial_phase(P, j, Mrows, lds, tid, lane, wid); }
__device__ NOINL void ph_mla_norm(int wv_) { CP P = GETP(); PH_IDS
#pragma unroll 1
    for (int rep = 0; rep < (PROBE_DUP == 6 ? 2 : 1); ++rep) mla_norm_pass(P, lane, gw, NGW); }
__device__ NOINL void ph_rope(int wv_, int which_) { CP P = GETP(); const int which = uni(which_); PH_IDS
    if (which == 0) rope_pass((bf16*)(P->ws + WS_QM), 3072, 128, 16, 192, lane, gw, NGW);
    else rope_pass((bf16*)(P->ws + WS_Z), 6144, 0, 64, 64, lane, gw, NGW); }
__device__ NOINL void ph_attn_mla(int wv_, LAS unsigned char* lds_) { CP P = GETP(); LAS unsigned char* lds = uni_lds(lds_); PH_IDS mla_attn_phase(P, lds, tid); if (PROBE_DUP == 2 || PROBE_DUP == 9) mla_attn_phase(P, lds, tid); }
__device__ NOINL void ph_attn_da(int wv_, LAS unsigned char* lds_, int L_, bool ctx_q) { CP P = GETP(); LAS unsigned char* lds = uni_lds(lds_); const int L = uni(L_); PH_IDS
    const float* lp = P->in[26];
    const float s01 = wave_sum(lp[lane] * lp[64 + lane]), s23 = wave_sum(lp[128 + lane] * lp[192 + lane]);
    const float lam_init = 0.8f - 0.6f * expf(-0.3f * (float)L);
    const float lam = expf(s01) - expf(s23) + lam_init;
    da_attn_phase(P, lam, 1.0f - lam_init, lds, tid, ctx_q); if (PROBE_DUP == 2 || PROBE_DUP == 10) da_attn_phase(P, lam, 1.0f - lam_init, lds, tid, ctx_q); }
__device__ NOINL void ph_route(int wv_, LAS unsigned char* lds_, int L_, int M_) { CP P = GETP(); LAS unsigned char* lds = uni_lds(lds_); const int L = uni(L_), Mrows = uni(M_); PH_IDS
#pragma unroll 1
    for (int rep = 0; rep < (PROBE_DUP == 4 ? 2 : 1); ++rep) route_phase(P, L, Mrows, lds, tid, lane, wid, gw, NGW); }
__device__ NOINL void ph_gather(int wv_, LAS unsigned char* lds_, int L_, int M_) { CP P = GETP(); LAS unsigned char* lds = uni_lds(lds_); const int L = uni(L_), Mrows = uni(M_); PH_IDS
    if (PROBE_DUP == 3) { gather_phase<0>(P, L, Mrows, lds, wid, lane, gw, NGW, true); }
    if (PROBE_DUP == 7) { gather_phase<1>(P, L, Mrows, lds, wid, lane, gw, NGW, true); }
    if (PROBE_DUP == 8) { gather_phase<2>(P, L, Mrows, lds, wid, lane, gw, NGW, true); }
    gather_phase<0>(P, L, Mrows, lds, wid, lane, gw, NGW); }

enum GemmId { G_GM_IN = 0, G_GM_OUT, G_MLA_IN, G_MLA_UQ, G_MLA_UKV, G_MLA_OUT, G_DA_IN, G_DA_OUT, G_PEER_Q };
__device__ NOINL void ph_gemm(int wv_, LAS unsigned char* lds_, int id_, int L_, int M_) {
    CP P = GETP(); LAS unsigned char* lds = uni_lds(lds_); const int id = uni(id_), L = uni(L_), Mrows = uni(M_); PH_IDS
    unsigned char* ws = P->ws; const int jj = L / 3;
    size_t a = WS_H, b = 0, o = 0; int M = MT, N = 2048, K = 2048, act = 0, rope = 0;
    switch (id) {
        case G_GM_IN:   a = WS_H;    b = WS_GMWIN + (size_t)jj * 4096 * 2048 * 2;  o = WS_Z;  M = Mrows; N = 4096; K = 2048; act = 1; break;
        case G_GM_OUT:  a = WS_G;    b = WS_GMWOUT + (size_t)jj * 2048 * 2048 * 2; o = WS_Y;  M = Mrows; N = 2048; K = 2048; break;
        case G_MLA_IN:  a = WS_H;    b = WS_MLAIN;  o = WS_C;  N = 1280; K = 2048; break;
        case G_MLA_UQ:  a = WS_CQN;  b = WS_MLAUQ;  o = WS_QM; N = 3072; K = 512;  rope = (ROPE_TEST == 2) ? 0 : 2; break;
        case G_MLA_UKV: a = WS_CKVN; b = WS_MLAUKV; o = WS_KV; N = 4096; K = 512;  break;
        case G_MLA_OUT: a = WS_G;    b = WS_MLAOUT; o = WS_Y;  N = 2048; K = 2048; break;
        case G_DA_IN:   a = WS_H;    b = WS_DAIN;   o = WS_Z;  N = 6144; K = 2048; rope = (ROPE_TEST == 1) ? 0 : 1; break;
        case G_DA_OUT:  a = WS_G;    b = WS_DAOUT;  o = WS_Y;  M = Mrows; N = 2048; K = 2048; break;
        default:        a = WS_H;    b = WS_PWQ + (size_t)L * 2048 * 2048 * 2;     o = WS_QP; M = Mrows; N = 2048; K = 2048; break;
    }
    pg8::Gemm g{(const pg8::bf16_t*)(ws + a), (const pg8::bf16_t*)(ws + b), M, N, K}; pg8::StaticOrder S; S.init(M, N, (int)gridDim.x, (int)blockIdx.x);
    pg8::EpiR E{(pg8::bf16_t*)(ws + o), N, act, rope, (const float*)(ws + WS_ROPE)};
#pragma unroll 1
    for (int rep = 0; rep < (PROBE_DUP == 1 ? 2 : 1); ++rep) { pg8::gemm_phase<pg8::EpiR, pg8::StaticOrder, true, true>((PG8_LAS unsigned char*)lds, g, S, E, tid); __syncthreads(); }
    const bool tail_u = (id == G_GM_OUT || id == G_MLA_OUT || id == G_DA_OUT), tail_v = (id == G_PEER_Q);
    if ((tail_u || tail_v) && L + 1 < NLAYER) {
        const int units = (M / 256) * (N / 256), G = (int)gridDim.x, tail = units % G, c = (int)blockIdx.x;
        const float* src = (tail_u ? P->in[11] : P->in[12]) + (size_t)(L + 1) * 16384 * 2048; unsigned char* dst = ws + WS_PU + (size_t)(L + 1) * 16384 * PREC;
        LAS float* scr = (LAS float*)(lds + wid * 16384);
        if (tail != 0 && c >= tail) cvt_table_fp6(src, dst, 16384, tail_u ? U_SCALE : V_SCALE, scr, lane, (c - tail) * NWAVES + wid, (G - tail) * NWAVES, tail_u ? 0 : 1);
        else if (tail == 0) cvt_table_fp6(src, dst, 16384, tail_u ? U_SCALE : V_SCALE, scr, lane, gw, NGW, tail_u ? 0 : 1);
    }
}

__global__ void __launch_bounds__(NWAVES * 64, 2) mk_fwd(Params Pv) {
    extern __shared__ __attribute__((aligned(16))) unsigned char lds_g[];
    LAS unsigned char* lds = (LAS unsigned char*)lds_g;
    const int wv = __builtin_amdgcn_readfirstlane((int)threadIdx.x >> 6);
    const int tid = wv * 64 + lane_id_fresh();
    for (int u = tid; u < (LDS_BYTES - RING_BYTES) / 4; u += NWAVES * 64) ((LAS unsigned*)(lds + RING_BYTES))[u] = 0u;
    __syncthreads();
    const int lo = Pv.ph_lo, hi = Pv.ph_hi;
    unsigned* barw = (unsigned*)(Pv.ws + WS_CTL) + CW_BAR;
    XcdBarrier bar; bar.bar = barw; bar.x = 0; bar.st = nullptr;
    if (hi - lo > 1) bar = xcd_barrier_post(barw, (volatile LAS unsigned*)(lds + MISC_OFF) + 8, tid == 0);
    int ph = 0;
#ifndef SEL
#define SELP(k) true
#else
#define SELP(k) ((k) == SEL)
#endif
    enum { RUN_BASE = __COUNTER__ + 1 };
#define RUN(call) do { if (SELP(__COUNTER__ - RUN_BASE) && ph >= lo && ph < hi) { call; } if (ph >= lo && ph + 1 < hi) xcd_barrier(bar, wv == 0 && lane_id_fresh() == 0); ++ph; } while (0)
    RUN(ph_prologue(wv, lds));
    RUN(ph_modreduce(wv));
    RUN(ph_first(wv));
#define LAYER(LL) do { constexpr int L = (LL); constexpr int kind = L % 3, jj = L / 3; constexpr int Mrows = (L == NLAYER - 1) ? ML : MT; \
        constexpr bool ctx_dead = (L == NLAYER - 2) && ((NLAYER - 1) % 3 == 0) && (kind != 0); constexpr int Mlive = ctx_dead ? ML : Mrows; \
        if (kind == 0) {                          \
            RUN(ph_gemm(wv, lds, G_GM_IN, L, Mrows)); \
            RUN(ph_vstats(wv, Mrows)); \
            RUN(ph_spatial(wv, lds, jj, Mrows)); \
            RUN(ph_gemm(wv, lds, G_GM_OUT, L, Mrows)); \
        } else if (kind == 1) {                   \
            RUN(ph_gemm(wv, lds, G_MLA_IN, L, Mrows)); \
            RUN(ph_mla_norm(wv)); \
            RUN(ph_gemm(wv, lds, G_MLA_UQ, L, Mrows); ph_gemm(wv, lds, G_MLA_UKV, L, Mrows)); \
            if (ROPE_TEST == 2) { RUN(ph_rope(wv, 0)); } \
            RUN(ph_attn_mla(wv, lds)); \
            RUN(ph_gemm(wv, lds, G_MLA_OUT, L, Mrows)); \
        } else {                                  \
            RUN(ph_gemm(wv, lds, G_DA_IN, L, Mrows); if (ROPE_TEST == 1) { __syncthreads(); } ); \
            if (ROPE_TEST == 1) { RUN(ph_rope(wv, 1)); } \
            RUN(ph_attn_da(wv, lds, L, !ctx_dead)); \
            RUN(ph_gemm(wv, lds, G_DA_OUT, L, Mlive)); \
        } \
        RUN(ph_postmix(wv, L, Mlive));                \
        RUN(ph_gemm(wv, lds, G_PEER_Q, L, Mlive));    \
        RUN(ph_route(wv, lds, L, Mlive));             \
        RUN(ph_gather(wv, lds, L, Mlive));            \
    } while (0)
    LAYER(0); LAYER(1); LAYER(2); LAYER(3);
#undef LAYER
#undef RUN
}

extern "C" void kernel_launch(void* const* d_in, const int* in_sizes, int n_in, void* d_out, int out_size, void* d_ws, size_t ws_size, hipStream_t stream) {
    static int grid = 0;
    if (grid == 0) {
        if (n_in != 29 || in_sizes[0] != ML * DM || out_size != ML * DM || ws_size < WS_END) {
            fprintf(stderr, "kernel_launch: shape mismatch: n_in %d in0 %d out %d ws %zu (need %zu); nothing launched\n", n_in, n_in > 0 ? in_sizes[0] : -1, out_size, ws_size, (size_t)WS_END); grid = -1; return; }
        int dev = 0, cus = 0, per_cu = 0;
        if (hipGetDevice(&dev) != hipSuccess || hipDeviceGetAttribute(&cus, hipDeviceAttributeMultiprocessorCount, dev) != hipSuccess) { fprintf(stderr, "kernel_launch: device query failed\n"); grid = -1; return; }
        if (hipFuncSetAttribute((const void*)mk_fwd, hipFuncAttributeMaxDynamicSharedMemorySize, LDS_BYTES) != hipSuccess) { fprintf(stderr, "kernel_launch: hipFuncSetAttribute failed\n"); grid = -1; return; }
        if (hipOccupancyMaxActiveBlocksPerMultiprocessor(&per_cu, (const void*)mk_fwd, NWAVES * 64, LDS_BYTES) != hipSuccess || per_cu < 1)
            fprintf(stderr, "kernel_launch: note: occupancy query reports %d workgroups per CU\n", per_cu);
        (void)hipGetLastError();
        grid = cus;
    }
    if (grid < 0) return;
    if (hipMemsetAsync((char*)d_ws + WS_CTL, 0, CTL_ZERO_BYTES, stream) != hipSuccess) { fprintf(stderr, "kernel_launch: memset failed\n"); return; }
    Params p{};
    for (int i = 0; i < 29; ++i) p.in[i] = (const float*)d_in[i];
    p.out = (float*)d_out; p.ws = (unsigned char*)d_ws;
#if MK_ONE_LAUNCH
    p.ph_lo = 0; p.ph_hi = NPH;
    hipLaunchKernelGGL(mk_fwd, dim3(grid), dim3(NWAVES * 64), LDS_BYTES, stream, p);
#else
    for (int li = 0; li < NPH; ++li) { p.ph_lo = li; p.ph_hi = li + 1; hipLaunchKernelGGL(mk_fwd, dim3(grid), dim3(NWAVES * 64), LDS_BYTES, stream, p); }
#endif
    const hipError_t le = hipPeekAtLastError();
    if (le != hipSuccess) fprintf(stderr, "kernel_launch: launch failed: %s\n", hipGetErrorName(le));
}
```

```cpp
#include <hip/hip_runtime.h>
#include <cstdio>
#include <cstdint>
#ifndef MK_ONE_LAUNCH
#define MK_ONE_LAUNCH 1
#endif
__device__ __forceinline__ int launder_v(int v) { asm volatile("" : "+v"(v)); return v; }
__device__ __forceinline__ int lane_id_fresh() { unsigned m = ~0u; asm volatile("" : "+s"(m)); return (int)__builtin_amdgcn_mbcnt_hi(m, __builtin_amdgcn_mbcnt_lo(m, 0u)); }
namespace pg8 {
#define PG8_LAS __attribute__((address_space(3)))
typedef unsigned short bf16_t;
typedef short bf16x8 __attribute__((ext_vector_type(8)));
typedef float f32x4 __attribute__((ext_vector_type(4)));
typedef unsigned u32x4 __attribute__((ext_vector_type(4)));
constexpr int BM = 256, BK = 64, HALF = 128, HTB = HALF * BK * 2  , STAGE_BYTES = 8 * HTB, NXCD = 8, WGM = 8;

__host__ __device__ __forceinline__ int lds_byte(int r, int c) { const int st = (r >> 4) * 2 + (c >> 5), rr = r & 15, cc = c & 31, ob = rr * 64 + cc * 2; return st * 1024 + (ob ^ (((ob >> 9) & 1) << 5)); }
__host__ __device__ __forceinline__ void stage_rc(int b, int& R, int& C) { const int st = b / 1024, sb = b % 1024, swz = sb ^ (((sb >> 9) & 1) << 5); R = (st >> 1) * 16 + swz / 64; C = (st & 1) * 32 + (swz % 64) / 2; }
__host__ __device__ __forceinline__ int perm32(int rho) { const int n = rho >> 4, i = rho & 15; return 8 * (i >> 2) + 4 * n + (i & 3); }

struct Unit { int pm, pn; };
struct Gemm { const bf16_t* A; const bf16_t* Bt; int M, N, K; };

struct StaticOrder {
    int nM, nN, nwg, G, c;
    __host__ __device__ void init(int M, int N, int G_, int c_) { nM = M / BM; nN = N / BM; nwg = nM * nN; G = G_; c = c_; }
    __host__ __device__ bool next(int i, Unit& u) const {
        const long L = (long)i * G + c; if (L >= nwg) return false;
        int wgid = (int)L; { const int q = nwg / NXCD, r = nwg % NXCD, xcd = wgid % NXCD, off = wgid / NXCD; wgid = (xcd < r ? xcd * (q + 1) : r * (q + 1) + (xcd - r) * q) + off; }
        const int nig = WGM * nN, gid = wgid / nig, fm = gid * WGM, gsz = (nM - fm) < WGM ? (nM - fm) : WGM;
        u.pm = fm + ((wgid % nig) % gsz); u.pn = (wgid % nig) / gsz; return true;
    }
    __device__ __forceinline__ void a_ready(const Unit&) const {}
    __device__ __forceinline__ void done(const Unit&) const {}
};

__device__ __forceinline__ unsigned cvt_pk_bf16(float lo, float hi) { unsigned r; asm volatile("v_cvt_pk_bf16_f32 %0, %1, %2" : "=v"(r) : "v"(lo), "v"(hi)); return r; }
typedef float f32x2 __attribute__((ext_vector_type(2)));
__device__ __forceinline__ f32x2 gelu_pk(f32x2 v) {
    const f32x2 av = __builtin_elementwise_abs(v), d = av * 0.2316418882f + 1.0f;
    f32x2 t; t.x = __builtin_amdgcn_rcpf(d.x); t.y = __builtin_amdgcn_rcpf(d.y);
    f32x2 q = t * 0.5307027145f + (-0.7265760135f); q = q * t + 0.7107068705f; q = q * t + (-0.142248368f); q = q * t + 0.127414796f; q = q * t;
    const f32x2 s = (v * v) * (-0.72134752044f);
    f32x2 e; e.x = __builtin_amdgcn_exp2f(s.x); e.y = __builtin_amdgcn_exp2f(s.y);
    const f32x2 m = v * (q * e), r = v - m;
    f32x2 o; o.x = v.x < 0.f ? m.x : r.x; o.y = v.y < 0.f ? m.y : r.y; return o;
}

template <int ACT  > struct EpiBf16 {
    static constexpr bool PERM = true, AFTER_DRAIN = false; static_assert(ACT == 0 || ACT == 1, "EpiBf16: ACT is 0 (none) or 1 (gelu_pk)");
    bf16_t* O; int ldc; const float* bias; int split_cols; size_t split_stride; float scale0;
    __device__ __forceinline__ void operator()(const f32x4 (&acc)[2][2][4][2], const Unit& u, int wr, int wc, int fr, int fq) const {
        const int row0 = u.pm * BM + wr * 64 + fr; int colt = u.pn * BM; bf16_t* base = O;
        float sc = 1.f; if (split_cols) { const int t = colt / split_cols; base += (size_t)t * split_stride; colt -= t * split_cols; if (t == 0) sc = scale0; }
        const int col0 = colt + wc * 32 + 8 * fq, bcol0 = u.pn * BM + wc * 32 + 8 * fq;
        f32x4 bv[2][2];
#pragma unroll
        for (int bj = 0; bj < 2; ++bj)
#pragma unroll
            for (int n = 0; n < 2; ++n) bv[bj][n] = bias ? *(const f32x4*)(bias + bcol0 + bj * HALF + 4 * n) : (f32x4){0.f, 0.f, 0.f, 0.f};
#pragma unroll
        for (int ai = 0; ai < 2; ++ai)
#pragma unroll
            for (int m = 0; m < 4; ++m) { bf16_t* rowp = base + (size_t)(row0 + ai * HALF + m * 16) * ldc + col0;
#pragma unroll
                for (int bj = 0; bj < 2; ++bj) { f32x4 v0 = acc[ai][bj][m][0] + bv[bj][0], v1 = acc[ai][bj][m][1] + bv[bj][1];
                    if (ACT == 1) { f32x2 a = gelu_pk((f32x2){v0[0], v0[1]}), b = gelu_pk((f32x2){v0[2], v0[3]}), c = gelu_pk((f32x2){v1[0], v1[1]}), d = gelu_pk((f32x2){v1[2], v1[3]});
                        v0 = (f32x4){a.x, a.y, b.x, b.y}; v1 = (f32x4){c.x, c.y, d.x, d.y}; }
                    v0 = v0 * sc; v1 = v1 * sc; u32x4 w; w.x = cvt_pk_bf16(v0[0], v0[1]); w.y = cvt_pk_bf16(v0[2], v0[3]); w.z = cvt_pk_bf16(v1[0], v1[1]); w.w = cvt_pk_bf16(v1[2], v1[3]);
                    *(u32x4*)(rowp + bj * HALF) = w; } }
    }
};
template <class Epi, class Sched, bool ALIGN_EPI = false, bool SP2 = false>
__device__ __forceinline__ void gemm_phase(PG8_LAS unsigned char* lds, const Gemm g, const Sched& S, const Epi& E, const int tid_in) {
    const int tid = launder_v(tid_in) & 511, wid = __builtin_amdgcn_readfirstlane(tid >> 6), lane = tid & 63, wr = wid >> 2, wc = wid & 3, fr = lane & 15, fq = lane >> 4;
    const int K = g.K, nt = K / BK;
    unsigned voffA[2], voffB[2];
#pragma unroll
    for (int i = 0; i < 2; ++i) { int R, C; stage_rc(tid * 16 + i * 8192, R, C); const int Rb = Epi::PERM ? ((R & ~31) + perm32(R & 31)) : R;
        voffA[i] = (unsigned)(R * K + C) * 2u; voffB[i] = (unsigned)(Rb * K + C) * 2u; }
    const size_t kstep = (size_t)(BK * 2);
    const size_t hstep = (size_t)HALF * K * 2;
    const size_t tstep = 2 * hstep;
    const unsigned ldsw = (unsigned)wid * 1024u;
    const int aoff = lds_byte(wr * 64 + fr, fq * 8), boff = lds_byte(wc * 32 + fr, fq * 8);
#define PG8_SA(b, h) (((b) * 2 + (h)) * HTB)
#define PG8_SB(b, h) ((4 + (b) * 2 + (h)) * HTB)
#define PG8_STAGE(bufoff, gbase, voff) do { _Pragma("unroll") for (int _i = 0; _i < 2; ++_i) \
        __builtin_amdgcn_global_load_lds((const unsigned*)((const char*)(gbase) + (voff)[_i]), (PG8_LAS unsigned*)(lds + (bufoff) + ldsw + _i * 8192), 16, 0, 0); } while (0)
#define PG8_LDA(dst, b, h) do { _Pragma("unroll") for (int m = 0; m < 4; ++m) _Pragma("unroll") for (int k = 0; k < 2; ++k) dst[m][k] = *(const PG8_LAS bf16x8*)(lds + PG8_SA(b, h) + aoff + m * 2048 + k * 1024); } while (0)
#define PG8_LDB(dst, b, h) do { _Pragma("unroll") for (int n = 0; n < 2; ++n) _Pragma("unroll") for (int k = 0; k < 2; ++k) dst[n][k] = *(const PG8_LAS bf16x8*)(lds + PG8_SB(b, h) + boff + n * 2048 + k * 1024); } while (0)
#define PG8_MMA(ai, bj, At, Bt) do { __builtin_amdgcn_s_setprio(1); _Pragma("unroll") for (int m = 0; m < 4; ++m) _Pragma("unroll") for (int n = 0; n < 2; ++n) _Pragma("unroll") for (int k = 0; k < 2; ++k) \
        acc[ai][bj][m][n] = __builtin_amdgcn_mfma_f32_16x16x32_bf16(Bt[n][k], At[m][k], acc[ai][bj][m][n], 0, 0, 0); __builtin_amdgcn_s_setprio(0); } while (0)
#define PG8_WAIT_V(n) asm volatile("s_waitcnt vmcnt(" #n ")" ::: "memory")
#define PG8_WAIT_L(n) asm volatile("s_waitcnt lgkmcnt(" #n ")" ::: "memory")
#define PG8_BAR __builtin_amdgcn_s_barrier()
#define PG8_SCHED __builtin_amdgcn_sched_barrier(0)
    Unit cur, nxt; int ui = 0;
    if (!S.next(0, cur)) return;
    f32x4 acc[2][2][4][2];
#pragma unroll
    for (int a = 0; a < 2; ++a)
#pragma unroll
        for (int b = 0; b < 2; ++b)
#pragma unroll
            for (int m = 0; m < 4; ++m)
#pragma unroll
                for (int n = 0; n < 2; ++n) acc[a][b][m][n] = (f32x4){0.f, 0.f, 0.f, 0.f};
    bf16x8 At[4][2], B0[2][2], B1[2][2];
    const char* cA = (const char*)g.A + (size_t)cur.pm * tstep; const char* cB = (const char*)g.Bt + (size_t)cur.pn * tstep;
    S.a_ready(cur);
    if constexpr (SP2) {
        PG8_STAGE(PG8_SB(0, 0), cB, voffB); PG8_STAGE(PG8_SB(0, 1), cB + hstep, voffB); PG8_STAGE(PG8_SA(0, 0), cA, voffA); PG8_STAGE(PG8_SA(0, 1), cA + hstep, voffA);
        if (wr == 1) PG8_BAR;
        PG8_WAIT_V(2); PG8_BAR;
        PG8_STAGE(PG8_SB(1, 0), cB + kstep, voffB); PG8_STAGE(PG8_SA(1, 0), cA + kstep, voffA); PG8_STAGE(PG8_SB(1, 1), cB + hstep + kstep, voffB);
        PG8_WAIT_V(6); PG8_BAR;
    } else {
        PG8_STAGE(PG8_SB(0, 0), cB, voffB); PG8_STAGE(PG8_SA(0, 0), cA, voffA); PG8_STAGE(PG8_SB(0, 1), cB + hstep, voffB); PG8_STAGE(PG8_SA(0, 1), cA + hstep, voffA);
        if (wr == 1) PG8_BAR;
        PG8_WAIT_V(4); PG8_BAR;
        PG8_STAGE(PG8_SB(1, 0), cB + kstep, voffB); PG8_STAGE(PG8_SA(1, 0), cA + kstep, voffA); PG8_STAGE(PG8_SB(1, 1), cB + hstep + kstep, voffB);
        PG8_WAIT_V(6); PG8_BAR;
    }
    for (;;) {
        const bool has_next = S.next(ui + 1, nxt);
        const char* nA = has_next ? (const char*)g.A + (size_t)nxt.pm * tstep : cA; const char* nB = has_next ? (const char*)g.Bt + (size_t)nxt.pn * tstep : cB;
        for (int t = 0; t < nt; t += 2) {
            const bool last = (t == nt - 2);
            const char* a1 = cA + (size_t)(t + 1) * kstep;
            const char* a2 = last ? nA : cA + (size_t)(t + 2) * kstep; const char* b2 = last ? nB : cB + (size_t)(t + 2) * kstep;
            const char* a3 = a2 + kstep; const char* b3 = b2 + kstep;
            if (last && has_next) S.a_ready(nxt);
            if constexpr (SP2) {
            PG8_LDB(B0, 0, 0); PG8_LDB(B1, 0, 1); PG8_SCHED; PG8_LDA(At, 0, 0); PG8_STAGE(PG8_SA(1, 1), a1 + hstep, voffA);
            PG8_WAIT_V(8); PG8_WAIT_L(0); PG8_BAR; PG8_MMA(0, 0, At, B0); PG8_MMA(0, 1, At, B1); PG8_BAR; PG8_SCHED;
            PG8_LDA(At, 0, 1); PG8_STAGE(PG8_SB(0, 0), b2, voffB); PG8_STAGE(PG8_SB(0, 1), b2 + hstep, voffB); PG8_STAGE(PG8_SA(0, 0), a2, voffA);
            PG8_WAIT_V(8); PG8_WAIT_L(0); PG8_BAR; PG8_MMA(1, 0, At, B0); PG8_MMA(1, 1, At, B1); PG8_BAR; PG8_SCHED;
            PG8_LDB(B0, 1, 0); PG8_LDB(B1, 1, 1); PG8_SCHED; PG8_LDA(At, 1, 0); PG8_STAGE(PG8_SA(0, 1), a2 + hstep, voffA);
            PG8_WAIT_V(8); PG8_WAIT_L(0); PG8_BAR; PG8_MMA(0, 0, At, B0); PG8_MMA(0, 1, At, B1); PG8_BAR; PG8_SCHED;
            PG8_LDA(At, 1, 1); PG8_STAGE(PG8_SB(1, 0), b3, voffB); PG8_STAGE(PG8_SB(1, 1), b3 + hstep, voffB); PG8_STAGE(PG8_SA(1, 0), a3, voffA);
            PG8_WAIT_V(8); PG8_WAIT_L(0); PG8_BAR; PG8_MMA(1, 0, At, B0); PG8_MMA(1, 1, At, B1); PG8_BAR; PG8_SCHED;
            } else {
            PG8_LDB(B0, 0, 0); PG8_SCHED; PG8_LDA(At, 0, 0); PG8_STAGE(PG8_SA(1, 1), a1 + hstep, voffA);
            PG8_WAIT_L(8); PG8_BAR; PG8_WAIT_L(0); PG8_MMA(0, 0, At, B0); PG8_BAR; PG8_SCHED;
            PG8_LDB(B1, 0, 1); PG8_STAGE(PG8_SB(0, 0), b2, voffB);
            PG8_BAR; PG8_WAIT_L(0); PG8_MMA(0, 1, At, B1); PG8_BAR;
            PG8_LDA(At, 0, 1); PG8_STAGE(PG8_SA(0, 0), a2, voffA);
            PG8_BAR; PG8_WAIT_L(0); PG8_MMA(1, 0, At, B0); PG8_BAR; PG8_SCHED;
            PG8_STAGE(PG8_SB(0, 1), b2 + hstep, voffB);
            PG8_WAIT_V(6); PG8_BAR; PG8_MMA(1, 1, At, B1); PG8_BAR;
            PG8_LDB(B0, 1, 0); PG8_SCHED; PG8_LDA(At, 1, 0); PG8_STAGE(PG8_SA(0, 1), a2 + hstep, voffA);
            PG8_WAIT_L(8); PG8_BAR; PG8_WAIT_L(0); PG8_MMA(0, 0, At, B0); PG8_BAR; PG8_SCHED;
            PG8_LDB(B1, 1, 1); PG8_STAGE(PG8_SB(1, 0), b3, voffB);
            PG8_BAR; PG8_WAIT_L(0); PG8_MMA(0, 1, At, B1); PG8_BAR;
            PG8_LDA(At, 1, 1); PG8_STAGE(PG8_SA(1, 0), a3, voffA);
            PG8_BAR; PG8_WAIT_L(0); PG8_MMA(1, 0, At, B0); PG8_BAR; PG8_SCHED;
            PG8_STAGE(PG8_SB(1, 1), b3 + hstep, voffB);
            PG8_WAIT_V(6); PG8_BAR; PG8_MMA(1, 1, At, B1); PG8_BAR;
            }
        }
        if constexpr (ALIGN_EPI) { if (wr == 0) PG8_BAR; }
        if constexpr (!Epi::AFTER_DRAIN) { E(acc, cur, wr, wc, fr, fq); S.done(cur); }
        if (!has_next) break;
#pragma unroll
        for (int a = 0; a < 2; ++a)
#pragma unroll
            for (int b = 0; b < 2; ++b)
#pragma unroll
                for (int m = 0; m < 4; ++m)
#pragma unroll
                    for (int n = 0; n < 2; ++n) acc[a][b][m][n] = (f32x4){0.f, 0.f, 0.f, 0.f};
        cur = nxt; cA = nA; cB = nB; ++ui;
        if constexpr (ALIGN_EPI) { if (wr == 1) PG8_BAR; }
    }
    PG8_WAIT_V(0);
    if constexpr (!ALIGN_EPI) { if (wr == 0) PG8_BAR; }
    PG8_BAR;
    if constexpr (Epi::AFTER_DRAIN) { E.fused(acc, cur, wr, wc, fr, fq, lds, wid, lane); S.done(cur); }
#undef PG8_SA
#undef PG8_SB
#undef PG8_STAGE
#undef PG8_LDA
#undef PG8_LDB
#undef PG8_MMA
#undef PG8_WAIT_V
#undef PG8_WAIT_L
#undef PG8_BAR
#undef PG8_SCHED
}
}

namespace pg8 {
__device__ __forceinline__ float gelu_tanh(float x) {
    const float t = x * (1.5957691216057308f + 0.07135481627f * x * x);
    const float e = __builtin_amdgcn_exp2f(-1.4426950408889634f * t);
    return x * __builtin_amdgcn_rcpf(1.0f + e);
}
template <int ACT> struct EpiT {
    static constexpr bool PERM = true, AFTER_DRAIN = false;
    bf16_t* O; int ldc;
    __device__ __forceinline__ void operator()(const f32x4 (&acc)[2][2][4][2], const Unit& u, int wr, int wc, int fr, int fq) const {
        const int row0 = u.pm * BM + wr * 64 + fr; const int col0 = u.pn * BM + wc * 32 + 8 * fq;
#pragma unroll
        for (int ai = 0; ai < 2; ++ai)
#pragma unroll
            for (int m = 0; m < 4; ++m) { bf16_t* rowp = O + (size_t)(row0 + ai * HALF + m * 16) * ldc + col0;
#pragma unroll
                for (int bj = 0; bj < 2; ++bj) { f32x4 v0 = acc[ai][bj][m][0], v1 = acc[ai][bj][m][1];
                    if (ACT == 2) { v0 = (f32x4){gelu_tanh(v0[0]), gelu_tanh(v0[1]), gelu_tanh(v0[2]), gelu_tanh(v0[3])}; v1 = (f32x4){gelu_tanh(v1[0]), gelu_tanh(v1[1]), gelu_tanh(v1[2]), gelu_tanh(v1[3])}; }
                    u32x4 w; w.x = cvt_pk_bf16(v0[0], v0[1]); w.y = cvt_pk_bf16(v0[2], v0[3]); w.z = cvt_pk_bf16(v1[0], v1[1]); w.w = cvt_pk_bf16(v1[2], v1[3]);
                    *(u32x4*)(rowp + bj * HALF) = w; } }
    }
};
struct EpiR {
    static constexpr bool PERM = true, AFTER_DRAIN = false;
    bf16_t* O; int ldc; int act; int rope; const float* ropet;
    __device__ __forceinline__ void operator()(const f32x4 (&acc)[2][2][4][2], const Unit& u, int wr, int wc, int fr, int fq) const {
        const int row0 = u.pm * BM + wr * 64 + fr; const int col0 = u.pn * BM + wc * 32 + 8 * fq;
        const bool rrows = rope != 0 && u.pm < 64;
#pragma unroll
        for (int ai = 0; ai < 2; ++ai)
#pragma unroll
            for (int m = 0; m < 4; ++m) { const int grow = row0 + ai * HALF + m * 16; bf16_t* rowp = O + (size_t)grow * ldc + col0;
#pragma unroll
                for (int bj = 0; bj < 2; ++bj) { f32x4 v0 = acc[ai][bj][m][0], v1 = acc[ai][bj][m][1];
                    if (act) { v0 = (f32x4){gelu_tanh(v0[0]), gelu_tanh(v0[1]), gelu_tanh(v0[2]), gelu_tanh(v0[3])}; v1 = (f32x4){gelu_tanh(v1[0]), gelu_tanh(v1[1]), gelu_tanh(v1[2]), gelu_tanh(v1[3])}; }
                    if (rrows) { const int blk = u.pn * 8 + bj * 4 + wc; const int b6 = blk % 6; const bool on = rope == 1 ? (blk < 128) : (b6 >= 4); const int half = rope == 1 ? (blk & 1) : (b6 - 4);
                        if (on) { const int t = grow & 8191; const int pos = half ? (t & 63) : (t >> 6);
                            const float* cp = ropet + pos * 16 + 8 * (fq & 1); const f32x4 c0 = *(const f32x4*)cp, c1 = *(const f32x4*)(cp + 4), s0 = *(const f32x4*)(cp + 2048), s1 = *(const f32x4*)(cp + 2052);
                            f32x4 p0, p1;
#pragma unroll
                            for (int i = 0; i < 4; ++i) { const float a_ = v0[i], b_ = v1[i];
                                const auto r0 = __builtin_amdgcn_permlane32_swap(__float_as_uint(a_), __float_as_uint(a_), false, false);
                                const auto r1 = __builtin_amdgcn_permlane32_swap(__float_as_uint(b_), __float_as_uint(b_), false, false);
                                const unsigned x0_ = (fq & 2) ? r0[0] : r0[1], x1_ = (fq & 2) ? r1[0] : r1[1]; p0[i] = __uint_as_float(x0_); p1[i] = __uint_as_float(x1_); }
                            if (fq & 2) { v0 = p0 * s0 + v0 * c0; v1 = p1 * s1 + v1 * c1; } else { v0 = v0 * c0 - p0 * s0; v1 = v1 * c1 - p1 * s1; } } }
                    u32x4 w; w.x = cvt_pk_bf16(v0[0], v0[1]); w.y = cvt_pk_bf16(v0[2], v0[3]); w.z = cvt_pk_bf16(v1[0], v1[1]); w.w = cvt_pk_bf16(v1[2], v1[3]);
                    *(u32x4*)(rowp + bj * HALF) = w; } }
    }
};
}

constexpr int DM = 2048, NBATCH = 2, SEQ = 8192, CTXL = 256;
constexpr int ML = NBATCH * SEQ;
constexpr int MC = NBATCH * CTXL;
constexpr int MT = ML + MC;
constexpr int NLAYER = 4;
constexpr float ALPHA = 1.6817928305074290f, LN_EPS = 1e-6f;
constexpr int NWAVES = 8;
constexpr float U_SCALE = 64.0f, V_SCALE = 4.0f;
constexpr int PROW = 1536;
constexpr int PREC = 2 * PROW;
constexpr int NPH = 35;

constexpr size_t MiB = 1ull << 20;
constexpr size_t WS_CTL = 0, CTL_ZERO_BYTES = 1 * MiB;
constexpr int    CW_BAR = 4096;
constexpr size_t WS_MOD = 128 * 1024;
constexpr size_t WS_VST = 1 * MiB;
constexpr size_t WS_ROPE = 1 * MiB + 160 * 1024;
constexpr size_t WS_MODP = 1 * MiB + 256 * 1024;
constexpr size_t WS_GMWIN = 6 * MiB;
constexpr size_t WS_GMWOUT = WS_GMWIN + 32 * MiB;
constexpr size_t WS_GMWS = WS_GMWOUT + 16 * MiB;
constexpr size_t WS_PWQ = WS_GMWS + 1 * MiB;
constexpr size_t WS_PK1 = WS_PWQ + 32 * MiB;
constexpr size_t WS_PK2 = WS_PK1 + 512 * 1024;
constexpr size_t WS_MLAIN = WS_PK1 + 1 * MiB;
constexpr size_t WS_MLAUQ = WS_MLAIN + 5 * MiB;
constexpr size_t WS_MLAUKV = WS_MLAUQ + 3 * MiB;
constexpr size_t WS_MLAOUT = WS_MLAUKV + 4 * MiB;
constexpr size_t WS_DAIN = WS_MLAOUT + 8 * MiB;
constexpr size_t WS_DAOUT = WS_DAIN + 24 * MiB;
constexpr size_t WS_PU = WS_DAOUT + 8 * MiB;
constexpr size_t WS_PV = WS_PU + 96 * MiB;
constexpr size_t WS_X = WS_PV + 96 * MiB;
constexpr size_t WS_H = WS_X + 66 * MiB;
constexpr size_t WS_G = WS_H + 66 * MiB;
constexpr size_t WS_Y = WS_G + 66 * MiB;
constexpr size_t WS_QP = WS_Y + 66 * MiB;
constexpr size_t WS_Z = WS_QP + 66 * MiB;
constexpr size_t WS_C = WS_Z + 198 * MiB;
constexpr size_t WS_CQN = WS_C + 42 * MiB;
constexpr size_t WS_CKVN = WS_CQN + 17 * MiB;
constexpr size_t WS_KR = WS_CKVN + 17 * MiB;
constexpr size_t WS_QM = WS_KR + 3 * MiB;
constexpr size_t WS_KV = WS_QM + 99 * MiB;
constexpr size_t WS_ROUTE = WS_KV + 132 * MiB;
constexpr size_t WS_END = WS_ROUTE + 17 * MiB;
static_assert((size_t)MT * DM * 2 == 66 * MiB, "row buffer size");

constexpr int RING_BYTES = 155648, MISC_OFF = RING_BYTES + 320, LDS_BYTES = 159744;

#define GAS __attribute__((address_space(1)))
#define LAS __attribute__((address_space(3)))
typedef unsigned short bf16;
typedef unsigned u32x4 __attribute__((ext_vector_type(4)));
typedef unsigned u32x2 __attribute__((ext_vector_type(2)));
typedef float f32x4 __attribute__((ext_vector_type(4)));
typedef float f32x16 __attribute__((ext_vector_type(16)));
typedef short bf16x8 __attribute__((ext_vector_type(8)));
typedef short s16x4 __attribute__((ext_vector_type(4)));
#define LDS_WAIT() asm volatile("s_waitcnt lgkmcnt(0)" ::: "memory")

__device__ __forceinline__ unsigned cvtpk(float lo, float hi) { unsigned r; asm("v_cvt_pk_bf16_f32 %0, %1, %2" : "=v"(r) : "v"(lo), "v"(hi)); return r; }
__device__ __forceinline__ float bflo(unsigned w) { return __uint_as_float(w << 16); }
__device__ __forceinline__ float bfhi(unsigned w) { return __uint_as_float(w & 0xffff0000u); }
__device__ __forceinline__ float bf1(bf16 b) { return __uint_as_float((unsigned)b << 16); }
__device__ __forceinline__ bf16 tobf1(float f) { return (bf16)(cvtpk(f, 0.f) & 0xffffu); }
#define DPP_F(v, ctrl) __int_as_float(__builtin_amdgcn_mov_dpp(__float_as_int(v), (ctrl), 0xF, 0xF, true))
__device__ __forceinline__ float row_sum16(float v) { v += DPP_F(v, 0xB1); v += DPP_F(v, 0x4E); v += DPP_F(v, 0x141); v += DPP_F(v, 0x140); return v; }
__device__ __forceinline__ float sum_xor16(float v) { const auto r = __builtin_amdgcn_permlane16_swap(__float_as_uint(v), __float_as_uint(v), false, false); return __uint_as_float(r[0]) + __uint_as_float(r[1]); }
__device__ __forceinline__ float sum_xor32(float v) { const auto r = __builtin_amdgcn_permlane32_swap(__float_as_uint(v), __float_as_uint(v), false, false); return __uint_as_float(r[0]) + __uint_as_float(r[1]); }
__device__ __forceinline__ float wave_sum(float v) { return sum_xor32(sum_xor16(row_sum16(v))); }
__device__ __forceinline__ float half_sum32(float v) { return sum_xor16(row_sum16(v)); }
__device__ __forceinline__ float lane_xor16(float v, int lane) { const auto r = __builtin_amdgcn_permlane16_swap(__float_as_uint(v), __float_as_uint(v), false, false); return __uint_as_float((lane & 16) ? r[0] : r[1]); }
__device__ __forceinline__ unsigned lane_xor32(unsigned v, int lane) { const auto r = __builtin_amdgcn_permlane32_swap(v, v, false, false); return (lane & 32) ? r[0] : r[1]; }
__device__ __forceinline__ float gelu_tanh(float x) { return pg8::gelu_tanh(x); }

__device__ __forceinline__ void load_row_bf16(const bf16* row, int lane, float (&v)[32]) {
#pragma unroll
    for (int j = 0; j < 4; ++j) { const u32x4 w = ((const u32x4*)row)[64 * j + lane];
        v[8 * j + 0] = bflo(w.x); v[8 * j + 1] = bfhi(w.x); v[8 * j + 2] = bflo(w.y); v[8 * j + 3] = bfhi(w.y);
        v[8 * j + 4] = bflo(w.z); v[8 * j + 5] = bfhi(w.z); v[8 * j + 6] = bflo(w.w); v[8 * j + 7] = bfhi(w.w); }
}
__device__ __forceinline__ void store_row_bf16(bf16* row, int lane, const float (&v)[32]) {
#pragma unroll
    for (int j = 0; j < 4; ++j) { u32x4 w; w.x = cvtpk(v[8 * j + 0], v[8 * j + 1]); w.y = cvtpk(v[8 * j + 2], v[8 * j + 3]); w.z = cvtpk(v[8 * j + 4], v[8 * j + 5]); w.w = cvtpk(v[8 * j + 6], v[8 * j + 7]);
        ((u32x4*)row)[64 * j + lane] = w; }
}
__device__ __forceinline__ void load_row_f32(const float* row, int lane, float (&v)[32]) {
#pragma unroll
    for (int j = 0; j < 4; ++j) { const f32x4 a = ((const f32x4*)row)[128 * j + 2 * lane], b = ((const f32x4*)row)[128 * j + 2 * lane + 1];
        v[8 * j + 0] = a.x; v[8 * j + 1] = a.y; v[8 * j + 2] = a.z; v[8 * j + 3] = a.w; v[8 * j + 4] = b.x; v[8 * j + 5] = b.y; v[8 * j + 6] = b.z; v[8 * j + 7] = b.w; }
}
__device__ __forceinline__ void store_row_f32(float* row, int lane, const float (&v)[32]) {
#pragma unroll
    for (int j = 0; j < 4; ++j) { ((f32x4*)row)[128 * j + 2 * lane] = (f32x4){v[8 * j + 0], v[8 * j + 1], v[8 * j + 2], v[8 * j + 3]};
        ((f32x4*)row)[128 * j + 2 * lane + 1] = (f32x4){v[8 * j + 4], v[8 * j + 5], v[8 * j + 6], v[8 * j + 7]}; }
}
__device__ __forceinline__ void load_row_bf16_b(const bf16* row, int lane, float (&v)[32]) {
#pragma unroll
    for (int j = 0; j < 4; ++j) { const u32x4 w = ((const u32x4*)row)[4 * lane + j];
        v[8 * j + 0] = bflo(w.x); v[8 * j + 1] = bfhi(w.x); v[8 * j + 2] = bflo(w.y); v[8 * j + 3] = bfhi(w.y);
        v[8 * j + 4] = bflo(w.z); v[8 * j + 5] = bfhi(w.z); v[8 * j + 6] = bflo(w.w); v[8 * j + 7] = bfhi(w.w); }
}
__device__ __forceinline__ void store_row_bf16_b(bf16* row, int lane, const float (&v)[32]) {
#pragma unroll
    for (int j = 0; j < 4; ++j) { u32x4 w; w.x = cvtpk(v[8 * j + 0], v[8 * j + 1]); w.y = cvtpk(v[8 * j + 2], v[8 * j + 3]); w.z = cvtpk(v[8 * j + 4], v[8 * j + 5]); w.w = cvtpk(v[8 * j + 6], v[8 * j + 7]);
        ((u32x4*)row)[4 * lane + j] = w; }
}
__device__ __forceinline__ void load_row_f32_b(const float* row, int lane, float (&v)[32]) {
#pragma unroll
    for (int q = 0; q < 8; ++q) { const f32x4 a = ((const f32x4*)row)[8 * lane + q];
        v[4 * q + 0] = a.x; v[4 * q + 1] = a.y; v[4 * q + 2] = a.z; v[4 * q + 3] = a.w; }
}
__device__ __forceinline__ void store_row_f32_b(float* row, int lane, const float (&v)[32]) {
#pragma unroll
    for (int q = 0; q < 8; ++q) ((f32x4*)row)[8 * lane + q] = (f32x4){v[4 * q + 0], v[4 * q + 1], v[4 * q + 2], v[4 * q + 3]};
}
__device__ __forceinline__ void ln_stats(const float (&v)[32], float& mean, float& rstd) {
    float s = 0.f;
#pragma unroll
    for (int i = 0; i < 32; ++i) s += v[i];
    mean = wave_sum(s) * (1.0f / DM);
    float q = 0.f;
#pragma unroll
    for (int i = 0; i < 32; ++i) { const float d = v[i] - mean; q += d * d; }
    rstd = 1.0f / sqrtf(wave_sum(q) * (1.0f / DM) + LN_EPS);
}
template <bool LAYB>
__device__ __forceinline__ void finish_row(float (&z)[32], const float* lng, const float* lnb, bf16* Xrow, const float* sh, const float* sc, bf16* Hrow, float* Orow, int lane) {
    float mean, rstd; ln_stats(z, mean, rstd);
    { float g[32], b[32]; if (LAYB) { load_row_f32_b(lng, lane, g); load_row_f32_b(lnb, lane, b); } else { load_row_f32(lng, lane, g); load_row_f32(lnb, lane, b); }
#pragma unroll
      for (int i = 0; i < 32; ++i) z[i] = (z[i] - mean) * rstd * g[i] + b[i]; }
    if (Xrow) { if (LAYB) store_row_bf16_b(Xrow, lane, z); else store_row_bf16(Xrow, lane, z); }
    if (Orow) { if (LAYB) store_row_f32_b(Orow, lane, z); else store_row_f32(Orow, lane, z); }
    if (Hrow) {
        ln_stats(z, mean, rstd);
        float a[32], s[32]; if (LAYB) { load_row_f32_b(sc, lane, a); load_row_f32_b(sh, lane, s); } else { load_row_f32(sc, lane, a); load_row_f32(sh, lane, s); }
#pragma unroll
        for (int i = 0; i < 32; ++i) a[i] = (z[i] - mean) * rstd * (1.0f + a[i]) + s[i];
        if (LAYB) store_row_bf16_b(Hrow, lane, a); else store_row_bf16(Hrow, lane, a);
    }
}
__device__ __forceinline__ int row_slot(int row) { return row < ML ? (row >> 13) : 2; }

__device__ __forceinline__ unsigned f2bf_rne(float f) { unsigned u = __float_as_uint(f); return (u + 0x7fffu + ((u >> 16) & 1u)) >> 16; }
__device__ __forceinline__ unsigned pk2(float lo, float hi) { return f2bf_rne(lo) | (f2bf_rne(hi) << 16); }
__device__ __forceinline__ void p0_transpose_item(const float* W, int K, int N, bf16* WT, LAS float* scr, int item, int lane) {
    const int nblk = N / 32, kb = item / nblk, nb = item % nblk, k0 = 64 * kb, n0 = 32 * nb;
    f32x4 t[8];
#pragma unroll
    for (int i = 0; i < 8; ++i) t[i] = *(const f32x4*)(W + (size_t)(k0 + 8 * i + (lane >> 3)) * N + n0 + 4 * (lane & 7));
#pragma unroll
    for (int i = 0; i < 8; ++i) { LAS float* d = scr + (8 * i + (lane >> 3)) * 33 + 4 * (lane & 7); d[0] = t[i].x; d[1] = t[i].y; d[2] = t[i].z; d[3] = t[i].w; }
    LDS_WAIT(); asm volatile("" ::: "memory");
    const int c = lane & 7;
#pragma unroll
    for (int j = 0; j < 4; ++j) { const int n = (lane >> 3) + 8 * j; const LAS float* s = scr + (8 * c) * 33 + n;
        u32x4 o; o.x = pk2(s[0 * 33], s[1 * 33]); o.y = pk2(s[2 * 33], s[3 * 33]); o.z = pk2(s[4 * 33], s[5 * 33]); o.w = pk2(s[6 * 33], s[7 * 33]);
        *(u32x4*)(WT + (size_t)(n0 + n) * K + k0 + 8 * c) = o; }
    LDS_WAIT(); asm volatile("" ::: "memory");
}
__device__ __forceinline__ void cvt_range(const float* src, bf16* dst, size_t n8, size_t gtid, size_t gthreads) {
#pragma unroll 4
    for (size_t i = gtid; i < n8; i += gthreads) { const f32x4 a = ((const f32x4*)src)[2 * i], b = ((const f32x4*)src)[2 * i + 1];
        u32x4 w; w.x = cvtpk(a.x, a.y); w.y = cvtpk(a.z, a.w); w.z = cvtpk(b.x, b.y); w.w = cvtpk(b.z, b.w); ((u32x4*)dst)[i] = w; }
}
__device__ __forceinline__ unsigned enc_e2m3(float x) {
    const unsigned sgn = (__float_as_uint(x) >> 26) & 32u;
    const float ax = fminf(fabsf(x), 7.5f);
    unsigned u = __float_as_uint(ax); u += 0x7FFFFu + ((u >> 20) & 1u);
    const unsigned cn = (u >> 20) - ((127u - 1u) << 3);
    const unsigned cs = (unsigned)__builtin_rintf(ax * 8.0f);
    return sgn | (ax < 1.0f ? cs : cn);
}
typedef float f32x16v __attribute__((ext_vector_type(16)));
typedef float f32x32v __attribute__((ext_vector_type(32)));
typedef unsigned u32x6v __attribute__((ext_vector_type(6)));
__device__ __forceinline__ u32x6v pack_fp6_32(const float (&e)[32], bool interleaved) {
    f32x16v s0, s1;
    if (interleaved) {
#pragma unroll
        for (int i = 0; i < 16; ++i) { s0[i] = e[2 * i]; s1[i] = e[2 * i + 1]; }
    } else {
#pragma unroll
        for (int i = 0; i < 16; ++i) { s0[i] = e[i]; s1[i] = e[16 + i]; }
    }
    return __builtin_amdgcn_cvt_scalef32_2xpk16_fp6_f32(s0, s1, 1.0f);
}
__device__ __forceinline__ void cvt_table_fp6(const float* src, unsigned char* dst, int nrows, float scale, LAS float* scr  , int lane, int gw, int NGW, const int isv) {
    bool interleaved;
    {
        float t[32];
#pragma unroll
        for (int k = 0; k < 32; ++k) t[k] = k < 16 ? 0.125f * k : (k < 24 ? 2.0f + 0.25f * (k - 16) : 4.0f + 0.5f * (k - 24));
        float tt[32];
#pragma unroll
        for (int k = 0; k < 32; ++k) { tt[k] = t[k]; asm volatile("" : "+v"(tt[k])); }
        const u32x6v p = pack_fp6_32(tt, true);
        const f32x32v o = __builtin_amdgcn_cvt_scalef32_pk32_f32_fp6(p, 1.0f);
        interleaved = (o[1] == t[1]) && (o[2] == t[2]) && (o[17] == t[17]);
        interleaved = __all(interleaved);
    }
    for (int row = gw; row < nrows; row += NGW) {
        const f32x4* s4 = (const f32x4*)(src + (size_t)row * 2048);
#pragma unroll
        for (int q = 0; q < 8; ++q) { const int s = 64 * q + lane; const f32x4 a = s4[s] * scale; *(LAS f32x4*)(scr + 4 * (s ^ ((s >> 4) & 7))) = a; }
        float e[32];
#pragma unroll
        for (int j = 0; j < 8; ++j) { const int s = 8 * lane + j; const f32x4 a = *(const LAS f32x4*)(scr + 4 * (s ^ ((s >> 4) & 7)));
            e[4 * j + 0] = __builtin_amdgcn_fmed3f(a.x, -7.5f, 7.5f); e[4 * j + 1] = __builtin_amdgcn_fmed3f(a.y, -7.5f, 7.5f); e[4 * j + 2] = __builtin_amdgcn_fmed3f(a.z, -7.5f, 7.5f); e[4 * j + 3] = __builtin_amdgcn_fmed3f(a.w, -7.5f, 7.5f); }
        const u32x6v p = pack_fp6_32(e, interleaved);
        unsigned char* rowp = dst + (size_t)row * PREC;
        *(u32x4*)(rowp + 1024 * isv + 16 * lane) = (u32x4){p[0], p[1], p[2], p[3]}; *(u32x2*)(rowp + 2048 + 512 * isv + 8 * lane) = (u32x2){p[4], p[5]};
    }
}
__device__ __forceinline__ float silu(float x) { return x / (1.0f + __expf(-x)); }

struct Params { const float* in[29]; float* out; unsigned char* ws; int ph_lo, ph_hi; };
typedef const __attribute__((address_space(4))) Params* CP;

__device__ __forceinline__ void p0_prologue(CP P, LAS unsigned char* lds, int tid, int lane, int wid, int gw, int NGW) {
    unsigned char* ws = P->ws;
    LAS float* scr = (LAS float*)(lds + wid * 16384);
    {
        constexpr int I_GMIN = (2048 / 64) * (4096 / 32), I_SQ = (2048 / 64) * (2048 / 32), I_MIN = (2048 / 64) * (1088 / 32), I_UQ = (512 / 64) * (3072 / 32), I_UKV = (512 / 64) * (4096 / 32), I_DIN = (2048 / 64) * (6144 / 32);
        constexpr int NIT = 2 * I_GMIN + 2 * I_SQ + 4 * I_SQ + I_MIN + I_UQ + I_UKV + I_SQ + I_DIN + I_SQ;
        for (int it = gw; it < NIT; it += NGW) {
            int r = it;
            if (r < 2 * I_GMIN) { const int j = r / I_GMIN; p0_transpose_item(P->in[13] + (size_t)j * 2048 * 4096, 2048, 4096, (bf16*)(ws + WS_GMWIN) + (size_t)j * 4096 * 2048, scr, r % I_GMIN, lane); continue; } r -= 2 * I_GMIN;
            if (r < 2 * I_SQ) { const int j = r / I_SQ; p0_transpose_item(P->in[18] + (size_t)j * 2048 * 2048, 2048, 2048, (bf16*)(ws + WS_GMWOUT) + (size_t)j * 2048 * 2048, scr, r % I_SQ, lane); continue; } r -= 2 * I_SQ;
            if (r < 4 * I_SQ) { const int j = r / I_SQ; p0_transpose_item(P->in[8] + (size_t)j * 2048 * 2048, 2048, 2048, (bf16*)(ws + WS_PWQ) + (size_t)j * 2048 * 2048, scr, r % I_SQ, lane); continue; } r -= 4 * I_SQ;
            if (r < I_MIN) { p0_transpose_item(P->in[19], 2048, 1088, (bf16*)(ws + WS_MLAIN), scr, r, lane); continue; } r -= I_MIN;
            if (r < I_UQ) { p0_transpose_item(P->in[22], 512, 3072, (bf16*)(ws + WS_MLAUQ), scr, r, lane); continue; } r -= I_UQ;
            if (r < I_UKV) { p0_transpose_item(P->in[23], 512, 4096, (bf16*)(ws + WS_MLAUKV), scr, r, lane); continue; } r -= I_UKV;
            if (r < I_SQ) { p0_transpose_item(P->in[24], 2048, 2048, (bf16*)(ws + WS_MLAOUT), scr, r, lane); continue; } r -= I_SQ;
            if (r < I_DIN) { p0_transpose_item(P->in[25], 2048, 6144, (bf16*)(ws + WS_DAIN), scr, r, lane); continue; } r -= I_DIN;
            p0_transpose_item(P->in[28], 2048, 2048, (bf16*)(ws + WS_DAOUT), scr, r, lane);
        }
    }
    const size_t gtid = (size_t)gw * 64 + lane, gthreads = (size_t)NGW * 64;
    { u32x4* z = (u32x4*)((bf16*)(ws + WS_MLAIN) + (size_t)1088 * 2048); const size_t n = (size_t)192 * 2048 / 8;
      for (size_t i = gtid; i < n; i += gthreads) z[i] = (u32x4){0u, 0u, 0u, 0u}; }
    cvt_range(P->in[16], (bf16*)(ws + WS_GMWS), (size_t)2 * 16 * 128 * 128 / 8, gtid, gthreads);
    cvt_range(P->in[9], (bf16*)(ws + WS_PK1), (size_t)4 * 128 * 128 / 8, gtid, gthreads);
    cvt_range(P->in[10], (bf16*)(ws + WS_PK2), (size_t)4 * 128 * 128 / 8, gtid, gthreads);
    cvt_table_fp6(P->in[11], ws + WS_PU, 16384, U_SCALE, scr, lane, gw, NGW, 0);
    cvt_table_fp6(P->in[12], ws + WS_PU, 16384, V_SCALE, scr, lane, gw, NGW, 1);
    if (gtid < 2048) { const int pos = (int)gtid >> 4, f = (int)gtid & 15; const float inv = powf(10000.0f, -(float)f * (1.0f / 16.0f)); float sn, cs; sincosf((float)pos * inv, &sn, &cs);
        float* rt = (float*)(ws + WS_ROPE); rt[gtid] = cs; rt[2048 + gtid] = sn; }
    {
        const float* cv = P->in[1]; const float* cc = P->in[3]; const float* mw = P->in[4]; float* PART = (float*)(ws + WS_MODP);
        for (int item = gw; item < 4 * 192 * 8; item += NGW) {
            const int ks = item & 7, r = item >> 3, L = r / 192, n = (r % 192) * 64 + lane;
            const float* W = mw + (size_t)L * 2048 * 12288 + (size_t)(ks * 256) * 12288 + n;
            float a0 = 0.f, a1 = 0.f, a2 = 0.f;
#pragma unroll 32
            for (int k = 0; k < 256; ++k) { const int kk = ks * 256 + k; const float s0 = silu(cv[kk]), s1 = silu(cv[2048 + kk]), s2 = silu(cc[kk]);
                const float w = W[(size_t)k * 12288]; a0 += s0 * w; a1 += s1 * w; a2 += s2 * w; }
            float* o = PART + ((size_t)ks * 4 + L) * 3 * 12288 + n;
            o[0] = a0; o[12288] = a1; o[24576] = a2;
        }
    }
}
__device__ __forceinline__ void mod_reduce(CP P, int gw, int lane, int NGW) {
    const float* PART = (const float*)(P->ws + WS_MODP); float* MOD = (float*)(P->ws + WS_MOD); const float* mb = P->in[5];
    for (int i = gw * 64 + lane; i < 4 * 3 * 12288; i += NGW * 64) {
        const int L = i / (3 * 12288), n = i % 12288;
        float s = mb[(size_t)L * 12288 + n];
#pragma unroll
        for (int ks = 0; ks < 8; ++ks) s += PART[(size_t)ks * 4 * 3 * 12288 + i];
        MOD[i] = s;
    }
}

__device__ __forceinline__ void first_row_pass(CP P, int lane, int gw, int NGW) {
    const float* MOD = (const float*)(P->ws + WS_MOD); bf16* X = (bf16*)(P->ws + WS_X); bf16* H = (bf16*)(P->ws + WS_H);
    for (int row = gw; row < MT; row += NGW) {
        const float* src = row < ML ? P->in[0] + (size_t)row * DM : P->in[2] + (size_t)(row - ML) * DM;
        float v[32]; load_row_f32(src, lane, v);
        store_row_bf16(X + (size_t)row * DM, lane, v);
        const float* mod = MOD + (size_t)row_slot(row) * 12288;
        float mean, rstd; ln_stats(v, mean, rstd);
        float a[32], s[32]; load_row_f32(mod + 2048, lane, a); load_row_f32(mod, lane, s);
#pragma unroll
        for (int i = 0; i < 32; ++i) a[i] = (v[i] - mean) * rstd * (1.0f + a[i]) + s[i];
        store_row_bf16(H + (size_t)row * DM, lane, a);
    }
}
__device__ __forceinline__ void post_mixer_pass(CP P, int L, int Mrows, int lane, int gw, int NGW) {
    const float* MOD = (const float*)(P->ws + WS_MOD); bf16* X = (bf16*)(P->ws + WS_X); bf16* H = (bf16*)(P->ws + WS_H); const bf16* Y = (const bf16*)(P->ws + WS_Y);
    const float* lng = P->in[6] + (size_t)(L * 2 + 0) * DM; const float* lnb = P->in[7] + (size_t)(L * 2 + 0) * DM;
    for (int row = gw; row < Mrows; row += NGW) {
        const float* mod = MOD + (size_t)(L * 3 + row_slot(row)) * 12288;
        float z[32], y[32], g[32]; load_row_bf16(X + (size_t)row * DM, lane, z); load_row_bf16(Y + (size_t)row * DM, lane, y); load_row_f32(mod + 2 * 2048, lane, g);
#pragma unroll
        for (int i = 0; i < 32; ++i) z[i] = ALPHA * z[i] + g[i] * y[i];
        finish_row<false>(z, lng, lnb, X + (size_t)row * DM, mod + 3 * 2048, mod + 4 * 2048, H + (size_t)row * DM, nullptr, lane);
    }
}
__device__ __forceinline__ void vstats_pass(CP P, int Mrows, int lane, int gw, int NGW) {
    const bf16* Z = (const bf16*)(P->ws + WS_Z); float* VST = (float*)(P->ws + WS_VST);
    for (int row = gw; row < Mrows; row += NGW) {
        float v[32]; load_row_bf16(Z + (size_t)row * 4096 + 2048, lane, v);
        float mean, rstd; ln_stats(v, mean, rstd);
        if (lane == 0) { VST[2 * row] = mean; VST[2 * row + 1] = rstd; }
    }
}
#define XB_TMO      128
#define XB_XCNT(j)  (256  + 64 * (j))
#define XB_XSUB(j)  (1280 + 64 * (j))
#define XB_XGEN(j)  (2304 + 64 * (j))
#define XB_TOP      3328
#define XB_TOPGEN   3392
#define XCD_BAR_WORDS 3456
#define XB_SPIN_CAP (1u << 18)

__device__ __forceinline__ unsigned xb_ld(unsigned* p)              { return __hip_atomic_load(p, __ATOMIC_RELAXED, __HIP_MEMORY_SCOPE_AGENT); }
__device__ __forceinline__ unsigned xb_add(unsigned* p, unsigned v) { return __hip_atomic_fetch_add(p, v, __ATOMIC_RELAXED, __HIP_MEMORY_SCOPE_AGENT); }
__device__ __forceinline__ unsigned xb_xcc_id() { return (unsigned)__builtin_amdgcn_s_getreg((3 << 11) | 20) & 0xFu; }
#define XB_SPIN(cond, bar) do { unsigned _sp = 0; while (cond) { __builtin_amdgcn_s_sleep(1); \
    if ((++_sp & 255u) == 0u) { if (xb_ld(&(bar)[XB_TMO])) break; if (_sp > XB_SPIN_CAP) { atomicAdd(&(bar)[XB_TMO], 1u); break; } } } } while (0)

struct XcdBarrier {
    unsigned* bar; unsigned x;
    volatile LAS unsigned* st;
};

__device__ __forceinline__ XcdBarrier xcd_barrier_post(unsigned* bar, volatile LAS unsigned* st, const bool t0) {
    XcdBarrier b; b.bar = bar; b.x = xb_xcc_id(); b.st = st;
    if (t0) (void)xb_add(&bar[XB_XCNT(b.x)], 1u);
    return b;
}
__device__ __forceinline__ void xcd_barrier_complete(unsigned* bar, unsigned x, unsigned& nloc, unsigned& nx) {
    const unsigned G = gridDim.x * gridDim.y * gridDim.z;
    unsigned sum, cnt, mine, sp = 0u;
    for (;;) {
        sum = 0u; cnt = 0u; mine = 0u;
#pragma unroll
        for (unsigned j = 0; j < 16; ++j) { const unsigned c = xb_ld(&bar[XB_XCNT(j)]); sum += c; cnt += (c > 0u) ? 1u : 0u; mine = (j == x) ? c : mine; }
        if (sum == G) break;
        __builtin_amdgcn_s_sleep(1);
        if ((++sp & 255u) == 0u) { if (xb_ld(&bar[XB_TMO])) break; if (sp > XB_SPIN_CAP) { atomicAdd(&bar[XB_TMO], 1u); break; } }
    }
    nloc = mine > 0u ? mine : 1u; nx = cnt > 0u ? cnt : 1u;
}

__device__ __attribute__((noinline)) void xcd_barrier(const XcdBarrier b, const bool t0) {
    asm volatile("s_waitcnt vmcnt(0)" ::: "memory");
    __syncthreads();
    if (t0) {
        unsigned* bar = b.bar;
        __builtin_amdgcn_s_waitcnt(0);
        unsigned nloc = b.st[0], nx = b.st[1];
        if (nloc == 0u) { xcd_barrier_complete(bar, b.x, nloc, nx); b.st[0] = nloc; b.st[1] = nx; }
        const unsigned old = xb_add(&bar[XB_XSUB(b.x)], 1u);
        const unsigned gen = old / nloc;
        if (old + 1u == (gen + 1u) * nloc) {
            __builtin_amdgcn_fence(__ATOMIC_RELEASE, "agent");
            asm volatile("s_waitcnt vmcnt(0)" ::: "memory");
            const unsigned og = xb_add(&bar[XB_TOP], 1u);
            const unsigned tg = og / nx;
            if (og + 1u == (tg + 1u) * nx) xb_add(&bar[XB_TOPGEN], 1u);
            else XB_SPIN(xb_ld(&bar[XB_TOPGEN]) == tg, bar);
            __builtin_amdgcn_fence(__ATOMIC_ACQUIRE, "agent");
            xb_add(&bar[XB_XGEN(b.x)], 1u);
            asm volatile("s_waitcnt vmcnt(0)" ::: "memory");
        } else {
            XB_SPIN(xb_ld(&bar[XB_XGEN(b.x)]) == gen, bar);
            __builtin_amdgcn_fence(__ATOMIC_ACQUIRE, "agent");
            asm volatile("s_waitcnt vmcnt(0)" ::: "memory");
        }
    }
    __syncthreads();
}

__device__ __forceinline__ void spatial_phase(CP P, int j, int Mrows, LAS unsigned char* lds_, int tid, int lane, int wid) {
    const bf16* Z = (const bf16*)(P->ws + WS_Z); const float* VST = (const float*)(P->ws + WS_VST); bf16* Gb = (bf16*)(P->ws + WS_G);
    const bf16* WS = (const bf16*)(P->ws + WS_GMWS) + (size_t)j * 16 * 128 * 128;
    const float* lng = P->in[14] + (size_t)j * DM; const float* lnb = P->in[15] + (size_t)j * DM; const float* bs = P->in[17] + (size_t)j * 16 * 128;
    LAS bf16* Vt = (LAS bf16*)(LAS unsigned char*)lds_;
    constexpr int VP = 136;
    const int nunits = (Mrows / 128) * 16;
    for (int u = blockIdx.x; u < nunits; u += gridDim.x) {
        const int c = u >> 4, g = u & 15;
        __syncthreads();
        {
            const int q = tid >> 2, dq = (tid & 3) * 32; const int row = c * 128 + q;
            const float mean = VST[2 * row], rstd = VST[2 * row + 1];
            const bf16* src = Z + (size_t)row * 4096 + 2048 + g * 128 + dq;
#pragma unroll
            for (int t = 0; t < 4; ++t) { const u32x4 w = *(const u32x4*)(src + 8 * t);
                float v[8] = {bflo(w.x), bfhi(w.x), bflo(w.y), bfhi(w.y), bflo(w.z), bfhi(w.z), bflo(w.w), bfhi(w.w)};
                const float* gp = lng + g * 128 + dq + 8 * t; const float* bp = lnb + g * 128 + dq + 8 * t;
#pragma unroll
                for (int i = 0; i < 8; ++i) { const float vn = (v[i] - mean) * rstd * gp[i] + bp[i]; Vt[(dq + 8 * t + i) * VP + q] = tobf1(vn); } }
        }
        __syncthreads();
        const int fr = lane & 15, fq = lane >> 4;
        bf16x8 a[4];
        const bf16* wrow = WS + (size_t)g * 128 * 128 + (size_t)(16 * wid + fr) * 128 + 8 * fq;
#pragma unroll
        for (int ks = 0; ks < 4; ++ks) a[ks] = *(const bf16x8*)(wrow + 32 * ks);
#pragma unroll
        for (int nb = 0; nb < 8; ++nb) {
            f32x4 acc = {0.f, 0.f, 0.f, 0.f};
#pragma unroll
            for (int ks = 0; ks < 4; ++ks) { const bf16x8 b = *(const LAS bf16x8*)(Vt + (16 * nb + fr) * VP + 32 * ks + 8 * fq);
                acc = __builtin_amdgcn_mfma_f32_16x16x32_bf16(a[ks], b, acc, 0, 0, 0); }
#pragma unroll
            for (int r = 0; r < 4; ++r) { const int p = 16 * wid + fq * 4 + r, d = 16 * nb + fr; const size_t grow = (size_t)(c * 128 + p);
                const float sv = acc[r] + bs[g * 128 + p];
                const float uu = bf1(Z[grow * 4096 + g * 128 + d]);
                Gb[grow * 2048 + g * 128 + d] = tobf1(uu * sv); }
        }
    }
}

__device__ __forceinline__ void rope_cs(int row, int l, float& cs, float& sn) {
    const int t = row & (SEQ - 1); const int pos = (l & 32) ? (t & 63) : (t >> 6);
    const float inv = powf(10000.0f, -(float)(l & 15) * (1.0f / 16.0f));
    const float ang = (float)pos * inv; sincosf(ang, &sn, &cs);
}
__device__ __forceinline__ float rope_apply(float x, int l, float cs, float sn) {
    const float p = lane_xor16(x, l);
    return (l & 16) ? (p * sn + x * cs) : (x * cs - p * sn);
}
__device__ __forceinline__ void mla_norm_pass(CP P, int lane, int gw, int NGW) {
    const bf16* C = (const bf16*)(P->ws + WS_C); bf16* CQN = (bf16*)(P->ws + WS_CQN); bf16* CKVN = (bf16*)(P->ws + WS_CKVN); bf16* KR = (bf16*)(P->ws + WS_KR);
    const float* qn = P->in[20]; const float* kvn = P->in[21];
    for (int row = gw; row < MT; row += NGW) {
        const bf16* c = C + (size_t)row * 1280;
#pragma unroll
        for (int part = 0; part < 2; ++part) {
            const u32x4 w = *(const u32x4*)(c + part * 512 + 8 * lane);
            float v[8] = {bflo(w.x), bfhi(w.x), bflo(w.y), bfhi(w.y), bflo(w.z), bfhi(w.z), bflo(w.w), bfhi(w.w)};
            float ss = 0.f;
#pragma unroll
            for (int i = 0; i < 8; ++i) ss += v[i] * v[i];
            const float r = 1.0f / sqrtf(wave_sum(ss) * (1.0f / 512.0f) + LN_EPS);
            const float* nw = (part ? kvn : qn) + 8 * lane;
            u32x4 o; o.x = cvtpk(v[0] * r * nw[0], v[1] * r * nw[1]); o.y = cvtpk(v[2] * r * nw[2], v[3] * r * nw[3]); o.z = cvtpk(v[4] * r * nw[4], v[5] * r * nw[5]); o.w = cvtpk(v[6] * r * nw[6], v[7] * r * nw[7]);
            *(u32x4*)((part ? CKVN : CQN) + (size_t)row * 512 + 8 * lane) = o;
        }
        float x = bf1(c[1024 + lane]);
        if (row < ML) { float cs, sn; rope_cs(row, lane, cs, sn); x = rope_apply(x, lane, cs, sn); }
        KR[(size_t)row * 64 + lane] = tobf1(x);
    }
}
__device__ __forceinline__ void rope_pass(bf16* buf, int ld, int col0, int nchunks, int cstride, int lane, int gw, int NGW) {
    for (int row = gw; row < ML; row += NGW) {
        float cs, sn; rope_cs(row, lane, cs, sn);
        bf16* r = buf + (size_t)row * ld + col0 + lane;
#pragma unroll 4
        for (int k = 0; k < nchunks; ++k) { const float x = bf1(r[k * cstride]); r[k * cstride] = tobf1(rope_apply(x, lane, cs, sn)); }
    }
}

namespace att {
#ifndef ATT_LEAN
#define ATT_LEAN 1
#endif
#ifndef ATT_3STAGE
#define ATT_3STAGE 0
#endif
#ifndef ATT_SDEPTH
#define ATT_SDEPTH(MODE) ((MODE) == 0 ? 1 : 1)
#endif
#ifndef ATT_PVPIPE
#define ATT_PVPIPE(MODE) false
#endif
#define SBAR() __builtin_amdgcn_sched_barrier(0)
__device__ __forceinline__ int crow(int r, int hi) { return (r & 3) + 8 * (r >> 2) + 4 * hi; }
__device__ __forceinline__ unsigned cvtpkv(float lo, float hi) { unsigned r; asm volatile("v_cvt_pk_bf16_f32 %0, %1, %2" : "=v"(r) : "v"(lo), "v"(hi)); return r; }

__device__ __forceinline__ void partialSM(f32x16& p0, f32x16& p1, float& m_reg, float& mn, float& alpha, const float C, const float THRS) {
  float pmax = p0[0];
#pragma unroll
  for (int r = 1; r < 16; ++r) pmax = fmaxf(pmax, p0[r]);
#pragma unroll
  for (int r = 0; r < 16; ++r) pmax = fmaxf(pmax, p1[r]);
  { auto rr = __builtin_amdgcn_permlane32_swap(__float_as_uint(pmax), __float_as_uint(pmax), false, false);
    pmax = fmaxf(__uint_as_float(rr[0]), __uint_as_float(rr[1])); }
  if (__builtin_expect(__all(pmax - m_reg <= THRS), 1)) { mn = m_reg; alpha = 1.f; }
  else { mn = fmaxf(m_reg, pmax); alpha = __builtin_amdgcn_exp2f((m_reg - mn) * C); m_reg = mn; }
  const float mnC = -mn * C;
#pragma unroll
  for (int r = 0; r < 16; ++r) p0[r] = fmaf(p0[r], C, mnC);
#pragma unroll
  for (int r = 0; r < 16; ++r) p1[r] = fmaf(p1[r], C, mnC);
#pragma unroll
  for (int r = 0; r < 16; ++r) p0[r] = __builtin_amdgcn_exp2f(p0[r]);
}
__device__ __forceinline__ void finishSM(f32x16& p0, f32x16& p1, float alpha, float& l_reg, bf16x8& pa0, bf16x8& pa1, bf16x8& pa2, bf16x8& pa3) {
#pragma unroll
  for (int r = 0; r < 16; ++r) p1[r] = __builtin_amdgcn_exp2f(p1[r]);
  float ps = 0;
#pragma unroll
  for (int r = 0; r < 16; ++r) ps += p0[r];
#pragma unroll
  for (int r = 0; r < 16; ++r) ps += p1[r];
  { auto rr = __builtin_amdgcn_permlane32_swap(__float_as_uint(ps), __float_as_uint(ps), false, false);
    ps = __uint_as_float(rr[0]) + __uint_as_float(rr[1]); }
  l_reg = l_reg * alpha + ps;
#define PK4(P, BASE, OUT) do { unsigned a0 = cvtpkv(P[BASE + 0], P[BASE + 1]), a1 = cvtpkv(P[BASE + 2], P[BASE + 3]);   \
    unsigned b0 = cvtpkv(P[BASE + 4], P[BASE + 5]), b1 = cvtpkv(P[BASE + 6], P[BASE + 7]);                              \
    auto r0 = __builtin_amdgcn_permlane32_swap(a0, b0, false, false); auto r1 = __builtin_amdgcn_permlane32_swap(a1, b1, false, false); \
    u32x4 w = {r0[0], r1[0], r0[1], r1[1]}; OUT = *reinterpret_cast<bf16x8*>(&w); } while (0)
  PK4(p0, 0, pa0); PK4(p0, 8, pa1); PK4(p1, 0, pa2); PK4(p1, 8, pa3);
#undef PK4
}
__device__ __forceinline__ void partialSM_lean(f32x16& p0, f32x16& p1, f32x16& nm, float& alpha, const bool first) {
  constexpr float THR2 = 11.541560327111707f;
  float dmax = p0[0];
#pragma unroll
  for (int r = 1; r < 16; ++r) dmax = fmaxf(dmax, p0[r]);
#pragma unroll
  for (int r = 0; r < 16; ++r) dmax = fmaxf(dmax, p1[r]);
  { auto rr = __builtin_amdgcn_permlane32_swap(__float_as_uint(dmax), __float_as_uint(dmax), false, false);
    dmax = fmaxf(__uint_as_float(rr[0]), __uint_as_float(rr[1])); }
  alpha = 1.f;
  if (first || !__all(dmax <= THR2)) {
    const float delta = first ? dmax : (dmax > THR2 ? dmax : 0.f);
    if (!first) alpha = __builtin_amdgcn_exp2f(-delta);
#pragma unroll
    for (int r = 0; r < 16; ++r) { p0[r] -= delta; p1[r] -= delta; nm[r] -= delta; }
  }
#pragma unroll
  for (int r = 0; r < 16; ++r) p0[r] = __builtin_amdgcn_exp2f(p0[r]);
}
__device__ __forceinline__ void finishSM_lean(f32x16& p0, f32x16& p1, bf16x8& pa0, bf16x8& pa1, bf16x8& pa2, bf16x8& pa3) {
#pragma unroll
  for (int r = 0; r < 16; ++r) p1[r] = __builtin_amdgcn_exp2f(p1[r]);
#define PK4(P, BASE, OUT) do { unsigned a0 = cvtpkv(P[BASE + 0], P[BASE + 1]), a1 = cvtpkv(P[BASE + 2], P[BASE + 3]);   \
    unsigned b0 = cvtpkv(P[BASE + 4], P[BASE + 5]), b1 = cvtpkv(P[BASE + 6], P[BASE + 7]);                              \
    auto r0 = __builtin_amdgcn_permlane32_swap(a0, b0, false, false); auto r1 = __builtin_amdgcn_permlane32_swap(a1, b1, false, false); \
    u32x4 w = {r0[0], r1[0], r0[1], r1[1]}; OUT = *reinterpret_cast<bf16x8*>(&w); } while (0)
  PK4(p0, 0, pa0); PK4(p0, 8, pa1); PK4(p1, 0, pa2); PK4(p1, 8, pa3);
#undef PK4
}
__device__ __forceinline__ bf16x8 scale_bf16x8(bf16x8 v, float c) {
  const u32x4 w = *reinterpret_cast<u32x4*>(&v); u32x4 o;
  o.x = cvtpk(bflo(w.x) * c, bfhi(w.x) * c); o.y = cvtpk(bflo(w.y) * c, bfhi(w.y) * c); o.z = cvtpk(bflo(w.z) * c, bfhi(w.z) * c); o.w = cvtpk(bflo(w.w) * c, bfhi(w.w) * c);
  return *reinterpret_cast<bf16x8*>(&o);
}
template <int PITCH> __device__ __forceinline__ int kswz(int r) { return PITCH == 256 ? (r & 15) : ((r >> 1) & 7); }
template <int NQF, int NQR, int PITCH> __device__ __forceinline__ void qkt(f32x16& p0, f32x16& p1, const LAS char* Ks, int chunk0, const bf16x8* qr, const LAS char* ql, int r32, int hi, const f32x16 init = f32x16{}) {
  p0 = init; p1 = init;
  const int sw = kswz<PITCH>(r32);
#pragma unroll
  for (int d0 = 0; d0 < NQF; ++d0) { const int off = ((chunk0 + d0 * 2 + hi) ^ sw) * 16;
    const bf16x8 b0 = *(const LAS bf16x8*)(Ks + r32 * PITCH + off);
    const bf16x8 b1 = *(const LAS bf16x8*)(Ks + (32 + r32) * PITCH + off);
    const bf16x8 q = d0 < NQR ? qr[d0 < NQR ? d0 : 0] : *(const LAS bf16x8*)(ql + (d0 - NQR < 0 ? 0 : d0 - NQR) * 1024);
    p0 = __builtin_amdgcn_mfma_f32_32x32x16_bf16(b0, q, p0, 0, 0, 0);
    p1 = __builtin_amdgcn_mfma_f32_32x32x16_bf16(b1, q, p1, 0, 0, 0); }
}
__device__ __forceinline__ int v_st(int k, int c) { const int kk = (k & ~0xC) | ((k & 4) << 1) | ((k & 8) >> 1); return ((kk >> 3) * 4 + (c >> 5)) * 512 + ((kk & 7) * 32 + (c & 31)) * 2; }
__device__ __forceinline__ int v_rd_base(int lane) { return ((lane & 3) << 3) | (((lane >> 2) & 3) << 6) | (((lane >> 4) & 1) << 5) | (((lane >> 5) & 1) << 8); }
constexpr int v_rd_off(int d0, int ks, int half) { return d0 * 512 + ks * 4096 + half * 2048; }
template <int OFF> __device__ __forceinline__ s16x4 tr_read(int vb) {
  s16x4 r; asm volatile("ds_read_b64_tr_b16 %0, %1 offset:%2" : "=&v"(r) : "v"(vb), "i"(OFF) : "memory"); return r;
}
template <int D0> __device__ __forceinline__ void pv_one(f32x16& od, int vb, bf16x8 pa0, bf16x8 pa1, bf16x8 pa2, bf16x8 pa3) {
  const s16x4 l0 = tr_read<v_rd_off(D0, 0, 0)>(vb), h0 = tr_read<v_rd_off(D0, 0, 1)>(vb), l1 = tr_read<v_rd_off(D0, 1, 0)>(vb), h1 = tr_read<v_rd_off(D0, 1, 1)>(vb);
  const s16x4 l2 = tr_read<v_rd_off(D0, 2, 0)>(vb), h2 = tr_read<v_rd_off(D0, 2, 1)>(vb), l3 = tr_read<v_rd_off(D0, 3, 0)>(vb), h3 = tr_read<v_rd_off(D0, 3, 1)>(vb);
  asm volatile("s_waitcnt lgkmcnt(0)" ::: "memory"); SBAR();
#define PK(L, H) (bf16x8){L[0], L[1], L[2], L[3], H[0], H[1], H[2], H[3]}
  od = __builtin_amdgcn_mfma_f32_32x32x16_bf16(pa0, PK(l0, h0), od, 0, 0, 0);
  od = __builtin_amdgcn_mfma_f32_32x32x16_bf16(pa1, PK(l1, h1), od, 0, 0, 0);
  od = __builtin_amdgcn_mfma_f32_32x32x16_bf16(pa2, PK(l2, h2), od, 0, 0, 0);
  od = __builtin_amdgcn_mfma_f32_32x32x16_bf16(pa3, PK(l3, h3), od, 0, 0, 0);
#undef PK
}
__device__ __forceinline__ void pv_d0(f32x16* o, int vb, bf16x8 pa0, bf16x8 pa1, bf16x8 pa2, bf16x8 pa3) {
  pv_one<0>(o[0], vb, pa0, pa1, pa2, pa3); pv_one<1>(o[1], vb, pa0, pa1, pa2, pa3); pv_one<2>(o[2], vb, pa0, pa1, pa2, pa3); pv_one<3>(o[3], vb, pa0, pa1, pa2, pa3);
}
struct VFrag { s16x4 l0, h0, l1, h1, l2, h2, l3, h3; };
template <int D0> __device__ __forceinline__ void tr8(VFrag& f, int vb) {
  f.l0 = tr_read<v_rd_off(D0, 0, 0)>(vb); f.h0 = tr_read<v_rd_off(D0, 0, 1)>(vb); f.l1 = tr_read<v_rd_off(D0, 1, 0)>(vb); f.h1 = tr_read<v_rd_off(D0, 1, 1)>(vb);
  f.l2 = tr_read<v_rd_off(D0, 2, 0)>(vb); f.h2 = tr_read<v_rd_off(D0, 2, 1)>(vb); f.l3 = tr_read<v_rd_off(D0, 3, 0)>(vb); f.h3 = tr_read<v_rd_off(D0, 3, 1)>(vb);
}
__device__ __forceinline__ void mfma4(f32x16& od, VFrag& f, bf16x8 pa0, bf16x8 pa1, bf16x8 pa2, bf16x8 pa3) {
#define PK(L, H) (bf16x8){L[0], L[1], L[2], L[3], H[0], H[1], H[2], H[3]}
  od = __builtin_amdgcn_mfma_f32_32x32x16_bf16(pa0, PK(f.l0, f.h0), od, 0, 0, 0);
  od = __builtin_amdgcn_mfma_f32_32x32x16_bf16(pa1, PK(f.l1, f.h1), od, 0, 0, 0);
  od = __builtin_amdgcn_mfma_f32_32x32x16_bf16(pa2, PK(f.l2, f.h2), od, 0, 0, 0);
  od = __builtin_amdgcn_mfma_f32_32x32x16_bf16(pa3, PK(f.l3, f.h3), od, 0, 0, 0);
#undef PK
}
#define VF_TIE(f) "+v"(f.l0), "+v"(f.h0), "+v"(f.l1), "+v"(f.h1), "+v"(f.l2), "+v"(f.h2), "+v"(f.l3), "+v"(f.h3)
__device__ __forceinline__ void pv_pipe(f32x16* o, int vb, bf16x8 pa0, bf16x8 pa1, bf16x8 pa2, bf16x8 pa3) {
  VFrag A, B;
  asm volatile("s_waitcnt lgkmcnt(0)" ::: "memory");
  tr8<0>(A, vb); tr8<1>(B, vb);
  asm volatile("s_waitcnt lgkmcnt(8)" : VF_TIE(A) :: "memory"); SBAR();
  mfma4(o[0], A, pa0, pa1, pa2, pa3); SBAR();
  tr8<2>(A, vb);
  asm volatile("s_waitcnt lgkmcnt(8)" : VF_TIE(B) :: "memory"); SBAR();
  mfma4(o[1], B, pa0, pa1, pa2, pa3); SBAR();
  tr8<3>(B, vb);
  asm volatile("s_waitcnt lgkmcnt(8)" : VF_TIE(A) :: "memory"); SBAR();
  mfma4(o[2], A, pa0, pa1, pa2, pa3); SBAR();
  asm volatile("s_waitcnt lgkmcnt(0)" : VF_TIE(B) :: "memory"); SBAR();
  mfma4(o[3], B, pa0, pa1, pa2, pa3);
}
__device__ __forceinline__ bf16x8 ld8(const bf16* p) { return *reinterpret_cast<const bf16x8*>(p); }

template <int MODE>
__device__ __forceinline__ void attn_unit(const bf16* __restrict__ Qrow0, int ldq, const bf16* __restrict__ Kb, const bf16* __restrict__ Vb, int ldk, const bf16* __restrict__ KRb,
                                          int b, int nct, int NT, bf16* __restrict__ Ob, float lam, const float* __restrict__ subln, float oscale, LAS unsigned char* lds_, const int tid_in) {
  constexpr bool LEAN = (MODE == 1) && ATT_LEAN; constexpr int NQF = MODE == 0 ? 12 : 4, NQR = MODE == 0 ? 4 : 0, NOB = LEAN ? 5 : 4, PITCH = MODE == 0 ? 384 : 256, SHM_V = 16384, SHM_K = 64 * PITCH, SDEPTH = ATT_SDEPTH(MODE); constexpr bool PVPIPE = ATT_PVPIPE(MODE);
  const float SCALE = MODE == 0 ? 0.07216878364870323f : 0.125f;
  const float C = SCALE * 1.4426950408889634f, THRS = 8.f / SCALE;
  const int tid = launder_v(tid_in) & 511, wid = tid >> 6, lane = tid & 63, r32 = lane & 31, hi = lane >> 5;
  LAS char* lds = (LAS char*)(LAS unsigned char*)lds_;
  constexpr bool THREE = (MODE == 1) && ATT_3STAGE; constexpr int NSTG = THREE ? 3 : 2, STG = SHM_V + SHM_K, SCR0 = NSTG * STG;
#define VOFF(s) (!THREE ? (s) * SHM_V : (s) * STG)
#define KOFF(s) (!THREE ? 2 * SHM_V + (s) * SHM_K : (s) * STG + SHM_V)
  LAS char* V_lds = lds; LAS char* K_lds = lds;
  LAS float* wsf = (LAS float*)(lds + NSTG * (SHM_V + SHM_K)) + wid * 64; LAS float* li_l = wsf; LAS float* al_l = wsf + 32;
  const int wq = MODE == 0 ? wid : (wid & 3), sgrp = MODE == 0 ? 0 : (wid >> 2);
  float m_reg = -1e30f, l_reg = 0; f32x16 o[NOB] = {}; bf16x8 qr[NQR > 0 ? NQR : 1]; f32x16 nm = {};
  LAS char* ql = lds + SCR0 + 2048 + wid * (MODE == 0 ? 8192 : 4096) + lane * 16;
  const bf16* Qw = Qrow0 + (size_t)(wq * 32 + r32) * ldq + sgrp * 64 + hi * 8;
#pragma unroll
  for (int d0 = 0; d0 < NQR; ++d0) qr[d0] = ld8(Qw + d0 * 16);
#pragma unroll
  for (int d0 = NQR; d0 < NQF; ++d0) { bf16x8 qv = ld8(Qw + d0 * 16); if (LEAN) qv = scale_bf16x8(qv, C); *(LAS bf16x8*)(ql + (d0 - NQR) * 1024) = qv; }
  const int sr = tid >> 4, sc = (tid & 15) * 8, vst0 = v_st(sr, sc), vst1 = v_st(32 + sr, sc);
  const int kst0 = sr * PITCH + (((tid & 15) ^ kswz<PITCH>(sr)) * 16), kst1 = kst0 + 32 * PITCH;
  const int rrow = tid >> 3, krs = rrow * PITCH + (((16 + (tid & 7)) ^ kswz<PITCH>(rrow)) * 16);
  const int chunk0 = sgrp * 8;
  const int vb0 = (int)(uintptr_t)V_lds + v_rd_base(lane);
  struct Slot { bf16x8 vs0, vs1, ks0, ks1, kr; } sr_[SDEPTH];
#define KROW(jt) ((jt) < nct ? (ML + b * CTXL + (jt) * 64) : (b * SEQ + ((jt) - nct) * 64))
#define SLOAD(i, jt) do { const int k0_ = KROW(jt); sr_[i].vs0 = ld8(Vb + (size_t)(k0_ + sr) * ldk + sc); sr_[i].vs1 = ld8(Vb + (size_t)(k0_ + 32 + sr) * ldk + sc); \
    sr_[i].ks0 = ld8(Kb + (size_t)(k0_ + sr) * ldk + sc); sr_[i].ks1 = ld8(Kb + (size_t)(k0_ + 32 + sr) * ldk + sc); \
    if (MODE == 0) sr_[i].kr = ld8(KRb + (size_t)(k0_ + rrow) * 64 + (tid & 7) * 8); } while (0)
#define SWRITE(bf, i) do { *(LAS bf16x8*)(V_lds + VOFF(bf) + vst0) = sr_[i].vs0; *(LAS bf16x8*)(V_lds + VOFF(bf) + vst1) = sr_[i].vs1; \
    *(LAS bf16x8*)(K_lds + KOFF(bf) + kst0) = sr_[i].ks0; *(LAS bf16x8*)(K_lds + KOFF(bf) + kst1) = sr_[i].ks1; \
    if (MODE == 0) *(LAS bf16x8*)(K_lds + KOFF(bf) + krs) = sr_[i].kr; } while (0)
#define SWAIT() do { if constexpr (SDEPTH == 2) asm volatile("s_waitcnt vmcnt(4)" ::: "memory"); else asm volatile("s_waitcnt vmcnt(0)" ::: "memory"); } while (0)
#define RESC(a) do { if (__any((a) < 1.f)) { if (hi == 0) al_l[r32] = (a); asm volatile("s_waitcnt lgkmcnt(0)" ::: "memory"); \
    _Pragma("unroll") for (int d = 0; d < NOB; ++d) _Pragma("unroll") for (int r = 0; r < 16; ++r) o[d][r] *= al_l[crow(r, hi)]; } } while (0)
#define PV(vb_) do { if constexpr (PVPIPE) pv_pipe(o, (vb_), pa0, pa1, pa2, pa3); else pv_d0(o, (vb_), pa0, pa1, pa2, pa3); \
    if constexpr (LEAN) { const bf16x8 one8 = {0x3F80, 0x3F80, 0x3F80, 0x3F80, 0x3F80, 0x3F80, 0x3F80, 0x3F80};     \
        o[NOB - 1] = __builtin_amdgcn_mfma_f32_32x32x16_bf16(pa0, one8, o[NOB - 1], 0, 0, 0); o[NOB - 1] = __builtin_amdgcn_mfma_f32_32x32x16_bf16(pa1, one8, o[NOB - 1], 0, 0, 0); \
        o[NOB - 1] = __builtin_amdgcn_mfma_f32_32x32x16_bf16(pa2, one8, o[NOB - 1], 0, 0, 0); o[NOB - 1] = __builtin_amdgcn_mfma_f32_32x32x16_bf16(pa3, one8, o[NOB - 1], 0, 0, 0); } } while (0)
#define PSM(p0_, p1_, mn_, al_, first_) do { if constexpr (LEAN) partialSM_lean(p0_, p1_, nm, al_, first_); else partialSM(p0_, p1_, m_reg, mn_, al_, C, THRS); } while (0)
#define FSM(p0_, p1_, al_) do { if constexpr (LEAN) finishSM_lean(p0_, p1_, pa0, pa1, pa2, pa3); else finishSM(p0_, p1_, al_, l_reg, pa0, pa1, pa2, pa3); } while (0)
#define QKT(p0_, p1_, Kp_) do { if constexpr (LEAN) qkt<NQF, NQR, PITCH>(p0_, p1_, Kp_, chunk0, qr, ql, r32, hi, nm); else qkt<NQF, NQR, PITCH>(p0_, p1_, Kp_, chunk0, qr, ql, r32, hi); } while (0)
  f32x16 pA0, pA1, pB0, pB1; float mnA, mnB, alA, alB; bf16x8 pa0, pa1, pa2, pa3;
  if constexpr (!THREE) {
  constexpr int SE = 0, SO = SDEPTH - 1;
  SLOAD(SE, 0); asm volatile("s_waitcnt vmcnt(0)" ::: "memory"); SWRITE(0, SE); __syncthreads();
  QKT(pA0, pA1, K_lds + KOFF(0)); PSM(pA0, pA1, mnA, alA, true);
  SLOAD(SO, 1); if constexpr (SDEPTH == 2) { if (2 < NT) SLOAD(SE, 2); }
  SWAIT(); SWRITE(1, SO); __syncthreads();
  for (int j = 1; j + 1 < NT; j += 2) {
    SBAR(); QKT(pB0, pB1, K_lds + KOFF(1));
    FSM(pA0, pA1, alA); SBAR();
    SLOAD(SO, j + SDEPTH); SBAR();
    PV(vb0); PSM(pB0, pB1, mnB, alB, false);
    __syncthreads(); SWAIT(); SWRITE(0, SE);
    RESC(alB); __syncthreads();
    SBAR(); QKT(pA0, pA1, K_lds + KOFF(0));
    FSM(pB0, pB1, alB); SBAR();
    if (SDEPTH == 1 || j + 3 < NT) SLOAD(SE, j + 1 + SDEPTH); SBAR();
    PV(vb0 + VOFF(1)); PSM(pA0, pA1, mnA, alA, false);
    __syncthreads(); SWAIT(); SWRITE(1, SO);
    RESC(alA); __syncthreads();
  }
  SBAR(); QKT(pB0, pB1, K_lds + KOFF(1));
  FSM(pA0, pA1, alA); SBAR();
  PV(vb0); PSM(pB0, pB1, mnB, alB, false);
  __syncthreads(); RESC(alB);
  FSM(pB0, pB1, alB); SBAR();
  PV(vb0 + VOFF(1));
  } else {
#define STEP(PC0, PC1, ALC, PP0, PP1, ALP, jj, SP, SC, SN) do { const int j_ = (jj); \
      if (j_ + 1 < NT) { asm volatile("s_waitcnt vmcnt(0)" ::: "memory"); SWRITE(SN, 0); if (j_ + 2 < NT) SLOAD(0, j_ + 2); } \
      SBAR(); QKT(PC0, PC1, K_lds + KOFF(SC)); FSM(PP0, PP1, ALP); SBAR(); \
      PV(vb0 + VOFF(SP)); PSM(PC0, PC1, mnA, ALC, false); \
      RESC(ALC); __syncthreads(); } while (0)
    SLOAD(0, 0); asm volatile("s_waitcnt vmcnt(0)" ::: "memory"); SWRITE(0, 0);
    SLOAD(0, 1); asm volatile("s_waitcnt vmcnt(0)" ::: "memory"); SWRITE(1, 0);
    SLOAD(0, 2); __syncthreads();
    QKT(pA0, pA1, K_lds + KOFF(0)); PSM(pA0, pA1, mnA, alA, true);
    STEP(pB0, pB1, alB, pA0, pA1, alA, 1, 0, 1, 2);
    int j = 2;
    for (; j + 5 < NT; j += 6) {
      STEP(pA0, pA1, alA, pB0, pB1, alB, j, 1, 2, 0);
      STEP(pB0, pB1, alB, pA0, pA1, alA, j + 1, 2, 0, 1);
      STEP(pA0, pA1, alA, pB0, pB1, alB, j + 2, 0, 1, 2);
      STEP(pB0, pB1, alB, pA0, pA1, alA, j + 3, 1, 2, 0);
      STEP(pA0, pA1, alA, pB0, pB1, alB, j + 4, 2, 0, 1);
      STEP(pB0, pB1, alB, pA0, pA1, alA, j + 5, 0, 1, 2);
    }
    if (j < NT) { STEP(pA0, pA1, alA, pB0, pB1, alB, j, 1, 2, 0); STEP(pB0, pB1, alB, pA0, pA1, alA, j + 1, 2, 0, 1); j += 2; }
    if (j < NT) { STEP(pA0, pA1, alA, pB0, pB1, alB, j, 0, 1, 2); STEP(pB0, pB1, alB, pA0, pA1, alA, j + 1, 1, 2, 0); j += 2; }
    FSM(pB0, pB1, alB); SBAR();
    { const int sl = (NT - 1) % 3; PV(vb0 + VOFF(sl)); }
#undef STEP
  }
  float rli[16];
  if constexpr (LEAN) {
#pragma unroll
    for (int r = 0; r < 16; ++r) rli[r] = __builtin_amdgcn_rcpf(o[NOB - 1][r]);
  } else {
    if (hi == 0) li_l[r32] = l_reg; asm volatile("s_waitcnt lgkmcnt(0)" ::: "memory");
#pragma unroll
    for (int r = 0; r < 16; ++r) rli[r] = __builtin_amdgcn_rcpf(li_l[crow(r, hi)]);
  }
  bf16* Ow = Ob + (size_t)(wq * 32) * DM;
  if constexpr (MODE == 0) {
#pragma unroll
    for (int r = 0; r < 16; ++r) { const int orow = crow(r, hi);
#pragma unroll
      for (int d0 = 0; d0 < 4; ++d0) Ow[(size_t)orow * DM + d0 * 32 + r32] = tobf1(o[d0][r] * rli[r]); }
    __syncthreads();
  } else {
    LAS float* ex = (LAS float*)lds;
    __syncthreads();
    if (sgrp == 1) {
#pragma unroll
      for (int r = 0; r < 16; ++r)
#pragma unroll
        for (int d0 = 0; d0 < 4; ++d0) ex[(wq * 32 + crow(r, hi)) * 128 + d0 * 32 + r32] = o[d0][r] * rli[r];
    }
    __syncthreads();
    if (sgrp == 0) {
#pragma unroll
      for (int r = 0; r < 16; ++r) { const int orow = crow(r, hi); float dd[4]; float ss = 0.f;
#pragma unroll
        for (int d0 = 0; d0 < 4; ++d0) { dd[d0] = o[d0][r] * rli[r] - lam * ex[(wq * 32 + orow) * 128 + d0 * 32 + r32]; ss += dd[d0] * dd[d0]; }
        ss = half_sum32(ss);
        const float rs = oscale / sqrtf(ss * (1.0f / 128.0f) + LN_EPS);
#pragma unroll
        for (int d0 = 0; d0 < 4; ++d0) Ow[(size_t)orow * DM + d0 * 32 + r32] = tobf1(dd[d0] * rs * subln[d0 * 32 + r32]); }
    }
    __syncthreads();
  }
#undef VOFF
#undef KOFF
#undef PV
#undef PSM
#undef FSM
#undef QKT
#undef KROW
#undef SLOAD
#undef SWRITE
#undef SWAIT
#undef RESC
}
}

__device__ __forceinline__ void mla_attn_phase(CP P, LAS unsigned char* lds, const int tid) {
    const bf16* QM = (const bf16*)(P->ws + WS_QM); const bf16* KV = (const bf16*)(P->ws + WS_KV); const bf16* KR = (const bf16*)(P->ws + WS_KR); bf16* Gb = (bf16*)(P->ws + WS_G);
    const int c = blockIdx.x, G = gridDim.x;
    for (int u = c; u < 1024 + 32; u += G) {
        int b, h, qrow0, NT;
        if (u < 1024) { const int i = u >> 8, cc = u & 255; const int bh = (cc & 7) + 8 * i, qb = cc >> 3; b = bh >> 4; h = bh & 15; qrow0 = b * SEQ + qb * 256; NT = 4 + 128; }
        else { const int bh = u - 1024; b = bh >> 4; h = bh & 15; qrow0 = ML + b * CTXL; NT = 4; }
        att::attn_unit<0>(QM + (size_t)qrow0 * 3072 + h * 192, 3072, KV + h * 256, KV + h * 256 + 128, 4096, KR, b, 4, NT, Gb + (size_t)qrow0 * DM + h * 128, 0.f, nullptr, 1.f, lds, tid);
    }
}
__device__ __forceinline__ void da_attn_phase(CP P, float lam, float oscale, LAS unsigned char* lds, const int tid, const bool ctx_q) {
    const bf16* Z = (const bf16*)(P->ws + WS_Z); bf16* Gb = (bf16*)(P->ws + WS_G); const float* subln = P->in[27];
    const int c = blockIdx.x, G = gridDim.x;
    for (int u = c; u < 2048 + (ctx_q ? 64 : 0); u += G) {
        int b, h, qrow0, NT;
        if (u < 2048) { const int i = u >> 8, cc = u & 255; const int bh = (cc & 7) + 8 * (i >> 1), qb = (cc >> 3) + 32 * (i & 1); b = bh >> 4; h = bh & 15; qrow0 = b * SEQ + qb * 128; NT = 4 + 128; }
        else { const int v = u - 2048; const int bh = v >> 1; b = bh >> 4; h = bh & 15; qrow0 = ML + b * CTXL + (v & 1) * 128; NT = 4; }
        att::attn_unit<1>(Z + (size_t)qrow0 * 6144 + h * 128, 6144, Z + 2048 + h * 128, Z + 4096 + h * 128, 6144, nullptr, b, 4, NT, Gb + (size_t)qrow0 * DM + h * 128, lam, subln, oscale, lds, tid);
    }
}

__device__ __forceinline__ unsigned f2ord(float f) { const unsigned u = __float_as_uint(f); return u ^ ((unsigned)((int)u >> 31) | 0x80000000u); }
__device__ __forceinline__ float ord2f(unsigned k) { return __uint_as_float((k & 0x80000000u) ? (k ^ 0x80000000u) : ~k); }
__device__ __forceinline__ void ce_desc(unsigned& a, unsigned& b) { const unsigned mx = a > b ? a : b, mn = a > b ? b : a; a = mx; b = mn; }
template <int N, bool DESC> __device__ __forceinline__ void bitonic_merge(unsigned* a) {
#pragma unroll
    for (int j = N / 2; j > 0; j >>= 1)
#pragma unroll
        for (int i = 0; i < N; ++i) { const int l = i ^ j; if (l > i) { if (DESC) ce_desc(a[i], a[l]); else ce_desc(a[l], a[i]); } }
}
template <int N, bool DESC> __device__ __forceinline__ void bitonic_sort(unsigned* a) {
#pragma unroll
    for (int k = 2; k <= N; k <<= 1)
#pragma unroll
        for (int j = k >> 1; j > 0; j >>= 1)
#pragma unroll
            for (int i = 0; i < N; ++i) { const int l = i ^ j; if (l > i) { const bool up = ((i & k) == 0); if (up == DESC) ce_desc(a[i], a[l]); else ce_desc(a[l], a[i]); } }
}
__device__ __forceinline__ void top16_of_64(unsigned (&a)[64]) {
    bitonic_sort<16, true>(a); bitonic_sort<16, false>(a + 16); bitonic_sort<16, true>(a + 32); bitonic_sort<16, false>(a + 48);
#pragma unroll
    for (int i = 0; i < 16; ++i) a[i] = a[i] > a[16 + i] ? a[i] : a[16 + i];
    bitonic_merge<16, true>(a);
#pragma unroll
    for (int i = 0; i < 16; ++i) a[32 + i] = a[32 + i] > a[48 + i] ? a[32 + i] : a[48 + i];
    bitonic_merge<16, false>(a + 32);
#pragma unroll
    for (int i = 0; i < 16; ++i) a[i] = a[i] > a[32 + i] ? a[i] : a[32 + i];
    bitonic_merge<16, true>(a);
}
template <int PASS> __device__ __forceinline__ void route_pass(const bf16* QP, const LAS char* lds, int tok, int head, int r32, int hi, unsigned (&top)[16]) {
    f32x16 acc[4] = {};
    const bf16* qp = QP + (size_t)tok * DM + head * 256 + PASS * 128 + hi * 8;
    bf16x8 qf[8];
#pragma unroll
    for (int ks = 0; ks < 8; ++ks) qf[ks] = *(const bf16x8*)(qp + ks * 16);
    const LAS char* Kl = lds + PASS * 32768;
#pragma unroll
    for (int kb = 0; kb < 4; ++kb)
#pragma unroll
        for (int ks = 0; ks < 8; ++ks) { const bf16x8 a = *(const LAS bf16x8*)(Kl + (kb * 32 + r32) * 256 + (((ks * 2 + hi) ^ (r32 & 15)) * 16));
            acc[kb] = __builtin_amdgcn_mfma_f32_32x32x16_bf16(a, qf[ks], acc[kb], 0, 0, 0); }
    unsigned key[64]; const unsigned base = 127u - 4u * (unsigned)hi;
#pragma unroll
    for (int kb = 0; kb < 4; ++kb)
#pragma unroll
        for (int r = 0; r < 16; ++r) key[kb * 16 + r] = (f2ord(acc[kb][r]) & ~127u) | (base - (unsigned)(kb * 32 + (r & 3) + 8 * (r >> 2)));
    top16_of_64(key);
    unsigned pr[16];
#pragma unroll
    for (int i = 0; i < 16; ++i) pr[i] = lane_xor32(key[15 - i], hi << 5);
#pragma unroll
    for (int i = 0; i < 16; ++i) key[i] = key[i] > pr[i] ? key[i] : pr[i];
    bitonic_merge<16, true>(key);
#pragma unroll
    for (int i = 0; i < 16; ++i) top[i] = key[i];
}
__device__ __forceinline__ void route_phase(CP P, int L, int Mrows, LAS unsigned char* lds_, int tid, int lane, int wid, int gw, int NGW) {
    const bf16* QP = (const bf16*)(P->ws + WS_QP); unsigned* ROUTE = (unsigned*)(P->ws + WS_ROUTE);
    LAS char* lds = (LAS char*)(LAS unsigned char*)lds_;
    __syncthreads();
    {
        const bf16* K1 = (const bf16*)(P->ws + WS_PK1) + (size_t)L * 128 * 128; const bf16* K2 = (const bf16*)(P->ws + WS_PK2) + (size_t)L * 128 * 128;
        for (int c16 = tid; c16 < 2 * 128 * 16; c16 += NWAVES * 64) { const int mat = c16 >> 11, row = (c16 >> 4) & 127, ch = c16 & 15;
            const u32x4 w = *(const u32x4*)((mat ? K2 : K1) + row * 128 + ch * 8);
            *(LAS u32x4*)(lds + mat * 32768 + row * 256 + ((ch ^ (row & 15)) * 16)) = w; }
    }
    __syncthreads();
    LAS unsigned* sc = (LAS unsigned*)(lds + 65536) + wid * 2048;
    const int r32 = lane & 31, hi = lane >> 5;
    for (int item = gw; item < Mrows / 4; item += NGW) {
        const int tok = item * 4 + (r32 >> 3), head = r32 & 7;
        unsigned top0[16], top1[16];
        route_pass<0>(QP, lds, tok, head, r32, hi, top0);
        route_pass<1>(QP, lds, tok, head, r32, hi, top1);
        float v1[16], v2[16];
#pragma unroll
        for (int i = 0; i < 16; ++i) { v1[i] = ord2f(top0[i] & ~127u); v2[i] = ord2f(top1[i] & ~127u);
            sc[i * 64 + lane] = 127u - (top0[i] & 127u); sc[(16 + i) * 64 + lane] = 127u - (top1[i] & 127u); }
        unsigned ck[64]; int n = 0;
#pragma unroll
        for (int i = 0; i < 16; ++i)
#pragma unroll
            for (int j = 0; j < 16; ++j) if ((i + 1) * (j + 1) <= 16) { ck[n] = (f2ord(v1[i] + v2[j]) & ~255u) | (unsigned)(i * 16 + j); ++n; }
#pragma unroll
        for (int i = 50; i < 64; ++i) ck[i] = 0u;
        top16_of_64(ck);
        float ev[16]; float sum = 0.f; const float mx = ord2f(ck[0] & ~255u);
#pragma unroll
        for (int k = 0; k < 16; ++k) { ev[k] = __expf(ord2f(ck[k] & ~255u) - mx); sum += ev[k]; }
        const float inv = 1.0f / sum;
        unsigned ee[16];
#pragma unroll
        for (int k = 0; k < 16; ++k) { const unsigned pc = ck[k] & 255u; const unsigned i1 = sc[(pc >> 4) * 64 + lane], i2 = sc[(16 + (pc & 15u)) * 64 + lane]; ee[k] = i1 * 128u + i2; ev[k] *= inv; }
        u32x4* outp = (u32x4*)(ROUTE + ((size_t)tok * 128 + head * 16 + hi * 8) * 2);
#pragma unroll
        for (int k = 0; k < 8; k += 2) { u32x4 w;
            const unsigned eL0 = ee[k], eH0 = ee[k + 8], eL1 = ee[k + 1], eH1 = ee[k + 9]; const float gL0 = ev[k], gH0 = ev[k + 8], gL1 = ev[k + 1], gH1 = ev[k + 9];
            w.x = hi ? eH0 : eL0; w.y = __float_as_uint(hi ? gH0 : gL0); w.z = hi ? eH1 : eL1; w.w = __float_as_uint(hi ? gH1 : gL1);
            outp[k >> 1] = w; }
    }
}

typedef float f32x2 __attribute__((ext_vector_type(2)));
typedef float f32x32 __attribute__((ext_vector_type(32)));
typedef unsigned u32x6 __attribute__((ext_vector_type(6)));
typedef __bf16 bf16x32 __attribute__((ext_vector_type(32)));
typedef unsigned u32x16 __attribute__((ext_vector_type(16)));
typedef __bf16 bf16x2_t __attribute__((ext_vector_type(2)));
constexpr int GS = 6, GSLOT = 2 * PROW;
__device__ __forceinline__ void glds16(const void* gsrc, unsigned lds_dst) { unsigned keep;
  asm volatile("s_mov_b32 %0, m0\n\ts_mov_b32 m0, %2\n\ts_nop 0\n\tglobal_load_lds_dwordx4 %1, off\n\ts_mov_b32 m0, %0" : "=&s"(keep) : "v"(gsrc), "s"(lds_dst) : "memory"); }
template <int GMODE = 0>
__device__ __forceinline__ void gather_phase(CP P, int L, int Mrows, LAS unsigned char* lds, int wid, int lane_, int gw, int NGW, bool dry = false) {
    const unsigned char* UV = P->ws + WS_PU + (size_t)L * 16384 * PREC;
    const unsigned* ROUTE = (const unsigned*)(P->ws + WS_ROUTE); const float* MOD = (const float*)(P->ws + WS_MOD);
    bf16* X = (bf16*)(P->ws + WS_X); bf16* H = (bf16*)(P->ws + WS_H); bf16* Xo = dry ? (bf16*)(P->ws + WS_Y) : X; bf16* Ho = dry ? (bf16*)(P->ws + WS_G) : H;
    const float* lng = P->in[6] + (size_t)(L * 2 + 1) * DM; const float* lnb = P->in[7] + (size_t)(L * 2 + 1) * DM;
    const unsigned ring = (unsigned)(uintptr_t)lds + (unsigned)wid * (GS * GSLOT);
    const int nfull = (Mrows / NGW) * NGW, rem = Mrows - nfull; const bool can_coop = (rem * 4 == NGW);
    const int nround = nfull / NGW + (rem > 0 ? 1 : 0);
#pragma unroll 1
    for (int it = 0; it < nround; ++it) {
        const bool coop = can_coop && (it == nround - 1);
        int row = gw + it * NGW, k0 = 0, kn = 128;
        if (coop) { row = nfull + (int)blockIdx.x * 2 + (wid >> 2); k0 = (wid & 3) * 32; kn = k0 + 32; }
        else if (row >= Mrows) break;
        const int lane = launder_v(lane_);
        const u32x2 ea = ((const u32x2*)(ROUTE + (size_t)row * 256))[lane], eb = ((const u32x2*)(ROUTE + (size_t)row * 256))[64 + lane];
        unsigned eax, eay, ebx, eby;
        unsigned hw[16];
#pragma unroll
        for (int j = 0; j < 4; ++j) { const u32x4 w = ((const u32x4*)(H + (size_t)row * DM))[4 * lane + j]; hw[4 * j] = w.x; hw[4 * j + 1] = w.y; hw[4 * j + 2] = w.z; hw[4 * j + 3] = w.w; }
        float y[32];
#pragma unroll
        for (int i = 0; i < 32; ++i) y[i] = 0.f;
        { unsigned e0 = ea.x, e1 = ea.y, e2 = eb.x, e3 = eb.y;
          asm volatile("" : "+v"(e0), "+v"(e1), "+v"(e2), "+v"(e3), "+v"(hw[0]), "+v"(hw[1]), "+v"(hw[2]), "+v"(hw[3]), "+v"(hw[4]), "+v"(hw[5]), "+v"(hw[6]), "+v"(hw[7]),
                       "+v"(hw[8]), "+v"(hw[9]), "+v"(hw[10]), "+v"(hw[11]), "+v"(hw[12]), "+v"(hw[13]), "+v"(hw[14]), "+v"(hw[15]) :: "memory");
          eax = e0; eay = e1; ebx = e2; eby = e3; }
        const unsigned rd_a = ring + 16u * (unsigned)lane, rd_b = ring + 2048u + 8u * (unsigned)lane;
#define G_ISSUE(k) do { const int k_ = (k); const unsigned e_ = (unsigned)__builtin_amdgcn_readlane((int)(k_ < 64 ? eax : ebx), k_ & 63); \
        const unsigned char* rp_ = UV + (size_t)e_ * PREC + 16 * lane; const unsigned sb_ = ring + (unsigned)(k_ % GS) * GSLOT; \
        if (GMODE != 2) { glds16(rp_, sb_); glds16(rp_ + 1024, sb_ + 1024); glds16(rp_ + 2048, sb_ + 2048); } else { asm volatile("" :: "v"(rp_), "s"(sb_)); } } while (0)
#pragma unroll
        for (int k = 0; k < 4; ++k) G_ISSUE(k0 + k);
#define G_READ(k, ua, ub, va, vb) do { const unsigned so_ = (unsigned)((k) % GS) * GSLOT; \
        asm volatile("ds_read_b128 %0, %4\n\tds_read_b64 %1, %5\n\tds_read_b128 %2, %4 offset:1024\n\tds_read_b64 %3, %5 offset:512" \
                     : "=&v"(ua), "=&v"(ub), "=&v"(va), "=&v"(vb) : "v"(rd_a + so_), "v"(rd_b + so_) : "memory"); } while (0)
#pragma unroll 1
        for (int k = k0; k < kn; k += 2) {
            if (k + 4 < kn) { G_ISSUE(k + 4); G_ISSUE(k + 5); asm volatile("s_waitcnt vmcnt(12)" ::: "memory"); }
            else if (k == kn - 4) asm volatile("s_waitcnt vmcnt(6)" ::: "memory");
            else asm volatile("s_waitcnt vmcnt(0)" ::: "memory");
            u32x4 uaA, vaA, uaB, vaB; u32x2 ubA, vbA, ubB, vbB;
            G_READ(k, uaA, ubA, vaA, vbA); G_READ(k + 1, uaB, ubB, vaB, vbB);
            asm volatile("s_waitcnt lgkmcnt(0)" : "+v"(uaA), "+v"(ubA), "+v"(vaA), "+v"(vbA), "+v"(uaB), "+v"(ubB), "+v"(vaB), "+v"(vbB) :: "memory");
            if (GMODE == 1) continue;
            const u32x6 u6A = {uaA.x, uaA.y, uaA.z, uaA.w, ubA.x, ubA.y}, u6B = {uaB.x, uaB.y, uaB.z, uaB.w, ubB.x, ubB.y};
            const u32x16 ubfA = __builtin_bit_cast(u32x16, __builtin_amdgcn_cvt_scalef32_pk32_bf16_fp6(u6A, 1.0f));
            const u32x16 ubfB = __builtin_bit_cast(u32x16, __builtin_amdgcn_cvt_scalef32_pk32_bf16_fp6(u6B, 1.0f));
            float a0 = 0.f, a1 = 0.f, b0 = 0.f, b1 = 0.f;
#pragma unroll
            for (int q = 0; q < 16; q += 2) { const unsigned h0_ = hw[q], h1_ = hw[q + 1], x0_ = ubfA[q], x1_ = ubfA[q + 1], z0_ = ubfB[q], z1_ = ubfB[q + 1];
                a0 = __builtin_amdgcn_fdot2_f32_bf16(__builtin_bit_cast(bf16x2_t, h0_), __builtin_bit_cast(bf16x2_t, x0_), a0, false);
                a1 = __builtin_amdgcn_fdot2_f32_bf16(__builtin_bit_cast(bf16x2_t, h1_), __builtin_bit_cast(bf16x2_t, x1_), a1, false);
                b0 = __builtin_amdgcn_fdot2_f32_bf16(__builtin_bit_cast(bf16x2_t, h0_), __builtin_bit_cast(bf16x2_t, z0_), b0, false);
                b1 = __builtin_amdgcn_fdot2_f32_bf16(__builtin_bit_cast(bf16x2_t, h1_), __builtin_bit_cast(bf16x2_t, z1_), b1, false); }
            const float dA = wave_sum(a0 + a1) * (1.0f / U_SCALE), dB = wave_sum(b0 + b1) * (1.0f / U_SCALE);
            const unsigned gsel = k < 64 ? eay : eby;
            const float wA = __uint_as_float((unsigned)__builtin_amdgcn_readlane((int)gsel, k & 63)) * gelu_tanh(dA) * (1.0f / V_SCALE);
            const float wB = __uint_as_float((unsigned)__builtin_amdgcn_readlane((int)gsel, (k & 63) + 1)) * gelu_tanh(dB) * (1.0f / V_SCALE);
            const u32x6 v6A = {vaA.x, vaA.y, vaA.z, vaA.w, vbA.x, vbA.y};
            const f32x32 vfA = __builtin_amdgcn_cvt_scalef32_pk32_f32_fp6(v6A, 1.0f);
#pragma unroll
            for (int i = 0; i < 32; ++i) y[i] += wA * vfA[i];
            const u32x6 v6B = {vaB.x, vaB.y, vaB.z, vaB.w, vbB.x, vbB.y};
            const f32x32 vfB = __builtin_amdgcn_cvt_scalef32_pk32_f32_fp6(v6B, 1.0f);
#pragma unroll
            for (int i = 0; i < 32; ++i) y[i] += wB * vfB[i];
        }
#undef G_READ
#undef G_ISSUE
        if (coop) {
            LAS f32x4* mine = (LAS f32x4*)(lds + wid * (GS * GSLOT)) + lane * 8;
#pragma unroll
            for (int i = 0; i < 8; ++i) mine[i] = (f32x4){y[4 * i], y[4 * i + 1], y[4 * i + 2], y[4 * i + 3]};
            __syncthreads();
            if ((wid & 3) == 0) {
#pragma unroll
                for (int j = 1; j < 4; ++j) { const LAS f32x4* oth = (const LAS f32x4*)(lds + (wid + j) * (GS * GSLOT)) + lane * 8;
#pragma unroll
                    for (int i = 0; i < 8; ++i) { const f32x4 t = oth[i]; y[4 * i] += t.x; y[4 * i + 1] += t.y; y[4 * i + 2] += t.z; y[4 * i + 3] += t.w; } }
            }
            __syncthreads();
            if ((wid & 3) != 0) continue;
        }
        const int slot = row_slot(row);
        const float* mod = MOD + (size_t)(L * 3 + slot) * 12288;
        const int le = launder_v(lane);
        { float xx[32], gg[32]; load_row_bf16_b(X + (size_t)row * DM, le, xx); load_row_f32_b(mod + 5 * 2048, le, gg);
#pragma unroll
          for (int i = 0; i < 32; ++i) y[i] = ALPHA * xx[i] + gg[i] * y[i]; }
        if (L < NLAYER - 1) { const float* modn = MOD + (size_t)((L + 1) * 3 + slot) * 12288;
            finish_row<true>(y, lng, lnb, Xo + (size_t)row * DM, modn, modn + 2048, Ho + (size_t)row * DM, nullptr, le); }
        else finish_row<true>(y, lng, lnb, nullptr, nullptr, nullptr, nullptr, P->out + (size_t)row * DM, le);
        asm volatile("s_waitcnt vmcnt(0)" ::: "memory");
    }
}

#ifndef ROPE_TEST
#define ROPE_TEST 0
#endif
#ifndef PROBE_DUP
#define PROBE_DUP 0
#endif
#define NOINL __forceinline__
__device__ __forceinline__ CP launder_cp(CP p) { asm volatile("" : "+s"(p)); return p; }
#define GETP() launder_cp((CP)__builtin_amdgcn_kernarg_segment_ptr())
__device__ __forceinline__ int uni(int v) { return __builtin_amdgcn_readfirstlane(v); }
__device__ __forceinline__ LAS unsigned char* uni_lds(LAS unsigned char* p) { return (LAS unsigned char*)(unsigned)__builtin_amdgcn_readfirstlane((int)(unsigned)(uintptr_t)p); }
#define PH_IDS const int wid = uni(wv_), lane = launder_v(lane_id_fresh()) & 63, tid = (wid & 7) * 64 + lane; const int gw = blockIdx.x * NWAVES + wid, NGW = gridDim.x * NWAVES; (void)lane; (void)gw; (void)NGW; (void)tid;

__device__ NOINL void ph_prologue(int wv_, LAS unsigned char* lds_) { CP P = GETP(); LAS unsigned char* lds = uni_lds(lds_); PH_IDS p0_prologue(P, lds, tid, lane, wid, gw, NGW); if (PROBE_DUP == 5) p0_prologue(P, lds, tid, lane, wid, gw, NGW); }
__device__ NOINL void ph_modreduce(int wv_) { CP P = GETP(); PH_IDS mod_reduce(P, gw, lane, NGW); }
__device__ NOINL void ph_first(int wv_) { CP P = GETP(); PH_IDS
#pragma unroll 1
    for (int rep = 0; rep < (PROBE_DUP == 6 ? 2 : 1); ++rep) first_row_pass(P, lane, gw, NGW); }
__device__ NOINL void ph_postmix(int wv_, int L_, int M_) { CP P = GETP(); const int L = uni(L_), Mrows = uni(M_); PH_IDS post_mixer_pass(P, L, Mrows, lane, gw, NGW); }
__device__ NOINL void ph_vstats(int wv_, int M_) { CP P = GETP(); const int Mrows = uni(M_); PH_IDS
#pragma unroll 1
    for (int rep = 0; rep < (PROBE_DUP == 6 ? 2 : 1); ++rep) vstats_pass(P, Mrows, lane, gw, NGW); }
__device__ NOINL void ph_spatial(int wv_, LAS unsigned char* lds_, int j_, int M_) { CP P = GETP(); LAS unsigned char* lds = uni_lds(lds_); const int j = uni(j_), Mrows = uni(M_); PH_IDS
#pragma unroll 1
    for (int rep = 0; rep < (PROBE_DUP == 6 ? 2 : 1); ++rep) spatial_phase(P, j, Mrows, lds, tid, lane, wid); }
__device__ NOINL void ph_mla_norm(int wv_) { CP P = GETP(); PH_IDS
#pragma unroll 1
    for (int rep = 0; rep < (PROBE_DUP == 6 ? 2 : 1); ++rep) mla_norm_pass(P, lane, gw, NGW); }
__device__ NOINL void ph_rope(int wv_, int which_) { CP P = GETP(); const int which = uni(which_); PH_IDS
    if (which == 0) rope_pass((bf16*)(P->ws + WS_QM), 3072, 128, 16, 192, lane, gw, NGW);
    else rope_pass((bf16*)(P->ws + WS_Z), 6144, 0, 64, 64, lane, gw, NGW); }
__device__ NOINL void ph_attn_mla(int wv_, LAS unsigned char* lds_) { CP P = GETP(); LAS unsigned char* lds = uni_lds(lds_); PH_IDS mla_attn_phase(P, lds, tid); if (PROBE_DUP == 2 || PROBE_DUP == 9) mla_attn_phase(P, lds, tid); }
__device__ NOINL void ph_attn_da(int wv_, LAS unsigned char* lds_, int L_, bool ctx_q) { CP P = GETP(); LAS unsigned char* lds = uni_lds(lds_); const int L = uni(L_); PH_IDS
    const float* lp = P->in[26];
    const float s01 = wave_sum(lp[lane] * lp[64 + lane]), s23 = wave_sum(lp[128 + lane] * lp[192 + lane]);
    const float lam_init = 0.8f - 0.6f * expf(-0.3f * (float)L);
    const float lam = expf(s01) - expf(s23) + lam_init;
    da_attn_phase(P, lam, 1.0f - lam_init, lds, tid, ctx_q); if (PROBE_DUP == 2 || PROBE_DUP == 10) da_attn_phase(P, lam, 1.0f - lam_init, lds, tid, ctx_q); }
__device__ NOINL void ph_route(int wv_, LAS unsigned char* lds_, int L_, int M_) { CP P = GETP(); LAS unsigned char* lds = uni_lds(lds_); const int L = uni(L_), Mrows = uni(M_); PH_IDS
#pragma unroll 1
    for (int rep = 0; rep < (PROBE_DUP == 4 ? 2 : 1); ++rep) route_phase(P, L, Mrows, lds, tid, lane, wid, gw, NGW); }
__device__ NOINL void ph_gather(int wv_, LAS unsigned char* lds_, int L_, int M_) { CP P = GETP(); LAS unsigned char* lds = uni_lds(lds_); const int L = uni(L_), Mrows = uni(M_); PH_IDS
    if (PROBE_DUP == 3) { gather_phase<0>(P, L, Mrows, lds, wid, lane, gw, NGW, true); }
    if (PROBE_DUP == 7) { gather_phase<1>(P, L, Mrows, lds, wid, lane, gw, NGW, true); }
    if (PROBE_DUP == 8) { gather_phase<2>(P, L, Mrows, lds, wid, lane, gw, NGW, true); }
    gather_phase<0>(P, L, Mrows, lds, wid, lane, gw, NGW); }

enum GemmId { G_GM_IN = 0, G_GM_OUT, G_MLA_IN, G_MLA_UQ, G_MLA_UKV, G_MLA_OUT, G_DA_IN, G_DA_OUT, G_PEER_Q };
__device__ NOINL void ph_gemm(int wv_, LAS unsigned char* lds_, int id_, int L_, int M_) {
    CP P = GETP(); LAS unsigned char* lds = uni_lds(lds_); const int id = uni(id_), L = uni(L_), Mrows = uni(M_); PH_IDS
    unsigned char* ws = P->ws; const int jj = L / 3;
    size_t a = WS_H, b = 0, o = 0; int M = MT, N = 2048, K = 2048, act = 0, rope = 0;
    switch (id) {
        case G_GM_IN:   a = WS_H;    b = WS_GMWIN + (size_t)jj * 4096 * 2048 * 2;  o = WS_Z;  M = Mrows; N = 4096; K = 2048; act = 1; break;
        case G_GM_OUT:  a = WS_G;    b = WS_GMWOUT + (size_t)jj * 2048 * 2048 * 2; o = WS_Y;  M = Mrows; N = 2048; K = 2048; break;
        case G_MLA_IN:  a = WS_H;    b = WS_MLAIN;  o = WS_C;  N = 1280; K = 2048; break;
        case G_MLA_UQ:  a = WS_CQN;  b = WS_MLAUQ;  o = WS_QM; N = 3072; K = 512;  rope = (ROPE_TEST == 2) ? 0 : 2; break;
        case G_MLA_UKV: a = WS_CKVN; b = WS_MLAUKV; o = WS_KV; N = 4096; K = 512;  break;
        case G_MLA_OUT: a = WS_G;    b = WS_MLAOUT; o = WS_Y;  N = 2048; K = 2048; break;
        case G_DA_IN:   a = WS_H;    b = WS_DAIN;   o = WS_Z;  N = 6144; K = 2048; rope = (ROPE_TEST == 1) ? 0 : 1; break;
        case G_DA_OUT:  a = WS_G;    b = WS_DAOUT;  o = WS_Y;  M = Mrows; N = 2048; K = 2048; break;
        default:        a = WS_H;    b = WS_PWQ + (size_t)L * 2048 * 2048 * 2;     o = WS_QP; M = Mrows; N = 2048; K = 2048; break;
    }
    pg8::Gemm g{(const pg8::bf16_t*)(ws + a), (const pg8::bf16_t*)(ws + b), M, N, K}; pg8::StaticOrder S; S.init(M, N, (int)gridDim.x, (int)blockIdx.x);
    pg8::EpiR E{(pg8::bf16_t*)(ws + o), N, act, rope, (const float*)(ws + WS_ROPE)};
#pragma unroll 1
    for (int rep = 0; rep < (PROBE_DUP == 1 ? 2 : 1); ++rep) { pg8::gemm_phase<pg8::EpiR, pg8::StaticOrder, true, true>((PG8_LAS unsigned char*)lds, g, S, E, tid); __syncthreads(); }
    const bool tail_u = (id == G_GM_OUT || id == G_MLA_OUT || id == G_DA_OUT), tail_v = (id == G_PEER_Q);
    if ((tail_u || tail_v) && L + 1 < NLAYER) {
        const int units = (M / 256) * (N / 256), G = (int)gridDim.x, tail = units % G, c = (int)blockIdx.x;
        const float* src = (tail_u ? P->in[11] : P->in[12]) + (size_t)(L + 1) * 16384 * 2048; unsigned char* dst = ws + WS_PU + (size_t)(L + 1) * 16384 * PREC;
        LAS float* scr = (LAS float*)(lds + wid * 16384);
        if (tail != 0 && c >= tail) cvt_table_fp6(src, dst, 16384, tail_u ? U_SCALE : V_SCALE, scr, lane, (c - tail) * NWAVES + wid, (G - tail) * NWAVES, tail_u ? 0 : 1);
        else if (tail == 0) cvt_table_fp6(src, dst, 16384, tail_u ? U_SCALE : V_SCALE, scr, lane, gw, NGW, tail_u ? 0 : 1);
    }
}

__global__ void __launch_bounds__(NWAVES * 64, 2) mk_fwd(Params Pv) {
    extern __shared__ __attribute__((aligned(16))) unsigned char lds_g[];
    LAS unsigned char* lds = (LAS unsigned char*)lds_g;
    const int wv = __builtin_amdgcn_readfirstlane((int)threadIdx.x >> 6);
    const int tid = wv * 64 + lane_id_fresh();
    for (int u = tid; u < (LDS_BYTES - RING_BYTES) / 4; u += NWAVES * 64) ((LAS unsigned*)(lds + RING_BYTES))[u] = 0u;
    __syncthreads();
    const int lo = Pv.ph_lo, hi = Pv.ph_hi;
    unsigned* barw = (unsigned*)(Pv.ws + WS_CTL) + CW_BAR;
    XcdBarrier bar; bar.bar = barw; bar.x = 0; bar.st = nullptr;
    if (hi - lo > 1) bar = xcd_barrier_post(barw, (volatile LAS unsigned*)(lds + MISC_OFF) + 8, tid == 0);
    int ph = 0;
#ifndef SEL
#define SELP(k) true
#else
#define SELP(k) ((k) == SEL)
#endif
    enum { RUN_BASE = __COUNTER__ + 1 };
#define RUN(call) do { if (SELP(__COUNTER__ - RUN_BASE) && ph >= lo && ph < hi) { call; } if (ph >= lo && ph + 1 < hi) xcd_barrier(bar, wv == 0 && lane_id_fresh() == 0); ++ph; } while (0)
    RUN(ph_prologue(wv, lds));
    RUN(ph_modreduce(wv));
    RUN(ph_first(wv));
#define LAYER(LL) do { constexpr int L = (LL); constexpr int kind = L % 3, jj = L / 3; constexpr int Mrows = (L == NLAYER - 1) ? ML : MT; \
        constexpr bool ctx_dead = (L == NLAYER - 2) && ((NLAYER - 1) % 3 == 0) && (kind != 0); constexpr int Mlive = ctx_dead ? ML : Mrows; \
        if (kind == 0) {                          \
            RUN(ph_gemm(wv, lds, G_GM_IN, L, Mrows)); \
            RUN(ph_vstats(wv, Mrows)); \
            RUN(ph_spatial(wv, lds, jj, Mrows)); \
            RUN(ph_gemm(wv, lds, G_GM_OUT, L, Mrows)); \
        } else if (kind == 1) {                   \
            RUN(ph_gemm(wv, lds, G_MLA_IN, L, Mrows)); \
            RUN(ph_mla_norm(wv)); \
            RUN(ph_gemm(wv, lds, G_MLA_UQ, L, Mrows); ph_gemm(wv, lds, G_MLA_UKV, L, Mrows)); \
            if (ROPE_TEST == 2) { RUN(ph_rope(wv, 0)); } \
            RUN(ph_attn_mla(wv, lds)); \
            RUN(ph_gemm(wv, lds, G_MLA_OUT, L, Mrows)); \
        } else {                                  \
            RUN(ph_gemm(wv, lds, G_DA_IN, L, Mrows); if (ROPE_TEST == 1) { __syncthreads(); } ); \
            if (ROPE_TEST == 1) { RUN(ph_rope(wv, 1)); } \
            RUN(ph_attn_da(wv, lds, L, !ctx_dead)); \
            RUN(ph_gemm(wv, lds, G_DA_OUT, L, Mlive)); \
        } \
        RUN(ph_postmix(wv, L, Mlive));                \
        RUN(ph_gemm(wv, lds, G_PEER_Q, L, Mlive));    \
        RUN(ph_route(wv, lds, L, Mlive));             \
        RUN(ph_gather(wv, lds, L, Mlive));            \
    } while (0)
    LAYER(0); LAYER(1); LAYER(2); LAYER(3);
#undef LAYER
#undef RUN
}

extern "C" void kernel_launch(void* const* d_in, const int* in_sizes, int n_in, void* d_out, int out_size, void* d_ws, size_t ws_size, hipStream_t stream) {
    static int grid = 0;
    if (grid == 0) {
        if (n_in != 29 || in_sizes[0] != ML * DM || out_size != ML * DM || ws_size < WS_END) {
            fprintf(stderr, "kernel_launch: shape mismatch: n_in %d in0 %d out %d ws %zu (need %zu); nothing launched\n", n_in, n_in > 0 ? in_sizes[0] : -1, out_size, ws_size, (size_t)WS_END); grid = -1; return; }
        int dev = 0, cus = 0, per_cu = 0;
        if (hipGetDevice(&dev) != hipSuccess || hipDeviceGetAttribute(&cus, hipDeviceAttributeMultiprocessorCount, dev) != hipSuccess) { fprintf(stderr, "kernel_launch: device query failed\n"); grid = -1; return; }
        if (hipFuncSetAttribute((const void*)mk_fwd, hipFuncAttributeMaxDynamicSharedMemorySize, LDS_BYTES) != hipSuccess) { fprintf(stderr, "kernel_launch: hipFuncSetAttribute failed\n"); grid = -1; return; }
        if (hipOccupancyMaxActiveBlocksPerMultiprocessor(&per_cu, (const void*)mk_fwd, NWAVES * 64, LDS_BYTES) != hipSuccess || per_cu < 1)
            fprintf(stderr, "kernel_launch: note: occupancy query reports %d workgroups per CU\n", per_cu);
        (void)hipGetLastError();
        grid = cus;
    }
    if (grid < 0) return;
    if (hipMemsetAsync((char*)d_ws + WS_CTL, 0, CTL_ZERO_BYTES, stream) != hipSuccess) { fprintf(stderr, "kernel_launch: memset failed\n"); return; }
    Params p{};
    for (int i = 0; i < 29; ++i) p.in[i] = (const float*)d_in[i];
    p.out = (float*)d_out; p.ws = (unsigned char*)d_ws;
#if MK_ONE_LAUNCH
    p.ph_lo = 0; p.ph_hi = NPH;
    hipLaunchKernelGGL(mk_fwd, dim3(grid), dim3(NWAVES * 64), LDS_BYTES, stream, p);
#else
    for (int li = 0; li < NPH; ++li) { p.ph_lo = li; p.ph_hi = li + 1; hipLaunchKernelGGL(mk_fwd, dim3(grid), dim3(NWAVES * 64), LDS_BYTES, stream, p); }
#endif
    const hipError_t le = hipPeekAtLastError();
    if (le != hipSuccess) fprintf(stderr, "kernel_launch: launch failed: %s\n", hipGetErrorName(le));
}
```

```cpp
#include <hip/hip_runtime.h>
#include <cstdio>
#include <cstdint>
#ifndef MK_ONE_LAUNCH
#define MK_ONE_LAUNCH 1
#endif
__device__ __forceinline__ int launder_v(int v) { asm volatile("" : "+v"(v)); return v; }
__device__ __forceinline__ int lane_id_fresh() { unsigned m = ~0u; asm volatile("" : "+s"(m)); return (int)__builtin_amdgcn_mbcnt_hi(m, __builtin_amdgcn_mbcnt_lo(m, 0u)); }
namespace pg8 {
#define PG8_LAS __attribute__((address_space(3)))
typedef unsigned short bf16_t;
typedef short bf16x8 __attribute__((ext_vector_type(8)));
typedef float f32x4 __attribute__((ext_vector_type(4)));
typedef unsigned u32x4 __attribute__((ext_vector_type(4)));
constexpr int BM = 256, BK = 64, HALF = 128, HTB = HALF * BK * 2  , STAGE_BYTES = 8 * HTB, NXCD = 8, WGM = 8;

__host__ __device__ __forceinline__ int lds_byte(int r, int c) { const int st = (r >> 4) * 2 + (c >> 5), rr = r & 15, cc = c & 31, ob = rr * 64 + cc * 2; return st * 1024 + (ob ^ (((ob >> 9) & 1) << 5)); }
__host__ __device__ __forceinline__ void stage_rc(int b, int& R, int& C) { const int st = b / 1024, sb = b % 1024, swz = sb ^ (((sb >> 9) & 1) << 5); R = (st >> 1) * 16 + swz / 64; C = (st & 1) * 32 + (swz % 64) / 2; }
__host__ __device__ __forceinline__ int perm32(int rho) { const int n = rho >> 4, i = rho & 15; return 8 * (i >> 2) + 4 * n + (i & 3); }

struct Unit { int pm, pn; };
struct Gemm { const bf16_t* A; const bf16_t* Bt; int M, N, K; };

struct StaticOrder {
    int nM, nN, nwg, G, c;
    __host__ __device__ void init(int M, int N, int G_, int c_) { nM = M / BM; nN = N / BM; nwg = nM * nN; G = G_; c = c_; }
    __host__ __device__ bool next(int i, Unit& u) const {
        const long L = (long)i * G + c; if (L >= nwg) return false;
        int wgid = (int)L; { const int q = nwg / NXCD, r = nwg % NXCD, xcd = wgid % NXCD, off = wgid / NXCD; wgid = (xcd < r ? xcd * (q + 1) : r * (q + 1) + (xcd - r) * q) + off; }
        const int nig = WGM * nN, gid = wgid / nig, fm = gid * WGM, gsz = (nM - fm) < WGM ? (nM - fm) : WGM;
        u.pm = fm + ((wgid % nig) % gsz); u.pn = (wgid % nig) / gsz; return true;
    }
    __device__ __forceinline__ void a_ready(const Unit&) const {}
    __device__ __forceinline__ void done(const Unit&) const {}
};

__device__ __forceinline__ unsigned cvt_pk_bf16(float lo, float hi) { unsigned r; asm volatile("v_cvt_pk_bf16_f32 %0, %1, %2" : "=v"(r) : "v"(lo), "v"(hi)); return r; }
typedef float f32x2 __attribute__((ext_vector_type(2)));
__device__ __forceinline__ f32x2 gelu_pk(f32x2 v) {
    const f32x2 av = __builtin_elementwise_abs(v), d = av * 0.2316418882f + 1.0f;
    f32x2 t; t.x = __builtin_amdgcn_rcpf(d.x); t.y = __builtin_amdgcn_rcpf(d.y);
    f32x2 q = t * 0.5307027145f + (-0.7265760135f); q = q * t + 0.7107068705f; q = q * t + (-0.142248368f); q = q * t + 0.127414796f; q = q * t;
    const f32x2 s = (v * v) * (-0.72134752044f);
    f32x2 e; e.x = __builtin_amdgcn_exp2f(s.x); e.y = __builtin_amdgcn_exp2f(s.y);
    const f32x2 m = v * (q * e), r = v - m;
    f32x2 o; o.x = v.x < 0.f ? m.x : r.x; o.y = v.y < 0.f ? m.y : r.y; return o;
}

template <int ACT  > struct EpiBf16 {
    static constexpr bool PERM = true, AFTER_DRAIN = false; static_assert(ACT == 0 || ACT == 1, "EpiBf16: ACT is 0 (none) or 1 (gelu_pk)");
    bf16_t* O; int ldc; const float* bias; int split_cols; size_t split_stride; float scale0;
    __device__ __forceinline__ void operator()(const f32x4 (&acc)[2][2][4][2], const Unit& u, int wr, int wc, int fr, int fq) const {
        const int row0 = u.pm * BM + wr * 64 + fr; int colt = u.pn * BM; bf16_t* base = O;
        float sc = 1.f; if (split_cols) { const int t = colt / split_cols; base += (size_t)t * split_stride; colt -= t * split_cols; if (t == 0) sc = scale0; }
        const int col0 = colt + wc * 32 + 8 * fq, bcol0 = u.pn * BM + wc * 32 + 8 * fq;
        f32x4 bv[2][2];
#pragma unroll
        for (int bj = 0; bj < 2; ++bj)
#pragma unroll
            for (int n = 0; n < 2; ++n) bv[bj][n] = bias ? *(const f32x4*)(bias + bcol0 + bj * HALF + 4 * n) : (f32x4){0.f, 0.f, 0.f, 0.f};
#pragma unroll
        for (int ai = 0; ai < 2; ++ai)
#pragma unroll
            for (int m = 0; m < 4; ++m) { bf16_t* rowp = base + (size_t)(row0 + ai * HALF + m * 16) * ldc + col0;
#pragma unroll
                for (int bj = 0; bj < 2; ++bj) { f32x4 v0 = acc[ai][bj][m][0] + bv[bj][0], v1 = acc[ai][bj][m][1] + bv[bj][1];
                    if (ACT == 1) { f32x2 a = gelu_pk((f32x2){v0[0], v0[1]}), b = gelu_pk((f32x2){v0[2], v0[3]}), c = gelu_pk((f32x2){v1[0], v1[1]}), d = gelu_pk((f32x2){v1[2], v1[3]});
                        v0 = (f32x4){a.x, a.y, b.x, b.y}; v1 = (f32x4){c.x, c.y, d.x, d.y}; }
                    v0 = v0 * sc; v1 = v1 * sc; u32x4 w; w.x = cvt_pk_bf16(v0[0], v0[1]); w.y = cvt_pk_bf16(v0[2], v0[3]); w.z = cvt_pk_bf16(v1[0], v1[1]); w.w = cvt_pk_bf16(v1[2], v1[3]);
                    *(u32x4*)(rowp + bj * HALF) = w; } }
    }
};
template <class Epi, class Sched, bool ALIGN_EPI = false, bool SP2 = false>
__device__ __forceinline__ void gemm_phase(PG8_LAS unsigned char* lds, const Gemm g, const Sched& S, const Epi& E, const int tid_in) {
    const int tid = launder_v(tid_in) & 511, wid = __builtin_amdgcn_readfirstlane(tid >> 6), lane = tid & 63, wr = wid >> 2, wc = wid & 3, fr = lane & 15, fq = lane >> 4;
    const int K = g.K, nt = K / BK;
    unsigned voffA[2], voffB[2];
#pragma unroll
    for (int i = 0; i < 2; ++i) { int R, C; stage_rc(tid * 16 + i * 8192, R, C); const int Rb = Epi::PERM ? ((R & ~31) + perm32(R & 31)) : R;
        voffA[i] = (unsigned)(R * K + C) * 2u; voffB[i] = (unsigned)(Rb * K + C) * 2u; }
    const size_t kstep = (size_t)(BK * 2);
    const size_t hstep = (size_t)HALF * K * 2;
    const size_t tstep = 2 * hstep;
    const unsigned ldsw = (unsigned)wid * 1024u;
    const int aoff = lds_byte(wr * 64 + fr, fq * 8), boff = lds_byte(wc * 32 + fr, fq * 8);
#define PG8_SA(b, h) (((b) * 2 + (h)) * HTB)
#define PG8_SB(b, h) ((4 + (b) * 2 + (h)) * HTB)
#define PG8_STAGE(bufoff, gbase, voff) do { _Pragma("unroll") for (int _i = 0; _i < 2; ++_i) \
        __builtin_amdgcn_global_load_lds((const unsigned*)((const char*)(gbase) + (voff)[_i]), (PG8_LAS unsigned*)(lds + (bufoff) + ldsw + _i * 8192), 16, 0, 0); } while (0)
#define PG8_LDA(dst, b, h) do { _Pragma("unroll") for (int m = 0; m < 4; ++m) _Pragma("unroll") for (int k = 0; k < 2; ++k) dst[m][k] = *(const PG8_LAS bf16x8*)(lds + PG8_SA(b, h) + aoff + m * 2048 + k * 1024); } while (0)
#define PG8_LDB(dst, b, h) do { _Pragma("unroll") for (int n = 0; n < 2; ++n) _Pragma("unroll") for (int k = 0; k < 2; ++k) dst[n][k] = *(const PG8_LAS bf16x8*)(lds + PG8_SB(b, h) + boff + n * 2048 + k * 1024); } while (0)
#define PG8_MMA(ai, bj, At, Bt) do { __builtin_amdgcn_s_setprio(1); _Pragma("unroll") for (int m = 0; m < 4; ++m) _Pragma("unroll") for (int n = 0; n < 2; ++n) _Pragma("unroll") for (int k = 0; k < 2; ++k) \
        acc[ai][bj][m][n] = __builtin_amdgcn_mfma_f32_16x16x32_bf16(Bt[n][k], At[m][k], acc[ai][bj][m][n], 0, 0, 0); __builtin_amdgcn_s_setprio(0); } while (0)
#define PG8_WAIT_V(n) asm volatile("s_waitcnt vmcnt(" #n ")" ::: "memory")
#define PG8_WAIT_L(n) asm volatile("s_waitcnt lgkmcnt(" #n ")" ::: "memory")
#define PG8_BAR __builtin_amdgcn_s_barrier()
#define PG8_SCHED __builtin_amdgcn_sched_barrier(0)
    Unit cur, nxt; int ui = 0;
    if (!S.next(0, cur)) return;
    f32x4 acc[2][2][4][2];
#pragma unroll
    for (int a = 0; a < 2; ++a)
#pragma unroll
        for (int b = 0; b < 2; ++b)
#pragma unroll
            for (int m = 0; m < 4; ++m)
#pragma unroll
                for (int n = 0; n < 2; ++n) acc[a][b][m][n] = (f32x4){0.f, 0.f, 0.f, 0.f};
    bf16x8 At[4][2], B0[2][2], B1[2][2];
    const char* cA = (const char*)g.A + (size_t)cur.pm * tstep; const char* cB = (const char*)g.Bt + (size_t)cur.pn * tstep;
    S.a_ready(cur);
    if constexpr (SP2) {
        PG8_STAGE(PG8_SB(0, 0), cB, voffB); PG8_STAGE(PG8_SB(0, 1), cB + hstep, voffB); PG8_STAGE(PG8_SA(0, 0), cA, voffA); PG8_STAGE(PG8_SA(0, 1), cA + hstep, voffA);
        if (wr == 1) PG8_BAR;
        PG8_WAIT_V(2); PG8_BAR;
        PG8_STAGE(PG8_SB(1, 0), cB + kstep, voffB); PG8_STAGE(PG8_SA(1, 0), cA + kstep, voffA); PG8_STAGE(PG8_SB(1, 1), cB + hstep + kstep, voffB);
        PG8_WAIT_V(6); PG8_BAR;
    } else {
        PG8_STAGE(PG8_SB(0, 0), cB, voffB); PG8_STAGE(PG8_SA(0, 0), cA, voffA); PG8_STAGE(PG8_SB(0, 1), cB + hstep, voffB); PG8_STAGE(PG8_SA(0, 1), cA + hstep, voffA);
        if (wr == 1) PG8_BAR;
        PG8_WAIT_V(4); PG8_BAR;
        PG8_STAGE(PG8_SB(1, 0), cB + kstep, voffB); PG8_STAGE(PG8_SA(1, 0), cA + kstep, voffA); PG8_STAGE(PG8_SB(1, 1), cB + hstep + kstep, voffB);
        PG8_WAIT_V(6); PG8_BAR;
    }
    for (;;) {
        const bool has_next = S.next(ui + 1, nxt);
        const char* nA = has_next ? (const char*)g.A + (size_t)nxt.pm * tstep : cA; const char* nB = has_next ? (const char*)g.Bt + (size_t)nxt.pn * tstep : cB;
        for (int t = 0; t < nt; t += 2) {
            const bool last = (t == nt - 2);
            const char* a1 = cA + (size_t)(t + 1) * kstep;
            const char* a2 = last ? nA : cA + (size_t)(t + 2) * kstep; const char* b2 = last ? nB : cB + (size_t)(t + 2) * kstep;
            const char* a3 = a2 + kstep; const char* b3 = b2 + kstep;
            if (last && has_next) S.a_ready(nxt);
            if constexpr (SP2) {
            PG8_LDB(B0, 0, 0); PG8_LDB(B1, 0, 1); PG8_SCHED; PG8_LDA(At, 0, 0); PG8_STAGE(PG8_SA(1, 1), a1 + hstep, voffA);
            PG8_WAIT_V(8); PG8_WAIT_L(0); PG8_BAR; PG8_MMA(0, 0, At, B0); PG8_MMA(0, 1, At, B1); PG8_BAR; PG8_SCHED;
            PG8_LDA(At, 0, 1); PG8_STAGE(PG8_SB(0, 0), b2, voffB); PG8_STAGE(PG8_SB(0, 1), b2 + hstep, voffB); PG8_STAGE(PG8_SA(0, 0), a2, voffA);
            PG8_WAIT_V(8); PG8_WAIT_L(0); PG8_BAR; PG8_MMA(1, 0, At, B0); PG8_MMA(1, 1, At, B1); PG8_BAR; PG8_SCHED;
            PG8_LDB(B0, 1, 0); PG8_LDB(B1, 1, 1); PG8_SCHED; PG8_LDA(At, 1, 0); PG8_STAGE(PG8_SA(0, 1), a2 + hstep, voffA);
            PG8_WAIT_V(8); PG8_WAIT_L(0); PG8_BAR; PG8_MMA(0, 0, At, B0); PG8_MMA(0, 1, At, B1); PG8_BAR; PG8_SCHED;
            PG8_LDA(At, 1, 1); PG8_STAGE(PG8_SB(1, 0), b3, voffB); PG8_STAGE(PG8_SB(1, 1), b3 + hstep, voffB); PG8_STAGE(PG8_SA(1, 0), a3, voffA);
            PG8_WAIT_V(8); PG8_WAIT_L(0); PG8_BAR; PG8_MMA(1, 0, At, B0); PG8_MMA(1, 1, At, B1); PG8_BAR; PG8_SCHED;
            } else {
            PG8_LDB(B0, 0, 0); PG8_SCHED; PG8_LDA(At, 0, 0); PG8_STAGE(PG8_SA(1, 1), a1 + hstep, voffA);
            PG8_WAIT_L(8); PG8_BAR; PG8_WAIT_L(0); PG8_MMA(0, 0, At, B0); PG8_BAR; PG8_SCHED;
            PG8_LDB(B1, 0, 1); PG8_STAGE(PG8_SB(0, 0), b2, voffB);
            PG8_BAR; PG8_WAIT_L(0); PG8_MMA(0, 1, At, B1); PG8_BAR;
            PG8_LDA(At, 0, 1); PG8_STAGE(PG8_SA(0, 0), a2, voffA);
            PG8_BAR; PG8_WAIT_L(0); PG8_MMA(1, 0, At, B0); PG8_BAR; PG8_SCHED;
            PG8_STAGE(PG8_SB(0, 1), b2 + hstep, voffB);
            PG8_WAIT_V(6); PG8_BAR; PG8_MMA(1, 1, At, B1); PG8_BAR;
            PG8_LDB(B0, 1, 0); PG8_SCHED; PG8_LDA(At, 1, 0); PG8_STAGE(PG8_SA(0, 1), a2 + hstep, voffA);
            PG8_WAIT_L(8); PG8_BAR; PG8_WAIT_L(0); PG8_MMA(0, 0, At, B0); PG8_BAR; PG8_SCHED;
            PG8_LDB(B1, 1, 1); PG8_STAGE(PG8_SB(1, 0), b3, voffB);
            PG8_BAR; PG8_WAIT_L(0); PG8_MMA(0, 1, At, B1); PG8_BAR;
            PG8_LDA(At, 1, 1); PG8_STAGE(PG8_SA(1, 0), a3, voffA);
            PG8_BAR; PG8_WAIT_L(0); PG8_MMA(1, 0, At, B0); PG8_BAR; PG8_SCHED;
            PG8_STAGE(PG8_SB(1, 1), b3 + hstep, voffB);
            PG8_WAIT_V(6); PG8_BAR; PG8_MMA(1, 1, At, B1); PG8_BAR;
            }
        }
        if constexpr (ALIGN_EPI) { if (wr == 0) PG8_BAR; }
        if constexpr (!Epi::AFTER_DRAIN) { E(acc, cur, wr, wc, fr, fq); S.done(cur); }
        if (!has_next) break;
#pragma unroll
        for (int a = 0; a < 2; ++a)
#pragma unroll
            for (int b = 0; b < 2; ++b)
#pragma unroll
                for (int m = 0; m < 4; ++m)
#pragma unroll
                    for (int n = 0; n < 2; ++n) acc[a][b][m][n] = (f32x4){0.f, 0.f, 0.f, 0.f};
        cur = nxt; cA = nA; cB = nB; ++ui;
        if constexpr (ALIGN_EPI) { if (wr == 1) PG8_BAR; }
    }
    PG8_WAIT_V(0);
    if constexpr (!ALIGN_EPI) { if (wr == 0) PG8_BAR; }
    PG8_BAR;
    if constexpr (Epi::AFTER_DRAIN) { E.fused(acc, cur, wr, wc, fr, fq, lds, wid, lane); S.done(cur); }
#undef PG8_SA
#undef PG8_SB
#undef PG8_STAGE
#undef PG8_LDA
#undef PG8_LDB
#undef PG8_MMA
#undef PG8_WAIT_V
#undef PG8_WAIT_L
#undef PG8_BAR
#undef PG8_SCHED
}
}

namespace pg8 {
__device__ __forceinline__ float gelu_tanh(float x) {
    const float t = x * (1.5957691216057308f + 0.07135481627f * x * x);
    const float e = __builtin_amdgcn_exp2f(-1.4426950408889634f * t);
    return x * __builtin_amdgcn_rcpf(1.0f + e);
}
template <int ACT> struct EpiT {
    static constexpr bool PERM = true, AFTER_DRAIN = false;
    bf16_t* O; int ldc;
    __device__ __forceinline__ void operator()(const f32x4 (&acc)[2][2][4][2], const Unit& u, int wr, int wc, int fr, int fq) const {
        const int row0 = u.pm * BM + wr * 64 + fr; const int col0 = u.pn * BM + wc * 32 + 8 * fq;
#pragma unroll
        for (int ai = 0; ai < 2; ++ai)
#pragma unroll
            for (int m = 0; m < 4; ++m) { bf16_t* rowp = O + (size_t)(row0 + ai * HALF + m * 16) * ldc + col0;
#pragma unroll
                for (int bj = 0; bj < 2; ++bj) { f32x4 v0 = acc[ai][bj][m][0], v1 = acc[ai][bj][m][1];
                    if (ACT == 2) { v0 = (f32x4){gelu_tanh(v0[0]), gelu_tanh(v0[1]), gelu_tanh(v0[2]), gelu_tanh(v0[3])}; v1 = (f32x4){gelu_tanh(v1[0]), gelu_tanh(v1[1]), gelu_tanh(v1[2]), gelu_tanh(v1[3])}; }
                    u32x4 w; w.x = cvt_pk_bf16(v0[0], v0[1]); w.y = cvt_pk_bf16(v0[2], v0[3]); w.z = cvt_pk_bf16(v1[0], v1[1]); w.w = cvt_pk_bf16(v1[2], v1[3]);
                    *(u32x4*)(rowp + bj * HALF) = w; } }
    }
};
struct EpiR {
    static constexpr bool PERM = true, AFTER_DRAIN = false;
    bf16_t* O; int ldc; int act; int rope; const float* ropet;
    __device__ __forceinline__ void operator()(const f32x4 (&acc)[2][2][4][2], const Unit& u, int wr, int wc, int fr, int fq) const {
        const int row0 = u.pm * BM + wr * 64 + fr; const int col0 = u.pn * BM + wc * 32 + 8 * fq;
        const bool rrows = rope != 0 && u.pm < 64;
#pragma unroll
        for (int ai = 0; ai < 2; ++ai)
#pragma unroll
            for (int m = 0; m < 4; ++m) { const int grow = row0 + ai * HALF + m * 16; bf16_t* rowp = O + (size_t)grow * ldc + col0;
#pragma unroll
                for (int bj = 0; bj < 2; ++bj) { f32x4 v0 = acc[ai][bj][m][0], v1 = acc[ai][bj][m][1];
                    if (act) { v0 = (f32x4){gelu_tanh(v0[0]), gelu_tanh(v0[1]), gelu_tanh(v0[2]), gelu_tanh(v0[3])}; v1 = (f32x4){gelu_tanh(v1[0]), gelu_tanh(v1[1]), gelu_tanh(v1[2]), gelu_tanh(v1[3])}; }
                    if (rrows) { const int blk = u.pn * 8 + bj * 4 + wc; const int b6 = blk % 6; const bool on = rope == 1 ? (blk < 128) : (b6 >= 4); const int half = rope == 1 ? (blk & 1) : (b6 - 4);
                        if (on) { const int t = grow & 8191; const int pos = half ? (t & 63) : (t >> 6);
                            const float* cp = ropet + pos * 16 + 8 * (fq & 1); const f32x4 c0 = *(const f32x4*)cp, c1 = *(const f32x4*)(cp + 4), s0 = *(const f32x4*)(cp + 2048), s1 = *(const f32x4*)(cp + 2052);
                            f32x4 p0, p1;
#pragma unroll
                            for (int i = 0; i < 4; ++i) { const float a_ = v0[i], b_ = v1[i];
                                const auto r0 = __builtin_amdgcn_permlane32_swap(__float_as_uint(a_), __float_as_uint(a_), false, false);
                                const auto r1 = __builtin_amdgcn_permlane32_swap(__float_as_uint(b_), __float_as_uint(b_), false, false);
                                const unsigned x0_ = (fq & 2) ? r0[0] : r0[1], x1_ = (fq & 2) ? r1[0] : r1[1]; p0[i] = __uint_as_float(x0_); p1[i] = __uint_as_float(x1_); }
                            if (fq & 2) { v0 = p0 * s0 + v0 * c0; v1 = p1 * s1 + v1 * c1; } else { v0 = v0 * c0 - p0 * s0; v1 = v1 * c1 - p1 * s1; } } }
                    u32x4 w; w.x = cvt_pk_bf16(v0[0], v0[1]); w.y = cvt_pk_bf16(v0[2], v0[3]); w.z = cvt_pk_bf16(v1[0], v1[1]); w.w = cvt_pk_bf16(v1[2], v1[3]);
                    *(u32x4*)(rowp + bj * HALF) = w; } }
    }
};
}

constexpr int DM = 2048, NBATCH = 2, SEQ = 8192, CTXL = 256;
constexpr int ML = NBATCH * SEQ;
constexpr int MC = NBATCH * CTXL;
constexpr int MT = ML + MC;
constexpr int NLAYER = 4;
constexpr float ALPHA = 1.6817928305074290f, LN_EPS = 1e-6f;
constexpr int NWAVES = 8;
constexpr float U_SCALE = 64.0f, V_SCALE = 4.0f;
constexpr int PROW = 1536;
constexpr int PREC = 2 * PROW;
constexpr int NPH = 35;

constexpr size_t MiB = 1ull << 20;
constexpr size_t WS_CTL = 0, CTL_ZERO_BYTES = 1 * MiB;
constexpr int    CW_BAR = 4096;
constexpr size_t WS_MOD = 128 * 1024;
constexpr size_t WS_VST = 1 * MiB;
constexpr size_t WS_ROPE = 1 * MiB + 160 * 1024;
constexpr size_t WS_MODP = 1 * MiB + 256 * 1024;
constexpr size_t WS_GMWIN = 6 * MiB;
constexpr size_t WS_GMWOUT = WS_GMWIN + 32 * MiB;
constexpr size_t WS_GMWS = WS_GMWOUT + 16 * MiB;
constexpr size_t WS_PWQ = WS_GMWS + 1 * MiB;
constexpr size_t WS_PK1 = WS_PWQ + 32 * MiB;
constexpr size_t WS_PK2 = WS_PK1 + 512 * 1024;
constexpr size_t WS_MLAIN = WS_PK1 + 1 * MiB;
constexpr size_t WS_MLAUQ = WS_MLAIN + 5 * MiB;
constexpr size_t WS_MLAUKV = WS_MLAUQ + 3 * MiB;
constexpr size_t WS_MLAOUT = WS_MLAUKV + 4 * MiB;
constexpr size_t WS_DAIN = WS_MLAOUT + 8 * MiB;
constexpr size_t WS_DAOUT = WS_DAIN + 24 * MiB;
constexpr size_t WS_PU = WS_DAOUT + 8 * MiB;
constexpr size_t WS_PV = WS_PU + 96 * MiB;
constexpr size_t WS_X = WS_PV + 96 * MiB;
constexpr size_t WS_H = WS_X + 66 * MiB;
constexpr size_t WS_G = WS_H + 66 * MiB;
constexpr size_t WS_Y = WS_G + 66 * MiB;
constexpr size_t WS_QP = WS_Y + 66 * MiB;
constexpr size_t WS_Z = WS_QP + 66 * MiB;
constexpr size_t WS_C = WS_Z + 198 * MiB;
constexpr size_t WS_CQN = WS_C + 42 * MiB;
constexpr size_t WS_CKVN = WS_CQN + 17 * MiB;
constexpr size_t WS_KR = WS_CKVN + 17 * MiB;
constexpr size_t WS_QM = WS_KR + 3 * MiB;
constexpr size_t WS_KV = WS_QM + 99 * MiB;
constexpr size_t WS_ROUTE = WS_KV + 132 * MiB;
constexpr size_t WS_END = WS_ROUTE + 17 * MiB;
static_assert((size_t)MT * DM * 2 == 66 * MiB, "row buffer size");

constexpr int RING_BYTES = 155648, MISC_OFF = RING_BYTES + 320, LDS_BYTES = 159744;

#define GAS __attribute__((address_space(1)))
#define LAS __attribute__((address_space(3)))
typedef unsigned short bf16;
typedef unsigned u32x4 __attribute__((ext_vector_type(4)));
typedef unsigned u32x2 __attribute__((ext_vector_type(2)));
typedef float f32x4 __attribute__((ext_vector_type(4)));
typedef float f32x16 __attribute__((ext_vector_type(16)));
typedef short bf16x8 __attribute__((ext_vector_type(8)));
typedef short s16x4 __attribute__((ext_vector_type(4)));
#define LDS_WAIT() asm volatile("s_waitcnt lgkmcnt(0)" ::: "memory")

__device__ __forceinline__ unsigned cvtpk(float lo, float hi) { unsigned r; asm("v_cvt_pk_bf16_f32 %0, %1, %2" : "=v"(r) : "v"(lo), "v"(hi)); return r; }
__device__ __forceinline__ float bflo(unsigned w) { return __uint_as_float(w << 16); }
__device__ __forceinline__ float bfhi(unsigned w) { return __uint_as_float(w & 0xffff0000u); }
__device__ __forceinline__ float bf1(bf16 b) { return __uint_as_float((unsigned)b << 16); }
__device__ __forceinline__ bf16 tobf1(float f) { return (bf16)(cvtpk(f, 0.f) & 0xffffu); }
#define DPP_F(v, ctrl) __int_as_float(__builtin_amdgcn_mov_dpp(__float_as_int(v), (ctrl), 0xF, 0xF, true))
__device__ __forceinline__ float row_sum16(float v) { v += DPP_F(v, 0xB1); v += DPP_F(v, 0x4E); v += DPP_F(v, 0x141); v += DPP_F(v, 0x140); return v; }
__device__ __forceinline__ float sum_xor16(float v) { const auto r = __builtin_amdgcn_permlane16_swap(__float_as_uint(v), __float_as_uint(v), false, false); return __uint_as_float(r[0]) + __uint_as_float(r[1]); }
__device__ __forceinline__ float sum_xor32(float v) { const auto r = __builtin_amdgcn_permlane32_swap(__float_as_uint(v), __float_as_uint(v), false, false); return __uint_as_float(r[0]) + __uint_as_float(r[1]); }
__device__ __forceinline__ float wave_sum(float v) { return sum_xor32(sum_xor16(row_sum16(v))); }
__device__ __forceinline__ float half_sum32(float v) { return sum_xor16(row_sum16(v)); }
__device__ __forceinline__ float lane_xor16(float v, int lane) { const auto r = __builtin_amdgcn_permlane16_swap(__float_as_uint(v), __float_as_uint(v), false, false); return __uint_as_float((lane & 16) ? r[0] : r[1]); }
__device__ __forceinline__ unsigned lane_xor32(unsigned v, int lane) { const auto r = __builtin_amdgcn_permlane32_swap(v, v, false, false); return (lane & 32) ? r[0] : r[1]; }
__device__ __forceinline__ float gelu_tanh(float x) { return pg8::gelu_tanh(x); }

__device__ __forceinline__ void load_row_bf16(const bf16* row, int lane, float (&v)[32]) {
#pragma unroll
    for (int j = 0; j < 4; ++j) { const u32x4 w = ((const u32x4*)row)[64 * j + lane];
        v[8 * j + 0] = bflo(w.x); v[8 * j + 1] = bfhi(w.x); v[8 * j + 2] = bflo(w.y); v[8 * j + 3] = bfhi(w.y);
        v[8 * j + 4] = bflo(w.z); v[8 * j + 5] = bfhi(w.z); v[8 * j + 6] = bflo(w.w); v[8 * j + 7] = bfhi(w.w); }
}
__device__ __forceinline__ void store_row_bf16(bf16* row, int lane, const float (&v)[32]) {
#pragma unroll
    for (int j = 0; j < 4; ++j) { u32x4 w; w.x = cvtpk(v[8 * j + 0], v[8 * j + 1]); w.y = cvtpk(v[8 * j + 2], v[8 * j + 3]); w.z = cvtpk(v[8 * j + 4], v[8 * j + 5]); w.w = cvtpk(v[8 * j + 6], v[8 * j + 7]);
        ((u32x4*)row)[64 * j + lane] = w; }
}
__device__ __forceinline__ void load_row_f32(const float* row, int lane, float (&v)[32]) {
#pragma unroll
    for (int j = 0; j < 4; ++j) { const f32x4 a = ((const f32x4*)row)[128 * j + 2 * lane], b = ((const f32x4*)row)[128 * j + 2 * lane + 1];
        v[8 * j + 0] = a.x; v[8 * j + 1] = a.y; v[8 * j + 2] = a.z; v[8 * j + 3] = a.w; v[8 * j + 4] = b.x; v[8 * j + 5] = b.y; v[8 * j + 6] = b.z; v[8 * j + 7] = b.w; }
}
__device__ __forceinline__ void store_row_f32(float* row, int lane, const float (&v)[32]) {
#pragma unroll
    for (int j = 0; j < 4; ++j) { ((f32x4*)row)[128 * j + 2 * lane] = (f32x4){v[8 * j + 0], v[8 * j + 1], v[8 * j + 2], v[8 * j + 3]};
        ((f32x4*)row)[128 * j + 2 * lane + 1] = (f32x4){v[8 * j + 4], v[8 * j + 5], v[8 * j + 6], v[8 * j + 7]}; }
}
__device__ __forceinline__ void load_row_bf16_b(const bf16* row, int lane, float (&v)[32]) {
#pragma unroll
    for (int j = 0; j < 4; ++j) { const u32x4 w = ((const u32x4*)row)[4 * lane + j];
        v[8 * j + 0] = bflo(w.x); v[8 * j + 1] = bfhi(w.x); v[8 * j + 2] = bflo(w.y); v[8 * j + 3] = bfhi(w.y);
        v[8 * j + 4] = bflo(w.z); v[8 * j + 5] = bfhi(w.z); v[8 * j + 6] = bflo(w.w); v[8 * j + 7] = bfhi(w.w); }
}
__device__ __forceinline__ void store_row_bf16_b(bf16* row, int lane, const float (&v)[32]) {
#pragma unroll
    for (int j = 0; j < 4; ++j) { u32x4 w; w.x = cvtpk(v[8 * j + 0], v[8 * j + 1]); w.y = cvtpk(v[8 * j + 2], v[8 * j + 3]); w.z = cvtpk(v[8 * j + 4], v[8 * j + 5]); w.w = cvtpk(v[8 * j + 6], v[8 * j + 7]);
        ((u32x4*)row)[4 * lane + j] = w; }
}
__device__ __forceinline__ void load_row_f32_b(const float* row, int lane, float (&v)[32]) {
#pragma unroll
    for (int q = 0; q < 8; ++q) { const f32x4 a = ((const f32x4*)row)[8 * lane + q];
        v[4 * q + 0] = a.x; v[4 * q + 1] = a.y; v[4 * q + 2] = a.z; v[4 * q + 3] = a.w; }
}
__device__ __forceinline__ void store_row_f32_b(float* row, int lane, const float (&v)[32]) {
#pragma unroll
    for (int q = 0; q < 8; ++q) ((f32x4*)row)[8 * lane + q] = (f32x4){v[4 * q + 0], v[4 * q + 1], v[4 * q + 2], v[4 * q + 3]};
}
__device__ __forceinline__ void ln_stats(const float (&v)[32], float& mean, float& rstd) {
    float s = 0.f;
#pragma unroll
    for (int i = 0; i < 32; ++i) s += v[i];
    mean = wave_sum(s) * (1.0f / DM);
    float q = 0.f;
#pragma unroll
    for (int i = 0; i < 32; ++i) { const float d = v[i] - mean; q += d * d; }
    rstd = 1.0f / sqrtf(wave_sum(q) * (1.0f / DM) + LN_EPS);
}
template <bool LAYB>
__device__ __forceinline__ void finish_row(float (&z)[32], const float* lng, const float* lnb, bf16* Xrow, const float* sh, const float* sc, bf16* Hrow, float* Orow, int lane) {
    float mean, rstd; ln_stats(z, mean, rstd);
    { float g[32], b[32]; if (LAYB) { load_row_f32_b(lng, lane, g); load_row_f32_b(lnb, lane, b); } else { load_row_f32(lng, lane, g); load_row_f32(lnb, lane, b); }
#pragma unroll
      for (int i = 0; i < 32; ++i) z[i] = (z[i] - mean) * rstd * g[i] + b[i]; }
    if (Xrow) { if (LAYB) store_row_bf16_b(Xrow, lane, z); else store_row_bf16(Xrow, lane, z); }
    if (Orow) { if (LAYB) store_row_f32_b(Orow, lane, z); else store_row_f32(Orow, lane, z); }
    if (Hrow) {
        ln_stats(z, mean, rstd);
        float a[32], s[32]; if (LAYB) { load_row_f32_b(sc, lane, a); load_row_f32_b(sh, lane, s); } else { load_row_f32(sc, lane, a); load_row_f32(sh, lane, s); }
#pragma unroll
        for (int i = 0; i < 32; ++i) a[i] = (z[i] - mean) * rstd * (1.0f + a[i]) + s[i];
        if (LAYB) store_row_bf16_b(Hrow, lane, a); else store_row_bf16(Hrow, lane, a);
    }
}
__device__ __forceinline__ int row_slot(int row) { return row < ML ? (row >> 13) : 2; }

__device__ __forceinline__ unsigned f2bf_rne(float f) { unsigned u = __float_as_uint(f); return (u + 0x7fffu + ((u >> 16) & 1u)) >> 16; }
__device__ __forceinline__ unsigned pk2(float lo, float hi) { return f2bf_rne(lo) | (f2bf_rne(hi) << 16); }
__device__ __forceinline__ void p0_transpose_item(const float* W, int K, int N, bf16* WT, LAS float* scr, int item, int lane) {
    const int nblk = N / 32, kb = item / nblk, nb = item % nblk, k0 = 64 * kb, n0 = 32 * nb;
    f32x4 t[8];
#pragma unroll
    for (int i = 0; i < 8; ++i) t[i] = *(const f32x4*)(W + (size_t)(k0 + 8 * i + (lane >> 3)) * N + n0 + 4 * (lane & 7));
#pragma unroll
    for (int i = 0; i < 8; ++i) { LAS float* d = scr + (8 * i + (lane >> 3)) * 33 + 4 * (lane & 7); d[0] = t[i].x; d[1] = t[i].y; d[2] = t[i].z; d[3] = t[i].w; }
    LDS_WAIT(); asm volatile("" ::: "memory");
    const int c = lane & 7;
#pragma unroll
    for (int j = 0; j < 4; ++j) { const int n = (lane >> 3) + 8 * j; const LAS float* s = scr + (8 * c) * 33 + n;
        u32x4 o; o.x = pk2(s[0 * 33], s[1 * 33]); o.y = pk2(s[2 * 33], s[3 * 33]); o.z = pk2(s[4 * 33], s[5 * 33]); o.w = pk2(s[6 * 33], s[7 * 33]);
        *(u32x4*)(WT + (size_t)(n0 + n) * K + k0 + 8 * c) = o; }
    LDS_WAIT(); asm volatile("" ::: "memory");
}
__device__ __forceinline__ void cvt_range(const float* src, bf16* dst, size_t n8, size_t gtid, size_t gthreads) {
#pragma unroll 4
    for (size_t i = gtid; i < n8; i += gthreads) { const f32x4 a = ((const f32x4*)src)[2 * i], b = ((const f32x4*)src)[2 * i + 1];
        u32x4 w; w.x = cvtpk(a.x, a.y); w.y = cvtpk(a.z, a.w); w.z = cvtpk(b.x, b.y); w.w = cvtpk(b.z, b.w); ((u32x4*)dst)[i] = w; }
}
__device__ __forceinline__ unsigned enc_e2m3(float x) {
    const unsigned sgn = (__float_as_uint(x) >> 26) & 32u;
    const float ax = fminf(fabsf(x), 7.5f);
    unsigned u = __float_as_uint(ax); u += 0x7FFFFu + ((u >> 20) & 1u);
    const unsigned cn = (u >> 20) - ((127u - 1u) << 3);
    const unsigned cs = (unsigned)__builtin_rintf(ax * 8.0f);
    return sgn | (ax < 1.0f ? cs : cn);
}
typedef float f32x16v __attribute__((ext_vector_type(16)));
typedef float f32x32v __attribute__((ext_vector_type(32)));
typedef unsigned u32x6v __attribute__((ext_vector_type(6)));
__device__ __forceinline__ u32x6v pack_fp6_32(const float (&e)[32], bool interleaved) {
    f32x16v s0, s1;
    if (interleaved) {
#pragma unroll
        for (int i = 0; i < 16; ++i) { s0[i] = e[2 * i]; s1[i] = e[2 * i + 1]; }
    } else {
#pragma unroll
        for (int i = 0; i < 16; ++i) { s0[i] = e[i]; s1[i] = e[16 + i]; }
    }
    return __builtin_amdgcn_cvt_scalef32_2xpk16_fp6_f32(s0, s1, 1.0f);
}
__device__ __forceinline__ void cvt_table_fp6(const float* src, unsigned char* dst, int nrows, float scale, LAS float* scr  , int lane, int gw, int NGW, const int isv) {
    bool interleaved;
    {
        float t[32];
#pragma unroll
        for (int k = 0; k < 32; ++k) t[k] = k < 16 ? 0.125f * k : (k < 24 ? 2.0f + 0.25f * (k - 16) : 4.0f + 0.5f * (k - 24));
        float tt[32];
#pragma unroll
        for (int k = 0; k < 32; ++k) { tt[k] = t[k]; asm volatile("" : "+v"(tt[k])); }
        const u32x6v p = pack_fp6_32(tt, true);
        const f32x32v o = __builtin_amdgcn_cvt_scalef32_pk32_f32_fp6(p, 1.0f);
        interleaved = (o[1] == t[1]) && (o[2] == t[2]) && (o[17] == t[17]);
        interleaved = __all(interleaved);
    }
    for (int row = gw; row < nrows; row += NGW) {
        const f32x4* s4 = (const f32x4*)(src + (size_t)row * 2048);
#pragma unroll
        for (int q = 0; q < 8; ++q) { const int s = 64 * q + lane; const f32x4 a = s4[s] * scale; *(LAS f32x4*)(scr + 4 * (s ^ ((s >> 4) & 7))) = a; }
        float e[32];
#pragma unroll
        for (int j = 0; j < 8; ++j) { const int s = 8 * lane + j; const f32x4 a = *(const LAS f32x4*)(scr + 4 * (s ^ ((s >> 4) & 7)));
            e[4 * j + 0] = __builtin_amdgcn_fmed3f(a.x, -7.5f, 7.5f); e[4 * j + 1] = __builtin_amdgcn_fmed3f(a.y, -7.5f, 7.5f); e[4 * j + 2] = __builtin_amdgcn_fmed3f(a.z, -7.5f, 7.5f); e[4 * j + 3] = __builtin_amdgcn_fmed3f(a.w, -7.5f, 7.5f); }
        const u32x6v p = pack_fp6_32(e, interleaved);
        unsigned char* rowp = dst + (size_t)row * PREC;
        *(u32x4*)(rowp + 1024 * isv + 16 * lane) = (u32x4){p[0], p[1], p[2], p[3]}; *(u32x2*)(rowp + 2048 + 512 * isv + 8 * lane) = (u32x2){p[4], p[5]};
    }
}
__device__ __forceinline__ float silu(float x) { return x / (1.0f + __expf(-x)); }

struct Params { const float* in[29]; float* out; unsigned char* ws; int ph_lo, ph_hi; };
typedef const __attribute__((address_space(4))) Params* CP;

__device__ __forceinline__ void p0_prologue(CP P, LAS unsigned char* lds, int tid, int lane, int wid, int gw, int NGW) {
    unsigned char* ws = P->ws;
    LAS float* scr = (LAS float*)(lds + wid * 16384);
    {
        constexpr int I_GMIN = (2048 / 64) * (4096 / 32), I_SQ = (2048 / 64) * (2048 / 32), I_MIN = (2048 / 64) * (1088 / 32), I_UQ = (512 / 64) * (3072 / 32), I_UKV = (512 / 64) * (4096 / 32), I_DIN = (2048 / 64) * (6144 / 32);
        constexpr int NIT = 2 * I_GMIN + 2 * I_SQ + 4 * I_SQ + I_MIN + I_UQ + I_UKV + I_SQ + I_DIN + I_SQ;
        for (int it = gw; it < NIT; it += NGW) {
            int r = it;
            if (r < 2 * I_GMIN) { const int j = r / I_GMIN; p0_transpose_item(P->in[13] + (size_t)j * 2048 * 4096, 2048, 4096, (bf16*)(ws + WS_GMWIN) + (size_t)j * 4096 * 2048, scr, r % I_GMIN, lane); continue; } r -= 2 * I_GMIN;
            if (r < 2 * I_SQ) { const int j = r / I_SQ; p0_transpose_item(P->in[18] + (size_t)j * 2048 * 2048, 2048, 2048, (bf16*)(ws + WS_GMWOUT) + (size_t)j * 2048 * 2048, scr, r % I_SQ, lane); continue; } r -= 2 * I_SQ;
            if (r < 4 * I_SQ) { const int j = r / I_SQ; p0_transpose_item(P->in[8] + (size_t)j * 2048 * 2048, 2048, 2048, (bf16*)(ws + WS_PWQ) + (size_t)j * 2048 * 2048, scr, r % I_SQ, lane); continue; } r -= 4 * I_SQ;
            if (r < I_MIN) { p0_transpose_item(P->in[19], 2048, 1088, (bf16*)(ws + WS_MLAIN), scr, r, lane); continue; } r -= I_MIN;
            if (r < I_UQ) { p0_transpose_item(P->in[22], 512, 3072, (bf16*)(ws + WS_MLAUQ), scr, r, lane); continue; } r -= I_UQ;
            if (r < I_UKV) { p0_transpose_item(P->in[23], 512, 4096, (bf16*)(ws + WS_MLAUKV), scr, r, lane); continue; } r -= I_UKV;
            if (r < I_SQ) { p0_transpose_item(P->in[24], 2048, 2048, (bf16*)(ws + WS_MLAOUT), scr, r, lane); continue; } r -= I_SQ;
            if (r < I_DIN) { p0_transpose_item(P->in[25], 2048, 6144, (bf16*)(ws + WS_DAIN), scr, r, lane); continue; } r -= I_DIN;
            p0_transpose_item(P->in[28], 2048, 2048, (bf16*)(ws + WS_DAOUT), scr, r, lane);
        }
    }
    const size_t gtid = (size_t)gw * 64 + lane, gthreads = (size_t)NGW * 64;
    { u32x4* z = (u32x4*)((bf16*)(ws + WS_MLAIN) + (size_t)1088 * 2048); const size_t n = (size_t)192 * 2048 / 8;
      for (size_t i = gtid; i < n; i += gthreads) z[i] = (u32x4){0u, 0u, 0u, 0u}; }
    cvt_range(P->in[16], (bf16*)(ws + WS_GMWS), (size_t)2 * 16 * 128 * 128 / 8, gtid, gthreads);
    cvt_range(P->in[9], (bf16*)(ws + WS_PK1), (size_t)4 * 128 * 128 / 8, gtid, gthreads);
    cvt_range(P->in[10], (bf16*)(ws + WS_PK2), (size_t)4 * 128 * 128 / 8, gtid, gthreads);
    cvt_table_fp6(P->in[11], ws + WS_PU, 16384, U_SCALE, scr, lane, gw, NGW, 0);
    cvt_table_fp6(P->in[12], ws + WS_PU, 16384, V_SCALE, scr, lane, gw, NGW, 1);
    if (gtid < 2048) { const int pos = (int)gtid >> 4, f = (int)gtid & 15; const float inv = powf(10000.0f, -(float)f * (1.0f / 16.0f)); float sn, cs; sincosf((float)pos * inv, &sn, &cs);
        float* rt = (float*)(ws + WS_ROPE); rt[gtid] = cs; rt[2048 + gtid] = sn; }
    {
        const float* cv = P->in[1]; const float* cc = P->in[3]; const float* mw = P->in[4]; float* PART = (float*)(ws + WS_MODP);
        for (int item = gw; item < 4 * 192 * 8; item += NGW) {
            const int ks = item & 7, r = item >> 3, L = r / 192, n = (r % 192) * 64 + lane;
            const float* W = mw + (size_t)L * 2048 * 12288 + (size_t)(ks * 256) * 12288 + n;
            float a0 = 0.f, a1 = 0.f, a2 = 0.f;
#pragma unroll 32
            for (int k = 0; k < 256; ++k) { const int kk = ks * 256 + k; const float s0 = silu(cv[kk]), s1 = silu(cv[2048 + kk]), s2 = silu(cc[kk]);
                const float w = W[(size_t)k * 12288]; a0 += s0 * w; a1 += s1 * w; a2 += s2 * w; }
            float* o = PART + ((size_t)ks * 4 + L) * 3 * 12288 + n;
            o[0] = a0; o[12288] = a1; o[24576] = a2;
        }
    }
}
__device__ __forceinline__ void mod_reduce(CP P, int gw, int lane, int NGW) {
    const float* PART = (const float*)(P->ws + WS_MODP); float* MOD = (float*)(P->ws + WS_MOD); const float* mb = P->in[5];
    for (int i = gw * 64 + lane; i < 4 * 3 * 12288; i += NGW * 64) {
        const int L = i / (3 * 12288), n = i % 12288;
        float s = mb[(size_t)L * 12288 + n];
#pragma unroll
        for (int ks = 0; ks < 8; ++ks) s += PART[(size_t)ks * 4 * 3 * 12288 + i];
        MOD[i] = s;
    }
}

__device__ __forceinline__ void first_row_pass(CP P, int lane, int gw, int NGW) {
    const float* MOD = (const float*)(P->ws + WS_MOD); bf16* X = (bf16*)(P->ws + WS_X); bf16* H = (bf16*)(P->ws + WS_H);
    for (int row = gw; row < MT; row += NGW) {
        const float* src = row < ML ? P->in[0] + (size_t)row * DM : P->in[2] + (size_t)(row - ML) * DM;
        float v[32]; load_row_f32(src, lane, v);
        store_row_bf16(X + (size_t)row * DM, lane, v);
        const float* mod = MOD + (size_t)row_slot(row) * 12288;
        float mean, rstd; ln_stats(v, mean, rstd);
        float a[32], s[32]; load_row_f32(mod + 2048, lane, a); load_row_f32(mod, lane, s);
#pragma unroll
        for (int i = 0; i < 32; ++i) a[i] = (v[i] - mean) * rstd * (1.0f + a[i]) + s[i];
        store_row_bf16(H + (size_t)row * DM, lane, a);
    }
}
__device__ __forceinline__ void post_mixer_pass(CP P, int L, int Mrows, int lane, int gw, int NGW) {
    const float* MOD = (const float*)(P->ws + WS_MOD); bf16* X = (bf16*)(P->ws + WS_X); bf16* H = (bf16*)(P->ws + WS_H); const bf16* Y = (const bf16*)(P->ws + WS_Y);
    const float* lng = P->in[6] + (size_t)(L * 2 + 0) * DM; const float* lnb = P->in[7] + (size_t)(L * 2 + 0) * DM;
    for (int row = gw; row < Mrows; row += NGW) {
        const float* mod = MOD + (size_t)(L * 3 + row_slot(row)) * 12288;
        float z[32], y[32], g[32]; load_row_bf16(X + (size_t)row * DM, lane, z); load_row_bf16(Y + (size_t)row * DM, lane, y); load_row_f32(mod + 2 * 2048, lane, g);
#pragma unroll
        for (int i = 0; i < 32; ++i) z[i] = ALPHA * z[i] + g[i] * y[i];
        finish_row<false>(z, lng, lnb, X + (size_t)row * DM, mod + 3 * 2048, mod + 4 * 2048, H + (size_t)row * DM, nullptr, lane);
    }
}
__device__ __forceinline__ void vstats_pass(CP P, int Mrows, int lane, int gw, int NGW) {
    const bf16* Z = (const bf16*)(P->ws + WS_Z); float* VST = (float*)(P->ws + WS_VST);
    for (int row = gw; row < Mrows; row += NGW) {
        float v[32]; load_row_bf16(Z + (size_t)row * 4096 + 2048, lane, v);
        float mean, rstd; ln_stats(v, mean, rstd);
        if (lane == 0) { VST[2 * row] = mean; VST[2 * row + 1] = rstd; }
    }
}
#define XB_TMO      128
#define XB_XCNT(j)  (256  + 64 * (j))
#define XB_XSUB(j)  (1280 + 64 * (j))
#define XB_XGEN(j)  (2304 + 64 * (j))
#define XB_TOP      3328
#define XB_TOPGEN   3392
#define XCD_BAR_WORDS 3456
#define XB_SPIN_CAP (1u << 18)

__device__ __forceinline__ unsigned xb_ld(unsigned* p)              { return __hip_atomic_load(p, __ATOMIC_RELAXED, __HIP_MEMORY_SCOPE_AGENT); }
__device__ __forceinline__ unsigned xb_add(unsigned* p, unsigned v) { return __hip_atomic_fetch_add(p, v, __ATOMIC_RELAXED, __HIP_MEMORY_SCOPE_AGENT); }
__device__ __forceinline__ unsigned xb_xcc_id() { return (unsigned)__builtin_amdgcn_s_getreg((3 << 11) | 20) & 0xFu; }
#define XB_SPIN(cond, bar) do { unsigned _sp = 0; while (cond) { __builtin_amdgcn_s_sleep(1); \
    if ((++_sp & 255u) == 0u) { if (xb_ld(&(bar)[XB_TMO])) break; if (_sp > XB_SPIN_CAP) { atomicAdd(&(bar)[XB_TMO], 1u); break; } } } } while (0)

struct XcdBarrier {
    unsigned* bar; unsigned x;
    volatile LAS unsigned* st;
};

__device__ __forceinline__ XcdBarrier xcd_barrier_post(unsigned* bar, volatile LAS unsigned* st, const bool t0) {
    XcdBarrier b; b.bar = bar; b.x = xb_xcc_id(); b.st = st;
    if (t0) (void)xb_add(&bar[XB_XCNT(b.x)], 1u);
    return b;
}
__device__ __forceinline__ void xcd_barrier_complete(unsigned* bar, unsigned x, unsigned& nloc, unsigned& nx) {
    const unsigned G = gridDim.x * gridDim.y * gridDim.z;
    unsigned sum, cnt, mine, sp = 0u;
    for (;;) {
        sum = 0u; cnt = 0u; mine = 0u;
#pragma unroll
        for (unsigned j = 0; j < 16; ++j) { const unsigned c = xb_ld(&bar[XB_XCNT(j)]); sum += c; cnt += (c > 0u) ? 1u : 0u; mine = (j == x) ? c : mine; }
        if (sum == G) break;
        __builtin_amdgcn_s_sleep(1);
        if ((++sp & 255u) == 0u) { if (xb_ld(&bar[XB_TMO])) break; if (sp > XB_SPIN_CAP) { atomicAdd(&bar[XB_TMO], 1u); break; } }
    }
    nloc = mine > 0u ? mine : 1u; nx = cnt > 0u ? cnt : 1u;
}

__device__ __attribute__((noinline)) void xcd_barrier(const XcdBarrier b, const bool t0) {
    asm volatile("s_waitcnt vmcnt(0)" ::: "memory");
    __syncthreads();
    if (t0) {
        unsigned* bar = b.bar;
        __builtin_amdgcn_s_waitcnt(0);
        unsigned nloc = b.st[0], nx = b.st[1];
        if (nloc == 0u) { xcd_barrier_complete(bar, b.x, nloc, nx); b.st[0] = nloc; b.st[1] = nx; }
        const unsigned old = xb_add(&bar[XB_XSUB(b.x)], 1u);
        const unsigned gen = old / nloc;
        if (old + 1u == (gen + 1u) * nloc) {
            __builtin_amdgcn_fence(__ATOMIC_RELEASE, "agent");
            asm volatile("s_waitcnt vmcnt(0)" ::: "memory");
            const unsigned og = xb_add(&bar[XB_TOP], 1u);
            const unsigned tg = og / nx;
            if (og + 1u == (tg + 1u) * nx) xb_add(&bar[XB_TOPGEN], 1u);
            else XB_SPIN(xb_ld(&bar[XB_TOPGEN]) == tg, bar);
            __builtin_amdgcn_fence(__ATOMIC_ACQUIRE, "agent");
            xb_add(&bar[XB_XGEN(b.x)], 1u);
            asm volatile("s_waitcnt vmcnt(0)" ::: "memory");
        } else {
            XB_SPIN(xb_ld(&bar[XB_XGEN(b.x)]) == gen, bar);
            __builtin_amdgcn_fence(__ATOMIC_ACQUIRE, "agent");
            asm volatile("s_waitcnt vmcnt(0)" ::: "memory");
        }
    }
    __syncthreads();
}

__device__ __forceinline__ void spatial_phase(CP P, int j, int Mrows, LAS unsigned char* lds_, int tid, int lane, int wid) {
    const bf16* Z = (const bf16*)(P->ws + WS_Z); const float* VST = (const float*)(P->ws + WS_VST); bf16* Gb = (bf16*)(P->ws + WS_G);
    const bf16* WS = (const bf16*)(P->ws + WS_GMWS) + (size_t)j * 16 * 128 * 128;
    const float* lng = P->in[14] + (size_t)j * DM; const float* lnb = P->in[15] + (size_t)j * DM; const float* bs = P->in[17] + (size_t)j * 16 * 128;
    LAS bf16* Vt = (LAS bf16*)(LAS unsigned char*)lds_;
    constexpr int VP = 136;
    const int nunits = (Mrows / 128) * 16;
    for (int u = blockIdx.x; u < nunits; u += gridDim.x) {
        const int c = u >> 4, g = u & 15;
        __syncthreads();
        {
            const int q = tid >> 2, dq = (tid & 3) * 32; const int row = c * 128 + q;
            const float mean = VST[2 * row], rstd = VST[2 * row + 1];
            const bf16* src = Z + (size_t)row * 4096 + 2048 + g * 128 + dq;
#pragma unroll
            for (int t = 0; t < 4; ++t) { const u32x4 w = *(const u32x4*)(src + 8 * t);
                float v[8] = {bflo(w.x), bfhi(w.x), bflo(w.y), bfhi(w.y), bflo(w.z), bfhi(w.z), bflo(w.w), bfhi(w.w)};
                const float* gp = lng + g * 128 + dq + 8 * t; const float* bp = lnb + g * 128 + dq + 8 * t;
#pragma unroll
                for (int i = 0; i < 8; ++i) { const float vn = (v[i] - mean) * rstd * gp[i] + bp[i]; Vt[(dq + 8 * t + i) * VP + q] = tobf1(vn); } }
        }
        __syncthreads();
        const int fr = lane & 15, fq = lane >> 4;
        bf16x8 a[4];
        const bf16* wrow = WS + (size_t)g * 128 * 128 + (size_t)(16 * wid + fr) * 128 + 8 * fq;
#pragma unroll
        for (int ks = 0; ks < 4; ++ks) a[ks] = *(const bf16x8*)(wrow + 32 * ks);
#pragma unroll
        for (int nb = 0; nb < 8; ++nb) {
            f32x4 acc = {0.f, 0.f, 0.f, 0.f};
#pragma unroll
            for (int ks = 0; ks < 4; ++ks) { const bf16x8 b = *(const LAS bf16x8*)(Vt + (16 * nb + fr) * VP + 32 * ks + 8 * fq);
                acc = __builtin_amdgcn_mfma_f32_16x16x32_bf16(a[ks], b, acc, 0, 0, 0); }
#pragma unroll
            for (int r = 0; r < 4; ++r) { const int p = 16 * wid + fq * 4 + r, d = 16 * nb + fr; const size_t grow = (size_t)(c * 128 + p);
                const float sv = acc[r] + bs[g * 128 + p];
                const float uu = bf1(Z[grow * 4096 + g * 128 + d]);
                Gb[grow * 2048 + g * 128 + d] = tobf1(uu * sv); }
        }
    }
}

__device__ __forceinline__ void rope_cs(int row, int l, float& cs, float& sn) {
    const int t = row & (SEQ - 1); const int pos = (l & 32) ? (t & 63) : (t >> 6);
    const float inv = powf(10000.0f, -(float)(l & 15) * (1.0f / 16.0f));
    const float ang = (float)pos * inv; sincosf(ang, &sn, &cs);
}
__device__ __forceinline__ float rope_apply(float x, int l, float cs, float sn) {
    const float p = lane_xor16(x, l);
    return (l & 16) ? (p * sn + x * cs) : (x * cs - p * sn);
}
__device__ __forceinline__ void mla_norm_pass(CP P, int lane, int gw, int NGW) {
    const bf16* C = (const bf16*)(P->ws + WS_C); bf16* CQN = (bf16*)(P->ws + WS_CQN); bf16* CKVN = (bf16*)(P->ws + WS_CKVN); bf16* KR = (bf16*)(P->ws + WS_KR);
    const float* qn = P->in[20]; const float* kvn = P->in[21];
    for (int row = gw; row < MT; row += NGW) {
        const bf16* c = C + (size_t)row * 1280;
#pragma unroll
        for (int part = 0; part < 2; ++part) {
            const u32x4 w = *(const u32x4*)(c + part * 512 + 8 * lane);
            float v[8] = {bflo(w.x), bfhi(w.x), bflo(w.y), bfhi(w.y), bflo(w.z), bfhi(w.z), bflo(w.w), bfhi(w.w)};
            float ss = 0.f;
#pragma unroll
            for (int i = 0; i < 8; ++i) ss += v[i] * v[i];
            const float r = 1.0f / sqrtf(wave_sum(ss) * (1.0f / 512.0f) + LN_EPS);
            const float* nw = (part ? kvn : qn) + 8 * lane;
            u32x4 o; o.x = cvtpk(v[0] * r * nw[0], v[1] * r * nw[1]); o.y = cvtpk(v[2] * r * nw[2], v[3] * r * nw[3]); o.z = cvtpk(v[4] * r * nw[4], v[5] * r * nw[5]); o.w = cvtpk(v[6] * r * nw[6], v[7] * r * nw[7]);
            *(u32x4*)((part ? CKVN : CQN) + (size_t)row * 512 + 8 * lane) = o;
        }
        float x = bf1(c[1024 + lane]);
        if (row < ML) { float cs, sn; rope_cs(row, lane, cs, sn); x = rope_apply(x, lane, cs, sn); }
        KR[(size_t)row * 64 + lane] = tobf1(x);
    }
}
__device__ __forceinline__ void rope_pass(bf16* buf, int ld, int col0, int nchunks, int cstride, int lane, int gw, int NGW) {
    for (int row = gw; row < ML; row += NGW) {
        float cs, sn; rope_cs(row, lane, cs, sn);
        bf16* r = buf + (size_t)row * ld + col0 + lane;
#pragma unroll 4
        for (int k = 0; k < nchunks; ++k) { const float x = bf1(r[k * cstride]); r[k * cstride] = tobf1(rope_apply(x, lane, cs, sn)); }
    }
}

namespace att {
#ifndef ATT_LEAN
#define ATT_LEAN 1
#endif
#ifndef ATT_3STAGE
#define ATT_3STAGE 0
#endif
#ifndef ATT_SDEPTH
#define ATT_SDEPTH(MODE) ((MODE) == 0 ? 1 : 1)
#endif
#ifndef ATT_PVPIPE
#define ATT_PVPIPE(MODE) false
#endif
#define SBAR() __builtin_amdgcn_sched_barrier(0)
__device__ __forceinline__ int crow(int r, int hi) { return (r & 3) + 8 * (r >> 2) + 4 * hi; }
__device__ __forceinline__ unsigned cvtpkv(float lo, float hi) { unsigned r; asm volatile("v_cvt_pk_bf16_f32 %0, %1, %2" : "=v"(r) : "v"(lo), "v"(hi)); return r; }

__device__ __forceinline__ void partialSM(f32x16& p0, f32x16& p1, float& m_reg, float& mn, float& alpha, const float C, const float THRS) {
  float pmax = p0[0];
#pragma unroll
  for (int r = 1; r < 16; ++r) pmax = fmaxf(pmax, p0[r]);
#pragma unroll
  for (int r = 0; r < 16; ++r) pmax = fmaxf(pmax, p1[r]);
  { auto rr = __builtin_amdgcn_permlane32_swap(__float_as_uint(pmax), __float_as_uint(pmax), false, false);
    pmax = fmaxf(__uint_as_float(rr[0]), __uint_as_float(rr[1])); }
  if (__builtin_expect(__all(pmax - m_reg <= THRS), 1)) { mn = m_reg; alpha = 1.f; }
  else { mn = fmaxf(m_reg, pmax); alpha = __builtin_amdgcn_exp2f((m_reg - mn) * C); m_reg = mn; }
  const float mnC = -mn * C;
#pragma unroll
  for (int r = 0; r < 16; ++r) p0[r] = fmaf(p0[r], C, mnC);
#pragma unroll
  for (int r = 0; r < 16; ++r) p1[r] = fmaf(p1[r], C, mnC);
#pragma unroll
  for (int r = 0; r < 16; ++r) p0[r] = __builtin_amdgcn_exp2f(p0[r]);
}
__device__ __forceinline__ void finishSM(f32x16& p0, f32x16& p1, float alpha, float& l_reg, bf16x8& pa0, bf16x8& pa1, bf16x8& pa2, bf16x8& pa3) {
#pragma unroll
  for (int r = 0; r < 16; ++r) p1[r] = __builtin_amdgcn_exp2f(p1[r]);
  float ps = 0;
#pragma unroll
  for (int r = 0; r < 16; ++r) ps += p0[r];
#pragma unroll
  for (int r = 0; r < 16; ++r) ps += p1[r];
  { auto rr = __builtin_amdgcn_permlane32_swap(__float_as_uint(ps), __float_as_uint(ps), false, false);
    ps = __uint_as_float(rr[0]) + __uint_as_float(rr[1]); }
  l_reg = l_reg * alpha + ps;
#define PK4(P, BASE, OUT) do { unsigned a0 = cvtpkv(P[BASE + 0], P[BASE + 1]), a1 = cvtpkv(P[BASE + 2], P[BASE + 3]);   \
    unsigned b0 = cvtpkv(P[BASE + 4], P[BASE + 5]), b1 = cvtpkv(P[BASE + 6], P[BASE + 7]);                              \
    auto r0 = __builtin_amdgcn_permlane32_swap(a0, b0, false, false); auto r1 = __builtin_amdgcn_permlane32_swap(a1, b1, false, false); \
    u32x4 w = {r0[0], r1[0], r0[1], r1[1]}; OUT = *reinterpret_cast<bf16x8*>(&w); } while (0)
  PK4(p0, 0, pa0); PK4(p0, 8, pa1); PK4(p1, 0, pa2); PK4(p1, 8, pa3);
#undef PK4
}
__device__ __forceinline__ void partialSM_lean(f32x16& p0, f32x16& p1, f32x16& nm, float& alpha, const bool first) {
  constexpr float THR2 = 11.541560327111707f;
  float dmax = p0[0];
#pragma unroll
  for (int r = 1; r < 16; ++r) dmax = fmaxf(dmax, p0[r]);
#pragma unroll
  for (int r = 0; r < 16; ++r) dmax = fmaxf(dmax, p1[r]);
  { auto rr = __builtin_amdgcn_permlane32_swap(__float_as_uint(dmax), __float_as_uint(dmax), false, false);
    dmax = fmaxf(__uint_as_float(rr[0]), __uint_as_float(rr[1])); }
  alpha = 1.f;
  if (first || !__all(dmax <= THR2)) {
    const float delta = first ? dmax : (dmax > THR2 ? dmax : 0.f);
    if (!first) alpha = __builtin_amdgcn_exp2f(-delta);
#pragma unroll
    for (int r = 0; r < 16; ++r) { p0[r] -= delta; p1[r] -= delta; nm[r] -= delta; }
  }
#pragma unroll
  for (int r = 0; r < 16; ++r) p0[r] = __builtin_amdgcn_exp2f(p0[r]);
}
__device__ __forceinline__ void finishSM_lean(f32x16& p0, f32x16& p1, bf16x8& pa0, bf16x8& pa1, bf16x8& pa2, bf16x8& pa3) {
#pragma unroll
  for (int r = 0; r < 16; ++r) p1[r] = __builtin_amdgcn_exp2f(p1[r]);
#define PK4(P, BASE, OUT) do { unsigned a0 = cvtpkv(P[BASE + 0], P[BASE + 1]), a1 = cvtpkv(P[BASE + 2], P[BASE + 3]);   \
    unsigned b0 = cvtpkv(P[BASE + 4], P[BASE + 5]), b1 = cvtpkv(P[BASE + 6], P[BASE + 7]);                              \
    auto r0 = __builtin_amdgcn_permlane32_swap(a0, b0, false, false); auto r1 = __builtin_amdgcn_permlane32_swap(a1, b1, false, false); \
    u32x4 w = {r0[0], r1[0], r0[1], r1[1]}; OUT = *reinterpret_cast<bf16x8*>(&w); } while (0)
  PK4(p0, 0, pa0); PK4(p0, 8, pa1); PK4(p1, 0, pa2); PK4(p1, 8, pa3);
#undef PK4
}
__device__ __forceinline__ bf16x8 scale_bf16x8(bf16x8 v, float c) {
  const u32x4 w = *reinterpret_cast<u32x4*>(&v); u32x4 o;
  o.x = cvtpk(bflo(w.x) * c, bfhi(w.x) * c); o.y = cvtpk(bflo(w.y) * c, bfhi(w.y) * c); o.z = cvtpk(bflo(w.z) * c, bfhi(w.z) * c); o.w = cvtpk(bflo(w.w) * c, bfhi(w.w) * c);
  return *reinterpret_cast<bf16x8*>(&o);
}
template <int PITCH> __device__ __forceinline__ int kswz(int r) { return PITCH == 256 ? (r & 15) : ((r >> 1) & 7); }
template <int NQF, int NQR, int PITCH> __device__ __forceinline__ void qkt(f32x16& p0, f32x16& p1, const LAS char* Ks, int chunk0, const bf16x8* qr, const LAS char* ql, int r32, int hi, const f32x16 init = f32x16{}) {
  p0 = init; p1 = init;
  const int sw = kswz<PITCH>(r32);
#pragma unroll
  for (int d0 = 0; d0 < NQF; ++d0) { const int off = ((chunk0 + d0 * 2 + hi) ^ sw) * 16;
    const bf16x8 b0 = *(const LAS bf16x8*)(Ks + r32 * PITCH + off);
    const bf16x8 b1 = *(const LAS bf16x8*)(Ks + (32 + r32) * PITCH + off);
    const bf16x8 q = d0 < NQR ? qr[d0 < NQR ? d0 : 0] : *(const LAS bf16x8*)(ql + (d0 - NQR < 0 ? 0 : d0 - NQR) * 1024);
    p0 = __builtin_amdgcn_mfma_f32_32x32x16_bf16(b0, q, p0, 0, 0, 0);
    p1 = __builtin_amdgcn_mfma_f32_32x32x16_bf16(b1, q, p1, 0, 0, 0); }
}
__device__ __forceinline__ int v_st(int k, int c) { const int kk = (k & ~0xC) | ((k & 4) << 1) | ((k & 8) >> 1); return ((kk >> 3) * 4 + (c >> 5)) * 512 + ((kk & 7) * 32 + (c & 31)) * 2; }
__device__ __forceinline__ int v_rd_base(int lane) { return ((lane & 3) << 3) | (((lane >> 2) & 3) << 6) | (((lane >> 4) & 1) << 5) | (((lane >> 5) & 1) << 8); }
constexpr int v_rd_off(int d0, int ks, int half) { return d0 * 512 + ks * 4096 + half * 2048; }
template <int OFF> __device__ __forceinline__ s16x4 tr_read(int vb) {
  s16x4 r; asm volatile("ds_read_b64_tr_b16 %0, %1 offset:%2" : "=&v"(r) : "v"(vb), "i"(OFF) : "memory"); return r;
}
template <int D0> __device__ __forceinline__ void pv_one(f32x16& od, int vb, bf16x8 pa0, bf16x8 pa1, bf16x8 pa2, bf16x8 pa3) {
  const s16x4 l0 = tr_read<v_rd_off(D0, 0, 0)>(vb), h0 = tr_read<v_rd_off(D0, 0, 1)>(vb), l1 = tr_read<v_rd_off(D0, 1, 0)>(vb), h1 = tr_read<v_rd_off(D0, 1, 1)>(vb);
  const s16x4 l2 = tr_read<v_rd_off(D0, 2, 0)>(vb), h2 = tr_read<v_rd_off(D0, 2, 1)>(vb), l3 = tr_read<v_rd_off(D0, 3, 0)>(vb), h3 = tr_read<v_rd_off(D0, 3, 1)>(vb);
  asm volatile("s_waitcnt lgkmcnt(0)" ::: "memory"); SBAR();
#define PK(L, H) (bf16x8){L[0], L[1], L[2], L[3], H[0], H[1], H[2], H[3]}
  od = __builtin_amdgcn_mfma_f32_32x32x16_bf16(pa0, PK(l0, h0), od, 0, 0, 0);
  od = __builtin_amdgcn_mfma_f32_32x32x16_bf16(pa1, PK(l1, h1), od, 0, 0, 0);
  od = __builtin_amdgcn_mfma_f32_32x32x16_bf16(pa2, PK(l2, h2), od, 0, 0, 0);
  od = __builtin_amdgcn_mfma_f32_32x32x16_bf16(pa3, PK(l3, h3), od, 0, 0, 0);
#undef PK
}
__device__ __forceinline__ void pv_d0(f32x16* o, int vb, bf16x8 pa0, bf16x8 pa1, bf16x8 pa2, bf16x8 pa3) {
  pv_one<0>(o[0], vb, pa0, pa1, pa2, pa3); pv_one<1>(o[1], vb, pa0, pa1, pa2, pa3); pv_one<2>(o[2], vb, pa0, pa1, pa2, pa3); pv_one<3>(o[3], vb, pa0, pa1, pa2, pa3);
}
struct VFrag { s16x4 l0, h0, l1, h1, l2, h2, l3, h3; };
template <int D0> __device__ __forceinline__ void tr8(VFrag& f, int vb) {
  f.l0 = tr_read<v_rd_off(D0, 0, 0)>(vb); f.h0 = tr_read<v_rd_off(D0, 0, 1)>(vb); f.l1 = tr_read<v_rd_off(D0, 1, 0)>(vb); f.h1 = tr_read<v_rd_off(D0, 1, 1)>(vb);
  f.l2 = tr_read<v_rd_off(D0, 2, 0)>(vb); f.h2 = tr_read<v_rd_off(D0, 2, 1)>(vb); f.l3 = tr_read<v_rd_off(D0, 3, 0)>(vb); f.h3 = tr_read<v_rd_off(D0, 3, 1)>(vb);
}
__device__ __forceinline__ void mfma4(f32x16& od, VFrag& f, bf16x8 pa0, bf16x8 pa1, bf16x8 pa2, bf16x8 pa3) {
#define PK(L, H) (bf16x8){L[0], L[1], L[2], L[3], H[0], H[1], H[2], H[3]}
  od = __builtin_amdgcn_mfma_f32_32x32x16_bf16(pa0, PK(f.l0, f.h0), od, 0, 0, 0);
  od = __builtin_amdgcn_mfma_f32_32x32x16_bf16(pa1, PK(f.l1, f.h1), od, 0, 0, 0);
  od = __builtin_amdgcn_mfma_f32_32x32x16_bf16(pa2, PK(f.l2, f.h2), od, 0, 0, 0);
  od = __builtin_amdgcn_mfma_f32_32x32x16_bf16(pa3, PK(f.l3, f.h3), od, 0, 0, 0);
#undef PK
}
#define VF_TIE(f) "+v"(f.l0), "+v"(f.h0), "+v"(f.l1), "+v"(f.h1), "+v"(f.l2), "+v"(f.h2), "+v"(f.l3), "+v"(f.h3)
__device__ __forceinline__ void pv_pipe(f32x16* o, int vb, bf16x8 pa0, bf16x8 pa1, bf16x8 pa2, bf16x8 pa3) {
  VFrag A, B;
  asm volatile("s_waitcnt lgkmcnt(0)" ::: "memory");
  tr8<0>(A, vb); tr8<1>(B, vb);
  asm volatile("s_waitcnt lgkmcnt(8)" : VF_TIE(A) :: "memory"); SBAR();
  mfma4(o[0], A, pa0, pa1, pa2, pa3); SBAR();
  tr8<2>(A, vb);
  asm volatile("s_waitcnt lgkmcnt(8)" : VF_TIE(B) :: "memory"); SBAR();
  mfma4(o[1], B, pa0, pa1, pa2, pa3); SBAR();
  tr8<3>(B, vb);
  asm volatile("s_waitcnt lgkmcnt(8)" : VF_TIE(A) :: "memory"); SBAR();
  mfma4(o[2], A, pa0, pa1, pa2, pa3); SBAR();
  asm volatile("s_waitcnt lgkmcnt(0)" : VF_TIE(B) :: "memory"); SBAR();
  mfma4(o[3], B, pa0, pa1, pa2, pa3);
}
__device__ __forceinline__ bf16x8 ld8(const bf16* p) { return *reinterpret_cast<const bf16x8*>(p); }

template <int MODE>
__device__ __forceinline__ void attn_unit(const bf16* __restrict__ Qrow0, int ldq, const bf16* __restrict__ Kb, const bf16* __restrict__ Vb, int ldk, const bf16* __restrict__ KRb,
                                          int b, int nct, int NT, bf16* __restrict__ Ob, float lam, const float* __restrict__ subln, float oscale, LAS unsigned char* lds_, const int tid_in) {
  constexpr bool LEAN = (MODE == 1) && ATT_LEAN; constexpr int NQF = MODE == 0 ? 12 : 4, NQR = MODE == 0 ? 4 : 0, NOB = LEAN ? 5 : 4, PITCH = MODE == 0 ? 384 : 256, SHM_V = 16384, SHM_K = 64 * PITCH, SDEPTH = ATT_SDEPTH(MODE); constexpr bool PVPIPE = ATT_PVPIPE(MODE);
  const float SCALE = MODE == 0 ? 0.07216878364870323f : 0.125f;
  const float C = SCALE * 1.4426950408889634f, THRS = 8.f / SCALE;
  const int tid = launder_v(tid_in) & 511, wid = tid >> 6, lane = tid & 63, r32 = lane & 31, hi = lane >> 5;
  LAS char* lds = (LAS char*)(LAS unsigned char*)lds_;
  constexpr bool THREE = (MODE == 1) && ATT_3STAGE; constexpr int NSTG = THREE ? 3 : 2, STG = SHM_V + SHM_K, SCR0 = NSTG * STG;
#define VOFF(s) (!THREE ? (s) * SHM_V : (s) * STG)
#define KOFF(s) (!THREE ? 2 * SHM_V + (s) * SHM_K : (s) * STG + SHM_V)
  LAS char* V_lds = lds; LAS char* K_lds = lds;
  LAS float* wsf = (LAS float*)(lds + NSTG * (SHM_V + SHM_K)) + wid * 64; LAS float* li_l = wsf; LAS float* al_l = wsf + 32;
  const int wq = MODE == 0 ? wid : (wid & 3), sgrp = MODE == 0 ? 0 : (wid >> 2);
  float m_reg = -1e30f, l_reg = 0; f32x16 o[NOB] = {}; bf16x8 qr[NQR > 0 ? NQR : 1]; f32x16 nm = {};
  LAS char* ql = lds + SCR0 + 2048 + wid * (MODE == 0 ? 8192 : 4096) + lane * 16;
  const bf16* Qw = Qrow0 + (size_t)(wq * 32 + r32) * ldq + sgrp * 64 + hi * 8;
#pragma unroll
  for (int d0 = 0; d0 < NQR; ++d0) qr[d0] = ld8(Qw + d0 * 16);
#pragma unroll
  for (int d0 = NQR; d0 < NQF; ++d0) { bf16x8 qv = ld8(Qw + d0 * 16); if (LEAN) qv = scale_bf16x8(qv, C); *(LAS bf16x8*)(ql + (d0 - NQR) * 1024) = qv; }
  const int sr = tid >> 4, sc = (tid & 15) * 8, vst0 = v_st(sr, sc), vst1 = v_st(32 + sr, sc);
  const int kst0 = sr * PITCH + (((tid & 15) ^ kswz<PITCH>(sr)) * 16), kst1 = kst0 + 32 * PITCH;
  const int rrow = tid >> 3, krs = rrow * PITCH + (((16 + (tid & 7)) ^ kswz<PITCH>(rrow)) * 16);
  const int chunk0 = sgrp * 8;
  const int vb0 = (int)(uintptr_t)V_lds + v_rd_base(lane);
  struct Slot { bf16x8 vs0, vs1, ks0, ks1, kr; } sr_[SDEPTH];
#define KROW(jt) ((jt) < nct ? (ML + b * CTXL + (jt) * 64) : (b * SEQ + ((jt) - nct) * 64))
#define SLOAD(i, jt) do { const int k0_ = KROW(jt); sr_[i].vs0 = ld8(Vb + (size_t)(k0_ + sr) * ldk + sc); sr_[i].vs1 = ld8(Vb + (size_t)(k0_ + 32 + sr) * ldk + sc); \
    sr_[i].ks0 = ld8(Kb + (size_t)(k0_ + sr) * ldk + sc); sr_[i].ks1 = ld8(Kb + (size_t)(k0_ + 32 + sr) * ldk + sc); \
    if (MODE == 0) sr_[i].kr = ld8(KRb + (size_t)(k0_ + rrow) * 64 + (tid & 7) * 8); } while (0)
#define SWRITE(bf, i) do { *(LAS bf16x8*)(V_lds + VOFF(bf) + vst0) = sr_[i].vs0; *(LAS bf16x8*)(V_lds + VOFF(bf) + vst1) = sr_[i].vs1; \
    *(LAS bf16x8*)(K_lds + KOFF(bf) + kst0) = sr_[i].ks0; *(LAS bf16x8*)(K_lds + KOFF(bf) + kst1) = sr_[i].ks1; \
    if (MODE == 0) *(LAS bf16x8*)(K_lds + KOFF(bf) + krs) = sr_[i].kr; } while (0)
#define SWAIT() do { if constexpr (SDEPTH == 2) asm volatile("s_waitcnt vmcnt(4)" ::: "memory"); else asm volatile("s_waitcnt vmcnt(0)" ::: "memory"); } while (0)
#define RESC(a) do { if (__any((a) < 1.f)) { if (hi == 0) al_l[r32] = (a); asm volatile("s_waitcnt lgkmcnt(0)" ::: "memory"); \
    _Pragma("unroll") for (int d = 0; d < NOB; ++d) _Pragma("unroll") for (int r = 0; r < 16; ++r) o[d][r] *= al_l[crow(r, hi)]; } } while (0)
#define PV(vb_) do { if constexpr (PVPIPE) pv_pipe(o, (vb_), pa0, pa1, pa2, pa3); else pv_d0(o, (vb_), pa0, pa1, pa2, pa3); \
    if constexpr (LEAN) { const bf16x8 one8 = {0x3F80, 0x3F80, 0x3F80, 0x3F80, 0x3F80, 0x3F80, 0x3F80, 0x3F80};     \
        o[NOB - 1] = __builtin_amdgcn_mfma_f32_32x32x16_bf16(pa0, one8, o[NOB - 1], 0, 0, 0); o[NOB - 1] = __builtin_amdgcn_mfma_f32_32x32x16_bf16(pa1, one8, o[NOB - 1], 0, 0, 0); \
        o[NOB - 1] = __builtin_amdgcn_mfma_f32_32x32x16_bf16(pa2, one8, o[NOB - 1], 0, 0, 0); o[NOB - 1] = __builtin_amdgcn_mfma_f32_32x32x16_bf16(pa3, one8, o[NOB - 1], 0, 0, 0); } } while (0)
#define PSM(p0_, p1_, mn_, al_, first_) do { if constexpr (LEAN) partialSM_lean(p0_, p1_, nm, al_, first_); else partialSM(p0_, p1_, m_reg, mn_, al_, C, THRS); } while (0)
#define FSM(p0_, p1_, al_) do { if constexpr (LEAN) finishSM_lean(p0_, p1_, pa0, pa1, pa2, pa3); else finishSM(p0_, p1_, al_, l_reg, pa0, pa1, pa2, pa3); } while (0)
#define QKT(p0_, p1_, Kp_) do { if constexpr (LEAN) qkt<NQF, NQR, PITCH>(p0_, p1_, Kp_, chunk0, qr, ql, r32, hi, nm); else qkt<NQF, NQR, PITCH>(p0_, p1_, Kp_, chunk0, qr, ql, r32, hi); } while (0)
  f32x16 pA0, pA1, pB0, pB1; float mnA, mnB, alA, alB; bf16x8 pa0, pa1, pa2, pa3;
  if constexpr (!THREE) {
  constexpr int SE = 0, SO = SDEPTH - 1;
  SLOAD(SE, 0); asm volatile("s_waitcnt vmcnt(0)" ::: "memory"); SWRITE(0, SE); __syncthreads();
  QKT(pA0, pA1, K_lds + KOFF(0)); PSM(pA0, pA1, mnA, alA, true);
  SLOAD(SO, 1); if constexpr (SDEPTH == 2) { if (2 < NT) SLOAD(SE, 2); }
  SWAIT(); SWRITE(1, SO); __syncthreads();
  for (int j = 1; j + 1 < NT; j += 2) {
    SBAR(); QKT(pB0, pB1, K_lds + KOFF(1));
    FSM(pA0, pA1, alA); SBAR();
    SLOAD(SO, j + SDEPTH); SBAR();
    PV(vb0); PSM(pB0, pB1, mnB, alB, false);
    __syncthreads(); SWAIT(); SWRITE(0, SE);
    RESC(alB); __syncthreads();
    SBAR(); QKT(pA0, pA1, K_lds + KOFF(0));
    FSM(pB0, pB1, alB); SBAR();
    if (SDEPTH == 1 || j + 3 < NT) SLOAD(SE, j + 1 + SDEPTH); SBAR();
    PV(vb0 + VOFF(1)); PSM(pA0, pA1, mnA, alA, false);
    __syncthreads(); SWAIT(); SWRITE(1, SO);
    RESC(alA); __syncthreads();
  }
  SBAR(); QKT(pB0, pB1, K_lds + KOFF(1));
  FSM(pA0, pA1, alA); SBAR();
  PV(vb0); PSM(pB0, pB1, mnB, alB, false);
  __syncthreads(); RESC(alB);
  FSM(pB0, pB1, alB); SBAR();
  PV(vb0 + VOFF(1));
  } else {
#define STEP(PC0, PC1, ALC, PP0, PP1, ALP, jj, SP, SC, SN) do { const int j_ = (jj); \
      if (j_ + 1 < NT) { asm volatile("s_waitcnt vmcnt(0)" ::: "memory"); SWRITE(SN, 0); if (j_ + 2 < NT) SLOAD(0, j_ + 2); } \
      SBAR(); QKT(PC0, PC1, K_lds + KOFF(SC)); FSM(PP0, PP1, ALP); SBAR(); \
      PV(vb0 + VOFF(SP)); PSM(PC0, PC1, mnA, ALC, false); \
      RESC(ALC); __syncthreads(); } while (0)
    SLOAD(0, 0); asm volatile("s_waitcnt vmcnt(0)" ::: "memory"); SWRITE(0, 0);
    SLOAD(0, 1); asm volatile("s_waitcnt vmcnt(0)" ::: "memory"); SWRITE(1, 0);
    SLOAD(0, 2); __syncthreads();
    QKT(pA0, pA1, K_lds + KOFF(0)); PSM(pA0, pA1, mnA, alA, true);
    STEP(pB0, pB1, alB, pA0, pA1, alA, 1, 0, 1, 2);
    int j = 2;
    for (; j + 5 < NT; j += 6) {
      STEP(pA0, pA1, alA, pB0, pB1, alB, j, 1, 2, 0);
      STEP(pB0, pB1, alB, pA0, pA1, alA, j + 1, 2, 0, 1);
      STEP(pA0, pA1, alA, pB0, pB1, alB, j + 2, 0, 1, 2);
      STEP(pB0, pB1, alB, pA0, pA1, alA, j + 3, 1, 2, 0);
      STEP(pA0, pA1, alA, pB0, pB1, alB, j + 4, 2, 0, 1);
      STEP(pB0, pB1, alB, pA0, pA1, alA, j + 5, 0, 1, 2);
    }
    if (j < NT) { STEP(pA0, pA1, alA, pB0, pB1, alB, j, 1, 2, 0); STEP(pB0, pB1, alB, pA0, pA1, alA, j + 1, 2, 0, 1); j += 2; }
    if (j < NT) { STEP(pA0, pA1, alA, pB0, pB1, alB, j, 0, 1, 2); STEP(pB0, pB1, alB, pA0, pA1, alA, j + 1, 1, 2, 0); j += 2; }
    FSM(pB0, pB1, alB); SBAR();
    { const int sl = (NT - 1) % 3; PV(vb0 + VOFF(sl)); }
#undef STEP
  }
  float rli[16];
  if constexpr (LEAN) {
#pragma unroll
    for (int r = 0; r < 16; ++r) rli[r] = __builtin_amdgcn_rcpf(o[NOB - 1][r]);
  } else {
    if (hi == 0) li_l[r32] = l_reg; asm volatile("s_waitcnt lgkmcnt(0)" ::: "memory");
#pragma unroll
    for (int r = 0; r < 16; ++r) rli[r] = __builtin_amdgcn_rcpf(li_l[crow(r, hi)]);
  }
  bf16* Ow = Ob + (size_t)(wq * 32) * DM;
  if constexpr (MODE == 0) {
#pragma unroll
    for (int r = 0; r < 16; ++r) { const int orow = crow(r, hi);
#pragma unroll
      for (int d0 = 0; d0 < 4; ++d0) Ow[(size_t)orow * DM + d0 * 32 + r32] = tobf1(o[d0][r] * rli[r]); }
    __syncthreads();
  } else {
    LAS float* ex = (LAS float*)lds;
    __syncthreads();
    if (sgrp == 1) {
#pragma unroll
      for (int r = 0; r < 16; ++r)
#pragma unroll
        for (int d0 = 0; d0 < 4; ++d0) ex[(wq * 32 + crow(r, hi)) * 128 + d0 * 32 + r32] = o[d0][r] * rli[r];
    }
    __syncthreads();
    if (sgrp == 0) {
#pragma unroll
      for (int r = 0; r < 16; ++r) { const int orow = crow(r, hi); float dd[4]; float ss = 0.f;
#pragma unroll
        for (int d0 = 0; d0 < 4; ++d0) { dd[d0] = o[d0][r] * rli[r] - lam * ex[(wq * 32 + orow) * 128 + d0 * 32 + r32]; ss += dd[d0] * dd[d0]; }
        ss = half_sum32(ss);
        const float rs = oscale / sqrtf(ss * (1.0f / 128.0f) + LN_EPS);
#pragma unroll
        for (int d0 = 0; d0 < 4; ++d0) Ow[(size_t)orow * DM + d0 * 32 + r32] = tobf1(dd[d0] * rs * subln[d0 * 32 + r32]); }
    }
    __syncthreads();
  }
#undef VOFF
#undef KOFF
#undef PV
#undef PSM
#undef FSM
#undef QKT
#undef KROW
#undef SLOAD
#undef SWRITE
#undef SWAIT
#undef RESC
}
}

__device__ __forceinline__ void mla_attn_phase(CP P, LAS unsigned char* lds, const int tid) {
    const bf16* QM = (const bf16*)(P->ws + WS_QM); const bf16* KV = (const bf16*)(P->ws + WS_KV); const bf16* KR = (const bf16*)(P->ws + WS_KR); bf16* Gb = (bf16*)(P->ws + WS_G);
    const int c = blockIdx.x, G = gridDim.x;
    for (int u = c; u < 1024 + 32; u += G) {
        int b, h, qrow0, NT;
        if (u < 1024) { const int i = u >> 8, cc = u & 255; const int bh = (cc & 7) + 8 * i, qb = cc >> 3; b = bh >> 4; h = bh & 15; qrow0 = b * SEQ + qb * 256; NT = 4 + 128; }
        else { const int bh = u - 1024; b = bh >> 4; h = bh & 15; qrow0 = ML + b * CTXL; NT = 4; }
        att::attn_unit<0>(QM + (size_t)qrow0 * 3072 + h * 192, 3072, KV + h * 256, KV + h * 256 + 128, 4096, KR, b, 4, NT, Gb + (size_t)qrow0 * DM + h * 128, 0.f, nullptr, 1.f, lds, tid);
    }
}
__device__ __forceinline__ void da_attn_phase(CP P, float lam, float oscale, LAS unsigned char* lds, const int tid, const bool ctx_q) {
    const bf16* Z = (const bf16*)(P->ws + WS_Z); bf16* Gb = (bf16*)(P->ws + WS_G); const float* subln = P->in[27];
    const int c = blockIdx.x, G = gridDim.x;
    for (int u = c; u < 2048 + (ctx_q ? 64 : 0); u += G) {
        int b, h, qrow0, NT;
        if (u < 2048) { const int i = u >> 8, cc = u & 255; const int bh = (cc & 7) + 8 * (i >> 1), qb = (cc >> 3) + 32 * (i & 1); b = bh >> 4; h = bh & 15; qrow0 = b * SEQ + qb * 128; NT = 4 + 128; }
        else { const int v = u - 2048; const int bh = v >> 1; b = bh >> 4; h = bh & 15; qrow0 = ML + b * CTXL + (v & 1) * 128; NT = 4; }
        att::attn_unit<1>(Z + (size_t)qrow0 * 6144 + h * 128, 6144, Z + 2048 + h * 128, Z + 4096 + h * 128, 6144, nullptr, b, 4, NT, Gb + (size_t)qrow0 * DM + h * 128, lam, subln, oscale, lds, tid);
    }
}

__device__ __forceinline__ unsigned f2ord(float f) { const unsigned u = __float_as_uint(f); return u ^ ((unsigned)((int)u >> 31) | 0x80000000u); }
__device__ __forceinline__ float ord2f(unsigned k) { return __uint_as_float((k & 0x80000000u) ? (k ^ 0x80000000u) : ~k); }
__device__ __forceinline__ void ce_desc(unsigned& a, unsigned& b) { const unsigned mx = a > b ? a : b, mn = a > b ? b : a; a = mx; b = mn; }
template <int N, bool DESC> __device__ __forceinline__ void bitonic_merge(unsigned* a) {
#pragma unroll
    for (int j = N / 2; j > 0; j >>= 1)
#pragma unroll
        for (int i = 0; i < N; ++i) { const int l = i ^ j; if (l > i) { if (DESC) ce_desc(a[i], a[l]); else ce_desc(a[l], a[i]); } }
}
template <int N, bool DESC> __device__ __forceinline__ void bitonic_sort(unsigned* a) {
#pragma unroll
    for (int k = 2; k <= N; k <<= 1)
#pragma unroll
        for (int j = k >> 1; j > 0; j >>= 1)
#pragma unroll
            for (int i = 0; i < N; ++i) { const int l = i ^ j; if (l > i) { const bool up = ((i & k) == 0); if (up == DESC) ce_desc(a[i], a[l]); else ce_desc(a[l], a[i]); } }
}
__device__ __forceinline__ void top16_of_64(unsigned (&a)[64]) {
    bitonic_sort<16, true>(a); bitonic_sort<16, false>(a + 16); bitonic_sort<16, true>(a + 32); bitonic_sort<16, false>(a + 48);
#pragma unroll
    for (int i = 0; i < 16; ++i) a[i] = a[i] > a[16 + i] ? a[i] : a[16 + i];
    bitonic_merge<16, true>(a);
#pragma unroll
    for (int i = 0; i < 16; ++i) a[32 + i] = a[32 + i] > a[48 + i] ? a[32 + i] : a[48 + i];
    bitonic_merge<16, false>(a + 32);
#pragma unroll
    for (int i = 0; i < 16; ++i) a[i] = a[i] > a[32 + i] ? a[i] : a[32 + i];
    bitonic_merge<16, true>(a);
}
template <int PASS> __device__ __forceinline__ void route_pass(const bf16* QP, const LAS char* lds, int tok, int head, int r32, int hi, unsigned (&top)[16]) {
    f32x16 acc[4] = {};
    const bf16* qp = QP + (size_t)tok * DM + head * 256 + PASS * 128 + hi * 8;
    bf16x8 qf[8];
#pragma unroll
    for (int ks = 0; ks < 8; ++ks) qf[ks] = *(const bf16x8*)(qp + ks * 16);
    const LAS char* Kl = lds + PASS * 32768;
#pragma unroll
    for (int kb = 0; kb < 4; ++kb)
#pragma unroll
        for (int ks = 0; ks < 8; ++ks) { const bf16x8 a = *(const LAS bf16x8*)(Kl + (kb * 32 + r32) * 256 + (((ks * 2 + hi) ^ (r32 & 15)) * 16));
            acc[kb] = __builtin_amdgcn_mfma_f32_32x32x16_bf16(a, qf[ks], acc[kb], 0, 0, 0); }
    unsigned key[64]; const unsigned base = 127u - 4u * (unsigned)hi;
#pragma unroll
    for (int kb = 0; kb < 4; ++kb)
#pragma unroll
        for (int r = 0; r < 16; ++r) key[kb * 16 + r] = (f2ord(acc[kb][r]) & ~127u) | (base - (unsigned)(kb * 32 + (r & 3) + 8 * (r >> 2)));
    top16_of_64(key);
    unsigned pr[16];
#pragma unroll
    for (int i = 0; i < 16; ++i) pr[i] = lane_xor32(key[15 - i], hi << 5);
#pragma unroll
    for (int i = 0; i < 16; ++i) key[i] = key[i] > pr[i] ? key[i] : pr[i];
    bitonic_merge<16, true>(key);
#pragma unroll
    for (int i = 0; i < 16; ++i) top[i] = key[i];
}
__device__ __forceinline__ void route_phase(CP P, int L, int Mrows, LAS unsigned char* lds_, int tid, int lane, int wid, int gw, int NGW) {
    const bf16* QP = (const bf16*)(P->ws + WS_QP); unsigned* ROUTE = (unsigned*)(P->ws + WS_ROUTE);
    LAS char* lds = (LAS char*)(LAS unsigned char*)lds_;
    __syncthreads();
    {
        const bf16* K1 = (const bf16*)(P->ws + WS_PK1) + (size_t)L * 128 * 128; const bf16* K2 = (const bf16*)(P->ws + WS_PK2) + (size_t)L * 128 * 128;
        for (int c16 = tid; c16 < 2 * 128 * 16; c16 += NWAVES * 64) { const int mat = c16 >> 11, row = (c16 >> 4) & 127, ch = c16 & 15;
            const u32x4 w = *(const u32x4*)((mat ? K2 : K1) + row * 128 + ch * 8);
            *(LAS u32x4*)(lds + mat * 32768 + row * 256 + ((ch ^ (row & 15)) * 16)) = w; }
    }
    __syncthreads();
    LAS unsigned* sc = (LAS unsigned*)(lds + 65536) + wid * 2048;
    const int r32 = lane & 31, hi = lane >> 5;
    for (int item = gw; item < Mrows / 4; item += NGW) {
        const int tok = item * 4 + (r32 >> 3), head = r32 & 7;
        unsigned top0[16], top1[16];
        route_pass<0>(QP, lds, tok, head, r32, hi, top0);
        route_pass<1>(QP, lds, tok, head, r32, hi, top1);
        float v1[16], v2[16];
#pragma unroll
        for (int i = 0; i < 16; ++i) { v1[i] = ord2f(top0[i] & ~127u); v2[i] = ord2f(top1[i] & ~127u);
            sc[i * 64 + lane] = 127u - (top0[i] & 127u); sc[(16 + i) * 64 + lane] = 127u - (top1[i] & 127u); }
        unsigned ck[64]; int n = 0;
#pragma unroll
        for (int i = 0; i < 16; ++i)
#pragma unroll
            for (int j = 0; j < 16; ++j) if ((i + 1) * (j + 1) <= 16) { ck[n] = (f2ord(v1[i] + v2[j]) & ~255u) | (unsigned)(i * 16 + j); ++n; }
#pragma unroll
        for (int i = 50; i < 64; ++i) ck[i] = 0u;
        top16_of_64(ck);
        float ev[16]; float sum = 0.f; const float mx = ord2f(ck[0] & ~255u);
#pragma unroll
        for (int k = 0; k < 16; ++k) { ev[k] = __expf(ord2f(ck[k] & ~255u) - mx); sum += ev[k]; }
        const float inv = 1.0f / sum;
        unsigned ee[16];
#pragma unroll
        for (int k = 0; k < 16; ++k) { const unsigned pc = ck[k] & 255u; const unsigned i1 = sc[(pc >> 4) * 64 + lane], i2 = sc[(16 + (pc & 15u)) * 64 + lane]; ee[k] = i1 * 128u + i2; ev[k] *= inv; }
        u32x4* outp = (u32x4*)(ROUTE + ((size_t)tok * 128 + head * 16 + hi * 8) * 2);
#pragma unroll
        for (int k = 0; k < 8; k += 2) { u32x4 w;
            const unsigned eL0 = ee[k], eH0 = ee[k + 8], eL1 = ee[k + 1], eH1 = ee[k + 9]; const float gL0 = ev[k], gH0 = ev[k + 8], gL1 = ev[k + 1], gH1 = ev[k + 9];
            w.x = hi ? eH0 : eL0; w.y = __float_as_uint(hi ? gH0 : gL0); w.z = hi ? eH1 : eL1; w.w = __float_as_uint(hi ? gH1 : gL1);
            outp[k >> 1] = w; }
    }
}

typedef float f32x2 __attribute__((ext_vector_type(2)));
typedef float f32x32 __attribute__((ext_vector_type(32)));
typedef unsigned u32x6 __attribute__((ext_vector_type(6)));
typedef __bf16 bf16x32 __attribute__((ext_vector_type(32)));
typedef unsigned u32x16 __attribute__((ext_vector_type(16)));
typedef __bf16 bf16x2_t __attribute__((ext_vector_type(2)));
constexpr int GS = 6, GSLOT = 2 * PROW;
__device__ __forceinline__ void glds16(const void* gsrc, unsigned lds_dst) { unsigned keep;
  asm volatile("s_mov_b32 %0, m0\n\ts_mov_b32 m0, %2\n\ts_nop 0\n\tglobal_load_lds_dwordx4 %1, off\n\ts_mov_b32 m0, %0" : "=&s"(keep) : "v"(gsrc), "s"(lds_dst) : "memory"); }
template <int GMODE = 0>
__device__ __forceinline__ void gather_phase(CP P, int L, int Mrows, LAS unsigned char* lds, int wid, int lane_, int gw, int NGW, bool dry = false) {
    const unsigned char* UV = P->ws + WS_PU + (size_t)L * 16384 * PREC;
    const unsigned* ROUTE = (const unsigned*)(P->ws + WS_ROUTE); const float* MOD = (const float*)(P->ws + WS_MOD);
    bf16* X = (bf16*)(P->ws + WS_X); bf16* H = (bf16*)(P->ws + WS_H); bf16* Xo = dry ? (bf16*)(P->ws + WS_Y) : X; bf16* Ho = dry ? (bf16*)(P->ws + WS_G) : H;
    const float* lng = P->in[6] + (size_t)(L * 2 + 1) * DM; const float* lnb = P->in[7] + (size_t)(L * 2 + 1) * DM;
    const unsigned ring = (unsigned)(uintptr_t)lds + (unsigned)wid * (GS * GSLOT);
    const int nfull = (Mrows / NGW) * NGW, rem = Mrows - nfull; const bool can_coop = (rem * 4 == NGW);
    const int nround = nfull / NGW + (rem > 0 ? 1 : 0);
#define G_ROWOF(it_) ((can_coop && (it_) == nround - 1) ? (nfull + (int)blockIdx.x * 2 + (wid >> 2)) : (gw + (it_) * NGW))
    u32x2 nea = {0u, 0u}, neb = {0u, 0u}; u32x4 nh0 = {0u, 0u, 0u, 0u}, nh1 = nh0, nh2 = nh0, nh3 = nh0;
#define G_PREFETCH(rowN_, ln_) do { const int rn_ = (rowN_); nea = ((const u32x2*)(ROUTE + (size_t)rn_ * 256))[ln_]; neb = ((const u32x2*)(ROUTE + (size_t)rn_ * 256))[64 + (ln_)]; \
        const u32x4* hp_ = (const u32x4*)(H + (size_t)rn_ * DM) + 4 * (ln_); nh0 = hp_[0]; nh1 = hp_[1]; nh2 = hp_[2]; nh3 = hp_[3]; } while (0)
    if (nround > 0 && G_ROWOF(0) < Mrows) G_PREFETCH(G_ROWOF(0), launder_v(lane_));
#pragma unroll 1
    for (int it = 0; it < nround; ++it) {
        const bool coop = can_coop && (it == nround - 1);
        int row = G_ROWOF(it), k0 = 0, kn = 128;
        if (coop) { k0 = (wid & 3) * 32; kn = k0 + 32; }
        else if (row >= Mrows) break;
        const int lane = launder_v(lane_);
        const u32x2 ea = nea, eb = neb;
        unsigned eax, eay, ebx, eby;
        unsigned hw[16] = {nh0.x, nh0.y, nh0.z, nh0.w, nh1.x, nh1.y, nh1.z, nh1.w, nh2.x, nh2.y, nh2.z, nh2.w, nh3.x, nh3.y, nh3.z, nh3.w};
        float y[32];
#pragma unroll
        for (int i = 0; i < 32; ++i) y[i] = 0.f;
        { unsigned e0 = ea.x, e1 = ea.y, e2 = eb.x, e3 = eb.y;
          asm volatile("" : "+v"(e0), "+v"(e1), "+v"(e2), "+v"(e3), "+v"(hw[0]), "+v"(hw[1]), "+v"(hw[2]), "+v"(hw[3]), "+v"(hw[4]), "+v"(hw[5]), "+v"(hw[6]), "+v"(hw[7]),
                       "+v"(hw[8]), "+v"(hw[9]), "+v"(hw[10]), "+v"(hw[11]), "+v"(hw[12]), "+v"(hw[13]), "+v"(hw[14]), "+v"(hw[15]) :: "memory");
          eax = e0; eay = e1; ebx = e2; eby = e3; }
        const unsigned rd_a = ring + 16u * (unsigned)lane, rd_b = ring + 2048u + 8u * (unsigned)lane;
#define G_ISSUE(k) do { const int k_ = (k); const unsigned e_ = (unsigned)__builtin_amdgcn_readlane((int)(k_ < 64 ? eax : ebx), k_ & 63); \
        const unsigned char* rp_ = UV + (size_t)e_ * PREC + 16 * lane; const unsigned sb_ = ring + (unsigned)(k_ % GS) * GSLOT; \
        if (GMODE != 2) { glds16(rp_, sb_); glds16(rp_ + 1024, sb_ + 1024); glds16(rp_ + 2048, sb_ + 2048); } else { asm volatile("" :: "v"(rp_), "s"(sb_)); } } while (0)
#pragma unroll
        for (int k = 0; k < 4; ++k) G_ISSUE(k0 + k);
        if (it + 1 < nround && G_ROWOF(it + 1) < Mrows) G_PREFETCH(G_ROWOF(it + 1), lane);
#define G_READ(k, ua, ub, va, vb) do { const unsigned so_ = (unsigned)((k) % GS) * GSLOT; \
        asm volatile("ds_read_b128 %0, %4\n\tds_read_b64 %1, %5\n\tds_read_b128 %2, %4 offset:1024\n\tds_read_b64 %3, %5 offset:512" \
                     : "=&v"(ua), "=&v"(ub), "=&v"(va), "=&v"(vb) : "v"(rd_a + so_), "v"(rd_b + so_) : "memory"); } while (0)
#pragma unroll 1
        for (int k = k0; k < kn; k += 2) {
            if (k + 4 < kn) { G_ISSUE(k + 4); G_ISSUE(k + 5); asm volatile("s_waitcnt vmcnt(12)" ::: "memory"); }
            else if (k == kn - 4) asm volatile("s_waitcnt vmcnt(6)" ::: "memory");
            else asm volatile("s_waitcnt vmcnt(0)" ::: "memory");
            u32x4 uaA, vaA, uaB, vaB; u32x2 ubA, vbA, ubB, vbB;
            G_READ(k, uaA, ubA, vaA, vbA); G_READ(k + 1, uaB, ubB, vaB, vbB);
            asm volatile("s_waitcnt lgkmcnt(0)" : "+v"(uaA), "+v"(ubA), "+v"(vaA), "+v"(vbA), "+v"(uaB), "+v"(ubB), "+v"(vaB), "+v"(vbB) :: "memory");
            if (GMODE == 1) continue;
            const u32x6 u6A = {uaA.x, uaA.y, uaA.z, uaA.w, ubA.x, ubA.y}, u6B = {uaB.x, uaB.y, uaB.z, uaB.w, ubB.x, ubB.y};
            const u32x16 ubfA = __builtin_bit_cast(u32x16, __builtin_amdgcn_cvt_scalef32_pk32_bf16_fp6(u6A, 1.0f));
            const u32x16 ubfB = __builtin_bit_cast(u32x16, __builtin_amdgcn_cvt_scalef32_pk32_bf16_fp6(u6B, 1.0f));
            float a0 = 0.f, a1 = 0.f, b0 = 0.f, b1 = 0.f;
#pragma unroll
            for (int q = 0; q < 16; q += 2) { const unsigned h0_ = hw[q], h1_ = hw[q + 1], x0_ = ubfA[q], x1_ = ubfA[q + 1], z0_ = ubfB[q], z1_ = ubfB[q + 1];
                a0 = __builtin_amdgcn_fdot2_f32_bf16(__builtin_bit_cast(bf16x2_t, h0_), __builtin_bit_cast(bf16x2_t, x0_), a0, false);
                a1 = __builtin_amdgcn_fdot2_f32_bf16(__builtin_bit_cast(bf16x2_t, h1_), __builtin_bit_cast(bf16x2_t, x1_), a1, false);
                b0 = __builtin_amdgcn_fdot2_f32_bf16(__builtin_bit_cast(bf16x2_t, h0_), __builtin_bit_cast(bf16x2_t, z0_), b0, false);
                b1 = __builtin_amdgcn_fdot2_f32_bf16(__builtin_bit_cast(bf16x2_t, h1_), __builtin_bit_cast(bf16x2_t, z1_), b1, false); }
            const float dA = wave_sum(a0 + a1) * (1.0f / U_SCALE), dB = wave_sum(b0 + b1) * (1.0f / U_SCALE);
            const unsigned gsel = k < 64 ? eay : eby;
            const float wA = __uint_as_float((unsigned)__builtin_amdgcn_readlane((int)gsel, k & 63)) * gelu_tanh(dA) * (1.0f / V_SCALE);
            const float wB = __uint_as_float((unsigned)__builtin_amdgcn_readlane((int)gsel, (k & 63) + 1)) * gelu_tanh(dB) * (1.0f / V_SCALE);
            const u32x6 v6A = {vaA.x, vaA.y, vaA.z, vaA.w, vbA.x, vbA.y};
            const f32x32 vfA = __builtin_amdgcn_cvt_scalef32_pk32_f32_fp6(v6A, 1.0f);
#pragma unroll
            for (int i = 0; i < 32; ++i) y[i] += wA * vfA[i];
            const u32x6 v6B = {vaB.x, vaB.y, vaB.z, vaB.w, vbB.x, vbB.y};
            const f32x32 vfB = __builtin_amdgcn_cvt_scalef32_pk32_f32_fp6(v6B, 1.0f);
#pragma unroll
            for (int i = 0; i < 32; ++i) y[i] += wB * vfB[i];
        }
#undef G_READ
#undef G_ISSUE
        if (coop) {
            LAS f32x4* mine = (LAS f32x4*)(lds + wid * (GS * GSLOT)) + lane * 8;
#pragma unroll
            for (int i = 0; i < 8; ++i) mine[i] = (f32x4){y[4 * i], y[4 * i + 1], y[4 * i + 2], y[4 * i + 3]};
            __syncthreads();
            if ((wid & 3) == 0) {
#pragma unroll
                for (int j = 1; j < 4; ++j) { const LAS f32x4* oth = (const LAS f32x4*)(lds + (wid + j) * (GS * GSLOT)) + lane * 8;
#pragma unroll
                    for (int i = 0; i < 8; ++i) { const f32x4 t = oth[i]; y[4 * i] += t.x; y[4 * i + 1] += t.y; y[4 * i + 2] += t.z; y[4 * i + 3] += t.w; } }
            }
            __syncthreads();
            if ((wid & 3) != 0) continue;
        }
        const int slot = row_slot(row);
        const float* mod = MOD + (size_t)(L * 3 + slot) * 12288;
        const int le = launder_v(lane);
        { float xx[32], gg[32]; load_row_bf16_b(X + (size_t)row * DM, le, xx); load_row_f32_b(mod + 5 * 2048, le, gg);
#pragma unroll
          for (int i = 0; i < 32; ++i) y[i] = ALPHA * xx[i] + gg[i] * y[i]; }
        if (L < NLAYER - 1) { const float* modn = MOD + (size_t)((L + 1) * 3 + slot) * 12288;
            finish_row<true>(y, lng, lnb, Xo + (size_t)row * DM, modn, modn + 2048, Ho + (size_t)row * DM, nullptr, le); }
        else finish_row<true>(y, lng, lnb, nullptr, nullptr, nullptr, nullptr, P->out + (size_t)row * DM, le);
        asm volatile("s_waitcnt vmcnt(0)" ::: "memory");
    }
#undef G_PREFETCH
#undef G_ROWOF
}

#ifndef ROPE_TEST
#define ROPE_TEST 0
#endif
#ifndef PROBE_DUP
#define PROBE_DUP 0
#endif
#define NOINL __forceinline__
__device__ __forceinline__ CP launder_cp(CP p) { asm volatile("" : "+s"(p)); return p; }
#define GETP() launder_cp((CP)__builtin_amdgcn_kernarg_segment_ptr())
__device__ __forceinline__ int uni(int v) { return __builtin_amdgcn_readfirstlane(v); }
__device__ __forceinline__ LAS unsigned char* uni_lds(LAS unsigned char* p) { return (LAS unsigned char*)(unsigned)__builtin_amdgcn_readfirstlane((int)(unsigned)(uintptr_t)p); }
#define PH_IDS const int wid = uni(wv_), lane = launder_v(lane_id_fresh()) & 63, tid = (wid & 7) * 64 + lane; const int gw = blockIdx.x * NWAVES + wid, NGW = gridDim.x * NWAVES; (void)lane; (void)gw; (void)NGW; (void)tid;

__device__ NOINL void ph_prologue(int wv_, LAS unsigned char* lds_) { CP P = GETP(); LAS unsigned char* lds = uni_lds(lds_); PH_IDS p0_prologue(P, lds, tid, lane, wid, gw, NGW); if (PROBE_DUP == 5) p0_prologue(P, lds, tid, lane, wid, gw, NGW); }
__device__ NOINL void ph_modreduce(int wv_) { CP P = GETP(); PH_IDS mod_reduce(P, gw, lane, NGW); }
__device__ NOINL void ph_first(int wv_) { CP P = GETP(); PH_IDS
#pragma unroll 1
    for (int rep = 0; rep < (PROBE_DUP == 6 ? 2 : 1); ++rep) first_row_pass(P, lane, gw, NGW); }
__device__ NOINL void ph_postmix(int wv_, int L_, int M_) { CP P = GETP(); const int L = uni(L_), Mrows = uni(M_); PH_IDS post_mixer_pass(P, L, Mrows, lane, gw, NGW); }
__device__ NOINL void ph_vstats(int wv_, int M_) { CP P = GETP(); const int Mrows = uni(M_); PH_IDS
#pragma unroll 1
    for (int rep = 0; rep < (PROBE_DUP == 6 ? 2 : 1); ++rep) vstats_pass(P, Mrows, lane, gw, NGW); }
__device__ NOINL void ph_spatial(int wv_, LAS unsigned char* lds_, int j_, int M_) { CP P = GETP(); LAS unsigned char* lds = uni_lds(lds_); const int j = uni(j_), Mrows = uni(M_); PH_IDS
#pragma unroll 1
    for (int rep = 0; rep < (PROBE_DUP == 6 ? 2 : 1); ++rep) spatial_phase(P, j, Mrows, lds, tid, lane, wid); }
__device__ NOINL void ph_mla_norm(int wv_) { CP P = GETP(); PH_IDS
#pragma unroll 1
    for (int rep = 0; rep < (PROBE_DUP == 6 ? 2 : 1); ++rep) mla_norm_pass(P, lane, gw, NGW); }
__device__ NOINL void ph_rope(int wv_, int which_) { CP P = GETP(); const int which = uni(which_); PH_IDS
    if (which == 0) rope_pass((bf16*)(P->ws + WS_QM), 3072, 128, 16, 192, lane, gw, NGW);
    else rope_pass((bf16*)(P->ws + WS_Z), 6144, 0, 64, 64, lane, gw, NGW); }
__device__ NOINL void ph_attn_mla(int wv_, LAS unsigned char* lds_) { CP P = GETP(); LAS unsigned char* lds = uni_lds(lds_); PH_IDS mla_attn_phase(P, lds, tid); if (PROBE_DUP == 2 || PROBE_DUP == 9) mla_attn_phase(P, lds, tid); }
__device__ NOINL void ph_attn_da(int wv_, LAS unsigned char* lds_, int L_, bool ctx_q) { CP P = GETP(); LAS unsigned char* lds = uni_lds(lds_); const int L = uni(L_); PH_IDS
    const float* lp = P->in[26];
    const float s01 = wave_sum(lp[lane] * lp[64 + lane]), s23 = wave_sum(lp[128 + lane] * lp[192 + lane]);
    const float lam_init = 0.8f - 0.6f * expf(-0.3f * (float)L);
    const float lam = expf(s01) - expf(s23) + lam_init;
    da_attn_phase(P, lam, 1.0f - lam_init, lds, tid, ctx_q); if (PROBE_DUP == 2 || PROBE_DUP == 10) da_attn_phase(P, lam, 1.0f - lam_init, lds, tid, ctx_q); }
__device__ NOINL void ph_route(int wv_, LAS unsigned char* lds_, int L_, int M_) { CP P = GETP(); LAS unsigned char* lds = uni_lds(lds_); const int L = uni(L_), Mrows = uni(M_); PH_IDS
#pragma unroll 1
    for (int rep = 0; rep < (PROBE_DUP == 4 ? 2 : 1); ++rep) route_phase(P, L, Mrows, lds, tid, lane, wid, gw, NGW); }
__device__ NOINL void ph_gather(int wv_, LAS unsigned char* lds_, int L_, int M_) { CP P = GETP(); LAS unsigned char* lds = uni_lds(lds_); const int L = uni(L_), Mrows = uni(M_); PH_IDS
    if (PROBE_DUP == 3) { gather_phase<0>(P, L, Mrows, lds, wid, lane, gw, NGW, true); }
    if (PROBE_DUP == 7) { gather_phase<1>(P, L, Mrows, lds, wid, lane, gw, NGW, true); }
    if (PROBE_DUP == 8) { gather_phase<2>(P, L, Mrows, lds, wid, lane, gw, NGW, true); }
    gather_phase<0>(P, L, Mrows, lds, wid, lane, gw, NGW); }

enum GemmId { G_GM_IN = 0, G_GM_OUT, G_MLA_IN, G_MLA_UQ, G_MLA_UKV, G_MLA_OUT, G_DA_IN, G_DA_OUT, G_PEER_Q };
__device__ NOINL void ph_gemm(int wv_, LAS unsigned char* lds_, int id_, int L_, int M_) {
    CP P = GETP(); LAS unsigned char* lds = uni_lds(lds_); const int id = uni(id_), L = uni(L_), Mrows = uni(M_); PH_IDS
    unsigned char* ws = P->ws; const int jj = L / 3;
    size_t a = WS_H, b = 0, o = 0; int M = MT, N = 2048, K = 2048, act = 0, rope = 0;
    switch (id) {
        case G_GM_IN:   a = WS_H;    b = WS_GMWIN + (size_t)jj * 4096 * 2048 * 2;  o = WS_Z;  M = Mrows; N = 4096; K = 2048; act = 1; break;
        case G_GM_OUT:  a = WS_G;    b = WS_GMWOUT + (size_t)jj * 2048 * 2048 * 2; o = WS_Y;  M = Mrows; N = 2048; K = 2048; break;
        case G_MLA_IN:  a = WS_H;    b = WS_MLAIN;  o = WS_C;  N = 1280; K = 2048; break;
        case G_MLA_UQ:  a = WS_CQN;  b = WS_MLAUQ;  o = WS_QM; N = 3072; K = 512;  rope = (ROPE_TEST == 2) ? 0 : 2; break;
        case G_MLA_UKV: a = WS_CKVN; b = WS_MLAUKV; o = WS_KV; N = 4096; K = 512;  break;
        case G_MLA_OUT: a = WS_G;    b = WS_MLAOUT; o = WS_Y;  N = 2048; K = 2048; break;
        case G_DA_IN:   a = WS_H;    b = WS_DAIN;   o = WS_Z;  N = 6144; K = 2048; rope = (ROPE_TEST == 1) ? 0 : 1; break;
        case G_DA_OUT:  a = WS_G;    b = WS_DAOUT;  o = WS_Y;  M = Mrows; N = 2048; K = 2048; break;
        default:        a = WS_H;    b = WS_PWQ + (size_t)L * 2048 * 2048 * 2;     o = WS_QP; M = Mrows; N = 2048; K = 2048; break;
    }
    pg8::Gemm g{(const pg8::bf16_t*)(ws + a), (const pg8::bf16_t*)(ws + b), M, N, K}; pg8::StaticOrder S; S.init(M, N, (int)gridDim.x, (int)blockIdx.x);
    pg8::EpiR E{(pg8::bf16_t*)(ws + o), N, act, rope, (const float*)(ws + WS_ROPE)};
#pragma unroll 1
    for (int rep = 0; rep < (PROBE_DUP == 1 ? 2 : 1); ++rep) { pg8::gemm_phase<pg8::EpiR, pg8::StaticOrder, true, true>((PG8_LAS unsigned char*)lds, g, S, E, tid); __syncthreads(); }
    const bool tail_u = (id == G_GM_OUT || id == G_MLA_OUT || id == G_DA_OUT), tail_v = (id == G_PEER_Q);
    if ((tail_u || tail_v) && L + 1 < NLAYER) {
        const int units = (M / 256) * (N / 256), G = (int)gridDim.x, tail = units % G, c = (int)blockIdx.x;
        const float* src = (tail_u ? P->in[11] : P->in[12]) + (size_t)(L + 1) * 16384 * 2048; unsigned char* dst = ws + WS_PU + (size_t)(L + 1) * 16384 * PREC;
        LAS float* scr = (LAS float*)(lds + wid * 16384);
        if (tail != 0 && c >= tail) cvt_table_fp6(src, dst, 16384, tail_u ? U_SCALE : V_SCALE, scr, lane, (c - tail) * NWAVES + wid, (G - tail) * NWAVES, tail_u ? 0 : 1);
        else if (tail == 0) cvt_table_fp6(src, dst, 16384, tail_u ? U_SCALE : V_SCALE, scr, lane, gw, NGW, tail_u ? 0 : 1);
    }
}

__global__ void __launch_bounds__(NWAVES * 64, 2) mk_fwd(Params Pv) {
    extern __shared__ __attribute__((aligned(16))) unsigned char lds_g[];
    LAS unsigned char* lds = (LAS unsigned char*)lds_g;
    const int wv = __builtin_amdgcn_readfirstlane((int)threadIdx.x >> 6);
    const int tid = wv * 64 + lane_id_fresh();
    for (int u = tid; u < (LDS_BYTES - RING_BYTES) / 4; u += NWAVES * 64) ((LAS unsigned*)(lds + RING_BYTES))[u] = 0u;
    __syncthreads();
    const int lo = Pv.ph_lo, hi = Pv.ph_hi;
    unsigned* barw = (unsigned*)(Pv.ws + WS_CTL) + CW_BAR;
    XcdBarrier bar; bar.bar = barw; bar.x = 0; bar.st = nullptr;
    if (hi - lo > 1) bar = xcd_barrier_post(barw, (volatile LAS unsigned*)(lds + MISC_OFF) + 8, tid == 0);
    int ph = 0;
#ifndef SEL
#define SELP(k) true
#else
#define SELP(k) ((k) == SEL)
#endif
    enum { RUN_BASE = __COUNTER__ + 1 };
#define RUN(call) do { if (SELP(__COUNTER__ - RUN_BASE) && ph >= lo && ph < hi) { call; } if (ph >= lo && ph + 1 < hi) xcd_barrier(bar, wv == 0 && lane_id_fresh() == 0); ++ph; } while (0)
    RUN(ph_prologue(wv, lds));
    RUN(ph_modreduce(wv));
    RUN(ph_first(wv));
#define LAYER(LL) do { constexpr int L = (LL); constexpr int kind = L % 3, jj = L / 3; constexpr int Mrows = (L == NLAYER - 1) ? ML : MT; \
        constexpr bool ctx_dead = (L == NLAYER - 2) && ((NLAYER - 1) % 3 == 0) && (kind != 0); constexpr int Mlive = ctx_dead ? ML : Mrows; \
        if (kind == 0) {                          \
            RUN(ph_gemm(wv, lds, G_GM_IN, L, Mrows)); \
            RUN(ph_vstats(wv, Mrows)); \
            RUN(ph_spatial(wv, lds, jj, Mrows)); \
            RUN(ph_gemm(wv, lds, G_GM_OUT, L, Mrows)); \
        } else if (kind == 1) {                   \
            RUN(ph_gemm(wv, lds, G_MLA_IN, L, Mrows)); \
            RUN(ph_mla_norm(wv)); \
            RUN(ph_gemm(wv, lds, G_MLA_UQ, L, Mrows); ph_gemm(wv, lds, G_MLA_UKV, L, Mrows)); \
            if (ROPE_TEST == 2) { RUN(ph_rope(wv, 0)); } \
            RUN(ph_attn_mla(wv, lds)); \
            RUN(ph_gemm(wv, lds, G_MLA_OUT, L, Mrows)); \
        } else {                                  \
            RUN(ph_gemm(wv, lds, G_DA_IN, L, Mrows); if (ROPE_TEST == 1) { __syncthreads(); } ); \
            if (ROPE_TEST == 1) { RUN(ph_rope(wv, 1)); } \
            RUN(ph_attn_da(wv, lds, L, !ctx_dead)); \
            RUN(ph_gemm(wv, lds, G_DA_OUT, L, Mlive)); \
        } \
        RUN(ph_postmix(wv, L, Mlive));                \
        RUN(ph_gemm(wv, lds, G_PEER_Q, L, Mlive));    \
        RUN(ph_route(wv, lds, L, Mlive));             \
        RUN(ph_gather(wv, lds, L, Mlive));            \
    } while (0)
    LAYER(0); LAYER(1); LAYER(2); LAYER(3);
#undef LAYER
#undef RUN
}

extern "C" void kernel_launch(void* const* d_in, const int* in_sizes, int n_in, void* d_out, int out_size, void* d_ws, size_t ws_size, hipStream_t stream) {
    static int grid = 0;
    if (grid == 0) {
        if (n_in != 29 || in_sizes[0] != ML * DM || out_size != ML * DM || ws_size < WS_END) {
            fprintf(stderr, "kernel_launch: shape mismatch: n_in %d in0 %d out %d ws %zu (need %zu); nothing launched\n", n_in, n_in > 0 ? in_sizes[0] : -1, out_size, ws_size, (size_t)WS_END); grid = -1; return; }
        int dev = 0, cus = 0, per_cu = 0;
        if (hipGetDevice(&dev) != hipSuccess || hipDeviceGetAttribute(&cus, hipDeviceAttributeMultiprocessorCount, dev) != hipSuccess) { fprintf(stderr, "kernel_launch: device query failed\n"); grid = -1; return; }
        if (hipFuncSetAttribute((const void*)mk_fwd, hipFuncAttributeMaxDynamicSharedMemorySize, LDS_BYTES) != hipSuccess) { fprintf(stderr, "kernel_launch: hipFuncSetAttribute failed\n"); grid = -1; return; }
        if (hipOccupancyMaxActiveBlocksPerMultiprocessor(&per_cu, (const void*)mk_fwd, NWAVES * 64, LDS_BYTES) != hipSuccess || per_cu < 1)
            fprintf(stderr, "kernel_launch: note: occupancy query reports %d workgroups per CU\n", per_cu);
        (void)hipGetLastError();
        grid = cus;
    }
    if (grid < 0) return;
    if (hipMemsetAsync((char*)d_ws + WS_CTL, 0, CTL_ZERO_BYTES, stream) != hipSuccess) { fprintf(stderr, "kernel_launch: memset failed\n"); return; }
    Params p{};
    for (int i = 0; i < 29; ++i) p.in[i] = (const float*)d_in[i];
    p.out = (float*)d_out; p.ws = (unsigned char*)d_ws;
#if MK_ONE_LAUNCH
    p.ph_lo = 0; p.ph_hi = NPH;
    hipLaunchKernelGGL(mk_fwd, dim3(grid), dim3(NWAVES * 64), LDS_BYTES, stream, p);
#else
    for (int li = 0; li < NPH; ++li) { p.ph_lo = li; p.ph_hi = li + 1; hipLaunchKernelGGL(mk_fwd, dim3(grid), dim3(NWAVES * 64), LDS_BYTES, stream, p); }
#endif
    const hipError_t le = hipPeekAtLastError();
    if (le != hipSuccess) fprintf(stderr, "kernel_launch: launch failed: %s\n", hipGetErrorName(le));
}
```

```cpp
#include <hip/hip_runtime.h>
#include <cstdio>
#include <cstdint>
#ifndef MK_ONE_LAUNCH
#define MK_ONE_LAUNCH 1
#endif
__device__ __forceinline__ int launder_v(int v) { asm volatile("" : "+v"(v)); return v; }
__device__ __forceinline__ int lane_id_fresh() { unsigned m = ~0u; asm volatile("" : "+s"(m)); return (int)__builtin_amdgcn_mbcnt_hi(m, __builtin_amdgcn_mbcnt_lo(m, 0u)); }
namespace pg8 {
#define PG8_LAS __attribute__((address_space(3)))
typedef unsigned short bf16_t;
typedef short bf16x8 __attribute__((ext_vector_type(8)));
typedef float f32x4 __attribute__((ext_vector_type(4)));
typedef unsigned u32x4 __attribute__((ext_vector_type(4)));
constexpr int BM = 256, BK = 64, HALF = 128, HTB = HALF * BK * 2  , STAGE_BYTES = 8 * HTB, NXCD = 8, WGM = 8;

__host__ __device__ __forceinline__ int lds_byte(int r, int c) { const int st = (r >> 4) * 2 + (c >> 5), rr = r & 15, cc = c & 31, ob = rr * 64 + cc * 2; return st * 1024 + (ob ^ (((ob >> 9) & 1) << 5)); }
__host__ __device__ __forceinline__ void stage_rc(int b, int& R, int& C) { const int st = b / 1024, sb = b % 1024, swz = sb ^ (((sb >> 9) & 1) << 5); R = (st >> 1) * 16 + swz / 64; C = (st & 1) * 32 + (swz % 64) / 2; }
__host__ __device__ __forceinline__ int perm32(int rho) { const int n = rho >> 4, i = rho & 15; return 8 * (i >> 2) + 4 * n + (i & 3); }

struct Unit { int pm, pn; };
struct Gemm { const bf16_t* A; const bf16_t* Bt; int M, N, K; };

struct StaticOrder {
    int nM, nN, nwg, G, c;
    __host__ __device__ void init(int M, int N, int G_, int c_) { nM = M / BM; nN = N / BM; nwg = nM * nN; G = G_; c = c_; }
    __host__ __device__ bool next(int i, Unit& u) const {
        const long L = (long)i * G + c; if (L >= nwg) return false;
        int wgid = (int)L; { const int q = nwg / NXCD, r = nwg % NXCD, xcd = wgid % NXCD, off = wgid / NXCD; wgid = (xcd < r ? xcd * (q + 1) : r * (q + 1) + (xcd - r) * q) + off; }
        const int nig = WGM * nN, gid = wgid / nig, fm = gid * WGM, gsz = (nM - fm) < WGM ? (nM - fm) : WGM;
        u.pm = fm + ((wgid % nig) % gsz); u.pn = (wgid % nig) / gsz; return true;
    }
    __device__ __forceinline__ void a_ready(const Unit&) const {}
    __device__ __forceinline__ void done(const Unit&) const {}
};

__device__ __forceinline__ unsigned cvt_pk_bf16(float lo, float hi) { unsigned r; asm volatile("v_cvt_pk_bf16_f32 %0, %1, %2" : "=v"(r) : "v"(lo), "v"(hi)); return r; }
typedef float f32x2 __attribute__((ext_vector_type(2)));
__device__ __forceinline__ f32x2 gelu_pk(f32x2 v) {
    const f32x2 av = __builtin_elementwise_abs(v), d = av * 0.2316418882f + 1.0f;
    f32x2 t; t.x = __builtin_amdgcn_rcpf(d.x); t.y = __builtin_amdgcn_rcpf(d.y);
    f32x2 q = t * 0.5307027145f + (-0.7265760135f); q = q * t + 0.7107068705f; q = q * t + (-0.142248368f); q = q * t + 0.127414796f; q = q * t;
    const f32x2 s = (v * v) * (-0.72134752044f);
    f32x2 e; e.x = __builtin_amdgcn_exp2f(s.x); e.y = __builtin_amdgcn_exp2f(s.y);
    const f32x2 m = v * (q * e), r = v - m;
    f32x2 o; o.x = v.x < 0.f ? m.x : r.x; o.y = v.y < 0.f ? m.y : r.y; return o;
}

template <int ACT  > struct EpiBf16 {
    static constexpr bool PERM = true, AFTER_DRAIN = false; static_assert(ACT == 0 || ACT == 1, "EpiBf16: ACT is 0 (none) or 1 (gelu_pk)");
    bf16_t* O; int ldc; const float* bias; int split_cols; size_t split_stride; float scale0;
    __device__ __forceinline__ void operator()(const f32x4 (&acc)[2][2][4][2], const Unit& u, int wr, int wc, int fr, int fq) const {
        const int row0 = u.pm * BM + wr * 64 + fr; int colt = u.pn * BM; bf16_t* base = O;
        float sc = 1.f; if (split_cols) { const int t = colt / split_cols; base += (size_t)t * split_stride; colt -= t * split_cols; if (t == 0) sc = scale0; }
        const int col0 = colt + wc * 32 + 8 * fq, bcol0 = u.pn * BM + wc * 32 + 8 * fq;
        f32x4 bv[2][2];
#pragma unroll
        for (int bj = 0; bj < 2; ++bj)
#pragma unroll
            for (int n = 0; n < 2; ++n) bv[bj][n] = bias ? *(const f32x4*)(bias + bcol0 + bj * HALF + 4 * n) : (f32x4){0.f, 0.f, 0.f, 0.f};
#pragma unroll
        for (int ai = 0; ai < 2; ++ai)
#pragma unroll
            for (int m = 0; m < 4; ++m) { bf16_t* rowp = base + (size_t)(row0 + ai * HALF + m * 16) * ldc + col0;
#pragma unroll
                for (int bj = 0; bj < 2; ++bj) { f32x4 v0 = acc[ai][bj][m][0] + bv[bj][0], v1 = acc[ai][bj][m][1] + bv[bj][1];
                    if (ACT == 1) { f32x2 a = gelu_pk((f32x2){v0[0], v0[1]}), b = gelu_pk((f32x2){v0[2], v0[3]}), c = gelu_pk((f32x2){v1[0], v1[1]}), d = gelu_pk((f32x2){v1[2], v1[3]});
                        v0 = (f32x4){a.x, a.y, b.x, b.y}; v1 = (f32x4){c.x, c.y, d.x, d.y}; }
                    v0 = v0 * sc; v1 = v1 * sc; u32x4 w; w.x = cvt_pk_bf16(v0[0], v0[1]); w.y = cvt_pk_bf16(v0[2], v0[3]); w.z = cvt_pk_bf16(v1[0], v1[1]); w.w = cvt_pk_bf16(v1[2], v1[3]);
                    *(u32x4*)(rowp + bj * HALF) = w; } }
    }
};
template <class Epi, class Sched, bool ALIGN_EPI = false, bool SP2 = false>
__device__ __forceinline__ void gemm_phase(PG8_LAS unsigned char* lds, const Gemm g, const Sched& S, const Epi& E, const int tid_in) {
    const int tid = launder_v(tid_in) & 511, wid = __builtin_amdgcn_readfirstlane(tid >> 6), lane = tid & 63, wr = wid >> 2, wc = wid & 3, fr = lane & 15, fq = lane >> 4;
    const int K = g.K, nt = K / BK;
    unsigned voffA[2], voffB[2];
#pragma unroll
    for (int i = 0; i < 2; ++i) { int R, C; stage_rc(tid * 16 + i * 8192, R, C); const int Rb = Epi::PERM ? ((R & ~31) + perm32(R & 31)) : R;
        voffA[i] = (unsigned)(R * K + C) * 2u; voffB[i] = (unsigned)(Rb * K + C) * 2u; }
    const size_t kstep = (size_t)(BK * 2);
    const size_t hstep = (size_t)HALF * K * 2;
    const size_t tstep = 2 * hstep;
    const unsigned ldsw = (unsigned)wid * 1024u;
    const int aoff = lds_byte(wr * 64 + fr, fq * 8), boff = lds_byte(wc * 32 + fr, fq * 8);
#define PG8_SA(b, h) (((b) * 2 + (h)) * HTB)
#define PG8_SB(b, h) ((4 + (b) * 2 + (h)) * HTB)
#define PG8_STAGE(bufoff, gbase, voff) do { _Pragma("unroll") for (int _i = 0; _i < 2; ++_i) \
        __builtin_amdgcn_global_load_lds((const unsigned*)((const char*)(gbase) + (voff)[_i]), (PG8_LAS unsigned*)(lds + (bufoff) + ldsw + _i * 8192), 16, 0, 0); } while (0)
#define PG8_LDA(dst, b, h) do { _Pragma("unroll") for (int m = 0; m < 4; ++m) _Pragma("unroll") for (int k = 0; k < 2; ++k) dst[m][k] = *(const PG8_LAS bf16x8*)(lds + PG8_SA(b, h) + aoff + m * 2048 + k * 1024); } while (0)
#define PG8_LDB(dst, b, h) do { _Pragma("unroll") for (int n = 0; n < 2; ++n) _Pragma("unroll") for (int k = 0; k < 2; ++k) dst[n][k] = *(const PG8_LAS bf16x8*)(lds + PG8_SB(b, h) + boff + n * 2048 + k * 1024); } while (0)
#define PG8_MMA(ai, bj, At, Bt) do { __builtin_amdgcn_s_setprio(1); _Pragma("unroll") for (int m = 0; m < 4; ++m) _Pragma("unroll") for (int n = 0; n < 2; ++n) _Pragma("unroll") for (int k = 0; k < 2; ++k) \
        acc[ai][bj][m][n] = __builtin_amdgcn_mfma_f32_16x16x32_bf16(Bt[n][k], At[m][k], acc[ai][bj][m][n], 0, 0, 0); __builtin_amdgcn_s_setprio(0); } while (0)
#define PG8_WAIT_V(n) asm volatile("s_waitcnt vmcnt(" #n ")" ::: "memory")
#define PG8_WAIT_L(n) asm volatile("s_waitcnt lgkmcnt(" #n ")" ::: "memory")
#define PG8_BAR __builtin_amdgcn_s_barrier()
#define PG8_SCHED __builtin_amdgcn_sched_barrier(0)
    Unit cur, nxt; int ui = 0;
    if (!S.next(0, cur)) return;
    f32x4 acc[2][2][4][2];
#pragma unroll
    for (int a = 0; a < 2; ++a)
#pragma unroll
        for (int b = 0; b < 2; ++b)
#pragma unroll
            for (int m = 0; m < 4; ++m)
#pragma unroll
                for (int n = 0; n < 2; ++n) acc[a][b][m][n] = (f32x4){0.f, 0.f, 0.f, 0.f};
    bf16x8 At[4][2], B0[2][2], B1[2][2];
    const char* cA = (const char*)g.A + (size_t)cur.pm * tstep; const char* cB = (const char*)g.Bt + (size_t)cur.pn * tstep;
    S.a_ready(cur);
    if constexpr (SP2) {
        PG8_STAGE(PG8_SB(0, 0), cB, voffB); PG8_STAGE(PG8_SB(0, 1), cB + hstep, voffB); PG8_STAGE(PG8_SA(0, 0), cA, voffA); PG8_STAGE(PG8_SA(0, 1), cA + hstep, voffA);
        if (wr == 1) PG8_BAR;
        PG8_WAIT_V(2); PG8_BAR;
        PG8_STAGE(PG8_SB(1, 0), cB + kstep, voffB); PG8_STAGE(PG8_SA(1, 0), cA + kstep, voffA); PG8_STAGE(PG8_SB(1, 1), cB + hstep + kstep, voffB);
        PG8_WAIT_V(6); PG8_BAR;
    } else {
        PG8_STAGE(PG8_SB(0, 0), cB, voffB); PG8_STAGE(PG8_SA(0, 0), cA, voffA); PG8_STAGE(PG8_SB(0, 1), cB + hstep, voffB); PG8_STAGE(PG8_SA(0, 1), cA + hstep, voffA);
        if (wr == 1) PG8_BAR;
        PG8_WAIT_V(4); PG8_BAR;
        PG8_STAGE(PG8_SB(1, 0), cB + kstep, voffB); PG8_STAGE(PG8_SA(1, 0), cA + kstep, voffA); PG8_STAGE(PG8_SB(1, 1), cB + hstep + kstep, voffB);
        PG8_WAIT_V(6); PG8_BAR;
    }
    for (;;) {
        const bool has_next = S.next(ui + 1, nxt);
        const char* nA = has_next ? (const char*)g.A + (size_t)nxt.pm * tstep : cA; const char* nB = has_next ? (const char*)g.Bt + (size_t)nxt.pn * tstep : cB;
        for (int t = 0; t < nt; t += 2) {
            const bool last = (t == nt - 2);
            const char* a1 = cA + (size_t)(t + 1) * kstep;
            const char* a2 = last ? nA : cA + (size_t)(t + 2) * kstep; const char* b2 = last ? nB : cB + (size_t)(t + 2) * kstep;
            const char* a3 = a2 + kstep; const char* b3 = b2 + kstep;
            if (last && has_next) S.a_ready(nxt);
            if constexpr (SP2) {
            PG8_LDB(B0, 0, 0); PG8_LDB(B1, 0, 1); PG8_SCHED; PG8_LDA(At, 0, 0); PG8_STAGE(PG8_SA(1, 1), a1 + hstep, voffA);
            PG8_WAIT_V(8); PG8_WAIT_L(0); PG8_BAR; PG8_MMA(0, 0, At, B0); PG8_MMA(0, 1, At, B1); PG8_BAR; PG8_SCHED;
            PG8_LDA(At, 0, 1); PG8_STAGE(PG8_SB(0, 0), b2, voffB); PG8_STAGE(PG8_SB(0, 1), b2 + hstep, voffB); PG8_STAGE(PG8_SA(0, 0), a2, voffA);
            PG8_WAIT_V(8); PG8_WAIT_L(0); PG8_BAR; PG8_MMA(1, 0, At, B0); PG8_MMA(1, 1, At, B1); PG8_BAR; PG8_SCHED;
            PG8_LDB(B0, 1, 0); PG8_LDB(B1, 1, 1); PG8_SCHED; PG8_LDA(At, 1, 0); PG8_STAGE(PG8_SA(0, 1), a2 + hstep, voffA);
            PG8_WAIT_V(8); PG8_WAIT_L(0); PG8_BAR; PG8_MMA(0, 0, At, B0); PG8_MMA(0, 1, At, B1); PG8_BAR; PG8_SCHED;
            PG8_LDA(At, 1, 1); PG8_STAGE(PG8_SB(1, 0), b3, voffB); PG8_STAGE(PG8_SB(1, 1), b3 + hstep, voffB); PG8_STAGE(PG8_SA(1, 0), a3, voffA);
            PG8_WAIT_V(8); PG8_WAIT_L(0); PG8_BAR; PG8_MMA(1, 0, At, B0); PG8_MMA(1, 1, At, B1); PG8_BAR; PG8_SCHED;
            } else {
            PG8_LDB(B0, 0, 0); PG8_SCHED; PG8_LDA(At, 0, 0); PG8_STAGE(PG8_SA(1, 1), a1 + hstep, voffA);
            PG8_WAIT_L(8); PG8_BAR; PG8_WAIT_L(0); PG8_MMA(0, 0, At, B0); PG8_BAR; PG8_SCHED;
            PG8_LDB(B1, 0, 1); PG8_STAGE(PG8_SB(0, 0), b2, voffB);
            PG8_BAR; PG8_WAIT_L(0); PG8_MMA(0, 1, At, B1); PG8_BAR;
            PG8_LDA(At, 0, 1); PG8_STAGE(PG8_SA(0, 0), a2, voffA);
            PG8_BAR; PG8_WAIT_L(0); PG8_MMA(1, 0, At, B0); PG8_BAR; PG8_SCHED;
            PG8_STAGE(PG8_SB(0, 1), b2 + hstep, voffB);
            PG8_WAIT_V(6); PG8_BAR; PG8_MMA(1, 1, At, B1); PG8_BAR;
            PG8_LDB(B0, 1, 0); PG8_SCHED; PG8_LDA(At, 1, 0); PG8_STAGE(PG8_SA(0, 1), a2 + hstep, voffA);
            PG8_WAIT_L(8); PG8_BAR; PG8_WAIT_L(0); PG8_MMA(0, 0, At, B0); PG8_BAR; PG8_SCHED;
            PG8_LDB(B1, 1, 1); PG8_STAGE(PG8_SB(1, 0), b3, voffB);
            PG8_BAR; PG8_WAIT_L(0); PG8_MMA(0, 1, At, B1); PG8_BAR;
            PG8_LDA(At, 1, 1); PG8_STAGE(PG8_SA(1, 0), a3, voffA);
            PG8_BAR; PG8_WAIT_L(0); PG8_MMA(1, 0, At, B0); PG8_BAR; PG8_SCHED;
            PG8_STAGE(PG8_SB(1, 1), b3 + hstep, voffB);
            PG8_WAIT_V(6); PG8_BAR; PG8_MMA(1, 1, At, B1); PG8_BAR;
            }
        }
        if constexpr (ALIGN_EPI) { if (wr == 0) PG8_BAR; }
        if constexpr (!Epi::AFTER_DRAIN) { E(acc, cur, wr, wc, fr, fq); S.done(cur); }
        if (!has_next) break;
#pragma unroll
        for (int a = 0; a < 2; ++a)
#pragma unroll
            for (int b = 0; b < 2; ++b)
#pragma unroll
                for (int m = 0; m < 4; ++m)
#pragma unroll
                    for (int n = 0; n < 2; ++n) acc[a][b][m][n] = (f32x4){0.f, 0.f, 0.f, 0.f};
        cur = nxt; cA = nA; cB = nB; ++ui;
        if constexpr (ALIGN_EPI) { if (wr == 1) PG8_BAR; }
    }
    PG8_WAIT_V(0);
    if constexpr (!ALIGN_EPI) { if (wr == 0) PG8_BAR; }
    PG8_BAR;
    if constexpr (Epi::AFTER_DRAIN) { E.fused(acc, cur, wr, wc, fr, fq, lds, wid, lane); S.done(cur); }
#undef PG8_SA
#undef PG8_SB
#undef PG8_STAGE
#undef PG8_LDA
#undef PG8_LDB
#undef PG8_MMA
#undef PG8_WAIT_V
#undef PG8_WAIT_L
#undef PG8_BAR
#undef PG8_SCHED
}
}

namespace pg8 {
__device__ __forceinline__ float gelu_tanh(float x) {
    const float t = x * (1.5957691216057308f + 0.07135481627f * x * x);
    const float e = __builtin_amdgcn_exp2f(-1.4426950408889634f * t);
    return x * __builtin_amdgcn_rcpf(1.0f + e);
}
template <int ACT> struct EpiT {
    static constexpr bool PERM = true, AFTER_DRAIN = false;
    bf16_t* O; int ldc;
    __device__ __forceinline__ void operator()(const f32x4 (&acc)[2][2][4][2], const Unit& u, int wr, int wc, int fr, int fq) const {
        const int row0 = u.pm * BM + wr * 64 + fr; const int col0 = u.pn * BM + wc * 32 + 8 * fq;
#pragma unroll
        for (int ai = 0; ai < 2; ++ai)
#pragma unroll
            for (int m = 0; m < 4; ++m) { bf16_t* rowp = O + (size_t)(row0 + ai * HALF + m * 16) * ldc + col0;
#pragma unroll
                for (int bj = 0; bj < 2; ++bj) { f32x4 v0 = acc[ai][bj][m][0], v1 = acc[ai][bj][m][1];
                    if (ACT == 2) { v0 = (f32x4){gelu_tanh(v0[0]), gelu_tanh(v0[1]), gelu_tanh(v0[2]), gelu_tanh(v0[3])}; v1 = (f32x4){gelu_tanh(v1[0]), gelu_tanh(v1[1]), gelu_tanh(v1[2]), gelu_tanh(v1[3])}; }
                    u32x4 w; w.x = cvt_pk_bf16(v0[0], v0[1]); w.y = cvt_pk_bf16(v0[2], v0[3]); w.z = cvt_pk_bf16(v1[0], v1[1]); w.w = cvt_pk_bf16(v1[2], v1[3]);
                    *(u32x4*)(rowp + bj * HALF) = w; } }
    }
};
struct EpiR {
    static constexpr bool PERM = true, AFTER_DRAIN = false;
    bf16_t* O; int ldc; int act; int rope; const float* ropet;
    __device__ __forceinline__ void operator()(const f32x4 (&acc)[2][2][4][2], const Unit& u, int wr, int wc, int fr, int fq) const {
        const int row0 = u.pm * BM + wr * 64 + fr; const int col0 = u.pn * BM + wc * 32 + 8 * fq;
        const bool rrows = rope != 0 && u.pm < 64;
#pragma unroll
        for (int ai = 0; ai < 2; ++ai)
#pragma unroll
            for (int m = 0; m < 4; ++m) { const int grow = row0 + ai * HALF + m * 16; bf16_t* rowp = O + (size_t)grow * ldc + col0;
#pragma unroll
                for (int bj = 0; bj < 2; ++bj) { f32x4 v0 = acc[ai][bj][m][0], v1 = acc[ai][bj][m][1];
                    if (act) { v0 = (f32x4){gelu_tanh(v0[0]), gelu_tanh(v0[1]), gelu_tanh(v0[2]), gelu_tanh(v0[3])}; v1 = (f32x4){gelu_tanh(v1[0]), gelu_tanh(v1[1]), gelu_tanh(v1[2]), gelu_tanh(v1[3])}; }
                    if (rrows) { const int blk = u.pn * 8 + bj * 4 + wc; const int b6 = blk % 6; const bool on = rope == 1 ? (blk < 128) : (b6 >= 4); const int half = rope == 1 ? (blk & 1) : (b6 - 4);
                        if (on) { const int t = grow & 8191; const int pos = half ? (t & 63) : (t >> 6);
                            const float* cp = ropet + pos * 16 + 8 * (fq & 1); const f32x4 c0 = *(const f32x4*)cp, c1 = *(const f32x4*)(cp + 4), s0 = *(const f32x4*)(cp + 2048), s1 = *(const f32x4*)(cp + 2052);
                            f32x4 p0, p1;
#pragma unroll
                            for (int i = 0; i < 4; ++i) { const float a_ = v0[i], b_ = v1[i];
                                const auto r0 = __builtin_amdgcn_permlane32_swap(__float_as_uint(a_), __float_as_uint(a_), false, false);
                                const auto r1 = __builtin_amdgcn_permlane32_swap(__float_as_uint(b_), __float_as_uint(b_), false, false);
                                const unsigned x0_ = (fq & 2) ? r0[0] : r0[1], x1_ = (fq & 2) ? r1[0] : r1[1]; p0[i] = __uint_as_float(x0_); p1[i] = __uint_as_float(x1_); }
                            if (fq & 2) { v0 = p0 * s0 + v0 * c0; v1 = p1 * s1 + v1 * c1; } else { v0 = v0 * c0 - p0 * s0; v1 = v1 * c1 - p1 * s1; } } }
                    u32x4 w; w.x = cvt_pk_bf16(v0[0], v0[1]); w.y = cvt_pk_bf16(v0[2], v0[3]); w.z = cvt_pk_bf16(v1[0], v1[1]); w.w = cvt_pk_bf16(v1[2], v1[3]);
                    *(u32x4*)(rowp + bj * HALF) = w; } }
    }
};
}

constexpr int DM = 2048, NBATCH = 2, SEQ = 8192, CTXL = 256;
constexpr int ML = NBATCH * SEQ;
constexpr int MC = NBATCH * CTXL;
constexpr int MT = ML + MC;
constexpr int NLAYER = 4;
constexpr float ALPHA = 1.6817928305074290f, LN_EPS = 1e-6f;
constexpr int NWAVES = 8;
constexpr float U_SCALE = 64.0f, V_SCALE = 4.0f;
constexpr int PROW = 1536;
constexpr int PREC = 2 * PROW;
constexpr int NPH = 35;

constexpr size_t MiB = 1ull << 20;
constexpr size_t WS_CTL = 0, CTL_ZERO_BYTES = 1 * MiB;
constexpr int    CW_BAR = 4096;
constexpr size_t WS_MOD = 128 * 1024;
constexpr size_t WS_VST = 1 * MiB;
constexpr size_t WS_ROPE = 1 * MiB + 160 * 1024;
constexpr size_t WS_MODP = 1 * MiB + 256 * 1024;
constexpr size_t WS_GMWIN = 6 * MiB;
constexpr size_t WS_GMWOUT = WS_GMWIN + 32 * MiB;
constexpr size_t WS_GMWS = WS_GMWOUT + 16 * MiB;
constexpr size_t WS_PWQ = WS_GMWS + 1 * MiB;
constexpr size_t WS_PK1 = WS_PWQ + 32 * MiB;
constexpr size_t WS_PK2 = WS_PK1 + 512 * 1024;
constexpr size_t WS_MLAIN = WS_PK1 + 1 * MiB;
constexpr size_t WS_MLAUQ = WS_MLAIN + 5 * MiB;
constexpr size_t WS_MLAUKV = WS_MLAUQ + 3 * MiB;
constexpr size_t WS_MLAOUT = WS_MLAUKV + 4 * MiB;
constexpr size_t WS_DAIN = WS_MLAOUT + 8 * MiB;
constexpr size_t WS_DAOUT = WS_DAIN + 24 * MiB;
constexpr size_t WS_PU = WS_DAOUT + 8 * MiB;
constexpr size_t WS_PV = WS_PU + 96 * MiB;
constexpr size_t WS_X = WS_PV + 96 * MiB;
constexpr size_t WS_H = WS_X + 66 * MiB;
constexpr size_t WS_G = WS_H + 66 * MiB;
constexpr size_t WS_Y = WS_G + 66 * MiB;
constexpr size_t WS_QP = WS_Y + 66 * MiB;
constexpr size_t WS_Z = WS_QP + 66 * MiB;
constexpr size_t WS_C = WS_Z + 198 * MiB;
constexpr size_t WS_CQN = WS_C + 42 * MiB;
constexpr size_t WS_CKVN = WS_CQN + 17 * MiB;
constexpr size_t WS_KR = WS_CKVN + 17 * MiB;
constexpr size_t WS_QM = WS_KR + 3 * MiB;
constexpr size_t WS_KV = WS_QM + 99 * MiB;
constexpr size_t WS_ROUTE = WS_KV + 132 * MiB;
constexpr size_t WS_END = WS_ROUTE + 17 * MiB;
static_assert((size_t)MT * DM * 2 == 66 * MiB, "row buffer size");

constexpr int RING_BYTES = 155648, MISC_OFF = RING_BYTES + 320, LDS_BYTES = 159744;

#define GAS __attribute__((address_space(1)))
#define LAS __attribute__((address_space(3)))
typedef unsigned short bf16;
typedef unsigned u32x4 __attribute__((ext_vector_type(4)));
typedef unsigned u32x2 __attribute__((ext_vector_type(2)));
typedef float f32x4 __attribute__((ext_vector_type(4)));
typedef float f32x16 __attribute__((ext_vector_type(16)));
typedef short bf16x8 __attribute__((ext_vector_type(8)));
typedef short s16x4 __attribute__((ext_vector_type(4)));
#define LDS_WAIT() asm volatile("s_waitcnt lgkmcnt(0)" ::: "memory")

__device__ __forceinline__ unsigned cvtpk(float lo, float hi) { unsigned r; asm("v_cvt_pk_bf16_f32 %0, %1, %2" : "=v"(r) : "v"(lo), "v"(hi)); return r; }
__device__ __forceinline__ float bflo(unsigned w) { return __uint_as_float(w << 16); }
__device__ __forceinline__ float bfhi(unsigned w) { return __uint_as_float(w & 0xffff0000u); }
__device__ __forceinline__ float bf1(bf16 b) { return __uint_as_float((unsigned)b << 16); }
__device__ __forceinline__ bf16 tobf1(float f) { return (bf16)(cvtpk(f, 0.f) & 0xffffu); }
#define DPP_F(v, ctrl) __int_as_float(__builtin_amdgcn_mov_dpp(__float_as_int(v), (ctrl), 0xF, 0xF, true))
__device__ __forceinline__ float row_sum16(float v) { v += DPP_F(v, 0xB1); v += DPP_F(v, 0x4E); v += DPP_F(v, 0x141); v += DPP_F(v, 0x140); return v; }
__device__ __forceinline__ float sum_xor16(float v) { const auto r = __builtin_amdgcn_permlane16_swap(__float_as_uint(v), __float_as_uint(v), false, false); return __uint_as_float(r[0]) + __uint_as_float(r[1]); }
__device__ __forceinline__ float sum_xor32(float v) { const auto r = __builtin_amdgcn_permlane32_swap(__float_as_uint(v), __float_as_uint(v), false, false); return __uint_as_float(r[0]) + __uint_as_float(r[1]); }
__device__ __forceinline__ float wave_sum(float v) { return sum_xor32(sum_xor16(row_sum16(v))); }
__device__ __forceinline__ float half_sum32(float v) { return sum_xor16(row_sum16(v)); }
__device__ __forceinline__ float lane_xor16(float v, int lane) { const auto r = __builtin_amdgcn_permlane16_swap(__float_as_uint(v), __float_as_uint(v), false, false); return __uint_as_float((lane & 16) ? r[0] : r[1]); }
__device__ __forceinline__ unsigned lane_xor32(unsigned v, int lane) { const auto r = __builtin_amdgcn_permlane32_swap(v, v, false, false); return (lane & 32) ? r[0] : r[1]; }
__device__ __forceinline__ float gelu_tanh(float x) { return pg8::gelu_tanh(x); }

__device__ __forceinline__ void load_row_bf16(const bf16* row, int lane, float (&v)[32]) {
#pragma unroll
    for (int j = 0; j < 4; ++j) { const u32x4 w = ((const u32x4*)row)[64 * j + lane];
        v[8 * j + 0] = bflo(w.x); v[8 * j + 1] = bfhi(w.x); v[8 * j + 2] = bflo(w.y); v[8 * j + 3] = bfhi(w.y);
        v[8 * j + 4] = bflo(w.z); v[8 * j + 5] = bfhi(w.z); v[8 * j + 6] = bflo(w.w); v[8 * j + 7] = bfhi(w.w); }
}
__device__ __forceinline__ void store_row_bf16(bf16* row, int lane, const float (&v)[32]) {
#pragma unroll
    for (int j = 0; j < 4; ++j) { u32x4 w; w.x = cvtpk(v[8 * j + 0], v[8 * j + 1]); w.y = cvtpk(v[8 * j + 2], v[8 * j + 3]); w.z = cvtpk(v[8 * j + 4], v[8 * j + 5]); w.w = cvtpk(v[8 * j + 6], v[8 * j + 7]);
        ((u32x4*)row)[64 * j + lane] = w; }
}
__device__ __forceinline__ void load_row_f32(const float* row, int lane, float (&v)[32]) {
#pragma unroll
    for (int j = 0; j < 4; ++j) { const f32x4 a = ((const f32x4*)row)[128 * j + 2 * lane], b = ((const f32x4*)row)[128 * j + 2 * lane + 1];
        v[8 * j + 0] = a.x; v[8 * j + 1] = a.y; v[8 * j + 2] = a.z; v[8 * j + 3] = a.w; v[8 * j + 4] = b.x; v[8 * j + 5] = b.y; v[8 * j + 6] = b.z; v[8 * j + 7] = b.w; }
}
__device__ __forceinline__ void store_row_f32(float* row, int lane, const float (&v)[32]) {
#pragma unroll
    for (int j = 0; j < 4; ++j) { ((f32x4*)row)[128 * j + 2 * lane] = (f32x4){v[8 * j + 0], v[8 * j + 1], v[8 * j + 2], v[8 * j + 3]};
        ((f32x4*)row)[128 * j + 2 * lane + 1] = (f32x4){v[8 * j + 4], v[8 * j + 5], v[8 * j + 6], v[8 * j + 7]}; }
}
__device__ __forceinline__ void load_row_bf16_b(const bf16* row, int lane, float (&v)[32]) {
#pragma unroll
    for (int j = 0; j < 4; ++j) { const u32x4 w = ((const u32x4*)row)[4 * lane + j];
        v[8 * j + 0] = bflo(w.x); v[8 * j + 1] = bfhi(w.x); v[8 * j + 2] = bflo(w.y); v[8 * j + 3] = bfhi(w.y);
        v[8 * j + 4] = bflo(w.z); v[8 * j + 5] = bfhi(w.z); v[8 * j + 6] = bflo(w.w); v[8 * j + 7] = bfhi(w.w); }
}
__device__ __forceinline__ void store_row_bf16_b(bf16* row, int lane, const float (&v)[32]) {
#pragma unroll
    for (int j = 0; j < 4; ++j) { u32x4 w; w.x = cvtpk(v[8 * j + 0], v[8 * j + 1]); w.y = cvtpk(v[8 * j + 2], v[8 * j + 3]); w.z = cvtpk(v[8 * j + 4], v[8 * j + 5]); w.w = cvtpk(v[8 * j + 6], v[8 * j + 7]);
        ((u32x4*)row)[4 * lane + j] = w; }
}
__device__ __forceinline__ void load_row_f32_b(const float* row, int lane, float (&v)[32]) {
#pragma unroll
    for (int q = 0; q < 8; ++q) { const f32x4 a = ((const f32x4*)row)[8 * lane + q];
        v[4 * q + 0] = a.x; v[4 * q + 1] = a.y; v[4 * q + 2] = a.z; v[4 * q + 3] = a.w; }
}
__device__ __forceinline__ void store_row_f32_b(float* row, int lane, const float (&v)[32]) {
#pragma unroll
    for (int q = 0; q < 8; ++q) ((f32x4*)row)[8 * lane + q] = (f32x4){v[4 * q + 0], v[4 * q + 1], v[4 * q + 2], v[4 * q + 3]};
}
__device__ __forceinline__ void ln_stats(const float (&v)[32], float& mean, float& rstd) {
    float s = 0.f;
#pragma unroll
    for (int i = 0; i < 32; ++i) s += v[i];
    mean = wave_sum(s) * (1.0f / DM);
    float q = 0.f;
#pragma unroll
    for (int i = 0; i < 32; ++i) { const float d = v[i] - mean; q += d * d; }
    rstd = 1.0f / sqrtf(wave_sum(q) * (1.0f / DM) + LN_EPS);
}
template <bool LAYB>
__device__ __forceinline__ void finish_row(float (&z)[32], const float* lng, const float* lnb, bf16* Xrow, const float* sh, const float* sc, bf16* Hrow, float* Orow, int lane) {
    float mean, rstd; ln_stats(z, mean, rstd);
    { float g[32], b[32]; if (LAYB) { load_row_f32_b(lng, lane, g); load_row_f32_b(lnb, lane, b); } else { load_row_f32(lng, lane, g); load_row_f32(lnb, lane, b); }
#pragma unroll
      for (int i = 0; i < 32; ++i) z[i] = (z[i] - mean) * rstd * g[i] + b[i]; }
    if (Xrow) { if (LAYB) store_row_bf16_b(Xrow, lane, z); else store_row_bf16(Xrow, lane, z); }
    if (Orow) { if (LAYB) store_row_f32_b(Orow, lane, z); else store_row_f32(Orow, lane, z); }
    if (Hrow) {
        ln_stats(z, mean, rstd);
        float a[32], s[32]; if (LAYB) { load_row_f32_b(sc, lane, a); load_row_f32_b(sh, lane, s); } else { load_row_f32(sc, lane, a); load_row_f32(sh, lane, s); }
#pragma unroll
        for (int i = 0; i < 32; ++i) a[i] = (z[i] - mean) * rstd * (1.0f + a[i]) + s[i];
        if (LAYB) store_row_bf16_b(Hrow, lane, a); else store_row_bf16(Hrow, lane, a);
    }
}
__device__ __forceinline__ int row_slot(int row) { return row < ML ? (row >> 13) : 2; }

__device__ __forceinline__ unsigned f2bf_rne(float f) { unsigned u = __float_as_uint(f); return (u + 0x7fffu + ((u >> 16) & 1u)) >> 16; }
__device__ __forceinline__ unsigned pk2(float lo, float hi) { return f2bf_rne(lo) | (f2bf_rne(hi) << 16); }
__device__ __forceinline__ void p0_transpose_item(const float* W, int K, int N, bf16* WT, LAS float* scr, int item, int lane) {
    const int nblk = N / 32, kb = item / nblk, nb = item % nblk, k0 = 64 * kb, n0 = 32 * nb;
    f32x4 t[8];
#pragma unroll
    for (int i = 0; i < 8; ++i) t[i] = *(const f32x4*)(W + (size_t)(k0 + 8 * i + (lane >> 3)) * N + n0 + 4 * (lane & 7));
#pragma unroll
    for (int i = 0; i < 8; ++i) { LAS float* d = scr + (8 * i + (lane >> 3)) * 33 + 4 * (lane & 7); d[0] = t[i].x; d[1] = t[i].y; d[2] = t[i].z; d[3] = t[i].w; }
    LDS_WAIT(); asm volatile("" ::: "memory");
    const int c = lane & 7;
#pragma unroll
    for (int j = 0; j < 4; ++j) { const int n = (lane >> 3) + 8 * j; const LAS float* s = scr + (8 * c) * 33 + n;
        u32x4 o; o.x = pk2(s[0 * 33], s[1 * 33]); o.y = pk2(s[2 * 33], s[3 * 33]); o.z = pk2(s[4 * 33], s[5 * 33]); o.w = pk2(s[6 * 33], s[7 * 33]);
        *(u32x4*)(WT + (size_t)(n0 + n) * K + k0 + 8 * c) = o; }
    LDS_WAIT(); asm volatile("" ::: "memory");
}
__device__ __forceinline__ void cvt_range(const float* src, bf16* dst, size_t n8, size_t gtid, size_t gthreads) {
#pragma unroll 4
    for (size_t i = gtid; i < n8; i += gthreads) { const f32x4 a = ((const f32x4*)src)[2 * i], b = ((const f32x4*)src)[2 * i + 1];
        u32x4 w; w.x = cvtpk(a.x, a.y); w.y = cvtpk(a.z, a.w); w.z = cvtpk(b.x, b.y); w.w = cvtpk(b.z, b.w); ((u32x4*)dst)[i] = w; }
}
__device__ __forceinline__ unsigned enc_e2m3(float x) {
    const unsigned sgn = (__float_as_uint(x) >> 26) & 32u;
    const float ax = fminf(fabsf(x), 7.5f);
    unsigned u = __float_as_uint(ax); u += 0x7FFFFu + ((u >> 20) & 1u);
    const unsigned cn = (u >> 20) - ((127u - 1u) << 3);
    const unsigned cs = (unsigned)__builtin_rintf(ax * 8.0f);
    return sgn | (ax < 1.0f ? cs : cn);
}
typedef float f32x16v __attribute__((ext_vector_type(16)));
typedef float f32x32v __attribute__((ext_vector_type(32)));
typedef unsigned u32x6v __attribute__((ext_vector_type(6)));
__device__ __forceinline__ u32x6v pack_fp6_32(const float (&e)[32], bool interleaved) {
    f32x16v s0, s1;
    if (interleaved) {
#pragma unroll
        for (int i = 0; i < 16; ++i) { s0[i] = e[2 * i]; s1[i] = e[2 * i + 1]; }
    } else {
#pragma unroll
        for (int i = 0; i < 16; ++i) { s0[i] = e[i]; s1[i] = e[16 + i]; }
    }
    return __builtin_amdgcn_cvt_scalef32_2xpk16_fp6_f32(s0, s1, 1.0f);
}
__device__ __forceinline__ void cvt_table_fp6(const float* src, unsigned char* dst, int nrows, float scale, LAS float* scr  , int lane, int gw, int NGW, const int isv) {
    bool interleaved;
    {
        float t[32];
#pragma unroll
        for (int k = 0; k < 32; ++k) t[k] = k < 16 ? 0.125f * k : (k < 24 ? 2.0f + 0.25f * (k - 16) : 4.0f + 0.5f * (k - 24));
        float tt[32];
#pragma unroll
        for (int k = 0; k < 32; ++k) { tt[k] = t[k]; asm volatile("" : "+v"(tt[k])); }
        const u32x6v p = pack_fp6_32(tt, true);
        const f32x32v o = __builtin_amdgcn_cvt_scalef32_pk32_f32_fp6(p, 1.0f);
        interleaved = (o[1] == t[1]) && (o[2] == t[2]) && (o[17] == t[17]);
        interleaved = __all(interleaved);
    }
    for (int row = gw; row < nrows; row += NGW) {
        const f32x4* s4 = (const f32x4*)(src + (size_t)row * 2048);
#pragma unroll
        for (int q = 0; q < 8; ++q) { const int s = 64 * q + lane; const f32x4 a = s4[s] * scale; *(LAS f32x4*)(scr + 4 * (s ^ ((s >> 4) & 7))) = a; }
        float e[32];
#pragma unroll
        for (int j = 0; j < 8; ++j) { const int s = 8 * lane + j; const f32x4 a = *(const LAS f32x4*)(scr + 4 * (s ^ ((s >> 4) & 7)));
            e[4 * j + 0] = __builtin_amdgcn_fmed3f(a.x, -7.5f, 7.5f); e[4 * j + 1] = __builtin_amdgcn_fmed3f(a.y, -7.5f, 7.5f); e[4 * j + 2] = __builtin_amdgcn_fmed3f(a.z, -7.5f, 7.5f); e[4 * j + 3] = __builtin_amdgcn_fmed3f(a.w, -7.5f, 7.5f); }
        const u32x6v p = pack_fp6_32(e, interleaved);
        unsigned char* rowp = dst + (size_t)row * PREC;
        *(u32x4*)(rowp + 1024 * isv + 16 * lane) = (u32x4){p[0], p[1], p[2], p[3]}; *(u32x2*)(rowp + 2048 + 512 * isv + 8 * lane) = (u32x2){p[4], p[5]};
    }
}
__device__ __forceinline__ float silu(float x) { return x / (1.0f + __expf(-x)); }

struct Params { const float* in[29]; float* out; unsigned char* ws; int ph_lo, ph_hi; };
typedef const __attribute__((address_space(4))) Params* CP;

__device__ __forceinline__ void p0_prologue(CP P, LAS unsigned char* lds, int tid, int lane, int wid, int gw, int NGW) {
    unsigned char* ws = P->ws;
    LAS float* scr = (LAS float*)(lds + wid * 16384);
    {
        constexpr int I_GMIN = (2048 / 64) * (4096 / 32), I_SQ = (2048 / 64) * (2048 / 32), I_MIN = (2048 / 64) * (1088 / 32), I_UQ = (512 / 64) * (3072 / 32), I_UKV = (512 / 64) * (4096 / 32), I_DIN = (2048 / 64) * (6144 / 32);
        constexpr int NIT = 2 * I_GMIN + 2 * I_SQ + 4 * I_SQ + I_MIN + I_UQ + I_UKV + I_SQ + I_DIN + I_SQ;
        for (int it = gw; it < NIT; it += NGW) {
            int r = it;
            if (r < 2 * I_GMIN) { const int j = r / I_GMIN; p0_transpose_item(P->in[13] + (size_t)j * 2048 * 4096, 2048, 4096, (bf16*)(ws + WS_GMWIN) + (size_t)j * 4096 * 2048, scr, r % I_GMIN, lane); continue; } r -= 2 * I_GMIN;
            if (r < 2 * I_SQ) { const int j = r / I_SQ; p0_transpose_item(P->in[18] + (size_t)j * 2048 * 2048, 2048, 2048, (bf16*)(ws + WS_GMWOUT) + (size_t)j * 2048 * 2048, scr, r % I_SQ, lane); continue; } r -= 2 * I_SQ;
            if (r < 4 * I_SQ) { const int j = r / I_SQ; p0_transpose_item(P->in[8] + (size_t)j * 2048 * 2048, 2048, 2048, (bf16*)(ws + WS_PWQ) + (size_t)j * 2048 * 2048, scr, r % I_SQ, lane); continue; } r -= 4 * I_SQ;
            if (r < I_MIN) { p0_transpose_item(P->in[19], 2048, 1088, (bf16*)(ws + WS_MLAIN), scr, r, lane); continue; } r -= I_MIN;
            if (r < I_UQ) { p0_transpose_item(P->in[22], 512, 3072, (bf16*)(ws + WS_MLAUQ), scr, r, lane); continue; } r -= I_UQ;
            if (r < I_UKV) { p0_transpose_item(P->in[23], 512, 4096, (bf16*)(ws + WS_MLAUKV), scr, r, lane); continue; } r -= I_UKV;
            if (r < I_SQ) { p0_transpose_item(P->in[24], 2048, 2048, (bf16*)(ws + WS_MLAOUT), scr, r, lane); continue; } r -= I_SQ;
            if (r < I_DIN) { p0_transpose_item(P->in[25], 2048, 6144, (bf16*)(ws + WS_DAIN), scr, r, lane); continue; } r -= I_DIN;
            p0_transpose_item(P->in[28], 2048, 2048, (bf16*)(ws + WS_DAOUT), scr, r, lane);
        }
    }
    const size_t gtid = (size_t)gw * 64 + lane, gthreads = (size_t)NGW * 64;
    { u32x4* z = (u32x4*)((bf16*)(ws + WS_MLAIN) + (size_t)1088 * 2048); const size_t n = (size_t)192 * 2048 / 8;
      for (size_t i = gtid; i < n; i += gthreads) z[i] = (u32x4){0u, 0u, 0u, 0u}; }
    cvt_range(P->in[16], (bf16*)(ws + WS_GMWS), (size_t)2 * 16 * 128 * 128 / 8, gtid, gthreads);
    cvt_range(P->in[9], (bf16*)(ws + WS_PK1), (size_t)4 * 128 * 128 / 8, gtid, gthreads);
    cvt_range(P->in[10], (bf16*)(ws + WS_PK2), (size_t)4 * 128 * 128 / 8, gtid, gthreads);
    cvt_table_fp6(P->in[11], ws + WS_PU, 16384, U_SCALE, scr, lane, gw, NGW, 0);
    cvt_table_fp6(P->in[12], ws + WS_PU, 16384, V_SCALE, scr, lane, gw, NGW, 1);
    if (gtid < 2048) { const int pos = (int)gtid >> 4, f = (int)gtid & 15; const float inv = powf(10000.0f, -(float)f * (1.0f / 16.0f)); float sn, cs; sincosf((float)pos * inv, &sn, &cs);
        float* rt = (float*)(ws + WS_ROPE); rt[gtid] = cs; rt[2048 + gtid] = sn; }
    {
        const float* cv = P->in[1]; const float* cc = P->in[3]; const float* mw = P->in[4]; float* PART = (float*)(ws + WS_MODP);
        for (int item = gw; item < 4 * 192 * 8; item += NGW) {
            const int ks = item & 7, r = item >> 3, L = r / 192, n = (r % 192) * 64 + lane;
            const float* W = mw + (size_t)L * 2048 * 12288 + (size_t)(ks * 256) * 12288 + n;
            float a0 = 0.f, a1 = 0.f, a2 = 0.f;
#pragma unroll 32
            for (int k = 0; k < 256; ++k) { const int kk = ks * 256 + k; const float s0 = silu(cv[kk]), s1 = silu(cv[2048 + kk]), s2 = silu(cc[kk]);
                const float w = W[(size_t)k * 12288]; a0 += s0 * w; a1 += s1 * w; a2 += s2 * w; }
            float* o = PART + ((size_t)ks * 4 + L) * 3 * 12288 + n;
            o[0] = a0; o[12288] = a1; o[24576] = a2;
        }
    }
}
__device__ __forceinline__ void mod_reduce(CP P, int gw, int lane, int NGW) {
    const float* PART = (const float*)(P->ws + WS_MODP); float* MOD = (float*)(P->ws + WS_MOD); const float* mb = P->in[5];
    for (int i = gw * 64 + lane; i < 4 * 3 * 12288; i += NGW * 64) {
        const int L = i / (3 * 12288), n = i % 12288;
        float s = mb[(size_t)L * 12288 + n];
#pragma unroll
        for (int ks = 0; ks < 8; ++ks) s += PART[(size_t)ks * 4 * 3 * 12288 + i];
        MOD[i] = s;
    }
}

__device__ __forceinline__ void first_row_pass(CP P, int lane, int gw, int NGW) {
    const float* MOD = (const float*)(P->ws + WS_MOD); bf16* X = (bf16*)(P->ws + WS_X); bf16* H = (bf16*)(P->ws + WS_H);
    for (int row = gw; row < MT; row += NGW) {
        const float* src = row < ML ? P->in[0] + (size_t)row * DM : P->in[2] + (size_t)(row - ML) * DM;
        float v[32]; load_row_f32(src, lane, v);
        store_row_bf16(X + (size_t)row * DM, lane, v);
        const float* mod = MOD + (size_t)row_slot(row) * 12288;
        float mean, rstd; ln_stats(v, mean, rstd);
        float a[32], s[32]; load_row_f32(mod + 2048, lane, a); load_row_f32(mod, lane, s);
#pragma unroll
        for (int i = 0; i < 32; ++i) a[i] = (v[i] - mean) * rstd * (1.0f + a[i]) + s[i];
        store_row_bf16(H + (size_t)row * DM, lane, a);
    }
}
__device__ __forceinline__ void post_mixer_pass(CP P, int L, int Mrows, int lane, int gw, int NGW) {
    const float* MOD = (const float*)(P->ws + WS_MOD); bf16* X = (bf16*)(P->ws + WS_X); bf16* H = (bf16*)(P->ws + WS_H); const bf16* Y = (const bf16*)(P->ws + WS_Y);
    const float* lng = P->in[6] + (size_t)(L * 2 + 0) * DM; const float* lnb = P->in[7] + (size_t)(L * 2 + 0) * DM;
    for (int row = gw; row < Mrows; row += NGW) {
        const float* mod = MOD + (size_t)(L * 3 + row_slot(row)) * 12288;
        float z[32], y[32], g[32]; load_row_bf16(X + (size_t)row * DM, lane, z); load_row_bf16(Y + (size_t)row * DM, lane, y); load_row_f32(mod + 2 * 2048, lane, g);
#pragma unroll
        for (int i = 0; i < 32; ++i) z[i] = ALPHA * z[i] + g[i] * y[i];
        finish_row<false>(z, lng, lnb, X + (size_t)row * DM, mod + 3 * 2048, mod + 4 * 2048, H + (size_t)row * DM, nullptr, lane);
    }
}
__device__ __forceinline__ void vstats_pass(CP P, int Mrows, int lane, int gw, int NGW) {
    const bf16* Z = (const bf16*)(P->ws + WS_Z); float* VST = (float*)(P->ws + WS_VST);
    for (int row = gw; row < Mrows; row += NGW) {
        float v[32]; load_row_bf16(Z + (size_t)row * 4096 + 2048, lane, v);
        float mean, rstd; ln_stats(v, mean, rstd);
        if (lane == 0) { VST[2 * row] = mean; VST[2 * row + 1] = rstd; }
    }
}
#define XB_TMO      128
#define XB_XCNT(j)  (256  + 64 * (j))
#define XB_XSUB(j)  (1280 + 64 * (j))
#define XB_XGEN(j)  (2304 + 64 * (j))
#define XB_TOP      3328
#define XB_TOPGEN   3392
#define XCD_BAR_WORDS 3456
#define XB_SPIN_CAP (1u << 18)

__device__ __forceinline__ unsigned xb_ld(unsigned* p)              { return __hip_atomic_load(p, __ATOMIC_RELAXED, __HIP_MEMORY_SCOPE_AGENT); }
__device__ __forceinline__ unsigned xb_add(unsigned* p, unsigned v) { return __hip_atomic_fetch_add(p, v, __ATOMIC_RELAXED, __HIP_MEMORY_SCOPE_AGENT); }
__device__ __forceinline__ unsigned xb_xcc_id() { return (unsigned)__builtin_amdgcn_s_getreg((3 << 11) | 20) & 0xFu; }
#define XB_SPIN(cond, bar) do { unsigned _sp = 0; while (cond) { __builtin_amdgcn_s_sleep(1); \
    if ((++_sp & 255u) == 0u) { if (xb_ld(&(bar)[XB_TMO])) break; if (_sp > XB_SPIN_CAP) { atomicAdd(&(bar)[XB_TMO], 1u); break; } } } } while (0)

struct XcdBarrier {
    unsigned* bar; unsigned x;
    volatile LAS unsigned* st;
};

__device__ __forceinline__ XcdBarrier xcd_barrier_post(unsigned* bar, volatile LAS unsigned* st, const bool t0) {
    XcdBarrier b; b.bar = bar; b.x = xb_xcc_id(); b.st = st;
    if (t0) (void)xb_add(&bar[XB_XCNT(b.x)], 1u);
    return b;
}
__device__ __forceinline__ void xcd_barrier_complete(unsigned* bar, unsigned x, unsigned& nloc, unsigned& nx) {
    const unsigned G = gridDim.x * gridDim.y * gridDim.z;
    unsigned sum, cnt, mine, sp = 0u;
    for (;;) {
        sum = 0u; cnt = 0u; mine = 0u;
#pragma unroll
        for (unsigned j = 0; j < 16; ++j) { const unsigned c = xb_ld(&bar[XB_XCNT(j)]); sum += c; cnt += (c > 0u) ? 1u : 0u; mine = (j == x) ? c : mine; }
        if (sum == G) break;
        __builtin_amdgcn_s_sleep(1);
        if ((++sp & 255u) == 0u) { if (xb_ld(&bar[XB_TMO])) break; if (sp > XB_SPIN_CAP) { atomicAdd(&bar[XB_TMO], 1u); break; } }
    }
    nloc = mine > 0u ? mine : 1u; nx = cnt > 0u ? cnt : 1u;
}

__device__ __attribute__((noinline)) void xcd_barrier(const XcdBarrier b, const bool t0) {
    asm volatile("s_waitcnt vmcnt(0)" ::: "memory");
    __syncthreads();
    if (t0) {
        unsigned* bar = b.bar;
        __builtin_amdgcn_s_waitcnt(0);
        unsigned nloc = b.st[0], nx = b.st[1];
        if (nloc == 0u) { xcd_barrier_complete(bar, b.x, nloc, nx); b.st[0] = nloc; b.st[1] = nx; }
        const unsigned old = xb_add(&bar[XB_XSUB(b.x)], 1u);
        const unsigned gen = old / nloc;
        if (old + 1u == (gen + 1u) * nloc) {
            __builtin_amdgcn_fence(__ATOMIC_RELEASE, "agent");
            asm volatile("s_waitcnt vmcnt(0)" ::: "memory");
            const unsigned og = xb_add(&bar[XB_TOP], 1u);
            const unsigned tg = og / nx;
            if (og + 1u == (tg + 1u) * nx) xb_add(&bar[XB_TOPGEN], 1u);
            else XB_SPIN(xb_ld(&bar[XB_TOPGEN]) == tg, bar);
            __builtin_amdgcn_fence(__ATOMIC_ACQUIRE, "agent");
            xb_add(&bar[XB_XGEN(b.x)], 1u);
            asm volatile("s_waitcnt vmcnt(0)" ::: "memory");
        } else {
            XB_SPIN(xb_ld(&bar[XB_XGEN(b.x)]) == gen, bar);
            __builtin_amdgcn_fence(__ATOMIC_ACQUIRE, "agent");
            asm volatile("s_waitcnt vmcnt(0)" ::: "memory");
        }
    }
    __syncthreads();
}

__device__ __forceinline__ void spatial_phase(CP P, int j, int Mrows, LAS unsigned char* lds_, int tid, int lane, int wid) {
    const bf16* Z = (const bf16*)(P->ws + WS_Z); const float* VST = (const float*)(P->ws + WS_VST); bf16* Gb = (bf16*)(P->ws + WS_G);
    const bf16* WS = (const bf16*)(P->ws + WS_GMWS) + (size_t)j * 16 * 128 * 128;
    const float* lng = P->in[14] + (size_t)j * DM; const float* lnb = P->in[15] + (size_t)j * DM; const float* bs = P->in[17] + (size_t)j * 16 * 128;
    LAS bf16* Vt = (LAS bf16*)(LAS unsigned char*)lds_;
    constexpr int VP = 136;
    const int nunits = (Mrows / 128) * 16;
    for (int u = blockIdx.x; u < nunits; u += gridDim.x) {
        const int c = u >> 4, g = u & 15;
        __syncthreads();
        {
            const int q = tid >> 2, dq = (tid & 3) * 32; const int row = c * 128 + q;
            const float mean = VST[2 * row], rstd = VST[2 * row + 1];
            const bf16* src = Z + (size_t)row * 4096 + 2048 + g * 128 + dq;
#pragma unroll
            for (int t = 0; t < 4; ++t) { const u32x4 w = *(const u32x4*)(src + 8 * t);
                float v[8] = {bflo(w.x), bfhi(w.x), bflo(w.y), bfhi(w.y), bflo(w.z), bfhi(w.z), bflo(w.w), bfhi(w.w)};
                const float* gp = lng + g * 128 + dq + 8 * t; const float* bp = lnb + g * 128 + dq + 8 * t;
#pragma unroll
                for (int i = 0; i < 8; ++i) { const float vn = (v[i] - mean) * rstd * gp[i] + bp[i]; Vt[(dq + 8 * t + i) * VP + q] = tobf1(vn); } }
        }
        __syncthreads();
        const int fr = lane & 15, fq = lane >> 4;
        bf16x8 a[4];
        const bf16* wrow = WS + (size_t)g * 128 * 128 + (size_t)(16 * wid + fr) * 128 + 8 * fq;
#pragma unroll
        for (int ks = 0; ks < 4; ++ks) a[ks] = *(const bf16x8*)(wrow + 32 * ks);
#pragma unroll
        for (int nb = 0; nb < 8; ++nb) {
            f32x4 acc = {0.f, 0.f, 0.f, 0.f};
#pragma unroll
            for (int ks = 0; ks < 4; ++ks) { const bf16x8 b = *(const LAS bf16x8*)(Vt + (16 * nb + fr) * VP + 32 * ks + 8 * fq);
                acc = __builtin_amdgcn_mfma_f32_16x16x32_bf16(a[ks], b, acc, 0, 0, 0); }
#pragma unroll
            for (int r = 0; r < 4; ++r) { const int p = 16 * wid + fq * 4 + r, d = 16 * nb + fr; const size_t grow = (size_t)(c * 128 + p);
                const float sv = acc[r] + bs[g * 128 + p];
                const float uu = bf1(Z[grow * 4096 + g * 128 + d]);
                Gb[grow * 2048 + g * 128 + d] = tobf1(uu * sv); }
        }
    }
}

__device__ __forceinline__ void rope_cs(int row, int l, float& cs, float& sn) {
    const int t = row & (SEQ - 1); const int pos = (l & 32) ? (t & 63) : (t >> 6);
    const float inv = powf(10000.0f, -(float)(l & 15) * (1.0f / 16.0f));
    const float ang = (float)pos * inv; sincosf(ang, &sn, &cs);
}
__device__ __forceinline__ float rope_apply(float x, int l, float cs, float sn) {
    const float p = lane_xor16(x, l);
    return (l & 16) ? (p * sn + x * cs) : (x * cs - p * sn);
}
__device__ __forceinline__ void mla_norm_pass(CP P, int lane, int gw, int NGW) {
    const bf16* C = (const bf16*)(P->ws + WS_C); bf16* CQN = (bf16*)(P->ws + WS_CQN); bf16* CKVN = (bf16*)(P->ws + WS_CKVN); bf16* KR = (bf16*)(P->ws + WS_KR);
    const float* qn = P->in[20]; const float* kvn = P->in[21];
    for (int row = gw; row < MT; row += NGW) {
        const bf16* c = C + (size_t)row * 1280;
#pragma unroll
        for (int part = 0; part < 2; ++part) {
            const u32x4 w = *(const u32x4*)(c + part * 512 + 8 * lane);
            float v[8] = {bflo(w.x), bfhi(w.x), bflo(w.y), bfhi(w.y), bflo(w.z), bfhi(w.z), bflo(w.w), bfhi(w.w)};
            float ss = 0.f;
#pragma unroll
            for (int i = 0; i < 8; ++i) ss += v[i] * v[i];
            const float r = 1.0f / sqrtf(wave_sum(ss) * (1.0f / 512.0f) + LN_EPS);
            const float* nw = (part ? kvn : qn) + 8 * lane;
            u32x4 o; o.x = cvtpk(v[0] * r * nw[0], v[1] * r * nw[1]); o.y = cvtpk(v[2] * r * nw[2], v[3] * r * nw[3]); o.z = cvtpk(v[4] * r * nw[4], v[5] * r * nw[5]); o.w = cvtpk(v[6] * r * nw[6], v[7] * r * nw[7]);
            *(u32x4*)((part ? CKVN : CQN) + (size_t)row * 512 + 8 * lane) = o;
        }
        float x = bf1(c[1024 + lane]);
        if (row < ML) { float cs, sn; rope_cs(row, lane, cs, sn); x = rope_apply(x, lane, cs, sn); }
        KR[(size_t)row * 64 + lane] = tobf1(x);
    }
}
__device__ __forceinline__ void rope_pass(bf16* buf, int ld, int col0, int nchunks, int cstride, int lane, int gw, int NGW) {
    for (int row = gw; row < ML; row += NGW) {
        float cs, sn; rope_cs(row, lane, cs, sn);
        bf16* r = buf + (size_t)row * ld + col0 + lane;
#pragma unroll 4
        for (int k = 0; k < nchunks; ++k) { const float x = bf1(r[k * cstride]); r[k * cstride] = tobf1(rope_apply(x, lane, cs, sn)); }
    }
}

namespace att {
#ifndef ATT_LEAN
#define ATT_LEAN 1
#endif
#ifndef ATT_3STAGE
#define ATT_3STAGE 0
#endif
#ifndef ATT_TRB
#define ATT_TRB 1
#endif
#ifndef ATT_STAGGER
#define ATT_STAGGER 0
#endif
#ifndef ATT_SDEPTH
#define ATT_SDEPTH(MODE) ((MODE) == 0 ? 1 : 1)
#endif
#ifndef ATT_PVPIPE
#define ATT_PVPIPE(MODE) ((MODE) == 1)
#endif
#define SBAR() __builtin_amdgcn_sched_barrier(0)
__device__ __forceinline__ int crow(int r, int hi) { return (r & 3) + 8 * (r >> 2) + 4 * hi; }
__device__ __forceinline__ unsigned cvtpkv(float lo, float hi) { unsigned r; asm volatile("v_cvt_pk_bf16_f32 %0, %1, %2" : "=v"(r) : "v"(lo), "v"(hi)); return r; }

__device__ __forceinline__ void partialSM(f32x16& p0, f32x16& p1, float& m_reg, float& mn, float& alpha, const float C, const float THRS) {
  float pmax = p0[0];
#pragma unroll
  for (int r = 1; r < 16; ++r) pmax = fmaxf(pmax, p0[r]);
#pragma unroll
  for (int r = 0; r < 16; ++r) pmax = fmaxf(pmax, p1[r]);
  { auto rr = __builtin_amdgcn_permlane32_swap(__float_as_uint(pmax), __float_as_uint(pmax), false, false);
    pmax = fmaxf(__uint_as_float(rr[0]), __uint_as_float(rr[1])); }
  if (__builtin_expect(__all(pmax - m_reg <= THRS), 1)) { mn = m_reg; alpha = 1.f; }
  else { mn = fmaxf(m_reg, pmax); alpha = __builtin_amdgcn_exp2f((m_reg - mn) * C); m_reg = mn; }
  const float mnC = -mn * C;
#pragma unroll
  for (int r = 0; r < 16; ++r) p0[r] = fmaf(p0[r], C, mnC);
#pragma unroll
  for (int r = 0; r < 16; ++r) p1[r] = fmaf(p1[r], C, mnC);
#pragma unroll
  for (int r = 0; r < 16; ++r) p0[r] = __builtin_amdgcn_exp2f(p0[r]);
}
__device__ __forceinline__ void finishSM(f32x16& p0, f32x16& p1, float alpha, float& l_reg, bf16x8& pa0, bf16x8& pa1, bf16x8& pa2, bf16x8& pa3) {
#pragma unroll
  for (int r = 0; r < 16; ++r) p1[r] = __builtin_amdgcn_exp2f(p1[r]);
  float ps = 0;
#pragma unroll
  for (int r = 0; r < 16; ++r) ps += p0[r];
#pragma unroll
  for (int r = 0; r < 16; ++r) ps += p1[r];
  { auto rr = __builtin_amdgcn_permlane32_swap(__float_as_uint(ps), __float_as_uint(ps), false, false);
    ps = __uint_as_float(rr[0]) + __uint_as_float(rr[1]); }
  l_reg = l_reg * alpha + ps;
#define PK4(P, BASE, OUT) do { unsigned a0 = cvtpkv(P[BASE + 0], P[BASE + 1]), a1 = cvtpkv(P[BASE + 2], P[BASE + 3]);   \
    unsigned b0 = cvtpkv(P[BASE + 4], P[BASE + 5]), b1 = cvtpkv(P[BASE + 6], P[BASE + 7]);                              \
    auto r0 = __builtin_amdgcn_permlane32_swap(a0, b0, false, false); auto r1 = __builtin_amdgcn_permlane32_swap(a1, b1, false, false); \
    u32x4 w = {r0[0], r1[0], r0[1], r1[1]}; OUT = *reinterpret_cast<bf16x8*>(&w); } while (0)
  PK4(p0, 0, pa0); PK4(p0, 8, pa1); PK4(p1, 0, pa2); PK4(p1, 8, pa3);
#undef PK4
}
__device__ __forceinline__ void partialSM_lean(f32x16& p0, f32x16& p1, f32x16& nm, float& alpha, const bool first) {
  constexpr float THR2 = 11.541560327111707f;
  float dmax = p0[0];
#pragma unroll
  for (int r = 1; r < 16; ++r) dmax = fmaxf(dmax, p0[r]);
#pragma unroll
  for (int r = 0; r < 16; ++r) dmax = fmaxf(dmax, p1[r]);
  { auto rr = __builtin_amdgcn_permlane32_swap(__float_as_uint(dmax), __float_as_uint(dmax), false, false);
    dmax = fmaxf(__uint_as_float(rr[0]), __uint_as_float(rr[1])); }
  alpha = 1.f;
  if (first || !__all(dmax <= THR2)) {
    const float delta = first ? dmax : (dmax > THR2 ? dmax : 0.f);
    if (!first) alpha = __builtin_amdgcn_exp2f(-delta);
#pragma unroll
    for (int r = 0; r < 16; ++r) { p0[r] -= delta; p1[r] -= delta; nm[r] -= delta; }
  }
#pragma unroll
  for (int r = 0; r < 16; ++r) p0[r] = __builtin_amdgcn_exp2f(p0[r]);
}
__device__ __forceinline__ void finishSM_lean(f32x16& p0, f32x16& p1, bf16x8& pa0, bf16x8& pa1, bf16x8& pa2, bf16x8& pa3) {
#pragma unroll
  for (int r = 0; r < 16; ++r) p1[r] = __builtin_amdgcn_exp2f(p1[r]);
#define PK4(P, BASE, OUT) do { unsigned a0 = cvtpkv(P[BASE + 0], P[BASE + 1]), a1 = cvtpkv(P[BASE + 2], P[BASE + 3]);   \
    unsigned b0 = cvtpkv(P[BASE + 4], P[BASE + 5]), b1 = cvtpkv(P[BASE + 6], P[BASE + 7]);                              \
    auto r0 = __builtin_amdgcn_permlane32_swap(a0, b0, false, false); auto r1 = __builtin_amdgcn_permlane32_swap(a1, b1, false, false); \
    u32x4 w = {r0[0], r1[0], r0[1], r1[1]}; OUT = *reinterpret_cast<bf16x8*>(&w); } while (0)
  PK4(p0, 0, pa0); PK4(p0, 8, pa1); PK4(p1, 0, pa2); PK4(p1, 8, pa3);
#undef PK4
}
__device__ __forceinline__ bf16x8 scale_bf16x8(bf16x8 v, float c) {
  const u32x4 w = *reinterpret_cast<u32x4*>(&v); u32x4 o;
  o.x = cvtpk(bflo(w.x) * c, bfhi(w.x) * c); o.y = cvtpk(bflo(w.y) * c, bfhi(w.y) * c); o.z = cvtpk(bflo(w.z) * c, bfhi(w.z) * c); o.w = cvtpk(bflo(w.w) * c, bfhi(w.w) * c);
  return *reinterpret_cast<bf16x8*>(&o);
}
template <int PITCH> __device__ __forceinline__ int kswz(int r) { return PITCH == 256 ? (r & 15) : ((r >> 1) & 7); }
template <int NQF, int NQR, int PITCH> __device__ __forceinline__ void qkt(f32x16& p0, f32x16& p1, const LAS char* Ks, int chunk0, const bf16x8* qr, const LAS char* ql, int r32, int hi, const f32x16 init = f32x16{}) {
  p0 = init; p1 = init;
  const int sw = kswz<PITCH>(r32);
#pragma unroll
  for (int d0 = 0; d0 < NQF; ++d0) { const int off = ((chunk0 + d0 * 2 + hi) ^ sw) * 16;
    const bf16x8 b0 = *(const LAS bf16x8*)(Ks + r32 * PITCH + off);
    const bf16x8 b1 = *(const LAS bf16x8*)(Ks + (32 + r32) * PITCH + off);
    const bf16x8 q = d0 < NQR ? qr[d0 < NQR ? d0 : 0] : *(const LAS bf16x8*)(ql + (d0 - NQR < 0 ? 0 : d0 - NQR) * 1024);
    p0 = __builtin_amdgcn_mfma_f32_32x32x16_bf16(b0, q, p0, 0, 0, 0);
    p1 = __builtin_amdgcn_mfma_f32_32x32x16_bf16(b1, q, p1, 0, 0, 0); }
}
__device__ __forceinline__ int v_st(int k, int c) { const int kk = (k & ~0xC) | ((k & 4) << 1) | ((k & 8) >> 1); return ((kk >> 3) * 4 + (c >> 5)) * 512 + ((kk & 7) * 32 + (c & 31)) * 2; }
__device__ __forceinline__ int v_rd_base(int lane) { return ((lane & 3) << 3) | (((lane >> 2) & 3) << 6) | (((lane >> 4) & 1) << 5) | (((lane >> 5) & 1) << 8); }
constexpr int v_rd_off(int d0, int ks, int half) { return d0 * 512 + ks * 4096 + half * 2048; }
template <int OFF> __device__ __forceinline__ s16x4 tr_read(int vb) {
  s16x4 r; asm volatile("ds_read_b64_tr_b16 %0, %1 offset:%2" : "=&v"(r) : "v"(vb), "i"(OFF) : "memory"); return r;
}
template <int D0> __device__ __forceinline__ void pv_one(f32x16& od, int vb, bf16x8 pa0, bf16x8 pa1, bf16x8 pa2, bf16x8 pa3) {
  const s16x4 l0 = tr_read<v_rd_off(D0, 0, 0)>(vb), h0 = tr_read<v_rd_off(D0, 0, 1)>(vb), l1 = tr_read<v_rd_off(D0, 1, 0)>(vb), h1 = tr_read<v_rd_off(D0, 1, 1)>(vb);
  const s16x4 l2 = tr_read<v_rd_off(D0, 2, 0)>(vb), h2 = tr_read<v_rd_off(D0, 2, 1)>(vb), l3 = tr_read<v_rd_off(D0, 3, 0)>(vb), h3 = tr_read<v_rd_off(D0, 3, 1)>(vb);
  asm volatile("s_waitcnt lgkmcnt(0)" ::: "memory"); SBAR();
#define PK(L, H) (bf16x8){L[0], L[1], L[2], L[3], H[0], H[1], H[2], H[3]}
  od = __builtin_amdgcn_mfma_f32_32x32x16_bf16(pa0, PK(l0, h0), od, 0, 0, 0);
  od = __builtin_amdgcn_mfma_f32_32x32x16_bf16(pa1, PK(l1, h1), od, 0, 0, 0);
  od = __builtin_amdgcn_mfma_f32_32x32x16_bf16(pa2, PK(l2, h2), od, 0, 0, 0);
  od = __builtin_amdgcn_mfma_f32_32x32x16_bf16(pa3, PK(l3, h3), od, 0, 0, 0);
#undef PK
}
__device__ __forceinline__ void pv_d0(f32x16* o, int vb, bf16x8 pa0, bf16x8 pa1, bf16x8 pa2, bf16x8 pa3) {
  pv_one<0>(o[0], vb, pa0, pa1, pa2, pa3); pv_one<1>(o[1], vb, pa0, pa1, pa2, pa3); pv_one<2>(o[2], vb, pa0, pa1, pa2, pa3); pv_one<3>(o[3], vb, pa0, pa1, pa2, pa3);
}
struct VFrag { s16x4 l0, h0, l1, h1, l2, h2, l3, h3; };
typedef short v4i16_t __attribute__((ext_vector_type(4)));
template <int OFF> __device__ __forceinline__ s16x4 tr_read_b(int vb) {
  return __builtin_bit_cast(s16x4, __builtin_amdgcn_ds_read_tr16_b64_v4i16((LAS v4i16_t*)(uintptr_t)(unsigned)(vb + OFF)));
}
template <int D0> __device__ __forceinline__ void tr8b(VFrag& f, int vb) {
  f.l0 = tr_read_b<v_rd_off(D0, 0, 0)>(vb); f.h0 = tr_read_b<v_rd_off(D0, 0, 1)>(vb); f.l1 = tr_read_b<v_rd_off(D0, 1, 0)>(vb); f.h1 = tr_read_b<v_rd_off(D0, 1, 1)>(vb);
  f.l2 = tr_read_b<v_rd_off(D0, 2, 0)>(vb); f.h2 = tr_read_b<v_rd_off(D0, 2, 1)>(vb); f.l3 = tr_read_b<v_rd_off(D0, 3, 0)>(vb); f.h3 = tr_read_b<v_rd_off(D0, 3, 1)>(vb);
}
template <int D0> __device__ __forceinline__ void tr8(VFrag& f, int vb) {
  f.l0 = tr_read<v_rd_off(D0, 0, 0)>(vb); f.h0 = tr_read<v_rd_off(D0, 0, 1)>(vb); f.l1 = tr_read<v_rd_off(D0, 1, 0)>(vb); f.h1 = tr_read<v_rd_off(D0, 1, 1)>(vb);
  f.l2 = tr_read<v_rd_off(D0, 2, 0)>(vb); f.h2 = tr_read<v_rd_off(D0, 2, 1)>(vb); f.l3 = tr_read<v_rd_off(D0, 3, 0)>(vb); f.h3 = tr_read<v_rd_off(D0, 3, 1)>(vb);
}
__device__ __forceinline__ void mfma4(f32x16& od, VFrag& f, bf16x8 pa0, bf16x8 pa1, bf16x8 pa2, bf16x8 pa3) {
#define PK(L, H) (bf16x8){L[0], L[1], L[2], L[3], H[0], H[1], H[2], H[3]}
  od = __builtin_amdgcn_mfma_f32_32x32x16_bf16(pa0, PK(f.l0, f.h0), od, 0, 0, 0);
  od = __builtin_amdgcn_mfma_f32_32x32x16_bf16(pa1, PK(f.l1, f.h1), od, 0, 0, 0);
  od = __builtin_amdgcn_mfma_f32_32x32x16_bf16(pa2, PK(f.l2, f.h2), od, 0, 0, 0);
  od = __builtin_amdgcn_mfma_f32_32x32x16_bf16(pa3, PK(f.l3, f.h3), od, 0, 0, 0);
#undef PK
}
#define VF_TIE(f) "+v"(f.l0), "+v"(f.h0), "+v"(f.l1), "+v"(f.h1), "+v"(f.l2), "+v"(f.h2), "+v"(f.l3), "+v"(f.h3)
__device__ __forceinline__ void pv_pipe(f32x16* o, int vb, bf16x8 pa0, bf16x8 pa1, bf16x8 pa2, bf16x8 pa3) {
  VFrag A, B;
  asm volatile("s_waitcnt lgkmcnt(0)" ::: "memory");
  tr8<0>(A, vb); tr8<1>(B, vb);
  asm volatile("s_waitcnt lgkmcnt(8)" : VF_TIE(A) :: "memory");
  mfma4(o[0], A, pa0, pa1, pa2, pa3);
  tr8<2>(A, vb);
  asm volatile("s_waitcnt lgkmcnt(8)" : VF_TIE(B) :: "memory");
  mfma4(o[1], B, pa0, pa1, pa2, pa3);
  tr8<3>(B, vb);
  asm volatile("s_waitcnt lgkmcnt(8)" : VF_TIE(A) :: "memory");
  mfma4(o[2], A, pa0, pa1, pa2, pa3);
  asm volatile("s_waitcnt lgkmcnt(0)" : VF_TIE(B) :: "memory");
  mfma4(o[3], B, pa0, pa1, pa2, pa3);
}
__device__ __forceinline__ void pv_psm_lean(f32x16* o, int vb, bf16x8 pa0, bf16x8 pa1, bf16x8 pa2, bf16x8 pa3, f32x16& p0, f32x16& p1, f32x16& nm, float& alpha) {
  constexpr float THR2 = 11.541560327111707f;
  const bf16x8 one8 = {0x3F80, 0x3F80, 0x3F80, 0x3F80, 0x3F80, 0x3F80, 0x3F80, 0x3F80};
  VFrag A, B;
  asm volatile("s_waitcnt lgkmcnt(0)" ::: "memory");
  tr8<0>(A, vb); tr8<1>(B, vb);
  asm volatile("s_waitcnt lgkmcnt(8)" : VF_TIE(A) :: "memory");
  mfma4(o[0], A, pa0, pa1, pa2, pa3);
  float dmax = p0[0];
#pragma unroll
  for (int r = 1; r < 16; ++r) dmax = fmaxf(dmax, p0[r]);
  tr8<2>(A, vb);
  asm volatile("s_waitcnt lgkmcnt(8)" : VF_TIE(B) :: "memory");
  mfma4(o[1], B, pa0, pa1, pa2, pa3);
#pragma unroll
  for (int r = 0; r < 16; ++r) dmax = fmaxf(dmax, p1[r]);
  { auto rr = __builtin_amdgcn_permlane32_swap(__float_as_uint(dmax), __float_as_uint(dmax), false, false);
    dmax = fmaxf(__uint_as_float(rr[0]), __uint_as_float(rr[1])); }
  alpha = 1.f;
  if (!__all(dmax <= THR2)) {
    const float delta = dmax > THR2 ? dmax : 0.f; alpha = __builtin_amdgcn_exp2f(-delta);
#pragma unroll
    for (int r = 0; r < 16; ++r) { p0[r] -= delta; p1[r] -= delta; nm[r] -= delta; }
  }
  tr8<3>(B, vb);
  asm volatile("s_waitcnt lgkmcnt(8)" : VF_TIE(A) :: "memory");
  mfma4(o[2], A, pa0, pa1, pa2, pa3);
#pragma unroll
  for (int r = 0; r < 8; ++r) p0[r] = __builtin_amdgcn_exp2f(p0[r]);
  asm volatile("s_waitcnt lgkmcnt(0)" : VF_TIE(B) :: "memory");
  mfma4(o[3], B, pa0, pa1, pa2, pa3);
#pragma unroll
  for (int r = 8; r < 16; ++r) p0[r] = __builtin_amdgcn_exp2f(p0[r]);
  o[4] = __builtin_amdgcn_mfma_f32_32x32x16_bf16(pa0, one8, o[4], 0, 0, 0); o[4] = __builtin_amdgcn_mfma_f32_32x32x16_bf16(pa1, one8, o[4], 0, 0, 0);
  o[4] = __builtin_amdgcn_mfma_f32_32x32x16_bf16(pa2, one8, o[4], 0, 0, 0); o[4] = __builtin_amdgcn_mfma_f32_32x32x16_bf16(pa3, one8, o[4], 0, 0, 0);
}
__device__ __forceinline__ void pv_psm_lean_b(f32x16* o, int vb, bf16x8 pa0, bf16x8 pa1, bf16x8 pa2, bf16x8 pa3, f32x16& p0, f32x16& p1, f32x16& nm, float& alpha) {
  constexpr float THR2 = 11.541560327111707f;
  const bf16x8 one8 = {0x3F80, 0x3F80, 0x3F80, 0x3F80, 0x3F80, 0x3F80, 0x3F80, 0x3F80};
  VFrag A, B;
  tr8b<0>(A, vb); tr8b<1>(B, vb);
  mfma4(o[0], A, pa0, pa1, pa2, pa3);
  float dmax = p0[0];
#pragma unroll
  for (int r = 1; r < 16; ++r) dmax = fmaxf(dmax, p0[r]);
  tr8b<2>(A, vb);
  mfma4(o[1], B, pa0, pa1, pa2, pa3);
#pragma unroll
  for (int r = 0; r < 16; ++r) dmax = fmaxf(dmax, p1[r]);
  { auto rr = __builtin_amdgcn_permlane32_swap(__float_as_uint(dmax), __float_as_uint(dmax), false, false);
    dmax = fmaxf(__uint_as_float(rr[0]), __uint_as_float(rr[1])); }
  alpha = 1.f;
  if (!__all(dmax <= THR2)) {
    const float delta = dmax > THR2 ? dmax : 0.f; alpha = __builtin_amdgcn_exp2f(-delta);
#pragma unroll
    for (int r = 0; r < 16; ++r) { p0[r] -= delta; p1[r] -= delta; nm[r] -= delta; }
  }
  tr8b<3>(B, vb);
  mfma4(o[2], A, pa0, pa1, pa2, pa3);
#pragma unroll
  for (int r = 0; r < 8; ++r) p0[r] = __builtin_amdgcn_exp2f(p0[r]);
  mfma4(o[3], B, pa0, pa1, pa2, pa3);
#pragma unroll
  for (int r = 8; r < 16; ++r) p0[r] = __builtin_amdgcn_exp2f(p0[r]);
  o[4] = __builtin_amdgcn_mfma_f32_32x32x16_bf16(pa0, one8, o[4], 0, 0, 0); o[4] = __builtin_amdgcn_mfma_f32_32x32x16_bf16(pa1, one8, o[4], 0, 0, 0);
  o[4] = __builtin_amdgcn_mfma_f32_32x32x16_bf16(pa2, one8, o[4], 0, 0, 0); o[4] = __builtin_amdgcn_mfma_f32_32x32x16_bf16(pa3, one8, o[4], 0, 0, 0);
}
__device__ __forceinline__ bf16x8 ld8(const bf16* p) { return *reinterpret_cast<const bf16x8*>(p); }

template <int MODE, int ATTV = 0>
__device__ __forceinline__ void attn_unit(const bf16* __restrict__ Qrow0, int ldq, const bf16* __restrict__ Kb, const bf16* __restrict__ Vb, int ldk, const bf16* __restrict__ KRb,
                                          int b, int nct, int NT, bf16* __restrict__ Ob, float lam, const float* __restrict__ subln, float oscale, LAS unsigned char* lds_, const int tid_in) {
  constexpr bool LEAN = (MODE == 1) && ATT_LEAN; constexpr int NQF = MODE == 0 ? 12 : 4, NQR = MODE == 0 ? 4 : 0, NOB = LEAN ? 5 : 4, PITCH = MODE == 0 ? 384 : 256, SHM_V = 16384, SHM_K = 64 * PITCH, SDEPTH = ATT_SDEPTH(MODE); constexpr bool PVPIPE = ATT_PVPIPE(MODE);
  const float SCALE = MODE == 0 ? 0.07216878364870323f : 0.125f;
  const float C = SCALE * 1.4426950408889634f, THRS = 8.f / SCALE;
  const int tid = launder_v(tid_in) & 511, wid = tid >> 6, lane = tid & 63, r32 = lane & 31, hi = lane >> 5;
  LAS char* lds = (LAS char*)(LAS unsigned char*)lds_;
  constexpr bool THREE = (MODE == 1) && ATT_3STAGE; constexpr int NSTG = THREE ? 3 : 2, STG = SHM_V + SHM_K, SCR0 = NSTG * STG;
#define VOFF(s) (!THREE ? (s) * SHM_V : (s) * STG)
#define KOFF(s) (!THREE ? 2 * SHM_V + (s) * SHM_K : (s) * STG + SHM_V)
  LAS char* V_lds = lds; LAS char* K_lds = lds;
  LAS float* wsf = (LAS float*)(lds + NSTG * (SHM_V + SHM_K)) + wid * 64; LAS float* li_l = wsf; LAS float* al_l = wsf + 32;
  const int wq = MODE == 0 ? wid : (wid & 3), sgrp = MODE == 0 ? 0 : (wid >> 2);
  float m_reg = -1e30f, l_reg = 0; f32x16 o[NOB] = {}; bf16x8 qr[NQR > 0 ? NQR : 1]; f32x16 nm = {};
  LAS char* ql = lds + SCR0 + 2048 + wid * (MODE == 0 ? 8192 : 4096) + lane * 16;
  const bf16* Qw = Qrow0 + (size_t)(wq * 32 + r32) * ldq + sgrp * 64 + hi * 8;
#pragma unroll
  for (int d0 = 0; d0 < NQR; ++d0) qr[d0] = ld8(Qw + d0 * 16);
#pragma unroll
  for (int d0 = NQR; d0 < NQF; ++d0) { bf16x8 qv = ld8(Qw + d0 * 16); if (LEAN) qv = scale_bf16x8(qv, C); *(LAS bf16x8*)(ql + (d0 - NQR) * 1024) = qv; }
  const int sr = tid >> 4, sc = (tid & 15) * 8, vst0 = v_st(sr, sc), vst1 = v_st(32 + sr, sc);
  const int kst0 = sr * PITCH + (((tid & 15) ^ kswz<PITCH>(sr)) * 16), kst1 = kst0 + 32 * PITCH;
  const int rrow = tid >> 3, krs = rrow * PITCH + (((16 + (tid & 7)) ^ kswz<PITCH>(rrow)) * 16);
  const int chunk0 = sgrp * 8;
  const int vb0 = (int)(uintptr_t)V_lds + v_rd_base(lane);
  struct Slot { bf16x8 vs0, vs1, ks0, ks1, kr; } sr_[SDEPTH];
#define KROW(jt) ((jt) < nct ? (ML + b * CTXL + (jt) * 64) : (b * SEQ + ((jt) - nct) * 64))
#define SLOAD(i, jt) do { const int k0_ = KROW(jt); sr_[i].vs0 = ld8(Vb + (size_t)(k0_ + sr) * ldk + sc); sr_[i].vs1 = ld8(Vb + (size_t)(k0_ + 32 + sr) * ldk + sc); \
    sr_[i].ks0 = ld8(Kb + (size_t)(k0_ + sr) * ldk + sc); sr_[i].ks1 = ld8(Kb + (size_t)(k0_ + 32 + sr) * ldk + sc); \
    if (MODE == 0) sr_[i].kr = ld8(KRb + (size_t)(k0_ + rrow) * 64 + (tid & 7) * 8); } while (0)
#define SWRITE(bf, i) do { *(LAS bf16x8*)(V_lds + VOFF(bf) + vst0) = sr_[i].vs0; *(LAS bf16x8*)(V_lds + VOFF(bf) + vst1) = sr_[i].vs1; \
    *(LAS bf16x8*)(K_lds + KOFF(bf) + kst0) = sr_[i].ks0; *(LAS bf16x8*)(K_lds + KOFF(bf) + kst1) = sr_[i].ks1; \
    if (MODE == 0) *(LAS bf16x8*)(K_lds + KOFF(bf) + krs) = sr_[i].kr; } while (0)
#define SWAIT() do { if constexpr (SDEPTH == 2) asm volatile("s_waitcnt vmcnt(4)" ::: "memory"); else asm volatile("s_waitcnt vmcnt(0)" ::: "memory"); } while (0)
#define RESC(a) do { if (__any((a) < 1.f)) { if (hi == 0) al_l[r32] = (a); asm volatile("s_waitcnt lgkmcnt(0)" ::: "memory"); \
    _Pragma("unroll") for (int d = 0; d < NOB; ++d) _Pragma("unroll") for (int r = 0; r < 16; ++r) o[d][r] *= al_l[crow(r, hi)]; } } while (0)
#define PV(vb_) do { if constexpr (ATTV == 2) { o[0][0] += __uint_as_float((unsigned)pa0[0] + (unsigned)pa3[1]); } else if constexpr (PVPIPE) pv_pipe(o, (vb_), pa0, pa1, pa2, pa3); else pv_d0(o, (vb_), pa0, pa1, pa2, pa3); \
    if constexpr (LEAN) { const bf16x8 one8 = {0x3F80, 0x3F80, 0x3F80, 0x3F80, 0x3F80, 0x3F80, 0x3F80, 0x3F80};     \
        o[NOB - 1] = __builtin_amdgcn_mfma_f32_32x32x16_bf16(pa0, one8, o[NOB - 1], 0, 0, 0); o[NOB - 1] = __builtin_amdgcn_mfma_f32_32x32x16_bf16(pa1, one8, o[NOB - 1], 0, 0, 0); \
        o[NOB - 1] = __builtin_amdgcn_mfma_f32_32x32x16_bf16(pa2, one8, o[NOB - 1], 0, 0, 0); o[NOB - 1] = __builtin_amdgcn_mfma_f32_32x32x16_bf16(pa3, one8, o[NOB - 1], 0, 0, 0); } } while (0)
#define PSM(p0_, p1_, mn_, al_, first_) do { if constexpr (ATTV == 1) { al_ = 1.f; } else if constexpr (LEAN) partialSM_lean(p0_, p1_, nm, al_, first_); else partialSM(p0_, p1_, m_reg, mn_, al_, C, THRS); } while (0)
#define FSM(p0_, p1_, al_) do { if constexpr (ATTV == 1) { u32x4 w0_ = {__float_as_uint(p0_[0]), __float_as_uint(p0_[1]), __float_as_uint(p1_[0]), __float_as_uint(p1_[1])}; pa0 = pa1 = pa2 = pa3 = *reinterpret_cast<bf16x8*>(&w0_); } else if constexpr (LEAN) finishSM_lean(p0_, p1_, pa0, pa1, pa2, pa3); else finishSM(p0_, p1_, al_, l_reg, pa0, pa1, pa2, pa3); } while (0)
#define QKT(p0_, p1_, Kp_) do { if constexpr (ATTV == 5) { p0_ = nm; p1_ = nm; p0_[0] += (float)r32; } else if constexpr (LEAN) qkt<NQF, NQR, PITCH>(p0_, p1_, Kp_, chunk0, qr, ql, r32, hi, nm); else qkt<NQF, NQR, PITCH>(p0_, p1_, Kp_, chunk0, qr, ql, r32, hi); } while (0)
  f32x16 pA0, pA1, pB0, pB1; float mnA, mnB, alA, alB; bf16x8 pa0, pa1, pa2, pa3;
  if constexpr (!THREE) {
  constexpr int SE = 0, SO = SDEPTH - 1;
  SLOAD(SE, 0); asm volatile("s_waitcnt vmcnt(0)" ::: "memory"); SWRITE(0, SE); __syncthreads();
  QKT(pA0, pA1, K_lds + KOFF(0)); PSM(pA0, pA1, mnA, alA, true);
  SLOAD(SO, 1); if constexpr (SDEPTH == 2) { if (2 < NT) SLOAD(SE, 2); }
  SWAIT(); SWRITE(1, SO); __syncthreads();
#define ILV() do { if constexpr (PVPIPE) { _Pragma("unroll") for (int i_ = 0; i_ < 20; ++i_) { __builtin_amdgcn_sched_group_barrier(0x008, 1, 0); __builtin_amdgcn_sched_group_barrier(0x002, 5, 0); } } } while (0)
#define LSLOAD(i, jt) do { if constexpr (ATTV != 3) SLOAD(i, jt); } while (0)
#define LSWRITE(bf, i) do { if constexpr (ATTV != 3) SWRITE(bf, i); } while (0)
#define LSWAIT() do { if constexpr (ATTV != 3) SWAIT(); } while (0)
#define LSYNC() do { if constexpr (ATTV != 4) __syncthreads(); } while (0)
#define HALFSTEP(PC0, PC1, MNC, ALC, PP0, PP1, ALP, KC, VP, LD) do { \
    if (!STAG || wid < 4) { \
      SBAR(); QKT(PC0, PC1, K_lds + KOFF(KC)); FSM(PP0, PP1, ALP); SBAR(); \
      LD; SBAR(); \
      if constexpr (PVPIPE && LEAN && ATTV == 0) { if constexpr (ATT_TRB) pv_psm_lean_b(o, vb0 + VOFF(VP), pa0, pa1, pa2, pa3, PC0, PC1, nm, ALC); else pv_psm_lean(o, vb0 + VOFF(VP), pa0, pa1, pa2, pa3, PC0, PC1, nm, ALC); } else { PV(vb0 + VOFF(VP)); PSM(PC0, PC1, MNC, ALC, false); } \
    } else { \
      SBAR(); FSM(PP0, PP1, ALP); SBAR(); \
      LD; SBAR(); \
      PV(vb0 + VOFF(VP)); SBAR(); \
      QKT(PC0, PC1, K_lds + KOFF(KC)); SBAR(); \
      PSM(PC0, PC1, MNC, ALC, false); \
    } } while (0)
  constexpr bool STAG = (MODE == 1) && ATT_STAGGER && ATTV == 0;
  for (int j = 1; j + 1 < NT; j += 2) {
    HALFSTEP(pB0, pB1, mnB, alB, pA0, pA1, alA, 1, 0, LSLOAD(SO, j + SDEPTH));
    LSYNC(); LSWAIT(); LSWRITE(0, SE);
    RESC(alB); LSYNC();
    HALFSTEP(pA0, pA1, mnA, alA, pB0, pB1, alB, 0, 1, if (SDEPTH == 1 || j + 3 < NT) LSLOAD(SE, j + 1 + SDEPTH));
    LSYNC(); LSWAIT(); LSWRITE(1, SO);
    RESC(alA); LSYNC();
  }
#undef HALFSTEP
#undef ILV
#undef LSLOAD
#undef LSWRITE
#undef LSWAIT
#undef LSYNC
  SBAR(); QKT(pB0, pB1, K_lds + KOFF(1));
  FSM(pA0, pA1, alA); SBAR();
  PV(vb0); PSM(pB0, pB1, mnB, alB, false);
  __syncthreads(); RESC(alB);
  FSM(pB0, pB1, alB); SBAR();
  PV(vb0 + VOFF(1));
  } else {
#define STEP(PC0, PC1, ALC, PP0, PP1, ALP, jj, SP, SC, SN) do { const int j_ = (jj); \
      if (j_ + 1 < NT) { asm volatile("s_waitcnt vmcnt(0)" ::: "memory"); SWRITE(SN, 0); if (j_ + 2 < NT) SLOAD(0, j_ + 2); } \
      SBAR(); QKT(PC0, PC1, K_lds + KOFF(SC)); FSM(PP0, PP1, ALP); SBAR(); \
      PV(vb0 + VOFF(SP)); PSM(PC0, PC1, mnA, ALC, false); \
      RESC(ALC); __syncthreads(); } while (0)
    SLOAD(0, 0); asm volatile("s_waitcnt vmcnt(0)" ::: "memory"); SWRITE(0, 0);
    SLOAD(0, 1); asm volatile("s_waitcnt vmcnt(0)" ::: "memory"); SWRITE(1, 0);
    SLOAD(0, 2); __syncthreads();
    QKT(pA0, pA1, K_lds + KOFF(0)); PSM(pA0, pA1, mnA, alA, true);
    STEP(pB0, pB1, alB, pA0, pA1, alA, 1, 0, 1, 2);
    int j = 2;
    for (; j + 5 < NT; j += 6) {
      STEP(pA0, pA1, alA, pB0, pB1, alB, j, 1, 2, 0);
      STEP(pB0, pB1, alB, pA0, pA1, alA, j + 1, 2, 0, 1);
      STEP(pA0, pA1, alA, pB0, pB1, alB, j + 2, 0, 1, 2);
      STEP(pB0, pB1, alB, pA0, pA1, alA, j + 3, 1, 2, 0);
      STEP(pA0, pA1, alA, pB0, pB1, alB, j + 4, 2, 0, 1);
      STEP(pB0, pB1, alB, pA0, pA1, alA, j + 5, 0, 1, 2);
    }
    if (j < NT) { STEP(pA0, pA1, alA, pB0, pB1, alB, j, 1, 2, 0); STEP(pB0, pB1, alB, pA0, pA1, alA, j + 1, 2, 0, 1); j += 2; }
    if (j < NT) { STEP(pA0, pA1, alA, pB0, pB1, alB, j, 0, 1, 2); STEP(pB0, pB1, alB, pA0, pA1, alA, j + 1, 1, 2, 0); j += 2; }
    FSM(pB0, pB1, alB); SBAR();
    { const int sl = (NT - 1) % 3; PV(vb0 + VOFF(sl)); }
#undef STEP
  }
  float rli[16];
  if constexpr (LEAN) {
#pragma unroll
    for (int r = 0; r < 16; ++r) rli[r] = __builtin_amdgcn_rcpf(o[NOB - 1][r]);
  } else {
    if (hi == 0) li_l[r32] = l_reg; asm volatile("s_waitcnt lgkmcnt(0)" ::: "memory");
#pragma unroll
    for (int r = 0; r < 16; ++r) rli[r] = __builtin_amdgcn_rcpf(li_l[crow(r, hi)]);
  }
  bf16* Ow = Ob + (size_t)(wq * 32) * DM;
  if constexpr (MODE == 0) {
#pragma unroll
    for (int r = 0; r < 16; ++r) { const int orow = crow(r, hi);
#pragma unroll
      for (int d0 = 0; d0 < 4; ++d0) Ow[(size_t)orow * DM + d0 * 32 + r32] = tobf1(o[d0][r] * rli[r]); }
    __syncthreads();
  } else {
    LAS float* ex = (LAS float*)lds;
    __syncthreads();
    if (sgrp == 1) {
#pragma unroll
      for (int r = 0; r < 16; ++r)
#pragma unroll
        for (int d0 = 0; d0 < 4; ++d0) ex[(wq * 32 + crow(r, hi)) * 128 + d0 * 32 + r32] = o[d0][r] * rli[r];
    }
    __syncthreads();
    if (sgrp == 0) {
#pragma unroll
      for (int r = 0; r < 16; ++r) { const int orow = crow(r, hi); float dd[4]; float ss = 0.f;
#pragma unroll
        for (int d0 = 0; d0 < 4; ++d0) { dd[d0] = o[d0][r] * rli[r] - lam * ex[(wq * 32 + orow) * 128 + d0 * 32 + r32]; ss += dd[d0] * dd[d0]; }
        ss = half_sum32(ss);
        const float rs = oscale / sqrtf(ss * (1.0f / 128.0f) + LN_EPS);
#pragma unroll
        for (int d0 = 0; d0 < 4; ++d0) Ow[(size_t)orow * DM + d0 * 32 + r32] = tobf1(dd[d0] * rs * subln[d0 * 32 + r32]); }
    }
    __syncthreads();
  }
#undef VOFF
#undef KOFF
#undef PV
#undef PSM
#undef FSM
#undef QKT
#undef KROW
#undef SLOAD
#undef SWRITE
#undef SWAIT
#undef RESC
}
}

__device__ __forceinline__ void mla_attn_phase(CP P, LAS unsigned char* lds, const int tid) {
    const bf16* QM = (const bf16*)(P->ws + WS_QM); const bf16* KV = (const bf16*)(P->ws + WS_KV); const bf16* KR = (const bf16*)(P->ws + WS_KR); bf16* Gb = (bf16*)(P->ws + WS_G);
    const int c = blockIdx.x, G = gridDim.x;
    for (int u = c; u < 1024 + 32; u += G) {
        int b, h, qrow0, NT;
        if (u < 1024) { const int i = u >> 8, cc = u & 255; const int bh = (cc & 7) + 8 * i, qb = cc >> 3; b = bh >> 4; h = bh & 15; qrow0 = b * SEQ + qb * 256; NT = 4 + 128; }
        else { const int bh = u - 1024; b = bh >> 4; h = bh & 15; qrow0 = ML + b * CTXL; NT = 4; }
        att::attn_unit<0>(QM + (size_t)qrow0 * 3072 + h * 192, 3072, KV + h * 256, KV + h * 256 + 128, 4096, KR, b, 4, NT, Gb + (size_t)qrow0 * DM + h * 128, 0.f, nullptr, 1.f, lds, tid);
    }
}
template <int ATTV = 0>
__device__ __forceinline__ void da_attn_phase(CP P, float lam, float oscale, LAS unsigned char* lds, const int tid, const bool ctx_q) {
    const bf16* Z = (const bf16*)(P->ws + WS_Z); bf16* Gb = (bf16*)(P->ws + WS_G); const float* subln = P->in[27];
    const int c = blockIdx.x, G = gridDim.x;
    for (int u = c; u < 2048 + (ctx_q ? 64 : 0); u += G) {
        int b, h, qrow0, NT;
        if (u < 2048) { const int i = u >> 8, cc = u & 255; const int bh = (cc & 7) + 8 * (i >> 1), qb = (cc >> 3) + 32 * (i & 1); b = bh >> 4; h = bh & 15; qrow0 = b * SEQ + qb * 128; NT = 4 + 128; }
        else { const int v = u - 2048; const int bh = v >> 1; b = bh >> 4; h = bh & 15; qrow0 = ML + b * CTXL + (v & 1) * 128; NT = 4; }
        att::attn_unit<1, ATTV>(Z + (size_t)qrow0 * 6144 + h * 128, 6144, Z + 2048 + h * 128, Z + 4096 + h * 128, 6144, nullptr, b, 4, NT, Gb + (size_t)qrow0 * DM + h * 128, lam, subln, oscale, lds, tid);
    }
}

__device__ __forceinline__ unsigned f2ord(float f) { const unsigned u = __float_as_uint(f); return u ^ ((unsigned)((int)u >> 31) | 0x80000000u); }
__device__ __forceinline__ float ord2f(unsigned k) { return __uint_as_float((k & 0x80000000u) ? (k ^ 0x80000000u) : ~k); }
__device__ __forceinline__ void ce_desc(unsigned& a, unsigned& b) { const unsigned mx = a > b ? a : b, mn = a > b ? b : a; a = mx; b = mn; }
template <int N, bool DESC> __device__ __forceinline__ void bitonic_merge(unsigned* a) {
#pragma unroll
    for (int j = N / 2; j > 0; j >>= 1)
#pragma unroll
        for (int i = 0; i < N; ++i) { const int l = i ^ j; if (l > i) { if (DESC) ce_desc(a[i], a[l]); else ce_desc(a[l], a[i]); } }
}
template <int N, bool DESC> __device__ __forceinline__ void bitonic_sort(unsigned* a) {
#pragma unroll
    for (int k = 2; k <= N; k <<= 1)
#pragma unroll
        for (int j = k >> 1; j > 0; j >>= 1)
#pragma unroll
            for (int i = 0; i < N; ++i) { const int l = i ^ j; if (l > i) { const bool up = ((i & k) == 0); if (up == DESC) ce_desc(a[i], a[l]); else ce_desc(a[l], a[i]); } }
}
__device__ __forceinline__ void top16_of_64(unsigned (&a)[64]) {
    bitonic_sort<16, true>(a); bitonic_sort<16, false>(a + 16); bitonic_sort<16, true>(a + 32); bitonic_sort<16, false>(a + 48);
#pragma unroll
    for (int i = 0; i < 16; ++i) a[i] = a[i] > a[16 + i] ? a[i] : a[16 + i];
    bitonic_merge<16, true>(a);
#pragma unroll
    for (int i = 0; i < 16; ++i) a[32 + i] = a[32 + i] > a[48 + i] ? a[32 + i] : a[48 + i];
    bitonic_merge<16, false>(a + 32);
#pragma unroll
    for (int i = 0; i < 16; ++i) a[i] = a[i] > a[32 + i] ? a[i] : a[32 + i];
    bitonic_merge<16, true>(a);
}
template <int PASS> __device__ __forceinline__ void route_pass(const bf16* QP, const LAS char* lds, int tok, int head, int r32, int hi, unsigned (&top)[16]) {
    f32x16 acc[4] = {};
    const bf16* qp = QP + (size_t)tok * DM + head * 256 + PASS * 128 + hi * 8;
    bf16x8 qf[8];
#pragma unroll
    for (int ks = 0; ks < 8; ++ks) qf[ks] = *(const bf16x8*)(qp + ks * 16);
    const LAS char* Kl = lds + PASS * 32768;
#pragma unroll
    for (int kb = 0; kb < 4; ++kb)
#pragma unroll
        for (int ks = 0; ks < 8; ++ks) { const bf16x8 a = *(const LAS bf16x8*)(Kl + (kb * 32 + r32) * 256 + (((ks * 2 + hi) ^ (r32 & 15)) * 16));
            acc[kb] = __builtin_amdgcn_mfma_f32_32x32x16_bf16(a, qf[ks], acc[kb], 0, 0, 0); }
    unsigned key[64]; const unsigned base = 127u - 4u * (unsigned)hi;
#pragma unroll
    for (int kb = 0; kb < 4; ++kb)
#pragma unroll
        for (int r = 0; r < 16; ++r) key[kb * 16 + r] = (f2ord(acc[kb][r]) & ~127u) | (base - (unsigned)(kb * 32 + (r & 3) + 8 * (r >> 2)));
    top16_of_64(key);
    unsigned pr[16];
#pragma unroll
    for (int i = 0; i < 16; ++i) pr[i] = lane_xor32(key[15 - i], hi << 5);
#pragma unroll
    for (int i = 0; i < 16; ++i) key[i] = key[i] > pr[i] ? key[i] : pr[i];
    bitonic_merge<16, true>(key);
#pragma unroll
    for (int i = 0; i < 16; ++i) top[i] = key[i];
}
__device__ __forceinline__ void route_phase(CP P, int L, int Mrows, LAS unsigned char* lds_, int tid, int lane, int wid, int gw, int NGW) {
    const bf16* QP = (const bf16*)(P->ws + WS_QP); unsigned* ROUTE = (unsigned*)(P->ws + WS_ROUTE);
    LAS char* lds = (LAS char*)(LAS unsigned char*)lds_;
    __syncthreads();
    {
        const bf16* K1 = (const bf16*)(P->ws + WS_PK1) + (size_t)L * 128 * 128; const bf16* K2 = (const bf16*)(P->ws + WS_PK2) + (size_t)L * 128 * 128;
        for (int c16 = tid; c16 < 2 * 128 * 16; c16 += NWAVES * 64) { const int mat = c16 >> 11, row = (c16 >> 4) & 127, ch = c16 & 15;
            const u32x4 w = *(const u32x4*)((mat ? K2 : K1) + row * 128 + ch * 8);
            *(LAS u32x4*)(lds + mat * 32768 + row * 256 + ((ch ^ (row & 15)) * 16)) = w; }
    }
    __syncthreads();
    LAS unsigned* sc = (LAS unsigned*)(lds + 65536) + wid * 2048;
    const int r32 = lane & 31, hi = lane >> 5;
    for (int item = gw; item < Mrows / 4; item += NGW) {
        const int tok = item * 4 + (r32 >> 3), head = r32 & 7;
        unsigned top0[16], top1[16];
        route_pass<0>(QP, lds, tok, head, r32, hi, top0);
        route_pass<1>(QP, lds, tok, head, r32, hi, top1);
        float v1[16], v2[16];
#pragma unroll
        for (int i = 0; i < 16; ++i) { v1[i] = ord2f(top0[i] & ~127u); v2[i] = ord2f(top1[i] & ~127u);
            sc[i * 64 + lane] = 127u - (top0[i] & 127u); sc[(16 + i) * 64 + lane] = 127u - (top1[i] & 127u); }
        unsigned ck[64]; int n = 0;
#pragma unroll
        for (int i = 0; i < 16; ++i)
#pragma unroll
            for (int j = 0; j < 16; ++j) if ((i + 1) * (j + 1) <= 16) { ck[n] = (f2ord(v1[i] + v2[j]) & ~255u) | (unsigned)(i * 16 + j); ++n; }
#pragma unroll
        for (int i = 50; i < 64; ++i) ck[i] = 0u;
        top16_of_64(ck);
        float ev[16]; float sum = 0.f; const float mx = ord2f(ck[0] & ~255u);
#pragma unroll
        for (int k = 0; k < 16; ++k) { ev[k] = __expf(ord2f(ck[k] & ~255u) - mx); sum += ev[k]; }
        const float inv = 1.0f / sum;
        unsigned ee[16];
#pragma unroll
        for (int k = 0; k < 16; ++k) { const unsigned pc = ck[k] & 255u; const unsigned i1 = sc[(pc >> 4) * 64 + lane], i2 = sc[(16 + (pc & 15u)) * 64 + lane]; ee[k] = i1 * 128u + i2; ev[k] *= inv; }
        u32x4* outp = (u32x4*)(ROUTE + ((size_t)tok * 128 + head * 16 + hi * 8) * 2);
#pragma unroll
        for (int k = 0; k < 8; k += 2) { u32x4 w;
            const unsigned eL0 = ee[k], eH0 = ee[k + 8], eL1 = ee[k + 1], eH1 = ee[k + 9]; const float gL0 = ev[k], gH0 = ev[k + 8], gL1 = ev[k + 1], gH1 = ev[k + 9];
            w.x = hi ? eH0 : eL0; w.y = __float_as_uint(hi ? gH0 : gL0); w.z = hi ? eH1 : eL1; w.w = __float_as_uint(hi ? gH1 : gL1);
            outp[k >> 1] = w; }
    }
}

typedef float f32x2 __attribute__((ext_vector_type(2)));
typedef float f32x32 __attribute__((ext_vector_type(32)));
typedef unsigned u32x6 __attribute__((ext_vector_type(6)));
typedef __bf16 bf16x32 __attribute__((ext_vector_type(32)));
typedef unsigned u32x16 __attribute__((ext_vector_type(16)));
typedef __bf16 bf16x2_t __attribute__((ext_vector_type(2)));
constexpr int GS = 6, GSLOT = 2 * PROW;
__device__ __forceinline__ void glds16(const void* gsrc, unsigned lds_dst) { unsigned keep;
  asm volatile("s_mov_b32 %0, m0\n\ts_mov_b32 m0, %2\n\ts_nop 0\n\tglobal_load_lds_dwordx4 %1, off\n\ts_mov_b32 m0, %0" : "=&s"(keep) : "v"(gsrc), "s"(lds_dst) : "memory"); }
template <int GMODE = 0>
__device__ __forceinline__ void gather_phase(CP P, int L, int Mrows, LAS unsigned char* lds, int wid, int lane_, int gw, int NGW, bool dry = false) {
    const unsigned char* UV = P->ws + WS_PU + (size_t)L * 16384 * PREC;
    const unsigned* ROUTE = (const unsigned*)(P->ws + WS_ROUTE); const float* MOD = (const float*)(P->ws + WS_MOD);
    bf16* X = (bf16*)(P->ws + WS_X); bf16* H = (bf16*)(P->ws + WS_H); bf16* Xo = dry ? (bf16*)(P->ws + WS_Y) : X; bf16* Ho = dry ? (bf16*)(P->ws + WS_G) : H;
    const float* lng = P->in[6] + (size_t)(L * 2 + 1) * DM; const float* lnb = P->in[7] + (size_t)(L * 2 + 1) * DM;
    const unsigned ring = (unsigned)(uintptr_t)lds + (unsigned)wid * (GS * GSLOT);
    const int nfull = (Mrows / NGW) * NGW, rem = Mrows - nfull; const bool can_coop = (rem * 4 == NGW);
    const int nround = nfull / NGW + (rem > 0 ? 1 : 0);
#define G_ROWOF(it_) ((can_coop && (it_) == nround - 1) ? (nfull + (int)blockIdx.x * 2 + (wid >> 2)) : (gw + (it_) * NGW))
    u32x2 nea = {0u, 0u}, neb = {0u, 0u}; u32x4 nh0 = {0u, 0u, 0u, 0u}, nh1 = nh0, nh2 = nh0, nh3 = nh0;
#define G_PREFETCH(rowN_, ln_) do { const int rn_ = (rowN_); nea = ((const u32x2*)(ROUTE + (size_t)rn_ * 256))[ln_]; neb = ((const u32x2*)(ROUTE + (size_t)rn_ * 256))[64 + (ln_)]; \
        const u32x4* hp_ = (const u32x4*)(H + (size_t)rn_ * DM) + 4 * (ln_); nh0 = hp_[0]; nh1 = hp_[1]; nh2 = hp_[2]; nh3 = hp_[3]; } while (0)
    if (nround > 0 && G_ROWOF(0) < Mrows) G_PREFETCH(G_ROWOF(0), launder_v(lane_));
#pragma unroll 1
    for (int it = 0; it < nround; ++it) {
        const bool coop = can_coop && (it == nround - 1);
        int row = G_ROWOF(it), k0 = 0, kn = 128;
        if (coop) { k0 = (wid & 3) * 32; kn = k0 + 32; }
        else if (row >= Mrows) break;
        const int lane = launder_v(lane_);
        const u32x2 ea = nea, eb = neb;
        unsigned eax, eay, ebx, eby;
        unsigned hw[16] = {nh0.x, nh0.y, nh0.z, nh0.w, nh1.x, nh1.y, nh1.z, nh1.w, nh2.x, nh2.y, nh2.z, nh2.w, nh3.x, nh3.y, nh3.z, nh3.w};
        float y[32];
#pragma unroll
        for (int i = 0; i < 32; ++i) y[i] = 0.f;
        { unsigned e0 = ea.x, e1 = ea.y, e2 = eb.x, e3 = eb.y;
          asm volatile("" : "+v"(e0), "+v"(e1), "+v"(e2), "+v"(e3), "+v"(hw[0]), "+v"(hw[1]), "+v"(hw[2]), "+v"(hw[3]), "+v"(hw[4]), "+v"(hw[5]), "+v"(hw[6]), "+v"(hw[7]),
                       "+v"(hw[8]), "+v"(hw[9]), "+v"(hw[10]), "+v"(hw[11]), "+v"(hw[12]), "+v"(hw[13]), "+v"(hw[14]), "+v"(hw[15]) :: "memory");
          eax = e0; eay = e1; ebx = e2; eby = e3; }
        const unsigned rd_a = ring + 16u * (unsigned)lane, rd_b = ring + 2048u + 8u * (unsigned)lane;
#define G_ISSUE(k) do { const int k_ = (k); const unsigned e_ = (unsigned)__builtin_amdgcn_readlane((int)(k_ < 64 ? eax : ebx), k_ & 63); \
        const unsigned char* rp_ = UV + (size_t)e_ * PREC + 16 * lane; const unsigned sb_ = ring + (unsigned)(k_ % GS) * GSLOT; \
        if (GMODE != 2) { glds16(rp_, sb_); glds16(rp_ + 1024, sb_ + 1024); glds16(rp_ + 2048, sb_ + 2048); } else { asm volatile("" :: "v"(rp_), "s"(sb_)); } } while (0)
#pragma unroll
        for (int k = 0; k < 4; ++k) G_ISSUE(k0 + k);
        if (it + 1 < nround && G_ROWOF(it + 1) < Mrows) G_PREFETCH(G_ROWOF(it + 1), lane);
#define G_READ(k, ua, ub, va, vb) do { const unsigned so_ = (unsigned)((k) % GS) * GSLOT; \
        asm volatile("ds_read_b128 %0, %4\n\tds_read_b64 %1, %5\n\tds_read_b128 %2, %4 offset:1024\n\tds_read_b64 %3, %5 offset:512" \
                     : "=&v"(ua), "=&v"(ub), "=&v"(va), "=&v"(vb) : "v"(rd_a + so_), "v"(rd_b + so_) : "memory"); } while (0)
#pragma unroll 1
        for (int k = k0; k < kn; k += 2) {
            if (k + 4 < kn) { G_ISSUE(k + 4); G_ISSUE(k + 5); asm volatile("s_waitcnt vmcnt(12)" ::: "memory"); }
            else if (k == kn - 4) asm volatile("s_waitcnt vmcnt(6)" ::: "memory");
            else asm volatile("s_waitcnt vmcnt(0)" ::: "memory");
            u32x4 uaA, vaA, uaB, vaB; u32x2 ubA, vbA, ubB, vbB;
            G_READ(k, uaA, ubA, vaA, vbA); G_READ(k + 1, uaB, ubB, vaB, vbB);
            asm volatile("s_waitcnt lgkmcnt(0)" : "+v"(uaA), "+v"(ubA), "+v"(vaA), "+v"(vbA), "+v"(uaB), "+v"(ubB), "+v"(vaB), "+v"(vbB) :: "memory");
            if (GMODE == 1) continue;
            const u32x6 u6A = {uaA.x, uaA.y, uaA.z, uaA.w, ubA.x, ubA.y}, u6B = {uaB.x, uaB.y, uaB.z, uaB.w, ubB.x, ubB.y};
            const u32x16 ubfA = __builtin_bit_cast(u32x16, __builtin_amdgcn_cvt_scalef32_pk32_bf16_fp6(u6A, 1.0f));
            const u32x16 ubfB = __builtin_bit_cast(u32x16, __builtin_amdgcn_cvt_scalef32_pk32_bf16_fp6(u6B, 1.0f));
            float a0 = 0.f, a1 = 0.f, b0 = 0.f, b1 = 0.f;
#pragma unroll
            for (int q = 0; q < 16; q += 2) { const unsigned h0_ = hw[q], h1_ = hw[q + 1], x0_ = ubfA[q], x1_ = ubfA[q + 1], z0_ = ubfB[q], z1_ = ubfB[q + 1];
                a0 = __builtin_amdgcn_fdot2_f32_bf16(__builtin_bit_cast(bf16x2_t, h0_), __builtin_bit_cast(bf16x2_t, x0_), a0, false);
                a1 = __builtin_amdgcn_fdot2_f32_bf16(__builtin_bit_cast(bf16x2_t, h1_), __builtin_bit_cast(bf16x2_t, x1_), a1, false);
                b0 = __builtin_amdgcn_fdot2_f32_bf16(__builtin_bit_cast(bf16x2_t, h0_), __builtin_bit_cast(bf16x2_t, z0_), b0, false);
                b1 = __builtin_amdgcn_fdot2_f32_bf16(__builtin_bit_cast(bf16x2_t, h1_), __builtin_bit_cast(bf16x2_t, z1_), b1, false); }
            const float dA = wave_sum(a0 + a1) * (1.0f / U_SCALE), dB = wave_sum(b0 + b1) * (1.0f / U_SCALE);
            const unsigned gsel = k < 64 ? eay : eby;
            const float wA = __uint_as_float((unsigned)__builtin_amdgcn_readlane((int)gsel, k & 63)) * gelu_tanh(dA) * (1.0f / V_SCALE);
            const float wB = __uint_as_float((unsigned)__builtin_amdgcn_readlane((int)gsel, (k & 63) + 1)) * gelu_tanh(dB) * (1.0f / V_SCALE);
            const u32x6 v6A = {vaA.x, vaA.y, vaA.z, vaA.w, vbA.x, vbA.y};
            const f32x32 vfA = __builtin_amdgcn_cvt_scalef32_pk32_f32_fp6(v6A, 1.0f);
#pragma unroll
            for (int i = 0; i < 32; ++i) y[i] += wA * vfA[i];
            const u32x6 v6B = {vaB.x, vaB.y, vaB.z, vaB.w, vbB.x, vbB.y};
            const f32x32 vfB = __builtin_amdgcn_cvt_scalef32_pk32_f32_fp6(v6B, 1.0f);
#pragma unroll
            for (int i = 0; i < 32; ++i) y[i] += wB * vfB[i];
        }
#undef G_READ
#undef G_ISSUE
        if (coop) {
            LAS f32x4* mine = (LAS f32x4*)(lds + wid * (GS * GSLOT)) + lane * 8;
#pragma unroll
            for (int i = 0; i < 8; ++i) mine[i] = (f32x4){y[4 * i], y[4 * i + 1], y[4 * i + 2], y[4 * i + 3]};
            __syncthreads();
            if ((wid & 3) == 0) {
#pragma unroll
                for (int j = 1; j < 4; ++j) { const LAS f32x4* oth = (const LAS f32x4*)(lds + (wid + j) * (GS * GSLOT)) + lane * 8;
#pragma unroll
                    for (int i = 0; i < 8; ++i) { const f32x4 t = oth[i]; y[4 * i] += t.x; y[4 * i + 1] += t.y; y[4 * i + 2] += t.z; y[4 * i + 3] += t.w; } }
            }
            __syncthreads();
            if ((wid & 3) != 0) continue;
        }
        const int slot = row_slot(row);
        const float* mod = MOD + (size_t)(L * 3 + slot) * 12288;
        const int le = launder_v(lane);
        { float xx[32], gg[32]; load_row_bf16_b(X + (size_t)row * DM, le, xx); load_row_f32_b(mod + 5 * 2048, le, gg);
#pragma unroll
          for (int i = 0; i < 32; ++i) y[i] = ALPHA * xx[i] + gg[i] * y[i]; }
        if (L < NLAYER - 1) { const float* modn = MOD + (size_t)((L + 1) * 3 + slot) * 12288;
            finish_row<true>(y, lng, lnb, Xo + (size_t)row * DM, modn, modn + 2048, Ho + (size_t)row * DM, nullptr, le); }
        else finish_row<true>(y, lng, lnb, nullptr, nullptr, nullptr, nullptr, P->out + (size_t)row * DM, le);
        asm volatile("s_waitcnt vmcnt(0)" ::: "memory");
    }
#undef G_PREFETCH
#undef G_ROWOF
}

#ifndef ROPE_TEST
#define ROPE_TEST 0
#endif
#ifndef PROBE_DUP
#define PROBE_DUP 0
#endif
#define NOINL __forceinline__
__device__ __forceinline__ CP launder_cp(CP p) { asm volatile("" : "+s"(p)); return p; }
#define GETP() launder_cp((CP)__builtin_amdgcn_kernarg_segment_ptr())
__device__ __forceinline__ int uni(int v) { return __builtin_amdgcn_readfirstlane(v); }
__device__ __forceinline__ LAS unsigned char* uni_lds(LAS unsigned char* p) { return (LAS unsigned char*)(unsigned)__builtin_amdgcn_readfirstlane((int)(unsigned)(uintptr_t)p); }
#define PH_IDS const int wid = uni(wv_), lane = launder_v(lane_id_fresh()) & 63, tid = (wid & 7) * 64 + lane; const int gw = blockIdx.x * NWAVES + wid, NGW = gridDim.x * NWAVES; (void)lane; (void)gw; (void)NGW; (void)tid;

__device__ NOINL void ph_prologue(int wv_, LAS unsigned char* lds_) { CP P = GETP(); LAS unsigned char* lds = uni_lds(lds_); PH_IDS p0_prologue(P, lds, tid, lane, wid, gw, NGW); if (PROBE_DUP == 5) p0_prologue(P, lds, tid, lane, wid, gw, NGW); }
__device__ NOINL void ph_modreduce(int wv_) { CP P = GETP(); PH_IDS mod_reduce(P, gw, lane, NGW); }
__device__ NOINL void ph_first(int wv_) { CP P = GETP(); PH_IDS
#pragma unroll 1
    for (int rep = 0; rep < (PROBE_DUP == 6 ? 2 : 1); ++rep) first_row_pass(P, lane, gw, NGW); }
__device__ NOINL void ph_postmix(int wv_, int L_, int M_) { CP P = GETP(); const int L = uni(L_), Mrows = uni(M_); PH_IDS post_mixer_pass(P, L, Mrows, lane, gw, NGW); }
__device__ NOINL void ph_vstats(int wv_, int M_) { CP P = GETP(); const int Mrows = uni(M_); PH_IDS
#pragma unroll 1
    for (int rep = 0; rep < (PROBE_DUP == 6 ? 2 : 1); ++rep) vstats_pass(P, Mrows, lane, gw, NGW); }
__device__ NOINL void ph_spatial(int wv_, LAS unsigned char* lds_, int j_, int M_) { CP P = GETP(); LAS unsigned char* lds = uni_lds(lds_); const int j = uni(j_), Mrows = uni(M_); PH_IDS
#pragma unroll 1
    for (int rep = 0; rep < (PROBE_DUP == 6 ? 2 : 1); ++rep) spatial_phase(P, j, Mrows, lds, tid, lane, wid); }
__device__ NOINL void ph_mla_norm(int wv_) { CP P = GETP(); PH_IDS
#pragma unroll 1
    for (int rep = 0; rep < (PROBE_DUP == 6 ? 2 : 1); ++rep) mla_norm_pass(P, lane, gw, NGW); }
__device__ NOINL void ph_rope(int wv_, int which_) { CP P = GETP(); const int which = uni(which_); PH_IDS
    if (which == 0) rope_pass((bf16*)(P->ws + WS_QM), 3072, 128, 16, 192, lane, gw, NGW);
    else rope_pass((bf16*)(P->ws + WS_Z), 6144, 0, 64, 64, lane, gw, NGW); }
__device__ NOINL void ph_attn_mla(int wv_, LAS unsigned char* lds_) { CP P = GETP(); LAS unsigned char* lds = uni_lds(lds_); PH_IDS mla_attn_phase(P, lds, tid); if (PROBE_DUP == 2 || PROBE_DUP == 9) mla_attn_phase(P, lds, tid); }
__device__ NOINL void ph_attn_da(int wv_, LAS unsigned char* lds_, int L_, bool ctx_q) { CP P = GETP(); LAS unsigned char* lds = uni_lds(lds_); const int L = uni(L_); PH_IDS
    const float* lp = P->in[26];
    const float s01 = wave_sum(lp[lane] * lp[64 + lane]), s23 = wave_sum(lp[128 + lane] * lp[192 + lane]);
    const float lam_init = 0.8f - 0.6f * expf(-0.3f * (float)L);
    const float lam = expf(s01) - expf(s23) + lam_init;
    if (!(PROBE_DUP >= 11 && PROBE_DUP <= 15)) da_attn_phase(P, lam, 1.0f - lam_init, lds, tid, ctx_q);
    if (PROBE_DUP == 2 || PROBE_DUP == 10) da_attn_phase(P, lam, 1.0f - lam_init, lds, tid, ctx_q);
    if (PROBE_DUP >= 11 && PROBE_DUP <= 15) { da_attn_phase<PROBE_DUP >= 11 && PROBE_DUP <= 15 ? PROBE_DUP - 10 : 0>(P, lam, 1.0f - lam_init, lds, tid, ctx_q); __syncthreads(); }
    if (PROBE_DUP >= 11 && PROBE_DUP <= 15) da_attn_phase(P, lam, 1.0f - lam_init, lds, tid, ctx_q); }
__device__ NOINL void ph_route(int wv_, LAS unsigned char* lds_, int L_, int M_) { CP P = GETP(); LAS unsigned char* lds = uni_lds(lds_); const int L = uni(L_), Mrows = uni(M_); PH_IDS
#pragma unroll 1
    for (int rep = 0; rep < (PROBE_DUP == 4 ? 2 : 1); ++rep) route_phase(P, L, Mrows, lds, tid, lane, wid, gw, NGW); }
__device__ NOINL void ph_gather(int wv_, LAS unsigned char* lds_, int L_, int M_) { CP P = GETP(); LAS unsigned char* lds = uni_lds(lds_); const int L = uni(L_), Mrows = uni(M_); PH_IDS
    if (PROBE_DUP == 3) { gather_phase<0>(P, L, Mrows, lds, wid, lane, gw, NGW, true); }
    if (PROBE_DUP == 7) { gather_phase<1>(P, L, Mrows, lds, wid, lane, gw, NGW, true); }
    if (PROBE_DUP == 8) { gather_phase<2>(P, L, Mrows, lds, wid, lane, gw, NGW, true); }
    gather_phase<0>(P, L, Mrows, lds, wid, lane, gw, NGW); }

enum GemmId { G_GM_IN = 0, G_GM_OUT, G_MLA_IN, G_MLA_UQ, G_MLA_UKV, G_MLA_OUT, G_DA_IN, G_DA_OUT, G_PEER_Q };
__device__ NOINL void ph_gemm(int wv_, LAS unsigned char* lds_, int id_, int L_, int M_) {
    CP P = GETP(); LAS unsigned char* lds = uni_lds(lds_); const int id = uni(id_), L = uni(L_), Mrows = uni(M_); PH_IDS
    unsigned char* ws = P->ws; const int jj = L / 3;
    size_t a = WS_H, b = 0, o = 0; int M = MT, N = 2048, K = 2048, act = 0, rope = 0;
    switch (id) {
        case G_GM_IN:   a = WS_H;    b = WS_GMWIN + (size_t)jj * 4096 * 2048 * 2;  o = WS_Z;  M = Mrows; N = 4096; K = 2048; act = 1; break;
        case G_GM_OUT:  a = WS_G;    b = WS_GMWOUT + (size_t)jj * 2048 * 2048 * 2; o = WS_Y;  M = Mrows; N = 2048; K = 2048; break;
        case G_MLA_IN:  a = WS_H;    b = WS_MLAIN;  o = WS_C;  N = 1280; K = 2048; break;
        case G_MLA_UQ:  a = WS_CQN;  b = WS_MLAUQ;  o = WS_QM; N = 3072; K = 512;  rope = (ROPE_TEST == 2) ? 0 : 2; break;
        case G_MLA_UKV: a = WS_CKVN; b = WS_MLAUKV; o = WS_KV; N = 4096; K = 512;  break;
        case G_MLA_OUT: a = WS_G;    b = WS_MLAOUT; o = WS_Y;  N = 2048; K = 2048; break;
        case G_DA_IN:   a = WS_H;    b = WS_DAIN;   o = WS_Z;  N = 6144; K = 2048; rope = (ROPE_TEST == 1) ? 0 : 1; break;
        case G_DA_OUT:  a = WS_G;    b = WS_DAOUT;  o = WS_Y;  M = Mrows; N = 2048; K = 2048; break;
        default:        a = WS_H;    b = WS_PWQ + (size_t)L * 2048 * 2048 * 2;     o = WS_QP; M = Mrows; N = 2048; K = 2048; break;
    }
    pg8::Gemm g{(const pg8::bf16_t*)(ws + a), (const pg8::bf16_t*)(ws + b), M, N, K}; pg8::StaticOrder S; S.init(M, N, (int)gridDim.x, (int)blockIdx.x);
    pg8::EpiR E{(pg8::bf16_t*)(ws + o), N, act, rope, (const float*)(ws + WS_ROPE)};
#pragma unroll 1
    for (int rep = 0; rep < (PROBE_DUP == 1 ? 2 : 1); ++rep) { pg8::gemm_phase<pg8::EpiR, pg8::StaticOrder, true, true>((PG8_LAS unsigned char*)lds, g, S, E, tid); __syncthreads(); }
    const bool tail_u = (id == G_GM_OUT || id == G_MLA_OUT || id == G_DA_OUT), tail_v = (id == G_PEER_Q);
    if ((tail_u || tail_v) && L + 1 < NLAYER) {
        const int units = (M / 256) * (N / 256), G = (int)gridDim.x, tail = units % G, c = (int)blockIdx.x;
        const float* src = (tail_u ? P->in[11] : P->in[12]) + (size_t)(L + 1) * 16384 * 2048; unsigned char* dst = ws + WS_PU + (size_t)(L + 1) * 16384 * PREC;
        LAS float* scr = (LAS float*)(lds + wid * 16384);
        if (tail != 0 && c >= tail) cvt_table_fp6(src, dst, 16384, tail_u ? U_SCALE : V_SCALE, scr, lane, (c - tail) * NWAVES + wid, (G - tail) * NWAVES, tail_u ? 0 : 1);
        else if (tail == 0) cvt_table_fp6(src, dst, 16384, tail_u ? U_SCALE : V_SCALE, scr, lane, gw, NGW, tail_u ? 0 : 1);
    }
}

__global__ void __launch_bounds__(NWAVES * 64, 2) mk_fwd(Params Pv) {
    extern __shared__ __attribute__((aligned(16))) unsigned char lds_g[];
    LAS unsigned char* lds = (LAS unsigned char*)lds_g;
    const int wv = __builtin_amdgcn_readfirstlane((int)threadIdx.x >> 6);
    const int tid = wv * 64 + lane_id_fresh();
    for (int u = tid; u < (LDS_BYTES - RING_BYTES) / 4; u += NWAVES * 64) ((LAS unsigned*)(lds + RING_BYTES))[u] = 0u;
    __syncthreads();
    const int lo = Pv.ph_lo, hi = Pv.ph_hi;
    unsigned* barw = (unsigned*)(Pv.ws + WS_CTL) + CW_BAR;
    XcdBarrier bar; bar.bar = barw; bar.x = 0; bar.st = nullptr;
    if (hi - lo > 1) bar = xcd_barrier_post(barw, (volatile LAS unsigned*)(lds + MISC_OFF) + 8, tid == 0);
    int ph = 0;
#ifndef SEL
#define SELP(k) true
#else
#define SELP(k) ((k) == SEL)
#endif
    enum { RUN_BASE = __COUNTER__ + 1 };
#define RUN(call) do { if (SELP(__COUNTER__ - RUN_BASE) && ph >= lo && ph < hi) { call; } if (ph >= lo && ph + 1 < hi) xcd_barrier(bar, wv == 0 && lane_id_fresh() == 0); ++ph; } while (0)
    RUN(ph_prologue(wv, lds));
    RUN(ph_modreduce(wv));
    RUN(ph_first(wv));
#define LAYER(LL) do { constexpr int L = (LL); constexpr int kind = L % 3, jj = L / 3; constexpr int Mrows = (L == NLAYER - 1) ? ML : MT; \
        constexpr bool ctx_dead = (L == NLAYER - 2) && ((NLAYER - 1) % 3 == 0) && (kind != 0); constexpr int Mlive = ctx_dead ? ML : Mrows; \
        if (kind == 0) {                          \
            RUN(ph_gemm(wv, lds, G_GM_IN, L, Mrows)); \
            RUN(ph_vstats(wv, Mrows)); \
            RUN(ph_spatial(wv, lds, jj, Mrows)); \
            RUN(ph_gemm(wv, lds, G_GM_OUT, L, Mrows)); \
        } else if (kind == 1) {                   \
            RUN(ph_gemm(wv, lds, G_MLA_IN, L, Mrows)); \
            RUN(ph_mla_norm(wv)); \
            RUN(ph_gemm(wv, lds, G_MLA_UQ, L, Mrows); ph_gemm(wv, lds, G_MLA_UKV, L, Mrows)); \
            if (ROPE_TEST == 2) { RUN(ph_rope(wv, 0)); } \
            RUN(ph_attn_mla(wv, lds)); \
            RUN(ph_gemm(wv, lds, G_MLA_OUT, L, Mrows)); \
        } else {                                  \
            RUN(ph_gemm(wv, lds, G_DA_IN, L, Mrows); if (ROPE_TEST == 1) { __syncthreads(); } ); \
            if (ROPE_TEST == 1) { RUN(ph_rope(wv, 1)); } \
            RUN(ph_attn_da(wv, lds, L, !ctx_dead)); \
            RUN(ph_gemm(wv, lds, G_DA_OUT, L, Mlive)); \
        } \
        RUN(ph_postmix(wv, L, Mlive));                \
        RUN(ph_gemm(wv, lds, G_PEER_Q, L, Mlive));    \
        RUN(ph_route(wv, lds, L, Mlive));             \
        RUN(ph_gather(wv, lds, L, Mlive));            \
    } while (0)
    LAYER(0); LAYER(1); LAYER(2); LAYER(3);
#undef LAYER
#undef RUN
}

extern "C" void kernel_launch(void* const* d_in, const int* in_sizes, int n_in, void* d_out, int out_size, void* d_ws, size_t ws_size, hipStream_t stream) {
    static int grid = 0;
    if (grid == 0) {
        if (n_in != 29 || in_sizes[0] != ML * DM || out_size != ML * DM || ws_size < WS_END) {
            fprintf(stderr, "kernel_launch: shape mismatch: n_in %d in0 %d out %d ws %zu (need %zu); nothing launched\n", n_in, n_in > 0 ? in_sizes[0] : -1, out_size, ws_size, (size_t)WS_END); grid = -1; return; }
        int dev = 0, cus = 0, per_cu = 0;
        if (hipGetDevice(&dev) != hipSuccess || hipDeviceGetAttribute(&cus, hipDeviceAttributeMultiprocessorCount, dev) != hipSuccess) { fprintf(stderr, "kernel_launch: device query failed\n"); grid = -1; return; }
        if (hipFuncSetAttribute((const void*)mk_fwd, hipFuncAttributeMaxDynamicSharedMemorySize, LDS_BYTES) != hipSuccess) { fprintf(stderr, "kernel_launch: hipFuncSetAttribute failed\n"); grid = -1; return; }
        if (hipOccupancyMaxActiveBlocksPerMultiprocessor(&per_cu, (const void*)mk_fwd, NWAVES * 64, LDS_BYTES) != hipSuccess || per_cu < 1)
            fprintf(stderr, "kernel_launch: note: occupancy query reports %d workgroups per CU\n", per_cu);
        (void)hipGetLastError();
        grid = cus;
    }
    if (grid < 0) return;
    if (hipMemsetAsync((char*)d_ws + WS_CTL, 0, CTL_ZERO_BYTES, stream) != hipSuccess) { fprintf(stderr, "kernel_launch: memset failed\n"); return; }
    Params p{};
    for (int i = 0; i < 29; ++i) p.in[i] = (const float*)d_in[i];
    p.out = (float*)d_out; p.ws = (unsigned char*)d_ws;
#if MK_ONE_LAUNCH
    p.ph_lo = 0; p.ph_hi = NPH;
    hipLaunchKernelGGL(mk_fwd, dim3(grid), dim3(NWAVES * 64), LDS_BYTES, stream, p);
#else
    for (int li = 0; li < NPH; ++li) { p.ph_lo = li; p.ph_hi = li + 1; hipLaunchKernelGGL(mk_fwd, dim3(grid), dim3(NWAVES * 64), LDS_BYTES, stream, p); }
#endif
    const hipError_t le = hipPeekAtLastError();
    if (le != hipSuccess) fprintf(stderr, "kernel_launch: launch failed: %s\n", hipGetErrorName(le));
}
```

```cpp
#include <hip/hip_runtime.h>
#include <cstdio>
#include <cstdint>
#ifndef MK_ONE_LAUNCH
#define MK_ONE_LAUNCH 1
#endif
__device__ __forceinline__ int launder_v(int v) { asm volatile("" : "+v"(v)); return v; }
__device__ __forceinline__ int lane_id_fresh() { unsigned m = ~0u; asm volatile("" : "+s"(m)); return (int)__builtin_amdgcn_mbcnt_hi(m, __builtin_amdgcn_mbcnt_lo(m, 0u)); }
namespace pg8 {
#define PG8_LAS __attribute__((address_space(3)))
typedef unsigned short bf16_t;
typedef short bf16x8 __attribute__((ext_vector_type(8)));
typedef float f32x4 __attribute__((ext_vector_type(4)));
typedef unsigned u32x4 __attribute__((ext_vector_type(4)));
constexpr int BM = 256, BK = 64, HALF = 128, HTB = HALF * BK * 2  , STAGE_BYTES = 8 * HTB, NXCD = 8, WGM = 8;

__host__ __device__ __forceinline__ int lds_byte(int r, int c) { const int st = (r >> 4) * 2 + (c >> 5), rr = r & 15, cc = c & 31, ob = rr * 64 + cc * 2; return st * 1024 + (ob ^ (((ob >> 9) & 1) << 5)); }
__host__ __device__ __forceinline__ void stage_rc(int b, int& R, int& C) { const int st = b / 1024, sb = b % 1024, swz = sb ^ (((sb >> 9) & 1) << 5); R = (st >> 1) * 16 + swz / 64; C = (st & 1) * 32 + (swz % 64) / 2; }
__host__ __device__ __forceinline__ int perm32(int rho) { const int n = rho >> 4, i = rho & 15; return 8 * (i >> 2) + 4 * n + (i & 3); }

struct Unit { int pm, pn; };
struct Gemm { const bf16_t* A; const bf16_t* Bt; int M, N, K; };

struct StaticOrder {
    int nM, nN, nwg, G, c;
    __host__ __device__ void init(int M, int N, int G_, int c_) { nM = M / BM; nN = N / BM; nwg = nM * nN; G = G_; c = c_; }
    __host__ __device__ bool next(int i, Unit& u) const {
        const long L = (long)i * G + c; if (L >= nwg) return false;
        int wgid = (int)L; { const int q = nwg / NXCD, r = nwg % NXCD, xcd = wgid % NXCD, off = wgid / NXCD; wgid = (xcd < r ? xcd * (q + 1) : r * (q + 1) + (xcd - r) * q) + off; }
        const int nig = WGM * nN, gid = wgid / nig, fm = gid * WGM, gsz = (nM - fm) < WGM ? (nM - fm) : WGM;
        u.pm = fm + ((wgid % nig) % gsz); u.pn = (wgid % nig) / gsz; return true;
    }
    __device__ __forceinline__ void a_ready(const Unit&) const {}
    __device__ __forceinline__ void done(const Unit&) const {}
};

__device__ __forceinline__ unsigned cvt_pk_bf16(float lo, float hi) { unsigned r; asm volatile("v_cvt_pk_bf16_f32 %0, %1, %2" : "=v"(r) : "v"(lo), "v"(hi)); return r; }
typedef float f32x2 __attribute__((ext_vector_type(2)));
__device__ __forceinline__ f32x2 gelu_pk(f32x2 v) {
    const f32x2 av = __builtin_elementwise_abs(v), d = av * 0.2316418882f + 1.0f;
    f32x2 t; t.x = __builtin_amdgcn_rcpf(d.x); t.y = __builtin_amdgcn_rcpf(d.y);
    f32x2 q = t * 0.5307027145f + (-0.7265760135f); q = q * t + 0.7107068705f; q = q * t + (-0.142248368f); q = q * t + 0.127414796f; q = q * t;
    const f32x2 s = (v * v) * (-0.72134752044f);
    f32x2 e; e.x = __builtin_amdgcn_exp2f(s.x); e.y = __builtin_amdgcn_exp2f(s.y);
    const f32x2 m = v * (q * e), r = v - m;
    f32x2 o; o.x = v.x < 0.f ? m.x : r.x; o.y = v.y < 0.f ? m.y : r.y; return o;
}

template <int ACT  > struct EpiBf16 {
    static constexpr bool PERM = true, AFTER_DRAIN = false; static_assert(ACT == 0 || ACT == 1, "EpiBf16: ACT is 0 (none) or 1 (gelu_pk)");
    bf16_t* O; int ldc; const float* bias; int split_cols; size_t split_stride; float scale0;
    __device__ __forceinline__ void operator()(const f32x4 (&acc)[2][2][4][2], const Unit& u, int wr, int wc, int fr, int fq) const {
        const int row0 = u.pm * BM + wr * 64 + fr; int colt = u.pn * BM; bf16_t* base = O;
        float sc = 1.f; if (split_cols) { const int t = colt / split_cols; base += (size_t)t * split_stride; colt -= t * split_cols; if (t == 0) sc = scale0; }
        const int col0 = colt + wc * 32 + 8 * fq, bcol0 = u.pn * BM + wc * 32 + 8 * fq;
        f32x4 bv[2][2];
#pragma unroll
        for (int bj = 0; bj < 2; ++bj)
#pragma unroll
            for (int n = 0; n < 2; ++n) bv[bj][n] = bias ? *(const f32x4*)(bias + bcol0 + bj * HALF + 4 * n) : (f32x4){0.f, 0.f, 0.f, 0.f};
#pragma unroll
        for (int ai = 0; ai < 2; ++ai)
#pragma unroll
            for (int m = 0; m < 4; ++m) { bf16_t* rowp = base + (size_t)(row0 + ai * HALF + m * 16) * ldc + col0;
#pragma unroll
                for (int bj = 0; bj < 2; ++bj) { f32x4 v0 = acc[ai][bj][m][0] + bv[bj][0], v1 = acc[ai][bj][m][1] + bv[bj][1];
                    if (ACT == 1) { f32x2 a = gelu_pk((f32x2){v0[0], v0[1]}), b = gelu_pk((f32x2){v0[2], v0[3]}), c = gelu_pk((f32x2){v1[0], v1[1]}), d = gelu_pk((f32x2){v1[2], v1[3]});
                        v0 = (f32x4){a.x, a.y, b.x, b.y}; v1 = (f32x4){c.x, c.y, d.x, d.y}; }
                    v0 = v0 * sc; v1 = v1 * sc; u32x4 w; w.x = cvt_pk_bf16(v0[0], v0[1]); w.y = cvt_pk_bf16(v0[2], v0[3]); w.z = cvt_pk_bf16(v1[0], v1[1]); w.w = cvt_pk_bf16(v1[2], v1[3]);
                    *(u32x4*)(rowp + bj * HALF) = w; } }
    }
};
template <class Epi, class Sched, bool ALIGN_EPI = false, bool SP2 = false>
__device__ __forceinline__ void gemm_phase(PG8_LAS unsigned char* lds, const Gemm g, const Sched& S, const Epi& E, const int tid_in) {
    const int tid = launder_v(tid_in) & 511, wid = __builtin_amdgcn_readfirstlane(tid >> 6), lane = tid & 63, wr = wid >> 2, wc = wid & 3, fr = lane & 15, fq = lane >> 4;
    const int K = g.K, nt = K / BK;
    unsigned voffA[2], voffB[2];
#pragma unroll
    for (int i = 0; i < 2; ++i) { int R, C; stage_rc(tid * 16 + i * 8192, R, C); const int Rb = Epi::PERM ? ((R & ~31) + perm32(R & 31)) : R;
        voffA[i] = (unsigned)(R * K + C) * 2u; voffB[i] = (unsigned)(Rb * K + C) * 2u; }
    const size_t kstep = (size_t)(BK * 2);
    const size_t hstep = (size_t)HALF * K * 2;
    const size_t tstep = 2 * hstep;
    const unsigned ldsw = (unsigned)wid * 1024u;
    const int aoff = lds_byte(wr * 64 + fr, fq * 8), boff = lds_byte(wc * 32 + fr, fq * 8);
#define PG8_SA(b, h) (((b) * 2 + (h)) * HTB)
#define PG8_SB(b, h) ((4 + (b) * 2 + (h)) * HTB)
#define PG8_STAGE(bufoff, gbase, voff) do { _Pragma("unroll") for (int _i = 0; _i < 2; ++_i) \
        __builtin_amdgcn_global_load_lds((const unsigned*)((const char*)(gbase) + (voff)[_i]), (PG8_LAS unsigned*)(lds + (bufoff) + ldsw + _i * 8192), 16, 0, 0); } while (0)
#define PG8_LDA(dst, b, h) do { _Pragma("unroll") for (int m = 0; m < 4; ++m) _Pragma("unroll") for (int k = 0; k < 2; ++k) dst[m][k] = *(const PG8_LAS bf16x8*)(lds + PG8_SA(b, h) + aoff + m * 2048 + k * 1024); } while (0)
#define PG8_LDB(dst, b, h) do { _Pragma("unroll") for (int n = 0; n < 2; ++n) _Pragma("unroll") for (int k = 0; k < 2; ++k) dst[n][k] = *(const PG8_LAS bf16x8*)(lds + PG8_SB(b, h) + boff + n * 2048 + k * 1024); } while (0)
#define PG8_MMA(ai, bj, At, Bt) do { __builtin_amdgcn_s_setprio(1); _Pragma("unroll") for (int m = 0; m < 4; ++m) _Pragma("unroll") for (int n = 0; n < 2; ++n) _Pragma("unroll") for (int k = 0; k < 2; ++k) \
        acc[ai][bj][m][n] = __builtin_amdgcn_mfma_f32_16x16x32_bf16(Bt[n][k], At[m][k], acc[ai][bj][m][n], 0, 0, 0); __builtin_amdgcn_s_setprio(0); } while (0)
#define PG8_WAIT_V(n) asm volatile("s_waitcnt vmcnt(" #n ")" ::: "memory")
#define PG8_WAIT_L(n) asm volatile("s_waitcnt lgkmcnt(" #n ")" ::: "memory")
#define PG8_BAR __builtin_amdgcn_s_barrier()
#define PG8_SCHED __builtin_amdgcn_sched_barrier(0)
    Unit cur, nxt; int ui = 0;
    if (!S.next(0, cur)) return;
    f32x4 acc[2][2][4][2];
#pragma unroll
    for (int a = 0; a < 2; ++a)
#pragma unroll
        for (int b = 0; b < 2; ++b)
#pragma unroll
            for (int m = 0; m < 4; ++m)
#pragma unroll
                for (int n = 0; n < 2; ++n) acc[a][b][m][n] = (f32x4){0.f, 0.f, 0.f, 0.f};
    bf16x8 At[4][2], B0[2][2], B1[2][2];
    const char* cA = (const char*)g.A + (size_t)cur.pm * tstep; const char* cB = (const char*)g.Bt + (size_t)cur.pn * tstep;
    S.a_ready(cur);
    if constexpr (SP2) {
        PG8_STAGE(PG8_SB(0, 0), cB, voffB); PG8_STAGE(PG8_SB(0, 1), cB + hstep, voffB); PG8_STAGE(PG8_SA(0, 0), cA, voffA); PG8_STAGE(PG8_SA(0, 1), cA + hstep, voffA);
        if (wr == 1) PG8_BAR;
        PG8_WAIT_V(2); PG8_BAR;
        PG8_STAGE(PG8_SB(1, 0), cB + kstep, voffB); PG8_STAGE(PG8_SA(1, 0), cA + kstep, voffA); PG8_STAGE(PG8_SB(1, 1), cB + hstep + kstep, voffB);
        PG8_WAIT_V(6); PG8_BAR;
    } else {
        PG8_STAGE(PG8_SB(0, 0), cB, voffB); PG8_STAGE(PG8_SA(0, 0), cA, voffA); PG8_STAGE(PG8_SB(0, 1), cB + hstep, voffB); PG8_STAGE(PG8_SA(0, 1), cA + hstep, voffA);
        if (wr == 1) PG8_BAR;
        PG8_WAIT_V(4); PG8_BAR;
        PG8_STAGE(PG8_SB(1, 0), cB + kstep, voffB); PG8_STAGE(PG8_SA(1, 0), cA + kstep, voffA); PG8_STAGE(PG8_SB(1, 1), cB + hstep + kstep, voffB);
        PG8_WAIT_V(6); PG8_BAR;
    }
    for (;;) {
        const bool has_next = S.next(ui + 1, nxt);
        const char* nA = has_next ? (const char*)g.A + (size_t)nxt.pm * tstep : cA; const char* nB = has_next ? (const char*)g.Bt + (size_t)nxt.pn * tstep : cB;
        for (int t = 0; t < nt; t += 2) {
            const bool last = (t == nt - 2);
            const char* a1 = cA + (size_t)(t + 1) * kstep;
            const char* a2 = last ? nA : cA + (size_t)(t + 2) * kstep; const char* b2 = last ? nB : cB + (size_t)(t + 2) * kstep;
            const char* a3 = a2 + kstep; const char* b3 = b2 + kstep;
            if (last && has_next) S.a_ready(nxt);
            if constexpr (SP2) {
            PG8_LDB(B0, 0, 0); PG8_LDB(B1, 0, 1); PG8_SCHED; PG8_LDA(At, 0, 0); PG8_STAGE(PG8_SA(1, 1), a1 + hstep, voffA);
            PG8_WAIT_V(8); PG8_WAIT_L(0); PG8_BAR; PG8_MMA(0, 0, At, B0); PG8_MMA(0, 1, At, B1); PG8_BAR; PG8_SCHED;
            PG8_LDA(At, 0, 1); PG8_STAGE(PG8_SB(0, 0), b2, voffB); PG8_STAGE(PG8_SB(0, 1), b2 + hstep, voffB); PG8_STAGE(PG8_SA(0, 0), a2, voffA);
            PG8_WAIT_V(8); PG8_WAIT_L(0); PG8_BAR; PG8_MMA(1, 0, At, B0); PG8_MMA(1, 1, At, B1); PG8_BAR; PG8_SCHED;
            PG8_LDB(B0, 1, 0); PG8_LDB(B1, 1, 1); PG8_SCHED; PG8_LDA(At, 1, 0); PG8_STAGE(PG8_SA(0, 1), a2 + hstep, voffA);
            PG8_WAIT_V(8); PG8_WAIT_L(0); PG8_BAR; PG8_MMA(0, 0, At, B0); PG8_MMA(0, 1, At, B1); PG8_BAR; PG8_SCHED;
            PG8_LDA(At, 1, 1); PG8_STAGE(PG8_SB(1, 0), b3, voffB); PG8_STAGE(PG8_SB(1, 1), b3 + hstep, voffB); PG8_STAGE(PG8_SA(1, 0), a3, voffA);
            PG8_WAIT_V(8); PG8_WAIT_L(0); PG8_BAR; PG8_MMA(1, 0, At, B0); PG8_MMA(1, 1, At, B1); PG8_BAR; PG8_SCHED;
            } else {
            PG8_LDB(B0, 0, 0); PG8_SCHED; PG8_LDA(At, 0, 0); PG8_STAGE(PG8_SA(1, 1), a1 + hstep, voffA);
            PG8_WAIT_L(8); PG8_BAR; PG8_WAIT_L(0); PG8_MMA(0, 0, At, B0); PG8_BAR; PG8_SCHED;
            PG8_LDB(B1, 0, 1); PG8_STAGE(PG8_SB(0, 0), b2, voffB);
            PG8_BAR; PG8_WAIT_L(0); PG8_MMA(0, 1, At, B1); PG8_BAR;
            PG8_LDA(At, 0, 1); PG8_STAGE(PG8_SA(0, 0), a2, voffA);
            PG8_BAR; PG8_WAIT_L(0); PG8_MMA(1, 0, At, B0); PG8_BAR; PG8_SCHED;
            PG8_STAGE(PG8_SB(0, 1), b2 + hstep, voffB);
            PG8_WAIT_V(6); PG8_BAR; PG8_MMA(1, 1, At, B1); PG8_BAR;
            PG8_LDB(B0, 1, 0); PG8_SCHED; PG8_LDA(At, 1, 0); PG8_STAGE(PG8_SA(0, 1), a2 + hstep, voffA);
            PG8_WAIT_L(8); PG8_BAR; PG8_WAIT_L(0); PG8_MMA(0, 0, At, B0); PG8_BAR; PG8_SCHED;
            PG8_LDB(B1, 1, 1); PG8_STAGE(PG8_SB(1, 0), b3, voffB);
            PG8_BAR; PG8_WAIT_L(0); PG8_MMA(0, 1, At, B1); PG8_BAR;
            PG8_LDA(At, 1, 1); PG8_STAGE(PG8_SA(1, 0), a3, voffA);
            PG8_BAR; PG8_WAIT_L(0); PG8_MMA(1, 0, At, B0); PG8_BAR; PG8_SCHED;
            PG8_STAGE(PG8_SB(1, 1), b3 + hstep, voffB);
            PG8_WAIT_V(6); PG8_BAR; PG8_MMA(1, 1, At, B1); PG8_BAR;
            }
        }
        if constexpr (ALIGN_EPI) { if (wr == 0) PG8_BAR; }
        if constexpr (!Epi::AFTER_DRAIN) { E(acc, cur, wr, wc, fr, fq); S.done(cur); }
        if (!has_next) break;
#pragma unroll
        for (int a = 0; a < 2; ++a)
#pragma unroll
            for (int b = 0; b < 2; ++b)
#pragma unroll
                for (int m = 0; m < 4; ++m)
#pragma unroll
                    for (int n = 0; n < 2; ++n) acc[a][b][m][n] = (f32x4){0.f, 0.f, 0.f, 0.f};
        cur = nxt; cA = nA; cB = nB; ++ui;
        if constexpr (ALIGN_EPI) { if (wr == 1) PG8_BAR; }
    }
    PG8_WAIT_V(0);
    if constexpr (!ALIGN_EPI) { if (wr == 0) PG8_BAR; }
    PG8_BAR;
    if constexpr (Epi::AFTER_DRAIN) { E.fused(acc, cur, wr, wc, fr, fq, lds, wid, lane); S.done(cur); }
#undef PG8_SA
#undef PG8_SB
#undef PG8_STAGE
#undef PG8_LDA
#undef PG8_LDB
#undef PG8_MMA
#undef PG8_WAIT_V
#undef PG8_WAIT_L
#undef PG8_BAR
#undef PG8_SCHED
}
}

namespace pg8 {
__device__ __forceinline__ float gelu_tanh(float x) {
    const float t = x * (1.5957691216057308f + 0.07135481627f * x * x);
    const float e = __builtin_amdgcn_exp2f(-1.4426950408889634f * t);
    return x * __builtin_amdgcn_rcpf(1.0f + e);
}
template <int ACT> struct EpiT {
    static constexpr bool PERM = true, AFTER_DRAIN = false;
    bf16_t* O; int ldc;
    __device__ __forceinline__ void operator()(const f32x4 (&acc)[2][2][4][2], const Unit& u, int wr, int wc, int fr, int fq) const {
        const int row0 = u.pm * BM + wr * 64 + fr; const int col0 = u.pn * BM + wc * 32 + 8 * fq;
#pragma unroll
        for (int ai = 0; ai < 2; ++ai)
#pragma unroll
            for (int m = 0; m < 4; ++m) { bf16_t* rowp = O + (size_t)(row0 + ai * HALF + m * 16) * ldc + col0;
#pragma unroll
                for (int bj = 0; bj < 2; ++bj) { f32x4 v0 = acc[ai][bj][m][0], v1 = acc[ai][bj][m][1];
                    if (ACT == 2) { v0 = (f32x4){gelu_tanh(v0[0]), gelu_tanh(v0[1]), gelu_tanh(v0[2]), gelu_tanh(v0[3])}; v1 = (f32x4){gelu_tanh(v1[0]), gelu_tanh(v1[1]), gelu_tanh(v1[2]), gelu_tanh(v1[3])}; }
                    u32x4 w; w.x = cvt_pk_bf16(v0[0], v0[1]); w.y = cvt_pk_bf16(v0[2], v0[3]); w.z = cvt_pk_bf16(v1[0], v1[1]); w.w = cvt_pk_bf16(v1[2], v1[3]);
                    *(u32x4*)(rowp + bj * HALF) = w; } }
    }
};
struct EpiR {
    static constexpr bool PERM = true, AFTER_DRAIN = false;
    bf16_t* O; int ldc; int act; int rope; const float* ropet;
    __device__ __forceinline__ void operator()(const f32x4 (&acc)[2][2][4][2], const Unit& u, int wr, int wc, int fr, int fq) const {
        const int row0 = u.pm * BM + wr * 64 + fr; const int col0 = u.pn * BM + wc * 32 + 8 * fq;
        const bool rrows = rope != 0 && u.pm < 64;
#pragma unroll
        for (int ai = 0; ai < 2; ++ai)
#pragma unroll
            for (int m = 0; m < 4; ++m) { const int grow = row0 + ai * HALF + m * 16; bf16_t* rowp = O + (size_t)grow * ldc + col0;
#pragma unroll
                for (int bj = 0; bj < 2; ++bj) { f32x4 v0 = acc[ai][bj][m][0], v1 = acc[ai][bj][m][1];
                    if (act) { v0 = (f32x4){gelu_tanh(v0[0]), gelu_tanh(v0[1]), gelu_tanh(v0[2]), gelu_tanh(v0[3])}; v1 = (f32x4){gelu_tanh(v1[0]), gelu_tanh(v1[1]), gelu_tanh(v1[2]), gelu_tanh(v1[3])}; }
                    if (rrows) { const int blk = u.pn * 8 + bj * 4 + wc; const int b6 = blk % 6; const bool on = rope == 1 ? (blk < 128) : (b6 >= 4); const int half = rope == 1 ? (blk & 1) : (b6 - 4);
                        if (on) { const int t = grow & 8191; const int pos = half ? (t & 63) : (t >> 6);
                            const float* cp = ropet + pos * 16 + 8 * (fq & 1); const f32x4 c0 = *(const f32x4*)cp, c1 = *(const f32x4*)(cp + 4), s0 = *(const f32x4*)(cp + 2048), s1 = *(const f32x4*)(cp + 2052);
                            f32x4 p0, p1;
#pragma unroll
                            for (int i = 0; i < 4; ++i) { const float a_ = v0[i], b_ = v1[i];
                                const auto r0 = __builtin_amdgcn_permlane32_swap(__float_as_uint(a_), __float_as_uint(a_), false, false);
                                const auto r1 = __builtin_amdgcn_permlane32_swap(__float_as_uint(b_), __float_as_uint(b_), false, false);
                                const unsigned x0_ = (fq & 2) ? r0[0] : r0[1], x1_ = (fq & 2) ? r1[0] : r1[1]; p0[i] = __uint_as_float(x0_); p1[i] = __uint_as_float(x1_); }
                            if (fq & 2) { v0 = p0 * s0 + v0 * c0; v1 = p1 * s1 + v1 * c1; } else { v0 = v0 * c0 - p0 * s0; v1 = v1 * c1 - p1 * s1; } } }
                    u32x4 w; w.x = cvt_pk_bf16(v0[0], v0[1]); w.y = cvt_pk_bf16(v0[2], v0[3]); w.z = cvt_pk_bf16(v1[0], v1[1]); w.w = cvt_pk_bf16(v1[2], v1[3]);
                    *(u32x4*)(rowp + bj * HALF) = w; } }
    }
};
}

constexpr int DM = 2048, NBATCH = 2, SEQ = 8192, CTXL = 256;
constexpr int ML = NBATCH * SEQ;
constexpr int MC = NBATCH * CTXL;
constexpr int MT = ML + MC;
constexpr int NLAYER = 4;
constexpr float ALPHA = 1.6817928305074290f, LN_EPS = 1e-6f;
constexpr int NWAVES = 8;
constexpr float U_SCALE = 64.0f, V_SCALE = 4.0f;
constexpr int PROW = 1536;
constexpr int PREC = 2 * PROW;
constexpr int NPH = 35;

constexpr size_t MiB = 1ull << 20;
constexpr size_t WS_CTL = 0, CTL_ZERO_BYTES = 1 * MiB;
constexpr int    CW_BAR = 4096;
constexpr size_t WS_MOD = 128 * 1024;
constexpr size_t WS_VST = 1 * MiB;
constexpr size_t WS_ROPE = 1 * MiB + 160 * 1024;
constexpr size_t WS_MODP = 1 * MiB + 256 * 1024;
constexpr size_t WS_GMWIN = 6 * MiB;
constexpr size_t WS_GMWOUT = WS_GMWIN + 32 * MiB;
constexpr size_t WS_GMWS = WS_GMWOUT + 16 * MiB;
constexpr size_t WS_PWQ = WS_GMWS + 1 * MiB;
constexpr size_t WS_PK1 = WS_PWQ + 32 * MiB;
constexpr size_t WS_PK2 = WS_PK1 + 512 * 1024;
constexpr size_t WS_MLAIN = WS_PK1 + 1 * MiB;
constexpr size_t WS_MLAUQ = WS_MLAIN + 5 * MiB;
constexpr size_t WS_MLAUKV = WS_MLAUQ + 3 * MiB;
constexpr size_t WS_MLAOUT = WS_MLAUKV + 4 * MiB;
constexpr size_t WS_DAIN = WS_MLAOUT + 8 * MiB;
constexpr size_t WS_DAOUT = WS_DAIN + 24 * MiB;
constexpr size_t WS_PU = WS_DAOUT + 8 * MiB;
constexpr size_t WS_PV = WS_PU + 96 * MiB;
constexpr size_t WS_X = WS_PV + 96 * MiB;
constexpr size_t WS_H = WS_X + 66 * MiB;
constexpr size_t WS_G = WS_H + 66 * MiB;
constexpr size_t WS_Y = WS_G + 66 * MiB;
constexpr size_t WS_QP = WS_Y + 66 * MiB;
constexpr size_t WS_Z = WS_QP + 66 * MiB;
constexpr size_t WS_C = WS_Z + 198 * MiB;
constexpr size_t WS_CQN = WS_C + 42 * MiB;
constexpr size_t WS_CKVN = WS_CQN + 17 * MiB;
constexpr size_t WS_KR = WS_CKVN + 17 * MiB;
constexpr size_t WS_QM = WS_KR + 3 * MiB;
constexpr size_t WS_KV = WS_QM + 99 * MiB;
constexpr size_t WS_ROUTE = WS_KV + 132 * MiB;
constexpr size_t WS_END = WS_ROUTE + 17 * MiB;
static_assert((size_t)MT * DM * 2 == 66 * MiB, "row buffer size");

constexpr int RING_BYTES = 155648, MISC_OFF = RING_BYTES + 320, LDS_BYTES = 159744;

#define GAS __attribute__((address_space(1)))
#define LAS __attribute__((address_space(3)))
typedef unsigned short bf16;
typedef unsigned u32x4 __attribute__((ext_vector_type(4)));
typedef unsigned u32x2 __attribute__((ext_vector_type(2)));
typedef float f32x4 __attribute__((ext_vector_type(4)));
typedef float f32x16 __attribute__((ext_vector_type(16)));
typedef short bf16x8 __attribute__((ext_vector_type(8)));
typedef short s16x4 __attribute__((ext_vector_type(4)));
#define LDS_WAIT() asm volatile("s_waitcnt lgkmcnt(0)" ::: "memory")

__device__ __forceinline__ unsigned cvtpk(float lo, float hi) { unsigned r; asm("v_cvt_pk_bf16_f32 %0, %1, %2" : "=v"(r) : "v"(lo), "v"(hi)); return r; }
__device__ __forceinline__ float bflo(unsigned w) { return __uint_as_float(w << 16); }
__device__ __forceinline__ float bfhi(unsigned w) { return __uint_as_float(w & 0xffff0000u); }
__device__ __forceinline__ float bf1(bf16 b) { return __uint_as_float((unsigned)b << 16); }
__device__ __forceinline__ bf16 tobf1(float f) { return (bf16)(cvtpk(f, 0.f) & 0xffffu); }
#define DPP_F(v, ctrl) __int_as_float(__builtin_amdgcn_mov_dpp(__float_as_int(v), (ctrl), 0xF, 0xF, true))
__device__ __forceinline__ float row_sum16(float v) { v += DPP_F(v, 0xB1); v += DPP_F(v, 0x4E); v += DPP_F(v, 0x141); v += DPP_F(v, 0x140); return v; }
__device__ __forceinline__ float sum_xor16(float v) { const auto r = __builtin_amdgcn_permlane16_swap(__float_as_uint(v), __float_as_uint(v), false, false); return __uint_as_float(r[0]) + __uint_as_float(r[1]); }
__device__ __forceinline__ float sum_xor32(float v) { const auto r = __builtin_amdgcn_permlane32_swap(__float_as_uint(v), __float_as_uint(v), false, false); return __uint_as_float(r[0]) + __uint_as_float(r[1]); }
__device__ __forceinline__ float wave_sum(float v) { return sum_xor32(sum_xor16(row_sum16(v))); }
__device__ __forceinline__ float half_sum32(float v) { return sum_xor16(row_sum16(v)); }
__device__ __forceinline__ float lane_xor16(float v, int lane) { const auto r = __builtin_amdgcn_permlane16_swap(__float_as_uint(v), __float_as_uint(v), false, false); return __uint_as_float((lane & 16) ? r[0] : r[1]); }
__device__ __forceinline__ unsigned lane_xor32(unsigned v, int lane) { const auto r = __builtin_amdgcn_permlane32_swap(v, v, false, false); return (lane & 32) ? r[0] : r[1]; }
__device__ __forceinline__ float gelu_tanh(float x) { return pg8::gelu_tanh(x); }

__device__ __forceinline__ void load_row_bf16(const bf16* row, int lane, float (&v)[32]) {
#pragma unroll
    for (int j = 0; j < 4; ++j) { const u32x4 w = ((const u32x4*)row)[64 * j + lane];
        v[8 * j + 0] = bflo(w.x); v[8 * j + 1] = bfhi(w.x); v[8 * j + 2] = bflo(w.y); v[8 * j + 3] = bfhi(w.y);
        v[8 * j + 4] = bflo(w.z); v[8 * j + 5] = bfhi(w.z); v[8 * j + 6] = bflo(w.w); v[8 * j + 7] = bfhi(w.w); }
}
__device__ __forceinline__ void store_row_bf16(bf16* row, int lane, const float (&v)[32]) {
#pragma unroll
    for (int j = 0; j < 4; ++j) { u32x4 w; w.x = cvtpk(v[8 * j + 0], v[8 * j + 1]); w.y = cvtpk(v[8 * j + 2], v[8 * j + 3]); w.z = cvtpk(v[8 * j + 4], v[8 * j + 5]); w.w = cvtpk(v[8 * j + 6], v[8 * j + 7]);
        ((u32x4*)row)[64 * j + lane] = w; }
}
__device__ __forceinline__ void load_row_f32(const float* row, int lane, float (&v)[32]) {
#pragma unroll
    for (int j = 0; j < 4; ++j) { const f32x4 a = ((const f32x4*)row)[128 * j + 2 * lane], b = ((const f32x4*)row)[128 * j + 2 * lane + 1];
        v[8 * j + 0] = a.x; v[8 * j + 1] = a.y; v[8 * j + 2] = a.z; v[8 * j + 3] = a.w; v[8 * j + 4] = b.x; v[8 * j + 5] = b.y; v[8 * j + 6] = b.z; v[8 * j + 7] = b.w; }
}
__device__ __forceinline__ void store_row_f32(float* row, int lane, const float (&v)[32]) {
#pragma unroll
    for (int j = 0; j < 4; ++j) { ((f32x4*)row)[128 * j + 2 * lane] = (f32x4){v[8 * j + 0], v[8 * j + 1], v[8 * j + 2], v[8 * j + 3]};
        ((f32x4*)row)[128 * j + 2 * lane + 1] = (f32x4){v[8 * j + 4], v[8 * j + 5], v[8 * j + 6], v[8 * j + 7]}; }
}
__device__ __forceinline__ void load_row_bf16_b(const bf16* row, int lane, float (&v)[32]) {
#pragma unroll
    for (int j = 0; j < 4; ++j) { const u32x4 w = ((const u32x4*)row)[4 * lane + j];
        v[8 * j + 0] = bflo(w.x); v[8 * j + 1] = bfhi(w.x); v[8 * j + 2] = bflo(w.y); v[8 * j + 3] = bfhi(w.y);
        v[8 * j + 4] = bflo(w.z); v[8 * j + 5] = bfhi(w.z); v[8 * j + 6] = bflo(w.w); v[8 * j + 7] = bfhi(w.w); }
}
__device__ __forceinline__ void store_row_bf16_b(bf16* row, int lane, const float (&v)[32]) {
#pragma unroll
    for (int j = 0; j < 4; ++j) { u32x4 w; w.x = cvtpk(v[8 * j + 0], v[8 * j + 1]); w.y = cvtpk(v[8 * j + 2], v[8 * j + 3]); w.z = cvtpk(v[8 * j + 4], v[8 * j + 5]); w.w = cvtpk(v[8 * j + 6], v[8 * j + 7]);
        ((u32x4*)row)[4 * lane + j] = w; }
}
__device__ __forceinline__ void load_row_f32_b(const float* row, int lane, float (&v)[32]) {
#pragma unroll
    for (int q = 0; q < 8; ++q) { const f32x4 a = ((const f32x4*)row)[8 * lane + q];
        v[4 * q + 0] = a.x; v[4 * q + 1] = a.y; v[4 * q + 2] = a.z; v[4 * q + 3] = a.w; }
}
__device__ __forceinline__ void store_row_f32_b(float* row, int lane, const float (&v)[32]) {
#pragma unroll
    for (int q = 0; q < 8; ++q) ((f32x4*)row)[8 * lane + q] = (f32x4){v[4 * q + 0], v[4 * q + 1], v[4 * q + 2], v[4 * q + 3]};
}
__device__ __forceinline__ void ln_stats(const float (&v)[32], float& mean, float& rstd) {
    float s = 0.f;
#pragma unroll
    for (int i = 0; i < 32; ++i) s += v[i];
    mean = wave_sum(s) * (1.0f / DM);
    float q = 0.f;
#pragma unroll
    for (int i = 0; i < 32; ++i) { const float d = v[i] - mean; q += d * d; }
    rstd = 1.0f / sqrtf(wave_sum(q) * (1.0f / DM) + LN_EPS);
}
template <bool LAYB>
__device__ __forceinline__ void finish_row(float (&z)[32], const float* lng, const float* lnb, bf16* Xrow, const float* sh, const float* sc, bf16* Hrow, float* Orow, int lane) {
    float mean, rstd; ln_stats(z, mean, rstd);
    { float g[32], b[32]; if (LAYB) { load_row_f32_b(lng, lane, g); load_row_f32_b(lnb, lane, b); } else { load_row_f32(lng, lane, g); load_row_f32(lnb, lane, b); }
#pragma unroll
      for (int i = 0; i < 32; ++i) z[i] = (z[i] - mean) * rstd * g[i] + b[i]; }
    if (Xrow) { if (LAYB) store_row_bf16_b(Xrow, lane, z); else store_row_bf16(Xrow, lane, z); }
    if (Orow) { if (LAYB) store_row_f32_b(Orow, lane, z); else store_row_f32(Orow, lane, z); }
    if (Hrow) {
        ln_stats(z, mean, rstd);
        float a[32], s[32]; if (LAYB) { load_row_f32_b(sc, lane, a); load_row_f32_b(sh, lane, s); } else { load_row_f32(sc, lane, a); load_row_f32(sh, lane, s); }
#pragma unroll
        for (int i = 0; i < 32; ++i) a[i] = (z[i] - mean) * rstd * (1.0f + a[i]) + s[i];
        if (LAYB) store_row_bf16_b(Hrow, lane, a); else store_row_bf16(Hrow, lane, a);
    }
}
__device__ __forceinline__ int row_slot(int row) { return row < ML ? (row >> 13) : 2; }

__device__ __forceinline__ unsigned f2bf_rne(float f) { unsigned u = __float_as_uint(f); return (u + 0x7fffu + ((u >> 16) & 1u)) >> 16; }
__device__ __forceinline__ unsigned pk2(float lo, float hi) { return f2bf_rne(lo) | (f2bf_rne(hi) << 16); }
__device__ __forceinline__ void p0_transpose_item(const float* W, int K, int N, bf16* WT, LAS float* scr, int item, int lane) {
    const int nblk = N / 32, kb = item / nblk, nb = item % nblk, k0 = 64 * kb, n0 = 32 * nb;
    f32x4 t[8];
#pragma unroll
    for (int i = 0; i < 8; ++i) t[i] = *(const f32x4*)(W + (size_t)(k0 + 8 * i + (lane >> 3)) * N + n0 + 4 * (lane & 7));
#pragma unroll
    for (int i = 0; i < 8; ++i) { LAS float* d = scr + (8 * i + (lane >> 3)) * 33 + 4 * (lane & 7); d[0] = t[i].x; d[1] = t[i].y; d[2] = t[i].z; d[3] = t[i].w; }
    LDS_WAIT(); asm volatile("" ::: "memory");
    const int c = lane & 7;
#pragma unroll
    for (int j = 0; j < 4; ++j) { const int n = (lane >> 3) + 8 * j; const LAS float* s = scr + (8 * c) * 33 + n;
        u32x4 o; o.x = pk2(s[0 * 33], s[1 * 33]); o.y = pk2(s[2 * 33], s[3 * 33]); o.z = pk2(s[4 * 33], s[5 * 33]); o.w = pk2(s[6 * 33], s[7 * 33]);
        *(u32x4*)(WT + (size_t)(n0 + n) * K + k0 + 8 * c) = o; }
    LDS_WAIT(); asm volatile("" ::: "memory");
}
__device__ __forceinline__ void cvt_range(const float* src, bf16* dst, size_t n8, size_t gtid, size_t gthreads) {
#pragma unroll 4
    for (size_t i = gtid; i < n8; i += gthreads) { const f32x4 a = ((const f32x4*)src)[2 * i], b = ((const f32x4*)src)[2 * i + 1];
        u32x4 w; w.x = cvtpk(a.x, a.y); w.y = cvtpk(a.z, a.w); w.z = cvtpk(b.x, b.y); w.w = cvtpk(b.z, b.w); ((u32x4*)dst)[i] = w; }
}
__device__ __forceinline__ unsigned enc_e2m3(float x) {
    const unsigned sgn = (__float_as_uint(x) >> 26) & 32u;
    const float ax = fminf(fabsf(x), 7.5f);
    unsigned u = __float_as_uint(ax); u += 0x7FFFFu + ((u >> 20) & 1u);
    const unsigned cn = (u >> 20) - ((127u - 1u) << 3);
    const unsigned cs = (unsigned)__builtin_rintf(ax * 8.0f);
    return sgn | (ax < 1.0f ? cs : cn);
}
typedef float f32x16v __attribute__((ext_vector_type(16)));
typedef float f32x32v __attribute__((ext_vector_type(32)));
typedef unsigned u32x6v __attribute__((ext_vector_type(6)));
__device__ __forceinline__ u32x6v pack_fp6_32(const float (&e)[32], bool interleaved) {
    f32x16v s0, s1;
    if (interleaved) {
#pragma unroll
        for (int i = 0; i < 16; ++i) { s0[i] = e[2 * i]; s1[i] = e[2 * i + 1]; }
    } else {
#pragma unroll
        for (int i = 0; i < 16; ++i) { s0[i] = e[i]; s1[i] = e[16 + i]; }
    }
    return __builtin_amdgcn_cvt_scalef32_2xpk16_fp6_f32(s0, s1, 1.0f);
}
__device__ __forceinline__ void cvt_table_fp6(const float* src, unsigned char* dst, int nrows, float scale, LAS float* scr  , int lane, int gw, int NGW, const int isv) {
    bool interleaved;
    {
        float t[32];
#pragma unroll
        for (int k = 0; k < 32; ++k) t[k] = k < 16 ? 0.125f * k : (k < 24 ? 2.0f + 0.25f * (k - 16) : 4.0f + 0.5f * (k - 24));
        float tt[32];
#pragma unroll
        for (int k = 0; k < 32; ++k) { tt[k] = t[k]; asm volatile("" : "+v"(tt[k])); }
        const u32x6v p = pack_fp6_32(tt, true);
        const f32x32v o = __builtin_amdgcn_cvt_scalef32_pk32_f32_fp6(p, 1.0f);
        interleaved = (o[1] == t[1]) && (o[2] == t[2]) && (o[17] == t[17]);
        interleaved = __all(interleaved);
    }
    for (int row = gw; row < nrows; row += NGW) {
        const f32x4* s4 = (const f32x4*)(src + (size_t)row * 2048);
#pragma unroll
        for (int q = 0; q < 8; ++q) { const int s = 64 * q + lane; const f32x4 a = s4[s] * scale; *(LAS f32x4*)(scr + 4 * (s ^ ((s >> 4) & 7))) = a; }
        float e[32];
#pragma unroll
        for (int j = 0; j < 8; ++j) { const int s = 8 * lane + j; const f32x4 a = *(const LAS f32x4*)(scr + 4 * (s ^ ((s >> 4) & 7)));
            e[4 * j + 0] = __builtin_amdgcn_fmed3f(a.x, -7.5f, 7.5f); e[4 * j + 1] = __builtin_amdgcn_fmed3f(a.y, -7.5f, 7.5f); e[4 * j + 2] = __builtin_amdgcn_fmed3f(a.z, -7.5f, 7.5f); e[4 * j + 3] = __builtin_amdgcn_fmed3f(a.w, -7.5f, 7.5f); }
        const u32x6v p = pack_fp6_32(e, interleaved);
        unsigned char* rowp = dst + (size_t)row * PREC;
        *(u32x4*)(rowp + 1024 * isv + 16 * lane) = (u32x4){p[0], p[1], p[2], p[3]}; *(u32x2*)(rowp + 2048 + 512 * isv + 8 * lane) = (u32x2){p[4], p[5]};
    }
}
__device__ __forceinline__ float silu(float x) { return x / (1.0f + __expf(-x)); }

struct Params { const float* in[29]; float* out; unsigned char* ws; int ph_lo, ph_hi; };
typedef const __attribute__((address_space(4))) Params* CP;

__device__ __forceinline__ void p0_prologue(CP P, LAS unsigned char* lds, int tid, int lane, int wid, int gw, int NGW) {
    unsigned char* ws = P->ws;
    LAS float* scr = (LAS float*)(lds + wid * 16384);
    {
        constexpr int I_GMIN = (2048 / 64) * (4096 / 32), I_SQ = (2048 / 64) * (2048 / 32), I_MIN = (2048 / 64) * (1088 / 32), I_UQ = (512 / 64) * (3072 / 32), I_UKV = (512 / 64) * (4096 / 32), I_DIN = (2048 / 64) * (6144 / 32);
        constexpr int NIT = 2 * I_GMIN + 2 * I_SQ + 4 * I_SQ + I_MIN + I_UQ + I_UKV + I_SQ + I_DIN + I_SQ;
        for (int it = gw; it < NIT; it += NGW) {
            int r = it;
            if (r < 2 * I_GMIN) { const int j = r / I_GMIN; p0_transpose_item(P->in[13] + (size_t)j * 2048 * 4096, 2048, 4096, (bf16*)(ws + WS_GMWIN) + (size_t)j * 4096 * 2048, scr, r % I_GMIN, lane); continue; } r -= 2 * I_GMIN;
            if (r < 2 * I_SQ) { const int j = r / I_SQ; p0_transpose_item(P->in[18] + (size_t)j * 2048 * 2048, 2048, 2048, (bf16*)(ws + WS_GMWOUT) + (size_t)j * 2048 * 2048, scr, r % I_SQ, lane); continue; } r -= 2 * I_SQ;
            if (r < 4 * I_SQ) { const int j = r / I_SQ; p0_transpose_item(P->in[8] + (size_t)j * 2048 * 2048, 2048, 2048, (bf16*)(ws + WS_PWQ) + (size_t)j * 2048 * 2048, scr, r % I_SQ, lane); continue; } r -= 4 * I_SQ;
            if (r < I_MIN) { p0_transpose_item(P->in[19], 2048, 1088, (bf16*)(ws + WS_MLAIN), scr, r, lane); continue; } r -= I_MIN;
            if (r < I_UQ) { p0_transpose_item(P->in[22], 512, 3072, (bf16*)(ws + WS_MLAUQ), scr, r, lane); continue; } r -= I_UQ;
            if (r < I_UKV) { p0_transpose_item(P->in[23], 512, 4096, (bf16*)(ws + WS_MLAUKV), scr, r, lane); continue; } r -= I_UKV;
            if (r < I_SQ) { p0_transpose_item(P->in[24], 2048, 2048, (bf16*)(ws + WS_MLAOUT), scr, r, lane); continue; } r -= I_SQ;
            if (r < I_DIN) { p0_transpose_item(P->in[25], 2048, 6144, (bf16*)(ws + WS_DAIN), scr, r, lane); continue; } r -= I_DIN;
            p0_transpose_item(P->in[28], 2048, 2048, (bf16*)(ws + WS_DAOUT), scr, r, lane);
        }
    }
    const size_t gtid = (size_t)gw * 64 + lane, gthreads = (size_t)NGW * 64;
    { u32x4* z = (u32x4*)((bf16*)(ws + WS_MLAIN) + (size_t)1088 * 2048); const size_t n = (size_t)192 * 2048 / 8;
      for (size_t i = gtid; i < n; i += gthreads) z[i] = (u32x4){0u, 0u, 0u, 0u}; }
    cvt_range(P->in[16], (bf16*)(ws + WS_GMWS), (size_t)2 * 16 * 128 * 128 / 8, gtid, gthreads);
    cvt_range(P->in[9], (bf16*)(ws + WS_PK1), (size_t)4 * 128 * 128 / 8, gtid, gthreads);
    cvt_range(P->in[10], (bf16*)(ws + WS_PK2), (size_t)4 * 128 * 128 / 8, gtid, gthreads);
    cvt_table_fp6(P->in[11], ws + WS_PU, 16384, U_SCALE, scr, lane, gw, NGW, 0);
    cvt_table_fp6(P->in[12], ws + WS_PU, 16384, V_SCALE, scr, lane, gw, NGW, 1);
    if (gtid < 2048) { const int pos = (int)gtid >> 4, f = (int)gtid & 15; const float inv = powf(10000.0f, -(float)f * (1.0f / 16.0f)); float sn, cs; sincosf((float)pos * inv, &sn, &cs);
        float* rt = (float*)(ws + WS_ROPE); rt[gtid] = cs; rt[2048 + gtid] = sn; }
    {
        const float* cv = P->in[1]; const float* cc = P->in[3]; const float* mw = P->in[4]; float* PART = (float*)(ws + WS_MODP);
        for (int item = gw; item < 4 * 192 * 8; item += NGW) {
            const int ks = item & 7, r = item >> 3, L = r / 192, n = (r % 192) * 64 + lane;
            const float* W = mw + (size_t)L * 2048 * 12288 + (size_t)(ks * 256) * 12288 + n;
            float a0 = 0.f, a1 = 0.f, a2 = 0.f;
#pragma unroll 32
            for (int k = 0; k < 256; ++k) { const int kk = ks * 256 + k; const float s0 = silu(cv[kk]), s1 = silu(cv[2048 + kk]), s2 = silu(cc[kk]);
                const float w = W[(size_t)k * 12288]; a0 += s0 * w; a1 += s1 * w; a2 += s2 * w; }
            float* o = PART + ((size_t)ks * 4 + L) * 3 * 12288 + n;
            o[0] = a0; o[12288] = a1; o[24576] = a2;
        }
    }
}
__device__ __forceinline__ void mod_reduce(CP P, int gw, int lane, int NGW) {
    const float* PART = (const float*)(P->ws + WS_MODP); float* MOD = (float*)(P->ws + WS_MOD); const float* mb = P->in[5];
    for (int i = gw * 64 + lane; i < 4 * 3 * 12288; i += NGW * 64) {
        const int L = i / (3 * 12288), n = i % 12288;
        float s = mb[(size_t)L * 12288 + n];
#pragma unroll
        for (int ks = 0; ks < 8; ++ks) s += PART[(size_t)ks * 4 * 3 * 12288 + i];
        MOD[i] = s;
    }
}

__device__ __forceinline__ void first_row_pass(CP P, int lane, int gw, int NGW) {
    const float* MOD = (const float*)(P->ws + WS_MOD); bf16* X = (bf16*)(P->ws + WS_X); bf16* H = (bf16*)(P->ws + WS_H);
    for (int row = gw; row < MT; row += NGW) {
        const float* src = row < ML ? P->in[0] + (size_t)row * DM : P->in[2] + (size_t)(row - ML) * DM;
        float v[32]; load_row_f32(src, lane, v);
        store_row_bf16(X + (size_t)row * DM, lane, v);
        const float* mod = MOD + (size_t)row_slot(row) * 12288;
        float mean, rstd; ln_stats(v, mean, rstd);
        float a[32], s[32]; load_row_f32(mod + 2048, lane, a); load_row_f32(mod, lane, s);
#pragma unroll
        for (int i = 0; i < 32; ++i) a[i] = (v[i] - mean) * rstd * (1.0f + a[i]) + s[i];
        store_row_bf16(H + (size_t)row * DM, lane, a);
    }
}
__device__ __forceinline__ void post_mixer_pass(CP P, int L, int Mrows, int lane, int gw, int NGW) {
    const float* MOD = (const float*)(P->ws + WS_MOD); bf16* X = (bf16*)(P->ws + WS_X); bf16* H = (bf16*)(P->ws + WS_H); const bf16* Y = (const bf16*)(P->ws + WS_Y);
    const float* lng = P->in[6] + (size_t)(L * 2 + 0) * DM; const float* lnb = P->in[7] + (size_t)(L * 2 + 0) * DM;
    for (int row = gw; row < Mrows; row += NGW) {
        const float* mod = MOD + (size_t)(L * 3 + row_slot(row)) * 12288;
        float z[32], y[32], g[32]; load_row_bf16(X + (size_t)row * DM, lane, z); load_row_bf16(Y + (size_t)row * DM, lane, y); load_row_f32(mod + 2 * 2048, lane, g);
#pragma unroll
        for (int i = 0; i < 32; ++i) z[i] = ALPHA * z[i] + g[i] * y[i];
        finish_row<false>(z, lng, lnb, X + (size_t)row * DM, mod + 3 * 2048, mod + 4 * 2048, H + (size_t)row * DM, nullptr, lane);
    }
}
__device__ __forceinline__ void vstats_pass(CP P, int Mrows, int lane, int gw, int NGW) {
    const bf16* Z = (const bf16*)(P->ws + WS_Z); float* VST = (float*)(P->ws + WS_VST);
    for (int row = gw; row < Mrows; row += NGW) {
        float v[32]; load_row_bf16(Z + (size_t)row * 4096 + 2048, lane, v);
        float mean, rstd; ln_stats(v, mean, rstd);
        if (lane == 0) { VST[2 * row] = mean; VST[2 * row + 1] = rstd; }
    }
}
#define XB_TMO      128
#define XB_XCNT(j)  (256  + 64 * (j))
#define XB_XSUB(j)  (1280 + 64 * (j))
#define XB_XGEN(j)  (2304 + 64 * (j))
#define XB_TOP      3328
#define XB_TOPGEN   3392
#define XCD_BAR_WORDS 3456
#define XB_SPIN_CAP (1u << 18)

__device__ __forceinline__ unsigned xb_ld(unsigned* p)              { return __hip_atomic_load(p, __ATOMIC_RELAXED, __HIP_MEMORY_SCOPE_AGENT); }
__device__ __forceinline__ unsigned xb_add(unsigned* p, unsigned v) { return __hip_atomic_fetch_add(p, v, __ATOMIC_RELAXED, __HIP_MEMORY_SCOPE_AGENT); }
__device__ __forceinline__ unsigned xb_xcc_id() { return (unsigned)__builtin_amdgcn_s_getreg((3 << 11) | 20) & 0xFu; }
#define XB_SPIN(cond, bar) do { unsigned _sp = 0; while (cond) { __builtin_amdgcn_s_sleep(1); \
    if ((++_sp & 255u) == 0u) { if (xb_ld(&(bar)[XB_TMO])) break; if (_sp > XB_SPIN_CAP) { atomicAdd(&(bar)[XB_TMO], 1u); break; } } } } while (0)

struct XcdBarrier {
    unsigned* bar; unsigned x;
    volatile LAS unsigned* st;
};

__device__ __forceinline__ XcdBarrier xcd_barrier_post(unsigned* bar, volatile LAS unsigned* st, const bool t0) {
    XcdBarrier b; b.bar = bar; b.x = xb_xcc_id(); b.st = st;
    if (t0) (void)xb_add(&bar[XB_XCNT(b.x)], 1u);
    return b;
}
__device__ __forceinline__ void xcd_barrier_complete(unsigned* bar, unsigned x, unsigned& nloc, unsigned& nx) {
    const unsigned G = gridDim.x * gridDim.y * gridDim.z;
    unsigned sum, cnt, mine, sp = 0u;
    for (;;) {
        sum = 0u; cnt = 0u; mine = 0u;
#pragma unroll
        for (unsigned j = 0; j < 16; ++j) { const unsigned c = xb_ld(&bar[XB_XCNT(j)]); sum += c; cnt += (c > 0u) ? 1u : 0u; mine = (j == x) ? c : mine; }
        if (sum == G) break;
        __builtin_amdgcn_s_sleep(1);
        if ((++sp & 255u) == 0u) { if (xb_ld(&bar[XB_TMO])) break; if (sp > XB_SPIN_CAP) { atomicAdd(&bar[XB_TMO], 1u); break; } }
    }
    nloc = mine > 0u ? mine : 1u; nx = cnt > 0u ? cnt : 1u;
}

__device__ __attribute__((noinline)) void xcd_barrier(const XcdBarrier b, const bool t0) {
    asm volatile("s_waitcnt vmcnt(0)" ::: "memory");
    __syncthreads();
    if (t0) {
        unsigned* bar = b.bar;
        __builtin_amdgcn_s_waitcnt(0);
        unsigned nloc = b.st[0], nx = b.st[1];
        if (nloc == 0u) { xcd_barrier_complete(bar, b.x, nloc, nx); b.st[0] = nloc; b.st[1] = nx; }
        const unsigned old = xb_add(&bar[XB_XSUB(b.x)], 1u);
        const unsigned gen = old / nloc;
        if (old + 1u == (gen + 1u) * nloc) {
            __builtin_amdgcn_fence(__ATOMIC_RELEASE, "agent");
            asm volatile("s_waitcnt vmcnt(0)" ::: "memory");
            const unsigned og = xb_add(&bar[XB_TOP], 1u);
            const unsigned tg = og / nx;
            if (og + 1u == (tg + 1u) * nx) xb_add(&bar[XB_TOPGEN], 1u);
            else XB_SPIN(xb_ld(&bar[XB_TOPGEN]) == tg, bar);
            __builtin_amdgcn_fence(__ATOMIC_ACQUIRE, "agent");
            xb_add(&bar[XB_XGEN(b.x)], 1u);
            asm volatile("s_waitcnt vmcnt(0)" ::: "memory");
        } else {
            XB_SPIN(xb_ld(&bar[XB_XGEN(b.x)]) == gen, bar);
            __builtin_amdgcn_fence(__ATOMIC_ACQUIRE, "agent");
            asm volatile("s_waitcnt vmcnt(0)" ::: "memory");
        }
    }
    __syncthreads();
}

__device__ __forceinline__ void spatial_phase(CP P, int j, int Mrows, LAS unsigned char* lds_, int tid, int lane, int wid) {
    const bf16* Z = (const bf16*)(P->ws + WS_Z); const float* VST = (const float*)(P->ws + WS_VST); bf16* Gb = (bf16*)(P->ws + WS_G);
    const bf16* WS = (const bf16*)(P->ws + WS_GMWS) + (size_t)j * 16 * 128 * 128;
    const float* lng = P->in[14] + (size_t)j * DM; const float* lnb = P->in[15] + (size_t)j * DM; const float* bs = P->in[17] + (size_t)j * 16 * 128;
    LAS bf16* Vt = (LAS bf16*)(LAS unsigned char*)lds_;
    constexpr int VP = 136;
    const int nunits = (Mrows / 128) * 16;
    for (int u = blockIdx.x; u < nunits; u += gridDim.x) {
        const int c = u >> 4, g = u & 15;
        __syncthreads();
        {
            const int q = tid >> 2, dq = (tid & 3) * 32; const int row = c * 128 + q;
            const float mean = VST[2 * row], rstd = VST[2 * row + 1];
            const bf16* src = Z + (size_t)row * 4096 + 2048 + g * 128 + dq;
#pragma unroll
            for (int t = 0; t < 4; ++t) { const u32x4 w = *(const u32x4*)(src + 8 * t);
                float v[8] = {bflo(w.x), bfhi(w.x), bflo(w.y), bfhi(w.y), bflo(w.z), bfhi(w.z), bflo(w.w), bfhi(w.w)};
                const float* gp = lng + g * 128 + dq + 8 * t; const float* bp = lnb + g * 128 + dq + 8 * t;
#pragma unroll
                for (int i = 0; i < 8; ++i) { const float vn = (v[i] - mean) * rstd * gp[i] + bp[i]; Vt[(dq + 8 * t + i) * VP + q] = tobf1(vn); } }
        }
        __syncthreads();
        const int fr = lane & 15, fq = lane >> 4;
        bf16x8 a[4];
        const bf16* wrow = WS + (size_t)g * 128 * 128 + (size_t)(16 * wid + fr) * 128 + 8 * fq;
#pragma unroll
        for (int ks = 0; ks < 4; ++ks) a[ks] = *(const bf16x8*)(wrow + 32 * ks);
#pragma unroll
        for (int nb = 0; nb < 8; ++nb) {
            f32x4 acc = {0.f, 0.f, 0.f, 0.f};
#pragma unroll
            for (int ks = 0; ks < 4; ++ks) { const bf16x8 b = *(const LAS bf16x8*)(Vt + (16 * nb + fr) * VP + 32 * ks + 8 * fq);
                acc = __builtin_amdgcn_mfma_f32_16x16x32_bf16(a[ks], b, acc, 0, 0, 0); }
#pragma unroll
            for (int r = 0; r < 4; ++r) { const int p = 16 * wid + fq * 4 + r, d = 16 * nb + fr; const size_t grow = (size_t)(c * 128 + p);
                const float sv = acc[r] + bs[g * 128 + p];
                const float uu = bf1(Z[grow * 4096 + g * 128 + d]);
                Gb[grow * 2048 + g * 128 + d] = tobf1(uu * sv); }
        }
    }
}

__device__ __forceinline__ void rope_cs(int row, int l, float& cs, float& sn) {
    const int t = row & (SEQ - 1); const int pos = (l & 32) ? (t & 63) : (t >> 6);
    const float inv = powf(10000.0f, -(float)(l & 15) * (1.0f / 16.0f));
    const float ang = (float)pos * inv; sincosf(ang, &sn, &cs);
}
__device__ __forceinline__ float rope_apply(float x, int l, float cs, float sn) {
    const float p = lane_xor16(x, l);
    return (l & 16) ? (p * sn + x * cs) : (x * cs - p * sn);
}
__device__ __forceinline__ void mla_norm_pass(CP P, int lane, int gw, int NGW) {
    const bf16* C = (const bf16*)(P->ws + WS_C); bf16* CQN = (bf16*)(P->ws + WS_CQN); bf16* CKVN = (bf16*)(P->ws + WS_CKVN); bf16* KR = (bf16*)(P->ws + WS_KR);
    const float* qn = P->in[20]; const float* kvn = P->in[21];
    for (int row = gw; row < MT; row += NGW) {
        const bf16* c = C + (size_t)row * 1280;
#pragma unroll
        for (int part = 0; part < 2; ++part) {
            const u32x4 w = *(const u32x4*)(c + part * 512 + 8 * lane);
            float v[8] = {bflo(w.x), bfhi(w.x), bflo(w.y), bfhi(w.y), bflo(w.z), bfhi(w.z), bflo(w.w), bfhi(w.w)};
            float ss = 0.f;
#pragma unroll
            for (int i = 0; i < 8; ++i) ss += v[i] * v[i];
            const float r = 1.0f / sqrtf(wave_sum(ss) * (1.0f / 512.0f) + LN_EPS);
            const float* nw = (part ? kvn : qn) + 8 * lane;
            u32x4 o; o.x = cvtpk(v[0] * r * nw[0], v[1] * r * nw[1]); o.y = cvtpk(v[2] * r * nw[2], v[3] * r * nw[3]); o.z = cvtpk(v[4] * r * nw[4], v[5] * r * nw[5]); o.w = cvtpk(v[6] * r * nw[6], v[7] * r * nw[7]);
            *(u32x4*)((part ? CKVN : CQN) + (size_t)row * 512 + 8 * lane) = o;
        }
        float x = bf1(c[1024 + lane]);
        if (row < ML) { float cs, sn; rope_cs(row, lane, cs, sn); x = rope_apply(x, lane, cs, sn); }
        KR[(size_t)row * 64 + lane] = tobf1(x);
    }
}
__device__ __forceinline__ void rope_pass(bf16* buf, int ld, int col0, int nchunks, int cstride, int lane, int gw, int NGW) {
    for (int row = gw; row < ML; row += NGW) {
        float cs, sn; rope_cs(row, lane, cs, sn);
        bf16* r = buf + (size_t)row * ld + col0 + lane;
#pragma unroll 4
        for (int k = 0; k < nchunks; ++k) { const float x = bf1(r[k * cstride]); r[k * cstride] = tobf1(rope_apply(x, lane, cs, sn)); }
    }
}

namespace att {
#ifndef ATT_LEAN
#define ATT_LEAN 1
#endif
#ifndef ATT_3STAGE
#define ATT_3STAGE 0
#endif
#ifndef ATT_PRIO
#define ATT_PRIO 0
#endif
#ifndef ATT_KMAJOR
#define ATT_KMAJOR 0
#endif
#ifndef ATT_TRB
#define ATT_TRB 1
#endif
#ifndef ATT_STAGGER
#define ATT_STAGGER 0
#endif
#ifndef ATT_SDEPTH
#define ATT_SDEPTH(MODE) ((MODE) == 0 ? 1 : 1)
#endif
#ifndef ATT_PVPIPE
#define ATT_PVPIPE(MODE) ((MODE) == 1)
#endif
#define SBAR() __builtin_amdgcn_sched_barrier(0)
__device__ __forceinline__ int crow(int r, int hi) { return (r & 3) + 8 * (r >> 2) + 4 * hi; }
__device__ __forceinline__ unsigned cvtpkv(float lo, float hi) { unsigned r; asm volatile("v_cvt_pk_bf16_f32 %0, %1, %2" : "=v"(r) : "v"(lo), "v"(hi)); return r; }

__device__ __forceinline__ void partialSM(f32x16& p0, f32x16& p1, float& m_reg, float& mn, float& alpha, const float C, const float THRS) {
  float pmax = p0[0];
#pragma unroll
  for (int r = 1; r < 16; ++r) pmax = fmaxf(pmax, p0[r]);
#pragma unroll
  for (int r = 0; r < 16; ++r) pmax = fmaxf(pmax, p1[r]);
  { auto rr = __builtin_amdgcn_permlane32_swap(__float_as_uint(pmax), __float_as_uint(pmax), false, false);
    pmax = fmaxf(__uint_as_float(rr[0]), __uint_as_float(rr[1])); }
  if (__builtin_expect(__all(pmax - m_reg <= THRS), 1)) { mn = m_reg; alpha = 1.f; }
  else { mn = fmaxf(m_reg, pmax); alpha = __builtin_amdgcn_exp2f((m_reg - mn) * C); m_reg = mn; }
  const float mnC = -mn * C;
#pragma unroll
  for (int r = 0; r < 16; ++r) p0[r] = fmaf(p0[r], C, mnC);
#pragma unroll
  for (int r = 0; r < 16; ++r) p1[r] = fmaf(p1[r], C, mnC);
#pragma unroll
  for (int r = 0; r < 16; ++r) p0[r] = __builtin_amdgcn_exp2f(p0[r]);
}
__device__ __forceinline__ void finishSM(f32x16& p0, f32x16& p1, float alpha, float& l_reg, bf16x8& pa0, bf16x8& pa1, bf16x8& pa2, bf16x8& pa3) {
#pragma unroll
  for (int r = 0; r < 16; ++r) p1[r] = __builtin_amdgcn_exp2f(p1[r]);
  float ps = 0;
#pragma unroll
  for (int r = 0; r < 16; ++r) ps += p0[r];
#pragma unroll
  for (int r = 0; r < 16; ++r) ps += p1[r];
  { auto rr = __builtin_amdgcn_permlane32_swap(__float_as_uint(ps), __float_as_uint(ps), false, false);
    ps = __uint_as_float(rr[0]) + __uint_as_float(rr[1]); }
  l_reg = l_reg * alpha + ps;
#define PK4(P, BASE, OUT) do { unsigned a0 = cvtpkv(P[BASE + 0], P[BASE + 1]), a1 = cvtpkv(P[BASE + 2], P[BASE + 3]);   \
    unsigned b0 = cvtpkv(P[BASE + 4], P[BASE + 5]), b1 = cvtpkv(P[BASE + 6], P[BASE + 7]);                              \
    auto r0 = __builtin_amdgcn_permlane32_swap(a0, b0, false, false); auto r1 = __builtin_amdgcn_permlane32_swap(a1, b1, false, false); \
    u32x4 w = {r0[0], r1[0], r0[1], r1[1]}; OUT = *reinterpret_cast<bf16x8*>(&w); } while (0)
  PK4(p0, 0, pa0); PK4(p0, 8, pa1); PK4(p1, 0, pa2); PK4(p1, 8, pa3);
#undef PK4
}
__device__ __forceinline__ void partialSM_lean(f32x16& p0, f32x16& p1, f32x16& nm, float& alpha, const bool first) {
  constexpr float THR2 = 11.541560327111707f;
  float dmax = p0[0];
#pragma unroll
  for (int r = 1; r < 16; ++r) dmax = fmaxf(dmax, p0[r]);
#pragma unroll
  for (int r = 0; r < 16; ++r) dmax = fmaxf(dmax, p1[r]);
  { auto rr = __builtin_amdgcn_permlane32_swap(__float_as_uint(dmax), __float_as_uint(dmax), false, false);
    dmax = fmaxf(__uint_as_float(rr[0]), __uint_as_float(rr[1])); }
  alpha = 1.f;
  if (first || !__all(dmax <= THR2)) {
    const float delta = first ? dmax : (dmax > THR2 ? dmax : 0.f);
    if (!first) alpha = __builtin_amdgcn_exp2f(-delta);
#pragma unroll
    for (int r = 0; r < 16; ++r) { p0[r] -= delta; p1[r] -= delta; nm[r] -= delta; }
  }
#pragma unroll
  for (int r = 0; r < 16; ++r) p0[r] = __builtin_amdgcn_exp2f(p0[r]);
}
__device__ __forceinline__ void finishSM_lean(f32x16& p0, f32x16& p1, bf16x8& pa0, bf16x8& pa1, bf16x8& pa2, bf16x8& pa3) {
#pragma unroll
  for (int r = 0; r < 16; ++r) p1[r] = __builtin_amdgcn_exp2f(p1[r]);
#define PK4(P, BASE, OUT) do { unsigned a0 = cvtpkv(P[BASE + 0], P[BASE + 1]), a1 = cvtpkv(P[BASE + 2], P[BASE + 3]);   \
    unsigned b0 = cvtpkv(P[BASE + 4], P[BASE + 5]), b1 = cvtpkv(P[BASE + 6], P[BASE + 7]);                              \
    auto r0 = __builtin_amdgcn_permlane32_swap(a0, b0, false, false); auto r1 = __builtin_amdgcn_permlane32_swap(a1, b1, false, false); \
    u32x4 w = {r0[0], r1[0], r0[1], r1[1]}; OUT = *reinterpret_cast<bf16x8*>(&w); } while (0)
  PK4(p0, 0, pa0); PK4(p0, 8, pa1); PK4(p1, 0, pa2); PK4(p1, 8, pa3);
#undef PK4
}
__device__ __forceinline__ bf16x8 scale_bf16x8(bf16x8 v, float c) {
  const u32x4 w = *reinterpret_cast<u32x4*>(&v); u32x4 o;
  o.x = cvtpk(bflo(w.x) * c, bfhi(w.x) * c); o.y = cvtpk(bflo(w.y) * c, bfhi(w.y) * c); o.z = cvtpk(bflo(w.z) * c, bfhi(w.z) * c); o.w = cvtpk(bflo(w.w) * c, bfhi(w.w) * c);
  return *reinterpret_cast<bf16x8*>(&o);
}
template <int PITCH> __device__ __forceinline__ int kswz(int r) { return PITCH == 256 ? (r & 15) : ((r >> 1) & 7); }
template <int NQF, int NQR, int PITCH> __device__ __forceinline__ void qkt(f32x16& p0, f32x16& p1, const LAS char* Ks, int chunk0, const bf16x8* qr, const LAS char* ql, int r32, int hi, const f32x16 init = f32x16{}) {
  p0 = init; p1 = init;
  const int sw = kswz<PITCH>(r32);
#pragma unroll
  for (int d0 = 0; d0 < NQF; ++d0) { const int off = ((chunk0 + d0 * 2 + hi) ^ sw) * 16;
    const bf16x8 b0 = *(const LAS bf16x8*)(Ks + r32 * PITCH + off);
    const bf16x8 b1 = *(const LAS bf16x8*)(Ks + (32 + r32) * PITCH + off);
    const bf16x8 q = d0 < NQR ? qr[d0 < NQR ? d0 : 0] : *(const LAS bf16x8*)(ql + (d0 - NQR < 0 ? 0 : d0 - NQR) * 1024);
    p0 = __builtin_amdgcn_mfma_f32_32x32x16_bf16(b0, q, p0, 0, 0, 0);
    p1 = __builtin_amdgcn_mfma_f32_32x32x16_bf16(b1, q, p1, 0, 0, 0); }
}
__device__ __forceinline__ int v_st(int k, int c) { const int kk = (k & ~0xC) | ((k & 4) << 1) | ((k & 8) >> 1); return ((kk >> 3) * 4 + (c >> 5)) * 512 + ((kk & 7) * 32 + (c & 31)) * 2; }
__device__ __forceinline__ int v_rd_base(int lane) { return ((lane & 3) << 3) | (((lane >> 2) & 3) << 6) | (((lane >> 4) & 1) << 5) | (((lane >> 5) & 1) << 8); }
constexpr int v_rd_off(int d0, int ks, int half) { return d0 * 512 + ks * 4096 + half * 2048; }
template <int OFF> __device__ __forceinline__ s16x4 tr_read(int vb) {
  s16x4 r; asm volatile("ds_read_b64_tr_b16 %0, %1 offset:%2" : "=&v"(r) : "v"(vb), "i"(OFF) : "memory"); return r;
}
template <int D0> __device__ __forceinline__ void pv_one(f32x16& od, int vb, bf16x8 pa0, bf16x8 pa1, bf16x8 pa2, bf16x8 pa3) {
  const s16x4 l0 = tr_read<v_rd_off(D0, 0, 0)>(vb), h0 = tr_read<v_rd_off(D0, 0, 1)>(vb), l1 = tr_read<v_rd_off(D0, 1, 0)>(vb), h1 = tr_read<v_rd_off(D0, 1, 1)>(vb);
  const s16x4 l2 = tr_read<v_rd_off(D0, 2, 0)>(vb), h2 = tr_read<v_rd_off(D0, 2, 1)>(vb), l3 = tr_read<v_rd_off(D0, 3, 0)>(vb), h3 = tr_read<v_rd_off(D0, 3, 1)>(vb);
  asm volatile("s_waitcnt lgkmcnt(0)" ::: "memory"); SBAR();
#define PK(L, H) (bf16x8){L[0], L[1], L[2], L[3], H[0], H[1], H[2], H[3]}
  od = __builtin_amdgcn_mfma_f32_32x32x16_bf16(pa0, PK(l0, h0), od, 0, 0, 0);
  od = __builtin_amdgcn_mfma_f32_32x32x16_bf16(pa1, PK(l1, h1), od, 0, 0, 0);
  od = __builtin_amdgcn_mfma_f32_32x32x16_bf16(pa2, PK(l2, h2), od, 0, 0, 0);
  od = __builtin_amdgcn_mfma_f32_32x32x16_bf16(pa3, PK(l3, h3), od, 0, 0, 0);
#undef PK
}
__device__ __forceinline__ void pv_d0(f32x16* o, int vb, bf16x8 pa0, bf16x8 pa1, bf16x8 pa2, bf16x8 pa3) {
  pv_one<0>(o[0], vb, pa0, pa1, pa2, pa3); pv_one<1>(o[1], vb, pa0, pa1, pa2, pa3); pv_one<2>(o[2], vb, pa0, pa1, pa2, pa3); pv_one<3>(o[3], vb, pa0, pa1, pa2, pa3);
}
struct VFrag { s16x4 l0, h0, l1, h1, l2, h2, l3, h3; };
typedef short v4i16_t __attribute__((ext_vector_type(4)));
template <int OFF> __device__ __forceinline__ s16x4 tr_read_b(int vb) {
  return __builtin_bit_cast(s16x4, __builtin_amdgcn_ds_read_tr16_b64_v4i16((LAS v4i16_t*)(uintptr_t)(unsigned)(vb + OFF)));
}
template <int D0> __device__ __forceinline__ void tr8b(VFrag& f, int vb) {
  f.l0 = tr_read_b<v_rd_off(D0, 0, 0)>(vb); f.h0 = tr_read_b<v_rd_off(D0, 0, 1)>(vb); f.l1 = tr_read_b<v_rd_off(D0, 1, 0)>(vb); f.h1 = tr_read_b<v_rd_off(D0, 1, 1)>(vb);
  f.l2 = tr_read_b<v_rd_off(D0, 2, 0)>(vb); f.h2 = tr_read_b<v_rd_off(D0, 2, 1)>(vb); f.l3 = tr_read_b<v_rd_off(D0, 3, 0)>(vb); f.h3 = tr_read_b<v_rd_off(D0, 3, 1)>(vb);
}
template <int D0> __device__ __forceinline__ void tr8(VFrag& f, int vb) {
  f.l0 = tr_read<v_rd_off(D0, 0, 0)>(vb); f.h0 = tr_read<v_rd_off(D0, 0, 1)>(vb); f.l1 = tr_read<v_rd_off(D0, 1, 0)>(vb); f.h1 = tr_read<v_rd_off(D0, 1, 1)>(vb);
  f.l2 = tr_read<v_rd_off(D0, 2, 0)>(vb); f.h2 = tr_read<v_rd_off(D0, 2, 1)>(vb); f.l3 = tr_read<v_rd_off(D0, 3, 0)>(vb); f.h3 = tr_read<v_rd_off(D0, 3, 1)>(vb);
}
__device__ __forceinline__ void mfma4(f32x16& od, VFrag& f, bf16x8 pa0, bf16x8 pa1, bf16x8 pa2, bf16x8 pa3) {
#define PK(L, H) (bf16x8){L[0], L[1], L[2], L[3], H[0], H[1], H[2], H[3]}
  od = __builtin_amdgcn_mfma_f32_32x32x16_bf16(pa0, PK(f.l0, f.h0), od, 0, 0, 0);
  od = __builtin_amdgcn_mfma_f32_32x32x16_bf16(pa1, PK(f.l1, f.h1), od, 0, 0, 0);
  od = __builtin_amdgcn_mfma_f32_32x32x16_bf16(pa2, PK(f.l2, f.h2), od, 0, 0, 0);
  od = __builtin_amdgcn_mfma_f32_32x32x16_bf16(pa3, PK(f.l3, f.h3), od, 0, 0, 0);
#undef PK
}
#define VF_TIE(f) "+v"(f.l0), "+v"(f.h0), "+v"(f.l1), "+v"(f.h1), "+v"(f.l2), "+v"(f.h2), "+v"(f.l3), "+v"(f.h3)
__device__ __forceinline__ void pv_pipe(f32x16* o, int vb, bf16x8 pa0, bf16x8 pa1, bf16x8 pa2, bf16x8 pa3) {
  VFrag A, B;
  asm volatile("s_waitcnt lgkmcnt(0)" ::: "memory");
  tr8<0>(A, vb); tr8<1>(B, vb);
  asm volatile("s_waitcnt lgkmcnt(8)" : VF_TIE(A) :: "memory");
  mfma4(o[0], A, pa0, pa1, pa2, pa3);
  tr8<2>(A, vb);
  asm volatile("s_waitcnt lgkmcnt(8)" : VF_TIE(B) :: "memory");
  mfma4(o[1], B, pa0, pa1, pa2, pa3);
  tr8<3>(B, vb);
  asm volatile("s_waitcnt lgkmcnt(8)" : VF_TIE(A) :: "memory");
  mfma4(o[2], A, pa0, pa1, pa2, pa3);
  asm volatile("s_waitcnt lgkmcnt(0)" : VF_TIE(B) :: "memory");
  mfma4(o[3], B, pa0, pa1, pa2, pa3);
}
__device__ __forceinline__ void pv_psm_lean(f32x16* o, int vb, bf16x8 pa0, bf16x8 pa1, bf16x8 pa2, bf16x8 pa3, f32x16& p0, f32x16& p1, f32x16& nm, float& alpha) {
  constexpr float THR2 = 11.541560327111707f;
  const bf16x8 one8 = {0x3F80, 0x3F80, 0x3F80, 0x3F80, 0x3F80, 0x3F80, 0x3F80, 0x3F80};
  VFrag A, B;
  asm volatile("s_waitcnt lgkmcnt(0)" ::: "memory");
  tr8<0>(A, vb); tr8<1>(B, vb);
  asm volatile("s_waitcnt lgkmcnt(8)" : VF_TIE(A) :: "memory");
  mfma4(o[0], A, pa0, pa1, pa2, pa3);
  float dmax = p0[0];
#pragma unroll
  for (int r = 1; r < 16; ++r) dmax = fmaxf(dmax, p0[r]);
  tr8<2>(A, vb);
  asm volatile("s_waitcnt lgkmcnt(8)" : VF_TIE(B) :: "memory");
  mfma4(o[1], B, pa0, pa1, pa2, pa3);
#pragma unroll
  for (int r = 0; r < 16; ++r) dmax = fmaxf(dmax, p1[r]);
  { auto rr = __builtin_amdgcn_permlane32_swap(__float_as_uint(dmax), __float_as_uint(dmax), false, false);
    dmax = fmaxf(__uint_as_float(rr[0]), __uint_as_float(rr[1])); }
  alpha = 1.f;
  if (!__all(dmax <= THR2)) {
    const float delta = dmax > THR2 ? dmax : 0.f; alpha = __builtin_amdgcn_exp2f(-delta);
#pragma unroll
    for (int r = 0; r < 16; ++r) { p0[r] -= delta; p1[r] -= delta; nm[r] -= delta; }
  }
  tr8<3>(B, vb);
  asm volatile("s_waitcnt lgkmcnt(8)" : VF_TIE(A) :: "memory");
  mfma4(o[2], A, pa0, pa1, pa2, pa3);
#pragma unroll
  for (int r = 0; r < 8; ++r) p0[r] = __builtin_amdgcn_exp2f(p0[r]);
  asm volatile("s_waitcnt lgkmcnt(0)" : VF_TIE(B) :: "memory");
  mfma4(o[3], B, pa0, pa1, pa2, pa3);
#pragma unroll
  for (int r = 8; r < 16; ++r) p0[r] = __builtin_amdgcn_exp2f(p0[r]);
  o[4] = __builtin_amdgcn_mfma_f32_32x32x16_bf16(pa0, one8, o[4], 0, 0, 0); o[4] = __builtin_amdgcn_mfma_f32_32x32x16_bf16(pa1, one8, o[4], 0, 0, 0);
  o[4] = __builtin_amdgcn_mfma_f32_32x32x16_bf16(pa2, one8, o[4], 0, 0, 0); o[4] = __builtin_amdgcn_mfma_f32_32x32x16_bf16(pa3, one8, o[4], 0, 0, 0);
}
__device__ __forceinline__ void pv_psm_lean_b(f32x16* o, int vb, bf16x8 pa0, bf16x8 pa1, bf16x8 pa2, bf16x8 pa3, f32x16& p0, f32x16& p1, f32x16& nm, float& alpha) {
  constexpr float THR2 = 11.541560327111707f;
  const bf16x8 one8 = {0x3F80, 0x3F80, 0x3F80, 0x3F80, 0x3F80, 0x3F80, 0x3F80, 0x3F80};
  VFrag A, B;
  tr8b<0>(A, vb); tr8b<1>(B, vb);
  mfma4(o[0], A, pa0, pa1, pa2, pa3);
  float dmax = p0[0];
#pragma unroll
  for (int r = 1; r < 16; ++r) dmax = fmaxf(dmax, p0[r]);
  tr8b<2>(A, vb);
  mfma4(o[1], B, pa0, pa1, pa2, pa3);
#pragma unroll
  for (int r = 0; r < 16; ++r) dmax = fmaxf(dmax, p1[r]);
  { auto rr = __builtin_amdgcn_permlane32_swap(__float_as_uint(dmax), __float_as_uint(dmax), false, false);
    dmax = fmaxf(__uint_as_float(rr[0]), __uint_as_float(rr[1])); }
  alpha = 1.f;
  if (!__all(dmax <= THR2)) {
    const float delta = dmax > THR2 ? dmax : 0.f; alpha = __builtin_amdgcn_exp2f(-delta);
#pragma unroll
    for (int r = 0; r < 16; ++r) { p0[r] -= delta; p1[r] -= delta; nm[r] -= delta; }
  }
  tr8b<3>(B, vb);
  mfma4(o[2], A, pa0, pa1, pa2, pa3);
#pragma unroll
  for (int r = 0; r < 8; ++r) p0[r] = __builtin_amdgcn_exp2f(p0[r]);
  mfma4(o[3], B, pa0, pa1, pa2, pa3);
#pragma unroll
  for (int r = 8; r < 16; ++r) p0[r] = __builtin_amdgcn_exp2f(p0[r]);
  o[4] = __builtin_amdgcn_mfma_f32_32x32x16_bf16(pa0, one8, o[4], 0, 0, 0); o[4] = __builtin_amdgcn_mfma_f32_32x32x16_bf16(pa1, one8, o[4], 0, 0, 0);
  o[4] = __builtin_amdgcn_mfma_f32_32x32x16_bf16(pa2, one8, o[4], 0, 0, 0); o[4] = __builtin_amdgcn_mfma_f32_32x32x16_bf16(pa3, one8, o[4], 0, 0, 0);
}
struct VStep { s16x4 l0, h0, l1, h1, l2, h2, l3, h3; };
template <int KS> __device__ __forceinline__ void trstep(VStep& f, int vb) {
  f.l0 = tr_read_b<v_rd_off(0, KS, 0)>(vb); f.h0 = tr_read_b<v_rd_off(0, KS, 1)>(vb); f.l1 = tr_read_b<v_rd_off(1, KS, 0)>(vb); f.h1 = tr_read_b<v_rd_off(1, KS, 1)>(vb);
  f.l2 = tr_read_b<v_rd_off(2, KS, 0)>(vb); f.h2 = tr_read_b<v_rd_off(2, KS, 1)>(vb); f.l3 = tr_read_b<v_rd_off(3, KS, 0)>(vb); f.h3 = tr_read_b<v_rd_off(3, KS, 1)>(vb);
}
__device__ __forceinline__ void mfma5(f32x16* o, const VStep& f, bf16x8 pa) {
  const bf16x8 one8 = {0x3F80, 0x3F80, 0x3F80, 0x3F80, 0x3F80, 0x3F80, 0x3F80, 0x3F80};
#define PK(L, H) (bf16x8){L[0], L[1], L[2], L[3], H[0], H[1], H[2], H[3]}
  o[0] = __builtin_amdgcn_mfma_f32_32x32x16_bf16(pa, PK(f.l0, f.h0), o[0], 0, 0, 0);
  o[1] = __builtin_amdgcn_mfma_f32_32x32x16_bf16(pa, PK(f.l1, f.h1), o[1], 0, 0, 0);
  o[2] = __builtin_amdgcn_mfma_f32_32x32x16_bf16(pa, PK(f.l2, f.h2), o[2], 0, 0, 0);
  o[3] = __builtin_amdgcn_mfma_f32_32x32x16_bf16(pa, PK(f.l3, f.h3), o[3], 0, 0, 0);
  o[4] = __builtin_amdgcn_mfma_f32_32x32x16_bf16(pa, one8, o[4], 0, 0, 0);
#undef PK
}
template <int BASE> __device__ __forceinline__ bf16x8 pk4e(const f32x16& P) {
  const float e0 = __builtin_amdgcn_exp2f(P[BASE + 0]), e1 = __builtin_amdgcn_exp2f(P[BASE + 1]), e2 = __builtin_amdgcn_exp2f(P[BASE + 2]), e3 = __builtin_amdgcn_exp2f(P[BASE + 3]);
  const float e4 = __builtin_amdgcn_exp2f(P[BASE + 4]), e5 = __builtin_amdgcn_exp2f(P[BASE + 5]), e6 = __builtin_amdgcn_exp2f(P[BASE + 6]), e7 = __builtin_amdgcn_exp2f(P[BASE + 7]);
  const unsigned a0 = cvtpk(e0, e1), a1 = cvtpk(e2, e3), b0 = cvtpk(e4, e5), b1 = cvtpk(e6, e7);
  const auto r0 = __builtin_amdgcn_permlane32_swap(a0, b0, false, false); const auto r1 = __builtin_amdgcn_permlane32_swap(a1, b1, false, false);
  u32x4 w = {r0[0], r1[0], r0[1], r1[1]}; return *reinterpret_cast<bf16x8*>(&w);
}
__device__ __forceinline__ float rowmax_lean(const f32x16& p0, const f32x16& p1) {
  float d = p0[0];
#pragma unroll
  for (int r = 1; r < 16; ++r) d = fmaxf(d, p0[r]);
#pragma unroll
  for (int r = 0; r < 16; ++r) d = fmaxf(d, p1[r]);
  const auto rr = __builtin_amdgcn_permlane32_swap(__float_as_uint(d), __float_as_uint(d), false, false);
  return fmaxf(__uint_as_float(rr[0]), __uint_as_float(rr[1]));
}
__device__ __forceinline__ void shift_lean(float dmax, f32x16& p0, f32x16& p1, f32x16& nm, float& alpha, const bool first) {
  constexpr float THR2 = 11.541560327111707f;
  alpha = 1.f;
  if (first || !__all(dmax <= THR2)) {
    const float delta = first ? dmax : (dmax > THR2 ? dmax : 0.f);
    if (!first) alpha = __builtin_amdgcn_exp2f(-delta);
#pragma unroll
    for (int r = 0; r < 16; ++r) { p0[r] -= delta; p1[r] -= delta; nm[r] -= delta; }
  }
}
#define SGB(mask, n) __builtin_amdgcn_sched_group_barrier((mask), (n), 0)
__device__ __forceinline__ bf16x8 ld8(const bf16* p) { return *reinterpret_cast<const bf16x8*>(p); }

template <int MODE, int ATTV = 0>
__device__ __forceinline__ void attn_unit(const bf16* __restrict__ Qrow0, int ldq, const bf16* __restrict__ Kb, const bf16* __restrict__ Vb, int ldk, const bf16* __restrict__ KRb,
                                          int b, int nct, int NT, bf16* __restrict__ Ob, float lam, const float* __restrict__ subln, float oscale, LAS unsigned char* lds_, const int tid_in) {
  constexpr bool LEAN = (MODE == 1) && ATT_LEAN; constexpr int NQF = MODE == 0 ? 12 : 4, NQR = MODE == 0 ? 4 : 0, NOB = LEAN ? 5 : 4, PITCH = MODE == 0 ? 384 : 256, SHM_V = 16384, SHM_K = 64 * PITCH, SDEPTH = ATT_SDEPTH(MODE); constexpr bool PVPIPE = ATT_PVPIPE(MODE);
  const float SCALE = MODE == 0 ? 0.07216878364870323f : 0.125f;
  const float C = SCALE * 1.4426950408889634f, THRS = 8.f / SCALE;
  if (ATT_PRIO) { if (__builtin_amdgcn_readfirstlane(tid_in >> 8) != 0) __builtin_amdgcn_s_setprio(1); }
  const int tid = launder_v(tid_in) & 511, wid = tid >> 6, lane = tid & 63, r32 = lane & 31, hi = lane >> 5;
  LAS char* lds = (LAS char*)(LAS unsigned char*)lds_;
  constexpr bool THREE = (MODE == 1) && ATT_3STAGE; constexpr int NSTG = THREE ? 3 : 2, STG = SHM_V + SHM_K, SCR0 = NSTG * STG;
#define VOFF(s) (!THREE ? (s) * SHM_V : (s) * STG)
#define KOFF(s) (!THREE ? 2 * SHM_V + (s) * SHM_K : (s) * STG + SHM_V)
  LAS char* V_lds = lds; LAS char* K_lds = lds;
  LAS float* wsf = (LAS float*)(lds + NSTG * (SHM_V + SHM_K)) + wid * 64; LAS float* li_l = wsf; LAS float* al_l = wsf + 32;
  const int wq = MODE == 0 ? wid : (wid & 3), sgrp = MODE == 0 ? 0 : (wid >> 2);
  float m_reg = -1e30f, l_reg = 0; f32x16 o[NOB] = {}; bf16x8 qr[NQR > 0 ? NQR : 1]; f32x16 nm = {};
  LAS char* ql = lds + SCR0 + 2048 + wid * (MODE == 0 ? 8192 : 4096) + lane * 16;
  const bf16* Qw = Qrow0 + (size_t)(wq * 32 + r32) * ldq + sgrp * 64 + hi * 8;
#pragma unroll
  for (int d0 = 0; d0 < NQR; ++d0) qr[d0] = ld8(Qw + d0 * 16);
#pragma unroll
  for (int d0 = NQR; d0 < NQF; ++d0) { bf16x8 qv = ld8(Qw + d0 * 16); if (LEAN) qv = scale_bf16x8(qv, C); *(LAS bf16x8*)(ql + (d0 - NQR) * 1024) = qv; }
  const int sr = tid >> 4, sc = (tid & 15) * 8, vst0 = v_st(sr, sc), vst1 = v_st(32 + sr, sc);
  const int kst0 = sr * PITCH + (((tid & 15) ^ kswz<PITCH>(sr)) * 16), kst1 = kst0 + 32 * PITCH;
  const int rrow = tid >> 3, krs = rrow * PITCH + (((16 + (tid & 7)) ^ kswz<PITCH>(rrow)) * 16);
  const int chunk0 = sgrp * 8;
  const int vb0 = (int)(uintptr_t)V_lds + v_rd_base(lane);
  struct Slot { bf16x8 vs0, vs1, ks0, ks1, kr; } sr_[SDEPTH];
#define KROW(jt) ((jt) < nct ? (ML + b * CTXL + (jt) * 64) : (b * SEQ + ((jt) - nct) * 64))
#define SLOAD(i, jt) do { const int k0_ = KROW(jt); sr_[i].vs0 = ld8(Vb + (size_t)(k0_ + sr) * ldk + sc); sr_[i].vs1 = ld8(Vb + (size_t)(k0_ + 32 + sr) * ldk + sc); \
    sr_[i].ks0 = ld8(Kb + (size_t)(k0_ + sr) * ldk + sc); sr_[i].ks1 = ld8(Kb + (size_t)(k0_ + 32 + sr) * ldk + sc); \
    if (MODE == 0) sr_[i].kr = ld8(KRb + (size_t)(k0_ + rrow) * 64 + (tid & 7) * 8); } while (0)
#define SWRITE(bf, i) do { *(LAS bf16x8*)(V_lds + VOFF(bf) + vst0) = sr_[i].vs0; *(LAS bf16x8*)(V_lds + VOFF(bf) + vst1) = sr_[i].vs1; \
    *(LAS bf16x8*)(K_lds + KOFF(bf) + kst0) = sr_[i].ks0; *(LAS bf16x8*)(K_lds + KOFF(bf) + kst1) = sr_[i].ks1; \
    if (MODE == 0) *(LAS bf16x8*)(K_lds + KOFF(bf) + krs) = sr_[i].kr; } while (0)
#define SWAIT() do { if constexpr (SDEPTH == 2) asm volatile("s_waitcnt vmcnt(4)" ::: "memory"); else asm volatile("s_waitcnt vmcnt(0)" ::: "memory"); } while (0)
#define RESC(a) do { if (__any((a) < 1.f)) { if (hi == 0) al_l[r32] = (a); asm volatile("s_waitcnt lgkmcnt(0)" ::: "memory"); \
    _Pragma("unroll") for (int d = 0; d < NOB; ++d) _Pragma("unroll") for (int r = 0; r < 16; ++r) o[d][r] *= al_l[crow(r, hi)]; } } while (0)
#define PV(vb_) do { if constexpr (ATTV == 2) { o[0][0] += __uint_as_float((unsigned)pa0[0] + (unsigned)pa3[1]); } else if constexpr (PVPIPE) pv_pipe(o, (vb_), pa0, pa1, pa2, pa3); else pv_d0(o, (vb_), pa0, pa1, pa2, pa3); \
    if constexpr (LEAN) { const bf16x8 one8 = {0x3F80, 0x3F80, 0x3F80, 0x3F80, 0x3F80, 0x3F80, 0x3F80, 0x3F80};     \
        o[NOB - 1] = __builtin_amdgcn_mfma_f32_32x32x16_bf16(pa0, one8, o[NOB - 1], 0, 0, 0); o[NOB - 1] = __builtin_amdgcn_mfma_f32_32x32x16_bf16(pa1, one8, o[NOB - 1], 0, 0, 0); \
        o[NOB - 1] = __builtin_amdgcn_mfma_f32_32x32x16_bf16(pa2, one8, o[NOB - 1], 0, 0, 0); o[NOB - 1] = __builtin_amdgcn_mfma_f32_32x32x16_bf16(pa3, one8, o[NOB - 1], 0, 0, 0); } } while (0)
#define PSM(p0_, p1_, mn_, al_, first_) do { if constexpr (ATTV == 1) { al_ = 1.f; } else if constexpr (LEAN) partialSM_lean(p0_, p1_, nm, al_, first_); else partialSM(p0_, p1_, m_reg, mn_, al_, C, THRS); } while (0)
#define FSM(p0_, p1_, al_) do { if constexpr (ATTV == 1) { u32x4 w0_ = {__float_as_uint(p0_[0]), __float_as_uint(p0_[1]), __float_as_uint(p1_[0]), __float_as_uint(p1_[1])}; pa0 = pa1 = pa2 = pa3 = *reinterpret_cast<bf16x8*>(&w0_); } else if constexpr (LEAN) finishSM_lean(p0_, p1_, pa0, pa1, pa2, pa3); else finishSM(p0_, p1_, al_, l_reg, pa0, pa1, pa2, pa3); } while (0)
#define QKT(p0_, p1_, Kp_) do { if constexpr (ATTV == 5) { p0_ = nm; p1_ = nm; p0_[0] += (float)r32; } else if constexpr (LEAN) qkt<NQF, NQR, PITCH>(p0_, p1_, Kp_, chunk0, qr, ql, r32, hi, nm); else qkt<NQF, NQR, PITCH>(p0_, p1_, Kp_, chunk0, qr, ql, r32, hi); } while (0)
  f32x16 pA0, pA1, pB0, pB1; float mnA, mnB, alA, alB; bf16x8 pa0, pa1, pa2, pa3;
  constexpr bool KMAJ = (MODE == 1) && LEAN && ATT_KMAJOR && (ATTV == 0) && !THREE;
  if constexpr (KMAJ) {
    VStep VA, VB;
#define KSTEPS(PC0, PC1, ALC, PP0, PP1, KC, VP, LD, DOQK) do { const int vb_ = vb0 + VOFF(VP); float dmx_ = 0.f; \
      SBAR(); \
      if (DOQK) QKT(PC0, PC1, K_lds + KOFF(KC)); \
      pa0 = pk4e<0>(PP0); trstep<0>(VA, vb_); \
      _Pragma("unroll") for (int i_ = 0; i_ < 8; ++i_) { SGB(0x008, 1); SGB(0x100, 3); SGB(0x002, 2); } \
      SBAR(); LD; SBAR(); \
      mfma5(o, VA, pa0); pa1 = pk4e<8>(PP0); trstep<1>(VB, vb_); \
      _Pragma("unroll") for (int i_ = 0; i_ < 5; ++i_) { SGB(0x008, 1); SGB(0x100, 2); SGB(0x002, 3); } \
      SBAR(); \
      mfma5(o, VB, pa1); pa2 = pk4e<0>(PP1); trstep<2>(VA, vb_); \
      _Pragma("unroll") for (int i_ = 0; i_ < 5; ++i_) { SGB(0x008, 1); SGB(0x100, 2); SGB(0x002, 3); } \
      SBAR(); \
      mfma5(o, VA, pa2); pa3 = pk4e<8>(PP1); trstep<3>(VB, vb_); \
      _Pragma("unroll") for (int i_ = 0; i_ < 5; ++i_) { SGB(0x008, 1); SGB(0x100, 2); SGB(0x002, 3); } \
      SBAR(); \
      mfma5(o, VB, pa3); if (DOQK) dmx_ = rowmax_lean(PC0, PC1); \
      _Pragma("unroll") for (int i_ = 0; i_ < 5; ++i_) { SGB(0x008, 1); SGB(0x002, 7); } \
      SBAR(); \
      if (DOQK) shift_lean(dmx_, PC0, PC1, nm, ALC, false); } while (0)
    SLOAD(0, 0); asm volatile("s_waitcnt vmcnt(0)" ::: "memory"); SWRITE(0, 0); __syncthreads();
    QKT(pA0, pA1, K_lds + KOFF(0)); shift_lean(rowmax_lean(pA0, pA1), pA0, pA1, nm, alA, true);
    SLOAD(0, 1); asm volatile("s_waitcnt vmcnt(0)" ::: "memory"); SWRITE(1, 0); __syncthreads();
    for (int j = 1; j + 1 < NT; j += 2) {
      KSTEPS(pB0, pB1, alB, pA0, pA1, 1, 0, SLOAD(0, j + 1), true);
      __syncthreads(); asm volatile("s_waitcnt vmcnt(0)" ::: "memory"); SWRITE(0, 0);
      RESC(alB); __syncthreads();
      KSTEPS(pA0, pA1, alA, pB0, pB1, 0, 1, SLOAD(0, j + 2), true);
      __syncthreads(); asm volatile("s_waitcnt vmcnt(0)" ::: "memory"); SWRITE(1, 0);
      RESC(alA); __syncthreads();
    }
    KSTEPS(pB0, pB1, alB, pA0, pA1, 1, 0, (void)0, true);
    __syncthreads(); RESC(alB);
    KSTEPS(pA0, pA1, alA, pB0, pB1, 0, 1, (void)0, false);
#undef KSTEPS
  } else if constexpr (!THREE) {
  constexpr int SE = 0, SO = SDEPTH - 1;
  SLOAD(SE, 0); asm volatile("s_waitcnt vmcnt(0)" ::: "memory"); SWRITE(0, SE); __syncthreads();
  QKT(pA0, pA1, K_lds + KOFF(0)); PSM(pA0, pA1, mnA, alA, true);
  SLOAD(SO, 1); if constexpr (SDEPTH == 2) { if (2 < NT) SLOAD(SE, 2); }
  SWAIT(); SWRITE(1, SO); __syncthreads();
#define ILV() do { if constexpr (PVPIPE) { _Pragma("unroll") for (int i_ = 0; i_ < 20; ++i_) { __builtin_amdgcn_sched_group_barrier(0x008, 1, 0); __builtin_amdgcn_sched_group_barrier(0x002, 5, 0); } } } while (0)
#define LSLOAD(i, jt) do { if constexpr (ATTV != 3) SLOAD(i, jt); } while (0)
#define LSWRITE(bf, i) do { if constexpr (ATTV != 3) SWRITE(bf, i); } while (0)
#define LSWAIT() do { if constexpr (ATTV != 3) SWAIT(); } while (0)
#define LSYNC() do { if constexpr (ATTV != 4) __syncthreads(); } while (0)
#define HALFSTEP(PC0, PC1, MNC, ALC, PP0, PP1, ALP, KC, VP, LD) do { \
    if (!STAG || wid < 4) { \
      SBAR(); QKT(PC0, PC1, K_lds + KOFF(KC)); FSM(PP0, PP1, ALP); SBAR(); \
      LD; SBAR(); \
      if constexpr (PVPIPE && LEAN && ATTV == 0) { if constexpr (ATT_TRB) pv_psm_lean_b(o, vb0 + VOFF(VP), pa0, pa1, pa2, pa3, PC0, PC1, nm, ALC); else pv_psm_lean(o, vb0 + VOFF(VP), pa0, pa1, pa2, pa3, PC0, PC1, nm, ALC); } else { PV(vb0 + VOFF(VP)); PSM(PC0, PC1, MNC, ALC, false); } \
    } else { \
      SBAR(); FSM(PP0, PP1, ALP); SBAR(); \
      LD; SBAR(); \
      PV(vb0 + VOFF(VP)); SBAR(); \
      QKT(PC0, PC1, K_lds + KOFF(KC)); SBAR(); \
      PSM(PC0, PC1, MNC, ALC, false); \
    } } while (0)
  constexpr bool STAG = (MODE == 1) && ATT_STAGGER && ATTV == 0;
  for (int j = 1; j + 1 < NT; j += 2) {
    HALFSTEP(pB0, pB1, mnB, alB, pA0, pA1, alA, 1, 0, LSLOAD(SO, j + SDEPTH));
    LSYNC(); LSWAIT(); LSWRITE(0, SE);
    RESC(alB); LSYNC();
    HALFSTEP(pA0, pA1, mnA, alA, pB0, pB1, alB, 0, 1, if (SDEPTH == 1 || j + 3 < NT) LSLOAD(SE, j + 1 + SDEPTH));
    LSYNC(); LSWAIT(); LSWRITE(1, SO);
    RESC(alA); LSYNC();
  }
#undef HALFSTEP
#undef ILV
#undef LSLOAD
#undef LSWRITE
#undef LSWAIT
#undef LSYNC
  SBAR(); QKT(pB0, pB1, K_lds + KOFF(1));
  FSM(pA0, pA1, alA); SBAR();
  PV(vb0); PSM(pB0, pB1, mnB, alB, false);
  __syncthreads(); RESC(alB);
  FSM(pB0, pB1, alB); SBAR();
  PV(vb0 + VOFF(1));
  } else {
#define STEP(PC0, PC1, ALC, PP0, PP1, ALP, jj, SP, SC, SN) do { const int j_ = (jj); \
      if (j_ + 1 < NT) { asm volatile("s_waitcnt vmcnt(0)" ::: "memory"); SWRITE(SN, 0); if (j_ + 2 < NT) SLOAD(0, j_ + 2); } \
      SBAR(); QKT(PC0, PC1, K_lds + KOFF(SC)); FSM(PP0, PP1, ALP); SBAR(); \
      PV(vb0 + VOFF(SP)); PSM(PC0, PC1, mnA, ALC, false); \
      RESC(ALC); __syncthreads(); } while (0)
    SLOAD(0, 0); asm volatile("s_waitcnt vmcnt(0)" ::: "memory"); SWRITE(0, 0);
    SLOAD(0, 1); asm volatile("s_waitcnt vmcnt(0)" ::: "memory"); SWRITE(1, 0);
    SLOAD(0, 2); __syncthreads();
    QKT(pA0, pA1, K_lds + KOFF(0)); PSM(pA0, pA1, mnA, alA, true);
    STEP(pB0, pB1, alB, pA0, pA1, alA, 1, 0, 1, 2);
    int j = 2;
    for (; j + 5 < NT; j += 6) {
      STEP(pA0, pA1, alA, pB0, pB1, alB, j, 1, 2, 0);
      STEP(pB0, pB1, alB, pA0, pA1, alA, j + 1, 2, 0, 1);
      STEP(pA0, pA1, alA, pB0, pB1, alB, j + 2, 0, 1, 2);
      STEP(pB0, pB1, alB, pA0, pA1, alA, j + 3, 1, 2, 0);
      STEP(pA0, pA1, alA, pB0, pB1, alB, j + 4, 2, 0, 1);
      STEP(pB0, pB1, alB, pA0, pA1, alA, j + 5, 0, 1, 2);
    }
    if (j < NT) { STEP(pA0, pA1, alA, pB0, pB1, alB, j, 1, 2, 0); STEP(pB0, pB1, alB, pA0, pA1, alA, j + 1, 2, 0, 1); j += 2; }
    if (j < NT) { STEP(pA0, pA1, alA, pB0, pB1, alB, j, 0, 1, 2); STEP(pB0, pB1, alB, pA0, pA1, alA, j + 1, 1, 2, 0); j += 2; }
    FSM(pB0, pB1, alB); SBAR();
    { const int sl = (NT - 1) % 3; PV(vb0 + VOFF(sl)); }
#undef STEP
  }
  float rli[16];
  if constexpr (LEAN) {
#pragma unroll
    for (int r = 0; r < 16; ++r) rli[r] = __builtin_amdgcn_rcpf(o[NOB - 1][r]);
  } else {
    if (hi == 0) li_l[r32] = l_reg; asm volatile("s_waitcnt lgkmcnt(0)" ::: "memory");
#pragma unroll
    for (int r = 0; r < 16; ++r) rli[r] = __builtin_amdgcn_rcpf(li_l[crow(r, hi)]);
  }
  bf16* Ow = Ob + (size_t)(wq * 32) * DM;
  if constexpr (MODE == 0) {
#pragma unroll
    for (int r = 0; r < 16; ++r) { const int orow = crow(r, hi);
#pragma unroll
      for (int d0 = 0; d0 < 4; ++d0) Ow[(size_t)orow * DM + d0 * 32 + r32] = tobf1(o[d0][r] * rli[r]); }
    __syncthreads();
  } else {
    LAS float* ex = (LAS float*)lds;
    __syncthreads();
    if (sgrp == 1) {
#pragma unroll
      for (int r = 0; r < 16; ++r)
#pragma unroll
        for (int d0 = 0; d0 < 4; ++d0) ex[(wq * 32 + crow(r, hi)) * 128 + d0 * 32 + r32] = o[d0][r] * rli[r];
    }
    __syncthreads();
    if (sgrp == 0) {
#pragma unroll
      for (int r = 0; r < 16; ++r) { const int orow = crow(r, hi); float dd[4]; float ss = 0.f;
#pragma unroll
        for (int d0 = 0; d0 < 4; ++d0) { dd[d0] = o[d0][r] * rli[r] - lam * ex[(wq * 32 + orow) * 128 + d0 * 32 + r32]; ss += dd[d0] * dd[d0]; }
        ss = half_sum32(ss);
        const float rs = oscale / sqrtf(ss * (1.0f / 128.0f) + LN_EPS);
#pragma unroll
        for (int d0 = 0; d0 < 4; ++d0) Ow[(size_t)orow * DM + d0 * 32 + r32] = tobf1(dd[d0] * rs * subln[d0 * 32 + r32]); }
    }
    __syncthreads();
  }
  if (ATT_PRIO) __builtin_amdgcn_s_setprio(0);
#undef VOFF
#undef KOFF
#undef PV
#undef PSM
#undef FSM
#undef QKT
#undef KROW
#undef SLOAD
#undef SWRITE
#undef SWAIT
#undef RESC
}
}

__device__ __forceinline__ void mla_attn_phase(CP P, LAS unsigned char* lds, const int tid) {
    const bf16* QM = (const bf16*)(P->ws + WS_QM); const bf16* KV = (const bf16*)(P->ws + WS_KV); const bf16* KR = (const bf16*)(P->ws + WS_KR); bf16* Gb = (bf16*)(P->ws + WS_G);
    const int c = blockIdx.x, G = gridDim.x;
    for (int u = c; u < 1024 + 32; u += G) {
        int b, h, qrow0, NT;
        if (u < 1024) { const int i = u >> 8, cc = u & 255; const int bh = (cc & 7) + 8 * i, qb = cc >> 3; b = bh >> 4; h = bh & 15; qrow0 = b * SEQ + qb * 256; NT = 4 + 128; }
        else { const int bh = u - 1024; b = bh >> 4; h = bh & 15; qrow0 = ML + b * CTXL; NT = 4; }
        att::attn_unit<0>(QM + (size_t)qrow0 * 3072 + h * 192, 3072, KV + h * 256, KV + h * 256 + 128, 4096, KR, b, 4, NT, Gb + (size_t)qrow0 * DM + h * 128, 0.f, nullptr, 1.f, lds, tid);
    }
}
template <int ATTV = 0>
__device__ __forceinline__ void da_attn_phase(CP P, float lam, float oscale, LAS unsigned char* lds, const int tid, const bool ctx_q) {
    const bf16* Z = (const bf16*)(P->ws + WS_Z); bf16* Gb = (bf16*)(P->ws + WS_G); const float* subln = P->in[27];
    const int c = blockIdx.x, G = gridDim.x;
    for (int u = c; u < 2048 + (ctx_q ? 64 : 0); u += G) {
        int b, h, qrow0, NT;
        if (u < 2048) { const int i = u >> 8, cc = u & 255; const int bh = (cc & 7) + 8 * (i >> 1), qb = (cc >> 3) + 32 * (i & 1); b = bh >> 4; h = bh & 15; qrow0 = b * SEQ + qb * 128; NT = 4 + 128; }
        else { const int v = u - 2048; const int bh = v >> 1; b = bh >> 4; h = bh & 15; qrow0 = ML + b * CTXL + (v & 1) * 128; NT = 4; }
        att::attn_unit<1, ATTV>(Z + (size_t)qrow0 * 6144 + h * 128, 6144, Z + 2048 + h * 128, Z + 4096 + h * 128, 6144, nullptr, b, 4, NT, Gb + (size_t)qrow0 * DM + h * 128, lam, subln, oscale, lds, tid);
    }
}

__device__ __forceinline__ unsigned f2ord(float f) { const unsigned u = __float_as_uint(f); return u ^ ((unsigned)((int)u >> 31) | 0x80000000u); }
__device__ __forceinline__ float ord2f(unsigned k) { return __uint_as_float((k & 0x80000000u) ? (k ^ 0x80000000u) : ~k); }
__device__ __forceinline__ void ce_desc(unsigned& a, unsigned& b) { const unsigned mx = a > b ? a : b, mn = a > b ? b : a; a = mx; b = mn; }
template <int N, bool DESC> __device__ __forceinline__ void bitonic_merge(unsigned* a) {
#pragma unroll
    for (int j = N / 2; j > 0; j >>= 1)
#pragma unroll
        for (int i = 0; i < N; ++i) { const int l = i ^ j; if (l > i) { if (DESC) ce_desc(a[i], a[l]); else ce_desc(a[l], a[i]); } }
}
template <int N, bool DESC> __device__ __forceinline__ void bitonic_sort(unsigned* a) {
#pragma unroll
    for (int k = 2; k <= N; k <<= 1)
#pragma unroll
        for (int j = k >> 1; j > 0; j >>= 1)
#pragma unroll
            for (int i = 0; i < N; ++i) { const int l = i ^ j; if (l > i) { const bool up = ((i & k) == 0); if (up == DESC) ce_desc(a[i], a[l]); else ce_desc(a[l], a[i]); } }
}
__device__ __forceinline__ void top16_of_64(unsigned (&a)[64]) {
    bitonic_sort<16, true>(a); bitonic_sort<16, false>(a + 16); bitonic_sort<16, true>(a + 32); bitonic_sort<16, false>(a + 48);
#pragma unroll
    for (int i = 0; i < 16; ++i) a[i] = a[i] > a[16 + i] ? a[i] : a[16 + i];
    bitonic_merge<16, true>(a);
#pragma unroll
    for (int i = 0; i < 16; ++i) a[32 + i] = a[32 + i] > a[48 + i] ? a[32 + i] : a[48 + i];
    bitonic_merge<16, false>(a + 32);
#pragma unroll
    for (int i = 0; i < 16; ++i) a[i] = a[i] > a[32 + i] ? a[i] : a[32 + i];
    bitonic_merge<16, true>(a);
}
template <int PASS> __device__ __forceinline__ void route_pass(const bf16* QP, const LAS char* lds, int tok, int head, int r32, int hi, unsigned (&top)[16]) {
    f32x16 acc[4] = {};
    const bf16* qp = QP + (size_t)tok * DM + head * 256 + PASS * 128 + hi * 8;
    bf16x8 qf[8];
#pragma unroll
    for (int ks = 0; ks < 8; ++ks) qf[ks] = *(const bf16x8*)(qp + ks * 16);
    const LAS char* Kl = lds + PASS * 32768;
#pragma unroll
    for (int kb = 0; kb < 4; ++kb)
#pragma unroll
        for (int ks = 0; ks < 8; ++ks) { const bf16x8 a = *(const LAS bf16x8*)(Kl + (kb * 32 + r32) * 256 + (((ks * 2 + hi) ^ (r32 & 15)) * 16));
            acc[kb] = __builtin_amdgcn_mfma_f32_32x32x16_bf16(a, qf[ks], acc[kb], 0, 0, 0); }
    unsigned key[64]; const unsigned base = 127u - 4u * (unsigned)hi;
#pragma unroll
    for (int kb = 0; kb < 4; ++kb)
#pragma unroll
        for (int r = 0; r < 16; ++r) key[kb * 16 + r] = (f2ord(acc[kb][r]) & ~127u) | (base - (unsigned)(kb * 32 + (r & 3) + 8 * (r >> 2)));
    top16_of_64(key);
    unsigned pr[16];
#pragma unroll
    for (int i = 0; i < 16; ++i) pr[i] = lane_xor32(key[15 - i], hi << 5);
#pragma unroll
    for (int i = 0; i < 16; ++i) key[i] = key[i] > pr[i] ? key[i] : pr[i];
    bitonic_merge<16, true>(key);
#pragma unroll
    for (int i = 0; i < 16; ++i) top[i] = key[i];
}
#ifndef ROUTE_SORT
#define ROUTE_SORT 1
#endif
#define DPP_U(v, ctrl) ((unsigned)__builtin_amdgcn_mov_dpp((int)(v), (ctrl), 0xF, 0xF, true))
template <int J> __device__ __forceinline__ unsigned lane_xor_u(unsigned v, int lane) {
    if (J == 1) return DPP_U(v, 0xB1);
    if (J == 2) return DPP_U(v, 0x4E);
    if (J == 4) { const unsigned t = DPP_U(v, 0x141); return DPP_U(t, 0x1B); }
    if (J == 8) { const unsigned t = DPP_U(v, 0x140); return DPP_U(t, 0x141); }
    if (J == 16) { const auto r = __builtin_amdgcn_permlane16_swap(v, v, false, false); return (lane & 16) ? r[0] : r[1]; }
    return lane_xor32(v, lane);
}
template <int K, int J> __device__ __forceinline__ void sort128_stage(unsigned& a0, unsigned& a1, int lane) {
    if constexpr (J == 64) { const unsigned mn = a0 < a1 ? a0 : a1, mx = a0 < a1 ? a1 : a0; a0 = mn; a1 = mx; }
    else { const unsigned p0 = lane_xor_u<J>(a0, lane), p1 = lane_xor_u<J>(a1, lane);
        const bool lower = (lane & J) == 0;
        const bool asc0 = (K >= 64) ? true : ((lane & K) == 0), asc1 = (K == 128) ? true : (K == 64 ? false : ((lane & K) == 0));
        const unsigned mn0 = a0 < p0 ? a0 : p0, mx0 = a0 < p0 ? p0 : a0, mn1 = a1 < p1 ? a1 : p1, mx1 = a1 < p1 ? p1 : a1;
        a0 = (lower == asc0) ? mn0 : mx0; a1 = (lower == asc1) ? mn1 : mx1; }
    if constexpr (J > 1) sort128_stage<K, J / 2>(a0, a1, lane);
    else if constexpr (K < 128) sort128_stage<K * 2, K>(a0, a1, lane);
}
__device__ __forceinline__ void sort128_asc(unsigned& a0, unsigned& a1, int lane) { sort128_stage<2, 1>(a0, a1, lane); }
__device__ __forceinline__ void route_phase(CP P, int L, int Mrows, LAS unsigned char* lds_, int tid, int lane, int wid, int gw, int NGW) {
    const bf16* QP = (const bf16*)(P->ws + WS_QP); unsigned* ROUTE = (unsigned*)(P->ws + WS_ROUTE);
    LAS char* lds = (LAS char*)(LAS unsigned char*)lds_;
    __syncthreads();
    {
        const bf16* K1 = (const bf16*)(P->ws + WS_PK1) + (size_t)L * 128 * 128; const bf16* K2 = (const bf16*)(P->ws + WS_PK2) + (size_t)L * 128 * 128;
        for (int c16 = tid; c16 < 2 * 128 * 16; c16 += NWAVES * 64) { const int mat = c16 >> 11, row = (c16 >> 4) & 127, ch = c16 & 15;
            const u32x4 w = *(const u32x4*)((mat ? K2 : K1) + row * 128 + ch * 8);
            *(LAS u32x4*)(lds + mat * 32768 + row * 256 + ((ch ^ (row & 15)) * 16)) = w; }
    }
    __syncthreads();
    LAS unsigned* sc = (LAS unsigned*)(lds + 65536) + wid * 2048;
    const int r32 = lane & 31, hi = lane >> 5;
    for (int item = gw; item < Mrows / 4; item += NGW) {
        const int tok = item * 4 + (r32 >> 3), head = r32 & 7;
        unsigned top0[16], top1[16];
        route_pass<0>(QP, lds, tok, head, r32, hi, top0);
        route_pass<1>(QP, lds, tok, head, r32, hi, top1);
        float v1[16], v2[16];
#pragma unroll
        for (int i = 0; i < 16; ++i) { v1[i] = ord2f(top0[i] & ~127u); v2[i] = ord2f(top1[i] & ~127u);
            sc[i * 64 + lane] = 127u - (top0[i] & 127u); sc[(16 + i) * 64 + lane] = 127u - (top1[i] & 127u); }
        unsigned ck[64]; int n = 0;
#pragma unroll
        for (int i = 0; i < 16; ++i)
#pragma unroll
            for (int j = 0; j < 16; ++j) if ((i + 1) * (j + 1) <= 16) { ck[n] = (f2ord(v1[i] + v2[j]) & ~255u) | (unsigned)(i * 16 + j); ++n; }
#pragma unroll
        for (int i = 50; i < 64; ++i) ck[i] = 0u;
        top16_of_64(ck);
        float ev[16]; float sum = 0.f; const float mx = ord2f(ck[0] & ~255u);
#pragma unroll
        for (int k = 0; k < 16; ++k) { ev[k] = __expf(ord2f(ck[k] & ~255u) - mx); sum += ev[k]; }
        const float inv = 1.0f / sum;
        unsigned ee[16];
#pragma unroll
        for (int k = 0; k < 16; ++k) { const unsigned pc = ck[k] & 255u; const unsigned i1 = sc[(pc >> 4) * 64 + lane], i2 = sc[(16 + (pc & 15u)) * 64 + lane]; ee[k] = i1 * 128u + i2; ev[k] *= inv; }
#if ROUTE_SORT
        { const int tq = r32 >> 3;
#pragma unroll
          for (int k = 0; k < 8; ++k) {
              const unsigned eL = ee[k], eH = ee[k + 8]; const float gL = ev[k], gH = ev[k + 8];
              sc[tq * 256 + head * 16 + hi * 8 + k] = hi ? eH : eL; sc[tq * 256 + 128 + head * 16 + hi * 8 + k] = __float_as_uint(hi ? gH : gL); }
#pragma unroll 1
          for (int t = 0; t < 4; ++t) {
              unsigned a0 = (sc[t * 256 + lane] << 7) | (unsigned)lane, a1 = (sc[t * 256 + 64 + lane] << 7) | (unsigned)(64 + lane);
              sort128_asc(a0, a1, lane);
              const unsigned g0 = sc[t * 256 + 128 + (a0 & 127u)], g1 = sc[t * 256 + 128 + (a1 & 127u)];
              u32x2* outp = (u32x2*)(ROUTE + (size_t)(item * 4 + t) * 256);
              outp[lane] = (u32x2){a0 >> 7, g0}; outp[64 + lane] = (u32x2){a1 >> 7, g1}; }
        }
#else
        u32x4* outp = (u32x4*)(ROUTE + ((size_t)tok * 128 + head * 16 + hi * 8) * 2);
#pragma unroll
        for (int k = 0; k < 8; k += 2) { u32x4 w;
            const unsigned eL0 = ee[k], eH0 = ee[k + 8], eL1 = ee[k + 1], eH1 = ee[k + 9]; const float gL0 = ev[k], gH0 = ev[k + 8], gL1 = ev[k + 1], gH1 = ev[k + 9];
            w.x = hi ? eH0 : eL0; w.y = __float_as_uint(hi ? gH0 : gL0); w.z = hi ? eH1 : eL1; w.w = __float_as_uint(hi ? gH1 : gL1);
            outp[k >> 1] = w; }
#endif
    }
}

typedef float f32x2 __attribute__((ext_vector_type(2)));
typedef float f32x32 __attribute__((ext_vector_type(32)));
typedef unsigned u32x6 __attribute__((ext_vector_type(6)));
typedef __bf16 bf16x32 __attribute__((ext_vector_type(32)));
typedef unsigned u32x16 __attribute__((ext_vector_type(16)));
typedef __bf16 bf16x2_t __attribute__((ext_vector_type(2)));
constexpr int GS = 6, GSLOT = 2 * PROW;
__device__ __forceinline__ void glds16(const void* gsrc, unsigned lds_dst) { unsigned keep;
  asm volatile("s_mov_b32 %0, m0\n\ts_mov_b32 m0, %2\n\ts_nop 0\n\tglobal_load_lds_dwordx4 %1, off\n\ts_mov_b32 m0, %0" : "=&s"(keep) : "v"(gsrc), "s"(lds_dst) : "memory"); }
template <int GMODE = 0>
__device__ __forceinline__ void gather_phase(CP P, int L, int Mrows, LAS unsigned char* lds, int wid, int lane_, int gw, int NGW, bool dry = false) {
    const unsigned char* UV = P->ws + WS_PU + (size_t)L * 16384 * PREC;
    const unsigned* ROUTE = (const unsigned*)(P->ws + WS_ROUTE); const float* MOD = (const float*)(P->ws + WS_MOD);
    bf16* X = (bf16*)(P->ws + WS_X); bf16* H = (bf16*)(P->ws + WS_H); bf16* Xo = dry ? (bf16*)(P->ws + WS_Y) : X; bf16* Ho = dry ? (bf16*)(P->ws + WS_G) : H;
    const float* lng = P->in[6] + (size_t)(L * 2 + 1) * DM; const float* lnb = P->in[7] + (size_t)(L * 2 + 1) * DM;
    const unsigned ring = (unsigned)(uintptr_t)lds + (unsigned)wid * (GS * GSLOT);
    const int nfull = (Mrows / NGW) * NGW, rem = Mrows - nfull; const bool can_coop = (rem * 4 == NGW);
    const int nround = nfull / NGW + (rem > 0 ? 1 : 0);
#define G_ROWOF(it_) ((can_coop && (it_) == nround - 1) ? (nfull + (int)blockIdx.x * 2 + (wid >> 2)) : (gw + (it_) * NGW))
    u32x2 nea = {0u, 0u}, neb = {0u, 0u}; u32x4 nh0 = {0u, 0u, 0u, 0u}, nh1 = nh0, nh2 = nh0, nh3 = nh0;
#define G_PREFETCH(rowN_, ln_) do { const int rn_ = (rowN_); nea = ((const u32x2*)(ROUTE + (size_t)rn_ * 256))[ln_]; neb = ((const u32x2*)(ROUTE + (size_t)rn_ * 256))[64 + (ln_)]; \
        const u32x4* hp_ = (const u32x4*)(H + (size_t)rn_ * DM) + 4 * (ln_); nh0 = hp_[0]; nh1 = hp_[1]; nh2 = hp_[2]; nh3 = hp_[3]; } while (0)
    if (nround > 0 && G_ROWOF(0) < Mrows) G_PREFETCH(G_ROWOF(0), launder_v(lane_));
#pragma unroll 1
    for (int it = 0; it < nround; ++it) {
        const bool coop = can_coop && (it == nround - 1);
        int row = G_ROWOF(it), k0 = 0, kn = 128;
        if (coop) { k0 = (wid & 3) * 32; kn = k0 + 32; }
        else if (row >= Mrows) break;
        const int lane = launder_v(lane_);
        const u32x2 ea = nea, eb = neb;
        unsigned eax, eay, ebx, eby;
        unsigned hw[16] = {nh0.x, nh0.y, nh0.z, nh0.w, nh1.x, nh1.y, nh1.z, nh1.w, nh2.x, nh2.y, nh2.z, nh2.w, nh3.x, nh3.y, nh3.z, nh3.w};
        float y[32];
#pragma unroll
        for (int i = 0; i < 32; ++i) y[i] = 0.f;
        { unsigned e0 = ea.x, e1 = ea.y, e2 = eb.x, e3 = eb.y;
          asm volatile("" : "+v"(e0), "+v"(e1), "+v"(e2), "+v"(e3), "+v"(hw[0]), "+v"(hw[1]), "+v"(hw[2]), "+v"(hw[3]), "+v"(hw[4]), "+v"(hw[5]), "+v"(hw[6]), "+v"(hw[7]),
                       "+v"(hw[8]), "+v"(hw[9]), "+v"(hw[10]), "+v"(hw[11]), "+v"(hw[12]), "+v"(hw[13]), "+v"(hw[14]), "+v"(hw[15]) :: "memory");
          eax = e0; eay = e1; ebx = e2; eby = e3; }
        const unsigned rd_a = ring + 16u * (unsigned)lane, rd_b = ring + 2048u + 8u * (unsigned)lane;
#define G_ISSUE(k) do { const int k_ = (k); const unsigned e_ = (unsigned)__builtin_amdgcn_readlane((int)(k_ < 64 ? eax : ebx), k_ & 63); \
        const unsigned char* rp_ = UV + (size_t)e_ * PREC + 16 * lane; const unsigned sb_ = ring + (unsigned)(k_ % GS) * GSLOT; \
        if (GMODE != 2) { glds16(rp_, sb_); glds16(rp_ + 1024, sb_ + 1024); glds16(rp_ + 2048, sb_ + 2048); } else { asm volatile("" :: "v"(rp_), "s"(sb_)); } } while (0)
#pragma unroll
        for (int k = 0; k < 4; ++k) G_ISSUE(k0 + k);
        if (it + 1 < nround && G_ROWOF(it + 1) < Mrows) G_PREFETCH(G_ROWOF(it + 1), lane);
#define G_READ(k, ua, ub, va, vb) do { const unsigned so_ = (unsigned)((k) % GS) * GSLOT; \
        asm volatile("ds_read_b128 %0, %4\n\tds_read_b64 %1, %5\n\tds_read_b128 %2, %4 offset:1024\n\tds_read_b64 %3, %5 offset:512" \
                     : "=&v"(ua), "=&v"(ub), "=&v"(va), "=&v"(vb) : "v"(rd_a + so_), "v"(rd_b + so_) : "memory"); } while (0)
#pragma unroll 1
        for (int k = k0; k < kn; k += 2) {
            if (k + 4 < kn) { G_ISSUE(k + 4); G_ISSUE(k + 5); asm volatile("s_waitcnt vmcnt(12)" ::: "memory"); }
            else if (k == kn - 4) asm volatile("s_waitcnt vmcnt(6)" ::: "memory");
            else asm volatile("s_waitcnt vmcnt(0)" ::: "memory");
            u32x4 uaA, vaA, uaB, vaB; u32x2 ubA, vbA, ubB, vbB;
            G_READ(k, uaA, ubA, vaA, vbA); G_READ(k + 1, uaB, ubB, vaB, vbB);
            asm volatile("s_waitcnt lgkmcnt(0)" : "+v"(uaA), "+v"(ubA), "+v"(vaA), "+v"(vbA), "+v"(uaB), "+v"(ubB), "+v"(vaB), "+v"(vbB) :: "memory");
            if (GMODE == 1) continue;
            const u32x6 u6A = {uaA.x, uaA.y, uaA.z, uaA.w, ubA.x, ubA.y}, u6B = {uaB.x, uaB.y, uaB.z, uaB.w, ubB.x, ubB.y};
            const u32x16 ubfA = __builtin_bit_cast(u32x16, __builtin_amdgcn_cvt_scalef32_pk32_bf16_fp6(u6A, 1.0f));
            const u32x16 ubfB = __builtin_bit_cast(u32x16, __builtin_amdgcn_cvt_scalef32_pk32_bf16_fp6(u6B, 1.0f));
            float a0 = 0.f, a1 = 0.f, b0 = 0.f, b1 = 0.f;
#pragma unroll
            for (int q = 0; q < 16; q += 2) { const unsigned h0_ = hw[q], h1_ = hw[q + 1], x0_ = ubfA[q], x1_ = ubfA[q + 1], z0_ = ubfB[q], z1_ = ubfB[q + 1];
                a0 = __builtin_amdgcn_fdot2_f32_bf16(__builtin_bit_cast(bf16x2_t, h0_), __builtin_bit_cast(bf16x2_t, x0_), a0, false);
                a1 = __builtin_amdgcn_fdot2_f32_bf16(__builtin_bit_cast(bf16x2_t, h1_), __builtin_bit_cast(bf16x2_t, x1_), a1, false);
                b0 = __builtin_amdgcn_fdot2_f32_bf16(__builtin_bit_cast(bf16x2_t, h0_), __builtin_bit_cast(bf16x2_t, z0_), b0, false);
                b1 = __builtin_amdgcn_fdot2_f32_bf16(__builtin_bit_cast(bf16x2_t, h1_), __builtin_bit_cast(bf16x2_t, z1_), b1, false); }
            const float dA = wave_sum(a0 + a1) * (1.0f / U_SCALE), dB = wave_sum(b0 + b1) * (1.0f / U_SCALE);
            const unsigned gsel = k < 64 ? eay : eby;
            const float wA = __uint_as_float((unsigned)__builtin_amdgcn_readlane((int)gsel, k & 63)) * gelu_tanh(dA) * (1.0f / V_SCALE);
            const float wB = __uint_as_float((unsigned)__builtin_amdgcn_readlane((int)gsel, (k & 63) + 1)) * gelu_tanh(dB) * (1.0f / V_SCALE);
            const u32x6 v6A = {vaA.x, vaA.y, vaA.z, vaA.w, vbA.x, vbA.y};
            const f32x32 vfA = __builtin_amdgcn_cvt_scalef32_pk32_f32_fp6(v6A, 1.0f);
#pragma unroll
            for (int i = 0; i < 32; ++i) y[i] += wA * vfA[i];
            const u32x6 v6B = {vaB.x, vaB.y, vaB.z, vaB.w, vbB.x, vbB.y};
            const f32x32 vfB = __builtin_amdgcn_cvt_scalef32_pk32_f32_fp6(v6B, 1.0f);
#pragma unroll
            for (int i = 0; i < 32; ++i) y[i] += wB * vfB[i];
        }
#undef G_READ
#undef G_ISSUE
        if (coop) {
            LAS f32x4* mine = (LAS f32x4*)(lds + wid * (GS * GSLOT)) + lane * 8;
#pragma unroll
            for (int i = 0; i < 8; ++i) mine[i] = (f32x4){y[4 * i], y[4 * i + 1], y[4 * i + 2], y[4 * i + 3]};
            __syncthreads();
            if ((wid & 3) == 0) {
#pragma unroll
                for (int j = 1; j < 4; ++j) { const LAS f32x4* oth = (const LAS f32x4*)(lds + (wid + j) * (GS * GSLOT)) + lane * 8;
#pragma unroll
                    for (int i = 0; i < 8; ++i) { const f32x4 t = oth[i]; y[4 * i] += t.x; y[4 * i + 1] += t.y; y[4 * i + 2] += t.z; y[4 * i + 3] += t.w; } }
            }
            __syncthreads();
            if ((wid & 3) != 0) continue;
        }
        const int slot = row_slot(row);
        const float* mod = MOD + (size_t)(L * 3 + slot) * 12288;
        const int le = launder_v(lane);
        { float xx[32], gg[32]; load_row_bf16_b(X + (size_t)row * DM, le, xx); load_row_f32_b(mod + 5 * 2048, le, gg);
#pragma unroll
          for (int i = 0; i < 32; ++i) y[i] = ALPHA * xx[i] + gg[i] * y[i]; }
        if (L < NLAYER - 1) { const float* modn = MOD + (size_t)((L + 1) * 3 + slot) * 12288;
            finish_row<true>(y, lng, lnb, Xo + (size_t)row * DM, modn, modn + 2048, Ho + (size_t)row * DM, nullptr, le); }
        else finish_row<true>(y, lng, lnb, nullptr, nullptr, nullptr, nullptr, P->out + (size_t)row * DM, le);
        asm volatile("s_waitcnt vmcnt(0)" ::: "memory");
    }
#undef G_PREFETCH
#undef G_ROWOF
}

#ifndef ROPE_TEST
#define ROPE_TEST 0
#endif
#ifndef PROBE_DUP
#define PROBE_DUP 0
#endif
#define NOINL __forceinline__
__device__ __forceinline__ CP launder_cp(CP p) { asm volatile("" : "+s"(p)); return p; }
#define GETP() launder_cp((CP)__builtin_amdgcn_kernarg_segment_ptr())
__device__ __forceinline__ int uni(int v) { return __builtin_amdgcn_readfirstlane(v); }
__device__ __forceinline__ LAS unsigned char* uni_lds(LAS unsigned char* p) { return (LAS unsigned char*)(unsigned)__builtin_amdgcn_readfirstlane((int)(unsigned)(uintptr_t)p); }
#define PH_IDS const int wid = uni(wv_), lane = launder_v(lane_id_fresh()) & 63, tid = (wid & 7) * 64 + lane; const int gw = blockIdx.x * NWAVES + wid, NGW = gridDim.x * NWAVES; (void)lane; (void)gw; (void)NGW; (void)tid;

__device__ NOINL void ph_prologue(int wv_, LAS unsigned char* lds_) { CP P = GETP(); LAS unsigned char* lds = uni_lds(lds_); PH_IDS p0_prologue(P, lds, tid, lane, wid, gw, NGW); if (PROBE_DUP == 5) p0_prologue(P, lds, tid, lane, wid, gw, NGW); }
__device__ NOINL void ph_modreduce(int wv_) { CP P = GETP(); PH_IDS mod_reduce(P, gw, lane, NGW); }
__device__ NOINL void ph_first(int wv_) { CP P = GETP(); PH_IDS
#pragma unroll 1
    for (int rep = 0; rep < (PROBE_DUP == 6 ? 2 : 1); ++rep) first_row_pass(P, lane, gw, NGW); }
__device__ NOINL void ph_postmix(int wv_, int L_, int M_) { CP P = GETP(); const int L = uni(L_), Mrows = uni(M_); PH_IDS post_mixer_pass(P, L, Mrows, lane, gw, NGW); }
__device__ NOINL void ph_vstats(int wv_, int M_) { CP P = GETP(); const int Mrows = uni(M_); PH_IDS
#pragma unroll 1
    for (int rep = 0; rep < (PROBE_DUP == 6 ? 2 : 1); ++rep) vstats_pass(P, Mrows, lane, gw, NGW); }
__device__ NOINL void ph_spatial(int wv_, LAS unsigned char* lds_, int j_, int M_) { CP P = GETP(); LAS unsigned char* lds = uni_lds(lds_); const int j = uni(j_), Mrows = uni(M_); PH_IDS
#pragma unroll 1
    for (int rep = 0; rep < (PROBE_DUP == 6 ? 2 : 1); ++rep) spatial_phase(P, j, Mrows, lds, tid, lane, wid); }
__device__ NOINL void ph_mla_norm(int wv_) { CP P = GETP(); PH_IDS
#pragma unroll 1
    for (int rep = 0; rep < (PROBE_DUP == 6 ? 2 : 1); ++rep) mla_norm_pass(P, lane, gw, NGW); }
__device__ NOINL void ph_rope(int wv_, int which_) { CP P = GETP(); const int which = uni(which_); PH_IDS
    if (which == 0) rope_pass((bf16*)(P->ws + WS_QM), 3072, 128, 16, 192, lane, gw, NGW);
    else rope_pass((bf16*)(P->ws + WS_Z), 6144, 0, 64, 64, lane, gw, NGW); }
__device__ NOINL void ph_attn_mla(int wv_, LAS unsigned char* lds_) { CP P = GETP(); LAS unsigned char* lds = uni_lds(lds_); PH_IDS mla_attn_phase(P, lds, tid); if (PROBE_DUP == 2 || PROBE_DUP == 9) mla_attn_phase(P, lds, tid); }
__device__ NOINL void ph_attn_da(int wv_, LAS unsigned char* lds_, int L_, bool ctx_q) { CP P = GETP(); LAS unsigned char* lds = uni_lds(lds_); const int L = uni(L_); PH_IDS
    const float* lp = P->in[26];
    const float s01 = wave_sum(lp[lane] * lp[64 + lane]), s23 = wave_sum(lp[128 + lane] * lp[192 + lane]);
    const float lam_init = 0.8f - 0.6f * expf(-0.3f * (float)L);
    const float lam = expf(s01) - expf(s23) + lam_init;
    if (!(PROBE_DUP >= 11 && PROBE_DUP <= 15)) da_attn_phase(P, lam, 1.0f - lam_init, lds, tid, ctx_q);
    if (PROBE_DUP == 2 || PROBE_DUP == 10) da_attn_phase(P, lam, 1.0f - lam_init, lds, tid, ctx_q);
    if (PROBE_DUP >= 11 && PROBE_DUP <= 15) { da_attn_phase<PROBE_DUP >= 11 && PROBE_DUP <= 15 ? PROBE_DUP - 10 : 0>(P, lam, 1.0f - lam_init, lds, tid, ctx_q); __syncthreads(); }
    if (PROBE_DUP >= 11 && PROBE_DUP <= 15) da_attn_phase(P, lam, 1.0f - lam_init, lds, tid, ctx_q); }
__device__ NOINL void ph_route(int wv_, LAS unsigned char* lds_, int L_, int M_) { CP P = GETP(); LAS unsigned char* lds = uni_lds(lds_); const int L = uni(L_), Mrows = uni(M_); PH_IDS
#pragma unroll 1
    for (int rep = 0; rep < (PROBE_DUP == 4 ? 2 : 1); ++rep) route_phase(P, L, Mrows, lds, tid, lane, wid, gw, NGW); }
__device__ NOINL void ph_gather(int wv_, LAS unsigned char* lds_, int L_, int M_) { CP P = GETP(); LAS unsigned char* lds = uni_lds(lds_); const int L = uni(L_), Mrows = uni(M_); PH_IDS
    if (PROBE_DUP == 3) { gather_phase<0>(P, L, Mrows, lds, wid, lane, gw, NGW, true); }
    if (PROBE_DUP == 7) { gather_phase<1>(P, L, Mrows, lds, wid, lane, gw, NGW, true); }
    if (PROBE_DUP == 8) { gather_phase<2>(P, L, Mrows, lds, wid, lane, gw, NGW, true); }
    gather_phase<0>(P, L, Mrows, lds, wid, lane, gw, NGW); }

enum GemmId { G_GM_IN = 0, G_GM_OUT, G_MLA_IN, G_MLA_UQ, G_MLA_UKV, G_MLA_OUT, G_DA_IN, G_DA_OUT, G_PEER_Q };
__device__ NOINL void ph_gemm(int wv_, LAS unsigned char* lds_, int id_, int L_, int M_) {
    CP P = GETP(); LAS unsigned char* lds = uni_lds(lds_); const int id = uni(id_), L = uni(L_), Mrows = uni(M_); PH_IDS
    unsigned char* ws = P->ws; const int jj = L / 3;
    size_t a = WS_H, b = 0, o = 0; int M = MT, N = 2048, K = 2048, act = 0, rope = 0;
    switch (id) {
        case G_GM_IN:   a = WS_H;    b = WS_GMWIN + (size_t)jj * 4096 * 2048 * 2;  o = WS_Z;  M = Mrows; N = 4096; K = 2048; act = 1; break;
        case G_GM_OUT:  a = WS_G;    b = WS_GMWOUT + (size_t)jj * 2048 * 2048 * 2; o = WS_Y;  M = Mrows; N = 2048; K = 2048; break;
        case G_MLA_IN:  a = WS_H;    b = WS_MLAIN;  o = WS_C;  N = 1280; K = 2048; break;
        case G_MLA_UQ:  a = WS_CQN;  b = WS_MLAUQ;  o = WS_QM; N = 3072; K = 512;  rope = (ROPE_TEST == 2) ? 0 : 2; break;
        case G_MLA_UKV: a = WS_CKVN; b = WS_MLAUKV; o = WS_KV; N = 4096; K = 512;  break;
        case G_MLA_OUT: a = WS_G;    b = WS_MLAOUT; o = WS_Y;  N = 2048; K = 2048; break;
        case G_DA_IN:   a = WS_H;    b = WS_DAIN;   o = WS_Z;  N = 6144; K = 2048; rope = (ROPE_TEST == 1) ? 0 : 1; break;
        case G_DA_OUT:  a = WS_G;    b = WS_DAOUT;  o = WS_Y;  M = Mrows; N = 2048; K = 2048; break;
        default:        a = WS_H;    b = WS_PWQ + (size_t)L * 2048 * 2048 * 2;     o = WS_QP; M = Mrows; N = 2048; K = 2048; break;
    }
    pg8::Gemm g{(const pg8::bf16_t*)(ws + a), (const pg8::bf16_t*)(ws + b), M, N, K}; pg8::StaticOrder S; S.init(M, N, (int)gridDim.x, (int)blockIdx.x);
    pg8::EpiR E{(pg8::bf16_t*)(ws + o), N, act, rope, (const float*)(ws + WS_ROPE)};
#pragma unroll 1
    for (int rep = 0; rep < (PROBE_DUP == 1 ? 2 : 1); ++rep) { pg8::gemm_phase<pg8::EpiR, pg8::StaticOrder, true, true>((PG8_LAS unsigned char*)lds, g, S, E, tid); __syncthreads(); }
    const bool tail_u = (id == G_GM_OUT || id == G_MLA_OUT || id == G_DA_OUT), tail_v = (id == G_PEER_Q);
    if ((tail_u || tail_v) && L + 1 < NLAYER) {
        const int units = (M / 256) * (N / 256), G = (int)gridDim.x, tail = units % G, c = (int)blockIdx.x;
        const float* src = (tail_u ? P->in[11] : P->in[12]) + (size_t)(L + 1) * 16384 * 2048; unsigned char* dst = ws + WS_PU + (size_t)(L + 1) * 16384 * PREC;
        LAS float* scr = (LAS float*)(lds + wid * 16384);
        if (tail != 0 && c >= tail) cvt_table_fp6(src, dst, 16384, tail_u ? U_SCALE : V_SCALE, scr, lane, (c - tail) * NWAVES + wid, (G - tail) * NWAVES, tail_u ? 0 : 1);
        else if (tail == 0) cvt_table_fp6(src, dst, 16384, tail_u ? U_SCALE : V_SCALE, scr, lane, gw, NGW, tail_u ? 0 : 1);
    }
}

__global__ void __launch_bounds__(NWAVES * 64, 2) mk_fwd(Params Pv) {
    extern __shared__ __attribute__((aligned(16))) unsigned char lds_g[];
    LAS unsigned char* lds = (LAS unsigned char*)lds_g;
    const int wv = __builtin_amdgcn_readfirstlane((int)threadIdx.x >> 6);
    const int tid = wv * 64 + lane_id_fresh();
    for (int u = tid; u < (LDS_BYTES - RING_BYTES) / 4; u += NWAVES * 64) ((LAS unsigned*)(lds + RING_BYTES))[u] = 0u;
    __syncthreads();
    const int lo = Pv.ph_lo, hi = Pv.ph_hi;
    unsigned* barw = (unsigned*)(Pv.ws + WS_CTL) + CW_BAR;
    XcdBarrier bar; bar.bar = barw; bar.x = 0; bar.st = nullptr;
    if (hi - lo > 1) bar = xcd_barrier_post(barw, (volatile LAS unsigned*)(lds + MISC_OFF) + 8, tid == 0);
    int ph = 0;
#ifndef SEL
#define SELP(k) true
#else
#define SELP(k) ((k) == SEL)
#endif
    enum { RUN_BASE = __COUNTER__ + 1 };
#define RUN(call) do { if (SELP(__COUNTER__ - RUN_BASE) && ph >= lo && ph < hi) { call; } if (ph >= lo && ph + 1 < hi) xcd_barrier(bar, wv == 0 && lane_id_fresh() == 0); ++ph; } while (0)
    RUN(ph_prologue(wv, lds));
    RUN(ph_modreduce(wv));
    RUN(ph_first(wv));
#define LAYER(LL) do { constexpr int L = (LL); constexpr int kind = L % 3, jj = L / 3; constexpr int Mrows = (L == NLAYER - 1) ? ML : MT; \
        constexpr bool ctx_dead = (L == NLAYER - 2) && ((NLAYER - 1) % 3 == 0) && (kind != 0); constexpr int Mlive = ctx_dead ? ML : Mrows; \
        if (kind == 0) {                          \
            RUN(ph_gemm(wv, lds, G_GM_IN, L, Mrows)); \
            RUN(ph_vstats(wv, Mrows)); \
            RUN(ph_spatial(wv, lds, jj, Mrows)); \
            RUN(ph_gemm(wv, lds, G_GM_OUT, L, Mrows)); \
        } else if (kind == 1) {                   \
            RUN(ph_gemm(wv, lds, G_MLA_IN, L, Mrows)); \
            RUN(ph_mla_norm(wv)); \
            RUN(ph_gemm(wv, lds, G_MLA_UQ, L, Mrows); ph_gemm(wv, lds, G_MLA_UKV, L, Mrows)); \
            if (ROPE_TEST == 2) { RUN(ph_rope(wv, 0)); } \
            RUN(ph_attn_mla(wv, lds)); \
            RUN(ph_gemm(wv, lds, G_MLA_OUT, L, Mrows)); \
        } else {                                  \
            RUN(ph_gemm(wv, lds, G_DA_IN, L, Mrows); if (ROPE_TEST == 1) { __syncthreads(); } ); \
            if (ROPE_TEST == 1) { RUN(ph_rope(wv, 1)); } \
            RUN(ph_attn_da(wv, lds, L, !ctx_dead)); \
            RUN(ph_gemm(wv, lds, G_DA_OUT, L, Mlive)); \
        } \
        RUN(ph_postmix(wv, L, Mlive));                \
        RUN(ph_gemm(wv, lds, G_PEER_Q, L, Mlive));    \
        RUN(ph_route(wv, lds, L, Mlive));             \
        RUN(ph_gather(wv, lds, L, Mlive));            \
    } while (0)
    LAYER(0); LAYER(1); LAYER(2); LAYER(3);
#undef LAYER
#undef RUN
}

extern "C" void kernel_launch(void* const* d_in, const int* in_sizes, int n_in, void* d_out, int out_size, void* d_ws, size_t ws_size, hipStream_t stream) {
    static int grid = 0;
    if (grid == 0) {
        if (n_in != 29 || in_sizes[0] != ML * DM || out_size != ML * DM || ws_size < WS_END) {
            fprintf(stderr, "kernel_launch: shape mismatch: n_in %d in0 %d out %d ws %zu (need %zu); nothing launched\n", n_in, n_in > 0 ? in_sizes[0] : -1, out_size, ws_size, (size_t)WS_END); grid = -1; return; }
        int dev = 0, cus = 0, per_cu = 0;
        if (hipGetDevice(&dev) != hipSuccess || hipDeviceGetAttribute(&cus, hipDeviceAttributeMultiprocessorCount, dev) != hipSuccess) { fprintf(stderr, "kernel_launch: device query failed\n"); grid = -1; return; }
        if (hipFuncSetAttribute((const void*)mk_fwd, hipFuncAttributeMaxDynamicSharedMemorySize, LDS_BYTES) != hipSuccess) { fprintf(stderr, "kernel_launch: hipFuncSetAttribute failed\n"); grid = -1; return; }
        if (hipOccupancyMaxActiveBlocksPerMultiprocessor(&per_cu, (const void*)mk_fwd, NWAVES * 64, LDS_BYTES) != hipSuccess || per_cu < 1)
            fprintf(stderr, "kernel_launch: note: occupancy query reports %d workgroups per CU\n", per_cu);
        (void)hipGetLastError();
        grid = cus;
    }
    if (grid < 0) return;
    if (hipMemsetAsync((char*)d_ws + WS_CTL, 0, CTL_ZERO_BYTES, stream) != hipSuccess) { fprintf(stderr, "kernel_launch: memset failed\n"); return; }
    Params p{};
    for (int i = 0; i < 29; ++i) p.in[i] = (const float*)d_in[i];
    p.out = (float*)d_out; p.ws = (unsigned char*)d_ws;
#if MK_ONE_LAUNCH
    p.ph_lo = 0; p.ph_hi = NPH;
    hipLaunchKernelGGL(mk_fwd, dim3(grid), dim3(NWAVES * 64), LDS_BYTES, stream, p);
#else
    for (int li = 0; li < NPH; ++li) { p.ph_lo = li; p.ph_hi = li + 1; hipLaunchKernelGGL(mk_fwd, dim3(grid), dim3(NWAVES * 64), LDS_BYTES, stream, p); }
#endif
    const hipError_t le = hipPeekAtLastError();
    if (le != hipSuccess) fprintf(stderr, "kernel_launch: launch failed: %s\n", hipGetErrorName(le));
}
```

```cpp
#include <hip/hip_runtime.h>
#include <cstdio>
#include <cstdint>
#ifndef MK_ONE_LAUNCH
#define MK_ONE_LAUNCH 1
#endif
__device__ __forceinline__ int launder_v(int v) { asm volatile("" : "+v"(v)); return v; }
__device__ __forceinline__ int lane_id_fresh() { unsigned m = ~0u; asm volatile("" : "+s"(m)); return (int)__builtin_amdgcn_mbcnt_hi(m, __builtin_amdgcn_mbcnt_lo(m, 0u)); }
namespace pg8 {
#define PG8_LAS __attribute__((address_space(3)))
typedef unsigned short bf16_t;
typedef short bf16x8 __attribute__((ext_vector_type(8)));
typedef float f32x4 __attribute__((ext_vector_type(4)));
typedef unsigned u32x4 __attribute__((ext_vector_type(4)));
constexpr int BM = 256, BK = 64, HALF = 128, HTB = HALF * BK * 2  , STAGE_BYTES = 8 * HTB, NXCD = 8, WGM = 8;

__host__ __device__ __forceinline__ int lds_byte(int r, int c) { const int st = (r >> 4) * 2 + (c >> 5), rr = r & 15, cc = c & 31, ob = rr * 64 + cc * 2; return st * 1024 + (ob ^ (((ob >> 9) & 1) << 5)); }
__host__ __device__ __forceinline__ void stage_rc(int b, int& R, int& C) { const int st = b / 1024, sb = b % 1024, swz = sb ^ (((sb >> 9) & 1) << 5); R = (st >> 1) * 16 + swz / 64; C = (st & 1) * 32 + (swz % 64) / 2; }
__host__ __device__ __forceinline__ int perm32(int rho) { const int n = rho >> 4, i = rho & 15; return 8 * (i >> 2) + 4 * n + (i & 3); }

struct Unit { int pm, pn; };
struct Gemm { const bf16_t* A; const bf16_t* Bt; int M, N, K; };

struct StaticOrder {
    int nM, nN, nwg, G, c;
    __host__ __device__ void init(int M, int N, int G_, int c_) { nM = M / BM; nN = N / BM; nwg = nM * nN; G = G_; c = c_; }
    __host__ __device__ bool next(int i, Unit& u) const {
        const long L = (long)i * G + c; if (L >= nwg) return false;
        int wgid = (int)L; { const int q = nwg / NXCD, r = nwg % NXCD, xcd = wgid % NXCD, off = wgid / NXCD; wgid = (xcd < r ? xcd * (q + 1) : r * (q + 1) + (xcd - r) * q) + off; }
        const int nig = WGM * nN, gid = wgid / nig, fm = gid * WGM, gsz = (nM - fm) < WGM ? (nM - fm) : WGM;
        u.pm = fm + ((wgid % nig) % gsz); u.pn = (wgid % nig) / gsz; return true;
    }
    __device__ __forceinline__ void a_ready(const Unit&) const {}
    __device__ __forceinline__ void done(const Unit&) const {}
};

__device__ __forceinline__ unsigned cvt_pk_bf16(float lo, float hi) { unsigned r; asm volatile("v_cvt_pk_bf16_f32 %0, %1, %2" : "=v"(r) : "v"(lo), "v"(hi)); return r; }
typedef float f32x2 __attribute__((ext_vector_type(2)));
__device__ __forceinline__ f32x2 gelu_pk(f32x2 v) {
    const f32x2 av = __builtin_elementwise_abs(v), d = av * 0.2316418882f + 1.0f;
    f32x2 t; t.x = __builtin_amdgcn_rcpf(d.x); t.y = __builtin_amdgcn_rcpf(d.y);
    f32x2 q = t * 0.5307027145f + (-0.7265760135f); q = q * t + 0.7107068705f; q = q * t + (-0.142248368f); q = q * t + 0.127414796f; q = q * t;
    const f32x2 s = (v * v) * (-0.72134752044f);
    f32x2 e; e.x = __builtin_amdgcn_exp2f(s.x); e.y = __builtin_amdgcn_exp2f(s.y);
    const f32x2 m = v * (q * e), r = v - m;
    f32x2 o; o.x = v.x < 0.f ? m.x : r.x; o.y = v.y < 0.f ? m.y : r.y; return o;
}

template <int ACT  > struct EpiBf16 {
    static constexpr bool PERM = true, AFTER_DRAIN = false; static_assert(ACT == 0 || ACT == 1, "EpiBf16: ACT is 0 (none) or 1 (gelu_pk)");
    bf16_t* O; int ldc; const float* bias; int split_cols; size_t split_stride; float scale0;
    __device__ __forceinline__ void operator()(const f32x4 (&acc)[2][2][4][2], const Unit& u, int wr, int wc, int fr, int fq) const {
        const int row0 = u.pm * BM + wr * 64 + fr; int colt = u.pn * BM; bf16_t* base = O;
        float sc = 1.f; if (split_cols) { const int t = colt / split_cols; base += (size_t)t * split_stride; colt -= t * split_cols; if (t == 0) sc = scale0; }
        const int col0 = colt + wc * 32 + 8 * fq, bcol0 = u.pn * BM + wc * 32 + 8 * fq;
        f32x4 bv[2][2];
#pragma unroll
        for (int bj = 0; bj < 2; ++bj)
#pragma unroll
            for (int n = 0; n < 2; ++n) bv[bj][n] = bias ? *(const f32x4*)(bias + bcol0 + bj * HALF + 4 * n) : (f32x4){0.f, 0.f, 0.f, 0.f};
#pragma unroll
        for (int ai = 0; ai < 2; ++ai)
#pragma unroll
            for (int m = 0; m < 4; ++m) { bf16_t* rowp = base + (size_t)(row0 + ai * HALF + m * 16) * ldc + col0;
#pragma unroll
                for (int bj = 0; bj < 2; ++bj) { f32x4 v0 = acc[ai][bj][m][0] + bv[bj][0], v1 = acc[ai][bj][m][1] + bv[bj][1];
                    if (ACT == 1) { f32x2 a = gelu_pk((f32x2){v0[0], v0[1]}), b = gelu_pk((f32x2){v0[2], v0[3]}), c = gelu_pk((f32x2){v1[0], v1[1]}), d = gelu_pk((f32x2){v1[2], v1[3]});
                        v0 = (f32x4){a.x, a.y, b.x, b.y}; v1 = (f32x4){c.x, c.y, d.x, d.y}; }
                    v0 = v0 * sc; v1 = v1 * sc; u32x4 w; w.x = cvt_pk_bf16(v0[0], v0[1]); w.y = cvt_pk_bf16(v0[2], v0[3]); w.z = cvt_pk_bf16(v1[0], v1[1]); w.w = cvt_pk_bf16(v1[2], v1[3]);
                    *(u32x4*)(rowp + bj * HALF) = w; } }
    }
};
template <class Epi, class Sched, bool ALIGN_EPI = false, bool SP2 = false>
__device__ __forceinline__ void gemm_phase(PG8_LAS unsigned char* lds, const Gemm g, const Sched& S, const Epi& E, const int tid_in) {
    const int tid = launder_v(tid_in) & 511, wid = __builtin_amdgcn_readfirstlane(tid >> 6), lane = tid & 63, wr = wid >> 2, wc = wid & 3, fr = lane & 15, fq = lane >> 4;
    const int K = g.K, nt = K / BK;
    unsigned voffA[2], voffB[2];
#pragma unroll
    for (int i = 0; i < 2; ++i) { int R, C; stage_rc(tid * 16 + i * 8192, R, C); const int Rb = Epi::PERM ? ((R & ~31) + perm32(R & 31)) : R;
        voffA[i] = (unsigned)(R * K + C) * 2u; voffB[i] = (unsigned)(Rb * K + C) * 2u; }
    const size_t kstep = (size_t)(BK * 2);
    const size_t hstep = (size_t)HALF * K * 2;
    const size_t tstep = 2 * hstep;
    const unsigned ldsw = (unsigned)wid * 1024u;
    const int aoff = lds_byte(wr * 64 + fr, fq * 8), boff = lds_byte(wc * 32 + fr, fq * 8);
#define PG8_SA(b, h) (((b) * 2 + (h)) * HTB)
#define PG8_SB(b, h) ((4 + (b) * 2 + (h)) * HTB)
#define PG8_STAGE(bufoff, gbase, voff) do { _Pragma("unroll") for (int _i = 0; _i < 2; ++_i) \
        __builtin_amdgcn_global_load_lds((const unsigned*)((const char*)(gbase) + (voff)[_i]), (PG8_LAS unsigned*)(lds + (bufoff) + ldsw + _i * 8192), 16, 0, 0); } while (0)
#define PG8_LDA(dst, b, h) do { _Pragma("unroll") for (int m = 0; m < 4; ++m) _Pragma("unroll") for (int k = 0; k < 2; ++k) dst[m][k] = *(const PG8_LAS bf16x8*)(lds + PG8_SA(b, h) + aoff + m * 2048 + k * 1024); } while (0)
#define PG8_LDB(dst, b, h) do { _Pragma("unroll") for (int n = 0; n < 2; ++n) _Pragma("unroll") for (int k = 0; k < 2; ++k) dst[n][k] = *(const PG8_LAS bf16x8*)(lds + PG8_SB(b, h) + boff + n * 2048 + k * 1024); } while (0)
#define PG8_MMA(ai, bj, At, Bt) do { __builtin_amdgcn_s_setprio(1); _Pragma("unroll") for (int m = 0; m < 4; ++m) _Pragma("unroll") for (int n = 0; n < 2; ++n) _Pragma("unroll") for (int k = 0; k < 2; ++k) \
        acc[ai][bj][m][n] = __builtin_amdgcn_mfma_f32_16x16x32_bf16(Bt[n][k], At[m][k], acc[ai][bj][m][n], 0, 0, 0); __builtin_amdgcn_s_setprio(0); } while (0)
#define PG8_WAIT_V(n) asm volatile("s_waitcnt vmcnt(" #n ")" ::: "memory")
#define PG8_WAIT_L(n) asm volatile("s_waitcnt lgkmcnt(" #n ")" ::: "memory")
#define PG8_BAR __builtin_amdgcn_s_barrier()
#define PG8_SCHED __builtin_amdgcn_sched_barrier(0)
    Unit cur, nxt; int ui = 0;
    if (!S.next(0, cur)) return;
    f32x4 acc[2][2][4][2];
#pragma unroll
    for (int a = 0; a < 2; ++a)
#pragma unroll
        for (int b = 0; b < 2; ++b)
#pragma unroll
            for (int m = 0; m < 4; ++m)
#pragma unroll
                for (int n = 0; n < 2; ++n) acc[a][b][m][n] = (f32x4){0.f, 0.f, 0.f, 0.f};
    bf16x8 At[4][2], B0[2][2], B1[2][2];
    const char* cA = (const char*)g.A + (size_t)cur.pm * tstep; const char* cB = (const char*)g.Bt + (size_t)cur.pn * tstep;
    S.a_ready(cur);
    if constexpr (SP2) {
        PG8_STAGE(PG8_SB(0, 0), cB, voffB); PG8_STAGE(PG8_SB(0, 1), cB + hstep, voffB); PG8_STAGE(PG8_SA(0, 0), cA, voffA); PG8_STAGE(PG8_SA(0, 1), cA + hstep, voffA);
        if (wr == 1) PG8_BAR;
        PG8_WAIT_V(2); PG8_BAR;
        PG8_STAGE(PG8_SB(1, 0), cB + kstep, voffB); PG8_STAGE(PG8_SA(1, 0), cA + kstep, voffA); PG8_STAGE(PG8_SB(1, 1), cB + hstep + kstep, voffB);
        PG8_WAIT_V(6); PG8_BAR;
    } else {
        PG8_STAGE(PG8_SB(0, 0), cB, voffB); PG8_STAGE(PG8_SA(0, 0), cA, voffA); PG8_STAGE(PG8_SB(0, 1), cB + hstep, voffB); PG8_STAGE(PG8_SA(0, 1), cA + hstep, voffA);
        if (wr == 1) PG8_BAR;
        PG8_WAIT_V(4); PG8_BAR;
        PG8_STAGE(PG8_SB(1, 0), cB + kstep, voffB); PG8_STAGE(PG8_SA(1, 0), cA + kstep, voffA); PG8_STAGE(PG8_SB(1, 1), cB + hstep + kstep, voffB);
        PG8_WAIT_V(6); PG8_BAR;
    }
    for (;;) {
        const bool has_next = S.next(ui + 1, nxt);
        const char* nA = has_next ? (const char*)g.A + (size_t)nxt.pm * tstep : cA; const char* nB = has_next ? (const char*)g.Bt + (size_t)nxt.pn * tstep : cB;
        for (int t = 0; t < nt; t += 2) {
            const bool last = (t == nt - 2);
            const char* a1 = cA + (size_t)(t + 1) * kstep;
            const char* a2 = last ? nA : cA + (size_t)(t + 2) * kstep; const char* b2 = last ? nB : cB + (size_t)(t + 2) * kstep;
            const char* a3 = a2 + kstep; const char* b3 = b2 + kstep;
            if (last && has_next) S.a_ready(nxt);
            if constexpr (SP2) {
            PG8_LDB(B0, 0, 0); PG8_LDB(B1, 0, 1); PG8_SCHED; PG8_LDA(At, 0, 0); PG8_STAGE(PG8_SA(1, 1), a1 + hstep, voffA);
            PG8_WAIT_V(8); PG8_WAIT_L(0); PG8_BAR; PG8_MMA(0, 0, At, B0); PG8_MMA(0, 1, At, B1); PG8_BAR; PG8_SCHED;
            PG8_LDA(At, 0, 1); PG8_STAGE(PG8_SB(0, 0), b2, voffB); PG8_STAGE(PG8_SB(0, 1), b2 + hstep, voffB); PG8_STAGE(PG8_SA(0, 0), a2, voffA);
            PG8_WAIT_V(8); PG8_WAIT_L(0); PG8_BAR; PG8_MMA(1, 0, At, B0); PG8_MMA(1, 1, At, B1); PG8_BAR; PG8_SCHED;
            PG8_LDB(B0, 1, 0); PG8_LDB(B1, 1, 1); PG8_SCHED; PG8_LDA(At, 1, 0); PG8_STAGE(PG8_SA(0, 1), a2 + hstep, voffA);
            PG8_WAIT_V(8); PG8_WAIT_L(0); PG8_BAR; PG8_MMA(0, 0, At, B0); PG8_MMA(0, 1, At, B1); PG8_BAR; PG8_SCHED;
            PG8_LDA(At, 1, 1); PG8_STAGE(PG8_SB(1, 0), b3, voffB); PG8_STAGE(PG8_SB(1, 1), b3 + hstep, voffB); PG8_STAGE(PG8_SA(1, 0), a3, voffA);
            PG8_WAIT_V(8); PG8_WAIT_L(0); PG8_BAR; PG8_MMA(1, 0, At, B0); PG8_MMA(1, 1, At, B1); PG8_BAR; PG8_SCHED;
            } else {
            PG8_LDB(B0, 0, 0); PG8_SCHED; PG8_LDA(At, 0, 0); PG8_STAGE(PG8_SA(1, 1), a1 + hstep, voffA);
            PG8_WAIT_L(8); PG8_BAR; PG8_WAIT_L(0); PG8_MMA(0, 0, At, B0); PG8_BAR; PG8_SCHED;
            PG8_LDB(B1, 0, 1); PG8_STAGE(PG8_SB(0, 0), b2, voffB);
            PG8_BAR; PG8_WAIT_L(0); PG8_MMA(0, 1, At, B1); PG8_BAR;
            PG8_LDA(At, 0, 1); PG8_STAGE(PG8_SA(0, 0), a2, voffA);
            PG8_BAR; PG8_WAIT_L(0); PG8_MMA(1, 0, At, B0); PG8_BAR; PG8_SCHED;
            PG8_STAGE(PG8_SB(0, 1), b2 + hstep, voffB);
            PG8_WAIT_V(6); PG8_BAR; PG8_MMA(1, 1, At, B1); PG8_BAR;
            PG8_LDB(B0, 1, 0); PG8_SCHED; PG8_LDA(At, 1, 0); PG8_STAGE(PG8_SA(0, 1), a2 + hstep, voffA);
            PG8_WAIT_L(8); PG8_BAR; PG8_WAIT_L(0); PG8_MMA(0, 0, At, B0); PG8_BAR; PG8_SCHED;
            PG8_LDB(B1, 1, 1); PG8_STAGE(PG8_SB(1, 0), b3, voffB);
            PG8_BAR; PG8_WAIT_L(0); PG8_MMA(0, 1, At, B1); PG8_BAR;
            PG8_LDA(At, 1, 1); PG8_STAGE(PG8_SA(1, 0), a3, voffA);
            PG8_BAR; PG8_WAIT_L(0); PG8_MMA(1, 0, At, B0); PG8_BAR; PG8_SCHED;
            PG8_STAGE(PG8_SB(1, 1), b3 + hstep, voffB);
            PG8_WAIT_V(6); PG8_BAR; PG8_MMA(1, 1, At, B1); PG8_BAR;
            }
        }
        if constexpr (ALIGN_EPI) { if (wr == 0) PG8_BAR; }
        if constexpr (!Epi::AFTER_DRAIN) { E(acc, cur, wr, wc, fr, fq); S.done(cur); }
        if (!has_next) break;
#pragma unroll
        for (int a = 0; a < 2; ++a)
#pragma unroll
            for (int b = 0; b < 2; ++b)
#pragma unroll
                for (int m = 0; m < 4; ++m)
#pragma unroll
                    for (int n = 0; n < 2; ++n) acc[a][b][m][n] = (f32x4){0.f, 0.f, 0.f, 0.f};
        cur = nxt; cA = nA; cB = nB; ++ui;
        if constexpr (ALIGN_EPI) { if (wr == 1) PG8_BAR; }
    }
    PG8_WAIT_V(0);
    if constexpr (!ALIGN_EPI) { if (wr == 0) PG8_BAR; }
    PG8_BAR;
    if constexpr (Epi::AFTER_DRAIN) { E.fused(acc, cur, wr, wc, fr, fq, lds, wid, lane); S.done(cur); }
#undef PG8_SA
#undef PG8_SB
#undef PG8_STAGE
#undef PG8_LDA
#undef PG8_LDB
#undef PG8_MMA
#undef PG8_WAIT_V
#undef PG8_WAIT_L
#undef PG8_BAR
#undef PG8_SCHED
}
}

namespace pg8 {
__device__ __forceinline__ float gelu_tanh(float x) {
    const float t = x * (1.5957691216057308f + 0.07135481627f * x * x);
    const float e = __builtin_amdgcn_exp2f(-1.4426950408889634f * t);
    return x * __builtin_amdgcn_rcpf(1.0f + e);
}
template <int ACT> struct EpiT {
    static constexpr bool PERM = true, AFTER_DRAIN = false;
    bf16_t* O; int ldc;
    __device__ __forceinline__ void operator()(const f32x4 (&acc)[2][2][4][2], const Unit& u, int wr, int wc, int fr, int fq) const {
        const int row0 = u.pm * BM + wr * 64 + fr; const int col0 = u.pn * BM + wc * 32 + 8 * fq;
#pragma unroll
        for (int ai = 0; ai < 2; ++ai)
#pragma unroll
            for (int m = 0; m < 4; ++m) { bf16_t* rowp = O + (size_t)(row0 + ai * HALF + m * 16) * ldc + col0;
#pragma unroll
                for (int bj = 0; bj < 2; ++bj) { f32x4 v0 = acc[ai][bj][m][0], v1 = acc[ai][bj][m][1];
                    if (ACT == 2) { v0 = (f32x4){gelu_tanh(v0[0]), gelu_tanh(v0[1]), gelu_tanh(v0[2]), gelu_tanh(v0[3])}; v1 = (f32x4){gelu_tanh(v1[0]), gelu_tanh(v1[1]), gelu_tanh(v1[2]), gelu_tanh(v1[3])}; }
                    u32x4 w; w.x = cvt_pk_bf16(v0[0], v0[1]); w.y = cvt_pk_bf16(v0[2], v0[3]); w.z = cvt_pk_bf16(v1[0], v1[1]); w.w = cvt_pk_bf16(v1[2], v1[3]);
                    *(u32x4*)(rowp + bj * HALF) = w; } }
    }
};
struct EpiR {
    static constexpr bool PERM = true, AFTER_DRAIN = false;
    bf16_t* O; int ldc; int act; int rope; const float* ropet;
    __device__ __forceinline__ void operator()(const f32x4 (&acc)[2][2][4][2], const Unit& u, int wr, int wc, int fr, int fq) const {
        const int row0 = u.pm * BM + wr * 64 + fr; const int col0 = u.pn * BM + wc * 32 + 8 * fq;
        const bool rrows = rope != 0 && u.pm < 64;
#pragma unroll
        for (int ai = 0; ai < 2; ++ai)
#pragma unroll
            for (int m = 0; m < 4; ++m) { const int grow = row0 + ai * HALF + m * 16; bf16_t* rowp = O + (size_t)grow * ldc + col0;
#pragma unroll
                for (int bj = 0; bj < 2; ++bj) { f32x4 v0 = acc[ai][bj][m][0], v1 = acc[ai][bj][m][1];
                    if (act) { v0 = (f32x4){gelu_tanh(v0[0]), gelu_tanh(v0[1]), gelu_tanh(v0[2]), gelu_tanh(v0[3])}; v1 = (f32x4){gelu_tanh(v1[0]), gelu_tanh(v1[1]), gelu_tanh(v1[2]), gelu_tanh(v1[3])}; }
                    if (rrows) { const int blk = u.pn * 8 + bj * 4 + wc; const int b6 = blk % 6; const bool on = rope == 1 ? (blk < 128) : (b6 >= 4); const int half = rope == 1 ? (blk & 1) : (b6 - 4);
                        if (on) { const int t = grow & 8191; const int pos = half ? (t & 63) : (t >> 6);
                            const float* cp = ropet + pos * 16 + 8 * (fq & 1); const f32x4 c0 = *(const f32x4*)cp, c1 = *(const f32x4*)(cp + 4), s0 = *(const f32x4*)(cp + 2048), s1 = *(const f32x4*)(cp + 2052);
                            f32x4 p0, p1;
#pragma unroll
                            for (int i = 0; i < 4; ++i) { const float a_ = v0[i], b_ = v1[i];
                                const auto r0 = __builtin_amdgcn_permlane32_swap(__float_as_uint(a_), __float_as_uint(a_), false, false);
                                const auto r1 = __builtin_amdgcn_permlane32_swap(__float_as_uint(b_), __float_as_uint(b_), false, false);
                                const unsigned x0_ = (fq & 2) ? r0[0] : r0[1], x1_ = (fq & 2) ? r1[0] : r1[1]; p0[i] = __uint_as_float(x0_); p1[i] = __uint_as_float(x1_); }
                            if (fq & 2) { v0 = p0 * s0 + v0 * c0; v1 = p1 * s1 + v1 * c1; } else { v0 = v0 * c0 - p0 * s0; v1 = v1 * c1 - p1 * s1; } } }
                    u32x4 w; w.x = cvt_pk_bf16(v0[0], v0[1]); w.y = cvt_pk_bf16(v0[2], v0[3]); w.z = cvt_pk_bf16(v1[0], v1[1]); w.w = cvt_pk_bf16(v1[2], v1[3]);
                    *(u32x4*)(rowp + bj * HALF) = w; } }
    }
};
}

constexpr int DM = 2048, NBATCH = 2, SEQ = 8192, CTXL = 256;
constexpr int ML = NBATCH * SEQ;
constexpr int MC = NBATCH * CTXL;
constexpr int MT = ML + MC;
constexpr int NLAYER = 4;
constexpr float ALPHA = 1.6817928305074290f, LN_EPS = 1e-6f;
constexpr int NWAVES = 8;
constexpr float U_SCALE = 64.0f, V_SCALE = 4.0f;
constexpr int PROW = 1536;
constexpr int PREC = 2 * PROW;
constexpr int NPH = 35;

constexpr size_t MiB = 1ull << 20;
constexpr size_t WS_CTL = 0, CTL_ZERO_BYTES = 1 * MiB;
constexpr int    CW_BAR = 4096;
constexpr size_t WS_MOD = 128 * 1024;
constexpr size_t WS_VST = 1 * MiB;
constexpr size_t WS_ROPE = 1 * MiB + 160 * 1024;
constexpr size_t WS_MODP = 1 * MiB + 256 * 1024;
constexpr size_t WS_GMWIN = 6 * MiB;
constexpr size_t WS_GMWOUT = WS_GMWIN + 32 * MiB;
constexpr size_t WS_GMWS = WS_GMWOUT + 16 * MiB;
constexpr size_t WS_PWQ = WS_GMWS + 1 * MiB;
constexpr size_t WS_PK1 = WS_PWQ + 32 * MiB;
constexpr size_t WS_PK2 = WS_PK1 + 512 * 1024;
constexpr size_t WS_MLAIN = WS_PK1 + 1 * MiB;
constexpr size_t WS_MLAUQ = WS_MLAIN + 5 * MiB;
constexpr size_t WS_MLAUKV = WS_MLAUQ + 3 * MiB;
constexpr size_t WS_MLAOUT = WS_MLAUKV + 4 * MiB;
constexpr size_t WS_DAIN = WS_MLAOUT + 8 * MiB;
constexpr size_t WS_DAOUT = WS_DAIN + 24 * MiB;
constexpr size_t WS_PU = WS_DAOUT + 8 * MiB;
constexpr size_t WS_PV = WS_PU + 96 * MiB;
constexpr size_t WS_X = WS_PV + 96 * MiB;
constexpr size_t WS_H = WS_X + 66 * MiB;
constexpr size_t WS_G = WS_H + 66 * MiB;
constexpr size_t WS_Y = WS_G + 66 * MiB;
constexpr size_t WS_QP = WS_Y + 66 * MiB;
constexpr size_t WS_Z = WS_QP + 66 * MiB;
constexpr size_t WS_C = WS_Z + 198 * MiB;
constexpr size_t WS_CQN = WS_C + 42 * MiB;
constexpr size_t WS_CKVN = WS_CQN + 17 * MiB;
constexpr size_t WS_KR = WS_CKVN + 17 * MiB;
constexpr size_t WS_QM = WS_KR + 3 * MiB;
constexpr size_t WS_KV = WS_QM + 99 * MiB;
constexpr size_t WS_ROUTE = WS_KV + 132 * MiB;
constexpr size_t WS_END = WS_ROUTE + 17 * MiB;
static_assert((size_t)MT * DM * 2 == 66 * MiB, "row buffer size");

constexpr int RING_BYTES = 155648, MISC_OFF = RING_BYTES + 320, LDS_BYTES = 159744;

#define GAS __attribute__((address_space(1)))
#define LAS __attribute__((address_space(3)))
typedef unsigned short bf16;
typedef unsigned u32x4 __attribute__((ext_vector_type(4)));
typedef unsigned u32x2 __attribute__((ext_vector_type(2)));
typedef float f32x4 __attribute__((ext_vector_type(4)));
typedef float f32x16 __attribute__((ext_vector_type(16)));
typedef short bf16x8 __attribute__((ext_vector_type(8)));
typedef short s16x4 __attribute__((ext_vector_type(4)));
#define LDS_WAIT() asm volatile("s_waitcnt lgkmcnt(0)" ::: "memory")

__device__ __forceinline__ unsigned cvtpk(float lo, float hi) { unsigned r; asm("v_cvt_pk_bf16_f32 %0, %1, %2" : "=v"(r) : "v"(lo), "v"(hi)); return r; }
__device__ __forceinline__ float bflo(unsigned w) { return __uint_as_float(w << 16); }
__device__ __forceinline__ float bfhi(unsigned w) { return __uint_as_float(w & 0xffff0000u); }
__device__ __forceinline__ float bf1(bf16 b) { return __uint_as_float((unsigned)b << 16); }
__device__ __forceinline__ bf16 tobf1(float f) { return (bf16)(cvtpk(f, 0.f) & 0xffffu); }
#define DPP_F(v, ctrl) __int_as_float(__builtin_amdgcn_mov_dpp(__float_as_int(v), (ctrl), 0xF, 0xF, true))
__device__ __forceinline__ float row_sum16(float v) { v += DPP_F(v, 0xB1); v += DPP_F(v, 0x4E); v += DPP_F(v, 0x141); v += DPP_F(v, 0x140); return v; }
__device__ __forceinline__ float sum_xor16(float v) { const auto r = __builtin_amdgcn_permlane16_swap(__float_as_uint(v), __float_as_uint(v), false, false); return __uint_as_float(r[0]) + __uint_as_float(r[1]); }
__device__ __forceinline__ float sum_xor32(float v) { const auto r = __builtin_amdgcn_permlane32_swap(__float_as_uint(v), __float_as_uint(v), false, false); return __uint_as_float(r[0]) + __uint_as_float(r[1]); }
__device__ __forceinline__ float wave_sum(float v) { return sum_xor32(sum_xor16(row_sum16(v))); }
__device__ __forceinline__ float half_sum32(float v) { return sum_xor16(row_sum16(v)); }
__device__ __forceinline__ float lane_xor16(float v, int lane) { const auto r = __builtin_amdgcn_permlane16_swap(__float_as_uint(v), __float_as_uint(v), false, false); return __uint_as_float((lane & 16) ? r[0] : r[1]); }
__device__ __forceinline__ unsigned lane_xor32(unsigned v, int lane) { const auto r = __builtin_amdgcn_permlane32_swap(v, v, false, false); return (lane & 32) ? r[0] : r[1]; }
__device__ __forceinline__ float gelu_tanh(float x) { return pg8::gelu_tanh(x); }

__device__ __forceinline__ void load_row_bf16(const bf16* row, int lane, float (&v)[32]) {
#pragma unroll
    for (int j = 0; j < 4; ++j) { const u32x4 w = ((const u32x4*)row)[64 * j + lane];
        v[8 * j + 0] = bflo(w.x); v[8 * j + 1] = bfhi(w.x); v[8 * j + 2] = bflo(w.y); v[8 * j + 3] = bfhi(w.y);
        v[8 * j + 4] = bflo(w.z); v[8 * j + 5] = bfhi(w.z); v[8 * j + 6] = bflo(w.w); v[8 * j + 7] = bfhi(w.w); }
}
__device__ __forceinline__ void store_row_bf16(bf16* row, int lane, const float (&v)[32]) {
#pragma unroll
    for (int j = 0; j < 4; ++j) { u32x4 w; w.x = cvtpk(v[8 * j + 0], v[8 * j + 1]); w.y = cvtpk(v[8 * j + 2], v[8 * j + 3]); w.z = cvtpk(v[8 * j + 4], v[8 * j + 5]); w.w = cvtpk(v[8 * j + 6], v[8 * j + 7]);
        ((u32x4*)row)[64 * j + lane] = w; }
}
__device__ __forceinline__ void load_row_f32(const float* row, int lane, float (&v)[32]) {
#pragma unroll
    for (int j = 0; j < 4; ++j) { const f32x4 a = ((const f32x4*)row)[128 * j + 2 * lane], b = ((const f32x4*)row)[128 * j + 2 * lane + 1];
        v[8 * j + 0] = a.x; v[8 * j + 1] = a.y; v[8 * j + 2] = a.z; v[8 * j + 3] = a.w; v[8 * j + 4] = b.x; v[8 * j + 5] = b.y; v[8 * j + 6] = b.z; v[8 * j + 7] = b.w; }
}
__device__ __forceinline__ void store_row_f32(float* row, int lane, const float (&v)[32]) {
#pragma unroll
    for (int j = 0; j < 4; ++j) { ((f32x4*)row)[128 * j + 2 * lane] = (f32x4){v[8 * j + 0], v[8 * j + 1], v[8 * j + 2], v[8 * j + 3]};
        ((f32x4*)row)[128 * j + 2 * lane + 1] = (f32x4){v[8 * j + 4], v[8 * j + 5], v[8 * j + 6], v[8 * j + 7]}; }
}
__device__ __forceinline__ void load_row_bf16_b(const bf16* row, int lane, float (&v)[32]) {
#pragma unroll
    for (int j = 0; j < 4; ++j) { const u32x4 w = ((const u32x4*)row)[4 * lane + j];
        v[8 * j + 0] = bflo(w.x); v[8 * j + 1] = bfhi(w.x); v[8 * j + 2] = bflo(w.y); v[8 * j + 3] = bfhi(w.y);
        v[8 * j + 4] = bflo(w.z); v[8 * j + 5] = bfhi(w.z); v[8 * j + 6] = bflo(w.w); v[8 * j + 7] = bfhi(w.w); }
}
__device__ __forceinline__ void store_row_bf16_b(bf16* row, int lane, const float (&v)[32]) {
#pragma unroll
    for (int j = 0; j < 4; ++j) { u32x4 w; w.x = cvtpk(v[8 * j + 0], v[8 * j + 1]); w.y = cvtpk(v[8 * j + 2], v[8 * j + 3]); w.z = cvtpk(v[8 * j + 4], v[8 * j + 5]); w.w = cvtpk(v[8 * j + 6], v[8 * j + 7]);
        ((u32x4*)row)[4 * lane + j] = w; }
}
__device__ __forceinline__ void load_row_f32_b(const float* row, int lane, float (&v)[32]) {
#pragma unroll
    for (int q = 0; q < 8; ++q) { const f32x4 a = ((const f32x4*)row)[8 * lane + q];
        v[4 * q + 0] = a.x; v[4 * q + 1] = a.y; v[4 * q + 2] = a.z; v[4 * q + 3] = a.w; }
}
__device__ __forceinline__ void store_row_f32_b(float* row, int lane, const float (&v)[32]) {
#pragma unroll
    for (int q = 0; q < 8; ++q) ((f32x4*)row)[8 * lane + q] = (f32x4){v[4 * q + 0], v[4 * q + 1], v[4 * q + 2], v[4 * q + 3]};
}
__device__ __forceinline__ void ln_stats(const float (&v)[32], float& mean, float& rstd) {
    float s = 0.f;
#pragma unroll
    for (int i = 0; i < 32; ++i) s += v[i];
    mean = wave_sum(s) * (1.0f / DM);
    float q = 0.f;
#pragma unroll
    for (int i = 0; i < 32; ++i) { const float d = v[i] - mean; q += d * d; }
    rstd = 1.0f / sqrtf(wave_sum(q) * (1.0f / DM) + LN_EPS);
}
template <bool LAYB>
__device__ __forceinline__ void finish_row(float (&z)[32], const float* lng, const float* lnb, bf16* Xrow, const float* sh, const float* sc, bf16* Hrow, float* Orow, int lane) {
    float mean, rstd; ln_stats(z, mean, rstd);
    { float g[32], b[32]; if (LAYB) { load_row_f32_b(lng, lane, g); load_row_f32_b(lnb, lane, b); } else { load_row_f32(lng, lane, g); load_row_f32(lnb, lane, b); }
#pragma unroll
      for (int i = 0; i < 32; ++i) z[i] = (z[i] - mean) * rstd * g[i] + b[i]; }
    if (Xrow) { if (LAYB) store_row_bf16_b(Xrow, lane, z); else store_row_bf16(Xrow, lane, z); }
    if (Orow) { if (LAYB) store_row_f32_b(Orow, lane, z); else store_row_f32(Orow, lane, z); }
    if (Hrow) {
        ln_stats(z, mean, rstd);
        float a[32], s[32]; if (LAYB) { load_row_f32_b(sc, lane, a); load_row_f32_b(sh, lane, s); } else { load_row_f32(sc, lane, a); load_row_f32(sh, lane, s); }
#pragma unroll
        for (int i = 0; i < 32; ++i) a[i] = (z[i] - mean) * rstd * (1.0f + a[i]) + s[i];
        if (LAYB) store_row_bf16_b(Hrow, lane, a); else store_row_bf16(Hrow, lane, a);
    }
}
__device__ __forceinline__ int row_slot(int row) { return row < ML ? (row >> 13) : 2; }

__device__ __forceinline__ unsigned f2bf_rne(float f) { unsigned u = __float_as_uint(f); return (u + 0x7fffu + ((u >> 16) & 1u)) >> 16; }
__device__ __forceinline__ unsigned pk2(float lo, float hi) { return f2bf_rne(lo) | (f2bf_rne(hi) << 16); }
__device__ __forceinline__ void p0_transpose_item(const float* W, int K, int N, bf16* WT, LAS float* scr, int item, int lane) {
    const int nblk = N / 32, kb = item / nblk, nb = item % nblk, k0 = 64 * kb, n0 = 32 * nb;
    f32x4 t[8];
#pragma unroll
    for (int i = 0; i < 8; ++i) t[i] = *(const f32x4*)(W + (size_t)(k0 + 8 * i + (lane >> 3)) * N + n0 + 4 * (lane & 7));
#pragma unroll
    for (int i = 0; i < 8; ++i) { LAS float* d = scr + (8 * i + (lane >> 3)) * 33 + 4 * (lane & 7); d[0] = t[i].x; d[1] = t[i].y; d[2] = t[i].z; d[3] = t[i].w; }
    LDS_WAIT(); asm volatile("" ::: "memory");
    const int c = lane & 7;
#pragma unroll
    for (int j = 0; j < 4; ++j) { const int n = (lane >> 3) + 8 * j; const LAS float* s = scr + (8 * c) * 33 + n;
        u32x4 o; o.x = pk2(s[0 * 33], s[1 * 33]); o.y = pk2(s[2 * 33], s[3 * 33]); o.z = pk2(s[4 * 33], s[5 * 33]); o.w = pk2(s[6 * 33], s[7 * 33]);
        *(u32x4*)(WT + (size_t)(n0 + n) * K + k0 + 8 * c) = o; }
    LDS_WAIT(); asm volatile("" ::: "memory");
}
__device__ __forceinline__ void cvt_range(const float* src, bf16* dst, size_t n8, size_t gtid, size_t gthreads) {
#pragma unroll 4
    for (size_t i = gtid; i < n8; i += gthreads) { const f32x4 a = ((const f32x4*)src)[2 * i], b = ((const f32x4*)src)[2 * i + 1];
        u32x4 w; w.x = cvtpk(a.x, a.y); w.y = cvtpk(a.z, a.w); w.z = cvtpk(b.x, b.y); w.w = cvtpk(b.z, b.w); ((u32x4*)dst)[i] = w; }
}
__device__ __forceinline__ unsigned enc_e2m3(float x) {
    const unsigned sgn = (__float_as_uint(x) >> 26) & 32u;
    const float ax = fminf(fabsf(x), 7.5f);
    unsigned u = __float_as_uint(ax); u += 0x7FFFFu + ((u >> 20) & 1u);
    const unsigned cn = (u >> 20) - ((127u - 1u) << 3);
    const unsigned cs = (unsigned)__builtin_rintf(ax * 8.0f);
    return sgn | (ax < 1.0f ? cs : cn);
}
#ifndef CVT_PIPE
#define CVT_PIPE 0
#endif
typedef float f32x16v __attribute__((ext_vector_type(16)));
typedef float f32x32v __attribute__((ext_vector_type(32)));
typedef unsigned u32x6v __attribute__((ext_vector_type(6)));
__device__ __forceinline__ u32x6v pack_fp6_32(const float (&e)[32], bool interleaved) {
    f32x16v s0, s1;
    if (interleaved) {
#pragma unroll
        for (int i = 0; i < 16; ++i) { s0[i] = e[2 * i]; s1[i] = e[2 * i + 1]; }
    } else {
#pragma unroll
        for (int i = 0; i < 16; ++i) { s0[i] = e[i]; s1[i] = e[16 + i]; }
    }
    return __builtin_amdgcn_cvt_scalef32_2xpk16_fp6_f32(s0, s1, 1.0f);
}
__device__ __forceinline__ void cvt_table_fp6(const float* src, unsigned char* dst, int nrows, float scale, LAS float* scr  , int lane, int gw, int NGW, const int isv) {
    bool interleaved;
    {
        float t[32];
#pragma unroll
        for (int k = 0; k < 32; ++k) t[k] = k < 16 ? 0.125f * k : (k < 24 ? 2.0f + 0.25f * (k - 16) : 4.0f + 0.5f * (k - 24));
        float tt[32];
#pragma unroll
        for (int k = 0; k < 32; ++k) { tt[k] = t[k]; asm volatile("" : "+v"(tt[k])); }
        const u32x6v p = pack_fp6_32(tt, true);
        const f32x32v o = __builtin_amdgcn_cvt_scalef32_pk32_f32_fp6(p, 1.0f);
        interleaved = (o[1] == t[1]) && (o[2] == t[2]) && (o[17] == t[17]);
        interleaved = __all(interleaved);
    }
#if CVT_PIPE
    f32x4 nx[8];
    if (gw < nrows) { const f32x4* s4 = (const f32x4*)(src + (size_t)gw * 2048);
#pragma unroll
        for (int q = 0; q < 8; ++q) nx[q] = s4[64 * q + lane]; }
    for (int row = gw; row < nrows; row += NGW) {
        f32x4 cur[8];
#pragma unroll
        for (int q = 0; q < 8; ++q) cur[q] = nx[q];
        if (row + NGW < nrows) { const f32x4* s4 = (const f32x4*)(src + (size_t)(row + NGW) * 2048);
#pragma unroll
            for (int q = 0; q < 8; ++q) nx[q] = s4[64 * q + lane]; }
#pragma unroll
        for (int q = 0; q < 8; ++q) { const int s = 64 * q + lane; const f32x4 a = cur[q] * scale; *(LAS f32x4*)(scr + 4 * (s ^ ((s >> 4) & 7))) = a; }
#else
    for (int row = gw; row < nrows; row += NGW) {
        const f32x4* s4 = (const f32x4*)(src + (size_t)row * 2048);
#pragma unroll
        for (int q = 0; q < 8; ++q) { const int s = 64 * q + lane; const f32x4 a = s4[s] * scale; *(LAS f32x4*)(scr + 4 * (s ^ ((s >> 4) & 7))) = a; }
#endif
        float e[32];
#pragma unroll
        for (int j = 0; j < 8; ++j) { const int s = 8 * lane + j; const f32x4 a = *(const LAS f32x4*)(scr + 4 * (s ^ ((s >> 4) & 7)));
            e[4 * j + 0] = __builtin_amdgcn_fmed3f(a.x, -7.5f, 7.5f); e[4 * j + 1] = __builtin_amdgcn_fmed3f(a.y, -7.5f, 7.5f); e[4 * j + 2] = __builtin_amdgcn_fmed3f(a.z, -7.5f, 7.5f); e[4 * j + 3] = __builtin_amdgcn_fmed3f(a.w, -7.5f, 7.5f); }
        const u32x6v p = pack_fp6_32(e, interleaved);
        unsigned char* rowp = dst + (size_t)row * PREC;
        *(u32x4*)(rowp + 1024 * isv + 16 * lane) = (u32x4){p[0], p[1], p[2], p[3]}; *(u32x2*)(rowp + 2048 + 512 * isv + 8 * lane) = (u32x2){p[4], p[5]};
    }
}
__device__ __forceinline__ float silu(float x) { return x / (1.0f + __expf(-x)); }

struct Params { const float* in[29]; float* out; unsigned char* ws; int ph_lo, ph_hi; };
typedef const __attribute__((address_space(4))) Params* CP;

#ifndef TAIL_REMAP
#define TAIL_REMAP 0
#endif
__device__ __forceinline__ void p0_prologue(CP P, LAS unsigned char* lds, int tid, int lane, int wid, int gw, int NGW, const int parts = 7) {
    unsigned char* ws = P->ws;
    LAS float* scr = (LAS float*)(lds + wid * 16384);
    if (parts & 1) {
        constexpr int I_GMIN = (2048 / 64) * (4096 / 32), I_SQ = (2048 / 64) * (2048 / 32), I_MIN = (2048 / 64) * (1088 / 32), I_UQ = (512 / 64) * (3072 / 32), I_UKV = (512 / 64) * (4096 / 32), I_DIN = (2048 / 64) * (6144 / 32);
        constexpr int NIT = 2 * I_GMIN + 2 * I_SQ + 4 * I_SQ + I_MIN + I_UQ + I_UKV + I_SQ + I_DIN + I_SQ;
        for (int it = gw; it < NIT; it += NGW) {
            int r = it;
            if (r < 2 * I_GMIN) { const int j = r / I_GMIN; p0_transpose_item(P->in[13] + (size_t)j * 2048 * 4096, 2048, 4096, (bf16*)(ws + WS_GMWIN) + (size_t)j * 4096 * 2048, scr, r % I_GMIN, lane); continue; } r -= 2 * I_GMIN;
            if (r < 2 * I_SQ) { const int j = r / I_SQ; p0_transpose_item(P->in[18] + (size_t)j * 2048 * 2048, 2048, 2048, (bf16*)(ws + WS_GMWOUT) + (size_t)j * 2048 * 2048, scr, r % I_SQ, lane); continue; } r -= 2 * I_SQ;
            if (r < 4 * I_SQ) { const int j = r / I_SQ; p0_transpose_item(P->in[8] + (size_t)j * 2048 * 2048, 2048, 2048, (bf16*)(ws + WS_PWQ) + (size_t)j * 2048 * 2048, scr, r % I_SQ, lane); continue; } r -= 4 * I_SQ;
            if (r < I_MIN) { p0_transpose_item(P->in[19], 2048, 1088, (bf16*)(ws + WS_MLAIN), scr, r, lane); continue; } r -= I_MIN;
            if (r < I_UQ) { p0_transpose_item(P->in[22], 512, 3072, (bf16*)(ws + WS_MLAUQ), scr, r, lane); continue; } r -= I_UQ;
            if (r < I_UKV) { p0_transpose_item(P->in[23], 512, 4096, (bf16*)(ws + WS_MLAUKV), scr, r, lane); continue; } r -= I_UKV;
            if (r < I_SQ) { p0_transpose_item(P->in[24], 2048, 2048, (bf16*)(ws + WS_MLAOUT), scr, r, lane); continue; } r -= I_SQ;
            if (r < I_DIN) { p0_transpose_item(P->in[25], 2048, 6144, (bf16*)(ws + WS_DAIN), scr, r, lane); continue; } r -= I_DIN;
            p0_transpose_item(P->in[28], 2048, 2048, (bf16*)(ws + WS_DAOUT), scr, r, lane);
        }
    }
    const size_t gtid = (size_t)gw * 64 + lane, gthreads = (size_t)NGW * 64;
    if (parts & 2) {
    { u32x4* z = (u32x4*)((bf16*)(ws + WS_MLAIN) + (size_t)1088 * 2048); const size_t n = (size_t)192 * 2048 / 8;
      for (size_t i = gtid; i < n; i += gthreads) z[i] = (u32x4){0u, 0u, 0u, 0u}; }
    cvt_range(P->in[16], (bf16*)(ws + WS_GMWS), (size_t)2 * 16 * 128 * 128 / 8, gtid, gthreads);
    cvt_range(P->in[9], (bf16*)(ws + WS_PK1), (size_t)4 * 128 * 128 / 8, gtid, gthreads);
    cvt_range(P->in[10], (bf16*)(ws + WS_PK2), (size_t)4 * 128 * 128 / 8, gtid, gthreads);
#if !TAIL_REMAP
    cvt_table_fp6(P->in[11], ws + WS_PU, 16384, U_SCALE, scr, lane, gw, NGW, 0);
    cvt_table_fp6(P->in[12], ws + WS_PU, 16384, V_SCALE, scr, lane, gw, NGW, 1);
#endif
    if (gtid < 2048) { const int pos = (int)gtid >> 4, f = (int)gtid & 15; const float inv = powf(10000.0f, -(float)f * (1.0f / 16.0f)); float sn, cs; sincosf((float)pos * inv, &sn, &cs);
        float* rt = (float*)(ws + WS_ROPE); rt[gtid] = cs; rt[2048 + gtid] = sn; }
    }
    if (parts & 4) {
        const float* cv = P->in[1]; const float* cc = P->in[3]; const float* mw = P->in[4]; float* PART = (float*)(ws + WS_MODP);
        LAS float* S = (LAS float*)lds;
        __syncthreads();
        for (int i = tid; i < 3 * 2048; i += NWAVES * 64) { const int sl = i >> 11, kk = i & 2047; S[i] = silu(sl == 0 ? cv[kk] : (sl == 1 ? cv[2048 + kk] : cc[kk])); }
        __syncthreads();
        for (int item = gw; item < 4 * 192 * 8; item += NGW) {
            const int ks = item & 7, r = item >> 3, L = r / 192, n = (r % 192) * 64 + lane;
            const float* W = mw + (size_t)L * 2048 * 12288 + (size_t)(ks * 256) * 12288 + n;
            float a0 = 0.f, a1 = 0.f, a2 = 0.f;
#pragma unroll 32
            for (int k = 0; k < 256; ++k) { const int kk = ks * 256 + k; const float s0 = S[kk], s1 = S[2048 + kk], s2 = S[4096 + kk];
                const float w = W[(size_t)k * 12288]; a0 += s0 * w; a1 += s1 * w; a2 += s2 * w; }
            float* o = PART + ((size_t)ks * 4 + L) * 3 * 12288 + n;
            o[0] = a0; o[12288] = a1; o[24576] = a2;
        }
    }
}
__device__ __forceinline__ void mod_reduce(CP P, int gw, int lane, int NGW) {
    const float* PART = (const float*)(P->ws + WS_MODP); float* MOD = (float*)(P->ws + WS_MOD); const float* mb = P->in[5];
    for (int i = gw * 64 + lane; i < 4 * 3 * 12288; i += NGW * 64) {
        const int L = i / (3 * 12288), n = i % 12288;
        float s = mb[(size_t)L * 12288 + n];
#pragma unroll
        for (int ks = 0; ks < 8; ++ks) s += PART[(size_t)ks * 4 * 3 * 12288 + i];
        MOD[i] = s;
    }
}

__device__ __forceinline__ void first_row_pass(CP P, int lane, int gw, int NGW) {
    const float* MOD = (const float*)(P->ws + WS_MOD); bf16* X = (bf16*)(P->ws + WS_X); bf16* H = (bf16*)(P->ws + WS_H);
    for (int row = gw; row < MT; row += NGW) {
        const float* src = row < ML ? P->in[0] + (size_t)row * DM : P->in[2] + (size_t)(row - ML) * DM;
        float v[32]; load_row_f32(src, lane, v);
        store_row_bf16(X + (size_t)row * DM, lane, v);
        const float* mod = MOD + (size_t)row_slot(row) * 12288;
        float mean, rstd; ln_stats(v, mean, rstd);
        float a[32], s[32]; load_row_f32(mod + 2048, lane, a); load_row_f32(mod, lane, s);
#pragma unroll
        for (int i = 0; i < 32; ++i) a[i] = (v[i] - mean) * rstd * (1.0f + a[i]) + s[i];
        store_row_bf16(H + (size_t)row * DM, lane, a);
    }
}
__device__ __forceinline__ void post_mixer_pass(CP P, int L, int Mrows, int lane, int gw, int NGW) {
    const float* MOD = (const float*)(P->ws + WS_MOD); bf16* X = (bf16*)(P->ws + WS_X); bf16* H = (bf16*)(P->ws + WS_H); const bf16* Y = (const bf16*)(P->ws + WS_Y);
    const float* lng = P->in[6] + (size_t)(L * 2 + 0) * DM; const float* lnb = P->in[7] + (size_t)(L * 2 + 0) * DM;
    for (int row = gw; row < Mrows; row += NGW) {
        const float* mod = MOD + (size_t)(L * 3 + row_slot(row)) * 12288;
        float z[32], y[32], g[32]; load_row_bf16(X + (size_t)row * DM, lane, z); load_row_bf16(Y + (size_t)row * DM, lane, y); load_row_f32(mod + 2 * 2048, lane, g);
#pragma unroll
        for (int i = 0; i < 32; ++i) z[i] = ALPHA * z[i] + g[i] * y[i];
        finish_row<false>(z, lng, lnb, X + (size_t)row * DM, mod + 3 * 2048, mod + 4 * 2048, H + (size_t)row * DM, nullptr, lane);
    }
}
__device__ __forceinline__ void vstats_pass(CP P, int Mrows, int lane, int gw, int NGW) {
    const bf16* Z = (const bf16*)(P->ws + WS_Z); float* VST = (float*)(P->ws + WS_VST);
    for (int row = gw; row < Mrows; row += NGW) {
        float v[32]; load_row_bf16(Z + (size_t)row * 4096 + 2048, lane, v);
        float mean, rstd; ln_stats(v, mean, rstd);
        if (lane == 0) { VST[2 * row] = mean; VST[2 * row + 1] = rstd; }
    }
}
#define XB_TMO      128
#define XB_XCNT(j)  (256  + 64 * (j))
#define XB_XSUB(j)  (1280 + 64 * (j))
#define XB_XGEN(j)  (2304 + 64 * (j))
#define XB_TOP      3328
#define XB_TOPGEN   3392
#define XCD_BAR_WORDS 3456
#define XB_SPIN_CAP (1u << 18)

__device__ __forceinline__ unsigned xb_ld(unsigned* p)              { return __hip_atomic_load(p, __ATOMIC_RELAXED, __HIP_MEMORY_SCOPE_AGENT); }
__device__ __forceinline__ unsigned xb_add(unsigned* p, unsigned v) { return __hip_atomic_fetch_add(p, v, __ATOMIC_RELAXED, __HIP_MEMORY_SCOPE_AGENT); }
__device__ __forceinline__ unsigned xb_xcc_id() { return (unsigned)__builtin_amdgcn_s_getreg((3 << 11) | 20) & 0xFu; }
#define XB_SPIN(cond, bar) do { unsigned _sp = 0; while (cond) { __builtin_amdgcn_s_sleep(1); \
    if ((++_sp & 255u) == 0u) { if (xb_ld(&(bar)[XB_TMO])) break; if (_sp > XB_SPIN_CAP) { atomicAdd(&(bar)[XB_TMO], 1u); break; } } } } while (0)

struct XcdBarrier {
    unsigned* bar; unsigned x;
    volatile LAS unsigned* st;
};

__device__ __forceinline__ XcdBarrier xcd_barrier_post(unsigned* bar, volatile LAS unsigned* st, const bool t0) {
    XcdBarrier b; b.bar = bar; b.x = xb_xcc_id(); b.st = st;
    if (t0) (void)xb_add(&bar[XB_XCNT(b.x)], 1u);
    return b;
}
__device__ __forceinline__ void xcd_barrier_complete(unsigned* bar, unsigned x, unsigned& nloc, unsigned& nx) {
    const unsigned G = gridDim.x * gridDim.y * gridDim.z;
    unsigned sum, cnt, mine, sp = 0u;
    for (;;) {
        sum = 0u; cnt = 0u; mine = 0u;
#pragma unroll
        for (unsigned j = 0; j < 16; ++j) { const unsigned c = xb_ld(&bar[XB_XCNT(j)]); sum += c; cnt += (c > 0u) ? 1u : 0u; mine = (j == x) ? c : mine; }
        if (sum == G) break;
        __builtin_amdgcn_s_sleep(1);
        if ((++sp & 255u) == 0u) { if (xb_ld(&bar[XB_TMO])) break; if (sp > XB_SPIN_CAP) { atomicAdd(&bar[XB_TMO], 1u); break; } }
    }
    nloc = mine > 0u ? mine : 1u; nx = cnt > 0u ? cnt : 1u;
}

__device__ __attribute__((noinline)) void xcd_barrier(const XcdBarrier b, const bool t0) {
    asm volatile("s_waitcnt vmcnt(0)" ::: "memory");
    __syncthreads();
    if (t0) {
        unsigned* bar = b.bar;
        __builtin_amdgcn_s_waitcnt(0);
        unsigned nloc = b.st[0], nx = b.st[1];
        if (nloc == 0u) { xcd_barrier_complete(bar, b.x, nloc, nx); b.st[0] = nloc; b.st[1] = nx; }
        const unsigned old = xb_add(&bar[XB_XSUB(b.x)], 1u);
        const unsigned gen = old / nloc;
        if (old + 1u == (gen + 1u) * nloc) {
            __builtin_amdgcn_fence(__ATOMIC_RELEASE, "agent");
            asm volatile("s_waitcnt vmcnt(0)" ::: "memory");
            const unsigned og = xb_add(&bar[XB_TOP], 1u);
            const unsigned tg = og / nx;
            if (og + 1u == (tg + 1u) * nx) xb_add(&bar[XB_TOPGEN], 1u);
            else XB_SPIN(xb_ld(&bar[XB_TOPGEN]) == tg, bar);
            __builtin_amdgcn_fence(__ATOMIC_ACQUIRE, "agent");
            xb_add(&bar[XB_XGEN(b.x)], 1u);
            asm volatile("s_waitcnt vmcnt(0)" ::: "memory");
        } else {
            XB_SPIN(xb_ld(&bar[XB_XGEN(b.x)]) == gen, bar);
            __builtin_amdgcn_fence(__ATOMIC_ACQUIRE, "agent");
            asm volatile("s_waitcnt vmcnt(0)" ::: "memory");
        }
    }
    __syncthreads();
}

__device__ __forceinline__ void spatial_phase(CP P, int j, int Mrows, LAS unsigned char* lds_, int tid, int lane, int wid) {
    const bf16* Z = (const bf16*)(P->ws + WS_Z); const float* VST = (const float*)(P->ws + WS_VST); bf16* Gb = (bf16*)(P->ws + WS_G);
    const bf16* WS = (const bf16*)(P->ws + WS_GMWS) + (size_t)j * 16 * 128 * 128;
    const float* lng = P->in[14] + (size_t)j * DM; const float* lnb = P->in[15] + (size_t)j * DM; const float* bs = P->in[17] + (size_t)j * 16 * 128;
    LAS bf16* Vt = (LAS bf16*)(LAS unsigned char*)lds_;
    constexpr int VP = 136;
    const int nunits = (Mrows / 128) * 16;
    for (int u = blockIdx.x; u < nunits; u += gridDim.x) {
        const int c = u >> 4, g = u & 15;
        __syncthreads();
        {
            const int q = tid >> 2, dq = (tid & 3) * 32; const int row = c * 128 + q;
            const float mean = VST[2 * row], rstd = VST[2 * row + 1];
            const bf16* src = Z + (size_t)row * 4096 + 2048 + g * 128 + dq;
#pragma unroll
            for (int t = 0; t < 4; ++t) { const u32x4 w = *(const u32x4*)(src + 8 * t);
                float v[8] = {bflo(w.x), bfhi(w.x), bflo(w.y), bfhi(w.y), bflo(w.z), bfhi(w.z), bflo(w.w), bfhi(w.w)};
                const float* gp = lng + g * 128 + dq + 8 * t; const float* bp = lnb + g * 128 + dq + 8 * t;
#pragma unroll
                for (int i = 0; i < 8; ++i) { const float vn = (v[i] - mean) * rstd * gp[i] + bp[i]; Vt[(dq + 8 * t + i) * VP + q] = tobf1(vn); } }
        }
        __syncthreads();
        const int fr = lane & 15, fq = lane >> 4;
        bf16x8 a[4];
        const bf16* wrow = WS + (size_t)g * 128 * 128 + (size_t)(16 * wid + fr) * 128 + 8 * fq;
#pragma unroll
        for (int ks = 0; ks < 4; ++ks) a[ks] = *(const bf16x8*)(wrow + 32 * ks);
#pragma unroll
        for (int nb = 0; nb < 8; ++nb) {
            f32x4 acc = {0.f, 0.f, 0.f, 0.f};
#pragma unroll
            for (int ks = 0; ks < 4; ++ks) { const bf16x8 b = *(const LAS bf16x8*)(Vt + (16 * nb + fr) * VP + 32 * ks + 8 * fq);
                acc = __builtin_amdgcn_mfma_f32_16x16x32_bf16(a[ks], b, acc, 0, 0, 0); }
#pragma unroll
            for (int r = 0; r < 4; ++r) { const int p = 16 * wid + fq * 4 + r, d = 16 * nb + fr; const size_t grow = (size_t)(c * 128 + p);
                const float sv = acc[r] + bs[g * 128 + p];
                const float uu = bf1(Z[grow * 4096 + g * 128 + d]);
                Gb[grow * 2048 + g * 128 + d] = tobf1(uu * sv); }
        }
    }
}

__device__ __forceinline__ void rope_cs(int row, int l, float& cs, float& sn) {
    const int t = row & (SEQ - 1); const int pos = (l & 32) ? (t & 63) : (t >> 6);
    const float inv = powf(10000.0f, -(float)(l & 15) * (1.0f / 16.0f));
    const float ang = (float)pos * inv; sincosf(ang, &sn, &cs);
}
__device__ __forceinline__ float rope_apply(float x, int l, float cs, float sn) {
    const float p = lane_xor16(x, l);
    return (l & 16) ? (p * sn + x * cs) : (x * cs - p * sn);
}
__device__ __forceinline__ void mla_norm_pass(CP P, int lane, int gw, int NGW) {
    const bf16* C = (const bf16*)(P->ws + WS_C); bf16* CQN = (bf16*)(P->ws + WS_CQN); bf16* CKVN = (bf16*)(P->ws + WS_CKVN); bf16* KR = (bf16*)(P->ws + WS_KR);
    const float* qn = P->in[20]; const float* kvn = P->in[21];
    for (int row = gw; row < MT; row += NGW) {
        const bf16* c = C + (size_t)row * 1280;
#pragma unroll
        for (int part = 0; part < 2; ++part) {
            const u32x4 w = *(const u32x4*)(c + part * 512 + 8 * lane);
            float v[8] = {bflo(w.x), bfhi(w.x), bflo(w.y), bfhi(w.y), bflo(w.z), bfhi(w.z), bflo(w.w), bfhi(w.w)};
            float ss = 0.f;
#pragma unroll
            for (int i = 0; i < 8; ++i) ss += v[i] * v[i];
            const float r = 1.0f / sqrtf(wave_sum(ss) * (1.0f / 512.0f) + LN_EPS);
            const float* nw = (part ? kvn : qn) + 8 * lane;
            u32x4 o; o.x = cvtpk(v[0] * r * nw[0], v[1] * r * nw[1]); o.y = cvtpk(v[2] * r * nw[2], v[3] * r * nw[3]); o.z = cvtpk(v[4] * r * nw[4], v[5] * r * nw[5]); o.w = cvtpk(v[6] * r * nw[6], v[7] * r * nw[7]);
            *(u32x4*)((part ? CKVN : CQN) + (size_t)row * 512 + 8 * lane) = o;
        }
        float x = bf1(c[1024 + lane]);
        if (row < ML) { float cs, sn; rope_cs(row, lane, cs, sn); x = rope_apply(x, lane, cs, sn); }
        KR[(size_t)row * 64 + lane] = tobf1(x);
    }
}
__device__ __forceinline__ void rope_pass(bf16* buf, int ld, int col0, int nchunks, int cstride, int lane, int gw, int NGW) {
    for (int row = gw; row < ML; row += NGW) {
        float cs, sn; rope_cs(row, lane, cs, sn);
        bf16* r = buf + (size_t)row * ld + col0 + lane;
#pragma unroll 4
        for (int k = 0; k < nchunks; ++k) { const float x = bf1(r[k * cstride]); r[k * cstride] = tobf1(rope_apply(x, lane, cs, sn)); }
    }
}

namespace att {
#ifndef ATT_LEAN
#define ATT_LEAN 1
#endif
#ifndef ATT_3STAGE
#define ATT_3STAGE 0
#endif
#ifndef ATT_PRIO
#define ATT_PRIO 0
#endif
#ifndef ATT_KMAJOR
#define ATT_KMAJOR 0
#endif
#ifndef ATT_TRB
#define ATT_TRB 1
#endif
#ifndef ATT_STAGGER
#define ATT_STAGGER 0
#endif
#ifndef ATT_SDEPTH
#define ATT_SDEPTH(MODE) ((MODE) == 0 ? 1 : 1)
#endif
#ifndef ATT_PVPIPE
#define ATT_PVPIPE(MODE) ((MODE) == 1)
#endif
#define SBAR() __builtin_amdgcn_sched_barrier(0)
__device__ __forceinline__ int crow(int r, int hi) { return (r & 3) + 8 * (r >> 2) + 4 * hi; }
__device__ __forceinline__ unsigned cvtpkv(float lo, float hi) { unsigned r; asm volatile("v_cvt_pk_bf16_f32 %0, %1, %2" : "=v"(r) : "v"(lo), "v"(hi)); return r; }

__device__ __forceinline__ void partialSM(f32x16& p0, f32x16& p1, float& m_reg, float& mn, float& alpha, const float C, const float THRS) {
  float pmax = p0[0];
#pragma unroll
  for (int r = 1; r < 16; ++r) pmax = fmaxf(pmax, p0[r]);
#pragma unroll
  for (int r = 0; r < 16; ++r) pmax = fmaxf(pmax, p1[r]);
  { auto rr = __builtin_amdgcn_permlane32_swap(__float_as_uint(pmax), __float_as_uint(pmax), false, false);
    pmax = fmaxf(__uint_as_float(rr[0]), __uint_as_float(rr[1])); }
  if (__builtin_expect(__all(pmax - m_reg <= THRS), 1)) { mn = m_reg; alpha = 1.f; }
  else { mn = fmaxf(m_reg, pmax); alpha = __builtin_amdgcn_exp2f((m_reg - mn) * C); m_reg = mn; }
  const float mnC = -mn * C;
#pragma unroll
  for (int r = 0; r < 16; ++r) p0[r] = fmaf(p0[r], C, mnC);
#pragma unroll
  for (int r = 0; r < 16; ++r) p1[r] = fmaf(p1[r], C, mnC);
#pragma unroll
  for (int r = 0; r < 16; ++r) p0[r] = __builtin_amdgcn_exp2f(p0[r]);
}
__device__ __forceinline__ void finishSM(f32x16& p0, f32x16& p1, float alpha, float& l_reg, bf16x8& pa0, bf16x8& pa1, bf16x8& pa2, bf16x8& pa3) {
#pragma unroll
  for (int r = 0; r < 16; ++r) p1[r] = __builtin_amdgcn_exp2f(p1[r]);
  float ps = 0;
#pragma unroll
  for (int r = 0; r < 16; ++r) ps += p0[r];
#pragma unroll
  for (int r = 0; r < 16; ++r) ps += p1[r];
  { auto rr = __builtin_amdgcn_permlane32_swap(__float_as_uint(ps), __float_as_uint(ps), false, false);
    ps = __uint_as_float(rr[0]) + __uint_as_float(rr[1]); }
  l_reg = l_reg * alpha + ps;
#define PK4(P, BASE, OUT) do { unsigned a0 = cvtpkv(P[BASE + 0], P[BASE + 1]), a1 = cvtpkv(P[BASE + 2], P[BASE + 3]);   \
    unsigned b0 = cvtpkv(P[BASE + 4], P[BASE + 5]), b1 = cvtpkv(P[BASE + 6], P[BASE + 7]);                              \
    auto r0 = __builtin_amdgcn_permlane32_swap(a0, b0, false, false); auto r1 = __builtin_amdgcn_permlane32_swap(a1, b1, false, false); \
    u32x4 w = {r0[0], r1[0], r0[1], r1[1]}; OUT = *reinterpret_cast<bf16x8*>(&w); } while (0)
  PK4(p0, 0, pa0); PK4(p0, 8, pa1); PK4(p1, 0, pa2); PK4(p1, 8, pa3);
#undef PK4
}
__device__ __forceinline__ void partialSM_lean(f32x16& p0, f32x16& p1, f32x16& nm, float& alpha, const bool first) {
  constexpr float THR2 = 11.541560327111707f;
  float dmax = p0[0];
#pragma unroll
  for (int r = 1; r < 16; ++r) dmax = fmaxf(dmax, p0[r]);
#pragma unroll
  for (int r = 0; r < 16; ++r) dmax = fmaxf(dmax, p1[r]);
  { auto rr = __builtin_amdgcn_permlane32_swap(__float_as_uint(dmax), __float_as_uint(dmax), false, false);
    dmax = fmaxf(__uint_as_float(rr[0]), __uint_as_float(rr[1])); }
  alpha = 1.f;
  if (first || !__all(dmax <= THR2)) {
    const float delta = first ? dmax : (dmax > THR2 ? dmax : 0.f);
    if (!first) alpha = __builtin_amdgcn_exp2f(-delta);
#pragma unroll
    for (int r = 0; r < 16; ++r) { p0[r] -= delta; p1[r] -= delta; nm[r] -= delta; }
  }
#pragma unroll
  for (int r = 0; r < 16; ++r) p0[r] = __builtin_amdgcn_exp2f(p0[r]);
}
__device__ __forceinline__ void finishSM_lean(f32x16& p0, f32x16& p1, bf16x8& pa0, bf16x8& pa1, bf16x8& pa2, bf16x8& pa3) {
#pragma unroll
  for (int r = 0; r < 16; ++r) p1[r] = __builtin_amdgcn_exp2f(p1[r]);
#define PK4(P, BASE, OUT) do { unsigned a0 = cvtpkv(P[BASE + 0], P[BASE + 1]), a1 = cvtpkv(P[BASE + 2], P[BASE + 3]);   \
    unsigned b0 = cvtpkv(P[BASE + 4], P[BASE + 5]), b1 = cvtpkv(P[BASE + 6], P[BASE + 7]);                              \
    auto r0 = __builtin_amdgcn_permlane32_swap(a0, b0, false, false); auto r1 = __builtin_amdgcn_permlane32_swap(a1, b1, false, false); \
    u32x4 w = {r0[0], r1[0], r0[1], r1[1]}; OUT = *reinterpret_cast<bf16x8*>(&w); } while (0)
  PK4(p0, 0, pa0); PK4(p0, 8, pa1); PK4(p1, 0, pa2); PK4(p1, 8, pa3);
#undef PK4
}
__device__ __forceinline__ bf16x8 scale_bf16x8(bf16x8 v, float c) {
  const u32x4 w = *reinterpret_cast<u32x4*>(&v); u32x4 o;
  o.x = cvtpk(bflo(w.x) * c, bfhi(w.x) * c); o.y = cvtpk(bflo(w.y) * c, bfhi(w.y) * c); o.z = cvtpk(bflo(w.z) * c, bfhi(w.z) * c); o.w = cvtpk(bflo(w.w) * c, bfhi(w.w) * c);
  return *reinterpret_cast<bf16x8*>(&o);
}
template <int PITCH> __device__ __forceinline__ int kswz(int r) { return PITCH == 256 ? (r & 15) : ((r >> 1) & 7); }
template <int NQF, int NQR, int PITCH> __device__ __forceinline__ void qkt(f32x16& p0, f32x16& p1, const LAS char* Ks, int chunk0, const bf16x8* qr, const LAS char* ql, int r32, int hi, const f32x16 init = f32x16{}) {
  p0 = init; p1 = init;
  const int sw = kswz<PITCH>(r32);
#pragma unroll
  for (int d0 = 0; d0 < NQF; ++d0) { const int off = ((chunk0 + d0 * 2 + hi) ^ sw) * 16;
    const bf16x8 b0 = *(const LAS bf16x8*)(Ks + r32 * PITCH + off);
    const bf16x8 b1 = *(const LAS bf16x8*)(Ks + (32 + r32) * PITCH + off);
    const bf16x8 q = d0 < NQR ? qr[d0 < NQR ? d0 : 0] : *(const LAS bf16x8*)(ql + (d0 - NQR < 0 ? 0 : d0 - NQR) * 1024);
    p0 = __builtin_amdgcn_mfma_f32_32x32x16_bf16(b0, q, p0, 0, 0, 0);
    p1 = __builtin_amdgcn_mfma_f32_32x32x16_bf16(b1, q, p1, 0, 0, 0); }
}
__device__ __forceinline__ int v_st(int k, int c) { const int kk = (k & ~0xC) | ((k & 4) << 1) | ((k & 8) >> 1); return ((kk >> 3) * 4 + (c >> 5)) * 512 + ((kk & 7) * 32 + (c & 31)) * 2; }
__device__ __forceinline__ int v_rd_base(int lane) { return ((lane & 3) << 3) | (((lane >> 2) & 3) << 6) | (((lane >> 4) & 1) << 5) | (((lane >> 5) & 1) << 8); }
constexpr int v_rd_off(int d0, int ks, int half) { return d0 * 512 + ks * 4096 + half * 2048; }
template <int OFF> __device__ __forceinline__ s16x4 tr_read(int vb) {
  s16x4 r; asm volatile("ds_read_b64_tr_b16 %0, %1 offset:%2" : "=&v"(r) : "v"(vb), "i"(OFF) : "memory"); return r;
}
template <int D0> __device__ __forceinline__ void pv_one(f32x16& od, int vb, bf16x8 pa0, bf16x8 pa1, bf16x8 pa2, bf16x8 pa3) {
  const s16x4 l0 = tr_read<v_rd_off(D0, 0, 0)>(vb), h0 = tr_read<v_rd_off(D0, 0, 1)>(vb), l1 = tr_read<v_rd_off(D0, 1, 0)>(vb), h1 = tr_read<v_rd_off(D0, 1, 1)>(vb);
  const s16x4 l2 = tr_read<v_rd_off(D0, 2, 0)>(vb), h2 = tr_read<v_rd_off(D0, 2, 1)>(vb), l3 = tr_read<v_rd_off(D0, 3, 0)>(vb), h3 = tr_read<v_rd_off(D0, 3, 1)>(vb);
  asm volatile("s_waitcnt lgkmcnt(0)" ::: "memory"); SBAR();
#define PK(L, H) (bf16x8){L[0], L[1], L[2], L[3], H[0], H[1], H[2], H[3]}
  od = __builtin_amdgcn_mfma_f32_32x32x16_bf16(pa0, PK(l0, h0), od, 0, 0, 0);
  od = __builtin_amdgcn_mfma_f32_32x32x16_bf16(pa1, PK(l1, h1), od, 0, 0, 0);
  od = __builtin_amdgcn_mfma_f32_32x32x16_bf16(pa2, PK(l2, h2), od, 0, 0, 0);
  od = __builtin_amdgcn_mfma_f32_32x32x16_bf16(pa3, PK(l3, h3), od, 0, 0, 0);
#undef PK
}
__device__ __forceinline__ void pv_d0(f32x16* o, int vb, bf16x8 pa0, bf16x8 pa1, bf16x8 pa2, bf16x8 pa3) {
  pv_one<0>(o[0], vb, pa0, pa1, pa2, pa3); pv_one<1>(o[1], vb, pa0, pa1, pa2, pa3); pv_one<2>(o[2], vb, pa0, pa1, pa2, pa3); pv_one<3>(o[3], vb, pa0, pa1, pa2, pa3);
}
struct VFrag { s16x4 l0, h0, l1, h1, l2, h2, l3, h3; };
typedef short v4i16_t __attribute__((ext_vector_type(4)));
template <int OFF> __device__ __forceinline__ s16x4 tr_read_b(int vb) {
  return __builtin_bit_cast(s16x4, __builtin_amdgcn_ds_read_tr16_b64_v4i16((LAS v4i16_t*)(uintptr_t)(unsigned)(vb + OFF)));
}
template <int D0> __device__ __forceinline__ void tr8b(VFrag& f, int vb) {
  f.l0 = tr_read_b<v_rd_off(D0, 0, 0)>(vb); f.h0 = tr_read_b<v_rd_off(D0, 0, 1)>(vb); f.l1 = tr_read_b<v_rd_off(D0, 1, 0)>(vb); f.h1 = tr_read_b<v_rd_off(D0, 1, 1)>(vb);
  f.l2 = tr_read_b<v_rd_off(D0, 2, 0)>(vb); f.h2 = tr_read_b<v_rd_off(D0, 2, 1)>(vb); f.l3 = tr_read_b<v_rd_off(D0, 3, 0)>(vb); f.h3 = tr_read_b<v_rd_off(D0, 3, 1)>(vb);
}
template <int D0> __device__ __forceinline__ void tr8(VFrag& f, int vb) {
  f.l0 = tr_read<v_rd_off(D0, 0, 0)>(vb); f.h0 = tr_read<v_rd_off(D0, 0, 1)>(vb); f.l1 = tr_read<v_rd_off(D0, 1, 0)>(vb); f.h1 = tr_read<v_rd_off(D0, 1, 1)>(vb);
  f.l2 = tr_read<v_rd_off(D0, 2, 0)>(vb); f.h2 = tr_read<v_rd_off(D0, 2, 1)>(vb); f.l3 = tr_read<v_rd_off(D0, 3, 0)>(vb); f.h3 = tr_read<v_rd_off(D0, 3, 1)>(vb);
}
__device__ __forceinline__ void mfma4(f32x16& od, VFrag& f, bf16x8 pa0, bf16x8 pa1, bf16x8 pa2, bf16x8 pa3) {
#define PK(L, H) (bf16x8){L[0], L[1], L[2], L[3], H[0], H[1], H[2], H[3]}
  od = __builtin_amdgcn_mfma_f32_32x32x16_bf16(pa0, PK(f.l0, f.h0), od, 0, 0, 0);
  od = __builtin_amdgcn_mfma_f32_32x32x16_bf16(pa1, PK(f.l1, f.h1), od, 0, 0, 0);
  od = __builtin_amdgcn_mfma_f32_32x32x16_bf16(pa2, PK(f.l2, f.h2), od, 0, 0, 0);
  od = __builtin_amdgcn_mfma_f32_32x32x16_bf16(pa3, PK(f.l3, f.h3), od, 0, 0, 0);
#undef PK
}
#define VF_TIE(f) "+v"(f.l0), "+v"(f.h0), "+v"(f.l1), "+v"(f.h1), "+v"(f.l2), "+v"(f.h2), "+v"(f.l3), "+v"(f.h3)
__device__ __forceinline__ void pv_pipe(f32x16* o, int vb, bf16x8 pa0, bf16x8 pa1, bf16x8 pa2, bf16x8 pa3) {
  VFrag A, B;
  asm volatile("s_waitcnt lgkmcnt(0)" ::: "memory");
  tr8<0>(A, vb); tr8<1>(B, vb);
  asm volatile("s_waitcnt lgkmcnt(8)" : VF_TIE(A) :: "memory");
  mfma4(o[0], A, pa0, pa1, pa2, pa3);
  tr8<2>(A, vb);
  asm volatile("s_waitcnt lgkmcnt(8)" : VF_TIE(B) :: "memory");
  mfma4(o[1], B, pa0, pa1, pa2, pa3);
  tr8<3>(B, vb);
  asm volatile("s_waitcnt lgkmcnt(8)" : VF_TIE(A) :: "memory");
  mfma4(o[2], A, pa0, pa1, pa2, pa3);
  asm volatile("s_waitcnt lgkmcnt(0)" : VF_TIE(B) :: "memory");
  mfma4(o[3], B, pa0, pa1, pa2, pa3);
}
__device__ __forceinline__ void pv_psm_lean(f32x16* o, int vb, bf16x8 pa0, bf16x8 pa1, bf16x8 pa2, bf16x8 pa3, f32x16& p0, f32x16& p1, f32x16& nm, float& alpha) {
  constexpr float THR2 = 11.541560327111707f;
  const bf16x8 one8 = {0x3F80, 0x3F80, 0x3F80, 0x3F80, 0x3F80, 0x3F80, 0x3F80, 0x3F80};
  VFrag A, B;
  asm volatile("s_waitcnt lgkmcnt(0)" ::: "memory");
  tr8<0>(A, vb); tr8<1>(B, vb);
  asm volatile("s_waitcnt lgkmcnt(8)" : VF_TIE(A) :: "memory");
  mfma4(o[0], A, pa0, pa1, pa2, pa3);
  float dmax = p0[0];
#pragma unroll
  for (int r = 1; r < 16; ++r) dmax = fmaxf(dmax, p0[r]);
  tr8<2>(A, vb);
  asm volatile("s_waitcnt lgkmcnt(8)" : VF_TIE(B) :: "memory");
  mfma4(o[1], B, pa0, pa1, pa2, pa3);
#pragma unroll
  for (int r = 0; r < 16; ++r) dmax = fmaxf(dmax, p1[r]);
  { auto rr = __builtin_amdgcn_permlane32_swap(__float_as_uint(dmax), __float_as_uint(dmax), false, false);
    dmax = fmaxf(__uint_as_float(rr[0]), __uint_as_float(rr[1])); }
  alpha = 1.f;
  if (!__all(dmax <= THR2)) {
    const float delta = dmax > THR2 ? dmax : 0.f; alpha = __builtin_amdgcn_exp2f(-delta);
#pragma unroll
    for (int r = 0; r < 16; ++r) { p0[r] -= delta; p1[r] -= delta; nm[r] -= delta; }
  }
  tr8<3>(B, vb);
  asm volatile("s_waitcnt lgkmcnt(8)" : VF_TIE(A) :: "memory");
  mfma4(o[2], A, pa0, pa1, pa2, pa3);
#pragma unroll
  for (int r = 0; r < 8; ++r) p0[r] = __builtin_amdgcn_exp2f(p0[r]);
  asm volatile("s_waitcnt lgkmcnt(0)" : VF_TIE(B) :: "memory");
  mfma4(o[3], B, pa0, pa1, pa2, pa3);
#pragma unroll
  for (int r = 8; r < 16; ++r) p0[r] = __builtin_amdgcn_exp2f(p0[r]);
  o[4] = __builtin_amdgcn_mfma_f32_32x32x16_bf16(pa0, one8, o[4], 0, 0, 0); o[4] = __builtin_amdgcn_mfma_f32_32x32x16_bf16(pa1, one8, o[4], 0, 0, 0);
  o[4] = __builtin_amdgcn_mfma_f32_32x32x16_bf16(pa2, one8, o[4], 0, 0, 0); o[4] = __builtin_amdgcn_mfma_f32_32x32x16_bf16(pa3, one8, o[4], 0, 0, 0);
}
__device__ __forceinline__ void pv_psm_lean_b(f32x16* o, int vb, bf16x8 pa0, bf16x8 pa1, bf16x8 pa2, bf16x8 pa3, f32x16& p0, f32x16& p1, f32x16& nm, float& alpha) {
  constexpr float THR2 = 11.541560327111707f;
  const bf16x8 one8 = {0x3F80, 0x3F80, 0x3F80, 0x3F80, 0x3F80, 0x3F80, 0x3F80, 0x3F80};
  VFrag A, B;
  tr8b<0>(A, vb); tr8b<1>(B, vb);
  mfma4(o[0], A, pa0, pa1, pa2, pa3);
  float dmax = p0[0];
#pragma unroll
  for (int r = 1; r < 16; ++r) dmax = fmaxf(dmax, p0[r]);
  tr8b<2>(A, vb);
  mfma4(o[1], B, pa0, pa1, pa2, pa3);
#pragma unroll
  for (int r = 0; r < 16; ++r) dmax = fmaxf(dmax, p1[r]);
  { auto rr = __builtin_amdgcn_permlane32_swap(__float_as_uint(dmax), __float_as_uint(dmax), false, false);
    dmax = fmaxf(__uint_as_float(rr[0]), __uint_as_float(rr[1])); }
  alpha = 1.f;
  if (!__all(dmax <= THR2)) {
    const float delta = dmax > THR2 ? dmax : 0.f; alpha = __builtin_amdgcn_exp2f(-delta);
#pragma unroll
    for (int r = 0; r < 16; ++r) { p0[r] -= delta; p1[r] -= delta; nm[r] -= delta; }
  }
  tr8b<3>(B, vb);
  mfma4(o[2], A, pa0, pa1, pa2, pa3);
#pragma unroll
  for (int r = 0; r < 8; ++r) p0[r] = __builtin_amdgcn_exp2f(p0[r]);
  mfma4(o[3], B, pa0, pa1, pa2, pa3);
#pragma unroll
  for (int r = 8; r < 16; ++r) p0[r] = __builtin_amdgcn_exp2f(p0[r]);
  o[4] = __builtin_amdgcn_mfma_f32_32x32x16_bf16(pa0, one8, o[4], 0, 0, 0); o[4] = __builtin_amdgcn_mfma_f32_32x32x16_bf16(pa1, one8, o[4], 0, 0, 0);
  o[4] = __builtin_amdgcn_mfma_f32_32x32x16_bf16(pa2, one8, o[4], 0, 0, 0); o[4] = __builtin_amdgcn_mfma_f32_32x32x16_bf16(pa3, one8, o[4], 0, 0, 0);
}
struct VStep { s16x4 l0, h0, l1, h1, l2, h2, l3, h3; };
template <int KS> __device__ __forceinline__ void trstep(VStep& f, int vb) {
  f.l0 = tr_read_b<v_rd_off(0, KS, 0)>(vb); f.h0 = tr_read_b<v_rd_off(0, KS, 1)>(vb); f.l1 = tr_read_b<v_rd_off(1, KS, 0)>(vb); f.h1 = tr_read_b<v_rd_off(1, KS, 1)>(vb);
  f.l2 = tr_read_b<v_rd_off(2, KS, 0)>(vb); f.h2 = tr_read_b<v_rd_off(2, KS, 1)>(vb); f.l3 = tr_read_b<v_rd_off(3, KS, 0)>(vb); f.h3 = tr_read_b<v_rd_off(3, KS, 1)>(vb);
}
__device__ __forceinline__ void mfma5(f32x16* o, const VStep& f, bf16x8 pa) {
  const bf16x8 one8 = {0x3F80, 0x3F80, 0x3F80, 0x3F80, 0x3F80, 0x3F80, 0x3F80, 0x3F80};
#define PK(L, H) (bf16x8){L[0], L[1], L[2], L[3], H[0], H[1], H[2], H[3]}
  o[0] = __builtin_amdgcn_mfma_f32_32x32x16_bf16(pa, PK(f.l0, f.h0), o[0], 0, 0, 0);
  o[1] = __builtin_amdgcn_mfma_f32_32x32x16_bf16(pa, PK(f.l1, f.h1), o[1], 0, 0, 0);
  o[2] = __builtin_amdgcn_mfma_f32_32x32x16_bf16(pa, PK(f.l2, f.h2), o[2], 0, 0, 0);
  o[3] = __builtin_amdgcn_mfma_f32_32x32x16_bf16(pa, PK(f.l3, f.h3), o[3], 0, 0, 0);
  o[4] = __builtin_amdgcn_mfma_f32_32x32x16_bf16(pa, one8, o[4], 0, 0, 0);
#undef PK
}
template <int BASE> __device__ __forceinline__ bf16x8 pk4e(const f32x16& P) {
  const float e0 = __builtin_amdgcn_exp2f(P[BASE + 0]), e1 = __builtin_amdgcn_exp2f(P[BASE + 1]), e2 = __builtin_amdgcn_exp2f(P[BASE + 2]), e3 = __builtin_amdgcn_exp2f(P[BASE + 3]);
  const float e4 = __builtin_amdgcn_exp2f(P[BASE + 4]), e5 = __builtin_amdgcn_exp2f(P[BASE + 5]), e6 = __builtin_amdgcn_exp2f(P[BASE + 6]), e7 = __builtin_amdgcn_exp2f(P[BASE + 7]);
  const unsigned a0 = cvtpk(e0, e1), a1 = cvtpk(e2, e3), b0 = cvtpk(e4, e5), b1 = cvtpk(e6, e7);
  const auto r0 = __builtin_amdgcn_permlane32_swap(a0, b0, false, false); const auto r1 = __builtin_amdgcn_permlane32_swap(a1, b1, false, false);
  u32x4 w = {r0[0], r1[0], r0[1], r1[1]}; return *reinterpret_cast<bf16x8*>(&w);
}
__device__ __forceinline__ float rowmax_lean(const f32x16& p0, const f32x16& p1) {
  float d = p0[0];
#pragma unroll
  for (int r = 1; r < 16; ++r) d = fmaxf(d, p0[r]);
#pragma unroll
  for (int r = 0; r < 16; ++r) d = fmaxf(d, p1[r]);
  const auto rr = __builtin_amdgcn_permlane32_swap(__float_as_uint(d), __float_as_uint(d), false, false);
  return fmaxf(__uint_as_float(rr[0]), __uint_as_float(rr[1]));
}
__device__ __forceinline__ void shift_lean(float dmax, f32x16& p0, f32x16& p1, f32x16& nm, float& alpha, const bool first) {
  constexpr float THR2 = 11.541560327111707f;
  alpha = 1.f;
  if (first || !__all(dmax <= THR2)) {
    const float delta = first ? dmax : (dmax > THR2 ? dmax : 0.f);
    if (!first) alpha = __builtin_amdgcn_exp2f(-delta);
#pragma unroll
    for (int r = 0; r < 16; ++r) { p0[r] -= delta; p1[r] -= delta; nm[r] -= delta; }
  }
}
#define SGB(mask, n) __builtin_amdgcn_sched_group_barrier((mask), (n), 0)
__device__ __forceinline__ bf16x8 ld8(const bf16* p) { return *reinterpret_cast<const bf16x8*>(p); }

template <int MODE, int ATTV = 0>
__device__ __forceinline__ void attn_unit(const bf16* __restrict__ Qrow0, int ldq, const bf16* __restrict__ Kb, const bf16* __restrict__ Vb, int ldk, const bf16* __restrict__ KRb,
                                          int b, int nct, int NT, bf16* __restrict__ Ob, float lam, const float* __restrict__ subln, float oscale, LAS unsigned char* lds_, const int tid_in) {
  constexpr bool LEAN = (MODE == 1) && ATT_LEAN; constexpr int NQF = MODE == 0 ? 12 : 4, NQR = MODE == 0 ? 4 : 0, NOB = LEAN ? 5 : 4, PITCH = MODE == 0 ? 384 : 256, SHM_V = 16384, SHM_K = 64 * PITCH, SDEPTH = ATT_SDEPTH(MODE); constexpr bool PVPIPE = ATT_PVPIPE(MODE);
  const float SCALE = MODE == 0 ? 0.07216878364870323f : 0.125f;
  const float C = SCALE * 1.4426950408889634f, THRS = 8.f / SCALE;
  if (ATT_PRIO) { if (__builtin_amdgcn_readfirstlane(tid_in >> 8) != 0) __builtin_amdgcn_s_setprio(1); }
  const int tid = launder_v(tid_in) & 511, wid = tid >> 6, lane = tid & 63, r32 = lane & 31, hi = lane >> 5;
  LAS char* lds = (LAS char*)(LAS unsigned char*)lds_;
  constexpr bool THREE = (MODE == 1) && ATT_3STAGE; constexpr int NSTG = THREE ? 3 : 2, STG = SHM_V + SHM_K, SCR0 = NSTG * STG;
#define VOFF(s) (!THREE ? (s) * SHM_V : (s) * STG)
#define KOFF(s) (!THREE ? 2 * SHM_V + (s) * SHM_K : (s) * STG + SHM_V)
  LAS char* V_lds = lds; LAS char* K_lds = lds;
  LAS float* wsf = (LAS float*)(lds + NSTG * (SHM_V + SHM_K)) + wid * 64; LAS float* li_l = wsf; LAS float* al_l = wsf + 32;
  const int wq = MODE == 0 ? wid : (wid & 3), sgrp = MODE == 0 ? 0 : (wid >> 2);
  float m_reg = -1e30f, l_reg = 0; f32x16 o[NOB] = {}; bf16x8 qr[NQR > 0 ? NQR : 1]; f32x16 nm = {};
  LAS char* ql = lds + SCR0 + 2048 + wid * (MODE == 0 ? 8192 : 4096) + lane * 16;
  const bf16* Qw = Qrow0 + (size_t)(wq * 32 + r32) * ldq + sgrp * 64 + hi * 8;
#pragma unroll
  for (int d0 = 0; d0 < NQR; ++d0) qr[d0] = ld8(Qw + d0 * 16);
#pragma unroll
  for (int d0 = NQR; d0 < NQF; ++d0) { bf16x8 qv = ld8(Qw + d0 * 16); if (LEAN) qv = scale_bf16x8(qv, C); *(LAS bf16x8*)(ql + (d0 - NQR) * 1024) = qv; }
  const int sr = tid >> 4, sc = (tid & 15) * 8, vst0 = v_st(sr, sc), vst1 = v_st(32 + sr, sc);
  const int kst0 = sr * PITCH + (((tid & 15) ^ kswz<PITCH>(sr)) * 16), kst1 = kst0 + 32 * PITCH;
  const int rrow = tid >> 3, krs = rrow * PITCH + (((16 + (tid & 7)) ^ kswz<PITCH>(rrow)) * 16);
  const int chunk0 = sgrp * 8;
  const int vb0 = (int)(uintptr_t)V_lds + v_rd_base(lane);
  struct Slot { bf16x8 vs0, vs1, ks0, ks1, kr; } sr_[SDEPTH];
#define KROW(jt) ((jt) < nct ? (ML + b * CTXL + (jt) * 64) : (b * SEQ + ((jt) - nct) * 64))
#define SLOAD(i, jt) do { const int k0_ = KROW(jt); sr_[i].vs0 = ld8(Vb + (size_t)(k0_ + sr) * ldk + sc); sr_[i].vs1 = ld8(Vb + (size_t)(k0_ + 32 + sr) * ldk + sc); \
    sr_[i].ks0 = ld8(Kb + (size_t)(k0_ + sr) * ldk + sc); sr_[i].ks1 = ld8(Kb + (size_t)(k0_ + 32 + sr) * ldk + sc); \
    if (MODE == 0) sr_[i].kr = ld8(KRb + (size_t)(k0_ + rrow) * 64 + (tid & 7) * 8); } while (0)
#define SWRITE(bf, i) do { *(LAS bf16x8*)(V_lds + VOFF(bf) + vst0) = sr_[i].vs0; *(LAS bf16x8*)(V_lds + VOFF(bf) + vst1) = sr_[i].vs1; \
    *(LAS bf16x8*)(K_lds + KOFF(bf) + kst0) = sr_[i].ks0; *(LAS bf16x8*)(K_lds + KOFF(bf) + kst1) = sr_[i].ks1; \
    if (MODE == 0) *(LAS bf16x8*)(K_lds + KOFF(bf) + krs) = sr_[i].kr; } while (0)
#define SWAIT() do { if constexpr (SDEPTH == 2) asm volatile("s_waitcnt vmcnt(4)" ::: "memory"); else asm volatile("s_waitcnt vmcnt(0)" ::: "memory"); } while (0)
#define RESC(a) do { if (__any((a) < 1.f)) { if (hi == 0) al_l[r32] = (a); asm volatile("s_waitcnt lgkmcnt(0)" ::: "memory"); \
    _Pragma("unroll") for (int d = 0; d < NOB; ++d) _Pragma("unroll") for (int r = 0; r < 16; ++r) o[d][r] *= al_l[crow(r, hi)]; } } while (0)
#define PV(vb_) do { if constexpr (ATTV == 2) { o[0][0] += __uint_as_float((unsigned)pa0[0] + (unsigned)pa3[1]); } else if constexpr (PVPIPE) pv_pipe(o, (vb_), pa0, pa1, pa2, pa3); else pv_d0(o, (vb_), pa0, pa1, pa2, pa3); \
    if constexpr (LEAN) { const bf16x8 one8 = {0x3F80, 0x3F80, 0x3F80, 0x3F80, 0x3F80, 0x3F80, 0x3F80, 0x3F80};     \
        o[NOB - 1] = __builtin_amdgcn_mfma_f32_32x32x16_bf16(pa0, one8, o[NOB - 1], 0, 0, 0); o[NOB - 1] = __builtin_amdgcn_mfma_f32_32x32x16_bf16(pa1, one8, o[NOB - 1], 0, 0, 0); \
        o[NOB - 1] = __builtin_amdgcn_mfma_f32_32x32x16_bf16(pa2, one8, o[NOB - 1], 0, 0, 0); o[NOB - 1] = __builtin_amdgcn_mfma_f32_32x32x16_bf16(pa3, one8, o[NOB - 1], 0, 0, 0); } } while (0)
#define PSM(p0_, p1_, mn_, al_, first_) do { if constexpr (ATTV == 1) { al_ = 1.f; } else if constexpr (LEAN) partialSM_lean(p0_, p1_, nm, al_, first_); else partialSM(p0_, p1_, m_reg, mn_, al_, C, THRS); } while (0)
#define FSM(p0_, p1_, al_) do { if constexpr (ATTV == 1) { u32x4 w0_ = {__float_as_uint(p0_[0]), __float_as_uint(p0_[1]), __float_as_uint(p1_[0]), __float_as_uint(p1_[1])}; pa0 = pa1 = pa2 = pa3 = *reinterpret_cast<bf16x8*>(&w0_); } else if constexpr (LEAN) finishSM_lean(p0_, p1_, pa0, pa1, pa2, pa3); else finishSM(p0_, p1_, al_, l_reg, pa0, pa1, pa2, pa3); } while (0)
#define QKT(p0_, p1_, Kp_) do { if constexpr (ATTV == 5) { p0_ = nm; p1_ = nm; p0_[0] += (float)r32; } else if constexpr (LEAN) qkt<NQF, NQR, PITCH>(p0_, p1_, Kp_, chunk0, qr, ql, r32, hi, nm); else qkt<NQF, NQR, PITCH>(p0_, p1_, Kp_, chunk0, qr, ql, r32, hi); } while (0)
  f32x16 pA0, pA1, pB0, pB1; float mnA, mnB, alA, alB; bf16x8 pa0, pa1, pa2, pa3;
  constexpr bool KMAJ = (MODE == 1) && LEAN && ATT_KMAJOR && (ATTV == 0) && !THREE;
  if constexpr (KMAJ) {
    VStep VA, VB;
#define KSTEPS(PC0, PC1, ALC, PP0, PP1, KC, VP, LD, DOQK) do { const int vb_ = vb0 + VOFF(VP); float dmx_ = 0.f; \
      SBAR(); \
      if (DOQK) QKT(PC0, PC1, K_lds + KOFF(KC)); \
      pa0 = pk4e<0>(PP0); trstep<0>(VA, vb_); \
      _Pragma("unroll") for (int i_ = 0; i_ < 8; ++i_) { SGB(0x008, 1); SGB(0x100, 3); SGB(0x002, 2); } \
      SBAR(); LD; SBAR(); \
      mfma5(o, VA, pa0); pa1 = pk4e<8>(PP0); trstep<1>(VB, vb_); \
      _Pragma("unroll") for (int i_ = 0; i_ < 5; ++i_) { SGB(0x008, 1); SGB(0x100, 2); SGB(0x002, 3); } \
      SBAR(); \
      mfma5(o, VB, pa1); pa2 = pk4e<0>(PP1); trstep<2>(VA, vb_); \
      _Pragma("unroll") for (int i_ = 0; i_ < 5; ++i_) { SGB(0x008, 1); SGB(0x100, 2); SGB(0x002, 3); } \
      SBAR(); \
      mfma5(o, VA, pa2); pa3 = pk4e<8>(PP1); trstep<3>(VB, vb_); \
      _Pragma("unroll") for (int i_ = 0; i_ < 5; ++i_) { SGB(0x008, 1); SGB(0x100, 2); SGB(0x002, 3); } \
      SBAR(); \
      mfma5(o, VB, pa3); if (DOQK) dmx_ = rowmax_lean(PC0, PC1); \
      _Pragma("unroll") for (int i_ = 0; i_ < 5; ++i_) { SGB(0x008, 1); SGB(0x002, 7); } \
      SBAR(); \
      if (DOQK) shift_lean(dmx_, PC0, PC1, nm, ALC, false); } while (0)
    SLOAD(0, 0); asm volatile("s_waitcnt vmcnt(0)" ::: "memory"); SWRITE(0, 0); __syncthreads();
    QKT(pA0, pA1, K_lds + KOFF(0)); shift_lean(rowmax_lean(pA0, pA1), pA0, pA1, nm, alA, true);
    SLOAD(0, 1); asm volatile("s_waitcnt vmcnt(0)" ::: "memory"); SWRITE(1, 0); __syncthreads();
    for (int j = 1; j + 1 < NT; j += 2) {
      KSTEPS(pB0, pB1, alB, pA0, pA1, 1, 0, SLOAD(0, j + 1), true);
      __syncthreads(); asm volatile("s_waitcnt vmcnt(0)" ::: "memory"); SWRITE(0, 0);
      RESC(alB); __syncthreads();
      KSTEPS(pA0, pA1, alA, pB0, pB1, 0, 1, SLOAD(0, j + 2), true);
      __syncthreads(); asm volatile("s_waitcnt vmcnt(0)" ::: "memory"); SWRITE(1, 0);
      RESC(alA); __syncthreads();
    }
    KSTEPS(pB0, pB1, alB, pA0, pA1, 1, 0, (void)0, true);
    __syncthreads(); RESC(alB);
    KSTEPS(pA0, pA1, alA, pB0, pB1, 0, 1, (void)0, false);
#undef KSTEPS
  } else if constexpr (!THREE) {
  constexpr int SE = 0, SO = SDEPTH - 1;
  SLOAD(SE, 0); asm volatile("s_waitcnt vmcnt(0)" ::: "memory"); SWRITE(0, SE); __syncthreads();
  QKT(pA0, pA1, K_lds + KOFF(0)); PSM(pA0, pA1, mnA, alA, true);
  SLOAD(SO, 1); if constexpr (SDEPTH == 2) { if (2 < NT) SLOAD(SE, 2); }
  SWAIT(); SWRITE(1, SO); __syncthreads();
#define ILV() do { if constexpr (PVPIPE) { _Pragma("unroll") for (int i_ = 0; i_ < 20; ++i_) { __builtin_amdgcn_sched_group_barrier(0x008, 1, 0); __builtin_amdgcn_sched_group_barrier(0x002, 5, 0); } } } while (0)
#define LSLOAD(i, jt) do { if constexpr (ATTV != 3) SLOAD(i, jt); } while (0)
#define LSWRITE(bf, i) do { if constexpr (ATTV != 3) SWRITE(bf, i); } while (0)
#define LSWAIT() do { if constexpr (ATTV != 3) SWAIT(); } while (0)
#define LSYNC() do { if constexpr (ATTV != 4) __syncthreads(); } while (0)
#define HALFSTEP(PC0, PC1, MNC, ALC, PP0, PP1, ALP, KC, VP, LD) do { \
    if (!STAG || wid < 4) { \
      SBAR(); QKT(PC0, PC1, K_lds + KOFF(KC)); FSM(PP0, PP1, ALP); SBAR(); \
      LD; SBAR(); \
      if constexpr (PVPIPE && LEAN && ATTV == 0) { if constexpr (ATT_TRB) pv_psm_lean_b(o, vb0 + VOFF(VP), pa0, pa1, pa2, pa3, PC0, PC1, nm, ALC); else pv_psm_lean(o, vb0 + VOFF(VP), pa0, pa1, pa2, pa3, PC0, PC1, nm, ALC); } else { PV(vb0 + VOFF(VP)); PSM(PC0, PC1, MNC, ALC, false); } \
    } else { \
      SBAR(); FSM(PP0, PP1, ALP); SBAR(); \
      LD; SBAR(); \
      PV(vb0 + VOFF(VP)); SBAR(); \
      QKT(PC0, PC1, K_lds + KOFF(KC)); SBAR(); \
      PSM(PC0, PC1, MNC, ALC, false); \
    } } while (0)
  constexpr bool STAG = (MODE == 1) && ATT_STAGGER && ATTV == 0;
  for (int j = 1; j + 1 < NT; j += 2) {
    HALFSTEP(pB0, pB1, mnB, alB, pA0, pA1, alA, 1, 0, LSLOAD(SO, j + SDEPTH));
    LSYNC(); LSWAIT(); LSWRITE(0, SE);
    RESC(alB); LSYNC();
    HALFSTEP(pA0, pA1, mnA, alA, pB0, pB1, alB, 0, 1, if (SDEPTH == 1 || j + 3 < NT) LSLOAD(SE, j + 1 + SDEPTH));
    LSYNC(); LSWAIT(); LSWRITE(1, SO);
    RESC(alA); LSYNC();
  }
#undef HALFSTEP
#undef ILV
#undef LSLOAD
#undef LSWRITE
#undef LSWAIT
#undef LSYNC
  SBAR(); QKT(pB0, pB1, K_lds + KOFF(1));
  FSM(pA0, pA1, alA); SBAR();
  PV(vb0); PSM(pB0, pB1, mnB, alB, false);
  __syncthreads(); RESC(alB);
  FSM(pB0, pB1, alB); SBAR();
  PV(vb0 + VOFF(1));
  } else {
#define STEP(PC0, PC1, ALC, PP0, PP1, ALP, jj, SP, SC, SN) do { const int j_ = (jj); \
      if (j_ + 1 < NT) { asm volatile("s_waitcnt vmcnt(0)" ::: "memory"); SWRITE(SN, 0); if (j_ + 2 < NT) SLOAD(0, j_ + 2); } \
      SBAR(); QKT(PC0, PC1, K_lds + KOFF(SC)); FSM(PP0, PP1, ALP); SBAR(); \
      PV(vb0 + VOFF(SP)); PSM(PC0, PC1, mnA, ALC, false); \
      RESC(ALC); __syncthreads(); } while (0)
    SLOAD(0, 0); asm volatile("s_waitcnt vmcnt(0)" ::: "memory"); SWRITE(0, 0);
    SLOAD(0, 1); asm volatile("s_waitcnt vmcnt(0)" ::: "memory"); SWRITE(1, 0);
    SLOAD(0, 2); __syncthreads();
    QKT(pA0, pA1, K_lds + KOFF(0)); PSM(pA0, pA1, mnA, alA, true);
    STEP(pB0, pB1, alB, pA0, pA1, alA, 1, 0, 1, 2);
    int j = 2;
    for (; j + 5 < NT; j += 6) {
      STEP(pA0, pA1, alA, pB0, pB1, alB, j, 1, 2, 0);
      STEP(pB0, pB1, alB, pA0, pA1, alA, j + 1, 2, 0, 1);
      STEP(pA0, pA1, alA, pB0, pB1, alB, j + 2, 0, 1, 2);
      STEP(pB0, pB1, alB, pA0, pA1, alA, j + 3, 1, 2, 0);
      STEP(pA0, pA1, alA, pB0, pB1, alB, j + 4, 2, 0, 1);
      STEP(pB0, pB1, alB, pA0, pA1, alA, j + 5, 0, 1, 2);
    }
    if (j < NT) { STEP(pA0, pA1, alA, pB0, pB1, alB, j, 1, 2, 0); STEP(pB0, pB1, alB, pA0, pA1, alA, j + 1, 2, 0, 1); j += 2; }
    if (j < NT) { STEP(pA0, pA1, alA, pB0, pB1, alB, j, 0, 1, 2); STEP(pB0, pB1, alB, pA0, pA1, alA, j + 1, 1, 2, 0); j += 2; }
    FSM(pB0, pB1, alB); SBAR();
    { const int sl = (NT - 1) % 3; PV(vb0 + VOFF(sl)); }
#undef STEP
  }
  float rli[16];
  if constexpr (LEAN) {
#pragma unroll
    for (int r = 0; r < 16; ++r) rli[r] = __builtin_amdgcn_rcpf(o[NOB - 1][r]);
  } else {
    if (hi == 0) li_l[r32] = l_reg; asm volatile("s_waitcnt lgkmcnt(0)" ::: "memory");
#pragma unroll
    for (int r = 0; r < 16; ++r) rli[r] = __builtin_amdgcn_rcpf(li_l[crow(r, hi)]);
  }
  bf16* Ow = Ob + (size_t)(wq * 32) * DM;
  if constexpr (MODE == 0) {
#pragma unroll
    for (int r = 0; r < 16; ++r) { const int orow = crow(r, hi);
#pragma unroll
      for (int d0 = 0; d0 < 4; ++d0) Ow[(size_t)orow * DM + d0 * 32 + r32] = tobf1(o[d0][r] * rli[r]); }
    __syncthreads();
  } else {
    LAS float* ex = (LAS float*)lds;
    __syncthreads();
    if (sgrp == 1) {
#pragma unroll
      for (int r = 0; r < 16; ++r)
#pragma unroll
        for (int d0 = 0; d0 < 4; ++d0) ex[(wq * 32 + crow(r, hi)) * 128 + d0 * 32 + r32] = o[d0][r] * rli[r];
    }
    __syncthreads();
    if (sgrp == 0) {
#pragma unroll
      for (int r = 0; r < 16; ++r) { const int orow = crow(r, hi); float dd[4]; float ss = 0.f;
#pragma unroll
        for (int d0 = 0; d0 < 4; ++d0) { dd[d0] = o[d0][r] * rli[r] - lam * ex[(wq * 32 + orow) * 128 + d0 * 32 + r32]; ss += dd[d0] * dd[d0]; }
        ss = half_sum32(ss);
        const float rs = oscale / sqrtf(ss * (1.0f / 128.0f) + LN_EPS);
#pragma unroll
        for (int d0 = 0; d0 < 4; ++d0) Ow[(size_t)orow * DM + d0 * 32 + r32] = tobf1(dd[d0] * rs * subln[d0 * 32 + r32]); }
    }
    __syncthreads();
  }
  if (ATT_PRIO) __builtin_amdgcn_s_setprio(0);
#undef VOFF
#undef KOFF
#undef PV
#undef PSM
#undef FSM
#undef QKT
#undef KROW
#undef SLOAD
#undef SWRITE
#undef SWAIT
#undef RESC
}
}

__device__ __forceinline__ void mla_attn_phase(CP P, LAS unsigned char* lds, const int tid) {
    const bf16* QM = (const bf16*)(P->ws + WS_QM); const bf16* KV = (const bf16*)(P->ws + WS_KV); const bf16* KR = (const bf16*)(P->ws + WS_KR); bf16* Gb = (bf16*)(P->ws + WS_G);
    const int c = blockIdx.x, G = gridDim.x;
    for (int u = c; u < 1024 + 32; u += G) {
        int b, h, qrow0, NT;
        if (u < 1024) { const int i = u >> 8, cc = u & 255; const int bh = (cc & 7) + 8 * i, qb = cc >> 3; b = bh >> 4; h = bh & 15; qrow0 = b * SEQ + qb * 256; NT = 4 + 128; }
        else { const int bh = u - 1024; b = bh >> 4; h = bh & 15; qrow0 = ML + b * CTXL; NT = 4; }
        att::attn_unit<0>(QM + (size_t)qrow0 * 3072 + h * 192, 3072, KV + h * 256, KV + h * 256 + 128, 4096, KR, b, 4, NT, Gb + (size_t)qrow0 * DM + h * 128, 0.f, nullptr, 1.f, lds, tid);
    }
}
template <int ATTV = 0>
__device__ __forceinline__ void da_attn_phase(CP P, float lam, float oscale, LAS unsigned char* lds, const int tid, const bool ctx_q) {
    const bf16* Z = (const bf16*)(P->ws + WS_Z); bf16* Gb = (bf16*)(P->ws + WS_G); const float* subln = P->in[27];
    const int c = blockIdx.x, G = gridDim.x;
    for (int u = c; u < 2048 + (ctx_q ? 64 : 0); u += G) {
        int b, h, qrow0, NT;
        if (u < 2048) { const int i = u >> 8, cc = u & 255; const int bh = (cc & 7) + 8 * (i >> 1), qb = (cc >> 3) + 32 * (i & 1); b = bh >> 4; h = bh & 15; qrow0 = b * SEQ + qb * 128; NT = 4 + 128; }
        else { const int v = u - 2048; const int bh = v >> 1; b = bh >> 4; h = bh & 15; qrow0 = ML + b * CTXL + (v & 1) * 128; NT = 4; }
        att::attn_unit<1, ATTV>(Z + (size_t)qrow0 * 6144 + h * 128, 6144, Z + 2048 + h * 128, Z + 4096 + h * 128, 6144, nullptr, b, 4, NT, Gb + (size_t)qrow0 * DM + h * 128, lam, subln, oscale, lds, tid);
    }
}

__device__ __forceinline__ unsigned f2ord(float f) { const unsigned u = __float_as_uint(f); return u ^ ((unsigned)((int)u >> 31) | 0x80000000u); }
__device__ __forceinline__ float ord2f(unsigned k) { return __uint_as_float((k & 0x80000000u) ? (k ^ 0x80000000u) : ~k); }
__device__ __forceinline__ void ce_desc(unsigned& a, unsigned& b) { const unsigned mx = a > b ? a : b, mn = a > b ? b : a; a = mx; b = mn; }
template <int N, bool DESC> __device__ __forceinline__ void bitonic_merge(unsigned* a) {
#pragma unroll
    for (int j = N / 2; j > 0; j >>= 1)
#pragma unroll
        for (int i = 0; i < N; ++i) { const int l = i ^ j; if (l > i) { if (DESC) ce_desc(a[i], a[l]); else ce_desc(a[l], a[i]); } }
}
template <int N, bool DESC> __device__ __forceinline__ void bitonic_sort(unsigned* a) {
#pragma unroll
    for (int k = 2; k <= N; k <<= 1)
#pragma unroll
        for (int j = k >> 1; j > 0; j >>= 1)
#pragma unroll
            for (int i = 0; i < N; ++i) { const int l = i ^ j; if (l > i) { const bool up = ((i & k) == 0); if (up == DESC) ce_desc(a[i], a[l]); else ce_desc(a[l], a[i]); } }
}
__device__ __forceinline__ void top16_of_64(unsigned (&a)[64]) {
    bitonic_sort<16, true>(a); bitonic_sort<16, false>(a + 16); bitonic_sort<16, true>(a + 32); bitonic_sort<16, false>(a + 48);
#pragma unroll
    for (int i = 0; i < 16; ++i) a[i] = a[i] > a[16 + i] ? a[i] : a[16 + i];
    bitonic_merge<16, true>(a);
#pragma unroll
    for (int i = 0; i < 16; ++i) a[32 + i] = a[32 + i] > a[48 + i] ? a[32 + i] : a[48 + i];
    bitonic_merge<16, false>(a + 32);
#pragma unroll
    for (int i = 0; i < 16; ++i) a[i] = a[i] > a[32 + i] ? a[i] : a[32 + i];
    bitonic_merge<16, true>(a);
}
template <int PASS> __device__ __forceinline__ void route_pass(const bf16* QP, const LAS char* lds, int tok, int head, int r32, int hi, unsigned (&top)[16]) {
    f32x16 acc[4] = {};
    const bf16* qp = QP + (size_t)tok * DM + head * 256 + PASS * 128 + hi * 8;
    bf16x8 qf[8];
#pragma unroll
    for (int ks = 0; ks < 8; ++ks) qf[ks] = *(const bf16x8*)(qp + ks * 16);
    const LAS char* Kl = lds + PASS * 32768;
#pragma unroll
    for (int kb = 0; kb < 4; ++kb)
#pragma unroll
        for (int ks = 0; ks < 8; ++ks) { const bf16x8 a = *(const LAS bf16x8*)(Kl + (kb * 32 + r32) * 256 + (((ks * 2 + hi) ^ (r32 & 15)) * 16));
            acc[kb] = __builtin_amdgcn_mfma_f32_32x32x16_bf16(a, qf[ks], acc[kb], 0, 0, 0); }
    unsigned key[64]; const unsigned base = 127u - 4u * (unsigned)hi;
#pragma unroll
    for (int kb = 0; kb < 4; ++kb)
#pragma unroll
        for (int r = 0; r < 16; ++r) key[kb * 16 + r] = (f2ord(acc[kb][r]) & ~127u) | (base - (unsigned)(kb * 32 + (r & 3) + 8 * (r >> 2)));
    top16_of_64(key);
    unsigned pr[16];
#pragma unroll
    for (int i = 0; i < 16; ++i) pr[i] = lane_xor32(key[15 - i], hi << 5);
#pragma unroll
    for (int i = 0; i < 16; ++i) key[i] = key[i] > pr[i] ? key[i] : pr[i];
    bitonic_merge<16, true>(key);
#pragma unroll
    for (int i = 0; i < 16; ++i) top[i] = key[i];
}
#ifndef ROUTE_SORT
#define ROUTE_SORT 1
#endif
#define DPP_U(v, ctrl) ((unsigned)__builtin_amdgcn_mov_dpp((int)(v), (ctrl), 0xF, 0xF, true))
template <int J> __device__ __forceinline__ unsigned lane_xor_u(unsigned v, int lane) {
    if (J == 1) return DPP_U(v, 0xB1);
    if (J == 2) return DPP_U(v, 0x4E);
    if (J == 4) { const unsigned t = DPP_U(v, 0x141); return DPP_U(t, 0x1B); }
    if (J == 8) { const unsigned t = DPP_U(v, 0x140); return DPP_U(t, 0x141); }
    if (J == 16) { const auto r = __builtin_amdgcn_permlane16_swap(v, v, false, false); return (lane & 16) ? r[0] : r[1]; }
    return lane_xor32(v, lane);
}
template <int K, int J> __device__ __forceinline__ void sort128_stage(unsigned& a0, unsigned& a1, int lane) {
    if constexpr (J == 64) { const unsigned mn = a0 < a1 ? a0 : a1, mx = a0 < a1 ? a1 : a0; a0 = mn; a1 = mx; }
    else { const unsigned p0 = lane_xor_u<J>(a0, lane), p1 = lane_xor_u<J>(a1, lane);
        const bool lower = (lane & J) == 0;
        const bool asc0 = (K >= 64) ? true : ((lane & K) == 0), asc1 = (K == 128) ? true : (K == 64 ? false : ((lane & K) == 0));
        const unsigned mn0 = a0 < p0 ? a0 : p0, mx0 = a0 < p0 ? p0 : a0, mn1 = a1 < p1 ? a1 : p1, mx1 = a1 < p1 ? p1 : a1;
        a0 = (lower == asc0) ? mn0 : mx0; a1 = (lower == asc1) ? mn1 : mx1; }
    if constexpr (J > 1) sort128_stage<K, J / 2>(a0, a1, lane);
    else if constexpr (K < 128) sort128_stage<K * 2, K>(a0, a1, lane);
}
__device__ __forceinline__ void sort128_asc(unsigned& a0, unsigned& a1, int lane) { sort128_stage<2, 1>(a0, a1, lane); }
__device__ __forceinline__ void route_phase(CP P, int L, int Mrows, LAS unsigned char* lds_, int tid, int lane, int wid, int gw, int NGW) {
    const bf16* QP = (const bf16*)(P->ws + WS_QP); unsigned* ROUTE = (unsigned*)(P->ws + WS_ROUTE);
    LAS char* lds = (LAS char*)(LAS unsigned char*)lds_;
    __syncthreads();
    {
        const bf16* K1 = (const bf16*)(P->ws + WS_PK1) + (size_t)L * 128 * 128; const bf16* K2 = (const bf16*)(P->ws + WS_PK2) + (size_t)L * 128 * 128;
        for (int c16 = tid; c16 < 2 * 128 * 16; c16 += NWAVES * 64) { const int mat = c16 >> 11, row = (c16 >> 4) & 127, ch = c16 & 15;
            const u32x4 w = *(const u32x4*)((mat ? K2 : K1) + row * 128 + ch * 8);
            *(LAS u32x4*)(lds + mat * 32768 + row * 256 + ((ch ^ (row & 15)) * 16)) = w; }
    }
    __syncthreads();
    LAS unsigned* sc = (LAS unsigned*)(lds + 65536) + wid * 2048;
    const int r32 = lane & 31, hi = lane >> 5;
    for (int item = gw; item < Mrows / 4; item += NGW) {
        const int tok = item * 4 + (r32 >> 3), head = r32 & 7;
        unsigned top0[16], top1[16];
        route_pass<0>(QP, lds, tok, head, r32, hi, top0);
        route_pass<1>(QP, lds, tok, head, r32, hi, top1);
        float v1[16], v2[16];
#pragma unroll
        for (int i = 0; i < 16; ++i) { v1[i] = ord2f(top0[i] & ~127u); v2[i] = ord2f(top1[i] & ~127u);
            sc[i * 64 + lane] = 127u - (top0[i] & 127u); sc[(16 + i) * 64 + lane] = 127u - (top1[i] & 127u); }
        unsigned ck[64]; int n = 0;
#pragma unroll
        for (int i = 0; i < 16; ++i)
#pragma unroll
            for (int j = 0; j < 16; ++j) if ((i + 1) * (j + 1) <= 16) { ck[n] = (f2ord(v1[i] + v2[j]) & ~255u) | (unsigned)(i * 16 + j); ++n; }
#pragma unroll
        for (int i = 50; i < 64; ++i) ck[i] = 0u;
        top16_of_64(ck);
        float ev[16]; float sum = 0.f; const float mx = ord2f(ck[0] & ~255u);
#pragma unroll
        for (int k = 0; k < 16; ++k) { ev[k] = __expf(ord2f(ck[k] & ~255u) - mx); sum += ev[k]; }
        const float inv = 1.0f / sum;
        unsigned ee[16];
#pragma unroll
        for (int k = 0; k < 16; ++k) { const unsigned pc = ck[k] & 255u; const unsigned i1 = sc[(pc >> 4) * 64 + lane], i2 = sc[(16 + (pc & 15u)) * 64 + lane]; ee[k] = i1 * 128u + i2; ev[k] *= inv; }
#if ROUTE_SORT
        { const int tq = r32 >> 3;
#pragma unroll
          for (int k = 0; k < 8; ++k) {
              const unsigned eL = ee[k], eH = ee[k + 8]; const float gL = ev[k], gH = ev[k + 8];
              sc[tq * 256 + head * 16 + hi * 8 + k] = hi ? eH : eL; sc[tq * 256 + 128 + head * 16 + hi * 8 + k] = __float_as_uint(hi ? gH : gL); }
#pragma unroll 1
          for (int t = 0; t < 4; ++t) {
              unsigned a0 = (sc[t * 256 + lane] << 7) | (unsigned)lane, a1 = (sc[t * 256 + 64 + lane] << 7) | (unsigned)(64 + lane);
              sort128_asc(a0, a1, lane);
              const unsigned g0 = sc[t * 256 + 128 + (a0 & 127u)], g1 = sc[t * 256 + 128 + (a1 & 127u)];
              u32x2* outp = (u32x2*)(ROUTE + (size_t)(item * 4 + t) * 256);
              outp[lane] = (u32x2){a0 >> 7, g0}; outp[64 + lane] = (u32x2){a1 >> 7, g1}; }
        }
#else
        u32x4* outp = (u32x4*)(ROUTE + ((size_t)tok * 128 + head * 16 + hi * 8) * 2);
#pragma unroll
        for (int k = 0; k < 8; k += 2) { u32x4 w;
            const unsigned eL0 = ee[k], eH0 = ee[k + 8], eL1 = ee[k + 1], eH1 = ee[k + 9]; const float gL0 = ev[k], gH0 = ev[k + 8], gL1 = ev[k + 1], gH1 = ev[k + 9];
            w.x = hi ? eH0 : eL0; w.y = __float_as_uint(hi ? gH0 : gL0); w.z = hi ? eH1 : eL1; w.w = __float_as_uint(hi ? gH1 : gL1);
            outp[k >> 1] = w; }
#endif
    }
}

typedef float f32x2 __attribute__((ext_vector_type(2)));
typedef float f32x32 __attribute__((ext_vector_type(32)));
typedef unsigned u32x6 __attribute__((ext_vector_type(6)));
typedef __bf16 bf16x32 __attribute__((ext_vector_type(32)));
typedef unsigned u32x16 __attribute__((ext_vector_type(16)));
typedef __bf16 bf16x2_t __attribute__((ext_vector_type(2)));
#ifndef GATHER_EARLY
#define GATHER_EARLY 1
#endif
#ifndef GATHER_PACE
#define GATHER_PACE 0
#endif
#define XB_PACE(j) (XCD_BAR_WORDS + 64 * (j))
constexpr int GS = 6, GSLOT = 2 * PROW;
__device__ __forceinline__ void glds16(const void* gsrc, unsigned lds_dst) { unsigned keep;
  asm volatile("s_mov_b32 %0, m0\n\ts_mov_b32 m0, %2\n\ts_nop 0\n\tglobal_load_lds_dwordx4 %1, off\n\ts_mov_b32 m0, %0" : "=&s"(keep) : "v"(gsrc), "s"(lds_dst) : "memory"); }
template <int GMODE = 0>
__device__ __forceinline__ void gather_phase(CP P, int L, int Mrows, LAS unsigned char* lds, int wid, int lane_, int gw, int NGW, bool dry = false) {
    const unsigned char* UV = P->ws + WS_PU + (size_t)L * 16384 * PREC;
    const unsigned* ROUTE = (const unsigned*)(P->ws + WS_ROUTE); const float* MOD = (const float*)(P->ws + WS_MOD);
    bf16* X = (bf16*)(P->ws + WS_X); bf16* H = (bf16*)(P->ws + WS_H); bf16* Xo = dry ? (bf16*)(P->ws + WS_Y) : X; bf16* Ho = dry ? (bf16*)(P->ws + WS_G) : H;
    const float* lng = P->in[6] + (size_t)(L * 2 + 1) * DM; const float* lnb = P->in[7] + (size_t)(L * 2 + 1) * DM;
    const unsigned ring = (unsigned)(uintptr_t)lds + (unsigned)wid * (GS * GSLOT);
    const int nfull = (Mrows / NGW) * NGW, rem = Mrows - nfull; const bool can_coop = (rem * 4 == NGW);
    const int nround = nfull / NGW + (rem > 0 ? 1 : 0);
    const bool pace_ok = (rem == 0) || can_coop;
#define G_ROWOF(it_) ((can_coop && (it_) == nround - 1) ? (nfull + (int)blockIdx.x * 2 + (wid >> 2)) : (gw + (it_) * NGW))
    u32x2 nea = {0u, 0u}, neb = {0u, 0u}; u32x4 nh0 = {0u, 0u, 0u, 0u}, nh1 = nh0, nh2 = nh0, nh3 = nh0;
#define G_PREFETCH(rowN_, ln_) do { const int rn_ = (rowN_); nea = ((const u32x2*)(ROUTE + (size_t)rn_ * 256))[ln_]; neb = ((const u32x2*)(ROUTE + (size_t)rn_ * 256))[64 + (ln_)]; \
        const u32x4* hp_ = (const u32x4*)(H + (size_t)rn_ * DM) + 4 * (ln_); nh0 = hp_[0]; nh1 = hp_[1]; nh2 = hp_[2]; nh3 = hp_[3]; } while (0)
    if (nround > 0 && G_ROWOF(0) < Mrows) G_PREFETCH(G_ROWOF(0), launder_v(lane_));
#pragma unroll 1
    for (int it = 0; it < nround; ++it) {
#if GATHER_PACE
        if (pace_ok && it > 0) {
            if (wid == 0 && lane_ == 0) { const unsigned nloc = ((volatile LAS unsigned*)(lds + MISC_OFF))[8];
                if (nloc != 0u) { unsigned* pc = (unsigned*)(P->ws + WS_CTL) + CW_BAR + XB_PACE(xb_xcc_id());
                    const unsigned old = xb_add(pc, 1u), tgt = (old / nloc + 1u) * nloc; unsigned sp = 0u;
                    while ((int)(xb_ld(pc) - tgt) < 0 && ++sp < 20000u) __builtin_amdgcn_s_sleep(1); } }
            __syncthreads();
        }
#endif
        const bool coop = can_coop && (it == nround - 1);
        int row = G_ROWOF(it), k0 = 0, kn = 128;
        if (coop) { k0 = (wid & 3) * 32; kn = k0 + 32; }
        else if (row >= Mrows) break;
        const int lane = launder_v(lane_);
        const u32x2 ea = nea, eb = neb;
        unsigned eax, eay, ebx, eby;
        unsigned hw[16] = {nh0.x, nh0.y, nh0.z, nh0.w, nh1.x, nh1.y, nh1.z, nh1.w, nh2.x, nh2.y, nh2.z, nh2.w, nh3.x, nh3.y, nh3.z, nh3.w};
        float y[32];
#pragma unroll
        for (int i = 0; i < 32; ++i) y[i] = 0.f;
        { unsigned e0 = ea.x, e1 = ea.y, e2 = eb.x, e3 = eb.y;
          asm volatile("" : "+v"(e0), "+v"(e1), "+v"(e2), "+v"(e3), "+v"(hw[0]), "+v"(hw[1]), "+v"(hw[2]), "+v"(hw[3]), "+v"(hw[4]), "+v"(hw[5]), "+v"(hw[6]), "+v"(hw[7]),
                       "+v"(hw[8]), "+v"(hw[9]), "+v"(hw[10]), "+v"(hw[11]), "+v"(hw[12]), "+v"(hw[13]), "+v"(hw[14]), "+v"(hw[15]) :: "memory");
          eax = e0; eay = e1; ebx = e2; eby = e3; }
        const unsigned rd_a = ring + 16u * (unsigned)lane, rd_b = ring + 2048u + 8u * (unsigned)lane;
#define G_ISSUE(k) do { const int k_ = (k); const unsigned e_ = (unsigned)__builtin_amdgcn_readlane((int)(k_ < 64 ? eax : ebx), k_ & 63); \
        const unsigned char* rp_ = UV + (size_t)e_ * PREC + 16 * lane; const unsigned sb_ = ring + (unsigned)(k_ % GS) * GSLOT; \
        if (GMODE == 3) { glds16(rp_, sb_); if (lane < 32) glds16(rp_ + 2048, sb_ + 2048); } \
        else if (GMODE != 2) { glds16(rp_, sb_); glds16(rp_ + 1024, sb_ + 1024); glds16(rp_ + 2048, sb_ + 2048); } else { asm volatile("" :: "v"(rp_), "s"(sb_)); } } while (0)
#if GATHER_EARLY
        if (it + 1 < nround && G_ROWOF(it + 1) < Mrows) G_PREFETCH(G_ROWOF(it + 1), lane);
#pragma unroll
        for (int k = 0; k < 6; ++k) G_ISSUE(k0 + k);
#else
#pragma unroll
        for (int k = 0; k < 4; ++k) G_ISSUE(k0 + k);
        if (it + 1 < nround && G_ROWOF(it + 1) < Mrows) G_PREFETCH(G_ROWOF(it + 1), lane);
#endif
#define G_READ(k, ua, ub, va, vb) do { const unsigned so_ = (unsigned)((k) % GS) * GSLOT; \
        asm volatile("ds_read_b128 %0, %4\n\tds_read_b64 %1, %5\n\tds_read_b128 %2, %4 offset:1024\n\tds_read_b64 %3, %5 offset:512" \
                     : "=&v"(ua), "=&v"(ub), "=&v"(va), "=&v"(vb) : "v"(rd_a + so_), "v"(rd_b + so_) : "memory"); } while (0)
#pragma unroll 1
        for (int k = k0; k < kn; k += 2) {
            if (k + 4 < kn) { if (!GATHER_EARLY) { G_ISSUE(k + 4); G_ISSUE(k + 5); } if (GMODE == 3) asm volatile("s_waitcnt vmcnt(8)" ::: "memory"); else asm volatile("s_waitcnt vmcnt(12)" ::: "memory"); }
            else if (k == kn - 4) { if (GMODE == 3) asm volatile("s_waitcnt vmcnt(4)" ::: "memory"); else asm volatile("s_waitcnt vmcnt(6)" ::: "memory"); }
            else asm volatile("s_waitcnt vmcnt(0)" ::: "memory");
            u32x4 uaA, vaA, uaB, vaB; u32x2 ubA, vbA, ubB, vbB;
            G_READ(k, uaA, ubA, vaA, vbA); G_READ(k + 1, uaB, ubB, vaB, vbB);
            asm volatile("s_waitcnt lgkmcnt(0)" : "+v"(uaA), "+v"(ubA), "+v"(vaA), "+v"(vbA), "+v"(uaB), "+v"(ubB), "+v"(vaB), "+v"(vbB) :: "memory");
            if (GATHER_EARLY && k + 6 < kn) { G_ISSUE(k + 6); G_ISSUE(k + 7); }
            if (GMODE == 1 || GMODE == 3) continue;
            const u32x6 u6A = {uaA.x, uaA.y, uaA.z, uaA.w, ubA.x, ubA.y}, u6B = {uaB.x, uaB.y, uaB.z, uaB.w, ubB.x, ubB.y};
            const u32x16 ubfA = __builtin_bit_cast(u32x16, __builtin_amdgcn_cvt_scalef32_pk32_bf16_fp6(u6A, 1.0f));
            const u32x16 ubfB = __builtin_bit_cast(u32x16, __builtin_amdgcn_cvt_scalef32_pk32_bf16_fp6(u6B, 1.0f));
            float a0 = 0.f, a1 = 0.f, b0 = 0.f, b1 = 0.f;
#pragma unroll
            for (int q = 0; q < 16; q += 2) { const unsigned h0_ = hw[q], h1_ = hw[q + 1], x0_ = ubfA[q], x1_ = ubfA[q + 1], z0_ = ubfB[q], z1_ = ubfB[q + 1];
                a0 = __builtin_amdgcn_fdot2_f32_bf16(__builtin_bit_cast(bf16x2_t, h0_), __builtin_bit_cast(bf16x2_t, x0_), a0, false);
                a1 = __builtin_amdgcn_fdot2_f32_bf16(__builtin_bit_cast(bf16x2_t, h1_), __builtin_bit_cast(bf16x2_t, x1_), a1, false);
                b0 = __builtin_amdgcn_fdot2_f32_bf16(__builtin_bit_cast(bf16x2_t, h0_), __builtin_bit_cast(bf16x2_t, z0_), b0, false);
                b1 = __builtin_amdgcn_fdot2_f32_bf16(__builtin_bit_cast(bf16x2_t, h1_), __builtin_bit_cast(bf16x2_t, z1_), b1, false); }
            const float dA = wave_sum(a0 + a1) * (1.0f / U_SCALE), dB = wave_sum(b0 + b1) * (1.0f / U_SCALE);
            const unsigned gsel = k < 64 ? eay : eby;
            const float wA = __uint_as_float((unsigned)__builtin_amdgcn_readlane((int)gsel, k & 63)) * gelu_tanh(dA) * (1.0f / V_SCALE);
            const float wB = __uint_as_float((unsigned)__builtin_amdgcn_readlane((int)gsel, (k & 63) + 1)) * gelu_tanh(dB) * (1.0f / V_SCALE);
            const u32x6 v6A = {vaA.x, vaA.y, vaA.z, vaA.w, vbA.x, vbA.y};
            const f32x32 vfA = __builtin_amdgcn_cvt_scalef32_pk32_f32_fp6(v6A, 1.0f);
#pragma unroll
            for (int i = 0; i < 32; ++i) y[i] += wA * vfA[i];
            const u32x6 v6B = {vaB.x, vaB.y, vaB.z, vaB.w, vbB.x, vbB.y};
            const f32x32 vfB = __builtin_amdgcn_cvt_scalef32_pk32_f32_fp6(v6B, 1.0f);
#pragma unroll
            for (int i = 0; i < 32; ++i) y[i] += wB * vfB[i];
        }
#undef G_READ
#undef G_ISSUE
        if (coop) {
            LAS f32x4* mine = (LAS f32x4*)(lds + wid * (GS * GSLOT)) + lane * 8;
#pragma unroll
            for (int i = 0; i < 8; ++i) mine[i] = (f32x4){y[4 * i], y[4 * i + 1], y[4 * i + 2], y[4 * i + 3]};
            __syncthreads();
            if ((wid & 3) == 0) {
#pragma unroll
                for (int j = 1; j < 4; ++j) { const LAS f32x4* oth = (const LAS f32x4*)(lds + (wid + j) * (GS * GSLOT)) + lane * 8;
#pragma unroll
                    for (int i = 0; i < 8; ++i) { const f32x4 t = oth[i]; y[4 * i] += t.x; y[4 * i + 1] += t.y; y[4 * i + 2] += t.z; y[4 * i + 3] += t.w; } }
            }
            __syncthreads();
            if ((wid & 3) != 0) continue;
        }
        const int slot = row_slot(row);
        const float* mod = MOD + (size_t)(L * 3 + slot) * 12288;
        const int le = launder_v(lane);
        { float xx[32], gg[32]; load_row_bf16_b(X + (size_t)row * DM, le, xx); load_row_f32_b(mod + 5 * 2048, le, gg);
#pragma unroll
          for (int i = 0; i < 32; ++i) y[i] = ALPHA * xx[i] + gg[i] * y[i]; }
        if (L < NLAYER - 1) { const float* modn = MOD + (size_t)((L + 1) * 3 + slot) * 12288;
            finish_row<true>(y, lng, lnb, Xo + (size_t)row * DM, modn, modn + 2048, Ho + (size_t)row * DM, nullptr, le); }
        else finish_row<true>(y, lng, lnb, nullptr, nullptr, nullptr, nullptr, P->out + (size_t)row * DM, le);
        asm volatile("s_waitcnt vmcnt(0)" ::: "memory");
    }
#undef G_PREFETCH
#undef G_ROWOF
}

#ifndef ROPE_TEST
#define ROPE_TEST 0
#endif
#ifndef PROBE_DUP
#define PROBE_DUP 0
#endif
#define NOINL __forceinline__
__device__ __forceinline__ CP launder_cp(CP p) { asm volatile("" : "+s"(p)); return p; }
#define GETP() launder_cp((CP)__builtin_amdgcn_kernarg_segment_ptr())
__device__ __forceinline__ int uni(int v) { return __builtin_amdgcn_readfirstlane(v); }
__device__ __forceinline__ LAS unsigned char* uni_lds(LAS unsigned char* p) { return (LAS unsigned char*)(unsigned)__builtin_amdgcn_readfirstlane((int)(unsigned)(uintptr_t)p); }
#define PH_IDS const int wid = uni(wv_), lane = launder_v(lane_id_fresh()) & 63, tid = (wid & 7) * 64 + lane; const int gw = blockIdx.x * NWAVES + wid, NGW = gridDim.x * NWAVES; (void)lane; (void)gw; (void)NGW; (void)tid;

__device__ NOINL void ph_prologue(int wv_, LAS unsigned char* lds_) { CP P = GETP(); LAS unsigned char* lds = uni_lds(lds_); PH_IDS p0_prologue(P, lds, tid, lane, wid, gw, NGW); if (PROBE_DUP == 5) p0_prologue(P, lds, tid, lane, wid, gw, NGW);
    if (PROBE_DUP >= 21 && PROBE_DUP <= 23) { __syncthreads(); p0_prologue(P, lds, tid, lane, wid, gw, NGW, 1 << (PROBE_DUP - 21 < 0 ? 0 : (PROBE_DUP - 21) & 3)); } }
__device__ NOINL void ph_modreduce(int wv_) { CP P = GETP(); PH_IDS mod_reduce(P, gw, lane, NGW); }
__device__ NOINL void ph_first(int wv_) { CP P = GETP(); PH_IDS
#pragma unroll 1
    for (int rep = 0; rep < (PROBE_DUP == 6 ? 2 : 1); ++rep) first_row_pass(P, lane, gw, NGW); }
__device__ NOINL void ph_postmix(int wv_, int L_, int M_) { CP P = GETP(); const int L = uni(L_), Mrows = uni(M_); PH_IDS post_mixer_pass(P, L, Mrows, lane, gw, NGW); }
__device__ NOINL void ph_vstats(int wv_, int M_) { CP P = GETP(); const int Mrows = uni(M_); PH_IDS
#pragma unroll 1
    for (int rep = 0; rep < (PROBE_DUP == 6 ? 2 : 1); ++rep) vstats_pass(P, Mrows, lane, gw, NGW); }
__device__ NOINL void ph_spatial(int wv_, LAS unsigned char* lds_, int j_, int M_) { CP P = GETP(); LAS unsigned char* lds = uni_lds(lds_); const int j = uni(j_), Mrows = uni(M_); PH_IDS
#pragma unroll 1
    for (int rep = 0; rep < (PROBE_DUP == 6 ? 2 : 1); ++rep) spatial_phase(P, j, Mrows, lds, tid, lane, wid); }
__device__ NOINL void ph_mla_norm(int wv_) { CP P = GETP(); PH_IDS
#pragma unroll 1
    for (int rep = 0; rep < (PROBE_DUP == 6 ? 2 : 1); ++rep) mla_norm_pass(P, lane, gw, NGW); }
__device__ NOINL void ph_rope(int wv_, int which_) { CP P = GETP(); const int which = uni(which_); PH_IDS
    if (which == 0) rope_pass((bf16*)(P->ws + WS_QM), 3072, 128, 16, 192, lane, gw, NGW);
    else rope_pass((bf16*)(P->ws + WS_Z), 6144, 0, 64, 64, lane, gw, NGW); }
__device__ NOINL void ph_attn_mla(int wv_, LAS unsigned char* lds_) { CP P = GETP(); LAS unsigned char* lds = uni_lds(lds_); PH_IDS mla_attn_phase(P, lds, tid); if (PROBE_DUP == 2 || PROBE_DUP == 9) mla_attn_phase(P, lds, tid); }
__device__ NOINL void ph_attn_da(int wv_, LAS unsigned char* lds_, int L_, bool ctx_q) { CP P = GETP(); LAS unsigned char* lds = uni_lds(lds_); const int L = uni(L_); PH_IDS
    const float* lp = P->in[26];
    const float s01 = wave_sum(lp[lane] * lp[64 + lane]), s23 = wave_sum(lp[128 + lane] * lp[192 + lane]);
    const float lam_init = 0.8f - 0.6f * expf(-0.3f * (float)L);
    const float lam = expf(s01) - expf(s23) + lam_init;
    if (!(PROBE_DUP >= 11 && PROBE_DUP <= 15)) da_attn_phase(P, lam, 1.0f - lam_init, lds, tid, ctx_q);
    if (PROBE_DUP == 2 || PROBE_DUP == 10) da_attn_phase(P, lam, 1.0f - lam_init, lds, tid, ctx_q);
    if (PROBE_DUP >= 11 && PROBE_DUP <= 15) { da_attn_phase<PROBE_DUP >= 11 && PROBE_DUP <= 15 ? PROBE_DUP - 10 : 0>(P, lam, 1.0f - lam_init, lds, tid, ctx_q); __syncthreads(); }
    if (PROBE_DUP >= 11 && PROBE_DUP <= 15) da_attn_phase(P, lam, 1.0f - lam_init, lds, tid, ctx_q); }
__device__ NOINL void ph_route(int wv_, LAS unsigned char* lds_, int L_, int M_) { CP P = GETP(); LAS unsigned char* lds = uni_lds(lds_); const int L = uni(L_), Mrows = uni(M_); PH_IDS
#pragma unroll 1
    for (int rep = 0; rep < (PROBE_DUP == 4 ? 2 : 1); ++rep) route_phase(P, L, Mrows, lds, tid, lane, wid, gw, NGW); }
__device__ NOINL void ph_gather(int wv_, LAS unsigned char* lds_, int L_, int M_) { CP P = GETP(); LAS unsigned char* lds = uni_lds(lds_); const int L = uni(L_), Mrows = uni(M_); PH_IDS
    if (PROBE_DUP == 3) { gather_phase<0>(P, L, Mrows, lds, wid, lane, gw, NGW, true); }
    if (PROBE_DUP == 7) { gather_phase<1>(P, L, Mrows, lds, wid, lane, gw, NGW, true); }
    if (PROBE_DUP == 17) { gather_phase<3>(P, L, Mrows, lds, wid, lane, gw, NGW, true); }
    if (PROBE_DUP == 8) { gather_phase<2>(P, L, Mrows, lds, wid, lane, gw, NGW, true); }
    gather_phase<0>(P, L, Mrows, lds, wid, lane, gw, NGW); }

enum GemmId { G_GM_IN = 0, G_GM_OUT, G_MLA_IN, G_MLA_UQ, G_MLA_UKV, G_MLA_OUT, G_DA_IN, G_DA_OUT, G_PEER_Q };
__device__ NOINL void ph_gemm(int wv_, LAS unsigned char* lds_, int id_, int L_, int M_) {
    CP P = GETP(); LAS unsigned char* lds = uni_lds(lds_); const int id = uni(id_), L = uni(L_), Mrows = uni(M_); PH_IDS
    unsigned char* ws = P->ws; const int jj = L / 3;
    size_t a = WS_H, b = 0, o = 0; int M = MT, N = 2048, K = 2048, act = 0, rope = 0;
    switch (id) {
        case G_GM_IN:   a = WS_H;    b = WS_GMWIN + (size_t)jj * 4096 * 2048 * 2;  o = WS_Z;  M = Mrows; N = 4096; K = 2048; act = 1; break;
        case G_GM_OUT:  a = WS_G;    b = WS_GMWOUT + (size_t)jj * 2048 * 2048 * 2; o = WS_Y;  M = Mrows; N = 2048; K = 2048; break;
        case G_MLA_IN:  a = WS_H;    b = WS_MLAIN;  o = WS_C;  N = 1280; K = 2048; break;
        case G_MLA_UQ:  a = WS_CQN;  b = WS_MLAUQ;  o = WS_QM; N = 3072; K = 512;  rope = (ROPE_TEST == 2) ? 0 : 2; break;
        case G_MLA_UKV: a = WS_CKVN; b = WS_MLAUKV; o = WS_KV; N = 4096; K = 512;  break;
        case G_MLA_OUT: a = WS_G;    b = WS_MLAOUT; o = WS_Y;  N = 2048; K = 2048; break;
        case G_DA_IN:   a = WS_H;    b = WS_DAIN;   o = WS_Z;  N = 6144; K = 2048; rope = (ROPE_TEST == 1) ? 0 : 1; break;
        case G_DA_OUT:  a = WS_G;    b = WS_DAOUT;  o = WS_Y;  M = Mrows; N = 2048; K = 2048; break;
        default:        a = WS_H;    b = WS_PWQ + (size_t)L * 2048 * 2048 * 2;     o = WS_QP; M = Mrows; N = 2048; K = 2048; break;
    }
    pg8::Gemm g{(const pg8::bf16_t*)(ws + a), (const pg8::bf16_t*)(ws + b), M, N, K}; pg8::StaticOrder S; S.init(M, N, (int)gridDim.x, (int)blockIdx.x);
    pg8::EpiR E{(pg8::bf16_t*)(ws + o), N, act, rope, (const float*)(ws + WS_ROPE)};
#pragma unroll 1
    for (int rep = 0; rep < (PROBE_DUP == 1 ? 2 : 1); ++rep) { pg8::gemm_phase<pg8::EpiR, pg8::StaticOrder, true, true>((PG8_LAS unsigned char*)lds, g, S, E, tid); __syncthreads(); }
#if TAIL_REMAP
    int TL = -1; bool tail_u = false;
    if (L == 0) { if (id == G_GM_IN) { TL = 0; tail_u = true; } else if (id == G_GM_OUT) { TL = 0; } else if (id == G_PEER_Q) { TL = 1; tail_u = true; } }
    else if (L == 1) { if (id == G_MLA_IN) { TL = 1; } else if (id == G_MLA_OUT) { TL = 2; tail_u = true; } else if (id == G_PEER_Q) { TL = 2; } }
    else if (L == 2) { if (id == G_DA_IN) { TL = 3; tail_u = true; } else if (id == G_DA_OUT) { TL = 3; } }
    if (TL >= 0) {
        const int units = (M / 256) * (N / 256), G = (int)gridDim.x, tail = units % G, c = (int)blockIdx.x;
        const float* src = (tail_u ? P->in[11] : P->in[12]) + (size_t)TL * 16384 * 2048; unsigned char* dst = ws + WS_PU + (size_t)TL * 16384 * PREC;
#else
    const bool tail_u = (id == G_GM_OUT || id == G_MLA_OUT || id == G_DA_OUT), tail_v = (id == G_PEER_Q);
    if ((tail_u || tail_v) && L + 1 < NLAYER) {
        const int units = (M / 256) * (N / 256), G = (int)gridDim.x, tail = units % G, c = (int)blockIdx.x;
        const float* src = (tail_u ? P->in[11] : P->in[12]) + (size_t)(L + 1) * 16384 * 2048; unsigned char* dst = ws + WS_PU + (size_t)(L + 1) * 16384 * PREC;
#endif
        LAS float* scr = (LAS float*)(lds + wid * 16384);
        if (tail != 0 && c >= tail) cvt_table_fp6(src, dst, 16384, tail_u ? U_SCALE : V_SCALE, scr, lane, (c - tail) * NWAVES + wid, (G - tail) * NWAVES, tail_u ? 0 : 1);
        else if (tail == 0) {
#pragma unroll 1
            for (int rep = 0; rep < (PROBE_DUP == 18 ? 3 : 1); ++rep) cvt_table_fp6(src, dst, 16384, tail_u ? U_SCALE : V_SCALE, scr, lane, gw, NGW, tail_u ? 0 : 1); }
    }
}

__global__ void __launch_bounds__(NWAVES * 64, 2) mk_fwd(Params Pv) {
    extern __shared__ __attribute__((aligned(16))) unsigned char lds_g[];
    LAS unsigned char* lds = (LAS unsigned char*)lds_g;
    const int wv = __builtin_amdgcn_readfirstlane((int)threadIdx.x >> 6);
    const int tid = wv * 64 + lane_id_fresh();
    for (int u = tid; u < (LDS_BYTES - RING_BYTES) / 4; u += NWAVES * 64) ((LAS unsigned*)(lds + RING_BYTES))[u] = 0u;
    __syncthreads();
    const int lo = Pv.ph_lo, hi = Pv.ph_hi;
    unsigned* barw = (unsigned*)(Pv.ws + WS_CTL) + CW_BAR;
    XcdBarrier bar; bar.bar = barw; bar.x = 0; bar.st = nullptr;
    if (hi - lo > 1) bar = xcd_barrier_post(barw, (volatile LAS unsigned*)(lds + MISC_OFF) + 8, tid == 0);
    int ph = 0;
#ifndef SEL
#define SELP(k) true
#else
#define SELP(k) ((k) == SEL)
#endif
    enum { RUN_BASE = __COUNTER__ + 1 };
#define RUN(call) do { if (SELP(__COUNTER__ - RUN_BASE) && ph >= lo && ph < hi) { call; } if (ph >= lo && ph + 1 < hi) xcd_barrier(bar, wv == 0 && lane_id_fresh() == 0); ++ph; } while (0)
    RUN(ph_prologue(wv, lds));
    RUN(ph_modreduce(wv));
    RUN(ph_first(wv));
#define LAYER(LL) do { constexpr int L = (LL); constexpr int kind = L % 3, jj = L / 3; constexpr int Mrows = (L == NLAYER - 1) ? ML : MT; \
        constexpr bool ctx_dead = (L == NLAYER - 2) && ((NLAYER - 1) % 3 == 0) && (kind != 0); constexpr int Mlive = ctx_dead ? ML : Mrows; \
        if (kind == 0) {                          \
            RUN(ph_gemm(wv, lds, G_GM_IN, L, Mrows)); \
            RUN(ph_vstats(wv, Mrows)); \
            RUN(ph_spatial(wv, lds, jj, Mrows)); \
            RUN(ph_gemm(wv, lds, G_GM_OUT, L, Mrows)); \
        } else if (kind == 1) {                   \
            RUN(ph_gemm(wv, lds, G_MLA_IN, L, Mrows)); \
            RUN(ph_mla_norm(wv)); \
            RUN(ph_gemm(wv, lds, G_MLA_UQ, L, Mrows); ph_gemm(wv, lds, G_MLA_UKV, L, Mrows)); \
            if (ROPE_TEST == 2) { RUN(ph_rope(wv, 0)); } \
            RUN(ph_attn_mla(wv, lds)); \
            RUN(ph_gemm(wv, lds, G_MLA_OUT, L, Mrows)); \
        } else {                                  \
            RUN(ph_gemm(wv, lds, G_DA_IN, L, Mrows); if (ROPE_TEST == 1) { __syncthreads(); } ); \
            if (ROPE_TEST == 1) { RUN(ph_rope(wv, 1)); } \
            RUN(ph_attn_da(wv, lds, L, !ctx_dead)); \
            RUN(ph_gemm(wv, lds, G_DA_OUT, L, Mlive)); \
        } \
        RUN(ph_postmix(wv, L, Mlive));                \
        RUN(ph_gemm(wv, lds, G_PEER_Q, L, Mlive));    \
        RUN(ph_route(wv, lds, L, Mlive));             \
        RUN(ph_gather(wv, lds, L, Mlive));            \
    } while (0)
    LAYER(0); LAYER(1); LAYER(2); LAYER(3);
#undef LAYER
#undef RUN
}

extern "C" void kernel_launch(void* const* d_in, const int* in_sizes, int n_in, void* d_out, int out_size, void* d_ws, size_t ws_size, hipStream_t stream) {
    static int grid = 0;
    if (grid == 0) {
        if (n_in != 29 || in_sizes[0] != ML * DM || out_size != ML * DM || ws_size < WS_END) {
            fprintf(stderr, "kernel_launch: shape mismatch: n_in %d in0 %d out %d ws %zu (need %zu); nothing launched\n", n_in, n_in > 0 ? in_sizes[0] : -1, out_size, ws_size, (size_t)WS_END); grid = -1; return; }
        int dev = 0, cus = 0, per_cu = 0;
        if (hipGetDevice(&dev) != hipSuccess || hipDeviceGetAttribute(&cus, hipDeviceAttributeMultiprocessorCount, dev) != hipSuccess) { fprintf(stderr, "kernel_launch: device query failed\n"); grid = -1; return; }
        if (hipFuncSetAttribute((const void*)mk_fwd, hipFuncAttributeMaxDynamicSharedMemorySize, LDS_BYTES) != hipSuccess) { fprintf(stderr, "kernel_launch: hipFuncSetAttribute failed\n"); grid = -1; return; }
        if (hipOccupancyMaxActiveBlocksPerMultiprocessor(&per_cu, (const void*)mk_fwd, NWAVES * 64, LDS_BYTES) != hipSuccess || per_cu < 1)
            fprintf(stderr, "kernel_launch: note: occupancy query reports %d workgroups per CU\n", per_cu);
        (void)hipGetLastError();
        grid = cus;
    }
    if (grid < 0) return;
    if (hipMemsetAsync((char*)d_ws + WS_CTL, 0, CTL_ZERO_BYTES, stream) != hipSuccess) { fprintf(stderr, "kernel_launch: memset failed\n"); return; }
    Params p{};
    for (int i = 0; i < 29; ++i) p.in[i] = (const float*)d_in[i];
    p.out = (float*)d_out; p.ws = (unsigned char*)d_ws;
#if MK_ONE_LAUNCH
    p.ph_lo = 0; p.ph_hi = NPH;
    hipLaunchKernelGGL(mk_fwd, dim3(grid), dim3(NWAVES * 64), LDS_BYTES, stream, p);
#else
    for (int li = 0; li < NPH; ++li) { p.ph_lo = li; p.ph_hi = li + 1; hipLaunchKernelGGL(mk_fwd, dim3(grid), dim3(NWAVES * 64), LDS_BYTES, stream, p); }
#endif
    const hipError_t le = hipPeekAtLastError();
    if (le != hipSuccess) fprintf(stderr, "kernel_launch: launch failed: %s\n", hipGetErrorName(le));
}
```

```cpp
#include <hip/hip_runtime.h>
#include <cstdio>
#include <cstdint>
#ifndef MK_ONE_LAUNCH
#define MK_ONE_LAUNCH 1
#endif
__device__ __forceinline__ int launder_v(int v) { asm volatile("" : "+v"(v)); return v; }
__device__ __forceinline__ int lane_id_fresh() { unsigned m = ~0u; asm volatile("" : "+s"(m)); return (int)__builtin_amdgcn_mbcnt_hi(m, __builtin_amdgcn_mbcnt_lo(m, 0u)); }
namespace pg8 {
#define PG8_LAS __attribute__((address_space(3)))
typedef unsigned short bf16_t;
typedef short bf16x8 __attribute__((ext_vector_type(8)));
typedef float f32x4 __attribute__((ext_vector_type(4)));
typedef unsigned u32x4 __attribute__((ext_vector_type(4)));
constexpr int BM = 256, BK = 64, HALF = 128, HTB = HALF * BK * 2  , STAGE_BYTES = 8 * HTB, NXCD = 8, WGM = 8;

__host__ __device__ __forceinline__ int lds_byte(int r, int c) { const int st = (r >> 4) * 2 + (c >> 5), rr = r & 15, cc = c & 31, ob = rr * 64 + cc * 2; return st * 1024 + (ob ^ (((ob >> 9) & 1) << 5)); }
__host__ __device__ __forceinline__ void stage_rc(int b, int& R, int& C) { const int st = b / 1024, sb = b % 1024, swz = sb ^ (((sb >> 9) & 1) << 5); R = (st >> 1) * 16 + swz / 64; C = (st & 1) * 32 + (swz % 64) / 2; }
__host__ __device__ __forceinline__ int perm32(int rho) { const int n = rho >> 4, i = rho & 15; return 8 * (i >> 2) + 4 * n + (i & 3); }

struct Unit { int pm, pn; };
struct Gemm { const bf16_t* A; const bf16_t* Bt; int M, N, K; };

struct StaticOrder {
    int nM, nN, nwg, G, c;
    __host__ __device__ void init(int M, int N, int G_, int c_) { nM = M / BM; nN = N / BM; nwg = nM * nN; G = G_; c = c_; }
    __host__ __device__ bool next(int i, Unit& u) const {
        const long L = (long)i * G + c; if (L >= nwg) return false;
        int wgid = (int)L; { const int q = nwg / NXCD, r = nwg % NXCD, xcd = wgid % NXCD, off = wgid / NXCD; wgid = (xcd < r ? xcd * (q + 1) : r * (q + 1) + (xcd - r) * q) + off; }
        const int nig = WGM * nN, gid = wgid / nig, fm = gid * WGM, gsz = (nM - fm) < WGM ? (nM - fm) : WGM;
        u.pm = fm + ((wgid % nig) % gsz); u.pn = (wgid % nig) / gsz; return true;
    }
    __device__ __forceinline__ void a_ready(const Unit&) const {}
    __device__ __forceinline__ void done(const Unit&) const {}
};

__device__ __forceinline__ unsigned cvt_pk_bf16(float lo, float hi) { unsigned r; asm volatile("v_cvt_pk_bf16_f32 %0, %1, %2" : "=v"(r) : "v"(lo), "v"(hi)); return r; }
typedef float f32x2 __attribute__((ext_vector_type(2)));
__device__ __forceinline__ f32x2 gelu_pk(f32x2 v) {
    const f32x2 av = __builtin_elementwise_abs(v), d = av * 0.2316418882f + 1.0f;
    f32x2 t; t.x = __builtin_amdgcn_rcpf(d.x); t.y = __builtin_amdgcn_rcpf(d.y);
    f32x2 q = t * 0.5307027145f + (-0.7265760135f); q = q * t + 0.7107068705f; q = q * t + (-0.142248368f); q = q * t + 0.127414796f; q = q * t;
    const f32x2 s = (v * v) * (-0.72134752044f);
    f32x2 e; e.x = __builtin_amdgcn_exp2f(s.x); e.y = __builtin_amdgcn_exp2f(s.y);
    const f32x2 m = v * (q * e), r = v - m;
    f32x2 o; o.x = v.x < 0.f ? m.x : r.x; o.y = v.y < 0.f ? m.y : r.y; return o;
}

template <int ACT  > struct EpiBf16 {
    static constexpr bool PERM = true, AFTER_DRAIN = false; static_assert(ACT == 0 || ACT == 1, "EpiBf16: ACT is 0 (none) or 1 (gelu_pk)");
    bf16_t* O; int ldc; const float* bias; int split_cols; size_t split_stride; float scale0;
    __device__ __forceinline__ void operator()(const f32x4 (&acc)[2][2][4][2], const Unit& u, int wr, int wc, int fr, int fq) const {
        const int row0 = u.pm * BM + wr * 64 + fr; int colt = u.pn * BM; bf16_t* base = O;
        float sc = 1.f; if (split_cols) { const int t = colt / split_cols; base += (size_t)t * split_stride; colt -= t * split_cols; if (t == 0) sc = scale0; }
        const int col0 = colt + wc * 32 + 8 * fq, bcol0 = u.pn * BM + wc * 32 + 8 * fq;
        f32x4 bv[2][2];
#pragma unroll
        for (int bj = 0; bj < 2; ++bj)
#pragma unroll
            for (int n = 0; n < 2; ++n) bv[bj][n] = bias ? *(const f32x4*)(bias + bcol0 + bj * HALF + 4 * n) : (f32x4){0.f, 0.f, 0.f, 0.f};
#pragma unroll
        for (int ai = 0; ai < 2; ++ai)
#pragma unroll
            for (int m = 0; m < 4; ++m) { bf16_t* rowp = base + (size_t)(row0 + ai * HALF + m * 16) * ldc + col0;
#pragma unroll
                for (int bj = 0; bj < 2; ++bj) { f32x4 v0 = acc[ai][bj][m][0] + bv[bj][0], v1 = acc[ai][bj][m][1] + bv[bj][1];
                    if (ACT == 1) { f32x2 a = gelu_pk((f32x2){v0[0], v0[1]}), b = gelu_pk((f32x2){v0[2], v0[3]}), c = gelu_pk((f32x2){v1[0], v1[1]}), d = gelu_pk((f32x2){v1[2], v1[3]});
                        v0 = (f32x4){a.x, a.y, b.x, b.y}; v1 = (f32x4){c.x, c.y, d.x, d.y}; }
                    v0 = v0 * sc; v1 = v1 * sc; u32x4 w; w.x = cvt_pk_bf16(v0[0], v0[1]); w.y = cvt_pk_bf16(v0[2], v0[3]); w.z = cvt_pk_bf16(v1[0], v1[1]); w.w = cvt_pk_bf16(v1[2], v1[3]);
                    *(u32x4*)(rowp + bj * HALF) = w; } }
    }
};
template <class Epi, class Sched, bool ALIGN_EPI = false, bool SP2 = false>
__device__ __forceinline__ void gemm_phase(PG8_LAS unsigned char* lds, const Gemm g, const Sched& S, const Epi& E, const int tid_in) {
    const int tid = launder_v(tid_in) & 511, wid = __builtin_amdgcn_readfirstlane(tid >> 6), lane = tid & 63, wr = wid >> 2, wc = wid & 3, fr = lane & 15, fq = lane >> 4;
    const int K = g.K, nt = K / BK;
    unsigned voffA[2], voffB[2];
#pragma unroll
    for (int i = 0; i < 2; ++i) { int R, C; stage_rc(tid * 16 + i * 8192, R, C); const int Rb = Epi::PERM ? ((R & ~31) + perm32(R & 31)) : R;
        voffA[i] = (unsigned)(R * K + C) * 2u; voffB[i] = (unsigned)(Rb * K + C) * 2u; }
    const size_t kstep = (size_t)(BK * 2);
    const size_t hstep = (size_t)HALF * K * 2;
    const size_t tstep = 2 * hstep;
    const unsigned ldsw = (unsigned)wid * 1024u;
    const int aoff = lds_byte(wr * 64 + fr, fq * 8), boff = lds_byte(wc * 32 + fr, fq * 8);
#define PG8_SA(b, h) (((b) * 2 + (h)) * HTB)
#define PG8_SB(b, h) ((4 + (b) * 2 + (h)) * HTB)
#define PG8_STAGE(bufoff, gbase, voff) do { _Pragma("unroll") for (int _i = 0; _i < 2; ++_i) \
        __builtin_amdgcn_global_load_lds((const unsigned*)((const char*)(gbase) + (voff)[_i]), (PG8_LAS unsigned*)(lds + (bufoff) + ldsw + _i * 8192), 16, 0, 0); } while (0)
#define PG8_LDA(dst, b, h) do { _Pragma("unroll") for (int m = 0; m < 4; ++m) _Pragma("unroll") for (int k = 0; k < 2; ++k) dst[m][k] = *(const PG8_LAS bf16x8*)(lds + PG8_SA(b, h) + aoff + m * 2048 + k * 1024); } while (0)
#define PG8_LDB(dst, b, h) do { _Pragma("unroll") for (int n = 0; n < 2; ++n) _Pragma("unroll") for (int k = 0; k < 2; ++k) dst[n][k] = *(const PG8_LAS bf16x8*)(lds + PG8_SB(b, h) + boff + n * 2048 + k * 1024); } while (0)
#define PG8_MMA(ai, bj, At, Bt) do { __builtin_amdgcn_s_setprio(1); _Pragma("unroll") for (int m = 0; m < 4; ++m) _Pragma("unroll") for (int n = 0; n < 2; ++n) _Pragma("unroll") for (int k = 0; k < 2; ++k) \
        acc[ai][bj][m][n] = __builtin_amdgcn_mfma_f32_16x16x32_bf16(Bt[n][k], At[m][k], acc[ai][bj][m][n], 0, 0, 0); __builtin_amdgcn_s_setprio(0); } while (0)
#define PG8_WAIT_V(n) asm volatile("s_waitcnt vmcnt(" #n ")" ::: "memory")
#define PG8_WAIT_L(n) asm volatile("s_waitcnt lgkmcnt(" #n ")" ::: "memory")
#define PG8_BAR __builtin_amdgcn_s_barrier()
#define PG8_SCHED __builtin_amdgcn_sched_barrier(0)
    Unit cur, nxt; int ui = 0;
    if (!S.next(0, cur)) return;
    f32x4 acc[2][2][4][2];
#pragma unroll
    for (int a = 0; a < 2; ++a)
#pragma unroll
        for (int b = 0; b < 2; ++b)
#pragma unroll
            for (int m = 0; m < 4; ++m)
#pragma unroll
                for (int n = 0; n < 2; ++n) acc[a][b][m][n] = (f32x4){0.f, 0.f, 0.f, 0.f};
    bf16x8 At[4][2], B0[2][2], B1[2][2];
    const char* cA = (const char*)g.A + (size_t)cur.pm * tstep; const char* cB = (const char*)g.Bt + (size_t)cur.pn * tstep;
    S.a_ready(cur);
    if constexpr (SP2) {
        PG8_STAGE(PG8_SB(0, 0), cB, voffB); PG8_STAGE(PG8_SB(0, 1), cB + hstep, voffB); PG8_STAGE(PG8_SA(0, 0), cA, voffA); PG8_STAGE(PG8_SA(0, 1), cA + hstep, voffA);
        if (wr == 1) PG8_BAR;
        PG8_WAIT_V(2); PG8_BAR;
        PG8_STAGE(PG8_SB(1, 0), cB + kstep, voffB); PG8_STAGE(PG8_SA(1, 0), cA + kstep, voffA); PG8_STAGE(PG8_SB(1, 1), cB + hstep + kstep, voffB);
        PG8_WAIT_V(6); PG8_BAR;
    } else {
        PG8_STAGE(PG8_SB(0, 0), cB, voffB); PG8_STAGE(PG8_SA(0, 0), cA, voffA); PG8_STAGE(PG8_SB(0, 1), cB + hstep, voffB); PG8_STAGE(PG8_SA(0, 1), cA + hstep, voffA);
        if (wr == 1) PG8_BAR;
        PG8_WAIT_V(4); PG8_BAR;
        PG8_STAGE(PG8_SB(1, 0), cB + kstep, voffB); PG8_STAGE(PG8_SA(1, 0), cA + kstep, voffA); PG8_STAGE(PG8_SB(1, 1), cB + hstep + kstep, voffB);
        PG8_WAIT_V(6); PG8_BAR;
    }
    for (;;) {
        const bool has_next = S.next(ui + 1, nxt);
        const char* nA = has_next ? (const char*)g.A + (size_t)nxt.pm * tstep : cA; const char* nB = has_next ? (const char*)g.Bt + (size_t)nxt.pn * tstep : cB;
        for (int t = 0; t < nt; t += 2) {
            const bool last = (t == nt - 2);
            const char* a1 = cA + (size_t)(t + 1) * kstep;
            const char* a2 = last ? nA : cA + (size_t)(t + 2) * kstep; const char* b2 = last ? nB : cB + (size_t)(t + 2) * kstep;
            const char* a3 = a2 + kstep; const char* b3 = b2 + kstep;
            if (last && has_next) S.a_ready(nxt);
            if constexpr (SP2) {
            PG8_LDB(B0, 0, 0); PG8_LDB(B1, 0, 1); PG8_SCHED; PG8_LDA(At, 0, 0); PG8_STAGE(PG8_SA(1, 1), a1 + hstep, voffA);
            PG8_WAIT_V(8); PG8_WAIT_L(0); PG8_BAR; PG8_MMA(0, 0, At, B0); PG8_MMA(0, 1, At, B1); PG8_BAR; PG8_SCHED;
            PG8_LDA(At, 0, 1); PG8_STAGE(PG8_SB(0, 0), b2, voffB); PG8_STAGE(PG8_SB(0, 1), b2 + hstep, voffB); PG8_STAGE(PG8_SA(0, 0), a2, voffA);
            PG8_WAIT_V(8); PG8_WAIT_L(0); PG8_BAR; PG8_MMA(1, 0, At, B0); PG8_MMA(1, 1, At, B1); PG8_BAR; PG8_SCHED;
            PG8_LDB(B0, 1, 0); PG8_LDB(B1, 1, 1); PG8_SCHED; PG8_LDA(At, 1, 0); PG8_STAGE(PG8_SA(0, 1), a2 + hstep, voffA);
            PG8_WAIT_V(8); PG8_WAIT_L(0); PG8_BAR; PG8_MMA(0, 0, At, B0); PG8_MMA(0, 1, At, B1); PG8_BAR; PG8_SCHED;
            PG8_LDA(At, 1, 1); PG8_STAGE(PG8_SB(1, 0), b3, voffB); PG8_STAGE(PG8_SB(1, 1), b3 + hstep, voffB); PG8_STAGE(PG8_SA(1, 0), a3, voffA);
            PG8_WAIT_V(8); PG8_WAIT_L(0); PG8_BAR; PG8_MMA(1, 0, At, B0); PG8_MMA(1, 1, At, B1); PG8_BAR; PG8_SCHED;
            } else {
            PG8_LDB(B0, 0, 0); PG8_SCHED; PG8_LDA(At, 0, 0); PG8_STAGE(PG8_SA(1, 1), a1 + hstep, voffA);
            PG8_WAIT_L(8); PG8_BAR; PG8_WAIT_L(0); PG8_MMA(0, 0, At, B0); PG8_BAR; PG8_SCHED;
            PG8_LDB(B1, 0, 1); PG8_STAGE(PG8_SB(0, 0), b2, voffB);
            PG8_BAR; PG8_WAIT_L(0); PG8_MMA(0, 1, At, B1); PG8_BAR;
            PG8_LDA(At, 0, 1); PG8_STAGE(PG8_SA(0, 0), a2, voffA);
            PG8_BAR; PG8_WAIT_L(0); PG8_MMA(1, 0, At, B0); PG8_BAR; PG8_SCHED;
            PG8_STAGE(PG8_SB(0, 1), b2 + hstep, voffB);
            PG8_WAIT_V(6); PG8_BAR; PG8_MMA(1, 1, At, B1); PG8_BAR;
            PG8_LDB(B0, 1, 0); PG8_SCHED; PG8_LDA(At, 1, 0); PG8_STAGE(PG8_SA(0, 1), a2 + hstep, voffA);
            PG8_WAIT_L(8); PG8_BAR; PG8_WAIT_L(0); PG8_MMA(0, 0, At, B0); PG8_BAR; PG8_SCHED;
            PG8_LDB(B1, 1, 1); PG8_STAGE(PG8_SB(1, 0), b3, voffB);
            PG8_BAR; PG8_WAIT_L(0); PG8_MMA(0, 1, At, B1); PG8_BAR;
            PG8_LDA(At, 1, 1); PG8_STAGE(PG8_SA(1, 0), a3, voffA);
            PG8_BAR; PG8_WAIT_L(0); PG8_MMA(1, 0, At, B0); PG8_BAR; PG8_SCHED;
            PG8_STAGE(PG8_SB(1, 1), b3 + hstep, voffB);
            PG8_WAIT_V(6); PG8_BAR; PG8_MMA(1, 1, At, B1); PG8_BAR;
            }
        }
        if constexpr (ALIGN_EPI) { if (wr == 0) PG8_BAR; }
        if constexpr (!Epi::AFTER_DRAIN) { E(acc, cur, wr, wc, fr, fq); S.done(cur); }
        if (!has_next) break;
#pragma unroll
        for (int a = 0; a < 2; ++a)
#pragma unroll
            for (int b = 0; b < 2; ++b)
#pragma unroll
                for (int m = 0; m < 4; ++m)
#pragma unroll
                    for (int n = 0; n < 2; ++n) acc[a][b][m][n] = (f32x4){0.f, 0.f, 0.f, 0.f};
        cur = nxt; cA = nA; cB = nB; ++ui;
        if constexpr (ALIGN_EPI) { if (wr == 1) PG8_BAR; }
    }
    PG8_WAIT_V(0);
    if constexpr (!ALIGN_EPI) { if (wr == 0) PG8_BAR; }
    PG8_BAR;
    if constexpr (Epi::AFTER_DRAIN) { E.fused(acc, cur, wr, wc, fr, fq, lds, wid, lane); S.done(cur); }
#undef PG8_SA
#undef PG8_SB
#undef PG8_STAGE
#undef PG8_LDA
#undef PG8_LDB
#undef PG8_MMA
#undef PG8_WAIT_V
#undef PG8_WAIT_L
#undef PG8_BAR
#undef PG8_SCHED
}
}

namespace pg8 {
__device__ __forceinline__ float gelu_tanh(float x) {
    const float t = x * (1.5957691216057308f + 0.07135481627f * x * x);
    const float e = __builtin_amdgcn_exp2f(-1.4426950408889634f * t);
    return x * __builtin_amdgcn_rcpf(1.0f + e);
}
template <int ACT> struct EpiT {
    static constexpr bool PERM = true, AFTER_DRAIN = false;
    bf16_t* O; int ldc;
    __device__ __forceinline__ void operator()(const f32x4 (&acc)[2][2][4][2], const Unit& u, int wr, int wc, int fr, int fq) const {
        const int row0 = u.pm * BM + wr * 64 + fr; const int col0 = u.pn * BM + wc * 32 + 8 * fq;
#pragma unroll
        for (int ai = 0; ai < 2; ++ai)
#pragma unroll
            for (int m = 0; m < 4; ++m) { bf16_t* rowp = O + (size_t)(row0 + ai * HALF + m * 16) * ldc + col0;
#pragma unroll
                for (int bj = 0; bj < 2; ++bj) { f32x4 v0 = acc[ai][bj][m][0], v1 = acc[ai][bj][m][1];
                    if (ACT == 2) { v0 = (f32x4){gelu_tanh(v0[0]), gelu_tanh(v0[1]), gelu_tanh(v0[2]), gelu_tanh(v0[3])}; v1 = (f32x4){gelu_tanh(v1[0]), gelu_tanh(v1[1]), gelu_tanh(v1[2]), gelu_tanh(v1[3])}; }
                    u32x4 w; w.x = cvt_pk_bf16(v0[0], v0[1]); w.y = cvt_pk_bf16(v0[2], v0[3]); w.z = cvt_pk_bf16(v1[0], v1[1]); w.w = cvt_pk_bf16(v1[2], v1[3]);
                    *(u32x4*)(rowp + bj * HALF) = w; } }
    }
};
struct EpiR {
    static constexpr bool PERM = true, AFTER_DRAIN = false;
    bf16_t* O; int ldc; int act; int rope; const float* ropet;
    __device__ __forceinline__ void operator()(const f32x4 (&acc)[2][2][4][2], const Unit& u, int wr, int wc, int fr, int fq) const {
        const int row0 = u.pm * BM + wr * 64 + fr; const int col0 = u.pn * BM + wc * 32 + 8 * fq;
        const bool rrows = rope != 0 && u.pm < 64;
#pragma unroll
        for (int ai = 0; ai < 2; ++ai)
#pragma unroll
            for (int m = 0; m < 4; ++m) { const int grow = row0 + ai * HALF + m * 16; bf16_t* rowp = O + (size_t)grow * ldc + col0;
#pragma unroll
                for (int bj = 0; bj < 2; ++bj) { f32x4 v0 = acc[ai][bj][m][0], v1 = acc[ai][bj][m][1];
                    if (act) { v0 = (f32x4){gelu_tanh(v0[0]), gelu_tanh(v0[1]), gelu_tanh(v0[2]), gelu_tanh(v0[3])}; v1 = (f32x4){gelu_tanh(v1[0]), gelu_tanh(v1[1]), gelu_tanh(v1[2]), gelu_tanh(v1[3])}; }
                    if (rrows) { const int blk = u.pn * 8 + bj * 4 + wc; const int b6 = blk % 6; const bool on = rope == 1 ? (blk < 128) : (b6 >= 4); const int half = rope == 1 ? (blk & 1) : (b6 - 4);
                        if (on) { const int t = grow & 8191; const int pos = half ? (t & 63) : (t >> 6);
                            const float* cp = ropet + pos * 16 + 8 * (fq & 1); const f32x4 c0 = *(const f32x4*)cp, c1 = *(const f32x4*)(cp + 4), s0 = *(const f32x4*)(cp + 2048), s1 = *(const f32x4*)(cp + 2052);
                            f32x4 p0, p1;
#pragma unroll
                            for (int i = 0; i < 4; ++i) { const float a_ = v0[i], b_ = v1[i];
                                const auto r0 = __builtin_amdgcn_permlane32_swap(__float_as_uint(a_), __float_as_uint(a_), false, false);
                                const auto r1 = __builtin_amdgcn_permlane32_swap(__float_as_uint(b_), __float_as_uint(b_), false, false);
                                const unsigned x0_ = (fq & 2) ? r0[0] : r0[1], x1_ = (fq & 2) ? r1[0] : r1[1]; p0[i] = __uint_as_float(x0_); p1[i] = __uint_as_float(x1_); }
                            if (fq & 2) { v0 = p0 * s0 + v0 * c0; v1 = p1 * s1 + v1 * c1; } else { v0 = v0 * c0 - p0 * s0; v1 = v1 * c1 - p1 * s1; } } }
                    u32x4 w; w.x = cvt_pk_bf16(v0[0], v0[1]); w.y = cvt_pk_bf16(v0[2], v0[3]); w.z = cvt_pk_bf16(v1[0], v1[1]); w.w = cvt_pk_bf16(v1[2], v1[3]);
                    *(u32x4*)(rowp + bj * HALF) = w; } }
    }
};
}

constexpr int DM = 2048, NBATCH = 2, SEQ = 8192, CTXL = 256;
constexpr int ML = NBATCH * SEQ;
constexpr int MC = NBATCH * CTXL;
constexpr int MT = ML + MC;
constexpr int NLAYER = 4;
constexpr float ALPHA = 1.6817928305074290f, LN_EPS = 1e-6f;
constexpr int NWAVES = 8;
constexpr float U_SCALE = 64.0f, V_SCALE = 4.0f;
constexpr int PROW = 1536;
constexpr int PREC = 2 * PROW;
constexpr int NPH = 35;

constexpr size_t MiB = 1ull << 20;
constexpr size_t WS_CTL = 0, CTL_ZERO_BYTES = 1 * MiB;
constexpr int    CW_BAR = 4096;
constexpr size_t WS_MOD = 128 * 1024;
constexpr size_t WS_VST = 1 * MiB;
constexpr size_t WS_ROPE = 1 * MiB + 160 * 1024;
constexpr size_t WS_MODP = 1 * MiB + 256 * 1024;
constexpr size_t WS_GMWIN = 6 * MiB;
constexpr size_t WS_GMWOUT = WS_GMWIN + 32 * MiB;
constexpr size_t WS_GMWS = WS_GMWOUT + 16 * MiB;
constexpr size_t WS_PWQ = WS_GMWS + 1 * MiB;
constexpr size_t WS_PK1 = WS_PWQ + 32 * MiB;
constexpr size_t WS_PK2 = WS_PK1 + 512 * 1024;
constexpr size_t WS_MLAIN = WS_PK1 + 1 * MiB;
constexpr size_t WS_MLAUQ = WS_MLAIN + 5 * MiB;
constexpr size_t WS_MLAUKV = WS_MLAUQ + 3 * MiB;
constexpr size_t WS_MLAOUT = WS_MLAUKV + 4 * MiB;
constexpr size_t WS_DAIN = WS_MLAOUT + 8 * MiB;
constexpr size_t WS_DAOUT = WS_DAIN + 24 * MiB;
constexpr size_t WS_PU = WS_DAOUT + 8 * MiB;
constexpr size_t WS_PV = WS_PU + 96 * MiB;
constexpr size_t WS_X = WS_PV + 96 * MiB;
constexpr size_t WS_H = WS_X + 66 * MiB;
constexpr size_t WS_G = WS_H + 66 * MiB;
constexpr size_t WS_Y = WS_G + 66 * MiB;
constexpr size_t WS_QP = WS_Y + 66 * MiB;
constexpr size_t WS_Z = WS_QP + 66 * MiB;
constexpr size_t WS_C = WS_Z + 198 * MiB;
constexpr size_t WS_CQN = WS_C + 42 * MiB;
constexpr size_t WS_CKVN = WS_CQN + 17 * MiB;
constexpr size_t WS_KR = WS_CKVN + 17 * MiB;
constexpr size_t WS_QM = WS_KR + 3 * MiB;
constexpr size_t WS_KV = WS_QM + 99 * MiB;
constexpr size_t WS_ROUTE = WS_KV + 132 * MiB;
constexpr size_t WS_END = WS_ROUTE + 17 * MiB;
static_assert((size_t)MT * DM * 2 == 66 * MiB, "row buffer size");

constexpr int RING_BYTES = 155648, MISC_OFF = RING_BYTES + 320, LDS_BYTES = 159744;

#define GAS __attribute__((address_space(1)))
#define LAS __attribute__((address_space(3)))
typedef unsigned short bf16;
typedef unsigned u32x4 __attribute__((ext_vector_type(4)));
typedef unsigned u32x2 __attribute__((ext_vector_type(2)));
typedef float f32x4 __attribute__((ext_vector_type(4)));
typedef float f32x16 __attribute__((ext_vector_type(16)));
typedef short bf16x8 __attribute__((ext_vector_type(8)));
typedef short s16x4 __attribute__((ext_vector_type(4)));
#define LDS_WAIT() asm volatile("s_waitcnt lgkmcnt(0)" ::: "memory")

__device__ __forceinline__ unsigned cvtpk(float lo, float hi) { unsigned r; asm("v_cvt_pk_bf16_f32 %0, %1, %2" : "=v"(r) : "v"(lo), "v"(hi)); return r; }
__device__ __forceinline__ float bflo(unsigned w) { return __uint_as_float(w << 16); }
__device__ __forceinline__ float bfhi(unsigned w) { return __uint_as_float(w & 0xffff0000u); }
__device__ __forceinline__ float bf1(bf16 b) { return __uint_as_float((unsigned)b << 16); }
__device__ __forceinline__ bf16 tobf1(float f) { return (bf16)(cvtpk(f, 0.f) & 0xffffu); }
#define DPP_F(v, ctrl) __int_as_float(__builtin_amdgcn_mov_dpp(__float_as_int(v), (ctrl), 0xF, 0xF, true))
__device__ __forceinline__ float row_sum16(float v) { v += DPP_F(v, 0xB1); v += DPP_F(v, 0x4E); v += DPP_F(v, 0x141); v += DPP_F(v, 0x140); return v; }
__device__ __forceinline__ float sum_xor16(float v) { const auto r = __builtin_amdgcn_permlane16_swap(__float_as_uint(v), __float_as_uint(v), false, false); return __uint_as_float(r[0]) + __uint_as_float(r[1]); }
__device__ __forceinline__ float sum_xor32(float v) { const auto r = __builtin_amdgcn_permlane32_swap(__float_as_uint(v), __float_as_uint(v), false, false); return __uint_as_float(r[0]) + __uint_as_float(r[1]); }
__device__ __forceinline__ float wave_sum(float v) { return sum_xor32(sum_xor16(row_sum16(v))); }
__device__ __forceinline__ float half_sum32(float v) { return sum_xor16(row_sum16(v)); }
__device__ __forceinline__ float lane_xor16(float v, int lane) { const auto r = __builtin_amdgcn_permlane16_swap(__float_as_uint(v), __float_as_uint(v), false, false); return __uint_as_float((lane & 16) ? r[0] : r[1]); }
__device__ __forceinline__ unsigned lane_xor32(unsigned v, int lane) { const auto r = __builtin_amdgcn_permlane32_swap(v, v, false, false); return (lane & 32) ? r[0] : r[1]; }
__device__ __forceinline__ float gelu_tanh(float x) { return pg8::gelu_tanh(x); }

__device__ __forceinline__ void load_row_bf16(const bf16* row, int lane, float (&v)[32]) {
#pragma unroll
    for (int j = 0; j < 4; ++j) { const u32x4 w = ((const u32x4*)row)[64 * j + lane];
        v[8 * j + 0] = bflo(w.x); v[8 * j + 1] = bfhi(w.x); v[8 * j + 2] = bflo(w.y); v[8 * j + 3] = bfhi(w.y);
        v[8 * j + 4] = bflo(w.z); v[8 * j + 5] = bfhi(w.z); v[8 * j + 6] = bflo(w.w); v[8 * j + 7] = bfhi(w.w); }
}
__device__ __forceinline__ void store_row_bf16(bf16* row, int lane, const float (&v)[32]) {
#pragma unroll
    for (int j = 0; j < 4; ++j) { u32x4 w; w.x = cvtpk(v[8 * j + 0], v[8 * j + 1]); w.y = cvtpk(v[8 * j + 2], v[8 * j + 3]); w.z = cvtpk(v[8 * j + 4], v[8 * j + 5]); w.w = cvtpk(v[8 * j + 6], v[8 * j + 7]);
        ((u32x4*)row)[64 * j + lane] = w; }
}
__device__ __forceinline__ void load_row_f32(const float* row, int lane, float (&v)[32]) {
#pragma unroll
    for (int j = 0; j < 4; ++j) { const f32x4 a = ((const f32x4*)row)[128 * j + 2 * lane], b = ((const f32x4*)row)[128 * j + 2 * lane + 1];
        v[8 * j + 0] = a.x; v[8 * j + 1] = a.y; v[8 * j + 2] = a.z; v[8 * j + 3] = a.w; v[8 * j + 4] = b.x; v[8 * j + 5] = b.y; v[8 * j + 6] = b.z; v[8 * j + 7] = b.w; }
}
__device__ __forceinline__ void store_row_f32(float* row, int lane, const float (&v)[32]) {
#pragma unroll
    for (int j = 0; j < 4; ++j) { ((f32x4*)row)[128 * j + 2 * lane] = (f32x4){v[8 * j + 0], v[8 * j + 1], v[8 * j + 2], v[8 * j + 3]};
        ((f32x4*)row)[128 * j + 2 * lane + 1] = (f32x4){v[8 * j + 4], v[8 * j + 5], v[8 * j + 6], v[8 * j + 7]}; }
}
__device__ __forceinline__ void load_row_bf16_b(const bf16* row, int lane, float (&v)[32]) {
#pragma unroll
    for (int j = 0; j < 4; ++j) { const u32x4 w = ((const u32x4*)row)[4 * lane + j];
        v[8 * j + 0] = bflo(w.x); v[8 * j + 1] = bfhi(w.x); v[8 * j + 2] = bflo(w.y); v[8 * j + 3] = bfhi(w.y);
        v[8 * j + 4] = bflo(w.z); v[8 * j + 5] = bfhi(w.z); v[8 * j + 6] = bflo(w.w); v[8 * j + 7] = bfhi(w.w); }
}
__device__ __forceinline__ void store_row_bf16_b(bf16* row, int lane, const float (&v)[32]) {
#pragma unroll
    for (int j = 0; j < 4; ++j) { u32x4 w; w.x = cvtpk(v[8 * j + 0], v[8 * j + 1]); w.y = cvtpk(v[8 * j + 2], v[8 * j + 3]); w.z = cvtpk(v[8 * j + 4], v[8 * j + 5]); w.w = cvtpk(v[8 * j + 6], v[8 * j + 7]);
        ((u32x4*)row)[4 * lane + j] = w; }
}
__device__ __forceinline__ void load_row_f32_b(const float* row, int lane, float (&v)[32]) {
#pragma unroll
    for (int q = 0; q < 8; ++q) { const f32x4 a = ((const f32x4*)row)[8 * lane + q];
        v[4 * q + 0] = a.x; v[4 * q + 1] = a.y; v[4 * q + 2] = a.z; v[4 * q + 3] = a.w; }
}
__device__ __forceinline__ void store_row_f32_b(float* row, int lane, const float (&v)[32]) {
#pragma unroll
    for (int q = 0; q < 8; ++q) ((f32x4*)row)[8 * lane + q] = (f32x4){v[4 * q + 0], v[4 * q + 1], v[4 * q + 2], v[4 * q + 3]};
}
__device__ __forceinline__ void ln_stats(const float (&v)[32], float& mean, float& rstd) {
    float s = 0.f;
#pragma unroll
    for (int i = 0; i < 32; ++i) s += v[i];
    mean = wave_sum(s) * (1.0f / DM);
    float q = 0.f;
#pragma unroll
    for (int i = 0; i < 32; ++i) { const float d = v[i] - mean; q += d * d; }
    rstd = 1.0f / sqrtf(wave_sum(q) * (1.0f / DM) + LN_EPS);
}
template <bool LAYB>
__device__ __forceinline__ void finish_row(float (&z)[32], const float* lng, const float* lnb, bf16* Xrow, const float* sh, const float* sc, bf16* Hrow, float* Orow, int lane) {
    float mean, rstd; ln_stats(z, mean, rstd);
    { float g[32], b[32]; if (LAYB) { load_row_f32_b(lng, lane, g); load_row_f32_b(lnb, lane, b); } else { load_row_f32(lng, lane, g); load_row_f32(lnb, lane, b); }
#pragma unroll
      for (int i = 0; i < 32; ++i) z[i] = (z[i] - mean) * rstd * g[i] + b[i]; }
    if (Xrow) { if (LAYB) store_row_bf16_b(Xrow, lane, z); else store_row_bf16(Xrow, lane, z); }
    if (Orow) { if (LAYB) store_row_f32_b(Orow, lane, z); else store_row_f32(Orow, lane, z); }
    if (Hrow) {
        ln_stats(z, mean, rstd);
        float a[32], s[32]; if (LAYB) { load_row_f32_b(sc, lane, a); load_row_f32_b(sh, lane, s); } else { load_row_f32(sc, lane, a); load_row_f32(sh, lane, s); }
#pragma unroll
        for (int i = 0; i < 32; ++i) a[i] = (z[i] - mean) * rstd * (1.0f + a[i]) + s[i];
        if (LAYB) store_row_bf16_b(Hrow, lane, a); else store_row_bf16(Hrow, lane, a);
    }
}
__device__ __forceinline__ int row_slot(int row) { return row < ML ? (row >> 13) : 2; }

__device__ __forceinline__ unsigned f2bf_rne(float f) { unsigned u = __float_as_uint(f); return (u + 0x7fffu + ((u >> 16) & 1u)) >> 16; }
__device__ __forceinline__ unsigned pk2(float lo, float hi) { return f2bf_rne(lo) | (f2bf_rne(hi) << 16); }
__device__ __forceinline__ void p0_transpose_item(const float* W, int K, int N, bf16* WT, LAS float* scr, int item, int lane) {
    const int nblk = N / 32, kb = item / nblk, nb = item % nblk, k0 = 64 * kb, n0 = 32 * nb;
    f32x4 t[8];
#pragma unroll
    for (int i = 0; i < 8; ++i) t[i] = *(const f32x4*)(W + (size_t)(k0 + 8 * i + (lane >> 3)) * N + n0 + 4 * (lane & 7));
#pragma unroll
    for (int i = 0; i < 8; ++i) { LAS float* d = scr + (8 * i + (lane >> 3)) * 33 + 4 * (lane & 7); d[0] = t[i].x; d[1] = t[i].y; d[2] = t[i].z; d[3] = t[i].w; }
    LDS_WAIT(); asm volatile("" ::: "memory");
    const int c = lane & 7;
#pragma unroll
    for (int j = 0; j < 4; ++j) { const int n = (lane >> 3) + 8 * j; const LAS float* s = scr + (8 * c) * 33 + n;
        u32x4 o; o.x = pk2(s[0 * 33], s[1 * 33]); o.y = pk2(s[2 * 33], s[3 * 33]); o.z = pk2(s[4 * 33], s[5 * 33]); o.w = pk2(s[6 * 33], s[7 * 33]);
        *(u32x4*)(WT + (size_t)(n0 + n) * K + k0 + 8 * c) = o; }
    LDS_WAIT(); asm volatile("" ::: "memory");
}
__device__ __forceinline__ void cvt_range(const float* src, bf16* dst, size_t n8, size_t gtid, size_t gthreads) {
#pragma unroll 4
    for (size_t i = gtid; i < n8; i += gthreads) { const f32x4 a = ((const f32x4*)src)[2 * i], b = ((const f32x4*)src)[2 * i + 1];
        u32x4 w; w.x = cvtpk(a.x, a.y); w.y = cvtpk(a.z, a.w); w.z = cvtpk(b.x, b.y); w.w = cvtpk(b.z, b.w); ((u32x4*)dst)[i] = w; }
}
__device__ __forceinline__ unsigned enc_e2m3(float x) {
    const unsigned sgn = (__float_as_uint(x) >> 26) & 32u;
    const float ax = fminf(fabsf(x), 7.5f);
    unsigned u = __float_as_uint(ax); u += 0x7FFFFu + ((u >> 20) & 1u);
    const unsigned cn = (u >> 20) - ((127u - 1u) << 3);
    const unsigned cs = (unsigned)__builtin_rintf(ax * 8.0f);
    return sgn | (ax < 1.0f ? cs : cn);
}
#ifndef CVT_PIPE
#define CVT_PIPE 0
#endif
typedef float f32x16v __attribute__((ext_vector_type(16)));
typedef float f32x32v __attribute__((ext_vector_type(32)));
typedef unsigned u32x6v __attribute__((ext_vector_type(6)));
__device__ __forceinline__ u32x6v pack_fp6_32(const float (&e)[32], bool interleaved) {
    f32x16v s0, s1;
    if (interleaved) {
#pragma unroll
        for (int i = 0; i < 16; ++i) { s0[i] = e[2 * i]; s1[i] = e[2 * i + 1]; }
    } else {
#pragma unroll
        for (int i = 0; i < 16; ++i) { s0[i] = e[i]; s1[i] = e[16 + i]; }
    }
    return __builtin_amdgcn_cvt_scalef32_2xpk16_fp6_f32(s0, s1, 1.0f);
}
__device__ __forceinline__ void cvt_table_fp6(const float* src, unsigned char* dst, int nrows, float scale, LAS float* scr  , int lane, int gw, int NGW, const int isv) {
    bool interleaved;
    {
        float t[32];
#pragma unroll
        for (int k = 0; k < 32; ++k) t[k] = k < 16 ? 0.125f * k : (k < 24 ? 2.0f + 0.25f * (k - 16) : 4.0f + 0.5f * (k - 24));
        float tt[32];
#pragma unroll
        for (int k = 0; k < 32; ++k) { tt[k] = t[k]; asm volatile("" : "+v"(tt[k])); }
        const u32x6v p = pack_fp6_32(tt, true);
        const f32x32v o = __builtin_amdgcn_cvt_scalef32_pk32_f32_fp6(p, 1.0f);
        interleaved = (o[1] == t[1]) && (o[2] == t[2]) && (o[17] == t[17]);
        interleaved = __all(interleaved);
    }
#if CVT_PIPE
    f32x4 nx[8];
    if (gw < nrows) { const f32x4* s4 = (const f32x4*)(src + (size_t)gw * 2048);
#pragma unroll
        for (int q = 0; q < 8; ++q) nx[q] = s4[64 * q + lane]; }
    for (int row = gw; row < nrows; row += NGW) {
        f32x4 cur[8];
#pragma unroll
        for (int q = 0; q < 8; ++q) cur[q] = nx[q];
        if (row + NGW < nrows) { const f32x4* s4 = (const f32x4*)(src + (size_t)(row + NGW) * 2048);
#pragma unroll
            for (int q = 0; q < 8; ++q) nx[q] = s4[64 * q + lane]; }
#pragma unroll
        for (int q = 0; q < 8; ++q) { const int s = 64 * q + lane; const f32x4 a = cur[q] * scale; *(LAS f32x4*)(scr + 4 * (s ^ ((s >> 4) & 7))) = a; }
#else
    for (int row = gw; row < nrows; row += NGW) {
        const f32x4* s4 = (const f32x4*)(src + (size_t)row * 2048);
#pragma unroll
        for (int q = 0; q < 8; ++q) { const int s = 64 * q + lane; const f32x4 a = s4[s] * scale; *(LAS f32x4*)(scr + 4 * (s ^ ((s >> 4) & 7))) = a; }
#endif
        float e[32];
#pragma unroll
        for (int j = 0; j < 8; ++j) { const int s = 8 * lane + j; const f32x4 a = *(const LAS f32x4*)(scr + 4 * (s ^ ((s >> 4) & 7)));
            e[4 * j + 0] = __builtin_amdgcn_fmed3f(a.x, -7.5f, 7.5f); e[4 * j + 1] = __builtin_amdgcn_fmed3f(a.y, -7.5f, 7.5f); e[4 * j + 2] = __builtin_amdgcn_fmed3f(a.z, -7.5f, 7.5f); e[4 * j + 3] = __builtin_amdgcn_fmed3f(a.w, -7.5f, 7.5f); }
        const u32x6v p = pack_fp6_32(e, interleaved);
        unsigned char* rowp = dst + (size_t)row * PREC;
        *(u32x4*)(rowp + 1024 * isv + 16 * lane) = (u32x4){p[0], p[1], p[2], p[3]}; *(u32x2*)(rowp + 2048 + 512 * isv + 8 * lane) = (u32x2){p[4], p[5]};
    }
}
__device__ __forceinline__ float silu(float x) { return x / (1.0f + __expf(-x)); }

struct Params { const float* in[29]; float* out; unsigned char* ws; int ph_lo, ph_hi; };
typedef const __attribute__((address_space(4))) Params* CP;

#ifndef TAIL_REMAP
#define TAIL_REMAP 0
#endif
__device__ __forceinline__ void p0_prologue(CP P, LAS unsigned char* lds, int tid, int lane, int wid, int gw, int NGW, const int parts = 7) {
    unsigned char* ws = P->ws;
    LAS float* scr = (LAS float*)(lds + wid * 16384);
    if (parts & 1) {
        constexpr int I_GMIN = (2048 / 64) * (4096 / 32), I_SQ = (2048 / 64) * (2048 / 32), I_MIN = (2048 / 64) * (1088 / 32), I_UQ = (512 / 64) * (3072 / 32), I_UKV = (512 / 64) * (4096 / 32), I_DIN = (2048 / 64) * (6144 / 32);
        constexpr int NIT = 2 * I_GMIN + 2 * I_SQ + 4 * I_SQ + I_MIN + I_UQ + I_UKV + I_SQ + I_DIN + I_SQ;
        for (int it = gw; it < NIT; it += NGW) {
            int r = it;
            if (r < 2 * I_GMIN) { const int j = r / I_GMIN; p0_transpose_item(P->in[13] + (size_t)j * 2048 * 4096, 2048, 4096, (bf16*)(ws + WS_GMWIN) + (size_t)j * 4096 * 2048, scr, r % I_GMIN, lane); continue; } r -= 2 * I_GMIN;
            if (r < 2 * I_SQ) { const int j = r / I_SQ; p0_transpose_item(P->in[18] + (size_t)j * 2048 * 2048, 2048, 2048, (bf16*)(ws + WS_GMWOUT) + (size_t)j * 2048 * 2048, scr, r % I_SQ, lane); continue; } r -= 2 * I_SQ;
            if (r < 4 * I_SQ) { const int j = r / I_SQ; p0_transpose_item(P->in[8] + (size_t)j * 2048 * 2048, 2048, 2048, (bf16*)(ws + WS_PWQ) + (size_t)j * 2048 * 2048, scr, r % I_SQ, lane); continue; } r -= 4 * I_SQ;
            if (r < I_MIN) { p0_transpose_item(P->in[19], 2048, 1088, (bf16*)(ws + WS_MLAIN), scr, r, lane); continue; } r -= I_MIN;
            if (r < I_UQ) { p0_transpose_item(P->in[22], 512, 3072, (bf16*)(ws + WS_MLAUQ), scr, r, lane); continue; } r -= I_UQ;
            if (r < I_UKV) { p0_transpose_item(P->in[23], 512, 4096, (bf16*)(ws + WS_MLAUKV), scr, r, lane); continue; } r -= I_UKV;
            if (r < I_SQ) { p0_transpose_item(P->in[24], 2048, 2048, (bf16*)(ws + WS_MLAOUT), scr, r, lane); continue; } r -= I_SQ;
            if (r < I_DIN) { p0_transpose_item(P->in[25], 2048, 6144, (bf16*)(ws + WS_DAIN), scr, r, lane); continue; } r -= I_DIN;
            p0_transpose_item(P->in[28], 2048, 2048, (bf16*)(ws + WS_DAOUT), scr, r, lane);
        }
    }
    const size_t gtid = (size_t)gw * 64 + lane, gthreads = (size_t)NGW * 64;
    if (parts & 2) {
    { u32x4* z = (u32x4*)((bf16*)(ws + WS_MLAIN) + (size_t)1088 * 2048); const size_t n = (size_t)192 * 2048 / 8;
      for (size_t i = gtid; i < n; i += gthreads) z[i] = (u32x4){0u, 0u, 0u, 0u}; }
    cvt_range(P->in[16], (bf16*)(ws + WS_GMWS), (size_t)2 * 16 * 128 * 128 / 8, gtid, gthreads);
    cvt_range(P->in[9], (bf16*)(ws + WS_PK1), (size_t)4 * 128 * 128 / 8, gtid, gthreads);
    cvt_range(P->in[10], (bf16*)(ws + WS_PK2), (size_t)4 * 128 * 128 / 8, gtid, gthreads);
#if !TAIL_REMAP
    cvt_table_fp6(P->in[11], ws + WS_PU, 16384, U_SCALE, scr, lane, gw, NGW, 0);
    cvt_table_fp6(P->in[12], ws + WS_PU, 16384, V_SCALE, scr, lane, gw, NGW, 1);
#endif
    if (gtid < 2048) { const int pos = (int)gtid >> 4, f = (int)gtid & 15; const float inv = powf(10000.0f, -(float)f * (1.0f / 16.0f)); float sn, cs; sincosf((float)pos * inv, &sn, &cs);
        float* rt = (float*)(ws + WS_ROPE); rt[gtid] = cs; rt[2048 + gtid] = sn; }
    }
    if (parts & 4) {
        const float* cv = P->in[1]; const float* cc = P->in[3]; const float* mw = P->in[4]; float* PART = (float*)(ws + WS_MODP);
        LAS float* S = (LAS float*)lds;
        __syncthreads();
        for (int i = tid; i < 3 * 2048; i += NWAVES * 64) { const int sl = i >> 11, kk = i & 2047; S[i] = silu(sl == 0 ? cv[kk] : (sl == 1 ? cv[2048 + kk] : cc[kk])); }
        __syncthreads();
        for (int item = gw; item < 4 * 192 * 8; item += NGW) {
            const int ks = item & 7, r = item >> 3, L = r / 192, n = (r % 192) * 64 + lane;
            const float* W = mw + (size_t)L * 2048 * 12288 + (size_t)(ks * 256) * 12288 + n;
            float a0 = 0.f, a1 = 0.f, a2 = 0.f;
#pragma unroll 32
            for (int k = 0; k < 256; ++k) { const int kk = ks * 256 + k; const float s0 = S[kk], s1 = S[2048 + kk], s2 = S[4096 + kk];
                const float w = W[(size_t)k * 12288]; a0 += s0 * w; a1 += s1 * w; a2 += s2 * w; }
            float* o = PART + ((size_t)ks * 4 + L) * 3 * 12288 + n;
            o[0] = a0; o[12288] = a1; o[24576] = a2;
        }
    }
}
__device__ __forceinline__ void mod_reduce(CP P, int gw, int lane, int NGW) {
    const float* PART = (const float*)(P->ws + WS_MODP); float* MOD = (float*)(P->ws + WS_MOD); const float* mb = P->in[5];
    for (int i = gw * 64 + lane; i < 4 * 3 * 12288; i += NGW * 64) {
        const int L = i / (3 * 12288), n = i % 12288;
        float s = mb[(size_t)L * 12288 + n];
#pragma unroll
        for (int ks = 0; ks < 8; ++ks) s += PART[(size_t)ks * 4 * 3 * 12288 + i];
        MOD[i] = s;
    }
}

__device__ __forceinline__ void first_row_pass(CP P, int lane, int gw, int NGW) {
    const float* MOD = (const float*)(P->ws + WS_MOD); bf16* X = (bf16*)(P->ws + WS_X); bf16* H = (bf16*)(P->ws + WS_H);
    for (int row = gw; row < MT; row += NGW) {
        const float* src = row < ML ? P->in[0] + (size_t)row * DM : P->in[2] + (size_t)(row - ML) * DM;
        float v[32]; load_row_f32(src, lane, v);
        store_row_bf16(X + (size_t)row * DM, lane, v);
        const float* mod = MOD + (size_t)row_slot(row) * 12288;
        float mean, rstd; ln_stats(v, mean, rstd);
        float a[32], s[32]; load_row_f32(mod + 2048, lane, a); load_row_f32(mod, lane, s);
#pragma unroll
        for (int i = 0; i < 32; ++i) a[i] = (v[i] - mean) * rstd * (1.0f + a[i]) + s[i];
        store_row_bf16(H + (size_t)row * DM, lane, a);
    }
}
__device__ __forceinline__ void post_mixer_pass(CP P, int L, int Mrows, int lane, int gw, int NGW) {
    const float* MOD = (const float*)(P->ws + WS_MOD); bf16* X = (bf16*)(P->ws + WS_X); bf16* H = (bf16*)(P->ws + WS_H); const bf16* Y = (const bf16*)(P->ws + WS_Y);
    const float* lng = P->in[6] + (size_t)(L * 2 + 0) * DM; const float* lnb = P->in[7] + (size_t)(L * 2 + 0) * DM;
    for (int row = gw; row < Mrows; row += NGW) {
        const float* mod = MOD + (size_t)(L * 3 + row_slot(row)) * 12288;
        float z[32], y[32], g[32]; load_row_bf16(X + (size_t)row * DM, lane, z); load_row_bf16(Y + (size_t)row * DM, lane, y); load_row_f32(mod + 2 * 2048, lane, g);
#pragma unroll
        for (int i = 0; i < 32; ++i) z[i] = ALPHA * z[i] + g[i] * y[i];
        finish_row<false>(z, lng, lnb, X + (size_t)row * DM, mod + 3 * 2048, mod + 4 * 2048, H + (size_t)row * DM, nullptr, lane);
    }
}
__device__ __forceinline__ void vstats_pass(CP P, int Mrows, int lane, int gw, int NGW) {
    const bf16* Z = (const bf16*)(P->ws + WS_Z); float* VST = (float*)(P->ws + WS_VST);
    for (int row = gw; row < Mrows; row += NGW) {
        float v[32]; load_row_bf16(Z + (size_t)row * 4096 + 2048, lane, v);
        float mean, rstd; ln_stats(v, mean, rstd);
        if (lane == 0) { VST[2 * row] = mean; VST[2 * row + 1] = rstd; }
    }
}
#define XB_TMO      128
#define XB_XCNT(j)  (256  + 64 * (j))
#define XB_XSUB(j)  (1280 + 64 * (j))
#define XB_XGEN(j)  (2304 + 64 * (j))
#define XB_TOP      3328
#define XB_TOPGEN   3392
#define XCD_BAR_WORDS 3456
#define XB_SPIN_CAP (1u << 18)

__device__ __forceinline__ unsigned xb_ld(unsigned* p)              { return __hip_atomic_load(p, __ATOMIC_RELAXED, __HIP_MEMORY_SCOPE_AGENT); }
__device__ __forceinline__ unsigned xb_add(unsigned* p, unsigned v) { return __hip_atomic_fetch_add(p, v, __ATOMIC_RELAXED, __HIP_MEMORY_SCOPE_AGENT); }
__device__ __forceinline__ unsigned xb_xcc_id() { return (unsigned)__builtin_amdgcn_s_getreg((3 << 11) | 20) & 0xFu; }
#define XB_SPIN(cond, bar) do { unsigned _sp = 0; while (cond) { __builtin_amdgcn_s_sleep(1); \
    if ((++_sp & 255u) == 0u) { if (xb_ld(&(bar)[XB_TMO])) break; if (_sp > XB_SPIN_CAP) { atomicAdd(&(bar)[XB_TMO], 1u); break; } } } } while (0)

struct XcdBarrier {
    unsigned* bar; unsigned x;
    volatile LAS unsigned* st;
};

__device__ __forceinline__ XcdBarrier xcd_barrier_post(unsigned* bar, volatile LAS unsigned* st, const bool t0) {
    XcdBarrier b; b.bar = bar; b.x = xb_xcc_id(); b.st = st;
    if (t0) (void)xb_add(&bar[XB_XCNT(b.x)], 1u);
    return b;
}
__device__ __forceinline__ void xcd_barrier_complete(unsigned* bar, unsigned x, unsigned& nloc, unsigned& nx) {
    const unsigned G = gridDim.x * gridDim.y * gridDim.z;
    unsigned sum, cnt, mine, sp = 0u;
    for (;;) {
        sum = 0u; cnt = 0u; mine = 0u;
#pragma unroll
        for (unsigned j = 0; j < 16; ++j) { const unsigned c = xb_ld(&bar[XB_XCNT(j)]); sum += c; cnt += (c > 0u) ? 1u : 0u; mine = (j == x) ? c : mine; }
        if (sum == G) break;
        __builtin_amdgcn_s_sleep(1);
        if ((++sp & 255u) == 0u) { if (xb_ld(&bar[XB_TMO])) break; if (sp > XB_SPIN_CAP) { atomicAdd(&bar[XB_TMO], 1u); break; } }
    }
    nloc = mine > 0u ? mine : 1u; nx = cnt > 0u ? cnt : 1u;
}

__device__ __attribute__((noinline)) void xcd_barrier(const XcdBarrier b, const bool t0) {
    asm volatile("s_waitcnt vmcnt(0)" ::: "memory");
    __syncthreads();
    if (t0) {
        unsigned* bar = b.bar;
        __builtin_amdgcn_s_waitcnt(0);
        unsigned nloc = b.st[0], nx = b.st[1];
        if (nloc == 0u) { xcd_barrier_complete(bar, b.x, nloc, nx); b.st[0] = nloc; b.st[1] = nx; }
        const unsigned old = xb_add(&bar[XB_XSUB(b.x)], 1u);
        const unsigned gen = old / nloc;
        if (old + 1u == (gen + 1u) * nloc) {
            __builtin_amdgcn_fence(__ATOMIC_RELEASE, "agent");
            asm volatile("s_waitcnt vmcnt(0)" ::: "memory");
            const unsigned og = xb_add(&bar[XB_TOP], 1u);
            const unsigned tg = og / nx;
            if (og + 1u == (tg + 1u) * nx) xb_add(&bar[XB_TOPGEN], 1u);
            else XB_SPIN(xb_ld(&bar[XB_TOPGEN]) == tg, bar);
            __builtin_amdgcn_fence(__ATOMIC_ACQUIRE, "agent");
            xb_add(&bar[XB_XGEN(b.x)], 1u);
            asm volatile("s_waitcnt vmcnt(0)" ::: "memory");
        } else {
            XB_SPIN(xb_ld(&bar[XB_XGEN(b.x)]) == gen, bar);
            __builtin_amdgcn_fence(__ATOMIC_ACQUIRE, "agent");
            asm volatile("s_waitcnt vmcnt(0)" ::: "memory");
        }
    }
    __syncthreads();
}

__device__ __forceinline__ void spatial_phase(CP P, int j, int Mrows, LAS unsigned char* lds_, int tid, int lane, int wid) {
    const bf16* Z = (const bf16*)(P->ws + WS_Z); const float* VST = (const float*)(P->ws + WS_VST); bf16* Gb = (bf16*)(P->ws + WS_G);
    const bf16* WS = (const bf16*)(P->ws + WS_GMWS) + (size_t)j * 16 * 128 * 128;
    const float* lng = P->in[14] + (size_t)j * DM; const float* lnb = P->in[15] + (size_t)j * DM; const float* bs = P->in[17] + (size_t)j * 16 * 128;
    LAS bf16* Vt = (LAS bf16*)(LAS unsigned char*)lds_;
    constexpr int VP = 136;
    const int nunits = (Mrows / 128) * 16;
    for (int u = blockIdx.x; u < nunits; u += gridDim.x) {
        const int c = u >> 4, g = u & 15;
        __syncthreads();
        {
            const int q = tid >> 2, dq = (tid & 3) * 32; const int row = c * 128 + q;
            const float mean = VST[2 * row], rstd = VST[2 * row + 1];
            const bf16* src = Z + (size_t)row * 4096 + 2048 + g * 128 + dq;
#pragma unroll
            for (int t = 0; t < 4; ++t) { const u32x4 w = *(const u32x4*)(src + 8 * t);
                float v[8] = {bflo(w.x), bfhi(w.x), bflo(w.y), bfhi(w.y), bflo(w.z), bfhi(w.z), bflo(w.w), bfhi(w.w)};
                const float* gp = lng + g * 128 + dq + 8 * t; const float* bp = lnb + g * 128 + dq + 8 * t;
#pragma unroll
                for (int i = 0; i < 8; ++i) { const float vn = (v[i] - mean) * rstd * gp[i] + bp[i]; Vt[(dq + 8 * t + i) * VP + q] = tobf1(vn); } }
        }
        __syncthreads();
        const int fr = lane & 15, fq = lane >> 4;
        bf16x8 a[4];
        const bf16* wrow = WS + (size_t)g * 128 * 128 + (size_t)(16 * wid + fr) * 128 + 8 * fq;
#pragma unroll
        for (int ks = 0; ks < 4; ++ks) a[ks] = *(const bf16x8*)(wrow + 32 * ks);
#pragma unroll
        for (int nb = 0; nb < 8; ++nb) {
            f32x4 acc = {0.f, 0.f, 0.f, 0.f};
#pragma unroll
            for (int ks = 0; ks < 4; ++ks) { const bf16x8 b = *(const LAS bf16x8*)(Vt + (16 * nb + fr) * VP + 32 * ks + 8 * fq);
                acc = __builtin_amdgcn_mfma_f32_16x16x32_bf16(a[ks], b, acc, 0, 0, 0); }
#pragma unroll
            for (int r = 0; r < 4; ++r) { const int p = 16 * wid + fq * 4 + r, d = 16 * nb + fr; const size_t grow = (size_t)(c * 128 + p);
                const float sv = acc[r] + bs[g * 128 + p];
                const float uu = bf1(Z[grow * 4096 + g * 128 + d]);
                Gb[grow * 2048 + g * 128 + d] = tobf1(uu * sv); }
        }
    }
}

__device__ __forceinline__ void rope_cs(int row, int l, float& cs, float& sn) {
    const int t = row & (SEQ - 1); const int pos = (l & 32) ? (t & 63) : (t >> 6);
    const float inv = powf(10000.0f, -(float)(l & 15) * (1.0f / 16.0f));
    const float ang = (float)pos * inv; sincosf(ang, &sn, &cs);
}
__device__ __forceinline__ float rope_apply(float x, int l, float cs, float sn) {
    const float p = lane_xor16(x, l);
    return (l & 16) ? (p * sn + x * cs) : (x * cs - p * sn);
}
__device__ __forceinline__ void mla_norm_pass(CP P, int lane, int gw, int NGW) {
    const bf16* C = (const bf16*)(P->ws + WS_C); bf16* CQN = (bf16*)(P->ws + WS_CQN); bf16* CKVN = (bf16*)(P->ws + WS_CKVN); bf16* KR = (bf16*)(P->ws + WS_KR);
    const float* qn = P->in[20]; const float* kvn = P->in[21];
    for (int row = gw; row < MT; row += NGW) {
        const bf16* c = C + (size_t)row * 1280;
#pragma unroll
        for (int part = 0; part < 2; ++part) {
            const u32x4 w = *(const u32x4*)(c + part * 512 + 8 * lane);
            float v[8] = {bflo(w.x), bfhi(w.x), bflo(w.y), bfhi(w.y), bflo(w.z), bfhi(w.z), bflo(w.w), bfhi(w.w)};
            float ss = 0.f;
#pragma unroll
            for (int i = 0; i < 8; ++i) ss += v[i] * v[i];
            const float r = 1.0f / sqrtf(wave_sum(ss) * (1.0f / 512.0f) + LN_EPS);
            const float* nw = (part ? kvn : qn) + 8 * lane;
            u32x4 o; o.x = cvtpk(v[0] * r * nw[0], v[1] * r * nw[1]); o.y = cvtpk(v[2] * r * nw[2], v[3] * r * nw[3]); o.z = cvtpk(v[4] * r * nw[4], v[5] * r * nw[5]); o.w = cvtpk(v[6] * r * nw[6], v[7] * r * nw[7]);
            *(u32x4*)((part ? CKVN : CQN) + (size_t)row * 512 + 8 * lane) = o;
        }
        float x = bf1(c[1024 + lane]);
        if (row < ML) { float cs, sn; rope_cs(row, lane, cs, sn); x = rope_apply(x, lane, cs, sn); }
        KR[(size_t)row * 64 + lane] = tobf1(x);
    }
}
__device__ __forceinline__ void rope_pass(bf16* buf, int ld, int col0, int nchunks, int cstride, int lane, int gw, int NGW) {
    for (int row = gw; row < ML; row += NGW) {
        float cs, sn; rope_cs(row, lane, cs, sn);
        bf16* r = buf + (size_t)row * ld + col0 + lane;
#pragma unroll 4
        for (int k = 0; k < nchunks; ++k) { const float x = bf1(r[k * cstride]); r[k * cstride] = tobf1(rope_apply(x, lane, cs, sn)); }
    }
}

namespace att {
#ifndef ATT_LEAN
#define ATT_LEAN 1
#endif
#ifndef ATT_3STAGE
#define ATT_3STAGE 0
#endif
#ifndef ATT_PRIO
#define ATT_PRIO 0
#endif
#ifndef ATT_KMAJOR
#define ATT_KMAJOR 0
#endif
#ifndef ATT_TRB
#define ATT_TRB 1
#endif
#ifndef ATT_STAGGER
#define ATT_STAGGER 0
#endif
#ifndef ATT_SDEPTH
#define ATT_SDEPTH(MODE) ((MODE) == 0 ? 1 : 1)
#endif
#ifndef ATT_PVPIPE
#define ATT_PVPIPE(MODE) ((MODE) == 1)
#endif
#define SBAR() __builtin_amdgcn_sched_barrier(0)
__device__ __forceinline__ int crow(int r, int hi) { return (r & 3) + 8 * (r >> 2) + 4 * hi; }
__device__ __forceinline__ unsigned cvtpkv(float lo, float hi) { unsigned r; asm volatile("v_cvt_pk_bf16_f32 %0, %1, %2" : "=v"(r) : "v"(lo), "v"(hi)); return r; }

__device__ __forceinline__ void partialSM(f32x16& p0, f32x16& p1, float& m_reg, float& mn, float& alpha, const float C, const float THRS) {
  float pmax = p0[0];
#pragma unroll
  for (int r = 1; r < 16; ++r) pmax = fmaxf(pmax, p0[r]);
#pragma unroll
  for (int r = 0; r < 16; ++r) pmax = fmaxf(pmax, p1[r]);
  { auto rr = __builtin_amdgcn_permlane32_swap(__float_as_uint(pmax), __float_as_uint(pmax), false, false);
    pmax = fmaxf(__uint_as_float(rr[0]), __uint_as_float(rr[1])); }
  if (__builtin_expect(__all(pmax - m_reg <= THRS), 1)) { mn = m_reg; alpha = 1.f; }
  else { mn = fmaxf(m_reg, pmax); alpha = __builtin_amdgcn_exp2f((m_reg - mn) * C); m_reg = mn; }
  const float mnC = -mn * C;
#pragma unroll
  for (int r = 0; r < 16; ++r) p0[r] = fmaf(p0[r], C, mnC);
#pragma unroll
  for (int r = 0; r < 16; ++r) p1[r] = fmaf(p1[r], C, mnC);
#pragma unroll
  for (int r = 0; r < 16; ++r) p0[r] = __builtin_amdgcn_exp2f(p0[r]);
}
__device__ __forceinline__ void finishSM(f32x16& p0, f32x16& p1, float alpha, float& l_reg, bf16x8& pa0, bf16x8& pa1, bf16x8& pa2, bf16x8& pa3) {
#pragma unroll
  for (int r = 0; r < 16; ++r) p1[r] = __builtin_amdgcn_exp2f(p1[r]);
  float ps = 0;
#pragma unroll
  for (int r = 0; r < 16; ++r) ps += p0[r];
#pragma unroll
  for (int r = 0; r < 16; ++r) ps += p1[r];
  { auto rr = __builtin_amdgcn_permlane32_swap(__float_as_uint(ps), __float_as_uint(ps), false, false);
    ps = __uint_as_float(rr[0]) + __uint_as_float(rr[1]); }
  l_reg = l_reg * alpha + ps;
#define PK4(P, BASE, OUT) do { unsigned a0 = cvtpkv(P[BASE + 0], P[BASE + 1]), a1 = cvtpkv(P[BASE + 2], P[BASE + 3]);   \
    unsigned b0 = cvtpkv(P[BASE + 4], P[BASE + 5]), b1 = cvtpkv(P[BASE + 6], P[BASE + 7]);                              \
    auto r0 = __builtin_amdgcn_permlane32_swap(a0, b0, false, false); auto r1 = __builtin_amdgcn_permlane32_swap(a1, b1, false, false); \
    u32x4 w = {r0[0], r1[0], r0[1], r1[1]}; OUT = *reinterpret_cast<bf16x8*>(&w); } while (0)
  PK4(p0, 0, pa0); PK4(p0, 8, pa1); PK4(p1, 0, pa2); PK4(p1, 8, pa3);
#undef PK4
}
__device__ __forceinline__ void partialSM_lean(f32x16& p0, f32x16& p1, f32x16& nm, float& alpha, const bool first) {
  constexpr float THR2 = 11.541560327111707f;
  float dmax = p0[0];
#pragma unroll
  for (int r = 1; r < 16; ++r) dmax = fmaxf(dmax, p0[r]);
#pragma unroll
  for (int r = 0; r < 16; ++r) dmax = fmaxf(dmax, p1[r]);
  { auto rr = __builtin_amdgcn_permlane32_swap(__float_as_uint(dmax), __float_as_uint(dmax), false, false);
    dmax = fmaxf(__uint_as_float(rr[0]), __uint_as_float(rr[1])); }
  alpha = 1.f;
  if (first || !__all(dmax <= THR2)) {
    const float delta = first ? dmax : (dmax > THR2 ? dmax : 0.f);
    if (!first) alpha = __builtin_amdgcn_exp2f(-delta);
#pragma unroll
    for (int r = 0; r < 16; ++r) { p0[r] -= delta; p1[r] -= delta; nm[r] -= delta; }
  }
#pragma unroll
  for (int r = 0; r < 16; ++r) p0[r] = __builtin_amdgcn_exp2f(p0[r]);
}
__device__ __forceinline__ void finishSM_lean(f32x16& p0, f32x16& p1, bf16x8& pa0, bf16x8& pa1, bf16x8& pa2, bf16x8& pa3) {
#pragma unroll
  for (int r = 0; r < 16; ++r) p1[r] = __builtin_amdgcn_exp2f(p1[r]);
#define PK4(P, BASE, OUT) do { unsigned a0 = cvtpkv(P[BASE + 0], P[BASE + 1]), a1 = cvtpkv(P[BASE + 2], P[BASE + 3]);   \
    unsigned b0 = cvtpkv(P[BASE + 4], P[BASE + 5]), b1 = cvtpkv(P[BASE + 6], P[BASE + 7]);                              \
    auto r0 = __builtin_amdgcn_permlane32_swap(a0, b0, false, false); auto r1 = __builtin_amdgcn_permlane32_swap(a1, b1, false, false); \
    u32x4 w = {r0[0], r1[0], r0[1], r1[1]}; OUT = *reinterpret_cast<bf16x8*>(&w); } while (0)
  PK4(p0, 0, pa0); PK4(p0, 8, pa1); PK4(p1, 0, pa2); PK4(p1, 8, pa3);
#undef PK4
}
__device__ __forceinline__ bf16x8 scale_bf16x8(bf16x8 v, float c) {
  const u32x4 w = *reinterpret_cast<u32x4*>(&v); u32x4 o;
  o.x = cvtpk(bflo(w.x) * c, bfhi(w.x) * c); o.y = cvtpk(bflo(w.y) * c, bfhi(w.y) * c); o.z = cvtpk(bflo(w.z) * c, bfhi(w.z) * c); o.w = cvtpk(bflo(w.w) * c, bfhi(w.w) * c);
  return *reinterpret_cast<bf16x8*>(&o);
}
template <int PITCH> __device__ __forceinline__ int kswz(int r) { return PITCH == 256 ? (r & 15) : ((r >> 1) & 7); }
template <int NQF, int NQR, int PITCH> __device__ __forceinline__ void qkt(f32x16& p0, f32x16& p1, const LAS char* Ks, int chunk0, const bf16x8* qr, const LAS char* ql, int r32, int hi, const f32x16 init = f32x16{}) {
  p0 = init; p1 = init;
  const int sw = kswz<PITCH>(r32);
#pragma unroll
  for (int d0 = 0; d0 < NQF; ++d0) { const int off = ((chunk0 + d0 * 2 + hi) ^ sw) * 16;
    const bf16x8 b0 = *(const LAS bf16x8*)(Ks + r32 * PITCH + off);
    const bf16x8 b1 = *(const LAS bf16x8*)(Ks + (32 + r32) * PITCH + off);
    const bf16x8 q = d0 < NQR ? qr[d0 < NQR ? d0 : 0] : *(const LAS bf16x8*)(ql + (d0 - NQR < 0 ? 0 : d0 - NQR) * 1024);
    p0 = __builtin_amdgcn_mfma_f32_32x32x16_bf16(b0, q, p0, 0, 0, 0);
    p1 = __builtin_amdgcn_mfma_f32_32x32x16_bf16(b1, q, p1, 0, 0, 0); }
}
__device__ __forceinline__ int v_st(int k, int c) { const int kk = (k & ~0xC) | ((k & 4) << 1) | ((k & 8) >> 1); return ((kk >> 3) * 4 + (c >> 5)) * 512 + ((kk & 7) * 32 + (c & 31)) * 2; }
__device__ __forceinline__ int v_rd_base(int lane) { return ((lane & 3) << 3) | (((lane >> 2) & 3) << 6) | (((lane >> 4) & 1) << 5) | (((lane >> 5) & 1) << 8); }
constexpr int v_rd_off(int d0, int ks, int half) { return d0 * 512 + ks * 4096 + half * 2048; }
template <int OFF> __device__ __forceinline__ s16x4 tr_read(int vb) {
  s16x4 r; asm volatile("ds_read_b64_tr_b16 %0, %1 offset:%2" : "=&v"(r) : "v"(vb), "i"(OFF) : "memory"); return r;
}
template <int D0> __device__ __forceinline__ void pv_one(f32x16& od, int vb, bf16x8 pa0, bf16x8 pa1, bf16x8 pa2, bf16x8 pa3) {
  const s16x4 l0 = tr_read<v_rd_off(D0, 0, 0)>(vb), h0 = tr_read<v_rd_off(D0, 0, 1)>(vb), l1 = tr_read<v_rd_off(D0, 1, 0)>(vb), h1 = tr_read<v_rd_off(D0, 1, 1)>(vb);
  const s16x4 l2 = tr_read<v_rd_off(D0, 2, 0)>(vb), h2 = tr_read<v_rd_off(D0, 2, 1)>(vb), l3 = tr_read<v_rd_off(D0, 3, 0)>(vb), h3 = tr_read<v_rd_off(D0, 3, 1)>(vb);
  asm volatile("s_waitcnt lgkmcnt(0)" ::: "memory"); SBAR();
#define PK(L, H) (bf16x8){L[0], L[1], L[2], L[3], H[0], H[1], H[2], H[3]}
  od = __builtin_amdgcn_mfma_f32_32x32x16_bf16(pa0, PK(l0, h0), od, 0, 0, 0);
  od = __builtin_amdgcn_mfma_f32_32x32x16_bf16(pa1, PK(l1, h1), od, 0, 0, 0);
  od = __builtin_amdgcn_mfma_f32_32x32x16_bf16(pa2, PK(l2, h2), od, 0, 0, 0);
  od = __builtin_amdgcn_mfma_f32_32x32x16_bf16(pa3, PK(l3, h3), od, 0, 0, 0);
#undef PK
}
__device__ __forceinline__ void pv_d0(f32x16* o, int vb, bf16x8 pa0, bf16x8 pa1, bf16x8 pa2, bf16x8 pa3) {
  pv_one<0>(o[0], vb, pa0, pa1, pa2, pa3); pv_one<1>(o[1], vb, pa0, pa1, pa2, pa3); pv_one<2>(o[2], vb, pa0, pa1, pa2, pa3); pv_one<3>(o[3], vb, pa0, pa1, pa2, pa3);
}
struct VFrag { s16x4 l0, h0, l1, h1, l2, h2, l3, h3; };
typedef short v4i16_t __attribute__((ext_vector_type(4)));
template <int OFF> __device__ __forceinline__ s16x4 tr_read_b(int vb) {
  return __builtin_bit_cast(s16x4, __builtin_amdgcn_ds_read_tr16_b64_v4i16((LAS v4i16_t*)(uintptr_t)(unsigned)(vb + OFF)));
}
template <int D0> __device__ __forceinline__ void tr8b(VFrag& f, int vb) {
  f.l0 = tr_read_b<v_rd_off(D0, 0, 0)>(vb); f.h0 = tr_read_b<v_rd_off(D0, 0, 1)>(vb); f.l1 = tr_read_b<v_rd_off(D0, 1, 0)>(vb); f.h1 = tr_read_b<v_rd_off(D0, 1, 1)>(vb);
  f.l2 = tr_read_b<v_rd_off(D0, 2, 0)>(vb); f.h2 = tr_read_b<v_rd_off(D0, 2, 1)>(vb); f.l3 = tr_read_b<v_rd_off(D0, 3, 0)>(vb); f.h3 = tr_read_b<v_rd_off(D0, 3, 1)>(vb);
}
template <int D0> __device__ __forceinline__ void tr8(VFrag& f, int vb) {
  f.l0 = tr_read<v_rd_off(D0, 0, 0)>(vb); f.h0 = tr_read<v_rd_off(D0, 0, 1)>(vb); f.l1 = tr_read<v_rd_off(D0, 1, 0)>(vb); f.h1 = tr_read<v_rd_off(D0, 1, 1)>(vb);
  f.l2 = tr_read<v_rd_off(D0, 2, 0)>(vb); f.h2 = tr_read<v_rd_off(D0, 2, 1)>(vb); f.l3 = tr_read<v_rd_off(D0, 3, 0)>(vb); f.h3 = tr_read<v_rd_off(D0, 3, 1)>(vb);
}
__device__ __forceinline__ void mfma4(f32x16& od, VFrag& f, bf16x8 pa0, bf16x8 pa1, bf16x8 pa2, bf16x8 pa3) {
#define PK(L, H) (bf16x8){L[0], L[1], L[2], L[3], H[0], H[1], H[2], H[3]}
  od = __builtin_amdgcn_mfma_f32_32x32x16_bf16(pa0, PK(f.l0, f.h0), od, 0, 0, 0);
  od = __builtin_amdgcn_mfma_f32_32x32x16_bf16(pa1, PK(f.l1, f.h1), od, 0, 0, 0);
  od = __builtin_amdgcn_mfma_f32_32x32x16_bf16(pa2, PK(f.l2, f.h2), od, 0, 0, 0);
  od = __builtin_amdgcn_mfma_f32_32x32x16_bf16(pa3, PK(f.l3, f.h3), od, 0, 0, 0);
#undef PK
}
#define VF_TIE(f) "+v"(f.l0), "+v"(f.h0), "+v"(f.l1), "+v"(f.h1), "+v"(f.l2), "+v"(f.h2), "+v"(f.l3), "+v"(f.h3)
__device__ __forceinline__ void pv_pipe(f32x16* o, int vb, bf16x8 pa0, bf16x8 pa1, bf16x8 pa2, bf16x8 pa3) {
  VFrag A, B;
  asm volatile("s_waitcnt lgkmcnt(0)" ::: "memory");
  tr8<0>(A, vb); tr8<1>(B, vb);
  asm volatile("s_waitcnt lgkmcnt(8)" : VF_TIE(A) :: "memory");
  mfma4(o[0], A, pa0, pa1, pa2, pa3);
  tr8<2>(A, vb);
  asm volatile("s_waitcnt lgkmcnt(8)" : VF_TIE(B) :: "memory");
  mfma4(o[1], B, pa0, pa1, pa2, pa3);
  tr8<3>(B, vb);
  asm volatile("s_waitcnt lgkmcnt(8)" : VF_TIE(A) :: "memory");
  mfma4(o[2], A, pa0, pa1, pa2, pa3);
  asm volatile("s_waitcnt lgkmcnt(0)" : VF_TIE(B) :: "memory");
  mfma4(o[3], B, pa0, pa1, pa2, pa3);
}
__device__ __forceinline__ void pv_psm_lean(f32x16* o, int vb, bf16x8 pa0, bf16x8 pa1, bf16x8 pa2, bf16x8 pa3, f32x16& p0, f32x16& p1, f32x16& nm, float& alpha) {
  constexpr float THR2 = 11.541560327111707f;
  const bf16x8 one8 = {0x3F80, 0x3F80, 0x3F80, 0x3F80, 0x3F80, 0x3F80, 0x3F80, 0x3F80};
  VFrag A, B;
  asm volatile("s_waitcnt lgkmcnt(0)" ::: "memory");
  tr8<0>(A, vb); tr8<1>(B, vb);
  asm volatile("s_waitcnt lgkmcnt(8)" : VF_TIE(A) :: "memory");
  mfma4(o[0], A, pa0, pa1, pa2, pa3);
  float dmax = p0[0];
#pragma unroll
  for (int r = 1; r < 16; ++r) dmax = fmaxf(dmax, p0[r]);
  tr8<2>(A, vb);
  asm volatile("s_waitcnt lgkmcnt(8)" : VF_TIE(B) :: "memory");
  mfma4(o[1], B, pa0, pa1, pa2, pa3);
#pragma unroll
  for (int r = 0; r < 16; ++r) dmax = fmaxf(dmax, p1[r]);
  { auto rr = __builtin_amdgcn_permlane32_swap(__float_as_uint(dmax), __float_as_uint(dmax), false, false);
    dmax = fmaxf(__uint_as_float(rr[0]), __uint_as_float(rr[1])); }
  alpha = 1.f;
  if (!__all(dmax <= THR2)) {
    const float delta = dmax > THR2 ? dmax : 0.f; alpha = __builtin_amdgcn_exp2f(-delta);
#pragma unroll
    for (int r = 0; r < 16; ++r) { p0[r] -= delta; p1[r] -= delta; nm[r] -= delta; }
  }
  tr8<3>(B, vb);
  asm volatile("s_waitcnt lgkmcnt(8)" : VF_TIE(A) :: "memory");
  mfma4(o[2], A, pa0, pa1, pa2, pa3);
#pragma unroll
  for (int r = 0; r < 8; ++r) p0[r] = __builtin_amdgcn_exp2f(p0[r]);
  asm volatile("s_waitcnt lgkmcnt(0)" : VF_TIE(B) :: "memory");
  mfma4(o[3], B, pa0, pa1, pa2, pa3);
#pragma unroll
  for (int r = 8; r < 16; ++r) p0[r] = __builtin_amdgcn_exp2f(p0[r]);
  o[4] = __builtin_amdgcn_mfma_f32_32x32x16_bf16(pa0, one8, o[4], 0, 0, 0); o[4] = __builtin_amdgcn_mfma_f32_32x32x16_bf16(pa1, one8, o[4], 0, 0, 0);
  o[4] = __builtin_amdgcn_mfma_f32_32x32x16_bf16(pa2, one8, o[4], 0, 0, 0); o[4] = __builtin_amdgcn_mfma_f32_32x32x16_bf16(pa3, one8, o[4], 0, 0, 0);
}
__device__ __forceinline__ void pv_psm_lean_b(f32x16* o, int vb, bf16x8 pa0, bf16x8 pa1, bf16x8 pa2, bf16x8 pa3, f32x16& p0, f32x16& p1, f32x16& nm, float& alpha) {
  constexpr float THR2 = 11.541560327111707f;
  const bf16x8 one8 = {0x3F80, 0x3F80, 0x3F80, 0x3F80, 0x3F80, 0x3F80, 0x3F80, 0x3F80};
  VFrag A, B;
  tr8b<0>(A, vb); tr8b<1>(B, vb);
  mfma4(o[0], A, pa0, pa1, pa2, pa3);
  float dmax = p0[0];
#pragma unroll
  for (int r = 1; r < 16; ++r) dmax = fmaxf(dmax, p0[r]);
  tr8b<2>(A, vb);
  mfma4(o[1], B, pa0, pa1, pa2, pa3);
#pragma unroll
  for (int r = 0; r < 16; ++r) dmax = fmaxf(dmax, p1[r]);
  { auto rr = __builtin_amdgcn_permlane32_swap(__float_as_uint(dmax), __float_as_uint(dmax), false, false);
    dmax = fmaxf(__uint_as_float(rr[0]), __uint_as_float(rr[1])); }
  alpha = 1.f;
  if (!__all(dmax <= THR2)) {
    const float delta = dmax > THR2 ? dmax : 0.f; alpha = __builtin_amdgcn_exp2f(-delta);
#pragma unroll
    for (int r = 0; r < 16; ++r) { p0[r] -= delta; p1[r] -= delta; nm[r] -= delta; }
  }
  tr8b<3>(B, vb);
  mfma4(o[2], A, pa0, pa1, pa2, pa3);
#pragma unroll
  for (int r = 0; r < 8; ++r) p0[r] = __builtin_amdgcn_exp2f(p0[r]);
  mfma4(o[3], B, pa0, pa1, pa2, pa3);
#pragma unroll
  for (int r = 8; r < 16; ++r) p0[r] = __builtin_amdgcn_exp2f(p0[r]);
  o[4] = __builtin_amdgcn_mfma_f32_32x32x16_bf16(pa0, one8, o[4], 0, 0, 0); o[4] = __builtin_amdgcn_mfma_f32_32x32x16_bf16(pa1, one8, o[4], 0, 0, 0);
  o[4] = __builtin_amdgcn_mfma_f32_32x32x16_bf16(pa2, one8, o[4], 0, 0, 0); o[4] = __builtin_amdgcn_mfma_f32_32x32x16_bf16(pa3, one8, o[4], 0, 0, 0);
}
struct VStep { s16x4 l0, h0, l1, h1, l2, h2, l3, h3; };
template <int KS> __device__ __forceinline__ void trstep(VStep& f, int vb) {
  f.l0 = tr_read_b<v_rd_off(0, KS, 0)>(vb); f.h0 = tr_read_b<v_rd_off(0, KS, 1)>(vb); f.l1 = tr_read_b<v_rd_off(1, KS, 0)>(vb); f.h1 = tr_read_b<v_rd_off(1, KS, 1)>(vb);
  f.l2 = tr_read_b<v_rd_off(2, KS, 0)>(vb); f.h2 = tr_read_b<v_rd_off(2, KS, 1)>(vb); f.l3 = tr_read_b<v_rd_off(3, KS, 0)>(vb); f.h3 = tr_read_b<v_rd_off(3, KS, 1)>(vb);
}
__device__ __forceinline__ void mfma5(f32x16* o, const VStep& f, bf16x8 pa) {
  const bf16x8 one8 = {0x3F80, 0x3F80, 0x3F80, 0x3F80, 0x3F80, 0x3F80, 0x3F80, 0x3F80};
#define PK(L, H) (bf16x8){L[0], L[1], L[2], L[3], H[0], H[1], H[2], H[3]}
  o[0] = __builtin_amdgcn_mfma_f32_32x32x16_bf16(pa, PK(f.l0, f.h0), o[0], 0, 0, 0);
  o[1] = __builtin_amdgcn_mfma_f32_32x32x16_bf16(pa, PK(f.l1, f.h1), o[1], 0, 0, 0);
  o[2] = __builtin_amdgcn_mfma_f32_32x32x16_bf16(pa, PK(f.l2, f.h2), o[2], 0, 0, 0);
  o[3] = __builtin_amdgcn_mfma_f32_32x32x16_bf16(pa, PK(f.l3, f.h3), o[3], 0, 0, 0);
  o[4] = __builtin_amdgcn_mfma_f32_32x32x16_bf16(pa, one8, o[4], 0, 0, 0);
#undef PK
}
template <int BASE> __device__ __forceinline__ bf16x8 pk4e(const f32x16& P) {
  const float e0 = __builtin_amdgcn_exp2f(P[BASE + 0]), e1 = __builtin_amdgcn_exp2f(P[BASE + 1]), e2 = __builtin_amdgcn_exp2f(P[BASE + 2]), e3 = __builtin_amdgcn_exp2f(P[BASE + 3]);
  const float e4 = __builtin_amdgcn_exp2f(P[BASE + 4]), e5 = __builtin_amdgcn_exp2f(P[BASE + 5]), e6 = __builtin_amdgcn_exp2f(P[BASE + 6]), e7 = __builtin_amdgcn_exp2f(P[BASE + 7]);
  const unsigned a0 = cvtpk(e0, e1), a1 = cvtpk(e2, e3), b0 = cvtpk(e4, e5), b1 = cvtpk(e6, e7);
  const auto r0 = __builtin_amdgcn_permlane32_swap(a0, b0, false, false); const auto r1 = __builtin_amdgcn_permlane32_swap(a1, b1, false, false);
  u32x4 w = {r0[0], r1[0], r0[1], r1[1]}; return *reinterpret_cast<bf16x8*>(&w);
}
__device__ __forceinline__ float rowmax_lean(const f32x16& p0, const f32x16& p1) {
  float d = p0[0];
#pragma unroll
  for (int r = 1; r < 16; ++r) d = fmaxf(d, p0[r]);
#pragma unroll
  for (int r = 0; r < 16; ++r) d = fmaxf(d, p1[r]);
  const auto rr = __builtin_amdgcn_permlane32_swap(__float_as_uint(d), __float_as_uint(d), false, false);
  return fmaxf(__uint_as_float(rr[0]), __uint_as_float(rr[1]));
}
__device__ __forceinline__ void shift_lean(float dmax, f32x16& p0, f32x16& p1, f32x16& nm, float& alpha, const bool first) {
  constexpr float THR2 = 11.541560327111707f;
  alpha = 1.f;
  if (first || !__all(dmax <= THR2)) {
    const float delta = first ? dmax : (dmax > THR2 ? dmax : 0.f);
    if (!first) alpha = __builtin_amdgcn_exp2f(-delta);
#pragma unroll
    for (int r = 0; r < 16; ++r) { p0[r] -= delta; p1[r] -= delta; nm[r] -= delta; }
  }
}
#define SGB(mask, n) __builtin_amdgcn_sched_group_barrier((mask), (n), 0)
__device__ __forceinline__ bf16x8 ld8(const bf16* p) { return *reinterpret_cast<const bf16x8*>(p); }

template <int MODE, int ATTV = 0>
__device__ __forceinline__ void attn_unit(const bf16* __restrict__ Qrow0, int ldq, const bf16* __restrict__ Kb, const bf16* __restrict__ Vb, int ldk, const bf16* __restrict__ KRb,
                                          int b, int nct, int NT, bf16* __restrict__ Ob, float lam, const float* __restrict__ subln, float oscale, LAS unsigned char* lds_, const int tid_in) {
  constexpr bool LEAN = (MODE == 1) && ATT_LEAN; constexpr int NQF = MODE == 0 ? 12 : 4, NQR = MODE == 0 ? 4 : 0, NOB = LEAN ? 5 : 4, PITCH = MODE == 0 ? 384 : 256, SHM_V = 16384, SHM_K = 64 * PITCH, SDEPTH = ATT_SDEPTH(MODE); constexpr bool PVPIPE = ATT_PVPIPE(MODE);
  const float SCALE = MODE == 0 ? 0.07216878364870323f : 0.125f;
  const float C = SCALE * 1.4426950408889634f, THRS = 8.f / SCALE;
  if (ATT_PRIO) { if (__builtin_amdgcn_readfirstlane(tid_in >> 8) != 0) __builtin_amdgcn_s_setprio(1); }
  const int tid = launder_v(tid_in) & 511, wid = tid >> 6, lane = tid & 63, r32 = lane & 31, hi = lane >> 5;
  LAS char* lds = (LAS char*)(LAS unsigned char*)lds_;
  constexpr bool THREE = (MODE == 1) && ATT_3STAGE; constexpr int NSTG = THREE ? 3 : 2, STG = SHM_V + SHM_K, SCR0 = NSTG * STG;
#define VOFF(s) (!THREE ? (s) * SHM_V : (s) * STG)
#define KOFF(s) (!THREE ? 2 * SHM_V + (s) * SHM_K : (s) * STG + SHM_V)
  LAS char* V_lds = lds; LAS char* K_lds = lds;
  LAS float* wsf = (LAS float*)(lds + NSTG * (SHM_V + SHM_K)) + wid * 64; LAS float* li_l = wsf; LAS float* al_l = wsf + 32;
  const int wq = MODE == 0 ? wid : (wid & 3), sgrp = MODE == 0 ? 0 : (wid >> 2);
  float m_reg = -1e30f, l_reg = 0; f32x16 o[NOB] = {}; bf16x8 qr[NQR > 0 ? NQR : 1]; f32x16 nm = {};
  LAS char* ql = lds + SCR0 + 2048 + wid * (MODE == 0 ? 8192 : 4096) + lane * 16;
  const bf16* Qw = Qrow0 + (size_t)(wq * 32 + r32) * ldq + sgrp * 64 + hi * 8;
#pragma unroll
  for (int d0 = 0; d0 < NQR; ++d0) qr[d0] = ld8(Qw + d0 * 16);
#pragma unroll
  for (int d0 = NQR; d0 < NQF; ++d0) { bf16x8 qv = ld8(Qw + d0 * 16); if (LEAN) qv = scale_bf16x8(qv, C); *(LAS bf16x8*)(ql + (d0 - NQR) * 1024) = qv; }
  const int sr = tid >> 4, sc = (tid & 15) * 8, vst0 = v_st(sr, sc), vst1 = v_st(32 + sr, sc);
  const int kst0 = sr * PITCH + (((tid & 15) ^ kswz<PITCH>(sr)) * 16), kst1 = kst0 + 32 * PITCH;
  const int rrow = tid >> 3, krs = rrow * PITCH + (((16 + (tid & 7)) ^ kswz<PITCH>(rrow)) * 16);
  const int chunk0 = sgrp * 8;
  const int vb0 = (int)(uintptr_t)V_lds + v_rd_base(lane);
  struct Slot { bf16x8 vs0, vs1, ks0, ks1, kr; } sr_[SDEPTH];
#define KROW(jt) ((jt) < nct ? (ML + b * CTXL + (jt) * 64) : (b * SEQ + ((jt) - nct) * 64))
#define SLOAD(i, jt) do { const int k0_ = KROW(jt); sr_[i].vs0 = ld8(Vb + (size_t)(k0_ + sr) * ldk + sc); sr_[i].vs1 = ld8(Vb + (size_t)(k0_ + 32 + sr) * ldk + sc); \
    sr_[i].ks0 = ld8(Kb + (size_t)(k0_ + sr) * ldk + sc); sr_[i].ks1 = ld8(Kb + (size_t)(k0_ + 32 + sr) * ldk + sc); \
    if (MODE == 0) sr_[i].kr = ld8(KRb + (size_t)(k0_ + rrow) * 64 + (tid & 7) * 8); } while (0)
#define SWRITE(bf, i) do { *(LAS bf16x8*)(V_lds + VOFF(bf) + vst0) = sr_[i].vs0; *(LAS bf16x8*)(V_lds + VOFF(bf) + vst1) = sr_[i].vs1; \
    *(LAS bf16x8*)(K_lds + KOFF(bf) + kst0) = sr_[i].ks0; *(LAS bf16x8*)(K_lds + KOFF(bf) + kst1) = sr_[i].ks1; \
    if (MODE == 0) *(LAS bf16x8*)(K_lds + KOFF(bf) + krs) = sr_[i].kr; } while (0)
#define SWAIT() do { if constexpr (SDEPTH == 2) asm volatile("s_waitcnt vmcnt(4)" ::: "memory"); else asm volatile("s_waitcnt vmcnt(0)" ::: "memory"); } while (0)
#define RESC(a) do { if (__any((a) < 1.f)) { if (hi == 0) al_l[r32] = (a); asm volatile("s_waitcnt lgkmcnt(0)" ::: "memory"); \
    _Pragma("unroll") for (int d = 0; d < NOB; ++d) _Pragma("unroll") for (int r = 0; r < 16; ++r) o[d][r] *= al_l[crow(r, hi)]; } } while (0)
#define PV(vb_) do { if constexpr (ATTV == 2) { o[0][0] += __uint_as_float((unsigned)pa0[0] + (unsigned)pa3[1]); } else if constexpr (PVPIPE) pv_pipe(o, (vb_), pa0, pa1, pa2, pa3); else pv_d0(o, (vb_), pa0, pa1, pa2, pa3); \
    if constexpr (LEAN) { const bf16x8 one8 = {0x3F80, 0x3F80, 0x3F80, 0x3F80, 0x3F80, 0x3F80, 0x3F80, 0x3F80};     \
        o[NOB - 1] = __builtin_amdgcn_mfma_f32_32x32x16_bf16(pa0, one8, o[NOB - 1], 0, 0, 0); o[NOB - 1] = __builtin_amdgcn_mfma_f32_32x32x16_bf16(pa1, one8, o[NOB - 1], 0, 0, 0); \
        o[NOB - 1] = __builtin_amdgcn_mfma_f32_32x32x16_bf16(pa2, one8, o[NOB - 1], 0, 0, 0); o[NOB - 1] = __builtin_amdgcn_mfma_f32_32x32x16_bf16(pa3, one8, o[NOB - 1], 0, 0, 0); } } while (0)
#define PSM(p0_, p1_, mn_, al_, first_) do { if constexpr (ATTV == 1) { al_ = 1.f; } else if constexpr (LEAN) partialSM_lean(p0_, p1_, nm, al_, first_); else partialSM(p0_, p1_, m_reg, mn_, al_, C, THRS); } while (0)
#define FSM(p0_, p1_, al_) do { if constexpr (ATTV == 1) { u32x4 w0_ = {__float_as_uint(p0_[0]), __float_as_uint(p0_[1]), __float_as_uint(p1_[0]), __float_as_uint(p1_[1])}; pa0 = pa1 = pa2 = pa3 = *reinterpret_cast<bf16x8*>(&w0_); } else if constexpr (LEAN) finishSM_lean(p0_, p1_, pa0, pa1, pa2, pa3); else finishSM(p0_, p1_, al_, l_reg, pa0, pa1, pa2, pa3); } while (0)
#define QKT(p0_, p1_, Kp_) do { if constexpr (ATTV == 5) { p0_ = nm; p1_ = nm; p0_[0] += (float)r32; } else if constexpr (LEAN) qkt<NQF, NQR, PITCH>(p0_, p1_, Kp_, chunk0, qr, ql, r32, hi, nm); else qkt<NQF, NQR, PITCH>(p0_, p1_, Kp_, chunk0, qr, ql, r32, hi); } while (0)
  f32x16 pA0, pA1, pB0, pB1; float mnA, mnB, alA, alB; bf16x8 pa0, pa1, pa2, pa3;
  constexpr bool KMAJ = (MODE == 1) && LEAN && ATT_KMAJOR && (ATTV == 0) && !THREE;
  if constexpr (KMAJ) {
    VStep VA, VB;
#define KSTEPS(PC0, PC1, ALC, PP0, PP1, KC, VP, LD, DOQK) do { const int vb_ = vb0 + VOFF(VP); float dmx_ = 0.f; \
      SBAR(); \
      if (DOQK) QKT(PC0, PC1, K_lds + KOFF(KC)); \
      pa0 = pk4e<0>(PP0); trstep<0>(VA, vb_); \
      _Pragma("unroll") for (int i_ = 0; i_ < 8; ++i_) { SGB(0x008, 1); SGB(0x100, 3); SGB(0x002, 2); } \
      SBAR(); LD; SBAR(); \
      mfma5(o, VA, pa0); pa1 = pk4e<8>(PP0); trstep<1>(VB, vb_); \
      _Pragma("unroll") for (int i_ = 0; i_ < 5; ++i_) { SGB(0x008, 1); SGB(0x100, 2); SGB(0x002, 3); } \
      SBAR(); \
      mfma5(o, VB, pa1); pa2 = pk4e<0>(PP1); trstep<2>(VA, vb_); \
      _Pragma("unroll") for (int i_ = 0; i_ < 5; ++i_) { SGB(0x008, 1); SGB(0x100, 2); SGB(0x002, 3); } \
      SBAR(); \
      mfma5(o, VA, pa2); pa3 = pk4e<8>(PP1); trstep<3>(VB, vb_); \
      _Pragma("unroll") for (int i_ = 0; i_ < 5; ++i_) { SGB(0x008, 1); SGB(0x100, 2); SGB(0x002, 3); } \
      SBAR(); \
      mfma5(o, VB, pa3); if (DOQK) dmx_ = rowmax_lean(PC0, PC1); \
      _Pragma("unroll") for (int i_ = 0; i_ < 5; ++i_) { SGB(0x008, 1); SGB(0x002, 7); } \
      SBAR(); \
      if (DOQK) shift_lean(dmx_, PC0, PC1, nm, ALC, false); } while (0)
    SLOAD(0, 0); asm volatile("s_waitcnt vmcnt(0)" ::: "memory"); SWRITE(0, 0); __syncthreads();
    QKT(pA0, pA1, K_lds + KOFF(0)); shift_lean(rowmax_lean(pA0, pA1), pA0, pA1, nm, alA, true);
    SLOAD(0, 1); asm volatile("s_waitcnt vmcnt(0)" ::: "memory"); SWRITE(1, 0); __syncthreads();
    for (int j = 1; j + 1 < NT; j += 2) {
      KSTEPS(pB0, pB1, alB, pA0, pA1, 1, 0, SLOAD(0, j + 1), true);
      __syncthreads(); asm volatile("s_waitcnt vmcnt(0)" ::: "memory"); SWRITE(0, 0);
      RESC(alB); __syncthreads();
      KSTEPS(pA0, pA1, alA, pB0, pB1, 0, 1, SLOAD(0, j + 2), true);
      __syncthreads(); asm volatile("s_waitcnt vmcnt(0)" ::: "memory"); SWRITE(1, 0);
      RESC(alA); __syncthreads();
    }
    KSTEPS(pB0, pB1, alB, pA0, pA1, 1, 0, (void)0, true);
    __syncthreads(); RESC(alB);
    KSTEPS(pA0, pA1, alA, pB0, pB1, 0, 1, (void)0, false);
#undef KSTEPS
  } else if constexpr (!THREE) {
  constexpr int SE = 0, SO = SDEPTH - 1;
  SLOAD(SE, 0); asm volatile("s_waitcnt vmcnt(0)" ::: "memory"); SWRITE(0, SE); __syncthreads();
  QKT(pA0, pA1, K_lds + KOFF(0)); PSM(pA0, pA1, mnA, alA, true);
  SLOAD(SO, 1); if constexpr (SDEPTH == 2) { if (2 < NT) SLOAD(SE, 2); }
  SWAIT(); SWRITE(1, SO); __syncthreads();
#define ILV() do { if constexpr (PVPIPE) { _Pragma("unroll") for (int i_ = 0; i_ < 20; ++i_) { __builtin_amdgcn_sched_group_barrier(0x008, 1, 0); __builtin_amdgcn_sched_group_barrier(0x002, 5, 0); } } } while (0)
#define LSLOAD(i, jt) do { if constexpr (ATTV != 3) SLOAD(i, jt); } while (0)
#define LSWRITE(bf, i) do { if constexpr (ATTV != 3) SWRITE(bf, i); } while (0)
#define LSWAIT() do { if constexpr (ATTV != 3) SWAIT(); } while (0)
#define LSYNC() do { if constexpr (ATTV != 4) __syncthreads(); } while (0)
#define HALFSTEP(PC0, PC1, MNC, ALC, PP0, PP1, ALP, KC, VP, LD) do { \
    if (!STAG || wid < 4) { \
      SBAR(); QKT(PC0, PC1, K_lds + KOFF(KC)); FSM(PP0, PP1, ALP); SBAR(); \
      LD; SBAR(); \
      if constexpr (PVPIPE && LEAN && ATTV == 0) { if constexpr (ATT_TRB) pv_psm_lean_b(o, vb0 + VOFF(VP), pa0, pa1, pa2, pa3, PC0, PC1, nm, ALC); else pv_psm_lean(o, vb0 + VOFF(VP), pa0, pa1, pa2, pa3, PC0, PC1, nm, ALC); } else { PV(vb0 + VOFF(VP)); PSM(PC0, PC1, MNC, ALC, false); } \
    } else { \
      SBAR(); FSM(PP0, PP1, ALP); SBAR(); \
      LD; SBAR(); \
      PV(vb0 + VOFF(VP)); SBAR(); \
      QKT(PC0, PC1, K_lds + KOFF(KC)); SBAR(); \
      PSM(PC0, PC1, MNC, ALC, false); \
    } } while (0)
  constexpr bool STAG = (MODE == 1) && ATT_STAGGER && ATTV == 0;
  for (int j = 1; j + 1 < NT; j += 2) {
    HALFSTEP(pB0, pB1, mnB, alB, pA0, pA1, alA, 1, 0, LSLOAD(SO, j + SDEPTH));
    LSYNC(); LSWAIT(); LSWRITE(0, SE);
    RESC(alB); LSYNC();
    HALFSTEP(pA0, pA1, mnA, alA, pB0, pB1, alB, 0, 1, if (SDEPTH == 1 || j + 3 < NT) LSLOAD(SE, j + 1 + SDEPTH));
    LSYNC(); LSWAIT(); LSWRITE(1, SO);
    RESC(alA); LSYNC();
  }
#undef HALFSTEP
#undef ILV
#undef LSLOAD
#undef LSWRITE
#undef LSWAIT
#undef LSYNC
  SBAR(); QKT(pB0, pB1, K_lds + KOFF(1));
  FSM(pA0, pA1, alA); SBAR();
  PV(vb0); PSM(pB0, pB1, mnB, alB, false);
  __syncthreads(); RESC(alB);
  FSM(pB0, pB1, alB); SBAR();
  PV(vb0 + VOFF(1));
  } else {
#define STEP(PC0, PC1, ALC, PP0, PP1, ALP, jj, SP, SC, SN) do { const int j_ = (jj); \
      if (j_ + 1 < NT) { asm volatile("s_waitcnt vmcnt(0)" ::: "memory"); SWRITE(SN, 0); if (j_ + 2 < NT) SLOAD(0, j_ + 2); } \
      SBAR(); QKT(PC0, PC1, K_lds + KOFF(SC)); FSM(PP0, PP1, ALP); SBAR(); \
      PV(vb0 + VOFF(SP)); PSM(PC0, PC1, mnA, ALC, false); \
      RESC(ALC); __syncthreads(); } while (0)
    SLOAD(0, 0); asm volatile("s_waitcnt vmcnt(0)" ::: "memory"); SWRITE(0, 0);
    SLOAD(0, 1); asm volatile("s_waitcnt vmcnt(0)" ::: "memory"); SWRITE(1, 0);
    SLOAD(0, 2); __syncthreads();
    QKT(pA0, pA1, K_lds + KOFF(0)); PSM(pA0, pA1, mnA, alA, true);
    STEP(pB0, pB1, alB, pA0, pA1, alA, 1, 0, 1, 2);
    int j = 2;
    for (; j + 5 < NT; j += 6) {
      STEP(pA0, pA1, alA, pB0, pB1, alB, j, 1, 2, 0);
      STEP(pB0, pB1, alB, pA0, pA1, alA, j + 1, 2, 0, 1);
      STEP(pA0, pA1, alA, pB0, pB1, alB, j + 2, 0, 1, 2);
      STEP(pB0, pB1, alB, pA0, pA1, alA, j + 3, 1, 2, 0);
      STEP(pA0, pA1, alA, pB0, pB1, alB, j + 4, 2, 0, 1);
      STEP(pB0, pB1, alB, pA0, pA1, alA, j + 5, 0, 1, 2);
    }
    if (j < NT) { STEP(pA0, pA1, alA, pB0, pB1, alB, j, 1, 2, 0); STEP(pB0, pB1, alB, pA0, pA1, alA, j + 1, 2, 0, 1); j += 2; }
    if (j < NT) { STEP(pA0, pA1, alA, pB0, pB1, alB, j, 0, 1, 2); STEP(pB0, pB1, alB, pA0, pA1, alA, j + 1, 1, 2, 0); j += 2; }
    FSM(pB0, pB1, alB); SBAR();
    { const int sl = (NT - 1) % 3; PV(vb0 + VOFF(sl)); }
#undef STEP
  }
  float rli[16];
  if constexpr (LEAN) {
#pragma unroll
    for (int r = 0; r < 16; ++r) rli[r] = __builtin_amdgcn_rcpf(o[NOB - 1][r]);
  } else {
    if (hi == 0) li_l[r32] = l_reg; asm volatile("s_waitcnt lgkmcnt(0)" ::: "memory");
#pragma unroll
    for (int r = 0; r < 16; ++r) rli[r] = __builtin_amdgcn_rcpf(li_l[crow(r, hi)]);
  }
  bf16* Ow = Ob + (size_t)(wq * 32) * DM;
  if constexpr (MODE == 0) {
#pragma unroll
    for (int r = 0; r < 16; ++r) { const int orow = crow(r, hi);
#pragma unroll
      for (int d0 = 0; d0 < 4; ++d0) Ow[(size_t)orow * DM + d0 * 32 + r32] = tobf1(o[d0][r] * rli[r]); }
    __syncthreads();
  } else {
    LAS float* ex = (LAS float*)lds;
    __syncthreads();
    if (sgrp == 1) {
#pragma unroll
      for (int r = 0; r < 16; ++r)
#pragma unroll
        for (int d0 = 0; d0 < 4; ++d0) ex[(wq * 32 + crow(r, hi)) * 128 + d0 * 32 + r32] = o[d0][r] * rli[r];
    }
    __syncthreads();
    if (sgrp == 0) {
#pragma unroll
      for (int r = 0; r < 16; ++r) { const int orow = crow(r, hi); float dd[4]; float ss = 0.f;
#pragma unroll
        for (int d0 = 0; d0 < 4; ++d0) { dd[d0] = o[d0][r] * rli[r] - lam * ex[(wq * 32 + orow) * 128 + d0 * 32 + r32]; ss += dd[d0] * dd[d0]; }
        ss = half_sum32(ss);
        const float rs = oscale / sqrtf(ss * (1.0f / 128.0f) + LN_EPS);
#pragma unroll
        for (int d0 = 0; d0 < 4; ++d0) Ow[(size_t)orow * DM + d0 * 32 + r32] = tobf1(dd[d0] * rs * subln[d0 * 32 + r32]); }
    }
    __syncthreads();
  }
  if (ATT_PRIO) __builtin_amdgcn_s_setprio(0);
#undef VOFF
#undef KOFF
#undef PV
#undef PSM
#undef FSM
#undef QKT
#undef KROW
#undef SLOAD
#undef SWRITE
#undef SWAIT
#undef RESC
}
}

__device__ __forceinline__ void mla_attn_phase(CP P, LAS unsigned char* lds, const int tid) {
    const bf16* QM = (const bf16*)(P->ws + WS_QM); const bf16* KV = (const bf16*)(P->ws + WS_KV); const bf16* KR = (const bf16*)(P->ws + WS_KR); bf16* Gb = (bf16*)(P->ws + WS_G);
    const int c = blockIdx.x, G = gridDim.x;
    for (int u = c; u < 1024 + 32; u += G) {
        int b, h, qrow0, NT;
        if (u < 1024) { const int i = u >> 8, cc = u & 255; const int bh = (cc & 7) + 8 * i, qb = cc >> 3; b = bh >> 4; h = bh & 15; qrow0 = b * SEQ + qb * 256; NT = 4 + 128; }
        else { const int bh = u - 1024; b = bh >> 4; h = bh & 15; qrow0 = ML + b * CTXL; NT = 4; }
        att::attn_unit<0>(QM + (size_t)qrow0 * 3072 + h * 192, 3072, KV + h * 256, KV + h * 256 + 128, 4096, KR, b, 4, NT, Gb + (size_t)qrow0 * DM + h * 128, 0.f, nullptr, 1.f, lds, tid);
    }
}
template <int ATTV = 0>
__device__ __forceinline__ void da_attn_phase(CP P, float lam, float oscale, LAS unsigned char* lds, const int tid, const bool ctx_q) {
    const bf16* Z = (const bf16*)(P->ws + WS_Z); bf16* Gb = (bf16*)(P->ws + WS_G); const float* subln = P->in[27];
    const int c = blockIdx.x, G = gridDim.x;
    for (int u = c; u < 2048 + (ctx_q ? 64 : 0); u += G) {
        int b, h, qrow0, NT;
        if (u < 2048) { const int i = u >> 8, cc = u & 255; const int bh = (cc & 7) + 8 * (i >> 1), qb = (cc >> 3) + 32 * (i & 1); b = bh >> 4; h = bh & 15; qrow0 = b * SEQ + qb * 128; NT = 4 + 128; }
        else { const int v = u - 2048; const int bh = v >> 1; b = bh >> 4; h = bh & 15; qrow0 = ML + b * CTXL + (v & 1) * 128; NT = 4; }
        att::attn_unit<1, ATTV>(Z + (size_t)qrow0 * 6144 + h * 128, 6144, Z + 2048 + h * 128, Z + 4096 + h * 128, 6144, nullptr, b, 4, NT, Gb + (size_t)qrow0 * DM + h * 128, lam, subln, oscale, lds, tid);
    }
}

__device__ __forceinline__ unsigned f2ord(float f) { const unsigned u = __float_as_uint(f); return u ^ ((unsigned)((int)u >> 31) | 0x80000000u); }
__device__ __forceinline__ float ord2f(unsigned k) { return __uint_as_float((k & 0x80000000u) ? (k ^ 0x80000000u) : ~k); }
__device__ __forceinline__ void ce_desc(unsigned& a, unsigned& b) { const unsigned mx = a > b ? a : b, mn = a > b ? b : a; a = mx; b = mn; }
template <int N, bool DESC> __device__ __forceinline__ void bitonic_merge(unsigned* a) {
#pragma unroll
    for (int j = N / 2; j > 0; j >>= 1)
#pragma unroll
        for (int i = 0; i < N; ++i) { const int l = i ^ j; if (l > i) { if (DESC) ce_desc(a[i], a[l]); else ce_desc(a[l], a[i]); } }
}
template <int N, bool DESC> __device__ __forceinline__ void bitonic_sort(unsigned* a) {
#pragma unroll
    for (int k = 2; k <= N; k <<= 1)
#pragma unroll
        for (int j = k >> 1; j > 0; j >>= 1)
#pragma unroll
            for (int i = 0; i < N; ++i) { const int l = i ^ j; if (l > i) { const bool up = ((i & k) == 0); if (up == DESC) ce_desc(a[i], a[l]); else ce_desc(a[l], a[i]); } }
}
__device__ __forceinline__ void top16_of_64(unsigned (&a)[64]) {
    bitonic_sort<16, true>(a); bitonic_sort<16, false>(a + 16); bitonic_sort<16, true>(a + 32); bitonic_sort<16, false>(a + 48);
#pragma unroll
    for (int i = 0; i < 16; ++i) a[i] = a[i] > a[16 + i] ? a[i] : a[16 + i];
    bitonic_merge<16, true>(a);
#pragma unroll
    for (int i = 0; i < 16; ++i) a[32 + i] = a[32 + i] > a[48 + i] ? a[32 + i] : a[48 + i];
    bitonic_merge<16, false>(a + 32);
#pragma unroll
    for (int i = 0; i < 16; ++i) a[i] = a[i] > a[32 + i] ? a[i] : a[32 + i];
    bitonic_merge<16, true>(a);
}
template <int PASS> __device__ __forceinline__ void route_pass(const bf16* QP, const LAS char* lds, int tok, int head, int r32, int hi, unsigned (&top)[16]) {
    f32x16 acc[4] = {};
    const bf16* qp = QP + (size_t)tok * DM + head * 256 + PASS * 128 + hi * 8;
    bf16x8 qf[8];
#pragma unroll
    for (int ks = 0; ks < 8; ++ks) qf[ks] = *(const bf16x8*)(qp + ks * 16);
    const LAS char* Kl = lds + PASS * 32768;
#pragma unroll
    for (int kb = 0; kb < 4; ++kb)
#pragma unroll
        for (int ks = 0; ks < 8; ++ks) { const bf16x8 a = *(const LAS bf16x8*)(Kl + (kb * 32 + r32) * 256 + (((ks * 2 + hi) ^ (r32 & 15)) * 16));
            acc[kb] = __builtin_amdgcn_mfma_f32_32x32x16_bf16(a, qf[ks], acc[kb], 0, 0, 0); }
    unsigned key[64]; const unsigned base = 127u - 4u * (unsigned)hi;
#pragma unroll
    for (int kb = 0; kb < 4; ++kb)
#pragma unroll
        for (int r = 0; r < 16; ++r) key[kb * 16 + r] = (f2ord(acc[kb][r]) & ~127u) | (base - (unsigned)(kb * 32 + (r & 3) + 8 * (r >> 2)));
    top16_of_64(key);
    unsigned pr[16];
#pragma unroll
    for (int i = 0; i < 16; ++i) pr[i] = lane_xor32(key[15 - i], hi << 5);
#pragma unroll
    for (int i = 0; i < 16; ++i) key[i] = key[i] > pr[i] ? key[i] : pr[i];
    bitonic_merge<16, true>(key);
#pragma unroll
    for (int i = 0; i < 16; ++i) top[i] = key[i];
}
#ifndef ROUTE_SORT
#define ROUTE_SORT 1
#endif
#define DPP_U(v, ctrl) ((unsigned)__builtin_amdgcn_mov_dpp((int)(v), (ctrl), 0xF, 0xF, true))
template <int J> __device__ __forceinline__ unsigned lane_xor_u(unsigned v, int lane) {
    if (J == 1) return DPP_U(v, 0xB1);
    if (J == 2) return DPP_U(v, 0x4E);
    if (J == 4) { const unsigned t = DPP_U(v, 0x141); return DPP_U(t, 0x1B); }
    if (J == 8) { const unsigned t = DPP_U(v, 0x140); return DPP_U(t, 0x141); }
    if (J == 16) { const auto r = __builtin_amdgcn_permlane16_swap(v, v, false, false); return (lane & 16) ? r[0] : r[1]; }
    return lane_xor32(v, lane);
}
template <int K, int J> __device__ __forceinline__ void sort128_stage(unsigned& a0, unsigned& a1, int lane) {
    if constexpr (J == 64) { const unsigned mn = a0 < a1 ? a0 : a1, mx = a0 < a1 ? a1 : a0; a0 = mn; a1 = mx; }
    else { const unsigned p0 = lane_xor_u<J>(a0, lane), p1 = lane_xor_u<J>(a1, lane);
        const bool lower = (lane & J) == 0;
        const bool asc0 = (K >= 64) ? true : ((lane & K) == 0), asc1 = (K == 128) ? true : (K == 64 ? false : ((lane & K) == 0));
        const unsigned mn0 = a0 < p0 ? a0 : p0, mx0 = a0 < p0 ? p0 : a0, mn1 = a1 < p1 ? a1 : p1, mx1 = a1 < p1 ? p1 : a1;
        a0 = (lower == asc0) ? mn0 : mx0; a1 = (lower == asc1) ? mn1 : mx1; }
    if constexpr (J > 1) sort128_stage<K, J / 2>(a0, a1, lane);
    else if constexpr (K < 128) sort128_stage<K * 2, K>(a0, a1, lane);
}
__device__ __forceinline__ void sort128_asc(unsigned& a0, unsigned& a1, int lane) { sort128_stage<2, 1>(a0, a1, lane); }
__device__ __forceinline__ void route_phase(CP P, int L, int Mrows, LAS unsigned char* lds_, int tid, int lane, int wid, int gw, int NGW) {
    const bf16* QP = (const bf16*)(P->ws + WS_QP); unsigned* ROUTE = (unsigned*)(P->ws + WS_ROUTE);
    LAS char* lds = (LAS char*)(LAS unsigned char*)lds_;
    __syncthreads();
    {
        const bf16* K1 = (const bf16*)(P->ws + WS_PK1) + (size_t)L * 128 * 128; const bf16* K2 = (const bf16*)(P->ws + WS_PK2) + (size_t)L * 128 * 128;
        for (int c16 = tid; c16 < 2 * 128 * 16; c16 += NWAVES * 64) { const int mat = c16 >> 11, row = (c16 >> 4) & 127, ch = c16 & 15;
            const u32x4 w = *(const u32x4*)((mat ? K2 : K1) + row * 128 + ch * 8);
            *(LAS u32x4*)(lds + mat * 32768 + row * 256 + ((ch ^ (row & 15)) * 16)) = w; }
    }
    __syncthreads();
    LAS unsigned* sc = (LAS unsigned*)(lds + 65536) + wid * 2048;
    const int r32 = lane & 31, hi = lane >> 5;
    for (int item = gw; item < Mrows / 4; item += NGW) {
        const int tok = item * 4 + (r32 >> 3), head = r32 & 7;
        unsigned top0[16], top1[16];
        route_pass<0>(QP, lds, tok, head, r32, hi, top0);
        route_pass<1>(QP, lds, tok, head, r32, hi, top1);
        float v1[16], v2[16];
#pragma unroll
        for (int i = 0; i < 16; ++i) { v1[i] = ord2f(top0[i] & ~127u); v2[i] = ord2f(top1[i] & ~127u);
            sc[i * 64 + lane] = 127u - (top0[i] & 127u); sc[(16 + i) * 64 + lane] = 127u - (top1[i] & 127u); }
        unsigned ck[64]; int n = 0;
#pragma unroll
        for (int i = 0; i < 16; ++i)
#pragma unroll
            for (int j = 0; j < 16; ++j) if ((i + 1) * (j + 1) <= 16) { ck[n] = (f2ord(v1[i] + v2[j]) & ~255u) | (unsigned)(i * 16 + j); ++n; }
#pragma unroll
        for (int i = 50; i < 64; ++i) ck[i] = 0u;
        top16_of_64(ck);
        float ev[16]; float sum = 0.f; const float mx = ord2f(ck[0] & ~255u);
#pragma unroll
        for (int k = 0; k < 16; ++k) { ev[k] = __expf(ord2f(ck[k] & ~255u) - mx); sum += ev[k]; }
        const float inv = 1.0f / sum;
        unsigned ee[16];
#pragma unroll
        for (int k = 0; k < 16; ++k) { const unsigned pc = ck[k] & 255u; const unsigned i1 = sc[(pc >> 4) * 64 + lane], i2 = sc[(16 + (pc & 15u)) * 64 + lane]; ee[k] = i1 * 128u + i2; ev[k] *= inv; }
#if ROUTE_SORT
        { const int tq = r32 >> 3;
#pragma unroll
          for (int k = 0; k < 8; ++k) {
              const unsigned eL = ee[k], eH = ee[k + 8]; const float gL = ev[k], gH = ev[k + 8];
              sc[tq * 256 + head * 16 + hi * 8 + k] = hi ? eH : eL; sc[tq * 256 + 128 + head * 16 + hi * 8 + k] = __float_as_uint(hi ? gH : gL); }
#pragma unroll 1
          for (int t = 0; t < 4; ++t) {
              unsigned a0 = (sc[t * 256 + lane] << 7) | (unsigned)lane, a1 = (sc[t * 256 + 64 + lane] << 7) | (unsigned)(64 + lane);
              sort128_asc(a0, a1, lane);
              const unsigned g0 = sc[t * 256 + 128 + (a0 & 127u)], g1 = sc[t * 256 + 128 + (a1 & 127u)];
              u32x2* outp = (u32x2*)(ROUTE + (size_t)(item * 4 + t) * 256);
              outp[lane] = (u32x2){a0 >> 7, g0}; outp[64 + lane] = (u32x2){a1 >> 7, g1}; }
        }
#else
        u32x4* outp = (u32x4*)(ROUTE + ((size_t)tok * 128 + head * 16 + hi * 8) * 2);
#pragma unroll
        for (int k = 0; k < 8; k += 2) { u32x4 w;
            const unsigned eL0 = ee[k], eH0 = ee[k + 8], eL1 = ee[k + 1], eH1 = ee[k + 9]; const float gL0 = ev[k], gH0 = ev[k + 8], gL1 = ev[k + 1], gH1 = ev[k + 9];
            w.x = hi ? eH0 : eL0; w.y = __float_as_uint(hi ? gH0 : gL0); w.z = hi ? eH1 : eL1; w.w = __float_as_uint(hi ? gH1 : gL1);
            outp[k >> 1] = w; }
#endif
    }
}

typedef float f32x2 __attribute__((ext_vector_type(2)));
typedef float f32x32 __attribute__((ext_vector_type(32)));
typedef unsigned u32x6 __attribute__((ext_vector_type(6)));
typedef __bf16 bf16x32 __attribute__((ext_vector_type(32)));
typedef unsigned u32x16 __attribute__((ext_vector_type(16)));
typedef __bf16 bf16x2_t __attribute__((ext_vector_type(2)));
#ifndef GATHER_ZIGZAG
#define GATHER_ZIGZAG 0
#endif
#ifndef GATHER_PRE
#define GATHER_PRE 0
#endif
#ifndef GATHER_PAIRRED
#define GATHER_PAIRRED 1
#endif
#ifndef GATHER_EARLY
#define GATHER_EARLY 1
#endif
#ifndef GATHER_PACE
#define GATHER_PACE 0
#endif
#define XB_PACE(j) (XCD_BAR_WORDS + 64 * (j))
constexpr int GS = 6, GSLOT = 2 * PROW;
__device__ __forceinline__ void glds16(const void* gsrc, unsigned lds_dst) { unsigned keep;
  asm volatile("s_mov_b32 %0, m0\n\ts_mov_b32 m0, %2\n\ts_nop 0\n\tglobal_load_lds_dwordx4 %1, off\n\ts_mov_b32 m0, %0" : "=&s"(keep) : "v"(gsrc), "s"(lds_dst) : "memory"); }
template <int GMODE = 0>
__device__ __forceinline__ void gather_phase(CP P, int L, int Mrows, LAS unsigned char* lds, int wid, int lane_, int gw, int NGW, bool dry = false) {
    const unsigned char* UV = P->ws + WS_PU + (size_t)L * 16384 * PREC;
    const unsigned* ROUTE = (const unsigned*)(P->ws + WS_ROUTE); const float* MOD = (const float*)(P->ws + WS_MOD);
    bf16* X = (bf16*)(P->ws + WS_X); bf16* H = (bf16*)(P->ws + WS_H); bf16* Xo = dry ? (bf16*)(P->ws + WS_Y) : X; bf16* Ho = dry ? (bf16*)(P->ws + WS_G) : H;
    const float* lng = P->in[6] + (size_t)(L * 2 + 1) * DM; const float* lnb = P->in[7] + (size_t)(L * 2 + 1) * DM;
    const unsigned ring = (unsigned)(uintptr_t)lds + (unsigned)wid * (GS * GSLOT);
    const int nfull = (Mrows / NGW) * NGW, rem = Mrows - nfull; const bool can_coop = (rem * 4 == NGW);
    const int nround = nfull / NGW + (rem > 0 ? 1 : 0);
    const bool pace_ok = (rem == 0) || can_coop;
#define G_ROWOF(it_) ((can_coop && (it_) == nround - 1) ? (nfull + (int)blockIdx.x * 2 + (wid >> 2)) : (gw + (it_) * NGW))
    u32x2 nea = {0u, 0u}, neb = {0u, 0u}; u32x4 nh0 = {0u, 0u, 0u, 0u}, nh1 = nh0, nh2 = nh0, nh3 = nh0;
#define G_PREFETCH(rowN_, ln_) do { const int rn_ = (rowN_); nea = ((const u32x2*)(ROUTE + (size_t)rn_ * 256))[ln_]; neb = ((const u32x2*)(ROUTE + (size_t)rn_ * 256))[64 + (ln_)]; \
        const u32x4* hp_ = (const u32x4*)(H + (size_t)rn_ * DM) + 4 * (ln_); nh0 = hp_[0]; nh1 = hp_[1]; nh2 = hp_[2]; nh3 = hp_[3]; } while (0)
    if (nround > 0 && G_ROWOF(0) < Mrows) G_PREFETCH(G_ROWOF(0), launder_v(lane_));
    bool pre = false;
#pragma unroll 1
    for (int it = 0; it < nround; ++it) {
#if GATHER_PACE
        if (pace_ok && it > 0) {
            if (wid == 0 && lane_ == 0) { const unsigned nloc = ((volatile LAS unsigned*)(lds + MISC_OFF))[8];
                if (nloc != 0u) { unsigned* pc = (unsigned*)(P->ws + WS_CTL) + CW_BAR + XB_PACE(xb_xcc_id());
                    const unsigned old = xb_add(pc, 1u), tgt = (old / nloc + 1u) * nloc; unsigned sp = 0u;
                    while ((int)(xb_ld(pc) - tgt) < 0 && ++sp < 20000u) __builtin_amdgcn_s_sleep(1); } }
            __syncthreads();
        }
#endif
        const bool coop = can_coop && (it == nround - 1);
        int row = G_ROWOF(it), k0 = 0, kn = 128;
        if (coop) { k0 = (wid & 3) * 32; kn = k0 + 32; }
        else if (row >= Mrows) break;
        const int lane = launder_v(lane_);
        const u32x2 ea = nea, eb = neb;
        unsigned eax, eay, ebx, eby;
        unsigned hw[16] = {nh0.x, nh0.y, nh0.z, nh0.w, nh1.x, nh1.y, nh1.z, nh1.w, nh2.x, nh2.y, nh2.z, nh2.w, nh3.x, nh3.y, nh3.z, nh3.w};
        float y[32];
#pragma unroll
        for (int i = 0; i < 32; ++i) y[i] = 0.f;
        { unsigned e0 = ea.x, e1 = ea.y, e2 = eb.x, e3 = eb.y;
          asm volatile("" : "+v"(e0), "+v"(e1), "+v"(e2), "+v"(e3), "+v"(hw[0]), "+v"(hw[1]), "+v"(hw[2]), "+v"(hw[3]), "+v"(hw[4]), "+v"(hw[5]), "+v"(hw[6]), "+v"(hw[7]),
                       "+v"(hw[8]), "+v"(hw[9]), "+v"(hw[10]), "+v"(hw[11]), "+v"(hw[12]), "+v"(hw[13]), "+v"(hw[14]), "+v"(hw[15]) :: "memory");
          eax = e0; eay = e1; ebx = e2; eby = e3; }
        const unsigned rd_a = ring + 16u * (unsigned)lane, rd_b = ring + 2048u + 8u * (unsigned)lane;
        const bool rev = GATHER_ZIGZAG && ((it & 1) != 0);
        const int kflip = rev ? (k0 + kn - 1) : 0, ksign = rev ? -1 : 1;
#define G_ISSUE(k) do { const int k_ = (k), ke_ = kflip + ksign * k_; const unsigned e_ = (unsigned)__builtin_amdgcn_readlane((int)(ke_ < 64 ? eax : ebx), ke_ & 63); \
        const unsigned char* rp_ = UV + (size_t)e_ * PREC + 16 * lane; const unsigned sb_ = ring + (unsigned)(k_ % GS) * GSLOT; \
        if (GMODE == 3) { glds16(rp_, sb_); if (lane < 32) glds16(rp_ + 2048, sb_ + 2048); } \
        else if (GMODE != 2) { glds16(rp_, sb_); glds16(rp_ + 1024, sb_ + 1024); glds16(rp_ + 2048, sb_ + 2048); } else { asm volatile("" :: "v"(rp_), "s"(sb_)); } } while (0)
#if GATHER_EARLY
        if (it + 1 < nround && G_ROWOF(it + 1) < Mrows) G_PREFETCH(G_ROWOF(it + 1), lane);
        if (!pre) {
#pragma unroll
            for (int k = 0; k < 6; ++k) G_ISSUE(k0 + k); }
#else
#pragma unroll
        for (int k = 0; k < 4; ++k) G_ISSUE(k0 + k);
        if (it + 1 < nround && G_ROWOF(it + 1) < Mrows) G_PREFETCH(G_ROWOF(it + 1), lane);
#endif
#define G_READ(k, ua, ub, va, vb) do { const unsigned so_ = (unsigned)((k) % GS) * GSLOT; \
        asm volatile("ds_read_b128 %0, %4\n\tds_read_b64 %1, %5\n\tds_read_b128 %2, %4 offset:1024\n\tds_read_b64 %3, %5 offset:512" \
                     : "=&v"(ua), "=&v"(ub), "=&v"(va), "=&v"(vb) : "v"(rd_a + so_), "v"(rd_b + so_) : "memory"); } while (0)
#pragma unroll 1
        for (int k = k0; k < kn; k += 2) {
            if (k + 4 < kn) { if (!GATHER_EARLY) { G_ISSUE(k + 4); G_ISSUE(k + 5); } if (GMODE == 3) asm volatile("s_waitcnt vmcnt(8)" ::: "memory"); else asm volatile("s_waitcnt vmcnt(12)" ::: "memory"); }
            else if (k == kn - 4) { if (GMODE == 3) asm volatile("s_waitcnt vmcnt(4)" ::: "memory"); else asm volatile("s_waitcnt vmcnt(6)" ::: "memory"); }
            else asm volatile("s_waitcnt vmcnt(0)" ::: "memory");
            u32x4 uaA, vaA, uaB, vaB; u32x2 ubA, vbA, ubB, vbB;
            G_READ(k, uaA, ubA, vaA, vbA); G_READ(k + 1, uaB, ubB, vaB, vbB);
            asm volatile("s_waitcnt lgkmcnt(0)" : "+v"(uaA), "+v"(ubA), "+v"(vaA), "+v"(vbA), "+v"(uaB), "+v"(ubB), "+v"(vaB), "+v"(vbB) :: "memory");
            if (GATHER_EARLY && k + 6 < kn) { G_ISSUE(k + 6); G_ISSUE(k + 7); }
            if (GMODE == 1 || GMODE == 3) continue;
            const u32x6 u6A = {uaA.x, uaA.y, uaA.z, uaA.w, ubA.x, ubA.y}, u6B = {uaB.x, uaB.y, uaB.z, uaB.w, ubB.x, ubB.y};
            const u32x16 ubfA = __builtin_bit_cast(u32x16, __builtin_amdgcn_cvt_scalef32_pk32_bf16_fp6(u6A, 1.0f));
            const u32x16 ubfB = __builtin_bit_cast(u32x16, __builtin_amdgcn_cvt_scalef32_pk32_bf16_fp6(u6B, 1.0f));
            float a0 = 0.f, a1 = 0.f, b0 = 0.f, b1 = 0.f;
#pragma unroll
            for (int q = 0; q < 16; q += 2) { const unsigned h0_ = hw[q], h1_ = hw[q + 1], x0_ = ubfA[q], x1_ = ubfA[q + 1], z0_ = ubfB[q], z1_ = ubfB[q + 1];
                a0 = __builtin_amdgcn_fdot2_f32_bf16(__builtin_bit_cast(bf16x2_t, h0_), __builtin_bit_cast(bf16x2_t, x0_), a0, false);
                a1 = __builtin_amdgcn_fdot2_f32_bf16(__builtin_bit_cast(bf16x2_t, h1_), __builtin_bit_cast(bf16x2_t, x1_), a1, false);
                b0 = __builtin_amdgcn_fdot2_f32_bf16(__builtin_bit_cast(bf16x2_t, h0_), __builtin_bit_cast(bf16x2_t, z0_), b0, false);
                b1 = __builtin_amdgcn_fdot2_f32_bf16(__builtin_bit_cast(bf16x2_t, h1_), __builtin_bit_cast(bf16x2_t, z1_), b1, false); }
            const int keA = kflip + ksign * k, keB = keA + ksign;
            const unsigned gsel = keA < 64 ? eay : eby;
#if GATHER_PAIRRED
            float wA, wB;
            { const auto sw = __builtin_amdgcn_permlane32_swap(__float_as_uint(a0 + a1), __float_as_uint(b0 + b1), false, false);
              const float d2 = half_sum32(__uint_as_float(sw[0]) + __uint_as_float(sw[1])) * (1.0f / U_SCALE);
              const float g2 = gelu_tanh(d2) * (1.0f / V_SCALE);
              const float gA = __uint_as_float((unsigned)__builtin_amdgcn_readlane((int)__float_as_uint(g2), 0)), gB = __uint_as_float((unsigned)__builtin_amdgcn_readlane((int)__float_as_uint(g2), 32));
              wA = __uint_as_float((unsigned)__builtin_amdgcn_readlane((int)gsel, keA & 63)) * gA; wB = __uint_as_float((unsigned)__builtin_amdgcn_readlane((int)gsel, keB & 63)) * gB; }
#else
            const float dA = wave_sum(a0 + a1) * (1.0f / U_SCALE), dB = wave_sum(b0 + b1) * (1.0f / U_SCALE);
            const float wA = __uint_as_float((unsigned)__builtin_amdgcn_readlane((int)gsel, keA & 63)) * gelu_tanh(dA) * (1.0f / V_SCALE);
            const float wB = __uint_as_float((unsigned)__builtin_amdgcn_readlane((int)gsel, keB & 63)) * gelu_tanh(dB) * (1.0f / V_SCALE);
#endif
            const u32x6 v6A = {vaA.x, vaA.y, vaA.z, vaA.w, vbA.x, vbA.y};
            const f32x32 vfA = __builtin_amdgcn_cvt_scalef32_pk32_f32_fp6(v6A, 1.0f);
#pragma unroll
            for (int i = 0; i < 32; ++i) y[i] += wA * vfA[i];
            const u32x6 v6B = {vaB.x, vaB.y, vaB.z, vaB.w, vbB.x, vbB.y};
            const f32x32 vfB = __builtin_amdgcn_cvt_scalef32_pk32_f32_fp6(v6B, 1.0f);
#pragma unroll
            for (int i = 0; i < 32; ++i) y[i] += wB * vfB[i];
        }
#if GATHER_PRE
        pre = (it + 1 < nround) && (G_ROWOF(it + 1) < Mrows);
        if (pre) { unsigned n0 = nea.x, n2 = neb.x; asm volatile("" : "+v"(n0), "+v"(n2) :: "memory"); eax = n0; ebx = n2;
            const int k0n = (can_coop && (it + 1 == nround - 1)) ? (wid & 3) * 32 : 0;
#pragma unroll
            for (int k = 0; k < 6; ++k) G_ISSUE(k0n + k); }
#endif
#undef G_READ
#undef G_ISSUE
        if (coop) {
            LAS f32x4* mine = (LAS f32x4*)(lds + wid * (GS * GSLOT)) + lane * 8;
#pragma unroll
            for (int i = 0; i < 8; ++i) mine[i] = (f32x4){y[4 * i], y[4 * i + 1], y[4 * i + 2], y[4 * i + 3]};
            __syncthreads();
            if ((wid & 3) == 0) {
#pragma unroll
                for (int j = 1; j < 4; ++j) { const LAS f32x4* oth = (const LAS f32x4*)(lds + (wid + j) * (GS * GSLOT)) + lane * 8;
#pragma unroll
                    for (int i = 0; i < 8; ++i) { const f32x4 t = oth[i]; y[4 * i] += t.x; y[4 * i + 1] += t.y; y[4 * i + 2] += t.z; y[4 * i + 3] += t.w; } }
            }
            __syncthreads();
            if ((wid & 3) != 0) continue;
        }
        const int slot = row_slot(row);
        const float* mod = MOD + (size_t)(L * 3 + slot) * 12288;
        const int le = launder_v(lane);
        { float xx[32], gg[32]; load_row_bf16_b(X + (size_t)row * DM, le, xx); load_row_f32_b(mod + 5 * 2048, le, gg);
#pragma unroll
          for (int i = 0; i < 32; ++i) y[i] = ALPHA * xx[i] + gg[i] * y[i]; }
        if (L < NLAYER - 1) { const float* modn = MOD + (size_t)((L + 1) * 3 + slot) * 12288;
            finish_row<true>(y, lng, lnb, Xo + (size_t)row * DM, modn, modn + 2048, Ho + (size_t)row * DM, nullptr, le); }
        else finish_row<true>(y, lng, lnb, nullptr, nullptr, nullptr, nullptr, P->out + (size_t)row * DM, le);
        asm volatile("s_waitcnt vmcnt(0)" ::: "memory");
    }
#undef G_PREFETCH
#undef G_ROWOF
}

#ifndef ROPE_TEST
#define ROPE_TEST 0
#endif
#ifndef PROBE_DUP
#define PROBE_DUP 0
#endif
#define NOINL __forceinline__
__device__ __forceinline__ CP launder_cp(CP p) { asm volatile("" : "+s"(p)); return p; }
#define GETP() launder_cp((CP)__builtin_amdgcn_kernarg_segment_ptr())
__device__ __forceinline__ int uni(int v) { return __builtin_amdgcn_readfirstlane(v); }
__device__ __forceinline__ LAS unsigned char* uni_lds(LAS unsigned char* p) { return (LAS unsigned char*)(unsigned)__builtin_amdgcn_readfirstlane((int)(unsigned)(uintptr_t)p); }
#define PH_IDS const int wid = uni(wv_), lane = launder_v(lane_id_fresh()) & 63, tid = (wid & 7) * 64 + lane; const int gw = blockIdx.x * NWAVES + wid, NGW = gridDim.x * NWAVES; (void)lane; (void)gw; (void)NGW; (void)tid;

__device__ NOINL void ph_prologue(int wv_, LAS unsigned char* lds_) { CP P = GETP(); LAS unsigned char* lds = uni_lds(lds_); PH_IDS p0_prologue(P, lds, tid, lane, wid, gw, NGW); if (PROBE_DUP == 5) p0_prologue(P, lds, tid, lane, wid, gw, NGW);
    if (PROBE_DUP >= 21 && PROBE_DUP <= 23) { __syncthreads(); p0_prologue(P, lds, tid, lane, wid, gw, NGW, 1 << (PROBE_DUP - 21 < 0 ? 0 : (PROBE_DUP - 21) & 3)); } }
__device__ NOINL void ph_modreduce(int wv_) { CP P = GETP(); PH_IDS mod_reduce(P, gw, lane, NGW); }
__device__ NOINL void ph_first(int wv_) { CP P = GETP(); PH_IDS
#pragma unroll 1
    for (int rep = 0; rep < (PROBE_DUP == 6 ? 2 : 1); ++rep) first_row_pass(P, lane, gw, NGW); }
__device__ NOINL void ph_postmix(int wv_, int L_, int M_) { CP P = GETP(); const int L = uni(L_), Mrows = uni(M_); PH_IDS post_mixer_pass(P, L, Mrows, lane, gw, NGW); }
__device__ NOINL void ph_vstats(int wv_, int M_) { CP P = GETP(); const int Mrows = uni(M_); PH_IDS
#pragma unroll 1
    for (int rep = 0; rep < (PROBE_DUP == 6 ? 2 : 1); ++rep) vstats_pass(P, Mrows, lane, gw, NGW); }
__device__ NOINL void ph_spatial(int wv_, LAS unsigned char* lds_, int j_, int M_) { CP P = GETP(); LAS unsigned char* lds = uni_lds(lds_); const int j = uni(j_), Mrows = uni(M_); PH_IDS
#pragma unroll 1
    for (int rep = 0; rep < (PROBE_DUP == 6 ? 2 : 1); ++rep) spatial_phase(P, j, Mrows, lds, tid, lane, wid); }
__device__ NOINL void ph_mla_norm(int wv_) { CP P = GETP(); PH_IDS
#pragma unroll 1
    for (int rep = 0; rep < (PROBE_DUP == 6 ? 2 : 1); ++rep) mla_norm_pass(P, lane, gw, NGW); }
__device__ NOINL void ph_rope(int wv_, int which_) { CP P = GETP(); const int which = uni(which_); PH_IDS
    if (which == 0) rope_pass((bf16*)(P->ws + WS_QM), 3072, 128, 16, 192, lane, gw, NGW);
    else rope_pass((bf16*)(P->ws + WS_Z), 6144, 0, 64, 64, lane, gw, NGW); }
__device__ NOINL void ph_attn_mla(int wv_, LAS unsigned char* lds_) { CP P = GETP(); LAS unsigned char* lds = uni_lds(lds_); PH_IDS mla_attn_phase(P, lds, tid); if (PROBE_DUP == 2 || PROBE_DUP == 9) mla_attn_phase(P, lds, tid); }
__device__ NOINL void ph_attn_da(int wv_, LAS unsigned char* lds_, int L_, bool ctx_q) { CP P = GETP(); LAS unsigned char* lds = uni_lds(lds_); const int L = uni(L_); PH_IDS
    const float* lp = P->in[26];
    const float s01 = wave_sum(lp[lane] * lp[64 + lane]), s23 = wave_sum(lp[128 + lane] * lp[192 + lane]);
    const float lam_init = 0.8f - 0.6f * expf(-0.3f * (float)L);
    const float lam = expf(s01) - expf(s23) + lam_init;
    if (!(PROBE_DUP >= 11 && PROBE_DUP <= 15)) da_attn_phase(P, lam, 1.0f - lam_init, lds, tid, ctx_q);
    if (PROBE_DUP == 2 || PROBE_DUP == 10) da_attn_phase(P, lam, 1.0f - lam_init, lds, tid, ctx_q);
    if (PROBE_DUP >= 11 && PROBE_DUP <= 15) { da_attn_phase<PROBE_DUP >= 11 && PROBE_DUP <= 15 ? PROBE_DUP - 10 : 0>(P, lam, 1.0f - lam_init, lds, tid, ctx_q); __syncthreads(); }
    if (PROBE_DUP >= 11 && PROBE_DUP <= 15) da_attn_phase(P, lam, 1.0f - lam_init, lds, tid, ctx_q); }
__device__ NOINL void ph_route(int wv_, LAS unsigned char* lds_, int L_, int M_) { CP P = GETP(); LAS unsigned char* lds = uni_lds(lds_); const int L = uni(L_), Mrows = uni(M_); PH_IDS
#pragma unroll 1
    for (int rep = 0; rep < (PROBE_DUP == 4 ? 2 : 1); ++rep) route_phase(P, L, Mrows, lds, tid, lane, wid, gw, NGW); }
__device__ NOINL void ph_gather(int wv_, LAS unsigned char* lds_, int L_, int M_) { CP P = GETP(); LAS unsigned char* lds = uni_lds(lds_); const int L = uni(L_), Mrows = uni(M_); PH_IDS
    if (PROBE_DUP == 3) { gather_phase<0>(P, L, Mrows, lds, wid, lane, gw, NGW, true); }
    if (PROBE_DUP == 7) { gather_phase<1>(P, L, Mrows, lds, wid, lane, gw, NGW, true); }
    if (PROBE_DUP == 17) { gather_phase<3>(P, L, Mrows, lds, wid, lane, gw, NGW, true); }
    if (PROBE_DUP == 8) { gather_phase<2>(P, L, Mrows, lds, wid, lane, gw, NGW, true); }
    gather_phase<0>(P, L, Mrows, lds, wid, lane, gw, NGW); }

enum GemmId { G_GM_IN = 0, G_GM_OUT, G_MLA_IN, G_MLA_UQ, G_MLA_UKV, G_MLA_OUT, G_DA_IN, G_DA_OUT, G_PEER_Q };
__device__ NOINL void ph_gemm(int wv_, LAS unsigned char* lds_, int id_, int L_, int M_) {
    CP P = GETP(); LAS unsigned char* lds = uni_lds(lds_); const int id = uni(id_), L = uni(L_), Mrows = uni(M_); PH_IDS
    unsigned char* ws = P->ws; const int jj = L / 3;
    size_t a = WS_H, b = 0, o = 0; int M = MT, N = 2048, K = 2048, act = 0, rope = 0;
    switch (id) {
        case G_GM_IN:   a = WS_H;    b = WS_GMWIN + (size_t)jj * 4096 * 2048 * 2;  o = WS_Z;  M = Mrows; N = 4096; K = 2048; act = 1; break;
        case G_GM_OUT:  a = WS_G;    b = WS_GMWOUT + (size_t)jj * 2048 * 2048 * 2; o = WS_Y;  M = Mrows; N = 2048; K = 2048; break;
        case G_MLA_IN:  a = WS_H;    b = WS_MLAIN;  o = WS_C;  N = 1280; K = 2048; break;
        case G_MLA_UQ:  a = WS_CQN;  b = WS_MLAUQ;  o = WS_QM; N = 3072; K = 512;  rope = (ROPE_TEST == 2) ? 0 : 2; break;
        case G_MLA_UKV: a = WS_CKVN; b = WS_MLAUKV; o = WS_KV; N = 4096; K = 512;  break;
        case G_MLA_OUT: a = WS_G;    b = WS_MLAOUT; o = WS_Y;  N = 2048; K = 2048; break;
        case G_DA_IN:   a = WS_H;    b = WS_DAIN;   o = WS_Z;  N = 6144; K = 2048; rope = (ROPE_TEST == 1) ? 0 : 1; break;
        case G_DA_OUT:  a = WS_G;    b = WS_DAOUT;  o = WS_Y;  M = Mrows; N = 2048; K = 2048; break;
        default:        a = WS_H;    b = WS_PWQ + (size_t)L * 2048 * 2048 * 2;     o = WS_QP; M = Mrows; N = 2048; K = 2048; break;
    }
    pg8::Gemm g{(const pg8::bf16_t*)(ws + a), (const pg8::bf16_t*)(ws + b), M, N, K}; pg8::StaticOrder S; S.init(M, N, (int)gridDim.x, (int)blockIdx.x);
    pg8::EpiR E{(pg8::bf16_t*)(ws + o), N, act, rope, (const float*)(ws + WS_ROPE)};
#pragma unroll 1
    for (int rep = 0; rep < (PROBE_DUP == 1 ? 2 : 1); ++rep) { pg8::gemm_phase<pg8::EpiR, pg8::StaticOrder, true, true>((PG8_LAS unsigned char*)lds, g, S, E, tid); __syncthreads(); }
#if TAIL_REMAP
    int TL = -1; bool tail_u = false;
    if (L == 0) { if (id == G_GM_IN) { TL = 0; tail_u = true; } else if (id == G_GM_OUT) { TL = 0; } else if (id == G_PEER_Q) { TL = 1; tail_u = true; } }
    else if (L == 1) { if (id == G_MLA_IN) { TL = 1; } else if (id == G_MLA_OUT) { TL = 2; tail_u = true; } else if (id == G_PEER_Q) { TL = 2; } }
    else if (L == 2) { if (id == G_DA_IN) { TL = 3; tail_u = true; } else if (id == G_DA_OUT) { TL = 3; } }
    if (TL >= 0) {
        const int units = (M / 256) * (N / 256), G = (int)gridDim.x, tail = units % G, c = (int)blockIdx.x;
        const float* src = (tail_u ? P->in[11] : P->in[12]) + (size_t)TL * 16384 * 2048; unsigned char* dst = ws + WS_PU + (size_t)TL * 16384 * PREC;
#else
    const bool tail_u = (id == G_GM_OUT || id == G_MLA_OUT || id == G_DA_OUT), tail_v = (id == G_PEER_Q);
    if ((tail_u || tail_v) && L + 1 < NLAYER) {
        const int units = (M / 256) * (N / 256), G = (int)gridDim.x, tail = units % G, c = (int)blockIdx.x;
        const float* src = (tail_u ? P->in[11] : P->in[12]) + (size_t)(L + 1) * 16384 * 2048; unsigned char* dst = ws + WS_PU + (size_t)(L + 1) * 16384 * PREC;
#endif
        LAS float* scr = (LAS float*)(lds + wid * 16384);
        if (tail != 0 && c >= tail) cvt_table_fp6(src, dst, 16384, tail_u ? U_SCALE : V_SCALE, scr, lane, (c - tail) * NWAVES + wid, (G - tail) * NWAVES, tail_u ? 0 : 1);
        else if (tail == 0) {
#pragma unroll 1
            for (int rep = 0; rep < (PROBE_DUP == 18 ? 3 : 1); ++rep) cvt_table_fp6(src, dst, 16384, tail_u ? U_SCALE : V_SCALE, scr, lane, gw, NGW, tail_u ? 0 : 1); }
    }
}

__global__ void __launch_bounds__(NWAVES * 64, 2) mk_fwd(Params Pv) {
    extern __shared__ __attribute__((aligned(16))) unsigned char lds_g[];
    LAS unsigned char* lds = (LAS unsigned char*)lds_g;
    const int wv = __builtin_amdgcn_readfirstlane((int)threadIdx.x >> 6);
    const int tid = wv * 64 + lane_id_fresh();
    for (int u = tid; u < (LDS_BYTES - RING_BYTES) / 4; u += NWAVES * 64) ((LAS unsigned*)(lds + RING_BYTES))[u] = 0u;
    __syncthreads();
    const int lo = Pv.ph_lo, hi = Pv.ph_hi;
    unsigned* barw = (unsigned*)(Pv.ws + WS_CTL) + CW_BAR;
    XcdBarrier bar; bar.bar = barw; bar.x = 0; bar.st = nullptr;
    if (hi - lo > 1) bar = xcd_barrier_post(barw, (volatile LAS unsigned*)(lds + MISC_OFF) + 8, tid == 0);
    int ph = 0;
#ifndef SEL
#define SELP(k) true
#else
#define SELP(k) ((k) == SEL)
#endif
    enum { RUN_BASE = __COUNTER__ + 1 };
#define RUN(call) do { if (SELP(__COUNTER__ - RUN_BASE) && ph >= lo && ph < hi) { call; } if (ph >= lo && ph + 1 < hi) xcd_barrier(bar, wv == 0 && lane_id_fresh() == 0); ++ph; } while (0)
    RUN(ph_prologue(wv, lds));
    RUN(ph_modreduce(wv));
    RUN(ph_first(wv));
#define LAYER(LL) do { constexpr int L = (LL); constexpr int kind = L % 3, jj = L / 3; constexpr int Mrows = (L == NLAYER - 1) ? ML : MT; \
        constexpr bool ctx_dead = (L == NLAYER - 2) && ((NLAYER - 1) % 3 == 0) && (kind != 0); constexpr int Mlive = ctx_dead ? ML : Mrows; \
        if (kind == 0) {                          \
            RUN(ph_gemm(wv, lds, G_GM_IN, L, Mrows)); \
            RUN(ph_vstats(wv, Mrows)); \
            RUN(ph_spatial(wv, lds, jj, Mrows)); \
            RUN(ph_gemm(wv, lds, G_GM_OUT, L, Mrows)); \
        } else if (kind == 1) {                   \
            RUN(ph_gemm(wv, lds, G_MLA_IN, L, Mrows)); \
            RUN(ph_mla_norm(wv)); \
            RUN(ph_gemm(wv, lds, G_MLA_UQ, L, Mrows); ph_gemm(wv, lds, G_MLA_UKV, L, Mrows)); \
            if (ROPE_TEST == 2) { RUN(ph_rope(wv, 0)); } \
            RUN(ph_attn_mla(wv, lds)); \
            RUN(ph_gemm(wv, lds, G_MLA_OUT, L, Mrows)); \
        } else {                                  \
            RUN(ph_gemm(wv, lds, G_DA_IN, L, Mrows); if (ROPE_TEST == 1) { __syncthreads(); } ); \
            if (ROPE_TEST == 1) { RUN(ph_rope(wv, 1)); } \
            RUN(ph_attn_da(wv, lds, L, !ctx_dead)); \
            RUN(ph_gemm(wv, lds, G_DA_OUT, L, Mlive)); \
        } \
        RUN(ph_postmix(wv, L, Mlive));                \
        RUN(ph_gemm(wv, lds, G_PEER_Q, L, Mlive));    \
        RUN(ph_route(wv, lds, L, Mlive));             \
        RUN(ph_gather(wv, lds, L, Mlive));            \
    } while (0)
    LAYER(0); LAYER(1); LAYER(2); LAYER(3);
#undef LAYER
#undef RUN
}

extern "C" void kernel_launch(void* const* d_in, const int* in_sizes, int n_in, void* d_out, int out_size, void* d_ws, size_t ws_size, hipStream_t stream) {
    static int grid = 0;
    if (grid == 0) {
        if (n_in != 29 || in_sizes[0] != ML * DM || out_size != ML * DM || ws_size < WS_END) {
            fprintf(stderr, "kernel_launch: shape mismatch: n_in %d in0 %d out %d ws %zu (need %zu); nothing launched\n", n_in, n_in > 0 ? in_sizes[0] : -1, out_size, ws_size, (size_t)WS_END); grid = -1; return; }
        int dev = 0, cus = 0, per_cu = 0;
        if (hipGetDevice(&dev) != hipSuccess || hipDeviceGetAttribute(&cus, hipDeviceAttributeMultiprocessorCount, dev) != hipSuccess) { fprintf(stderr, "kernel_launch: device query failed\n"); grid = -1; return; }
        if (hipFuncSetAttribute((const void*)mk_fwd, hipFuncAttributeMaxDynamicSharedMemorySize, LDS_BYTES) != hipSuccess) { fprintf(stderr, "kernel_launch: hipFuncSetAttribute failed\n"); grid = -1; return; }
        if (hipOccupancyMaxActiveBlocksPerMultiprocessor(&per_cu, (const void*)mk_fwd, NWAVES * 64, LDS_BYTES) != hipSuccess || per_cu < 1)
            fprintf(stderr, "kernel_launch: note: occupancy query reports %d workgroups per CU\n", per_cu);
        (void)hipGetLastError();
        grid = cus;
    }
    if (grid < 0) return;
    if (hipMemsetAsync((char*)d_ws + WS_CTL, 0, CTL_ZERO_BYTES, stream) != hipSuccess) { fprintf(stderr, "kernel_launch: memset failed\n"); return; }
    Params p{};
    for (int i = 0; i < 29; ++i) p.in[i] = (const float*)d_in[i];
    p.out = (float*)d_out; p.ws = (unsigned char*)d_ws;
#if MK_ONE_LAUNCH
    p.ph_lo = 0; p.ph_hi = NPH;
    hipLaunchKernelGGL(mk_fwd, dim3(grid), dim3(NWAVES * 64), LDS_BYTES, stream, p);
#else
    for (int li = 0; li < NPH; ++li) { p.ph_lo = li; p.ph_hi = li + 1; hipLaunchKernelGGL(mk_fwd, dim3(grid), dim3(NWAVES * 64), LDS_BYTES, stream, p); }
#endif
    const hipError_t le = hipPeekAtLastError();
    if (le != hipSuccess) fprintf(stderr, "kernel_launch: launch failed: %s\n", hipGetErrorName(le));
}
```

```cpp
#include <hip/hip_runtime.h>
#include <cstdio>
#include <cstdint>
#ifndef MK_ONE_LAUNCH
#define MK_ONE_LAUNCH 1
#endif
__device__ __forceinline__ int launder_v(int v) { asm volatile("" : "+v"(v)); return v; }
__device__ __forceinline__ int lane_id_fresh() { unsigned m = ~0u; asm volatile("" : "+s"(m)); return (int)__builtin_amdgcn_mbcnt_hi(m, __builtin_amdgcn_mbcnt_lo(m, 0u)); }
namespace pg8 {
#define PG8_LAS __attribute__((address_space(3)))
typedef unsigned short bf16_t;
typedef short bf16x8 __attribute__((ext_vector_type(8)));
typedef float f32x4 __attribute__((ext_vector_type(4)));
typedef unsigned u32x4 __attribute__((ext_vector_type(4)));
constexpr int BM = 256, BK = 64, HALF = 128, HTB = HALF * BK * 2  , STAGE_BYTES = 8 * HTB, NXCD = 8, WGM = 8;

__host__ __device__ __forceinline__ int lds_byte(int r, int c) { const int st = (r >> 4) * 2 + (c >> 5), rr = r & 15, cc = c & 31, ob = rr * 64 + cc * 2; return st * 1024 + (ob ^ (((ob >> 9) & 1) << 5)); }
__host__ __device__ __forceinline__ void stage_rc(int b, int& R, int& C) { const int st = b / 1024, sb = b % 1024, swz = sb ^ (((sb >> 9) & 1) << 5); R = (st >> 1) * 16 + swz / 64; C = (st & 1) * 32 + (swz % 64) / 2; }
__host__ __device__ __forceinline__ int perm32(int rho) { const int n = rho >> 4, i = rho & 15; return 8 * (i >> 2) + 4 * n + (i & 3); }

struct Unit { int pm, pn; };
struct Gemm { const bf16_t* A; const bf16_t* Bt; int M, N, K; };

struct StaticOrder {
    int nM, nN, nwg, G, c;
    __host__ __device__ void init(int M, int N, int G_, int c_) { nM = M / BM; nN = N / BM; nwg = nM * nN; G = G_; c = c_; }
    __host__ __device__ bool next(int i, Unit& u) const {
        const long L = (long)i * G + c; if (L >= nwg) return false;
        int wgid = (int)L; { const int q = nwg / NXCD, r = nwg % NXCD, xcd = wgid % NXCD, off = wgid / NXCD; wgid = (xcd < r ? xcd * (q + 1) : r * (q + 1) + (xcd - r) * q) + off; }
        const int nig = WGM * nN, gid = wgid / nig, fm = gid * WGM, gsz = (nM - fm) < WGM ? (nM - fm) : WGM;
        u.pm = fm + ((wgid % nig) % gsz); u.pn = (wgid % nig) / gsz; return true;
    }
    __device__ __forceinline__ void a_ready(const Unit&) const {}
    __device__ __forceinline__ void done(const Unit&) const {}
};

__device__ __forceinline__ unsigned cvt_pk_bf16(float lo, float hi) { unsigned r; asm volatile("v_cvt_pk_bf16_f32 %0, %1, %2" : "=v"(r) : "v"(lo), "v"(hi)); return r; }
typedef float f32x2 __attribute__((ext_vector_type(2)));
__device__ __forceinline__ f32x2 gelu_pk(f32x2 v) {
    const f32x2 av = __builtin_elementwise_abs(v), d = av * 0.2316418882f + 1.0f;
    f32x2 t; t.x = __builtin_amdgcn_rcpf(d.x); t.y = __builtin_amdgcn_rcpf(d.y);
    f32x2 q = t * 0.5307027145f + (-0.7265760135f); q = q * t + 0.7107068705f; q = q * t + (-0.142248368f); q = q * t + 0.127414796f; q = q * t;
    const f32x2 s = (v * v) * (-0.72134752044f);
    f32x2 e; e.x = __builtin_amdgcn_exp2f(s.x); e.y = __builtin_amdgcn_exp2f(s.y);
    const f32x2 m = v * (q * e), r = v - m;
    f32x2 o; o.x = v.x < 0.f ? m.x : r.x; o.y = v.y < 0.f ? m.y : r.y; return o;
}

template <int ACT  > struct EpiBf16 {
    static constexpr bool PERM = true, AFTER_DRAIN = false; static_assert(ACT == 0 || ACT == 1, "EpiBf16: ACT is 0 (none) or 1 (gelu_pk)");
    bf16_t* O; int ldc; const float* bias; int split_cols; size_t split_stride; float scale0;
    __device__ __forceinline__ void operator()(const f32x4 (&acc)[2][2][4][2], const Unit& u, int wr, int wc, int fr, int fq) const {
        const int row0 = u.pm * BM + wr * 64 + fr; int colt = u.pn * BM; bf16_t* base = O;
        float sc = 1.f; if (split_cols) { const int t = colt / split_cols; base += (size_t)t * split_stride; colt -= t * split_cols; if (t == 0) sc = scale0; }
        const int col0 = colt + wc * 32 + 8 * fq, bcol0 = u.pn * BM + wc * 32 + 8 * fq;
        f32x4 bv[2][2];
#pragma unroll
        for (int bj = 0; bj < 2; ++bj)
#pragma unroll
            for (int n = 0; n < 2; ++n) bv[bj][n] = bias ? *(const f32x4*)(bias + bcol0 + bj * HALF + 4 * n) : (f32x4){0.f, 0.f, 0.f, 0.f};
#pragma unroll
        for (int ai = 0; ai < 2; ++ai)
#pragma unroll
            for (int m = 0; m < 4; ++m) { bf16_t* rowp = base + (size_t)(row0 + ai * HALF + m * 16) * ldc + col0;
#pragma unroll
                for (int bj = 0; bj < 2; ++bj) { f32x4 v0 = acc[ai][bj][m][0] + bv[bj][0], v1 = acc[ai][bj][m][1] + bv[bj][1];
                    if (ACT == 1) { f32x2 a = gelu_pk((f32x2){v0[0], v0[1]}), b = gelu_pk((f32x2){v0[2], v0[3]}), c = gelu_pk((f32x2){v1[0], v1[1]}), d = gelu_pk((f32x2){v1[2], v1[3]});
                        v0 = (f32x4){a.x, a.y, b.x, b.y}; v1 = (f32x4){c.x, c.y, d.x, d.y}; }
                    v0 = v0 * sc; v1 = v1 * sc; u32x4 w; w.x = cvt_pk_bf16(v0[0], v0[1]); w.y = cvt_pk_bf16(v0[2], v0[3]); w.z = cvt_pk_bf16(v1[0], v1[1]); w.w = cvt_pk_bf16(v1[2], v1[3]);
                    *(u32x4*)(rowp + bj * HALF) = w; } }
    }
};
template <class Epi, class Sched, bool ALIGN_EPI = false, bool SP2 = false>
__device__ __forceinline__ void gemm_phase(PG8_LAS unsigned char* lds, const Gemm g, const Sched& S, const Epi& E, const int tid_in) {
    const int tid = launder_v(tid_in) & 511, wid = __builtin_amdgcn_readfirstlane(tid >> 6), lane = tid & 63, wr = wid >> 2, wc = wid & 3, fr = lane & 15, fq = lane >> 4;
    const int K = g.K, nt = K / BK;
    unsigned voffA[2], voffB[2];
#pragma unroll
    for (int i = 0; i < 2; ++i) { int R, C; stage_rc(tid * 16 + i * 8192, R, C); const int Rb = Epi::PERM ? ((R & ~31) + perm32(R & 31)) : R;
        voffA[i] = (unsigned)(R * K + C) * 2u; voffB[i] = (unsigned)(Rb * K + C) * 2u; }
    const size_t kstep = (size_t)(BK * 2);
    const size_t hstep = (size_t)HALF * K * 2;
    const size_t tstep = 2 * hstep;
    const unsigned ldsw = (unsigned)wid * 1024u;
    const int aoff = lds_byte(wr * 64 + fr, fq * 8), boff = lds_byte(wc * 32 + fr, fq * 8);
#define PG8_SA(b, h) (((b) * 2 + (h)) * HTB)
#define PG8_SB(b, h) ((4 + (b) * 2 + (h)) * HTB)
#define PG8_STAGE(bufoff, gbase, voff) do { _Pragma("unroll") for (int _i = 0; _i < 2; ++_i) \
        __builtin_amdgcn_global_load_lds((const unsigned*)((const char*)(gbase) + (voff)[_i]), (PG8_LAS unsigned*)(lds + (bufoff) + ldsw + _i * 8192), 16, 0, 0); } while (0)
#define PG8_LDA(dst, b, h) do { _Pragma("unroll") for (int m = 0; m < 4; ++m) _Pragma("unroll") for (int k = 0; k < 2; ++k) dst[m][k] = *(const PG8_LAS bf16x8*)(lds + PG8_SA(b, h) + aoff + m * 2048 + k * 1024); } while (0)
#define PG8_LDB(dst, b, h) do { _Pragma("unroll") for (int n = 0; n < 2; ++n) _Pragma("unroll") for (int k = 0; k < 2; ++k) dst[n][k] = *(const PG8_LAS bf16x8*)(lds + PG8_SB(b, h) + boff + n * 2048 + k * 1024); } while (0)
#define PG8_MMA(ai, bj, At, Bt) do { __builtin_amdgcn_s_setprio(1); _Pragma("unroll") for (int m = 0; m < 4; ++m) _Pragma("unroll") for (int n = 0; n < 2; ++n) _Pragma("unroll") for (int k = 0; k < 2; ++k) \
        acc[ai][bj][m][n] = __builtin_amdgcn_mfma_f32_16x16x32_bf16(Bt[n][k], At[m][k], acc[ai][bj][m][n], 0, 0, 0); __builtin_amdgcn_s_setprio(0); } while (0)
#define PG8_WAIT_V(n) asm volatile("s_waitcnt vmcnt(" #n ")" ::: "memory")
#define PG8_WAIT_L(n) asm volatile("s_waitcnt lgkmcnt(" #n ")" ::: "memory")
#define PG8_BAR __builtin_amdgcn_s_barrier()
#define PG8_SCHED __builtin_amdgcn_sched_barrier(0)
    Unit cur, nxt; int ui = 0;
    if (!S.next(0, cur)) return;
    f32x4 acc[2][2][4][2];
#pragma unroll
    for (int a = 0; a < 2; ++a)
#pragma unroll
        for (int b = 0; b < 2; ++b)
#pragma unroll
            for (int m = 0; m < 4; ++m)
#pragma unroll
                for (int n = 0; n < 2; ++n) acc[a][b][m][n] = (f32x4){0.f, 0.f, 0.f, 0.f};
    bf16x8 At[4][2], B0[2][2], B1[2][2];
    const char* cA = (const char*)g.A + (size_t)cur.pm * tstep; const char* cB = (const char*)g.Bt + (size_t)cur.pn * tstep;
    S.a_ready(cur);
    if constexpr (SP2) {
        PG8_STAGE(PG8_SB(0, 0), cB, voffB); PG8_STAGE(PG8_SB(0, 1), cB + hstep, voffB); PG8_STAGE(PG8_SA(0, 0), cA, voffA); PG8_STAGE(PG8_SA(0, 1), cA + hstep, voffA);
        if (wr == 1) PG8_BAR;
        PG8_WAIT_V(2); PG8_BAR;
        PG8_STAGE(PG8_SB(1, 0), cB + kstep, voffB); PG8_STAGE(PG8_SA(1, 0), cA + kstep, voffA); PG8_STAGE(PG8_SB(1, 1), cB + hstep + kstep, voffB);
        PG8_WAIT_V(6); PG8_BAR;
    } else {
        PG8_STAGE(PG8_SB(0, 0), cB, voffB); PG8_STAGE(PG8_SA(0, 0), cA, voffA); PG8_STAGE(PG8_SB(0, 1), cB + hstep, voffB); PG8_STAGE(PG8_SA(0, 1), cA + hstep, voffA);
        if (wr == 1) PG8_BAR;
        PG8_WAIT_V(4); PG8_BAR;
        PG8_STAGE(PG8_SB(1, 0), cB + kstep, voffB); PG8_STAGE(PG8_SA(1, 0), cA + kstep, voffA); PG8_STAGE(PG8_SB(1, 1), cB + hstep + kstep, voffB);
        PG8_WAIT_V(6); PG8_BAR;
    }
    for (;;) {
        const bool has_next = S.next(ui + 1, nxt);
        const char* nA = has_next ? (const char*)g.A + (size_t)nxt.pm * tstep : cA; const char* nB = has_next ? (const char*)g.Bt + (size_t)nxt.pn * tstep : cB;
        for (int t = 0; t < nt; t += 2) {
            const bool last = (t == nt - 2);
            const char* a1 = cA + (size_t)(t + 1) * kstep;
            const char* a2 = last ? nA : cA + (size_t)(t + 2) * kstep; const char* b2 = last ? nB : cB + (size_t)(t + 2) * kstep;
            const char* a3 = a2 + kstep; const char* b3 = b2 + kstep;
            if (last && has_next) S.a_ready(nxt);
            if constexpr (SP2) {
            PG8_LDB(B0, 0, 0); PG8_LDB(B1, 0, 1); PG8_SCHED; PG8_LDA(At, 0, 0); PG8_STAGE(PG8_SA(1, 1), a1 + hstep, voffA);
            PG8_WAIT_V(8); PG8_WAIT_L(0); PG8_BAR; PG8_MMA(0, 0, At, B0); PG8_MMA(0, 1, At, B1); PG8_BAR; PG8_SCHED;
            PG8_LDA(At, 0, 1); PG8_STAGE(PG8_SB(0, 0), b2, voffB); PG8_STAGE(PG8_SB(0, 1), b2 + hstep, voffB); PG8_STAGE(PG8_SA(0, 0), a2, voffA);
            PG8_WAIT_V(8); PG8_WAIT_L(0); PG8_BAR; PG8_MMA(1, 0, At, B0); PG8_MMA(1, 1, At, B1); PG8_BAR; PG8_SCHED;
            PG8_LDB(B0, 1, 0); PG8_LDB(B1, 1, 1); PG8_SCHED; PG8_LDA(At, 1, 0); PG8_STAGE(PG8_SA(0, 1), a2 + hstep, voffA);
            PG8_WAIT_V(8); PG8_WAIT_L(0); PG8_BAR; PG8_MMA(0, 0, At, B0); PG8_MMA(0, 1, At, B1); PG8_BAR; PG8_SCHED;
            PG8_LDA(At, 1, 1); PG8_STAGE(PG8_SB(1, 0), b3, voffB); PG8_STAGE(PG8_SB(1, 1), b3 + hstep, voffB); PG8_STAGE(PG8_SA(1, 0), a3, voffA);
            PG8_WAIT_V(8); PG8_WAIT_L(0); PG8_BAR; PG8_MMA(1, 0, At, B0); PG8_MMA(1, 1, At, B1); PG8_BAR; PG8_SCHED;
            } else {
            PG8_LDB(B0, 0, 0); PG8_SCHED; PG8_LDA(At, 0, 0); PG8_STAGE(PG8_SA(1, 1), a1 + hstep, voffA);
            PG8_WAIT_L(8); PG8_BAR; PG8_WAIT_L(0); PG8_MMA(0, 0, At, B0); PG8_BAR; PG8_SCHED;
            PG8_LDB(B1, 0, 1); PG8_STAGE(PG8_SB(0, 0), b2, voffB);
            PG8_BAR; PG8_WAIT_L(0); PG8_MMA(0, 1, At, B1); PG8_BAR;
            PG8_LDA(At, 0, 1); PG8_STAGE(PG8_SA(0, 0), a2, voffA);
            PG8_BAR; PG8_WAIT_L(0); PG8_MMA(1, 0, At, B0); PG8_BAR; PG8_SCHED;
            PG8_STAGE(PG8_SB(0, 1), b2 + hstep, voffB);
            PG8_WAIT_V(6); PG8_BAR; PG8_MMA(1, 1, At, B1); PG8_BAR;
            PG8_LDB(B0, 1, 0); PG8_SCHED; PG8_LDA(At, 1, 0); PG8_STAGE(PG8_SA(0, 1), a2 + hstep, voffA);
            PG8_WAIT_L(8); PG8_BAR; PG8_WAIT_L(0); PG8_MMA(0, 0, At, B0); PG8_BAR; PG8_SCHED;
            PG8_LDB(B1, 1, 1); PG8_STAGE(PG8_SB(1, 0), b3, voffB);
            PG8_BAR; PG8_WAIT_L(0); PG8_MMA(0, 1, At, B1); PG8_BAR;
            PG8_LDA(At, 1, 1); PG8_STAGE(PG8_SA(1, 0), a3, voffA);
            PG8_BAR; PG8_WAIT_L(0); PG8_MMA(1, 0, At, B0); PG8_BAR; PG8_SCHED;
            PG8_STAGE(PG8_SB(1, 1), b3 + hstep, voffB);
            PG8_WAIT_V(6); PG8_BAR; PG8_MMA(1, 1, At, B1); PG8_BAR;
            }
        }
        if constexpr (ALIGN_EPI) { if (wr == 0) PG8_BAR; }
        if constexpr (!Epi::AFTER_DRAIN) { E(acc, cur, wr, wc, fr, fq); S.done(cur); }
        if (!has_next) break;
#pragma unroll
        for (int a = 0; a < 2; ++a)
#pragma unroll
            for (int b = 0; b < 2; ++b)
#pragma unroll
                for (int m = 0; m < 4; ++m)
#pragma unroll
                    for (int n = 0; n < 2; ++n) acc[a][b][m][n] = (f32x4){0.f, 0.f, 0.f, 0.f};
        cur = nxt; cA = nA; cB = nB; ++ui;
        if constexpr (ALIGN_EPI) { if (wr == 1) PG8_BAR; }
    }
    PG8_WAIT_V(0);
    if constexpr (!ALIGN_EPI) { if (wr == 0) PG8_BAR; }
    PG8_BAR;
    if constexpr (Epi::AFTER_DRAIN) { E.fused(acc, cur, wr, wc, fr, fq, lds, wid, lane); S.done(cur); }
#undef PG8_SA
#undef PG8_SB
#undef PG8_STAGE
#undef PG8_LDA
#undef PG8_LDB
#undef PG8_MMA
#undef PG8_WAIT_V
#undef PG8_WAIT_L
#undef PG8_BAR
#undef PG8_SCHED
}
}

namespace pg8 {
__device__ __forceinline__ float gelu_tanh(float x) {
    const float t = x * (1.5957691216057308f + 0.07135481627f * x * x);
    const float e = __builtin_amdgcn_exp2f(-1.4426950408889634f * t);
    return x * __builtin_amdgcn_rcpf(1.0f + e);
}
template <int ACT> struct EpiT {
    static constexpr bool PERM = true, AFTER_DRAIN = false;
    bf16_t* O; int ldc;
    __device__ __forceinline__ void operator()(const f32x4 (&acc)[2][2][4][2], const Unit& u, int wr, int wc, int fr, int fq) const {
        const int row0 = u.pm * BM + wr * 64 + fr; const int col0 = u.pn * BM + wc * 32 + 8 * fq;
#pragma unroll
        for (int ai = 0; ai < 2; ++ai)
#pragma unroll
            for (int m = 0; m < 4; ++m) { bf16_t* rowp = O + (size_t)(row0 + ai * HALF + m * 16) * ldc + col0;
#pragma unroll
                for (int bj = 0; bj < 2; ++bj) { f32x4 v0 = acc[ai][bj][m][0], v1 = acc[ai][bj][m][1];
                    if (ACT == 2) { v0 = (f32x4){gelu_tanh(v0[0]), gelu_tanh(v0[1]), gelu_tanh(v0[2]), gelu_tanh(v0[3])}; v1 = (f32x4){gelu_tanh(v1[0]), gelu_tanh(v1[1]), gelu_tanh(v1[2]), gelu_tanh(v1[3])}; }
                    u32x4 w; w.x = cvt_pk_bf16(v0[0], v0[1]); w.y = cvt_pk_bf16(v0[2], v0[3]); w.z = cvt_pk_bf16(v1[0], v1[1]); w.w = cvt_pk_bf16(v1[2], v1[3]);
                    *(u32x4*)(rowp + bj * HALF) = w; } }
    }
};
struct EpiR {
    static constexpr bool PERM = true, AFTER_DRAIN = false;
    bf16_t* O; int ldc; int act; int rope; const float* ropet;
    __device__ __forceinline__ void operator()(const f32x4 (&acc)[2][2][4][2], const Unit& u, int wr, int wc, int fr, int fq) const {
        const int row0 = u.pm * BM + wr * 64 + fr; const int col0 = u.pn * BM + wc * 32 + 8 * fq;
        const bool rrows = rope != 0 && u.pm < 64;
#pragma unroll
        for (int ai = 0; ai < 2; ++ai)
#pragma unroll
            for (int m = 0; m < 4; ++m) { const int grow = row0 + ai * HALF + m * 16; bf16_t* rowp = O + (size_t)grow * ldc + col0;
#pragma unroll
                for (int bj = 0; bj < 2; ++bj) { f32x4 v0 = acc[ai][bj][m][0], v1 = acc[ai][bj][m][1];
                    if (act) { v0 = (f32x4){gelu_tanh(v0[0]), gelu_tanh(v0[1]), gelu_tanh(v0[2]), gelu_tanh(v0[3])}; v1 = (f32x4){gelu_tanh(v1[0]), gelu_tanh(v1[1]), gelu_tanh(v1[2]), gelu_tanh(v1[3])}; }
                    if (rrows) { const int blk = u.pn * 8 + bj * 4 + wc; const int b6 = blk % 6; const bool on = rope == 1 ? (blk < 128) : (b6 >= 4); const int half = rope == 1 ? (blk & 1) : (b6 - 4);
                        if (on) { const int t = grow & 8191; const int pos = half ? (t & 63) : (t >> 6);
                            const float* cp = ropet + pos * 16 + 8 * (fq & 1); const f32x4 c0 = *(const f32x4*)cp, c1 = *(const f32x4*)(cp + 4), s0 = *(const f32x4*)(cp + 2048), s1 = *(const f32x4*)(cp + 2052);
                            f32x4 p0, p1;
#pragma unroll
                            for (int i = 0; i < 4; ++i) { const float a_ = v0[i], b_ = v1[i];
                                const auto r0 = __builtin_amdgcn_permlane32_swap(__float_as_uint(a_), __float_as_uint(a_), false, false);
                                const auto r1 = __builtin_amdgcn_permlane32_swap(__float_as_uint(b_), __float_as_uint(b_), false, false);
                                const unsigned x0_ = (fq & 2) ? r0[0] : r0[1], x1_ = (fq & 2) ? r1[0] : r1[1]; p0[i] = __uint_as_float(x0_); p1[i] = __uint_as_float(x1_); }
                            if (fq & 2) { v0 = p0 * s0 + v0 * c0; v1 = p1 * s1 + v1 * c1; } else { v0 = v0 * c0 - p0 * s0; v1 = v1 * c1 - p1 * s1; } } }
                    u32x4 w; w.x = cvt_pk_bf16(v0[0], v0[1]); w.y = cvt_pk_bf16(v0[2], v0[3]); w.z = cvt_pk_bf16(v1[0], v1[1]); w.w = cvt_pk_bf16(v1[2], v1[3]);
                    *(u32x4*)(rowp + bj * HALF) = w; } }
    }
};
}

constexpr int DM = 2048, NBATCH = 2, SEQ = 8192, CTXL = 256;
constexpr int ML = NBATCH * SEQ;
constexpr int MC = NBATCH * CTXL;
constexpr int MT = ML + MC;
constexpr int NLAYER = 4;
constexpr float ALPHA = 1.6817928305074290f, LN_EPS = 1e-6f;
constexpr int NWAVES = 8;
constexpr float U_SCALE = 64.0f, V_SCALE = 4.0f;
constexpr int PROW = 1536;
constexpr int PREC = 2 * PROW;
constexpr int NPH = 35;

constexpr size_t MiB = 1ull << 20;
constexpr size_t WS_CTL = 0, CTL_ZERO_BYTES = 1 * MiB;
constexpr int    CW_BAR = 4096;
constexpr size_t WS_MOD = 128 * 1024;
constexpr size_t WS_VST = 1 * MiB;
constexpr size_t WS_ROPE = 1 * MiB + 160 * 1024;
constexpr size_t WS_MODP = 1 * MiB + 256 * 1024;
constexpr size_t WS_GMWIN = 6 * MiB;
constexpr size_t WS_GMWOUT = WS_GMWIN + 32 * MiB;
constexpr size_t WS_GMWS = WS_GMWOUT + 16 * MiB;
constexpr size_t WS_PWQ = WS_GMWS + 1 * MiB;
constexpr size_t WS_PK1 = WS_PWQ + 32 * MiB;
constexpr size_t WS_PK2 = WS_PK1 + 512 * 1024;
constexpr size_t WS_MLAIN = WS_PK1 + 1 * MiB;
constexpr size_t WS_MLAUQ = WS_MLAIN + 5 * MiB;
constexpr size_t WS_MLAUKV = WS_MLAUQ + 3 * MiB;
constexpr size_t WS_MLAOUT = WS_MLAUKV + 4 * MiB;
constexpr size_t WS_DAIN = WS_MLAOUT + 8 * MiB;
constexpr size_t WS_DAOUT = WS_DAIN + 24 * MiB;
constexpr size_t WS_PU = WS_DAOUT + 8 * MiB;
constexpr size_t WS_PV = WS_PU + 96 * MiB;
constexpr size_t WS_X = WS_PV + 96 * MiB;
constexpr size_t WS_H = WS_X + 66 * MiB;
constexpr size_t WS_G = WS_H + 66 * MiB;
constexpr size_t WS_Y = WS_G + 66 * MiB;
constexpr size_t WS_QP = WS_Y + 66 * MiB;
constexpr size_t WS_Z = WS_QP + 66 * MiB;
constexpr size_t WS_C = WS_Z + 198 * MiB;
constexpr size_t WS_CQN = WS_C + 42 * MiB;
constexpr size_t WS_CKVN = WS_CQN + 17 * MiB;
constexpr size_t WS_KR = WS_CKVN + 17 * MiB;
constexpr size_t WS_QM = WS_KR + 3 * MiB;
constexpr size_t WS_KV = WS_QM + 99 * MiB;
constexpr size_t WS_ROUTE = WS_KV + 132 * MiB;
constexpr size_t WS_END = WS_ROUTE + 17 * MiB;
static_assert((size_t)MT * DM * 2 == 66 * MiB, "row buffer size");

constexpr int RING_BYTES = 155648, MISC_OFF = RING_BYTES + 320, LDS_BYTES = 159744;

#define GAS __attribute__((address_space(1)))
#define LAS __attribute__((address_space(3)))
typedef unsigned short bf16;
typedef unsigned u32x4 __attribute__((ext_vector_type(4)));
typedef unsigned u32x2 __attribute__((ext_vector_type(2)));
typedef float f32x4 __attribute__((ext_vector_type(4)));
typedef float f32x16 __attribute__((ext_vector_type(16)));
typedef short bf16x8 __attribute__((ext_vector_type(8)));
typedef short s16x4 __attribute__((ext_vector_type(4)));
#define LDS_WAIT() asm volatile("s_waitcnt lgkmcnt(0)" ::: "memory")

__device__ __forceinline__ unsigned cvtpk(float lo, float hi) { unsigned r; asm("v_cvt_pk_bf16_f32 %0, %1, %2" : "=v"(r) : "v"(lo), "v"(hi)); return r; }
__device__ __forceinline__ float bflo(unsigned w) { return __uint_as_float(w << 16); }
__device__ __forceinline__ float bfhi(unsigned w) { return __uint_as_float(w & 0xffff0000u); }
__device__ __forceinline__ float bf1(bf16 b) { return __uint_as_float((unsigned)b << 16); }
__device__ __forceinline__ bf16 tobf1(float f) { return (bf16)(cvtpk(f, 0.f) & 0xffffu); }
#define DPP_F(v, ctrl) __int_as_float(__builtin_amdgcn_mov_dpp(__float_as_int(v), (ctrl), 0xF, 0xF, true))
__device__ __forceinline__ float row_sum16(float v) { v += DPP_F(v, 0xB1); v += DPP_F(v, 0x4E); v += DPP_F(v, 0x141); v += DPP_F(v, 0x140); return v; }
__device__ __forceinline__ float sum_xor16(float v) { const auto r = __builtin_amdgcn_permlane16_swap(__float_as_uint(v), __float_as_uint(v), false, false); return __uint_as_float(r[0]) + __uint_as_float(r[1]); }
__device__ __forceinline__ float sum_xor32(float v) { const auto r = __builtin_amdgcn_permlane32_swap(__float_as_uint(v), __float_as_uint(v), false, false); return __uint_as_float(r[0]) + __uint_as_float(r[1]); }
__device__ __forceinline__ float wave_sum(float v) { return sum_xor32(sum_xor16(row_sum16(v))); }
__device__ __forceinline__ float half_sum32(float v) { return sum_xor16(row_sum16(v)); }
__device__ __forceinline__ float lane_xor16(float v, int lane) { const auto r = __builtin_amdgcn_permlane16_swap(__float_as_uint(v), __float_as_uint(v), false, false); return __uint_as_float((lane & 16) ? r[0] : r[1]); }
__device__ __forceinline__ unsigned lane_xor32(unsigned v, int lane) { const auto r = __builtin_amdgcn_permlane32_swap(v, v, false, false); return (lane & 32) ? r[0] : r[1]; }
__device__ __forceinline__ float gelu_tanh(float x) { return pg8::gelu_tanh(x); }

__device__ __forceinline__ void load_row_bf16(const bf16* row, int lane, float (&v)[32]) {
#pragma unroll
    for (int j = 0; j < 4; ++j) { const u32x4 w = ((const u32x4*)row)[64 * j + lane];
        v[8 * j + 0] = bflo(w.x); v[8 * j + 1] = bfhi(w.x); v[8 * j + 2] = bflo(w.y); v[8 * j + 3] = bfhi(w.y);
        v[8 * j + 4] = bflo(w.z); v[8 * j + 5] = bfhi(w.z); v[8 * j + 6] = bflo(w.w); v[8 * j + 7] = bfhi(w.w); }
}
__device__ __forceinline__ void store_row_bf16(bf16* row, int lane, const float (&v)[32]) {
#pragma unroll
    for (int j = 0; j < 4; ++j) { u32x4 w; w.x = cvtpk(v[8 * j + 0], v[8 * j + 1]); w.y = cvtpk(v[8 * j + 2], v[8 * j + 3]); w.z = cvtpk(v[8 * j + 4], v[8 * j + 5]); w.w = cvtpk(v[8 * j + 6], v[8 * j + 7]);
        ((u32x4*)row)[64 * j + lane] = w; }
}
__device__ __forceinline__ void load_row_f32(const float* row, int lane, float (&v)[32]) {
#pragma unroll
    for (int j = 0; j < 4; ++j) { const f32x4 a = ((const f32x4*)row)[128 * j + 2 * lane], b = ((const f32x4*)row)[128 * j + 2 * lane + 1];
        v[8 * j + 0] = a.x; v[8 * j + 1] = a.y; v[8 * j + 2] = a.z; v[8 * j + 3] = a.w; v[8 * j + 4] = b.x; v[8 * j + 5] = b.y; v[8 * j + 6] = b.z; v[8 * j + 7] = b.w; }
}
__device__ __forceinline__ void store_row_f32(float* row, int lane, const float (&v)[32]) {
#pragma unroll
    for (int j = 0; j < 4; ++j) { ((f32x4*)row)[128 * j + 2 * lane] = (f32x4){v[8 * j + 0], v[8 * j + 1], v[8 * j + 2], v[8 * j + 3]};
        ((f32x4*)row)[128 * j + 2 * lane + 1] = (f32x4){v[8 * j + 4], v[8 * j + 5], v[8 * j + 6], v[8 * j + 7]}; }
}
__device__ __forceinline__ void load_row_bf16_b(const bf16* row, int lane, float (&v)[32]) {
#pragma unroll
    for (int j = 0; j < 4; ++j) { const u32x4 w = ((const u32x4*)row)[4 * lane + j];
        v[8 * j + 0] = bflo(w.x); v[8 * j + 1] = bfhi(w.x); v[8 * j + 2] = bflo(w.y); v[8 * j + 3] = bfhi(w.y);
        v[8 * j + 4] = bflo(w.z); v[8 * j + 5] = bfhi(w.z); v[8 * j + 6] = bflo(w.w); v[8 * j + 7] = bfhi(w.w); }
}
__device__ __forceinline__ void store_row_bf16_b(bf16* row, int lane, const float (&v)[32]) {
#pragma unroll
    for (int j = 0; j < 4; ++j) { u32x4 w; w.x = cvtpk(v[8 * j + 0], v[8 * j + 1]); w.y = cvtpk(v[8 * j + 2], v[8 * j + 3]); w.z = cvtpk(v[8 * j + 4], v[8 * j + 5]); w.w = cvtpk(v[8 * j + 6], v[8 * j + 7]);
        ((u32x4*)row)[4 * lane + j] = w; }
}
__device__ __forceinline__ void load_row_f32_b(const float* row, int lane, float (&v)[32]) {
#pragma unroll
    for (int q = 0; q < 8; ++q) { const f32x4 a = ((const f32x4*)row)[8 * lane + q];
        v[4 * q + 0] = a.x; v[4 * q + 1] = a.y; v[4 * q + 2] = a.z; v[4 * q + 3] = a.w; }
}
__device__ __forceinline__ void store_row_f32_b(float* row, int lane, const float (&v)[32]) {
#pragma unroll
    for (int q = 0; q < 8; ++q) ((f32x4*)row)[8 * lane + q] = (f32x4){v[4 * q + 0], v[4 * q + 1], v[4 * q + 2], v[4 * q + 3]};
}
__device__ __forceinline__ void ln_stats(const float (&v)[32], float& mean, float& rstd) {
    float s = 0.f;
#pragma unroll
    for (int i = 0; i < 32; ++i) s += v[i];
    mean = wave_sum(s) * (1.0f / DM);
    float q = 0.f;
#pragma unroll
    for (int i = 0; i < 32; ++i) { const float d = v[i] - mean; q += d * d; }
    rstd = 1.0f / sqrtf(wave_sum(q) * (1.0f / DM) + LN_EPS);
}
template <bool LAYB>
__device__ __forceinline__ void finish_row(float (&z)[32], const float* lng, const float* lnb, bf16* Xrow, const float* sh, const float* sc, bf16* Hrow, float* Orow, int lane) {
    float mean, rstd; ln_stats(z, mean, rstd);
    { float g[32], b[32]; if (LAYB) { load_row_f32_b(lng, lane, g); load_row_f32_b(lnb, lane, b); } else { load_row_f32(lng, lane, g); load_row_f32(lnb, lane, b); }
#pragma unroll
      for (int i = 0; i < 32; ++i) z[i] = (z[i] - mean) * rstd * g[i] + b[i]; }
    if (Xrow) { if (LAYB) store_row_bf16_b(Xrow, lane, z); else store_row_bf16(Xrow, lane, z); }
    if (Orow) { if (LAYB) store_row_f32_b(Orow, lane, z); else store_row_f32(Orow, lane, z); }
    if (Hrow) {
        ln_stats(z, mean, rstd);
        float a[32], s[32]; if (LAYB) { load_row_f32_b(sc, lane, a); load_row_f32_b(sh, lane, s); } else { load_row_f32(sc, lane, a); load_row_f32(sh, lane, s); }
#pragma unroll
        for (int i = 0; i < 32; ++i) a[i] = (z[i] - mean) * rstd * (1.0f + a[i]) + s[i];
        if (LAYB) store_row_bf16_b(Hrow, lane, a); else store_row_bf16(Hrow, lane, a);
    }
}
__device__ __forceinline__ int row_slot(int row) { return row < ML ? (row >> 13) : 2; }

__device__ __forceinline__ unsigned f2bf_rne(float f) { unsigned u = __float_as_uint(f); return (u + 0x7fffu + ((u >> 16) & 1u)) >> 16; }
__device__ __forceinline__ unsigned pk2(float lo, float hi) { return f2bf_rne(lo) | (f2bf_rne(hi) << 16); }
__device__ __forceinline__ void p0_transpose_item(const float* W, int K, int N, bf16* WT, LAS float* scr, int item, int lane) {
    const int nblk = N / 32, kb = item / nblk, nb = item % nblk, k0 = 64 * kb, n0 = 32 * nb;
    f32x4 t[8];
#pragma unroll
    for (int i = 0; i < 8; ++i) t[i] = *(const f32x4*)(W + (size_t)(k0 + 8 * i + (lane >> 3)) * N + n0 + 4 * (lane & 7));
#pragma unroll
    for (int i = 0; i < 8; ++i) { LAS float* d = scr + (8 * i + (lane >> 3)) * 33 + 4 * (lane & 7); d[0] = t[i].x; d[1] = t[i].y; d[2] = t[i].z; d[3] = t[i].w; }
    LDS_WAIT(); asm volatile("" ::: "memory");
    const int c = lane & 7;
#pragma unroll
    for (int j = 0; j < 4; ++j) { const int n = (lane >> 3) + 8 * j; const LAS float* s = scr + (8 * c) * 33 + n;
        u32x4 o; o.x = pk2(s[0 * 33], s[1 * 33]); o.y = pk2(s[2 * 33], s[3 * 33]); o.z = pk2(s[4 * 33], s[5 * 33]); o.w = pk2(s[6 * 33], s[7 * 33]);
        *(u32x4*)(WT + (size_t)(n0 + n) * K + k0 + 8 * c) = o; }
    LDS_WAIT(); asm volatile("" ::: "memory");
}
__device__ __forceinline__ void cvt_range(const float* src, bf16* dst, size_t n8, size_t gtid, size_t gthreads) {
#pragma unroll 4
    for (size_t i = gtid; i < n8; i += gthreads) { const f32x4 a = ((const f32x4*)src)[2 * i], b = ((const f32x4*)src)[2 * i + 1];
        u32x4 w; w.x = cvtpk(a.x, a.y); w.y = cvtpk(a.z, a.w); w.z = cvtpk(b.x, b.y); w.w = cvtpk(b.z, b.w); ((u32x4*)dst)[i] = w; }
}
__device__ __forceinline__ unsigned enc_e2m3(float x) {
    const unsigned sgn = (__float_as_uint(x) >> 26) & 32u;
    const float ax = fminf(fabsf(x), 7.5f);
    unsigned u = __float_as_uint(ax); u += 0x7FFFFu + ((u >> 20) & 1u);
    const unsigned cn = (u >> 20) - ((127u - 1u) << 3);
    const unsigned cs = (unsigned)__builtin_rintf(ax * 8.0f);
    return sgn | (ax < 1.0f ? cs : cn);
}
#ifndef CVT_PIPE
#define CVT_PIPE 0
#endif
typedef float f32x16v __attribute__((ext_vector_type(16)));
typedef float f32x32v __attribute__((ext_vector_type(32)));
typedef unsigned u32x6v __attribute__((ext_vector_type(6)));
__device__ __forceinline__ u32x6v pack_fp6_32(const float (&e)[32], bool interleaved) {
    f32x16v s0, s1;
    if (interleaved) {
#pragma unroll
        for (int i = 0; i < 16; ++i) { s0[i] = e[2 * i]; s1[i] = e[2 * i + 1]; }
    } else {
#pragma unroll
        for (int i = 0; i < 16; ++i) { s0[i] = e[i]; s1[i] = e[16 + i]; }
    }
    return __builtin_amdgcn_cvt_scalef32_2xpk16_fp6_f32(s0, s1, 1.0f);
}
__device__ __forceinline__ void cvt_table_fp6(const float* src, unsigned char* dst, int nrows, float scale, LAS float* scr  , int lane, int gw, int NGW, const int isv) {
    bool interleaved;
    {
        float t[32];
#pragma unroll
        for (int k = 0; k < 32; ++k) t[k] = k < 16 ? 0.125f * k : (k < 24 ? 2.0f + 0.25f * (k - 16) : 4.0f + 0.5f * (k - 24));
        float tt[32];
#pragma unroll
        for (int k = 0; k < 32; ++k) { tt[k] = t[k]; asm volatile("" : "+v"(tt[k])); }
        const u32x6v p = pack_fp6_32(tt, true);
        const f32x32v o = __builtin_amdgcn_cvt_scalef32_pk32_f32_fp6(p, 1.0f);
        interleaved = (o[1] == t[1]) && (o[2] == t[2]) && (o[17] == t[17]);
        interleaved = __all(interleaved);
    }
#if CVT_PIPE
    f32x4 nx[8];
    if (gw < nrows) { const f32x4* s4 = (const f32x4*)(src + (size_t)gw * 2048);
#pragma unroll
        for (int q = 0; q < 8; ++q) nx[q] = s4[64 * q + lane]; }
    for (int row = gw; row < nrows; row += NGW) {
        f32x4 cur[8];
#pragma unroll
        for (int q = 0; q < 8; ++q) cur[q] = nx[q];
        if (row + NGW < nrows) { const f32x4* s4 = (const f32x4*)(src + (size_t)(row + NGW) * 2048);
#pragma unroll
            for (int q = 0; q < 8; ++q) nx[q] = s4[64 * q + lane]; }
#pragma unroll
        for (int q = 0; q < 8; ++q) { const int s = 64 * q + lane; const f32x4 a = cur[q] * scale; *(LAS f32x4*)(scr + 4 * (s ^ ((s >> 4) & 7))) = a; }
#else
    for (int row = gw; row < nrows; row += NGW) {
        const f32x4* s4 = (const f32x4*)(src + (size_t)row * 2048);
#pragma unroll
        for (int q = 0; q < 8; ++q) { const int s = 64 * q + lane; const f32x4 a = s4[s] * scale; *(LAS f32x4*)(scr + 4 * (s ^ ((s >> 4) & 7))) = a; }
#endif
        float e[32];
#pragma unroll
        for (int j = 0; j < 8; ++j) { const int s = 8 * lane + j; const f32x4 a = *(const LAS f32x4*)(scr + 4 * (s ^ ((s >> 4) & 7)));
            e[4 * j + 0] = __builtin_amdgcn_fmed3f(a.x, -7.5f, 7.5f); e[4 * j + 1] = __builtin_amdgcn_fmed3f(a.y, -7.5f, 7.5f); e[4 * j + 2] = __builtin_amdgcn_fmed3f(a.z, -7.5f, 7.5f); e[4 * j + 3] = __builtin_amdgcn_fmed3f(a.w, -7.5f, 7.5f); }
        const u32x6v p = pack_fp6_32(e, interleaved);
        unsigned char* rowp = dst + (size_t)row * PREC;
        *(u32x4*)(rowp + 1024 * isv + 16 * lane) = (u32x4){p[0], p[1], p[2], p[3]}; *(u32x2*)(rowp + 2048 + 512 * isv + 8 * lane) = (u32x2){p[4], p[5]};
    }
}
__device__ __forceinline__ float silu(float x) { return x / (1.0f + __expf(-x)); }

struct Params { const float* in[29]; float* out; unsigned char* ws; int ph_lo, ph_hi; };
typedef const __attribute__((address_space(4))) Params* CP;

#ifndef TAIL_REMAP
#define TAIL_REMAP 0
#endif
__device__ __forceinline__ void p0_prologue(CP P, LAS unsigned char* lds, int tid, int lane, int wid, int gw, int NGW, const int parts = 7) {
    unsigned char* ws = P->ws;
    LAS float* scr = (LAS float*)(lds + wid * 16384);
    if (parts & 1) {
        constexpr int I_GMIN = (2048 / 64) * (4096 / 32), I_SQ = (2048 / 64) * (2048 / 32), I_MIN = (2048 / 64) * (1088 / 32), I_UQ = (512 / 64) * (3072 / 32), I_UKV = (512 / 64) * (4096 / 32), I_DIN = (2048 / 64) * (6144 / 32);
        constexpr int NIT = 2 * I_GMIN + 2 * I_SQ + 4 * I_SQ + I_MIN + I_UQ + I_UKV + I_SQ + I_DIN + I_SQ;
        for (int it = gw; it < NIT; it += NGW) {
            int r = it;
            if (r < 2 * I_GMIN) { const int j = r / I_GMIN; p0_transpose_item(P->in[13] + (size_t)j * 2048 * 4096, 2048, 4096, (bf16*)(ws + WS_GMWIN) + (size_t)j * 4096 * 2048, scr, r % I_GMIN, lane); continue; } r -= 2 * I_GMIN;
            if (r < 2 * I_SQ) { const int j = r / I_SQ; p0_transpose_item(P->in[18] + (size_t)j * 2048 * 2048, 2048, 2048, (bf16*)(ws + WS_GMWOUT) + (size_t)j * 2048 * 2048, scr, r % I_SQ, lane); continue; } r -= 2 * I_SQ;
            if (r < 4 * I_SQ) { const int j = r / I_SQ; p0_transpose_item(P->in[8] + (size_t)j * 2048 * 2048, 2048, 2048, (bf16*)(ws + WS_PWQ) + (size_t)j * 2048 * 2048, scr, r % I_SQ, lane); continue; } r -= 4 * I_SQ;
            if (r < I_MIN) { p0_transpose_item(P->in[19], 2048, 1088, (bf16*)(ws + WS_MLAIN), scr, r, lane); continue; } r -= I_MIN;
            if (r < I_UQ) { p0_transpose_item(P->in[22], 512, 3072, (bf16*)(ws + WS_MLAUQ), scr, r, lane); continue; } r -= I_UQ;
            if (r < I_UKV) { p0_transpose_item(P->in[23], 512, 4096, (bf16*)(ws + WS_MLAUKV), scr, r, lane); continue; } r -= I_UKV;
            if (r < I_SQ) { p0_transpose_item(P->in[24], 2048, 2048, (bf16*)(ws + WS_MLAOUT), scr, r, lane); continue; } r -= I_SQ;
            if (r < I_DIN) { p0_transpose_item(P->in[25], 2048, 6144, (bf16*)(ws + WS_DAIN), scr, r, lane); continue; } r -= I_DIN;
            p0_transpose_item(P->in[28], 2048, 2048, (bf16*)(ws + WS_DAOUT), scr, r, lane);
        }
    }
    const size_t gtid = (size_t)gw * 64 + lane, gthreads = (size_t)NGW * 64;
    if (parts & 2) {
    { u32x4* z = (u32x4*)((bf16*)(ws + WS_MLAIN) + (size_t)1088 * 2048); const size_t n = (size_t)192 * 2048 / 8;
      for (size_t i = gtid; i < n; i += gthreads) z[i] = (u32x4){0u, 0u, 0u, 0u}; }
    cvt_range(P->in[16], (bf16*)(ws + WS_GMWS), (size_t)2 * 16 * 128 * 128 / 8, gtid, gthreads);
    cvt_range(P->in[9], (bf16*)(ws + WS_PK1), (size_t)4 * 128 * 128 / 8, gtid, gthreads);
    cvt_range(P->in[10], (bf16*)(ws + WS_PK2), (size_t)4 * 128 * 128 / 8, gtid, gthreads);
#if !TAIL_REMAP
    cvt_table_fp6(P->in[11], ws + WS_PU, 16384, U_SCALE, scr, lane, gw, NGW, 0);
    cvt_table_fp6(P->in[12], ws + WS_PU, 16384, V_SCALE, scr, lane, gw, NGW, 1);
#endif
    if (gtid < 2048) { const int pos = (int)gtid >> 4, f = (int)gtid & 15; const float inv = powf(10000.0f, -(float)f * (1.0f / 16.0f)); float sn, cs; sincosf((float)pos * inv, &sn, &cs);
        float* rt = (float*)(ws + WS_ROPE); rt[gtid] = cs; rt[2048 + gtid] = sn; }
    }
    if (parts & 4) {
        const float* cv = P->in[1]; const float* cc = P->in[3]; const float* mw = P->in[4]; float* PART = (float*)(ws + WS_MODP);
        LAS float* S = (LAS float*)lds;
        __syncthreads();
        for (int i = tid; i < 3 * 2048; i += NWAVES * 64) { const int sl = i >> 11, kk = i & 2047; S[i] = silu(sl == 0 ? cv[kk] : (sl == 1 ? cv[2048 + kk] : cc[kk])); }
        __syncthreads();
        for (int item = gw; item < 4 * 192 * 8; item += NGW) {
            const int ks = item & 7, r = item >> 3, L = r / 192, n = (r % 192) * 64 + lane;
            const float* W = mw + (size_t)L * 2048 * 12288 + (size_t)(ks * 256) * 12288 + n;
            float a0 = 0.f, a1 = 0.f, a2 = 0.f;
#pragma unroll 32
            for (int k = 0; k < 256; ++k) { const int kk = ks * 256 + k; const float s0 = S[kk], s1 = S[2048 + kk], s2 = S[4096 + kk];
                const float w = W[(size_t)k * 12288]; a0 += s0 * w; a1 += s1 * w; a2 += s2 * w; }
            float* o = PART + ((size_t)ks * 4 + L) * 3 * 12288 + n;
            o[0] = a0; o[12288] = a1; o[24576] = a2;
        }
    }
}
__device__ __forceinline__ void mod_reduce(CP P, int gw, int lane, int NGW) {
    const float* PART = (const float*)(P->ws + WS_MODP); float* MOD = (float*)(P->ws + WS_MOD); const float* mb = P->in[5];
    for (int i = gw * 64 + lane; i < 4 * 3 * 12288; i += NGW * 64) {
        const int L = i / (3 * 12288), n = i % 12288;
        float s = mb[(size_t)L * 12288 + n];
#pragma unroll
        for (int ks = 0; ks < 8; ++ks) s += PART[(size_t)ks * 4 * 3 * 12288 + i];
        MOD[i] = s;
    }
}

__device__ __forceinline__ void first_row_pass(CP P, int lane, int gw, int NGW) {
    const float* MOD = (const float*)(P->ws + WS_MOD); bf16* X = (bf16*)(P->ws + WS_X); bf16* H = (bf16*)(P->ws + WS_H);
    for (int row = gw; row < MT; row += NGW) {
        const float* src = row < ML ? P->in[0] + (size_t)row * DM : P->in[2] + (size_t)(row - ML) * DM;
        float v[32]; load_row_f32(src, lane, v);
        store_row_bf16(X + (size_t)row * DM, lane, v);
        const float* mod = MOD + (size_t)row_slot(row) * 12288;
        float mean, rstd; ln_stats(v, mean, rstd);
        float a[32], s[32]; load_row_f32(mod + 2048, lane, a); load_row_f32(mod, lane, s);
#pragma unroll
        for (int i = 0; i < 32; ++i) a[i] = (v[i] - mean) * rstd * (1.0f + a[i]) + s[i];
        store_row_bf16(H + (size_t)row * DM, lane, a);
    }
}
#ifndef POSTMIX_LDS
#define POSTMIX_LDS 1
#endif
__device__ __forceinline__ void load_row_f32_l(const LAS float* row, int lane, float (&v)[32]) {
#pragma unroll
    for (int j = 0; j < 4; ++j) { const f32x4 a = ((const LAS f32x4*)row)[128 * j + 2 * lane], b = ((const LAS f32x4*)row)[128 * j + 2 * lane + 1];
        v[8 * j + 0] = a.x; v[8 * j + 1] = a.y; v[8 * j + 2] = a.z; v[8 * j + 3] = a.w; v[8 * j + 4] = b.x; v[8 * j + 5] = b.y; v[8 * j + 6] = b.z; v[8 * j + 7] = b.w; }
}
__device__ __forceinline__ void post_mixer_pass_lds(CP P, int L, int Mrows, LAS unsigned char* lds, int tid, int lane, int gw, int NGW) {
    const float* MOD = (const float*)(P->ws + WS_MOD); bf16* X = (bf16*)(P->ws + WS_X); bf16* H = (bf16*)(P->ws + WS_H); const bf16* Y = (const bf16*)(P->ws + WS_Y);
    const float* lng = P->in[6] + (size_t)(L * 2 + 0) * DM; const float* lnb = P->in[7] + (size_t)(L * 2 + 0) * DM;
    LAS float* V = (LAS float*)lds;
    __syncthreads();
    for (int i = tid; i < 11 * 512; i += NWAVES * 64) { const int vec = i >> 9, g4 = i & 511;
        const float* src = vec == 0 ? lng : (vec == 1 ? lnb : MOD + (size_t)(L * 3 + (vec - 2) / 3) * 12288 + (size_t)(2 + (vec - 2) % 3) * 2048);
        ((LAS f32x4*)V)[i] = ((const f32x4*)src)[g4]; }
    __syncthreads();
    for (int row = gw; row < Mrows; row += NGW) {
        const LAS float* mv = V + (2 + 3 * row_slot(row)) * 2048;
        float z[32], y[32]; load_row_bf16(X + (size_t)row * DM, lane, z); load_row_bf16(Y + (size_t)row * DM, lane, y);
        { float g[32]; load_row_f32_l(mv, lane, g);
#pragma unroll
          for (int i = 0; i < 32; ++i) z[i] = ALPHA * z[i] + g[i] * y[i]; }
        float mean, rstd; ln_stats(z, mean, rstd);
        { float g[32], b[32]; load_row_f32_l(V, lane, g); load_row_f32_l(V + 2048, lane, b);
#pragma unroll
          for (int i = 0; i < 32; ++i) z[i] = (z[i] - mean) * rstd * g[i] + b[i]; }
        store_row_bf16(X + (size_t)row * DM, lane, z);
        ln_stats(z, mean, rstd);
        { float a[32], s_[32]; load_row_f32_l(mv + 2 * 2048, lane, a); load_row_f32_l(mv + 2048, lane, s_);
#pragma unroll
          for (int i = 0; i < 32; ++i) a[i] = (z[i] - mean) * rstd * (1.0f + a[i]) + s_[i];
          store_row_bf16(H + (size_t)row * DM, lane, a); }
    }
}
__device__ __forceinline__ void post_mixer_pass(CP P, int L, int Mrows, int lane, int gw, int NGW) {
    const float* MOD = (const float*)(P->ws + WS_MOD); bf16* X = (bf16*)(P->ws + WS_X); bf16* H = (bf16*)(P->ws + WS_H); const bf16* Y = (const bf16*)(P->ws + WS_Y);
    const float* lng = P->in[6] + (size_t)(L * 2 + 0) * DM; const float* lnb = P->in[7] + (size_t)(L * 2 + 0) * DM;
    for (int row = gw; row < Mrows; row += NGW) {
        const float* mod = MOD + (size_t)(L * 3 + row_slot(row)) * 12288;
        float z[32], y[32], g[32]; load_row_bf16(X + (size_t)row * DM, lane, z); load_row_bf16(Y + (size_t)row * DM, lane, y); load_row_f32(mod + 2 * 2048, lane, g);
#pragma unroll
        for (int i = 0; i < 32; ++i) z[i] = ALPHA * z[i] + g[i] * y[i];
        finish_row<false>(z, lng, lnb, X + (size_t)row * DM, mod + 3 * 2048, mod + 4 * 2048, H + (size_t)row * DM, nullptr, lane);
    }
}
__device__ __forceinline__ void vstats_pass(CP P, int Mrows, int lane, int gw, int NGW) {
    const bf16* Z = (const bf16*)(P->ws + WS_Z); float* VST = (float*)(P->ws + WS_VST);
    for (int row = gw; row < Mrows; row += NGW) {
        float v[32]; load_row_bf16(Z + (size_t)row * 4096 + 2048, lane, v);
        float mean, rstd; ln_stats(v, mean, rstd);
        if (lane == 0) { VST[2 * row] = mean; VST[2 * row + 1] = rstd; }
    }
}
#define XB_TMO      128
#define XB_XCNT(j)  (256  + 64 * (j))
#define XB_XSUB(j)  (1280 + 64 * (j))
#define XB_XGEN(j)  (2304 + 64 * (j))
#define XB_TOP      3328
#define XB_TOPGEN   3392
#define XCD_BAR_WORDS 3456
#define XB_SPIN_CAP (1u << 18)

__device__ __forceinline__ unsigned xb_ld(unsigned* p)              { return __hip_atomic_load(p, __ATOMIC_RELAXED, __HIP_MEMORY_SCOPE_AGENT); }
__device__ __forceinline__ unsigned xb_add(unsigned* p, unsigned v) { return __hip_atomic_fetch_add(p, v, __ATOMIC_RELAXED, __HIP_MEMORY_SCOPE_AGENT); }
__device__ __forceinline__ unsigned xb_xcc_id() { return (unsigned)__builtin_amdgcn_s_getreg((3 << 11) | 20) & 0xFu; }
#define XB_SPIN(cond, bar) do { unsigned _sp = 0; while (cond) { __builtin_amdgcn_s_sleep(1); \
    if ((++_sp & 255u) == 0u) { if (xb_ld(&(bar)[XB_TMO])) break; if (_sp > XB_SPIN_CAP) { atomicAdd(&(bar)[XB_TMO], 1u); break; } } } } while (0)

struct XcdBarrier {
    unsigned* bar; unsigned x;
    volatile LAS unsigned* st;
};

__device__ __forceinline__ XcdBarrier xcd_barrier_post(unsigned* bar, volatile LAS unsigned* st, const bool t0) {
    XcdBarrier b; b.bar = bar; b.x = xb_xcc_id(); b.st = st;
    if (t0) (void)xb_add(&bar[XB_XCNT(b.x)], 1u);
    return b;
}
__device__ __forceinline__ void xcd_barrier_complete(unsigned* bar, unsigned x, unsigned& nloc, unsigned& nx) {
    const unsigned G = gridDim.x * gridDim.y * gridDim.z;
    unsigned sum, cnt, mine, sp = 0u;
    for (;;) {
        sum = 0u; cnt = 0u; mine = 0u;
#pragma unroll
        for (unsigned j = 0; j < 16; ++j) { const unsigned c = xb_ld(&bar[XB_XCNT(j)]); sum += c; cnt += (c > 0u) ? 1u : 0u; mine = (j == x) ? c : mine; }
        if (sum == G) break;
        __builtin_amdgcn_s_sleep(1);
        if ((++sp & 255u) == 0u) { if (xb_ld(&bar[XB_TMO])) break; if (sp > XB_SPIN_CAP) { atomicAdd(&bar[XB_TMO], 1u); break; } }
    }
    nloc = mine > 0u ? mine : 1u; nx = cnt > 0u ? cnt : 1u;
}

__device__ __attribute__((noinline)) void xcd_barrier(const XcdBarrier b, const bool t0) {
    asm volatile("s_waitcnt vmcnt(0)" ::: "memory");
    __syncthreads();
    if (t0) {
        unsigned* bar = b.bar;
        __builtin_amdgcn_s_waitcnt(0);
        unsigned nloc = b.st[0], nx = b.st[1];
        if (nloc == 0u) { xcd_barrier_complete(bar, b.x, nloc, nx); b.st[0] = nloc; b.st[1] = nx; }
        const unsigned old = xb_add(&bar[XB_XSUB(b.x)], 1u);
        const unsigned gen = old / nloc;
        if (old + 1u == (gen + 1u) * nloc) {
            __builtin_amdgcn_fence(__ATOMIC_RELEASE, "agent");
            asm volatile("s_waitcnt vmcnt(0)" ::: "memory");
            const unsigned og = xb_add(&bar[XB_TOP], 1u);
            const unsigned tg = og / nx;
            if (og + 1u == (tg + 1u) * nx) xb_add(&bar[XB_TOPGEN], 1u);
            else XB_SPIN(xb_ld(&bar[XB_TOPGEN]) == tg, bar);
            __builtin_amdgcn_fence(__ATOMIC_ACQUIRE, "agent");
            xb_add(&bar[XB_XGEN(b.x)], 1u);
            asm volatile("s_waitcnt vmcnt(0)" ::: "memory");
        } else {
            XB_SPIN(xb_ld(&bar[XB_XGEN(b.x)]) == gen, bar);
            __builtin_amdgcn_fence(__ATOMIC_ACQUIRE, "agent");
            asm volatile("s_waitcnt vmcnt(0)" ::: "memory");
        }
    }
    __syncthreads();
}

__device__ __forceinline__ void spatial_phase(CP P, int j, int Mrows, LAS unsigned char* lds_, int tid, int lane, int wid) {
    const bf16* Z = (const bf16*)(P->ws + WS_Z); const float* VST = (const float*)(P->ws + WS_VST); bf16* Gb = (bf16*)(P->ws + WS_G);
    const bf16* WS = (const bf16*)(P->ws + WS_GMWS) + (size_t)j * 16 * 128 * 128;
    const float* lng = P->in[14] + (size_t)j * DM; const float* lnb = P->in[15] + (size_t)j * DM; const float* bs = P->in[17] + (size_t)j * 16 * 128;
    LAS bf16* Vt = (LAS bf16*)(LAS unsigned char*)lds_;
    constexpr int VP = 136;
    const int nunits = (Mrows / 128) * 16;
    for (int u = blockIdx.x; u < nunits; u += gridDim.x) {
        const int c = u >> 4, g = u & 15;
        __syncthreads();
        {
            const int q = tid >> 2, dq = (tid & 3) * 32; const int row = c * 128 + q;
            const float mean = VST[2 * row], rstd = VST[2 * row + 1];
            const bf16* src = Z + (size_t)row * 4096 + 2048 + g * 128 + dq;
#pragma unroll
            for (int t = 0; t < 4; ++t) { const u32x4 w = *(const u32x4*)(src + 8 * t);
                float v[8] = {bflo(w.x), bfhi(w.x), bflo(w.y), bfhi(w.y), bflo(w.z), bfhi(w.z), bflo(w.w), bfhi(w.w)};
                const float* gp = lng + g * 128 + dq + 8 * t; const float* bp = lnb + g * 128 + dq + 8 * t;
#pragma unroll
                for (int i = 0; i < 8; ++i) { const float vn = (v[i] - mean) * rstd * gp[i] + bp[i]; Vt[(dq + 8 * t + i) * VP + q] = tobf1(vn); } }
        }
        __syncthreads();
        const int fr = lane & 15, fq = lane >> 4;
        bf16x8 a[4];
        const bf16* wrow = WS + (size_t)g * 128 * 128 + (size_t)(16 * wid + fr) * 128 + 8 * fq;
#pragma unroll
        for (int ks = 0; ks < 4; ++ks) a[ks] = *(const bf16x8*)(wrow + 32 * ks);
#pragma unroll
        for (int nb = 0; nb < 8; ++nb) {
            f32x4 acc = {0.f, 0.f, 0.f, 0.f};
#pragma unroll
            for (int ks = 0; ks < 4; ++ks) { const bf16x8 b = *(const LAS bf16x8*)(Vt + (16 * nb + fr) * VP + 32 * ks + 8 * fq);
                acc = __builtin_amdgcn_mfma_f32_16x16x32_bf16(a[ks], b, acc, 0, 0, 0); }
#pragma unroll
            for (int r = 0; r < 4; ++r) { const int p = 16 * wid + fq * 4 + r, d = 16 * nb + fr; const size_t grow = (size_t)(c * 128 + p);
                const float sv = acc[r] + bs[g * 128 + p];
                const float uu = bf1(Z[grow * 4096 + g * 128 + d]);
                Gb[grow * 2048 + g * 128 + d] = tobf1(uu * sv); }
        }
    }
}

__device__ __forceinline__ void rope_cs(int row, int l, float& cs, float& sn) {
    const int t = row & (SEQ - 1); const int pos = (l & 32) ? (t & 63) : (t >> 6);
    const float inv = powf(10000.0f, -(float)(l & 15) * (1.0f / 16.0f));
    const float ang = (float)pos * inv; sincosf(ang, &sn, &cs);
}
__device__ __forceinline__ float rope_apply(float x, int l, float cs, float sn) {
    const float p = lane_xor16(x, l);
    return (l & 16) ? (p * sn + x * cs) : (x * cs - p * sn);
}
__device__ __forceinline__ void mla_norm_pass(CP P, int lane, int gw, int NGW) {
    const bf16* C = (const bf16*)(P->ws + WS_C); bf16* CQN = (bf16*)(P->ws + WS_CQN); bf16* CKVN = (bf16*)(P->ws + WS_CKVN); bf16* KR = (bf16*)(P->ws + WS_KR);
    const float* qn = P->in[20]; const float* kvn = P->in[21];
    for (int row = gw; row < MT; row += NGW) {
        const bf16* c = C + (size_t)row * 1280;
#pragma unroll
        for (int part = 0; part < 2; ++part) {
            const u32x4 w = *(const u32x4*)(c + part * 512 + 8 * lane);
            float v[8] = {bflo(w.x), bfhi(w.x), bflo(w.y), bfhi(w.y), bflo(w.z), bfhi(w.z), bflo(w.w), bfhi(w.w)};
            float ss = 0.f;
#pragma unroll
            for (int i = 0; i < 8; ++i) ss += v[i] * v[i];
            const float r = 1.0f / sqrtf(wave_sum(ss) * (1.0f / 512.0f) + LN_EPS);
            const float* nw = (part ? kvn : qn) + 8 * lane;
            u32x4 o; o.x = cvtpk(v[0] * r * nw[0], v[1] * r * nw[1]); o.y = cvtpk(v[2] * r * nw[2], v[3] * r * nw[3]); o.z = cvtpk(v[4] * r * nw[4], v[5] * r * nw[5]); o.w = cvtpk(v[6] * r * nw[6], v[7] * r * nw[7]);
            *(u32x4*)((part ? CKVN : CQN) + (size_t)row * 512 + 8 * lane) = o;
        }
        float x = bf1(c[1024 + lane]);
        if (row < ML) { float cs, sn; rope_cs(row, lane, cs, sn); x = rope_apply(x, lane, cs, sn); }
        KR[(size_t)row * 64 + lane] = tobf1(x);
    }
}
__device__ __forceinline__ void rope_pass(bf16* buf, int ld, int col0, int nchunks, int cstride, int lane, int gw, int NGW) {
    for (int row = gw; row < ML; row += NGW) {
        float cs, sn; rope_cs(row, lane, cs, sn);
        bf16* r = buf + (size_t)row * ld + col0 + lane;
#pragma unroll 4
        for (int k = 0; k < nchunks; ++k) { const float x = bf1(r[k * cstride]); r[k * cstride] = tobf1(rope_apply(x, lane, cs, sn)); }
    }
}

namespace att {
#ifndef ATT_LEAN
#define ATT_LEAN 1
#endif
#ifndef ATT_3STAGE
#define ATT_3STAGE 0
#endif
#ifndef ATT_PRIO
#define ATT_PRIO 0
#endif
#ifndef ATT_KMAJOR
#define ATT_KMAJOR 0
#endif
#ifndef ATT_TRB
#define ATT_TRB 1
#endif
#ifndef ATT_STAGGER
#define ATT_STAGGER 0
#endif
#ifndef ATT_SDEPTH
#define ATT_SDEPTH(MODE) ((MODE) == 0 ? 1 : 1)
#endif
#ifndef ATT_PVPIPE
#define ATT_PVPIPE(MODE) ((MODE) == 1)
#endif
#define SBAR() __builtin_amdgcn_sched_barrier(0)
__device__ __forceinline__ int crow(int r, int hi) { return (r & 3) + 8 * (r >> 2) + 4 * hi; }
__device__ __forceinline__ unsigned cvtpkv(float lo, float hi) { unsigned r; asm volatile("v_cvt_pk_bf16_f32 %0, %1, %2" : "=v"(r) : "v"(lo), "v"(hi)); return r; }

__device__ __forceinline__ void partialSM(f32x16& p0, f32x16& p1, float& m_reg, float& mn, float& alpha, const float C, const float THRS) {
  float pmax = p0[0];
#pragma unroll
  for (int r = 1; r < 16; ++r) pmax = fmaxf(pmax, p0[r]);
#pragma unroll
  for (int r = 0; r < 16; ++r) pmax = fmaxf(pmax, p1[r]);
  { auto rr = __builtin_amdgcn_permlane32_swap(__float_as_uint(pmax), __float_as_uint(pmax), false, false);
    pmax = fmaxf(__uint_as_float(rr[0]), __uint_as_float(rr[1])); }
  if (__builtin_expect(__all(pmax - m_reg <= THRS), 1)) { mn = m_reg; alpha = 1.f; }
  else { mn = fmaxf(m_reg, pmax); alpha = __builtin_amdgcn_exp2f((m_reg - mn) * C); m_reg = mn; }
  const float mnC = -mn * C;
#pragma unroll
  for (int r = 0; r < 16; ++r) p0[r] = fmaf(p0[r], C, mnC);
#pragma unroll
  for (int r = 0; r < 16; ++r) p1[r] = fmaf(p1[r], C, mnC);
#pragma unroll
  for (int r = 0; r < 16; ++r) p0[r] = __builtin_amdgcn_exp2f(p0[r]);
}
__device__ __forceinline__ void finishSM(f32x16& p0, f32x16& p1, float alpha, float& l_reg, bf16x8& pa0, bf16x8& pa1, bf16x8& pa2, bf16x8& pa3) {
#pragma unroll
  for (int r = 0; r < 16; ++r) p1[r] = __builtin_amdgcn_exp2f(p1[r]);
  float ps = 0;
#pragma unroll
  for (int r = 0; r < 16; ++r) ps += p0[r];
#pragma unroll
  for (int r = 0; r < 16; ++r) ps += p1[r];
  { auto rr = __builtin_amdgcn_permlane32_swap(__float_as_uint(ps), __float_as_uint(ps), false, false);
    ps = __uint_as_float(rr[0]) + __uint_as_float(rr[1]); }
  l_reg = l_reg * alpha + ps;
#define PK4(P, BASE, OUT) do { unsigned a0 = cvtpkv(P[BASE + 0], P[BASE + 1]), a1 = cvtpkv(P[BASE + 2], P[BASE + 3]);   \
    unsigned b0 = cvtpkv(P[BASE + 4], P[BASE + 5]), b1 = cvtpkv(P[BASE + 6], P[BASE + 7]);                              \
    auto r0 = __builtin_amdgcn_permlane32_swap(a0, b0, false, false); auto r1 = __builtin_amdgcn_permlane32_swap(a1, b1, false, false); \
    u32x4 w = {r0[0], r1[0], r0[1], r1[1]}; OUT = *reinterpret_cast<bf16x8*>(&w); } while (0)
  PK4(p0, 0, pa0); PK4(p0, 8, pa1); PK4(p1, 0, pa2); PK4(p1, 8, pa3);
#undef PK4
}
__device__ __forceinline__ void partialSM_lean(f32x16& p0, f32x16& p1, f32x16& nm, float& alpha, const bool first) {
  constexpr float THR2 = 11.541560327111707f;
  float dmax = p0[0];
#pragma unroll
  for (int r = 1; r < 16; ++r) dmax = fmaxf(dmax, p0[r]);
#pragma unroll
  for (int r = 0; r < 16; ++r) dmax = fmaxf(dmax, p1[r]);
  { auto rr = __builtin_amdgcn_permlane32_swap(__float_as_uint(dmax), __float_as_uint(dmax), false, false);
    dmax = fmaxf(__uint_as_float(rr[0]), __uint_as_float(rr[1])); }
  alpha = 1.f;
  if (first || !__all(dmax <= THR2)) {
    const float delta = first ? dmax : (dmax > THR2 ? dmax : 0.f);
    if (!first) alpha = __builtin_amdgcn_exp2f(-delta);
#pragma unroll
    for (int r = 0; r < 16; ++r) { p0[r] -= delta; p1[r] -= delta; nm[r] -= delta; }
  }
#pragma unroll
  for (int r = 0; r < 16; ++r) p0[r] = __builtin_amdgcn_exp2f(p0[r]);
}
__device__ __forceinline__ void finishSM_lean(f32x16& p0, f32x16& p1, bf16x8& pa0, bf16x8& pa1, bf16x8& pa2, bf16x8& pa3) {
#pragma unroll
  for (int r = 0; r < 16; ++r) p1[r] = __builtin_amdgcn_exp2f(p1[r]);
#define PK4(P, BASE, OUT) do { unsigned a0 = cvtpkv(P[BASE + 0], P[BASE + 1]), a1 = cvtpkv(P[BASE + 2], P[BASE + 3]);   \
    unsigned b0 = cvtpkv(P[BASE + 4], P[BASE + 5]), b1 = cvtpkv(P[BASE + 6], P[BASE + 7]);                              \
    auto r0 = __builtin_amdgcn_permlane32_swap(a0, b0, false, false); auto r1 = __builtin_amdgcn_permlane32_swap(a1, b1, false, false); \
    u32x4 w = {r0[0], r1[0], r0[1], r1[1]}; OUT = *reinterpret_cast<bf16x8*>(&w); } while (0)
  PK4(p0, 0, pa0); PK4(p0, 8, pa1); PK4(p1, 0, pa2); PK4(p1, 8, pa3);
#undef PK4
}
__device__ __forceinline__ bf16x8 scale_bf16x8(bf16x8 v, float c) {
  const u32x4 w = *reinterpret_cast<u32x4*>(&v); u32x4 o;
  o.x = cvtpk(bflo(w.x) * c, bfhi(w.x) * c); o.y = cvtpk(bflo(w.y) * c, bfhi(w.y) * c); o.z = cvtpk(bflo(w.z) * c, bfhi(w.z) * c); o.w = cvtpk(bflo(w.w) * c, bfhi(w.w) * c);
  return *reinterpret_cast<bf16x8*>(&o);
}
template <int PITCH> __device__ __forceinline__ int kswz(int r) { return PITCH == 256 ? (r & 15) : ((r >> 1) & 7); }
template <int NQF, int NQR, int PITCH> __device__ __forceinline__ void qkt(f32x16& p0, f32x16& p1, const LAS char* Ks, int chunk0, const bf16x8* qr, const LAS char* ql, int r32, int hi, const f32x16 init = f32x16{}) {
  p0 = init; p1 = init;
  const int sw = kswz<PITCH>(r32);
#pragma unroll
  for (int d0 = 0; d0 < NQF; ++d0) { const int off = ((chunk0 + d0 * 2 + hi) ^ sw) * 16;
    const bf16x8 b0 = *(const LAS bf16x8*)(Ks + r32 * PITCH + off);
    const bf16x8 b1 = *(const LAS bf16x8*)(Ks + (32 + r32) * PITCH + off);
    const bf16x8 q = d0 < NQR ? qr[d0 < NQR ? d0 : 0] : *(const LAS bf16x8*)(ql + (d0 - NQR < 0 ? 0 : d0 - NQR) * 1024);
    p0 = __builtin_amdgcn_mfma_f32_32x32x16_bf16(b0, q, p0, 0, 0, 0);
    p1 = __builtin_amdgcn_mfma_f32_32x32x16_bf16(b1, q, p1, 0, 0, 0); }
}
__device__ __forceinline__ int v_st(int k, int c) { const int kk = (k & ~0xC) | ((k & 4) << 1) | ((k & 8) >> 1); return ((kk >> 3) * 4 + (c >> 5)) * 512 + ((kk & 7) * 32 + (c & 31)) * 2; }
__device__ __forceinline__ int v_rd_base(int lane) { return ((lane & 3) << 3) | (((lane >> 2) & 3) << 6) | (((lane >> 4) & 1) << 5) | (((lane >> 5) & 1) << 8); }
constexpr int v_rd_off(int d0, int ks, int half) { return d0 * 512 + ks * 4096 + half * 2048; }
template <int OFF> __device__ __forceinline__ s16x4 tr_read(int vb) {
  s16x4 r; asm volatile("ds_read_b64_tr_b16 %0, %1 offset:%2" : "=&v"(r) : "v"(vb), "i"(OFF) : "memory"); return r;
}
template <int D0> __device__ __forceinline__ void pv_one(f32x16& od, int vb, bf16x8 pa0, bf16x8 pa1, bf16x8 pa2, bf16x8 pa3) {
  const s16x4 l0 = tr_read<v_rd_off(D0, 0, 0)>(vb), h0 = tr_read<v_rd_off(D0, 0, 1)>(vb), l1 = tr_read<v_rd_off(D0, 1, 0)>(vb), h1 = tr_read<v_rd_off(D0, 1, 1)>(vb);
  const s16x4 l2 = tr_read<v_rd_off(D0, 2, 0)>(vb), h2 = tr_read<v_rd_off(D0, 2, 1)>(vb), l3 = tr_read<v_rd_off(D0, 3, 0)>(vb), h3 = tr_read<v_rd_off(D0, 3, 1)>(vb);
  asm volatile("s_waitcnt lgkmcnt(0)" ::: "memory"); SBAR();
#define PK(L, H) (bf16x8){L[0], L[1], L[2], L[3], H[0], H[1], H[2], H[3]}
  od = __builtin_amdgcn_mfma_f32_32x32x16_bf16(pa0, PK(l0, h0), od, 0, 0, 0);
  od = __builtin_amdgcn_mfma_f32_32x32x16_bf16(pa1, PK(l1, h1), od, 0, 0, 0);
  od = __builtin_amdgcn_mfma_f32_32x32x16_bf16(pa2, PK(l2, h2), od, 0, 0, 0);
  od = __builtin_amdgcn_mfma_f32_32x32x16_bf16(pa3, PK(l3, h3), od, 0, 0, 0);
#undef PK
}
__device__ __forceinline__ void pv_d0(f32x16* o, int vb, bf16x8 pa0, bf16x8 pa1, bf16x8 pa2, bf16x8 pa3) {
  pv_one<0>(o[0], vb, pa0, pa1, pa2, pa3); pv_one<1>(o[1], vb, pa0, pa1, pa2, pa3); pv_one<2>(o[2], vb, pa0, pa1, pa2, pa3); pv_one<3>(o[3], vb, pa0, pa1, pa2, pa3);
}
struct VFrag { s16x4 l0, h0, l1, h1, l2, h2, l3, h3; };
typedef short v4i16_t __attribute__((ext_vector_type(4)));
template <int OFF> __device__ __forceinline__ s16x4 tr_read_b(int vb) {
  return __builtin_bit_cast(s16x4, __builtin_amdgcn_ds_read_tr16_b64_v4i16((LAS v4i16_t*)(uintptr_t)(unsigned)(vb + OFF)));
}
template <int D0> __device__ __forceinline__ void tr8b(VFrag& f, int vb) {
  f.l0 = tr_read_b<v_rd_off(D0, 0, 0)>(vb); f.h0 = tr_read_b<v_rd_off(D0, 0, 1)>(vb); f.l1 = tr_read_b<v_rd_off(D0, 1, 0)>(vb); f.h1 = tr_read_b<v_rd_off(D0, 1, 1)>(vb);
  f.l2 = tr_read_b<v_rd_off(D0, 2, 0)>(vb); f.h2 = tr_read_b<v_rd_off(D0, 2, 1)>(vb); f.l3 = tr_read_b<v_rd_off(D0, 3, 0)>(vb); f.h3 = tr_read_b<v_rd_off(D0, 3, 1)>(vb);
}
template <int D0> __device__ __forceinline__ void tr8(VFrag& f, int vb) {
  f.l0 = tr_read<v_rd_off(D0, 0, 0)>(vb); f.h0 = tr_read<v_rd_off(D0, 0, 1)>(vb); f.l1 = tr_read<v_rd_off(D0, 1, 0)>(vb); f.h1 = tr_read<v_rd_off(D0, 1, 1)>(vb);
  f.l2 = tr_read<v_rd_off(D0, 2, 0)>(vb); f.h2 = tr_read<v_rd_off(D0, 2, 1)>(vb); f.l3 = tr_read<v_rd_off(D0, 3, 0)>(vb); f.h3 = tr_read<v_rd_off(D0, 3, 1)>(vb);
}
__device__ __forceinline__ void mfma4(f32x16& od, VFrag& f, bf16x8 pa0, bf16x8 pa1, bf16x8 pa2, bf16x8 pa3) {
#define PK(L, H) (bf16x8){L[0], L[1], L[2], L[3], H[0], H[1], H[2], H[3]}
  od = __builtin_amdgcn_mfma_f32_32x32x16_bf16(pa0, PK(f.l0, f.h0), od, 0, 0, 0);
  od = __builtin_amdgcn_mfma_f32_32x32x16_bf16(pa1, PK(f.l1, f.h1), od, 0, 0, 0);
  od = __builtin_amdgcn_mfma_f32_32x32x16_bf16(pa2, PK(f.l2, f.h2), od, 0, 0, 0);
  od = __builtin_amdgcn_mfma_f32_32x32x16_bf16(pa3, PK(f.l3, f.h3), od, 0, 0, 0);
#undef PK
}
#define VF_TIE(f) "+v"(f.l0), "+v"(f.h0), "+v"(f.l1), "+v"(f.h1), "+v"(f.l2), "+v"(f.h2), "+v"(f.l3), "+v"(f.h3)
__device__ __forceinline__ void pv_pipe(f32x16* o, int vb, bf16x8 pa0, bf16x8 pa1, bf16x8 pa2, bf16x8 pa3) {
  VFrag A, B;
  asm volatile("s_waitcnt lgkmcnt(0)" ::: "memory");
  tr8<0>(A, vb); tr8<1>(B, vb);
  asm volatile("s_waitcnt lgkmcnt(8)" : VF_TIE(A) :: "memory");
  mfma4(o[0], A, pa0, pa1, pa2, pa3);
  tr8<2>(A, vb);
  asm volatile("s_waitcnt lgkmcnt(8)" : VF_TIE(B) :: "memory");
  mfma4(o[1], B, pa0, pa1, pa2, pa3);
  tr8<3>(B, vb);
  asm volatile("s_waitcnt lgkmcnt(8)" : VF_TIE(A) :: "memory");
  mfma4(o[2], A, pa0, pa1, pa2, pa3);
  asm volatile("s_waitcnt lgkmcnt(0)" : VF_TIE(B) :: "memory");
  mfma4(o[3], B, pa0, pa1, pa2, pa3);
}
__device__ __forceinline__ void pv_psm_lean(f32x16* o, int vb, bf16x8 pa0, bf16x8 pa1, bf16x8 pa2, bf16x8 pa3, f32x16& p0, f32x16& p1, f32x16& nm, float& alpha) {
  constexpr float THR2 = 11.541560327111707f;
  const bf16x8 one8 = {0x3F80, 0x3F80, 0x3F80, 0x3F80, 0x3F80, 0x3F80, 0x3F80, 0x3F80};
  VFrag A, B;
  asm volatile("s_waitcnt lgkmcnt(0)" ::: "memory");
  tr8<0>(A, vb); tr8<1>(B, vb);
  asm volatile("s_waitcnt lgkmcnt(8)" : VF_TIE(A) :: "memory");
  mfma4(o[0], A, pa0, pa1, pa2, pa3);
  float dmax = p0[0];
#pragma unroll
  for (int r = 1; r < 16; ++r) dmax = fmaxf(dmax, p0[r]);
  tr8<2>(A, vb);
  asm volatile("s_waitcnt lgkmcnt(8)" : VF_TIE(B) :: "memory");
  mfma4(o[1], B, pa0, pa1, pa2, pa3);
#pragma unroll
  for (int r = 0; r < 16; ++r) dmax = fmaxf(dmax, p1[r]);
  { auto rr = __builtin_amdgcn_permlane32_swap(__float_as_uint(dmax), __float_as_uint(dmax), false, false);
    dmax = fmaxf(__uint_as_float(rr[0]), __uint_as_float(rr[1])); }
  alpha = 1.f;
  if (!__all(dmax <= THR2)) {
    const float delta = dmax > THR2 ? dmax : 0.f; alpha = __builtin_amdgcn_exp2f(-delta);
#pragma unroll
    for (int r = 0; r < 16; ++r) { p0[r] -= delta; p1[r] -= delta; nm[r] -= delta; }
  }
  tr8<3>(B, vb);
  asm volatile("s_waitcnt lgkmcnt(8)" : VF_TIE(A) :: "memory");
  mfma4(o[2], A, pa0, pa1, pa2, pa3);
#pragma unroll
  for (int r = 0; r < 8; ++r) p0[r] = __builtin_amdgcn_exp2f(p0[r]);
  asm volatile("s_waitcnt lgkmcnt(0)" : VF_TIE(B) :: "memory");
  mfma4(o[3], B, pa0, pa1, pa2, pa3);
#pragma unroll
  for (int r = 8; r < 16; ++r) p0[r] = __builtin_amdgcn_exp2f(p0[r]);
  o[4] = __builtin_amdgcn_mfma_f32_32x32x16_bf16(pa0, one8, o[4], 0, 0, 0); o[4] = __builtin_amdgcn_mfma_f32_32x32x16_bf16(pa1, one8, o[4], 0, 0, 0);
  o[4] = __builtin_amdgcn_mfma_f32_32x32x16_bf16(pa2, one8, o[4], 0, 0, 0); o[4] = __builtin_amdgcn_mfma_f32_32x32x16_bf16(pa3, one8, o[4], 0, 0, 0);
}
__device__ __forceinline__ void pv_psm_lean_b(f32x16* o, int vb, bf16x8 pa0, bf16x8 pa1, bf16x8 pa2, bf16x8 pa3, f32x16& p0, f32x16& p1, f32x16& nm, float& alpha) {
  constexpr float THR2 = 11.541560327111707f;
  const bf16x8 one8 = {0x3F80, 0x3F80, 0x3F80, 0x3F80, 0x3F80, 0x3F80, 0x3F80, 0x3F80};
  VFrag A, B;
  tr8b<0>(A, vb); tr8b<1>(B, vb);
  mfma4(o[0], A, pa0, pa1, pa2, pa3);
  float dmax = p0[0];
#pragma unroll
  for (int r = 1; r < 16; ++r) dmax = fmaxf(dmax, p0[r]);
  tr8b<2>(A, vb);
  mfma4(o[1], B, pa0, pa1, pa2, pa3);
#pragma unroll
  for (int r = 0; r < 16; ++r) dmax = fmaxf(dmax, p1[r]);
  { auto rr = __builtin_amdgcn_permlane32_swap(__float_as_uint(dmax), __float_as_uint(dmax), false, false);
    dmax = fmaxf(__uint_as_float(rr[0]), __uint_as_float(rr[1])); }
  alpha = 1.f;
  if (!__all(dmax <= THR2)) {
    const float delta = dmax > THR2 ? dmax : 0.f; alpha = __builtin_amdgcn_exp2f(-delta);
#pragma unroll
    for (int r = 0; r < 16; ++r) { p0[r] -= delta; p1[r] -= delta; nm[r] -= delta; }
  }
  tr8b<3>(B, vb);
  mfma4(o[2], A, pa0, pa1, pa2, pa3);
#pragma unroll
  for (int r = 0; r < 8; ++r) p0[r] = __builtin_amdgcn_exp2f(p0[r]);
  mfma4(o[3], B, pa0, pa1, pa2, pa3);
#pragma unroll
  for (int r = 8; r < 16; ++r) p0[r] = __builtin_amdgcn_exp2f(p0[r]);
  o[4] = __builtin_amdgcn_mfma_f32_32x32x16_bf16(pa0, one8, o[4], 0, 0, 0); o[4] = __builtin_amdgcn_mfma_f32_32x32x16_bf16(pa1, one8, o[4], 0, 0, 0);
  o[4] = __builtin_amdgcn_mfma_f32_32x32x16_bf16(pa2, one8, o[4], 0, 0, 0); o[4] = __builtin_amdgcn_mfma_f32_32x32x16_bf16(pa3, one8, o[4], 0, 0, 0);
}
struct VStep { s16x4 l0, h0, l1, h1, l2, h2, l3, h3; };
template <int KS> __device__ __forceinline__ void trstep(VStep& f, int vb) {
  f.l0 = tr_read_b<v_rd_off(0, KS, 0)>(vb); f.h0 = tr_read_b<v_rd_off(0, KS, 1)>(vb); f.l1 = tr_read_b<v_rd_off(1, KS, 0)>(vb); f.h1 = tr_read_b<v_rd_off(1, KS, 1)>(vb);
  f.l2 = tr_read_b<v_rd_off(2, KS, 0)>(vb); f.h2 = tr_read_b<v_rd_off(2, KS, 1)>(vb); f.l3 = tr_read_b<v_rd_off(3, KS, 0)>(vb); f.h3 = tr_read_b<v_rd_off(3, KS, 1)>(vb);
}
__device__ __forceinline__ void mfma5(f32x16* o, const VStep& f, bf16x8 pa) {
  const bf16x8 one8 = {0x3F80, 0x3F80, 0x3F80, 0x3F80, 0x3F80, 0x3F80, 0x3F80, 0x3F80};
#define PK(L, H) (bf16x8){L[0], L[1], L[2], L[3], H[0], H[1], H[2], H[3]}
  o[0] = __builtin_amdgcn_mfma_f32_32x32x16_bf16(pa, PK(f.l0, f.h0), o[0], 0, 0, 0);
  o[1] = __builtin_amdgcn_mfma_f32_32x32x16_bf16(pa, PK(f.l1, f.h1), o[1], 0, 0, 0);
  o[2] = __builtin_amdgcn_mfma_f32_32x32x16_bf16(pa, PK(f.l2, f.h2), o[2], 0, 0, 0);
  o[3] = __builtin_amdgcn_mfma_f32_32x32x16_bf16(pa, PK(f.l3, f.h3), o[3], 0, 0, 0);
  o[4] = __builtin_amdgcn_mfma_f32_32x32x16_bf16(pa, one8, o[4], 0, 0, 0);
#undef PK
}
template <int BASE> __device__ __forceinline__ bf16x8 pk4e(const f32x16& P) {
  const float e0 = __builtin_amdgcn_exp2f(P[BASE + 0]), e1 = __builtin_amdgcn_exp2f(P[BASE + 1]), e2 = __builtin_amdgcn_exp2f(P[BASE + 2]), e3 = __builtin_amdgcn_exp2f(P[BASE + 3]);
  const float e4 = __builtin_amdgcn_exp2f(P[BASE + 4]), e5 = __builtin_amdgcn_exp2f(P[BASE + 5]), e6 = __builtin_amdgcn_exp2f(P[BASE + 6]), e7 = __builtin_amdgcn_exp2f(P[BASE + 7]);
  const unsigned a0 = cvtpk(e0, e1), a1 = cvtpk(e2, e3), b0 = cvtpk(e4, e5), b1 = cvtpk(e6, e7);
  const auto r0 = __builtin_amdgcn_permlane32_swap(a0, b0, false, false); const auto r1 = __builtin_amdgcn_permlane32_swap(a1, b1, false, false);
  u32x4 w = {r0[0], r1[0], r0[1], r1[1]}; return *reinterpret_cast<bf16x8*>(&w);
}
__device__ __forceinline__ float rowmax_lean(const f32x16& p0, const f32x16& p1) {
  float d = p0[0];
#pragma unroll
  for (int r = 1; r < 16; ++r) d = fmaxf(d, p0[r]);
#pragma unroll
  for (int r = 0; r < 16; ++r) d = fmaxf(d, p1[r]);
  const auto rr = __builtin_amdgcn_permlane32_swap(__float_as_uint(d), __float_as_uint(d), false, false);
  return fmaxf(__uint_as_float(rr[0]), __uint_as_float(rr[1]));
}
__device__ __forceinline__ void shift_lean(float dmax, f32x16& p0, f32x16& p1, f32x16& nm, float& alpha, const bool first) {
  constexpr float THR2 = 11.541560327111707f;
  alpha = 1.f;
  if (first || !__all(dmax <= THR2)) {
    const float delta = first ? dmax : (dmax > THR2 ? dmax : 0.f);
    if (!first) alpha = __builtin_amdgcn_exp2f(-delta);
#pragma unroll
    for (int r = 0; r < 16; ++r) { p0[r] -= delta; p1[r] -= delta; nm[r] -= delta; }
  }
}
#define SGB(mask, n) __builtin_amdgcn_sched_group_barrier((mask), (n), 0)
__device__ __forceinline__ bf16x8 ld8(const bf16* p) { return *reinterpret_cast<const bf16x8*>(p); }

template <int MODE, int ATTV = 0>
__device__ __forceinline__ void attn_unit(const bf16* __restrict__ Qrow0, int ldq, const bf16* __restrict__ Kb, const bf16* __restrict__ Vb, int ldk, const bf16* __restrict__ KRb,
                                          int b, int nct, int NT, bf16* __restrict__ Ob, float lam, const float* __restrict__ subln, float oscale, LAS unsigned char* lds_, const int tid_in) {
  constexpr bool LEAN = (MODE == 1) && ATT_LEAN; constexpr int NQF = MODE == 0 ? 12 : 4, NQR = MODE == 0 ? 4 : 0, NOB = LEAN ? 5 : 4, PITCH = MODE == 0 ? 384 : 256, SHM_V = 16384, SHM_K = 64 * PITCH, SDEPTH = ATT_SDEPTH(MODE); constexpr bool PVPIPE = ATT_PVPIPE(MODE);
  const float SCALE = MODE == 0 ? 0.07216878364870323f : 0.125f;
  const float C = SCALE * 1.4426950408889634f, THRS = 8.f / SCALE;
  if (ATT_PRIO) { if (__builtin_amdgcn_readfirstlane(tid_in >> 8) != 0) __builtin_amdgcn_s_setprio(1); }
  const int tid = launder_v(tid_in) & 511, wid = tid >> 6, lane = tid & 63, r32 = lane & 31, hi = lane >> 5;
  LAS char* lds = (LAS char*)(LAS unsigned char*)lds_;
  constexpr bool THREE = (MODE == 1) && ATT_3STAGE; constexpr int NSTG = THREE ? 3 : 2, STG = SHM_V + SHM_K, SCR0 = NSTG * STG;
#define VOFF(s) (!THREE ? (s) * SHM_V : (s) * STG)
#define KOFF(s) (!THREE ? 2 * SHM_V + (s) * SHM_K : (s) * STG + SHM_V)
  LAS char* V_lds = lds; LAS char* K_lds = lds;
  LAS float* wsf = (LAS float*)(lds + NSTG * (SHM_V + SHM_K)) + wid * 64; LAS float* li_l = wsf; LAS float* al_l = wsf + 32;
  const int wq = MODE == 0 ? wid : (wid & 3), sgrp = MODE == 0 ? 0 : (wid >> 2);
  float m_reg = -1e30f, l_reg = 0; f32x16 o[NOB] = {}; bf16x8 qr[NQR > 0 ? NQR : 1]; f32x16 nm = {};
  LAS char* ql = lds + SCR0 + 2048 + wid * (MODE == 0 ? 8192 : 4096) + lane * 16;
  const bf16* Qw = Qrow0 + (size_t)(wq * 32 + r32) * ldq + sgrp * 64 + hi * 8;
#pragma unroll
  for (int d0 = 0; d0 < NQR; ++d0) qr[d0] = ld8(Qw + d0 * 16);
#pragma unroll
  for (int d0 = NQR; d0 < NQF; ++d0) { bf16x8 qv = ld8(Qw + d0 * 16); if (LEAN) qv = scale_bf16x8(qv, C); *(LAS bf16x8*)(ql + (d0 - NQR) * 1024) = qv; }
  const int sr = tid >> 4, sc = (tid & 15) * 8, vst0 = v_st(sr, sc), vst1 = v_st(32 + sr, sc);
  const int kst0 = sr * PITCH + (((tid & 15) ^ kswz<PITCH>(sr)) * 16), kst1 = kst0 + 32 * PITCH;
  const int rrow = tid >> 3, krs = rrow * PITCH + (((16 + (tid & 7)) ^ kswz<PITCH>(rrow)) * 16);
  const int chunk0 = sgrp * 8;
  const int vb0 = (int)(uintptr_t)V_lds + v_rd_base(lane);
  struct Slot { bf16x8 vs0, vs1, ks0, ks1, kr; } sr_[SDEPTH];
#define KROW(jt) ((jt) < nct ? (ML + b * CTXL + (jt) * 64) : (b * SEQ + ((jt) - nct) * 64))
#define SLOAD(i, jt) do { const int k0_ = KROW(jt); sr_[i].vs0 = ld8(Vb + (size_t)(k0_ + sr) * ldk + sc); sr_[i].vs1 = ld8(Vb + (size_t)(k0_ + 32 + sr) * ldk + sc); \
    sr_[i].ks0 = ld8(Kb + (size_t)(k0_ + sr) * ldk + sc); sr_[i].ks1 = ld8(Kb + (size_t)(k0_ + 32 + sr) * ldk + sc); \
    if (MODE == 0) sr_[i].kr = ld8(KRb + (size_t)(k0_ + rrow) * 64 + (tid & 7) * 8); } while (0)
#define SWRITE(bf, i) do { *(LAS bf16x8*)(V_lds + VOFF(bf) + vst0) = sr_[i].vs0; *(LAS bf16x8*)(V_lds + VOFF(bf) + vst1) = sr_[i].vs1; \
    *(LAS bf16x8*)(K_lds + KOFF(bf) + kst0) = sr_[i].ks0; *(LAS bf16x8*)(K_lds + KOFF(bf) + kst1) = sr_[i].ks1; \
    if (MODE == 0) *(LAS bf16x8*)(K_lds + KOFF(bf) + krs) = sr_[i].kr; } while (0)
#define SWAIT() do { if constexpr (SDEPTH == 2) asm volatile("s_waitcnt vmcnt(4)" ::: "memory"); else asm volatile("s_waitcnt vmcnt(0)" ::: "memory"); } while (0)
#define RESC(a) do { if (__any((a) < 1.f)) { if (hi == 0) al_l[r32] = (a); asm volatile("s_waitcnt lgkmcnt(0)" ::: "memory"); \
    _Pragma("unroll") for (int d = 0; d < NOB; ++d) _Pragma("unroll") for (int r = 0; r < 16; ++r) o[d][r] *= al_l[crow(r, hi)]; } } while (0)
#define PV(vb_) do { if constexpr (ATTV == 2) { o[0][0] += __uint_as_float((unsigned)pa0[0] + (unsigned)pa3[1]); } else if constexpr (PVPIPE) pv_pipe(o, (vb_), pa0, pa1, pa2, pa3); else pv_d0(o, (vb_), pa0, pa1, pa2, pa3); \
    if constexpr (LEAN) { const bf16x8 one8 = {0x3F80, 0x3F80, 0x3F80, 0x3F80, 0x3F80, 0x3F80, 0x3F80, 0x3F80};     \
        o[NOB - 1] = __builtin_amdgcn_mfma_f32_32x32x16_bf16(pa0, one8, o[NOB - 1], 0, 0, 0); o[NOB - 1] = __builtin_amdgcn_mfma_f32_32x32x16_bf16(pa1, one8, o[NOB - 1], 0, 0, 0); \
        o[NOB - 1] = __builtin_amdgcn_mfma_f32_32x32x16_bf16(pa2, one8, o[NOB - 1], 0, 0, 0); o[NOB - 1] = __builtin_amdgcn_mfma_f32_32x32x16_bf16(pa3, one8, o[NOB - 1], 0, 0, 0); } } while (0)
#define PSM(p0_, p1_, mn_, al_, first_) do { if constexpr (ATTV == 1) { al_ = 1.f; } else if constexpr (LEAN) partialSM_lean(p0_, p1_, nm, al_, first_); else partialSM(p0_, p1_, m_reg, mn_, al_, C, THRS); } while (0)
#define FSM(p0_, p1_, al_) do { if constexpr (ATTV == 1) { u32x4 w0_ = {__float_as_uint(p0_[0]), __float_as_uint(p0_[1]), __float_as_uint(p1_[0]), __float_as_uint(p1_[1])}; pa0 = pa1 = pa2 = pa3 = *reinterpret_cast<bf16x8*>(&w0_); } else if constexpr (LEAN) finishSM_lean(p0_, p1_, pa0, pa1, pa2, pa3); else finishSM(p0_, p1_, al_, l_reg, pa0, pa1, pa2, pa3); } while (0)
#define QKT(p0_, p1_, Kp_) do { if constexpr (ATTV == 5) { p0_ = nm; p1_ = nm; p0_[0] += (float)r32; } else if constexpr (LEAN) qkt<NQF, NQR, PITCH>(p0_, p1_, Kp_, chunk0, qr, ql, r32, hi, nm); else qkt<NQF, NQR, PITCH>(p0_, p1_, Kp_, chunk0, qr, ql, r32, hi); } while (0)
  f32x16 pA0, pA1, pB0, pB1; float mnA, mnB, alA, alB; bf16x8 pa0, pa1, pa2, pa3;
  constexpr bool KMAJ = (MODE == 1) && LEAN && ATT_KMAJOR && (ATTV == 0) && !THREE;
  if constexpr (KMAJ) {
    VStep VA, VB;
#define KSTEPS(PC0, PC1, ALC, PP0, PP1, KC, VP, LD, DOQK) do { const int vb_ = vb0 + VOFF(VP); float dmx_ = 0.f; \
      SBAR(); \
      if (DOQK) QKT(PC0, PC1, K_lds + KOFF(KC)); \
      pa0 = pk4e<0>(PP0); trstep<0>(VA, vb_); \
      _Pragma("unroll") for (int i_ = 0; i_ < 8; ++i_) { SGB(0x008, 1); SGB(0x100, 3); SGB(0x002, 2); } \
      SBAR(); LD; SBAR(); \
      mfma5(o, VA, pa0); pa1 = pk4e<8>(PP0); trstep<1>(VB, vb_); \
      _Pragma("unroll") for (int i_ = 0; i_ < 5; ++i_) { SGB(0x008, 1); SGB(0x100, 2); SGB(0x002, 3); } \
      SBAR(); \
      mfma5(o, VB, pa1); pa2 = pk4e<0>(PP1); trstep<2>(VA, vb_); \
      _Pragma("unroll") for (int i_ = 0; i_ < 5; ++i_) { SGB(0x008, 1); SGB(0x100, 2); SGB(0x002, 3); } \
      SBAR(); \
      mfma5(o, VA, pa2); pa3 = pk4e<8>(PP1); trstep<3>(VB, vb_); \
      _Pragma("unroll") for (int i_ = 0; i_ < 5; ++i_) { SGB(0x008, 1); SGB(0x100, 2); SGB(0x002, 3); } \
      SBAR(); \
      mfma5(o, VB, pa3); if (DOQK) dmx_ = rowmax_lean(PC0, PC1); \
      _Pragma("unroll") for (int i_ = 0; i_ < 5; ++i_) { SGB(0x008, 1); SGB(0x002, 7); } \
      SBAR(); \
      if (DOQK) shift_lean(dmx_, PC0, PC1, nm, ALC, false); } while (0)
    SLOAD(0, 0); asm volatile("s_waitcnt vmcnt(0)" ::: "memory"); SWRITE(0, 0); __syncthreads();
    QKT(pA0, pA1, K_lds + KOFF(0)); shift_lean(rowmax_lean(pA0, pA1), pA0, pA1, nm, alA, true);
    SLOAD(0, 1); asm volatile("s_waitcnt vmcnt(0)" ::: "memory"); SWRITE(1, 0); __syncthreads();
    for (int j = 1; j + 1 < NT; j += 2) {
      KSTEPS(pB0, pB1, alB, pA0, pA1, 1, 0, SLOAD(0, j + 1), true);
      __syncthreads(); asm volatile("s_waitcnt vmcnt(0)" ::: "memory"); SWRITE(0, 0);
      RESC(alB); __syncthreads();
      KSTEPS(pA0, pA1, alA, pB0, pB1, 0, 1, SLOAD(0, j + 2), true);
      __syncthreads(); asm volatile("s_waitcnt vmcnt(0)" ::: "memory"); SWRITE(1, 0);
      RESC(alA); __syncthreads();
    }
    KSTEPS(pB0, pB1, alB, pA0, pA1, 1, 0, (void)0, true);
    __syncthreads(); RESC(alB);
    KSTEPS(pA0, pA1, alA, pB0, pB1, 0, 1, (void)0, false);
#undef KSTEPS
  } else if constexpr (!THREE) {
  constexpr int SE = 0, SO = SDEPTH - 1;
  SLOAD(SE, 0); asm volatile("s_waitcnt vmcnt(0)" ::: "memory"); SWRITE(0, SE); __syncthreads();
  QKT(pA0, pA1, K_lds + KOFF(0)); PSM(pA0, pA1, mnA, alA, true);
  SLOAD(SO, 1); if constexpr (SDEPTH == 2) { if (2 < NT) SLOAD(SE, 2); }
  SWAIT(); SWRITE(1, SO); __syncthreads();
#define ILV() do { if constexpr (PVPIPE) { _Pragma("unroll") for (int i_ = 0; i_ < 20; ++i_) { __builtin_amdgcn_sched_group_barrier(0x008, 1, 0); __builtin_amdgcn_sched_group_barrier(0x002, 5, 0); } } } while (0)
#define LSLOAD(i, jt) do { if constexpr (ATTV != 3) SLOAD(i, jt); } while (0)
#define LSWRITE(bf, i) do { if constexpr (ATTV != 3) SWRITE(bf, i); } while (0)
#define LSWAIT() do { if constexpr (ATTV != 3) SWAIT(); } while (0)
#define LSYNC() do { if constexpr (ATTV != 4) __syncthreads(); } while (0)
#define HALFSTEP(PC0, PC1, MNC, ALC, PP0, PP1, ALP, KC, VP, LD) do { \
    if (!STAG || wid < 4) { \
      SBAR(); QKT(PC0, PC1, K_lds + KOFF(KC)); FSM(PP0, PP1, ALP); SBAR(); \
      LD; SBAR(); \
      if constexpr (PVPIPE && LEAN && ATTV == 0) { if constexpr (ATT_TRB) pv_psm_lean_b(o, vb0 + VOFF(VP), pa0, pa1, pa2, pa3, PC0, PC1, nm, ALC); else pv_psm_lean(o, vb0 + VOFF(VP), pa0, pa1, pa2, pa3, PC0, PC1, nm, ALC); } else { PV(vb0 + VOFF(VP)); PSM(PC0, PC1, MNC, ALC, false); } \
    } else { \
      SBAR(); FSM(PP0, PP1, ALP); SBAR(); \
      LD; SBAR(); \
      PV(vb0 + VOFF(VP)); SBAR(); \
      QKT(PC0, PC1, K_lds + KOFF(KC)); SBAR(); \
      PSM(PC0, PC1, MNC, ALC, false); \
    } } while (0)
  constexpr bool STAG = (MODE == 1) && ATT_STAGGER && ATTV == 0;
  for (int j = 1; j + 1 < NT; j += 2) {
    HALFSTEP(pB0, pB1, mnB, alB, pA0, pA1, alA, 1, 0, LSLOAD(SO, j + SDEPTH));
    LSYNC(); LSWAIT(); LSWRITE(0, SE);
    RESC(alB); LSYNC();
    HALFSTEP(pA0, pA1, mnA, alA, pB0, pB1, alB, 0, 1, if (SDEPTH == 1 || j + 3 < NT) LSLOAD(SE, j + 1 + SDEPTH));
    LSYNC(); LSWAIT(); LSWRITE(1, SO);
    RESC(alA); LSYNC();
  }
#undef HALFSTEP
#undef ILV
#undef LSLOAD
#undef LSWRITE
#undef LSWAIT
#undef LSYNC
  SBAR(); QKT(pB0, pB1, K_lds + KOFF(1));
  FSM(pA0, pA1, alA); SBAR();
  PV(vb0); PSM(pB0, pB1, mnB, alB, false);
  __syncthreads(); RESC(alB);
  FSM(pB0, pB1, alB); SBAR();
  PV(vb0 + VOFF(1));
  } else {
#define STEP(PC0, PC1, ALC, PP0, PP1, ALP, jj, SP, SC, SN) do { const int j_ = (jj); \
      if (j_ + 1 < NT) { asm volatile("s_waitcnt vmcnt(0)" ::: "memory"); SWRITE(SN, 0); if (j_ + 2 < NT) SLOAD(0, j_ + 2); } \
      SBAR(); QKT(PC0, PC1, K_lds + KOFF(SC)); FSM(PP0, PP1, ALP); SBAR(); \
      PV(vb0 + VOFF(SP)); PSM(PC0, PC1, mnA, ALC, false); \
      RESC(ALC); __syncthreads(); } while (0)
    SLOAD(0, 0); asm volatile("s_waitcnt vmcnt(0)" ::: "memory"); SWRITE(0, 0);
    SLOAD(0, 1); asm volatile("s_waitcnt vmcnt(0)" ::: "memory"); SWRITE(1, 0);
    SLOAD(0, 2); __syncthreads();
    QKT(pA0, pA1, K_lds + KOFF(0)); PSM(pA0, pA1, mnA, alA, true);
    STEP(pB0, pB1, alB, pA0, pA1, alA, 1, 0, 1, 2);
    int j = 2;
    for (; j + 5 < NT; j += 6) {
      STEP(pA0, pA1, alA, pB0, pB1, alB, j, 1, 2, 0);
      STEP(pB0, pB1, alB, pA0, pA1, alA, j + 1, 2, 0, 1);
      STEP(pA0, pA1, alA, pB0, pB1, alB, j + 2, 0, 1, 2);
      STEP(pB0, pB1, alB, pA0, pA1, alA, j + 3, 1, 2, 0);
      STEP(pA0, pA1, alA, pB0, pB1, alB, j + 4, 2, 0, 1);
      STEP(pB0, pB1, alB, pA0, pA1, alA, j + 5, 0, 1, 2);
    }
    if (j < NT) { STEP(pA0, pA1, alA, pB0, pB1, alB, j, 1, 2, 0); STEP(pB0, pB1, alB, pA0, pA1, alA, j + 1, 2, 0, 1); j += 2; }
    if (j < NT) { STEP(pA0, pA1, alA, pB0, pB1, alB, j, 0, 1, 2); STEP(pB0, pB1, alB, pA0, pA1, alA, j + 1, 1, 2, 0); j += 2; }
    FSM(pB0, pB1, alB); SBAR();
    { const int sl = (NT - 1) % 3; PV(vb0 + VOFF(sl)); }
#undef STEP
  }
  float rli[16];
  if constexpr (LEAN) {
#pragma unroll
    for (int r = 0; r < 16; ++r) rli[r] = __builtin_amdgcn_rcpf(o[NOB - 1][r]);
  } else {
    if (hi == 0) li_l[r32] = l_reg; asm volatile("s_waitcnt lgkmcnt(0)" ::: "memory");
#pragma unroll
    for (int r = 0; r < 16; ++r) rli[r] = __builtin_amdgcn_rcpf(li_l[crow(r, hi)]);
  }
  bf16* Ow = Ob + (size_t)(wq * 32) * DM;
  if constexpr (MODE == 0) {
#pragma unroll
    for (int r = 0; r < 16; ++r) { const int orow = crow(r, hi);
#pragma unroll
      for (int d0 = 0; d0 < 4; ++d0) Ow[(size_t)orow * DM + d0 * 32 + r32] = tobf1(o[d0][r] * rli[r]); }
    __syncthreads();
  } else {
    LAS float* ex = (LAS float*)lds;
    __syncthreads();
    if (sgrp == 1) {
#pragma unroll
      for (int r = 0; r < 16; ++r)
#pragma unroll
        for (int d0 = 0; d0 < 4; ++d0) ex[(wq * 32 + crow(r, hi)) * 128 + d0 * 32 + r32] = o[d0][r] * rli[r];
    }
    __syncthreads();
    if (sgrp == 0) {
#pragma unroll
      for (int r = 0; r < 16; ++r) { const int orow = crow(r, hi); float dd[4]; float ss = 0.f;
#pragma unroll
        for (int d0 = 0; d0 < 4; ++d0) { dd[d0] = o[d0][r] * rli[r] - lam * ex[(wq * 32 + orow) * 128 + d0 * 32 + r32]; ss += dd[d0] * dd[d0]; }
        ss = half_sum32(ss);
        const float rs = oscale / sqrtf(ss * (1.0f / 128.0f) + LN_EPS);
#pragma unroll
        for (int d0 = 0; d0 < 4; ++d0) Ow[(size_t)orow * DM + d0 * 32 + r32] = tobf1(dd[d0] * rs * subln[d0 * 32 + r32]); }
    }
    __syncthreads();
  }
  if (ATT_PRIO) __builtin_amdgcn_s_setprio(0);
#undef VOFF
#undef KOFF
#undef PV
#undef PSM
#undef FSM
#undef QKT
#undef KROW
#undef SLOAD
#undef SWRITE
#undef SWAIT
#undef RESC
}
}

__device__ __forceinline__ void mla_attn_phase(CP P, LAS unsigned char* lds, const int tid) {
    const bf16* QM = (const bf16*)(P->ws + WS_QM); const bf16* KV = (const bf16*)(P->ws + WS_KV); const bf16* KR = (const bf16*)(P->ws + WS_KR); bf16* Gb = (bf16*)(P->ws + WS_G);
    const int c = blockIdx.x, G = gridDim.x;
    for (int u = c; u < 1024 + 32; u += G) {
        int b, h, qrow0, NT;
        if (u < 1024) { const int i = u >> 8, cc = u & 255; const int bh = (cc & 7) + 8 * i, qb = cc >> 3; b = bh >> 4; h = bh & 15; qrow0 = b * SEQ + qb * 256; NT = 4 + 128; }
        else { const int bh = u - 1024; b = bh >> 4; h = bh & 15; qrow0 = ML + b * CTXL; NT = 4; }
        att::attn_unit<0>(QM + (size_t)qrow0 * 3072 + h * 192, 3072, KV + h * 256, KV + h * 256 + 128, 4096, KR, b, 4, NT, Gb + (size_t)qrow0 * DM + h * 128, 0.f, nullptr, 1.f, lds, tid);
    }
}
template <int ATTV = 0>
__device__ __forceinline__ void da_attn_phase(CP P, float lam, float oscale, LAS unsigned char* lds, const int tid, const bool ctx_q) {
    const bf16* Z = (const bf16*)(P->ws + WS_Z); bf16* Gb = (bf16*)(P->ws + WS_G); const float* subln = P->in[27];
    const int c = blockIdx.x, G = gridDim.x;
    for (int u = c; u < 2048 + (ctx_q ? 64 : 0); u += G) {
        int b, h, qrow0, NT;
        if (u < 2048) { const int i = u >> 8, cc = u & 255; const int bh = (cc & 7) + 8 * (i >> 1), qb = (cc >> 3) + 32 * (i & 1); b = bh >> 4; h = bh & 15; qrow0 = b * SEQ + qb * 128; NT = 4 + 128; }
        else { const int v = u - 2048; const int bh = v >> 1; b = bh >> 4; h = bh & 15; qrow0 = ML + b * CTXL + (v & 1) * 128; NT = 4; }
        att::attn_unit<1, ATTV>(Z + (size_t)qrow0 * 6144 + h * 128, 6144, Z + 2048 + h * 128, Z + 4096 + h * 128, 6144, nullptr, b, 4, NT, Gb + (size_t)qrow0 * DM + h * 128, lam, subln, oscale, lds, tid);
    }
}

__device__ __forceinline__ unsigned f2ord(float f) { const unsigned u = __float_as_uint(f); return u ^ ((unsigned)((int)u >> 31) | 0x80000000u); }
__device__ __forceinline__ float ord2f(unsigned k) { return __uint_as_float((k & 0x80000000u) ? (k ^ 0x80000000u) : ~k); }
__device__ __forceinline__ void ce_desc(unsigned& a, unsigned& b) { const unsigned mx = a > b ? a : b, mn = a > b ? b : a; a = mx; b = mn; }
template <int N, bool DESC> __device__ __forceinline__ void bitonic_merge(unsigned* a) {
#pragma unroll
    for (int j = N / 2; j > 0; j >>= 1)
#pragma unroll
        for (int i = 0; i < N; ++i) { const int l = i ^ j; if (l > i) { if (DESC) ce_desc(a[i], a[l]); else ce_desc(a[l], a[i]); } }
}
template <int N, bool DESC> __device__ __forceinline__ void bitonic_sort(unsigned* a) {
#pragma unroll
    for (int k = 2; k <= N; k <<= 1)
#pragma unroll
        for (int j = k >> 1; j > 0; j >>= 1)
#pragma unroll
            for (int i = 0; i < N; ++i) { const int l = i ^ j; if (l > i) { const bool up = ((i & k) == 0); if (up == DESC) ce_desc(a[i], a[l]); else ce_desc(a[l], a[i]); } }
}
__device__ __forceinline__ void top16_of_64(unsigned (&a)[64]) {
    bitonic_sort<16, true>(a); bitonic_sort<16, false>(a + 16); bitonic_sort<16, true>(a + 32); bitonic_sort<16, false>(a + 48);
#pragma unroll
    for (int i = 0; i < 16; ++i) a[i] = a[i] > a[16 + i] ? a[i] : a[16 + i];
    bitonic_merge<16, true>(a);
#pragma unroll
    for (int i = 0; i < 16; ++i) a[32 + i] = a[32 + i] > a[48 + i] ? a[32 + i] : a[48 + i];
    bitonic_merge<16, false>(a + 32);
#pragma unroll
    for (int i = 0; i < 16; ++i) a[i] = a[i] > a[32 + i] ? a[i] : a[32 + i];
    bitonic_merge<16, true>(a);
}
template <int PASS> __device__ __forceinline__ void route_pass(const bf16* QP, const LAS char* lds, int tok, int head, int r32, int hi, unsigned (&top)[16]) {
    f32x16 acc[4] = {};
    const bf16* qp = QP + (size_t)tok * DM + head * 256 + PASS * 128 + hi * 8;
    bf16x8 qf[8];
#pragma unroll
    for (int ks = 0; ks < 8; ++ks) qf[ks] = *(const bf16x8*)(qp + ks * 16);
    const LAS char* Kl = lds + PASS * 32768;
#pragma unroll
    for (int kb = 0; kb < 4; ++kb)
#pragma unroll
        for (int ks = 0; ks < 8; ++ks) { const bf16x8 a = *(const LAS bf16x8*)(Kl + (kb * 32 + r32) * 256 + (((ks * 2 + hi) ^ (r32 & 15)) * 16));
            acc[kb] = __builtin_amdgcn_mfma_f32_32x32x16_bf16(a, qf[ks], acc[kb], 0, 0, 0); }
    unsigned key[64]; const unsigned base = 127u - 4u * (unsigned)hi;
#pragma unroll
    for (int kb = 0; kb < 4; ++kb)
#pragma unroll
        for (int r = 0; r < 16; ++r) key[kb * 16 + r] = (f2ord(acc[kb][r]) & ~127u) | (base - (unsigned)(kb * 32 + (r & 3) + 8 * (r >> 2)));
    top16_of_64(key);
    unsigned pr[16];
#pragma unroll
    for (int i = 0; i < 16; ++i) pr[i] = lane_xor32(key[15 - i], hi << 5);
#pragma unroll
    for (int i = 0; i < 16; ++i) key[i] = key[i] > pr[i] ? key[i] : pr[i];
    bitonic_merge<16, true>(key);
#pragma unroll
    for (int i = 0; i < 16; ++i) top[i] = key[i];
}
#ifndef ROUTE_SORT
#define ROUTE_SORT 1
#endif
#define DPP_U(v, ctrl) ((unsigned)__builtin_amdgcn_mov_dpp((int)(v), (ctrl), 0xF, 0xF, true))
template <int J> __device__ __forceinline__ unsigned lane_xor_u(unsigned v, int lane) {
    if (J == 1) return DPP_U(v, 0xB1);
    if (J == 2) return DPP_U(v, 0x4E);
    if (J == 4) { const unsigned t = DPP_U(v, 0x141); return DPP_U(t, 0x1B); }
    if (J == 8) { const unsigned t = DPP_U(v, 0x140); return DPP_U(t, 0x141); }
    if (J == 16) { const auto r = __builtin_amdgcn_permlane16_swap(v, v, false, false); return (lane & 16) ? r[0] : r[1]; }
    return lane_xor32(v, lane);
}
template <int K, int J> __device__ __forceinline__ void sort128_stage(unsigned& a0, unsigned& a1, int lane) {
    if constexpr (J == 64) { const unsigned mn = a0 < a1 ? a0 : a1, mx = a0 < a1 ? a1 : a0; a0 = mn; a1 = mx; }
    else { const unsigned p0 = lane_xor_u<J>(a0, lane), p1 = lane_xor_u<J>(a1, lane);
        const bool lower = (lane & J) == 0;
        const bool asc0 = (K >= 64) ? true : ((lane & K) == 0), asc1 = (K == 128) ? true : (K == 64 ? false : ((lane & K) == 0));
        const unsigned mn0 = a0 < p0 ? a0 : p0, mx0 = a0 < p0 ? p0 : a0, mn1 = a1 < p1 ? a1 : p1, mx1 = a1 < p1 ? p1 : a1;
        a0 = (lower == asc0) ? mn0 : mx0; a1 = (lower == asc1) ? mn1 : mx1; }
    if constexpr (J > 1) sort128_stage<K, J / 2>(a0, a1, lane);
    else if constexpr (K < 128) sort128_stage<K * 2, K>(a0, a1, lane);
}
__device__ __forceinline__ void sort128_asc(unsigned& a0, unsigned& a1, int lane) { sort128_stage<2, 1>(a0, a1, lane); }
__device__ __forceinline__ void route_phase(CP P, int L, int Mrows, LAS unsigned char* lds_, int tid, int lane, int wid, int gw, int NGW) {
    const bf16* QP = (const bf16*)(P->ws + WS_QP); unsigned* ROUTE = (unsigned*)(P->ws + WS_ROUTE);
    LAS char* lds = (LAS char*)(LAS unsigned char*)lds_;
    __syncthreads();
    {
        const bf16* K1 = (const bf16*)(P->ws + WS_PK1) + (size_t)L * 128 * 128; const bf16* K2 = (const bf16*)(P->ws + WS_PK2) + (size_t)L * 128 * 128;
        for (int c16 = tid; c16 < 2 * 128 * 16; c16 += NWAVES * 64) { const int mat = c16 >> 11, row = (c16 >> 4) & 127, ch = c16 & 15;
            const u32x4 w = *(const u32x4*)((mat ? K2 : K1) + row * 128 + ch * 8);
            *(LAS u32x4*)(lds + mat * 32768 + row * 256 + ((ch ^ (row & 15)) * 16)) = w; }
    }
    __syncthreads();
    LAS unsigned* sc = (LAS unsigned*)(lds + 65536) + wid * 2048;
    const int r32 = lane & 31, hi = lane >> 5;
    for (int item = gw; item < Mrows / 4; item += NGW) {
        const int tok = item * 4 + (r32 >> 3), head = r32 & 7;
        unsigned top0[16], top1[16];
        route_pass<0>(QP, lds, tok, head, r32, hi, top0);
        route_pass<1>(QP, lds, tok, head, r32, hi, top1);
        float v1[16], v2[16];
#pragma unroll
        for (int i = 0; i < 16; ++i) { v1[i] = ord2f(top0[i] & ~127u); v2[i] = ord2f(top1[i] & ~127u);
            sc[i * 64 + lane] = 127u - (top0[i] & 127u); sc[(16 + i) * 64 + lane] = 127u - (top1[i] & 127u); }
        unsigned ck[64]; int n = 0;
#pragma unroll
        for (int i = 0; i < 16; ++i)
#pragma unroll
            for (int j = 0; j < 16; ++j) if ((i + 1) * (j + 1) <= 16) { ck[n] = (f2ord(v1[i] + v2[j]) & ~255u) | (unsigned)(i * 16 + j); ++n; }
#pragma unroll
        for (int i = 50; i < 64; ++i) ck[i] = 0u;
        top16_of_64(ck);
        float ev[16]; float sum = 0.f; const float mx = ord2f(ck[0] & ~255u);
#pragma unroll
        for (int k = 0; k < 16; ++k) { ev[k] = __expf(ord2f(ck[k] & ~255u) - mx); sum += ev[k]; }
        const float inv = 1.0f / sum;
        unsigned ee[16];
#pragma unroll
        for (int k = 0; k < 16; ++k) { const unsigned pc = ck[k] & 255u; const unsigned i1 = sc[(pc >> 4) * 64 + lane], i2 = sc[(16 + (pc & 15u)) * 64 + lane]; ee[k] = i1 * 128u + i2; ev[k] *= inv; }
#if ROUTE_SORT
        { const int tq = r32 >> 3;
#pragma unroll
          for (int k = 0; k < 8; ++k) {
              const unsigned eL = ee[k], eH = ee[k + 8]; const float gL = ev[k], gH = ev[k + 8];
              sc[tq * 256 + head * 16 + hi * 8 + k] = hi ? eH : eL; sc[tq * 256 + 128 + head * 16 + hi * 8 + k] = __float_as_uint(hi ? gH : gL); }
#pragma unroll 1
          for (int t = 0; t < 4; ++t) {
              unsigned a0 = (sc[t * 256 + lane] << 7) | (unsigned)lane, a1 = (sc[t * 256 + 64 + lane] << 7) | (unsigned)(64 + lane);
              sort128_asc(a0, a1, lane);
              const unsigned g0 = sc[t * 256 + 128 + (a0 & 127u)], g1 = sc[t * 256 + 128 + (a1 & 127u)];
              u32x2* outp = (u32x2*)(ROUTE + (size_t)(item * 4 + t) * 256);
              outp[lane] = (u32x2){a0 >> 7, g0}; outp[64 + lane] = (u32x2){a1 >> 7, g1}; }
        }
#else
        u32x4* outp = (u32x4*)(ROUTE + ((size_t)tok * 128 + head * 16 + hi * 8) * 2);
#pragma unroll
        for (int k = 0; k < 8; k += 2) { u32x4 w;
            const unsigned eL0 = ee[k], eH0 = ee[k + 8], eL1 = ee[k + 1], eH1 = ee[k + 9]; const float gL0 = ev[k], gH0 = ev[k + 8], gL1 = ev[k + 1], gH1 = ev[k + 9];
            w.x = hi ? eH0 : eL0; w.y = __float_as_uint(hi ? gH0 : gL0); w.z = hi ? eH1 : eL1; w.w = __float_as_uint(hi ? gH1 : gL1);
            outp[k >> 1] = w; }
#endif
    }
}

typedef float f32x2 __attribute__((ext_vector_type(2)));
typedef float f32x32 __attribute__((ext_vector_type(32)));
typedef unsigned u32x6 __attribute__((ext_vector_type(6)));
typedef __bf16 bf16x32 __attribute__((ext_vector_type(32)));
typedef unsigned u32x16 __attribute__((ext_vector_type(16)));
typedef __bf16 bf16x2_t __attribute__((ext_vector_type(2)));
#ifndef GATHER_ZIGZAG
#define GATHER_ZIGZAG 0
#endif
#ifndef GATHER_PRE
#define GATHER_PRE 0
#endif
#ifndef GATHER_MFMADOT
#define GATHER_MFMADOT 0
#endif
typedef short s16x4_t __attribute__((ext_vector_type(4)));
#ifndef GATHER_PAIRRED
#define GATHER_PAIRRED 1
#endif
#ifndef GATHER_EARLY
#define GATHER_EARLY 1
#endif
#ifndef GATHER_PACE
#define GATHER_PACE 0
#endif
#define XB_PACE(j) (XCD_BAR_WORDS + 64 * (j))
constexpr int GS = 6, GSLOT = 2 * PROW;
__device__ __forceinline__ void glds16(const void* gsrc, unsigned lds_dst) { unsigned keep;
  asm volatile("s_mov_b32 %0, m0\n\ts_mov_b32 m0, %2\n\ts_nop 0\n\tglobal_load_lds_dwordx4 %1, off\n\ts_mov_b32 m0, %0" : "=&s"(keep) : "v"(gsrc), "s"(lds_dst) : "memory"); }
template <int GMODE = 0>
__device__ __forceinline__ void gather_phase(CP P, int L, int Mrows, LAS unsigned char* lds, int wid, int lane_, int gw, int NGW, bool dry = false) {
    const unsigned char* UV = P->ws + WS_PU + (size_t)L * 16384 * PREC;
    const unsigned* ROUTE = (const unsigned*)(P->ws + WS_ROUTE); const float* MOD = (const float*)(P->ws + WS_MOD);
    bf16* X = (bf16*)(P->ws + WS_X); bf16* H = (bf16*)(P->ws + WS_H); bf16* Xo = dry ? (bf16*)(P->ws + WS_Y) : X; bf16* Ho = dry ? (bf16*)(P->ws + WS_G) : H;
    const float* lng = P->in[6] + (size_t)(L * 2 + 1) * DM; const float* lnb = P->in[7] + (size_t)(L * 2 + 1) * DM;
    const unsigned ring = (unsigned)(uintptr_t)lds + (unsigned)wid * (GS * GSLOT);
    const int nfull = (Mrows / NGW) * NGW, rem = Mrows - nfull; const bool can_coop = (rem * 4 == NGW);
    const int nround = nfull / NGW + (rem > 0 ? 1 : 0);
    const bool pace_ok = (rem == 0) || can_coop;
#define G_ROWOF(it_) ((can_coop && (it_) == nround - 1) ? (nfull + (int)blockIdx.x * 2 + (wid >> 2)) : (gw + (it_) * NGW))
    u32x2 nea = {0u, 0u}, neb = {0u, 0u}; u32x4 nh0 = {0u, 0u, 0u, 0u}, nh1 = nh0, nh2 = nh0, nh3 = nh0;
#define G_PREFETCH(rowN_, ln_) do { const int rn_ = (rowN_); nea = ((const u32x2*)(ROUTE + (size_t)rn_ * 256))[ln_]; neb = ((const u32x2*)(ROUTE + (size_t)rn_ * 256))[64 + (ln_)]; \
        const u32x4* hp_ = (const u32x4*)(H + (size_t)rn_ * DM) + 4 * (ln_); nh0 = hp_[0]; nh1 = hp_[1]; nh2 = hp_[2]; nh3 = hp_[3]; } while (0)
    if (nround > 0 && G_ROWOF(0) < Mrows) G_PREFETCH(G_ROWOF(0), launder_v(lane_));
    bool pre = false;
#pragma unroll 1
    for (int it = 0; it < nround; ++it) {
#if GATHER_PACE
        if (pace_ok && it > 0) {
            if (wid == 0 && lane_ == 0) { const unsigned nloc = ((volatile LAS unsigned*)(lds + MISC_OFF))[8];
                if (nloc != 0u) { unsigned* pc = (unsigned*)(P->ws + WS_CTL) + CW_BAR + XB_PACE(xb_xcc_id());
                    const unsigned old = xb_add(pc, 1u), tgt = (old / nloc + 1u) * nloc; unsigned sp = 0u;
                    while ((int)(xb_ld(pc) - tgt) < 0 && ++sp < 20000u) __builtin_amdgcn_s_sleep(1); } }
            __syncthreads();
        }
#endif
        const bool coop = can_coop && (it == nround - 1);
        int row = G_ROWOF(it), k0 = 0, kn = 128;
        if (coop) { k0 = (wid & 3) * 32; kn = k0 + 32; }
        else if (row >= Mrows) break;
        const int lane = launder_v(lane_);
        const u32x2 ea = nea, eb = neb;
        unsigned eax, eay, ebx, eby;
        unsigned hw[16] = {nh0.x, nh0.y, nh0.z, nh0.w, nh1.x, nh1.y, nh1.z, nh1.w, nh2.x, nh2.y, nh2.z, nh2.w, nh3.x, nh3.y, nh3.z, nh3.w};
        float y[32];
#pragma unroll
        for (int i = 0; i < 32; ++i) y[i] = 0.f;
        { unsigned e0 = ea.x, e1 = ea.y, e2 = eb.x, e3 = eb.y;
          asm volatile("" : "+v"(e0), "+v"(e1), "+v"(e2), "+v"(e3), "+v"(hw[0]), "+v"(hw[1]), "+v"(hw[2]), "+v"(hw[3]), "+v"(hw[4]), "+v"(hw[5]), "+v"(hw[6]), "+v"(hw[7]),
                       "+v"(hw[8]), "+v"(hw[9]), "+v"(hw[10]), "+v"(hw[11]), "+v"(hw[12]), "+v"(hw[13]), "+v"(hw[14]), "+v"(hw[15]) :: "memory");
          eax = e0; eay = e1; ebx = e2; eby = e3; }
        const unsigned rd_a = ring + 16u * (unsigned)lane, rd_b = ring + 2048u + 8u * (unsigned)lane;
        const bool rev = GATHER_ZIGZAG && ((it & 1) != 0);
        const int kflip = rev ? (k0 + kn - 1) : 0, ksign = rev ? -1 : 1;
#define G_ISSUE(k) do { const int k_ = (k), ke_ = kflip + ksign * k_; const unsigned e_ = (unsigned)__builtin_amdgcn_readlane((int)(ke_ < 64 ? eax : ebx), ke_ & 63); \
        const unsigned char* rp_ = UV + (size_t)e_ * PREC + 16 * lane; const unsigned sb_ = ring + (unsigned)(k_ % GS) * GSLOT; \
        if (GMODE == 3) { glds16(rp_, sb_); if (lane < 32) glds16(rp_ + 2048, sb_ + 2048); } \
        else if (GMODE != 2) { glds16(rp_, sb_); glds16(rp_ + 1024, sb_ + 1024); glds16(rp_ + 2048, sb_ + 2048); } else { asm volatile("" :: "v"(rp_), "s"(sb_)); } } while (0)
#if GATHER_EARLY
        if (it + 1 < nround && G_ROWOF(it + 1) < Mrows) G_PREFETCH(G_ROWOF(it + 1), lane);
        if (!pre) {
#pragma unroll
            for (int k = 0; k < 6; ++k) G_ISSUE(k0 + k); }
#else
#pragma unroll
        for (int k = 0; k < 4; ++k) G_ISSUE(k0 + k);
        if (it + 1 < nround && G_ROWOF(it + 1) < Mrows) G_PREFETCH(G_ROWOF(it + 1), lane);
#endif
#define G_READ(k, ua, ub, va, vb) do { const unsigned so_ = (unsigned)((k) % GS) * GSLOT; \
        asm volatile("ds_read_b128 %0, %4\n\tds_read_b64 %1, %5\n\tds_read_b128 %2, %4 offset:1024\n\tds_read_b64 %3, %5 offset:512" \
                     : "=&v"(ua), "=&v"(ub), "=&v"(va), "=&v"(vb) : "v"(rd_a + so_), "v"(rd_b + so_) : "memory"); } while (0)
#pragma unroll 1
        for (int k = k0; k < kn; k += 2) {
            if (k + 4 < kn) { if (!GATHER_EARLY) { G_ISSUE(k + 4); G_ISSUE(k + 5); } if (GMODE == 3) asm volatile("s_waitcnt vmcnt(8)" ::: "memory"); else asm volatile("s_waitcnt vmcnt(12)" ::: "memory"); }
            else if (k == kn - 4) { if (GMODE == 3) asm volatile("s_waitcnt vmcnt(4)" ::: "memory"); else asm volatile("s_waitcnt vmcnt(6)" ::: "memory"); }
            else asm volatile("s_waitcnt vmcnt(0)" ::: "memory");
            u32x4 uaA, vaA, uaB, vaB; u32x2 ubA, vbA, ubB, vbB;
            G_READ(k, uaA, ubA, vaA, vbA); G_READ(k + 1, uaB, ubB, vaB, vbB);
            asm volatile("s_waitcnt lgkmcnt(0)" : "+v"(uaA), "+v"(ubA), "+v"(vaA), "+v"(vbA), "+v"(uaB), "+v"(ubB), "+v"(vaB), "+v"(vbB) :: "memory");
            if (GATHER_EARLY && k + 6 < kn) { G_ISSUE(k + 6); G_ISSUE(k + 7); }
            if (GMODE == 1 || GMODE == 3) continue;
            const u32x6 u6A = {uaA.x, uaA.y, uaA.z, uaA.w, ubA.x, ubA.y}, u6B = {uaB.x, uaB.y, uaB.z, uaB.w, ubB.x, ubB.y};
            const u32x16 ubfA = __builtin_bit_cast(u32x16, __builtin_amdgcn_cvt_scalef32_pk32_bf16_fp6(u6A, 1.0f));
            const u32x16 ubfB = __builtin_bit_cast(u32x16, __builtin_amdgcn_cvt_scalef32_pk32_bf16_fp6(u6B, 1.0f));
#if GATHER_MFMADOT
            f32x4 dgA = {0.f, 0.f, 0.f, 0.f}, dgB = {0.f, 0.f, 0.f, 0.f};
#pragma unroll
            for (int q = 0; q < 16; q += 2) { const u32x2 hq_ = {hw[q], hw[q + 1]}, xa_ = {ubfA[q], ubfA[q + 1]}, xb_ = {ubfB[q], ubfB[q + 1]};
                dgA = __builtin_amdgcn_mfma_f32_4x4x4bf16_1k(__builtin_bit_cast(s16x4_t, xa_), __builtin_bit_cast(s16x4_t, hq_), dgA, 0, 0, 0);
                dgB = __builtin_amdgcn_mfma_f32_4x4x4bf16_1k(__builtin_bit_cast(s16x4_t, xb_), __builtin_bit_cast(s16x4_t, hq_), dgB, 0, 0, 0); }
            float a0, a1 = 0.f, b0, b1 = 0.f;
            { const float x0 = dgA[0], x1 = dgA[1], x2 = dgA[2], x3 = dgA[3], y0 = dgB[0], y1 = dgB[1], y2 = dgB[2], y3 = dgB[3];
              a0 = DPP_F(x0, 0x00); a0 += DPP_F(x1, 0x55); a0 += DPP_F(x2, 0xAA); a0 += DPP_F(x3, 0xFF);
              b0 = DPP_F(y0, 0x00); b0 += DPP_F(y1, 0x55); b0 += DPP_F(y2, 0xAA); b0 += DPP_F(y3, 0xFF); }
#else
            float a0 = 0.f, a1 = 0.f, b0 = 0.f, b1 = 0.f;
#pragma unroll
            for (int q = 0; q < 16; q += 2) { const unsigned h0_ = hw[q], h1_ = hw[q + 1], x0_ = ubfA[q], x1_ = ubfA[q + 1], z0_ = ubfB[q], z1_ = ubfB[q + 1];
                a0 = __builtin_amdgcn_fdot2_f32_bf16(__builtin_bit_cast(bf16x2_t, h0_), __builtin_bit_cast(bf16x2_t, x0_), a0, false);
                a1 = __builtin_amdgcn_fdot2_f32_bf16(__builtin_bit_cast(bf16x2_t, h1_), __builtin_bit_cast(bf16x2_t, x1_), a1, false);
                b0 = __builtin_amdgcn_fdot2_f32_bf16(__builtin_bit_cast(bf16x2_t, h0_), __builtin_bit_cast(bf16x2_t, z0_), b0, false);
                b1 = __builtin_amdgcn_fdot2_f32_bf16(__builtin_bit_cast(bf16x2_t, h1_), __builtin_bit_cast(bf16x2_t, z1_), b1, false); }
#endif
            const int keA = kflip + ksign * k, keB = keA + ksign;
            const unsigned gsel = keA < 64 ? eay : eby;
#if GATHER_PAIRRED
            float wA, wB;
            { const auto sw = __builtin_amdgcn_permlane32_swap(__float_as_uint(GATHER_MFMADOT ? a0 : a0 + a1), __float_as_uint(GATHER_MFMADOT ? b0 : b0 + b1), false, false);
#if GATHER_MFMADOT
              float c2 = __uint_as_float(sw[0]) + __uint_as_float(sw[1]); c2 += DPP_F(c2, 0x141); c2 += DPP_F(c2, 0x140);
              const float d2 = sum_xor16(c2) * (1.0f / U_SCALE);
#else
              const float d2 = half_sum32(__uint_as_float(sw[0]) + __uint_as_float(sw[1])) * (1.0f / U_SCALE);
#endif
              const float g2 = gelu_tanh(d2) * (1.0f / V_SCALE);
              const float gA = __uint_as_float((unsigned)__builtin_amdgcn_readlane((int)__float_as_uint(g2), 0)), gB = __uint_as_float((unsigned)__builtin_amdgcn_readlane((int)__float_as_uint(g2), 32));
              wA = __uint_as_float((unsigned)__builtin_amdgcn_readlane((int)gsel, keA & 63)) * gA; wB = __uint_as_float((unsigned)__builtin_amdgcn_readlane((int)gsel, keB & 63)) * gB; }
#else
            const float dA = wave_sum(a0 + a1) * (1.0f / U_SCALE), dB = wave_sum(b0 + b1) * (1.0f / U_SCALE);
            const float wA = __uint_as_float((unsigned)__builtin_amdgcn_readlane((int)gsel, keA & 63)) * gelu_tanh(dA) * (1.0f / V_SCALE);
            const float wB = __uint_as_float((unsigned)__builtin_amdgcn_readlane((int)gsel, keB & 63)) * gelu_tanh(dB) * (1.0f / V_SCALE);
#endif
            const u32x6 v6A = {vaA.x, vaA.y, vaA.z, vaA.w, vbA.x, vbA.y};
            const f32x32 vfA = __builtin_amdgcn_cvt_scalef32_pk32_f32_fp6(v6A, 1.0f);
#pragma unroll
            for (int i = 0; i < 32; ++i) y[i] += wA * vfA[i];
            const u32x6 v6B = {vaB.x, vaB.y, vaB.z, vaB.w, vbB.x, vbB.y};
            const f32x32 vfB = __builtin_amdgcn_cvt_scalef32_pk32_f32_fp6(v6B, 1.0f);
#pragma unroll
            for (int i = 0; i < 32; ++i) y[i] += wB * vfB[i];
        }
#if GATHER_PRE
        pre = (it + 1 < nround) && (G_ROWOF(it + 1) < Mrows);
        if (pre) { unsigned n0 = nea.x, n2 = neb.x; asm volatile("" : "+v"(n0), "+v"(n2) :: "memory"); eax = n0; ebx = n2;
            const int k0n = (can_coop && (it + 1 == nround - 1)) ? (wid & 3) * 32 : 0;
#pragma unroll
            for (int k = 0; k < 6; ++k) G_ISSUE(k0n + k); }
#endif
#undef G_READ
#undef G_ISSUE
        if (coop) {
            LAS f32x4* mine = (LAS f32x4*)(lds + wid * (GS * GSLOT)) + lane * 8;
#pragma unroll
            for (int i = 0; i < 8; ++i) mine[i] = (f32x4){y[4 * i], y[4 * i + 1], y[4 * i + 2], y[4 * i + 3]};
            __syncthreads();
            if ((wid & 3) == 0) {
#pragma unroll
                for (int j = 1; j < 4; ++j) { const LAS f32x4* oth = (const LAS f32x4*)(lds + (wid + j) * (GS * GSLOT)) + lane * 8;
#pragma unroll
                    for (int i = 0; i < 8; ++i) { const f32x4 t = oth[i]; y[4 * i] += t.x; y[4 * i + 1] += t.y; y[4 * i + 2] += t.z; y[4 * i + 3] += t.w; } }
            }
            __syncthreads();
            if ((wid & 3) != 0) continue;
        }
        const int slot = row_slot(row);
        const float* mod = MOD + (size_t)(L * 3 + slot) * 12288;
        const int le = launder_v(lane);
        { float xx[32], gg[32]; load_row_bf16_b(X + (size_t)row * DM, le, xx); load_row_f32_b(mod + 5 * 2048, le, gg);
#pragma unroll
          for (int i = 0; i < 32; ++i) y[i] = ALPHA * xx[i] + gg[i] * y[i]; }
        if (L < NLAYER - 1) { const float* modn = MOD + (size_t)((L + 1) * 3 + slot) * 12288;
            finish_row<true>(y, lng, lnb, Xo + (size_t)row * DM, modn, modn + 2048, Ho + (size_t)row * DM, nullptr, le); }
        else finish_row<true>(y, lng, lnb, nullptr, nullptr, nullptr, nullptr, P->out + (size_t)row * DM, le);
        asm volatile("s_waitcnt vmcnt(0)" ::: "memory");
    }
#undef G_PREFETCH
#undef G_ROWOF
}

#ifndef ROPE_TEST
#define ROPE_TEST 0
#endif
#ifndef PROBE_DUP
#define PROBE_DUP 0
#endif
#define NOINL __forceinline__
__device__ __forceinline__ CP launder_cp(CP p) { asm volatile("" : "+s"(p)); return p; }
#define GETP() launder_cp((CP)__builtin_amdgcn_kernarg_segment_ptr())
__device__ __forceinline__ int uni(int v) { return __builtin_amdgcn_readfirstlane(v); }
__device__ __forceinline__ LAS unsigned char* uni_lds(LAS unsigned char* p) { return (LAS unsigned char*)(unsigned)__builtin_amdgcn_readfirstlane((int)(unsigned)(uintptr_t)p); }
#define PH_IDS const int wid = uni(wv_), lane = launder_v(lane_id_fresh()) & 63, tid = (wid & 7) * 64 + lane; const int gw = blockIdx.x * NWAVES + wid, NGW = gridDim.x * NWAVES; (void)lane; (void)gw; (void)NGW; (void)tid;

__device__ NOINL void ph_prologue(int wv_, LAS unsigned char* lds_) { CP P = GETP(); LAS unsigned char* lds = uni_lds(lds_); PH_IDS p0_prologue(P, lds, tid, lane, wid, gw, NGW); if (PROBE_DUP == 5) p0_prologue(P, lds, tid, lane, wid, gw, NGW);
    if (PROBE_DUP >= 21 && PROBE_DUP <= 23) { __syncthreads(); p0_prologue(P, lds, tid, lane, wid, gw, NGW, 1 << (PROBE_DUP - 21 < 0 ? 0 : (PROBE_DUP - 21) & 3)); } }
__device__ NOINL void ph_modreduce(int wv_) { CP P = GETP(); PH_IDS mod_reduce(P, gw, lane, NGW); }
__device__ NOINL void ph_first(int wv_) { CP P = GETP(); PH_IDS
#pragma unroll 1
    for (int rep = 0; rep < (PROBE_DUP == 6 ? 2 : 1); ++rep) first_row_pass(P, lane, gw, NGW); }
__device__ NOINL void ph_postmix(int wv_, LAS unsigned char* lds_, int L_, int M_) { CP P = GETP(); LAS unsigned char* lds = uni_lds(lds_); const int L = uni(L_), Mrows = uni(M_); PH_IDS
    if (POSTMIX_LDS) post_mixer_pass_lds(P, L, Mrows, lds, tid, lane, gw, NGW); else post_mixer_pass(P, L, Mrows, lane, gw, NGW); }
__device__ NOINL void ph_vstats(int wv_, int M_) { CP P = GETP(); const int Mrows = uni(M_); PH_IDS
#pragma unroll 1
    for (int rep = 0; rep < (PROBE_DUP == 6 ? 2 : 1); ++rep) vstats_pass(P, Mrows, lane, gw, NGW); }
__device__ NOINL void ph_spatial(int wv_, LAS unsigned char* lds_, int j_, int M_) { CP P = GETP(); LAS unsigned char* lds = uni_lds(lds_); const int j = uni(j_), Mrows = uni(M_); PH_IDS
#pragma unroll 1
    for (int rep = 0; rep < (PROBE_DUP == 6 ? 2 : 1); ++rep) spatial_phase(P, j, Mrows, lds, tid, lane, wid); }
__device__ NOINL void ph_mla_norm(int wv_) { CP P = GETP(); PH_IDS
#pragma unroll 1
    for (int rep = 0; rep < (PROBE_DUP == 6 ? 2 : 1); ++rep) mla_norm_pass(P, lane, gw, NGW); }
__device__ NOINL void ph_rope(int wv_, int which_) { CP P = GETP(); const int which = uni(which_); PH_IDS
    if (which == 0) rope_pass((bf16*)(P->ws + WS_QM), 3072, 128, 16, 192, lane, gw, NGW);
    else rope_pass((bf16*)(P->ws + WS_Z), 6144, 0, 64, 64, lane, gw, NGW); }
__device__ NOINL void ph_attn_mla(int wv_, LAS unsigned char* lds_) { CP P = GETP(); LAS unsigned char* lds = uni_lds(lds_); PH_IDS mla_attn_phase(P, lds, tid); if (PROBE_DUP == 2 || PROBE_DUP == 9) mla_attn_phase(P, lds, tid); }
__device__ NOINL void ph_attn_da(int wv_, LAS unsigned char* lds_, int L_, bool ctx_q) { CP P = GETP(); LAS unsigned char* lds = uni_lds(lds_); const int L = uni(L_); PH_IDS
    const float* lp = P->in[26];
    const float s01 = wave_sum(lp[lane] * lp[64 + lane]), s23 = wave_sum(lp[128 + lane] * lp[192 + lane]);
    const float lam_init = 0.8f - 0.6f * expf(-0.3f * (float)L);
    const float lam = expf(s01) - expf(s23) + lam_init;
    if (!(PROBE_DUP >= 11 && PROBE_DUP <= 15)) da_attn_phase(P, lam, 1.0f - lam_init, lds, tid, ctx_q);
    if (PROBE_DUP == 2 || PROBE_DUP == 10) da_attn_phase(P, lam, 1.0f - lam_init, lds, tid, ctx_q);
    if (PROBE_DUP >= 11 && PROBE_DUP <= 15) { da_attn_phase<PROBE_DUP >= 11 && PROBE_DUP <= 15 ? PROBE_DUP - 10 : 0>(P, lam, 1.0f - lam_init, lds, tid, ctx_q); __syncthreads(); }
    if (PROBE_DUP >= 11 && PROBE_DUP <= 15) da_attn_phase(P, lam, 1.0f - lam_init, lds, tid, ctx_q); }
__device__ NOINL void ph_route(int wv_, LAS unsigned char* lds_, int L_, int M_) { CP P = GETP(); LAS unsigned char* lds = uni_lds(lds_); const int L = uni(L_), Mrows = uni(M_); PH_IDS
#pragma unroll 1
    for (int rep = 0; rep < (PROBE_DUP == 4 ? 2 : 1); ++rep) route_phase(P, L, Mrows, lds, tid, lane, wid, gw, NGW); }
__device__ NOINL void ph_gather(int wv_, LAS unsigned char* lds_, int L_, int M_) { CP P = GETP(); LAS unsigned char* lds = uni_lds(lds_); const int L = uni(L_), Mrows = uni(M_); PH_IDS
    if (PROBE_DUP == 3) { gather_phase<0>(P, L, Mrows, lds, wid, lane, gw, NGW, true); }
    if (PROBE_DUP == 7) { gather_phase<1>(P, L, Mrows, lds, wid, lane, gw, NGW, true); }
    if (PROBE_DUP == 17) { gather_phase<3>(P, L, Mrows, lds, wid, lane, gw, NGW, true); }
    if (PROBE_DUP == 8) { gather_phase<2>(P, L, Mrows, lds, wid, lane, gw, NGW, true); }
    gather_phase<0>(P, L, Mrows, lds, wid, lane, gw, NGW); }

enum GemmId { G_GM_IN = 0, G_GM_OUT, G_MLA_IN, G_MLA_UQ, G_MLA_UKV, G_MLA_OUT, G_DA_IN, G_DA_OUT, G_PEER_Q };
__device__ NOINL void ph_gemm(int wv_, LAS unsigned char* lds_, int id_, int L_, int M_) {
    CP P = GETP(); LAS unsigned char* lds = uni_lds(lds_); const int id = uni(id_), L = uni(L_), Mrows = uni(M_); PH_IDS
    unsigned char* ws = P->ws; const int jj = L / 3;
    size_t a = WS_H, b = 0, o = 0; int M = MT, N = 2048, K = 2048, act = 0, rope = 0;
    switch (id) {
        case G_GM_IN:   a = WS_H;    b = WS_GMWIN + (size_t)jj * 4096 * 2048 * 2;  o = WS_Z;  M = Mrows; N = 4096; K = 2048; act = 1; break;
        case G_GM_OUT:  a = WS_G;    b = WS_GMWOUT + (size_t)jj * 2048 * 2048 * 2; o = WS_Y;  M = Mrows; N = 2048; K = 2048; break;
        case G_MLA_IN:  a = WS_H;    b = WS_MLAIN;  o = WS_C;  N = 1280; K = 2048; break;
        case G_MLA_UQ:  a = WS_CQN;  b = WS_MLAUQ;  o = WS_QM; N = 3072; K = 512;  rope = (ROPE_TEST == 2) ? 0 : 2; break;
        case G_MLA_UKV: a = WS_CKVN; b = WS_MLAUKV; o = WS_KV; N = 4096; K = 512;  break;
        case G_MLA_OUT: a = WS_G;    b = WS_MLAOUT; o = WS_Y;  N = 2048; K = 2048; break;
        case G_DA_IN:   a = WS_H;    b = WS_DAIN;   o = WS_Z;  N = 6144; K = 2048; rope = (ROPE_TEST == 1) ? 0 : 1; break;
        case G_DA_OUT:  a = WS_G;    b = WS_DAOUT;  o = WS_Y;  M = Mrows; N = 2048; K = 2048; break;
        default:        a = WS_H;    b = WS_PWQ + (size_t)L * 2048 * 2048 * 2;     o = WS_QP; M = Mrows; N = 2048; K = 2048; break;
    }
    pg8::Gemm g{(const pg8::bf16_t*)(ws + a), (const pg8::bf16_t*)(ws + b), M, N, K}; pg8::StaticOrder S; S.init(M, N, (int)gridDim.x, (int)blockIdx.x);
    pg8::EpiR E{(pg8::bf16_t*)(ws + o), N, act, rope, (const float*)(ws + WS_ROPE)};
#pragma unroll 1
    for (int rep = 0; rep < (PROBE_DUP == 1 ? 2 : 1); ++rep) { pg8::gemm_phase<pg8::EpiR, pg8::StaticOrder, true, true>((PG8_LAS unsigned char*)lds, g, S, E, tid); __syncthreads(); }
#if TAIL_REMAP
    int TL = -1; bool tail_u = false;
    if (L == 0) { if (id == G_GM_IN) { TL = 0; tail_u = true; } else if (id == G_GM_OUT) { TL = 0; } else if (id == G_PEER_Q) { TL = 1; tail_u = true; } }
    else if (L == 1) { if (id == G_MLA_IN) { TL = 1; } else if (id == G_MLA_OUT) { TL = 2; tail_u = true; } else if (id == G_PEER_Q) { TL = 2; } }
    else if (L == 2) { if (id == G_DA_IN) { TL = 3; tail_u = true; } else if (id == G_DA_OUT) { TL = 3; } }
    if (TL >= 0) {
        const int units = (M / 256) * (N / 256), G = (int)gridDim.x, tail = units % G, c = (int)blockIdx.x;
        const float* src = (tail_u ? P->in[11] : P->in[12]) + (size_t)TL * 16384 * 2048; unsigned char* dst = ws + WS_PU + (size_t)TL * 16384 * PREC;
#else
    const bool tail_u = (id == G_GM_OUT || id == G_MLA_OUT || id == G_DA_OUT), tail_v = (id == G_PEER_Q);
    if ((tail_u || tail_v) && L + 1 < NLAYER) {
        const int units = (M / 256) * (N / 256), G = (int)gridDim.x, tail = units % G, c = (int)blockIdx.x;
        const float* src = (tail_u ? P->in[11] : P->in[12]) + (size_t)(L + 1) * 16384 * 2048; unsigned char* dst = ws + WS_PU + (size_t)(L + 1) * 16384 * PREC;
#endif
        LAS float* scr = (LAS float*)(lds + wid * 16384);
        if (tail != 0 && c >= tail) cvt_table_fp6(src, dst, 16384, tail_u ? U_SCALE : V_SCALE, scr, lane, (c - tail) * NWAVES + wid, (G - tail) * NWAVES, tail_u ? 0 : 1);
        else if (tail == 0) {
#pragma unroll 1
            for (int rep = 0; rep < (PROBE_DUP == 18 ? 3 : 1); ++rep) cvt_table_fp6(src, dst, 16384, tail_u ? U_SCALE : V_SCALE, scr, lane, gw, NGW, tail_u ? 0 : 1); }
    }
}

__global__ void __launch_bounds__(NWAVES * 64, 2) mk_fwd(Params Pv) {
    extern __shared__ __attribute__((aligned(16))) unsigned char lds_g[];
    LAS unsigned char* lds = (LAS unsigned char*)lds_g;
    const int wv = __builtin_amdgcn_readfirstlane((int)threadIdx.x >> 6);
    const int tid = wv * 64 + lane_id_fresh();
    for (int u = tid; u < (LDS_BYTES - RING_BYTES) / 4; u += NWAVES * 64) ((LAS unsigned*)(lds + RING_BYTES))[u] = 0u;
    __syncthreads();
    const int lo = Pv.ph_lo, hi = Pv.ph_hi;
    unsigned* barw = (unsigned*)(Pv.ws + WS_CTL) + CW_BAR;
    XcdBarrier bar; bar.bar = barw; bar.x = 0; bar.st = nullptr;
    if (hi - lo > 1) bar = xcd_barrier_post(barw, (volatile LAS unsigned*)(lds + MISC_OFF) + 8, tid == 0);
    int ph = 0;
#ifndef SEL
#define SELP(k) true
#else
#define SELP(k) ((k) == SEL)
#endif
    enum { RUN_BASE = __COUNTER__ + 1 };
#define RUN(call) do { if (SELP(__COUNTER__ - RUN_BASE) && ph >= lo && ph < hi) { call; } if (ph >= lo && ph + 1 < hi) xcd_barrier(bar, wv == 0 && lane_id_fresh() == 0); ++ph; } while (0)
    RUN(ph_prologue(wv, lds));
    RUN(ph_modreduce(wv));
    RUN(ph_first(wv));
#define LAYER(LL) do { constexpr int L = (LL); constexpr int kind = L % 3, jj = L / 3; constexpr int Mrows = (L == NLAYER - 1) ? ML : MT; \
        constexpr bool ctx_dead = (L == NLAYER - 2) && ((NLAYER - 1) % 3 == 0) && (kind != 0); constexpr int Mlive = ctx_dead ? ML : Mrows; \
        if (kind == 0) {                          \
            RUN(ph_gemm(wv, lds, G_GM_IN, L, Mrows)); \
            RUN(ph_vstats(wv, Mrows)); \
            RUN(ph_spatial(wv, lds, jj, Mrows)); \
            RUN(ph_gemm(wv, lds, G_GM_OUT, L, Mrows)); \
        } else if (kind == 1) {                   \
            RUN(ph_gemm(wv, lds, G_MLA_IN, L, Mrows)); \
            RUN(ph_mla_norm(wv)); \
            RUN(ph_gemm(wv, lds, G_MLA_UQ, L, Mrows); ph_gemm(wv, lds, G_MLA_UKV, L, Mrows)); \
            if (ROPE_TEST == 2) { RUN(ph_rope(wv, 0)); } \
            RUN(ph_attn_mla(wv, lds)); \
            RUN(ph_gemm(wv, lds, G_MLA_OUT, L, Mrows)); \
        } else {                                  \
            RUN(ph_gemm(wv, lds, G_DA_IN, L, Mrows); if (ROPE_TEST == 1) { __syncthreads(); } ); \
            if (ROPE_TEST == 1) { RUN(ph_rope(wv, 1)); } \
            RUN(ph_attn_da(wv, lds, L, !ctx_dead)); \
            RUN(ph_gemm(wv, lds, G_DA_OUT, L, Mlive)); \
        } \
        RUN(ph_postmix(wv, lds, L, Mlive));                \
        RUN(ph_gemm(wv, lds, G_PEER_Q, L, Mlive));    \
        RUN(ph_route(wv, lds, L, Mlive));             \
        RUN(ph_gather(wv, lds, L, Mlive));            \
    } while (0)
    LAYER(0); LAYER(1); LAYER(2); LAYER(3);
#undef LAYER
#undef RUN
}

extern "C" void kernel_launch(void* const* d_in, const int* in_sizes, int n_in, void* d_out, int out_size, void* d_ws, size_t ws_size, hipStream_t stream) {
    static int grid = 0;
    if (grid == 0) {
        if (n_in != 29 || in_sizes[0] != ML * DM || out_size != ML * DM || ws_size < WS_END) {
            fprintf(stderr, "kernel_launch: shape mismatch: n_in %d in0 %d out %d ws %zu (need %zu); nothing launched\n", n_in, n_in > 0 ? in_sizes[0] : -1, out_size, ws_size, (size_t)WS_END); grid = -1; return; }
        int dev = 0, cus = 0, per_cu = 0;
        if (hipGetDevice(&dev) != hipSuccess || hipDeviceGetAttribute(&cus, hipDeviceAttributeMultiprocessorCount, dev) != hipSuccess) { fprintf(stderr, "kernel_launch: device query failed\n"); grid = -1; return; }
        if (hipFuncSetAttribute((const void*)mk_fwd, hipFuncAttributeMaxDynamicSharedMemorySize, LDS_BYTES) != hipSuccess) { fprintf(stderr, "kernel_launch: hipFuncSetAttribute failed\n"); grid = -1; return; }
        if (hipOccupancyMaxActiveBlocksPerMultiprocessor(&per_cu, (const void*)mk_fwd, NWAVES * 64, LDS_BYTES) != hipSuccess || per_cu < 1)
            fprintf(stderr, "kernel_launch: note: occupancy query reports %d workgroups per CU\n", per_cu);
        (void)hipGetLastError();
        grid = cus;
    }
    if (grid < 0) return;
    if (hipMemsetAsync((char*)d_ws + WS_CTL, 0, CTL_ZERO_BYTES, stream) != hipSuccess) { fprintf(stderr, "kernel_launch: memset failed\n"); return; }
    Params p{};
    for (int i = 0; i < 29; ++i) p.in[i] = (const float*)d_in[i];
    p.out = (float*)d_out; p.ws = (unsigned char*)d_ws;
#if MK_ONE_LAUNCH
    p.ph_lo = 0; p.ph_hi = NPH;
    hipLaunchKernelGGL(mk_fwd, dim3(grid), dim3(NWAVES * 64), LDS_BYTES, stream, p);
#else
    for (int li = 0; li < NPH; ++li) { p.ph_lo = li; p.ph_hi = li + 1; hipLaunchKernelGGL(mk_fwd, dim3(grid), dim3(NWAVES * 64), LDS_BYTES, stream, p); }
#endif
    const hipError_t le = hipPeekAtLastError();
    if (le != hipSuccess) fprintf(stderr, "kernel_launch: launch failed: %s\n", hipGetErrorName(le));
}
```

```cpp
#include <hip/hip_runtime.h>
#include <cstdio>
#include <cstdint>
#ifndef MK_ONE_LAUNCH
#define MK_ONE_LAUNCH 1
#endif
__device__ __forceinline__ int launder_v(int v) { asm volatile("" : "+v"(v)); return v; }
__device__ __forceinline__ int lane_id_fresh() { unsigned m = ~0u; asm volatile("" : "+s"(m)); return (int)__builtin_amdgcn_mbcnt_hi(m, __builtin_amdgcn_mbcnt_lo(m, 0u)); }
namespace pg8 {
#define PG8_LAS __attribute__((address_space(3)))
typedef unsigned short bf16_t;
typedef short bf16x8 __attribute__((ext_vector_type(8)));
typedef float f32x4 __attribute__((ext_vector_type(4)));
typedef unsigned u32x4 __attribute__((ext_vector_type(4)));
constexpr int BM = 256, BK = 64, HALF = 128, HTB = HALF * BK * 2  , STAGE_BYTES = 8 * HTB, NXCD = 8, WGM = 8;

__host__ __device__ __forceinline__ int lds_byte(int r, int c) { const int st = (r >> 4) * 2 + (c >> 5), rr = r & 15, cc = c & 31, ob = rr * 64 + cc * 2; return st * 1024 + (ob ^ (((ob >> 9) & 1) << 5)); }
__host__ __device__ __forceinline__ void stage_rc(int b, int& R, int& C) { const int st = b / 1024, sb = b % 1024, swz = sb ^ (((sb >> 9) & 1) << 5); R = (st >> 1) * 16 + swz / 64; C = (st & 1) * 32 + (swz % 64) / 2; }
__host__ __device__ __forceinline__ int perm32(int rho) { const int n = rho >> 4, i = rho & 15; return 8 * (i >> 2) + 4 * n + (i & 3); }

struct Unit { int pm, pn; };
struct Gemm { const bf16_t* A; const bf16_t* Bt; int M, N, K; };

struct StaticOrder {
    int nM, nN, nwg, G, c;
    __host__ __device__ void init(int M, int N, int G_, int c_) { nM = M / BM; nN = N / BM; nwg = nM * nN; G = G_; c = c_; }
    __host__ __device__ bool next(int i, Unit& u) const {
        const long L = (long)i * G + c; if (L >= nwg) return false;
        int wgid = (int)L; { const int q = nwg / NXCD, r = nwg % NXCD, xcd = wgid % NXCD, off = wgid / NXCD; wgid = (xcd < r ? xcd * (q + 1) : r * (q + 1) + (xcd - r) * q) + off; }
        const int nig = WGM * nN, gid = wgid / nig, fm = gid * WGM, gsz = (nM - fm) < WGM ? (nM - fm) : WGM;
        u.pm = fm + ((wgid % nig) % gsz); u.pn = (wgid % nig) / gsz; return true;
    }
    __device__ __forceinline__ void a_ready(const Unit&) const {}
    __device__ __forceinline__ void done(const Unit&) const {}
};

__device__ __forceinline__ unsigned cvt_pk_bf16(float lo, float hi) { unsigned r; asm volatile("v_cvt_pk_bf16_f32 %0, %1, %2" : "=v"(r) : "v"(lo), "v"(hi)); return r; }
typedef float f32x2 __attribute__((ext_vector_type(2)));
__device__ __forceinline__ f32x2 gelu_pk(f32x2 v) {
    const f32x2 av = __builtin_elementwise_abs(v), d = av * 0.2316418882f + 1.0f;
    f32x2 t; t.x = __builtin_amdgcn_rcpf(d.x); t.y = __builtin_amdgcn_rcpf(d.y);
    f32x2 q = t * 0.5307027145f + (-0.7265760135f); q = q * t + 0.7107068705f; q = q * t + (-0.142248368f); q = q * t + 0.127414796f; q = q * t;
    const f32x2 s = (v * v) * (-0.72134752044f);
    f32x2 e; e.x = __builtin_amdgcn_exp2f(s.x); e.y = __builtin_amdgcn_exp2f(s.y);
    const f32x2 m = v * (q * e), r = v - m;
    f32x2 o; o.x = v.x < 0.f ? m.x : r.x; o.y = v.y < 0.f ? m.y : r.y; return o;
}

template <int ACT  > struct EpiBf16 {
    static constexpr bool PERM = true, AFTER_DRAIN = false; static_assert(ACT == 0 || ACT == 1, "EpiBf16: ACT is 0 (none) or 1 (gelu_pk)");
    bf16_t* O; int ldc; const float* bias; int split_cols; size_t split_stride; float scale0;
    __device__ __forceinline__ void operator()(const f32x4 (&acc)[2][2][4][2], const Unit& u, int wr, int wc, int fr, int fq) const {
        const int row0 = u.pm * BM + wr * 64 + fr; int colt = u.pn * BM; bf16_t* base = O;
        float sc = 1.f; if (split_cols) { const int t = colt / split_cols; base += (size_t)t * split_stride; colt -= t * split_cols; if (t == 0) sc = scale0; }
        const int col0 = colt + wc * 32 + 8 * fq, bcol0 = u.pn * BM + wc * 32 + 8 * fq;
        f32x4 bv[2][2];
#pragma unroll
        for (int bj = 0; bj < 2; ++bj)
#pragma unroll
            for (int n = 0; n < 2; ++n) bv[bj][n] = bias ? *(const f32x4*)(bias + bcol0 + bj * HALF + 4 * n) : (f32x4){0.f, 0.f, 0.f, 0.f};
#pragma unroll
        for (int ai = 0; ai < 2; ++ai)
#pragma unroll
            for (int m = 0; m < 4; ++m) { bf16_t* rowp = base + (size_t)(row0 + ai * HALF + m * 16) * ldc + col0;
#pragma unroll
                for (int bj = 0; bj < 2; ++bj) { f32x4 v0 = acc[ai][bj][m][0] + bv[bj][0], v1 = acc[ai][bj][m][1] + bv[bj][1];
                    if (ACT == 1) { f32x2 a = gelu_pk((f32x2){v0[0], v0[1]}), b = gelu_pk((f32x2){v0[2], v0[3]}), c = gelu_pk((f32x2){v1[0], v1[1]}), d = gelu_pk((f32x2){v1[2], v1[3]});
                        v0 = (f32x4){a.x, a.y, b.x, b.y}; v1 = (f32x4){c.x, c.y, d.x, d.y}; }
                    v0 = v0 * sc; v1 = v1 * sc; u32x4 w; w.x = cvt_pk_bf16(v0[0], v0[1]); w.y = cvt_pk_bf16(v0[2], v0[3]); w.z = cvt_pk_bf16(v1[0], v1[1]); w.w = cvt_pk_bf16(v1[2], v1[3]);
                    *(u32x4*)(rowp + bj * HALF) = w; } }
    }
};
template <class Epi, class Sched, bool ALIGN_EPI = false, bool SP2 = false>
__device__ __forceinline__ void gemm_phase(PG8_LAS unsigned char* lds, const Gemm g, const Sched& S, const Epi& E, const int tid_in) {
    const int tid = launder_v(tid_in) & 511, wid = __builtin_amdgcn_readfirstlane(tid >> 6), lane = tid & 63, wr = wid >> 2, wc = wid & 3, fr = lane & 15, fq = lane >> 4;
    const int K = g.K, nt = K / BK;
    unsigned voffA[2], voffB[2];
#pragma unroll
    for (int i = 0; i < 2; ++i) { int R, C; stage_rc(tid * 16 + i * 8192, R, C); const int Rb = Epi::PERM ? ((R & ~31) + perm32(R & 31)) : R;
        voffA[i] = (unsigned)(R * K + C) * 2u; voffB[i] = (unsigned)(Rb * K + C) * 2u; }
    const size_t kstep = (size_t)(BK * 2);
    const size_t hstep = (size_t)HALF * K * 2;
    const size_t tstep = 2 * hstep;
    const unsigned ldsw = (unsigned)wid * 1024u;
    const int aoff = lds_byte(wr * 64 + fr, fq * 8), boff = lds_byte(wc * 32 + fr, fq * 8);
#define PG8_SA(b, h) (((b) * 2 + (h)) * HTB)
#define PG8_SB(b, h) ((4 + (b) * 2 + (h)) * HTB)
#define PG8_STAGE(bufoff, gbase, voff) do { _Pragma("unroll") for (int _i = 0; _i < 2; ++_i) \
        __builtin_amdgcn_global_load_lds((const unsigned*)((const char*)(gbase) + (voff)[_i]), (PG8_LAS unsigned*)(lds + (bufoff) + ldsw + _i * 8192), 16, 0, 0); } while (0)
#define PG8_LDA(dst, b, h) do { _Pragma("unroll") for (int m = 0; m < 4; ++m) _Pragma("unroll") for (int k = 0; k < 2; ++k) dst[m][k] = *(const PG8_LAS bf16x8*)(lds + PG8_SA(b, h) + aoff + m * 2048 + k * 1024); } while (0)
#define PG8_LDB(dst, b, h) do { _Pragma("unroll") for (int n = 0; n < 2; ++n) _Pragma("unroll") for (int k = 0; k < 2; ++k) dst[n][k] = *(const PG8_LAS bf16x8*)(lds + PG8_SB(b, h) + boff + n * 2048 + k * 1024); } while (0)
#define PG8_MMA(ai, bj, At, Bt) do { __builtin_amdgcn_s_setprio(1); _Pragma("unroll") for (int m = 0; m < 4; ++m) _Pragma("unroll") for (int n = 0; n < 2; ++n) _Pragma("unroll") for (int k = 0; k < 2; ++k) \
        acc[ai][bj][m][n] = __builtin_amdgcn_mfma_f32_16x16x32_bf16(Bt[n][k], At[m][k], acc[ai][bj][m][n], 0, 0, 0); __builtin_amdgcn_s_setprio(0); } while (0)
#define PG8_WAIT_V(n) asm volatile("s_waitcnt vmcnt(" #n ")" ::: "memory")
#define PG8_WAIT_L(n) asm volatile("s_waitcnt lgkmcnt(" #n ")" ::: "memory")
#define PG8_BAR __builtin_amdgcn_s_barrier()
#define PG8_SCHED __builtin_amdgcn_sched_barrier(0)
    Unit cur, nxt; int ui = 0;
    if (!S.next(0, cur)) return;
    f32x4 acc[2][2][4][2];
#pragma unroll
    for (int a = 0; a < 2; ++a)
#pragma unroll
        for (int b = 0; b < 2; ++b)
#pragma unroll
            for (int m = 0; m < 4; ++m)
#pragma unroll
                for (int n = 0; n < 2; ++n) acc[a][b][m][n] = (f32x4){0.f, 0.f, 0.f, 0.f};
    bf16x8 At[4][2], B0[2][2], B1[2][2];
    const char* cA = (const char*)g.A + (size_t)cur.pm * tstep; const char* cB = (const char*)g.Bt + (size_t)cur.pn * tstep;
    S.a_ready(cur);
    if constexpr (SP2) {
        PG8_STAGE(PG8_SB(0, 0), cB, voffB); PG8_STAGE(PG8_SB(0, 1), cB + hstep, voffB); PG8_STAGE(PG8_SA(0, 0), cA, voffA); PG8_STAGE(PG8_SA(0, 1), cA + hstep, voffA);
        if (wr == 1) PG8_BAR;
        PG8_WAIT_V(2); PG8_BAR;
        PG8_STAGE(PG8_SB(1, 0), cB + kstep, voffB); PG8_STAGE(PG8_SA(1, 0), cA + kstep, voffA); PG8_STAGE(PG8_SB(1, 1), cB + hstep + kstep, voffB);
        PG8_WAIT_V(6); PG8_BAR;
    } else {
        PG8_STAGE(PG8_SB(0, 0), cB, voffB); PG8_STAGE(PG8_SA(0, 0), cA, voffA); PG8_STAGE(PG8_SB(0, 1), cB + hstep, voffB); PG8_STAGE(PG8_SA(0, 1), cA + hstep, voffA);
        if (wr == 1) PG8_BAR;
        PG8_WAIT_V(4); PG8_BAR;
        PG8_STAGE(PG8_SB(1, 0), cB + kstep, voffB); PG8_STAGE(PG8_SA(1, 0), cA + kstep, voffA); PG8_STAGE(PG8_SB(1, 1), cB + hstep + kstep, voffB);
        PG8_WAIT_V(6); PG8_BAR;
    }
    for (;;) {
        const bool has_next = S.next(ui + 1, nxt);
        const char* nA = has_next ? (const char*)g.A + (size_t)nxt.pm * tstep : cA; const char* nB = has_next ? (const char*)g.Bt + (size_t)nxt.pn * tstep : cB;
        for (int t = 0; t < nt; t += 2) {
            const bool last = (t == nt - 2);
            const char* a1 = cA + (size_t)(t + 1) * kstep;
            const char* a2 = last ? nA : cA + (size_t)(t + 2) * kstep; const char* b2 = last ? nB : cB + (size_t)(t + 2) * kstep;
            const char* a3 = a2 + kstep; const char* b3 = b2 + kstep;
            if (last && has_next) S.a_ready(nxt);
            if constexpr (SP2) {
            PG8_LDB(B0, 0, 0); PG8_LDB(B1, 0, 1); PG8_SCHED; PG8_LDA(At, 0, 0); PG8_STAGE(PG8_SA(1, 1), a1 + hstep, voffA);
            PG8_WAIT_V(8); PG8_WAIT_L(0); PG8_BAR; PG8_MMA(0, 0, At, B0); PG8_MMA(0, 1, At, B1); PG8_BAR; PG8_SCHED;
            PG8_LDA(At, 0, 1); PG8_STAGE(PG8_SB(0, 0), b2, voffB); PG8_STAGE(PG8_SB(0, 1), b2 + hstep, voffB); PG8_STAGE(PG8_SA(0, 0), a2, voffA);
            PG8_WAIT_V(8); PG8_WAIT_L(0); PG8_BAR; PG8_MMA(1, 0, At, B0); PG8_MMA(1, 1, At, B1); PG8_BAR; PG8_SCHED;
            PG8_LDB(B0, 1, 0); PG8_LDB(B1, 1, 1); PG8_SCHED; PG8_LDA(At, 1, 0); PG8_STAGE(PG8_SA(0, 1), a2 + hstep, voffA);
            PG8_WAIT_V(8); PG8_WAIT_L(0); PG8_BAR; PG8_MMA(0, 0, At, B0); PG8_MMA(0, 1, At, B1); PG8_BAR; PG8_SCHED;
            PG8_LDA(At, 1, 1); PG8_STAGE(PG8_SB(1, 0), b3, voffB); PG8_STAGE(PG8_SB(1, 1), b3 + hstep, voffB); PG8_STAGE(PG8_SA(1, 0), a3, voffA);
            PG8_WAIT_V(8); PG8_WAIT_L(0); PG8_BAR; PG8_MMA(1, 0, At, B0); PG8_MMA(1, 1, At, B1); PG8_BAR; PG8_SCHED;
            } else {
            PG8_LDB(B0, 0, 0); PG8_SCHED; PG8_LDA(At, 0, 0); PG8_STAGE(PG8_SA(1, 1), a1 + hstep, voffA);
            PG8_WAIT_L(8); PG8_BAR; PG8_WAIT_L(0); PG8_MMA(0, 0, At, B0); PG8_BAR; PG8_SCHED;
            PG8_LDB(B1, 0, 1); PG8_STAGE(PG8_SB(0, 0), b2, voffB);
            PG8_BAR; PG8_WAIT_L(0); PG8_MMA(0, 1, At, B1); PG8_BAR;
            PG8_LDA(At, 0, 1); PG8_STAGE(PG8_SA(0, 0), a2, voffA);
            PG8_BAR; PG8_WAIT_L(0); PG8_MMA(1, 0, At, B0); PG8_BAR; PG8_SCHED;
            PG8_STAGE(PG8_SB(0, 1), b2 + hstep, voffB);
            PG8_WAIT_V(6); PG8_BAR; PG8_MMA(1, 1, At, B1); PG8_BAR;
            PG8_LDB(B0, 1, 0); PG8_SCHED; PG8_LDA(At, 1, 0); PG8_STAGE(PG8_SA(0, 1), a2 + hstep, voffA);
            PG8_WAIT_L(8); PG8_BAR; PG8_WAIT_L(0); PG8_MMA(0, 0, At, B0); PG8_BAR; PG8_SCHED;
            PG8_LDB(B1, 1, 1); PG8_STAGE(PG8_SB(1, 0), b3, voffB);
            PG8_BAR; PG8_WAIT_L(0); PG8_MMA(0, 1, At, B1); PG8_BAR;
            PG8_LDA(At, 1, 1); PG8_STAGE(PG8_SA(1, 0), a3, voffA);
            PG8_BAR; PG8_WAIT_L(0); PG8_MMA(1, 0, At, B0); PG8_BAR; PG8_SCHED;
            PG8_STAGE(PG8_SB(1, 1), b3 + hstep, voffB);
            PG8_WAIT_V(6); PG8_BAR; PG8_MMA(1, 1, At, B1); PG8_BAR;
            }
        }
        if constexpr (ALIGN_EPI) { if (wr == 0) PG8_BAR; }
        if constexpr (!Epi::AFTER_DRAIN) { E(acc, cur, wr, wc, fr, fq); S.done(cur); }
        if (!has_next) break;
#pragma unroll
        for (int a = 0; a < 2; ++a)
#pragma unroll
            for (int b = 0; b < 2; ++b)
#pragma unroll
                for (int m = 0; m < 4; ++m)
#pragma unroll
                    for (int n = 0; n < 2; ++n) acc[a][b][m][n] = (f32x4){0.f, 0.f, 0.f, 0.f};
        cur = nxt; cA = nA; cB = nB; ++ui;
        if constexpr (ALIGN_EPI) { if (wr == 1) PG8_BAR; }
    }
    PG8_WAIT_V(0);
    if constexpr (!ALIGN_EPI) { if (wr == 0) PG8_BAR; }
    PG8_BAR;
    if constexpr (Epi::AFTER_DRAIN) { E.fused(acc, cur, wr, wc, fr, fq, lds, wid, lane); S.done(cur); }
#undef PG8_SA
#undef PG8_SB
#undef PG8_STAGE
#undef PG8_LDA
#undef PG8_LDB
#undef PG8_MMA
#undef PG8_WAIT_V
#undef PG8_WAIT_L
#undef PG8_BAR
#undef PG8_SCHED
}
}

namespace pg8 {
__device__ __forceinline__ float gelu_tanh(float x) {
    const float t = x * (1.5957691216057308f + 0.07135481627f * x * x);
    const float e = __builtin_amdgcn_exp2f(-1.4426950408889634f * t);
    return x * __builtin_amdgcn_rcpf(1.0f + e);
}
template <int ACT> struct EpiT {
    static constexpr bool PERM = true, AFTER_DRAIN = false;
    bf16_t* O; int ldc;
    __device__ __forceinline__ void operator()(const f32x4 (&acc)[2][2][4][2], const Unit& u, int wr, int wc, int fr, int fq) const {
        const int row0 = u.pm * BM + wr * 64 + fr; const int col0 = u.pn * BM + wc * 32 + 8 * fq;
#pragma unroll
        for (int ai = 0; ai < 2; ++ai)
#pragma unroll
            for (int m = 0; m < 4; ++m) { bf16_t* rowp = O + (size_t)(row0 + ai * HALF + m * 16) * ldc + col0;
#pragma unroll
                for (int bj = 0; bj < 2; ++bj) { f32x4 v0 = acc[ai][bj][m][0], v1 = acc[ai][bj][m][1];
                    if (ACT == 2) { v0 = (f32x4){gelu_tanh(v0[0]), gelu_tanh(v0[1]), gelu_tanh(v0[2]), gelu_tanh(v0[3])}; v1 = (f32x4){gelu_tanh(v1[0]), gelu_tanh(v1[1]), gelu_tanh(v1[2]), gelu_tanh(v1[3])}; }
                    u32x4 w; w.x = cvt_pk_bf16(v0[0], v0[1]); w.y = cvt_pk_bf16(v0[2], v0[3]); w.z = cvt_pk_bf16(v1[0], v1[1]); w.w = cvt_pk_bf16(v1[2], v1[3]);
                    *(u32x4*)(rowp + bj * HALF) = w; } }
    }
};
struct EpiR {
    static constexpr bool PERM = true, AFTER_DRAIN = false;
    bf16_t* O; int ldc; int act; int rope; const float* ropet;
    __device__ __forceinline__ void operator()(const f32x4 (&acc)[2][2][4][2], const Unit& u, int wr, int wc, int fr, int fq) const {
        const int row0 = u.pm * BM + wr * 64 + fr; const int col0 = u.pn * BM + wc * 32 + 8 * fq;
        const bool rrows = rope != 0 && u.pm < 64;
#pragma unroll
        for (int ai = 0; ai < 2; ++ai)
#pragma unroll
            for (int m = 0; m < 4; ++m) { const int grow = row0 + ai * HALF + m * 16; bf16_t* rowp = O + (size_t)grow * ldc + col0;
#pragma unroll
                for (int bj = 0; bj < 2; ++bj) { f32x4 v0 = acc[ai][bj][m][0], v1 = acc[ai][bj][m][1];
                    if (act) { v0 = (f32x4){gelu_tanh(v0[0]), gelu_tanh(v0[1]), gelu_tanh(v0[2]), gelu_tanh(v0[3])}; v1 = (f32x4){gelu_tanh(v1[0]), gelu_tanh(v1[1]), gelu_tanh(v1[2]), gelu_tanh(v1[3])}; }
                    if (rrows) { const int blk = u.pn * 8 + bj * 4 + wc; const int b6 = blk % 6; const bool on = rope == 1 ? (blk < 128) : (b6 >= 4); const int half = rope == 1 ? (blk & 1) : (b6 - 4);
                        if (on) { const int t = grow & 8191; const int pos = half ? (t & 63) : (t >> 6);
                            const float* cp = ropet + pos * 16 + 8 * (fq & 1); const f32x4 c0 = *(const f32x4*)cp, c1 = *(const f32x4*)(cp + 4), s0 = *(const f32x4*)(cp + 2048), s1 = *(const f32x4*)(cp + 2052);
                            f32x4 p0, p1;
#pragma unroll
                            for (int i = 0; i < 4; ++i) { const float a_ = v0[i], b_ = v1[i];
                                const auto r0 = __builtin_amdgcn_permlane32_swap(__float_as_uint(a_), __float_as_uint(a_), false, false);
                                const auto r1 = __builtin_amdgcn_permlane32_swap(__float_as_uint(b_), __float_as_uint(b_), false, false);
                                const unsigned x0_ = (fq & 2) ? r0[0] : r0[1], x1_ = (fq & 2) ? r1[0] : r1[1]; p0[i] = __uint_as_float(x0_); p1[i] = __uint_as_float(x1_); }
                            if (fq & 2) { v0 = p0 * s0 + v0 * c0; v1 = p1 * s1 + v1 * c1; } else { v0 = v0 * c0 - p0 * s0; v1 = v1 * c1 - p1 * s1; } } }
                    u32x4 w; w.x = cvt_pk_bf16(v0[0], v0[1]); w.y = cvt_pk_bf16(v0[2], v0[3]); w.z = cvt_pk_bf16(v1[0], v1[1]); w.w = cvt_pk_bf16(v1[2], v1[3]);
                    *(u32x4*)(rowp + bj * HALF) = w; } }
    }
};
}

constexpr int DM = 2048, NBATCH = 2, SEQ = 8192, CTXL = 256;
constexpr int ML = NBATCH * SEQ;
constexpr int MC = NBATCH * CTXL;
constexpr int MT = ML + MC;
constexpr int NLAYER = 4;
constexpr float ALPHA = 1.6817928305074290f, LN_EPS = 1e-6f;
constexpr int NWAVES = 8;
constexpr float U_SCALE = 64.0f, V_SCALE = 4.0f;
constexpr int PROW = 1536;
constexpr int PREC = 2 * PROW;
constexpr int NPH = 35;

constexpr size_t MiB = 1ull << 20;
constexpr size_t WS_CTL = 0, CTL_ZERO_BYTES = 1 * MiB;
constexpr int    CW_BAR = 4096;
constexpr size_t WS_MOD = 128 * 1024;
constexpr size_t WS_VST = 1 * MiB;
constexpr size_t WS_ROPE = 1 * MiB + 160 * 1024;
constexpr size_t WS_MODP = 1 * MiB + 256 * 1024;
constexpr size_t WS_GMWIN = 6 * MiB;
constexpr size_t WS_GMWOUT = WS_GMWIN + 32 * MiB;
constexpr size_t WS_GMWS = WS_GMWOUT + 16 * MiB;
constexpr size_t WS_PWQ = WS_GMWS + 1 * MiB;
constexpr size_t WS_PK1 = WS_PWQ + 32 * MiB;
constexpr size_t WS_PK2 = WS_PK1 + 512 * 1024;
constexpr size_t WS_MLAIN = WS_PK1 + 1 * MiB;
constexpr size_t WS_MLAUQ = WS_MLAIN + 5 * MiB;
constexpr size_t WS_MLAUKV = WS_MLAUQ + 3 * MiB;
constexpr size_t WS_MLAOUT = WS_MLAUKV + 4 * MiB;
constexpr size_t WS_DAIN = WS_MLAOUT + 8 * MiB;
constexpr size_t WS_DAOUT = WS_DAIN + 24 * MiB;
constexpr size_t WS_PU = WS_DAOUT + 8 * MiB;
constexpr size_t WS_PV = WS_PU + 96 * MiB;
constexpr size_t WS_X = WS_PV + 96 * MiB;
constexpr size_t WS_H = WS_X + 66 * MiB;
constexpr size_t WS_G = WS_H + 66 * MiB;
constexpr size_t WS_Y = WS_G + 66 * MiB;
constexpr size_t WS_QP = WS_Y + 66 * MiB;
constexpr size_t WS_Z = WS_QP + 66 * MiB;
constexpr size_t WS_C = WS_Z + 198 * MiB;
constexpr size_t WS_CQN = WS_C + 42 * MiB;
constexpr size_t WS_CKVN = WS_CQN + 17 * MiB;
constexpr size_t WS_KR = WS_CKVN + 17 * MiB;
constexpr size_t WS_QM = WS_KR + 3 * MiB;
constexpr size_t WS_KV = WS_QM + 99 * MiB;
constexpr size_t WS_ROUTE = WS_KV + 132 * MiB;
constexpr size_t WS_END = WS_ROUTE + 17 * MiB;
static_assert((size_t)MT * DM * 2 == 66 * MiB, "row buffer size");

constexpr int RING_BYTES = 155648, MISC_OFF = RING_BYTES + 320, LDS_BYTES = 159744;

#define GAS __attribute__((address_space(1)))
#define LAS __attribute__((address_space(3)))
typedef unsigned short bf16;
typedef unsigned u32x4 __attribute__((ext_vector_type(4)));
typedef unsigned u32x2 __attribute__((ext_vector_type(2)));
typedef float f32x4 __attribute__((ext_vector_type(4)));
typedef float f32x16 __attribute__((ext_vector_type(16)));
typedef short bf16x8 __attribute__((ext_vector_type(8)));
typedef short s16x4 __attribute__((ext_vector_type(4)));
#define LDS_WAIT() asm volatile("s_waitcnt lgkmcnt(0)" ::: "memory")

__device__ __forceinline__ unsigned cvtpk(float lo, float hi) { unsigned r; asm("v_cvt_pk_bf16_f32 %0, %1, %2" : "=v"(r) : "v"(lo), "v"(hi)); return r; }
__device__ __forceinline__ float bflo(unsigned w) { return __uint_as_float(w << 16); }
__device__ __forceinline__ float bfhi(unsigned w) { return __uint_as_float(w & 0xffff0000u); }
__device__ __forceinline__ float bf1(bf16 b) { return __uint_as_float((unsigned)b << 16); }
__device__ __forceinline__ bf16 tobf1(float f) { return (bf16)(cvtpk(f, 0.f) & 0xffffu); }
#define DPP_F(v, ctrl) __int_as_float(__builtin_amdgcn_mov_dpp(__float_as_int(v), (ctrl), 0xF, 0xF, true))
__device__ __forceinline__ float row_sum16(float v) { v += DPP_F(v, 0xB1); v += DPP_F(v, 0x4E); v += DPP_F(v, 0x141); v += DPP_F(v, 0x140); return v; }
__device__ __forceinline__ float sum_xor16(float v) { const auto r = __builtin_amdgcn_permlane16_swap(__float_as_uint(v), __float_as_uint(v), false, false); return __uint_as_float(r[0]) + __uint_as_float(r[1]); }
__device__ __forceinline__ float sum_xor32(float v) { const auto r = __builtin_amdgcn_permlane32_swap(__float_as_uint(v), __float_as_uint(v), false, false); return __uint_as_float(r[0]) + __uint_as_float(r[1]); }
__device__ __forceinline__ float wave_sum(float v) { return sum_xor32(sum_xor16(row_sum16(v))); }
__device__ __forceinline__ float half_sum32(float v) { return sum_xor16(row_sum16(v)); }
__device__ __forceinline__ float lane_xor16(float v, int lane) { const auto r = __builtin_amdgcn_permlane16_swap(__float_as_uint(v), __float_as_uint(v), false, false); return __uint_as_float((lane & 16) ? r[0] : r[1]); }
__device__ __forceinline__ unsigned lane_xor32(unsigned v, int lane) { const auto r = __builtin_amdgcn_permlane32_swap(v, v, false, false); return (lane & 32) ? r[0] : r[1]; }
__device__ __forceinline__ float gelu_tanh(float x) { return pg8::gelu_tanh(x); }

__device__ __forceinline__ void load_row_bf16(const bf16* row, int lane, float (&v)[32]) {
#pragma unroll
    for (int j = 0; j < 4; ++j) { const u32x4 w = ((const u32x4*)row)[64 * j + lane];
        v[8 * j + 0] = bflo(w.x); v[8 * j + 1] = bfhi(w.x); v[8 * j + 2] = bflo(w.y); v[8 * j + 3] = bfhi(w.y);
        v[8 * j + 4] = bflo(w.z); v[8 * j + 5] = bfhi(w.z); v[8 * j + 6] = bflo(w.w); v[8 * j + 7] = bfhi(w.w); }
}
__device__ __forceinline__ void store_row_bf16(bf16* row, int lane, const float (&v)[32]) {
#pragma unroll
    for (int j = 0; j < 4; ++j) { u32x4 w; w.x = cvtpk(v[8 * j + 0], v[8 * j + 1]); w.y = cvtpk(v[8 * j + 2], v[8 * j + 3]); w.z = cvtpk(v[8 * j + 4], v[8 * j + 5]); w.w = cvtpk(v[8 * j + 6], v[8 * j + 7]);
        ((u32x4*)row)[64 * j + lane] = w; }
}
__device__ __forceinline__ void load_row_f32(const float* row, int lane, float (&v)[32]) {
#pragma unroll
    for (int j = 0; j < 4; ++j) { const f32x4 a = ((const f32x4*)row)[128 * j + 2 * lane], b = ((const f32x4*)row)[128 * j + 2 * lane + 1];
        v[8 * j + 0] = a.x; v[8 * j + 1] = a.y; v[8 * j + 2] = a.z; v[8 * j + 3] = a.w; v[8 * j + 4] = b.x; v[8 * j + 5] = b.y; v[8 * j + 6] = b.z; v[8 * j + 7] = b.w; }
}
__device__ __forceinline__ void store_row_f32(float* row, int lane, const float (&v)[32]) {
#pragma unroll
    for (int j = 0; j < 4; ++j) { ((f32x4*)row)[128 * j + 2 * lane] = (f32x4){v[8 * j + 0], v[8 * j + 1], v[8 * j + 2], v[8 * j + 3]};
        ((f32x4*)row)[128 * j + 2 * lane + 1] = (f32x4){v[8 * j + 4], v[8 * j + 5], v[8 * j + 6], v[8 * j + 7]}; }
}
__device__ __forceinline__ void load_row_bf16_b(const bf16* row, int lane, float (&v)[32]) {
#pragma unroll
    for (int j = 0; j < 4; ++j) { const u32x4 w = ((const u32x4*)row)[4 * lane + j];
        v[8 * j + 0] = bflo(w.x); v[8 * j + 1] = bfhi(w.x); v[8 * j + 2] = bflo(w.y); v[8 * j + 3] = bfhi(w.y);
        v[8 * j + 4] = bflo(w.z); v[8 * j + 5] = bfhi(w.z); v[8 * j + 6] = bflo(w.w); v[8 * j + 7] = bfhi(w.w); }
}
__device__ __forceinline__ void store_row_bf16_b(bf16* row, int lane, const float (&v)[32]) {
#pragma unroll
    for (int j = 0; j < 4; ++j) { u32x4 w; w.x = cvtpk(v[8 * j + 0], v[8 * j + 1]); w.y = cvtpk(v[8 * j + 2], v[8 * j + 3]); w.z = cvtpk(v[8 * j + 4], v[8 * j + 5]); w.w = cvtpk(v[8 * j + 6], v[8 * j + 7]);
        ((u32x4*)row)[4 * lane + j] = w; }
}
__device__ __forceinline__ void load_row_f32_b(const float* row, int lane, float (&v)[32]) {
#pragma unroll
    for (int q = 0; q < 8; ++q) { const f32x4 a = ((const f32x4*)row)[8 * lane + q];
        v[4 * q + 0] = a.x; v[4 * q + 1] = a.y; v[4 * q + 2] = a.z; v[4 * q + 3] = a.w; }
}
__device__ __forceinline__ void store_row_f32_b(float* row, int lane, const float (&v)[32]) {
#pragma unroll
    for (int q = 0; q < 8; ++q) ((f32x4*)row)[8 * lane + q] = (f32x4){v[4 * q + 0], v[4 * q + 1], v[4 * q + 2], v[4 * q + 3]};
}
__device__ __forceinline__ void ln_stats(const float (&v)[32], float& mean, float& rstd) {
    float s = 0.f;
#pragma unroll
    for (int i = 0; i < 32; ++i) s += v[i];
    mean = wave_sum(s) * (1.0f / DM);
    float q = 0.f;
#pragma unroll
    for (int i = 0; i < 32; ++i) { const float d = v[i] - mean; q += d * d; }
    rstd = 1.0f / sqrtf(wave_sum(q) * (1.0f / DM) + LN_EPS);
}
template <bool LAYB>
__device__ __forceinline__ void finish_row(float (&z)[32], const float* lng, const float* lnb, bf16* Xrow, const float* sh, const float* sc, bf16* Hrow, float* Orow, int lane) {
    float mean, rstd; ln_stats(z, mean, rstd);
    { float g[32], b[32]; if (LAYB) { load_row_f32_b(lng, lane, g); load_row_f32_b(lnb, lane, b); } else { load_row_f32(lng, lane, g); load_row_f32(lnb, lane, b); }
#pragma unroll
      for (int i = 0; i < 32; ++i) z[i] = (z[i] - mean) * rstd * g[i] + b[i]; }
    if (Xrow) { if (LAYB) store_row_bf16_b(Xrow, lane, z); else store_row_bf16(Xrow, lane, z); }
    if (Orow) { if (LAYB) store_row_f32_b(Orow, lane, z); else store_row_f32(Orow, lane, z); }
    if (Hrow) {
        ln_stats(z, mean, rstd);
        float a[32], s[32]; if (LAYB) { load_row_f32_b(sc, lane, a); load_row_f32_b(sh, lane, s); } else { load_row_f32(sc, lane, a); load_row_f32(sh, lane, s); }
#pragma unroll
        for (int i = 0; i < 32; ++i) a[i] = (z[i] - mean) * rstd * (1.0f + a[i]) + s[i];
        if (LAYB) store_row_bf16_b(Hrow, lane, a); else store_row_bf16(Hrow, lane, a);
    }
}
__device__ __forceinline__ int row_slot(int row) { return row < ML ? (row >> 13) : 2; }

__device__ __forceinline__ unsigned f2bf_rne(float f) { unsigned u = __float_as_uint(f); return (u + 0x7fffu + ((u >> 16) & 1u)) >> 16; }
__device__ __forceinline__ unsigned pk2(float lo, float hi) { return f2bf_rne(lo) | (f2bf_rne(hi) << 16); }
__device__ __forceinline__ void p0_transpose_item(const float* W, int K, int N, bf16* WT, LAS float* scr, int item, int lane) {
    const int nblk = N / 32, kb = item / nblk, nb = item % nblk, k0 = 64 * kb, n0 = 32 * nb;
    f32x4 t[8];
#pragma unroll
    for (int i = 0; i < 8; ++i) t[i] = *(const f32x4*)(W + (size_t)(k0 + 8 * i + (lane >> 3)) * N + n0 + 4 * (lane & 7));
#pragma unroll
    for (int i = 0; i < 8; ++i) { LAS float* d = scr + (8 * i + (lane >> 3)) * 33 + 4 * (lane & 7); d[0] = t[i].x; d[1] = t[i].y; d[2] = t[i].z; d[3] = t[i].w; }
    LDS_WAIT(); asm volatile("" ::: "memory");
    const int c = lane & 7;
#pragma unroll
    for (int j = 0; j < 4; ++j) { const int n = (lane >> 3) + 8 * j; const LAS float* s = scr + (8 * c) * 33 + n;
        u32x4 o; o.x = pk2(s[0 * 33], s[1 * 33]); o.y = pk2(s[2 * 33], s[3 * 33]); o.z = pk2(s[4 * 33], s[5 * 33]); o.w = pk2(s[6 * 33], s[7 * 33]);
        *(u32x4*)(WT + (size_t)(n0 + n) * K + k0 + 8 * c) = o; }
    LDS_WAIT(); asm volatile("" ::: "memory");
}
__device__ __forceinline__ void cvt_range(const float* src, bf16* dst, size_t n8, size_t gtid, size_t gthreads) {
#pragma unroll 4
    for (size_t i = gtid; i < n8; i += gthreads) { const f32x4 a = ((const f32x4*)src)[2 * i], b = ((const f32x4*)src)[2 * i + 1];
        u32x4 w; w.x = cvtpk(a.x, a.y); w.y = cvtpk(a.z, a.w); w.z = cvtpk(b.x, b.y); w.w = cvtpk(b.z, b.w); ((u32x4*)dst)[i] = w; }
}
__device__ __forceinline__ unsigned enc_e2m3(float x) {
    const unsigned sgn = (__float_as_uint(x) >> 26) & 32u;
    const float ax = fminf(fabsf(x), 7.5f);
    unsigned u = __float_as_uint(ax); u += 0x7FFFFu + ((u >> 20) & 1u);
    const unsigned cn = (u >> 20) - ((127u - 1u) << 3);
    const unsigned cs = (unsigned)__builtin_rintf(ax * 8.0f);
    return sgn | (ax < 1.0f ? cs : cn);
}
#ifndef CVT_PIPE
#define CVT_PIPE 0
#endif
typedef float f32x16v __attribute__((ext_vector_type(16)));
typedef float f32x32v __attribute__((ext_vector_type(32)));
typedef unsigned u32x6v __attribute__((ext_vector_type(6)));
__device__ __forceinline__ u32x6v pack_fp6_32(const float (&e)[32], bool interleaved) {
    f32x16v s0, s1;
    if (interleaved) {
#pragma unroll
        for (int i = 0; i < 16; ++i) { s0[i] = e[2 * i]; s1[i] = e[2 * i + 1]; }
    } else {
#pragma unroll
        for (int i = 0; i < 16; ++i) { s0[i] = e[i]; s1[i] = e[16 + i]; }
    }
    return __builtin_amdgcn_cvt_scalef32_2xpk16_fp6_f32(s0, s1, 1.0f);
}
__device__ __forceinline__ void cvt_table_fp6(const float* src, unsigned char* dst, int nrows, float scale, LAS float* scr  , int lane, int gw, int NGW, const int isv) {
    bool interleaved;
    {
        float t[32];
#pragma unroll
        for (int k = 0; k < 32; ++k) t[k] = k < 16 ? 0.125f * k : (k < 24 ? 2.0f + 0.25f * (k - 16) : 4.0f + 0.5f * (k - 24));
        float tt[32];
#pragma unroll
        for (int k = 0; k < 32; ++k) { tt[k] = t[k]; asm volatile("" : "+v"(tt[k])); }
        const u32x6v p = pack_fp6_32(tt, true);
        const f32x32v o = __builtin_amdgcn_cvt_scalef32_pk32_f32_fp6(p, 1.0f);
        interleaved = (o[1] == t[1]) && (o[2] == t[2]) && (o[17] == t[17]);
        interleaved = __all(interleaved);
    }
#if CVT_PIPE
    f32x4 nx[8];
    if (gw < nrows) { const f32x4* s4 = (const f32x4*)(src + (size_t)gw * 2048);
#pragma unroll
        for (int q = 0; q < 8; ++q) nx[q] = s4[64 * q + lane]; }
    for (int row = gw; row < nrows; row += NGW) {
        f32x4 cur[8];
#pragma unroll
        for (int q = 0; q < 8; ++q) cur[q] = nx[q];
        if (row + NGW < nrows) { const f32x4* s4 = (const f32x4*)(src + (size_t)(row + NGW) * 2048);
#pragma unroll
            for (int q = 0; q < 8; ++q) nx[q] = s4[64 * q + lane]; }
#pragma unroll
        for (int q = 0; q < 8; ++q) { const int s = 64 * q + lane; const f32x4 a = cur[q] * scale; *(LAS f32x4*)(scr + 4 * (s ^ ((s >> 4) & 7))) = a; }
#else
    for (int row = gw; row < nrows; row += NGW) {
        const f32x4* s4 = (const f32x4*)(src + (size_t)row * 2048);
#pragma unroll
        for (int q = 0; q < 8; ++q) { const int s = 64 * q + lane; const f32x4 a = s4[s] * scale; *(LAS f32x4*)(scr + 4 * (s ^ ((s >> 4) & 7))) = a; }
#endif
        float e[32];
#pragma unroll
        for (int j = 0; j < 8; ++j) { const int s = 8 * lane + j; const f32x4 a = *(const LAS f32x4*)(scr + 4 * (s ^ ((s >> 4) & 7)));
            e[4 * j + 0] = __builtin_amdgcn_fmed3f(a.x, -7.5f, 7.5f); e[4 * j + 1] = __builtin_amdgcn_fmed3f(a.y, -7.5f, 7.5f); e[4 * j + 2] = __builtin_amdgcn_fmed3f(a.z, -7.5f, 7.5f); e[4 * j + 3] = __builtin_amdgcn_fmed3f(a.w, -7.5f, 7.5f); }
        const u32x6v p = pack_fp6_32(e, interleaved);
        unsigned char* rowp = dst + (size_t)row * PREC;
        *(u32x4*)(rowp + 1024 * isv + 16 * lane) = (u32x4){p[0], p[1], p[2], p[3]}; *(u32x2*)(rowp + 2048 + 512 * isv + 8 * lane) = (u32x2){p[4], p[5]};
    }
}
__device__ __forceinline__ float silu(float x) { return x / (1.0f + __expf(-x)); }

struct Params { const float* in[29]; float* out; unsigned char* ws; int ph_lo, ph_hi; };
typedef const __attribute__((address_space(4))) Params* CP;

#ifndef TAIL_REMAP
#define TAIL_REMAP 0
#endif
__device__ __forceinline__ void p0_prologue(CP P, LAS unsigned char* lds, int tid, int lane, int wid, int gw, int NGW, const int parts = 7) {
    unsigned char* ws = P->ws;
    LAS float* scr = (LAS float*)(lds + wid * 16384);
    if (parts & 1) {
        constexpr int I_GMIN = (2048 / 64) * (4096 / 32), I_SQ = (2048 / 64) * (2048 / 32), I_MIN = (2048 / 64) * (1088 / 32), I_UQ = (512 / 64) * (3072 / 32), I_UKV = (512 / 64) * (4096 / 32), I_DIN = (2048 / 64) * (6144 / 32);
        constexpr int NIT = 2 * I_GMIN + 2 * I_SQ + 4 * I_SQ + I_MIN + I_UQ + I_UKV + I_SQ + I_DIN + I_SQ;
        for (int it = gw; it < NIT; it += NGW) {
            int r = it;
            if (r < 2 * I_GMIN) { const int j = r / I_GMIN; p0_transpose_item(P->in[13] + (size_t)j * 2048 * 4096, 2048, 4096, (bf16*)(ws + WS_GMWIN) + (size_t)j * 4096 * 2048, scr, r % I_GMIN, lane); continue; } r -= 2 * I_GMIN;
            if (r < 2 * I_SQ) { const int j = r / I_SQ; p0_transpose_item(P->in[18] + (size_t)j * 2048 * 2048, 2048, 2048, (bf16*)(ws + WS_GMWOUT) + (size_t)j * 2048 * 2048, scr, r % I_SQ, lane); continue; } r -= 2 * I_SQ;
            if (r < 4 * I_SQ) { const int j = r / I_SQ; p0_transpose_item(P->in[8] + (size_t)j * 2048 * 2048, 2048, 2048, (bf16*)(ws + WS_PWQ) + (size_t)j * 2048 * 2048, scr, r % I_SQ, lane); continue; } r -= 4 * I_SQ;
            if (r < I_MIN) { p0_transpose_item(P->in[19], 2048, 1088, (bf16*)(ws + WS_MLAIN), scr, r, lane); continue; } r -= I_MIN;
            if (r < I_UQ) { p0_transpose_item(P->in[22], 512, 3072, (bf16*)(ws + WS_MLAUQ), scr, r, lane); continue; } r -= I_UQ;
            if (r < I_UKV) { p0_transpose_item(P->in[23], 512, 4096, (bf16*)(ws + WS_MLAUKV), scr, r, lane); continue; } r -= I_UKV;
            if (r < I_SQ) { p0_transpose_item(P->in[24], 2048, 2048, (bf16*)(ws + WS_MLAOUT), scr, r, lane); continue; } r -= I_SQ;
            if (r < I_DIN) { p0_transpose_item(P->in[25], 2048, 6144, (bf16*)(ws + WS_DAIN), scr, r, lane); continue; } r -= I_DIN;
            p0_transpose_item(P->in[28], 2048, 2048, (bf16*)(ws + WS_DAOUT), scr, r, lane);
        }
    }
    const size_t gtid = (size_t)gw * 64 + lane, gthreads = (size_t)NGW * 64;
    if (parts & 2) {
    { u32x4* z = (u32x4*)((bf16*)(ws + WS_MLAIN) + (size_t)1088 * 2048); const size_t n = (size_t)192 * 2048 / 8;
      for (size_t i = gtid; i < n; i += gthreads) z[i] = (u32x4){0u, 0u, 0u, 0u}; }
    cvt_range(P->in[16], (bf16*)(ws + WS_GMWS), (size_t)2 * 16 * 128 * 128 / 8, gtid, gthreads);
    cvt_range(P->in[9], (bf16*)(ws + WS_PK1), (size_t)4 * 128 * 128 / 8, gtid, gthreads);
    cvt_range(P->in[10], (bf16*)(ws + WS_PK2), (size_t)4 * 128 * 128 / 8, gtid, gthreads);
#if !TAIL_REMAP
    cvt_table_fp6(P->in[11], ws + WS_PU, 16384, U_SCALE, scr, lane, gw, NGW, 0);
    cvt_table_fp6(P->in[12], ws + WS_PU, 16384, V_SCALE, scr, lane, gw, NGW, 1);
#endif
    if (gtid < 2048) { const int pos = (int)gtid >> 4, f = (int)gtid & 15; const float inv = powf(10000.0f, -(float)f * (1.0f / 16.0f)); float sn, cs; sincosf((float)pos * inv, &sn, &cs);
        float* rt = (float*)(ws + WS_ROPE); rt[gtid] = cs; rt[2048 + gtid] = sn; }
    }
    if (parts & 4) {
        const float* cv = P->in[1]; const float* cc = P->in[3]; const float* mw = P->in[4]; float* PART = (float*)(ws + WS_MODP);
        LAS float* S = (LAS float*)lds;
        __syncthreads();
        for (int i = tid; i < 3 * 2048; i += NWAVES * 64) { const int sl = i >> 11, kk = i & 2047; S[i] = silu(sl == 0 ? cv[kk] : (sl == 1 ? cv[2048 + kk] : cc[kk])); }
        __syncthreads();
        for (int item = gw; item < 4 * 192 * 8; item += NGW) {
            const int ks = item & 7, r = item >> 3, L = r / 192, n = (r % 192) * 64 + lane;
            const float* W = mw + (size_t)L * 2048 * 12288 + (size_t)(ks * 256) * 12288 + n;
            float a0 = 0.f, a1 = 0.f, a2 = 0.f;
#pragma unroll 32
            for (int k = 0; k < 256; ++k) { const int kk = ks * 256 + k; const float s0 = S[kk], s1 = S[2048 + kk], s2 = S[4096 + kk];
                const float w = W[(size_t)k * 12288]; a0 += s0 * w; a1 += s1 * w; a2 += s2 * w; }
            float* o = PART + ((size_t)ks * 4 + L) * 3 * 12288 + n;
            o[0] = a0; o[12288] = a1; o[24576] = a2;
        }
    }
}
__device__ __forceinline__ void mod_reduce(CP P, int gw, int lane, int NGW) {
    const float* PART = (const float*)(P->ws + WS_MODP); float* MOD = (float*)(P->ws + WS_MOD); const float* mb = P->in[5];
    for (int i = gw * 64 + lane; i < 4 * 3 * 12288; i += NGW * 64) {
        const int L = i / (3 * 12288), n = i % 12288;
        float s = mb[(size_t)L * 12288 + n];
#pragma unroll
        for (int ks = 0; ks < 8; ++ks) s += PART[(size_t)ks * 4 * 3 * 12288 + i];
        MOD[i] = s;
    }
}

__device__ __forceinline__ void first_row_pass(CP P, int lane, int gw, int NGW) {
    const float* MOD = (const float*)(P->ws + WS_MOD); bf16* X = (bf16*)(P->ws + WS_X); bf16* H = (bf16*)(P->ws + WS_H);
    for (int row = gw; row < MT; row += NGW) {
        const float* src = row < ML ? P->in[0] + (size_t)row * DM : P->in[2] + (size_t)(row - ML) * DM;
        float v[32]; load_row_f32(src, lane, v);
        store_row_bf16(X + (size_t)row * DM, lane, v);
        const float* mod = MOD + (size_t)row_slot(row) * 12288;
        float mean, rstd; ln_stats(v, mean, rstd);
        float a[32], s[32]; load_row_f32(mod + 2048, lane, a); load_row_f32(mod, lane, s);
#pragma unroll
        for (int i = 0; i < 32; ++i) a[i] = (v[i] - mean) * rstd * (1.0f + a[i]) + s[i];
        store_row_bf16(H + (size_t)row * DM, lane, a);
    }
}
#ifndef POSTMIX_LDS
#define POSTMIX_LDS 1
#endif
__device__ __forceinline__ void load_row_f32_l(const LAS float* row, int lane, float (&v)[32]) {
#pragma unroll
    for (int j = 0; j < 4; ++j) { const f32x4 a = ((const LAS f32x4*)row)[128 * j + 2 * lane], b = ((const LAS f32x4*)row)[128 * j + 2 * lane + 1];
        v[8 * j + 0] = a.x; v[8 * j + 1] = a.y; v[8 * j + 2] = a.z; v[8 * j + 3] = a.w; v[8 * j + 4] = b.x; v[8 * j + 5] = b.y; v[8 * j + 6] = b.z; v[8 * j + 7] = b.w; }
}
__device__ __forceinline__ void post_mixer_pass_lds(CP P, int L, int Mrows, LAS unsigned char* lds, int tid, int lane, int gw, int NGW) {
    const float* MOD = (const float*)(P->ws + WS_MOD); bf16* X = (bf16*)(P->ws + WS_X); bf16* H = (bf16*)(P->ws + WS_H); const bf16* Y = (const bf16*)(P->ws + WS_Y);
    const float* lng = P->in[6] + (size_t)(L * 2 + 0) * DM; const float* lnb = P->in[7] + (size_t)(L * 2 + 0) * DM;
    LAS float* V = (LAS float*)lds;
    __syncthreads();
    for (int i = tid; i < 11 * 512; i += NWAVES * 64) { const int vec = i >> 9, g4 = i & 511;
        const float* src = vec == 0 ? lng : (vec == 1 ? lnb : MOD + (size_t)(L * 3 + (vec - 2) / 3) * 12288 + (size_t)(2 + (vec - 2) % 3) * 2048);
        ((LAS f32x4*)V)[i] = ((const f32x4*)src)[g4]; }
    __syncthreads();
    for (int row = gw; row < Mrows; row += NGW) {
        const LAS float* mv = V + (2 + 3 * row_slot(row)) * 2048;
        float z[32], y[32]; load_row_bf16(X + (size_t)row * DM, lane, z); load_row_bf16(Y + (size_t)row * DM, lane, y);
        { float g[32]; load_row_f32_l(mv, lane, g);
#pragma unroll
          for (int i = 0; i < 32; ++i) z[i] = ALPHA * z[i] + g[i] * y[i]; }
        float mean, rstd; ln_stats(z, mean, rstd);
        { float g[32], b[32]; load_row_f32_l(V, lane, g); load_row_f32_l(V + 2048, lane, b);
#pragma unroll
          for (int i = 0; i < 32; ++i) z[i] = (z[i] - mean) * rstd * g[i] + b[i]; }
        store_row_bf16(X + (size_t)row * DM, lane, z);
        ln_stats(z, mean, rstd);
        { float a[32], s_[32]; load_row_f32_l(mv + 2 * 2048, lane, a); load_row_f32_l(mv + 2048, lane, s_);
#pragma unroll
          for (int i = 0; i < 32; ++i) a[i] = (z[i] - mean) * rstd * (1.0f + a[i]) + s_[i];
          store_row_bf16(H + (size_t)row * DM, lane, a); }
    }
}
__device__ __forceinline__ void post_mixer_pass(CP P, int L, int Mrows, int lane, int gw, int NGW) {
    const float* MOD = (const float*)(P->ws + WS_MOD); bf16* X = (bf16*)(P->ws + WS_X); bf16* H = (bf16*)(P->ws + WS_H); const bf16* Y = (const bf16*)(P->ws + WS_Y);
    const float* lng = P->in[6] + (size_t)(L * 2 + 0) * DM; const float* lnb = P->in[7] + (size_t)(L * 2 + 0) * DM;
    for (int row = gw; row < Mrows; row += NGW) {
        const float* mod = MOD + (size_t)(L * 3 + row_slot(row)) * 12288;
        float z[32], y[32], g[32]; load_row_bf16(X + (size_t)row * DM, lane, z); load_row_bf16(Y + (size_t)row * DM, lane, y); load_row_f32(mod + 2 * 2048, lane, g);
#pragma unroll
        for (int i = 0; i < 32; ++i) z[i] = ALPHA * z[i] + g[i] * y[i];
        finish_row<false>(z, lng, lnb, X + (size_t)row * DM, mod + 3 * 2048, mod + 4 * 2048, H + (size_t)row * DM, nullptr, lane);
    }
}
__device__ __forceinline__ void vstats_pass(CP P, int Mrows, int lane, int gw, int NGW) {
    const bf16* Z = (const bf16*)(P->ws + WS_Z); float* VST = (float*)(P->ws + WS_VST);
    for (int row = gw; row < Mrows; row += NGW) {
        float v[32]; load_row_bf16(Z + (size_t)row * 4096 + 2048, lane, v);
        float mean, rstd; ln_stats(v, mean, rstd);
        if (lane == 0) { VST[2 * row] = mean; VST[2 * row + 1] = rstd; }
    }
}
#define XB_TMO      128
#define XB_XCNT(j)  (256  + 64 * (j))
#define XB_XSUB(j)  (1280 + 64 * (j))
#define XB_XGEN(j)  (2304 + 64 * (j))
#define XB_TOP      3328
#define XB_TOPGEN   3392
#define XCD_BAR_WORDS 3456
#define XB_SPIN_CAP (1u << 18)

__device__ __forceinline__ unsigned xb_ld(unsigned* p)              { return __hip_atomic_load(p, __ATOMIC_RELAXED, __HIP_MEMORY_SCOPE_AGENT); }
__device__ __forceinline__ unsigned xb_add(unsigned* p, unsigned v) { return __hip_atomic_fetch_add(p, v, __ATOMIC_RELAXED, __HIP_MEMORY_SCOPE_AGENT); }
__device__ __forceinline__ unsigned xb_xcc_id() { return (unsigned)__builtin_amdgcn_s_getreg((3 << 11) | 20) & 0xFu; }
#define XB_SPIN(cond, bar) do { unsigned _sp = 0; while (cond) { __builtin_amdgcn_s_sleep(1); \
    if ((++_sp & 255u) == 0u) { if (xb_ld(&(bar)[XB_TMO])) break; if (_sp > XB_SPIN_CAP) { atomicAdd(&(bar)[XB_TMO], 1u); break; } } } } while (0)

struct XcdBarrier {
    unsigned* bar; unsigned x;
    volatile LAS unsigned* st;
};

__device__ __forceinline__ XcdBarrier xcd_barrier_post(unsigned* bar, volatile LAS unsigned* st, const bool t0) {
    XcdBarrier b; b.bar = bar; b.x = xb_xcc_id(); b.st = st;
    if (t0) (void)xb_add(&bar[XB_XCNT(b.x)], 1u);
    return b;
}
__device__ __forceinline__ void xcd_barrier_complete(unsigned* bar, unsigned x, unsigned& nloc, unsigned& nx) {
    const unsigned G = gridDim.x * gridDim.y * gridDim.z;
    unsigned sum, cnt, mine, sp = 0u;
    for (;;) {
        sum = 0u; cnt = 0u; mine = 0u;
#pragma unroll
        for (unsigned j = 0; j < 16; ++j) { const unsigned c = xb_ld(&bar[XB_XCNT(j)]); sum += c; cnt += (c > 0u) ? 1u : 0u; mine = (j == x) ? c : mine; }
        if (sum == G) break;
        __builtin_amdgcn_s_sleep(1);
        if ((++sp & 255u) == 0u) { if (xb_ld(&bar[XB_TMO])) break; if (sp > XB_SPIN_CAP) { atomicAdd(&bar[XB_TMO], 1u); break; } }
    }
    nloc = mine > 0u ? mine : 1u; nx = cnt > 0u ? cnt : 1u;
}

__device__ __attribute__((noinline)) void xcd_barrier(const XcdBarrier b, const bool t0) {
    asm volatile("s_waitcnt vmcnt(0)" ::: "memory");
    __syncthreads();
    if (t0) {
        unsigned* bar = b.bar;
        __builtin_amdgcn_s_waitcnt(0);
        unsigned nloc = b.st[0], nx = b.st[1];
        if (nloc == 0u) { xcd_barrier_complete(bar, b.x, nloc, nx); b.st[0] = nloc; b.st[1] = nx; }
        const unsigned old = xb_add(&bar[XB_XSUB(b.x)], 1u);
        const unsigned gen = old / nloc;
        if (old + 1u == (gen + 1u) * nloc) {
            __builtin_amdgcn_fence(__ATOMIC_RELEASE, "agent");
            asm volatile("s_waitcnt vmcnt(0)" ::: "memory");
            const unsigned og = xb_add(&bar[XB_TOP], 1u);
            const unsigned tg = og / nx;
            if (og + 1u == (tg + 1u) * nx) xb_add(&bar[XB_TOPGEN], 1u);
            else XB_SPIN(xb_ld(&bar[XB_TOPGEN]) == tg, bar);
            __builtin_amdgcn_fence(__ATOMIC_ACQUIRE, "agent");
            xb_add(&bar[XB_XGEN(b.x)], 1u);
            asm volatile("s_waitcnt vmcnt(0)" ::: "memory");
        } else {
            XB_SPIN(xb_ld(&bar[XB_XGEN(b.x)]) == gen, bar);
            __builtin_amdgcn_fence(__ATOMIC_ACQUIRE, "agent");
            asm volatile("s_waitcnt vmcnt(0)" ::: "memory");
        }
    }
    __syncthreads();
}

__device__ __forceinline__ void spatial_phase(CP P, int j, int Mrows, LAS unsigned char* lds_, int tid, int lane, int wid) {
    const bf16* Z = (const bf16*)(P->ws + WS_Z); const float* VST = (const float*)(P->ws + WS_VST); bf16* Gb = (bf16*)(P->ws + WS_G);
    const bf16* WS = (const bf16*)(P->ws + WS_GMWS) + (size_t)j * 16 * 128 * 128;
    const float* lng = P->in[14] + (size_t)j * DM; const float* lnb = P->in[15] + (size_t)j * DM; const float* bs = P->in[17] + (size_t)j * 16 * 128;
    LAS bf16* Vt = (LAS bf16*)(LAS unsigned char*)lds_;
    constexpr int VP = 136;
    const int nunits = (Mrows / 128) * 16;
    for (int u = blockIdx.x; u < nunits; u += gridDim.x) {
        const int c = u >> 4, g = u & 15;
        __syncthreads();
        {
            const int q = tid >> 2, dq = (tid & 3) * 32; const int row = c * 128 + q;
            const float mean = VST[2 * row], rstd = VST[2 * row + 1];
            const bf16* src = Z + (size_t)row * 4096 + 2048 + g * 128 + dq;
#pragma unroll
            for (int t = 0; t < 4; ++t) { const u32x4 w = *(const u32x4*)(src + 8 * t);
                float v[8] = {bflo(w.x), bfhi(w.x), bflo(w.y), bfhi(w.y), bflo(w.z), bfhi(w.z), bflo(w.w), bfhi(w.w)};
                const float* gp = lng + g * 128 + dq + 8 * t; const float* bp = lnb + g * 128 + dq + 8 * t;
#pragma unroll
                for (int i = 0; i < 8; ++i) { const float vn = (v[i] - mean) * rstd * gp[i] + bp[i]; Vt[(dq + 8 * t + i) * VP + q] = tobf1(vn); } }
        }
        __syncthreads();
        const int fr = lane & 15, fq = lane >> 4;
        bf16x8 a[4];
        const bf16* wrow = WS + (size_t)g * 128 * 128 + (size_t)(16 * wid + fr) * 128 + 8 * fq;
#pragma unroll
        for (int ks = 0; ks < 4; ++ks) a[ks] = *(const bf16x8*)(wrow + 32 * ks);
#pragma unroll
        for (int nb = 0; nb < 8; ++nb) {
            f32x4 acc = {0.f, 0.f, 0.f, 0.f};
#pragma unroll
            for (int ks = 0; ks < 4; ++ks) { const bf16x8 b = *(const LAS bf16x8*)(Vt + (16 * nb + fr) * VP + 32 * ks + 8 * fq);
                acc = __builtin_amdgcn_mfma_f32_16x16x32_bf16(a[ks], b, acc, 0, 0, 0); }
#pragma unroll
            for (int r = 0; r < 4; ++r) { const int p = 16 * wid + fq * 4 + r, d = 16 * nb + fr; const size_t grow = (size_t)(c * 128 + p);
                const float sv = acc[r] + bs[g * 128 + p];
                const float uu = bf1(Z[grow * 4096 + g * 128 + d]);
                Gb[grow * 2048 + g * 128 + d] = tobf1(uu * sv); }
        }
    }
}

__device__ __forceinline__ void rope_cs(int row, int l, float& cs, float& sn) {
    const int t = row & (SEQ - 1); const int pos = (l & 32) ? (t & 63) : (t >> 6);
    const float inv = powf(10000.0f, -(float)(l & 15) * (1.0f / 16.0f));
    const float ang = (float)pos * inv; sincosf(ang, &sn, &cs);
}
__device__ __forceinline__ float rope_apply(float x, int l, float cs, float sn) {
    const float p = lane_xor16(x, l);
    return (l & 16) ? (p * sn + x * cs) : (x * cs - p * sn);
}
__device__ __forceinline__ void mla_norm_pass(CP P, int lane, int gw, int NGW) {
    const bf16* C = (const bf16*)(P->ws + WS_C); bf16* CQN = (bf16*)(P->ws + WS_CQN); bf16* CKVN = (bf16*)(P->ws + WS_CKVN); bf16* KR = (bf16*)(P->ws + WS_KR);
    const float* qn = P->in[20]; const float* kvn = P->in[21];
    for (int row = gw; row < MT; row += NGW) {
        const bf16* c = C + (size_t)row * 1280;
#pragma unroll
        for (int part = 0; part < 2; ++part) {
            const u32x4 w = *(const u32x4*)(c + part * 512 + 8 * lane);
            float v[8] = {bflo(w.x), bfhi(w.x), bflo(w.y), bfhi(w.y), bflo(w.z), bfhi(w.z), bflo(w.w), bfhi(w.w)};
            float ss = 0.f;
#pragma unroll
            for (int i = 0; i < 8; ++i) ss += v[i] * v[i];
            const float r = 1.0f / sqrtf(wave_sum(ss) * (1.0f / 512.0f) + LN_EPS);
            const float* nw = (part ? kvn : qn) + 8 * lane;
            u32x4 o; o.x = cvtpk(v[0] * r * nw[0], v[1] * r * nw[1]); o.y = cvtpk(v[2] * r * nw[2], v[3] * r * nw[3]); o.z = cvtpk(v[4] * r * nw[4], v[5] * r * nw[5]); o.w = cvtpk(v[6] * r * nw[6], v[7] * r * nw[7]);
            *(u32x4*)((part ? CKVN : CQN) + (size_t)row * 512 + 8 * lane) = o;
        }
        float x = bf1(c[1024 + lane]);
        if (row < ML) { float cs, sn; rope_cs(row, lane, cs, sn); x = rope_apply(x, lane, cs, sn); }
        KR[(size_t)row * 64 + lane] = tobf1(x);
    }
}
__device__ __forceinline__ void rope_pass(bf16* buf, int ld, int col0, int nchunks, int cstride, int lane, int gw, int NGW) {
    for (int row = gw; row < ML; row += NGW) {
        float cs, sn; rope_cs(row, lane, cs, sn);
        bf16* r = buf + (size_t)row * ld + col0 + lane;
#pragma unroll 4
        for (int k = 0; k < nchunks; ++k) { const float x = bf1(r[k * cstride]); r[k * cstride] = tobf1(rope_apply(x, lane, cs, sn)); }
    }
}

namespace att {
#ifndef ATT_LEAN
#define ATT_LEAN 1
#endif
#ifndef ATT_3STAGE
#define ATT_3STAGE 0
#endif
#ifndef ATT_PRIO
#define ATT_PRIO 0
#endif
#ifndef ATT_KMAJOR
#define ATT_KMAJOR 0
#endif
#ifndef ATT_TRB
#define ATT_TRB 1
#endif
#ifndef ATT_STAGGER
#define ATT_STAGGER 0
#endif
#ifndef ATT_SDEPTH
#define ATT_SDEPTH(MODE) ((MODE) == 0 ? 1 : 1)
#endif
#ifndef ATT_PVPIPE
#define ATT_PVPIPE(MODE) ((MODE) == 1)
#endif
#define SBAR() __builtin_amdgcn_sched_barrier(0)
__device__ __forceinline__ int crow(int r, int hi) { return (r & 3) + 8 * (r >> 2) + 4 * hi; }
__device__ __forceinline__ unsigned cvtpkv(float lo, float hi) { unsigned r; asm volatile("v_cvt_pk_bf16_f32 %0, %1, %2" : "=v"(r) : "v"(lo), "v"(hi)); return r; }

__device__ __forceinline__ void partialSM(f32x16& p0, f32x16& p1, float& m_reg, float& mn, float& alpha, const float C, const float THRS) {
  float pmax = p0[0];
#pragma unroll
  for (int r = 1; r < 16; ++r) pmax = fmaxf(pmax, p0[r]);
#pragma unroll
  for (int r = 0; r < 16; ++r) pmax = fmaxf(pmax, p1[r]);
  { auto rr = __builtin_amdgcn_permlane32_swap(__float_as_uint(pmax), __float_as_uint(pmax), false, false);
    pmax = fmaxf(__uint_as_float(rr[0]), __uint_as_float(rr[1])); }
  if (__builtin_expect(__all(pmax - m_reg <= THRS), 1)) { mn = m_reg; alpha = 1.f; }
  else { mn = fmaxf(m_reg, pmax); alpha = __builtin_amdgcn_exp2f((m_reg - mn) * C); m_reg = mn; }
  const float mnC = -mn * C;
#pragma unroll
  for (int r = 0; r < 16; ++r) p0[r] = fmaf(p0[r], C, mnC);
#pragma unroll
  for (int r = 0; r < 16; ++r) p1[r] = fmaf(p1[r], C, mnC);
#pragma unroll
  for (int r = 0; r < 16; ++r) p0[r] = __builtin_amdgcn_exp2f(p0[r]);
}
__device__ __forceinline__ void finishSM(f32x16& p0, f32x16& p1, float alpha, float& l_reg, bf16x8& pa0, bf16x8& pa1, bf16x8& pa2, bf16x8& pa3) {
#pragma unroll
  for (int r = 0; r < 16; ++r) p1[r] = __builtin_amdgcn_exp2f(p1[r]);
  float ps = 0;
#pragma unroll
  for (int r = 0; r < 16; ++r) ps += p0[r];
#pragma unroll
  for (int r = 0; r < 16; ++r) ps += p1[r];
  { auto rr = __builtin_amdgcn_permlane32_swap(__float_as_uint(ps), __float_as_uint(ps), false, false);
    ps = __uint_as_float(rr[0]) + __uint_as_float(rr[1]); }
  l_reg = l_reg * alpha + ps;
#define PK4(P, BASE, OUT) do { unsigned a0 = cvtpkv(P[BASE + 0], P[BASE + 1]), a1 = cvtpkv(P[BASE + 2], P[BASE + 3]);   \
    unsigned b0 = cvtpkv(P[BASE + 4], P[BASE + 5]), b1 = cvtpkv(P[BASE + 6], P[BASE + 7]);                              \
    auto r0 = __builtin_amdgcn_permlane32_swap(a0, b0, false, false); auto r1 = __builtin_amdgcn_permlane32_swap(a1, b1, false, false); \
    u32x4 w = {r0[0], r1[0], r0[1], r1[1]}; OUT = *reinterpret_cast<bf16x8*>(&w); } while (0)
  PK4(p0, 0, pa0); PK4(p0, 8, pa1); PK4(p1, 0, pa2); PK4(p1, 8, pa3);
#undef PK4
}
__device__ __forceinline__ void partialSM_lean(f32x16& p0, f32x16& p1, f32x16& nm, float& alpha, const bool first) {
  constexpr float THR2 = 11.541560327111707f;
  float dmax = p0[0];
#pragma unroll
  for (int r = 1; r < 16; ++r) dmax = fmaxf(dmax, p0[r]);
#pragma unroll
  for (int r = 0; r < 16; ++r) dmax = fmaxf(dmax, p1[r]);
  { auto rr = __builtin_amdgcn_permlane32_swap(__float_as_uint(dmax), __float_as_uint(dmax), false, false);
    dmax = fmaxf(__uint_as_float(rr[0]), __uint_as_float(rr[1])); }
  alpha = 1.f;
  if (first || !__all(dmax <= THR2)) {
    const float delta = first ? dmax : (dmax > THR2 ? dmax : 0.f);
    if (!first) alpha = __builtin_amdgcn_exp2f(-delta);
#pragma unroll
    for (int r = 0; r < 16; ++r) { p0[r] -= delta; p1[r] -= delta; nm[r] -= delta; }
  }
#pragma unroll
  for (int r = 0; r < 16; ++r) p0[r] = __builtin_amdgcn_exp2f(p0[r]);
}
__device__ __forceinline__ void finishSM_lean(f32x16& p0, f32x16& p1, bf16x8& pa0, bf16x8& pa1, bf16x8& pa2, bf16x8& pa3) {
#pragma unroll
  for (int r = 0; r < 16; ++r) p1[r] = __builtin_amdgcn_exp2f(p1[r]);
#define PK4(P, BASE, OUT) do { unsigned a0 = cvtpkv(P[BASE + 0], P[BASE + 1]), a1 = cvtpkv(P[BASE + 2], P[BASE + 3]);   \
    unsigned b0 = cvtpkv(P[BASE + 4], P[BASE + 5]), b1 = cvtpkv(P[BASE + 6], P[BASE + 7]);                              \
    auto r0 = __builtin_amdgcn_permlane32_swap(a0, b0, false, false); auto r1 = __builtin_amdgcn_permlane32_swap(a1, b1, false, false); \
    u32x4 w = {r0[0], r1[0], r0[1], r1[1]}; OUT = *reinterpret_cast<bf16x8*>(&w); } while (0)
  PK4(p0, 0, pa0); PK4(p0, 8, pa1); PK4(p1, 0, pa2); PK4(p1, 8, pa3);
#undef PK4
}
__device__ __forceinline__ bf16x8 scale_bf16x8(bf16x8 v, float c) {
  const u32x4 w = *reinterpret_cast<u32x4*>(&v); u32x4 o;
  o.x = cvtpk(bflo(w.x) * c, bfhi(w.x) * c); o.y = cvtpk(bflo(w.y) * c, bfhi(w.y) * c); o.z = cvtpk(bflo(w.z) * c, bfhi(w.z) * c); o.w = cvtpk(bflo(w.w) * c, bfhi(w.w) * c);
  return *reinterpret_cast<bf16x8*>(&o);
}
template <int PITCH> __device__ __forceinline__ int kswz(int r) { return PITCH == 256 ? (r & 15) : ((r >> 1) & 7); }
template <int NQF, int NQR, int PITCH> __device__ __forceinline__ void qkt(f32x16& p0, f32x16& p1, const LAS char* Ks, int chunk0, const bf16x8* qr, const LAS char* ql, int r32, int hi, const f32x16 init = f32x16{}) {
  p0 = init; p1 = init;
  const int sw = kswz<PITCH>(r32);
#pragma unroll
  for (int d0 = 0; d0 < NQF; ++d0) { const int off = ((chunk0 + d0 * 2 + hi) ^ sw) * 16;
    const bf16x8 b0 = *(const LAS bf16x8*)(Ks + r32 * PITCH + off);
    const bf16x8 b1 = *(const LAS bf16x8*)(Ks + (32 + r32) * PITCH + off);
    const bf16x8 q = d0 < NQR ? qr[d0 < NQR ? d0 : 0] : *(const LAS bf16x8*)(ql + (d0 - NQR < 0 ? 0 : d0 - NQR) * 1024);
    p0 = __builtin_amdgcn_mfma_f32_32x32x16_bf16(b0, q, p0, 0, 0, 0);
    p1 = __builtin_amdgcn_mfma_f32_32x32x16_bf16(b1, q, p1, 0, 0, 0); }
}
__device__ __forceinline__ int v_st(int k, int c) { const int kk = (k & ~0xC) | ((k & 4) << 1) | ((k & 8) >> 1); return ((kk >> 3) * 4 + (c >> 5)) * 512 + ((kk & 7) * 32 + (c & 31)) * 2; }
__device__ __forceinline__ int v_rd_base(int lane) { return ((lane & 3) << 3) | (((lane >> 2) & 3) << 6) | (((lane >> 4) & 1) << 5) | (((lane >> 5) & 1) << 8); }
constexpr int v_rd_off(int d0, int ks, int half) { return d0 * 512 + ks * 4096 + half * 2048; }
template <int OFF> __device__ __forceinline__ s16x4 tr_read(int vb) {
  s16x4 r; asm volatile("ds_read_b64_tr_b16 %0, %1 offset:%2" : "=&v"(r) : "v"(vb), "i"(OFF) : "memory"); return r;
}
template <int D0> __device__ __forceinline__ void pv_one(f32x16& od, int vb, bf16x8 pa0, bf16x8 pa1, bf16x8 pa2, bf16x8 pa3) {
  const s16x4 l0 = tr_read<v_rd_off(D0, 0, 0)>(vb), h0 = tr_read<v_rd_off(D0, 0, 1)>(vb), l1 = tr_read<v_rd_off(D0, 1, 0)>(vb), h1 = tr_read<v_rd_off(D0, 1, 1)>(vb);
  const s16x4 l2 = tr_read<v_rd_off(D0, 2, 0)>(vb), h2 = tr_read<v_rd_off(D0, 2, 1)>(vb), l3 = tr_read<v_rd_off(D0, 3, 0)>(vb), h3 = tr_read<v_rd_off(D0, 3, 1)>(vb);
  asm volatile("s_waitcnt lgkmcnt(0)" ::: "memory"); SBAR();
#define PK(L, H) (bf16x8){L[0], L[1], L[2], L[3], H[0], H[1], H[2], H[3]}
  od = __builtin_amdgcn_mfma_f32_32x32x16_bf16(pa0, PK(l0, h0), od, 0, 0, 0);
  od = __builtin_amdgcn_mfma_f32_32x32x16_bf16(pa1, PK(l1, h1), od, 0, 0, 0);
  od = __builtin_amdgcn_mfma_f32_32x32x16_bf16(pa2, PK(l2, h2), od, 0, 0, 0);
  od = __builtin_amdgcn_mfma_f32_32x32x16_bf16(pa3, PK(l3, h3), od, 0, 0, 0);
#undef PK
}
__device__ __forceinline__ void pv_d0(f32x16* o, int vb, bf16x8 pa0, bf16x8 pa1, bf16x8 pa2, bf16x8 pa3) {
  pv_one<0>(o[0], vb, pa0, pa1, pa2, pa3); pv_one<1>(o[1], vb, pa0, pa1, pa2, pa3); pv_one<2>(o[2], vb, pa0, pa1, pa2, pa3); pv_one<3>(o[3], vb, pa0, pa1, pa2, pa3);
}
struct VFrag { s16x4 l0, h0, l1, h1, l2, h2, l3, h3; };
typedef short v4i16_t __attribute__((ext_vector_type(4)));
template <int OFF> __device__ __forceinline__ s16x4 tr_read_b(int vb) {
  return __builtin_bit_cast(s16x4, __builtin_amdgcn_ds_read_tr16_b64_v4i16((LAS v4i16_t*)(uintptr_t)(unsigned)(vb + OFF)));
}
template <int D0> __device__ __forceinline__ void tr8b(VFrag& f, int vb) {
  f.l0 = tr_read_b<v_rd_off(D0, 0, 0)>(vb); f.h0 = tr_read_b<v_rd_off(D0, 0, 1)>(vb); f.l1 = tr_read_b<v_rd_off(D0, 1, 0)>(vb); f.h1 = tr_read_b<v_rd_off(D0, 1, 1)>(vb);
  f.l2 = tr_read_b<v_rd_off(D0, 2, 0)>(vb); f.h2 = tr_read_b<v_rd_off(D0, 2, 1)>(vb); f.l3 = tr_read_b<v_rd_off(D0, 3, 0)>(vb); f.h3 = tr_read_b<v_rd_off(D0, 3, 1)>(vb);
}
template <int D0> __device__ __forceinline__ void tr8(VFrag& f, int vb) {
  f.l0 = tr_read<v_rd_off(D0, 0, 0)>(vb); f.h0 = tr_read<v_rd_off(D0, 0, 1)>(vb); f.l1 = tr_read<v_rd_off(D0, 1, 0)>(vb); f.h1 = tr_read<v_rd_off(D0, 1, 1)>(vb);
  f.l2 = tr_read<v_rd_off(D0, 2, 0)>(vb); f.h2 = tr_read<v_rd_off(D0, 2, 1)>(vb); f.l3 = tr_read<v_rd_off(D0, 3, 0)>(vb); f.h3 = tr_read<v_rd_off(D0, 3, 1)>(vb);
}
__device__ __forceinline__ void mfma4(f32x16& od, VFrag& f, bf16x8 pa0, bf16x8 pa1, bf16x8 pa2, bf16x8 pa3) {
#define PK(L, H) (bf16x8){L[0], L[1], L[2], L[3], H[0], H[1], H[2], H[3]}
  od = __builtin_amdgcn_mfma_f32_32x32x16_bf16(pa0, PK(f.l0, f.h0), od, 0, 0, 0);
  od = __builtin_amdgcn_mfma_f32_32x32x16_bf16(pa1, PK(f.l1, f.h1), od, 0, 0, 0);
  od = __builtin_amdgcn_mfma_f32_32x32x16_bf16(pa2, PK(f.l2, f.h2), od, 0, 0, 0);
  od = __builtin_amdgcn_mfma_f32_32x32x16_bf16(pa3, PK(f.l3, f.h3), od, 0, 0, 0);
#undef PK
}
#define VF_TIE(f) "+v"(f.l0), "+v"(f.h0), "+v"(f.l1), "+v"(f.h1), "+v"(f.l2), "+v"(f.h2), "+v"(f.l3), "+v"(f.h3)
__device__ __forceinline__ void pv_pipe(f32x16* o, int vb, bf16x8 pa0, bf16x8 pa1, bf16x8 pa2, bf16x8 pa3) {
  VFrag A, B;
  asm volatile("s_waitcnt lgkmcnt(0)" ::: "memory");
  tr8<0>(A, vb); tr8<1>(B, vb);
  asm volatile("s_waitcnt lgkmcnt(8)" : VF_TIE(A) :: "memory");
  mfma4(o[0], A, pa0, pa1, pa2, pa3);
  tr8<2>(A, vb);
  asm volatile("s_waitcnt lgkmcnt(8)" : VF_TIE(B) :: "memory");
  mfma4(o[1], B, pa0, pa1, pa2, pa3);
  tr8<3>(B, vb);
  asm volatile("s_waitcnt lgkmcnt(8)" : VF_TIE(A) :: "memory");
  mfma4(o[2], A, pa0, pa1, pa2, pa3);
  asm volatile("s_waitcnt lgkmcnt(0)" : VF_TIE(B) :: "memory");
  mfma4(o[3], B, pa0, pa1, pa2, pa3);
}
__device__ __forceinline__ void pv_psm_lean(f32x16* o, int vb, bf16x8 pa0, bf16x8 pa1, bf16x8 pa2, bf16x8 pa3, f32x16& p0, f32x16& p1, f32x16& nm, float& alpha) {
  constexpr float THR2 = 11.541560327111707f;
  const bf16x8 one8 = {0x3F80, 0x3F80, 0x3F80, 0x3F80, 0x3F80, 0x3F80, 0x3F80, 0x3F80};
  VFrag A, B;
  asm volatile("s_waitcnt lgkmcnt(0)" ::: "memory");
  tr8<0>(A, vb); tr8<1>(B, vb);
  asm volatile("s_waitcnt lgkmcnt(8)" : VF_TIE(A) :: "memory");
  mfma4(o[0], A, pa0, pa1, pa2, pa3);
  float dmax = p0[0];
#pragma unroll
  for (int r = 1; r < 16; ++r) dmax = fmaxf(dmax, p0[r]);
  tr8<2>(A, vb);
  asm volatile("s_waitcnt lgkmcnt(8)" : VF_TIE(B) :: "memory");
  mfma4(o[1], B, pa0, pa1, pa2, pa3);
#pragma unroll
  for (int r = 0; r < 16; ++r) dmax = fmaxf(dmax, p1[r]);
  { auto rr = __builtin_amdgcn_permlane32_swap(__float_as_uint(dmax), __float_as_uint(dmax), false, false);
    dmax = fmaxf(__uint_as_float(rr[0]), __uint_as_float(rr[1])); }
  alpha = 1.f;
  if (!__all(dmax <= THR2)) {
    const float delta = dmax > THR2 ? dmax : 0.f; alpha = __builtin_amdgcn_exp2f(-delta);
#pragma unroll
    for (int r = 0; r < 16; ++r) { p0[r] -= delta; p1[r] -= delta; nm[r] -= delta; }
  }
  tr8<3>(B, vb);
  asm volatile("s_waitcnt lgkmcnt(8)" : VF_TIE(A) :: "memory");
  mfma4(o[2], A, pa0, pa1, pa2, pa3);
#pragma unroll
  for (int r = 0; r < 8; ++r) p0[r] = __builtin_amdgcn_exp2f(p0[r]);
  asm volatile("s_waitcnt lgkmcnt(0)" : VF_TIE(B) :: "memory");
  mfma4(o[3], B, pa0, pa1, pa2, pa3);
#pragma unroll
  for (int r = 8; r < 16; ++r) p0[r] = __builtin_amdgcn_exp2f(p0[r]);
  o[4] = __builtin_amdgcn_mfma_f32_32x32x16_bf16(pa0, one8, o[4], 0, 0, 0); o[4] = __builtin_amdgcn_mfma_f32_32x32x16_bf16(pa1, one8, o[4], 0, 0, 0);
  o[4] = __builtin_amdgcn_mfma_f32_32x32x16_bf16(pa2, one8, o[4], 0, 0, 0); o[4] = __builtin_amdgcn_mfma_f32_32x32x16_bf16(pa3, one8, o[4], 0, 0, 0);
}
__device__ __forceinline__ void pv_psm_lean_b(f32x16* o, int vb, bf16x8 pa0, bf16x8 pa1, bf16x8 pa2, bf16x8 pa3, f32x16& p0, f32x16& p1, f32x16& nm, float& alpha) {
  constexpr float THR2 = 11.541560327111707f;
  const bf16x8 one8 = {0x3F80, 0x3F80, 0x3F80, 0x3F80, 0x3F80, 0x3F80, 0x3F80, 0x3F80};
  VFrag A, B;
  tr8b<0>(A, vb); tr8b<1>(B, vb);
  mfma4(o[0], A, pa0, pa1, pa2, pa3);
  float dmax = p0[0];
#pragma unroll
  for (int r = 1; r < 16; ++r) dmax = fmaxf(dmax, p0[r]);
  tr8b<2>(A, vb);
  mfma4(o[1], B, pa0, pa1, pa2, pa3);
#pragma unroll
  for (int r = 0; r < 16; ++r) dmax = fmaxf(dmax, p1[r]);
  { auto rr = __builtin_amdgcn_permlane32_swap(__float_as_uint(dmax), __float_as_uint(dmax), false, false);
    dmax = fmaxf(__uint_as_float(rr[0]), __uint_as_float(rr[1])); }
  alpha = 1.f;
  if (!__all(dmax <= THR2)) {
    const float delta = dmax > THR2 ? dmax : 0.f; alpha = __builtin_amdgcn_exp2f(-delta);
#pragma unroll
    for (int r = 0; r < 16; ++r) { p0[r] -= delta; p1[r] -= delta; nm[r] -= delta; }
  }
  tr8b<3>(B, vb);
  mfma4(o[2], A, pa0, pa1, pa2, pa3);
#pragma unroll
  for (int r = 0; r < 8; ++r) p0[r] = __builtin_amdgcn_exp2f(p0[r]);
  mfma4(o[3], B, pa0, pa1, pa2, pa3);
#pragma unroll
  for (int r = 8; r < 16; ++r) p0[r] = __builtin_amdgcn_exp2f(p0[r]);
  o[4] = __builtin_amdgcn_mfma_f32_32x32x16_bf16(pa0, one8, o[4], 0, 0, 0); o[4] = __builtin_amdgcn_mfma_f32_32x32x16_bf16(pa1, one8, o[4], 0, 0, 0);
  o[4] = __builtin_amdgcn_mfma_f32_32x32x16_bf16(pa2, one8, o[4], 0, 0, 0); o[4] = __builtin_amdgcn_mfma_f32_32x32x16_bf16(pa3, one8, o[4], 0, 0, 0);
}
struct VStep { s16x4 l0, h0, l1, h1, l2, h2, l3, h3; };
template <int KS> __device__ __forceinline__ void trstep(VStep& f, int vb) {
  f.l0 = tr_read_b<v_rd_off(0, KS, 0)>(vb); f.h0 = tr_read_b<v_rd_off(0, KS, 1)>(vb); f.l1 = tr_read_b<v_rd_off(1, KS, 0)>(vb); f.h1 = tr_read_b<v_rd_off(1, KS, 1)>(vb);
  f.l2 = tr_read_b<v_rd_off(2, KS, 0)>(vb); f.h2 = tr_read_b<v_rd_off(2, KS, 1)>(vb); f.l3 = tr_read_b<v_rd_off(3, KS, 0)>(vb); f.h3 = tr_read_b<v_rd_off(3, KS, 1)>(vb);
}
__device__ __forceinline__ void mfma5(f32x16* o, const VStep& f, bf16x8 pa) {
  const bf16x8 one8 = {0x3F80, 0x3F80, 0x3F80, 0x3F80, 0x3F80, 0x3F80, 0x3F80, 0x3F80};
#define PK(L, H) (bf16x8){L[0], L[1], L[2], L[3], H[0], H[1], H[2], H[3]}
  o[0] = __builtin_amdgcn_mfma_f32_32x32x16_bf16(pa, PK(f.l0, f.h0), o[0], 0, 0, 0);
  o[1] = __builtin_amdgcn_mfma_f32_32x32x16_bf16(pa, PK(f.l1, f.h1), o[1], 0, 0, 0);
  o[2] = __builtin_amdgcn_mfma_f32_32x32x16_bf16(pa, PK(f.l2, f.h2), o[2], 0, 0, 0);
  o[3] = __builtin_amdgcn_mfma_f32_32x32x16_bf16(pa, PK(f.l3, f.h3), o[3], 0, 0, 0);
  o[4] = __builtin_amdgcn_mfma_f32_32x32x16_bf16(pa, one8, o[4], 0, 0, 0);
#undef PK
}
template <int BASE> __device__ __forceinline__ bf16x8 pk4e(const f32x16& P) {
  const float e0 = __builtin_amdgcn_exp2f(P[BASE + 0]), e1 = __builtin_amdgcn_exp2f(P[BASE + 1]), e2 = __builtin_amdgcn_exp2f(P[BASE + 2]), e3 = __builtin_amdgcn_exp2f(P[BASE + 3]);
  const float e4 = __builtin_amdgcn_exp2f(P[BASE + 4]), e5 = __builtin_amdgcn_exp2f(P[BASE + 5]), e6 = __builtin_amdgcn_exp2f(P[BASE + 6]), e7 = __builtin_amdgcn_exp2f(P[BASE + 7]);
  const unsigned a0 = cvtpk(e0, e1), a1 = cvtpk(e2, e3), b0 = cvtpk(e4, e5), b1 = cvtpk(e6, e7);
  const auto r0 = __builtin_amdgcn_permlane32_swap(a0, b0, false, false); const auto r1 = __builtin_amdgcn_permlane32_swap(a1, b1, false, false);
  u32x4 w = {r0[0], r1[0], r0[1], r1[1]}; return *reinterpret_cast<bf16x8*>(&w);
}
__device__ __forceinline__ float rowmax_lean(const f32x16& p0, const f32x16& p1) {
  float d = p0[0];
#pragma unroll
  for (int r = 1; r < 16; ++r) d = fmaxf(d, p0[r]);
#pragma unroll
  for (int r = 0; r < 16; ++r) d = fmaxf(d, p1[r]);
  const auto rr = __builtin_amdgcn_permlane32_swap(__float_as_uint(d), __float_as_uint(d), false, false);
  return fmaxf(__uint_as_float(rr[0]), __uint_as_float(rr[1]));
}
__device__ __forceinline__ void shift_lean(float dmax, f32x16& p0, f32x16& p1, f32x16& nm, float& alpha, const bool first) {
  constexpr float THR2 = 11.541560327111707f;
  alpha = 1.f;
  if (first || !__all(dmax <= THR2)) {
    const float delta = first ? dmax : (dmax > THR2 ? dmax : 0.f);
    if (!first) alpha = __builtin_amdgcn_exp2f(-delta);
#pragma unroll
    for (int r = 0; r < 16; ++r) { p0[r] -= delta; p1[r] -= delta; nm[r] -= delta; }
  }
}
#define SGB(mask, n) __builtin_amdgcn_sched_group_barrier((mask), (n), 0)
__device__ __forceinline__ bf16x8 ld8(const bf16* p) { return *reinterpret_cast<const bf16x8*>(p); }

template <int MODE, int ATTV = 0>
__device__ __forceinline__ void attn_unit(const bf16* __restrict__ Qrow0, int ldq, const bf16* __restrict__ Kb, const bf16* __restrict__ Vb, int ldk, const bf16* __restrict__ KRb,
                                          int b, int nct, int NT, bf16* __restrict__ Ob, float lam, const float* __restrict__ subln, float oscale, LAS unsigned char* lds_, const int tid_in) {
  constexpr bool LEAN = (MODE == 1) && ATT_LEAN; constexpr int NQF = MODE == 0 ? 12 : 4, NQR = MODE == 0 ? 4 : 0, NOB = LEAN ? 5 : 4, PITCH = MODE == 0 ? 384 : 256, SHM_V = 16384, SHM_K = 64 * PITCH, SDEPTH = ATT_SDEPTH(MODE); constexpr bool PVPIPE = ATT_PVPIPE(MODE);
  const float SCALE = MODE == 0 ? 0.07216878364870323f : 0.125f;
  const float C = SCALE * 1.4426950408889634f, THRS = 8.f / SCALE;
  if (ATT_PRIO) { if (__builtin_amdgcn_readfirstlane(tid_in >> 8) != 0) __builtin_amdgcn_s_setprio(1); }
  const int tid = launder_v(tid_in) & 511, wid = tid >> 6, lane = tid & 63, r32 = lane & 31, hi = lane >> 5;
  LAS char* lds = (LAS char*)(LAS unsigned char*)lds_;
  constexpr bool THREE = (MODE == 1) && ATT_3STAGE; constexpr int NSTG = THREE ? 3 : 2, STG = SHM_V + SHM_K, SCR0 = NSTG * STG;
#define VOFF(s) (!THREE ? (s) * SHM_V : (s) * STG)
#define KOFF(s) (!THREE ? 2 * SHM_V + (s) * SHM_K : (s) * STG + SHM_V)
  LAS char* V_lds = lds; LAS char* K_lds = lds;
  LAS float* wsf = (LAS float*)(lds + NSTG * (SHM_V + SHM_K)) + wid * 64; LAS float* li_l = wsf; LAS float* al_l = wsf + 32;
  const int wq = MODE == 0 ? wid : (wid & 3), sgrp = MODE == 0 ? 0 : (wid >> 2);
  float m_reg = -1e30f, l_reg = 0; f32x16 o[NOB] = {}; bf16x8 qr[NQR > 0 ? NQR : 1]; f32x16 nm = {};
  LAS char* ql = lds + SCR0 + 2048 + wid * (MODE == 0 ? 8192 : 4096) + lane * 16;
  const bf16* Qw = Qrow0 + (size_t)(wq * 32 + r32) * ldq + sgrp * 64 + hi * 8;
#pragma unroll
  for (int d0 = 0; d0 < NQR; ++d0) qr[d0] = ld8(Qw + d0 * 16);
#pragma unroll
  for (int d0 = NQR; d0 < NQF; ++d0) { bf16x8 qv = ld8(Qw + d0 * 16); if (LEAN) qv = scale_bf16x8(qv, C); *(LAS bf16x8*)(ql + (d0 - NQR) * 1024) = qv; }
  const int sr = tid >> 4, sc = (tid & 15) * 8, vst0 = v_st(sr, sc), vst1 = v_st(32 + sr, sc);
  const int kst0 = sr * PITCH + (((tid & 15) ^ kswz<PITCH>(sr)) * 16), kst1 = kst0 + 32 * PITCH;
  const int rrow = tid >> 3, krs = rrow * PITCH + (((16 + (tid & 7)) ^ kswz<PITCH>(rrow)) * 16);
  const int chunk0 = sgrp * 8;
  const int vb0 = (int)(uintptr_t)V_lds + v_rd_base(lane);
  struct Slot { bf16x8 vs0, vs1, ks0, ks1, kr; } sr_[SDEPTH];
#define KROW(jt) ((jt) < nct ? (ML + b * CTXL + (jt) * 64) : (b * SEQ + ((jt) - nct) * 64))
#define SLOAD(i, jt) do { const int k0_ = KROW(jt); sr_[i].vs0 = ld8(Vb + (size_t)(k0_ + sr) * ldk + sc); sr_[i].vs1 = ld8(Vb + (size_t)(k0_ + 32 + sr) * ldk + sc); \
    sr_[i].ks0 = ld8(Kb + (size_t)(k0_ + sr) * ldk + sc); sr_[i].ks1 = ld8(Kb + (size_t)(k0_ + 32 + sr) * ldk + sc); \
    if (MODE == 0) sr_[i].kr = ld8(KRb + (size_t)(k0_ + rrow) * 64 + (tid & 7) * 8); } while (0)
#define SWRITE(bf, i) do { *(LAS bf16x8*)(V_lds + VOFF(bf) + vst0) = sr_[i].vs0; *(LAS bf16x8*)(V_lds + VOFF(bf) + vst1) = sr_[i].vs1; \
    *(LAS bf16x8*)(K_lds + KOFF(bf) + kst0) = sr_[i].ks0; *(LAS bf16x8*)(K_lds + KOFF(bf) + kst1) = sr_[i].ks1; \
    if (MODE == 0) *(LAS bf16x8*)(K_lds + KOFF(bf) + krs) = sr_[i].kr; } while (0)
#define SWAIT() do { if constexpr (SDEPTH == 2) asm volatile("s_waitcnt vmcnt(4)" ::: "memory"); else asm volatile("s_waitcnt vmcnt(0)" ::: "memory"); } while (0)
#define RESC(a) do { if (__any((a) < 1.f)) { if (hi == 0) al_l[r32] = (a); asm volatile("s_waitcnt lgkmcnt(0)" ::: "memory"); \
    _Pragma("unroll") for (int d = 0; d < NOB; ++d) _Pragma("unroll") for (int r = 0; r < 16; ++r) o[d][r] *= al_l[crow(r, hi)]; } } while (0)
#define PV(vb_) do { if constexpr (ATTV == 2) { o[0][0] += __uint_as_float((unsigned)pa0[0] + (unsigned)pa3[1]); } else if constexpr (PVPIPE) pv_pipe(o, (vb_), pa0, pa1, pa2, pa3); else pv_d0(o, (vb_), pa0, pa1, pa2, pa3); \
    if constexpr (LEAN) { const bf16x8 one8 = {0x3F80, 0x3F80, 0x3F80, 0x3F80, 0x3F80, 0x3F80, 0x3F80, 0x3F80};     \
        o[NOB - 1] = __builtin_amdgcn_mfma_f32_32x32x16_bf16(pa0, one8, o[NOB - 1], 0, 0, 0); o[NOB - 1] = __builtin_amdgcn_mfma_f32_32x32x16_bf16(pa1, one8, o[NOB - 1], 0, 0, 0); \
        o[NOB - 1] = __builtin_amdgcn_mfma_f32_32x32x16_bf16(pa2, one8, o[NOB - 1], 0, 0, 0); o[NOB - 1] = __builtin_amdgcn_mfma_f32_32x32x16_bf16(pa3, one8, o[NOB - 1], 0, 0, 0); } } while (0)
#define PSM(p0_, p1_, mn_, al_, first_) do { if constexpr (ATTV == 1) { al_ = 1.f; } else if constexpr (LEAN) partialSM_lean(p0_, p1_, nm, al_, first_); else partialSM(p0_, p1_, m_reg, mn_, al_, C, THRS); } while (0)
#define FSM(p0_, p1_, al_) do { if constexpr (ATTV == 1) { u32x4 w0_ = {__float_as_uint(p0_[0]), __float_as_uint(p0_[1]), __float_as_uint(p1_[0]), __float_as_uint(p1_[1])}; pa0 = pa1 = pa2 = pa3 = *reinterpret_cast<bf16x8*>(&w0_); } else if constexpr (LEAN) finishSM_lean(p0_, p1_, pa0, pa1, pa2, pa3); else finishSM(p0_, p1_, al_, l_reg, pa0, pa1, pa2, pa3); } while (0)
#define QKT(p0_, p1_, Kp_) do { if constexpr (ATTV == 5) { p0_ = nm; p1_ = nm; p0_[0] += (float)r32; } else if constexpr (LEAN) qkt<NQF, NQR, PITCH>(p0_, p1_, Kp_, chunk0, qr, ql, r32, hi, nm); else qkt<NQF, NQR, PITCH>(p0_, p1_, Kp_, chunk0, qr, ql, r32, hi); } while (0)
  f32x16 pA0, pA1, pB0, pB1; float mnA, mnB, alA, alB; bf16x8 pa0, pa1, pa2, pa3;
  constexpr bool KMAJ = (MODE == 1) && LEAN && ATT_KMAJOR && (ATTV == 0) && !THREE;
  if constexpr (KMAJ) {
    VStep VA, VB;
#define KSTEPS(PC0, PC1, ALC, PP0, PP1, KC, VP, LD, DOQK) do { const int vb_ = vb0 + VOFF(VP); float dmx_ = 0.f; \
      SBAR(); \
      if (DOQK) QKT(PC0, PC1, K_lds + KOFF(KC)); \
      pa0 = pk4e<0>(PP0); trstep<0>(VA, vb_); \
      _Pragma("unroll") for (int i_ = 0; i_ < 8; ++i_) { SGB(0x008, 1); SGB(0x100, 3); SGB(0x002, 2); } \
      SBAR(); LD; SBAR(); \
      mfma5(o, VA, pa0); pa1 = pk4e<8>(PP0); trstep<1>(VB, vb_); \
      _Pragma("unroll") for (int i_ = 0; i_ < 5; ++i_) { SGB(0x008, 1); SGB(0x100, 2); SGB(0x002, 3); } \
      SBAR(); \
      mfma5(o, VB, pa1); pa2 = pk4e<0>(PP1); trstep<2>(VA, vb_); \
      _Pragma("unroll") for (int i_ = 0; i_ < 5; ++i_) { SGB(0x008, 1); SGB(0x100, 2); SGB(0x002, 3); } \
      SBAR(); \
      mfma5(o, VA, pa2); pa3 = pk4e<8>(PP1); trstep<3>(VB, vb_); \
      _Pragma("unroll") for (int i_ = 0; i_ < 5; ++i_) { SGB(0x008, 1); SGB(0x100, 2); SGB(0x002, 3); } \
      SBAR(); \
      mfma5(o, VB, pa3); if (DOQK) dmx_ = rowmax_lean(PC0, PC1); \
      _Pragma("unroll") for (int i_ = 0; i_ < 5; ++i_) { SGB(0x008, 1); SGB(0x002, 7); } \
      SBAR(); \
      if (DOQK) shift_lean(dmx_, PC0, PC1, nm, ALC, false); } while (0)
    SLOAD(0, 0); asm volatile("s_waitcnt vmcnt(0)" ::: "memory"); SWRITE(0, 0); __syncthreads();
    QKT(pA0, pA1, K_lds + KOFF(0)); shift_lean(rowmax_lean(pA0, pA1), pA0, pA1, nm, alA, true);
    SLOAD(0, 1); asm volatile("s_waitcnt vmcnt(0)" ::: "memory"); SWRITE(1, 0); __syncthreads();
    for (int j = 1; j + 1 < NT; j += 2) {
      KSTEPS(pB0, pB1, alB, pA0, pA1, 1, 0, SLOAD(0, j + 1), true);
      __syncthreads(); asm volatile("s_waitcnt vmcnt(0)" ::: "memory"); SWRITE(0, 0);
      RESC(alB); __syncthreads();
      KSTEPS(pA0, pA1, alA, pB0, pB1, 0, 1, SLOAD(0, j + 2), true);
      __syncthreads(); asm volatile("s_waitcnt vmcnt(0)" ::: "memory"); SWRITE(1, 0);
      RESC(alA); __syncthreads();
    }
    KSTEPS(pB0, pB1, alB, pA0, pA1, 1, 0, (void)0, true);
    __syncthreads(); RESC(alB);
    KSTEPS(pA0, pA1, alA, pB0, pB1, 0, 1, (void)0, false);
#undef KSTEPS
  } else if constexpr (!THREE) {
  constexpr int SE = 0, SO = SDEPTH - 1;
  SLOAD(SE, 0); asm volatile("s_waitcnt vmcnt(0)" ::: "memory"); SWRITE(0, SE); __syncthreads();
  QKT(pA0, pA1, K_lds + KOFF(0)); PSM(pA0, pA1, mnA, alA, true);
  SLOAD(SO, 1); if constexpr (SDEPTH == 2) { if (2 < NT) SLOAD(SE, 2); }
  SWAIT(); SWRITE(1, SO); __syncthreads();
#define ILV() do { if constexpr (PVPIPE) { _Pragma("unroll") for (int i_ = 0; i_ < 20; ++i_) { __builtin_amdgcn_sched_group_barrier(0x008, 1, 0); __builtin_amdgcn_sched_group_barrier(0x002, 5, 0); } } } while (0)
#define LSLOAD(i, jt) do { if constexpr (ATTV != 3) SLOAD(i, jt); } while (0)
#define LSWRITE(bf, i) do { if constexpr (ATTV != 3) SWRITE(bf, i); } while (0)
#define LSWAIT() do { if constexpr (ATTV != 3) SWAIT(); } while (0)
#define LSYNC() do { if constexpr (ATTV != 4) __syncthreads(); } while (0)
#define HALFSTEP(PC0, PC1, MNC, ALC, PP0, PP1, ALP, KC, VP, LD) do { \
    if (!STAG || wid < 4) { \
      SBAR(); QKT(PC0, PC1, K_lds + KOFF(KC)); FSM(PP0, PP1, ALP); SBAR(); \
      LD; SBAR(); \
      if constexpr (PVPIPE && LEAN && ATTV == 0) { if constexpr (ATT_TRB) pv_psm_lean_b(o, vb0 + VOFF(VP), pa0, pa1, pa2, pa3, PC0, PC1, nm, ALC); else pv_psm_lean(o, vb0 + VOFF(VP), pa0, pa1, pa2, pa3, PC0, PC1, nm, ALC); } else { PV(vb0 + VOFF(VP)); PSM(PC0, PC1, MNC, ALC, false); } \
    } else { \
      SBAR(); FSM(PP0, PP1, ALP); SBAR(); \
      LD; SBAR(); \
      PV(vb0 + VOFF(VP)); SBAR(); \
      QKT(PC0, PC1, K_lds + KOFF(KC)); SBAR(); \
      PSM(PC0, PC1, MNC, ALC, false); \
    } } while (0)
  constexpr bool STAG = (MODE == 1) && ATT_STAGGER && ATTV == 0;
  for (int j = 1; j + 1 < NT; j += 2) {
    HALFSTEP(pB0, pB1, mnB, alB, pA0, pA1, alA, 1, 0, LSLOAD(SO, j + SDEPTH));
    LSYNC(); LSWAIT(); LSWRITE(0, SE);
    RESC(alB); LSYNC();
    HALFSTEP(pA0, pA1, mnA, alA, pB0, pB1, alB, 0, 1, if (SDEPTH == 1 || j + 3 < NT) LSLOAD(SE, j + 1 + SDEPTH));
    LSYNC(); LSWAIT(); LSWRITE(1, SO);
    RESC(alA); LSYNC();
  }
#undef HALFSTEP
#undef ILV
#undef LSLOAD
#undef LSWRITE
#undef LSWAIT
#undef LSYNC
  SBAR(); QKT(pB0, pB1, K_lds + KOFF(1));
  FSM(pA0, pA1, alA); SBAR();
  PV(vb0); PSM(pB0, pB1, mnB, alB, false);
  __syncthreads(); RESC(alB);
  FSM(pB0, pB1, alB); SBAR();
  PV(vb0 + VOFF(1));
  } else {
#define STEP(PC0, PC1, ALC, PP0, PP1, ALP, jj, SP, SC, SN) do { const int j_ = (jj); \
      if (j_ + 1 < NT) { asm volatile("s_waitcnt vmcnt(0)" ::: "memory"); SWRITE(SN, 0); if (j_ + 2 < NT) SLOAD(0, j_ + 2); } \
      SBAR(); QKT(PC0, PC1, K_lds + KOFF(SC)); FSM(PP0, PP1, ALP); SBAR(); \
      PV(vb0 + VOFF(SP)); PSM(PC0, PC1, mnA, ALC, false); \
      RESC(ALC); __syncthreads(); } while (0)
    SLOAD(0, 0); asm volatile("s_waitcnt vmcnt(0)" ::: "memory"); SWRITE(0, 0);
    SLOAD(0, 1); asm volatile("s_waitcnt vmcnt(0)" ::: "memory"); SWRITE(1, 0);
    SLOAD(0, 2); __syncthreads();
    QKT(pA0, pA1, K_lds + KOFF(0)); PSM(pA0, pA1, mnA, alA, true);
    STEP(pB0, pB1, alB, pA0, pA1, alA, 1, 0, 1, 2);
    int j = 2;
    for (; j + 5 < NT; j += 6) {
      STEP(pA0, pA1, alA, pB0, pB1, alB, j, 1, 2, 0);
      STEP(pB0, pB1, alB, pA0, pA1, alA, j + 1, 2, 0, 1);
      STEP(pA0, pA1, alA, pB0, pB1, alB, j + 2, 0, 1, 2);
      STEP(pB0, pB1, alB, pA0, pA1, alA, j + 3, 1, 2, 0);
      STEP(pA0, pA1, alA, pB0, pB1, alB, j + 4, 2, 0, 1);
      STEP(pB0, pB1, alB, pA0, pA1, alA, j + 5, 0, 1, 2);
    }
    if (j < NT) { STEP(pA0, pA1, alA, pB0, pB1, alB, j, 1, 2, 0); STEP(pB0, pB1, alB, pA0, pA1, alA, j + 1, 2, 0, 1); j += 2; }
    if (j < NT) { STEP(pA0, pA1, alA, pB0, pB1, alB, j, 0, 1, 2); STEP(pB0, pB1, alB, pA0, pA1, alA, j + 1, 1, 2, 0); j += 2; }
    FSM(pB0, pB1, alB); SBAR();
    { const int sl = (NT - 1) % 3; PV(vb0 + VOFF(sl)); }
#undef STEP
  }
  float rli[16];
  if constexpr (LEAN) {
#pragma unroll
    for (int r = 0; r < 16; ++r) rli[r] = __builtin_amdgcn_rcpf(o[NOB - 1][r]);
  } else {
    if (hi == 0) li_l[r32] = l_reg; asm volatile("s_waitcnt lgkmcnt(0)" ::: "memory");
#pragma unroll
    for (int r = 0; r < 16; ++r) rli[r] = __builtin_amdgcn_rcpf(li_l[crow(r, hi)]);
  }
  bf16* Ow = Ob + (size_t)(wq * 32) * DM;
  if constexpr (MODE == 0) {
#pragma unroll
    for (int r = 0; r < 16; ++r) { const int orow = crow(r, hi);
#pragma unroll
      for (int d0 = 0; d0 < 4; ++d0) Ow[(size_t)orow * DM + d0 * 32 + r32] = tobf1(o[d0][r] * rli[r]); }
    __syncthreads();
  } else {
    LAS float* ex = (LAS float*)lds;
    __syncthreads();
    if (sgrp == 1) {
#pragma unroll
      for (int r = 0; r < 16; ++r)
#pragma unroll
        for (int d0 = 0; d0 < 4; ++d0) ex[(wq * 32 + crow(r, hi)) * 128 + d0 * 32 + r32] = o[d0][r] * rli[r];
    }
    __syncthreads();
    if (sgrp == 0) {
#pragma unroll
      for (int r = 0; r < 16; ++r) { const int orow = crow(r, hi); float dd[4]; float ss = 0.f;
#pragma unroll
        for (int d0 = 0; d0 < 4; ++d0) { dd[d0] = o[d0][r] * rli[r] - lam * ex[(wq * 32 + orow) * 128 + d0 * 32 + r32]; ss += dd[d0] * dd[d0]; }
        ss = half_sum32(ss);
        const float rs = oscale / sqrtf(ss * (1.0f / 128.0f) + LN_EPS);
#pragma unroll
        for (int d0 = 0; d0 < 4; ++d0) Ow[(size_t)orow * DM + d0 * 32 + r32] = tobf1(dd[d0] * rs * subln[d0 * 32 + r32]); }
    }
    __syncthreads();
  }
  if (ATT_PRIO) __builtin_amdgcn_s_setprio(0);
#undef VOFF
#undef KOFF
#undef PV
#undef PSM
#undef FSM
#undef QKT
#undef KROW
#undef SLOAD
#undef SWRITE
#undef SWAIT
#undef RESC
}
}

__device__ __forceinline__ void mla_attn_phase(CP P, LAS unsigned char* lds, const int tid) {
    const bf16* QM = (const bf16*)(P->ws + WS_QM); const bf16* KV = (const bf16*)(P->ws + WS_KV); const bf16* KR = (const bf16*)(P->ws + WS_KR); bf16* Gb = (bf16*)(P->ws + WS_G);
    const int c = blockIdx.x, G = gridDim.x;
    for (int u = c; u < 1024 + 32; u += G) {
        int b, h, qrow0, NT;
        if (u < 1024) { const int i = u >> 8, cc = u & 255; const int bh = (cc & 7) + 8 * i, qb = cc >> 3; b = bh >> 4; h = bh & 15; qrow0 = b * SEQ + qb * 256; NT = 4 + 128; }
        else { const int bh = u - 1024; b = bh >> 4; h = bh & 15; qrow0 = ML + b * CTXL; NT = 4; }
        att::attn_unit<0>(QM + (size_t)qrow0 * 3072 + h * 192, 3072, KV + h * 256, KV + h * 256 + 128, 4096, KR, b, 4, NT, Gb + (size_t)qrow0 * DM + h * 128, 0.f, nullptr, 1.f, lds, tid);
    }
}
template <int ATTV = 0>
__device__ __forceinline__ void da_attn_phase(CP P, float lam, float oscale, LAS unsigned char* lds, const int tid, const bool ctx_q) {
    const bf16* Z = (const bf16*)(P->ws + WS_Z); bf16* Gb = (bf16*)(P->ws + WS_G); const float* subln = P->in[27];
    const int c = blockIdx.x, G = gridDim.x;
    for (int u = c; u < 2048 + (ctx_q ? 64 : 0); u += G) {
        int b, h, qrow0, NT;
        if (u < 2048) { const int i = u >> 8, cc = u & 255; const int bh = (cc & 7) + 8 * (i >> 1), qb = (cc >> 3) + 32 * (i & 1); b = bh >> 4; h = bh & 15; qrow0 = b * SEQ + qb * 128; NT = 4 + 128; }
        else { const int v = u - 2048; const int bh = v >> 1; b = bh >> 4; h = bh & 15; qrow0 = ML + b * CTXL + (v & 1) * 128; NT = 4; }
        att::attn_unit<1, ATTV>(Z + (size_t)qrow0 * 6144 + h * 128, 6144, Z + 2048 + h * 128, Z + 4096 + h * 128, 6144, nullptr, b, 4, NT, Gb + (size_t)qrow0 * DM + h * 128, lam, subln, oscale, lds, tid);
    }
}

__device__ __forceinline__ unsigned f2ord(float f) { const unsigned u = __float_as_uint(f); return u ^ ((unsigned)((int)u >> 31) | 0x80000000u); }
__device__ __forceinline__ float ord2f(unsigned k) { return __uint_as_float((k & 0x80000000u) ? (k ^ 0x80000000u) : ~k); }
__device__ __forceinline__ void ce_desc(unsigned& a, unsigned& b) { const unsigned mx = a > b ? a : b, mn = a > b ? b : a; a = mx; b = mn; }
template <int N, bool DESC> __device__ __forceinline__ void bitonic_merge(unsigned* a) {
#pragma unroll
    for (int j = N / 2; j > 0; j >>= 1)
#pragma unroll
        for (int i = 0; i < N; ++i) { const int l = i ^ j; if (l > i) { if (DESC) ce_desc(a[i], a[l]); else ce_desc(a[l], a[i]); } }
}
template <int N, bool DESC> __device__ __forceinline__ void bitonic_sort(unsigned* a) {
#pragma unroll
    for (int k = 2; k <= N; k <<= 1)
#pragma unroll
        for (int j = k >> 1; j > 0; j >>= 1)
#pragma unroll
            for (int i = 0; i < N; ++i) { const int l = i ^ j; if (l > i) { const bool up = ((i & k) == 0); if (up == DESC) ce_desc(a[i], a[l]); else ce_desc(a[l], a[i]); } }
}
__device__ __forceinline__ void top16_of_64(unsigned (&a)[64]) {
    bitonic_sort<16, true>(a); bitonic_sort<16, false>(a + 16); bitonic_sort<16, true>(a + 32); bitonic_sort<16, false>(a + 48);
#pragma unroll
    for (int i = 0; i < 16; ++i) a[i] = a[i] > a[16 + i] ? a[i] : a[16 + i];
    bitonic_merge<16, true>(a);
#pragma unroll
    for (int i = 0; i < 16; ++i) a[32 + i] = a[32 + i] > a[48 + i] ? a[32 + i] : a[48 + i];
    bitonic_merge<16, false>(a + 32);
#pragma unroll
    for (int i = 0; i < 16; ++i) a[i] = a[i] > a[32 + i] ? a[i] : a[32 + i];
    bitonic_merge<16, true>(a);
}
template <int PASS> __device__ __forceinline__ void route_pass(const bf16* QP, const LAS char* lds, int tok, int head, int r32, int hi, unsigned (&top)[16]) {
    f32x16 acc[4] = {};
    const bf16* qp = QP + (size_t)tok * DM + head * 256 + PASS * 128 + hi * 8;
    bf16x8 qf[8];
#pragma unroll
    for (int ks = 0; ks < 8; ++ks) qf[ks] = *(const bf16x8*)(qp + ks * 16);
    const LAS char* Kl = lds + PASS * 32768;
#pragma unroll
    for (int kb = 0; kb < 4; ++kb)
#pragma unroll
        for (int ks = 0; ks < 8; ++ks) { const bf16x8 a = *(const LAS bf16x8*)(Kl + (kb * 32 + r32) * 256 + (((ks * 2 + hi) ^ (r32 & 15)) * 16));
            acc[kb] = __builtin_amdgcn_mfma_f32_32x32x16_bf16(a, qf[ks], acc[kb], 0, 0, 0); }
    unsigned key[64]; const unsigned base = 127u - 4u * (unsigned)hi;
#pragma unroll
    for (int kb = 0; kb < 4; ++kb)
#pragma unroll
        for (int r = 0; r < 16; ++r) key[kb * 16 + r] = (f2ord(acc[kb][r]) & ~127u) | (base - (unsigned)(kb * 32 + (r & 3) + 8 * (r >> 2)));
    top16_of_64(key);
    unsigned pr[16];
#pragma unroll
    for (int i = 0; i < 16; ++i) pr[i] = lane_xor32(key[15 - i], hi << 5);
#pragma unroll
    for (int i = 0; i < 16; ++i) key[i] = key[i] > pr[i] ? key[i] : pr[i];
    bitonic_merge<16, true>(key);
#pragma unroll
    for (int i = 0; i < 16; ++i) top[i] = key[i];
}
#ifndef ROUTE_SORT
#define ROUTE_SORT 1
#endif
#define DPP_U(v, ctrl) ((unsigned)__builtin_amdgcn_mov_dpp((int)(v), (ctrl), 0xF, 0xF, true))
template <int J> __device__ __forceinline__ unsigned lane_xor_u(unsigned v, int lane) {
    if (J == 1) return DPP_U(v, 0xB1);
    if (J == 2) return DPP_U(v, 0x4E);
    if (J == 4) { const unsigned t = DPP_U(v, 0x141); return DPP_U(t, 0x1B); }
    if (J == 8) { const unsigned t = DPP_U(v, 0x140); return DPP_U(t, 0x141); }
    if (J == 16) { const auto r = __builtin_amdgcn_permlane16_swap(v, v, false, false); return (lane & 16) ? r[0] : r[1]; }
    return lane_xor32(v, lane);
}
template <int K, int J> __device__ __forceinline__ void sort128_stage(unsigned& a0, unsigned& a1, int lane) {
    if constexpr (J == 64) { const unsigned mn = a0 < a1 ? a0 : a1, mx = a0 < a1 ? a1 : a0; a0 = mn; a1 = mx; }
    else { const unsigned p0 = lane_xor_u<J>(a0, lane), p1 = lane_xor_u<J>(a1, lane);
        const bool lower = (lane & J) == 0;
        const bool asc0 = (K >= 64) ? true : ((lane & K) == 0), asc1 = (K == 128) ? true : (K == 64 ? false : ((lane & K) == 0));
        const unsigned mn0 = a0 < p0 ? a0 : p0, mx0 = a0 < p0 ? p0 : a0, mn1 = a1 < p1 ? a1 : p1, mx1 = a1 < p1 ? p1 : a1;
        a0 = (lower == asc0) ? mn0 : mx0; a1 = (lower == asc1) ? mn1 : mx1; }
    if constexpr (J > 1) sort128_stage<K, J / 2>(a0, a1, lane);
    else if constexpr (K < 128) sort128_stage<K * 2, K>(a0, a1, lane);
}
__device__ __forceinline__ void sort128_asc(unsigned& a0, unsigned& a1, int lane) { sort128_stage<2, 1>(a0, a1, lane); }
__device__ __forceinline__ void route_phase(CP P, int L, int Mrows, LAS unsigned char* lds_, int tid, int lane, int wid, int gw, int NGW) {
    const bf16* QP = (const bf16*)(P->ws + WS_QP); unsigned* ROUTE = (unsigned*)(P->ws + WS_ROUTE);
    LAS char* lds = (LAS char*)(LAS unsigned char*)lds_;
    __syncthreads();
    {
        const bf16* K1 = (const bf16*)(P->ws + WS_PK1) + (size_t)L * 128 * 128; const bf16* K2 = (const bf16*)(P->ws + WS_PK2) + (size_t)L * 128 * 128;
        for (int c16 = tid; c16 < 2 * 128 * 16; c16 += NWAVES * 64) { const int mat = c16 >> 11, row = (c16 >> 4) & 127, ch = c16 & 15;
            const u32x4 w = *(const u32x4*)((mat ? K2 : K1) + row * 128 + ch * 8);
            *(LAS u32x4*)(lds + mat * 32768 + row * 256 + ((ch ^ (row & 15)) * 16)) = w; }
    }
    __syncthreads();
    LAS unsigned* sc = (LAS unsigned*)(lds + 65536) + wid * 2048;
    const int r32 = lane & 31, hi = lane >> 5;
    for (int item = gw; item < Mrows / 4; item += NGW) {
        const int tok = item * 4 + (r32 >> 3), head = r32 & 7;
        unsigned top0[16], top1[16];
        route_pass<0>(QP, lds, tok, head, r32, hi, top0);
        route_pass<1>(QP, lds, tok, head, r32, hi, top1);
        float v1[16], v2[16];
#pragma unroll
        for (int i = 0; i < 16; ++i) { v1[i] = ord2f(top0[i] & ~127u); v2[i] = ord2f(top1[i] & ~127u);
            sc[i * 64 + lane] = 127u - (top0[i] & 127u); sc[(16 + i) * 64 + lane] = 127u - (top1[i] & 127u); }
        unsigned ck[64]; int n = 0;
#pragma unroll
        for (int i = 0; i < 16; ++i)
#pragma unroll
            for (int j = 0; j < 16; ++j) if ((i + 1) * (j + 1) <= 16) { ck[n] = (f2ord(v1[i] + v2[j]) & ~255u) | (unsigned)(i * 16 + j); ++n; }
#pragma unroll
        for (int i = 50; i < 64; ++i) ck[i] = 0u;
        top16_of_64(ck);
        float ev[16]; float sum = 0.f; const float mx = ord2f(ck[0] & ~255u);
#pragma unroll
        for (int k = 0; k < 16; ++k) { ev[k] = __expf(ord2f(ck[k] & ~255u) - mx); sum += ev[k]; }
        const float inv = 1.0f / sum;
        unsigned ee[16];
#pragma unroll
        for (int k = 0; k < 16; ++k) { const unsigned pc = ck[k] & 255u; const unsigned i1 = sc[(pc >> 4) * 64 + lane], i2 = sc[(16 + (pc & 15u)) * 64 + lane]; ee[k] = i1 * 128u + i2; ev[k] *= inv; }
#if ROUTE_SORT
        { const int tq = r32 >> 3;
#pragma unroll
          for (int k = 0; k < 8; ++k) {
              const unsigned eL = ee[k], eH = ee[k + 8]; const float gL = ev[k], gH = ev[k + 8];
              sc[tq * 256 + head * 16 + hi * 8 + k] = hi ? eH : eL; sc[tq * 256 + 128 + head * 16 + hi * 8 + k] = __float_as_uint(hi ? gH : gL); }
#pragma unroll 1
          for (int t = 0; t < 4; ++t) {
              unsigned a0 = (sc[t * 256 + lane] << 7) | (unsigned)lane, a1 = (sc[t * 256 + 64 + lane] << 7) | (unsigned)(64 + lane);
              sort128_asc(a0, a1, lane);
              const unsigned g0 = sc[t * 256 + 128 + (a0 & 127u)], g1 = sc[t * 256 + 128 + (a1 & 127u)];
              u32x2* outp = (u32x2*)(ROUTE + (size_t)(item * 4 + t) * 256);
              outp[lane] = (u32x2){a0 >> 7, g0}; outp[64 + lane] = (u32x2){a1 >> 7, g1}; }
        }
#else
        u32x4* outp = (u32x4*)(ROUTE + ((size_t)tok * 128 + head * 16 + hi * 8) * 2);
#pragma unroll
        for (int k = 0; k < 8; k += 2) { u32x4 w;
            const unsigned eL0 = ee[k], eH0 = ee[k + 8], eL1 = ee[k + 1], eH1 = ee[k + 9]; const float gL0 = ev[k], gH0 = ev[k + 8], gL1 = ev[k + 1], gH1 = ev[k + 9];
            w.x = hi ? eH0 : eL0; w.y = __float_as_uint(hi ? gH0 : gL0); w.z = hi ? eH1 : eL1; w.w = __float_as_uint(hi ? gH1 : gL1);
            outp[k >> 1] = w; }
#endif
    }
}

typedef float f32x2 __attribute__((ext_vector_type(2)));
typedef float f32x32 __attribute__((ext_vector_type(32)));
typedef unsigned u32x6 __attribute__((ext_vector_type(6)));
typedef __bf16 bf16x32 __attribute__((ext_vector_type(32)));
typedef unsigned u32x16 __attribute__((ext_vector_type(16)));
typedef __bf16 bf16x2_t __attribute__((ext_vector_type(2)));
#ifndef GATHER_ZIGZAG
#define GATHER_ZIGZAG 0
#endif
#ifndef GATHER_PRE
#define GATHER_PRE 0
#endif
#ifndef GATHER_VECREG
#define GATHER_VECREG 1
#endif
#ifndef GATHER_MFMADOT
#define GATHER_MFMADOT 0
#endif
typedef short s16x4_t __attribute__((ext_vector_type(4)));
#ifndef GATHER_PAIRRED
#define GATHER_PAIRRED 1
#endif
#ifndef GATHER_EARLY
#define GATHER_EARLY 1
#endif
#ifndef GATHER_PACE
#define GATHER_PACE 0
#endif
#define XB_PACE(j) (XCD_BAR_WORDS + 64 * (j))
constexpr int GS = 6, GSLOT = 2 * PROW;
__device__ __forceinline__ void glds16(const void* gsrc, unsigned lds_dst) { unsigned keep;
  asm volatile("s_mov_b32 %0, m0\n\ts_mov_b32 m0, %2\n\ts_nop 0\n\tglobal_load_lds_dwordx4 %1, off\n\ts_mov_b32 m0, %0" : "=&s"(keep) : "v"(gsrc), "s"(lds_dst) : "memory"); }
template <int GMODE = 0>
__device__ __forceinline__ void gather_phase(CP P, int L, int Mrows, LAS unsigned char* lds, int wid, int lane_, int gw, int NGW, bool dry = false) {
    const unsigned char* UV = P->ws + WS_PU + (size_t)L * 16384 * PREC;
    const unsigned* ROUTE = (const unsigned*)(P->ws + WS_ROUTE); const float* MOD = (const float*)(P->ws + WS_MOD);
    bf16* X = (bf16*)(P->ws + WS_X); bf16* H = (bf16*)(P->ws + WS_H); bf16* Xo = dry ? (bf16*)(P->ws + WS_Y) : X; bf16* Ho = dry ? (bf16*)(P->ws + WS_G) : H;
    const float* lng = P->in[6] + (size_t)(L * 2 + 1) * DM; const float* lnb = P->in[7] + (size_t)(L * 2 + 1) * DM;
    const unsigned ring = (unsigned)(uintptr_t)lds + (unsigned)wid * (GS * GSLOT);
    const int nfull = (Mrows / NGW) * NGW, rem = Mrows - nfull; const bool can_coop = (rem * 4 == NGW);
    const int nround = nfull / NGW + (rem > 0 ? 1 : 0);
    const bool pace_ok = (rem == 0) || can_coop;
#define G_ROWOF(it_) ((can_coop && (it_) == nround - 1) ? (nfull + (int)blockIdx.x * 2 + (wid >> 2)) : (gw + (it_) * NGW))
    u32x2 nea = {0u, 0u}, neb = {0u, 0u}; u32x4 nh0 = {0u, 0u, 0u, 0u}, nh1 = nh0, nh2 = nh0, nh3 = nh0;
#define G_PREFETCH(rowN_, ln_) do { const int rn_ = (rowN_); nea = ((const u32x2*)(ROUTE + (size_t)rn_ * 256))[ln_]; neb = ((const u32x2*)(ROUTE + (size_t)rn_ * 256))[64 + (ln_)]; \
        const u32x4* hp_ = (const u32x4*)(H + (size_t)rn_ * DM) + 4 * (ln_); nh0 = hp_[0]; nh1 = hp_[1]; nh2 = hp_[2]; nh3 = hp_[3]; } while (0)
    if (nround > 0 && G_ROWOF(0) < Mrows) G_PREFETCH(G_ROWOF(0), launder_v(lane_));
#if GATHER_VECREG
    LAS unsigned* LNV = (LAS unsigned*)(lds + NWAVES * GS * GSLOT);
    for (int i = wid * 64 + lane_; i < 2048; i += NWAVES * 64) { const float* s_ = (i >> 10) ? lnb : lng; const int pr = i & 1023; LNV[i] = cvtpk(s_[2 * pr], s_[2 * pr + 1]); }
    __syncthreads();
    unsigned mg[16], ms[16], mc[16]; int cur_slot = -1;
#pragma unroll
    for (int i = 0; i < 16; ++i) { mg[i] = 0u; ms[i] = 0u; mc[i] = 0u; }
#endif
    bool pre = false;
#pragma unroll 1
    for (int it = 0; it < nround; ++it) {
#if GATHER_PACE
        if (pace_ok && it > 0) {
            if (wid == 0 && lane_ == 0) { const unsigned nloc = ((volatile LAS unsigned*)(lds + MISC_OFF))[8];
                if (nloc != 0u) { unsigned* pc = (unsigned*)(P->ws + WS_CTL) + CW_BAR + XB_PACE(xb_xcc_id());
                    const unsigned old = xb_add(pc, 1u), tgt = (old / nloc + 1u) * nloc; unsigned sp = 0u;
                    while ((int)(xb_ld(pc) - tgt) < 0 && ++sp < 20000u) __builtin_amdgcn_s_sleep(1); } }
            __syncthreads();
        }
#endif
        const bool coop = can_coop && (it == nround - 1);
        int row = G_ROWOF(it), k0 = 0, kn = 128;
        if (coop) { k0 = (wid & 3) * 32; kn = k0 + 32; }
        else if (row >= Mrows) break;
        const int lane = launder_v(lane_);
        const u32x2 ea = nea, eb = neb;
        unsigned eax, eay, ebx, eby;
        unsigned hw[16] = {nh0.x, nh0.y, nh0.z, nh0.w, nh1.x, nh1.y, nh1.z, nh1.w, nh2.x, nh2.y, nh2.z, nh2.w, nh3.x, nh3.y, nh3.z, nh3.w};
        float y[32];
#pragma unroll
        for (int i = 0; i < 32; ++i) y[i] = 0.f;
        { unsigned e0 = ea.x, e1 = ea.y, e2 = eb.x, e3 = eb.y;
          asm volatile("" : "+v"(e0), "+v"(e1), "+v"(e2), "+v"(e3), "+v"(hw[0]), "+v"(hw[1]), "+v"(hw[2]), "+v"(hw[3]), "+v"(hw[4]), "+v"(hw[5]), "+v"(hw[6]), "+v"(hw[7]),
                       "+v"(hw[8]), "+v"(hw[9]), "+v"(hw[10]), "+v"(hw[11]), "+v"(hw[12]), "+v"(hw[13]), "+v"(hw[14]), "+v"(hw[15]) :: "memory");
          eax = e0; eay = e1; ebx = e2; eby = e3; }
        const unsigned rd_a = ring + 16u * (unsigned)lane, rd_b = ring + 2048u + 8u * (unsigned)lane;
        const bool rev = GATHER_ZIGZAG && ((it & 1) != 0);
        const int kflip = rev ? (k0 + kn - 1) : 0, ksign = rev ? -1 : 1;
#define G_ISSUE(k) do { const int k_ = (k), ke_ = kflip + ksign * k_; const unsigned e_ = (unsigned)__builtin_amdgcn_readlane((int)(ke_ < 64 ? eax : ebx), ke_ & 63); \
        const unsigned char* rp_ = UV + (size_t)e_ * PREC + 16 * lane; const unsigned sb_ = ring + (unsigned)(k_ % GS) * GSLOT; \
        if (GMODE == 3) { glds16(rp_, sb_); if (lane < 32) glds16(rp_ + 2048, sb_ + 2048); } \
        else if (GMODE != 2) { glds16(rp_, sb_); glds16(rp_ + 1024, sb_ + 1024); glds16(rp_ + 2048, sb_ + 2048); } else { asm volatile("" :: "v"(rp_), "s"(sb_)); } } while (0)
#if GATHER_EARLY
        if (it + 1 < nround && G_ROWOF(it + 1) < Mrows) G_PREFETCH(G_ROWOF(it + 1), lane);
        if (!pre) {
#pragma unroll
            for (int k = 0; k < 6; ++k) G_ISSUE(k0 + k); }
#else
#pragma unroll
        for (int k = 0; k < 4; ++k) G_ISSUE(k0 + k);
        if (it + 1 < nround && G_ROWOF(it + 1) < Mrows) G_PREFETCH(G_ROWOF(it + 1), lane);
#endif
#define G_READ(k, ua, ub, va, vb) do { const unsigned so_ = (unsigned)((k) % GS) * GSLOT; \
        asm volatile("ds_read_b128 %0, %4\n\tds_read_b64 %1, %5\n\tds_read_b128 %2, %4 offset:1024\n\tds_read_b64 %3, %5 offset:512" \
                     : "=&v"(ua), "=&v"(ub), "=&v"(va), "=&v"(vb) : "v"(rd_a + so_), "v"(rd_b + so_) : "memory"); } while (0)
#pragma unroll 1
        for (int k = k0; k < kn; k += 2) {
            if (k + 4 < kn) { if (!GATHER_EARLY) { G_ISSUE(k + 4); G_ISSUE(k + 5); } if (GMODE == 3) asm volatile("s_waitcnt vmcnt(8)" ::: "memory"); else asm volatile("s_waitcnt vmcnt(12)" ::: "memory"); }
            else if (k == kn - 4) { if (GMODE == 3) asm volatile("s_waitcnt vmcnt(4)" ::: "memory"); else asm volatile("s_waitcnt vmcnt(6)" ::: "memory"); }
            else asm volatile("s_waitcnt vmcnt(0)" ::: "memory");
            u32x4 uaA, vaA, uaB, vaB; u32x2 ubA, vbA, ubB, vbB;
            G_READ(k, uaA, ubA, vaA, vbA); G_READ(k + 1, uaB, ubB, vaB, vbB);
            asm volatile("s_waitcnt lgkmcnt(0)" : "+v"(uaA), "+v"(ubA), "+v"(vaA), "+v"(vbA), "+v"(uaB), "+v"(ubB), "+v"(vaB), "+v"(vbB) :: "memory");
            if (GATHER_EARLY && k + 6 < kn) { G_ISSUE(k + 6); G_ISSUE(k + 7); }
            if (GMODE == 1 || GMODE == 3) continue;
            const u32x6 u6A = {uaA.x, uaA.y, uaA.z, uaA.w, ubA.x, ubA.y}, u6B = {uaB.x, uaB.y, uaB.z, uaB.w, ubB.x, ubB.y};
            const u32x16 ubfA = __builtin_bit_cast(u32x16, __builtin_amdgcn_cvt_scalef32_pk32_bf16_fp6(u6A, 1.0f));
            const u32x16 ubfB = __builtin_bit_cast(u32x16, __builtin_amdgcn_cvt_scalef32_pk32_bf16_fp6(u6B, 1.0f));
#if GATHER_MFMADOT
            f32x4 dgA = {0.f, 0.f, 0.f, 0.f}, dgB = {0.f, 0.f, 0.f, 0.f};
#pragma unroll
            for (int q = 0; q < 16; q += 2) { const u32x2 hq_ = {hw[q], hw[q + 1]}, xa_ = {ubfA[q], ubfA[q + 1]}, xb_ = {ubfB[q], ubfB[q + 1]};
                dgA = __builtin_amdgcn_mfma_f32_4x4x4bf16_1k(__builtin_bit_cast(s16x4_t, xa_), __builtin_bit_cast(s16x4_t, hq_), dgA, 0, 0, 0);
                dgB = __builtin_amdgcn_mfma_f32_4x4x4bf16_1k(__builtin_bit_cast(s16x4_t, xb_), __builtin_bit_cast(s16x4_t, hq_), dgB, 0, 0, 0); }
            float a0, a1 = 0.f, b0, b1 = 0.f;
            { const float x0 = dgA[0], x1 = dgA[1], x2 = dgA[2], x3 = dgA[3], y0 = dgB[0], y1 = dgB[1], y2 = dgB[2], y3 = dgB[3];
              a0 = DPP_F(x0, 0x00); a0 += DPP_F(x1, 0x55); a0 += DPP_F(x2, 0xAA); a0 += DPP_F(x3, 0xFF);
              b0 = DPP_F(y0, 0x00); b0 += DPP_F(y1, 0x55); b0 += DPP_F(y2, 0xAA); b0 += DPP_F(y3, 0xFF); }
#else
            float a0 = 0.f, a1 = 0.f, b0 = 0.f, b1 = 0.f;
#pragma unroll
            for (int q = 0; q < 16; q += 2) { const unsigned h0_ = hw[q], h1_ = hw[q + 1], x0_ = ubfA[q], x1_ = ubfA[q + 1], z0_ = ubfB[q], z1_ = ubfB[q + 1];
                a0 = __builtin_amdgcn_fdot2_f32_bf16(__builtin_bit_cast(bf16x2_t, h0_), __builtin_bit_cast(bf16x2_t, x0_), a0, false);
                a1 = __builtin_amdgcn_fdot2_f32_bf16(__builtin_bit_cast(bf16x2_t, h1_), __builtin_bit_cast(bf16x2_t, x1_), a1, false);
                b0 = __builtin_amdgcn_fdot2_f32_bf16(__builtin_bit_cast(bf16x2_t, h0_), __builtin_bit_cast(bf16x2_t, z0_), b0, false);
                b1 = __builtin_amdgcn_fdot2_f32_bf16(__builtin_bit_cast(bf16x2_t, h1_), __builtin_bit_cast(bf16x2_t, z1_), b1, false); }
#endif
            const int keA = kflip + ksign * k, keB = keA + ksign;
            const unsigned gsel = keA < 64 ? eay : eby;
#if GATHER_PAIRRED
            float wA, wB;
            { const auto sw = __builtin_amdgcn_permlane32_swap(__float_as_uint(GATHER_MFMADOT ? a0 : a0 + a1), __float_as_uint(GATHER_MFMADOT ? b0 : b0 + b1), false, false);
#if GATHER_MFMADOT
              float c2 = __uint_as_float(sw[0]) + __uint_as_float(sw[1]); c2 += DPP_F(c2, 0x141); c2 += DPP_F(c2, 0x140);
              const float d2 = sum_xor16(c2) * (1.0f / U_SCALE);
#else
              const float d2 = half_sum32(__uint_as_float(sw[0]) + __uint_as_float(sw[1])) * (1.0f / U_SCALE);
#endif
              const float g2 = gelu_tanh(d2) * (1.0f / V_SCALE);
              const float gA = __uint_as_float((unsigned)__builtin_amdgcn_readlane((int)__float_as_uint(g2), 0)), gB = __uint_as_float((unsigned)__builtin_amdgcn_readlane((int)__float_as_uint(g2), 32));
              wA = __uint_as_float((unsigned)__builtin_amdgcn_readlane((int)gsel, keA & 63)) * gA; wB = __uint_as_float((unsigned)__builtin_amdgcn_readlane((int)gsel, keB & 63)) * gB; }
#else
            const float dA = wave_sum(a0 + a1) * (1.0f / U_SCALE), dB = wave_sum(b0 + b1) * (1.0f / U_SCALE);
            const float wA = __uint_as_float((unsigned)__builtin_amdgcn_readlane((int)gsel, keA & 63)) * gelu_tanh(dA) * (1.0f / V_SCALE);
            const float wB = __uint_as_float((unsigned)__builtin_amdgcn_readlane((int)gsel, keB & 63)) * gelu_tanh(dB) * (1.0f / V_SCALE);
#endif
            const u32x6 v6A = {vaA.x, vaA.y, vaA.z, vaA.w, vbA.x, vbA.y};
            const f32x32 vfA = __builtin_amdgcn_cvt_scalef32_pk32_f32_fp6(v6A, 1.0f);
#pragma unroll
            for (int i = 0; i < 32; ++i) y[i] += wA * vfA[i];
            const u32x6 v6B = {vaB.x, vaB.y, vaB.z, vaB.w, vbB.x, vbB.y};
            const f32x32 vfB = __builtin_amdgcn_cvt_scalef32_pk32_f32_fp6(v6B, 1.0f);
#pragma unroll
            for (int i = 0; i < 32; ++i) y[i] += wB * vfB[i];
        }
#if GATHER_PRE
        pre = (it + 1 < nround) && (G_ROWOF(it + 1) < Mrows);
        if (pre) { unsigned n0 = nea.x, n2 = neb.x; asm volatile("" : "+v"(n0), "+v"(n2) :: "memory"); eax = n0; ebx = n2;
            const int k0n = (can_coop && (it + 1 == nround - 1)) ? (wid & 3) * 32 : 0;
#pragma unroll
            for (int k = 0; k < 6; ++k) G_ISSUE(k0n + k); }
#endif
#undef G_READ
#undef G_ISSUE
        if (coop) {
            LAS f32x4* mine = (LAS f32x4*)(lds + wid * (GS * GSLOT)) + lane * 8;
#pragma unroll
            for (int i = 0; i < 8; ++i) mine[i] = (f32x4){y[4 * i], y[4 * i + 1], y[4 * i + 2], y[4 * i + 3]};
            __syncthreads();
            if ((wid & 3) == 0) {
#pragma unroll
                for (int j = 1; j < 4; ++j) { const LAS f32x4* oth = (const LAS f32x4*)(lds + (wid + j) * (GS * GSLOT)) + lane * 8;
#pragma unroll
                    for (int i = 0; i < 8; ++i) { const f32x4 t = oth[i]; y[4 * i] += t.x; y[4 * i + 1] += t.y; y[4 * i + 2] += t.z; y[4 * i + 3] += t.w; } }
            }
            __syncthreads();
            if ((wid & 3) != 0) continue;
        }
        const int slot = row_slot(row);
        const float* mod = MOD + (size_t)(L * 3 + slot) * 12288;
        const int le = launder_v(lane);
#if GATHER_VECREG
        if (slot != cur_slot) { cur_slot = slot; float t_[32];
            load_row_f32_b(mod + 5 * 2048, le, t_);
#pragma unroll
            for (int i = 0; i < 16; ++i) mg[i] = cvtpk(t_[2 * i], t_[2 * i + 1]);
            if (L < NLAYER - 1) { const float* modn = MOD + (size_t)((L + 1) * 3 + slot) * 12288;
                load_row_f32_b(modn, le, t_);
#pragma unroll
                for (int i = 0; i < 16; ++i) ms[i] = cvtpk(t_[2 * i], t_[2 * i + 1]);
                load_row_f32_b(modn + 2048, le, t_);
#pragma unroll
                for (int i = 0; i < 16; ++i) mc[i] = cvtpk(t_[2 * i], t_[2 * i + 1]); } }
        { float xx[32]; load_row_bf16_b(X + (size_t)row * DM, le, xx);
#pragma unroll
          for (int i = 0; i < 16; ++i) { y[2 * i] = ALPHA * xx[2 * i] + bflo(mg[i]) * y[2 * i]; y[2 * i + 1] = ALPHA * xx[2 * i + 1] + bfhi(mg[i]) * y[2 * i + 1]; } }
        { float mean, rstd; ln_stats(y, mean, rstd);
          const LAS u32x4* gp = (const LAS u32x4*)(LNV + le * 16); const LAS u32x4* bp = (const LAS u32x4*)(LNV + 1024 + le * 16);
#pragma unroll
          for (int q = 0; q < 4; ++q) { const u32x4 g4 = gp[q], b4 = bp[q]; const unsigned gw_[4] = {g4.x, g4.y, g4.z, g4.w}, bw_[4] = {b4.x, b4.y, b4.z, b4.w};
#pragma unroll
              for (int j = 0; j < 4; ++j) { const int i = 8 * q + 2 * j; y[i] = (y[i] - mean) * rstd * bflo(gw_[j]) + bflo(bw_[j]); y[i + 1] = (y[i + 1] - mean) * rstd * bfhi(gw_[j]) + bfhi(bw_[j]); } }
          if (L < NLAYER - 1) { store_row_bf16_b(Xo + (size_t)row * DM, le, y);
              ln_stats(y, mean, rstd); float a_[32];
#pragma unroll
              for (int i = 0; i < 16; ++i) { a_[2 * i] = (y[2 * i] - mean) * rstd * (1.0f + bflo(mc[i])) + bflo(ms[i]); a_[2 * i + 1] = (y[2 * i + 1] - mean) * rstd * (1.0f + bfhi(mc[i])) + bfhi(ms[i]); }
              store_row_bf16_b(Ho + (size_t)row * DM, le, a_); }
          else store_row_f32_b(P->out + (size_t)row * DM, le, y); }
        asm volatile("s_waitcnt vmcnt(0)" ::: "memory");
        continue;
#endif
        { float xx[32], gg[32]; load_row_bf16_b(X + (size_t)row * DM, le, xx); load_row_f32_b(mod + 5 * 2048, le, gg);
#pragma unroll
          for (int i = 0; i < 32; ++i) y[i] = ALPHA * xx[i] + gg[i] * y[i]; }
        if (L < NLAYER - 1) { const float* modn = MOD + (size_t)((L + 1) * 3 + slot) * 12288;
            finish_row<true>(y, lng, lnb, Xo + (size_t)row * DM, modn, modn + 2048, Ho + (size_t)row * DM, nullptr, le); }
        else finish_row<true>(y, lng, lnb, nullptr, nullptr, nullptr, nullptr, P->out + (size_t)row * DM, le);
        asm volatile("s_waitcnt vmcnt(0)" ::: "memory");
    }
#undef G_PREFETCH
#undef G_ROWOF
}

#ifndef ROPE_TEST
#define ROPE_TEST 0
#endif
#ifndef PROBE_DUP
#define PROBE_DUP 0
#endif
#define NOINL __forceinline__
__device__ __forceinline__ CP launder_cp(CP p) { asm volatile("" : "+s"(p)); return p; }
#define GETP() launder_cp((CP)__builtin_amdgcn_kernarg_segment_ptr())
__device__ __forceinline__ int uni(int v) { return __builtin_amdgcn_readfirstlane(v); }
__device__ __forceinline__ LAS unsigned char* uni_lds(LAS unsigned char* p) { return (LAS unsigned char*)(unsigned)__builtin_amdgcn_readfirstlane((int)(unsigned)(uintptr_t)p); }
#define PH_IDS const int wid = uni(wv_), lane = launder_v(lane_id_fresh()) & 63, tid = (wid & 7) * 64 + lane; const int gw = blockIdx.x * NWAVES + wid, NGW = gridDim.x * NWAVES; (void)lane; (void)gw; (void)NGW; (void)tid;

__device__ NOINL void ph_prologue(int wv_, LAS unsigned char* lds_) { CP P = GETP(); LAS unsigned char* lds = uni_lds(lds_); PH_IDS p0_prologue(P, lds, tid, lane, wid, gw, NGW); if (PROBE_DUP == 5) p0_prologue(P, lds, tid, lane, wid, gw, NGW);
    if (PROBE_DUP >= 21 && PROBE_DUP <= 23) { __syncthreads(); p0_prologue(P, lds, tid, lane, wid, gw, NGW, 1 << (PROBE_DUP - 21 < 0 ? 0 : (PROBE_DUP - 21) & 3)); } }
__device__ NOINL void ph_modreduce(int wv_) { CP P = GETP(); PH_IDS mod_reduce(P, gw, lane, NGW); }
__device__ NOINL void ph_first(int wv_) { CP P = GETP(); PH_IDS
#pragma unroll 1
    for (int rep = 0; rep < (PROBE_DUP == 6 ? 2 : 1); ++rep) first_row_pass(P, lane, gw, NGW); }
__device__ NOINL void ph_postmix(int wv_, LAS unsigned char* lds_, int L_, int M_) { CP P = GETP(); LAS unsigned char* lds = uni_lds(lds_); const int L = uni(L_), Mrows = uni(M_); PH_IDS
    if (POSTMIX_LDS) post_mixer_pass_lds(P, L, Mrows, lds, tid, lane, gw, NGW); else post_mixer_pass(P, L, Mrows, lane, gw, NGW); }
__device__ NOINL void ph_vstats(int wv_, int M_) { CP P = GETP(); const int Mrows = uni(M_); PH_IDS
#pragma unroll 1
    for (int rep = 0; rep < (PROBE_DUP == 6 ? 2 : 1); ++rep) vstats_pass(P, Mrows, lane, gw, NGW); }
__device__ NOINL void ph_spatial(int wv_, LAS unsigned char* lds_, int j_, int M_) { CP P = GETP(); LAS unsigned char* lds = uni_lds(lds_); const int j = uni(j_), Mrows = uni(M_); PH_IDS
#pragma unroll 1
    for (int rep = 0; rep < (PROBE_DUP == 6 ? 2 : 1); ++rep) spatial_phase(P, j, Mrows, lds, tid, lane, wid); }
__device__ NOINL void ph_mla_norm(int wv_) { CP P = GETP(); PH_IDS
#pragma unroll 1
    for (int rep = 0; rep < (PROBE_DUP == 6 ? 2 : 1); ++rep) mla_norm_pass(P, lane, gw, NGW); }
__device__ NOINL void ph_rope(int wv_, int which_) { CP P = GETP(); const int which = uni(which_); PH_IDS
    if (which == 0) rope_pass((bf16*)(P->ws + WS_QM), 3072, 128, 16, 192, lane, gw, NGW);
    else rope_pass((bf16*)(P->ws + WS_Z), 6144, 0, 64, 64, lane, gw, NGW); }
__device__ NOINL void ph_attn_mla(int wv_, LAS unsigned char* lds_) { CP P = GETP(); LAS unsigned char* lds = uni_lds(lds_); PH_IDS mla_attn_phase(P, lds, tid); if (PROBE_DUP == 2 || PROBE_DUP == 9) mla_attn_phase(P, lds, tid); }
__device__ NOINL void ph_attn_da(int wv_, LAS unsigned char* lds_, int L_, bool ctx_q) { CP P = GETP(); LAS unsigned char* lds = uni_lds(lds_); const int L = uni(L_); PH_IDS
    const float* lp = P->in[26];
    const float s01 = wave_sum(lp[lane] * lp[64 + lane]), s23 = wave_sum(lp[128 + lane] * lp[192 + lane]);
    const float lam_init = 0.8f - 0.6f * expf(-0.3f * (float)L);
    const float lam = expf(s01) - expf(s23) + lam_init;
    if (!(PROBE_DUP >= 11 && PROBE_DUP <= 15)) da_attn_phase(P, lam, 1.0f - lam_init, lds, tid, ctx_q);
    if (PROBE_DUP == 2 || PROBE_DUP == 10) da_attn_phase(P, lam, 1.0f - lam_init, lds, tid, ctx_q);
    if (PROBE_DUP >= 11 && PROBE_DUP <= 15) { da_attn_phase<PROBE_DUP >= 11 && PROBE_DUP <= 15 ? PROBE_DUP - 10 : 0>(P, lam, 1.0f - lam_init, lds, tid, ctx_q); __syncthreads(); }
    if (PROBE_DUP >= 11 && PROBE_DUP <= 15) da_attn_phase(P, lam, 1.0f - lam_init, lds, tid, ctx_q); }
__device__ NOINL void ph_route(int wv_, LAS unsigned char* lds_, int L_, int M_) { CP P = GETP(); LAS unsigned char* lds = uni_lds(lds_); const int L = uni(L_), Mrows = uni(M_); PH_IDS
#pragma unroll 1
    for (int rep = 0; rep < (PROBE_DUP == 4 ? 2 : 1); ++rep) route_phase(P, L, Mrows, lds, tid, lane, wid, gw, NGW); }
__device__ NOINL void ph_gather(int wv_, LAS unsigned char* lds_, int L_, int M_) { CP P = GETP(); LAS unsigned char* lds = uni_lds(lds_); const int L = uni(L_), Mrows = uni(M_); PH_IDS
    if (PROBE_DUP == 3) { gather_phase<0>(P, L, Mrows, lds, wid, lane, gw, NGW, true); }
    if (PROBE_DUP == 7) { gather_phase<1>(P, L, Mrows, lds, wid, lane, gw, NGW, true); }
    if (PROBE_DUP == 17) { gather_phase<3>(P, L, Mrows, lds, wid, lane, gw, NGW, true); }
    if (PROBE_DUP == 8) { gather_phase<2>(P, L, Mrows, lds, wid, lane, gw, NGW, true); }
    gather_phase<0>(P, L, Mrows, lds, wid, lane, gw, NGW); }

enum GemmId { G_GM_IN = 0, G_GM_OUT, G_MLA_IN, G_MLA_UQ, G_MLA_UKV, G_MLA_OUT, G_DA_IN, G_DA_OUT, G_PEER_Q };
__device__ NOINL void ph_gemm(int wv_, LAS unsigned char* lds_, int id_, int L_, int M_) {
    CP P = GETP(); LAS unsigned char* lds = uni_lds(lds_); const int id = uni(id_), L = uni(L_), Mrows = uni(M_); PH_IDS
    unsigned char* ws = P->ws; const int jj = L / 3;
    size_t a = WS_H, b = 0, o = 0; int M = MT, N = 2048, K = 2048, act = 0, rope = 0;
    switch (id) {
        case G_GM_IN:   a = WS_H;    b = WS_GMWIN + (size_t)jj * 4096 * 2048 * 2;  o = WS_Z;  M = Mrows; N = 4096; K = 2048; act = 1; break;
        case G_GM_OUT:  a = WS_G;    b = WS_GMWOUT + (size_t)jj * 2048 * 2048 * 2; o = WS_Y;  M = Mrows; N = 2048; K = 2048; break;
        case G_MLA_IN:  a = WS_H;    b = WS_MLAIN;  o = WS_C;  N = 1280; K = 2048; break;
        case G_MLA_UQ:  a = WS_CQN;  b = WS_MLAUQ;  o = WS_QM; N = 3072; K = 512;  rope = (ROPE_TEST == 2) ? 0 : 2; break;
        case G_MLA_UKV: a = WS_CKVN; b = WS_MLAUKV; o = WS_KV; N = 4096; K = 512;  break;
        case G_MLA_OUT: a = WS_G;    b = WS_MLAOUT; o = WS_Y;  N = 2048; K = 2048; break;
        case G_DA_IN:   a = WS_H;    b = WS_DAIN;   o = WS_Z;  N = 6144; K = 2048; rope = (ROPE_TEST == 1) ? 0 : 1; break;
        case G_DA_OUT:  a = WS_G;    b = WS_DAOUT;  o = WS_Y;  M = Mrows; N = 2048; K = 2048; break;
        default:        a = WS_H;    b = WS_PWQ + (size_t)L * 2048 * 2048 * 2;     o = WS_QP; M = Mrows; N = 2048; K = 2048; break;
    }
    pg8::Gemm g{(const pg8::bf16_t*)(ws + a), (const pg8::bf16_t*)(ws + b), M, N, K}; pg8::StaticOrder S; S.init(M, N, (int)gridDim.x, (int)blockIdx.x);
    pg8::EpiR E{(pg8::bf16_t*)(ws + o), N, act, rope, (const float*)(ws + WS_ROPE)};
#pragma unroll 1
    for (int rep = 0; rep < (PROBE_DUP == 1 ? 2 : 1); ++rep) { pg8::gemm_phase<pg8::EpiR, pg8::StaticOrder, true, true>((PG8_LAS unsigned char*)lds, g, S, E, tid); __syncthreads(); }
#if TAIL_REMAP
    int TL = -1; bool tail_u = false;
    if (L == 0) { if (id == G_GM_IN) { TL = 0; tail_u = true; } else if (id == G_GM_OUT) { TL = 0; } else if (id == G_PEER_Q) { TL = 1; tail_u = true; } }
    else if (L == 1) { if (id == G_MLA_IN) { TL = 1; } else if (id == G_MLA_OUT) { TL = 2; tail_u = true; } else if (id == G_PEER_Q) { TL = 2; } }
    else if (L == 2) { if (id == G_DA_IN) { TL = 3; tail_u = true; } else if (id == G_DA_OUT) { TL = 3; } }
    if (TL >= 0) {
        const int units = (M / 256) * (N / 256), G = (int)gridDim.x, tail = units % G, c = (int)blockIdx.x;
        const float* src = (tail_u ? P->in[11] : P->in[12]) + (size_t)TL * 16384 * 2048; unsigned char* dst = ws + WS_PU + (size_t)TL * 16384 * PREC;
#else
    const bool tail_u = (id == G_GM_OUT || id == G_MLA_OUT || id == G_DA_OUT), tail_v = (id == G_PEER_Q);
    if ((tail_u || tail_v) && L + 1 < NLAYER) {
        const int units = (M / 256) * (N / 256), G = (int)gridDim.x, tail = units % G, c = (int)blockIdx.x;
        const float* src = (tail_u ? P->in[11] : P->in[12]) + (size_t)(L + 1) * 16384 * 2048; unsigned char* dst = ws + WS_PU + (size_t)(L + 1) * 16384 * PREC;
#endif
        LAS float* scr = (LAS float*)(lds + wid * 16384);
        if (tail != 0 && c >= tail) cvt_table_fp6(src, dst, 16384, tail_u ? U_SCALE : V_SCALE, scr, lane, (c - tail) * NWAVES + wid, (G - tail) * NWAVES, tail_u ? 0 : 1);
        else if (tail == 0) {
#pragma unroll 1
            for (int rep = 0; rep < (PROBE_DUP == 18 ? 3 : 1); ++rep) cvt_table_fp6(src, dst, 16384, tail_u ? U_SCALE : V_SCALE, scr, lane, gw, NGW, tail_u ? 0 : 1); }
    }
}

__global__ void __launch_bounds__(NWAVES * 64, 2) mk_fwd(Params Pv) {
    extern __shared__ __attribute__((aligned(16))) unsigned char lds_g[];
    LAS unsigned char* lds = (LAS unsigned char*)lds_g;
    const int wv = __builtin_amdgcn_readfirstlane((int)threadIdx.x >> 6);
    const int tid = wv * 64 + lane_id_fresh();
    for (int u = tid; u < (LDS_BYTES - RING_BYTES) / 4; u += NWAVES * 64) ((LAS unsigned*)(lds + RING_BYTES))[u] = 0u;
    __syncthreads();
    const int lo = Pv.ph_lo, hi = Pv.ph_hi;
    unsigned* barw = (unsigned*)(Pv.ws + WS_CTL) + CW_BAR;
    XcdBarrier bar; bar.bar = barw; bar.x = 0; bar.st = nullptr;
    if (hi - lo > 1) bar = xcd_barrier_post(barw, (volatile LAS unsigned*)(lds + MISC_OFF) + 8, tid == 0);
    int ph = 0;
#ifndef SEL
#define SELP(k) true
#else
#define SELP(k) ((k) == SEL)
#endif
    enum { RUN_BASE = __COUNTER__ + 1 };
#define RUN(call) do { if (SELP(__COUNTER__ - RUN_BASE) && ph >= lo && ph < hi) { call; } if (ph >= lo && ph + 1 < hi) xcd_barrier(bar, wv == 0 && lane_id_fresh() == 0); ++ph; } while (0)
    RUN(ph_prologue(wv, lds));
    RUN(ph_modreduce(wv));
    RUN(ph_first(wv));
#define LAYER(LL) do { constexpr int L = (LL); constexpr int kind = L % 3, jj = L / 3; constexpr int Mrows = (L == NLAYER - 1) ? ML : MT; \
        constexpr bool ctx_dead = (L == NLAYER - 2) && ((NLAYER - 1) % 3 == 0) && (kind != 0); constexpr int Mlive = ctx_dead ? ML : Mrows; \
        if (kind == 0) {                          \
            RUN(ph_gemm(wv, lds, G_GM_IN, L, Mrows)); \
            RUN(ph_vstats(wv, Mrows)); \
            RUN(ph_spatial(wv, lds, jj, Mrows)); \
            RUN(ph_gemm(wv, lds, G_GM_OUT, L, Mrows)); \
        } else if (kind == 1) {                   \
            RUN(ph_gemm(wv, lds, G_MLA_IN, L, Mrows)); \
            RUN(ph_mla_norm(wv)); \
            RUN(ph_gemm(wv, lds, G_MLA_UQ, L, Mrows); ph_gemm(wv, lds, G_MLA_UKV, L, Mrows)); \
            if (ROPE_TEST == 2) { RUN(ph_rope(wv, 0)); } \
            RUN(ph_attn_mla(wv, lds)); \
            RUN(ph_gemm(wv, lds, G_MLA_OUT, L, Mrows)); \
        } else {                                  \
            RUN(ph_gemm(wv, lds, G_DA_IN, L, Mrows); if (ROPE_TEST == 1) { __syncthreads(); } ); \
            if (ROPE_TEST == 1) { RUN(ph_rope(wv, 1)); } \
            RUN(ph_attn_da(wv, lds, L, !ctx_dead)); \
            RUN(ph_gemm(wv, lds, G_DA_OUT, L, Mlive)); \
        } \
        RUN(ph_postmix(wv, lds, L, Mlive));                \
        RUN(ph_gemm(wv, lds, G_PEER_Q, L, Mlive));    \
        RUN(ph_route(wv, lds, L, Mlive));             \
        RUN(ph_gather(wv, lds, L, Mlive));            \
    } while (0)
    LAYER(0); LAYER(1); LAYER(2); LAYER(3);
#undef LAYER
#undef RUN
}

extern "C" void kernel_launch(void* const* d_in, const int* in_sizes, int n_in, void* d_out, int out_size, void* d_ws, size_t ws_size, hipStream_t stream) {
    static int grid = 0;
    if (grid == 0) {
        if (n_in != 29 || in_sizes[0] != ML * DM || out_size != ML * DM || ws_size < WS_END) {
            fprintf(stderr, "kernel_launch: shape mismatch: n_in %d in0 %d out %d ws %zu (need %zu); nothing launched\n", n_in, n_in > 0 ? in_sizes[0] : -1, out_size, ws_size, (size_t)WS_END); grid = -1; return; }
        int dev = 0, cus = 0, per_cu = 0;
        if (hipGetDevice(&dev) != hipSuccess || hipDeviceGetAttribute(&cus, hipDeviceAttributeMultiprocessorCount, dev) != hipSuccess) { fprintf(stderr, "kernel_launch: device query failed\n"); grid = -1; return; }
        if (hipFuncSetAttribute((const void*)mk_fwd, hipFuncAttributeMaxDynamicSharedMemorySize, LDS_BYTES) != hipSuccess) { fprintf(stderr, "kernel_launch: hipFuncSetAttribute failed\n"); grid = -1; return; }
        if (hipOccupancyMaxActiveBlocksPerMultiprocessor(&per_cu, (const void*)mk_fwd, NWAVES * 64, LDS_BYTES) != hipSuccess || per_cu < 1)
            fprintf(stderr, "kernel_launch: note: occupancy query reports %d workgroups per CU\n", per_cu);
        (void)hipGetLastError();
        grid = cus;
    }
    if (grid < 0) return;
    if (hipMemsetAsync((char*)d_ws + WS_CTL, 0, CTL_ZERO_BYTES, stream) != hipSuccess) { fprintf(stderr, "kernel_launch: memset failed\n"); return; }
    Params p{};
    for (int i = 0; i < 29; ++i) p.in[i] = (const float*)d_in[i];
    p.out = (float*)d_out; p.ws = (unsigned char*)d_ws;
#if MK_ONE_LAUNCH
    p.ph_lo = 0; p.ph_hi = NPH;
    hipLaunchKernelGGL(mk_fwd, dim3(grid), dim3(NWAVES * 64), LDS_BYTES, stream, p);
#else
    for (int li = 0; li < NPH; ++li) { p.ph_lo = li; p.ph_hi = li + 1; hipLaunchKernelGGL(mk_fwd, dim3(grid), dim3(NWAVES * 64), LDS_BYTES, stream, p); }
#endif
    const hipError_t le = hipPeekAtLastError();
    if (le != hipSuccess) fprintf(stderr, "kernel_launch: launch failed: %s\n", hipGetErrorName(le));
}
```

```cpp
#include <hip/hip_runtime.h>
#include <cstdio>
#include <cstdint>
#ifndef MK_ONE_LAUNCH
#define MK_ONE_LAUNCH 1
#endif
__device__ __forceinline__ int launder_v(int v) { asm volatile("" : "+v"(v)); return v; }
__device__ __forceinline__ int lane_id_fresh() { unsigned m = ~0u; asm volatile("" : "+s"(m)); return (int)__builtin_amdgcn_mbcnt_hi(m, __builtin_amdgcn_mbcnt_lo(m, 0u)); }
namespace pg8 {
#define PG8_LAS __attribute__((address_space(3)))
typedef unsigned short bf16_t;
typedef short bf16x8 __attribute__((ext_vector_type(8)));
typedef float f32x4 __attribute__((ext_vector_type(4)));
typedef unsigned u32x4 __attribute__((ext_vector_type(4)));
constexpr int BM = 256, BK = 64, HALF = 128, HTB = HALF * BK * 2  , STAGE_BYTES = 8 * HTB, NXCD = 8, WGM = 8;

__host__ __device__ __forceinline__ int lds_byte(int r, int c) { const int st = (r >> 4) * 2 + (c >> 5), rr = r & 15, cc = c & 31, ob = rr * 64 + cc * 2; return st * 1024 + (ob ^ (((ob >> 9) & 1) << 5)); }
__host__ __device__ __forceinline__ void stage_rc(int b, int& R, int& C) { const int st = b / 1024, sb = b % 1024, swz = sb ^ (((sb >> 9) & 1) << 5); R = (st >> 1) * 16 + swz / 64; C = (st & 1) * 32 + (swz % 64) / 2; }
__host__ __device__ __forceinline__ int perm32(int rho) { const int n = rho >> 4, i = rho & 15; return 8 * (i >> 2) + 4 * n + (i & 3); }

struct Unit { int pm, pn; };
struct Gemm { const bf16_t* A; const bf16_t* Bt; int M, N, K; };

struct StaticOrder {
    int nM, nN, nwg, G, c;
    __host__ __device__ void init(int M, int N, int G_, int c_) { nM = M / BM; nN = N / BM; nwg = nM * nN; G = G_; c = c_; }
    __host__ __device__ bool next(int i, Unit& u) const {
        const long L = (long)i * G + c; if (L >= nwg) return false;
        int wgid = (int)L; { const int q = nwg / NXCD, r = nwg % NXCD, xcd = wgid % NXCD, off = wgid / NXCD; wgid = (xcd < r ? xcd * (q + 1) : r * (q + 1) + (xcd - r) * q) + off; }
        const int nig = WGM * nN, gid = wgid / nig, fm = gid * WGM, gsz = (nM - fm) < WGM ? (nM - fm) : WGM;
        u.pm = fm + ((wgid % nig) % gsz); u.pn = (wgid % nig) / gsz; return true;
    }
    __device__ __forceinline__ void a_ready(const Unit&) const {}
    __device__ __forceinline__ void done(const Unit&) const {}
};

__device__ __forceinline__ unsigned cvt_pk_bf16(float lo, float hi) { unsigned r; asm volatile("v_cvt_pk_bf16_f32 %0, %1, %2" : "=v"(r) : "v"(lo), "v"(hi)); return r; }
typedef float f32x2 __attribute__((ext_vector_type(2)));
__device__ __forceinline__ f32x2 gelu_pk(f32x2 v) {
    const f32x2 av = __builtin_elementwise_abs(v), d = av * 0.2316418882f + 1.0f;
    f32x2 t; t.x = __builtin_amdgcn_rcpf(d.x); t.y = __builtin_amdgcn_rcpf(d.y);
    f32x2 q = t * 0.5307027145f + (-0.7265760135f); q = q * t + 0.7107068705f; q = q * t + (-0.142248368f); q = q * t + 0.127414796f; q = q * t;
    const f32x2 s = (v * v) * (-0.72134752044f);
    f32x2 e; e.x = __builtin_amdgcn_exp2f(s.x); e.y = __builtin_amdgcn_exp2f(s.y);
    const f32x2 m = v * (q * e), r = v - m;
    f32x2 o; o.x = v.x < 0.f ? m.x : r.x; o.y = v.y < 0.f ? m.y : r.y; return o;
}

template <int ACT  > struct EpiBf16 {
    static constexpr bool PERM = true, AFTER_DRAIN = false; static_assert(ACT == 0 || ACT == 1, "EpiBf16: ACT is 0 (none) or 1 (gelu_pk)");
    bf16_t* O; int ldc; const float* bias; int split_cols; size_t split_stride; float scale0;
    __device__ __forceinline__ void operator()(const f32x4 (&acc)[2][2][4][2], const Unit& u, int wr, int wc, int fr, int fq) const {
        const int row0 = u.pm * BM + wr * 64 + fr; int colt = u.pn * BM; bf16_t* base = O;
        float sc = 1.f; if (split_cols) { const int t = colt / split_cols; base += (size_t)t * split_stride; colt -= t * split_cols; if (t == 0) sc = scale0; }
        const int col0 = colt + wc * 32 + 8 * fq, bcol0 = u.pn * BM + wc * 32 + 8 * fq;
        f32x4 bv[2][2];
#pragma unroll
        for (int bj = 0; bj < 2; ++bj)
#pragma unroll
            for (int n = 0; n < 2; ++n) bv[bj][n] = bias ? *(const f32x4*)(bias + bcol0 + bj * HALF + 4 * n) : (f32x4){0.f, 0.f, 0.f, 0.f};
#pragma unroll
        for (int ai = 0; ai < 2; ++ai)
#pragma unroll
            for (int m = 0; m < 4; ++m) { bf16_t* rowp = base + (size_t)(row0 + ai * HALF + m * 16) * ldc + col0;
#pragma unroll
                for (int bj = 0; bj < 2; ++bj) { f32x4 v0 = acc[ai][bj][m][0] + bv[bj][0], v1 = acc[ai][bj][m][1] + bv[bj][1];
                    if (ACT == 1) { f32x2 a = gelu_pk((f32x2){v0[0], v0[1]}), b = gelu_pk((f32x2){v0[2], v0[3]}), c = gelu_pk((f32x2){v1[0], v1[1]}), d = gelu_pk((f32x2){v1[2], v1[3]});
                        v0 = (f32x4){a.x, a.y, b.x, b.y}; v1 = (f32x4){c.x, c.y, d.x, d.y}; }
                    v0 = v0 * sc; v1 = v1 * sc; u32x4 w; w.x = cvt_pk_bf16(v0[0], v0[1]); w.y = cvt_pk_bf16(v0[2], v0[3]); w.z = cvt_pk_bf16(v1[0], v1[1]); w.w = cvt_pk_bf16(v1[2], v1[3]);
                    *(u32x4*)(rowp + bj * HALF) = w; } }
    }
};
template <class Epi, class Sched, bool ALIGN_EPI = false, bool SP2 = false>
__device__ __forceinline__ void gemm_phase(PG8_LAS unsigned char* lds, const Gemm g, const Sched& S, const Epi& E, const int tid_in) {
    const int tid = launder_v(tid_in) & 511, wid = __builtin_amdgcn_readfirstlane(tid >> 6), lane = tid & 63, wr = wid >> 2, wc = wid & 3, fr = lane & 15, fq = lane >> 4;
    const int K = g.K, nt = K / BK;
    unsigned voffA[2], voffB[2];
#pragma unroll
    for (int i = 0; i < 2; ++i) { int R, C; stage_rc(tid * 16 + i * 8192, R, C); const int Rb = Epi::PERM ? ((R & ~31) + perm32(R & 31)) : R;
        voffA[i] = (unsigned)(R * K + C) * 2u; voffB[i] = (unsigned)(Rb * K + C) * 2u; }
    const size_t kstep = (size_t)(BK * 2);
    const size_t hstep = (size_t)HALF * K * 2;
    const size_t tstep = 2 * hstep;
    const unsigned ldsw = (unsigned)wid * 1024u;
    const int aoff = lds_byte(wr * 64 + fr, fq * 8), boff = lds_byte(wc * 32 + fr, fq * 8);
#define PG8_SA(b, h) (((b) * 2 + (h)) * HTB)
#define PG8_SB(b, h) ((4 + (b) * 2 + (h)) * HTB)
#define PG8_STAGE(bufoff, gbase, voff) do { _Pragma("unroll") for (int _i = 0; _i < 2; ++_i) \
        __builtin_amdgcn_global_load_lds((const unsigned*)((const char*)(gbase) + (voff)[_i]), (PG8_LAS unsigned*)(lds + (bufoff) + ldsw + _i * 8192), 16, 0, 0); } while (0)
#define PG8_LDA(dst, b, h) do { _Pragma("unroll") for (int m = 0; m < 4; ++m) _Pragma("unroll") for (int k = 0; k < 2; ++k) dst[m][k] = *(const PG8_LAS bf16x8*)(lds + PG8_SA(b, h) + aoff + m * 2048 + k * 1024); } while (0)
#define PG8_LDB(dst, b, h) do { _Pragma("unroll") for (int n = 0; n < 2; ++n) _Pragma("unroll") for (int k = 0; k < 2; ++k) dst[n][k] = *(const PG8_LAS bf16x8*)(lds + PG8_SB(b, h) + boff + n * 2048 + k * 1024); } while (0)
#define PG8_MMA(ai, bj, At, Bt) do { __builtin_amdgcn_s_setprio(1); _Pragma("unroll") for (int m = 0; m < 4; ++m) _Pragma("unroll") for (int n = 0; n < 2; ++n) _Pragma("unroll") for (int k = 0; k < 2; ++k) \
        acc[ai][bj][m][n] = __builtin_amdgcn_mfma_f32_16x16x32_bf16(Bt[n][k], At[m][k], acc[ai][bj][m][n], 0, 0, 0); __builtin_amdgcn_s_setprio(0); } while (0)
#define PG8_WAIT_V(n) asm volatile("s_waitcnt vmcnt(" #n ")" ::: "memory")
#define PG8_WAIT_L(n) asm volatile("s_waitcnt lgkmcnt(" #n ")" ::: "memory")
#define PG8_BAR __builtin_amdgcn_s_barrier()
#define PG8_SCHED __builtin_amdgcn_sched_barrier(0)
    Unit cur, nxt; int ui = 0;
    if (!S.next(0, cur)) return;
    f32x4 acc[2][2][4][2];
#pragma unroll
    for (int a = 0; a < 2; ++a)
#pragma unroll
        for (int b = 0; b < 2; ++b)
#pragma unroll
            for (int m = 0; m < 4; ++m)
#pragma unroll
                for (int n = 0; n < 2; ++n) acc[a][b][m][n] = (f32x4){0.f, 0.f, 0.f, 0.f};
    bf16x8 At[4][2], B0[2][2], B1[2][2];
    const char* cA = (const char*)g.A + (size_t)cur.pm * tstep; const char* cB = (const char*)g.Bt + (size_t)cur.pn * tstep;
    S.a_ready(cur);
    if constexpr (SP2) {
        PG8_STAGE(PG8_SB(0, 0), cB, voffB); PG8_STAGE(PG8_SB(0, 1), cB + hstep, voffB); PG8_STAGE(PG8_SA(0, 0), cA, voffA); PG8_STAGE(PG8_SA(0, 1), cA + hstep, voffA);
        if (wr == 1) PG8_BAR;
        PG8_WAIT_V(2); PG8_BAR;
        PG8_STAGE(PG8_SB(1, 0), cB + kstep, voffB); PG8_STAGE(PG8_SA(1, 0), cA + kstep, voffA); PG8_STAGE(PG8_SB(1, 1), cB + hstep + kstep, voffB);
        PG8_WAIT_V(6); PG8_BAR;
    } else {
        PG8_STAGE(PG8_SB(0, 0), cB, voffB); PG8_STAGE(PG8_SA(0, 0), cA, voffA); PG8_STAGE(PG8_SB(0, 1), cB + hstep, voffB); PG8_STAGE(PG8_SA(0, 1), cA + hstep, voffA);
        if (wr == 1) PG8_BAR;
        PG8_WAIT_V(4); PG8_BAR;
        PG8_STAGE(PG8_SB(1, 0), cB + kstep, voffB); PG8_STAGE(PG8_SA(1, 0), cA + kstep, voffA); PG8_STAGE(PG8_SB(1, 1), cB + hstep + kstep, voffB);
        PG8_WAIT_V(6); PG8_BAR;
    }
    for (;;) {
        const bool has_next = S.next(ui + 1, nxt);
        const char* nA = has_next ? (const char*)g.A + (size_t)nxt.pm * tstep : cA; const char* nB = has_next ? (const char*)g.Bt + (size_t)nxt.pn * tstep : cB;
        for (int t = 0; t < nt; t += 2) {
            const bool last = (t == nt - 2);
            const char* a1 = cA + (size_t)(t + 1) * kstep;
            const char* a2 = last ? nA : cA + (size_t)(t + 2) * kstep; const char* b2 = last ? nB : cB + (size_t)(t + 2) * kstep;
            const char* a3 = a2 + kstep; const char* b3 = b2 + kstep;
            if (last && has_next) S.a_ready(nxt);
            if constexpr (SP2) {
            PG8_LDB(B0, 0, 0); PG8_LDB(B1, 0, 1); PG8_SCHED; PG8_LDA(At, 0, 0); PG8_STAGE(PG8_SA(1, 1), a1 + hstep, voffA);
            PG8_WAIT_V(8); PG8_WAIT_L(0); PG8_BAR; PG8_MMA(0, 0, At, B0); PG8_MMA(0, 1, At, B1); PG8_BAR; PG8_SCHED;
            PG8_LDA(At, 0, 1); PG8_STAGE(PG8_SB(0, 0), b2, voffB); PG8_STAGE(PG8_SB(0, 1), b2 + hstep, voffB); PG8_STAGE(PG8_SA(0, 0), a2, voffA);
            PG8_WAIT_V(8); PG8_WAIT_L(0); PG8_BAR; PG8_MMA(1, 0, At, B0); PG8_MMA(1, 1, At, B1); PG8_BAR; PG8_SCHED;
            PG8_LDB(B0, 1, 0); PG8_LDB(B1, 1, 1); PG8_SCHED; PG8_LDA(At, 1, 0); PG8_STAGE(PG8_SA(0, 1), a2 + hstep, voffA);
            PG8_WAIT_V(8); PG8_WAIT_L(0); PG8_BAR; PG8_MMA(0, 0, At, B0); PG8_MMA(0, 1, At, B1); PG8_BAR; PG8_SCHED;
            PG8_LDA(At, 1, 1); PG8_STAGE(PG8_SB(1, 0), b3, voffB); PG8_STAGE(PG8_SB(1, 1), b3 + hstep, voffB); PG8_STAGE(PG8_SA(1, 0), a3, voffA);
            PG8_WAIT_V(8); PG8_WAIT_L(0); PG8_BAR; PG8_MMA(1, 0, At, B0); PG8_MMA(1, 1, At, B1); PG8_BAR; PG8_SCHED;
            } else {
            PG8_LDB(B0, 0, 0); PG8_SCHED; PG8_LDA(At, 0, 0); PG8_STAGE(PG8_SA(1, 1), a1 + hstep, voffA);
            PG8_WAIT_L(8); PG8_BAR; PG8_WAIT_L(0); PG8_MMA(0, 0, At, B0); PG8_BAR; PG8_SCHED;
            PG8_LDB(B1, 0, 1); PG8_STAGE(PG8_SB(0, 0), b2, voffB);
            PG8_BAR; PG8_WAIT_L(0); PG8_MMA(0, 1, At, B1); PG8_BAR;
            PG8_LDA(At, 0, 1); PG8_STAGE(PG8_SA(0, 0), a2, voffA);
            PG8_BAR; PG8_WAIT_L(0); PG8_MMA(1, 0, At, B0); PG8_BAR; PG8_SCHED;
            PG8_STAGE(PG8_SB(0, 1), b2 + hstep, voffB);
            PG8_WAIT_V(6); PG8_BAR; PG8_MMA(1, 1, At, B1); PG8_BAR;
            PG8_LDB(B0, 1, 0); PG8_SCHED; PG8_LDA(At, 1, 0); PG8_STAGE(PG8_SA(0, 1), a2 + hstep, voffA);
            PG8_WAIT_L(8); PG8_BAR; PG8_WAIT_L(0); PG8_MMA(0, 0, At, B0); PG8_BAR; PG8_SCHED;
            PG8_LDB(B1, 1, 1); PG8_STAGE(PG8_SB(1, 0), b3, voffB);
            PG8_BAR; PG8_WAIT_L(0); PG8_MMA(0, 1, At, B1); PG8_BAR;
            PG8_LDA(At, 1, 1); PG8_STAGE(PG8_SA(1, 0), a3, voffA);
            PG8_BAR; PG8_WAIT_L(0); PG8_MMA(1, 0, At, B0); PG8_BAR; PG8_SCHED;
            PG8_STAGE(PG8_SB(1, 1), b3 + hstep, voffB);
            PG8_WAIT_V(6); PG8_BAR; PG8_MMA(1, 1, At, B1); PG8_BAR;
            }
        }
        if constexpr (ALIGN_EPI) { if (wr == 0) PG8_BAR; }
        if constexpr (!Epi::AFTER_DRAIN) { E(acc, cur, wr, wc, fr, fq); S.done(cur); }
        if (!has_next) break;
#pragma unroll
        for (int a = 0; a < 2; ++a)
#pragma unroll
            for (int b = 0; b < 2; ++b)
#pragma unroll
                for (int m = 0; m < 4; ++m)
#pragma unroll
                    for (int n = 0; n < 2; ++n) acc[a][b][m][n] = (f32x4){0.f, 0.f, 0.f, 0.f};
        cur = nxt; cA = nA; cB = nB; ++ui;
        if constexpr (ALIGN_EPI) { if (wr == 1) PG8_BAR; }
    }
    PG8_WAIT_V(0);
    if constexpr (!ALIGN_EPI) { if (wr == 0) PG8_BAR; }
    PG8_BAR;
    if constexpr (Epi::AFTER_DRAIN) { E.fused(acc, cur, wr, wc, fr, fq, lds, wid, lane); S.done(cur); }
#undef PG8_SA
#undef PG8_SB
#undef PG8_STAGE
#undef PG8_LDA
#undef PG8_LDB
#undef PG8_MMA
#undef PG8_WAIT_V
#undef PG8_WAIT_L
#undef PG8_BAR
#undef PG8_SCHED
}
}

namespace pg8 {
__device__ __forceinline__ float gelu_tanh(float x) {
    const float t = x * (1.5957691216057308f + 0.07135481627f * x * x);
    const float e = __builtin_amdgcn_exp2f(-1.4426950408889634f * t);
    return x * __builtin_amdgcn_rcpf(1.0f + e);
}
template <int ACT> struct EpiT {
    static constexpr bool PERM = true, AFTER_DRAIN = false;
    bf16_t* O; int ldc;
    __device__ __forceinline__ void operator()(const f32x4 (&acc)[2][2][4][2], const Unit& u, int wr, int wc, int fr, int fq) const {
        const int row0 = u.pm * BM + wr * 64 + fr; const int col0 = u.pn * BM + wc * 32 + 8 * fq;
#pragma unroll
        for (int ai = 0; ai < 2; ++ai)
#pragma unroll
            for (int m = 0; m < 4; ++m) { bf16_t* rowp = O + (size_t)(row0 + ai * HALF + m * 16) * ldc + col0;
#pragma unroll
                for (int bj = 0; bj < 2; ++bj) { f32x4 v0 = acc[ai][bj][m][0], v1 = acc[ai][bj][m][1];
                    if (ACT == 2) { v0 = (f32x4){gelu_tanh(v0[0]), gelu_tanh(v0[1]), gelu_tanh(v0[2]), gelu_tanh(v0[3])}; v1 = (f32x4){gelu_tanh(v1[0]), gelu_tanh(v1[1]), gelu_tanh(v1[2]), gelu_tanh(v1[3])}; }
                    u32x4 w; w.x = cvt_pk_bf16(v0[0], v0[1]); w.y = cvt_pk_bf16(v0[2], v0[3]); w.z = cvt_pk_bf16(v1[0], v1[1]); w.w = cvt_pk_bf16(v1[2], v1[3]);
                    *(u32x4*)(rowp + bj * HALF) = w; } }
    }
};
struct EpiR {
    static constexpr bool PERM = true, AFTER_DRAIN = false;
    bf16_t* O; int ldc; int act; int rope; const float* ropet;
    __device__ __forceinline__ void operator()(const f32x4 (&acc)[2][2][4][2], const Unit& u, int wr, int wc, int fr, int fq) const {
        const int row0 = u.pm * BM + wr * 64 + fr; const int col0 = u.pn * BM + wc * 32 + 8 * fq;
        const bool rrows = rope != 0 && u.pm < 64;
#pragma unroll
        for (int ai = 0; ai < 2; ++ai)
#pragma unroll
            for (int m = 0; m < 4; ++m) { const int grow = row0 + ai * HALF + m * 16; bf16_t* rowp = O + (size_t)grow * ldc + col0;
#pragma unroll
                for (int bj = 0; bj < 2; ++bj) { f32x4 v0 = acc[ai][bj][m][0], v1 = acc[ai][bj][m][1];
                    if (act) { v0 = (f32x4){gelu_tanh(v0[0]), gelu_tanh(v0[1]), gelu_tanh(v0[2]), gelu_tanh(v0[3])}; v1 = (f32x4){gelu_tanh(v1[0]), gelu_tanh(v1[1]), gelu_tanh(v1[2]), gelu_tanh(v1[3])}; }
                    if (rrows) { const int blk = u.pn * 8 + bj * 4 + wc; const int b6 = blk % 6; const bool on = rope == 1 ? (blk < 128) : (b6 >= 4); const int half = rope == 1 ? (blk & 1) : (b6 - 4);
                        if (on) { const int t = grow & 8191; const int pos = half ? (t & 63) : (t >> 6);
                            const float* cp = ropet + pos * 16 + 8 * (fq & 1); const f32x4 c0 = *(const f32x4*)cp, c1 = *(const f32x4*)(cp + 4), s0 = *(const f32x4*)(cp + 2048), s1 = *(const f32x4*)(cp + 2052);
                            f32x4 p0, p1;
#pragma unroll
                            for (int i = 0; i < 4; ++i) { const float a_ = v0[i], b_ = v1[i];
                                const auto r0 = __builtin_amdgcn_permlane32_swap(__float_as_uint(a_), __float_as_uint(a_), false, false);
                                const auto r1 = __builtin_amdgcn_permlane32_swap(__float_as_uint(b_), __float_as_uint(b_), false, false);
                                const unsigned x0_ = (fq & 2) ? r0[0] : r0[1], x1_ = (fq & 2) ? r1[0] : r1[1]; p0[i] = __uint_as_float(x0_); p1[i] = __uint_as_float(x1_); }
                            if (fq & 2) { v0 = p0 * s0 + v0 * c0; v1 = p1 * s1 + v1 * c1; } else { v0 = v0 * c0 - p0 * s0; v1 = v1 * c1 - p1 * s1; } } }
                    u32x4 w; w.x = cvt_pk_bf16(v0[0], v0[1]); w.y = cvt_pk_bf16(v0[2], v0[3]); w.z = cvt_pk_bf16(v1[0], v1[1]); w.w = cvt_pk_bf16(v1[2], v1[3]);
                    *(u32x4*)(rowp + bj * HALF) = w; } }
    }
};
}

constexpr int DM = 2048, NBATCH = 2, SEQ = 8192, CTXL = 256;
constexpr int ML = NBATCH * SEQ;
constexpr int MC = NBATCH * CTXL;
constexpr int MT = ML + MC;
constexpr int NLAYER = 4;
constexpr float ALPHA = 1.6817928305074290f, LN_EPS = 1e-6f;
constexpr int NWAVES = 8;
constexpr float U_SCALE = 64.0f, V_SCALE = 4.0f;
constexpr int PROW = 1536;
constexpr int PREC = 2 * PROW;
constexpr int NPH = 35;

constexpr size_t MiB = 1ull << 20;
constexpr size_t WS_CTL = 0, CTL_ZERO_BYTES = 1 * MiB;
constexpr int    CW_BAR = 4096;
constexpr size_t WS_MOD = 128 * 1024;
constexpr size_t WS_VST = 1 * MiB;
constexpr size_t WS_ROPE = 1 * MiB + 160 * 1024;
constexpr size_t WS_MODP = 1 * MiB + 256 * 1024;
constexpr size_t WS_GMWIN = 6 * MiB;
constexpr size_t WS_GMWOUT = WS_GMWIN + 32 * MiB;
constexpr size_t WS_GMWS = WS_GMWOUT + 16 * MiB;
constexpr size_t WS_PWQ = WS_GMWS + 1 * MiB;
constexpr size_t WS_PK1 = WS_PWQ + 32 * MiB;
constexpr size_t WS_PK2 = WS_PK1 + 512 * 1024;
constexpr size_t WS_MLAIN = WS_PK1 + 1 * MiB;
constexpr size_t WS_MLAUQ = WS_MLAIN + 5 * MiB;
constexpr size_t WS_MLAUKV = WS_MLAUQ + 3 * MiB;
constexpr size_t WS_MLAOUT = WS_MLAUKV + 4 * MiB;
constexpr size_t WS_DAIN = WS_MLAOUT + 8 * MiB;
constexpr size_t WS_DAOUT = WS_DAIN + 24 * MiB;
constexpr size_t WS_PU = WS_DAOUT + 8 * MiB;
constexpr size_t WS_PV = WS_PU + 96 * MiB;
constexpr size_t WS_X = WS_PV + 96 * MiB;
constexpr size_t WS_H = WS_X + 66 * MiB;
constexpr size_t WS_G = WS_H + 66 * MiB;
constexpr size_t WS_Y = WS_G + 66 * MiB;
constexpr size_t WS_QP = WS_Y + 66 * MiB;
constexpr size_t WS_Z = WS_QP + 66 * MiB;
constexpr size_t WS_C = WS_Z + 198 * MiB;
constexpr size_t WS_CQN = WS_C + 42 * MiB;
constexpr size_t WS_CKVN = WS_CQN + 17 * MiB;
constexpr size_t WS_KR = WS_CKVN + 17 * MiB;
constexpr size_t WS_QM = WS_KR + 3 * MiB;
constexpr size_t WS_KV = WS_QM + 99 * MiB;
constexpr size_t WS_ROUTE = WS_KV + 132 * MiB;
constexpr size_t WS_END = WS_ROUTE + 17 * MiB;
static_assert((size_t)MT * DM * 2 == 66 * MiB, "row buffer size");

constexpr int RING_BYTES = 155648, MISC_OFF = RING_BYTES + 320, LDS_BYTES = 159744;

#define GAS __attribute__((address_space(1)))
#define LAS __attribute__((address_space(3)))
typedef unsigned short bf16;
typedef unsigned u32x4 __attribute__((ext_vector_type(4)));
typedef unsigned u32x2 __attribute__((ext_vector_type(2)));
typedef float f32x4 __attribute__((ext_vector_type(4)));
typedef float f32x16 __attribute__((ext_vector_type(16)));
typedef short bf16x8 __attribute__((ext_vector_type(8)));
typedef short s16x4 __attribute__((ext_vector_type(4)));
#define LDS_WAIT() asm volatile("s_waitcnt lgkmcnt(0)" ::: "memory")

__device__ __forceinline__ unsigned cvtpk(float lo, float hi) { unsigned r; asm("v_cvt_pk_bf16_f32 %0, %1, %2" : "=v"(r) : "v"(lo), "v"(hi)); return r; }
__device__ __forceinline__ float bflo(unsigned w) { return __uint_as_float(w << 16); }
__device__ __forceinline__ float bfhi(unsigned w) { return __uint_as_float(w & 0xffff0000u); }
__device__ __forceinline__ float bf1(bf16 b) { return __uint_as_float((unsigned)b << 16); }
__device__ __forceinline__ bf16 tobf1(float f) { return (bf16)(cvtpk(f, 0.f) & 0xffffu); }
#define DPP_F(v, ctrl) __int_as_float(__builtin_amdgcn_mov_dpp(__float_as_int(v), (ctrl), 0xF, 0xF, true))
__device__ __forceinline__ float row_sum16(float v) { v += DPP_F(v, 0xB1); v += DPP_F(v, 0x4E); v += DPP_F(v, 0x141); v += DPP_F(v, 0x140); return v; }
__device__ __forceinline__ float sum_xor16(float v) { const auto r = __builtin_amdgcn_permlane16_swap(__float_as_uint(v), __float_as_uint(v), false, false); return __uint_as_float(r[0]) + __uint_as_float(r[1]); }
__device__ __forceinline__ float sum_xor32(float v) { const auto r = __builtin_amdgcn_permlane32_swap(__float_as_uint(v), __float_as_uint(v), false, false); return __uint_as_float(r[0]) + __uint_as_float(r[1]); }
__device__ __forceinline__ float wave_sum(float v) { return sum_xor32(sum_xor16(row_sum16(v))); }
__device__ __forceinline__ float half_sum32(float v) { return sum_xor16(row_sum16(v)); }
__device__ __forceinline__ float lane_xor16(float v, int lane) { const auto r = __builtin_amdgcn_permlane16_swap(__float_as_uint(v), __float_as_uint(v), false, false); return __uint_as_float((lane & 16) ? r[0] : r[1]); }
__device__ __forceinline__ unsigned lane_xor32(unsigned v, int lane) { const auto r = __builtin_amdgcn_permlane32_swap(v, v, false, false); return (lane & 32) ? r[0] : r[1]; }
__device__ __forceinline__ float gelu_tanh(float x) { return pg8::gelu_tanh(x); }

__device__ __forceinline__ void load_row_bf16(const bf16* row, int lane, float (&v)[32]) {
#pragma unroll
    for (int j = 0; j < 4; ++j) { const u32x4 w = ((const u32x4*)row)[64 * j + lane];
        v[8 * j + 0] = bflo(w.x); v[8 * j + 1] = bfhi(w.x); v[8 * j + 2] = bflo(w.y); v[8 * j + 3] = bfhi(w.y);
        v[8 * j + 4] = bflo(w.z); v[8 * j + 5] = bfhi(w.z); v[8 * j + 6] = bflo(w.w); v[8 * j + 7] = bfhi(w.w); }
}
__device__ __forceinline__ void store_row_bf16(bf16* row, int lane, const float (&v)[32]) {
#pragma unroll
    for (int j = 0; j < 4; ++j) { u32x4 w; w.x = cvtpk(v[8 * j + 0], v[8 * j + 1]); w.y = cvtpk(v[8 * j + 2], v[8 * j + 3]); w.z = cvtpk(v[8 * j + 4], v[8 * j + 5]); w.w = cvtpk(v[8 * j + 6], v[8 * j + 7]);
        ((u32x4*)row)[64 * j + lane] = w; }
}
__device__ __forceinline__ void load_row_f32(const float* row, int lane, float (&v)[32]) {
#pragma unroll
    for (int j = 0; j < 4; ++j) { const f32x4 a = ((const f32x4*)row)[128 * j + 2 * lane], b = ((const f32x4*)row)[128 * j + 2 * lane + 1];
        v[8 * j + 0] = a.x; v[8 * j + 1] = a.y; v[8 * j + 2] = a.z; v[8 * j + 3] = a.w; v[8 * j + 4] = b.x; v[8 * j + 5] = b.y; v[8 * j + 6] = b.z; v[8 * j + 7] = b.w; }
}
__device__ __forceinline__ void store_row_f32(float* row, int lane, const float (&v)[32]) {
#pragma unroll
    for (int j = 0; j < 4; ++j) { ((f32x4*)row)[128 * j + 2 * lane] = (f32x4){v[8 * j + 0], v[8 * j + 1], v[8 * j + 2], v[8 * j + 3]};
        ((f32x4*)row)[128 * j + 2 * lane + 1] = (f32x4){v[8 * j + 4], v[8 * j + 5], v[8 * j + 6], v[8 * j + 7]}; }
}
__device__ __forceinline__ void load_row_bf16_b(const bf16* row, int lane, float (&v)[32]) {
#pragma unroll
    for (int j = 0; j < 4; ++j) { const u32x4 w = ((const u32x4*)row)[4 * lane + j];
        v[8 * j + 0] = bflo(w.x); v[8 * j + 1] = bfhi(w.x); v[8 * j + 2] = bflo(w.y); v[8 * j + 3] = bfhi(w.y);
        v[8 * j + 4] = bflo(w.z); v[8 * j + 5] = bfhi(w.z); v[8 * j + 6] = bflo(w.w); v[8 * j + 7] = bfhi(w.w); }
}
__device__ __forceinline__ void store_row_bf16_b(bf16* row, int lane, const float (&v)[32]) {
#pragma unroll
    for (int j = 0; j < 4; ++j) { u32x4 w; w.x = cvtpk(v[8 * j + 0], v[8 * j + 1]); w.y = cvtpk(v[8 * j + 2], v[8 * j + 3]); w.z = cvtpk(v[8 * j + 4], v[8 * j + 5]); w.w = cvtpk(v[8 * j + 6], v[8 * j + 7]);
        ((u32x4*)row)[4 * lane + j] = w; }
}
__device__ __forceinline__ void load_row_f32_b(const float* row, int lane, float (&v)[32]) {
#pragma unroll
    for (int q = 0; q < 8; ++q) { const f32x4 a = ((const f32x4*)row)[8 * lane + q];
        v[4 * q + 0] = a.x; v[4 * q + 1] = a.y; v[4 * q + 2] = a.z; v[4 * q + 3] = a.w; }
}
__device__ __forceinline__ void store_row_f32_b(float* row, int lane, const float (&v)[32]) {
#pragma unroll
    for (int q = 0; q < 8; ++q) ((f32x4*)row)[8 * lane + q] = (f32x4){v[4 * q + 0], v[4 * q + 1], v[4 * q + 2], v[4 * q + 3]};
}
__device__ __forceinline__ void ln_stats(const float (&v)[32], float& mean, float& rstd) {
    float s = 0.f;
#pragma unroll
    for (int i = 0; i < 32; ++i) s += v[i];
    mean = wave_sum(s) * (1.0f / DM);
    float q = 0.f;
#pragma unroll
    for (int i = 0; i < 32; ++i) { const float d = v[i] - mean; q += d * d; }
    rstd = 1.0f / sqrtf(wave_sum(q) * (1.0f / DM) + LN_EPS);
}
template <bool LAYB>
__device__ __forceinline__ void finish_row(float (&z)[32], const float* lng, const float* lnb, bf16* Xrow, const float* sh, const float* sc, bf16* Hrow, float* Orow, int lane) {
    float mean, rstd; ln_stats(z, mean, rstd);
    { float g[32], b[32]; if (LAYB) { load_row_f32_b(lng, lane, g); load_row_f32_b(lnb, lane, b); } else { load_row_f32(lng, lane, g); load_row_f32(lnb, lane, b); }
#pragma unroll
      for (int i = 0; i < 32; ++i) z[i] = (z[i] - mean) * rstd * g[i] + b[i]; }
    if (Xrow) { if (LAYB) store_row_bf16_b(Xrow, lane, z); else store_row_bf16(Xrow, lane, z); }
    if (Orow) { if (LAYB) store_row_f32_b(Orow, lane, z); else store_row_f32(Orow, lane, z); }
    if (Hrow) {
        ln_stats(z, mean, rstd);
        float a[32], s[32]; if (LAYB) { load_row_f32_b(sc, lane, a); load_row_f32_b(sh, lane, s); } else { load_row_f32(sc, lane, a); load_row_f32(sh, lane, s); }
#pragma unroll
        for (int i = 0; i < 32; ++i) a[i] = (z[i] - mean) * rstd * (1.0f + a[i]) + s[i];
        if (LAYB) store_row_bf16_b(Hrow, lane, a); else store_row_bf16(Hrow, lane, a);
    }
}
__device__ __forceinline__ int row_slot(int row) { return row < ML ? (row >> 13) : 2; }

__device__ __forceinline__ unsigned f2bf_rne(float f) { unsigned u = __float_as_uint(f); return (u + 0x7fffu + ((u >> 16) & 1u)) >> 16; }
__device__ __forceinline__ unsigned pk2(float lo, float hi) { return f2bf_rne(lo) | (f2bf_rne(hi) << 16); }
__device__ __forceinline__ void p0_transpose_item(const float* W, int K, int N, bf16* WT, LAS float* scr, int item, int lane) {
    const int nblk = N / 32, kb = item / nblk, nb = item % nblk, k0 = 64 * kb, n0 = 32 * nb;
    f32x4 t[8];
#pragma unroll
    for (int i = 0; i < 8; ++i) t[i] = *(const f32x4*)(W + (size_t)(k0 + 8 * i + (lane >> 3)) * N + n0 + 4 * (lane & 7));
#pragma unroll
    for (int i = 0; i < 8; ++i) { LAS float* d = scr + (8 * i + (lane >> 3)) * 33 + 4 * (lane & 7); d[0] = t[i].x; d[1] = t[i].y; d[2] = t[i].z; d[3] = t[i].w; }
    LDS_WAIT(); asm volatile("" ::: "memory");
    const int c = lane & 7;
#pragma unroll
    for (int j = 0; j < 4; ++j) { const int n = (lane >> 3) + 8 * j; const LAS float* s = scr + (8 * c) * 33 + n;
        u32x4 o; o.x = pk2(s[0 * 33], s[1 * 33]); o.y = pk2(s[2 * 33], s[3 * 33]); o.z = pk2(s[4 * 33], s[5 * 33]); o.w = pk2(s[6 * 33], s[7 * 33]);
        *(u32x4*)(WT + (size_t)(n0 + n) * K + k0 + 8 * c) = o; }
    LDS_WAIT(); asm volatile("" ::: "memory");
}
__device__ __forceinline__ void cvt_range(const float* src, bf16* dst, size_t n8, size_t gtid, size_t gthreads) {
#pragma unroll 4
    for (size_t i = gtid; i < n8; i += gthreads) { const f32x4 a = ((const f32x4*)src)[2 * i], b = ((const f32x4*)src)[2 * i + 1];
        u32x4 w; w.x = cvtpk(a.x, a.y); w.y = cvtpk(a.z, a.w); w.z = cvtpk(b.x, b.y); w.w = cvtpk(b.z, b.w); ((u32x4*)dst)[i] = w; }
}
__device__ __forceinline__ unsigned enc_e2m3(float x) {
    const unsigned sgn = (__float_as_uint(x) >> 26) & 32u;
    const float ax = fminf(fabsf(x), 7.5f);
    unsigned u = __float_as_uint(ax); u += 0x7FFFFu + ((u >> 20) & 1u);
    const unsigned cn = (u >> 20) - ((127u - 1u) << 3);
    const unsigned cs = (unsigned)__builtin_rintf(ax * 8.0f);
    return sgn | (ax < 1.0f ? cs : cn);
}
#ifndef CVT_PIPE
#define CVT_PIPE 0
#endif
typedef float f32x16v __attribute__((ext_vector_type(16)));
typedef float f32x32v __attribute__((ext_vector_type(32)));
typedef unsigned u32x6v __attribute__((ext_vector_type(6)));
__device__ __forceinline__ u32x6v pack_fp6_32(const float (&e)[32], bool interleaved) {
    f32x16v s0, s1;
    if (interleaved) {
#pragma unroll
        for (int i = 0; i < 16; ++i) { s0[i] = e[2 * i]; s1[i] = e[2 * i + 1]; }
    } else {
#pragma unroll
        for (int i = 0; i < 16; ++i) { s0[i] = e[i]; s1[i] = e[16 + i]; }
    }
    return __builtin_amdgcn_cvt_scalef32_2xpk16_fp6_f32(s0, s1, 1.0f);
}
__device__ __forceinline__ void cvt_table_fp6(const float* src, unsigned char* dst, int nrows, float scale, LAS float* scr  , int lane, int gw, int NGW, const int isv) {
    bool interleaved;
    {
        float t[32];
#pragma unroll
        for (int k = 0; k < 32; ++k) t[k] = k < 16 ? 0.125f * k : (k < 24 ? 2.0f + 0.25f * (k - 16) : 4.0f + 0.5f * (k - 24));
        float tt[32];
#pragma unroll
        for (int k = 0; k < 32; ++k) { tt[k] = t[k]; asm volatile("" : "+v"(tt[k])); }
        const u32x6v p = pack_fp6_32(tt, true);
        const f32x32v o = __builtin_amdgcn_cvt_scalef32_pk32_f32_fp6(p, 1.0f);
        interleaved = (o[1] == t[1]) && (o[2] == t[2]) && (o[17] == t[17]);
        interleaved = __all(interleaved);
    }
#if CVT_PIPE
    f32x4 nx[8];
    if (gw < nrows) { const f32x4* s4 = (const f32x4*)(src + (size_t)gw * 2048);
#pragma unroll
        for (int q = 0; q < 8; ++q) nx[q] = s4[64 * q + lane]; }
    for (int row = gw; row < nrows; row += NGW) {
        f32x4 cur[8];
#pragma unroll
        for (int q = 0; q < 8; ++q) cur[q] = nx[q];
        if (row + NGW < nrows) { const f32x4* s4 = (const f32x4*)(src + (size_t)(row + NGW) * 2048);
#pragma unroll
            for (int q = 0; q < 8; ++q) nx[q] = s4[64 * q + lane]; }
#pragma unroll
        for (int q = 0; q < 8; ++q) { const int s = 64 * q + lane; const f32x4 a = cur[q] * scale; *(LAS f32x4*)(scr + 4 * (s ^ ((s >> 4) & 7))) = a; }
#else
    for (int row = gw; row < nrows; row += NGW) {
        const f32x4* s4 = (const f32x4*)(src + (size_t)row * 2048);
#pragma unroll
        for (int q = 0; q < 8; ++q) { const int s = 64 * q + lane; const f32x4 a = s4[s] * scale; *(LAS f32x4*)(scr + 4 * (s ^ ((s >> 4) & 7))) = a; }
#endif
        float e[32];
#pragma unroll
        for (int j = 0; j < 8; ++j) { const int s = 8 * lane + j; const f32x4 a = *(const LAS f32x4*)(scr + 4 * (s ^ ((s >> 4) & 7)));
            e[4 * j + 0] = __builtin_amdgcn_fmed3f(a.x, -7.5f, 7.5f); e[4 * j + 1] = __builtin_amdgcn_fmed3f(a.y, -7.5f, 7.5f); e[4 * j + 2] = __builtin_amdgcn_fmed3f(a.z, -7.5f, 7.5f); e[4 * j + 3] = __builtin_amdgcn_fmed3f(a.w, -7.5f, 7.5f); }
        const u32x6v p = pack_fp6_32(e, interleaved);
        unsigned char* rowp = dst + (size_t)row * PREC;
        *(u32x4*)(rowp + 1024 * isv + 16 * lane) = (u32x4){p[0], p[1], p[2], p[3]}; *(u32x2*)(rowp + 2048 + 512 * isv + 8 * lane) = (u32x2){p[4], p[5]};
    }
}
__device__ __forceinline__ float silu(float x) { return x / (1.0f + __expf(-x)); }

struct Params { const float* in[29]; float* out; unsigned char* ws; int ph_lo, ph_hi; };
typedef const __attribute__((address_space(4))) Params* CP;

#ifndef TAIL_REMAP
#define TAIL_REMAP 0
#endif
__device__ __forceinline__ void p0_prologue(CP P, LAS unsigned char* lds, int tid, int lane, int wid, int gw, int NGW, const int parts = 7) {
    unsigned char* ws = P->ws;
    LAS float* scr = (LAS float*)(lds + wid * 16384);
    if (parts & 1) {
        constexpr int I_GMIN = (2048 / 64) * (4096 / 32), I_SQ = (2048 / 64) * (2048 / 32), I_MIN = (2048 / 64) * (1088 / 32), I_UQ = (512 / 64) * (3072 / 32), I_UKV = (512 / 64) * (4096 / 32), I_DIN = (2048 / 64) * (6144 / 32);
        constexpr int NIT = 2 * I_GMIN + 2 * I_SQ + 4 * I_SQ + I_MIN + I_UQ + I_UKV + I_SQ + I_DIN + I_SQ;
        for (int it = gw; it < NIT; it += NGW) {
            int r = it;
            if (r < 2 * I_GMIN) { const int j = r / I_GMIN; p0_transpose_item(P->in[13] + (size_t)j * 2048 * 4096, 2048, 4096, (bf16*)(ws + WS_GMWIN) + (size_t)j * 4096 * 2048, scr, r % I_GMIN, lane); continue; } r -= 2 * I_GMIN;
            if (r < 2 * I_SQ) { const int j = r / I_SQ; p0_transpose_item(P->in[18] + (size_t)j * 2048 * 2048, 2048, 2048, (bf16*)(ws + WS_GMWOUT) + (size_t)j * 2048 * 2048, scr, r % I_SQ, lane); continue; } r -= 2 * I_SQ;
            if (r < 4 * I_SQ) { const int j = r / I_SQ; p0_transpose_item(P->in[8] + (size_t)j * 2048 * 2048, 2048, 2048, (bf16*)(ws + WS_PWQ) + (size_t)j * 2048 * 2048, scr, r % I_SQ, lane); continue; } r -= 4 * I_SQ;
            if (r < I_MIN) { p0_transpose_item(P->in[19], 2048, 1088, (bf16*)(ws + WS_MLAIN), scr, r, lane); continue; } r -= I_MIN;
            if (r < I_UQ) { p0_transpose_item(P->in[22], 512, 3072, (bf16*)(ws + WS_MLAUQ), scr, r, lane); continue; } r -= I_UQ;
            if (r < I_UKV) { p0_transpose_item(P->in[23], 512, 4096, (bf16*)(ws + WS_MLAUKV), scr, r, lane); continue; } r -= I_UKV;
            if (r < I_SQ) { p0_transpose_item(P->in[24], 2048, 2048, (bf16*)(ws + WS_MLAOUT), scr, r, lane); continue; } r -= I_SQ;
            if (r < I_DIN) { p0_transpose_item(P->in[25], 2048, 6144, (bf16*)(ws + WS_DAIN), scr, r, lane); continue; } r -= I_DIN;
            p0_transpose_item(P->in[28], 2048, 2048, (bf16*)(ws + WS_DAOUT), scr, r, lane);
        }
    }
    const size_t gtid = (size_t)gw * 64 + lane, gthreads = (size_t)NGW * 64;
    if (parts & 2) {
    { u32x4* z = (u32x4*)((bf16*)(ws + WS_MLAIN) + (size_t)1088 * 2048); const size_t n = (size_t)192 * 2048 / 8;
      for (size_t i = gtid; i < n; i += gthreads) z[i] = (u32x4){0u, 0u, 0u, 0u}; }
    cvt_range(P->in[16], (bf16*)(ws + WS_GMWS), (size_t)2 * 16 * 128 * 128 / 8, gtid, gthreads);
    cvt_range(P->in[9], (bf16*)(ws + WS_PK1), (size_t)4 * 128 * 128 / 8, gtid, gthreads);
    cvt_range(P->in[10], (bf16*)(ws + WS_PK2), (size_t)4 * 128 * 128 / 8, gtid, gthreads);
#if !TAIL_REMAP
    cvt_table_fp6(P->in[11], ws + WS_PU, 16384, U_SCALE, scr, lane, gw, NGW, 0);
    cvt_table_fp6(P->in[12], ws + WS_PU, 16384, V_SCALE, scr, lane, gw, NGW, 1);
#endif
    if (gtid < 2048) { const int pos = (int)gtid >> 4, f = (int)gtid & 15; const float inv = powf(10000.0f, -(float)f * (1.0f / 16.0f)); float sn, cs; sincosf((float)pos * inv, &sn, &cs);
        float* rt = (float*)(ws + WS_ROPE); rt[gtid] = cs; rt[2048 + gtid] = sn; }
    }
    if (parts & 4) {
        const float* cv = P->in[1]; const float* cc = P->in[3]; const float* mw = P->in[4]; float* PART = (float*)(ws + WS_MODP);
        LAS float* S = (LAS float*)lds;
        __syncthreads();
        for (int i = tid; i < 3 * 2048; i += NWAVES * 64) { const int sl = i >> 11, kk = i & 2047; S[i] = silu(sl == 0 ? cv[kk] : (sl == 1 ? cv[2048 + kk] : cc[kk])); }
        __syncthreads();
        for (int item = gw; item < 4 * 192 * 8; item += NGW) {
            const int ks = item & 7, r = item >> 3, L = r / 192, n = (r % 192) * 64 + lane;
            const float* W = mw + (size_t)L * 2048 * 12288 + (size_t)(ks * 256) * 12288 + n;
            float a0 = 0.f, a1 = 0.f, a2 = 0.f;
#pragma unroll 32
            for (int k = 0; k < 256; ++k) { const int kk = ks * 256 + k; const float s0 = S[kk], s1 = S[2048 + kk], s2 = S[4096 + kk];
                const float w = W[(size_t)k * 12288]; a0 += s0 * w; a1 += s1 * w; a2 += s2 * w; }
            float* o = PART + ((size_t)ks * 4 + L) * 3 * 12288 + n;
            o[0] = a0; o[12288] = a1; o[24576] = a2;
        }
    }
}
__device__ __forceinline__ void mod_reduce(CP P, int gw, int lane, int NGW) {
    const float* PART = (const float*)(P->ws + WS_MODP); float* MOD = (float*)(P->ws + WS_MOD); const float* mb = P->in[5];
    for (int i = gw * 64 + lane; i < 4 * 3 * 12288; i += NGW * 64) {
        const int L = i / (3 * 12288), n = i % 12288;
        float s = mb[(size_t)L * 12288 + n];
#pragma unroll
        for (int ks = 0; ks < 8; ++ks) s += PART[(size_t)ks * 4 * 3 * 12288 + i];
        MOD[i] = s;
    }
}

__device__ __forceinline__ void first_row_pass(CP P, int lane, int gw, int NGW) {
    const float* MOD = (const float*)(P->ws + WS_MOD); bf16* X = (bf16*)(P->ws + WS_X); bf16* H = (bf16*)(P->ws + WS_H);
    for (int row = gw; row < MT; row += NGW) {
        const float* src = row < ML ? P->in[0] + (size_t)row * DM : P->in[2] + (size_t)(row - ML) * DM;
        float v[32]; load_row_f32(src, lane, v);
        store_row_bf16(X + (size_t)row * DM, lane, v);
        const float* mod = MOD + (size_t)row_slot(row) * 12288;
        float mean, rstd; ln_stats(v, mean, rstd);
        float a[32], s[32]; load_row_f32(mod + 2048, lane, a); load_row_f32(mod, lane, s);
#pragma unroll
        for (int i = 0; i < 32; ++i) a[i] = (v[i] - mean) * rstd * (1.0f + a[i]) + s[i];
        store_row_bf16(H + (size_t)row * DM, lane, a);
    }
}
#ifndef POSTMIX_LDS
#define POSTMIX_LDS 1
#endif
__device__ __forceinline__ void load_row_f32_l(const LAS float* row, int lane, float (&v)[32]) {
#pragma unroll
    for (int j = 0; j < 4; ++j) { const f32x4 a = ((const LAS f32x4*)row)[128 * j + 2 * lane], b = ((const LAS f32x4*)row)[128 * j + 2 * lane + 1];
        v[8 * j + 0] = a.x; v[8 * j + 1] = a.y; v[8 * j + 2] = a.z; v[8 * j + 3] = a.w; v[8 * j + 4] = b.x; v[8 * j + 5] = b.y; v[8 * j + 6] = b.z; v[8 * j + 7] = b.w; }
}
__device__ __forceinline__ void post_mixer_pass_lds(CP P, int L, int Mrows, LAS unsigned char* lds, int tid, int lane, int gw, int NGW) {
    const float* MOD = (const float*)(P->ws + WS_MOD); bf16* X = (bf16*)(P->ws + WS_X); bf16* H = (bf16*)(P->ws + WS_H); const bf16* Y = (const bf16*)(P->ws + WS_Y);
    const float* lng = P->in[6] + (size_t)(L * 2 + 0) * DM; const float* lnb = P->in[7] + (size_t)(L * 2 + 0) * DM;
    LAS float* V = (LAS float*)lds;
    __syncthreads();
    for (int i = tid; i < 11 * 512; i += NWAVES * 64) { const int vec = i >> 9, g4 = i & 511;
        const float* src = vec == 0 ? lng : (vec == 1 ? lnb : MOD + (size_t)(L * 3 + (vec - 2) / 3) * 12288 + (size_t)(2 + (vec - 2) % 3) * 2048);
        ((LAS f32x4*)V)[i] = ((const f32x4*)src)[g4]; }
    __syncthreads();
    for (int row = gw; row < Mrows; row += NGW) {
        const LAS float* mv = V + (2 + 3 * row_slot(row)) * 2048;
        float z[32], y[32]; load_row_bf16(X + (size_t)row * DM, lane, z); load_row_bf16(Y + (size_t)row * DM, lane, y);
        { float g[32]; load_row_f32_l(mv, lane, g);
#pragma unroll
          for (int i = 0; i < 32; ++i) z[i] = ALPHA * z[i] + g[i] * y[i]; }
        float mean, rstd; ln_stats(z, mean, rstd);
        { float g[32], b[32]; load_row_f32_l(V, lane, g); load_row_f32_l(V + 2048, lane, b);
#pragma unroll
          for (int i = 0; i < 32; ++i) z[i] = (z[i] - mean) * rstd * g[i] + b[i]; }
        store_row_bf16(X + (size_t)row * DM, lane, z);
        ln_stats(z, mean, rstd);
        { float a[32], s_[32]; load_row_f32_l(mv + 2 * 2048, lane, a); load_row_f32_l(mv + 2048, lane, s_);
#pragma unroll
          for (int i = 0; i < 32; ++i) a[i] = (z[i] - mean) * rstd * (1.0f + a[i]) + s_[i];
          store_row_bf16(H + (size_t)row * DM, lane, a); }
    }
}
__device__ __forceinline__ void post_mixer_pass(CP P, int L, int Mrows, int lane, int gw, int NGW) {
    const float* MOD = (const float*)(P->ws + WS_MOD); bf16* X = (bf16*)(P->ws + WS_X); bf16* H = (bf16*)(P->ws + WS_H); const bf16* Y = (const bf16*)(P->ws + WS_Y);
    const float* lng = P->in[6] + (size_t)(L * 2 + 0) * DM; const float* lnb = P->in[7] + (size_t)(L * 2 + 0) * DM;
    for (int row = gw; row < Mrows; row += NGW) {
        const float* mod = MOD + (size_t)(L * 3 + row_slot(row)) * 12288;
        float z[32], y[32], g[32]; load_row_bf16(X + (size_t)row * DM, lane, z); load_row_bf16(Y + (size_t)row * DM, lane, y); load_row_f32(mod + 2 * 2048, lane, g);
#pragma unroll
        for (int i = 0; i < 32; ++i) z[i] = ALPHA * z[i] + g[i] * y[i];
        finish_row<false>(z, lng, lnb, X + (size_t)row * DM, mod + 3 * 2048, mod + 4 * 2048, H + (size_t)row * DM, nullptr, lane);
    }
}
__device__ __forceinline__ void vstats_pass(CP P, int Mrows, int lane, int gw, int NGW) {
    const bf16* Z = (const bf16*)(P->ws + WS_Z); float* VST = (float*)(P->ws + WS_VST);
    for (int row = gw; row < Mrows; row += NGW) {
        float v[32]; load_row_bf16(Z + (size_t)row * 4096 + 2048, lane, v);
        float mean, rstd; ln_stats(v, mean, rstd);
        if (lane == 0) { VST[2 * row] = mean; VST[2 * row + 1] = rstd; }
    }
}
#define XB_TMO      128
#define XB_XCNT(j)  (256  + 64 * (j))
#define XB_XSUB(j)  (1280 + 64 * (j))
#define XB_XGEN(j)  (2304 + 64 * (j))
#define XB_TOP      3328
#define XB_TOPGEN   3392
#define XCD_BAR_WORDS 3456
#define XB_SPIN_CAP (1u << 18)

__device__ __forceinline__ unsigned xb_ld(unsigned* p)              { return __hip_atomic_load(p, __ATOMIC_RELAXED, __HIP_MEMORY_SCOPE_AGENT); }
__device__ __forceinline__ unsigned xb_add(unsigned* p, unsigned v) { return __hip_atomic_fetch_add(p, v, __ATOMIC_RELAXED, __HIP_MEMORY_SCOPE_AGENT); }
__device__ __forceinline__ unsigned xb_xcc_id() { return (unsigned)__builtin_amdgcn_s_getreg((3 << 11) | 20) & 0xFu; }
#define XB_SPIN(cond, bar) do { unsigned _sp = 0; while (cond) { __builtin_amdgcn_s_sleep(1); \
    if ((++_sp & 255u) == 0u) { if (xb_ld(&(bar)[XB_TMO])) break; if (_sp > XB_SPIN_CAP) { atomicAdd(&(bar)[XB_TMO], 1u); break; } } } } while (0)

struct XcdBarrier {
    unsigned* bar; unsigned x;
    volatile LAS unsigned* st;
};

__device__ __forceinline__ XcdBarrier xcd_barrier_post(unsigned* bar, volatile LAS unsigned* st, const bool t0) {
    XcdBarrier b; b.bar = bar; b.x = xb_xcc_id(); b.st = st;
    if (t0) (void)xb_add(&bar[XB_XCNT(b.x)], 1u);
    return b;
}
__device__ __forceinline__ void xcd_barrier_complete(unsigned* bar, unsigned x, unsigned& nloc, unsigned& nx) {
    const unsigned G = gridDim.x * gridDim.y * gridDim.z;
    unsigned sum, cnt, mine, sp = 0u;
    for (;;) {
        sum = 0u; cnt = 0u; mine = 0u;
#pragma unroll
        for (unsigned j = 0; j < 16; ++j) { const unsigned c = xb_ld(&bar[XB_XCNT(j)]); sum += c; cnt += (c > 0u) ? 1u : 0u; mine = (j == x) ? c : mine; }
        if (sum == G) break;
        __builtin_amdgcn_s_sleep(1);
        if ((++sp & 255u) == 0u) { if (xb_ld(&bar[XB_TMO])) break; if (sp > XB_SPIN_CAP) { atomicAdd(&bar[XB_TMO], 1u); break; } }
    }
    nloc = mine > 0u ? mine : 1u; nx = cnt > 0u ? cnt : 1u;
}

__device__ __attribute__((noinline)) void xcd_barrier(const XcdBarrier b, const bool t0) {
    asm volatile("s_waitcnt vmcnt(0)" ::: "memory");
    __syncthreads();
    if (t0) {
        unsigned* bar = b.bar;
        __builtin_amdgcn_s_waitcnt(0);
        unsigned nloc = b.st[0], nx = b.st[1];
        if (nloc == 0u) { xcd_barrier_complete(bar, b.x, nloc, nx); b.st[0] = nloc; b.st[1] = nx; }
        const unsigned old = xb_add(&bar[XB_XSUB(b.x)], 1u);
        const unsigned gen = old / nloc;
        if (old + 1u == (gen + 1u) * nloc) {
            __builtin_amdgcn_fence(__ATOMIC_RELEASE, "agent");
            asm volatile("s_waitcnt vmcnt(0)" ::: "memory");
            const unsigned og = xb_add(&bar[XB_TOP], 1u);
            const unsigned tg = og / nx;
            if (og + 1u == (tg + 1u) * nx) xb_add(&bar[XB_TOPGEN], 1u);
            else XB_SPIN(xb_ld(&bar[XB_TOPGEN]) == tg, bar);
            __builtin_amdgcn_fence(__ATOMIC_ACQUIRE, "agent");
            xb_add(&bar[XB_XGEN(b.x)], 1u);
            asm volatile("s_waitcnt vmcnt(0)" ::: "memory");
        } else {
            XB_SPIN(xb_ld(&bar[XB_XGEN(b.x)]) == gen, bar);
            __builtin_amdgcn_fence(__ATOMIC_ACQUIRE, "agent");
            asm volatile("s_waitcnt vmcnt(0)" ::: "memory");
        }
    }
    __syncthreads();
}

#ifndef SPATIAL_PIPE
#define SPATIAL_PIPE 1
#endif
#if SPATIAL_PIPE
struct SpReg { u32x4 w[4]; float mean, rstd; bf16x8 a[4]; bf16 uu[32]; float bsv[4]; };
__device__ __forceinline__ void sp_load(SpReg& R, const bf16* Z, const float* VST, const bf16* WS, const float* bs, int u, int tid, int lane, int wid) {
    const int c = u >> 4, g = u & 15, fr = lane & 15, fq = lane >> 4;
    { const int q = tid >> 2, dq = (tid & 3) * 32; const int row = c * 128 + q;
      R.mean = VST[2 * row]; R.rstd = VST[2 * row + 1];
      const bf16* src = Z + (size_t)row * 4096 + 2048 + g * 128 + dq;
#pragma unroll
      for (int t = 0; t < 4; ++t) R.w[t] = *(const u32x4*)(src + 8 * t); }
    const bf16* wrow = WS + (size_t)g * 128 * 128 + (size_t)(16 * wid + fr) * 128 + 8 * fq;
#pragma unroll
    for (int ks = 0; ks < 4; ++ks) R.a[ks] = *(const bf16x8*)(wrow + 32 * ks);
#pragma unroll
    for (int r = 0; r < 4; ++r) R.bsv[r] = bs[g * 128 + 16 * wid + fq * 4 + r];
#pragma unroll
    for (int nb = 0; nb < 8; ++nb)
#pragma unroll
        for (int r = 0; r < 4; ++r) { const int p = 16 * wid + fq * 4 + r, d = 16 * nb + fr; R.uu[nb * 4 + r] = Z[(size_t)(c * 128 + p) * 4096 + g * 128 + d]; }
}
__device__ __forceinline__ void spatial_phase(CP P, int j, int Mrows, LAS unsigned char* lds_, int tid, int lane, int wid) {
    const bf16* Z = (const bf16*)(P->ws + WS_Z); const float* VST = (const float*)(P->ws + WS_VST); bf16* Gb = (bf16*)(P->ws + WS_G);
    const bf16* WS = (const bf16*)(P->ws + WS_GMWS) + (size_t)j * 16 * 128 * 128;
    const float* lng = P->in[14] + (size_t)j * DM; const float* lnb = P->in[15] + (size_t)j * DM; const float* bs = P->in[17] + (size_t)j * 16 * 128;
    LAS bf16* Vt = (LAS bf16*)(LAS unsigned char*)lds_;
    constexpr int VP = 136;
    const int nunits = (Mrows / 128) * 16;
    LAS float* LNl = (LAS float*)(lds_ + 36864);
    __syncthreads();
    for (int i = tid; i < 1024; i += NWAVES * 64) { const int vec = i >> 9, g4 = i & 511; ((LAS f32x4*)LNl)[i] = ((const f32x4*)(vec ? lnb : lng))[g4]; }
    SpReg nx;
    if ((int)blockIdx.x < nunits) sp_load(nx, Z, VST, WS, bs, blockIdx.x, tid, lane, wid);
    for (int u = blockIdx.x; u < nunits; u += gridDim.x) {
        const int c = u >> 4, g = u & 15;
        const SpReg cur = nx;
        if (u + (int)gridDim.x < nunits) sp_load(nx, Z, VST, WS, bs, u + gridDim.x, tid, lane, wid);
        __syncthreads();
        {
            const int q = tid >> 2, dq = (tid & 3) * 32;
#pragma unroll
            for (int t = 0; t < 4; ++t) { const u32x4 w = cur.w[t];
                float v[8] = {bflo(w.x), bfhi(w.x), bflo(w.y), bfhi(w.y), bflo(w.z), bfhi(w.z), bflo(w.w), bfhi(w.w)};
                const LAS float* gp = LNl + g * 128 + dq + 8 * t; const LAS float* bp = LNl + 2048 + g * 128 + dq + 8 * t;
#pragma unroll
                for (int i = 0; i < 8; ++i) { const float vn = (v[i] - cur.mean) * cur.rstd * gp[i] + bp[i]; Vt[(dq + 8 * t + i) * VP + q] = tobf1(vn); } }
        }
        __syncthreads();
        const int fr = lane & 15, fq = lane >> 4;
#pragma unroll
        for (int nb = 0; nb < 8; ++nb) {
            f32x4 acc = {0.f, 0.f, 0.f, 0.f};
#pragma unroll
            for (int ks = 0; ks < 4; ++ks) { const bf16x8 b = *(const LAS bf16x8*)(Vt + (16 * nb + fr) * VP + 32 * ks + 8 * fq);
                acc = __builtin_amdgcn_mfma_f32_16x16x32_bf16(cur.a[ks], b, acc, 0, 0, 0); }
#pragma unroll
            for (int r = 0; r < 4; ++r) { const int p = 16 * wid + fq * 4 + r, d = 16 * nb + fr; const size_t grow = (size_t)(c * 128 + p);
                const float sv = acc[r] + cur.bsv[r];
                const float uu = bf1(cur.uu[nb * 4 + r]);
                Gb[grow * 2048 + g * 128 + d] = tobf1(uu * sv); }
        }
    }
}
#else
__device__ __forceinline__ void spatial_phase(CP P, int j, int Mrows, LAS unsigned char* lds_, int tid, int lane, int wid) {
    const bf16* Z = (const bf16*)(P->ws + WS_Z); const float* VST = (const float*)(P->ws + WS_VST); bf16* Gb = (bf16*)(P->ws + WS_G);
    const bf16* WS = (const bf16*)(P->ws + WS_GMWS) + (size_t)j * 16 * 128 * 128;
    const float* lng = P->in[14] + (size_t)j * DM; const float* lnb = P->in[15] + (size_t)j * DM; const float* bs = P->in[17] + (size_t)j * 16 * 128;
    LAS bf16* Vt = (LAS bf16*)(LAS unsigned char*)lds_;
    constexpr int VP = 136;
    const int nunits = (Mrows / 128) * 16;
    for (int u = blockIdx.x; u < nunits; u += gridDim.x) {
        const int c = u >> 4, g = u & 15;
        __syncthreads();
        {
            const int q = tid >> 2, dq = (tid & 3) * 32; const int row = c * 128 + q;
            const float mean = VST[2 * row], rstd = VST[2 * row + 1];
            const bf16* src = Z + (size_t)row * 4096 + 2048 + g * 128 + dq;
#pragma unroll
            for (int t = 0; t < 4; ++t) { const u32x4 w = *(const u32x4*)(src + 8 * t);
                float v[8] = {bflo(w.x), bfhi(w.x), bflo(w.y), bfhi(w.y), bflo(w.z), bfhi(w.z), bflo(w.w), bfhi(w.w)};
                const float* gp = lng + g * 128 + dq + 8 * t; const float* bp = lnb + g * 128 + dq + 8 * t;
#pragma unroll
                for (int i = 0; i < 8; ++i) { const float vn = (v[i] - mean) * rstd * gp[i] + bp[i]; Vt[(dq + 8 * t + i) * VP + q] = tobf1(vn); } }
        }
        __syncthreads();
        const int fr = lane & 15, fq = lane >> 4;
        bf16x8 a[4];
        const bf16* wrow = WS + (size_t)g * 128 * 128 + (size_t)(16 * wid + fr) * 128 + 8 * fq;
#pragma unroll
        for (int ks = 0; ks < 4; ++ks) a[ks] = *(const bf16x8*)(wrow + 32 * ks);
#pragma unroll
        for (int nb = 0; nb < 8; ++nb) {
            f32x4 acc = {0.f, 0.f, 0.f, 0.f};
#pragma unroll
            for (int ks = 0; ks < 4; ++ks) { const bf16x8 b = *(const LAS bf16x8*)(Vt + (16 * nb + fr) * VP + 32 * ks + 8 * fq);
                acc = __builtin_amdgcn_mfma_f32_16x16x32_bf16(a[ks], b, acc, 0, 0, 0); }
#pragma unroll
            for (int r = 0; r < 4; ++r) { const int p = 16 * wid + fq * 4 + r, d = 16 * nb + fr; const size_t grow = (size_t)(c * 128 + p);
                const float sv = acc[r] + bs[g * 128 + p];
                const float uu = bf1(Z[grow * 4096 + g * 128 + d]);
                Gb[grow * 2048 + g * 128 + d] = tobf1(uu * sv); }
        }
    }
}
#endif

__device__ __forceinline__ void rope_cs(int row, int l, float& cs, float& sn) {
    const int t = row & (SEQ - 1); const int pos = (l & 32) ? (t & 63) : (t >> 6);
    const float inv = powf(10000.0f, -(float)(l & 15) * (1.0f / 16.0f));
    const float ang = (float)pos * inv; sincosf(ang, &sn, &cs);
}
__device__ __forceinline__ float rope_apply(float x, int l, float cs, float sn) {
    const float p = lane_xor16(x, l);
    return (l & 16) ? (p * sn + x * cs) : (x * cs - p * sn);
}
__device__ __forceinline__ void mla_norm_pass(CP P, int lane, int gw, int NGW) {
    const bf16* C = (const bf16*)(P->ws + WS_C); bf16* CQN = (bf16*)(P->ws + WS_CQN); bf16* CKVN = (bf16*)(P->ws + WS_CKVN); bf16* KR = (bf16*)(P->ws + WS_KR);
    const float* qn = P->in[20]; const float* kvn = P->in[21];
    for (int row = gw; row < MT; row += NGW) {
        const bf16* c = C + (size_t)row * 1280;
#pragma unroll
        for (int part = 0; part < 2; ++part) {
            const u32x4 w = *(const u32x4*)(c + part * 512 + 8 * lane);
            float v[8] = {bflo(w.x), bfhi(w.x), bflo(w.y), bfhi(w.y), bflo(w.z), bfhi(w.z), bflo(w.w), bfhi(w.w)};
            float ss = 0.f;
#pragma unroll
            for (int i = 0; i < 8; ++i) ss += v[i] * v[i];
            const float r = 1.0f / sqrtf(wave_sum(ss) * (1.0f / 512.0f) + LN_EPS);
            const float* nw = (part ? kvn : qn) + 8 * lane;
            u32x4 o; o.x = cvtpk(v[0] * r * nw[0], v[1] * r * nw[1]); o.y = cvtpk(v[2] * r * nw[2], v[3] * r * nw[3]); o.z = cvtpk(v[4] * r * nw[4], v[5] * r * nw[5]); o.w = cvtpk(v[6] * r * nw[6], v[7] * r * nw[7]);
            *(u32x4*)((part ? CKVN : CQN) + (size_t)row * 512 + 8 * lane) = o;
        }
        float x = bf1(c[1024 + lane]);
        if (row < ML) { float cs, sn; rope_cs(row, lane, cs, sn); x = rope_apply(x, lane, cs, sn); }
        KR[(size_t)row * 64 + lane] = tobf1(x);
    }
}
__device__ __forceinline__ void rope_pass(bf16* buf, int ld, int col0, int nchunks, int cstride, int lane, int gw, int NGW) {
    for (int row = gw; row < ML; row += NGW) {
        float cs, sn; rope_cs(row, lane, cs, sn);
        bf16* r = buf + (size_t)row * ld + col0 + lane;
#pragma unroll 4
        for (int k = 0; k < nchunks; ++k) { const float x = bf1(r[k * cstride]); r[k * cstride] = tobf1(rope_apply(x, lane, cs, sn)); }
    }
}

namespace att {
#ifndef ATT_LEAN
#define ATT_LEAN 1
#endif
#ifndef ATT_3STAGE
#define ATT_3STAGE 0
#endif
#ifndef ATT_PRIO
#define ATT_PRIO 0
#endif
#ifndef ATT_KMAJOR
#define ATT_KMAJOR 0
#endif
#ifndef ATT_TRB
#define ATT_TRB 1
#endif
#ifndef ATT_STAGGER
#define ATT_STAGGER 0
#endif
#ifndef ATT_SDEPTH
#define ATT_SDEPTH(MODE) ((MODE) == 0 ? 1 : 1)
#endif
#ifndef ATT_PVPIPE
#define ATT_PVPIPE(MODE) ((MODE) == 1)
#endif
#define SBAR() __builtin_amdgcn_sched_barrier(0)
__device__ __forceinline__ int crow(int r, int hi) { return (r & 3) + 8 * (r >> 2) + 4 * hi; }
__device__ __forceinline__ unsigned cvtpkv(float lo, float hi) { unsigned r; asm volatile("v_cvt_pk_bf16_f32 %0, %1, %2" : "=v"(r) : "v"(lo), "v"(hi)); return r; }

__device__ __forceinline__ void partialSM(f32x16& p0, f32x16& p1, float& m_reg, float& mn, float& alpha, const float C, const float THRS) {
  float pmax = p0[0];
#pragma unroll
  for (int r = 1; r < 16; ++r) pmax = fmaxf(pmax, p0[r]);
#pragma unroll
  for (int r = 0; r < 16; ++r) pmax = fmaxf(pmax, p1[r]);
  { auto rr = __builtin_amdgcn_permlane32_swap(__float_as_uint(pmax), __float_as_uint(pmax), false, false);
    pmax = fmaxf(__uint_as_float(rr[0]), __uint_as_float(rr[1])); }
  if (__builtin_expect(__all(pmax - m_reg <= THRS), 1)) { mn = m_reg; alpha = 1.f; }
  else { mn = fmaxf(m_reg, pmax); alpha = __builtin_amdgcn_exp2f((m_reg - mn) * C); m_reg = mn; }
  const float mnC = -mn * C;
#pragma unroll
  for (int r = 0; r < 16; ++r) p0[r] = fmaf(p0[r], C, mnC);
#pragma unroll
  for (int r = 0; r < 16; ++r) p1[r] = fmaf(p1[r], C, mnC);
#pragma unroll
  for (int r = 0; r < 16; ++r) p0[r] = __builtin_amdgcn_exp2f(p0[r]);
}
__device__ __forceinline__ void finishSM(f32x16& p0, f32x16& p1, float alpha, float& l_reg, bf16x8& pa0, bf16x8& pa1, bf16x8& pa2, bf16x8& pa3) {
#pragma unroll
  for (int r = 0; r < 16; ++r) p1[r] = __builtin_amdgcn_exp2f(p1[r]);
  float ps = 0;
#pragma unroll
  for (int r = 0; r < 16; ++r) ps += p0[r];
#pragma unroll
  for (int r = 0; r < 16; ++r) ps += p1[r];
  { auto rr = __builtin_amdgcn_permlane32_swap(__float_as_uint(ps), __float_as_uint(ps), false, false);
    ps = __uint_as_float(rr[0]) + __uint_as_float(rr[1]); }
  l_reg = l_reg * alpha + ps;
#define PK4(P, BASE, OUT) do { unsigned a0 = cvtpkv(P[BASE + 0], P[BASE + 1]), a1 = cvtpkv(P[BASE + 2], P[BASE + 3]);   \
    unsigned b0 = cvtpkv(P[BASE + 4], P[BASE + 5]), b1 = cvtpkv(P[BASE + 6], P[BASE + 7]);                              \
    auto r0 = __builtin_amdgcn_permlane32_swap(a0, b0, false, false); auto r1 = __builtin_amdgcn_permlane32_swap(a1, b1, false, false); \
    u32x4 w = {r0[0], r1[0], r0[1], r1[1]}; OUT = *reinterpret_cast<bf16x8*>(&w); } while (0)
  PK4(p0, 0, pa0); PK4(p0, 8, pa1); PK4(p1, 0, pa2); PK4(p1, 8, pa3);
#undef PK4
}
__device__ __forceinline__ void partialSM_lean(f32x16& p0, f32x16& p1, f32x16& nm, float& alpha, const bool first) {
  constexpr float THR2 = 11.541560327111707f;
  float dmax = p0[0];
#pragma unroll
  for (int r = 1; r < 16; ++r) dmax = fmaxf(dmax, p0[r]);
#pragma unroll
  for (int r = 0; r < 16; ++r) dmax = fmaxf(dmax, p1[r]);
  { auto rr = __builtin_amdgcn_permlane32_swap(__float_as_uint(dmax), __float_as_uint(dmax), false, false);
    dmax = fmaxf(__uint_as_float(rr[0]), __uint_as_float(rr[1])); }
  alpha = 1.f;
  if (first || !__all(dmax <= THR2)) {
    const float delta = first ? dmax : (dmax > THR2 ? dmax : 0.f);
    if (!first) alpha = __builtin_amdgcn_exp2f(-delta);
#pragma unroll
    for (int r = 0; r < 16; ++r) { p0[r] -= delta; p1[r] -= delta; nm[r] -= delta; }
  }
#pragma unroll
  for (int r = 0; r < 16; ++r) p0[r] = __builtin_amdgcn_exp2f(p0[r]);
}
__device__ __forceinline__ void finishSM_lean(f32x16& p0, f32x16& p1, bf16x8& pa0, bf16x8& pa1, bf16x8& pa2, bf16x8& pa3) {
#pragma unroll
  for (int r = 0; r < 16; ++r) p1[r] = __builtin_amdgcn_exp2f(p1[r]);
#define PK4(P, BASE, OUT) do { unsigned a0 = cvtpkv(P[BASE + 0], P[BASE + 1]), a1 = cvtpkv(P[BASE + 2], P[BASE + 3]);   \
    unsigned b0 = cvtpkv(P[BASE + 4], P[BASE + 5]), b1 = cvtpkv(P[BASE + 6], P[BASE + 7]);                              \
    auto r0 = __builtin_amdgcn_permlane32_swap(a0, b0, false, false); auto r1 = __builtin_amdgcn_permlane32_swap(a1, b1, false, false); \
    u32x4 w = {r0[0], r1[0], r0[1], r1[1]}; OUT = *reinterpret_cast<bf16x8*>(&w); } while (0)
  PK4(p0, 0, pa0); PK4(p0, 8, pa1); PK4(p1, 0, pa2); PK4(p1, 8, pa3);
#undef PK4
}
__device__ __forceinline__ bf16x8 scale_bf16x8(bf16x8 v, float c) {
  const u32x4 w = *reinterpret_cast<u32x4*>(&v); u32x4 o;
  o.x = cvtpk(bflo(w.x) * c, bfhi(w.x) * c); o.y = cvtpk(bflo(w.y) * c, bfhi(w.y) * c); o.z = cvtpk(bflo(w.z) * c, bfhi(w.z) * c); o.w = cvtpk(bflo(w.w) * c, bfhi(w.w) * c);
  return *reinterpret_cast<bf16x8*>(&o);
}
template <int PITCH> __device__ __forceinline__ int kswz(int r) { return PITCH == 256 ? (r & 15) : ((r >> 1) & 7); }
template <int NQF, int NQR, int PITCH> __device__ __forceinline__ void qkt(f32x16& p0, f32x16& p1, const LAS char* Ks, int chunk0, const bf16x8* qr, const LAS char* ql, int r32, int hi, const f32x16 init = f32x16{}) {
  p0 = init; p1 = init;
  const int sw = kswz<PITCH>(r32);
#pragma unroll
  for (int d0 = 0; d0 < NQF; ++d0) { const int off = ((chunk0 + d0 * 2 + hi) ^ sw) * 16;
    const bf16x8 b0 = *(const LAS bf16x8*)(Ks + r32 * PITCH + off);
    const bf16x8 b1 = *(const LAS bf16x8*)(Ks + (32 + r32) * PITCH + off);
    const bf16x8 q = d0 < NQR ? qr[d0 < NQR ? d0 : 0] : *(const LAS bf16x8*)(ql + (d0 - NQR < 0 ? 0 : d0 - NQR) * 1024);
    p0 = __builtin_amdgcn_mfma_f32_32x32x16_bf16(b0, q, p0, 0, 0, 0);
    p1 = __builtin_amdgcn_mfma_f32_32x32x16_bf16(b1, q, p1, 0, 0, 0); }
}
__device__ __forceinline__ int v_st(int k, int c) { const int kk = (k & ~0xC) | ((k & 4) << 1) | ((k & 8) >> 1); return ((kk >> 3) * 4 + (c >> 5)) * 512 + ((kk & 7) * 32 + (c & 31)) * 2; }
__device__ __forceinline__ int v_rd_base(int lane) { return ((lane & 3) << 3) | (((lane >> 2) & 3) << 6) | (((lane >> 4) & 1) << 5) | (((lane >> 5) & 1) << 8); }
constexpr int v_rd_off(int d0, int ks, int half) { return d0 * 512 + ks * 4096 + half * 2048; }
template <int OFF> __device__ __forceinline__ s16x4 tr_read(int vb) {
  s16x4 r; asm volatile("ds_read_b64_tr_b16 %0, %1 offset:%2" : "=&v"(r) : "v"(vb), "i"(OFF) : "memory"); return r;
}
template <int D0> __device__ __forceinline__ void pv_one(f32x16& od, int vb, bf16x8 pa0, bf16x8 pa1, bf16x8 pa2, bf16x8 pa3) {
  const s16x4 l0 = tr_read<v_rd_off(D0, 0, 0)>(vb), h0 = tr_read<v_rd_off(D0, 0, 1)>(vb), l1 = tr_read<v_rd_off(D0, 1, 0)>(vb), h1 = tr_read<v_rd_off(D0, 1, 1)>(vb);
  const s16x4 l2 = tr_read<v_rd_off(D0, 2, 0)>(vb), h2 = tr_read<v_rd_off(D0, 2, 1)>(vb), l3 = tr_read<v_rd_off(D0, 3, 0)>(vb), h3 = tr_read<v_rd_off(D0, 3, 1)>(vb);
  asm volatile("s_waitcnt lgkmcnt(0)" ::: "memory"); SBAR();
#define PK(L, H) (bf16x8){L[0], L[1], L[2], L[3], H[0], H[1], H[2], H[3]}
  od = __builtin_amdgcn_mfma_f32_32x32x16_bf16(pa0, PK(l0, h0), od, 0, 0, 0);
  od = __builtin_amdgcn_mfma_f32_32x32x16_bf16(pa1, PK(l1, h1), od, 0, 0, 0);
  od = __builtin_amdgcn_mfma_f32_32x32x16_bf16(pa2, PK(l2, h2), od, 0, 0, 0);
  od = __builtin_amdgcn_mfma_f32_32x32x16_bf16(pa3, PK(l3, h3), od, 0, 0, 0);
#undef PK
}
__device__ __forceinline__ void pv_d0(f32x16* o, int vb, bf16x8 pa0, bf16x8 pa1, bf16x8 pa2, bf16x8 pa3) {
  pv_one<0>(o[0], vb, pa0, pa1, pa2, pa3); pv_one<1>(o[1], vb, pa0, pa1, pa2, pa3); pv_one<2>(o[2], vb, pa0, pa1, pa2, pa3); pv_one<3>(o[3], vb, pa0, pa1, pa2, pa3);
}
struct VFrag { s16x4 l0, h0, l1, h1, l2, h2, l3, h3; };
typedef short v4i16_t __attribute__((ext_vector_type(4)));
template <int OFF> __device__ __forceinline__ s16x4 tr_read_b(int vb) {
  return __builtin_bit_cast(s16x4, __builtin_amdgcn_ds_read_tr16_b64_v4i16((LAS v4i16_t*)(uintptr_t)(unsigned)(vb + OFF)));
}
template <int D0> __device__ __forceinline__ void tr8b(VFrag& f, int vb) {
  f.l0 = tr_read_b<v_rd_off(D0, 0, 0)>(vb); f.h0 = tr_read_b<v_rd_off(D0, 0, 1)>(vb); f.l1 = tr_read_b<v_rd_off(D0, 1, 0)>(vb); f.h1 = tr_read_b<v_rd_off(D0, 1, 1)>(vb);
  f.l2 = tr_read_b<v_rd_off(D0, 2, 0)>(vb); f.h2 = tr_read_b<v_rd_off(D0, 2, 1)>(vb); f.l3 = tr_read_b<v_rd_off(D0, 3, 0)>(vb); f.h3 = tr_read_b<v_rd_off(D0, 3, 1)>(vb);
}
template <int D0> __device__ __forceinline__ void tr8(VFrag& f, int vb) {
  f.l0 = tr_read<v_rd_off(D0, 0, 0)>(vb); f.h0 = tr_read<v_rd_off(D0, 0, 1)>(vb); f.l1 = tr_read<v_rd_off(D0, 1, 0)>(vb); f.h1 = tr_read<v_rd_off(D0, 1, 1)>(vb);
  f.l2 = tr_read<v_rd_off(D0, 2, 0)>(vb); f.h2 = tr_read<v_rd_off(D0, 2, 1)>(vb); f.l3 = tr_read<v_rd_off(D0, 3, 0)>(vb); f.h3 = tr_read<v_rd_off(D0, 3, 1)>(vb);
}
__device__ __forceinline__ void mfma4(f32x16& od, VFrag& f, bf16x8 pa0, bf16x8 pa1, bf16x8 pa2, bf16x8 pa3) {
#define PK(L, H) (bf16x8){L[0], L[1], L[2], L[3], H[0], H[1], H[2], H[3]}
  od = __builtin_amdgcn_mfma_f32_32x32x16_bf16(pa0, PK(f.l0, f.h0), od, 0, 0, 0);
  od = __builtin_amdgcn_mfma_f32_32x32x16_bf16(pa1, PK(f.l1, f.h1), od, 0, 0, 0);
  od = __builtin_amdgcn_mfma_f32_32x32x16_bf16(pa2, PK(f.l2, f.h2), od, 0, 0, 0);
  od = __builtin_amdgcn_mfma_f32_32x32x16_bf16(pa3, PK(f.l3, f.h3), od, 0, 0, 0);
#undef PK
}
#define VF_TIE(f) "+v"(f.l0), "+v"(f.h0), "+v"(f.l1), "+v"(f.h1), "+v"(f.l2), "+v"(f.h2), "+v"(f.l3), "+v"(f.h3)
__device__ __forceinline__ void pv_pipe(f32x16* o, int vb, bf16x8 pa0, bf16x8 pa1, bf16x8 pa2, bf16x8 pa3) {
  VFrag A, B;
  asm volatile("s_waitcnt lgkmcnt(0)" ::: "memory");
  tr8<0>(A, vb); tr8<1>(B, vb);
  asm volatile("s_waitcnt lgkmcnt(8)" : VF_TIE(A) :: "memory");
  mfma4(o[0], A, pa0, pa1, pa2, pa3);
  tr8<2>(A, vb);
  asm volatile("s_waitcnt lgkmcnt(8)" : VF_TIE(B) :: "memory");
  mfma4(o[1], B, pa0, pa1, pa2, pa3);
  tr8<3>(B, vb);
  asm volatile("s_waitcnt lgkmcnt(8)" : VF_TIE(A) :: "memory");
  mfma4(o[2], A, pa0, pa1, pa2, pa3);
  asm volatile("s_waitcnt lgkmcnt(0)" : VF_TIE(B) :: "memory");
  mfma4(o[3], B, pa0, pa1, pa2, pa3);
}
__device__ __forceinline__ void pv_psm_lean(f32x16* o, int vb, bf16x8 pa0, bf16x8 pa1, bf16x8 pa2, bf16x8 pa3, f32x16& p0, f32x16& p1, f32x16& nm, float& alpha) {
  constexpr float THR2 = 11.541560327111707f;
  const bf16x8 one8 = {0x3F80, 0x3F80, 0x3F80, 0x3F80, 0x3F80, 0x3F80, 0x3F80, 0x3F80};
  VFrag A, B;
  asm volatile("s_waitcnt lgkmcnt(0)" ::: "memory");
  tr8<0>(A, vb); tr8<1>(B, vb);
  asm volatile("s_waitcnt lgkmcnt(8)" : VF_TIE(A) :: "memory");
  mfma4(o[0], A, pa0, pa1, pa2, pa3);
  float dmax = p0[0];
#pragma unroll
  for (int r = 1; r < 16; ++r) dmax = fmaxf(dmax, p0[r]);
  tr8<2>(A, vb);
  asm volatile("s_waitcnt lgkmcnt(8)" : VF_TIE(B) :: "memory");
  mfma4(o[1], B, pa0, pa1, pa2, pa3);
#pragma unroll
  for (int r = 0; r < 16; ++r) dmax = fmaxf(dmax, p1[r]);
  { auto rr = __builtin_amdgcn_permlane32_swap(__float_as_uint(dmax), __float_as_uint(dmax), false, false);
    dmax = fmaxf(__uint_as_float(rr[0]), __uint_as_float(rr[1])); }
  alpha = 1.f;
  if (!__all(dmax <= THR2)) {
    const float delta = dmax > THR2 ? dmax : 0.f; alpha = __builtin_amdgcn_exp2f(-delta);
#pragma unroll
    for (int r = 0; r < 16; ++r) { p0[r] -= delta; p1[r] -= delta; nm[r] -= delta; }
  }
  tr8<3>(B, vb);
  asm volatile("s_waitcnt lgkmcnt(8)" : VF_TIE(A) :: "memory");
  mfma4(o[2], A, pa0, pa1, pa2, pa3);
#pragma unroll
  for (int r = 0; r < 8; ++r) p0[r] = __builtin_amdgcn_exp2f(p0[r]);
  asm volatile("s_waitcnt lgkmcnt(0)" : VF_TIE(B) :: "memory");
  mfma4(o[3], B, pa0, pa1, pa2, pa3);
#pragma unroll
  for (int r = 8; r < 16; ++r) p0[r] = __builtin_amdgcn_exp2f(p0[r]);
  o[4] = __builtin_amdgcn_mfma_f32_32x32x16_bf16(pa0, one8, o[4], 0, 0, 0); o[4] = __builtin_amdgcn_mfma_f32_32x32x16_bf16(pa1, one8, o[4], 0, 0, 0);
  o[4] = __builtin_amdgcn_mfma_f32_32x32x16_bf16(pa2, one8, o[4], 0, 0, 0); o[4] = __builtin_amdgcn_mfma_f32_32x32x16_bf16(pa3, one8, o[4], 0, 0, 0);
}
__device__ __forceinline__ void pv_psm_lean_b(f32x16* o, int vb, bf16x8 pa0, bf16x8 pa1, bf16x8 pa2, bf16x8 pa3, f32x16& p0, f32x16& p1, f32x16& nm, float& alpha) {
  constexpr float THR2 = 11.541560327111707f;
  const bf16x8 one8 = {0x3F80, 0x3F80, 0x3F80, 0x3F80, 0x3F80, 0x3F80, 0x3F80, 0x3F80};
  VFrag A, B;
  tr8b<0>(A, vb); tr8b<1>(B, vb);
  mfma4(o[0], A, pa0, pa1, pa2, pa3);
  float dmax = p0[0];
#pragma unroll
  for (int r = 1; r < 16; ++r) dmax = fmaxf(dmax, p0[r]);
  tr8b<2>(A, vb);
  mfma4(o[1], B, pa0, pa1, pa2, pa3);
#pragma unroll
  for (int r = 0; r < 16; ++r) dmax = fmaxf(dmax, p1[r]);
  { auto rr = __builtin_amdgcn_permlane32_swap(__float_as_uint(dmax), __float_as_uint(dmax), false, false);
    dmax = fmaxf(__uint_as_float(rr[0]), __uint_as_float(rr[1])); }
  alpha = 1.f;
  if (!__all(dmax <= THR2)) {
    const float delta = dmax > THR2 ? dmax : 0.f; alpha = __builtin_amdgcn_exp2f(-delta);
#pragma unroll
    for (int r = 0; r < 16; ++r) { p0[r] -= delta; p1[r] -= delta; nm[r] -= delta; }
  }
  tr8b<3>(B, vb);
  mfma4(o[2], A, pa0, pa1, pa2, pa3);
#pragma unroll
  for (int r = 0; r < 8; ++r) p0[r] = __builtin_amdgcn_exp2f(p0[r]);
  mfma4(o[3], B, pa0, pa1, pa2, pa3);
#pragma unroll
  for (int r = 8; r < 16; ++r) p0[r] = __builtin_amdgcn_exp2f(p0[r]);
  o[4] = __builtin_amdgcn_mfma_f32_32x32x16_bf16(pa0, one8, o[4], 0, 0, 0); o[4] = __builtin_amdgcn_mfma_f32_32x32x16_bf16(pa1, one8, o[4], 0, 0, 0);
  o[4] = __builtin_amdgcn_mfma_f32_32x32x16_bf16(pa2, one8, o[4], 0, 0, 0); o[4] = __builtin_amdgcn_mfma_f32_32x32x16_bf16(pa3, one8, o[4], 0, 0, 0);
}
struct VStep { s16x4 l0, h0, l1, h1, l2, h2, l3, h3; };
template <int KS> __device__ __forceinline__ void trstep(VStep& f, int vb) {
  f.l0 = tr_read_b<v_rd_off(0, KS, 0)>(vb); f.h0 = tr_read_b<v_rd_off(0, KS, 1)>(vb); f.l1 = tr_read_b<v_rd_off(1, KS, 0)>(vb); f.h1 = tr_read_b<v_rd_off(1, KS, 1)>(vb);
  f.l2 = tr_read_b<v_rd_off(2, KS, 0)>(vb); f.h2 = tr_read_b<v_rd_off(2, KS, 1)>(vb); f.l3 = tr_read_b<v_rd_off(3, KS, 0)>(vb); f.h3 = tr_read_b<v_rd_off(3, KS, 1)>(vb);
}
__device__ __forceinline__ void mfma5(f32x16* o, const VStep& f, bf16x8 pa) {
  const bf16x8 one8 = {0x3F80, 0x3F80, 0x3F80, 0x3F80, 0x3F80, 0x3F80, 0x3F80, 0x3F80};
#define PK(L, H) (bf16x8){L[0], L[1], L[2], L[3], H[0], H[1], H[2], H[3]}
  o[0] = __builtin_amdgcn_mfma_f32_32x32x16_bf16(pa, PK(f.l0, f.h0), o[0], 0, 0, 0);
  o[1] = __builtin_amdgcn_mfma_f32_32x32x16_bf16(pa, PK(f.l1, f.h1), o[1], 0, 0, 0);
  o[2] = __builtin_amdgcn_mfma_f32_32x32x16_bf16(pa, PK(f.l2, f.h2), o[2], 0, 0, 0);
  o[3] = __builtin_amdgcn_mfma_f32_32x32x16_bf16(pa, PK(f.l3, f.h3), o[3], 0, 0, 0);
  o[4] = __builtin_amdgcn_mfma_f32_32x32x16_bf16(pa, one8, o[4], 0, 0, 0);
#undef PK
}
template <int BASE> __device__ __forceinline__ bf16x8 pk4e(const f32x16& P) {
  const float e0 = __builtin_amdgcn_exp2f(P[BASE + 0]), e1 = __builtin_amdgcn_exp2f(P[BASE + 1]), e2 = __builtin_amdgcn_exp2f(P[BASE + 2]), e3 = __builtin_amdgcn_exp2f(P[BASE + 3]);
  const float e4 = __builtin_amdgcn_exp2f(P[BASE + 4]), e5 = __builtin_amdgcn_exp2f(P[BASE + 5]), e6 = __builtin_amdgcn_exp2f(P[BASE + 6]), e7 = __builtin_amdgcn_exp2f(P[BASE + 7]);
  const unsigned a0 = cvtpk(e0, e1), a1 = cvtpk(e2, e3), b0 = cvtpk(e4, e5), b1 = cvtpk(e6, e7);
  const auto r0 = __builtin_amdgcn_permlane32_swap(a0, b0, false, false); const auto r1 = __builtin_amdgcn_permlane32_swap(a1, b1, false, false);
  u32x4 w = {r0[0], r1[0], r0[1], r1[1]}; return *reinterpret_cast<bf16x8*>(&w);
}
__device__ __forceinline__ float rowmax_lean(const f32x16& p0, const f32x16& p1) {
  float d = p0[0];
#pragma unroll
  for (int r = 1; r < 16; ++r) d = fmaxf(d, p0[r]);
#pragma unroll
  for (int r = 0; r < 16; ++r) d = fmaxf(d, p1[r]);
  const auto rr = __builtin_amdgcn_permlane32_swap(__float_as_uint(d), __float_as_uint(d), false, false);
  return fmaxf(__uint_as_float(rr[0]), __uint_as_float(rr[1]));
}
__device__ __forceinline__ void shift_lean(float dmax, f32x16& p0, f32x16& p1, f32x16& nm, float& alpha, const bool first) {
  constexpr float THR2 = 11.541560327111707f;
  alpha = 1.f;
  if (first || !__all(dmax <= THR2)) {
    const float delta = first ? dmax : (dmax > THR2 ? dmax : 0.f);
    if (!first) alpha = __builtin_amdgcn_exp2f(-delta);
#pragma unroll
    for (int r = 0; r < 16; ++r) { p0[r] -= delta; p1[r] -= delta; nm[r] -= delta; }
  }
}
#define SGB(mask, n) __builtin_amdgcn_sched_group_barrier((mask), (n), 0)
__device__ __forceinline__ bf16x8 ld8(const bf16* p) { return *reinterpret_cast<const bf16x8*>(p); }

template <int MODE, int ATTV = 0>
__device__ __forceinline__ void attn_unit(const bf16* __restrict__ Qrow0, int ldq, const bf16* __restrict__ Kb, const bf16* __restrict__ Vb, int ldk, const bf16* __restrict__ KRb,
                                          int b, int nct, int NT, bf16* __restrict__ Ob, float lam, const float* __restrict__ subln, float oscale, LAS unsigned char* lds_, const int tid_in) {
  constexpr bool LEAN = (MODE == 1) && ATT_LEAN; constexpr int NQF = MODE == 0 ? 12 : 4, NQR = MODE == 0 ? 4 : 0, NOB = LEAN ? 5 : 4, PITCH = MODE == 0 ? 384 : 256, SHM_V = 16384, SHM_K = 64 * PITCH, SDEPTH = ATT_SDEPTH(MODE); constexpr bool PVPIPE = ATT_PVPIPE(MODE);
  const float SCALE = MODE == 0 ? 0.07216878364870323f : 0.125f;
  const float C = SCALE * 1.4426950408889634f, THRS = 8.f / SCALE;
  if (ATT_PRIO) { if (__builtin_amdgcn_readfirstlane(tid_in >> 8) != 0) __builtin_amdgcn_s_setprio(1); }
  const int tid = launder_v(tid_in) & 511, wid = tid >> 6, lane = tid & 63, r32 = lane & 31, hi = lane >> 5;
  LAS char* lds = (LAS char*)(LAS unsigned char*)lds_;
  constexpr bool THREE = (MODE == 1) && ATT_3STAGE; constexpr int NSTG = THREE ? 3 : 2, STG = SHM_V + SHM_K, SCR0 = NSTG * STG;
#define VOFF(s) (!THREE ? (s) * SHM_V : (s) * STG)
#define KOFF(s) (!THREE ? 2 * SHM_V + (s) * SHM_K : (s) * STG + SHM_V)
  LAS char* V_lds = lds; LAS char* K_lds = lds;
  LAS float* wsf = (LAS float*)(lds + NSTG * (SHM_V + SHM_K)) + wid * 64; LAS float* li_l = wsf; LAS float* al_l = wsf + 32;
  const int wq = MODE == 0 ? wid : (wid & 3), sgrp = MODE == 0 ? 0 : (wid >> 2);
  float m_reg = -1e30f, l_reg = 0; f32x16 o[NOB] = {}; bf16x8 qr[NQR > 0 ? NQR : 1]; f32x16 nm = {};
  LAS char* ql = lds + SCR0 + 2048 + wid * (MODE == 0 ? 8192 : 4096) + lane * 16;
  const bf16* Qw = Qrow0 + (size_t)(wq * 32 + r32) * ldq + sgrp * 64 + hi * 8;
#pragma unroll
  for (int d0 = 0; d0 < NQR; ++d0) qr[d0] = ld8(Qw + d0 * 16);
#pragma unroll
  for (int d0 = NQR; d0 < NQF; ++d0) { bf16x8 qv = ld8(Qw + d0 * 16); if (LEAN) qv = scale_bf16x8(qv, C); *(LAS bf16x8*)(ql + (d0 - NQR) * 1024) = qv; }
  const int sr = tid >> 4, sc = (tid & 15) * 8, vst0 = v_st(sr, sc), vst1 = v_st(32 + sr, sc);
  const int kst0 = sr * PITCH + (((tid & 15) ^ kswz<PITCH>(sr)) * 16), kst1 = kst0 + 32 * PITCH;
  const int rrow = tid >> 3, krs = rrow * PITCH + (((16 + (tid & 7)) ^ kswz<PITCH>(rrow)) * 16);
  const int chunk0 = sgrp * 8;
  const int vb0 = (int)(uintptr_t)V_lds + v_rd_base(lane);
  struct Slot { bf16x8 vs0, vs1, ks0, ks1, kr; } sr_[SDEPTH];
#define KROW(jt) ((jt) < nct ? (ML + b * CTXL + (jt) * 64) : (b * SEQ + ((jt) - nct) * 64))
#define SLOAD(i, jt) do { const int k0_ = KROW(jt); sr_[i].vs0 = ld8(Vb + (size_t)(k0_ + sr) * ldk + sc); sr_[i].vs1 = ld8(Vb + (size_t)(k0_ + 32 + sr) * ldk + sc); \
    sr_[i].ks0 = ld8(Kb + (size_t)(k0_ + sr) * ldk + sc); sr_[i].ks1 = ld8(Kb + (size_t)(k0_ + 32 + sr) * ldk + sc); \
    if (MODE == 0) sr_[i].kr = ld8(KRb + (size_t)(k0_ + rrow) * 64 + (tid & 7) * 8); } while (0)
#define SWRITE(bf, i) do { *(LAS bf16x8*)(V_lds + VOFF(bf) + vst0) = sr_[i].vs0; *(LAS bf16x8*)(V_lds + VOFF(bf) + vst1) = sr_[i].vs1; \
    *(LAS bf16x8*)(K_lds + KOFF(bf) + kst0) = sr_[i].ks0; *(LAS bf16x8*)(K_lds + KOFF(bf) + kst1) = sr_[i].ks1; \
    if (MODE == 0) *(LAS bf16x8*)(K_lds + KOFF(bf) + krs) = sr_[i].kr; } while (0)
#define SWAIT() do { if constexpr (SDEPTH == 2) asm volatile("s_waitcnt vmcnt(4)" ::: "memory"); else asm volatile("s_waitcnt vmcnt(0)" ::: "memory"); } while (0)
#define RESC(a) do { if (__any((a) < 1.f)) { if (hi == 0) al_l[r32] = (a); asm volatile("s_waitcnt lgkmcnt(0)" ::: "memory"); \
    _Pragma("unroll") for (int d = 0; d < NOB; ++d) _Pragma("unroll") for (int r = 0; r < 16; ++r) o[d][r] *= al_l[crow(r, hi)]; } } while (0)
#define PV(vb_) do { if constexpr (ATTV == 2) { o[0][0] += __uint_as_float((unsigned)pa0[0] + (unsigned)pa3[1]); } else if constexpr (PVPIPE) pv_pipe(o, (vb_), pa0, pa1, pa2, pa3); else pv_d0(o, (vb_), pa0, pa1, pa2, pa3); \
    if constexpr (LEAN) { const bf16x8 one8 = {0x3F80, 0x3F80, 0x3F80, 0x3F80, 0x3F80, 0x3F80, 0x3F80, 0x3F80};     \
        o[NOB - 1] = __builtin_amdgcn_mfma_f32_32x32x16_bf16(pa0, one8, o[NOB - 1], 0, 0, 0); o[NOB - 1] = __builtin_amdgcn_mfma_f32_32x32x16_bf16(pa1, one8, o[NOB - 1], 0, 0, 0); \
        o[NOB - 1] = __builtin_amdgcn_mfma_f32_32x32x16_bf16(pa2, one8, o[NOB - 1], 0, 0, 0); o[NOB - 1] = __builtin_amdgcn_mfma_f32_32x32x16_bf16(pa3, one8, o[NOB - 1], 0, 0, 0); } } while (0)
#define PSM(p0_, p1_, mn_, al_, first_) do { if constexpr (ATTV == 1) { al_ = 1.f; } else if constexpr (LEAN) partialSM_lean(p0_, p1_, nm, al_, first_); else partialSM(p0_, p1_, m_reg, mn_, al_, C, THRS); } while (0)
#define FSM(p0_, p1_, al_) do { if constexpr (ATTV == 1) { u32x4 w0_ = {__float_as_uint(p0_[0]), __float_as_uint(p0_[1]), __float_as_uint(p1_[0]), __float_as_uint(p1_[1])}; pa0 = pa1 = pa2 = pa3 = *reinterpret_cast<bf16x8*>(&w0_); } else if constexpr (LEAN) finishSM_lean(p0_, p1_, pa0, pa1, pa2, pa3); else finishSM(p0_, p1_, al_, l_reg, pa0, pa1, pa2, pa3); } while (0)
#define QKT(p0_, p1_, Kp_) do { if constexpr (ATTV == 5) { p0_ = nm; p1_ = nm; p0_[0] += (float)r32; } else if constexpr (LEAN) qkt<NQF, NQR, PITCH>(p0_, p1_, Kp_, chunk0, qr, ql, r32, hi, nm); else qkt<NQF, NQR, PITCH>(p0_, p1_, Kp_, chunk0, qr, ql, r32, hi); } while (0)
  f32x16 pA0, pA1, pB0, pB1; float mnA, mnB, alA, alB; bf16x8 pa0, pa1, pa2, pa3;
  constexpr bool KMAJ = (MODE == 1) && LEAN && ATT_KMAJOR && (ATTV == 0) && !THREE;
  if constexpr (KMAJ) {
    VStep VA, VB;
#define KSTEPS(PC0, PC1, ALC, PP0, PP1, KC, VP, LD, DOQK) do { const int vb_ = vb0 + VOFF(VP); float dmx_ = 0.f; \
      SBAR(); \
      if (DOQK) QKT(PC0, PC1, K_lds + KOFF(KC)); \
      pa0 = pk4e<0>(PP0); trstep<0>(VA, vb_); \
      _Pragma("unroll") for (int i_ = 0; i_ < 8; ++i_) { SGB(0x008, 1); SGB(0x100, 3); SGB(0x002, 2); } \
      SBAR(); LD; SBAR(); \
      mfma5(o, VA, pa0); pa1 = pk4e<8>(PP0); trstep<1>(VB, vb_); \
      _Pragma("unroll") for (int i_ = 0; i_ < 5; ++i_) { SGB(0x008, 1); SGB(0x100, 2); SGB(0x002, 3); } \
      SBAR(); \
      mfma5(o, VB, pa1); pa2 = pk4e<0>(PP1); trstep<2>(VA, vb_); \
      _Pragma("unroll") for (int i_ = 0; i_ < 5; ++i_) { SGB(0x008, 1); SGB(0x100, 2); SGB(0x002, 3); } \
      SBAR(); \
      mfma5(o, VA, pa2); pa3 = pk4e<8>(PP1); trstep<3>(VB, vb_); \
      _Pragma("unroll") for (int i_ = 0; i_ < 5; ++i_) { SGB(0x008, 1); SGB(0x100, 2); SGB(0x002, 3); } \
      SBAR(); \
      mfma5(o, VB, pa3); if (DOQK) dmx_ = rowmax_lean(PC0, PC1); \
      _Pragma("unroll") for (int i_ = 0; i_ < 5; ++i_) { SGB(0x008, 1); SGB(0x002, 7); } \
      SBAR(); \
      if (DOQK) shift_lean(dmx_, PC0, PC1, nm, ALC, false); } while (0)
    SLOAD(0, 0); asm volatile("s_waitcnt vmcnt(0)" ::: "memory"); SWRITE(0, 0); __syncthreads();
    QKT(pA0, pA1, K_lds + KOFF(0)); shift_lean(rowmax_lean(pA0, pA1), pA0, pA1, nm, alA, true);
    SLOAD(0, 1); asm volatile("s_waitcnt vmcnt(0)" ::: "memory"); SWRITE(1, 0); __syncthreads();
    for (int j = 1; j + 1 < NT; j += 2) {
      KSTEPS(pB0, pB1, alB, pA0, pA1, 1, 0, SLOAD(0, j + 1), true);
      __syncthreads(); asm volatile("s_waitcnt vmcnt(0)" ::: "memory"); SWRITE(0, 0);
      RESC(alB); __syncthreads();
      KSTEPS(pA0, pA1, alA, pB0, pB1, 0, 1, SLOAD(0, j + 2), true);
      __syncthreads(); asm volatile("s_waitcnt vmcnt(0)" ::: "memory"); SWRITE(1, 0);
      RESC(alA); __syncthreads();
    }
    KSTEPS(pB0, pB1, alB, pA0, pA1, 1, 0, (void)0, true);
    __syncthreads(); RESC(alB);
    KSTEPS(pA0, pA1, alA, pB0, pB1, 0, 1, (void)0, false);
#undef KSTEPS
  } else if constexpr (!THREE) {
  constexpr int SE = 0, SO = SDEPTH - 1;
  SLOAD(SE, 0); asm volatile("s_waitcnt vmcnt(0)" ::: "memory"); SWRITE(0, SE); __syncthreads();
  QKT(pA0, pA1, K_lds + KOFF(0)); PSM(pA0, pA1, mnA, alA, true);
  SLOAD(SO, 1); if constexpr (SDEPTH == 2) { if (2 < NT) SLOAD(SE, 2); }
  SWAIT(); SWRITE(1, SO); __syncthreads();
#define ILV() do { if constexpr (PVPIPE) { _Pragma("unroll") for (int i_ = 0; i_ < 20; ++i_) { __builtin_amdgcn_sched_group_barrier(0x008, 1, 0); __builtin_amdgcn_sched_group_barrier(0x002, 5, 0); } } } while (0)
#define LSLOAD(i, jt) do { if constexpr (ATTV != 3) SLOAD(i, jt); } while (0)
#define LSWRITE(bf, i) do { if constexpr (ATTV != 3) SWRITE(bf, i); } while (0)
#define LSWAIT() do { if constexpr (ATTV != 3) SWAIT(); } while (0)
#define LSYNC() do { if constexpr (ATTV != 4) __syncthreads(); } while (0)
#define HALFSTEP(PC0, PC1, MNC, ALC, PP0, PP1, ALP, KC, VP, LD) do { \
    if (!STAG || wid < 4) { \
      SBAR(); QKT(PC0, PC1, K_lds + KOFF(KC)); FSM(PP0, PP1, ALP); SBAR(); \
      LD; SBAR(); \
      if constexpr (PVPIPE && LEAN && ATTV == 0) { if constexpr (ATT_TRB) pv_psm_lean_b(o, vb0 + VOFF(VP), pa0, pa1, pa2, pa3, PC0, PC1, nm, ALC); else pv_psm_lean(o, vb0 + VOFF(VP), pa0, pa1, pa2, pa3, PC0, PC1, nm, ALC); } else { PV(vb0 + VOFF(VP)); PSM(PC0, PC1, MNC, ALC, false); } \
    } else { \
      SBAR(); FSM(PP0, PP1, ALP); SBAR(); \
      LD; SBAR(); \
      PV(vb0 + VOFF(VP)); SBAR(); \
      QKT(PC0, PC1, K_lds + KOFF(KC)); SBAR(); \
      PSM(PC0, PC1, MNC, ALC, false); \
    } } while (0)
  constexpr bool STAG = (MODE == 1) && ATT_STAGGER && ATTV == 0;
  for (int j = 1; j + 1 < NT; j += 2) {
    HALFSTEP(pB0, pB1, mnB, alB, pA0, pA1, alA, 1, 0, LSLOAD(SO, j + SDEPTH));
    LSYNC(); LSWAIT(); LSWRITE(0, SE);
    RESC(alB); LSYNC();
    HALFSTEP(pA0, pA1, mnA, alA, pB0, pB1, alB, 0, 1, if (SDEPTH == 1 || j + 3 < NT) LSLOAD(SE, j + 1 + SDEPTH));
    LSYNC(); LSWAIT(); LSWRITE(1, SO);
    RESC(alA); LSYNC();
  }
#undef HALFSTEP
#undef ILV
#undef LSLOAD
#undef LSWRITE
#undef LSWAIT
#undef LSYNC
  SBAR(); QKT(pB0, pB1, K_lds + KOFF(1));
  FSM(pA0, pA1, alA); SBAR();
  PV(vb0); PSM(pB0, pB1, mnB, alB, false);
  __syncthreads(); RESC(alB);
  FSM(pB0, pB1, alB); SBAR();
  PV(vb0 + VOFF(1));
  } else {
#define STEP(PC0, PC1, ALC, PP0, PP1, ALP, jj, SP, SC, SN) do { const int j_ = (jj); \
      if (j_ + 1 < NT) { asm volatile("s_waitcnt vmcnt(0)" ::: "memory"); SWRITE(SN, 0); if (j_ + 2 < NT) SLOAD(0, j_ + 2); } \
      SBAR(); QKT(PC0, PC1, K_lds + KOFF(SC)); FSM(PP0, PP1, ALP); SBAR(); \
      PV(vb0 + VOFF(SP)); PSM(PC0, PC1, mnA, ALC, false); \
      RESC(ALC); __syncthreads(); } while (0)
    SLOAD(0, 0); asm volatile("s_waitcnt vmcnt(0)" ::: "memory"); SWRITE(0, 0);
    SLOAD(0, 1); asm volatile("s_waitcnt vmcnt(0)" ::: "memory"); SWRITE(1, 0);
    SLOAD(0, 2); __syncthreads();
    QKT(pA0, pA1, K_lds + KOFF(0)); PSM(pA0, pA1, mnA, alA, true);
    STEP(pB0, pB1, alB, pA0, pA1, alA, 1, 0, 1, 2);
    int j = 2;
    for (; j + 5 < NT; j += 6) {
      STEP(pA0, pA1, alA, pB0, pB1, alB, j, 1, 2, 0);
      STEP(pB0, pB1, alB, pA0, pA1, alA, j + 1, 2, 0, 1);
      STEP(pA0, pA1, alA, pB0, pB1, alB, j + 2, 0, 1, 2);
      STEP(pB0, pB1, alB, pA0, pA1, alA, j + 3, 1, 2, 0);
      STEP(pA0, pA1, alA, pB0, pB1, alB, j + 4, 2, 0, 1);
      STEP(pB0, pB1, alB, pA0, pA1, alA, j + 5, 0, 1, 2);
    }
    if (j < NT) { STEP(pA0, pA1, alA, pB0, pB1, alB, j, 1, 2, 0); STEP(pB0, pB1, alB, pA0, pA1, alA, j + 1, 2, 0, 1); j += 2; }
    if (j < NT) { STEP(pA0, pA1, alA, pB0, pB1, alB, j, 0, 1, 2); STEP(pB0, pB1, alB, pA0, pA1, alA, j + 1, 1, 2, 0); j += 2; }
    FSM(pB0, pB1, alB); SBAR();
    { const int sl = (NT - 1) % 3; PV(vb0 + VOFF(sl)); }
#undef STEP
  }
  float rli[16];
  if constexpr (LEAN) {
#pragma unroll
    for (int r = 0; r < 16; ++r) rli[r] = __builtin_amdgcn_rcpf(o[NOB - 1][r]);
  } else {
    if (hi == 0) li_l[r32] = l_reg; asm volatile("s_waitcnt lgkmcnt(0)" ::: "memory");
#pragma unroll
    for (int r = 0; r < 16; ++r) rli[r] = __builtin_amdgcn_rcpf(li_l[crow(r, hi)]);
  }
  bf16* Ow = Ob + (size_t)(wq * 32) * DM;
  if constexpr (MODE == 0) {
#pragma unroll
    for (int r = 0; r < 16; ++r) { const int orow = crow(r, hi);
#pragma unroll
      for (int d0 = 0; d0 < 4; ++d0) Ow[(size_t)orow * DM + d0 * 32 + r32] = tobf1(o[d0][r] * rli[r]); }
    __syncthreads();
  } else {
    LAS float* ex = (LAS float*)lds;
    __syncthreads();
    if (sgrp == 1) {
#pragma unroll
      for (int r = 0; r < 16; ++r)
#pragma unroll
        for (int d0 = 0; d0 < 4; ++d0) ex[(wq * 32 + crow(r, hi)) * 128 + d0 * 32 + r32] = o[d0][r] * rli[r];
    }
    __syncthreads();
    if (sgrp == 0) {
#pragma unroll
      for (int r = 0; r < 16; ++r) { const int orow = crow(r, hi); float dd[4]; float ss = 0.f;
#pragma unroll
        for (int d0 = 0; d0 < 4; ++d0) { dd[d0] = o[d0][r] * rli[r] - lam * ex[(wq * 32 + orow) * 128 + d0 * 32 + r32]; ss += dd[d0] * dd[d0]; }
        ss = half_sum32(ss);
        const float rs = oscale / sqrtf(ss * (1.0f / 128.0f) + LN_EPS);
#pragma unroll
        for (int d0 = 0; d0 < 4; ++d0) Ow[(size_t)orow * DM + d0 * 32 + r32] = tobf1(dd[d0] * rs * subln[d0 * 32 + r32]); }
    }
    __syncthreads();
  }
  if (ATT_PRIO) __builtin_amdgcn_s_setprio(0);
#undef VOFF
#undef KOFF
#undef PV
#undef PSM
#undef FSM
#undef QKT
#undef KROW
#undef SLOAD
#undef SWRITE
#undef SWAIT
#undef RESC
}
}

__device__ __forceinline__ void mla_attn_phase(CP P, LAS unsigned char* lds, const int tid) {
    const bf16* QM = (const bf16*)(P->ws + WS_QM); const bf16* KV = (const bf16*)(P->ws + WS_KV); const bf16* KR = (const bf16*)(P->ws + WS_KR); bf16* Gb = (bf16*)(P->ws + WS_G);
    const int c = blockIdx.x, G = gridDim.x;
    for (int u = c; u < 1024 + 32; u += G) {
        int b, h, qrow0, NT;
        if (u < 1024) { const int i = u >> 8, cc = u & 255; const int bh = (cc & 7) + 8 * i, qb = cc >> 3; b = bh >> 4; h = bh & 15; qrow0 = b * SEQ + qb * 256; NT = 4 + 128; }
        else { const int bh = u - 1024; b = bh >> 4; h = bh & 15; qrow0 = ML + b * CTXL; NT = 4; }
        att::attn_unit<0>(QM + (size_t)qrow0 * 3072 + h * 192, 3072, KV + h * 256, KV + h * 256 + 128, 4096, KR, b, 4, NT, Gb + (size_t)qrow0 * DM + h * 128, 0.f, nullptr, 1.f, lds, tid);
    }
}
template <int ATTV = 0>
__device__ __forceinline__ void da_attn_phase(CP P, float lam, float oscale, LAS unsigned char* lds, const int tid, const bool ctx_q) {
    const bf16* Z = (const bf16*)(P->ws + WS_Z); bf16* Gb = (bf16*)(P->ws + WS_G); const float* subln = P->in[27];
    const int c = blockIdx.x, G = gridDim.x;
    for (int u = c; u < 2048 + (ctx_q ? 64 : 0); u += G) {
        int b, h, qrow0, NT;
        if (u < 2048) { const int i = u >> 8, cc = u & 255; const int bh = (cc & 7) + 8 * (i >> 1), qb = (cc >> 3) + 32 * (i & 1); b = bh >> 4; h = bh & 15; qrow0 = b * SEQ + qb * 128; NT = 4 + 128; }
        else { const int v = u - 2048; const int bh = v >> 1; b = bh >> 4; h = bh & 15; qrow0 = ML + b * CTXL + (v & 1) * 128; NT = 4; }
        att::attn_unit<1, ATTV>(Z + (size_t)qrow0 * 6144 + h * 128, 6144, Z + 2048 + h * 128, Z + 4096 + h * 128, 6144, nullptr, b, 4, NT, Gb + (size_t)qrow0 * DM + h * 128, lam, subln, oscale, lds, tid);
    }
}

__device__ __forceinline__ unsigned f2ord(float f) { const unsigned u = __float_as_uint(f); return u ^ ((unsigned)((int)u >> 31) | 0x80000000u); }
__device__ __forceinline__ float ord2f(unsigned k) { return __uint_as_float((k & 0x80000000u) ? (k ^ 0x80000000u) : ~k); }
__device__ __forceinline__ void ce_desc(unsigned& a, unsigned& b) { const unsigned mx = a > b ? a : b, mn = a > b ? b : a; a = mx; b = mn; }
template <int N, bool DESC> __device__ __forceinline__ void bitonic_merge(unsigned* a) {
#pragma unroll
    for (int j = N / 2; j > 0; j >>= 1)
#pragma unroll
        for (int i = 0; i < N; ++i) { const int l = i ^ j; if (l > i) { if (DESC) ce_desc(a[i], a[l]); else ce_desc(a[l], a[i]); } }
}
template <int N, bool DESC> __device__ __forceinline__ void bitonic_sort(unsigned* a) {
#pragma unroll
    for (int k = 2; k <= N; k <<= 1)
#pragma unroll
        for (int j = k >> 1; j > 0; j >>= 1)
#pragma unroll
            for (int i = 0; i < N; ++i) { const int l = i ^ j; if (l > i) { const bool up = ((i & k) == 0); if (up == DESC) ce_desc(a[i], a[l]); else ce_desc(a[l], a[i]); } }
}
__device__ __forceinline__ void top16_of_64(unsigned (&a)[64]) {
    bitonic_sort<16, true>(a); bitonic_sort<16, false>(a + 16); bitonic_sort<16, true>(a + 32); bitonic_sort<16, false>(a + 48);
#pragma unroll
    for (int i = 0; i < 16; ++i) a[i] = a[i] > a[16 + i] ? a[i] : a[16 + i];
    bitonic_merge<16, true>(a);
#pragma unroll
    for (int i = 0; i < 16; ++i) a[32 + i] = a[32 + i] > a[48 + i] ? a[32 + i] : a[48 + i];
    bitonic_merge<16, false>(a + 32);
#pragma unroll
    for (int i = 0; i < 16; ++i) a[i] = a[i] > a[32 + i] ? a[i] : a[32 + i];
    bitonic_merge<16, true>(a);
}
template <int PASS> __device__ __forceinline__ void route_pass(const bf16* QP, const LAS char* lds, int tok, int head, int r32, int hi, unsigned (&top)[16]) {
    f32x16 acc[4] = {};
    const bf16* qp = QP + (size_t)tok * DM + head * 256 + PASS * 128 + hi * 8;
    bf16x8 qf[8];
#pragma unroll
    for (int ks = 0; ks < 8; ++ks) qf[ks] = *(const bf16x8*)(qp + ks * 16);
    const LAS char* Kl = lds + PASS * 32768;
#pragma unroll
    for (int kb = 0; kb < 4; ++kb)
#pragma unroll
        for (int ks = 0; ks < 8; ++ks) { const bf16x8 a = *(const LAS bf16x8*)(Kl + (kb * 32 + r32) * 256 + (((ks * 2 + hi) ^ (r32 & 15)) * 16));
            acc[kb] = __builtin_amdgcn_mfma_f32_32x32x16_bf16(a, qf[ks], acc[kb], 0, 0, 0); }
    unsigned key[64]; const unsigned base = 127u - 4u * (unsigned)hi;
#pragma unroll
    for (int kb = 0; kb < 4; ++kb)
#pragma unroll
        for (int r = 0; r < 16; ++r) key[kb * 16 + r] = (f2ord(acc[kb][r]) & ~127u) | (base - (unsigned)(kb * 32 + (r & 3) + 8 * (r >> 2)));
    top16_of_64(key);
    unsigned pr[16];
#pragma unroll
    for (int i = 0; i < 16; ++i) pr[i] = lane_xor32(key[15 - i], hi << 5);
#pragma unroll
    for (int i = 0; i < 16; ++i) key[i] = key[i] > pr[i] ? key[i] : pr[i];
    bitonic_merge<16, true>(key);
#pragma unroll
    for (int i = 0; i < 16; ++i) top[i] = key[i];
}
#ifndef ROUTE_SORT
#define ROUTE_SORT 1
#endif
#define DPP_U(v, ctrl) ((unsigned)__builtin_amdgcn_mov_dpp((int)(v), (ctrl), 0xF, 0xF, true))
template <int J> __device__ __forceinline__ unsigned lane_xor_u(unsigned v, int lane) {
    if (J == 1) return DPP_U(v, 0xB1);
    if (J == 2) return DPP_U(v, 0x4E);
    if (J == 4) { const unsigned t = DPP_U(v, 0x141); return DPP_U(t, 0x1B); }
    if (J == 8) { const unsigned t = DPP_U(v, 0x140); return DPP_U(t, 0x141); }
    if (J == 16) { const auto r = __builtin_amdgcn_permlane16_swap(v, v, false, false); return (lane & 16) ? r[0] : r[1]; }
    return lane_xor32(v, lane);
}
template <int K, int J> __device__ __forceinline__ void sort128_stage(unsigned& a0, unsigned& a1, int lane) {
    if constexpr (J == 64) { const unsigned mn = a0 < a1 ? a0 : a1, mx = a0 < a1 ? a1 : a0; a0 = mn; a1 = mx; }
    else { const unsigned p0 = lane_xor_u<J>(a0, lane), p1 = lane_xor_u<J>(a1, lane);
        const bool lower = (lane & J) == 0;
        const bool asc0 = (K >= 64) ? true : ((lane & K) == 0), asc1 = (K == 128) ? true : (K == 64 ? false : ((lane & K) == 0));
        const unsigned mn0 = a0 < p0 ? a0 : p0, mx0 = a0 < p0 ? p0 : a0, mn1 = a1 < p1 ? a1 : p1, mx1 = a1 < p1 ? p1 : a1;
        a0 = (lower == asc0) ? mn0 : mx0; a1 = (lower == asc1) ? mn1 : mx1; }
    if constexpr (J > 1) sort128_stage<K, J / 2>(a0, a1, lane);
    else if constexpr (K < 128) sort128_stage<K * 2, K>(a0, a1, lane);
}
__device__ __forceinline__ void sort128_asc(unsigned& a0, unsigned& a1, int lane) { sort128_stage<2, 1>(a0, a1, lane); }
__device__ __forceinline__ void route_phase(CP P, int L, int Mrows, LAS unsigned char* lds_, int tid, int lane, int wid, int gw, int NGW) {
    const bf16* QP = (const bf16*)(P->ws + WS_QP); unsigned* ROUTE = (unsigned*)(P->ws + WS_ROUTE);
    LAS char* lds = (LAS char*)(LAS unsigned char*)lds_;
    __syncthreads();
    {
        const bf16* K1 = (const bf16*)(P->ws + WS_PK1) + (size_t)L * 128 * 128; const bf16* K2 = (const bf16*)(P->ws + WS_PK2) + (size_t)L * 128 * 128;
        for (int c16 = tid; c16 < 2 * 128 * 16; c16 += NWAVES * 64) { const int mat = c16 >> 11, row = (c16 >> 4) & 127, ch = c16 & 15;
            const u32x4 w = *(const u32x4*)((mat ? K2 : K1) + row * 128 + ch * 8);
            *(LAS u32x4*)(lds + mat * 32768 + row * 256 + ((ch ^ (row & 15)) * 16)) = w; }
    }
    __syncthreads();
    LAS unsigned* sc = (LAS unsigned*)(lds + 65536) + wid * 2048;
    const int r32 = lane & 31, hi = lane >> 5;
    for (int item = gw; item < Mrows / 4; item += NGW) {
        const int tok = item * 4 + (r32 >> 3), head = r32 & 7;
        unsigned top0[16], top1[16];
        route_pass<0>(QP, lds, tok, head, r32, hi, top0);
        route_pass<1>(QP, lds, tok, head, r32, hi, top1);
        float v1[16], v2[16];
#pragma unroll
        for (int i = 0; i < 16; ++i) { v1[i] = ord2f(top0[i] & ~127u); v2[i] = ord2f(top1[i] & ~127u);
            sc[i * 64 + lane] = 127u - (top0[i] & 127u); sc[(16 + i) * 64 + lane] = 127u - (top1[i] & 127u); }
        unsigned ck[64]; int n = 0;
#pragma unroll
        for (int i = 0; i < 16; ++i)
#pragma unroll
            for (int j = 0; j < 16; ++j) if ((i + 1) * (j + 1) <= 16) { ck[n] = (f2ord(v1[i] + v2[j]) & ~255u) | (unsigned)(i * 16 + j); ++n; }
#pragma unroll
        for (int i = 50; i < 64; ++i) ck[i] = 0u;
        top16_of_64(ck);
        float ev[16]; float sum = 0.f; const float mx = ord2f(ck[0] & ~255u);
#pragma unroll
        for (int k = 0; k < 16; ++k) { ev[k] = __expf(ord2f(ck[k] & ~255u) - mx); sum += ev[k]; }
        const float inv = 1.0f / sum;
        unsigned ee[16];
#pragma unroll
        for (int k = 0; k < 16; ++k) { const unsigned pc = ck[k] & 255u; const unsigned i1 = sc[(pc >> 4) * 64 + lane], i2 = sc[(16 + (pc & 15u)) * 64 + lane]; ee[k] = i1 * 128u + i2; ev[k] *= inv; }
#if ROUTE_SORT
        { const int tq = r32 >> 3;
#pragma unroll
          for (int k = 0; k < 8; ++k) {
              const unsigned eL = ee[k], eH = ee[k + 8]; const float gL = ev[k], gH = ev[k + 8];
              sc[tq * 256 + head * 16 + hi * 8 + k] = hi ? eH : eL; sc[tq * 256 + 128 + head * 16 + hi * 8 + k] = __float_as_uint(hi ? gH : gL); }
#pragma unroll 1
          for (int t = 0; t < 4; ++t) {
              unsigned a0 = (sc[t * 256 + lane] << 7) | (unsigned)lane, a1 = (sc[t * 256 + 64 + lane] << 7) | (unsigned)(64 + lane);
              sort128_asc(a0, a1, lane);
              const unsigned g0 = sc[t * 256 + 128 + (a0 & 127u)], g1 = sc[t * 256 + 128 + (a1 & 127u)];
              u32x2* outp = (u32x2*)(ROUTE + (size_t)(item * 4 + t) * 256);
              outp[lane] = (u32x2){a0 >> 7, g0}; outp[64 + lane] = (u32x2){a1 >> 7, g1}; }
        }
#else
        u32x4* outp = (u32x4*)(ROUTE + ((size_t)tok * 128 + head * 16 + hi * 8) * 2);
#pragma unroll
        for (int k = 0; k < 8; k += 2) { u32x4 w;
            const unsigned eL0 = ee[k], eH0 = ee[k + 8], eL1 = ee[k + 1], eH1 = ee[k + 9]; const float gL0 = ev[k], gH0 = ev[k + 8], gL1 = ev[k + 1], gH1 = ev[k + 9];
            w.x = hi ? eH0 : eL0; w.y = __float_as_uint(hi ? gH0 : gL0); w.z = hi ? eH1 : eL1; w.w = __float_as_uint(hi ? gH1 : gL1);
            outp[k >> 1] = w; }
#endif
    }
}

typedef float f32x2 __attribute__((ext_vector_type(2)));
typedef float f32x32 __attribute__((ext_vector_type(32)));
typedef unsigned u32x6 __attribute__((ext_vector_type(6)));
typedef __bf16 bf16x32 __attribute__((ext_vector_type(32)));
typedef unsigned u32x16 __attribute__((ext_vector_type(16)));
typedef __bf16 bf16x2_t __attribute__((ext_vector_type(2)));
#ifndef GATHER_ZIGZAG
#define GATHER_ZIGZAG 0
#endif
#ifndef GATHER_PRE
#define GATHER_PRE 0
#endif
#ifndef GATHER_VECREG
#define GATHER_VECREG 1
#endif
#ifndef GATHER_MFMADOT
#define GATHER_MFMADOT 0
#endif
typedef short s16x4_t __attribute__((ext_vector_type(4)));
#ifndef GATHER_PAIRRED
#define GATHER_PAIRRED 1
#endif
#ifndef GATHER_EARLY
#define GATHER_EARLY 1
#endif
#ifndef GATHER_PACE
#define GATHER_PACE 0
#endif
#define XB_PACE(j) (XCD_BAR_WORDS + 64 * (j))
constexpr int GS = 6, GSLOT = 2 * PROW;
__device__ __forceinline__ void glds16(const void* gsrc, unsigned lds_dst) { unsigned keep;
  asm volatile("s_mov_b32 %0, m0\n\ts_mov_b32 m0, %2\n\ts_nop 0\n\tglobal_load_lds_dwordx4 %1, off\n\ts_mov_b32 m0, %0" : "=&s"(keep) : "v"(gsrc), "s"(lds_dst) : "memory"); }
template <int GMODE = 0>
__device__ __forceinline__ void gather_phase(CP P, int L, int Mrows, LAS unsigned char* lds, int wid, int lane_, int gw, int NGW, bool dry = false) {
    const unsigned char* UV = P->ws + WS_PU + (size_t)L * 16384 * PREC;
    const unsigned* ROUTE = (const unsigned*)(P->ws + WS_ROUTE); const float* MOD = (const float*)(P->ws + WS_MOD);
    bf16* X = (bf16*)(P->ws + WS_X); bf16* H = (bf16*)(P->ws + WS_H); bf16* Xo = dry ? (bf16*)(P->ws + WS_Y) : X; bf16* Ho = dry ? (bf16*)(P->ws + WS_G) : H;
    const float* lng = P->in[6] + (size_t)(L * 2 + 1) * DM; const float* lnb = P->in[7] + (size_t)(L * 2 + 1) * DM;
    const unsigned ring = (unsigned)(uintptr_t)lds + (unsigned)wid * (GS * GSLOT);
    const int nfull = (Mrows / NGW) * NGW, rem = Mrows - nfull; const bool can_coop = (rem * 4 == NGW);
    const int nround = nfull / NGW + (rem > 0 ? 1 : 0);
    const bool pace_ok = (rem == 0) || can_coop;
#define G_ROWOF(it_) ((can_coop && (it_) == nround - 1) ? (nfull + (int)blockIdx.x * 2 + (wid >> 2)) : (gw + (it_) * NGW))
    u32x2 nea = {0u, 0u}, neb = {0u, 0u}; u32x4 nh0 = {0u, 0u, 0u, 0u}, nh1 = nh0, nh2 = nh0, nh3 = nh0;
#define G_PREFETCH(rowN_, ln_) do { const int rn_ = (rowN_); nea = ((const u32x2*)(ROUTE + (size_t)rn_ * 256))[ln_]; neb = ((const u32x2*)(ROUTE + (size_t)rn_ * 256))[64 + (ln_)]; \
        const u32x4* hp_ = (const u32x4*)(H + (size_t)rn_ * DM) + 4 * (ln_); nh0 = hp_[0]; nh1 = hp_[1]; nh2 = hp_[2]; nh3 = hp_[3]; } while (0)
    if (nround > 0 && G_ROWOF(0) < Mrows) G_PREFETCH(G_ROWOF(0), launder_v(lane_));
#if GATHER_VECREG
    LAS unsigned* LNV = (LAS unsigned*)(lds + NWAVES * GS * GSLOT);
    for (int i = wid * 64 + lane_; i < 2048; i += NWAVES * 64) { const float* s_ = (i >> 10) ? lnb : lng; const int pr = i & 1023; LNV[i] = cvtpk(s_[2 * pr], s_[2 * pr + 1]); }
    __syncthreads();
    unsigned mg[16], ms[16], mc[16]; int cur_slot = -1;
#pragma unroll
    for (int i = 0; i < 16; ++i) { mg[i] = 0u; ms[i] = 0u; mc[i] = 0u; }
#endif
    bool pre = false;
#pragma unroll 1
    for (int it = 0; it < nround; ++it) {
#if GATHER_PACE
        if (pace_ok && it > 0) {
            if (wid == 0 && lane_ == 0) { const unsigned nloc = ((volatile LAS unsigned*)(lds + MISC_OFF))[8];
                if (nloc != 0u) { unsigned* pc = (unsigned*)(P->ws + WS_CTL) + CW_BAR + XB_PACE(xb_xcc_id());
                    const unsigned old = xb_add(pc, 1u), tgt = (old / nloc + 1u) * nloc; unsigned sp = 0u;
                    while ((int)(xb_ld(pc) - tgt) < 0 && ++sp < 20000u) __builtin_amdgcn_s_sleep(1); } }
            __syncthreads();
        }
#endif
        const bool coop = can_coop && (it == nround - 1);
        int row = G_ROWOF(it), k0 = 0, kn = 128;
        if (coop) { k0 = (wid & 3) * 32; kn = k0 + 32; }
        else if (row >= Mrows) break;
        const int lane = launder_v(lane_);
        const u32x2 ea = nea, eb = neb;
        unsigned eax, eay, ebx, eby;
        unsigned hw[16] = {nh0.x, nh0.y, nh0.z, nh0.w, nh1.x, nh1.y, nh1.z, nh1.w, nh2.x, nh2.y, nh2.z, nh2.w, nh3.x, nh3.y, nh3.z, nh3.w};
        float y[32];
#pragma unroll
        for (int i = 0; i < 32; ++i) y[i] = 0.f;
        { unsigned e0 = ea.x, e1 = ea.y, e2 = eb.x, e3 = eb.y;
          asm volatile("" : "+v"(e0), "+v"(e1), "+v"(e2), "+v"(e3), "+v"(hw[0]), "+v"(hw[1]), "+v"(hw[2]), "+v"(hw[3]), "+v"(hw[4]), "+v"(hw[5]), "+v"(hw[6]), "+v"(hw[7]),
                       "+v"(hw[8]), "+v"(hw[9]), "+v"(hw[10]), "+v"(hw[11]), "+v"(hw[12]), "+v"(hw[13]), "+v"(hw[14]), "+v"(hw[15]) :: "memory");
          eax = e0; eay = e1; ebx = e2; eby = e3; }
        const unsigned rd_a = ring + 16u * (unsigned)lane, rd_b = ring + 2048u + 8u * (unsigned)lane;
        const bool rev = GATHER_ZIGZAG && ((it & 1) != 0);
        const int kflip = rev ? (k0 + kn - 1) : 0, ksign = rev ? -1 : 1;
#define G_ISSUE(k) do { const int k_ = (k), ke_ = kflip + ksign * k_; const unsigned e_ = (unsigned)__builtin_amdgcn_readlane((int)(ke_ < 64 ? eax : ebx), ke_ & 63); \
        const unsigned char* rp_ = UV + (size_t)e_ * PREC + 16 * lane; const unsigned sb_ = ring + (unsigned)(k_ % GS) * GSLOT; \
        if (GMODE == 3) { glds16(rp_, sb_); if (lane < 32) glds16(rp_ + 2048, sb_ + 2048); } \
        else if (GMODE != 2) { glds16(rp_, sb_); glds16(rp_ + 1024, sb_ + 1024); glds16(rp_ + 2048, sb_ + 2048); } else { asm volatile("" :: "v"(rp_), "s"(sb_)); } } while (0)
#if GATHER_EARLY
        if (it + 1 < nround && G_ROWOF(it + 1) < Mrows) G_PREFETCH(G_ROWOF(it + 1), lane);
        if (!pre) {
#pragma unroll
            for (int k = 0; k < 6; ++k) G_ISSUE(k0 + k); }
#else
#pragma unroll
        for (int k = 0; k < 4; ++k) G_ISSUE(k0 + k);
        if (it + 1 < nround && G_ROWOF(it + 1) < Mrows) G_PREFETCH(G_ROWOF(it + 1), lane);
#endif
#define G_READ(k, ua, ub, va, vb) do { const unsigned so_ = (unsigned)((k) % GS) * GSLOT; \
        asm volatile("ds_read_b128 %0, %4\n\tds_read_b64 %1, %5\n\tds_read_b128 %2, %4 offset:1024\n\tds_read_b64 %3, %5 offset:512" \
                     : "=&v"(ua), "=&v"(ub), "=&v"(va), "=&v"(vb) : "v"(rd_a + so_), "v"(rd_b + so_) : "memory"); } while (0)
#pragma unroll 1
        for (int k = k0; k < kn; k += 2) {
            if (k + 4 < kn) { if (!GATHER_EARLY) { G_ISSUE(k + 4); G_ISSUE(k + 5); } if (GMODE == 3) asm volatile("s_waitcnt vmcnt(8)" ::: "memory"); else asm volatile("s_waitcnt vmcnt(12)" ::: "memory"); }
            else if (k == kn - 4) { if (GMODE == 3) asm volatile("s_waitcnt vmcnt(4)" ::: "memory"); else asm volatile("s_waitcnt vmcnt(6)" ::: "memory"); }
            else asm volatile("s_waitcnt vmcnt(0)" ::: "memory");
            u32x4 uaA, vaA, uaB, vaB; u32x2 ubA, vbA, ubB, vbB;
            G_READ(k, uaA, ubA, vaA, vbA); G_READ(k + 1, uaB, ubB, vaB, vbB);
            asm volatile("s_waitcnt lgkmcnt(0)" : "+v"(uaA), "+v"(ubA), "+v"(vaA), "+v"(vbA), "+v"(uaB), "+v"(ubB), "+v"(vaB), "+v"(vbB) :: "memory");
            if (GATHER_EARLY && k + 6 < kn) { G_ISSUE(k + 6); G_ISSUE(k + 7); }
            if (GMODE == 1 || GMODE == 3) continue;
            const u32x6 u6A = {uaA.x, uaA.y, uaA.z, uaA.w, ubA.x, ubA.y}, u6B = {uaB.x, uaB.y, uaB.z, uaB.w, ubB.x, ubB.y};
            const u32x16 ubfA = __builtin_bit_cast(u32x16, __builtin_amdgcn_cvt_scalef32_pk32_bf16_fp6(u6A, 1.0f));
            const u32x16 ubfB = __builtin_bit_cast(u32x16, __builtin_amdgcn_cvt_scalef32_pk32_bf16_fp6(u6B, 1.0f));
#if GATHER_MFMADOT
            f32x4 dgA = {0.f, 0.f, 0.f, 0.f}, dgB = {0.f, 0.f, 0.f, 0.f};
#pragma unroll
            for (int q = 0; q < 16; q += 2) { const u32x2 hq_ = {hw[q], hw[q + 1]}, xa_ = {ubfA[q], ubfA[q + 1]}, xb_ = {ubfB[q], ubfB[q + 1]};
                dgA = __builtin_amdgcn_mfma_f32_4x4x4bf16_1k(__builtin_bit_cast(s16x4_t, xa_), __builtin_bit_cast(s16x4_t, hq_), dgA, 0, 0, 0);
                dgB = __builtin_amdgcn_mfma_f32_4x4x4bf16_1k(__builtin_bit_cast(s16x4_t, xb_), __builtin_bit_cast(s16x4_t, hq_), dgB, 0, 0, 0); }
            float a0, a1 = 0.f, b0, b1 = 0.f;
            { const float x0 = dgA[0], x1 = dgA[1], x2 = dgA[2], x3 = dgA[3], y0 = dgB[0], y1 = dgB[1], y2 = dgB[2], y3 = dgB[3];
              a0 = DPP_F(x0, 0x00); a0 += DPP_F(x1, 0x55); a0 += DPP_F(x2, 0xAA); a0 += DPP_F(x3, 0xFF);
              b0 = DPP_F(y0, 0x00); b0 += DPP_F(y1, 0x55); b0 += DPP_F(y2, 0xAA); b0 += DPP_F(y3, 0xFF); }
#else
            float a0 = 0.f, a1 = 0.f, b0 = 0.f, b1 = 0.f;
#pragma unroll
            for (int q = 0; q < 16; q += 2) { const unsigned h0_ = hw[q], h1_ = hw[q + 1], x0_ = ubfA[q], x1_ = ubfA[q + 1], z0_ = ubfB[q], z1_ = ubfB[q + 1];
                a0 = __builtin_amdgcn_fdot2_f32_bf16(__builtin_bit_cast(bf16x2_t, h0_), __builtin_bit_cast(bf16x2_t, x0_), a0, false);
                a1 = __builtin_amdgcn_fdot2_f32_bf16(__builtin_bit_cast(bf16x2_t, h1_), __builtin_bit_cast(bf16x2_t, x1_), a1, false);
                b0 = __builtin_amdgcn_fdot2_f32_bf16(__builtin_bit_cast(bf16x2_t, h0_), __builtin_bit_cast(bf16x2_t, z0_), b0, false);
                b1 = __builtin_amdgcn_fdot2_f32_bf16(__builtin_bit_cast(bf16x2_t, h1_), __builtin_bit_cast(bf16x2_t, z1_), b1, false); }
#endif
            const int keA = kflip + ksign * k, keB = keA + ksign;
            const unsigned gsel = keA < 64 ? eay : eby;
#if GATHER_PAIRRED
            float wA, wB;
            { const auto sw = __builtin_amdgcn_permlane32_swap(__float_as_uint(GATHER_MFMADOT ? a0 : a0 + a1), __float_as_uint(GATHER_MFMADOT ? b0 : b0 + b1), false, false);
#if GATHER_MFMADOT
              float c2 = __uint_as_float(sw[0]) + __uint_as_float(sw[1]); c2 += DPP_F(c2, 0x141); c2 += DPP_F(c2, 0x140);
              const float d2 = sum_xor16(c2) * (1.0f / U_SCALE);
#else
              const float d2 = half_sum32(__uint_as_float(sw[0]) + __uint_as_float(sw[1])) * (1.0f / U_SCALE);
#endif
              const float g2 = gelu_tanh(d2) * (1.0f / V_SCALE);
              const float gA = __uint_as_float((unsigned)__builtin_amdgcn_readlane((int)__float_as_uint(g2), 0)), gB = __uint_as_float((unsigned)__builtin_amdgcn_readlane((int)__float_as_uint(g2), 32));
              wA = __uint_as_float((unsigned)__builtin_amdgcn_readlane((int)gsel, keA & 63)) * gA; wB = __uint_as_float((unsigned)__builtin_amdgcn_readlane((int)gsel, keB & 63)) * gB; }
#else
            const float dA = wave_sum(a0 + a1) * (1.0f / U_SCALE), dB = wave_sum(b0 + b1) * (1.0f / U_SCALE);
            const float wA = __uint_as_float((unsigned)__builtin_amdgcn_readlane((int)gsel, keA & 63)) * gelu_tanh(dA) * (1.0f / V_SCALE);
            const float wB = __uint_as_float((unsigned)__builtin_amdgcn_readlane((int)gsel, keB & 63)) * gelu_tanh(dB) * (1.0f / V_SCALE);
#endif
            const u32x6 v6A = {vaA.x, vaA.y, vaA.z, vaA.w, vbA.x, vbA.y};
            const f32x32 vfA = __builtin_amdgcn_cvt_scalef32_pk32_f32_fp6(v6A, 1.0f);
#pragma unroll
            for (int i = 0; i < 32; ++i) y[i] += wA * vfA[i];
            const u32x6 v6B = {vaB.x, vaB.y, vaB.z, vaB.w, vbB.x, vbB.y};
            const f32x32 vfB = __builtin_amdgcn_cvt_scalef32_pk32_f32_fp6(v6B, 1.0f);
#pragma unroll
            for (int i = 0; i < 32; ++i) y[i] += wB * vfB[i];
        }
#if GATHER_PRE
        pre = (it + 1 < nround) && (G_ROWOF(it + 1) < Mrows);
        if (pre) { unsigned n0 = nea.x, n2 = neb.x; asm volatile("" : "+v"(n0), "+v"(n2) :: "memory"); eax = n0; ebx = n2;
            const int k0n = (can_coop && (it + 1 == nround - 1)) ? (wid & 3) * 32 : 0;
#pragma unroll
            for (int k = 0; k < 6; ++k) G_ISSUE(k0n + k); }
#endif
#undef G_READ
#undef G_ISSUE
        if (coop) {
            LAS f32x4* mine = (LAS f32x4*)(lds + wid * (GS * GSLOT)) + lane * 8;
#pragma unroll
            for (int i = 0; i < 8; ++i) mine[i] = (f32x4){y[4 * i], y[4 * i + 1], y[4 * i + 2], y[4 * i + 3]};
            __syncthreads();
            if ((wid & 3) == 0) {
#pragma unroll
                for (int j = 1; j < 4; ++j) { const LAS f32x4* oth = (const LAS f32x4*)(lds + (wid + j) * (GS * GSLOT)) + lane * 8;
#pragma unroll
                    for (int i = 0; i < 8; ++i) { const f32x4 t = oth[i]; y[4 * i] += t.x; y[4 * i + 1] += t.y; y[4 * i + 2] += t.z; y[4 * i + 3] += t.w; } }
            }
            __syncthreads();
            if ((wid & 3) != 0) continue;
        }
        const int slot = row_slot(row);
        const float* mod = MOD + (size_t)(L * 3 + slot) * 12288;
        const int le = launder_v(lane);
#if GATHER_VECREG
        if (slot != cur_slot) { cur_slot = slot; float t_[32];
            load_row_f32_b(mod + 5 * 2048, le, t_);
#pragma unroll
            for (int i = 0; i < 16; ++i) mg[i] = cvtpk(t_[2 * i], t_[2 * i + 1]);
            if (L < NLAYER - 1) { const float* modn = MOD + (size_t)((L + 1) * 3 + slot) * 12288;
                load_row_f32_b(modn, le, t_);
#pragma unroll
                for (int i = 0; i < 16; ++i) ms[i] = cvtpk(t_[2 * i], t_[2 * i + 1]);
                load_row_f32_b(modn + 2048, le, t_);
#pragma unroll
                for (int i = 0; i < 16; ++i) mc[i] = cvtpk(t_[2 * i], t_[2 * i + 1]); } }
        { float xx[32]; load_row_bf16_b(X + (size_t)row * DM, le, xx);
#pragma unroll
          for (int i = 0; i < 16; ++i) { y[2 * i] = ALPHA * xx[2 * i] + bflo(mg[i]) * y[2 * i]; y[2 * i + 1] = ALPHA * xx[2 * i + 1] + bfhi(mg[i]) * y[2 * i + 1]; } }
        { float mean, rstd; ln_stats(y, mean, rstd);
          const LAS u32x4* gp = (const LAS u32x4*)(LNV + le * 16); const LAS u32x4* bp = (const LAS u32x4*)(LNV + 1024 + le * 16);
#pragma unroll
          for (int q = 0; q < 4; ++q) { const u32x4 g4 = gp[q], b4 = bp[q]; const unsigned gw_[4] = {g4.x, g4.y, g4.z, g4.w}, bw_[4] = {b4.x, b4.y, b4.z, b4.w};
#pragma unroll
              for (int j = 0; j < 4; ++j) { const int i = 8 * q + 2 * j; y[i] = (y[i] - mean) * rstd * bflo(gw_[j]) + bflo(bw_[j]); y[i + 1] = (y[i + 1] - mean) * rstd * bfhi(gw_[j]) + bfhi(bw_[j]); } }
          if (L < NLAYER - 1) { store_row_bf16_b(Xo + (size_t)row * DM, le, y);
              ln_stats(y, mean, rstd); float a_[32];
#pragma unroll
              for (int i = 0; i < 16; ++i) { a_[2 * i] = (y[2 * i] - mean) * rstd * (1.0f + bflo(mc[i])) + bflo(ms[i]); a_[2 * i + 1] = (y[2 * i + 1] - mean) * rstd * (1.0f + bfhi(mc[i])) + bfhi(ms[i]); }
              store_row_bf16_b(Ho + (size_t)row * DM, le, a_); }
          else store_row_f32_b(P->out + (size_t)row * DM, le, y); }
        asm volatile("s_waitcnt vmcnt(0)" ::: "memory");
        continue;
#endif
        { float xx[32], gg[32]; load_row_bf16_b(X + (size_t)row * DM, le, xx); load_row_f32_b(mod + 5 * 2048, le, gg);
#pragma unroll
          for (int i = 0; i < 32; ++i) y[i] = ALPHA * xx[i] + gg[i] * y[i]; }
        if (L < NLAYER - 1) { const float* modn = MOD + (size_t)((L + 1) * 3 + slot) * 12288;
            finish_row<true>(y, lng, lnb, Xo + (size_t)row * DM, modn, modn + 2048, Ho + (size_t)row * DM, nullptr, le); }
        else finish_row<true>(y, lng, lnb, nullptr, nullptr, nullptr, nullptr, P->out + (size_t)row * DM, le);
        asm volatile("s_waitcnt vmcnt(0)" ::: "memory");
    }
#undef G_PREFETCH
#undef G_ROWOF
}

#ifndef ROPE_TEST
#define ROPE_TEST 0
#endif
#ifndef PROBE_DUP
#define PROBE_DUP 0
#endif
#define NOINL __forceinline__
__device__ __forceinline__ CP launder_cp(CP p) { asm volatile("" : "+s"(p)); return p; }
#define GETP() launder_cp((CP)__builtin_amdgcn_kernarg_segment_ptr())
__device__ __forceinline__ int uni(int v) { return __builtin_amdgcn_readfirstlane(v); }
__device__ __forceinline__ LAS unsigned char* uni_lds(LAS unsigned char* p) { return (LAS unsigned char*)(unsigned)__builtin_amdgcn_readfirstlane((int)(unsigned)(uintptr_t)p); }
#define PH_IDS const int wid = uni(wv_), lane = launder_v(lane_id_fresh()) & 63, tid = (wid & 7) * 64 + lane; const int gw = blockIdx.x * NWAVES + wid, NGW = gridDim.x * NWAVES; (void)lane; (void)gw; (void)NGW; (void)tid;

__device__ NOINL void ph_prologue(int wv_, LAS unsigned char* lds_) { CP P = GETP(); LAS unsigned char* lds = uni_lds(lds_); PH_IDS p0_prologue(P, lds, tid, lane, wid, gw, NGW); if (PROBE_DUP == 5) p0_prologue(P, lds, tid, lane, wid, gw, NGW);
    if (PROBE_DUP >= 21 && PROBE_DUP <= 23) { __syncthreads(); p0_prologue(P, lds, tid, lane, wid, gw, NGW, 1 << (PROBE_DUP - 21 < 0 ? 0 : (PROBE_DUP - 21) & 3)); } }
__device__ NOINL void ph_modreduce(int wv_) { CP P = GETP(); PH_IDS mod_reduce(P, gw, lane, NGW); }
__device__ NOINL void ph_first(int wv_) { CP P = GETP(); PH_IDS
#pragma unroll 1
    for (int rep = 0; rep < (PROBE_DUP == 6 ? 2 : 1); ++rep) first_row_pass(P, lane, gw, NGW); }
__device__ NOINL void ph_postmix(int wv_, LAS unsigned char* lds_, int L_, int M_) { CP P = GETP(); LAS unsigned char* lds = uni_lds(lds_); const int L = uni(L_), Mrows = uni(M_); PH_IDS
    if (POSTMIX_LDS) post_mixer_pass_lds(P, L, Mrows, lds, tid, lane, gw, NGW); else post_mixer_pass(P, L, Mrows, lane, gw, NGW); }
__device__ NOINL void ph_vstats(int wv_, int M_) { CP P = GETP(); const int Mrows = uni(M_); PH_IDS
#pragma unroll 1
    for (int rep = 0; rep < (PROBE_DUP == 6 ? 2 : 1); ++rep) vstats_pass(P, Mrows, lane, gw, NGW); }
__device__ NOINL void ph_spatial(int wv_, LAS unsigned char* lds_, int j_, int M_) { CP P = GETP(); LAS unsigned char* lds = uni_lds(lds_); const int j = uni(j_), Mrows = uni(M_); PH_IDS
#pragma unroll 1
    for (int rep = 0; rep < ((PROBE_DUP == 6 || PROBE_DUP == 19) ? 2 : 1); ++rep) spatial_phase(P, j, Mrows, lds, tid, lane, wid); }
__device__ NOINL void ph_mla_norm(int wv_) { CP P = GETP(); PH_IDS
#pragma unroll 1
    for (int rep = 0; rep < (PROBE_DUP == 6 ? 2 : 1); ++rep) mla_norm_pass(P, lane, gw, NGW); }
__device__ NOINL void ph_rope(int wv_, int which_) { CP P = GETP(); const int which = uni(which_); PH_IDS
    if (which == 0) rope_pass((bf16*)(P->ws + WS_QM), 3072, 128, 16, 192, lane, gw, NGW);
    else rope_pass((bf16*)(P->ws + WS_Z), 6144, 0, 64, 64, lane, gw, NGW); }
__device__ NOINL void ph_attn_mla(int wv_, LAS unsigned char* lds_) { CP P = GETP(); LAS unsigned char* lds = uni_lds(lds_); PH_IDS mla_attn_phase(P, lds, tid); if (PROBE_DUP == 2 || PROBE_DUP == 9) mla_attn_phase(P, lds, tid); }
__device__ NOINL void ph_attn_da(int wv_, LAS unsigned char* lds_, int L_, bool ctx_q) { CP P = GETP(); LAS unsigned char* lds = uni_lds(lds_); const int L = uni(L_); PH_IDS
    const float* lp = P->in[26];
    const float s01 = wave_sum(lp[lane] * lp[64 + lane]), s23 = wave_sum(lp[128 + lane] * lp[192 + lane]);
    const float lam_init = 0.8f - 0.6f * expf(-0.3f * (float)L);
    const float lam = expf(s01) - expf(s23) + lam_init;
    if (!(PROBE_DUP >= 11 && PROBE_DUP <= 15)) da_attn_phase(P, lam, 1.0f - lam_init, lds, tid, ctx_q);
    if (PROBE_DUP == 2 || PROBE_DUP == 10) da_attn_phase(P, lam, 1.0f - lam_init, lds, tid, ctx_q);
    if (PROBE_DUP >= 11 && PROBE_DUP <= 15) { da_attn_phase<PROBE_DUP >= 11 && PROBE_DUP <= 15 ? PROBE_DUP - 10 : 0>(P, lam, 1.0f - lam_init, lds, tid, ctx_q); __syncthreads(); }
    if (PROBE_DUP >= 11 && PROBE_DUP <= 15) da_attn_phase(P, lam, 1.0f - lam_init, lds, tid, ctx_q); }
__device__ NOINL void ph_route(int wv_, LAS unsigned char* lds_, int L_, int M_) { CP P = GETP(); LAS unsigned char* lds = uni_lds(lds_); const int L = uni(L_), Mrows = uni(M_); PH_IDS
#pragma unroll 1
    for (int rep = 0; rep < (PROBE_DUP == 4 ? 2 : 1); ++rep) route_phase(P, L, Mrows, lds, tid, lane, wid, gw, NGW); }
__device__ NOINL void ph_gather(int wv_, LAS unsigned char* lds_, int L_, int M_) { CP P = GETP(); LAS unsigned char* lds = uni_lds(lds_); const int L = uni(L_), Mrows = uni(M_); PH_IDS
    if (PROBE_DUP == 3) { gather_phase<0>(P, L, Mrows, lds, wid, lane, gw, NGW, true); }
    if (PROBE_DUP == 7) { gather_phase<1>(P, L, Mrows, lds, wid, lane, gw, NGW, true); }
    if (PROBE_DUP == 17) { gather_phase<3>(P, L, Mrows, lds, wid, lane, gw, NGW, true); }
    if (PROBE_DUP == 8) { gather_phase<2>(P, L, Mrows, lds, wid, lane, gw, NGW, true); }
    gather_phase<0>(P, L, Mrows, lds, wid, lane, gw, NGW); }

enum GemmId { G_GM_IN = 0, G_GM_OUT, G_MLA_IN, G_MLA_UQ, G_MLA_UKV, G_MLA_OUT, G_DA_IN, G_DA_OUT, G_PEER_Q };
__device__ NOINL void ph_gemm(int wv_, LAS unsigned char* lds_, int id_, int L_, int M_) {
    CP P = GETP(); LAS unsigned char* lds = uni_lds(lds_); const int id = uni(id_), L = uni(L_), Mrows = uni(M_); PH_IDS
    unsigned char* ws = P->ws; const int jj = L / 3;
    size_t a = WS_H, b = 0, o = 0; int M = MT, N = 2048, K = 2048, act = 0, rope = 0;
    switch (id) {
        case G_GM_IN:   a = WS_H;    b = WS_GMWIN + (size_t)jj * 4096 * 2048 * 2;  o = WS_Z;  M = Mrows; N = 4096; K = 2048; act = 1; break;
        case G_GM_OUT:  a = WS_G;    b = WS_GMWOUT + (size_t)jj * 2048 * 2048 * 2; o = WS_Y;  M = Mrows; N = 2048; K = 2048; break;
        case G_MLA_IN:  a = WS_H;    b = WS_MLAIN;  o = WS_C;  N = 1280; K = 2048; break;
        case G_MLA_UQ:  a = WS_CQN;  b = WS_MLAUQ;  o = WS_QM; N = 3072; K = 512;  rope = (ROPE_TEST == 2) ? 0 : 2; break;
        case G_MLA_UKV: a = WS_CKVN; b = WS_MLAUKV; o = WS_KV; N = 4096; K = 512;  break;
        case G_MLA_OUT: a = WS_G;    b = WS_MLAOUT; o = WS_Y;  N = 2048; K = 2048; break;
        case G_DA_IN:   a = WS_H;    b = WS_DAIN;   o = WS_Z;  N = 6144; K = 2048; rope = (ROPE_TEST == 1) ? 0 : 1; break;
        case G_DA_OUT:  a = WS_G;    b = WS_DAOUT;  o = WS_Y;  M = Mrows; N = 2048; K = 2048; break;
        default:        a = WS_H;    b = WS_PWQ + (size_t)L * 2048 * 2048 * 2;     o = WS_QP; M = Mrows; N = 2048; K = 2048; break;
    }
    pg8::Gemm g{(const pg8::bf16_t*)(ws + a), (const pg8::bf16_t*)(ws + b), M, N, K}; pg8::StaticOrder S; S.init(M, N, (int)gridDim.x, (int)blockIdx.x);
    pg8::EpiR E{(pg8::bf16_t*)(ws + o), N, act, rope, (const float*)(ws + WS_ROPE)};
#pragma unroll 1
    for (int rep = 0; rep < (PROBE_DUP == 1 ? 2 : 1); ++rep) { pg8::gemm_phase<pg8::EpiR, pg8::StaticOrder, true, true>((PG8_LAS unsigned char*)lds, g, S, E, tid); __syncthreads(); }
#if TAIL_REMAP
    int TL = -1; bool tail_u = false;
    if (L == 0) { if (id == G_GM_IN) { TL = 0; tail_u = true; } else if (id == G_GM_OUT) { TL = 0; } else if (id == G_PEER_Q) { TL = 1; tail_u = true; } }
    else if (L == 1) { if (id == G_MLA_IN) { TL = 1; } else if (id == G_MLA_OUT) { TL = 2; tail_u = true; } else if (id == G_PEER_Q) { TL = 2; } }
    else if (L == 2) { if (id == G_DA_IN) { TL = 3; tail_u = true; } else if (id == G_DA_OUT) { TL = 3; } }
    if (TL >= 0) {
        const int units = (M / 256) * (N / 256), G = (int)gridDim.x, tail = units % G, c = (int)blockIdx.x;
        const float* src = (tail_u ? P->in[11] : P->in[12]) + (size_t)TL * 16384 * 2048; unsigned char* dst = ws + WS_PU + (size_t)TL * 16384 * PREC;
#else
    const bool tail_u = (id == G_GM_OUT || id == G_MLA_OUT || id == G_DA_OUT), tail_v = (id == G_PEER_Q);
    if ((tail_u || tail_v) && L + 1 < NLAYER) {
        const int units = (M / 256) * (N / 256), G = (int)gridDim.x, tail = units % G, c = (int)blockIdx.x;
        const float* src = (tail_u ? P->in[11] : P->in[12]) + (size_t)(L + 1) * 16384 * 2048; unsigned char* dst = ws + WS_PU + (size_t)(L + 1) * 16384 * PREC;
#endif
        LAS float* scr = (LAS float*)(lds + wid * 16384);
        if (tail != 0 && c >= tail) cvt_table_fp6(src, dst, 16384, tail_u ? U_SCALE : V_SCALE, scr, lane, (c - tail) * NWAVES + wid, (G - tail) * NWAVES, tail_u ? 0 : 1);
        else if (tail == 0) {
#pragma unroll 1
            for (int rep = 0; rep < (PROBE_DUP == 18 ? 3 : 1); ++rep) cvt_table_fp6(src, dst, 16384, tail_u ? U_SCALE : V_SCALE, scr, lane, gw, NGW, tail_u ? 0 : 1); }
    }
}

__global__ void __launch_bounds__(NWAVES * 64, 2) mk_fwd(Params Pv) {
    extern __shared__ __attribute__((aligned(16))) unsigned char lds_g[];
    LAS unsigned char* lds = (LAS unsigned char*)lds_g;
    const int wv = __builtin_amdgcn_readfirstlane((int)threadIdx.x >> 6);
    const int tid = wv * 64 + lane_id_fresh();
    for (int u = tid; u < (LDS_BYTES - RING_BYTES) / 4; u += NWAVES * 64) ((LAS unsigned*)(lds + RING_BYTES))[u] = 0u;
    __syncthreads();
    const int lo = Pv.ph_lo, hi = Pv.ph_hi;
    unsigned* barw = (unsigned*)(Pv.ws + WS_CTL) + CW_BAR;
    XcdBarrier bar; bar.bar = barw; bar.x = 0; bar.st = nullptr;
    if (hi - lo > 1) bar = xcd_barrier_post(barw, (volatile LAS unsigned*)(lds + MISC_OFF) + 8, tid == 0);
    int ph = 0;
#ifndef SEL
#define SELP(k) true
#else
#define SELP(k) ((k) == SEL)
#endif
    enum { RUN_BASE = __COUNTER__ + 1 };
#define RUN(call) do { if (SELP(__COUNTER__ - RUN_BASE) && ph >= lo && ph < hi) { call; } if (ph >= lo && ph + 1 < hi) xcd_barrier(bar, wv == 0 && lane_id_fresh() == 0); ++ph; } while (0)
    RUN(ph_prologue(wv, lds));
    RUN(ph_modreduce(wv));
    RUN(ph_first(wv));
#define LAYER(LL) do { constexpr int L = (LL); constexpr int kind = L % 3, jj = L / 3; constexpr int Mrows = (L == NLAYER - 1) ? ML : MT; \
        constexpr bool ctx_dead = (L == NLAYER - 2) && ((NLAYER - 1) % 3 == 0) && (kind != 0); constexpr int Mlive = ctx_dead ? ML : Mrows; \
        if (kind == 0) {                          \
            RUN(ph_gemm(wv, lds, G_GM_IN, L, Mrows)); \
            RUN(ph_vstats(wv, Mrows)); \
            RUN(ph_spatial(wv, lds, jj, Mrows)); \
            RUN(ph_gemm(wv, lds, G_GM_OUT, L, Mrows)); \
        } else if (kind == 1) {                   \
            RUN(ph_gemm(wv, lds, G_MLA_IN, L, Mrows)); \
            RUN(ph_mla_norm(wv)); \
            RUN(ph_gemm(wv, lds, G_MLA_UQ, L, Mrows); ph_gemm(wv, lds, G_MLA_UKV, L, Mrows)); \
            if (ROPE_TEST == 2) { RUN(ph_rope(wv, 0)); } \
            RUN(ph_attn_mla(wv, lds)); \
            RUN(ph_gemm(wv, lds, G_MLA_OUT, L, Mrows)); \
        } else {                                  \
            RUN(ph_gemm(wv, lds, G_DA_IN, L, Mrows); if (ROPE_TEST == 1) { __syncthreads(); } ); \
            if (ROPE_TEST == 1) { RUN(ph_rope(wv, 1)); } \
            RUN(ph_attn_da(wv, lds, L, !ctx_dead)); \
            RUN(ph_gemm(wv, lds, G_DA_OUT, L, Mlive)); \
        } \
        RUN(ph_postmix(wv, lds, L, Mlive));                \
        RUN(ph_gemm(wv, lds, G_PEER_Q, L, Mlive));    \
        RUN(ph_route(wv, lds, L, Mlive));             \
        RUN(ph_gather(wv, lds, L, Mlive));            \
    } while (0)
    LAYER(0); LAYER(1); LAYER(2); LAYER(3);
#undef LAYER
#undef RUN
}

extern "C" void kernel_launch(void* const* d_in, const int* in_sizes, int n_in, void* d_out, int out_size, void* d_ws, size_t ws_size, hipStream_t stream) {
    static int grid = 0;
    if (grid == 0) {
        if (n_in != 29 || in_sizes[0] != ML * DM || out_size != ML * DM || ws_size < WS_END) {
            fprintf(stderr, "kernel_launch: shape mismatch: n_in %d in0 %d out %d ws %zu (need %zu); nothing launched\n", n_in, n_in > 0 ? in_sizes[0] : -1, out_size, ws_size, (size_t)WS_END); grid = -1; return; }
        int dev = 0, cus = 0, per_cu = 0;
        if (hipGetDevice(&dev) != hipSuccess || hipDeviceGetAttribute(&cus, hipDeviceAttributeMultiprocessorCount, dev) != hipSuccess) { fprintf(stderr, "kernel_launch: device query failed\n"); grid = -1; return; }
        if (hipFuncSetAttribute((const void*)mk_fwd, hipFuncAttributeMaxDynamicSharedMemorySize, LDS_BYTES) != hipSuccess) { fprintf(stderr, "kernel_launch: hipFuncSetAttribute failed\n"); grid = -1; return; }
        if (hipOccupancyMaxActiveBlocksPerMultiprocessor(&per_cu, (const void*)mk_fwd, NWAVES * 64, LDS_BYTES) != hipSuccess || per_cu < 1)
            fprintf(stderr, "kernel_launch: note: occupancy query reports %d workgroups per CU\n", per_cu);
        (void)hipGetLastError();
        grid = cus;
    }
    if (grid < 0) return;
    if (hipMemsetAsync((char*)d_ws + WS_CTL, 0, CTL_ZERO_BYTES, stream) != hipSuccess) { fprintf(stderr, "kernel_launch: memset failed\n"); return; }
    Params p{};
    for (int i = 0; i < 29; ++i) p.in[i] = (const float*)d_in[i];
    p.out = (float*)d_out; p.ws = (unsigned char*)d_ws;
#if MK_ONE_LAUNCH
    p.ph_lo = 0; p.ph_hi = NPH;
    hipLaunchKernelGGL(mk_fwd, dim3(grid), dim3(NWAVES * 64), LDS_BYTES, stream, p);
#else
    for (int li = 0; li < NPH; ++li) { p.ph_lo = li; p.ph_hi = li + 1; hipLaunchKernelGGL(mk_fwd, dim3(grid), dim3(NWAVES * 64), LDS_BYTES, stream, p); }
#endif
    const hipError_t le = hipPeekAtLastError();
    if (le != hipSuccess) fprintf(stderr, "kernel_launch: launch failed: %s\n", hipGetErrorName(le));
}
```

```cpp
#include <hip/hip_runtime.h>
#include <cstdio>
#include <cstdint>
#ifndef MK_ONE_LAUNCH
#define MK_ONE_LAUNCH 1
#endif
__device__ __forceinline__ int launder_v(int v) { asm volatile("" : "+v"(v)); return v; }
__device__ __forceinline__ int lane_id_fresh() { unsigned m = ~0u; asm volatile("" : "+s"(m)); return (int)__builtin_amdgcn_mbcnt_hi(m, __builtin_amdgcn_mbcnt_lo(m, 0u)); }
namespace pg8 {
#define PG8_LAS __attribute__((address_space(3)))
typedef unsigned short bf16_t;
typedef short bf16x8 __attribute__((ext_vector_type(8)));
typedef float f32x4 __attribute__((ext_vector_type(4)));
typedef unsigned u32x4 __attribute__((ext_vector_type(4)));
constexpr int BM = 256, BK = 64, HALF = 128, HTB = HALF * BK * 2  , STAGE_BYTES = 8 * HTB, NXCD = 8, WGM = 8;

__host__ __device__ __forceinline__ int lds_byte(int r, int c) { const int st = (r >> 4) * 2 + (c >> 5), rr = r & 15, cc = c & 31, ob = rr * 64 + cc * 2; return st * 1024 + (ob ^ (((ob >> 9) & 1) << 5)); }
__host__ __device__ __forceinline__ void stage_rc(int b, int& R, int& C) { const int st = b / 1024, sb = b % 1024, swz = sb ^ (((sb >> 9) & 1) << 5); R = (st >> 1) * 16 + swz / 64; C = (st & 1) * 32 + (swz % 64) / 2; }
__host__ __device__ __forceinline__ int perm32(int rho) { const int n = rho >> 4, i = rho & 15; return 8 * (i >> 2) + 4 * n + (i & 3); }

struct Unit { int pm, pn; };
struct Gemm { const bf16_t* A; const bf16_t* Bt; int M, N, K; };

struct StaticOrder {
    int nM, nN, nwg, G, c;
    __host__ __device__ void init(int M, int N, int G_, int c_) { nM = M / BM; nN = N / BM; nwg = nM * nN; G = G_; c = c_; }
    __host__ __device__ bool next(int i, Unit& u) const {
        const long L = (long)i * G + c; if (L >= nwg) return false;
        int wgid = (int)L; { const int q = nwg / NXCD, r = nwg % NXCD, xcd = wgid % NXCD, off = wgid / NXCD; wgid = (xcd < r ? xcd * (q + 1) : r * (q + 1) + (xcd - r) * q) + off; }
        const int nig = WGM * nN, gid = wgid / nig, fm = gid * WGM, gsz = (nM - fm) < WGM ? (nM - fm) : WGM;
        u.pm = fm + ((wgid % nig) % gsz); u.pn = (wgid % nig) / gsz; return true;
    }
    __device__ __forceinline__ void a_ready(const Unit&) const {}
    __device__ __forceinline__ void done(const Unit&) const {}
};

__device__ __forceinline__ unsigned cvt_pk_bf16(float lo, float hi) { unsigned r; asm volatile("v_cvt_pk_bf16_f32 %0, %1, %2" : "=v"(r) : "v"(lo), "v"(hi)); return r; }
typedef float f32x2 __attribute__((ext_vector_type(2)));
__device__ __forceinline__ f32x2 gelu_pk(f32x2 v) {
    const f32x2 av = __builtin_elementwise_abs(v), d = av * 0.2316418882f + 1.0f;
    f32x2 t; t.x = __builtin_amdgcn_rcpf(d.x); t.y = __builtin_amdgcn_rcpf(d.y);
    f32x2 q = t * 0.5307027145f + (-0.7265760135f); q = q * t + 0.7107068705f; q = q * t + (-0.142248368f); q = q * t + 0.127414796f; q = q * t;
    const f32x2 s = (v * v) * (-0.72134752044f);
    f32x2 e; e.x = __builtin_amdgcn_exp2f(s.x); e.y = __builtin_amdgcn_exp2f(s.y);
    const f32x2 m = v * (q * e), r = v - m;
    f32x2 o; o.x = v.x < 0.f ? m.x : r.x; o.y = v.y < 0.f ? m.y : r.y; return o;
}

template <int ACT  > struct EpiBf16 {
    static constexpr bool PERM = true, AFTER_DRAIN = false; static_assert(ACT == 0 || ACT == 1, "EpiBf16: ACT is 0 (none) or 1 (gelu_pk)");
    bf16_t* O; int ldc; const float* bias; int split_cols; size_t split_stride; float scale0;
    __device__ __forceinline__ void operator()(const f32x4 (&acc)[2][2][4][2], const Unit& u, int wr, int wc, int fr, int fq) const {
        const int row0 = u.pm * BM + wr * 64 + fr; int colt = u.pn * BM; bf16_t* base = O;
        float sc = 1.f; if (split_cols) { const int t = colt / split_cols; base += (size_t)t * split_stride; colt -= t * split_cols; if (t == 0) sc = scale0; }
        const int col0 = colt + wc * 32 + 8 * fq, bcol0 = u.pn * BM + wc * 32 + 8 * fq;
        f32x4 bv[2][2];
#pragma unroll
        for (int bj = 0; bj < 2; ++bj)
#pragma unroll
            for (int n = 0; n < 2; ++n) bv[bj][n] = bias ? *(const f32x4*)(bias + bcol0 + bj * HALF + 4 * n) : (f32x4){0.f, 0.f, 0.f, 0.f};
#pragma unroll
        for (int ai = 0; ai < 2; ++ai)
#pragma unroll
            for (int m = 0; m < 4; ++m) { bf16_t* rowp = base + (size_t)(row0 + ai * HALF + m * 16) * ldc + col0;
#pragma unroll
                for (int bj = 0; bj < 2; ++bj) { f32x4 v0 = acc[ai][bj][m][0] + bv[bj][0], v1 = acc[ai][bj][m][1] + bv[bj][1];
                    if (ACT == 1) { f32x2 a = gelu_pk((f32x2){v0[0], v0[1]}), b = gelu_pk((f32x2){v0[2], v0[3]}), c = gelu_pk((f32x2){v1[0], v1[1]}), d = gelu_pk((f32x2){v1[2], v1[3]});
                        v0 = (f32x4){a.x, a.y, b.x, b.y}; v1 = (f32x4){c.x, c.y, d.x, d.y}; }
                    v0 = v0 * sc; v1 = v1 * sc; u32x4 w; w.x = cvt_pk_bf16(v0[0], v0[1]); w.y = cvt_pk_bf16(v0[2], v0[3]); w.z = cvt_pk_bf16(v1[0], v1[1]); w.w = cvt_pk_bf16(v1[2], v1[3]);
                    *(u32x4*)(rowp + bj * HALF) = w; } }
    }
};
template <class Epi, class Sched, bool ALIGN_EPI = false, bool SP2 = false>
__device__ __forceinline__ void gemm_phase(PG8_LAS unsigned char* lds, const Gemm g, const Sched& S, const Epi& E, const int tid_in) {
    const int tid = launder_v(tid_in) & 511, wid = __builtin_amdgcn_readfirstlane(tid >> 6), lane = tid & 63, wr = wid >> 2, wc = wid & 3, fr = lane & 15, fq = lane >> 4;
    const int K = g.K, nt = K / BK;
    unsigned voffA[2], voffB[2];
#pragma unroll
    for (int i = 0; i < 2; ++i) { int R, C; stage_rc(tid * 16 + i * 8192, R, C); const int Rb = Epi::PERM ? ((R & ~31) + perm32(R & 31)) : R;
        voffA[i] = (unsigned)(R * K + C) * 2u; voffB[i] = (unsigned)(Rb * K + C) * 2u; }
    const size_t kstep = (size_t)(BK * 2);
    const size_t hstep = (size_t)HALF * K * 2;
    const size_t tstep = 2 * hstep;
    const unsigned ldsw = (unsigned)wid * 1024u;
    const int aoff = lds_byte(wr * 64 + fr, fq * 8), boff = lds_byte(wc * 32 + fr, fq * 8);
#define PG8_SA(b, h) (((b) * 2 + (h)) * HTB)
#define PG8_SB(b, h) ((4 + (b) * 2 + (h)) * HTB)
#define PG8_STAGE(bufoff, gbase, voff) do { _Pragma("unroll") for (int _i = 0; _i < 2; ++_i) \
        __builtin_amdgcn_global_load_lds((const unsigned*)((const char*)(gbase) + (voff)[_i]), (PG8_LAS unsigned*)(lds + (bufoff) + ldsw + _i * 8192), 16, 0, 0); } while (0)
#define PG8_LDA(dst, b, h) do { _Pragma("unroll") for (int m = 0; m < 4; ++m) _Pragma("unroll") for (int k = 0; k < 2; ++k) dst[m][k] = *(const PG8_LAS bf16x8*)(lds + PG8_SA(b, h) + aoff + m * 2048 + k * 1024); } while (0)
#define PG8_LDB(dst, b, h) do { _Pragma("unroll") for (int n = 0; n < 2; ++n) _Pragma("unroll") for (int k = 0; k < 2; ++k) dst[n][k] = *(const PG8_LAS bf16x8*)(lds + PG8_SB(b, h) + boff + n * 2048 + k * 1024); } while (0)
#define PG8_MMA(ai, bj, At, Bt) do { __builtin_amdgcn_s_setprio(1); _Pragma("unroll") for (int m = 0; m < 4; ++m) _Pragma("unroll") for (int n = 0; n < 2; ++n) _Pragma("unroll") for (int k = 0; k < 2; ++k) \
        acc[ai][bj][m][n] = __builtin_amdgcn_mfma_f32_16x16x32_bf16(Bt[n][k], At[m][k], acc[ai][bj][m][n], 0, 0, 0); __builtin_amdgcn_s_setprio(0); } while (0)
#define PG8_WAIT_V(n) asm volatile("s_waitcnt vmcnt(" #n ")" ::: "memory")
#define PG8_WAIT_L(n) asm volatile("s_waitcnt lgkmcnt(" #n ")" ::: "memory")
#define PG8_BAR __builtin_amdgcn_s_barrier()
#define PG8_SCHED __builtin_amdgcn_sched_barrier(0)
    Unit cur, nxt; int ui = 0;
    if (!S.next(0, cur)) return;
    f32x4 acc[2][2][4][2];
#pragma unroll
    for (int a = 0; a < 2; ++a)
#pragma unroll
        for (int b = 0; b < 2; ++b)
#pragma unroll
            for (int m = 0; m < 4; ++m)
#pragma unroll
                for (int n = 0; n < 2; ++n) acc[a][b][m][n] = (f32x4){0.f, 0.f, 0.f, 0.f};
    bf16x8 At[4][2], B0[2][2], B1[2][2];
    const char* cA = (const char*)g.A + (size_t)cur.pm * tstep; const char* cB = (const char*)g.Bt + (size_t)cur.pn * tstep;
    S.a_ready(cur);
    if constexpr (SP2) {
        PG8_STAGE(PG8_SB(0, 0), cB, voffB); PG8_STAGE(PG8_SB(0, 1), cB + hstep, voffB); PG8_STAGE(PG8_SA(0, 0), cA, voffA); PG8_STAGE(PG8_SA(0, 1), cA + hstep, voffA);
        if (wr == 1) PG8_BAR;
        PG8_WAIT_V(2); PG8_BAR;
        PG8_STAGE(PG8_SB(1, 0), cB + kstep, voffB); PG8_STAGE(PG8_SA(1, 0), cA + kstep, voffA); PG8_STAGE(PG8_SB(1, 1), cB + hstep + kstep, voffB);
        PG8_WAIT_V(6); PG8_BAR;
    } else {
        PG8_STAGE(PG8_SB(0, 0), cB, voffB); PG8_STAGE(PG8_SA(0, 0), cA, voffA); PG8_STAGE(PG8_SB(0, 1), cB + hstep, voffB); PG8_STAGE(PG8_SA(0, 1), cA + hstep, voffA);
        if (wr == 1) PG8_BAR;
        PG8_WAIT_V(4); PG8_BAR;
        PG8_STAGE(PG8_SB(1, 0), cB + kstep, voffB); PG8_STAGE(PG8_SA(1, 0), cA + kstep, voffA); PG8_STAGE(PG8_SB(1, 1), cB + hstep + kstep, voffB);
        PG8_WAIT_V(6); PG8_BAR;
    }
    for (;;) {
        const bool has_next = S.next(ui + 1, nxt);
        const char* nA = has_next ? (const char*)g.A + (size_t)nxt.pm * tstep : cA; const char* nB = has_next ? (const char*)g.Bt + (size_t)nxt.pn * tstep : cB;
        for (int t = 0; t < nt; t += 2) {
            const bool last = (t == nt - 2);
            const char* a1 = cA + (size_t)(t + 1) * kstep;
            const char* a2 = last ? nA : cA + (size_t)(t + 2) * kstep; const char* b2 = last ? nB : cB + (size_t)(t + 2) * kstep;
            const char* a3 = a2 + kstep; const char* b3 = b2 + kstep;
            if (last && has_next) S.a_ready(nxt);
            if constexpr (SP2) {
            PG8_LDB(B0, 0, 0); PG8_LDB(B1, 0, 1); PG8_SCHED; PG8_LDA(At, 0, 0); PG8_STAGE(PG8_SA(1, 1), a1 + hstep, voffA);
            PG8_WAIT_V(8); PG8_WAIT_L(0); PG8_BAR; PG8_MMA(0, 0, At, B0); PG8_MMA(0, 1, At, B1); PG8_BAR; PG8_SCHED;
            PG8_LDA(At, 0, 1); PG8_STAGE(PG8_SB(0, 0), b2, voffB); PG8_STAGE(PG8_SB(0, 1), b2 + hstep, voffB); PG8_STAGE(PG8_SA(0, 0), a2, voffA);
            PG8_WAIT_V(8); PG8_WAIT_L(0); PG8_BAR; PG8_MMA(1, 0, At, B0); PG8_MMA(1, 1, At, B1); PG8_BAR; PG8_SCHED;
            PG8_LDB(B0, 1, 0); PG8_LDB(B1, 1, 1); PG8_SCHED; PG8_LDA(At, 1, 0); PG8_STAGE(PG8_SA(0, 1), a2 + hstep, voffA);
            PG8_WAIT_V(8); PG8_WAIT_L(0); PG8_BAR; PG8_MMA(0, 0, At, B0); PG8_MMA(0, 1, At, B1); PG8_BAR; PG8_SCHED;
            PG8_LDA(At, 1, 1); PG8_STAGE(PG8_SB(1, 0), b3, voffB); PG8_STAGE(PG8_SB(1, 1), b3 + hstep, voffB); PG8_STAGE(PG8_SA(1, 0), a3, voffA);
            PG8_WAIT_V(8); PG8_WAIT_L(0); PG8_BAR; PG8_MMA(1, 0, At, B0); PG8_MMA(1, 1, At, B1); PG8_BAR; PG8_SCHED;
            } else {
            PG8_LDB(B0, 0, 0); PG8_SCHED; PG8_LDA(At, 0, 0); PG8_STAGE(PG8_SA(1, 1), a1 + hstep, voffA);
            PG8_WAIT_L(8); PG8_BAR; PG8_WAIT_L(0); PG8_MMA(0, 0, At, B0); PG8_BAR; PG8_SCHED;
            PG8_LDB(B1, 0, 1); PG8_STAGE(PG8_SB(0, 0), b2, voffB);
            PG8_BAR; PG8_WAIT_L(0); PG8_MMA(0, 1, At, B1); PG8_BAR;
            PG8_LDA(At, 0, 1); PG8_STAGE(PG8_SA(0, 0), a2, voffA);
            PG8_BAR; PG8_WAIT_L(0); PG8_MMA(1, 0, At, B0); PG8_BAR; PG8_SCHED;
            PG8_STAGE(PG8_SB(0, 1), b2 + hstep, voffB);
            PG8_WAIT_V(6); PG8_BAR; PG8_MMA(1, 1, At, B1); PG8_BAR;
            PG8_LDB(B0, 1, 0); PG8_SCHED; PG8_LDA(At, 1, 0); PG8_STAGE(PG8_SA(0, 1), a2 + hstep, voffA);
            PG8_WAIT_L(8); PG8_BAR; PG8_WAIT_L(0); PG8_MMA(0, 0, At, B0); PG8_BAR; PG8_SCHED;
            PG8_LDB(B1, 1, 1); PG8_STAGE(PG8_SB(1, 0), b3, voffB);
            PG8_BAR; PG8_WAIT_L(0); PG8_MMA(0, 1, At, B1); PG8_BAR;
            PG8_LDA(At, 1, 1); PG8_STAGE(PG8_SA(1, 0), a3, voffA);
            PG8_BAR; PG8_WAIT_L(0); PG8_MMA(1, 0, At, B0); PG8_BAR; PG8_SCHED;
            PG8_STAGE(PG8_SB(1, 1), b3 + hstep, voffB);
            PG8_WAIT_V(6); PG8_BAR; PG8_MMA(1, 1, At, B1); PG8_BAR;
            }
        }
        if constexpr (ALIGN_EPI) { if (wr == 0) PG8_BAR; }
        if constexpr (!Epi::AFTER_DRAIN) { E(acc, cur, wr, wc, fr, fq); S.done(cur); }
        if (!has_next) break;
#pragma unroll
        for (int a = 0; a < 2; ++a)
#pragma unroll
            for (int b = 0; b < 2; ++b)
#pragma unroll
                for (int m = 0; m < 4; ++m)
#pragma unroll
                    for (int n = 0; n < 2; ++n) acc[a][b][m][n] = (f32x4){0.f, 0.f, 0.f, 0.f};
        cur = nxt; cA = nA; cB = nB; ++ui;
        if constexpr (ALIGN_EPI) { if (wr == 1) PG8_BAR; }
    }
    PG8_WAIT_V(0);
    if constexpr (!ALIGN_EPI) { if (wr == 0) PG8_BAR; }
    PG8_BAR;
    if constexpr (Epi::AFTER_DRAIN) { E.fused(acc, cur, wr, wc, fr, fq, lds, wid, lane); S.done(cur); }
#undef PG8_SA
#undef PG8_SB
#undef PG8_STAGE
#undef PG8_LDA
#undef PG8_LDB
#undef PG8_MMA
#undef PG8_WAIT_V
#undef PG8_WAIT_L
#undef PG8_BAR
#undef PG8_SCHED
}
}

namespace pg8 {
__device__ __forceinline__ float gelu_tanh(float x) {
    const float t = x * (1.5957691216057308f + 0.07135481627f * x * x);
    const float e = __builtin_amdgcn_exp2f(-1.4426950408889634f * t);
    return x * __builtin_amdgcn_rcpf(1.0f + e);
}
template <int ACT> struct EpiT {
    static constexpr bool PERM = true, AFTER_DRAIN = false;
    bf16_t* O; int ldc;
    __device__ __forceinline__ void operator()(const f32x4 (&acc)[2][2][4][2], const Unit& u, int wr, int wc, int fr, int fq) const {
        const int row0 = u.pm * BM + wr * 64 + fr; const int col0 = u.pn * BM + wc * 32 + 8 * fq;
#pragma unroll
        for (int ai = 0; ai < 2; ++ai)
#pragma unroll
            for (int m = 0; m < 4; ++m) { bf16_t* rowp = O + (size_t)(row0 + ai * HALF + m * 16) * ldc + col0;
#pragma unroll
                for (int bj = 0; bj < 2; ++bj) { f32x4 v0 = acc[ai][bj][m][0], v1 = acc[ai][bj][m][1];
                    if (ACT == 2) { v0 = (f32x4){gelu_tanh(v0[0]), gelu_tanh(v0[1]), gelu_tanh(v0[2]), gelu_tanh(v0[3])}; v1 = (f32x4){gelu_tanh(v1[0]), gelu_tanh(v1[1]), gelu_tanh(v1[2]), gelu_tanh(v1[3])}; }
                    u32x4 w; w.x = cvt_pk_bf16(v0[0], v0[1]); w.y = cvt_pk_bf16(v0[2], v0[3]); w.z = cvt_pk_bf16(v1[0], v1[1]); w.w = cvt_pk_bf16(v1[2], v1[3]);
                    *(u32x4*)(rowp + bj * HALF) = w; } }
    }
};
struct EpiR {
    static constexpr bool PERM = true, AFTER_DRAIN = false;
    bf16_t* O; int ldc; int act; int rope; const float* ropet;
    __device__ __forceinline__ void operator()(const f32x4 (&acc)[2][2][4][2], const Unit& u, int wr, int wc, int fr, int fq) const {
        const int row0 = u.pm * BM + wr * 64 + fr; const int col0 = u.pn * BM + wc * 32 + 8 * fq;
        const bool rrows = rope != 0 && u.pm < 64;
#pragma unroll
        for (int ai = 0; ai < 2; ++ai)
#pragma unroll
            for (int m = 0; m < 4; ++m) { const int grow = row0 + ai * HALF + m * 16; bf16_t* rowp = O + (size_t)grow * ldc + col0;
#pragma unroll
                for (int bj = 0; bj < 2; ++bj) { f32x4 v0 = acc[ai][bj][m][0], v1 = acc[ai][bj][m][1];
                    if (act) { v0 = (f32x4){gelu_tanh(v0[0]), gelu_tanh(v0[1]), gelu_tanh(v0[2]), gelu_tanh(v0[3])}; v1 = (f32x4){gelu_tanh(v1[0]), gelu_tanh(v1[1]), gelu_tanh(v1[2]), gelu_tanh(v1[3])}; }
                    if (rrows) { const int blk = u.pn * 8 + bj * 4 + wc; const int b6 = blk % 6; const bool on = rope == 1 ? (blk < 128) : (b6 >= 4); const int half = rope == 1 ? (blk & 1) : (b6 - 4);
                        if (on) { const int t = grow & 8191; const int pos = half ? (t & 63) : (t >> 6);
                            const float* cp = ropet + pos * 16 + 8 * (fq & 1); const f32x4 c0 = *(const f32x4*)cp, c1 = *(const f32x4*)(cp + 4), s0 = *(const f32x4*)(cp + 2048), s1 = *(const f32x4*)(cp + 2052);
                            f32x4 p0, p1;
#pragma unroll
                            for (int i = 0; i < 4; ++i) { const float a_ = v0[i], b_ = v1[i];
                                const auto r0 = __builtin_amdgcn_permlane32_swap(__float_as_uint(a_), __float_as_uint(a_), false, false);
                                const auto r1 = __builtin_amdgcn_permlane32_swap(__float_as_uint(b_), __float_as_uint(b_), false, false);
                                const unsigned x0_ = (fq & 2) ? r0[0] : r0[1], x1_ = (fq & 2) ? r1[0] : r1[1]; p0[i] = __uint_as_float(x0_); p1[i] = __uint_as_float(x1_); }
                            if (fq & 2) { v0 = p0 * s0 + v0 * c0; v1 = p1 * s1 + v1 * c1; } else { v0 = v0 * c0 - p0 * s0; v1 = v1 * c1 - p1 * s1; } } }
                    u32x4 w; w.x = cvt_pk_bf16(v0[0], v0[1]); w.y = cvt_pk_bf16(v0[2], v0[3]); w.z = cvt_pk_bf16(v1[0], v1[1]); w.w = cvt_pk_bf16(v1[2], v1[3]);
                    *(u32x4*)(rowp + bj * HALF) = w; } }
    }
};
}

constexpr int DM = 2048, NBATCH = 2, SEQ = 8192, CTXL = 256;
constexpr int ML = NBATCH * SEQ;
constexpr int MC = NBATCH * CTXL;
constexpr int MT = ML + MC;
constexpr int NLAYER = 4;
constexpr float ALPHA = 1.6817928305074290f, LN_EPS = 1e-6f;
constexpr int NWAVES = 8;
constexpr float U_SCALE = 64.0f, V_SCALE = 4.0f;
constexpr int PROW = 1536;
#ifndef PEER_V4
#define PEER_V4 1
#endif
#ifndef PEER_U4
#define PEER_U4 1
#endif
constexpr int PREC = PEER_U4 ? 2048 : PEER_V4 ? 2560 : 2 * PROW;
constexpr int NPH = 35;

constexpr size_t MiB = 1ull << 20;
constexpr size_t WS_CTL = 0, CTL_ZERO_BYTES = 1 * MiB;
constexpr int    CW_BAR = 4096;
constexpr size_t WS_MOD = 128 * 1024;
constexpr size_t WS_VST = 1 * MiB;
constexpr size_t WS_ROPE = 1 * MiB + 160 * 1024;
constexpr size_t WS_MODP = 1 * MiB + 256 * 1024;
constexpr size_t WS_GMWIN = 6 * MiB;
constexpr size_t WS_GMWOUT = WS_GMWIN + 32 * MiB;
constexpr size_t WS_GMWS = WS_GMWOUT + 16 * MiB;
constexpr size_t WS_PWQ = WS_GMWS + 1 * MiB;
constexpr size_t WS_PK1 = WS_PWQ + 32 * MiB;
constexpr size_t WS_PK2 = WS_PK1 + 512 * 1024;
constexpr size_t WS_MLAIN = WS_PK1 + 1 * MiB;
constexpr size_t WS_MLAUQ = WS_MLAIN + 5 * MiB;
constexpr size_t WS_MLAUKV = WS_MLAUQ + 3 * MiB;
constexpr size_t WS_MLAOUT = WS_MLAUKV + 4 * MiB;
constexpr size_t WS_DAIN = WS_MLAOUT + 8 * MiB;
constexpr size_t WS_DAOUT = WS_DAIN + 24 * MiB;
constexpr size_t WS_PU = WS_DAOUT + 8 * MiB;
constexpr size_t WS_PV = WS_PU + 96 * MiB;
constexpr size_t WS_X = WS_PV + 96 * MiB;
constexpr size_t WS_H = WS_X + 66 * MiB;
constexpr size_t WS_G = WS_H + 66 * MiB;
constexpr size_t WS_Y = WS_G + 66 * MiB;
constexpr size_t WS_QP = WS_Y + 66 * MiB;
constexpr size_t WS_Z = WS_QP + 66 * MiB;
constexpr size_t WS_C = WS_Z + 198 * MiB;
constexpr size_t WS_CQN = WS_C + 42 * MiB;
constexpr size_t WS_CKVN = WS_CQN + 17 * MiB;
constexpr size_t WS_KR = WS_CKVN + 17 * MiB;
constexpr size_t WS_QM = WS_KR + 3 * MiB;
constexpr size_t WS_KV = WS_QM + 99 * MiB;
constexpr size_t WS_ROUTE = WS_KV + 132 * MiB;
constexpr size_t WS_END = WS_ROUTE + 17 * MiB;
static_assert((size_t)MT * DM * 2 == 66 * MiB, "row buffer size");

constexpr int RING_BYTES = 155648, MISC_OFF = RING_BYTES + 320, LDS_BYTES = 159744;

#define GAS __attribute__((address_space(1)))
#define LAS __attribute__((address_space(3)))
typedef unsigned short bf16;
typedef unsigned u32x4 __attribute__((ext_vector_type(4)));
typedef unsigned u32x2 __attribute__((ext_vector_type(2)));
typedef float f32x4 __attribute__((ext_vector_type(4)));
typedef float f32x16 __attribute__((ext_vector_type(16)));
typedef short bf16x8 __attribute__((ext_vector_type(8)));
typedef short s16x4 __attribute__((ext_vector_type(4)));
#define LDS_WAIT() asm volatile("s_waitcnt lgkmcnt(0)" ::: "memory")

__device__ __forceinline__ unsigned cvtpk(float lo, float hi) { unsigned r; asm("v_cvt_pk_bf16_f32 %0, %1, %2" : "=v"(r) : "v"(lo), "v"(hi)); return r; }
__device__ __forceinline__ float bflo(unsigned w) { return __uint_as_float(w << 16); }
__device__ __forceinline__ float bfhi(unsigned w) { return __uint_as_float(w & 0xffff0000u); }
__device__ __forceinline__ float bf1(bf16 b) { return __uint_as_float((unsigned)b << 16); }
__device__ __forceinline__ bf16 tobf1(float f) { return (bf16)(cvtpk(f, 0.f) & 0xffffu); }
#define DPP_F(v, ctrl) __int_as_float(__builtin_amdgcn_mov_dpp(__float_as_int(v), (ctrl), 0xF, 0xF, true))
__device__ __forceinline__ float row_sum16(float v) { v += DPP_F(v, 0xB1); v += DPP_F(v, 0x4E); v += DPP_F(v, 0x141); v += DPP_F(v, 0x140); return v; }
__device__ __forceinline__ float sum_xor16(float v) { const auto r = __builtin_amdgcn_permlane16_swap(__float_as_uint(v), __float_as_uint(v), false, false); return __uint_as_float(r[0]) + __uint_as_float(r[1]); }
__device__ __forceinline__ float sum_xor32(float v) { const auto r = __builtin_amdgcn_permlane32_swap(__float_as_uint(v), __float_as_uint(v), false, false); return __uint_as_float(r[0]) + __uint_as_float(r[1]); }
__device__ __forceinline__ float wave_sum(float v) { return sum_xor32(sum_xor16(row_sum16(v))); }
__device__ __forceinline__ float half_sum32(float v) { return sum_xor16(row_sum16(v)); }
__device__ __forceinline__ float lane_xor16(float v, int lane) { const auto r = __builtin_amdgcn_permlane16_swap(__float_as_uint(v), __float_as_uint(v), false, false); return __uint_as_float((lane & 16) ? r[0] : r[1]); }
__device__ __forceinline__ unsigned lane_xor32(unsigned v, int lane) { const auto r = __builtin_amdgcn_permlane32_swap(v, v, false, false); return (lane & 32) ? r[0] : r[1]; }
__device__ __forceinline__ float gelu_tanh(float x) { return pg8::gelu_tanh(x); }

__device__ __forceinline__ void load_row_bf16(const bf16* row, int lane, float (&v)[32]) {
#pragma unroll
    for (int j = 0; j < 4; ++j) { const u32x4 w = ((const u32x4*)row)[64 * j + lane];
        v[8 * j + 0] = bflo(w.x); v[8 * j + 1] = bfhi(w.x); v[8 * j + 2] = bflo(w.y); v[8 * j + 3] = bfhi(w.y);
        v[8 * j + 4] = bflo(w.z); v[8 * j + 5] = bfhi(w.z); v[8 * j + 6] = bflo(w.w); v[8 * j + 7] = bfhi(w.w); }
}
__device__ __forceinline__ void store_row_bf16(bf16* row, int lane, const float (&v)[32]) {
#pragma unroll
    for (int j = 0; j < 4; ++j) { u32x4 w; w.x = cvtpk(v[8 * j + 0], v[8 * j + 1]); w.y = cvtpk(v[8 * j + 2], v[8 * j + 3]); w.z = cvtpk(v[8 * j + 4], v[8 * j + 5]); w.w = cvtpk(v[8 * j + 6], v[8 * j + 7]);
        ((u32x4*)row)[64 * j + lane] = w; }
}
__device__ __forceinline__ void load_row_f32(const float* row, int lane, float (&v)[32]) {
#pragma unroll
    for (int j = 0; j < 4; ++j) { const f32x4 a = ((const f32x4*)row)[128 * j + 2 * lane], b = ((const f32x4*)row)[128 * j + 2 * lane + 1];
        v[8 * j + 0] = a.x; v[8 * j + 1] = a.y; v[8 * j + 2] = a.z; v[8 * j + 3] = a.w; v[8 * j + 4] = b.x; v[8 * j + 5] = b.y; v[8 * j + 6] = b.z; v[8 * j + 7] = b.w; }
}
__device__ __forceinline__ void load_row_f32_nt(const float* row, int lane, float (&v)[32]) {
#pragma unroll
    for (int j = 0; j < 4; ++j) { const f32x4 a = __builtin_nontemporal_load(&((const f32x4*)row)[128 * j + 2 * lane]), b = __builtin_nontemporal_load(&((const f32x4*)row)[128 * j + 2 * lane + 1]);
        v[8 * j + 0] = a.x; v[8 * j + 1] = a.y; v[8 * j + 2] = a.z; v[8 * j + 3] = a.w; v[8 * j + 4] = b.x; v[8 * j + 5] = b.y; v[8 * j + 6] = b.z; v[8 * j + 7] = b.w; }
}
__device__ __forceinline__ void store_row_f32(float* row, int lane, const float (&v)[32]) {
#pragma unroll
    for (int j = 0; j < 4; ++j) { ((f32x4*)row)[128 * j + 2 * lane] = (f32x4){v[8 * j + 0], v[8 * j + 1], v[8 * j + 2], v[8 * j + 3]};
        ((f32x4*)row)[128 * j + 2 * lane + 1] = (f32x4){v[8 * j + 4], v[8 * j + 5], v[8 * j + 6], v[8 * j + 7]}; }
}
__device__ __forceinline__ void load_row_bf16_b(const bf16* row, int lane, float (&v)[32]) {
#pragma unroll
    for (int j = 0; j < 4; ++j) { const u32x4 w = ((const u32x4*)row)[4 * lane + j];
        v[8 * j + 0] = bflo(w.x); v[8 * j + 1] = bfhi(w.x); v[8 * j + 2] = bflo(w.y); v[8 * j + 3] = bfhi(w.y);
        v[8 * j + 4] = bflo(w.z); v[8 * j + 5] = bfhi(w.z); v[8 * j + 6] = bflo(w.w); v[8 * j + 7] = bfhi(w.w); }
}
__device__ __forceinline__ void store_row_bf16_b(bf16* row, int lane, const float (&v)[32]) {
#pragma unroll
    for (int j = 0; j < 4; ++j) { u32x4 w; w.x = cvtpk(v[8 * j + 0], v[8 * j + 1]); w.y = cvtpk(v[8 * j + 2], v[8 * j + 3]); w.z = cvtpk(v[8 * j + 4], v[8 * j + 5]); w.w = cvtpk(v[8 * j + 6], v[8 * j + 7]);
        ((u32x4*)row)[4 * lane + j] = w; }
}
__device__ __forceinline__ void load_row_f32_b(const float* row, int lane, float (&v)[32]) {
#pragma unroll
    for (int q = 0; q < 8; ++q) { const f32x4 a = ((const f32x4*)row)[8 * lane + q];
        v[4 * q + 0] = a.x; v[4 * q + 1] = a.y; v[4 * q + 2] = a.z; v[4 * q + 3] = a.w; }
}
__device__ __forceinline__ void store_row_f32_b(float* row, int lane, const float (&v)[32]) {
#pragma unroll
    for (int q = 0; q < 8; ++q) ((f32x4*)row)[8 * lane + q] = (f32x4){v[4 * q + 0], v[4 * q + 1], v[4 * q + 2], v[4 * q + 3]};
}
__device__ __forceinline__ void store_row_f32_b_nt(float* row, int lane, const float (&v)[32]) {
#pragma unroll
    for (int q = 0; q < 8; ++q) __builtin_nontemporal_store((f32x4){v[4 * q + 0], v[4 * q + 1], v[4 * q + 2], v[4 * q + 3]}, &((f32x4*)row)[8 * lane + q]);
}
__device__ __forceinline__ void ln_stats(const float (&v)[32], float& mean, float& rstd) {
    float s = 0.f;
#pragma unroll
    for (int i = 0; i < 32; ++i) s += v[i];
    mean = wave_sum(s) * (1.0f / DM);
    float q = 0.f;
#pragma unroll
    for (int i = 0; i < 32; ++i) { const float d = v[i] - mean; q += d * d; }
    rstd = 1.0f / sqrtf(wave_sum(q) * (1.0f / DM) + LN_EPS);
}
template <bool LAYB>
__device__ __forceinline__ void finish_row(float (&z)[32], const float* lng, const float* lnb, bf16* Xrow, const float* sh, const float* sc, bf16* Hrow, float* Orow, int lane) {
    float mean, rstd; ln_stats(z, mean, rstd);
    { float g[32], b[32]; if (LAYB) { load_row_f32_b(lng, lane, g); load_row_f32_b(lnb, lane, b); } else { load_row_f32(lng, lane, g); load_row_f32(lnb, lane, b); }
#pragma unroll
      for (int i = 0; i < 32; ++i) z[i] = (z[i] - mean) * rstd * g[i] + b[i]; }
    if (Xrow) { if (LAYB) store_row_bf16_b(Xrow, lane, z); else store_row_bf16(Xrow, lane, z); }
    if (Orow) { if (LAYB) store_row_f32_b(Orow, lane, z); else store_row_f32(Orow, lane, z); }
    if (Hrow) {
        ln_stats(z, mean, rstd);
        float a[32], s[32]; if (LAYB) { load_row_f32_b(sc, lane, a); load_row_f32_b(sh, lane, s); } else { load_row_f32(sc, lane, a); load_row_f32(sh, lane, s); }
#pragma unroll
        for (int i = 0; i < 32; ++i) a[i] = (z[i] - mean) * rstd * (1.0f + a[i]) + s[i];
        if (LAYB) store_row_bf16_b(Hrow, lane, a); else store_row_bf16(Hrow, lane, a);
    }
}
__device__ __forceinline__ int row_slot(int row) { return row < ML ? (row >> 13) : 2; }

__device__ __forceinline__ unsigned f2bf_rne(float f) { unsigned u = __float_as_uint(f); return (u + 0x7fffu + ((u >> 16) & 1u)) >> 16; }
__device__ __forceinline__ unsigned pk2(float lo, float hi) { return f2bf_rne(lo) | (f2bf_rne(hi) << 16); }
#ifndef NT_STREAM
#define NT_STREAM 1
#endif
__device__ __forceinline__ void p0_transpose_item(const float* W, int K, int N, bf16* WT, LAS float* scr, int item, int lane) {
    const int nblk = N / 32, kb = item / nblk, nb = item % nblk, k0 = 64 * kb, n0 = 32 * nb;
    f32x4 t[8];
#pragma unroll
    for (int i = 0; i < 8; ++i) { const f32x4* p_ = (const f32x4*)(W + (size_t)(k0 + 8 * i + (lane >> 3)) * N + n0 + 4 * (lane & 7)); t[i] = NT_STREAM ? __builtin_nontemporal_load(p_) : *p_; }
#pragma unroll
    for (int i = 0; i < 8; ++i) { LAS float* d = scr + (8 * i + (lane >> 3)) * 33 + 4 * (lane & 7); d[0] = t[i].x; d[1] = t[i].y; d[2] = t[i].z; d[3] = t[i].w; }
    LDS_WAIT(); asm volatile("" ::: "memory");
    const int c = lane & 7;
#pragma unroll
    for (int j = 0; j < 4; ++j) { const int n = (lane >> 3) + 8 * j; const LAS float* s = scr + (8 * c) * 33 + n;
        u32x4 o; o.x = pk2(s[0 * 33], s[1 * 33]); o.y = pk2(s[2 * 33], s[3 * 33]); o.z = pk2(s[4 * 33], s[5 * 33]); o.w = pk2(s[6 * 33], s[7 * 33]);
        *(u32x4*)(WT + (size_t)(n0 + n) * K + k0 + 8 * c) = o; }
    LDS_WAIT(); asm volatile("" ::: "memory");
}
__device__ __forceinline__ void cvt_range(const float* src, bf16* dst, size_t n8, size_t gtid, size_t gthreads) {
#pragma unroll 4
    for (size_t i = gtid; i < n8; i += gthreads) { const f32x4 a = ((const f32x4*)src)[2 * i], b = ((const f32x4*)src)[2 * i + 1];
        u32x4 w; w.x = cvtpk(a.x, a.y); w.y = cvtpk(a.z, a.w); w.z = cvtpk(b.x, b.y); w.w = cvtpk(b.z, b.w); ((u32x4*)dst)[i] = w; }
}
__device__ __forceinline__ unsigned enc_e2m3(float x) {
    const unsigned sgn = (__float_as_uint(x) >> 26) & 32u;
    const float ax = fminf(fabsf(x), 7.5f);
    unsigned u = __float_as_uint(ax); u += 0x7FFFFu + ((u >> 20) & 1u);
    const unsigned cn = (u >> 20) - ((127u - 1u) << 3);
    const unsigned cs = (unsigned)__builtin_rintf(ax * 8.0f);
    return sgn | (ax < 1.0f ? cs : cn);
}
#ifndef EMU_FP4V
#define EMU_FP4V 0
#endif
#ifndef CVT_PIPE
#define CVT_PIPE 0
#endif
typedef float f32x2v __attribute__((ext_vector_type(2)));
typedef float f32x16v __attribute__((ext_vector_type(16)));
typedef float f32x32v __attribute__((ext_vector_type(32)));
typedef unsigned u32x6v __attribute__((ext_vector_type(6)));
__device__ __forceinline__ u32x6v pack_fp6_32(const float (&e)[32], bool interleaved) {
    f32x16v s0, s1;
    if (interleaved) {
#pragma unroll
        for (int i = 0; i < 16; ++i) { s0[i] = e[2 * i]; s1[i] = e[2 * i + 1]; }
    } else {
#pragma unroll
        for (int i = 0; i < 16; ++i) { s0[i] = e[i]; s1[i] = e[16 + i]; }
    }
    return __builtin_amdgcn_cvt_scalef32_2xpk16_fp6_f32(s0, s1, 1.0f);
}
__device__ __forceinline__ void cvt_table_fp6(const float* src, unsigned char* dst, int nrows, float scale, LAS float* scr  , int lane, int gw, int NGW, const int isv) {
    bool interleaved;
    {
        float t[32];
#pragma unroll
        for (int k = 0; k < 32; ++k) t[k] = k < 16 ? 0.125f * k : (k < 24 ? 2.0f + 0.25f * (k - 16) : 4.0f + 0.5f * (k - 24));
        float tt[32];
#pragma unroll
        for (int k = 0; k < 32; ++k) { tt[k] = t[k]; asm volatile("" : "+v"(tt[k])); }
        const u32x6v p = pack_fp6_32(tt, true);
        const f32x32v o = __builtin_amdgcn_cvt_scalef32_pk32_f32_fp6(p, 1.0f);
        interleaved = (o[1] == t[1]) && (o[2] == t[2]) && (o[17] == t[17]);
        interleaved = __all(interleaved);
    }
#if CVT_PIPE
    f32x4 nx[8];
    if (gw < nrows) { const f32x4* s4 = (const f32x4*)(src + (size_t)gw * 2048);
#pragma unroll
        for (int q = 0; q < 8; ++q) nx[q] = s4[64 * q + lane]; }
    for (int row = gw; row < nrows; row += NGW) {
        f32x4 cur[8];
#pragma unroll
        for (int q = 0; q < 8; ++q) cur[q] = nx[q];
        if (row + NGW < nrows) { const f32x4* s4 = (const f32x4*)(src + (size_t)(row + NGW) * 2048);
#pragma unroll
            for (int q = 0; q < 8; ++q) nx[q] = s4[64 * q + lane]; }
#pragma unroll
        for (int q = 0; q < 8; ++q) { const int s = 64 * q + lane; const f32x4 a = cur[q] * scale; *(LAS f32x4*)(scr + 4 * (s ^ ((s >> 4) & 7))) = a; }
#else
    bool fp4_swapped = false;
    if (PEER_V4) {
        float t0 = 1.0f, t1 = 2.0f; asm volatile("" : "+v"(t0), "+v"(t1));
        const unsigned pw = __builtin_amdgcn_cvt_scalef32_pk_fp4_f32(0u, t0, t1, 1.0f, 0);
        const f32x2v pr = __builtin_amdgcn_cvt_scalef32_pk_f32_fp4(pw, 1.0f, 0);
        fp4_swapped = !__all(pr[0] == 1.0f);
    }
    for (int row = gw; row < nrows; row += NGW) {
        const f32x4* s4 = (const f32x4*)(src + (size_t)row * 2048);
#pragma unroll
        for (int q = 0; q < 8; ++q) { const int s = 64 * q + lane; const f32x4 a = (NT_STREAM ? __builtin_nontemporal_load(&s4[s]) : s4[s]) * scale; *(LAS f32x4*)(scr + 4 * (s ^ ((s >> 4) & 7))) = a; }
#endif
        float e[32];
#pragma unroll
        for (int j = 0; j < 8; ++j) { const int s = 8 * lane + j; const f32x4 a = *(const LAS f32x4*)(scr + 4 * (s ^ ((s >> 4) & 7)));
            e[4 * j + 0] = __builtin_amdgcn_fmed3f(a.x, -7.5f, 7.5f); e[4 * j + 1] = __builtin_amdgcn_fmed3f(a.y, -7.5f, 7.5f); e[4 * j + 2] = __builtin_amdgcn_fmed3f(a.z, -7.5f, 7.5f); e[4 * j + 3] = __builtin_amdgcn_fmed3f(a.w, -7.5f, 7.5f); }
#if EMU_FP4V
        if (EMU_FP4V == 2 ? !isv : isv) {
#pragma unroll
            for (int i = 0; i < 32; ++i) { const float a = fabsf(e[i]); float q = a < 2.0f ? rintf(a * 2.0f) * 0.5f : (a < 4.0f ? rintf(a) : fminf(rintf(a * 0.5f) * 2.0f, 6.0f)); e[i] = copysignf(q, e[i]); }
        }
#endif
        unsigned char* rowp = dst + (size_t)row * PREC;
        if (PEER_V4 && (isv || PEER_U4)) {
            u32x4 w4;
#pragma unroll
            for (int w = 0; w < 4; ++w) { unsigned d = 0u; float x_[8];
#pragma unroll
                for (int i = 0; i < 8; i += 2) { const float x0 = __builtin_amdgcn_fmed3f(e[8 * w + i], -6.0f, 6.0f), x1 = __builtin_amdgcn_fmed3f(e[8 * w + i + 1], -6.0f, 6.0f); x_[i] = fp4_swapped ? x1 : x0; x_[i + 1] = fp4_swapped ? x0 : x1; }
                d = __builtin_amdgcn_cvt_scalef32_pk_fp4_f32(d, x_[0], x_[1], 1.0f, 0); d = __builtin_amdgcn_cvt_scalef32_pk_fp4_f32(d, x_[2], x_[3], 1.0f, 1);
                d = __builtin_amdgcn_cvt_scalef32_pk_fp4_f32(d, x_[4], x_[5], 1.0f, 2); d = __builtin_amdgcn_cvt_scalef32_pk_fp4_f32(d, x_[6], x_[7], 1.0f, 3);
                w4[w] = d; }
            *(u32x4*)(rowp + ((isv || !PEER_U4) ? 1024 : 0) + 16 * lane) = w4;
            continue;
        }
        const u32x6v p = pack_fp6_32(e, interleaved);
        *(u32x4*)(rowp + 1024 * isv + 16 * lane) = (u32x4){p[0], p[1], p[2], p[3]}; *(u32x2*)(rowp + 2048 + 512 * isv + 8 * lane) = (u32x2){p[4], p[5]};
    }
}
__device__ __forceinline__ float silu(float x) { return x / (1.0f + __expf(-x)); }

struct Params { const float* in[29]; float* out; unsigned char* ws; int ph_lo, ph_hi; };
typedef const __attribute__((address_space(4))) Params* CP;

#ifndef P0_NOV
#define P0_NOV 0
#endif
#ifndef TAIL_REMAP
#define TAIL_REMAP 0
#endif
__device__ __forceinline__ void p0_prologue(CP P, LAS unsigned char* lds, int tid, int lane, int wid, int gw, int NGW, const int parts = 7) {
    unsigned char* ws = P->ws;
    LAS float* scr = (LAS float*)(lds + wid * 16384);
    if (parts & 1) {
        constexpr int I_GMIN = (2048 / 64) * (4096 / 32), I_SQ = (2048 / 64) * (2048 / 32), I_MIN = (2048 / 64) * (1088 / 32), I_UQ = (512 / 64) * (3072 / 32), I_UKV = (512 / 64) * (4096 / 32), I_DIN = (2048 / 64) * (6144 / 32);
        constexpr int NIT = 2 * I_GMIN + 2 * I_SQ + 4 * I_SQ + I_MIN + I_UQ + I_UKV + I_SQ + I_DIN + I_SQ;
        for (int it = gw; it < NIT; it += NGW) {
            int r = it;
            if (r < 2 * I_GMIN) { const int j = r / I_GMIN; p0_transpose_item(P->in[13] + (size_t)j * 2048 * 4096, 2048, 4096, (bf16*)(ws + WS_GMWIN) + (size_t)j * 4096 * 2048, scr, r % I_GMIN, lane); continue; } r -= 2 * I_GMIN;
            if (r < 2 * I_SQ) { const int j = r / I_SQ; p0_transpose_item(P->in[18] + (size_t)j * 2048 * 2048, 2048, 2048, (bf16*)(ws + WS_GMWOUT) + (size_t)j * 2048 * 2048, scr, r % I_SQ, lane); continue; } r -= 2 * I_SQ;
            if (r < 4 * I_SQ) { const int j = r / I_SQ; p0_transpose_item(P->in[8] + (size_t)j * 2048 * 2048, 2048, 2048, (bf16*)(ws + WS_PWQ) + (size_t)j * 2048 * 2048, scr, r % I_SQ, lane); continue; } r -= 4 * I_SQ;
            if (r < I_MIN) { p0_transpose_item(P->in[19], 2048, 1088, (bf16*)(ws + WS_MLAIN), scr, r, lane); continue; } r -= I_MIN;
            if (r < I_UQ) { p0_transpose_item(P->in[22], 512, 3072, (bf16*)(ws + WS_MLAUQ), scr, r, lane); continue; } r -= I_UQ;
            if (r < I_UKV) { p0_transpose_item(P->in[23], 512, 4096, (bf16*)(ws + WS_MLAUKV), scr, r, lane); continue; } r -= I_UKV;
            if (r < I_SQ) { p0_transpose_item(P->in[24], 2048, 2048, (bf16*)(ws + WS_MLAOUT), scr, r, lane); continue; } r -= I_SQ;
            if (r < I_DIN) { p0_transpose_item(P->in[25], 2048, 6144, (bf16*)(ws + WS_DAIN), scr, r, lane); continue; } r -= I_DIN;
            p0_transpose_item(P->in[28], 2048, 2048, (bf16*)(ws + WS_DAOUT), scr, r, lane);
        }
    }
    const size_t gtid = (size_t)gw * 64 + lane, gthreads = (size_t)NGW * 64;
    if (parts & 2) {
    { u32x4* z = (u32x4*)((bf16*)(ws + WS_MLAIN) + (size_t)1088 * 2048); const size_t n = (size_t)192 * 2048 / 8;
      for (size_t i = gtid; i < n; i += gthreads) z[i] = (u32x4){0u, 0u, 0u, 0u}; }
    cvt_range(P->in[16], (bf16*)(ws + WS_GMWS), (size_t)2 * 16 * 128 * 128 / 8, gtid, gthreads);
    cvt_range(P->in[9], (bf16*)(ws + WS_PK1), (size_t)4 * 128 * 128 / 8, gtid, gthreads);
    cvt_range(P->in[10], (bf16*)(ws + WS_PK2), (size_t)4 * 128 * 128 / 8, gtid, gthreads);
#if !TAIL_REMAP
    cvt_table_fp6(P->in[11], ws + WS_PU, 16384, U_SCALE, scr, lane, gw, NGW, 0);
    if (!P0_NOV) cvt_table_fp6(P->in[12], ws + WS_PU, 16384, V_SCALE, scr, lane, gw, NGW, 1);
#endif
    if (gtid < 2048) { const int pos = (int)gtid >> 4, f = (int)gtid & 15; const float inv = powf(10000.0f, -(float)f * (1.0f / 16.0f)); float sn, cs; sincosf((float)pos * inv, &sn, &cs);
        float* rt = (float*)(ws + WS_ROPE); rt[gtid] = cs; rt[2048 + gtid] = sn; }
    }
    if (parts & 4) {
        const float* cv = P->in[1]; const float* cc = P->in[3]; const float* mw = P->in[4]; float* PART = (float*)(ws + WS_MODP);
        LAS float* S = (LAS float*)lds;
        __syncthreads();
        for (int i = tid; i < 3 * 2048; i += NWAVES * 64) { const int sl = i >> 11, kk = i & 2047; S[i] = silu(sl == 0 ? cv[kk] : (sl == 1 ? cv[2048 + kk] : cc[kk])); }
        __syncthreads();
        for (int item = gw; item < 4 * 192 * 8; item += NGW) {
            const int ks = item & 7, r = item >> 3, L = r / 192, n = (r % 192) * 64 + lane;
            const float* W = mw + (size_t)L * 2048 * 12288 + (size_t)(ks * 256) * 12288 + n;
            float a0 = 0.f, a1 = 0.f, a2 = 0.f;
#pragma unroll 32
            for (int k = 0; k < 256; ++k) { const int kk = ks * 256 + k; const float s0 = S[kk], s1 = S[2048 + kk], s2 = S[4096 + kk];
                const float w = NT_STREAM ? __builtin_nontemporal_load(&W[(size_t)k * 12288]) : W[(size_t)k * 12288]; a0 += s0 * w; a1 += s1 * w; a2 += s2 * w; }
            float* o = PART + ((size_t)ks * 4 + L) * 3 * 12288 + n;
            o[0] = a0; o[12288] = a1; o[24576] = a2;
        }
    }
}
__device__ __forceinline__ void mod_reduce(CP P, int gw, int lane, int NGW) {
    const float* PART = (const float*)(P->ws + WS_MODP); float* MOD = (float*)(P->ws + WS_MOD); const float* mb = P->in[5];
    for (int i = gw * 64 + lane; i < 4 * 3 * 12288; i += NGW * 64) {
        const int L = i / (3 * 12288), n = i % 12288;
        float s = mb[(size_t)L * 12288 + n];
#pragma unroll
        for (int ks = 0; ks < 8; ++ks) s += PART[(size_t)ks * 4 * 3 * 12288 + i];
        MOD[i] = s;
    }
}

__device__ __forceinline__ void load_row_f32_l(const LAS float* row, int lane, float (&v)[32]) {
#pragma unroll
    for (int j = 0; j < 4; ++j) { const f32x4 a = ((const LAS f32x4*)row)[128 * j + 2 * lane], b = ((const LAS f32x4*)row)[128 * j + 2 * lane + 1];
        v[8 * j + 0] = a.x; v[8 * j + 1] = a.y; v[8 * j + 2] = a.z; v[8 * j + 3] = a.w; v[8 * j + 4] = b.x; v[8 * j + 5] = b.y; v[8 * j + 6] = b.z; v[8 * j + 7] = b.w; }
}
__device__ __forceinline__ void first_row_pass(CP P, LAS unsigned char* lds, int tid, int lane, int gw, int NGW) {
    const float* MOD = (const float*)(P->ws + WS_MOD); bf16* X = (bf16*)(P->ws + WS_X); bf16* H = (bf16*)(P->ws + WS_H);
    LAS float* V = (LAS float*)lds;
    __syncthreads();
    { f32x4 t_[6];
#pragma unroll
      for (int vec = 0; vec < 6; ++vec) t_[vec] = ((const f32x4*)(MOD + (size_t)(vec >> 1) * 12288 + (size_t)(vec & 1) * 2048))[tid];
#pragma unroll
      for (int vec = 0; vec < 6; ++vec) ((LAS f32x4*)V)[vec * 512 + tid] = t_[vec]; }
    __syncthreads();
    for (int row = gw; row < MT; row += NGW) {
        const float* src = row < ML ? P->in[0] + (size_t)row * DM : P->in[2] + (size_t)(row - ML) * DM;
        float v[32]; if (NT_STREAM) load_row_f32_nt(src, lane, v); else load_row_f32(src, lane, v);
        store_row_bf16(X + (size_t)row * DM, lane, v);
        const LAS float* mod = V + row_slot(row) * 4096;
        float mean, rstd; ln_stats(v, mean, rstd);
        float a[32], s[32]; load_row_f32_l(mod + 2048, lane, a); load_row_f32_l(mod, lane, s);
#pragma unroll
        for (int i = 0; i < 32; ++i) a[i] = (v[i] - mean) * rstd * (1.0f + a[i]) + s[i];
        store_row_bf16(H + (size_t)row * DM, lane, a);
    }
}
#ifndef POSTMIX_LDS
#define POSTMIX_LDS 1
#endif
__device__ __forceinline__ void post_mixer_pass_lds(CP P, int L, int Mrows, LAS unsigned char* lds, int tid, int lane, int gw, int NGW) {
    const float* MOD = (const float*)(P->ws + WS_MOD); bf16* X = (bf16*)(P->ws + WS_X); bf16* H = (bf16*)(P->ws + WS_H); const bf16* Y = (const bf16*)(P->ws + WS_Y);
    const float* lng = P->in[6] + (size_t)(L * 2 + 0) * DM; const float* lnb = P->in[7] + (size_t)(L * 2 + 0) * DM;
    LAS float* V = (LAS float*)lds;
    __syncthreads();
    { f32x4 t_[11];
#pragma unroll
      for (int vec = 0; vec < 11; ++vec) { const float* src = vec == 0 ? lng : (vec == 1 ? lnb : MOD + (size_t)(L * 3 + (vec - 2) / 3) * 12288 + (size_t)(2 + (vec - 2) % 3) * 2048);
          t_[vec] = ((const f32x4*)src)[tid]; }
#pragma unroll
      for (int vec = 0; vec < 11; ++vec) ((LAS f32x4*)V)[vec * 512 + tid] = t_[vec]; }
    __syncthreads();
    for (int row = gw; row < Mrows; row += NGW) {
        const LAS float* mv = V + (2 + 3 * row_slot(row)) * 2048;
        float z[32], y[32]; load_row_bf16(X + (size_t)row * DM, lane, z); load_row_bf16(Y + (size_t)row * DM, lane, y);
        { float g[32]; load_row_f32_l(mv, lane, g);
#pragma unroll
          for (int i = 0; i < 32; ++i) z[i] = ALPHA * z[i] + g[i] * y[i]; }
        float mean, rstd; ln_stats(z, mean, rstd);
        { float g[32], b[32]; load_row_f32_l(V, lane, g); load_row_f32_l(V + 2048, lane, b);
#pragma unroll
          for (int i = 0; i < 32; ++i) z[i] = (z[i] - mean) * rstd * g[i] + b[i]; }
        store_row_bf16(X + (size_t)row * DM, lane, z);
        ln_stats(z, mean, rstd);
        { float a[32], s_[32]; load_row_f32_l(mv + 2 * 2048, lane, a); load_row_f32_l(mv + 2048, lane, s_);
#pragma unroll
          for (int i = 0; i < 32; ++i) a[i] = (z[i] - mean) * rstd * (1.0f + a[i]) + s_[i];
          store_row_bf16(H + (size_t)row * DM, lane, a); }
    }
}
__device__ __forceinline__ void post_mixer_pass(CP P, int L, int Mrows, int lane, int gw, int NGW) {
    const float* MOD = (const float*)(P->ws + WS_MOD); bf16* X = (bf16*)(P->ws + WS_X); bf16* H = (bf16*)(P->ws + WS_H); const bf16* Y = (const bf16*)(P->ws + WS_Y);
    const float* lng = P->in[6] + (size_t)(L * 2 + 0) * DM; const float* lnb = P->in[7] + (size_t)(L * 2 + 0) * DM;
    for (int row = gw; row < Mrows; row += NGW) {
        const float* mod = MOD + (size_t)(L * 3 + row_slot(row)) * 12288;
        float z[32], y[32], g[32]; load_row_bf16(X + (size_t)row * DM, lane, z); load_row_bf16(Y + (size_t)row * DM, lane, y); load_row_f32(mod + 2 * 2048, lane, g);
#pragma unroll
        for (int i = 0; i < 32; ++i) z[i] = ALPHA * z[i] + g[i] * y[i];
        finish_row<false>(z, lng, lnb, X + (size_t)row * DM, mod + 3 * 2048, mod + 4 * 2048, H + (size_t)row * DM, nullptr, lane);
    }
}
__device__ __forceinline__ void vstats_pass(CP P, int Mrows, int lane, int gw, int NGW) {
    const bf16* Z = (const bf16*)(P->ws + WS_Z); float* VST = (float*)(P->ws + WS_VST);
    for (int row = gw; row < Mrows; row += NGW) {
        float v[32]; load_row_bf16(Z + (size_t)row * 4096 + 2048, lane, v);
        float mean, rstd; ln_stats(v, mean, rstd);
        if (lane == 0) { VST[2 * row] = mean; VST[2 * row + 1] = rstd; }
    }
}
#define XB_TMO      128
#define XB_XCNT(j)  (256  + 64 * (j))
#define XB_XSUB(j)  (1280 + 64 * (j))
#define XB_XGEN(j)  (2304 + 64 * (j))
#define XB_TOP      3328
#define XB_TOPGEN   3392
#define XCD_BAR_WORDS 3456
#define XB_SPIN_CAP (1u << 18)

__device__ __forceinline__ unsigned xb_ld(unsigned* p)              { return __hip_atomic_load(p, __ATOMIC_RELAXED, __HIP_MEMORY_SCOPE_AGENT); }
__device__ __forceinline__ unsigned xb_add(unsigned* p, unsigned v) { return __hip_atomic_fetch_add(p, v, __ATOMIC_RELAXED, __HIP_MEMORY_SCOPE_AGENT); }
__device__ __forceinline__ unsigned xb_xcc_id() { return (unsigned)__builtin_amdgcn_s_getreg((3 << 11) | 20) & 0xFu; }
#define XB_SPIN(cond, bar) do { unsigned _sp = 0; while (cond) { __builtin_amdgcn_s_sleep(1); \
    if ((++_sp & 255u) == 0u) { if (xb_ld(&(bar)[XB_TMO])) break; if (_sp > XB_SPIN_CAP) { atomicAdd(&(bar)[XB_TMO], 1u); break; } } } } while (0)

struct XcdBarrier {
    unsigned* bar; unsigned x;
    volatile LAS unsigned* st;
};

__device__ __forceinline__ XcdBarrier xcd_barrier_post(unsigned* bar, volatile LAS unsigned* st, const bool t0) {
    XcdBarrier b; b.bar = bar; b.x = xb_xcc_id(); b.st = st;
    if (t0) (void)xb_add(&bar[XB_XCNT(b.x)], 1u);
    return b;
}
__device__ __forceinline__ void xcd_barrier_complete(unsigned* bar, unsigned x, unsigned& nloc, unsigned& nx) {
    const unsigned G = gridDim.x * gridDim.y * gridDim.z;
    unsigned sum, cnt, mine, sp = 0u;
    for (;;) {
        sum = 0u; cnt = 0u; mine = 0u;
#pragma unroll
        for (unsigned j = 0; j < 16; ++j) { const unsigned c = xb_ld(&bar[XB_XCNT(j)]); sum += c; cnt += (c > 0u) ? 1u : 0u; mine = (j == x) ? c : mine; }
        if (sum == G) break;
        __builtin_amdgcn_s_sleep(1);
        if ((++sp & 255u) == 0u) { if (xb_ld(&bar[XB_TMO])) break; if (sp > XB_SPIN_CAP) { atomicAdd(&bar[XB_TMO], 1u); break; } }
    }
    nloc = mine > 0u ? mine : 1u; nx = cnt > 0u ? cnt : 1u;
}

__device__ __attribute__((noinline)) void xcd_barrier(const XcdBarrier b, const bool t0) {
    asm volatile("s_waitcnt vmcnt(0)" ::: "memory");
    __syncthreads();
    if (t0) {
        unsigned* bar = b.bar;
        __builtin_amdgcn_s_waitcnt(0);
        unsigned nloc = b.st[0], nx = b.st[1];
        if (nloc == 0u) { xcd_barrier_complete(bar, b.x, nloc, nx); b.st[0] = nloc; b.st[1] = nx; }
        const unsigned old = xb_add(&bar[XB_XSUB(b.x)], 1u);
        const unsigned gen = old / nloc;
        if (old + 1u == (gen + 1u) * nloc) {
            __builtin_amdgcn_fence(__ATOMIC_RELEASE, "agent");
            asm volatile("s_waitcnt vmcnt(0)" ::: "memory");
            const unsigned og = xb_add(&bar[XB_TOP], 1u);
            const unsigned tg = og / nx;
            if (og + 1u == (tg + 1u) * nx) xb_add(&bar[XB_TOPGEN], 1u);
            else XB_SPIN(xb_ld(&bar[XB_TOPGEN]) == tg, bar);
            __builtin_amdgcn_fence(__ATOMIC_ACQUIRE, "agent");
            xb_add(&bar[XB_XGEN(b.x)], 1u);
            asm volatile("s_waitcnt vmcnt(0)" ::: "memory");
        } else {
            XB_SPIN(xb_ld(&bar[XB_XGEN(b.x)]) == gen, bar);
            __builtin_amdgcn_fence(__ATOMIC_ACQUIRE, "agent");
            asm volatile("s_waitcnt vmcnt(0)" ::: "memory");
        }
    }
    __syncthreads();
}

#ifndef SPATIAL_PIPE
#define SPATIAL_PIPE 1
#endif
#if SPATIAL_PIPE
#ifndef SPATIAL_OTILE
#define SPATIAL_OTILE 0
#endif
struct SpReg { u32x4 w[4]; float mean, rstd; bf16x8 a[4]; bf16 uu[SPATIAL_OTILE ? 1 : 32]; u32x4 uq[4]; float bsv[4]; };
__device__ __forceinline__ void sp_load(SpReg& R, const bf16* Z, const float* VST, const bf16* WS, const float* bs, int u, int tid, int lane, int wid) {
    const int c = u >> 4, g = u & 15, fr = lane & 15, fq = lane >> 4;
    { const int q = tid >> 2, dq = (tid & 3) * 32; const int row = c * 128 + q;
      R.mean = VST[2 * row]; R.rstd = VST[2 * row + 1];
      const bf16* src = Z + (size_t)row * 4096 + 2048 + g * 128 + dq;
#pragma unroll
      for (int t = 0; t < 4; ++t) R.w[t] = *(const u32x4*)(src + 8 * t); }
    const bf16* wrow = WS + (size_t)g * 128 * 128 + (size_t)(16 * wid + fr) * 128 + 8 * fq;
#pragma unroll
    for (int ks = 0; ks < 4; ++ks) R.a[ks] = *(const bf16x8*)(wrow + 32 * ks);
#pragma unroll
    for (int r = 0; r < 4; ++r) R.bsv[r] = bs[g * 128 + 16 * wid + fq * 4 + r];
#if SPATIAL_OTILE
#pragma unroll
    for (int t = 0; t < 4; ++t) { const int ch = tid + 512 * t, p = ch >> 4, d8 = (ch & 15) * 8; R.uq[t] = *(const u32x4*)(Z + (size_t)(c * 128 + p) * 4096 + g * 128 + d8); }
    R.uu[0] = 0;
#else
#pragma unroll
    for (int nb = 0; nb < 8; ++nb)
#pragma unroll
        for (int r = 0; r < 4; ++r) { const int p = 16 * wid + fq * 4 + r, d = 16 * nb + fr; R.uu[nb * 4 + r] = Z[(size_t)(c * 128 + p) * 4096 + g * 128 + d]; }
#endif
}
__device__ __forceinline__ void spatial_phase(CP P, int j, int Mrows, LAS unsigned char* lds_, int tid, int lane, int wid) {
    const bf16* Z = (const bf16*)(P->ws + WS_Z); const float* VST = (const float*)(P->ws + WS_VST); bf16* Gb = (bf16*)(P->ws + WS_G);
    const bf16* WS = (const bf16*)(P->ws + WS_GMWS) + (size_t)j * 16 * 128 * 128;
    const float* lng = P->in[14] + (size_t)j * DM; const float* lnb = P->in[15] + (size_t)j * DM; const float* bs = P->in[17] + (size_t)j * 16 * 128;
    LAS bf16* Vt = (LAS bf16*)(LAS unsigned char*)lds_;
    constexpr int VP = 136;
    const int nunits = (Mrows / 128) * 16;
    LAS float* LNl = (LAS float*)(lds_ + 36864);
    __syncthreads();
    for (int i = tid; i < 1024; i += NWAVES * 64) { const int vec = i >> 9, g4 = i & 511; ((LAS f32x4*)LNl)[i] = ((const f32x4*)(vec ? lnb : lng))[g4]; }
    LAS float* Ot = (LAS float*)(lds_ + 53248);
    (void)Ot;
    SpReg nx;
    if ((int)blockIdx.x < nunits) sp_load(nx, Z, VST, WS, bs, blockIdx.x, tid, lane, wid);
    for (int u = blockIdx.x; u < nunits; u += gridDim.x) {
        const int c = u >> 4, g = u & 15;
        const SpReg cur = nx;
        if (u + (int)gridDim.x < nunits) sp_load(nx, Z, VST, WS, bs, u + gridDim.x, tid, lane, wid);
        __syncthreads();
        {
            const int q = tid >> 2, dq = (tid & 3) * 32;
#pragma unroll
            for (int t = 0; t < 4; ++t) { const u32x4 w = cur.w[t];
                float v[8] = {bflo(w.x), bfhi(w.x), bflo(w.y), bfhi(w.y), bflo(w.z), bfhi(w.z), bflo(w.w), bfhi(w.w)};
                const LAS float* gp = LNl + g * 128 + dq + 8 * t; const LAS float* bp = LNl + 2048 + g * 128 + dq + 8 * t;
#pragma unroll
                for (int i = 0; i < 8; ++i) { const float vn = (v[i] - cur.mean) * cur.rstd * gp[i] + bp[i]; Vt[(dq + 8 * t + i) * VP + (q ^ ((tid & 3) << 4))] = tobf1(vn); } }
        }
        __syncthreads();
        const int fr = lane & 15, fq = lane >> 4;
#pragma unroll
        for (int nb = 0; nb < 8; ++nb) {
            f32x4 acc = {0.f, 0.f, 0.f, 0.f};
#pragma unroll
            for (int ks = 0; ks < 4; ++ks) { const bf16x8 b = *(const LAS bf16x8*)(Vt + (16 * nb + fr) * VP + 8 * ((4 * ks + fq) ^ ((nb >> 1) << 1)));
                acc = __builtin_amdgcn_mfma_f32_16x16x32_bf16(cur.a[ks], b, acc, 0, 0, 0); }
#if SPATIAL_OTILE
#pragma unroll
            for (int r = 0; r < 4; ++r) Ot[(16 * wid + fq * 4 + r) * 132 + 16 * nb + fr] = acc[r] + cur.bsv[r];
#else
#pragma unroll
            for (int r = 0; r < 4; ++r) { const int p = 16 * wid + fq * 4 + r, d = 16 * nb + fr; const size_t grow = (size_t)(c * 128 + p);
                const float sv = acc[r] + cur.bsv[r];
                const float uu = bf1(cur.uu[nb * 4 + r]);
                Gb[grow * 2048 + g * 128 + d] = tobf1(uu * sv); }
#endif
        }
#if SPATIAL_OTILE
        __syncthreads();
#pragma unroll
        for (int t = 0; t < 4; ++t) { const int ch = tid + 512 * t, p = ch >> 4, d8 = (ch & 15) * 8;
            const LAS f32x4* op = (const LAS f32x4*)(Ot + p * 132 + d8); const f32x4 s0 = op[0], s1 = op[1]; const u32x4 uw = cur.uq[t];
            u32x4 o; o.x = cvtpk(bflo(uw.x) * s0.x, bfhi(uw.x) * s0.y); o.y = cvtpk(bflo(uw.y) * s0.z, bfhi(uw.y) * s0.w); o.z = cvtpk(bflo(uw.z) * s1.x, bfhi(uw.z) * s1.y); o.w = cvtpk(bflo(uw.w) * s1.z, bfhi(uw.w) * s1.w);
            *(u32x4*)(Gb + (size_t)(c * 128 + p) * 2048 + g * 128 + d8) = o; }
#endif
    }
}
#else
__device__ __forceinline__ void spatial_phase(CP P, int j, int Mrows, LAS unsigned char* lds_, int tid, int lane, int wid) {
    const bf16* Z = (const bf16*)(P->ws + WS_Z); const float* VST = (const float*)(P->ws + WS_VST); bf16* Gb = (bf16*)(P->ws + WS_G);
    const bf16* WS = (const bf16*)(P->ws + WS_GMWS) + (size_t)j * 16 * 128 * 128;
    const float* lng = P->in[14] + (size_t)j * DM; const float* lnb = P->in[15] + (size_t)j * DM; const float* bs = P->in[17] + (size_t)j * 16 * 128;
    LAS bf16* Vt = (LAS bf16*)(LAS unsigned char*)lds_;
    constexpr int VP = 136;
    const int nunits = (Mrows / 128) * 16;
    for (int u = blockIdx.x; u < nunits; u += gridDim.x) {
        const int c = u >> 4, g = u & 15;
        __syncthreads();
        {
            const int q = tid >> 2, dq = (tid & 3) * 32; const int row = c * 128 + q;
            const float mean = VST[2 * row], rstd = VST[2 * row + 1];
            const bf16* src = Z + (size_t)row * 4096 + 2048 + g * 128 + dq;
#pragma unroll
            for (int t = 0; t < 4; ++t) { const u32x4 w = *(const u32x4*)(src + 8 * t);
                float v[8] = {bflo(w.x), bfhi(w.x), bflo(w.y), bfhi(w.y), bflo(w.z), bfhi(w.z), bflo(w.w), bfhi(w.w)};
                const float* gp = lng + g * 128 + dq + 8 * t; const float* bp = lnb + g * 128 + dq + 8 * t;
#pragma unroll
                for (int i = 0; i < 8; ++i) { const float vn = (v[i] - mean) * rstd * gp[i] + bp[i]; Vt[(dq + 8 * t + i) * VP + q] = tobf1(vn); } }
        }
        __syncthreads();
        const int fr = lane & 15, fq = lane >> 4;
        bf16x8 a[4];
        const bf16* wrow = WS + (size_t)g * 128 * 128 + (size_t)(16 * wid + fr) * 128 + 8 * fq;
#pragma unroll
        for (int ks = 0; ks < 4; ++ks) a[ks] = *(const bf16x8*)(wrow + 32 * ks);
#pragma unroll
        for (int nb = 0; nb < 8; ++nb) {
            f32x4 acc = {0.f, 0.f, 0.f, 0.f};
#pragma unroll
            for (int ks = 0; ks < 4; ++ks) { const bf16x8 b = *(const LAS bf16x8*)(Vt + (16 * nb + fr) * VP + 32 * ks + 8 * fq);
                acc = __builtin_amdgcn_mfma_f32_16x16x32_bf16(a[ks], b, acc, 0, 0, 0); }
#pragma unroll
            for (int r = 0; r < 4; ++r) { const int p = 16 * wid + fq * 4 + r, d = 16 * nb + fr; const size_t grow = (size_t)(c * 128 + p);
                const float sv = acc[r] + bs[g * 128 + p];
                const float uu = bf1(Z[grow * 4096 + g * 128 + d]);
                Gb[grow * 2048 + g * 128 + d] = tobf1(uu * sv); }
        }
    }
}
#endif

__device__ __forceinline__ void rope_cs(int row, int l, float& cs, float& sn) {
    const int t = row & (SEQ - 1); const int pos = (l & 32) ? (t & 63) : (t >> 6);
    const float inv = powf(10000.0f, -(float)(l & 15) * (1.0f / 16.0f));
    const float ang = (float)pos * inv; sincosf(ang, &sn, &cs);
}
__device__ __forceinline__ float rope_apply(float x, int l, float cs, float sn) {
    const float p = lane_xor16(x, l);
    return (l & 16) ? (p * sn + x * cs) : (x * cs - p * sn);
}
__device__ __forceinline__ void mla_norm_pass(CP P, int lane, int gw, int NGW) {
    const bf16* C = (const bf16*)(P->ws + WS_C); bf16* CQN = (bf16*)(P->ws + WS_CQN); bf16* CKVN = (bf16*)(P->ws + WS_CKVN); bf16* KR = (bf16*)(P->ws + WS_KR);
    const float* qn = P->in[20]; const float* kvn = P->in[21];
    for (int row = gw; row < MT; row += NGW) {
        const bf16* c = C + (size_t)row * 1280;
#pragma unroll
        for (int part = 0; part < 2; ++part) {
            const u32x4 w = *(const u32x4*)(c + part * 512 + 8 * lane);
            float v[8] = {bflo(w.x), bfhi(w.x), bflo(w.y), bfhi(w.y), bflo(w.z), bfhi(w.z), bflo(w.w), bfhi(w.w)};
            float ss = 0.f;
#pragma unroll
            for (int i = 0; i < 8; ++i) ss += v[i] * v[i];
            const float r = 1.0f / sqrtf(wave_sum(ss) * (1.0f / 512.0f) + LN_EPS);
            const float* nw = (part ? kvn : qn) + 8 * lane;
            u32x4 o; o.x = cvtpk(v[0] * r * nw[0], v[1] * r * nw[1]); o.y = cvtpk(v[2] * r * nw[2], v[3] * r * nw[3]); o.z = cvtpk(v[4] * r * nw[4], v[5] * r * nw[5]); o.w = cvtpk(v[6] * r * nw[6], v[7] * r * nw[7]);
            *(u32x4*)((part ? CKVN : CQN) + (size_t)row * 512 + 8 * lane) = o;
        }
        float x = bf1(c[1024 + lane]);
        if (row < ML) { float cs, sn; rope_cs(row, lane, cs, sn); x = rope_apply(x, lane, cs, sn); }
        KR[(size_t)row * 64 + lane] = tobf1(x);
    }
}
__device__ __forceinline__ void rope_pass(bf16* buf, int ld, int col0, int nchunks, int cstride, int lane, int gw, int NGW) {
    for (int row = gw; row < ML; row += NGW) {
        float cs, sn; rope_cs(row, lane, cs, sn);
        bf16* r = buf + (size_t)row * ld + col0 + lane;
#pragma unroll 4
        for (int k = 0; k < nchunks; ++k) { const float x = bf1(r[k * cstride]); r[k * cstride] = tobf1(rope_apply(x, lane, cs, sn)); }
    }
}

namespace att {
#ifndef ATT_LEAN
#define ATT_LEAN 1
#endif
#ifndef ATT_3STAGE
#define ATT_3STAGE 0
#endif
#ifndef ATT_QLATE
#define ATT_QLATE 1
#endif
#ifndef ATT_PRIO
#define ATT_PRIO 1
#endif
#ifndef ATT_KMAJOR
#define ATT_KMAJOR 0
#endif
#ifndef ATT_TRB
#define ATT_TRB 1
#endif
#ifndef ATT_STAGGER
#define ATT_STAGGER 0
#endif
#ifndef ATT_SDEPTH
#define ATT_SDEPTH(MODE) ((MODE) == 0 ? 1 : 1)
#endif
#ifndef ATT_PVPIPE
#define ATT_PVPIPE(MODE) ((MODE) == 1)
#endif
#define SBAR() __builtin_amdgcn_sched_barrier(0)
__device__ __forceinline__ int crow(int r, int hi) { return (r & 3) + 8 * (r >> 2) + 4 * hi; }
__device__ __forceinline__ unsigned cvtpkv(float lo, float hi) { unsigned r; asm volatile("v_cvt_pk_bf16_f32 %0, %1, %2" : "=v"(r) : "v"(lo), "v"(hi)); return r; }

__device__ __forceinline__ void partialSM(f32x16& p0, f32x16& p1, float& m_reg, float& mn, float& alpha, const float C, const float THRS) {
  float pmax = p0[0];
#pragma unroll
  for (int r = 1; r < 16; ++r) pmax = fmaxf(pmax, p0[r]);
#pragma unroll
  for (int r = 0; r < 16; ++r) pmax = fmaxf(pmax, p1[r]);
  { auto rr = __builtin_amdgcn_permlane32_swap(__float_as_uint(pmax), __float_as_uint(pmax), false, false);
    pmax = fmaxf(__uint_as_float(rr[0]), __uint_as_float(rr[1])); }
  if (__builtin_expect(__all(pmax - m_reg <= THRS), 1)) { mn = m_reg; alpha = 1.f; }
  else { mn = fmaxf(m_reg, pmax); alpha = __builtin_amdgcn_exp2f((m_reg - mn) * C); m_reg = mn; }
  const float mnC = -mn * C;
#pragma unroll
  for (int r = 0; r < 16; ++r) p0[r] = fmaf(p0[r], C, mnC);
#pragma unroll
  for (int r = 0; r < 16; ++r) p1[r] = fmaf(p1[r], C, mnC);
#pragma unroll
  for (int r = 0; r < 16; ++r) p0[r] = __builtin_amdgcn_exp2f(p0[r]);
}
__device__ __forceinline__ void finishSM(f32x16& p0, f32x16& p1, float alpha, float& l_reg, bf16x8& pa0, bf16x8& pa1, bf16x8& pa2, bf16x8& pa3) {
#pragma unroll
  for (int r = 0; r < 16; ++r) p1[r] = __builtin_amdgcn_exp2f(p1[r]);
  float ps = 0;
#pragma unroll
  for (int r = 0; r < 16; ++r) ps += p0[r];
#pragma unroll
  for (int r = 0; r < 16; ++r) ps += p1[r];
  { auto rr = __builtin_amdgcn_permlane32_swap(__float_as_uint(ps), __float_as_uint(ps), false, false);
    ps = __uint_as_float(rr[0]) + __uint_as_float(rr[1]); }
  l_reg = l_reg * alpha + ps;
#define PK4(P, BASE, OUT) do { unsigned a0 = cvtpkv(P[BASE + 0], P[BASE + 1]), a1 = cvtpkv(P[BASE + 2], P[BASE + 3]);   \
    unsigned b0 = cvtpkv(P[BASE + 4], P[BASE + 5]), b1 = cvtpkv(P[BASE + 6], P[BASE + 7]);                              \
    auto r0 = __builtin_amdgcn_permlane32_swap(a0, b0, false, false); auto r1 = __builtin_amdgcn_permlane32_swap(a1, b1, false, false); \
    u32x4 w = {r0[0], r1[0], r0[1], r1[1]}; OUT = *reinterpret_cast<bf16x8*>(&w); } while (0)
  PK4(p0, 0, pa0); PK4(p0, 8, pa1); PK4(p1, 0, pa2); PK4(p1, 8, pa3);
#undef PK4
}
__device__ __forceinline__ void partialSM_lean(f32x16& p0, f32x16& p1, f32x16& nm, float& alpha, const bool first) {
  constexpr float THR2 = 11.541560327111707f;
  float dmax = p0[0];
#pragma unroll
  for (int r = 1; r < 16; ++r) dmax = fmaxf(dmax, p0[r]);
#pragma unroll
  for (int r = 0; r < 16; ++r) dmax = fmaxf(dmax, p1[r]);
  { auto rr = __builtin_amdgcn_permlane32_swap(__float_as_uint(dmax), __float_as_uint(dmax), false, false);
    dmax = fmaxf(__uint_as_float(rr[0]), __uint_as_float(rr[1])); }
  alpha = 1.f;
  if (first || !__all(dmax <= THR2)) {
    const float delta = first ? dmax : (dmax > THR2 ? dmax : 0.f);
    if (!first) alpha = __builtin_amdgcn_exp2f(-delta);
#pragma unroll
    for (int r = 0; r < 16; ++r) { p0[r] -= delta; p1[r] -= delta; nm[r] -= delta; }
  }
#pragma unroll
  for (int r = 0; r < 16; ++r) p0[r] = __builtin_amdgcn_exp2f(p0[r]);
}
__device__ __forceinline__ void finishSM_lean(f32x16& p0, f32x16& p1, bf16x8& pa0, bf16x8& pa1, bf16x8& pa2, bf16x8& pa3) {
#pragma unroll
  for (int r = 0; r < 16; ++r) p1[r] = __builtin_amdgcn_exp2f(p1[r]);
#define PK4(P, BASE, OUT) do { unsigned a0 = cvtpkv(P[BASE + 0], P[BASE + 1]), a1 = cvtpkv(P[BASE + 2], P[BASE + 3]);   \
    unsigned b0 = cvtpkv(P[BASE + 4], P[BASE + 5]), b1 = cvtpkv(P[BASE + 6], P[BASE + 7]);                              \
    auto r0 = __builtin_amdgcn_permlane32_swap(a0, b0, false, false); auto r1 = __builtin_amdgcn_permlane32_swap(a1, b1, false, false); \
    u32x4 w = {r0[0], r1[0], r0[1], r1[1]}; OUT = *reinterpret_cast<bf16x8*>(&w); } while (0)
  PK4(p0, 0, pa0); PK4(p0, 8, pa1); PK4(p1, 0, pa2); PK4(p1, 8, pa3);
#undef PK4
}
__device__ __forceinline__ bf16x8 scale_bf16x8(bf16x8 v, float c) {
  const u32x4 w = *reinterpret_cast<u32x4*>(&v); u32x4 o;
  o.x = cvtpk(bflo(w.x) * c, bfhi(w.x) * c); o.y = cvtpk(bflo(w.y) * c, bfhi(w.y) * c); o.z = cvtpk(bflo(w.z) * c, bfhi(w.z) * c); o.w = cvtpk(bflo(w.w) * c, bfhi(w.w) * c);
  return *reinterpret_cast<bf16x8*>(&o);
}
template <int PITCH> __device__ __forceinline__ int kswz(int r) { return PITCH == 256 ? (r & 15) : ((r >> 1) & 7); }
template <int NQF, int NQR, int PITCH> __device__ __forceinline__ void qkt(f32x16& p0, f32x16& p1, const LAS char* Ks, int chunk0, const bf16x8* qr, const LAS char* ql, int r32, int hi, const f32x16 init = f32x16{}) {
  p0 = init; p1 = init;
  const int sw = kswz<PITCH>(r32);
#pragma unroll
  for (int d0 = 0; d0 < NQF; ++d0) { const int off = ((chunk0 + d0 * 2 + hi) ^ sw) * 16;
    const bf16x8 b0 = *(const LAS bf16x8*)(Ks + r32 * PITCH + off);
    const bf16x8 b1 = *(const LAS bf16x8*)(Ks + (32 + r32) * PITCH + off);
    const bf16x8 q = d0 < NQR ? qr[d0 < NQR ? d0 : 0] : *(const LAS bf16x8*)(ql + (d0 - NQR < 0 ? 0 : d0 - NQR) * 1024);
    p0 = __builtin_amdgcn_mfma_f32_32x32x16_bf16(b0, q, p0, 0, 0, 0);
    p1 = __builtin_amdgcn_mfma_f32_32x32x16_bf16(b1, q, p1, 0, 0, 0); }
}
__device__ __forceinline__ int v_st(int k, int c) { const int kk = (k & ~0xC) | ((k & 4) << 1) | ((k & 8) >> 1); return ((kk >> 3) * 4 + (c >> 5)) * 512 + ((kk & 7) * 32 + (c & 31)) * 2; }
__device__ __forceinline__ int v_rd_base(int lane) { return ((lane & 3) << 3) | (((lane >> 2) & 3) << 6) | (((lane >> 4) & 1) << 5) | (((lane >> 5) & 1) << 8); }
constexpr int v_rd_off(int d0, int ks, int half) { return d0 * 512 + ks * 4096 + half * 2048; }
template <int OFF> __device__ __forceinline__ s16x4 tr_read(int vb) {
  s16x4 r; asm volatile("ds_read_b64_tr_b16 %0, %1 offset:%2" : "=&v"(r) : "v"(vb), "i"(OFF) : "memory"); return r;
}
template <int D0> __device__ __forceinline__ void pv_one(f32x16& od, int vb, bf16x8 pa0, bf16x8 pa1, bf16x8 pa2, bf16x8 pa3) {
  const s16x4 l0 = tr_read<v_rd_off(D0, 0, 0)>(vb), h0 = tr_read<v_rd_off(D0, 0, 1)>(vb), l1 = tr_read<v_rd_off(D0, 1, 0)>(vb), h1 = tr_read<v_rd_off(D0, 1, 1)>(vb);
  const s16x4 l2 = tr_read<v_rd_off(D0, 2, 0)>(vb), h2 = tr_read<v_rd_off(D0, 2, 1)>(vb), l3 = tr_read<v_rd_off(D0, 3, 0)>(vb), h3 = tr_read<v_rd_off(D0, 3, 1)>(vb);
  asm volatile("s_waitcnt lgkmcnt(0)" ::: "memory"); SBAR();
#define PK(L, H) (bf16x8){L[0], L[1], L[2], L[3], H[0], H[1], H[2], H[3]}
  od = __builtin_amdgcn_mfma_f32_32x32x16_bf16(pa0, PK(l0, h0), od, 0, 0, 0);
  od = __builtin_amdgcn_mfma_f32_32x32x16_bf16(pa1, PK(l1, h1), od, 0, 0, 0);
  od = __builtin_amdgcn_mfma_f32_32x32x16_bf16(pa2, PK(l2, h2), od, 0, 0, 0);
  od = __builtin_amdgcn_mfma_f32_32x32x16_bf16(pa3, PK(l3, h3), od, 0, 0, 0);
#undef PK
}
__device__ __forceinline__ void pv_d0(f32x16* o, int vb, bf16x8 pa0, bf16x8 pa1, bf16x8 pa2, bf16x8 pa3) {
  pv_one<0>(o[0], vb, pa0, pa1, pa2, pa3); pv_one<1>(o[1], vb, pa0, pa1, pa2, pa3); pv_one<2>(o[2], vb, pa0, pa1, pa2, pa3); pv_one<3>(o[3], vb, pa0, pa1, pa2, pa3);
}
struct VFrag { s16x4 l0, h0, l1, h1, l2, h2, l3, h3; };
typedef short v4i16_t __attribute__((ext_vector_type(4)));
template <int OFF> __device__ __forceinline__ s16x4 tr_read_b(int vb) {
  return __builtin_bit_cast(s16x4, __builtin_amdgcn_ds_read_tr16_b64_v4i16((LAS v4i16_t*)(uintptr_t)(unsigned)(vb + OFF)));
}
template <int D0> __device__ __forceinline__ void tr8b(VFrag& f, int vb) {
  f.l0 = tr_read_b<v_rd_off(D0, 0, 0)>(vb); f.h0 = tr_read_b<v_rd_off(D0, 0, 1)>(vb); f.l1 = tr_read_b<v_rd_off(D0, 1, 0)>(vb); f.h1 = tr_read_b<v_rd_off(D0, 1, 1)>(vb);
  f.l2 = tr_read_b<v_rd_off(D0, 2, 0)>(vb); f.h2 = tr_read_b<v_rd_off(D0, 2, 1)>(vb); f.l3 = tr_read_b<v_rd_off(D0, 3, 0)>(vb); f.h3 = tr_read_b<v_rd_off(D0, 3, 1)>(vb);
}
template <int D0> __device__ __forceinline__ void tr8(VFrag& f, int vb) {
  f.l0 = tr_read<v_rd_off(D0, 0, 0)>(vb); f.h0 = tr_read<v_rd_off(D0, 0, 1)>(vb); f.l1 = tr_read<v_rd_off(D0, 1, 0)>(vb); f.h1 = tr_read<v_rd_off(D0, 1, 1)>(vb);
  f.l2 = tr_read<v_rd_off(D0, 2, 0)>(vb); f.h2 = tr_read<v_rd_off(D0, 2, 1)>(vb); f.l3 = tr_read<v_rd_off(D0, 3, 0)>(vb); f.h3 = tr_read<v_rd_off(D0, 3, 1)>(vb);
}
__device__ __forceinline__ void mfma4(f32x16& od, VFrag& f, bf16x8 pa0, bf16x8 pa1, bf16x8 pa2, bf16x8 pa3) {
#define PK(L, H) (bf16x8){L[0], L[1], L[2], L[3], H[0], H[1], H[2], H[3]}
  od = __builtin_amdgcn_mfma_f32_32x32x16_bf16(pa0, PK(f.l0, f.h0), od, 0, 0, 0);
  od = __builtin_amdgcn_mfma_f32_32x32x16_bf16(pa1, PK(f.l1, f.h1), od, 0, 0, 0);
  od = __builtin_amdgcn_mfma_f32_32x32x16_bf16(pa2, PK(f.l2, f.h2), od, 0, 0, 0);
  od = __builtin_amdgcn_mfma_f32_32x32x16_bf16(pa3, PK(f.l3, f.h3), od, 0, 0, 0);
#undef PK
}
#define VF_TIE(f) "+v"(f.l0), "+v"(f.h0), "+v"(f.l1), "+v"(f.h1), "+v"(f.l2), "+v"(f.h2), "+v"(f.l3), "+v"(f.h3)
__device__ __forceinline__ void pv_pipe(f32x16* o, int vb, bf16x8 pa0, bf16x8 pa1, bf16x8 pa2, bf16x8 pa3) {
  VFrag A, B;
  asm volatile("s_waitcnt lgkmcnt(0)" ::: "memory");
  tr8<0>(A, vb); tr8<1>(B, vb);
  asm volatile("s_waitcnt lgkmcnt(8)" : VF_TIE(A) :: "memory");
  mfma4(o[0], A, pa0, pa1, pa2, pa3);
  tr8<2>(A, vb);
  asm volatile("s_waitcnt lgkmcnt(8)" : VF_TIE(B) :: "memory");
  mfma4(o[1], B, pa0, pa1, pa2, pa3);
  tr8<3>(B, vb);
  asm volatile("s_waitcnt lgkmcnt(8)" : VF_TIE(A) :: "memory");
  mfma4(o[2], A, pa0, pa1, pa2, pa3);
  asm volatile("s_waitcnt lgkmcnt(0)" : VF_TIE(B) :: "memory");
  mfma4(o[3], B, pa0, pa1, pa2, pa3);
}
__device__ __forceinline__ void pv_psm_lean(f32x16* o, int vb, bf16x8 pa0, bf16x8 pa1, bf16x8 pa2, bf16x8 pa3, f32x16& p0, f32x16& p1, f32x16& nm, float& alpha) {
  constexpr float THR2 = 11.541560327111707f;
  const bf16x8 one8 = {0x3F80, 0x3F80, 0x3F80, 0x3F80, 0x3F80, 0x3F80, 0x3F80, 0x3F80};
  VFrag A, B;
  asm volatile("s_waitcnt lgkmcnt(0)" ::: "memory");
  tr8<0>(A, vb); tr8<1>(B, vb);
  asm volatile("s_waitcnt lgkmcnt(8)" : VF_TIE(A) :: "memory");
  mfma4(o[0], A, pa0, pa1, pa2, pa3);
  float dmax = p0[0];
#pragma unroll
  for (int r = 1; r < 16; ++r) dmax = fmaxf(dmax, p0[r]);
  tr8<2>(A, vb);
  asm volatile("s_waitcnt lgkmcnt(8)" : VF_TIE(B) :: "memory");
  mfma4(o[1], B, pa0, pa1, pa2, pa3);
#pragma unroll
  for (int r = 0; r < 16; ++r) dmax = fmaxf(dmax, p1[r]);
  { auto rr = __builtin_amdgcn_permlane32_swap(__float_as_uint(dmax), __float_as_uint(dmax), false, false);
    dmax = fmaxf(__uint_as_float(rr[0]), __uint_as_float(rr[1])); }
  alpha = 1.f;
  if (!__all(dmax <= THR2)) {
    const float delta = dmax > THR2 ? dmax : 0.f; alpha = __builtin_amdgcn_exp2f(-delta);
#pragma unroll
    for (int r = 0; r < 16; ++r) { p0[r] -= delta; p1[r] -= delta; nm[r] -= delta; }
  }
  tr8<3>(B, vb);
  asm volatile("s_waitcnt lgkmcnt(8)" : VF_TIE(A) :: "memory");
  mfma4(o[2], A, pa0, pa1, pa2, pa3);
#pragma unroll
  for (int r = 0; r < 8; ++r) p0[r] = __builtin_amdgcn_exp2f(p0[r]);
  asm volatile("s_waitcnt lgkmcnt(0)" : VF_TIE(B) :: "memory");
  mfma4(o[3], B, pa0, pa1, pa2, pa3);
#pragma unroll
  for (int r = 8; r < 16; ++r) p0[r] = __builtin_amdgcn_exp2f(p0[r]);
  o[4] = __builtin_amdgcn_mfma_f32_32x32x16_bf16(pa0, one8, o[4], 0, 0, 0); o[4] = __builtin_amdgcn_mfma_f32_32x32x16_bf16(pa1, one8, o[4], 0, 0, 0);
  o[4] = __builtin_amdgcn_mfma_f32_32x32x16_bf16(pa2, one8, o[4], 0, 0, 0); o[4] = __builtin_amdgcn_mfma_f32_32x32x16_bf16(pa3, one8, o[4], 0, 0, 0);
}
__device__ __forceinline__ void pv_psm_lean_b(f32x16* o, int vb, bf16x8 pa0, bf16x8 pa1, bf16x8 pa2, bf16x8 pa3, f32x16& p0, f32x16& p1, f32x16& nm, float& alpha) {
  constexpr float THR2 = 11.541560327111707f;
  const bf16x8 one8 = {0x3F80, 0x3F80, 0x3F80, 0x3F80, 0x3F80, 0x3F80, 0x3F80, 0x3F80};
  VFrag A, B;
  tr8b<0>(A, vb); tr8b<1>(B, vb);
  mfma4(o[0], A, pa0, pa1, pa2, pa3);
  float dmax = p0[0];
#pragma unroll
  for (int r = 1; r < 16; ++r) dmax = fmaxf(dmax, p0[r]);
  tr8b<2>(A, vb);
  mfma4(o[1], B, pa0, pa1, pa2, pa3);
#pragma unroll
  for (int r = 0; r < 16; ++r) dmax = fmaxf(dmax, p1[r]);
  { auto rr = __builtin_amdgcn_permlane32_swap(__float_as_uint(dmax), __float_as_uint(dmax), false, false);
    dmax = fmaxf(__uint_as_float(rr[0]), __uint_as_float(rr[1])); }
  alpha = 1.f;
  if (!__all(dmax <= THR2)) {
    const float delta = dmax > THR2 ? dmax : 0.f; alpha = __builtin_amdgcn_exp2f(-delta);
#pragma unroll
    for (int r = 0; r < 16; ++r) { p0[r] -= delta; p1[r] -= delta; nm[r] -= delta; }
  }
  tr8b<3>(B, vb);
  mfma4(o[2], A, pa0, pa1, pa2, pa3);
#pragma unroll
  for (int r = 0; r < 8; ++r) p0[r] = __builtin_amdgcn_exp2f(p0[r]);
  mfma4(o[3], B, pa0, pa1, pa2, pa3);
#pragma unroll
  for (int r = 8; r < 16; ++r) p0[r] = __builtin_amdgcn_exp2f(p0[r]);
  o[4] = __builtin_amdgcn_mfma_f32_32x32x16_bf16(pa0, one8, o[4], 0, 0, 0); o[4] = __builtin_amdgcn_mfma_f32_32x32x16_bf16(pa1, one8, o[4], 0, 0, 0);
  o[4] = __builtin_amdgcn_mfma_f32_32x32x16_bf16(pa2, one8, o[4], 0, 0, 0); o[4] = __builtin_amdgcn_mfma_f32_32x32x16_bf16(pa3, one8, o[4], 0, 0, 0);
}
struct VStep { s16x4 l0, h0, l1, h1, l2, h2, l3, h3; };
template <int KS> __device__ __forceinline__ void trstep(VStep& f, int vb) {
  f.l0 = tr_read_b<v_rd_off(0, KS, 0)>(vb); f.h0 = tr_read_b<v_rd_off(0, KS, 1)>(vb); f.l1 = tr_read_b<v_rd_off(1, KS, 0)>(vb); f.h1 = tr_read_b<v_rd_off(1, KS, 1)>(vb);
  f.l2 = tr_read_b<v_rd_off(2, KS, 0)>(vb); f.h2 = tr_read_b<v_rd_off(2, KS, 1)>(vb); f.l3 = tr_read_b<v_rd_off(3, KS, 0)>(vb); f.h3 = tr_read_b<v_rd_off(3, KS, 1)>(vb);
}
__device__ __forceinline__ void mfma5(f32x16* o, const VStep& f, bf16x8 pa) {
  const bf16x8 one8 = {0x3F80, 0x3F80, 0x3F80, 0x3F80, 0x3F80, 0x3F80, 0x3F80, 0x3F80};
#define PK(L, H) (bf16x8){L[0], L[1], L[2], L[3], H[0], H[1], H[2], H[3]}
  o[0] = __builtin_amdgcn_mfma_f32_32x32x16_bf16(pa, PK(f.l0, f.h0), o[0], 0, 0, 0);
  o[1] = __builtin_amdgcn_mfma_f32_32x32x16_bf16(pa, PK(f.l1, f.h1), o[1], 0, 0, 0);
  o[2] = __builtin_amdgcn_mfma_f32_32x32x16_bf16(pa, PK(f.l2, f.h2), o[2], 0, 0, 0);
  o[3] = __builtin_amdgcn_mfma_f32_32x32x16_bf16(pa, PK(f.l3, f.h3), o[3], 0, 0, 0);
  o[4] = __builtin_amdgcn_mfma_f32_32x32x16_bf16(pa, one8, o[4], 0, 0, 0);
#undef PK
}
template <int BASE> __device__ __forceinline__ bf16x8 pk4e(const f32x16& P) {
  const float e0 = __builtin_amdgcn_exp2f(P[BASE + 0]), e1 = __builtin_amdgcn_exp2f(P[BASE + 1]), e2 = __builtin_amdgcn_exp2f(P[BASE + 2]), e3 = __builtin_amdgcn_exp2f(P[BASE + 3]);
  const float e4 = __builtin_amdgcn_exp2f(P[BASE + 4]), e5 = __builtin_amdgcn_exp2f(P[BASE + 5]), e6 = __builtin_amdgcn_exp2f(P[BASE + 6]), e7 = __builtin_amdgcn_exp2f(P[BASE + 7]);
  const unsigned a0 = cvtpk(e0, e1), a1 = cvtpk(e2, e3), b0 = cvtpk(e4, e5), b1 = cvtpk(e6, e7);
  const auto r0 = __builtin_amdgcn_permlane32_swap(a0, b0, false, false); const auto r1 = __builtin_amdgcn_permlane32_swap(a1, b1, false, false);
  u32x4 w = {r0[0], r1[0], r0[1], r1[1]}; return *reinterpret_cast<bf16x8*>(&w);
}
__device__ __forceinline__ float rowmax_lean(const f32x16& p0, const f32x16& p1) {
  float d = p0[0];
#pragma unroll
  for (int r = 1; r < 16; ++r) d = fmaxf(d, p0[r]);
#pragma unroll
  for (int r = 0; r < 16; ++r) d = fmaxf(d, p1[r]);
  const auto rr = __builtin_amdgcn_permlane32_swap(__float_as_uint(d), __float_as_uint(d), false, false);
  return fmaxf(__uint_as_float(rr[0]), __uint_as_float(rr[1]));
}
__device__ __forceinline__ void shift_lean(float dmax, f32x16& p0, f32x16& p1, f32x16& nm, float& alpha, const bool first) {
  constexpr float THR2 = 11.541560327111707f;
  alpha = 1.f;
  if (first || !__all(dmax <= THR2)) {
    const float delta = first ? dmax : (dmax > THR2 ? dmax : 0.f);
    if (!first) alpha = __builtin_amdgcn_exp2f(-delta);
#pragma unroll
    for (int r = 0; r < 16; ++r) { p0[r] -= delta; p1[r] -= delta; nm[r] -= delta; }
  }
}
#define SGB(mask, n) __builtin_amdgcn_sched_group_barrier((mask), (n), 0)
__device__ __forceinline__ bf16x8 ld8(const bf16* p) { return *reinterpret_cast<const bf16x8*>(p); }

template <int MODE, int ATTV = 0>
__device__ __forceinline__ void attn_unit(const bf16* __restrict__ Qrow0, int ldq, const bf16* __restrict__ Kb, const bf16* __restrict__ Vb, int ldk, const bf16* __restrict__ KRb,
                                          int b, int nct, int NT, bf16* __restrict__ Ob, float lam, const float* __restrict__ subln, float oscale, LAS unsigned char* lds_, const int tid_in) {
  constexpr bool LEAN = (MODE == 1) && ATT_LEAN; constexpr int NQF = MODE == 0 ? 12 : 4, NQR = MODE == 0 ? 4 : 0, NOB = LEAN ? 5 : 4, PITCH = MODE == 0 ? 384 : 256, SHM_V = 16384, SHM_K = 64 * PITCH, SDEPTH = ATT_SDEPTH(MODE); constexpr bool PVPIPE = ATT_PVPIPE(MODE);
  const float SCALE = MODE == 0 ? 0.07216878364870323f : 0.125f;
  const float C = SCALE * 1.4426950408889634f, THRS = 8.f / SCALE;
  if (ATT_PRIO) { if (__builtin_amdgcn_readfirstlane(tid_in >> 8) != 0) __builtin_amdgcn_s_setprio(1); }
  const int tid = launder_v(tid_in) & 511, wid = tid >> 6, lane = tid & 63, r32 = lane & 31, hi = lane >> 5;
  LAS char* lds = (LAS char*)(LAS unsigned char*)lds_;
  constexpr bool THREE = (MODE == 1) && ATT_3STAGE; constexpr int NSTG = THREE ? 3 : 2, STG = SHM_V + SHM_K, SCR0 = NSTG * STG;
#define VOFF(s) (!THREE ? (s) * SHM_V : (s) * STG)
#define KOFF(s) (!THREE ? 2 * SHM_V + (s) * SHM_K : (s) * STG + SHM_V)
  LAS char* V_lds = lds; LAS char* K_lds = lds;
  LAS float* wsf = (LAS float*)(lds + NSTG * (SHM_V + SHM_K)) + wid * 64; LAS float* li_l = wsf; LAS float* al_l = wsf + 32;
  const int wq = MODE == 0 ? wid : (wid & 3), sgrp = MODE == 0 ? 0 : (wid >> 2);
  float m_reg = -1e30f, l_reg = 0; f32x16 o[NOB] = {}; bf16x8 qr[NQR > 0 ? NQR : 1]; f32x16 nm = {};
  LAS char* ql = lds + SCR0 + 2048 + wid * (MODE == 0 ? 8192 : 4096) + lane * 16;
  const bf16* Qw = Qrow0 + (size_t)(wq * 32 + r32) * ldq + sgrp * 64 + hi * 8;
#define QLOADS() do { _Pragma("unroll") for (int d0 = 0; d0 < NQR; ++d0) qr[d0] = ld8(Qw + d0 * 16); \
    _Pragma("unroll") for (int d0 = NQR; d0 < NQF; ++d0) { bf16x8 qv = ld8(Qw + d0 * 16); if (LEAN) qv = scale_bf16x8(qv, C); *(LAS bf16x8*)(ql + (d0 - NQR) * 1024) = qv; } } while (0)
  constexpr bool QLATE = ATT_QLATE && !((MODE == 1) && ATT_3STAGE) && !((MODE == 1) && ATT_LEAN && ATT_KMAJOR && (ATTV == 0));
  if (!QLATE) QLOADS();
  const int sr = tid >> 4, sc = (tid & 15) * 8, vst0 = v_st(sr, sc), vst1 = v_st(32 + sr, sc);
  const int kst0 = sr * PITCH + (((tid & 15) ^ kswz<PITCH>(sr)) * 16), kst1 = kst0 + 32 * PITCH;
  const int rrow = tid >> 3, krs = rrow * PITCH + (((16 + (tid & 7)) ^ kswz<PITCH>(rrow)) * 16);
  const int chunk0 = sgrp * 8;
  const int vb0 = (int)(uintptr_t)V_lds + v_rd_base(lane);
  struct Slot { bf16x8 vs0, vs1, ks0, ks1, kr; } sr_[SDEPTH];
#define KROW(jt) ((jt) < nct ? (ML + b * CTXL + (jt) * 64) : (b * SEQ + ((jt) - nct) * 64))
#define SLOAD(i, jt) do { const int k0_ = KROW(jt); sr_[i].vs0 = ld8(Vb + (size_t)(k0_ + sr) * ldk + sc); sr_[i].vs1 = ld8(Vb + (size_t)(k0_ + 32 + sr) * ldk + sc); \
    sr_[i].ks0 = ld8(Kb + (size_t)(k0_ + sr) * ldk + sc); sr_[i].ks1 = ld8(Kb + (size_t)(k0_ + 32 + sr) * ldk + sc); \
    if (MODE == 0) sr_[i].kr = ld8(KRb + (size_t)(k0_ + rrow) * 64 + (tid & 7) * 8); } while (0)
#define SWRITE(bf, i) do { *(LAS bf16x8*)(V_lds + VOFF(bf) + vst0) = sr_[i].vs0; *(LAS bf16x8*)(V_lds + VOFF(bf) + vst1) = sr_[i].vs1; \
    *(LAS bf16x8*)(K_lds + KOFF(bf) + kst0) = sr_[i].ks0; *(LAS bf16x8*)(K_lds + KOFF(bf) + kst1) = sr_[i].ks1; \
    if (MODE == 0) *(LAS bf16x8*)(K_lds + KOFF(bf) + krs) = sr_[i].kr; } while (0)
#define SWAIT() do { if constexpr (SDEPTH == 2) asm volatile("s_waitcnt vmcnt(4)" ::: "memory"); else asm volatile("s_waitcnt vmcnt(0)" ::: "memory"); } while (0)
#define RESC(a) do { if (__any((a) < 1.f)) { if (hi == 0) al_l[r32] = (a); asm volatile("s_waitcnt lgkmcnt(0)" ::: "memory"); \
    _Pragma("unroll") for (int d = 0; d < NOB; ++d) _Pragma("unroll") for (int r = 0; r < 16; ++r) o[d][r] *= al_l[crow(r, hi)]; } } while (0)
#define PV(vb_) do { if constexpr (ATTV == 2) { o[0][0] += __uint_as_float((unsigned)pa0[0] + (unsigned)pa3[1]); } else if constexpr (PVPIPE) pv_pipe(o, (vb_), pa0, pa1, pa2, pa3); else pv_d0(o, (vb_), pa0, pa1, pa2, pa3); \
    if constexpr (LEAN) { const bf16x8 one8 = {0x3F80, 0x3F80, 0x3F80, 0x3F80, 0x3F80, 0x3F80, 0x3F80, 0x3F80};     \
        o[NOB - 1] = __builtin_amdgcn_mfma_f32_32x32x16_bf16(pa0, one8, o[NOB - 1], 0, 0, 0); o[NOB - 1] = __builtin_amdgcn_mfma_f32_32x32x16_bf16(pa1, one8, o[NOB - 1], 0, 0, 0); \
        o[NOB - 1] = __builtin_amdgcn_mfma_f32_32x32x16_bf16(pa2, one8, o[NOB - 1], 0, 0, 0); o[NOB - 1] = __builtin_amdgcn_mfma_f32_32x32x16_bf16(pa3, one8, o[NOB - 1], 0, 0, 0); } } while (0)
#define PSM(p0_, p1_, mn_, al_, first_) do { if constexpr (ATTV == 1) { al_ = 1.f; } else if constexpr (LEAN) partialSM_lean(p0_, p1_, nm, al_, first_); else partialSM(p0_, p1_, m_reg, mn_, al_, C, THRS); } while (0)
#define FSM(p0_, p1_, al_) do { if constexpr (ATTV == 1) { u32x4 w0_ = {__float_as_uint(p0_[0]), __float_as_uint(p0_[1]), __float_as_uint(p1_[0]), __float_as_uint(p1_[1])}; pa0 = pa1 = pa2 = pa3 = *reinterpret_cast<bf16x8*>(&w0_); } else if constexpr (LEAN) finishSM_lean(p0_, p1_, pa0, pa1, pa2, pa3); else finishSM(p0_, p1_, al_, l_reg, pa0, pa1, pa2, pa3); } while (0)
#define QKT(p0_, p1_, Kp_) do { if constexpr (ATTV == 5) { p0_ = nm; p1_ = nm; p0_[0] += (float)r32; } else if constexpr (LEAN) qkt<NQF, NQR, PITCH>(p0_, p1_, Kp_, chunk0, qr, ql, r32, hi, nm); else qkt<NQF, NQR, PITCH>(p0_, p1_, Kp_, chunk0, qr, ql, r32, hi); } while (0)
  f32x16 pA0, pA1, pB0, pB1; float mnA, mnB, alA, alB; bf16x8 pa0, pa1, pa2, pa3;
  constexpr bool KMAJ = (MODE == 1) && LEAN && ATT_KMAJOR && (ATTV == 0) && !THREE;
  if constexpr (KMAJ) {
    VStep VA, VB;
#define KSTEPS(PC0, PC1, ALC, PP0, PP1, KC, VP, LD, DOQK) do { const int vb_ = vb0 + VOFF(VP); float dmx_ = 0.f; \
      SBAR(); \
      if (DOQK) QKT(PC0, PC1, K_lds + KOFF(KC)); \
      pa0 = pk4e<0>(PP0); trstep<0>(VA, vb_); \
      _Pragma("unroll") for (int i_ = 0; i_ < 8; ++i_) { SGB(0x008, 1); SGB(0x100, 3); SGB(0x002, 2); } \
      SBAR(); LD; SBAR(); \
      mfma5(o, VA, pa0); pa1 = pk4e<8>(PP0); trstep<1>(VB, vb_); \
      _Pragma("unroll") for (int i_ = 0; i_ < 5; ++i_) { SGB(0x008, 1); SGB(0x100, 2); SGB(0x002, 3); } \
      SBAR(); \
      mfma5(o, VB, pa1); pa2 = pk4e<0>(PP1); trstep<2>(VA, vb_); \
      _Pragma("unroll") for (int i_ = 0; i_ < 5; ++i_) { SGB(0x008, 1); SGB(0x100, 2); SGB(0x002, 3); } \
      SBAR(); \
      mfma5(o, VA, pa2); pa3 = pk4e<8>(PP1); trstep<3>(VB, vb_); \
      _Pragma("unroll") for (int i_ = 0; i_ < 5; ++i_) { SGB(0x008, 1); SGB(0x100, 2); SGB(0x002, 3); } \
      SBAR(); \
      mfma5(o, VB, pa3); if (DOQK) dmx_ = rowmax_lean(PC0, PC1); \
      _Pragma("unroll") for (int i_ = 0; i_ < 5; ++i_) { SGB(0x008, 1); SGB(0x002, 7); } \
      SBAR(); \
      if (DOQK) shift_lean(dmx_, PC0, PC1, nm, ALC, false); } while (0)
    SLOAD(0, 0); asm volatile("s_waitcnt vmcnt(0)" ::: "memory"); SWRITE(0, 0); __syncthreads();
    QKT(pA0, pA1, K_lds + KOFF(0)); shift_lean(rowmax_lean(pA0, pA1), pA0, pA1, nm, alA, true);
    SLOAD(0, 1); asm volatile("s_waitcnt vmcnt(0)" ::: "memory"); SWRITE(1, 0); __syncthreads();
    for (int j = 1; j + 1 < NT; j += 2) {
      KSTEPS(pB0, pB1, alB, pA0, pA1, 1, 0, SLOAD(0, j + 1), true);
      __syncthreads(); asm volatile("s_waitcnt vmcnt(0)" ::: "memory"); SWRITE(0, 0);
      RESC(alB); __syncthreads();
      KSTEPS(pA0, pA1, alA, pB0, pB1, 0, 1, SLOAD(0, j + 2), true);
      __syncthreads(); asm volatile("s_waitcnt vmcnt(0)" ::: "memory"); SWRITE(1, 0);
      RESC(alA); __syncthreads();
    }
    KSTEPS(pB0, pB1, alB, pA0, pA1, 1, 0, (void)0, true);
    __syncthreads(); RESC(alB);
    KSTEPS(pA0, pA1, alA, pB0, pB1, 0, 1, (void)0, false);
#undef KSTEPS
  } else if constexpr (!THREE) {
  constexpr int SE = 0, SO = SDEPTH - 1;
  SLOAD(SE, 0); if (QLATE) QLOADS(); asm volatile("s_waitcnt vmcnt(0)" ::: "memory"); SWRITE(0, SE);
  if constexpr (QLATE && SDEPTH == 1) SLOAD(SO, 1);
  __syncthreads();
  QKT(pA0, pA1, K_lds + KOFF(0)); PSM(pA0, pA1, mnA, alA, true);
  if constexpr (!(QLATE && SDEPTH == 1)) SLOAD(SO, 1);
  if constexpr (SDEPTH == 2) { if (2 < NT) SLOAD(SE, 2); }
  SWAIT(); SWRITE(1, SO); __syncthreads();
#define ILV() do { if constexpr (PVPIPE) { _Pragma("unroll") for (int i_ = 0; i_ < 20; ++i_) { __builtin_amdgcn_sched_group_barrier(0x008, 1, 0); __builtin_amdgcn_sched_group_barrier(0x002, 5, 0); } } } while (0)
#define LSLOAD(i, jt) do { if constexpr (ATTV != 3) SLOAD(i, jt); } while (0)
#define LSWRITE(bf, i) do { if constexpr (ATTV != 3) SWRITE(bf, i); } while (0)
#define LSWAIT() do { if constexpr (ATTV != 3) SWAIT(); } while (0)
#define LSYNC() do { if constexpr (ATTV != 4) __syncthreads(); } while (0)
#define HALFSTEP(PC0, PC1, MNC, ALC, PP0, PP1, ALP, KC, VP, LD) do { \
    if (!STAG || wid < 4) { \
      SBAR(); QKT(PC0, PC1, K_lds + KOFF(KC)); FSM(PP0, PP1, ALP); SBAR(); \
      LD; SBAR(); \
      if constexpr (PVPIPE && LEAN && ATTV == 0) { if constexpr (ATT_TRB) pv_psm_lean_b(o, vb0 + VOFF(VP), pa0, pa1, pa2, pa3, PC0, PC1, nm, ALC); else pv_psm_lean(o, vb0 + VOFF(VP), pa0, pa1, pa2, pa3, PC0, PC1, nm, ALC); } else { PV(vb0 + VOFF(VP)); PSM(PC0, PC1, MNC, ALC, false); } \
    } else { \
      SBAR(); FSM(PP0, PP1, ALP); SBAR(); \
      LD; SBAR(); \
      PV(vb0 + VOFF(VP)); SBAR(); \
      QKT(PC0, PC1, K_lds + KOFF(KC)); SBAR(); \
      PSM(PC0, PC1, MNC, ALC, false); \
    } } while (0)
  constexpr bool STAG = (MODE == 1) && ATT_STAGGER && ATTV == 0;
  for (int j = 1; j + 1 < NT; j += 2) {
    HALFSTEP(pB0, pB1, mnB, alB, pA0, pA1, alA, 1, 0, LSLOAD(SO, j + SDEPTH));
    LSYNC(); LSWAIT(); LSWRITE(0, SE);
    RESC(alB); LSYNC();
    HALFSTEP(pA0, pA1, mnA, alA, pB0, pB1, alB, 0, 1, if (SDEPTH == 1 || j + 3 < NT) LSLOAD(SE, j + 1 + SDEPTH));
    LSYNC(); LSWAIT(); LSWRITE(1, SO);
    RESC(alA); LSYNC();
  }
#undef HALFSTEP
#undef ILV
#undef LSLOAD
#undef LSWRITE
#undef LSWAIT
#undef LSYNC
  SBAR(); QKT(pB0, pB1, K_lds + KOFF(1));
  FSM(pA0, pA1, alA); SBAR();
  PV(vb0); PSM(pB0, pB1, mnB, alB, false);
  __syncthreads(); RESC(alB);
  FSM(pB0, pB1, alB); SBAR();
  PV(vb0 + VOFF(1));
  } else {
#define STEP(PC0, PC1, ALC, PP0, PP1, ALP, jj, SP, SC, SN) do { const int j_ = (jj); \
      if (j_ + 1 < NT) { asm volatile("s_waitcnt vmcnt(0)" ::: "memory"); SWRITE(SN, 0); if (j_ + 2 < NT) SLOAD(0, j_ + 2); } \
      SBAR(); QKT(PC0, PC1, K_lds + KOFF(SC)); FSM(PP0, PP1, ALP); SBAR(); \
      PV(vb0 + VOFF(SP)); PSM(PC0, PC1, mnA, ALC, false); \
      RESC(ALC); __syncthreads(); } while (0)
    SLOAD(0, 0); asm volatile("s_waitcnt vmcnt(0)" ::: "memory"); SWRITE(0, 0);
    SLOAD(0, 1); asm volatile("s_waitcnt vmcnt(0)" ::: "memory"); SWRITE(1, 0);
    SLOAD(0, 2); __syncthreads();
    QKT(pA0, pA1, K_lds + KOFF(0)); PSM(pA0, pA1, mnA, alA, true);
    STEP(pB0, pB1, alB, pA0, pA1, alA, 1, 0, 1, 2);
    int j = 2;
    for (; j + 5 < NT; j += 6) {
      STEP(pA0, pA1, alA, pB0, pB1, alB, j, 1, 2, 0);
      STEP(pB0, pB1, alB, pA0, pA1, alA, j + 1, 2, 0, 1);
      STEP(pA0, pA1, alA, pB0, pB1, alB, j + 2, 0, 1, 2);
      STEP(pB0, pB1, alB, pA0, pA1, alA, j + 3, 1, 2, 0);
      STEP(pA0, pA1, alA, pB0, pB1, alB, j + 4, 2, 0, 1);
      STEP(pB0, pB1, alB, pA0, pA1, alA, j + 5, 0, 1, 2);
    }
    if (j < NT) { STEP(pA0, pA1, alA, pB0, pB1, alB, j, 1, 2, 0); STEP(pB0, pB1, alB, pA0, pA1, alA, j + 1, 2, 0, 1); j += 2; }
    if (j < NT) { STEP(pA0, pA1, alA, pB0, pB1, alB, j, 0, 1, 2); STEP(pB0, pB1, alB, pA0, pA1, alA, j + 1, 1, 2, 0); j += 2; }
    FSM(pB0, pB1, alB); SBAR();
    { const int sl = (NT - 1) % 3; PV(vb0 + VOFF(sl)); }
#undef STEP
  }
  float rli[16];
  if constexpr (LEAN) {
#pragma unroll
    for (int r = 0; r < 16; ++r) rli[r] = __builtin_amdgcn_rcpf(o[NOB - 1][r]);
  } else {
    if (hi == 0) li_l[r32] = l_reg; asm volatile("s_waitcnt lgkmcnt(0)" ::: "memory");
#pragma unroll
    for (int r = 0; r < 16; ++r) rli[r] = __builtin_amdgcn_rcpf(li_l[crow(r, hi)]);
  }
  bf16* Ow = Ob + (size_t)(wq * 32) * DM;
  if constexpr (MODE == 0) {
#pragma unroll
    for (int r = 0; r < 16; ++r) { const int orow = crow(r, hi);
#pragma unroll
      for (int d0 = 0; d0 < 4; ++d0) Ow[(size_t)orow * DM + d0 * 32 + r32] = tobf1(o[d0][r] * rli[r]); }
    __syncthreads();
  } else {
    LAS float* ex = (LAS float*)lds;
    __syncthreads();
    if (sgrp == 1) {
#pragma unroll
      for (int r = 0; r < 16; ++r)
#pragma unroll
        for (int d0 = 0; d0 < 4; ++d0) ex[(wq * 32 + crow(r, hi)) * 128 + d0 * 32 + r32] = o[d0][r] * rli[r];
    }
    __syncthreads();
    if (sgrp == 0) {
#pragma unroll
      for (int r = 0; r < 16; ++r) { const int orow = crow(r, hi); float dd[4]; float ss = 0.f;
#pragma unroll
        for (int d0 = 0; d0 < 4; ++d0) { dd[d0] = o[d0][r] * rli[r] - lam * ex[(wq * 32 + orow) * 128 + d0 * 32 + r32]; ss += dd[d0] * dd[d0]; }
        ss = half_sum32(ss);
        const float rs = oscale / sqrtf(ss * (1.0f / 128.0f) + LN_EPS);
#pragma unroll
        for (int d0 = 0; d0 < 4; ++d0) Ow[(size_t)orow * DM + d0 * 32 + r32] = tobf1(dd[d0] * rs * subln[d0 * 32 + r32]); }
    }
    __syncthreads();
  }
  if (ATT_PRIO) __builtin_amdgcn_s_setprio(0);
#undef VOFF
#undef KOFF
#undef PV
#undef PSM
#undef FSM
#undef QKT
#undef KROW
#undef SLOAD
#undef SWRITE
#undef SWAIT
#undef RESC
}
}

__device__ __forceinline__ void mla_attn_phase(CP P, LAS unsigned char* lds, const int tid) {
    const bf16* QM = (const bf16*)(P->ws + WS_QM); const bf16* KV = (const bf16*)(P->ws + WS_KV); const bf16* KR = (const bf16*)(P->ws + WS_KR); bf16* Gb = (bf16*)(P->ws + WS_G);
    const int c = blockIdx.x, G = gridDim.x;
    for (int u = c; u < 1024 + 32; u += G) {
        int b, h, qrow0, NT;
        if (u < 1024) { const int i = u >> 8, cc = u & 255; const int bh = (cc & 7) + 8 * i, qb = cc >> 3; b = bh >> 4; h = bh & 15; qrow0 = b * SEQ + qb * 256; NT = 4 + 128; }
        else { const int bh = u - 1024; b = bh >> 4; h = bh & 15; qrow0 = ML + b * CTXL; NT = 4; }
        att::attn_unit<0>(QM + (size_t)qrow0 * 3072 + h * 192, 3072, KV + h * 256, KV + h * 256 + 128, 4096, KR, b, 4, NT, Gb + (size_t)qrow0 * DM + h * 128, 0.f, nullptr, 1.f, lds, tid);
    }
}
template <int ATTV = 0>
__device__ __forceinline__ void da_attn_phase(CP P, float lam, float oscale, LAS unsigned char* lds, const int tid, const bool ctx_q, const int nt_cap = 0) {
    const bf16* Z = (const bf16*)(P->ws + WS_Z); bf16* Gb = (bf16*)(P->ws + WS_G); const float* subln = P->in[27];
    const int c = blockIdx.x, G = gridDim.x;
    for (int u = c; u < 2048 + (ctx_q ? 64 : 0); u += G) {
        int b, h, qrow0, NT;
        if (u < 2048) { const int i = u >> 8, cc = u & 255; const int bh = (cc & 7) + 8 * (i >> 1), qb = (cc >> 3) + 32 * (i & 1); b = bh >> 4; h = bh & 15; qrow0 = b * SEQ + qb * 128; NT = 4 + 128; }
        else { const int v = u - 2048; const int bh = v >> 1; b = bh >> 4; h = bh & 15; qrow0 = ML + b * CTXL + (v & 1) * 128; NT = 4; }
        if (nt_cap) NT = nt_cap;
        att::attn_unit<1, ATTV>(Z + (size_t)qrow0 * 6144 + h * 128, 6144, Z + 2048 + h * 128, Z + 4096 + h * 128, 6144, nullptr, b, 4, NT, Gb + (size_t)qrow0 * DM + h * 128, lam, subln, oscale, lds, tid);
    }
}

__device__ __forceinline__ unsigned f2ord(float f) { const unsigned u = __float_as_uint(f); return u ^ ((unsigned)((int)u >> 31) | 0x80000000u); }
__device__ __forceinline__ float ord2f(unsigned k) { return __uint_as_float((k & 0x80000000u) ? (k ^ 0x80000000u) : ~k); }
__device__ __forceinline__ void ce_desc(unsigned& a, unsigned& b) { const unsigned mx = a > b ? a : b, mn = a > b ? b : a; a = mx; b = mn; }
template <int N, bool DESC> __device__ __forceinline__ void bitonic_merge(unsigned* a) {
#pragma unroll
    for (int j = N / 2; j > 0; j >>= 1)
#pragma unroll
        for (int i = 0; i < N; ++i) { const int l = i ^ j; if (l > i) { if (DESC) ce_desc(a[i], a[l]); else ce_desc(a[l], a[i]); } }
}
template <int N, bool DESC> __device__ __forceinline__ void bitonic_sort(unsigned* a) {
#pragma unroll
    for (int k = 2; k <= N; k <<= 1)
#pragma unroll
        for (int j = k >> 1; j > 0; j >>= 1)
#pragma unroll
            for (int i = 0; i < N; ++i) { const int l = i ^ j; if (l > i) { const bool up = ((i & k) == 0); if (up == DESC) ce_desc(a[i], a[l]); else ce_desc(a[l], a[i]); } }
}
__device__ __forceinline__ void top16_of_64(unsigned (&a)[64]) {
    bitonic_sort<16, true>(a); bitonic_sort<16, false>(a + 16); bitonic_sort<16, true>(a + 32); bitonic_sort<16, false>(a + 48);
#pragma unroll
    for (int i = 0; i < 16; ++i) a[i] = a[i] > a[16 + i] ? a[i] : a[16 + i];
    bitonic_merge<16, true>(a);
#pragma unroll
    for (int i = 0; i < 16; ++i) a[32 + i] = a[32 + i] > a[48 + i] ? a[32 + i] : a[48 + i];
    bitonic_merge<16, false>(a + 32);
#pragma unroll
    for (int i = 0; i < 16; ++i) a[i] = a[i] > a[32 + i] ? a[i] : a[32 + i];
    bitonic_merge<16, true>(a);
}
template <int PASS> __device__ __forceinline__ void route_qload(const bf16* QP, int tok, int head, int hi, bf16x8 (&qf)[8]) {
    const bf16* qp = QP + (size_t)tok * DM + head * 256 + PASS * 128 + hi * 8;
#pragma unroll
    for (int ks = 0; ks < 8; ++ks) qf[ks] = *(const bf16x8*)(qp + ks * 16);
}
template <int PASS> __device__ __forceinline__ void route_pass(const bf16x8 (&qf)[8], const LAS char* lds, int tok, int head, int r32, int hi, unsigned (&top)[16]) {
    f32x16 acc[4] = {};
    const LAS char* Kl = lds + PASS * 32768;
#pragma unroll
    for (int kb = 0; kb < 4; ++kb)
#pragma unroll
        for (int ks = 0; ks < 8; ++ks) { const bf16x8 a = *(const LAS bf16x8*)(Kl + (kb * 32 + r32) * 256 + (((ks * 2 + hi) ^ (r32 & 15)) * 16));
            acc[kb] = __builtin_amdgcn_mfma_f32_32x32x16_bf16(a, qf[ks], acc[kb], 0, 0, 0); }
    unsigned key[64]; const unsigned base = 127u - 4u * (unsigned)hi;
#pragma unroll
    for (int kb = 0; kb < 4; ++kb)
#pragma unroll
        for (int r = 0; r < 16; ++r) key[kb * 16 + r] = (f2ord(acc[kb][r]) & ~127u) | (base - (unsigned)(kb * 32 + (r & 3) + 8 * (r >> 2)));
    top16_of_64(key);
    unsigned pr[16];
#pragma unroll
    for (int i = 0; i < 16; ++i) pr[i] = lane_xor32(key[15 - i], hi << 5);
#pragma unroll
    for (int i = 0; i < 16; ++i) key[i] = key[i] > pr[i] ? key[i] : pr[i];
    bitonic_merge<16, true>(key);
#pragma unroll
    for (int i = 0; i < 16; ++i) top[i] = key[i];
}
#ifndef ROUTE_SORT
#define ROUTE_SORT 1
#endif
#define DPP_U(v, ctrl) ((unsigned)__builtin_amdgcn_mov_dpp((int)(v), (ctrl), 0xF, 0xF, true))
template <int J> __device__ __forceinline__ unsigned lane_xor_u(unsigned v, int lane) {
    if (J == 1) return DPP_U(v, 0xB1);
    if (J == 2) return DPP_U(v, 0x4E);
    if (J == 4) { const unsigned t = DPP_U(v, 0x141); return DPP_U(t, 0x1B); }
    if (J == 8) { const unsigned t = DPP_U(v, 0x140); return DPP_U(t, 0x141); }
    if (J == 16) { const auto r = __builtin_amdgcn_permlane16_swap(v, v, false, false); return (lane & 16) ? r[0] : r[1]; }
    return lane_xor32(v, lane);
}
template <int K, int J> __device__ __forceinline__ void sort128_stage(unsigned& a0, unsigned& a1, int lane) {
    if constexpr (J == 64) { const unsigned mn = a0 < a1 ? a0 : a1, mx = a0 < a1 ? a1 : a0; a0 = mn; a1 = mx; }
    else { const unsigned p0 = lane_xor_u<J>(a0, lane), p1 = lane_xor_u<J>(a1, lane);
        const bool lower = (lane & J) == 0;
        const bool asc0 = (K >= 64) ? true : ((lane & K) == 0), asc1 = (K == 128) ? true : (K == 64 ? false : ((lane & K) == 0));
        const unsigned mn0 = a0 < p0 ? a0 : p0, mx0 = a0 < p0 ? p0 : a0, mn1 = a1 < p1 ? a1 : p1, mx1 = a1 < p1 ? p1 : a1;
        a0 = (lower == asc0) ? mn0 : mx0; a1 = (lower == asc1) ? mn1 : mx1; }
    if constexpr (J > 1) sort128_stage<K, J / 2>(a0, a1, lane);
    else if constexpr (K < 128) sort128_stage<K * 2, K>(a0, a1, lane);
}
__device__ __forceinline__ void sort128_asc(unsigned& a0, unsigned& a1, int lane) { sort128_stage<2, 1>(a0, a1, lane); }
__device__ __forceinline__ void route_phase(CP P, int L, int Mrows, LAS unsigned char* lds_, int tid, int lane, int wid, int gw, int NGW) {
    const bf16* QP = (const bf16*)(P->ws + WS_QP); unsigned* ROUTE = (unsigned*)(P->ws + WS_ROUTE);
    LAS char* lds = (LAS char*)(LAS unsigned char*)lds_;
    __syncthreads();
    {
        const bf16* K1 = (const bf16*)(P->ws + WS_PK1) + (size_t)L * 128 * 128; const bf16* K2 = (const bf16*)(P->ws + WS_PK2) + (size_t)L * 128 * 128;
        u32x4 kw[8];
#pragma unroll
        for (int t = 0; t < 8; ++t) { const int c16 = tid + t * NWAVES * 64; const int mat = c16 >> 11, row = (c16 >> 4) & 127, ch = c16 & 15; kw[t] = *(const u32x4*)((mat ? K2 : K1) + row * 128 + ch * 8); }
#pragma unroll
        for (int t = 0; t < 8; ++t) { const int c16 = tid + t * NWAVES * 64; const int mat = c16 >> 11, row = (c16 >> 4) & 127, ch = c16 & 15; *(LAS u32x4*)(lds + mat * 32768 + row * 256 + ((ch ^ (row & 15)) * 16)) = kw[t]; }
    }
    __syncthreads();
    LAS unsigned* sc = (LAS unsigned*)(lds + 65536) + wid * 2048;
    const int r32 = lane & 31, hi = lane >> 5;
    for (int item = gw; item < Mrows / 4; item += NGW) {
        const int tok = item * 4 + (r32 >> 3), head = r32 & 7;
        unsigned top0[16], top1[16];
        { bf16x8 q0[8], q1[8]; route_qload<0>(QP, tok, head, hi, q0); route_qload<1>(QP, tok, head, hi, q1);
          route_pass<0>(q0, lds, tok, head, r32, hi, top0);
          route_pass<1>(q1, lds, tok, head, r32, hi, top1); }
        float v1[16], v2[16];
#pragma unroll
        for (int i = 0; i < 16; ++i) { v1[i] = ord2f(top0[i] & ~127u); v2[i] = ord2f(top1[i] & ~127u);
            sc[i * 64 + lane] = 127u - (top0[i] & 127u); sc[(16 + i) * 64 + lane] = 127u - (top1[i] & 127u); }
        unsigned ck[64]; int n = 0;
#pragma unroll
        for (int i = 0; i < 16; ++i)
#pragma unroll
            for (int j = 0; j < 16; ++j) if ((i + 1) * (j + 1) <= 16) { ck[n] = (f2ord(v1[i] + v2[j]) & ~255u) | (unsigned)(i * 16 + j); ++n; }
#pragma unroll
        for (int i = 50; i < 64; ++i) ck[i] = 0u;
        top16_of_64(ck);
        float ev[16]; float sum = 0.f; const float mx = ord2f(ck[0] & ~255u);
#pragma unroll
        for (int k = 0; k < 16; ++k) { ev[k] = __expf(ord2f(ck[k] & ~255u) - mx); sum += ev[k]; }
        const float inv = 1.0f / sum;
        unsigned ee[16];
#pragma unroll
        for (int k = 0; k < 16; ++k) { const unsigned pc = ck[k] & 255u; const unsigned i1 = sc[(pc >> 4) * 64 + lane], i2 = sc[(16 + (pc & 15u)) * 64 + lane]; ee[k] = i1 * 128u + i2; ev[k] *= inv; }
#if ROUTE_SORT
        { const int tq = r32 >> 3;
#pragma unroll
          for (int k = 0; k < 8; ++k) {
              const unsigned eL = ee[k], eH = ee[k + 8]; const float gL = ev[k], gH = ev[k + 8];
              sc[tq * 256 + head * 16 + hi * 8 + k] = hi ? eH : eL; sc[tq * 256 + 128 + head * 16 + hi * 8 + k] = __float_as_uint(hi ? gH : gL); }
#pragma unroll 1
          for (int t = 0; t < 4; ++t) {
              unsigned a0 = (sc[t * 256 + lane] << 7) | (unsigned)lane, a1 = (sc[t * 256 + 64 + lane] << 7) | (unsigned)(64 + lane);
              sort128_asc(a0, a1, lane);
              const unsigned g0 = sc[t * 256 + 128 + (a0 & 127u)], g1 = sc[t * 256 + 128 + (a1 & 127u)];
              u32x2* outp = (u32x2*)(ROUTE + (size_t)(item * 4 + t) * 256);
              outp[lane] = (u32x2){a0 >> 7, g0}; outp[64 + lane] = (u32x2){a1 >> 7, g1}; }
        }
#else
        u32x4* outp = (u32x4*)(ROUTE + ((size_t)tok * 128 + head * 16 + hi * 8) * 2);
#pragma unroll
        for (int k = 0; k < 8; k += 2) { u32x4 w;
            const unsigned eL0 = ee[k], eH0 = ee[k + 8], eL1 = ee[k + 1], eH1 = ee[k + 9]; const float gL0 = ev[k], gH0 = ev[k + 8], gL1 = ev[k + 1], gH1 = ev[k + 9];
            w.x = hi ? eH0 : eL0; w.y = __float_as_uint(hi ? gH0 : gL0); w.z = hi ? eH1 : eL1; w.w = __float_as_uint(hi ? gH1 : gL1);
            outp[k >> 1] = w; }
#endif
    }
}

typedef float f32x2 __attribute__((ext_vector_type(2)));
typedef float f32x32 __attribute__((ext_vector_type(32)));
typedef unsigned u32x6 __attribute__((ext_vector_type(6)));
typedef __bf16 bf16x32 __attribute__((ext_vector_type(32)));
typedef unsigned u32x16 __attribute__((ext_vector_type(16)));
typedef __bf16 bf16x2_t __attribute__((ext_vector_type(2)));
#ifndef GATHER_ZIGZAG
#define GATHER_ZIGZAG 0
#endif
#ifndef GATHER_PRE
#define GATHER_PRE 0
#endif
#ifndef GATHER_XEARLY
#define GATHER_XEARLY 0
#endif
#ifndef GATHER_SWP
#define GATHER_SWP 0
#endif
#ifndef GATHER_VECREG
#define GATHER_VECREG 1
#endif
#ifndef GATHER_MFMADOT
#define GATHER_MFMADOT 1
#endif
typedef short s16x4_t __attribute__((ext_vector_type(4)));
#ifndef GATHER_PAIRRED
#define GATHER_PAIRRED 1
#endif
#ifndef GATHER_EARLY
#define GATHER_EARLY 1
#endif
#ifndef GATHER_PACE
#define GATHER_PACE 0
#endif
#define XB_PACE(j) (XCD_BAR_WORDS + 64 * (j))
#ifndef GATHER_DEEP
#define GATHER_DEEP 0
#endif
constexpr int GS = GATHER_DEEP ? 8 : 6, GSLOT = GATHER_DEEP ? 2048 : 2 * PROW;
__device__ __forceinline__ void glds16(const void* gsrc, unsigned lds_dst) { unsigned keep;
  asm volatile("s_mov_b32 %0, m0\n\ts_mov_b32 m0, %2\n\ts_nop 0\n\tglobal_load_lds_dwordx4 %1, off\n\ts_mov_b32 m0, %0" : "=&s"(keep) : "v"(gsrc), "s"(lds_dst) : "memory"); }
template <int GMODE = 0>
__device__ __forceinline__ void gather_phase(CP P, int L, int Mrows, LAS unsigned char* lds, int wid, int lane_, int gw, int NGW, bool dry = false) {
    const unsigned char* UV = P->ws + WS_PU + (size_t)L * 16384 * PREC;
    const unsigned* ROUTE = (const unsigned*)(P->ws + WS_ROUTE); const float* MOD = (const float*)(P->ws + WS_MOD);
    bf16* X = (bf16*)(P->ws + WS_X); bf16* H = (bf16*)(P->ws + WS_H); bf16* Xo = dry ? (bf16*)(P->ws + WS_Y) : X; bf16* Ho = dry ? (bf16*)(P->ws + WS_G) : H;
    const float* lng = P->in[6] + (size_t)(L * 2 + 1) * DM; const float* lnb = P->in[7] + (size_t)(L * 2 + 1) * DM;
    const unsigned ring = (unsigned)(uintptr_t)lds + (unsigned)wid * (GS * GSLOT);
    const int nfull = (Mrows / NGW) * NGW, rem = Mrows - nfull; const bool can_coop = (rem * 4 == NGW);
    const int nround = nfull / NGW + (rem > 0 ? 1 : 0);
    const bool pace_ok = (rem == 0) || can_coop;
#define G_ROWOF(it_) ((can_coop && (it_) == nround - 1) ? (nfull + (int)blockIdx.x * 2 + (wid >> 2)) : (gw + (it_) * NGW))
    u32x2 nea = {0u, 0u}, neb = {0u, 0u}; u32x4 nh0 = {0u, 0u, 0u, 0u}, nh1 = nh0, nh2 = nh0, nh3 = nh0;
#define G_NTL(p_) (NT_STREAM ? __builtin_nontemporal_load(p_) : *(p_))
#define G_PREFETCH(rowN_, ln_) do { const int rn_ = (rowN_); nea = G_NTL(&((const u32x2*)(ROUTE + (size_t)rn_ * 256))[ln_]); neb = G_NTL(&((const u32x2*)(ROUTE + (size_t)rn_ * 256))[64 + (ln_)]); \
        const u32x4* hp_ = (const u32x4*)(H + (size_t)rn_ * DM) + 4 * (ln_); nh0 = G_NTL(hp_); nh1 = G_NTL(hp_ + 1); nh2 = G_NTL(hp_ + 2); nh3 = G_NTL(hp_ + 3); } while (0)
    if (nround > 0 && G_ROWOF(0) < Mrows) G_PREFETCH(G_ROWOF(0), launder_v(lane_));
#if GATHER_VECREG
    LAS unsigned* LNV = (LAS unsigned*)(lds + NWAVES * GS * GSLOT);
    for (int i = wid * 64 + lane_; i < 2048; i += NWAVES * 64) { const float* s_ = (i >> 10) ? lnb : lng; const int pr = i & 1023; LNV[i] = cvtpk(s_[2 * pr], s_[2 * pr + 1]); }
    __syncthreads();
    unsigned mg[16], ms[16], mc[16]; int cur_slot = -1;
#pragma unroll
    for (int i = 0; i < 16; ++i) { mg[i] = 0u; ms[i] = 0u; mc[i] = 0u; }
#endif
    bool pre = false;
#pragma unroll 1
    for (int it = 0; it < nround; ++it) {
#if GATHER_PACE
        if (pace_ok && it > 0) {
            if (wid == 0 && lane_ == 0) { const unsigned nloc = ((volatile LAS unsigned*)(lds + MISC_OFF))[8];
                if (nloc != 0u) { unsigned* pc = (unsigned*)(P->ws + WS_CTL) + CW_BAR + XB_PACE(xb_xcc_id());
                    const unsigned old = xb_add(pc, 1u), tgt = (old / nloc + 1u) * nloc; unsigned sp = 0u;
                    while ((int)(xb_ld(pc) - tgt) < 0 && ++sp < 20000u) __builtin_amdgcn_s_sleep(1); } }
            __syncthreads();
        }
#endif
        const bool coop = can_coop && (it == nround - 1);
        int row = G_ROWOF(it), k0 = 0, kn = 128;
        if (coop) { k0 = (wid & 3) * 32; kn = k0 + 32; }
        else if (row >= Mrows) break;
        const int lane = launder_v(lane_);
        const u32x2 ea = nea, eb = neb;
        unsigned eax, eay, ebx, eby;
        unsigned hw[16] = {nh0.x, nh0.y, nh0.z, nh0.w, nh1.x, nh1.y, nh1.z, nh1.w, nh2.x, nh2.y, nh2.z, nh2.w, nh3.x, nh3.y, nh3.z, nh3.w};
        float y[32];
#pragma unroll
        for (int i = 0; i < 32; ++i) y[i] = 0.f;
        { unsigned e0 = ea.x, e1 = ea.y, e2 = eb.x, e3 = eb.y;
          asm volatile("" : "+v"(e0), "+v"(e1), "+v"(e2), "+v"(e3), "+v"(hw[0]), "+v"(hw[1]), "+v"(hw[2]), "+v"(hw[3]), "+v"(hw[4]), "+v"(hw[5]), "+v"(hw[6]), "+v"(hw[7]),
                       "+v"(hw[8]), "+v"(hw[9]), "+v"(hw[10]), "+v"(hw[11]), "+v"(hw[12]), "+v"(hw[13]), "+v"(hw[14]), "+v"(hw[15]) :: "memory");
          eax = e0; eay = e1; ebx = e2; eby = e3; }
        const unsigned rd_a = ring + 16u * (unsigned)lane, rd_b = ring + 2048u + 8u * (unsigned)lane;
        const bool rev = GATHER_ZIGZAG && ((it & 1) != 0);
        const int kflip = rev ? (k0 + kn - 1) : 0, ksign = rev ? -1 : 1;
#define G_ISSUE(k) do { const int k_ = (k), ke_ = kflip + ksign * k_; const unsigned e_ = (unsigned)__builtin_amdgcn_readlane((int)(ke_ < 64 ? eax : ebx), ke_ & 63); \
        const unsigned char* rp_ = UV + (size_t)e_ * PREC + 16 * lane; const unsigned sb_ = ring + (unsigned)(k_ % GS) * GSLOT; \
        if (GMODE == 3) { glds16(rp_, sb_); if (lane < 32) glds16(rp_ + 2048, sb_ + 2048); } \
        else if (GMODE != 2) { glds16(rp_, sb_); glds16(rp_ + 1024, sb_ + 1024); if (PEER_U4) {} else if (PEER_V4) { if (lane < 32) glds16(rp_ + 2048, sb_ + 2048); } else glds16(rp_ + 2048, sb_ + 2048); } else { asm volatile("" :: "v"(rp_), "s"(sb_)); } } while (0)
#if GATHER_EARLY
        if (it + 1 < nround && G_ROWOF(it + 1) < Mrows) G_PREFETCH(G_ROWOF(it + 1), lane);
        if (!pre) {
#pragma unroll
            for (int k = 0; k < GS; ++k) G_ISSUE(k0 + k); }
#else
#pragma unroll
        for (int k = 0; k < 4; ++k) G_ISSUE(k0 + k);
        if (it + 1 < nround && G_ROWOF(it + 1) < Mrows) G_PREFETCH(G_ROWOF(it + 1), lane);
#endif
#define G_READ(k, ua, ub, va, vb) do { const unsigned so_ = (unsigned)((k) % GS) * GSLOT; \
        if (PEER_U4) asm volatile("ds_read_b128 %0, %2\n\tds_read_b128 %1, %2 offset:1024" : "=&v"(ua), "=&v"(va) : "v"(rd_a + so_) : "memory"); \
        else if (PEER_V4) asm volatile("ds_read_b128 %0, %3\n\tds_read_b64 %1, %4\n\tds_read_b128 %2, %3 offset:1024" \
                     : "=&v"(ua), "=&v"(ub), "=&v"(va) : "v"(rd_a + so_), "v"(rd_b + so_) : "memory"); \
        else asm volatile("ds_read_b128 %0, %4\n\tds_read_b64 %1, %5\n\tds_read_b128 %2, %4 offset:1024\n\tds_read_b64 %3, %5 offset:512" \
                     : "=&v"(ua), "=&v"(ub), "=&v"(va), "=&v"(vb) : "v"(rd_a + so_), "v"(rd_b + so_) : "memory"); } while (0)
#if GATHER_XEARLY
        u32x4 xr0 = {0u, 0u, 0u, 0u}, xr1 = xr0, xr2 = xr0, xr3 = xr0;
#endif
#if GATHER_SWP
        static_assert(!GATHER_SWP || (PEER_U4 && PEER_V4 && GATHER_EARLY && GATHER_PAIRRED && GATHER_MFMADOT && !GATHER_DEEP && !GATHER_XEARLY && !GATHER_PRE), "GATHER_SWP: configuration");
#define SWP_FETCH(kk, uA, uB, vA, vB) do { const int kk_ = (kk); \
            if (kk_ + 4 < kn) asm volatile("s_waitcnt vmcnt(8)" ::: "memory"); else if (kk_ == kn - 4) asm volatile("s_waitcnt vmcnt(4)" ::: "memory"); else asm volatile("s_waitcnt vmcnt(0)" ::: "memory"); \
            u32x2 d0_ = {0u, 0u}, d1_ = {0u, 0u}; G_READ(kk_, uA, d0_, vA, d1_); G_READ(kk_ + 1, uB, d0_, vB, d1_); \
            asm volatile("s_waitcnt lgkmcnt(0)" : "+v"(uA), "+v"(vA), "+v"(uB), "+v"(vB) :: "memory"); \
            if (kk_ + GS < kn) { G_ISSUE(kk_ + GS); G_ISSUE(kk_ + GS + 1); } } while (0)
#define SWP_U4(dst_, src_, w_, b_) dst_[4 * (w_) + (b_)] = __builtin_bit_cast(unsigned, __builtin_amdgcn_cvt_scalef32_pk_bf16_fp4(src_[w_], 1.0f, b_))
#define SWP_UPART(kk, uA, uB, wA_, wB_) do { const int kk_ = (kk); u32x16 ubfA, ubfB; const unsigned uwA[4] = {uA.x, uA.y, uA.z, uA.w}, uwB[4] = {uB.x, uB.y, uB.z, uB.w}; \
            _Pragma("unroll") for (int w = 0; w < 4; ++w) { SWP_U4(ubfA, uwA, w, 0); SWP_U4(ubfA, uwA, w, 1); SWP_U4(ubfA, uwA, w, 2); SWP_U4(ubfA, uwA, w, 3); SWP_U4(ubfB, uwB, w, 0); SWP_U4(ubfB, uwB, w, 1); SWP_U4(ubfB, uwB, w, 2); SWP_U4(ubfB, uwB, w, 3); } \
            f32x4 dgA = {0.f, 0.f, 0.f, 0.f}, dgB = {0.f, 0.f, 0.f, 0.f}; \
            _Pragma("unroll") for (int q = 0; q < 16; q += 2) { const u32x2 hq_ = {hw[q], hw[q + 1]}, xa_ = {ubfA[q], ubfA[q + 1]}, xb_ = {ubfB[q], ubfB[q + 1]}; \
                dgA = __builtin_amdgcn_mfma_f32_4x4x4bf16_1k(__builtin_bit_cast(s16x4_t, xa_), __builtin_bit_cast(s16x4_t, hq_), dgA, 0, 0, 0); \
                dgB = __builtin_amdgcn_mfma_f32_4x4x4bf16_1k(__builtin_bit_cast(s16x4_t, xb_), __builtin_bit_cast(s16x4_t, hq_), dgB, 0, 0, 0); } \
            const float x0 = dgA[0], x1 = dgA[1], x2 = dgA[2], x3 = dgA[3], y0 = dgB[0], y1 = dgB[1], y2 = dgB[2], y3 = dgB[3]; \
            float a0 = DPP_F(x0, 0x00); a0 += DPP_F(x1, 0x55); a0 += DPP_F(x2, 0xAA); a0 += DPP_F(x3, 0xFF); \
            float b0 = DPP_F(y0, 0x00); b0 += DPP_F(y1, 0x55); b0 += DPP_F(y2, 0xAA); b0 += DPP_F(y3, 0xFF); \
            const auto sw = __builtin_amdgcn_permlane32_swap(__float_as_uint(a0), __float_as_uint(b0), false, false); \
            float c2 = __uint_as_float(sw[0]) + __uint_as_float(sw[1]); c2 += DPP_F(c2, 0x141); c2 += DPP_F(c2, 0x140); \
            const float d2 = sum_xor16(c2) * (1.0f / U_SCALE); const float g2 = gelu_tanh(d2) * (1.0f / V_SCALE); \
            const float gA = __uint_as_float((unsigned)__builtin_amdgcn_readlane((int)__float_as_uint(g2), 0)), gB = __uint_as_float((unsigned)__builtin_amdgcn_readlane((int)__float_as_uint(g2), 32)); \
            const int keA = kflip + ksign * kk_, keB = keA + ksign; const unsigned gsel = keA < 64 ? eay : eby; \
            wA_ = __uint_as_float((unsigned)__builtin_amdgcn_readlane((int)gsel, keA & 63)) * gA; wB_ = __uint_as_float((unsigned)__builtin_amdgcn_readlane((int)gsel, keB & 63)) * gB; } while (0)
#define SWP_V4(vwA, vwB, w_, b_, wA_, wB_) do { const f32x2 pA = __builtin_amdgcn_cvt_scalef32_pk_f32_fp4(vwA[w_], 1.0f, b_), pB = __builtin_amdgcn_cvt_scalef32_pk_f32_fp4(vwB[w_], 1.0f, b_); const int j = 4 * (w_) + (b_); \
            const float pa0 = pA[0], pa1 = pA[1], pb0 = pB[0], pb1 = pB[1]; y[2 * j] += wA_ * pa0; y[2 * j + 1] += wA_ * pa1; y[2 * j] += wB_ * pb0; y[2 * j + 1] += wB_ * pb1; } while (0)
#define SWP_VPART(vA, vB, wA_, wB_) do { const unsigned vwA[4] = {vA.x, vA.y, vA.z, vA.w}, vwB[4] = {vB.x, vB.y, vB.z, vB.w}; \
            _Pragma("unroll") for (int w = 0; w < 4; ++w) { SWP_V4(vwA, vwB, w, 0, wA_, wB_); SWP_V4(vwA, vwB, w, 1, wA_, wB_); SWP_V4(vwA, vwB, w, 2, wA_, wB_); SWP_V4(vwA, vwB, w, 3, wA_, wB_); } } while (0)
#define SWP_VCH(w_, qA_, qB_) do { SWP_V4(vwA, vwB, w_, 0, qA_, qB_); SWP_V4(vwA, vwB, w_, 1, qA_, qB_); SWP_V4(vwA, vwB, w_, 2, qA_, qB_); SWP_V4(vwA, vwB, w_, 3, qA_, qB_); } while (0)
#define SWP_MIX(kk, uA, uB, wA_, wB_, pvA, pvB, pwA_, pwB_) do { const int kk_ = (kk); u32x16 ubfA, ubfB; const unsigned uwA[4] = {uA.x, uA.y, uA.z, uA.w}, uwB[4] = {uB.x, uB.y, uB.z, uB.w}; \
            const unsigned vwA[4] = {pvA.x, pvA.y, pvA.z, pvA.w}, vwB[4] = {pvB.x, pvB.y, pvB.z, pvB.w}; \
            _Pragma("unroll") for (int w = 0; w < 4; ++w) { SWP_U4(ubfA, uwA, w, 0); SWP_U4(ubfA, uwA, w, 1); SWP_U4(ubfA, uwA, w, 2); SWP_U4(ubfA, uwA, w, 3); SWP_U4(ubfB, uwB, w, 0); SWP_U4(ubfB, uwB, w, 1); SWP_U4(ubfB, uwB, w, 2); SWP_U4(ubfB, uwB, w, 3); } \
            f32x4 dgA = {0.f, 0.f, 0.f, 0.f}, dgB = {0.f, 0.f, 0.f, 0.f}; \
            _Pragma("unroll") for (int q = 0; q < 16; q += 2) { const u32x2 hq_ = {hw[q], hw[q + 1]}, xa_ = {ubfA[q], ubfA[q + 1]}, xb_ = {ubfB[q], ubfB[q + 1]}; \
                dgA = __builtin_amdgcn_mfma_f32_4x4x4bf16_1k(__builtin_bit_cast(s16x4_t, xa_), __builtin_bit_cast(s16x4_t, hq_), dgA, 0, 0, 0); \
                dgB = __builtin_amdgcn_mfma_f32_4x4x4bf16_1k(__builtin_bit_cast(s16x4_t, xb_), __builtin_bit_cast(s16x4_t, hq_), dgB, 0, 0, 0); } \
            SWP_VCH(0, pwA_, pwB_); \
            const float x0 = dgA[0], x1 = dgA[1], x2 = dgA[2], x3 = dgA[3], y0 = dgB[0], y1 = dgB[1], y2 = dgB[2], y3 = dgB[3]; \
            float a0 = DPP_F(x0, 0x00); a0 += DPP_F(x1, 0x55); a0 += DPP_F(x2, 0xAA); a0 += DPP_F(x3, 0xFF); \
            float b0 = DPP_F(y0, 0x00); b0 += DPP_F(y1, 0x55); b0 += DPP_F(y2, 0xAA); b0 += DPP_F(y3, 0xFF); \
            SWP_VCH(1, pwA_, pwB_); \
            const auto sw = __builtin_amdgcn_permlane32_swap(__float_as_uint(a0), __float_as_uint(b0), false, false); \
            float c2 = __uint_as_float(sw[0]) + __uint_as_float(sw[1]); c2 += DPP_F(c2, 0x141); c2 += DPP_F(c2, 0x140); \
            float d2 = sum_xor16(c2) * (1.0f / U_SCALE); \
            SWP_VCH(2, pwA_, pwB_); \
            float g2 = gelu_tanh(d2) * (1.0f / V_SCALE); \
            SWP_VCH(3, pwA_, pwB_); \
            const float gA = __uint_as_float((unsigned)__builtin_amdgcn_readlane((int)__float_as_uint(g2), 0)), gB = __uint_as_float((unsigned)__builtin_amdgcn_readlane((int)__float_as_uint(g2), 32)); \
            const int keA = kflip + ksign * kk_, keB = keA + ksign; const unsigned gsel = keA < 64 ? eay : eby; \
            wA_ = __uint_as_float((unsigned)__builtin_amdgcn_readlane((int)gsel, keA & 63)) * gA; wB_ = __uint_as_float((unsigned)__builtin_amdgcn_readlane((int)gsel, keB & 63)) * gB; } while (0)
        if (GMODE == 0) {
            u32x4 cuA, cuB, cvA, cvB; float cwA, cwB;
            SWP_FETCH(k0, cuA, cuB, cvA, cvB); SWP_UPART(k0, cuA, cuB, cwA, cwB);
#pragma unroll 1
            for (int k = k0; k + 2 < kn; k += 2) {
                u32x4 nuA, nuB, nvA, nvB; float nwA, nwB;
                SWP_FETCH(k + 2, nuA, nuB, nvA, nvB);
                SWP_MIX(k + 2, nuA, nuB, nwA, nwB, cvA, cvB, cwA, cwB);
                cvA = nvA; cvB = nvB; cwA = nwA; cwB = nwB;
            }
            SWP_VPART(cvA, cvB, cwA, cwB);
        } else
#undef SWP_MIX
#undef SWP_VCH
#undef SWP_FETCH
#undef SWP_U4
#undef SWP_UPART
#undef SWP_V4
#undef SWP_VPART
#endif
#pragma unroll 1
        for (int k = k0; k < kn; k += 2) {
            if (GATHER_DEEP && k + 6 < kn) asm volatile("s_waitcnt vmcnt(12)" ::: "memory");
            else if (GATHER_DEEP && k == kn - 6) asm volatile("s_waitcnt vmcnt(8)" ::: "memory");
            else if (k + 4 < kn) { if (!GATHER_EARLY) { G_ISSUE(k + 4); G_ISSUE(k + 5); } if (GMODE == 3 || PEER_U4) asm volatile("s_waitcnt vmcnt(8)" ::: "memory"); else asm volatile("s_waitcnt vmcnt(12)" ::: "memory"); }
            else if (k == kn - 4) { if (GMODE == 3 || PEER_U4) asm volatile("s_waitcnt vmcnt(4)" ::: "memory"); else asm volatile("s_waitcnt vmcnt(6)" ::: "memory"); }
            else asm volatile("s_waitcnt vmcnt(0)" ::: "memory");
            u32x4 uaA, vaA, uaB, vaB; u32x2 ubA = {0u, 0u}, vbA = {0u, 0u}, ubB = {0u, 0u}, vbB = {0u, 0u};
            G_READ(k, uaA, ubA, vaA, vbA); G_READ(k + 1, uaB, ubB, vaB, vbB);
            asm volatile("s_waitcnt lgkmcnt(0)" : "+v"(uaA), "+v"(ubA), "+v"(vaA), "+v"(vbA), "+v"(uaB), "+v"(ubB), "+v"(vaB), "+v"(vbB) :: "memory");
#if GATHER_XEARLY
            if (k == kn - 4) { const u32x4* xp_ = (const u32x4*)(X + (size_t)row * DM) + 4 * lane; xr0 = xp_[0]; xr1 = xp_[1]; xr2 = xp_[2]; xr3 = xp_[3]; }
#endif
            if (GATHER_EARLY && k + GS < kn) { G_ISSUE(k + GS); G_ISSUE(k + GS + 1); }
            if (GMODE == 1 || GMODE == 3) continue;
#if PEER_U4
            u32x16 ubfA, ubfB;
            { const unsigned uwA[4] = {uaA.x, uaA.y, uaA.z, uaA.w}, uwB[4] = {uaB.x, uaB.y, uaB.z, uaB.w};
#pragma unroll
              for (int w = 0; w < 4; ++w) {
#define U4_CVT(b_) do { ubfA[4 * w + (b_)] = __builtin_bit_cast(unsigned, __builtin_amdgcn_cvt_scalef32_pk_bf16_fp4(uwA[w], 1.0f, b_)); ubfB[4 * w + (b_)] = __builtin_bit_cast(unsigned, __builtin_amdgcn_cvt_scalef32_pk_bf16_fp4(uwB[w], 1.0f, b_)); } while (0)
                  U4_CVT(0); U4_CVT(1); U4_CVT(2); U4_CVT(3);
#undef U4_CVT
              } }
#else
            const u32x6 u6A = {uaA.x, uaA.y, uaA.z, uaA.w, ubA.x, ubA.y}, u6B = {uaB.x, uaB.y, uaB.z, uaB.w, ubB.x, ubB.y};
            const u32x16 ubfA = __builtin_bit_cast(u32x16, __builtin_amdgcn_cvt_scalef32_pk32_bf16_fp6(u6A, 1.0f));
            const u32x16 ubfB = __builtin_bit_cast(u32x16, __builtin_amdgcn_cvt_scalef32_pk32_bf16_fp6(u6B, 1.0f));
#endif
#if GATHER_MFMADOT
            f32x4 dgA = {0.f, 0.f, 0.f, 0.f}, dgB = {0.f, 0.f, 0.f, 0.f};
#pragma unroll
            for (int q = 0; q < 16; q += 2) { const u32x2 hq_ = {hw[q], hw[q + 1]}, xa_ = {ubfA[q], ubfA[q + 1]}, xb_ = {ubfB[q], ubfB[q + 1]};
                dgA = __builtin_amdgcn_mfma_f32_4x4x4bf16_1k(__builtin_bit_cast(s16x4_t, xa_), __builtin_bit_cast(s16x4_t, hq_), dgA, 0, 0, 0);
                dgB = __builtin_amdgcn_mfma_f32_4x4x4bf16_1k(__builtin_bit_cast(s16x4_t, xb_), __builtin_bit_cast(s16x4_t, hq_), dgB, 0, 0, 0); }
            float a0, a1 = 0.f, b0, b1 = 0.f;
            { const float x0 = dgA[0], x1 = dgA[1], x2 = dgA[2], x3 = dgA[3], y0 = dgB[0], y1 = dgB[1], y2 = dgB[2], y3 = dgB[3];
              a0 = DPP_F(x0, 0x00); a0 += DPP_F(x1, 0x55); a0 += DPP_F(x2, 0xAA); a0 += DPP_F(x3, 0xFF);
              b0 = DPP_F(y0, 0x00); b0 += DPP_F(y1, 0x55); b0 += DPP_F(y2, 0xAA); b0 += DPP_F(y3, 0xFF); }
#else
            float a0 = 0.f, a1 = 0.f, b0 = 0.f, b1 = 0.f;
#pragma unroll
            for (int q = 0; q < 16; q += 2) { const unsigned h0_ = hw[q], h1_ = hw[q + 1], x0_ = ubfA[q], x1_ = ubfA[q + 1], z0_ = ubfB[q], z1_ = ubfB[q + 1];
                a0 = __builtin_amdgcn_fdot2_f32_bf16(__builtin_bit_cast(bf16x2_t, h0_), __builtin_bit_cast(bf16x2_t, x0_), a0, false);
                a1 = __builtin_amdgcn_fdot2_f32_bf16(__builtin_bit_cast(bf16x2_t, h1_), __builtin_bit_cast(bf16x2_t, x1_), a1, false);
                b0 = __builtin_amdgcn_fdot2_f32_bf16(__builtin_bit_cast(bf16x2_t, h0_), __builtin_bit_cast(bf16x2_t, z0_), b0, false);
                b1 = __builtin_amdgcn_fdot2_f32_bf16(__builtin_bit_cast(bf16x2_t, h1_), __builtin_bit_cast(bf16x2_t, z1_), b1, false); }
#endif
            const int keA = kflip + ksign * k, keB = keA + ksign;
            const unsigned gsel = keA < 64 ? eay : eby;
#if GATHER_PAIRRED
            float wA, wB;
            { const auto sw = __builtin_amdgcn_permlane32_swap(__float_as_uint(GATHER_MFMADOT ? a0 : a0 + a1), __float_as_uint(GATHER_MFMADOT ? b0 : b0 + b1), false, false);
#if GATHER_MFMADOT
              float c2 = __uint_as_float(sw[0]) + __uint_as_float(sw[1]); c2 += DPP_F(c2, 0x141); c2 += DPP_F(c2, 0x140);
              const float d2 = sum_xor16(c2) * (1.0f / U_SCALE);
#else
              const float d2 = half_sum32(__uint_as_float(sw[0]) + __uint_as_float(sw[1])) * (1.0f / U_SCALE);
#endif
              const float g2 = gelu_tanh(d2) * (1.0f / V_SCALE);
              const float gA = __uint_as_float((unsigned)__builtin_amdgcn_readlane((int)__float_as_uint(g2), 0)), gB = __uint_as_float((unsigned)__builtin_amdgcn_readlane((int)__float_as_uint(g2), 32));
              wA = __uint_as_float((unsigned)__builtin_amdgcn_readlane((int)gsel, keA & 63)) * gA; wB = __uint_as_float((unsigned)__builtin_amdgcn_readlane((int)gsel, keB & 63)) * gB; }
#else
            const float dA = wave_sum(a0 + a1) * (1.0f / U_SCALE), dB = wave_sum(b0 + b1) * (1.0f / U_SCALE);
            const float wA = __uint_as_float((unsigned)__builtin_amdgcn_readlane((int)gsel, keA & 63)) * gelu_tanh(dA) * (1.0f / V_SCALE);
            const float wB = __uint_as_float((unsigned)__builtin_amdgcn_readlane((int)gsel, keB & 63)) * gelu_tanh(dB) * (1.0f / V_SCALE);
#endif
#if PEER_V4
            { const unsigned vwA[4] = {vaA.x, vaA.y, vaA.z, vaA.w}, vwB[4] = {vaB.x, vaB.y, vaB.z, vaB.w};
#pragma unroll
              for (int w = 0; w < 4; ++w) {
#define V4_ACC(b_) do { const f32x2 pA = __builtin_amdgcn_cvt_scalef32_pk_f32_fp4(vwA[w], 1.0f, b_), pB = __builtin_amdgcn_cvt_scalef32_pk_f32_fp4(vwB[w], 1.0f, b_); const int j = 4 * w + (b_); \
                    const float pa0 = pA[0], pa1 = pA[1], pb0 = pB[0], pb1 = pB[1]; y[2 * j] += wA * pa0; y[2 * j + 1] += wA * pa1; y[2 * j] += wB * pb0; y[2 * j + 1] += wB * pb1; } while (0)
                  V4_ACC(0); V4_ACC(1); V4_ACC(2); V4_ACC(3);
#undef V4_ACC
              } }
#else
            const u32x6 v6A = {vaA.x, vaA.y, vaA.z, vaA.w, vbA.x, vbA.y};
            const f32x32 vfA = __builtin_amdgcn_cvt_scalef32_pk32_f32_fp6(v6A, 1.0f);
#pragma unroll
            for (int i = 0; i < 32; ++i) y[i] += wA * vfA[i];
            const u32x6 v6B = {vaB.x, vaB.y, vaB.z, vaB.w, vbB.x, vbB.y};
            const f32x32 vfB = __builtin_amdgcn_cvt_scalef32_pk32_f32_fp6(v6B, 1.0f);
#pragma unroll
            for (int i = 0; i < 32; ++i) y[i] += wB * vfB[i];
#endif
        }
#if GATHER_PRE
        pre = (it + 1 < nround) && (G_ROWOF(it + 1) < Mrows);
        if (pre) { unsigned n0 = nea.x, n2 = neb.x; asm volatile("" : "+v"(n0), "+v"(n2) :: "memory"); eax = n0; ebx = n2;
            const int k0n = (can_coop && (it + 1 == nround - 1)) ? (wid & 3) * 32 : 0;
#pragma unroll
            for (int k = 0; k < 6; ++k) G_ISSUE(k0n + k); }
#endif
#undef G_READ
#undef G_ISSUE
        if (coop) {
            LAS f32x4* mine = (LAS f32x4*)(lds + wid * (GS * GSLOT)) + lane * 8;
#pragma unroll
            for (int i = 0; i < 8; ++i) mine[i] = (f32x4){y[4 * i], y[4 * i + 1], y[4 * i + 2], y[4 * i + 3]};
            __syncthreads();
            if ((wid & 3) == 0) {
#pragma unroll
                for (int j = 1; j < 4; ++j) { const LAS f32x4* oth = (const LAS f32x4*)(lds + (wid + j) * (GS * GSLOT)) + lane * 8;
#pragma unroll
                    for (int i = 0; i < 8; ++i) { const f32x4 t = oth[i]; y[4 * i] += t.x; y[4 * i + 1] += t.y; y[4 * i + 2] += t.z; y[4 * i + 3] += t.w; } }
            }
            __syncthreads();
            if ((wid & 3) != 0) continue;
        }
        const int slot = row_slot(row);
        const float* mod = MOD + (size_t)(L * 3 + slot) * 12288;
        const int le = launder_v(lane);
#if GATHER_VECREG
        if (slot != cur_slot) { cur_slot = slot; float t_[32];
            load_row_f32_b(mod + 5 * 2048, le, t_);
#pragma unroll
            for (int i = 0; i < 16; ++i) mg[i] = cvtpk(t_[2 * i], t_[2 * i + 1]);
            if (L < NLAYER - 1) { const float* modn = MOD + (size_t)((L + 1) * 3 + slot) * 12288;
                load_row_f32_b(modn, le, t_);
#pragma unroll
                for (int i = 0; i < 16; ++i) ms[i] = cvtpk(t_[2 * i], t_[2 * i + 1]);
                load_row_f32_b(modn + 2048, le, t_);
#pragma unroll
                for (int i = 0; i < 16; ++i) mc[i] = cvtpk(t_[2 * i], t_[2 * i + 1]); } }
        { float xx[32];
#if GATHER_XEARLY
          { const unsigned xw_[16] = {xr0.x, xr0.y, xr0.z, xr0.w, xr1.x, xr1.y, xr1.z, xr1.w, xr2.x, xr2.y, xr2.z, xr2.w, xr3.x, xr3.y, xr3.z, xr3.w};
#pragma unroll
            for (int i = 0; i < 16; ++i) { xx[2 * i] = bflo(xw_[i]); xx[2 * i + 1] = bfhi(xw_[i]); } }
#else
          { const u32x4* xp_ = (const u32x4*)(X + (size_t)row * DM) + 4 * le;
#pragma unroll
            for (int j = 0; j < 4; ++j) { const u32x4 w = G_NTL(xp_ + j); xx[8 * j + 0] = bflo(w.x); xx[8 * j + 1] = bfhi(w.x); xx[8 * j + 2] = bflo(w.y); xx[8 * j + 3] = bfhi(w.y);
                xx[8 * j + 4] = bflo(w.z); xx[8 * j + 5] = bfhi(w.z); xx[8 * j + 6] = bflo(w.w); xx[8 * j + 7] = bfhi(w.w); } }
#endif
#pragma unroll
          for (int i = 0; i < 16; ++i) { y[2 * i] = ALPHA * xx[2 * i] + bflo(mg[i]) * y[2 * i]; y[2 * i + 1] = ALPHA * xx[2 * i + 1] + bfhi(mg[i]) * y[2 * i + 1]; } }
        { float mean, rstd; ln_stats(y, mean, rstd);
          const LAS u32x4* gp = (const LAS u32x4*)(LNV + le * 16); const LAS u32x4* bp = (const LAS u32x4*)(LNV + 1024 + le * 16);
#pragma unroll
          for (int q = 0; q < 4; ++q) { const u32x4 g4 = gp[q], b4 = bp[q]; const unsigned gw_[4] = {g4.x, g4.y, g4.z, g4.w}, bw_[4] = {b4.x, b4.y, b4.z, b4.w};
#pragma unroll
              for (int j = 0; j < 4; ++j) { const int i = 8 * q + 2 * j; y[i] = (y[i] - mean) * rstd * bflo(gw_[j]) + bflo(bw_[j]); y[i + 1] = (y[i + 1] - mean) * rstd * bfhi(gw_[j]) + bfhi(bw_[j]); } }
          if (L < NLAYER - 1) { store_row_bf16_b(Xo + (size_t)row * DM, le, y);
              ln_stats(y, mean, rstd); float a_[32];
#pragma unroll
              for (int i = 0; i < 16; ++i) { a_[2 * i] = (y[2 * i] - mean) * rstd * (1.0f + bflo(mc[i])) + bflo(ms[i]); a_[2 * i + 1] = (y[2 * i + 1] - mean) * rstd * (1.0f + bfhi(mc[i])) + bfhi(ms[i]); }
              store_row_bf16_b(Ho + (size_t)row * DM, le, a_); }
          else { if (NT_STREAM > 1) store_row_f32_b_nt(P->out + (size_t)row * DM, le, y); else store_row_f32_b(P->out + (size_t)row * DM, le, y); } }
        asm volatile("s_waitcnt vmcnt(0)" ::: "memory");
        continue;
#endif
        { float xx[32], gg[32]; load_row_bf16_b(X + (size_t)row * DM, le, xx); load_row_f32_b(mod + 5 * 2048, le, gg);
#pragma unroll
          for (int i = 0; i < 32; ++i) y[i] = ALPHA * xx[i] + gg[i] * y[i]; }
        if (L < NLAYER - 1) { const float* modn = MOD + (size_t)((L + 1) * 3 + slot) * 12288;
            finish_row<true>(y, lng, lnb, Xo + (size_t)row * DM, modn, modn + 2048, Ho + (size_t)row * DM, nullptr, le); }
        else finish_row<true>(y, lng, lnb, nullptr, nullptr, nullptr, nullptr, P->out + (size_t)row * DM, le);
        asm volatile("s_waitcnt vmcnt(0)" ::: "memory");
    }
#undef G_PREFETCH
#undef G_ROWOF
}

#ifndef ROPE_TEST
#define ROPE_TEST 0
#endif
#ifndef TAIL_L3MOVE
#define TAIL_L3MOVE 1
#endif
#ifndef PROBE_DUP
#define PROBE_DUP 0
#endif
#define NOINL __forceinline__
__device__ __forceinline__ CP launder_cp(CP p) { asm volatile("" : "+s"(p)); return p; }
#define GETP() launder_cp((CP)__builtin_amdgcn_kernarg_segment_ptr())
__device__ __forceinline__ int uni(int v) { return __builtin_amdgcn_readfirstlane(v); }
__device__ __forceinline__ LAS unsigned char* uni_lds(LAS unsigned char* p) { return (LAS unsigned char*)(unsigned)__builtin_amdgcn_readfirstlane((int)(unsigned)(uintptr_t)p); }
#define PH_IDS const int wid = uni(wv_), lane = launder_v(lane_id_fresh()) & 63, tid = (wid & 7) * 64 + lane; const int gw = blockIdx.x * NWAVES + wid, NGW = gridDim.x * NWAVES; (void)lane; (void)gw; (void)NGW; (void)tid;

__device__ NOINL void ph_prologue(int wv_, LAS unsigned char* lds_) { CP P = GETP(); LAS unsigned char* lds = uni_lds(lds_); PH_IDS p0_prologue(P, lds, tid, lane, wid, gw, NGW); if (PROBE_DUP == 5) p0_prologue(P, lds, tid, lane, wid, gw, NGW);
    if (PROBE_DUP >= 21 && PROBE_DUP <= 23) { __syncthreads(); p0_prologue(P, lds, tid, lane, wid, gw, NGW, 1 << (PROBE_DUP - 21 < 0 ? 0 : (PROBE_DUP - 21) & 3)); } }
__device__ NOINL void ph_modreduce(int wv_) { CP P = GETP(); PH_IDS mod_reduce(P, gw, lane, NGW); }
__device__ NOINL void ph_first(int wv_, LAS unsigned char* lds_) { CP P = GETP(); LAS unsigned char* lds = uni_lds(lds_); PH_IDS
#pragma unroll 1
    for (int rep = 0; rep < (PROBE_DUP == 6 ? 2 : 1); ++rep) first_row_pass(P, lds, tid, lane, gw, NGW); }
__device__ NOINL void ph_postmix(int wv_, LAS unsigned char* lds_, int L_, int M_) { CP P = GETP(); LAS unsigned char* lds = uni_lds(lds_); const int L = uni(L_), Mrows = uni(M_); PH_IDS
    if (POSTMIX_LDS) post_mixer_pass_lds(P, L, Mrows, lds, tid, lane, gw, NGW); else post_mixer_pass(P, L, Mrows, lane, gw, NGW); }
__device__ NOINL void ph_vstats(int wv_, int M_) { CP P = GETP(); const int Mrows = uni(M_); PH_IDS
#pragma unroll 1
    for (int rep = 0; rep < (PROBE_DUP == 6 ? 2 : 1); ++rep) vstats_pass(P, Mrows, lane, gw, NGW); }
__device__ NOINL void ph_spatial(int wv_, LAS unsigned char* lds_, int j_, int M_) { CP P = GETP(); LAS unsigned char* lds = uni_lds(lds_); const int j = uni(j_), Mrows = uni(M_); PH_IDS
#pragma unroll 1
    for (int rep = 0; rep < ((PROBE_DUP == 6 || PROBE_DUP == 19) ? 2 : 1); ++rep) spatial_phase(P, j, Mrows, lds, tid, lane, wid); }
__device__ NOINL void ph_mla_norm(int wv_) { CP P = GETP(); PH_IDS
#pragma unroll 1
    for (int rep = 0; rep < (PROBE_DUP == 6 ? 2 : 1); ++rep) mla_norm_pass(P, lane, gw, NGW); }
__device__ NOINL void ph_rope(int wv_, int which_) { CP P = GETP(); const int which = uni(which_); PH_IDS
    if (which == 0) rope_pass((bf16*)(P->ws + WS_QM), 3072, 128, 16, 192, lane, gw, NGW);
    else rope_pass((bf16*)(P->ws + WS_Z), 6144, 0, 64, 64, lane, gw, NGW); }
__device__ NOINL void ph_attn_mla(int wv_, LAS unsigned char* lds_) { CP P = GETP(); LAS unsigned char* lds = uni_lds(lds_); PH_IDS mla_attn_phase(P, lds, tid); if (PROBE_DUP == 2 || PROBE_DUP == 9) mla_attn_phase(P, lds, tid); }
__device__ NOINL void ph_attn_da(int wv_, LAS unsigned char* lds_, int L_, bool ctx_q) { CP P = GETP(); LAS unsigned char* lds = uni_lds(lds_); const int L = uni(L_); PH_IDS
    const float* lp = P->in[26];
    const float s01 = wave_sum(lp[lane] * lp[64 + lane]), s23 = wave_sum(lp[128 + lane] * lp[192 + lane]);
    const float lam_init = 0.8f - 0.6f * expf(-0.3f * (float)L);
    const float lam = expf(s01) - expf(s23) + lam_init;
    if (PROBE_DUP == 24) { da_attn_phase(P, lam, 1.0f - lam_init, lds, tid, ctx_q, 4); __syncthreads(); }
    if (!(PROBE_DUP >= 11 && PROBE_DUP <= 15)) da_attn_phase(P, lam, 1.0f - lam_init, lds, tid, ctx_q);
    if (PROBE_DUP == 2 || PROBE_DUP == 10) da_attn_phase(P, lam, 1.0f - lam_init, lds, tid, ctx_q);
    if (PROBE_DUP >= 11 && PROBE_DUP <= 15) { da_attn_phase<PROBE_DUP >= 11 && PROBE_DUP <= 15 ? PROBE_DUP - 10 : 0>(P, lam, 1.0f - lam_init, lds, tid, ctx_q); __syncthreads(); }
    if (PROBE_DUP >= 11 && PROBE_DUP <= 15) da_attn_phase(P, lam, 1.0f - lam_init, lds, tid, ctx_q); }
__device__ NOINL void ph_route(int wv_, LAS unsigned char* lds_, int L_, int M_) { CP P = GETP(); LAS unsigned char* lds = uni_lds(lds_); const int L = uni(L_), Mrows = uni(M_); PH_IDS
#pragma unroll 1
    for (int rep = 0; rep < (PROBE_DUP == 4 ? 2 : 1); ++rep) route_phase(P, L, Mrows, lds, tid, lane, wid, gw, NGW); }
__device__ NOINL void ph_gather(int wv_, LAS unsigned char* lds_, int L_, int M_) { CP P = GETP(); LAS unsigned char* lds = uni_lds(lds_); const int L = uni(L_), Mrows = uni(M_); PH_IDS
    if (PROBE_DUP == 3) { gather_phase<0>(P, L, Mrows, lds, wid, lane, gw, NGW, true); }
    if (PROBE_DUP == 7) { gather_phase<1>(P, L, Mrows, lds, wid, lane, gw, NGW, true); }
    if (PROBE_DUP == 17) { gather_phase<3>(P, L, Mrows, lds, wid, lane, gw, NGW, true); }
    if (PROBE_DUP == 8) { gather_phase<2>(P, L, Mrows, lds, wid, lane, gw, NGW, true); }
    gather_phase<0>(P, L, Mrows, lds, wid, lane, gw, NGW); }

enum GemmId { G_GM_IN = 0, G_GM_OUT, G_MLA_IN, G_MLA_UQ, G_MLA_UKV, G_MLA_OUT, G_DA_IN, G_DA_OUT, G_PEER_Q };
__device__ NOINL void ph_gemm(int wv_, LAS unsigned char* lds_, int id_, int L_, int M_) {
    CP P = GETP(); LAS unsigned char* lds = uni_lds(lds_); const int id = uni(id_), L = uni(L_), Mrows = uni(M_); PH_IDS
    unsigned char* ws = P->ws; const int jj = L / 3;
    size_t a = WS_H, b = 0, o = 0; int M = MT, N = 2048, K = 2048, act = 0, rope = 0;
    switch (id) {
        case G_GM_IN:   a = WS_H;    b = WS_GMWIN + (size_t)jj * 4096 * 2048 * 2;  o = WS_Z;  M = Mrows; N = 4096; K = 2048; act = 1; break;
        case G_GM_OUT:  a = WS_G;    b = WS_GMWOUT + (size_t)jj * 2048 * 2048 * 2; o = WS_Y;  M = Mrows; N = 2048; K = 2048; break;
        case G_MLA_IN:  a = WS_H;    b = WS_MLAIN;  o = WS_C;  N = 1280; K = 2048; break;
        case G_MLA_UQ:  a = WS_CQN;  b = WS_MLAUQ;  o = WS_QM; N = 3072; K = 512;  rope = (ROPE_TEST == 2) ? 0 : 2; break;
        case G_MLA_UKV: a = WS_CKVN; b = WS_MLAUKV; o = WS_KV; N = 4096; K = 512;  break;
        case G_MLA_OUT: a = WS_G;    b = WS_MLAOUT; o = WS_Y;  N = 2048; K = 2048; break;
        case G_DA_IN:   a = WS_H;    b = WS_DAIN;   o = WS_Z;  N = 6144; K = 2048; rope = (ROPE_TEST == 1) ? 0 : 1; break;
        case G_DA_OUT:  a = WS_G;    b = WS_DAOUT;  o = WS_Y;  M = Mrows; N = 2048; K = 2048; break;
        default:        a = WS_H;    b = WS_PWQ + (size_t)L * 2048 * 2048 * 2;     o = WS_QP; M = Mrows; N = 2048; K = 2048; break;
    }
    pg8::Gemm g{(const pg8::bf16_t*)(ws + a), (const pg8::bf16_t*)(ws + b), M, N, K}; pg8::StaticOrder S; S.init(M, N, (int)gridDim.x, id == G_MLA_UKV ? (int)gridDim.x - 1 - (int)blockIdx.x : (int)blockIdx.x);
    pg8::EpiR E{(pg8::bf16_t*)(ws + o), N, act, rope, (const float*)(ws + WS_ROPE)};
#pragma unroll 1
    for (int rep = 0; rep < (PROBE_DUP == 1 ? 2 : 1); ++rep) { pg8::gemm_phase<pg8::EpiR, pg8::StaticOrder, true, true>((PG8_LAS unsigned char*)lds, g, S, E, tid); __syncthreads(); }
#if TAIL_REMAP
    int TL = -1; bool tail_u = false;
    if (L == 0) { if (id == G_GM_IN) { TL = 0; tail_u = true; } else if (id == G_GM_OUT) { TL = 0; } else if (id == G_PEER_Q) { TL = 1; tail_u = true; } }
    else if (L == 1) { if (id == G_MLA_IN) { TL = 1; } else if (id == G_MLA_OUT) { TL = 2; tail_u = true; } else if (id == G_PEER_Q) { TL = 2; } }
    else if (L == 2) { if (id == G_DA_IN) { TL = 3; tail_u = true; } else if (id == G_DA_OUT) { TL = 3; } }
    if (TL >= 0) {
        const int units = (M / 256) * (N / 256), G = (int)gridDim.x, tail = units % G, c = (int)blockIdx.x;
        const float* src = (tail_u ? P->in[11] : P->in[12]) + (size_t)TL * 16384 * 2048; unsigned char* dst = ws + WS_PU + (size_t)TL * 16384 * PREC;
#else
#if TAIL_L3MOVE
    const bool l3u = (id == G_MLA_IN && L == 1), l3v = (id == G_DA_IN && L == 2), skip = (L == NLAYER - 2) && (id == G_DA_OUT || id == G_PEER_Q);
    const bool l0v = P0_NOV && (id == G_GM_IN && L == 0);
    const bool tail_u = !skip && ((id == G_GM_OUT || id == G_MLA_OUT || id == G_DA_OUT) || l3u), tail_v = !skip && ((id == G_PEER_Q) || l3v || l0v);
    const int TLx = (l3u || l3v) ? NLAYER - 1 : (l0v ? 0 : L + 1);
    if ((tail_u || tail_v) && TLx < NLAYER) {
        const int units = (M / 256) * (N / 256), G = (int)gridDim.x, tail = units % G, c = (int)blockIdx.x;
        const float* src = (tail_u ? P->in[11] : P->in[12]) + (size_t)TLx * 16384 * 2048; unsigned char* dst = ws + WS_PU + (size_t)TLx * 16384 * PREC;
#else
    const bool tail_u = (id == G_GM_OUT || id == G_MLA_OUT || id == G_DA_OUT), tail_v = (id == G_PEER_Q);
    if ((tail_u || tail_v) && L + 1 < NLAYER) {
        const int units = (M / 256) * (N / 256), G = (int)gridDim.x, tail = units % G, c = (int)blockIdx.x;
        const float* src = (tail_u ? P->in[11] : P->in[12]) + (size_t)(L + 1) * 16384 * 2048; unsigned char* dst = ws + WS_PU + (size_t)(L + 1) * 16384 * PREC;
#endif
#endif
        LAS float* scr = (LAS float*)(lds + wid * 16384);
        if (tail != 0 && c >= tail) cvt_table_fp6(src, dst, 16384, tail_u ? U_SCALE : V_SCALE, scr, lane, (c - tail) * NWAVES + wid, (G - tail) * NWAVES, tail_u ? 0 : 1);
        else if (tail == 0) {
#pragma unroll 1
            for (int rep = 0; rep < (PROBE_DUP == 18 ? 3 : 1); ++rep) cvt_table_fp6(src, dst, 16384, tail_u ? U_SCALE : V_SCALE, scr, lane, gw, NGW, tail_u ? 0 : 1); }
    }
}

__global__ void __launch_bounds__(NWAVES * 64, 2) mk_fwd(Params Pv) {
    extern __shared__ __attribute__((aligned(16))) unsigned char lds_g[];
    LAS unsigned char* lds = (LAS unsigned char*)lds_g;
    const int wv = __builtin_amdgcn_readfirstlane((int)threadIdx.x >> 6);
    const int tid = wv * 64 + lane_id_fresh();
    for (int u = tid; u < (LDS_BYTES - RING_BYTES) / 4; u += NWAVES * 64) ((LAS unsigned*)(lds + RING_BYTES))[u] = 0u;
    __syncthreads();
    const int lo = Pv.ph_lo, hi = Pv.ph_hi;
    unsigned* barw = (unsigned*)(Pv.ws + WS_CTL) + CW_BAR;
    XcdBarrier bar; bar.bar = barw; bar.x = 0; bar.st = nullptr;
    if (hi - lo > 1) bar = xcd_barrier_post(barw, (volatile LAS unsigned*)(lds + MISC_OFF) + 8, tid == 0);
    int ph = 0;
#ifndef SEL
#define SELP(k) true
#else
#define SELP(k) ((k) == SEL)
#endif
    enum { RUN_BASE = __COUNTER__ + 1 };
#define RUN(call) do { if (SELP(__COUNTER__ - RUN_BASE) && ph >= lo && ph < hi) { call; } if (ph >= lo && ph + 1 < hi) xcd_barrier(bar, wv == 0 && lane_id_fresh() == 0); ++ph; } while (0)
    RUN(ph_prologue(wv, lds));
    RUN(ph_modreduce(wv));
    RUN(ph_first(wv, lds));
#define LAYER(LL) do { constexpr int L = (LL); constexpr int kind = L % 3, jj = L / 3; constexpr int Mrows = (L == NLAYER - 1) ? ML : MT; \
        constexpr bool ctx_dead = (L == NLAYER - 2) && ((NLAYER - 1) % 3 == 0) && (kind != 0); constexpr int Mlive = ctx_dead ? ML : Mrows; \
        if (kind == 0) {                          \
            RUN(ph_gemm(wv, lds, G_GM_IN, L, Mrows)); \
            RUN(ph_vstats(wv, Mrows)); \
            RUN(ph_spatial(wv, lds, jj, Mrows)); \
            RUN(ph_gemm(wv, lds, G_GM_OUT, L, Mrows)); \
        } else if (kind == 1) {                   \
            RUN(ph_gemm(wv, lds, G_MLA_IN, L, Mrows)); \
            RUN(ph_mla_norm(wv)); \
            RUN(ph_gemm(wv, lds, G_MLA_UQ, L, Mrows); ph_gemm(wv, lds, G_MLA_UKV, L, Mrows)); \
            if (ROPE_TEST == 2) { RUN(ph_rope(wv, 0)); } \
            RUN(ph_attn_mla(wv, lds)); \
            RUN(ph_gemm(wv, lds, G_MLA_OUT, L, Mrows)); \
        } else {                                  \
            RUN(ph_gemm(wv, lds, G_DA_IN, L, Mrows); if (ROPE_TEST == 1) { __syncthreads(); } ); \
            if (ROPE_TEST == 1) { RUN(ph_rope(wv, 1)); } \
            RUN(ph_attn_da(wv, lds, L, !ctx_dead)); \
            RUN(ph_gemm(wv, lds, G_DA_OUT, L, Mlive)); \
        } \
        RUN(ph_postmix(wv, lds, L, Mlive));                \
        RUN(ph_gemm(wv, lds, G_PEER_Q, L, Mlive));    \
        RUN(ph_route(wv, lds, L, Mlive));             \
        RUN(ph_gather(wv, lds, L, Mlive));            \
    } while (0)
    LAYER(0); LAYER(1); LAYER(2); LAYER(3);
#undef LAYER
#undef RUN
}

extern "C" void kernel_launch(void* const* d_in, const int* in_sizes, int n_in, void* d_out, int out_size, void* d_ws, size_t ws_size, hipStream_t stream) {
    static int grid = 0;
    if (grid == 0) {
        if (n_in != 29 || in_sizes[0] != ML * DM || out_size != ML * DM || ws_size < WS_END) {
            fprintf(stderr, "kernel_launch: shape mismatch: n_in %d in0 %d out %d ws %zu (need %zu); nothing launched\n", n_in, n_in > 0 ? in_sizes[0] : -1, out_size, ws_size, (size_t)WS_END); grid = -1; return; }
        int dev = 0, cus = 0, per_cu = 0;
        if (hipGetDevice(&dev) != hipSuccess || hipDeviceGetAttribute(&cus, hipDeviceAttributeMultiprocessorCount, dev) != hipSuccess) { fprintf(stderr, "kernel_launch: device query failed\n"); grid = -1; return; }
        if (hipFuncSetAttribute((const void*)mk_fwd, hipFuncAttributeMaxDynamicSharedMemorySize, LDS_BYTES) != hipSuccess) { fprintf(stderr, "kernel_launch: hipFuncSetAttribute failed\n"); grid = -1; return; }
        if (hipOccupancyMaxActiveBlocksPerMultiprocessor(&per_cu, (const void*)mk_fwd, NWAVES * 64, LDS_BYTES) != hipSuccess || per_cu < 1)
            fprintf(stderr, "kernel_launch: note: occupancy query reports %d workgroups per CU\n", per_cu);
        (void)hipGetLastError();
        grid = cus;
    }
    if (grid < 0) return;
    if (hipMemsetAsync((char*)d_ws + WS_CTL, 0, CTL_ZERO_BYTES, stream) != hipSuccess) { fprintf(stderr, "kernel_launch: memset failed\n"); return; }
    Params p{};
    for (int i = 0; i < 29; ++i) p.in[i] = (const float*)d_in[i];
    p.out = (float*)d_out; p.ws = (unsigned char*)d_ws;
#if MK_ONE_LAUNCH
    p.ph_lo = 0; p.ph_hi = NPH;
    hipLaunchKernelGGL(mk_fwd, dim3(grid), dim3(NWAVES * 64), LDS_BYTES, stream, p);
#else
    for (int li = 0; li < NPH; ++li) { p.ph_lo = li; p.ph_hi = li + 1; hipLaunchKernelGGL(mk_fwd, dim3(grid), dim3(NWAVES * 64), LDS_BYTES, stream, p); }
#endif
    const hipError_t le = hipPeekAtLastError();
    if (le != hipSuccess) fprintf(stderr, "kernel_launch: launch failed: %s\n", hipGetErrorName(le));
}
```

```cpp
#include <hip/hip_runtime.h>
#include <cstdio>
#include <cstdint>
#ifndef MK_ONE_LAUNCH
#define MK_ONE_LAUNCH 1
#endif
__device__ __forceinline__ int launder_v(int v) { asm volatile("" : "+v"(v)); return v; }
__device__ __forceinline__ int lane_id_fresh() { unsigned m = ~0u; asm volatile("" : "+s"(m)); return (int)__builtin_amdgcn_mbcnt_hi(m, __builtin_amdgcn_mbcnt_lo(m, 0u)); }
namespace pg8 {
#define PG8_LAS __attribute__((address_space(3)))
typedef unsigned short bf16_t;
typedef short bf16x8 __attribute__((ext_vector_type(8)));
typedef float f32x4 __attribute__((ext_vector_type(4)));
typedef unsigned u32x4 __attribute__((ext_vector_type(4)));
constexpr int BM = 256, BK = 64, HALF = 128, HTB = HALF * BK * 2  , STAGE_BYTES = 8 * HTB, NXCD = 8, WGM = 8;

__host__ __device__ __forceinline__ int lds_byte(int r, int c) { const int st = (r >> 4) * 2 + (c >> 5), rr = r & 15, cc = c & 31, ob = rr * 64 + cc * 2; return st * 1024 + (ob ^ (((ob >> 9) & 1) << 5)); }
__host__ __device__ __forceinline__ void stage_rc(int b, int& R, int& C) { const int st = b / 1024, sb = b % 1024, swz = sb ^ (((sb >> 9) & 1) << 5); R = (st >> 1) * 16 + swz / 64; C = (st & 1) * 32 + (swz % 64) / 2; }
__host__ __device__ __forceinline__ int perm32(int rho) { const int n = rho >> 4, i = rho & 15; return 8 * (i >> 2) + 4 * n + (i & 3); }

struct Unit { int pm, pn; };
struct Gemm { const bf16_t* A; const bf16_t* Bt; int M, N, K; };

struct StaticOrder {
    int nM, nN, nwg, G, c;
    __host__ __device__ void init(int M, int N, int G_, int c_) { nM = M / BM; nN = N / BM; nwg = nM * nN; G = G_; c = c_; }
    __host__ __device__ bool next(int i, Unit& u) const {
        const long L = (long)i * G + c; if (L >= nwg) return false;
        int wgid = (int)L; { const int q = nwg / NXCD, r = nwg % NXCD, xcd = wgid % NXCD, off = wgid / NXCD; wgid = (xcd < r ? xcd * (q + 1) : r * (q + 1) + (xcd - r) * q) + off; }
        const int nig = WGM * nN, gid = wgid / nig, fm = gid * WGM, gsz = (nM - fm) < WGM ? (nM - fm) : WGM;
        u.pm = fm + ((wgid % nig) % gsz); u.pn = (wgid % nig) / gsz; return true;
    }
    __device__ __forceinline__ void a_ready(const Unit&) const {}
    __device__ __forceinline__ void done(const Unit&) const {}
};

__device__ __forceinline__ unsigned cvt_pk_bf16(float lo, float hi) { unsigned r; asm volatile("v_cvt_pk_bf16_f32 %0, %1, %2" : "=v"(r) : "v"(lo), "v"(hi)); return r; }
typedef float f32x2 __attribute__((ext_vector_type(2)));
__device__ __forceinline__ f32x2 gelu_pk(f32x2 v) {
    const f32x2 av = __builtin_elementwise_abs(v), d = av * 0.2316418882f + 1.0f;
    f32x2 t; t.x = __builtin_amdgcn_rcpf(d.x); t.y = __builtin_amdgcn_rcpf(d.y);
    f32x2 q = t * 0.5307027145f + (-0.7265760135f); q = q * t + 0.7107068705f; q = q * t + (-0.142248368f); q = q * t + 0.127414796f; q = q * t;
    const f32x2 s = (v * v) * (-0.72134752044f);
    f32x2 e; e.x = __builtin_amdgcn_exp2f(s.x); e.y = __builtin_amdgcn_exp2f(s.y);
    const f32x2 m = v * (q * e), r = v - m;
    f32x2 o; o.x = v.x < 0.f ? m.x : r.x; o.y = v.y < 0.f ? m.y : r.y; return o;
}

template <int ACT  > struct EpiBf16 {
    static constexpr bool PERM = true, AFTER_DRAIN = false; static_assert(ACT == 0 || ACT == 1, "EpiBf16: ACT is 0 (none) or 1 (gelu_pk)");
    bf16_t* O; int ldc; const float* bias; int split_cols; size_t split_stride; float scale0;
    __device__ __forceinline__ void operator()(const f32x4 (&acc)[2][2][4][2], const Unit& u, int wr, int wc, int fr, int fq) const {
        const int row0 = u.pm * BM + wr * 64 + fr; int colt = u.pn * BM; bf16_t* base = O;
        float sc = 1.f; if (split_cols) { const int t = colt / split_cols; base += (size_t)t * split_stride; colt -= t * split_cols; if (t == 0) sc = scale0; }
        const int col0 = colt + wc * 32 + 8 * fq, bcol0 = u.pn * BM + wc * 32 + 8 * fq;
        f32x4 bv[2][2];
#pragma unroll
        for (int bj = 0; bj < 2; ++bj)
#pragma unroll
            for (int n = 0; n < 2; ++n) bv[bj][n] = bias ? *(const f32x4*)(bias + bcol0 + bj * HALF + 4 * n) : (f32x4){0.f, 0.f, 0.f, 0.f};
#pragma unroll
        for (int ai = 0; ai < 2; ++ai)
#pragma unroll
            for (int m = 0; m < 4; ++m) { bf16_t* rowp = base + (size_t)(row0 + ai * HALF + m * 16) * ldc + col0;
#pragma unroll
                for (int bj = 0; bj < 2; ++bj) { f32x4 v0 = acc[ai][bj][m][0] + bv[bj][0], v1 = acc[ai][bj][m][1] + bv[bj][1];
                    if (ACT == 1) { f32x2 a = gelu_pk((f32x2){v0[0], v0[1]}), b = gelu_pk((f32x2){v0[2], v0[3]}), c = gelu_pk((f32x2){v1[0], v1[1]}), d = gelu_pk((f32x2){v1[2], v1[3]});
                        v0 = (f32x4){a.x, a.y, b.x, b.y}; v1 = (f32x4){c.x, c.y, d.x, d.y}; }
                    v0 = v0 * sc; v1 = v1 * sc; u32x4 w; w.x = cvt_pk_bf16(v0[0], v0[1]); w.y = cvt_pk_bf16(v0[2], v0[3]); w.z = cvt_pk_bf16(v1[0], v1[1]); w.w = cvt_pk_bf16(v1[2], v1[3]);
                    *(u32x4*)(rowp + bj * HALF) = w; } }
    }
};
template <class Epi, class Sched, bool ALIGN_EPI = false, bool SP2 = false>
__device__ __forceinline__ void gemm_phase(PG8_LAS unsigned char* lds, const Gemm g, const Sched& S, const Epi& E, const int tid_in) {
    const int tid = launder_v(tid_in) & 511, wid = __builtin_amdgcn_readfirstlane(tid >> 6), lane = tid & 63, wr = wid >> 2, wc = wid & 3, fr = lane & 15, fq = lane >> 4;
    const int K = g.K, nt = K / BK;
    unsigned voffA[2], voffB[2];
#pragma unroll
    for (int i = 0; i < 2; ++i) { int R, C; stage_rc(tid * 16 + i * 8192, R, C); const int Rb = Epi::PERM ? ((R & ~31) + perm32(R & 31)) : R;
        voffA[i] = (unsigned)(R * K + C) * 2u; voffB[i] = (unsigned)(Rb * K + C) * 2u; }
    const size_t kstep = (size_t)(BK * 2);
    const size_t hstep = (size_t)HALF * K * 2;
    const size_t tstep = 2 * hstep;
    const unsigned ldsw = (unsigned)wid * 1024u;
    const int aoff = lds_byte(wr * 64 + fr, fq * 8), boff = lds_byte(wc * 32 + fr, fq * 8);
#define PG8_SA(b, h) (((b) * 2 + (h)) * HTB)
#define PG8_SB(b, h) ((4 + (b) * 2 + (h)) * HTB)
#define PG8_STAGE(bufoff, gbase, voff) do { _Pragma("unroll") for (int _i = 0; _i < 2; ++_i) \
        __builtin_amdgcn_global_load_lds((const unsigned*)((const char*)(gbase) + (voff)[_i]), (PG8_LAS unsigned*)(lds + (bufoff) + ldsw + _i * 8192), 16, 0, 0); } while (0)
#define PG8_LDA(dst, b, h) do { _Pragma("unroll") for (int m = 0; m < 4; ++m) _Pragma("unroll") for (int k = 0; k < 2; ++k) dst[m][k] = *(const PG8_LAS bf16x8*)(lds + PG8_SA(b, h) + aoff + m * 2048 + k * 1024); } while (0)
#define PG8_LDB(dst, b, h) do { _Pragma("unroll") for (int n = 0; n < 2; ++n) _Pragma("unroll") for (int k = 0; k < 2; ++k) dst[n][k] = *(const PG8_LAS bf16x8*)(lds + PG8_SB(b, h) + boff + n * 2048 + k * 1024); } while (0)
#define PG8_MMA(ai, bj, At, Bt) do { __builtin_amdgcn_s_setprio(1); _Pragma("unroll") for (int m = 0; m < 4; ++m) _Pragma("unroll") for (int n = 0; n < 2; ++n) _Pragma("unroll") for (int k = 0; k < 2; ++k) \
        acc[ai][bj][m][n] = __builtin_amdgcn_mfma_f32_16x16x32_bf16(Bt[n][k], At[m][k], acc[ai][bj][m][n], 0, 0, 0); __builtin_amdgcn_s_setprio(0); } while (0)
#define PG8_WAIT_V(n) asm volatile("s_waitcnt vmcnt(" #n ")" ::: "memory")
#define PG8_WAIT_L(n) asm volatile("s_waitcnt lgkmcnt(" #n ")" ::: "memory")
#define PG8_BAR __builtin_amdgcn_s_barrier()
#define PG8_SCHED __builtin_amdgcn_sched_barrier(0)
    Unit cur, nxt; int ui = 0;
    if (!S.next(0, cur)) return;
    f32x4 acc[2][2][4][2];
#pragma unroll
    for (int a = 0; a < 2; ++a)
#pragma unroll
        for (int b = 0; b < 2; ++b)
#pragma unroll
            for (int m = 0; m < 4; ++m)
#pragma unroll
                for (int n = 0; n < 2; ++n) acc[a][b][m][n] = (f32x4){0.f, 0.f, 0.f, 0.f};
    bf16x8 At[4][2], B0[2][2], B1[2][2];
    const char* cA = (const char*)g.A + (size_t)cur.pm * tstep; const char* cB = (const char*)g.Bt + (size_t)cur.pn * tstep;
    S.a_ready(cur);
    if constexpr (SP2) {
        PG8_STAGE(PG8_SB(0, 0), cB, voffB); PG8_STAGE(PG8_SB(0, 1), cB + hstep, voffB); PG8_STAGE(PG8_SA(0, 0), cA, voffA); PG8_STAGE(PG8_SA(0, 1), cA + hstep, voffA);
        if (wr == 1) PG8_BAR;
        PG8_WAIT_V(2); PG8_BAR;
        PG8_STAGE(PG8_SB(1, 0), cB + kstep, voffB); PG8_STAGE(PG8_SA(1, 0), cA + kstep, voffA); PG8_STAGE(PG8_SB(1, 1), cB + hstep + kstep, voffB);
        PG8_WAIT_V(6); PG8_BAR;
    } else {
        PG8_STAGE(PG8_SB(0, 0), cB, voffB); PG8_STAGE(PG8_SA(0, 0), cA, voffA); PG8_STAGE(PG8_SB(0, 1), cB + hstep, voffB); PG8_STAGE(PG8_SA(0, 1), cA + hstep, voffA);
        if (wr == 1) PG8_BAR;
        PG8_WAIT_V(4); PG8_BAR;
        PG8_STAGE(PG8_SB(1, 0), cB + kstep, voffB); PG8_STAGE(PG8_SA(1, 0), cA + kstep, voffA); PG8_STAGE(PG8_SB(1, 1), cB + hstep + kstep, voffB);
        PG8_WAIT_V(6); PG8_BAR;
    }
    for (;;) {
        const bool has_next = S.next(ui + 1, nxt);
        const char* nA = has_next ? (const char*)g.A + (size_t)nxt.pm * tstep : cA; const char* nB = has_next ? (const char*)g.Bt + (size_t)nxt.pn * tstep : cB;
        for (int t = 0; t < nt; t += 2) {
            const bool last = (t == nt - 2);
            const char* a1 = cA + (size_t)(t + 1) * kstep;
            const char* a2 = last ? nA : cA + (size_t)(t + 2) * kstep; const char* b2 = last ? nB : cB + (size_t)(t + 2) * kstep;
            const char* a3 = a2 + kstep; const char* b3 = b2 + kstep;
            if (last && has_next) S.a_ready(nxt);
            if constexpr (SP2) {
            PG8_LDB(B0, 0, 0); PG8_LDB(B1, 0, 1); PG8_SCHED; PG8_LDA(At, 0, 0); PG8_STAGE(PG8_SA(1, 1), a1 + hstep, voffA);
            PG8_WAIT_V(8); PG8_WAIT_L(0); PG8_BAR; PG8_MMA(0, 0, At, B0); PG8_MMA(0, 1, At, B1); PG8_BAR; PG8_SCHED;
            PG8_LDA(At, 0, 1); PG8_STAGE(PG8_SB(0, 0), b2, voffB); PG8_STAGE(PG8_SB(0, 1), b2 + hstep, voffB); PG8_STAGE(PG8_SA(0, 0), a2, voffA);
            PG8_WAIT_V(8); PG8_WAIT_L(0); PG8_BAR; PG8_MMA(1, 0, At, B0); PG8_MMA(1, 1, At, B1); PG8_BAR; PG8_SCHED;
            PG8_LDB(B0, 1, 0); PG8_LDB(B1, 1, 1); PG8_SCHED; PG8_LDA(At, 1, 0); PG8_STAGE(PG8_SA(0, 1), a2 + hstep, voffA);
            PG8_WAIT_V(8); PG8_WAIT_L(0); PG8_BAR; PG8_MMA(0, 0, At, B0); PG8_MMA(0, 1, At, B1); PG8_BAR; PG8_SCHED;
            PG8_LDA(At, 1, 1); PG8_STAGE(PG8_SB(1, 0), b3, voffB); PG8_STAGE(PG8_SB(1, 1), b3 + hstep, voffB); PG8_STAGE(PG8_SA(1, 0), a3, voffA);
            PG8_WAIT_V(8); PG8_WAIT_L(0); PG8_BAR; PG8_MMA(1, 0, At, B0); PG8_MMA(1, 1, At, B1); PG8_BAR; PG8_SCHED;
            } else {
            PG8_LDB(B0, 0, 0); PG8_SCHED; PG8_LDA(At, 0, 0); PG8_STAGE(PG8_SA(1, 1), a1 + hstep, voffA);
            PG8_WAIT_L(8); PG8_BAR; PG8_WAIT_L(0); PG8_MMA(0, 0, At, B0); PG8_BAR; PG8_SCHED;
            PG8_LDB(B1, 0, 1); PG8_STAGE(PG8_SB(0, 0), b2, voffB);
            PG8_BAR; PG8_WAIT_L(0); PG8_MMA(0, 1, At, B1); PG8_BAR;
            PG8_LDA(At, 0, 1); PG8_STAGE(PG8_SA(0, 0), a2, voffA);
            PG8_BAR; PG8_WAIT_L(0); PG8_MMA(1, 0, At, B0); PG8_BAR; PG8_SCHED;
            PG8_STAGE(PG8_SB(0, 1), b2 + hstep, voffB);
            PG8_WAIT_V(6); PG8_BAR; PG8_MMA(1, 1, At, B1); PG8_BAR;
            PG8_LDB(B0, 1, 0); PG8_SCHED; PG8_LDA(At, 1, 0); PG8_STAGE(PG8_SA(0, 1), a2 + hstep, voffA);
            PG8_WAIT_L(8); PG8_BAR; PG8_WAIT_L(0); PG8_MMA(0, 0, At, B0); PG8_BAR; PG8_SCHED;
            PG8_LDB(B1, 1, 1); PG8_STAGE(PG8_SB(1, 0), b3, voffB);
            PG8_BAR; PG8_WAIT_L(0); PG8_MMA(0, 1, At, B1); PG8_BAR;
            PG8_LDA(At, 1, 1); PG8_STAGE(PG8_SA(1, 0), a3, voffA);
            PG8_BAR; PG8_WAIT_L(0); PG8_MMA(1, 0, At, B0); PG8_BAR; PG8_SCHED;
            PG8_STAGE(PG8_SB(1, 1), b3 + hstep, voffB);
            PG8_WAIT_V(6); PG8_BAR; PG8_MMA(1, 1, At, B1); PG8_BAR;
            }
        }
        if constexpr (ALIGN_EPI) { if (wr == 0) PG8_BAR; }
        if constexpr (!Epi::AFTER_DRAIN) { E(acc, cur, wr, wc, fr, fq); S.done(cur); }
        if (!has_next) break;
#pragma unroll
        for (int a = 0; a < 2; ++a)
#pragma unroll
            for (int b = 0; b < 2; ++b)
#pragma unroll
                for (int m = 0; m < 4; ++m)
#pragma unroll
                    for (int n = 0; n < 2; ++n) acc[a][b][m][n] = (f32x4){0.f, 0.f, 0.f, 0.f};
        cur = nxt; cA = nA; cB = nB; ++ui;
        if constexpr (ALIGN_EPI) { if (wr == 1) PG8_BAR; }
    }
    PG8_WAIT_V(0);
    if constexpr (!ALIGN_EPI) { if (wr == 0) PG8_BAR; }
    PG8_BAR;
    if constexpr (Epi::AFTER_DRAIN) { E.fused(acc, cur, wr, wc, fr, fq, lds, wid, lane); S.done(cur); }
#undef PG8_SA
#undef PG8_SB
#undef PG8_STAGE
#undef PG8_LDA
#undef PG8_LDB
#undef PG8_MMA
#undef PG8_WAIT_V
#undef PG8_WAIT_L
#undef PG8_BAR
#undef PG8_SCHED
}
}

namespace pg8 {
__device__ __forceinline__ float gelu_tanh(float x) {
    const float t = x * (1.5957691216057308f + 0.07135481627f * x * x);
    const float e = __builtin_amdgcn_exp2f(-1.4426950408889634f * t);
    return x * __builtin_amdgcn_rcpf(1.0f + e);
}
template <int ACT> struct EpiT {
    static constexpr bool PERM = true, AFTER_DRAIN = false;
    bf16_t* O; int ldc;
    __device__ __forceinline__ void operator()(const f32x4 (&acc)[2][2][4][2], const Unit& u, int wr, int wc, int fr, int fq) const {
        const int row0 = u.pm * BM + wr * 64 + fr; const int col0 = u.pn * BM + wc * 32 + 8 * fq;
#pragma unroll
        for (int ai = 0; ai < 2; ++ai)
#pragma unroll
            for (int m = 0; m < 4; ++m) { bf16_t* rowp = O + (size_t)(row0 + ai * HALF + m * 16) * ldc + col0;
#pragma unroll
                for (int bj = 0; bj < 2; ++bj) { f32x4 v0 = acc[ai][bj][m][0], v1 = acc[ai][bj][m][1];
                    if (ACT == 2) { v0 = (f32x4){gelu_tanh(v0[0]), gelu_tanh(v0[1]), gelu_tanh(v0[2]), gelu_tanh(v0[3])}; v1 = (f32x4){gelu_tanh(v1[0]), gelu_tanh(v1[1]), gelu_tanh(v1[2]), gelu_tanh(v1[3])}; }
                    u32x4 w; w.x = cvt_pk_bf16(v0[0], v0[1]); w.y = cvt_pk_bf16(v0[2], v0[3]); w.z = cvt_pk_bf16(v1[0], v1[1]); w.w = cvt_pk_bf16(v1[2], v1[3]);
                    *(u32x4*)(rowp + bj * HALF) = w; } }
    }
};
struct EpiR {
    static constexpr bool PERM = true, AFTER_DRAIN = false;
    bf16_t* O; int ldc; int act; int rope; const float* ropet;
    __device__ __forceinline__ void operator()(const f32x4 (&acc)[2][2][4][2], const Unit& u, int wr, int wc, int fr, int fq) const {
        const int row0 = u.pm * BM + wr * 64 + fr; const int col0 = u.pn * BM + wc * 32 + 8 * fq;
        const bool rrows = rope != 0 && u.pm < 64;
#pragma unroll
        for (int ai = 0; ai < 2; ++ai)
#pragma unroll
            for (int m = 0; m < 4; ++m) { const int grow = row0 + ai * HALF + m * 16; bf16_t* rowp = O + (size_t)grow * ldc + col0;
#pragma unroll
                for (int bj = 0; bj < 2; ++bj) { f32x4 v0 = acc[ai][bj][m][0], v1 = acc[ai][bj][m][1];
                    if (act) { v0 = (f32x4){gelu_tanh(v0[0]), gelu_tanh(v0[1]), gelu_tanh(v0[2]), gelu_tanh(v0[3])}; v1 = (f32x4){gelu_tanh(v1[0]), gelu_tanh(v1[1]), gelu_tanh(v1[2]), gelu_tanh(v1[3])}; }
                    if (rrows) { const int blk = u.pn * 8 + bj * 4 + wc; const int b6 = blk % 6; const bool on = rope == 1 ? (blk < 128) : (b6 >= 4); const int half = rope == 1 ? (blk & 1) : (b6 - 4);
                        if (on) { const int t = grow & 8191; const int pos = half ? (t & 63) : (t >> 6);
                            const float* cp = ropet + pos * 16 + 8 * (fq & 1); const f32x4 c0 = *(const f32x4*)cp, c1 = *(const f32x4*)(cp + 4), s0 = *(const f32x4*)(cp + 2048), s1 = *(const f32x4*)(cp + 2052);
                            f32x4 p0, p1;
#pragma unroll
                            for (int i = 0; i < 4; ++i) { const float a_ = v0[i], b_ = v1[i];
                                const auto r0 = __builtin_amdgcn_permlane32_swap(__float_as_uint(a_), __float_as_uint(a_), false, false);
                                const auto r1 = __builtin_amdgcn_permlane32_swap(__float_as_uint(b_), __float_as_uint(b_), false, false);
                                const unsigned x0_ = (fq & 2) ? r0[0] : r0[1], x1_ = (fq & 2) ? r1[0] : r1[1]; p0[i] = __uint_as_float(x0_); p1[i] = __uint_as_float(x1_); }
                            if (fq & 2) { v0 = p0 * s0 + v0 * c0; v1 = p1 * s1 + v1 * c1; } else { v0 = v0 * c0 - p0 * s0; v1 = v1 * c1 - p1 * s1; } } }
                    u32x4 w; w.x = cvt_pk_bf16(v0[0], v0[1]); w.y = cvt_pk_bf16(v0[2], v0[3]); w.z = cvt_pk_bf16(v1[0], v1[1]); w.w = cvt_pk_bf16(v1[2], v1[3]);
                    *(u32x4*)(rowp + bj * HALF) = w; } }
    }
};
}

constexpr int DM = 2048, NBATCH = 2, SEQ = 8192, CTXL = 256;
constexpr int ML = NBATCH * SEQ;
constexpr int MC = NBATCH * CTXL;
constexpr int MT = ML + MC;
constexpr int NLAYER = 4;
constexpr float ALPHA = 1.6817928305074290f, LN_EPS = 1e-6f;
constexpr int NWAVES = 8;
constexpr float U_SCALE = 64.0f, V_SCALE = 4.0f;
constexpr int PROW = 1536;
#ifndef PEER_V4
#define PEER_V4 1
#endif
#ifndef PEER_U4
#define PEER_U4 1
#endif
constexpr int PREC = PEER_U4 ? 2048 : PEER_V4 ? 2560 : 2 * PROW;
constexpr int NPH = 35;

constexpr size_t MiB = 1ull << 20;
constexpr size_t WS_CTL = 0, CTL_ZERO_BYTES = 1 * MiB;
constexpr int    CW_BAR = 4096;
constexpr size_t WS_MOD = 128 * 1024;
constexpr size_t WS_VST = 1 * MiB;
constexpr size_t WS_ROPE = 1 * MiB + 160 * 1024;
constexpr size_t WS_MODP = 1 * MiB + 256 * 1024;
constexpr size_t WS_GMWIN = 6 * MiB;
constexpr size_t WS_GMWOUT = WS_GMWIN + 32 * MiB;
constexpr size_t WS_GMWS = WS_GMWOUT + 16 * MiB;
constexpr size_t WS_PWQ = WS_GMWS + 1 * MiB;
constexpr size_t WS_PK1 = WS_PWQ + 32 * MiB;
constexpr size_t WS_PK2 = WS_PK1 + 512 * 1024;
constexpr size_t WS_MLAIN = WS_PK1 + 1 * MiB;
constexpr size_t WS_MLAUQ = WS_MLAIN + 5 * MiB;
constexpr size_t WS_MLAUKV = WS_MLAUQ + 3 * MiB;
constexpr size_t WS_MLAOUT = WS_MLAUKV + 4 * MiB;
constexpr size_t WS_DAIN = WS_MLAOUT + 8 * MiB;
constexpr size_t WS_DAOUT = WS_DAIN + 24 * MiB;
constexpr size_t WS_PU = WS_DAOUT + 8 * MiB;
constexpr size_t WS_PV = WS_PU + 96 * MiB;
constexpr size_t WS_X = WS_PV + 96 * MiB;
constexpr size_t WS_H = WS_X + 66 * MiB;
constexpr size_t WS_G = WS_H + 66 * MiB;
constexpr size_t WS_Y = WS_G + 66 * MiB;
constexpr size_t WS_QP = WS_Y + 66 * MiB;
constexpr size_t WS_Z = WS_QP + 66 * MiB;
constexpr size_t WS_C = WS_Z + 198 * MiB;
constexpr size_t WS_CQN = WS_C + 42 * MiB;
constexpr size_t WS_CKVN = WS_CQN + 17 * MiB;
constexpr size_t WS_KR = WS_CKVN + 17 * MiB;
constexpr size_t WS_QM = WS_KR + 3 * MiB;
constexpr size_t WS_KV = WS_QM + 99 * MiB;
constexpr size_t WS_ROUTE = WS_KV + 132 * MiB;
constexpr size_t WS_END = WS_ROUTE + 17 * MiB;
static_assert((size_t)MT * DM * 2 == 66 * MiB, "row buffer size");

constexpr int RING_BYTES = 155648, MISC_OFF = RING_BYTES + 320, LDS_BYTES = 159744;

#define GAS __attribute__((address_space(1)))
#define LAS __attribute__((address_space(3)))
typedef unsigned short bf16;
typedef unsigned u32x4 __attribute__((ext_vector_type(4)));
typedef unsigned u32x2 __attribute__((ext_vector_type(2)));
typedef float f32x4 __attribute__((ext_vector_type(4)));
typedef float f32x16 __attribute__((ext_vector_type(16)));
typedef short bf16x8 __attribute__((ext_vector_type(8)));
typedef short s16x4 __attribute__((ext_vector_type(4)));
#define LDS_WAIT() asm volatile("s_waitcnt lgkmcnt(0)" ::: "memory")

__device__ __forceinline__ unsigned cvtpk(float lo, float hi) { unsigned r; asm("v_cvt_pk_bf16_f32 %0, %1, %2" : "=v"(r) : "v"(lo), "v"(hi)); return r; }
__device__ __forceinline__ float bflo(unsigned w) { return __uint_as_float(w << 16); }
__device__ __forceinline__ float bfhi(unsigned w) { return __uint_as_float(w & 0xffff0000u); }
__device__ __forceinline__ float bf1(bf16 b) { return __uint_as_float((unsigned)b << 16); }
__device__ __forceinline__ bf16 tobf1(float f) { return (bf16)(cvtpk(f, 0.f) & 0xffffu); }
#define DPP_F(v, ctrl) __int_as_float(__builtin_amdgcn_mov_dpp(__float_as_int(v), (ctrl), 0xF, 0xF, true))
__device__ __forceinline__ float row_sum16(float v) { v += DPP_F(v, 0xB1); v += DPP_F(v, 0x4E); v += DPP_F(v, 0x141); v += DPP_F(v, 0x140); return v; }
__device__ __forceinline__ float sum_xor16(float v) { const auto r = __builtin_amdgcn_permlane16_swap(__float_as_uint(v), __float_as_uint(v), false, false); return __uint_as_float(r[0]) + __uint_as_float(r[1]); }
__device__ __forceinline__ float sum_xor32(float v) { const auto r = __builtin_amdgcn_permlane32_swap(__float_as_uint(v), __float_as_uint(v), false, false); return __uint_as_float(r[0]) + __uint_as_float(r[1]); }
__device__ __forceinline__ float wave_sum(float v) { return sum_xor32(sum_xor16(row_sum16(v))); }
__device__ __forceinline__ float half_sum32(float v) { return sum_xor16(row_sum16(v)); }
__device__ __forceinline__ float lane_xor16(float v, int lane) { const auto r = __builtin_amdgcn_permlane16_swap(__float_as_uint(v), __float_as_uint(v), false, false); return __uint_as_float((lane & 16) ? r[0] : r[1]); }
__device__ __forceinline__ unsigned lane_xor32(unsigned v, int lane) { const auto r = __builtin_amdgcn_permlane32_swap(v, v, false, false); return (lane & 32) ? r[0] : r[1]; }
__device__ __forceinline__ float gelu_tanh(float x) { return pg8::gelu_tanh(x); }

__device__ __forceinline__ void load_row_bf16(const bf16* row, int lane, float (&v)[32]) {
#pragma unroll
    for (int j = 0; j < 4; ++j) { const u32x4 w = ((const u32x4*)row)[64 * j + lane];
        v[8 * j + 0] = bflo(w.x); v[8 * j + 1] = bfhi(w.x); v[8 * j + 2] = bflo(w.y); v[8 * j + 3] = bfhi(w.y);
        v[8 * j + 4] = bflo(w.z); v[8 * j + 5] = bfhi(w.z); v[8 * j + 6] = bflo(w.w); v[8 * j + 7] = bfhi(w.w); }
}
__device__ __forceinline__ void load_row_bf16_nt(const bf16* row, int lane, float (&v)[32]) {
#pragma unroll
    for (int j = 0; j < 4; ++j) { const u32x4 w = __builtin_nontemporal_load(&((const u32x4*)row)[64 * j + lane]);
        v[8 * j + 0] = bflo(w.x); v[8 * j + 1] = bfhi(w.x); v[8 * j + 2] = bflo(w.y); v[8 * j + 3] = bfhi(w.y);
        v[8 * j + 4] = bflo(w.z); v[8 * j + 5] = bfhi(w.z); v[8 * j + 6] = bflo(w.w); v[8 * j + 7] = bfhi(w.w); }
}
__device__ __forceinline__ void store_row_bf16(bf16* row, int lane, const float (&v)[32]) {
#pragma unroll
    for (int j = 0; j < 4; ++j) { u32x4 w; w.x = cvtpk(v[8 * j + 0], v[8 * j + 1]); w.y = cvtpk(v[8 * j + 2], v[8 * j + 3]); w.z = cvtpk(v[8 * j + 4], v[8 * j + 5]); w.w = cvtpk(v[8 * j + 6], v[8 * j + 7]);
        ((u32x4*)row)[64 * j + lane] = w; }
}
__device__ __forceinline__ void load_row_f32(const float* row, int lane, float (&v)[32]) {
#pragma unroll
    for (int j = 0; j < 4; ++j) { const f32x4 a = ((const f32x4*)row)[128 * j + 2 * lane], b = ((const f32x4*)row)[128 * j + 2 * lane + 1];
        v[8 * j + 0] = a.x; v[8 * j + 1] = a.y; v[8 * j + 2] = a.z; v[8 * j + 3] = a.w; v[8 * j + 4] = b.x; v[8 * j + 5] = b.y; v[8 * j + 6] = b.z; v[8 * j + 7] = b.w; }
}
__device__ __forceinline__ void load_row_f32_nt(const float* row, int lane, float (&v)[32]) {
#pragma unroll
    for (int j = 0; j < 4; ++j) { const f32x4 a = __builtin_nontemporal_load(&((const f32x4*)row)[128 * j + 2 * lane]), b = __builtin_nontemporal_load(&((const f32x4*)row)[128 * j + 2 * lane + 1]);
        v[8 * j + 0] = a.x; v[8 * j + 1] = a.y; v[8 * j + 2] = a.z; v[8 * j + 3] = a.w; v[8 * j + 4] = b.x; v[8 * j + 5] = b.y; v[8 * j + 6] = b.z; v[8 * j + 7] = b.w; }
}
__device__ __forceinline__ void store_row_f32(float* row, int lane, const float (&v)[32]) {
#pragma unroll
    for (int j = 0; j < 4; ++j) { ((f32x4*)row)[128 * j + 2 * lane] = (f32x4){v[8 * j + 0], v[8 * j + 1], v[8 * j + 2], v[8 * j + 3]};
        ((f32x4*)row)[128 * j + 2 * lane + 1] = (f32x4){v[8 * j + 4], v[8 * j + 5], v[8 * j + 6], v[8 * j + 7]}; }
}
__device__ __forceinline__ void load_row_bf16_b(const bf16* row, int lane, float (&v)[32]) {
#pragma unroll
    for (int j = 0; j < 4; ++j) { const u32x4 w = ((const u32x4*)row)[4 * lane + j];
        v[8 * j + 0] = bflo(w.x); v[8 * j + 1] = bfhi(w.x); v[8 * j + 2] = bflo(w.y); v[8 * j + 3] = bfhi(w.y);
        v[8 * j + 4] = bflo(w.z); v[8 * j + 5] = bfhi(w.z); v[8 * j + 6] = bflo(w.w); v[8 * j + 7] = bfhi(w.w); }
}
__device__ __forceinline__ void store_row_bf16_b(bf16* row, int lane, const float (&v)[32]) {
#pragma unroll
    for (int j = 0; j < 4; ++j) { u32x4 w; w.x = cvtpk(v[8 * j + 0], v[8 * j + 1]); w.y = cvtpk(v[8 * j + 2], v[8 * j + 3]); w.z = cvtpk(v[8 * j + 4], v[8 * j + 5]); w.w = cvtpk(v[8 * j + 6], v[8 * j + 7]);
        ((u32x4*)row)[4 * lane + j] = w; }
}
__device__ __forceinline__ void load_row_f32_b(const float* row, int lane, float (&v)[32]) {
#pragma unroll
    for (int q = 0; q < 8; ++q) { const f32x4 a = ((const f32x4*)row)[8 * lane + q];
        v[4 * q + 0] = a.x; v[4 * q + 1] = a.y; v[4 * q + 2] = a.z; v[4 * q + 3] = a.w; }
}
__device__ __forceinline__ void store_row_f32_b(float* row, int lane, const float (&v)[32]) {
#pragma unroll
    for (int q = 0; q < 8; ++q) ((f32x4*)row)[8 * lane + q] = (f32x4){v[4 * q + 0], v[4 * q + 1], v[4 * q + 2], v[4 * q + 3]};
}
__device__ __forceinline__ void store_row_f32_b_nt(float* row, int lane, const float (&v)[32]) {
#pragma unroll
    for (int q = 0; q < 8; ++q) __builtin_nontemporal_store((f32x4){v[4 * q + 0], v[4 * q + 1], v[4 * q + 2], v[4 * q + 3]}, &((f32x4*)row)[8 * lane + q]);
}
__device__ __forceinline__ void ln_stats(const float (&v)[32], float& mean, float& rstd) {
    float s = 0.f;
#pragma unroll
    for (int i = 0; i < 32; ++i) s += v[i];
    mean = wave_sum(s) * (1.0f / DM);
    float q = 0.f;
#pragma unroll
    for (int i = 0; i < 32; ++i) { const float d = v[i] - mean; q += d * d; }
    rstd = 1.0f / sqrtf(wave_sum(q) * (1.0f / DM) + LN_EPS);
}
template <bool LAYB>
__device__ __forceinline__ void finish_row(float (&z)[32], const float* lng, const float* lnb, bf16* Xrow, const float* sh, const float* sc, bf16* Hrow, float* Orow, int lane) {
    float mean, rstd; ln_stats(z, mean, rstd);
    { float g[32], b[32]; if (LAYB) { load_row_f32_b(lng, lane, g); load_row_f32_b(lnb, lane, b); } else { load_row_f32(lng, lane, g); load_row_f32(lnb, lane, b); }
#pragma unroll
      for (int i = 0; i < 32; ++i) z[i] = (z[i] - mean) * rstd * g[i] + b[i]; }
    if (Xrow) { if (LAYB) store_row_bf16_b(Xrow, lane, z); else store_row_bf16(Xrow, lane, z); }
    if (Orow) { if (LAYB) store_row_f32_b(Orow, lane, z); else store_row_f32(Orow, lane, z); }
    if (Hrow) {
        ln_stats(z, mean, rstd);
        float a[32], s[32]; if (LAYB) { load_row_f32_b(sc, lane, a); load_row_f32_b(sh, lane, s); } else { load_row_f32(sc, lane, a); load_row_f32(sh, lane, s); }
#pragma unroll
        for (int i = 0; i < 32; ++i) a[i] = (z[i] - mean) * rstd * (1.0f + a[i]) + s[i];
        if (LAYB) store_row_bf16_b(Hrow, lane, a); else store_row_bf16(Hrow, lane, a);
    }
}
__device__ __forceinline__ int row_slot(int row) { return row < ML ? (row >> 13) : 2; }

__device__ __forceinline__ unsigned f2bf_rne(float f) { unsigned u = __float_as_uint(f); return (u + 0x7fffu + ((u >> 16) & 1u)) >> 16; }
__device__ __forceinline__ unsigned pk2(float lo, float hi) { return f2bf_rne(lo) | (f2bf_rne(hi) << 16); }
#ifndef GEMV_PIPE
#define GEMV_PIPE 1
#endif
#ifndef NT_ACT
#define NT_ACT 0
#endif
#ifndef NT_STREAM
#define NT_STREAM 1
#endif
__device__ __forceinline__ void p0_transpose_item(const float* W, int K, int N, bf16* WT, LAS float* scr, int item, int lane) {
    const int nblk = N / 32, kb = item / nblk, nb = item % nblk, k0 = 64 * kb, n0 = 32 * nb;
    f32x4 t[8];
#pragma unroll
    for (int i = 0; i < 8; ++i) { const f32x4* p_ = (const f32x4*)(W + (size_t)(k0 + 8 * i + (lane >> 3)) * N + n0 + 4 * (lane & 7)); t[i] = NT_STREAM ? __builtin_nontemporal_load(p_) : *p_; }
#pragma unroll
    for (int i = 0; i < 8; ++i) { LAS float* d = scr + (8 * i + (lane >> 3)) * 33 + 4 * (lane & 7); d[0] = t[i].x; d[1] = t[i].y; d[2] = t[i].z; d[3] = t[i].w; }
    LDS_WAIT(); asm volatile("" ::: "memory");
    const int c = lane & 7;
#pragma unroll
    for (int j = 0; j < 4; ++j) { const int n = (lane >> 3) + 8 * j; const LAS float* s = scr + (8 * c) * 33 + n;
        u32x4 o; o.x = pk2(s[0 * 33], s[1 * 33]); o.y = pk2(s[2 * 33], s[3 * 33]); o.z = pk2(s[4 * 33], s[5 * 33]); o.w = pk2(s[6 * 33], s[7 * 33]);
        *(u32x4*)(WT + (size_t)(n0 + n) * K + k0 + 8 * c) = o; }
    LDS_WAIT(); asm volatile("" ::: "memory");
}
__device__ __forceinline__ void cvt_range(const float* src, bf16* dst, size_t n8, size_t gtid, size_t gthreads) {
#pragma unroll 4
    for (size_t i = gtid; i < n8; i += gthreads) { const f32x4 a = ((const f32x4*)src)[2 * i], b = ((const f32x4*)src)[2 * i + 1];
        u32x4 w; w.x = cvtpk(a.x, a.y); w.y = cvtpk(a.z, a.w); w.z = cvtpk(b.x, b.y); w.w = cvtpk(b.z, b.w); ((u32x4*)dst)[i] = w; }
}
__device__ __forceinline__ unsigned enc_e2m3(float x) {
    const unsigned sgn = (__float_as_uint(x) >> 26) & 32u;
    const float ax = fminf(fabsf(x), 7.5f);
    unsigned u = __float_as_uint(ax); u += 0x7FFFFu + ((u >> 20) & 1u);
    const unsigned cn = (u >> 20) - ((127u - 1u) << 3);
    const unsigned cs = (unsigned)__builtin_rintf(ax * 8.0f);
    return sgn | (ax < 1.0f ? cs : cn);
}
#ifndef EMU_FP4V
#define EMU_FP4V 0
#endif
#ifndef CVT_PIPE
#define CVT_PIPE 0
#endif
typedef float f32x2v __attribute__((ext_vector_type(2)));
typedef float f32x16v __attribute__((ext_vector_type(16)));
typedef float f32x32v __attribute__((ext_vector_type(32)));
typedef unsigned u32x6v __attribute__((ext_vector_type(6)));
__device__ __forceinline__ u32x6v pack_fp6_32(const float (&e)[32], bool interleaved) {
    f32x16v s0, s1;
    if (interleaved) {
#pragma unroll
        for (int i = 0; i < 16; ++i) { s0[i] = e[2 * i]; s1[i] = e[2 * i + 1]; }
    } else {
#pragma unroll
        for (int i = 0; i < 16; ++i) { s0[i] = e[i]; s1[i] = e[16 + i]; }
    }
    return __builtin_amdgcn_cvt_scalef32_2xpk16_fp6_f32(s0, s1, 1.0f);
}
__device__ __forceinline__ void cvt_table_fp6(const float* src, unsigned char* dst, int nrows, float scale, LAS float* scr  , int lane, int gw, int NGW, const int isv) {
    bool interleaved;
    {
        float t[32];
#pragma unroll
        for (int k = 0; k < 32; ++k) t[k] = k < 16 ? 0.125f * k : (k < 24 ? 2.0f + 0.25f * (k - 16) : 4.0f + 0.5f * (k - 24));
        float tt[32];
#pragma unroll
        for (int k = 0; k < 32; ++k) { tt[k] = t[k]; asm volatile("" : "+v"(tt[k])); }
        const u32x6v p = pack_fp6_32(tt, true);
        const f32x32v o = __builtin_amdgcn_cvt_scalef32_pk32_f32_fp6(p, 1.0f);
        interleaved = (o[1] == t[1]) && (o[2] == t[2]) && (o[17] == t[17]);
        interleaved = __all(interleaved);
    }
#if CVT_PIPE
    f32x4 nx[8];
    if (gw < nrows) { const f32x4* s4 = (const f32x4*)(src + (size_t)gw * 2048);
#pragma unroll
        for (int q = 0; q < 8; ++q) nx[q] = s4[64 * q + lane]; }
    for (int row = gw; row < nrows; row += NGW) {
        f32x4 cur[8];
#pragma unroll
        for (int q = 0; q < 8; ++q) cur[q] = nx[q];
        if (row + NGW < nrows) { const f32x4* s4 = (const f32x4*)(src + (size_t)(row + NGW) * 2048);
#pragma unroll
            for (int q = 0; q < 8; ++q) nx[q] = s4[64 * q + lane]; }
#pragma unroll
        for (int q = 0; q < 8; ++q) { const int s = 64 * q + lane; const f32x4 a = cur[q] * scale; *(LAS f32x4*)(scr + 4 * (s ^ ((s >> 4) & 7))) = a; }
#else
    bool fp4_swapped = false;
    if (PEER_V4) {
        float t0 = 1.0f, t1 = 2.0f; asm volatile("" : "+v"(t0), "+v"(t1));
        const unsigned pw = __builtin_amdgcn_cvt_scalef32_pk_fp4_f32(0u, t0, t1, 1.0f, 0);
        const f32x2v pr = __builtin_amdgcn_cvt_scalef32_pk_f32_fp4(pw, 1.0f, 0);
        fp4_swapped = !__all(pr[0] == 1.0f);
    }
    for (int row = gw; row < nrows; row += NGW) {
        const f32x4* s4 = (const f32x4*)(src + (size_t)row * 2048);
#pragma unroll
        for (int q = 0; q < 8; ++q) { const int s = 64 * q + lane; const f32x4 a = (NT_STREAM ? __builtin_nontemporal_load(&s4[s]) : s4[s]) * scale; *(LAS f32x4*)(scr + 4 * (s ^ ((s >> 4) & 7))) = a; }
#endif
        float e[32];
#pragma unroll
        for (int j = 0; j < 8; ++j) { const int s = 8 * lane + j; const f32x4 a = *(const LAS f32x4*)(scr + 4 * (s ^ ((s >> 4) & 7)));
            e[4 * j + 0] = __builtin_amdgcn_fmed3f(a.x, -7.5f, 7.5f); e[4 * j + 1] = __builtin_amdgcn_fmed3f(a.y, -7.5f, 7.5f); e[4 * j + 2] = __builtin_amdgcn_fmed3f(a.z, -7.5f, 7.5f); e[4 * j + 3] = __builtin_amdgcn_fmed3f(a.w, -7.5f, 7.5f); }
#if EMU_FP4V
        if (EMU_FP4V == 2 ? !isv : isv) {
#pragma unroll
            for (int i = 0; i < 32; ++i) { const float a = fabsf(e[i]); float q = a < 2.0f ? rintf(a * 2.0f) * 0.5f : (a < 4.0f ? rintf(a) : fminf(rintf(a * 0.5f) * 2.0f, 6.0f)); e[i] = copysignf(q, e[i]); }
        }
#endif
        unsigned char* rowp = dst + (size_t)row * PREC;
        if (PEER_V4 && (isv || PEER_U4)) {
            u32x4 w4;
#pragma unroll
            for (int w = 0; w < 4; ++w) { unsigned d = 0u; float x_[8];
#pragma unroll
                for (int i = 0; i < 8; i += 2) { const float x0 = __builtin_amdgcn_fmed3f(e[8 * w + i], -6.0f, 6.0f), x1 = __builtin_amdgcn_fmed3f(e[8 * w + i + 1], -6.0f, 6.0f); x_[i] = fp4_swapped ? x1 : x0; x_[i + 1] = fp4_swapped ? x0 : x1; }
                d = __builtin_amdgcn_cvt_scalef32_pk_fp4_f32(d, x_[0], x_[1], 1.0f, 0); d = __builtin_amdgcn_cvt_scalef32_pk_fp4_f32(d, x_[2], x_[3], 1.0f, 1);
                d = __builtin_amdgcn_cvt_scalef32_pk_fp4_f32(d, x_[4], x_[5], 1.0f, 2); d = __builtin_amdgcn_cvt_scalef32_pk_fp4_f32(d, x_[6], x_[7], 1.0f, 3);
                w4[w] = d; }
            *(u32x4*)(rowp + ((isv || !PEER_U4) ? 1024 : 0) + 16 * lane) = w4;
            continue;
        }
        const u32x6v p = pack_fp6_32(e, interleaved);
        *(u32x4*)(rowp + 1024 * isv + 16 * lane) = (u32x4){p[0], p[1], p[2], p[3]}; *(u32x2*)(rowp + 2048 + 512 * isv + 8 * lane) = (u32x2){p[4], p[5]};
    }
}
__device__ __forceinline__ float silu(float x) { return x / (1.0f + __expf(-x)); }

struct Params { const float* in[29]; float* out; unsigned char* ws; int ph_lo, ph_hi; };
typedef const __attribute__((address_space(4))) Params* CP;

#ifndef P0_NOV
#define P0_NOV 0
#endif
#ifndef TAIL_REMAP
#define TAIL_REMAP 0
#endif
__device__ __forceinline__ void p0_prologue(CP P, LAS unsigned char* lds, int tid, int lane, int wid, int gw, int NGW, const int parts = 7) {
    unsigned char* ws = P->ws;
    LAS float* scr = (LAS float*)(lds + wid * 16384);
    if (parts & 1) {
        constexpr int I_GMIN = (2048 / 64) * (4096 / 32), I_SQ = (2048 / 64) * (2048 / 32), I_MIN = (2048 / 64) * (1088 / 32), I_UQ = (512 / 64) * (3072 / 32), I_UKV = (512 / 64) * (4096 / 32), I_DIN = (2048 / 64) * (6144 / 32);
        constexpr int NIT = 2 * I_GMIN + 2 * I_SQ + 4 * I_SQ + I_MIN + I_UQ + I_UKV + I_SQ + I_DIN + I_SQ;
        for (int it = gw; it < NIT; it += NGW) {
            int r = it;
            if (r < 2 * I_GMIN) { const int j = r / I_GMIN; p0_transpose_item(P->in[13] + (size_t)j * 2048 * 4096, 2048, 4096, (bf16*)(ws + WS_GMWIN) + (size_t)j * 4096 * 2048, scr, r % I_GMIN, lane); continue; } r -= 2 * I_GMIN;
            if (r < 2 * I_SQ) { const int j = r / I_SQ; p0_transpose_item(P->in[18] + (size_t)j * 2048 * 2048, 2048, 2048, (bf16*)(ws + WS_GMWOUT) + (size_t)j * 2048 * 2048, scr, r % I_SQ, lane); continue; } r -= 2 * I_SQ;
            if (r < 4 * I_SQ) { const int j = r / I_SQ; p0_transpose_item(P->in[8] + (size_t)j * 2048 * 2048, 2048, 2048, (bf16*)(ws + WS_PWQ) + (size_t)j * 2048 * 2048, scr, r % I_SQ, lane); continue; } r -= 4 * I_SQ;
            if (r < I_MIN) { p0_transpose_item(P->in[19], 2048, 1088, (bf16*)(ws + WS_MLAIN), scr, r, lane); continue; } r -= I_MIN;
            if (r < I_UQ) { p0_transpose_item(P->in[22], 512, 3072, (bf16*)(ws + WS_MLAUQ), scr, r, lane); continue; } r -= I_UQ;
            if (r < I_UKV) { p0_transpose_item(P->in[23], 512, 4096, (bf16*)(ws + WS_MLAUKV), scr, r, lane); continue; } r -= I_UKV;
            if (r < I_SQ) { p0_transpose_item(P->in[24], 2048, 2048, (bf16*)(ws + WS_MLAOUT), scr, r, lane); continue; } r -= I_SQ;
            if (r < I_DIN) { p0_transpose_item(P->in[25], 2048, 6144, (bf16*)(ws + WS_DAIN), scr, r, lane); continue; } r -= I_DIN;
            p0_transpose_item(P->in[28], 2048, 2048, (bf16*)(ws + WS_DAOUT), scr, r, lane);
        }
    }
    const size_t gtid = (size_t)gw * 64 + lane, gthreads = (size_t)NGW * 64;
    if (parts & 2) {
    { u32x4* z = (u32x4*)((bf16*)(ws + WS_MLAIN) + (size_t)1088 * 2048); const size_t n = (size_t)192 * 2048 / 8;
      for (size_t i = gtid; i < n; i += gthreads) z[i] = (u32x4){0u, 0u, 0u, 0u}; }
    cvt_range(P->in[16], (bf16*)(ws + WS_GMWS), (size_t)2 * 16 * 128 * 128 / 8, gtid, gthreads);
    cvt_range(P->in[9], (bf16*)(ws + WS_PK1), (size_t)4 * 128 * 128 / 8, gtid, gthreads);
    cvt_range(P->in[10], (bf16*)(ws + WS_PK2), (size_t)4 * 128 * 128 / 8, gtid, gthreads);
#if !TAIL_REMAP
    cvt_table_fp6(P->in[11], ws + WS_PU, 16384, U_SCALE, scr, lane, gw, NGW, 0);
    if (!P0_NOV) cvt_table_fp6(P->in[12], ws + WS_PU, 16384, V_SCALE, scr, lane, gw, NGW, 1);
#endif
    if (gtid < 2048) { const int pos = (int)gtid >> 4, f = (int)gtid & 15; const float inv = powf(10000.0f, -(float)f * (1.0f / 16.0f)); float sn, cs; sincosf((float)pos * inv, &sn, &cs);
        float* rt = (float*)(ws + WS_ROPE); rt[gtid] = cs; rt[2048 + gtid] = sn; }
    }
    if (parts & 4) {
        const float* cv = P->in[1]; const float* cc = P->in[3]; const float* mw = P->in[4]; float* PART = (float*)(ws + WS_MODP);
        LAS float* S = (LAS float*)lds;
        __syncthreads();
        { float t_[12];
#pragma unroll
          for (int t = 0; t < 12; ++t) { const int i = tid + t * NWAVES * 64, sl = i >> 11, kk = i & 2047; t_[t] = sl == 0 ? cv[kk] : (sl == 1 ? cv[2048 + kk] : cc[kk]); }
#pragma unroll
          for (int t = 0; t < 12; ++t) S[tid + t * NWAVES * 64] = silu(t_[t]); }
        __syncthreads();
        for (int item = gw; item < 4 * 192 * 8; item += NGW) {
            const int ks = item & 7, r = item >> 3, L = r / 192, n = (r % 192) * 64 + lane;
            const float* W = mw + (size_t)L * 2048 * 12288 + (size_t)(ks * 256) * 12288 + n;
            float a0 = 0.f, a1 = 0.f, a2 = 0.f;
#if GEMV_PIPE
#define GV_LD(dst_, kb_) do { _Pragma("unroll") for (int t = 0; t < 32; ++t) dst_[t] = NT_STREAM ? __builtin_nontemporal_load(&W[(size_t)((kb_) + t) * 12288]) : W[(size_t)((kb_) + t) * 12288]; } while (0)
            float wa[32], wb[32];
            GV_LD(wa, 0);
#pragma unroll 1
            for (int kb = 0; kb < 256; kb += 64) {
                GV_LD(wb, kb + 32);
#pragma unroll
                for (int t = 0; t < 32; ++t) { const int kk = ks * 256 + kb + t; a0 += S[kk] * wa[t]; a1 += S[2048 + kk] * wa[t]; a2 += S[4096 + kk] * wa[t]; }
                if (kb + 64 < 256) GV_LD(wa, kb + 64);
#pragma unroll
                for (int t = 0; t < 32; ++t) { const int kk = ks * 256 + kb + 32 + t; a0 += S[kk] * wb[t]; a1 += S[2048 + kk] * wb[t]; a2 += S[4096 + kk] * wb[t]; }
            }
#undef GV_LD
#else
#pragma unroll 32
            for (int k = 0; k < 256; ++k) { const int kk = ks * 256 + k; const float s0 = S[kk], s1 = S[2048 + kk], s2 = S[4096 + kk];
                const float w = NT_STREAM ? __builtin_nontemporal_load(&W[(size_t)k * 12288]) : W[(size_t)k * 12288]; a0 += s0 * w; a1 += s1 * w; a2 += s2 * w; }
#endif
            float* o = PART + ((size_t)ks * 4 + L) * 3 * 12288 + n;
            o[0] = a0; o[12288] = a1; o[24576] = a2;
        }
    }
}
__device__ __forceinline__ void mod_reduce(CP P, int gw, int lane, int NGW) {
    const float* PART = (const float*)(P->ws + WS_MODP); float* MOD = (float*)(P->ws + WS_MOD); const float* mb = P->in[5];
    for (int i = gw * 64 + lane; i < 4 * 3 * 12288; i += NGW * 64) {
        const int L = i / (3 * 12288), n = i % 12288;
        float s = mb[(size_t)L * 12288 + n];
#pragma unroll
        for (int ks = 0; ks < 8; ++ks) s += PART[(size_t)ks * 4 * 3 * 12288 + i];
        MOD[i] = s;
    }
}

__device__ __forceinline__ void load_row_f32_l(const LAS float* row, int lane, float (&v)[32]) {
#pragma unroll
    for (int j = 0; j < 4; ++j) { const f32x4 a = ((const LAS f32x4*)row)[128 * j + 2 * lane], b = ((const LAS f32x4*)row)[128 * j + 2 * lane + 1];
        v[8 * j + 0] = a.x; v[8 * j + 1] = a.y; v[8 * j + 2] = a.z; v[8 * j + 3] = a.w; v[8 * j + 4] = b.x; v[8 * j + 5] = b.y; v[8 * j + 6] = b.z; v[8 * j + 7] = b.w; }
}
__device__ __forceinline__ void first_row_pass(CP P, LAS unsigned char* lds, int tid, int lane, int gw, int NGW) {
    const float* MOD = (const float*)(P->ws + WS_MOD); bf16* X = (bf16*)(P->ws + WS_X); bf16* H = (bf16*)(P->ws + WS_H);
    LAS float* V = (LAS float*)lds;
    __syncthreads();
    { f32x4 t_[6];
#pragma unroll
      for (int vec = 0; vec < 6; ++vec) t_[vec] = ((const f32x4*)(MOD + (size_t)(vec >> 1) * 12288 + (size_t)(vec & 1) * 2048))[tid];
#pragma unroll
      for (int vec = 0; vec < 6; ++vec) ((LAS f32x4*)V)[vec * 512 + tid] = t_[vec]; }
    __syncthreads();
    for (int row = gw; row < MT; row += NGW) {
        const float* src = row < ML ? P->in[0] + (size_t)row * DM : P->in[2] + (size_t)(row - ML) * DM;
        float v[32]; if (NT_STREAM > 1) load_row_f32_nt(src, lane, v); else load_row_f32(src, lane, v);
        store_row_bf16(X + (size_t)row * DM, lane, v);
        const LAS float* mod = V + row_slot(row) * 4096;
        float mean, rstd; ln_stats(v, mean, rstd);
        float a[32], s[32]; load_row_f32_l(mod + 2048, lane, a); load_row_f32_l(mod, lane, s);
#pragma unroll
        for (int i = 0; i < 32; ++i) a[i] = (v[i] - mean) * rstd * (1.0f + a[i]) + s[i];
        store_row_bf16(H + (size_t)row * DM, lane, a);
    }
}
#ifndef POSTMIX_LDS
#define POSTMIX_LDS 1
#endif
__device__ __forceinline__ void post_mixer_pass_lds(CP P, int L, int Mrows, LAS unsigned char* lds, int tid, int lane, int gw, int NGW) {
    const float* MOD = (const float*)(P->ws + WS_MOD); bf16* X = (bf16*)(P->ws + WS_X); bf16* H = (bf16*)(P->ws + WS_H); const bf16* Y = (const bf16*)(P->ws + WS_Y);
    const float* lng = P->in[6] + (size_t)(L * 2 + 0) * DM; const float* lnb = P->in[7] + (size_t)(L * 2 + 0) * DM;
    LAS float* V = (LAS float*)lds;
    __syncthreads();
    { f32x4 t_[11];
#pragma unroll
      for (int vec = 0; vec < 11; ++vec) { const float* src = vec == 0 ? lng : (vec == 1 ? lnb : MOD + (size_t)(L * 3 + (vec - 2) / 3) * 12288 + (size_t)(2 + (vec - 2) % 3) * 2048);
          t_[vec] = ((const f32x4*)src)[tid]; }
#pragma unroll
      for (int vec = 0; vec < 11; ++vec) ((LAS f32x4*)V)[vec * 512 + tid] = t_[vec]; }
    __syncthreads();
    for (int row = gw; row < Mrows; row += NGW) {
        const LAS float* mv = V + (2 + 3 * row_slot(row)) * 2048;
        float z[32], y[32]; if (NT_ACT) { load_row_bf16_nt(X + (size_t)row * DM, lane, z); load_row_bf16_nt(Y + (size_t)row * DM, lane, y); } else { load_row_bf16(X + (size_t)row * DM, lane, z); load_row_bf16(Y + (size_t)row * DM, lane, y); }
        { float g[32]; load_row_f32_l(mv, lane, g);
#pragma unroll
          for (int i = 0; i < 32; ++i) z[i] = ALPHA * z[i] + g[i] * y[i]; }
        float mean, rstd; ln_stats(z, mean, rstd);
        { float g[32], b[32]; load_row_f32_l(V, lane, g); load_row_f32_l(V + 2048, lane, b);
#pragma unroll
          for (int i = 0; i < 32; ++i) z[i] = (z[i] - mean) * rstd * g[i] + b[i]; }
        store_row_bf16(X + (size_t)row * DM, lane, z);
        ln_stats(z, mean, rstd);
        { float a[32], s_[32]; load_row_f32_l(mv + 2 * 2048, lane, a); load_row_f32_l(mv + 2048, lane, s_);
#pragma unroll
          for (int i = 0; i < 32; ++i) a[i] = (z[i] - mean) * rstd * (1.0f + a[i]) + s_[i];
          store_row_bf16(H + (size_t)row * DM, lane, a); }
    }
}
__device__ __forceinline__ void post_mixer_pass(CP P, int L, int Mrows, int lane, int gw, int NGW) {
    const float* MOD = (const float*)(P->ws + WS_MOD); bf16* X = (bf16*)(P->ws + WS_X); bf16* H = (bf16*)(P->ws + WS_H); const bf16* Y = (const bf16*)(P->ws + WS_Y);
    const float* lng = P->in[6] + (size_t)(L * 2 + 0) * DM; const float* lnb = P->in[7] + (size_t)(L * 2 + 0) * DM;
    for (int row = gw; row < Mrows; row += NGW) {
        const float* mod = MOD + (size_t)(L * 3 + row_slot(row)) * 12288;
        float z[32], y[32], g[32]; load_row_bf16(X + (size_t)row * DM, lane, z); load_row_bf16(Y + (size_t)row * DM, lane, y); load_row_f32(mod + 2 * 2048, lane, g);
#pragma unroll
        for (int i = 0; i < 32; ++i) z[i] = ALPHA * z[i] + g[i] * y[i];
        finish_row<false>(z, lng, lnb, X + (size_t)row * DM, mod + 3 * 2048, mod + 4 * 2048, H + (size_t)row * DM, nullptr, lane);
    }
}
__device__ __forceinline__ void vstats_pass(CP P, int Mrows, int lane, int gw, int NGW) {
    const bf16* Z = (const bf16*)(P->ws + WS_Z); float* VST = (float*)(P->ws + WS_VST);
    for (int row = gw; row < Mrows; row += NGW) {
        float v[32]; load_row_bf16(Z + (size_t)row * 4096 + 2048, lane, v);
        float mean, rstd; ln_stats(v, mean, rstd);
        if (lane == 0) { VST[2 * row] = mean; VST[2 * row + 1] = rstd; }
    }
}
#define XB_TMO      128
#define XB_XCNT(j)  (256  + 64 * (j))
#define XB_XSUB(j)  (1280 + 64 * (j))
#define XB_XGEN(j)  (2304 + 64 * (j))
#define XB_TOP      3328
#define XB_TOPGEN   3392
#define XCD_BAR_WORDS 3456
#define XB_SPIN_CAP (1u << 18)

__device__ __forceinline__ unsigned xb_ld(unsigned* p)              { return __hip_atomic_load(p, __ATOMIC_RELAXED, __HIP_MEMORY_SCOPE_AGENT); }
__device__ __forceinline__ unsigned xb_add(unsigned* p, unsigned v) { return __hip_atomic_fetch_add(p, v, __ATOMIC_RELAXED, __HIP_MEMORY_SCOPE_AGENT); }
__device__ __forceinline__ unsigned xb_xcc_id() { return (unsigned)__builtin_amdgcn_s_getreg((3 << 11) | 20) & 0xFu; }
#define XB_SPIN(cond, bar) do { unsigned _sp = 0; while (cond) { __builtin_amdgcn_s_sleep(1); \
    if ((++_sp & 255u) == 0u) { if (xb_ld(&(bar)[XB_TMO])) break; if (_sp > XB_SPIN_CAP) { atomicAdd(&(bar)[XB_TMO], 1u); break; } } } } while (0)

struct XcdBarrier {
    unsigned* bar; unsigned x;
    volatile LAS unsigned* st;
};

__device__ __forceinline__ XcdBarrier xcd_barrier_post(unsigned* bar, volatile LAS unsigned* st, const bool t0) {
    XcdBarrier b; b.bar = bar; b.x = xb_xcc_id(); b.st = st;
    if (t0) (void)xb_add(&bar[XB_XCNT(b.x)], 1u);
    return b;
}
__device__ __forceinline__ void xcd_barrier_complete(unsigned* bar, unsigned x, unsigned& nloc, unsigned& nx) {
    const unsigned G = gridDim.x * gridDim.y * gridDim.z;
    unsigned sum, cnt, mine, sp = 0u;
    for (;;) {
        sum = 0u; cnt = 0u; mine = 0u;
#pragma unroll
        for (unsigned j = 0; j < 16; ++j) { const unsigned c = xb_ld(&bar[XB_XCNT(j)]); sum += c; cnt += (c > 0u) ? 1u : 0u; mine = (j == x) ? c : mine; }
        if (sum == G) break;
        __builtin_amdgcn_s_sleep(1);
        if ((++sp & 255u) == 0u) { if (xb_ld(&bar[XB_TMO])) break; if (sp > XB_SPIN_CAP) { atomicAdd(&bar[XB_TMO], 1u); break; } }
    }
    nloc = mine > 0u ? mine : 1u; nx = cnt > 0u ? cnt : 1u;
}

__device__ __attribute__((noinline)) void xcd_barrier(const XcdBarrier b, const bool t0) {
    asm volatile("s_waitcnt vmcnt(0)" ::: "memory");
    __syncthreads();
    if (t0) {
        unsigned* bar = b.bar;
        __builtin_amdgcn_s_waitcnt(0);
        unsigned nloc = b.st[0], nx = b.st[1];
        if (nloc == 0u) { xcd_barrier_complete(bar, b.x, nloc, nx); b.st[0] = nloc; b.st[1] = nx; }
        const unsigned old = xb_add(&bar[XB_XSUB(b.x)], 1u);
        const unsigned gen = old / nloc;
        if (old + 1u == (gen + 1u) * nloc) {
            __builtin_amdgcn_fence(__ATOMIC_RELEASE, "agent");
            asm volatile("s_waitcnt vmcnt(0)" ::: "memory");
            const unsigned og = xb_add(&bar[XB_TOP], 1u);
            const unsigned tg = og / nx;
            if (og + 1u == (tg + 1u) * nx) xb_add(&bar[XB_TOPGEN], 1u);
            else XB_SPIN(xb_ld(&bar[XB_TOPGEN]) == tg, bar);
            __builtin_amdgcn_fence(__ATOMIC_ACQUIRE, "agent");
            xb_add(&bar[XB_XGEN(b.x)], 1u);
            asm volatile("s_waitcnt vmcnt(0)" ::: "memory");
        } else {
            XB_SPIN(xb_ld(&bar[XB_XGEN(b.x)]) == gen, bar);
            __builtin_amdgcn_fence(__ATOMIC_ACQUIRE, "agent");
            asm volatile("s_waitcnt vmcnt(0)" ::: "memory");
        }
    }
    __syncthreads();
}

#ifndef SPATIAL_PIPE
#define SPATIAL_PIPE 1
#endif
#if SPATIAL_PIPE
#ifndef SPATIAL_OTILE
#define SPATIAL_OTILE 0
#endif
struct SpReg { u32x4 w[4]; float mean, rstd; bf16x8 a[4]; bf16 uu[SPATIAL_OTILE ? 1 : 32]; u32x4 uq[4]; float bsv[4]; };
__device__ __forceinline__ void sp_load(SpReg& R, const bf16* Z, const float* VST, const bf16* WS, const float* bs, int u, int tid, int lane, int wid) {
    const int c = u >> 4, g = u & 15, fr = lane & 15, fq = lane >> 4;
    { const int q = tid >> 2, dq = (tid & 3) * 32; const int row = c * 128 + q;
      R.mean = VST[2 * row]; R.rstd = VST[2 * row + 1];
      const bf16* src = Z + (size_t)row * 4096 + 2048 + g * 128 + dq;
#pragma unroll
      for (int t = 0; t < 4; ++t) R.w[t] = *(const u32x4*)(src + 8 * t); }
    const bf16* wrow = WS + (size_t)g * 128 * 128 + (size_t)(16 * wid + fr) * 128 + 8 * fq;
#pragma unroll
    for (int ks = 0; ks < 4; ++ks) R.a[ks] = *(const bf16x8*)(wrow + 32 * ks);
#pragma unroll
    for (int r = 0; r < 4; ++r) R.bsv[r] = bs[g * 128 + 16 * wid + fq * 4 + r];
#if SPATIAL_OTILE
#pragma unroll
    for (int t = 0; t < 4; ++t) { const int ch = tid + 512 * t, p = ch >> 4, d8 = (ch & 15) * 8; R.uq[t] = *(const u32x4*)(Z + (size_t)(c * 128 + p) * 4096 + g * 128 + d8); }
    R.uu[0] = 0;
#else
#pragma unroll
    for (int nb = 0; nb < 8; ++nb)
#pragma unroll
        for (int r = 0; r < 4; ++r) { const int p = 16 * wid + fq * 4 + r, d = 16 * nb + fr; R.uu[nb * 4 + r] = Z[(size_t)(c * 128 + p) * 4096 + g * 128 + d]; }
#endif
}
__device__ __forceinline__ void spatial_phase(CP P, int j, int Mrows, LAS unsigned char* lds_, int tid, int lane, int wid) {
    const bf16* Z = (const bf16*)(P->ws + WS_Z); const float* VST = (const float*)(P->ws + WS_VST); bf16* Gb = (bf16*)(P->ws + WS_G);
    const bf16* WS = (const bf16*)(P->ws + WS_GMWS) + (size_t)j * 16 * 128 * 128;
    const float* lng = P->in[14] + (size_t)j * DM; const float* lnb = P->in[15] + (size_t)j * DM; const float* bs = P->in[17] + (size_t)j * 16 * 128;
    LAS bf16* Vt = (LAS bf16*)(LAS unsigned char*)lds_;
    constexpr int VP = 136;
    const int nunits = (Mrows / 128) * 16;
    LAS float* LNl = (LAS float*)(lds_ + 36864);
    __syncthreads();
    { const f32x4 t0_ = ((const f32x4*)lng)[tid], t1_ = ((const f32x4*)lnb)[tid]; ((LAS f32x4*)LNl)[tid] = t0_; ((LAS f32x4*)LNl)[512 + tid] = t1_; }
    LAS float* Ot = (LAS float*)(lds_ + 53248);
    (void)Ot;
    SpReg nx;
    if ((int)blockIdx.x < nunits) sp_load(nx, Z, VST, WS, bs, blockIdx.x, tid, lane, wid);
    for (int u = blockIdx.x; u < nunits; u += gridDim.x) {
        const int c = u >> 4, g = u & 15;
        const SpReg cur = nx;
        if (u + (int)gridDim.x < nunits) sp_load(nx, Z, VST, WS, bs, u + gridDim.x, tid, lane, wid);
        __syncthreads();
        {
            const int q = tid >> 2, dq = (tid & 3) * 32;
#pragma unroll
            for (int t = 0; t < 4; ++t) { const u32x4 w = cur.w[t];
                float v[8] = {bflo(w.x), bfhi(w.x), bflo(w.y), bfhi(w.y), bflo(w.z), bfhi(w.z), bflo(w.w), bfhi(w.w)};
                const LAS float* gp = LNl + g * 128 + dq + 8 * t; const LAS float* bp = LNl + 2048 + g * 128 + dq + 8 * t;
#pragma unroll
                for (int i = 0; i < 8; ++i) { const float vn = (v[i] - cur.mean) * cur.rstd * gp[i] + bp[i]; Vt[(dq + 8 * t + i) * VP + (q ^ ((tid & 3) << 4))] = tobf1(vn); } }
        }
        __syncthreads();
        const int fr = lane & 15, fq = lane >> 4;
#pragma unroll
        for (int nb = 0; nb < 8; ++nb) {
            f32x4 acc = {0.f, 0.f, 0.f, 0.f};
#pragma unroll
            for (int ks = 0; ks < 4; ++ks) { const bf16x8 b = *(const LAS bf16x8*)(Vt + (16 * nb + fr) * VP + 8 * ((4 * ks + fq) ^ ((nb >> 1) << 1)));
                acc = __builtin_amdgcn_mfma_f32_16x16x32_bf16(cur.a[ks], b, acc, 0, 0, 0); }
#if SPATIAL_OTILE
#pragma unroll
            for (int r = 0; r < 4; ++r) Ot[(16 * wid + fq * 4 + r) * 132 + 16 * nb + fr] = acc[r] + cur.bsv[r];
#else
#pragma unroll
            for (int r = 0; r < 4; ++r) { const int p = 16 * wid + fq * 4 + r, d = 16 * nb + fr; const size_t grow = (size_t)(c * 128 + p);
                const float sv = acc[r] + cur.bsv[r];
                const float uu = bf1(cur.uu[nb * 4 + r]);
                Gb[grow * 2048 + g * 128 + d] = tobf1(uu * sv); }
#endif
        }
#if SPATIAL_OTILE
        __syncthreads();
#pragma unroll
        for (int t = 0; t < 4; ++t) { const int ch = tid + 512 * t, p = ch >> 4, d8 = (ch & 15) * 8;
            const LAS f32x4* op = (const LAS f32x4*)(Ot + p * 132 + d8); const f32x4 s0 = op[0], s1 = op[1]; const u32x4 uw = cur.uq[t];
            u32x4 o; o.x = cvtpk(bflo(uw.x) * s0.x, bfhi(uw.x) * s0.y); o.y = cvtpk(bflo(uw.y) * s0.z, bfhi(uw.y) * s0.w); o.z = cvtpk(bflo(uw.z) * s1.x, bfhi(uw.z) * s1.y); o.w = cvtpk(bflo(uw.w) * s1.z, bfhi(uw.w) * s1.w);
            *(u32x4*)(Gb + (size_t)(c * 128 + p) * 2048 + g * 128 + d8) = o; }
#endif
    }
}
#else
__device__ __forceinline__ void spatial_phase(CP P, int j, int Mrows, LAS unsigned char* lds_, int tid, int lane, int wid) {
    const bf16* Z = (const bf16*)(P->ws + WS_Z); const float* VST = (const float*)(P->ws + WS_VST); bf16* Gb = (bf16*)(P->ws + WS_G);
    const bf16* WS = (const bf16*)(P->ws + WS_GMWS) + (size_t)j * 16 * 128 * 128;
    const float* lng = P->in[14] + (size_t)j * DM; const float* lnb = P->in[15] + (size_t)j * DM; const float* bs = P->in[17] + (size_t)j * 16 * 128;
    LAS bf16* Vt = (LAS bf16*)(LAS unsigned char*)lds_;
    constexpr int VP = 136;
    const int nunits = (Mrows / 128) * 16;
    for (int u = blockIdx.x; u < nunits; u += gridDim.x) {
        const int c = u >> 4, g = u & 15;
        __syncthreads();
        {
            const int q = tid >> 2, dq = (tid & 3) * 32; const int row = c * 128 + q;
            const float mean = VST[2 * row], rstd = VST[2 * row + 1];
            const bf16* src = Z + (size_t)row * 4096 + 2048 + g * 128 + dq;
#pragma unroll
            for (int t = 0; t < 4; ++t) { const u32x4 w = *(const u32x4*)(src + 8 * t);
                float v[8] = {bflo(w.x), bfhi(w.x), bflo(w.y), bfhi(w.y), bflo(w.z), bfhi(w.z), bflo(w.w), bfhi(w.w)};
                const float* gp = lng + g * 128 + dq + 8 * t; const float* bp = lnb + g * 128 + dq + 8 * t;
#pragma unroll
                for (int i = 0; i < 8; ++i) { const float vn = (v[i] - mean) * rstd * gp[i] + bp[i]; Vt[(dq + 8 * t + i) * VP + q] = tobf1(vn); } }
        }
        __syncthreads();
        const int fr = lane & 15, fq = lane >> 4;
        bf16x8 a[4];
        const bf16* wrow = WS + (size_t)g * 128 * 128 + (size_t)(16 * wid + fr) * 128 + 8 * fq;
#pragma unroll
        for (int ks = 0; ks < 4; ++ks) a[ks] = *(const bf16x8*)(wrow + 32 * ks);
#pragma unroll
        for (int nb = 0; nb < 8; ++nb) {
            f32x4 acc = {0.f, 0.f, 0.f, 0.f};
#pragma unroll
            for (int ks = 0; ks < 4; ++ks) { const bf16x8 b = *(const LAS bf16x8*)(Vt + (16 * nb + fr) * VP + 32 * ks + 8 * fq);
                acc = __builtin_amdgcn_mfma_f32_16x16x32_bf16(a[ks], b, acc, 0, 0, 0); }
#pragma unroll
            for (int r = 0; r < 4; ++r) { const int p = 16 * wid + fq * 4 + r, d = 16 * nb + fr; const size_t grow = (size_t)(c * 128 + p);
                const float sv = acc[r] + bs[g * 128 + p];
                const float uu = bf1(Z[grow * 4096 + g * 128 + d]);
                Gb[grow * 2048 + g * 128 + d] = tobf1(uu * sv); }
        }
    }
}
#endif

__device__ __forceinline__ void rope_cs(int row, int l, float& cs, float& sn) {
    const int t = row & (SEQ - 1); const int pos = (l & 32) ? (t & 63) : (t >> 6);
    const float inv = powf(10000.0f, -(float)(l & 15) * (1.0f / 16.0f));
    const float ang = (float)pos * inv; sincosf(ang, &sn, &cs);
}
__device__ __forceinline__ float rope_apply(float x, int l, float cs, float sn) {
    const float p = lane_xor16(x, l);
    return (l & 16) ? (p * sn + x * cs) : (x * cs - p * sn);
}
__device__ __forceinline__ void mla_norm_pass(CP P, int lane, int gw, int NGW) {
    const bf16* C = (const bf16*)(P->ws + WS_C); bf16* CQN = (bf16*)(P->ws + WS_CQN); bf16* CKVN = (bf16*)(P->ws + WS_CKVN); bf16* KR = (bf16*)(P->ws + WS_KR);
    const float* qn = P->in[20]; const float* kvn = P->in[21];
    for (int row = gw; row < MT; row += NGW) {
        const bf16* c = C + (size_t)row * 1280;
#pragma unroll
        for (int part = 0; part < 2; ++part) {
            const u32x4 w = *(const u32x4*)(c + part * 512 + 8 * lane);
            float v[8] = {bflo(w.x), bfhi(w.x), bflo(w.y), bfhi(w.y), bflo(w.z), bfhi(w.z), bflo(w.w), bfhi(w.w)};
            float ss = 0.f;
#pragma unroll
            for (int i = 0; i < 8; ++i) ss += v[i] * v[i];
            const float r = 1.0f / sqrtf(wave_sum(ss) * (1.0f / 512.0f) + LN_EPS);
            const float* nw = (part ? kvn : qn) + 8 * lane;
            u32x4 o; o.x = cvtpk(v[0] * r * nw[0], v[1] * r * nw[1]); o.y = cvtpk(v[2] * r * nw[2], v[3] * r * nw[3]); o.z = cvtpk(v[4] * r * nw[4], v[5] * r * nw[5]); o.w = cvtpk(v[6] * r * nw[6], v[7] * r * nw[7]);
            *(u32x4*)((part ? CKVN : CQN) + (size_t)row * 512 + 8 * lane) = o;
        }
        float x = bf1(c[1024 + lane]);
        if (row < ML) { float cs, sn; rope_cs(row, lane, cs, sn); x = rope_apply(x, lane, cs, sn); }
        KR[(size_t)row * 64 + lane] = tobf1(x);
    }
}
__device__ __forceinline__ void rope_pass(bf16* buf, int ld, int col0, int nchunks, int cstride, int lane, int gw, int NGW) {
    for (int row = gw; row < ML; row += NGW) {
        float cs, sn; rope_cs(row, lane, cs, sn);
        bf16* r = buf + (size_t)row * ld + col0 + lane;
#pragma unroll 4
        for (int k = 0; k < nchunks; ++k) { const float x = bf1(r[k * cstride]); r[k * cstride] = tobf1(rope_apply(x, lane, cs, sn)); }
    }
}

namespace att {
#ifndef ATT_LEAN
#define ATT_LEAN 1
#endif
#ifndef ATT_3STAGE
#define ATT_3STAGE 0
#endif
#ifndef ATT_QLATE
#define ATT_QLATE 1
#endif
#ifndef ATT_PRIO
#define ATT_PRIO 1
#endif
#ifndef ATT_KMAJOR
#define ATT_KMAJOR 0
#endif
#ifndef ATT_TRB
#define ATT_TRB 1
#endif
#ifndef ATT_STAGGER
#define ATT_STAGGER 0
#endif
#ifndef ATT_SDEPTH
#define ATT_SDEPTH(MODE) ((MODE) == 0 ? 1 : 1)
#endif
#ifndef ATT_PVPIPE
#define ATT_PVPIPE(MODE) ((MODE) == 1)
#endif
#define SBAR() __builtin_amdgcn_sched_barrier(0)
__device__ __forceinline__ int crow(int r, int hi) { return (r & 3) + 8 * (r >> 2) + 4 * hi; }
__device__ __forceinline__ unsigned cvtpkv(float lo, float hi) { unsigned r; asm volatile("v_cvt_pk_bf16_f32 %0, %1, %2" : "=v"(r) : "v"(lo), "v"(hi)); return r; }

__device__ __forceinline__ void partialSM(f32x16& p0, f32x16& p1, float& m_reg, float& mn, float& alpha, const float C, const float THRS) {
  float pmax = p0[0];
#pragma unroll
  for (int r = 1; r < 16; ++r) pmax = fmaxf(pmax, p0[r]);
#pragma unroll
  for (int r = 0; r < 16; ++r) pmax = fmaxf(pmax, p1[r]);
  { auto rr = __builtin_amdgcn_permlane32_swap(__float_as_uint(pmax), __float_as_uint(pmax), false, false);
    pmax = fmaxf(__uint_as_float(rr[0]), __uint_as_float(rr[1])); }
  if (__builtin_expect(__all(pmax - m_reg <= THRS), 1)) { mn = m_reg; alpha = 1.f; }
  else { mn = fmaxf(m_reg, pmax); alpha = __builtin_amdgcn_exp2f((m_reg - mn) * C); m_reg = mn; }
  const float mnC = -mn * C;
#pragma unroll
  for (int r = 0; r < 16; ++r) p0[r] = fmaf(p0[r], C, mnC);
#pragma unroll
  for (int r = 0; r < 16; ++r) p1[r] = fmaf(p1[r], C, mnC);
#pragma unroll
  for (int r = 0; r < 16; ++r) p0[r] = __builtin_amdgcn_exp2f(p0[r]);
}
__device__ __forceinline__ void finishSM(f32x16& p0, f32x16& p1, float alpha, float& l_reg, bf16x8& pa0, bf16x8& pa1, bf16x8& pa2, bf16x8& pa3) {
#pragma unroll
  for (int r = 0; r < 16; ++r) p1[r] = __builtin_amdgcn_exp2f(p1[r]);
  float ps = 0;
#pragma unroll
  for (int r = 0; r < 16; ++r) ps += p0[r];
#pragma unroll
  for (int r = 0; r < 16; ++r) ps += p1[r];
  { auto rr = __builtin_amdgcn_permlane32_swap(__float_as_uint(ps), __float_as_uint(ps), false, false);
    ps = __uint_as_float(rr[0]) + __uint_as_float(rr[1]); }
  l_reg = l_reg * alpha + ps;
#define PK4(P, BASE, OUT) do { unsigned a0 = cvtpkv(P[BASE + 0], P[BASE + 1]), a1 = cvtpkv(P[BASE + 2], P[BASE + 3]);   \
    unsigned b0 = cvtpkv(P[BASE + 4], P[BASE + 5]), b1 = cvtpkv(P[BASE + 6], P[BASE + 7]);                              \
    auto r0 = __builtin_amdgcn_permlane32_swap(a0, b0, false, false); auto r1 = __builtin_amdgcn_permlane32_swap(a1, b1, false, false); \
    u32x4 w = {r0[0], r1[0], r0[1], r1[1]}; OUT = *reinterpret_cast<bf16x8*>(&w); } while (0)
  PK4(p0, 0, pa0); PK4(p0, 8, pa1); PK4(p1, 0, pa2); PK4(p1, 8, pa3);
#undef PK4
}
__device__ __forceinline__ void partialSM_lean(f32x16& p0, f32x16& p1, f32x16& nm, float& alpha, const bool first) {
  constexpr float THR2 = 11.541560327111707f;
  float dmax = p0[0];
#pragma unroll
  for (int r = 1; r < 16; ++r) dmax = fmaxf(dmax, p0[r]);
#pragma unroll
  for (int r = 0; r < 16; ++r) dmax = fmaxf(dmax, p1[r]);
  { auto rr = __builtin_amdgcn_permlane32_swap(__float_as_uint(dmax), __float_as_uint(dmax), false, false);
    dmax = fmaxf(__uint_as_float(rr[0]), __uint_as_float(rr[1])); }
  alpha = 1.f;
  if (first || !__all(dmax <= THR2)) {
    const float delta = first ? dmax : (dmax > THR2 ? dmax : 0.f);
    if (!first) alpha = __builtin_amdgcn_exp2f(-delta);
#pragma unroll
    for (int r = 0; r < 16; ++r) { p0[r] -= delta; p1[r] -= delta; nm[r] -= delta; }
  }
#pragma unroll
  for (int r = 0; r < 16; ++r) p0[r] = __builtin_amdgcn_exp2f(p0[r]);
}
__device__ __forceinline__ void finishSM_lean(f32x16& p0, f32x16& p1, bf16x8& pa0, bf16x8& pa1, bf16x8& pa2, bf16x8& pa3) {
#pragma unroll
  for (int r = 0; r < 16; ++r) p1[r] = __builtin_amdgcn_exp2f(p1[r]);
#define PK4(P, BASE, OUT) do { unsigned a0 = cvtpkv(P[BASE + 0], P[BASE + 1]), a1 = cvtpkv(P[BASE + 2], P[BASE + 3]);   \
    unsigned b0 = cvtpkv(P[BASE + 4], P[BASE + 5]), b1 = cvtpkv(P[BASE + 6], P[BASE + 7]);                              \
    auto r0 = __builtin_amdgcn_permlane32_swap(a0, b0, false, false); auto r1 = __builtin_amdgcn_permlane32_swap(a1, b1, false, false); \
    u32x4 w = {r0[0], r1[0], r0[1], r1[1]}; OUT = *reinterpret_cast<bf16x8*>(&w); } while (0)
  PK4(p0, 0, pa0); PK4(p0, 8, pa1); PK4(p1, 0, pa2); PK4(p1, 8, pa3);
#undef PK4
}
__device__ __forceinline__ bf16x8 scale_bf16x8(bf16x8 v, float c) {
  const u32x4 w = *reinterpret_cast<u32x4*>(&v); u32x4 o;
  o.x = cvtpk(bflo(w.x) * c, bfhi(w.x) * c); o.y = cvtpk(bflo(w.y) * c, bfhi(w.y) * c); o.z = cvtpk(bflo(w.z) * c, bfhi(w.z) * c); o.w = cvtpk(bflo(w.w) * c, bfhi(w.w) * c);
  return *reinterpret_cast<bf16x8*>(&o);
}
template <int PITCH> __device__ __forceinline__ int kswz(int r) { return PITCH == 256 ? (r & 15) : ((r >> 1) & 7); }
template <int NQF, int NQR, int PITCH> __device__ __forceinline__ void qkt(f32x16& p0, f32x16& p1, const LAS char* Ks, int chunk0, const bf16x8* qr, const LAS char* ql, int r32, int hi, const f32x16 init = f32x16{}) {
  p0 = init; p1 = init;
  const int sw = kswz<PITCH>(r32);
#pragma unroll
  for (int d0 = 0; d0 < NQF; ++d0) { const int off = ((chunk0 + d0 * 2 + hi) ^ sw) * 16;
    const bf16x8 b0 = *(const LAS bf16x8*)(Ks + r32 * PITCH + off);
    const bf16x8 b1 = *(const LAS bf16x8*)(Ks + (32 + r32) * PITCH + off);
    const bf16x8 q = d0 < NQR ? qr[d0 < NQR ? d0 : 0] : *(const LAS bf16x8*)(ql + (d0 - NQR < 0 ? 0 : d0 - NQR) * 1024);
    p0 = __builtin_amdgcn_mfma_f32_32x32x16_bf16(b0, q, p0, 0, 0, 0);
    p1 = __builtin_amdgcn_mfma_f32_32x32x16_bf16(b1, q, p1, 0, 0, 0); }
}
__device__ __forceinline__ int v_st(int k, int c) { const int kk = (k & ~0xC) | ((k & 4) << 1) | ((k & 8) >> 1); return ((kk >> 3) * 4 + (c >> 5)) * 512 + ((kk & 7) * 32 + (c & 31)) * 2; }
__device__ __forceinline__ int v_rd_base(int lane) { return ((lane & 3) << 3) | (((lane >> 2) & 3) << 6) | (((lane >> 4) & 1) << 5) | (((lane >> 5) & 1) << 8); }
constexpr int v_rd_off(int d0, int ks, int half) { return d0 * 512 + ks * 4096 + half * 2048; }
template <int OFF> __device__ __forceinline__ s16x4 tr_read(int vb) {
  s16x4 r; asm volatile("ds_read_b64_tr_b16 %0, %1 offset:%2" : "=&v"(r) : "v"(vb), "i"(OFF) : "memory"); return r;
}
template <int D0> __device__ __forceinline__ void pv_one(f32x16& od, int vb, bf16x8 pa0, bf16x8 pa1, bf16x8 pa2, bf16x8 pa3) {
  const s16x4 l0 = tr_read<v_rd_off(D0, 0, 0)>(vb), h0 = tr_read<v_rd_off(D0, 0, 1)>(vb), l1 = tr_read<v_rd_off(D0, 1, 0)>(vb), h1 = tr_read<v_rd_off(D0, 1, 1)>(vb);
  const s16x4 l2 = tr_read<v_rd_off(D0, 2, 0)>(vb), h2 = tr_read<v_rd_off(D0, 2, 1)>(vb), l3 = tr_read<v_rd_off(D0, 3, 0)>(vb), h3 = tr_read<v_rd_off(D0, 3, 1)>(vb);
  asm volatile("s_waitcnt lgkmcnt(0)" ::: "memory"); SBAR();
#define PK(L, H) (bf16x8){L[0], L[1], L[2], L[3], H[0], H[1], H[2], H[3]}
  od = __builtin_amdgcn_mfma_f32_32x32x16_bf16(pa0, PK(l0, h0), od, 0, 0, 0);
  od = __builtin_amdgcn_mfma_f32_32x32x16_bf16(pa1, PK(l1, h1), od, 0, 0, 0);
  od = __builtin_amdgcn_mfma_f32_32x32x16_bf16(pa2, PK(l2, h2), od, 0, 0, 0);
  od = __builtin_amdgcn_mfma_f32_32x32x16_bf16(pa3, PK(l3, h3), od, 0, 0, 0);
#undef PK
}
__device__ __forceinline__ void pv_d0(f32x16* o, int vb, bf16x8 pa0, bf16x8 pa1, bf16x8 pa2, bf16x8 pa3) {
  pv_one<0>(o[0], vb, pa0, pa1, pa2, pa3); pv_one<1>(o[1], vb, pa0, pa1, pa2, pa3); pv_one<2>(o[2], vb, pa0, pa1, pa2, pa3); pv_one<3>(o[3], vb, pa0, pa1, pa2, pa3);
}
struct VFrag { s16x4 l0, h0, l1, h1, l2, h2, l3, h3; };
typedef short v4i16_t __attribute__((ext_vector_type(4)));
template <int OFF> __device__ __forceinline__ s16x4 tr_read_b(int vb) {
  return __builtin_bit_cast(s16x4, __builtin_amdgcn_ds_read_tr16_b64_v4i16((LAS v4i16_t*)(uintptr_t)(unsigned)(vb + OFF)));
}
template <int D0> __device__ __forceinline__ void tr8b(VFrag& f, int vb) {
  f.l0 = tr_read_b<v_rd_off(D0, 0, 0)>(vb); f.h0 = tr_read_b<v_rd_off(D0, 0, 1)>(vb); f.l1 = tr_read_b<v_rd_off(D0, 1, 0)>(vb); f.h1 = tr_read_b<v_rd_off(D0, 1, 1)>(vb);
  f.l2 = tr_read_b<v_rd_off(D0, 2, 0)>(vb); f.h2 = tr_read_b<v_rd_off(D0, 2, 1)>(vb); f.l3 = tr_read_b<v_rd_off(D0, 3, 0)>(vb); f.h3 = tr_read_b<v_rd_off(D0, 3, 1)>(vb);
}
template <int D0> __device__ __forceinline__ void tr8(VFrag& f, int vb) {
  f.l0 = tr_read<v_rd_off(D0, 0, 0)>(vb); f.h0 = tr_read<v_rd_off(D0, 0, 1)>(vb); f.l1 = tr_read<v_rd_off(D0, 1, 0)>(vb); f.h1 = tr_read<v_rd_off(D0, 1, 1)>(vb);
  f.l2 = tr_read<v_rd_off(D0, 2, 0)>(vb); f.h2 = tr_read<v_rd_off(D0, 2, 1)>(vb); f.l3 = tr_read<v_rd_off(D0, 3, 0)>(vb); f.h3 = tr_read<v_rd_off(D0, 3, 1)>(vb);
}
__device__ __forceinline__ void mfma4(f32x16& od, VFrag& f, bf16x8 pa0, bf16x8 pa1, bf16x8 pa2, bf16x8 pa3) {
#define PK(L, H) (bf16x8){L[0], L[1], L[2], L[3], H[0], H[1], H[2], H[3]}
  od = __builtin_amdgcn_mfma_f32_32x32x16_bf16(pa0, PK(f.l0, f.h0), od, 0, 0, 0);
  od = __builtin_amdgcn_mfma_f32_32x32x16_bf16(pa1, PK(f.l1, f.h1), od, 0, 0, 0);
  od = __builtin_amdgcn_mfma_f32_32x32x16_bf16(pa2, PK(f.l2, f.h2), od, 0, 0, 0);
  od = __builtin_amdgcn_mfma_f32_32x32x16_bf16(pa3, PK(f.l3, f.h3), od, 0, 0, 0);
#undef PK
}
#define VF_TIE(f) "+v"(f.l0), "+v"(f.h0), "+v"(f.l1), "+v"(f.h1), "+v"(f.l2), "+v"(f.h2), "+v"(f.l3), "+v"(f.h3)
__device__ __forceinline__ void pv_pipe(f32x16* o, int vb, bf16x8 pa0, bf16x8 pa1, bf16x8 pa2, bf16x8 pa3) {
  VFrag A, B;
  asm volatile("s_waitcnt lgkmcnt(0)" ::: "memory");
  tr8<0>(A, vb); tr8<1>(B, vb);
  asm volatile("s_waitcnt lgkmcnt(8)" : VF_TIE(A) :: "memory");
  mfma4(o[0], A, pa0, pa1, pa2, pa3);
  tr8<2>(A, vb);
  asm volatile("s_waitcnt lgkmcnt(8)" : VF_TIE(B) :: "memory");
  mfma4(o[1], B, pa0, pa1, pa2, pa3);
  tr8<3>(B, vb);
  asm volatile("s_waitcnt lgkmcnt(8)" : VF_TIE(A) :: "memory");
  mfma4(o[2], A, pa0, pa1, pa2, pa3);
  asm volatile("s_waitcnt lgkmcnt(0)" : VF_TIE(B) :: "memory");
  mfma4(o[3], B, pa0, pa1, pa2, pa3);
}
__device__ __forceinline__ void pv_psm_lean(f32x16* o, int vb, bf16x8 pa0, bf16x8 pa1, bf16x8 pa2, bf16x8 pa3, f32x16& p0, f32x16& p1, f32x16& nm, float& alpha) {
  constexpr float THR2 = 11.541560327111707f;
  const bf16x8 one8 = {0x3F80, 0x3F80, 0x3F80, 0x3F80, 0x3F80, 0x3F80, 0x3F80, 0x3F80};
  VFrag A, B;
  asm volatile("s_waitcnt lgkmcnt(0)" ::: "memory");
  tr8<0>(A, vb); tr8<1>(B, vb);
  asm volatile("s_waitcnt lgkmcnt(8)" : VF_TIE(A) :: "memory");
  mfma4(o[0], A, pa0, pa1, pa2, pa3);
  float dmax = p0[0];
#pragma unroll
  for (int r = 1; r < 16; ++r) dmax = fmaxf(dmax, p0[r]);
  tr8<2>(A, vb);
  asm volatile("s_waitcnt lgkmcnt(8)" : VF_TIE(B) :: "memory");
  mfma4(o[1], B, pa0, pa1, pa2, pa3);
#pragma unroll
  for (int r = 0; r < 16; ++r) dmax = fmaxf(dmax, p1[r]);
  { auto rr = __builtin_amdgcn_permlane32_swap(__float_as_uint(dmax), __float_as_uint(dmax), false, false);
    dmax = fmaxf(__uint_as_float(rr[0]), __uint_as_float(rr[1])); }
  alpha = 1.f;
  if (!__all(dmax <= THR2)) {
    const float delta = dmax > THR2 ? dmax : 0.f; alpha = __builtin_amdgcn_exp2f(-delta);
#pragma unroll
    for (int r = 0; r < 16; ++r) { p0[r] -= delta; p1[r] -= delta; nm[r] -= delta; }
  }
  tr8<3>(B, vb);
  asm volatile("s_waitcnt lgkmcnt(8)" : VF_TIE(A) :: "memory");
  mfma4(o[2], A, pa0, pa1, pa2, pa3);
#pragma unroll
  for (int r = 0; r < 8; ++r) p0[r] = __builtin_amdgcn_exp2f(p0[r]);
  asm volatile("s_waitcnt lgkmcnt(0)" : VF_TIE(B) :: "memory");
  mfma4(o[3], B, pa0, pa1, pa2, pa3);
#pragma unroll
  for (int r = 8; r < 16; ++r) p0[r] = __builtin_amdgcn_exp2f(p0[r]);
  o[4] = __builtin_amdgcn_mfma_f32_32x32x16_bf16(pa0, one8, o[4], 0, 0, 0); o[4] = __builtin_amdgcn_mfma_f32_32x32x16_bf16(pa1, one8, o[4], 0, 0, 0);
  o[4] = __builtin_amdgcn_mfma_f32_32x32x16_bf16(pa2, one8, o[4], 0, 0, 0); o[4] = __builtin_amdgcn_mfma_f32_32x32x16_bf16(pa3, one8, o[4], 0, 0, 0);
}
__device__ __forceinline__ void pv_psm_lean_b(f32x16* o, int vb, bf16x8 pa0, bf16x8 pa1, bf16x8 pa2, bf16x8 pa3, f32x16& p0, f32x16& p1, f32x16& nm, float& alpha) {
  constexpr float THR2 = 11.541560327111707f;
  const bf16x8 one8 = {0x3F80, 0x3F80, 0x3F80, 0x3F80, 0x3F80, 0x3F80, 0x3F80, 0x3F80};
  VFrag A, B;
  tr8b<0>(A, vb); tr8b<1>(B, vb);
  mfma4(o[0], A, pa0, pa1, pa2, pa3);
  float dmax = p0[0];
#pragma unroll
  for (int r = 1; r < 16; ++r) dmax = fmaxf(dmax, p0[r]);
  tr8b<2>(A, vb);
  mfma4(o[1], B, pa0, pa1, pa2, pa3);
#pragma unroll
  for (int r = 0; r < 16; ++r) dmax = fmaxf(dmax, p1[r]);
  { auto rr = __builtin_amdgcn_permlane32_swap(__float_as_uint(dmax), __float_as_uint(dmax), false, false);
    dmax = fmaxf(__uint_as_float(rr[0]), __uint_as_float(rr[1])); }
  alpha = 1.f;
  if (!__all(dmax <= THR2)) {
    const float delta = dmax > THR2 ? dmax : 0.f; alpha = __builtin_amdgcn_exp2f(-delta);
#pragma unroll
    for (int r = 0; r < 16; ++r) { p0[r] -= delta; p1[r] -= delta; nm[r] -= delta; }
  }
  tr8b<3>(B, vb);
  mfma4(o[2], A, pa0, pa1, pa2, pa3);
#pragma unroll
  for (int r = 0; r < 8; ++r) p0[r] = __builtin_amdgcn_exp2f(p0[r]);
  mfma4(o[3], B, pa0, pa1, pa2, pa3);
#pragma unroll
  for (int r = 8; r < 16; ++r) p0[r] = __builtin_amdgcn_exp2f(p0[r]);
  o[4] = __builtin_amdgcn_mfma_f32_32x32x16_bf16(pa0, one8, o[4], 0, 0, 0); o[4] = __builtin_amdgcn_mfma_f32_32x32x16_bf16(pa1, one8, o[4], 0, 0, 0);
  o[4] = __builtin_amdgcn_mfma_f32_32x32x16_bf16(pa2, one8, o[4], 0, 0, 0); o[4] = __builtin_amdgcn_mfma_f32_32x32x16_bf16(pa3, one8, o[4], 0, 0, 0);
}
struct VStep { s16x4 l0, h0, l1, h1, l2, h2, l3, h3; };
template <int KS> __device__ __forceinline__ void trstep(VStep& f, int vb) {
  f.l0 = tr_read_b<v_rd_off(0, KS, 0)>(vb); f.h0 = tr_read_b<v_rd_off(0, KS, 1)>(vb); f.l1 = tr_read_b<v_rd_off(1, KS, 0)>(vb); f.h1 = tr_read_b<v_rd_off(1, KS, 1)>(vb);
  f.l2 = tr_read_b<v_rd_off(2, KS, 0)>(vb); f.h2 = tr_read_b<v_rd_off(2, KS, 1)>(vb); f.l3 = tr_read_b<v_rd_off(3, KS, 0)>(vb); f.h3 = tr_read_b<v_rd_off(3, KS, 1)>(vb);
}
__device__ __forceinline__ void mfma5(f32x16* o, const VStep& f, bf16x8 pa) {
  const bf16x8 one8 = {0x3F80, 0x3F80, 0x3F80, 0x3F80, 0x3F80, 0x3F80, 0x3F80, 0x3F80};
#define PK(L, H) (bf16x8){L[0], L[1], L[2], L[3], H[0], H[1], H[2], H[3]}
  o[0] = __builtin_amdgcn_mfma_f32_32x32x16_bf16(pa, PK(f.l0, f.h0), o[0], 0, 0, 0);
  o[1] = __builtin_amdgcn_mfma_f32_32x32x16_bf16(pa, PK(f.l1, f.h1), o[1], 0, 0, 0);
  o[2] = __builtin_amdgcn_mfma_f32_32x32x16_bf16(pa, PK(f.l2, f.h2), o[2], 0, 0, 0);
  o[3] = __builtin_amdgcn_mfma_f32_32x32x16_bf16(pa, PK(f.l3, f.h3), o[3], 0, 0, 0);
  o[4] = __builtin_amdgcn_mfma_f32_32x32x16_bf16(pa, one8, o[4], 0, 0, 0);
#undef PK
}
template <int BASE> __device__ __forceinline__ bf16x8 pk4e(const f32x16& P) {
  const float e0 = __builtin_amdgcn_exp2f(P[BASE + 0]), e1 = __builtin_amdgcn_exp2f(P[BASE + 1]), e2 = __builtin_amdgcn_exp2f(P[BASE + 2]), e3 = __builtin_amdgcn_exp2f(P[BASE + 3]);
  const float e4 = __builtin_amdgcn_exp2f(P[BASE + 4]), e5 = __builtin_amdgcn_exp2f(P[BASE + 5]), e6 = __builtin_amdgcn_exp2f(P[BASE + 6]), e7 = __builtin_amdgcn_exp2f(P[BASE + 7]);
  const unsigned a0 = cvtpk(e0, e1), a1 = cvtpk(e2, e3), b0 = cvtpk(e4, e5), b1 = cvtpk(e6, e7);
  const auto r0 = __builtin_amdgcn_permlane32_swap(a0, b0, false, false); const auto r1 = __builtin_amdgcn_permlane32_swap(a1, b1, false, false);
  u32x4 w = {r0[0], r1[0], r0[1], r1[1]}; return *reinterpret_cast<bf16x8*>(&w);
}
__device__ __forceinline__ float rowmax_lean(const f32x16& p0, const f32x16& p1) {
  float d = p0[0];
#pragma unroll
  for (int r = 1; r < 16; ++r) d = fmaxf(d, p0[r]);
#pragma unroll
  for (int r = 0; r < 16; ++r) d = fmaxf(d, p1[r]);
  const auto rr = __builtin_amdgcn_permlane32_swap(__float_as_uint(d), __float_as_uint(d), false, false);
  return fmaxf(__uint_as_float(rr[0]), __uint_as_float(rr[1]));
}
__device__ __forceinline__ void shift_lean(float dmax, f32x16& p0, f32x16& p1, f32x16& nm, float& alpha, const bool first) {
  constexpr float THR2 = 11.541560327111707f;
  alpha = 1.f;
  if (first || !__all(dmax <= THR2)) {
    const float delta = first ? dmax : (dmax > THR2 ? dmax : 0.f);
    if (!first) alpha = __builtin_amdgcn_exp2f(-delta);
#pragma unroll
    for (int r = 0; r < 16; ++r) { p0[r] -= delta; p1[r] -= delta; nm[r] -= delta; }
  }
}
#define SGB(mask, n) __builtin_amdgcn_sched_group_barrier((mask), (n), 0)
__device__ __forceinline__ bf16x8 ld8(const bf16* p) { return *reinterpret_cast<const bf16x8*>(p); }

template <int MODE, int ATTV = 0>
__device__ __forceinline__ void attn_unit(const bf16* __restrict__ Qrow0, int ldq, const bf16* __restrict__ Kb, const bf16* __restrict__ Vb, int ldk, const bf16* __restrict__ KRb,
                                          int b, int nct, int NT, bf16* __restrict__ Ob, float lam, const float* __restrict__ subln, float oscale, LAS unsigned char* lds_, const int tid_in) {
  constexpr bool LEAN = (MODE == 1) && ATT_LEAN; constexpr int NQF = MODE == 0 ? 12 : 4, NQR = MODE == 0 ? 4 : 0, NOB = LEAN ? 5 : 4, PITCH = MODE == 0 ? 384 : 256, SHM_V = 16384, SHM_K = 64 * PITCH, SDEPTH = ATT_SDEPTH(MODE); constexpr bool PVPIPE = ATT_PVPIPE(MODE);
  const float SCALE = MODE == 0 ? 0.07216878364870323f : 0.125f;
  const float C = SCALE * 1.4426950408889634f, THRS = 8.f / SCALE;
  if (ATT_PRIO) { if (__builtin_amdgcn_readfirstlane(tid_in >> 8) != 0) __builtin_amdgcn_s_setprio(1); }
  const int tid = launder_v(tid_in) & 511, wid = tid >> 6, lane = tid & 63, r32 = lane & 31, hi = lane >> 5;
  LAS char* lds = (LAS char*)(LAS unsigned char*)lds_;
  constexpr bool THREE = (MODE == 1) && ATT_3STAGE; constexpr int NSTG = THREE ? 3 : 2, STG = SHM_V + SHM_K, SCR0 = NSTG * STG;
#define VOFF(s) (!THREE ? (s) * SHM_V : (s) * STG)
#define KOFF(s) (!THREE ? 2 * SHM_V + (s) * SHM_K : (s) * STG + SHM_V)
  LAS char* V_lds = lds; LAS char* K_lds = lds;
  LAS float* wsf = (LAS float*)(lds + NSTG * (SHM_V + SHM_K)) + wid * 64; LAS float* li_l = wsf; LAS float* al_l = wsf + 32;
  const int wq = MODE == 0 ? wid : (wid & 3), sgrp = MODE == 0 ? 0 : (wid >> 2);
  float m_reg = -1e30f, l_reg = 0; f32x16 o[NOB] = {}; bf16x8 qr[NQR > 0 ? NQR : 1]; f32x16 nm = {};
  LAS char* ql = lds + SCR0 + 2048 + wid * (MODE == 0 ? 8192 : 4096) + lane * 16;
  const bf16* Qw = Qrow0 + (size_t)(wq * 32 + r32) * ldq + sgrp * 64 + hi * 8;
#define QLOADS() do { _Pragma("unroll") for (int d0 = 0; d0 < NQR; ++d0) qr[d0] = ld8(Qw + d0 * 16); \
    _Pragma("unroll") for (int d0 = NQR; d0 < NQF; ++d0) { bf16x8 qv = ld8(Qw + d0 * 16); if (LEAN) qv = scale_bf16x8(qv, C); *(LAS bf16x8*)(ql + (d0 - NQR) * 1024) = qv; } } while (0)
  constexpr bool QLATE = ATT_QLATE && !((MODE == 1) && ATT_3STAGE) && !((MODE == 1) && ATT_LEAN && ATT_KMAJOR && (ATTV == 0));
  if (!QLATE) QLOADS();
  const int sr = tid >> 4, sc = (tid & 15) * 8, vst0 = v_st(sr, sc), vst1 = v_st(32 + sr, sc);
  const int kst0 = sr * PITCH + (((tid & 15) ^ kswz<PITCH>(sr)) * 16), kst1 = kst0 + 32 * PITCH;
  const int rrow = tid >> 3, krs = rrow * PITCH + (((16 + (tid & 7)) ^ kswz<PITCH>(rrow)) * 16);
  const int chunk0 = sgrp * 8;
  const int vb0 = (int)(uintptr_t)V_lds + v_rd_base(lane);
  struct Slot { bf16x8 vs0, vs1, ks0, ks1, kr; } sr_[SDEPTH];
#define KROW(jt) ((jt) < nct ? (ML + b * CTXL + (jt) * 64) : (b * SEQ + ((jt) - nct) * 64))
#define SLOAD(i, jt) do { const int k0_ = KROW(jt); sr_[i].vs0 = ld8(Vb + (size_t)(k0_ + sr) * ldk + sc); sr_[i].vs1 = ld8(Vb + (size_t)(k0_ + 32 + sr) * ldk + sc); \
    sr_[i].ks0 = ld8(Kb + (size_t)(k0_ + sr) * ldk + sc); sr_[i].ks1 = ld8(Kb + (size_t)(k0_ + 32 + sr) * ldk + sc); \
    if (MODE == 0) sr_[i].kr = ld8(KRb + (size_t)(k0_ + rrow) * 64 + (tid & 7) * 8); } while (0)
#define SWRITE(bf, i) do { *(LAS bf16x8*)(V_lds + VOFF(bf) + vst0) = sr_[i].vs0; *(LAS bf16x8*)(V_lds + VOFF(bf) + vst1) = sr_[i].vs1; \
    *(LAS bf16x8*)(K_lds + KOFF(bf) + kst0) = sr_[i].ks0; *(LAS bf16x8*)(K_lds + KOFF(bf) + kst1) = sr_[i].ks1; \
    if (MODE == 0) *(LAS bf16x8*)(K_lds + KOFF(bf) + krs) = sr_[i].kr; } while (0)
#define SWAIT() do { if constexpr (SDEPTH == 2) asm volatile("s_waitcnt vmcnt(4)" ::: "memory"); else asm volatile("s_waitcnt vmcnt(0)" ::: "memory"); } while (0)
#define RESC(a) do { if (__any((a) < 1.f)) { if (hi == 0) al_l[r32] = (a); asm volatile("s_waitcnt lgkmcnt(0)" ::: "memory"); \
    _Pragma("unroll") for (int d = 0; d < NOB; ++d) _Pragma("unroll") for (int r = 0; r < 16; ++r) o[d][r] *= al_l[crow(r, hi)]; } } while (0)
#define PV(vb_) do { if constexpr (ATTV == 2) { o[0][0] += __uint_as_float((unsigned)pa0[0] + (unsigned)pa3[1]); } else if constexpr (PVPIPE) pv_pipe(o, (vb_), pa0, pa1, pa2, pa3); else pv_d0(o, (vb_), pa0, pa1, pa2, pa3); \
    if constexpr (LEAN) { const bf16x8 one8 = {0x3F80, 0x3F80, 0x3F80, 0x3F80, 0x3F80, 0x3F80, 0x3F80, 0x3F80};     \
        o[NOB - 1] = __builtin_amdgcn_mfma_f32_32x32x16_bf16(pa0, one8, o[NOB - 1], 0, 0, 0); o[NOB - 1] = __builtin_amdgcn_mfma_f32_32x32x16_bf16(pa1, one8, o[NOB - 1], 0, 0, 0); \
        o[NOB - 1] = __builtin_amdgcn_mfma_f32_32x32x16_bf16(pa2, one8, o[NOB - 1], 0, 0, 0); o[NOB - 1] = __builtin_amdgcn_mfma_f32_32x32x16_bf16(pa3, one8, o[NOB - 1], 0, 0, 0); } } while (0)
#define PSM(p0_, p1_, mn_, al_, first_) do { if constexpr (ATTV == 1) { al_ = 1.f; } else if constexpr (LEAN) partialSM_lean(p0_, p1_, nm, al_, first_); else partialSM(p0_, p1_, m_reg, mn_, al_, C, THRS); } while (0)
#define FSM(p0_, p1_, al_) do { if constexpr (ATTV == 1) { u32x4 w0_ = {__float_as_uint(p0_[0]), __float_as_uint(p0_[1]), __float_as_uint(p1_[0]), __float_as_uint(p1_[1])}; pa0 = pa1 = pa2 = pa3 = *reinterpret_cast<bf16x8*>(&w0_); } else if constexpr (LEAN) finishSM_lean(p0_, p1_, pa0, pa1, pa2, pa3); else finishSM(p0_, p1_, al_, l_reg, pa0, pa1, pa2, pa3); } while (0)
#define QKT(p0_, p1_, Kp_) do { if constexpr (ATTV == 5) { p0_ = nm; p1_ = nm; p0_[0] += (float)r32; } else if constexpr (LEAN) qkt<NQF, NQR, PITCH>(p0_, p1_, Kp_, chunk0, qr, ql, r32, hi, nm); else qkt<NQF, NQR, PITCH>(p0_, p1_, Kp_, chunk0, qr, ql, r32, hi); } while (0)
  f32x16 pA0, pA1, pB0, pB1; float mnA, mnB, alA, alB; bf16x8 pa0, pa1, pa2, pa3;
  constexpr bool KMAJ = (MODE == 1) && LEAN && ATT_KMAJOR && (ATTV == 0) && !THREE;
  if constexpr (KMAJ) {
    VStep VA, VB;
#define KSTEPS(PC0, PC1, ALC, PP0, PP1, KC, VP, LD, DOQK) do { const int vb_ = vb0 + VOFF(VP); float dmx_ = 0.f; \
      SBAR(); \
      if (DOQK) QKT(PC0, PC1, K_lds + KOFF(KC)); \
      pa0 = pk4e<0>(PP0); trstep<0>(VA, vb_); \
      _Pragma("unroll") for (int i_ = 0; i_ < 8; ++i_) { SGB(0x008, 1); SGB(0x100, 3); SGB(0x002, 2); } \
      SBAR(); LD; SBAR(); \
      mfma5(o, VA, pa0); pa1 = pk4e<8>(PP0); trstep<1>(VB, vb_); \
      _Pragma("unroll") for (int i_ = 0; i_ < 5; ++i_) { SGB(0x008, 1); SGB(0x100, 2); SGB(0x002, 3); } \
      SBAR(); \
      mfma5(o, VB, pa1); pa2 = pk4e<0>(PP1); trstep<2>(VA, vb_); \
      _Pragma("unroll") for (int i_ = 0; i_ < 5; ++i_) { SGB(0x008, 1); SGB(0x100, 2); SGB(0x002, 3); } \
      SBAR(); \
      mfma5(o, VA, pa2); pa3 = pk4e<8>(PP1); trstep<3>(VB, vb_); \
      _Pragma("unroll") for (int i_ = 0; i_ < 5; ++i_) { SGB(0x008, 1); SGB(0x100, 2); SGB(0x002, 3); } \
      SBAR(); \
      mfma5(o, VB, pa3); if (DOQK) dmx_ = rowmax_lean(PC0, PC1); \
      _Pragma("unroll") for (int i_ = 0; i_ < 5; ++i_) { SGB(0x008, 1); SGB(0x002, 7); } \
      SBAR(); \
      if (DOQK) shift_lean(dmx_, PC0, PC1, nm, ALC, false); } while (0)
    SLOAD(0, 0); asm volatile("s_waitcnt vmcnt(0)" ::: "memory"); SWRITE(0, 0); __syncthreads();
    QKT(pA0, pA1, K_lds + KOFF(0)); shift_lean(rowmax_lean(pA0, pA1), pA0, pA1, nm, alA, true);
    SLOAD(0, 1); asm volatile("s_waitcnt vmcnt(0)" ::: "memory"); SWRITE(1, 0); __syncthreads();
    for (int j = 1; j + 1 < NT; j += 2) {
      KSTEPS(pB0, pB1, alB, pA0, pA1, 1, 0, SLOAD(0, j + 1), true);
      __syncthreads(); asm volatile("s_waitcnt vmcnt(0)" ::: "memory"); SWRITE(0, 0);
      RESC(alB); __syncthreads();
      KSTEPS(pA0, pA1, alA, pB0, pB1, 0, 1, SLOAD(0, j + 2), true);
      __syncthreads(); asm volatile("s_waitcnt vmcnt(0)" ::: "memory"); SWRITE(1, 0);
      RESC(alA); __syncthreads();
    }
    KSTEPS(pB0, pB1, alB, pA0, pA1, 1, 0, (void)0, true);
    __syncthreads(); RESC(alB);
    KSTEPS(pA0, pA1, alA, pB0, pB1, 0, 1, (void)0, false);
#undef KSTEPS
  } else if constexpr (!THREE) {
  constexpr int SE = 0, SO = SDEPTH - 1;
  SLOAD(SE, 0); if (QLATE) QLOADS(); asm volatile("s_waitcnt vmcnt(0)" ::: "memory"); SWRITE(0, SE);
  if constexpr (QLATE && SDEPTH == 1) SLOAD(SO, 1);
  __syncthreads();
  QKT(pA0, pA1, K_lds + KOFF(0)); PSM(pA0, pA1, mnA, alA, true);
  if constexpr (!(QLATE && SDEPTH == 1)) SLOAD(SO, 1);
  if constexpr (SDEPTH == 2) { if (2 < NT) SLOAD(SE, 2); }
  SWAIT(); SWRITE(1, SO); __syncthreads();
#define ILV() do { if constexpr (PVPIPE) { _Pragma("unroll") for (int i_ = 0; i_ < 20; ++i_) { __builtin_amdgcn_sched_group_barrier(0x008, 1, 0); __builtin_amdgcn_sched_group_barrier(0x002, 5, 0); } } } while (0)
#define LSLOAD(i, jt) do { if constexpr (ATTV != 3) SLOAD(i, jt); } while (0)
#define LSWRITE(bf, i) do { if constexpr (ATTV != 3) SWRITE(bf, i); } while (0)
#define LSWAIT() do { if constexpr (ATTV != 3) SWAIT(); } while (0)
#define LSYNC() do { if constexpr (ATTV != 4) __syncthreads(); } while (0)
#define HALFSTEP(PC0, PC1, MNC, ALC, PP0, PP1, ALP, KC, VP, LD) do { \
    if (!STAG || wid < 4) { \
      SBAR(); QKT(PC0, PC1, K_lds + KOFF(KC)); FSM(PP0, PP1, ALP); SBAR(); \
      LD; SBAR(); \
      if constexpr (PVPIPE && LEAN && ATTV == 0) { if constexpr (ATT_TRB) pv_psm_lean_b(o, vb0 + VOFF(VP), pa0, pa1, pa2, pa3, PC0, PC1, nm, ALC); else pv_psm_lean(o, vb0 + VOFF(VP), pa0, pa1, pa2, pa3, PC0, PC1, nm, ALC); } else { PV(vb0 + VOFF(VP)); PSM(PC0, PC1, MNC, ALC, false); } \
    } else { \
      SBAR(); FSM(PP0, PP1, ALP); SBAR(); \
      LD; SBAR(); \
      PV(vb0 + VOFF(VP)); SBAR(); \
      QKT(PC0, PC1, K_lds + KOFF(KC)); SBAR(); \
      PSM(PC0, PC1, MNC, ALC, false); \
    } } while (0)
  constexpr bool STAG = (MODE == 1) && ATT_STAGGER && ATTV == 0;
  for (int j = 1; j + 1 < NT; j += 2) {
    HALFSTEP(pB0, pB1, mnB, alB, pA0, pA1, alA, 1, 0, LSLOAD(SO, j + SDEPTH));
    LSYNC(); LSWAIT(); LSWRITE(0, SE);
    RESC(alB); LSYNC();
    HALFSTEP(pA0, pA1, mnA, alA, pB0, pB1, alB, 0, 1, if (SDEPTH == 1 || j + 3 < NT) LSLOAD(SE, j + 1 + SDEPTH));
    LSYNC(); LSWAIT(); LSWRITE(1, SO);
    RESC(alA); LSYNC();
  }
#undef HALFSTEP
#undef ILV
#undef LSLOAD
#undef LSWRITE
#undef LSWAIT
#undef LSYNC
  SBAR(); QKT(pB0, pB1, K_lds + KOFF(1));
  FSM(pA0, pA1, alA); SBAR();
  PV(vb0); PSM(pB0, pB1, mnB, alB, false);
  __syncthreads(); RESC(alB);
  FSM(pB0, pB1, alB); SBAR();
  PV(vb0 + VOFF(1));
  } else {
#define STEP(PC0, PC1, ALC, PP0, PP1, ALP, jj, SP, SC, SN) do { const int j_ = (jj); \
      if (j_ + 1 < NT) { asm volatile("s_waitcnt vmcnt(0)" ::: "memory"); SWRITE(SN, 0); if (j_ + 2 < NT) SLOAD(0, j_ + 2); } \
      SBAR(); QKT(PC0, PC1, K_lds + KOFF(SC)); FSM(PP0, PP1, ALP); SBAR(); \
      PV(vb0 + VOFF(SP)); PSM(PC0, PC1, mnA, ALC, false); \
      RESC(ALC); __syncthreads(); } while (0)
    SLOAD(0, 0); asm volatile("s_waitcnt vmcnt(0)" ::: "memory"); SWRITE(0, 0);
    SLOAD(0, 1); asm volatile("s_waitcnt vmcnt(0)" ::: "memory"); SWRITE(1, 0);
    SLOAD(0, 2); __syncthreads();
    QKT(pA0, pA1, K_lds + KOFF(0)); PSM(pA0, pA1, mnA, alA, true);
    STEP(pB0, pB1, alB, pA0, pA1, alA, 1, 0, 1, 2);
    int j = 2;
    for (; j + 5 < NT; j += 6) {
      STEP(pA0, pA1, alA, pB0, pB1, alB, j, 1, 2, 0);
      STEP(pB0, pB1, alB, pA0, pA1, alA, j + 1, 2, 0, 1);
      STEP(pA0, pA1, alA, pB0, pB1, alB, j + 2, 0, 1, 2);
      STEP(pB0, pB1, alB, pA0, pA1, alA, j + 3, 1, 2, 0);
      STEP(pA0, pA1, alA, pB0, pB1, alB, j + 4, 2, 0, 1);
      STEP(pB0, pB1, alB, pA0, pA1, alA, j + 5, 0, 1, 2);
    }
    if (j < NT) { STEP(pA0, pA1, alA, pB0, pB1, alB, j, 1, 2, 0); STEP(pB0, pB1, alB, pA0, pA1, alA, j + 1, 2, 0, 1); j += 2; }
    if (j < NT) { STEP(pA0, pA1, alA, pB0, pB1, alB, j, 0, 1, 2); STEP(pB0, pB1, alB, pA0, pA1, alA, j + 1, 1, 2, 0); j += 2; }
    FSM(pB0, pB1, alB); SBAR();
    { const int sl = (NT - 1) % 3; PV(vb0 + VOFF(sl)); }
#undef STEP
  }
  float rli[16];
  if constexpr (LEAN) {
#pragma unroll
    for (int r = 0; r < 16; ++r) rli[r] = __builtin_amdgcn_rcpf(o[NOB - 1][r]);
  } else {
    if (hi == 0) li_l[r32] = l_reg; asm volatile("s_waitcnt lgkmcnt(0)" ::: "memory");
#pragma unroll
    for (int r = 0; r < 16; ++r) rli[r] = __builtin_amdgcn_rcpf(li_l[crow(r, hi)]);
  }
  bf16* Ow = Ob + (size_t)(wq * 32) * DM;
  if constexpr (MODE == 0) {
#pragma unroll
    for (int r = 0; r < 16; ++r) { const int orow = crow(r, hi);
#pragma unroll
      for (int d0 = 0; d0 < 4; ++d0) Ow[(size_t)orow * DM + d0 * 32 + r32] = tobf1(o[d0][r] * rli[r]); }
    __syncthreads();
  } else {
    LAS float* ex = (LAS float*)lds;
    __syncthreads();
    if (sgrp == 1) {
#pragma unroll
      for (int r = 0; r < 16; ++r)
#pragma unroll
        for (int d0 = 0; d0 < 4; ++d0) ex[(wq * 32 + crow(r, hi)) * 128 + d0 * 32 + r32] = o[d0][r] * rli[r];
    }
    __syncthreads();
    if (sgrp == 0) {
#pragma unroll
      for (int r = 0; r < 16; ++r) { const int orow = crow(r, hi); float dd[4]; float ss = 0.f;
#pragma unroll
        for (int d0 = 0; d0 < 4; ++d0) { dd[d0] = o[d0][r] * rli[r] - lam * ex[(wq * 32 + orow) * 128 + d0 * 32 + r32]; ss += dd[d0] * dd[d0]; }
        ss = half_sum32(ss);
        const float rs = oscale / sqrtf(ss * (1.0f / 128.0f) + LN_EPS);
#pragma unroll
        for (int d0 = 0; d0 < 4; ++d0) Ow[(size_t)orow * DM + d0 * 32 + r32] = tobf1(dd[d0] * rs * subln[d0 * 32 + r32]); }
    }
    __syncthreads();
  }
  if (ATT_PRIO) __builtin_amdgcn_s_setprio(0);
#undef VOFF
#undef KOFF
#undef PV
#undef PSM
#undef FSM
#undef QKT
#undef KROW
#undef SLOAD
#undef SWRITE
#undef SWAIT
#undef RESC
}
}

__device__ __forceinline__ void mla_attn_phase(CP P, LAS unsigned char* lds, const int tid) {
    const bf16* QM = (const bf16*)(P->ws + WS_QM); const bf16* KV = (const bf16*)(P->ws + WS_KV); const bf16* KR = (const bf16*)(P->ws + WS_KR); bf16* Gb = (bf16*)(P->ws + WS_G);
    const int c = blockIdx.x, G = gridDim.x;
    for (int u = c; u < 1024 + 32; u += G) {
        int b, h, qrow0, NT;
        if (u < 1024) { const int i = u >> 8, cc = u & 255; const int bh = (cc & 7) + 8 * i, qb = cc >> 3; b = bh >> 4; h = bh & 15; qrow0 = b * SEQ + qb * 256; NT = 4 + 128; }
        else { const int bh = u - 1024; b = bh >> 4; h = bh & 15; qrow0 = ML + b * CTXL; NT = 4; }
        att::attn_unit<0>(QM + (size_t)qrow0 * 3072 + h * 192, 3072, KV + h * 256, KV + h * 256 + 128, 4096, KR, b, 4, NT, Gb + (size_t)qrow0 * DM + h * 128, 0.f, nullptr, 1.f, lds, tid);
    }
}
template <int ATTV = 0>
__device__ __forceinline__ void da_attn_phase(CP P, float lam, float oscale, LAS unsigned char* lds, const int tid, const bool ctx_q, const int nt_cap = 0) {
    const bf16* Z = (const bf16*)(P->ws + WS_Z); bf16* Gb = (bf16*)(P->ws + WS_G); const float* subln = P->in[27];
    const int c = blockIdx.x, G = gridDim.x;
    for (int u = c; u < 2048 + (ctx_q ? 64 : 0); u += G) {
        int b, h, qrow0, NT;
        if (u < 2048) { const int i = u >> 8, cc = u & 255; const int bh = (cc & 7) + 8 * (i >> 1), qb = (cc >> 3) + 32 * (i & 1); b = bh >> 4; h = bh & 15; qrow0 = b * SEQ + qb * 128; NT = 4 + 128; }
        else { const int v = u - 2048; const int bh = v >> 1; b = bh >> 4; h = bh & 15; qrow0 = ML + b * CTXL + (v & 1) * 128; NT = 4; }
        if (nt_cap) NT = nt_cap;
        att::attn_unit<1, ATTV>(Z + (size_t)qrow0 * 6144 + h * 128, 6144, Z + 2048 + h * 128, Z + 4096 + h * 128, 6144, nullptr, b, 4, NT, Gb + (size_t)qrow0 * DM + h * 128, lam, subln, oscale, lds, tid);
    }
}

__device__ __forceinline__ unsigned f2ord(float f) { const unsigned u = __float_as_uint(f); return u ^ ((unsigned)((int)u >> 31) | 0x80000000u); }
__device__ __forceinline__ float ord2f(unsigned k) { return __uint_as_float((k & 0x80000000u) ? (k ^ 0x80000000u) : ~k); }
__device__ __forceinline__ void ce_desc(unsigned& a, unsigned& b) { const unsigned mx = a > b ? a : b, mn = a > b ? b : a; a = mx; b = mn; }
template <int N, bool DESC> __device__ __forceinline__ void bitonic_merge(unsigned* a) {
#pragma unroll
    for (int j = N / 2; j > 0; j >>= 1)
#pragma unroll
        for (int i = 0; i < N; ++i) { const int l = i ^ j; if (l > i) { if (DESC) ce_desc(a[i], a[l]); else ce_desc(a[l], a[i]); } }
}
template <int N, bool DESC> __device__ __forceinline__ void bitonic_sort(unsigned* a) {
#pragma unroll
    for (int k = 2; k <= N; k <<= 1)
#pragma unroll
        for (int j = k >> 1; j > 0; j >>= 1)
#pragma unroll
            for (int i = 0; i < N; ++i) { const int l = i ^ j; if (l > i) { const bool up = ((i & k) == 0); if (up == DESC) ce_desc(a[i], a[l]); else ce_desc(a[l], a[i]); } }
}
__device__ __forceinline__ void top16_of_64(unsigned (&a)[64]) {
    bitonic_sort<16, true>(a); bitonic_sort<16, false>(a + 16); bitonic_sort<16, true>(a + 32); bitonic_sort<16, false>(a + 48);
#pragma unroll
    for (int i = 0; i < 16; ++i) a[i] = a[i] > a[16 + i] ? a[i] : a[16 + i];
    bitonic_merge<16, true>(a);
#pragma unroll
    for (int i = 0; i < 16; ++i) a[32 + i] = a[32 + i] > a[48 + i] ? a[32 + i] : a[48 + i];
    bitonic_merge<16, false>(a + 32);
#pragma unroll
    for (int i = 0; i < 16; ++i) a[i] = a[i] > a[32 + i] ? a[i] : a[32 + i];
    bitonic_merge<16, true>(a);
}
template <int PASS> __device__ __forceinline__ void route_qload(const bf16* QP, int tok, int head, int hi, bf16x8 (&qf)[8]) {
    const bf16* qp = QP + (size_t)tok * DM + head * 256 + PASS * 128 + hi * 8;
#pragma unroll
    for (int ks = 0; ks < 8; ++ks) qf[ks] = NT_ACT ? __builtin_nontemporal_load((const bf16x8*)(qp + ks * 16)) : *(const bf16x8*)(qp + ks * 16);
}
template <int PASS> __device__ __forceinline__ void route_pass(const bf16x8 (&qf)[8], const LAS char* lds, int tok, int head, int r32, int hi, unsigned (&top)[16]) {
    f32x16 acc[4] = {};
    const LAS char* Kl = lds + PASS * 32768;
#pragma unroll
    for (int kb = 0; kb < 4; ++kb)
#pragma unroll
        for (int ks = 0; ks < 8; ++ks) { const bf16x8 a = *(const LAS bf16x8*)(Kl + (kb * 32 + r32) * 256 + (((ks * 2 + hi) ^ (r32 & 15)) * 16));
            acc[kb] = __builtin_amdgcn_mfma_f32_32x32x16_bf16(a, qf[ks], acc[kb], 0, 0, 0); }
    unsigned key[64]; const unsigned base = 127u - 4u * (unsigned)hi;
#pragma unroll
    for (int kb = 0; kb < 4; ++kb)
#pragma unroll
        for (int r = 0; r < 16; ++r) key[kb * 16 + r] = (f2ord(acc[kb][r]) & ~127u) | (base - (unsigned)(kb * 32 + (r & 3) + 8 * (r >> 2)));
    top16_of_64(key);
    unsigned pr[16];
#pragma unroll
    for (int i = 0; i < 16; ++i) pr[i] = lane_xor32(key[15 - i], hi << 5);
#pragma unroll
    for (int i = 0; i < 16; ++i) key[i] = key[i] > pr[i] ? key[i] : pr[i];
    bitonic_merge<16, true>(key);
#pragma unroll
    for (int i = 0; i < 16; ++i) top[i] = key[i];
}
#ifndef ROUTE_SORT
#define ROUTE_SORT 1
#endif
#define DPP_U(v, ctrl) ((unsigned)__builtin_amdgcn_mov_dpp((int)(v), (ctrl), 0xF, 0xF, true))
template <int J> __device__ __forceinline__ unsigned lane_xor_u(unsigned v, int lane) {
    if (J == 1) return DPP_U(v, 0xB1);
    if (J == 2) return DPP_U(v, 0x4E);
    if (J == 4) { const unsigned t = DPP_U(v, 0x141); return DPP_U(t, 0x1B); }
    if (J == 8) { const unsigned t = DPP_U(v, 0x140); return DPP_U(t, 0x141); }
    if (J == 16) { const auto r = __builtin_amdgcn_permlane16_swap(v, v, false, false); return (lane & 16) ? r[0] : r[1]; }
    return lane_xor32(v, lane);
}
template <int K, int J> __device__ __forceinline__ void sort128_stage(unsigned& a0, unsigned& a1, int lane) {
    if constexpr (J == 64) { const unsigned mn = a0 < a1 ? a0 : a1, mx = a0 < a1 ? a1 : a0; a0 = mn; a1 = mx; }
    else { const unsigned p0 = lane_xor_u<J>(a0, lane), p1 = lane_xor_u<J>(a1, lane);
        const bool lower = (lane & J) == 0;
        const bool asc0 = (K >= 64) ? true : ((lane & K) == 0), asc1 = (K == 128) ? true : (K == 64 ? false : ((lane & K) == 0));
        const unsigned mn0 = a0 < p0 ? a0 : p0, mx0 = a0 < p0 ? p0 : a0, mn1 = a1 < p1 ? a1 : p1, mx1 = a1 < p1 ? p1 : a1;
        a0 = (lower == asc0) ? mn0 : mx0; a1 = (lower == asc1) ? mn1 : mx1; }
    if constexpr (J > 1) sort128_stage<K, J / 2>(a0, a1, lane);
    else if constexpr (K < 128) sort128_stage<K * 2, K>(a0, a1, lane);
}
__device__ __forceinline__ void sort128_asc(unsigned& a0, unsigned& a1, int lane) { sort128_stage<2, 1>(a0, a1, lane); }
__device__ __forceinline__ void route_phase(CP P, int L, int Mrows, LAS unsigned char* lds_, int tid, int lane, int wid, int gw, int NGW) {
    const bf16* QP = (const bf16*)(P->ws + WS_QP); unsigned* ROUTE = (unsigned*)(P->ws + WS_ROUTE);
    LAS char* lds = (LAS char*)(LAS unsigned char*)lds_;
    __syncthreads();
    {
        const bf16* K1 = (const bf16*)(P->ws + WS_PK1) + (size_t)L * 128 * 128; const bf16* K2 = (const bf16*)(P->ws + WS_PK2) + (size_t)L * 128 * 128;
        u32x4 kw[8];
#pragma unroll
        for (int t = 0; t < 8; ++t) { const int c16 = tid + t * NWAVES * 64; const int mat = c16 >> 11, row = (c16 >> 4) & 127, ch = c16 & 15; kw[t] = *(const u32x4*)((mat ? K2 : K1) + row * 128 + ch * 8); }
#pragma unroll
        for (int t = 0; t < 8; ++t) { const int c16 = tid + t * NWAVES * 64; const int mat = c16 >> 11, row = (c16 >> 4) & 127, ch = c16 & 15; *(LAS u32x4*)(lds + mat * 32768 + row * 256 + ((ch ^ (row & 15)) * 16)) = kw[t]; }
    }
    __syncthreads();
    LAS unsigned* sc = (LAS unsigned*)(lds + 65536) + wid * 2048;
    const int r32 = lane & 31, hi = lane >> 5;
    for (int item = gw; item < Mrows / 4; item += NGW) {
        const int tok = item * 4 + (r32 >> 3), head = r32 & 7;
        unsigned top0[16], top1[16];
        { bf16x8 q0[8], q1[8]; route_qload<0>(QP, tok, head, hi, q0); route_qload<1>(QP, tok, head, hi, q1);
          route_pass<0>(q0, lds, tok, head, r32, hi, top0);
          route_pass<1>(q1, lds, tok, head, r32, hi, top1); }
        float v1[16], v2[16];
#pragma unroll
        for (int i = 0; i < 16; ++i) { v1[i] = ord2f(top0[i] & ~127u); v2[i] = ord2f(top1[i] & ~127u);
            sc[i * 64 + lane] = 127u - (top0[i] & 127u); sc[(16 + i) * 64 + lane] = 127u - (top1[i] & 127u); }
        unsigned ck[64]; int n = 0;
#pragma unroll
        for (int i = 0; i < 16; ++i)
#pragma unroll
            for (int j = 0; j < 16; ++j) if ((i + 1) * (j + 1) <= 16) { ck[n] = (f2ord(v1[i] + v2[j]) & ~255u) | (unsigned)(i * 16 + j); ++n; }
#pragma unroll
        for (int i = 50; i < 64; ++i) ck[i] = 0u;
        top16_of_64(ck);
        float ev[16]; float sum = 0.f; const float mx = ord2f(ck[0] & ~255u);
#pragma unroll
        for (int k = 0; k < 16; ++k) { ev[k] = __expf(ord2f(ck[k] & ~255u) - mx); sum += ev[k]; }
        const float inv = 1.0f / sum;
        unsigned ee[16];
#pragma unroll
        for (int k = 0; k < 16; ++k) { const unsigned pc = ck[k] & 255u; const unsigned i1 = sc[(pc >> 4) * 64 + lane], i2 = sc[(16 + (pc & 15u)) * 64 + lane]; ee[k] = i1 * 128u + i2; ev[k] *= inv; }
#if ROUTE_SORT
        { const int tq = r32 >> 3;
#pragma unroll
          for (int k = 0; k < 8; ++k) {
              const unsigned eL = ee[k], eH = ee[k + 8]; const float gL = ev[k], gH = ev[k + 8];
              sc[tq * 256 + head * 16 + hi * 8 + k] = hi ? eH : eL; sc[tq * 256 + 128 + head * 16 + hi * 8 + k] = __float_as_uint(hi ? gH : gL); }
#pragma unroll 1
          for (int t = 0; t < 4; ++t) {
              unsigned a0 = (sc[t * 256 + lane] << 7) | (unsigned)lane, a1 = (sc[t * 256 + 64 + lane] << 7) | (unsigned)(64 + lane);
              sort128_asc(a0, a1, lane);
              const unsigned g0 = sc[t * 256 + 128 + (a0 & 127u)], g1 = sc[t * 256 + 128 + (a1 & 127u)];
              u32x2* outp = (u32x2*)(ROUTE + (size_t)(item * 4 + t) * 256);
              outp[lane] = (u32x2){a0 >> 7, g0}; outp[64 + lane] = (u32x2){a1 >> 7, g1}; }
        }
#else
        u32x4* outp = (u32x4*)(ROUTE + ((size_t)tok * 128 + head * 16 + hi * 8) * 2);
#pragma unroll
        for (int k = 0; k < 8; k += 2) { u32x4 w;
            const unsigned eL0 = ee[k], eH0 = ee[k + 8], eL1 = ee[k + 1], eH1 = ee[k + 9]; const float gL0 = ev[k], gH0 = ev[k + 8], gL1 = ev[k + 1], gH1 = ev[k + 9];
            w.x = hi ? eH0 : eL0; w.y = __float_as_uint(hi ? gH0 : gL0); w.z = hi ? eH1 : eL1; w.w = __float_as_uint(hi ? gH1 : gL1);
            outp[k >> 1] = w; }
#endif
    }
}

typedef float f32x2 __attribute__((ext_vector_type(2)));
typedef float f32x32 __attribute__((ext_vector_type(32)));
typedef unsigned u32x6 __attribute__((ext_vector_type(6)));
typedef __bf16 bf16x32 __attribute__((ext_vector_type(32)));
typedef unsigned u32x16 __attribute__((ext_vector_type(16)));
typedef __bf16 bf16x2_t __attribute__((ext_vector_type(2)));
#ifndef GATHER_ZIGZAG
#define GATHER_ZIGZAG 0
#endif
#ifndef GATHER_PRE
#define GATHER_PRE 0
#endif
#ifndef GATHER_XEARLY
#define GATHER_XEARLY 0
#endif
#ifndef GATHER_SWP
#define GATHER_SWP 0
#endif
#ifndef GATHER_VECREG
#define GATHER_VECREG 1
#endif
#ifndef GATHER_MFMADOT
#define GATHER_MFMADOT 1
#endif
typedef short s16x4_t __attribute__((ext_vector_type(4)));
#ifndef GATHER_PAIRRED
#define GATHER_PAIRRED 1
#endif
#ifndef GATHER_EARLY
#define GATHER_EARLY 1
#endif
#ifndef GATHER_PACE
#define GATHER_PACE 0
#endif
#define XB_PACE(j) (XCD_BAR_WORDS + 64 * (j))
#ifndef GATHER_DEEP
#define GATHER_DEEP 0
#endif
constexpr int GS = GATHER_DEEP ? 8 : 6, GSLOT = GATHER_DEEP ? 2048 : 2 * PROW;
__device__ __forceinline__ void glds16(const void* gsrc, unsigned lds_dst) { unsigned keep;
  asm volatile("s_mov_b32 %0, m0\n\ts_mov_b32 m0, %2\n\ts_nop 0\n\tglobal_load_lds_dwordx4 %1, off\n\ts_mov_b32 m0, %0" : "=&s"(keep) : "v"(gsrc), "s"(lds_dst) : "memory"); }
template <int GMODE = 0>
__device__ __forceinline__ void gather_phase(CP P, int L, int Mrows, LAS unsigned char* lds, int wid, int lane_, int gw, int NGW, bool dry = false) {
    const unsigned char* UV = P->ws + WS_PU + (size_t)L * 16384 * PREC;
    const unsigned* ROUTE = (const unsigned*)(P->ws + WS_ROUTE); const float* MOD = (const float*)(P->ws + WS_MOD);
    bf16* X = (bf16*)(P->ws + WS_X); bf16* H = (bf16*)(P->ws + WS_H); bf16* Xo = dry ? (bf16*)(P->ws + WS_Y) : X; bf16* Ho = dry ? (bf16*)(P->ws + WS_G) : H;
    const float* lng = P->in[6] + (size_t)(L * 2 + 1) * DM; const float* lnb = P->in[7] + (size_t)(L * 2 + 1) * DM;
    const unsigned ring = (unsigned)(uintptr_t)lds + (unsigned)wid * (GS * GSLOT);
    const int nfull = (Mrows / NGW) * NGW, rem = Mrows - nfull; const bool can_coop = (rem * 4 == NGW);
    const int nround = nfull / NGW + (rem > 0 ? 1 : 0);
    const bool pace_ok = (rem == 0) || can_coop;
#define G_ROWOF(it_) ((can_coop && (it_) == nround - 1) ? (nfull + (int)blockIdx.x * 2 + (wid >> 2)) : (gw + (it_) * NGW))
    u32x2 nea = {0u, 0u}, neb = {0u, 0u}; u32x4 nh0 = {0u, 0u, 0u, 0u}, nh1 = nh0, nh2 = nh0, nh3 = nh0;
#define G_NTL(p_) (NT_STREAM > 1 ? __builtin_nontemporal_load(p_) : *(p_))
#define G_PREFETCH(rowN_, ln_) do { const int rn_ = (rowN_); nea = G_NTL(&((const u32x2*)(ROUTE + (size_t)rn_ * 256))[ln_]); neb = G_NTL(&((const u32x2*)(ROUTE + (size_t)rn_ * 256))[64 + (ln_)]); \
        const u32x4* hp_ = (const u32x4*)(H + (size_t)rn_ * DM) + 4 * (ln_); nh0 = G_NTL(hp_); nh1 = G_NTL(hp_ + 1); nh2 = G_NTL(hp_ + 2); nh3 = G_NTL(hp_ + 3); } while (0)
    if (nround > 0 && G_ROWOF(0) < Mrows) G_PREFETCH(G_ROWOF(0), launder_v(lane_));
#if GATHER_VECREG
    LAS unsigned* LNV = (LAS unsigned*)(lds + NWAVES * GS * GSLOT);
    { f32x2 t_[4];
#pragma unroll
      for (int t = 0; t < 4; ++t) { const int i = wid * 64 + lane_ + t * NWAVES * 64; t_[t] = *(const f32x2*)(((i >> 10) ? lnb : lng) + 2 * (i & 1023)); }
#pragma unroll
      for (int t = 0; t < 4; ++t) { const float x0_ = t_[t][0], x1_ = t_[t][1]; LNV[wid * 64 + lane_ + t * NWAVES * 64] = cvtpk(x0_, x1_); } }
    __syncthreads();
    unsigned mg[16], ms[16], mc[16]; int cur_slot = -1;
#pragma unroll
    for (int i = 0; i < 16; ++i) { mg[i] = 0u; ms[i] = 0u; mc[i] = 0u; }
#endif
    bool pre = false;
#pragma unroll 1
    for (int it = 0; it < nround; ++it) {
#if GATHER_PACE
        if (pace_ok && it > 0) {
            if (wid == 0 && lane_ == 0) { const unsigned nloc = ((volatile LAS unsigned*)(lds + MISC_OFF))[8];
                if (nloc != 0u) { unsigned* pc = (unsigned*)(P->ws + WS_CTL) + CW_BAR + XB_PACE(xb_xcc_id());
                    const unsigned old = xb_add(pc, 1u), tgt = (old / nloc + 1u) * nloc; unsigned sp = 0u;
                    while ((int)(xb_ld(pc) - tgt) < 0 && ++sp < 20000u) __builtin_amdgcn_s_sleep(1); } }
            __syncthreads();
        }
#endif
        const bool coop = can_coop && (it == nround - 1);
        int row = G_ROWOF(it), k0 = 0, kn = 128;
        if (coop) { k0 = (wid & 3) * 32; kn = k0 + 32; }
        else if (row >= Mrows) break;
        const int lane = launder_v(lane_);
        const u32x2 ea = nea, eb = neb;
        unsigned eax, eay, ebx, eby;
        unsigned hw[16] = {nh0.x, nh0.y, nh0.z, nh0.w, nh1.x, nh1.y, nh1.z, nh1.w, nh2.x, nh2.y, nh2.z, nh2.w, nh3.x, nh3.y, nh3.z, nh3.w};
        float y[32];
#pragma unroll
        for (int i = 0; i < 32; ++i) y[i] = 0.f;
        { unsigned e0 = ea.x, e1 = ea.y, e2 = eb.x, e3 = eb.y;
          asm volatile("" : "+v"(e0), "+v"(e1), "+v"(e2), "+v"(e3), "+v"(hw[0]), "+v"(hw[1]), "+v"(hw[2]), "+v"(hw[3]), "+v"(hw[4]), "+v"(hw[5]), "+v"(hw[6]), "+v"(hw[7]),
                       "+v"(hw[8]), "+v"(hw[9]), "+v"(hw[10]), "+v"(hw[11]), "+v"(hw[12]), "+v"(hw[13]), "+v"(hw[14]), "+v"(hw[15]) :: "memory");
          eax = e0; eay = e1; ebx = e2; eby = e3; }
        const unsigned rd_a = ring + 16u * (unsigned)lane, rd_b = ring + 2048u + 8u * (unsigned)lane;
        const bool rev = GATHER_ZIGZAG && ((it & 1) != 0);
        const int kflip = rev ? (k0 + kn - 1) : 0, ksign = rev ? -1 : 1;
#define G_ISSUE(k) do { const int k_ = (k), ke_ = kflip + ksign * k_; const unsigned e_ = (unsigned)__builtin_amdgcn_readlane((int)(ke_ < 64 ? eax : ebx), ke_ & 63); \
        const unsigned char* rp_ = UV + (size_t)e_ * PREC + 16 * lane; const unsigned sb_ = ring + (unsigned)(k_ % GS) * GSLOT; \
        if (GMODE == 3) { glds16(rp_, sb_); if (lane < 32) glds16(rp_ + 2048, sb_ + 2048); } \
        else if (GMODE != 2) { glds16(rp_, sb_); glds16(rp_ + 1024, sb_ + 1024); if (PEER_U4) {} else if (PEER_V4) { if (lane < 32) glds16(rp_ + 2048, sb_ + 2048); } else glds16(rp_ + 2048, sb_ + 2048); } else { asm volatile("" :: "v"(rp_), "s"(sb_)); } } while (0)
#if GATHER_EARLY
        if (it + 1 < nround && G_ROWOF(it + 1) < Mrows) G_PREFETCH(G_ROWOF(it + 1), lane);
        if (!pre) {
#pragma unroll
            for (int k = 0; k < GS; ++k) G_ISSUE(k0 + k); }
#else
#pragma unroll
        for (int k = 0; k < 4; ++k) G_ISSUE(k0 + k);
        if (it + 1 < nround && G_ROWOF(it + 1) < Mrows) G_PREFETCH(G_ROWOF(it + 1), lane);
#endif
#define G_READ(k, ua, ub, va, vb) do { const unsigned so_ = (unsigned)((k) % GS) * GSLOT; \
        if (PEER_U4) asm volatile("ds_read_b128 %0, %2\n\tds_read_b128 %1, %2 offset:1024" : "=&v"(ua), "=&v"(va) : "v"(rd_a + so_) : "memory"); \
        else if (PEER_V4) asm volatile("ds_read_b128 %0, %3\n\tds_read_b64 %1, %4\n\tds_read_b128 %2, %3 offset:1024" \
                     : "=&v"(ua), "=&v"(ub), "=&v"(va) : "v"(rd_a + so_), "v"(rd_b + so_) : "memory"); \
        else asm volatile("ds_read_b128 %0, %4\n\tds_read_b64 %1, %5\n\tds_read_b128 %2, %4 offset:1024\n\tds_read_b64 %3, %5 offset:512" \
                     : "=&v"(ua), "=&v"(ub), "=&v"(va), "=&v"(vb) : "v"(rd_a + so_), "v"(rd_b + so_) : "memory"); } while (0)
#if GATHER_XEARLY
        u32x4 xr0 = {0u, 0u, 0u, 0u}, xr1 = xr0, xr2 = xr0, xr3 = xr0;
#endif
#if GATHER_SWP
        static_assert(!GATHER_SWP || (PEER_U4 && PEER_V4 && GATHER_EARLY && GATHER_PAIRRED && GATHER_MFMADOT && !GATHER_DEEP && !GATHER_XEARLY && !GATHER_PRE), "GATHER_SWP: configuration");
#define SWP_FETCH(kk, uA, uB, vA, vB) do { const int kk_ = (kk); \
            if (kk_ + 4 < kn) asm volatile("s_waitcnt vmcnt(8)" ::: "memory"); else if (kk_ == kn - 4) asm volatile("s_waitcnt vmcnt(4)" ::: "memory"); else asm volatile("s_waitcnt vmcnt(0)" ::: "memory"); \
            u32x2 d0_ = {0u, 0u}, d1_ = {0u, 0u}; G_READ(kk_, uA, d0_, vA, d1_); G_READ(kk_ + 1, uB, d0_, vB, d1_); \
            asm volatile("s_waitcnt lgkmcnt(0)" : "+v"(uA), "+v"(vA), "+v"(uB), "+v"(vB) :: "memory"); \
            if (kk_ + GS < kn) { G_ISSUE(kk_ + GS); G_ISSUE(kk_ + GS + 1); } } while (0)
#define SWP_U4(dst_, src_, w_, b_) dst_[4 * (w_) + (b_)] = __builtin_bit_cast(unsigned, __builtin_amdgcn_cvt_scalef32_pk_bf16_fp4(src_[w_], 1.0f, b_))
#define SWP_UPART(kk, uA, uB, wA_, wB_) do { const int kk_ = (kk); u32x16 ubfA, ubfB; const unsigned uwA[4] = {uA.x, uA.y, uA.z, uA.w}, uwB[4] = {uB.x, uB.y, uB.z, uB.w}; \
            _Pragma("unroll") for (int w = 0; w < 4; ++w) { SWP_U4(ubfA, uwA, w, 0); SWP_U4(ubfA, uwA, w, 1); SWP_U4(ubfA, uwA, w, 2); SWP_U4(ubfA, uwA, w, 3); SWP_U4(ubfB, uwB, w, 0); SWP_U4(ubfB, uwB, w, 1); SWP_U4(ubfB, uwB, w, 2); SWP_U4(ubfB, uwB, w, 3); } \
            f32x4 dgA = {0.f, 0.f, 0.f, 0.f}, dgB = {0.f, 0.f, 0.f, 0.f}; \
            _Pragma("unroll") for (int q = 0; q < 16; q += 2) { const u32x2 hq_ = {hw[q], hw[q + 1]}, xa_ = {ubfA[q], ubfA[q + 1]}, xb_ = {ubfB[q], ubfB[q + 1]}; \
                dgA = __builtin_amdgcn_mfma_f32_4x4x4bf16_1k(__builtin_bit_cast(s16x4_t, xa_), __builtin_bit_cast(s16x4_t, hq_), dgA, 0, 0, 0); \
                dgB = __builtin_amdgcn_mfma_f32_4x4x4bf16_1k(__builtin_bit_cast(s16x4_t, xb_), __builtin_bit_cast(s16x4_t, hq_), dgB, 0, 0, 0); } \
            const float x0 = dgA[0], x1 = dgA[1], x2 = dgA[2], x3 = dgA[3], y0 = dgB[0], y1 = dgB[1], y2 = dgB[2], y3 = dgB[3]; \
            float a0 = DPP_F(x0, 0x00); a0 += DPP_F(x1, 0x55); a0 += DPP_F(x2, 0xAA); a0 += DPP_F(x3, 0xFF); \
            float b0 = DPP_F(y0, 0x00); b0 += DPP_F(y1, 0x55); b0 += DPP_F(y2, 0xAA); b0 += DPP_F(y3, 0xFF); \
            const auto sw = __builtin_amdgcn_permlane32_swap(__float_as_uint(a0), __float_as_uint(b0), false, false); \
            float c2 = __uint_as_float(sw[0]) + __uint_as_float(sw[1]); c2 += DPP_F(c2, 0x141); c2 += DPP_F(c2, 0x140); \
            const float d2 = sum_xor16(c2) * (1.0f / U_SCALE); const float g2 = gelu_tanh(d2) * (1.0f / V_SCALE); \
            const float gA = __uint_as_float((unsigned)__builtin_amdgcn_readlane((int)__float_as_uint(g2), 0)), gB = __uint_as_float((unsigned)__builtin_amdgcn_readlane((int)__float_as_uint(g2), 32)); \
            const int keA = kflip + ksign * kk_, keB = keA + ksign; const unsigned gsel = keA < 64 ? eay : eby; \
            wA_ = __uint_as_float((unsigned)__builtin_amdgcn_readlane((int)gsel, keA & 63)) * gA; wB_ = __uint_as_float((unsigned)__builtin_amdgcn_readlane((int)gsel, keB & 63)) * gB; } while (0)
#define SWP_V4(vwA, vwB, w_, b_, wA_, wB_) do { const f32x2 pA = __builtin_amdgcn_cvt_scalef32_pk_f32_fp4(vwA[w_], 1.0f, b_), pB = __builtin_amdgcn_cvt_scalef32_pk_f32_fp4(vwB[w_], 1.0f, b_); const int j = 4 * (w_) + (b_); \
            const float pa0 = pA[0], pa1 = pA[1], pb0 = pB[0], pb1 = pB[1]; y[2 * j] += wA_ * pa0; y[2 * j + 1] += wA_ * pa1; y[2 * j] += wB_ * pb0; y[2 * j + 1] += wB_ * pb1; } while (0)
#define SWP_VPART(vA, vB, wA_, wB_) do { const unsigned vwA[4] = {vA.x, vA.y, vA.z, vA.w}, vwB[4] = {vB.x, vB.y, vB.z, vB.w}; \
            _Pragma("unroll") for (int w = 0; w < 4; ++w) { SWP_V4(vwA, vwB, w, 0, wA_, wB_); SWP_V4(vwA, vwB, w, 1, wA_, wB_); SWP_V4(vwA, vwB, w, 2, wA_, wB_); SWP_V4(vwA, vwB, w, 3, wA_, wB_); } } while (0)
#define SWP_VCH(w_, qA_, qB_) do { SWP_V4(vwA, vwB, w_, 0, qA_, qB_); SWP_V4(vwA, vwB, w_, 1, qA_, qB_); SWP_V4(vwA, vwB, w_, 2, qA_, qB_); SWP_V4(vwA, vwB, w_, 3, qA_, qB_); } while (0)
#define SWP_MIX(kk, uA, uB, wA_, wB_, pvA, pvB, pwA_, pwB_) do { const int kk_ = (kk); u32x16 ubfA, ubfB; const unsigned uwA[4] = {uA.x, uA.y, uA.z, uA.w}, uwB[4] = {uB.x, uB.y, uB.z, uB.w}; \
            const unsigned vwA[4] = {pvA.x, pvA.y, pvA.z, pvA.w}, vwB[4] = {pvB.x, pvB.y, pvB.z, pvB.w}; \
            _Pragma("unroll") for (int w = 0; w < 4; ++w) { SWP_U4(ubfA, uwA, w, 0); SWP_U4(ubfA, uwA, w, 1); SWP_U4(ubfA, uwA, w, 2); SWP_U4(ubfA, uwA, w, 3); SWP_U4(ubfB, uwB, w, 0); SWP_U4(ubfB, uwB, w, 1); SWP_U4(ubfB, uwB, w, 2); SWP_U4(ubfB, uwB, w, 3); } \
            f32x4 dgA = {0.f, 0.f, 0.f, 0.f}, dgB = {0.f, 0.f, 0.f, 0.f}; \
            _Pragma("unroll") for (int q = 0; q < 16; q += 2) { const u32x2 hq_ = {hw[q], hw[q + 1]}, xa_ = {ubfA[q], ubfA[q + 1]}, xb_ = {ubfB[q], ubfB[q + 1]}; \
                dgA = __builtin_amdgcn_mfma_f32_4x4x4bf16_1k(__builtin_bit_cast(s16x4_t, xa_), __builtin_bit_cast(s16x4_t, hq_), dgA, 0, 0, 0); \
                dgB = __builtin_amdgcn_mfma_f32_4x4x4bf16_1k(__builtin_bit_cast(s16x4_t, xb_), __builtin_bit_cast(s16x4_t, hq_), dgB, 0, 0, 0); } \
            SWP_VCH(0, pwA_, pwB_); \
            const float x0 = dgA[0], x1 = dgA[1], x2 = dgA[2], x3 = dgA[3], y0 = dgB[0], y1 = dgB[1], y2 = dgB[2], y3 = dgB[3]; \
            float a0 = DPP_F(x0, 0x00); a0 += DPP_F(x1, 0x55); a0 += DPP_F(x2, 0xAA); a0 += DPP_F(x3, 0xFF); \
            float b0 = DPP_F(y0, 0x00); b0 += DPP_F(y1, 0x55); b0 += DPP_F(y2, 0xAA); b0 += DPP_F(y3, 0xFF); \
            SWP_VCH(1, pwA_, pwB_); \
            const auto sw = __builtin_amdgcn_permlane32_swap(__float_as_uint(a0), __float_as_uint(b0), false, false); \
            float c2 = __uint_as_float(sw[0]) + __uint_as_float(sw[1]); c2 += DPP_F(c2, 0x141); c2 += DPP_F(c2, 0x140); \
            float d2 = sum_xor16(c2) * (1.0f / U_SCALE); \
            SWP_VCH(2, pwA_, pwB_); \
            float g2 = gelu_tanh(d2) * (1.0f / V_SCALE); \
            SWP_VCH(3, pwA_, pwB_); \
            const float gA = __uint_as_float((unsigned)__builtin_amdgcn_readlane((int)__float_as_uint(g2), 0)), gB = __uint_as_float((unsigned)__builtin_amdgcn_readlane((int)__float_as_uint(g2), 32)); \
            const int keA = kflip + ksign * kk_, keB = keA + ksign; const unsigned gsel = keA < 64 ? eay : eby; \
            wA_ = __uint_as_float((unsigned)__builtin_amdgcn_readlane((int)gsel, keA & 63)) * gA; wB_ = __uint_as_float((unsigned)__builtin_amdgcn_readlane((int)gsel, keB & 63)) * gB; } while (0)
        if (GMODE == 0) {
            u32x4 cuA, cuB, cvA, cvB; float cwA, cwB;
            SWP_FETCH(k0, cuA, cuB, cvA, cvB); SWP_UPART(k0, cuA, cuB, cwA, cwB);
#pragma unroll 1
            for (int k = k0; k + 2 < kn; k += 2) {
                u32x4 nuA, nuB, nvA, nvB; float nwA, nwB;
                SWP_FETCH(k + 2, nuA, nuB, nvA, nvB);
                SWP_MIX(k + 2, nuA, nuB, nwA, nwB, cvA, cvB, cwA, cwB);
                cvA = nvA; cvB = nvB; cwA = nwA; cwB = nwB;
            }
            SWP_VPART(cvA, cvB, cwA, cwB);
        } else
#undef SWP_MIX
#undef SWP_VCH
#undef SWP_FETCH
#undef SWP_U4
#undef SWP_UPART
#undef SWP_V4
#undef SWP_VPART
#endif
#pragma unroll 1
        for (int k = k0; k < kn; k += 2) {
            if (GATHER_DEEP && k + 6 < kn) asm volatile("s_waitcnt vmcnt(12)" ::: "memory");
            else if (GATHER_DEEP && k == kn - 6) asm volatile("s_waitcnt vmcnt(8)" ::: "memory");
            else if (k + 4 < kn) { if (!GATHER_EARLY) { G_ISSUE(k + 4); G_ISSUE(k + 5); } if (GMODE == 3 || PEER_U4) asm volatile("s_waitcnt vmcnt(8)" ::: "memory"); else asm volatile("s_waitcnt vmcnt(12)" ::: "memory"); }
            else if (k == kn - 4) { if (GMODE == 3 || PEER_U4) asm volatile("s_waitcnt vmcnt(4)" ::: "memory"); else asm volatile("s_waitcnt vmcnt(6)" ::: "memory"); }
            else asm volatile("s_waitcnt vmcnt(0)" ::: "memory");
            u32x4 uaA, vaA, uaB, vaB; u32x2 ubA = {0u, 0u}, vbA = {0u, 0u}, ubB = {0u, 0u}, vbB = {0u, 0u};
            G_READ(k, uaA, ubA, vaA, vbA); G_READ(k + 1, uaB, ubB, vaB, vbB);
            asm volatile("s_waitcnt lgkmcnt(0)" : "+v"(uaA), "+v"(ubA), "+v"(vaA), "+v"(vbA), "+v"(uaB), "+v"(ubB), "+v"(vaB), "+v"(vbB) :: "memory");
#if GATHER_XEARLY
            if (k == kn - 4) { const u32x4* xp_ = (const u32x4*)(X + (size_t)row * DM) + 4 * lane; xr0 = xp_[0]; xr1 = xp_[1]; xr2 = xp_[2]; xr3 = xp_[3]; }
#endif
            if (GATHER_EARLY && k + GS < kn) { G_ISSUE(k + GS); G_ISSUE(k + GS + 1); }
            if (GMODE == 1 || GMODE == 3) continue;
#if PEER_U4
            u32x16 ubfA, ubfB;
            { const unsigned uwA[4] = {uaA.x, uaA.y, uaA.z, uaA.w}, uwB[4] = {uaB.x, uaB.y, uaB.z, uaB.w};
#pragma unroll
              for (int w = 0; w < 4; ++w) {
#define U4_CVT(b_) do { ubfA[4 * w + (b_)] = __builtin_bit_cast(unsigned, __builtin_amdgcn_cvt_scalef32_pk_bf16_fp4(uwA[w], 1.0f, b_)); ubfB[4 * w + (b_)] = __builtin_bit_cast(unsigned, __builtin_amdgcn_cvt_scalef32_pk_bf16_fp4(uwB[w], 1.0f, b_)); } while (0)
                  U4_CVT(0); U4_CVT(1); U4_CVT(2); U4_CVT(3);
#undef U4_CVT
              } }
#else
            const u32x6 u6A = {uaA.x, uaA.y, uaA.z, uaA.w, ubA.x, ubA.y}, u6B = {uaB.x, uaB.y, uaB.z, uaB.w, ubB.x, ubB.y};
            const u32x16 ubfA = __builtin_bit_cast(u32x16, __builtin_amdgcn_cvt_scalef32_pk32_bf16_fp6(u6A, 1.0f));
            const u32x16 ubfB = __builtin_bit_cast(u32x16, __builtin_amdgcn_cvt_scalef32_pk32_bf16_fp6(u6B, 1.0f));
#endif
#if GATHER_MFMADOT
            f32x4 dgA = {0.f, 0.f, 0.f, 0.f}, dgB = {0.f, 0.f, 0.f, 0.f};
#pragma unroll
            for (int q = 0; q < 16; q += 2) { const u32x2 hq_ = {hw[q], hw[q + 1]}, xa_ = {ubfA[q], ubfA[q + 1]}, xb_ = {ubfB[q], ubfB[q + 1]};
                dgA = __builtin_amdgcn_mfma_f32_4x4x4bf16_1k(__builtin_bit_cast(s16x4_t, xa_), __builtin_bit_cast(s16x4_t, hq_), dgA, 0, 0, 0);
                dgB = __builtin_amdgcn_mfma_f32_4x4x4bf16_1k(__builtin_bit_cast(s16x4_t, xb_), __builtin_bit_cast(s16x4_t, hq_), dgB, 0, 0, 0); }
            float a0, a1 = 0.f, b0, b1 = 0.f;
            { const float x0 = dgA[0], x1 = dgA[1], x2 = dgA[2], x3 = dgA[3], y0 = dgB[0], y1 = dgB[1], y2 = dgB[2], y3 = dgB[3];
              a0 = DPP_F(x0, 0x00); a0 += DPP_F(x1, 0x55); a0 += DPP_F(x2, 0xAA); a0 += DPP_F(x3, 0xFF);
              b0 = DPP_F(y0, 0x00); b0 += DPP_F(y1, 0x55); b0 += DPP_F(y2, 0xAA); b0 += DPP_F(y3, 0xFF); }
#else
            float a0 = 0.f, a1 = 0.f, b0 = 0.f, b1 = 0.f;
#pragma unroll
            for (int q = 0; q < 16; q += 2) { const unsigned h0_ = hw[q], h1_ = hw[q + 1], x0_ = ubfA[q], x1_ = ubfA[q + 1], z0_ = ubfB[q], z1_ = ubfB[q + 1];
                a0 = __builtin_amdgcn_fdot2_f32_bf16(__builtin_bit_cast(bf16x2_t, h0_), __builtin_bit_cast(bf16x2_t, x0_), a0, false);
                a1 = __builtin_amdgcn_fdot2_f32_bf16(__builtin_bit_cast(bf16x2_t, h1_), __builtin_bit_cast(bf16x2_t, x1_), a1, false);
                b0 = __builtin_amdgcn_fdot2_f32_bf16(__builtin_bit_cast(bf16x2_t, h0_), __builtin_bit_cast(bf16x2_t, z0_), b0, false);
                b1 = __builtin_amdgcn_fdot2_f32_bf16(__builtin_bit_cast(bf16x2_t, h1_), __builtin_bit_cast(bf16x2_t, z1_), b1, false); }
#endif
            const int keA = kflip + ksign * k, keB = keA + ksign;
            const unsigned gsel = keA < 64 ? eay : eby;
#if GATHER_PAIRRED
            float wA, wB;
            { const auto sw = __builtin_amdgcn_permlane32_swap(__float_as_uint(GATHER_MFMADOT ? a0 : a0 + a1), __float_as_uint(GATHER_MFMADOT ? b0 : b0 + b1), false, false);
#if GATHER_MFMADOT
              float c2 = __uint_as_float(sw[0]) + __uint_as_float(sw[1]); c2 += DPP_F(c2, 0x141); c2 += DPP_F(c2, 0x140);
              const float d2 = sum_xor16(c2) * (1.0f / U_SCALE);
#else
              const float d2 = half_sum32(__uint_as_float(sw[0]) + __uint_as_float(sw[1])) * (1.0f / U_SCALE);
#endif
              const float g2 = gelu_tanh(d2) * (1.0f / V_SCALE);
              const float gA = __uint_as_float((unsigned)__builtin_amdgcn_readlane((int)__float_as_uint(g2), 0)), gB = __uint_as_float((unsigned)__builtin_amdgcn_readlane((int)__float_as_uint(g2), 32));
              wA = __uint_as_float((unsigned)__builtin_amdgcn_readlane((int)gsel, keA & 63)) * gA; wB = __uint_as_float((unsigned)__builtin_amdgcn_readlane((int)gsel, keB & 63)) * gB; }
#else
            const float dA = wave_sum(a0 + a1) * (1.0f / U_SCALE), dB = wave_sum(b0 + b1) * (1.0f / U_SCALE);
            const float wA = __uint_as_float((unsigned)__builtin_amdgcn_readlane((int)gsel, keA & 63)) * gelu_tanh(dA) * (1.0f / V_SCALE);
            const float wB = __uint_as_float((unsigned)__builtin_amdgcn_readlane((int)gsel, keB & 63)) * gelu_tanh(dB) * (1.0f / V_SCALE);
#endif
#if PEER_V4
            { const unsigned vwA[4] = {vaA.x, vaA.y, vaA.z, vaA.w}, vwB[4] = {vaB.x, vaB.y, vaB.z, vaB.w};
#pragma unroll
              for (int w = 0; w < 4; ++w) {
#define V4_ACC(b_) do { const f32x2 pA = __builtin_amdgcn_cvt_scalef32_pk_f32_fp4(vwA[w], 1.0f, b_), pB = __builtin_amdgcn_cvt_scalef32_pk_f32_fp4(vwB[w], 1.0f, b_); const int j = 4 * w + (b_); \
                    const float pa0 = pA[0], pa1 = pA[1], pb0 = pB[0], pb1 = pB[1]; y[2 * j] += wA * pa0; y[2 * j + 1] += wA * pa1; y[2 * j] += wB * pb0; y[2 * j + 1] += wB * pb1; } while (0)
                  V4_ACC(0); V4_ACC(1); V4_ACC(2); V4_ACC(3);
#undef V4_ACC
              } }
#else
            const u32x6 v6A = {vaA.x, vaA.y, vaA.z, vaA.w, vbA.x, vbA.y};
            const f32x32 vfA = __builtin_amdgcn_cvt_scalef32_pk32_f32_fp6(v6A, 1.0f);
#pragma unroll
            for (int i = 0; i < 32; ++i) y[i] += wA * vfA[i];
            const u32x6 v6B = {vaB.x, vaB.y, vaB.z, vaB.w, vbB.x, vbB.y};
            const f32x32 vfB = __builtin_amdgcn_cvt_scalef32_pk32_f32_fp6(v6B, 1.0f);
#pragma unroll
            for (int i = 0; i < 32; ++i) y[i] += wB * vfB[i];
#endif
        }
#if GATHER_PRE
        pre = (it + 1 < nround) && (G_ROWOF(it + 1) < Mrows);
        if (pre) { unsigned n0 = nea.x, n2 = neb.x; asm volatile("" : "+v"(n0), "+v"(n2) :: "memory"); eax = n0; ebx = n2;
            const int k0n = (can_coop && (it + 1 == nround - 1)) ? (wid & 3) * 32 : 0;
#pragma unroll
            for (int k = 0; k < 6; ++k) G_ISSUE(k0n + k); }
#endif
#undef G_READ
#undef G_ISSUE
        if (coop) {
            LAS f32x4* mine = (LAS f32x4*)(lds + wid * (GS * GSLOT)) + lane * 8;
#pragma unroll
            for (int i = 0; i < 8; ++i) mine[i] = (f32x4){y[4 * i], y[4 * i + 1], y[4 * i + 2], y[4 * i + 3]};
            __syncthreads();
            if ((wid & 3) == 0) {
#pragma unroll
                for (int j = 1; j < 4; ++j) { const LAS f32x4* oth = (const LAS f32x4*)(lds + (wid + j) * (GS * GSLOT)) + lane * 8;
#pragma unroll
                    for (int i = 0; i < 8; ++i) { const f32x4 t = oth[i]; y[4 * i] += t.x; y[4 * i + 1] += t.y; y[4 * i + 2] += t.z; y[4 * i + 3] += t.w; } }
            }
            __syncthreads();
            if ((wid & 3) != 0) continue;
        }
        const int slot = row_slot(row);
        const float* mod = MOD + (size_t)(L * 3 + slot) * 12288;
        const int le = launder_v(lane);
#if GATHER_VECREG
        if (slot != cur_slot) { cur_slot = slot; float t_[32];
            load_row_f32_b(mod + 5 * 2048, le, t_);
#pragma unroll
            for (int i = 0; i < 16; ++i) mg[i] = cvtpk(t_[2 * i], t_[2 * i + 1]);
            if (L < NLAYER - 1) { const float* modn = MOD + (size_t)((L + 1) * 3 + slot) * 12288;
                load_row_f32_b(modn, le, t_);
#pragma unroll
                for (int i = 0; i < 16; ++i) ms[i] = cvtpk(t_[2 * i], t_[2 * i + 1]);
                load_row_f32_b(modn + 2048, le, t_);
#pragma unroll
                for (int i = 0; i < 16; ++i) mc[i] = cvtpk(t_[2 * i], t_[2 * i + 1]); } }
        { float xx[32];
#if GATHER_XEARLY
          { const unsigned xw_[16] = {xr0.x, xr0.y, xr0.z, xr0.w, xr1.x, xr1.y, xr1.z, xr1.w, xr2.x, xr2.y, xr2.z, xr2.w, xr3.x, xr3.y, xr3.z, xr3.w};
#pragma unroll
            for (int i = 0; i < 16; ++i) { xx[2 * i] = bflo(xw_[i]); xx[2 * i + 1] = bfhi(xw_[i]); } }
#else
          { const u32x4* xp_ = (const u32x4*)(X + (size_t)row * DM) + 4 * le;
#pragma unroll
            for (int j = 0; j < 4; ++j) { const u32x4 w = G_NTL(xp_ + j); xx[8 * j + 0] = bflo(w.x); xx[8 * j + 1] = bfhi(w.x); xx[8 * j + 2] = bflo(w.y); xx[8 * j + 3] = bfhi(w.y);
                xx[8 * j + 4] = bflo(w.z); xx[8 * j + 5] = bfhi(w.z); xx[8 * j + 6] = bflo(w.w); xx[8 * j + 7] = bfhi(w.w); } }
#endif
#pragma unroll
          for (int i = 0; i < 16; ++i) { y[2 * i] = ALPHA * xx[2 * i] + bflo(mg[i]) * y[2 * i]; y[2 * i + 1] = ALPHA * xx[2 * i + 1] + bfhi(mg[i]) * y[2 * i + 1]; } }
        { float mean, rstd; ln_stats(y, mean, rstd);
          const LAS u32x4* gp = (const LAS u32x4*)(LNV + le * 16); const LAS u32x4* bp = (const LAS u32x4*)(LNV + 1024 + le * 16);
#pragma unroll
          for (int q = 0; q < 4; ++q) { const u32x4 g4 = gp[q], b4 = bp[q]; const unsigned gw_[4] = {g4.x, g4.y, g4.z, g4.w}, bw_[4] = {b4.x, b4.y, b4.z, b4.w};
#pragma unroll
              for (int j = 0; j < 4; ++j) { const int i = 8 * q + 2 * j; y[i] = (y[i] - mean) * rstd * bflo(gw_[j]) + bflo(bw_[j]); y[i + 1] = (y[i + 1] - mean) * rstd * bfhi(gw_[j]) + bfhi(bw_[j]); } }
          if (L < NLAYER - 1) { store_row_bf16_b(Xo + (size_t)row * DM, le, y);
              ln_stats(y, mean, rstd); float a_[32];
#pragma unroll
              for (int i = 0; i < 16; ++i) { a_[2 * i] = (y[2 * i] - mean) * rstd * (1.0f + bflo(mc[i])) + bflo(ms[i]); a_[2 * i + 1] = (y[2 * i + 1] - mean) * rstd * (1.0f + bfhi(mc[i])) + bfhi(ms[i]); }
              store_row_bf16_b(Ho + (size_t)row * DM, le, a_); }
          else { if (NT_STREAM > 1) store_row_f32_b_nt(P->out + (size_t)row * DM, le, y); else store_row_f32_b(P->out + (size_t)row * DM, le, y); } }
        asm volatile("s_waitcnt vmcnt(0)" ::: "memory");
        continue;
#endif
        { float xx[32], gg[32]; load_row_bf16_b(X + (size_t)row * DM, le, xx); load_row_f32_b(mod + 5 * 2048, le, gg);
#pragma unroll
          for (int i = 0; i < 32; ++i) y[i] = ALPHA * xx[i] + gg[i] * y[i]; }
        if (L < NLAYER - 1) { const float* modn = MOD + (size_t)((L + 1) * 3 + slot) * 12288;
            finish_row<true>(y, lng, lnb, Xo + (size_t)row * DM, modn, modn + 2048, Ho + (size_t)row * DM, nullptr, le); }
        else finish_row<true>(y, lng, lnb, nullptr, nullptr, nullptr, nullptr, P->out + (size_t)row * DM, le);
        asm volatile("s_waitcnt vmcnt(0)" ::: "memory");
    }
#undef G_PREFETCH
#undef G_ROWOF
}

#ifndef ROPE_TEST
#define ROPE_TEST 0
#endif
#ifndef TAIL_L3MOVE
#define TAIL_L3MOVE 1
#endif
#ifndef PROBE_DUP
#define PROBE_DUP 0
#endif
#define NOINL __forceinline__
__device__ __forceinline__ CP launder_cp(CP p) { asm volatile("" : "+s"(p)); return p; }
#define GETP() launder_cp((CP)__builtin_amdgcn_kernarg_segment_ptr())
__device__ __forceinline__ int uni(int v) { return __builtin_amdgcn_readfirstlane(v); }
__device__ __forceinline__ LAS unsigned char* uni_lds(LAS unsigned char* p) { return (LAS unsigned char*)(unsigned)__builtin_amdgcn_readfirstlane((int)(unsigned)(uintptr_t)p); }
#define PH_IDS const int wid = uni(wv_), lane = launder_v(lane_id_fresh()) & 63, tid = (wid & 7) * 64 + lane; const int gw = blockIdx.x * NWAVES + wid, NGW = gridDim.x * NWAVES; (void)lane; (void)gw; (void)NGW; (void)tid;

__device__ NOINL void ph_prologue(int wv_, LAS unsigned char* lds_) { CP P = GETP(); LAS unsigned char* lds = uni_lds(lds_); PH_IDS p0_prologue(P, lds, tid, lane, wid, gw, NGW); if (PROBE_DUP == 5) p0_prologue(P, lds, tid, lane, wid, gw, NGW);
    if (PROBE_DUP >= 21 && PROBE_DUP <= 23) { __syncthreads(); p0_prologue(P, lds, tid, lane, wid, gw, NGW, 1 << (PROBE_DUP - 21 < 0 ? 0 : (PROBE_DUP - 21) & 3)); } }
__device__ NOINL void ph_modreduce(int wv_) { CP P = GETP(); PH_IDS mod_reduce(P, gw, lane, NGW); }
__device__ NOINL void ph_first(int wv_, LAS unsigned char* lds_) { CP P = GETP(); LAS unsigned char* lds = uni_lds(lds_); PH_IDS
#pragma unroll 1
    for (int rep = 0; rep < (PROBE_DUP == 6 ? 2 : 1); ++rep) first_row_pass(P, lds, tid, lane, gw, NGW); }
__device__ NOINL void ph_postmix(int wv_, LAS unsigned char* lds_, int L_, int M_) { CP P = GETP(); LAS unsigned char* lds = uni_lds(lds_); const int L = uni(L_), Mrows = uni(M_); PH_IDS
    if (POSTMIX_LDS) post_mixer_pass_lds(P, L, Mrows, lds, tid, lane, gw, NGW); else post_mixer_pass(P, L, Mrows, lane, gw, NGW); }
__device__ NOINL void ph_vstats(int wv_, int M_) { CP P = GETP(); const int Mrows = uni(M_); PH_IDS
#pragma unroll 1
    for (int rep = 0; rep < (PROBE_DUP == 6 ? 2 : 1); ++rep) vstats_pass(P, Mrows, lane, gw, NGW); }
__device__ NOINL void ph_spatial(int wv_, LAS unsigned char* lds_, int j_, int M_) { CP P = GETP(); LAS unsigned char* lds = uni_lds(lds_); const int j = uni(j_), Mrows = uni(M_); PH_IDS
#pragma unroll 1
    for (int rep = 0; rep < ((PROBE_DUP == 6 || PROBE_DUP == 19) ? 2 : 1); ++rep) spatial_phase(P, j, Mrows, lds, tid, lane, wid); }
__device__ NOINL void ph_mla_norm(int wv_) { CP P = GETP(); PH_IDS
#pragma unroll 1
    for (int rep = 0; rep < (PROBE_DUP == 6 ? 2 : 1); ++rep) mla_norm_pass(P, lane, gw, NGW); }
__device__ NOINL void ph_rope(int wv_, int which_) { CP P = GETP(); const int which = uni(which_); PH_IDS
    if (which == 0) rope_pass((bf16*)(P->ws + WS_QM), 3072, 128, 16, 192, lane, gw, NGW);
    else rope_pass((bf16*)(P->ws + WS_Z), 6144, 0, 64, 64, lane, gw, NGW); }
__device__ NOINL void ph_attn_mla(int wv_, LAS unsigned char* lds_) { CP P = GETP(); LAS unsigned char* lds = uni_lds(lds_); PH_IDS mla_attn_phase(P, lds, tid); if (PROBE_DUP == 2 || PROBE_DUP == 9) mla_attn_phase(P, lds, tid); }
__device__ NOINL void ph_attn_da(int wv_, LAS unsigned char* lds_, int L_, bool ctx_q) { CP P = GETP(); LAS unsigned char* lds = uni_lds(lds_); const int L = uni(L_); PH_IDS
    const float* lp = P->in[26];
    const float s01 = wave_sum(lp[lane] * lp[64 + lane]), s23 = wave_sum(lp[128 + lane] * lp[192 + lane]);
    const float lam_init = 0.8f - 0.6f * expf(-0.3f * (float)L);
    const float lam = expf(s01) - expf(s23) + lam_init;
    if (PROBE_DUP == 24) { da_attn_phase(P, lam, 1.0f - lam_init, lds, tid, ctx_q, 4); __syncthreads(); }
    if (!(PROBE_DUP >= 11 && PROBE_DUP <= 15)) da_attn_phase(P, lam, 1.0f - lam_init, lds, tid, ctx_q);
    if (PROBE_DUP == 2 || PROBE_DUP == 10) da_attn_phase(P, lam, 1.0f - lam_init, lds, tid, ctx_q);
    if (PROBE_DUP >= 11 && PROBE_DUP <= 15) { da_attn_phase<PROBE_DUP >= 11 && PROBE_DUP <= 15 ? PROBE_DUP - 10 : 0>(P, lam, 1.0f - lam_init, lds, tid, ctx_q); __syncthreads(); }
    if (PROBE_DUP >= 11 && PROBE_DUP <= 15) da_attn_phase(P, lam, 1.0f - lam_init, lds, tid, ctx_q); }
__device__ NOINL void ph_route(int wv_, LAS unsigned char* lds_, int L_, int M_) { CP P = GETP(); LAS unsigned char* lds = uni_lds(lds_); const int L = uni(L_), Mrows = uni(M_); PH_IDS
#pragma unroll 1
    for (int rep = 0; rep < (PROBE_DUP == 4 ? 2 : 1); ++rep) route_phase(P, L, Mrows, lds, tid, lane, wid, gw, NGW); }
__device__ NOINL void ph_gather(int wv_, LAS unsigned char* lds_, int L_, int M_) { CP P = GETP(); LAS unsigned char* lds = uni_lds(lds_); const int L = uni(L_), Mrows = uni(M_); PH_IDS
    if (PROBE_DUP == 3) { gather_phase<0>(P, L, Mrows, lds, wid, lane, gw, NGW, true); }
    if (PROBE_DUP == 7) { gather_phase<1>(P, L, Mrows, lds, wid, lane, gw, NGW, true); }
    if (PROBE_DUP == 17) { gather_phase<3>(P, L, Mrows, lds, wid, lane, gw, NGW, true); }
    if (PROBE_DUP == 8) { gather_phase<2>(P, L, Mrows, lds, wid, lane, gw, NGW, true); }
    gather_phase<0>(P, L, Mrows, lds, wid, lane, gw, NGW); }

enum GemmId { G_GM_IN = 0, G_GM_OUT, G_MLA_IN, G_MLA_UQ, G_MLA_UKV, G_MLA_OUT, G_DA_IN, G_DA_OUT, G_PEER_Q };
__device__ NOINL void ph_gemm(int wv_, LAS unsigned char* lds_, int id_, int L_, int M_) {
    CP P = GETP(); LAS unsigned char* lds = uni_lds(lds_); const int id = uni(id_), L = uni(L_), Mrows = uni(M_); PH_IDS
    unsigned char* ws = P->ws; const int jj = L / 3;
    size_t a = WS_H, b = 0, o = 0; int M = MT, N = 2048, K = 2048, act = 0, rope = 0;
    switch (id) {
        case G_GM_IN:   a = WS_H;    b = WS_GMWIN + (size_t)jj * 4096 * 2048 * 2;  o = WS_Z;  M = Mrows; N = 4096; K = 2048; act = 1; break;
        case G_GM_OUT:  a = WS_G;    b = WS_GMWOUT + (size_t)jj * 2048 * 2048 * 2; o = WS_Y;  M = Mrows; N = 2048; K = 2048; break;
        case G_MLA_IN:  a = WS_H;    b = WS_MLAIN;  o = WS_C;  N = 1280; K = 2048; break;
        case G_MLA_UQ:  a = WS_CQN;  b = WS_MLAUQ;  o = WS_QM; N = 3072; K = 512;  rope = (ROPE_TEST == 2) ? 0 : 2; break;
        case G_MLA_UKV: a = WS_CKVN; b = WS_MLAUKV; o = WS_KV; N = 4096; K = 512;  break;
        case G_MLA_OUT: a = WS_G;    b = WS_MLAOUT; o = WS_Y;  N = 2048; K = 2048; break;
        case G_DA_IN:   a = WS_H;    b = WS_DAIN;   o = WS_Z;  N = 6144; K = 2048; rope = (ROPE_TEST == 1) ? 0 : 1; break;
        case G_DA_OUT:  a = WS_G;    b = WS_DAOUT;  o = WS_Y;  M = Mrows; N = 2048; K = 2048; break;
        default:        a = WS_H;    b = WS_PWQ + (size_t)L * 2048 * 2048 * 2;     o = WS_QP; M = Mrows; N = 2048; K = 2048; break;
    }
    pg8::Gemm g{(const pg8::bf16_t*)(ws + a), (const pg8::bf16_t*)(ws + b), M, N, K}; pg8::StaticOrder S; S.init(M, N, (int)gridDim.x, id == G_MLA_UKV ? (int)gridDim.x - 1 - (int)blockIdx.x : (int)blockIdx.x);
    pg8::EpiR E{(pg8::bf16_t*)(ws + o), N, act, rope, (const float*)(ws + WS_ROPE)};
#pragma unroll 1
    for (int rep = 0; rep < (PROBE_DUP == 1 ? 2 : 1); ++rep) { pg8::gemm_phase<pg8::EpiR, pg8::StaticOrder, true, true>((PG8_LAS unsigned char*)lds, g, S, E, tid); __syncthreads(); }
#if TAIL_REMAP
    int TL = -1; bool tail_u = false;
    if (L == 0) { if (id == G_GM_IN) { TL = 0; tail_u = true; } else if (id == G_GM_OUT) { TL = 0; } else if (id == G_PEER_Q) { TL = 1; tail_u = true; } }
    else if (L == 1) { if (id == G_MLA_IN) { TL = 1; } else if (id == G_MLA_OUT) { TL = 2; tail_u = true; } else if (id == G_PEER_Q) { TL = 2; } }
    else if (L == 2) { if (id == G_DA_IN) { TL = 3; tail_u = true; } else if (id == G_DA_OUT) { TL = 3; } }
    if (TL >= 0) {
        const int units = (M / 256) * (N / 256), G = (int)gridDim.x, tail = units % G, c = (int)blockIdx.x;
        const float* src = (tail_u ? P->in[11] : P->in[12]) + (size_t)TL * 16384 * 2048; unsigned char* dst = ws + WS_PU + (size_t)TL * 16384 * PREC;
#else
#if TAIL_L3MOVE
    const bool l3u = (id == G_MLA_IN && L == 1), l3v = (id == G_DA_IN && L == 2), skip = (L == NLAYER - 2) && (id == G_DA_OUT || id == G_PEER_Q);
    const bool l0v = P0_NOV && (id == G_GM_IN && L == 0);
    const bool tail_u = !skip && ((id == G_GM_OUT || id == G_MLA_OUT || id == G_DA_OUT) || l3u), tail_v = !skip && ((id == G_PEER_Q) || l3v || l0v);
    const int TLx = (l3u || l3v) ? NLAYER - 1 : (l0v ? 0 : L + 1);
    if ((tail_u || tail_v) && TLx < NLAYER) {
        const int units = (M / 256) * (N / 256), G = (int)gridDim.x, tail = units % G, c = (int)blockIdx.x;
        const float* src = (tail_u ? P->in[11] : P->in[12]) + (size_t)TLx * 16384 * 2048; unsigned char* dst = ws + WS_PU + (size_t)TLx * 16384 * PREC;
#else
    const bool tail_u = (id == G_GM_OUT || id == G_MLA_OUT || id == G_DA_OUT), tail_v = (id == G_PEER_Q);
    if ((tail_u || tail_v) && L + 1 < NLAYER) {
        const int units = (M / 256) * (N / 256), G = (int)gridDim.x, tail = units % G, c = (int)blockIdx.x;
        const float* src = (tail_u ? P->in[11] : P->in[12]) + (size_t)(L + 1) * 16384 * 2048; unsigned char* dst = ws + WS_PU + (size_t)(L + 1) * 16384 * PREC;
#endif
#endif
        LAS float* scr = (LAS float*)(lds + wid * 16384);
        if (tail != 0 && c >= tail) cvt_table_fp6(src, dst, 16384, tail_u ? U_SCALE : V_SCALE, scr, lane, (c - tail) * NWAVES + wid, (G - tail) * NWAVES, tail_u ? 0 : 1);
        else if (tail == 0) {
#pragma unroll 1
            for (int rep = 0; rep < (PROBE_DUP == 18 ? 3 : 1); ++rep) cvt_table_fp6(src, dst, 16384, tail_u ? U_SCALE : V_SCALE, scr, lane, gw, NGW, tail_u ? 0 : 1); }
    }
}

__global__ void __launch_bounds__(NWAVES * 64, 2) mk_fwd(Params Pv) {
    extern __shared__ __attribute__((aligned(16))) unsigned char lds_g[];
    LAS unsigned char* lds = (LAS unsigned char*)lds_g;
    const int wv = __builtin_amdgcn_readfirstlane((int)threadIdx.x >> 6);
    const int tid = wv * 64 + lane_id_fresh();
    for (int u = tid; u < (LDS_BYTES - RING_BYTES) / 4; u += NWAVES * 64) ((LAS unsigned*)(lds + RING_BYTES))[u] = 0u;
    __syncthreads();
    const int lo = Pv.ph_lo, hi = Pv.ph_hi;
    unsigned* barw = (unsigned*)(Pv.ws + WS_CTL) + CW_BAR;
    XcdBarrier bar; bar.bar = barw; bar.x = 0; bar.st = nullptr;
    if (hi - lo > 1) bar = xcd_barrier_post(barw, (volatile LAS unsigned*)(lds + MISC_OFF) + 8, tid == 0);
    int ph = 0;
#ifndef SEL
#define SELP(k) true
#else
#define SELP(k) ((k) == SEL)
#endif
    enum { RUN_BASE = __COUNTER__ + 1 };
#define RUN(call) do { if (SELP(__COUNTER__ - RUN_BASE) && ph >= lo && ph < hi) { call; } if (ph >= lo && ph + 1 < hi) xcd_barrier(bar, wv == 0 && lane_id_fresh() == 0); ++ph; } while (0)
    RUN(ph_prologue(wv, lds));
    RUN(ph_modreduce(wv));
    RUN(ph_first(wv, lds));
#define LAYER(LL) do { constexpr int L = (LL); constexpr int kind = L % 3, jj = L / 3; constexpr int Mrows = (L == NLAYER - 1) ? ML : MT; \
        constexpr bool ctx_dead = (L == NLAYER - 2) && ((NLAYER - 1) % 3 == 0) && (kind != 0); constexpr int Mlive = ctx_dead ? ML : Mrows; \
        if (kind == 0) {                          \
            RUN(ph_gemm(wv, lds, G_GM_IN, L, Mrows)); \
            RUN(ph_vstats(wv, Mrows)); \
            RUN(ph_spatial(wv, lds, jj, Mrows)); \
            RUN(ph_gemm(wv, lds, G_GM_OUT, L, Mrows)); \
        } else if (kind == 1) {                   \
            RUN(ph_gemm(wv, lds, G_MLA_IN, L, Mrows)); \
            RUN(ph_mla_norm(wv)); \
            RUN(ph_gemm(wv, lds, G_MLA_UQ, L, Mrows); ph_gemm(wv, lds, G_MLA_UKV, L, Mrows)); \
            if (ROPE_TEST == 2) { RUN(ph_rope(wv, 0)); } \
            RUN(ph_attn_mla(wv, lds)); \
            RUN(ph_gemm(wv, lds, G_MLA_OUT, L, Mrows)); \
        } else {                                  \
            RUN(ph_gemm(wv, lds, G_DA_IN, L, Mrows); if (ROPE_TEST == 1) { __syncthreads(); } ); \
            if (ROPE_TEST == 1) { RUN(ph_rope(wv, 1)); } \
            RUN(ph_attn_da(wv, lds, L, !ctx_dead)); \
            RUN(ph_gemm(wv, lds, G_DA_OUT, L, Mlive)); \
        } \
        RUN(ph_postmix(wv, lds, L, Mlive));                \
        RUN(ph_gemm(wv, lds, G_PEER_Q, L, Mlive));    \
        RUN(ph_route(wv, lds, L, Mlive));             \
        RUN(ph_gather(wv, lds, L, Mlive));            \
    } while (0)
    LAYER(0); LAYER(1); LAYER(2); LAYER(3);
#undef LAYER
#undef RUN
}

extern "C" void kernel_launch(void* const* d_in, const int* in_sizes, int n_in, void* d_out, int out_size, void* d_ws, size_t ws_size, hipStream_t stream) {
    static int grid = 0;
    if (grid == 0) {
        if (n_in != 29 || in_sizes[0] != ML * DM || out_size != ML * DM || ws_size < WS_END) {
            fprintf(stderr, "kernel_launch: shape mismatch: n_in %d in0 %d out %d ws %zu (need %zu); nothing launched\n", n_in, n_in > 0 ? in_sizes[0] : -1, out_size, ws_size, (size_t)WS_END); grid = -1; return; }
        int dev = 0, cus = 0, per_cu = 0;
        if (hipGetDevice(&dev) != hipSuccess || hipDeviceGetAttribute(&cus, hipDeviceAttributeMultiprocessorCount, dev) != hipSuccess) { fprintf(stderr, "kernel_launch: device query failed\n"); grid = -1; return; }
        if (hipFuncSetAttribute((const void*)mk_fwd, hipFuncAttributeMaxDynamicSharedMemorySize, LDS_BYTES) != hipSuccess) { fprintf(stderr, "kernel_launch: hipFuncSetAttribute failed\n"); grid = -1; return; }
        if (hipOccupancyMaxActiveBlocksPerMultiprocessor(&per_cu, (const void*)mk_fwd, NWAVES * 64, LDS_BYTES) != hipSuccess || per_cu < 1)
            fprintf(stderr, "kernel_launch: note: occupancy query reports %d workgroups per CU\n", per_cu);
        (void)hipGetLastError();
        grid = cus;
    }
    if (grid < 0) return;
    if (hipMemsetAsync((char*)d_ws + WS_CTL, 0, CTL_ZERO_BYTES, stream) != hipSuccess) { fprintf(stderr, "kernel_launch: memset failed\n"); return; }
    Params p{};
    for (int i = 0; i < 29; ++i) p.in[i] = (const float*)d_in[i];
    p.out = (float*)d_out; p.ws = (unsigned char*)d_ws;
#if MK_ONE_LAUNCH
    p.ph_lo = 0; p.ph_hi = NPH;
    hipLaunchKernelGGL(mk_fwd, dim3(grid), dim3(NWAVES * 64), LDS_BYTES, stream, p);
#else
    for (int li = 0; li < NPH; ++li) { p.ph_lo = li; p.ph_hi = li + 1; hipLaunchKernelGGL(mk_fwd, dim3(grid), dim3(NWAVES * 64), LDS_BYTES, stream, p); }
#endif
    const hipError_t le = hipPeekAtLastError();
    if (le != hipSuccess) fprintf(stderr, "kernel_launch: launch failed: %s\n", hipGetErrorName(le));
}
```

```cpp
#include <hip/hip_runtime.h>
#include <cstdio>
#include <cstdint>
#ifndef MK_ONE_LAUNCH
#define MK_ONE_LAUNCH 1
#endif
__device__ __forceinline__ int launder_v(int v) { asm volatile("" : "+v"(v)); return v; }
__device__ __forceinline__ int lane_id_fresh() { unsigned m = ~0u; asm volatile("" : "+s"(m)); return (int)__builtin_amdgcn_mbcnt_hi(m, __builtin_amdgcn_mbcnt_lo(m, 0u)); }
#ifndef WT_STORES
#define WT_STORES 0
#endif
typedef unsigned wt_u32x4 __attribute__((ext_vector_type(4)));
__device__ __forceinline__ void st16_wt(void* p, wt_u32x4 v) {
#if WT_STORES
    asm volatile("global_store_dwordx4 %0, %1, off sc1\n\ts_nop 1" :: "v"(p), "v"(v) : "memory");
#else
    *(wt_u32x4*)p = v;
#endif
}
namespace pg8 {
#define PG8_LAS __attribute__((address_space(3)))
typedef unsigned short bf16_t;
typedef short bf16x8 __attribute__((ext_vector_type(8)));
typedef float f32x4 __attribute__((ext_vector_type(4)));
typedef unsigned u32x4 __attribute__((ext_vector_type(4)));
constexpr int BM = 256, BK = 64, HALF = 128, HTB = HALF * BK * 2  , STAGE_BYTES = 8 * HTB, NXCD = 8, WGM = 8;

__host__ __device__ __forceinline__ int lds_byte(int r, int c) { const int st = (r >> 4) * 2 + (c >> 5), rr = r & 15, cc = c & 31, ob = rr * 64 + cc * 2; return st * 1024 + (ob ^ (((ob >> 9) & 1) << 5)); }
__host__ __device__ __forceinline__ void stage_rc(int b, int& R, int& C) { const int st = b / 1024, sb = b % 1024, swz = sb ^ (((sb >> 9) & 1) << 5); R = (st >> 1) * 16 + swz / 64; C = (st & 1) * 32 + (swz % 64) / 2; }
__host__ __device__ __forceinline__ int perm32(int rho) { const int n = rho >> 4, i = rho & 15; return 8 * (i >> 2) + 4 * n + (i & 3); }

struct Unit { int pm, pn; };
struct Gemm { const bf16_t* A; const bf16_t* Bt; int M, N, K; };

struct StaticOrder {
    int nM, nN, nwg, G, c;
    __host__ __device__ void init(int M, int N, int G_, int c_) { nM = M / BM; nN = N / BM; nwg = nM * nN; G = G_; c = c_; }
    __host__ __device__ bool next(int i, Unit& u) const {
        const long L = (long)i * G + c; if (L >= nwg) return false;
        int wgid = (int)L; { const int q = nwg / NXCD, r = nwg % NXCD, xcd = wgid % NXCD, off = wgid / NXCD; wgid = (xcd < r ? xcd * (q + 1) : r * (q + 1) + (xcd - r) * q) + off; }
        const int nig = WGM * nN, gid = wgid / nig, fm = gid * WGM, gsz = (nM - fm) < WGM ? (nM - fm) : WGM;
        u.pm = fm + ((wgid % nig) % gsz); u.pn = (wgid % nig) / gsz; return true;
    }
    __device__ __forceinline__ void a_ready(const Unit&) const {}
    __device__ __forceinline__ void done(const Unit&) const {}
};

__device__ __forceinline__ unsigned cvt_pk_bf16(float lo, float hi) { unsigned r; asm volatile("v_cvt_pk_bf16_f32 %0, %1, %2" : "=v"(r) : "v"(lo), "v"(hi)); return r; }
typedef float f32x2 __attribute__((ext_vector_type(2)));
__device__ __forceinline__ f32x2 gelu_pk(f32x2 v) {
    const f32x2 av = __builtin_elementwise_abs(v), d = av * 0.2316418882f + 1.0f;
    f32x2 t; t.x = __builtin_amdgcn_rcpf(d.x); t.y = __builtin_amdgcn_rcpf(d.y);
    f32x2 q = t * 0.5307027145f + (-0.7265760135f); q = q * t + 0.7107068705f; q = q * t + (-0.142248368f); q = q * t + 0.127414796f; q = q * t;
    const f32x2 s = (v * v) * (-0.72134752044f);
    f32x2 e; e.x = __builtin_amdgcn_exp2f(s.x); e.y = __builtin_amdgcn_exp2f(s.y);
    const f32x2 m = v * (q * e), r = v - m;
    f32x2 o; o.x = v.x < 0.f ? m.x : r.x; o.y = v.y < 0.f ? m.y : r.y; return o;
}

template <int ACT  > struct EpiBf16 {
    static constexpr bool PERM = true, AFTER_DRAIN = false; static_assert(ACT == 0 || ACT == 1, "EpiBf16: ACT is 0 (none) or 1 (gelu_pk)");
    bf16_t* O; int ldc; const float* bias; int split_cols; size_t split_stride; float scale0;
    __device__ __forceinline__ void operator()(const f32x4 (&acc)[2][2][4][2], const Unit& u, int wr, int wc, int fr, int fq) const {
        const int row0 = u.pm * BM + wr * 64 + fr; int colt = u.pn * BM; bf16_t* base = O;
        float sc = 1.f; if (split_cols) { const int t = colt / split_cols; base += (size_t)t * split_stride; colt -= t * split_cols; if (t == 0) sc = scale0; }
        const int col0 = colt + wc * 32 + 8 * fq, bcol0 = u.pn * BM + wc * 32 + 8 * fq;
        f32x4 bv[2][2];
#pragma unroll
        for (int bj = 0; bj < 2; ++bj)
#pragma unroll
            for (int n = 0; n < 2; ++n) bv[bj][n] = bias ? *(const f32x4*)(bias + bcol0 + bj * HALF + 4 * n) : (f32x4){0.f, 0.f, 0.f, 0.f};
#pragma unroll
        for (int ai = 0; ai < 2; ++ai)
#pragma unroll
            for (int m = 0; m < 4; ++m) { bf16_t* rowp = base + (size_t)(row0 + ai * HALF + m * 16) * ldc + col0;
#pragma unroll
                for (int bj = 0; bj < 2; ++bj) { f32x4 v0 = acc[ai][bj][m][0] + bv[bj][0], v1 = acc[ai][bj][m][1] + bv[bj][1];
                    if (ACT == 1) { f32x2 a = gelu_pk((f32x2){v0[0], v0[1]}), b = gelu_pk((f32x2){v0[2], v0[3]}), c = gelu_pk((f32x2){v1[0], v1[1]}), d = gelu_pk((f32x2){v1[2], v1[3]});
                        v0 = (f32x4){a.x, a.y, b.x, b.y}; v1 = (f32x4){c.x, c.y, d.x, d.y}; }
                    v0 = v0 * sc; v1 = v1 * sc; u32x4 w; w.x = cvt_pk_bf16(v0[0], v0[1]); w.y = cvt_pk_bf16(v0[2], v0[3]); w.z = cvt_pk_bf16(v1[0], v1[1]); w.w = cvt_pk_bf16(v1[2], v1[3]);
                    *(u32x4*)(rowp + bj * HALF) = w; } }
    }
};
template <class Epi, class Sched, bool ALIGN_EPI = false, bool SP2 = false>
__device__ __forceinline__ void gemm_phase(PG8_LAS unsigned char* lds, const Gemm g, const Sched& S, const Epi& E, const int tid_in) {
    const int tid = launder_v(tid_in) & 511, wid = __builtin_amdgcn_readfirstlane(tid >> 6), lane = tid & 63, wr = wid >> 2, wc = wid & 3, fr = lane & 15, fq = lane >> 4;
    const int K = g.K, nt = K / BK;
    unsigned voffA[2], voffB[2];
#pragma unroll
    for (int i = 0; i < 2; ++i) { int R, C; stage_rc(tid * 16 + i * 8192, R, C); const int Rb = Epi::PERM ? ((R & ~31) + perm32(R & 31)) : R;
        voffA[i] = (unsigned)(R * K + C) * 2u; voffB[i] = (unsigned)(Rb * K + C) * 2u; }
    const size_t kstep = (size_t)(BK * 2);
    const size_t hstep = (size_t)HALF * K * 2;
    const size_t tstep = 2 * hstep;
    const unsigned ldsw = (unsigned)wid * 1024u;
    const int aoff = lds_byte(wr * 64 + fr, fq * 8), boff = lds_byte(wc * 32 + fr, fq * 8);
#define PG8_SA(b, h) (((b) * 2 + (h)) * HTB)
#define PG8_SB(b, h) ((4 + (b) * 2 + (h)) * HTB)
#define PG8_STAGE(bufoff, gbase, voff) do { _Pragma("unroll") for (int _i = 0; _i < 2; ++_i) \
        __builtin_amdgcn_global_load_lds((const unsigned*)((const char*)(gbase) + (voff)[_i]), (PG8_LAS unsigned*)(lds + (bufoff) + ldsw + _i * 8192), 16, 0, 0); } while (0)
#define PG8_LDA(dst, b, h) do { _Pragma("unroll") for (int m = 0; m < 4; ++m) _Pragma("unroll") for (int k = 0; k < 2; ++k) dst[m][k] = *(const PG8_LAS bf16x8*)(lds + PG8_SA(b, h) + aoff + m * 2048 + k * 1024); } while (0)
#define PG8_LDB(dst, b, h) do { _Pragma("unroll") for (int n = 0; n < 2; ++n) _Pragma("unroll") for (int k = 0; k < 2; ++k) dst[n][k] = *(const PG8_LAS bf16x8*)(lds + PG8_SB(b, h) + boff + n * 2048 + k * 1024); } while (0)
#define PG8_MMA(ai, bj, At, Bt) do { __builtin_amdgcn_s_setprio(1); _Pragma("unroll") for (int m = 0; m < 4; ++m) _Pragma("unroll") for (int n = 0; n < 2; ++n) _Pragma("unroll") for (int k = 0; k < 2; ++k) \
        acc[ai][bj][m][n] = __builtin_amdgcn_mfma_f32_16x16x32_bf16(Bt[n][k], At[m][k], acc[ai][bj][m][n], 0, 0, 0); __builtin_amdgcn_s_setprio(0); } while (0)
#define PG8_WAIT_V(n) asm volatile("s_waitcnt vmcnt(" #n ")" ::: "memory")
#define PG8_WAIT_L(n) asm volatile("s_waitcnt lgkmcnt(" #n ")" ::: "memory")
#define PG8_BAR __builtin_amdgcn_s_barrier()
#define PG8_SCHED __builtin_amdgcn_sched_barrier(0)
    Unit cur, nxt; int ui = 0;
    if (!S.next(0, cur)) return;
    f32x4 acc[2][2][4][2];
#pragma unroll
    for (int a = 0; a < 2; ++a)
#pragma unroll
        for (int b = 0; b < 2; ++b)
#pragma unroll
            for (int m = 0; m < 4; ++m)
#pragma unroll
                for (int n = 0; n < 2; ++n) acc[a][b][m][n] = (f32x4){0.f, 0.f, 0.f, 0.f};
    bf16x8 At[4][2], B0[2][2], B1[2][2];
    const char* cA = (const char*)g.A + (size_t)cur.pm * tstep; const char* cB = (const char*)g.Bt + (size_t)cur.pn * tstep;
    S.a_ready(cur);
    if constexpr (SP2) {
        PG8_STAGE(PG8_SB(0, 0), cB, voffB); PG8_STAGE(PG8_SB(0, 1), cB + hstep, voffB); PG8_STAGE(PG8_SA(0, 0), cA, voffA); PG8_STAGE(PG8_SA(0, 1), cA + hstep, voffA);
        if (wr == 1) PG8_BAR;
        PG8_WAIT_V(2); PG8_BAR;
        PG8_STAGE(PG8_SB(1, 0), cB + kstep, voffB); PG8_STAGE(PG8_SA(1, 0), cA + kstep, voffA); PG8_STAGE(PG8_SB(1, 1), cB + hstep + kstep, voffB);
        PG8_WAIT_V(6); PG8_BAR;
    } else {
        PG8_STAGE(PG8_SB(0, 0), cB, voffB); PG8_STAGE(PG8_SA(0, 0), cA, voffA); PG8_STAGE(PG8_SB(0, 1), cB + hstep, voffB); PG8_STAGE(PG8_SA(0, 1), cA + hstep, voffA);
        if (wr == 1) PG8_BAR;
        PG8_WAIT_V(4); PG8_BAR;
        PG8_STAGE(PG8_SB(1, 0), cB + kstep, voffB); PG8_STAGE(PG8_SA(1, 0), cA + kstep, voffA); PG8_STAGE(PG8_SB(1, 1), cB + hstep + kstep, voffB);
        PG8_WAIT_V(6); PG8_BAR;
    }
    for (;;) {
        const bool has_next = S.next(ui + 1, nxt);
        const char* nA = has_next ? (const char*)g.A + (size_t)nxt.pm * tstep : cA; const char* nB = has_next ? (const char*)g.Bt + (size_t)nxt.pn * tstep : cB;
        for (int t = 0; t < nt; t += 2) {
            const bool last = (t == nt - 2);
            const char* a1 = cA + (size_t)(t + 1) * kstep;
            const char* a2 = last ? nA : cA + (size_t)(t + 2) * kstep; const char* b2 = last ? nB : cB + (size_t)(t + 2) * kstep;
            const char* a3 = a2 + kstep; const char* b3 = b2 + kstep;
            if (last && has_next) S.a_ready(nxt);
            if constexpr (SP2) {
            PG8_LDB(B0, 0, 0); PG8_LDB(B1, 0, 1); PG8_SCHED; PG8_LDA(At, 0, 0); PG8_STAGE(PG8_SA(1, 1), a1 + hstep, voffA);
            PG8_WAIT_V(8); PG8_WAIT_L(0); PG8_BAR; PG8_MMA(0, 0, At, B0); PG8_MMA(0, 1, At, B1); PG8_BAR; PG8_SCHED;
            PG8_LDA(At, 0, 1); PG8_STAGE(PG8_SB(0, 0), b2, voffB); PG8_STAGE(PG8_SB(0, 1), b2 + hstep, voffB); PG8_STAGE(PG8_SA(0, 0), a2, voffA);
            PG8_WAIT_V(8); PG8_WAIT_L(0); PG8_BAR; PG8_MMA(1, 0, At, B0); PG8_MMA(1, 1, At, B1); PG8_BAR; PG8_SCHED;
            PG8_LDB(B0, 1, 0); PG8_LDB(B1, 1, 1); PG8_SCHED; PG8_LDA(At, 1, 0); PG8_STAGE(PG8_SA(0, 1), a2 + hstep, voffA);
            PG8_WAIT_V(8); PG8_WAIT_L(0); PG8_BAR; PG8_MMA(0, 0, At, B0); PG8_MMA(0, 1, At, B1); PG8_BAR; PG8_SCHED;
            PG8_LDA(At, 1, 1); PG8_STAGE(PG8_SB(1, 0), b3, voffB); PG8_STAGE(PG8_SB(1, 1), b3 + hstep, voffB); PG8_STAGE(PG8_SA(1, 0), a3, voffA);
            PG8_WAIT_V(8); PG8_WAIT_L(0); PG8_BAR; PG8_MMA(1, 0, At, B0); PG8_MMA(1, 1, At, B1); PG8_BAR; PG8_SCHED;
            } else {
            PG8_LDB(B0, 0, 0); PG8_SCHED; PG8_LDA(At, 0, 0); PG8_STAGE(PG8_SA(1, 1), a1 + hstep, voffA);
            PG8_WAIT_L(8); PG8_BAR; PG8_WAIT_L(0); PG8_MMA(0, 0, At, B0); PG8_BAR; PG8_SCHED;
            PG8_LDB(B1, 0, 1); PG8_STAGE(PG8_SB(0, 0), b2, voffB);
            PG8_BAR; PG8_WAIT_L(0); PG8_MMA(0, 1, At, B1); PG8_BAR;
            PG8_LDA(At, 0, 1); PG8_STAGE(PG8_SA(0, 0), a2, voffA);
            PG8_BAR; PG8_WAIT_L(0); PG8_MMA(1, 0, At, B0); PG8_BAR; PG8_SCHED;
            PG8_STAGE(PG8_SB(0, 1), b2 + hstep, voffB);
            PG8_WAIT_V(6); PG8_BAR; PG8_MMA(1, 1, At, B1); PG8_BAR;
            PG8_LDB(B0, 1, 0); PG8_SCHED; PG8_LDA(At, 1, 0); PG8_STAGE(PG8_SA(0, 1), a2 + hstep, voffA);
            PG8_WAIT_L(8); PG8_BAR; PG8_WAIT_L(0); PG8_MMA(0, 0, At, B0); PG8_BAR; PG8_SCHED;
            PG8_LDB(B1, 1, 1); PG8_STAGE(PG8_SB(1, 0), b3, voffB);
            PG8_BAR; PG8_WAIT_L(0); PG8_MMA(0, 1, At, B1); PG8_BAR;
            PG8_LDA(At, 1, 1); PG8_STAGE(PG8_SA(1, 0), a3, voffA);
            PG8_BAR; PG8_WAIT_L(0); PG8_MMA(1, 0, At, B0); PG8_BAR; PG8_SCHED;
            PG8_STAGE(PG8_SB(1, 1), b3 + hstep, voffB);
            PG8_WAIT_V(6); PG8_BAR; PG8_MMA(1, 1, At, B1); PG8_BAR;
            }
        }
        if constexpr (ALIGN_EPI) { if (wr == 0) PG8_BAR; }
        if constexpr (!Epi::AFTER_DRAIN) { E(acc, cur, wr, wc, fr, fq); S.done(cur); }
        if (!has_next) break;
#pragma unroll
        for (int a = 0; a < 2; ++a)
#pragma unroll
            for (int b = 0; b < 2; ++b)
#pragma unroll
                for (int m = 0; m < 4; ++m)
#pragma unroll
                    for (int n = 0; n < 2; ++n) acc[a][b][m][n] = (f32x4){0.f, 0.f, 0.f, 0.f};
        cur = nxt; cA = nA; cB = nB; ++ui;
        if constexpr (ALIGN_EPI) { if (wr == 1) PG8_BAR; }
    }
    PG8_WAIT_V(0);
    if constexpr (!ALIGN_EPI) { if (wr == 0) PG8_BAR; }
    PG8_BAR;
    if constexpr (Epi::AFTER_DRAIN) { E.fused(acc, cur, wr, wc, fr, fq, lds, wid, lane); S.done(cur); }
#undef PG8_SA
#undef PG8_SB
#undef PG8_STAGE
#undef PG8_LDA
#undef PG8_LDB
#undef PG8_MMA
#undef PG8_WAIT_V
#undef PG8_WAIT_L
#undef PG8_BAR
#undef PG8_SCHED
}
}

namespace pg8 {
__device__ __forceinline__ float gelu_tanh(float x) {
    const float t = x * (1.5957691216057308f + 0.07135481627f * x * x);
    const float e = __builtin_amdgcn_exp2f(-1.4426950408889634f * t);
    return x * __builtin_amdgcn_rcpf(1.0f + e);
}
template <int ACT> struct EpiT {
    static constexpr bool PERM = true, AFTER_DRAIN = false;
    bf16_t* O; int ldc;
    __device__ __forceinline__ void operator()(const f32x4 (&acc)[2][2][4][2], const Unit& u, int wr, int wc, int fr, int fq) const {
        const int row0 = u.pm * BM + wr * 64 + fr; const int col0 = u.pn * BM + wc * 32 + 8 * fq;
#pragma unroll
        for (int ai = 0; ai < 2; ++ai)
#pragma unroll
            for (int m = 0; m < 4; ++m) { bf16_t* rowp = O + (size_t)(row0 + ai * HALF + m * 16) * ldc + col0;
#pragma unroll
                for (int bj = 0; bj < 2; ++bj) { f32x4 v0 = acc[ai][bj][m][0], v1 = acc[ai][bj][m][1];
                    if (ACT == 2) { v0 = (f32x4){gelu_tanh(v0[0]), gelu_tanh(v0[1]), gelu_tanh(v0[2]), gelu_tanh(v0[3])}; v1 = (f32x4){gelu_tanh(v1[0]), gelu_tanh(v1[1]), gelu_tanh(v1[2]), gelu_tanh(v1[3])}; }
                    u32x4 w; w.x = cvt_pk_bf16(v0[0], v0[1]); w.y = cvt_pk_bf16(v0[2], v0[3]); w.z = cvt_pk_bf16(v1[0], v1[1]); w.w = cvt_pk_bf16(v1[2], v1[3]);
                    ::st16_wt(rowp + bj * HALF, w); } }
    }
};
struct EpiR {
    static constexpr bool PERM = true, AFTER_DRAIN = false;
    bf16_t* O; int ldc; int act; int rope; const float* ropet;
    __device__ __forceinline__ void operator()(const f32x4 (&acc)[2][2][4][2], const Unit& u, int wr, int wc, int fr, int fq) const {
        const int row0 = u.pm * BM + wr * 64 + fr; const int col0 = u.pn * BM + wc * 32 + 8 * fq;
        const bool rrows = rope != 0 && u.pm < 64;
#pragma unroll
        for (int ai = 0; ai < 2; ++ai)
#pragma unroll
            for (int m = 0; m < 4; ++m) { const int grow = row0 + ai * HALF + m * 16; bf16_t* rowp = O + (size_t)grow * ldc + col0;
#pragma unroll
                for (int bj = 0; bj < 2; ++bj) { f32x4 v0 = acc[ai][bj][m][0], v1 = acc[ai][bj][m][1];
                    if (act) { v0 = (f32x4){gelu_tanh(v0[0]), gelu_tanh(v0[1]), gelu_tanh(v0[2]), gelu_tanh(v0[3])}; v1 = (f32x4){gelu_tanh(v1[0]), gelu_tanh(v1[1]), gelu_tanh(v1[2]), gelu_tanh(v1[3])}; }
                    if (rrows) { const int blk = u.pn * 8 + bj * 4 + wc; const int b6 = blk % 6; const bool on = rope == 1 ? (blk < 128) : (b6 >= 4); const int half = rope == 1 ? (blk & 1) : (b6 - 4);
                        if (on) { const int t = grow & 8191; const int pos = half ? (t & 63) : (t >> 6);
                            const float* cp = ropet + pos * 16 + 8 * (fq & 1); const f32x4 c0 = *(const f32x4*)cp, c1 = *(const f32x4*)(cp + 4), s0 = *(const f32x4*)(cp + 2048), s1 = *(const f32x4*)(cp + 2052);
                            f32x4 p0, p1;
#pragma unroll
                            for (int i = 0; i < 4; ++i) { const float a_ = v0[i], b_ = v1[i];
                                const auto r0 = __builtin_amdgcn_permlane32_swap(__float_as_uint(a_), __float_as_uint(a_), false, false);
                                const auto r1 = __builtin_amdgcn_permlane32_swap(__float_as_uint(b_), __float_as_uint(b_), false, false);
                                const unsigned x0_ = (fq & 2) ? r0[0] : r0[1], x1_ = (fq & 2) ? r1[0] : r1[1]; p0[i] = __uint_as_float(x0_); p1[i] = __uint_as_float(x1_); }
                            if (fq & 2) { v0 = p0 * s0 + v0 * c0; v1 = p1 * s1 + v1 * c1; } else { v0 = v0 * c0 - p0 * s0; v1 = v1 * c1 - p1 * s1; } } }
                    u32x4 w; w.x = cvt_pk_bf16(v0[0], v0[1]); w.y = cvt_pk_bf16(v0[2], v0[3]); w.z = cvt_pk_bf16(v1[0], v1[1]); w.w = cvt_pk_bf16(v1[2], v1[3]);
                    ::st16_wt(rowp + bj * HALF, w); } }
    }
};
}

constexpr int DM = 2048, NBATCH = 2, SEQ = 8192, CTXL = 256;
constexpr int ML = NBATCH * SEQ;
constexpr int MC = NBATCH * CTXL;
constexpr int MT = ML + MC;
constexpr int NLAYER = 4;
constexpr float ALPHA = 1.6817928305074290f, LN_EPS = 1e-6f;
constexpr int NWAVES = 8;
constexpr float U_SCALE = 64.0f, V_SCALE = 4.0f;
constexpr int PROW = 1536;
#ifndef PEER_V4
#define PEER_V4 1
#endif
#ifndef PEER_U4
#define PEER_U4 1
#endif
constexpr int PREC = PEER_U4 ? 2048 : PEER_V4 ? 2560 : 2 * PROW;
constexpr int NPH = 35;

constexpr size_t MiB = 1ull << 20;
constexpr size_t WS_CTL = 0, CTL_ZERO_BYTES = 1 * MiB;
constexpr int    CW_BAR = 4096;
constexpr size_t WS_MOD = 128 * 1024;
constexpr size_t WS_VST = 1 * MiB;
constexpr size_t WS_ROPE = 1 * MiB + 160 * 1024;
constexpr size_t WS_MODP = 1 * MiB + 256 * 1024;
constexpr size_t WS_GMWIN = 6 * MiB;
constexpr size_t WS_GMWOUT = WS_GMWIN + 32 * MiB;
constexpr size_t WS_GMWS = WS_GMWOUT + 16 * MiB;
constexpr size_t WS_PWQ = WS_GMWS + 1 * MiB;
constexpr size_t WS_PK1 = WS_PWQ + 32 * MiB;
constexpr size_t WS_PK2 = WS_PK1 + 512 * 1024;
constexpr size_t WS_MLAIN = WS_PK1 + 1 * MiB;
constexpr size_t WS_MLAUQ = WS_MLAIN + 5 * MiB;
constexpr size_t WS_MLAUKV = WS_MLAUQ + 3 * MiB;
constexpr size_t WS_MLAOUT = WS_MLAUKV + 4 * MiB;
constexpr size_t WS_DAIN = WS_MLAOUT + 8 * MiB;
constexpr size_t WS_DAOUT = WS_DAIN + 24 * MiB;
constexpr size_t WS_PU = WS_DAOUT + 8 * MiB;
constexpr size_t WS_PV = WS_PU + 96 * MiB;
constexpr size_t WS_X = WS_PV + 96 * MiB;
constexpr size_t WS_H = WS_X + 66 * MiB;
constexpr size_t WS_G = WS_H + 66 * MiB;
constexpr size_t WS_Y = WS_G + 66 * MiB;
constexpr size_t WS_QP = WS_Y + 66 * MiB;
constexpr size_t WS_Z = WS_QP + 66 * MiB;
constexpr size_t WS_C = WS_Z + 198 * MiB;
constexpr size_t WS_CQN = WS_C + 42 * MiB;
constexpr size_t WS_CKVN = WS_CQN + 17 * MiB;
constexpr size_t WS_KR = WS_CKVN + 17 * MiB;
constexpr size_t WS_QM = WS_KR + 3 * MiB;
constexpr size_t WS_KV = WS_QM + 99 * MiB;
constexpr size_t WS_ROUTE = WS_KV + 132 * MiB;
constexpr size_t WS_END = WS_ROUTE + 17 * MiB;
static_assert((size_t)MT * DM * 2 == 66 * MiB, "row buffer size");

constexpr int RING_BYTES = 155648, MISC_OFF = RING_BYTES + 320, LDS_BYTES = 159744;

#define GAS __attribute__((address_space(1)))
#define LAS __attribute__((address_space(3)))
typedef unsigned short bf16;
typedef unsigned u32x4 __attribute__((ext_vector_type(4)));
typedef unsigned u32x2 __attribute__((ext_vector_type(2)));
typedef float f32x4 __attribute__((ext_vector_type(4)));
typedef float f32x16 __attribute__((ext_vector_type(16)));
typedef short bf16x8 __attribute__((ext_vector_type(8)));
typedef short s16x4 __attribute__((ext_vector_type(4)));
#define LDS_WAIT() asm volatile("s_waitcnt lgkmcnt(0)" ::: "memory")

__device__ __forceinline__ unsigned cvtpk(float lo, float hi) { unsigned r; asm("v_cvt_pk_bf16_f32 %0, %1, %2" : "=v"(r) : "v"(lo), "v"(hi)); return r; }
__device__ __forceinline__ float bflo(unsigned w) { return __uint_as_float(w << 16); }
__device__ __forceinline__ float bfhi(unsigned w) { return __uint_as_float(w & 0xffff0000u); }
__device__ __forceinline__ float bf1(bf16 b) { return __uint_as_float((unsigned)b << 16); }
__device__ __forceinline__ bf16 tobf1(float f) { return (bf16)(cvtpk(f, 0.f) & 0xffffu); }
#define DPP_F(v, ctrl) __int_as_float(__builtin_amdgcn_mov_dpp(__float_as_int(v), (ctrl), 0xF, 0xF, true))
__device__ __forceinline__ float row_sum16(float v) { v += DPP_F(v, 0xB1); v += DPP_F(v, 0x4E); v += DPP_F(v, 0x141); v += DPP_F(v, 0x140); return v; }
__device__ __forceinline__ float sum_xor16(float v) { const auto r = __builtin_amdgcn_permlane16_swap(__float_as_uint(v), __float_as_uint(v), false, false); return __uint_as_float(r[0]) + __uint_as_float(r[1]); }
__device__ __forceinline__ float sum_xor32(float v) { const auto r = __builtin_amdgcn_permlane32_swap(__float_as_uint(v), __float_as_uint(v), false, false); return __uint_as_float(r[0]) + __uint_as_float(r[1]); }
__device__ __forceinline__ float wave_sum(float v) { return sum_xor32(sum_xor16(row_sum16(v))); }
__device__ __forceinline__ float half_sum32(float v) { return sum_xor16(row_sum16(v)); }
__device__ __forceinline__ float lane_xor16(float v, int lane) { const auto r = __builtin_amdgcn_permlane16_swap(__float_as_uint(v), __float_as_uint(v), false, false); return __uint_as_float((lane & 16) ? r[0] : r[1]); }
__device__ __forceinline__ unsigned lane_xor32(unsigned v, int lane) { const auto r = __builtin_amdgcn_permlane32_swap(v, v, false, false); return (lane & 32) ? r[0] : r[1]; }
__device__ __forceinline__ float gelu_tanh(float x) { return pg8::gelu_tanh(x); }

__device__ __forceinline__ void load_row_bf16(const bf16* row, int lane, float (&v)[32]) {
#pragma unroll
    for (int j = 0; j < 4; ++j) { const u32x4 w = ((const u32x4*)row)[64 * j + lane];
        v[8 * j + 0] = bflo(w.x); v[8 * j + 1] = bfhi(w.x); v[8 * j + 2] = bflo(w.y); v[8 * j + 3] = bfhi(w.y);
        v[8 * j + 4] = bflo(w.z); v[8 * j + 5] = bfhi(w.z); v[8 * j + 6] = bflo(w.w); v[8 * j + 7] = bfhi(w.w); }
}
__device__ __forceinline__ void load_row_bf16_nt(const bf16* row, int lane, float (&v)[32]) {
#pragma unroll
    for (int j = 0; j < 4; ++j) { const u32x4 w = __builtin_nontemporal_load(&((const u32x4*)row)[64 * j + lane]);
        v[8 * j + 0] = bflo(w.x); v[8 * j + 1] = bfhi(w.x); v[8 * j + 2] = bflo(w.y); v[8 * j + 3] = bfhi(w.y);
        v[8 * j + 4] = bflo(w.z); v[8 * j + 5] = bfhi(w.z); v[8 * j + 6] = bflo(w.w); v[8 * j + 7] = bfhi(w.w); }
}
__device__ __forceinline__ void store_row_bf16(bf16* row, int lane, const float (&v)[32]) {
#pragma unroll
    for (int j = 0; j < 4; ++j) { u32x4 w; w.x = cvtpk(v[8 * j + 0], v[8 * j + 1]); w.y = cvtpk(v[8 * j + 2], v[8 * j + 3]); w.z = cvtpk(v[8 * j + 4], v[8 * j + 5]); w.w = cvtpk(v[8 * j + 6], v[8 * j + 7]);
        ((u32x4*)row)[64 * j + lane] = w; }
}
__device__ __forceinline__ void load_row_f32(const float* row, int lane, float (&v)[32]) {
#pragma unroll
    for (int j = 0; j < 4; ++j) { const f32x4 a = ((const f32x4*)row)[128 * j + 2 * lane], b = ((const f32x4*)row)[128 * j + 2 * lane + 1];
        v[8 * j + 0] = a.x; v[8 * j + 1] = a.y; v[8 * j + 2] = a.z; v[8 * j + 3] = a.w; v[8 * j + 4] = b.x; v[8 * j + 5] = b.y; v[8 * j + 6] = b.z; v[8 * j + 7] = b.w; }
}
__device__ __forceinline__ void load_row_f32_nt(const float* row, int lane, float (&v)[32]) {
#pragma unroll
    for (int j = 0; j < 4; ++j) { const f32x4 a = __builtin_nontemporal_load(&((const f32x4*)row)[128 * j + 2 * lane]), b = __builtin_nontemporal_load(&((const f32x4*)row)[128 * j + 2 * lane + 1]);
        v[8 * j + 0] = a.x; v[8 * j + 1] = a.y; v[8 * j + 2] = a.z; v[8 * j + 3] = a.w; v[8 * j + 4] = b.x; v[8 * j + 5] = b.y; v[8 * j + 6] = b.z; v[8 * j + 7] = b.w; }
}
__device__ __forceinline__ void store_row_f32(float* row, int lane, const float (&v)[32]) {
#pragma unroll
    for (int j = 0; j < 4; ++j) { ((f32x4*)row)[128 * j + 2 * lane] = (f32x4){v[8 * j + 0], v[8 * j + 1], v[8 * j + 2], v[8 * j + 3]};
        ((f32x4*)row)[128 * j + 2 * lane + 1] = (f32x4){v[8 * j + 4], v[8 * j + 5], v[8 * j + 6], v[8 * j + 7]}; }
}
__device__ __forceinline__ void load_row_bf16_b(const bf16* row, int lane, float (&v)[32]) {
#pragma unroll
    for (int j = 0; j < 4; ++j) { const u32x4 w = ((const u32x4*)row)[4 * lane + j];
        v[8 * j + 0] = bflo(w.x); v[8 * j + 1] = bfhi(w.x); v[8 * j + 2] = bflo(w.y); v[8 * j + 3] = bfhi(w.y);
        v[8 * j + 4] = bflo(w.z); v[8 * j + 5] = bfhi(w.z); v[8 * j + 6] = bflo(w.w); v[8 * j + 7] = bfhi(w.w); }
}
__device__ __forceinline__ void store_row_bf16_b(bf16* row, int lane, const float (&v)[32]) {
#pragma unroll
    for (int j = 0; j < 4; ++j) { u32x4 w; w.x = cvtpk(v[8 * j + 0], v[8 * j + 1]); w.y = cvtpk(v[8 * j + 2], v[8 * j + 3]); w.z = cvtpk(v[8 * j + 4], v[8 * j + 5]); w.w = cvtpk(v[8 * j + 6], v[8 * j + 7]);
        ((u32x4*)row)[4 * lane + j] = w; }
}
__device__ __forceinline__ void load_row_f32_b(const float* row, int lane, float (&v)[32]) {
#pragma unroll
    for (int q = 0; q < 8; ++q) { const f32x4 a = ((const f32x4*)row)[8 * lane + q];
        v[4 * q + 0] = a.x; v[4 * q + 1] = a.y; v[4 * q + 2] = a.z; v[4 * q + 3] = a.w; }
}
__device__ __forceinline__ void store_row_f32_b(float* row, int lane, const float (&v)[32]) {
#pragma unroll
    for (int q = 0; q < 8; ++q) ((f32x4*)row)[8 * lane + q] = (f32x4){v[4 * q + 0], v[4 * q + 1], v[4 * q + 2], v[4 * q + 3]};
}
__device__ __forceinline__ void store_row_f32_b_nt(float* row, int lane, const float (&v)[32]) {
#pragma unroll
    for (int q = 0; q < 8; ++q) __builtin_nontemporal_store((f32x4){v[4 * q + 0], v[4 * q + 1], v[4 * q + 2], v[4 * q + 3]}, &((f32x4*)row)[8 * lane + q]);
}
__device__ __forceinline__ void ln_stats(const float (&v)[32], float& mean, float& rstd) {
    float s = 0.f;
#pragma unroll
    for (int i = 0; i < 32; ++i) s += v[i];
    mean = wave_sum(s) * (1.0f / DM);
    float q = 0.f;
#pragma unroll
    for (int i = 0; i < 32; ++i) { const float d = v[i] - mean; q += d * d; }
    rstd = 1.0f / sqrtf(wave_sum(q) * (1.0f / DM) + LN_EPS);
}
template <bool LAYB>
__device__ __forceinline__ void finish_row(float (&z)[32], const float* lng, const float* lnb, bf16* Xrow, const float* sh, const float* sc, bf16* Hrow, float* Orow, int lane) {
    float mean, rstd; ln_stats(z, mean, rstd);
    { float g[32], b[32]; if (LAYB) { load_row_f32_b(lng, lane, g); load_row_f32_b(lnb, lane, b); } else { load_row_f32(lng, lane, g); load_row_f32(lnb, lane, b); }
#pragma unroll
      for (int i = 0; i < 32; ++i) z[i] = (z[i] - mean) * rstd * g[i] + b[i]; }
    if (Xrow) { if (LAYB) store_row_bf16_b(Xrow, lane, z); else store_row_bf16(Xrow, lane, z); }
    if (Orow) { if (LAYB) store_row_f32_b(Orow, lane, z); else store_row_f32(Orow, lane, z); }
    if (Hrow) {
        ln_stats(z, mean, rstd);
        float a[32], s[32]; if (LAYB) { load_row_f32_b(sc, lane, a); load_row_f32_b(sh, lane, s); } else { load_row_f32(sc, lane, a); load_row_f32(sh, lane, s); }
#pragma unroll
        for (int i = 0; i < 32; ++i) a[i] = (z[i] - mean) * rstd * (1.0f + a[i]) + s[i];
        if (LAYB) store_row_bf16_b(Hrow, lane, a); else store_row_bf16(Hrow, lane, a);
    }
}
__device__ __forceinline__ int row_slot(int row) { return row < ML ? (row >> 13) : 2; }

__device__ __forceinline__ unsigned f2bf_rne(float f) { unsigned u = __float_as_uint(f); return (u + 0x7fffu + ((u >> 16) & 1u)) >> 16; }
__device__ __forceinline__ unsigned pk2(float lo, float hi) { return f2bf_rne(lo) | (f2bf_rne(hi) << 16); }
#ifndef GEMV_PIPE
#define GEMV_PIPE 1
#endif
#ifndef NT_ACT
#define NT_ACT 0
#endif
#ifndef NT_STREAM
#define NT_STREAM 1
#endif
__device__ __forceinline__ void p0_transpose_item(const float* W, int K, int N, bf16* WT, LAS float* scr, int item, int lane) {
    const int nblk = N / 32, kb = item / nblk, nb = item % nblk, k0 = 64 * kb, n0 = 32 * nb;
    f32x4 t[8];
#pragma unroll
    for (int i = 0; i < 8; ++i) { const f32x4* p_ = (const f32x4*)(W + (size_t)(k0 + 8 * i + (lane >> 3)) * N + n0 + 4 * (lane & 7)); t[i] = NT_STREAM ? __builtin_nontemporal_load(p_) : *p_; }
#pragma unroll
    for (int i = 0; i < 8; ++i) { LAS float* d = scr + (8 * i + (lane >> 3)) * 33 + 4 * (lane & 7); d[0] = t[i].x; d[1] = t[i].y; d[2] = t[i].z; d[3] = t[i].w; }
    LDS_WAIT(); asm volatile("" ::: "memory");
    const int c = lane & 7;
#pragma unroll
    for (int j = 0; j < 4; ++j) { const int n = (lane >> 3) + 8 * j; const LAS float* s = scr + (8 * c) * 33 + n;
        u32x4 o; o.x = pk2(s[0 * 33], s[1 * 33]); o.y = pk2(s[2 * 33], s[3 * 33]); o.z = pk2(s[4 * 33], s[5 * 33]); o.w = pk2(s[6 * 33], s[7 * 33]);
        *(u32x4*)(WT + (size_t)(n0 + n) * K + k0 + 8 * c) = o; }
    LDS_WAIT(); asm volatile("" ::: "memory");
}
__device__ __forceinline__ void cvt_range(const float* src, bf16* dst, size_t n8, size_t gtid, size_t gthreads) {
#pragma unroll 4
    for (size_t i = gtid; i < n8; i += gthreads) { const f32x4 a = ((const f32x4*)src)[2 * i], b = ((const f32x4*)src)[2 * i + 1];
        u32x4 w; w.x = cvtpk(a.x, a.y); w.y = cvtpk(a.z, a.w); w.z = cvtpk(b.x, b.y); w.w = cvtpk(b.z, b.w); ((u32x4*)dst)[i] = w; }
}
__device__ __forceinline__ unsigned enc_e2m3(float x) {
    const unsigned sgn = (__float_as_uint(x) >> 26) & 32u;
    const float ax = fminf(fabsf(x), 7.5f);
    unsigned u = __float_as_uint(ax); u += 0x7FFFFu + ((u >> 20) & 1u);
    const unsigned cn = (u >> 20) - ((127u - 1u) << 3);
    const unsigned cs = (unsigned)__builtin_rintf(ax * 8.0f);
    return sgn | (ax < 1.0f ? cs : cn);
}
#ifndef EMU_FP4V
#define EMU_FP4V 0
#endif
#ifndef CVT_PIPE
#define CVT_PIPE 0
#endif
typedef float f32x2v __attribute__((ext_vector_type(2)));
typedef float f32x16v __attribute__((ext_vector_type(16)));
typedef float f32x32v __attribute__((ext_vector_type(32)));
typedef unsigned u32x6v __attribute__((ext_vector_type(6)));
__device__ __forceinline__ u32x6v pack_fp6_32(const float (&e)[32], bool interleaved) {
    f32x16v s0, s1;
    if (interleaved) {
#pragma unroll
        for (int i = 0; i < 16; ++i) { s0[i] = e[2 * i]; s1[i] = e[2 * i + 1]; }
    } else {
#pragma unroll
        for (int i = 0; i < 16; ++i) { s0[i] = e[i]; s1[i] = e[16 + i]; }
    }
    return __builtin_amdgcn_cvt_scalef32_2xpk16_fp6_f32(s0, s1, 1.0f);
}
__device__ __forceinline__ void cvt_table_fp6(const float* src, unsigned char* dst, int nrows, float scale, LAS float* scr  , int lane, int gw, int NGW, const int isv) {
    bool interleaved;
    {
        float t[32];
#pragma unroll
        for (int k = 0; k < 32; ++k) t[k] = k < 16 ? 0.125f * k : (k < 24 ? 2.0f + 0.25f * (k - 16) : 4.0f + 0.5f * (k - 24));
        float tt[32];
#pragma unroll
        for (int k = 0; k < 32; ++k) { tt[k] = t[k]; asm volatile("" : "+v"(tt[k])); }
        const u32x6v p = pack_fp6_32(tt, true);
        const f32x32v o = __builtin_amdgcn_cvt_scalef32_pk32_f32_fp6(p, 1.0f);
        interleaved = (o[1] == t[1]) && (o[2] == t[2]) && (o[17] == t[17]);
        interleaved = __all(interleaved);
    }
#if CVT_PIPE
    f32x4 nx[8];
    if (gw < nrows) { const f32x4* s4 = (const f32x4*)(src + (size_t)gw * 2048);
#pragma unroll
        for (int q = 0; q < 8; ++q) nx[q] = s4[64 * q + lane]; }
    for (int row = gw; row < nrows; row += NGW) {
        f32x4 cur[8];
#pragma unroll
        for (int q = 0; q < 8; ++q) cur[q] = nx[q];
        if (row + NGW < nrows) { const f32x4* s4 = (const f32x4*)(src + (size_t)(row + NGW) * 2048);
#pragma unroll
            for (int q = 0; q < 8; ++q) nx[q] = s4[64 * q + lane]; }
#pragma unroll
        for (int q = 0; q < 8; ++q) { const int s = 64 * q + lane; const f32x4 a = cur[q] * scale; *(LAS f32x4*)(scr + 4 * (s ^ ((s >> 4) & 7))) = a; }
#else
    bool fp4_swapped = false;
    if (PEER_V4) {
        float t0 = 1.0f, t1 = 2.0f; asm volatile("" : "+v"(t0), "+v"(t1));
        const unsigned pw = __builtin_amdgcn_cvt_scalef32_pk_fp4_f32(0u, t0, t1, 1.0f, 0);
        const f32x2v pr = __builtin_amdgcn_cvt_scalef32_pk_f32_fp4(pw, 1.0f, 0);
        fp4_swapped = !__all(pr[0] == 1.0f);
    }
    for (int row = gw; row < nrows; row += NGW) {
        const f32x4* s4 = (const f32x4*)(src + (size_t)row * 2048);
#pragma unroll
        for (int q = 0; q < 8; ++q) { const int s = 64 * q + lane; const f32x4 a = (NT_STREAM ? __builtin_nontemporal_load(&s4[s]) : s4[s]) * scale; *(LAS f32x4*)(scr + 4 * (s ^ ((s >> 4) & 7))) = a; }
#endif
        float e[32];
#pragma unroll
        for (int j = 0; j < 8; ++j) { const int s = 8 * lane + j; const f32x4 a = *(const LAS f32x4*)(scr + 4 * (s ^ ((s >> 4) & 7)));
            e[4 * j + 0] = __builtin_amdgcn_fmed3f(a.x, -7.5f, 7.5f); e[4 * j + 1] = __builtin_amdgcn_fmed3f(a.y, -7.5f, 7.5f); e[4 * j + 2] = __builtin_amdgcn_fmed3f(a.z, -7.5f, 7.5f); e[4 * j + 3] = __builtin_amdgcn_fmed3f(a.w, -7.5f, 7.5f); }
#if EMU_FP4V
        if (EMU_FP4V == 2 ? !isv : isv) {
#pragma unroll
            for (int i = 0; i < 32; ++i) { const float a = fabsf(e[i]); float q = a < 2.0f ? rintf(a * 2.0f) * 0.5f : (a < 4.0f ? rintf(a) : fminf(rintf(a * 0.5f) * 2.0f, 6.0f)); e[i] = copysignf(q, e[i]); }
        }
#endif
        unsigned char* rowp = dst + (size_t)row * PREC;
        if (PEER_V4 && (isv || PEER_U4)) {
            u32x4 w4;
#pragma unroll
            for (int w = 0; w < 4; ++w) { unsigned d = 0u; float x_[8];
#pragma unroll
                for (int i = 0; i < 8; i += 2) { const float x0 = __builtin_amdgcn_fmed3f(e[8 * w + i], -6.0f, 6.0f), x1 = __builtin_amdgcn_fmed3f(e[8 * w + i + 1], -6.0f, 6.0f); x_[i] = fp4_swapped ? x1 : x0; x_[i + 1] = fp4_swapped ? x0 : x1; }
                d = __builtin_amdgcn_cvt_scalef32_pk_fp4_f32(d, x_[0], x_[1], 1.0f, 0); d = __builtin_amdgcn_cvt_scalef32_pk_fp4_f32(d, x_[2], x_[3], 1.0f, 1);
                d = __builtin_amdgcn_cvt_scalef32_pk_fp4_f32(d, x_[4], x_[5], 1.0f, 2); d = __builtin_amdgcn_cvt_scalef32_pk_fp4_f32(d, x_[6], x_[7], 1.0f, 3);
                w4[w] = d; }
            *(u32x4*)(rowp + ((isv || !PEER_U4) ? 1024 : 0) + 16 * lane) = w4;
            continue;
        }
        const u32x6v p = pack_fp6_32(e, interleaved);
        *(u32x4*)(rowp + 1024 * isv + 16 * lane) = (u32x4){p[0], p[1], p[2], p[3]}; *(u32x2*)(rowp + 2048 + 512 * isv + 8 * lane) = (u32x2){p[4], p[5]};
    }
}
__device__ __forceinline__ float silu(float x) { return x / (1.0f + __expf(-x)); }

struct Params { const float* in[29]; float* out; unsigned char* ws; int ph_lo, ph_hi; };
typedef const __attribute__((address_space(4))) Params* CP;

#ifndef P0_NOV
#define P0_NOV 0
#endif
#ifndef TAIL_REMAP
#define TAIL_REMAP 0
#endif
__device__ __forceinline__ void p0_prologue(CP P, LAS unsigned char* lds, int tid, int lane, int wid, int gw, int NGW, const int parts = 7) {
    unsigned char* ws = P->ws;
    LAS float* scr = (LAS float*)(lds + wid * 16384);
    if (parts & 1) {
        constexpr int I_GMIN = (2048 / 64) * (4096 / 32), I_SQ = (2048 / 64) * (2048 / 32), I_MIN = (2048 / 64) * (1088 / 32), I_UQ = (512 / 64) * (3072 / 32), I_UKV = (512 / 64) * (4096 / 32), I_DIN = (2048 / 64) * (6144 / 32);
        constexpr int NIT = 2 * I_GMIN + 2 * I_SQ + 4 * I_SQ + I_MIN + I_UQ + I_UKV + I_SQ + I_DIN + I_SQ;
        for (int it = gw; it < NIT; it += NGW) {
            int r = it;
            if (r < 2 * I_GMIN) { const int j = r / I_GMIN; p0_transpose_item(P->in[13] + (size_t)j * 2048 * 4096, 2048, 4096, (bf16*)(ws + WS_GMWIN) + (size_t)j * 4096 * 2048, scr, r % I_GMIN, lane); continue; } r -= 2 * I_GMIN;
            if (r < 2 * I_SQ) { const int j = r / I_SQ; p0_transpose_item(P->in[18] + (size_t)j * 2048 * 2048, 2048, 2048, (bf16*)(ws + WS_GMWOUT) + (size_t)j * 2048 * 2048, scr, r % I_SQ, lane); continue; } r -= 2 * I_SQ;
            if (r < 4 * I_SQ) { const int j = r / I_SQ; p0_transpose_item(P->in[8] + (size_t)j * 2048 * 2048, 2048, 2048, (bf16*)(ws + WS_PWQ) + (size_t)j * 2048 * 2048, scr, r % I_SQ, lane); continue; } r -= 4 * I_SQ;
            if (r < I_MIN) { p0_transpose_item(P->in[19], 2048, 1088, (bf16*)(ws + WS_MLAIN), scr, r, lane); continue; } r -= I_MIN;
            if (r < I_UQ) { p0_transpose_item(P->in[22], 512, 3072, (bf16*)(ws + WS_MLAUQ), scr, r, lane); continue; } r -= I_UQ;
            if (r < I_UKV) { p0_transpose_item(P->in[23], 512, 4096, (bf16*)(ws + WS_MLAUKV), scr, r, lane); continue; } r -= I_UKV;
            if (r < I_SQ) { p0_transpose_item(P->in[24], 2048, 2048, (bf16*)(ws + WS_MLAOUT), scr, r, lane); continue; } r -= I_SQ;
            if (r < I_DIN) { p0_transpose_item(P->in[25], 2048, 6144, (bf16*)(ws + WS_DAIN), scr, r, lane); continue; } r -= I_DIN;
            p0_transpose_item(P->in[28], 2048, 2048, (bf16*)(ws + WS_DAOUT), scr, r, lane);
        }
    }
    const size_t gtid = (size_t)gw * 64 + lane, gthreads = (size_t)NGW * 64;
    if (parts & 2) {
    { u32x4* z = (u32x4*)((bf16*)(ws + WS_MLAIN) + (size_t)1088 * 2048); const size_t n = (size_t)192 * 2048 / 8;
      for (size_t i = gtid; i < n; i += gthreads) z[i] = (u32x4){0u, 0u, 0u, 0u}; }
    cvt_range(P->in[16], (bf16*)(ws + WS_GMWS), (size_t)2 * 16 * 128 * 128 / 8, gtid, gthreads);
    cvt_range(P->in[9], (bf16*)(ws + WS_PK1), (size_t)4 * 128 * 128 / 8, gtid, gthreads);
    cvt_range(P->in[10], (bf16*)(ws + WS_PK2), (size_t)4 * 128 * 128 / 8, gtid, gthreads);
#if !TAIL_REMAP
    cvt_table_fp6(P->in[11], ws + WS_PU, 16384, U_SCALE, scr, lane, gw, NGW, 0);
    if (!P0_NOV) cvt_table_fp6(P->in[12], ws + WS_PU, 16384, V_SCALE, scr, lane, gw, NGW, 1);
#endif
    if (gtid < 2048) { const int pos = (int)gtid >> 4, f = (int)gtid & 15; const float inv = powf(10000.0f, -(float)f * (1.0f / 16.0f)); float sn, cs; sincosf((float)pos * inv, &sn, &cs);
        float* rt = (float*)(ws + WS_ROPE); rt[gtid] = cs; rt[2048 + gtid] = sn; }
    }
    if (parts & 4) {
        const float* cv = P->in[1]; const float* cc = P->in[3]; const float* mw = P->in[4]; float* PART = (float*)(ws + WS_MODP);
        LAS float* S = (LAS float*)lds;
        __syncthreads();
        { float t_[12];
#pragma unroll
          for (int t = 0; t < 12; ++t) { const int i = tid + t * NWAVES * 64, sl = i >> 11, kk = i & 2047; t_[t] = sl == 0 ? cv[kk] : (sl == 1 ? cv[2048 + kk] : cc[kk]); }
#pragma unroll
          for (int t = 0; t < 12; ++t) S[tid + t * NWAVES * 64] = silu(t_[t]); }
        __syncthreads();
        for (int item = gw; item < 4 * 192 * 8; item += NGW) {
            const int ks = item & 7, r = item >> 3, L = r / 192, n = (r % 192) * 64 + lane;
            const float* W = mw + (size_t)L * 2048 * 12288 + (size_t)(ks * 256) * 12288 + n;
            float a0 = 0.f, a1 = 0.f, a2 = 0.f;
#if GEMV_PIPE
#define GV_LD(dst_, kb_) do { _Pragma("unroll") for (int t = 0; t < 32; ++t) dst_[t] = NT_STREAM ? __builtin_nontemporal_load(&W[(size_t)((kb_) + t) * 12288]) : W[(size_t)((kb_) + t) * 12288]; } while (0)
            float wa[32], wb[32];
            GV_LD(wa, 0);
#pragma unroll 1
            for (int kb = 0; kb < 256; kb += 64) {
                GV_LD(wb, kb + 32);
#pragma unroll
                for (int t = 0; t < 32; ++t) { const int kk = ks * 256 + kb + t; a0 += S[kk] * wa[t]; a1 += S[2048 + kk] * wa[t]; a2 += S[4096 + kk] * wa[t]; }
                if (kb + 64 < 256) GV_LD(wa, kb + 64);
#pragma unroll
                for (int t = 0; t < 32; ++t) { const int kk = ks * 256 + kb + 32 + t; a0 += S[kk] * wb[t]; a1 += S[2048 + kk] * wb[t]; a2 += S[4096 + kk] * wb[t]; }
            }
#undef GV_LD
#else
#pragma unroll 32
            for (int k = 0; k < 256; ++k) { const int kk = ks * 256 + k; const float s0 = S[kk], s1 = S[2048 + kk], s2 = S[4096 + kk];
                const float w = NT_STREAM ? __builtin_nontemporal_load(&W[(size_t)k * 12288]) : W[(size_t)k * 12288]; a0 += s0 * w; a1 += s1 * w; a2 += s2 * w; }
#endif
            float* o = PART + ((size_t)ks * 4 + L) * 3 * 12288 + n;
            o[0] = a0; o[12288] = a1; o[24576] = a2;
        }
    }
}
__device__ __forceinline__ void mod_reduce(CP P, int gw, int lane, int NGW) {
    const float* PART = (const float*)(P->ws + WS_MODP); float* MOD = (float*)(P->ws + WS_MOD); const float* mb = P->in[5];
    for (int i = gw * 64 + lane; i < 4 * 3 * 12288; i += NGW * 64) {
        const int L = i / (3 * 12288), n = i % 12288;
        float s = mb[(size_t)L * 12288 + n];
#pragma unroll
        for (int ks = 0; ks < 8; ++ks) s += PART[(size_t)ks * 4 * 3 * 12288 + i];
        MOD[i] = s;
    }
}

__device__ __forceinline__ void load_row_f32_l(const LAS float* row, int lane, float (&v)[32]) {
#pragma unroll
    for (int j = 0; j < 4; ++j) { const f32x4 a = ((const LAS f32x4*)row)[128 * j + 2 * lane], b = ((const LAS f32x4*)row)[128 * j + 2 * lane + 1];
        v[8 * j + 0] = a.x; v[8 * j + 1] = a.y; v[8 * j + 2] = a.z; v[8 * j + 3] = a.w; v[8 * j + 4] = b.x; v[8 * j + 5] = b.y; v[8 * j + 6] = b.z; v[8 * j + 7] = b.w; }
}
__device__ __forceinline__ void first_row_pass(CP P, LAS unsigned char* lds, int tid, int lane, int gw, int NGW) {
    const float* MOD = (const float*)(P->ws + WS_MOD); bf16* X = (bf16*)(P->ws + WS_X); bf16* H = (bf16*)(P->ws + WS_H);
    LAS float* V = (LAS float*)lds;
    __syncthreads();
    { f32x4 t_[6];
#pragma unroll
      for (int vec = 0; vec < 6; ++vec) t_[vec] = ((const f32x4*)(MOD + (size_t)(vec >> 1) * 12288 + (size_t)(vec & 1) * 2048))[tid];
#pragma unroll
      for (int vec = 0; vec < 6; ++vec) ((LAS f32x4*)V)[vec * 512 + tid] = t_[vec]; }
    __syncthreads();
    for (int row = gw; row < MT; row += NGW) {
        const float* src = row < ML ? P->in[0] + (size_t)row * DM : P->in[2] + (size_t)(row - ML) * DM;
        float v[32]; if (NT_STREAM > 1) load_row_f32_nt(src, lane, v); else load_row_f32(src, lane, v);
        store_row_bf16(X + (size_t)row * DM, lane, v);
        const LAS float* mod = V + row_slot(row) * 4096;
        float mean, rstd; ln_stats(v, mean, rstd);
        float a[32], s[32]; load_row_f32_l(mod + 2048, lane, a); load_row_f32_l(mod, lane, s);
#pragma unroll
        for (int i = 0; i < 32; ++i) a[i] = (v[i] - mean) * rstd * (1.0f + a[i]) + s[i];
        store_row_bf16(H + (size_t)row * DM, lane, a);
    }
}
#ifndef POSTMIX_LDS
#define POSTMIX_LDS 1
#endif
__device__ __forceinline__ void post_mixer_pass_lds(CP P, int L, int Mrows, LAS unsigned char* lds, int tid, int lane, int gw, int NGW) {
    const float* MOD = (const float*)(P->ws + WS_MOD); bf16* X = (bf16*)(P->ws + WS_X); bf16* H = (bf16*)(P->ws + WS_H); const bf16* Y = (const bf16*)(P->ws + WS_Y);
    const float* lng = P->in[6] + (size_t)(L * 2 + 0) * DM; const float* lnb = P->in[7] + (size_t)(L * 2 + 0) * DM;
    LAS float* V = (LAS float*)lds;
    __syncthreads();
    { f32x4 t_[11];
#pragma unroll
      for (int vec = 0; vec < 11; ++vec) { const float* src = vec == 0 ? lng : (vec == 1 ? lnb : MOD + (size_t)(L * 3 + (vec - 2) / 3) * 12288 + (size_t)(2 + (vec - 2) % 3) * 2048);
          t_[vec] = ((const f32x4*)src)[tid]; }
#pragma unroll
      for (int vec = 0; vec < 11; ++vec) ((LAS f32x4*)V)[vec * 512 + tid] = t_[vec]; }
    __syncthreads();
    for (int row = gw; row < Mrows; row += NGW) {
        const LAS float* mv = V + (2 + 3 * row_slot(row)) * 2048;
        float z[32], y[32]; if (NT_ACT) { load_row_bf16_nt(X + (size_t)row * DM, lane, z); load_row_bf16_nt(Y + (size_t)row * DM, lane, y); } else { load_row_bf16(X + (size_t)row * DM, lane, z); load_row_bf16(Y + (size_t)row * DM, lane, y); }
        { float g[32]; load_row_f32_l(mv, lane, g);
#pragma unroll
          for (int i = 0; i < 32; ++i) z[i] = ALPHA * z[i] + g[i] * y[i]; }
        float mean, rstd; ln_stats(z, mean, rstd);
        { float g[32], b[32]; load_row_f32_l(V, lane, g); load_row_f32_l(V + 2048, lane, b);
#pragma unroll
          for (int i = 0; i < 32; ++i) z[i] = (z[i] - mean) * rstd * g[i] + b[i]; }
        store_row_bf16(X + (size_t)row * DM, lane, z);
        ln_stats(z, mean, rstd);
        { float a[32], s_[32]; load_row_f32_l(mv + 2 * 2048, lane, a); load_row_f32_l(mv + 2048, lane, s_);
#pragma unroll
          for (int i = 0; i < 32; ++i) a[i] = (z[i] - mean) * rstd * (1.0f + a[i]) + s_[i];
          store_row_bf16(H + (size_t)row * DM, lane, a); }
    }
}
__device__ __forceinline__ void post_mixer_pass(CP P, int L, int Mrows, int lane, int gw, int NGW) {
    const float* MOD = (const float*)(P->ws + WS_MOD); bf16* X = (bf16*)(P->ws + WS_X); bf16* H = (bf16*)(P->ws + WS_H); const bf16* Y = (const bf16*)(P->ws + WS_Y);
    const float* lng = P->in[6] + (size_t)(L * 2 + 0) * DM; const float* lnb = P->in[7] + (size_t)(L * 2 + 0) * DM;
    for (int row = gw; row < Mrows; row += NGW) {
        const float* mod = MOD + (size_t)(L * 3 + row_slot(row)) * 12288;
        float z[32], y[32], g[32]; load_row_bf16(X + (size_t)row * DM, lane, z); load_row_bf16(Y + (size_t)row * DM, lane, y); load_row_f32(mod + 2 * 2048, lane, g);
#pragma unroll
        for (int i = 0; i < 32; ++i) z[i] = ALPHA * z[i] + g[i] * y[i];
        finish_row<false>(z, lng, lnb, X + (size_t)row * DM, mod + 3 * 2048, mod + 4 * 2048, H + (size_t)row * DM, nullptr, lane);
    }
}
__device__ __forceinline__ void vstats_pass(CP P, int Mrows, int lane, int gw, int NGW) {
    const bf16* Z = (const bf16*)(P->ws + WS_Z); float* VST = (float*)(P->ws + WS_VST);
    for (int row = gw; row < Mrows; row += NGW) {
        float v[32]; load_row_bf16(Z + (size_t)row * 4096 + 2048, lane, v);
        float mean, rstd; ln_stats(v, mean, rstd);
        if (lane == 0) { VST[2 * row] = mean; VST[2 * row + 1] = rstd; }
    }
}
#define XB_TMO      128
#define XB_XCNT(j)  (256  + 64 * (j))
#define XB_XSUB(j)  (1280 + 64 * (j))
#define XB_XGEN(j)  (2304 + 64 * (j))
#define XB_TOP      3328
#define XB_TOPGEN   3392
#define XCD_BAR_WORDS 3456
#define XB_SPIN_CAP (1u << 18)

__device__ __forceinline__ unsigned xb_ld(unsigned* p)              { return __hip_atomic_load(p, __ATOMIC_RELAXED, __HIP_MEMORY_SCOPE_AGENT); }
__device__ __forceinline__ unsigned xb_add(unsigned* p, unsigned v) { return __hip_atomic_fetch_add(p, v, __ATOMIC_RELAXED, __HIP_MEMORY_SCOPE_AGENT); }
__device__ __forceinline__ unsigned xb_xcc_id() { return (unsigned)__builtin_amdgcn_s_getreg((3 << 11) | 20) & 0xFu; }
#define XB_SPIN(cond, bar) do { unsigned _sp = 0; while (cond) { __builtin_amdgcn_s_sleep(1); \
    if ((++_sp & 255u) == 0u) { if (xb_ld(&(bar)[XB_TMO])) break; if (_sp > XB_SPIN_CAP) { atomicAdd(&(bar)[XB_TMO], 1u); break; } } } } while (0)

struct XcdBarrier {
    unsigned* bar; unsigned x;
    volatile LAS unsigned* st;
};

__device__ __forceinline__ XcdBarrier xcd_barrier_post(unsigned* bar, volatile LAS unsigned* st, const bool t0) {
    XcdBarrier b; b.bar = bar; b.x = xb_xcc_id(); b.st = st;
    if (t0) (void)xb_add(&bar[XB_XCNT(b.x)], 1u);
    return b;
}
__device__ __forceinline__ void xcd_barrier_complete(unsigned* bar, unsigned x, unsigned& nloc, unsigned& nx) {
    const unsigned G = gridDim.x * gridDim.y * gridDim.z;
    unsigned sum, cnt, mine, sp = 0u;
    for (;;) {
        sum = 0u; cnt = 0u; mine = 0u;
#pragma unroll
        for (unsigned j = 0; j < 16; ++j) { const unsigned c = xb_ld(&bar[XB_XCNT(j)]); sum += c; cnt += (c > 0u) ? 1u : 0u; mine = (j == x) ? c : mine; }
        if (sum == G) break;
        __builtin_amdgcn_s_sleep(1);
        if ((++sp & 255u) == 0u) { if (xb_ld(&bar[XB_TMO])) break; if (sp > XB_SPIN_CAP) { atomicAdd(&bar[XB_TMO], 1u); break; } }
    }
    nloc = mine > 0u ? mine : 1u; nx = cnt > 0u ? cnt : 1u;
}

__device__ __attribute__((noinline)) void xcd_barrier(const XcdBarrier b, const bool t0) {
    asm volatile("s_waitcnt vmcnt(0)" ::: "memory");
    __syncthreads();
    if (t0) {
        unsigned* bar = b.bar;
        __builtin_amdgcn_s_waitcnt(0);
        unsigned nloc = b.st[0], nx = b.st[1];
        if (nloc == 0u) { xcd_barrier_complete(bar, b.x, nloc, nx); b.st[0] = nloc; b.st[1] = nx; }
        const unsigned old = xb_add(&bar[XB_XSUB(b.x)], 1u);
        const unsigned gen = old / nloc;
        if (old + 1u == (gen + 1u) * nloc) {
            __builtin_amdgcn_fence(__ATOMIC_RELEASE, "agent");
            asm volatile("s_waitcnt vmcnt(0)" ::: "memory");
            const unsigned og = xb_add(&bar[XB_TOP], 1u);
            const unsigned tg = og / nx;
            if (og + 1u == (tg + 1u) * nx) xb_add(&bar[XB_TOPGEN], 1u);
            else XB_SPIN(xb_ld(&bar[XB_TOPGEN]) == tg, bar);
            __builtin_amdgcn_fence(__ATOMIC_ACQUIRE, "agent");
            xb_add(&bar[XB_XGEN(b.x)], 1u);
            asm volatile("s_waitcnt vmcnt(0)" ::: "memory");
        } else {
            XB_SPIN(xb_ld(&bar[XB_XGEN(b.x)]) == gen, bar);
            __builtin_amdgcn_fence(__ATOMIC_ACQUIRE, "agent");
            asm volatile("s_waitcnt vmcnt(0)" ::: "memory");
        }
    }
    __syncthreads();
}

#ifndef SPATIAL_PIPE
#define SPATIAL_PIPE 1
#endif
#if SPATIAL_PIPE
#ifndef SPATIAL_OTILE
#define SPATIAL_OTILE 0
#endif
struct SpReg { u32x4 w[4]; float mean, rstd; bf16x8 a[4]; bf16 uu[SPATIAL_OTILE ? 1 : 32]; u32x4 uq[4]; float bsv[4]; };
__device__ __forceinline__ void sp_load(SpReg& R, const bf16* Z, const float* VST, const bf16* WS, const float* bs, int u, int tid, int lane, int wid) {
    const int c = u >> 4, g = u & 15, fr = lane & 15, fq = lane >> 4;
    { const int q = tid >> 2, dq = (tid & 3) * 32; const int row = c * 128 + q;
      R.mean = VST[2 * row]; R.rstd = VST[2 * row + 1];
      const bf16* src = Z + (size_t)row * 4096 + 2048 + g * 128 + dq;
#pragma unroll
      for (int t = 0; t < 4; ++t) R.w[t] = *(const u32x4*)(src + 8 * t); }
    const bf16* wrow = WS + (size_t)g * 128 * 128 + (size_t)(16 * wid + fr) * 128 + 8 * fq;
#pragma unroll
    for (int ks = 0; ks < 4; ++ks) R.a[ks] = *(const bf16x8*)(wrow + 32 * ks);
#pragma unroll
    for (int r = 0; r < 4; ++r) R.bsv[r] = bs[g * 128 + 16 * wid + fq * 4 + r];
#if SPATIAL_OTILE
#pragma unroll
    for (int t = 0; t < 4; ++t) { const int ch = tid + 512 * t, p = ch >> 4, d8 = (ch & 15) * 8; R.uq[t] = *(const u32x4*)(Z + (size_t)(c * 128 + p) * 4096 + g * 128 + d8); }
    R.uu[0] = 0;
#else
#pragma unroll
    for (int nb = 0; nb < 8; ++nb)
#pragma unroll
        for (int r = 0; r < 4; ++r) { const int p = 16 * wid + fq * 4 + r, d = 16 * nb + fr; R.uu[nb * 4 + r] = Z[(size_t)(c * 128 + p) * 4096 + g * 128 + d]; }
#endif
}
__device__ __forceinline__ void spatial_phase(CP P, int j, int Mrows, LAS unsigned char* lds_, int tid, int lane, int wid) {
    const bf16* Z = (const bf16*)(P->ws + WS_Z); const float* VST = (const float*)(P->ws + WS_VST); bf16* Gb = (bf16*)(P->ws + WS_G);
    const bf16* WS = (const bf16*)(P->ws + WS_GMWS) + (size_t)j * 16 * 128 * 128;
    const float* lng = P->in[14] + (size_t)j * DM; const float* lnb = P->in[15] + (size_t)j * DM; const float* bs = P->in[17] + (size_t)j * 16 * 128;
    LAS bf16* Vt = (LAS bf16*)(LAS unsigned char*)lds_;
    constexpr int VP = 136;
    const int nunits = (Mrows / 128) * 16;
    LAS float* LNl = (LAS float*)(lds_ + 36864);
    __syncthreads();
    { const f32x4 t0_ = ((const f32x4*)lng)[tid], t1_ = ((const f32x4*)lnb)[tid]; ((LAS f32x4*)LNl)[tid] = t0_; ((LAS f32x4*)LNl)[512 + tid] = t1_; }
    LAS float* Ot = (LAS float*)(lds_ + 53248);
    (void)Ot;
    SpReg nx;
    if ((int)blockIdx.x < nunits) sp_load(nx, Z, VST, WS, bs, blockIdx.x, tid, lane, wid);
    for (int u = blockIdx.x; u < nunits; u += gridDim.x) {
        const int c = u >> 4, g = u & 15;
        const SpReg cur = nx;
        if (u + (int)gridDim.x < nunits) sp_load(nx, Z, VST, WS, bs, u + gridDim.x, tid, lane, wid);
        __syncthreads();
        {
            const int q = tid >> 2, dq = (tid & 3) * 32;
#pragma unroll
            for (int t = 0; t < 4; ++t) { const u32x4 w = cur.w[t];
                float v[8] = {bflo(w.x), bfhi(w.x), bflo(w.y), bfhi(w.y), bflo(w.z), bfhi(w.z), bflo(w.w), bfhi(w.w)};
                const LAS float* gp = LNl + g * 128 + dq + 8 * t; const LAS float* bp = LNl + 2048 + g * 128 + dq + 8 * t;
#pragma unroll
                for (int i = 0; i < 8; ++i) { const float vn = (v[i] - cur.mean) * cur.rstd * gp[i] + bp[i]; Vt[(dq + 8 * t + i) * VP + (q ^ ((tid & 3) << 4))] = tobf1(vn); } }
        }
        __syncthreads();
        const int fr = lane & 15, fq = lane >> 4;
#pragma unroll
        for (int nb = 0; nb < 8; ++nb) {
            f32x4 acc = {0.f, 0.f, 0.f, 0.f};
#pragma unroll
            for (int ks = 0; ks < 4; ++ks) { const bf16x8 b = *(const LAS bf16x8*)(Vt + (16 * nb + fr) * VP + 8 * ((4 * ks + fq) ^ ((nb >> 1) << 1)));
                acc = __builtin_amdgcn_mfma_f32_16x16x32_bf16(cur.a[ks], b, acc, 0, 0, 0); }
#if SPATIAL_OTILE
#pragma unroll
            for (int r = 0; r < 4; ++r) Ot[(16 * wid + fq * 4 + r) * 132 + 16 * nb + fr] = acc[r] + cur.bsv[r];
#else
#pragma unroll
            for (int r = 0; r < 4; ++r) { const int p = 16 * wid + fq * 4 + r, d = 16 * nb + fr; const size_t grow = (size_t)(c * 128 + p);
                const float sv = acc[r] + cur.bsv[r];
                const float uu = bf1(cur.uu[nb * 4 + r]);
                Gb[grow * 2048 + g * 128 + d] = tobf1(uu * sv); }
#endif
        }
#if SPATIAL_OTILE
        __syncthreads();
#pragma unroll
        for (int t = 0; t < 4; ++t) { const int ch = tid + 512 * t, p = ch >> 4, d8 = (ch & 15) * 8;
            const LAS f32x4* op = (const LAS f32x4*)(Ot + p * 132 + d8); const f32x4 s0 = op[0], s1 = op[1]; const u32x4 uw = cur.uq[t];
            u32x4 o; o.x = cvtpk(bflo(uw.x) * s0.x, bfhi(uw.x) * s0.y); o.y = cvtpk(bflo(uw.y) * s0.z, bfhi(uw.y) * s0.w); o.z = cvtpk(bflo(uw.z) * s1.x, bfhi(uw.z) * s1.y); o.w = cvtpk(bflo(uw.w) * s1.z, bfhi(uw.w) * s1.w);
            *(u32x4*)(Gb + (size_t)(c * 128 + p) * 2048 + g * 128 + d8) = o; }
#endif
    }
}
#else
__device__ __forceinline__ void spatial_phase(CP P, int j, int Mrows, LAS unsigned char* lds_, int tid, int lane, int wid) {
    const bf16* Z = (const bf16*)(P->ws + WS_Z); const float* VST = (const float*)(P->ws + WS_VST); bf16* Gb = (bf16*)(P->ws + WS_G);
    const bf16* WS = (const bf16*)(P->ws + WS_GMWS) + (size_t)j * 16 * 128 * 128;
    const float* lng = P->in[14] + (size_t)j * DM; const float* lnb = P->in[15] + (size_t)j * DM; const float* bs = P->in[17] + (size_t)j * 16 * 128;
    LAS bf16* Vt = (LAS bf16*)(LAS unsigned char*)lds_;
    constexpr int VP = 136;
    const int nunits = (Mrows / 128) * 16;
    for (int u = blockIdx.x; u < nunits; u += gridDim.x) {
        const int c = u >> 4, g = u & 15;
        __syncthreads();
        {
            const int q = tid >> 2, dq = (tid & 3) * 32; const int row = c * 128 + q;
            const float mean = VST[2 * row], rstd = VST[2 * row + 1];
            const bf16* src = Z + (size_t)row * 4096 + 2048 + g * 128 + dq;
#pragma unroll
            for (int t = 0; t < 4; ++t) { const u32x4 w = *(const u32x4*)(src + 8 * t);
                float v[8] = {bflo(w.x), bfhi(w.x), bflo(w.y), bfhi(w.y), bflo(w.z), bfhi(w.z), bflo(w.w), bfhi(w.w)};
                const float* gp = lng + g * 128 + dq + 8 * t; const float* bp = lnb + g * 128 + dq + 8 * t;
#pragma unroll
                for (int i = 0; i < 8; ++i) { const float vn = (v[i] - mean) * rstd * gp[i] + bp[i]; Vt[(dq + 8 * t + i) * VP + q] = tobf1(vn); } }
        }
        __syncthreads();
        const int fr = lane & 15, fq = lane >> 4;
        bf16x8 a[4];
        const bf16* wrow = WS + (size_t)g * 128 * 128 + (size_t)(16 * wid + fr) * 128 + 8 * fq;
#pragma unroll
        for (int ks = 0; ks < 4; ++ks) a[ks] = *(const bf16x8*)(wrow + 32 * ks);
#pragma unroll
        for (int nb = 0; nb < 8; ++nb) {
            f32x4 acc = {0.f, 0.f, 0.f, 0.f};
#pragma unroll
            for (int ks = 0; ks < 4; ++ks) { const bf16x8 b = *(const LAS bf16x8*)(Vt + (16 * nb + fr) * VP + 32 * ks + 8 * fq);
                acc = __builtin_amdgcn_mfma_f32_16x16x32_bf16(a[ks], b, acc, 0, 0, 0); }
#pragma unroll
            for (int r = 0; r < 4; ++r) { const int p = 16 * wid + fq * 4 + r, d = 16 * nb + fr; const size_t grow = (size_t)(c * 128 + p);
                const float sv = acc[r] + bs[g * 128 + p];
                const float uu = bf1(Z[grow * 4096 + g * 128 + d]);
                Gb[grow * 2048 + g * 128 + d] = tobf1(uu * sv); }
        }
    }
}
#endif

__device__ __forceinline__ void rope_cs(int row, int l, float& cs, float& sn) {
    const int t = row & (SEQ - 1); const int pos = (l & 32) ? (t & 63) : (t >> 6);
    const float inv = powf(10000.0f, -(float)(l & 15) * (1.0f / 16.0f));
    const float ang = (float)pos * inv; sincosf(ang, &sn, &cs);
}
__device__ __forceinline__ float rope_apply(float x, int l, float cs, float sn) {
    const float p = lane_xor16(x, l);
    return (l & 16) ? (p * sn + x * cs) : (x * cs - p * sn);
}
__device__ __forceinline__ void mla_norm_pass(CP P, int lane, int gw, int NGW) {
    const bf16* C = (const bf16*)(P->ws + WS_C); bf16* CQN = (bf16*)(P->ws + WS_CQN); bf16* CKVN = (bf16*)(P->ws + WS_CKVN); bf16* KR = (bf16*)(P->ws + WS_KR);
    const float* qn = P->in[20]; const float* kvn = P->in[21];
    for (int row = gw; row < MT; row += NGW) {
        const bf16* c = C + (size_t)row * 1280;
#pragma unroll
        for (int part = 0; part < 2; ++part) {
            const u32x4 w = *(const u32x4*)(c + part * 512 + 8 * lane);
            float v[8] = {bflo(w.x), bfhi(w.x), bflo(w.y), bfhi(w.y), bflo(w.z), bfhi(w.z), bflo(w.w), bfhi(w.w)};
            float ss = 0.f;
#pragma unroll
            for (int i = 0; i < 8; ++i) ss += v[i] * v[i];
            const float r = 1.0f / sqrtf(wave_sum(ss) * (1.0f / 512.0f) + LN_EPS);
            const float* nw = (part ? kvn : qn) + 8 * lane;
            u32x4 o; o.x = cvtpk(v[0] * r * nw[0], v[1] * r * nw[1]); o.y = cvtpk(v[2] * r * nw[2], v[3] * r * nw[3]); o.z = cvtpk(v[4] * r * nw[4], v[5] * r * nw[5]); o.w = cvtpk(v[6] * r * nw[6], v[7] * r * nw[7]);
            *(u32x4*)((part ? CKVN : CQN) + (size_t)row * 512 + 8 * lane) = o;
        }
        float x = bf1(c[1024 + lane]);
        if (row < ML) { float cs, sn; rope_cs(row, lane, cs, sn); x = rope_apply(x, lane, cs, sn); }
        KR[(size_t)row * 64 + lane] = tobf1(x);
    }
}
__device__ __forceinline__ void rope_pass(bf16* buf, int ld, int col0, int nchunks, int cstride, int lane, int gw, int NGW) {
    for (int row = gw; row < ML; row += NGW) {
        float cs, sn; rope_cs(row, lane, cs, sn);
        bf16* r = buf + (size_t)row * ld + col0 + lane;
#pragma unroll 4
        for (int k = 0; k < nchunks; ++k) { const float x = bf1(r[k * cstride]); r[k * cstride] = tobf1(rope_apply(x, lane, cs, sn)); }
    }
}

namespace att {
#ifndef ATT_LEAN0
#define ATT_LEAN0 0
#endif
#ifndef ATT_LEAN
#define ATT_LEAN 1
#endif
#ifndef ATT_3STAGE
#define ATT_3STAGE 0
#endif
#ifndef ATT_QLATE
#define ATT_QLATE 1
#endif
#ifndef ATT_PRIO
#define ATT_PRIO 1
#endif
#ifndef ATT_KMAJOR
#define ATT_KMAJOR 0
#endif
#ifndef ATT_TRB
#define ATT_TRB 1
#endif
#ifndef ATT_STAGGER
#define ATT_STAGGER 0
#endif
#ifndef ATT_SDEPTH
#define ATT_SDEPTH(MODE) ((MODE) == 0 ? 1 : 1)
#endif
#ifndef ATT_PVPIPE
#define ATT_PVPIPE(MODE) ((MODE) == 1)
#endif
#define SBAR() __builtin_amdgcn_sched_barrier(0)
__device__ __forceinline__ int crow(int r, int hi) { return (r & 3) + 8 * (r >> 2) + 4 * hi; }
__device__ __forceinline__ unsigned cvtpkv(float lo, float hi) { unsigned r; asm volatile("v_cvt_pk_bf16_f32 %0, %1, %2" : "=v"(r) : "v"(lo), "v"(hi)); return r; }

__device__ __forceinline__ void partialSM(f32x16& p0, f32x16& p1, float& m_reg, float& mn, float& alpha, const float C, const float THRS) {
  float pmax = p0[0];
#pragma unroll
  for (int r = 1; r < 16; ++r) pmax = fmaxf(pmax, p0[r]);
#pragma unroll
  for (int r = 0; r < 16; ++r) pmax = fmaxf(pmax, p1[r]);
  { auto rr = __builtin_amdgcn_permlane32_swap(__float_as_uint(pmax), __float_as_uint(pmax), false, false);
    pmax = fmaxf(__uint_as_float(rr[0]), __uint_as_float(rr[1])); }
  if (__builtin_expect(__all(pmax - m_reg <= THRS), 1)) { mn = m_reg; alpha = 1.f; }
  else { mn = fmaxf(m_reg, pmax); alpha = __builtin_amdgcn_exp2f((m_reg - mn) * C); m_reg = mn; }
  const float mnC = -mn * C;
#pragma unroll
  for (int r = 0; r < 16; ++r) p0[r] = fmaf(p0[r], C, mnC);
#pragma unroll
  for (int r = 0; r < 16; ++r) p1[r] = fmaf(p1[r], C, mnC);
#pragma unroll
  for (int r = 0; r < 16; ++r) p0[r] = __builtin_amdgcn_exp2f(p0[r]);
}
__device__ __forceinline__ void finishSM(f32x16& p0, f32x16& p1, float alpha, float& l_reg, bf16x8& pa0, bf16x8& pa1, bf16x8& pa2, bf16x8& pa3) {
#pragma unroll
  for (int r = 0; r < 16; ++r) p1[r] = __builtin_amdgcn_exp2f(p1[r]);
  float ps = 0;
#pragma unroll
  for (int r = 0; r < 16; ++r) ps += p0[r];
#pragma unroll
  for (int r = 0; r < 16; ++r) ps += p1[r];
  { auto rr = __builtin_amdgcn_permlane32_swap(__float_as_uint(ps), __float_as_uint(ps), false, false);
    ps = __uint_as_float(rr[0]) + __uint_as_float(rr[1]); }
  l_reg = l_reg * alpha + ps;
#define PK4(P, BASE, OUT) do { unsigned a0 = cvtpkv(P[BASE + 0], P[BASE + 1]), a1 = cvtpkv(P[BASE + 2], P[BASE + 3]);   \
    unsigned b0 = cvtpkv(P[BASE + 4], P[BASE + 5]), b1 = cvtpkv(P[BASE + 6], P[BASE + 7]);                              \
    auto r0 = __builtin_amdgcn_permlane32_swap(a0, b0, false, false); auto r1 = __builtin_amdgcn_permlane32_swap(a1, b1, false, false); \
    u32x4 w = {r0[0], r1[0], r0[1], r1[1]}; OUT = *reinterpret_cast<bf16x8*>(&w); } while (0)
  PK4(p0, 0, pa0); PK4(p0, 8, pa1); PK4(p1, 0, pa2); PK4(p1, 8, pa3);
#undef PK4
}
__device__ __forceinline__ void partialSM_lean(f32x16& p0, f32x16& p1, f32x16& nm, float& alpha, const bool first) {
  constexpr float THR2 = 11.541560327111707f;
  float dmax = p0[0];
#pragma unroll
  for (int r = 1; r < 16; ++r) dmax = fmaxf(dmax, p0[r]);
#pragma unroll
  for (int r = 0; r < 16; ++r) dmax = fmaxf(dmax, p1[r]);
  { auto rr = __builtin_amdgcn_permlane32_swap(__float_as_uint(dmax), __float_as_uint(dmax), false, false);
    dmax = fmaxf(__uint_as_float(rr[0]), __uint_as_float(rr[1])); }
  alpha = 1.f;
  if (first || !__all(dmax <= THR2)) {
    const float delta = first ? dmax : (dmax > THR2 ? dmax : 0.f);
    if (!first) alpha = __builtin_amdgcn_exp2f(-delta);
#pragma unroll
    for (int r = 0; r < 16; ++r) { p0[r] -= delta; p1[r] -= delta; nm[r] -= delta; }
  }
#pragma unroll
  for (int r = 0; r < 16; ++r) p0[r] = __builtin_amdgcn_exp2f(p0[r]);
}
__device__ __forceinline__ void finishSM_lean(f32x16& p0, f32x16& p1, bf16x8& pa0, bf16x8& pa1, bf16x8& pa2, bf16x8& pa3) {
#pragma unroll
  for (int r = 0; r < 16; ++r) p1[r] = __builtin_amdgcn_exp2f(p1[r]);
#define PK4(P, BASE, OUT) do { unsigned a0 = cvtpkv(P[BASE + 0], P[BASE + 1]), a1 = cvtpkv(P[BASE + 2], P[BASE + 3]);   \
    unsigned b0 = cvtpkv(P[BASE + 4], P[BASE + 5]), b1 = cvtpkv(P[BASE + 6], P[BASE + 7]);                              \
    auto r0 = __builtin_amdgcn_permlane32_swap(a0, b0, false, false); auto r1 = __builtin_amdgcn_permlane32_swap(a1, b1, false, false); \
    u32x4 w = {r0[0], r1[0], r0[1], r1[1]}; OUT = *reinterpret_cast<bf16x8*>(&w); } while (0)
  PK4(p0, 0, pa0); PK4(p0, 8, pa1); PK4(p1, 0, pa2); PK4(p1, 8, pa3);
#undef PK4
}
__device__ __forceinline__ bf16x8 scale_bf16x8(bf16x8 v, float c) {
  const u32x4 w = *reinterpret_cast<u32x4*>(&v); u32x4 o;
  o.x = cvtpk(bflo(w.x) * c, bfhi(w.x) * c); o.y = cvtpk(bflo(w.y) * c, bfhi(w.y) * c); o.z = cvtpk(bflo(w.z) * c, bfhi(w.z) * c); o.w = cvtpk(bflo(w.w) * c, bfhi(w.w) * c);
  return *reinterpret_cast<bf16x8*>(&o);
}
template <int PITCH> __device__ __forceinline__ int kswz(int r) { return PITCH == 256 ? (r & 15) : ((r >> 1) & 7); }
template <int NQF, int NQR, int PITCH> __device__ __forceinline__ void qkt(f32x16& p0, f32x16& p1, const LAS char* Ks, int chunk0, const bf16x8* qr, const LAS char* ql, int r32, int hi, const f32x16 init = f32x16{}) {
  p0 = init; p1 = init;
  const int sw = kswz<PITCH>(r32);
#pragma unroll
  for (int d0 = 0; d0 < NQF; ++d0) { const int off = ((chunk0 + d0 * 2 + hi) ^ sw) * 16;
    const bf16x8 b0 = *(const LAS bf16x8*)(Ks + r32 * PITCH + off);
    const bf16x8 b1 = *(const LAS bf16x8*)(Ks + (32 + r32) * PITCH + off);
    const bf16x8 q = d0 < NQR ? qr[d0 < NQR ? d0 : 0] : *(const LAS bf16x8*)(ql + (d0 - NQR < 0 ? 0 : d0 - NQR) * 1024);
    p0 = __builtin_amdgcn_mfma_f32_32x32x16_bf16(b0, q, p0, 0, 0, 0);
    p1 = __builtin_amdgcn_mfma_f32_32x32x16_bf16(b1, q, p1, 0, 0, 0); }
}
__device__ __forceinline__ int v_st(int k, int c) { const int kk = (k & ~0xC) | ((k & 4) << 1) | ((k & 8) >> 1); return ((kk >> 3) * 4 + (c >> 5)) * 512 + ((kk & 7) * 32 + (c & 31)) * 2; }
__device__ __forceinline__ int v_rd_base(int lane) { return ((lane & 3) << 3) | (((lane >> 2) & 3) << 6) | (((lane >> 4) & 1) << 5) | (((lane >> 5) & 1) << 8); }
constexpr int v_rd_off(int d0, int ks, int half) { return d0 * 512 + ks * 4096 + half * 2048; }
template <int OFF> __device__ __forceinline__ s16x4 tr_read(int vb) {
  s16x4 r; asm volatile("ds_read_b64_tr_b16 %0, %1 offset:%2" : "=&v"(r) : "v"(vb), "i"(OFF) : "memory"); return r;
}
template <int D0> __device__ __forceinline__ void pv_one(f32x16& od, int vb, bf16x8 pa0, bf16x8 pa1, bf16x8 pa2, bf16x8 pa3) {
  const s16x4 l0 = tr_read<v_rd_off(D0, 0, 0)>(vb), h0 = tr_read<v_rd_off(D0, 0, 1)>(vb), l1 = tr_read<v_rd_off(D0, 1, 0)>(vb), h1 = tr_read<v_rd_off(D0, 1, 1)>(vb);
  const s16x4 l2 = tr_read<v_rd_off(D0, 2, 0)>(vb), h2 = tr_read<v_rd_off(D0, 2, 1)>(vb), l3 = tr_read<v_rd_off(D0, 3, 0)>(vb), h3 = tr_read<v_rd_off(D0, 3, 1)>(vb);
  asm volatile("s_waitcnt lgkmcnt(0)" ::: "memory"); SBAR();
#define PK(L, H) (bf16x8){L[0], L[1], L[2], L[3], H[0], H[1], H[2], H[3]}
  od = __builtin_amdgcn_mfma_f32_32x32x16_bf16(pa0, PK(l0, h0), od, 0, 0, 0);
  od = __builtin_amdgcn_mfma_f32_32x32x16_bf16(pa1, PK(l1, h1), od, 0, 0, 0);
  od = __builtin_amdgcn_mfma_f32_32x32x16_bf16(pa2, PK(l2, h2), od, 0, 0, 0);
  od = __builtin_amdgcn_mfma_f32_32x32x16_bf16(pa3, PK(l3, h3), od, 0, 0, 0);
#undef PK
}
__device__ __forceinline__ void pv_d0(f32x16* o, int vb, bf16x8 pa0, bf16x8 pa1, bf16x8 pa2, bf16x8 pa3) {
  pv_one<0>(o[0], vb, pa0, pa1, pa2, pa3); pv_one<1>(o[1], vb, pa0, pa1, pa2, pa3); pv_one<2>(o[2], vb, pa0, pa1, pa2, pa3); pv_one<3>(o[3], vb, pa0, pa1, pa2, pa3);
}
struct VFrag { s16x4 l0, h0, l1, h1, l2, h2, l3, h3; };
typedef short v4i16_t __attribute__((ext_vector_type(4)));
template <int OFF> __device__ __forceinline__ s16x4 tr_read_b(int vb) {
  return __builtin_bit_cast(s16x4, __builtin_amdgcn_ds_read_tr16_b64_v4i16((LAS v4i16_t*)(uintptr_t)(unsigned)(vb + OFF)));
}
template <int D0> __device__ __forceinline__ void tr8b(VFrag& f, int vb) {
  f.l0 = tr_read_b<v_rd_off(D0, 0, 0)>(vb); f.h0 = tr_read_b<v_rd_off(D0, 0, 1)>(vb); f.l1 = tr_read_b<v_rd_off(D0, 1, 0)>(vb); f.h1 = tr_read_b<v_rd_off(D0, 1, 1)>(vb);
  f.l2 = tr_read_b<v_rd_off(D0, 2, 0)>(vb); f.h2 = tr_read_b<v_rd_off(D0, 2, 1)>(vb); f.l3 = tr_read_b<v_rd_off(D0, 3, 0)>(vb); f.h3 = tr_read_b<v_rd_off(D0, 3, 1)>(vb);
}
template <int D0> __device__ __forceinline__ void tr8(VFrag& f, int vb) {
  f.l0 = tr_read<v_rd_off(D0, 0, 0)>(vb); f.h0 = tr_read<v_rd_off(D0, 0, 1)>(vb); f.l1 = tr_read<v_rd_off(D0, 1, 0)>(vb); f.h1 = tr_read<v_rd_off(D0, 1, 1)>(vb);
  f.l2 = tr_read<v_rd_off(D0, 2, 0)>(vb); f.h2 = tr_read<v_rd_off(D0, 2, 1)>(vb); f.l3 = tr_read<v_rd_off(D0, 3, 0)>(vb); f.h3 = tr_read<v_rd_off(D0, 3, 1)>(vb);
}
__device__ __forceinline__ void mfma4(f32x16& od, VFrag& f, bf16x8 pa0, bf16x8 pa1, bf16x8 pa2, bf16x8 pa3) {
#define PK(L, H) (bf16x8){L[0], L[1], L[2], L[3], H[0], H[1], H[2], H[3]}
  od = __builtin_amdgcn_mfma_f32_32x32x16_bf16(pa0, PK(f.l0, f.h0), od, 0, 0, 0);
  od = __builtin_amdgcn_mfma_f32_32x32x16_bf16(pa1, PK(f.l1, f.h1), od, 0, 0, 0);
  od = __builtin_amdgcn_mfma_f32_32x32x16_bf16(pa2, PK(f.l2, f.h2), od, 0, 0, 0);
  od = __builtin_amdgcn_mfma_f32_32x32x16_bf16(pa3, PK(f.l3, f.h3), od, 0, 0, 0);
#undef PK
}
#define VF_TIE(f) "+v"(f.l0), "+v"(f.h0), "+v"(f.l1), "+v"(f.h1), "+v"(f.l2), "+v"(f.h2), "+v"(f.l3), "+v"(f.h3)
__device__ __forceinline__ void pv_pipe(f32x16* o, int vb, bf16x8 pa0, bf16x8 pa1, bf16x8 pa2, bf16x8 pa3) {
  VFrag A, B;
  asm volatile("s_waitcnt lgkmcnt(0)" ::: "memory");
  tr8<0>(A, vb); tr8<1>(B, vb);
  asm volatile("s_waitcnt lgkmcnt(8)" : VF_TIE(A) :: "memory");
  mfma4(o[0], A, pa0, pa1, pa2, pa3);
  tr8<2>(A, vb);
  asm volatile("s_waitcnt lgkmcnt(8)" : VF_TIE(B) :: "memory");
  mfma4(o[1], B, pa0, pa1, pa2, pa3);
  tr8<3>(B, vb);
  asm volatile("s_waitcnt lgkmcnt(8)" : VF_TIE(A) :: "memory");
  mfma4(o[2], A, pa0, pa1, pa2, pa3);
  asm volatile("s_waitcnt lgkmcnt(0)" : VF_TIE(B) :: "memory");
  mfma4(o[3], B, pa0, pa1, pa2, pa3);
}
__device__ __forceinline__ void pv_psm_lean(f32x16* o, int vb, bf16x8 pa0, bf16x8 pa1, bf16x8 pa2, bf16x8 pa3, f32x16& p0, f32x16& p1, f32x16& nm, float& alpha) {
  constexpr float THR2 = 11.541560327111707f;
  const bf16x8 one8 = {0x3F80, 0x3F80, 0x3F80, 0x3F80, 0x3F80, 0x3F80, 0x3F80, 0x3F80};
  VFrag A, B;
  asm volatile("s_waitcnt lgkmcnt(0)" ::: "memory");
  tr8<0>(A, vb); tr8<1>(B, vb);
  asm volatile("s_waitcnt lgkmcnt(8)" : VF_TIE(A) :: "memory");
  mfma4(o[0], A, pa0, pa1, pa2, pa3);
  float dmax = p0[0];
#pragma unroll
  for (int r = 1; r < 16; ++r) dmax = fmaxf(dmax, p0[r]);
  tr8<2>(A, vb);
  asm volatile("s_waitcnt lgkmcnt(8)" : VF_TIE(B) :: "memory");
  mfma4(o[1], B, pa0, pa1, pa2, pa3);
#pragma unroll
  for (int r = 0; r < 16; ++r) dmax = fmaxf(dmax, p1[r]);
  { auto rr = __builtin_amdgcn_permlane32_swap(__float_as_uint(dmax), __float_as_uint(dmax), false, false);
    dmax = fmaxf(__uint_as_float(rr[0]), __uint_as_float(rr[1])); }
  alpha = 1.f;
  if (!__all(dmax <= THR2)) {
    const float delta = dmax > THR2 ? dmax : 0.f; alpha = __builtin_amdgcn_exp2f(-delta);
#pragma unroll
    for (int r = 0; r < 16; ++r) { p0[r] -= delta; p1[r] -= delta; nm[r] -= delta; }
  }
  tr8<3>(B, vb);
  asm volatile("s_waitcnt lgkmcnt(8)" : VF_TIE(A) :: "memory");
  mfma4(o[2], A, pa0, pa1, pa2, pa3);
#pragma unroll
  for (int r = 0; r < 8; ++r) p0[r] = __builtin_amdgcn_exp2f(p0[r]);
  asm volatile("s_waitcnt lgkmcnt(0)" : VF_TIE(B) :: "memory");
  mfma4(o[3], B, pa0, pa1, pa2, pa3);
#pragma unroll
  for (int r = 8; r < 16; ++r) p0[r] = __builtin_amdgcn_exp2f(p0[r]);
  o[4] = __builtin_amdgcn_mfma_f32_32x32x16_bf16(pa0, one8, o[4], 0, 0, 0); o[4] = __builtin_amdgcn_mfma_f32_32x32x16_bf16(pa1, one8, o[4], 0, 0, 0);
  o[4] = __builtin_amdgcn_mfma_f32_32x32x16_bf16(pa2, one8, o[4], 0, 0, 0); o[4] = __builtin_amdgcn_mfma_f32_32x32x16_bf16(pa3, one8, o[4], 0, 0, 0);
}
__device__ __forceinline__ void pv_psm_lean_b(f32x16* o, int vb, bf16x8 pa0, bf16x8 pa1, bf16x8 pa2, bf16x8 pa3, f32x16& p0, f32x16& p1, f32x16& nm, float& alpha) {
  constexpr float THR2 = 11.541560327111707f;
  const bf16x8 one8 = {0x3F80, 0x3F80, 0x3F80, 0x3F80, 0x3F80, 0x3F80, 0x3F80, 0x3F80};
  VFrag A, B;
  tr8b<0>(A, vb); tr8b<1>(B, vb);
  mfma4(o[0], A, pa0, pa1, pa2, pa3);
  float dmax = p0[0];
#pragma unroll
  for (int r = 1; r < 16; ++r) dmax = fmaxf(dmax, p0[r]);
  tr8b<2>(A, vb);
  mfma4(o[1], B, pa0, pa1, pa2, pa3);
#pragma unroll
  for (int r = 0; r < 16; ++r) dmax = fmaxf(dmax, p1[r]);
  { auto rr = __builtin_amdgcn_permlane32_swap(__float_as_uint(dmax), __float_as_uint(dmax), false, false);
    dmax = fmaxf(__uint_as_float(rr[0]), __uint_as_float(rr[1])); }
  alpha = 1.f;
  if (!__all(dmax <= THR2)) {
    const float delta = dmax > THR2 ? dmax : 0.f; alpha = __builtin_amdgcn_exp2f(-delta);
#pragma unroll
    for (int r = 0; r < 16; ++r) { p0[r] -= delta; p1[r] -= delta; nm[r] -= delta; }
  }
  tr8b<3>(B, vb);
  mfma4(o[2], A, pa0, pa1, pa2, pa3);
#pragma unroll
  for (int r = 0; r < 8; ++r) p0[r] = __builtin_amdgcn_exp2f(p0[r]);
  mfma4(o[3], B, pa0, pa1, pa2, pa3);
#pragma unroll
  for (int r = 8; r < 16; ++r) p0[r] = __builtin_amdgcn_exp2f(p0[r]);
  o[4] = __builtin_amdgcn_mfma_f32_32x32x16_bf16(pa0, one8, o[4], 0, 0, 0); o[4] = __builtin_amdgcn_mfma_f32_32x32x16_bf16(pa1, one8, o[4], 0, 0, 0);
  o[4] = __builtin_amdgcn_mfma_f32_32x32x16_bf16(pa2, one8, o[4], 0, 0, 0); o[4] = __builtin_amdgcn_mfma_f32_32x32x16_bf16(pa3, one8, o[4], 0, 0, 0);
}
struct VStep { s16x4 l0, h0, l1, h1, l2, h2, l3, h3; };
template <int KS> __device__ __forceinline__ void trstep(VStep& f, int vb) {
  f.l0 = tr_read_b<v_rd_off(0, KS, 0)>(vb); f.h0 = tr_read_b<v_rd_off(0, KS, 1)>(vb); f.l1 = tr_read_b<v_rd_off(1, KS, 0)>(vb); f.h1 = tr_read_b<v_rd_off(1, KS, 1)>(vb);
  f.l2 = tr_read_b<v_rd_off(2, KS, 0)>(vb); f.h2 = tr_read_b<v_rd_off(2, KS, 1)>(vb); f.l3 = tr_read_b<v_rd_off(3, KS, 0)>(vb); f.h3 = tr_read_b<v_rd_off(3, KS, 1)>(vb);
}
__device__ __forceinline__ void mfma5(f32x16* o, const VStep& f, bf16x8 pa) {
  const bf16x8 one8 = {0x3F80, 0x3F80, 0x3F80, 0x3F80, 0x3F80, 0x3F80, 0x3F80, 0x3F80};
#define PK(L, H) (bf16x8){L[0], L[1], L[2], L[3], H[0], H[1], H[2], H[3]}
  o[0] = __builtin_amdgcn_mfma_f32_32x32x16_bf16(pa, PK(f.l0, f.h0), o[0], 0, 0, 0);
  o[1] = __builtin_amdgcn_mfma_f32_32x32x16_bf16(pa, PK(f.l1, f.h1), o[1], 0, 0, 0);
  o[2] = __builtin_amdgcn_mfma_f32_32x32x16_bf16(pa, PK(f.l2, f.h2), o[2], 0, 0, 0);
  o[3] = __builtin_amdgcn_mfma_f32_32x32x16_bf16(pa, PK(f.l3, f.h3), o[3], 0, 0, 0);
  o[4] = __builtin_amdgcn_mfma_f32_32x32x16_bf16(pa, one8, o[4], 0, 0, 0);
#undef PK
}
template <int BASE> __device__ __forceinline__ bf16x8 pk4e(const f32x16& P) {
  const float e0 = __builtin_amdgcn_exp2f(P[BASE + 0]), e1 = __builtin_amdgcn_exp2f(P[BASE + 1]), e2 = __builtin_amdgcn_exp2f(P[BASE + 2]), e3 = __builtin_amdgcn_exp2f(P[BASE + 3]);
  const float e4 = __builtin_amdgcn_exp2f(P[BASE + 4]), e5 = __builtin_amdgcn_exp2f(P[BASE + 5]), e6 = __builtin_amdgcn_exp2f(P[BASE + 6]), e7 = __builtin_amdgcn_exp2f(P[BASE + 7]);
  const unsigned a0 = cvtpk(e0, e1), a1 = cvtpk(e2, e3), b0 = cvtpk(e4, e5), b1 = cvtpk(e6, e7);
  const auto r0 = __builtin_amdgcn_permlane32_swap(a0, b0, false, false); const auto r1 = __builtin_amdgcn_permlane32_swap(a1, b1, false, false);
  u32x4 w = {r0[0], r1[0], r0[1], r1[1]}; return *reinterpret_cast<bf16x8*>(&w);
}
__device__ __forceinline__ float rowmax_lean(const f32x16& p0, const f32x16& p1) {
  float d = p0[0];
#pragma unroll
  for (int r = 1; r < 16; ++r) d = fmaxf(d, p0[r]);
#pragma unroll
  for (int r = 0; r < 16; ++r) d = fmaxf(d, p1[r]);
  const auto rr = __builtin_amdgcn_permlane32_swap(__float_as_uint(d), __float_as_uint(d), false, false);
  return fmaxf(__uint_as_float(rr[0]), __uint_as_float(rr[1]));
}
__device__ __forceinline__ void shift_lean(float dmax, f32x16& p0, f32x16& p1, f32x16& nm, float& alpha, const bool first) {
  constexpr float THR2 = 11.541560327111707f;
  alpha = 1.f;
  if (first || !__all(dmax <= THR2)) {
    const float delta = first ? dmax : (dmax > THR2 ? dmax : 0.f);
    if (!first) alpha = __builtin_amdgcn_exp2f(-delta);
#pragma unroll
    for (int r = 0; r < 16; ++r) { p0[r] -= delta; p1[r] -= delta; nm[r] -= delta; }
  }
}
#define SGB(mask, n) __builtin_amdgcn_sched_group_barrier((mask), (n), 0)
__device__ __forceinline__ bf16x8 ld8(const bf16* p) { return *reinterpret_cast<const bf16x8*>(p); }

template <int MODE, int ATTV = 0>
__device__ __forceinline__ void attn_unit(const bf16* __restrict__ Qrow0, int ldq, const bf16* __restrict__ Kb, const bf16* __restrict__ Vb, int ldk, const bf16* __restrict__ KRb,
                                          int b, int nct, int NT, bf16* __restrict__ Ob, float lam, const float* __restrict__ subln, float oscale, LAS unsigned char* lds_, const int tid_in) {
  constexpr bool LEAN = ((MODE == 1) && ATT_LEAN) || ((MODE == 0) && ATT_LEAN0); constexpr int NQF = MODE == 0 ? 12 : 4, NQR = MODE == 0 ? 4 : 4, NOB = LEAN ? 5 : 4, PITCH = MODE == 0 ? 384 : 256, SHM_V = 16384, SHM_K = 64 * PITCH, SDEPTH = ATT_SDEPTH(MODE); constexpr bool PVPIPE = ATT_PVPIPE(MODE);
  const float SCALE = MODE == 0 ? 0.07216878364870323f : 0.125f;
  const float C = SCALE * 1.4426950408889634f, THRS = 8.f / SCALE;
  if (ATT_PRIO) { if (__builtin_amdgcn_readfirstlane(tid_in >> 8) != 0) __builtin_amdgcn_s_setprio(1); }
  const int tid = launder_v(tid_in) & 511, wid = tid >> 6, lane = tid & 63, r32 = lane & 31, hi = lane >> 5;
  LAS char* lds = (LAS char*)(LAS unsigned char*)lds_;
  constexpr bool THREE = (MODE == 1) && ATT_3STAGE; constexpr int NSTG = THREE ? 3 : 2, STG = SHM_V + SHM_K, SCR0 = NSTG * STG;
#define VOFF(s) (!THREE ? (s) * SHM_V : (s) * STG)
#define KOFF(s) (!THREE ? 2 * SHM_V + (s) * SHM_K : (s) * STG + SHM_V)
  LAS char* V_lds = lds; LAS char* K_lds = lds;
  LAS float* wsf = (LAS float*)(lds + NSTG * (SHM_V + SHM_K)) + wid * 64; LAS float* li_l = wsf; LAS float* al_l = wsf + 32;
  const int wq = MODE == 0 ? wid : (wid & 3), sgrp = MODE == 0 ? 0 : (wid >> 2);
  float m_reg = -1e30f, l_reg = 0; f32x16 o[NOB] = {}; bf16x8 qr[NQR > 0 ? NQR : 1]; f32x16 nm = {};
  LAS char* ql = lds + SCR0 + 2048 + wid * (MODE == 0 ? 8192 : 4096) + lane * 16;
  const bf16* Qw = Qrow0 + (size_t)(wq * 32 + r32) * ldq + sgrp * 64 + hi * 8;
#define QLOADS() do { _Pragma("unroll") for (int d0 = 0; d0 < NQR; ++d0) { qr[d0] = ld8(Qw + d0 * 16); if (LEAN) qr[d0] = scale_bf16x8(qr[d0], C); } \
    _Pragma("unroll") for (int d0 = NQR; d0 < NQF; ++d0) { bf16x8 qv = ld8(Qw + d0 * 16); if (LEAN) qv = scale_bf16x8(qv, C); *(LAS bf16x8*)(ql + (d0 - NQR) * 1024) = qv; } } while (0)
  constexpr bool QLATE = ATT_QLATE && !((MODE == 1) && ATT_3STAGE) && !((MODE == 1) && ATT_LEAN && ATT_KMAJOR && (ATTV == 0));
  if (!QLATE) QLOADS();
  const int sr = tid >> 4, sc = (tid & 15) * 8, vst0 = v_st(sr, sc), vst1 = v_st(32 + sr, sc);
  const int kst0 = sr * PITCH + (((tid & 15) ^ kswz<PITCH>(sr)) * 16), kst1 = kst0 + 32 * PITCH;
  const int rrow = tid >> 3, krs = rrow * PITCH + (((16 + (tid & 7)) ^ kswz<PITCH>(rrow)) * 16);
  const int chunk0 = sgrp * 8;
  const int vb0 = (int)(uintptr_t)V_lds + v_rd_base(lane);
  struct Slot { bf16x8 vs0, vs1, ks0, ks1, kr; } sr_[SDEPTH];
#define KROW(jt) ((jt) < nct ? (ML + b * CTXL + (jt) * 64) : (b * SEQ + ((jt) - nct) * 64))
#define SLOAD(i, jt) do { const int k0_ = KROW(jt); sr_[i].vs0 = ld8(Vb + (size_t)(k0_ + sr) * ldk + sc); sr_[i].vs1 = ld8(Vb + (size_t)(k0_ + 32 + sr) * ldk + sc); \
    sr_[i].ks0 = ld8(Kb + (size_t)(k0_ + sr) * ldk + sc); sr_[i].ks1 = ld8(Kb + (size_t)(k0_ + 32 + sr) * ldk + sc); \
    if (MODE == 0) sr_[i].kr = ld8(KRb + (size_t)(k0_ + rrow) * 64 + (tid & 7) * 8); } while (0)
#define SWRITE(bf, i) do { *(LAS bf16x8*)(V_lds + VOFF(bf) + vst0) = sr_[i].vs0; *(LAS bf16x8*)(V_lds + VOFF(bf) + vst1) = sr_[i].vs1; \
    *(LAS bf16x8*)(K_lds + KOFF(bf) + kst0) = sr_[i].ks0; *(LAS bf16x8*)(K_lds + KOFF(bf) + kst1) = sr_[i].ks1; \
    if (MODE == 0) *(LAS bf16x8*)(K_lds + KOFF(bf) + krs) = sr_[i].kr; } while (0)
#define SWAIT() do { if constexpr (SDEPTH == 2) asm volatile("s_waitcnt vmcnt(4)" ::: "memory"); else asm volatile("s_waitcnt vmcnt(0)" ::: "memory"); } while (0)
#define RESC(a) do { if (__any((a) < 1.f)) { if (hi == 0) al_l[r32] = (a); asm volatile("s_waitcnt lgkmcnt(0)" ::: "memory"); \
    _Pragma("unroll") for (int d = 0; d < NOB; ++d) _Pragma("unroll") for (int r = 0; r < 16; ++r) o[d][r] *= al_l[crow(r, hi)]; } } while (0)
#define PV(vb_) do { if constexpr (ATTV == 2) { o[0][0] += __uint_as_float((unsigned)pa0[0] + (unsigned)pa3[1]); } else if constexpr (PVPIPE) pv_pipe(o, (vb_), pa0, pa1, pa2, pa3); else pv_d0(o, (vb_), pa0, pa1, pa2, pa3); \
    if constexpr (LEAN) { const bf16x8 one8 = {0x3F80, 0x3F80, 0x3F80, 0x3F80, 0x3F80, 0x3F80, 0x3F80, 0x3F80};     \
        o[NOB - 1] = __builtin_amdgcn_mfma_f32_32x32x16_bf16(pa0, one8, o[NOB - 1], 0, 0, 0); o[NOB - 1] = __builtin_amdgcn_mfma_f32_32x32x16_bf16(pa1, one8, o[NOB - 1], 0, 0, 0); \
        o[NOB - 1] = __builtin_amdgcn_mfma_f32_32x32x16_bf16(pa2, one8, o[NOB - 1], 0, 0, 0); o[NOB - 1] = __builtin_amdgcn_mfma_f32_32x32x16_bf16(pa3, one8, o[NOB - 1], 0, 0, 0); } } while (0)
#define PSM(p0_, p1_, mn_, al_, first_) do { if constexpr (ATTV == 1) { al_ = 1.f; } else if constexpr (LEAN) partialSM_lean(p0_, p1_, nm, al_, first_); else partialSM(p0_, p1_, m_reg, mn_, al_, C, THRS); } while (0)
#define FSM(p0_, p1_, al_) do { if constexpr (ATTV == 1) { u32x4 w0_ = {__float_as_uint(p0_[0]), __float_as_uint(p0_[1]), __float_as_uint(p1_[0]), __float_as_uint(p1_[1])}; pa0 = pa1 = pa2 = pa3 = *reinterpret_cast<bf16x8*>(&w0_); } else if constexpr (LEAN) finishSM_lean(p0_, p1_, pa0, pa1, pa2, pa3); else finishSM(p0_, p1_, al_, l_reg, pa0, pa1, pa2, pa3); } while (0)
#define QKT(p0_, p1_, Kp_) do { if constexpr (ATTV == 5) { p0_ = nm; p1_ = nm; p0_[0] += (float)r32; } else if constexpr (LEAN) qkt<NQF, NQR, PITCH>(p0_, p1_, Kp_, chunk0, qr, ql, r32, hi, nm); else qkt<NQF, NQR, PITCH>(p0_, p1_, Kp_, chunk0, qr, ql, r32, hi); } while (0)
  f32x16 pA0, pA1, pB0, pB1; float mnA, mnB, alA, alB; bf16x8 pa0, pa1, pa2, pa3;
  constexpr bool KMAJ = (MODE == 1) && LEAN && ATT_KMAJOR && (ATTV == 0) && !THREE;
  if constexpr (KMAJ) {
    VStep VA, VB;
#define KSTEPS(PC0, PC1, ALC, PP0, PP1, KC, VP, LD, DOQK) do { const int vb_ = vb0 + VOFF(VP); float dmx_ = 0.f; \
      SBAR(); \
      if (DOQK) QKT(PC0, PC1, K_lds + KOFF(KC)); \
      pa0 = pk4e<0>(PP0); trstep<0>(VA, vb_); \
      _Pragma("unroll") for (int i_ = 0; i_ < 8; ++i_) { SGB(0x008, 1); SGB(0x100, 3); SGB(0x002, 2); } \
      SBAR(); LD; SBAR(); \
      mfma5(o, VA, pa0); pa1 = pk4e<8>(PP0); trstep<1>(VB, vb_); \
      _Pragma("unroll") for (int i_ = 0; i_ < 5; ++i_) { SGB(0x008, 1); SGB(0x100, 2); SGB(0x002, 3); } \
      SBAR(); \
      mfma5(o, VB, pa1); pa2 = pk4e<0>(PP1); trstep<2>(VA, vb_); \
      _Pragma("unroll") for (int i_ = 0; i_ < 5; ++i_) { SGB(0x008, 1); SGB(0x100, 2); SGB(0x002, 3); } \
      SBAR(); \
      mfma5(o, VA, pa2); pa3 = pk4e<8>(PP1); trstep<3>(VB, vb_); \
      _Pragma("unroll") for (int i_ = 0; i_ < 5; ++i_) { SGB(0x008, 1); SGB(0x100, 2); SGB(0x002, 3); } \
      SBAR(); \
      mfma5(o, VB, pa3); if (DOQK) dmx_ = rowmax_lean(PC0, PC1); \
      _Pragma("unroll") for (int i_ = 0; i_ < 5; ++i_) { SGB(0x008, 1); SGB(0x002, 7); } \
      SBAR(); \
      if (DOQK) shift_lean(dmx_, PC0, PC1, nm, ALC, false); } while (0)
    SLOAD(0, 0); asm volatile("s_waitcnt vmcnt(0)" ::: "memory"); SWRITE(0, 0); __syncthreads();
    QKT(pA0, pA1, K_lds + KOFF(0)); shift_lean(rowmax_lean(pA0, pA1), pA0, pA1, nm, alA, true);
    SLOAD(0, 1); asm volatile("s_waitcnt vmcnt(0)" ::: "memory"); SWRITE(1, 0); __syncthreads();
    for (int j = 1; j + 1 < NT; j += 2) {
      KSTEPS(pB0, pB1, alB, pA0, pA1, 1, 0, SLOAD(0, j + 1), true);
      __syncthreads(); asm volatile("s_waitcnt vmcnt(0)" ::: "memory"); SWRITE(0, 0);
      RESC(alB); __syncthreads();
      KSTEPS(pA0, pA1, alA, pB0, pB1, 0, 1, SLOAD(0, j + 2), true);
      __syncthreads(); asm volatile("s_waitcnt vmcnt(0)" ::: "memory"); SWRITE(1, 0);
      RESC(alA); __syncthreads();
    }
    KSTEPS(pB0, pB1, alB, pA0, pA1, 1, 0, (void)0, true);
    __syncthreads(); RESC(alB);
    KSTEPS(pA0, pA1, alA, pB0, pB1, 0, 1, (void)0, false);
#undef KSTEPS
  } else if constexpr (!THREE) {
  constexpr int SE = 0, SO = SDEPTH - 1;
  SLOAD(SE, 0); if (QLATE) QLOADS(); asm volatile("s_waitcnt vmcnt(0)" ::: "memory"); SWRITE(0, SE);
  if constexpr (QLATE && SDEPTH == 1) SLOAD(SO, 1);
  __syncthreads();
  QKT(pA0, pA1, K_lds + KOFF(0)); PSM(pA0, pA1, mnA, alA, true);
  if constexpr (!(QLATE && SDEPTH == 1)) SLOAD(SO, 1);
  if constexpr (SDEPTH == 2) { if (2 < NT) SLOAD(SE, 2); }
  SWAIT(); SWRITE(1, SO); __syncthreads();
#define ILV() do { if constexpr (PVPIPE) { _Pragma("unroll") for (int i_ = 0; i_ < 20; ++i_) { __builtin_amdgcn_sched_group_barrier(0x008, 1, 0); __builtin_amdgcn_sched_group_barrier(0x002, 5, 0); } } } while (0)
#define LSLOAD(i, jt) do { if constexpr (ATTV != 3) SLOAD(i, jt); } while (0)
#define LSWRITE(bf, i) do { if constexpr (ATTV != 3) SWRITE(bf, i); } while (0)
#define LSWAIT() do { if constexpr (ATTV != 3) SWAIT(); } while (0)
#define LSYNC() do { if constexpr (ATTV != 4) __syncthreads(); } while (0)
#define HALFSTEP(PC0, PC1, MNC, ALC, PP0, PP1, ALP, KC, VP, LD) do { \
    if (!STAG || wid < 4) { \
      SBAR(); QKT(PC0, PC1, K_lds + KOFF(KC)); FSM(PP0, PP1, ALP); SBAR(); \
      LD; SBAR(); \
      if constexpr (PVPIPE && LEAN && ATTV == 0) { if constexpr (ATT_TRB) pv_psm_lean_b(o, vb0 + VOFF(VP), pa0, pa1, pa2, pa3, PC0, PC1, nm, ALC); else pv_psm_lean(o, vb0 + VOFF(VP), pa0, pa1, pa2, pa3, PC0, PC1, nm, ALC); } else { PV(vb0 + VOFF(VP)); PSM(PC0, PC1, MNC, ALC, false); } \
    } else { \
      SBAR(); FSM(PP0, PP1, ALP); SBAR(); \
      LD; SBAR(); \
      PV(vb0 + VOFF(VP)); SBAR(); \
      QKT(PC0, PC1, K_lds + KOFF(KC)); SBAR(); \
      PSM(PC0, PC1, MNC, ALC, false); \
    } } while (0)
  constexpr bool STAG = (MODE == 1) && ATT_STAGGER && ATTV == 0;
  for (int j = 1; j + 1 < NT; j += 2) {
    HALFSTEP(pB0, pB1, mnB, alB, pA0, pA1, alA, 1, 0, LSLOAD(SO, j + SDEPTH));
    LSYNC(); LSWAIT(); LSWRITE(0, SE);
    RESC(alB); LSYNC();
    HALFSTEP(pA0, pA1, mnA, alA, pB0, pB1, alB, 0, 1, if (SDEPTH == 1 || j + 3 < NT) LSLOAD(SE, j + 1 + SDEPTH));
    LSYNC(); LSWAIT(); LSWRITE(1, SO);
    RESC(alA); LSYNC();
  }
#undef HALFSTEP
#undef ILV
#undef LSLOAD
#undef LSWRITE
#undef LSWAIT
#undef LSYNC
  SBAR(); QKT(pB0, pB1, K_lds + KOFF(1));
  FSM(pA0, pA1, alA); SBAR();
  PV(vb0); PSM(pB0, pB1, mnB, alB, false);
  __syncthreads(); RESC(alB);
  FSM(pB0, pB1, alB); SBAR();
  PV(vb0 + VOFF(1));
  } else {
#define STEP(PC0, PC1, ALC, PP0, PP1, ALP, jj, SP, SC, SN) do { const int j_ = (jj); \
      if (j_ + 1 < NT) { asm volatile("s_waitcnt vmcnt(0)" ::: "memory"); SWRITE(SN, 0); if (j_ + 2 < NT) SLOAD(0, j_ + 2); } \
      SBAR(); QKT(PC0, PC1, K_lds + KOFF(SC)); FSM(PP0, PP1, ALP); SBAR(); \
      PV(vb0 + VOFF(SP)); PSM(PC0, PC1, mnA, ALC, false); \
      RESC(ALC); __syncthreads(); } while (0)
    SLOAD(0, 0); asm volatile("s_waitcnt vmcnt(0)" ::: "memory"); SWRITE(0, 0);
    SLOAD(0, 1); asm volatile("s_waitcnt vmcnt(0)" ::: "memory"); SWRITE(1, 0);
    SLOAD(0, 2); __syncthreads();
    QKT(pA0, pA1, K_lds + KOFF(0)); PSM(pA0, pA1, mnA, alA, true);
    STEP(pB0, pB1, alB, pA0, pA1, alA, 1, 0, 1, 2);
    int j = 2;
    for (; j + 5 < NT; j += 6) {
      STEP(pA0, pA1, alA, pB0, pB1, alB, j, 1, 2, 0);
      STEP(pB0, pB1, alB, pA0, pA1, alA, j + 1, 2, 0, 1);
      STEP(pA0, pA1, alA, pB0, pB1, alB, j + 2, 0, 1, 2);
      STEP(pB0, pB1, alB, pA0, pA1, alA, j + 3, 1, 2, 0);
      STEP(pA0, pA1, alA, pB0, pB1, alB, j + 4, 2, 0, 1);
      STEP(pB0, pB1, alB, pA0, pA1, alA, j + 5, 0, 1, 2);
    }
    if (j < NT) { STEP(pA0, pA1, alA, pB0, pB1, alB, j, 1, 2, 0); STEP(pB0, pB1, alB, pA0, pA1, alA, j + 1, 2, 0, 1); j += 2; }
    if (j < NT) { STEP(pA0, pA1, alA, pB0, pB1, alB, j, 0, 1, 2); STEP(pB0, pB1, alB, pA0, pA1, alA, j + 1, 1, 2, 0); j += 2; }
    FSM(pB0, pB1, alB); SBAR();
    { const int sl = (NT - 1) % 3; PV(vb0 + VOFF(sl)); }
#undef STEP
  }
  float rli[16];
  if constexpr (LEAN) {
#pragma unroll
    for (int r = 0; r < 16; ++r) rli[r] = __builtin_amdgcn_rcpf(o[NOB - 1][r]);
  } else {
    if (hi == 0) li_l[r32] = l_reg; asm volatile("s_waitcnt lgkmcnt(0)" ::: "memory");
#pragma unroll
    for (int r = 0; r < 16; ++r) rli[r] = __builtin_amdgcn_rcpf(li_l[crow(r, hi)]);
  }
  bf16* Ow = Ob + (size_t)(wq * 32) * DM;
  if constexpr (MODE == 0) {
#pragma unroll
    for (int r = 0; r < 16; ++r) { const int orow = crow(r, hi);
#pragma unroll
      for (int d0 = 0; d0 < 4; ++d0) Ow[(size_t)orow * DM + d0 * 32 + r32] = tobf1(o[d0][r] * rli[r]); }
    __syncthreads();
  } else {
    LAS float* ex = (LAS float*)lds;
    __syncthreads();
    if (sgrp == 1) {
#pragma unroll
      for (int r = 0; r < 16; ++r)
#pragma unroll
        for (int d0 = 0; d0 < 4; ++d0) ex[(wq * 32 + crow(r, hi)) * 128 + d0 * 32 + r32] = o[d0][r] * rli[r];
    }
    __syncthreads();
    if (sgrp == 0) {
#pragma unroll
      for (int r = 0; r < 16; ++r) { const int orow = crow(r, hi); float dd[4]; float ss = 0.f;
#pragma unroll
        for (int d0 = 0; d0 < 4; ++d0) { dd[d0] = o[d0][r] * rli[r] - lam * ex[(wq * 32 + orow) * 128 + d0 * 32 + r32]; ss += dd[d0] * dd[d0]; }
        ss = half_sum32(ss);
        const float rs = oscale / sqrtf(ss * (1.0f / 128.0f) + LN_EPS);
#pragma unroll
        for (int d0 = 0; d0 < 4; ++d0) Ow[(size_t)orow * DM + d0 * 32 + r32] = tobf1(dd[d0] * rs * subln[d0 * 32 + r32]); }
    }
    __syncthreads();
  }
  if (ATT_PRIO) __builtin_amdgcn_s_setprio(0);
#undef VOFF
#undef KOFF
#undef PV
#undef PSM
#undef FSM
#undef QKT
#undef KROW
#undef SLOAD
#undef SWRITE
#undef SWAIT
#undef RESC
}
}

__device__ __forceinline__ void mla_attn_phase(CP P, LAS unsigned char* lds, const int tid) {
    const bf16* QM = (const bf16*)(P->ws + WS_QM); const bf16* KV = (const bf16*)(P->ws + WS_KV); const bf16* KR = (const bf16*)(P->ws + WS_KR); bf16* Gb = (bf16*)(P->ws + WS_G);
    const int c = blockIdx.x, G = gridDim.x;
    for (int u = c; u < 1024 + 32; u += G) {
        int b, h, qrow0, NT;
        if (u < 1024) { const int i = u >> 8, cc = u & 255; const int bh = (cc & 7) + 8 * i, qb = cc >> 3; b = bh >> 4; h = bh & 15; qrow0 = b * SEQ + qb * 256; NT = 4 + 128; }
        else { const int bh = u - 1024; b = bh >> 4; h = bh & 15; qrow0 = ML + b * CTXL; NT = 4; }
        att::attn_unit<0>(QM + (size_t)qrow0 * 3072 + h * 192, 3072, KV + h * 256, KV + h * 256 + 128, 4096, KR, b, 4, NT, Gb + (size_t)qrow0 * DM + h * 128, 0.f, nullptr, 1.f, lds, tid);
    }
}
template <int ATTV = 0>
__device__ __forceinline__ void da_attn_phase(CP P, float lam, float oscale, LAS unsigned char* lds, const int tid, const bool ctx_q, const int nt_cap = 0) {
    const bf16* Z = (const bf16*)(P->ws + WS_Z); bf16* Gb = (bf16*)(P->ws + WS_G); const float* subln = P->in[27];
    const int c = blockIdx.x, G = gridDim.x;
    for (int u = c; u < 2048 + (ctx_q ? 64 : 0); u += G) {
        int b, h, qrow0, NT;
        if (u < 2048) { const int i = u >> 8, cc = u & 255; const int bh = (cc & 7) + 8 * (i >> 1), qb = (cc >> 3) + 32 * (i & 1); b = bh >> 4; h = bh & 15; qrow0 = b * SEQ + qb * 128; NT = 4 + 128; }
        else { const int v = u - 2048; const int bh = v >> 1; b = bh >> 4; h = bh & 15; qrow0 = ML + b * CTXL + (v & 1) * 128; NT = 4; }
        if (nt_cap) NT = nt_cap;
        att::attn_unit<1, ATTV>(Z + (size_t)qrow0 * 6144 + h * 128, 6144, Z + 2048 + h * 128, Z + 4096 + h * 128, 6144, nullptr, b, 4, NT, Gb + (size_t)qrow0 * DM + h * 128, lam, subln, oscale, lds, tid);
    }
}

__device__ __forceinline__ unsigned f2ord(float f) { const unsigned u = __float_as_uint(f); return u ^ ((unsigned)((int)u >> 31) | 0x80000000u); }
__device__ __forceinline__ float ord2f(unsigned k) { return __uint_as_float((k & 0x80000000u) ? (k ^ 0x80000000u) : ~k); }
__device__ __forceinline__ void ce_desc(unsigned& a, unsigned& b) { const unsigned mx = a > b ? a : b, mn = a > b ? b : a; a = mx; b = mn; }
template <int N, bool DESC> __device__ __forceinline__ void bitonic_merge(unsigned* a) {
#pragma unroll
    for (int j = N / 2; j > 0; j >>= 1)
#pragma unroll
        for (int i = 0; i < N; ++i) { const int l = i ^ j; if (l > i) { if (DESC) ce_desc(a[i], a[l]); else ce_desc(a[l], a[i]); } }
}
template <int N, bool DESC> __device__ __forceinline__ void bitonic_sort(unsigned* a) {
#pragma unroll
    for (int k = 2; k <= N; k <<= 1)
#pragma unroll
        for (int j = k >> 1; j > 0; j >>= 1)
#pragma unroll
            for (int i = 0; i < N; ++i) { const int l = i ^ j; if (l > i) { const bool up = ((i & k) == 0); if (up == DESC) ce_desc(a[i], a[l]); else ce_desc(a[l], a[i]); } }
}
__device__ __forceinline__ void top16_of_64(unsigned (&a)[64]) {
    bitonic_sort<16, true>(a); bitonic_sort<16, false>(a + 16); bitonic_sort<16, true>(a + 32); bitonic_sort<16, false>(a + 48);
#pragma unroll
    for (int i = 0; i < 16; ++i) a[i] = a[i] > a[16 + i] ? a[i] : a[16 + i];
    bitonic_merge<16, true>(a);
#pragma unroll
    for (int i = 0; i < 16; ++i) a[32 + i] = a[32 + i] > a[48 + i] ? a[32 + i] : a[48 + i];
    bitonic_merge<16, false>(a + 32);
#pragma unroll
    for (int i = 0; i < 16; ++i) a[i] = a[i] > a[32 + i] ? a[i] : a[32 + i];
    bitonic_merge<16, true>(a);
}
template <int PASS> __device__ __forceinline__ void route_qload(const bf16* QP, int tok, int head, int hi, bf16x8 (&qf)[8]) {
    const bf16* qp = QP + (size_t)tok * DM + head * 256 + PASS * 128 + hi * 8;
#pragma unroll
    for (int ks = 0; ks < 8; ++ks) qf[ks] = NT_ACT ? __builtin_nontemporal_load((const bf16x8*)(qp + ks * 16)) : *(const bf16x8*)(qp + ks * 16);
}
template <int PASS> __device__ __forceinline__ void route_pass(const bf16x8 (&qf)[8], const LAS char* lds, int tok, int head, int r32, int hi, unsigned (&top)[16]) {
    f32x16 acc[4] = {};
    const LAS char* Kl = lds + PASS * 32768;
#pragma unroll
    for (int kb = 0; kb < 4; ++kb)
#pragma unroll
        for (int ks = 0; ks < 8; ++ks) { const bf16x8 a = *(const LAS bf16x8*)(Kl + (kb * 32 + r32) * 256 + (((ks * 2 + hi) ^ (r32 & 15)) * 16));
            acc[kb] = __builtin_amdgcn_mfma_f32_32x32x16_bf16(a, qf[ks], acc[kb], 0, 0, 0); }
    unsigned key[64]; const unsigned base = 127u - 4u * (unsigned)hi;
#pragma unroll
    for (int kb = 0; kb < 4; ++kb)
#pragma unroll
        for (int r = 0; r < 16; ++r) key[kb * 16 + r] = (f2ord(acc[kb][r]) & ~127u) | (base - (unsigned)(kb * 32 + (r & 3) + 8 * (r >> 2)));
    top16_of_64(key);
    unsigned pr[16];
#pragma unroll
    for (int i = 0; i < 16; ++i) pr[i] = lane_xor32(key[15 - i], hi << 5);
#pragma unroll
    for (int i = 0; i < 16; ++i) key[i] = key[i] > pr[i] ? key[i] : pr[i];
    bitonic_merge<16, true>(key);
#pragma unroll
    for (int i = 0; i < 16; ++i) top[i] = key[i];
}
#ifndef ROUTE_SORT
#define ROUTE_SORT 1
#endif
#define DPP_U(v, ctrl) ((unsigned)__builtin_amdgcn_mov_dpp((int)(v), (ctrl), 0xF, 0xF, true))
template <int J> __device__ __forceinline__ unsigned lane_xor_u(unsigned v, int lane) {
    if (J == 1) return DPP_U(v, 0xB1);
    if (J == 2) return DPP_U(v, 0x4E);
    if (J == 4) { const unsigned t = DPP_U(v, 0x141); return DPP_U(t, 0x1B); }
    if (J == 8) { const unsigned t = DPP_U(v, 0x140); return DPP_U(t, 0x141); }
    if (J == 16) { const auto r = __builtin_amdgcn_permlane16_swap(v, v, false, false); return (lane & 16) ? r[0] : r[1]; }
    return lane_xor32(v, lane);
}
template <int K, int J> __device__ __forceinline__ void sort128_stage(unsigned& a0, unsigned& a1, int lane) {
    if constexpr (J == 64) { const unsigned mn = a0 < a1 ? a0 : a1, mx = a0 < a1 ? a1 : a0; a0 = mn; a1 = mx; }
    else { const unsigned p0 = lane_xor_u<J>(a0, lane), p1 = lane_xor_u<J>(a1, lane);
        const bool lower = (lane & J) == 0;
        const bool asc0 = (K >= 64) ? true : ((lane & K) == 0), asc1 = (K == 128) ? true : (K == 64 ? false : ((lane & K) == 0));
        const unsigned mn0 = a0 < p0 ? a0 : p0, mx0 = a0 < p0 ? p0 : a0, mn1 = a1 < p1 ? a1 : p1, mx1 = a1 < p1 ? p1 : a1;
        a0 = (lower == asc0) ? mn0 : mx0; a1 = (lower == asc1) ? mn1 : mx1; }
    if constexpr (J > 1) sort128_stage<K, J / 2>(a0, a1, lane);
    else if constexpr (K < 128) sort128_stage<K * 2, K>(a0, a1, lane);
}
__device__ __forceinline__ void sort128_asc(unsigned& a0, unsigned& a1, int lane) { sort128_stage<2, 1>(a0, a1, lane); }
__device__ __forceinline__ void route_phase(CP P, int L, int Mrows, LAS unsigned char* lds_, int tid, int lane, int wid, int gw, int NGW) {
    const bf16* QP = (const bf16*)(P->ws + WS_QP); unsigned* ROUTE = (unsigned*)(P->ws + WS_ROUTE);
    LAS char* lds = (LAS char*)(LAS unsigned char*)lds_;
    __syncthreads();
    {
        const bf16* K1 = (const bf16*)(P->ws + WS_PK1) + (size_t)L * 128 * 128; const bf16* K2 = (const bf16*)(P->ws + WS_PK2) + (size_t)L * 128 * 128;
        u32x4 kw[8];
#pragma unroll
        for (int t = 0; t < 8; ++t) { const int c16 = tid + t * NWAVES * 64; const int mat = c16 >> 11, row = (c16 >> 4) & 127, ch = c16 & 15; kw[t] = *(const u32x4*)((mat ? K2 : K1) + row * 128 + ch * 8); }
#pragma unroll
        for (int t = 0; t < 8; ++t) { const int c16 = tid + t * NWAVES * 64; const int mat = c16 >> 11, row = (c16 >> 4) & 127, ch = c16 & 15; *(LAS u32x4*)(lds + mat * 32768 + row * 256 + ((ch ^ (row & 15)) * 16)) = kw[t]; }
    }
    __syncthreads();
    LAS unsigned* sc = (LAS unsigned*)(lds + 65536) + wid * 2048;
    const int r32 = lane & 31, hi = lane >> 5;
    for (int item = gw; item < Mrows / 4; item += NGW) {
        const int tok = item * 4 + (r32 >> 3), head = r32 & 7;
        unsigned top0[16], top1[16];
        { bf16x8 q0[8], q1[8]; route_qload<0>(QP, tok, head, hi, q0); route_qload<1>(QP, tok, head, hi, q1);
          route_pass<0>(q0, lds, tok, head, r32, hi, top0);
          route_pass<1>(q1, lds, tok, head, r32, hi, top1); }
        float v1[16], v2[16];
#pragma unroll
        for (int i = 0; i < 16; ++i) { v1[i] = ord2f(top0[i] & ~127u); v2[i] = ord2f(top1[i] & ~127u);
            sc[i * 64 + lane] = 127u - (top0[i] & 127u); sc[(16 + i) * 64 + lane] = 127u - (top1[i] & 127u); }
        unsigned ck[64]; int n = 0;
#pragma unroll
        for (int i = 0; i < 16; ++i)
#pragma unroll
            for (int j = 0; j < 16; ++j) if ((i + 1) * (j + 1) <= 16) { ck[n] = (f2ord(v1[i] + v2[j]) & ~255u) | (unsigned)(i * 16 + j); ++n; }
#pragma unroll
        for (int i = 50; i < 64; ++i) ck[i] = 0u;
        top16_of_64(ck);
        float ev[16]; float sum = 0.f; const float mx = ord2f(ck[0] & ~255u);
#pragma unroll
        for (int k = 0; k < 16; ++k) { ev[k] = __expf(ord2f(ck[k] & ~255u) - mx); sum += ev[k]; }
        const float inv = 1.0f / sum;
        unsigned ee[16];
#pragma unroll
        for (int k = 0; k < 16; ++k) { const unsigned pc = ck[k] & 255u; const unsigned i1 = sc[(pc >> 4) * 64 + lane], i2 = sc[(16 + (pc & 15u)) * 64 + lane]; ee[k] = i1 * 128u + i2; ev[k] *= inv; }
#if ROUTE_SORT
        { const int tq = r32 >> 3;
#pragma unroll
          for (int k = 0; k < 8; ++k) {
              const unsigned eL = ee[k], eH = ee[k + 8]; const float gL = ev[k], gH = ev[k + 8];
              sc[tq * 256 + head * 16 + hi * 8 + k] = hi ? eH : eL; sc[tq * 256 + 128 + head * 16 + hi * 8 + k] = __float_as_uint(hi ? gH : gL); }
#pragma unroll 1
          for (int t = 0; t < 4; ++t) {
              unsigned a0 = (sc[t * 256 + lane] << 7) | (unsigned)lane, a1 = (sc[t * 256 + 64 + lane] << 7) | (unsigned)(64 + lane);
              sort128_asc(a0, a1, lane);
              const unsigned g0 = sc[t * 256 + 128 + (a0 & 127u)], g1 = sc[t * 256 + 128 + (a1 & 127u)];
              u32x2* outp = (u32x2*)(ROUTE + (size_t)(item * 4 + t) * 256);
              outp[lane] = (u32x2){a0 >> 7, g0}; outp[64 + lane] = (u32x2){a1 >> 7, g1}; }
        }
#else
        u32x4* outp = (u32x4*)(ROUTE + ((size_t)tok * 128 + head * 16 + hi * 8) * 2);
#pragma unroll
        for (int k = 0; k < 8; k += 2) { u32x4 w;
            const unsigned eL0 = ee[k], eH0 = ee[k + 8], eL1 = ee[k + 1], eH1 = ee[k + 9]; const float gL0 = ev[k], gH0 = ev[k + 8], gL1 = ev[k + 1], gH1 = ev[k + 9];
            w.x = hi ? eH0 : eL0; w.y = __float_as_uint(hi ? gH0 : gL0); w.z = hi ? eH1 : eL1; w.w = __float_as_uint(hi ? gH1 : gL1);
            outp[k >> 1] = w; }
#endif
    }
}

typedef float f32x2 __attribute__((ext_vector_type(2)));
typedef float f32x32 __attribute__((ext_vector_type(32)));
typedef unsigned u32x6 __attribute__((ext_vector_type(6)));
typedef __bf16 bf16x32 __attribute__((ext_vector_type(32)));
typedef unsigned u32x16 __attribute__((ext_vector_type(16)));
typedef __bf16 bf16x2_t __attribute__((ext_vector_type(2)));
#ifndef GATHER_ZIGZAG
#define GATHER_ZIGZAG 0
#endif
#ifndef GATHER_PRE
#define GATHER_PRE 0
#endif
#ifndef GATHER_XEARLY
#define GATHER_XEARLY 0
#endif
#ifndef GATHER_SWP
#define GATHER_SWP 0
#endif
#ifndef GATHER_VECREG
#define GATHER_VECREG 1
#endif
#ifndef GATHER_MFMADOT
#define GATHER_MFMADOT 1
#endif
typedef short s16x4_t __attribute__((ext_vector_type(4)));
#ifndef GATHER_PAIRRED
#define GATHER_PAIRRED 1
#endif
#ifndef GATHER_EARLY
#define GATHER_EARLY 1
#endif
#ifndef GATHER_PACE
#define GATHER_PACE 0
#endif
#define XB_PACE(j) (XCD_BAR_WORDS + 64 * (j))
#ifndef GATHER_DEEP
#define GATHER_DEEP 0
#endif
constexpr int GS = GATHER_DEEP ? 8 : 6, GSLOT = GATHER_DEEP ? 2048 : 2 * PROW;
__device__ __forceinline__ void glds16(const void* gsrc, unsigned lds_dst) { unsigned keep;
  asm volatile("s_mov_b32 %0, m0\n\ts_mov_b32 m0, %2\n\ts_nop 0\n\tglobal_load_lds_dwordx4 %1, off\n\ts_mov_b32 m0, %0" : "=&s"(keep) : "v"(gsrc), "s"(lds_dst) : "memory"); }
template <int GMODE = 0>
__device__ __forceinline__ void gather_phase(CP P, int L, int Mrows, LAS unsigned char* lds, int wid, int lane_, int gw, int NGW, bool dry = false) {
    const unsigned char* UV = P->ws + WS_PU + (size_t)L * 16384 * PREC;
    const unsigned* ROUTE = (const unsigned*)(P->ws + WS_ROUTE); const float* MOD = (const float*)(P->ws + WS_MOD);
    bf16* X = (bf16*)(P->ws + WS_X); bf16* H = (bf16*)(P->ws + WS_H); bf16* Xo = dry ? (bf16*)(P->ws + WS_Y) : X; bf16* Ho = dry ? (bf16*)(P->ws + WS_G) : H;
    const float* lng = P->in[6] + (size_t)(L * 2 + 1) * DM; const float* lnb = P->in[7] + (size_t)(L * 2 + 1) * DM;
    const unsigned ring = (unsigned)(uintptr_t)lds + (unsigned)wid * (GS * GSLOT);
    const int nfull = (Mrows / NGW) * NGW, rem = Mrows - nfull; const bool can_coop = (rem * 4 == NGW);
    const int nround = nfull / NGW + (rem > 0 ? 1 : 0);
    const bool pace_ok = (rem == 0) || can_coop;
#define G_ROWOF(it_) ((can_coop && (it_) == nround - 1) ? (nfull + (int)blockIdx.x * 2 + (wid >> 2)) : (gw + (it_) * NGW))
    u32x2 nea = {0u, 0u}, neb = {0u, 0u}; u32x4 nh0 = {0u, 0u, 0u, 0u}, nh1 = nh0, nh2 = nh0, nh3 = nh0;
#define G_NTL(p_) (NT_STREAM > 1 ? __builtin_nontemporal_load(p_) : *(p_))
#define G_PREFETCH(rowN_, ln_) do { const int rn_ = (rowN_); nea = G_NTL(&((const u32x2*)(ROUTE + (size_t)rn_ * 256))[ln_]); neb = G_NTL(&((const u32x2*)(ROUTE + (size_t)rn_ * 256))[64 + (ln_)]); \
        const u32x4* hp_ = (const u32x4*)(H + (size_t)rn_ * DM) + 4 * (ln_); nh0 = G_NTL(hp_); nh1 = G_NTL(hp_ + 1); nh2 = G_NTL(hp_ + 2); nh3 = G_NTL(hp_ + 3); } while (0)
    if (nround > 0 && G_ROWOF(0) < Mrows) G_PREFETCH(G_ROWOF(0), launder_v(lane_));
#if GATHER_VECREG
    LAS unsigned* LNV = (LAS unsigned*)(lds + NWAVES * GS * GSLOT);
    { f32x2 t_[4];
#pragma unroll
      for (int t = 0; t < 4; ++t) { const int i = wid * 64 + lane_ + t * NWAVES * 64; t_[t] = *(const f32x2*)(((i >> 10) ? lnb : lng) + 2 * (i & 1023)); }
#pragma unroll
      for (int t = 0; t < 4; ++t) { const float x0_ = t_[t][0], x1_ = t_[t][1]; LNV[wid * 64 + lane_ + t * NWAVES * 64] = cvtpk(x0_, x1_); } }
    __syncthreads();
    unsigned mg[16], ms[16], mc[16]; int cur_slot = -1;
#pragma unroll
    for (int i = 0; i < 16; ++i) { mg[i] = 0u; ms[i] = 0u; mc[i] = 0u; }
#endif
    bool pre = false;
#pragma unroll 1
    for (int it = 0; it < nround; ++it) {
#if GATHER_PACE
        if (pace_ok && it > 0) {
            if (wid == 0 && lane_ == 0) { const unsigned nloc = ((volatile LAS unsigned*)(lds + MISC_OFF))[8];
                if (nloc != 0u) { unsigned* pc = (unsigned*)(P->ws + WS_CTL) + CW_BAR + XB_PACE(xb_xcc_id());
                    const unsigned old = xb_add(pc, 1u), tgt = (old / nloc + 1u) * nloc; unsigned sp = 0u;
                    while ((int)(xb_ld(pc) - tgt) < 0 && ++sp < 20000u) __builtin_amdgcn_s_sleep(1); } }
            __syncthreads();
        }
#endif
        const bool coop = can_coop && (it == nround - 1);
        int row = G_ROWOF(it), k0 = 0, kn = 128;
        if (coop) { k0 = (wid & 3) * 32; kn = k0 + 32; }
        else if (row >= Mrows) break;
        const int lane = launder_v(lane_);
        const u32x2 ea = nea, eb = neb;
        unsigned eax, eay, ebx, eby;
        unsigned hw[16] = {nh0.x, nh0.y, nh0.z, nh0.w, nh1.x, nh1.y, nh1.z, nh1.w, nh2.x, nh2.y, nh2.z, nh2.w, nh3.x, nh3.y, nh3.z, nh3.w};
        float y[32];
#pragma unroll
        for (int i = 0; i < 32; ++i) y[i] = 0.f;
        { unsigned e0 = ea.x, e1 = ea.y, e2 = eb.x, e3 = eb.y;
          asm volatile("" : "+v"(e0), "+v"(e1), "+v"(e2), "+v"(e3), "+v"(hw[0]), "+v"(hw[1]), "+v"(hw[2]), "+v"(hw[3]), "+v"(hw[4]), "+v"(hw[5]), "+v"(hw[6]), "+v"(hw[7]),
                       "+v"(hw[8]), "+v"(hw[9]), "+v"(hw[10]), "+v"(hw[11]), "+v"(hw[12]), "+v"(hw[13]), "+v"(hw[14]), "+v"(hw[15]) :: "memory");
          eax = e0; eay = e1; ebx = e2; eby = e3; }
        const unsigned rd_a = ring + 16u * (unsigned)lane, rd_b = ring + 2048u + 8u * (unsigned)lane;
        const bool rev = GATHER_ZIGZAG && ((it & 1) != 0);
        const int kflip = rev ? (k0 + kn - 1) : 0, ksign = rev ? -1 : 1;
#define G_ISSUE(k) do { const int k_ = (k), ke_ = kflip + ksign * k_; const unsigned e_ = (unsigned)__builtin_amdgcn_readlane((int)(ke_ < 64 ? eax : ebx), ke_ & 63); \
        const unsigned char* rp_ = UV + (size_t)e_ * PREC + 16 * lane; const unsigned sb_ = ring + (unsigned)(k_ % GS) * GSLOT; \
        if (GMODE == 3) { glds16(rp_, sb_); if (lane < 32) glds16(rp_ + 2048, sb_ + 2048); } \
        else if (GMODE != 2) { glds16(rp_, sb_); glds16(rp_ + 1024, sb_ + 1024); if (PEER_U4) {} else if (PEER_V4) { if (lane < 32) glds16(rp_ + 2048, sb_ + 2048); } else glds16(rp_ + 2048, sb_ + 2048); } else { asm volatile("" :: "v"(rp_), "s"(sb_)); } } while (0)
#if GATHER_EARLY
        if (it + 1 < nround && G_ROWOF(it + 1) < Mrows) G_PREFETCH(G_ROWOF(it + 1), lane);
        if (!pre) {
#pragma unroll
            for (int k = 0; k < GS; ++k) G_ISSUE(k0 + k); }
#else
#pragma unroll
        for (int k = 0; k < 4; ++k) G_ISSUE(k0 + k);
        if (it + 1 < nround && G_ROWOF(it + 1) < Mrows) G_PREFETCH(G_ROWOF(it + 1), lane);
#endif
#define G_READ(k, ua, ub, va, vb) do { const unsigned so_ = (unsigned)((k) % GS) * GSLOT; \
        if (PEER_U4) asm volatile("ds_read_b128 %0, %2\n\tds_read_b128 %1, %2 offset:1024" : "=&v"(ua), "=&v"(va) : "v"(rd_a + so_) : "memory"); \
        else if (PEER_V4) asm volatile("ds_read_b128 %0, %3\n\tds_read_b64 %1, %4\n\tds_read_b128 %2, %3 offset:1024" \
                     : "=&v"(ua), "=&v"(ub), "=&v"(va) : "v"(rd_a + so_), "v"(rd_b + so_) : "memory"); \
        else asm volatile("ds_read_b128 %0, %4\n\tds_read_b64 %1, %5\n\tds_read_b128 %2, %4 offset:1024\n\tds_read_b64 %3, %5 offset:512" \
                     : "=&v"(ua), "=&v"(ub), "=&v"(va), "=&v"(vb) : "v"(rd_a + so_), "v"(rd_b + so_) : "memory"); } while (0)
#if GATHER_XEARLY
        u32x4 xr0 = {0u, 0u, 0u, 0u}, xr1 = xr0, xr2 = xr0, xr3 = xr0;
#endif
#if GATHER_SWP
        static_assert(!GATHER_SWP || (PEER_U4 && PEER_V4 && GATHER_EARLY && GATHER_PAIRRED && GATHER_MFMADOT && !GATHER_DEEP && !GATHER_XEARLY && !GATHER_PRE), "GATHER_SWP: configuration");
#define SWP_FETCH(kk, uA, uB, vA, vB) do { const int kk_ = (kk); \
            if (kk_ + 4 < kn) asm volatile("s_waitcnt vmcnt(8)" ::: "memory"); else if (kk_ == kn - 4) asm volatile("s_waitcnt vmcnt(4)" ::: "memory"); else asm volatile("s_waitcnt vmcnt(0)" ::: "memory"); \
            u32x2 d0_ = {0u, 0u}, d1_ = {0u, 0u}; G_READ(kk_, uA, d0_, vA, d1_); G_READ(kk_ + 1, uB, d0_, vB, d1_); \
            asm volatile("s_waitcnt lgkmcnt(0)" : "+v"(uA), "+v"(vA), "+v"(uB), "+v"(vB) :: "memory"); \
            if (kk_ + GS < kn) { G_ISSUE(kk_ + GS); G_ISSUE(kk_ + GS + 1); } } while (0)
#define SWP_U4(dst_, src_, w_, b_) dst_[4 * (w_) + (b_)] = __builtin_bit_cast(unsigned, __builtin_amdgcn_cvt_scalef32_pk_bf16_fp4(src_[w_], 1.0f, b_))
#define SWP_UPART(kk, uA, uB, wA_, wB_) do { const int kk_ = (kk); u32x16 ubfA, ubfB; const unsigned uwA[4] = {uA.x, uA.y, uA.z, uA.w}, uwB[4] = {uB.x, uB.y, uB.z, uB.w}; \
            _Pragma("unroll") for (int w = 0; w < 4; ++w) { SWP_U4(ubfA, uwA, w, 0); SWP_U4(ubfA, uwA, w, 1); SWP_U4(ubfA, uwA, w, 2); SWP_U4(ubfA, uwA, w, 3); SWP_U4(ubfB, uwB, w, 0); SWP_U4(ubfB, uwB, w, 1); SWP_U4(ubfB, uwB, w, 2); SWP_U4(ubfB, uwB, w, 3); } \
            f32x4 dgA = {0.f, 0.f, 0.f, 0.f}, dgB = {0.f, 0.f, 0.f, 0.f}; \
            _Pragma("unroll") for (int q = 0; q < 16; q += 2) { const u32x2 hq_ = {hw[q], hw[q + 1]}, xa_ = {ubfA[q], ubfA[q + 1]}, xb_ = {ubfB[q], ubfB[q + 1]}; \
                dgA = __builtin_amdgcn_mfma_f32_4x4x4bf16_1k(__builtin_bit_cast(s16x4_t, xa_), __builtin_bit_cast(s16x4_t, hq_), dgA, 0, 0, 0); \
                dgB = __builtin_amdgcn_mfma_f32_4x4x4bf16_1k(__builtin_bit_cast(s16x4_t, xb_), __builtin_bit_cast(s16x4_t, hq_), dgB, 0, 0, 0); } \
            const float x0 = dgA[0], x1 = dgA[1], x2 = dgA[2], x3 = dgA[3], y0 = dgB[0], y1 = dgB[1], y2 = dgB[2], y3 = dgB[3]; \
            float a0 = DPP_F(x0, 0x00); a0 += DPP_F(x1, 0x55); a0 += DPP_F(x2, 0xAA); a0 += DPP_F(x3, 0xFF); \
            float b0 = DPP_F(y0, 0x00); b0 += DPP_F(y1, 0x55); b0 += DPP_F(y2, 0xAA); b0 += DPP_F(y3, 0xFF); \
            const auto sw = __builtin_amdgcn_permlane32_swap(__float_as_uint(a0), __float_as_uint(b0), false, false); \
            float c2 = __uint_as_float(sw[0]) + __uint_as_float(sw[1]); c2 += DPP_F(c2, 0x141); c2 += DPP_F(c2, 0x140); \
            const float d2 = sum_xor16(c2) * (1.0f / U_SCALE); const float g2 = gelu_tanh(d2) * (1.0f / V_SCALE); \
            const float gA = __uint_as_float((unsigned)__builtin_amdgcn_readlane((int)__float_as_uint(g2), 0)), gB = __uint_as_float((unsigned)__builtin_amdgcn_readlane((int)__float_as_uint(g2), 32)); \
            const int keA = kflip + ksign * kk_, keB = keA + ksign; const unsigned gsel = keA < 64 ? eay : eby; \
            wA_ = __uint_as_float((unsigned)__builtin_amdgcn_readlane((int)gsel, keA & 63)) * gA; wB_ = __uint_as_float((unsigned)__builtin_amdgcn_readlane((int)gsel, keB & 63)) * gB; } while (0)
#define SWP_V4(vwA, vwB, w_, b_, wA_, wB_) do { const f32x2 pA = __builtin_amdgcn_cvt_scalef32_pk_f32_fp4(vwA[w_], 1.0f, b_), pB = __builtin_amdgcn_cvt_scalef32_pk_f32_fp4(vwB[w_], 1.0f, b_); const int j = 4 * (w_) + (b_); \
            const float pa0 = pA[0], pa1 = pA[1], pb0 = pB[0], pb1 = pB[1]; y[2 * j] += wA_ * pa0; y[2 * j + 1] += wA_ * pa1; y[2 * j] += wB_ * pb0; y[2 * j + 1] += wB_ * pb1; } while (0)
#define SWP_VPART(vA, vB, wA_, wB_) do { const unsigned vwA[4] = {vA.x, vA.y, vA.z, vA.w}, vwB[4] = {vB.x, vB.y, vB.z, vB.w}; \
            _Pragma("unroll") for (int w = 0; w < 4; ++w) { SWP_V4(vwA, vwB, w, 0, wA_, wB_); SWP_V4(vwA, vwB, w, 1, wA_, wB_); SWP_V4(vwA, vwB, w, 2, wA_, wB_); SWP_V4(vwA, vwB, w, 3, wA_, wB_); } } while (0)
#define SWP_VCH(w_, qA_, qB_) do { SWP_V4(vwA, vwB, w_, 0, qA_, qB_); SWP_V4(vwA, vwB, w_, 1, qA_, qB_); SWP_V4(vwA, vwB, w_, 2, qA_, qB_); SWP_V4(vwA, vwB, w_, 3, qA_, qB_); } while (0)
#define SWP_MIX(kk, uA, uB, wA_, wB_, pvA, pvB, pwA_, pwB_) do { const int kk_ = (kk); u32x16 ubfA, ubfB; const unsigned uwA[4] = {uA.x, uA.y, uA.z, uA.w}, uwB[4] = {uB.x, uB.y, uB.z, uB.w}; \
            const unsigned vwA[4] = {pvA.x, pvA.y, pvA.z, pvA.w}, vwB[4] = {pvB.x, pvB.y, pvB.z, pvB.w}; \
            _Pragma("unroll") for (int w = 0; w < 4; ++w) { SWP_U4(ubfA, uwA, w, 0); SWP_U4(ubfA, uwA, w, 1); SWP_U4(ubfA, uwA, w, 2); SWP_U4(ubfA, uwA, w, 3); SWP_U4(ubfB, uwB, w, 0); SWP_U4(ubfB, uwB, w, 1); SWP_U4(ubfB, uwB, w, 2); SWP_U4(ubfB, uwB, w, 3); } \
            f32x4 dgA = {0.f, 0.f, 0.f, 0.f}, dgB = {0.f, 0.f, 0.f, 0.f}; \
            _Pragma("unroll") for (int q = 0; q < 16; q += 2) { const u32x2 hq_ = {hw[q], hw[q + 1]}, xa_ = {ubfA[q], ubfA[q + 1]}, xb_ = {ubfB[q], ubfB[q + 1]}; \
                dgA = __builtin_amdgcn_mfma_f32_4x4x4bf16_1k(__builtin_bit_cast(s16x4_t, xa_), __builtin_bit_cast(s16x4_t, hq_), dgA, 0, 0, 0); \
                dgB = __builtin_amdgcn_mfma_f32_4x4x4bf16_1k(__builtin_bit_cast(s16x4_t, xb_), __builtin_bit_cast(s16x4_t, hq_), dgB, 0, 0, 0); } \
            SWP_VCH(0, pwA_, pwB_); \
            const float x0 = dgA[0], x1 = dgA[1], x2 = dgA[2], x3 = dgA[3], y0 = dgB[0], y1 = dgB[1], y2 = dgB[2], y3 = dgB[3]; \
            float a0 = DPP_F(x0, 0x00); a0 += DPP_F(x1, 0x55); a0 += DPP_F(x2, 0xAA); a0 += DPP_F(x3, 0xFF); \
            float b0 = DPP_F(y0, 0x00); b0 += DPP_F(y1, 0x55); b0 += DPP_F(y2, 0xAA); b0 += DPP_F(y3, 0xFF); \
            SWP_VCH(1, pwA_, pwB_); \
            const auto sw = __builtin_amdgcn_permlane32_swap(__float_as_uint(a0), __float_as_uint(b0), false, false); \
            float c2 = __uint_as_float(sw[0]) + __uint_as_float(sw[1]); c2 += DPP_F(c2, 0x141); c2 += DPP_F(c2, 0x140); \
            float d2 = sum_xor16(c2) * (1.0f / U_SCALE); \
            SWP_VCH(2, pwA_, pwB_); \
            float g2 = gelu_tanh(d2) * (1.0f / V_SCALE); \
            SWP_VCH(3, pwA_, pwB_); \
            const float gA = __uint_as_float((unsigned)__builtin_amdgcn_readlane((int)__float_as_uint(g2), 0)), gB = __uint_as_float((unsigned)__builtin_amdgcn_readlane((int)__float_as_uint(g2), 32)); \
            const int keA = kflip + ksign * kk_, keB = keA + ksign; const unsigned gsel = keA < 64 ? eay : eby; \
            wA_ = __uint_as_float((unsigned)__builtin_amdgcn_readlane((int)gsel, keA & 63)) * gA; wB_ = __uint_as_float((unsigned)__builtin_amdgcn_readlane((int)gsel, keB & 63)) * gB; } while (0)
        if (GMODE == 0) {
            u32x4 cuA, cuB, cvA, cvB; float cwA, cwB;
            SWP_FETCH(k0, cuA, cuB, cvA, cvB); SWP_UPART(k0, cuA, cuB, cwA, cwB);
#pragma unroll 1
            for (int k = k0; k + 2 < kn; k += 2) {
                u32x4 nuA, nuB, nvA, nvB; float nwA, nwB;
                SWP_FETCH(k + 2, nuA, nuB, nvA, nvB);
                SWP_MIX(k + 2, nuA, nuB, nwA, nwB, cvA, cvB, cwA, cwB);
                cvA = nvA; cvB = nvB; cwA = nwA; cwB = nwB;
            }
            SWP_VPART(cvA, cvB, cwA, cwB);
        } else
#undef SWP_MIX
#undef SWP_VCH
#undef SWP_FETCH
#undef SWP_U4
#undef SWP_UPART
#undef SWP_V4
#undef SWP_VPART
#endif
#pragma unroll 1
        for (int k = k0; k < kn; k += 2) {
            if (GATHER_DEEP && k + 6 < kn) asm volatile("s_waitcnt vmcnt(12)" ::: "memory");
            else if (GATHER_DEEP && k == kn - 6) asm volatile("s_waitcnt vmcnt(8)" ::: "memory");
            else if (k + 4 < kn) { if (!GATHER_EARLY) { G_ISSUE(k + 4); G_ISSUE(k + 5); } if (GMODE == 3 || PEER_U4) asm volatile("s_waitcnt vmcnt(8)" ::: "memory"); else asm volatile("s_waitcnt vmcnt(12)" ::: "memory"); }
            else if (k == kn - 4) { if (GMODE == 3 || PEER_U4) asm volatile("s_waitcnt vmcnt(4)" ::: "memory"); else asm volatile("s_waitcnt vmcnt(6)" ::: "memory"); }
            else asm volatile("s_waitcnt vmcnt(0)" ::: "memory");
            u32x4 uaA, vaA, uaB, vaB; u32x2 ubA = {0u, 0u}, vbA = {0u, 0u}, ubB = {0u, 0u}, vbB = {0u, 0u};
            G_READ(k, uaA, ubA, vaA, vbA); G_READ(k + 1, uaB, ubB, vaB, vbB);
            asm volatile("s_waitcnt lgkmcnt(0)" : "+v"(uaA), "+v"(ubA), "+v"(vaA), "+v"(vbA), "+v"(uaB), "+v"(ubB), "+v"(vaB), "+v"(vbB) :: "memory");
#if GATHER_XEARLY
            if (k == kn - 4) { const u32x4* xp_ = (const u32x4*)(X + (size_t)row * DM) + 4 * lane; xr0 = xp_[0]; xr1 = xp_[1]; xr2 = xp_[2]; xr3 = xp_[3]; }
#endif
            if (GATHER_EARLY && k + GS < kn) { G_ISSUE(k + GS); G_ISSUE(k + GS + 1); }
            if (GMODE == 1 || GMODE == 3) continue;
#if PEER_U4
            u32x16 ubfA, ubfB;
            { const unsigned uwA[4] = {uaA.x, uaA.y, uaA.z, uaA.w}, uwB[4] = {uaB.x, uaB.y, uaB.z, uaB.w};
#pragma unroll
              for (int w = 0; w < 4; ++w) {
#define U4_CVT(b_) do { ubfA[4 * w + (b_)] = __builtin_bit_cast(unsigned, __builtin_amdgcn_cvt_scalef32_pk_bf16_fp4(uwA[w], 1.0f, b_)); ubfB[4 * w + (b_)] = __builtin_bit_cast(unsigned, __builtin_amdgcn_cvt_scalef32_pk_bf16_fp4(uwB[w], 1.0f, b_)); } while (0)
                  U4_CVT(0); U4_CVT(1); U4_CVT(2); U4_CVT(3);
#undef U4_CVT
              } }
#else
            const u32x6 u6A = {uaA.x, uaA.y, uaA.z, uaA.w, ubA.x, ubA.y}, u6B = {uaB.x, uaB.y, uaB.z, uaB.w, ubB.x, ubB.y};
            const u32x16 ubfA = __builtin_bit_cast(u32x16, __builtin_amdgcn_cvt_scalef32_pk32_bf16_fp6(u6A, 1.0f));
            const u32x16 ubfB = __builtin_bit_cast(u32x16, __builtin_amdgcn_cvt_scalef32_pk32_bf16_fp6(u6B, 1.0f));
#endif
#if GATHER_MFMADOT
            f32x4 dgA = {0.f, 0.f, 0.f, 0.f}, dgB = {0.f, 0.f, 0.f, 0.f};
#pragma unroll
            for (int q = 0; q < 16; q += 2) { const u32x2 hq_ = {hw[q], hw[q + 1]}, xa_ = {ubfA[q], ubfA[q + 1]}, xb_ = {ubfB[q], ubfB[q + 1]};
                dgA = __builtin_amdgcn_mfma_f32_4x4x4bf16_1k(__builtin_bit_cast(s16x4_t, xa_), __builtin_bit_cast(s16x4_t, hq_), dgA, 0, 0, 0);
                dgB = __builtin_amdgcn_mfma_f32_4x4x4bf16_1k(__builtin_bit_cast(s16x4_t, xb_), __builtin_bit_cast(s16x4_t, hq_), dgB, 0, 0, 0); }
            float a0, a1 = 0.f, b0, b1 = 0.f;
            { const float x0 = dgA[0], x1 = dgA[1], x2 = dgA[2], x3 = dgA[3], y0 = dgB[0], y1 = dgB[1], y2 = dgB[2], y3 = dgB[3];
              a0 = DPP_F(x0, 0x00); a0 += DPP_F(x1, 0x55); a0 += DPP_F(x2, 0xAA); a0 += DPP_F(x3, 0xFF);
              b0 = DPP_F(y0, 0x00); b0 += DPP_F(y1, 0x55); b0 += DPP_F(y2, 0xAA); b0 += DPP_F(y3, 0xFF); }
#else
            float a0 = 0.f, a1 = 0.f, b0 = 0.f, b1 = 0.f;
#pragma unroll
            for (int q = 0; q < 16; q += 2) { const unsigned h0_ = hw[q], h1_ = hw[q + 1], x0_ = ubfA[q], x1_ = ubfA[q + 1], z0_ = ubfB[q], z1_ = ubfB[q + 1];
                a0 = __builtin_amdgcn_fdot2_f32_bf16(__builtin_bit_cast(bf16x2_t, h0_), __builtin_bit_cast(bf16x2_t, x0_), a0, false);
                a1 = __builtin_amdgcn_fdot2_f32_bf16(__builtin_bit_cast(bf16x2_t, h1_), __builtin_bit_cast(bf16x2_t, x1_), a1, false);
                b0 = __builtin_amdgcn_fdot2_f32_bf16(__builtin_bit_cast(bf16x2_t, h0_), __builtin_bit_cast(bf16x2_t, z0_), b0, false);
                b1 = __builtin_amdgcn_fdot2_f32_bf16(__builtin_bit_cast(bf16x2_t, h1_), __builtin_bit_cast(bf16x2_t, z1_), b1, false); }
#endif
            const int keA = kflip + ksign * k, keB = keA + ksign;
            const unsigned gsel = keA < 64 ? eay : eby;
#if GATHER_PAIRRED
            float wA, wB;
            { const auto sw = __builtin_amdgcn_permlane32_swap(__float_as_uint(GATHER_MFMADOT ? a0 : a0 + a1), __float_as_uint(GATHER_MFMADOT ? b0 : b0 + b1), false, false);
#if GATHER_MFMADOT
              float c2 = __uint_as_float(sw[0]) + __uint_as_float(sw[1]); c2 += DPP_F(c2, 0x141); c2 += DPP_F(c2, 0x140);
              const float d2 = sum_xor16(c2) * (1.0f / U_SCALE);
#else
              const float d2 = half_sum32(__uint_as_float(sw[0]) + __uint_as_float(sw[1])) * (1.0f / U_SCALE);
#endif
              const float g2 = gelu_tanh(d2) * (1.0f / V_SCALE);
              const float gA = __uint_as_float((unsigned)__builtin_amdgcn_readlane((int)__float_as_uint(g2), 0)), gB = __uint_as_float((unsigned)__builtin_amdgcn_readlane((int)__float_as_uint(g2), 32));
              wA = __uint_as_float((unsigned)__builtin_amdgcn_readlane((int)gsel, keA & 63)) * gA; wB = __uint_as_float((unsigned)__builtin_amdgcn_readlane((int)gsel, keB & 63)) * gB; }
#else
            const float dA = wave_sum(a0 + a1) * (1.0f / U_SCALE), dB = wave_sum(b0 + b1) * (1.0f / U_SCALE);
            const float wA = __uint_as_float((unsigned)__builtin_amdgcn_readlane((int)gsel, keA & 63)) * gelu_tanh(dA) * (1.0f / V_SCALE);
            const float wB = __uint_as_float((unsigned)__builtin_amdgcn_readlane((int)gsel, keB & 63)) * gelu_tanh(dB) * (1.0f / V_SCALE);
#endif
#if PEER_V4
            { const unsigned vwA[4] = {vaA.x, vaA.y, vaA.z, vaA.w}, vwB[4] = {vaB.x, vaB.y, vaB.z, vaB.w};
#pragma unroll
              for (int w = 0; w < 4; ++w) {
#define V4_ACC(b_) do { const f32x2 pA = __builtin_amdgcn_cvt_scalef32_pk_f32_fp4(vwA[w], 1.0f, b_), pB = __builtin_amdgcn_cvt_scalef32_pk_f32_fp4(vwB[w], 1.0f, b_); const int j = 4 * w + (b_); \
                    const float pa0 = pA[0], pa1 = pA[1], pb0 = pB[0], pb1 = pB[1]; y[2 * j] += wA * pa0; y[2 * j + 1] += wA * pa1; y[2 * j] += wB * pb0; y[2 * j + 1] += wB * pb1; } while (0)
                  V4_ACC(0); V4_ACC(1); V4_ACC(2); V4_ACC(3);
#undef V4_ACC
              } }
#else
            const u32x6 v6A = {vaA.x, vaA.y, vaA.z, vaA.w, vbA.x, vbA.y};
            const f32x32 vfA = __builtin_amdgcn_cvt_scalef32_pk32_f32_fp6(v6A, 1.0f);
#pragma unroll
            for (int i = 0; i < 32; ++i) y[i] += wA * vfA[i];
            const u32x6 v6B = {vaB.x, vaB.y, vaB.z, vaB.w, vbB.x, vbB.y};
            const f32x32 vfB = __builtin_amdgcn_cvt_scalef32_pk32_f32_fp6(v6B, 1.0f);
#pragma unroll
            for (int i = 0; i < 32; ++i) y[i] += wB * vfB[i];
#endif
        }
#if GATHER_PRE
        pre = (it + 1 < nround) && (G_ROWOF(it + 1) < Mrows);
        if (pre) { unsigned n0 = nea.x, n2 = neb.x; asm volatile("" : "+v"(n0), "+v"(n2) :: "memory"); eax = n0; ebx = n2;
            const int k0n = (can_coop && (it + 1 == nround - 1)) ? (wid & 3) * 32 : 0;
#pragma unroll
            for (int k = 0; k < 6; ++k) G_ISSUE(k0n + k); }
#endif
#undef G_READ
#undef G_ISSUE
        if (coop) {
            LAS f32x4* mine = (LAS f32x4*)(lds + wid * (GS * GSLOT)) + lane * 8;
#pragma unroll
            for (int i = 0; i < 8; ++i) mine[i] = (f32x4){y[4 * i], y[4 * i + 1], y[4 * i + 2], y[4 * i + 3]};
            __syncthreads();
            if ((wid & 3) == 0) {
#pragma unroll
                for (int j = 1; j < 4; ++j) { const LAS f32x4* oth = (const LAS f32x4*)(lds + (wid + j) * (GS * GSLOT)) + lane * 8;
#pragma unroll
                    for (int i = 0; i < 8; ++i) { const f32x4 t = oth[i]; y[4 * i] += t.x; y[4 * i + 1] += t.y; y[4 * i + 2] += t.z; y[4 * i + 3] += t.w; } }
            }
            __syncthreads();
            if ((wid & 3) != 0) continue;
        }
        const int slot = row_slot(row);
        const float* mod = MOD + (size_t)(L * 3 + slot) * 12288;
        const int le = launder_v(lane);
#if GATHER_VECREG
        if (slot != cur_slot) { cur_slot = slot; float t_[32];
            load_row_f32_b(mod + 5 * 2048, le, t_);
#pragma unroll
            for (int i = 0; i < 16; ++i) mg[i] = cvtpk(t_[2 * i], t_[2 * i + 1]);
            if (L < NLAYER - 1) { const float* modn = MOD + (size_t)((L + 1) * 3 + slot) * 12288;
                load_row_f32_b(modn, le, t_);
#pragma unroll
                for (int i = 0; i < 16; ++i) ms[i] = cvtpk(t_[2 * i], t_[2 * i + 1]);
                load_row_f32_b(modn + 2048, le, t_);
#pragma unroll
                for (int i = 0; i < 16; ++i) mc[i] = cvtpk(t_[2 * i], t_[2 * i + 1]); } }
        { float xx[32];
#if GATHER_XEARLY
          { const unsigned xw_[16] = {xr0.x, xr0.y, xr0.z, xr0.w, xr1.x, xr1.y, xr1.z, xr1.w, xr2.x, xr2.y, xr2.z, xr2.w, xr3.x, xr3.y, xr3.z, xr3.w};
#pragma unroll
            for (int i = 0; i < 16; ++i) { xx[2 * i] = bflo(xw_[i]); xx[2 * i + 1] = bfhi(xw_[i]); } }
#else
          { const u32x4* xp_ = (const u32x4*)(X + (size_t)row * DM) + 4 * le;
#pragma unroll
            for (int j = 0; j < 4; ++j) { const u32x4 w = G_NTL(xp_ + j); xx[8 * j + 0] = bflo(w.x); xx[8 * j + 1] = bfhi(w.x); xx[8 * j + 2] = bflo(w.y); xx[8 * j + 3] = bfhi(w.y);
                xx[8 * j + 4] = bflo(w.z); xx[8 * j + 5] = bfhi(w.z); xx[8 * j + 6] = bflo(w.w); xx[8 * j + 7] = bfhi(w.w); } }
#endif
#pragma unroll
          for (int i = 0; i < 16; ++i) { y[2 * i] = ALPHA * xx[2 * i] + bflo(mg[i]) * y[2 * i]; y[2 * i + 1] = ALPHA * xx[2 * i + 1] + bfhi(mg[i]) * y[2 * i + 1]; } }
        { float mean, rstd; ln_stats(y, mean, rstd);
          const LAS u32x4* gp = (const LAS u32x4*)(LNV + le * 16); const LAS u32x4* bp = (const LAS u32x4*)(LNV + 1024 + le * 16);
#pragma unroll
          for (int q = 0; q < 4; ++q) { const u32x4 g4 = gp[q], b4 = bp[q]; const unsigned gw_[4] = {g4.x, g4.y, g4.z, g4.w}, bw_[4] = {b4.x, b4.y, b4.z, b4.w};
#pragma unroll
              for (int j = 0; j < 4; ++j) { const int i = 8 * q + 2 * j; y[i] = (y[i] - mean) * rstd * bflo(gw_[j]) + bflo(bw_[j]); y[i + 1] = (y[i + 1] - mean) * rstd * bfhi(gw_[j]) + bfhi(bw_[j]); } }
          if (L < NLAYER - 1) { store_row_bf16_b(Xo + (size_t)row * DM, le, y);
              ln_stats(y, mean, rstd); float a_[32];
#pragma unroll
              for (int i = 0; i < 16; ++i) { a_[2 * i] = (y[2 * i] - mean) * rstd * (1.0f + bflo(mc[i])) + bflo(ms[i]); a_[2 * i + 1] = (y[2 * i + 1] - mean) * rstd * (1.0f + bfhi(mc[i])) + bfhi(ms[i]); }
              store_row_bf16_b(Ho + (size_t)row * DM, le, a_); }
          else { if (NT_STREAM > 1) store_row_f32_b_nt(P->out + (size_t)row * DM, le, y); else store_row_f32_b(P->out + (size_t)row * DM, le, y); } }
        asm volatile("s_waitcnt vmcnt(0)" ::: "memory");
        continue;
#endif
        { float xx[32], gg[32]; load_row_bf16_b(X + (size_t)row * DM, le, xx); load_row_f32_b(mod + 5 * 2048, le, gg);
#pragma unroll
          for (int i = 0; i < 32; ++i) y[i] = ALPHA * xx[i] + gg[i] * y[i]; }
        if (L < NLAYER - 1) { const float* modn = MOD + (size_t)((L + 1) * 3 + slot) * 12288;
            finish_row<true>(y, lng, lnb, Xo + (size_t)row * DM, modn, modn + 2048, Ho + (size_t)row * DM, nullptr, le); }
        else finish_row<true>(y, lng, lnb, nullptr, nullptr, nullptr, nullptr, P->out + (size_t)row * DM, le);
        asm volatile("s_waitcnt vmcnt(0)" ::: "memory");
    }
#undef G_PREFETCH
#undef G_ROWOF
}

#ifndef ROPE_TEST
#define ROPE_TEST 0
#endif
#ifndef TAIL_L3MOVE
#define TAIL_L3MOVE 1
#endif
#ifndef PROBE_DUP
#define PROBE_DUP 0
#endif
#define NOINL __forceinline__
__device__ __forceinline__ CP launder_cp(CP p) { asm volatile("" : "+s"(p)); return p; }
#define GETP() launder_cp((CP)__builtin_amdgcn_kernarg_segment_ptr())
__device__ __forceinline__ int uni(int v) { return __builtin_amdgcn_readfirstlane(v); }
__device__ __forceinline__ LAS unsigned char* uni_lds(LAS unsigned char* p) { return (LAS unsigned char*)(unsigned)__builtin_amdgcn_readfirstlane((int)(unsigned)(uintptr_t)p); }
#define PH_IDS const int wid = uni(wv_), lane = launder_v(lane_id_fresh()) & 63, tid = (wid & 7) * 64 + lane; const int gw = blockIdx.x * NWAVES + wid, NGW = gridDim.x * NWAVES; (void)lane; (void)gw; (void)NGW; (void)tid;

__device__ NOINL void ph_prologue(int wv_, LAS unsigned char* lds_) { CP P = GETP(); LAS unsigned char* lds = uni_lds(lds_); PH_IDS p0_prologue(P, lds, tid, lane, wid, gw, NGW); if (PROBE_DUP == 5) p0_prologue(P, lds, tid, lane, wid, gw, NGW);
    if (PROBE_DUP >= 21 && PROBE_DUP <= 23) { __syncthreads(); p0_prologue(P, lds, tid, lane, wid, gw, NGW, 1 << (PROBE_DUP - 21 < 0 ? 0 : (PROBE_DUP - 21) & 3)); } }
__device__ NOINL void ph_modreduce(int wv_) { CP P = GETP(); PH_IDS mod_reduce(P, gw, lane, NGW); }
__device__ NOINL void ph_first(int wv_, LAS unsigned char* lds_) { CP P = GETP(); LAS unsigned char* lds = uni_lds(lds_); PH_IDS
#pragma unroll 1
    for (int rep = 0; rep < (PROBE_DUP == 6 ? 2 : 1); ++rep) first_row_pass(P, lds, tid, lane, gw, NGW); }
__device__ NOINL void ph_postmix(int wv_, LAS unsigned char* lds_, int L_, int M_) { CP P = GETP(); LAS unsigned char* lds = uni_lds(lds_); const int L = uni(L_), Mrows = uni(M_); PH_IDS
    if (POSTMIX_LDS) post_mixer_pass_lds(P, L, Mrows, lds, tid, lane, gw, NGW); else post_mixer_pass(P, L, Mrows, lane, gw, NGW); }
__device__ NOINL void ph_vstats(int wv_, int M_) { CP P = GETP(); const int Mrows = uni(M_); PH_IDS
#pragma unroll 1
    for (int rep = 0; rep < (PROBE_DUP == 6 ? 2 : 1); ++rep) vstats_pass(P, Mrows, lane, gw, NGW); }
__device__ NOINL void ph_spatial(int wv_, LAS unsigned char* lds_, int j_, int M_) { CP P = GETP(); LAS unsigned char* lds = uni_lds(lds_); const int j = uni(j_), Mrows = uni(M_); PH_IDS
#pragma unroll 1
    for (int rep = 0; rep < ((PROBE_DUP == 6 || PROBE_DUP == 19) ? 2 : 1); ++rep) spatial_phase(P, j, Mrows, lds, tid, lane, wid); }
__device__ NOINL void ph_mla_norm(int wv_) { CP P = GETP(); PH_IDS
#pragma unroll 1
    for (int rep = 0; rep < (PROBE_DUP == 6 ? 2 : 1); ++rep) mla_norm_pass(P, lane, gw, NGW); }
__device__ NOINL void ph_rope(int wv_, int which_) { CP P = GETP(); const int which = uni(which_); PH_IDS
    if (which == 0) rope_pass((bf16*)(P->ws + WS_QM), 3072, 128, 16, 192, lane, gw, NGW);
    else rope_pass((bf16*)(P->ws + WS_Z), 6144, 0, 64, 64, lane, gw, NGW); }
__device__ NOINL void ph_attn_mla(int wv_, LAS unsigned char* lds_) { CP P = GETP(); LAS unsigned char* lds = uni_lds(lds_); PH_IDS mla_attn_phase(P, lds, tid); if (PROBE_DUP == 2 || PROBE_DUP == 9) mla_attn_phase(P, lds, tid); }
__device__ NOINL void ph_attn_da(int wv_, LAS unsigned char* lds_, int L_, bool ctx_q) { CP P = GETP(); LAS unsigned char* lds = uni_lds(lds_); const int L = uni(L_); PH_IDS
    const float* lp = P->in[26];
    const float s01 = wave_sum(lp[lane] * lp[64 + lane]), s23 = wave_sum(lp[128 + lane] * lp[192 + lane]);
    const float lam_init = 0.8f - 0.6f * expf(-0.3f * (float)L);
    const float lam = expf(s01) - expf(s23) + lam_init;
    if (PROBE_DUP == 24) { da_attn_phase(P, lam, 1.0f - lam_init, lds, tid, ctx_q, 4); __syncthreads(); }
    if (PROBE_DUP == 25) { da_attn_phase(P, lam, 1.0f - lam_init, lds, tid, ctx_q, 2); __syncthreads(); }
    if (PROBE_DUP == 26) { da_attn_phase(P, lam, 1.0f - lam_init, lds, tid, ctx_q, 12); __syncthreads(); }
    if (!(PROBE_DUP >= 11 && PROBE_DUP <= 15)) da_attn_phase(P, lam, 1.0f - lam_init, lds, tid, ctx_q);
    if (PROBE_DUP == 2 || PROBE_DUP == 10) da_attn_phase(P, lam, 1.0f - lam_init, lds, tid, ctx_q);
    if (PROBE_DUP >= 11 && PROBE_DUP <= 15) { da_attn_phase<PROBE_DUP >= 11 && PROBE_DUP <= 15 ? PROBE_DUP - 10 : 0>(P, lam, 1.0f - lam_init, lds, tid, ctx_q); __syncthreads(); }
    if (PROBE_DUP >= 11 && PROBE_DUP <= 15) da_attn_phase(P, lam, 1.0f - lam_init, lds, tid, ctx_q); }
__device__ NOINL void ph_route(int wv_, LAS unsigned char* lds_, int L_, int M_) { CP P = GETP(); LAS unsigned char* lds = uni_lds(lds_); const int L = uni(L_), Mrows = uni(M_); PH_IDS
#pragma unroll 1
    for (int rep = 0; rep < (PROBE_DUP == 4 ? 2 : 1); ++rep) route_phase(P, L, Mrows, lds, tid, lane, wid, gw, NGW); }
__device__ NOINL void ph_gather(int wv_, LAS unsigned char* lds_, int L_, int M_) { CP P = GETP(); LAS unsigned char* lds = uni_lds(lds_); const int L = uni(L_), Mrows = uni(M_); PH_IDS
    if (PROBE_DUP == 3) { gather_phase<0>(P, L, Mrows, lds, wid, lane, gw, NGW, true); }
    if (PROBE_DUP == 7) { gather_phase<1>(P, L, Mrows, lds, wid, lane, gw, NGW, true); }
    if (PROBE_DUP == 17) { gather_phase<3>(P, L, Mrows, lds, wid, lane, gw, NGW, true); }
    if (PROBE_DUP == 8) { gather_phase<2>(P, L, Mrows, lds, wid, lane, gw, NGW, true); }
    gather_phase<0>(P, L, Mrows, lds, wid, lane, gw, NGW); }

enum GemmId { G_GM_IN = 0, G_GM_OUT, G_MLA_IN, G_MLA_UQ, G_MLA_UKV, G_MLA_OUT, G_DA_IN, G_DA_OUT, G_PEER_Q };
__device__ NOINL void ph_gemm(int wv_, LAS unsigned char* lds_, int id_, int L_, int M_) {
    CP P = GETP(); LAS unsigned char* lds = uni_lds(lds_); const int id = uni(id_), L = uni(L_), Mrows = uni(M_); PH_IDS
    unsigned char* ws = P->ws; const int jj = L / 3;
    size_t a = WS_H, b = 0, o = 0; int M = MT, N = 2048, K = 2048, act = 0, rope = 0;
    switch (id) {
        case G_GM_IN:   a = WS_H;    b = WS_GMWIN + (size_t)jj * 4096 * 2048 * 2;  o = WS_Z;  M = Mrows; N = 4096; K = 2048; act = 1; break;
        case G_GM_OUT:  a = WS_G;    b = WS_GMWOUT + (size_t)jj * 2048 * 2048 * 2; o = WS_Y;  M = Mrows; N = 2048; K = 2048; break;
        case G_MLA_IN:  a = WS_H;    b = WS_MLAIN;  o = WS_C;  N = 1280; K = 2048; break;
        case G_MLA_UQ:  a = WS_CQN;  b = WS_MLAUQ;  o = WS_QM; N = 3072; K = 512;  rope = (ROPE_TEST == 2) ? 0 : 2; break;
        case G_MLA_UKV: a = WS_CKVN; b = WS_MLAUKV; o = WS_KV; N = 4096; K = 512;  break;
        case G_MLA_OUT: a = WS_G;    b = WS_MLAOUT; o = WS_Y;  N = 2048; K = 2048; break;
        case G_DA_IN:   a = WS_H;    b = WS_DAIN;   o = WS_Z;  N = 6144; K = 2048; rope = (ROPE_TEST == 1) ? 0 : 1; break;
        case G_DA_OUT:  a = WS_G;    b = WS_DAOUT;  o = WS_Y;  M = Mrows; N = 2048; K = 2048; break;
        default:        a = WS_H;    b = WS_PWQ + (size_t)L * 2048 * 2048 * 2;     o = WS_QP; M = Mrows; N = 2048; K = 2048; break;
    }
    pg8::Gemm g{(const pg8::bf16_t*)(ws + a), (const pg8::bf16_t*)(ws + b), M, N, K}; pg8::StaticOrder S; S.init(M, N, (int)gridDim.x, id == G_MLA_UKV ? (int)gridDim.x - 1 - (int)blockIdx.x : (int)blockIdx.x);
    pg8::EpiR E{(pg8::bf16_t*)(ws + o), N, act, rope, (const float*)(ws + WS_ROPE)};
#pragma unroll 1
    for (int rep = 0; rep < ((PROBE_DUP == 1 || (PROBE_DUP == 31 && id == G_MLA_OUT) || (PROBE_DUP == 32 && id == G_DA_OUT)) ? 2 : 1); ++rep) { pg8::gemm_phase<pg8::EpiR, pg8::StaticOrder, true, true>((PG8_LAS unsigned char*)lds, g, S, E, tid); __syncthreads(); }
#if TAIL_REMAP
    int TL = -1; bool tail_u = false;
    if (L == 0) { if (id == G_GM_IN) { TL = 0; tail_u = true; } else if (id == G_GM_OUT) { TL = 0; } else if (id == G_PEER_Q) { TL = 1; tail_u = true; } }
    else if (L == 1) { if (id == G_MLA_IN) { TL = 1; } else if (id == G_MLA_OUT) { TL = 2; tail_u = true; } else if (id == G_PEER_Q) { TL = 2; } }
    else if (L == 2) { if (id == G_DA_IN) { TL = 3; tail_u = true; } else if (id == G_DA_OUT) { TL = 3; } }
    if (TL >= 0) {
        const int units = (M / 256) * (N / 256), G = (int)gridDim.x, tail = units % G, c = (int)blockIdx.x;
        const float* src = (tail_u ? P->in[11] : P->in[12]) + (size_t)TL * 16384 * 2048; unsigned char* dst = ws + WS_PU + (size_t)TL * 16384 * PREC;
#else
#if TAIL_L3MOVE
    const bool l3u = (id == G_MLA_IN && L == 1), l3v = (id == G_DA_IN && L == 2), skip = (L == NLAYER - 2) && (id == G_DA_OUT || id == G_PEER_Q);
    const bool l0v = P0_NOV && (id == G_GM_IN && L == 0);
    const bool tail_u = !skip && ((id == G_GM_OUT || id == G_MLA_OUT || id == G_DA_OUT) || l3u), tail_v = !skip && ((id == G_PEER_Q) || l3v || l0v);
    const int TLx = (l3u || l3v) ? NLAYER - 1 : (l0v ? 0 : L + 1);
    if ((tail_u || tail_v) && TLx < NLAYER) {
        const int units = (M / 256) * (N / 256), G = (int)gridDim.x, tail = units % G, c = (int)blockIdx.x;
        const float* src = (tail_u ? P->in[11] : P->in[12]) + (size_t)TLx * 16384 * 2048; unsigned char* dst = ws + WS_PU + (size_t)TLx * 16384 * PREC;
#else
    const bool tail_u = (id == G_GM_OUT || id == G_MLA_OUT || id == G_DA_OUT), tail_v = (id == G_PEER_Q);
    if ((tail_u || tail_v) && L + 1 < NLAYER) {
        const int units = (M / 256) * (N / 256), G = (int)gridDim.x, tail = units % G, c = (int)blockIdx.x;
        const float* src = (tail_u ? P->in[11] : P->in[12]) + (size_t)(L + 1) * 16384 * 2048; unsigned char* dst = ws + WS_PU + (size_t)(L + 1) * 16384 * PREC;
#endif
#endif
        LAS float* scr = (LAS float*)(lds + wid * 16384);
        if (tail != 0 && c >= tail) cvt_table_fp6(src, dst, 16384, tail_u ? U_SCALE : V_SCALE, scr, lane, (c - tail) * NWAVES + wid, (G - tail) * NWAVES, tail_u ? 0 : 1);
        else if (tail == 0) {
#pragma unroll 1
            for (int rep = 0; rep < (PROBE_DUP == 18 ? 3 : 1); ++rep) cvt_table_fp6(src, dst, 16384, tail_u ? U_SCALE : V_SCALE, scr, lane, gw, NGW, tail_u ? 0 : 1); }
    }
}

__global__ void __launch_bounds__(NWAVES * 64, 2) mk_fwd(Params Pv) {
    extern __shared__ __attribute__((aligned(16))) unsigned char lds_g[];
    LAS unsigned char* lds = (LAS unsigned char*)lds_g;
    const int wv = __builtin_amdgcn_readfirstlane((int)threadIdx.x >> 6);
    const int tid = wv * 64 + lane_id_fresh();
    for (int u = tid; u < (LDS_BYTES - RING_BYTES) / 4; u += NWAVES * 64) ((LAS unsigned*)(lds + RING_BYTES))[u] = 0u;
    __syncthreads();
    const int lo = Pv.ph_lo, hi = Pv.ph_hi;
    unsigned* barw = (unsigned*)(Pv.ws + WS_CTL) + CW_BAR;
    XcdBarrier bar; bar.bar = barw; bar.x = 0; bar.st = nullptr;
    if (hi - lo > 1) bar = xcd_barrier_post(barw, (volatile LAS unsigned*)(lds + MISC_OFF) + 8, tid == 0);
    int ph = 0;
#ifndef SEL
#define SELP(k) true
#else
#define SELP(k) ((k) == SEL)
#endif
    enum { RUN_BASE = __COUNTER__ + 1 };
#define RUN(call) do { if (SELP(__COUNTER__ - RUN_BASE) && ph >= lo && ph < hi) { call; } if (ph >= lo && ph + 1 < hi) { xcd_barrier(bar, wv == 0 && lane_id_fresh() == 0); if (PROBE_DUP == 30) { xcd_barrier(bar, wv == 0 && lane_id_fresh() == 0); xcd_barrier(bar, wv == 0 && lane_id_fresh() == 0); } } ++ph; } while (0)
    RUN(ph_prologue(wv, lds));
    RUN(ph_modreduce(wv));
    RUN(ph_first(wv, lds));
#define LAYER(LL) do { constexpr int L = (LL); constexpr int kind = L % 3, jj = L / 3; constexpr int Mrows = (L == NLAYER - 1) ? ML : MT; \
        constexpr bool ctx_dead = (L == NLAYER - 2) && ((NLAYER - 1) % 3 == 0) && (kind != 0); constexpr int Mlive = ctx_dead ? ML : Mrows; \
        if (kind == 0) {                          \
            RUN(ph_gemm(wv, lds, G_GM_IN, L, Mrows)); \
            RUN(ph_vstats(wv, Mrows)); \
            RUN(ph_spatial(wv, lds, jj, Mrows)); \
            RUN(ph_gemm(wv, lds, G_GM_OUT, L, Mrows)); \
        } else if (kind == 1) {                   \
            RUN(ph_gemm(wv, lds, G_MLA_IN, L, Mrows)); \
            RUN(ph_mla_norm(wv)); \
            RUN(ph_gemm(wv, lds, G_MLA_UQ, L, Mrows); ph_gemm(wv, lds, G_MLA_UKV, L, Mrows)); \
            if (ROPE_TEST == 2) { RUN(ph_rope(wv, 0)); } \
            RUN(ph_attn_mla(wv, lds)); \
            RUN(ph_gemm(wv, lds, G_MLA_OUT, L, Mrows)); \
        } else {                                  \
            RUN(ph_gemm(wv, lds, G_DA_IN, L, Mrows); if (ROPE_TEST == 1) { __syncthreads(); } ); \
            if (ROPE_TEST == 1) { RUN(ph_rope(wv, 1)); } \
            RUN(ph_attn_da(wv, lds, L, !ctx_dead)); \
            RUN(ph_gemm(wv, lds, G_DA_OUT, L, Mlive)); \
        } \
        RUN(ph_postmix(wv, lds, L, Mlive));                \
        RUN(ph_gemm(wv, lds, G_PEER_Q, L, Mlive));    \
        RUN(ph_route(wv, lds, L, Mlive));             \
        RUN(ph_gather(wv, lds, L, Mlive));            \
    } while (0)
    LAYER(0); LAYER(1); LAYER(2); LAYER(3);
#undef LAYER
#undef RUN
}

extern "C" void kernel_launch(void* const* d_in, const int* in_sizes, int n_in, void* d_out, int out_size, void* d_ws, size_t ws_size, hipStream_t stream) {
    static int grid = 0;
    if (grid == 0) {
        if (n_in != 29 || in_sizes[0] != ML * DM || out_size != ML * DM || ws_size < WS_END) {
            fprintf(stderr, "kernel_launch: shape mismatch: n_in %d in0 %d out %d ws %zu (need %zu); nothing launched\n", n_in, n_in > 0 ? in_sizes[0] : -1, out_size, ws_size, (size_t)WS_END); grid = -1; return; }
        int dev = 0, cus = 0, per_cu = 0;
        if (hipGetDevice(&dev) != hipSuccess || hipDeviceGetAttribute(&cus, hipDeviceAttributeMultiprocessorCount, dev) != hipSuccess) { fprintf(stderr, "kernel_launch: device query failed\n"); grid = -1; return; }
        if (hipFuncSetAttribute((const void*)mk_fwd, hipFuncAttributeMaxDynamicSharedMemorySize, LDS_BYTES) != hipSuccess) { fprintf(stderr, "kernel_launch: hipFuncSetAttribute failed\n"); grid = -1; return; }
        if (hipOccupancyMaxActiveBlocksPerMultiprocessor(&per_cu, (const void*)mk_fwd, NWAVES * 64, LDS_BYTES) != hipSuccess || per_cu < 1)
            fprintf(stderr, "kernel_launch: note: occupancy query reports %d workgroups per CU\n", per_cu);
        (void)hipGetLastError();
        grid = cus;
    }
    if (grid < 0) return;
    if (hipMemsetAsync((char*)d_ws + WS_CTL, 0, CTL_ZERO_BYTES, stream) != hipSuccess) { fprintf(stderr, "kernel_launch: memset failed\n"); return; }
    Params p{};
    for (int i = 0; i < 29; ++i) p.in[i] = (const float*)d_in[i];
    p.out = (float*)d_out; p.ws = (unsigned char*)d_ws;
#if MK_ONE_LAUNCH
    p.ph_lo = 0; p.ph_hi = NPH;
    hipLaunchKernelGGL(mk_fwd, dim3(grid), dim3(NWAVES * 64), LDS_BYTES, stream, p);
#else
    for (int li = 0; li < NPH; ++li) { p.ph_lo = li; p.ph_hi = li + 1; hipLaunchKernelGGL(mk_fwd, dim3(grid), dim3(NWAVES * 64), LDS_BYTES, stream, p); }
#endif
    const hipError_t le = hipPeekAtLastError();
    if (le != hipSuccess) fprintf(stderr, "kernel_launch: launch failed: %s\n", hipGetErrorName(le));
}
```

```cpp
#include <hip/hip_runtime.h>
#include <cstdio>
#include <cstdint>
#ifndef MK_ONE_LAUNCH
#define MK_ONE_LAUNCH 1
#endif
__device__ __forceinline__ int launder_v(int v) { asm volatile("" : "+v"(v)); return v; }
__device__ __forceinline__ int lane_id_fresh() { unsigned m = ~0u; asm volatile("" : "+s"(m)); return (int)__builtin_amdgcn_mbcnt_hi(m, __builtin_amdgcn_mbcnt_lo(m, 0u)); }
#ifndef WT_STORES
#define WT_STORES 0
#endif
typedef unsigned wt_u32x4 __attribute__((ext_vector_type(4)));
__device__ __forceinline__ void st16_wt(void* p, wt_u32x4 v) {
#if WT_STORES
    asm volatile("global_store_dwordx4 %0, %1, off sc1\n\ts_nop 1" :: "v"(p), "v"(v) : "memory");
#else
    *(wt_u32x4*)p = v;
#endif
}
namespace pg8 {
#define PG8_LAS __attribute__((address_space(3)))
typedef unsigned short bf16_t;
typedef short bf16x8 __attribute__((ext_vector_type(8)));
typedef float f32x4 __attribute__((ext_vector_type(4)));
typedef unsigned u32x4 __attribute__((ext_vector_type(4)));
constexpr int BM = 256, BK = 64, HALF = 128, HTB = HALF * BK * 2  , STAGE_BYTES = 8 * HTB, NXCD = 8, WGM = 8;

__host__ __device__ __forceinline__ int lds_byte(int r, int c) { const int st = (r >> 4) * 2 + (c >> 5), rr = r & 15, cc = c & 31, ob = rr * 64 + cc * 2; return st * 1024 + (ob ^ (((ob >> 9) & 1) << 5)); }
__host__ __device__ __forceinline__ void stage_rc(int b, int& R, int& C) { const int st = b / 1024, sb = b % 1024, swz = sb ^ (((sb >> 9) & 1) << 5); R = (st >> 1) * 16 + swz / 64; C = (st & 1) * 32 + (swz % 64) / 2; }
__host__ __device__ __forceinline__ int perm32(int rho) { const int n = rho >> 4, i = rho & 15; return 8 * (i >> 2) + 4 * n + (i & 3); }

struct Unit { int pm, pn; };
struct Gemm { const bf16_t* A; const bf16_t* Bt; int M, N, K; };

struct StaticOrder {
    int nM, nN, nwg, G, c;
    __host__ __device__ void init(int M, int N, int G_, int c_) { nM = M / BM; nN = N / BM; nwg = nM * nN; G = G_; c = c_; }
    __host__ __device__ bool next(int i, Unit& u) const {
        const long L = (long)i * G + c; if (L >= nwg) return false;
        int wgid = (int)L; { const int q = nwg / NXCD, r = nwg % NXCD, xcd = wgid % NXCD, off = wgid / NXCD; wgid = (xcd < r ? xcd * (q + 1) : r * (q + 1) + (xcd - r) * q) + off; }
        const int nig = WGM * nN, gid = wgid / nig, fm = gid * WGM, gsz = (nM - fm) < WGM ? (nM - fm) : WGM;
        u.pm = fm + ((wgid % nig) % gsz); u.pn = (wgid % nig) / gsz; return true;
    }
    __device__ __forceinline__ void a_ready(const Unit&) const {}
    __device__ __forceinline__ void done(const Unit&) const {}
};

__device__ __forceinline__ unsigned cvt_pk_bf16(float lo, float hi) { unsigned r; asm volatile("v_cvt_pk_bf16_f32 %0, %1, %2" : "=v"(r) : "v"(lo), "v"(hi)); return r; }
typedef float f32x2 __attribute__((ext_vector_type(2)));
__device__ __forceinline__ f32x2 gelu_pk(f32x2 v) {
    const f32x2 av = __builtin_elementwise_abs(v), d = av * 0.2316418882f + 1.0f;
    f32x2 t; t.x = __builtin_amdgcn_rcpf(d.x); t.y = __builtin_amdgcn_rcpf(d.y);
    f32x2 q = t * 0.5307027145f + (-0.7265760135f); q = q * t + 0.7107068705f; q = q * t + (-0.142248368f); q = q * t + 0.127414796f; q = q * t;
    const f32x2 s = (v * v) * (-0.72134752044f);
    f32x2 e; e.x = __builtin_amdgcn_exp2f(s.x); e.y = __builtin_amdgcn_exp2f(s.y);
    const f32x2 m = v * (q * e), r = v - m;
    f32x2 o; o.x = v.x < 0.f ? m.x : r.x; o.y = v.y < 0.f ? m.y : r.y; return o;
}

template <int ACT  > struct EpiBf16 {
    static constexpr bool PERM = true, AFTER_DRAIN = false; static_assert(ACT == 0 || ACT == 1, "EpiBf16: ACT is 0 (none) or 1 (gelu_pk)");
    bf16_t* O; int ldc; const float* bias; int split_cols; size_t split_stride; float scale0;
    __device__ __forceinline__ void operator()(const f32x4 (&acc)[2][2][4][2], const Unit& u, int wr, int wc, int fr, int fq) const {
        const int row0 = u.pm * BM + wr * 64 + fr; int colt = u.pn * BM; bf16_t* base = O;
        float sc = 1.f; if (split_cols) { const int t = colt / split_cols; base += (size_t)t * split_stride; colt -= t * split_cols; if (t == 0) sc = scale0; }
        const int col0 = colt + wc * 32 + 8 * fq, bcol0 = u.pn * BM + wc * 32 + 8 * fq;
        f32x4 bv[2][2];
#pragma unroll
        for (int bj = 0; bj < 2; ++bj)
#pragma unroll
            for (int n = 0; n < 2; ++n) bv[bj][n] = bias ? *(const f32x4*)(bias + bcol0 + bj * HALF + 4 * n) : (f32x4){0.f, 0.f, 0.f, 0.f};
#pragma unroll
        for (int ai = 0; ai < 2; ++ai)
#pragma unroll
            for (int m = 0; m < 4; ++m) { bf16_t* rowp = base + (size_t)(row0 + ai * HALF + m * 16) * ldc + col0;
#pragma unroll
                for (int bj = 0; bj < 2; ++bj) { f32x4 v0 = acc[ai][bj][m][0] + bv[bj][0], v1 = acc[ai][bj][m][1] + bv[bj][1];
                    if (ACT == 1) { f32x2 a = gelu_pk((f32x2){v0[0], v0[1]}), b = gelu_pk((f32x2){v0[2], v0[3]}), c = gelu_pk((f32x2){v1[0], v1[1]}), d = gelu_pk((f32x2){v1[2], v1[3]});
                        v0 = (f32x4){a.x, a.y, b.x, b.y}; v1 = (f32x4){c.x, c.y, d.x, d.y}; }
                    v0 = v0 * sc; v1 = v1 * sc; u32x4 w; w.x = cvt_pk_bf16(v0[0], v0[1]); w.y = cvt_pk_bf16(v0[2], v0[3]); w.z = cvt_pk_bf16(v1[0], v1[1]); w.w = cvt_pk_bf16(v1[2], v1[3]);
                    *(u32x4*)(rowp + bj * HALF) = w; } }
    }
};
template <class Epi, class Sched, bool ALIGN_EPI = false, bool SP2 = false>
__device__ __forceinline__ void gemm_phase(PG8_LAS unsigned char* lds, const Gemm g, const Sched& S, const Epi& E, const int tid_in) {
    const int tid = launder_v(tid_in) & 511, wid = __builtin_amdgcn_readfirstlane(tid >> 6), lane = tid & 63, wr = wid >> 2, wc = wid & 3, fr = lane & 15, fq = lane >> 4;
    const int K = g.K, nt = K / BK;
    unsigned voffA[2], voffB[2];
#pragma unroll
    for (int i = 0; i < 2; ++i) { int R, C; stage_rc(tid * 16 + i * 8192, R, C); const int Rb = Epi::PERM ? ((R & ~31) + perm32(R & 31)) : R;
        voffA[i] = (unsigned)(R * K + C) * 2u; voffB[i] = (unsigned)(Rb * K + C) * 2u; }
    const size_t kstep = (size_t)(BK * 2);
    const size_t hstep = (size_t)HALF * K * 2;
    const size_t tstep = 2 * hstep;
    const unsigned ldsw = (unsigned)wid * 1024u;
    const int aoff = lds_byte(wr * 64 + fr, fq * 8), boff = lds_byte(wc * 32 + fr, fq * 8);
#define PG8_SA(b, h) (((b) * 2 + (h)) * HTB)
#define PG8_SB(b, h) ((4 + (b) * 2 + (h)) * HTB)
#define PG8_STAGE(bufoff, gbase, voff) do { _Pragma("unroll") for (int _i = 0; _i < 2; ++_i) \
        __builtin_amdgcn_global_load_lds((const unsigned*)((const char*)(gbase) + (voff)[_i]), (PG8_LAS unsigned*)(lds + (bufoff) + ldsw + _i * 8192), 16, 0, 0); } while (0)
#define PG8_LDA(dst, b, h) do { _Pragma("unroll") for (int m = 0; m < 4; ++m) _Pragma("unroll") for (int k = 0; k < 2; ++k) dst[m][k] = *(const PG8_LAS bf16x8*)(lds + PG8_SA(b, h) + aoff + m * 2048 + k * 1024); } while (0)
#define PG8_LDB(dst, b, h) do { _Pragma("unroll") for (int n = 0; n < 2; ++n) _Pragma("unroll") for (int k = 0; k < 2; ++k) dst[n][k] = *(const PG8_LAS bf16x8*)(lds + PG8_SB(b, h) + boff + n * 2048 + k * 1024); } while (0)
#define PG8_MMA(ai, bj, At, Bt) do { __builtin_amdgcn_s_setprio(1); _Pragma("unroll") for (int m = 0; m < 4; ++m) _Pragma("unroll") for (int n = 0; n < 2; ++n) _Pragma("unroll") for (int k = 0; k < 2; ++k) \
        acc[ai][bj][m][n] = __builtin_amdgcn_mfma_f32_16x16x32_bf16(Bt[n][k], At[m][k], acc[ai][bj][m][n], 0, 0, 0); __builtin_amdgcn_s_setprio(0); } while (0)
#define PG8_WAIT_V(n) asm volatile("s_waitcnt vmcnt(" #n ")" ::: "memory")
#define PG8_WAIT_L(n) asm volatile("s_waitcnt lgkmcnt(" #n ")" ::: "memory")
#define PG8_BAR __builtin_amdgcn_s_barrier()
#define PG8_SCHED __builtin_amdgcn_sched_barrier(0)
    Unit cur, nxt; int ui = 0;
    if (!S.next(0, cur)) return;
    f32x4 acc[2][2][4][2];
#pragma unroll
    for (int a = 0; a < 2; ++a)
#pragma unroll
        for (int b = 0; b < 2; ++b)
#pragma unroll
            for (int m = 0; m < 4; ++m)
#pragma unroll
                for (int n = 0; n < 2; ++n) acc[a][b][m][n] = (f32x4){0.f, 0.f, 0.f, 0.f};
    bf16x8 At[4][2], B0[2][2], B1[2][2];
    const char* cA = (const char*)g.A + (size_t)cur.pm * tstep; const char* cB = (const char*)g.Bt + (size_t)cur.pn * tstep;
    S.a_ready(cur);
    if constexpr (SP2) {
        PG8_STAGE(PG8_SB(0, 0), cB, voffB); PG8_STAGE(PG8_SB(0, 1), cB + hstep, voffB); PG8_STAGE(PG8_SA(0, 0), cA, voffA); PG8_STAGE(PG8_SA(0, 1), cA + hstep, voffA);
        if (wr == 1) PG8_BAR;
        PG8_WAIT_V(2); PG8_BAR;
        PG8_STAGE(PG8_SB(1, 0), cB + kstep, voffB); PG8_STAGE(PG8_SA(1, 0), cA + kstep, voffA); PG8_STAGE(PG8_SB(1, 1), cB + hstep + kstep, voffB);
        PG8_WAIT_V(6); PG8_BAR;
    } else {
        PG8_STAGE(PG8_SB(0, 0), cB, voffB); PG8_STAGE(PG8_SA(0, 0), cA, voffA); PG8_STAGE(PG8_SB(0, 1), cB + hstep, voffB); PG8_STAGE(PG8_SA(0, 1), cA + hstep, voffA);
        if (wr == 1) PG8_BAR;
        PG8_WAIT_V(4); PG8_BAR;
        PG8_STAGE(PG8_SB(1, 0), cB + kstep, voffB); PG8_STAGE(PG8_SA(1, 0), cA + kstep, voffA); PG8_STAGE(PG8_SB(1, 1), cB + hstep + kstep, voffB);
        PG8_WAIT_V(6); PG8_BAR;
    }
    for (;;) {
        const bool has_next = S.next(ui + 1, nxt);
        const char* nA = has_next ? (const char*)g.A + (size_t)nxt.pm * tstep : cA; const char* nB = has_next ? (const char*)g.Bt + (size_t)nxt.pn * tstep : cB;
        for (int t = 0; t < nt; t += 2) {
            const bool last = (t == nt - 2);
            const char* a1 = cA + (size_t)(t + 1) * kstep;
            const char* a2 = last ? nA : cA + (size_t)(t + 2) * kstep; const char* b2 = last ? nB : cB + (size_t)(t + 2) * kstep;
            const char* a3 = a2 + kstep; const char* b3 = b2 + kstep;
            if (last && has_next) S.a_ready(nxt);
            if constexpr (SP2) {
            PG8_LDB(B0, 0, 0); PG8_LDB(B1, 0, 1); PG8_SCHED; PG8_LDA(At, 0, 0); PG8_STAGE(PG8_SA(1, 1), a1 + hstep, voffA);
            PG8_WAIT_V(8); PG8_WAIT_L(0); PG8_BAR; PG8_MMA(0, 0, At, B0); PG8_MMA(0, 1, At, B1); PG8_BAR; PG8_SCHED;
            PG8_LDA(At, 0, 1); PG8_STAGE(PG8_SB(0, 0), b2, voffB); PG8_STAGE(PG8_SB(0, 1), b2 + hstep, voffB); PG8_STAGE(PG8_SA(0, 0), a2, voffA);
            PG8_WAIT_V(8); PG8_WAIT_L(0); PG8_BAR; PG8_MMA(1, 0, At, B0); PG8_MMA(1, 1, At, B1); PG8_BAR; PG8_SCHED;
            PG8_LDB(B0, 1, 0); PG8_LDB(B1, 1, 1); PG8_SCHED; PG8_LDA(At, 1, 0); PG8_STAGE(PG8_SA(0, 1), a2 + hstep, voffA);
            PG8_WAIT_V(8); PG8_WAIT_L(0); PG8_BAR; PG8_MMA(0, 0, At, B0); PG8_MMA(0, 1, At, B1); PG8_BAR; PG8_SCHED;
            PG8_LDA(At, 1, 1); PG8_STAGE(PG8_SB(1, 0), b3, voffB); PG8_STAGE(PG8_SB(1, 1), b3 + hstep, voffB); PG8_STAGE(PG8_SA(1, 0), a3, voffA);
            PG8_WAIT_V(8); PG8_WAIT_L(0); PG8_BAR; PG8_MMA(1, 0, At, B0); PG8_MMA(1, 1, At, B1); PG8_BAR; PG8_SCHED;
            } else {
            PG8_LDB(B0, 0, 0); PG8_SCHED; PG8_LDA(At, 0, 0); PG8_STAGE(PG8_SA(1, 1), a1 + hstep, voffA);
            PG8_WAIT_L(8); PG8_BAR; PG8_WAIT_L(0); PG8_MMA(0, 0, At, B0); PG8_BAR; PG8_SCHED;
            PG8_LDB(B1, 0, 1); PG8_STAGE(PG8_SB(0, 0), b2, voffB);
            PG8_BAR; PG8_WAIT_L(0); PG8_MMA(0, 1, At, B1); PG8_BAR;
            PG8_LDA(At, 0, 1); PG8_STAGE(PG8_SA(0, 0), a2, voffA);
            PG8_BAR; PG8_WAIT_L(0); PG8_MMA(1, 0, At, B0); PG8_BAR; PG8_SCHED;
            PG8_STAGE(PG8_SB(0, 1), b2 + hstep, voffB);
            PG8_WAIT_V(6); PG8_BAR; PG8_MMA(1, 1, At, B1); PG8_BAR;
            PG8_LDB(B0, 1, 0); PG8_SCHED; PG8_LDA(At, 1, 0); PG8_STAGE(PG8_SA(0, 1), a2 + hstep, voffA);
            PG8_WAIT_L(8); PG8_BAR; PG8_WAIT_L(0); PG8_MMA(0, 0, At, B0); PG8_BAR; PG8_SCHED;
            PG8_LDB(B1, 1, 1); PG8_STAGE(PG8_SB(1, 0), b3, voffB);
            PG8_BAR; PG8_WAIT_L(0); PG8_MMA(0, 1, At, B1); PG8_BAR;
            PG8_LDA(At, 1, 1); PG8_STAGE(PG8_SA(1, 0), a3, voffA);
            PG8_BAR; PG8_WAIT_L(0); PG8_MMA(1, 0, At, B0); PG8_BAR; PG8_SCHED;
            PG8_STAGE(PG8_SB(1, 1), b3 + hstep, voffB);
            PG8_WAIT_V(6); PG8_BAR; PG8_MMA(1, 1, At, B1); PG8_BAR;
            }
        }
        if constexpr (ALIGN_EPI) { if (wr == 0) PG8_BAR; }
        if constexpr (!Epi::AFTER_DRAIN) { E(acc, cur, wr, wc, fr, fq); S.done(cur); }
        if (!has_next) break;
#pragma unroll
        for (int a = 0; a < 2; ++a)
#pragma unroll
            for (int b = 0; b < 2; ++b)
#pragma unroll
                for (int m = 0; m < 4; ++m)
#pragma unroll
                    for (int n = 0; n < 2; ++n) acc[a][b][m][n] = (f32x4){0.f, 0.f, 0.f, 0.f};
        cur = nxt; cA = nA; cB = nB; ++ui;
        if constexpr (ALIGN_EPI) { if (wr == 1) PG8_BAR; }
    }
    PG8_WAIT_V(0);
    if constexpr (!ALIGN_EPI) { if (wr == 0) PG8_BAR; }
    PG8_BAR;
    if constexpr (Epi::AFTER_DRAIN) { E.fused(acc, cur, wr, wc, fr, fq, lds, wid, lane); S.done(cur); }
#undef PG8_SA
#undef PG8_SB
#undef PG8_STAGE
#undef PG8_LDA
#undef PG8_LDB
#undef PG8_MMA
#undef PG8_WAIT_V
#undef PG8_WAIT_L
#undef PG8_BAR
#undef PG8_SCHED
}
}

namespace pg8 {
__device__ __forceinline__ float gelu_tanh(float x) {
    const float t = x * (1.5957691216057308f + 0.07135481627f * x * x);
    const float e = __builtin_amdgcn_exp2f(-1.4426950408889634f * t);
    return x * __builtin_amdgcn_rcpf(1.0f + e);
}
template <int ACT> struct EpiT {
    static constexpr bool PERM = true, AFTER_DRAIN = false;
    bf16_t* O; int ldc;
    __device__ __forceinline__ void operator()(const f32x4 (&acc)[2][2][4][2], const Unit& u, int wr, int wc, int fr, int fq) const {
        const int row0 = u.pm * BM + wr * 64 + fr; const int col0 = u.pn * BM + wc * 32 + 8 * fq;
#pragma unroll
        for (int ai = 0; ai < 2; ++ai)
#pragma unroll
            for (int m = 0; m < 4; ++m) { bf16_t* rowp = O + (size_t)(row0 + ai * HALF + m * 16) * ldc + col0;
#pragma unroll
                for (int bj = 0; bj < 2; ++bj) { f32x4 v0 = acc[ai][bj][m][0], v1 = acc[ai][bj][m][1];
                    if (ACT == 2) { v0 = (f32x4){gelu_tanh(v0[0]), gelu_tanh(v0[1]), gelu_tanh(v0[2]), gelu_tanh(v0[3])}; v1 = (f32x4){gelu_tanh(v1[0]), gelu_tanh(v1[1]), gelu_tanh(v1[2]), gelu_tanh(v1[3])}; }
                    u32x4 w; w.x = cvt_pk_bf16(v0[0], v0[1]); w.y = cvt_pk_bf16(v0[2], v0[3]); w.z = cvt_pk_bf16(v1[0], v1[1]); w.w = cvt_pk_bf16(v1[2], v1[3]);
                    ::st16_wt(rowp + bj * HALF, w); } }
    }
};
struct EpiR {
    static constexpr bool PERM = true, AFTER_DRAIN = false;
    bf16_t* O; int ldc; int act; int rope; const float* ropet;
    __device__ __forceinline__ void operator()(const f32x4 (&acc)[2][2][4][2], const Unit& u, int wr, int wc, int fr, int fq) const {
        const int row0 = u.pm * BM + wr * 64 + fr; const int col0 = u.pn * BM + wc * 32 + 8 * fq;
        const bool rrows = rope != 0 && u.pm < 64;
#pragma unroll
        for (int ai = 0; ai < 2; ++ai)
#pragma unroll
            for (int m = 0; m < 4; ++m) { const int grow = row0 + ai * HALF + m * 16; bf16_t* rowp = O + (size_t)grow * ldc + col0;
#pragma unroll
                for (int bj = 0; bj < 2; ++bj) { f32x4 v0 = acc[ai][bj][m][0], v1 = acc[ai][bj][m][1];
                    if (act) { v0 = (f32x4){gelu_tanh(v0[0]), gelu_tanh(v0[1]), gelu_tanh(v0[2]), gelu_tanh(v0[3])}; v1 = (f32x4){gelu_tanh(v1[0]), gelu_tanh(v1[1]), gelu_tanh(v1[2]), gelu_tanh(v1[3])}; }
                    if (rrows) { const int blk = u.pn * 8 + bj * 4 + wc; const int b6 = blk % 6; const bool on = rope == 1 ? (blk < 128) : (b6 >= 4); const int half = rope == 1 ? (blk & 1) : (b6 - 4);
                        if (on) { const int t = grow & 8191; const int pos = half ? (t & 63) : (t >> 6);
                            const float* cp = ropet + pos * 16 + 8 * (fq & 1); const f32x4 c0 = *(const f32x4*)cp, c1 = *(const f32x4*)(cp + 4), s0 = *(const f32x4*)(cp + 2048), s1 = *(const f32x4*)(cp + 2052);
                            f32x4 p0, p1;
#pragma unroll
                            for (int i = 0; i < 4; ++i) { const float a_ = v0[i], b_ = v1[i];
                                const auto r0 = __builtin_amdgcn_permlane32_swap(__float_as_uint(a_), __float_as_uint(a_), false, false);
                                const auto r1 = __builtin_amdgcn_permlane32_swap(__float_as_uint(b_), __float_as_uint(b_), false, false);
                                const unsigned x0_ = (fq & 2) ? r0[0] : r0[1], x1_ = (fq & 2) ? r1[0] : r1[1]; p0[i] = __uint_as_float(x0_); p1[i] = __uint_as_float(x1_); }
                            if (fq & 2) { v0 = p0 * s0 + v0 * c0; v1 = p1 * s1 + v1 * c1; } else { v0 = v0 * c0 - p0 * s0; v1 = v1 * c1 - p1 * s1; } } }
                    u32x4 w; w.x = cvt_pk_bf16(v0[0], v0[1]); w.y = cvt_pk_bf16(v0[2], v0[3]); w.z = cvt_pk_bf16(v1[0], v1[1]); w.w = cvt_pk_bf16(v1[2], v1[3]);
                    ::st16_wt(rowp + bj * HALF, w); } }
    }
};
}

constexpr int DM = 2048, NBATCH = 2, SEQ = 8192, CTXL = 256;
constexpr int ML = NBATCH * SEQ;
constexpr int MC = NBATCH * CTXL;
constexpr int MT = ML + MC;
constexpr int NLAYER = 4;
constexpr float ALPHA = 1.6817928305074290f, LN_EPS = 1e-6f;
constexpr int NWAVES = 8;
constexpr float U_SCALE = 64.0f, V_SCALE = 4.0f;
constexpr int PROW = 1536;
#ifndef PEER_V4
#define PEER_V4 1
#endif
#ifndef PEER_U4
#define PEER_U4 1
#endif
constexpr int PREC = PEER_U4 ? 2048 : PEER_V4 ? 2560 : 2 * PROW;
constexpr int NPH = 35;

constexpr size_t MiB = 1ull << 20;
constexpr size_t WS_CTL = 0, CTL_ZERO_BYTES = 1 * MiB;
constexpr int    CW_BAR = 4096;
constexpr size_t WS_MOD = 128 * 1024;
constexpr size_t WS_VST = 1 * MiB;
constexpr size_t WS_ROPE = 1 * MiB + 160 * 1024;
constexpr size_t WS_MODP = 1 * MiB + 256 * 1024;
constexpr size_t WS_GMWIN = 6 * MiB;
constexpr size_t WS_GMWOUT = WS_GMWIN + 32 * MiB;
constexpr size_t WS_GMWS = WS_GMWOUT + 16 * MiB;
constexpr size_t WS_PWQ = WS_GMWS + 1 * MiB;
constexpr size_t WS_PK1 = WS_PWQ + 32 * MiB;
constexpr size_t WS_PK2 = WS_PK1 + 512 * 1024;
constexpr size_t WS_MLAIN = WS_PK1 + 1 * MiB;
constexpr size_t WS_MLAUQ = WS_MLAIN + 5 * MiB;
constexpr size_t WS_MLAUKV = WS_MLAUQ + 3 * MiB;
constexpr size_t WS_MLAOUT = WS_MLAUKV + 4 * MiB;
constexpr size_t WS_DAIN = WS_MLAOUT + 8 * MiB;
constexpr size_t WS_DAOUT = WS_DAIN + 24 * MiB;
constexpr size_t WS_PU = WS_DAOUT + 8 * MiB;
constexpr size_t WS_PV = WS_PU + 96 * MiB;
constexpr size_t WS_X = WS_PV + 96 * MiB;
constexpr size_t WS_H = WS_X + 66 * MiB;
constexpr size_t WS_G = WS_H + 66 * MiB;
constexpr size_t WS_Y = WS_G + 66 * MiB;
constexpr size_t WS_QP = WS_Y + 66 * MiB;
constexpr size_t WS_Z = WS_QP + 66 * MiB;
constexpr size_t WS_C = WS_Z + 198 * MiB;
constexpr size_t WS_CQN = WS_C + 42 * MiB;
constexpr size_t WS_CKVN = WS_CQN + 17 * MiB;
constexpr size_t WS_KR = WS_CKVN + 17 * MiB;
constexpr size_t WS_QM = WS_KR + 3 * MiB;
constexpr size_t WS_KV = WS_QM + 99 * MiB;
constexpr size_t WS_ROUTE = WS_KV + 132 * MiB;
constexpr size_t WS_END = WS_ROUTE + 17 * MiB;
static_assert((size_t)MT * DM * 2 == 66 * MiB, "row buffer size");

constexpr int RING_BYTES = 155648, MISC_OFF = RING_BYTES + 320, LDS_BYTES = 159744;

#define GAS __attribute__((address_space(1)))
#define LAS __attribute__((address_space(3)))
typedef unsigned short bf16;
typedef unsigned u32x4 __attribute__((ext_vector_type(4)));
typedef unsigned u32x2 __attribute__((ext_vector_type(2)));
typedef float f32x4 __attribute__((ext_vector_type(4)));
typedef float f32x16 __attribute__((ext_vector_type(16)));
typedef short bf16x8 __attribute__((ext_vector_type(8)));
typedef short s16x4 __attribute__((ext_vector_type(4)));
#define LDS_WAIT() asm volatile("s_waitcnt lgkmcnt(0)" ::: "memory")

__device__ __forceinline__ unsigned cvtpk(float lo, float hi) { unsigned r; asm("v_cvt_pk_bf16_f32 %0, %1, %2" : "=v"(r) : "v"(lo), "v"(hi)); return r; }
__device__ __forceinline__ float bflo(unsigned w) { return __uint_as_float(w << 16); }
__device__ __forceinline__ float bfhi(unsigned w) { return __uint_as_float(w & 0xffff0000u); }
__device__ __forceinline__ float bf1(bf16 b) { return __uint_as_float((unsigned)b << 16); }
__device__ __forceinline__ bf16 tobf1(float f) { return (bf16)(cvtpk(f, 0.f) & 0xffffu); }
#define DPP_F(v, ctrl) __int_as_float(__builtin_amdgcn_mov_dpp(__float_as_int(v), (ctrl), 0xF, 0xF, true))
__device__ __forceinline__ float row_sum16(float v) { v += DPP_F(v, 0xB1); v += DPP_F(v, 0x4E); v += DPP_F(v, 0x141); v += DPP_F(v, 0x140); return v; }
__device__ __forceinline__ float sum_xor16(float v) { const auto r = __builtin_amdgcn_permlane16_swap(__float_as_uint(v), __float_as_uint(v), false, false); return __uint_as_float(r[0]) + __uint_as_float(r[1]); }
__device__ __forceinline__ float sum_xor32(float v) { const auto r = __builtin_amdgcn_permlane32_swap(__float_as_uint(v), __float_as_uint(v), false, false); return __uint_as_float(r[0]) + __uint_as_float(r[1]); }
__device__ __forceinline__ float wave_sum(float v) { return sum_xor32(sum_xor16(row_sum16(v))); }
__device__ __forceinline__ float half_sum32(float v) { return sum_xor16(row_sum16(v)); }
__device__ __forceinline__ float lane_xor16(float v, int lane) { const auto r = __builtin_amdgcn_permlane16_swap(__float_as_uint(v), __float_as_uint(v), false, false); return __uint_as_float((lane & 16) ? r[0] : r[1]); }
__device__ __forceinline__ unsigned lane_xor32(unsigned v, int lane) { const auto r = __builtin_amdgcn_permlane32_swap(v, v, false, false); return (lane & 32) ? r[0] : r[1]; }
__device__ __forceinline__ float gelu_tanh(float x) { return pg8::gelu_tanh(x); }

__device__ __forceinline__ void load_row_bf16(const bf16* row, int lane, float (&v)[32]) {
#pragma unroll
    for (int j = 0; j < 4; ++j) { const u32x4 w = ((const u32x4*)row)[64 * j + lane];
        v[8 * j + 0] = bflo(w.x); v[8 * j + 1] = bfhi(w.x); v[8 * j + 2] = bflo(w.y); v[8 * j + 3] = bfhi(w.y);
        v[8 * j + 4] = bflo(w.z); v[8 * j + 5] = bfhi(w.z); v[8 * j + 6] = bflo(w.w); v[8 * j + 7] = bfhi(w.w); }
}
__device__ __forceinline__ void load_row_bf16_nt(const bf16* row, int lane, float (&v)[32]) {
#pragma unroll
    for (int j = 0; j < 4; ++j) { const u32x4 w = __builtin_nontemporal_load(&((const u32x4*)row)[64 * j + lane]);
        v[8 * j + 0] = bflo(w.x); v[8 * j + 1] = bfhi(w.x); v[8 * j + 2] = bflo(w.y); v[8 * j + 3] = bfhi(w.y);
        v[8 * j + 4] = bflo(w.z); v[8 * j + 5] = bfhi(w.z); v[8 * j + 6] = bflo(w.w); v[8 * j + 7] = bfhi(w.w); }
}
__device__ __forceinline__ void store_row_bf16(bf16* row, int lane, const float (&v)[32]) {
#pragma unroll
    for (int j = 0; j < 4; ++j) { u32x4 w; w.x = cvtpk(v[8 * j + 0], v[8 * j + 1]); w.y = cvtpk(v[8 * j + 2], v[8 * j + 3]); w.z = cvtpk(v[8 * j + 4], v[8 * j + 5]); w.w = cvtpk(v[8 * j + 6], v[8 * j + 7]);
        ((u32x4*)row)[64 * j + lane] = w; }
}
__device__ __forceinline__ void load_row_f32(const float* row, int lane, float (&v)[32]) {
#pragma unroll
    for (int j = 0; j < 4; ++j) { const f32x4 a = ((const f32x4*)row)[128 * j + 2 * lane], b = ((const f32x4*)row)[128 * j + 2 * lane + 1];
        v[8 * j + 0] = a.x; v[8 * j + 1] = a.y; v[8 * j + 2] = a.z; v[8 * j + 3] = a.w; v[8 * j + 4] = b.x; v[8 * j + 5] = b.y; v[8 * j + 6] = b.z; v[8 * j + 7] = b.w; }
}
__device__ __forceinline__ void load_row_f32_nt(const float* row, int lane, float (&v)[32]) {
#pragma unroll
    for (int j = 0; j < 4; ++j) { const f32x4 a = __builtin_nontemporal_load(&((const f32x4*)row)[128 * j + 2 * lane]), b = __builtin_nontemporal_load(&((const f32x4*)row)[128 * j + 2 * lane + 1]);
        v[8 * j + 0] = a.x; v[8 * j + 1] = a.y; v[8 * j + 2] = a.z; v[8 * j + 3] = a.w; v[8 * j + 4] = b.x; v[8 * j + 5] = b.y; v[8 * j + 6] = b.z; v[8 * j + 7] = b.w; }
}
__device__ __forceinline__ void store_row_f32(float* row, int lane, const float (&v)[32]) {
#pragma unroll
    for (int j = 0; j < 4; ++j) { ((f32x4*)row)[128 * j + 2 * lane] = (f32x4){v[8 * j + 0], v[8 * j + 1], v[8 * j + 2], v[8 * j + 3]};
        ((f32x4*)row)[128 * j + 2 * lane + 1] = (f32x4){v[8 * j + 4], v[8 * j + 5], v[8 * j + 6], v[8 * j + 7]}; }
}
__device__ __forceinline__ void load_row_bf16_b(const bf16* row, int lane, float (&v)[32]) {
#pragma unroll
    for (int j = 0; j < 4; ++j) { const u32x4 w = ((const u32x4*)row)[4 * lane + j];
        v[8 * j + 0] = bflo(w.x); v[8 * j + 1] = bfhi(w.x); v[8 * j + 2] = bflo(w.y); v[8 * j + 3] = bfhi(w.y);
        v[8 * j + 4] = bflo(w.z); v[8 * j + 5] = bfhi(w.z); v[8 * j + 6] = bflo(w.w); v[8 * j + 7] = bfhi(w.w); }
}
__device__ __forceinline__ void store_row_bf16_b(bf16* row, int lane, const float (&v)[32]) {
#pragma unroll
    for (int j = 0; j < 4; ++j) { u32x4 w; w.x = cvtpk(v[8 * j + 0], v[8 * j + 1]); w.y = cvtpk(v[8 * j + 2], v[8 * j + 3]); w.z = cvtpk(v[8 * j + 4], v[8 * j + 5]); w.w = cvtpk(v[8 * j + 6], v[8 * j + 7]);
        ((u32x4*)row)[4 * lane + j] = w; }
}
__device__ __forceinline__ void load_row_f32_b(const float* row, int lane, float (&v)[32]) {
#pragma unroll
    for (int q = 0; q < 8; ++q) { const f32x4 a = ((const f32x4*)row)[8 * lane + q];
        v[4 * q + 0] = a.x; v[4 * q + 1] = a.y; v[4 * q + 2] = a.z; v[4 * q + 3] = a.w; }
}
__device__ __forceinline__ void store_row_f32_b(float* row, int lane, const float (&v)[32]) {
#pragma unroll
    for (int q = 0; q < 8; ++q) ((f32x4*)row)[8 * lane + q] = (f32x4){v[4 * q + 0], v[4 * q + 1], v[4 * q + 2], v[4 * q + 3]};
}
__device__ __forceinline__ void store_row_f32_b_nt(float* row, int lane, const float (&v)[32]) {
#pragma unroll
    for (int q = 0; q < 8; ++q) __builtin_nontemporal_store((f32x4){v[4 * q + 0], v[4 * q + 1], v[4 * q + 2], v[4 * q + 3]}, &((f32x4*)row)[8 * lane + q]);
}
__device__ __forceinline__ void ln_stats(const float (&v)[32], float& mean, float& rstd) {
    float s = 0.f;
#pragma unroll
    for (int i = 0; i < 32; ++i) s += v[i];
    mean = wave_sum(s) * (1.0f / DM);
    float q = 0.f;
#pragma unroll
    for (int i = 0; i < 32; ++i) { const float d = v[i] - mean; q += d * d; }
    rstd = 1.0f / sqrtf(wave_sum(q) * (1.0f / DM) + LN_EPS);
}
template <bool LAYB>
__device__ __forceinline__ void finish_row(float (&z)[32], const float* lng, const float* lnb, bf16* Xrow, const float* sh, const float* sc, bf16* Hrow, float* Orow, int lane) {
    float mean, rstd; ln_stats(z, mean, rstd);
    { float g[32], b[32]; if (LAYB) { load_row_f32_b(lng, lane, g); load_row_f32_b(lnb, lane, b); } else { load_row_f32(lng, lane, g); load_row_f32(lnb, lane, b); }
#pragma unroll
      for (int i = 0; i < 32; ++i) z[i] = (z[i] - mean) * rstd * g[i] + b[i]; }
    if (Xrow) { if (LAYB) store_row_bf16_b(Xrow, lane, z); else store_row_bf16(Xrow, lane, z); }
    if (Orow) { if (LAYB) store_row_f32_b(Orow, lane, z); else store_row_f32(Orow, lane, z); }
    if (Hrow) {
        ln_stats(z, mean, rstd);
        float a[32], s[32]; if (LAYB) { load_row_f32_b(sc, lane, a); load_row_f32_b(sh, lane, s); } else { load_row_f32(sc, lane, a); load_row_f32(sh, lane, s); }
#pragma unroll
        for (int i = 0; i < 32; ++i) a[i] = (z[i] - mean) * rstd * (1.0f + a[i]) + s[i];
        if (LAYB) store_row_bf16_b(Hrow, lane, a); else store_row_bf16(Hrow, lane, a);
    }
}
__device__ __forceinline__ int row_slot(int row) { return row < ML ? (row >> 13) : 2; }

__device__ __forceinline__ unsigned f2bf_rne(float f) { unsigned u = __float_as_uint(f); return (u + 0x7fffu + ((u >> 16) & 1u)) >> 16; }
__device__ __forceinline__ unsigned pk2(float lo, float hi) { return f2bf_rne(lo) | (f2bf_rne(hi) << 16); }
#ifndef GEMV_PIPE
#define GEMV_PIPE 1
#endif
#ifndef NT_ACT
#define NT_ACT 0
#endif
#ifndef NT_STREAM
#define NT_STREAM 1
#endif
__device__ __forceinline__ void p0_transpose_item(const float* W, int K, int N, bf16* WT, LAS float* scr, int item, int lane) {
    const int nblk = N / 32, kb = item / nblk, nb = item % nblk, k0 = 64 * kb, n0 = 32 * nb;
    f32x4 t[8];
#pragma unroll
    for (int i = 0; i < 8; ++i) { const f32x4* p_ = (const f32x4*)(W + (size_t)(k0 + 8 * i + (lane >> 3)) * N + n0 + 4 * (lane & 7)); t[i] = NT_STREAM ? __builtin_nontemporal_load(p_) : *p_; }
#pragma unroll
    for (int i = 0; i < 8; ++i) { LAS float* d = scr + (8 * i + (lane >> 3)) * 33 + 4 * (lane & 7); d[0] = t[i].x; d[1] = t[i].y; d[2] = t[i].z; d[3] = t[i].w; }
    LDS_WAIT(); asm volatile("" ::: "memory");
    const int c = lane & 7;
#pragma unroll
    for (int j = 0; j < 4; ++j) { const int n = (lane >> 3) + 8 * j; const LAS float* s = scr + (8 * c) * 33 + n;
        u32x4 o; o.x = pk2(s[0 * 33], s[1 * 33]); o.y = pk2(s[2 * 33], s[3 * 33]); o.z = pk2(s[4 * 33], s[5 * 33]); o.w = pk2(s[6 * 33], s[7 * 33]);
        *(u32x4*)(WT + (size_t)(n0 + n) * K + k0 + 8 * c) = o; }
    LDS_WAIT(); asm volatile("" ::: "memory");
}
__device__ __forceinline__ void cvt_range(const float* src, bf16* dst, size_t n8, size_t gtid, size_t gthreads) {
#pragma unroll 4
    for (size_t i = gtid; i < n8; i += gthreads) { const f32x4 a = ((const f32x4*)src)[2 * i], b = ((const f32x4*)src)[2 * i + 1];
        u32x4 w; w.x = cvtpk(a.x, a.y); w.y = cvtpk(a.z, a.w); w.z = cvtpk(b.x, b.y); w.w = cvtpk(b.z, b.w); ((u32x4*)dst)[i] = w; }
}
__device__ __forceinline__ unsigned enc_e2m3(float x) {
    const unsigned sgn = (__float_as_uint(x) >> 26) & 32u;
    const float ax = fminf(fabsf(x), 7.5f);
    unsigned u = __float_as_uint(ax); u += 0x7FFFFu + ((u >> 20) & 1u);
    const unsigned cn = (u >> 20) - ((127u - 1u) << 3);
    const unsigned cs = (unsigned)__builtin_rintf(ax * 8.0f);
    return sgn | (ax < 1.0f ? cs : cn);
}
#ifndef EMU_FP4V
#define EMU_FP4V 0
#endif
#ifndef CVT_PIPE
#define CVT_PIPE 0
#endif
typedef float f32x2v __attribute__((ext_vector_type(2)));
typedef float f32x16v __attribute__((ext_vector_type(16)));
typedef float f32x32v __attribute__((ext_vector_type(32)));
typedef unsigned u32x6v __attribute__((ext_vector_type(6)));
__device__ __forceinline__ u32x6v pack_fp6_32(const float (&e)[32], bool interleaved) {
    f32x16v s0, s1;
    if (interleaved) {
#pragma unroll
        for (int i = 0; i < 16; ++i) { s0[i] = e[2 * i]; s1[i] = e[2 * i + 1]; }
    } else {
#pragma unroll
        for (int i = 0; i < 16; ++i) { s0[i] = e[i]; s1[i] = e[16 + i]; }
    }
    return __builtin_amdgcn_cvt_scalef32_2xpk16_fp6_f32(s0, s1, 1.0f);
}
__device__ __forceinline__ void cvt_table_fp6(const float* src, unsigned char* dst, int nrows, float scale, LAS float* scr  , int lane, int gw, int NGW, const int isv) {
    bool interleaved;
    {
        float t[32];
#pragma unroll
        for (int k = 0; k < 32; ++k) t[k] = k < 16 ? 0.125f * k : (k < 24 ? 2.0f + 0.25f * (k - 16) : 4.0f + 0.5f * (k - 24));
        float tt[32];
#pragma unroll
        for (int k = 0; k < 32; ++k) { tt[k] = t[k]; asm volatile("" : "+v"(tt[k])); }
        const u32x6v p = pack_fp6_32(tt, true);
        const f32x32v o = __builtin_amdgcn_cvt_scalef32_pk32_f32_fp6(p, 1.0f);
        interleaved = (o[1] == t[1]) && (o[2] == t[2]) && (o[17] == t[17]);
        interleaved = __all(interleaved);
    }
#if CVT_PIPE
    f32x4 nx[8];
    if (gw < nrows) { const f32x4* s4 = (const f32x4*)(src + (size_t)gw * 2048);
#pragma unroll
        for (int q = 0; q < 8; ++q) nx[q] = s4[64 * q + lane]; }
    for (int row = gw; row < nrows; row += NGW) {
        f32x4 cur[8];
#pragma unroll
        for (int q = 0; q < 8; ++q) cur[q] = nx[q];
        if (row + NGW < nrows) { const f32x4* s4 = (const f32x4*)(src + (size_t)(row + NGW) * 2048);
#pragma unroll
            for (int q = 0; q < 8; ++q) nx[q] = s4[64 * q + lane]; }
#pragma unroll
        for (int q = 0; q < 8; ++q) { const int s = 64 * q + lane; const f32x4 a = cur[q] * scale; *(LAS f32x4*)(scr + 4 * (s ^ ((s >> 4) & 7))) = a; }
#else
    bool fp4_swapped = false;
    if (PEER_V4) {
        float t0 = 1.0f, t1 = 2.0f; asm volatile("" : "+v"(t0), "+v"(t1));
        const unsigned pw = __builtin_amdgcn_cvt_scalef32_pk_fp4_f32(0u, t0, t1, 1.0f, 0);
        const f32x2v pr = __builtin_amdgcn_cvt_scalef32_pk_f32_fp4(pw, 1.0f, 0);
        fp4_swapped = !__all(pr[0] == 1.0f);
    }
    for (int row = gw; row < nrows; row += NGW) {
        const f32x4* s4 = (const f32x4*)(src + (size_t)row * 2048);
#pragma unroll
        for (int q = 0; q < 8; ++q) { const int s = 64 * q + lane; const f32x4 a = (NT_STREAM ? __builtin_nontemporal_load(&s4[s]) : s4[s]) * scale; *(LAS f32x4*)(scr + 4 * (s ^ ((s >> 4) & 7))) = a; }
#endif
        float e[32];
#pragma unroll
        for (int j = 0; j < 8; ++j) { const int s = 8 * lane + j; const f32x4 a = *(const LAS f32x4*)(scr + 4 * (s ^ ((s >> 4) & 7)));
            e[4 * j + 0] = __builtin_amdgcn_fmed3f(a.x, -7.5f, 7.5f); e[4 * j + 1] = __builtin_amdgcn_fmed3f(a.y, -7.5f, 7.5f); e[4 * j + 2] = __builtin_amdgcn_fmed3f(a.z, -7.5f, 7.5f); e[4 * j + 3] = __builtin_amdgcn_fmed3f(a.w, -7.5f, 7.5f); }
#if EMU_FP4V
        if (EMU_FP4V == 2 ? !isv : isv) {
#pragma unroll
            for (int i = 0; i < 32; ++i) { const float a = fabsf(e[i]); float q = a < 2.0f ? rintf(a * 2.0f) * 0.5f : (a < 4.0f ? rintf(a) : fminf(rintf(a * 0.5f) * 2.0f, 6.0f)); e[i] = copysignf(q, e[i]); }
        }
#endif
        unsigned char* rowp = dst + (size_t)row * PREC;
        if (PEER_V4 && (isv || PEER_U4)) {
            u32x4 w4;
#pragma unroll
            for (int w = 0; w < 4; ++w) { unsigned d = 0u; float x_[8];
#pragma unroll
                for (int i = 0; i < 8; i += 2) { const float x0 = __builtin_amdgcn_fmed3f(e[8 * w + i], -6.0f, 6.0f), x1 = __builtin_amdgcn_fmed3f(e[8 * w + i + 1], -6.0f, 6.0f); x_[i] = fp4_swapped ? x1 : x0; x_[i + 1] = fp4_swapped ? x0 : x1; }
                d = __builtin_amdgcn_cvt_scalef32_pk_fp4_f32(d, x_[0], x_[1], 1.0f, 0); d = __builtin_amdgcn_cvt_scalef32_pk_fp4_f32(d, x_[2], x_[3], 1.0f, 1);
                d = __builtin_amdgcn_cvt_scalef32_pk_fp4_f32(d, x_[4], x_[5], 1.0f, 2); d = __builtin_amdgcn_cvt_scalef32_pk_fp4_f32(d, x_[6], x_[7], 1.0f, 3);
                w4[w] = d; }
            *(u32x4*)(rowp + ((isv || !PEER_U4) ? 1024 : 0) + 16 * lane) = w4;
            continue;
        }
        const u32x6v p = pack_fp6_32(e, interleaved);
        *(u32x4*)(rowp + 1024 * isv + 16 * lane) = (u32x4){p[0], p[1], p[2], p[3]}; *(u32x2*)(rowp + 2048 + 512 * isv + 8 * lane) = (u32x2){p[4], p[5]};
    }
}
__device__ __forceinline__ float silu(float x) { return x / (1.0f + __expf(-x)); }

struct Params { const float* in[29]; float* out; unsigned char* ws; int ph_lo, ph_hi; };
typedef const __attribute__((address_space(4))) Params* CP;

#ifndef P0_NOV
#define P0_NOV 0
#endif
#ifndef TAIL_REMAP
#define TAIL_REMAP 0
#endif
__device__ __forceinline__ void p0_prologue(CP P, LAS unsigned char* lds, int tid, int lane, int wid, int gw, int NGW, const int parts = 7) {
    unsigned char* ws = P->ws;
    LAS float* scr = (LAS float*)(lds + wid * 16384);
    if (parts & 1) {
        constexpr int I_GMIN = (2048 / 64) * (4096 / 32), I_SQ = (2048 / 64) * (2048 / 32), I_MIN = (2048 / 64) * (1088 / 32), I_UQ = (512 / 64) * (3072 / 32), I_UKV = (512 / 64) * (4096 / 32), I_DIN = (2048 / 64) * (6144 / 32);
        constexpr int NIT = 2 * I_GMIN + 2 * I_SQ + 4 * I_SQ + I_MIN + I_UQ + I_UKV + I_SQ + I_DIN + I_SQ;
        for (int it = gw; it < NIT; it += NGW) {
            int r = it;
            if (r < 2 * I_GMIN) { const int j = r / I_GMIN; p0_transpose_item(P->in[13] + (size_t)j * 2048 * 4096, 2048, 4096, (bf16*)(ws + WS_GMWIN) + (size_t)j * 4096 * 2048, scr, r % I_GMIN, lane); continue; } r -= 2 * I_GMIN;
            if (r < 2 * I_SQ) { const int j = r / I_SQ; p0_transpose_item(P->in[18] + (size_t)j * 2048 * 2048, 2048, 2048, (bf16*)(ws + WS_GMWOUT) + (size_t)j * 2048 * 2048, scr, r % I_SQ, lane); continue; } r -= 2 * I_SQ;
            if (r < 4 * I_SQ) { const int j = r / I_SQ; p0_transpose_item(P->in[8] + (size_t)j * 2048 * 2048, 2048, 2048, (bf16*)(ws + WS_PWQ) + (size_t)j * 2048 * 2048, scr, r % I_SQ, lane); continue; } r -= 4 * I_SQ;
            if (r < I_MIN) { p0_transpose_item(P->in[19], 2048, 1088, (bf16*)(ws + WS_MLAIN), scr, r, lane); continue; } r -= I_MIN;
            if (r < I_UQ) { p0_transpose_item(P->in[22], 512, 3072, (bf16*)(ws + WS_MLAUQ), scr, r, lane); continue; } r -= I_UQ;
            if (r < I_UKV) { p0_transpose_item(P->in[23], 512, 4096, (bf16*)(ws + WS_MLAUKV), scr, r, lane); continue; } r -= I_UKV;
            if (r < I_SQ) { p0_transpose_item(P->in[24], 2048, 2048, (bf16*)(ws + WS_MLAOUT), scr, r, lane); continue; } r -= I_SQ;
            if (r < I_DIN) { p0_transpose_item(P->in[25], 2048, 6144, (bf16*)(ws + WS_DAIN), scr, r, lane); continue; } r -= I_DIN;
            p0_transpose_item(P->in[28], 2048, 2048, (bf16*)(ws + WS_DAOUT), scr, r, lane);
        }
    }
    const size_t gtid = (size_t)gw * 64 + lane, gthreads = (size_t)NGW * 64;
    if (parts & 2) {
    { u32x4* z = (u32x4*)((bf16*)(ws + WS_MLAIN) + (size_t)1088 * 2048); const size_t n = (size_t)192 * 2048 / 8;
      for (size_t i = gtid; i < n; i += gthreads) z[i] = (u32x4){0u, 0u, 0u, 0u}; }
    cvt_range(P->in[16], (bf16*)(ws + WS_GMWS), (size_t)2 * 16 * 128 * 128 / 8, gtid, gthreads);
    cvt_range(P->in[9], (bf16*)(ws + WS_PK1), (size_t)4 * 128 * 128 / 8, gtid, gthreads);
    cvt_range(P->in[10], (bf16*)(ws + WS_PK2), (size_t)4 * 128 * 128 / 8, gtid, gthreads);
#if !TAIL_REMAP
    cvt_table_fp6(P->in[11], ws + WS_PU, 16384, U_SCALE, scr, lane, gw, NGW, 0);
    if (!P0_NOV) cvt_table_fp6(P->in[12], ws + WS_PU, 16384, V_SCALE, scr, lane, gw, NGW, 1);
#endif
    if (gtid < 2048) { const int pos = (int)gtid >> 4, f = (int)gtid & 15; const float inv = powf(10000.0f, -(float)f * (1.0f / 16.0f)); float sn, cs; sincosf((float)pos * inv, &sn, &cs);
        float* rt = (float*)(ws + WS_ROPE); rt[gtid] = cs; rt[2048 + gtid] = sn; }
    }
    if (parts & 4) {
        const float* cv = P->in[1]; const float* cc = P->in[3]; const float* mw = P->in[4]; float* PART = (float*)(ws + WS_MODP);
        LAS float* S = (LAS float*)lds;
        __syncthreads();
        { float t_[12];
#pragma unroll
          for (int t = 0; t < 12; ++t) { const int i = tid + t * NWAVES * 64, sl = i >> 11, kk = i & 2047; t_[t] = sl == 0 ? cv[kk] : (sl == 1 ? cv[2048 + kk] : cc[kk]); }
#pragma unroll
          for (int t = 0; t < 12; ++t) S[tid + t * NWAVES * 64] = silu(t_[t]); }
        __syncthreads();
        for (int item = gw; item < 4 * 192 * 8; item += NGW) {
            const int ks = item & 7, r = item >> 3, L = r / 192, n = (r % 192) * 64 + lane;
            const float* W = mw + (size_t)L * 2048 * 12288 + (size_t)(ks * 256) * 12288 + n;
            float a0 = 0.f, a1 = 0.f, a2 = 0.f;
#if GEMV_PIPE
#define GV_LD(dst_, kb_) do { _Pragma("unroll") for (int t = 0; t < 32; ++t) dst_[t] = NT_STREAM ? __builtin_nontemporal_load(&W[(size_t)((kb_) + t) * 12288]) : W[(size_t)((kb_) + t) * 12288]; } while (0)
            float wa[32], wb[32];
            GV_LD(wa, 0);
#pragma unroll 1
            for (int kb = 0; kb < 256; kb += 64) {
                GV_LD(wb, kb + 32);
#pragma unroll
                for (int t = 0; t < 32; ++t) { const int kk = ks * 256 + kb + t; a0 += S[kk] * wa[t]; a1 += S[2048 + kk] * wa[t]; a2 += S[4096 + kk] * wa[t]; }
                if (kb + 64 < 256) GV_LD(wa, kb + 64);
#pragma unroll
                for (int t = 0; t < 32; ++t) { const int kk = ks * 256 + kb + 32 + t; a0 += S[kk] * wb[t]; a1 += S[2048 + kk] * wb[t]; a2 += S[4096 + kk] * wb[t]; }
            }
#undef GV_LD
#else
#pragma unroll 32
            for (int k = 0; k < 256; ++k) { const int kk = ks * 256 + k; const float s0 = S[kk], s1 = S[2048 + kk], s2 = S[4096 + kk];
                const float w = NT_STREAM ? __builtin_nontemporal_load(&W[(size_t)k * 12288]) : W[(size_t)k * 12288]; a0 += s0 * w; a1 += s1 * w; a2 += s2 * w; }
#endif
            float* o = PART + ((size_t)ks * 4 + L) * 3 * 12288 + n;
            o[0] = a0; o[12288] = a1; o[24576] = a2;
        }
    }
}
__device__ __forceinline__ void mod_reduce(CP P, int gw, int lane, int NGW) {
    const float* PART = (const float*)(P->ws + WS_MODP); float* MOD = (float*)(P->ws + WS_MOD); const float* mb = P->in[5];
    for (int i = gw * 64 + lane; i < 4 * 3 * 12288; i += NGW * 64) {
        const int L = i / (3 * 12288), n = i % 12288;
        float s = mb[(size_t)L * 12288 + n];
#pragma unroll
        for (int ks = 0; ks < 8; ++ks) s += PART[(size_t)ks * 4 * 3 * 12288 + i];
        MOD[i] = s;
    }
}

__device__ __forceinline__ void load_row_f32_l(const LAS float* row, int lane, float (&v)[32]) {
#pragma unroll
    for (int j = 0; j < 4; ++j) { const f32x4 a = ((const LAS f32x4*)row)[128 * j + 2 * lane], b = ((const LAS f32x4*)row)[128 * j + 2 * lane + 1];
        v[8 * j + 0] = a.x; v[8 * j + 1] = a.y; v[8 * j + 2] = a.z; v[8 * j + 3] = a.w; v[8 * j + 4] = b.x; v[8 * j + 5] = b.y; v[8 * j + 6] = b.z; v[8 * j + 7] = b.w; }
}
__device__ __forceinline__ void first_row_pass(CP P, LAS unsigned char* lds, int tid, int lane, int gw, int NGW) {
    const float* MOD = (const float*)(P->ws + WS_MOD); bf16* X = (bf16*)(P->ws + WS_X); bf16* H = (bf16*)(P->ws + WS_H);
    LAS float* V = (LAS float*)lds;
    __syncthreads();
    { f32x4 t_[6];
#pragma unroll
      for (int vec = 0; vec < 6; ++vec) t_[vec] = ((const f32x4*)(MOD + (size_t)(vec >> 1) * 12288 + (size_t)(vec & 1) * 2048))[tid];
#pragma unroll
      for (int vec = 0; vec < 6; ++vec) ((LAS f32x4*)V)[vec * 512 + tid] = t_[vec]; }
    __syncthreads();
    for (int row = gw; row < MT; row += NGW) {
        const float* src = row < ML ? P->in[0] + (size_t)row * DM : P->in[2] + (size_t)(row - ML) * DM;
        float v[32]; if (NT_STREAM > 1) load_row_f32_nt(src, lane, v); else load_row_f32(src, lane, v);
        store_row_bf16(X + (size_t)row * DM, lane, v);
        const LAS float* mod = V + row_slot(row) * 4096;
        float mean, rstd; ln_stats(v, mean, rstd);
        float a[32], s[32]; load_row_f32_l(mod + 2048, lane, a); load_row_f32_l(mod, lane, s);
#pragma unroll
        for (int i = 0; i < 32; ++i) a[i] = (v[i] - mean) * rstd * (1.0f + a[i]) + s[i];
        store_row_bf16(H + (size_t)row * DM, lane, a);
    }
}
#ifndef POSTMIX_LDS
#define POSTMIX_LDS 1
#endif
__device__ __forceinline__ void post_mixer_pass_lds(CP P, int L, int Mrows, LAS unsigned char* lds, int tid, int lane, int gw, int NGW) {
    const float* MOD = (const float*)(P->ws + WS_MOD); bf16* X = (bf16*)(P->ws + WS_X); bf16* H = (bf16*)(P->ws + WS_H); const bf16* Y = (const bf16*)(P->ws + WS_Y);
    const float* lng = P->in[6] + (size_t)(L * 2 + 0) * DM; const float* lnb = P->in[7] + (size_t)(L * 2 + 0) * DM;
    LAS float* V = (LAS float*)lds;
    __syncthreads();
    { f32x4 t_[11];
#pragma unroll
      for (int vec = 0; vec < 11; ++vec) { const float* src = vec == 0 ? lng : (vec == 1 ? lnb : MOD + (size_t)(L * 3 + (vec - 2) / 3) * 12288 + (size_t)(2 + (vec - 2) % 3) * 2048);
          t_[vec] = ((const f32x4*)src)[tid]; }
#pragma unroll
      for (int vec = 0; vec < 11; ++vec) ((LAS f32x4*)V)[vec * 512 + tid] = t_[vec]; }
    __syncthreads();
    for (int row = gw; row < Mrows; row += NGW) {
        const LAS float* mv = V + (2 + 3 * row_slot(row)) * 2048;
        float z[32], y[32]; if (NT_ACT) { load_row_bf16_nt(X + (size_t)row * DM, lane, z); load_row_bf16_nt(Y + (size_t)row * DM, lane, y); } else { load_row_bf16(X + (size_t)row * DM, lane, z); load_row_bf16(Y + (size_t)row * DM, lane, y); }
        { float g[32]; load_row_f32_l(mv, lane, g);
#pragma unroll
          for (int i = 0; i < 32; ++i) z[i] = ALPHA * z[i] + g[i] * y[i]; }
        float mean, rstd; ln_stats(z, mean, rstd);
        { float g[32], b[32]; load_row_f32_l(V, lane, g); load_row_f32_l(V + 2048, lane, b);
#pragma unroll
          for (int i = 0; i < 32; ++i) z[i] = (z[i] - mean) * rstd * g[i] + b[i]; }
        store_row_bf16(X + (size_t)row * DM, lane, z);
        ln_stats(z, mean, rstd);
        { float a[32], s_[32]; load_row_f32_l(mv + 2 * 2048, lane, a); load_row_f32_l(mv + 2048, lane, s_);
#pragma unroll
          for (int i = 0; i < 32; ++i) a[i] = (z[i] - mean) * rstd * (1.0f + a[i]) + s_[i];
          store_row_bf16(H + (size_t)row * DM, lane, a); }
    }
}
__device__ __forceinline__ void post_mixer_pass(CP P, int L, int Mrows, int lane, int gw, int NGW) {
    const float* MOD = (const float*)(P->ws + WS_MOD); bf16* X = (bf16*)(P->ws + WS_X); bf16* H = (bf16*)(P->ws + WS_H); const bf16* Y = (const bf16*)(P->ws + WS_Y);
    const float* lng = P->in[6] + (size_t)(L * 2 + 0) * DM; const float* lnb = P->in[7] + (size_t)(L * 2 + 0) * DM;
    for (int row = gw; row < Mrows; row += NGW) {
        const float* mod = MOD + (size_t)(L * 3 + row_slot(row)) * 12288;
        float z[32], y[32], g[32]; load_row_bf16(X + (size_t)row * DM, lane, z); load_row_bf16(Y + (size_t)row * DM, lane, y); load_row_f32(mod + 2 * 2048, lane, g);
#pragma unroll
        for (int i = 0; i < 32; ++i) z[i] = ALPHA * z[i] + g[i] * y[i];
        finish_row<false>(z, lng, lnb, X + (size_t)row * DM, mod + 3 * 2048, mod + 4 * 2048, H + (size_t)row * DM, nullptr, lane);
    }
}
__device__ __forceinline__ void vstats_pass(CP P, int Mrows, int lane, int gw, int NGW) {
    const bf16* Z = (const bf16*)(P->ws + WS_Z); float* VST = (float*)(P->ws + WS_VST);
    for (int row = gw; row < Mrows; row += NGW) {
        float v[32]; load_row_bf16(Z + (size_t)row * 4096 + 2048, lane, v);
        float mean, rstd; ln_stats(v, mean, rstd);
        if (lane == 0) { VST[2 * row] = mean; VST[2 * row + 1] = rstd; }
    }
}
#define XB_TMO      128
#define XB_XCNT(j)  (256  + 64 * (j))
#define XB_XSUB(j)  (1280 + 64 * (j))
#define XB_XGEN(j)  (2304 + 64 * (j))
#define XB_TOP      3328
#define XB_TOPGEN   3392
#define XCD_BAR_WORDS 3456
#define XB_SPIN_CAP (1u << 18)

__device__ __forceinline__ unsigned xb_ld(unsigned* p)              { return __hip_atomic_load(p, __ATOMIC_RELAXED, __HIP_MEMORY_SCOPE_AGENT); }
__device__ __forceinline__ unsigned xb_add(unsigned* p, unsigned v) { return __hip_atomic_fetch_add(p, v, __ATOMIC_RELAXED, __HIP_MEMORY_SCOPE_AGENT); }
__device__ __forceinline__ unsigned xb_xcc_id() { return (unsigned)__builtin_amdgcn_s_getreg((3 << 11) | 20) & 0xFu; }
#define XB_SPIN(cond, bar) do { unsigned _sp = 0; while (cond) { __builtin_amdgcn_s_sleep(1); \
    if ((++_sp & 255u) == 0u) { if (xb_ld(&(bar)[XB_TMO])) break; if (_sp > XB_SPIN_CAP) { atomicAdd(&(bar)[XB_TMO], 1u); break; } } } } while (0)

struct XcdBarrier {
    unsigned* bar; unsigned x;
    volatile LAS unsigned* st;
};

__device__ __forceinline__ XcdBarrier xcd_barrier_post(unsigned* bar, volatile LAS unsigned* st, const bool t0) {
    XcdBarrier b; b.bar = bar; b.x = xb_xcc_id(); b.st = st;
    if (t0) (void)xb_add(&bar[XB_XCNT(b.x)], 1u);
    return b;
}
__device__ __forceinline__ void xcd_barrier_complete(unsigned* bar, unsigned x, unsigned& nloc, unsigned& nx) {
    const unsigned G = gridDim.x * gridDim.y * gridDim.z;
    unsigned sum, cnt, mine, sp = 0u;
    for (;;) {
        sum = 0u; cnt = 0u; mine = 0u;
#pragma unroll
        for (unsigned j = 0; j < 16; ++j) { const unsigned c = xb_ld(&bar[XB_XCNT(j)]); sum += c; cnt += (c > 0u) ? 1u : 0u; mine = (j == x) ? c : mine; }
        if (sum == G) break;
        __builtin_amdgcn_s_sleep(1);
        if ((++sp & 255u) == 0u) { if (xb_ld(&bar[XB_TMO])) break; if (sp > XB_SPIN_CAP) { atomicAdd(&bar[XB_TMO], 1u); break; } }
    }
    nloc = mine > 0u ? mine : 1u; nx = cnt > 0u ? cnt : 1u;
}

__device__ __attribute__((noinline)) void xcd_barrier(const XcdBarrier b, const bool t0) {
    asm volatile("s_waitcnt vmcnt(0)" ::: "memory");
    __syncthreads();
    if (t0) {
        unsigned* bar = b.bar;
        __builtin_amdgcn_s_waitcnt(0);
        unsigned nloc = b.st[0], nx = b.st[1];
        if (nloc == 0u) { xcd_barrier_complete(bar, b.x, nloc, nx); b.st[0] = nloc; b.st[1] = nx; }
        const unsigned old = xb_add(&bar[XB_XSUB(b.x)], 1u);
        const unsigned gen = old / nloc;
        if (old + 1u == (gen + 1u) * nloc) {
            __builtin_amdgcn_fence(__ATOMIC_RELEASE, "agent");
            asm volatile("s_waitcnt vmcnt(0)" ::: "memory");
            const unsigned og = xb_add(&bar[XB_TOP], 1u);
            const unsigned tg = og / nx;
            if (og + 1u == (tg + 1u) * nx) xb_add(&bar[XB_TOPGEN], 1u);
            else XB_SPIN(xb_ld(&bar[XB_TOPGEN]) == tg, bar);
            __builtin_amdgcn_fence(__ATOMIC_ACQUIRE, "agent");
            xb_add(&bar[XB_XGEN(b.x)], 1u);
            asm volatile("s_waitcnt vmcnt(0)" ::: "memory");
        } else {
            XB_SPIN(xb_ld(&bar[XB_XGEN(b.x)]) == gen, bar);
            __builtin_amdgcn_fence(__ATOMIC_ACQUIRE, "agent");
            asm volatile("s_waitcnt vmcnt(0)" ::: "memory");
        }
    }
    __syncthreads();
}

#ifndef SPATIAL_PIPE
#define SPATIAL_PIPE 1
#endif
#if SPATIAL_PIPE
#ifndef SPATIAL_OTILE
#define SPATIAL_OTILE 0
#endif
struct SpReg { u32x4 w[4]; float mean, rstd; bf16x8 a[4]; bf16 uu[SPATIAL_OTILE ? 1 : 32]; u32x4 uq[4]; float bsv[4]; };
__device__ __forceinline__ void sp_load(SpReg& R, const bf16* Z, const float* VST, const bf16* WS, const float* bs, int u, int tid, int lane, int wid) {
    const int c = u >> 4, g = u & 15, fr = lane & 15, fq = lane >> 4;
    { const int q = tid >> 2, dq = (tid & 3) * 32; const int row = c * 128 + q;
      R.mean = VST[2 * row]; R.rstd = VST[2 * row + 1];
      const bf16* src = Z + (size_t)row * 4096 + 2048 + g * 128 + dq;
#pragma unroll
      for (int t = 0; t < 4; ++t) R.w[t] = *(const u32x4*)(src + 8 * t); }
    const bf16* wrow = WS + (size_t)g * 128 * 128 + (size_t)(16 * wid + fr) * 128 + 8 * fq;
#pragma unroll
    for (int ks = 0; ks < 4; ++ks) R.a[ks] = *(const bf16x8*)(wrow + 32 * ks);
#pragma unroll
    for (int r = 0; r < 4; ++r) R.bsv[r] = bs[g * 128 + 16 * wid + fq * 4 + r];
#if SPATIAL_OTILE
#pragma unroll
    for (int t = 0; t < 4; ++t) { const int ch = tid + 512 * t, p = ch >> 4, d8 = (ch & 15) * 8; R.uq[t] = *(const u32x4*)(Z + (size_t)(c * 128 + p) * 4096 + g * 128 + d8); }
    R.uu[0] = 0;
#else
#pragma unroll
    for (int nb = 0; nb < 8; ++nb)
#pragma unroll
        for (int r = 0; r < 4; ++r) { const int p = 16 * wid + fq * 4 + r, d = 16 * nb + fr; R.uu[nb * 4 + r] = Z[(size_t)(c * 128 + p) * 4096 + g * 128 + d]; }
#endif
}
__device__ __forceinline__ void spatial_phase(CP P, int j, int Mrows, LAS unsigned char* lds_, int tid, int lane, int wid) {
    const bf16* Z = (const bf16*)(P->ws + WS_Z); const float* VST = (const float*)(P->ws + WS_VST); bf16* Gb = (bf16*)(P->ws + WS_G);
    const bf16* WS = (const bf16*)(P->ws + WS_GMWS) + (size_t)j * 16 * 128 * 128;
    const float* lng = P->in[14] + (size_t)j * DM; const float* lnb = P->in[15] + (size_t)j * DM; const float* bs = P->in[17] + (size_t)j * 16 * 128;
    LAS bf16* Vt = (LAS bf16*)(LAS unsigned char*)lds_;
    constexpr int VP = 136;
    const int nunits = (Mrows / 128) * 16;
    LAS float* LNl = (LAS float*)(lds_ + 36864);
    __syncthreads();
    { const f32x4 t0_ = ((const f32x4*)lng)[tid], t1_ = ((const f32x4*)lnb)[tid]; ((LAS f32x4*)LNl)[tid] = t0_; ((LAS f32x4*)LNl)[512 + tid] = t1_; }
    LAS float* Ot = (LAS float*)(lds_ + 53248);
    (void)Ot;
    SpReg nx;
    if ((int)blockIdx.x < nunits) sp_load(nx, Z, VST, WS, bs, blockIdx.x, tid, lane, wid);
    for (int u = blockIdx.x; u < nunits; u += gridDim.x) {
        const int c = u >> 4, g = u & 15;
        const SpReg cur = nx;
        if (u + (int)gridDim.x < nunits) sp_load(nx, Z, VST, WS, bs, u + gridDim.x, tid, lane, wid);
        __syncthreads();
        {
            const int q = tid >> 2, dq = (tid & 3) * 32;
#pragma unroll
            for (int t = 0; t < 4; ++t) { const u32x4 w = cur.w[t];
                float v[8] = {bflo(w.x), bfhi(w.x), bflo(w.y), bfhi(w.y), bflo(w.z), bfhi(w.z), bflo(w.w), bfhi(w.w)};
                const LAS float* gp = LNl + g * 128 + dq + 8 * t; const LAS float* bp = LNl + 2048 + g * 128 + dq + 8 * t;
#pragma unroll
                for (int i = 0; i < 8; ++i) { const float vn = (v[i] - cur.mean) * cur.rstd * gp[i] + bp[i]; Vt[(dq + 8 * t + i) * VP + (q ^ ((tid & 3) << 4))] = tobf1(vn); } }
        }
        __syncthreads();
        const int fr = lane & 15, fq = lane >> 4;
#pragma unroll
        for (int nb = 0; nb < 8; ++nb) {
            f32x4 acc = {0.f, 0.f, 0.f, 0.f};
#pragma unroll
            for (int ks = 0; ks < 4; ++ks) { const bf16x8 b = *(const LAS bf16x8*)(Vt + (16 * nb + fr) * VP + 8 * ((4 * ks + fq) ^ ((nb >> 1) << 1)));
                acc = __builtin_amdgcn_mfma_f32_16x16x32_bf16(cur.a[ks], b, acc, 0, 0, 0); }
#if SPATIAL_OTILE
#pragma unroll
            for (int r = 0; r < 4; ++r) Ot[(16 * wid + fq * 4 + r) * 132 + 16 * nb + fr] = acc[r] + cur.bsv[r];
#else
#pragma unroll
            for (int r = 0; r < 4; ++r) { const int p = 16 * wid + fq * 4 + r, d = 16 * nb + fr; const size_t grow = (size_t)(c * 128 + p);
                const float sv = acc[r] + cur.bsv[r];
                const float uu = bf1(cur.uu[nb * 4 + r]);
                Gb[grow * 2048 + g * 128 + d] = tobf1(uu * sv); }
#endif
        }
#if SPATIAL_OTILE
        __syncthreads();
#pragma unroll
        for (int t = 0; t < 4; ++t) { const int ch = tid + 512 * t, p = ch >> 4, d8 = (ch & 15) * 8;
            const LAS f32x4* op = (const LAS f32x4*)(Ot + p * 132 + d8); const f32x4 s0 = op[0], s1 = op[1]; const u32x4 uw = cur.uq[t];
            u32x4 o; o.x = cvtpk(bflo(uw.x) * s0.x, bfhi(uw.x) * s0.y); o.y = cvtpk(bflo(uw.y) * s0.z, bfhi(uw.y) * s0.w); o.z = cvtpk(bflo(uw.z) * s1.x, bfhi(uw.z) * s1.y); o.w = cvtpk(bflo(uw.w) * s1.z, bfhi(uw.w) * s1.w);
            *(u32x4*)(Gb + (size_t)(c * 128 + p) * 2048 + g * 128 + d8) = o; }
#endif
    }
}
#else
__device__ __forceinline__ void spatial_phase(CP P, int j, int Mrows, LAS unsigned char* lds_, int tid, int lane, int wid) {
    const bf16* Z = (const bf16*)(P->ws + WS_Z); const float* VST = (const float*)(P->ws + WS_VST); bf16* Gb = (bf16*)(P->ws + WS_G);
    const bf16* WS = (const bf16*)(P->ws + WS_GMWS) + (size_t)j * 16 * 128 * 128;
    const float* lng = P->in[14] + (size_t)j * DM; const float* lnb = P->in[15] + (size_t)j * DM; const float* bs = P->in[17] + (size_t)j * 16 * 128;
    LAS bf16* Vt = (LAS bf16*)(LAS unsigned char*)lds_;
    constexpr int VP = 136;
    const int nunits = (Mrows / 128) * 16;
    for (int u = blockIdx.x; u < nunits; u += gridDim.x) {
        const int c = u >> 4, g = u & 15;
        __syncthreads();
        {
            const int q = tid >> 2, dq = (tid & 3) * 32; const int row = c * 128 + q;
            const float mean = VST[2 * row], rstd = VST[2 * row + 1];
            const bf16* src = Z + (size_t)row * 4096 + 2048 + g * 128 + dq;
#pragma unroll
            for (int t = 0; t < 4; ++t) { const u32x4 w = *(const u32x4*)(src + 8 * t);
                float v[8] = {bflo(w.x), bfhi(w.x), bflo(w.y), bfhi(w.y), bflo(w.z), bfhi(w.z), bflo(w.w), bfhi(w.w)};
                const float* gp = lng + g * 128 + dq + 8 * t; const float* bp = lnb + g * 128 + dq + 8 * t;
#pragma unroll
                for (int i = 0; i < 8; ++i) { const float vn = (v[i] - mean) * rstd * gp[i] + bp[i]; Vt[(dq + 8 * t + i) * VP + q] = tobf1(vn); } }
        }
        __syncthreads();
        const int fr = lane & 15, fq = lane >> 4;
        bf16x8 a[4];
        const bf16* wrow = WS + (size_t)g * 128 * 128 + (size_t)(16 * wid + fr) * 128 + 8 * fq;
#pragma unroll
        for (int ks = 0; ks < 4; ++ks) a[ks] = *(const bf16x8*)(wrow + 32 * ks);
#pragma unroll
        for (int nb = 0; nb < 8; ++nb) {
            f32x4 acc = {0.f, 0.f, 0.f, 0.f};
#pragma unroll
            for (int ks = 0; ks < 4; ++ks) { const bf16x8 b = *(const LAS bf16x8*)(Vt + (16 * nb + fr) * VP + 32 * ks + 8 * fq);
                acc = __builtin_amdgcn_mfma_f32_16x16x32_bf16(a[ks], b, acc, 0, 0, 0); }
#pragma unroll
            for (int r = 0; r < 4; ++r) { const int p = 16 * wid + fq * 4 + r, d = 16 * nb + fr; const size_t grow = (size_t)(c * 128 + p);
                const float sv = acc[r] + bs[g * 128 + p];
                const float uu = bf1(Z[grow * 4096 + g * 128 + d]);
                Gb[grow * 2048 + g * 128 + d] = tobf1(uu * sv); }
        }
    }
}
#endif

__device__ __forceinline__ void rope_cs(int row, int l, float& cs, float& sn) {
    const int t = row & (SEQ - 1); const int pos = (l & 32) ? (t & 63) : (t >> 6);
    const float inv = powf(10000.0f, -(float)(l & 15) * (1.0f / 16.0f));
    const float ang = (float)pos * inv; sincosf(ang, &sn, &cs);
}
__device__ __forceinline__ float rope_apply(float x, int l, float cs, float sn) {
    const float p = lane_xor16(x, l);
    return (l & 16) ? (p * sn + x * cs) : (x * cs - p * sn);
}
__device__ __forceinline__ void mla_norm_pass(CP P, int lane, int gw, int NGW) {
    const bf16* C = (const bf16*)(P->ws + WS_C); bf16* CQN = (bf16*)(P->ws + WS_CQN); bf16* CKVN = (bf16*)(P->ws + WS_CKVN); bf16* KR = (bf16*)(P->ws + WS_KR);
    const float* qn = P->in[20]; const float* kvn = P->in[21];
    for (int row = gw; row < MT; row += NGW) {
        const bf16* c = C + (size_t)row * 1280;
#pragma unroll
        for (int part = 0; part < 2; ++part) {
            const u32x4 w = *(const u32x4*)(c + part * 512 + 8 * lane);
            float v[8] = {bflo(w.x), bfhi(w.x), bflo(w.y), bfhi(w.y), bflo(w.z), bfhi(w.z), bflo(w.w), bfhi(w.w)};
            float ss = 0.f;
#pragma unroll
            for (int i = 0; i < 8; ++i) ss += v[i] * v[i];
            const float r = 1.0f / sqrtf(wave_sum(ss) * (1.0f / 512.0f) + LN_EPS);
            const float* nw = (part ? kvn : qn) + 8 * lane;
            u32x4 o; o.x = cvtpk(v[0] * r * nw[0], v[1] * r * nw[1]); o.y = cvtpk(v[2] * r * nw[2], v[3] * r * nw[3]); o.z = cvtpk(v[4] * r * nw[4], v[5] * r * nw[5]); o.w = cvtpk(v[6] * r * nw[6], v[7] * r * nw[7]);
            *(u32x4*)((part ? CKVN : CQN) + (size_t)row * 512 + 8 * lane) = o;
        }
        float x = bf1(c[1024 + lane]);
        if (row < ML) { float cs, sn; rope_cs(row, lane, cs, sn); x = rope_apply(x, lane, cs, sn); }
        KR[(size_t)row * 64 + lane] = tobf1(x);
    }
}
__device__ __forceinline__ void rope_pass(bf16* buf, int ld, int col0, int nchunks, int cstride, int lane, int gw, int NGW) {
    for (int row = gw; row < ML; row += NGW) {
        float cs, sn; rope_cs(row, lane, cs, sn);
        bf16* r = buf + (size_t)row * ld + col0 + lane;
#pragma unroll 4
        for (int k = 0; k < nchunks; ++k) { const float x = bf1(r[k * cstride]); r[k * cstride] = tobf1(rope_apply(x, lane, cs, sn)); }
    }
}

namespace att {
#ifndef ATT_DA_NQR
#define ATT_DA_NQR 4
#endif
#ifndef ATT_LEAN0
#define ATT_LEAN0 0
#endif
#ifndef ATT_LEAN
#define ATT_LEAN 1
#endif
#ifndef ATT_3STAGE
#define ATT_3STAGE 0
#endif
#ifndef ATT_QLATE
#define ATT_QLATE 1
#endif
#ifndef ATT_PRIO
#define ATT_PRIO 1
#endif
#ifndef ATT_KMAJOR
#define ATT_KMAJOR 0
#endif
#ifndef ATT_TRB
#define ATT_TRB 1
#endif
#ifndef ATT_STAGGER
#define ATT_STAGGER 0
#endif
#ifndef ATT_SDEPTH
#define ATT_SDEPTH(MODE) ((MODE) == 0 ? 1 : 1)
#endif
#ifndef ATT_PVPIPE
#define ATT_PVPIPE(MODE) ((MODE) == 1)
#endif
#define SBAR() __builtin_amdgcn_sched_barrier(0)
__device__ __forceinline__ int crow(int r, int hi) { return (r & 3) + 8 * (r >> 2) + 4 * hi; }
__device__ __forceinline__ unsigned cvtpkv(float lo, float hi) { unsigned r; asm volatile("v_cvt_pk_bf16_f32 %0, %1, %2" : "=v"(r) : "v"(lo), "v"(hi)); return r; }

__device__ __forceinline__ void partialSM(f32x16& p0, f32x16& p1, float& m_reg, float& mn, float& alpha, const float C, const float THRS) {
  float pmax = p0[0];
#pragma unroll
  for (int r = 1; r < 16; ++r) pmax = fmaxf(pmax, p0[r]);
#pragma unroll
  for (int r = 0; r < 16; ++r) pmax = fmaxf(pmax, p1[r]);
  { auto rr = __builtin_amdgcn_permlane32_swap(__float_as_uint(pmax), __float_as_uint(pmax), false, false);
    pmax = fmaxf(__uint_as_float(rr[0]), __uint_as_float(rr[1])); }
  if (__builtin_expect(__all(pmax - m_reg <= THRS), 1)) { mn = m_reg; alpha = 1.f; }
  else { mn = fmaxf(m_reg, pmax); alpha = __builtin_amdgcn_exp2f((m_reg - mn) * C); m_reg = mn; }
  const float mnC = -mn * C;
#pragma unroll
  for (int r = 0; r < 16; ++r) p0[r] = fmaf(p0[r], C, mnC);
#pragma unroll
  for (int r = 0; r < 16; ++r) p1[r] = fmaf(p1[r], C, mnC);
#pragma unroll
  for (int r = 0; r < 16; ++r) p0[r] = __builtin_amdgcn_exp2f(p0[r]);
}
__device__ __forceinline__ void finishSM(f32x16& p0, f32x16& p1, float alpha, float& l_reg, bf16x8& pa0, bf16x8& pa1, bf16x8& pa2, bf16x8& pa3) {
#pragma unroll
  for (int r = 0; r < 16; ++r) p1[r] = __builtin_amdgcn_exp2f(p1[r]);
  float ps = 0;
#pragma unroll
  for (int r = 0; r < 16; ++r) ps += p0[r];
#pragma unroll
  for (int r = 0; r < 16; ++r) ps += p1[r];
  { auto rr = __builtin_amdgcn_permlane32_swap(__float_as_uint(ps), __float_as_uint(ps), false, false);
    ps = __uint_as_float(rr[0]) + __uint_as_float(rr[1]); }
  l_reg = l_reg * alpha + ps;
#define PK4(P, BASE, OUT) do { unsigned a0 = cvtpkv(P[BASE + 0], P[BASE + 1]), a1 = cvtpkv(P[BASE + 2], P[BASE + 3]);   \
    unsigned b0 = cvtpkv(P[BASE + 4], P[BASE + 5]), b1 = cvtpkv(P[BASE + 6], P[BASE + 7]);                              \
    auto r0 = __builtin_amdgcn_permlane32_swap(a0, b0, false, false); auto r1 = __builtin_amdgcn_permlane32_swap(a1, b1, false, false); \
    u32x4 w = {r0[0], r1[0], r0[1], r1[1]}; OUT = *reinterpret_cast<bf16x8*>(&w); } while (0)
  PK4(p0, 0, pa0); PK4(p0, 8, pa1); PK4(p1, 0, pa2); PK4(p1, 8, pa3);
#undef PK4
}
__device__ __forceinline__ void partialSM_lean(f32x16& p0, f32x16& p1, f32x16& nm, float& alpha, const bool first) {
  constexpr float THR2 = 11.541560327111707f;
  float dmax = p0[0];
#pragma unroll
  for (int r = 1; r < 16; ++r) dmax = fmaxf(dmax, p0[r]);
#pragma unroll
  for (int r = 0; r < 16; ++r) dmax = fmaxf(dmax, p1[r]);
  { auto rr = __builtin_amdgcn_permlane32_swap(__float_as_uint(dmax), __float_as_uint(dmax), false, false);
    dmax = fmaxf(__uint_as_float(rr[0]), __uint_as_float(rr[1])); }
  alpha = 1.f;
  if (first || !__all(dmax <= THR2)) {
    const float delta = first ? dmax : (dmax > THR2 ? dmax : 0.f);
    if (!first) alpha = __builtin_amdgcn_exp2f(-delta);
#pragma unroll
    for (int r = 0; r < 16; ++r) { p0[r] -= delta; p1[r] -= delta; nm[r] -= delta; }
  }
#pragma unroll
  for (int r = 0; r < 16; ++r) p0[r] = __builtin_amdgcn_exp2f(p0[r]);
}
__device__ __forceinline__ void finishSM_lean(f32x16& p0, f32x16& p1, bf16x8& pa0, bf16x8& pa1, bf16x8& pa2, bf16x8& pa3) {
#pragma unroll
  for (int r = 0; r < 16; ++r) p1[r] = __builtin_amdgcn_exp2f(p1[r]);
#define PK4(P, BASE, OUT) do { unsigned a0 = cvtpkv(P[BASE + 0], P[BASE + 1]), a1 = cvtpkv(P[BASE + 2], P[BASE + 3]);   \
    unsigned b0 = cvtpkv(P[BASE + 4], P[BASE + 5]), b1 = cvtpkv(P[BASE + 6], P[BASE + 7]);                              \
    auto r0 = __builtin_amdgcn_permlane32_swap(a0, b0, false, false); auto r1 = __builtin_amdgcn_permlane32_swap(a1, b1, false, false); \
    u32x4 w = {r0[0], r1[0], r0[1], r1[1]}; OUT = *reinterpret_cast<bf16x8*>(&w); } while (0)
  PK4(p0, 0, pa0); PK4(p0, 8, pa1); PK4(p1, 0, pa2); PK4(p1, 8, pa3);
#undef PK4
}
__device__ __forceinline__ bf16x8 scale_bf16x8(bf16x8 v, float c) {
  const u32x4 w = *reinterpret_cast<u32x4*>(&v); u32x4 o;
  o.x = cvtpk(bflo(w.x) * c, bfhi(w.x) * c); o.y = cvtpk(bflo(w.y) * c, bfhi(w.y) * c); o.z = cvtpk(bflo(w.z) * c, bfhi(w.z) * c); o.w = cvtpk(bflo(w.w) * c, bfhi(w.w) * c);
  return *reinterpret_cast<bf16x8*>(&o);
}
template <int PITCH> __device__ __forceinline__ int kswz(int r) { return PITCH == 256 ? (r & 15) : ((r >> 1) & 7); }
template <int NQF, int NQR, int PITCH> __device__ __forceinline__ void qkt(f32x16& p0, f32x16& p1, const LAS char* Ks, int chunk0, const bf16x8* qr, const LAS char* ql, int r32, int hi, const f32x16 init = f32x16{}) {
  p0 = init; p1 = init;
  const int sw = kswz<PITCH>(r32);
#pragma unroll
  for (int d0 = 0; d0 < NQF; ++d0) { const int off = ((chunk0 + d0 * 2 + hi) ^ sw) * 16;
    const bf16x8 b0 = *(const LAS bf16x8*)(Ks + r32 * PITCH + off);
    const bf16x8 b1 = *(const LAS bf16x8*)(Ks + (32 + r32) * PITCH + off);
    const bf16x8 q = d0 < NQR ? qr[d0 < NQR ? d0 : 0] : *(const LAS bf16x8*)(ql + (d0 - NQR < 0 ? 0 : d0 - NQR) * 1024);
    p0 = __builtin_amdgcn_mfma_f32_32x32x16_bf16(b0, q, p0, 0, 0, 0);
    p1 = __builtin_amdgcn_mfma_f32_32x32x16_bf16(b1, q, p1, 0, 0, 0); }
}
__device__ __forceinline__ int v_st(int k, int c) { const int kk = (k & ~0xC) | ((k & 4) << 1) | ((k & 8) >> 1); return ((kk >> 3) * 4 + (c >> 5)) * 512 + ((kk & 7) * 32 + (c & 31)) * 2; }
__device__ __forceinline__ int v_rd_base(int lane) { return ((lane & 3) << 3) | (((lane >> 2) & 3) << 6) | (((lane >> 4) & 1) << 5) | (((lane >> 5) & 1) << 8); }
constexpr int v_rd_off(int d0, int ks, int half) { return d0 * 512 + ks * 4096 + half * 2048; }
template <int OFF> __device__ __forceinline__ s16x4 tr_read(int vb) {
  s16x4 r; asm volatile("ds_read_b64_tr_b16 %0, %1 offset:%2" : "=&v"(r) : "v"(vb), "i"(OFF) : "memory"); return r;
}
template <int D0> __device__ __forceinline__ void pv_one(f32x16& od, int vb, bf16x8 pa0, bf16x8 pa1, bf16x8 pa2, bf16x8 pa3) {
  const s16x4 l0 = tr_read<v_rd_off(D0, 0, 0)>(vb), h0 = tr_read<v_rd_off(D0, 0, 1)>(vb), l1 = tr_read<v_rd_off(D0, 1, 0)>(vb), h1 = tr_read<v_rd_off(D0, 1, 1)>(vb);
  const s16x4 l2 = tr_read<v_rd_off(D0, 2, 0)>(vb), h2 = tr_read<v_rd_off(D0, 2, 1)>(vb), l3 = tr_read<v_rd_off(D0, 3, 0)>(vb), h3 = tr_read<v_rd_off(D0, 3, 1)>(vb);
  asm volatile("s_waitcnt lgkmcnt(0)" ::: "memory"); SBAR();
#define PK(L, H) (bf16x8){L[0], L[1], L[2], L[3], H[0], H[1], H[2], H[3]}
  od = __builtin_amdgcn_mfma_f32_32x32x16_bf16(pa0, PK(l0, h0), od, 0, 0, 0);
  od = __builtin_amdgcn_mfma_f32_32x32x16_bf16(pa1, PK(l1, h1), od, 0, 0, 0);
  od = __builtin_amdgcn_mfma_f32_32x32x16_bf16(pa2, PK(l2, h2), od, 0, 0, 0);
  od = __builtin_amdgcn_mfma_f32_32x32x16_bf16(pa3, PK(l3, h3), od, 0, 0, 0);
#undef PK
}
__device__ __forceinline__ void pv_d0(f32x16* o, int vb, bf16x8 pa0, bf16x8 pa1, bf16x8 pa2, bf16x8 pa3) {
  pv_one<0>(o[0], vb, pa0, pa1, pa2, pa3); pv_one<1>(o[1], vb, pa0, pa1, pa2, pa3); pv_one<2>(o[2], vb, pa0, pa1, pa2, pa3); pv_one<3>(o[3], vb, pa0, pa1, pa2, pa3);
}
struct VFrag { s16x4 l0, h0, l1, h1, l2, h2, l3, h3; };
typedef short v4i16_t __attribute__((ext_vector_type(4)));
template <int OFF> __device__ __forceinline__ s16x4 tr_read_b(int vb) {
  return __builtin_bit_cast(s16x4, __builtin_amdgcn_ds_read_tr16_b64_v4i16((LAS v4i16_t*)(uintptr_t)(unsigned)(vb + OFF)));
}
template <int D0> __device__ __forceinline__ void tr8b(VFrag& f, int vb) {
  f.l0 = tr_read_b<v_rd_off(D0, 0, 0)>(vb); f.h0 = tr_read_b<v_rd_off(D0, 0, 1)>(vb); f.l1 = tr_read_b<v_rd_off(D0, 1, 0)>(vb); f.h1 = tr_read_b<v_rd_off(D0, 1, 1)>(vb);
  f.l2 = tr_read_b<v_rd_off(D0, 2, 0)>(vb); f.h2 = tr_read_b<v_rd_off(D0, 2, 1)>(vb); f.l3 = tr_read_b<v_rd_off(D0, 3, 0)>(vb); f.h3 = tr_read_b<v_rd_off(D0, 3, 1)>(vb);
}
template <int D0> __device__ __forceinline__ void tr8(VFrag& f, int vb) {
  f.l0 = tr_read<v_rd_off(D0, 0, 0)>(vb); f.h0 = tr_read<v_rd_off(D0, 0, 1)>(vb); f.l1 = tr_read<v_rd_off(D0, 1, 0)>(vb); f.h1 = tr_read<v_rd_off(D0, 1, 1)>(vb);
  f.l2 = tr_read<v_rd_off(D0, 2, 0)>(vb); f.h2 = tr_read<v_rd_off(D0, 2, 1)>(vb); f.l3 = tr_read<v_rd_off(D0, 3, 0)>(vb); f.h3 = tr_read<v_rd_off(D0, 3, 1)>(vb);
}
__device__ __forceinline__ void mfma4(f32x16& od, VFrag& f, bf16x8 pa0, bf16x8 pa1, bf16x8 pa2, bf16x8 pa3) {
#define PK(L, H) (bf16x8){L[0], L[1], L[2], L[3], H[0], H[1], H[2], H[3]}
  od = __builtin_amdgcn_mfma_f32_32x32x16_bf16(pa0, PK(f.l0, f.h0), od, 0, 0, 0);
  od = __builtin_amdgcn_mfma_f32_32x32x16_bf16(pa1, PK(f.l1, f.h1), od, 0, 0, 0);
  od = __builtin_amdgcn_mfma_f32_32x32x16_bf16(pa2, PK(f.l2, f.h2), od, 0, 0, 0);
  od = __builtin_amdgcn_mfma_f32_32x32x16_bf16(pa3, PK(f.l3, f.h3), od, 0, 0, 0);
#undef PK
}
#define VF_TIE(f) "+v"(f.l0), "+v"(f.h0), "+v"(f.l1), "+v"(f.h1), "+v"(f.l2), "+v"(f.h2), "+v"(f.l3), "+v"(f.h3)
__device__ __forceinline__ void pv_pipe(f32x16* o, int vb, bf16x8 pa0, bf16x8 pa1, bf16x8 pa2, bf16x8 pa3) {
  VFrag A, B;
  asm volatile("s_waitcnt lgkmcnt(0)" ::: "memory");
  tr8<0>(A, vb); tr8<1>(B, vb);
  asm volatile("s_waitcnt lgkmcnt(8)" : VF_TIE(A) :: "memory");
  mfma4(o[0], A, pa0, pa1, pa2, pa3);
  tr8<2>(A, vb);
  asm volatile("s_waitcnt lgkmcnt(8)" : VF_TIE(B) :: "memory");
  mfma4(o[1], B, pa0, pa1, pa2, pa3);
  tr8<3>(B, vb);
  asm volatile("s_waitcnt lgkmcnt(8)" : VF_TIE(A) :: "memory");
  mfma4(o[2], A, pa0, pa1, pa2, pa3);
  asm volatile("s_waitcnt lgkmcnt(0)" : VF_TIE(B) :: "memory");
  mfma4(o[3], B, pa0, pa1, pa2, pa3);
}
__device__ __forceinline__ void pv_psm_lean(f32x16* o, int vb, bf16x8 pa0, bf16x8 pa1, bf16x8 pa2, bf16x8 pa3, f32x16& p0, f32x16& p1, f32x16& nm, float& alpha) {
  constexpr float THR2 = 11.541560327111707f;
  const bf16x8 one8 = {0x3F80, 0x3F80, 0x3F80, 0x3F80, 0x3F80, 0x3F80, 0x3F80, 0x3F80};
  VFrag A, B;
  asm volatile("s_waitcnt lgkmcnt(0)" ::: "memory");
  tr8<0>(A, vb); tr8<1>(B, vb);
  asm volatile("s_waitcnt lgkmcnt(8)" : VF_TIE(A) :: "memory");
  mfma4(o[0], A, pa0, pa1, pa2, pa3);
  float dmax = p0[0];
#pragma unroll
  for (int r = 1; r < 16; ++r) dmax = fmaxf(dmax, p0[r]);
  tr8<2>(A, vb);
  asm volatile("s_waitcnt lgkmcnt(8)" : VF_TIE(B) :: "memory");
  mfma4(o[1], B, pa0, pa1, pa2, pa3);
#pragma unroll
  for (int r = 0; r < 16; ++r) dmax = fmaxf(dmax, p1[r]);
  { auto rr = __builtin_amdgcn_permlane32_swap(__float_as_uint(dmax), __float_as_uint(dmax), false, false);
    dmax = fmaxf(__uint_as_float(rr[0]), __uint_as_float(rr[1])); }
  alpha = 1.f;
  if (!__all(dmax <= THR2)) {
    const float delta = dmax > THR2 ? dmax : 0.f; alpha = __builtin_amdgcn_exp2f(-delta);
#pragma unroll
    for (int r = 0; r < 16; ++r) { p0[r] -= delta; p1[r] -= delta; nm[r] -= delta; }
  }
  tr8<3>(B, vb);
  asm volatile("s_waitcnt lgkmcnt(8)" : VF_TIE(A) :: "memory");
  mfma4(o[2], A, pa0, pa1, pa2, pa3);
#pragma unroll
  for (int r = 0; r < 8; ++r) p0[r] = __builtin_amdgcn_exp2f(p0[r]);
  asm volatile("s_waitcnt lgkmcnt(0)" : VF_TIE(B) :: "memory");
  mfma4(o[3], B, pa0, pa1, pa2, pa3);
#pragma unroll
  for (int r = 8; r < 16; ++r) p0[r] = __builtin_amdgcn_exp2f(p0[r]);
  o[4] = __builtin_amdgcn_mfma_f32_32x32x16_bf16(pa0, one8, o[4], 0, 0, 0); o[4] = __builtin_amdgcn_mfma_f32_32x32x16_bf16(pa1, one8, o[4], 0, 0, 0);
  o[4] = __builtin_amdgcn_mfma_f32_32x32x16_bf16(pa2, one8, o[4], 0, 0, 0); o[4] = __builtin_amdgcn_mfma_f32_32x32x16_bf16(pa3, one8, o[4], 0, 0, 0);
}
__device__ __forceinline__ void pv_psm_lean_b(f32x16* o, int vb, bf16x8 pa0, bf16x8 pa1, bf16x8 pa2, bf16x8 pa3, f32x16& p0, f32x16& p1, f32x16& nm, float& alpha) {
  constexpr float THR2 = 11.541560327111707f;
  const bf16x8 one8 = {0x3F80, 0x3F80, 0x3F80, 0x3F80, 0x3F80, 0x3F80, 0x3F80, 0x3F80};
  VFrag A, B;
  tr8b<0>(A, vb); tr8b<1>(B, vb);
  mfma4(o[0], A, pa0, pa1, pa2, pa3);
  float dmax = p0[0];
#pragma unroll
  for (int r = 1; r < 16; ++r) dmax = fmaxf(dmax, p0[r]);
  tr8b<2>(A, vb);
  mfma4(o[1], B, pa0, pa1, pa2, pa3);
#pragma unroll
  for (int r = 0; r < 16; ++r) dmax = fmaxf(dmax, p1[r]);
  { auto rr = __builtin_amdgcn_permlane32_swap(__float_as_uint(dmax), __float_as_uint(dmax), false, false);
    dmax = fmaxf(__uint_as_float(rr[0]), __uint_as_float(rr[1])); }
  alpha = 1.f;
  if (!__all(dmax <= THR2)) {
    const float delta = dmax > THR2 ? dmax : 0.f; alpha = __builtin_amdgcn_exp2f(-delta);
#pragma unroll
    for (int r = 0; r < 16; ++r) { p0[r] -= delta; p1[r] -= delta; nm[r] -= delta; }
  }
  tr8b<3>(B, vb);
  mfma4(o[2], A, pa0, pa1, pa2, pa3);
#pragma unroll
  for (int r = 0; r < 8; ++r) p0[r] = __builtin_amdgcn_exp2f(p0[r]);
  mfma4(o[3], B, pa0, pa1, pa2, pa3);
#pragma unroll
  for (int r = 8; r < 16; ++r) p0[r] = __builtin_amdgcn_exp2f(p0[r]);
  o[4] = __builtin_amdgcn_mfma_f32_32x32x16_bf16(pa0, one8, o[4], 0, 0, 0); o[4] = __builtin_amdgcn_mfma_f32_32x32x16_bf16(pa1, one8, o[4], 0, 0, 0);
  o[4] = __builtin_amdgcn_mfma_f32_32x32x16_bf16(pa2, one8, o[4], 0, 0, 0); o[4] = __builtin_amdgcn_mfma_f32_32x32x16_bf16(pa3, one8, o[4], 0, 0, 0);
}
struct VStep { s16x4 l0, h0, l1, h1, l2, h2, l3, h3; };
template <int KS> __device__ __forceinline__ void trstep(VStep& f, int vb) {
  f.l0 = tr_read_b<v_rd_off(0, KS, 0)>(vb); f.h0 = tr_read_b<v_rd_off(0, KS, 1)>(vb); f.l1 = tr_read_b<v_rd_off(1, KS, 0)>(vb); f.h1 = tr_read_b<v_rd_off(1, KS, 1)>(vb);
  f.l2 = tr_read_b<v_rd_off(2, KS, 0)>(vb); f.h2 = tr_read_b<v_rd_off(2, KS, 1)>(vb); f.l3 = tr_read_b<v_rd_off(3, KS, 0)>(vb); f.h3 = tr_read_b<v_rd_off(3, KS, 1)>(vb);
}
__device__ __forceinline__ void mfma5(f32x16* o, const VStep& f, bf16x8 pa) {
  const bf16x8 one8 = {0x3F80, 0x3F80, 0x3F80, 0x3F80, 0x3F80, 0x3F80, 0x3F80, 0x3F80};
#define PK(L, H) (bf16x8){L[0], L[1], L[2], L[3], H[0], H[1], H[2], H[3]}
  o[0] = __builtin_amdgcn_mfma_f32_32x32x16_bf16(pa, PK(f.l0, f.h0), o[0], 0, 0, 0);
  o[1] = __builtin_amdgcn_mfma_f32_32x32x16_bf16(pa, PK(f.l1, f.h1), o[1], 0, 0, 0);
  o[2] = __builtin_amdgcn_mfma_f32_32x32x16_bf16(pa, PK(f.l2, f.h2), o[2], 0, 0, 0);
  o[3] = __builtin_amdgcn_mfma_f32_32x32x16_bf16(pa, PK(f.l3, f.h3), o[3], 0, 0, 0);
  o[4] = __builtin_amdgcn_mfma_f32_32x32x16_bf16(pa, one8, o[4], 0, 0, 0);
#undef PK
}
template <int BASE> __device__ __forceinline__ bf16x8 pk4e(const f32x16& P) {
  const float e0 = __builtin_amdgcn_exp2f(P[BASE + 0]), e1 = __builtin_amdgcn_exp2f(P[BASE + 1]), e2 = __builtin_amdgcn_exp2f(P[BASE + 2]), e3 = __builtin_amdgcn_exp2f(P[BASE + 3]);
  const float e4 = __builtin_amdgcn_exp2f(P[BASE + 4]), e5 = __builtin_amdgcn_exp2f(P[BASE + 5]), e6 = __builtin_amdgcn_exp2f(P[BASE + 6]), e7 = __builtin_amdgcn_exp2f(P[BASE + 7]);
  const unsigned a0 = cvtpk(e0, e1), a1 = cvtpk(e2, e3), b0 = cvtpk(e4, e5), b1 = cvtpk(e6, e7);
  const auto r0 = __builtin_amdgcn_permlane32_swap(a0, b0, false, false); const auto r1 = __builtin_amdgcn_permlane32_swap(a1, b1, false, false);
  u32x4 w = {r0[0], r1[0], r0[1], r1[1]}; return *reinterpret_cast<bf16x8*>(&w);
}
__device__ __forceinline__ float rowmax_lean(const f32x16& p0, const f32x16& p1) {
  float d = p0[0];
#pragma unroll
  for (int r = 1; r < 16; ++r) d = fmaxf(d, p0[r]);
#pragma unroll
  for (int r = 0; r < 16; ++r) d = fmaxf(d, p1[r]);
  const auto rr = __builtin_amdgcn_permlane32_swap(__float_as_uint(d), __float_as_uint(d), false, false);
  return fmaxf(__uint_as_float(rr[0]), __uint_as_float(rr[1]));
}
__device__ __forceinline__ void shift_lean(float dmax, f32x16& p0, f32x16& p1, f32x16& nm, float& alpha, const bool first) {
  constexpr float THR2 = 11.541560327111707f;
  alpha = 1.f;
  if (first || !__all(dmax <= THR2)) {
    const float delta = first ? dmax : (dmax > THR2 ? dmax : 0.f);
    if (!first) alpha = __builtin_amdgcn_exp2f(-delta);
#pragma unroll
    for (int r = 0; r < 16; ++r) { p0[r] -= delta; p1[r] -= delta; nm[r] -= delta; }
  }
}
#define SGB(mask, n) __builtin_amdgcn_sched_group_barrier((mask), (n), 0)
__device__ __forceinline__ bf16x8 ld8(const bf16* p) { return *reinterpret_cast<const bf16x8*>(p); }

template <int MODE, int ATTV = 0>
__device__ __forceinline__ void attn_unit(const bf16* __restrict__ Qrow0, int ldq, const bf16* __restrict__ Kb, const bf16* __restrict__ Vb, int ldk, const bf16* __restrict__ KRb,
                                          int b, int nct, int NT, bf16* __restrict__ Ob, float lam, const float* __restrict__ subln, float oscale, LAS unsigned char* lds_, const int tid_in) {
  constexpr bool LEAN = ((MODE == 1) && ATT_LEAN) || ((MODE == 0) && ATT_LEAN0); constexpr int NQF = MODE == 0 ? 12 : 4, NQR = MODE == 0 ? 6 : ATT_DA_NQR, NOB = LEAN ? 5 : 4, PITCH = MODE == 0 ? 384 : 256, SHM_V = 16384, SHM_K = 64 * PITCH, SDEPTH = ATT_SDEPTH(MODE); constexpr bool PVPIPE = ATT_PVPIPE(MODE);
  const float SCALE = MODE == 0 ? 0.07216878364870323f : 0.125f;
  const float C = SCALE * 1.4426950408889634f, THRS = 8.f / SCALE;
  if (ATT_PRIO) { if (__builtin_amdgcn_readfirstlane(tid_in >> 8) != 0) __builtin_amdgcn_s_setprio(1); }
  const int tid = launder_v(tid_in) & 511, wid = tid >> 6, lane = tid & 63, r32 = lane & 31, hi = lane >> 5;
  LAS char* lds = (LAS char*)(LAS unsigned char*)lds_;
  constexpr bool THREE = (MODE == 1) && ATT_3STAGE; constexpr int NSTG = THREE ? 3 : 2, STG = SHM_V + SHM_K, SCR0 = NSTG * STG;
#define VOFF(s) (!THREE ? (s) * SHM_V : (s) * STG)
#define KOFF(s) (!THREE ? 2 * SHM_V + (s) * SHM_K : (s) * STG + SHM_V)
  LAS char* V_lds = lds; LAS char* K_lds = lds;
  LAS float* wsf = (LAS float*)(lds + NSTG * (SHM_V + SHM_K)) + wid * 64; LAS float* li_l = wsf; LAS float* al_l = wsf + 32;
  const int wq = MODE == 0 ? wid : (wid & 3), sgrp = MODE == 0 ? 0 : (wid >> 2);
  float m_reg = -1e30f, l_reg = 0; f32x16 o[NOB] = {}; bf16x8 qr[NQR > 0 ? NQR : 1]; f32x16 nm = {};
  LAS char* ql = lds + SCR0 + 2048 + wid * (MODE == 0 ? 8192 : 4096) + lane * 16;
  const bf16* Qw = Qrow0 + (size_t)(wq * 32 + r32) * ldq + sgrp * 64 + hi * 8;
#define QLOADS() do { _Pragma("unroll") for (int d0 = 0; d0 < NQR; ++d0) { qr[d0] = ld8(Qw + d0 * 16); if (LEAN) qr[d0] = scale_bf16x8(qr[d0], C); } \
    _Pragma("unroll") for (int d0 = NQR; d0 < NQF; ++d0) { bf16x8 qv = ld8(Qw + d0 * 16); if (LEAN) qv = scale_bf16x8(qv, C); *(LAS bf16x8*)(ql + (d0 - NQR) * 1024) = qv; } } while (0)
  constexpr bool QLATE = ATT_QLATE && !((MODE == 1) && ATT_3STAGE) && !((MODE == 1) && ATT_LEAN && ATT_KMAJOR && (ATTV == 0));
  if (!QLATE) QLOADS();
  const int sr = tid >> 4, sc = (tid & 15) * 8, vst0 = v_st(sr, sc), vst1 = v_st(32 + sr, sc);
  const int kst0 = sr * PITCH + (((tid & 15) ^ kswz<PITCH>(sr)) * 16), kst1 = kst0 + 32 * PITCH;
  const int rrow = tid >> 3, krs = rrow * PITCH + (((16 + (tid & 7)) ^ kswz<PITCH>(rrow)) * 16);
  const int chunk0 = sgrp * 8;
  const int vb0 = (int)(uintptr_t)V_lds + v_rd_base(lane);
  struct Slot { bf16x8 vs0, vs1, ks0, ks1, kr; } sr_[SDEPTH];
#define KROW(jt) ((jt) < nct ? (ML + b * CTXL + (jt) * 64) : (b * SEQ + ((jt) - nct) * 64))
#define SLOAD(i, jt) do { const int k0_ = KROW(jt); sr_[i].vs0 = ld8(Vb + (size_t)(k0_ + sr) * ldk + sc); sr_[i].vs1 = ld8(Vb + (size_t)(k0_ + 32 + sr) * ldk + sc); \
    sr_[i].ks0 = ld8(Kb + (size_t)(k0_ + sr) * ldk + sc); sr_[i].ks1 = ld8(Kb + (size_t)(k0_ + 32 + sr) * ldk + sc); \
    if (MODE == 0) sr_[i].kr = ld8(KRb + (size_t)(k0_ + rrow) * 64 + (tid & 7) * 8); } while (0)
#define SWRITE(bf, i) do { *(LAS bf16x8*)(V_lds + VOFF(bf) + vst0) = sr_[i].vs0; *(LAS bf16x8*)(V_lds + VOFF(bf) + vst1) = sr_[i].vs1; \
    *(LAS bf16x8*)(K_lds + KOFF(bf) + kst0) = sr_[i].ks0; *(LAS bf16x8*)(K_lds + KOFF(bf) + kst1) = sr_[i].ks1; \
    if (MODE == 0) *(LAS bf16x8*)(K_lds + KOFF(bf) + krs) = sr_[i].kr; } while (0)
#define SWAIT() do { if constexpr (SDEPTH == 2) asm volatile("s_waitcnt vmcnt(4)" ::: "memory"); else asm volatile("s_waitcnt vmcnt(0)" ::: "memory"); } while (0)
#define RESC(a) do { if (__any((a) < 1.f)) { if (hi == 0) al_l[r32] = (a); asm volatile("s_waitcnt lgkmcnt(0)" ::: "memory"); \
    _Pragma("unroll") for (int d = 0; d < NOB; ++d) _Pragma("unroll") for (int r = 0; r < 16; ++r) o[d][r] *= al_l[crow(r, hi)]; } } while (0)
#define PV(vb_) do { if constexpr (ATTV == 2) { o[0][0] += __uint_as_float((unsigned)pa0[0] + (unsigned)pa3[1]); } else if constexpr (PVPIPE) pv_pipe(o, (vb_), pa0, pa1, pa2, pa3); else pv_d0(o, (vb_), pa0, pa1, pa2, pa3); \
    if constexpr (LEAN) { const bf16x8 one8 = {0x3F80, 0x3F80, 0x3F80, 0x3F80, 0x3F80, 0x3F80, 0x3F80, 0x3F80};     \
        o[NOB - 1] = __builtin_amdgcn_mfma_f32_32x32x16_bf16(pa0, one8, o[NOB - 1], 0, 0, 0); o[NOB - 1] = __builtin_amdgcn_mfma_f32_32x32x16_bf16(pa1, one8, o[NOB - 1], 0, 0, 0); \
        o[NOB - 1] = __builtin_amdgcn_mfma_f32_32x32x16_bf16(pa2, one8, o[NOB - 1], 0, 0, 0); o[NOB - 1] = __builtin_amdgcn_mfma_f32_32x32x16_bf16(pa3, one8, o[NOB - 1], 0, 0, 0); } } while (0)
#define PSM(p0_, p1_, mn_, al_, first_) do { if constexpr (ATTV == 1) { al_ = 1.f; } else if constexpr (LEAN) partialSM_lean(p0_, p1_, nm, al_, first_); else partialSM(p0_, p1_, m_reg, mn_, al_, C, THRS); } while (0)
#define FSM(p0_, p1_, al_) do { if constexpr (ATTV == 1) { u32x4 w0_ = {__float_as_uint(p0_[0]), __float_as_uint(p0_[1]), __float_as_uint(p1_[0]), __float_as_uint(p1_[1])}; pa0 = pa1 = pa2 = pa3 = *reinterpret_cast<bf16x8*>(&w0_); } else if constexpr (LEAN) finishSM_lean(p0_, p1_, pa0, pa1, pa2, pa3); else finishSM(p0_, p1_, al_, l_reg, pa0, pa1, pa2, pa3); } while (0)
#define QKT(p0_, p1_, Kp_) do { if constexpr (ATTV == 5) { p0_ = nm; p1_ = nm; p0_[0] += (float)r32; } else if constexpr (LEAN) qkt<NQF, NQR, PITCH>(p0_, p1_, Kp_, chunk0, qr, ql, r32, hi, nm); else qkt<NQF, NQR, PITCH>(p0_, p1_, Kp_, chunk0, qr, ql, r32, hi); } while (0)
  f32x16 pA0, pA1, pB0, pB1; float mnA, mnB, alA, alB; bf16x8 pa0, pa1, pa2, pa3;
  constexpr bool KMAJ = (MODE == 1) && LEAN && ATT_KMAJOR && (ATTV == 0) && !THREE;
  if constexpr (KMAJ) {
    VStep VA, VB;
#define KSTEPS(PC0, PC1, ALC, PP0, PP1, KC, VP, LD, DOQK) do { const int vb_ = vb0 + VOFF(VP); float dmx_ = 0.f; \
      SBAR(); \
      if (DOQK) QKT(PC0, PC1, K_lds + KOFF(KC)); \
      pa0 = pk4e<0>(PP0); trstep<0>(VA, vb_); \
      _Pragma("unroll") for (int i_ = 0; i_ < 8; ++i_) { SGB(0x008, 1); SGB(0x100, 3); SGB(0x002, 2); } \
      SBAR(); LD; SBAR(); \
      mfma5(o, VA, pa0); pa1 = pk4e<8>(PP0); trstep<1>(VB, vb_); \
      _Pragma("unroll") for (int i_ = 0; i_ < 5; ++i_) { SGB(0x008, 1); SGB(0x100, 2); SGB(0x002, 3); } \
      SBAR(); \
      mfma5(o, VB, pa1); pa2 = pk4e<0>(PP1); trstep<2>(VA, vb_); \
      _Pragma("unroll") for (int i_ = 0; i_ < 5; ++i_) { SGB(0x008, 1); SGB(0x100, 2); SGB(0x002, 3); } \
      SBAR(); \
      mfma5(o, VA, pa2); pa3 = pk4e<8>(PP1); trstep<3>(VB, vb_); \
      _Pragma("unroll") for (int i_ = 0; i_ < 5; ++i_) { SGB(0x008, 1); SGB(0x100, 2); SGB(0x002, 3); } \
      SBAR(); \
      mfma5(o, VB, pa3); if (DOQK) dmx_ = rowmax_lean(PC0, PC1); \
      _Pragma("unroll") for (int i_ = 0; i_ < 5; ++i_) { SGB(0x008, 1); SGB(0x002, 7); } \
      SBAR(); \
      if (DOQK) shift_lean(dmx_, PC0, PC1, nm, ALC, false); } while (0)
    SLOAD(0, 0); asm volatile("s_waitcnt vmcnt(0)" ::: "memory"); SWRITE(0, 0); __syncthreads();
    QKT(pA0, pA1, K_lds + KOFF(0)); shift_lean(rowmax_lean(pA0, pA1), pA0, pA1, nm, alA, true);
    SLOAD(0, 1); asm volatile("s_waitcnt vmcnt(0)" ::: "memory"); SWRITE(1, 0); __syncthreads();
    for (int j = 1; j + 1 < NT; j += 2) {
      KSTEPS(pB0, pB1, alB, pA0, pA1, 1, 0, SLOAD(0, j + 1), true);
      __syncthreads(); asm volatile("s_waitcnt vmcnt(0)" ::: "memory"); SWRITE(0, 0);
      RESC(alB); __syncthreads();
      KSTEPS(pA0, pA1, alA, pB0, pB1, 0, 1, SLOAD(0, j + 2), true);
      __syncthreads(); asm volatile("s_waitcnt vmcnt(0)" ::: "memory"); SWRITE(1, 0);
      RESC(alA); __syncthreads();
    }
    KSTEPS(pB0, pB1, alB, pA0, pA1, 1, 0, (void)0, true);
    __syncthreads(); RESC(alB);
    KSTEPS(pA0, pA1, alA, pB0, pB1, 0, 1, (void)0, false);
#undef KSTEPS
  } else if constexpr (!THREE) {
  constexpr int SE = 0, SO = SDEPTH - 1;
  SLOAD(SE, 0); if (QLATE) QLOADS(); asm volatile("s_waitcnt vmcnt(0)" ::: "memory"); SWRITE(0, SE);
  if constexpr (QLATE && SDEPTH == 1) SLOAD(SO, 1);
  __syncthreads();
  QKT(pA0, pA1, K_lds + KOFF(0)); PSM(pA0, pA1, mnA, alA, true);
  if constexpr (!(QLATE && SDEPTH == 1)) SLOAD(SO, 1);
  if constexpr (SDEPTH == 2) { if (2 < NT) SLOAD(SE, 2); }
  SWAIT(); SWRITE(1, SO); __syncthreads();
#define ILV() do { if constexpr (PVPIPE) { _Pragma("unroll") for (int i_ = 0; i_ < 20; ++i_) { __builtin_amdgcn_sched_group_barrier(0x008, 1, 0); __builtin_amdgcn_sched_group_barrier(0x002, 5, 0); } } } while (0)
#define LSLOAD(i, jt) do { if constexpr (ATTV != 3) SLOAD(i, jt); } while (0)
#define LSWRITE(bf, i) do { if constexpr (ATTV != 3) SWRITE(bf, i); } while (0)
#define LSWAIT() do { if constexpr (ATTV != 3) SWAIT(); } while (0)
#define LSYNC() do { if constexpr (ATTV != 4) __syncthreads(); } while (0)
#define HALFSTEP(PC0, PC1, MNC, ALC, PP0, PP1, ALP, KC, VP, LD) do { \
    if (!STAG || wid < 4) { \
      SBAR(); QKT(PC0, PC1, K_lds + KOFF(KC)); FSM(PP0, PP1, ALP); SBAR(); \
      LD; SBAR(); \
      if constexpr (PVPIPE && LEAN && ATTV == 0) { if constexpr (ATT_TRB) pv_psm_lean_b(o, vb0 + VOFF(VP), pa0, pa1, pa2, pa3, PC0, PC1, nm, ALC); else pv_psm_lean(o, vb0 + VOFF(VP), pa0, pa1, pa2, pa3, PC0, PC1, nm, ALC); } else { PV(vb0 + VOFF(VP)); PSM(PC0, PC1, MNC, ALC, false); } \
    } else { \
      SBAR(); FSM(PP0, PP1, ALP); SBAR(); \
      LD; SBAR(); \
      PV(vb0 + VOFF(VP)); SBAR(); \
      QKT(PC0, PC1, K_lds + KOFF(KC)); SBAR(); \
      PSM(PC0, PC1, MNC, ALC, false); \
    } } while (0)
  constexpr bool STAG = (MODE == 1) && ATT_STAGGER && ATTV == 0;
  for (int j = 1; j + 1 < NT; j += 2) {
    HALFSTEP(pB0, pB1, mnB, alB, pA0, pA1, alA, 1, 0, LSLOAD(SO, j + SDEPTH));
    LSYNC(); LSWAIT(); LSWRITE(0, SE);
    RESC(alB); LSYNC();
    HALFSTEP(pA0, pA1, mnA, alA, pB0, pB1, alB, 0, 1, if (SDEPTH == 1 || j + 3 < NT) LSLOAD(SE, j + 1 + SDEPTH));
    LSYNC(); LSWAIT(); LSWRITE(1, SO);
    RESC(alA); LSYNC();
  }
#undef HALFSTEP
#undef ILV
#undef LSLOAD
#undef LSWRITE
#undef LSWAIT
#undef LSYNC
  SBAR(); QKT(pB0, pB1, K_lds + KOFF(1));
  FSM(pA0, pA1, alA); SBAR();
  PV(vb0); PSM(pB0, pB1, mnB, alB, false);
  __syncthreads(); RESC(alB);
  FSM(pB0, pB1, alB); SBAR();
  PV(vb0 + VOFF(1));
  } else {
#define STEP(PC0, PC1, ALC, PP0, PP1, ALP, jj, SP, SC, SN) do { const int j_ = (jj); \
      if (j_ + 1 < NT) { asm volatile("s_waitcnt vmcnt(0)" ::: "memory"); SWRITE(SN, 0); if (j_ + 2 < NT) SLOAD(0, j_ + 2); } \
      SBAR(); QKT(PC0, PC1, K_lds + KOFF(SC)); FSM(PP0, PP1, ALP); SBAR(); \
      PV(vb0 + VOFF(SP)); PSM(PC0, PC1, mnA, ALC, false); \
      RESC(ALC); __syncthreads(); } while (0)
    SLOAD(0, 0); asm volatile("s_waitcnt vmcnt(0)" ::: "memory"); SWRITE(0, 0);
    SLOAD(0, 1); asm volatile("s_waitcnt vmcnt(0)" ::: "memory"); SWRITE(1, 0);
    SLOAD(0, 2); __syncthreads();
    QKT(pA0, pA1, K_lds + KOFF(0)); PSM(pA0, pA1, mnA, alA, true);
    STEP(pB0, pB1, alB, pA0, pA1, alA, 1, 0, 1, 2);
    int j = 2;
    for (; j + 5 < NT; j += 6) {
      STEP(pA0, pA1, alA, pB0, pB1, alB, j, 1, 2, 0);
      STEP(pB0, pB1, alB, pA0, pA1, alA, j + 1, 2, 0, 1);
      STEP(pA0, pA1, alA, pB0, pB1, alB, j + 2, 0, 1, 2);
      STEP(pB0, pB1, alB, pA0, pA1, alA, j + 3, 1, 2, 0);
      STEP(pA0, pA1, alA, pB0, pB1, alB, j + 4, 2, 0, 1);
      STEP(pB0, pB1, alB, pA0, pA1, alA, j + 5, 0, 1, 2);
    }
    if (j < NT) { STEP(pA0, pA1, alA, pB0, pB1, alB, j, 1, 2, 0); STEP(pB0, pB1, alB, pA0, pA1, alA, j + 1, 2, 0, 1); j += 2; }
    if (j < NT) { STEP(pA0, pA1, alA, pB0, pB1, alB, j, 0, 1, 2); STEP(pB0, pB1, alB, pA0, pA1, alA, j + 1, 1, 2, 0); j += 2; }
    FSM(pB0, pB1, alB); SBAR();
    { const int sl = (NT - 1) % 3; PV(vb0 + VOFF(sl)); }
#undef STEP
  }
  float rli[16];
  if constexpr (LEAN) {
#pragma unroll
    for (int r = 0; r < 16; ++r) rli[r] = __builtin_amdgcn_rcpf(o[NOB - 1][r]);
  } else {
    if (hi == 0) li_l[r32] = l_reg; asm volatile("s_waitcnt lgkmcnt(0)" ::: "memory");
#pragma unroll
    for (int r = 0; r < 16; ++r) rli[r] = __builtin_amdgcn_rcpf(li_l[crow(r, hi)]);
  }
  bf16* Ow = Ob + (size_t)(wq * 32) * DM;
  if constexpr (MODE == 0) {
#pragma unroll
    for (int r = 0; r < 16; ++r) { const int orow = crow(r, hi);
#pragma unroll
      for (int d0 = 0; d0 < 4; ++d0) Ow[(size_t)orow * DM + d0 * 32 + r32] = tobf1(o[d0][r] * rli[r]); }
    __syncthreads();
  } else {
    LAS float* ex = (LAS float*)lds;
    __syncthreads();
    if (sgrp == 1) {
#pragma unroll
      for (int r = 0; r < 16; ++r)
#pragma unroll
        for (int d0 = 0; d0 < 4; ++d0) ex[(wq * 32 + crow(r, hi)) * 128 + d0 * 32 + r32] = o[d0][r] * rli[r];
    }
    __syncthreads();
    if (sgrp == 0) {
#pragma unroll
      for (int r = 0; r < 16; ++r) { const int orow = crow(r, hi); float dd[4]; float ss = 0.f;
#pragma unroll
        for (int d0 = 0; d0 < 4; ++d0) { dd[d0] = o[d0][r] * rli[r] - lam * ex[(wq * 32 + orow) * 128 + d0 * 32 + r32]; ss += dd[d0] * dd[d0]; }
        ss = half_sum32(ss);
        const float rs = oscale / sqrtf(ss * (1.0f / 128.0f) + LN_EPS);
#pragma unroll
        for (int d0 = 0; d0 < 4; ++d0) Ow[(size_t)orow * DM + d0 * 32 + r32] = tobf1(dd[d0] * rs * subln[d0 * 32 + r32]); }
    }
    __syncthreads();
  }
  if (ATT_PRIO) __builtin_amdgcn_s_setprio(0);
#undef VOFF
#undef KOFF
#undef PV
#undef PSM
#undef FSM
#undef QKT
#undef KROW
#undef SLOAD
#undef SWRITE
#undef SWAIT
#undef RESC
}
}

__device__ __forceinline__ void mla_attn_phase(CP P, LAS unsigned char* lds, const int tid) {
    const bf16* QM = (const bf16*)(P->ws + WS_QM); const bf16* KV = (const bf16*)(P->ws + WS_KV); const bf16* KR = (const bf16*)(P->ws + WS_KR); bf16* Gb = (bf16*)(P->ws + WS_G);
    const int c = blockIdx.x, G = gridDim.x;
    for (int u = c; u < 1024 + 32; u += G) {
        int b, h, qrow0, NT;
        if (u < 1024) { const int i = u >> 8, cc = u & 255; const int bh = (cc & 7) + 8 * i, qb = cc >> 3; b = bh >> 4; h = bh & 15; qrow0 = b * SEQ + qb * 256; NT = 4 + 128; }
        else { const int bh = u - 1024; b = bh >> 4; h = bh & 15; qrow0 = ML + b * CTXL; NT = 4; }
        att::attn_unit<0>(QM + (size_t)qrow0 * 3072 + h * 192, 3072, KV + h * 256, KV + h * 256 + 128, 4096, KR, b, 4, NT, Gb + (size_t)qrow0 * DM + h * 128, 0.f, nullptr, 1.f, lds, tid);
    }
}
template <int ATTV = 0>
__device__ __forceinline__ void da_attn_phase(CP P, float lam, float oscale, LAS unsigned char* lds, const int tid, const bool ctx_q, const int nt_cap = 0) {
    const bf16* Z = (const bf16*)(P->ws + WS_Z); bf16* Gb = (bf16*)(P->ws + WS_G); const float* subln = P->in[27];
    const int c = blockIdx.x, G = gridDim.x;
    for (int u = c; u < 2048 + (ctx_q ? 64 : 0); u += G) {
        int b, h, qrow0, NT;
        if (u < 2048) { const int i = u >> 8, cc = u & 255; const int bh = (cc & 7) + 8 * (i >> 1), qb = (cc >> 3) + 32 * (i & 1); b = bh >> 4; h = bh & 15; qrow0 = b * SEQ + qb * 128; NT = 4 + 128; }
        else { const int v = u - 2048; const int bh = v >> 1; b = bh >> 4; h = bh & 15; qrow0 = ML + b * CTXL + (v & 1) * 128; NT = 4; }
        if (nt_cap) NT = nt_cap;
        att::attn_unit<1, ATTV>(Z + (size_t)qrow0 * 6144 + h * 128, 6144, Z + 2048 + h * 128, Z + 4096 + h * 128, 6144, nullptr, b, 4, NT, Gb + (size_t)qrow0 * DM + h * 128, lam, subln, oscale, lds, tid);
    }
}

__device__ __forceinline__ unsigned f2ord(float f) { const unsigned u = __float_as_uint(f); return u ^ ((unsigned)((int)u >> 31) | 0x80000000u); }
__device__ __forceinline__ float ord2f(unsigned k) { return __uint_as_float((k & 0x80000000u) ? (k ^ 0x80000000u) : ~k); }
__device__ __forceinline__ void ce_desc(unsigned& a, unsigned& b) { const unsigned mx = a > b ? a : b, mn = a > b ? b : a; a = mx; b = mn; }
template <int N, bool DESC> __device__ __forceinline__ void bitonic_merge(unsigned* a) {
#pragma unroll
    for (int j = N / 2; j > 0; j >>= 1)
#pragma unroll
        for (int i = 0; i < N; ++i) { const int l = i ^ j; if (l > i) { if (DESC) ce_desc(a[i], a[l]); else ce_desc(a[l], a[i]); } }
}
template <int N, bool DESC> __device__ __forceinline__ void bitonic_sort(unsigned* a) {
#pragma unroll
    for (int k = 2; k <= N; k <<= 1)
#pragma unroll
        for (int j = k >> 1; j > 0; j >>= 1)
#pragma unroll
            for (int i = 0; i < N; ++i) { const int l = i ^ j; if (l > i) { const bool up = ((i & k) == 0); if (up == DESC) ce_desc(a[i], a[l]); else ce_desc(a[l], a[i]); } }
}
__device__ __forceinline__ void top16_of_64(unsigned (&a)[64]) {
    bitonic_sort<16, true>(a); bitonic_sort<16, false>(a + 16); bitonic_sort<16, true>(a + 32); bitonic_sort<16, false>(a + 48);
#pragma unroll
    for (int i = 0; i < 16; ++i) a[i] = a[i] > a[16 + i] ? a[i] : a[16 + i];
    bitonic_merge<16, true>(a);
#pragma unroll
    for (int i = 0; i < 16; ++i) a[32 + i] = a[32 + i] > a[48 + i] ? a[32 + i] : a[48 + i];
    bitonic_merge<16, false>(a + 32);
#pragma unroll
    for (int i = 0; i < 16; ++i) a[i] = a[i] > a[32 + i] ? a[i] : a[32 + i];
    bitonic_merge<16, true>(a);
}
template <int PASS> __device__ __forceinline__ void route_qload(const bf16* QP, int tok, int head, int hi, bf16x8 (&qf)[8]) {
    const bf16* qp = QP + (size_t)tok * DM + head * 256 + PASS * 128 + hi * 8;
#pragma unroll
    for (int ks = 0; ks < 8; ++ks) qf[ks] = NT_ACT ? __builtin_nontemporal_load((const bf16x8*)(qp + ks * 16)) : *(const bf16x8*)(qp + ks * 16);
}
template <int PASS> __device__ __forceinline__ void route_pass(const bf16x8 (&qf)[8], const LAS char* lds, int tok, int head, int r32, int hi, unsigned (&top)[16]) {
    f32x16 acc[4] = {};
    const LAS char* Kl = lds + PASS * 32768;
#pragma unroll
    for (int kb = 0; kb < 4; ++kb)
#pragma unroll
        for (int ks = 0; ks < 8; ++ks) { const bf16x8 a = *(const LAS bf16x8*)(Kl + (kb * 32 + r32) * 256 + (((ks * 2 + hi) ^ (r32 & 15)) * 16));
            acc[kb] = __builtin_amdgcn_mfma_f32_32x32x16_bf16(a, qf[ks], acc[kb], 0, 0, 0); }
    unsigned key[64]; const unsigned base = 127u - 4u * (unsigned)hi;
#pragma unroll
    for (int kb = 0; kb < 4; ++kb)
#pragma unroll
        for (int r = 0; r < 16; ++r) key[kb * 16 + r] = (f2ord(acc[kb][r]) & ~127u) | (base - (unsigned)(kb * 32 + (r & 3) + 8 * (r >> 2)));
    top16_of_64(key);
    unsigned pr[16];
#pragma unroll
    for (int i = 0; i < 16; ++i) pr[i] = lane_xor32(key[15 - i], hi << 5);
#pragma unroll
    for (int i = 0; i < 16; ++i) key[i] = key[i] > pr[i] ? key[i] : pr[i];
    bitonic_merge<16, true>(key);
#pragma unroll
    for (int i = 0; i < 16; ++i) top[i] = key[i];
}
#ifndef ROUTE_SORT
#define ROUTE_SORT 1
#endif
#define DPP_U(v, ctrl) ((unsigned)__builtin_amdgcn_mov_dpp((int)(v), (ctrl), 0xF, 0xF, true))
template <int J> __device__ __forceinline__ unsigned lane_xor_u(unsigned v, int lane) {
    if (J == 1) return DPP_U(v, 0xB1);
    if (J == 2) return DPP_U(v, 0x4E);
    if (J == 4) { const unsigned t = DPP_U(v, 0x141); return DPP_U(t, 0x1B); }
    if (J == 8) { const unsigned t = DPP_U(v, 0x140); return DPP_U(t, 0x141); }
    if (J == 16) { const auto r = __builtin_amdgcn_permlane16_swap(v, v, false, false); return (lane & 16) ? r[0] : r[1]; }
    return lane_xor32(v, lane);
}
template <int K, int J> __device__ __forceinline__ void sort128_stage(unsigned& a0, unsigned& a1, int lane) {
    if constexpr (J == 64) { const unsigned mn = a0 < a1 ? a0 : a1, mx = a0 < a1 ? a1 : a0; a0 = mn; a1 = mx; }
    else { const unsigned p0 = lane_xor_u<J>(a0, lane), p1 = lane_xor_u<J>(a1, lane);
        const bool lower = (lane & J) == 0;
        const bool asc0 = (K >= 64) ? true : ((lane & K) == 0), asc1 = (K == 128) ? true : (K == 64 ? false : ((lane & K) == 0));
        const unsigned mn0 = a0 < p0 ? a0 : p0, mx0 = a0 < p0 ? p0 : a0, mn1 = a1 < p1 ? a1 : p1, mx1 = a1 < p1 ? p1 : a1;
        a0 = (lower == asc0) ? mn0 : mx0; a1 = (lower == asc1) ? mn1 : mx1; }
    if constexpr (J > 1) sort128_stage<K, J / 2>(a0, a1, lane);
    else if constexpr (K < 128) sort128_stage<K * 2, K>(a0, a1, lane);
}
__device__ __forceinline__ void sort128_asc(unsigned& a0, unsigned& a1, int lane) { sort128_stage<2, 1>(a0, a1, lane); }
__device__ __forceinline__ void route_phase(CP P, int L, int Mrows, LAS unsigned char* lds_, int tid, int lane, int wid, int gw, int NGW) {
    const bf16* QP = (const bf16*)(P->ws + WS_QP); unsigned* ROUTE = (unsigned*)(P->ws + WS_ROUTE);
    LAS char* lds = (LAS char*)(LAS unsigned char*)lds_;
    __syncthreads();
    {
        const bf16* K1 = (const bf16*)(P->ws + WS_PK1) + (size_t)L * 128 * 128; const bf16* K2 = (const bf16*)(P->ws + WS_PK2) + (size_t)L * 128 * 128;
        u32x4 kw[8];
#pragma unroll
        for (int t = 0; t < 8; ++t) { const int c16 = tid + t * NWAVES * 64; const int mat = c16 >> 11, row = (c16 >> 4) & 127, ch = c16 & 15; kw[t] = *(const u32x4*)((mat ? K2 : K1) + row * 128 + ch * 8); }
#pragma unroll
        for (int t = 0; t < 8; ++t) { const int c16 = tid + t * NWAVES * 64; const int mat = c16 >> 11, row = (c16 >> 4) & 127, ch = c16 & 15; *(LAS u32x4*)(lds + mat * 32768 + row * 256 + ((ch ^ (row & 15)) * 16)) = kw[t]; }
    }
    __syncthreads();
    LAS unsigned* sc = (LAS unsigned*)(lds + 65536) + wid * 2048;
    const int r32 = lane & 31, hi = lane >> 5;
    for (int item = gw; item < Mrows / 4; item += NGW) {
        const int tok = item * 4 + (r32 >> 3), head = r32 & 7;
        unsigned top0[16], top1[16];
        { bf16x8 q0[8], q1[8]; route_qload<0>(QP, tok, head, hi, q0); route_qload<1>(QP, tok, head, hi, q1);
          route_pass<0>(q0, lds, tok, head, r32, hi, top0);
          route_pass<1>(q1, lds, tok, head, r32, hi, top1); }
        float v1[16], v2[16];
#pragma unroll
        for (int i = 0; i < 16; ++i) { v1[i] = ord2f(top0[i] & ~127u); v2[i] = ord2f(top1[i] & ~127u);
            sc[i * 64 + lane] = 127u - (top0[i] & 127u); sc[(16 + i) * 64 + lane] = 127u - (top1[i] & 127u); }
        unsigned ck[64]; int n = 0;
#pragma unroll
        for (int i = 0; i < 16; ++i)
#pragma unroll
            for (int j = 0; j < 16; ++j) if ((i + 1) * (j + 1) <= 16) { ck[n] = (f2ord(v1[i] + v2[j]) & ~255u) | (unsigned)(i * 16 + j); ++n; }
#pragma unroll
        for (int i = 50; i < 64; ++i) ck[i] = 0u;
        top16_of_64(ck);
        float ev[16]; float sum = 0.f; const float mx = ord2f(ck[0] & ~255u);
#pragma unroll
        for (int k = 0; k < 16; ++k) { ev[k] = __expf(ord2f(ck[k] & ~255u) - mx); sum += ev[k]; }
        const float inv = 1.0f / sum;
        unsigned ee[16];
#pragma unroll
        for (int k = 0; k < 16; ++k) { const unsigned pc = ck[k] & 255u; const unsigned i1 = sc[(pc >> 4) * 64 + lane], i2 = sc[(16 + (pc & 15u)) * 64 + lane]; ee[k] = i1 * 128u + i2; ev[k] *= inv; }
#if ROUTE_SORT
        { const int tq = r32 >> 3;
#pragma unroll
          for (int k = 0; k < 8; ++k) {
              const unsigned eL = ee[k], eH = ee[k + 8]; const float gL = ev[k], gH = ev[k + 8];
              sc[tq * 256 + head * 16 + hi * 8 + k] = hi ? eH : eL; sc[tq * 256 + 128 + head * 16 + hi * 8 + k] = __float_as_uint(hi ? gH : gL); }
#pragma unroll 1
          for (int t = 0; t < 4; ++t) {
              unsigned a0 = (sc[t * 256 + lane] << 7) | (unsigned)lane, a1 = (sc[t * 256 + 64 + lane] << 7) | (unsigned)(64 + lane);
              sort128_asc(a0, a1, lane);
              const unsigned g0 = sc[t * 256 + 128 + (a0 & 127u)], g1 = sc[t * 256 + 128 + (a1 & 127u)];
              u32x2* outp = (u32x2*)(ROUTE + (size_t)(item * 4 + t) * 256);
              outp[lane] = (u32x2){a0 >> 7, g0}; outp[64 + lane] = (u32x2){a1 >> 7, g1}; }
        }
#else
        u32x4* outp = (u32x4*)(ROUTE + ((size_t)tok * 128 + head * 16 + hi * 8) * 2);
#pragma unroll
        for (int k = 0; k < 8; k += 2) { u32x4 w;
            const unsigned eL0 = ee[k], eH0 = ee[k + 8], eL1 = ee[k + 1], eH1 = ee[k + 9]; const float gL0 = ev[k], gH0 = ev[k + 8], gL1 = ev[k + 1], gH1 = ev[k + 9];
            w.x = hi ? eH0 : eL0; w.y = __float_as_uint(hi ? gH0 : gL0); w.z = hi ? eH1 : eL1; w.w = __float_as_uint(hi ? gH1 : gL1);
            outp[k >> 1] = w; }
#endif
    }
}

typedef float f32x2 __attribute__((ext_vector_type(2)));
typedef float f32x32 __attribute__((ext_vector_type(32)));
typedef unsigned u32x6 __attribute__((ext_vector_type(6)));
typedef __bf16 bf16x32 __attribute__((ext_vector_type(32)));
typedef unsigned u32x16 __attribute__((ext_vector_type(16)));
typedef __bf16 bf16x2_t __attribute__((ext_vector_type(2)));
#ifndef GATHER_ZIGZAG
#define GATHER_ZIGZAG 0
#endif
#ifndef GATHER_PRE
#define GATHER_PRE 0
#endif
#ifndef GATHER_XEARLY
#define GATHER_XEARLY 0
#endif
#ifndef GATHER_SWP
#define GATHER_SWP 0
#endif
#ifndef GATHER_VECREG
#define GATHER_VECREG 1
#endif
#ifndef GATHER_MFMADOT
#define GATHER_MFMADOT 1
#endif
typedef short s16x4_t __attribute__((ext_vector_type(4)));
#ifndef GATHER_PAIRRED
#define GATHER_PAIRRED 1
#endif
#ifndef GATHER_EARLY
#define GATHER_EARLY 1
#endif
#ifndef GATHER_PACE
#define GATHER_PACE 0
#endif
#define XB_PACE(j) (XCD_BAR_WORDS + 64 * (j))
#ifndef GATHER_DEEP
#define GATHER_DEEP 0
#endif
constexpr int GS = GATHER_DEEP ? 8 : 6, GSLOT = GATHER_DEEP ? 2048 : 2 * PROW;
__device__ __forceinline__ void glds16(const void* gsrc, unsigned lds_dst) { unsigned keep;
  asm volatile("s_mov_b32 %0, m0\n\ts_mov_b32 m0, %2\n\ts_nop 0\n\tglobal_load_lds_dwordx4 %1, off\n\ts_mov_b32 m0, %0" : "=&s"(keep) : "v"(gsrc), "s"(lds_dst) : "memory"); }
template <int GMODE = 0>
__device__ __forceinline__ void gather_phase(CP P, int L, int Mrows, LAS unsigned char* lds, int wid, int lane_, int gw, int NGW, bool dry = false) {
    const unsigned char* UV = P->ws + WS_PU + (size_t)L * 16384 * PREC;
    const unsigned* ROUTE = (const unsigned*)(P->ws + WS_ROUTE); const float* MOD = (const float*)(P->ws + WS_MOD);
    bf16* X = (bf16*)(P->ws + WS_X); bf16* H = (bf16*)(P->ws + WS_H); bf16* Xo = dry ? (bf16*)(P->ws + WS_Y) : X; bf16* Ho = dry ? (bf16*)(P->ws + WS_G) : H;
    const float* lng = P->in[6] + (size_t)(L * 2 + 1) * DM; const float* lnb = P->in[7] + (size_t)(L * 2 + 1) * DM;
    const unsigned ring = (unsigned)(uintptr_t)lds + (unsigned)wid * (GS * GSLOT);
    const int nfull = (Mrows / NGW) * NGW, rem = Mrows - nfull; const bool can_coop = (rem * 4 == NGW);
    const int nround = nfull / NGW + (rem > 0 ? 1 : 0);
    const bool pace_ok = (rem == 0) || can_coop;
#define G_ROWOF(it_) ((can_coop && (it_) == nround - 1) ? (nfull + (int)blockIdx.x * 2 + (wid >> 2)) : (gw + (it_) * NGW))
    u32x2 nea = {0u, 0u}, neb = {0u, 0u}; u32x4 nh0 = {0u, 0u, 0u, 0u}, nh1 = nh0, nh2 = nh0, nh3 = nh0;
#define G_NTL(p_) (NT_STREAM > 1 ? __builtin_nontemporal_load(p_) : *(p_))
#define G_PREFETCH(rowN_, ln_) do { const int rn_ = (rowN_); nea = G_NTL(&((const u32x2*)(ROUTE + (size_t)rn_ * 256))[ln_]); neb = G_NTL(&((const u32x2*)(ROUTE + (size_t)rn_ * 256))[64 + (ln_)]); \
        const u32x4* hp_ = (const u32x4*)(H + (size_t)rn_ * DM) + 4 * (ln_); nh0 = G_NTL(hp_); nh1 = G_NTL(hp_ + 1); nh2 = G_NTL(hp_ + 2); nh3 = G_NTL(hp_ + 3); } while (0)
    if (nround > 0 && G_ROWOF(0) < Mrows) G_PREFETCH(G_ROWOF(0), launder_v(lane_));
#if GATHER_VECREG
    LAS unsigned* LNV = (LAS unsigned*)(lds + NWAVES * GS * GSLOT);
    { f32x2 t_[4];
#pragma unroll
      for (int t = 0; t < 4; ++t) { const int i = wid * 64 + lane_ + t * NWAVES * 64; t_[t] = *(const f32x2*)(((i >> 10) ? lnb : lng) + 2 * (i & 1023)); }
#pragma unroll
      for (int t = 0; t < 4; ++t) { const float x0_ = t_[t][0], x1_ = t_[t][1]; LNV[wid * 64 + lane_ + t * NWAVES * 64] = cvtpk(x0_, x1_); } }
    __syncthreads();
    unsigned mg[16], ms[16], mc[16]; int cur_slot = -1;
#pragma unroll
    for (int i = 0; i < 16; ++i) { mg[i] = 0u; ms[i] = 0u; mc[i] = 0u; }
#endif
    bool pre = false;
#pragma unroll 1
    for (int it = 0; it < nround; ++it) {
#if GATHER_PACE
        if (pace_ok && it > 0) {
            if (wid == 0 && lane_ == 0) { const unsigned nloc = ((volatile LAS unsigned*)(lds + MISC_OFF))[8];
                if (nloc != 0u) { unsigned* pc = (unsigned*)(P->ws + WS_CTL) + CW_BAR + XB_PACE(xb_xcc_id());
                    const unsigned old = xb_add(pc, 1u), tgt = (old / nloc + 1u) * nloc; unsigned sp = 0u;
                    while ((int)(xb_ld(pc) - tgt) < 0 && ++sp < 20000u) __builtin_amdgcn_s_sleep(1); } }
            __syncthreads();
        }
#endif
        const bool coop = can_coop && (it == nround - 1);
        int row = G_ROWOF(it), k0 = 0, kn = 128;
        if (coop) { k0 = (wid & 3) * 32; kn = k0 + 32; }
        else if (row >= Mrows) break;
        const int lane = launder_v(lane_);
        const u32x2 ea = nea, eb = neb;
        unsigned eax, eay, ebx, eby;
        unsigned hw[16] = {nh0.x, nh0.y, nh0.z, nh0.w, nh1.x, nh1.y, nh1.z, nh1.w, nh2.x, nh2.y, nh2.z, nh2.w, nh3.x, nh3.y, nh3.z, nh3.w};
        float y[32];
#pragma unroll
        for (int i = 0; i < 32; ++i) y[i] = 0.f;
        { unsigned e0 = ea.x, e1 = ea.y, e2 = eb.x, e3 = eb.y;
          asm volatile("" : "+v"(e0), "+v"(e1), "+v"(e2), "+v"(e3), "+v"(hw[0]), "+v"(hw[1]), "+v"(hw[2]), "+v"(hw[3]), "+v"(hw[4]), "+v"(hw[5]), "+v"(hw[6]), "+v"(hw[7]),
                       "+v"(hw[8]), "+v"(hw[9]), "+v"(hw[10]), "+v"(hw[11]), "+v"(hw[12]), "+v"(hw[13]), "+v"(hw[14]), "+v"(hw[15]) :: "memory");
          eax = e0; eay = e1; ebx = e2; eby = e3; }
        const unsigned rd_a = ring + 16u * (unsigned)lane, rd_b = ring + 2048u + 8u * (unsigned)lane;
        const bool rev = GATHER_ZIGZAG && ((it & 1) != 0);
        const int kflip = rev ? (k0 + kn - 1) : 0, ksign = rev ? -1 : 1;
#define G_ISSUE(k) do { const int k_ = (k), ke_ = kflip + ksign * k_; const unsigned e_ = (unsigned)__builtin_amdgcn_readlane((int)(ke_ < 64 ? eax : ebx), ke_ & 63); \
        const unsigned char* rp_ = UV + (size_t)e_ * PREC + 16 * lane; const unsigned sb_ = ring + (unsigned)(k_ % GS) * GSLOT; \
        if (GMODE == 3) { glds16(rp_, sb_); if (lane < 32) glds16(rp_ + 2048, sb_ + 2048); } \
        else if (GMODE != 2) { glds16(rp_, sb_); glds16(rp_ + 1024, sb_ + 1024); if (PEER_U4) {} else if (PEER_V4) { if (lane < 32) glds16(rp_ + 2048, sb_ + 2048); } else glds16(rp_ + 2048, sb_ + 2048); } else { asm volatile("" :: "v"(rp_), "s"(sb_)); } } while (0)
#if GATHER_EARLY
        if (it + 1 < nround && G_ROWOF(it + 1) < Mrows) G_PREFETCH(G_ROWOF(it + 1), lane);
        if (!pre) {
#pragma unroll
            for (int k = 0; k < GS; ++k) G_ISSUE(k0 + k); }
#else
#pragma unroll
        for (int k = 0; k < 4; ++k) G_ISSUE(k0 + k);
        if (it + 1 < nround && G_ROWOF(it + 1) < Mrows) G_PREFETCH(G_ROWOF(it + 1), lane);
#endif
#define G_READ(k, ua, ub, va, vb) do { const unsigned so_ = (unsigned)((k) % GS) * GSLOT; \
        if (PEER_U4) asm volatile("ds_read_b128 %0, %2\n\tds_read_b128 %1, %2 offset:1024" : "=&v"(ua), "=&v"(va) : "v"(rd_a + so_) : "memory"); \
        else if (PEER_V4) asm volatile("ds_read_b128 %0, %3\n\tds_read_b64 %1, %4\n\tds_read_b128 %2, %3 offset:1024" \
                     : "=&v"(ua), "=&v"(ub), "=&v"(va) : "v"(rd_a + so_), "v"(rd_b + so_) : "memory"); \
        else asm volatile("ds_read_b128 %0, %4\n\tds_read_b64 %1, %5\n\tds_read_b128 %2, %4 offset:1024\n\tds_read_b64 %3, %5 offset:512" \
                     : "=&v"(ua), "=&v"(ub), "=&v"(va), "=&v"(vb) : "v"(rd_a + so_), "v"(rd_b + so_) : "memory"); } while (0)
#if GATHER_XEARLY
        u32x4 xr0 = {0u, 0u, 0u, 0u}, xr1 = xr0, xr2 = xr0, xr3 = xr0;
#endif
#if GATHER_SWP
        static_assert(!GATHER_SWP || (PEER_U4 && PEER_V4 && GATHER_EARLY && GATHER_PAIRRED && GATHER_MFMADOT && !GATHER_DEEP && !GATHER_XEARLY && !GATHER_PRE), "GATHER_SWP: configuration");
#define SWP_FETCH(kk, uA, uB, vA, vB) do { const int kk_ = (kk); \
            if (kk_ + 4 < kn) asm volatile("s_waitcnt vmcnt(8)" ::: "memory"); else if (kk_ == kn - 4) asm volatile("s_waitcnt vmcnt(4)" ::: "memory"); else asm volatile("s_waitcnt vmcnt(0)" ::: "memory"); \
            u32x2 d0_ = {0u, 0u}, d1_ = {0u, 0u}; G_READ(kk_, uA, d0_, vA, d1_); G_READ(kk_ + 1, uB, d0_, vB, d1_); \
            asm volatile("s_waitcnt lgkmcnt(0)" : "+v"(uA), "+v"(vA), "+v"(uB), "+v"(vB) :: "memory"); \
            if (kk_ + GS < kn) { G_ISSUE(kk_ + GS); G_ISSUE(kk_ + GS + 1); } } while (0)
#define SWP_U4(dst_, src_, w_, b_) dst_[4 * (w_) + (b_)] = __builtin_bit_cast(unsigned, __builtin_amdgcn_cvt_scalef32_pk_bf16_fp4(src_[w_], 1.0f, b_))
#define SWP_UPART(kk, uA, uB, wA_, wB_) do { const int kk_ = (kk); u32x16 ubfA, ubfB; const unsigned uwA[4] = {uA.x, uA.y, uA.z, uA.w}, uwB[4] = {uB.x, uB.y, uB.z, uB.w}; \
            _Pragma("unroll") for (int w = 0; w < 4; ++w) { SWP_U4(ubfA, uwA, w, 0); SWP_U4(ubfA, uwA, w, 1); SWP_U4(ubfA, uwA, w, 2); SWP_U4(ubfA, uwA, w, 3); SWP_U4(ubfB, uwB, w, 0); SWP_U4(ubfB, uwB, w, 1); SWP_U4(ubfB, uwB, w, 2); SWP_U4(ubfB, uwB, w, 3); } \
            f32x4 dgA = {0.f, 0.f, 0.f, 0.f}, dgB = {0.f, 0.f, 0.f, 0.f}; \
            _Pragma("unroll") for (int q = 0; q < 16; q += 2) { const u32x2 hq_ = {hw[q], hw[q + 1]}, xa_ = {ubfA[q], ubfA[q + 1]}, xb_ = {ubfB[q], ubfB[q + 1]}; \
                dgA = __builtin_amdgcn_mfma_f32_4x4x4bf16_1k(__builtin_bit_cast(s16x4_t, xa_), __builtin_bit_cast(s16x4_t, hq_), dgA, 0, 0, 0); \
                dgB = __builtin_amdgcn_mfma_f32_4x4x4bf16_1k(__builtin_bit_cast(s16x4_t, xb_), __builtin_bit_cast(s16x4_t, hq_), dgB, 0, 0, 0); } \
            const float x0 = dgA[0], x1 = dgA[1], x2 = dgA[2], x3 = dgA[3], y0 = dgB[0], y1 = dgB[1], y2 = dgB[2], y3 = dgB[3]; \
            float a0 = DPP_F(x0, 0x00); a0 += DPP_F(x1, 0x55); a0 += DPP_F(x2, 0xAA); a0 += DPP_F(x3, 0xFF); \
            float b0 = DPP_F(y0, 0x00); b0 += DPP_F(y1, 0x55); b0 += DPP_F(y2, 0xAA); b0 += DPP_F(y3, 0xFF); \
            const auto sw = __builtin_amdgcn_permlane32_swap(__float_as_uint(a0), __float_as_uint(b0), false, false); \
            float c2 = __uint_as_float(sw[0]) + __uint_as_float(sw[1]); c2 += DPP_F(c2, 0x141); c2 += DPP_F(c2, 0x140); \
            const float d2 = sum_xor16(c2) * (1.0f / U_SCALE); const float g2 = gelu_tanh(d2) * (1.0f / V_SCALE); \
            const float gA = __uint_as_float((unsigned)__builtin_amdgcn_readlane((int)__float_as_uint(g2), 0)), gB = __uint_as_float((unsigned)__builtin_amdgcn_readlane((int)__float_as_uint(g2), 32)); \
            const int keA = kflip + ksign * kk_, keB = keA + ksign; const unsigned gsel = keA < 64 ? eay : eby; \
            wA_ = __uint_as_float((unsigned)__builtin_amdgcn_readlane((int)gsel, keA & 63)) * gA; wB_ = __uint_as_float((unsigned)__builtin_amdgcn_readlane((int)gsel, keB & 63)) * gB; } while (0)
#define SWP_V4(vwA, vwB, w_, b_, wA_, wB_) do { const f32x2 pA = __builtin_amdgcn_cvt_scalef32_pk_f32_fp4(vwA[w_], 1.0f, b_), pB = __builtin_amdgcn_cvt_scalef32_pk_f32_fp4(vwB[w_], 1.0f, b_); const int j = 4 * (w_) + (b_); \
            const float pa0 = pA[0], pa1 = pA[1], pb0 = pB[0], pb1 = pB[1]; y[2 * j] += wA_ * pa0; y[2 * j + 1] += wA_ * pa1; y[2 * j] += wB_ * pb0; y[2 * j + 1] += wB_ * pb1; } while (0)
#define SWP_VPART(vA, vB, wA_, wB_) do { const unsigned vwA[4] = {vA.x, vA.y, vA.z, vA.w}, vwB[4] = {vB.x, vB.y, vB.z, vB.w}; \
            _Pragma("unroll") for (int w = 0; w < 4; ++w) { SWP_V4(vwA, vwB, w, 0, wA_, wB_); SWP_V4(vwA, vwB, w, 1, wA_, wB_); SWP_V4(vwA, vwB, w, 2, wA_, wB_); SWP_V4(vwA, vwB, w, 3, wA_, wB_); } } while (0)
#define SWP_VCH(w_, qA_, qB_) do { SWP_V4(vwA, vwB, w_, 0, qA_, qB_); SWP_V4(vwA, vwB, w_, 1, qA_, qB_); SWP_V4(vwA, vwB, w_, 2, qA_, qB_); SWP_V4(vwA, vwB, w_, 3, qA_, qB_); } while (0)
#define SWP_MIX(kk, uA, uB, wA_, wB_, pvA, pvB, pwA_, pwB_) do { const int kk_ = (kk); u32x16 ubfA, ubfB; const unsigned uwA[4] = {uA.x, uA.y, uA.z, uA.w}, uwB[4] = {uB.x, uB.y, uB.z, uB.w}; \
            const unsigned vwA[4] = {pvA.x, pvA.y, pvA.z, pvA.w}, vwB[4] = {pvB.x, pvB.y, pvB.z, pvB.w}; \
            _Pragma("unroll") for (int w = 0; w < 4; ++w) { SWP_U4(ubfA, uwA, w, 0); SWP_U4(ubfA, uwA, w, 1); SWP_U4(ubfA, uwA, w, 2); SWP_U4(ubfA, uwA, w, 3); SWP_U4(ubfB, uwB, w, 0); SWP_U4(ubfB, uwB, w, 1); SWP_U4(ubfB, uwB, w, 2); SWP_U4(ubfB, uwB, w, 3); } \
            f32x4 dgA = {0.f, 0.f, 0.f, 0.f}, dgB = {0.f, 0.f, 0.f, 0.f}; \
            _Pragma("unroll") for (int q = 0; q < 16; q += 2) { const u32x2 hq_ = {hw[q], hw[q + 1]}, xa_ = {ubfA[q], ubfA[q + 1]}, xb_ = {ubfB[q], ubfB[q + 1]}; \
                dgA = __builtin_amdgcn_mfma_f32_4x4x4bf16_1k(__builtin_bit_cast(s16x4_t, xa_), __builtin_bit_cast(s16x4_t, hq_), dgA, 0, 0, 0); \
                dgB = __builtin_amdgcn_mfma_f32_4x4x4bf16_1k(__builtin_bit_cast(s16x4_t, xb_), __builtin_bit_cast(s16x4_t, hq_), dgB, 0, 0, 0); } \
            SWP_VCH(0, pwA_, pwB_); \
            const float x0 = dgA[0], x1 = dgA[1], x2 = dgA[2], x3 = dgA[3], y0 = dgB[0], y1 = dgB[1], y2 = dgB[2], y3 = dgB[3]; \
            float a0 = DPP_F(x0, 0x00); a0 += DPP_F(x1, 0x55); a0 += DPP_F(x2, 0xAA); a0 += DPP_F(x3, 0xFF); \
            float b0 = DPP_F(y0, 0x00); b0 += DPP_F(y1, 0x55); b0 += DPP_F(y2, 0xAA); b0 += DPP_F(y3, 0xFF); \
            SWP_VCH(1, pwA_, pwB_); \
            const auto sw = __builtin_amdgcn_permlane32_swap(__float_as_uint(a0), __float_as_uint(b0), false, false); \
            float c2 = __uint_as_float(sw[0]) + __uint_as_float(sw[1]); c2 += DPP_F(c2, 0x141); c2 += DPP_F(c2, 0x140); \
            float d2 = sum_xor16(c2) * (1.0f / U_SCALE); \
            SWP_VCH(2, pwA_, pwB_); \
            float g2 = gelu_tanh(d2) * (1.0f / V_SCALE); \
            SWP_VCH(3, pwA_, pwB_); \
            const float gA = __uint_as_float((unsigned)__builtin_amdgcn_readlane((int)__float_as_uint(g2), 0)), gB = __uint_as_float((unsigned)__builtin_amdgcn_readlane((int)__float_as_uint(g2), 32)); \
            const int keA = kflip + ksign * kk_, keB = keA + ksign; const unsigned gsel = keA < 64 ? eay : eby; \
            wA_ = __uint_as_float((unsigned)__builtin_amdgcn_readlane((int)gsel, keA & 63)) * gA; wB_ = __uint_as_float((unsigned)__builtin_amdgcn_readlane((int)gsel, keB & 63)) * gB; } while (0)
        if (GMODE == 0) {
            u32x4 cuA, cuB, cvA, cvB; float cwA, cwB;
            SWP_FETCH(k0, cuA, cuB, cvA, cvB); SWP_UPART(k0, cuA, cuB, cwA, cwB);
#pragma unroll 1
            for (int k = k0; k + 2 < kn; k += 2) {
                u32x4 nuA, nuB, nvA, nvB; float nwA, nwB;
                SWP_FETCH(k + 2, nuA, nuB, nvA, nvB);
                SWP_MIX(k + 2, nuA, nuB, nwA, nwB, cvA, cvB, cwA, cwB);
                cvA = nvA; cvB = nvB; cwA = nwA; cwB = nwB;
            }
            SWP_VPART(cvA, cvB, cwA, cwB);
        } else
#undef SWP_MIX
#undef SWP_VCH
#undef SWP_FETCH
#undef SWP_U4
#undef SWP_UPART
#undef SWP_V4
#undef SWP_VPART
#endif
#pragma unroll 1
        for (int k = k0; k < kn; k += 2) {
            if (GATHER_DEEP && k + 6 < kn) asm volatile("s_waitcnt vmcnt(12)" ::: "memory");
            else if (GATHER_DEEP && k == kn - 6) asm volatile("s_waitcnt vmcnt(8)" ::: "memory");
            else if (k + 4 < kn) { if (!GATHER_EARLY) { G_ISSUE(k + 4); G_ISSUE(k + 5); } if (GMODE == 3 || PEER_U4) asm volatile("s_waitcnt vmcnt(8)" ::: "memory"); else asm volatile("s_waitcnt vmcnt(12)" ::: "memory"); }
            else if (k == kn - 4) { if (GMODE == 3 || PEER_U4) asm volatile("s_waitcnt vmcnt(4)" ::: "memory"); else asm volatile("s_waitcnt vmcnt(6)" ::: "memory"); }
            else asm volatile("s_waitcnt vmcnt(0)" ::: "memory");
            u32x4 uaA, vaA, uaB, vaB; u32x2 ubA = {0u, 0u}, vbA = {0u, 0u}, ubB = {0u, 0u}, vbB = {0u, 0u};
            G_READ(k, uaA, ubA, vaA, vbA); G_READ(k + 1, uaB, ubB, vaB, vbB);
            asm volatile("s_waitcnt lgkmcnt(0)" : "+v"(uaA), "+v"(ubA), "+v"(vaA), "+v"(vbA), "+v"(uaB), "+v"(ubB), "+v"(vaB), "+v"(vbB) :: "memory");
#if GATHER_XEARLY
            if (k == kn - 4) { const u32x4* xp_ = (const u32x4*)(X + (size_t)row * DM) + 4 * lane; xr0 = xp_[0]; xr1 = xp_[1]; xr2 = xp_[2]; xr3 = xp_[3]; }
#endif
            if (GATHER_EARLY && k + GS < kn) { G_ISSUE(k + GS); G_ISSUE(k + GS + 1); }
            if (GMODE == 1 || GMODE == 3) continue;
#if PEER_U4
            u32x16 ubfA, ubfB;
            { const unsigned uwA[4] = {uaA.x, uaA.y, uaA.z, uaA.w}, uwB[4] = {uaB.x, uaB.y, uaB.z, uaB.w};
#pragma unroll
              for (int w = 0; w < 4; ++w) {
#define U4_CVT(b_) do { ubfA[4 * w + (b_)] = __builtin_bit_cast(unsigned, __builtin_amdgcn_cvt_scalef32_pk_bf16_fp4(uwA[w], 1.0f, b_)); ubfB[4 * w + (b_)] = __builtin_bit_cast(unsigned, __builtin_amdgcn_cvt_scalef32_pk_bf16_fp4(uwB[w], 1.0f, b_)); } while (0)
                  U4_CVT(0); U4_CVT(1); U4_CVT(2); U4_CVT(3);
#undef U4_CVT
              } }
#else
            const u32x6 u6A = {uaA.x, uaA.y, uaA.z, uaA.w, ubA.x, ubA.y}, u6B = {uaB.x, uaB.y, uaB.z, uaB.w, ubB.x, ubB.y};
            const u32x16 ubfA = __builtin_bit_cast(u32x16, __builtin_amdgcn_cvt_scalef32_pk32_bf16_fp6(u6A, 1.0f));
            const u32x16 ubfB = __builtin_bit_cast(u32x16, __builtin_amdgcn_cvt_scalef32_pk32_bf16_fp6(u6B, 1.0f));
#endif
#if GATHER_MFMADOT
            f32x4 dgA = {0.f, 0.f, 0.f, 0.f}, dgB = {0.f, 0.f, 0.f, 0.f};
#pragma unroll
            for (int q = 0; q < 16; q += 2) { const u32x2 hq_ = {hw[q], hw[q + 1]}, xa_ = {ubfA[q], ubfA[q + 1]}, xb_ = {ubfB[q], ubfB[q + 1]};
                dgA = __builtin_amdgcn_mfma_f32_4x4x4bf16_1k(__builtin_bit_cast(s16x4_t, xa_), __builtin_bit_cast(s16x4_t, hq_), dgA, 0, 0, 0);
                dgB = __builtin_amdgcn_mfma_f32_4x4x4bf16_1k(__builtin_bit_cast(s16x4_t, xb_), __builtin_bit_cast(s16x4_t, hq_), dgB, 0, 0, 0); }
            float a0, a1 = 0.f, b0, b1 = 0.f;
            { const float x0 = dgA[0], x1 = dgA[1], x2 = dgA[2], x3 = dgA[3], y0 = dgB[0], y1 = dgB[1], y2 = dgB[2], y3 = dgB[3];
              a0 = DPP_F(x0, 0x00); a0 += DPP_F(x1, 0x55); a0 += DPP_F(x2, 0xAA); a0 += DPP_F(x3, 0xFF);
              b0 = DPP_F(y0, 0x00); b0 += DPP_F(y1, 0x55); b0 += DPP_F(y2, 0xAA); b0 += DPP_F(y3, 0xFF); }
#else
            float a0 = 0.f, a1 = 0.f, b0 = 0.f, b1 = 0.f;
#pragma unroll
            for (int q = 0; q < 16; q += 2) { const unsigned h0_ = hw[q], h1_ = hw[q + 1], x0_ = ubfA[q], x1_ = ubfA[q + 1], z0_ = ubfB[q], z1_ = ubfB[q + 1];
                a0 = __builtin_amdgcn_fdot2_f32_bf16(__builtin_bit_cast(bf16x2_t, h0_), __builtin_bit_cast(bf16x2_t, x0_), a0, false);
                a1 = __builtin_amdgcn_fdot2_f32_bf16(__builtin_bit_cast(bf16x2_t, h1_), __builtin_bit_cast(bf16x2_t, x1_), a1, false);
                b0 = __builtin_amdgcn_fdot2_f32_bf16(__builtin_bit_cast(bf16x2_t, h0_), __builtin_bit_cast(bf16x2_t, z0_), b0, false);
                b1 = __builtin_amdgcn_fdot2_f32_bf16(__builtin_bit_cast(bf16x2_t, h1_), __builtin_bit_cast(bf16x2_t, z1_), b1, false); }
#endif
            const int keA = kflip + ksign * k, keB = keA + ksign;
            const unsigned gsel = keA < 64 ? eay : eby;
#if GATHER_PAIRRED
            float wA, wB;
            { const auto sw = __builtin_amdgcn_permlane32_swap(__float_as_uint(GATHER_MFMADOT ? a0 : a0 + a1), __float_as_uint(GATHER_MFMADOT ? b0 : b0 + b1), false, false);
#if GATHER_MFMADOT
              float c2 = __uint_as_float(sw[0]) + __uint_as_float(sw[1]); c2 += DPP_F(c2, 0x141); c2 += DPP_F(c2, 0x140);
              const float d2 = sum_xor16(c2) * (1.0f / U_SCALE);
#else
              const float d2 = half_sum32(__uint_as_float(sw[0]) + __uint_as_float(sw[1])) * (1.0f / U_SCALE);
#endif
              const float g2 = gelu_tanh(d2) * (1.0f / V_SCALE);
              const float gA = __uint_as_float((unsigned)__builtin_amdgcn_readlane((int)__float_as_uint(g2), 0)), gB = __uint_as_float((unsigned)__builtin_amdgcn_readlane((int)__float_as_uint(g2), 32));
              wA = __uint_as_float((unsigned)__builtin_amdgcn_readlane((int)gsel, keA & 63)) * gA; wB = __uint_as_float((unsigned)__builtin_amdgcn_readlane((int)gsel, keB & 63)) * gB; }
#else
            const float dA = wave_sum(a0 + a1) * (1.0f / U_SCALE), dB = wave_sum(b0 + b1) * (1.0f / U_SCALE);
            const float wA = __uint_as_float((unsigned)__builtin_amdgcn_readlane((int)gsel, keA & 63)) * gelu_tanh(dA) * (1.0f / V_SCALE);
            const float wB = __uint_as_float((unsigned)__builtin_amdgcn_readlane((int)gsel, keB & 63)) * gelu_tanh(dB) * (1.0f / V_SCALE);
#endif
#if PEER_V4
            { const unsigned vwA[4] = {vaA.x, vaA.y, vaA.z, vaA.w}, vwB[4] = {vaB.x, vaB.y, vaB.z, vaB.w};
#pragma unroll
              for (int w = 0; w < 4; ++w) {
#define V4_ACC(b_) do { const f32x2 pA = __builtin_amdgcn_cvt_scalef32_pk_f32_fp4(vwA[w], 1.0f, b_), pB = __builtin_amdgcn_cvt_scalef32_pk_f32_fp4(vwB[w], 1.0f, b_); const int j = 4 * w + (b_); \
                    const float pa0 = pA[0], pa1 = pA[1], pb0 = pB[0], pb1 = pB[1]; y[2 * j] += wA * pa0; y[2 * j + 1] += wA * pa1; y[2 * j] += wB * pb0; y[2 * j + 1] += wB * pb1; } while (0)
                  V4_ACC(0); V4_ACC(1); V4_ACC(2); V4_ACC(3);
#undef V4_ACC
              } }
#else
            const u32x6 v6A = {vaA.x, vaA.y, vaA.z, vaA.w, vbA.x, vbA.y};
            const f32x32 vfA = __builtin_amdgcn_cvt_scalef32_pk32_f32_fp6(v6A, 1.0f);
#pragma unroll
            for (int i = 0; i < 32; ++i) y[i] += wA * vfA[i];
            const u32x6 v6B = {vaB.x, vaB.y, vaB.z, vaB.w, vbB.x, vbB.y};
            const f32x32 vfB = __builtin_amdgcn_cvt_scalef32_pk32_f32_fp6(v6B, 1.0f);
#pragma unroll
            for (int i = 0; i < 32; ++i) y[i] += wB * vfB[i];
#endif
        }
#if GATHER_PRE
        pre = (it + 1 < nround) && (G_ROWOF(it + 1) < Mrows);
        if (pre) { unsigned n0 = nea.x, n2 = neb.x; asm volatile("" : "+v"(n0), "+v"(n2) :: "memory"); eax = n0; ebx = n2;
            const int k0n = (can_coop && (it + 1 == nround - 1)) ? (wid & 3) * 32 : 0;
#pragma unroll
            for (int k = 0; k < 6; ++k) G_ISSUE(k0n + k); }
#endif
#undef G_READ
#undef G_ISSUE
        if (coop) {
            LAS f32x4* mine = (LAS f32x4*)(lds + wid * (GS * GSLOT)) + lane * 8;
#pragma unroll
            for (int i = 0; i < 8; ++i) mine[i] = (f32x4){y[4 * i], y[4 * i + 1], y[4 * i + 2], y[4 * i + 3]};
            __syncthreads();
            if ((wid & 3) == 0) {
#pragma unroll
                for (int j = 1; j < 4; ++j) { const LAS f32x4* oth = (const LAS f32x4*)(lds + (wid + j) * (GS * GSLOT)) + lane * 8;
#pragma unroll
                    for (int i = 0; i < 8; ++i) { const f32x4 t = oth[i]; y[4 * i] += t.x; y[4 * i + 1] += t.y; y[4 * i + 2] += t.z; y[4 * i + 3] += t.w; } }
            }
            __syncthreads();
            if ((wid & 3) != 0) continue;
        }
        const int slot = row_slot(row);
        const float* mod = MOD + (size_t)(L * 3 + slot) * 12288;
        const int le = launder_v(lane);
#if GATHER_VECREG
        if (slot != cur_slot) { cur_slot = slot; float t_[32];
            load_row_f32_b(mod + 5 * 2048, le, t_);
#pragma unroll
            for (int i = 0; i < 16; ++i) mg[i] = cvtpk(t_[2 * i], t_[2 * i + 1]);
            if (L < NLAYER - 1) { const float* modn = MOD + (size_t)((L + 1) * 3 + slot) * 12288;
                load_row_f32_b(modn, le, t_);
#pragma unroll
                for (int i = 0; i < 16; ++i) ms[i] = cvtpk(t_[2 * i], t_[2 * i + 1]);
                load_row_f32_b(modn + 2048, le, t_);
#pragma unroll
                for (int i = 0; i < 16; ++i) mc[i] = cvtpk(t_[2 * i], t_[2 * i + 1]); } }
        { float xx[32];
#if GATHER_XEARLY
          { const unsigned xw_[16] = {xr0.x, xr0.y, xr0.z, xr0.w, xr1.x, xr1.y, xr1.z, xr1.w, xr2.x, xr2.y, xr2.z, xr2.w, xr3.x, xr3.y, xr3.z, xr3.w};
#pragma unroll
            for (int i = 0; i < 16; ++i) { xx[2 * i] = bflo(xw_[i]); xx[2 * i + 1] = bfhi(xw_[i]); } }
#else
          { const u32x4* xp_ = (const u32x4*)(X + (size_t)row * DM) + 4 * le;
#pragma unroll
            for (int j = 0; j < 4; ++j) { const u32x4 w = G_NTL(xp_ + j); xx[8 * j + 0] = bflo(w.x); xx[8 * j + 1] = bfhi(w.x); xx[8 * j + 2] = bflo(w.y); xx[8 * j + 3] = bfhi(w.y);
                xx[8 * j + 4] = bflo(w.z); xx[8 * j + 5] = bfhi(w.z); xx[8 * j + 6] = bflo(w.w); xx[8 * j + 7] = bfhi(w.w); } }
#endif
#pragma unroll
          for (int i = 0; i < 16; ++i) { y[2 * i] = ALPHA * xx[2 * i] + bflo(mg[i]) * y[2 * i]; y[2 * i + 1] = ALPHA * xx[2 * i + 1] + bfhi(mg[i]) * y[2 * i + 1]; } }
        { float mean, rstd; ln_stats(y, mean, rstd);
          const LAS u32x4* gp = (const LAS u32x4*)(LNV + le * 16); const LAS u32x4* bp = (const LAS u32x4*)(LNV + 1024 + le * 16);
#pragma unroll
          for (int q = 0; q < 4; ++q) { const u32x4 g4 = gp[q], b4 = bp[q]; const unsigned gw_[4] = {g4.x, g4.y, g4.z, g4.w}, bw_[4] = {b4.x, b4.y, b4.z, b4.w};
#pragma unroll
              for (int j = 0; j < 4; ++j) { const int i = 8 * q + 2 * j; y[i] = (y[i] - mean) * rstd * bflo(gw_[j]) + bflo(bw_[j]); y[i + 1] = (y[i + 1] - mean) * rstd * bfhi(gw_[j]) + bfhi(bw_[j]); } }
          if (L < NLAYER - 1) { store_row_bf16_b(Xo + (size_t)row * DM, le, y);
              ln_stats(y, mean, rstd); float a_[32];
#pragma unroll
              for (int i = 0; i < 16; ++i) { a_[2 * i] = (y[2 * i] - mean) * rstd * (1.0f + bflo(mc[i])) + bflo(ms[i]); a_[2 * i + 1] = (y[2 * i + 1] - mean) * rstd * (1.0f + bfhi(mc[i])) + bfhi(ms[i]); }
              store_row_bf16_b(Ho + (size_t)row * DM, le, a_); }
          else { if (NT_STREAM > 1) store_row_f32_b_nt(P->out + (size_t)row * DM, le, y); else store_row_f32_b(P->out + (size_t)row * DM, le, y); } }
        asm volatile("s_waitcnt vmcnt(0)" ::: "memory");
        continue;
#endif
        { float xx[32], gg[32]; load_row_bf16_b(X + (size_t)row * DM, le, xx); load_row_f32_b(mod + 5 * 2048, le, gg);
#pragma unroll
          for (int i = 0; i < 32; ++i) y[i] = ALPHA * xx[i] + gg[i] * y[i]; }
        if (L < NLAYER - 1) { const float* modn = MOD + (size_t)((L + 1) * 3 + slot) * 12288;
            finish_row<true>(y, lng, lnb, Xo + (size_t)row * DM, modn, modn + 2048, Ho + (size_t)row * DM, nullptr, le); }
        else finish_row<true>(y, lng, lnb, nullptr, nullptr, nullptr, nullptr, P->out + (size_t)row * DM, le);
        asm volatile("s_waitcnt vmcnt(0)" ::: "memory");
    }
#undef G_PREFETCH
#undef G_ROWOF
}

#ifndef ROPE_TEST
#define ROPE_TEST 0
#endif
#ifndef TAIL_L3MOVE
#define TAIL_L3MOVE 1
#endif
#ifndef PROBE_DUP
#define PROBE_DUP 0
#endif
#define NOINL __forceinline__
__device__ __forceinline__ CP launder_cp(CP p) { asm volatile("" : "+s"(p)); return p; }
#define GETP() launder_cp((CP)__builtin_amdgcn_kernarg_segment_ptr())
__device__ __forceinline__ int uni(int v) { return __builtin_amdgcn_readfirstlane(v); }
__device__ __forceinline__ LAS unsigned char* uni_lds(LAS unsigned char* p) { return (LAS unsigned char*)(unsigned)__builtin_amdgcn_readfirstlane((int)(unsigned)(uintptr_t)p); }
#define PH_IDS const int wid = uni(wv_), lane = launder_v(lane_id_fresh()) & 63, tid = (wid & 7) * 64 + lane; const int gw = blockIdx.x * NWAVES + wid, NGW = gridDim.x * NWAVES; (void)lane; (void)gw; (void)NGW; (void)tid;

__device__ NOINL void ph_prologue(int wv_, LAS unsigned char* lds_) { CP P = GETP(); LAS unsigned char* lds = uni_lds(lds_); PH_IDS p0_prologue(P, lds, tid, lane, wid, gw, NGW); if (PROBE_DUP == 5) p0_prologue(P, lds, tid, lane, wid, gw, NGW);
    if (PROBE_DUP >= 21 && PROBE_DUP <= 23) { __syncthreads(); p0_prologue(P, lds, tid, lane, wid, gw, NGW, 1 << (PROBE_DUP - 21 < 0 ? 0 : (PROBE_DUP - 21) & 3)); } }
__device__ NOINL void ph_modreduce(int wv_) { CP P = GETP(); PH_IDS mod_reduce(P, gw, lane, NGW); }
__device__ NOINL void ph_first(int wv_, LAS unsigned char* lds_) { CP P = GETP(); LAS unsigned char* lds = uni_lds(lds_); PH_IDS
#pragma unroll 1
    for (int rep = 0; rep < (PROBE_DUP == 6 ? 2 : 1); ++rep) first_row_pass(P, lds, tid, lane, gw, NGW); }
__device__ NOINL void ph_postmix(int wv_, LAS unsigned char* lds_, int L_, int M_) { CP P = GETP(); LAS unsigned char* lds = uni_lds(lds_); const int L = uni(L_), Mrows = uni(M_); PH_IDS
    if (POSTMIX_LDS) post_mixer_pass_lds(P, L, Mrows, lds, tid, lane, gw, NGW); else post_mixer_pass(P, L, Mrows, lane, gw, NGW); }
__device__ NOINL void ph_vstats(int wv_, int M_) { CP P = GETP(); const int Mrows = uni(M_); PH_IDS
#pragma unroll 1
    for (int rep = 0; rep < (PROBE_DUP == 6 ? 2 : 1); ++rep) vstats_pass(P, Mrows, lane, gw, NGW); }
__device__ NOINL void ph_spatial(int wv_, LAS unsigned char* lds_, int j_, int M_) { CP P = GETP(); LAS unsigned char* lds = uni_lds(lds_); const int j = uni(j_), Mrows = uni(M_); PH_IDS
#pragma unroll 1
    for (int rep = 0; rep < ((PROBE_DUP == 6 || PROBE_DUP == 19) ? 2 : 1); ++rep) spatial_phase(P, j, Mrows, lds, tid, lane, wid); }
__device__ NOINL void ph_mla_norm(int wv_) { CP P = GETP(); PH_IDS
#pragma unroll 1
    for (int rep = 0; rep < (PROBE_DUP == 6 ? 2 : 1); ++rep) mla_norm_pass(P, lane, gw, NGW); }
__device__ NOINL void ph_rope(int wv_, int which_) { CP P = GETP(); const int which = uni(which_); PH_IDS
    if (which == 0) rope_pass((bf16*)(P->ws + WS_QM), 3072, 128, 16, 192, lane, gw, NGW);
    else rope_pass((bf16*)(P->ws + WS_Z), 6144, 0, 64, 64, lane, gw, NGW); }
__device__ NOINL void ph_attn_mla(int wv_, LAS unsigned char* lds_) { CP P = GETP(); LAS unsigned char* lds = uni_lds(lds_); PH_IDS mla_attn_phase(P, lds, tid); if (PROBE_DUP == 2 || PROBE_DUP == 9) mla_attn_phase(P, lds, tid); }
__device__ NOINL void ph_attn_da(int wv_, LAS unsigned char* lds_, int L_, bool ctx_q) { CP P = GETP(); LAS unsigned char* lds = uni_lds(lds_); const int L = uni(L_); PH_IDS
    const float* lp = P->in[26];
    const float s01 = wave_sum(lp[lane] * lp[64 + lane]), s23 = wave_sum(lp[128 + lane] * lp[192 + lane]);
    const float lam_init = 0.8f - 0.6f * expf(-0.3f * (float)L);
    const float lam = expf(s01) - expf(s23) + lam_init;
    if (PROBE_DUP == 24) { da_attn_phase(P, lam, 1.0f - lam_init, lds, tid, ctx_q, 4); __syncthreads(); }
    if (PROBE_DUP == 25) { da_attn_phase(P, lam, 1.0f - lam_init, lds, tid, ctx_q, 2); __syncthreads(); }
    if (PROBE_DUP == 26) { da_attn_phase(P, lam, 1.0f - lam_init, lds, tid, ctx_q, 12); __syncthreads(); }
    if (!(PROBE_DUP >= 11 && PROBE_DUP <= 15)) da_attn_phase(P, lam, 1.0f - lam_init, lds, tid, ctx_q);
    if (PROBE_DUP == 2 || PROBE_DUP == 10) da_attn_phase(P, lam, 1.0f - lam_init, lds, tid, ctx_q);
    if (PROBE_DUP >= 11 && PROBE_DUP <= 15) { da_attn_phase<PROBE_DUP >= 11 && PROBE_DUP <= 15 ? PROBE_DUP - 10 : 0>(P, lam, 1.0f - lam_init, lds, tid, ctx_q); __syncthreads(); }
    if (PROBE_DUP >= 11 && PROBE_DUP <= 15) da_attn_phase(P, lam, 1.0f - lam_init, lds, tid, ctx_q); }
__device__ NOINL void ph_route(int wv_, LAS unsigned char* lds_, int L_, int M_) { CP P = GETP(); LAS unsigned char* lds = uni_lds(lds_); const int L = uni(L_), Mrows = uni(M_); PH_IDS
#pragma unroll 1
    for (int rep = 0; rep < (PROBE_DUP == 4 ? 2 : 1); ++rep) route_phase(P, L, Mrows, lds, tid, lane, wid, gw, NGW); }
__device__ NOINL void ph_gather(int wv_, LAS unsigned char* lds_, int L_, int M_) { CP P = GETP(); LAS unsigned char* lds = uni_lds(lds_); const int L = uni(L_), Mrows = uni(M_); PH_IDS
    if (PROBE_DUP == 3) { gather_phase<0>(P, L, Mrows, lds, wid, lane, gw, NGW, true); }
    if (PROBE_DUP == 7) { gather_phase<1>(P, L, Mrows, lds, wid, lane, gw, NGW, true); }
    if (PROBE_DUP == 17) { gather_phase<3>(P, L, Mrows, lds, wid, lane, gw, NGW, true); }
    if (PROBE_DUP == 8) { gather_phase<2>(P, L, Mrows, lds, wid, lane, gw, NGW, true); }
    gather_phase<0>(P, L, Mrows, lds, wid, lane, gw, NGW); }

enum GemmId { G_GM_IN = 0, G_GM_OUT, G_MLA_IN, G_MLA_UQ, G_MLA_UKV, G_MLA_OUT, G_DA_IN, G_DA_OUT, G_PEER_Q };
__device__ NOINL void ph_gemm(int wv_, LAS unsigned char* lds_, int id_, int L_, int M_) {
    CP P = GETP(); LAS unsigned char* lds = uni_lds(lds_); const int id = uni(id_), L = uni(L_), Mrows = uni(M_); PH_IDS
    unsigned char* ws = P->ws; const int jj = L / 3;
    size_t a = WS_H, b = 0, o = 0; int M = MT, N = 2048, K = 2048, act = 0, rope = 0;
    switch (id) {
        case G_GM_IN:   a = WS_H;    b = WS_GMWIN + (size_t)jj * 4096 * 2048 * 2;  o = WS_Z;  M = Mrows; N = 4096; K = 2048; act = 1; break;
        case G_GM_OUT:  a = WS_G;    b = WS_GMWOUT + (size_t)jj * 2048 * 2048 * 2; o = WS_Y;  M = Mrows; N = 2048; K = 2048; break;
        case G_MLA_IN:  a = WS_H;    b = WS_MLAIN;  o = WS_C;  N = 1280; K = 2048; break;
        case G_MLA_UQ:  a = WS_CQN;  b = WS_MLAUQ;  o = WS_QM; N = 3072; K = 512;  rope = (ROPE_TEST == 2) ? 0 : 2; break;
        case G_MLA_UKV: a = WS_CKVN; b = WS_MLAUKV; o = WS_KV; N = 4096; K = 512;  break;
        case G_MLA_OUT: a = WS_G;    b = WS_MLAOUT; o = WS_Y;  N = 2048; K = 2048; break;
        case G_DA_IN:   a = WS_H;    b = WS_DAIN;   o = WS_Z;  N = 6144; K = 2048; rope = (ROPE_TEST == 1) ? 0 : 1; break;
        case G_DA_OUT:  a = WS_G;    b = WS_DAOUT;  o = WS_Y;  M = Mrows; N = 2048; K = 2048; break;
        default:        a = WS_H;    b = WS_PWQ + (size_t)L * 2048 * 2048 * 2;     o = WS_QP; M = Mrows; N = 2048; K = 2048; break;
    }
    pg8::Gemm g{(const pg8::bf16_t*)(ws + a), (const pg8::bf16_t*)(ws + b), M, N, K}; pg8::StaticOrder S; S.init(M, N, (int)gridDim.x, id == G_MLA_UKV ? (int)gridDim.x - 1 - (int)blockIdx.x : (int)blockIdx.x);
    pg8::EpiR E{(pg8::bf16_t*)(ws + o), N, act, rope, (const float*)(ws + WS_ROPE)};
#pragma unroll 1
    for (int rep = 0; rep < ((PROBE_DUP == 1 || (PROBE_DUP == 31 && id == G_MLA_OUT) || (PROBE_DUP == 32 && id == G_DA_OUT)) ? 2 : 1); ++rep) { pg8::gemm_phase<pg8::EpiR, pg8::StaticOrder, true, true>((PG8_LAS unsigned char*)lds, g, S, E, tid); __syncthreads(); }
#if TAIL_REMAP
    int TL = -1; bool tail_u = false;
    if (L == 0) { if (id == G_GM_IN) { TL = 0; tail_u = true; } else if (id == G_GM_OUT) { TL = 0; } else if (id == G_PEER_Q) { TL = 1; tail_u = true; } }
    else if (L == 1) { if (id == G_MLA_IN) { TL = 1; } else if (id == G_MLA_OUT) { TL = 2; tail_u = true; } else if (id == G_PEER_Q) { TL = 2; } }
    else if (L == 2) { if (id == G_DA_IN) { TL = 3; tail_u = true; } else if (id == G_DA_OUT) { TL = 3; } }
    if (TL >= 0) {
        const int units = (M / 256) * (N / 256), G = (int)gridDim.x, tail = units % G, c = (int)blockIdx.x;
        const float* src = (tail_u ? P->in[11] : P->in[12]) + (size_t)TL * 16384 * 2048; unsigned char* dst = ws + WS_PU + (size_t)TL * 16384 * PREC;
#else
#if TAIL_L3MOVE
    const bool l3u = (id == G_MLA_IN && L == 1), l3v = (id == G_DA_IN && L == 2), skip = (L == NLAYER - 2) && (id == G_DA_OUT || id == G_PEER_Q);
    const bool l0v = P0_NOV && (id == G_GM_IN && L == 0);
    const bool tail_u = !skip && ((id == G_GM_OUT || id == G_MLA_OUT || id == G_DA_OUT) || l3u), tail_v = !skip && ((id == G_PEER_Q) || l3v || l0v);
    const int TLx = (l3u || l3v) ? NLAYER - 1 : (l0v ? 0 : L + 1);
    if ((tail_u || tail_v) && TLx < NLAYER) {
        const int units = (M / 256) * (N / 256), G = (int)gridDim.x, tail = units % G, c = (int)blockIdx.x;
        const float* src = (tail_u ? P->in[11] : P->in[12]) + (size_t)TLx * 16384 * 2048; unsigned char* dst = ws + WS_PU + (size_t)TLx * 16384 * PREC;
#else
    const bool tail_u = (id == G_GM_OUT || id == G_MLA_OUT || id == G_DA_OUT), tail_v = (id == G_PEER_Q);
    if ((tail_u || tail_v) && L + 1 < NLAYER) {
        const int units = (M / 256) * (N / 256), G = (int)gridDim.x, tail = units % G, c = (int)blockIdx.x;
        const float* src = (tail_u ? P->in[11] : P->in[12]) + (size_t)(L + 1) * 16384 * 2048; unsigned char* dst = ws + WS_PU + (size_t)(L + 1) * 16384 * PREC;
#endif
#endif
        LAS float* scr = (LAS float*)(lds + wid * 16384);
        if (tail != 0 && c >= tail) cvt_table_fp6(src, dst, 16384, tail_u ? U_SCALE : V_SCALE, scr, lane, (c - tail) * NWAVES + wid, (G - tail) * NWAVES, tail_u ? 0 : 1);
        else if (tail == 0) {
#pragma unroll 1
            for (int rep = 0; rep < (PROBE_DUP == 18 ? 3 : 1); ++rep) cvt_table_fp6(src, dst, 16384, tail_u ? U_SCALE : V_SCALE, scr, lane, gw, NGW, tail_u ? 0 : 1); }
    }
}

__global__ void __launch_bounds__(NWAVES * 64, 2) mk_fwd(Params Pv) {
    extern __shared__ __attribute__((aligned(16))) unsigned char lds_g[];
    LAS unsigned char* lds = (LAS unsigned char*)lds_g;
    const int wv = __builtin_amdgcn_readfirstlane((int)threadIdx.x >> 6);
    const int tid = wv * 64 + lane_id_fresh();
    for (int u = tid; u < (LDS_BYTES - RING_BYTES) / 4; u += NWAVES * 64) ((LAS unsigned*)(lds + RING_BYTES))[u] = 0u;
    __syncthreads();
    const int lo = Pv.ph_lo, hi = Pv.ph_hi;
    unsigned* barw = (unsigned*)(Pv.ws + WS_CTL) + CW_BAR;
    XcdBarrier bar; bar.bar = barw; bar.x = 0; bar.st = nullptr;
    if (hi - lo > 1) bar = xcd_barrier_post(barw, (volatile LAS unsigned*)(lds + MISC_OFF) + 8, tid == 0);
    int ph = 0;
#ifndef SEL
#define SELP(k) true
#else
#define SELP(k) ((k) == SEL)
#endif
    enum { RUN_BASE = __COUNTER__ + 1 };
#define RUN(call) do { if (SELP(__COUNTER__ - RUN_BASE) && ph >= lo && ph < hi) { call; } if (ph >= lo && ph + 1 < hi) { xcd_barrier(bar, wv == 0 && lane_id_fresh() == 0); if (PROBE_DUP == 30) { xcd_barrier(bar, wv == 0 && lane_id_fresh() == 0); xcd_barrier(bar, wv == 0 && lane_id_fresh() == 0); } } ++ph; } while (0)
    RUN(ph_prologue(wv, lds));
    RUN(ph_modreduce(wv));
    RUN(ph_first(wv, lds));
#define LAYER(LL) do { constexpr int L = (LL); constexpr int kind = L % 3, jj = L / 3; constexpr int Mrows = (L == NLAYER - 1) ? ML : MT; \
        constexpr bool ctx_dead = (L == NLAYER - 2) && ((NLAYER - 1) % 3 == 0) && (kind != 0); constexpr int Mlive = ctx_dead ? ML : Mrows; \
        if (kind == 0) {                          \
            RUN(ph_gemm(wv, lds, G_GM_IN, L, Mrows)); \
            RUN(ph_vstats(wv, Mrows)); \
            RUN(ph_spatial(wv, lds, jj, Mrows)); \
            RUN(ph_gemm(wv, lds, G_GM_OUT, L, Mrows)); \
        } else if (kind == 1) {                   \
            RUN(ph_gemm(wv, lds, G_MLA_IN, L, Mrows)); \
            RUN(ph_mla_norm(wv)); \
            RUN(ph_gemm(wv, lds, G_MLA_UQ, L, Mrows); ph_gemm(wv, lds, G_MLA_UKV, L, Mrows)); \
            if (ROPE_TEST == 2) { RUN(ph_rope(wv, 0)); } \
            RUN(ph_attn_mla(wv, lds)); \
            RUN(ph_gemm(wv, lds, G_MLA_OUT, L, Mrows)); \
        } else {                                  \
            RUN(ph_gemm(wv, lds, G_DA_IN, L, Mrows); if (ROPE_TEST == 1) { __syncthreads(); } ); \
            if (ROPE_TEST == 1) { RUN(ph_rope(wv, 1)); } \
            RUN(ph_attn_da(wv, lds, L, !ctx_dead)); \
            RUN(ph_gemm(wv, lds, G_DA_OUT, L, Mlive)); \
        } \
        RUN(ph_postmix(wv, lds, L, Mlive));                \
        RUN(ph_gemm(wv, lds, G_PEER_Q, L, Mlive));    \
        RUN(ph_route(wv, lds, L, Mlive));             \
        RUN(ph_gather(wv, lds, L, Mlive));            \
    } while (0)
    LAYER(0); LAYER(1); LAYER(2); LAYER(3);
#undef LAYER
#undef RUN
}

extern "C" void kernel_launch(void* const* d_in, const int* in_sizes, int n_in, void* d_out, int out_size, void* d_ws, size_t ws_size, hipStream_t stream) {
    static int grid = 0;
    if (grid == 0) {
        if (n_in != 29 || in_sizes[0] != ML * DM || out_size != ML * DM || ws_size < WS_END) {
            fprintf(stderr, "kernel_launch: shape mismatch: n_in %d in0 %d out %d ws %zu (need %zu); nothing launched\n", n_in, n_in > 0 ? in_sizes[0] : -1, out_size, ws_size, (size_t)WS_END); grid = -1; return; }
        int dev = 0, cus = 0, per_cu = 0;
        if (hipGetDevice(&dev) != hipSuccess || hipDeviceGetAttribute(&cus, hipDeviceAttributeMultiprocessorCount, dev) != hipSuccess) { fprintf(stderr, "kernel_launch: device query failed\n"); grid = -1; return; }
        if (hipFuncSetAttribute((const void*)mk_fwd, hipFuncAttributeMaxDynamicSharedMemorySize, LDS_BYTES) != hipSuccess) { fprintf(stderr, "kernel_launch: hipFuncSetAttribute failed\n"); grid = -1; return; }
        if (hipOccupancyMaxActiveBlocksPerMultiprocessor(&per_cu, (const void*)mk_fwd, NWAVES * 64, LDS_BYTES) != hipSuccess || per_cu < 1)
            fprintf(stderr, "kernel_launch: note: occupancy query reports %d workgroups per CU\n", per_cu);
        (void)hipGetLastError();
        grid = cus;
    }
    if (grid < 0) return;
    if (hipMemsetAsync((char*)d_ws + WS_CTL, 0, CTL_ZERO_BYTES, stream) != hipSuccess) { fprintf(stderr, "kernel_launch: memset failed\n"); return; }
    Params p{};
    for (int i = 0; i < 29; ++i) p.in[i] = (const float*)d_in[i];
    p.out = (float*)d_out; p.ws = (unsigned char*)d_ws;
#if MK_ONE_LAUNCH
    p.ph_lo = 0; p.ph_hi = NPH;
    hipLaunchKernelGGL(mk_fwd, dim3(grid), dim3(NWAVES * 64), LDS_BYTES, stream, p);
#else
    for (int li = 0; li < NPH; ++li) { p.ph_lo = li; p.ph_hi = li + 1; hipLaunchKernelGGL(mk_fwd, dim3(grid), dim3(NWAVES * 64), LDS_BYTES, stream, p); }
#endif
    const hipError_t le = hipPeekAtLastError();
    if (le != hipSuccess) fprintf(stderr, "kernel_launch: launch failed: %s\n", hipGetErrorName(le));
}
```

```cpp
#include <hip/hip_runtime.h>
#include <cstdio>
#include <cstdint>
#ifndef MK_ONE_LAUNCH
#define MK_ONE_LAUNCH 1
#endif
__device__ __forceinline__ int launder_v(int v) { asm volatile("" : "+v"(v)); return v; }
__device__ __forceinline__ int lane_id_fresh() { unsigned m = ~0u; asm volatile("" : "+s"(m)); return (int)__builtin_amdgcn_mbcnt_hi(m, __builtin_amdgcn_mbcnt_lo(m, 0u)); }
#ifndef WT_STORES
#define WT_STORES 0
#endif
typedef unsigned wt_u32x4 __attribute__((ext_vector_type(4)));
__device__ __forceinline__ void st16_wt(void* p, wt_u32x4 v) {
#if WT_STORES
    asm volatile("global_store_dwordx4 %0, %1, off sc1\n\ts_nop 1" :: "v"(p), "v"(v) : "memory");
#else
    *(wt_u32x4*)p = v;
#endif
}
namespace pg8 {
#define PG8_LAS __attribute__((address_space(3)))
typedef unsigned short bf16_t;
typedef short bf16x8 __attribute__((ext_vector_type(8)));
typedef float f32x4 __attribute__((ext_vector_type(4)));
typedef unsigned u32x4 __attribute__((ext_vector_type(4)));
constexpr int BM = 256, BK = 64, HALF = 128, HTB = HALF * BK * 2  , STAGE_BYTES = 8 * HTB, NXCD = 8, WGM = 8;

__host__ __device__ __forceinline__ int lds_byte(int r, int c) { const int st = (r >> 4) * 2 + (c >> 5), rr = r & 15, cc = c & 31, ob = rr * 64 + cc * 2; return st * 1024 + (ob ^ (((ob >> 9) & 1) << 5)); }
__host__ __device__ __forceinline__ void stage_rc(int b, int& R, int& C) { const int st = b / 1024, sb = b % 1024, swz = sb ^ (((sb >> 9) & 1) << 5); R = (st >> 1) * 16 + swz / 64; C = (st & 1) * 32 + (swz % 64) / 2; }
__host__ __device__ __forceinline__ int perm32(int rho) { const int n = rho >> 4, i = rho & 15; return 8 * (i >> 2) + 4 * n + (i & 3); }

struct Unit { int pm, pn; };
struct Gemm { const bf16_t* A; const bf16_t* Bt; int M, N, K; };

struct StaticOrder {
    int nM, nN, nwg, G, c;
    __host__ __device__ void init(int M, int N, int G_, int c_) { nM = M / BM; nN = N / BM; nwg = nM * nN; G = G_; c = c_; }
    __host__ __device__ bool next(int i, Unit& u) const {
        const long L = (long)i * G + c; if (L >= nwg) return false;
        int wgid = (int)L; { const int q = nwg / NXCD, r = nwg % NXCD, xcd = wgid % NXCD, off = wgid / NXCD; wgid = (xcd < r ? xcd * (q + 1) : r * (q + 1) + (xcd - r) * q) + off; }
        const int nig = WGM * nN, gid = wgid / nig, fm = gid * WGM, gsz = (nM - fm) < WGM ? (nM - fm) : WGM;
        u.pm = fm + ((wgid % nig) % gsz); u.pn = (wgid % nig) / gsz; return true;
    }
    __device__ __forceinline__ void a_ready(const Unit&) const {}
    __device__ __forceinline__ void done(const Unit&) const {}
};

__device__ __forceinline__ unsigned cvt_pk_bf16(float lo, float hi) { unsigned r; asm volatile("v_cvt_pk_bf16_f32 %0, %1, %2" : "=v"(r) : "v"(lo), "v"(hi)); return r; }
typedef float f32x2 __attribute__((ext_vector_type(2)));
__device__ __forceinline__ f32x2 gelu_pk(f32x2 v) {
    const f32x2 av = __builtin_elementwise_abs(v), d = av * 0.2316418882f + 1.0f;
    f32x2 t; t.x = __builtin_amdgcn_rcpf(d.x); t.y = __builtin_amdgcn_rcpf(d.y);
    f32x2 q = t * 0.5307027145f + (-0.7265760135f); q = q * t + 0.7107068705f; q = q * t + (-0.142248368f); q = q * t + 0.127414796f; q = q * t;
    const f32x2 s = (v * v) * (-0.72134752044f);
    f32x2 e; e.x = __builtin_amdgcn_exp2f(s.x); e.y = __builtin_amdgcn_exp2f(s.y);
    const f32x2 m = v * (q * e), r = v - m;
    f32x2 o; o.x = v.x < 0.f ? m.x : r.x; o.y = v.y < 0.f ? m.y : r.y; return o;
}

template <int ACT  > struct EpiBf16 {
    static constexpr bool PERM = true, AFTER_DRAIN = false; static_assert(ACT == 0 || ACT == 1, "EpiBf16: ACT is 0 (none) or 1 (gelu_pk)");
    bf16_t* O; int ldc; const float* bias; int split_cols; size_t split_stride; float scale0;
    __device__ __forceinline__ void operator()(const f32x4 (&acc)[2][2][4][2], const Unit& u, int wr, int wc, int fr, int fq) const {
        const int row0 = u.pm * BM + wr * 64 + fr; int colt = u.pn * BM; bf16_t* base = O;
        float sc = 1.f; if (split_cols) { const int t = colt / split_cols; base += (size_t)t * split_stride; colt -= t * split_cols; if (t == 0) sc = scale0; }
        const int col0 = colt + wc * 32 + 8 * fq, bcol0 = u.pn * BM + wc * 32 + 8 * fq;
        f32x4 bv[2][2];
#pragma unroll
        for (int bj = 0; bj < 2; ++bj)
#pragma unroll
            for (int n = 0; n < 2; ++n) bv[bj][n] = bias ? *(const f32x4*)(bias + bcol0 + bj * HALF + 4 * n) : (f32x4){0.f, 0.f, 0.f, 0.f};
#pragma unroll
        for (int ai = 0; ai < 2; ++ai)
#pragma unroll
            for (int m = 0; m < 4; ++m) { bf16_t* rowp = base + (size_t)(row0 + ai * HALF + m * 16) * ldc + col0;
#pragma unroll
                for (int bj = 0; bj < 2; ++bj) { f32x4 v0 = acc[ai][bj][m][0] + bv[bj][0], v1 = acc[ai][bj][m][1] + bv[bj][1];
                    if (ACT == 1) { f32x2 a = gelu_pk((f32x2){v0[0], v0[1]}), b = gelu_pk((f32x2){v0[2], v0[3]}), c = gelu_pk((f32x2){v1[0], v1[1]}), d = gelu_pk((f32x2){v1[2], v1[3]});
                        v0 = (f32x4){a.x, a.y, b.x, b.y}; v1 = (f32x4){c.x, c.y, d.x, d.y}; }
                    v0 = v0 * sc; v1 = v1 * sc; u32x4 w; w.x = cvt_pk_bf16(v0[0], v0[1]); w.y = cvt_pk_bf16(v0[2], v0[3]); w.z = cvt_pk_bf16(v1[0], v1[1]); w.w = cvt_pk_bf16(v1[2], v1[3]);
                    *(u32x4*)(rowp + bj * HALF) = w; } }
    }
};
template <class Epi, class Sched, bool ALIGN_EPI = false, bool SP2 = false>
__device__ __forceinline__ void gemm_phase(PG8_LAS unsigned char* lds, const Gemm g, const Sched& S, const Epi& E, const int tid_in) {
    const int tid = launder_v(tid_in) & 511, wid = __builtin_amdgcn_readfirstlane(tid >> 6), lane = tid & 63, wr = wid >> 2, wc = wid & 3, fr = lane & 15, fq = lane >> 4;
    const int K = g.K, nt = K / BK;
    unsigned voffA[2], voffB[2];
#pragma unroll
    for (int i = 0; i < 2; ++i) { int R, C; stage_rc(tid * 16 + i * 8192, R, C); const int Rb = Epi::PERM ? ((R & ~31) + perm32(R & 31)) : R;
        voffA[i] = (unsigned)(R * K + C) * 2u; voffB[i] = (unsigned)(Rb * K + C) * 2u; }
    const size_t kstep = (size_t)(BK * 2);
    const size_t hstep = (size_t)HALF * K * 2;
    const size_t tstep = 2 * hstep;
    const unsigned ldsw = (unsigned)wid * 1024u;
    const int aoff = lds_byte(wr * 64 + fr, fq * 8), boff = lds_byte(wc * 32 + fr, fq * 8);
#define PG8_SA(b, h) (((b) * 2 + (h)) * HTB)
#define PG8_SB(b, h) ((4 + (b) * 2 + (h)) * HTB)
#define PG8_STAGE(bufoff, gbase, voff) do { _Pragma("unroll") for (int _i = 0; _i < 2; ++_i) \
        __builtin_amdgcn_global_load_lds((const unsigned*)((const char*)(gbase) + (voff)[_i]), (PG8_LAS unsigned*)(lds + (bufoff) + ldsw + _i * 8192), 16, 0, 0); } while (0)
#define PG8_LDA(dst, b, h) do { _Pragma("unroll") for (int m = 0; m < 4; ++m) _Pragma("unroll") for (int k = 0; k < 2; ++k) dst[m][k] = *(const PG8_LAS bf16x8*)(lds + PG8_SA(b, h) + aoff + m * 2048 + k * 1024); } while (0)
#define PG8_LDB(dst, b, h) do { _Pragma("unroll") for (int n = 0; n < 2; ++n) _Pragma("unroll") for (int k = 0; k < 2; ++k) dst[n][k] = *(const PG8_LAS bf16x8*)(lds + PG8_SB(b, h) + boff + n * 2048 + k * 1024); } while (0)
#define PG8_MMA(ai, bj, At, Bt) do { __builtin_amdgcn_s_setprio(1); _Pragma("unroll") for (int m = 0; m < 4; ++m) _Pragma("unroll") for (int n = 0; n < 2; ++n) _Pragma("unroll") for (int k = 0; k < 2; ++k) \
        acc[ai][bj][m][n] = __builtin_amdgcn_mfma_f32_16x16x32_bf16(Bt[n][k], At[m][k], acc[ai][bj][m][n], 0, 0, 0); __builtin_amdgcn_s_setprio(0); } while (0)
#define PG8_WAIT_V(n) asm volatile("s_waitcnt vmcnt(" #n ")" ::: "memory")
#define PG8_WAIT_L(n) asm volatile("s_waitcnt lgkmcnt(" #n ")" ::: "memory")
#define PG8_BAR __builtin_amdgcn_s_barrier()
#define PG8_SCHED __builtin_amdgcn_sched_barrier(0)
    Unit cur, nxt; int ui = 0;
    if (!S.next(0, cur)) return;
    f32x4 acc[2][2][4][2];
#pragma unroll
    for (int a = 0; a < 2; ++a)
#pragma unroll
        for (int b = 0; b < 2; ++b)
#pragma unroll
            for (int m = 0; m < 4; ++m)
#pragma unroll
                for (int n = 0; n < 2; ++n) acc[a][b][m][n] = (f32x4){0.f, 0.f, 0.f, 0.f};
    bf16x8 At[4][2], B0[2][2], B1[2][2];
    const char* cA = (const char*)g.A + (size_t)cur.pm * tstep; const char* cB = (const char*)g.Bt + (size_t)cur.pn * tstep;
    S.a_ready(cur);
    if constexpr (SP2) {
        PG8_STAGE(PG8_SB(0, 0), cB, voffB); PG8_STAGE(PG8_SB(0, 1), cB + hstep, voffB); PG8_STAGE(PG8_SA(0, 0), cA, voffA); PG8_STAGE(PG8_SA(0, 1), cA + hstep, voffA);
        if (wr == 1) PG8_BAR;
        PG8_WAIT_V(2); PG8_BAR;
        PG8_STAGE(PG8_SB(1, 0), cB + kstep, voffB); PG8_STAGE(PG8_SA(1, 0), cA + kstep, voffA); PG8_STAGE(PG8_SB(1, 1), cB + hstep + kstep, voffB);
        PG8_WAIT_V(6); PG8_BAR;
    } else {
        PG8_STAGE(PG8_SB(0, 0), cB, voffB); PG8_STAGE(PG8_SA(0, 0), cA, voffA); PG8_STAGE(PG8_SB(0, 1), cB + hstep, voffB); PG8_STAGE(PG8_SA(0, 1), cA + hstep, voffA);
        if (wr == 1) PG8_BAR;
        PG8_WAIT_V(4); PG8_BAR;
        PG8_STAGE(PG8_SB(1, 0), cB + kstep, voffB); PG8_STAGE(PG8_SA(1, 0), cA + kstep, voffA); PG8_STAGE(PG8_SB(1, 1), cB + hstep + kstep, voffB);
        PG8_WAIT_V(6); PG8_BAR;
    }
    for (;;) {
        const bool has_next = S.next(ui + 1, nxt);
        const char* nA = has_next ? (const char*)g.A + (size_t)nxt.pm * tstep : cA; const char* nB = has_next ? (const char*)g.Bt + (size_t)nxt.pn * tstep : cB;
        for (int t = 0; t < nt; t += 2) {
            const bool last = (t == nt - 2);
            const char* a1 = cA + (size_t)(t + 1) * kstep;
            const char* a2 = last ? nA : cA + (size_t)(t + 2) * kstep; const char* b2 = last ? nB : cB + (size_t)(t + 2) * kstep;
            const char* a3 = a2 + kstep; const char* b3 = b2 + kstep;
            if (last && has_next) S.a_ready(nxt);
            if constexpr (SP2) {
            PG8_LDB(B0, 0, 0); PG8_LDB(B1, 0, 1); PG8_SCHED; PG8_LDA(At, 0, 0); PG8_STAGE(PG8_SA(1, 1), a1 + hstep, voffA);
            PG8_WAIT_V(8); PG8_WAIT_L(0); PG8_BAR; PG8_MMA(0, 0, At, B0); PG8_MMA(0, 1, At, B1); PG8_BAR; PG8_SCHED;
            PG8_LDA(At, 0, 1); PG8_STAGE(PG8_SB(0, 0), b2, voffB); PG8_STAGE(PG8_SB(0, 1), b2 + hstep, voffB); PG8_STAGE(PG8_SA(0, 0), a2, voffA);
            PG8_WAIT_V(8); PG8_WAIT_L(0); PG8_BAR; PG8_MMA(1, 0, At, B0); PG8_MMA(1, 1, At, B1); PG8_BAR; PG8_SCHED;
            PG8_LDB(B0, 1, 0); PG8_LDB(B1, 1, 1); PG8_SCHED; PG8_LDA(At, 1, 0); PG8_STAGE(PG8_SA(0, 1), a2 + hstep, voffA);
            PG8_WAIT_V(8); PG8_WAIT_L(0); PG8_BAR; PG8_MMA(0, 0, At, B0); PG8_MMA(0, 1, At, B1); PG8_BAR; PG8_SCHED;
            PG8_LDA(At, 1, 1); PG8_STAGE(PG8_SB(1, 0), b3, voffB); PG8_STAGE(PG8_SB(1, 1), b3 + hstep, voffB); PG8_STAGE(PG8_SA(1, 0), a3, voffA);
            PG8_WAIT_V(8); PG8_WAIT_L(0); PG8_BAR; PG8_MMA(1, 0, At, B0); PG8_MMA(1, 1, At, B1); PG8_BAR; PG8_SCHED;
            } else {
            PG8_LDB(B0, 0, 0); PG8_SCHED; PG8_LDA(At, 0, 0); PG8_STAGE(PG8_SA(1, 1), a1 + hstep, voffA);
            PG8_WAIT_L(8); PG8_BAR; PG8_WAIT_L(0); PG8_MMA(0, 0, At, B0); PG8_BAR; PG8_SCHED;
            PG8_LDB(B1, 0, 1); PG8_STAGE(PG8_SB(0, 0), b2, voffB);
            PG8_BAR; PG8_WAIT_L(0); PG8_MMA(0, 1, At, B1); PG8_BAR;
            PG8_LDA(At, 0, 1); PG8_STAGE(PG8_SA(0, 0), a2, voffA);
            PG8_BAR; PG8_WAIT_L(0); PG8_MMA(1, 0, At, B0); PG8_BAR; PG8_SCHED;
            PG8_STAGE(PG8_SB(0, 1), b2 + hstep, voffB);
            PG8_WAIT_V(6); PG8_BAR; PG8_MMA(1, 1, At, B1); PG8_BAR;
            PG8_LDB(B0, 1, 0); PG8_SCHED; PG8_LDA(At, 1, 0); PG8_STAGE(PG8_SA(0, 1), a2 + hstep, voffA);
            PG8_WAIT_L(8); PG8_BAR; PG8_WAIT_L(0); PG8_MMA(0, 0, At, B0); PG8_BAR; PG8_SCHED;
            PG8_LDB(B1, 1, 1); PG8_STAGE(PG8_SB(1, 0), b3, voffB);
            PG8_BAR; PG8_WAIT_L(0); PG8_MMA(0, 1, At, B1); PG8_BAR;
            PG8_LDA(At, 1, 1); PG8_STAGE(PG8_SA(1, 0), a3, voffA);
            PG8_BAR; PG8_WAIT_L(0); PG8_MMA(1, 0, At, B0); PG8_BAR; PG8_SCHED;
            PG8_STAGE(PG8_SB(1, 1), b3 + hstep, voffB);
            PG8_WAIT_V(6); PG8_BAR; PG8_MMA(1, 1, At, B1); PG8_BAR;
            }
        }
        if constexpr (ALIGN_EPI) { if (wr == 0) PG8_BAR; }
        if constexpr (!Epi::AFTER_DRAIN) { E(acc, cur, wr, wc, fr, fq); S.done(cur); }
        if (!has_next) break;
#pragma unroll
        for (int a = 0; a < 2; ++a)
#pragma unroll
            for (int b = 0; b < 2; ++b)
#pragma unroll
                for (int m = 0; m < 4; ++m)
#pragma unroll
                    for (int n = 0; n < 2; ++n) acc[a][b][m][n] = (f32x4){0.f, 0.f, 0.f, 0.f};
        cur = nxt; cA = nA; cB = nB; ++ui;
        if constexpr (ALIGN_EPI) { if (wr == 1) PG8_BAR; }
    }
    PG8_WAIT_V(0);
    if constexpr (!ALIGN_EPI) { if (wr == 0) PG8_BAR; }
    PG8_BAR;
    if constexpr (Epi::AFTER_DRAIN) { E.fused(acc, cur, wr, wc, fr, fq, lds, wid, lane); S.done(cur); }
#undef PG8_SA
#undef PG8_SB
#undef PG8_STAGE
#undef PG8_LDA
#undef PG8_LDB
#undef PG8_MMA
#undef PG8_WAIT_V
#undef PG8_WAIT_L
#undef PG8_BAR
#undef PG8_SCHED
}
}

namespace pg8 {
__device__ __forceinline__ float gelu_tanh(float x) {
    const float t = x * (1.5957691216057308f + 0.07135481627f * x * x);
    const float e = __builtin_amdgcn_exp2f(-1.4426950408889634f * t);
    return x * __builtin_amdgcn_rcpf(1.0f + e);
}
template <int ACT> struct EpiT {
    static constexpr bool PERM = true, AFTER_DRAIN = false;
    bf16_t* O; int ldc;
    __device__ __forceinline__ void operator()(const f32x4 (&acc)[2][2][4][2], const Unit& u, int wr, int wc, int fr, int fq) const {
        const int row0 = u.pm * BM + wr * 64 + fr; const int col0 = u.pn * BM + wc * 32 + 8 * fq;
#pragma unroll
        for (int ai = 0; ai < 2; ++ai)
#pragma unroll
            for (int m = 0; m < 4; ++m) { bf16_t* rowp = O + (size_t)(row0 + ai * HALF + m * 16) * ldc + col0;
#pragma unroll
                for (int bj = 0; bj < 2; ++bj) { f32x4 v0 = acc[ai][bj][m][0], v1 = acc[ai][bj][m][1];
                    if (ACT == 2) { v0 = (f32x4){gelu_tanh(v0[0]), gelu_tanh(v0[1]), gelu_tanh(v0[2]), gelu_tanh(v0[3])}; v1 = (f32x4){gelu_tanh(v1[0]), gelu_tanh(v1[1]), gelu_tanh(v1[2]), gelu_tanh(v1[3])}; }
                    u32x4 w; w.x = cvt_pk_bf16(v0[0], v0[1]); w.y = cvt_pk_bf16(v0[2], v0[3]); w.z = cvt_pk_bf16(v1[0], v1[1]); w.w = cvt_pk_bf16(v1[2], v1[3]);
                    ::st16_wt(rowp + bj * HALF, w); } }
    }
};
struct EpiR {
    static constexpr bool PERM = true, AFTER_DRAIN = false;
    bf16_t* O; int ldc; int act; int rope; const float* ropet;
    __device__ __forceinline__ void operator()(const f32x4 (&acc)[2][2][4][2], const Unit& u, int wr, int wc, int fr, int fq) const {
        const int row0 = u.pm * BM + wr * 64 + fr; const int col0 = u.pn * BM + wc * 32 + 8 * fq;
        const bool rrows = rope != 0 && u.pm < 64;
#pragma unroll
        for (int ai = 0; ai < 2; ++ai)
#pragma unroll
            for (int m = 0; m < 4; ++m) { const int grow = row0 + ai * HALF + m * 16; bf16_t* rowp = O + (size_t)grow * ldc + col0;
#pragma unroll
                for (int bj = 0; bj < 2; ++bj) { f32x4 v0 = acc[ai][bj][m][0], v1 = acc[ai][bj][m][1];
                    if (act) { v0 = (f32x4){gelu_tanh(v0[0]), gelu_tanh(v0[1]), gelu_tanh(v0[2]), gelu_tanh(v0[3])}; v1 = (f32x4){gelu_tanh(v1[0]), gelu_tanh(v1[1]), gelu_tanh(v1[2]), gelu_tanh(v1[3])}; }
                    if (rrows) { const int blk = u.pn * 8 + bj * 4 + wc; const int b6 = blk % 6; const bool on = rope == 1 ? (blk < 128) : (b6 >= 4); const int half = rope == 1 ? (blk & 1) : (b6 - 4);
                        if (on) { const int t = grow & 8191; const int pos = half ? (t & 63) : (t >> 6);
                            const float* cp = ropet + pos * 16 + 8 * (fq & 1); const f32x4 c0 = *(const f32x4*)cp, c1 = *(const f32x4*)(cp + 4), s0 = *(const f32x4*)(cp + 2048), s1 = *(const f32x4*)(cp + 2052);
                            f32x4 p0, p1;
#pragma unroll
                            for (int i = 0; i < 4; ++i) { const float a_ = v0[i], b_ = v1[i];
                                const auto r0 = __builtin_amdgcn_permlane32_swap(__float_as_uint(a_), __float_as_uint(a_), false, false);
                                const auto r1 = __builtin_amdgcn_permlane32_swap(__float_as_uint(b_), __float_as_uint(b_), false, false);
                                const unsigned x0_ = (fq & 2) ? r0[0] : r0[1], x1_ = (fq & 2) ? r1[0] : r1[1]; p0[i] = __uint_as_float(x0_); p1[i] = __uint_as_float(x1_); }
                            if (fq & 2) { v0 = p0 * s0 + v0 * c0; v1 = p1 * s1 + v1 * c1; } else { v0 = v0 * c0 - p0 * s0; v1 = v1 * c1 - p1 * s1; } } }
                    u32x4 w; w.x = cvt_pk_bf16(v0[0], v0[1]); w.y = cvt_pk_bf16(v0[2], v0[3]); w.z = cvt_pk_bf16(v1[0], v1[1]); w.w = cvt_pk_bf16(v1[2], v1[3]);
                    ::st16_wt(rowp + bj * HALF, w); } }
    }
};
}

constexpr int DM = 2048, NBATCH = 2, SEQ = 8192, CTXL = 256;
constexpr int ML = NBATCH * SEQ;
constexpr int MC = NBATCH * CTXL;
constexpr int MT = ML + MC;
constexpr int NLAYER = 4;
constexpr float ALPHA = 1.6817928305074290f, LN_EPS = 1e-6f;
constexpr int NWAVES = 8;
constexpr float U_SCALE = 64.0f, V_SCALE = 4.0f;
constexpr int PROW = 1536;
#ifndef PEER_V4
#define PEER_V4 1
#endif
#ifndef PEER_U4
#define PEER_U4 1
#endif
constexpr int PREC = PEER_U4 ? 2048 : PEER_V4 ? 2560 : 2 * PROW;
constexpr int NPH = 35;

constexpr size_t MiB = 1ull << 20;
constexpr size_t WS_CTL = 0, CTL_ZERO_BYTES = 1 * MiB;
constexpr int    CW_BAR = 4096;
constexpr size_t WS_MOD = 128 * 1024;
constexpr size_t WS_VST = 1 * MiB;
constexpr size_t WS_ROPE = 1 * MiB + 160 * 1024;
constexpr size_t WS_MODP = 1 * MiB + 256 * 1024;
constexpr size_t WS_GMWIN = 6 * MiB;
constexpr size_t WS_GMWOUT = WS_GMWIN + 32 * MiB;
constexpr size_t WS_GMWS = WS_GMWOUT + 16 * MiB;
constexpr size_t WS_PWQ = WS_GMWS + 1 * MiB;
constexpr size_t WS_PK1 = WS_PWQ + 32 * MiB;
constexpr size_t WS_PK2 = WS_PK1 + 512 * 1024;
constexpr size_t WS_MLAIN = WS_PK1 + 1 * MiB;
constexpr size_t WS_MLAUQ = WS_MLAIN + 5 * MiB;
constexpr size_t WS_MLAUKV = WS_MLAUQ + 3 * MiB;
constexpr size_t WS_MLAOUT = WS_MLAUKV + 4 * MiB;
constexpr size_t WS_DAIN = WS_MLAOUT + 8 * MiB;
constexpr size_t WS_DAOUT = WS_DAIN + 24 * MiB;
constexpr size_t WS_PU = WS_DAOUT + 8 * MiB;
constexpr size_t WS_PV = WS_PU + 96 * MiB;
constexpr size_t WS_X = WS_PV + 96 * MiB;
constexpr size_t WS_H = WS_X + 66 * MiB;
constexpr size_t WS_G = WS_H + 66 * MiB;
constexpr size_t WS_Y = WS_G + 66 * MiB;
constexpr size_t WS_QP = WS_Y + 66 * MiB;
constexpr size_t WS_Z = WS_QP + 66 * MiB;
constexpr size_t WS_C = WS_Z + 198 * MiB;
constexpr size_t WS_CQN = WS_C + 42 * MiB;
constexpr size_t WS_CKVN = WS_CQN + 17 * MiB;
constexpr size_t WS_KR = WS_CKVN + 17 * MiB;
constexpr size_t WS_QM = WS_KR + 3 * MiB;
constexpr size_t WS_KV = WS_QM + 99 * MiB;
constexpr size_t WS_ROUTE = WS_KV + 132 * MiB;
constexpr size_t WS_END = WS_ROUTE + 17 * MiB;
static_assert((size_t)MT * DM * 2 == 66 * MiB, "row buffer size");

constexpr int RING_BYTES = 155648, MISC_OFF = RING_BYTES + 320, LDS_BYTES = 159744;

#define GAS __attribute__((address_space(1)))
#define LAS __attribute__((address_space(3)))
typedef unsigned short bf16;
typedef unsigned u32x4 __attribute__((ext_vector_type(4)));
typedef unsigned u32x2 __attribute__((ext_vector_type(2)));
typedef float f32x4 __attribute__((ext_vector_type(4)));
typedef float f32x16 __attribute__((ext_vector_type(16)));
typedef short bf16x8 __attribute__((ext_vector_type(8)));
typedef short s16x4 __attribute__((ext_vector_type(4)));
#define LDS_WAIT() asm volatile("s_waitcnt lgkmcnt(0)" ::: "memory")

__device__ __forceinline__ unsigned cvtpk(float lo, float hi) { unsigned r; asm("v_cvt_pk_bf16_f32 %0, %1, %2" : "=v"(r) : "v"(lo), "v"(hi)); return r; }
__device__ __forceinline__ float bflo(unsigned w) { return __uint_as_float(w << 16); }
__device__ __forceinline__ float bfhi(unsigned w) { return __uint_as_float(w & 0xffff0000u); }
__device__ __forceinline__ float bf1(bf16 b) { return __uint_as_float((unsigned)b << 16); }
__device__ __forceinline__ bf16 tobf1(float f) { return (bf16)(cvtpk(f, 0.f) & 0xffffu); }
#define DPP_F(v, ctrl) __int_as_float(__builtin_amdgcn_mov_dpp(__float_as_int(v), (ctrl), 0xF, 0xF, true))
__device__ __forceinline__ float row_sum16(float v) { v += DPP_F(v, 0xB1); v += DPP_F(v, 0x4E); v += DPP_F(v, 0x141); v += DPP_F(v, 0x140); return v; }
__device__ __forceinline__ float sum_xor16(float v) { const auto r = __builtin_amdgcn_permlane16_swap(__float_as_uint(v), __float_as_uint(v), false, false); return __uint_as_float(r[0]) + __uint_as_float(r[1]); }
__device__ __forceinline__ float sum_xor32(float v) { const auto r = __builtin_amdgcn_permlane32_swap(__float_as_uint(v), __float_as_uint(v), false, false); return __uint_as_float(r[0]) + __uint_as_float(r[1]); }
__device__ __forceinline__ float wave_sum(float v) { return sum_xor32(sum_xor16(row_sum16(v))); }
__device__ __forceinline__ float half_sum32(float v) { return sum_xor16(row_sum16(v)); }
__device__ __forceinline__ float lane_xor16(float v, int lane) { const auto r = __builtin_amdgcn_permlane16_swap(__float_as_uint(v), __float_as_uint(v), false, false); return __uint_as_float((lane & 16) ? r[0] : r[1]); }
__device__ __forceinline__ unsigned lane_xor32(unsigned v, int lane) { const auto r = __builtin_amdgcn_permlane32_swap(v, v, false, false); return (lane & 32) ? r[0] : r[1]; }
__device__ __forceinline__ float gelu_tanh(float x) { return pg8::gelu_tanh(x); }

__device__ __forceinline__ void load_row_bf16(const bf16* row, int lane, float (&v)[32]) {
#pragma unroll
    for (int j = 0; j < 4; ++j) { const u32x4 w = ((const u32x4*)row)[64 * j + lane];
        v[8 * j + 0] = bflo(w.x); v[8 * j + 1] = bfhi(w.x); v[8 * j + 2] = bflo(w.y); v[8 * j + 3] = bfhi(w.y);
        v[8 * j + 4] = bflo(w.z); v[8 * j + 5] = bfhi(w.z); v[8 * j + 6] = bflo(w.w); v[8 * j + 7] = bfhi(w.w); }
}
__device__ __forceinline__ void load_row_bf16_nt(const bf16* row, int lane, float (&v)[32]) {
#pragma unroll
    for (int j = 0; j < 4; ++j) { const u32x4 w = __builtin_nontemporal_load(&((const u32x4*)row)[64 * j + lane]);
        v[8 * j + 0] = bflo(w.x); v[8 * j + 1] = bfhi(w.x); v[8 * j + 2] = bflo(w.y); v[8 * j + 3] = bfhi(w.y);
        v[8 * j + 4] = bflo(w.z); v[8 * j + 5] = bfhi(w.z); v[8 * j + 6] = bflo(w.w); v[8 * j + 7] = bfhi(w.w); }
}
__device__ __forceinline__ void store_row_bf16(bf16* row, int lane, const float (&v)[32]) {
#pragma unroll
    for (int j = 0; j < 4; ++j) { u32x4 w; w.x = cvtpk(v[8 * j + 0], v[8 * j + 1]); w.y = cvtpk(v[8 * j + 2], v[8 * j + 3]); w.z = cvtpk(v[8 * j + 4], v[8 * j + 5]); w.w = cvtpk(v[8 * j + 6], v[8 * j + 7]);
        ((u32x4*)row)[64 * j + lane] = w; }
}
__device__ __forceinline__ void load_row_f32(const float* row, int lane, float (&v)[32]) {
#pragma unroll
    for (int j = 0; j < 4; ++j) { const f32x4 a = ((const f32x4*)row)[128 * j + 2 * lane], b = ((const f32x4*)row)[128 * j + 2 * lane + 1];
        v[8 * j + 0] = a.x; v[8 * j + 1] = a.y; v[8 * j + 2] = a.z; v[8 * j + 3] = a.w; v[8 * j + 4] = b.x; v[8 * j + 5] = b.y; v[8 * j + 6] = b.z; v[8 * j + 7] = b.w; }
}
__device__ __forceinline__ void load_row_f32_nt(const float* row, int lane, float (&v)[32]) {
#pragma unroll
    for (int j = 0; j < 4; ++j) { const f32x4 a = __builtin_nontemporal_load(&((const f32x4*)row)[128 * j + 2 * lane]), b = __builtin_nontemporal_load(&((const f32x4*)row)[128 * j + 2 * lane + 1]);
        v[8 * j + 0] = a.x; v[8 * j + 1] = a.y; v[8 * j + 2] = a.z; v[8 * j + 3] = a.w; v[8 * j + 4] = b.x; v[8 * j + 5] = b.y; v[8 * j + 6] = b.z; v[8 * j + 7] = b.w; }
}
__device__ __forceinline__ void store_row_f32(float* row, int lane, const float (&v)[32]) {
#pragma unroll
    for (int j = 0; j < 4; ++j) { ((f32x4*)row)[128 * j + 2 * lane] = (f32x4){v[8 * j + 0], v[8 * j + 1], v[8 * j + 2], v[8 * j + 3]};
        ((f32x4*)row)[128 * j + 2 * lane + 1] = (f32x4){v[8 * j + 4], v[8 * j + 5], v[8 * j + 6], v[8 * j + 7]}; }
}
__device__ __forceinline__ void load_row_bf16_b(const bf16* row, int lane, float (&v)[32]) {
#pragma unroll
    for (int j = 0; j < 4; ++j) { const u32x4 w = ((const u32x4*)row)[4 * lane + j];
        v[8 * j + 0] = bflo(w.x); v[8 * j + 1] = bfhi(w.x); v[8 * j + 2] = bflo(w.y); v[8 * j + 3] = bfhi(w.y);
        v[8 * j + 4] = bflo(w.z); v[8 * j + 5] = bfhi(w.z); v[8 * j + 6] = bflo(w.w); v[8 * j + 7] = bfhi(w.w); }
}
__device__ __forceinline__ void store_row_bf16_b(bf16* row, int lane, const float (&v)[32]) {
#pragma unroll
    for (int j = 0; j < 4; ++j) { u32x4 w; w.x = cvtpk(v[8 * j + 0], v[8 * j + 1]); w.y = cvtpk(v[8 * j + 2], v[8 * j + 3]); w.z = cvtpk(v[8 * j + 4], v[8 * j + 5]); w.w = cvtpk(v[8 * j + 6], v[8 * j + 7]);
        ((u32x4*)row)[4 * lane + j] = w; }
}
__device__ __forceinline__ void load_row_f32_b(const float* row, int lane, float (&v)[32]) {
#pragma unroll
    for (int q = 0; q < 8; ++q) { const f32x4 a = ((const f32x4*)row)[8 * lane + q];
        v[4 * q + 0] = a.x; v[4 * q + 1] = a.y; v[4 * q + 2] = a.z; v[4 * q + 3] = a.w; }
}
__device__ __forceinline__ void store_row_f32_b(float* row, int lane, const float (&v)[32]) {
#pragma unroll
    for (int q = 0; q < 8; ++q) ((f32x4*)row)[8 * lane + q] = (f32x4){v[4 * q + 0], v[4 * q + 1], v[4 * q + 2], v[4 * q + 3]};
}
__device__ __forceinline__ void store_row_f32_b_nt(float* row, int lane, const float (&v)[32]) {
#pragma unroll
    for (int q = 0; q < 8; ++q) __builtin_nontemporal_store((f32x4){v[4 * q + 0], v[4 * q + 1], v[4 * q + 2], v[4 * q + 3]}, &((f32x4*)row)[8 * lane + q]);
}
__device__ __forceinline__ void ln_stats(const float (&v)[32], float& mean, float& rstd) {
    float s = 0.f;
#pragma unroll
    for (int i = 0; i < 32; ++i) s += v[i];
    mean = wave_sum(s) * (1.0f / DM);
    float q = 0.f;
#pragma unroll
    for (int i = 0; i < 32; ++i) { const float d = v[i] - mean; q += d * d; }
    rstd = 1.0f / sqrtf(wave_sum(q) * (1.0f / DM) + LN_EPS);
}
template <bool LAYB>
__device__ __forceinline__ void finish_row(float (&z)[32], const float* lng, const float* lnb, bf16* Xrow, const float* sh, const float* sc, bf16* Hrow, float* Orow, int lane) {
    float mean, rstd; ln_stats(z, mean, rstd);
    { float g[32], b[32]; if (LAYB) { load_row_f32_b(lng, lane, g); load_row_f32_b(lnb, lane, b); } else { load_row_f32(lng, lane, g); load_row_f32(lnb, lane, b); }
#pragma unroll
      for (int i = 0; i < 32; ++i) z[i] = (z[i] - mean) * rstd * g[i] + b[i]; }
    if (Xrow) { if (LAYB) store_row_bf16_b(Xrow, lane, z); else store_row_bf16(Xrow, lane, z); }
    if (Orow) { if (LAYB) store_row_f32_b(Orow, lane, z); else store_row_f32(Orow, lane, z); }
    if (Hrow) {
        ln_stats(z, mean, rstd);
        float a[32], s[32]; if (LAYB) { load_row_f32_b(sc, lane, a); load_row_f32_b(sh, lane, s); } else { load_row_f32(sc, lane, a); load_row_f32(sh, lane, s); }
#pragma unroll
        for (int i = 0; i < 32; ++i) a[i] = (z[i] - mean) * rstd * (1.0f + a[i]) + s[i];
        if (LAYB) store_row_bf16_b(Hrow, lane, a); else store_row_bf16(Hrow, lane, a);
    }
}
__device__ __forceinline__ int row_slot(int row) { return row < ML ? (row >> 13) : 2; }

__device__ __forceinline__ unsigned f2bf_rne(float f) { unsigned u = __float_as_uint(f); return (u + 0x7fffu + ((u >> 16) & 1u)) >> 16; }
__device__ __forceinline__ unsigned pk2(float lo, float hi) { return f2bf_rne(lo) | (f2bf_rne(hi) << 16); }
#ifndef GEMV_PIPE
#define GEMV_PIPE 1
#endif
#ifndef NT_ACT
#define NT_ACT 0
#endif
#ifndef NT_STREAM
#define NT_STREAM 1
#endif
__device__ __forceinline__ void p0_transpose_item(const float* W, int K, int N, bf16* WT, LAS float* scr, int item, int lane) {
    const int nblk = N / 32, kb = item / nblk, nb = item % nblk, k0 = 64 * kb, n0 = 32 * nb;
    f32x4 t[8];
#pragma unroll
    for (int i = 0; i < 8; ++i) { const f32x4* p_ = (const f32x4*)(W + (size_t)(k0 + 8 * i + (lane >> 3)) * N + n0 + 4 * (lane & 7)); t[i] = NT_STREAM ? __builtin_nontemporal_load(p_) : *p_; }
#pragma unroll
    for (int i = 0; i < 8; ++i) { LAS float* d = scr + (8 * i + (lane >> 3)) * 33 + 4 * (lane & 7); d[0] = t[i].x; d[1] = t[i].y; d[2] = t[i].z; d[3] = t[i].w; }
    LDS_WAIT(); asm volatile("" ::: "memory");
    const int c = lane & 7;
#pragma unroll
    for (int j = 0; j < 4; ++j) { const int n = (lane >> 3) + 8 * j; const LAS float* s = scr + (8 * c) * 33 + n;
        u32x4 o; o.x = pk2(s[0 * 33], s[1 * 33]); o.y = pk2(s[2 * 33], s[3 * 33]); o.z = pk2(s[4 * 33], s[5 * 33]); o.w = pk2(s[6 * 33], s[7 * 33]);
        *(u32x4*)(WT + (size_t)(n0 + n) * K + k0 + 8 * c) = o; }
    LDS_WAIT(); asm volatile("" ::: "memory");
}
__device__ __forceinline__ void cvt_range(const float* src, bf16* dst, size_t n8, size_t gtid, size_t gthreads) {
#pragma unroll 4
    for (size_t i = gtid; i < n8; i += gthreads) { const f32x4 a = ((const f32x4*)src)[2 * i], b = ((const f32x4*)src)[2 * i + 1];
        u32x4 w; w.x = cvtpk(a.x, a.y); w.y = cvtpk(a.z, a.w); w.z = cvtpk(b.x, b.y); w.w = cvtpk(b.z, b.w); ((u32x4*)dst)[i] = w; }
}
__device__ __forceinline__ unsigned enc_e2m3(float x) {
    const unsigned sgn = (__float_as_uint(x) >> 26) & 32u;
    const float ax = fminf(fabsf(x), 7.5f);
    unsigned u = __float_as_uint(ax); u += 0x7FFFFu + ((u >> 20) & 1u);
    const unsigned cn = (u >> 20) - ((127u - 1u) << 3);
    const unsigned cs = (unsigned)__builtin_rintf(ax * 8.0f);
    return sgn | (ax < 1.0f ? cs : cn);
}
#ifndef EMU_FP4V
#define EMU_FP4V 0
#endif
#ifndef CVT_PIPE
#define CVT_PIPE 0
#endif
typedef float f32x2v __attribute__((ext_vector_type(2)));
typedef float f32x16v __attribute__((ext_vector_type(16)));
typedef float f32x32v __attribute__((ext_vector_type(32)));
typedef unsigned u32x6v __attribute__((ext_vector_type(6)));
__device__ __forceinline__ u32x6v pack_fp6_32(const float (&e)[32], bool interleaved) {
    f32x16v s0, s1;
    if (interleaved) {
#pragma unroll
        for (int i = 0; i < 16; ++i) { s0[i] = e[2 * i]; s1[i] = e[2 * i + 1]; }
    } else {
#pragma unroll
        for (int i = 0; i < 16; ++i) { s0[i] = e[i]; s1[i] = e[16 + i]; }
    }
    return __builtin_amdgcn_cvt_scalef32_2xpk16_fp6_f32(s0, s1, 1.0f);
}
__device__ __forceinline__ void cvt_table_fp6(const float* src, unsigned char* dst, int nrows, float scale, LAS float* scr  , int lane, int gw, int NGW, const int isv) {
    bool interleaved;
    {
        float t[32];
#pragma unroll
        for (int k = 0; k < 32; ++k) t[k] = k < 16 ? 0.125f * k : (k < 24 ? 2.0f + 0.25f * (k - 16) : 4.0f + 0.5f * (k - 24));
        float tt[32];
#pragma unroll
        for (int k = 0; k < 32; ++k) { tt[k] = t[k]; asm volatile("" : "+v"(tt[k])); }
        const u32x6v p = pack_fp6_32(tt, true);
        const f32x32v o = __builtin_amdgcn_cvt_scalef32_pk32_f32_fp6(p, 1.0f);
        interleaved = (o[1] == t[1]) && (o[2] == t[2]) && (o[17] == t[17]);
        interleaved = __all(interleaved);
    }
#if CVT_PIPE
    f32x4 nx[8];
    if (gw < nrows) { const f32x4* s4 = (const f32x4*)(src + (size_t)gw * 2048);
#pragma unroll
        for (int q = 0; q < 8; ++q) nx[q] = s4[64 * q + lane]; }
    for (int row = gw; row < nrows; row += NGW) {
        f32x4 cur[8];
#pragma unroll
        for (int q = 0; q < 8; ++q) cur[q] = nx[q];
        if (row + NGW < nrows) { const f32x4* s4 = (const f32x4*)(src + (size_t)(row + NGW) * 2048);
#pragma unroll
            for (int q = 0; q < 8; ++q) nx[q] = s4[64 * q + lane]; }
#pragma unroll
        for (int q = 0; q < 8; ++q) { const int s = 64 * q + lane; const f32x4 a = cur[q] * scale; *(LAS f32x4*)(scr + 4 * (s ^ ((s >> 4) & 7))) = a; }
#else
    bool fp4_swapped = false;
    if (PEER_V4) {
        float t0 = 1.0f, t1 = 2.0f; asm volatile("" : "+v"(t0), "+v"(t1));
        const unsigned pw = __builtin_amdgcn_cvt_scalef32_pk_fp4_f32(0u, t0, t1, 1.0f, 0);
        const f32x2v pr = __builtin_amdgcn_cvt_scalef32_pk_f32_fp4(pw, 1.0f, 0);
        fp4_swapped = !__all(pr[0] == 1.0f);
    }
    for (int row = gw; row < nrows; row += NGW) {
        const f32x4* s4 = (const f32x4*)(src + (size_t)row * 2048);
#pragma unroll
        for (int q = 0; q < 8; ++q) { const int s = 64 * q + lane; const f32x4 a = (NT_STREAM ? __builtin_nontemporal_load(&s4[s]) : s4[s]) * scale; *(LAS f32x4*)(scr + 4 * (s ^ ((s >> 4) & 7))) = a; }
#endif
        float e[32];
#pragma unroll
        for (int j = 0; j < 8; ++j) { const int s = 8 * lane + j; const f32x4 a = *(const LAS f32x4*)(scr + 4 * (s ^ ((s >> 4) & 7)));
            e[4 * j + 0] = __builtin_amdgcn_fmed3f(a.x, -7.5f, 7.5f); e[4 * j + 1] = __builtin_amdgcn_fmed3f(a.y, -7.5f, 7.5f); e[4 * j + 2] = __builtin_amdgcn_fmed3f(a.z, -7.5f, 7.5f); e[4 * j + 3] = __builtin_amdgcn_fmed3f(a.w, -7.5f, 7.5f); }
#if EMU_FP4V
        if (EMU_FP4V == 2 ? !isv : isv) {
#pragma unroll
            for (int i = 0; i < 32; ++i) { const float a = fabsf(e[i]); float q = a < 2.0f ? rintf(a * 2.0f) * 0.5f : (a < 4.0f ? rintf(a) : fminf(rintf(a * 0.5f) * 2.0f, 6.0f)); e[i] = copysignf(q, e[i]); }
        }
#endif
        unsigned char* rowp = dst + (size_t)row * PREC;
        if (PEER_V4 && (isv || PEER_U4)) {
            u32x4 w4;
#pragma unroll
            for (int w = 0; w < 4; ++w) { unsigned d = 0u; float x_[8];
#pragma unroll
                for (int i = 0; i < 8; i += 2) { const float x0 = __builtin_amdgcn_fmed3f(e[8 * w + i], -6.0f, 6.0f), x1 = __builtin_amdgcn_fmed3f(e[8 * w + i + 1], -6.0f, 6.0f); x_[i] = fp4_swapped ? x1 : x0; x_[i + 1] = fp4_swapped ? x0 : x1; }
                d = __builtin_amdgcn_cvt_scalef32_pk_fp4_f32(d, x_[0], x_[1], 1.0f, 0); d = __builtin_amdgcn_cvt_scalef32_pk_fp4_f32(d, x_[2], x_[3], 1.0f, 1);
                d = __builtin_amdgcn_cvt_scalef32_pk_fp4_f32(d, x_[4], x_[5], 1.0f, 2); d = __builtin_amdgcn_cvt_scalef32_pk_fp4_f32(d, x_[6], x_[7], 1.0f, 3);
                w4[w] = d; }
            *(u32x4*)(rowp + ((isv || !PEER_U4) ? 1024 : 0) + 16 * lane) = w4;
            continue;
        }
        const u32x6v p = pack_fp6_32(e, interleaved);
        *(u32x4*)(rowp + 1024 * isv + 16 * lane) = (u32x4){p[0], p[1], p[2], p[3]}; *(u32x2*)(rowp + 2048 + 512 * isv + 8 * lane) = (u32x2){p[4], p[5]};
    }
}
__device__ __forceinline__ float silu(float x) { return x / (1.0f + __expf(-x)); }

struct Params { const float* in[29]; float* out; unsigned char* ws; int ph_lo, ph_hi; };
typedef const __attribute__((address_space(4))) Params* CP;

#ifndef P0_NOV
#define P0_NOV 0
#endif
#ifndef TAIL_REMAP
#define TAIL_REMAP 0
#endif
__device__ __forceinline__ void p0_prologue(CP P, LAS unsigned char* lds, int tid, int lane, int wid, int gw, int NGW, const int parts = 7) {
    unsigned char* ws = P->ws;
    LAS float* scr = (LAS float*)(lds + wid * 16384);
    if (parts & 1) {
        constexpr int I_GMIN = (2048 / 64) * (4096 / 32), I_SQ = (2048 / 64) * (2048 / 32), I_MIN = (2048 / 64) * (1088 / 32), I_UQ = (512 / 64) * (3072 / 32), I_UKV = (512 / 64) * (4096 / 32), I_DIN = (2048 / 64) * (6144 / 32);
        constexpr int NIT = 2 * I_GMIN + 2 * I_SQ + 4 * I_SQ + I_MIN + I_UQ + I_UKV + I_SQ + I_DIN + I_SQ;
        for (int it = gw; it < NIT; it += NGW) {
            int r = it;
            if (r < 2 * I_GMIN) { const int j = r / I_GMIN; p0_transpose_item(P->in[13] + (size_t)j * 2048 * 4096, 2048, 4096, (bf16*)(ws + WS_GMWIN) + (size_t)j * 4096 * 2048, scr, r % I_GMIN, lane); continue; } r -= 2 * I_GMIN;
            if (r < 2 * I_SQ) { const int j = r / I_SQ; p0_transpose_item(P->in[18] + (size_t)j * 2048 * 2048, 2048, 2048, (bf16*)(ws + WS_GMWOUT) + (size_t)j * 2048 * 2048, scr, r % I_SQ, lane); continue; } r -= 2 * I_SQ;
            if (r < 4 * I_SQ) { const int j = r / I_SQ; p0_transpose_item(P->in[8] + (size_t)j * 2048 * 2048, 2048, 2048, (bf16*)(ws + WS_PWQ) + (size_t)j * 2048 * 2048, scr, r % I_SQ, lane); continue; } r -= 4 * I_SQ;
            if (r < I_MIN) { p0_transpose_item(P->in[19], 2048, 1088, (bf16*)(ws + WS_MLAIN), scr, r, lane); continue; } r -= I_MIN;
            if (r < I_UQ) { p0_transpose_item(P->in[22], 512, 3072, (bf16*)(ws + WS_MLAUQ), scr, r, lane); continue; } r -= I_UQ;
            if (r < I_UKV) { p0_transpose_item(P->in[23], 512, 4096, (bf16*)(ws + WS_MLAUKV), scr, r, lane); continue; } r -= I_UKV;
            if (r < I_SQ) { p0_transpose_item(P->in[24], 2048, 2048, (bf16*)(ws + WS_MLAOUT), scr, r, lane); continue; } r -= I_SQ;
            if (r < I_DIN) { p0_transpose_item(P->in[25], 2048, 6144, (bf16*)(ws + WS_DAIN), scr, r, lane); continue; } r -= I_DIN;
            p0_transpose_item(P->in[28], 2048, 2048, (bf16*)(ws + WS_DAOUT), scr, r, lane);
        }
    }
    const size_t gtid = (size_t)gw * 64 + lane, gthreads = (size_t)NGW * 64;
    if (parts & 2) {
    { u32x4* z = (u32x4*)((bf16*)(ws + WS_MLAIN) + (size_t)1088 * 2048); const size_t n = (size_t)192 * 2048 / 8;
      for (size_t i = gtid; i < n; i += gthreads) z[i] = (u32x4){0u, 0u, 0u, 0u}; }
    cvt_range(P->in[16], (bf16*)(ws + WS_GMWS), (size_t)2 * 16 * 128 * 128 / 8, gtid, gthreads);
    cvt_range(P->in[9], (bf16*)(ws + WS_PK1), (size_t)4 * 128 * 128 / 8, gtid, gthreads);
    cvt_range(P->in[10], (bf16*)(ws + WS_PK2), (size_t)4 * 128 * 128 / 8, gtid, gthreads);
#if !TAIL_REMAP
    cvt_table_fp6(P->in[11], ws + WS_PU, 16384, U_SCALE, scr, lane, gw, NGW, 0);
    if (!P0_NOV) cvt_table_fp6(P->in[12], ws + WS_PU, 16384, V_SCALE, scr, lane, gw, NGW, 1);
#endif
    if (gtid < 2048) { const int pos = (int)gtid >> 4, f = (int)gtid & 15; const float inv = powf(10000.0f, -(float)f * (1.0f / 16.0f)); float sn, cs; sincosf((float)pos * inv, &sn, &cs);
        float* rt = (float*)(ws + WS_ROPE); rt[gtid] = cs; rt[2048 + gtid] = sn; }
    }
    if (parts & 4) {
        const float* cv = P->in[1]; const float* cc = P->in[3]; const float* mw = P->in[4]; float* PART = (float*)(ws + WS_MODP);
        LAS float* S = (LAS float*)lds;
        __syncthreads();
        { float t_[12];
#pragma unroll
          for (int t = 0; t < 12; ++t) { const int i = tid + t * NWAVES * 64, sl = i >> 11, kk = i & 2047; t_[t] = sl == 0 ? cv[kk] : (sl == 1 ? cv[2048 + kk] : cc[kk]); }
#pragma unroll
          for (int t = 0; t < 12; ++t) S[tid + t * NWAVES * 64] = silu(t_[t]); }
        __syncthreads();
        for (int item = gw; item < 4 * 192 * 8; item += NGW) {
            const int ks = item & 7, r = item >> 3, L = r / 192, n = (r % 192) * 64 + lane;
            const float* W = mw + (size_t)L * 2048 * 12288 + (size_t)(ks * 256) * 12288 + n;
            float a0 = 0.f, a1 = 0.f, a2 = 0.f;
#if GEMV_PIPE
#define GV_LD(dst_, kb_) do { _Pragma("unroll") for (int t = 0; t < 32; ++t) dst_[t] = NT_STREAM ? __builtin_nontemporal_load(&W[(size_t)((kb_) + t) * 12288]) : W[(size_t)((kb_) + t) * 12288]; } while (0)
            float wa[32], wb[32];
            GV_LD(wa, 0);
#pragma unroll 1
            for (int kb = 0; kb < 256; kb += 64) {
                GV_LD(wb, kb + 32);
#pragma unroll
                for (int t = 0; t < 32; ++t) { const int kk = ks * 256 + kb + t; a0 += S[kk] * wa[t]; a1 += S[2048 + kk] * wa[t]; a2 += S[4096 + kk] * wa[t]; }
                if (kb + 64 < 256) GV_LD(wa, kb + 64);
#pragma unroll
                for (int t = 0; t < 32; ++t) { const int kk = ks * 256 + kb + 32 + t; a0 += S[kk] * wb[t]; a1 += S[2048 + kk] * wb[t]; a2 += S[4096 + kk] * wb[t]; }
            }
#undef GV_LD
#else
#pragma unroll 32
            for (int k = 0; k < 256; ++k) { const int kk = ks * 256 + k; const float s0 = S[kk], s1 = S[2048 + kk], s2 = S[4096 + kk];
                const float w = NT_STREAM ? __builtin_nontemporal_load(&W[(size_t)k * 12288]) : W[(size_t)k * 12288]; a0 += s0 * w; a1 += s1 * w; a2 += s2 * w; }
#endif
            float* o = PART + ((size_t)ks * 4 + L) * 3 * 12288 + n;
            o[0] = a0; o[12288] = a1; o[24576] = a2;
        }
    }
}
__device__ __forceinline__ void mod_reduce(CP P, int gw, int lane, int NGW) {
    const float* PART = (const float*)(P->ws + WS_MODP); float* MOD = (float*)(P->ws + WS_MOD); const float* mb = P->in[5];
    for (int i = gw * 64 + lane; i < 4 * 3 * 12288; i += NGW * 64) {
        const int L = i / (3 * 12288), n = i % 12288;
        float s = mb[(size_t)L * 12288 + n];
#pragma unroll
        for (int ks = 0; ks < 8; ++ks) s += PART[(size_t)ks * 4 * 3 * 12288 + i];
        MOD[i] = s;
    }
}

__device__ __forceinline__ void load_row_f32_l(const LAS float* row, int lane, float (&v)[32]) {
#pragma unroll
    for (int j = 0; j < 4; ++j) { const f32x4 a = ((const LAS f32x4*)row)[128 * j + 2 * lane], b = ((const LAS f32x4*)row)[128 * j + 2 * lane + 1];
        v[8 * j + 0] = a.x; v[8 * j + 1] = a.y; v[8 * j + 2] = a.z; v[8 * j + 3] = a.w; v[8 * j + 4] = b.x; v[8 * j + 5] = b.y; v[8 * j + 6] = b.z; v[8 * j + 7] = b.w; }
}
__device__ __forceinline__ void first_row_pass(CP P, LAS unsigned char* lds, int tid, int lane, int gw, int NGW) {
    const float* MOD = (const float*)(P->ws + WS_MOD); bf16* X = (bf16*)(P->ws + WS_X); bf16* H = (bf16*)(P->ws + WS_H);
    LAS float* V = (LAS float*)lds;
    __syncthreads();
    { f32x4 t_[6];
#pragma unroll
      for (int vec = 0; vec < 6; ++vec) t_[vec] = ((const f32x4*)(MOD + (size_t)(vec >> 1) * 12288 + (size_t)(vec & 1) * 2048))[tid];
#pragma unroll
      for (int vec = 0; vec < 6; ++vec) ((LAS f32x4*)V)[vec * 512 + tid] = t_[vec]; }
    __syncthreads();
    for (int row = gw; row < MT; row += NGW) {
        const float* src = row < ML ? P->in[0] + (size_t)row * DM : P->in[2] + (size_t)(row - ML) * DM;
        float v[32]; if (NT_STREAM > 1) load_row_f32_nt(src, lane, v); else load_row_f32(src, lane, v);
        store_row_bf16(X + (size_t)row * DM, lane, v);
        const LAS float* mod = V + row_slot(row) * 4096;
        float mean, rstd; ln_stats(v, mean, rstd);
        float a[32], s[32]; load_row_f32_l(mod + 2048, lane, a); load_row_f32_l(mod, lane, s);
#pragma unroll
        for (int i = 0; i < 32; ++i) a[i] = (v[i] - mean) * rstd * (1.0f + a[i]) + s[i];
        store_row_bf16(H + (size_t)row * DM, lane, a);
    }
}
#ifndef POSTMIX_LDS
#define POSTMIX_LDS 1
#endif
__device__ __forceinline__ void post_mixer_pass_lds(CP P, int L, int Mrows, LAS unsigned char* lds, int tid, int lane, int gw, int NGW) {
    const float* MOD = (const float*)(P->ws + WS_MOD); bf16* X = (bf16*)(P->ws + WS_X); bf16* H = (bf16*)(P->ws + WS_H); const bf16* Y = (const bf16*)(P->ws + WS_Y);
    const float* lng = P->in[6] + (size_t)(L * 2 + 0) * DM; const float* lnb = P->in[7] + (size_t)(L * 2 + 0) * DM;
    LAS float* V = (LAS float*)lds;
    __syncthreads();
    { f32x4 t_[11];
#pragma unroll
      for (int vec = 0; vec < 11; ++vec) { const float* src = vec == 0 ? lng : (vec == 1 ? lnb : MOD + (size_t)(L * 3 + (vec - 2) / 3) * 12288 + (size_t)(2 + (vec - 2) % 3) * 2048);
          t_[vec] = ((const f32x4*)src)[tid]; }
#pragma unroll
      for (int vec = 0; vec < 11; ++vec) ((LAS f32x4*)V)[vec * 512 + tid] = t_[vec]; }
    __syncthreads();
    for (int row = gw; row < Mrows; row += NGW) {
        const LAS float* mv = V + (2 + 3 * row_slot(row)) * 2048;
        float z[32], y[32]; if (NT_ACT) { load_row_bf16_nt(X + (size_t)row * DM, lane, z); load_row_bf16_nt(Y + (size_t)row * DM, lane, y); } else { load_row_bf16(X + (size_t)row * DM, lane, z); load_row_bf16(Y + (size_t)row * DM, lane, y); }
        { float g[32]; load_row_f32_l(mv, lane, g);
#pragma unroll
          for (int i = 0; i < 32; ++i) z[i] = ALPHA * z[i] + g[i] * y[i]; }
        float mean, rstd; ln_stats(z, mean, rstd);
        { float g[32], b[32]; load_row_f32_l(V, lane, g); load_row_f32_l(V + 2048, lane, b);
#pragma unroll
          for (int i = 0; i < 32; ++i) z[i] = (z[i] - mean) * rstd * g[i] + b[i]; }
        store_row_bf16(X + (size_t)row * DM, lane, z);
        ln_stats(z, mean, rstd);
        { float a[32], s_[32]; load_row_f32_l(mv + 2 * 2048, lane, a); load_row_f32_l(mv + 2048, lane, s_);
#pragma unroll
          for (int i = 0; i < 32; ++i) a[i] = (z[i] - mean) * rstd * (1.0f + a[i]) + s_[i];
          store_row_bf16(H + (size_t)row * DM, lane, a); }
    }
}
__device__ __forceinline__ void post_mixer_pass(CP P, int L, int Mrows, int lane, int gw, int NGW) {
    const float* MOD = (const float*)(P->ws + WS_MOD); bf16* X = (bf16*)(P->ws + WS_X); bf16* H = (bf16*)(P->ws + WS_H); const bf16* Y = (const bf16*)(P->ws + WS_Y);
    const float* lng = P->in[6] + (size_t)(L * 2 + 0) * DM; const float* lnb = P->in[7] + (size_t)(L * 2 + 0) * DM;
    for (int row = gw; row < Mrows; row += NGW) {
        const float* mod = MOD + (size_t)(L * 3 + row_slot(row)) * 12288;
        float z[32], y[32], g[32]; load_row_bf16(X + (size_t)row * DM, lane, z); load_row_bf16(Y + (size_t)row * DM, lane, y); load_row_f32(mod + 2 * 2048, lane, g);
#pragma unroll
        for (int i = 0; i < 32; ++i) z[i] = ALPHA * z[i] + g[i] * y[i];
        finish_row<false>(z, lng, lnb, X + (size_t)row * DM, mod + 3 * 2048, mod + 4 * 2048, H + (size_t)row * DM, nullptr, lane);
    }
}
__device__ __forceinline__ void vstats_pass(CP P, int Mrows, int lane, int gw, int NGW) {
    const bf16* Z = (const bf16*)(P->ws + WS_Z); float* VST = (float*)(P->ws + WS_VST);
    for (int row = gw; row < Mrows; row += NGW) {
        float v[32]; load_row_bf16(Z + (size_t)row * 4096 + 2048, lane, v);
        float mean, rstd; ln_stats(v, mean, rstd);
        if (lane == 0) { VST[2 * row] = mean; VST[2 * row + 1] = rstd; }
    }
}
#define XB_TMO      128
#define XB_XCNT(j)  (256  + 64 * (j))
#define XB_XSUB(j)  (1280 + 64 * (j))
#define XB_XGEN(j)  (2304 + 64 * (j))
#define XB_TOP      3328
#define XB_TOPGEN   3392
#define XCD_BAR_WORDS 3456
#define XB_SPIN_CAP (1u << 18)

__device__ __forceinline__ unsigned xb_ld(unsigned* p)              { return __hip_atomic_load(p, __ATOMIC_RELAXED, __HIP_MEMORY_SCOPE_AGENT); }
__device__ __forceinline__ unsigned xb_add(unsigned* p, unsigned v) { return __hip_atomic_fetch_add(p, v, __ATOMIC_RELAXED, __HIP_MEMORY_SCOPE_AGENT); }
__device__ __forceinline__ unsigned xb_xcc_id() { return (unsigned)__builtin_amdgcn_s_getreg((3 << 11) | 20) & 0xFu; }
#define XB_SPIN(cond, bar) do { unsigned _sp = 0; while (cond) { __builtin_amdgcn_s_sleep(1); \
    if ((++_sp & 255u) == 0u) { if (xb_ld(&(bar)[XB_TMO])) break; if (_sp > XB_SPIN_CAP) { atomicAdd(&(bar)[XB_TMO], 1u); break; } } } } while (0)

struct XcdBarrier {
    unsigned* bar; unsigned x;
    volatile LAS unsigned* st;
};

__device__ __forceinline__ XcdBarrier xcd_barrier_post(unsigned* bar, volatile LAS unsigned* st, const bool t0) {
    XcdBarrier b; b.bar = bar; b.x = xb_xcc_id(); b.st = st;
    if (t0) (void)xb_add(&bar[XB_XCNT(b.x)], 1u);
    return b;
}
__device__ __forceinline__ void xcd_barrier_complete(unsigned* bar, unsigned x, unsigned& nloc, unsigned& nx) {
    const unsigned G = gridDim.x * gridDim.y * gridDim.z;
    unsigned sum, cnt, mine, sp = 0u;
    for (;;) {
        sum = 0u; cnt = 0u; mine = 0u;
#pragma unroll
        for (unsigned j = 0; j < 16; ++j) { const unsigned c = xb_ld(&bar[XB_XCNT(j)]); sum += c; cnt += (c > 0u) ? 1u : 0u; mine = (j == x) ? c : mine; }
        if (sum == G) break;
        __builtin_amdgcn_s_sleep(1);
        if ((++sp & 255u) == 0u) { if (xb_ld(&bar[XB_TMO])) break; if (sp > XB_SPIN_CAP) { atomicAdd(&bar[XB_TMO], 1u); break; } }
    }
    nloc = mine > 0u ? mine : 1u; nx = cnt > 0u ? cnt : 1u;
}

__device__ __attribute__((noinline)) void xcd_barrier(const XcdBarrier b, const bool t0) {
    asm volatile("s_waitcnt vmcnt(0)" ::: "memory");
    __syncthreads();
    if (t0) {
        unsigned* bar = b.bar;
        __builtin_amdgcn_s_waitcnt(0);
        unsigned nloc = b.st[0], nx = b.st[1];
        if (nloc == 0u) { xcd_barrier_complete(bar, b.x, nloc, nx); b.st[0] = nloc; b.st[1] = nx; }
        const unsigned old = xb_add(&bar[XB_XSUB(b.x)], 1u);
        const unsigned gen = old / nloc;
        if (old + 1u == (gen + 1u) * nloc) {
            __builtin_amdgcn_fence(__ATOMIC_RELEASE, "agent");
            asm volatile("s_waitcnt vmcnt(0)" ::: "memory");
            const unsigned og = xb_add(&bar[XB_TOP], 1u);
            const unsigned tg = og / nx;
            if (og + 1u == (tg + 1u) * nx) xb_add(&bar[XB_TOPGEN], 1u);
            else XB_SPIN(xb_ld(&bar[XB_TOPGEN]) == tg, bar);
            __builtin_amdgcn_fence(__ATOMIC_ACQUIRE, "agent");
            xb_add(&bar[XB_XGEN(b.x)], 1u);
            asm volatile("s_waitcnt vmcnt(0)" ::: "memory");
        } else {
            XB_SPIN(xb_ld(&bar[XB_XGEN(b.x)]) == gen, bar);
            __builtin_amdgcn_fence(__ATOMIC_ACQUIRE, "agent");
            asm volatile("s_waitcnt vmcnt(0)" ::: "memory");
        }
    }
    __syncthreads();
}

#ifndef SPATIAL_PIPE
#define SPATIAL_PIPE 1
#endif
#if SPATIAL_PIPE
#ifndef SPATIAL_OTILE
#define SPATIAL_OTILE 0
#endif
struct SpReg { u32x4 w[4]; float mean, rstd; bf16x8 a[4]; bf16 uu[SPATIAL_OTILE ? 1 : 32]; u32x4 uq[4]; float bsv[4]; };
__device__ __forceinline__ void sp_load(SpReg& R, const bf16* Z, const float* VST, const bf16* WS, const float* bs, int u, int tid, int lane, int wid) {
    const int c = u >> 4, g = u & 15, fr = lane & 15, fq = lane >> 4;
    { const int q = tid >> 2, dq = (tid & 3) * 32; const int row = c * 128 + q;
      R.mean = VST[2 * row]; R.rstd = VST[2 * row + 1];
      const bf16* src = Z + (size_t)row * 4096 + 2048 + g * 128 + dq;
#pragma unroll
      for (int t = 0; t < 4; ++t) R.w[t] = *(const u32x4*)(src + 8 * t); }
    const bf16* wrow = WS + (size_t)g * 128 * 128 + (size_t)(16 * wid + fr) * 128 + 8 * fq;
#pragma unroll
    for (int ks = 0; ks < 4; ++ks) R.a[ks] = *(const bf16x8*)(wrow + 32 * ks);
#pragma unroll
    for (int r = 0; r < 4; ++r) R.bsv[r] = bs[g * 128 + 16 * wid + fq * 4 + r];
#if SPATIAL_OTILE
#pragma unroll
    for (int t = 0; t < 4; ++t) { const int ch = tid + 512 * t, p = ch >> 4, d8 = (ch & 15) * 8; R.uq[t] = *(const u32x4*)(Z + (size_t)(c * 128 + p) * 4096 + g * 128 + d8); }
    R.uu[0] = 0;
#else
#pragma unroll
    for (int nb = 0; nb < 8; ++nb)
#pragma unroll
        for (int r = 0; r < 4; ++r) { const int p = 16 * wid + fq * 4 + r, d = 16 * nb + fr; R.uu[nb * 4 + r] = Z[(size_t)(c * 128 + p) * 4096 + g * 128 + d]; }
#endif
}
__device__ __forceinline__ void spatial_phase(CP P, int j, int Mrows, LAS unsigned char* lds_, int tid, int lane, int wid) {
    const bf16* Z = (const bf16*)(P->ws + WS_Z); const float* VST = (const float*)(P->ws + WS_VST); bf16* Gb = (bf16*)(P->ws + WS_G);
    const bf16* WS = (const bf16*)(P->ws + WS_GMWS) + (size_t)j * 16 * 128 * 128;
    const float* lng = P->in[14] + (size_t)j * DM; const float* lnb = P->in[15] + (size_t)j * DM; const float* bs = P->in[17] + (size_t)j * 16 * 128;
    LAS bf16* Vt = (LAS bf16*)(LAS unsigned char*)lds_;
    constexpr int VP = 136;
    const int nunits = (Mrows / 128) * 16;
    LAS float* LNl = (LAS float*)(lds_ + 36864);
    __syncthreads();
    { const f32x4 t0_ = ((const f32x4*)lng)[tid], t1_ = ((const f32x4*)lnb)[tid]; ((LAS f32x4*)LNl)[tid] = t0_; ((LAS f32x4*)LNl)[512 + tid] = t1_; }
    LAS float* Ot = (LAS float*)(lds_ + 53248);
    (void)Ot;
    SpReg nx;
    if ((int)blockIdx.x < nunits) sp_load(nx, Z, VST, WS, bs, blockIdx.x, tid, lane, wid);
    for (int u = blockIdx.x; u < nunits; u += gridDim.x) {
        const int c = u >> 4, g = u & 15;
        const SpReg cur = nx;
        if (u + (int)gridDim.x < nunits) sp_load(nx, Z, VST, WS, bs, u + gridDim.x, tid, lane, wid);
        __syncthreads();
        {
            const int q = tid >> 2, dq = (tid & 3) * 32;
#pragma unroll
            for (int t = 0; t < 4; ++t) { const u32x4 w = cur.w[t];
                float v[8] = {bflo(w.x), bfhi(w.x), bflo(w.y), bfhi(w.y), bflo(w.z), bfhi(w.z), bflo(w.w), bfhi(w.w)};
                const LAS float* gp = LNl + g * 128 + dq + 8 * t; const LAS float* bp = LNl + 2048 + g * 128 + dq + 8 * t;
#pragma unroll
                for (int i = 0; i < 8; ++i) { const float vn = (v[i] - cur.mean) * cur.rstd * gp[i] + bp[i]; Vt[(dq + 8 * t + i) * VP + (q ^ ((tid & 3) << 4))] = tobf1(vn); } }
        }
        __syncthreads();
        const int fr = lane & 15, fq = lane >> 4;
#pragma unroll
        for (int nb = 0; nb < 8; ++nb) {
            f32x4 acc = {0.f, 0.f, 0.f, 0.f};
#pragma unroll
            for (int ks = 0; ks < 4; ++ks) { const bf16x8 b = *(const LAS bf16x8*)(Vt + (16 * nb + fr) * VP + 8 * ((4 * ks + fq) ^ ((nb >> 1) << 1)));
                acc = __builtin_amdgcn_mfma_f32_16x16x32_bf16(cur.a[ks], b, acc, 0, 0, 0); }
#if SPATIAL_OTILE
#pragma unroll
            for (int r = 0; r < 4; ++r) Ot[(16 * wid + fq * 4 + r) * 132 + 16 * nb + fr] = acc[r] + cur.bsv[r];
#else
#pragma unroll
            for (int r = 0; r < 4; ++r) { const int p = 16 * wid + fq * 4 + r, d = 16 * nb + fr; const size_t grow = (size_t)(c * 128 + p);
                const float sv = acc[r] + cur.bsv[r];
                const float uu = bf1(cur.uu[nb * 4 + r]);
                Gb[grow * 2048 + g * 128 + d] = tobf1(uu * sv); }
#endif
        }
#if SPATIAL_OTILE
        __syncthreads();
#pragma unroll
        for (int t = 0; t < 4; ++t) { const int ch = tid + 512 * t, p = ch >> 4, d8 = (ch & 15) * 8;
            const LAS f32x4* op = (const LAS f32x4*)(Ot + p * 132 + d8); const f32x4 s0 = op[0], s1 = op[1]; const u32x4 uw = cur.uq[t];
            u32x4 o; o.x = cvtpk(bflo(uw.x) * s0.x, bfhi(uw.x) * s0.y); o.y = cvtpk(bflo(uw.y) * s0.z, bfhi(uw.y) * s0.w); o.z = cvtpk(bflo(uw.z) * s1.x, bfhi(uw.z) * s1.y); o.w = cvtpk(bflo(uw.w) * s1.z, bfhi(uw.w) * s1.w);
            *(u32x4*)(Gb + (size_t)(c * 128 + p) * 2048 + g * 128 + d8) = o; }
#endif
    }
}
#else
__device__ __forceinline__ void spatial_phase(CP P, int j, int Mrows, LAS unsigned char* lds_, int tid, int lane, int wid) {
    const bf16* Z = (const bf16*)(P->ws + WS_Z); const float* VST = (const float*)(P->ws + WS_VST); bf16* Gb = (bf16*)(P->ws + WS_G);
    const bf16* WS = (const bf16*)(P->ws + WS_GMWS) + (size_t)j * 16 * 128 * 128;
    const float* lng = P->in[14] + (size_t)j * DM; const float* lnb = P->in[15] + (size_t)j * DM; const float* bs = P->in[17] + (size_t)j * 16 * 128;
    LAS bf16* Vt = (LAS bf16*)(LAS unsigned char*)lds_;
    constexpr int VP = 136;
    const int nunits = (Mrows / 128) * 16;
    for (int u = blockIdx.x; u < nunits; u += gridDim.x) {
        const int c = u >> 4, g = u & 15;
        __syncthreads();
        {
            const int q = tid >> 2, dq = (tid & 3) * 32; const int row = c * 128 + q;
            const float mean = VST[2 * row], rstd = VST[2 * row + 1];
            const bf16* src = Z + (size_t)row * 4096 + 2048 + g * 128 + dq;
#pragma unroll
            for (int t = 0; t < 4; ++t) { const u32x4 w = *(const u32x4*)(src + 8 * t);
                float v[8] = {bflo(w.x), bfhi(w.x), bflo(w.y), bfhi(w.y), bflo(w.z), bfhi(w.z), bflo(w.w), bfhi(w.w)};
                const float* gp = lng + g * 128 + dq + 8 * t; const float* bp = lnb + g * 128 + dq + 8 * t;
#pragma unroll
                for (int i = 0; i < 8; ++i) { const float vn = (v[i] - mean) * rstd * gp[i] + bp[i]; Vt[(dq + 8 * t + i) * VP + q] = tobf1(vn); } }
        }
        __syncthreads();
        const int fr = lane & 15, fq = lane >> 4;
        bf16x8 a[4];
        const bf16* wrow = WS + (size_t)g * 128 * 128 + (size_t)(16 * wid + fr) * 128 + 8 * fq;
#pragma unroll
        for (int ks = 0; ks < 4; ++ks) a[ks] = *(const bf16x8*)(wrow + 32 * ks);
#pragma unroll
        for (int nb = 0; nb < 8; ++nb) {
            f32x4 acc = {0.f, 0.f, 0.f, 0.f};
#pragma unroll
            for (int ks = 0; ks < 4; ++ks) { const bf16x8 b = *(const LAS bf16x8*)(Vt + (16 * nb + fr) * VP + 32 * ks + 8 * fq);
                acc = __builtin_amdgcn_mfma_f32_16x16x32_bf16(a[ks], b, acc, 0, 0, 0); }
#pragma unroll
            for (int r = 0; r < 4; ++r) { const int p = 16 * wid + fq * 4 + r, d = 16 * nb + fr; const size_t grow = (size_t)(c * 128 + p);
                const float sv = acc[r] + bs[g * 128 + p];
                const float uu = bf1(Z[grow * 4096 + g * 128 + d]);
                Gb[grow * 2048 + g * 128 + d] = tobf1(uu * sv); }
        }
    }
}
#endif

__device__ __forceinline__ void rope_cs(int row, int l, float& cs, float& sn) {
    const int t = row & (SEQ - 1); const int pos = (l & 32) ? (t & 63) : (t >> 6);
    const float inv = powf(10000.0f, -(float)(l & 15) * (1.0f / 16.0f));
    const float ang = (float)pos * inv; sincosf(ang, &sn, &cs);
}
__device__ __forceinline__ float rope_apply(float x, int l, float cs, float sn) {
    const float p = lane_xor16(x, l);
    return (l & 16) ? (p * sn + x * cs) : (x * cs - p * sn);
}
__device__ __forceinline__ void mla_norm_pass(CP P, int lane, int gw, int NGW) {
    const bf16* C = (const bf16*)(P->ws + WS_C); bf16* CQN = (bf16*)(P->ws + WS_CQN); bf16* CKVN = (bf16*)(P->ws + WS_CKVN); bf16* KR = (bf16*)(P->ws + WS_KR);
    const float* qn = P->in[20]; const float* kvn = P->in[21];
    for (int row = gw; row < MT; row += NGW) {
        const bf16* c = C + (size_t)row * 1280;
#pragma unroll
        for (int part = 0; part < 2; ++part) {
            const u32x4 w = *(const u32x4*)(c + part * 512 + 8 * lane);
            float v[8] = {bflo(w.x), bfhi(w.x), bflo(w.y), bfhi(w.y), bflo(w.z), bfhi(w.z), bflo(w.w), bfhi(w.w)};
            float ss = 0.f;
#pragma unroll
            for (int i = 0; i < 8; ++i) ss += v[i] * v[i];
            const float r = 1.0f / sqrtf(wave_sum(ss) * (1.0f / 512.0f) + LN_EPS);
            const float* nw = (part ? kvn : qn) + 8 * lane;
            u32x4 o; o.x = cvtpk(v[0] * r * nw[0], v[1] * r * nw[1]); o.y = cvtpk(v[2] * r * nw[2], v[3] * r * nw[3]); o.z = cvtpk(v[4] * r * nw[4], v[5] * r * nw[5]); o.w = cvtpk(v[6] * r * nw[6], v[7] * r * nw[7]);
            *(u32x4*)((part ? CKVN : CQN) + (size_t)row * 512 + 8 * lane) = o;
        }
        float x = bf1(c[1024 + lane]);
        if (row < ML) { float cs, sn; rope_cs(row, lane, cs, sn); x = rope_apply(x, lane, cs, sn); }
        KR[(size_t)row * 64 + lane] = tobf1(x);
    }
}
__device__ __forceinline__ void rope_pass(bf16* buf, int ld, int col0, int nchunks, int cstride, int lane, int gw, int NGW) {
    for (int row = gw; row < ML; row += NGW) {
        float cs, sn; rope_cs(row, lane, cs, sn);
        bf16* r = buf + (size_t)row * ld + col0 + lane;
#pragma unroll 4
        for (int k = 0; k < nchunks; ++k) { const float x = bf1(r[k * cstride]); r[k * cstride] = tobf1(rope_apply(x, lane, cs, sn)); }
    }
}

namespace att {
#ifndef ATT_VSTCF
#define ATT_VSTCF 1
#endif
#ifndef ATT_DA_NQR
#define ATT_DA_NQR 4
#endif
#ifndef ATT_LEAN0
#define ATT_LEAN0 0
#endif
#ifndef ATT_LEAN
#define ATT_LEAN 1
#endif
#ifndef ATT_3STAGE
#define ATT_3STAGE 0
#endif
#ifndef ATT_QLATE
#define ATT_QLATE 1
#endif
#ifndef ATT_PRIO
#define ATT_PRIO 1
#endif
#ifndef ATT_KMAJOR
#define ATT_KMAJOR 0
#endif
#ifndef ATT_TRB
#define ATT_TRB 1
#endif
#ifndef ATT_STAGGER
#define ATT_STAGGER 0
#endif
#ifndef ATT_SDEPTH
#define ATT_SDEPTH(MODE) ((MODE) == 0 ? 1 : 1)
#endif
#ifndef ATT_PVPIPE
#define ATT_PVPIPE(MODE) ((MODE) == 1)
#endif
#define SBAR() __builtin_amdgcn_sched_barrier(0)
__device__ __forceinline__ int crow(int r, int hi) { return (r & 3) + 8 * (r >> 2) + 4 * hi; }
__device__ __forceinline__ unsigned cvtpkv(float lo, float hi) { unsigned r; asm volatile("v_cvt_pk_bf16_f32 %0, %1, %2" : "=v"(r) : "v"(lo), "v"(hi)); return r; }

__device__ __forceinline__ void partialSM(f32x16& p0, f32x16& p1, float& m_reg, float& mn, float& alpha, const float C, const float THRS) {
  float pmax = p0[0];
#pragma unroll
  for (int r = 1; r < 16; ++r) pmax = fmaxf(pmax, p0[r]);
#pragma unroll
  for (int r = 0; r < 16; ++r) pmax = fmaxf(pmax, p1[r]);
  { auto rr = __builtin_amdgcn_permlane32_swap(__float_as_uint(pmax), __float_as_uint(pmax), false, false);
    pmax = fmaxf(__uint_as_float(rr[0]), __uint_as_float(rr[1])); }
  if (__builtin_expect(__all(pmax - m_reg <= THRS), 1)) { mn = m_reg; alpha = 1.f; }
  else { mn = fmaxf(m_reg, pmax); alpha = __builtin_amdgcn_exp2f((m_reg - mn) * C); m_reg = mn; }
  const float mnC = -mn * C;
#pragma unroll
  for (int r = 0; r < 16; ++r) p0[r] = fmaf(p0[r], C, mnC);
#pragma unroll
  for (int r = 0; r < 16; ++r) p1[r] = fmaf(p1[r], C, mnC);
#pragma unroll
  for (int r = 0; r < 16; ++r) p0[r] = __builtin_amdgcn_exp2f(p0[r]);
}
__device__ __forceinline__ void finishSM(f32x16& p0, f32x16& p1, float alpha, float& l_reg, bf16x8& pa0, bf16x8& pa1, bf16x8& pa2, bf16x8& pa3) {
#pragma unroll
  for (int r = 0; r < 16; ++r) p1[r] = __builtin_amdgcn_exp2f(p1[r]);
  float ps = 0;
#pragma unroll
  for (int r = 0; r < 16; ++r) ps += p0[r];
#pragma unroll
  for (int r = 0; r < 16; ++r) ps += p1[r];
  { auto rr = __builtin_amdgcn_permlane32_swap(__float_as_uint(ps), __float_as_uint(ps), false, false);
    ps = __uint_as_float(rr[0]) + __uint_as_float(rr[1]); }
  l_reg = l_reg * alpha + ps;
#define PK4(P, BASE, OUT) do { unsigned a0 = cvtpkv(P[BASE + 0], P[BASE + 1]), a1 = cvtpkv(P[BASE + 2], P[BASE + 3]);   \
    unsigned b0 = cvtpkv(P[BASE + 4], P[BASE + 5]), b1 = cvtpkv(P[BASE + 6], P[BASE + 7]);                              \
    auto r0 = __builtin_amdgcn_permlane32_swap(a0, b0, false, false); auto r1 = __builtin_amdgcn_permlane32_swap(a1, b1, false, false); \
    u32x4 w = {r0[0], r1[0], r0[1], r1[1]}; OUT = *reinterpret_cast<bf16x8*>(&w); } while (0)
  PK4(p0, 0, pa0); PK4(p0, 8, pa1); PK4(p1, 0, pa2); PK4(p1, 8, pa3);
#undef PK4
}
__device__ __forceinline__ void partialSM_lean(f32x16& p0, f32x16& p1, f32x16& nm, float& alpha, const bool first) {
  constexpr float THR2 = 11.541560327111707f;
  float dmax = p0[0];
#pragma unroll
  for (int r = 1; r < 16; ++r) dmax = fmaxf(dmax, p0[r]);
#pragma unroll
  for (int r = 0; r < 16; ++r) dmax = fmaxf(dmax, p1[r]);
  { auto rr = __builtin_amdgcn_permlane32_swap(__float_as_uint(dmax), __float_as_uint(dmax), false, false);
    dmax = fmaxf(__uint_as_float(rr[0]), __uint_as_float(rr[1])); }
  alpha = 1.f;
  if (first || !__all(dmax <= THR2)) {
    const float delta = first ? dmax : (dmax > THR2 ? dmax : 0.f);
    if (!first) alpha = __builtin_amdgcn_exp2f(-delta);
#pragma unroll
    for (int r = 0; r < 16; ++r) { p0[r] -= delta; p1[r] -= delta; nm[r] -= delta; }
  }
#pragma unroll
  for (int r = 0; r < 16; ++r) p0[r] = __builtin_amdgcn_exp2f(p0[r]);
}
__device__ __forceinline__ void finishSM_lean(f32x16& p0, f32x16& p1, bf16x8& pa0, bf16x8& pa1, bf16x8& pa2, bf16x8& pa3) {
#pragma unroll
  for (int r = 0; r < 16; ++r) p1[r] = __builtin_amdgcn_exp2f(p1[r]);
#define PK4(P, BASE, OUT) do { unsigned a0 = cvtpkv(P[BASE + 0], P[BASE + 1]), a1 = cvtpkv(P[BASE + 2], P[BASE + 3]);   \
    unsigned b0 = cvtpkv(P[BASE + 4], P[BASE + 5]), b1 = cvtpkv(P[BASE + 6], P[BASE + 7]);                              \
    auto r0 = __builtin_amdgcn_permlane32_swap(a0, b0, false, false); auto r1 = __builtin_amdgcn_permlane32_swap(a1, b1, false, false); \
    u32x4 w = {r0[0], r1[0], r0[1], r1[1]}; OUT = *reinterpret_cast<bf16x8*>(&w); } while (0)
  PK4(p0, 0, pa0); PK4(p0, 8, pa1); PK4(p1, 0, pa2); PK4(p1, 8, pa3);
#undef PK4
}
__device__ __forceinline__ bf16x8 scale_bf16x8(bf16x8 v, float c) {
  const u32x4 w = *reinterpret_cast<u32x4*>(&v); u32x4 o;
  o.x = cvtpk(bflo(w.x) * c, bfhi(w.x) * c); o.y = cvtpk(bflo(w.y) * c, bfhi(w.y) * c); o.z = cvtpk(bflo(w.z) * c, bfhi(w.z) * c); o.w = cvtpk(bflo(w.w) * c, bfhi(w.w) * c);
  return *reinterpret_cast<bf16x8*>(&o);
}
template <int PITCH> __device__ __forceinline__ int kswz(int r) { return PITCH == 256 ? (r & 15) : ((r >> 1) & 7); }
template <int NQF, int NQR, int PITCH> __device__ __forceinline__ void qkt(f32x16& p0, f32x16& p1, const LAS char* Ks, int chunk0, const bf16x8* qr, const LAS char* ql, int r32, int hi, const f32x16 init = f32x16{}) {
  p0 = init; p1 = init;
  const int sw = kswz<PITCH>(r32);
#pragma unroll
  for (int d0 = 0; d0 < NQF; ++d0) { const int off = ((chunk0 + d0 * 2 + hi) ^ sw) * 16;
    const bf16x8 b0 = *(const LAS bf16x8*)(Ks + r32 * PITCH + off);
    const bf16x8 b1 = *(const LAS bf16x8*)(Ks + (32 + r32) * PITCH + off);
    const bf16x8 q = d0 < NQR ? qr[d0 < NQR ? d0 : 0] : *(const LAS bf16x8*)(ql + (d0 - NQR < 0 ? 0 : d0 - NQR) * 1024);
    p0 = __builtin_amdgcn_mfma_f32_32x32x16_bf16(b0, q, p0, 0, 0, 0);
    p1 = __builtin_amdgcn_mfma_f32_32x32x16_bf16(b1, q, p1, 0, 0, 0); }
}
__device__ __forceinline__ int v_st(int k, int c) { const int kk = (k & ~0xC) | ((k & 4) << 1) | ((k & 8) >> 1); return ((kk >> 3) * 4 + (c >> 5)) * 512 + ((kk & 7) * 32 + (c & 31)) * 2; }
__device__ __forceinline__ int v_rd_base(int lane) { return ((lane & 3) << 3) | (((lane >> 2) & 3) << 6) | (((lane >> 4) & 1) << 5) | (((lane >> 5) & 1) << 8); }
constexpr int v_rd_off(int d0, int ks, int half) { return d0 * 512 + ks * 4096 + half * 2048; }
template <int OFF> __device__ __forceinline__ s16x4 tr_read(int vb) {
  s16x4 r; asm volatile("ds_read_b64_tr_b16 %0, %1 offset:%2" : "=&v"(r) : "v"(vb), "i"(OFF) : "memory"); return r;
}
template <int D0> __device__ __forceinline__ void pv_one(f32x16& od, int vb, bf16x8 pa0, bf16x8 pa1, bf16x8 pa2, bf16x8 pa3) {
  const s16x4 l0 = tr_read<v_rd_off(D0, 0, 0)>(vb), h0 = tr_read<v_rd_off(D0, 0, 1)>(vb), l1 = tr_read<v_rd_off(D0, 1, 0)>(vb), h1 = tr_read<v_rd_off(D0, 1, 1)>(vb);
  const s16x4 l2 = tr_read<v_rd_off(D0, 2, 0)>(vb), h2 = tr_read<v_rd_off(D0, 2, 1)>(vb), l3 = tr_read<v_rd_off(D0, 3, 0)>(vb), h3 = tr_read<v_rd_off(D0, 3, 1)>(vb);
  asm volatile("s_waitcnt lgkmcnt(0)" ::: "memory"); SBAR();
#define PK(L, H) (bf16x8){L[0], L[1], L[2], L[3], H[0], H[1], H[2], H[3]}
  od = __builtin_amdgcn_mfma_f32_32x32x16_bf16(pa0, PK(l0, h0), od, 0, 0, 0);
  od = __builtin_amdgcn_mfma_f32_32x32x16_bf16(pa1, PK(l1, h1), od, 0, 0, 0);
  od = __builtin_amdgcn_mfma_f32_32x32x16_bf16(pa2, PK(l2, h2), od, 0, 0, 0);
  od = __builtin_amdgcn_mfma_f32_32x32x16_bf16(pa3, PK(l3, h3), od, 0, 0, 0);
#undef PK
}
__device__ __forceinline__ void pv_d0(f32x16* o, int vb, bf16x8 pa0, bf16x8 pa1, bf16x8 pa2, bf16x8 pa3) {
  pv_one<0>(o[0], vb, pa0, pa1, pa2, pa3); pv_one<1>(o[1], vb, pa0, pa1, pa2, pa3); pv_one<2>(o[2], vb, pa0, pa1, pa2, pa3); pv_one<3>(o[3], vb, pa0, pa1, pa2, pa3);
}
struct VFrag { s16x4 l0, h0, l1, h1, l2, h2, l3, h3; };
typedef short v4i16_t __attribute__((ext_vector_type(4)));
template <int OFF> __device__ __forceinline__ s16x4 tr_read_b(int vb) {
  return __builtin_bit_cast(s16x4, __builtin_amdgcn_ds_read_tr16_b64_v4i16((LAS v4i16_t*)(uintptr_t)(unsigned)(vb + OFF)));
}
template <int D0> __device__ __forceinline__ void tr8b(VFrag& f, int vb) {
  f.l0 = tr_read_b<v_rd_off(D0, 0, 0)>(vb); f.h0 = tr_read_b<v_rd_off(D0, 0, 1)>(vb); f.l1 = tr_read_b<v_rd_off(D0, 1, 0)>(vb); f.h1 = tr_read_b<v_rd_off(D0, 1, 1)>(vb);
  f.l2 = tr_read_b<v_rd_off(D0, 2, 0)>(vb); f.h2 = tr_read_b<v_rd_off(D0, 2, 1)>(vb); f.l3 = tr_read_b<v_rd_off(D0, 3, 0)>(vb); f.h3 = tr_read_b<v_rd_off(D0, 3, 1)>(vb);
}
template <int D0> __device__ __forceinline__ void tr8(VFrag& f, int vb) {
  f.l0 = tr_read<v_rd_off(D0, 0, 0)>(vb); f.h0 = tr_read<v_rd_off(D0, 0, 1)>(vb); f.l1 = tr_read<v_rd_off(D0, 1, 0)>(vb); f.h1 = tr_read<v_rd_off(D0, 1, 1)>(vb);
  f.l2 = tr_read<v_rd_off(D0, 2, 0)>(vb); f.h2 = tr_read<v_rd_off(D0, 2, 1)>(vb); f.l3 = tr_read<v_rd_off(D0, 3, 0)>(vb); f.h3 = tr_read<v_rd_off(D0, 3, 1)>(vb);
}
__device__ __forceinline__ void mfma4(f32x16& od, VFrag& f, bf16x8 pa0, bf16x8 pa1, bf16x8 pa2, bf16x8 pa3) {
#define PK(L, H) (bf16x8){L[0], L[1], L[2], L[3], H[0], H[1], H[2], H[3]}
  od = __builtin_amdgcn_mfma_f32_32x32x16_bf16(pa0, PK(f.l0, f.h0), od, 0, 0, 0);
  od = __builtin_amdgcn_mfma_f32_32x32x16_bf16(pa1, PK(f.l1, f.h1), od, 0, 0, 0);
  od = __builtin_amdgcn_mfma_f32_32x32x16_bf16(pa2, PK(f.l2, f.h2), od, 0, 0, 0);
  od = __builtin_amdgcn_mfma_f32_32x32x16_bf16(pa3, PK(f.l3, f.h3), od, 0, 0, 0);
#undef PK
}
#define VF_TIE(f) "+v"(f.l0), "+v"(f.h0), "+v"(f.l1), "+v"(f.h1), "+v"(f.l2), "+v"(f.h2), "+v"(f.l3), "+v"(f.h3)
__device__ __forceinline__ void pv_pipe(f32x16* o, int vb, bf16x8 pa0, bf16x8 pa1, bf16x8 pa2, bf16x8 pa3) {
  VFrag A, B;
  asm volatile("s_waitcnt lgkmcnt(0)" ::: "memory");
  tr8<0>(A, vb); tr8<1>(B, vb);
  asm volatile("s_waitcnt lgkmcnt(8)" : VF_TIE(A) :: "memory");
  mfma4(o[0], A, pa0, pa1, pa2, pa3);
  tr8<2>(A, vb);
  asm volatile("s_waitcnt lgkmcnt(8)" : VF_TIE(B) :: "memory");
  mfma4(o[1], B, pa0, pa1, pa2, pa3);
  tr8<3>(B, vb);
  asm volatile("s_waitcnt lgkmcnt(8)" : VF_TIE(A) :: "memory");
  mfma4(o[2], A, pa0, pa1, pa2, pa3);
  asm volatile("s_waitcnt lgkmcnt(0)" : VF_TIE(B) :: "memory");
  mfma4(o[3], B, pa0, pa1, pa2, pa3);
}
__device__ __forceinline__ void pv_psm_lean(f32x16* o, int vb, bf16x8 pa0, bf16x8 pa1, bf16x8 pa2, bf16x8 pa3, f32x16& p0, f32x16& p1, f32x16& nm, float& alpha) {
  constexpr float THR2 = 11.541560327111707f;
  const bf16x8 one8 = {0x3F80, 0x3F80, 0x3F80, 0x3F80, 0x3F80, 0x3F80, 0x3F80, 0x3F80};
  VFrag A, B;
  asm volatile("s_waitcnt lgkmcnt(0)" ::: "memory");
  tr8<0>(A, vb); tr8<1>(B, vb);
  asm volatile("s_waitcnt lgkmcnt(8)" : VF_TIE(A) :: "memory");
  mfma4(o[0], A, pa0, pa1, pa2, pa3);
  float dmax = p0[0];
#pragma unroll
  for (int r = 1; r < 16; ++r) dmax = fmaxf(dmax, p0[r]);
  tr8<2>(A, vb);
  asm volatile("s_waitcnt lgkmcnt(8)" : VF_TIE(B) :: "memory");
  mfma4(o[1], B, pa0, pa1, pa2, pa3);
#pragma unroll
  for (int r = 0; r < 16; ++r) dmax = fmaxf(dmax, p1[r]);
  { auto rr = __builtin_amdgcn_permlane32_swap(__float_as_uint(dmax), __float_as_uint(dmax), false, false);
    dmax = fmaxf(__uint_as_float(rr[0]), __uint_as_float(rr[1])); }
  alpha = 1.f;
  if (!__all(dmax <= THR2)) {
    const float delta = dmax > THR2 ? dmax : 0.f; alpha = __builtin_amdgcn_exp2f(-delta);
#pragma unroll
    for (int r = 0; r < 16; ++r) { p0[r] -= delta; p1[r] -= delta; nm[r] -= delta; }
  }
  tr8<3>(B, vb);
  asm volatile("s_waitcnt lgkmcnt(8)" : VF_TIE(A) :: "memory");
  mfma4(o[2], A, pa0, pa1, pa2, pa3);
#pragma unroll
  for (int r = 0; r < 8; ++r) p0[r] = __builtin_amdgcn_exp2f(p0[r]);
  asm volatile("s_waitcnt lgkmcnt(0)" : VF_TIE(B) :: "memory");
  mfma4(o[3], B, pa0, pa1, pa2, pa3);
#pragma unroll
  for (int r = 8; r < 16; ++r) p0[r] = __builtin_amdgcn_exp2f(p0[r]);
  o[4] = __builtin_amdgcn_mfma_f32_32x32x16_bf16(pa0, one8, o[4], 0, 0, 0); o[4] = __builtin_amdgcn_mfma_f32_32x32x16_bf16(pa1, one8, o[4], 0, 0, 0);
  o[4] = __builtin_amdgcn_mfma_f32_32x32x16_bf16(pa2, one8, o[4], 0, 0, 0); o[4] = __builtin_amdgcn_mfma_f32_32x32x16_bf16(pa3, one8, o[4], 0, 0, 0);
}
__device__ __forceinline__ void pv_psm_lean_b(f32x16* o, int vb, bf16x8 pa0, bf16x8 pa1, bf16x8 pa2, bf16x8 pa3, f32x16& p0, f32x16& p1, f32x16& nm, float& alpha) {
  constexpr float THR2 = 11.541560327111707f;
  const bf16x8 one8 = {0x3F80, 0x3F80, 0x3F80, 0x3F80, 0x3F80, 0x3F80, 0x3F80, 0x3F80};
  VFrag A, B;
  tr8b<0>(A, vb); tr8b<1>(B, vb);
  mfma4(o[0], A, pa0, pa1, pa2, pa3);
  float dmax = p0[0];
#pragma unroll
  for (int r = 1; r < 16; ++r) dmax = fmaxf(dmax, p0[r]);
  tr8b<2>(A, vb);
  mfma4(o[1], B, pa0, pa1, pa2, pa3);
#pragma unroll
  for (int r = 0; r < 16; ++r) dmax = fmaxf(dmax, p1[r]);
  { auto rr = __builtin_amdgcn_permlane32_swap(__float_as_uint(dmax), __float_as_uint(dmax), false, false);
    dmax = fmaxf(__uint_as_float(rr[0]), __uint_as_float(rr[1])); }
  alpha = 1.f;
  if (!__all(dmax <= THR2)) {
    const float delta = dmax > THR2 ? dmax : 0.f; alpha = __builtin_amdgcn_exp2f(-delta);
#pragma unroll
    for (int r = 0; r < 16; ++r) { p0[r] -= delta; p1[r] -= delta; nm[r] -= delta; }
  }
  tr8b<3>(B, vb);
  mfma4(o[2], A, pa0, pa1, pa2, pa3);
#pragma unroll
  for (int r = 0; r < 8; ++r) p0[r] = __builtin_amdgcn_exp2f(p0[r]);
  mfma4(o[3], B, pa0, pa1, pa2, pa3);
#pragma unroll
  for (int r = 8; r < 16; ++r) p0[r] = __builtin_amdgcn_exp2f(p0[r]);
  o[4] = __builtin_amdgcn_mfma_f32_32x32x16_bf16(pa0, one8, o[4], 0, 0, 0); o[4] = __builtin_amdgcn_mfma_f32_32x32x16_bf16(pa1, one8, o[4], 0, 0, 0);
  o[4] = __builtin_amdgcn_mfma_f32_32x32x16_bf16(pa2, one8, o[4], 0, 0, 0); o[4] = __builtin_amdgcn_mfma_f32_32x32x16_bf16(pa3, one8, o[4], 0, 0, 0);
}
struct VStep { s16x4 l0, h0, l1, h1, l2, h2, l3, h3; };
template <int KS> __device__ __forceinline__ void trstep(VStep& f, int vb) {
  f.l0 = tr_read_b<v_rd_off(0, KS, 0)>(vb); f.h0 = tr_read_b<v_rd_off(0, KS, 1)>(vb); f.l1 = tr_read_b<v_rd_off(1, KS, 0)>(vb); f.h1 = tr_read_b<v_rd_off(1, KS, 1)>(vb);
  f.l2 = tr_read_b<v_rd_off(2, KS, 0)>(vb); f.h2 = tr_read_b<v_rd_off(2, KS, 1)>(vb); f.l3 = tr_read_b<v_rd_off(3, KS, 0)>(vb); f.h3 = tr_read_b<v_rd_off(3, KS, 1)>(vb);
}
__device__ __forceinline__ void mfma5(f32x16* o, const VStep& f, bf16x8 pa) {
  const bf16x8 one8 = {0x3F80, 0x3F80, 0x3F80, 0x3F80, 0x3F80, 0x3F80, 0x3F80, 0x3F80};
#define PK(L, H) (bf16x8){L[0], L[1], L[2], L[3], H[0], H[1], H[2], H[3]}
  o[0] = __builtin_amdgcn_mfma_f32_32x32x16_bf16(pa, PK(f.l0, f.h0), o[0], 0, 0, 0);
  o[1] = __builtin_amdgcn_mfma_f32_32x32x16_bf16(pa, PK(f.l1, f.h1), o[1], 0, 0, 0);
  o[2] = __builtin_amdgcn_mfma_f32_32x32x16_bf16(pa, PK(f.l2, f.h2), o[2], 0, 0, 0);
  o[3] = __builtin_amdgcn_mfma_f32_32x32x16_bf16(pa, PK(f.l3, f.h3), o[3], 0, 0, 0);
  o[4] = __builtin_amdgcn_mfma_f32_32x32x16_bf16(pa, one8, o[4], 0, 0, 0);
#undef PK
}
template <int BASE> __device__ __forceinline__ bf16x8 pk4e(const f32x16& P) {
  const float e0 = __builtin_amdgcn_exp2f(P[BASE + 0]), e1 = __builtin_amdgcn_exp2f(P[BASE + 1]), e2 = __builtin_amdgcn_exp2f(P[BASE + 2]), e3 = __builtin_amdgcn_exp2f(P[BASE + 3]);
  const float e4 = __builtin_amdgcn_exp2f(P[BASE + 4]), e5 = __builtin_amdgcn_exp2f(P[BASE + 5]), e6 = __builtin_amdgcn_exp2f(P[BASE + 6]), e7 = __builtin_amdgcn_exp2f(P[BASE + 7]);
  const unsigned a0 = cvtpk(e0, e1), a1 = cvtpk(e2, e3), b0 = cvtpk(e4, e5), b1 = cvtpk(e6, e7);
  const auto r0 = __builtin_amdgcn_permlane32_swap(a0, b0, false, false); const auto r1 = __builtin_amdgcn_permlane32_swap(a1, b1, false, false);
  u32x4 w = {r0[0], r1[0], r0[1], r1[1]}; return *reinterpret_cast<bf16x8*>(&w);
}
__device__ __forceinline__ float rowmax_lean(const f32x16& p0, const f32x16& p1) {
  float d = p0[0];
#pragma unroll
  for (int r = 1; r < 16; ++r) d = fmaxf(d, p0[r]);
#pragma unroll
  for (int r = 0; r < 16; ++r) d = fmaxf(d, p1[r]);
  const auto rr = __builtin_amdgcn_permlane32_swap(__float_as_uint(d), __float_as_uint(d), false, false);
  return fmaxf(__uint_as_float(rr[0]), __uint_as_float(rr[1]));
}
__device__ __forceinline__ void shift_lean(float dmax, f32x16& p0, f32x16& p1, f32x16& nm, float& alpha, const bool first) {
  constexpr float THR2 = 11.541560327111707f;
  alpha = 1.f;
  if (first || !__all(dmax <= THR2)) {
    const float delta = first ? dmax : (dmax > THR2 ? dmax : 0.f);
    if (!first) alpha = __builtin_amdgcn_exp2f(-delta);
#pragma unroll
    for (int r = 0; r < 16; ++r) { p0[r] -= delta; p1[r] -= delta; nm[r] -= delta; }
  }
}
#define SGB(mask, n) __builtin_amdgcn_sched_group_barrier((mask), (n), 0)
__device__ __forceinline__ bf16x8 ld8(const bf16* p) { return *reinterpret_cast<const bf16x8*>(p); }

template <int MODE, int ATTV = 0>
__device__ __forceinline__ void attn_unit(const bf16* __restrict__ Qrow0, int ldq, const bf16* __restrict__ Kb, const bf16* __restrict__ Vb, int ldk, const bf16* __restrict__ KRb,
                                          int b, int nct, int NT, bf16* __restrict__ Ob, float lam, const float* __restrict__ subln, float oscale, LAS unsigned char* lds_, const int tid_in) {
  constexpr bool LEAN = ((MODE == 1) && ATT_LEAN) || ((MODE == 0) && ATT_LEAN0); constexpr int NQF = MODE == 0 ? 12 : 4, NQR = MODE == 0 ? 6 : ATT_DA_NQR, NOB = LEAN ? 5 : 4, PITCH = MODE == 0 ? 384 : 256, SHM_V = 16384, SHM_K = 64 * PITCH, SDEPTH = ATT_SDEPTH(MODE); constexpr bool PVPIPE = ATT_PVPIPE(MODE);
  const float SCALE = MODE == 0 ? 0.07216878364870323f : 0.125f;
  const float C = SCALE * 1.4426950408889634f, THRS = 8.f / SCALE;
  if (ATT_PRIO) { if (__builtin_amdgcn_readfirstlane(tid_in >> 8) != 0) __builtin_amdgcn_s_setprio(1); }
  const int tid = launder_v(tid_in) & 511, wid = tid >> 6, lane = tid & 63, r32 = lane & 31, hi = lane >> 5;
  LAS char* lds = (LAS char*)(LAS unsigned char*)lds_;
  constexpr bool THREE = (MODE == 1) && ATT_3STAGE; constexpr int NSTG = THREE ? 3 : 2, STG = SHM_V + SHM_K, SCR0 = NSTG * STG;
#define VOFF(s) (!THREE ? (s) * SHM_V : (s) * STG)
#define KOFF(s) (!THREE ? 2 * SHM_V + (s) * SHM_K : (s) * STG + SHM_V)
  LAS char* V_lds = lds; LAS char* K_lds = lds;
  LAS float* wsf = (LAS float*)(lds + NSTG * (SHM_V + SHM_K)) + wid * 64; LAS float* li_l = wsf; LAS float* al_l = wsf + 32;
  const int wq = MODE == 0 ? wid : (wid & 3), sgrp = MODE == 0 ? 0 : (wid >> 2);
  float m_reg = -1e30f, l_reg = 0; f32x16 o[NOB] = {}; bf16x8 qr[NQR > 0 ? NQR : 1]; f32x16 nm = {};
  LAS char* ql = lds + SCR0 + 2048 + wid * (MODE == 0 ? 8192 : 4096) + lane * 16;
  const bf16* Qw = Qrow0 + (size_t)(wq * 32 + r32) * ldq + sgrp * 64 + hi * 8;
#define QLOADS() do { _Pragma("unroll") for (int d0 = 0; d0 < NQR; ++d0) { qr[d0] = ld8(Qw + d0 * 16); if (LEAN) qr[d0] = scale_bf16x8(qr[d0], C); } \
    _Pragma("unroll") for (int d0 = NQR; d0 < NQF; ++d0) { bf16x8 qv = ld8(Qw + d0 * 16); if (LEAN) qv = scale_bf16x8(qv, C); *(LAS bf16x8*)(ql + (d0 - NQR) * 1024) = qv; } } while (0)
  constexpr bool QLATE = ATT_QLATE && !((MODE == 1) && ATT_3STAGE) && !((MODE == 1) && ATT_LEAN && ATT_KMAJOR && (ATTV == 0));
  if (!QLATE) QLOADS();
  const int sr = tid >> 4, sc = (tid & 15) * 8;
  const int srv = ATT_VSTCF ? (tid >> 6) * 4 + ((tid >> 2) & 3) : sr, scv = ATT_VSTCF ? ((tid >> 4) & 3) * 32 + (tid & 3) * 8 : sc;
  const int vst0 = v_st(srv, scv), vst1 = v_st(32 + srv, scv);
  const int kst0 = sr * PITCH + (((tid & 15) ^ kswz<PITCH>(sr)) * 16), kst1 = kst0 + 32 * PITCH;
  const int rrow = tid >> 3, krs = rrow * PITCH + (((16 + (tid & 7)) ^ kswz<PITCH>(rrow)) * 16);
  const int chunk0 = sgrp * 8;
  const int vb0 = (int)(uintptr_t)V_lds + v_rd_base(lane);
  struct Slot { bf16x8 vs0, vs1, ks0, ks1, kr; } sr_[SDEPTH];
#define KROW(jt) ((jt) < nct ? (ML + b * CTXL + (jt) * 64) : (b * SEQ + ((jt) - nct) * 64))
#define SLOAD(i, jt) do { const int k0_ = KROW(jt); sr_[i].vs0 = ld8(Vb + (size_t)(k0_ + srv) * ldk + scv); sr_[i].vs1 = ld8(Vb + (size_t)(k0_ + 32 + srv) * ldk + scv); \
    sr_[i].ks0 = ld8(Kb + (size_t)(k0_ + sr) * ldk + sc); sr_[i].ks1 = ld8(Kb + (size_t)(k0_ + 32 + sr) * ldk + sc); \
    if (MODE == 0) sr_[i].kr = ld8(KRb + (size_t)(k0_ + rrow) * 64 + (tid & 7) * 8); } while (0)
#define SWRITE(bf, i) do { *(LAS bf16x8*)(V_lds + VOFF(bf) + vst0) = sr_[i].vs0; *(LAS bf16x8*)(V_lds + VOFF(bf) + vst1) = sr_[i].vs1; \
    *(LAS bf16x8*)(K_lds + KOFF(bf) + kst0) = sr_[i].ks0; *(LAS bf16x8*)(K_lds + KOFF(bf) + kst1) = sr_[i].ks1; \
    if (MODE == 0) *(LAS bf16x8*)(K_lds + KOFF(bf) + krs) = sr_[i].kr; } while (0)
#define SWAIT() do { if constexpr (SDEPTH == 2) asm volatile("s_waitcnt vmcnt(4)" ::: "memory"); else asm volatile("s_waitcnt vmcnt(0)" ::: "memory"); } while (0)
#define RESC(a) do { if (__any((a) < 1.f)) { if (hi == 0) al_l[r32] = (a); asm volatile("s_waitcnt lgkmcnt(0)" ::: "memory"); \
    _Pragma("unroll") for (int d = 0; d < NOB; ++d) _Pragma("unroll") for (int r = 0; r < 16; ++r) o[d][r] *= al_l[crow(r, hi)]; } } while (0)
#define PV(vb_) do { if constexpr (ATTV == 2) { o[0][0] += __uint_as_float((unsigned)pa0[0] + (unsigned)pa3[1]); } else if constexpr (PVPIPE) pv_pipe(o, (vb_), pa0, pa1, pa2, pa3); else pv_d0(o, (vb_), pa0, pa1, pa2, pa3); \
    if constexpr (LEAN) { const bf16x8 one8 = {0x3F80, 0x3F80, 0x3F80, 0x3F80, 0x3F80, 0x3F80, 0x3F80, 0x3F80};     \
        o[NOB - 1] = __builtin_amdgcn_mfma_f32_32x32x16_bf16(pa0, one8, o[NOB - 1], 0, 0, 0); o[NOB - 1] = __builtin_amdgcn_mfma_f32_32x32x16_bf16(pa1, one8, o[NOB - 1], 0, 0, 0); \
        o[NOB - 1] = __builtin_amdgcn_mfma_f32_32x32x16_bf16(pa2, one8, o[NOB - 1], 0, 0, 0); o[NOB - 1] = __builtin_amdgcn_mfma_f32_32x32x16_bf16(pa3, one8, o[NOB - 1], 0, 0, 0); } } while (0)
#define PSM(p0_, p1_, mn_, al_, first_) do { if constexpr (ATTV == 1) { al_ = 1.f; } else if constexpr (LEAN) partialSM_lean(p0_, p1_, nm, al_, first_); else partialSM(p0_, p1_, m_reg, mn_, al_, C, THRS); } while (0)
#define FSM(p0_, p1_, al_) do { if constexpr (ATTV == 1) { u32x4 w0_ = {__float_as_uint(p0_[0]), __float_as_uint(p0_[1]), __float_as_uint(p1_[0]), __float_as_uint(p1_[1])}; pa0 = pa1 = pa2 = pa3 = *reinterpret_cast<bf16x8*>(&w0_); } else if constexpr (LEAN) finishSM_lean(p0_, p1_, pa0, pa1, pa2, pa3); else finishSM(p0_, p1_, al_, l_reg, pa0, pa1, pa2, pa3); } while (0)
#define QKT(p0_, p1_, Kp_) do { if constexpr (ATTV == 5) { p0_ = nm; p1_ = nm; p0_[0] += (float)r32; } else if constexpr (LEAN) qkt<NQF, NQR, PITCH>(p0_, p1_, Kp_, chunk0, qr, ql, r32, hi, nm); else qkt<NQF, NQR, PITCH>(p0_, p1_, Kp_, chunk0, qr, ql, r32, hi); } while (0)
  f32x16 pA0, pA1, pB0, pB1; float mnA, mnB, alA, alB; bf16x8 pa0, pa1, pa2, pa3;
  constexpr bool KMAJ = (MODE == 1) && LEAN && ATT_KMAJOR && (ATTV == 0) && !THREE;
  if constexpr (KMAJ) {
    VStep VA, VB;
#define KSTEPS(PC0, PC1, ALC, PP0, PP1, KC, VP, LD, DOQK) do { const int vb_ = vb0 + VOFF(VP); float dmx_ = 0.f; \
      SBAR(); \
      if (DOQK) QKT(PC0, PC1, K_lds + KOFF(KC)); \
      pa0 = pk4e<0>(PP0); trstep<0>(VA, vb_); \
      _Pragma("unroll") for (int i_ = 0; i_ < 8; ++i_) { SGB(0x008, 1); SGB(0x100, 3); SGB(0x002, 2); } \
      SBAR(); LD; SBAR(); \
      mfma5(o, VA, pa0); pa1 = pk4e<8>(PP0); trstep<1>(VB, vb_); \
      _Pragma("unroll") for (int i_ = 0; i_ < 5; ++i_) { SGB(0x008, 1); SGB(0x100, 2); SGB(0x002, 3); } \
      SBAR(); \
      mfma5(o, VB, pa1); pa2 = pk4e<0>(PP1); trstep<2>(VA, vb_); \
      _Pragma("unroll") for (int i_ = 0; i_ < 5; ++i_) { SGB(0x008, 1); SGB(0x100, 2); SGB(0x002, 3); } \
      SBAR(); \
      mfma5(o, VA, pa2); pa3 = pk4e<8>(PP1); trstep<3>(VB, vb_); \
      _Pragma("unroll") for (int i_ = 0; i_ < 5; ++i_) { SGB(0x008, 1); SGB(0x100, 2); SGB(0x002, 3); } \
      SBAR(); \
      mfma5(o, VB, pa3); if (DOQK) dmx_ = rowmax_lean(PC0, PC1); \
      _Pragma("unroll") for (int i_ = 0; i_ < 5; ++i_) { SGB(0x008, 1); SGB(0x002, 7); } \
      SBAR(); \
      if (DOQK) shift_lean(dmx_, PC0, PC1, nm, ALC, false); } while (0)
    SLOAD(0, 0); asm volatile("s_waitcnt vmcnt(0)" ::: "memory"); SWRITE(0, 0); __syncthreads();
    QKT(pA0, pA1, K_lds + KOFF(0)); shift_lean(rowmax_lean(pA0, pA1), pA0, pA1, nm, alA, true);
    SLOAD(0, 1); asm volatile("s_waitcnt vmcnt(0)" ::: "memory"); SWRITE(1, 0); __syncthreads();
    for (int j = 1; j + 1 < NT; j += 2) {
      KSTEPS(pB0, pB1, alB, pA0, pA1, 1, 0, SLOAD(0, j + 1), true);
      __syncthreads(); asm volatile("s_waitcnt vmcnt(0)" ::: "memory"); SWRITE(0, 0);
      RESC(alB); __syncthreads();
      KSTEPS(pA0, pA1, alA, pB0, pB1, 0, 1, SLOAD(0, j + 2), true);
      __syncthreads(); asm volatile("s_waitcnt vmcnt(0)" ::: "memory"); SWRITE(1, 0);
      RESC(alA); __syncthreads();
    }
    KSTEPS(pB0, pB1, alB, pA0, pA1, 1, 0, (void)0, true);
    __syncthreads(); RESC(alB);
    KSTEPS(pA0, pA1, alA, pB0, pB1, 0, 1, (void)0, false);
#undef KSTEPS
  } else if constexpr (!THREE) {
  constexpr int SE = 0, SO = SDEPTH - 1;
  SLOAD(SE, 0); if (QLATE) QLOADS(); asm volatile("s_waitcnt vmcnt(0)" ::: "memory"); SWRITE(0, SE);
  if constexpr (QLATE && SDEPTH == 1) SLOAD(SO, 1);
  __syncthreads();
  QKT(pA0, pA1, K_lds + KOFF(0)); PSM(pA0, pA1, mnA, alA, true);
  if constexpr (!(QLATE && SDEPTH == 1)) SLOAD(SO, 1);
  if constexpr (SDEPTH == 2) { if (2 < NT) SLOAD(SE, 2); }
  SWAIT(); SWRITE(1, SO); __syncthreads();
#define ILV() do { if constexpr (PVPIPE) { _Pragma("unroll") for (int i_ = 0; i_ < 20; ++i_) { __builtin_amdgcn_sched_group_barrier(0x008, 1, 0); __builtin_amdgcn_sched_group_barrier(0x002, 5, 0); } } } while (0)
#define LSLOAD(i, jt) do { if constexpr (ATTV != 3) SLOAD(i, jt); } while (0)
#define LSWRITE(bf, i) do { if constexpr (ATTV != 3) SWRITE(bf, i); } while (0)
#define LSWAIT() do { if constexpr (ATTV != 3) SWAIT(); } while (0)
#define LSYNC() do { if constexpr (ATTV != 4) __syncthreads(); } while (0)
#define HALFSTEP(PC0, PC1, MNC, ALC, PP0, PP1, ALP, KC, VP, LD) do { \
    if (!STAG || wid < 4) { \
      SBAR(); QKT(PC0, PC1, K_lds + KOFF(KC)); FSM(PP0, PP1, ALP); SBAR(); \
      LD; SBAR(); \
      if constexpr (PVPIPE && LEAN && ATTV == 0) { if constexpr (ATT_TRB) pv_psm_lean_b(o, vb0 + VOFF(VP), pa0, pa1, pa2, pa3, PC0, PC1, nm, ALC); else pv_psm_lean(o, vb0 + VOFF(VP), pa0, pa1, pa2, pa3, PC0, PC1, nm, ALC); } else { PV(vb0 + VOFF(VP)); PSM(PC0, PC1, MNC, ALC, false); } \
    } else { \
      SBAR(); FSM(PP0, PP1, ALP); SBAR(); \
      LD; SBAR(); \
      PV(vb0 + VOFF(VP)); SBAR(); \
      QKT(PC0, PC1, K_lds + KOFF(KC)); SBAR(); \
      PSM(PC0, PC1, MNC, ALC, false); \
    } } while (0)
  constexpr bool STAG = (MODE == 1) && ATT_STAGGER && ATTV == 0;
  for (int j = 1; j + 1 < NT; j += 2) {
    HALFSTEP(pB0, pB1, mnB, alB, pA0, pA1, alA, 1, 0, LSLOAD(SO, j + SDEPTH));
    LSYNC(); LSWAIT(); LSWRITE(0, SE);
    RESC(alB); LSYNC();
    HALFSTEP(pA0, pA1, mnA, alA, pB0, pB1, alB, 0, 1, if (SDEPTH == 1 || j + 3 < NT) LSLOAD(SE, j + 1 + SDEPTH));
    LSYNC(); LSWAIT(); LSWRITE(1, SO);
    RESC(alA); LSYNC();
  }
#undef HALFSTEP
#undef ILV
#undef LSLOAD
#undef LSWRITE
#undef LSWAIT
#undef LSYNC
  SBAR(); QKT(pB0, pB1, K_lds + KOFF(1));
  FSM(pA0, pA1, alA); SBAR();
  PV(vb0); PSM(pB0, pB1, mnB, alB, false);
  __syncthreads(); RESC(alB);
  FSM(pB0, pB1, alB); SBAR();
  PV(vb0 + VOFF(1));
  } else {
#define STEP(PC0, PC1, ALC, PP0, PP1, ALP, jj, SP, SC, SN) do { const int j_ = (jj); \
      if (j_ + 1 < NT) { asm volatile("s_waitcnt vmcnt(0)" ::: "memory"); SWRITE(SN, 0); if (j_ + 2 < NT) SLOAD(0, j_ + 2); } \
      SBAR(); QKT(PC0, PC1, K_lds + KOFF(SC)); FSM(PP0, PP1, ALP); SBAR(); \
      PV(vb0 + VOFF(SP)); PSM(PC0, PC1, mnA, ALC, false); \
      RESC(ALC); __syncthreads(); } while (0)
    SLOAD(0, 0); asm volatile("s_waitcnt vmcnt(0)" ::: "memory"); SWRITE(0, 0);
    SLOAD(0, 1); asm volatile("s_waitcnt vmcnt(0)" ::: "memory"); SWRITE(1, 0);
    SLOAD(0, 2); __syncthreads();
    QKT(pA0, pA1, K_lds + KOFF(0)); PSM(pA0, pA1, mnA, alA, true);
    STEP(pB0, pB1, alB, pA0, pA1, alA, 1, 0, 1, 2);
    int j = 2;
    for (; j + 5 < NT; j += 6) {
      STEP(pA0, pA1, alA, pB0, pB1, alB, j, 1, 2, 0);
      STEP(pB0, pB1, alB, pA0, pA1, alA, j + 1, 2, 0, 1);
      STEP(pA0, pA1, alA, pB0, pB1, alB, j + 2, 0, 1, 2);
      STEP(pB0, pB1, alB, pA0, pA1, alA, j + 3, 1, 2, 0);
      STEP(pA0, pA1, alA, pB0, pB1, alB, j + 4, 2, 0, 1);
      STEP(pB0, pB1, alB, pA0, pA1, alA, j + 5, 0, 1, 2);
    }
    if (j < NT) { STEP(pA0, pA1, alA, pB0, pB1, alB, j, 1, 2, 0); STEP(pB0, pB1, alB, pA0, pA1, alA, j + 1, 2, 0, 1); j += 2; }
    if (j < NT) { STEP(pA0, pA1, alA, pB0, pB1, alB, j, 0, 1, 2); STEP(pB0, pB1, alB, pA0, pA1, alA, j + 1, 1, 2, 0); j += 2; }
    FSM(pB0, pB1, alB); SBAR();
    { const int sl = (NT - 1) % 3; PV(vb0 + VOFF(sl)); }
#undef STEP
  }
  float rli[16];
  if constexpr (LEAN) {
#pragma unroll
    for (int r = 0; r < 16; ++r) rli[r] = __builtin_amdgcn_rcpf(o[NOB - 1][r]);
  } else {
    if (hi == 0) li_l[r32] = l_reg; asm volatile("s_waitcnt lgkmcnt(0)" ::: "memory");
#pragma unroll
    for (int r = 0; r < 16; ++r) rli[r] = __builtin_amdgcn_rcpf(li_l[crow(r, hi)]);
  }
  bf16* Ow = Ob + (size_t)(wq * 32) * DM;
  if constexpr (MODE == 0) {
#pragma unroll
    for (int r = 0; r < 16; ++r) { const int orow = crow(r, hi);
#pragma unroll
      for (int d0 = 0; d0 < 4; ++d0) Ow[(size_t)orow * DM + d0 * 32 + r32] = tobf1(o[d0][r] * rli[r]); }
    __syncthreads();
  } else {
    LAS float* ex = (LAS float*)lds;
    __syncthreads();
    if (sgrp == 1) {
#pragma unroll
      for (int r = 0; r < 16; ++r)
#pragma unroll
        for (int d0 = 0; d0 < 4; ++d0) ex[(wq * 32 + crow(r, hi)) * 128 + d0 * 32 + r32] = o[d0][r] * rli[r];
    }
    __syncthreads();
    if (sgrp == 0) {
#pragma unroll
      for (int r = 0; r < 16; ++r) { const int orow = crow(r, hi); float dd[4]; float ss = 0.f;
#pragma unroll
        for (int d0 = 0; d0 < 4; ++d0) { dd[d0] = o[d0][r] * rli[r] - lam * ex[(wq * 32 + orow) * 128 + d0 * 32 + r32]; ss += dd[d0] * dd[d0]; }
        ss = half_sum32(ss);
        const float rs = oscale / sqrtf(ss * (1.0f / 128.0f) + LN_EPS);
#pragma unroll
        for (int d0 = 0; d0 < 4; ++d0) Ow[(size_t)orow * DM + d0 * 32 + r32] = tobf1(dd[d0] * rs * subln[d0 * 32 + r32]); }
    }
    __syncthreads();
  }
  if (ATT_PRIO) __builtin_amdgcn_s_setprio(0);
#undef VOFF
#undef KOFF
#undef PV
#undef PSM
#undef FSM
#undef QKT
#undef KROW
#undef SLOAD
#undef SWRITE
#undef SWAIT
#undef RESC
}
}

__device__ __forceinline__ void mla_attn_phase(CP P, LAS unsigned char* lds, const int tid) {
    const bf16* QM = (const bf16*)(P->ws + WS_QM); const bf16* KV = (const bf16*)(P->ws + WS_KV); const bf16* KR = (const bf16*)(P->ws + WS_KR); bf16* Gb = (bf16*)(P->ws + WS_G);
    const int c = blockIdx.x, G = gridDim.x;
    for (int u = c; u < 1024 + 32; u += G) {
        int b, h, qrow0, NT;
        if (u < 1024) { const int i = u >> 8, cc = u & 255; const int bh = (cc & 7) + 8 * i, qb = cc >> 3; b = bh >> 4; h = bh & 15; qrow0 = b * SEQ + qb * 256; NT = 4 + 128; }
        else { const int bh = u - 1024; b = bh >> 4; h = bh & 15; qrow0 = ML + b * CTXL; NT = 4; }
        att::attn_unit<0>(QM + (size_t)qrow0 * 3072 + h * 192, 3072, KV + h * 256, KV + h * 256 + 128, 4096, KR, b, 4, NT, Gb + (size_t)qrow0 * DM + h * 128, 0.f, nullptr, 1.f, lds, tid);
    }
}
template <int ATTV = 0>
__device__ __forceinline__ void da_attn_phase(CP P, float lam, float oscale, LAS unsigned char* lds, const int tid, const bool ctx_q, const int nt_cap = 0) {
    const bf16* Z = (const bf16*)(P->ws + WS_Z); bf16* Gb = (bf16*)(P->ws + WS_G); const float* subln = P->in[27];
    const int c = blockIdx.x, G = gridDim.x;
    for (int u = c; u < 2048 + (ctx_q ? 64 : 0); u += G) {
        int b, h, qrow0, NT;
        if (u < 2048) { const int i = u >> 8, cc = u & 255; const int bh = (cc & 7) + 8 * (i >> 1), qb = (cc >> 3) + 32 * (i & 1); b = bh >> 4; h = bh & 15; qrow0 = b * SEQ + qb * 128; NT = 4 + 128; }
        else { const int v = u - 2048; const int bh = v >> 1; b = bh >> 4; h = bh & 15; qrow0 = ML + b * CTXL + (v & 1) * 128; NT = 4; }
        if (nt_cap) NT = nt_cap;
        att::attn_unit<1, ATTV>(Z + (size_t)qrow0 * 6144 + h * 128, 6144, Z + 2048 + h * 128, Z + 4096 + h * 128, 6144, nullptr, b, 4, NT, Gb + (size_t)qrow0 * DM + h * 128, lam, subln, oscale, lds, tid);
    }
}

__device__ __forceinline__ unsigned f2ord(float f) { const unsigned u = __float_as_uint(f); return u ^ ((unsigned)((int)u >> 31) | 0x80000000u); }
__device__ __forceinline__ float ord2f(unsigned k) { return __uint_as_float((k & 0x80000000u) ? (k ^ 0x80000000u) : ~k); }
__device__ __forceinline__ void ce_desc(unsigned& a, unsigned& b) { const unsigned mx = a > b ? a : b, mn = a > b ? b : a; a = mx; b = mn; }
template <int N, bool DESC> __device__ __forceinline__ void bitonic_merge(unsigned* a) {
#pragma unroll
    for (int j = N / 2; j > 0; j >>= 1)
#pragma unroll
        for (int i = 0; i < N; ++i) { const int l = i ^ j; if (l > i) { if (DESC) ce_desc(a[i], a[l]); else ce_desc(a[l], a[i]); } }
}
template <int N, bool DESC> __device__ __forceinline__ void bitonic_sort(unsigned* a) {
#pragma unroll
    for (int k = 2; k <= N; k <<= 1)
#pragma unroll
        for (int j = k >> 1; j > 0; j >>= 1)
#pragma unroll
            for (int i = 0; i < N; ++i) { const int l = i ^ j; if (l > i) { const bool up = ((i & k) == 0); if (up == DESC) ce_desc(a[i], a[l]); else ce_desc(a[l], a[i]); } }
}
__device__ __forceinline__ void top16_of_64(unsigned (&a)[64]) {
    bitonic_sort<16, true>(a); bitonic_sort<16, false>(a + 16); bitonic_sort<16, true>(a + 32); bitonic_sort<16, false>(a + 48);
#pragma unroll
    for (int i = 0; i < 16; ++i) a[i] = a[i] > a[16 + i] ? a[i] : a[16 + i];
    bitonic_merge<16, true>(a);
#pragma unroll
    for (int i = 0; i < 16; ++i) a[32 + i] = a[32 + i] > a[48 + i] ? a[32 + i] : a[48 + i];
    bitonic_merge<16, false>(a + 32);
#pragma unroll
    for (int i = 0; i < 16; ++i) a[i] = a[i] > a[32 + i] ? a[i] : a[32 + i];
    bitonic_merge<16, true>(a);
}
template <int PASS> __device__ __forceinline__ void route_qload(const bf16* QP, int tok, int head, int hi, bf16x8 (&qf)[8]) {
    const bf16* qp = QP + (size_t)tok * DM + head * 256 + PASS * 128 + hi * 8;
#pragma unroll
    for (int ks = 0; ks < 8; ++ks) qf[ks] = NT_ACT ? __builtin_nontemporal_load((const bf16x8*)(qp + ks * 16)) : *(const bf16x8*)(qp + ks * 16);
}
template <int PASS> __device__ __forceinline__ void route_pass(const bf16x8 (&qf)[8], const LAS char* lds, int tok, int head, int r32, int hi, unsigned (&top)[16]) {
    f32x16 acc[4] = {};
    const LAS char* Kl = lds + PASS * 32768;
#pragma unroll
    for (int kb = 0; kb < 4; ++kb)
#pragma unroll
        for (int ks = 0; ks < 8; ++ks) { const bf16x8 a = *(const LAS bf16x8*)(Kl + (kb * 32 + r32) * 256 + (((ks * 2 + hi) ^ (r32 & 15)) * 16));
            acc[kb] = __builtin_amdgcn_mfma_f32_32x32x16_bf16(a, qf[ks], acc[kb], 0, 0, 0); }
    unsigned key[64]; const unsigned base = 127u - 4u * (unsigned)hi;
#pragma unroll
    for (int kb = 0; kb < 4; ++kb)
#pragma unroll
        for (int r = 0; r < 16; ++r) key[kb * 16 + r] = (f2ord(acc[kb][r]) & ~127u) | (base - (unsigned)(kb * 32 + (r & 3) + 8 * (r >> 2)));
    top16_of_64(key);
    unsigned pr[16];
#pragma unroll
    for (int i = 0; i < 16; ++i) pr[i] = lane_xor32(key[15 - i], hi << 5);
#pragma unroll
    for (int i = 0; i < 16; ++i) key[i] = key[i] > pr[i] ? key[i] : pr[i];
    bitonic_merge<16, true>(key);
#pragma unroll
    for (int i = 0; i < 16; ++i) top[i] = key[i];
}
#ifndef ROUTE_SORT
#define ROUTE_SORT 1
#endif
#define DPP_U(v, ctrl) ((unsigned)__builtin_amdgcn_mov_dpp((int)(v), (ctrl), 0xF, 0xF, true))
template <int J> __device__ __forceinline__ unsigned lane_xor_u(unsigned v, int lane) {
    if (J == 1) return DPP_U(v, 0xB1);
    if (J == 2) return DPP_U(v, 0x4E);
    if (J == 4) { const unsigned t = DPP_U(v, 0x141); return DPP_U(t, 0x1B); }
    if (J == 8) { const unsigned t = DPP_U(v, 0x140); return DPP_U(t, 0x141); }
    if (J == 16) { const auto r = __builtin_amdgcn_permlane16_swap(v, v, false, false); return (lane & 16) ? r[0] : r[1]; }
    return lane_xor32(v, lane);
}
template <int K, int J> __device__ __forceinline__ void sort128_stage(unsigned& a0, unsigned& a1, int lane) {
    if constexpr (J == 64) { const unsigned mn = a0 < a1 ? a0 : a1, mx = a0 < a1 ? a1 : a0; a0 = mn; a1 = mx; }
    else { const unsigned p0 = lane_xor_u<J>(a0, lane), p1 = lane_xor_u<J>(a1, lane);
        const bool lower = (lane & J) == 0;
        const bool asc0 = (K >= 64) ? true : ((lane & K) == 0), asc1 = (K == 128) ? true : (K == 64 ? false : ((lane & K) == 0));
        const unsigned mn0 = a0 < p0 ? a0 : p0, mx0 = a0 < p0 ? p0 : a0, mn1 = a1 < p1 ? a1 : p1, mx1 = a1 < p1 ? p1 : a1;
        a0 = (lower == asc0) ? mn0 : mx0; a1 = (lower == asc1) ? mn1 : mx1; }
    if constexpr (J > 1) sort128_stage<K, J / 2>(a0, a1, lane);
    else if constexpr (K < 128) sort128_stage<K * 2, K>(a0, a1, lane);
}
__device__ __forceinline__ void sort128_asc(unsigned& a0, unsigned& a1, int lane) { sort128_stage<2, 1>(a0, a1, lane); }
__device__ __forceinline__ void route_phase(CP P, int L, int Mrows, LAS unsigned char* lds_, int tid, int lane, int wid, int gw, int NGW) {
    const bf16* QP = (const bf16*)(P->ws + WS_QP); unsigned* ROUTE = (unsigned*)(P->ws + WS_ROUTE);
    LAS char* lds = (LAS char*)(LAS unsigned char*)lds_;
    __syncthreads();
    {
        const bf16* K1 = (const bf16*)(P->ws + WS_PK1) + (size_t)L * 128 * 128; const bf16* K2 = (const bf16*)(P->ws + WS_PK2) + (size_t)L * 128 * 128;
        u32x4 kw[8];
#pragma unroll
        for (int t = 0; t < 8; ++t) { const int c16 = tid + t * NWAVES * 64; const int mat = c16 >> 11, row = (c16 >> 4) & 127, ch = c16 & 15; kw[t] = *(const u32x4*)((mat ? K2 : K1) + row * 128 + ch * 8); }
#pragma unroll
        for (int t = 0; t < 8; ++t) { const int c16 = tid + t * NWAVES * 64; const int mat = c16 >> 11, row = (c16 >> 4) & 127, ch = c16 & 15; *(LAS u32x4*)(lds + mat * 32768 + row * 256 + ((ch ^ (row & 15)) * 16)) = kw[t]; }
    }
    __syncthreads();
    LAS unsigned* sc = (LAS unsigned*)(lds + 65536) + wid * 2048;
    const int r32 = lane & 31, hi = lane >> 5;
    for (int item = gw; item < Mrows / 4; item += NGW) {
        const int tok = item * 4 + (r32 >> 3), head = r32 & 7;
        unsigned top0[16], top1[16];
        { bf16x8 q0[8], q1[8]; route_qload<0>(QP, tok, head, hi, q0); route_qload<1>(QP, tok, head, hi, q1);
          route_pass<0>(q0, lds, tok, head, r32, hi, top0);
          route_pass<1>(q1, lds, tok, head, r32, hi, top1); }
        float v1[16], v2[16];
#pragma unroll
        for (int i = 0; i < 16; ++i) { v1[i] = ord2f(top0[i] & ~127u); v2[i] = ord2f(top1[i] & ~127u);
            sc[i * 64 + lane] = 127u - (top0[i] & 127u); sc[(16 + i) * 64 + lane] = 127u - (top1[i] & 127u); }
        unsigned ck[64]; int n = 0;
#pragma unroll
        for (int i = 0; i < 16; ++i)
#pragma unroll
            for (int j = 0; j < 16; ++j) if ((i + 1) * (j + 1) <= 16) { ck[n] = (f2ord(v1[i] + v2[j]) & ~255u) | (unsigned)(i * 16 + j); ++n; }
#pragma unroll
        for (int i = 50; i < 64; ++i) ck[i] = 0u;
        top16_of_64(ck);
        float ev[16]; float sum = 0.f; const float mx = ord2f(ck[0] & ~255u);
#pragma unroll
        for (int k = 0; k < 16; ++k) { ev[k] = __expf(ord2f(ck[k] & ~255u) - mx); sum += ev[k]; }
        const float inv = 1.0f / sum;
        unsigned ee[16];
#pragma unroll
        for (int k = 0; k < 16; ++k) { const unsigned pc = ck[k] & 255u; const unsigned i1 = sc[(pc >> 4) * 64 + lane], i2 = sc[(16 + (pc & 15u)) * 64 + lane]; ee[k] = i1 * 128u + i2; ev[k] *= inv; }
#if ROUTE_SORT
        { const int tq = r32 >> 3;
#pragma unroll
          for (int k = 0; k < 8; ++k) {
              const unsigned eL = ee[k], eH = ee[k + 8]; const float gL = ev[k], gH = ev[k + 8];
              sc[tq * 256 + head * 16 + hi * 8 + k] = hi ? eH : eL; sc[tq * 256 + 128 + head * 16 + hi * 8 + k] = __float_as_uint(hi ? gH : gL); }
#pragma unroll 1
          for (int t = 0; t < 4; ++t) {
              unsigned a0 = (sc[t * 256 + lane] << 7) | (unsigned)lane, a1 = (sc[t * 256 + 64 + lane] << 7) | (unsigned)(64 + lane);
              sort128_asc(a0, a1, lane);
              const unsigned g0 = sc[t * 256 + 128 + (a0 & 127u)], g1 = sc[t * 256 + 128 + (a1 & 127u)];
              u32x2* outp = (u32x2*)(ROUTE + (size_t)(item * 4 + t) * 256);
              outp[lane] = (u32x2){a0 >> 7, g0}; outp[64 + lane] = (u32x2){a1 >> 7, g1}; }
        }
#else
        u32x4* outp = (u32x4*)(ROUTE + ((size_t)tok * 128 + head * 16 + hi * 8) * 2);
#pragma unroll
        for (int k = 0; k < 8; k += 2) { u32x4 w;
            const unsigned eL0 = ee[k], eH0 = ee[k + 8], eL1 = ee[k + 1], eH1 = ee[k + 9]; const float gL0 = ev[k], gH0 = ev[k + 8], gL1 = ev[k + 1], gH1 = ev[k + 9];
            w.x = hi ? eH0 : eL0; w.y = __float_as_uint(hi ? gH0 : gL0); w.z = hi ? eH1 : eL1; w.w = __float_as_uint(hi ? gH1 : gL1);
            outp[k >> 1] = w; }
#endif
    }
}

typedef float f32x2 __attribute__((ext_vector_type(2)));
typedef float f32x32 __attribute__((ext_vector_type(32)));
typedef unsigned u32x6 __attribute__((ext_vector_type(6)));
typedef __bf16 bf16x32 __attribute__((ext_vector_type(32)));
typedef unsigned u32x16 __attribute__((ext_vector_type(16)));
typedef __bf16 bf16x2_t __attribute__((ext_vector_type(2)));
#ifndef GATHER_ZIGZAG
#define GATHER_ZIGZAG 0
#endif
#ifndef GATHER_PRE
#define GATHER_PRE 0
#endif
#ifndef GATHER_XEARLY
#define GATHER_XEARLY 0
#endif
#ifndef GATHER_SWP
#define GATHER_SWP 0
#endif
#ifndef GATHER_VECREG
#define GATHER_VECREG 1
#endif
#ifndef GATHER_MFMADOT
#define GATHER_MFMADOT 1
#endif
typedef short s16x4_t __attribute__((ext_vector_type(4)));
#ifndef GATHER_PAIRRED
#define GATHER_PAIRRED 1
#endif
#ifndef GATHER_EARLY
#define GATHER_EARLY 1
#endif
#ifndef GATHER_PACE
#define GATHER_PACE 0
#endif
#define XB_PACE(j) (XCD_BAR_WORDS + 64 * (j))
#ifndef GATHER_DEEP
#define GATHER_DEEP 0
#endif
constexpr int GS = GATHER_DEEP ? 8 : 6, GSLOT = GATHER_DEEP ? 2048 : 2 * PROW;
__device__ __forceinline__ void glds16(const void* gsrc, unsigned lds_dst) { unsigned keep;
  asm volatile("s_mov_b32 %0, m0\n\ts_mov_b32 m0, %2\n\ts_nop 0\n\tglobal_load_lds_dwordx4 %1, off\n\ts_mov_b32 m0, %0" : "=&s"(keep) : "v"(gsrc), "s"(lds_dst) : "memory"); }
template <int GMODE = 0>
__device__ __forceinline__ void gather_phase(CP P, int L, int Mrows, LAS unsigned char* lds, int wid, int lane_, int gw, int NGW, bool dry = false) {
    const unsigned char* UV = P->ws + WS_PU + (size_t)L * 16384 * PREC;
    const unsigned* ROUTE = (const unsigned*)(P->ws + WS_ROUTE); const float* MOD = (const float*)(P->ws + WS_MOD);
    bf16* X = (bf16*)(P->ws + WS_X); bf16* H = (bf16*)(P->ws + WS_H); bf16* Xo = dry ? (bf16*)(P->ws + WS_Y) : X; bf16* Ho = dry ? (bf16*)(P->ws + WS_G) : H;
    const float* lng = P->in[6] + (size_t)(L * 2 + 1) * DM; const float* lnb = P->in[7] + (size_t)(L * 2 + 1) * DM;
    const unsigned ring = (unsigned)(uintptr_t)lds + (unsigned)wid * (GS * GSLOT);
    const int nfull = (Mrows / NGW) * NGW, rem = Mrows - nfull; const bool can_coop = (rem * 4 == NGW);
    const int nround = nfull / NGW + (rem > 0 ? 1 : 0);
    const bool pace_ok = (rem == 0) || can_coop;
#define G_ROWOF(it_) ((can_coop && (it_) == nround - 1) ? (nfull + (int)blockIdx.x * 2 + (wid >> 2)) : (gw + (it_) * NGW))
    u32x2 nea = {0u, 0u}, neb = {0u, 0u}; u32x4 nh0 = {0u, 0u, 0u, 0u}, nh1 = nh0, nh2 = nh0, nh3 = nh0;
#define G_NTL(p_) (NT_STREAM > 1 ? __builtin_nontemporal_load(p_) : *(p_))
#define G_PREFETCH(rowN_, ln_) do { const int rn_ = (rowN_); nea = G_NTL(&((const u32x2*)(ROUTE + (size_t)rn_ * 256))[ln_]); neb = G_NTL(&((const u32x2*)(ROUTE + (size_t)rn_ * 256))[64 + (ln_)]); \
        const u32x4* hp_ = (const u32x4*)(H + (size_t)rn_ * DM) + 4 * (ln_); nh0 = G_NTL(hp_); nh1 = G_NTL(hp_ + 1); nh2 = G_NTL(hp_ + 2); nh3 = G_NTL(hp_ + 3); } while (0)
    if (nround > 0 && G_ROWOF(0) < Mrows) G_PREFETCH(G_ROWOF(0), launder_v(lane_));
#if GATHER_VECREG
    LAS unsigned* LNV = (LAS unsigned*)(lds + NWAVES * GS * GSLOT);
    { f32x2 t_[4];
#pragma unroll
      for (int t = 0; t < 4; ++t) { const int i = wid * 64 + lane_ + t * NWAVES * 64; t_[t] = *(const f32x2*)(((i >> 10) ? lnb : lng) + 2 * (i & 1023)); }
#pragma unroll
      for (int t = 0; t < 4; ++t) { const float x0_ = t_[t][0], x1_ = t_[t][1]; LNV[wid * 64 + lane_ + t * NWAVES * 64] = cvtpk(x0_, x1_); } }
    __syncthreads();
    unsigned mg[16], ms[16], mc[16]; int cur_slot = -1;
#pragma unroll
    for (int i = 0; i < 16; ++i) { mg[i] = 0u; ms[i] = 0u; mc[i] = 0u; }
#endif
    bool pre = false;
#pragma unroll 1
    for (int it = 0; it < nround; ++it) {
#if GATHER_PACE
        if (pace_ok && it > 0) {
            if (wid == 0 && lane_ == 0) { const unsigned nloc = ((volatile LAS unsigned*)(lds + MISC_OFF))[8];
                if (nloc != 0u) { unsigned* pc = (unsigned*)(P->ws + WS_CTL) + CW_BAR + XB_PACE(xb_xcc_id());
                    const unsigned old = xb_add(pc, 1u), tgt = (old / nloc + 1u) * nloc; unsigned sp = 0u;
                    while ((int)(xb_ld(pc) - tgt) < 0 && ++sp < 20000u) __builtin_amdgcn_s_sleep(1); } }
            __syncthreads();
        }
#endif
        const bool coop = can_coop && (it == nround - 1);
        int row = G_ROWOF(it), k0 = 0, kn = 128;
        if (coop) { k0 = (wid & 3) * 32; kn = k0 + 32; }
        else if (row >= Mrows) break;
        const int lane = launder_v(lane_);
        const u32x2 ea = nea, eb = neb;
        unsigned eax, eay, ebx, eby;
        unsigned hw[16] = {nh0.x, nh0.y, nh0.z, nh0.w, nh1.x, nh1.y, nh1.z, nh1.w, nh2.x, nh2.y, nh2.z, nh2.w, nh3.x, nh3.y, nh3.z, nh3.w};
        float y[32];
#pragma unroll
        for (int i = 0; i < 32; ++i) y[i] = 0.f;
        { unsigned e0 = ea.x, e1 = ea.y, e2 = eb.x, e3 = eb.y;
          asm volatile("" : "+v"(e0), "+v"(e1), "+v"(e2), "+v"(e3), "+v"(hw[0]), "+v"(hw[1]), "+v"(hw[2]), "+v"(hw[3]), "+v"(hw[4]), "+v"(hw[5]), "+v"(hw[6]), "+v"(hw[7]),
                       "+v"(hw[8]), "+v"(hw[9]), "+v"(hw[10]), "+v"(hw[11]), "+v"(hw[12]), "+v"(hw[13]), "+v"(hw[14]), "+v"(hw[15]) :: "memory");
          eax = e0; eay = e1; ebx = e2; eby = e3; }
        const unsigned rd_a = ring + 16u * (unsigned)lane, rd_b = ring + 2048u + 8u * (unsigned)lane;
        const bool rev = GATHER_ZIGZAG && ((it & 1) != 0);
        const int kflip = rev ? (k0 + kn - 1) : 0, ksign = rev ? -1 : 1;
#define G_ISSUE(k) do { const int k_ = (k), ke_ = kflip + ksign * k_; const unsigned e_ = (unsigned)__builtin_amdgcn_readlane((int)(ke_ < 64 ? eax : ebx), ke_ & 63); \
        const unsigned char* rp_ = UV + (size_t)e_ * PREC + 16 * lane; const unsigned sb_ = ring + (unsigned)(k_ % GS) * GSLOT; \
        if (GMODE == 3) { glds16(rp_, sb_); if (lane < 32) glds16(rp_ + 2048, sb_ + 2048); } \
        else if (GMODE != 2) { glds16(rp_, sb_); glds16(rp_ + 1024, sb_ + 1024); if (PEER_U4) {} else if (PEER_V4) { if (lane < 32) glds16(rp_ + 2048, sb_ + 2048); } else glds16(rp_ + 2048, sb_ + 2048); } else { asm volatile("" :: "v"(rp_), "s"(sb_)); } } while (0)
#if GATHER_EARLY
        if (it + 1 < nround && G_ROWOF(it + 1) < Mrows) G_PREFETCH(G_ROWOF(it + 1), lane);
        if (!pre) {
#pragma unroll
            for (int k = 0; k < GS; ++k) G_ISSUE(k0 + k); }
#else
#pragma unroll
        for (int k = 0; k < 4; ++k) G_ISSUE(k0 + k);
        if (it + 1 < nround && G_ROWOF(it + 1) < Mrows) G_PREFETCH(G_ROWOF(it + 1), lane);
#endif
#define G_READ(k, ua, ub, va, vb) do { const unsigned so_ = (unsigned)((k) % GS) * GSLOT; \
        if (PEER_U4) asm volatile("ds_read_b128 %0, %2\n\tds_read_b128 %1, %2 offset:1024" : "=&v"(ua), "=&v"(va) : "v"(rd_a + so_) : "memory"); \
        else if (PEER_V4) asm volatile("ds_read_b128 %0, %3\n\tds_read_b64 %1, %4\n\tds_read_b128 %2, %3 offset:1024" \
                     : "=&v"(ua), "=&v"(ub), "=&v"(va) : "v"(rd_a + so_), "v"(rd_b + so_) : "memory"); \
        else asm volatile("ds_read_b128 %0, %4\n\tds_read_b64 %1, %5\n\tds_read_b128 %2, %4 offset:1024\n\tds_read_b64 %3, %5 offset:512" \
                     : "=&v"(ua), "=&v"(ub), "=&v"(va), "=&v"(vb) : "v"(rd_a + so_), "v"(rd_b + so_) : "memory"); } while (0)
#if GATHER_XEARLY
        u32x4 xr0 = {0u, 0u, 0u, 0u}, xr1 = xr0, xr2 = xr0, xr3 = xr0;
#endif
#if GATHER_SWP
        static_assert(!GATHER_SWP || (PEER_U4 && PEER_V4 && GATHER_EARLY && GATHER_PAIRRED && GATHER_MFMADOT && !GATHER_DEEP && !GATHER_XEARLY && !GATHER_PRE), "GATHER_SWP: configuration");
#define SWP_FETCH(kk, uA, uB, vA, vB) do { const int kk_ = (kk); \
            if (kk_ + 4 < kn) asm volatile("s_waitcnt vmcnt(8)" ::: "memory"); else if (kk_ == kn - 4) asm volatile("s_waitcnt vmcnt(4)" ::: "memory"); else asm volatile("s_waitcnt vmcnt(0)" ::: "memory"); \
            u32x2 d0_ = {0u, 0u}, d1_ = {0u, 0u}; G_READ(kk_, uA, d0_, vA, d1_); G_READ(kk_ + 1, uB, d0_, vB, d1_); \
            asm volatile("s_waitcnt lgkmcnt(0)" : "+v"(uA), "+v"(vA), "+v"(uB), "+v"(vB) :: "memory"); \
            if (kk_ + GS < kn) { G_ISSUE(kk_ + GS); G_ISSUE(kk_ + GS + 1); } } while (0)
#define SWP_U4(dst_, src_, w_, b_) dst_[4 * (w_) + (b_)] = __builtin_bit_cast(unsigned, __builtin_amdgcn_cvt_scalef32_pk_bf16_fp4(src_[w_], 1.0f, b_))
#define SWP_UPART(kk, uA, uB, wA_, wB_) do { const int kk_ = (kk); u32x16 ubfA, ubfB; const unsigned uwA[4] = {uA.x, uA.y, uA.z, uA.w}, uwB[4] = {uB.x, uB.y, uB.z, uB.w}; \
            _Pragma("unroll") for (int w = 0; w < 4; ++w) { SWP_U4(ubfA, uwA, w, 0); SWP_U4(ubfA, uwA, w, 1); SWP_U4(ubfA, uwA, w, 2); SWP_U4(ubfA, uwA, w, 3); SWP_U4(ubfB, uwB, w, 0); SWP_U4(ubfB, uwB, w, 1); SWP_U4(ubfB, uwB, w, 2); SWP_U4(ubfB, uwB, w, 3); } \
            f32x4 dgA = {0.f, 0.f, 0.f, 0.f}, dgB = {0.f, 0.f, 0.f, 0.f}; \
            _Pragma("unroll") for (int q = 0; q < 16; q += 2) { const u32x2 hq_ = {hw[q], hw[q + 1]}, xa_ = {ubfA[q], ubfA[q + 1]}, xb_ = {ubfB[q], ubfB[q + 1]}; \
                dgA = __builtin_amdgcn_mfma_f32_4x4x4bf16_1k(__builtin_bit_cast(s16x4_t, xa_), __builtin_bit_cast(s16x4_t, hq_), dgA, 0, 0, 0); \
                dgB = __builtin_amdgcn_mfma_f32_4x4x4bf16_1k(__builtin_bit_cast(s16x4_t, xb_), __builtin_bit_cast(s16x4_t, hq_), dgB, 0, 0, 0); } \
            const float x0 = dgA[0], x1 = dgA[1], x2 = dgA[2], x3 = dgA[3], y0 = dgB[0], y1 = dgB[1], y2 = dgB[2], y3 = dgB[3]; \
            float a0 = DPP_F(x0, 0x00); a0 += DPP_F(x1, 0x55); a0 += DPP_F(x2, 0xAA); a0 += DPP_F(x3, 0xFF); \
            float b0 = DPP_F(y0, 0x00); b0 += DPP_F(y1, 0x55); b0 += DPP_F(y2, 0xAA); b0 += DPP_F(y3, 0xFF); \
            const auto sw = __builtin_amdgcn_permlane32_swap(__float_as_uint(a0), __float_as_uint(b0), false, false); \
            float c2 = __uint_as_float(sw[0]) + __uint_as_float(sw[1]); c2 += DPP_F(c2, 0x141); c2 += DPP_F(c2, 0x140); \
            const float d2 = sum_xor16(c2) * (1.0f / U_SCALE); const float g2 = gelu_tanh(d2) * (1.0f / V_SCALE); \
            const float gA = __uint_as_float((unsigned)__builtin_amdgcn_readlane((int)__float_as_uint(g2), 0)), gB = __uint_as_float((unsigned)__builtin_amdgcn_readlane((int)__float_as_uint(g2), 32)); \
            const int keA = kflip + ksign * kk_, keB = keA + ksign; const unsigned gsel = keA < 64 ? eay : eby; \
            wA_ = __uint_as_float((unsigned)__builtin_amdgcn_readlane((int)gsel, keA & 63)) * gA; wB_ = __uint_as_float((unsigned)__builtin_amdgcn_readlane((int)gsel, keB & 63)) * gB; } while (0)
#define SWP_V4(vwA, vwB, w_, b_, wA_, wB_) do { const f32x2 pA = __builtin_amdgcn_cvt_scalef32_pk_f32_fp4(vwA[w_], 1.0f, b_), pB = __builtin_amdgcn_cvt_scalef32_pk_f32_fp4(vwB[w_], 1.0f, b_); const int j = 4 * (w_) + (b_); \
            const float pa0 = pA[0], pa1 = pA[1], pb0 = pB[0], pb1 = pB[1]; y[2 * j] += wA_ * pa0; y[2 * j + 1] += wA_ * pa1; y[2 * j] += wB_ * pb0; y[2 * j + 1] += wB_ * pb1; } while (0)
#define SWP_VPART(vA, vB, wA_, wB_) do { const unsigned vwA[4] = {vA.x, vA.y, vA.z, vA.w}, vwB[4] = {vB.x, vB.y, vB.z, vB.w}; \
            _Pragma("unroll") for (int w = 0; w < 4; ++w) { SWP_V4(vwA, vwB, w, 0, wA_, wB_); SWP_V4(vwA, vwB, w, 1, wA_, wB_); SWP_V4(vwA, vwB, w, 2, wA_, wB_); SWP_V4(vwA, vwB, w, 3, wA_, wB_); } } while (0)
#define SWP_VCH(w_, qA_, qB_) do { SWP_V4(vwA, vwB, w_, 0, qA_, qB_); SWP_V4(vwA, vwB, w_, 1, qA_, qB_); SWP_V4(vwA, vwB, w_, 2, qA_, qB_); SWP_V4(vwA, vwB, w_, 3, qA_, qB_); } while (0)
#define SWP_MIX(kk, uA, uB, wA_, wB_, pvA, pvB, pwA_, pwB_) do { const int kk_ = (kk); u32x16 ubfA, ubfB; const unsigned uwA[4] = {uA.x, uA.y, uA.z, uA.w}, uwB[4] = {uB.x, uB.y, uB.z, uB.w}; \
            const unsigned vwA[4] = {pvA.x, pvA.y, pvA.z, pvA.w}, vwB[4] = {pvB.x, pvB.y, pvB.z, pvB.w}; \
            _Pragma("unroll") for (int w = 0; w < 4; ++w) { SWP_U4(ubfA, uwA, w, 0); SWP_U4(ubfA, uwA, w, 1); SWP_U4(ubfA, uwA, w, 2); SWP_U4(ubfA, uwA, w, 3); SWP_U4(ubfB, uwB, w, 0); SWP_U4(ubfB, uwB, w, 1); SWP_U4(ubfB, uwB, w, 2); SWP_U4(ubfB, uwB, w, 3); } \
            f32x4 dgA = {0.f, 0.f, 0.f, 0.f}, dgB = {0.f, 0.f, 0.f, 0.f}; \
            _Pragma("unroll") for (int q = 0; q < 16; q += 2) { const u32x2 hq_ = {hw[q], hw[q + 1]}, xa_ = {ubfA[q], ubfA[q + 1]}, xb_ = {ubfB[q], ubfB[q + 1]}; \
                dgA = __builtin_amdgcn_mfma_f32_4x4x4bf16_1k(__builtin_bit_cast(s16x4_t, xa_), __builtin_bit_cast(s16x4_t, hq_), dgA, 0, 0, 0); \
                dgB = __builtin_amdgcn_mfma_f32_4x4x4bf16_1k(__builtin_bit_cast(s16x4_t, xb_), __builtin_bit_cast(s16x4_t, hq_), dgB, 0, 0, 0); } \
            SWP_VCH(0, pwA_, pwB_); \
            const float x0 = dgA[0], x1 = dgA[1], x2 = dgA[2], x3 = dgA[3], y0 = dgB[0], y1 = dgB[1], y2 = dgB[2], y3 = dgB[3]; \
            float a0 = DPP_F(x0, 0x00); a0 += DPP_F(x1, 0x55); a0 += DPP_F(x2, 0xAA); a0 += DPP_F(x3, 0xFF); \
            float b0 = DPP_F(y0, 0x00); b0 += DPP_F(y1, 0x55); b0 += DPP_F(y2, 0xAA); b0 += DPP_F(y3, 0xFF); \
            SWP_VCH(1, pwA_, pwB_); \
            const auto sw = __builtin_amdgcn_permlane32_swap(__float_as_uint(a0), __float_as_uint(b0), false, false); \
            float c2 = __uint_as_float(sw[0]) + __uint_as_float(sw[1]); c2 += DPP_F(c2, 0x141); c2 += DPP_F(c2, 0x140); \
            float d2 = sum_xor16(c2) * (1.0f / U_SCALE); \
            SWP_VCH(2, pwA_, pwB_); \
            float g2 = gelu_tanh(d2) * (1.0f / V_SCALE); \
            SWP_VCH(3, pwA_, pwB_); \
            const float gA = __uint_as_float((unsigned)__builtin_amdgcn_readlane((int)__float_as_uint(g2), 0)), gB = __uint_as_float((unsigned)__builtin_amdgcn_readlane((int)__float_as_uint(g2), 32)); \
            const int keA = kflip + ksign * kk_, keB = keA + ksign; const unsigned gsel = keA < 64 ? eay : eby; \
            wA_ = __uint_as_float((unsigned)__builtin_amdgcn_readlane((int)gsel, keA & 63)) * gA; wB_ = __uint_as_float((unsigned)__builtin_amdgcn_readlane((int)gsel, keB & 63)) * gB; } while (0)
        if (GMODE == 0) {
            u32x4 cuA, cuB, cvA, cvB; float cwA, cwB;
            SWP_FETCH(k0, cuA, cuB, cvA, cvB); SWP_UPART(k0, cuA, cuB, cwA, cwB);
#pragma unroll 1
            for (int k = k0; k + 2 < kn; k += 2) {
                u32x4 nuA, nuB, nvA, nvB; float nwA, nwB;
                SWP_FETCH(k + 2, nuA, nuB, nvA, nvB);
                SWP_MIX(k + 2, nuA, nuB, nwA, nwB, cvA, cvB, cwA, cwB);
                cvA = nvA; cvB = nvB; cwA = nwA; cwB = nwB;
            }
            SWP_VPART(cvA, cvB, cwA, cwB);
        } else
#undef SWP_MIX
#undef SWP_VCH
#undef SWP_FETCH
#undef SWP_U4
#undef SWP_UPART
#undef SWP_V4
#undef SWP_VPART
#endif
#pragma unroll 1
        for (int k = k0; k < kn; k += 2) {
            if (GATHER_DEEP && k + 6 < kn) asm volatile("s_waitcnt vmcnt(12)" ::: "memory");
            else if (GATHER_DEEP && k == kn - 6) asm volatile("s_waitcnt vmcnt(8)" ::: "memory");
            else if (k + 4 < kn) { if (!GATHER_EARLY) { G_ISSUE(k + 4); G_ISSUE(k + 5); } if (GMODE == 3 || PEER_U4) asm volatile("s_waitcnt vmcnt(8)" ::: "memory"); else asm volatile("s_waitcnt vmcnt(12)" ::: "memory"); }
            else if (k == kn - 4) { if (GMODE == 3 || PEER_U4) asm volatile("s_waitcnt vmcnt(4)" ::: "memory"); else asm volatile("s_waitcnt vmcnt(6)" ::: "memory"); }
            else asm volatile("s_waitcnt vmcnt(0)" ::: "memory");
            u32x4 uaA, vaA, uaB, vaB; u32x2 ubA = {0u, 0u}, vbA = {0u, 0u}, ubB = {0u, 0u}, vbB = {0u, 0u};
            G_READ(k, uaA, ubA, vaA, vbA); G_READ(k + 1, uaB, ubB, vaB, vbB);
            asm volatile("s_waitcnt lgkmcnt(0)" : "+v"(uaA), "+v"(ubA), "+v"(vaA), "+v"(vbA), "+v"(uaB), "+v"(ubB), "+v"(vaB), "+v"(vbB) :: "memory");
#if GATHER_XEARLY
            if (k == kn - 4) { const u32x4* xp_ = (const u32x4*)(X + (size_t)row * DM) + 4 * lane; xr0 = xp_[0]; xr1 = xp_[1]; xr2 = xp_[2]; xr3 = xp_[3]; }
#endif
            if (GATHER_EARLY && k + GS < kn) { G_ISSUE(k + GS); G_ISSUE(k + GS + 1); }
            if (GMODE == 1 || GMODE == 3) continue;
#if PEER_U4
            u32x16 ubfA, ubfB;
            { const unsigned uwA[4] = {uaA.x, uaA.y, uaA.z, uaA.w}, uwB[4] = {uaB.x, uaB.y, uaB.z, uaB.w};
#pragma unroll
              for (int w = 0; w < 4; ++w) {
#define U4_CVT(b_) do { ubfA[4 * w + (b_)] = __builtin_bit_cast(unsigned, __builtin_amdgcn_cvt_scalef32_pk_bf16_fp4(uwA[w], 1.0f, b_)); ubfB[4 * w + (b_)] = __builtin_bit_cast(unsigned, __builtin_amdgcn_cvt_scalef32_pk_bf16_fp4(uwB[w], 1.0f, b_)); } while (0)
                  U4_CVT(0); U4_CVT(1); U4_CVT(2); U4_CVT(3);
#undef U4_CVT
              } }
#else
            const u32x6 u6A = {uaA.x, uaA.y, uaA.z, uaA.w, ubA.x, ubA.y}, u6B = {uaB.x, uaB.y, uaB.z, uaB.w, ubB.x, ubB.y};
            const u32x16 ubfA = __builtin_bit_cast(u32x16, __builtin_amdgcn_cvt_scalef32_pk32_bf16_fp6(u6A, 1.0f));
            const u32x16 ubfB = __builtin_bit_cast(u32x16, __builtin_amdgcn_cvt_scalef32_pk32_bf16_fp6(u6B, 1.0f));
#endif
#if GATHER_MFMADOT
            f32x4 dgA = {0.f, 0.f, 0.f, 0.f}, dgB = {0.f, 0.f, 0.f, 0.f};
#pragma unroll
            for (int q = 0; q < 16; q += 2) { const u32x2 hq_ = {hw[q], hw[q + 1]}, xa_ = {ubfA[q], ubfA[q + 1]}, xb_ = {ubfB[q], ubfB[q + 1]};
                dgA = __builtin_amdgcn_mfma_f32_4x4x4bf16_1k(__builtin_bit_cast(s16x4_t, xa_), __builtin_bit_cast(s16x4_t, hq_), dgA, 0, 0, 0);
                dgB = __builtin_amdgcn_mfma_f32_4x4x4bf16_1k(__builtin_bit_cast(s16x4_t, xb_), __builtin_bit_cast(s16x4_t, hq_), dgB, 0, 0, 0); }
            float a0, a1 = 0.f, b0, b1 = 0.f;
            { const float x0 = dgA[0], x1 = dgA[1], x2 = dgA[2], x3 = dgA[3], y0 = dgB[0], y1 = dgB[1], y2 = dgB[2], y3 = dgB[3];
              a0 = DPP_F(x0, 0x00); a0 += DPP_F(x1, 0x55); a0 += DPP_F(x2, 0xAA); a0 += DPP_F(x3, 0xFF);
              b0 = DPP_F(y0, 0x00); b0 += DPP_F(y1, 0x55); b0 += DPP_F(y2, 0xAA); b0 += DPP_F(y3, 0xFF); }
#else
            float a0 = 0.f, a1 = 0.f, b0 = 0.f, b1 = 0.f;
#pragma unroll
            for (int q = 0; q < 16; q += 2) { const unsigned h0_ = hw[q], h1_ = hw[q + 1], x0_ = ubfA[q], x1_ = ubfA[q + 1], z0_ = ubfB[q], z1_ = ubfB[q + 1];
                a0 = __builtin_amdgcn_fdot2_f32_bf16(__builtin_bit_cast(bf16x2_t, h0_), __builtin_bit_cast(bf16x2_t, x0_), a0, false);
                a1 = __builtin_amdgcn_fdot2_f32_bf16(__builtin_bit_cast(bf16x2_t, h1_), __builtin_bit_cast(bf16x2_t, x1_), a1, false);
                b0 = __builtin_amdgcn_fdot2_f32_bf16(__builtin_bit_cast(bf16x2_t, h0_), __builtin_bit_cast(bf16x2_t, z0_), b0, false);
                b1 = __builtin_amdgcn_fdot2_f32_bf16(__builtin_bit_cast(bf16x2_t, h1_), __builtin_bit_cast(bf16x2_t, z1_), b1, false); }
#endif
            const int keA = kflip + ksign * k, keB = keA + ksign;
            const unsigned gsel = keA < 64 ? eay : eby;
#if GATHER_PAIRRED
            float wA, wB;
            { const auto sw = __builtin_amdgcn_permlane32_swap(__float_as_uint(GATHER_MFMADOT ? a0 : a0 + a1), __float_as_uint(GATHER_MFMADOT ? b0 : b0 + b1), false, false);
#if GATHER_MFMADOT
              float c2 = __uint_as_float(sw[0]) + __uint_as_float(sw[1]); c2 += DPP_F(c2, 0x141); c2 += DPP_F(c2, 0x140);
              const float d2 = sum_xor16(c2) * (1.0f / U_SCALE);
#else
              const float d2 = half_sum32(__uint_as_float(sw[0]) + __uint_as_float(sw[1])) * (1.0f / U_SCALE);
#endif
              const float g2 = gelu_tanh(d2) * (1.0f / V_SCALE);
              const float gA = __uint_as_float((unsigned)__builtin_amdgcn_readlane((int)__float_as_uint(g2), 0)), gB = __uint_as_float((unsigned)__builtin_amdgcn_readlane((int)__float_as_uint(g2), 32));
              wA = __uint_as_float((unsigned)__builtin_amdgcn_readlane((int)gsel, keA & 63)) * gA; wB = __uint_as_float((unsigned)__builtin_amdgcn_readlane((int)gsel, keB & 63)) * gB; }
#else
            const float dA = wave_sum(a0 + a1) * (1.0f / U_SCALE), dB = wave_sum(b0 + b1) * (1.0f / U_SCALE);
            const float wA = __uint_as_float((unsigned)__builtin_amdgcn_readlane((int)gsel, keA & 63)) * gelu_tanh(dA) * (1.0f / V_SCALE);
            const float wB = __uint_as_float((unsigned)__builtin_amdgcn_readlane((int)gsel, keB & 63)) * gelu_tanh(dB) * (1.0f / V_SCALE);
#endif
#if PEER_V4
            { const unsigned vwA[4] = {vaA.x, vaA.y, vaA.z, vaA.w}, vwB[4] = {vaB.x, vaB.y, vaB.z, vaB.w};
#pragma unroll
              for (int w = 0; w < 4; ++w) {
#define V4_ACC(b_) do { const f32x2 pA = __builtin_amdgcn_cvt_scalef32_pk_f32_fp4(vwA[w], 1.0f, b_), pB = __builtin_amdgcn_cvt_scalef32_pk_f32_fp4(vwB[w], 1.0f, b_); const int j = 4 * w + (b_); \
                    const float pa0 = pA[0], pa1 = pA[1], pb0 = pB[0], pb1 = pB[1]; y[2 * j] += wA * pa0; y[2 * j + 1] += wA * pa1; y[2 * j] += wB * pb0; y[2 * j + 1] += wB * pb1; } while (0)
                  V4_ACC(0); V4_ACC(1); V4_ACC(2); V4_ACC(3);
#undef V4_ACC
              } }
#else
            const u32x6 v6A = {vaA.x, vaA.y, vaA.z, vaA.w, vbA.x, vbA.y};
            const f32x32 vfA = __builtin_amdgcn_cvt_scalef32_pk32_f32_fp6(v6A, 1.0f);
#pragma unroll
            for (int i = 0; i < 32; ++i) y[i] += wA * vfA[i];
            const u32x6 v6B = {vaB.x, vaB.y, vaB.z, vaB.w, vbB.x, vbB.y};
            const f32x32 vfB = __builtin_amdgcn_cvt_scalef32_pk32_f32_fp6(v6B, 1.0f);
#pragma unroll
            for (int i = 0; i < 32; ++i) y[i] += wB * vfB[i];
#endif
        }
#if GATHER_PRE
        pre = (it + 1 < nround) && (G_ROWOF(it + 1) < Mrows);
        if (pre) { unsigned n0 = nea.x, n2 = neb.x; asm volatile("" : "+v"(n0), "+v"(n2) :: "memory"); eax = n0; ebx = n2;
            const int k0n = (can_coop && (it + 1 == nround - 1)) ? (wid & 3) * 32 : 0;
#pragma unroll
            for (int k = 0; k < 6; ++k) G_ISSUE(k0n + k); }
#endif
#undef G_READ
#undef G_ISSUE
        if (coop) {
            LAS f32x4* mine = (LAS f32x4*)(lds + wid * (GS * GSLOT)) + lane * 8;
#pragma unroll
            for (int i = 0; i < 8; ++i) mine[i] = (f32x4){y[4 * i], y[4 * i + 1], y[4 * i + 2], y[4 * i + 3]};
            __syncthreads();
            if ((wid & 3) == 0) {
#pragma unroll
                for (int j = 1; j < 4; ++j) { const LAS f32x4* oth = (const LAS f32x4*)(lds + (wid + j) * (GS * GSLOT)) + lane * 8;
#pragma unroll
                    for (int i = 0; i < 8; ++i) { const f32x4 t = oth[i]; y[4 * i] += t.x; y[4 * i + 1] += t.y; y[4 * i + 2] += t.z; y[4 * i + 3] += t.w; } }
            }
            __syncthreads();
            if ((wid & 3) != 0) continue;
        }
        const int slot = row_slot(row);
        const float* mod = MOD + (size_t)(L * 3 + slot) * 12288;
        const int le = launder_v(lane);
#if GATHER_VECREG
        if (slot != cur_slot) { cur_slot = slot; float t_[32];
            load_row_f32_b(mod + 5 * 2048, le, t_);
#pragma unroll
            for (int i = 0; i < 16; ++i) mg[i] = cvtpk(t_[2 * i], t_[2 * i + 1]);
            if (L < NLAYER - 1) { const float* modn = MOD + (size_t)((L + 1) * 3 + slot) * 12288;
                load_row_f32_b(modn, le, t_);
#pragma unroll
                for (int i = 0; i < 16; ++i) ms[i] = cvtpk(t_[2 * i], t_[2 * i + 1]);
                load_row_f32_b(modn + 2048, le, t_);
#pragma unroll
                for (int i = 0; i < 16; ++i) mc[i] = cvtpk(t_[2 * i], t_[2 * i + 1]); } }
        { float xx[32];
#if GATHER_XEARLY
          { const unsigned xw_[16] = {xr0.x, xr0.y, xr0.z, xr0.w, xr1.x, xr1.y, xr1.z, xr1.w, xr2.x, xr2.y, xr2.z, xr2.w, xr3.x, xr3.y, xr3.z, xr3.w};
#pragma unroll
            for (int i = 0; i < 16; ++i) { xx[2 * i] = bflo(xw_[i]); xx[2 * i + 1] = bfhi(xw_[i]); } }
#else
          { const u32x4* xp_ = (const u32x4*)(X + (size_t)row * DM) + 4 * le;
#pragma unroll
            for (int j = 0; j < 4; ++j) { const u32x4 w = G_NTL(xp_ + j); xx[8 * j + 0] = bflo(w.x); xx[8 * j + 1] = bfhi(w.x); xx[8 * j + 2] = bflo(w.y); xx[8 * j + 3] = bfhi(w.y);
                xx[8 * j + 4] = bflo(w.z); xx[8 * j + 5] = bfhi(w.z); xx[8 * j + 6] = bflo(w.w); xx[8 * j + 7] = bfhi(w.w); } }
#endif
#pragma unroll
          for (int i = 0; i < 16; ++i) { y[2 * i] = ALPHA * xx[2 * i] + bflo(mg[i]) * y[2 * i]; y[2 * i + 1] = ALPHA * xx[2 * i + 1] + bfhi(mg[i]) * y[2 * i + 1]; } }
        { float mean, rstd; ln_stats(y, mean, rstd);
          const LAS u32x4* gp = (const LAS u32x4*)(LNV + le * 16); const LAS u32x4* bp = (const LAS u32x4*)(LNV + 1024 + le * 16);
#pragma unroll
          for (int q = 0; q < 4; ++q) { const u32x4 g4 = gp[q], b4 = bp[q]; const unsigned gw_[4] = {g4.x, g4.y, g4.z, g4.w}, bw_[4] = {b4.x, b4.y, b4.z, b4.w};
#pragma unroll
              for (int j = 0; j < 4; ++j) { const int i = 8 * q + 2 * j; y[i] = (y[i] - mean) * rstd * bflo(gw_[j]) + bflo(bw_[j]); y[i + 1] = (y[i + 1] - mean) * rstd * bfhi(gw_[j]) + bfhi(bw_[j]); } }
          if (L < NLAYER - 1) { store_row_bf16_b(Xo + (size_t)row * DM, le, y);
              ln_stats(y, mean, rstd); float a_[32];
#pragma unroll
              for (int i = 0; i < 16; ++i) { a_[2 * i] = (y[2 * i] - mean) * rstd * (1.0f + bflo(mc[i])) + bflo(ms[i]); a_[2 * i + 1] = (y[2 * i + 1] - mean) * rstd * (1.0f + bfhi(mc[i])) + bfhi(ms[i]); }
              store_row_bf16_b(Ho + (size_t)row * DM, le, a_); }
          else { if (NT_STREAM > 1) store_row_f32_b_nt(P->out + (size_t)row * DM, le, y); else store_row_f32_b(P->out + (size_t)row * DM, le, y); } }
        asm volatile("s_waitcnt vmcnt(0)" ::: "memory");
        continue;
#endif
        { float xx[32], gg[32]; load_row_bf16_b(X + (size_t)row * DM, le, xx); load_row_f32_b(mod + 5 * 2048, le, gg);
#pragma unroll
          for (int i = 0; i < 32; ++i) y[i] = ALPHA * xx[i] + gg[i] * y[i]; }
        if (L < NLAYER - 1) { const float* modn = MOD + (size_t)((L + 1) * 3 + slot) * 12288;
            finish_row<true>(y, lng, lnb, Xo + (size_t)row * DM, modn, modn + 2048, Ho + (size_t)row * DM, nullptr, le); }
        else finish_row<true>(y, lng, lnb, nullptr, nullptr, nullptr, nullptr, P->out + (size_t)row * DM, le);
        asm volatile("s_waitcnt vmcnt(0)" ::: "memory");
    }
#undef G_PREFETCH
#undef G_ROWOF
}

#ifndef ROPE_TEST
#define ROPE_TEST 0
#endif
#ifndef TAIL_L3MOVE
#define TAIL_L3MOVE 1
#endif
#ifndef PROBE_DUP
#define PROBE_DUP 0
#endif
#define NOINL __forceinline__
__device__ __forceinline__ CP launder_cp(CP p) { asm volatile("" : "+s"(p)); return p; }
#define GETP() launder_cp((CP)__builtin_amdgcn_kernarg_segment_ptr())
__device__ __forceinline__ int uni(int v) { return __builtin_amdgcn_readfirstlane(v); }
__device__ __forceinline__ LAS unsigned char* uni_lds(LAS unsigned char* p) { return (LAS unsigned char*)(unsigned)__builtin_amdgcn_readfirstlane((int)(unsigned)(uintptr_t)p); }
#define PH_IDS const int wid = uni(wv_), lane = launder_v(lane_id_fresh()) & 63, tid = (wid & 7) * 64 + lane; const int gw = blockIdx.x * NWAVES + wid, NGW = gridDim.x * NWAVES; (void)lane; (void)gw; (void)NGW; (void)tid;

__device__ NOINL void ph_prologue(int wv_, LAS unsigned char* lds_) { CP P = GETP(); LAS unsigned char* lds = uni_lds(lds_); PH_IDS p0_prologue(P, lds, tid, lane, wid, gw, NGW); if (PROBE_DUP == 5) p0_prologue(P, lds, tid, lane, wid, gw, NGW);
    if (PROBE_DUP >= 21 && PROBE_DUP <= 23) { __syncthreads(); p0_prologue(P, lds, tid, lane, wid, gw, NGW, 1 << (PROBE_DUP - 21 < 0 ? 0 : (PROBE_DUP - 21) & 3)); } }
__device__ NOINL void ph_modreduce(int wv_) { CP P = GETP(); PH_IDS mod_reduce(P, gw, lane, NGW); }
__device__ NOINL void ph_first(int wv_, LAS unsigned char* lds_) { CP P = GETP(); LAS unsigned char* lds = uni_lds(lds_); PH_IDS
#pragma unroll 1
    for (int rep = 0; rep < (PROBE_DUP == 6 ? 2 : 1); ++rep) first_row_pass(P, lds, tid, lane, gw, NGW); }
__device__ NOINL void ph_postmix(int wv_, LAS unsigned char* lds_, int L_, int M_) { CP P = GETP(); LAS unsigned char* lds = uni_lds(lds_); const int L = uni(L_), Mrows = uni(M_); PH_IDS
    if (POSTMIX_LDS) post_mixer_pass_lds(P, L, Mrows, lds, tid, lane, gw, NGW); else post_mixer_pass(P, L, Mrows, lane, gw, NGW); }
__device__ NOINL void ph_vstats(int wv_, int M_) { CP P = GETP(); const int Mrows = uni(M_); PH_IDS
#pragma unroll 1
    for (int rep = 0; rep < (PROBE_DUP == 6 ? 2 : 1); ++rep) vstats_pass(P, Mrows, lane, gw, NGW); }
__device__ NOINL void ph_spatial(int wv_, LAS unsigned char* lds_, int j_, int M_) { CP P = GETP(); LAS unsigned char* lds = uni_lds(lds_); const int j = uni(j_), Mrows = uni(M_); PH_IDS
#pragma unroll 1
    for (int rep = 0; rep < ((PROBE_DUP == 6 || PROBE_DUP == 19) ? 2 : 1); ++rep) spatial_phase(P, j, Mrows, lds, tid, lane, wid); }
__device__ NOINL void ph_mla_norm(int wv_) { CP P = GETP(); PH_IDS
#pragma unroll 1
    for (int rep = 0; rep < (PROBE_DUP == 6 ? 2 : 1); ++rep) mla_norm_pass(P, lane, gw, NGW); }
__device__ NOINL void ph_rope(int wv_, int which_) { CP P = GETP(); const int which = uni(which_); PH_IDS
    if (which == 0) rope_pass((bf16*)(P->ws + WS_QM), 3072, 128, 16, 192, lane, gw, NGW);
    else rope_pass((bf16*)(P->ws + WS_Z), 6144, 0, 64, 64, lane, gw, NGW); }
__device__ NOINL void ph_attn_mla(int wv_, LAS unsigned char* lds_) { CP P = GETP(); LAS unsigned char* lds = uni_lds(lds_); PH_IDS mla_attn_phase(P, lds, tid); if (PROBE_DUP == 2 || PROBE_DUP == 9) mla_attn_phase(P, lds, tid); }
__device__ NOINL void ph_attn_da(int wv_, LAS unsigned char* lds_, int L_, bool ctx_q) { CP P = GETP(); LAS unsigned char* lds = uni_lds(lds_); const int L = uni(L_); PH_IDS
    const float* lp = P->in[26];
    const float s01 = wave_sum(lp[lane] * lp[64 + lane]), s23 = wave_sum(lp[128 + lane] * lp[192 + lane]);
    const float lam_init = 0.8f - 0.6f * expf(-0.3f * (float)L);
    const float lam = expf(s01) - expf(s23) + lam_init;
    if (PROBE_DUP == 24) { da_attn_phase(P, lam, 1.0f - lam_init, lds, tid, ctx_q, 4); __syncthreads(); }
    if (PROBE_DUP == 25) { da_attn_phase(P, lam, 1.0f - lam_init, lds, tid, ctx_q, 2); __syncthreads(); }
    if (PROBE_DUP == 26) { da_attn_phase(P, lam, 1.0f - lam_init, lds, tid, ctx_q, 12); __syncthreads(); }
    if (!(PROBE_DUP >= 11 && PROBE_DUP <= 15)) da_attn_phase(P, lam, 1.0f - lam_init, lds, tid, ctx_q);
    if (PROBE_DUP == 2 || PROBE_DUP == 10) da_attn_phase(P, lam, 1.0f - lam_init, lds, tid, ctx_q);
    if (PROBE_DUP >= 11 && PROBE_DUP <= 15) { da_attn_phase<PROBE_DUP >= 11 && PROBE_DUP <= 15 ? PROBE_DUP - 10 : 0>(P, lam, 1.0f - lam_init, lds, tid, ctx_q); __syncthreads(); }
    if (PROBE_DUP >= 11 && PROBE_DUP <= 15) da_attn_phase(P, lam, 1.0f - lam_init, lds, tid, ctx_q); }
__device__ NOINL void ph_route(int wv_, LAS unsigned char* lds_, int L_, int M_) { CP P = GETP(); LAS unsigned char* lds = uni_lds(lds_); const int L = uni(L_), Mrows = uni(M_); PH_IDS
#pragma unroll 1
    for (int rep = 0; rep < (PROBE_DUP == 4 ? 2 : 1); ++rep) route_phase(P, L, Mrows, lds, tid, lane, wid, gw, NGW); }
__device__ NOINL void ph_gather(int wv_, LAS unsigned char* lds_, int L_, int M_) { CP P = GETP(); LAS unsigned char* lds = uni_lds(lds_); const int L = uni(L_), Mrows = uni(M_); PH_IDS
    if (PROBE_DUP == 3) { gather_phase<0>(P, L, Mrows, lds, wid, lane, gw, NGW, true); }
    if (PROBE_DUP == 7) { gather_phase<1>(P, L, Mrows, lds, wid, lane, gw, NGW, true); }
    if (PROBE_DUP == 17) { gather_phase<3>(P, L, Mrows, lds, wid, lane, gw, NGW, true); }
    if (PROBE_DUP == 8) { gather_phase<2>(P, L, Mrows, lds, wid, lane, gw, NGW, true); }
    gather_phase<0>(P, L, Mrows, lds, wid, lane, gw, NGW); }

enum GemmId { G_GM_IN = 0, G_GM_OUT, G_MLA_IN, G_MLA_UQ, G_MLA_UKV, G_MLA_OUT, G_DA_IN, G_DA_OUT, G_PEER_Q };
__device__ NOINL void ph_gemm(int wv_, LAS unsigned char* lds_, int id_, int L_, int M_) {
    CP P = GETP(); LAS unsigned char* lds = uni_lds(lds_); const int id = uni(id_), L = uni(L_), Mrows = uni(M_); PH_IDS
    unsigned char* ws = P->ws; const int jj = L / 3;
    size_t a = WS_H, b = 0, o = 0; int M = MT, N = 2048, K = 2048, act = 0, rope = 0;
    switch (id) {
        case G_GM_IN:   a = WS_H;    b = WS_GMWIN + (size_t)jj * 4096 * 2048 * 2;  o = WS_Z;  M = Mrows; N = 4096; K = 2048; act = 1; break;
        case G_GM_OUT:  a = WS_G;    b = WS_GMWOUT + (size_t)jj * 2048 * 2048 * 2; o = WS_Y;  M = Mrows; N = 2048; K = 2048; break;
        case G_MLA_IN:  a = WS_H;    b = WS_MLAIN;  o = WS_C;  N = 1280; K = 2048; break;
        case G_MLA_UQ:  a = WS_CQN;  b = WS_MLAUQ;  o = WS_QM; N = 3072; K = 512;  rope = (ROPE_TEST == 2) ? 0 : 2; break;
        case G_MLA_UKV: a = WS_CKVN; b = WS_MLAUKV; o = WS_KV; N = 4096; K = 512;  break;
        case G_MLA_OUT: a = WS_G;    b = WS_MLAOUT; o = WS_Y;  N = 2048; K = 2048; break;
        case G_DA_IN:   a = WS_H;    b = WS_DAIN;   o = WS_Z;  N = 6144; K = 2048; rope = (ROPE_TEST == 1) ? 0 : 1; break;
        case G_DA_OUT:  a = WS_G;    b = WS_DAOUT;  o = WS_Y;  M = Mrows; N = 2048; K = 2048; break;
        default:        a = WS_H;    b = WS_PWQ + (size_t)L * 2048 * 2048 * 2;     o = WS_QP; M = Mrows; N = 2048; K = 2048; break;
    }
    pg8::Gemm g{(const pg8::bf16_t*)(ws + a), (const pg8::bf16_t*)(ws + b), M, N, K}; pg8::StaticOrder S; S.init(M, N, (int)gridDim.x, id == G_MLA_UKV ? (int)gridDim.x - 1 - (int)blockIdx.x : (int)blockIdx.x);
    pg8::EpiR E{(pg8::bf16_t*)(ws + o), N, act, rope, (const float*)(ws + WS_ROPE)};
#pragma unroll 1
    for (int rep = 0; rep < ((PROBE_DUP == 1 || (PROBE_DUP == 31 && id == G_MLA_OUT) || (PROBE_DUP == 32 && id == G_DA_OUT)) ? 2 : 1); ++rep) { pg8::gemm_phase<pg8::EpiR, pg8::StaticOrder, true, true>((PG8_LAS unsigned char*)lds, g, S, E, tid); __syncthreads(); }
#if TAIL_REMAP
    int TL = -1; bool tail_u = false;
    if (L == 0) { if (id == G_GM_IN) { TL = 0; tail_u = true; } else if (id == G_GM_OUT) { TL = 0; } else if (id == G_PEER_Q) { TL = 1; tail_u = true; } }
    else if (L == 1) { if (id == G_MLA_IN) { TL = 1; } else if (id == G_MLA_OUT) { TL = 2; tail_u = true; } else if (id == G_PEER_Q) { TL = 2; } }
    else if (L == 2) { if (id == G_DA_IN) { TL = 3; tail_u = true; } else if (id == G_DA_OUT) { TL = 3; } }
    if (TL >= 0) {
        const int units = (M / 256) * (N / 256), G = (int)gridDim.x, tail = units % G, c = (int)blockIdx.x;
        const float* src = (tail_u ? P->in[11] : P->in[12]) + (size_t)TL * 16384 * 2048; unsigned char* dst = ws + WS_PU + (size_t)TL * 16384 * PREC;
#else
#if TAIL_L3MOVE
    const bool l3u = (id == G_MLA_IN && L == 1), l3v = (id == G_DA_IN && L == 2), skip = (L == NLAYER - 2) && (id == G_DA_OUT || id == G_PEER_Q);
    const bool l0v = P0_NOV && (id == G_GM_IN && L == 0);
    const bool tail_u = !skip && ((id == G_GM_OUT || id == G_MLA_OUT || id == G_DA_OUT) || l3u), tail_v = !skip && ((id == G_PEER_Q) || l3v || l0v);
    const int TLx = (l3u || l3v) ? NLAYER - 1 : (l0v ? 0 : L + 1);
    if ((tail_u || tail_v) && TLx < NLAYER) {
        const int units = (M / 256) * (N / 256), G = (int)gridDim.x, tail = units % G, c = (int)blockIdx.x;
        const float* src = (tail_u ? P->in[11] : P->in[12]) + (size_t)TLx * 16384 * 2048; unsigned char* dst = ws + WS_PU + (size_t)TLx * 16384 * PREC;
#else
    const bool tail_u = (id == G_GM_OUT || id == G_MLA_OUT || id == G_DA_OUT), tail_v = (id == G_PEER_Q);
    if ((tail_u || tail_v) && L + 1 < NLAYER) {
        const int units = (M / 256) * (N / 256), G = (int)gridDim.x, tail = units % G, c = (int)blockIdx.x;
        const float* src = (tail_u ? P->in[11] : P->in[12]) + (size_t)(L + 1) * 16384 * 2048; unsigned char* dst = ws + WS_PU + (size_t)(L + 1) * 16384 * PREC;
#endif
#endif
        LAS float* scr = (LAS float*)(lds + wid * 16384);
        if (tail != 0 && c >= tail) cvt_table_fp6(src, dst, 16384, tail_u ? U_SCALE : V_SCALE, scr, lane, (c - tail) * NWAVES + wid, (G - tail) * NWAVES, tail_u ? 0 : 1);
        else if (tail == 0) {
#pragma unroll 1
            for (int rep = 0; rep < (PROBE_DUP == 18 ? 3 : 1); ++rep) cvt_table_fp6(src, dst, 16384, tail_u ? U_SCALE : V_SCALE, scr, lane, gw, NGW, tail_u ? 0 : 1); }
    }
}

__global__ void __launch_bounds__(NWAVES * 64, 2) mk_fwd(Params Pv) {
    extern __shared__ __attribute__((aligned(16))) unsigned char lds_g[];
    LAS unsigned char* lds = (LAS unsigned char*)lds_g;
    const int wv = __builtin_amdgcn_readfirstlane((int)threadIdx.x >> 6);
    const int tid = wv * 64 + lane_id_fresh();
    for (int u = tid; u < (LDS_BYTES - RING_BYTES) / 4; u += NWAVES * 64) ((LAS unsigned*)(lds + RING_BYTES))[u] = 0u;
    __syncthreads();
    const int lo = Pv.ph_lo, hi = Pv.ph_hi;
    unsigned* barw = (unsigned*)(Pv.ws + WS_CTL) + CW_BAR;
    XcdBarrier bar; bar.bar = barw; bar.x = 0; bar.st = nullptr;
    if (hi - lo > 1) bar = xcd_barrier_post(barw, (volatile LAS unsigned*)(lds + MISC_OFF) + 8, tid == 0);
    int ph = 0;
#ifndef SEL
#define SELP(k) true
#else
#define SELP(k) ((k) == SEL)
#endif
    enum { RUN_BASE = __COUNTER__ + 1 };
#define RUN(call) do { if (SELP(__COUNTER__ - RUN_BASE) && ph >= lo && ph < hi) { call; } if (ph >= lo && ph + 1 < hi) { xcd_barrier(bar, wv == 0 && lane_id_fresh() == 0); if (PROBE_DUP == 30) { xcd_barrier(bar, wv == 0 && lane_id_fresh() == 0); xcd_barrier(bar, wv == 0 && lane_id_fresh() == 0); } } ++ph; } while (0)
    RUN(ph_prologue(wv, lds));
    RUN(ph_modreduce(wv));
    RUN(ph_first(wv, lds));
#define LAYER(LL) do { constexpr int L = (LL); constexpr int kind = L % 3, jj = L / 3; constexpr int Mrows = (L == NLAYER - 1) ? ML : MT; \
        constexpr bool ctx_dead = (L == NLAYER - 2) && ((NLAYER - 1) % 3 == 0) && (kind != 0); constexpr int Mlive = ctx_dead ? ML : Mrows; \
        if (kind == 0) {                          \
            RUN(ph_gemm(wv, lds, G_GM_IN, L, Mrows)); \
            RUN(ph_vstats(wv, Mrows)); \
            RUN(ph_spatial(wv, lds, jj, Mrows)); \
            RUN(ph_gemm(wv, lds, G_GM_OUT, L, Mrows)); \
        } else if (kind == 1) {                   \
            RUN(ph_gemm(wv, lds, G_MLA_IN, L, Mrows)); \
            RUN(ph_mla_norm(wv)); \
            RUN(ph_gemm(wv, lds, G_MLA_UQ, L, Mrows); ph_gemm(wv, lds, G_MLA_UKV, L, Mrows)); \
            if (ROPE_TEST == 2) { RUN(ph_rope(wv, 0)); } \
            RUN(ph_attn_mla(wv, lds)); \
            RUN(ph_gemm(wv, lds, G_MLA_OUT, L, Mrows)); \
        } else {                                  \
            RUN(ph_gemm(wv, lds, G_DA_IN, L, Mrows); if (ROPE_TEST == 1) { __syncthreads(); } ); \
            if (ROPE_TEST == 1) { RUN(ph_rope(wv, 1)); } \
            RUN(ph_attn_da(wv, lds, L, !ctx_dead)); \
            RUN(ph_gemm(wv, lds, G_DA_OUT, L, Mlive)); \
        } \
        RUN(ph_postmix(wv, lds, L, Mlive));                \
        RUN(ph_gemm(wv, lds, G_PEER_Q, L, Mlive));    \
        RUN(ph_route(wv, lds, L, Mlive));             \
        RUN(ph_gather(wv, lds, L, Mlive));            \
    } while (0)
    LAYER(0); LAYER(1); LAYER(2); LAYER(3);
#undef LAYER
#undef RUN
}

extern "C" void kernel_launch(void* const* d_in, const int* in_sizes, int n_in, void* d_out, int out_size, void* d_ws, size_t ws_size, hipStream_t stream) {
    static int grid = 0;
    if (grid == 0) {
        if (n_in != 29 || in_sizes[0] != ML * DM || out_size != ML * DM || ws_size < WS_END) {
            fprintf(stderr, "kernel_launch: shape mismatch: n_in %d in0 %d out %d ws %zu (need %zu); nothing launched\n", n_in, n_in > 0 ? in_sizes[0] : -1, out_size, ws_size, (size_t)WS_END); grid = -1; return; }
        int dev = 0, cus = 0, per_cu = 0;
        if (hipGetDevice(&dev) != hipSuccess || hipDeviceGetAttribute(&cus, hipDeviceAttributeMultiprocessorCount, dev) != hipSuccess) { fprintf(stderr, "kernel_launch: device query failed\n"); grid = -1; return; }
        if (hipFuncSetAttribute((const void*)mk_fwd, hipFuncAttributeMaxDynamicSharedMemorySize, LDS_BYTES) != hipSuccess) { fprintf(stderr, "kernel_launch: hipFuncSetAttribute failed\n"); grid = -1; return; }
        if (hipOccupancyMaxActiveBlocksPerMultiprocessor(&per_cu, (const void*)mk_fwd, NWAVES * 64, LDS_BYTES) != hipSuccess || per_cu < 1)
            fprintf(stderr, "kernel_launch: note: occupancy query reports %d workgroups per CU\n", per_cu);
        (void)hipGetLastError();
        grid = cus;
    }
    if (grid < 0) return;
    if (hipMemsetAsync((char*)d_ws + WS_CTL, 0, CTL_ZERO_BYTES, stream) != hipSuccess) { fprintf(stderr, "kernel_launch: memset failed\n"); return; }
    Params p{};
    for (int i = 0; i < 29; ++i) p.in[i] = (const float*)d_in[i];
    p.out = (float*)d_out; p.ws = (unsigned char*)d_ws;
#if MK_ONE_LAUNCH
    p.ph_lo = 0; p.ph_hi = NPH;
    hipLaunchKernelGGL(mk_fwd, dim3(grid), dim3(NWAVES * 64), LDS_BYTES, stream, p);
#else
    for (int li = 0; li < NPH; ++li) { p.ph_lo = li; p.ph_hi = li + 1; hipLaunchKernelGGL(mk_fwd, dim3(grid), dim3(NWAVES * 64), LDS_BYTES, stream, p); }
#endif
    const hipError_t le = hipPeekAtLastError();
    if (le != hipSuccess) fprintf(stderr, "kernel_launch: launch failed: %s\n", hipGetErrorName(le));
}
```

```cpp
#include <hip/hip_runtime.h>
#include <cstdio>
#include <cstdint>
#ifndef MK_ONE_LAUNCH
#define MK_ONE_LAUNCH 1
#endif
__device__ __forceinline__ int launder_v(int v) { asm volatile("" : "+v"(v)); return v; }
__device__ __forceinline__ int lane_id_fresh() { unsigned m = ~0u; asm volatile("" : "+s"(m)); return (int)__builtin_amdgcn_mbcnt_hi(m, __builtin_amdgcn_mbcnt_lo(m, 0u)); }
#ifndef WT_STORES
#define WT_STORES 0
#endif
typedef unsigned wt_u32x4 __attribute__((ext_vector_type(4)));
__device__ __forceinline__ void st16_wt(void* p, wt_u32x4 v) {
#if WT_STORES
    asm volatile("global_store_dwordx4 %0, %1, off sc1\n\ts_nop 1" :: "v"(p), "v"(v) : "memory");
#else
    *(wt_u32x4*)p = v;
#endif
}
namespace pg8 {
#define PG8_LAS __attribute__((address_space(3)))
typedef unsigned short bf16_t;
typedef short bf16x8 __attribute__((ext_vector_type(8)));
typedef float f32x4 __attribute__((ext_vector_type(4)));
typedef unsigned u32x4 __attribute__((ext_vector_type(4)));
constexpr int BM = 256, BK = 64, HALF = 128, HTB = HALF * BK * 2  , STAGE_BYTES = 8 * HTB, NXCD = 8, WGM = 8;

__host__ __device__ __forceinline__ int lds_byte(int r, int c) { const int st = (r >> 4) * 2 + (c >> 5), rr = r & 15, cc = c & 31, ob = rr * 64 + cc * 2; return st * 1024 + (ob ^ (((ob >> 9) & 1) << 5)); }
__host__ __device__ __forceinline__ void stage_rc(int b, int& R, int& C) { const int st = b / 1024, sb = b % 1024, swz = sb ^ (((sb >> 9) & 1) << 5); R = (st >> 1) * 16 + swz / 64; C = (st & 1) * 32 + (swz % 64) / 2; }
__host__ __device__ __forceinline__ int perm32(int rho) { const int n = rho >> 4, i = rho & 15; return 8 * (i >> 2) + 4 * n + (i & 3); }

struct Unit { int pm, pn; };
struct Gemm { const bf16_t* A; const bf16_t* Bt; int M, N, K; };

struct StaticOrder {
    int nM, nN, nwg, G, c;
    __host__ __device__ void init(int M, int N, int G_, int c_) { nM = M / BM; nN = N / BM; nwg = nM * nN; G = G_; c = c_; }
    __host__ __device__ bool next(int i, Unit& u) const {
        const long L = (long)i * G + c; if (L >= nwg) return false;
        int wgid = (int)L; { const int q = nwg / NXCD, r = nwg % NXCD, xcd = wgid % NXCD, off = wgid / NXCD; wgid = (xcd < r ? xcd * (q + 1) : r * (q + 1) + (xcd - r) * q) + off; }
        const int nig = WGM * nN, gid = wgid / nig, fm = gid * WGM, gsz = (nM - fm) < WGM ? (nM - fm) : WGM;
        u.pm = fm + ((wgid % nig) % gsz); u.pn = (wgid % nig) / gsz; return true;
    }
    __device__ __forceinline__ void a_ready(const Unit&) const {}
    __device__ __forceinline__ void done(const Unit&) const {}
};

__device__ __forceinline__ unsigned cvt_pk_bf16(float lo, float hi) { unsigned r; asm volatile("v_cvt_pk_bf16_f32 %0, %1, %2" : "=v"(r) : "v"(lo), "v"(hi)); return r; }
typedef float f32x2 __attribute__((ext_vector_type(2)));
__device__ __forceinline__ f32x2 gelu_pk(f32x2 v) {
    const f32x2 av = __builtin_elementwise_abs(v), d = av * 0.2316418882f + 1.0f;
    f32x2 t; t.x = __builtin_amdgcn_rcpf(d.x); t.y = __builtin_amdgcn_rcpf(d.y);
    f32x2 q = t * 0.5307027145f + (-0.7265760135f); q = q * t + 0.7107068705f; q = q * t + (-0.142248368f); q = q * t + 0.127414796f; q = q * t;
    const f32x2 s = (v * v) * (-0.72134752044f);
    f32x2 e; e.x = __builtin_amdgcn_exp2f(s.x); e.y = __builtin_amdgcn_exp2f(s.y);
    const f32x2 m = v * (q * e), r = v - m;
    f32x2 o; o.x = v.x < 0.f ? m.x : r.x; o.y = v.y < 0.f ? m.y : r.y; return o;
}

template <int ACT  > struct EpiBf16 {
    static constexpr bool PERM = true, AFTER_DRAIN = false; static_assert(ACT == 0 || ACT == 1, "EpiBf16: ACT is 0 (none) or 1 (gelu_pk)");
    bf16_t* O; int ldc; const float* bias; int split_cols; size_t split_stride; float scale0;
    __device__ __forceinline__ void operator()(const f32x4 (&acc)[2][2][4][2], const Unit& u, int wr, int wc, int fr, int fq) const {
        const int row0 = u.pm * BM + wr * 64 + fr; int colt = u.pn * BM; bf16_t* base = O;
        float sc = 1.f; if (split_cols) { const int t = colt / split_cols; base += (size_t)t * split_stride; colt -= t * split_cols; if (t == 0) sc = scale0; }
        const int col0 = colt + wc * 32 + 8 * fq, bcol0 = u.pn * BM + wc * 32 + 8 * fq;
        f32x4 bv[2][2];
#pragma unroll
        for (int bj = 0; bj < 2; ++bj)
#pragma unroll
            for (int n = 0; n < 2; ++n) bv[bj][n] = bias ? *(const f32x4*)(bias + bcol0 + bj * HALF + 4 * n) : (f32x4){0.f, 0.f, 0.f, 0.f};
#pragma unroll
        for (int ai = 0; ai < 2; ++ai)
#pragma unroll
            for (int m = 0; m < 4; ++m) { bf16_t* rowp = base + (size_t)(row0 + ai * HALF + m * 16) * ldc + col0;
#pragma unroll
                for (int bj = 0; bj < 2; ++bj) { f32x4 v0 = acc[ai][bj][m][0] + bv[bj][0], v1 = acc[ai][bj][m][1] + bv[bj][1];
                    if (ACT == 1) { f32x2 a = gelu_pk((f32x2){v0[0], v0[1]}), b = gelu_pk((f32x2){v0[2], v0[3]}), c = gelu_pk((f32x2){v1[0], v1[1]}), d = gelu_pk((f32x2){v1[2], v1[3]});
                        v0 = (f32x4){a.x, a.y, b.x, b.y}; v1 = (f32x4){c.x, c.y, d.x, d.y}; }
                    v0 = v0 * sc; v1 = v1 * sc; u32x4 w; w.x = cvt_pk_bf16(v0[0], v0[1]); w.y = cvt_pk_bf16(v0[2], v0[3]); w.z = cvt_pk_bf16(v1[0], v1[1]); w.w = cvt_pk_bf16(v1[2], v1[3]);
                    *(u32x4*)(rowp + bj * HALF) = w; } }
    }
};
template <class Epi, class Sched, bool ALIGN_EPI = false, bool SP2 = false>
__device__ __forceinline__ void gemm_phase(PG8_LAS unsigned char* lds, const Gemm g, const Sched& S, const Epi& E, const int tid_in) {
    const int tid = launder_v(tid_in) & 511, wid = __builtin_amdgcn_readfirstlane(tid >> 6), lane = tid & 63, wr = wid >> 2, wc = wid & 3, fr = lane & 15, fq = lane >> 4;
    const int K = g.K, nt = K / BK;
    unsigned voffA[2], voffB[2];
#pragma unroll
    for (int i = 0; i < 2; ++i) { int R, C; stage_rc(tid * 16 + i * 8192, R, C); const int Rb = Epi::PERM ? ((R & ~31) + perm32(R & 31)) : R;
        voffA[i] = (unsigned)(R * K + C) * 2u; voffB[i] = (unsigned)(Rb * K + C) * 2u; }
    const size_t kstep = (size_t)(BK * 2);
    const size_t hstep = (size_t)HALF * K * 2;
    const size_t tstep = 2 * hstep;
    const unsigned ldsw = (unsigned)wid * 1024u;
    const int aoff = lds_byte(wr * 64 + fr, fq * 8), boff = lds_byte(wc * 32 + fr, fq * 8);
#define PG8_SA(b, h) (((b) * 2 + (h)) * HTB)
#define PG8_SB(b, h) ((4 + (b) * 2 + (h)) * HTB)
#define PG8_STAGE(bufoff, gbase, voff) do { _Pragma("unroll") for (int _i = 0; _i < 2; ++_i) \
        __builtin_amdgcn_global_load_lds((const unsigned*)((const char*)(gbase) + (voff)[_i]), (PG8_LAS unsigned*)(lds + (bufoff) + ldsw + _i * 8192), 16, 0, 0); } while (0)
#define PG8_LDA(dst, b, h) do { _Pragma("unroll") for (int m = 0; m < 4; ++m) _Pragma("unroll") for (int k = 0; k < 2; ++k) dst[m][k] = *(const PG8_LAS bf16x8*)(lds + PG8_SA(b, h) + aoff + m * 2048 + k * 1024); } while (0)
#define PG8_LDB(dst, b, h) do { _Pragma("unroll") for (int n = 0; n < 2; ++n) _Pragma("unroll") for (int k = 0; k < 2; ++k) dst[n][k] = *(const PG8_LAS bf16x8*)(lds + PG8_SB(b, h) + boff + n * 2048 + k * 1024); } while (0)
#define PG8_MMA(ai, bj, At, Bt) do { __builtin_amdgcn_s_setprio(1); _Pragma("unroll") for (int m = 0; m < 4; ++m) _Pragma("unroll") for (int n = 0; n < 2; ++n) _Pragma("unroll") for (int k = 0; k < 2; ++k) \
        acc[ai][bj][m][n] = __builtin_amdgcn_mfma_f32_16x16x32_bf16(Bt[n][k], At[m][k], acc[ai][bj][m][n], 0, 0, 0); __builtin_amdgcn_s_setprio(0); } while (0)
#define PG8_WAIT_V(n) asm volatile("s_waitcnt vmcnt(" #n ")" ::: "memory")
#define PG8_WAIT_L(n) asm volatile("s_waitcnt lgkmcnt(" #n ")" ::: "memory")
#define PG8_BAR __builtin_amdgcn_s_barrier()
#define PG8_SCHED __builtin_amdgcn_sched_barrier(0)
    Unit cur, nxt; int ui = 0;
    if (!S.next(0, cur)) return;
    f32x4 acc[2][2][4][2];
#pragma unroll
    for (int a = 0; a < 2; ++a)
#pragma unroll
        for (int b = 0; b < 2; ++b)
#pragma unroll
            for (int m = 0; m < 4; ++m)
#pragma unroll
                for (int n = 0; n < 2; ++n) acc[a][b][m][n] = (f32x4){0.f, 0.f, 0.f, 0.f};
    bf16x8 At[4][2], B0[2][2], B1[2][2];
    const char* cA = (const char*)g.A + (size_t)cur.pm * tstep; const char* cB = (const char*)g.Bt + (size_t)cur.pn * tstep;
    S.a_ready(cur);
    if constexpr (SP2) {
        PG8_STAGE(PG8_SB(0, 0), cB, voffB); PG8_STAGE(PG8_SB(0, 1), cB + hstep, voffB); PG8_STAGE(PG8_SA(0, 0), cA, voffA); PG8_STAGE(PG8_SA(0, 1), cA + hstep, voffA);
        if (wr == 1) PG8_BAR;
        PG8_WAIT_V(2); PG8_BAR;
        PG8_STAGE(PG8_SB(1, 0), cB + kstep, voffB); PG8_STAGE(PG8_SA(1, 0), cA + kstep, voffA); PG8_STAGE(PG8_SB(1, 1), cB + hstep + kstep, voffB);
        PG8_WAIT_V(6); PG8_BAR;
    } else {
        PG8_STAGE(PG8_SB(0, 0), cB, voffB); PG8_STAGE(PG8_SA(0, 0), cA, voffA); PG8_STAGE(PG8_SB(0, 1), cB + hstep, voffB); PG8_STAGE(PG8_SA(0, 1), cA + hstep, voffA);
        if (wr == 1) PG8_BAR;
        PG8_WAIT_V(4); PG8_BAR;
        PG8_STAGE(PG8_SB(1, 0), cB + kstep, voffB); PG8_STAGE(PG8_SA(1, 0), cA + kstep, voffA); PG8_STAGE(PG8_SB(1, 1), cB + hstep + kstep, voffB);
        PG8_WAIT_V(6); PG8_BAR;
    }
    for (;;) {
        const bool has_next = S.next(ui + 1, nxt);
        const char* nA = has_next ? (const char*)g.A + (size_t)nxt.pm * tstep : cA; const char* nB = has_next ? (const char*)g.Bt + (size_t)nxt.pn * tstep : cB;
        for (int t = 0; t < nt; t += 2) {
            const bool last = (t == nt - 2);
            const char* a1 = cA + (size_t)(t + 1) * kstep;
            const char* a2 = last ? nA : cA + (size_t)(t + 2) * kstep; const char* b2 = last ? nB : cB + (size_t)(t + 2) * kstep;
            const char* a3 = a2 + kstep; const char* b3 = b2 + kstep;
            if (last && has_next) S.a_ready(nxt);
            if constexpr (SP2) {
            PG8_LDB(B0, 0, 0); PG8_LDB(B1, 0, 1); PG8_SCHED; PG8_LDA(At, 0, 0); PG8_STAGE(PG8_SA(1, 1), a1 + hstep, voffA);
            PG8_WAIT_V(8); PG8_WAIT_L(0); PG8_BAR; PG8_MMA(0, 0, At, B0); PG8_MMA(0, 1, At, B1); PG8_BAR; PG8_SCHED;
            PG8_LDA(At, 0, 1); PG8_STAGE(PG8_SB(0, 0), b2, voffB); PG8_STAGE(PG8_SB(0, 1), b2 + hstep, voffB); PG8_STAGE(PG8_SA(0, 0), a2, voffA);
            PG8_WAIT_V(8); PG8_WAIT_L(0); PG8_BAR; PG8_MMA(1, 0, At, B0); PG8_MMA(1, 1, At, B1); PG8_BAR; PG8_SCHED;
            PG8_LDB(B0, 1, 0); PG8_LDB(B1, 1, 1); PG8_SCHED; PG8_LDA(At, 1, 0); PG8_STAGE(PG8_SA(0, 1), a2 + hstep, voffA);
            PG8_WAIT_V(8); PG8_WAIT_L(0); PG8_BAR; PG8_MMA(0, 0, At, B0); PG8_MMA(0, 1, At, B1); PG8_BAR; PG8_SCHED;
            PG8_LDA(At, 1, 1); PG8_STAGE(PG8_SB(1, 0), b3, voffB); PG8_STAGE(PG8_SB(1, 1), b3 + hstep, voffB); PG8_STAGE(PG8_SA(1, 0), a3, voffA);
            PG8_WAIT_V(8); PG8_WAIT_L(0); PG8_BAR; PG8_MMA(1, 0, At, B0); PG8_MMA(1, 1, At, B1); PG8_BAR; PG8_SCHED;
            } else {
            PG8_LDB(B0, 0, 0); PG8_SCHED; PG8_LDA(At, 0, 0); PG8_STAGE(PG8_SA(1, 1), a1 + hstep, voffA);
            PG8_WAIT_L(8); PG8_BAR; PG8_WAIT_L(0); PG8_MMA(0, 0, At, B0); PG8_BAR; PG8_SCHED;
            PG8_LDB(B1, 0, 1); PG8_STAGE(PG8_SB(0, 0), b2, voffB);
            PG8_BAR; PG8_WAIT_L(0); PG8_MMA(0, 1, At, B1); PG8_BAR;
            PG8_LDA(At, 0, 1); PG8_STAGE(PG8_SA(0, 0), a2, voffA);
            PG8_BAR; PG8_WAIT_L(0); PG8_MMA(1, 0, At, B0); PG8_BAR; PG8_SCHED;
            PG8_STAGE(PG8_SB(0, 1), b2 + hstep, voffB);
            PG8_WAIT_V(6); PG8_BAR; PG8_MMA(1, 1, At, B1); PG8_BAR;
            PG8_LDB(B0, 1, 0); PG8_SCHED; PG8_LDA(At, 1, 0); PG8_STAGE(PG8_SA(0, 1), a2 + hstep, voffA);
            PG8_WAIT_L(8); PG8_BAR; PG8_WAIT_L(0); PG8_MMA(0, 0, At, B0); PG8_BAR; PG8_SCHED;
            PG8_LDB(B1, 1, 1); PG8_STAGE(PG8_SB(1, 0), b3, voffB);
            PG8_BAR; PG8_WAIT_L(0); PG8_MMA(0, 1, At, B1); PG8_BAR;
            PG8_LDA(At, 1, 1); PG8_STAGE(PG8_SA(1, 0), a3, voffA);
            PG8_BAR; PG8_WAIT_L(0); PG8_MMA(1, 0, At, B0); PG8_BAR; PG8_SCHED;
            PG8_STAGE(PG8_SB(1, 1), b3 + hstep, voffB);
            PG8_WAIT_V(6); PG8_BAR; PG8_MMA(1, 1, At, B1); PG8_BAR;
            }
        }
        if constexpr (ALIGN_EPI) { if (wr == 0) PG8_BAR; }
        if constexpr (!Epi::AFTER_DRAIN) { E(acc, cur, wr, wc, fr, fq); S.done(cur); }
        if (!has_next) break;
#pragma unroll
        for (int a = 0; a < 2; ++a)
#pragma unroll
            for (int b = 0; b < 2; ++b)
#pragma unroll
                for (int m = 0; m < 4; ++m)
#pragma unroll
                    for (int n = 0; n < 2; ++n) acc[a][b][m][n] = (f32x4){0.f, 0.f, 0.f, 0.f};
        cur = nxt; cA = nA; cB = nB; ++ui;
        if constexpr (ALIGN_EPI) { if (wr == 1) PG8_BAR; }
    }
    PG8_WAIT_V(0);
    if constexpr (!ALIGN_EPI) { if (wr == 0) PG8_BAR; }
    PG8_BAR;
    if constexpr (Epi::AFTER_DRAIN) { E.fused(acc, cur, wr, wc, fr, fq, lds, wid, lane); S.done(cur); }
#undef PG8_SA
#undef PG8_SB
#undef PG8_STAGE
#undef PG8_LDA
#undef PG8_LDB
#undef PG8_MMA
#undef PG8_WAIT_V
#undef PG8_WAIT_L
#undef PG8_BAR
#undef PG8_SCHED
}
}

namespace pg8 {
__device__ __forceinline__ float gelu_tanh(float x) {
    const float t = x * (1.5957691216057308f + 0.07135481627f * x * x);
    const float e = __builtin_amdgcn_exp2f(-1.4426950408889634f * t);
    return x * __builtin_amdgcn_rcpf(1.0f + e);
}
template <int ACT> struct EpiT {
    static constexpr bool PERM = true, AFTER_DRAIN = false;
    bf16_t* O; int ldc;
    __device__ __forceinline__ void operator()(const f32x4 (&acc)[2][2][4][2], const Unit& u, int wr, int wc, int fr, int fq) const {
        const int row0 = u.pm * BM + wr * 64 + fr; const int col0 = u.pn * BM + wc * 32 + 8 * fq;
#pragma unroll
        for (int ai = 0; ai < 2; ++ai)
#pragma unroll
            for (int m = 0; m < 4; ++m) { bf16_t* rowp = O + (size_t)(row0 + ai * HALF + m * 16) * ldc + col0;
#pragma unroll
                for (int bj = 0; bj < 2; ++bj) { f32x4 v0 = acc[ai][bj][m][0], v1 = acc[ai][bj][m][1];
                    if (ACT == 2) { v0 = (f32x4){gelu_tanh(v0[0]), gelu_tanh(v0[1]), gelu_tanh(v0[2]), gelu_tanh(v0[3])}; v1 = (f32x4){gelu_tanh(v1[0]), gelu_tanh(v1[1]), gelu_tanh(v1[2]), gelu_tanh(v1[3])}; }
                    u32x4 w; w.x = cvt_pk_bf16(v0[0], v0[1]); w.y = cvt_pk_bf16(v0[2], v0[3]); w.z = cvt_pk_bf16(v1[0], v1[1]); w.w = cvt_pk_bf16(v1[2], v1[3]);
                    ::st16_wt(rowp + bj * HALF, w); } }
    }
};
struct EpiR {
    static constexpr bool PERM = true, AFTER_DRAIN = false;
    bf16_t* O; int ldc; int act; int rope; const float* ropet;
    __device__ __forceinline__ void operator()(const f32x4 (&acc)[2][2][4][2], const Unit& u, int wr, int wc, int fr, int fq) const {
        const int row0 = u.pm * BM + wr * 64 + fr; const int col0 = u.pn * BM + wc * 32 + 8 * fq;
        const bool rrows = rope != 0 && u.pm < 64;
#pragma unroll
        for (int ai = 0; ai < 2; ++ai)
#pragma unroll
            for (int m = 0; m < 4; ++m) { const int grow = row0 + ai * HALF + m * 16; bf16_t* rowp = O + (size_t)grow * ldc + col0;
#pragma unroll
                for (int bj = 0; bj < 2; ++bj) { f32x4 v0 = acc[ai][bj][m][0], v1 = acc[ai][bj][m][1];
                    if (act) { v0 = (f32x4){gelu_tanh(v0[0]), gelu_tanh(v0[1]), gelu_tanh(v0[2]), gelu_tanh(v0[3])}; v1 = (f32x4){gelu_tanh(v1[0]), gelu_tanh(v1[1]), gelu_tanh(v1[2]), gelu_tanh(v1[3])}; }
                    if (rrows) { const int blk = u.pn * 8 + bj * 4 + wc; const int b6 = blk % 6; const bool on = rope == 1 ? (blk < 128) : (b6 >= 4); const int half = rope == 1 ? (blk & 1) : (b6 - 4);
                        if (on) { const int t = grow & 8191; const int pos = half ? (t & 63) : (t >> 6);
                            const float* cp = ropet + pos * 16 + 8 * (fq & 1); const f32x4 c0 = *(const f32x4*)cp, c1 = *(const f32x4*)(cp + 4), s0 = *(const f32x4*)(cp + 2048), s1 = *(const f32x4*)(cp + 2052);
                            f32x4 p0, p1;
#pragma unroll
                            for (int i = 0; i < 4; ++i) { const float a_ = v0[i], b_ = v1[i];
                                const auto r0 = __builtin_amdgcn_permlane32_swap(__float_as_uint(a_), __float_as_uint(a_), false, false);
                                const auto r1 = __builtin_amdgcn_permlane32_swap(__float_as_uint(b_), __float_as_uint(b_), false, false);
                                const unsigned x0_ = (fq & 2) ? r0[0] : r0[1], x1_ = (fq & 2) ? r1[0] : r1[1]; p0[i] = __uint_as_float(x0_); p1[i] = __uint_as_float(x1_); }
                            if (fq & 2) { v0 = p0 * s0 + v0 * c0; v1 = p1 * s1 + v1 * c1; } else { v0 = v0 * c0 - p0 * s0; v1 = v1 * c1 - p1 * s1; } } }
                    u32x4 w; w.x = cvt_pk_bf16(v0[0], v0[1]); w.y = cvt_pk_bf16(v0[2], v0[3]); w.z = cvt_pk_bf16(v1[0], v1[1]); w.w = cvt_pk_bf16(v1[2], v1[3]);
                    ::st16_wt(rowp + bj * HALF, w); } }
    }
};
}

constexpr int DM = 2048, NBATCH = 2, SEQ = 8192, CTXL = 256;
constexpr int ML = NBATCH * SEQ;
constexpr int MC = NBATCH * CTXL;
constexpr int MT = ML + MC;
constexpr int NLAYER = 4;
constexpr float ALPHA = 1.6817928305074290f, LN_EPS = 1e-6f;
constexpr int NWAVES = 8;
constexpr float U_SCALE = 64.0f, V_SCALE = 4.0f;
constexpr int PROW = 1536;
#ifndef PEER_V4
#define PEER_V4 1
#endif
#ifndef PEER_U4
#define PEER_U4 1
#endif
constexpr int PREC = PEER_U4 ? 2048 : PEER_V4 ? 2560 : 2 * PROW;
constexpr int NPH = 35;

constexpr size_t MiB = 1ull << 20;
constexpr size_t WS_CTL = 0, CTL_ZERO_BYTES = 1 * MiB;
constexpr int    CW_BAR = 4096;
constexpr size_t WS_MOD = 128 * 1024;
constexpr size_t WS_VST = 1 * MiB;
constexpr size_t WS_ROPE = 1 * MiB + 160 * 1024;
constexpr size_t WS_MODP = 1 * MiB + 256 * 1024;
constexpr size_t WS_GMWIN = 6 * MiB;
constexpr size_t WS_GMWOUT = WS_GMWIN + 32 * MiB;
constexpr size_t WS_GMWS = WS_GMWOUT + 16 * MiB;
constexpr size_t WS_PWQ = WS_GMWS + 1 * MiB;
constexpr size_t WS_PK1 = WS_PWQ + 32 * MiB;
constexpr size_t WS_PK2 = WS_PK1 + 512 * 1024;
constexpr size_t WS_MLAIN = WS_PK1 + 1 * MiB;
constexpr size_t WS_MLAUQ = WS_MLAIN + 5 * MiB;
constexpr size_t WS_MLAUKV = WS_MLAUQ + 3 * MiB;
constexpr size_t WS_MLAOUT = WS_MLAUKV + 4 * MiB;
constexpr size_t WS_DAIN = WS_MLAOUT + 8 * MiB;
constexpr size_t WS_DAOUT = WS_DAIN + 24 * MiB;
constexpr size_t WS_PU = WS_DAOUT + 8 * MiB;
constexpr size_t WS_PV = WS_PU + 96 * MiB;
constexpr size_t WS_X = WS_PV + 96 * MiB;
constexpr size_t WS_H = WS_X + 66 * MiB;
constexpr size_t WS_G = WS_H + 66 * MiB;
constexpr size_t WS_Y = WS_G + 66 * MiB;
constexpr size_t WS_QP = WS_Y + 66 * MiB;
constexpr size_t WS_Z = WS_QP + 66 * MiB;
constexpr size_t WS_C = WS_Z + 198 * MiB;
constexpr size_t WS_CQN = WS_C + 42 * MiB;
constexpr size_t WS_CKVN = WS_CQN + 17 * MiB;
constexpr size_t WS_KR = WS_CKVN + 17 * MiB;
constexpr size_t WS_QM = WS_KR + 3 * MiB;
constexpr size_t WS_KV = WS_QM + 99 * MiB;
constexpr size_t WS_ROUTE = WS_KV + 132 * MiB;
constexpr size_t WS_END = WS_ROUTE + 17 * MiB;
static_assert((size_t)MT * DM * 2 == 66 * MiB, "row buffer size");

constexpr int RING_BYTES = 155648, MISC_OFF = RING_BYTES + 320, LDS_BYTES = 159744;

#define GAS __attribute__((address_space(1)))
#define LAS __attribute__((address_space(3)))
typedef unsigned short bf16;
typedef unsigned u32x4 __attribute__((ext_vector_type(4)));
typedef unsigned u32x2 __attribute__((ext_vector_type(2)));
typedef float f32x4 __attribute__((ext_vector_type(4)));
typedef float f32x16 __attribute__((ext_vector_type(16)));
typedef short bf16x8 __attribute__((ext_vector_type(8)));
typedef short s16x4 __attribute__((ext_vector_type(4)));
#define LDS_WAIT() asm volatile("s_waitcnt lgkmcnt(0)" ::: "memory")

__device__ __forceinline__ unsigned cvtpk(float lo, float hi) { unsigned r; asm("v_cvt_pk_bf16_f32 %0, %1, %2" : "=v"(r) : "v"(lo), "v"(hi)); return r; }
__device__ __forceinline__ float bflo(unsigned w) { return __uint_as_float(w << 16); }
__device__ __forceinline__ float bfhi(unsigned w) { return __uint_as_float(w & 0xffff0000u); }
__device__ __forceinline__ float bf1(bf16 b) { return __uint_as_float((unsigned)b << 16); }
__device__ __forceinline__ bf16 tobf1(float f) { return (bf16)(cvtpk(f, 0.f) & 0xffffu); }
#define DPP_F(v, ctrl) __int_as_float(__builtin_amdgcn_mov_dpp(__float_as_int(v), (ctrl), 0xF, 0xF, true))
__device__ __forceinline__ float row_sum16(float v) { v += DPP_F(v, 0xB1); v += DPP_F(v, 0x4E); v += DPP_F(v, 0x141); v += DPP_F(v, 0x140); return v; }
__device__ __forceinline__ float sum_xor16(float v) { const auto r = __builtin_amdgcn_permlane16_swap(__float_as_uint(v), __float_as_uint(v), false, false); return __uint_as_float(r[0]) + __uint_as_float(r[1]); }
__device__ __forceinline__ float sum_xor32(float v) { const auto r = __builtin_amdgcn_permlane32_swap(__float_as_uint(v), __float_as_uint(v), false, false); return __uint_as_float(r[0]) + __uint_as_float(r[1]); }
__device__ __forceinline__ float wave_sum(float v) { return sum_xor32(sum_xor16(row_sum16(v))); }
__device__ __forceinline__ float half_sum32(float v) { return sum_xor16(row_sum16(v)); }
__device__ __forceinline__ float lane_xor16(float v, int lane) { const auto r = __builtin_amdgcn_permlane16_swap(__float_as_uint(v), __float_as_uint(v), false, false); return __uint_as_float((lane & 16) ? r[0] : r[1]); }
__device__ __forceinline__ unsigned lane_xor32(unsigned v, int lane) { const auto r = __builtin_amdgcn_permlane32_swap(v, v, false, false); return (lane & 32) ? r[0] : r[1]; }
__device__ __forceinline__ float gelu_tanh(float x) { return pg8::gelu_tanh(x); }

__device__ __forceinline__ void load_row_bf16(const bf16* row, int lane, float (&v)[32]) {
#pragma unroll
    for (int j = 0; j < 4; ++j) { const u32x4 w = ((const u32x4*)row)[64 * j + lane];
        v[8 * j + 0] = bflo(w.x); v[8 * j + 1] = bfhi(w.x); v[8 * j + 2] = bflo(w.y); v[8 * j + 3] = bfhi(w.y);
        v[8 * j + 4] = bflo(w.z); v[8 * j + 5] = bfhi(w.z); v[8 * j + 6] = bflo(w.w); v[8 * j + 7] = bfhi(w.w); }
}
__device__ __forceinline__ void load_row_bf16_nt(const bf16* row, int lane, float (&v)[32]) {
#pragma unroll
    for (int j = 0; j < 4; ++j) { const u32x4 w = __builtin_nontemporal_load(&((const u32x4*)row)[64 * j + lane]);
        v[8 * j + 0] = bflo(w.x); v[8 * j + 1] = bfhi(w.x); v[8 * j + 2] = bflo(w.y); v[8 * j + 3] = bfhi(w.y);
        v[8 * j + 4] = bflo(w.z); v[8 * j + 5] = bfhi(w.z); v[8 * j + 6] = bflo(w.w); v[8 * j + 7] = bfhi(w.w); }
}
__device__ __forceinline__ void store_row_bf16(bf16* row, int lane, const float (&v)[32]) {
#pragma unroll
    for (int j = 0; j < 4; ++j) { u32x4 w; w.x = cvtpk(v[8 * j + 0], v[8 * j + 1]); w.y = cvtpk(v[8 * j + 2], v[8 * j + 3]); w.z = cvtpk(v[8 * j + 4], v[8 * j + 5]); w.w = cvtpk(v[8 * j + 6], v[8 * j + 7]);
        ((u32x4*)row)[64 * j + lane] = w; }
}
__device__ __forceinline__ void load_row_f32(const float* row, int lane, float (&v)[32]) {
#pragma unroll
    for (int j = 0; j < 4; ++j) { const f32x4 a = ((const f32x4*)row)[128 * j + 2 * lane], b = ((const f32x4*)row)[128 * j + 2 * lane + 1];
        v[8 * j + 0] = a.x; v[8 * j + 1] = a.y; v[8 * j + 2] = a.z; v[8 * j + 3] = a.w; v[8 * j + 4] = b.x; v[8 * j + 5] = b.y; v[8 * j + 6] = b.z; v[8 * j + 7] = b.w; }
}
__device__ __forceinline__ void load_row_f32_nt(const float* row, int lane, float (&v)[32]) {
#pragma unroll
    for (int j = 0; j < 4; ++j) { const f32x4 a = __builtin_nontemporal_load(&((const f32x4*)row)[128 * j + 2 * lane]), b = __builtin_nontemporal_load(&((const f32x4*)row)[128 * j + 2 * lane + 1]);
        v[8 * j + 0] = a.x; v[8 * j + 1] = a.y; v[8 * j + 2] = a.z; v[8 * j + 3] = a.w; v[8 * j + 4] = b.x; v[8 * j + 5] = b.y; v[8 * j + 6] = b.z; v[8 * j + 7] = b.w; }
}
__device__ __forceinline__ void store_row_f32(float* row, int lane, const float (&v)[32]) {
#pragma unroll
    for (int j = 0; j < 4; ++j) { ((f32x4*)row)[128 * j + 2 * lane] = (f32x4){v[8 * j + 0], v[8 * j + 1], v[8 * j + 2], v[8 * j + 3]};
        ((f32x4*)row)[128 * j + 2 * lane + 1] = (f32x4){v[8 * j + 4], v[8 * j + 5], v[8 * j + 6], v[8 * j + 7]}; }
}
__device__ __forceinline__ void load_row_bf16_b(const bf16* row, int lane, float (&v)[32]) {
#pragma unroll
    for (int j = 0; j < 4; ++j) { const u32x4 w = ((const u32x4*)row)[4 * lane + j];
        v[8 * j + 0] = bflo(w.x); v[8 * j + 1] = bfhi(w.x); v[8 * j + 2] = bflo(w.y); v[8 * j + 3] = bfhi(w.y);
        v[8 * j + 4] = bflo(w.z); v[8 * j + 5] = bfhi(w.z); v[8 * j + 6] = bflo(w.w); v[8 * j + 7] = bfhi(w.w); }
}
__device__ __forceinline__ void store_row_bf16_b(bf16* row, int lane, const float (&v)[32]) {
#pragma unroll
    for (int j = 0; j < 4; ++j) { u32x4 w; w.x = cvtpk(v[8 * j + 0], v[8 * j + 1]); w.y = cvtpk(v[8 * j + 2], v[8 * j + 3]); w.z = cvtpk(v[8 * j + 4], v[8 * j + 5]); w.w = cvtpk(v[8 * j + 6], v[8 * j + 7]);
        ((u32x4*)row)[4 * lane + j] = w; }
}
__device__ __forceinline__ void load_row_f32_b(const float* row, int lane, float (&v)[32]) {
#pragma unroll
    for (int q = 0; q < 8; ++q) { const f32x4 a = ((const f32x4*)row)[8 * lane + q];
        v[4 * q + 0] = a.x; v[4 * q + 1] = a.y; v[4 * q + 2] = a.z; v[4 * q + 3] = a.w; }
}
__device__ __forceinline__ void store_row_f32_b(float* row, int lane, const float (&v)[32]) {
#pragma unroll
    for (int q = 0; q < 8; ++q) ((f32x4*)row)[8 * lane + q] = (f32x4){v[4 * q + 0], v[4 * q + 1], v[4 * q + 2], v[4 * q + 3]};
}
__device__ __forceinline__ void store_row_f32_b_nt(float* row, int lane, const float (&v)[32]) {
#pragma unroll
    for (int q = 0; q < 8; ++q) __builtin_nontemporal_store((f32x4){v[4 * q + 0], v[4 * q + 1], v[4 * q + 2], v[4 * q + 3]}, &((f32x4*)row)[8 * lane + q]);
}
__device__ __forceinline__ void ln_stats(const float (&v)[32], float& mean, float& rstd) {
    float s = 0.f;
#pragma unroll
    for (int i = 0; i < 32; ++i) s += v[i];
    mean = wave_sum(s) * (1.0f / DM);
    float q = 0.f;
#pragma unroll
    for (int i = 0; i < 32; ++i) { const float d = v[i] - mean; q += d * d; }
    rstd = 1.0f / sqrtf(wave_sum(q) * (1.0f / DM) + LN_EPS);
}
template <bool LAYB>
__device__ __forceinline__ void finish_row(float (&z)[32], const float* lng, const float* lnb, bf16* Xrow, const float* sh, const float* sc, bf16* Hrow, float* Orow, int lane) {
    float mean, rstd; ln_stats(z, mean, rstd);
    { float g[32], b[32]; if (LAYB) { load_row_f32_b(lng, lane, g); load_row_f32_b(lnb, lane, b); } else { load_row_f32(lng, lane, g); load_row_f32(lnb, lane, b); }
#pragma unroll
      for (int i = 0; i < 32; ++i) z[i] = (z[i] - mean) * rstd * g[i] + b[i]; }
    if (Xrow) { if (LAYB) store_row_bf16_b(Xrow, lane, z); else store_row_bf16(Xrow, lane, z); }
    if (Orow) { if (LAYB) store_row_f32_b(Orow, lane, z); else store_row_f32(Orow, lane, z); }
    if (Hrow) {
        ln_stats(z, mean, rstd);
        float a[32], s[32]; if (LAYB) { load_row_f32_b(sc, lane, a); load_row_f32_b(sh, lane, s); } else { load_row_f32(sc, lane, a); load_row_f32(sh, lane, s); }
#pragma unroll
        for (int i = 0; i < 32; ++i) a[i] = (z[i] - mean) * rstd * (1.0f + a[i]) + s[i];
        if (LAYB) store_row_bf16_b(Hrow, lane, a); else store_row_bf16(Hrow, lane, a);
    }
}
__device__ __forceinline__ int row_slot(int row) { return row < ML ? (row >> 13) : 2; }

__device__ __forceinline__ unsigned f2bf_rne(float f) { unsigned u = __float_as_uint(f); return (u + 0x7fffu + ((u >> 16) & 1u)) >> 16; }
__device__ __forceinline__ unsigned pk2(float lo, float hi) { return f2bf_rne(lo) | (f2bf_rne(hi) << 16); }
#ifndef GEMV_PIPE
#define GEMV_PIPE 1
#endif
#ifndef NT_ACT
#define NT_ACT 0
#endif
#ifndef NT_STREAM
#define NT_STREAM 1
#endif
__device__ __forceinline__ void p0_transpose_item(const float* W, int K, int N, bf16* WT, LAS float* scr, int item, int lane) {
    const int nblk = N / 32, kb = item / nblk, nb = item % nblk, k0 = 64 * kb, n0 = 32 * nb;
    f32x4 t[8];
#pragma unroll
    for (int i = 0; i < 8; ++i) { const f32x4* p_ = (const f32x4*)(W + (size_t)(k0 + 8 * i + (lane >> 3)) * N + n0 + 4 * (lane & 7)); t[i] = NT_STREAM ? __builtin_nontemporal_load(p_) : *p_; }
#pragma unroll
    for (int i = 0; i < 8; ++i) { LAS float* d = scr + (8 * i + (lane >> 3)) * 33 + 4 * (lane & 7); d[0] = t[i].x; d[1] = t[i].y; d[2] = t[i].z; d[3] = t[i].w; }
    LDS_WAIT(); asm volatile("" ::: "memory");
    const int c = lane & 7;
#pragma unroll
    for (int j = 0; j < 4; ++j) { const int n = (lane >> 3) + 8 * j; const LAS float* s = scr + (8 * c) * 33 + n;
        u32x4 o; o.x = pk2(s[0 * 33], s[1 * 33]); o.y = pk2(s[2 * 33], s[3 * 33]); o.z = pk2(s[4 * 33], s[5 * 33]); o.w = pk2(s[6 * 33], s[7 * 33]);
        *(u32x4*)(WT + (size_t)(n0 + n) * K + k0 + 8 * c) = o; }
    LDS_WAIT(); asm volatile("" ::: "memory");
}
__device__ __forceinline__ void cvt_range(const float* src, bf16* dst, size_t n8, size_t gtid, size_t gthreads) {
#pragma unroll 4
    for (size_t i = gtid; i < n8; i += gthreads) { const f32x4 a = ((const f32x4*)src)[2 * i], b = ((const f32x4*)src)[2 * i + 1];
        u32x4 w; w.x = cvtpk(a.x, a.y); w.y = cvtpk(a.z, a.w); w.z = cvtpk(b.x, b.y); w.w = cvtpk(b.z, b.w); ((u32x4*)dst)[i] = w; }
}
__device__ __forceinline__ unsigned enc_e2m3(float x) {
    const unsigned sgn = (__float_as_uint(x) >> 26) & 32u;
    const float ax = fminf(fabsf(x), 7.5f);
    unsigned u = __float_as_uint(ax); u += 0x7FFFFu + ((u >> 20) & 1u);
    const unsigned cn = (u >> 20) - ((127u - 1u) << 3);
    const unsigned cs = (unsigned)__builtin_rintf(ax * 8.0f);
    return sgn | (ax < 1.0f ? cs : cn);
}
#ifndef EMU_FP4V
#define EMU_FP4V 0
#endif
#ifndef CVT_PIPE
#define CVT_PIPE 0
#endif
typedef float f32x2v __attribute__((ext_vector_type(2)));
typedef float f32x16v __attribute__((ext_vector_type(16)));
typedef float f32x32v __attribute__((ext_vector_type(32)));
typedef unsigned u32x6v __attribute__((ext_vector_type(6)));
__device__ __forceinline__ u32x6v pack_fp6_32(const float (&e)[32], bool interleaved) {
    f32x16v s0, s1;
    if (interleaved) {
#pragma unroll
        for (int i = 0; i < 16; ++i) { s0[i] = e[2 * i]; s1[i] = e[2 * i + 1]; }
    } else {
#pragma unroll
        for (int i = 0; i < 16; ++i) { s0[i] = e[i]; s1[i] = e[16 + i]; }
    }
    return __builtin_amdgcn_cvt_scalef32_2xpk16_fp6_f32(s0, s1, 1.0f);
}
__device__ __forceinline__ void cvt_table_fp6(const float* src, unsigned char* dst, int nrows, float scale, LAS float* scr  , int lane, int gw, int NGW, const int isv) {
    bool interleaved;
    {
        float t[32];
#pragma unroll
        for (int k = 0; k < 32; ++k) t[k] = k < 16 ? 0.125f * k : (k < 24 ? 2.0f + 0.25f * (k - 16) : 4.0f + 0.5f * (k - 24));
        float tt[32];
#pragma unroll
        for (int k = 0; k < 32; ++k) { tt[k] = t[k]; asm volatile("" : "+v"(tt[k])); }
        const u32x6v p = pack_fp6_32(tt, true);
        const f32x32v o = __builtin_amdgcn_cvt_scalef32_pk32_f32_fp6(p, 1.0f);
        interleaved = (o[1] == t[1]) && (o[2] == t[2]) && (o[17] == t[17]);
        interleaved = __all(interleaved);
    }
#if CVT_PIPE
    f32x4 nx[8];
    if (gw < nrows) { const f32x4* s4 = (const f32x4*)(src + (size_t)gw * 2048);
#pragma unroll
        for (int q = 0; q < 8; ++q) nx[q] = s4[64 * q + lane]; }
    for (int row = gw; row < nrows; row += NGW) {
        f32x4 cur[8];
#pragma unroll
        for (int q = 0; q < 8; ++q) cur[q] = nx[q];
        if (row + NGW < nrows) { const f32x4* s4 = (const f32x4*)(src + (size_t)(row + NGW) * 2048);
#pragma unroll
            for (int q = 0; q < 8; ++q) nx[q] = s4[64 * q + lane]; }
#pragma unroll
        for (int q = 0; q < 8; ++q) { const int s = 64 * q + lane; const f32x4 a = cur[q] * scale; *(LAS f32x4*)(scr + 4 * (s ^ ((s >> 4) & 7))) = a; }
#else
    bool fp4_swapped = false;
    if (PEER_V4) {
        float t0 = 1.0f, t1 = 2.0f; asm volatile("" : "+v"(t0), "+v"(t1));
        const unsigned pw = __builtin_amdgcn_cvt_scalef32_pk_fp4_f32(0u, t0, t1, 1.0f, 0);
        const f32x2v pr = __builtin_amdgcn_cvt_scalef32_pk_f32_fp4(pw, 1.0f, 0);
        fp4_swapped = !__all(pr[0] == 1.0f);
    }
    for (int row = gw; row < nrows; row += NGW) {
        const f32x4* s4 = (const f32x4*)(src + (size_t)row * 2048);
#pragma unroll
        for (int q = 0; q < 8; ++q) { const int s = 64 * q + lane; const f32x4 a = (NT_STREAM ? __builtin_nontemporal_load(&s4[s]) : s4[s]) * scale; *(LAS f32x4*)(scr + 4 * (s ^ ((s >> 4) & 7))) = a; }
#endif
        float e[32];
#pragma unroll
        for (int j = 0; j < 8; ++j) { const int s = 8 * lane + j; const f32x4 a = *(const LAS f32x4*)(scr + 4 * (s ^ ((s >> 4) & 7)));
            e[4 * j + 0] = __builtin_amdgcn_fmed3f(a.x, -7.5f, 7.5f); e[4 * j + 1] = __builtin_amdgcn_fmed3f(a.y, -7.5f, 7.5f); e[4 * j + 2] = __builtin_amdgcn_fmed3f(a.z, -7.5f, 7.5f); e[4 * j + 3] = __builtin_amdgcn_fmed3f(a.w, -7.5f, 7.5f); }
#if EMU_FP4V
        if (EMU_FP4V == 2 ? !isv : isv) {
#pragma unroll
            for (int i = 0; i < 32; ++i) { const float a = fabsf(e[i]); float q = a < 2.0f ? rintf(a * 2.0f) * 0.5f : (a < 4.0f ? rintf(a) : fminf(rintf(a * 0.5f) * 2.0f, 6.0f)); e[i] = copysignf(q, e[i]); }
        }
#endif
        unsigned char* rowp = dst + (size_t)row * PREC;
        if (PEER_V4 && (isv || PEER_U4)) {
            u32x4 w4;
#pragma unroll
            for (int w = 0; w < 4; ++w) { unsigned d = 0u; float x_[8];
#pragma unroll
                for (int i = 0; i < 8; i += 2) { const float x0 = __builtin_amdgcn_fmed3f(e[8 * w + i], -6.0f, 6.0f), x1 = __builtin_amdgcn_fmed3f(e[8 * w + i + 1], -6.0f, 6.0f); x_[i] = fp4_swapped ? x1 : x0; x_[i + 1] = fp4_swapped ? x0 : x1; }
                d = __builtin_amdgcn_cvt_scalef32_pk_fp4_f32(d, x_[0], x_[1], 1.0f, 0); d = __builtin_amdgcn_cvt_scalef32_pk_fp4_f32(d, x_[2], x_[3], 1.0f, 1);
                d = __builtin_amdgcn_cvt_scalef32_pk_fp4_f32(d, x_[4], x_[5], 1.0f, 2); d = __builtin_amdgcn_cvt_scalef32_pk_fp4_f32(d, x_[6], x_[7], 1.0f, 3);
                w4[w] = d; }
            *(u32x4*)(rowp + ((isv || !PEER_U4) ? 1024 : 0) + 16 * lane) = w4;
            continue;
        }
        const u32x6v p = pack_fp6_32(e, interleaved);
        *(u32x4*)(rowp + 1024 * isv + 16 * lane) = (u32x4){p[0], p[1], p[2], p[3]}; *(u32x2*)(rowp + 2048 + 512 * isv + 8 * lane) = (u32x2){p[4], p[5]};
    }
}
__device__ __forceinline__ float silu(float x) { return x / (1.0f + __expf(-x)); }

struct Params { const float* in[29]; float* out; unsigned char* ws; int ph_lo, ph_hi; };
typedef const __attribute__((address_space(4))) Params* CP;

#ifndef P0_NOV
#define P0_NOV 0
#endif
#ifndef TAIL_REMAP
#define TAIL_REMAP 0
#endif
__device__ __forceinline__ void p0_prologue(CP P, LAS unsigned char* lds, int tid, int lane, int wid, int gw, int NGW, const int parts = 7) {
    unsigned char* ws = P->ws;
    LAS float* scr = (LAS float*)(lds + wid * 16384);
    if (parts & 1) {
        constexpr int I_GMIN = (2048 / 64) * (4096 / 32), I_SQ = (2048 / 64) * (2048 / 32), I_MIN = (2048 / 64) * (1088 / 32), I_UQ = (512 / 64) * (3072 / 32), I_UKV = (512 / 64) * (4096 / 32), I_DIN = (2048 / 64) * (6144 / 32);
        constexpr int NIT = 2 * I_GMIN + 2 * I_SQ + 4 * I_SQ + I_MIN + I_UQ + I_UKV + I_SQ + I_DIN + I_SQ;
        for (int it = gw; it < NIT; it += NGW) {
            int r = it;
            if (r < 2 * I_GMIN) { const int j = r / I_GMIN; p0_transpose_item(P->in[13] + (size_t)j * 2048 * 4096, 2048, 4096, (bf16*)(ws + WS_GMWIN) + (size_t)j * 4096 * 2048, scr, r % I_GMIN, lane); continue; } r -= 2 * I_GMIN;
            if (r < 2 * I_SQ) { const int j = r / I_SQ; p0_transpose_item(P->in[18] + (size_t)j * 2048 * 2048, 2048, 2048, (bf16*)(ws + WS_GMWOUT) + (size_t)j * 2048 * 2048, scr, r % I_SQ, lane); continue; } r -= 2 * I_SQ;
            if (r < 4 * I_SQ) { const int j = r / I_SQ; p0_transpose_item(P->in[8] + (size_t)j * 2048 * 2048, 2048, 2048, (bf16*)(ws + WS_PWQ) + (size_t)j * 2048 * 2048, scr, r % I_SQ, lane); continue; } r -= 4 * I_SQ;
            if (r < I_MIN) { p0_transpose_item(P->in[19], 2048, 1088, (bf16*)(ws + WS_MLAIN), scr, r, lane); continue; } r -= I_MIN;
            if (r < I_UQ) { p0_transpose_item(P->in[22], 512, 3072, (bf16*)(ws + WS_MLAUQ), scr, r, lane); continue; } r -= I_UQ;
            if (r < I_UKV) { p0_transpose_item(P->in[23], 512, 4096, (bf16*)(ws + WS_MLAUKV), scr, r, lane); continue; } r -= I_UKV;
            if (r < I_SQ) { p0_transpose_item(P->in[24], 2048, 2048, (bf16*)(ws + WS_MLAOUT), scr, r, lane); continue; } r -= I_SQ;
            if (r < I_DIN) { p0_transpose_item(P->in[25], 2048, 6144, (bf16*)(ws + WS_DAIN), scr, r, lane); continue; } r -= I_DIN;
            p0_transpose_item(P->in[28], 2048, 2048, (bf16*)(ws + WS_DAOUT), scr, r, lane);
        }
    }
    const size_t gtid = (size_t)gw * 64 + lane, gthreads = (size_t)NGW * 64;
    if (parts & 2) {
    { u32x4* z = (u32x4*)((bf16*)(ws + WS_MLAIN) + (size_t)1088 * 2048); const size_t n = (size_t)192 * 2048 / 8;
      for (size_t i = gtid; i < n; i += gthreads) z[i] = (u32x4){0u, 0u, 0u, 0u}; }
    cvt_range(P->in[16], (bf16*)(ws + WS_GMWS), (size_t)2 * 16 * 128 * 128 / 8, gtid, gthreads);
    cvt_range(P->in[9], (bf16*)(ws + WS_PK1), (size_t)4 * 128 * 128 / 8, gtid, gthreads);
    cvt_range(P->in[10], (bf16*)(ws + WS_PK2), (size_t)4 * 128 * 128 / 8, gtid, gthreads);
#if !TAIL_REMAP
    cvt_table_fp6(P->in[11], ws + WS_PU, 16384, U_SCALE, scr, lane, gw, NGW, 0);
    if (!P0_NOV) cvt_table_fp6(P->in[12], ws + WS_PU, 16384, V_SCALE, scr, lane, gw, NGW, 1);
#endif
    if (gtid < 2048) { const int pos = (int)gtid >> 4, f = (int)gtid & 15; const float inv = powf(10000.0f, -(float)f * (1.0f / 16.0f)); float sn, cs; sincosf((float)pos * inv, &sn, &cs);
        float* rt = (float*)(ws + WS_ROPE); rt[gtid] = cs; rt[2048 + gtid] = sn; }
    }
    if (parts & 4) {
        const float* cv = P->in[1]; const float* cc = P->in[3]; const float* mw = P->in[4]; float* PART = (float*)(ws + WS_MODP);
        LAS float* S = (LAS float*)lds;
        __syncthreads();
        { float t_[12];
#pragma unroll
          for (int t = 0; t < 12; ++t) { const int i = tid + t * NWAVES * 64, sl = i >> 11, kk = i & 2047; t_[t] = sl == 0 ? cv[kk] : (sl == 1 ? cv[2048 + kk] : cc[kk]); }
#pragma unroll
          for (int t = 0; t < 12; ++t) S[tid + t * NWAVES * 64] = silu(t_[t]); }
        __syncthreads();
        for (int item = gw; item < 4 * 192 * 8; item += NGW) {
            const int ks = item & 7, r = item >> 3, L = r / 192, n = (r % 192) * 64 + lane;
            const float* W = mw + (size_t)L * 2048 * 12288 + (size_t)(ks * 256) * 12288 + n;
            float a0 = 0.f, a1 = 0.f, a2 = 0.f;
#if GEMV_PIPE
#define GV_LD(dst_, kb_) do { _Pragma("unroll") for (int t = 0; t < 32; ++t) dst_[t] = NT_STREAM ? __builtin_nontemporal_load(&W[(size_t)((kb_) + t) * 12288]) : W[(size_t)((kb_) + t) * 12288]; } while (0)
            float wa[32], wb[32];
            GV_LD(wa, 0);
#pragma unroll 1
            for (int kb = 0; kb < 256; kb += 64) {
                GV_LD(wb, kb + 32);
#pragma unroll
                for (int t = 0; t < 32; ++t) { const int kk = ks * 256 + kb + t; a0 += S[kk] * wa[t]; a1 += S[2048 + kk] * wa[t]; a2 += S[4096 + kk] * wa[t]; }
                if (kb + 64 < 256) GV_LD(wa, kb + 64);
#pragma unroll
                for (int t = 0; t < 32; ++t) { const int kk = ks * 256 + kb + 32 + t; a0 += S[kk] * wb[t]; a1 += S[2048 + kk] * wb[t]; a2 += S[4096 + kk] * wb[t]; }
            }
#undef GV_LD
#else
#pragma unroll 32
            for (int k = 0; k < 256; ++k) { const int kk = ks * 256 + k; const float s0 = S[kk], s1 = S[2048 + kk], s2 = S[4096 + kk];
                const float w = NT_STREAM ? __builtin_nontemporal_load(&W[(size_t)k * 12288]) : W[(size_t)k * 12288]; a0 += s0 * w; a1 += s1 * w; a2 += s2 * w; }
#endif
            float* o = PART + ((size_t)ks * 4 + L) * 3 * 12288 + n;
            o[0] = a0; o[12288] = a1; o[24576] = a2;
        }
    }
}
__device__ __forceinline__ void mod_reduce(CP P, int gw, int lane, int NGW) {
    const float* PART = (const float*)(P->ws + WS_MODP); float* MOD = (float*)(P->ws + WS_MOD); const float* mb = P->in[5];
    for (int i = gw * 64 + lane; i < 4 * 3 * 12288; i += NGW * 64) {
        const int L = i / (3 * 12288), n = i % 12288;
        float s = mb[(size_t)L * 12288 + n];
#pragma unroll
        for (int ks = 0; ks < 8; ++ks) s += PART[(size_t)ks * 4 * 3 * 12288 + i];
        MOD[i] = s;
    }
}

__device__ __forceinline__ void load_row_f32_l(const LAS float* row, int lane, float (&v)[32]) {
#pragma unroll
    for (int j = 0; j < 4; ++j) { const f32x4 a = ((const LAS f32x4*)row)[128 * j + 2 * lane], b = ((const LAS f32x4*)row)[128 * j + 2 * lane + 1];
        v[8 * j + 0] = a.x; v[8 * j + 1] = a.y; v[8 * j + 2] = a.z; v[8 * j + 3] = a.w; v[8 * j + 4] = b.x; v[8 * j + 5] = b.y; v[8 * j + 6] = b.z; v[8 * j + 7] = b.w; }
}
__device__ __forceinline__ void first_row_pass(CP P, LAS unsigned char* lds, int tid, int lane, int gw, int NGW) {
    const float* MOD = (const float*)(P->ws + WS_MOD); bf16* X = (bf16*)(P->ws + WS_X); bf16* H = (bf16*)(P->ws + WS_H);
    LAS float* V = (LAS float*)lds;
    __syncthreads();
    { f32x4 t_[6];
#pragma unroll
      for (int vec = 0; vec < 6; ++vec) t_[vec] = ((const f32x4*)(MOD + (size_t)(vec >> 1) * 12288 + (size_t)(vec & 1) * 2048))[tid];
#pragma unroll
      for (int vec = 0; vec < 6; ++vec) ((LAS f32x4*)V)[vec * 512 + tid] = t_[vec]; }
    __syncthreads();
    for (int row = gw; row < MT; row += NGW) {
        const float* src = row < ML ? P->in[0] + (size_t)row * DM : P->in[2] + (size_t)(row - ML) * DM;
        float v[32]; if (NT_STREAM > 1) load_row_f32_nt(src, lane, v); else load_row_f32(src, lane, v);
        store_row_bf16(X + (size_t)row * DM, lane, v);
        const LAS float* mod = V + row_slot(row) * 4096;
        float mean, rstd; ln_stats(v, mean, rstd);
        float a[32], s[32]; load_row_f32_l(mod + 2048, lane, a); load_row_f32_l(mod, lane, s);
#pragma unroll
        for (int i = 0; i < 32; ++i) a[i] = (v[i] - mean) * rstd * (1.0f + a[i]) + s[i];
        store_row_bf16(H + (size_t)row * DM, lane, a);
    }
}
#ifndef POSTMIX_LDS
#define POSTMIX_LDS 1
#endif
__device__ __forceinline__ void post_mixer_pass_lds(CP P, int L, int Mrows, LAS unsigned char* lds, int tid, int lane, int gw, int NGW) {
    const float* MOD = (const float*)(P->ws + WS_MOD); bf16* X = (bf16*)(P->ws + WS_X); bf16* H = (bf16*)(P->ws + WS_H); const bf16* Y = (const bf16*)(P->ws + WS_Y);
    const float* lng = P->in[6] + (size_t)(L * 2 + 0) * DM; const float* lnb = P->in[7] + (size_t)(L * 2 + 0) * DM;
    LAS float* V = (LAS float*)lds;
    __syncthreads();
    { f32x4 t_[11];
#pragma unroll
      for (int vec = 0; vec < 11; ++vec) { const float* src = vec == 0 ? lng : (vec == 1 ? lnb : MOD + (size_t)(L * 3 + (vec - 2) / 3) * 12288 + (size_t)(2 + (vec - 2) % 3) * 2048);
          t_[vec] = ((const f32x4*)src)[tid]; }
#pragma unroll
      for (int vec = 0; vec < 11; ++vec) ((LAS f32x4*)V)[vec * 512 + tid] = t_[vec]; }
    __syncthreads();
    for (int row = gw; row < Mrows; row += NGW) {
        const LAS float* mv = V + (2 + 3 * row_slot(row)) * 2048;
        float z[32], y[32]; if (NT_ACT) { load_row_bf16_nt(X + (size_t)row * DM, lane, z); load_row_bf16_nt(Y + (size_t)row * DM, lane, y); } else { load_row_bf16(X + (size_t)row * DM, lane, z); load_row_bf16(Y + (size_t)row * DM, lane, y); }
        { float g[32]; load_row_f32_l(mv, lane, g);
#pragma unroll
          for (int i = 0; i < 32; ++i) z[i] = ALPHA * z[i] + g[i] * y[i]; }
        float mean, rstd; ln_stats(z, mean, rstd);
        { float g[32], b[32]; load_row_f32_l(V, lane, g); load_row_f32_l(V + 2048, lane, b);
#pragma unroll
          for (int i = 0; i < 32; ++i) z[i] = (z[i] - mean) * rstd * g[i] + b[i]; }
        store_row_bf16(X + (size_t)row * DM, lane, z);
        ln_stats(z, mean, rstd);
        { float a[32], s_[32]; load_row_f32_l(mv + 2 * 2048, lane, a); load_row_f32_l(mv + 2048, lane, s_);
#pragma unroll
          for (int i = 0; i < 32; ++i) a[i] = (z[i] - mean) * rstd * (1.0f + a[i]) + s_[i];
          store_row_bf16(H + (size_t)row * DM, lane, a); }
    }
}
__device__ __forceinline__ void post_mixer_pass(CP P, int L, int Mrows, int lane, int gw, int NGW) {
    const float* MOD = (const float*)(P->ws + WS_MOD); bf16* X = (bf16*)(P->ws + WS_X); bf16* H = (bf16*)(P->ws + WS_H); const bf16* Y = (const bf16*)(P->ws + WS_Y);
    const float* lng = P->in[6] + (size_t)(L * 2 + 0) * DM; const float* lnb = P->in[7] + (size_t)(L * 2 + 0) * DM;
    for (int row = gw; row < Mrows; row += NGW) {
        const float* mod = MOD + (size_t)(L * 3 + row_slot(row)) * 12288;
        float z[32], y[32], g[32]; load_row_bf16(X + (size_t)row * DM, lane, z); load_row_bf16(Y + (size_t)row * DM, lane, y); load_row_f32(mod + 2 * 2048, lane, g);
#pragma unroll
        for (int i = 0; i < 32; ++i) z[i] = ALPHA * z[i] + g[i] * y[i];
        finish_row<false>(z, lng, lnb, X + (size_t)row * DM, mod + 3 * 2048, mod + 4 * 2048, H + (size_t)row * DM, nullptr, lane);
    }
}
__device__ __forceinline__ void vstats_pass(CP P, int Mrows, int lane, int gw, int NGW) {
    const bf16* Z = (const bf16*)(P->ws + WS_Z); float* VST = (float*)(P->ws + WS_VST);
    for (int row = gw; row < Mrows; row += NGW) {
        float v[32]; load_row_bf16(Z + (size_t)row * 4096 + 2048, lane, v);
        float mean, rstd; ln_stats(v, mean, rstd);
        if (lane == 0) { VST[2 * row] = mean; VST[2 * row + 1] = rstd; }
    }
}
#define XB_TMO      128
#define XB_XCNT(j)  (256  + 64 * (j))
#define XB_XSUB(j)  (1280 + 64 * (j))
#define XB_XGEN(j)  (2304 + 64 * (j))
#define XB_TOP      3328
#define XB_TOPGEN   3392
#define XCD_BAR_WORDS 3456
#define XB_SPIN_CAP (1u << 18)

__device__ __forceinline__ unsigned xb_ld(unsigned* p)              { return __hip_atomic_load(p, __ATOMIC_RELAXED, __HIP_MEMORY_SCOPE_AGENT); }
__device__ __forceinline__ unsigned xb_add(unsigned* p, unsigned v) { return __hip_atomic_fetch_add(p, v, __ATOMIC_RELAXED, __HIP_MEMORY_SCOPE_AGENT); }
__device__ __forceinline__ unsigned xb_xcc_id() { return (unsigned)__builtin_amdgcn_s_getreg((3 << 11) | 20) & 0xFu; }
#define XB_SPIN(cond, bar) do { unsigned _sp = 0; while (cond) { __builtin_amdgcn_s_sleep(1); \
    if ((++_sp & 255u) == 0u) { if (xb_ld(&(bar)[XB_TMO])) break; if (_sp > XB_SPIN_CAP) { atomicAdd(&(bar)[XB_TMO], 1u); break; } } } } while (0)

struct XcdBarrier {
    unsigned* bar; unsigned x;
    volatile LAS unsigned* st;
};

__device__ __forceinline__ XcdBarrier xcd_barrier_post(unsigned* bar, volatile LAS unsigned* st, const bool t0) {
    XcdBarrier b; b.bar = bar; b.x = xb_xcc_id(); b.st = st;
    if (t0) (void)xb_add(&bar[XB_XCNT(b.x)], 1u);
    return b;
}
__device__ __forceinline__ void xcd_barrier_complete(unsigned* bar, unsigned x, unsigned& nloc, unsigned& nx) {
    const unsigned G = gridDim.x * gridDim.y * gridDim.z;
    unsigned sum, cnt, mine, sp = 0u;
    for (;;) {
        sum = 0u; cnt = 0u; mine = 0u;
#pragma unroll
        for (unsigned j = 0; j < 16; ++j) { const unsigned c = xb_ld(&bar[XB_XCNT(j)]); sum += c; cnt += (c > 0u) ? 1u : 0u; mine = (j == x) ? c : mine; }
        if (sum == G) break;
        __builtin_amdgcn_s_sleep(1);
        if ((++sp & 255u) == 0u) { if (xb_ld(&bar[XB_TMO])) break; if (sp > XB_SPIN_CAP) { atomicAdd(&bar[XB_TMO], 1u); break; } }
    }
    nloc = mine > 0u ? mine : 1u; nx = cnt > 0u ? cnt : 1u;
}

__device__ __attribute__((noinline)) void xcd_barrier(const XcdBarrier b, const bool t0) {
    asm volatile("s_waitcnt vmcnt(0)" ::: "memory");
    __syncthreads();
    if (t0) {
        unsigned* bar = b.bar;
        __builtin_amdgcn_s_waitcnt(0);
        unsigned nloc = b.st[0], nx = b.st[1];
        if (nloc == 0u) { xcd_barrier_complete(bar, b.x, nloc, nx); b.st[0] = nloc; b.st[1] = nx; }
        const unsigned old = xb_add(&bar[XB_XSUB(b.x)], 1u);
        const unsigned gen = old / nloc;
        if (old + 1u == (gen + 1u) * nloc) {
            __builtin_amdgcn_fence(__ATOMIC_RELEASE, "agent");
            asm volatile("s_waitcnt vmcnt(0)" ::: "memory");
            const unsigned og = xb_add(&bar[XB_TOP], 1u);
            const unsigned tg = og / nx;
            if (og + 1u == (tg + 1u) * nx) xb_add(&bar[XB_TOPGEN], 1u);
            else XB_SPIN(xb_ld(&bar[XB_TOPGEN]) == tg, bar);
            __builtin_amdgcn_fence(__ATOMIC_ACQUIRE, "agent");
            xb_add(&bar[XB_XGEN(b.x)], 1u);
            asm volatile("s_waitcnt vmcnt(0)" ::: "memory");
        } else {
            XB_SPIN(xb_ld(&bar[XB_XGEN(b.x)]) == gen, bar);
            __builtin_amdgcn_fence(__ATOMIC_ACQUIRE, "agent");
            asm volatile("s_waitcnt vmcnt(0)" ::: "memory");
        }
    }
    __syncthreads();
}

#ifndef SPATIAL_PIPE
#define SPATIAL_PIPE 1
#endif
#if SPATIAL_PIPE
#ifndef SPATIAL_OTILE
#define SPATIAL_OTILE 0
#endif
struct SpReg { u32x4 w[4]; float mean, rstd; bf16x8 a[4]; bf16 uu[SPATIAL_OTILE ? 1 : 32]; u32x4 uq[4]; float bsv[4]; };
__device__ __forceinline__ void sp_load(SpReg& R, const bf16* Z, const float* VST, const bf16* WS, const float* bs, int u, int tid, int lane, int wid) {
    const int c = u >> 4, g = u & 15, fr = lane & 15, fq = lane >> 4;
    { const int q = tid >> 2, dq = (tid & 3) * 32; const int row = c * 128 + q;
      R.mean = VST[2 * row]; R.rstd = VST[2 * row + 1];
      const bf16* src = Z + (size_t)row * 4096 + 2048 + g * 128 + dq;
#pragma unroll
      for (int t = 0; t < 4; ++t) R.w[t] = *(const u32x4*)(src + 8 * t); }
    const bf16* wrow = WS + (size_t)g * 128 * 128 + (size_t)(16 * wid + fr) * 128 + 8 * fq;
#pragma unroll
    for (int ks = 0; ks < 4; ++ks) R.a[ks] = *(const bf16x8*)(wrow + 32 * ks);
#pragma unroll
    for (int r = 0; r < 4; ++r) R.bsv[r] = bs[g * 128 + 16 * wid + fq * 4 + r];
#if SPATIAL_OTILE
#pragma unroll
    for (int t = 0; t < 4; ++t) { const int ch = tid + 512 * t, p = ch >> 4, d8 = (ch & 15) * 8; R.uq[t] = *(const u32x4*)(Z + (size_t)(c * 128 + p) * 4096 + g * 128 + d8); }
    R.uu[0] = 0;
#else
#pragma unroll
    for (int nb = 0; nb < 8; ++nb)
#pragma unroll
        for (int r = 0; r < 4; ++r) { const int p = 16 * wid + fq * 4 + r, d = 16 * nb + fr; R.uu[nb * 4 + r] = Z[(size_t)(c * 128 + p) * 4096 + g * 128 + d]; }
#endif
}
__device__ __forceinline__ void spatial_phase(CP P, int j, int Mrows, LAS unsigned char* lds_, int tid, int lane, int wid) {
    const bf16* Z = (const bf16*)(P->ws + WS_Z); const float* VST = (const float*)(P->ws + WS_VST); bf16* Gb = (bf16*)(P->ws + WS_G);
    const bf16* WS = (const bf16*)(P->ws + WS_GMWS) + (size_t)j * 16 * 128 * 128;
    const float* lng = P->in[14] + (size_t)j * DM; const float* lnb = P->in[15] + (size_t)j * DM; const float* bs = P->in[17] + (size_t)j * 16 * 128;
    LAS bf16* Vt = (LAS bf16*)(LAS unsigned char*)lds_;
    constexpr int VP = 136;
    const int nunits = (Mrows / 128) * 16;
    LAS float* LNl = (LAS float*)(lds_ + 36864);
    __syncthreads();
    { const f32x4 t0_ = ((const f32x4*)lng)[tid], t1_ = ((const f32x4*)lnb)[tid]; ((LAS f32x4*)LNl)[tid] = t0_; ((LAS f32x4*)LNl)[512 + tid] = t1_; }
    LAS float* Ot = (LAS float*)(lds_ + 53248);
    (void)Ot;
    SpReg nx;
    if ((int)blockIdx.x < nunits) sp_load(nx, Z, VST, WS, bs, blockIdx.x, tid, lane, wid);
    for (int u = blockIdx.x; u < nunits; u += gridDim.x) {
        const int c = u >> 4, g = u & 15;
        const SpReg cur = nx;
        if (u + (int)gridDim.x < nunits) sp_load(nx, Z, VST, WS, bs, u + gridDim.x, tid, lane, wid);
        __syncthreads();
        {
            const int q = tid >> 2, dq = (tid & 3) * 32;
#pragma unroll
            for (int t = 0; t < 4; ++t) { const u32x4 w = cur.w[t];
                float v[8] = {bflo(w.x), bfhi(w.x), bflo(w.y), bfhi(w.y), bflo(w.z), bfhi(w.z), bflo(w.w), bfhi(w.w)};
                const LAS float* gp = LNl + g * 128 + dq + 8 * t; const LAS float* bp = LNl + 2048 + g * 128 + dq + 8 * t;
#pragma unroll
                for (int i = 0; i < 8; ++i) { const float vn = (v[i] - cur.mean) * cur.rstd * gp[i] + bp[i]; Vt[(dq + 8 * t + i) * VP + (q ^ ((tid & 3) << 4))] = tobf1(vn); } }
        }
        __syncthreads();
        const int fr = lane & 15, fq = lane >> 4;
#pragma unroll
        for (int nb = 0; nb < 8; ++nb) {
            f32x4 acc = {0.f, 0.f, 0.f, 0.f};
#pragma unroll
            for (int ks = 0; ks < 4; ++ks) { const bf16x8 b = *(const LAS bf16x8*)(Vt + (16 * nb + fr) * VP + 8 * ((4 * ks + fq) ^ ((nb >> 1) << 1)));
                acc = __builtin_amdgcn_mfma_f32_16x16x32_bf16(cur.a[ks], b, acc, 0, 0, 0); }
#if SPATIAL_OTILE
#pragma unroll
            for (int r = 0; r < 4; ++r) Ot[(16 * wid + fq * 4 + r) * 132 + 16 * nb + fr] = acc[r] + cur.bsv[r];
#else
#pragma unroll
            for (int r = 0; r < 4; ++r) { const int p = 16 * wid + fq * 4 + r, d = 16 * nb + fr; const size_t grow = (size_t)(c * 128 + p);
                const float sv = acc[r] + cur.bsv[r];
                const float uu = bf1(cur.uu[nb * 4 + r]);
                Gb[grow * 2048 + g * 128 + d] = tobf1(uu * sv); }
#endif
        }
#if SPATIAL_OTILE
        __syncthreads();
#pragma unroll
        for (int t = 0; t < 4; ++t) { const int ch = tid + 512 * t, p = ch >> 4, d8 = (ch & 15) * 8;
            const LAS f32x4* op = (const LAS f32x4*)(Ot + p * 132 + d8); const f32x4 s0 = op[0], s1 = op[1]; const u32x4 uw = cur.uq[t];
            u32x4 o; o.x = cvtpk(bflo(uw.x) * s0.x, bfhi(uw.x) * s0.y); o.y = cvtpk(bflo(uw.y) * s0.z, bfhi(uw.y) * s0.w); o.z = cvtpk(bflo(uw.z) * s1.x, bfhi(uw.z) * s1.y); o.w = cvtpk(bflo(uw.w) * s1.z, bfhi(uw.w) * s1.w);
            *(u32x4*)(Gb + (size_t)(c * 128 + p) * 2048 + g * 128 + d8) = o; }
#endif
    }
}
#else
__device__ __forceinline__ void spatial_phase(CP P, int j, int Mrows, LAS unsigned char* lds_, int tid, int lane, int wid) {
    const bf16* Z = (const bf16*)(P->ws + WS_Z); const float* VST = (const float*)(P->ws + WS_VST); bf16* Gb = (bf16*)(P->ws + WS_G);
    const bf16* WS = (const bf16*)(P->ws + WS_GMWS) + (size_t)j * 16 * 128 * 128;
    const float* lng = P->in[14] + (size_t)j * DM; const float* lnb = P->in[15] + (size_t)j * DM; const float* bs = P->in[17] + (size_t)j * 16 * 128;
    LAS bf16* Vt = (LAS bf16*)(LAS unsigned char*)lds_;
    constexpr int VP = 136;
    const int nunits = (Mrows / 128) * 16;
    for (int u = blockIdx.x; u < nunits; u += gridDim.x) {
        const int c = u >> 4, g = u & 15;
        __syncthreads();
        {
            const int q = tid >> 2, dq = (tid & 3) * 32; const int row = c * 128 + q;
            const float mean = VST[2 * row], rstd = VST[2 * row + 1];
            const bf16* src = Z + (size_t)row * 4096 + 2048 + g * 128 + dq;
#pragma unroll
            for (int t = 0; t < 4; ++t) { const u32x4 w = *(const u32x4*)(src + 8 * t);
                float v[8] = {bflo(w.x), bfhi(w.x), bflo(w.y), bfhi(w.y), bflo(w.z), bfhi(w.z), bflo(w.w), bfhi(w.w)};
                const float* gp = lng + g * 128 + dq + 8 * t; const float* bp = lnb + g * 128 + dq + 8 * t;
#pragma unroll
                for (int i = 0; i < 8; ++i) { const float vn = (v[i] - mean) * rstd * gp[i] + bp[i]; Vt[(dq + 8 * t + i) * VP + q] = tobf1(vn); } }
        }
        __syncthreads();
        const int fr = lane & 15, fq = lane >> 4;
        bf16x8 a[4];
        const bf16* wrow = WS + (size_t)g * 128 * 128 + (size_t)(16 * wid + fr) * 128 + 8 * fq;
#pragma unroll
        for (int ks = 0; ks < 4; ++ks) a[ks] = *(const bf16x8*)(wrow + 32 * ks);
#pragma unroll
        for (int nb = 0; nb < 8; ++nb) {
            f32x4 acc = {0.f, 0.f, 0.f, 0.f};
#pragma unroll
            for (int ks = 0; ks < 4; ++ks) { const bf16x8 b = *(const LAS bf16x8*)(Vt + (16 * nb + fr) * VP + 32 * ks + 8 * fq);
                acc = __builtin_amdgcn_mfma_f32_16x16x32_bf16(a[ks], b, acc, 0, 0, 0); }
#pragma unroll
            for (int r = 0; r < 4; ++r) { const int p = 16 * wid + fq * 4 + r, d = 16 * nb + fr; const size_t grow = (size_t)(c * 128 + p);
                const float sv = acc[r] + bs[g * 128 + p];
                const float uu = bf1(Z[grow * 4096 + g * 128 + d]);
                Gb[grow * 2048 + g * 128 + d] = tobf1(uu * sv); }
        }
    }
}
#endif

__device__ __forceinline__ void rope_cs(int row, int l, float& cs, float& sn) {
    const int t = row & (SEQ - 1); const int pos = (l & 32) ? (t & 63) : (t >> 6);
    const float inv = powf(10000.0f, -(float)(l & 15) * (1.0f / 16.0f));
    const float ang = (float)pos * inv; sincosf(ang, &sn, &cs);
}
__device__ __forceinline__ float rope_apply(float x, int l, float cs, float sn) {
    const float p = lane_xor16(x, l);
    return (l & 16) ? (p * sn + x * cs) : (x * cs - p * sn);
}
__device__ __forceinline__ void mla_norm_pass(CP P, int lane, int gw, int NGW) {
    const bf16* C = (const bf16*)(P->ws + WS_C); bf16* CQN = (bf16*)(P->ws + WS_CQN); bf16* CKVN = (bf16*)(P->ws + WS_CKVN); bf16* KR = (bf16*)(P->ws + WS_KR);
    const float* qn = P->in[20]; const float* kvn = P->in[21];
    for (int row = gw; row < MT; row += NGW) {
        const bf16* c = C + (size_t)row * 1280;
#pragma unroll
        for (int part = 0; part < 2; ++part) {
            const u32x4 w = *(const u32x4*)(c + part * 512 + 8 * lane);
            float v[8] = {bflo(w.x), bfhi(w.x), bflo(w.y), bfhi(w.y), bflo(w.z), bfhi(w.z), bflo(w.w), bfhi(w.w)};
            float ss = 0.f;
#pragma unroll
            for (int i = 0; i < 8; ++i) ss += v[i] * v[i];
            const float r = 1.0f / sqrtf(wave_sum(ss) * (1.0f / 512.0f) + LN_EPS);
            const float* nw = (part ? kvn : qn) + 8 * lane;
            u32x4 o; o.x = cvtpk(v[0] * r * nw[0], v[1] * r * nw[1]); o.y = cvtpk(v[2] * r * nw[2], v[3] * r * nw[3]); o.z = cvtpk(v[4] * r * nw[4], v[5] * r * nw[5]); o.w = cvtpk(v[6] * r * nw[6], v[7] * r * nw[7]);
            *(u32x4*)((part ? CKVN : CQN) + (size_t)row * 512 + 8 * lane) = o;
        }
        float x = bf1(c[1024 + lane]);
        if (row < ML) { float cs, sn; rope_cs(row, lane, cs, sn); x = rope_apply(x, lane, cs, sn); }
        KR[(size_t)row * 64 + lane] = tobf1(x);
    }
}
__device__ __forceinline__ void rope_pass(bf16* buf, int ld, int col0, int nchunks, int cstride, int lane, int gw, int NGW) {
    for (int row = gw; row < ML; row += NGW) {
        float cs, sn; rope_cs(row, lane, cs, sn);
        bf16* r = buf + (size_t)row * ld + col0 + lane;
#pragma unroll 4
        for (int k = 0; k < nchunks; ++k) { const float x = bf1(r[k * cstride]); r[k * cstride] = tobf1(rope_apply(x, lane, cs, sn)); }
    }
}

namespace att {
#ifndef ATT_VPRE
#define ATT_VPRE 1
#endif
#ifndef ATT_LSUM
#define ATT_LSUM 1
#endif
#ifndef ATT_VSTCF
#define ATT_VSTCF 1
#endif
#ifndef ATT_DA_NQR
#define ATT_DA_NQR 4
#endif
#ifndef ATT_LEAN0
#define ATT_LEAN0 0
#endif
#ifndef ATT_LEAN
#define ATT_LEAN 1
#endif
#ifndef ATT_3STAGE
#define ATT_3STAGE 0
#endif
#ifndef ATT_QLATE
#define ATT_QLATE 1
#endif
#ifndef ATT_PRIO
#define ATT_PRIO 1
#endif
#ifndef ATT_KMAJOR
#define ATT_KMAJOR 0
#endif
#ifndef ATT_TRB
#define ATT_TRB 1
#endif
#ifndef ATT_STAGGER
#define ATT_STAGGER 0
#endif
#ifndef ATT_SDEPTH
#define ATT_SDEPTH(MODE) ((MODE) == 0 ? 1 : 1)
#endif
#ifndef ATT_PVPIPE
#define ATT_PVPIPE(MODE) ((MODE) == 1)
#endif
#define SBAR() __builtin_amdgcn_sched_barrier(0)
__device__ __forceinline__ int crow(int r, int hi) { return (r & 3) + 8 * (r >> 2) + 4 * hi; }
__device__ __forceinline__ unsigned cvtpkv(float lo, float hi) { unsigned r; asm volatile("v_cvt_pk_bf16_f32 %0, %1, %2" : "=v"(r) : "v"(lo), "v"(hi)); return r; }

__device__ __forceinline__ void partialSM(f32x16& p0, f32x16& p1, float& m_reg, float& mn, float& alpha, const float C, const float THRS) {
  float pmax = p0[0];
#pragma unroll
  for (int r = 1; r < 16; ++r) pmax = fmaxf(pmax, p0[r]);
#pragma unroll
  for (int r = 0; r < 16; ++r) pmax = fmaxf(pmax, p1[r]);
  { auto rr = __builtin_amdgcn_permlane32_swap(__float_as_uint(pmax), __float_as_uint(pmax), false, false);
    pmax = fmaxf(__uint_as_float(rr[0]), __uint_as_float(rr[1])); }
  if (__builtin_expect(__all(pmax - m_reg <= THRS), 1)) { mn = m_reg; alpha = 1.f; }
  else { mn = fmaxf(m_reg, pmax); alpha = __builtin_amdgcn_exp2f((m_reg - mn) * C); m_reg = mn; }
  const float mnC = -mn * C;
#pragma unroll
  for (int r = 0; r < 16; ++r) p0[r] = fmaf(p0[r], C, mnC);
#pragma unroll
  for (int r = 0; r < 16; ++r) p1[r] = fmaf(p1[r], C, mnC);
#pragma unroll
  for (int r = 0; r < 16; ++r) p0[r] = __builtin_amdgcn_exp2f(p0[r]);
}
__device__ __forceinline__ void finishSM(f32x16& p0, f32x16& p1, float alpha, float& l_reg, bf16x8& pa0, bf16x8& pa1, bf16x8& pa2, bf16x8& pa3) {
#pragma unroll
  for (int r = 0; r < 16; ++r) p1[r] = __builtin_amdgcn_exp2f(p1[r]);
  float ps = 0;
#pragma unroll
  for (int r = 0; r < 16; ++r) ps += p0[r];
#pragma unroll
  for (int r = 0; r < 16; ++r) ps += p1[r];
  { auto rr = __builtin_amdgcn_permlane32_swap(__float_as_uint(ps), __float_as_uint(ps), false, false);
    ps = __uint_as_float(rr[0]) + __uint_as_float(rr[1]); }
  l_reg = l_reg * alpha + ps;
#define PK4(P, BASE, OUT) do { unsigned a0 = cvtpkv(P[BASE + 0], P[BASE + 1]), a1 = cvtpkv(P[BASE + 2], P[BASE + 3]);   \
    unsigned b0 = cvtpkv(P[BASE + 4], P[BASE + 5]), b1 = cvtpkv(P[BASE + 6], P[BASE + 7]);                              \
    auto r0 = __builtin_amdgcn_permlane32_swap(a0, b0, false, false); auto r1 = __builtin_amdgcn_permlane32_swap(a1, b1, false, false); \
    u32x4 w = {r0[0], r1[0], r0[1], r1[1]}; OUT = *reinterpret_cast<bf16x8*>(&w); } while (0)
  PK4(p0, 0, pa0); PK4(p0, 8, pa1); PK4(p1, 0, pa2); PK4(p1, 8, pa3);
#undef PK4
}
__device__ __forceinline__ void partialSM_lean(f32x16& p0, f32x16& p1, f32x16& nm, float& alpha, const bool first) {
  constexpr float THR2 = 11.541560327111707f;
  float dmax = p0[0];
#pragma unroll
  for (int r = 1; r < 16; ++r) dmax = fmaxf(dmax, p0[r]);
#pragma unroll
  for (int r = 0; r < 16; ++r) dmax = fmaxf(dmax, p1[r]);
  { auto rr = __builtin_amdgcn_permlane32_swap(__float_as_uint(dmax), __float_as_uint(dmax), false, false);
    dmax = fmaxf(__uint_as_float(rr[0]), __uint_as_float(rr[1])); }
  alpha = 1.f;
  if (first || !__all(dmax <= THR2)) {
    const float delta = first ? dmax : (dmax > THR2 ? dmax : 0.f);
    if (!first) alpha = __builtin_amdgcn_exp2f(-delta);
#pragma unroll
    for (int r = 0; r < 16; ++r) { p0[r] -= delta; p1[r] -= delta; nm[r] -= delta; }
  }
#pragma unroll
  for (int r = 0; r < 16; ++r) p0[r] = __builtin_amdgcn_exp2f(p0[r]);
}
template <bool LS> __device__ __forceinline__ void finishSM_lean(f32x16& p0, f32x16& p1, bf16x8& pa0, bf16x8& pa1, bf16x8& pa2, bf16x8& pa3, float& lrun) {
#pragma unroll
  for (int r = 0; r < 16; ++r) p1[r] = __builtin_amdgcn_exp2f(p1[r]);
  if constexpr (LS) {
    typedef float f32x2_ __attribute__((ext_vector_type(2)));
    f32x2_ s0 = {p0[0], p0[1]}, s1 = {p1[0], p1[1]};
#pragma unroll
    for (int r = 2; r < 16; r += 2) { s0 += (f32x2_){p0[r], p0[r + 1]}; s1 += (f32x2_){p1[r], p1[r + 1]}; }
    s0 += s1; lrun += s0[0] + s0[1];
  }
#define PK4(P, BASE, OUT) do { unsigned a0 = cvtpkv(P[BASE + 0], P[BASE + 1]), a1 = cvtpkv(P[BASE + 2], P[BASE + 3]);   \
    unsigned b0 = cvtpkv(P[BASE + 4], P[BASE + 5]), b1 = cvtpkv(P[BASE + 6], P[BASE + 7]);                              \
    auto r0 = __builtin_amdgcn_permlane32_swap(a0, b0, false, false); auto r1 = __builtin_amdgcn_permlane32_swap(a1, b1, false, false); \
    u32x4 w = {r0[0], r1[0], r0[1], r1[1]}; OUT = *reinterpret_cast<bf16x8*>(&w); } while (0)
  PK4(p0, 0, pa0); PK4(p0, 8, pa1); PK4(p1, 0, pa2); PK4(p1, 8, pa3);
#undef PK4
}
__device__ __forceinline__ bf16x8 scale_bf16x8(bf16x8 v, float c) {
  const u32x4 w = *reinterpret_cast<u32x4*>(&v); u32x4 o;
  o.x = cvtpk(bflo(w.x) * c, bfhi(w.x) * c); o.y = cvtpk(bflo(w.y) * c, bfhi(w.y) * c); o.z = cvtpk(bflo(w.z) * c, bfhi(w.z) * c); o.w = cvtpk(bflo(w.w) * c, bfhi(w.w) * c);
  return *reinterpret_cast<bf16x8*>(&o);
}
template <int PITCH> __device__ __forceinline__ int kswz(int r) { return PITCH == 256 ? (r & 15) : ((r >> 1) & 7); }
template <int NQF, int NQR, int PITCH> __device__ __forceinline__ void qkt(f32x16& p0, f32x16& p1, const LAS char* Ks, int chunk0, const bf16x8* qr, const LAS char* ql, int r32, int hi, const f32x16 init = f32x16{}) {
  p0 = init; p1 = init;
  const int sw = kswz<PITCH>(r32);
#pragma unroll
  for (int d0 = 0; d0 < NQF; ++d0) { const int off = ((chunk0 + d0 * 2 + hi) ^ sw) * 16;
    const bf16x8 b0 = *(const LAS bf16x8*)(Ks + r32 * PITCH + off);
    const bf16x8 b1 = *(const LAS bf16x8*)(Ks + (32 + r32) * PITCH + off);
    const bf16x8 q = d0 < NQR ? qr[d0 < NQR ? d0 : 0] : *(const LAS bf16x8*)(ql + (d0 - NQR < 0 ? 0 : d0 - NQR) * 1024);
    p0 = __builtin_amdgcn_mfma_f32_32x32x16_bf16(b0, q, p0, 0, 0, 0);
    p1 = __builtin_amdgcn_mfma_f32_32x32x16_bf16(b1, q, p1, 0, 0, 0); }
}
__device__ __forceinline__ int v_st(int k, int c) { const int kk = (k & ~0xC) | ((k & 4) << 1) | ((k & 8) >> 1); return ((kk >> 3) * 4 + (c >> 5)) * 512 + ((kk & 7) * 32 + (c & 31)) * 2; }
__device__ __forceinline__ int v_rd_base(int lane) { return ((lane & 3) << 3) | (((lane >> 2) & 3) << 6) | (((lane >> 4) & 1) << 5) | (((lane >> 5) & 1) << 8); }
constexpr int v_rd_off(int d0, int ks, int half) { return d0 * 512 + ks * 4096 + half * 2048; }
template <int OFF> __device__ __forceinline__ s16x4 tr_read(int vb) {
  s16x4 r; asm volatile("ds_read_b64_tr_b16 %0, %1 offset:%2" : "=&v"(r) : "v"(vb), "i"(OFF) : "memory"); return r;
}
template <int D0> __device__ __forceinline__ void pv_one(f32x16& od, int vb, bf16x8 pa0, bf16x8 pa1, bf16x8 pa2, bf16x8 pa3) {
  const s16x4 l0 = tr_read<v_rd_off(D0, 0, 0)>(vb), h0 = tr_read<v_rd_off(D0, 0, 1)>(vb), l1 = tr_read<v_rd_off(D0, 1, 0)>(vb), h1 = tr_read<v_rd_off(D0, 1, 1)>(vb);
  const s16x4 l2 = tr_read<v_rd_off(D0, 2, 0)>(vb), h2 = tr_read<v_rd_off(D0, 2, 1)>(vb), l3 = tr_read<v_rd_off(D0, 3, 0)>(vb), h3 = tr_read<v_rd_off(D0, 3, 1)>(vb);
  asm volatile("s_waitcnt lgkmcnt(0)" ::: "memory"); SBAR();
#define PK(L, H) (bf16x8){L[0], L[1], L[2], L[3], H[0], H[1], H[2], H[3]}
  od = __builtin_amdgcn_mfma_f32_32x32x16_bf16(pa0, PK(l0, h0), od, 0, 0, 0);
  od = __builtin_amdgcn_mfma_f32_32x32x16_bf16(pa1, PK(l1, h1), od, 0, 0, 0);
  od = __builtin_amdgcn_mfma_f32_32x32x16_bf16(pa2, PK(l2, h2), od, 0, 0, 0);
  od = __builtin_amdgcn_mfma_f32_32x32x16_bf16(pa3, PK(l3, h3), od, 0, 0, 0);
#undef PK
}
__device__ __forceinline__ void pv_d0(f32x16* o, int vb, bf16x8 pa0, bf16x8 pa1, bf16x8 pa2, bf16x8 pa3) {
  pv_one<0>(o[0], vb, pa0, pa1, pa2, pa3); pv_one<1>(o[1], vb, pa0, pa1, pa2, pa3); pv_one<2>(o[2], vb, pa0, pa1, pa2, pa3); pv_one<3>(o[3], vb, pa0, pa1, pa2, pa3);
}
struct VFrag { s16x4 l0, h0, l1, h1, l2, h2, l3, h3; };
typedef short v4i16_t __attribute__((ext_vector_type(4)));
template <int OFF> __device__ __forceinline__ s16x4 tr_read_b(int vb) {
  return __builtin_bit_cast(s16x4, __builtin_amdgcn_ds_read_tr16_b64_v4i16((LAS v4i16_t*)(uintptr_t)(unsigned)(vb + OFF)));
}
template <int D0> __device__ __forceinline__ void tr8b(VFrag& f, int vb) {
  f.l0 = tr_read_b<v_rd_off(D0, 0, 0)>(vb); f.h0 = tr_read_b<v_rd_off(D0, 0, 1)>(vb); f.l1 = tr_read_b<v_rd_off(D0, 1, 0)>(vb); f.h1 = tr_read_b<v_rd_off(D0, 1, 1)>(vb);
  f.l2 = tr_read_b<v_rd_off(D0, 2, 0)>(vb); f.h2 = tr_read_b<v_rd_off(D0, 2, 1)>(vb); f.l3 = tr_read_b<v_rd_off(D0, 3, 0)>(vb); f.h3 = tr_read_b<v_rd_off(D0, 3, 1)>(vb);
}
template <int D0> __device__ __forceinline__ void tr8(VFrag& f, int vb) {
  f.l0 = tr_read<v_rd_off(D0, 0, 0)>(vb); f.h0 = tr_read<v_rd_off(D0, 0, 1)>(vb); f.l1 = tr_read<v_rd_off(D0, 1, 0)>(vb); f.h1 = tr_read<v_rd_off(D0, 1, 1)>(vb);
  f.l2 = tr_read<v_rd_off(D0, 2, 0)>(vb); f.h2 = tr_read<v_rd_off(D0, 2, 1)>(vb); f.l3 = tr_read<v_rd_off(D0, 3, 0)>(vb); f.h3 = tr_read<v_rd_off(D0, 3, 1)>(vb);
}
__device__ __forceinline__ void mfma4(f32x16& od, VFrag& f, bf16x8 pa0, bf16x8 pa1, bf16x8 pa2, bf16x8 pa3) {
#define PK(L, H) (bf16x8){L[0], L[1], L[2], L[3], H[0], H[1], H[2], H[3]}
  od = __builtin_amdgcn_mfma_f32_32x32x16_bf16(pa0, PK(f.l0, f.h0), od, 0, 0, 0);
  od = __builtin_amdgcn_mfma_f32_32x32x16_bf16(pa1, PK(f.l1, f.h1), od, 0, 0, 0);
  od = __builtin_amdgcn_mfma_f32_32x32x16_bf16(pa2, PK(f.l2, f.h2), od, 0, 0, 0);
  od = __builtin_amdgcn_mfma_f32_32x32x16_bf16(pa3, PK(f.l3, f.h3), od, 0, 0, 0);
#undef PK
}
#define VF_TIE(f) "+v"(f.l0), "+v"(f.h0), "+v"(f.l1), "+v"(f.h1), "+v"(f.l2), "+v"(f.h2), "+v"(f.l3), "+v"(f.h3)
__device__ __forceinline__ void pv_pipe(f32x16* o, int vb, bf16x8 pa0, bf16x8 pa1, bf16x8 pa2, bf16x8 pa3) {
  VFrag A, B;
  asm volatile("s_waitcnt lgkmcnt(0)" ::: "memory");
  tr8<0>(A, vb); tr8<1>(B, vb);
  asm volatile("s_waitcnt lgkmcnt(8)" : VF_TIE(A) :: "memory");
  mfma4(o[0], A, pa0, pa1, pa2, pa3);
  tr8<2>(A, vb);
  asm volatile("s_waitcnt lgkmcnt(8)" : VF_TIE(B) :: "memory");
  mfma4(o[1], B, pa0, pa1, pa2, pa3);
  tr8<3>(B, vb);
  asm volatile("s_waitcnt lgkmcnt(8)" : VF_TIE(A) :: "memory");
  mfma4(o[2], A, pa0, pa1, pa2, pa3);
  asm volatile("s_waitcnt lgkmcnt(0)" : VF_TIE(B) :: "memory");
  mfma4(o[3], B, pa0, pa1, pa2, pa3);
}
template <bool ONES = true> __device__ __forceinline__ void pv_psm_lean(f32x16* o, int vb, bf16x8 pa0, bf16x8 pa1, bf16x8 pa2, bf16x8 pa3, f32x16& p0, f32x16& p1, f32x16& nm, float& alpha) {
  constexpr float THR2 = 11.541560327111707f;
  const bf16x8 one8 = {0x3F80, 0x3F80, 0x3F80, 0x3F80, 0x3F80, 0x3F80, 0x3F80, 0x3F80};
  VFrag A, B;
  asm volatile("s_waitcnt lgkmcnt(0)" ::: "memory");
  tr8<0>(A, vb); tr8<1>(B, vb);
  asm volatile("s_waitcnt lgkmcnt(8)" : VF_TIE(A) :: "memory");
  mfma4(o[0], A, pa0, pa1, pa2, pa3);
  float dmax = p0[0];
#pragma unroll
  for (int r = 1; r < 16; ++r) dmax = fmaxf(dmax, p0[r]);
  tr8<2>(A, vb);
  asm volatile("s_waitcnt lgkmcnt(8)" : VF_TIE(B) :: "memory");
  mfma4(o[1], B, pa0, pa1, pa2, pa3);
#pragma unroll
  for (int r = 0; r < 16; ++r) dmax = fmaxf(dmax, p1[r]);
  { auto rr = __builtin_amdgcn_permlane32_swap(__float_as_uint(dmax), __float_as_uint(dmax), false, false);
    dmax = fmaxf(__uint_as_float(rr[0]), __uint_as_float(rr[1])); }
  alpha = 1.f;
  if (!__all(dmax <= THR2)) {
    const float delta = dmax > THR2 ? dmax : 0.f; alpha = __builtin_amdgcn_exp2f(-delta);
#pragma unroll
    for (int r = 0; r < 16; ++r) { p0[r] -= delta; p1[r] -= delta; nm[r] -= delta; }
  }
  tr8<3>(B, vb);
  asm volatile("s_waitcnt lgkmcnt(8)" : VF_TIE(A) :: "memory");
  mfma4(o[2], A, pa0, pa1, pa2, pa3);
#pragma unroll
  for (int r = 0; r < 8; ++r) p0[r] = __builtin_amdgcn_exp2f(p0[r]);
  asm volatile("s_waitcnt lgkmcnt(0)" : VF_TIE(B) :: "memory");
  mfma4(o[3], B, pa0, pa1, pa2, pa3);
#pragma unroll
  for (int r = 8; r < 16; ++r) p0[r] = __builtin_amdgcn_exp2f(p0[r]);
  if constexpr (ONES) { o[4] = __builtin_amdgcn_mfma_f32_32x32x16_bf16(pa0, one8, o[4], 0, 0, 0); o[4] = __builtin_amdgcn_mfma_f32_32x32x16_bf16(pa1, one8, o[4], 0, 0, 0);
  o[4] = __builtin_amdgcn_mfma_f32_32x32x16_bf16(pa2, one8, o[4], 0, 0, 0); o[4] = __builtin_amdgcn_mfma_f32_32x32x16_bf16(pa3, one8, o[4], 0, 0, 0); }
}
template <bool ONES = true, bool PRE = false> __device__ __forceinline__ void pv_psm_lean_b(f32x16* o, int vb, bf16x8 pa0, bf16x8 pa1, bf16x8 pa2, bf16x8 pa3, f32x16& p0, f32x16& p1, f32x16& nm, float& alpha, const VFrag* pre = nullptr) {
  constexpr float THR2 = 11.541560327111707f;
  const bf16x8 one8 = {0x3F80, 0x3F80, 0x3F80, 0x3F80, 0x3F80, 0x3F80, 0x3F80, 0x3F80};
  VFrag A, B;
  if constexpr (PRE) A = *pre; else tr8b<0>(A, vb);
  tr8b<1>(B, vb);
  mfma4(o[0], A, pa0, pa1, pa2, pa3);
  float dmax = p0[0];
#pragma unroll
  for (int r = 1; r < 16; ++r) dmax = fmaxf(dmax, p0[r]);
  tr8b<2>(A, vb);
  mfma4(o[1], B, pa0, pa1, pa2, pa3);
#pragma unroll
  for (int r = 0; r < 16; ++r) dmax = fmaxf(dmax, p1[r]);
  { auto rr = __builtin_amdgcn_permlane32_swap(__float_as_uint(dmax), __float_as_uint(dmax), false, false);
    dmax = fmaxf(__uint_as_float(rr[0]), __uint_as_float(rr[1])); }
  alpha = 1.f;
  if (!__all(dmax <= THR2)) {
    const float delta = dmax > THR2 ? dmax : 0.f; alpha = __builtin_amdgcn_exp2f(-delta);
#pragma unroll
    for (int r = 0; r < 16; ++r) { p0[r] -= delta; p1[r] -= delta; nm[r] -= delta; }
  }
  tr8b<3>(B, vb);
  mfma4(o[2], A, pa0, pa1, pa2, pa3);
#pragma unroll
  for (int r = 0; r < 8; ++r) p0[r] = __builtin_amdgcn_exp2f(p0[r]);
  mfma4(o[3], B, pa0, pa1, pa2, pa3);
#pragma unroll
  for (int r = 8; r < 16; ++r) p0[r] = __builtin_amdgcn_exp2f(p0[r]);
  if constexpr (ONES) { o[4] = __builtin_amdgcn_mfma_f32_32x32x16_bf16(pa0, one8, o[4], 0, 0, 0); o[4] = __builtin_amdgcn_mfma_f32_32x32x16_bf16(pa1, one8, o[4], 0, 0, 0);
  o[4] = __builtin_amdgcn_mfma_f32_32x32x16_bf16(pa2, one8, o[4], 0, 0, 0); o[4] = __builtin_amdgcn_mfma_f32_32x32x16_bf16(pa3, one8, o[4], 0, 0, 0); }
}
struct VStep { s16x4 l0, h0, l1, h1, l2, h2, l3, h3; };
template <int KS> __device__ __forceinline__ void trstep(VStep& f, int vb) {
  f.l0 = tr_read_b<v_rd_off(0, KS, 0)>(vb); f.h0 = tr_read_b<v_rd_off(0, KS, 1)>(vb); f.l1 = tr_read_b<v_rd_off(1, KS, 0)>(vb); f.h1 = tr_read_b<v_rd_off(1, KS, 1)>(vb);
  f.l2 = tr_read_b<v_rd_off(2, KS, 0)>(vb); f.h2 = tr_read_b<v_rd_off(2, KS, 1)>(vb); f.l3 = tr_read_b<v_rd_off(3, KS, 0)>(vb); f.h3 = tr_read_b<v_rd_off(3, KS, 1)>(vb);
}
__device__ __forceinline__ void mfma5(f32x16* o, const VStep& f, bf16x8 pa) {
  const bf16x8 one8 = {0x3F80, 0x3F80, 0x3F80, 0x3F80, 0x3F80, 0x3F80, 0x3F80, 0x3F80};
#define PK(L, H) (bf16x8){L[0], L[1], L[2], L[3], H[0], H[1], H[2], H[3]}
  o[0] = __builtin_amdgcn_mfma_f32_32x32x16_bf16(pa, PK(f.l0, f.h0), o[0], 0, 0, 0);
  o[1] = __builtin_amdgcn_mfma_f32_32x32x16_bf16(pa, PK(f.l1, f.h1), o[1], 0, 0, 0);
  o[2] = __builtin_amdgcn_mfma_f32_32x32x16_bf16(pa, PK(f.l2, f.h2), o[2], 0, 0, 0);
  o[3] = __builtin_amdgcn_mfma_f32_32x32x16_bf16(pa, PK(f.l3, f.h3), o[3], 0, 0, 0);
  o[4] = __builtin_amdgcn_mfma_f32_32x32x16_bf16(pa, one8, o[4], 0, 0, 0);
#undef PK
}
template <int BASE> __device__ __forceinline__ bf16x8 pk4e(const f32x16& P) {
  const float e0 = __builtin_amdgcn_exp2f(P[BASE + 0]), e1 = __builtin_amdgcn_exp2f(P[BASE + 1]), e2 = __builtin_amdgcn_exp2f(P[BASE + 2]), e3 = __builtin_amdgcn_exp2f(P[BASE + 3]);
  const float e4 = __builtin_amdgcn_exp2f(P[BASE + 4]), e5 = __builtin_amdgcn_exp2f(P[BASE + 5]), e6 = __builtin_amdgcn_exp2f(P[BASE + 6]), e7 = __builtin_amdgcn_exp2f(P[BASE + 7]);
  const unsigned a0 = cvtpk(e0, e1), a1 = cvtpk(e2, e3), b0 = cvtpk(e4, e5), b1 = cvtpk(e6, e7);
  const auto r0 = __builtin_amdgcn_permlane32_swap(a0, b0, false, false); const auto r1 = __builtin_amdgcn_permlane32_swap(a1, b1, false, false);
  u32x4 w = {r0[0], r1[0], r0[1], r1[1]}; return *reinterpret_cast<bf16x8*>(&w);
}
__device__ __forceinline__ float rowmax_lean(const f32x16& p0, const f32x16& p1) {
  float d = p0[0];
#pragma unroll
  for (int r = 1; r < 16; ++r) d = fmaxf(d, p0[r]);
#pragma unroll
  for (int r = 0; r < 16; ++r) d = fmaxf(d, p1[r]);
  const auto rr = __builtin_amdgcn_permlane32_swap(__float_as_uint(d), __float_as_uint(d), false, false);
  return fmaxf(__uint_as_float(rr[0]), __uint_as_float(rr[1]));
}
__device__ __forceinline__ void shift_lean(float dmax, f32x16& p0, f32x16& p1, f32x16& nm, float& alpha, const bool first) {
  constexpr float THR2 = 11.541560327111707f;
  alpha = 1.f;
  if (first || !__all(dmax <= THR2)) {
    const float delta = first ? dmax : (dmax > THR2 ? dmax : 0.f);
    if (!first) alpha = __builtin_amdgcn_exp2f(-delta);
#pragma unroll
    for (int r = 0; r < 16; ++r) { p0[r] -= delta; p1[r] -= delta; nm[r] -= delta; }
  }
}
#define SGB(mask, n) __builtin_amdgcn_sched_group_barrier((mask), (n), 0)
__device__ __forceinline__ bf16x8 ld8(const bf16* p) { return *reinterpret_cast<const bf16x8*>(p); }

template <int MODE, int ATTV = 0>
__device__ __forceinline__ void attn_unit(const bf16* __restrict__ Qrow0, int ldq, const bf16* __restrict__ Kb, const bf16* __restrict__ Vb, int ldk, const bf16* __restrict__ KRb,
                                          int b, int nct, int NT, bf16* __restrict__ Ob, float lam, const float* __restrict__ subln, float oscale, LAS unsigned char* lds_, const int tid_in) {
  constexpr bool LEAN = ((MODE == 1) && ATT_LEAN) || ((MODE == 0) && ATT_LEAN0); constexpr bool LSUM = LEAN && ATT_LSUM && (MODE == 1); constexpr int NQF = MODE == 0 ? 12 : 4, NQR = MODE == 0 ? 6 : ATT_DA_NQR, NOB = (LEAN && !(ATT_LSUM && MODE == 1)) ? 5 : 4, PITCH = MODE == 0 ? 384 : 256, SHM_V = 16384, SHM_K = 64 * PITCH, SDEPTH = ATT_SDEPTH(MODE); constexpr bool PVPIPE = ATT_PVPIPE(MODE);
  const float SCALE = MODE == 0 ? 0.07216878364870323f : 0.125f;
  const float C = SCALE * 1.4426950408889634f, THRS = 8.f / SCALE;
  if (ATT_PRIO) { if (__builtin_amdgcn_readfirstlane(tid_in >> 8) != 0) __builtin_amdgcn_s_setprio(1); }
  const int tid = launder_v(tid_in) & 511, wid = tid >> 6, lane = tid & 63, r32 = lane & 31, hi = lane >> 5;
  LAS char* lds = (LAS char*)(LAS unsigned char*)lds_;
  constexpr bool THREE = (MODE == 1) && ATT_3STAGE; constexpr int NSTG = THREE ? 3 : 2, STG = SHM_V + SHM_K, SCR0 = NSTG * STG;
#define VOFF(s) (!THREE ? (s) * SHM_V : (s) * STG)
#define KOFF(s) (!THREE ? 2 * SHM_V + (s) * SHM_K : (s) * STG + SHM_V)
  LAS char* V_lds = lds; LAS char* K_lds = lds;
  LAS float* wsf = (LAS float*)(lds + NSTG * (SHM_V + SHM_K)) + wid * 64; LAS float* li_l = wsf; LAS float* al_l = wsf + 32;
  const int wq = MODE == 0 ? wid : (wid & 3), sgrp = MODE == 0 ? 0 : (wid >> 2);
  float m_reg = -1e30f, l_reg = 0; f32x16 o[NOB] = {}; bf16x8 qr[NQR > 0 ? NQR : 1]; f32x16 nm = {};
  LAS char* ql = lds + SCR0 + 2048 + wid * (MODE == 0 ? 8192 : 4096) + lane * 16;
  const bf16* Qw = Qrow0 + (size_t)(wq * 32 + r32) * ldq + sgrp * 64 + hi * 8;
#define QLOADS() do { _Pragma("unroll") for (int d0 = 0; d0 < NQR; ++d0) { qr[d0] = ld8(Qw + d0 * 16); if (LEAN) qr[d0] = scale_bf16x8(qr[d0], C); } \
    _Pragma("unroll") for (int d0 = NQR; d0 < NQF; ++d0) { bf16x8 qv = ld8(Qw + d0 * 16); if (LEAN) qv = scale_bf16x8(qv, C); *(LAS bf16x8*)(ql + (d0 - NQR) * 1024) = qv; } } while (0)
  constexpr bool QLATE = ATT_QLATE && !((MODE == 1) && ATT_3STAGE) && !((MODE == 1) && ATT_LEAN && ATT_KMAJOR && (ATTV == 0));
  if (!QLATE) QLOADS();
  const int sr = tid >> 4, sc = (tid & 15) * 8;
  const int srv = ATT_VSTCF ? (tid >> 6) * 4 + ((tid >> 2) & 3) : sr, scv = ATT_VSTCF ? ((tid >> 4) & 3) * 32 + (tid & 3) * 8 : sc;
  const int vst0 = v_st(srv, scv), vst1 = v_st(32 + srv, scv);
  const int kst0 = sr * PITCH + (((tid & 15) ^ kswz<PITCH>(sr)) * 16), kst1 = kst0 + 32 * PITCH;
  const int rrow = tid >> 3, krs = rrow * PITCH + (((16 + (tid & 7)) ^ kswz<PITCH>(rrow)) * 16);
  const int chunk0 = sgrp * 8;
  const int vb0 = (int)(uintptr_t)V_lds + v_rd_base(lane);
  struct Slot { bf16x8 vs0, vs1, ks0, ks1, kr; } sr_[SDEPTH];
#define KROW(jt) ((jt) < nct ? (ML + b * CTXL + (jt) * 64) : (b * SEQ + ((jt) - nct) * 64))
#define SLOAD(i, jt) do { const int k0_ = KROW(jt); sr_[i].vs0 = ld8(Vb + (size_t)(k0_ + srv) * ldk + scv); sr_[i].vs1 = ld8(Vb + (size_t)(k0_ + 32 + srv) * ldk + scv); \
    sr_[i].ks0 = ld8(Kb + (size_t)(k0_ + sr) * ldk + sc); sr_[i].ks1 = ld8(Kb + (size_t)(k0_ + 32 + sr) * ldk + sc); \
    if (MODE == 0) sr_[i].kr = ld8(KRb + (size_t)(k0_ + rrow) * 64 + (tid & 7) * 8); } while (0)
#define SWRITE(bf, i) do { *(LAS bf16x8*)(V_lds + VOFF(bf) + vst0) = sr_[i].vs0; *(LAS bf16x8*)(V_lds + VOFF(bf) + vst1) = sr_[i].vs1; \
    *(LAS bf16x8*)(K_lds + KOFF(bf) + kst0) = sr_[i].ks0; *(LAS bf16x8*)(K_lds + KOFF(bf) + kst1) = sr_[i].ks1; \
    if (MODE == 0) *(LAS bf16x8*)(K_lds + KOFF(bf) + krs) = sr_[i].kr; } while (0)
#define SWAIT() do { if constexpr (SDEPTH == 2) asm volatile("s_waitcnt vmcnt(4)" ::: "memory"); else asm volatile("s_waitcnt vmcnt(0)" ::: "memory"); } while (0)
#define RESC(a) do { if (__any((a) < 1.f)) { if constexpr (LSUM) l_reg *= (a); if (hi == 0) al_l[r32] = (a); asm volatile("s_waitcnt lgkmcnt(0)" ::: "memory"); \
    _Pragma("unroll") for (int d = 0; d < NOB; ++d) _Pragma("unroll") for (int r = 0; r < 16; ++r) o[d][r] *= al_l[crow(r, hi)]; } } while (0)
#define PV(vb_) do { if constexpr (ATTV == 2) { o[0][0] += __uint_as_float((unsigned)pa0[0] + (unsigned)pa3[1]); } else if constexpr (PVPIPE) pv_pipe(o, (vb_), pa0, pa1, pa2, pa3); else pv_d0(o, (vb_), pa0, pa1, pa2, pa3); \
    if constexpr (LEAN && !LSUM) { const bf16x8 one8 = {0x3F80, 0x3F80, 0x3F80, 0x3F80, 0x3F80, 0x3F80, 0x3F80, 0x3F80};     \
        o[NOB - 1] = __builtin_amdgcn_mfma_f32_32x32x16_bf16(pa0, one8, o[NOB - 1], 0, 0, 0); o[NOB - 1] = __builtin_amdgcn_mfma_f32_32x32x16_bf16(pa1, one8, o[NOB - 1], 0, 0, 0); \
        o[NOB - 1] = __builtin_amdgcn_mfma_f32_32x32x16_bf16(pa2, one8, o[NOB - 1], 0, 0, 0); o[NOB - 1] = __builtin_amdgcn_mfma_f32_32x32x16_bf16(pa3, one8, o[NOB - 1], 0, 0, 0); } } while (0)
#define PSM(p0_, p1_, mn_, al_, first_) do { if constexpr (ATTV == 1) { al_ = 1.f; } else if constexpr (LEAN) partialSM_lean(p0_, p1_, nm, al_, first_); else partialSM(p0_, p1_, m_reg, mn_, al_, C, THRS); } while (0)
#define FSM(p0_, p1_, al_) do { if constexpr (ATTV == 1) { u32x4 w0_ = {__float_as_uint(p0_[0]), __float_as_uint(p0_[1]), __float_as_uint(p1_[0]), __float_as_uint(p1_[1])}; pa0 = pa1 = pa2 = pa3 = *reinterpret_cast<bf16x8*>(&w0_); } else if constexpr (LEAN) finishSM_lean<LSUM>(p0_, p1_, pa0, pa1, pa2, pa3, l_reg); else finishSM(p0_, p1_, al_, l_reg, pa0, pa1, pa2, pa3); } while (0)
#define QKT(p0_, p1_, Kp_) do { if constexpr (ATTV == 5) { p0_ = nm; p1_ = nm; p0_[0] += (float)r32; } else if constexpr (LEAN) qkt<NQF, NQR, PITCH>(p0_, p1_, Kp_, chunk0, qr, ql, r32, hi, nm); else qkt<NQF, NQR, PITCH>(p0_, p1_, Kp_, chunk0, qr, ql, r32, hi); } while (0)
  f32x16 pA0, pA1, pB0, pB1; float mnA, mnB, alA, alB; bf16x8 pa0, pa1, pa2, pa3;
  constexpr bool KMAJ = (MODE == 1) && LEAN && ATT_KMAJOR && (ATTV == 0) && !THREE;
  if constexpr (KMAJ) {
    VStep VA, VB;
#define KSTEPS(PC0, PC1, ALC, PP0, PP1, KC, VP, LD, DOQK) do { const int vb_ = vb0 + VOFF(VP); float dmx_ = 0.f; \
      SBAR(); \
      if (DOQK) QKT(PC0, PC1, K_lds + KOFF(KC)); \
      pa0 = pk4e<0>(PP0); trstep<0>(VA, vb_); \
      _Pragma("unroll") for (int i_ = 0; i_ < 8; ++i_) { SGB(0x008, 1); SGB(0x100, 3); SGB(0x002, 2); } \
      SBAR(); LD; SBAR(); \
      mfma5(o, VA, pa0); pa1 = pk4e<8>(PP0); trstep<1>(VB, vb_); \
      _Pragma("unroll") for (int i_ = 0; i_ < 5; ++i_) { SGB(0x008, 1); SGB(0x100, 2); SGB(0x002, 3); } \
      SBAR(); \
      mfma5(o, VB, pa1); pa2 = pk4e<0>(PP1); trstep<2>(VA, vb_); \
      _Pragma("unroll") for (int i_ = 0; i_ < 5; ++i_) { SGB(0x008, 1); SGB(0x100, 2); SGB(0x002, 3); } \
      SBAR(); \
      mfma5(o, VA, pa2); pa3 = pk4e<8>(PP1); trstep<3>(VB, vb_); \
      _Pragma("unroll") for (int i_ = 0; i_ < 5; ++i_) { SGB(0x008, 1); SGB(0x100, 2); SGB(0x002, 3); } \
      SBAR(); \
      mfma5(o, VB, pa3); if (DOQK) dmx_ = rowmax_lean(PC0, PC1); \
      _Pragma("unroll") for (int i_ = 0; i_ < 5; ++i_) { SGB(0x008, 1); SGB(0x002, 7); } \
      SBAR(); \
      if (DOQK) shift_lean(dmx_, PC0, PC1, nm, ALC, false); } while (0)
    SLOAD(0, 0); asm volatile("s_waitcnt vmcnt(0)" ::: "memory"); SWRITE(0, 0); __syncthreads();
    QKT(pA0, pA1, K_lds + KOFF(0)); shift_lean(rowmax_lean(pA0, pA1), pA0, pA1, nm, alA, true);
    SLOAD(0, 1); asm volatile("s_waitcnt vmcnt(0)" ::: "memory"); SWRITE(1, 0); __syncthreads();
    for (int j = 1; j + 1 < NT; j += 2) {
      KSTEPS(pB0, pB1, alB, pA0, pA1, 1, 0, SLOAD(0, j + 1), true);
      __syncthreads(); asm volatile("s_waitcnt vmcnt(0)" ::: "memory"); SWRITE(0, 0);
      RESC(alB); __syncthreads();
      KSTEPS(pA0, pA1, alA, pB0, pB1, 0, 1, SLOAD(0, j + 2), true);
      __syncthreads(); asm volatile("s_waitcnt vmcnt(0)" ::: "memory"); SWRITE(1, 0);
      RESC(alA); __syncthreads();
    }
    KSTEPS(pB0, pB1, alB, pA0, pA1, 1, 0, (void)0, true);
    __syncthreads(); RESC(alB);
    KSTEPS(pA0, pA1, alA, pB0, pB1, 0, 1, (void)0, false);
#undef KSTEPS
  } else if constexpr (!THREE) {
  constexpr int SE = 0, SO = SDEPTH - 1;
  SLOAD(SE, 0); if (QLATE) QLOADS(); asm volatile("s_waitcnt vmcnt(0)" ::: "memory"); SWRITE(0, SE);
  if constexpr (QLATE && SDEPTH == 1) SLOAD(SO, 1);
  __syncthreads();
  QKT(pA0, pA1, K_lds + KOFF(0)); PSM(pA0, pA1, mnA, alA, true);
  if constexpr (!(QLATE && SDEPTH == 1)) SLOAD(SO, 1);
  if constexpr (SDEPTH == 2) { if (2 < NT) SLOAD(SE, 2); }
  SWAIT(); SWRITE(1, SO); __syncthreads();
#define ILV() do { if constexpr (PVPIPE) { _Pragma("unroll") for (int i_ = 0; i_ < 20; ++i_) { __builtin_amdgcn_sched_group_barrier(0x008, 1, 0); __builtin_amdgcn_sched_group_barrier(0x002, 5, 0); } } } while (0)
#define LSLOAD(i, jt) do { if constexpr (ATTV != 3) SLOAD(i, jt); } while (0)
#define LSWRITE(bf, i) do { if constexpr (ATTV != 3) SWRITE(bf, i); } while (0)
#define LSWAIT() do { if constexpr (ATTV != 3) SWAIT(); } while (0)
#define LSYNC() do { if constexpr (ATTV != 4) __syncthreads(); } while (0)
#define HALFSTEP(PC0, PC1, MNC, ALC, PP0, PP1, ALP, KC, VP, LD) do { \
    if (!STAG || wid < 4) { \
      VFrag vpre_; SBAR(); if constexpr (VPRE) tr8b<0>(vpre_, vb0 + VOFF(VP)); QKT(PC0, PC1, K_lds + KOFF(KC)); FSM(PP0, PP1, ALP); SBAR(); \
      LD; SBAR(); \
      if constexpr (PVPIPE && LEAN && ATTV == 0) { if constexpr (VPRE) pv_psm_lean_b<!LSUM, true>(o, vb0 + VOFF(VP), pa0, pa1, pa2, pa3, PC0, PC1, nm, ALC, &vpre_); else if constexpr (ATT_TRB) pv_psm_lean_b<!LSUM>(o, vb0 + VOFF(VP), pa0, pa1, pa2, pa3, PC0, PC1, nm, ALC); else pv_psm_lean<!LSUM>(o, vb0 + VOFF(VP), pa0, pa1, pa2, pa3, PC0, PC1, nm, ALC); } else { PV(vb0 + VOFF(VP)); PSM(PC0, PC1, MNC, ALC, false); } \
    } else { \
      SBAR(); FSM(PP0, PP1, ALP); SBAR(); \
      LD; SBAR(); \
      PV(vb0 + VOFF(VP)); SBAR(); \
      QKT(PC0, PC1, K_lds + KOFF(KC)); SBAR(); \
      PSM(PC0, PC1, MNC, ALC, false); \
    } } while (0)
  constexpr bool STAG = (MODE == 1) && ATT_STAGGER && ATTV == 0;
  constexpr bool VPRE = ATT_VPRE && PVPIPE && LEAN && LSUM && ATT_TRB && (ATTV == 0);
  for (int j = 1; j + 1 < NT; j += 2) {
    HALFSTEP(pB0, pB1, mnB, alB, pA0, pA1, alA, 1, 0, LSLOAD(SO, j + SDEPTH));
    LSYNC(); LSWAIT(); LSWRITE(0, SE);
    RESC(alB); LSYNC();
    HALFSTEP(pA0, pA1, mnA, alA, pB0, pB1, alB, 0, 1, if (SDEPTH == 1 || j + 3 < NT) LSLOAD(SE, j + 1 + SDEPTH));
    LSYNC(); LSWAIT(); LSWRITE(1, SO);
    RESC(alA); LSYNC();
  }
#undef HALFSTEP
#undef ILV
#undef LSLOAD
#undef LSWRITE
#undef LSWAIT
#undef LSYNC
  SBAR(); QKT(pB0, pB1, K_lds + KOFF(1));
  FSM(pA0, pA1, alA); SBAR();
  PV(vb0); PSM(pB0, pB1, mnB, alB, false);
  __syncthreads(); RESC(alB);
  FSM(pB0, pB1, alB); SBAR();
  PV(vb0 + VOFF(1));
  } else {
#define STEP(PC0, PC1, ALC, PP0, PP1, ALP, jj, SP, SC, SN) do { const int j_ = (jj); \
      if (j_ + 1 < NT) { asm volatile("s_waitcnt vmcnt(0)" ::: "memory"); SWRITE(SN, 0); if (j_ + 2 < NT) SLOAD(0, j_ + 2); } \
      SBAR(); QKT(PC0, PC1, K_lds + KOFF(SC)); FSM(PP0, PP1, ALP); SBAR(); \
      PV(vb0 + VOFF(SP)); PSM(PC0, PC1, mnA, ALC, false); \
      RESC(ALC); __syncthreads(); } while (0)
    SLOAD(0, 0); asm volatile("s_waitcnt vmcnt(0)" ::: "memory"); SWRITE(0, 0);
    SLOAD(0, 1); asm volatile("s_waitcnt vmcnt(0)" ::: "memory"); SWRITE(1, 0);
    SLOAD(0, 2); __syncthreads();
    QKT(pA0, pA1, K_lds + KOFF(0)); PSM(pA0, pA1, mnA, alA, true);
    STEP(pB0, pB1, alB, pA0, pA1, alA, 1, 0, 1, 2);
    int j = 2;
    for (; j + 5 < NT; j += 6) {
      STEP(pA0, pA1, alA, pB0, pB1, alB, j, 1, 2, 0);
      STEP(pB0, pB1, alB, pA0, pA1, alA, j + 1, 2, 0, 1);
      STEP(pA0, pA1, alA, pB0, pB1, alB, j + 2, 0, 1, 2);
      STEP(pB0, pB1, alB, pA0, pA1, alA, j + 3, 1, 2, 0);
      STEP(pA0, pA1, alA, pB0, pB1, alB, j + 4, 2, 0, 1);
      STEP(pB0, pB1, alB, pA0, pA1, alA, j + 5, 0, 1, 2);
    }
    if (j < NT) { STEP(pA0, pA1, alA, pB0, pB1, alB, j, 1, 2, 0); STEP(pB0, pB1, alB, pA0, pA1, alA, j + 1, 2, 0, 1); j += 2; }
    if (j < NT) { STEP(pA0, pA1, alA, pB0, pB1, alB, j, 0, 1, 2); STEP(pB0, pB1, alB, pA0, pA1, alA, j + 1, 1, 2, 0); j += 2; }
    FSM(pB0, pB1, alB); SBAR();
    { const int sl = (NT - 1) % 3; PV(vb0 + VOFF(sl)); }
#undef STEP
  }
  float rli[16];
  if constexpr (LEAN && !LSUM) {
#pragma unroll
    for (int r = 0; r < 16; ++r) rli[r] = __builtin_amdgcn_rcpf(o[NOB - 1][r]);
  } else {
    if constexpr (LSUM) l_reg += __uint_as_float(lane_xor32(__float_as_uint(l_reg), lane));
    if (hi == 0) li_l[r32] = l_reg; asm volatile("s_waitcnt lgkmcnt(0)" ::: "memory");
#pragma unroll
    for (int r = 0; r < 16; ++r) rli[r] = __builtin_amdgcn_rcpf(li_l[crow(r, hi)]);
  }
  bf16* Ow = Ob + (size_t)(wq * 32) * DM;
  if constexpr (MODE == 0) {
#pragma unroll
    for (int r = 0; r < 16; ++r) { const int orow = crow(r, hi);
#pragma unroll
      for (int d0 = 0; d0 < 4; ++d0) Ow[(size_t)orow * DM + d0 * 32 + r32] = tobf1(o[d0][r] * rli[r]); }
    __syncthreads();
  } else {
    LAS float* ex = (LAS float*)lds;
    __syncthreads();
    if (sgrp == 1) {
#pragma unroll
      for (int r = 0; r < 16; ++r)
#pragma unroll
        for (int d0 = 0; d0 < 4; ++d0) ex[(wq * 32 + crow(r, hi)) * 128 + d0 * 32 + r32] = o[d0][r] * rli[r];
    }
    __syncthreads();
    if (sgrp == 0) {
#pragma unroll
      for (int r = 0; r < 16; ++r) { const int orow = crow(r, hi); float dd[4]; float ss = 0.f;
#pragma unroll
        for (int d0 = 0; d0 < 4; ++d0) { dd[d0] = o[d0][r] * rli[r] - lam * ex[(wq * 32 + orow) * 128 + d0 * 32 + r32]; ss += dd[d0] * dd[d0]; }
        ss = half_sum32(ss);
        const float rs = oscale / sqrtf(ss * (1.0f / 128.0f) + LN_EPS);
#pragma unroll
        for (int d0 = 0; d0 < 4; ++d0) Ow[(size_t)orow * DM + d0 * 32 + r32] = tobf1(dd[d0] * rs * subln[d0 * 32 + r32]); }
    }
    __syncthreads();
  }
  if (ATT_PRIO) __builtin_amdgcn_s_setprio(0);
#undef VOFF
#undef KOFF
#undef PV
#undef PSM
#undef FSM
#undef QKT
#undef KROW
#undef SLOAD
#undef SWRITE
#undef SWAIT
#undef RESC
}
}

__device__ __forceinline__ void mla_attn_phase(CP P, LAS unsigned char* lds, const int tid) {
    const bf16* QM = (const bf16*)(P->ws + WS_QM); const bf16* KV = (const bf16*)(P->ws + WS_KV); const bf16* KR = (const bf16*)(P->ws + WS_KR); bf16* Gb = (bf16*)(P->ws + WS_G);
    const int c = blockIdx.x, G = gridDim.x;
    for (int u = c; u < 1024 + 32; u += G) {
        int b, h, qrow0, NT;
        if (u < 1024) { const int i = u >> 8, cc = u & 255; const int bh = (cc & 7) + 8 * i, qb = cc >> 3; b = bh >> 4; h = bh & 15; qrow0 = b * SEQ + qb * 256; NT = 4 + 128; }
        else { const int bh = u - 1024; b = bh >> 4; h = bh & 15; qrow0 = ML + b * CTXL; NT = 4; }
        att::attn_unit<0>(QM + (size_t)qrow0 * 3072 + h * 192, 3072, KV + h * 256, KV + h * 256 + 128, 4096, KR, b, 4, NT, Gb + (size_t)qrow0 * DM + h * 128, 0.f, nullptr, 1.f, lds, tid);
    }
}
template <int ATTV = 0>
__device__ __forceinline__ void da_attn_phase(CP P, float lam, float oscale, LAS unsigned char* lds, const int tid, const bool ctx_q, const int nt_cap = 0) {
    const bf16* Z = (const bf16*)(P->ws + WS_Z); bf16* Gb = (bf16*)(P->ws + WS_G); const float* subln = P->in[27];
    const int c = blockIdx.x, G = gridDim.x;
    for (int u = c; u < 2048 + (ctx_q ? 64 : 0); u += G) {
        int b, h, qrow0, NT;
        if (u < 2048) { const int i = u >> 8, cc = u & 255; const int bh = (cc & 7) + 8 * (i >> 1), qb = (cc >> 3) + 32 * (i & 1); b = bh >> 4; h = bh & 15; qrow0 = b * SEQ + qb * 128; NT = 4 + 128; }
        else { const int v = u - 2048; const int bh = v >> 1; b = bh >> 4; h = bh & 15; qrow0 = ML + b * CTXL + (v & 1) * 128; NT = 4; }
        if (nt_cap) NT = nt_cap;
        att::attn_unit<1, ATTV>(Z + (size_t)qrow0 * 6144 + h * 128, 6144, Z + 2048 + h * 128, Z + 4096 + h * 128, 6144, nullptr, b, 4, NT, Gb + (size_t)qrow0 * DM + h * 128, lam, subln, oscale, lds, tid);
    }
}

__device__ __forceinline__ unsigned f2ord(float f) { const unsigned u = __float_as_uint(f); return u ^ ((unsigned)((int)u >> 31) | 0x80000000u); }
__device__ __forceinline__ float ord2f(unsigned k) { return __uint_as_float((k & 0x80000000u) ? (k ^ 0x80000000u) : ~k); }
__device__ __forceinline__ void ce_desc(unsigned& a, unsigned& b) { const unsigned mx = a > b ? a : b, mn = a > b ? b : a; a = mx; b = mn; }
template <int N, bool DESC> __device__ __forceinline__ void bitonic_merge(unsigned* a) {
#pragma unroll
    for (int j = N / 2; j > 0; j >>= 1)
#pragma unroll
        for (int i = 0; i < N; ++i) { const int l = i ^ j; if (l > i) { if (DESC) ce_desc(a[i], a[l]); else ce_desc(a[l], a[i]); } }
}
template <int N, bool DESC> __device__ __forceinline__ void bitonic_sort(unsigned* a) {
#pragma unroll
    for (int k = 2; k <= N; k <<= 1)
#pragma unroll
        for (int j = k >> 1; j > 0; j >>= 1)
#pragma unroll
            for (int i = 0; i < N; ++i) { const int l = i ^ j; if (l > i) { const bool up = ((i & k) == 0); if (up == DESC) ce_desc(a[i], a[l]); else ce_desc(a[l], a[i]); } }
}
__device__ __forceinline__ void top16_of_64(unsigned (&a)[64]) {
    bitonic_sort<16, true>(a); bitonic_sort<16, false>(a + 16); bitonic_sort<16, true>(a + 32); bitonic_sort<16, false>(a + 48);
#pragma unroll
    for (int i = 0; i < 16; ++i) a[i] = a[i] > a[16 + i] ? a[i] : a[16 + i];
    bitonic_merge<16, true>(a);
#pragma unroll
    for (int i = 0; i < 16; ++i) a[32 + i] = a[32 + i] > a[48 + i] ? a[32 + i] : a[48 + i];
    bitonic_merge<16, false>(a + 32);
#pragma unroll
    for (int i = 0; i < 16; ++i) a[i] = a[i] > a[32 + i] ? a[i] : a[32 + i];
    bitonic_merge<16, true>(a);
}
template <int PASS> __device__ __forceinline__ void route_qload(const bf16* QP, int tok, int head, int hi, bf16x8 (&qf)[8]) {
    const bf16* qp = QP + (size_t)tok * DM + head * 256 + PASS * 128 + hi * 8;
#pragma unroll
    for (int ks = 0; ks < 8; ++ks) qf[ks] = NT_ACT ? __builtin_nontemporal_load((const bf16x8*)(qp + ks * 16)) : *(const bf16x8*)(qp + ks * 16);
}
template <int PASS> __device__ __forceinline__ void route_pass(const bf16x8 (&qf)[8], const LAS char* lds, int tok, int head, int r32, int hi, unsigned (&top)[16]) {
    f32x16 acc[4] = {};
    const LAS char* Kl = lds + PASS * 32768;
#pragma unroll
    for (int kb = 0; kb < 4; ++kb)
#pragma unroll
        for (int ks = 0; ks < 8; ++ks) { const bf16x8 a = *(const LAS bf16x8*)(Kl + (kb * 32 + r32) * 256 + (((ks * 2 + hi) ^ (r32 & 15)) * 16));
            acc[kb] = __builtin_amdgcn_mfma_f32_32x32x16_bf16(a, qf[ks], acc[kb], 0, 0, 0); }
    unsigned key[64]; const unsigned base = 127u - 4u * (unsigned)hi;
#pragma unroll
    for (int kb = 0; kb < 4; ++kb)
#pragma unroll
        for (int r = 0; r < 16; ++r) key[kb * 16 + r] = (f2ord(acc[kb][r]) & ~127u) | (base - (unsigned)(kb * 32 + (r & 3) + 8 * (r >> 2)));
    top16_of_64(key);
    unsigned pr[16];
#pragma unroll
    for (int i = 0; i < 16; ++i) pr[i] = lane_xor32(key[15 - i], hi << 5);
#pragma unroll
    for (int i = 0; i < 16; ++i) key[i] = key[i] > pr[i] ? key[i] : pr[i];
    bitonic_merge<16, true>(key);
#pragma unroll
    for (int i = 0; i < 16; ++i) top[i] = key[i];
}
#ifndef ROUTE_SORT
#define ROUTE_SORT 1
#endif
#define DPP_U(v, ctrl) ((unsigned)__builtin_amdgcn_mov_dpp((int)(v), (ctrl), 0xF, 0xF, true))
template <int J> __device__ __forceinline__ unsigned lane_xor_u(unsigned v, int lane) {
    if (J == 1) return DPP_U(v, 0xB1);
    if (J == 2) return DPP_U(v, 0x4E);
    if (J == 4) { const unsigned t = DPP_U(v, 0x141); return DPP_U(t, 0x1B); }
    if (J == 8) { const unsigned t = DPP_U(v, 0x140); return DPP_U(t, 0x141); }
    if (J == 16) { const auto r = __builtin_amdgcn_permlane16_swap(v, v, false, false); return (lane & 16) ? r[0] : r[1]; }
    return lane_xor32(v, lane);
}
template <int K, int J> __device__ __forceinline__ void sort128_stage(unsigned& a0, unsigned& a1, int lane) {
    if constexpr (J == 64) { const unsigned mn = a0 < a1 ? a0 : a1, mx = a0 < a1 ? a1 : a0; a0 = mn; a1 = mx; }
    else { const unsigned p0 = lane_xor_u<J>(a0, lane), p1 = lane_xor_u<J>(a1, lane);
        const bool lower = (lane & J) == 0;
        const bool asc0 = (K >= 64) ? true : ((lane & K) == 0), asc1 = (K == 128) ? true : (K == 64 ? false : ((lane & K) == 0));
        const unsigned mn0 = a0 < p0 ? a0 : p0, mx0 = a0 < p0 ? p0 : a0, mn1 = a1 < p1 ? a1 : p1, mx1 = a1 < p1 ? p1 : a1;
        a0 = (lower == asc0) ? mn0 : mx0; a1 = (lower == asc1) ? mn1 : mx1; }
    if constexpr (J > 1) sort128_stage<K, J / 2>(a0, a1, lane);
    else if constexpr (K < 128) sort128_stage<K * 2, K>(a0, a1, lane);
}
__device__ __forceinline__ void sort128_asc(unsigned& a0, unsigned& a1, int lane) { sort128_stage<2, 1>(a0, a1, lane); }
__device__ __forceinline__ void route_phase(CP P, int L, int Mrows, LAS unsigned char* lds_, int tid, int lane, int wid, int gw, int NGW) {
    const bf16* QP = (const bf16*)(P->ws + WS_QP); unsigned* ROUTE = (unsigned*)(P->ws + WS_ROUTE);
    LAS char* lds = (LAS char*)(LAS unsigned char*)lds_;
    __syncthreads();
    {
        const bf16* K1 = (const bf16*)(P->ws + WS_PK1) + (size_t)L * 128 * 128; const bf16* K2 = (const bf16*)(P->ws + WS_PK2) + (size_t)L * 128 * 128;
        u32x4 kw[8];
#pragma unroll
        for (int t = 0; t < 8; ++t) { const int c16 = tid + t * NWAVES * 64; const int mat = c16 >> 11, row = (c16 >> 4) & 127, ch = c16 & 15; kw[t] = *(const u32x4*)((mat ? K2 : K1) + row * 128 + ch * 8); }
#pragma unroll
        for (int t = 0; t < 8; ++t) { const int c16 = tid + t * NWAVES * 64; const int mat = c16 >> 11, row = (c16 >> 4) & 127, ch = c16 & 15; *(LAS u32x4*)(lds + mat * 32768 + row * 256 + ((ch ^ (row & 15)) * 16)) = kw[t]; }
    }
    __syncthreads();
    LAS unsigned* sc = (LAS unsigned*)(lds + 65536) + wid * 2048;
    const int r32 = lane & 31, hi = lane >> 5;
    for (int item = gw; item < Mrows / 4; item += NGW) {
        const int tok = item * 4 + (r32 >> 3), head = r32 & 7;
        unsigned top0[16], top1[16];
        { bf16x8 q0[8], q1[8]; route_qload<0>(QP, tok, head, hi, q0); route_qload<1>(QP, tok, head, hi, q1);
          route_pass<0>(q0, lds, tok, head, r32, hi, top0);
          route_pass<1>(q1, lds, tok, head, r32, hi, top1); }
        float v1[16], v2[16];
#pragma unroll
        for (int i = 0; i < 16; ++i) { v1[i] = ord2f(top0[i] & ~127u); v2[i] = ord2f(top1[i] & ~127u);
            sc[i * 64 + lane] = 127u - (top0[i] & 127u); sc[(16 + i) * 64 + lane] = 127u - (top1[i] & 127u); }
        unsigned ck[64]; int n = 0;
#pragma unroll
        for (int i = 0; i < 16; ++i)
#pragma unroll
            for (int j = 0; j < 16; ++j) if ((i + 1) * (j + 1) <= 16) { ck[n] = (f2ord(v1[i] + v2[j]) & ~255u) | (unsigned)(i * 16 + j); ++n; }
#pragma unroll
        for (int i = 50; i < 64; ++i) ck[i] = 0u;
        top16_of_64(ck);
        float ev[16]; float sum = 0.f; const float mx = ord2f(ck[0] & ~255u);
#pragma unroll
        for (int k = 0; k < 16; ++k) { ev[k] = __expf(ord2f(ck[k] & ~255u) - mx); sum += ev[k]; }
        const float inv = 1.0f / sum;
        unsigned ee[16];
#pragma unroll
        for (int k = 0; k < 16; ++k) { const unsigned pc = ck[k] & 255u; const unsigned i1 = sc[(pc >> 4) * 64 + lane], i2 = sc[(16 + (pc & 15u)) * 64 + lane]; ee[k] = i1 * 128u + i2; ev[k] *= inv; }
#if ROUTE_SORT
        { const int tq = r32 >> 3;
#pragma unroll
          for (int k = 0; k < 8; ++k) {
              const unsigned eL = ee[k], eH = ee[k + 8]; const float gL = ev[k], gH = ev[k + 8];
              sc[tq * 256 + head * 16 + hi * 8 + k] = hi ? eH : eL; sc[tq * 256 + 128 + head * 16 + hi * 8 + k] = __float_as_uint(hi ? gH : gL); }
#pragma unroll 1
          for (int t = 0; t < 4; ++t) {
              unsigned a0 = (sc[t * 256 + lane] << 7) | (unsigned)lane, a1 = (sc[t * 256 + 64 + lane] << 7) | (unsigned)(64 + lane);
              sort128_asc(a0, a1, lane);
              const unsigned g0 = sc[t * 256 + 128 + (a0 & 127u)], g1 = sc[t * 256 + 128 + (a1 & 127u)];
              u32x2* outp = (u32x2*)(ROUTE + (size_t)(item * 4 + t) * 256);
              outp[lane] = (u32x2){a0 >> 7, g0}; outp[64 + lane] = (u32x2){a1 >> 7, g1}; }
        }
#else
        u32x4* outp = (u32x4*)(ROUTE + ((size_t)tok * 128 + head * 16 + hi * 8) * 2);
#pragma unroll
        for (int k = 0; k < 8; k += 2) { u32x4 w;
            const unsigned eL0 = ee[k], eH0 = ee[k + 8], eL1 = ee[k + 1], eH1 = ee[k + 9]; const float gL0 = ev[k], gH0 = ev[k + 8], gL1 = ev[k + 1], gH1 = ev[k + 9];
            w.x = hi ? eH0 : eL0; w.y = __float_as_uint(hi ? gH0 : gL0); w.z = hi ? eH1 : eL1; w.w = __float_as_uint(hi ? gH1 : gL1);
            outp[k >> 1] = w; }
#endif
    }
}

typedef float f32x2 __attribute__((ext_vector_type(2)));
typedef float f32x32 __attribute__((ext_vector_type(32)));
typedef unsigned u32x6 __attribute__((ext_vector_type(6)));
typedef __bf16 bf16x32 __attribute__((ext_vector_type(32)));
typedef unsigned u32x16 __attribute__((ext_vector_type(16)));
typedef __bf16 bf16x2_t __attribute__((ext_vector_type(2)));
#ifndef GATHER_ZIGZAG
#define GATHER_ZIGZAG 0
#endif
#ifndef GATHER_PRE
#define GATHER_PRE 0
#endif
#ifndef GATHER_XEARLY
#define GATHER_XEARLY 0
#endif
#ifndef GATHER_SWP
#define GATHER_SWP 0
#endif
#ifndef GATHER_VECREG
#define GATHER_VECREG 1
#endif
#ifndef GATHER_MFMADOT
#define GATHER_MFMADOT 1
#endif
typedef short s16x4_t __attribute__((ext_vector_type(4)));
#ifndef GATHER_PAIRRED
#define GATHER_PAIRRED 1
#endif
#ifndef GATHER_EARLY
#define GATHER_EARLY 1
#endif
#ifndef GATHER_PACE
#define GATHER_PACE 0
#endif
#define XB_PACE(j) (XCD_BAR_WORDS + 64 * (j))
#ifndef GATHER_DEEP
#define GATHER_DEEP 0
#endif
constexpr int GS = GATHER_DEEP ? 8 : 6, GSLOT = GATHER_DEEP ? 2048 : 2 * PROW;
__device__ __forceinline__ void glds16(const void* gsrc, unsigned lds_dst) { unsigned keep;
  asm volatile("s_mov_b32 %0, m0\n\ts_mov_b32 m0, %2\n\ts_nop 0\n\tglobal_load_lds_dwordx4 %1, off\n\ts_mov_b32 m0, %0" : "=&s"(keep) : "v"(gsrc), "s"(lds_dst) : "memory"); }
template <int GMODE = 0>
__device__ __forceinline__ void gather_phase(CP P, int L, int Mrows, LAS unsigned char* lds, int wid, int lane_, int gw, int NGW, bool dry = false) {
    const unsigned char* UV = P->ws + WS_PU + (size_t)L * 16384 * PREC;
    const unsigned* ROUTE = (const unsigned*)(P->ws + WS_ROUTE); const float* MOD = (const float*)(P->ws + WS_MOD);
    bf16* X = (bf16*)(P->ws + WS_X); bf16* H = (bf16*)(P->ws + WS_H); bf16* Xo = dry ? (bf16*)(P->ws + WS_Y) : X; bf16* Ho = dry ? (bf16*)(P->ws + WS_G) : H;
    const float* lng = P->in[6] + (size_t)(L * 2 + 1) * DM; const float* lnb = P->in[7] + (size_t)(L * 2 + 1) * DM;
    const unsigned ring = (unsigned)(uintptr_t)lds + (unsigned)wid * (GS * GSLOT);
    const int nfull = (Mrows / NGW) * NGW, rem = Mrows - nfull; const bool can_coop = (rem * 4 == NGW);
    const int nround = nfull / NGW + (rem > 0 ? 1 : 0);
    const bool pace_ok = (rem == 0) || can_coop;
#define G_ROWOF(it_) ((can_coop && (it_) == nround - 1) ? (nfull + (int)blockIdx.x * 2 + (wid >> 2)) : (gw + (it_) * NGW))
    u32x2 nea = {0u, 0u}, neb = {0u, 0u}; u32x4 nh0 = {0u, 0u, 0u, 0u}, nh1 = nh0, nh2 = nh0, nh3 = nh0;
#define G_NTL(p_) (NT_STREAM > 1 ? __builtin_nontemporal_load(p_) : *(p_))
#define G_PREFETCH(rowN_, ln_) do { const int rn_ = (rowN_); nea = G_NTL(&((const u32x2*)(ROUTE + (size_t)rn_ * 256))[ln_]); neb = G_NTL(&((const u32x2*)(ROUTE + (size_t)rn_ * 256))[64 + (ln_)]); \
        const u32x4* hp_ = (const u32x4*)(H + (size_t)rn_ * DM) + 4 * (ln_); nh0 = G_NTL(hp_); nh1 = G_NTL(hp_ + 1); nh2 = G_NTL(hp_ + 2); nh3 = G_NTL(hp_ + 3); } while (0)
    if (nround > 0 && G_ROWOF(0) < Mrows) G_PREFETCH(G_ROWOF(0), launder_v(lane_));
#if GATHER_VECREG
    LAS unsigned* LNV = (LAS unsigned*)(lds + NWAVES * GS * GSLOT);
    { f32x2 t_[4];
#pragma unroll
      for (int t = 0; t < 4; ++t) { const int i = wid * 64 + lane_ + t * NWAVES * 64; t_[t] = *(const f32x2*)(((i >> 10) ? lnb : lng) + 2 * (i & 1023)); }
#pragma unroll
      for (int t = 0; t < 4; ++t) { const float x0_ = t_[t][0], x1_ = t_[t][1]; LNV[wid * 64 + lane_ + t * NWAVES * 64] = cvtpk(x0_, x1_); } }
    __syncthreads();
    unsigned mg[16], ms[16], mc[16]; int cur_slot = -1;
#pragma unroll
    for (int i = 0; i < 16; ++i) { mg[i] = 0u; ms[i] = 0u; mc[i] = 0u; }
#endif
    bool pre = false;
#pragma unroll 1
    for (int it = 0; it < nround; ++it) {
#if GATHER_PACE
        if (pace_ok && it > 0) {
            if (wid == 0 && lane_ == 0) { const unsigned nloc = ((volatile LAS unsigned*)(lds + MISC_OFF))[8];
                if (nloc != 0u) { unsigned* pc = (unsigned*)(P->ws + WS_CTL) + CW_BAR + XB_PACE(xb_xcc_id());
                    const unsigned old = xb_add(pc, 1u), tgt = (old / nloc + 1u) * nloc; unsigned sp = 0u;
                    while ((int)(xb_ld(pc) - tgt) < 0 && ++sp < 20000u) __builtin_amdgcn_s_sleep(1); } }
            __syncthreads();
        }
#endif
        const bool coop = can_coop && (it == nround - 1);
        int row = G_ROWOF(it), k0 = 0, kn = 128;
        if (coop) { k0 = (wid & 3) * 32; kn = k0 + 32; }
        else if (row >= Mrows) break;
        const int lane = launder_v(lane_);
        const u32x2 ea = nea, eb = neb;
        unsigned eax, eay, ebx, eby;
        unsigned hw[16] = {nh0.x, nh0.y, nh0.z, nh0.w, nh1.x, nh1.y, nh1.z, nh1.w, nh2.x, nh2.y, nh2.z, nh2.w, nh3.x, nh3.y, nh3.z, nh3.w};
        float y[32];
#pragma unroll
        for (int i = 0; i < 32; ++i) y[i] = 0.f;
        { unsigned e0 = ea.x, e1 = ea.y, e2 = eb.x, e3 = eb.y;
          asm volatile("" : "+v"(e0), "+v"(e1), "+v"(e2), "+v"(e3), "+v"(hw[0]), "+v"(hw[1]), "+v"(hw[2]), "+v"(hw[3]), "+v"(hw[4]), "+v"(hw[5]), "+v"(hw[6]), "+v"(hw[7]),
                       "+v"(hw[8]), "+v"(hw[9]), "+v"(hw[10]), "+v"(hw[11]), "+v"(hw[12]), "+v"(hw[13]), "+v"(hw[14]), "+v"(hw[15]) :: "memory");
          eax = e0; eay = e1; ebx = e2; eby = e3; }
        const unsigned rd_a = ring + 16u * (unsigned)lane, rd_b = ring + 2048u + 8u * (unsigned)lane;
        const bool rev = GATHER_ZIGZAG && ((it & 1) != 0);
        const int kflip = rev ? (k0 + kn - 1) : 0, ksign = rev ? -1 : 1;
#define G_ISSUE(k) do { const int k_ = (k), ke_ = kflip + ksign * k_; const unsigned e_ = (unsigned)__builtin_amdgcn_readlane((int)(ke_ < 64 ? eax : ebx), ke_ & 63); \
        const unsigned char* rp_ = UV + (size_t)e_ * PREC + 16 * lane; const unsigned sb_ = ring + (unsigned)(k_ % GS) * GSLOT; \
        if (GMODE == 3) { glds16(rp_, sb_); if (lane < 32) glds16(rp_ + 2048, sb_ + 2048); } \
        else if (GMODE != 2) { glds16(rp_, sb_); glds16(rp_ + 1024, sb_ + 1024); if (PEER_U4) {} else if (PEER_V4) { if (lane < 32) glds16(rp_ + 2048, sb_ + 2048); } else glds16(rp_ + 2048, sb_ + 2048); } else { asm volatile("" :: "v"(rp_), "s"(sb_)); } } while (0)
#if GATHER_EARLY
        if (it + 1 < nround && G_ROWOF(it + 1) < Mrows) G_PREFETCH(G_ROWOF(it + 1), lane);
        if (!pre) {
#pragma unroll
            for (int k = 0; k < GS; ++k) G_ISSUE(k0 + k); }
#else
#pragma unroll
        for (int k = 0; k < 4; ++k) G_ISSUE(k0 + k);
        if (it + 1 < nround && G_ROWOF(it + 1) < Mrows) G_PREFETCH(G_ROWOF(it + 1), lane);
#endif
#define G_READ(k, ua, ub, va, vb) do { const unsigned so_ = (unsigned)((k) % GS) * GSLOT; \
        if (PEER_U4) asm volatile("ds_read_b128 %0, %2\n\tds_read_b128 %1, %2 offset:1024" : "=&v"(ua), "=&v"(va) : "v"(rd_a + so_) : "memory"); \
        else if (PEER_V4) asm volatile("ds_read_b128 %0, %3\n\tds_read_b64 %1, %4\n\tds_read_b128 %2, %3 offset:1024" \
                     : "=&v"(ua), "=&v"(ub), "=&v"(va) : "v"(rd_a + so_), "v"(rd_b + so_) : "memory"); \
        else asm volatile("ds_read_b128 %0, %4\n\tds_read_b64 %1, %5\n\tds_read_b128 %2, %4 offset:1024\n\tds_read_b64 %3, %5 offset:512" \
                     : "=&v"(ua), "=&v"(ub), "=&v"(va), "=&v"(vb) : "v"(rd_a + so_), "v"(rd_b + so_) : "memory"); } while (0)
#if GATHER_XEARLY
        u32x4 xr0 = {0u, 0u, 0u, 0u}, xr1 = xr0, xr2 = xr0, xr3 = xr0;
#endif
#if GATHER_SWP
        static_assert(!GATHER_SWP || (PEER_U4 && PEER_V4 && GATHER_EARLY && GATHER_PAIRRED && GATHER_MFMADOT && !GATHER_DEEP && !GATHER_XEARLY && !GATHER_PRE), "GATHER_SWP: configuration");
#define SWP_FETCH(kk, uA, uB, vA, vB) do { const int kk_ = (kk); \
            if (kk_ + 4 < kn) asm volatile("s_waitcnt vmcnt(8)" ::: "memory"); else if (kk_ == kn - 4) asm volatile("s_waitcnt vmcnt(4)" ::: "memory"); else asm volatile("s_waitcnt vmcnt(0)" ::: "memory"); \
            u32x2 d0_ = {0u, 0u}, d1_ = {0u, 0u}; G_READ(kk_, uA, d0_, vA, d1_); G_READ(kk_ + 1, uB, d0_, vB, d1_); \
            asm volatile("s_waitcnt lgkmcnt(0)" : "+v"(uA), "+v"(vA), "+v"(uB), "+v"(vB) :: "memory"); \
            if (kk_ + GS < kn) { G_ISSUE(kk_ + GS); G_ISSUE(kk_ + GS + 1); } } while (0)
#define SWP_U4(dst_, src_, w_, b_) dst_[4 * (w_) + (b_)] = __builtin_bit_cast(unsigned, __builtin_amdgcn_cvt_scalef32_pk_bf16_fp4(src_[w_], 1.0f, b_))
#define SWP_UPART(kk, uA, uB, wA_, wB_) do { const int kk_ = (kk); u32x16 ubfA, ubfB; const unsigned uwA[4] = {uA.x, uA.y, uA.z, uA.w}, uwB[4] = {uB.x, uB.y, uB.z, uB.w}; \
            _Pragma("unroll") for (int w = 0; w < 4; ++w) { SWP_U4(ubfA, uwA, w, 0); SWP_U4(ubfA, uwA, w, 1); SWP_U4(ubfA, uwA, w, 2); SWP_U4(ubfA, uwA, w, 3); SWP_U4(ubfB, uwB, w, 0); SWP_U4(ubfB, uwB, w, 1); SWP_U4(ubfB, uwB, w, 2); SWP_U4(ubfB, uwB, w, 3); } \
            f32x4 dgA = {0.f, 0.f, 0.f, 0.f}, dgB = {0.f, 0.f, 0.f, 0.f}; \
            _Pragma("unroll") for (int q = 0; q < 16; q += 2) { const u32x2 hq_ = {hw[q], hw[q + 1]}, xa_ = {ubfA[q], ubfA[q + 1]}, xb_ = {ubfB[q], ubfB[q + 1]}; \
                dgA = __builtin_amdgcn_mfma_f32_4x4x4bf16_1k(__builtin_bit_cast(s16x4_t, xa_), __builtin_bit_cast(s16x4_t, hq_), dgA, 0, 0, 0); \
                dgB = __builtin_amdgcn_mfma_f32_4x4x4bf16_1k(__builtin_bit_cast(s16x4_t, xb_), __builtin_bit_cast(s16x4_t, hq_), dgB, 0, 0, 0); } \
            const float x0 = dgA[0], x1 = dgA[1], x2 = dgA[2], x3 = dgA[3], y0 = dgB[0], y1 = dgB[1], y2 = dgB[2], y3 = dgB[3]; \
            float a0 = DPP_F(x0, 0x00); a0 += DPP_F(x1, 0x55); a0 += DPP_F(x2, 0xAA); a0 += DPP_F(x3, 0xFF); \
            float b0 = DPP_F(y0, 0x00); b0 += DPP_F(y1, 0x55); b0 += DPP_F(y2, 0xAA); b0 += DPP_F(y3, 0xFF); \
            const auto sw = __builtin_amdgcn_permlane32_swap(__float_as_uint(a0), __float_as_uint(b0), false, false); \
            float c2 = __uint_as_float(sw[0]) + __uint_as_float(sw[1]); c2 += DPP_F(c2, 0x141); c2 += DPP_F(c2, 0x140); \
            const float d2 = sum_xor16(c2) * (1.0f / U_SCALE); const float g2 = gelu_tanh(d2) * (1.0f / V_SCALE); \
            const float gA = __uint_as_float((unsigned)__builtin_amdgcn_readlane((int)__float_as_uint(g2), 0)), gB = __uint_as_float((unsigned)__builtin_amdgcn_readlane((int)__float_as_uint(g2), 32)); \
            const int keA = kflip + ksign * kk_, keB = keA + ksign; const unsigned gsel = keA < 64 ? eay : eby; \
            wA_ = __uint_as_float((unsigned)__builtin_amdgcn_readlane((int)gsel, keA & 63)) * gA; wB_ = __uint_as_float((unsigned)__builtin_amdgcn_readlane((int)gsel, keB & 63)) * gB; } while (0)
#define SWP_V4(vwA, vwB, w_, b_, wA_, wB_) do { const f32x2 pA = __builtin_amdgcn_cvt_scalef32_pk_f32_fp4(vwA[w_], 1.0f, b_), pB = __builtin_amdgcn_cvt_scalef32_pk_f32_fp4(vwB[w_], 1.0f, b_); const int j = 4 * (w_) + (b_); \
            const float pa0 = pA[0], pa1 = pA[1], pb0 = pB[0], pb1 = pB[1]; y[2 * j] += wA_ * pa0; y[2 * j + 1] += wA_ * pa1; y[2 * j] += wB_ * pb0; y[2 * j + 1] += wB_ * pb1; } while (0)
#define SWP_VPART(vA, vB, wA_, wB_) do { const unsigned vwA[4] = {vA.x, vA.y, vA.z, vA.w}, vwB[4] = {vB.x, vB.y, vB.z, vB.w}; \
            _Pragma("unroll") for (int w = 0; w < 4; ++w) { SWP_V4(vwA, vwB, w, 0, wA_, wB_); SWP_V4(vwA, vwB, w, 1, wA_, wB_); SWP_V4(vwA, vwB, w, 2, wA_, wB_); SWP_V4(vwA, vwB, w, 3, wA_, wB_); } } while (0)
#define SWP_VCH(w_, qA_, qB_) do { SWP_V4(vwA, vwB, w_, 0, qA_, qB_); SWP_V4(vwA, vwB, w_, 1, qA_, qB_); SWP_V4(vwA, vwB, w_, 2, qA_, qB_); SWP_V4(vwA, vwB, w_, 3, qA_, qB_); } while (0)
#define SWP_MIX(kk, uA, uB, wA_, wB_, pvA, pvB, pwA_, pwB_) do { const int kk_ = (kk); u32x16 ubfA, ubfB; const unsigned uwA[4] = {uA.x, uA.y, uA.z, uA.w}, uwB[4] = {uB.x, uB.y, uB.z, uB.w}; \
            const unsigned vwA[4] = {pvA.x, pvA.y, pvA.z, pvA.w}, vwB[4] = {pvB.x, pvB.y, pvB.z, pvB.w}; \
            _Pragma("unroll") for (int w = 0; w < 4; ++w) { SWP_U4(ubfA, uwA, w, 0); SWP_U4(ubfA, uwA, w, 1); SWP_U4(ubfA, uwA, w, 2); SWP_U4(ubfA, uwA, w, 3); SWP_U4(ubfB, uwB, w, 0); SWP_U4(ubfB, uwB, w, 1); SWP_U4(ubfB, uwB, w, 2); SWP_U4(ubfB, uwB, w, 3); } \
            f32x4 dgA = {0.f, 0.f, 0.f, 0.f}, dgB = {0.f, 0.f, 0.f, 0.f}; \
            _Pragma("unroll") for (int q = 0; q < 16; q += 2) { const u32x2 hq_ = {hw[q], hw[q + 1]}, xa_ = {ubfA[q], ubfA[q + 1]}, xb_ = {ubfB[q], ubfB[q + 1]}; \
                dgA = __builtin_amdgcn_mfma_f32_4x4x4bf16_1k(__builtin_bit_cast(s16x4_t, xa_), __builtin_bit_cast(s16x4_t, hq_), dgA, 0, 0, 0); \
                dgB = __builtin_amdgcn_mfma_f32_4x4x4bf16_1k(__builtin_bit_cast(s16x4_t, xb_), __builtin_bit_cast(s16x4_t, hq_), dgB, 0, 0, 0); } \
            SWP_VCH(0, pwA_, pwB_); \
            const float x0 = dgA[0], x1 = dgA[1], x2 = dgA[2], x3 = dgA[3], y0 = dgB[0], y1 = dgB[1], y2 = dgB[2], y3 = dgB[3]; \
            float a0 = DPP_F(x0, 0x00); a0 += DPP_F(x1, 0x55); a0 += DPP_F(x2, 0xAA); a0 += DPP_F(x3, 0xFF); \
            float b0 = DPP_F(y0, 0x00); b0 += DPP_F(y1, 0x55); b0 += DPP_F(y2, 0xAA); b0 += DPP_F(y3, 0xFF); \
            SWP_VCH(1, pwA_, pwB_); \
            const auto sw = __builtin_amdgcn_permlane32_swap(__float_as_uint(a0), __float_as_uint(b0), false, false); \
            float c2 = __uint_as_float(sw[0]) + __uint_as_float(sw[1]); c2 += DPP_F(c2, 0x141); c2 += DPP_F(c2, 0x140); \
            float d2 = sum_xor16(c2) * (1.0f / U_SCALE); \
            SWP_VCH(2, pwA_, pwB_); \
            float g2 = gelu_tanh(d2) * (1.0f / V_SCALE); \
            SWP_VCH(3, pwA_, pwB_); \
            const float gA = __uint_as_float((unsigned)__builtin_amdgcn_readlane((int)__float_as_uint(g2), 0)), gB = __uint_as_float((unsigned)__builtin_amdgcn_readlane((int)__float_as_uint(g2), 32)); \
            const int keA = kflip + ksign * kk_, keB = keA + ksign; const unsigned gsel = keA < 64 ? eay : eby; \
            wA_ = __uint_as_float((unsigned)__builtin_amdgcn_readlane((int)gsel, keA & 63)) * gA; wB_ = __uint_as_float((unsigned)__builtin_amdgcn_readlane((int)gsel, keB & 63)) * gB; } while (0)
        if (GMODE == 0) {
            u32x4 cuA, cuB, cvA, cvB; float cwA, cwB;
            SWP_FETCH(k0, cuA, cuB, cvA, cvB); SWP_UPART(k0, cuA, cuB, cwA, cwB);
#pragma unroll 1
            for (int k = k0; k + 2 < kn; k += 2) {
                u32x4 nuA, nuB, nvA, nvB; float nwA, nwB;
                SWP_FETCH(k + 2, nuA, nuB, nvA, nvB);
                SWP_MIX(k + 2, nuA, nuB, nwA, nwB, cvA, cvB, cwA, cwB);
                cvA = nvA; cvB = nvB; cwA = nwA; cwB = nwB;
            }
            SWP_VPART(cvA, cvB, cwA, cwB);
        } else
#undef SWP_MIX
#undef SWP_VCH
#undef SWP_FETCH
#undef SWP_U4
#undef SWP_UPART
#undef SWP_V4
#undef SWP_VPART
#endif
#pragma unroll 1
        for (int k = k0; k < kn; k += 2) {
            if (GATHER_DEEP && k + 6 < kn) asm volatile("s_waitcnt vmcnt(12)" ::: "memory");
            else if (GATHER_DEEP && k == kn - 6) asm volatile("s_waitcnt vmcnt(8)" ::: "memory");
            else if (k + 4 < kn) { if (!GATHER_EARLY) { G_ISSUE(k + 4); G_ISSUE(k + 5); } if (GMODE == 3 || PEER_U4) asm volatile("s_waitcnt vmcnt(8)" ::: "memory"); else asm volatile("s_waitcnt vmcnt(12)" ::: "memory"); }
            else if (k == kn - 4) { if (GMODE == 3 || PEER_U4) asm volatile("s_waitcnt vmcnt(4)" ::: "memory"); else asm volatile("s_waitcnt vmcnt(6)" ::: "memory"); }
            else asm volatile("s_waitcnt vmcnt(0)" ::: "memory");
            u32x4 uaA, vaA, uaB, vaB; u32x2 ubA = {0u, 0u}, vbA = {0u, 0u}, ubB = {0u, 0u}, vbB = {0u, 0u};
            G_READ(k, uaA, ubA, vaA, vbA); G_READ(k + 1, uaB, ubB, vaB, vbB);
            asm volatile("s_waitcnt lgkmcnt(0)" : "+v"(uaA), "+v"(ubA), "+v"(vaA), "+v"(vbA), "+v"(uaB), "+v"(ubB), "+v"(vaB), "+v"(vbB) :: "memory");
#if GATHER_XEARLY
            if (k == kn - 4) { const u32x4* xp_ = (const u32x4*)(X + (size_t)row * DM) + 4 * lane; xr0 = xp_[0]; xr1 = xp_[1]; xr2 = xp_[2]; xr3 = xp_[3]; }
#endif
            if (GATHER_EARLY && k + GS < kn) { G_ISSUE(k + GS); G_ISSUE(k + GS + 1); }
            if (GMODE == 1 || GMODE == 3) continue;
#if PEER_U4
            u32x16 ubfA, ubfB;
            { const unsigned uwA[4] = {uaA.x, uaA.y, uaA.z, uaA.w}, uwB[4] = {uaB.x, uaB.y, uaB.z, uaB.w};
#pragma unroll
              for (int w = 0; w < 4; ++w) {
#define U4_CVT(b_) do { ubfA[4 * w + (b_)] = __builtin_bit_cast(unsigned, __builtin_amdgcn_cvt_scalef32_pk_bf16_fp4(uwA[w], 1.0f, b_)); ubfB[4 * w + (b_)] = __builtin_bit_cast(unsigned, __builtin_amdgcn_cvt_scalef32_pk_bf16_fp4(uwB[w], 1.0f, b_)); } while (0)
                  U4_CVT(0); U4_CVT(1); U4_CVT(2); U4_CVT(3);
#undef U4_CVT
              } }
#else
            const u32x6 u6A = {uaA.x, uaA.y, uaA.z, uaA.w, ubA.x, ubA.y}, u6B = {uaB.x, uaB.y, uaB.z, uaB.w, ubB.x, ubB.y};
            const u32x16 ubfA = __builtin_bit_cast(u32x16, __builtin_amdgcn_cvt_scalef32_pk32_bf16_fp6(u6A, 1.0f));
            const u32x16 ubfB = __builtin_bit_cast(u32x16, __builtin_amdgcn_cvt_scalef32_pk32_bf16_fp6(u6B, 1.0f));
#endif
#if GATHER_MFMADOT
            f32x4 dgA = {0.f, 0.f, 0.f, 0.f}, dgB = {0.f, 0.f, 0.f, 0.f};
#pragma unroll
            for (int q = 0; q < 16; q += 2) { const u32x2 hq_ = {hw[q], hw[q + 1]}, xa_ = {ubfA[q], ubfA[q + 1]}, xb_ = {ubfB[q], ubfB[q + 1]};
                dgA = __builtin_amdgcn_mfma_f32_4x4x4bf16_1k(__builtin_bit_cast(s16x4_t, xa_), __builtin_bit_cast(s16x4_t, hq_), dgA, 0, 0, 0);
                dgB = __builtin_amdgcn_mfma_f32_4x4x4bf16_1k(__builtin_bit_cast(s16x4_t, xb_), __builtin_bit_cast(s16x4_t, hq_), dgB, 0, 0, 0); }
            float a0, a1 = 0.f, b0, b1 = 0.f;
            { const float x0 = dgA[0], x1 = dgA[1], x2 = dgA[2], x3 = dgA[3], y0 = dgB[0], y1 = dgB[1], y2 = dgB[2], y3 = dgB[3];
              a0 = DPP_F(x0, 0x00); a0 += DPP_F(x1, 0x55); a0 += DPP_F(x2, 0xAA); a0 += DPP_F(x3, 0xFF);
              b0 = DPP_F(y0, 0x00); b0 += DPP_F(y1, 0x55); b0 += DPP_F(y2, 0xAA); b0 += DPP_F(y3, 0xFF); }
#else
            float a0 = 0.f, a1 = 0.f, b0 = 0.f, b1 = 0.f;
#pragma unroll
            for (int q = 0; q < 16; q += 2) { const unsigned h0_ = hw[q], h1_ = hw[q + 1], x0_ = ubfA[q], x1_ = ubfA[q + 1], z0_ = ubfB[q], z1_ = ubfB[q + 1];
                a0 = __builtin_amdgcn_fdot2_f32_bf16(__builtin_bit_cast(bf16x2_t, h0_), __builtin_bit_cast(bf16x2_t, x0_), a0, false);
                a1 = __builtin_amdgcn_fdot2_f32_bf16(__builtin_bit_cast(bf16x2_t, h1_), __builtin_bit_cast(bf16x2_t, x1_), a1, false);
                b0 = __builtin_amdgcn_fdot2_f32_bf16(__builtin_bit_cast(bf16x2_t, h0_), __builtin_bit_cast(bf16x2_t, z0_), b0, false);
                b1 = __builtin_amdgcn_fdot2_f32_bf16(__builtin_bit_cast(bf16x2_t, h1_), __builtin_bit_cast(bf16x2_t, z1_), b1, false); }
#endif
            const int keA = kflip + ksign * k, keB = keA + ksign;
            const unsigned gsel = keA < 64 ? eay : eby;
#if GATHER_PAIRRED
            float wA, wB;
            { const auto sw = __builtin_amdgcn_permlane32_swap(__float_as_uint(GATHER_MFMADOT ? a0 : a0 + a1), __float_as_uint(GATHER_MFMADOT ? b0 : b0 + b1), false, false);
#if GATHER_MFMADOT
              float c2 = __uint_as_float(sw[0]) + __uint_as_float(sw[1]); c2 += DPP_F(c2, 0x141); c2 += DPP_F(c2, 0x140);
              const float d2 = sum_xor16(c2) * (1.0f / U_SCALE);
#else
              const float d2 = half_sum32(__uint_as_float(sw[0]) + __uint_as_float(sw[1])) * (1.0f / U_SCALE);
#endif
              const float g2 = gelu_tanh(d2) * (1.0f / V_SCALE);
              const float gA = __uint_as_float((unsigned)__builtin_amdgcn_readlane((int)__float_as_uint(g2), 0)), gB = __uint_as_float((unsigned)__builtin_amdgcn_readlane((int)__float_as_uint(g2), 32));
              wA = __uint_as_float((unsigned)__builtin_amdgcn_readlane((int)gsel, keA & 63)) * gA; wB = __uint_as_float((unsigned)__builtin_amdgcn_readlane((int)gsel, keB & 63)) * gB; }
#else
            const float dA = wave_sum(a0 + a1) * (1.0f / U_SCALE), dB = wave_sum(b0 + b1) * (1.0f / U_SCALE);
            const float wA = __uint_as_float((unsigned)__builtin_amdgcn_readlane((int)gsel, keA & 63)) * gelu_tanh(dA) * (1.0f / V_SCALE);
            const float wB = __uint_as_float((unsigned)__builtin_amdgcn_readlane((int)gsel, keB & 63)) * gelu_tanh(dB) * (1.0f / V_SCALE);
#endif
#if PEER_V4
            { const unsigned vwA[4] = {vaA.x, vaA.y, vaA.z, vaA.w}, vwB[4] = {vaB.x, vaB.y, vaB.z, vaB.w};
#pragma unroll
              for (int w = 0; w < 4; ++w) {
#define V4_ACC(b_) do { const f32x2 pA = __builtin_amdgcn_cvt_scalef32_pk_f32_fp4(vwA[w], 1.0f, b_), pB = __builtin_amdgcn_cvt_scalef32_pk_f32_fp4(vwB[w], 1.0f, b_); const int j = 4 * w + (b_); \
                    const float pa0 = pA[0], pa1 = pA[1], pb0 = pB[0], pb1 = pB[1]; y[2 * j] += wA * pa0; y[2 * j + 1] += wA * pa1; y[2 * j] += wB * pb0; y[2 * j + 1] += wB * pb1; } while (0)
                  V4_ACC(0); V4_ACC(1); V4_ACC(2); V4_ACC(3);
#undef V4_ACC
              } }
#else
            const u32x6 v6A = {vaA.x, vaA.y, vaA.z, vaA.w, vbA.x, vbA.y};
            const f32x32 vfA = __builtin_amdgcn_cvt_scalef32_pk32_f32_fp6(v6A, 1.0f);
#pragma unroll
            for (int i = 0; i < 32; ++i) y[i] += wA * vfA[i];
            const u32x6 v6B = {vaB.x, vaB.y, vaB.z, vaB.w, vbB.x, vbB.y};
            const f32x32 vfB = __builtin_amdgcn_cvt_scalef32_pk32_f32_fp6(v6B, 1.0f);
#pragma unroll
            for (int i = 0; i < 32; ++i) y[i] += wB * vfB[i];
#endif
        }
#if GATHER_PRE
        pre = (it + 1 < nround) && (G_ROWOF(it + 1) < Mrows);
        if (pre) { unsigned n0 = nea.x, n2 = neb.x; asm volatile("" : "+v"(n0), "+v"(n2) :: "memory"); eax = n0; ebx = n2;
            const int k0n = (can_coop && (it + 1 == nround - 1)) ? (wid & 3) * 32 : 0;
#pragma unroll
            for (int k = 0; k < 6; ++k) G_ISSUE(k0n + k); }
#endif
#undef G_READ
#undef G_ISSUE
        if (coop) {
            LAS f32x4* mine = (LAS f32x4*)(lds + wid * (GS * GSLOT)) + lane * 8;
#pragma unroll
            for (int i = 0; i < 8; ++i) mine[i] = (f32x4){y[4 * i], y[4 * i + 1], y[4 * i + 2], y[4 * i + 3]};
            __syncthreads();
            if ((wid & 3) == 0) {
#pragma unroll
                for (int j = 1; j < 4; ++j) { const LAS f32x4* oth = (const LAS f32x4*)(lds + (wid + j) * (GS * GSLOT)) + lane * 8;
#pragma unroll
                    for (int i = 0; i < 8; ++i) { const f32x4 t = oth[i]; y[4 * i] += t.x; y[4 * i + 1] += t.y; y[4 * i + 2] += t.z; y[4 * i + 3] += t.w; } }
            }
            __syncthreads();
            if ((wid & 3) != 0) continue;
        }
        const int slot = row_slot(row);
        const float* mod = MOD + (size_t)(L * 3 + slot) * 12288;
        const int le = launder_v(lane);
#if GATHER_VECREG
        if (slot != cur_slot) { cur_slot = slot; float t_[32];
            load_row_f32_b(mod + 5 * 2048, le, t_);
#pragma unroll
            for (int i = 0; i < 16; ++i) mg[i] = cvtpk(t_[2 * i], t_[2 * i + 1]);
            if (L < NLAYER - 1) { const float* modn = MOD + (size_t)((L + 1) * 3 + slot) * 12288;
                load_row_f32_b(modn, le, t_);
#pragma unroll
                for (int i = 0; i < 16; ++i) ms[i] = cvtpk(t_[2 * i], t_[2 * i + 1]);
                load_row_f32_b(modn + 2048, le, t_);
#pragma unroll
                for (int i = 0; i < 16; ++i) mc[i] = cvtpk(t_[2 * i], t_[2 * i + 1]); } }
        { float xx[32];
#if GATHER_XEARLY
          { const unsigned xw_[16] = {xr0.x, xr0.y, xr0.z, xr0.w, xr1.x, xr1.y, xr1.z, xr1.w, xr2.x, xr2.y, xr2.z, xr2.w, xr3.x, xr3.y, xr3.z, xr3.w};
#pragma unroll
            for (int i = 0; i < 16; ++i) { xx[2 * i] = bflo(xw_[i]); xx[2 * i + 1] = bfhi(xw_[i]); } }
#else
          { const u32x4* xp_ = (const u32x4*)(X + (size_t)row * DM) + 4 * le;
#pragma unroll
            for (int j = 0; j < 4; ++j) { const u32x4 w = G_NTL(xp_ + j); xx[8 * j + 0] = bflo(w.x); xx[8 * j + 1] = bfhi(w.x); xx[8 * j + 2] = bflo(w.y); xx[8 * j + 3] = bfhi(w.y);
                xx[8 * j + 4] = bflo(w.z); xx[8 * j + 5] = bfhi(w.z); xx[8 * j + 6] = bflo(w.w); xx[8 * j + 7] = bfhi(w.w); } }
#endif
#pragma unroll
          for (int i = 0; i < 16; ++i) { y[2 * i] = ALPHA * xx[2 * i] + bflo(mg[i]) * y[2 * i]; y[2 * i + 1] = ALPHA * xx[2 * i + 1] + bfhi(mg[i]) * y[2 * i + 1]; } }
        { float mean, rstd; ln_stats(y, mean, rstd);
          const LAS u32x4* gp = (const LAS u32x4*)(LNV + le * 16); const LAS u32x4* bp = (const LAS u32x4*)(LNV + 1024 + le * 16);
#pragma unroll
          for (int q = 0; q < 4; ++q) { const u32x4 g4 = gp[q], b4 = bp[q]; const unsigned gw_[4] = {g4.x, g4.y, g4.z, g4.w}, bw_[4] = {b4.x, b4.y, b4.z, b4.w};
#pragma unroll
              for (int j = 0; j < 4; ++j) { const int i = 8 * q + 2 * j; y[i] = (y[i] - mean) * rstd * bflo(gw_[j]) + bflo(bw_[j]); y[i + 1] = (y[i + 1] - mean) * rstd * bfhi(gw_[j]) + bfhi(bw_[j]); } }
          if (L < NLAYER - 1) { store_row_bf16_b(Xo + (size_t)row * DM, le, y);
              ln_stats(y, mean, rstd); float a_[32];
#pragma unroll
              for (int i = 0; i < 16; ++i) { a_[2 * i] = (y[2 * i] - mean) * rstd * (1.0f + bflo(mc[i])) + bflo(ms[i]); a_[2 * i + 1] = (y[2 * i + 1] - mean) * rstd * (1.0f + bfhi(mc[i])) + bfhi(ms[i]); }
              store_row_bf16_b(Ho + (size_t)row * DM, le, a_); }
          else { if (NT_STREAM > 1) store_row_f32_b_nt(P->out + (size_t)row * DM, le, y); else store_row_f32_b(P->out + (size_t)row * DM, le, y); } }
        asm volatile("s_waitcnt vmcnt(0)" ::: "memory");
        continue;
#endif
        { float xx[32], gg[32]; load_row_bf16_b(X + (size_t)row * DM, le, xx); load_row_f32_b(mod + 5 * 2048, le, gg);
#pragma unroll
          for (int i = 0; i < 32; ++i) y[i] = ALPHA * xx[i] + gg[i] * y[i]; }
        if (L < NLAYER - 1) { const float* modn = MOD + (size_t)((L + 1) * 3 + slot) * 12288;
            finish_row<true>(y, lng, lnb, Xo + (size_t)row * DM, modn, modn + 2048, Ho + (size_t)row * DM, nullptr, le); }
        else finish_row<true>(y, lng, lnb, nullptr, nullptr, nullptr, nullptr, P->out + (size_t)row * DM, le);
        asm volatile("s_waitcnt vmcnt(0)" ::: "memory");
    }
#undef G_PREFETCH
#undef G_ROWOF
}

#ifndef ROPE_TEST
#define ROPE_TEST 0
#endif
#ifndef TAIL_L3MOVE
#define TAIL_L3MOVE 1
#endif
#ifndef PROBE_DUP
#define PROBE_DUP 0
#endif
#define NOINL __forceinline__
__device__ __forceinline__ CP launder_cp(CP p) { asm volatile("" : "+s"(p)); return p; }
#define GETP() launder_cp((CP)__builtin_amdgcn_kernarg_segment_ptr())
__device__ __forceinline__ int uni(int v) { return __builtin_amdgcn_readfirstlane(v); }
__device__ __forceinline__ LAS unsigned char* uni_lds(LAS unsigned char* p) { return (LAS unsigned char*)(unsigned)__builtin_amdgcn_readfirstlane((int)(unsigned)(uintptr_t)p); }
#define PH_IDS const int wid = uni(wv_), lane = launder_v(lane_id_fresh()) & 63, tid = (wid & 7) * 64 + lane; const int gw = blockIdx.x * NWAVES + wid, NGW = gridDim.x * NWAVES; (void)lane; (void)gw; (void)NGW; (void)tid;

__device__ NOINL void ph_prologue(int wv_, LAS unsigned char* lds_) { CP P = GETP(); LAS unsigned char* lds = uni_lds(lds_); PH_IDS p0_prologue(P, lds, tid, lane, wid, gw, NGW); if (PROBE_DUP == 5) p0_prologue(P, lds, tid, lane, wid, gw, NGW);
    if (PROBE_DUP >= 21 && PROBE_DUP <= 23) { __syncthreads(); p0_prologue(P, lds, tid, lane, wid, gw, NGW, 1 << (PROBE_DUP - 21 < 0 ? 0 : (PROBE_DUP - 21) & 3)); } }
__device__ NOINL void ph_modreduce(int wv_) { CP P = GETP(); PH_IDS mod_reduce(P, gw, lane, NGW); }
__device__ NOINL void ph_first(int wv_, LAS unsigned char* lds_) { CP P = GETP(); LAS unsigned char* lds = uni_lds(lds_); PH_IDS
#pragma unroll 1
    for (int rep = 0; rep < (PROBE_DUP == 6 ? 2 : 1); ++rep) first_row_pass(P, lds, tid, lane, gw, NGW); }
__device__ NOINL void ph_postmix(int wv_, LAS unsigned char* lds_, int L_, int M_) { CP P = GETP(); LAS unsigned char* lds = uni_lds(lds_); const int L = uni(L_), Mrows = uni(M_); PH_IDS
    if (POSTMIX_LDS) post_mixer_pass_lds(P, L, Mrows, lds, tid, lane, gw, NGW); else post_mixer_pass(P, L, Mrows, lane, gw, NGW); }
__device__ NOINL void ph_vstats(int wv_, int M_) { CP P = GETP(); const int Mrows = uni(M_); PH_IDS
#pragma unroll 1
    for (int rep = 0; rep < (PROBE_DUP == 6 ? 2 : 1); ++rep) vstats_pass(P, Mrows, lane, gw, NGW); }
__device__ NOINL void ph_spatial(int wv_, LAS unsigned char* lds_, int j_, int M_) { CP P = GETP(); LAS unsigned char* lds = uni_lds(lds_); const int j = uni(j_), Mrows = uni(M_); PH_IDS
#pragma unroll 1
    for (int rep = 0; rep < ((PROBE_DUP == 6 || PROBE_DUP == 19) ? 2 : 1); ++rep) spatial_phase(P, j, Mrows, lds, tid, lane, wid); }
__device__ NOINL void ph_mla_norm(int wv_) { CP P = GETP(); PH_IDS
#pragma unroll 1
    for (int rep = 0; rep < (PROBE_DUP == 6 ? 2 : 1); ++rep) mla_norm_pass(P, lane, gw, NGW); }
__device__ NOINL void ph_rope(int wv_, int which_) { CP P = GETP(); const int which = uni(which_); PH_IDS
    if (which == 0) rope_pass((bf16*)(P->ws + WS_QM), 3072, 128, 16, 192, lane, gw, NGW);
    else rope_pass((bf16*)(P->ws + WS_Z), 6144, 0, 64, 64, lane, gw, NGW); }
__device__ NOINL void ph_attn_mla(int wv_, LAS unsigned char* lds_) { CP P = GETP(); LAS unsigned char* lds = uni_lds(lds_); PH_IDS mla_attn_phase(P, lds, tid); if (PROBE_DUP == 2 || PROBE_DUP == 9) mla_attn_phase(P, lds, tid); }
__device__ NOINL void ph_attn_da(int wv_, LAS unsigned char* lds_, int L_, bool ctx_q) { CP P = GETP(); LAS unsigned char* lds = uni_lds(lds_); const int L = uni(L_); PH_IDS
    const float* lp = P->in[26];
    const float s01 = wave_sum(lp[lane] * lp[64 + lane]), s23 = wave_sum(lp[128 + lane] * lp[192 + lane]);
    const float lam_init = 0.8f - 0.6f * expf(-0.3f * (float)L);
    const float lam = expf(s01) - expf(s23) + lam_init;
    if (PROBE_DUP == 24) { da_attn_phase(P, lam, 1.0f - lam_init, lds, tid, ctx_q, 4); __syncthreads(); }
    if (PROBE_DUP == 25) { da_attn_phase(P, lam, 1.0f - lam_init, lds, tid, ctx_q, 2); __syncthreads(); }
    if (PROBE_DUP == 26) { da_attn_phase(P, lam, 1.0f - lam_init, lds, tid, ctx_q, 12); __syncthreads(); }
    if (!(PROBE_DUP >= 11 && PROBE_DUP <= 15)) da_attn_phase(P, lam, 1.0f - lam_init, lds, tid, ctx_q);
    if (PROBE_DUP == 2 || PROBE_DUP == 10) da_attn_phase(P, lam, 1.0f - lam_init, lds, tid, ctx_q);
    if (PROBE_DUP >= 11 && PROBE_DUP <= 15) { da_attn_phase<PROBE_DUP >= 11 && PROBE_DUP <= 15 ? PROBE_DUP - 10 : 0>(P, lam, 1.0f - lam_init, lds, tid, ctx_q); __syncthreads(); }
    if (PROBE_DUP >= 11 && PROBE_DUP <= 15) da_attn_phase(P, lam, 1.0f - lam_init, lds, tid, ctx_q); }
__device__ NOINL void ph_route(int wv_, LAS unsigned char* lds_, int L_, int M_) { CP P = GETP(); LAS unsigned char* lds = uni_lds(lds_); const int L = uni(L_), Mrows = uni(M_); PH_IDS
#pragma unroll 1
    for (int rep = 0; rep < (PROBE_DUP == 4 ? 2 : 1); ++rep) route_phase(P, L, Mrows, lds, tid, lane, wid, gw, NGW); }
__device__ NOINL void ph_gather(int wv_, LAS unsigned char* lds_, int L_, int M_) { CP P = GETP(); LAS unsigned char* lds = uni_lds(lds_); const int L = uni(L_), Mrows = uni(M_); PH_IDS
    if (PROBE_DUP == 3) { gather_phase<0>(P, L, Mrows, lds, wid, lane, gw, NGW, true); }
    if (PROBE_DUP == 7) { gather_phase<1>(P, L, Mrows, lds, wid, lane, gw, NGW, true); }
    if (PROBE_DUP == 17) { gather_phase<3>(P, L, Mrows, lds, wid, lane, gw, NGW, true); }
    if (PROBE_DUP == 8) { gather_phase<2>(P, L, Mrows, lds, wid, lane, gw, NGW, true); }
    gather_phase<0>(P, L, Mrows, lds, wid, lane, gw, NGW); }

enum GemmId { G_GM_IN = 0, G_GM_OUT, G_MLA_IN, G_MLA_UQ, G_MLA_UKV, G_MLA_OUT, G_DA_IN, G_DA_OUT, G_PEER_Q };
__device__ NOINL void ph_gemm(int wv_, LAS unsigned char* lds_, int id_, int L_, int M_) {
    CP P = GETP(); LAS unsigned char* lds = uni_lds(lds_); const int id = uni(id_), L = uni(L_), Mrows = uni(M_); PH_IDS
    unsigned char* ws = P->ws; const int jj = L / 3;
    size_t a = WS_H, b = 0, o = 0; int M = MT, N = 2048, K = 2048, act = 0, rope = 0;
    switch (id) {
        case G_GM_IN:   a = WS_H;    b = WS_GMWIN + (size_t)jj * 4096 * 2048 * 2;  o = WS_Z;  M = Mrows; N = 4096; K = 2048; act = 1; break;
        case G_GM_OUT:  a = WS_G;    b = WS_GMWOUT + (size_t)jj * 2048 * 2048 * 2; o = WS_Y;  M = Mrows; N = 2048; K = 2048; break;
        case G_MLA_IN:  a = WS_H;    b = WS_MLAIN;  o = WS_C;  N = 1280; K = 2048; break;
        case G_MLA_UQ:  a = WS_CQN;  b = WS_MLAUQ;  o = WS_QM; N = 3072; K = 512;  rope = (ROPE_TEST == 2) ? 0 : 2; break;
        case G_MLA_UKV: a = WS_CKVN; b = WS_MLAUKV; o = WS_KV; N = 4096; K = 512;  break;
        case G_MLA_OUT: a = WS_G;    b = WS_MLAOUT; o = WS_Y;  N = 2048; K = 2048; break;
        case G_DA_IN:   a = WS_H;    b = WS_DAIN;   o = WS_Z;  N = 6144; K = 2048; rope = (ROPE_TEST == 1) ? 0 : 1; break;
        case G_DA_OUT:  a = WS_G;    b = WS_DAOUT;  o = WS_Y;  M = Mrows; N = 2048; K = 2048; break;
        default:        a = WS_H;    b = WS_PWQ + (size_t)L * 2048 * 2048 * 2;     o = WS_QP; M = Mrows; N = 2048; K = 2048; break;
    }
    pg8::Gemm g{(const pg8::bf16_t*)(ws + a), (const pg8::bf16_t*)(ws + b), M, N, K}; pg8::StaticOrder S; S.init(M, N, (int)gridDim.x, id == G_MLA_UKV ? (int)gridDim.x - 1 - (int)blockIdx.x : (int)blockIdx.x);
    pg8::EpiR E{(pg8::bf16_t*)(ws + o), N, act, rope, (const float*)(ws + WS_ROPE)};
#pragma unroll 1
    for (int rep = 0; rep < ((PROBE_DUP == 1 || (PROBE_DUP == 31 && id == G_MLA_OUT) || (PROBE_DUP == 32 && id == G_DA_OUT)) ? 2 : 1); ++rep) { pg8::gemm_phase<pg8::EpiR, pg8::StaticOrder, true, true>((PG8_LAS unsigned char*)lds, g, S, E, tid); __syncthreads(); }
#if TAIL_REMAP
    int TL = -1; bool tail_u = false;
    if (L == 0) { if (id == G_GM_IN) { TL = 0; tail_u = true; } else if (id == G_GM_OUT) { TL = 0; } else if (id == G_PEER_Q) { TL = 1; tail_u = true; } }
    else if (L == 1) { if (id == G_MLA_IN) { TL = 1; } else if (id == G_MLA_OUT) { TL = 2; tail_u = true; } else if (id == G_PEER_Q) { TL = 2; } }
    else if (L == 2) { if (id == G_DA_IN) { TL = 3; tail_u = true; } else if (id == G_DA_OUT) { TL = 3; } }
    if (TL >= 0) {
        const int units = (M / 256) * (N / 256), G = (int)gridDim.x, tail = units % G, c = (int)blockIdx.x;
        const float* src = (tail_u ? P->in[11] : P->in[12]) + (size_t)TL * 16384 * 2048; unsigned char* dst = ws + WS_PU + (size_t)TL * 16384 * PREC;
#else
#if TAIL_L3MOVE
    const bool l3u = (id == G_MLA_IN && L == 1), l3v = (id == G_DA_IN && L == 2), skip = (L == NLAYER - 2) && (id == G_DA_OUT || id == G_PEER_Q);
    const bool l0v = P0_NOV && (id == G_GM_IN && L == 0);
    const bool tail_u = !skip && ((id == G_GM_OUT || id == G_MLA_OUT || id == G_DA_OUT) || l3u), tail_v = !skip && ((id == G_PEER_Q) || l3v || l0v);
    const int TLx = (l3u || l3v) ? NLAYER - 1 : (l0v ? 0 : L + 1);
    if ((tail_u || tail_v) && TLx < NLAYER) {
        const int units = (M / 256) * (N / 256), G = (int)gridDim.x, tail = units % G, c = (int)blockIdx.x;
        const float* src = (tail_u ? P->in[11] : P->in[12]) + (size_t)TLx * 16384 * 2048; unsigned char* dst = ws + WS_PU + (size_t)TLx * 16384 * PREC;
#else
    const bool tail_u = (id == G_GM_OUT || id == G_MLA_OUT || id == G_DA_OUT), tail_v = (id == G_PEER_Q);
    if ((tail_u || tail_v) && L + 1 < NLAYER) {
        const int units = (M / 256) * (N / 256), G = (int)gridDim.x, tail = units % G, c = (int)blockIdx.x;
        const float* src = (tail_u ? P->in[11] : P->in[12]) + (size_t)(L + 1) * 16384 * 2048; unsigned char* dst = ws + WS_PU + (size_t)(L + 1) * 16384 * PREC;
#endif
#endif
        LAS float* scr = (LAS float*)(lds + wid * 16384);
        if (tail != 0 && c >= tail) cvt_table_fp6(src, dst, 16384, tail_u ? U_SCALE : V_SCALE, scr, lane, (c - tail) * NWAVES + wid, (G - tail) * NWAVES, tail_u ? 0 : 1);
        else if (tail == 0) {
#pragma unroll 1
            for (int rep = 0; rep < (PROBE_DUP == 18 ? 3 : 1); ++rep) cvt_table_fp6(src, dst, 16384, tail_u ? U_SCALE : V_SCALE, scr, lane, gw, NGW, tail_u ? 0 : 1); }
    }
}

__global__ void __launch_bounds__(NWAVES * 64, 2) mk_fwd(Params Pv) {
    extern __shared__ __attribute__((aligned(16))) unsigned char lds_g[];
    LAS unsigned char* lds = (LAS unsigned char*)lds_g;
    const int wv = __builtin_amdgcn_readfirstlane((int)threadIdx.x >> 6);
    const int tid = wv * 64 + lane_id_fresh();
    for (int u = tid; u < (LDS_BYTES - RING_BYTES) / 4; u += NWAVES * 64) ((LAS unsigned*)(lds + RING_BYTES))[u] = 0u;
    __syncthreads();
    const int lo = Pv.ph_lo, hi = Pv.ph_hi;
    unsigned* barw = (unsigned*)(Pv.ws + WS_CTL) + CW_BAR;
    XcdBarrier bar; bar.bar = barw; bar.x = 0; bar.st = nullptr;
    if (hi - lo > 1) bar = xcd_barrier_post(barw, (volatile LAS unsigned*)(lds + MISC_OFF) + 8, tid == 0);
    int ph = 0;
#ifndef SEL
#define SELP(k) true
#else
#define SELP(k) ((k) == SEL)
#endif
    enum { RUN_BASE = __COUNTER__ + 1 };
#define RUN(call) do { if (SELP(__COUNTER__ - RUN_BASE) && ph >= lo && ph < hi) { call; } if (ph >= lo && ph + 1 < hi) { xcd_barrier(bar, wv == 0 && lane_id_fresh() == 0); if (PROBE_DUP == 30) { xcd_barrier(bar, wv == 0 && lane_id_fresh() == 0); xcd_barrier(bar, wv == 0 && lane_id_fresh() == 0); } } ++ph; } while (0)
    RUN(ph_prologue(wv, lds));
    RUN(ph_modreduce(wv));
    RUN(ph_first(wv, lds));
#define LAYER(LL) do { constexpr int L = (LL); constexpr int kind = L % 3, jj = L / 3; constexpr int Mrows = (L == NLAYER - 1) ? ML : MT; \
        constexpr bool ctx_dead = (L == NLAYER - 2) && ((NLAYER - 1) % 3 == 0) && (kind != 0); constexpr int Mlive = ctx_dead ? ML : Mrows; \
        if (kind == 0) {                          \
            RUN(ph_gemm(wv, lds, G_GM_IN, L, Mrows)); \
            RUN(ph_vstats(wv, Mrows)); \
            RUN(ph_spatial(wv, lds, jj, Mrows)); \
            RUN(ph_gemm(wv, lds, G_GM_OUT, L, Mrows)); \
        } else if (kind == 1) {                   \
            RUN(ph_gemm(wv, lds, G_MLA_IN, L, Mrows)); \
            RUN(ph_mla_norm(wv)); \
            RUN(ph_gemm(wv, lds, G_MLA_UQ, L, Mrows); ph_gemm(wv, lds, G_MLA_UKV, L, Mrows)); \
            if (ROPE_TEST == 2) { RUN(ph_rope(wv, 0)); } \
            RUN(ph_attn_mla(wv, lds)); \
            RUN(ph_gemm(wv, lds, G_MLA_OUT, L, Mrows)); \
        } else {                                  \
            RUN(ph_gemm(wv, lds, G_DA_IN, L, Mrows); if (ROPE_TEST == 1) { __syncthreads(); } ); \
            if (ROPE_TEST == 1) { RUN(ph_rope(wv, 1)); } \
            RUN(ph_attn_da(wv, lds, L, !ctx_dead)); \
            RUN(ph_gemm(wv, lds, G_DA_OUT, L, Mlive)); \
        } \
        RUN(ph_postmix(wv, lds, L, Mlive));                \
        RUN(ph_gemm(wv, lds, G_PEER_Q, L, Mlive));    \
        RUN(ph_route(wv, lds, L, Mlive));             \
        RUN(ph_gather(wv, lds, L, Mlive));            \
    } while (0)
    LAYER(0); LAYER(1); LAYER(2); LAYER(3);
#undef LAYER
#undef RUN
}

extern "C" void kernel_launch(void* const* d_in, const int* in_sizes, int n_in, void* d_out, int out_size, void* d_ws, size_t ws_size, hipStream_t stream) {
    static int grid = 0;
    if (grid == 0) {
        if (n_in != 29 || in_sizes[0] != ML * DM || out_size != ML * DM || ws_size < WS_END) {
            fprintf(stderr, "kernel_launch: shape mismatch: n_in %d in0 %d out %d ws %zu (need %zu); nothing launched\n", n_in, n_in > 0 ? in_sizes[0] : -1, out_size, ws_size, (size_t)WS_END); grid = -1; return; }
        int dev = 0, cus = 0, per_cu = 0;
        if (hipGetDevice(&dev) != hipSuccess || hipDeviceGetAttribute(&cus, hipDeviceAttributeMultiprocessorCount, dev) != hipSuccess) { fprintf(stderr, "kernel_launch: device query failed\n"); grid = -1; return; }
        if (hipFuncSetAttribute((const void*)mk_fwd, hipFuncAttributeMaxDynamicSharedMemorySize, LDS_BYTES) != hipSuccess) { fprintf(stderr, "kernel_launch: hipFuncSetAttribute failed\n"); grid = -1; return; }
        if (hipOccupancyMaxActiveBlocksPerMultiprocessor(&per_cu, (const void*)mk_fwd, NWAVES * 64, LDS_BYTES) != hipSuccess || per_cu < 1)
            fprintf(stderr, "kernel_launch: note: occupancy query reports %d workgroups per CU\n", per_cu);
        (void)hipGetLastError();
        grid = cus;
    }
    if (grid < 0) return;
    if (hipMemsetAsync((char*)d_ws + WS_CTL, 0, CTL_ZERO_BYTES, stream) != hipSuccess) { fprintf(stderr, "kernel_launch: memset failed\n"); return; }
    Params p{};
    for (int i = 0; i < 29; ++i) p.in[i] = (const float*)d_in[i];
    p.out = (float*)d_out; p.ws = (unsigned char*)d_ws;
#if MK_ONE_LAUNCH
    p.ph_lo = 0; p.ph_hi = NPH;
    hipLaunchKernelGGL(mk_fwd, dim3(grid), dim3(NWAVES * 64), LDS_BYTES, stream, p);
#else
    for (int li = 0; li < NPH; ++li) { p.ph_lo = li; p.ph_hi = li + 1; hipLaunchKernelGGL(mk_fwd, dim3(grid), dim3(NWAVES * 64), LDS_BYTES, stream, p); }
#endif
    const hipError_t le = hipPeekAtLastError();
    if (le != hipSuccess) fprintf(stderr, "kernel_launch: launch failed: %s\n", hipGetErrorName(le));
}
```

```cpp
#include <hip/hip_runtime.h>
#include <cstdio>
#include <cstdint>
#ifndef MK_ONE_LAUNCH
#define MK_ONE_LAUNCH 1
#endif
__device__ __forceinline__ int launder_v(int v) { asm volatile("" : "+v"(v)); return v; }
__device__ __forceinline__ int lane_id_fresh() { unsigned m = ~0u; asm volatile("" : "+s"(m)); return (int)__builtin_amdgcn_mbcnt_hi(m, __builtin_amdgcn_mbcnt_lo(m, 0u)); }
#ifndef WT_STORES
#define WT_STORES 0
#endif
typedef unsigned wt_u32x4 __attribute__((ext_vector_type(4)));
__device__ __forceinline__ void st16_wt(void* p, wt_u32x4 v) {
#if WT_STORES
    asm volatile("global_store_dwordx4 %0, %1, off sc1\n\ts_nop 1" :: "v"(p), "v"(v) : "memory");
#else
    *(wt_u32x4*)p = v;
#endif
}
namespace pg8 {
#define PG8_LAS __attribute__((address_space(3)))
typedef unsigned short bf16_t;
typedef short bf16x8 __attribute__((ext_vector_type(8)));
typedef float f32x4 __attribute__((ext_vector_type(4)));
typedef unsigned u32x4 __attribute__((ext_vector_type(4)));
constexpr int BM = 256, BK = 64, HALF = 128, HTB = HALF * BK * 2  , STAGE_BYTES = 8 * HTB, NXCD = 8, WGM = 8;

__host__ __device__ __forceinline__ int lds_byte(int r, int c) { const int st = (r >> 4) * 2 + (c >> 5), rr = r & 15, cc = c & 31, ob = rr * 64 + cc * 2; return st * 1024 + (ob ^ (((ob >> 9) & 1) << 5)); }
__host__ __device__ __forceinline__ void stage_rc(int b, int& R, int& C) { const int st = b / 1024, sb = b % 1024, swz = sb ^ (((sb >> 9) & 1) << 5); R = (st >> 1) * 16 + swz / 64; C = (st & 1) * 32 + (swz % 64) / 2; }
__host__ __device__ __forceinline__ int perm32(int rho) { const int n = rho >> 4, i = rho & 15; return 8 * (i >> 2) + 4 * n + (i & 3); }

struct Unit { int pm, pn; };
struct Gemm { const bf16_t* A; const bf16_t* Bt; int M, N, K; };

struct StaticOrder {
    int nM, nN, nwg, G, c;
    __host__ __device__ void init(int M, int N, int G_, int c_) { nM = M / BM; nN = N / BM; nwg = nM * nN; G = G_; c = c_; }
    __host__ __device__ bool next(int i, Unit& u) const {
        const long L = (long)i * G + c; if (L >= nwg) return false;
        int wgid = (int)L; { const int q = nwg / NXCD, r = nwg % NXCD, xcd = wgid % NXCD, off = wgid / NXCD; wgid = (xcd < r ? xcd * (q + 1) : r * (q + 1) + (xcd - r) * q) + off; }
        const int nig = WGM * nN, gid = wgid / nig, fm = gid * WGM, gsz = (nM - fm) < WGM ? (nM - fm) : WGM;
        u.pm = fm + ((wgid % nig) % gsz); u.pn = (wgid % nig) / gsz; return true;
    }
    __device__ __forceinline__ void a_ready(const Unit&) const {}
    __device__ __forceinline__ void done(const Unit&) const {}
};

__device__ __forceinline__ unsigned cvt_pk_bf16(float lo, float hi) { unsigned r; asm volatile("v_cvt_pk_bf16_f32 %0, %1, %2" : "=v"(r) : "v"(lo), "v"(hi)); return r; }
typedef float f32x2 __attribute__((ext_vector_type(2)));
__device__ __forceinline__ f32x2 gelu_pk(f32x2 v) {
    const f32x2 av = __builtin_elementwise_abs(v), d = av * 0.2316418882f + 1.0f;
    f32x2 t; t.x = __builtin_amdgcn_rcpf(d.x); t.y = __builtin_amdgcn_rcpf(d.y);
    f32x2 q = t * 0.5307027145f + (-0.7265760135f); q = q * t + 0.7107068705f; q = q * t + (-0.142248368f); q = q * t + 0.127414796f; q = q * t;
    const f32x2 s = (v * v) * (-0.72134752044f);
    f32x2 e; e.x = __builtin_amdgcn_exp2f(s.x); e.y = __builtin_amdgcn_exp2f(s.y);
    const f32x2 m = v * (q * e), r = v - m;
    f32x2 o; o.x = v.x < 0.f ? m.x : r.x; o.y = v.y < 0.f ? m.y : r.y; return o;
}

template <int ACT  > struct EpiBf16 {
    static constexpr bool PERM = true, AFTER_DRAIN = false; static_assert(ACT == 0 || ACT == 1, "EpiBf16: ACT is 0 (none) or 1 (gelu_pk)");
    bf16_t* O; int ldc; const float* bias; int split_cols; size_t split_stride; float scale0;
    __device__ __forceinline__ void operator()(const f32x4 (&acc)[2][2][4][2], const Unit& u, int wr, int wc, int fr, int fq) const {
        const int row0 = u.pm * BM + wr * 64 + fr; int colt = u.pn * BM; bf16_t* base = O;
        float sc = 1.f; if (split_cols) { const int t = colt / split_cols; base += (size_t)t * split_stride; colt -= t * split_cols; if (t == 0) sc = scale0; }
        const int col0 = colt + wc * 32 + 8 * fq, bcol0 = u.pn * BM + wc * 32 + 8 * fq;
        f32x4 bv[2][2];
#pragma unroll
        for (int bj = 0; bj < 2; ++bj)
#pragma unroll
            for (int n = 0; n < 2; ++n) bv[bj][n] = bias ? *(const f32x4*)(bias + bcol0 + bj * HALF + 4 * n) : (f32x4){0.f, 0.f, 0.f, 0.f};
#pragma unroll
        for (int ai = 0; ai < 2; ++ai)
#pragma unroll
            for (int m = 0; m < 4; ++m) { bf16_t* rowp = base + (size_t)(row0 + ai * HALF + m * 16) * ldc + col0;
#pragma unroll
                for (int bj = 0; bj < 2; ++bj) { f32x4 v0 = acc[ai][bj][m][0] + bv[bj][0], v1 = acc[ai][bj][m][1] + bv[bj][1];
                    if (ACT == 1) { f32x2 a = gelu_pk((f32x2){v0[0], v0[1]}), b = gelu_pk((f32x2){v0[2], v0[3]}), c = gelu_pk((f32x2){v1[0], v1[1]}), d = gelu_pk((f32x2){v1[2], v1[3]});
                        v0 = (f32x4){a.x, a.y, b.x, b.y}; v1 = (f32x4){c.x, c.y, d.x, d.y}; }
                    v0 = v0 * sc; v1 = v1 * sc; u32x4 w; w.x = cvt_pk_bf16(v0[0], v0[1]); w.y = cvt_pk_bf16(v0[2], v0[3]); w.z = cvt_pk_bf16(v1[0], v1[1]); w.w = cvt_pk_bf16(v1[2], v1[3]);
                    *(u32x4*)(rowp + bj * HALF) = w; } }
    }
};
template <class Epi, class Sched, bool ALIGN_EPI = false, bool SP2 = false>
__device__ __forceinline__ void gemm_phase(PG8_LAS unsigned char* lds, const Gemm g, const Sched& S, const Epi& E, const int tid_in) {
    const int tid = launder_v(tid_in) & 511, wid = __builtin_amdgcn_readfirstlane(tid >> 6), lane = tid & 63, wr = wid >> 2, wc = wid & 3, fr = lane & 15, fq = lane >> 4;
    const int K = g.K, nt = K / BK;
    unsigned voffA[2], voffB[2];
#pragma unroll
    for (int i = 0; i < 2; ++i) { int R, C; stage_rc(tid * 16 + i * 8192, R, C); const int Rb = Epi::PERM ? ((R & ~31) + perm32(R & 31)) : R;
        voffA[i] = (unsigned)(R * K + C) * 2u; voffB[i] = (unsigned)(Rb * K + C) * 2u; }
    const size_t kstep = (size_t)(BK * 2);
    const size_t hstep = (size_t)HALF * K * 2;
    const size_t tstep = 2 * hstep;
    const unsigned ldsw = (unsigned)wid * 1024u;
    const int aoff = lds_byte(wr * 64 + fr, fq * 8), boff = lds_byte(wc * 32 + fr, fq * 8);
#define PG8_SA(b, h) (((b) * 2 + (h)) * HTB)
#define PG8_SB(b, h) ((4 + (b) * 2 + (h)) * HTB)
#define PG8_STAGE(bufoff, gbase, voff) do { _Pragma("unroll") for (int _i = 0; _i < 2; ++_i) \
        __builtin_amdgcn_global_load_lds((const unsigned*)((const char*)(gbase) + (voff)[_i]), (PG8_LAS unsigned*)(lds + (bufoff) + ldsw + _i * 8192), 16, 0, 0); } while (0)
#define PG8_LDA(dst, b, h) do { _Pragma("unroll") for (int m = 0; m < 4; ++m) _Pragma("unroll") for (int k = 0; k < 2; ++k) dst[m][k] = *(const PG8_LAS bf16x8*)(lds + PG8_SA(b, h) + aoff + m * 2048 + k * 1024); } while (0)
#define PG8_LDB(dst, b, h) do { _Pragma("unroll") for (int n = 0; n < 2; ++n) _Pragma("unroll") for (int k = 0; k < 2; ++k) dst[n][k] = *(const PG8_LAS bf16x8*)(lds + PG8_SB(b, h) + boff + n * 2048 + k * 1024); } while (0)
#define PG8_MMA(ai, bj, At, Bt) do { __builtin_amdgcn_s_setprio(1); _Pragma("unroll") for (int m = 0; m < 4; ++m) _Pragma("unroll") for (int n = 0; n < 2; ++n) _Pragma("unroll") for (int k = 0; k < 2; ++k) \
        acc[ai][bj][m][n] = __builtin_amdgcn_mfma_f32_16x16x32_bf16(Bt[n][k], At[m][k], acc[ai][bj][m][n], 0, 0, 0); __builtin_amdgcn_s_setprio(0); } while (0)
#define PG8_WAIT_V(n) asm volatile("s_waitcnt vmcnt(" #n ")" ::: "memory")
#define PG8_WAIT_L(n) asm volatile("s_waitcnt lgkmcnt(" #n ")" ::: "memory")
#define PG8_BAR __builtin_amdgcn_s_barrier()
#define PG8_SCHED __builtin_amdgcn_sched_barrier(0)
    Unit cur, nxt; int ui = 0;
    if (!S.next(0, cur)) return;
    f32x4 acc[2][2][4][2];
#pragma unroll
    for (int a = 0; a < 2; ++a)
#pragma unroll
        for (int b = 0; b < 2; ++b)
#pragma unroll
            for (int m = 0; m < 4; ++m)
#pragma unroll
                for (int n = 0; n < 2; ++n) acc[a][b][m][n] = (f32x4){0.f, 0.f, 0.f, 0.f};
    bf16x8 At[4][2], B0[2][2], B1[2][2];
    const char* cA = (const char*)g.A + (size_t)cur.pm * tstep; const char* cB = (const char*)g.Bt + (size_t)cur.pn * tstep;
    S.a_ready(cur);
    if constexpr (SP2) {
        PG8_STAGE(PG8_SB(0, 0), cB, voffB); PG8_STAGE(PG8_SB(0, 1), cB + hstep, voffB); PG8_STAGE(PG8_SA(0, 0), cA, voffA); PG8_STAGE(PG8_SA(0, 1), cA + hstep, voffA);
        if (wr == 1) PG8_BAR;
        PG8_WAIT_V(2); PG8_BAR;
        PG8_STAGE(PG8_SB(1, 0), cB + kstep, voffB); PG8_STAGE(PG8_SA(1, 0), cA + kstep, voffA); PG8_STAGE(PG8_SB(1, 1), cB + hstep + kstep, voffB);
        PG8_WAIT_V(6); PG8_BAR;
    } else {
        PG8_STAGE(PG8_SB(0, 0), cB, voffB); PG8_STAGE(PG8_SA(0, 0), cA, voffA); PG8_STAGE(PG8_SB(0, 1), cB + hstep, voffB); PG8_STAGE(PG8_SA(0, 1), cA + hstep, voffA);
        if (wr == 1) PG8_BAR;
        PG8_WAIT_V(4); PG8_BAR;
        PG8_STAGE(PG8_SB(1, 0), cB + kstep, voffB); PG8_STAGE(PG8_SA(1, 0), cA + kstep, voffA); PG8_STAGE(PG8_SB(1, 1), cB + hstep + kstep, voffB);
        PG8_WAIT_V(6); PG8_BAR;
    }
    for (;;) {
        const bool has_next = S.next(ui + 1, nxt);
        const char* nA = has_next ? (const char*)g.A + (size_t)nxt.pm * tstep : cA; const char* nB = has_next ? (const char*)g.Bt + (size_t)nxt.pn * tstep : cB;
        for (int t = 0; t < nt; t += 2) {
            const bool last = (t == nt - 2);
            const char* a1 = cA + (size_t)(t + 1) * kstep;
            const char* a2 = last ? nA : cA + (size_t)(t + 2) * kstep; const char* b2 = last ? nB : cB + (size_t)(t + 2) * kstep;
            const char* a3 = a2 + kstep; const char* b3 = b2 + kstep;
            if (last && has_next) S.a_ready(nxt);
            if constexpr (SP2) {
            PG8_LDB(B0, 0, 0); PG8_LDB(B1, 0, 1); PG8_SCHED; PG8_LDA(At, 0, 0); PG8_STAGE(PG8_SA(1, 1), a1 + hstep, voffA);
            PG8_WAIT_V(8); PG8_WAIT_L(0); PG8_BAR; PG8_MMA(0, 0, At, B0); PG8_MMA(0, 1, At, B1); PG8_BAR; PG8_SCHED;
            PG8_LDA(At, 0, 1); PG8_STAGE(PG8_SB(0, 0), b2, voffB); PG8_STAGE(PG8_SB(0, 1), b2 + hstep, voffB); PG8_STAGE(PG8_SA(0, 0), a2, voffA);
            PG8_WAIT_V(8); PG8_WAIT_L(0); PG8_BAR; PG8_MMA(1, 0, At, B0); PG8_MMA(1, 1, At, B1); PG8_BAR; PG8_SCHED;
            PG8_LDB(B0, 1, 0); PG8_LDB(B1, 1, 1); PG8_SCHED; PG8_LDA(At, 1, 0); PG8_STAGE(PG8_SA(0, 1), a2 + hstep, voffA);
            PG8_WAIT_V(8); PG8_WAIT_L(0); PG8_BAR; PG8_MMA(0, 0, At, B0); PG8_MMA(0, 1, At, B1); PG8_BAR; PG8_SCHED;
            PG8_LDA(At, 1, 1); PG8_STAGE(PG8_SB(1, 0), b3, voffB); PG8_STAGE(PG8_SB(1, 1), b3 + hstep, voffB); PG8_STAGE(PG8_SA(1, 0), a3, voffA);
            PG8_WAIT_V(8); PG8_WAIT_L(0); PG8_BAR; PG8_MMA(1, 0, At, B0); PG8_MMA(1, 1, At, B1); PG8_BAR; PG8_SCHED;
            } else {
            PG8_LDB(B0, 0, 0); PG8_SCHED; PG8_LDA(At, 0, 0); PG8_STAGE(PG8_SA(1, 1), a1 + hstep, voffA);
            PG8_WAIT_L(8); PG8_BAR; PG8_WAIT_L(0); PG8_MMA(0, 0, At, B0); PG8_BAR; PG8_SCHED;
            PG8_LDB(B1, 0, 1); PG8_STAGE(PG8_SB(0, 0), b2, voffB);
            PG8_BAR; PG8_WAIT_L(0); PG8_MMA(0, 1, At, B1); PG8_BAR;
            PG8_LDA(At, 0, 1); PG8_STAGE(PG8_SA(0, 0), a2, voffA);
            PG8_BAR; PG8_WAIT_L(0); PG8_MMA(1, 0, At, B0); PG8_BAR; PG8_SCHED;
            PG8_STAGE(PG8_SB(0, 1), b2 + hstep, voffB);
            PG8_WAIT_V(6); PG8_BAR; PG8_MMA(1, 1, At, B1); PG8_BAR;
            PG8_LDB(B0, 1, 0); PG8_SCHED; PG8_LDA(At, 1, 0); PG8_STAGE(PG8_SA(0, 1), a2 + hstep, voffA);
            PG8_WAIT_L(8); PG8_BAR; PG8_WAIT_L(0); PG8_MMA(0, 0, At, B0); PG8_BAR; PG8_SCHED;
            PG8_LDB(B1, 1, 1); PG8_STAGE(PG8_SB(1, 0), b3, voffB);
            PG8_BAR; PG8_WAIT_L(0); PG8_MMA(0, 1, At, B1); PG8_BAR;
            PG8_LDA(At, 1, 1); PG8_STAGE(PG8_SA(1, 0), a3, voffA);
            PG8_BAR; PG8_WAIT_L(0); PG8_MMA(1, 0, At, B0); PG8_BAR; PG8_SCHED;
            PG8_STAGE(PG8_SB(1, 1), b3 + hstep, voffB);
            PG8_WAIT_V(6); PG8_BAR; PG8_MMA(1, 1, At, B1); PG8_BAR;
            }
        }
        if constexpr (ALIGN_EPI) { if (wr == 0) PG8_BAR; }
        if constexpr (!Epi::AFTER_DRAIN) { E(acc, cur, wr, wc, fr, fq); S.done(cur); }
        if (!has_next) break;
#pragma unroll
        for (int a = 0; a < 2; ++a)
#pragma unroll
            for (int b = 0; b < 2; ++b)
#pragma unroll
                for (int m = 0; m < 4; ++m)
#pragma unroll
                    for (int n = 0; n < 2; ++n) acc[a][b][m][n] = (f32x4){0.f, 0.f, 0.f, 0.f};
        cur = nxt; cA = nA; cB = nB; ++ui;
        if constexpr (ALIGN_EPI) { if (wr == 1) PG8_BAR; }
    }
    PG8_WAIT_V(0);
    if constexpr (!ALIGN_EPI) { if (wr == 0) PG8_BAR; }
    PG8_BAR;
    if constexpr (Epi::AFTER_DRAIN) { E.fused(acc, cur, wr, wc, fr, fq, lds, wid, lane); S.done(cur); }
#undef PG8_SA
#undef PG8_SB
#undef PG8_STAGE
#undef PG8_LDA
#undef PG8_LDB
#undef PG8_MMA
#undef PG8_WAIT_V
#undef PG8_WAIT_L
#undef PG8_BAR
#undef PG8_SCHED
}
}

namespace pg8 {
__device__ __forceinline__ float gelu_tanh(float x) {
    const float t = x * (1.5957691216057308f + 0.07135481627f * x * x);
    const float e = __builtin_amdgcn_exp2f(-1.4426950408889634f * t);
    return x * __builtin_amdgcn_rcpf(1.0f + e);
}
template <int ACT> struct EpiT {
    static constexpr bool PERM = true, AFTER_DRAIN = false;
    bf16_t* O; int ldc;
    __device__ __forceinline__ void operator()(const f32x4 (&acc)[2][2][4][2], const Unit& u, int wr, int wc, int fr, int fq) const {
        const int row0 = u.pm * BM + wr * 64 + fr; const int col0 = u.pn * BM + wc * 32 + 8 * fq;
#pragma unroll
        for (int ai = 0; ai < 2; ++ai)
#pragma unroll
            for (int m = 0; m < 4; ++m) { bf16_t* rowp = O + (size_t)(row0 + ai * HALF + m * 16) * ldc + col0;
#pragma unroll
                for (int bj = 0; bj < 2; ++bj) { f32x4 v0 = acc[ai][bj][m][0], v1 = acc[ai][bj][m][1];
                    if (ACT == 2) { v0 = (f32x4){gelu_tanh(v0[0]), gelu_tanh(v0[1]), gelu_tanh(v0[2]), gelu_tanh(v0[3])}; v1 = (f32x4){gelu_tanh(v1[0]), gelu_tanh(v1[1]), gelu_tanh(v1[2]), gelu_tanh(v1[3])}; }
                    u32x4 w; w.x = cvt_pk_bf16(v0[0], v0[1]); w.y = cvt_pk_bf16(v0[2], v0[3]); w.z = cvt_pk_bf16(v1[0], v1[1]); w.w = cvt_pk_bf16(v1[2], v1[3]);
                    ::st16_wt(rowp + bj * HALF, w); } }
    }
};
struct EpiR {
    static constexpr bool PERM = true, AFTER_DRAIN = false;
    bf16_t* O; int ldc; int act; int rope; const float* ropet;
    __device__ __forceinline__ void operator()(const f32x4 (&acc)[2][2][4][2], const Unit& u, int wr, int wc, int fr, int fq) const {
        const int row0 = u.pm * BM + wr * 64 + fr; const int col0 = u.pn * BM + wc * 32 + 8 * fq;
        const bool rrows = rope != 0 && u.pm < 64;
#pragma unroll
        for (int ai = 0; ai < 2; ++ai)
#pragma unroll
            for (int m = 0; m < 4; ++m) { const int grow = row0 + ai * HALF + m * 16; bf16_t* rowp = O + (size_t)grow * ldc + col0;
#pragma unroll
                for (int bj = 0; bj < 2; ++bj) { f32x4 v0 = acc[ai][bj][m][0], v1 = acc[ai][bj][m][1];
                    if (act) { v0 = (f32x4){gelu_tanh(v0[0]), gelu_tanh(v0[1]), gelu_tanh(v0[2]), gelu_tanh(v0[3])}; v1 = (f32x4){gelu_tanh(v1[0]), gelu_tanh(v1[1]), gelu_tanh(v1[2]), gelu_tanh(v1[3])}; }
                    if (rrows) { const int blk = u.pn * 8 + bj * 4 + wc; const int b6 = blk % 6; const bool on = rope == 1 ? (blk < 128) : (b6 >= 4); const int half = rope == 1 ? (blk & 1) : (b6 - 4);
                        if (on) { const int t = grow & 8191; const int pos = half ? (t & 63) : (t >> 6);
                            const float* cp = ropet + pos * 16 + 8 * (fq & 1); const f32x4 c0 = *(const f32x4*)cp, c1 = *(const f32x4*)(cp + 4), s0 = *(const f32x4*)(cp + 2048), s1 = *(const f32x4*)(cp + 2052);
                            f32x4 p0, p1;
#pragma unroll
                            for (int i = 0; i < 4; ++i) { const float a_ = v0[i], b_ = v1[i];
                                const auto r0 = __builtin_amdgcn_permlane32_swap(__float_as_uint(a_), __float_as_uint(a_), false, false);
                                const auto r1 = __builtin_amdgcn_permlane32_swap(__float_as_uint(b_), __float_as_uint(b_), false, false);
                                const unsigned x0_ = (fq & 2) ? r0[0] : r0[1], x1_ = (fq & 2) ? r1[0] : r1[1]; p0[i] = __uint_as_float(x0_); p1[i] = __uint_as_float(x1_); }
                            if (fq & 2) { v0 = p0 * s0 + v0 * c0; v1 = p1 * s1 + v1 * c1; } else { v0 = v0 * c0 - p0 * s0; v1 = v1 * c1 - p1 * s1; } } }
                    u32x4 w; w.x = cvt_pk_bf16(v0[0], v0[1]); w.y = cvt_pk_bf16(v0[2], v0[3]); w.z = cvt_pk_bf16(v1[0], v1[1]); w.w = cvt_pk_bf16(v1[2], v1[3]);
                    ::st16_wt(rowp + bj * HALF, w); } }
    }
};
}

constexpr int DM = 2048, NBATCH = 2, SEQ = 8192, CTXL = 256;
constexpr int ML = NBATCH * SEQ;
constexpr int MC = NBATCH * CTXL;
constexpr int MT = ML + MC;
constexpr int NLAYER = 4;
constexpr float ALPHA = 1.6817928305074290f, LN_EPS = 1e-6f;
constexpr int NWAVES = 8;
constexpr float U_SCALE = 64.0f, V_SCALE = 4.0f;
constexpr int PROW = 1536;
#ifndef PEER_V4
#define PEER_V4 1
#endif
#ifndef PEER_U4
#define PEER_U4 1
#endif
constexpr int PREC = PEER_U4 ? 2048 : PEER_V4 ? 2560 : 2 * PROW;
constexpr int NPH = 35;

constexpr size_t MiB = 1ull << 20;
constexpr size_t WS_CTL = 0, CTL_ZERO_BYTES = 1 * MiB;
constexpr int    CW_BAR = 4096;
constexpr size_t WS_MOD = 128 * 1024;
constexpr size_t WS_VST = 1 * MiB;
constexpr size_t WS_ROPE = 1 * MiB + 160 * 1024;
constexpr size_t WS_MODP = 1 * MiB + 256 * 1024;
constexpr size_t WS_GMWIN = 6 * MiB;
constexpr size_t WS_GMWOUT = WS_GMWIN + 32 * MiB;
constexpr size_t WS_GMWS = WS_GMWOUT + 16 * MiB;
constexpr size_t WS_PWQ = WS_GMWS + 1 * MiB;
constexpr size_t WS_PK1 = WS_PWQ + 32 * MiB;
constexpr size_t WS_PK2 = WS_PK1 + 512 * 1024;
constexpr size_t WS_MLAIN = WS_PK1 + 1 * MiB;
constexpr size_t WS_MLAUQ = WS_MLAIN + 5 * MiB;
constexpr size_t WS_MLAUKV = WS_MLAUQ + 3 * MiB;
constexpr size_t WS_MLAOUT = WS_MLAUKV + 4 * MiB;
constexpr size_t WS_DAIN = WS_MLAOUT + 8 * MiB;
constexpr size_t WS_DAOUT = WS_DAIN + 24 * MiB;
constexpr size_t WS_PU = WS_DAOUT + 8 * MiB;
constexpr size_t WS_PV = WS_PU + 96 * MiB;
constexpr size_t WS_X = WS_PV + 96 * MiB;
constexpr size_t WS_H = WS_X + 66 * MiB;
constexpr size_t WS_G = WS_H + 66 * MiB;
constexpr size_t WS_Y = WS_G + 66 * MiB;
constexpr size_t WS_QP = WS_Y + 66 * MiB;
constexpr size_t WS_Z = WS_QP + 66 * MiB;
constexpr size_t WS_C = WS_Z + 198 * MiB;
constexpr size_t WS_CQN = WS_C + 42 * MiB;
constexpr size_t WS_CKVN = WS_CQN + 17 * MiB;
constexpr size_t WS_KR = WS_CKVN + 17 * MiB;
constexpr size_t WS_QM = WS_KR + 3 * MiB;
constexpr size_t WS_KV = WS_QM + 99 * MiB;
constexpr size_t WS_ROUTE = WS_KV + 132 * MiB;
constexpr size_t WS_END = WS_ROUTE + 17 * MiB;
static_assert((size_t)MT * DM * 2 == 66 * MiB, "row buffer size");

constexpr int RING_BYTES = 155648, MISC_OFF = RING_BYTES + 320, LDS_BYTES = 159744;

#define GAS __attribute__((address_space(1)))
#define LAS __attribute__((address_space(3)))
typedef unsigned short bf16;
typedef unsigned u32x4 __attribute__((ext_vector_type(4)));
typedef unsigned u32x2 __attribute__((ext_vector_type(2)));
typedef float f32x4 __attribute__((ext_vector_type(4)));
typedef float f32x16 __attribute__((ext_vector_type(16)));
typedef short bf16x8 __attribute__((ext_vector_type(8)));
typedef short s16x4 __attribute__((ext_vector_type(4)));
#define LDS_WAIT() asm volatile("s_waitcnt lgkmcnt(0)" ::: "memory")

__device__ __forceinline__ unsigned cvtpk(float lo, float hi) { unsigned r; asm("v_cvt_pk_bf16_f32 %0, %1, %2" : "=v"(r) : "v"(lo), "v"(hi)); return r; }
__device__ __forceinline__ float bflo(unsigned w) { return __uint_as_float(w << 16); }
__device__ __forceinline__ float bfhi(unsigned w) { return __uint_as_float(w & 0xffff0000u); }
__device__ __forceinline__ float bf1(bf16 b) { return __uint_as_float((unsigned)b << 16); }
__device__ __forceinline__ bf16 tobf1(float f) { return (bf16)(cvtpk(f, 0.f) & 0xffffu); }
#define DPP_F(v, ctrl) __int_as_float(__builtin_amdgcn_mov_dpp(__float_as_int(v), (ctrl), 0xF, 0xF, true))
__device__ __forceinline__ float row_sum16(float v) { v += DPP_F(v, 0xB1); v += DPP_F(v, 0x4E); v += DPP_F(v, 0x141); v += DPP_F(v, 0x140); return v; }
__device__ __forceinline__ float sum_xor16(float v) { const auto r = __builtin_amdgcn_permlane16_swap(__float_as_uint(v), __float_as_uint(v), false, false); return __uint_as_float(r[0]) + __uint_as_float(r[1]); }
__device__ __forceinline__ float sum_xor32(float v) { const auto r = __builtin_amdgcn_permlane32_swap(__float_as_uint(v), __float_as_uint(v), false, false); return __uint_as_float(r[0]) + __uint_as_float(r[1]); }
__device__ __forceinline__ float wave_sum(float v) { return sum_xor32(sum_xor16(row_sum16(v))); }
__device__ __forceinline__ float half_sum32(float v) { return sum_xor16(row_sum16(v)); }
__device__ __forceinline__ float lane_xor16(float v, int lane) { const auto r = __builtin_amdgcn_permlane16_swap(__float_as_uint(v), __float_as_uint(v), false, false); return __uint_as_float((lane & 16) ? r[0] : r[1]); }
__device__ __forceinline__ unsigned lane_xor32(unsigned v, int lane) { const auto r = __builtin_amdgcn_permlane32_swap(v, v, false, false); return (lane & 32) ? r[0] : r[1]; }
__device__ __forceinline__ float gelu_tanh(float x) { return pg8::gelu_tanh(x); }

__device__ __forceinline__ void load_row_bf16(const bf16* row, int lane, float (&v)[32]) {
#pragma unroll
    for (int j = 0; j < 4; ++j) { const u32x4 w = ((const u32x4*)row)[64 * j + lane];
        v[8 * j + 0] = bflo(w.x); v[8 * j + 1] = bfhi(w.x); v[8 * j + 2] = bflo(w.y); v[8 * j + 3] = bfhi(w.y);
        v[8 * j + 4] = bflo(w.z); v[8 * j + 5] = bfhi(w.z); v[8 * j + 6] = bflo(w.w); v[8 * j + 7] = bfhi(w.w); }
}
__device__ __forceinline__ void load_row_bf16_nt(const bf16* row, int lane, float (&v)[32]) {
#pragma unroll
    for (int j = 0; j < 4; ++j) { const u32x4 w = __builtin_nontemporal_load(&((const u32x4*)row)[64 * j + lane]);
        v[8 * j + 0] = bflo(w.x); v[8 * j + 1] = bfhi(w.x); v[8 * j + 2] = bflo(w.y); v[8 * j + 3] = bfhi(w.y);
        v[8 * j + 4] = bflo(w.z); v[8 * j + 5] = bfhi(w.z); v[8 * j + 6] = bflo(w.w); v[8 * j + 7] = bfhi(w.w); }
}
__device__ __forceinline__ void store_row_bf16(bf16* row, int lane, const float (&v)[32]) {
#pragma unroll
    for (int j = 0; j < 4; ++j) { u32x4 w; w.x = cvtpk(v[8 * j + 0], v[8 * j + 1]); w.y = cvtpk(v[8 * j + 2], v[8 * j + 3]); w.z = cvtpk(v[8 * j + 4], v[8 * j + 5]); w.w = cvtpk(v[8 * j + 6], v[8 * j + 7]);
        ((u32x4*)row)[64 * j + lane] = w; }
}
__device__ __forceinline__ void load_row_f32(const float* row, int lane, float (&v)[32]) {
#pragma unroll
    for (int j = 0; j < 4; ++j) { const f32x4 a = ((const f32x4*)row)[128 * j + 2 * lane], b = ((const f32x4*)row)[128 * j + 2 * lane + 1];
        v[8 * j + 0] = a.x; v[8 * j + 1] = a.y; v[8 * j + 2] = a.z; v[8 * j + 3] = a.w; v[8 * j + 4] = b.x; v[8 * j + 5] = b.y; v[8 * j + 6] = b.z; v[8 * j + 7] = b.w; }
}
__device__ __forceinline__ void load_row_f32_nt(const float* row, int lane, float (&v)[32]) {
#pragma unroll
    for (int j = 0; j < 4; ++j) { const f32x4 a = __builtin_nontemporal_load(&((const f32x4*)row)[128 * j + 2 * lane]), b = __builtin_nontemporal_load(&((const f32x4*)row)[128 * j + 2 * lane + 1]);
        v[8 * j + 0] = a.x; v[8 * j + 1] = a.y; v[8 * j + 2] = a.z; v[8 * j + 3] = a.w; v[8 * j + 4] = b.x; v[8 * j + 5] = b.y; v[8 * j + 6] = b.z; v[8 * j + 7] = b.w; }
}
__device__ __forceinline__ void store_row_f32(float* row, int lane, const float (&v)[32]) {
#pragma unroll
    for (int j = 0; j < 4; ++j) { ((f32x4*)row)[128 * j + 2 * lane] = (f32x4){v[8 * j + 0], v[8 * j + 1], v[8 * j + 2], v[8 * j + 3]};
        ((f32x4*)row)[128 * j + 2 * lane + 1] = (f32x4){v[8 * j + 4], v[8 * j + 5], v[8 * j + 6], v[8 * j + 7]}; }
}
__device__ __forceinline__ void load_row_bf16_b(const bf16* row, int lane, float (&v)[32]) {
#pragma unroll
    for (int j = 0; j < 4; ++j) { const u32x4 w = ((const u32x4*)row)[4 * lane + j];
        v[8 * j + 0] = bflo(w.x); v[8 * j + 1] = bfhi(w.x); v[8 * j + 2] = bflo(w.y); v[8 * j + 3] = bfhi(w.y);
        v[8 * j + 4] = bflo(w.z); v[8 * j + 5] = bfhi(w.z); v[8 * j + 6] = bflo(w.w); v[8 * j + 7] = bfhi(w.w); }
}
__device__ __forceinline__ void store_row_bf16_b(bf16* row, int lane, const float (&v)[32]) {
#pragma unroll
    for (int j = 0; j < 4; ++j) { u32x4 w; w.x = cvtpk(v[8 * j + 0], v[8 * j + 1]); w.y = cvtpk(v[8 * j + 2], v[8 * j + 3]); w.z = cvtpk(v[8 * j + 4], v[8 * j + 5]); w.w = cvtpk(v[8 * j + 6], v[8 * j + 7]);
        ((u32x4*)row)[4 * lane + j] = w; }
}
__device__ __forceinline__ void load_row_f32_b(const float* row, int lane, float (&v)[32]) {
#pragma unroll
    for (int q = 0; q < 8; ++q) { const f32x4 a = ((const f32x4*)row)[8 * lane + q];
        v[4 * q + 0] = a.x; v[4 * q + 1] = a.y; v[4 * q + 2] = a.z; v[4 * q + 3] = a.w; }
}
__device__ __forceinline__ void store_row_f32_b(float* row, int lane, const float (&v)[32]) {
#pragma unroll
    for (int q = 0; q < 8; ++q) ((f32x4*)row)[8 * lane + q] = (f32x4){v[4 * q + 0], v[4 * q + 1], v[4 * q + 2], v[4 * q + 3]};
}
__device__ __forceinline__ void store_row_f32_b_nt(float* row, int lane, const float (&v)[32]) {
#pragma unroll
    for (int q = 0; q < 8; ++q) __builtin_nontemporal_store((f32x4){v[4 * q + 0], v[4 * q + 1], v[4 * q + 2], v[4 * q + 3]}, &((f32x4*)row)[8 * lane + q]);
}
__device__ __forceinline__ void ln_stats(const float (&v)[32], float& mean, float& rstd) {
    float s = 0.f;
#pragma unroll
    for (int i = 0; i < 32; ++i) s += v[i];
    mean = wave_sum(s) * (1.0f / DM);
    float q = 0.f;
#pragma unroll
    for (int i = 0; i < 32; ++i) { const float d = v[i] - mean; q += d * d; }
    rstd = 1.0f / sqrtf(wave_sum(q) * (1.0f / DM) + LN_EPS);
}
template <bool LAYB>
__device__ __forceinline__ void finish_row(float (&z)[32], const float* lng, const float* lnb, bf16* Xrow, const float* sh, const float* sc, bf16* Hrow, float* Orow, int lane) {
    float mean, rstd; ln_stats(z, mean, rstd);
    { float g[32], b[32]; if (LAYB) { load_row_f32_b(lng, lane, g); load_row_f32_b(lnb, lane, b); } else { load_row_f32(lng, lane, g); load_row_f32(lnb, lane, b); }
#pragma unroll
      for (int i = 0; i < 32; ++i) z[i] = (z[i] - mean) * rstd * g[i] + b[i]; }
    if (Xrow) { if (LAYB) store_row_bf16_b(Xrow, lane, z); else store_row_bf16(Xrow, lane, z); }
    if (Orow) { if (LAYB) store_row_f32_b(Orow, lane, z); else store_row_f32(Orow, lane, z); }
    if (Hrow) {
        ln_stats(z, mean, rstd);
        float a[32], s[32]; if (LAYB) { load_row_f32_b(sc, lane, a); load_row_f32_b(sh, lane, s); } else { load_row_f32(sc, lane, a); load_row_f32(sh, lane, s); }
#pragma unroll
        for (int i = 0; i < 32; ++i) a[i] = (z[i] - mean) * rstd * (1.0f + a[i]) + s[i];
        if (LAYB) store_row_bf16_b(Hrow, lane, a); else store_row_bf16(Hrow, lane, a);
    }
}
__device__ __forceinline__ int row_slot(int row) { return row < ML ? (row >> 13) : 2; }

__device__ __forceinline__ unsigned f2bf_rne(float f) { unsigned u = __float_as_uint(f); return (u + 0x7fffu + ((u >> 16) & 1u)) >> 16; }
__device__ __forceinline__ unsigned pk2(float lo, float hi) { return f2bf_rne(lo) | (f2bf_rne(hi) << 16); }
#ifndef GEMV_PIPE
#define GEMV_PIPE 1
#endif
#ifndef NT_ACT
#define NT_ACT 0
#endif
#ifndef NT_STREAM
#define NT_STREAM 1
#endif
__device__ __forceinline__ void p0_transpose_item(const float* W, int K, int N, bf16* WT, LAS float* scr, int item, int lane) {
    const int nblk = N / 32, kb = item / nblk, nb = item % nblk, k0 = 64 * kb, n0 = 32 * nb;
    f32x4 t[8];
#pragma unroll
    for (int i = 0; i < 8; ++i) { const f32x4* p_ = (const f32x4*)(W + (size_t)(k0 + 8 * i + (lane >> 3)) * N + n0 + 4 * (lane & 7)); t[i] = NT_STREAM ? __builtin_nontemporal_load(p_) : *p_; }
#pragma unroll
    for (int i = 0; i < 8; ++i) { LAS float* d = scr + (8 * i + (lane >> 3)) * 33 + 4 * (lane & 7); d[0] = t[i].x; d[1] = t[i].y; d[2] = t[i].z; d[3] = t[i].w; }
    LDS_WAIT(); asm volatile("" ::: "memory");
    const int c = lane & 7;
#pragma unroll
    for (int j = 0; j < 4; ++j) { const int n = (lane >> 3) + 8 * j; const LAS float* s = scr + (8 * c) * 33 + n;
        u32x4 o; o.x = pk2(s[0 * 33], s[1 * 33]); o.y = pk2(s[2 * 33], s[3 * 33]); o.z = pk2(s[4 * 33], s[5 * 33]); o.w = pk2(s[6 * 33], s[7 * 33]);
        *(u32x4*)(WT + (size_t)(n0 + n) * K + k0 + 8 * c) = o; }
    LDS_WAIT(); asm volatile("" ::: "memory");
}
__device__ __forceinline__ void cvt_range(const float* src, bf16* dst, size_t n8, size_t gtid, size_t gthreads) {
#pragma unroll 4
    for (size_t i = gtid; i < n8; i += gthreads) { const f32x4 a = ((const f32x4*)src)[2 * i], b = ((const f32x4*)src)[2 * i + 1];
        u32x4 w; w.x = cvtpk(a.x, a.y); w.y = cvtpk(a.z, a.w); w.z = cvtpk(b.x, b.y); w.w = cvtpk(b.z, b.w); ((u32x4*)dst)[i] = w; }
}
__device__ __forceinline__ unsigned enc_e2m3(float x) {
    const unsigned sgn = (__float_as_uint(x) >> 26) & 32u;
    const float ax = fminf(fabsf(x), 7.5f);
    unsigned u = __float_as_uint(ax); u += 0x7FFFFu + ((u >> 20) & 1u);
    const unsigned cn = (u >> 20) - ((127u - 1u) << 3);
    const unsigned cs = (unsigned)__builtin_rintf(ax * 8.0f);
    return sgn | (ax < 1.0f ? cs : cn);
}
#ifndef EMU_FP4V
#define EMU_FP4V 0
#endif
#ifndef CVT_PIPE
#define CVT_PIPE 0
#endif
typedef float f32x2v __attribute__((ext_vector_type(2)));
typedef float f32x16v __attribute__((ext_vector_type(16)));
typedef float f32x32v __attribute__((ext_vector_type(32)));
typedef unsigned u32x6v __attribute__((ext_vector_type(6)));
__device__ __forceinline__ u32x6v pack_fp6_32(const float (&e)[32], bool interleaved) {
    f32x16v s0, s1;
    if (interleaved) {
#pragma unroll
        for (int i = 0; i < 16; ++i) { s0[i] = e[2 * i]; s1[i] = e[2 * i + 1]; }
    } else {
#pragma unroll
        for (int i = 0; i < 16; ++i) { s0[i] = e[i]; s1[i] = e[16 + i]; }
    }
    return __builtin_amdgcn_cvt_scalef32_2xpk16_fp6_f32(s0, s1, 1.0f);
}
__device__ __forceinline__ void cvt_table_fp6(const float* src, unsigned char* dst, int nrows, float scale, LAS float* scr  , int lane, int gw, int NGW, const int isv) {
    bool interleaved;
    {
        float t[32];
#pragma unroll
        for (int k = 0; k < 32; ++k) t[k] = k < 16 ? 0.125f * k : (k < 24 ? 2.0f + 0.25f * (k - 16) : 4.0f + 0.5f * (k - 24));
        float tt[32];
#pragma unroll
        for (int k = 0; k < 32; ++k) { tt[k] = t[k]; asm volatile("" : "+v"(tt[k])); }
        const u32x6v p = pack_fp6_32(tt, true);
        const f32x32v o = __builtin_amdgcn_cvt_scalef32_pk32_f32_fp6(p, 1.0f);
        interleaved = (o[1] == t[1]) && (o[2] == t[2]) && (o[17] == t[17]);
        interleaved = __all(interleaved);
    }
#if CVT_PIPE
    f32x4 nx[8];
    if (gw < nrows) { const f32x4* s4 = (const f32x4*)(src + (size_t)gw * 2048);
#pragma unroll
        for (int q = 0; q < 8; ++q) nx[q] = s4[64 * q + lane]; }
    for (int row = gw; row < nrows; row += NGW) {
        f32x4 cur[8];
#pragma unroll
        for (int q = 0; q < 8; ++q) cur[q] = nx[q];
        if (row + NGW < nrows) { const f32x4* s4 = (const f32x4*)(src + (size_t)(row + NGW) * 2048);
#pragma unroll
            for (int q = 0; q < 8; ++q) nx[q] = s4[64 * q + lane]; }
#pragma unroll
        for (int q = 0; q < 8; ++q) { const int s = 64 * q + lane; const f32x4 a = cur[q] * scale; *(LAS f32x4*)(scr + 4 * (s ^ ((s >> 4) & 7))) = a; }
#else
    bool fp4_swapped = false;
    if (PEER_V4) {
        float t0 = 1.0f, t1 = 2.0f; asm volatile("" : "+v"(t0), "+v"(t1));
        const unsigned pw = __builtin_amdgcn_cvt_scalef32_pk_fp4_f32(0u, t0, t1, 1.0f, 0);
        const f32x2v pr = __builtin_amdgcn_cvt_scalef32_pk_f32_fp4(pw, 1.0f, 0);
        fp4_swapped = !__all(pr[0] == 1.0f);
    }
    for (int row = gw; row < nrows; row += NGW) {
        const f32x4* s4 = (const f32x4*)(src + (size_t)row * 2048);
#pragma unroll
        for (int q = 0; q < 8; ++q) { const int s = 64 * q + lane; const f32x4 a = (NT_STREAM ? __builtin_nontemporal_load(&s4[s]) : s4[s]) * scale; *(LAS f32x4*)(scr + 4 * (s ^ ((s >> 4) & 7))) = a; }
#endif
        float e[32];
#pragma unroll
        for (int j = 0; j < 8; ++j) { const int s = 8 * lane + j; const f32x4 a = *(const LAS f32x4*)(scr + 4 * (s ^ ((s >> 4) & 7)));
            e[4 * j + 0] = __builtin_amdgcn_fmed3f(a.x, -7.5f, 7.5f); e[4 * j + 1] = __builtin_amdgcn_fmed3f(a.y, -7.5f, 7.5f); e[4 * j + 2] = __builtin_amdgcn_fmed3f(a.z, -7.5f, 7.5f); e[4 * j + 3] = __builtin_amdgcn_fmed3f(a.w, -7.5f, 7.5f); }
#if EMU_FP4V
        if (EMU_FP4V == 2 ? !isv : isv) {
#pragma unroll
            for (int i = 0; i < 32; ++i) { const float a = fabsf(e[i]); float q = a < 2.0f ? rintf(a * 2.0f) * 0.5f : (a < 4.0f ? rintf(a) : fminf(rintf(a * 0.5f) * 2.0f, 6.0f)); e[i] = copysignf(q, e[i]); }
        }
#endif
        unsigned char* rowp = dst + (size_t)row * PREC;
        if (PEER_V4 && (isv || PEER_U4)) {
            u32x4 w4;
#pragma unroll
            for (int w = 0; w < 4; ++w) { unsigned d = 0u; float x_[8];
#pragma unroll
                for (int i = 0; i < 8; i += 2) { const float x0 = __builtin_amdgcn_fmed3f(e[8 * w + i], -6.0f, 6.0f), x1 = __builtin_amdgcn_fmed3f(e[8 * w + i + 1], -6.0f, 6.0f); x_[i] = fp4_swapped ? x1 : x0; x_[i + 1] = fp4_swapped ? x0 : x1; }
                d = __builtin_amdgcn_cvt_scalef32_pk_fp4_f32(d, x_[0], x_[1], 1.0f, 0); d = __builtin_amdgcn_cvt_scalef32_pk_fp4_f32(d, x_[2], x_[3], 1.0f, 1);
                d = __builtin_amdgcn_cvt_scalef32_pk_fp4_f32(d, x_[4], x_[5], 1.0f, 2); d = __builtin_amdgcn_cvt_scalef32_pk_fp4_f32(d, x_[6], x_[7], 1.0f, 3);
                w4[w] = d; }
            *(u32x4*)(rowp + ((isv || !PEER_U4) ? 1024 : 0) + 16 * lane) = w4;
            continue;
        }
        const u32x6v p = pack_fp6_32(e, interleaved);
        *(u32x4*)(rowp + 1024 * isv + 16 * lane) = (u32x4){p[0], p[1], p[2], p[3]}; *(u32x2*)(rowp + 2048 + 512 * isv + 8 * lane) = (u32x2){p[4], p[5]};
    }
}
__device__ __forceinline__ float silu(float x) { return x / (1.0f + __expf(-x)); }

struct Params { const float* in[29]; float* out; unsigned char* ws; int ph_lo, ph_hi; };
typedef const __attribute__((address_space(4))) Params* CP;

#ifndef P0_NOV
#define P0_NOV 0
#endif
#ifndef TAIL_REMAP
#define TAIL_REMAP 0
#endif
__device__ __forceinline__ void p0_prologue(CP P, LAS unsigned char* lds, int tid, int lane, int wid, int gw, int NGW, const int parts = 7) {
    unsigned char* ws = P->ws;
    LAS float* scr = (LAS float*)(lds + wid * 16384);
    if (parts & 1) {
        constexpr int I_GMIN = (2048 / 64) * (4096 / 32), I_SQ = (2048 / 64) * (2048 / 32), I_MIN = (2048 / 64) * (1088 / 32), I_UQ = (512 / 64) * (3072 / 32), I_UKV = (512 / 64) * (4096 / 32), I_DIN = (2048 / 64) * (6144 / 32);
        constexpr int NIT = 2 * I_GMIN + 2 * I_SQ + 4 * I_SQ + I_MIN + I_UQ + I_UKV + I_SQ + I_DIN + I_SQ;
        for (int it = gw; it < NIT; it += NGW) {
            int r = it;
            if (r < 2 * I_GMIN) { const int j = r / I_GMIN; p0_transpose_item(P->in[13] + (size_t)j * 2048 * 4096, 2048, 4096, (bf16*)(ws + WS_GMWIN) + (size_t)j * 4096 * 2048, scr, r % I_GMIN, lane); continue; } r -= 2 * I_GMIN;
            if (r < 2 * I_SQ) { const int j = r / I_SQ; p0_transpose_item(P->in[18] + (size_t)j * 2048 * 2048, 2048, 2048, (bf16*)(ws + WS_GMWOUT) + (size_t)j * 2048 * 2048, scr, r % I_SQ, lane); continue; } r -= 2 * I_SQ;
            if (r < 4 * I_SQ) { const int j = r / I_SQ; p0_transpose_item(P->in[8] + (size_t)j * 2048 * 2048, 2048, 2048, (bf16*)(ws + WS_PWQ) + (size_t)j * 2048 * 2048, scr, r % I_SQ, lane); continue; } r -= 4 * I_SQ;
            if (r < I_MIN) { p0_transpose_item(P->in[19], 2048, 1088, (bf16*)(ws + WS_MLAIN), scr, r, lane); continue; } r -= I_MIN;
            if (r < I_UQ) { p0_transpose_item(P->in[22], 512, 3072, (bf16*)(ws + WS_MLAUQ), scr, r, lane); continue; } r -= I_UQ;
            if (r < I_UKV) { p0_transpose_item(P->in[23], 512, 4096, (bf16*)(ws + WS_MLAUKV), scr, r, lane); continue; } r -= I_UKV;
            if (r < I_SQ) { p0_transpose_item(P->in[24], 2048, 2048, (bf16*)(ws + WS_MLAOUT), scr, r, lane); continue; } r -= I_SQ;
            if (r < I_DIN) { p0_transpose_item(P->in[25], 2048, 6144, (bf16*)(ws + WS_DAIN), scr, r, lane); continue; } r -= I_DIN;
            p0_transpose_item(P->in[28], 2048, 2048, (bf16*)(ws + WS_DAOUT), scr, r, lane);
        }
    }
    const size_t gtid = (size_t)gw * 64 + lane, gthreads = (size_t)NGW * 64;
    if (parts & 2) {
    { u32x4* z = (u32x4*)((bf16*)(ws + WS_MLAIN) + (size_t)1088 * 2048); const size_t n = (size_t)192 * 2048 / 8;
      for (size_t i = gtid; i < n; i += gthreads) z[i] = (u32x4){0u, 0u, 0u, 0u}; }
    cvt_range(P->in[16], (bf16*)(ws + WS_GMWS), (size_t)2 * 16 * 128 * 128 / 8, gtid, gthreads);
    cvt_range(P->in[9], (bf16*)(ws + WS_PK1), (size_t)4 * 128 * 128 / 8, gtid, gthreads);
    cvt_range(P->in[10], (bf16*)(ws + WS_PK2), (size_t)4 * 128 * 128 / 8, gtid, gthreads);
#if !TAIL_REMAP
    cvt_table_fp6(P->in[11], ws + WS_PU, 16384, U_SCALE, scr, lane, gw, NGW, 0);
    if (!P0_NOV) cvt_table_fp6(P->in[12], ws + WS_PU, 16384, V_SCALE, scr, lane, gw, NGW, 1);
#endif
    if (gtid < 2048) { const int pos = (int)gtid >> 4, f = (int)gtid & 15; const float inv = powf(10000.0f, -(float)f * (1.0f / 16.0f)); float sn, cs; sincosf((float)pos * inv, &sn, &cs);
        float* rt = (float*)(ws + WS_ROPE); rt[gtid] = cs; rt[2048 + gtid] = sn; }
    }
    if (parts & 4) {
        const float* cv = P->in[1]; const float* cc = P->in[3]; const float* mw = P->in[4]; float* PART = (float*)(ws + WS_MODP);
        LAS float* S = (LAS float*)lds;
        __syncthreads();
        { float t_[12];
#pragma unroll
          for (int t = 0; t < 12; ++t) { const int i = tid + t * NWAVES * 64, sl = i >> 11, kk = i & 2047; t_[t] = sl == 0 ? cv[kk] : (sl == 1 ? cv[2048 + kk] : cc[kk]); }
#pragma unroll
          for (int t = 0; t < 12; ++t) S[tid + t * NWAVES * 64] = silu(t_[t]); }
        __syncthreads();
        for (int item = gw; item < 4 * 192 * 8; item += NGW) {
            const int ks = item & 7, r = item >> 3, L = r / 192, n = (r % 192) * 64 + lane;
            const float* W = mw + (size_t)L * 2048 * 12288 + (size_t)(ks * 256) * 12288 + n;
            float a0 = 0.f, a1 = 0.f, a2 = 0.f;
#if GEMV_PIPE
#define GV_LD(dst_, kb_) do { _Pragma("unroll") for (int t = 0; t < 32; ++t) dst_[t] = NT_STREAM ? __builtin_nontemporal_load(&W[(size_t)((kb_) + t) * 12288]) : W[(size_t)((kb_) + t) * 12288]; } while (0)
            float wa[32], wb[32];
            GV_LD(wa, 0);
#pragma unroll 1
            for (int kb = 0; kb < 256; kb += 64) {
                GV_LD(wb, kb + 32);
#pragma unroll
                for (int t = 0; t < 32; ++t) { const int kk = ks * 256 + kb + t; a0 += S[kk] * wa[t]; a1 += S[2048 + kk] * wa[t]; a2 += S[4096 + kk] * wa[t]; }
                if (kb + 64 < 256) GV_LD(wa, kb + 64);
#pragma unroll
                for (int t = 0; t < 32; ++t) { const int kk = ks * 256 + kb + 32 + t; a0 += S[kk] * wb[t]; a1 += S[2048 + kk] * wb[t]; a2 += S[4096 + kk] * wb[t]; }
            }
#undef GV_LD
#else
#pragma unroll 32
            for (int k = 0; k < 256; ++k) { const int kk = ks * 256 + k; const float s0 = S[kk], s1 = S[2048 + kk], s2 = S[4096 + kk];
                const float w = NT_STREAM ? __builtin_nontemporal_load(&W[(size_t)k * 12288]) : W[(size_t)k * 12288]; a0 += s0 * w; a1 += s1 * w; a2 += s2 * w; }
#endif
            float* o = PART + ((size_t)ks * 4 + L) * 3 * 12288 + n;
            o[0] = a0; o[12288] = a1; o[24576] = a2;
        }
    }
}
__device__ __forceinline__ void mod_reduce(CP P, int gw, int lane, int NGW) {
    const float* PART = (const float*)(P->ws + WS_MODP); float* MOD = (float*)(P->ws + WS_MOD); const float* mb = P->in[5];
    for (int i = gw * 64 + lane; i < 4 * 3 * 12288; i += NGW * 64) {
        const int L = i / (3 * 12288), n = i % 12288;
        float s = mb[(size_t)L * 12288 + n];
#pragma unroll
        for (int ks = 0; ks < 8; ++ks) s += PART[(size_t)ks * 4 * 3 * 12288 + i];
        MOD[i] = s;
    }
}

__device__ __forceinline__ void load_row_f32_l(const LAS float* row, int lane, float (&v)[32]) {
#pragma unroll
    for (int j = 0; j < 4; ++j) { const f32x4 a = ((const LAS f32x4*)row)[128 * j + 2 * lane], b = ((const LAS f32x4*)row)[128 * j + 2 * lane + 1];
        v[8 * j + 0] = a.x; v[8 * j + 1] = a.y; v[8 * j + 2] = a.z; v[8 * j + 3] = a.w; v[8 * j + 4] = b.x; v[8 * j + 5] = b.y; v[8 * j + 6] = b.z; v[8 * j + 7] = b.w; }
}
__device__ __forceinline__ void first_row_pass(CP P, LAS unsigned char* lds, int tid, int lane, int gw, int NGW) {
    const float* MOD = (const float*)(P->ws + WS_MOD); bf16* X = (bf16*)(P->ws + WS_X); bf16* H = (bf16*)(P->ws + WS_H);
    LAS float* V = (LAS float*)lds;
    __syncthreads();
    { f32x4 t_[6];
#pragma unroll
      for (int vec = 0; vec < 6; ++vec) t_[vec] = ((const f32x4*)(MOD + (size_t)(vec >> 1) * 12288 + (size_t)(vec & 1) * 2048))[tid];
#pragma unroll
      for (int vec = 0; vec < 6; ++vec) ((LAS f32x4*)V)[vec * 512 + tid] = t_[vec]; }
    __syncthreads();
    for (int row = gw; row < MT; row += NGW) {
        const float* src = row < ML ? P->in[0] + (size_t)row * DM : P->in[2] + (size_t)(row - ML) * DM;
        float v[32]; if (NT_STREAM > 1) load_row_f32_nt(src, lane, v); else load_row_f32(src, lane, v);
        store_row_bf16(X + (size_t)row * DM, lane, v);
        const LAS float* mod = V + row_slot(row) * 4096;
        float mean, rstd; ln_stats(v, mean, rstd);
        float a[32], s[32]; load_row_f32_l(mod + 2048, lane, a); load_row_f32_l(mod, lane, s);
#pragma unroll
        for (int i = 0; i < 32; ++i) a[i] = (v[i] - mean) * rstd * (1.0f + a[i]) + s[i];
        store_row_bf16(H + (size_t)row * DM, lane, a);
    }
}
#ifndef POSTMIX_LDS
#define POSTMIX_LDS 1
#endif
__device__ __forceinline__ void post_mixer_pass_lds(CP P, int L, int Mrows, LAS unsigned char* lds, int tid, int lane, int gw, int NGW) {
    const float* MOD = (const float*)(P->ws + WS_MOD); bf16* X = (bf16*)(P->ws + WS_X); bf16* H = (bf16*)(P->ws + WS_H); const bf16* Y = (const bf16*)(P->ws + WS_Y);
    const float* lng = P->in[6] + (size_t)(L * 2 + 0) * DM; const float* lnb = P->in[7] + (size_t)(L * 2 + 0) * DM;
    LAS float* V = (LAS float*)lds;
    __syncthreads();
    { f32x4 t_[11];
#pragma unroll
      for (int vec = 0; vec < 11; ++vec) { const float* src = vec == 0 ? lng : (vec == 1 ? lnb : MOD + (size_t)(L * 3 + (vec - 2) / 3) * 12288 + (size_t)(2 + (vec - 2) % 3) * 2048);
          t_[vec] = ((const f32x4*)src)[tid]; }
#pragma unroll
      for (int vec = 0; vec < 11; ++vec) ((LAS f32x4*)V)[vec * 512 + tid] = t_[vec]; }
    __syncthreads();
    for (int row = gw; row < Mrows; row += NGW) {
        const LAS float* mv = V + (2 + 3 * row_slot(row)) * 2048;
        float z[32], y[32]; if (NT_ACT) { load_row_bf16_nt(X + (size_t)row * DM, lane, z); load_row_bf16_nt(Y + (size_t)row * DM, lane, y); } else { load_row_bf16(X + (size_t)row * DM, lane, z); load_row_bf16(Y + (size_t)row * DM, lane, y); }
        { float g[32]; load_row_f32_l(mv, lane, g);
#pragma unroll
          for (int i = 0; i < 32; ++i) z[i] = ALPHA * z[i] + g[i] * y[i]; }
        float mean, rstd; ln_stats(z, mean, rstd);
        { float g[32], b[32]; load_row_f32_l(V, lane, g); load_row_f32_l(V + 2048, lane, b);
#pragma unroll
          for (int i = 0; i < 32; ++i) z[i] = (z[i] - mean) * rstd * g[i] + b[i]; }
        store_row_bf16(X + (size_t)row * DM, lane, z);
        ln_stats(z, mean, rstd);
        { float a[32], s_[32]; load_row_f32_l(mv + 2 * 2048, lane, a); load_row_f32_l(mv + 2048, lane, s_);
#pragma unroll
          for (int i = 0; i < 32; ++i) a[i] = (z[i] - mean) * rstd * (1.0f + a[i]) + s_[i];
          store_row_bf16(H + (size_t)row * DM, lane, a); }
    }
}
__device__ __forceinline__ void post_mixer_pass(CP P, int L, int Mrows, int lane, int gw, int NGW) {
    const float* MOD = (const float*)(P->ws + WS_MOD); bf16* X = (bf16*)(P->ws + WS_X); bf16* H = (bf16*)(P->ws + WS_H); const bf16* Y = (const bf16*)(P->ws + WS_Y);
    const float* lng = P->in[6] + (size_t)(L * 2 + 0) * DM; const float* lnb = P->in[7] + (size_t)(L * 2 + 0) * DM;
    for (int row = gw; row < Mrows; row += NGW) {
        const float* mod = MOD + (size_t)(L * 3 + row_slot(row)) * 12288;
        float z[32], y[32], g[32]; load_row_bf16(X + (size_t)row * DM, lane, z); load_row_bf16(Y + (size_t)row * DM, lane, y); load_row_f32(mod + 2 * 2048, lane, g);
#pragma unroll
        for (int i = 0; i < 32; ++i) z[i] = ALPHA * z[i] + g[i] * y[i];
        finish_row<false>(z, lng, lnb, X + (size_t)row * DM, mod + 3 * 2048, mod + 4 * 2048, H + (size_t)row * DM, nullptr, lane);
    }
}
__device__ __forceinline__ void vstats_pass(CP P, int Mrows, int lane, int gw, int NGW) {
    const bf16* Z = (const bf16*)(P->ws + WS_Z); float* VST = (float*)(P->ws + WS_VST);
    for (int row = gw; row < Mrows; row += NGW) {
        float v[32]; load_row_bf16(Z + (size_t)row * 4096 + 2048, lane, v);
        float mean, rstd; ln_stats(v, mean, rstd);
        if (lane == 0) { VST[2 * row] = mean; VST[2 * row + 1] = rstd; }
    }
}
#define XB_TMO      128
#define XB_XCNT(j)  (256  + 64 * (j))
#define XB_XSUB(j)  (1280 + 64 * (j))
#define XB_XGEN(j)  (2304 + 64 * (j))
#define XB_TOP      3328
#define XB_TOPGEN   3392
#define XCD_BAR_WORDS 3456
#define XB_SPIN_CAP (1u << 18)

__device__ __forceinline__ unsigned xb_ld(unsigned* p)              { return __hip_atomic_load(p, __ATOMIC_RELAXED, __HIP_MEMORY_SCOPE_AGENT); }
__device__ __forceinline__ unsigned xb_add(unsigned* p, unsigned v) { return __hip_atomic_fetch_add(p, v, __ATOMIC_RELAXED, __HIP_MEMORY_SCOPE_AGENT); }
__device__ __forceinline__ unsigned xb_xcc_id() { return (unsigned)__builtin_amdgcn_s_getreg((3 << 11) | 20) & 0xFu; }
#define XB_SPIN(cond, bar) do { unsigned _sp = 0; while (cond) { __builtin_amdgcn_s_sleep(1); \
    if ((++_sp & 255u) == 0u) { if (xb_ld(&(bar)[XB_TMO])) break; if (_sp > XB_SPIN_CAP) { atomicAdd(&(bar)[XB_TMO], 1u); break; } } } } while (0)

struct XcdBarrier {
    unsigned* bar; unsigned x;
    volatile LAS unsigned* st;
};

__device__ __forceinline__ XcdBarrier xcd_barrier_post(unsigned* bar, volatile LAS unsigned* st, const bool t0) {
    XcdBarrier b; b.bar = bar; b.x = xb_xcc_id(); b.st = st;
    if (t0) (void)xb_add(&bar[XB_XCNT(b.x)], 1u);
    return b;
}
__device__ __forceinline__ void xcd_barrier_complete(unsigned* bar, unsigned x, unsigned& nloc, unsigned& nx) {
    const unsigned G = gridDim.x * gridDim.y * gridDim.z;
    unsigned sum, cnt, mine, sp = 0u;
    for (;;) {
        sum = 0u; cnt = 0u; mine = 0u;
#pragma unroll
        for (unsigned j = 0; j < 16; ++j) { const unsigned c = xb_ld(&bar[XB_XCNT(j)]); sum += c; cnt += (c > 0u) ? 1u : 0u; mine = (j == x) ? c : mine; }
        if (sum == G) break;
        __builtin_amdgcn_s_sleep(1);
        if ((++sp & 255u) == 0u) { if (xb_ld(&bar[XB_TMO])) break; if (sp > XB_SPIN_CAP) { atomicAdd(&bar[XB_TMO], 1u); break; } }
    }
    nloc = mine > 0u ? mine : 1u; nx = cnt > 0u ? cnt : 1u;
}

__device__ __attribute__((noinline)) void xcd_barrier(const XcdBarrier b, const bool t0) {
    asm volatile("s_waitcnt vmcnt(0)" ::: "memory");
    __syncthreads();
    if (t0) {
        unsigned* bar = b.bar;
        __builtin_amdgcn_s_waitcnt(0);
        unsigned nloc = b.st[0], nx = b.st[1];
        if (nloc == 0u) { xcd_barrier_complete(bar, b.x, nloc, nx); b.st[0] = nloc; b.st[1] = nx; }
        const unsigned old = xb_add(&bar[XB_XSUB(b.x)], 1u);
        const unsigned gen = old / nloc;
        if (old + 1u == (gen + 1u) * nloc) {
            __builtin_amdgcn_fence(__ATOMIC_RELEASE, "agent");
            asm volatile("s_waitcnt vmcnt(0)" ::: "memory");
            const unsigned og = xb_add(&bar[XB_TOP], 1u);
            const unsigned tg = og / nx;
            if (og + 1u == (tg + 1u) * nx) xb_add(&bar[XB_TOPGEN], 1u);
            else XB_SPIN(xb_ld(&bar[XB_TOPGEN]) == tg, bar);
            __builtin_amdgcn_fence(__ATOMIC_ACQUIRE, "agent");
            xb_add(&bar[XB_XGEN(b.x)], 1u);
            asm volatile("s_waitcnt vmcnt(0)" ::: "memory");
        } else {
            XB_SPIN(xb_ld(&bar[XB_XGEN(b.x)]) == gen, bar);
            __builtin_amdgcn_fence(__ATOMIC_ACQUIRE, "agent");
            asm volatile("s_waitcnt vmcnt(0)" ::: "memory");
        }
    }
    __syncthreads();
}

#ifndef SPATIAL_PIPE
#define SPATIAL_PIPE 1
#endif
#if SPATIAL_PIPE
#ifndef SPATIAL_OTILE
#define SPATIAL_OTILE 0
#endif
struct SpReg { u32x4 w[4]; float mean, rstd; bf16x8 a[4]; bf16 uu[SPATIAL_OTILE ? 1 : 32]; u32x4 uq[4]; float bsv[4]; };
__device__ __forceinline__ void sp_load(SpReg& R, const bf16* Z, const float* VST, const bf16* WS, const float* bs, int u, int tid, int lane, int wid) {
    const int c = u >> 4, g = u & 15, fr = lane & 15, fq = lane >> 4;
    { const int q = tid >> 2, dq = (tid & 3) * 32; const int row = c * 128 + q;
      R.mean = VST[2 * row]; R.rstd = VST[2 * row + 1];
      const bf16* src = Z + (size_t)row * 4096 + 2048 + g * 128 + dq;
#pragma unroll
      for (int t = 0; t < 4; ++t) R.w[t] = *(const u32x4*)(src + 8 * t); }
    const bf16* wrow = WS + (size_t)g * 128 * 128 + (size_t)(16 * wid + fr) * 128 + 8 * fq;
#pragma unroll
    for (int ks = 0; ks < 4; ++ks) R.a[ks] = *(const bf16x8*)(wrow + 32 * ks);
#pragma unroll
    for (int r = 0; r < 4; ++r) R.bsv[r] = bs[g * 128 + 16 * wid + fq * 4 + r];
#if SPATIAL_OTILE
#pragma unroll
    for (int t = 0; t < 4; ++t) { const int ch = tid + 512 * t, p = ch >> 4, d8 = (ch & 15) * 8; R.uq[t] = *(const u32x4*)(Z + (size_t)(c * 128 + p) * 4096 + g * 128 + d8); }
    R.uu[0] = 0;
#else
#pragma unroll
    for (int nb = 0; nb < 8; ++nb)
#pragma unroll
        for (int r = 0; r < 4; ++r) { const int p = 16 * wid + fq * 4 + r, d = 16 * nb + fr; R.uu[nb * 4 + r] = Z[(size_t)(c * 128 + p) * 4096 + g * 128 + d]; }
#endif
}
__device__ __forceinline__ void spatial_phase(CP P, int j, int Mrows, LAS unsigned char* lds_, int tid, int lane, int wid) {
    const bf16* Z = (const bf16*)(P->ws + WS_Z); const float* VST = (const float*)(P->ws + WS_VST); bf16* Gb = (bf16*)(P->ws + WS_G);
    const bf16* WS = (const bf16*)(P->ws + WS_GMWS) + (size_t)j * 16 * 128 * 128;
    const float* lng = P->in[14] + (size_t)j * DM; const float* lnb = P->in[15] + (size_t)j * DM; const float* bs = P->in[17] + (size_t)j * 16 * 128;
    LAS bf16* Vt = (LAS bf16*)(LAS unsigned char*)lds_;
    constexpr int VP = 136;
    const int nunits = (Mrows / 128) * 16;
    LAS float* LNl = (LAS float*)(lds_ + 36864);
    __syncthreads();
    { const f32x4 t0_ = ((const f32x4*)lng)[tid], t1_ = ((const f32x4*)lnb)[tid]; ((LAS f32x4*)LNl)[tid] = t0_; ((LAS f32x4*)LNl)[512 + tid] = t1_; }
    LAS float* Ot = (LAS float*)(lds_ + 53248);
    (void)Ot;
    SpReg nx;
    if ((int)blockIdx.x < nunits) sp_load(nx, Z, VST, WS, bs, blockIdx.x, tid, lane, wid);
    for (int u = blockIdx.x; u < nunits; u += gridDim.x) {
        const int c = u >> 4, g = u & 15;
        const SpReg cur = nx;
        if (u + (int)gridDim.x < nunits) sp_load(nx, Z, VST, WS, bs, u + gridDim.x, tid, lane, wid);
        __syncthreads();
        {
            const int q = tid >> 2, dq = (tid & 3) * 32;
#pragma unroll
            for (int t = 0; t < 4; ++t) { const u32x4 w = cur.w[t];
                float v[8] = {bflo(w.x), bfhi(w.x), bflo(w.y), bfhi(w.y), bflo(w.z), bfhi(w.z), bflo(w.w), bfhi(w.w)};
                const LAS float* gp = LNl + g * 128 + dq + 8 * t; const LAS float* bp = LNl + 2048 + g * 128 + dq + 8 * t;
#pragma unroll
                for (int i = 0; i < 8; ++i) { const float vn = (v[i] - cur.mean) * cur.rstd * gp[i] + bp[i]; Vt[(dq + 8 * t + i) * VP + (q ^ ((tid & 3) << 4))] = tobf1(vn); } }
        }
        __syncthreads();
        const int fr = lane & 15, fq = lane >> 4;
#pragma unroll
        for (int nb = 0; nb < 8; ++nb) {
            f32x4 acc = {0.f, 0.f, 0.f, 0.f};
#pragma unroll
            for (int ks = 0; ks < 4; ++ks) { const bf16x8 b = *(const LAS bf16x8*)(Vt + (16 * nb + fr) * VP + 8 * ((4 * ks + fq) ^ ((nb >> 1) << 1)));
                acc = __builtin_amdgcn_mfma_f32_16x16x32_bf16(cur.a[ks], b, acc, 0, 0, 0); }
#if SPATIAL_OTILE
#pragma unroll
            for (int r = 0; r < 4; ++r) Ot[(16 * wid + fq * 4 + r) * 132 + 16 * nb + fr] = acc[r] + cur.bsv[r];
#else
#pragma unroll
            for (int r = 0; r < 4; ++r) { const int p = 16 * wid + fq * 4 + r, d = 16 * nb + fr; const size_t grow = (size_t)(c * 128 + p);
                const float sv = acc[r] + cur.bsv[r];
                const float uu = bf1(cur.uu[nb * 4 + r]);
                Gb[grow * 2048 + g * 128 + d] = tobf1(uu * sv); }
#endif
        }
#if SPATIAL_OTILE
        __syncthreads();
#pragma unroll
        for (int t = 0; t < 4; ++t) { const int ch = tid + 512 * t, p = ch >> 4, d8 = (ch & 15) * 8;
            const LAS f32x4* op = (const LAS f32x4*)(Ot + p * 132 + d8); const f32x4 s0 = op[0], s1 = op[1]; const u32x4 uw = cur.uq[t];
            u32x4 o; o.x = cvtpk(bflo(uw.x) * s0.x, bfhi(uw.x) * s0.y); o.y = cvtpk(bflo(uw.y) * s0.z, bfhi(uw.y) * s0.w); o.z = cvtpk(bflo(uw.z) * s1.x, bfhi(uw.z) * s1.y); o.w = cvtpk(bflo(uw.w) * s1.z, bfhi(uw.w) * s1.w);
            *(u32x4*)(Gb + (size_t)(c * 128 + p) * 2048 + g * 128 + d8) = o; }
#endif
    }
}
#else
__device__ __forceinline__ void spatial_phase(CP P, int j, int Mrows, LAS unsigned char* lds_, int tid, int lane, int wid) {
    const bf16* Z = (const bf16*)(P->ws + WS_Z); const float* VST = (const float*)(P->ws + WS_VST); bf16* Gb = (bf16*)(P->ws + WS_G);
    const bf16* WS = (const bf16*)(P->ws + WS_GMWS) + (size_t)j * 16 * 128 * 128;
    const float* lng = P->in[14] + (size_t)j * DM; const float* lnb = P->in[15] + (size_t)j * DM; const float* bs = P->in[17] + (size_t)j * 16 * 128;
    LAS bf16* Vt = (LAS bf16*)(LAS unsigned char*)lds_;
    constexpr int VP = 136;
    const int nunits = (Mrows / 128) * 16;
    for (int u = blockIdx.x; u < nunits; u += gridDim.x) {
        const int c = u >> 4, g = u & 15;
        __syncthreads();
        {
            const int q = tid >> 2, dq = (tid & 3) * 32; const int row = c * 128 + q;
            const float mean = VST[2 * row], rstd = VST[2 * row + 1];
            const bf16* src = Z + (size_t)row * 4096 + 2048 + g * 128 + dq;
#pragma unroll
            for (int t = 0; t < 4; ++t) { const u32x4 w = *(const u32x4*)(src + 8 * t);
                float v[8] = {bflo(w.x), bfhi(w.x), bflo(w.y), bfhi(w.y), bflo(w.z), bfhi(w.z), bflo(w.w), bfhi(w.w)};
                const float* gp = lng + g * 128 + dq + 8 * t; const float* bp = lnb + g * 128 + dq + 8 * t;
#pragma unroll
                for (int i = 0; i < 8; ++i) { const float vn = (v[i] - mean) * rstd * gp[i] + bp[i]; Vt[(dq + 8 * t + i) * VP + q] = tobf1(vn); } }
        }
        __syncthreads();
        const int fr = lane & 15, fq = lane >> 4;
        bf16x8 a[4];
        const bf16* wrow = WS + (size_t)g * 128 * 128 + (size_t)(16 * wid + fr) * 128 + 8 * fq;
#pragma unroll
        for (int ks = 0; ks < 4; ++ks) a[ks] = *(const bf16x8*)(wrow + 32 * ks);
#pragma unroll
        for (int nb = 0; nb < 8; ++nb) {
            f32x4 acc = {0.f, 0.f, 0.f, 0.f};
#pragma unroll
            for (int ks = 0; ks < 4; ++ks) { const bf16x8 b = *(const LAS bf16x8*)(Vt + (16 * nb + fr) * VP + 32 * ks + 8 * fq);
                acc = __builtin_amdgcn_mfma_f32_16x16x32_bf16(a[ks], b, acc, 0, 0, 0); }
#pragma unroll
            for (int r = 0; r < 4; ++r) { const int p = 16 * wid + fq * 4 + r, d = 16 * nb + fr; const size_t grow = (size_t)(c * 128 + p);
                const float sv = acc[r] + bs[g * 128 + p];
                const float uu = bf1(Z[grow * 4096 + g * 128 + d]);
                Gb[grow * 2048 + g * 128 + d] = tobf1(uu * sv); }
        }
    }
}
#endif

__device__ __forceinline__ void rope_cs(int row, int l, float& cs, float& sn) {
    const int t = row & (SEQ - 1); const int pos = (l & 32) ? (t & 63) : (t >> 6);
    const float inv = powf(10000.0f, -(float)(l & 15) * (1.0f / 16.0f));
    const float ang = (float)pos * inv; sincosf(ang, &sn, &cs);
}
__device__ __forceinline__ float rope_apply(float x, int l, float cs, float sn) {
    const float p = lane_xor16(x, l);
    return (l & 16) ? (p * sn + x * cs) : (x * cs - p * sn);
}
__device__ __forceinline__ void mla_norm_pass(CP P, int lane, int gw, int NGW) {
    const bf16* C = (const bf16*)(P->ws + WS_C); bf16* CQN = (bf16*)(P->ws + WS_CQN); bf16* CKVN = (bf16*)(P->ws + WS_CKVN); bf16* KR = (bf16*)(P->ws + WS_KR);
    const float* qn = P->in[20]; const float* kvn = P->in[21];
    for (int row = gw; row < MT; row += NGW) {
        const bf16* c = C + (size_t)row * 1280;
#pragma unroll
        for (int part = 0; part < 2; ++part) {
            const u32x4 w = *(const u32x4*)(c + part * 512 + 8 * lane);
            float v[8] = {bflo(w.x), bfhi(w.x), bflo(w.y), bfhi(w.y), bflo(w.z), bfhi(w.z), bflo(w.w), bfhi(w.w)};
            float ss = 0.f;
#pragma unroll
            for (int i = 0; i < 8; ++i) ss += v[i] * v[i];
            const float r = 1.0f / sqrtf(wave_sum(ss) * (1.0f / 512.0f) + LN_EPS);
            const float* nw = (part ? kvn : qn) + 8 * lane;
            u32x4 o; o.x = cvtpk(v[0] * r * nw[0], v[1] * r * nw[1]); o.y = cvtpk(v[2] * r * nw[2], v[3] * r * nw[3]); o.z = cvtpk(v[4] * r * nw[4], v[5] * r * nw[5]); o.w = cvtpk(v[6] * r * nw[6], v[7] * r * nw[7]);
            *(u32x4*)((part ? CKVN : CQN) + (size_t)row * 512 + 8 * lane) = o;
        }
        float x = bf1(c[1024 + lane]);
        if (row < ML) { float cs, sn; rope_cs(row, lane, cs, sn); x = rope_apply(x, lane, cs, sn); }
        KR[(size_t)row * 64 + lane] = tobf1(x);
    }
}
__device__ __forceinline__ void rope_pass(bf16* buf, int ld, int col0, int nchunks, int cstride, int lane, int gw, int NGW) {
    for (int row = gw; row < ML; row += NGW) {
        float cs, sn; rope_cs(row, lane, cs, sn);
        bf16* r = buf + (size_t)row * ld + col0 + lane;
#pragma unroll 4
        for (int k = 0; k < nchunks; ++k) { const float x = bf1(r[k * cstride]); r[k * cstride] = tobf1(rope_apply(x, lane, cs, sn)); }
    }
}

namespace att {
#ifndef ATT_VPRE0
#define ATT_VPRE0 1
#endif
#ifndef ATT_VPRE
#define ATT_VPRE 1
#endif
#ifndef ATT_LSUM
#define ATT_LSUM 1
#endif
#ifndef ATT_VSTCF
#define ATT_VSTCF 1
#endif
#ifndef ATT_DA_NQR
#define ATT_DA_NQR 4
#endif
#ifndef ATT_LEAN0
#define ATT_LEAN0 0
#endif
#ifndef ATT_LEAN
#define ATT_LEAN 1
#endif
#ifndef ATT_3STAGE
#define ATT_3STAGE 0
#endif
#ifndef ATT_QLATE
#define ATT_QLATE 1
#endif
#ifndef ATT_PRIO
#define ATT_PRIO 1
#endif
#ifndef ATT_KMAJOR
#define ATT_KMAJOR 0
#endif
#ifndef ATT_TRB
#define ATT_TRB 1
#endif
#ifndef ATT_STAGGER
#define ATT_STAGGER 0
#endif
#ifndef ATT_SDEPTH
#define ATT_SDEPTH(MODE) ((MODE) == 0 ? 1 : 1)
#endif
#ifndef ATT_PVPIPE
#define ATT_PVPIPE(MODE) ((MODE) == 1)
#endif
#define SBAR() __builtin_amdgcn_sched_barrier(0)
__device__ __forceinline__ int crow(int r, int hi) { return (r & 3) + 8 * (r >> 2) + 4 * hi; }
__device__ __forceinline__ unsigned cvtpkv(float lo, float hi) { unsigned r; asm volatile("v_cvt_pk_bf16_f32 %0, %1, %2" : "=v"(r) : "v"(lo), "v"(hi)); return r; }

__device__ __forceinline__ void partialSM(f32x16& p0, f32x16& p1, float& m_reg, float& mn, float& alpha, const float C, const float THRS) {
  float pmax = p0[0];
#pragma unroll
  for (int r = 1; r < 16; ++r) pmax = fmaxf(pmax, p0[r]);
#pragma unroll
  for (int r = 0; r < 16; ++r) pmax = fmaxf(pmax, p1[r]);
  { auto rr = __builtin_amdgcn_permlane32_swap(__float_as_uint(pmax), __float_as_uint(pmax), false, false);
    pmax = fmaxf(__uint_as_float(rr[0]), __uint_as_float(rr[1])); }
  if (__builtin_expect(__all(pmax - m_reg <= THRS), 1)) { mn = m_reg; alpha = 1.f; }
  else { mn = fmaxf(m_reg, pmax); alpha = __builtin_amdgcn_exp2f((m_reg - mn) * C); m_reg = mn; }
  const float mnC = -mn * C;
#pragma unroll
  for (int r = 0; r < 16; ++r) p0[r] = fmaf(p0[r], C, mnC);
#pragma unroll
  for (int r = 0; r < 16; ++r) p1[r] = fmaf(p1[r], C, mnC);
#pragma unroll
  for (int r = 0; r < 16; ++r) p0[r] = __builtin_amdgcn_exp2f(p0[r]);
}
__device__ __forceinline__ void finishSM(f32x16& p0, f32x16& p1, float alpha, float& l_reg, bf16x8& pa0, bf16x8& pa1, bf16x8& pa2, bf16x8& pa3) {
#pragma unroll
  for (int r = 0; r < 16; ++r) p1[r] = __builtin_amdgcn_exp2f(p1[r]);
  float ps = 0;
#pragma unroll
  for (int r = 0; r < 16; ++r) ps += p0[r];
#pragma unroll
  for (int r = 0; r < 16; ++r) ps += p1[r];
  { auto rr = __builtin_amdgcn_permlane32_swap(__float_as_uint(ps), __float_as_uint(ps), false, false);
    ps = __uint_as_float(rr[0]) + __uint_as_float(rr[1]); }
  l_reg = l_reg * alpha + ps;
#define PK4(P, BASE, OUT) do { unsigned a0 = cvtpkv(P[BASE + 0], P[BASE + 1]), a1 = cvtpkv(P[BASE + 2], P[BASE + 3]);   \
    unsigned b0 = cvtpkv(P[BASE + 4], P[BASE + 5]), b1 = cvtpkv(P[BASE + 6], P[BASE + 7]);                              \
    auto r0 = __builtin_amdgcn_permlane32_swap(a0, b0, false, false); auto r1 = __builtin_amdgcn_permlane32_swap(a1, b1, false, false); \
    u32x4 w = {r0[0], r1[0], r0[1], r1[1]}; OUT = *reinterpret_cast<bf16x8*>(&w); } while (0)
  PK4(p0, 0, pa0); PK4(p0, 8, pa1); PK4(p1, 0, pa2); PK4(p1, 8, pa3);
#undef PK4
}
__device__ __forceinline__ void partialSM_lean(f32x16& p0, f32x16& p1, f32x16& nm, float& alpha, const bool first) {
  constexpr float THR2 = 11.541560327111707f;
  float dmax = p0[0];
#pragma unroll
  for (int r = 1; r < 16; ++r) dmax = fmaxf(dmax, p0[r]);
#pragma unroll
  for (int r = 0; r < 16; ++r) dmax = fmaxf(dmax, p1[r]);
  { auto rr = __builtin_amdgcn_permlane32_swap(__float_as_uint(dmax), __float_as_uint(dmax), false, false);
    dmax = fmaxf(__uint_as_float(rr[0]), __uint_as_float(rr[1])); }
  alpha = 1.f;
  if (first || !__all(dmax <= THR2)) {
    const float delta = first ? dmax : (dmax > THR2 ? dmax : 0.f);
    if (!first) alpha = __builtin_amdgcn_exp2f(-delta);
#pragma unroll
    for (int r = 0; r < 16; ++r) { p0[r] -= delta; p1[r] -= delta; nm[r] -= delta; }
  }
#pragma unroll
  for (int r = 0; r < 16; ++r) p0[r] = __builtin_amdgcn_exp2f(p0[r]);
}
template <bool LS> __device__ __forceinline__ void finishSM_lean(f32x16& p0, f32x16& p1, bf16x8& pa0, bf16x8& pa1, bf16x8& pa2, bf16x8& pa3, float& lrun) {
#pragma unroll
  for (int r = 0; r < 16; ++r) p1[r] = __builtin_amdgcn_exp2f(p1[r]);
  if constexpr (LS) {
    typedef float f32x2_ __attribute__((ext_vector_type(2)));
    f32x2_ s0 = {p0[0], p0[1]}, s1 = {p1[0], p1[1]};
#pragma unroll
    for (int r = 2; r < 16; r += 2) { s0 += (f32x2_){p0[r], p0[r + 1]}; s1 += (f32x2_){p1[r], p1[r + 1]}; }
    s0 += s1; lrun += s0[0] + s0[1];
  }
#define PK4(P, BASE, OUT) do { unsigned a0 = cvtpkv(P[BASE + 0], P[BASE + 1]), a1 = cvtpkv(P[BASE + 2], P[BASE + 3]);   \
    unsigned b0 = cvtpkv(P[BASE + 4], P[BASE + 5]), b1 = cvtpkv(P[BASE + 6], P[BASE + 7]);                              \
    auto r0 = __builtin_amdgcn_permlane32_swap(a0, b0, false, false); auto r1 = __builtin_amdgcn_permlane32_swap(a1, b1, false, false); \
    u32x4 w = {r0[0], r1[0], r0[1], r1[1]}; OUT = *reinterpret_cast<bf16x8*>(&w); } while (0)
  PK4(p0, 0, pa0); PK4(p0, 8, pa1); PK4(p1, 0, pa2); PK4(p1, 8, pa3);
#undef PK4
}
__device__ __forceinline__ bf16x8 scale_bf16x8(bf16x8 v, float c) {
  const u32x4 w = *reinterpret_cast<u32x4*>(&v); u32x4 o;
  o.x = cvtpk(bflo(w.x) * c, bfhi(w.x) * c); o.y = cvtpk(bflo(w.y) * c, bfhi(w.y) * c); o.z = cvtpk(bflo(w.z) * c, bfhi(w.z) * c); o.w = cvtpk(bflo(w.w) * c, bfhi(w.w) * c);
  return *reinterpret_cast<bf16x8*>(&o);
}
template <int PITCH> __device__ __forceinline__ int kswz(int r) { return PITCH == 256 ? (r & 15) : ((r >> 1) & 7); }
template <int NQF, int NQR, int PITCH> __device__ __forceinline__ void qkt(f32x16& p0, f32x16& p1, const LAS char* Ks, int chunk0, const bf16x8* qr, const LAS char* ql, int r32, int hi, const f32x16 init = f32x16{}) {
  p0 = init; p1 = init;
  const int sw = kswz<PITCH>(r32);
#pragma unroll
  for (int d0 = 0; d0 < NQF; ++d0) { const int off = ((chunk0 + d0 * 2 + hi) ^ sw) * 16;
    const bf16x8 b0 = *(const LAS bf16x8*)(Ks + r32 * PITCH + off);
    const bf16x8 b1 = *(const LAS bf16x8*)(Ks + (32 + r32) * PITCH + off);
    const bf16x8 q = d0 < NQR ? qr[d0 < NQR ? d0 : 0] : *(const LAS bf16x8*)(ql + (d0 - NQR < 0 ? 0 : d0 - NQR) * 1024);
    p0 = __builtin_amdgcn_mfma_f32_32x32x16_bf16(b0, q, p0, 0, 0, 0);
    p1 = __builtin_amdgcn_mfma_f32_32x32x16_bf16(b1, q, p1, 0, 0, 0); }
}
__device__ __forceinline__ int v_st(int k, int c) { const int kk = (k & ~0xC) | ((k & 4) << 1) | ((k & 8) >> 1); return ((kk >> 3) * 4 + (c >> 5)) * 512 + ((kk & 7) * 32 + (c & 31)) * 2; }
__device__ __forceinline__ int v_rd_base(int lane) { return ((lane & 3) << 3) | (((lane >> 2) & 3) << 6) | (((lane >> 4) & 1) << 5) | (((lane >> 5) & 1) << 8); }
constexpr int v_rd_off(int d0, int ks, int half) { return d0 * 512 + ks * 4096 + half * 2048; }
template <int OFF> __device__ __forceinline__ s16x4 tr_read(int vb) {
  s16x4 r; asm volatile("ds_read_b64_tr_b16 %0, %1 offset:%2" : "=&v"(r) : "v"(vb), "i"(OFF) : "memory"); return r;
}
template <int D0> __device__ __forceinline__ void pv_one(f32x16& od, int vb, bf16x8 pa0, bf16x8 pa1, bf16x8 pa2, bf16x8 pa3) {
  const s16x4 l0 = tr_read<v_rd_off(D0, 0, 0)>(vb), h0 = tr_read<v_rd_off(D0, 0, 1)>(vb), l1 = tr_read<v_rd_off(D0, 1, 0)>(vb), h1 = tr_read<v_rd_off(D0, 1, 1)>(vb);
  const s16x4 l2 = tr_read<v_rd_off(D0, 2, 0)>(vb), h2 = tr_read<v_rd_off(D0, 2, 1)>(vb), l3 = tr_read<v_rd_off(D0, 3, 0)>(vb), h3 = tr_read<v_rd_off(D0, 3, 1)>(vb);
  asm volatile("s_waitcnt lgkmcnt(0)" ::: "memory"); SBAR();
#define PK(L, H) (bf16x8){L[0], L[1], L[2], L[3], H[0], H[1], H[2], H[3]}
  od = __builtin_amdgcn_mfma_f32_32x32x16_bf16(pa0, PK(l0, h0), od, 0, 0, 0);
  od = __builtin_amdgcn_mfma_f32_32x32x16_bf16(pa1, PK(l1, h1), od, 0, 0, 0);
  od = __builtin_amdgcn_mfma_f32_32x32x16_bf16(pa2, PK(l2, h2), od, 0, 0, 0);
  od = __builtin_amdgcn_mfma_f32_32x32x16_bf16(pa3, PK(l3, h3), od, 0, 0, 0);
#undef PK
}
__device__ __forceinline__ void pv_d0(f32x16* o, int vb, bf16x8 pa0, bf16x8 pa1, bf16x8 pa2, bf16x8 pa3) {
  pv_one<0>(o[0], vb, pa0, pa1, pa2, pa3); pv_one<1>(o[1], vb, pa0, pa1, pa2, pa3); pv_one<2>(o[2], vb, pa0, pa1, pa2, pa3); pv_one<3>(o[3], vb, pa0, pa1, pa2, pa3);
}
struct VHalf { s16x4 l0, h0, l1, h1; };
__device__ __forceinline__ void pv_d0_pre(f32x16* o, int vb, bf16x8 pa0, bf16x8 pa1, bf16x8 pa2, bf16x8 pa3, const VHalf& pre) {
  { const s16x4 l2 = tr_read<v_rd_off(0, 2, 0)>(vb), h2 = tr_read<v_rd_off(0, 2, 1)>(vb), l3 = tr_read<v_rd_off(0, 3, 0)>(vb), h3 = tr_read<v_rd_off(0, 3, 1)>(vb);
#define PK(L, H) (bf16x8){L[0], L[1], L[2], L[3], H[0], H[1], H[2], H[3]}
    o[0] = __builtin_amdgcn_mfma_f32_32x32x16_bf16(pa0, PK(pre.l0, pre.h0), o[0], 0, 0, 0);
    o[0] = __builtin_amdgcn_mfma_f32_32x32x16_bf16(pa1, PK(pre.l1, pre.h1), o[0], 0, 0, 0);
    asm volatile("s_waitcnt lgkmcnt(0)" ::: "memory"); SBAR();
    o[0] = __builtin_amdgcn_mfma_f32_32x32x16_bf16(pa2, PK(l2, h2), o[0], 0, 0, 0);
    o[0] = __builtin_amdgcn_mfma_f32_32x32x16_bf16(pa3, PK(l3, h3), o[0], 0, 0, 0);
#undef PK
  }
  pv_one<1>(o[1], vb, pa0, pa1, pa2, pa3); pv_one<2>(o[2], vb, pa0, pa1, pa2, pa3); pv_one<3>(o[3], vb, pa0, pa1, pa2, pa3);
}
struct VFrag { s16x4 l0, h0, l1, h1, l2, h2, l3, h3; };
typedef short v4i16_t __attribute__((ext_vector_type(4)));
template <int OFF> __device__ __forceinline__ s16x4 tr_read_b(int vb) {
  return __builtin_bit_cast(s16x4, __builtin_amdgcn_ds_read_tr16_b64_v4i16((LAS v4i16_t*)(uintptr_t)(unsigned)(vb + OFF)));
}
template <int D0> __device__ __forceinline__ void tr8b(VFrag& f, int vb) {
  f.l0 = tr_read_b<v_rd_off(D0, 0, 0)>(vb); f.h0 = tr_read_b<v_rd_off(D0, 0, 1)>(vb); f.l1 = tr_read_b<v_rd_off(D0, 1, 0)>(vb); f.h1 = tr_read_b<v_rd_off(D0, 1, 1)>(vb);
  f.l2 = tr_read_b<v_rd_off(D0, 2, 0)>(vb); f.h2 = tr_read_b<v_rd_off(D0, 2, 1)>(vb); f.l3 = tr_read_b<v_rd_off(D0, 3, 0)>(vb); f.h3 = tr_read_b<v_rd_off(D0, 3, 1)>(vb);
}
template <int D0> __device__ __forceinline__ void tr8(VFrag& f, int vb) {
  f.l0 = tr_read<v_rd_off(D0, 0, 0)>(vb); f.h0 = tr_read<v_rd_off(D0, 0, 1)>(vb); f.l1 = tr_read<v_rd_off(D0, 1, 0)>(vb); f.h1 = tr_read<v_rd_off(D0, 1, 1)>(vb);
  f.l2 = tr_read<v_rd_off(D0, 2, 0)>(vb); f.h2 = tr_read<v_rd_off(D0, 2, 1)>(vb); f.l3 = tr_read<v_rd_off(D0, 3, 0)>(vb); f.h3 = tr_read<v_rd_off(D0, 3, 1)>(vb);
}
__device__ __forceinline__ void mfma4(f32x16& od, VFrag& f, bf16x8 pa0, bf16x8 pa1, bf16x8 pa2, bf16x8 pa3) {
#define PK(L, H) (bf16x8){L[0], L[1], L[2], L[3], H[0], H[1], H[2], H[3]}
  od = __builtin_amdgcn_mfma_f32_32x32x16_bf16(pa0, PK(f.l0, f.h0), od, 0, 0, 0);
  od = __builtin_amdgcn_mfma_f32_32x32x16_bf16(pa1, PK(f.l1, f.h1), od, 0, 0, 0);
  od = __builtin_amdgcn_mfma_f32_32x32x16_bf16(pa2, PK(f.l2, f.h2), od, 0, 0, 0);
  od = __builtin_amdgcn_mfma_f32_32x32x16_bf16(pa3, PK(f.l3, f.h3), od, 0, 0, 0);
#undef PK
}
#define VF_TIE(f) "+v"(f.l0), "+v"(f.h0), "+v"(f.l1), "+v"(f.h1), "+v"(f.l2), "+v"(f.h2), "+v"(f.l3), "+v"(f.h3)
__device__ __forceinline__ void pv_pipe(f32x16* o, int vb, bf16x8 pa0, bf16x8 pa1, bf16x8 pa2, bf16x8 pa3) {
  VFrag A, B;
  asm volatile("s_waitcnt lgkmcnt(0)" ::: "memory");
  tr8<0>(A, vb); tr8<1>(B, vb);
  asm volatile("s_waitcnt lgkmcnt(8)" : VF_TIE(A) :: "memory");
  mfma4(o[0], A, pa0, pa1, pa2, pa3);
  tr8<2>(A, vb);
  asm volatile("s_waitcnt lgkmcnt(8)" : VF_TIE(B) :: "memory");
  mfma4(o[1], B, pa0, pa1, pa2, pa3);
  tr8<3>(B, vb);
  asm volatile("s_waitcnt lgkmcnt(8)" : VF_TIE(A) :: "memory");
  mfma4(o[2], A, pa0, pa1, pa2, pa3);
  asm volatile("s_waitcnt lgkmcnt(0)" : VF_TIE(B) :: "memory");
  mfma4(o[3], B, pa0, pa1, pa2, pa3);
}
template <bool ONES = true> __device__ __forceinline__ void pv_psm_lean(f32x16* o, int vb, bf16x8 pa0, bf16x8 pa1, bf16x8 pa2, bf16x8 pa3, f32x16& p0, f32x16& p1, f32x16& nm, float& alpha) {
  constexpr float THR2 = 11.541560327111707f;
  const bf16x8 one8 = {0x3F80, 0x3F80, 0x3F80, 0x3F80, 0x3F80, 0x3F80, 0x3F80, 0x3F80};
  VFrag A, B;
  asm volatile("s_waitcnt lgkmcnt(0)" ::: "memory");
  tr8<0>(A, vb); tr8<1>(B, vb);
  asm volatile("s_waitcnt lgkmcnt(8)" : VF_TIE(A) :: "memory");
  mfma4(o[0], A, pa0, pa1, pa2, pa3);
  float dmax = p0[0];
#pragma unroll
  for (int r = 1; r < 16; ++r) dmax = fmaxf(dmax, p0[r]);
  tr8<2>(A, vb);
  asm volatile("s_waitcnt lgkmcnt(8)" : VF_TIE(B) :: "memory");
  mfma4(o[1], B, pa0, pa1, pa2, pa3);
#pragma unroll
  for (int r = 0; r < 16; ++r) dmax = fmaxf(dmax, p1[r]);
  { auto rr = __builtin_amdgcn_permlane32_swap(__float_as_uint(dmax), __float_as_uint(dmax), false, false);
    dmax = fmaxf(__uint_as_float(rr[0]), __uint_as_float(rr[1])); }
  alpha = 1.f;
  if (!__all(dmax <= THR2)) {
    const float delta = dmax > THR2 ? dmax : 0.f; alpha = __builtin_amdgcn_exp2f(-delta);
#pragma unroll
    for (int r = 0; r < 16; ++r) { p0[r] -= delta; p1[r] -= delta; nm[r] -= delta; }
  }
  tr8<3>(B, vb);
  asm volatile("s_waitcnt lgkmcnt(8)" : VF_TIE(A) :: "memory");
  mfma4(o[2], A, pa0, pa1, pa2, pa3);
#pragma unroll
  for (int r = 0; r < 8; ++r) p0[r] = __builtin_amdgcn_exp2f(p0[r]);
  asm volatile("s_waitcnt lgkmcnt(0)" : VF_TIE(B) :: "memory");
  mfma4(o[3], B, pa0, pa1, pa2, pa3);
#pragma unroll
  for (int r = 8; r < 16; ++r) p0[r] = __builtin_amdgcn_exp2f(p0[r]);
  if constexpr (ONES) { o[4] = __builtin_amdgcn_mfma_f32_32x32x16_bf16(pa0, one8, o[4], 0, 0, 0); o[4] = __builtin_amdgcn_mfma_f32_32x32x16_bf16(pa1, one8, o[4], 0, 0, 0);
  o[4] = __builtin_amdgcn_mfma_f32_32x32x16_bf16(pa2, one8, o[4], 0, 0, 0); o[4] = __builtin_amdgcn_mfma_f32_32x32x16_bf16(pa3, one8, o[4], 0, 0, 0); }
}
template <bool ONES = true, bool PRE = false> __device__ __forceinline__ void pv_psm_lean_b(f32x16* o, int vb, bf16x8 pa0, bf16x8 pa1, bf16x8 pa2, bf16x8 pa3, f32x16& p0, f32x16& p1, f32x16& nm, float& alpha, const VFrag* pre = nullptr) {
  constexpr float THR2 = 11.541560327111707f;
  const bf16x8 one8 = {0x3F80, 0x3F80, 0x3F80, 0x3F80, 0x3F80, 0x3F80, 0x3F80, 0x3F80};
  VFrag A, B;
  if constexpr (PRE) A = *pre; else tr8b<0>(A, vb);
  tr8b<1>(B, vb);
  mfma4(o[0], A, pa0, pa1, pa2, pa3);
  float dmax = p0[0];
#pragma unroll
  for (int r = 1; r < 16; ++r) dmax = fmaxf(dmax, p0[r]);
  tr8b<2>(A, vb);
  mfma4(o[1], B, pa0, pa1, pa2, pa3);
#pragma unroll
  for (int r = 0; r < 16; ++r) dmax = fmaxf(dmax, p1[r]);
  { auto rr = __builtin_amdgcn_permlane32_swap(__float_as_uint(dmax), __float_as_uint(dmax), false, false);
    dmax = fmaxf(__uint_as_float(rr[0]), __uint_as_float(rr[1])); }
  alpha = 1.f;
  if (!__all(dmax <= THR2)) {
    const float delta = dmax > THR2 ? dmax : 0.f; alpha = __builtin_amdgcn_exp2f(-delta);
#pragma unroll
    for (int r = 0; r < 16; ++r) { p0[r] -= delta; p1[r] -= delta; nm[r] -= delta; }
  }
  tr8b<3>(B, vb);
  mfma4(o[2], A, pa0, pa1, pa2, pa3);
#pragma unroll
  for (int r = 0; r < 8; ++r) p0[r] = __builtin_amdgcn_exp2f(p0[r]);
  mfma4(o[3], B, pa0, pa1, pa2, pa3);
#pragma unroll
  for (int r = 8; r < 16; ++r) p0[r] = __builtin_amdgcn_exp2f(p0[r]);
  if constexpr (ONES) { o[4] = __builtin_amdgcn_mfma_f32_32x32x16_bf16(pa0, one8, o[4], 0, 0, 0); o[4] = __builtin_amdgcn_mfma_f32_32x32x16_bf16(pa1, one8, o[4], 0, 0, 0);
  o[4] = __builtin_amdgcn_mfma_f32_32x32x16_bf16(pa2, one8, o[4], 0, 0, 0); o[4] = __builtin_amdgcn_mfma_f32_32x32x16_bf16(pa3, one8, o[4], 0, 0, 0); }
}
struct VStep { s16x4 l0, h0, l1, h1, l2, h2, l3, h3; };
template <int KS> __device__ __forceinline__ void trstep(VStep& f, int vb) {
  f.l0 = tr_read_b<v_rd_off(0, KS, 0)>(vb); f.h0 = tr_read_b<v_rd_off(0, KS, 1)>(vb); f.l1 = tr_read_b<v_rd_off(1, KS, 0)>(vb); f.h1 = tr_read_b<v_rd_off(1, KS, 1)>(vb);
  f.l2 = tr_read_b<v_rd_off(2, KS, 0)>(vb); f.h2 = tr_read_b<v_rd_off(2, KS, 1)>(vb); f.l3 = tr_read_b<v_rd_off(3, KS, 0)>(vb); f.h3 = tr_read_b<v_rd_off(3, KS, 1)>(vb);
}
__device__ __forceinline__ void mfma5(f32x16* o, const VStep& f, bf16x8 pa) {
  const bf16x8 one8 = {0x3F80, 0x3F80, 0x3F80, 0x3F80, 0x3F80, 0x3F80, 0x3F80, 0x3F80};
#define PK(L, H) (bf16x8){L[0], L[1], L[2], L[3], H[0], H[1], H[2], H[3]}
  o[0] = __builtin_amdgcn_mfma_f32_32x32x16_bf16(pa, PK(f.l0, f.h0), o[0], 0, 0, 0);
  o[1] = __builtin_amdgcn_mfma_f32_32x32x16_bf16(pa, PK(f.l1, f.h1), o[1], 0, 0, 0);
  o[2] = __builtin_amdgcn_mfma_f32_32x32x16_bf16(pa, PK(f.l2, f.h2), o[2], 0, 0, 0);
  o[3] = __builtin_amdgcn_mfma_f32_32x32x16_bf16(pa, PK(f.l3, f.h3), o[3], 0, 0, 0);
  o[4] = __builtin_amdgcn_mfma_f32_32x32x16_bf16(pa, one8, o[4], 0, 0, 0);
#undef PK
}
template <int BASE> __device__ __forceinline__ bf16x8 pk4e(const f32x16& P) {
  const float e0 = __builtin_amdgcn_exp2f(P[BASE + 0]), e1 = __builtin_amdgcn_exp2f(P[BASE + 1]), e2 = __builtin_amdgcn_exp2f(P[BASE + 2]), e3 = __builtin_amdgcn_exp2f(P[BASE + 3]);
  const float e4 = __builtin_amdgcn_exp2f(P[BASE + 4]), e5 = __builtin_amdgcn_exp2f(P[BASE + 5]), e6 = __builtin_amdgcn_exp2f(P[BASE + 6]), e7 = __builtin_amdgcn_exp2f(P[BASE + 7]);
  const unsigned a0 = cvtpk(e0, e1), a1 = cvtpk(e2, e3), b0 = cvtpk(e4, e5), b1 = cvtpk(e6, e7);
  const auto r0 = __builtin_amdgcn_permlane32_swap(a0, b0, false, false); const auto r1 = __builtin_amdgcn_permlane32_swap(a1, b1, false, false);
  u32x4 w = {r0[0], r1[0], r0[1], r1[1]}; return *reinterpret_cast<bf16x8*>(&w);
}
__device__ __forceinline__ float rowmax_lean(const f32x16& p0, const f32x16& p1) {
  float d = p0[0];
#pragma unroll
  for (int r = 1; r < 16; ++r) d = fmaxf(d, p0[r]);
#pragma unroll
  for (int r = 0; r < 16; ++r) d = fmaxf(d, p1[r]);
  const auto rr = __builtin_amdgcn_permlane32_swap(__float_as_uint(d), __float_as_uint(d), false, false);
  return fmaxf(__uint_as_float(rr[0]), __uint_as_float(rr[1]));
}
__device__ __forceinline__ void shift_lean(float dmax, f32x16& p0, f32x16& p1, f32x16& nm, float& alpha, const bool first) {
  constexpr float THR2 = 11.541560327111707f;
  alpha = 1.f;
  if (first || !__all(dmax <= THR2)) {
    const float delta = first ? dmax : (dmax > THR2 ? dmax : 0.f);
    if (!first) alpha = __builtin_amdgcn_exp2f(-delta);
#pragma unroll
    for (int r = 0; r < 16; ++r) { p0[r] -= delta; p1[r] -= delta; nm[r] -= delta; }
  }
}
#define SGB(mask, n) __builtin_amdgcn_sched_group_barrier((mask), (n), 0)
__device__ __forceinline__ bf16x8 ld8(const bf16* p) { return *reinterpret_cast<const bf16x8*>(p); }

template <int MODE, int ATTV = 0>
__device__ __forceinline__ void attn_unit(const bf16* __restrict__ Qrow0, int ldq, const bf16* __restrict__ Kb, const bf16* __restrict__ Vb, int ldk, const bf16* __restrict__ KRb,
                                          int b, int nct, int NT, bf16* __restrict__ Ob, float lam, const float* __restrict__ subln, float oscale, LAS unsigned char* lds_, const int tid_in) {
  constexpr bool LEAN = ((MODE == 1) && ATT_LEAN) || ((MODE == 0) && ATT_LEAN0); constexpr bool LSUM = LEAN && ATT_LSUM && (MODE == 1); constexpr int NQF = MODE == 0 ? 12 : 4, NQR = MODE == 0 ? 4 : ATT_DA_NQR, NOB = (LEAN && !(ATT_LSUM && MODE == 1)) ? 5 : 4, PITCH = MODE == 0 ? 384 : 256, SHM_V = 16384, SHM_K = 64 * PITCH, SDEPTH = ATT_SDEPTH(MODE); constexpr bool PVPIPE = ATT_PVPIPE(MODE);
  const float SCALE = MODE == 0 ? 0.07216878364870323f : 0.125f;
  const float C = SCALE * 1.4426950408889634f, THRS = 8.f / SCALE;
  if (ATT_PRIO) { if (__builtin_amdgcn_readfirstlane(tid_in >> 8) != 0) __builtin_amdgcn_s_setprio(1); }
  const int tid = launder_v(tid_in) & 511, wid = tid >> 6, lane = tid & 63, r32 = lane & 31, hi = lane >> 5;
  LAS char* lds = (LAS char*)(LAS unsigned char*)lds_;
  constexpr bool THREE = (MODE == 1) && ATT_3STAGE; constexpr int NSTG = THREE ? 3 : 2, STG = SHM_V + SHM_K, SCR0 = NSTG * STG;
#define VOFF(s) (!THREE ? (s) * SHM_V : (s) * STG)
#define KOFF(s) (!THREE ? 2 * SHM_V + (s) * SHM_K : (s) * STG + SHM_V)
  LAS char* V_lds = lds; LAS char* K_lds = lds;
  LAS float* wsf = (LAS float*)(lds + NSTG * (SHM_V + SHM_K)) + wid * 64; LAS float* li_l = wsf; LAS float* al_l = wsf + 32;
  const int wq = MODE == 0 ? wid : (wid & 3), sgrp = MODE == 0 ? 0 : (wid >> 2);
  float m_reg = -1e30f, l_reg = 0; f32x16 o[NOB] = {}; bf16x8 qr[NQR > 0 ? NQR : 1]; f32x16 nm = {};
  LAS char* ql = lds + SCR0 + 2048 + wid * (MODE == 0 ? 8192 : 4096) + lane * 16;
  const bf16* Qw = Qrow0 + (size_t)(wq * 32 + r32) * ldq + sgrp * 64 + hi * 8;
#define QLOADS() do { _Pragma("unroll") for (int d0 = 0; d0 < NQR; ++d0) { qr[d0] = ld8(Qw + d0 * 16); if (LEAN) qr[d0] = scale_bf16x8(qr[d0], C); } \
    _Pragma("unroll") for (int d0 = NQR; d0 < NQF; ++d0) { bf16x8 qv = ld8(Qw + d0 * 16); if (LEAN) qv = scale_bf16x8(qv, C); *(LAS bf16x8*)(ql + (d0 - NQR) * 1024) = qv; } } while (0)
  constexpr bool QLATE = ATT_QLATE && !((MODE == 1) && ATT_3STAGE) && !((MODE == 1) && ATT_LEAN && ATT_KMAJOR && (ATTV == 0));
  if (!QLATE) QLOADS();
  const int sr = tid >> 4, sc = (tid & 15) * 8;
  const int srv = ATT_VSTCF ? (tid >> 6) * 4 + ((tid >> 2) & 3) : sr, scv = ATT_VSTCF ? ((tid >> 4) & 3) * 32 + (tid & 3) * 8 : sc;
  const int vst0 = v_st(srv, scv), vst1 = v_st(32 + srv, scv);
  const int kst0 = sr * PITCH + (((tid & 15) ^ kswz<PITCH>(sr)) * 16), kst1 = kst0 + 32 * PITCH;
  const int rrow = tid >> 3, krs = rrow * PITCH + (((16 + (tid & 7)) ^ kswz<PITCH>(rrow)) * 16);
  const int chunk0 = sgrp * 8;
  const int vb0 = (int)(uintptr_t)V_lds + v_rd_base(lane);
  struct Slot { bf16x8 vs0, vs1, ks0, ks1, kr; } sr_[SDEPTH];
#define KROW(jt) ((jt) < nct ? (ML + b * CTXL + (jt) * 64) : (b * SEQ + ((jt) - nct) * 64))
#define SLOAD(i, jt) do { const int k0_ = KROW(jt); sr_[i].vs0 = ld8(Vb + (size_t)(k0_ + srv) * ldk + scv); sr_[i].vs1 = ld8(Vb + (size_t)(k0_ + 32 + srv) * ldk + scv); \
    sr_[i].ks0 = ld8(Kb + (size_t)(k0_ + sr) * ldk + sc); sr_[i].ks1 = ld8(Kb + (size_t)(k0_ + 32 + sr) * ldk + sc); \
    if (MODE == 0) sr_[i].kr = ld8(KRb + (size_t)(k0_ + rrow) * 64 + (tid & 7) * 8); } while (0)
#define SWRITE(bf, i) do { *(LAS bf16x8*)(V_lds + VOFF(bf) + vst0) = sr_[i].vs0; *(LAS bf16x8*)(V_lds + VOFF(bf) + vst1) = sr_[i].vs1; \
    *(LAS bf16x8*)(K_lds + KOFF(bf) + kst0) = sr_[i].ks0; *(LAS bf16x8*)(K_lds + KOFF(bf) + kst1) = sr_[i].ks1; \
    if (MODE == 0) *(LAS bf16x8*)(K_lds + KOFF(bf) + krs) = sr_[i].kr; } while (0)
#define SWAIT() do { if constexpr (SDEPTH == 2) asm volatile("s_waitcnt vmcnt(4)" ::: "memory"); else asm volatile("s_waitcnt vmcnt(0)" ::: "memory"); } while (0)
#define RESC(a) do { if (__any((a) < 1.f)) { if constexpr (LSUM) l_reg *= (a); if (hi == 0) al_l[r32] = (a); asm volatile("s_waitcnt lgkmcnt(0)" ::: "memory"); \
    _Pragma("unroll") for (int d = 0; d < NOB; ++d) _Pragma("unroll") for (int r = 0; r < 16; ++r) o[d][r] *= al_l[crow(r, hi)]; } } while (0)
#define PV(vb_) do { if constexpr (ATTV == 2) { o[0][0] += __uint_as_float((unsigned)pa0[0] + (unsigned)pa3[1]); } else if constexpr (PVPIPE) pv_pipe(o, (vb_), pa0, pa1, pa2, pa3); else pv_d0(o, (vb_), pa0, pa1, pa2, pa3); \
    if constexpr (LEAN && !LSUM) { const bf16x8 one8 = {0x3F80, 0x3F80, 0x3F80, 0x3F80, 0x3F80, 0x3F80, 0x3F80, 0x3F80};     \
        o[NOB - 1] = __builtin_amdgcn_mfma_f32_32x32x16_bf16(pa0, one8, o[NOB - 1], 0, 0, 0); o[NOB - 1] = __builtin_amdgcn_mfma_f32_32x32x16_bf16(pa1, one8, o[NOB - 1], 0, 0, 0); \
        o[NOB - 1] = __builtin_amdgcn_mfma_f32_32x32x16_bf16(pa2, one8, o[NOB - 1], 0, 0, 0); o[NOB - 1] = __builtin_amdgcn_mfma_f32_32x32x16_bf16(pa3, one8, o[NOB - 1], 0, 0, 0); } } while (0)
#define PSM(p0_, p1_, mn_, al_, first_) do { if constexpr (ATTV == 1) { al_ = 1.f; } else if constexpr (LEAN) partialSM_lean(p0_, p1_, nm, al_, first_); else partialSM(p0_, p1_, m_reg, mn_, al_, C, THRS); } while (0)
#define FSM(p0_, p1_, al_) do { if constexpr (ATTV == 1) { u32x4 w0_ = {__float_as_uint(p0_[0]), __float_as_uint(p0_[1]), __float_as_uint(p1_[0]), __float_as_uint(p1_[1])}; pa0 = pa1 = pa2 = pa3 = *reinterpret_cast<bf16x8*>(&w0_); } else if constexpr (LEAN) finishSM_lean<LSUM>(p0_, p1_, pa0, pa1, pa2, pa3, l_reg); else finishSM(p0_, p1_, al_, l_reg, pa0, pa1, pa2, pa3); } while (0)
#define QKT(p0_, p1_, Kp_) do { if constexpr (ATTV == 5) { p0_ = nm; p1_ = nm; p0_[0] += (float)r32; } else if constexpr (LEAN) qkt<NQF, NQR, PITCH>(p0_, p1_, Kp_, chunk0, qr, ql, r32, hi, nm); else qkt<NQF, NQR, PITCH>(p0_, p1_, Kp_, chunk0, qr, ql, r32, hi); } while (0)
  f32x16 pA0, pA1, pB0, pB1; float mnA, mnB, alA, alB; bf16x8 pa0, pa1, pa2, pa3;
  constexpr bool KMAJ = (MODE == 1) && LEAN && ATT_KMAJOR && (ATTV == 0) && !THREE;
  if constexpr (KMAJ) {
    VStep VA, VB;
#define KSTEPS(PC0, PC1, ALC, PP0, PP1, KC, VP, LD, DOQK) do { const int vb_ = vb0 + VOFF(VP); float dmx_ = 0.f; \
      SBAR(); \
      if (DOQK) QKT(PC0, PC1, K_lds + KOFF(KC)); \
      pa0 = pk4e<0>(PP0); trstep<0>(VA, vb_); \
      _Pragma("unroll") for (int i_ = 0; i_ < 8; ++i_) { SGB(0x008, 1); SGB(0x100, 3); SGB(0x002, 2); } \
      SBAR(); LD; SBAR(); \
      mfma5(o, VA, pa0); pa1 = pk4e<8>(PP0); trstep<1>(VB, vb_); \
      _Pragma("unroll") for (int i_ = 0; i_ < 5; ++i_) { SGB(0x008, 1); SGB(0x100, 2); SGB(0x002, 3); } \
      SBAR(); \
      mfma5(o, VB, pa1); pa2 = pk4e<0>(PP1); trstep<2>(VA, vb_); \
      _Pragma("unroll") for (int i_ = 0; i_ < 5; ++i_) { SGB(0x008, 1); SGB(0x100, 2); SGB(0x002, 3); } \
      SBAR(); \
      mfma5(o, VA, pa2); pa3 = pk4e<8>(PP1); trstep<3>(VB, vb_); \
      _Pragma("unroll") for (int i_ = 0; i_ < 5; ++i_) { SGB(0x008, 1); SGB(0x100, 2); SGB(0x002, 3); } \
      SBAR(); \
      mfma5(o, VB, pa3); if (DOQK) dmx_ = rowmax_lean(PC0, PC1); \
      _Pragma("unroll") for (int i_ = 0; i_ < 5; ++i_) { SGB(0x008, 1); SGB(0x002, 7); } \
      SBAR(); \
      if (DOQK) shift_lean(dmx_, PC0, PC1, nm, ALC, false); } while (0)
    SLOAD(0, 0); asm volatile("s_waitcnt vmcnt(0)" ::: "memory"); SWRITE(0, 0); __syncthreads();
    QKT(pA0, pA1, K_lds + KOFF(0)); shift_lean(rowmax_lean(pA0, pA1), pA0, pA1, nm, alA, true);
    SLOAD(0, 1); asm volatile("s_waitcnt vmcnt(0)" ::: "memory"); SWRITE(1, 0); __syncthreads();
    for (int j = 1; j + 1 < NT; j += 2) {
      KSTEPS(pB0, pB1, alB, pA0, pA1, 1, 0, SLOAD(0, j + 1), true);
      __syncthreads(); asm volatile("s_waitcnt vmcnt(0)" ::: "memory"); SWRITE(0, 0);
      RESC(alB); __syncthreads();
      KSTEPS(pA0, pA1, alA, pB0, pB1, 0, 1, SLOAD(0, j + 2), true);
      __syncthreads(); asm volatile("s_waitcnt vmcnt(0)" ::: "memory"); SWRITE(1, 0);
      RESC(alA); __syncthreads();
    }
    KSTEPS(pB0, pB1, alB, pA0, pA1, 1, 0, (void)0, true);
    __syncthreads(); RESC(alB);
    KSTEPS(pA0, pA1, alA, pB0, pB1, 0, 1, (void)0, false);
#undef KSTEPS
  } else if constexpr (!THREE) {
  constexpr int SE = 0, SO = SDEPTH - 1;
  SLOAD(SE, 0); if (QLATE) QLOADS(); asm volatile("s_waitcnt vmcnt(0)" ::: "memory"); SWRITE(0, SE);
  if constexpr (QLATE && SDEPTH == 1) SLOAD(SO, 1);
  __syncthreads();
  QKT(pA0, pA1, K_lds + KOFF(0)); PSM(pA0, pA1, mnA, alA, true);
  if constexpr (!(QLATE && SDEPTH == 1)) SLOAD(SO, 1);
  if constexpr (SDEPTH == 2) { if (2 < NT) SLOAD(SE, 2); }
  SWAIT(); SWRITE(1, SO); __syncthreads();
#define ILV() do { if constexpr (PVPIPE) { _Pragma("unroll") for (int i_ = 0; i_ < 20; ++i_) { __builtin_amdgcn_sched_group_barrier(0x008, 1, 0); __builtin_amdgcn_sched_group_barrier(0x002, 5, 0); } } } while (0)
#define LSLOAD(i, jt) do { if constexpr (ATTV != 3) SLOAD(i, jt); } while (0)
#define LSWRITE(bf, i) do { if constexpr (ATTV != 3) SWRITE(bf, i); } while (0)
#define LSWAIT() do { if constexpr (ATTV != 3) SWAIT(); } while (0)
#define LSYNC() do { if constexpr (ATTV != 4) __syncthreads(); } while (0)
#define HALFSTEP(PC0, PC1, MNC, ALC, PP0, PP1, ALP, KC, VP, LD) do { \
    if (!STAG || wid < 4) { \
      VFrag vpre_; VHalf vh_; SBAR(); if constexpr (VPRE) tr8b<0>(vpre_, vb0 + VOFF(VP)); \
      if constexpr (VPRE0) { vh_.l0 = tr_read_b<v_rd_off(0, 0, 0)>(vb0 + VOFF(VP)); vh_.h0 = tr_read_b<v_rd_off(0, 0, 1)>(vb0 + VOFF(VP)); vh_.l1 = tr_read_b<v_rd_off(0, 1, 0)>(vb0 + VOFF(VP)); vh_.h1 = tr_read_b<v_rd_off(0, 1, 1)>(vb0 + VOFF(VP)); } \
      QKT(PC0, PC1, K_lds + KOFF(KC)); FSM(PP0, PP1, ALP); SBAR(); \
      LD; SBAR(); \
      if constexpr (PVPIPE && LEAN && ATTV == 0) { if constexpr (VPRE) pv_psm_lean_b<!LSUM, true>(o, vb0 + VOFF(VP), pa0, pa1, pa2, pa3, PC0, PC1, nm, ALC, &vpre_); else if constexpr (ATT_TRB) pv_psm_lean_b<!LSUM>(o, vb0 + VOFF(VP), pa0, pa1, pa2, pa3, PC0, PC1, nm, ALC); else pv_psm_lean<!LSUM>(o, vb0 + VOFF(VP), pa0, pa1, pa2, pa3, PC0, PC1, nm, ALC); } else { if constexpr (VPRE0) pv_d0_pre(o, vb0 + VOFF(VP), pa0, pa1, pa2, pa3, vh_); else PV(vb0 + VOFF(VP)); PSM(PC0, PC1, MNC, ALC, false); } \
    } else { \
      SBAR(); FSM(PP0, PP1, ALP); SBAR(); \
      LD; SBAR(); \
      PV(vb0 + VOFF(VP)); SBAR(); \
      QKT(PC0, PC1, K_lds + KOFF(KC)); SBAR(); \
      PSM(PC0, PC1, MNC, ALC, false); \
    } } while (0)
  constexpr bool STAG = (MODE == 1) && ATT_STAGGER && ATTV == 0;
  constexpr bool VPRE = ATT_VPRE && PVPIPE && LEAN && LSUM && ATT_TRB && (ATTV == 0);
  constexpr bool VPRE0 = ATT_VPRE0 && (MODE == 0) && !PVPIPE && !LEAN && (ATTV == 0);
  for (int j = 1; j + 1 < NT; j += 2) {
    HALFSTEP(pB0, pB1, mnB, alB, pA0, pA1, alA, 1, 0, LSLOAD(SO, j + SDEPTH));
    LSYNC(); LSWAIT(); LSWRITE(0, SE);
    RESC(alB); LSYNC();
    HALFSTEP(pA0, pA1, mnA, alA, pB0, pB1, alB, 0, 1, if (SDEPTH == 1 || j + 3 < NT) LSLOAD(SE, j + 1 + SDEPTH));
    LSYNC(); LSWAIT(); LSWRITE(1, SO);
    RESC(alA); LSYNC();
  }
#undef HALFSTEP
#undef ILV
#undef LSLOAD
#undef LSWRITE
#undef LSWAIT
#undef LSYNC
  SBAR(); QKT(pB0, pB1, K_lds + KOFF(1));
  FSM(pA0, pA1, alA); SBAR();
  PV(vb0); PSM(pB0, pB1, mnB, alB, false);
  __syncthreads(); RESC(alB);
  FSM(pB0, pB1, alB); SBAR();
  PV(vb0 + VOFF(1));
  } else {
#define STEP(PC0, PC1, ALC, PP0, PP1, ALP, jj, SP, SC, SN) do { const int j_ = (jj); \
      if (j_ + 1 < NT) { asm volatile("s_waitcnt vmcnt(0)" ::: "memory"); SWRITE(SN, 0); if (j_ + 2 < NT) SLOAD(0, j_ + 2); } \
      SBAR(); QKT(PC0, PC1, K_lds + KOFF(SC)); FSM(PP0, PP1, ALP); SBAR(); \
      PV(vb0 + VOFF(SP)); PSM(PC0, PC1, mnA, ALC, false); \
      RESC(ALC); __syncthreads(); } while (0)
    SLOAD(0, 0); asm volatile("s_waitcnt vmcnt(0)" ::: "memory"); SWRITE(0, 0);
    SLOAD(0, 1); asm volatile("s_waitcnt vmcnt(0)" ::: "memory"); SWRITE(1, 0);
    SLOAD(0, 2); __syncthreads();
    QKT(pA0, pA1, K_lds + KOFF(0)); PSM(pA0, pA1, mnA, alA, true);
    STEP(pB0, pB1, alB, pA0, pA1, alA, 1, 0, 1, 2);
    int j = 2;
    for (; j + 5 < NT; j += 6) {
      STEP(pA0, pA1, alA, pB0, pB1, alB, j, 1, 2, 0);
      STEP(pB0, pB1, alB, pA0, pA1, alA, j + 1, 2, 0, 1);
      STEP(pA0, pA1, alA, pB0, pB1, alB, j + 2, 0, 1, 2);
      STEP(pB0, pB1, alB, pA0, pA1, alA, j + 3, 1, 2, 0);
      STEP(pA0, pA1, alA, pB0, pB1, alB, j + 4, 2, 0, 1);
      STEP(pB0, pB1, alB, pA0, pA1, alA, j + 5, 0, 1, 2);
    }
    if (j < NT) { STEP(pA0, pA1, alA, pB0, pB1, alB, j, 1, 2, 0); STEP(pB0, pB1, alB, pA0, pA1, alA, j + 1, 2, 0, 1); j += 2; }
    if (j < NT) { STEP(pA0, pA1, alA, pB0, pB1, alB, j, 0, 1, 2); STEP(pB0, pB1, alB, pA0, pA1, alA, j + 1, 1, 2, 0); j += 2; }
    FSM(pB0, pB1, alB); SBAR();
    { const int sl = (NT - 1) % 3; PV(vb0 + VOFF(sl)); }
#undef STEP
  }
  float rli[16];
  if constexpr (LEAN && !LSUM) {
#pragma unroll
    for (int r = 0; r < 16; ++r) rli[r] = __builtin_amdgcn_rcpf(o[NOB - 1][r]);
  } else {
    if constexpr (LSUM) l_reg += __uint_as_float(lane_xor32(__float_as_uint(l_reg), lane));
    if (hi == 0) li_l[r32] = l_reg; asm volatile("s_waitcnt lgkmcnt(0)" ::: "memory");
#pragma unroll
    for (int r = 0; r < 16; ++r) rli[r] = __builtin_amdgcn_rcpf(li_l[crow(r, hi)]);
  }
  bf16* Ow = Ob + (size_t)(wq * 32) * DM;
  if constexpr (MODE == 0) {
#pragma unroll
    for (int r = 0; r < 16; ++r) { const int orow = crow(r, hi);
#pragma unroll
      for (int d0 = 0; d0 < 4; ++d0) Ow[(size_t)orow * DM + d0 * 32 + r32] = tobf1(o[d0][r] * rli[r]); }
    __syncthreads();
  } else {
    LAS float* ex = (LAS float*)lds;
    __syncthreads();
    if (sgrp == 1) {
#pragma unroll
      for (int r = 0; r < 16; ++r)
#pragma unroll
        for (int d0 = 0; d0 < 4; ++d0) ex[(wq * 32 + crow(r, hi)) * 128 + d0 * 32 + r32] = o[d0][r] * rli[r];
    }
    __syncthreads();
    if (sgrp == 0) {
#pragma unroll
      for (int r = 0; r < 16; ++r) { const int orow = crow(r, hi); float dd[4]; float ss = 0.f;
#pragma unroll
        for (int d0 = 0; d0 < 4; ++d0) { dd[d0] = o[d0][r] * rli[r] - lam * ex[(wq * 32 + orow) * 128 + d0 * 32 + r32]; ss += dd[d0] * dd[d0]; }
        ss = half_sum32(ss);
        const float rs = oscale / sqrtf(ss * (1.0f / 128.0f) + LN_EPS);
#pragma unroll
        for (int d0 = 0; d0 < 4; ++d0) Ow[(size_t)orow * DM + d0 * 32 + r32] = tobf1(dd[d0] * rs * subln[d0 * 32 + r32]); }
    }
    __syncthreads();
  }
  if (ATT_PRIO) __builtin_amdgcn_s_setprio(0);
#undef VOFF
#undef KOFF
#undef PV
#undef PSM
#undef FSM
#undef QKT
#undef KROW
#undef SLOAD
#undef SWRITE
#undef SWAIT
#undef RESC
}
}

__device__ __forceinline__ void mla_attn_phase(CP P, LAS unsigned char* lds, const int tid) {
    const bf16* QM = (const bf16*)(P->ws + WS_QM); const bf16* KV = (const bf16*)(P->ws + WS_KV); const bf16* KR = (const bf16*)(P->ws + WS_KR); bf16* Gb = (bf16*)(P->ws + WS_G);
    const int c = blockIdx.x, G = gridDim.x;
    for (int u = c; u < 1024 + 32; u += G) {
        int b, h, qrow0, NT;
        if (u < 1024) { const int i = u >> 8, cc = u & 255; const int bh = (cc & 7) + 8 * i, qb = cc >> 3; b = bh >> 4; h = bh & 15; qrow0 = b * SEQ + qb * 256; NT = 4 + 128; }
        else { const int bh = u - 1024; b = bh >> 4; h = bh & 15; qrow0 = ML + b * CTXL; NT = 4; }
        att::attn_unit<0>(QM + (size_t)qrow0 * 3072 + h * 192, 3072, KV + h * 256, KV + h * 256 + 128, 4096, KR, b, 4, NT, Gb + (size_t)qrow0 * DM + h * 128, 0.f, nullptr, 1.f, lds, tid);
    }
}
template <int ATTV = 0>
__device__ __forceinline__ void da_attn_phase(CP P, float lam, float oscale, LAS unsigned char* lds, const int tid, const bool ctx_q, const int nt_cap = 0) {
    const bf16* Z = (const bf16*)(P->ws + WS_Z); bf16* Gb = (bf16*)(P->ws + WS_G); const float* subln = P->in[27];
    const int c = blockIdx.x, G = gridDim.x;
    for (int u = c; u < 2048 + (ctx_q ? 64 : 0); u += G) {
        int b, h, qrow0, NT;
        if (u < 2048) { const int i = u >> 8, cc = u & 255; const int bh = (cc & 7) + 8 * (i >> 1), qb = (cc >> 3) + 32 * (i & 1); b = bh >> 4; h = bh & 15; qrow0 = b * SEQ + qb * 128; NT = 4 + 128; }
        else { const int v = u - 2048; const int bh = v >> 1; b = bh >> 4; h = bh & 15; qrow0 = ML + b * CTXL + (v & 1) * 128; NT = 4; }
        if (nt_cap) NT = nt_cap;
        att::attn_unit<1, ATTV>(Z + (size_t)qrow0 * 6144 + h * 128, 6144, Z + 2048 + h * 128, Z + 4096 + h * 128, 6144, nullptr, b, 4, NT, Gb + (size_t)qrow0 * DM + h * 128, lam, subln, oscale, lds, tid);
    }
}

__device__ __forceinline__ unsigned f2ord(float f) { const unsigned u = __float_as_uint(f); return u ^ ((unsigned)((int)u >> 31) | 0x80000000u); }
__device__ __forceinline__ float ord2f(unsigned k) { return __uint_as_float((k & 0x80000000u) ? (k ^ 0x80000000u) : ~k); }
__device__ __forceinline__ void ce_desc(unsigned& a, unsigned& b) { const unsigned mx = a > b ? a : b, mn = a > b ? b : a; a = mx; b = mn; }
template <int N, bool DESC> __device__ __forceinline__ void bitonic_merge(unsigned* a) {
#pragma unroll
    for (int j = N / 2; j > 0; j >>= 1)
#pragma unroll
        for (int i = 0; i < N; ++i) { const int l = i ^ j; if (l > i) { if (DESC) ce_desc(a[i], a[l]); else ce_desc(a[l], a[i]); } }
}
template <int N, bool DESC> __device__ __forceinline__ void bitonic_sort(unsigned* a) {
#pragma unroll
    for (int k = 2; k <= N; k <<= 1)
#pragma unroll
        for (int j = k >> 1; j > 0; j >>= 1)
#pragma unroll
            for (int i = 0; i < N; ++i) { const int l = i ^ j; if (l > i) { const bool up = ((i & k) == 0); if (up == DESC) ce_desc(a[i], a[l]); else ce_desc(a[l], a[i]); } }
}
__device__ __forceinline__ void top16_of_64(unsigned (&a)[64]) {
    bitonic_sort<16, true>(a); bitonic_sort<16, false>(a + 16); bitonic_sort<16, true>(a + 32); bitonic_sort<16, false>(a + 48);
#pragma unroll
    for (int i = 0; i < 16; ++i) a[i] = a[i] > a[16 + i] ? a[i] : a[16 + i];
    bitonic_merge<16, true>(a);
#pragma unroll
    for (int i = 0; i < 16; ++i) a[32 + i] = a[32 + i] > a[48 + i] ? a[32 + i] : a[48 + i];
    bitonic_merge<16, false>(a + 32);
#pragma unroll
    for (int i = 0; i < 16; ++i) a[i] = a[i] > a[32 + i] ? a[i] : a[32 + i];
    bitonic_merge<16, true>(a);
}
template <int PASS> __device__ __forceinline__ void route_qload(const bf16* QP, int tok, int head, int hi, bf16x8 (&qf)[8]) {
    const bf16* qp = QP + (size_t)tok * DM + head * 256 + PASS * 128 + hi * 8;
#pragma unroll
    for (int ks = 0; ks < 8; ++ks) qf[ks] = NT_ACT ? __builtin_nontemporal_load((const bf16x8*)(qp + ks * 16)) : *(const bf16x8*)(qp + ks * 16);
}
template <int PASS> __device__ __forceinline__ void route_pass(const bf16x8 (&qf)[8], const LAS char* lds, int tok, int head, int r32, int hi, unsigned (&top)[16]) {
    f32x16 acc[4] = {};
    const LAS char* Kl = lds + PASS * 32768;
#pragma unroll
    for (int kb = 0; kb < 4; ++kb)
#pragma unroll
        for (int ks = 0; ks < 8; ++ks) { const bf16x8 a = *(const LAS bf16x8*)(Kl + (kb * 32 + r32) * 256 + (((ks * 2 + hi) ^ (r32 & 15)) * 16));
            acc[kb] = __builtin_amdgcn_mfma_f32_32x32x16_bf16(a, qf[ks], acc[kb], 0, 0, 0); }
    unsigned key[64]; const unsigned base = 127u - 4u * (unsigned)hi;
#pragma unroll
    for (int kb = 0; kb < 4; ++kb)
#pragma unroll
        for (int r = 0; r < 16; ++r) key[kb * 16 + r] = (f2ord(acc[kb][r]) & ~127u) | (base - (unsigned)(kb * 32 + (r & 3) + 8 * (r >> 2)));
    top16_of_64(key);
    unsigned pr[16];
#pragma unroll
    for (int i = 0; i < 16; ++i) pr[i] = lane_xor32(key[15 - i], hi << 5);
#pragma unroll
    for (int i = 0; i < 16; ++i) key[i] = key[i] > pr[i] ? key[i] : pr[i];
    bitonic_merge<16, true>(key);
#pragma unroll
    for (int i = 0; i < 16; ++i) top[i] = key[i];
}
#ifndef ROUTE_SORT
#define ROUTE_SORT 1
#endif
#define DPP_U(v, ctrl) ((unsigned)__builtin_amdgcn_mov_dpp((int)(v), (ctrl), 0xF, 0xF, true))
template <int J> __device__ __forceinline__ unsigned lane_xor_u(unsigned v, int lane) {
    if (J == 1) return DPP_U(v, 0xB1);
    if (J == 2) return DPP_U(v, 0x4E);
    if (J == 4) { const unsigned t = DPP_U(v, 0x141); return DPP_U(t, 0x1B); }
    if (J == 8) { const unsigned t = DPP_U(v, 0x140); return DPP_U(t, 0x141); }
    if (J == 16) { const auto r = __builtin_amdgcn_permlane16_swap(v, v, false, false); return (lane & 16) ? r[0] : r[1]; }
    return lane_xor32(v, lane);
}
template <int K, int J> __device__ __forceinline__ void sort128_stage(unsigned& a0, unsigned& a1, int lane) {
    if constexpr (J == 64) { const unsigned mn = a0 < a1 ? a0 : a1, mx = a0 < a1 ? a1 : a0; a0 = mn; a1 = mx; }
    else { const unsigned p0 = lane_xor_u<J>(a0, lane), p1 = lane_xor_u<J>(a1, lane);
        const bool lower = (lane & J) == 0;
        const bool asc0 = (K >= 64) ? true : ((lane & K) == 0), asc1 = (K == 128) ? true : (K == 64 ? false : ((lane & K) == 0));
        const unsigned mn0 = a0 < p0 ? a0 : p0, mx0 = a0 < p0 ? p0 : a0, mn1 = a1 < p1 ? a1 : p1, mx1 = a1 < p1 ? p1 : a1;
        a0 = (lower == asc0) ? mn0 : mx0; a1 = (lower == asc1) ? mn1 : mx1; }
    if constexpr (J > 1) sort128_stage<K, J / 2>(a0, a1, lane);
    else if constexpr (K < 128) sort128_stage<K * 2, K>(a0, a1, lane);
}
__device__ __forceinline__ void sort128_asc(unsigned& a0, unsigned& a1, int lane) { sort128_stage<2, 1>(a0, a1, lane); }
__device__ __forceinline__ void route_phase(CP P, int L, int Mrows, LAS unsigned char* lds_, int tid, int lane, int wid, int gw, int NGW) {
    const bf16* QP = (const bf16*)(P->ws + WS_QP); unsigned* ROUTE = (unsigned*)(P->ws + WS_ROUTE);
    LAS char* lds = (LAS char*)(LAS unsigned char*)lds_;
    __syncthreads();
    {
        const bf16* K1 = (const bf16*)(P->ws + WS_PK1) + (size_t)L * 128 * 128; const bf16* K2 = (const bf16*)(P->ws + WS_PK2) + (size_t)L * 128 * 128;
        u32x4 kw[8];
#pragma unroll
        for (int t = 0; t < 8; ++t) { const int c16 = tid + t * NWAVES * 64; const int mat = c16 >> 11, row = (c16 >> 4) & 127, ch = c16 & 15; kw[t] = *(const u32x4*)((mat ? K2 : K1) + row * 128 + ch * 8); }
#pragma unroll
        for (int t = 0; t < 8; ++t) { const int c16 = tid + t * NWAVES * 64; const int mat = c16 >> 11, row = (c16 >> 4) & 127, ch = c16 & 15; *(LAS u32x4*)(lds + mat * 32768 + row * 256 + ((ch ^ (row & 15)) * 16)) = kw[t]; }
    }
    __syncthreads();
    LAS unsigned* sc = (LAS unsigned*)(lds + 65536) + wid * 2048;
    const int r32 = lane & 31, hi = lane >> 5;
    for (int item = gw; item < Mrows / 4; item += NGW) {
        const int tok = item * 4 + (r32 >> 3), head = r32 & 7;
        unsigned top0[16], top1[16];
        { bf16x8 q0[8], q1[8]; route_qload<0>(QP, tok, head, hi, q0); route_qload<1>(QP, tok, head, hi, q1);
          route_pass<0>(q0, lds, tok, head, r32, hi, top0);
          route_pass<1>(q1, lds, tok, head, r32, hi, top1); }
        float v1[16], v2[16];
#pragma unroll
        for (int i = 0; i < 16; ++i) { v1[i] = ord2f(top0[i] & ~127u); v2[i] = ord2f(top1[i] & ~127u);
            sc[i * 64 + lane] = 127u - (top0[i] & 127u); sc[(16 + i) * 64 + lane] = 127u - (top1[i] & 127u); }
        unsigned ck[64]; int n = 0;
#pragma unroll
        for (int i = 0; i < 16; ++i)
#pragma unroll
            for (int j = 0; j < 16; ++j) if ((i + 1) * (j + 1) <= 16) { ck[n] = (f2ord(v1[i] + v2[j]) & ~255u) | (unsigned)(i * 16 + j); ++n; }
#pragma unroll
        for (int i = 50; i < 64; ++i) ck[i] = 0u;
        top16_of_64(ck);
        float ev[16]; float sum = 0.f; const float mx = ord2f(ck[0] & ~255u);
#pragma unroll
        for (int k = 0; k < 16; ++k) { ev[k] = __expf(ord2f(ck[k] & ~255u) - mx); sum += ev[k]; }
        const float inv = 1.0f / sum;
        unsigned ee[16];
#pragma unroll
        for (int k = 0; k < 16; ++k) { const unsigned pc = ck[k] & 255u; const unsigned i1 = sc[(pc >> 4) * 64 + lane], i2 = sc[(16 + (pc & 15u)) * 64 + lane]; ee[k] = i1 * 128u + i2; ev[k] *= inv; }
#if ROUTE_SORT
        { const int tq = r32 >> 3;
#pragma unroll
          for (int k = 0; k < 8; ++k) {
              const unsigned eL = ee[k], eH = ee[k + 8]; const float gL = ev[k], gH = ev[k + 8];
              sc[tq * 256 + head * 16 + hi * 8 + k] = hi ? eH : eL; sc[tq * 256 + 128 + head * 16 + hi * 8 + k] = __float_as_uint(hi ? gH : gL); }
#pragma unroll 1
          for (int t = 0; t < 4; ++t) {
              unsigned a0 = (sc[t * 256 + lane] << 7) | (unsigned)lane, a1 = (sc[t * 256 + 64 + lane] << 7) | (unsigned)(64 + lane);
              sort128_asc(a0, a1, lane);
              const unsigned g0 = sc[t * 256 + 128 + (a0 & 127u)], g1 = sc[t * 256 + 128 + (a1 & 127u)];
              u32x2* outp = (u32x2*)(ROUTE + (size_t)(item * 4 + t) * 256);
              outp[lane] = (u32x2){a0 >> 7, g0}; outp[64 + lane] = (u32x2){a1 >> 7, g1}; }
        }
#else
        u32x4* outp = (u32x4*)(ROUTE + ((size_t)tok * 128 + head * 16 + hi * 8) * 2);
#pragma unroll
        for (int k = 0; k < 8; k += 2) { u32x4 w;
            const unsigned eL0 = ee[k], eH0 = ee[k + 8], eL1 = ee[k + 1], eH1 = ee[k + 9]; const float gL0 = ev[k], gH0 = ev[k + 8], gL1 = ev[k + 1], gH1 = ev[k + 9];
            w.x = hi ? eH0 : eL0; w.y = __float_as_uint(hi ? gH0 : gL0); w.z = hi ? eH1 : eL1; w.w = __float_as_uint(hi ? gH1 : gL1);
            outp[k >> 1] = w; }
#endif
    }
}

typedef float f32x2 __attribute__((ext_vector_type(2)));
typedef float f32x32 __attribute__((ext_vector_type(32)));
typedef unsigned u32x6 __attribute__((ext_vector_type(6)));
typedef __bf16 bf16x32 __attribute__((ext_vector_type(32)));
typedef unsigned u32x16 __attribute__((ext_vector_type(16)));
typedef __bf16 bf16x2_t __attribute__((ext_vector_type(2)));
#ifndef GATHER_ZIGZAG
#define GATHER_ZIGZAG 0
#endif
#ifndef GATHER_PRE
#define GATHER_PRE 0
#endif
#ifndef GATHER_XEARLY
#define GATHER_XEARLY 0
#endif
#ifndef GATHER_SWP
#define GATHER_SWP 0
#endif
#ifndef GATHER_VECREG
#define GATHER_VECREG 1
#endif
#ifndef GATHER_MFMADOT
#define GATHER_MFMADOT 1
#endif
typedef short s16x4_t __attribute__((ext_vector_type(4)));
#ifndef GATHER_PAIRRED
#define GATHER_PAIRRED 1
#endif
#ifndef GATHER_EARLY
#define GATHER_EARLY 1
#endif
#ifndef GATHER_PACE
#define GATHER_PACE 0
#endif
#define XB_PACE(j) (XCD_BAR_WORDS + 64 * (j))
#ifndef GATHER_DEEP
#define GATHER_DEEP 0
#endif
constexpr int GS = GATHER_DEEP ? 8 : 6, GSLOT = GATHER_DEEP ? 2048 : 2 * PROW;
__device__ __forceinline__ void glds16(const void* gsrc, unsigned lds_dst) { unsigned keep;
  asm volatile("s_mov_b32 %0, m0\n\ts_mov_b32 m0, %2\n\ts_nop 0\n\tglobal_load_lds_dwordx4 %1, off\n\ts_mov_b32 m0, %0" : "=&s"(keep) : "v"(gsrc), "s"(lds_dst) : "memory"); }
template <int GMODE = 0>
__device__ __forceinline__ void gather_phase(CP P, int L, int Mrows, LAS unsigned char* lds, int wid, int lane_, int gw, int NGW, bool dry = false) {
    const unsigned char* UV = P->ws + WS_PU + (size_t)L * 16384 * PREC;
    const unsigned* ROUTE = (const unsigned*)(P->ws + WS_ROUTE); const float* MOD = (const float*)(P->ws + WS_MOD);
    bf16* X = (bf16*)(P->ws + WS_X); bf16* H = (bf16*)(P->ws + WS_H); bf16* Xo = dry ? (bf16*)(P->ws + WS_Y) : X; bf16* Ho = dry ? (bf16*)(P->ws + WS_G) : H;
    const float* lng = P->in[6] + (size_t)(L * 2 + 1) * DM; const float* lnb = P->in[7] + (size_t)(L * 2 + 1) * DM;
    const unsigned ring = (unsigned)(uintptr_t)lds + (unsigned)wid * (GS * GSLOT);
    const int nfull = (Mrows / NGW) * NGW, rem = Mrows - nfull; const bool can_coop = (rem * 4 == NGW);
    const int nround = nfull / NGW + (rem > 0 ? 1 : 0);
    const bool pace_ok = (rem == 0) || can_coop;
#define G_ROWOF(it_) ((can_coop && (it_) == nround - 1) ? (nfull + (int)blockIdx.x * 2 + (wid >> 2)) : (gw + (it_) * NGW))
    u32x2 nea = {0u, 0u}, neb = {0u, 0u}; u32x4 nh0 = {0u, 0u, 0u, 0u}, nh1 = nh0, nh2 = nh0, nh3 = nh0;
#define G_NTL(p_) (NT_STREAM > 1 ? __builtin_nontemporal_load(p_) : *(p_))
#define G_PREFETCH(rowN_, ln_) do { const int rn_ = (rowN_); nea = G_NTL(&((const u32x2*)(ROUTE + (size_t)rn_ * 256))[ln_]); neb = G_NTL(&((const u32x2*)(ROUTE + (size_t)rn_ * 256))[64 + (ln_)]); \
        const u32x4* hp_ = (const u32x4*)(H + (size_t)rn_ * DM) + 4 * (ln_); nh0 = G_NTL(hp_); nh1 = G_NTL(hp_ + 1); nh2 = G_NTL(hp_ + 2); nh3 = G_NTL(hp_ + 3); } while (0)
    if (nround > 0 && G_ROWOF(0) < Mrows) G_PREFETCH(G_ROWOF(0), launder_v(lane_));
#if GATHER_VECREG
    LAS unsigned* LNV = (LAS unsigned*)(lds + NWAVES * GS * GSLOT);
    { f32x2 t_[4];
#pragma unroll
      for (int t = 0; t < 4; ++t) { const int i = wid * 64 + lane_ + t * NWAVES * 64; t_[t] = *(const f32x2*)(((i >> 10) ? lnb : lng) + 2 * (i & 1023)); }
#pragma unroll
      for (int t = 0; t < 4; ++t) { const float x0_ = t_[t][0], x1_ = t_[t][1]; LNV[wid * 64 + lane_ + t * NWAVES * 64] = cvtpk(x0_, x1_); } }
    __syncthreads();
    unsigned mg[16], ms[16], mc[16]; int cur_slot = -1;
#pragma unroll
    for (int i = 0; i < 16; ++i) { mg[i] = 0u; ms[i] = 0u; mc[i] = 0u; }
#endif
    bool pre = false;
#pragma unroll 1
    for (int it = 0; it < nround; ++it) {
#if GATHER_PACE
        if (pace_ok && it > 0) {
            if (wid == 0 && lane_ == 0) { const unsigned nloc = ((volatile LAS unsigned*)(lds + MISC_OFF))[8];
                if (nloc != 0u) { unsigned* pc = (unsigned*)(P->ws + WS_CTL) + CW_BAR + XB_PACE(xb_xcc_id());
                    const unsigned old = xb_add(pc, 1u), tgt = (old / nloc + 1u) * nloc; unsigned sp = 0u;
                    while ((int)(xb_ld(pc) - tgt) < 0 && ++sp < 20000u) __builtin_amdgcn_s_sleep(1); } }
            __syncthreads();
        }
#endif
        const bool coop = can_coop && (it == nround - 1);
        int row = G_ROWOF(it), k0 = 0, kn = 128;
        if (coop) { k0 = (wid & 3) * 32; kn = k0 + 32; }
        else if (row >= Mrows) break;
        const int lane = launder_v(lane_);
        const u32x2 ea = nea, eb = neb;
        unsigned eax, eay, ebx, eby;
        unsigned hw[16] = {nh0.x, nh0.y, nh0.z, nh0.w, nh1.x, nh1.y, nh1.z, nh1.w, nh2.x, nh2.y, nh2.z, nh2.w, nh3.x, nh3.y, nh3.z, nh3.w};
        float y[32];
#pragma unroll
        for (int i = 0; i < 32; ++i) y[i] = 0.f;
        { unsigned e0 = ea.x, e1 = ea.y, e2 = eb.x, e3 = eb.y;
          asm volatile("" : "+v"(e0), "+v"(e1), "+v"(e2), "+v"(e3), "+v"(hw[0]), "+v"(hw[1]), "+v"(hw[2]), "+v"(hw[3]), "+v"(hw[4]), "+v"(hw[5]), "+v"(hw[6]), "+v"(hw[7]),
                       "+v"(hw[8]), "+v"(hw[9]), "+v"(hw[10]), "+v"(hw[11]), "+v"(hw[12]), "+v"(hw[13]), "+v"(hw[14]), "+v"(hw[15]) :: "memory");
          eax = e0; eay = e1; ebx = e2; eby = e3; }
        const unsigned rd_a = ring + 16u * (unsigned)lane, rd_b = ring + 2048u + 8u * (unsigned)lane;
        const bool rev = GATHER_ZIGZAG && ((it & 1) != 0);
        const int kflip = rev ? (k0 + kn - 1) : 0, ksign = rev ? -1 : 1;
#define G_ISSUE(k) do { const int k_ = (k), ke_ = kflip + ksign * k_; const unsigned e_ = (unsigned)__builtin_amdgcn_readlane((int)(ke_ < 64 ? eax : ebx), ke_ & 63); \
        const unsigned char* rp_ = UV + (size_t)e_ * PREC + 16 * lane; const unsigned sb_ = ring + (unsigned)(k_ % GS) * GSLOT; \
        if (GMODE == 3) { glds16(rp_, sb_); if (lane < 32) glds16(rp_ + 2048, sb_ + 2048); } \
        else if (GMODE != 2) { glds16(rp_, sb_); glds16(rp_ + 1024, sb_ + 1024); if (PEER_U4) {} else if (PEER_V4) { if (lane < 32) glds16(rp_ + 2048, sb_ + 2048); } else glds16(rp_ + 2048, sb_ + 2048); } else { asm volatile("" :: "v"(rp_), "s"(sb_)); } } while (0)
#if GATHER_EARLY
        if (it + 1 < nround && G_ROWOF(it + 1) < Mrows) G_PREFETCH(G_ROWOF(it + 1), lane);
        if (!pre) {
#pragma unroll
            for (int k = 0; k < GS; ++k) G_ISSUE(k0 + k); }
#else
#pragma unroll
        for (int k = 0; k < 4; ++k) G_ISSUE(k0 + k);
        if (it + 1 < nround && G_ROWOF(it + 1) < Mrows) G_PREFETCH(G_ROWOF(it + 1), lane);
#endif
#define G_READ(k, ua, ub, va, vb) do { const unsigned so_ = (unsigned)((k) % GS) * GSLOT; \
        if (PEER_U4) asm volatile("ds_read_b128 %0, %2\n\tds_read_b128 %1, %2 offset:1024" : "=&v"(ua), "=&v"(va) : "v"(rd_a + so_) : "memory"); \
        else if (PEER_V4) asm volatile("ds_read_b128 %0, %3\n\tds_read_b64 %1, %4\n\tds_read_b128 %2, %3 offset:1024" \
                     : "=&v"(ua), "=&v"(ub), "=&v"(va) : "v"(rd_a + so_), "v"(rd_b + so_) : "memory"); \
        else asm volatile("ds_read_b128 %0, %4\n\tds_read_b64 %1, %5\n\tds_read_b128 %2, %4 offset:1024\n\tds_read_b64 %3, %5 offset:512" \
                     : "=&v"(ua), "=&v"(ub), "=&v"(va), "=&v"(vb) : "v"(rd_a + so_), "v"(rd_b + so_) : "memory"); } while (0)
#if GATHER_XEARLY
        u32x4 xr0 = {0u, 0u, 0u, 0u}, xr1 = xr0, xr2 = xr0, xr3 = xr0;
#endif
#if GATHER_SWP
        static_assert(!GATHER_SWP || (PEER_U4 && PEER_V4 && GATHER_EARLY && GATHER_PAIRRED && GATHER_MFMADOT && !GATHER_DEEP && !GATHER_XEARLY && !GATHER_PRE), "GATHER_SWP: configuration");
#define SWP_FETCH(kk, uA, uB, vA, vB) do { const int kk_ = (kk); \
            if (kk_ + 4 < kn) asm volatile("s_waitcnt vmcnt(8)" ::: "memory"); else if (kk_ == kn - 4) asm volatile("s_waitcnt vmcnt(4)" ::: "memory"); else asm volatile("s_waitcnt vmcnt(0)" ::: "memory"); \
            u32x2 d0_ = {0u, 0u}, d1_ = {0u, 0u}; G_READ(kk_, uA, d0_, vA, d1_); G_READ(kk_ + 1, uB, d0_, vB, d1_); \
            asm volatile("s_waitcnt lgkmcnt(0)" : "+v"(uA), "+v"(vA), "+v"(uB), "+v"(vB) :: "memory"); \
            if (kk_ + GS < kn) { G_ISSUE(kk_ + GS); G_ISSUE(kk_ + GS + 1); } } while (0)
#define SWP_U4(dst_, src_, w_, b_) dst_[4 * (w_) + (b_)] = __builtin_bit_cast(unsigned, __builtin_amdgcn_cvt_scalef32_pk_bf16_fp4(src_[w_], 1.0f, b_))
#define SWP_UPART(kk, uA, uB, wA_, wB_) do { const int kk_ = (kk); u32x16 ubfA, ubfB; const unsigned uwA[4] = {uA.x, uA.y, uA.z, uA.w}, uwB[4] = {uB.x, uB.y, uB.z, uB.w}; \
            _Pragma("unroll") for (int w = 0; w < 4; ++w) { SWP_U4(ubfA, uwA, w, 0); SWP_U4(ubfA, uwA, w, 1); SWP_U4(ubfA, uwA, w, 2); SWP_U4(ubfA, uwA, w, 3); SWP_U4(ubfB, uwB, w, 0); SWP_U4(ubfB, uwB, w, 1); SWP_U4(ubfB, uwB, w, 2); SWP_U4(ubfB, uwB, w, 3); } \
            f32x4 dgA = {0.f, 0.f, 0.f, 0.f}, dgB = {0.f, 0.f, 0.f, 0.f}; \
            _Pragma("unroll") for (int q = 0; q < 16; q += 2) { const u32x2 hq_ = {hw[q], hw[q + 1]}, xa_ = {ubfA[q], ubfA[q + 1]}, xb_ = {ubfB[q], ubfB[q + 1]}; \
                dgA = __builtin_amdgcn_mfma_f32_4x4x4bf16_1k(__builtin_bit_cast(s16x4_t, xa_), __builtin_bit_cast(s16x4_t, hq_), dgA, 0, 0, 0); \
                dgB = __builtin_amdgcn_mfma_f32_4x4x4bf16_1k(__builtin_bit_cast(s16x4_t, xb_), __builtin_bit_cast(s16x4_t, hq_), dgB, 0, 0, 0); } \
            const float x0 = dgA[0], x1 = dgA[1], x2 = dgA[2], x3 = dgA[3], y0 = dgB[0], y1 = dgB[1], y2 = dgB[2], y3 = dgB[3]; \
            float a0 = DPP_F(x0, 0x00); a0 += DPP_F(x1, 0x55); a0 += DPP_F(x2, 0xAA); a0 += DPP_F(x3, 0xFF); \
            float b0 = DPP_F(y0, 0x00); b0 += DPP_F(y1, 0x55); b0 += DPP_F(y2, 0xAA); b0 += DPP_F(y3, 0xFF); \
            const auto sw = __builtin_amdgcn_permlane32_swap(__float_as_uint(a0), __float_as_uint(b0), false, false); \
            float c2 = __uint_as_float(sw[0]) + __uint_as_float(sw[1]); c2 += DPP_F(c2, 0x141); c2 += DPP_F(c2, 0x140); \
            const float d2 = sum_xor16(c2) * (1.0f / U_SCALE); const float g2 = gelu_tanh(d2) * (1.0f / V_SCALE); \
            const float gA = __uint_as_float((unsigned)__builtin_amdgcn_readlane((int)__float_as_uint(g2), 0)), gB = __uint_as_float((unsigned)__builtin_amdgcn_readlane((int)__float_as_uint(g2), 32)); \
            const int keA = kflip + ksign * kk_, keB = keA + ksign; const unsigned gsel = keA < 64 ? eay : eby; \
            wA_ = __uint_as_float((unsigned)__builtin_amdgcn_readlane((int)gsel, keA & 63)) * gA; wB_ = __uint_as_float((unsigned)__builtin_amdgcn_readlane((int)gsel, keB & 63)) * gB; } while (0)
#define SWP_V4(vwA, vwB, w_, b_, wA_, wB_) do { const f32x2 pA = __builtin_amdgcn_cvt_scalef32_pk_f32_fp4(vwA[w_], 1.0f, b_), pB = __builtin_amdgcn_cvt_scalef32_pk_f32_fp4(vwB[w_], 1.0f, b_); const int j = 4 * (w_) + (b_); \
            const float pa0 = pA[0], pa1 = pA[1], pb0 = pB[0], pb1 = pB[1]; y[2 * j] += wA_ * pa0; y[2 * j + 1] += wA_ * pa1; y[2 * j] += wB_ * pb0; y[2 * j + 1] += wB_ * pb1; } while (0)
#define SWP_VPART(vA, vB, wA_, wB_) do { const unsigned vwA[4] = {vA.x, vA.y, vA.z, vA.w}, vwB[4] = {vB.x, vB.y, vB.z, vB.w}; \
            _Pragma("unroll") for (int w = 0; w < 4; ++w) { SWP_V4(vwA, vwB, w, 0, wA_, wB_); SWP_V4(vwA, vwB, w, 1, wA_, wB_); SWP_V4(vwA, vwB, w, 2, wA_, wB_); SWP_V4(vwA, vwB, w, 3, wA_, wB_); } } while (0)
#define SWP_VCH(w_, qA_, qB_) do { SWP_V4(vwA, vwB, w_, 0, qA_, qB_); SWP_V4(vwA, vwB, w_, 1, qA_, qB_); SWP_V4(vwA, vwB, w_, 2, qA_, qB_); SWP_V4(vwA, vwB, w_, 3, qA_, qB_); } while (0)
#define SWP_MIX(kk, uA, uB, wA_, wB_, pvA, pvB, pwA_, pwB_) do { const int kk_ = (kk); u32x16 ubfA, ubfB; const unsigned uwA[4] = {uA.x, uA.y, uA.z, uA.w}, uwB[4] = {uB.x, uB.y, uB.z, uB.w}; \
            const unsigned vwA[4] = {pvA.x, pvA.y, pvA.z, pvA.w}, vwB[4] = {pvB.x, pvB.y, pvB.z, pvB.w}; \
            _Pragma("unroll") for (int w = 0; w < 4; ++w) { SWP_U4(ubfA, uwA, w, 0); SWP_U4(ubfA, uwA, w, 1); SWP_U4(ubfA, uwA, w, 2); SWP_U4(ubfA, uwA, w, 3); SWP_U4(ubfB, uwB, w, 0); SWP_U4(ubfB, uwB, w, 1); SWP_U4(ubfB, uwB, w, 2); SWP_U4(ubfB, uwB, w, 3); } \
            f32x4 dgA = {0.f, 0.f, 0.f, 0.f}, dgB = {0.f, 0.f, 0.f, 0.f}; \
            _Pragma("unroll") for (int q = 0; q < 16; q += 2) { const u32x2 hq_ = {hw[q], hw[q + 1]}, xa_ = {ubfA[q], ubfA[q + 1]}, xb_ = {ubfB[q], ubfB[q + 1]}; \
                dgA = __builtin_amdgcn_mfma_f32_4x4x4bf16_1k(__builtin_bit_cast(s16x4_t, xa_), __builtin_bit_cast(s16x4_t, hq_), dgA, 0, 0, 0); \
                dgB = __builtin_amdgcn_mfma_f32_4x4x4bf16_1k(__builtin_bit_cast(s16x4_t, xb_), __builtin_bit_cast(s16x4_t, hq_), dgB, 0, 0, 0); } \
            SWP_VCH(0, pwA_, pwB_); \
            const float x0 = dgA[0], x1 = dgA[1], x2 = dgA[2], x3 = dgA[3], y0 = dgB[0], y1 = dgB[1], y2 = dgB[2], y3 = dgB[3]; \
            float a0 = DPP_F(x0, 0x00); a0 += DPP_F(x1, 0x55); a0 += DPP_F(x2, 0xAA); a0 += DPP_F(x3, 0xFF); \
            float b0 = DPP_F(y0, 0x00); b0 += DPP_F(y1, 0x55); b0 += DPP_F(y2, 0xAA); b0 += DPP_F(y3, 0xFF); \
            SWP_VCH(1, pwA_, pwB_); \
            const auto sw = __builtin_amdgcn_permlane32_swap(__float_as_uint(a0), __float_as_uint(b0), false, false); \
            float c2 = __uint_as_float(sw[0]) + __uint_as_float(sw[1]); c2 += DPP_F(c2, 0x141); c2 += DPP_F(c2, 0x140); \
            float d2 = sum_xor16(c2) * (1.0f / U_SCALE); \
            SWP_VCH(2, pwA_, pwB_); \
            float g2 = gelu_tanh(d2) * (1.0f / V_SCALE); \
            SWP_VCH(3, pwA_, pwB_); \
            const float gA = __uint_as_float((unsigned)__builtin_amdgcn_readlane((int)__float_as_uint(g2), 0)), gB = __uint_as_float((unsigned)__builtin_amdgcn_readlane((int)__float_as_uint(g2), 32)); \
            const int keA = kflip + ksign * kk_, keB = keA + ksign; const unsigned gsel = keA < 64 ? eay : eby; \
            wA_ = __uint_as_float((unsigned)__builtin_amdgcn_readlane((int)gsel, keA & 63)) * gA; wB_ = __uint_as_float((unsigned)__builtin_amdgcn_readlane((int)gsel, keB & 63)) * gB; } while (0)
        if (GMODE == 0) {
            u32x4 cuA, cuB, cvA, cvB; float cwA, cwB;
            SWP_FETCH(k0, cuA, cuB, cvA, cvB); SWP_UPART(k0, cuA, cuB, cwA, cwB);
#pragma unroll 1
            for (int k = k0; k + 2 < kn; k += 2) {
                u32x4 nuA, nuB, nvA, nvB; float nwA, nwB;
                SWP_FETCH(k + 2, nuA, nuB, nvA, nvB);
                SWP_MIX(k + 2, nuA, nuB, nwA, nwB, cvA, cvB, cwA, cwB);
                cvA = nvA; cvB = nvB; cwA = nwA; cwB = nwB;
            }
            SWP_VPART(cvA, cvB, cwA, cwB);
        } else
#undef SWP_MIX
#undef SWP_VCH
#undef SWP_FETCH
#undef SWP_U4
#undef SWP_UPART
#undef SWP_V4
#undef SWP_VPART
#endif
#pragma unroll 1
        for (int k = k0; k < kn; k += 2) {
            if (GATHER_DEEP && k + 6 < kn) asm volatile("s_waitcnt vmcnt(12)" ::: "memory");
            else if (GATHER_DEEP && k == kn - 6) asm volatile("s_waitcnt vmcnt(8)" ::: "memory");
            else if (k + 4 < kn) { if (!GATHER_EARLY) { G_ISSUE(k + 4); G_ISSUE(k + 5); } if (GMODE == 3 || PEER_U4) asm volatile("s_waitcnt vmcnt(8)" ::: "memory"); else asm volatile("s_waitcnt vmcnt(12)" ::: "memory"); }
            else if (k == kn - 4) { if (GMODE == 3 || PEER_U4) asm volatile("s_waitcnt vmcnt(4)" ::: "memory"); else asm volatile("s_waitcnt vmcnt(6)" ::: "memory"); }
            else asm volatile("s_waitcnt vmcnt(0)" ::: "memory");
            u32x4 uaA, vaA, uaB, vaB; u32x2 ubA = {0u, 0u}, vbA = {0u, 0u}, ubB = {0u, 0u}, vbB = {0u, 0u};
            G_READ(k, uaA, ubA, vaA, vbA); G_READ(k + 1, uaB, ubB, vaB, vbB);
            asm volatile("s_waitcnt lgkmcnt(0)" : "+v"(uaA), "+v"(ubA), "+v"(vaA), "+v"(vbA), "+v"(uaB), "+v"(ubB), "+v"(vaB), "+v"(vbB) :: "memory");
#if GATHER_XEARLY
            if (k == kn - 4) { const u32x4* xp_ = (const u32x4*)(X + (size_t)row * DM) + 4 * lane; xr0 = xp_[0]; xr1 = xp_[1]; xr2 = xp_[2]; xr3 = xp_[3]; }
#endif
            if (GATHER_EARLY && k + GS < kn) { G_ISSUE(k + GS); G_ISSUE(k + GS + 1); }
            if (GMODE == 1 || GMODE == 3) continue;
#if PEER_U4
            u32x16 ubfA, ubfB;
            { const unsigned uwA[4] = {uaA.x, uaA.y, uaA.z, uaA.w}, uwB[4] = {uaB.x, uaB.y, uaB.z, uaB.w};
#pragma unroll
              for (int w = 0; w < 4; ++w) {
#define U4_CVT(b_) do { ubfA[4 * w + (b_)] = __builtin_bit_cast(unsigned, __builtin_amdgcn_cvt_scalef32_pk_bf16_fp4(uwA[w], 1.0f, b_)); ubfB[4 * w + (b_)] = __builtin_bit_cast(unsigned, __builtin_amdgcn_cvt_scalef32_pk_bf16_fp4(uwB[w], 1.0f, b_)); } while (0)
                  U4_CVT(0); U4_CVT(1); U4_CVT(2); U4_CVT(3);
#undef U4_CVT
              } }
#else
            const u32x6 u6A = {uaA.x, uaA.y, uaA.z, uaA.w, ubA.x, ubA.y}, u6B = {uaB.x, uaB.y, uaB.z, uaB.w, ubB.x, ubB.y};
            const u32x16 ubfA = __builtin_bit_cast(u32x16, __builtin_amdgcn_cvt_scalef32_pk32_bf16_fp6(u6A, 1.0f));
            const u32x16 ubfB = __builtin_bit_cast(u32x16, __builtin_amdgcn_cvt_scalef32_pk32_bf16_fp6(u6B, 1.0f));
#endif
#if GATHER_MFMADOT
            f32x4 dgA = {0.f, 0.f, 0.f, 0.f}, dgB = {0.f, 0.f, 0.f, 0.f};
#pragma unroll
            for (int q = 0; q < 16; q += 2) { const u32x2 hq_ = {hw[q], hw[q + 1]}, xa_ = {ubfA[q], ubfA[q + 1]}, xb_ = {ubfB[q], ubfB[q + 1]};
                dgA = __builtin_amdgcn_mfma_f32_4x4x4bf16_1k(__builtin_bit_cast(s16x4_t, xa_), __builtin_bit_cast(s16x4_t, hq_), dgA, 0, 0, 0);
                dgB = __builtin_amdgcn_mfma_f32_4x4x4bf16_1k(__builtin_bit_cast(s16x4_t, xb_), __builtin_bit_cast(s16x4_t, hq_), dgB, 0, 0, 0); }
            float a0, a1 = 0.f, b0, b1 = 0.f;
            { const float x0 = dgA[0], x1 = dgA[1], x2 = dgA[2], x3 = dgA[3], y0 = dgB[0], y1 = dgB[1], y2 = dgB[2], y3 = dgB[3];
              a0 = DPP_F(x0, 0x00); a0 += DPP_F(x1, 0x55); a0 += DPP_F(x2, 0xAA); a0 += DPP_F(x3, 0xFF);
              b0 = DPP_F(y0, 0x00); b0 += DPP_F(y1, 0x55); b0 += DPP_F(y2, 0xAA); b0 += DPP_F(y3, 0xFF); }
#else
            float a0 = 0.f, a1 = 0.f, b0 = 0.f, b1 = 0.f;
#pragma unroll
            for (int q = 0; q < 16; q += 2) { const unsigned h0_ = hw[q], h1_ = hw[q + 1], x0_ = ubfA[q], x1_ = ubfA[q + 1], z0_ = ubfB[q], z1_ = ubfB[q + 1];
                a0 = __builtin_amdgcn_fdot2_f32_bf16(__builtin_bit_cast(bf16x2_t, h0_), __builtin_bit_cast(bf16x2_t, x0_), a0, false);
                a1 = __builtin_amdgcn_fdot2_f32_bf16(__builtin_bit_cast(bf16x2_t, h1_), __builtin_bit_cast(bf16x2_t, x1_), a1, false);
                b0 = __builtin_amdgcn_fdot2_f32_bf16(__builtin_bit_cast(bf16x2_t, h0_), __builtin_bit_cast(bf16x2_t, z0_), b0, false);
                b1 = __builtin_amdgcn_fdot2_f32_bf16(__builtin_bit_cast(bf16x2_t, h1_), __builtin_bit_cast(bf16x2_t, z1_), b1, false); }
#endif
            const int keA = kflip + ksign * k, keB = keA + ksign;
            const unsigned gsel = keA < 64 ? eay : eby;
#if GATHER_PAIRRED
            float wA, wB;
            { const auto sw = __builtin_amdgcn_permlane32_swap(__float_as_uint(GATHER_MFMADOT ? a0 : a0 + a1), __float_as_uint(GATHER_MFMADOT ? b0 : b0 + b1), false, false);
#if GATHER_MFMADOT
              float c2 = __uint_as_float(sw[0]) + __uint_as_float(sw[1]); c2 += DPP_F(c2, 0x141); c2 += DPP_F(c2, 0x140);
              const float d2 = sum_xor16(c2) * (1.0f / U_SCALE);
#else
              const float d2 = half_sum32(__uint_as_float(sw[0]) + __uint_as_float(sw[1])) * (1.0f / U_SCALE);
#endif
              const float g2 = gelu_tanh(d2) * (1.0f / V_SCALE);
              const float gA = __uint_as_float((unsigned)__builtin_amdgcn_readlane((int)__float_as_uint(g2), 0)), gB = __uint_as_float((unsigned)__builtin_amdgcn_readlane((int)__float_as_uint(g2), 32));
              wA = __uint_as_float((unsigned)__builtin_amdgcn_readlane((int)gsel, keA & 63)) * gA; wB = __uint_as_float((unsigned)__builtin_amdgcn_readlane((int)gsel, keB & 63)) * gB; }
#else
            const float dA = wave_sum(a0 + a1) * (1.0f / U_SCALE), dB = wave_sum(b0 + b1) * (1.0f / U_SCALE);
            const float wA = __uint_as_float((unsigned)__builtin_amdgcn_readlane((int)gsel, keA & 63)) * gelu_tanh(dA) * (1.0f / V_SCALE);
            const float wB = __uint_as_float((unsigned)__builtin_amdgcn_readlane((int)gsel, keB & 63)) * gelu_tanh(dB) * (1.0f / V_SCALE);
#endif
#if PEER_V4
            { const unsigned vwA[4] = {vaA.x, vaA.y, vaA.z, vaA.w}, vwB[4] = {vaB.x, vaB.y, vaB.z, vaB.w};
#pragma unroll
              for (int w = 0; w < 4; ++w) {
#define V4_ACC(b_) do { const f32x2 pA = __builtin_amdgcn_cvt_scalef32_pk_f32_fp4(vwA[w], 1.0f, b_), pB = __builtin_amdgcn_cvt_scalef32_pk_f32_fp4(vwB[w], 1.0f, b_); const int j = 4 * w + (b_); \
                    const float pa0 = pA[0], pa1 = pA[1], pb0 = pB[0], pb1 = pB[1]; y[2 * j] += wA * pa0; y[2 * j + 1] += wA * pa1; y[2 * j] += wB * pb0; y[2 * j + 1] += wB * pb1; } while (0)
                  V4_ACC(0); V4_ACC(1); V4_ACC(2); V4_ACC(3);
#undef V4_ACC
              } }
#else
            const u32x6 v6A = {vaA.x, vaA.y, vaA.z, vaA.w, vbA.x, vbA.y};
            const f32x32 vfA = __builtin_amdgcn_cvt_scalef32_pk32_f32_fp6(v6A, 1.0f);
#pragma unroll
            for (int i = 0; i < 32; ++i) y[i] += wA * vfA[i];
            const u32x6 v6B = {vaB.x, vaB.y, vaB.z, vaB.w, vbB.x, vbB.y};
            const f32x32 vfB = __builtin_amdgcn_cvt_scalef32_pk32_f32_fp6(v6B, 1.0f);
#pragma unroll
            for (int i = 0; i < 32; ++i) y[i] += wB * vfB[i];
#endif
        }
#if GATHER_PRE
        pre = (it + 1 < nround) && (G_ROWOF(it + 1) < Mrows);
        if (pre) { unsigned n0 = nea.x, n2 = neb.x; asm volatile("" : "+v"(n0), "+v"(n2) :: "memory"); eax = n0; ebx = n2;
            const int k0n = (can_coop && (it + 1 == nround - 1)) ? (wid & 3) * 32 : 0;
#pragma unroll
            for (int k = 0; k < 6; ++k) G_ISSUE(k0n + k); }
#endif
#undef G_READ
#undef G_ISSUE
        if (coop) {
            LAS f32x4* mine = (LAS f32x4*)(lds + wid * (GS * GSLOT)) + lane * 8;
#pragma unroll
            for (int i = 0; i < 8; ++i) mine[i] = (f32x4){y[4 * i], y[4 * i + 1], y[4 * i + 2], y[4 * i + 3]};
            __syncthreads();
            if ((wid & 3) == 0) {
#pragma unroll
                for (int j = 1; j < 4; ++j) { const LAS f32x4* oth = (const LAS f32x4*)(lds + (wid + j) * (GS * GSLOT)) + lane * 8;
#pragma unroll
                    for (int i = 0; i < 8; ++i) { const f32x4 t = oth[i]; y[4 * i] += t.x; y[4 * i + 1] += t.y; y[4 * i + 2] += t.z; y[4 * i + 3] += t.w; } }
            }
            __syncthreads();
            if ((wid & 3) != 0) continue;
        }
        const int slot = row_slot(row);
        const float* mod = MOD + (size_t)(L * 3 + slot) * 12288;
        const int le = launder_v(lane);
#if GATHER_VECREG
        if (slot != cur_slot) { cur_slot = slot; float t_[32];
            load_row_f32_b(mod + 5 * 2048, le, t_);
#pragma unroll
            for (int i = 0; i < 16; ++i) mg[i] = cvtpk(t_[2 * i], t_[2 * i + 1]);
            if (L < NLAYER - 1) { const float* modn = MOD + (size_t)((L + 1) * 3 + slot) * 12288;
                load_row_f32_b(modn, le, t_);
#pragma unroll
                for (int i = 0; i < 16; ++i) ms[i] = cvtpk(t_[2 * i], t_[2 * i + 1]);
                load_row_f32_b(modn + 2048, le, t_);
#pragma unroll
                for (int i = 0; i < 16; ++i) mc[i] = cvtpk(t_[2 * i], t_[2 * i + 1]); } }
        { float xx[32];
#if GATHER_XEARLY
          { const unsigned xw_[16] = {xr0.x, xr0.y, xr0.z, xr0.w, xr1.x, xr1.y, xr1.z, xr1.w, xr2.x, xr2.y, xr2.z, xr2.w, xr3.x, xr3.y, xr3.z, xr3.w};
#pragma unroll
            for (int i = 0; i < 16; ++i) { xx[2 * i] = bflo(xw_[i]); xx[2 * i + 1] = bfhi(xw_[i]); } }
#else
          { const u32x4* xp_ = (const u32x4*)(X + (size_t)row * DM) + 4 * le;
#pragma unroll
            for (int j = 0; j < 4; ++j) { const u32x4 w = G_NTL(xp_ + j); xx[8 * j + 0] = bflo(w.x); xx[8 * j + 1] = bfhi(w.x); xx[8 * j + 2] = bflo(w.y); xx[8 * j + 3] = bfhi(w.y);
                xx[8 * j + 4] = bflo(w.z); xx[8 * j + 5] = bfhi(w.z); xx[8 * j + 6] = bflo(w.w); xx[8 * j + 7] = bfhi(w.w); } }
#endif
#pragma unroll
          for (int i = 0; i < 16; ++i) { y[2 * i] = ALPHA * xx[2 * i] + bflo(mg[i]) * y[2 * i]; y[2 * i + 1] = ALPHA * xx[2 * i + 1] + bfhi(mg[i]) * y[2 * i + 1]; } }
        { float mean, rstd; ln_stats(y, mean, rstd);
          const LAS u32x4* gp = (const LAS u32x4*)(LNV + le * 16); const LAS u32x4* bp = (const LAS u32x4*)(LNV + 1024 + le * 16);
#pragma unroll
          for (int q = 0; q < 4; ++q) { const u32x4 g4 = gp[q], b4 = bp[q]; const unsigned gw_[4] = {g4.x, g4.y, g4.z, g4.w}, bw_[4] = {b4.x, b4.y, b4.z, b4.w};
#pragma unroll
              for (int j = 0; j < 4; ++j) { const int i = 8 * q + 2 * j; y[i] = (y[i] - mean) * rstd * bflo(gw_[j]) + bflo(bw_[j]); y[i + 1] = (y[i + 1] - mean) * rstd * bfhi(gw_[j]) + bfhi(bw_[j]); } }
          if (L < NLAYER - 1) { store_row_bf16_b(Xo + (size_t)row * DM, le, y);
              ln_stats(y, mean, rstd); float a_[32];
#pragma unroll
              for (int i = 0; i < 16; ++i) { a_[2 * i] = (y[2 * i] - mean) * rstd * (1.0f + bflo(mc[i])) + bflo(ms[i]); a_[2 * i + 1] = (y[2 * i + 1] - mean) * rstd * (1.0f + bfhi(mc[i])) + bfhi(ms[i]); }
              store_row_bf16_b(Ho + (size_t)row * DM, le, a_); }
          else { if (NT_STREAM > 1) store_row_f32_b_nt(P->out + (size_t)row * DM, le, y); else store_row_f32_b(P->out + (size_t)row * DM, le, y); } }
        asm volatile("s_waitcnt vmcnt(0)" ::: "memory");
        continue;
#endif
        { float xx[32], gg[32]; load_row_bf16_b(X + (size_t)row * DM, le, xx); load_row_f32_b(mod + 5 * 2048, le, gg);
#pragma unroll
          for (int i = 0; i < 32; ++i) y[i] = ALPHA * xx[i] + gg[i] * y[i]; }
        if (L < NLAYER - 1) { const float* modn = MOD + (size_t)((L + 1) * 3 + slot) * 12288;
            finish_row<true>(y, lng, lnb, Xo + (size_t)row * DM, modn, modn + 2048, Ho + (size_t)row * DM, nullptr, le); }
        else finish_row<true>(y, lng, lnb, nullptr, nullptr, nullptr, nullptr, P->out + (size_t)row * DM, le);
        asm volatile("s_waitcnt vmcnt(0)" ::: "memory");
    }
#undef G_PREFETCH
#undef G_ROWOF
}

#ifndef ROPE_TEST
#define ROPE_TEST 0
#endif
#ifndef TAIL_L3MOVE
#define TAIL_L3MOVE 1
#endif
#ifndef PROBE_DUP
#define PROBE_DUP 0
#endif
#define NOINL __forceinline__
__device__ __forceinline__ CP launder_cp(CP p) { asm volatile("" : "+s"(p)); return p; }
#define GETP() launder_cp((CP)__builtin_amdgcn_kernarg_segment_ptr())
__device__ __forceinline__ int uni(int v) { return __builtin_amdgcn_readfirstlane(v); }
__device__ __forceinline__ LAS unsigned char* uni_lds(LAS unsigned char* p) { return (LAS unsigned char*)(unsigned)__builtin_amdgcn_readfirstlane((int)(unsigned)(uintptr_t)p); }
#define PH_IDS const int wid = uni(wv_), lane = launder_v(lane_id_fresh()) & 63, tid = (wid & 7) * 64 + lane; const int gw = blockIdx.x * NWAVES + wid, NGW = gridDim.x * NWAVES; (void)lane; (void)gw; (void)NGW; (void)tid;

__device__ NOINL void ph_prologue(int wv_, LAS unsigned char* lds_) { CP P = GETP(); LAS unsigned char* lds = uni_lds(lds_); PH_IDS p0_prologue(P, lds, tid, lane, wid, gw, NGW); if (PROBE_DUP == 5) p0_prologue(P, lds, tid, lane, wid, gw, NGW);
    if (PROBE_DUP >= 21 && PROBE_DUP <= 23) { __syncthreads(); p0_prologue(P, lds, tid, lane, wid, gw, NGW, 1 << (PROBE_DUP - 21 < 0 ? 0 : (PROBE_DUP - 21) & 3)); } }
__device__ NOINL void ph_modreduce(int wv_) { CP P = GETP(); PH_IDS mod_reduce(P, gw, lane, NGW); }
__device__ NOINL void ph_first(int wv_, LAS unsigned char* lds_) { CP P = GETP(); LAS unsigned char* lds = uni_lds(lds_); PH_IDS
#pragma unroll 1
    for (int rep = 0; rep < (PROBE_DUP == 6 ? 2 : 1); ++rep) first_row_pass(P, lds, tid, lane, gw, NGW); }
__device__ NOINL void ph_postmix(int wv_, LAS unsigned char* lds_, int L_, int M_) { CP P = GETP(); LAS unsigned char* lds = uni_lds(lds_); const int L = uni(L_), Mrows = uni(M_); PH_IDS
    if (POSTMIX_LDS) post_mixer_pass_lds(P, L, Mrows, lds, tid, lane, gw, NGW); else post_mixer_pass(P, L, Mrows, lane, gw, NGW); }
__device__ NOINL void ph_vstats(int wv_, int M_) { CP P = GETP(); const int Mrows = uni(M_); PH_IDS
#pragma unroll 1
    for (int rep = 0; rep < (PROBE_DUP == 6 ? 2 : 1); ++rep) vstats_pass(P, Mrows, lane, gw, NGW); }
__device__ NOINL void ph_spatial(int wv_, LAS unsigned char* lds_, int j_, int M_) { CP P = GETP(); LAS unsigned char* lds = uni_lds(lds_); const int j = uni(j_), Mrows = uni(M_); PH_IDS
#pragma unroll 1
    for (int rep = 0; rep < ((PROBE_DUP == 6 || PROBE_DUP == 19) ? 2 : 1); ++rep) spatial_phase(P, j, Mrows, lds, tid, lane, wid); }
__device__ NOINL void ph_mla_norm(int wv_) { CP P = GETP(); PH_IDS
#pragma unroll 1
    for (int rep = 0; rep < (PROBE_DUP == 6 ? 2 : 1); ++rep) mla_norm_pass(P, lane, gw, NGW); }
__device__ NOINL void ph_rope(int wv_, int which_) { CP P = GETP(); const int which = uni(which_); PH_IDS
    if (which == 0) rope_pass((bf16*)(P->ws + WS_QM), 3072, 128, 16, 192, lane, gw, NGW);
    else rope_pass((bf16*)(P->ws + WS_Z), 6144, 0, 64, 64, lane, gw, NGW); }
__device__ NOINL void ph_attn_mla(int wv_, LAS unsigned char* lds_) { CP P = GETP(); LAS unsigned char* lds = uni_lds(lds_); PH_IDS mla_attn_phase(P, lds, tid); if (PROBE_DUP == 2 || PROBE_DUP == 9) mla_attn_phase(P, lds, tid); }
__device__ NOINL void ph_attn_da(int wv_, LAS unsigned char* lds_, int L_, bool ctx_q) { CP P = GETP(); LAS unsigned char* lds = uni_lds(lds_); const int L = uni(L_); PH_IDS
    const float* lp = P->in[26];
    const float s01 = wave_sum(lp[lane] * lp[64 + lane]), s23 = wave_sum(lp[128 + lane] * lp[192 + lane]);
    const float lam_init = 0.8f - 0.6f * expf(-0.3f * (float)L);
    const float lam = expf(s01) - expf(s23) + lam_init;
    if (PROBE_DUP == 24) { da_attn_phase(P, lam, 1.0f - lam_init, lds, tid, ctx_q, 4); __syncthreads(); }
    if (PROBE_DUP == 25) { da_attn_phase(P, lam, 1.0f - lam_init, lds, tid, ctx_q, 2); __syncthreads(); }
    if (PROBE_DUP == 26) { da_attn_phase(P, lam, 1.0f - lam_init, lds, tid, ctx_q, 12); __syncthreads(); }
    if (!(PROBE_DUP >= 11 && PROBE_DUP <= 15)) da_attn_phase(P, lam, 1.0f - lam_init, lds, tid, ctx_q);
    if (PROBE_DUP == 2 || PROBE_DUP == 10) da_attn_phase(P, lam, 1.0f - lam_init, lds, tid, ctx_q);
    if (PROBE_DUP >= 11 && PROBE_DUP <= 15) { da_attn_phase<PROBE_DUP >= 11 && PROBE_DUP <= 15 ? PROBE_DUP - 10 : 0>(P, lam, 1.0f - lam_init, lds, tid, ctx_q); __syncthreads(); }
    if (PROBE_DUP >= 11 && PROBE_DUP <= 15) da_attn_phase(P, lam, 1.0f - lam_init, lds, tid, ctx_q); }
__device__ NOINL void ph_route(int wv_, LAS unsigned char* lds_, int L_, int M_) { CP P = GETP(); LAS unsigned char* lds = uni_lds(lds_); const int L = uni(L_), Mrows = uni(M_); PH_IDS
#pragma unroll 1
    for (int rep = 0; rep < (PROBE_DUP == 4 ? 2 : 1); ++rep) route_phase(P, L, Mrows, lds, tid, lane, wid, gw, NGW); }
__device__ NOINL void ph_gather(int wv_, LAS unsigned char* lds_, int L_, int M_) { CP P = GETP(); LAS unsigned char* lds = uni_lds(lds_); const int L = uni(L_), Mrows = uni(M_); PH_IDS
    if (PROBE_DUP == 3) { gather_phase<0>(P, L, Mrows, lds, wid, lane, gw, NGW, true); }
    if (PROBE_DUP == 7) { gather_phase<1>(P, L, Mrows, lds, wid, lane, gw, NGW, true); }
    if (PROBE_DUP == 17) { gather_phase<3>(P, L, Mrows, lds, wid, lane, gw, NGW, true); }
    if (PROBE_DUP == 8) { gather_phase<2>(P, L, Mrows, lds, wid, lane, gw, NGW, true); }
    gather_phase<0>(P, L, Mrows, lds, wid, lane, gw, NGW); }

enum GemmId { G_GM_IN = 0, G_GM_OUT, G_MLA_IN, G_MLA_UQ, G_MLA_UKV, G_MLA_OUT, G_DA_IN, G_DA_OUT, G_PEER_Q };
__device__ NOINL void ph_gemm(int wv_, LAS unsigned char* lds_, int id_, int L_, int M_) {
    CP P = GETP(); LAS unsigned char* lds = uni_lds(lds_); const int id = uni(id_), L = uni(L_), Mrows = uni(M_); PH_IDS
    unsigned char* ws = P->ws; const int jj = L / 3;
    size_t a = WS_H, b = 0, o = 0; int M = MT, N = 2048, K = 2048, act = 0, rope = 0;
    switch (id) {
        case G_GM_IN:   a = WS_H;    b = WS_GMWIN + (size_t)jj * 4096 * 2048 * 2;  o = WS_Z;  M = Mrows; N = 4096; K = 2048; act = 1; break;
        case G_GM_OUT:  a = WS_G;    b = WS_GMWOUT + (size_t)jj * 2048 * 2048 * 2; o = WS_Y;  M = Mrows; N = 2048; K = 2048; break;
        case G_MLA_IN:  a = WS_H;    b = WS_MLAIN;  o = WS_C;  N = 1280; K = 2048; break;
        case G_MLA_UQ:  a = WS_CQN;  b = WS_MLAUQ;  o = WS_QM; N = 3072; K = 512;  rope = (ROPE_TEST == 2) ? 0 : 2; break;
        case G_MLA_UKV: a = WS_CKVN; b = WS_MLAUKV; o = WS_KV; N = 4096; K = 512;  break;
        case G_MLA_OUT: a = WS_G;    b = WS_MLAOUT; o = WS_Y;  N = 2048; K = 2048; break;
        case G_DA_IN:   a = WS_H;    b = WS_DAIN;   o = WS_Z;  N = 6144; K = 2048; rope = (ROPE_TEST == 1) ? 0 : 1; break;
        case G_DA_OUT:  a = WS_G;    b = WS_DAOUT;  o = WS_Y;  M = Mrows; N = 2048; K = 2048; break;
        default:        a = WS_H;    b = WS_PWQ + (size_t)L * 2048 * 2048 * 2;     o = WS_QP; M = Mrows; N = 2048; K = 2048; break;
    }
    pg8::Gemm g{(const pg8::bf16_t*)(ws + a), (const pg8::bf16_t*)(ws + b), M, N, K}; pg8::StaticOrder S; S.init(M, N, (int)gridDim.x, id == G_MLA_UKV ? (int)gridDim.x - 1 - (int)blockIdx.x : (int)blockIdx.x);
    pg8::EpiR E{(pg8::bf16_t*)(ws + o), N, act, rope, (const float*)(ws + WS_ROPE)};
#pragma unroll 1
    for (int rep = 0; rep < ((PROBE_DUP == 1 || (PROBE_DUP == 31 && id == G_MLA_OUT) || (PROBE_DUP == 32 && id == G_DA_OUT)) ? 2 : 1); ++rep) { pg8::gemm_phase<pg8::EpiR, pg8::StaticOrder, true, true>((PG8_LAS unsigned char*)lds, g, S, E, tid); __syncthreads(); }
#if TAIL_REMAP
    int TL = -1; bool tail_u = false;
    if (L == 0) { if (id == G_GM_IN) { TL = 0; tail_u = true; } else if (id == G_GM_OUT) { TL = 0; } else if (id == G_PEER_Q) { TL = 1; tail_u = true; } }
    else if (L == 1) { if (id == G_MLA_IN) { TL = 1; } else if (id == G_MLA_OUT) { TL = 2; tail_u = true; } else if (id == G_PEER_Q) { TL = 2; } }
    else if (L == 2) { if (id == G_DA_IN) { TL = 3; tail_u = true; } else if (id == G_DA_OUT) { TL = 3; } }
    if (TL >= 0) {
        const int units = (M / 256) * (N / 256), G = (int)gridDim.x, tail = units % G, c = (int)blockIdx.x;
        const float* src = (tail_u ? P->in[11] : P->in[12]) + (size_t)TL * 16384 * 2048; unsigned char* dst = ws + WS_PU + (size_t)TL * 16384 * PREC;
#else
#if TAIL_L3MOVE
    const bool l3u = (id == G_MLA_IN && L == 1), l3v = (id == G_DA_IN && L == 2), skip = (L == NLAYER - 2) && (id == G_DA_OUT || id == G_PEER_Q);
    const bool l0v = P0_NOV && (id == G_GM_IN && L == 0);
    const bool tail_u = !skip && ((id == G_GM_OUT || id == G_MLA_OUT || id == G_DA_OUT) || l3u), tail_v = !skip && ((id == G_PEER_Q) || l3v || l0v);
    const int TLx = (l3u || l3v) ? NLAYER - 1 : (l0v ? 0 : L + 1);
    if ((tail_u || tail_v) && TLx < NLAYER) {
        const int units = (M / 256) * (N / 256), G = (int)gridDim.x, tail = units % G, c = (int)blockIdx.x;
        const float* src = (tail_u ? P->in[11] : P->in[12]) + (size_t)TLx * 16384 * 2048; unsigned char* dst = ws + WS_PU + (size_t)TLx * 16384 * PREC;
#else
    const bool tail_u = (id == G_GM_OUT || id == G_MLA_OUT || id == G_DA_OUT), tail_v = (id == G_PEER_Q);
    if ((tail_u || tail_v) && L + 1 < NLAYER) {
        const int units = (M / 256) * (N / 256), G = (int)gridDim.x, tail = units % G, c = (int)blockIdx.x;
        const float* src = (tail_u ? P->in[11] : P->in[12]) + (size_t)(L + 1) * 16384 * 2048; unsigned char* dst = ws + WS_PU + (size_t)(L + 1) * 16384 * PREC;
#endif
#endif
        LAS float* scr = (LAS float*)(lds + wid * 16384);
        if (tail != 0 && c >= tail) cvt_table_fp6(src, dst, 16384, tail_u ? U_SCALE : V_SCALE, scr, lane, (c - tail) * NWAVES + wid, (G - tail) * NWAVES, tail_u ? 0 : 1);
        else if (tail == 0) {
#pragma unroll 1
            for (int rep = 0; rep < (PROBE_DUP == 18 ? 3 : 1); ++rep) cvt_table_fp6(src, dst, 16384, tail_u ? U_SCALE : V_SCALE, scr, lane, gw, NGW, tail_u ? 0 : 1); }
    }
}

__global__ void __launch_bounds__(NWAVES * 64, 2) mk_fwd(Params Pv) {
    extern __shared__ __attribute__((aligned(16))) unsigned char lds_g[];
    LAS unsigned char* lds = (LAS unsigned char*)lds_g;
    const int wv = __builtin_amdgcn_readfirstlane((int)threadIdx.x >> 6);
    const int tid = wv * 64 + lane_id_fresh();
    for (int u = tid; u < (LDS_BYTES - RING_BYTES) / 4; u += NWAVES * 64) ((LAS unsigned*)(lds + RING_BYTES))[u] = 0u;
    __syncthreads();
    const int lo = Pv.ph_lo, hi = Pv.ph_hi;
    unsigned* barw = (unsigned*)(Pv.ws + WS_CTL) + CW_BAR;
    XcdBarrier bar; bar.bar = barw; bar.x = 0; bar.st = nullptr;
    if (hi - lo > 1) bar = xcd_barrier_post(barw, (volatile LAS unsigned*)(lds + MISC_OFF) + 8, tid == 0);
    int ph = 0;
#ifndef SEL
#define SELP(k) true
#else
#define SELP(k) ((k) == SEL)
#endif
    enum { RUN_BASE = __COUNTER__ + 1 };
#define RUN(call) do { if (SELP(__COUNTER__ - RUN_BASE) && ph >= lo && ph < hi) { call; } if (ph >= lo && ph + 1 < hi) { xcd_barrier(bar, wv == 0 && lane_id_fresh() == 0); if (PROBE_DUP == 30) { xcd_barrier(bar, wv == 0 && lane_id_fresh() == 0); xcd_barrier(bar, wv == 0 && lane_id_fresh() == 0); } } ++ph; } while (0)
    RUN(ph_prologue(wv, lds));
    RUN(ph_modreduce(wv));
    RUN(ph_first(wv, lds));
#define LAYER(LL) do { constexpr int L = (LL); constexpr int kind = L % 3, jj = L / 3; constexpr int Mrows = (L == NLAYER - 1) ? ML : MT; \
        constexpr bool ctx_dead = (L == NLAYER - 2) && ((NLAYER - 1) % 3 == 0) && (kind != 0); constexpr int Mlive = ctx_dead ? ML : Mrows; \
        if (kind == 0) {                          \
            RUN(ph_gemm(wv, lds, G_GM_IN, L, Mrows)); \
            RUN(ph_vstats(wv, Mrows)); \
            RUN(ph_spatial(wv, lds, jj, Mrows)); \
            RUN(ph_gemm(wv, lds, G_GM_OUT, L, Mrows)); \
        } else if (kind == 1) {                   \
            RUN(ph_gemm(wv, lds, G_MLA_IN, L, Mrows)); \
            RUN(ph_mla_norm(wv)); \
            RUN(ph_gemm(wv, lds, G_MLA_UQ, L, Mrows); ph_gemm(wv, lds, G_MLA_UKV, L, Mrows)); \
            if (ROPE_TEST == 2) { RUN(ph_rope(wv, 0)); } \
            RUN(ph_attn_mla(wv, lds)); \
            RUN(ph_gemm(wv, lds, G_MLA_OUT, L, Mrows)); \
        } else {                                  \
            RUN(ph_gemm(wv, lds, G_DA_IN, L, Mrows); if (ROPE_TEST == 1) { __syncthreads(); } ); \
            if (ROPE_TEST == 1) { RUN(ph_rope(wv, 1)); } \
            RUN(ph_attn_da(wv, lds, L, !ctx_dead)); \
            RUN(ph_gemm(wv, lds, G_DA_OUT, L, Mlive)); \
        } \
        RUN(ph_postmix(wv, lds, L, Mlive));                \
        RUN(ph_gemm(wv, lds, G_PEER_Q, L, Mlive));    \
        RUN(ph_route(wv, lds, L, Mlive));             \
        RUN(ph_gather(wv, lds, L, Mlive));            \
    } while (0)
    LAYER(0); LAYER(1); LAYER(2); LAYER(3);
#undef LAYER
#undef RUN
}

extern "C" void kernel_launch(void* const* d_in, const int* in_sizes, int n_in, void* d_out, int out_size, void* d_ws, size_t ws_size, hipStream_t stream) {
    static int grid = 0;
    if (grid == 0) {
        if (n_in != 29 || in_sizes[0] != ML * DM || out_size != ML * DM || ws_size < WS_END) {
            fprintf(stderr, "kernel_launch: shape mismatch: n_in %d in0 %d out %d ws %zu (need %zu); nothing launched\n", n_in, n_in > 0 ? in_sizes[0] : -1, out_size, ws_size, (size_t)WS_END); grid = -1; return; }
        int dev = 0, cus = 0, per_cu = 0;
        if (hipGetDevice(&dev) != hipSuccess || hipDeviceGetAttribute(&cus, hipDeviceAttributeMultiprocessorCount, dev) != hipSuccess) { fprintf(stderr, "kernel_launch: device query failed\n"); grid = -1; return; }
        if (hipFuncSetAttribute((const void*)mk_fwd, hipFuncAttributeMaxDynamicSharedMemorySize, LDS_BYTES) != hipSuccess) { fprintf(stderr, "kernel_launch: hipFuncSetAttribute failed\n"); grid = -1; return; }
        if (hipOccupancyMaxActiveBlocksPerMultiprocessor(&per_cu, (const void*)mk_fwd, NWAVES * 64, LDS_BYTES) != hipSuccess || per_cu < 1)
            fprintf(stderr, "kernel_launch: note: occupancy query reports %d workgroups per CU\n", per_cu);
        (void)hipGetLastError();
        grid = cus;
    }
    if (grid < 0) return;
    if (hipMemsetAsync((char*)d_ws + WS_CTL, 0, CTL_ZERO_BYTES, stream) != hipSuccess) { fprintf(stderr, "kernel_launch: memset failed\n"); return; }
    Params p{};
    for (int i = 0; i < 29; ++i) p.in[i] = (const float*)d_in[i];
    p.out = (float*)d_out; p.ws = (unsigned char*)d_ws;
#if MK_ONE_LAUNCH
    p.ph_lo = 0; p.ph_hi = NPH;
    hipLaunchKernelGGL(mk_fwd, dim3(grid), dim3(NWAVES * 64), LDS_BYTES, stream, p);
#else
    for (int li = 0; li < NPH; ++li) { p.ph_lo = li; p.ph_hi = li + 1; hipLaunchKernelGGL(mk_fwd, dim3(grid), dim3(NWAVES * 64), LDS_BYTES, stream, p); }
#endif
    const hipError_t le = hipPeekAtLastError();
    if (le != hipSuccess) fprintf(stderr, "kernel_launch: launch failed: %s\n", hipGetErrorName(le));
}
```

```cpp
#include <hip/hip_runtime.h>
#include <cstdio>
#include <cstdint>
#ifndef MK_ONE_LAUNCH
#define MK_ONE_LAUNCH 1
#endif
__device__ __forceinline__ int launder_v(int v) { asm volatile("" : "+v"(v)); return v; }
__device__ __forceinline__ int lane_id_fresh() { unsigned m = ~0u; asm volatile("" : "+s"(m)); return (int)__builtin_amdgcn_mbcnt_hi(m, __builtin_amdgcn_mbcnt_lo(m, 0u)); }
#ifndef WT_STORES
#define WT_STORES 0
#endif
typedef unsigned wt_u32x4 __attribute__((ext_vector_type(4)));
__device__ __forceinline__ void st16_wt(void* p, wt_u32x4 v) {
#if WT_STORES
    asm volatile("global_store_dwordx4 %0, %1, off sc1\n\ts_nop 1" :: "v"(p), "v"(v) : "memory");
#else
    *(wt_u32x4*)p = v;
#endif
}
namespace pg8 {
#define PG8_LAS __attribute__((address_space(3)))
typedef unsigned short bf16_t;
typedef short bf16x8 __attribute__((ext_vector_type(8)));
typedef float f32x4 __attribute__((ext_vector_type(4)));
typedef unsigned u32x4 __attribute__((ext_vector_type(4)));
constexpr int BM = 256, BK = 64, HALF = 128, HTB = HALF * BK * 2  , STAGE_BYTES = 8 * HTB, NXCD = 8, WGM = 8;

__host__ __device__ __forceinline__ int lds_byte(int r, int c) { const int st = (r >> 4) * 2 + (c >> 5), rr = r & 15, cc = c & 31, ob = rr * 64 + cc * 2; return st * 1024 + (ob ^ (((ob >> 9) & 1) << 5)); }
__host__ __device__ __forceinline__ void stage_rc(int b, int& R, int& C) { const int st = b / 1024, sb = b % 1024, swz = sb ^ (((sb >> 9) & 1) << 5); R = (st >> 1) * 16 + swz / 64; C = (st & 1) * 32 + (swz % 64) / 2; }
__host__ __device__ __forceinline__ int perm32(int rho) { const int n = rho >> 4, i = rho & 15; return 8 * (i >> 2) + 4 * n + (i & 3); }

struct Unit { int pm, pn; };
struct Gemm { const bf16_t* A; const bf16_t* Bt; int M, N, K; };

struct StaticOrder {
    int nM, nN, nwg, G, c;
    __host__ __device__ void init(int M, int N, int G_, int c_) { nM = M / BM; nN = N / BM; nwg = nM * nN; G = G_; c = c_; }
    __host__ __device__ bool next(int i, Unit& u) const {
        const long L = (long)i * G + c; if (L >= nwg) return false;
        int wgid = (int)L; { const int q = nwg / NXCD, r = nwg % NXCD, xcd = wgid % NXCD, off = wgid / NXCD; wgid = (xcd < r ? xcd * (q + 1) : r * (q + 1) + (xcd - r) * q) + off; }
        const int nig = WGM * nN, gid = wgid / nig, fm = gid * WGM, gsz = (nM - fm) < WGM ? (nM - fm) : WGM;
        u.pm = fm + ((wgid % nig) % gsz); u.pn = (wgid % nig) / gsz; return true;
    }
    __device__ __forceinline__ void a_ready(const Unit&) const {}
    __device__ __forceinline__ void done(const Unit&) const {}
};

__device__ __forceinline__ unsigned cvt_pk_bf16(float lo, float hi) { unsigned r; asm volatile("v_cvt_pk_bf16_f32 %0, %1, %2" : "=v"(r) : "v"(lo), "v"(hi)); return r; }
typedef float f32x2 __attribute__((ext_vector_type(2)));
__device__ __forceinline__ f32x2 gelu_pk(f32x2 v) {
    const f32x2 av = __builtin_elementwise_abs(v), d = av * 0.2316418882f + 1.0f;
    f32x2 t; t.x = __builtin_amdgcn_rcpf(d.x); t.y = __builtin_amdgcn_rcpf(d.y);
    f32x2 q = t * 0.5307027145f + (-0.7265760135f); q = q * t + 0.7107068705f; q = q * t + (-0.142248368f); q = q * t + 0.127414796f; q = q * t;
    const f32x2 s = (v * v) * (-0.72134752044f);
    f32x2 e; e.x = __builtin_amdgcn_exp2f(s.x); e.y = __builtin_amdgcn_exp2f(s.y);
    const f32x2 m = v * (q * e), r = v - m;
    f32x2 o; o.x = v.x < 0.f ? m.x : r.x; o.y = v.y < 0.f ? m.y : r.y; return o;
}

template <int ACT  > struct EpiBf16 {
    static constexpr bool PERM = true, AFTER_DRAIN = false; static_assert(ACT == 0 || ACT == 1, "EpiBf16: ACT is 0 (none) or 1 (gelu_pk)");
    bf16_t* O; int ldc; const float* bias; int split_cols; size_t split_stride; float scale0;
    __device__ __forceinline__ void operator()(const f32x4 (&acc)[2][2][4][2], const Unit& u, int wr, int wc, int fr, int fq) const {
        const int row0 = u.pm * BM + wr * 64 + fr; int colt = u.pn * BM; bf16_t* base = O;
        float sc = 1.f; if (split_cols) { const int t = colt / split_cols; base += (size_t)t * split_stride; colt -= t * split_cols; if (t == 0) sc = scale0; }
        const int col0 = colt + wc * 32 + 8 * fq, bcol0 = u.pn * BM + wc * 32 + 8 * fq;
        f32x4 bv[2][2];
#pragma unroll
        for (int bj = 0; bj < 2; ++bj)
#pragma unroll
            for (int n = 0; n < 2; ++n) bv[bj][n] = bias ? *(const f32x4*)(bias + bcol0 + bj * HALF + 4 * n) : (f32x4){0.f, 0.f, 0.f, 0.f};
#pragma unroll
        for (int ai = 0; ai < 2; ++ai)
#pragma unroll
            for (int m = 0; m < 4; ++m) { bf16_t* rowp = base + (size_t)(row0 + ai * HALF + m * 16) * ldc + col0;
#pragma unroll
                for (int bj = 0; bj < 2; ++bj) { f32x4 v0 = acc[ai][bj][m][0] + bv[bj][0], v1 = acc[ai][bj][m][1] + bv[bj][1];
                    if (ACT == 1) { f32x2 a = gelu_pk((f32x2){v0[0], v0[1]}), b = gelu_pk((f32x2){v0[2], v0[3]}), c = gelu_pk((f32x2){v1[0], v1[1]}), d = gelu_pk((f32x2){v1[2], v1[3]});
                        v0 = (f32x4){a.x, a.y, b.x, b.y}; v1 = (f32x4){c.x, c.y, d.x, d.y}; }
                    v0 = v0 * sc; v1 = v1 * sc; u32x4 w; w.x = cvt_pk_bf16(v0[0], v0[1]); w.y = cvt_pk_bf16(v0[2], v0[3]); w.z = cvt_pk_bf16(v1[0], v1[1]); w.w = cvt_pk_bf16(v1[2], v1[3]);
                    *(u32x4*)(rowp + bj * HALF) = w; } }
    }
};
template <class Epi, class Sched, bool ALIGN_EPI = false, bool SP2 = false>
__device__ __forceinline__ void gemm_phase(PG8_LAS unsigned char* lds, const Gemm g, const Sched& S, const Epi& E, const int tid_in) {
    const int tid = launder_v(tid_in) & 511, wid = __builtin_amdgcn_readfirstlane(tid >> 6), lane = tid & 63, wr = wid >> 2, wc = wid & 3, fr = lane & 15, fq = lane >> 4;
    const int K = g.K, nt = K / BK;
    unsigned voffA[2], voffB[2];
#pragma unroll
    for (int i = 0; i < 2; ++i) { int R, C; stage_rc(tid * 16 + i * 8192, R, C); const int Rb = Epi::PERM ? ((R & ~31) + perm32(R & 31)) : R;
        voffA[i] = (unsigned)(R * K + C) * 2u; voffB[i] = (unsigned)(Rb * K + C) * 2u; }
    const size_t kstep = (size_t)(BK * 2);
    const size_t hstep = (size_t)HALF * K * 2;
    const size_t tstep = 2 * hstep;
    const unsigned ldsw = (unsigned)wid * 1024u;
    const int aoff = lds_byte(wr * 64 + fr, fq * 8), boff = lds_byte(wc * 32 + fr, fq * 8);
#define PG8_SA(b, h) (((b) * 2 + (h)) * HTB)
#define PG8_SB(b, h) ((4 + (b) * 2 + (h)) * HTB)
#define PG8_STAGE(bufoff, gbase, voff) do { _Pragma("unroll") for (int _i = 0; _i < 2; ++_i) \
        __builtin_amdgcn_global_load_lds((const unsigned*)((const char*)(gbase) + (voff)[_i]), (PG8_LAS unsigned*)(lds + (bufoff) + ldsw + _i * 8192), 16, 0, 0); } while (0)
#define PG8_LDA(dst, b, h) do { _Pragma("unroll") for (int m = 0; m < 4; ++m) _Pragma("unroll") for (int k = 0; k < 2; ++k) dst[m][k] = *(const PG8_LAS bf16x8*)(lds + PG8_SA(b, h) + aoff + m * 2048 + k * 1024); } while (0)
#define PG8_LDB(dst, b, h) do { _Pragma("unroll") for (int n = 0; n < 2; ++n) _Pragma("unroll") for (int k = 0; k < 2; ++k) dst[n][k] = *(const PG8_LAS bf16x8*)(lds + PG8_SB(b, h) + boff + n * 2048 + k * 1024); } while (0)
#define PG8_MMA(ai, bj, At, Bt) do { __builtin_amdgcn_s_setprio(1); _Pragma("unroll") for (int m = 0; m < 4; ++m) _Pragma("unroll") for (int n = 0; n < 2; ++n) _Pragma("unroll") for (int k = 0; k < 2; ++k) \
        acc[ai][bj][m][n] = __builtin_amdgcn_mfma_f32_16x16x32_bf16(Bt[n][k], At[m][k], acc[ai][bj][m][n], 0, 0, 0); __builtin_amdgcn_s_setprio(0); } while (0)
#define PG8_WAIT_V(n) asm volatile("s_waitcnt vmcnt(" #n ")" ::: "memory")
#define PG8_WAIT_L(n) asm volatile("s_waitcnt lgkmcnt(" #n ")" ::: "memory")
#define PG8_BAR __builtin_amdgcn_s_barrier()
#define PG8_SCHED __builtin_amdgcn_sched_barrier(0)
    Unit cur, nxt; int ui = 0;
    if (!S.next(0, cur)) return;
    f32x4 acc[2][2][4][2];
#pragma unroll
    for (int a = 0; a < 2; ++a)
#pragma unroll
        for (int b = 0; b < 2; ++b)
#pragma unroll
            for (int m = 0; m < 4; ++m)
#pragma unroll
                for (int n = 0; n < 2; ++n) acc[a][b][m][n] = (f32x4){0.f, 0.f, 0.f, 0.f};
    bf16x8 At[4][2], B0[2][2], B1[2][2];
    const char* cA = (const char*)g.A + (size_t)cur.pm * tstep; const char* cB = (const char*)g.Bt + (size_t)cur.pn * tstep;
    S.a_ready(cur);
    if constexpr (SP2) {
        PG8_STAGE(PG8_SB(0, 0), cB, voffB); PG8_STAGE(PG8_SB(0, 1), cB + hstep, voffB); PG8_STAGE(PG8_SA(0, 0), cA, voffA); PG8_STAGE(PG8_SA(0, 1), cA + hstep, voffA);
        if (wr == 1) PG8_BAR;
        PG8_WAIT_V(2); PG8_BAR;
        PG8_STAGE(PG8_SB(1, 0), cB + kstep, voffB); PG8_STAGE(PG8_SA(1, 0), cA + kstep, voffA); PG8_STAGE(PG8_SB(1, 1), cB + hstep + kstep, voffB);
        PG8_WAIT_V(6); PG8_BAR;
    } else {
        PG8_STAGE(PG8_SB(0, 0), cB, voffB); PG8_STAGE(PG8_SA(0, 0), cA, voffA); PG8_STAGE(PG8_SB(0, 1), cB + hstep, voffB); PG8_STAGE(PG8_SA(0, 1), cA + hstep, voffA);
        if (wr == 1) PG8_BAR;
        PG8_WAIT_V(4); PG8_BAR;
        PG8_STAGE(PG8_SB(1, 0), cB + kstep, voffB); PG8_STAGE(PG8_SA(1, 0), cA + kstep, voffA); PG8_STAGE(PG8_SB(1, 1), cB + hstep + kstep, voffB);
        PG8_WAIT_V(6); PG8_BAR;
    }
    for (;;) {
        const bool has_next = S.next(ui + 1, nxt);
        const char* nA = has_next ? (const char*)g.A + (size_t)nxt.pm * tstep : cA; const char* nB = has_next ? (const char*)g.Bt + (size_t)nxt.pn * tstep : cB;
        for (int t = 0; t < nt; t += 2) {
            const bool last = (t == nt - 2);
            const char* a1 = cA + (size_t)(t + 1) * kstep;
            const char* a2 = last ? nA : cA + (size_t)(t + 2) * kstep; const char* b2 = last ? nB : cB + (size_t)(t + 2) * kstep;
            const char* a3 = a2 + kstep; const char* b3 = b2 + kstep;
            if (last && has_next) S.a_ready(nxt);
            if constexpr (SP2) {
            PG8_LDB(B0, 0, 0); PG8_LDB(B1, 0, 1); PG8_SCHED; PG8_LDA(At, 0, 0); PG8_STAGE(PG8_SA(1, 1), a1 + hstep, voffA);
            PG8_WAIT_V(8); PG8_WAIT_L(0); PG8_BAR; PG8_MMA(0, 0, At, B0); PG8_MMA(0, 1, At, B1); PG8_BAR; PG8_SCHED;
            PG8_LDA(At, 0, 1); PG8_STAGE(PG8_SB(0, 0), b2, voffB); PG8_STAGE(PG8_SB(0, 1), b2 + hstep, voffB); PG8_STAGE(PG8_SA(0, 0), a2, voffA);
            PG8_WAIT_V(8); PG8_WAIT_L(0); PG8_BAR; PG8_MMA(1, 0, At, B0); PG8_MMA(1, 1, At, B1); PG8_BAR; PG8_SCHED;
            PG8_LDB(B0, 1, 0); PG8_LDB(B1, 1, 1); PG8_SCHED; PG8_LDA(At, 1, 0); PG8_STAGE(PG8_SA(0, 1), a2 + hstep, voffA);
            PG8_WAIT_V(8); PG8_WAIT_L(0); PG8_BAR; PG8_MMA(0, 0, At, B0); PG8_MMA(0, 1, At, B1); PG8_BAR; PG8_SCHED;
            PG8_LDA(At, 1, 1); PG8_STAGE(PG8_SB(1, 0), b3, voffB); PG8_STAGE(PG8_SB(1, 1), b3 + hstep, voffB); PG8_STAGE(PG8_SA(1, 0), a3, voffA);
            PG8_WAIT_V(8); PG8_WAIT_L(0); PG8_BAR; PG8_MMA(1, 0, At, B0); PG8_MMA(1, 1, At, B1); PG8_BAR; PG8_SCHED;
            } else {
            PG8_LDB(B0, 0, 0); PG8_SCHED; PG8_LDA(At, 0, 0); PG8_STAGE(PG8_SA(1, 1), a1 + hstep, voffA);
            PG8_WAIT_L(8); PG8_BAR; PG8_WAIT_L(0); PG8_MMA(0, 0, At, B0); PG8_BAR; PG8_SCHED;
            PG8_LDB(B1, 0, 1); PG8_STAGE(PG8_SB(0, 0), b2, voffB);
            PG8_BAR; PG8_WAIT_L(0); PG8_MMA(0, 1, At, B1); PG8_BAR;
            PG8_LDA(At, 0, 1); PG8_STAGE(PG8_SA(0, 0), a2, voffA);
            PG8_BAR; PG8_WAIT_L(0); PG8_MMA(1, 0, At, B0); PG8_BAR; PG8_SCHED;
            PG8_STAGE(PG8_SB(0, 1), b2 + hstep, voffB);
            PG8_WAIT_V(6); PG8_BAR; PG8_MMA(1, 1, At, B1); PG8_BAR;
            PG8_LDB(B0, 1, 0); PG8_SCHED; PG8_LDA(At, 1, 0); PG8_STAGE(PG8_SA(0, 1), a2 + hstep, voffA);
            PG8_WAIT_L(8); PG8_BAR; PG8_WAIT_L(0); PG8_MMA(0, 0, At, B0); PG8_BAR; PG8_SCHED;
            PG8_LDB(B1, 1, 1); PG8_STAGE(PG8_SB(1, 0), b3, voffB);
            PG8_BAR; PG8_WAIT_L(0); PG8_MMA(0, 1, At, B1); PG8_BAR;
            PG8_LDA(At, 1, 1); PG8_STAGE(PG8_SA(1, 0), a3, voffA);
            PG8_BAR; PG8_WAIT_L(0); PG8_MMA(1, 0, At, B0); PG8_BAR; PG8_SCHED;
            PG8_STAGE(PG8_SB(1, 1), b3 + hstep, voffB);
            PG8_WAIT_V(6); PG8_BAR; PG8_MMA(1, 1, At, B1); PG8_BAR;
            }
        }
        if constexpr (ALIGN_EPI) { if (wr == 0) PG8_BAR; }
        if constexpr (!Epi::AFTER_DRAIN) { E(acc, cur, wr, wc, fr, fq); S.done(cur); }
        if (!has_next) break;
#pragma unroll
        for (int a = 0; a < 2; ++a)
#pragma unroll
            for (int b = 0; b < 2; ++b)
#pragma unroll
                for (int m = 0; m < 4; ++m)
#pragma unroll
                    for (int n = 0; n < 2; ++n) acc[a][b][m][n] = (f32x4){0.f, 0.f, 0.f, 0.f};
        cur = nxt; cA = nA; cB = nB; ++ui;
        if constexpr (ALIGN_EPI) { if (wr == 1) PG8_BAR; }
    }
    PG8_WAIT_V(0);
    if constexpr (!ALIGN_EPI) { if (wr == 0) PG8_BAR; }
    PG8_BAR;
    if constexpr (Epi::AFTER_DRAIN) { E.fused(acc, cur, wr, wc, fr, fq, lds, wid, lane); S.done(cur); }
#undef PG8_SA
#undef PG8_SB
#undef PG8_STAGE
#undef PG8_LDA
#undef PG8_LDB
#undef PG8_MMA
#undef PG8_WAIT_V
#undef PG8_WAIT_L
#undef PG8_BAR
#undef PG8_SCHED
}
}

namespace pg8 {
__device__ __forceinline__ float gelu_tanh(float x) {
    const float t = x * (1.5957691216057308f + 0.07135481627f * x * x);
    const float e = __builtin_amdgcn_exp2f(-1.4426950408889634f * t);
    return x * __builtin_amdgcn_rcpf(1.0f + e);
}
template <int ACT> struct EpiT {
    static constexpr bool PERM = true, AFTER_DRAIN = false;
    bf16_t* O; int ldc;
    __device__ __forceinline__ void operator()(const f32x4 (&acc)[2][2][4][2], const Unit& u, int wr, int wc, int fr, int fq) const {
        const int row0 = u.pm * BM + wr * 64 + fr; const int col0 = u.pn * BM + wc * 32 + 8 * fq;
#pragma unroll
        for (int ai = 0; ai < 2; ++ai)
#pragma unroll
            for (int m = 0; m < 4; ++m) { bf16_t* rowp = O + (size_t)(row0 + ai * HALF + m * 16) * ldc + col0;
#pragma unroll
                for (int bj = 0; bj < 2; ++bj) { f32x4 v0 = acc[ai][bj][m][0], v1 = acc[ai][bj][m][1];
                    if (ACT == 2) { v0 = (f32x4){gelu_tanh(v0[0]), gelu_tanh(v0[1]), gelu_tanh(v0[2]), gelu_tanh(v0[3])}; v1 = (f32x4){gelu_tanh(v1[0]), gelu_tanh(v1[1]), gelu_tanh(v1[2]), gelu_tanh(v1[3])}; }
                    u32x4 w; w.x = cvt_pk_bf16(v0[0], v0[1]); w.y = cvt_pk_bf16(v0[2], v0[3]); w.z = cvt_pk_bf16(v1[0], v1[1]); w.w = cvt_pk_bf16(v1[2], v1[3]);
                    ::st16_wt(rowp + bj * HALF, w); } }
    }
};
struct EpiR {
    static constexpr bool PERM = true, AFTER_DRAIN = false;
    bf16_t* O; int ldc; int act; int rope; const float* ropet;
    __device__ __forceinline__ void operator()(const f32x4 (&acc)[2][2][4][2], const Unit& u, int wr, int wc, int fr, int fq) const {
        const int row0 = u.pm * BM + wr * 64 + fr; const int col0 = u.pn * BM + wc * 32 + 8 * fq;
        const bool rrows = rope != 0 && u.pm < 64;
#pragma unroll
        for (int ai = 0; ai < 2; ++ai)
#pragma unroll
            for (int m = 0; m < 4; ++m) { const int grow = row0 + ai * HALF + m * 16; bf16_t* rowp = O + (size_t)grow * ldc + col0;
#pragma unroll
                for (int bj = 0; bj < 2; ++bj) { f32x4 v0 = acc[ai][bj][m][0], v1 = acc[ai][bj][m][1];
                    if (act) { v0 = (f32x4){gelu_tanh(v0[0]), gelu_tanh(v0[1]), gelu_tanh(v0[2]), gelu_tanh(v0[3])}; v1 = (f32x4){gelu_tanh(v1[0]), gelu_tanh(v1[1]), gelu_tanh(v1[2]), gelu_tanh(v1[3])}; }
                    if (rrows) { const int blk = u.pn * 8 + bj * 4 + wc; const int b6 = blk % 6; const bool on = rope == 1 ? (blk < 128) : (b6 >= 4); const int half = rope == 1 ? (blk & 1) : (b6 - 4);
                        if (on) { const int t = grow & 8191; const int pos = half ? (t & 63) : (t >> 6);
                            const float* cp = ropet + pos * 16 + 8 * (fq & 1); const f32x4 c0 = *(const f32x4*)cp, c1 = *(const f32x4*)(cp + 4), s0 = *(const f32x4*)(cp + 2048), s1 = *(const f32x4*)(cp + 2052);
                            f32x4 p0, p1;
#pragma unroll
                            for (int i = 0; i < 4; ++i) { const float a_ = v0[i], b_ = v1[i];
                                const auto r0 = __builtin_amdgcn_permlane32_swap(__float_as_uint(a_), __float_as_uint(a_), false, false);
                                const auto r1 = __builtin_amdgcn_permlane32_swap(__float_as_uint(b_), __float_as_uint(b_), false, false);
                                const unsigned x0_ = (fq & 2) ? r0[0] : r0[1], x1_ = (fq & 2) ? r1[0] : r1[1]; p0[i] = __uint_as_float(x0_); p1[i] = __uint_as_float(x1_); }
                            if (fq & 2) { v0 = p0 * s0 + v0 * c0; v1 = p1 * s1 + v1 * c1; } else { v0 = v0 * c0 - p0 * s0; v1 = v1 * c1 - p1 * s1; } } }
                    u32x4 w; w.x = cvt_pk_bf16(v0[0], v0[1]); w.y = cvt_pk_bf16(v0[2], v0[3]); w.z = cvt_pk_bf16(v1[0], v1[1]); w.w = cvt_pk_bf16(v1[2], v1[3]);
                    ::st16_wt(rowp + bj * HALF, w); } }
    }
};
}

constexpr int DM = 2048, NBATCH = 2, SEQ = 8192, CTXL = 256;
constexpr int ML = NBATCH * SEQ;
constexpr int MC = NBATCH * CTXL;
constexpr int MT = ML + MC;
constexpr int NLAYER = 4;
constexpr float ALPHA = 1.6817928305074290f, LN_EPS = 1e-6f;
constexpr int NWAVES = 8;
constexpr float U_SCALE = 64.0f, V_SCALE = 4.0f;
constexpr int PROW = 1536;
#ifndef PEER_V4
#define PEER_V4 1
#endif
#ifndef PEER_U4
#define PEER_U4 1
#endif
constexpr int PREC = PEER_U4 ? 2048 : PEER_V4 ? 2560 : 2 * PROW;
constexpr int NPH = 35;

constexpr size_t MiB = 1ull << 20;
constexpr size_t WS_CTL = 0, CTL_ZERO_BYTES = 1 * MiB;
constexpr int    CW_BAR = 4096;
constexpr size_t WS_MOD = 128 * 1024;
constexpr size_t WS_VST = 1 * MiB;
constexpr size_t WS_ROPE = 1 * MiB + 160 * 1024;
constexpr size_t WS_MODP = 1 * MiB + 256 * 1024;
constexpr size_t WS_GMWIN = 6 * MiB;
constexpr size_t WS_GMWOUT = WS_GMWIN + 32 * MiB;
constexpr size_t WS_GMWS = WS_GMWOUT + 16 * MiB;
constexpr size_t WS_PWQ = WS_GMWS + 1 * MiB;
constexpr size_t WS_PK1 = WS_PWQ + 32 * MiB;
constexpr size_t WS_PK2 = WS_PK1 + 512 * 1024;
constexpr size_t WS_MLAIN = WS_PK1 + 1 * MiB;
constexpr size_t WS_MLAUQ = WS_MLAIN + 5 * MiB;
constexpr size_t WS_MLAUKV = WS_MLAUQ + 3 * MiB;
constexpr size_t WS_MLAOUT = WS_MLAUKV + 4 * MiB;
constexpr size_t WS_DAIN = WS_MLAOUT + 8 * MiB;
constexpr size_t WS_DAOUT = WS_DAIN + 24 * MiB;
constexpr size_t WS_PU = WS_DAOUT + 8 * MiB;
constexpr size_t WS_PV = WS_PU + 96 * MiB;
constexpr size_t WS_X = WS_PV + 96 * MiB;
constexpr size_t WS_H = WS_X + 66 * MiB;
constexpr size_t WS_G = WS_H + 66 * MiB;
constexpr size_t WS_Y = WS_G + 66 * MiB;
constexpr size_t WS_QP = WS_Y + 66 * MiB;
constexpr size_t WS_Z = WS_QP + 66 * MiB;
constexpr size_t WS_C = WS_Z + 198 * MiB;
constexpr size_t WS_CQN = WS_C + 42 * MiB;
constexpr size_t WS_CKVN = WS_CQN + 17 * MiB;
constexpr size_t WS_KR = WS_CKVN + 17 * MiB;
constexpr size_t WS_QM = WS_KR + 3 * MiB;
constexpr size_t WS_KV = WS_QM + 99 * MiB;
constexpr size_t WS_ROUTE = WS_KV + 132 * MiB;
constexpr size_t WS_END = WS_ROUTE + 17 * MiB;
static_assert((size_t)MT * DM * 2 == 66 * MiB, "row buffer size");

constexpr int RING_BYTES = 155648, MISC_OFF = RING_BYTES + 320, LDS_BYTES = 159744;

#define GAS __attribute__((address_space(1)))
#define LAS __attribute__((address_space(3)))
typedef unsigned short bf16;
typedef unsigned u32x4 __attribute__((ext_vector_type(4)));
typedef unsigned u32x2 __attribute__((ext_vector_type(2)));
typedef float f32x4 __attribute__((ext_vector_type(4)));
typedef float f32x16 __attribute__((ext_vector_type(16)));
typedef short bf16x8 __attribute__((ext_vector_type(8)));
typedef short s16x4 __attribute__((ext_vector_type(4)));
#define LDS_WAIT() asm volatile("s_waitcnt lgkmcnt(0)" ::: "memory")

__device__ __forceinline__ unsigned cvtpk(float lo, float hi) { unsigned r; asm("v_cvt_pk_bf16_f32 %0, %1, %2" : "=v"(r) : "v"(lo), "v"(hi)); return r; }
__device__ __forceinline__ float bflo(unsigned w) { return __uint_as_float(w << 16); }
__device__ __forceinline__ float bfhi(unsigned w) { return __uint_as_float(w & 0xffff0000u); }
__device__ __forceinline__ float bf1(bf16 b) { return __uint_as_float((unsigned)b << 16); }
__device__ __forceinline__ bf16 tobf1(float f) { return (bf16)(cvtpk(f, 0.f) & 0xffffu); }
#define DPP_F(v, ctrl) __int_as_float(__builtin_amdgcn_mov_dpp(__float_as_int(v), (ctrl), 0xF, 0xF, true))
__device__ __forceinline__ float row_sum16(float v) { v += DPP_F(v, 0xB1); v += DPP_F(v, 0x4E); v += DPP_F(v, 0x141); v += DPP_F(v, 0x140); return v; }
__device__ __forceinline__ float sum_xor16(float v) { const auto r = __builtin_amdgcn_permlane16_swap(__float_as_uint(v), __float_as_uint(v), false, false); return __uint_as_float(r[0]) + __uint_as_float(r[1]); }
__device__ __forceinline__ float sum_xor32(float v) { const auto r = __builtin_amdgcn_permlane32_swap(__float_as_uint(v), __float_as_uint(v), false, false); return __uint_as_float(r[0]) + __uint_as_float(r[1]); }
__device__ __forceinline__ float wave_sum(float v) { return sum_xor32(sum_xor16(row_sum16(v))); }
__device__ __forceinline__ float half_sum32(float v) { return sum_xor16(row_sum16(v)); }
__device__ __forceinline__ float lane_xor16(float v, int lane) { const auto r = __builtin_amdgcn_permlane16_swap(__float_as_uint(v), __float_as_uint(v), false, false); return __uint_as_float((lane & 16) ? r[0] : r[1]); }
__device__ __forceinline__ unsigned lane_xor32(unsigned v, int lane) { const auto r = __builtin_amdgcn_permlane32_swap(v, v, false, false); return (lane & 32) ? r[0] : r[1]; }
__device__ __forceinline__ float gelu_tanh(float x) { return pg8::gelu_tanh(x); }

__device__ __forceinline__ void load_row_bf16(const bf16* row, int lane, float (&v)[32]) {
#pragma unroll
    for (int j = 0; j < 4; ++j) { const u32x4 w = ((const u32x4*)row)[64 * j + lane];
        v[8 * j + 0] = bflo(w.x); v[8 * j + 1] = bfhi(w.x); v[8 * j + 2] = bflo(w.y); v[8 * j + 3] = bfhi(w.y);
        v[8 * j + 4] = bflo(w.z); v[8 * j + 5] = bfhi(w.z); v[8 * j + 6] = bflo(w.w); v[8 * j + 7] = bfhi(w.w); }
}
__device__ __forceinline__ void load_row_bf16_nt(const bf16* row, int lane, float (&v)[32]) {
#pragma unroll
    for (int j = 0; j < 4; ++j) { const u32x4 w = __builtin_nontemporal_load(&((const u32x4*)row)[64 * j + lane]);
        v[8 * j + 0] = bflo(w.x); v[8 * j + 1] = bfhi(w.x); v[8 * j + 2] = bflo(w.y); v[8 * j + 3] = bfhi(w.y);
        v[8 * j + 4] = bflo(w.z); v[8 * j + 5] = bfhi(w.z); v[8 * j + 6] = bflo(w.w); v[8 * j + 7] = bfhi(w.w); }
}
__device__ __forceinline__ void store_row_bf16(bf16* row, int lane, const float (&v)[32]) {
#pragma unroll
    for (int j = 0; j < 4; ++j) { u32x4 w; w.x = cvtpk(v[8 * j + 0], v[8 * j + 1]); w.y = cvtpk(v[8 * j + 2], v[8 * j + 3]); w.z = cvtpk(v[8 * j + 4], v[8 * j + 5]); w.w = cvtpk(v[8 * j + 6], v[8 * j + 7]);
        ((u32x4*)row)[64 * j + lane] = w; }
}
__device__ __forceinline__ void load_row_f32(const float* row, int lane, float (&v)[32]) {
#pragma unroll
    for (int j = 0; j < 4; ++j) { const f32x4 a = ((const f32x4*)row)[128 * j + 2 * lane], b = ((const f32x4*)row)[128 * j + 2 * lane + 1];
        v[8 * j + 0] = a.x; v[8 * j + 1] = a.y; v[8 * j + 2] = a.z; v[8 * j + 3] = a.w; v[8 * j + 4] = b.x; v[8 * j + 5] = b.y; v[8 * j + 6] = b.z; v[8 * j + 7] = b.w; }
}
__device__ __forceinline__ void load_row_f32_nt(const float* row, int lane, float (&v)[32]) {
#pragma unroll
    for (int j = 0; j < 4; ++j) { const f32x4 a = __builtin_nontemporal_load(&((const f32x4*)row)[128 * j + 2 * lane]), b = __builtin_nontemporal_load(&((const f32x4*)row)[128 * j + 2 * lane + 1]);
        v[8 * j + 0] = a.x; v[8 * j + 1] = a.y; v[8 * j + 2] = a.z; v[8 * j + 3] = a.w; v[8 * j + 4] = b.x; v[8 * j + 5] = b.y; v[8 * j + 6] = b.z; v[8 * j + 7] = b.w; }
}
__device__ __forceinline__ void store_row_f32(float* row, int lane, const float (&v)[32]) {
#pragma unroll
    for (int j = 0; j < 4; ++j) { ((f32x4*)row)[128 * j + 2 * lane] = (f32x4){v[8 * j + 0], v[8 * j + 1], v[8 * j + 2], v[8 * j + 3]};
        ((f32x4*)row)[128 * j + 2 * lane + 1] = (f32x4){v[8 * j + 4], v[8 * j + 5], v[8 * j + 6], v[8 * j + 7]}; }
}
__device__ __forceinline__ void load_row_bf16_b(const bf16* row, int lane, float (&v)[32]) {
#pragma unroll
    for (int j = 0; j < 4; ++j) { const u32x4 w = ((const u32x4*)row)[4 * lane + j];
        v[8 * j + 0] = bflo(w.x); v[8 * j + 1] = bfhi(w.x); v[8 * j + 2] = bflo(w.y); v[8 * j + 3] = bfhi(w.y);
        v[8 * j + 4] = bflo(w.z); v[8 * j + 5] = bfhi(w.z); v[8 * j + 6] = bflo(w.w); v[8 * j + 7] = bfhi(w.w); }
}
__device__ __forceinline__ void store_row_bf16_b(bf16* row, int lane, const float (&v)[32]) {
#pragma unroll
    for (int j = 0; j < 4; ++j) { u32x4 w; w.x = cvtpk(v[8 * j + 0], v[8 * j + 1]); w.y = cvtpk(v[8 * j + 2], v[8 * j + 3]); w.z = cvtpk(v[8 * j + 4], v[8 * j + 5]); w.w = cvtpk(v[8 * j + 6], v[8 * j + 7]);
        ((u32x4*)row)[4 * lane + j] = w; }
}
__device__ __forceinline__ void load_row_f32_b(const float* row, int lane, float (&v)[32]) {
#pragma unroll
    for (int q = 0; q < 8; ++q) { const f32x4 a = ((const f32x4*)row)[8 * lane + q];
        v[4 * q + 0] = a.x; v[4 * q + 1] = a.y; v[4 * q + 2] = a.z; v[4 * q + 3] = a.w; }
}
__device__ __forceinline__ void store_row_f32_b(float* row, int lane, const float (&v)[32]) {
#pragma unroll
    for (int q = 0; q < 8; ++q) ((f32x4*)row)[8 * lane + q] = (f32x4){v[4 * q + 0], v[4 * q + 1], v[4 * q + 2], v[4 * q + 3]};
}
__device__ __forceinline__ void store_row_f32_b_nt(float* row, int lane, const float (&v)[32]) {
#pragma unroll
    for (int q = 0; q < 8; ++q) __builtin_nontemporal_store((f32x4){v[4 * q + 0], v[4 * q + 1], v[4 * q + 2], v[4 * q + 3]}, &((f32x4*)row)[8 * lane + q]);
}
__device__ __forceinline__ void ln_stats(const float (&v)[32], float& mean, float& rstd) {
    float s = 0.f;
#pragma unroll
    for (int i = 0; i < 32; ++i) s += v[i];
    mean = wave_sum(s) * (1.0f / DM);
    float q = 0.f;
#pragma unroll
    for (int i = 0; i < 32; ++i) { const float d = v[i] - mean; q += d * d; }
    rstd = 1.0f / sqrtf(wave_sum(q) * (1.0f / DM) + LN_EPS);
}
template <bool LAYB>
__device__ __forceinline__ void finish_row(float (&z)[32], const float* lng, const float* lnb, bf16* Xrow, const float* sh, const float* sc, bf16* Hrow, float* Orow, int lane) {
    float mean, rstd; ln_stats(z, mean, rstd);
    { float g[32], b[32]; if (LAYB) { load_row_f32_b(lng, lane, g); load_row_f32_b(lnb, lane, b); } else { load_row_f32(lng, lane, g); load_row_f32(lnb, lane, b); }
#pragma unroll
      for (int i = 0; i < 32; ++i) z[i] = (z[i] - mean) * rstd * g[i] + b[i]; }
    if (Xrow) { if (LAYB) store_row_bf16_b(Xrow, lane, z); else store_row_bf16(Xrow, lane, z); }
    if (Orow) { if (LAYB) store_row_f32_b(Orow, lane, z); else store_row_f32(Orow, lane, z); }
    if (Hrow) {
        ln_stats(z, mean, rstd);
        float a[32], s[32]; if (LAYB) { load_row_f32_b(sc, lane, a); load_row_f32_b(sh, lane, s); } else { load_row_f32(sc, lane, a); load_row_f32(sh, lane, s); }
#pragma unroll
        for (int i = 0; i < 32; ++i) a[i] = (z[i] - mean) * rstd * (1.0f + a[i]) + s[i];
        if (LAYB) store_row_bf16_b(Hrow, lane, a); else store_row_bf16(Hrow, lane, a);
    }
}
__device__ __forceinline__ int row_slot(int row) { return row < ML ? (row >> 13) : 2; }

__device__ __forceinline__ unsigned f2bf_rne(float f) { unsigned u = __float_as_uint(f); return (u + 0x7fffu + ((u >> 16) & 1u)) >> 16; }
__device__ __forceinline__ unsigned pk2(float lo, float hi) { return f2bf_rne(lo) | (f2bf_rne(hi) << 16); }
#ifndef GEMV_PIPE
#define GEMV_PIPE 1
#endif
#ifndef NT_ACT
#define NT_ACT 0
#endif
#ifndef NT_STREAM
#define NT_STREAM 1
#endif
__device__ __forceinline__ void p0_transpose_item(const float* W, int K, int N, bf16* WT, LAS float* scr, int item, int lane) {
    const int nblk = N / 32, kb = item / nblk, nb = item % nblk, k0 = 64 * kb, n0 = 32 * nb;
    f32x4 t[8];
#pragma unroll
    for (int i = 0; i < 8; ++i) { const f32x4* p_ = (const f32x4*)(W + (size_t)(k0 + 8 * i + (lane >> 3)) * N + n0 + 4 * (lane & 7)); t[i] = NT_STREAM ? __builtin_nontemporal_load(p_) : *p_; }
#pragma unroll
    for (int i = 0; i < 8; ++i) { LAS float* d = scr + (8 * i + (lane >> 3)) * 33 + 4 * (lane & 7); d[0] = t[i].x; d[1] = t[i].y; d[2] = t[i].z; d[3] = t[i].w; }
    LDS_WAIT(); asm volatile("" ::: "memory");
    const int c = lane & 7;
#pragma unroll
    for (int j = 0; j < 4; ++j) { const int n = (lane >> 3) + 8 * j; const LAS float* s = scr + (8 * c) * 33 + n;
        u32x4 o; o.x = pk2(s[0 * 33], s[1 * 33]); o.y = pk2(s[2 * 33], s[3 * 33]); o.z = pk2(s[4 * 33], s[5 * 33]); o.w = pk2(s[6 * 33], s[7 * 33]);
        *(u32x4*)(WT + (size_t)(n0 + n) * K + k0 + 8 * c) = o; }
    LDS_WAIT(); asm volatile("" ::: "memory");
}
__device__ __forceinline__ void cvt_range(const float* src, bf16* dst, size_t n8, size_t gtid, size_t gthreads) {
#pragma unroll 4
    for (size_t i = gtid; i < n8; i += gthreads) { const f32x4 a = ((const f32x4*)src)[2 * i], b = ((const f32x4*)src)[2 * i + 1];
        u32x4 w; w.x = cvtpk(a.x, a.y); w.y = cvtpk(a.z, a.w); w.z = cvtpk(b.x, b.y); w.w = cvtpk(b.z, b.w); ((u32x4*)dst)[i] = w; }
}
__device__ __forceinline__ unsigned enc_e2m3(float x) {
    const unsigned sgn = (__float_as_uint(x) >> 26) & 32u;
    const float ax = fminf(fabsf(x), 7.5f);
    unsigned u = __float_as_uint(ax); u += 0x7FFFFu + ((u >> 20) & 1u);
    const unsigned cn = (u >> 20) - ((127u - 1u) << 3);
    const unsigned cs = (unsigned)__builtin_rintf(ax * 8.0f);
    return sgn | (ax < 1.0f ? cs : cn);
}
#ifndef EMU_FP4V
#define EMU_FP4V 0
#endif
#ifndef CVT_PIPE
#define CVT_PIPE 0
#endif
typedef float f32x2v __attribute__((ext_vector_type(2)));
typedef float f32x16v __attribute__((ext_vector_type(16)));
typedef float f32x32v __attribute__((ext_vector_type(32)));
typedef unsigned u32x6v __attribute__((ext_vector_type(6)));
__device__ __forceinline__ u32x6v pack_fp6_32(const float (&e)[32], bool interleaved) {
    f32x16v s0, s1;
    if (interleaved) {
#pragma unroll
        for (int i = 0; i < 16; ++i) { s0[i] = e[2 * i]; s1[i] = e[2 * i + 1]; }
    } else {
#pragma unroll
        for (int i = 0; i < 16; ++i) { s0[i] = e[i]; s1[i] = e[16 + i]; }
    }
    return __builtin_amdgcn_cvt_scalef32_2xpk16_fp6_f32(s0, s1, 1.0f);
}
__device__ __forceinline__ void cvt_table_fp6(const float* src, unsigned char* dst, int nrows, float scale, LAS float* scr  , int lane, int gw, int NGW, const int isv) {
    bool interleaved;
    {
        float t[32];
#pragma unroll
        for (int k = 0; k < 32; ++k) t[k] = k < 16 ? 0.125f * k : (k < 24 ? 2.0f + 0.25f * (k - 16) : 4.0f + 0.5f * (k - 24));
        float tt[32];
#pragma unroll
        for (int k = 0; k < 32; ++k) { tt[k] = t[k]; asm volatile("" : "+v"(tt[k])); }
        const u32x6v p = pack_fp6_32(tt, true);
        const f32x32v o = __builtin_amdgcn_cvt_scalef32_pk32_f32_fp6(p, 1.0f);
        interleaved = (o[1] == t[1]) && (o[2] == t[2]) && (o[17] == t[17]);
        interleaved = __all(interleaved);
    }
#if CVT_PIPE
    f32x4 nx[8];
    if (gw < nrows) { const f32x4* s4 = (const f32x4*)(src + (size_t)gw * 2048);
#pragma unroll
        for (int q = 0; q < 8; ++q) nx[q] = s4[64 * q + lane]; }
    for (int row = gw; row < nrows; row += NGW) {
        f32x4 cur[8];
#pragma unroll
        for (int q = 0; q < 8; ++q) cur[q] = nx[q];
        if (row + NGW < nrows) { const f32x4* s4 = (const f32x4*)(src + (size_t)(row + NGW) * 2048);
#pragma unroll
            for (int q = 0; q < 8; ++q) nx[q] = s4[64 * q + lane]; }
#pragma unroll
        for (int q = 0; q < 8; ++q) { const int s = 64 * q + lane; const f32x4 a = cur[q] * scale; *(LAS f32x4*)(scr + 4 * (s ^ ((s >> 4) & 7))) = a; }
#else
    bool fp4_swapped = false;
    if (PEER_V4) {
        float t0 = 1.0f, t1 = 2.0f; asm volatile("" : "+v"(t0), "+v"(t1));
        const unsigned pw = __builtin_amdgcn_cvt_scalef32_pk_fp4_f32(0u, t0, t1, 1.0f, 0);
        const f32x2v pr = __builtin_amdgcn_cvt_scalef32_pk_f32_fp4(pw, 1.0f, 0);
        fp4_swapped = !__all(pr[0] == 1.0f);
    }
    for (int row = gw; row < nrows; row += NGW) {
        const f32x4* s4 = (const f32x4*)(src + (size_t)row * 2048);
#pragma unroll
        for (int q = 0; q < 8; ++q) { const int s = 64 * q + lane; const f32x4 a = (NT_STREAM ? __builtin_nontemporal_load(&s4[s]) : s4[s]) * scale; *(LAS f32x4*)(scr + 4 * (s ^ ((s >> 4) & 7))) = a; }
#endif
        float e[32];
#pragma unroll
        for (int j = 0; j < 8; ++j) { const int s = 8 * lane + j; const f32x4 a = *(const LAS f32x4*)(scr + 4 * (s ^ ((s >> 4) & 7)));
            e[4 * j + 0] = __builtin_amdgcn_fmed3f(a.x, -7.5f, 7.5f); e[4 * j + 1] = __builtin_amdgcn_fmed3f(a.y, -7.5f, 7.5f); e[4 * j + 2] = __builtin_amdgcn_fmed3f(a.z, -7.5f, 7.5f); e[4 * j + 3] = __builtin_amdgcn_fmed3f(a.w, -7.5f, 7.5f); }
#if EMU_FP4V
        if (EMU_FP4V == 2 ? !isv : isv) {
#pragma unroll
            for (int i = 0; i < 32; ++i) { const float a = fabsf(e[i]); float q = a < 2.0f ? rintf(a * 2.0f) * 0.5f : (a < 4.0f ? rintf(a) : fminf(rintf(a * 0.5f) * 2.0f, 6.0f)); e[i] = copysignf(q, e[i]); }
        }
#endif
        unsigned char* rowp = dst + (size_t)row * PREC;
        if (PEER_V4 && (isv || PEER_U4)) {
            u32x4 w4;
#pragma unroll
            for (int w = 0; w < 4; ++w) { unsigned d = 0u; float x_[8];
#pragma unroll
                for (int i = 0; i < 8; i += 2) { const float x0 = __builtin_amdgcn_fmed3f(e[8 * w + i], -6.0f, 6.0f), x1 = __builtin_amdgcn_fmed3f(e[8 * w + i + 1], -6.0f, 6.0f); x_[i] = fp4_swapped ? x1 : x0; x_[i + 1] = fp4_swapped ? x0 : x1; }
                d = __builtin_amdgcn_cvt_scalef32_pk_fp4_f32(d, x_[0], x_[1], 1.0f, 0); d = __builtin_amdgcn_cvt_scalef32_pk_fp4_f32(d, x_[2], x_[3], 1.0f, 1);
                d = __builtin_amdgcn_cvt_scalef32_pk_fp4_f32(d, x_[4], x_[5], 1.0f, 2); d = __builtin_amdgcn_cvt_scalef32_pk_fp4_f32(d, x_[6], x_[7], 1.0f, 3);
                w4[w] = d; }
            *(u32x4*)(rowp + ((isv || !PEER_U4) ? 1024 : 0) + 16 * lane) = w4;
            continue;
        }
        const u32x6v p = pack_fp6_32(e, interleaved);
        *(u32x4*)(rowp + 1024 * isv + 16 * lane) = (u32x4){p[0], p[1], p[2], p[3]}; *(u32x2*)(rowp + 2048 + 512 * isv + 8 * lane) = (u32x2){p[4], p[5]};
    }
}
__device__ __forceinline__ float silu(float x) { return x / (1.0f + __expf(-x)); }

struct Params { const float* in[29]; float* out; unsigned char* ws; int ph_lo, ph_hi; };
typedef const __attribute__((address_space(4))) Params* CP;

#ifndef P0_NOV
#define P0_NOV 0
#endif
#ifndef TAIL_REMAP
#define TAIL_REMAP 0
#endif
__device__ __forceinline__ void p0_prologue(CP P, LAS unsigned char* lds, int tid, int lane, int wid, int gw, int NGW, const int parts = 7) {
    unsigned char* ws = P->ws;
    LAS float* scr = (LAS float*)(lds + wid * 16384);
    if (parts & 1) {
        constexpr int I_GMIN = (2048 / 64) * (4096 / 32), I_SQ = (2048 / 64) * (2048 / 32), I_MIN = (2048 / 64) * (1088 / 32), I_UQ = (512 / 64) * (3072 / 32), I_UKV = (512 / 64) * (4096 / 32), I_DIN = (2048 / 64) * (6144 / 32);
        constexpr int NIT = 2 * I_GMIN + 2 * I_SQ + 4 * I_SQ + I_MIN + I_UQ + I_UKV + I_SQ + I_DIN + I_SQ;
        for (int it = gw; it < NIT; it += NGW) {
            int r = it;
            if (r < 2 * I_GMIN) { const int j = r / I_GMIN; p0_transpose_item(P->in[13] + (size_t)j * 2048 * 4096, 2048, 4096, (bf16*)(ws + WS_GMWIN) + (size_t)j * 4096 * 2048, scr, r % I_GMIN, lane); continue; } r -= 2 * I_GMIN;
            if (r < 2 * I_SQ) { const int j = r / I_SQ; p0_transpose_item(P->in[18] + (size_t)j * 2048 * 2048, 2048, 2048, (bf16*)(ws + WS_GMWOUT) + (size_t)j * 2048 * 2048, scr, r % I_SQ, lane); continue; } r -= 2 * I_SQ;
            if (r < 4 * I_SQ) { const int j = r / I_SQ; p0_transpose_item(P->in[8] + (size_t)j * 2048 * 2048, 2048, 2048, (bf16*)(ws + WS_PWQ) + (size_t)j * 2048 * 2048, scr, r % I_SQ, lane); continue; } r -= 4 * I_SQ;
            if (r < I_MIN) { p0_transpose_item(P->in[19], 2048, 1088, (bf16*)(ws + WS_MLAIN), scr, r, lane); continue; } r -= I_MIN;
            if (r < I_UQ) { p0_transpose_item(P->in[22], 512, 3072, (bf16*)(ws + WS_MLAUQ), scr, r, lane); continue; } r -= I_UQ;
            if (r < I_UKV) { p0_transpose_item(P->in[23], 512, 4096, (bf16*)(ws + WS_MLAUKV), scr, r, lane); continue; } r -= I_UKV;
            if (r < I_SQ) { p0_transpose_item(P->in[24], 2048, 2048, (bf16*)(ws + WS_MLAOUT), scr, r, lane); continue; } r -= I_SQ;
            if (r < I_DIN) { p0_transpose_item(P->in[25], 2048, 6144, (bf16*)(ws + WS_DAIN), scr, r, lane); continue; } r -= I_DIN;
            p0_transpose_item(P->in[28], 2048, 2048, (bf16*)(ws + WS_DAOUT), scr, r, lane);
        }
    }
    const size_t gtid = (size_t)gw * 64 + lane, gthreads = (size_t)NGW * 64;
    if (parts & 2) {
    { u32x4* z = (u32x4*)((bf16*)(ws + WS_MLAIN) + (size_t)1088 * 2048); const size_t n = (size_t)192 * 2048 / 8;
      for (size_t i = gtid; i < n; i += gthreads) z[i] = (u32x4){0u, 0u, 0u, 0u}; }
    cvt_range(P->in[16], (bf16*)(ws + WS_GMWS), (size_t)2 * 16 * 128 * 128 / 8, gtid, gthreads);
    cvt_range(P->in[9], (bf16*)(ws + WS_PK1), (size_t)4 * 128 * 128 / 8, gtid, gthreads);
    cvt_range(P->in[10], (bf16*)(ws + WS_PK2), (size_t)4 * 128 * 128 / 8, gtid, gthreads);
#if !TAIL_REMAP
    cvt_table_fp6(P->in[11], ws + WS_PU, 16384, U_SCALE, scr, lane, gw, NGW, 0);
    if (!P0_NOV) cvt_table_fp6(P->in[12], ws + WS_PU, 16384, V_SCALE, scr, lane, gw, NGW, 1);
#endif
    if (gtid < 2048) { const int pos = (int)gtid >> 4, f = (int)gtid & 15; const float inv = powf(10000.0f, -(float)f * (1.0f / 16.0f)); float sn, cs; sincosf((float)pos * inv, &sn, &cs);
        float* rt = (float*)(ws + WS_ROPE); rt[gtid] = cs; rt[2048 + gtid] = sn; }
    }
    if (parts & 4) {
        const float* cv = P->in[1]; const float* cc = P->in[3]; const float* mw = P->in[4]; float* PART = (float*)(ws + WS_MODP);
        LAS float* S = (LAS float*)lds;
        __syncthreads();
        { float t_[12];
#pragma unroll
          for (int t = 0; t < 12; ++t) { const int i = tid + t * NWAVES * 64, sl = i >> 11, kk = i & 2047; t_[t] = sl == 0 ? cv[kk] : (sl == 1 ? cv[2048 + kk] : cc[kk]); }
#pragma unroll
          for (int t = 0; t < 12; ++t) S[tid + t * NWAVES * 64] = silu(t_[t]); }
        __syncthreads();
        for (int item = gw; item < 4 * 192 * 8; item += NGW) {
            const int ks = item & 7, r = item >> 3, L = r / 192, n = (r % 192) * 64 + lane;
            const float* W = mw + (size_t)L * 2048 * 12288 + (size_t)(ks * 256) * 12288 + n;
            float a0 = 0.f, a1 = 0.f, a2 = 0.f;
#if GEMV_PIPE
#define GV_LD(dst_, kb_) do { _Pragma("unroll") for (int t = 0; t < 32; ++t) dst_[t] = NT_STREAM ? __builtin_nontemporal_load(&W[(size_t)((kb_) + t) * 12288]) : W[(size_t)((kb_) + t) * 12288]; } while (0)
            float wa[32], wb[32];
            GV_LD(wa, 0);
#pragma unroll 1
            for (int kb = 0; kb < 256; kb += 64) {
                GV_LD(wb, kb + 32);
#pragma unroll
                for (int t = 0; t < 32; ++t) { const int kk = ks * 256 + kb + t; a0 += S[kk] * wa[t]; a1 += S[2048 + kk] * wa[t]; a2 += S[4096 + kk] * wa[t]; }
                if (kb + 64 < 256) GV_LD(wa, kb + 64);
#pragma unroll
                for (int t = 0; t < 32; ++t) { const int kk = ks * 256 + kb + 32 + t; a0 += S[kk] * wb[t]; a1 += S[2048 + kk] * wb[t]; a2 += S[4096 + kk] * wb[t]; }
            }
#undef GV_LD
#else
#pragma unroll 32
            for (int k = 0; k < 256; ++k) { const int kk = ks * 256 + k; const float s0 = S[kk], s1 = S[2048 + kk], s2 = S[4096 + kk];
                const float w = NT_STREAM ? __builtin_nontemporal_load(&W[(size_t)k * 12288]) : W[(size_t)k * 12288]; a0 += s0 * w; a1 += s1 * w; a2 += s2 * w; }
#endif
            float* o = PART + ((size_t)ks * 4 + L) * 3 * 12288 + n;
            o[0] = a0; o[12288] = a1; o[24576] = a2;
        }
    }
}
__device__ __forceinline__ void mod_reduce(CP P, int gw, int lane, int NGW) {
    const float* PART = (const float*)(P->ws + WS_MODP); float* MOD = (float*)(P->ws + WS_MOD); const float* mb = P->in[5];
    for (int i = gw * 64 + lane; i < 4 * 3 * 12288; i += NGW * 64) {
        const int L = i / (3 * 12288), n = i % 12288;
        float s = mb[(size_t)L * 12288 + n];
#pragma unroll
        for (int ks = 0; ks < 8; ++ks) s += PART[(size_t)ks * 4 * 3 * 12288 + i];
        MOD[i] = s;
    }
}

__device__ __forceinline__ void load_row_f32_l(const LAS float* row, int lane, float (&v)[32]) {
#pragma unroll
    for (int j = 0; j < 4; ++j) { const f32x4 a = ((const LAS f32x4*)row)[128 * j + 2 * lane], b = ((const LAS f32x4*)row)[128 * j + 2 * lane + 1];
        v[8 * j + 0] = a.x; v[8 * j + 1] = a.y; v[8 * j + 2] = a.z; v[8 * j + 3] = a.w; v[8 * j + 4] = b.x; v[8 * j + 5] = b.y; v[8 * j + 6] = b.z; v[8 * j + 7] = b.w; }
}
__device__ __forceinline__ void first_row_pass(CP P, LAS unsigned char* lds, int tid, int lane, int gw, int NGW) {
    const float* MOD = (const float*)(P->ws + WS_MOD); bf16* X = (bf16*)(P->ws + WS_X); bf16* H = (bf16*)(P->ws + WS_H);
    LAS float* V = (LAS float*)lds;
    __syncthreads();
    { f32x4 t_[6];
#pragma unroll
      for (int vec = 0; vec < 6; ++vec) t_[vec] = ((const f32x4*)(MOD + (size_t)(vec >> 1) * 12288 + (size_t)(vec & 1) * 2048))[tid];
#pragma unroll
      for (int vec = 0; vec < 6; ++vec) ((LAS f32x4*)V)[vec * 512 + tid] = t_[vec]; }
    __syncthreads();
    for (int row = gw; row < MT; row += NGW) {
        const float* src = row < ML ? P->in[0] + (size_t)row * DM : P->in[2] + (size_t)(row - ML) * DM;
        float v[32]; if (NT_STREAM > 1) load_row_f32_nt(src, lane, v); else load_row_f32(src, lane, v);
        store_row_bf16(X + (size_t)row * DM, lane, v);
        const LAS float* mod = V + row_slot(row) * 4096;
        float mean, rstd; ln_stats(v, mean, rstd);
        float a[32], s[32]; load_row_f32_l(mod + 2048, lane, a); load_row_f32_l(mod, lane, s);
#pragma unroll
        for (int i = 0; i < 32; ++i) a[i] = (v[i] - mean) * rstd * (1.0f + a[i]) + s[i];
        store_row_bf16(H + (size_t)row * DM, lane, a);
    }
}
#ifndef POSTMIX_LDS
#define POSTMIX_LDS 1
#endif
__device__ __forceinline__ void post_mixer_pass_lds(CP P, int L, int Mrows, LAS unsigned char* lds, int tid, int lane, int gw, int NGW) {
    const float* MOD = (const float*)(P->ws + WS_MOD); bf16* X = (bf16*)(P->ws + WS_X); bf16* H = (bf16*)(P->ws + WS_H); const bf16* Y = (const bf16*)(P->ws + WS_Y);
    const float* lng = P->in[6] + (size_t)(L * 2 + 0) * DM; const float* lnb = P->in[7] + (size_t)(L * 2 + 0) * DM;
    LAS float* V = (LAS float*)lds;
    __syncthreads();
    { f32x4 t_[11];
#pragma unroll
      for (int vec = 0; vec < 11; ++vec) { const float* src = vec == 0 ? lng : (vec == 1 ? lnb : MOD + (size_t)(L * 3 + (vec - 2) / 3) * 12288 + (size_t)(2 + (vec - 2) % 3) * 2048);
          t_[vec] = ((const f32x4*)src)[tid]; }
#pragma unroll
      for (int vec = 0; vec < 11; ++vec) ((LAS f32x4*)V)[vec * 512 + tid] = t_[vec]; }
    __syncthreads();
    for (int row = gw; row < Mrows; row += NGW) {
        const LAS float* mv = V + (2 + 3 * row_slot(row)) * 2048;
        float z[32], y[32]; if (NT_ACT) { load_row_bf16_nt(X + (size_t)row * DM, lane, z); load_row_bf16_nt(Y + (size_t)row * DM, lane, y); } else { load_row_bf16(X + (size_t)row * DM, lane, z); load_row_bf16(Y + (size_t)row * DM, lane, y); }
        { float g[32]; load_row_f32_l(mv, lane, g);
#pragma unroll
          for (int i = 0; i < 32; ++i) z[i] = ALPHA * z[i] + g[i] * y[i]; }
        float mean, rstd; ln_stats(z, mean, rstd);
        { float g[32], b[32]; load_row_f32_l(V, lane, g); load_row_f32_l(V + 2048, lane, b);
#pragma unroll
          for (int i = 0; i < 32; ++i) z[i] = (z[i] - mean) * rstd * g[i] + b[i]; }
        store_row_bf16(X + (size_t)row * DM, lane, z);
        ln_stats(z, mean, rstd);
        { float a[32], s_[32]; load_row_f32_l(mv + 2 * 2048, lane, a); load_row_f32_l(mv + 2048, lane, s_);
#pragma unroll
          for (int i = 0; i < 32; ++i) a[i] = (z[i] - mean) * rstd * (1.0f + a[i]) + s_[i];
          store_row_bf16(H + (size_t)row * DM, lane, a); }
    }
}
__device__ __forceinline__ void post_mixer_pass(CP P, int L, int Mrows, int lane, int gw, int NGW) {
    const float* MOD = (const float*)(P->ws + WS_MOD); bf16* X = (bf16*)(P->ws + WS_X); bf16* H = (bf16*)(P->ws + WS_H); const bf16* Y = (const bf16*)(P->ws + WS_Y);
    const float* lng = P->in[6] + (size_t)(L * 2 + 0) * DM; const float* lnb = P->in[7] + (size_t)(L * 2 + 0) * DM;
    for (int row = gw; row < Mrows; row += NGW) {
        const float* mod = MOD + (size_t)(L * 3 + row_slot(row)) * 12288;
        float z[32], y[32], g[32]; load_row_bf16(X + (size_t)row * DM, lane, z); load_row_bf16(Y + (size_t)row * DM, lane, y); load_row_f32(mod + 2 * 2048, lane, g);
#pragma unroll
        for (int i = 0; i < 32; ++i) z[i] = ALPHA * z[i] + g[i] * y[i];
        finish_row<false>(z, lng, lnb, X + (size_t)row * DM, mod + 3 * 2048, mod + 4 * 2048, H + (size_t)row * DM, nullptr, lane);
    }
}
__device__ __forceinline__ void vstats_pass(CP P, int Mrows, int lane, int gw, int NGW) {
    const bf16* Z = (const bf16*)(P->ws + WS_Z); float* VST = (float*)(P->ws + WS_VST);
    for (int row = gw; row < Mrows; row += NGW) {
        float v[32]; load_row_bf16(Z + (size_t)row * 4096 + 2048, lane, v);
        float mean, rstd; ln_stats(v, mean, rstd);
        if (lane == 0) { VST[2 * row] = mean; VST[2 * row + 1] = rstd; }
    }
}
#define XB_TMO      128
#define XB_XCNT(j)  (256  + 64 * (j))
#define XB_XSUB(j)  (1280 + 64 * (j))
#define XB_XGEN(j)  (2304 + 64 * (j))
#define XB_TOP      3328
#define XB_TOPGEN   3392
#define XCD_BAR_WORDS 3456
#define XB_SPIN_CAP (1u << 18)

__device__ __forceinline__ unsigned xb_ld(unsigned* p)              { return __hip_atomic_load(p, __ATOMIC_RELAXED, __HIP_MEMORY_SCOPE_AGENT); }
__device__ __forceinline__ unsigned xb_add(unsigned* p, unsigned v) { return __hip_atomic_fetch_add(p, v, __ATOMIC_RELAXED, __HIP_MEMORY_SCOPE_AGENT); }
__device__ __forceinline__ unsigned xb_xcc_id() { return (unsigned)__builtin_amdgcn_s_getreg((3 << 11) | 20) & 0xFu; }
#define XB_SPIN(cond, bar) do { unsigned _sp = 0; while (cond) { __builtin_amdgcn_s_sleep(1); \
    if ((++_sp & 255u) == 0u) { if (xb_ld(&(bar)[XB_TMO])) break; if (_sp > XB_SPIN_CAP) { atomicAdd(&(bar)[XB_TMO], 1u); break; } } } } while (0)

struct XcdBarrier {
    unsigned* bar; unsigned x;
    volatile LAS unsigned* st;
};

__device__ __forceinline__ XcdBarrier xcd_barrier_post(unsigned* bar, volatile LAS unsigned* st, const bool t0) {
    XcdBarrier b; b.bar = bar; b.x = xb_xcc_id(); b.st = st;
    if (t0) (void)xb_add(&bar[XB_XCNT(b.x)], 1u);
    return b;
}
__device__ __forceinline__ void xcd_barrier_complete(unsigned* bar, unsigned x, unsigned& nloc, unsigned& nx) {
    const unsigned G = gridDim.x * gridDim.y * gridDim.z;
    unsigned sum, cnt, mine, sp = 0u;
    for (;;) {
        sum = 0u; cnt = 0u; mine = 0u;
#pragma unroll
        for (unsigned j = 0; j < 16; ++j) { const unsigned c = xb_ld(&bar[XB_XCNT(j)]); sum += c; cnt += (c > 0u) ? 1u : 0u; mine = (j == x) ? c : mine; }
        if (sum == G) break;
        __builtin_amdgcn_s_sleep(1);
        if ((++sp & 255u) == 0u) { if (xb_ld(&bar[XB_TMO])) break; if (sp > XB_SPIN_CAP) { atomicAdd(&bar[XB_TMO], 1u); break; } }
    }
    nloc = mine > 0u ? mine : 1u; nx = cnt > 0u ? cnt : 1u;
}

__device__ __attribute__((noinline)) void xcd_barrier(const XcdBarrier b, const bool t0) {
    asm volatile("s_waitcnt vmcnt(0)" ::: "memory");
    __syncthreads();
    if (t0) {
        unsigned* bar = b.bar;
        __builtin_amdgcn_s_waitcnt(0);
        unsigned nloc = b.st[0], nx = b.st[1];
        if (nloc == 0u) { xcd_barrier_complete(bar, b.x, nloc, nx); b.st[0] = nloc; b.st[1] = nx; }
        const unsigned old = xb_add(&bar[XB_XSUB(b.x)], 1u);
        const unsigned gen = old / nloc;
        if (old + 1u == (gen + 1u) * nloc) {
            __builtin_amdgcn_fence(__ATOMIC_RELEASE, "agent");
            asm volatile("s_waitcnt vmcnt(0)" ::: "memory");
            const unsigned og = xb_add(&bar[XB_TOP], 1u);
            const unsigned tg = og / nx;
            if (og + 1u == (tg + 1u) * nx) xb_add(&bar[XB_TOPGEN], 1u);
            else XB_SPIN(xb_ld(&bar[XB_TOPGEN]) == tg, bar);
            __builtin_amdgcn_fence(__ATOMIC_ACQUIRE, "agent");
            xb_add(&bar[XB_XGEN(b.x)], 1u);
            asm volatile("s_waitcnt vmcnt(0)" ::: "memory");
        } else {
            XB_SPIN(xb_ld(&bar[XB_XGEN(b.x)]) == gen, bar);
            __builtin_amdgcn_fence(__ATOMIC_ACQUIRE, "agent");
            asm volatile("s_waitcnt vmcnt(0)" ::: "memory");
        }
    }
    __syncthreads();
}

#ifndef SPATIAL_PIPE
#define SPATIAL_PIPE 1
#endif
#if SPATIAL_PIPE
#ifndef SPATIAL_OTILE
#define SPATIAL_OTILE 0
#endif
struct SpReg { u32x4 w[4]; float mean, rstd; bf16x8 a[4]; bf16 uu[SPATIAL_OTILE ? 1 : 32]; u32x4 uq[4]; float bsv[4]; };
__device__ __forceinline__ void sp_load(SpReg& R, const bf16* Z, const float* VST, const bf16* WS, const float* bs, int u, int tid, int lane, int wid) {
    const int c = u >> 4, g = u & 15, fr = lane & 15, fq = lane >> 4;
    { const int q = tid >> 2, dq = (tid & 3) * 32; const int row = c * 128 + q;
      R.mean = VST[2 * row]; R.rstd = VST[2 * row + 1];
      const bf16* src = Z + (size_t)row * 4096 + 2048 + g * 128 + dq;
#pragma unroll
      for (int t = 0; t < 4; ++t) R.w[t] = *(const u32x4*)(src + 8 * t); }
    const bf16* wrow = WS + (size_t)g * 128 * 128 + (size_t)(16 * wid + fr) * 128 + 8 * fq;
#pragma unroll
    for (int ks = 0; ks < 4; ++ks) R.a[ks] = *(const bf16x8*)(wrow + 32 * ks);
#pragma unroll
    for (int r = 0; r < 4; ++r) R.bsv[r] = bs[g * 128 + 16 * wid + fq * 4 + r];
#if SPATIAL_OTILE
#pragma unroll
    for (int t = 0; t < 4; ++t) { const int ch = tid + 512 * t, p = ch >> 4, d8 = (ch & 15) * 8; R.uq[t] = *(const u32x4*)(Z + (size_t)(c * 128 + p) * 4096 + g * 128 + d8); }
    R.uu[0] = 0;
#else
#pragma unroll
    for (int nb = 0; nb < 8; ++nb)
#pragma unroll
        for (int r = 0; r < 4; ++r) { const int p = 16 * wid + fq * 4 + r, d = 16 * nb + fr; R.uu[nb * 4 + r] = Z[(size_t)(c * 128 + p) * 4096 + g * 128 + d]; }
#endif
}
__device__ __forceinline__ void spatial_phase(CP P, int j, int Mrows, LAS unsigned char* lds_, int tid, int lane, int wid) {
    const bf16* Z = (const bf16*)(P->ws + WS_Z); const float* VST = (const float*)(P->ws + WS_VST); bf16* Gb = (bf16*)(P->ws + WS_G);
    const bf16* WS = (const bf16*)(P->ws + WS_GMWS) + (size_t)j * 16 * 128 * 128;
    const float* lng = P->in[14] + (size_t)j * DM; const float* lnb = P->in[15] + (size_t)j * DM; const float* bs = P->in[17] + (size_t)j * 16 * 128;
    LAS bf16* Vt = (LAS bf16*)(LAS unsigned char*)lds_;
    constexpr int VP = 136;
    const int nunits = (Mrows / 128) * 16;
    LAS float* LNl = (LAS float*)(lds_ + 36864);
    __syncthreads();
    { const f32x4 t0_ = ((const f32x4*)lng)[tid], t1_ = ((const f32x4*)lnb)[tid]; ((LAS f32x4*)LNl)[tid] = t0_; ((LAS f32x4*)LNl)[512 + tid] = t1_; }
    LAS float* Ot = (LAS float*)(lds_ + 53248);
    (void)Ot;
    SpReg nx;
    if ((int)blockIdx.x < nunits) sp_load(nx, Z, VST, WS, bs, blockIdx.x, tid, lane, wid);
    for (int u = blockIdx.x; u < nunits; u += gridDim.x) {
        const int c = u >> 4, g = u & 15;
        const SpReg cur = nx;
        if (u + (int)gridDim.x < nunits) sp_load(nx, Z, VST, WS, bs, u + gridDim.x, tid, lane, wid);
        __syncthreads();
        {
            const int q = tid >> 2, dq = (tid & 3) * 32;
#pragma unroll
            for (int t = 0; t < 4; ++t) { const u32x4 w = cur.w[t];
                float v[8] = {bflo(w.x), bfhi(w.x), bflo(w.y), bfhi(w.y), bflo(w.z), bfhi(w.z), bflo(w.w), bfhi(w.w)};
                const LAS float* gp = LNl + g * 128 + dq + 8 * t; const LAS float* bp = LNl + 2048 + g * 128 + dq + 8 * t;
#pragma unroll
                for (int i = 0; i < 8; ++i) { const float vn = (v[i] - cur.mean) * cur.rstd * gp[i] + bp[i]; Vt[(dq + 8 * t + i) * VP + (q ^ ((tid & 3) << 4))] = tobf1(vn); } }
        }
        __syncthreads();
        const int fr = lane & 15, fq = lane >> 4;
#pragma unroll
        for (int nb = 0; nb < 8; ++nb) {
            f32x4 acc = {0.f, 0.f, 0.f, 0.f};
#pragma unroll
            for (int ks = 0; ks < 4; ++ks) { const bf16x8 b = *(const LAS bf16x8*)(Vt + (16 * nb + fr) * VP + 8 * ((4 * ks + fq) ^ ((nb >> 1) << 1)));
                acc = __builtin_amdgcn_mfma_f32_16x16x32_bf16(cur.a[ks], b, acc, 0, 0, 0); }
#if SPATIAL_OTILE
#pragma unroll
            for (int r = 0; r < 4; ++r) Ot[(16 * wid + fq * 4 + r) * 132 + 16 * nb + fr] = acc[r] + cur.bsv[r];
#else
#pragma unroll
            for (int r = 0; r < 4; ++r) { const int p = 16 * wid + fq * 4 + r, d = 16 * nb + fr; const size_t grow = (size_t)(c * 128 + p);
                const float sv = acc[r] + cur.bsv[r];
                const float uu = bf1(cur.uu[nb * 4 + r]);
                Gb[grow * 2048 + g * 128 + d] = tobf1(uu * sv); }
#endif
        }
#if SPATIAL_OTILE
        __syncthreads();
#pragma unroll
        for (int t = 0; t < 4; ++t) { const int ch = tid + 512 * t, p = ch >> 4, d8 = (ch & 15) * 8;
            const LAS f32x4* op = (const LAS f32x4*)(Ot + p * 132 + d8); const f32x4 s0 = op[0], s1 = op[1]; const u32x4 uw = cur.uq[t];
            u32x4 o; o.x = cvtpk(bflo(uw.x) * s0.x, bfhi(uw.x) * s0.y); o.y = cvtpk(bflo(uw.y) * s0.z, bfhi(uw.y) * s0.w); o.z = cvtpk(bflo(uw.z) * s1.x, bfhi(uw.z) * s1.y); o.w = cvtpk(bflo(uw.w) * s1.z, bfhi(uw.w) * s1.w);
            *(u32x4*)(Gb + (size_t)(c * 128 + p) * 2048 + g * 128 + d8) = o; }
#endif
    }
}
#else
__device__ __forceinline__ void spatial_phase(CP P, int j, int Mrows, LAS unsigned char* lds_, int tid, int lane, int wid) {
    const bf16* Z = (const bf16*)(P->ws + WS_Z); const float* VST = (const float*)(P->ws + WS_VST); bf16* Gb = (bf16*)(P->ws + WS_G);
    const bf16* WS = (const bf16*)(P->ws + WS_GMWS) + (size_t)j * 16 * 128 * 128;
    const float* lng = P->in[14] + (size_t)j * DM; const float* lnb = P->in[15] + (size_t)j * DM; const float* bs = P->in[17] + (size_t)j * 16 * 128;
    LAS bf16* Vt = (LAS bf16*)(LAS unsigned char*)lds_;
    constexpr int VP = 136;
    const int nunits = (Mrows / 128) * 16;
    for (int u = blockIdx.x; u < nunits; u += gridDim.x) {
        const int c = u >> 4, g = u & 15;
        __syncthreads();
        {
            const int q = tid >> 2, dq = (tid & 3) * 32; const int row = c * 128 + q;
            const float mean = VST[2 * row], rstd = VST[2 * row + 1];
            const bf16* src = Z + (size_t)row * 4096 + 2048 + g * 128 + dq;
#pragma unroll
            for (int t = 0; t < 4; ++t) { const u32x4 w = *(const u32x4*)(src + 8 * t);
                float v[8] = {bflo(w.x), bfhi(w.x), bflo(w.y), bfhi(w.y), bflo(w.z), bfhi(w.z), bflo(w.w), bfhi(w.w)};
                const float* gp = lng + g * 128 + dq + 8 * t; const float* bp = lnb + g * 128 + dq + 8 * t;
#pragma unroll
                for (int i = 0; i < 8; ++i) { const float vn = (v[i] - mean) * rstd * gp[i] + bp[i]; Vt[(dq + 8 * t + i) * VP + q] = tobf1(vn); } }
        }
        __syncthreads();
        const int fr = lane & 15, fq = lane >> 4;
        bf16x8 a[4];
        const bf16* wrow = WS + (size_t)g * 128 * 128 + (size_t)(16 * wid + fr) * 128 + 8 * fq;
#pragma unroll
        for (int ks = 0; ks < 4; ++ks) a[ks] = *(const bf16x8*)(wrow + 32 * ks);
#pragma unroll
        for (int nb = 0; nb < 8; ++nb) {
            f32x4 acc = {0.f, 0.f, 0.f, 0.f};
#pragma unroll
            for (int ks = 0; ks < 4; ++ks) { const bf16x8 b = *(const LAS bf16x8*)(Vt + (16 * nb + fr) * VP + 32 * ks + 8 * fq);
                acc = __builtin_amdgcn_mfma_f32_16x16x32_bf16(a[ks], b, acc, 0, 0, 0); }
#pragma unroll
            for (int r = 0; r < 4; ++r) { const int p = 16 * wid + fq * 4 + r, d = 16 * nb + fr; const size_t grow = (size_t)(c * 128 + p);
                const float sv = acc[r] + bs[g * 128 + p];
                const float uu = bf1(Z[grow * 4096 + g * 128 + d]);
                Gb[grow * 2048 + g * 128 + d] = tobf1(uu * sv); }
        }
    }
}
#endif

__device__ __forceinline__ void rope_cs(int row, int l, float& cs, float& sn) {
    const int t = row & (SEQ - 1); const int pos = (l & 32) ? (t & 63) : (t >> 6);
    const float inv = powf(10000.0f, -(float)(l & 15) * (1.0f / 16.0f));
    const float ang = (float)pos * inv; sincosf(ang, &sn, &cs);
}
__device__ __forceinline__ float rope_apply(float x, int l, float cs, float sn) {
    const float p = lane_xor16(x, l);
    return (l & 16) ? (p * sn + x * cs) : (x * cs - p * sn);
}
__device__ __forceinline__ void mla_norm_pass(CP P, int lane, int gw, int NGW) {
    const bf16* C = (const bf16*)(P->ws + WS_C); bf16* CQN = (bf16*)(P->ws + WS_CQN); bf16* CKVN = (bf16*)(P->ws + WS_CKVN); bf16* KR = (bf16*)(P->ws + WS_KR);
    const float* qn = P->in[20]; const float* kvn = P->in[21];
    for (int row = gw; row < MT; row += NGW) {
        const bf16* c = C + (size_t)row * 1280;
#pragma unroll
        for (int part = 0; part < 2; ++part) {
            const u32x4 w = *(const u32x4*)(c + part * 512 + 8 * lane);
            float v[8] = {bflo(w.x), bfhi(w.x), bflo(w.y), bfhi(w.y), bflo(w.z), bfhi(w.z), bflo(w.w), bfhi(w.w)};
            float ss = 0.f;
#pragma unroll
            for (int i = 0; i < 8; ++i) ss += v[i] * v[i];
            const float r = 1.0f / sqrtf(wave_sum(ss) * (1.0f / 512.0f) + LN_EPS);
            const float* nw = (part ? kvn : qn) + 8 * lane;
            u32x4 o; o.x = cvtpk(v[0] * r * nw[0], v[1] * r * nw[1]); o.y = cvtpk(v[2] * r * nw[2], v[3] * r * nw[3]); o.z = cvtpk(v[4] * r * nw[4], v[5] * r * nw[5]); o.w = cvtpk(v[6] * r * nw[6], v[7] * r * nw[7]);
            *(u32x4*)((part ? CKVN : CQN) + (size_t)row * 512 + 8 * lane) = o;
        }
        float x = bf1(c[1024 + lane]);
        if (row < ML) { float cs, sn; rope_cs(row, lane, cs, sn); x = rope_apply(x, lane, cs, sn); }
        KR[(size_t)row * 64 + lane] = tobf1(x);
    }
}
__device__ __forceinline__ void rope_pass(bf16* buf, int ld, int col0, int nchunks, int cstride, int lane, int gw, int NGW) {
    for (int row = gw; row < ML; row += NGW) {
        float cs, sn; rope_cs(row, lane, cs, sn);
        bf16* r = buf + (size_t)row * ld + col0 + lane;
#pragma unroll 4
        for (int k = 0; k < nchunks; ++k) { const float x = bf1(r[k * cstride]); r[k * cstride] = tobf1(rope_apply(x, lane, cs, sn)); }
    }
}

namespace att {
#ifndef ATT_FSMFIRST
#define ATT_FSMFIRST 0
#endif
#ifndef ATT_VPRE0
#define ATT_VPRE0 1
#endif
#ifndef ATT_VPRE
#define ATT_VPRE 1
#endif
#ifndef ATT_LSUM
#define ATT_LSUM 1
#endif
#ifndef ATT_VSTCF
#define ATT_VSTCF 1
#endif
#ifndef ATT_DA_NQR
#define ATT_DA_NQR 4
#endif
#ifndef ATT_LEAN0
#define ATT_LEAN0 0
#endif
#ifndef ATT_LEAN
#define ATT_LEAN 1
#endif
#ifndef ATT_3STAGE
#define ATT_3STAGE 0
#endif
#ifndef ATT_QLATE
#define ATT_QLATE 1
#endif
#ifndef ATT_PRIO
#define ATT_PRIO 0
#endif
#ifndef ATT_KMAJOR
#define ATT_KMAJOR 0
#endif
#ifndef ATT_TRB
#define ATT_TRB 1
#endif
#ifndef ATT_STAGGER
#define ATT_STAGGER 0
#endif
#ifndef ATT_SDEPTH
#define ATT_SDEPTH(MODE) ((MODE) == 0 ? 1 : 1)
#endif
#ifndef ATT_PVPIPE
#define ATT_PVPIPE(MODE) ((MODE) == 1)
#endif
#define SBAR() __builtin_amdgcn_sched_barrier(0)
__device__ __forceinline__ int crow(int r, int hi) { return (r & 3) + 8 * (r >> 2) + 4 * hi; }
__device__ __forceinline__ unsigned cvtpkv(float lo, float hi) { unsigned r; asm volatile("v_cvt_pk_bf16_f32 %0, %1, %2" : "=v"(r) : "v"(lo), "v"(hi)); return r; }

__device__ __forceinline__ void partialSM(f32x16& p0, f32x16& p1, float& m_reg, float& mn, float& alpha, const float C, const float THRS) {
  float pmax = p0[0];
#pragma unroll
  for (int r = 1; r < 16; ++r) pmax = fmaxf(pmax, p0[r]);
#pragma unroll
  for (int r = 0; r < 16; ++r) pmax = fmaxf(pmax, p1[r]);
  { auto rr = __builtin_amdgcn_permlane32_swap(__float_as_uint(pmax), __float_as_uint(pmax), false, false);
    pmax = fmaxf(__uint_as_float(rr[0]), __uint_as_float(rr[1])); }
  if (__builtin_expect(__all(pmax - m_reg <= THRS), 1)) { mn = m_reg; alpha = 1.f; }
  else { mn = fmaxf(m_reg, pmax); alpha = __builtin_amdgcn_exp2f((m_reg - mn) * C); m_reg = mn; }
  const float mnC = -mn * C;
#pragma unroll
  for (int r = 0; r < 16; ++r) p0[r] = fmaf(p0[r], C, mnC);
#pragma unroll
  for (int r = 0; r < 16; ++r) p1[r] = fmaf(p1[r], C, mnC);
#pragma unroll
  for (int r = 0; r < 16; ++r) p0[r] = __builtin_amdgcn_exp2f(p0[r]);
}
__device__ __forceinline__ void finishSM(f32x16& p0, f32x16& p1, float alpha, float& l_reg, bf16x8& pa0, bf16x8& pa1, bf16x8& pa2, bf16x8& pa3) {
#pragma unroll
  for (int r = 0; r < 16; ++r) p1[r] = __builtin_amdgcn_exp2f(p1[r]);
  float ps = 0;
#pragma unroll
  for (int r = 0; r < 16; ++r) ps += p0[r];
#pragma unroll
  for (int r = 0; r < 16; ++r) ps += p1[r];
  { auto rr = __builtin_amdgcn_permlane32_swap(__float_as_uint(ps), __float_as_uint(ps), false, false);
    ps = __uint_as_float(rr[0]) + __uint_as_float(rr[1]); }
  l_reg = l_reg * alpha + ps;
#define PK4(P, BASE, OUT) do { unsigned a0 = cvtpkv(P[BASE + 0], P[BASE + 1]), a1 = cvtpkv(P[BASE + 2], P[BASE + 3]);   \
    unsigned b0 = cvtpkv(P[BASE + 4], P[BASE + 5]), b1 = cvtpkv(P[BASE + 6], P[BASE + 7]);                              \
    auto r0 = __builtin_amdgcn_permlane32_swap(a0, b0, false, false); auto r1 = __builtin_amdgcn_permlane32_swap(a1, b1, false, false); \
    u32x4 w = {r0[0], r1[0], r0[1], r1[1]}; OUT = *reinterpret_cast<bf16x8*>(&w); } while (0)
  PK4(p0, 0, pa0); PK4(p0, 8, pa1); PK4(p1, 0, pa2); PK4(p1, 8, pa3);
#undef PK4
}
__device__ __forceinline__ void partialSM_lean(f32x16& p0, f32x16& p1, f32x16& nm, float& alpha, const bool first) {
  constexpr float THR2 = 11.541560327111707f;
  float dmax = p0[0];
#pragma unroll
  for (int r = 1; r < 16; ++r) dmax = fmaxf(dmax, p0[r]);
#pragma unroll
  for (int r = 0; r < 16; ++r) dmax = fmaxf(dmax, p1[r]);
  { auto rr = __builtin_amdgcn_permlane32_swap(__float_as_uint(dmax), __float_as_uint(dmax), false, false);
    dmax = fmaxf(__uint_as_float(rr[0]), __uint_as_float(rr[1])); }
  alpha = 1.f;
  if (first || !__all(dmax <= THR2)) {
    const float delta = first ? dmax : (dmax > THR2 ? dmax : 0.f);
    if (!first) alpha = __builtin_amdgcn_exp2f(-delta);
#pragma unroll
    for (int r = 0; r < 16; ++r) { p0[r] -= delta; p1[r] -= delta; nm[r] -= delta; }
  }
#pragma unroll
  for (int r = 0; r < 16; ++r) p0[r] = __builtin_amdgcn_exp2f(p0[r]);
}
template <bool LS> __device__ __forceinline__ void finishSM_lean(f32x16& p0, f32x16& p1, bf16x8& pa0, bf16x8& pa1, bf16x8& pa2, bf16x8& pa3, float& lrun) {
#pragma unroll
  for (int r = 0; r < 16; ++r) p1[r] = __builtin_amdgcn_exp2f(p1[r]);
  if constexpr (LS) {
    typedef float f32x2_ __attribute__((ext_vector_type(2)));
    f32x2_ s0 = {p0[0], p0[1]}, s1 = {p1[0], p1[1]};
#pragma unroll
    for (int r = 2; r < 16; r += 2) { s0 += (f32x2_){p0[r], p0[r + 1]}; s1 += (f32x2_){p1[r], p1[r + 1]}; }
    s0 += s1; lrun += s0[0] + s0[1];
  }
#define PK4(P, BASE, OUT) do { unsigned a0 = cvtpkv(P[BASE + 0], P[BASE + 1]), a1 = cvtpkv(P[BASE + 2], P[BASE + 3]);   \
    unsigned b0 = cvtpkv(P[BASE + 4], P[BASE + 5]), b1 = cvtpkv(P[BASE + 6], P[BASE + 7]);                              \
    auto r0 = __builtin_amdgcn_permlane32_swap(a0, b0, false, false); auto r1 = __builtin_amdgcn_permlane32_swap(a1, b1, false, false); \
    u32x4 w = {r0[0], r1[0], r0[1], r1[1]}; OUT = *reinterpret_cast<bf16x8*>(&w); } while (0)
  PK4(p0, 0, pa0); PK4(p0, 8, pa1); PK4(p1, 0, pa2); PK4(p1, 8, pa3);
#undef PK4
}
__device__ __forceinline__ bf16x8 scale_bf16x8(bf16x8 v, float c) {
  const u32x4 w = *reinterpret_cast<u32x4*>(&v); u32x4 o;
  o.x = cvtpk(bflo(w.x) * c, bfhi(w.x) * c); o.y = cvtpk(bflo(w.y) * c, bfhi(w.y) * c); o.z = cvtpk(bflo(w.z) * c, bfhi(w.z) * c); o.w = cvtpk(bflo(w.w) * c, bfhi(w.w) * c);
  return *reinterpret_cast<bf16x8*>(&o);
}
template <int PITCH> __device__ __forceinline__ int kswz(int r) { return PITCH == 256 ? (r & 15) : ((r >> 1) & 7); }
template <int NQF, int NQR, int PITCH> __device__ __forceinline__ void qkt(f32x16& p0, f32x16& p1, const LAS char* Ks, int chunk0, const bf16x8* qr, const LAS char* ql, int r32, int hi, const f32x16 init = f32x16{}) {
  p0 = init; p1 = init;
  const int sw = kswz<PITCH>(r32);
#pragma unroll
  for (int d0 = 0; d0 < NQF; ++d0) { const int off = ((chunk0 + d0 * 2 + hi) ^ sw) * 16;
    const bf16x8 b0 = *(const LAS bf16x8*)(Ks + r32 * PITCH + off);
    const bf16x8 b1 = *(const LAS bf16x8*)(Ks + (32 + r32) * PITCH + off);
    const bf16x8 q = d0 < NQR ? qr[d0 < NQR ? d0 : 0] : *(const LAS bf16x8*)(ql + (d0 - NQR < 0 ? 0 : d0 - NQR) * 1024);
    p0 = __builtin_amdgcn_mfma_f32_32x32x16_bf16(b0, q, p0, 0, 0, 0);
    p1 = __builtin_amdgcn_mfma_f32_32x32x16_bf16(b1, q, p1, 0, 0, 0); }
}
__device__ __forceinline__ int v_st(int k, int c) { const int kk = (k & ~0xC) | ((k & 4) << 1) | ((k & 8) >> 1); return ((kk >> 3) * 4 + (c >> 5)) * 512 + ((kk & 7) * 32 + (c & 31)) * 2; }
__device__ __forceinline__ int v_rd_base(int lane) { return ((lane & 3) << 3) | (((lane >> 2) & 3) << 6) | (((lane >> 4) & 1) << 5) | (((lane >> 5) & 1) << 8); }
constexpr int v_rd_off(int d0, int ks, int half) { return d0 * 512 + ks * 4096 + half * 2048; }
template <int OFF> __device__ __forceinline__ s16x4 tr_read(int vb) {
  s16x4 r; asm volatile("ds_read_b64_tr_b16 %0, %1 offset:%2" : "=&v"(r) : "v"(vb), "i"(OFF) : "memory"); return r;
}
template <int D0> __device__ __forceinline__ void pv_one(f32x16& od, int vb, bf16x8 pa0, bf16x8 pa1, bf16x8 pa2, bf16x8 pa3) {
  const s16x4 l0 = tr_read<v_rd_off(D0, 0, 0)>(vb), h0 = tr_read<v_rd_off(D0, 0, 1)>(vb), l1 = tr_read<v_rd_off(D0, 1, 0)>(vb), h1 = tr_read<v_rd_off(D0, 1, 1)>(vb);
  const s16x4 l2 = tr_read<v_rd_off(D0, 2, 0)>(vb), h2 = tr_read<v_rd_off(D0, 2, 1)>(vb), l3 = tr_read<v_rd_off(D0, 3, 0)>(vb), h3 = tr_read<v_rd_off(D0, 3, 1)>(vb);
  asm volatile("s_waitcnt lgkmcnt(0)" ::: "memory"); SBAR();
#define PK(L, H) (bf16x8){L[0], L[1], L[2], L[3], H[0], H[1], H[2], H[3]}
  od = __builtin_amdgcn_mfma_f32_32x32x16_bf16(pa0, PK(l0, h0), od, 0, 0, 0);
  od = __builtin_amdgcn_mfma_f32_32x32x16_bf16(pa1, PK(l1, h1), od, 0, 0, 0);
  od = __builtin_amdgcn_mfma_f32_32x32x16_bf16(pa2, PK(l2, h2), od, 0, 0, 0);
  od = __builtin_amdgcn_mfma_f32_32x32x16_bf16(pa3, PK(l3, h3), od, 0, 0, 0);
#undef PK
}
__device__ __forceinline__ void pv_d0(f32x16* o, int vb, bf16x8 pa0, bf16x8 pa1, bf16x8 pa2, bf16x8 pa3) {
  pv_one<0>(o[0], vb, pa0, pa1, pa2, pa3); pv_one<1>(o[1], vb, pa0, pa1, pa2, pa3); pv_one<2>(o[2], vb, pa0, pa1, pa2, pa3); pv_one<3>(o[3], vb, pa0, pa1, pa2, pa3);
}
struct VHalf { s16x4 l0, h0, l1, h1; };
__device__ __forceinline__ void pv_d0_pre(f32x16* o, int vb, bf16x8 pa0, bf16x8 pa1, bf16x8 pa2, bf16x8 pa3, const VHalf& pre) {
  { const s16x4 l2 = tr_read<v_rd_off(0, 2, 0)>(vb), h2 = tr_read<v_rd_off(0, 2, 1)>(vb), l3 = tr_read<v_rd_off(0, 3, 0)>(vb), h3 = tr_read<v_rd_off(0, 3, 1)>(vb);
#define PK(L, H) (bf16x8){L[0], L[1], L[2], L[3], H[0], H[1], H[2], H[3]}
    o[0] = __builtin_amdgcn_mfma_f32_32x32x16_bf16(pa0, PK(pre.l0, pre.h0), o[0], 0, 0, 0);
    o[0] = __builtin_amdgcn_mfma_f32_32x32x16_bf16(pa1, PK(pre.l1, pre.h1), o[0], 0, 0, 0);
    asm volatile("s_waitcnt lgkmcnt(0)" ::: "memory"); SBAR();
    o[0] = __builtin_amdgcn_mfma_f32_32x32x16_bf16(pa2, PK(l2, h2), o[0], 0, 0, 0);
    o[0] = __builtin_amdgcn_mfma_f32_32x32x16_bf16(pa3, PK(l3, h3), o[0], 0, 0, 0);
#undef PK
  }
  pv_one<1>(o[1], vb, pa0, pa1, pa2, pa3); pv_one<2>(o[2], vb, pa0, pa1, pa2, pa3); pv_one<3>(o[3], vb, pa0, pa1, pa2, pa3);
}
struct VFrag { s16x4 l0, h0, l1, h1, l2, h2, l3, h3; };
typedef short v4i16_t __attribute__((ext_vector_type(4)));
template <int OFF> __device__ __forceinline__ s16x4 tr_read_b(int vb) {
  return __builtin_bit_cast(s16x4, __builtin_amdgcn_ds_read_tr16_b64_v4i16((LAS v4i16_t*)(uintptr_t)(unsigned)(vb + OFF)));
}
template <int D0> __device__ __forceinline__ void tr8b(VFrag& f, int vb) {
  f.l0 = tr_read_b<v_rd_off(D0, 0, 0)>(vb); f.h0 = tr_read_b<v_rd_off(D0, 0, 1)>(vb); f.l1 = tr_read_b<v_rd_off(D0, 1, 0)>(vb); f.h1 = tr_read_b<v_rd_off(D0, 1, 1)>(vb);
  f.l2 = tr_read_b<v_rd_off(D0, 2, 0)>(vb); f.h2 = tr_read_b<v_rd_off(D0, 2, 1)>(vb); f.l3 = tr_read_b<v_rd_off(D0, 3, 0)>(vb); f.h3 = tr_read_b<v_rd_off(D0, 3, 1)>(vb);
}
template <int D0> __device__ __forceinline__ void tr8(VFrag& f, int vb) {
  f.l0 = tr_read<v_rd_off(D0, 0, 0)>(vb); f.h0 = tr_read<v_rd_off(D0, 0, 1)>(vb); f.l1 = tr_read<v_rd_off(D0, 1, 0)>(vb); f.h1 = tr_read<v_rd_off(D0, 1, 1)>(vb);
  f.l2 = tr_read<v_rd_off(D0, 2, 0)>(vb); f.h2 = tr_read<v_rd_off(D0, 2, 1)>(vb); f.l3 = tr_read<v_rd_off(D0, 3, 0)>(vb); f.h3 = tr_read<v_rd_off(D0, 3, 1)>(vb);
}
__device__ __forceinline__ void mfma4(f32x16& od, VFrag& f, bf16x8 pa0, bf16x8 pa1, bf16x8 pa2, bf16x8 pa3) {
#define PK(L, H) (bf16x8){L[0], L[1], L[2], L[3], H[0], H[1], H[2], H[3]}
  od = __builtin_amdgcn_mfma_f32_32x32x16_bf16(pa0, PK(f.l0, f.h0), od, 0, 0, 0);
  od = __builtin_amdgcn_mfma_f32_32x32x16_bf16(pa1, PK(f.l1, f.h1), od, 0, 0, 0);
  od = __builtin_amdgcn_mfma_f32_32x32x16_bf16(pa2, PK(f.l2, f.h2), od, 0, 0, 0);
  od = __builtin_amdgcn_mfma_f32_32x32x16_bf16(pa3, PK(f.l3, f.h3), od, 0, 0, 0);
#undef PK
}
#define VF_TIE(f) "+v"(f.l0), "+v"(f.h0), "+v"(f.l1), "+v"(f.h1), "+v"(f.l2), "+v"(f.h2), "+v"(f.l3), "+v"(f.h3)
__device__ __forceinline__ void pv_pipe(f32x16* o, int vb, bf16x8 pa0, bf16x8 pa1, bf16x8 pa2, bf16x8 pa3) {
  VFrag A, B;
  asm volatile("s_waitcnt lgkmcnt(0)" ::: "memory");
  tr8<0>(A, vb); tr8<1>(B, vb);
  asm volatile("s_waitcnt lgkmcnt(8)" : VF_TIE(A) :: "memory");
  mfma4(o[0], A, pa0, pa1, pa2, pa3);
  tr8<2>(A, vb);
  asm volatile("s_waitcnt lgkmcnt(8)" : VF_TIE(B) :: "memory");
  mfma4(o[1], B, pa0, pa1, pa2, pa3);
  tr8<3>(B, vb);
  asm volatile("s_waitcnt lgkmcnt(8)" : VF_TIE(A) :: "memory");
  mfma4(o[2], A, pa0, pa1, pa2, pa3);
  asm volatile("s_waitcnt lgkmcnt(0)" : VF_TIE(B) :: "memory");
  mfma4(o[3], B, pa0, pa1, pa2, pa3);
}
template <bool ONES = true> __device__ __forceinline__ void pv_psm_lean(f32x16* o, int vb, bf16x8 pa0, bf16x8 pa1, bf16x8 pa2, bf16x8 pa3, f32x16& p0, f32x16& p1, f32x16& nm, float& alpha) {
  constexpr float THR2 = 11.541560327111707f;
  const bf16x8 one8 = {0x3F80, 0x3F80, 0x3F80, 0x3F80, 0x3F80, 0x3F80, 0x3F80, 0x3F80};
  VFrag A, B;
  asm volatile("s_waitcnt lgkmcnt(0)" ::: "memory");
  tr8<0>(A, vb); tr8<1>(B, vb);
  asm volatile("s_waitcnt lgkmcnt(8)" : VF_TIE(A) :: "memory");
  mfma4(o[0], A, pa0, pa1, pa2, pa3);
  float dmax = p0[0];
#pragma unroll
  for (int r = 1; r < 16; ++r) dmax = fmaxf(dmax, p0[r]);
  tr8<2>(A, vb);
  asm volatile("s_waitcnt lgkmcnt(8)" : VF_TIE(B) :: "memory");
  mfma4(o[1], B, pa0, pa1, pa2, pa3);
#pragma unroll
  for (int r = 0; r < 16; ++r) dmax = fmaxf(dmax, p1[r]);
  { auto rr = __builtin_amdgcn_permlane32_swap(__float_as_uint(dmax), __float_as_uint(dmax), false, false);
    dmax = fmaxf(__uint_as_float(rr[0]), __uint_as_float(rr[1])); }
  alpha = 1.f;
  if (!__all(dmax <= THR2)) {
    const float delta = dmax > THR2 ? dmax : 0.f; alpha = __builtin_amdgcn_exp2f(-delta);
#pragma unroll
    for (int r = 0; r < 16; ++r) { p0[r] -= delta; p1[r] -= delta; nm[r] -= delta; }
  }
  tr8<3>(B, vb);
  asm volatile("s_waitcnt lgkmcnt(8)" : VF_TIE(A) :: "memory");
  mfma4(o[2], A, pa0, pa1, pa2, pa3);
#pragma unroll
  for (int r = 0; r < 8; ++r) p0[r] = __builtin_amdgcn_exp2f(p0[r]);
  asm volatile("s_waitcnt lgkmcnt(0)" : VF_TIE(B) :: "memory");
  mfma4(o[3], B, pa0, pa1, pa2, pa3);
#pragma unroll
  for (int r = 8; r < 16; ++r) p0[r] = __builtin_amdgcn_exp2f(p0[r]);
  if constexpr (ONES) { o[4] = __builtin_amdgcn_mfma_f32_32x32x16_bf16(pa0, one8, o[4], 0, 0, 0); o[4] = __builtin_amdgcn_mfma_f32_32x32x16_bf16(pa1, one8, o[4], 0, 0, 0);
  o[4] = __builtin_amdgcn_mfma_f32_32x32x16_bf16(pa2, one8, o[4], 0, 0, 0); o[4] = __builtin_amdgcn_mfma_f32_32x32x16_bf16(pa3, one8, o[4], 0, 0, 0); }
}
template <bool ONES = true, bool PRE = false> __device__ __forceinline__ void pv_psm_lean_b(f32x16* o, int vb, bf16x8 pa0, bf16x8 pa1, bf16x8 pa2, bf16x8 pa3, f32x16& p0, f32x16& p1, f32x16& nm, float& alpha, const VFrag* pre = nullptr) {
  constexpr float THR2 = 11.541560327111707f;
  const bf16x8 one8 = {0x3F80, 0x3F80, 0x3F80, 0x3F80, 0x3F80, 0x3F80, 0x3F80, 0x3F80};
  VFrag A, B;
  if constexpr (PRE) A = *pre; else tr8b<0>(A, vb);
  tr8b<1>(B, vb);
  mfma4(o[0], A, pa0, pa1, pa2, pa3);
  float dmax = p0[0];
#pragma unroll
  for (int r = 1; r < 16; ++r) dmax = fmaxf(dmax, p0[r]);
  tr8b<2>(A, vb);
  mfma4(o[1], B, pa0, pa1, pa2, pa3);
#pragma unroll
  for (int r = 0; r < 16; ++r) dmax = fmaxf(dmax, p1[r]);
  { auto rr = __builtin_amdgcn_permlane32_swap(__float_as_uint(dmax), __float_as_uint(dmax), false, false);
    dmax = fmaxf(__uint_as_float(rr[0]), __uint_as_float(rr[1])); }
  alpha = 1.f;
  if (!__all(dmax <= THR2)) {
    const float delta = dmax > THR2 ? dmax : 0.f; alpha = __builtin_amdgcn_exp2f(-delta);
#pragma unroll
    for (int r = 0; r < 16; ++r) { p0[r] -= delta; p1[r] -= delta; nm[r] -= delta; }
  }
  tr8b<3>(B, vb);
  mfma4(o[2], A, pa0, pa1, pa2, pa3);
#pragma unroll
  for (int r = 0; r < 8; ++r) p0[r] = __builtin_amdgcn_exp2f(p0[r]);
  mfma4(o[3], B, pa0, pa1, pa2, pa3);
#pragma unroll
  for (int r = 8; r < 16; ++r) p0[r] = __builtin_amdgcn_exp2f(p0[r]);
  if constexpr (ONES) { o[4] = __builtin_amdgcn_mfma_f32_32x32x16_bf16(pa0, one8, o[4], 0, 0, 0); o[4] = __builtin_amdgcn_mfma_f32_32x32x16_bf16(pa1, one8, o[4], 0, 0, 0);
  o[4] = __builtin_amdgcn_mfma_f32_32x32x16_bf16(pa2, one8, o[4], 0, 0, 0); o[4] = __builtin_amdgcn_mfma_f32_32x32x16_bf16(pa3, one8, o[4], 0, 0, 0); }
}
struct VStep { s16x4 l0, h0, l1, h1, l2, h2, l3, h3; };
template <int KS> __device__ __forceinline__ void trstep(VStep& f, int vb) {
  f.l0 = tr_read_b<v_rd_off(0, KS, 0)>(vb); f.h0 = tr_read_b<v_rd_off(0, KS, 1)>(vb); f.l1 = tr_read_b<v_rd_off(1, KS, 0)>(vb); f.h1 = tr_read_b<v_rd_off(1, KS, 1)>(vb);
  f.l2 = tr_read_b<v_rd_off(2, KS, 0)>(vb); f.h2 = tr_read_b<v_rd_off(2, KS, 1)>(vb); f.l3 = tr_read_b<v_rd_off(3, KS, 0)>(vb); f.h3 = tr_read_b<v_rd_off(3, KS, 1)>(vb);
}
__device__ __forceinline__ void mfma5(f32x16* o, const VStep& f, bf16x8 pa) {
  const bf16x8 one8 = {0x3F80, 0x3F80, 0x3F80, 0x3F80, 0x3F80, 0x3F80, 0x3F80, 0x3F80};
#define PK(L, H) (bf16x8){L[0], L[1], L[2], L[3], H[0], H[1], H[2], H[3]}
  o[0] = __builtin_amdgcn_mfma_f32_32x32x16_bf16(pa, PK(f.l0, f.h0), o[0], 0, 0, 0);
  o[1] = __builtin_amdgcn_mfma_f32_32x32x16_bf16(pa, PK(f.l1, f.h1), o[1], 0, 0, 0);
  o[2] = __builtin_amdgcn_mfma_f32_32x32x16_bf16(pa, PK(f.l2, f.h2), o[2], 0, 0, 0);
  o[3] = __builtin_amdgcn_mfma_f32_32x32x16_bf16(pa, PK(f.l3, f.h3), o[3], 0, 0, 0);
  o[4] = __builtin_amdgcn_mfma_f32_32x32x16_bf16(pa, one8, o[4], 0, 0, 0);
#undef PK
}
template <int BASE> __device__ __forceinline__ bf16x8 pk4e(const f32x16& P) {
  const float e0 = __builtin_amdgcn_exp2f(P[BASE + 0]), e1 = __builtin_amdgcn_exp2f(P[BASE + 1]), e2 = __builtin_amdgcn_exp2f(P[BASE + 2]), e3 = __builtin_amdgcn_exp2f(P[BASE + 3]);
  const float e4 = __builtin_amdgcn_exp2f(P[BASE + 4]), e5 = __builtin_amdgcn_exp2f(P[BASE + 5]), e6 = __builtin_amdgcn_exp2f(P[BASE + 6]), e7 = __builtin_amdgcn_exp2f(P[BASE + 7]);
  const unsigned a0 = cvtpk(e0, e1), a1 = cvtpk(e2, e3), b0 = cvtpk(e4, e5), b1 = cvtpk(e6, e7);
  const auto r0 = __builtin_amdgcn_permlane32_swap(a0, b0, false, false); const auto r1 = __builtin_amdgcn_permlane32_swap(a1, b1, false, false);
  u32x4 w = {r0[0], r1[0], r0[1], r1[1]}; return *reinterpret_cast<bf16x8*>(&w);
}
__device__ __forceinline__ float rowmax_lean(const f32x16& p0, const f32x16& p1) {
  float d = p0[0];
#pragma unroll
  for (int r = 1; r < 16; ++r) d = fmaxf(d, p0[r]);
#pragma unroll
  for (int r = 0; r < 16; ++r) d = fmaxf(d, p1[r]);
  const auto rr = __builtin_amdgcn_permlane32_swap(__float_as_uint(d), __float_as_uint(d), false, false);
  return fmaxf(__uint_as_float(rr[0]), __uint_as_float(rr[1]));
}
__device__ __forceinline__ void shift_lean(float dmax, f32x16& p0, f32x16& p1, f32x16& nm, float& alpha, const bool first) {
  constexpr float THR2 = 11.541560327111707f;
  alpha = 1.f;
  if (first || !__all(dmax <= THR2)) {
    const float delta = first ? dmax : (dmax > THR2 ? dmax : 0.f);
    if (!first) alpha = __builtin_amdgcn_exp2f(-delta);
#pragma unroll
    for (int r = 0; r < 16; ++r) { p0[r] -= delta; p1[r] -= delta; nm[r] -= delta; }
  }
}
#define SGB(mask, n) __builtin_amdgcn_sched_group_barrier((mask), (n), 0)
__device__ __forceinline__ bf16x8 ld8(const bf16* p) { return *reinterpret_cast<const bf16x8*>(p); }

template <int MODE, int ATTV = 0>
__device__ __forceinline__ void attn_unit(const bf16* __restrict__ Qrow0, int ldq, const bf16* __restrict__ Kb, const bf16* __restrict__ Vb, int ldk, const bf16* __restrict__ KRb,
                                          int b, int nct, int NT, bf16* __restrict__ Ob, float lam, const float* __restrict__ subln, float oscale, LAS unsigned char* lds_, const int tid_in) {
  constexpr bool LEAN = ((MODE == 1) && ATT_LEAN) || ((MODE == 0) && ATT_LEAN0); constexpr bool LSUM = LEAN && ATT_LSUM && (MODE == 1); constexpr int NQF = MODE == 0 ? 12 : 4, NQR = MODE == 0 ? 4 : ATT_DA_NQR, NOB = (LEAN && !(ATT_LSUM && MODE == 1)) ? 5 : 4, PITCH = MODE == 0 ? 384 : 256, SHM_V = 16384, SHM_K = 64 * PITCH, SDEPTH = ATT_SDEPTH(MODE); constexpr bool PVPIPE = ATT_PVPIPE(MODE);
  const float SCALE = MODE == 0 ? 0.07216878364870323f : 0.125f;
  const float C = SCALE * 1.4426950408889634f, THRS = 8.f / SCALE;
  if (ATT_PRIO) { if (__builtin_amdgcn_readfirstlane(tid_in >> 8) != 0) __builtin_amdgcn_s_setprio(1); }
  const int tid = launder_v(tid_in) & 511, wid = tid >> 6, lane = tid & 63, r32 = lane & 31, hi = lane >> 5;
  LAS char* lds = (LAS char*)(LAS unsigned char*)lds_;
  constexpr bool THREE = (MODE == 1) && ATT_3STAGE; constexpr int NSTG = THREE ? 3 : 2, STG = SHM_V + SHM_K, SCR0 = NSTG * STG;
#define VOFF(s) (!THREE ? (s) * SHM_V : (s) * STG)
#define KOFF(s) (!THREE ? 2 * SHM_V + (s) * SHM_K : (s) * STG + SHM_V)
  LAS char* V_lds = lds; LAS char* K_lds = lds;
  LAS float* wsf = (LAS float*)(lds + NSTG * (SHM_V + SHM_K)) + wid * 64; LAS float* li_l = wsf; LAS float* al_l = wsf + 32;
  const int wq = MODE == 0 ? wid : (wid & 3), sgrp = MODE == 0 ? 0 : (wid >> 2);
  float m_reg = -1e30f, l_reg = 0; f32x16 o[NOB] = {}; bf16x8 qr[NQR > 0 ? NQR : 1]; f32x16 nm = {};
  LAS char* ql = lds + SCR0 + 2048 + wid * (MODE == 0 ? 8192 : 4096) + lane * 16;
  const bf16* Qw = Qrow0 + (size_t)(wq * 32 + r32) * ldq + sgrp * 64 + hi * 8;
#define QLOADS() do { _Pragma("unroll") for (int d0 = 0; d0 < NQR; ++d0) { qr[d0] = ld8(Qw + d0 * 16); if (LEAN) qr[d0] = scale_bf16x8(qr[d0], C); } \
    _Pragma("unroll") for (int d0 = NQR; d0 < NQF; ++d0) { bf16x8 qv = ld8(Qw + d0 * 16); if (LEAN) qv = scale_bf16x8(qv, C); *(LAS bf16x8*)(ql + (d0 - NQR) * 1024) = qv; } } while (0)
  constexpr bool QLATE = ATT_QLATE && !((MODE == 1) && ATT_3STAGE) && !((MODE == 1) && ATT_LEAN && ATT_KMAJOR && (ATTV == 0));
  if (!QLATE) QLOADS();
  const int sr = tid >> 4, sc = (tid & 15) * 8;
  const int srv = ATT_VSTCF ? (tid >> 6) * 4 + ((tid >> 2) & 3) : sr, scv = ATT_VSTCF ? ((tid >> 4) & 3) * 32 + (tid & 3) * 8 : sc;
  const int vst0 = v_st(srv, scv), vst1 = v_st(32 + srv, scv);
  const int kst0 = sr * PITCH + (((tid & 15) ^ kswz<PITCH>(sr)) * 16), kst1 = kst0 + 32 * PITCH;
  const int rrow = tid >> 3, krs = rrow * PITCH + (((16 + (tid & 7)) ^ kswz<PITCH>(rrow)) * 16);
  const int chunk0 = sgrp * 8;
  const int vb0 = (int)(uintptr_t)V_lds + v_rd_base(lane);
  struct Slot { bf16x8 vs0, vs1, ks0, ks1, kr; } sr_[SDEPTH];
#define KROW(jt) ((jt) < nct ? (ML + b * CTXL + (jt) * 64) : (b * SEQ + ((jt) - nct) * 64))
#define SLOAD(i, jt) do { const int k0_ = KROW(jt); sr_[i].vs0 = ld8(Vb + (size_t)(k0_ + srv) * ldk + scv); sr_[i].vs1 = ld8(Vb + (size_t)(k0_ + 32 + srv) * ldk + scv); \
    sr_[i].ks0 = ld8(Kb + (size_t)(k0_ + sr) * ldk + sc); sr_[i].ks1 = ld8(Kb + (size_t)(k0_ + 32 + sr) * ldk + sc); \
    if (MODE == 0) sr_[i].kr = ld8(KRb + (size_t)(k0_ + rrow) * 64 + (tid & 7) * 8); } while (0)
#define SWRITE(bf, i) do { *(LAS bf16x8*)(V_lds + VOFF(bf) + vst0) = sr_[i].vs0; *(LAS bf16x8*)(V_lds + VOFF(bf) + vst1) = sr_[i].vs1; \
    *(LAS bf16x8*)(K_lds + KOFF(bf) + kst0) = sr_[i].ks0; *(LAS bf16x8*)(K_lds + KOFF(bf) + kst1) = sr_[i].ks1; \
    if (MODE == 0) *(LAS bf16x8*)(K_lds + KOFF(bf) + krs) = sr_[i].kr; } while (0)
#define SWAIT() do { if constexpr (SDEPTH == 2) asm volatile("s_waitcnt vmcnt(4)" ::: "memory"); else asm volatile("s_waitcnt vmcnt(0)" ::: "memory"); } while (0)
#define RESC(a) do { if (__any((a) < 1.f)) { if constexpr (LSUM) l_reg *= (a); if (hi == 0) al_l[r32] = (a); asm volatile("s_waitcnt lgkmcnt(0)" ::: "memory"); \
    _Pragma("unroll") for (int d = 0; d < NOB; ++d) _Pragma("unroll") for (int r = 0; r < 16; ++r) o[d][r] *= al_l[crow(r, hi)]; } } while (0)
#define PV(vb_) do { if constexpr (ATTV == 2) { o[0][0] += __uint_as_float((unsigned)pa0[0] + (unsigned)pa3[1]); } else if constexpr (PVPIPE) pv_pipe(o, (vb_), pa0, pa1, pa2, pa3); else pv_d0(o, (vb_), pa0, pa1, pa2, pa3); \
    if constexpr (LEAN && !LSUM) { const bf16x8 one8 = {0x3F80, 0x3F80, 0x3F80, 0x3F80, 0x3F80, 0x3F80, 0x3F80, 0x3F80};     \
        o[NOB - 1] = __builtin_amdgcn_mfma_f32_32x32x16_bf16(pa0, one8, o[NOB - 1], 0, 0, 0); o[NOB - 1] = __builtin_amdgcn_mfma_f32_32x32x16_bf16(pa1, one8, o[NOB - 1], 0, 0, 0); \
        o[NOB - 1] = __builtin_amdgcn_mfma_f32_32x32x16_bf16(pa2, one8, o[NOB - 1], 0, 0, 0); o[NOB - 1] = __builtin_amdgcn_mfma_f32_32x32x16_bf16(pa3, one8, o[NOB - 1], 0, 0, 0); } } while (0)
#define PSM(p0_, p1_, mn_, al_, first_) do { if constexpr (ATTV == 1) { al_ = 1.f; } else if constexpr (LEAN) partialSM_lean(p0_, p1_, nm, al_, first_); else partialSM(p0_, p1_, m_reg, mn_, al_, C, THRS); } while (0)
#define FSM(p0_, p1_, al_) do { if constexpr (ATTV == 1) { u32x4 w0_ = {__float_as_uint(p0_[0]), __float_as_uint(p0_[1]), __float_as_uint(p1_[0]), __float_as_uint(p1_[1])}; pa0 = pa1 = pa2 = pa3 = *reinterpret_cast<bf16x8*>(&w0_); } else if constexpr (LEAN) finishSM_lean<LSUM>(p0_, p1_, pa0, pa1, pa2, pa3, l_reg); else finishSM(p0_, p1_, al_, l_reg, pa0, pa1, pa2, pa3); } while (0)
#define QKT(p0_, p1_, Kp_) do { if constexpr (ATTV == 5) { p0_ = nm; p1_ = nm; p0_[0] += (float)r32; } else if constexpr (LEAN) qkt<NQF, NQR, PITCH>(p0_, p1_, Kp_, chunk0, qr, ql, r32, hi, nm); else qkt<NQF, NQR, PITCH>(p0_, p1_, Kp_, chunk0, qr, ql, r32, hi); } while (0)
  f32x16 pA0, pA1, pB0, pB1; float mnA, mnB, alA, alB; bf16x8 pa0, pa1, pa2, pa3;
  constexpr bool KMAJ = (MODE == 1) && LEAN && ATT_KMAJOR && (ATTV == 0) && !THREE;
  if constexpr (KMAJ) {
    VStep VA, VB;
#define KSTEPS(PC0, PC1, ALC, PP0, PP1, KC, VP, LD, DOQK) do { const int vb_ = vb0 + VOFF(VP); float dmx_ = 0.f; \
      SBAR(); \
      if (DOQK) QKT(PC0, PC1, K_lds + KOFF(KC)); \
      pa0 = pk4e<0>(PP0); trstep<0>(VA, vb_); \
      _Pragma("unroll") for (int i_ = 0; i_ < 8; ++i_) { SGB(0x008, 1); SGB(0x100, 3); SGB(0x002, 2); } \
      SBAR(); LD; SBAR(); \
      mfma5(o, VA, pa0); pa1 = pk4e<8>(PP0); trstep<1>(VB, vb_); \
      _Pragma("unroll") for (int i_ = 0; i_ < 5; ++i_) { SGB(0x008, 1); SGB(0x100, 2); SGB(0x002, 3); } \
      SBAR(); \
      mfma5(o, VB, pa1); pa2 = pk4e<0>(PP1); trstep<2>(VA, vb_); \
      _Pragma("unroll") for (int i_ = 0; i_ < 5; ++i_) { SGB(0x008, 1); SGB(0x100, 2); SGB(0x002, 3); } \
      SBAR(); \
      mfma5(o, VA, pa2); pa3 = pk4e<8>(PP1); trstep<3>(VB, vb_); \
      _Pragma("unroll") for (int i_ = 0; i_ < 5; ++i_) { SGB(0x008, 1); SGB(0x100, 2); SGB(0x002, 3); } \
      SBAR(); \
      mfma5(o, VB, pa3); if (DOQK) dmx_ = rowmax_lean(PC0, PC1); \
      _Pragma("unroll") for (int i_ = 0; i_ < 5; ++i_) { SGB(0x008, 1); SGB(0x002, 7); } \
      SBAR(); \
      if (DOQK) shift_lean(dmx_, PC0, PC1, nm, ALC, false); } while (0)
    SLOAD(0, 0); asm volatile("s_waitcnt vmcnt(0)" ::: "memory"); SWRITE(0, 0); __syncthreads();
    QKT(pA0, pA1, K_lds + KOFF(0)); shift_lean(rowmax_lean(pA0, pA1), pA0, pA1, nm, alA, true);
    SLOAD(0, 1); asm volatile("s_waitcnt vmcnt(0)" ::: "memory"); SWRITE(1, 0); __syncthreads();
    for (int j = 1; j + 1 < NT; j += 2) {
      KSTEPS(pB0, pB1, alB, pA0, pA1, 1, 0, SLOAD(0, j + 1), true);
      __syncthreads(); asm volatile("s_waitcnt vmcnt(0)" ::: "memory"); SWRITE(0, 0);
      RESC(alB); __syncthreads();
      KSTEPS(pA0, pA1, alA, pB0, pB1, 0, 1, SLOAD(0, j + 2), true);
      __syncthreads(); asm volatile("s_waitcnt vmcnt(0)" ::: "memory"); SWRITE(1, 0);
      RESC(alA); __syncthreads();
    }
    KSTEPS(pB0, pB1, alB, pA0, pA1, 1, 0, (void)0, true);
    __syncthreads(); RESC(alB);
    KSTEPS(pA0, pA1, alA, pB0, pB1, 0, 1, (void)0, false);
#undef KSTEPS
  } else if constexpr (!THREE) {
  constexpr int SE = 0, SO = SDEPTH - 1;
  SLOAD(SE, 0); if (QLATE) QLOADS(); asm volatile("s_waitcnt vmcnt(0)" ::: "memory"); SWRITE(0, SE);
  if constexpr (QLATE && SDEPTH == 1) SLOAD(SO, 1);
  __syncthreads();
  QKT(pA0, pA1, K_lds + KOFF(0)); PSM(pA0, pA1, mnA, alA, true);
  if constexpr (!(QLATE && SDEPTH == 1)) SLOAD(SO, 1);
  if constexpr (SDEPTH == 2) { if (2 < NT) SLOAD(SE, 2); }
  SWAIT(); SWRITE(1, SO); __syncthreads();
#define ILV() do { if constexpr (PVPIPE) { _Pragma("unroll") for (int i_ = 0; i_ < 20; ++i_) { __builtin_amdgcn_sched_group_barrier(0x008, 1, 0); __builtin_amdgcn_sched_group_barrier(0x002, 5, 0); } } } while (0)
#define LSLOAD(i, jt) do { if constexpr (ATTV != 3) SLOAD(i, jt); } while (0)
#define LSWRITE(bf, i) do { if constexpr (ATTV != 3) SWRITE(bf, i); } while (0)
#define LSWAIT() do { if constexpr (ATTV != 3) SWAIT(); } while (0)
#define LSYNC() do { if constexpr (ATTV != 4) __syncthreads(); } while (0)
#define HALFSTEP(PC0, PC1, MNC, ALC, PP0, PP1, ALP, KC, VP, LD) do { \
    if (!STAG || wid < 4) { \
      VFrag vpre_; VHalf vh_; SBAR(); if constexpr (VPRE) tr8b<0>(vpre_, vb0 + VOFF(VP)); \
      if constexpr (VPRE0) { vh_.l0 = tr_read_b<v_rd_off(0, 0, 0)>(vb0 + VOFF(VP)); vh_.h0 = tr_read_b<v_rd_off(0, 0, 1)>(vb0 + VOFF(VP)); vh_.l1 = tr_read_b<v_rd_off(0, 1, 0)>(vb0 + VOFF(VP)); vh_.h1 = tr_read_b<v_rd_off(0, 1, 1)>(vb0 + VOFF(VP)); } \
      if constexpr (ATT_FSMFIRST) { FSM(PP0, PP1, ALP); QKT(PC0, PC1, K_lds + KOFF(KC)); } else { QKT(PC0, PC1, K_lds + KOFF(KC)); FSM(PP0, PP1, ALP); } SBAR(); \
      LD; SBAR(); \
      if constexpr (PVPIPE && LEAN && ATTV == 0) { if constexpr (VPRE) pv_psm_lean_b<!LSUM, true>(o, vb0 + VOFF(VP), pa0, pa1, pa2, pa3, PC0, PC1, nm, ALC, &vpre_); else if constexpr (ATT_TRB) pv_psm_lean_b<!LSUM>(o, vb0 + VOFF(VP), pa0, pa1, pa2, pa3, PC0, PC1, nm, ALC); else pv_psm_lean<!LSUM>(o, vb0 + VOFF(VP), pa0, pa1, pa2, pa3, PC0, PC1, nm, ALC); } else { if constexpr (VPRE0) pv_d0_pre(o, vb0 + VOFF(VP), pa0, pa1, pa2, pa3, vh_); else PV(vb0 + VOFF(VP)); PSM(PC0, PC1, MNC, ALC, false); } \
    } else { \
      SBAR(); FSM(PP0, PP1, ALP); SBAR(); \
      LD; SBAR(); \
      PV(vb0 + VOFF(VP)); SBAR(); \
      QKT(PC0, PC1, K_lds + KOFF(KC)); SBAR(); \
      PSM(PC0, PC1, MNC, ALC, false); \
    } } while (0)
  constexpr bool STAG = (MODE == 1) && ATT_STAGGER && ATTV == 0;
  constexpr bool VPRE = ATT_VPRE && PVPIPE && LEAN && LSUM && ATT_TRB && (ATTV == 0);
  constexpr bool VPRE0 = ATT_VPRE0 && (MODE == 0) && !PVPIPE && !LEAN && (ATTV == 0);
  for (int j = 1; j + 1 < NT; j += 2) {
    HALFSTEP(pB0, pB1, mnB, alB, pA0, pA1, alA, 1, 0, LSLOAD(SO, j + SDEPTH));
    LSYNC(); LSWAIT(); LSWRITE(0, SE);
    RESC(alB); LSYNC();
    HALFSTEP(pA0, pA1, mnA, alA, pB0, pB1, alB, 0, 1, if (SDEPTH == 1 || j + 3 < NT) LSLOAD(SE, j + 1 + SDEPTH));
    LSYNC(); LSWAIT(); LSWRITE(1, SO);
    RESC(alA); LSYNC();
  }
#undef HALFSTEP
#undef ILV
#undef LSLOAD
#undef LSWRITE
#undef LSWAIT
#undef LSYNC
  SBAR(); QKT(pB0, pB1, K_lds + KOFF(1));
  FSM(pA0, pA1, alA); SBAR();
  PV(vb0); PSM(pB0, pB1, mnB, alB, false);
  __syncthreads(); RESC(alB);
  FSM(pB0, pB1, alB); SBAR();
  PV(vb0 + VOFF(1));
  } else {
#define STEP(PC0, PC1, ALC, PP0, PP1, ALP, jj, SP, SC, SN) do { const int j_ = (jj); \
      if (j_ + 1 < NT) { asm volatile("s_waitcnt vmcnt(0)" ::: "memory"); SWRITE(SN, 0); if (j_ + 2 < NT) SLOAD(0, j_ + 2); } \
      SBAR(); QKT(PC0, PC1, K_lds + KOFF(SC)); FSM(PP0, PP1, ALP); SBAR(); \
      PV(vb0 + VOFF(SP)); PSM(PC0, PC1, mnA, ALC, false); \
      RESC(ALC); __syncthreads(); } while (0)
    SLOAD(0, 0); asm volatile("s_waitcnt vmcnt(0)" ::: "memory"); SWRITE(0, 0);
    SLOAD(0, 1); asm volatile("s_waitcnt vmcnt(0)" ::: "memory"); SWRITE(1, 0);
    SLOAD(0, 2); __syncthreads();
    QKT(pA0, pA1, K_lds + KOFF(0)); PSM(pA0, pA1, mnA, alA, true);
    STEP(pB0, pB1, alB, pA0, pA1, alA, 1, 0, 1, 2);
    int j = 2;
    for (; j + 5 < NT; j += 6) {
      STEP(pA0, pA1, alA, pB0, pB1, alB, j, 1, 2, 0);
      STEP(pB0, pB1, alB, pA0, pA1, alA, j + 1, 2, 0, 1);
      STEP(pA0, pA1, alA, pB0, pB1, alB, j + 2, 0, 1, 2);
      STEP(pB0, pB1, alB, pA0, pA1, alA, j + 3, 1, 2, 0);
      STEP(pA0, pA1, alA, pB0, pB1, alB, j + 4, 2, 0, 1);
      STEP(pB0, pB1, alB, pA0, pA1, alA, j + 5, 0, 1, 2);
    }
    if (j < NT) { STEP(pA0, pA1, alA, pB0, pB1, alB, j, 1, 2, 0); STEP(pB0, pB1, alB, pA0, pA1, alA, j + 1, 2, 0, 1); j += 2; }
    if (j < NT) { STEP(pA0, pA1, alA, pB0, pB1, alB, j, 0, 1, 2); STEP(pB0, pB1, alB, pA0, pA1, alA, j + 1, 1, 2, 0); j += 2; }
    FSM(pB0, pB1, alB); SBAR();
    { const int sl = (NT - 1) % 3; PV(vb0 + VOFF(sl)); }
#undef STEP
  }
  float rli[16];
  if constexpr (LEAN && !LSUM) {
#pragma unroll
    for (int r = 0; r < 16; ++r) rli[r] = __builtin_amdgcn_rcpf(o[NOB - 1][r]);
  } else {
    if constexpr (LSUM) l_reg += __uint_as_float(lane_xor32(__float_as_uint(l_reg), lane));
    if (hi == 0) li_l[r32] = l_reg; asm volatile("s_waitcnt lgkmcnt(0)" ::: "memory");
#pragma unroll
    for (int r = 0; r < 16; ++r) rli[r] = __builtin_amdgcn_rcpf(li_l[crow(r, hi)]);
  }
  bf16* Ow = Ob + (size_t)(wq * 32) * DM;
  if constexpr (MODE == 0) {
#pragma unroll
    for (int r = 0; r < 16; ++r) { const int orow = crow(r, hi);
#pragma unroll
      for (int d0 = 0; d0 < 4; ++d0) Ow[(size_t)orow * DM + d0 * 32 + r32] = tobf1(o[d0][r] * rli[r]); }
    __syncthreads();
  } else {
    LAS float* ex = (LAS float*)lds;
    __syncthreads();
    if (sgrp == 1) {
#pragma unroll
      for (int r = 0; r < 16; ++r)
#pragma unroll
        for (int d0 = 0; d0 < 4; ++d0) ex[(wq * 32 + crow(r, hi)) * 128 + d0 * 32 + r32] = o[d0][r] * rli[r];
    }
    __syncthreads();
    if (sgrp == 0) {
#pragma unroll
      for (int r = 0; r < 16; ++r) { const int orow = crow(r, hi); float dd[4]; float ss = 0.f;
#pragma unroll
        for (int d0 = 0; d0 < 4; ++d0) { dd[d0] = o[d0][r] * rli[r] - lam * ex[(wq * 32 + orow) * 128 + d0 * 32 + r32]; ss += dd[d0] * dd[d0]; }
        ss = half_sum32(ss);
        const float rs = oscale / sqrtf(ss * (1.0f / 128.0f) + LN_EPS);
#pragma unroll
        for (int d0 = 0; d0 < 4; ++d0) Ow[(size_t)orow * DM + d0 * 32 + r32] = tobf1(dd[d0] * rs * subln[d0 * 32 + r32]); }
    }
    __syncthreads();
  }
  if (ATT_PRIO) __builtin_amdgcn_s_setprio(0);
#undef VOFF
#undef KOFF
#undef PV
#undef PSM
#undef FSM
#undef QKT
#undef KROW
#undef SLOAD
#undef SWRITE
#undef SWAIT
#undef RESC
}
}

__device__ __forceinline__ void mla_attn_phase(CP P, LAS unsigned char* lds, const int tid) {
    const bf16* QM = (const bf16*)(P->ws + WS_QM); const bf16* KV = (const bf16*)(P->ws + WS_KV); const bf16* KR = (const bf16*)(P->ws + WS_KR); bf16* Gb = (bf16*)(P->ws + WS_G);
    const int c = blockIdx.x, G = gridDim.x;
    for (int u = c; u < 1024 + 32; u += G) {
        int b, h, qrow0, NT;
        if (u < 1024) { const int i = u >> 8, cc = u & 255; const int bh = (cc & 7) + 8 * i, qb = cc >> 3; b = bh >> 4; h = bh & 15; qrow0 = b * SEQ + qb * 256; NT = 4 + 128; }
        else { const int bh = u - 1024; b = bh >> 4; h = bh & 15; qrow0 = ML + b * CTXL; NT = 4; }
        att::attn_unit<0>(QM + (size_t)qrow0 * 3072 + h * 192, 3072, KV + h * 256, KV + h * 256 + 128, 4096, KR, b, 4, NT, Gb + (size_t)qrow0 * DM + h * 128, 0.f, nullptr, 1.f, lds, tid);
    }
}
template <int ATTV = 0>
__device__ __forceinline__ void da_attn_phase(CP P, float lam, float oscale, LAS unsigned char* lds, const int tid, const bool ctx_q, const int nt_cap = 0) {
    const bf16* Z = (const bf16*)(P->ws + WS_Z); bf16* Gb = (bf16*)(P->ws + WS_G); const float* subln = P->in[27];
    const int c = blockIdx.x, G = gridDim.x;
    for (int u = c; u < 2048 + (ctx_q ? 64 : 0); u += G) {
        int b, h, qrow0, NT;
        if (u < 2048) { const int i = u >> 8, cc = u & 255; const int bh = (cc & 7) + 8 * (i >> 1), qb = (cc >> 3) + 32 * (i & 1); b = bh >> 4; h = bh & 15; qrow0 = b * SEQ + qb * 128; NT = 4 + 128; }
        else { const int v = u - 2048; const int bh = v >> 1; b = bh >> 4; h = bh & 15; qrow0 = ML + b * CTXL + (v & 1) * 128; NT = 4; }
        if (nt_cap) NT = nt_cap;
        att::attn_unit<1, ATTV>(Z + (size_t)qrow0 * 6144 + h * 128, 6144, Z + 2048 + h * 128, Z + 4096 + h * 128, 6144, nullptr, b, 4, NT, Gb + (size_t)qrow0 * DM + h * 128, lam, subln, oscale, lds, tid);
    }
}

__device__ __forceinline__ unsigned f2ord(float f) { const unsigned u = __float_as_uint(f); return u ^ ((unsigned)((int)u >> 31) | 0x80000000u); }
__device__ __forceinline__ float ord2f(unsigned k) { return __uint_as_float((k & 0x80000000u) ? (k ^ 0x80000000u) : ~k); }
__device__ __forceinline__ void ce_desc(unsigned& a, unsigned& b) { const unsigned mx = a > b ? a : b, mn = a > b ? b : a; a = mx; b = mn; }
template <int N, bool DESC> __device__ __forceinline__ void bitonic_merge(unsigned* a) {
#pragma unroll
    for (int j = N / 2; j > 0; j >>= 1)
#pragma unroll
        for (int i = 0; i < N; ++i) { const int l = i ^ j; if (l > i) { if (DESC) ce_desc(a[i], a[l]); else ce_desc(a[l], a[i]); } }
}
template <int N, bool DESC> __device__ __forceinline__ void bitonic_sort(unsigned* a) {
#pragma unroll
    for (int k = 2; k <= N; k <<= 1)
#pragma unroll
        for (int j = k >> 1; j > 0; j >>= 1)
#pragma unroll
            for (int i = 0; i < N; ++i) { const int l = i ^ j; if (l > i) { const bool up = ((i & k) == 0); if (up == DESC) ce_desc(a[i], a[l]); else ce_desc(a[l], a[i]); } }
}
__device__ __forceinline__ void top16_of_64(unsigned (&a)[64]) {
    bitonic_sort<16, true>(a); bitonic_sort<16, false>(a + 16); bitonic_sort<16, true>(a + 32); bitonic_sort<16, false>(a + 48);
#pragma unroll
    for (int i = 0; i < 16; ++i) a[i] = a[i] > a[16 + i] ? a[i] : a[16 + i];
    bitonic_merge<16, true>(a);
#pragma unroll
    for (int i = 0; i < 16; ++i) a[32 + i] = a[32 + i] > a[48 + i] ? a[32 + i] : a[48 + i];
    bitonic_merge<16, false>(a + 32);
#pragma unroll
    for (int i = 0; i < 16; ++i) a[i] = a[i] > a[32 + i] ? a[i] : a[32 + i];
    bitonic_merge<16, true>(a);
}
template <int PASS> __device__ __forceinline__ void route_qload(const bf16* QP, int tok, int head, int hi, bf16x8 (&qf)[8]) {
    const bf16* qp = QP + (size_t)tok * DM + head * 256 + PASS * 128 + hi * 8;
#pragma unroll
    for (int ks = 0; ks < 8; ++ks) qf[ks] = NT_ACT ? __builtin_nontemporal_load((const bf16x8*)(qp + ks * 16)) : *(const bf16x8*)(qp + ks * 16);
}
template <int PASS> __device__ __forceinline__ void route_pass(const bf16x8 (&qf)[8], const LAS char* lds, int tok, int head, int r32, int hi, unsigned (&top)[16]) {
    f32x16 acc[4] = {};
    const LAS char* Kl = lds + PASS * 32768;
#pragma unroll
    for (int kb = 0; kb < 4; ++kb)
#pragma unroll
        for (int ks = 0; ks < 8; ++ks) { const bf16x8 a = *(const LAS bf16x8*)(Kl + (kb * 32 + r32) * 256 + (((ks * 2 + hi) ^ (r32 & 15)) * 16));
            acc[kb] = __builtin_amdgcn_mfma_f32_32x32x16_bf16(a, qf[ks], acc[kb], 0, 0, 0); }
    unsigned key[64]; const unsigned base = 127u - 4u * (unsigned)hi;
#pragma unroll
    for (int kb = 0; kb < 4; ++kb)
#pragma unroll
        for (int r = 0; r < 16; ++r) key[kb * 16 + r] = (f2ord(acc[kb][r]) & ~127u) | (base - (unsigned)(kb * 32 + (r & 3) + 8 * (r >> 2)));
    top16_of_64(key);
    unsigned pr[16];
#pragma unroll
    for (int i = 0; i < 16; ++i) pr[i] = lane_xor32(key[15 - i], hi << 5);
#pragma unroll
    for (int i = 0; i < 16; ++i) key[i] = key[i] > pr[i] ? key[i] : pr[i];
    bitonic_merge<16, true>(key);
#pragma unroll
    for (int i = 0; i < 16; ++i) top[i] = key[i];
}
#ifndef ROUTE_SORT
#define ROUTE_SORT 1
#endif
#define DPP_U(v, ctrl) ((unsigned)__builtin_amdgcn_mov_dpp((int)(v), (ctrl), 0xF, 0xF, true))
template <int J> __device__ __forceinline__ unsigned lane_xor_u(unsigned v, int lane) {
    if (J == 1) return DPP_U(v, 0xB1);
    if (J == 2) return DPP_U(v, 0x4E);
    if (J == 4) { const unsigned t = DPP_U(v, 0x141); return DPP_U(t, 0x1B); }
    if (J == 8) { const unsigned t = DPP_U(v, 0x140); return DPP_U(t, 0x141); }
    if (J == 16) { const auto r = __builtin_amdgcn_permlane16_swap(v, v, false, false); return (lane & 16) ? r[0] : r[1]; }
    return lane_xor32(v, lane);
}
template <int K, int J> __device__ __forceinline__ void sort128_stage(unsigned& a0, unsigned& a1, int lane) {
    if constexpr (J == 64) { const unsigned mn = a0 < a1 ? a0 : a1, mx = a0 < a1 ? a1 : a0; a0 = mn; a1 = mx; }
    else { const unsigned p0 = lane_xor_u<J>(a0, lane), p1 = lane_xor_u<J>(a1, lane);
        const bool lower = (lane & J) == 0;
        const bool asc0 = (K >= 64) ? true : ((lane & K) == 0), asc1 = (K == 128) ? true : (K == 64 ? false : ((lane & K) == 0));
        const unsigned mn0 = a0 < p0 ? a0 : p0, mx0 = a0 < p0 ? p0 : a0, mn1 = a1 < p1 ? a1 : p1, mx1 = a1 < p1 ? p1 : a1;
        a0 = (lower == asc0) ? mn0 : mx0; a1 = (lower == asc1) ? mn1 : mx1; }
    if constexpr (J > 1) sort128_stage<K, J / 2>(a0, a1, lane);
    else if constexpr (K < 128) sort128_stage<K * 2, K>(a0, a1, lane);
}
__device__ __forceinline__ void sort128_asc(unsigned& a0, unsigned& a1, int lane) { sort128_stage<2, 1>(a0, a1, lane); }
__device__ __forceinline__ void route_phase(CP P, int L, int Mrows, LAS unsigned char* lds_, int tid, int lane, int wid, int gw, int NGW) {
    const bf16* QP = (const bf16*)(P->ws + WS_QP); unsigned* ROUTE = (unsigned*)(P->ws + WS_ROUTE);
    LAS char* lds = (LAS char*)(LAS unsigned char*)lds_;
    __syncthreads();
    {
        const bf16* K1 = (const bf16*)(P->ws + WS_PK1) + (size_t)L * 128 * 128; const bf16* K2 = (const bf16*)(P->ws + WS_PK2) + (size_t)L * 128 * 128;
        u32x4 kw[8];
#pragma unroll
        for (int t = 0; t < 8; ++t) { const int c16 = tid + t * NWAVES * 64; const int mat = c16 >> 11, row = (c16 >> 4) & 127, ch = c16 & 15; kw[t] = *(const u32x4*)((mat ? K2 : K1) + row * 128 + ch * 8); }
#pragma unroll
        for (int t = 0; t < 8; ++t) { const int c16 = tid + t * NWAVES * 64; const int mat = c16 >> 11, row = (c16 >> 4) & 127, ch = c16 & 15; *(LAS u32x4*)(lds + mat * 32768 + row * 256 + ((ch ^ (row & 15)) * 16)) = kw[t]; }
    }
    __syncthreads();
    LAS unsigned* sc = (LAS unsigned*)(lds + 65536) + wid * 2048;
    const int r32 = lane & 31, hi = lane >> 5;
    for (int item = gw; item < Mrows / 4; item += NGW) {
        const int tok = item * 4 + (r32 >> 3), head = r32 & 7;
        unsigned top0[16], top1[16];
        { bf16x8 q0[8], q1[8]; route_qload<0>(QP, tok, head, hi, q0); route_qload<1>(QP, tok, head, hi, q1);
          route_pass<0>(q0, lds, tok, head, r32, hi, top0);
          route_pass<1>(q1, lds, tok, head, r32, hi, top1); }
        float v1[16], v2[16];
#pragma unroll
        for (int i = 0; i < 16; ++i) { v1[i] = ord2f(top0[i] & ~127u); v2[i] = ord2f(top1[i] & ~127u);
            sc[i * 64 + lane] = 127u - (top0[i] & 127u); sc[(16 + i) * 64 + lane] = 127u - (top1[i] & 127u); }
        unsigned ck[64]; int n = 0;
#pragma unroll
        for (int i = 0; i < 16; ++i)
#pragma unroll
            for (int j = 0; j < 16; ++j) if ((i + 1) * (j + 1) <= 16) { ck[n] = (f2ord(v1[i] + v2[j]) & ~255u) | (unsigned)(i * 16 + j); ++n; }
#pragma unroll
        for (int i = 50; i < 64; ++i) ck[i] = 0u;
        top16_of_64(ck);
        float ev[16]; float sum = 0.f; const float mx = ord2f(ck[0] & ~255u);
#pragma unroll
        for (int k = 0; k < 16; ++k) { ev[k] = __expf(ord2f(ck[k] & ~255u) - mx); sum += ev[k]; }
        const float inv = 1.0f / sum;
        unsigned ee[16];
#pragma unroll
        for (int k = 0; k < 16; ++k) { const unsigned pc = ck[k] & 255u; const unsigned i1 = sc[(pc >> 4) * 64 + lane], i2 = sc[(16 + (pc & 15u)) * 64 + lane]; ee[k] = i1 * 128u + i2; ev[k] *= inv; }
#if ROUTE_SORT
        { const int tq = r32 >> 3;
#pragma unroll
          for (int k = 0; k < 8; ++k) {
              const unsigned eL = ee[k], eH = ee[k + 8]; const float gL = ev[k], gH = ev[k + 8];
              sc[tq * 256 + head * 16 + hi * 8 + k] = hi ? eH : eL; sc[tq * 256 + 128 + head * 16 + hi * 8 + k] = __float_as_uint(hi ? gH : gL); }
#pragma unroll 1
          for (int t = 0; t < 4; ++t) {
              unsigned a0 = (sc[t * 256 + lane] << 7) | (unsigned)lane, a1 = (sc[t * 256 + 64 + lane] << 7) | (unsigned)(64 + lane);
              sort128_asc(a0, a1, lane);
              const unsigned g0 = sc[t * 256 + 128 + (a0 & 127u)], g1 = sc[t * 256 + 128 + (a1 & 127u)];
              u32x2* outp = (u32x2*)(ROUTE + (size_t)(item * 4 + t) * 256);
              outp[lane] = (u32x2){a0 >> 7, g0}; outp[64 + lane] = (u32x2){a1 >> 7, g1}; }
        }
#else
        u32x4* outp = (u32x4*)(ROUTE + ((size_t)tok * 128 + head * 16 + hi * 8) * 2);
#pragma unroll
        for (int k = 0; k < 8; k += 2) { u32x4 w;
            const unsigned eL0 = ee[k], eH0 = ee[k + 8], eL1 = ee[k + 1], eH1 = ee[k + 9]; const float gL0 = ev[k], gH0 = ev[k + 8], gL1 = ev[k + 1], gH1 = ev[k + 9];
            w.x = hi ? eH0 : eL0; w.y = __float_as_uint(hi ? gH0 : gL0); w.z = hi ? eH1 : eL1; w.w = __float_as_uint(hi ? gH1 : gL1);
            outp[k >> 1] = w; }
#endif
    }
}

typedef float f32x2 __attribute__((ext_vector_type(2)));
typedef float f32x32 __attribute__((ext_vector_type(32)));
typedef unsigned u32x6 __attribute__((ext_vector_type(6)));
typedef __bf16 bf16x32 __attribute__((ext_vector_type(32)));
typedef unsigned u32x16 __attribute__((ext_vector_type(16)));
typedef __bf16 bf16x2_t __attribute__((ext_vector_type(2)));
#ifndef GATHER_ZIGZAG
#define GATHER_ZIGZAG 0
#endif
#ifndef GATHER_PRE
#define GATHER_PRE 0
#endif
#ifndef GATHER_XEARLY
#define GATHER_XEARLY 0
#endif
#ifndef GATHER_SWP
#define GATHER_SWP 0
#endif
#ifndef GATHER_VECREG
#define GATHER_VECREG 1
#endif
#ifndef GATHER_MFMADOT
#define GATHER_MFMADOT 1
#endif
typedef short s16x4_t __attribute__((ext_vector_type(4)));
#ifndef GATHER_PAIRRED
#define GATHER_PAIRRED 1
#endif
#ifndef GATHER_EARLY
#define GATHER_EARLY 1
#endif
#ifndef GATHER_PACE
#define GATHER_PACE 0
#endif
#define XB_PACE(j) (XCD_BAR_WORDS + 64 * (j))
#ifndef GATHER_DEEP
#define GATHER_DEEP 0
#endif
constexpr int GS = GATHER_DEEP ? 8 : 6, GSLOT = GATHER_DEEP ? 2048 : 2 * PROW;
__device__ __forceinline__ void glds16(const void* gsrc, unsigned lds_dst) { unsigned keep;
  asm volatile("s_mov_b32 %0, m0\n\ts_mov_b32 m0, %2\n\ts_nop 0\n\tglobal_load_lds_dwordx4 %1, off\n\ts_mov_b32 m0, %0" : "=&s"(keep) : "v"(gsrc), "s"(lds_dst) : "memory"); }
template <int GMODE = 0>
__device__ __forceinline__ void gather_phase(CP P, int L, int Mrows, LAS unsigned char* lds, int wid, int lane_, int gw, int NGW, bool dry = false) {
    const unsigned char* UV = P->ws + WS_PU + (size_t)L * 16384 * PREC;
    const unsigned* ROUTE = (const unsigned*)(P->ws + WS_ROUTE); const float* MOD = (const float*)(P->ws + WS_MOD);
    bf16* X = (bf16*)(P->ws + WS_X); bf16* H = (bf16*)(P->ws + WS_H); bf16* Xo = dry ? (bf16*)(P->ws + WS_Y) : X; bf16* Ho = dry ? (bf16*)(P->ws + WS_G) : H;
    const float* lng = P->in[6] + (size_t)(L * 2 + 1) * DM; const float* lnb = P->in[7] + (size_t)(L * 2 + 1) * DM;
    const unsigned ring = (unsigned)(uintptr_t)lds + (unsigned)wid * (GS * GSLOT);
    const int nfull = (Mrows / NGW) * NGW, rem = Mrows - nfull; const bool can_coop = (rem * 4 == NGW);
    const int nround = nfull / NGW + (rem > 0 ? 1 : 0);
    const bool pace_ok = (rem == 0) || can_coop;
#define G_ROWOF(it_) ((can_coop && (it_) == nround - 1) ? (nfull + (int)blockIdx.x * 2 + (wid >> 2)) : (gw + (it_) * NGW))
    u32x2 nea = {0u, 0u}, neb = {0u, 0u}; u32x4 nh0 = {0u, 0u, 0u, 0u}, nh1 = nh0, nh2 = nh0, nh3 = nh0;
#define G_NTL(p_) (NT_STREAM > 1 ? __builtin_nontemporal_load(p_) : *(p_))
#define G_PREFETCH(rowN_, ln_) do { const int rn_ = (rowN_); nea = G_NTL(&((const u32x2*)(ROUTE + (size_t)rn_ * 256))[ln_]); neb = G_NTL(&((const u32x2*)(ROUTE + (size_t)rn_ * 256))[64 + (ln_)]); \
        const u32x4* hp_ = (const u32x4*)(H + (size_t)rn_ * DM) + 4 * (ln_); nh0 = G_NTL(hp_); nh1 = G_NTL(hp_ + 1); nh2 = G_NTL(hp_ + 2); nh3 = G_NTL(hp_ + 3); } while (0)
    if (nround > 0 && G_ROWOF(0) < Mrows) G_PREFETCH(G_ROWOF(0), launder_v(lane_));
#if GATHER_VECREG
    LAS unsigned* LNV = (LAS unsigned*)(lds + NWAVES * GS * GSLOT);
    { f32x2 t_[4];
#pragma unroll
      for (int t = 0; t < 4; ++t) { const int i = wid * 64 + lane_ + t * NWAVES * 64; t_[t] = *(const f32x2*)(((i >> 10) ? lnb : lng) + 2 * (i & 1023)); }
#pragma unroll
      for (int t = 0; t < 4; ++t) { const float x0_ = t_[t][0], x1_ = t_[t][1]; LNV[wid * 64 + lane_ + t * NWAVES * 64] = cvtpk(x0_, x1_); } }
    __syncthreads();
    unsigned mg[16], ms[16], mc[16]; int cur_slot = -1;
#pragma unroll
    for (int i = 0; i < 16; ++i) { mg[i] = 0u; ms[i] = 0u; mc[i] = 0u; }
#endif
    bool pre = false;
#pragma unroll 1
    for (int it = 0; it < nround; ++it) {
#if GATHER_PACE
        if (pace_ok && it > 0) {
            if (wid == 0 && lane_ == 0) { const unsigned nloc = ((volatile LAS unsigned*)(lds + MISC_OFF))[8];
                if (nloc != 0u) { unsigned* pc = (unsigned*)(P->ws + WS_CTL) + CW_BAR + XB_PACE(xb_xcc_id());
                    const unsigned old = xb_add(pc, 1u), tgt = (old / nloc + 1u) * nloc; unsigned sp = 0u;
                    while ((int)(xb_ld(pc) - tgt) < 0 && ++sp < 20000u) __builtin_amdgcn_s_sleep(1); } }
            __syncthreads();
        }
#endif
        const bool coop = can_coop && (it == nround - 1);
        int row = G_ROWOF(it), k0 = 0, kn = 128;
        if (coop) { k0 = (wid & 3) * 32; kn = k0 + 32; }
        else if (row >= Mrows) break;
        const int lane = launder_v(lane_);
        const u32x2 ea = nea, eb = neb;
        unsigned eax, eay, ebx, eby;
        unsigned hw[16] = {nh0.x, nh0.y, nh0.z, nh0.w, nh1.x, nh1.y, nh1.z, nh1.w, nh2.x, nh2.y, nh2.z, nh2.w, nh3.x, nh3.y, nh3.z, nh3.w};
        float y[32];
#pragma unroll
        for (int i = 0; i < 32; ++i) y[i] = 0.f;
        { unsigned e0 = ea.x, e1 = ea.y, e2 = eb.x, e3 = eb.y;
          asm volatile("" : "+v"(e0), "+v"(e1), "+v"(e2), "+v"(e3), "+v"(hw[0]), "+v"(hw[1]), "+v"(hw[2]), "+v"(hw[3]), "+v"(hw[4]), "+v"(hw[5]), "+v"(hw[6]), "+v"(hw[7]),
                       "+v"(hw[8]), "+v"(hw[9]), "+v"(hw[10]), "+v"(hw[11]), "+v"(hw[12]), "+v"(hw[13]), "+v"(hw[14]), "+v"(hw[15]) :: "memory");
          eax = e0; eay = e1; ebx = e2; eby = e3; }
        const unsigned rd_a = ring + 16u * (unsigned)lane, rd_b = ring + 2048u + 8u * (unsigned)lane;
        const bool rev = GATHER_ZIGZAG && ((it & 1) != 0);
        const int kflip = rev ? (k0 + kn - 1) : 0, ksign = rev ? -1 : 1;
#define G_ISSUE(k) do { const int k_ = (k), ke_ = kflip + ksign * k_; const unsigned e_ = (unsigned)__builtin_amdgcn_readlane((int)(ke_ < 64 ? eax : ebx), ke_ & 63); \
        const unsigned char* rp_ = UV + (size_t)e_ * PREC + 16 * lane; const unsigned sb_ = ring + (unsigned)(k_ % GS) * GSLOT; \
        if (GMODE == 3) { glds16(rp_, sb_); if (lane < 32) glds16(rp_ + 2048, sb_ + 2048); } \
        else if (GMODE != 2) { glds16(rp_, sb_); glds16(rp_ + 1024, sb_ + 1024); if (PEER_U4) {} else if (PEER_V4) { if (lane < 32) glds16(rp_ + 2048, sb_ + 2048); } else glds16(rp_ + 2048, sb_ + 2048); } else { asm volatile("" :: "v"(rp_), "s"(sb_)); } } while (0)
#if GATHER_EARLY
        if (it + 1 < nround && G_ROWOF(it + 1) < Mrows) G_PREFETCH(G_ROWOF(it + 1), lane);
        if (!pre) {
#pragma unroll
            for (int k = 0; k < GS; ++k) G_ISSUE(k0 + k); }
#else
#pragma unroll
        for (int k = 0; k < 4; ++k) G_ISSUE(k0 + k);
        if (it + 1 < nround && G_ROWOF(it + 1) < Mrows) G_PREFETCH(G_ROWOF(it + 1), lane);
#endif
#define G_READ(k, ua, ub, va, vb) do { const unsigned so_ = (unsigned)((k) % GS) * GSLOT; \
        if (PEER_U4) asm volatile("ds_read_b128 %0, %2\n\tds_read_b128 %1, %2 offset:1024" : "=&v"(ua), "=&v"(va) : "v"(rd_a + so_) : "memory"); \
        else if (PEER_V4) asm volatile("ds_read_b128 %0, %3\n\tds_read_b64 %1, %4\n\tds_read_b128 %2, %3 offset:1024" \
                     : "=&v"(ua), "=&v"(ub), "=&v"(va) : "v"(rd_a + so_), "v"(rd_b + so_) : "memory"); \
        else asm volatile("ds_read_b128 %0, %4\n\tds_read_b64 %1, %5\n\tds_read_b128 %2, %4 offset:1024\n\tds_read_b64 %3, %5 offset:512" \
                     : "=&v"(ua), "=&v"(ub), "=&v"(va), "=&v"(vb) : "v"(rd_a + so_), "v"(rd_b + so_) : "memory"); } while (0)
#if GATHER_XEARLY
        u32x4 xr0 = {0u, 0u, 0u, 0u}, xr1 = xr0, xr2 = xr0, xr3 = xr0;
#endif
#if GATHER_SWP
        static_assert(!GATHER_SWP || (PEER_U4 && PEER_V4 && GATHER_EARLY && GATHER_PAIRRED && GATHER_MFMADOT && !GATHER_DEEP && !GATHER_XEARLY && !GATHER_PRE), "GATHER_SWP: configuration");
#define SWP_FETCH(kk, uA, uB, vA, vB) do { const int kk_ = (kk); \
            if (kk_ + 4 < kn) asm volatile("s_waitcnt vmcnt(8)" ::: "memory"); else if (kk_ == kn - 4) asm volatile("s_waitcnt vmcnt(4)" ::: "memory"); else asm volatile("s_waitcnt vmcnt(0)" ::: "memory"); \
            u32x2 d0_ = {0u, 0u}, d1_ = {0u, 0u}; G_READ(kk_, uA, d0_, vA, d1_); G_READ(kk_ + 1, uB, d0_, vB, d1_); \
            asm volatile("s_waitcnt lgkmcnt(0)" : "+v"(uA), "+v"(vA), "+v"(uB), "+v"(vB) :: "memory"); \
            if (kk_ + GS < kn) { G_ISSUE(kk_ + GS); G_ISSUE(kk_ + GS + 1); } } while (0)
#define SWP_U4(dst_, src_, w_, b_) dst_[4 * (w_) + (b_)] = __builtin_bit_cast(unsigned, __builtin_amdgcn_cvt_scalef32_pk_bf16_fp4(src_[w_], 1.0f, b_))
#define SWP_UPART(kk, uA, uB, wA_, wB_) do { const int kk_ = (kk); u32x16 ubfA, ubfB; const unsigned uwA[4] = {uA.x, uA.y, uA.z, uA.w}, uwB[4] = {uB.x, uB.y, uB.z, uB.w}; \
            _Pragma("unroll") for (int w = 0; w < 4; ++w) { SWP_U4(ubfA, uwA, w, 0); SWP_U4(ubfA, uwA, w, 1); SWP_U4(ubfA, uwA, w, 2); SWP_U4(ubfA, uwA, w, 3); SWP_U4(ubfB, uwB, w, 0); SWP_U4(ubfB, uwB, w, 1); SWP_U4(ubfB, uwB, w, 2); SWP_U4(ubfB, uwB, w, 3); } \
            f32x4 dgA = {0.f, 0.f, 0.f, 0.f}, dgB = {0.f, 0.f, 0.f, 0.f}; \
            _Pragma("unroll") for (int q = 0; q < 16; q += 2) { const u32x2 hq_ = {hw[q], hw[q + 1]}, xa_ = {ubfA[q], ubfA[q + 1]}, xb_ = {ubfB[q], ubfB[q + 1]}; \
                dgA = __builtin_amdgcn_mfma_f32_4x4x4bf16_1k(__builtin_bit_cast(s16x4_t, xa_), __builtin_bit_cast(s16x4_t, hq_), dgA, 0, 0, 0); \
                dgB = __builtin_amdgcn_mfma_f32_4x4x4bf16_1k(__builtin_bit_cast(s16x4_t, xb_), __builtin_bit_cast(s16x4_t, hq_), dgB, 0, 0, 0); } \
            const float x0 = dgA[0], x1 = dgA[1], x2 = dgA[2], x3 = dgA[3], y0 = dgB[0], y1 = dgB[1], y2 = dgB[2], y3 = dgB[3]; \
            float a0 = DPP_F(x0, 0x00); a0 += DPP_F(x1, 0x55); a0 += DPP_F(x2, 0xAA); a0 += DPP_F(x3, 0xFF); \
            float b0 = DPP_F(y0, 0x00); b0 += DPP_F(y1, 0x55); b0 += DPP_F(y2, 0xAA); b0 += DPP_F(y3, 0xFF); \
            const auto sw = __builtin_amdgcn_permlane32_swap(__float_as_uint(a0), __float_as_uint(b0), false, false); \
            float c2 = __uint_as_float(sw[0]) + __uint_as_float(sw[1]); c2 += DPP_F(c2, 0x141); c2 += DPP_F(c2, 0x140); \
            const float d2 = sum_xor16(c2) * (1.0f / U_SCALE); const float g2 = gelu_tanh(d2) * (1.0f / V_SCALE); \
            const float gA = __uint_as_float((unsigned)__builtin_amdgcn_readlane((int)__float_as_uint(g2), 0)), gB = __uint_as_float((unsigned)__builtin_amdgcn_readlane((int)__float_as_uint(g2), 32)); \
            const int keA = kflip + ksign * kk_, keB = keA + ksign; const unsigned gsel = keA < 64 ? eay : eby; \
            wA_ = __uint_as_float((unsigned)__builtin_amdgcn_readlane((int)gsel, keA & 63)) * gA; wB_ = __uint_as_float((unsigned)__builtin_amdgcn_readlane((int)gsel, keB & 63)) * gB; } while (0)
#define SWP_V4(vwA, vwB, w_, b_, wA_, wB_) do { const f32x2 pA = __builtin_amdgcn_cvt_scalef32_pk_f32_fp4(vwA[w_], 1.0f, b_), pB = __builtin_amdgcn_cvt_scalef32_pk_f32_fp4(vwB[w_], 1.0f, b_); const int j = 4 * (w_) + (b_); \
            const float pa0 = pA[0], pa1 = pA[1], pb0 = pB[0], pb1 = pB[1]; y[2 * j] += wA_ * pa0; y[2 * j + 1] += wA_ * pa1; y[2 * j] += wB_ * pb0; y[2 * j + 1] += wB_ * pb1; } while (0)
#define SWP_VPART(vA, vB, wA_, wB_) do { const unsigned vwA[4] = {vA.x, vA.y, vA.z, vA.w}, vwB[4] = {vB.x, vB.y, vB.z, vB.w}; \
            _Pragma("unroll") for (int w = 0; w < 4; ++w) { SWP_V4(vwA, vwB, w, 0, wA_, wB_); SWP_V4(vwA, vwB, w, 1, wA_, wB_); SWP_V4(vwA, vwB, w, 2, wA_, wB_); SWP_V4(vwA, vwB, w, 3, wA_, wB_); } } while (0)
#define SWP_VCH(w_, qA_, qB_) do { SWP_V4(vwA, vwB, w_, 0, qA_, qB_); SWP_V4(vwA, vwB, w_, 1, qA_, qB_); SWP_V4(vwA, vwB, w_, 2, qA_, qB_); SWP_V4(vwA, vwB, w_, 3, qA_, qB_); } while (0)
#define SWP_MIX(kk, uA, uB, wA_, wB_, pvA, pvB, pwA_, pwB_) do { const int kk_ = (kk); u32x16 ubfA, ubfB; const unsigned uwA[4] = {uA.x, uA.y, uA.z, uA.w}, uwB[4] = {uB.x, uB.y, uB.z, uB.w}; \
            const unsigned vwA[4] = {pvA.x, pvA.y, pvA.z, pvA.w}, vwB[4] = {pvB.x, pvB.y, pvB.z, pvB.w}; \
            _Pragma("unroll") for (int w = 0; w < 4; ++w) { SWP_U4(ubfA, uwA, w, 0); SWP_U4(ubfA, uwA, w, 1); SWP_U4(ubfA, uwA, w, 2); SWP_U4(ubfA, uwA, w, 3); SWP_U4(ubfB, uwB, w, 0); SWP_U4(ubfB, uwB, w, 1); SWP_U4(ubfB, uwB, w, 2); SWP_U4(ubfB, uwB, w, 3); } \
            f32x4 dgA = {0.f, 0.f, 0.f, 0.f}, dgB = {0.f, 0.f, 0.f, 0.f}; \
            _Pragma("unroll") for (int q = 0; q < 16; q += 2) { const u32x2 hq_ = {hw[q], hw[q + 1]}, xa_ = {ubfA[q], ubfA[q + 1]}, xb_ = {ubfB[q], ubfB[q + 1]}; \
                dgA = __builtin_amdgcn_mfma_f32_4x4x4bf16_1k(__builtin_bit_cast(s16x4_t, xa_), __builtin_bit_cast(s16x4_t, hq_), dgA, 0, 0, 0); \
                dgB = __builtin_amdgcn_mfma_f32_4x4x4bf16_1k(__builtin_bit_cast(s16x4_t, xb_), __builtin_bit_cast(s16x4_t, hq_), dgB, 0, 0, 0); } \
            SWP_VCH(0, pwA_, pwB_); \
            const float x0 = dgA[0], x1 = dgA[1], x2 = dgA[2], x3 = dgA[3], y0 = dgB[0], y1 = dgB[1], y2 = dgB[2], y3 = dgB[3]; \
            float a0 = DPP_F(x0, 0x00); a0 += DPP_F(x1, 0x55); a0 += DPP_F(x2, 0xAA); a0 += DPP_F(x3, 0xFF); \
            float b0 = DPP_F(y0, 0x00); b0 += DPP_F(y1, 0x55); b0 += DPP_F(y2, 0xAA); b0 += DPP_F(y3, 0xFF); \
            SWP_VCH(1, pwA_, pwB_); \
            const auto sw = __builtin_amdgcn_permlane32_swap(__float_as_uint(a0), __float_as_uint(b0), false, false); \
            float c2 = __uint_as_float(sw[0]) + __uint_as_float(sw[1]); c2 += DPP_F(c2, 0x141); c2 += DPP_F(c2, 0x140); \
            float d2 = sum_xor16(c2) * (1.0f / U_SCALE); \
            SWP_VCH(2, pwA_, pwB_); \
            float g2 = gelu_tanh(d2) * (1.0f / V_SCALE); \
            SWP_VCH(3, pwA_, pwB_); \
            const float gA = __uint_as_float((unsigned)__builtin_amdgcn_readlane((int)__float_as_uint(g2), 0)), gB = __uint_as_float((unsigned)__builtin_amdgcn_readlane((int)__float_as_uint(g2), 32)); \
            const int keA = kflip + ksign * kk_, keB = keA + ksign; const unsigned gsel = keA < 64 ? eay : eby; \
            wA_ = __uint_as_float((unsigned)__builtin_amdgcn_readlane((int)gsel, keA & 63)) * gA; wB_ = __uint_as_float((unsigned)__builtin_amdgcn_readlane((int)gsel, keB & 63)) * gB; } while (0)
        if (GMODE == 0) {
            u32x4 cuA, cuB, cvA, cvB; float cwA, cwB;
            SWP_FETCH(k0, cuA, cuB, cvA, cvB); SWP_UPART(k0, cuA, cuB, cwA, cwB);
#pragma unroll 1
            for (int k = k0; k + 2 < kn; k += 2) {
                u32x4 nuA, nuB, nvA, nvB; float nwA, nwB;
                SWP_FETCH(k + 2, nuA, nuB, nvA, nvB);
                SWP_MIX(k + 2, nuA, nuB, nwA, nwB, cvA, cvB, cwA, cwB);
                cvA = nvA; cvB = nvB; cwA = nwA; cwB = nwB;
            }
            SWP_VPART(cvA, cvB, cwA, cwB);
        } else
#undef SWP_MIX
#undef SWP_VCH
#undef SWP_FETCH
#undef SWP_U4
#undef SWP_UPART
#undef SWP_V4
#undef SWP_VPART
#endif
#pragma unroll 1
        for (int k = k0; k < kn; k += 2) {
            if (GATHER_DEEP && k + 6 < kn) asm volatile("s_waitcnt vmcnt(12)" ::: "memory");
            else if (GATHER_DEEP && k == kn - 6) asm volatile("s_waitcnt vmcnt(8)" ::: "memory");
            else if (k + 4 < kn) { if (!GATHER_EARLY) { G_ISSUE(k + 4); G_ISSUE(k + 5); } if (GMODE == 3 || PEER_U4) asm volatile("s_waitcnt vmcnt(8)" ::: "memory"); else asm volatile("s_waitcnt vmcnt(12)" ::: "memory"); }
            else if (k == kn - 4) { if (GMODE == 3 || PEER_U4) asm volatile("s_waitcnt vmcnt(4)" ::: "memory"); else asm volatile("s_waitcnt vmcnt(6)" ::: "memory"); }
            else asm volatile("s_waitcnt vmcnt(0)" ::: "memory");
            u32x4 uaA, vaA, uaB, vaB; u32x2 ubA = {0u, 0u}, vbA = {0u, 0u}, ubB = {0u, 0u}, vbB = {0u, 0u};
            G_READ(k, uaA, ubA, vaA, vbA); G_READ(k + 1, uaB, ubB, vaB, vbB);
            asm volatile("s_waitcnt lgkmcnt(0)" : "+v"(uaA), "+v"(ubA), "+v"(vaA), "+v"(vbA), "+v"(uaB), "+v"(ubB), "+v"(vaB), "+v"(vbB) :: "memory");
#if GATHER_XEARLY
            if (k == kn - 4) { const u32x4* xp_ = (const u32x4*)(X + (size_t)row * DM) + 4 * lane; xr0 = xp_[0]; xr1 = xp_[1]; xr2 = xp_[2]; xr3 = xp_[3]; }
#endif
            if (GATHER_EARLY && k + GS < kn) { G_ISSUE(k + GS); G_ISSUE(k + GS + 1); }
            if (GMODE == 1 || GMODE == 3) continue;
#if PEER_U4
            u32x16 ubfA, ubfB;
            { const unsigned uwA[4] = {uaA.x, uaA.y, uaA.z, uaA.w}, uwB[4] = {uaB.x, uaB.y, uaB.z, uaB.w};
#pragma unroll
              for (int w = 0; w < 4; ++w) {
#define U4_CVT(b_) do { ubfA[4 * w + (b_)] = __builtin_bit_cast(unsigned, __builtin_amdgcn_cvt_scalef32_pk_bf16_fp4(uwA[w], 1.0f, b_)); ubfB[4 * w + (b_)] = __builtin_bit_cast(unsigned, __builtin_amdgcn_cvt_scalef32_pk_bf16_fp4(uwB[w], 1.0f, b_)); } while (0)
                  U4_CVT(0); U4_CVT(1); U4_CVT(2); U4_CVT(3);
#undef U4_CVT
              } }
#else
            const u32x6 u6A = {uaA.x, uaA.y, uaA.z, uaA.w, ubA.x, ubA.y}, u6B = {uaB.x, uaB.y, uaB.z, uaB.w, ubB.x, ubB.y};
            const u32x16 ubfA = __builtin_bit_cast(u32x16, __builtin_amdgcn_cvt_scalef32_pk32_bf16_fp6(u6A, 1.0f));
            const u32x16 ubfB = __builtin_bit_cast(u32x16, __builtin_amdgcn_cvt_scalef32_pk32_bf16_fp6(u6B, 1.0f));
#endif
#if GATHER_MFMADOT
            f32x4 dgA = {0.f, 0.f, 0.f, 0.f}, dgB = {0.f, 0.f, 0.f, 0.f};
#pragma unroll
            for (int q = 0; q < 16; q += 2) { const u32x2 hq_ = {hw[q], hw[q + 1]}, xa_ = {ubfA[q], ubfA[q + 1]}, xb_ = {ubfB[q], ubfB[q + 1]};
                dgA = __builtin_amdgcn_mfma_f32_4x4x4bf16_1k(__builtin_bit_cast(s16x4_t, xa_), __builtin_bit_cast(s16x4_t, hq_), dgA, 0, 0, 0);
                dgB = __builtin_amdgcn_mfma_f32_4x4x4bf16_1k(__builtin_bit_cast(s16x4_t, xb_), __builtin_bit_cast(s16x4_t, hq_), dgB, 0, 0, 0); }
            float a0, a1 = 0.f, b0, b1 = 0.f;
            { const float x0 = dgA[0], x1 = dgA[1], x2 = dgA[2], x3 = dgA[3], y0 = dgB[0], y1 = dgB[1], y2 = dgB[2], y3 = dgB[3];
              a0 = DPP_F(x0, 0x00); a0 += DPP_F(x1, 0x55); a0 += DPP_F(x2, 0xAA); a0 += DPP_F(x3, 0xFF);
              b0 = DPP_F(y0, 0x00); b0 += DPP_F(y1, 0x55); b0 += DPP_F(y2, 0xAA); b0 += DPP_F(y3, 0xFF); }
#else
            float a0 = 0.f, a1 = 0.f, b0 = 0.f, b1 = 0.f;
#pragma unroll
            for (int q = 0; q < 16; q += 2) { const unsigned h0_ = hw[q], h1_ = hw[q + 1], x0_ = ubfA[q], x1_ = ubfA[q + 1], z0_ = ubfB[q], z1_ = ubfB[q + 1];
                a0 = __builtin_amdgcn_fdot2_f32_bf16(__builtin_bit_cast(bf16x2_t, h0_), __builtin_bit_cast(bf16x2_t, x0_), a0, false);
                a1 = __builtin_amdgcn_fdot2_f32_bf16(__builtin_bit_cast(bf16x2_t, h1_), __builtin_bit_cast(bf16x2_t, x1_), a1, false);
                b0 = __builtin_amdgcn_fdot2_f32_bf16(__builtin_bit_cast(bf16x2_t, h0_), __builtin_bit_cast(bf16x2_t, z0_), b0, false);
                b1 = __builtin_amdgcn_fdot2_f32_bf16(__builtin_bit_cast(bf16x2_t, h1_), __builtin_bit_cast(bf16x2_t, z1_), b1, false); }
#endif
            const int keA = kflip + ksign * k, keB = keA + ksign;
            const unsigned gsel = keA < 64 ? eay : eby;
#if GATHER_PAIRRED
            float wA, wB;
            { const auto sw = __builtin_amdgcn_permlane32_swap(__float_as_uint(GATHER_MFMADOT ? a0 : a0 + a1), __float_as_uint(GATHER_MFMADOT ? b0 : b0 + b1), false, false);
#if GATHER_MFMADOT
              float c2 = __uint_as_float(sw[0]) + __uint_as_float(sw[1]); c2 += DPP_F(c2, 0x141); c2 += DPP_F(c2, 0x140);
              const float d2 = sum_xor16(c2) * (1.0f / U_SCALE);
#else
              const float d2 = half_sum32(__uint_as_float(sw[0]) + __uint_as_float(sw[1])) * (1.0f / U_SCALE);
#endif
              const float g2 = gelu_tanh(d2) * (1.0f / V_SCALE);
              const float gA = __uint_as_float((unsigned)__builtin_amdgcn_readlane((int)__float_as_uint(g2), 0)), gB = __uint_as_float((unsigned)__builtin_amdgcn_readlane((int)__float_as_uint(g2), 32));
              wA = __uint_as_float((unsigned)__builtin_amdgcn_readlane((int)gsel, keA & 63)) * gA; wB = __uint_as_float((unsigned)__builtin_amdgcn_readlane((int)gsel, keB & 63)) * gB; }
#else
            const float dA = wave_sum(a0 + a1) * (1.0f / U_SCALE), dB = wave_sum(b0 + b1) * (1.0f / U_SCALE);
            const float wA = __uint_as_float((unsigned)__builtin_amdgcn_readlane((int)gsel, keA & 63)) * gelu_tanh(dA) * (1.0f / V_SCALE);
            const float wB = __uint_as_float((unsigned)__builtin_amdgcn_readlane((int)gsel, keB & 63)) * gelu_tanh(dB) * (1.0f / V_SCALE);
#endif
#if PEER_V4
            { const unsigned vwA[4] = {vaA.x, vaA.y, vaA.z, vaA.w}, vwB[4] = {vaB.x, vaB.y, vaB.z, vaB.w};
#pragma unroll
              for (int w = 0; w < 4; ++w) {
#define V4_ACC(b_) do { const f32x2 pA = __builtin_amdgcn_cvt_scalef32_pk_f32_fp4(vwA[w], 1.0f, b_), pB = __builtin_amdgcn_cvt_scalef32_pk_f32_fp4(vwB[w], 1.0f, b_); const int j = 4 * w + (b_); \
                    const float pa0 = pA[0], pa1 = pA[1], pb0 = pB[0], pb1 = pB[1]; y[2 * j] += wA * pa0; y[2 * j + 1] += wA * pa1; y[2 * j] += wB * pb0; y[2 * j + 1] += wB * pb1; } while (0)
                  V4_ACC(0); V4_ACC(1); V4_ACC(2); V4_ACC(3);
#undef V4_ACC
              } }
#else
            const u32x6 v6A = {vaA.x, vaA.y, vaA.z, vaA.w, vbA.x, vbA.y};
            const f32x32 vfA = __builtin_amdgcn_cvt_scalef32_pk32_f32_fp6(v6A, 1.0f);
#pragma unroll
            for (int i = 0; i < 32; ++i) y[i] += wA * vfA[i];
            const u32x6 v6B = {vaB.x, vaB.y, vaB.z, vaB.w, vbB.x, vbB.y};
            const f32x32 vfB = __builtin_amdgcn_cvt_scalef32_pk32_f32_fp6(v6B, 1.0f);
#pragma unroll
            for (int i = 0; i < 32; ++i) y[i] += wB * vfB[i];
#endif
        }
#if GATHER_PRE
        pre = (it + 1 < nround) && (G_ROWOF(it + 1) < Mrows);
        if (pre) { unsigned n0 = nea.x, n2 = neb.x; asm volatile("" : "+v"(n0), "+v"(n2) :: "memory"); eax = n0; ebx = n2;
            const int k0n = (can_coop && (it + 1 == nround - 1)) ? (wid & 3) * 32 : 0;
#pragma unroll
            for (int k = 0; k < 6; ++k) G_ISSUE(k0n + k); }
#endif
#undef G_READ
#undef G_ISSUE
        if (coop) {
            LAS f32x4* mine = (LAS f32x4*)(lds + wid * (GS * GSLOT)) + lane * 8;
#pragma unroll
            for (int i = 0; i < 8; ++i) mine[i] = (f32x4){y[4 * i], y[4 * i + 1], y[4 * i + 2], y[4 * i + 3]};
            __syncthreads();
            if ((wid & 3) == 0) {
#pragma unroll
                for (int j = 1; j < 4; ++j) { const LAS f32x4* oth = (const LAS f32x4*)(lds + (wid + j) * (GS * GSLOT)) + lane * 8;
#pragma unroll
                    for (int i = 0; i < 8; ++i) { const f32x4 t = oth[i]; y[4 * i] += t.x; y[4 * i + 1] += t.y; y[4 * i + 2] += t.z; y[4 * i + 3] += t.w; } }
            }
            __syncthreads();
            if ((wid & 3) != 0) continue;
        }
        const int slot = row_slot(row);
        const float* mod = MOD + (size_t)(L * 3 + slot) * 12288;
        const int le = launder_v(lane);
#if GATHER_VECREG
        if (slot != cur_slot) { cur_slot = slot; float t_[32];
            load_row_f32_b(mod + 5 * 2048, le, t_);
#pragma unroll
            for (int i = 0; i < 16; ++i) mg[i] = cvtpk(t_[2 * i], t_[2 * i + 1]);
            if (L < NLAYER - 1) { const float* modn = MOD + (size_t)((L + 1) * 3 + slot) * 12288;
                load_row_f32_b(modn, le, t_);
#pragma unroll
                for (int i = 0; i < 16; ++i) ms[i] = cvtpk(t_[2 * i], t_[2 * i + 1]);
                load_row_f32_b(modn + 2048, le, t_);
#pragma unroll
                for (int i = 0; i < 16; ++i) mc[i] = cvtpk(t_[2 * i], t_[2 * i + 1]); } }
        { float xx[32];
#if GATHER_XEARLY
          { const unsigned xw_[16] = {xr0.x, xr0.y, xr0.z, xr0.w, xr1.x, xr1.y, xr1.z, xr1.w, xr2.x, xr2.y, xr2.z, xr2.w, xr3.x, xr3.y, xr3.z, xr3.w};
#pragma unroll
            for (int i = 0; i < 16; ++i) { xx[2 * i] = bflo(xw_[i]); xx[2 * i + 1] = bfhi(xw_[i]); } }
#else
          { const u32x4* xp_ = (const u32x4*)(X + (size_t)row * DM) + 4 * le;
#pragma unroll
            for (int j = 0; j < 4; ++j) { const u32x4 w = G_NTL(xp_ + j); xx[8 * j + 0] = bflo(w.x); xx[8 * j + 1] = bfhi(w.x); xx[8 * j + 2] = bflo(w.y); xx[8 * j + 3] = bfhi(w.y);
                xx[8 * j + 4] = bflo(w.z); xx[8 * j + 5] = bfhi(w.z); xx[8 * j + 6] = bflo(w.w); xx[8 * j + 7] = bfhi(w.w); } }
#endif
#pragma unroll
          for (int i = 0; i < 16; ++i) { y[2 * i] = ALPHA * xx[2 * i] + bflo(mg[i]) * y[2 * i]; y[2 * i + 1] = ALPHA * xx[2 * i + 1] + bfhi(mg[i]) * y[2 * i + 1]; } }
        { float mean, rstd; ln_stats(y, mean, rstd);
          const LAS u32x4* gp = (const LAS u32x4*)(LNV + le * 16); const LAS u32x4* bp = (const LAS u32x4*)(LNV + 1024 + le * 16);
#pragma unroll
          for (int q = 0; q < 4; ++q) { const u32x4 g4 = gp[q], b4 = bp[q]; const unsigned gw_[4] = {g4.x, g4.y, g4.z, g4.w}, bw_[4] = {b4.x, b4.y, b4.z, b4.w};
#pragma unroll
              for (int j = 0; j < 4; ++j) { const int i = 8 * q + 2 * j; y[i] = (y[i] - mean) * rstd * bflo(gw_[j]) + bflo(bw_[j]); y[i + 1] = (y[i + 1] - mean) * rstd * bfhi(gw_[j]) + bfhi(bw_[j]); } }
          if (L < NLAYER - 1) { store_row_bf16_b(Xo + (size_t)row * DM, le, y);
              ln_stats(y, mean, rstd); float a_[32];
#pragma unroll
              for (int i = 0; i < 16; ++i) { a_[2 * i] = (y[2 * i] - mean) * rstd * (1.0f + bflo(mc[i])) + bflo(ms[i]); a_[2 * i + 1] = (y[2 * i + 1] - mean) * rstd * (1.0f + bfhi(mc[i])) + bfhi(ms[i]); }
              store_row_bf16_b(Ho + (size_t)row * DM, le, a_); }
          else { if (NT_STREAM > 1) store_row_f32_b_nt(P->out + (size_t)row * DM, le, y); else store_row_f32_b(P->out + (size_t)row * DM, le, y); } }
        asm volatile("s_waitcnt vmcnt(0)" ::: "memory");
        continue;
#endif
        { float xx[32], gg[32]; load_row_bf16_b(X + (size_t)row * DM, le, xx); load_row_f32_b(mod + 5 * 2048, le, gg);
#pragma unroll
          for (int i = 0; i < 32; ++i) y[i] = ALPHA * xx[i] + gg[i] * y[i]; }
        if (L < NLAYER - 1) { const float* modn = MOD + (size_t)((L + 1) * 3 + slot) * 12288;
            finish_row<true>(y, lng, lnb, Xo + (size_t)row * DM, modn, modn + 2048, Ho + (size_t)row * DM, nullptr, le); }
        else finish_row<true>(y, lng, lnb, nullptr, nullptr, nullptr, nullptr, P->out + (size_t)row * DM, le);
        asm volatile("s_waitcnt vmcnt(0)" ::: "memory");
    }
#undef G_PREFETCH
#undef G_ROWOF
}

#ifndef ROPE_TEST
#define ROPE_TEST 0
#endif
#ifndef TAIL_L3MOVE
#define TAIL_L3MOVE 1
#endif
#ifndef PROBE_DUP
#define PROBE_DUP 0
#endif
#define NOINL __forceinline__
__device__ __forceinline__ CP launder_cp(CP p) { asm volatile("" : "+s"(p)); return p; }
#define GETP() launder_cp((CP)__builtin_amdgcn_kernarg_segment_ptr())
__device__ __forceinline__ int uni(int v) { return __builtin_amdgcn_readfirstlane(v); }
__device__ __forceinline__ LAS unsigned char* uni_lds(LAS unsigned char* p) { return (LAS unsigned char*)(unsigned)__builtin_amdgcn_readfirstlane((int)(unsigned)(uintptr_t)p); }
#define PH_IDS const int wid = uni(wv_), lane = launder_v(lane_id_fresh()) & 63, tid = (wid & 7) * 64 + lane; const int gw = blockIdx.x * NWAVES + wid, NGW = gridDim.x * NWAVES; (void)lane; (void)gw; (void)NGW; (void)tid;

__device__ NOINL void ph_prologue(int wv_, LAS unsigned char* lds_) { CP P = GETP(); LAS unsigned char* lds = uni_lds(lds_); PH_IDS p0_prologue(P, lds, tid, lane, wid, gw, NGW); if (PROBE_DUP == 5) p0_prologue(P, lds, tid, lane, wid, gw, NGW);
    if (PROBE_DUP >= 21 && PROBE_DUP <= 23) { __syncthreads(); p0_prologue(P, lds, tid, lane, wid, gw, NGW, 1 << (PROBE_DUP - 21 < 0 ? 0 : (PROBE_DUP - 21) & 3)); } }
__device__ NOINL void ph_modreduce(int wv_) { CP P = GETP(); PH_IDS mod_reduce(P, gw, lane, NGW); }
__device__ NOINL void ph_first(int wv_, LAS unsigned char* lds_) { CP P = GETP(); LAS unsigned char* lds = uni_lds(lds_); PH_IDS
#pragma unroll 1
    for (int rep = 0; rep < (PROBE_DUP == 6 ? 2 : 1); ++rep) first_row_pass(P, lds, tid, lane, gw, NGW); }
__device__ NOINL void ph_postmix(int wv_, LAS unsigned char* lds_, int L_, int M_) { CP P = GETP(); LAS unsigned char* lds = uni_lds(lds_); const int L = uni(L_), Mrows = uni(M_); PH_IDS
    if (POSTMIX_LDS) post_mixer_pass_lds(P, L, Mrows, lds, tid, lane, gw, NGW); else post_mixer_pass(P, L, Mrows, lane, gw, NGW); }
__device__ NOINL void ph_vstats(int wv_, int M_) { CP P = GETP(); const int Mrows = uni(M_); PH_IDS
#pragma unroll 1
    for (int rep = 0; rep < (PROBE_DUP == 6 ? 2 : 1); ++rep) vstats_pass(P, Mrows, lane, gw, NGW); }
__device__ NOINL void ph_spatial(int wv_, LAS unsigned char* lds_, int j_, int M_) { CP P = GETP(); LAS unsigned char* lds = uni_lds(lds_); const int j = uni(j_), Mrows = uni(M_); PH_IDS
#pragma unroll 1
    for (int rep = 0; rep < ((PROBE_DUP == 6 || PROBE_DUP == 19) ? 2 : 1); ++rep) spatial_phase(P, j, Mrows, lds, tid, lane, wid); }
__device__ NOINL void ph_mla_norm(int wv_) { CP P = GETP(); PH_IDS
#pragma unroll 1
    for (int rep = 0; rep < (PROBE_DUP == 6 ? 2 : 1); ++rep) mla_norm_pass(P, lane, gw, NGW); }
__device__ NOINL void ph_rope(int wv_, int which_) { CP P = GETP(); const int which = uni(which_); PH_IDS
    if (which == 0) rope_pass((bf16*)(P->ws + WS_QM), 3072, 128, 16, 192, lane, gw, NGW);
    else rope_pass((bf16*)(P->ws + WS_Z), 6144, 0, 64, 64, lane, gw, NGW); }
__device__ NOINL void ph_attn_mla(int wv_, LAS unsigned char* lds_) { CP P = GETP(); LAS unsigned char* lds = uni_lds(lds_); PH_IDS mla_attn_phase(P, lds, tid); if (PROBE_DUP == 2 || PROBE_DUP == 9) mla_attn_phase(P, lds, tid); }
__device__ NOINL void ph_attn_da(int wv_, LAS unsigned char* lds_, int L_, bool ctx_q) { CP P = GETP(); LAS unsigned char* lds = uni_lds(lds_); const int L = uni(L_); PH_IDS
    const float* lp = P->in[26];
    const float s01 = wave_sum(lp[lane] * lp[64 + lane]), s23 = wave_sum(lp[128 + lane] * lp[192 + lane]);
    const float lam_init = 0.8f - 0.6f * expf(-0.3f * (float)L);
    const float lam = expf(s01) - expf(s23) + lam_init;
    if (PROBE_DUP == 24) { da_attn_phase(P, lam, 1.0f - lam_init, lds, tid, ctx_q, 4); __syncthreads(); }
    if (PROBE_DUP == 25) { da_attn_phase(P, lam, 1.0f - lam_init, lds, tid, ctx_q, 2); __syncthreads(); }
    if (PROBE_DUP == 26) { da_attn_phase(P, lam, 1.0f - lam_init, lds, tid, ctx_q, 12); __syncthreads(); }
    if (!(PROBE_DUP >= 11 && PROBE_DUP <= 15)) da_attn_phase(P, lam, 1.0f - lam_init, lds, tid, ctx_q);
    if (PROBE_DUP == 2 || PROBE_DUP == 10) da_attn_phase(P, lam, 1.0f - lam_init, lds, tid, ctx_q);
    if (PROBE_DUP >= 11 && PROBE_DUP <= 15) { da_attn_phase<PROBE_DUP >= 11 && PROBE_DUP <= 15 ? PROBE_DUP - 10 : 0>(P, lam, 1.0f - lam_init, lds, tid, ctx_q); __syncthreads(); }
    if (PROBE_DUP >= 11 && PROBE_DUP <= 15) da_attn_phase(P, lam, 1.0f - lam_init, lds, tid, ctx_q); }
__device__ NOINL void ph_route(int wv_, LAS unsigned char* lds_, int L_, int M_) { CP P = GETP(); LAS unsigned char* lds = uni_lds(lds_); const int L = uni(L_), Mrows = uni(M_); PH_IDS
#pragma unroll 1
    for (int rep = 0; rep < (PROBE_DUP == 4 ? 2 : 1); ++rep) route_phase(P, L, Mrows, lds, tid, lane, wid, gw, NGW); }
__device__ NOINL void ph_gather(int wv_, LAS unsigned char* lds_, int L_, int M_) { CP P = GETP(); LAS unsigned char* lds = uni_lds(lds_); const int L = uni(L_), Mrows = uni(M_); PH_IDS
    if (PROBE_DUP == 3) { gather_phase<0>(P, L, Mrows, lds, wid, lane, gw, NGW, true); }
    if (PROBE_DUP == 7) { gather_phase<1>(P, L, Mrows, lds, wid, lane, gw, NGW, true); }
    if (PROBE_DUP == 17) { gather_phase<3>(P, L, Mrows, lds, wid, lane, gw, NGW, true); }
    if (PROBE_DUP == 8) { gather_phase<2>(P, L, Mrows, lds, wid, lane, gw, NGW, true); }
    gather_phase<0>(P, L, Mrows, lds, wid, lane, gw, NGW); }

enum GemmId { G_GM_IN = 0, G_GM_OUT, G_MLA_IN, G_MLA_UQ, G_MLA_UKV, G_MLA_OUT, G_DA_IN, G_DA_OUT, G_PEER_Q };
__device__ NOINL void ph_gemm(int wv_, LAS unsigned char* lds_, int id_, int L_, int M_) {
    CP P = GETP(); LAS unsigned char* lds = uni_lds(lds_); const int id = uni(id_), L = uni(L_), Mrows = uni(M_); PH_IDS
    unsigned char* ws = P->ws; const int jj = L / 3;
    size_t a = WS_H, b = 0, o = 0; int M = MT, N = 2048, K = 2048, act = 0, rope = 0;
    switch (id) {
        case G_GM_IN:   a = WS_H;    b = WS_GMWIN + (size_t)jj * 4096 * 2048 * 2;  o = WS_Z;  M = Mrows; N = 4096; K = 2048; act = 1; break;
        case G_GM_OUT:  a = WS_G;    b = WS_GMWOUT + (size_t)jj * 2048 * 2048 * 2; o = WS_Y;  M = Mrows; N = 2048; K = 2048; break;
        case G_MLA_IN:  a = WS_H;    b = WS_MLAIN;  o = WS_C;  N = 1280; K = 2048; break;
        case G_MLA_UQ:  a = WS_CQN;  b = WS_MLAUQ;  o = WS_QM; N = 3072; K = 512;  rope = (ROPE_TEST == 2) ? 0 : 2; break;
        case G_MLA_UKV: a = WS_CKVN; b = WS_MLAUKV; o = WS_KV; N = 4096; K = 512;  break;
        case G_MLA_OUT: a = WS_G;    b = WS_MLAOUT; o = WS_Y;  N = 2048; K = 2048; break;
        case G_DA_IN:   a = WS_H;    b = WS_DAIN;   o = WS_Z;  N = 6144; K = 2048; rope = (ROPE_TEST == 1) ? 0 : 1; break;
        case G_DA_OUT:  a = WS_G;    b = WS_DAOUT;  o = WS_Y;  M = Mrows; N = 2048; K = 2048; break;
        default:        a = WS_H;    b = WS_PWQ + (size_t)L * 2048 * 2048 * 2;     o = WS_QP; M = Mrows; N = 2048; K = 2048; break;
    }
    pg8::Gemm g{(const pg8::bf16_t*)(ws + a), (const pg8::bf16_t*)(ws + b), M, N, K}; pg8::StaticOrder S; S.init(M, N, (int)gridDim.x, id == G_MLA_UKV ? (int)gridDim.x - 1 - (int)blockIdx.x : (int)blockIdx.x);
    pg8::EpiR E{(pg8::bf16_t*)(ws + o), N, act, rope, (const float*)(ws + WS_ROPE)};
#pragma unroll 1
    for (int rep = 0; rep < ((PROBE_DUP == 1 || (PROBE_DUP == 31 && id == G_MLA_OUT) || (PROBE_DUP == 32 && id == G_DA_OUT)) ? 2 : 1); ++rep) { pg8::gemm_phase<pg8::EpiR, pg8::StaticOrder, true, true>((PG8_LAS unsigned char*)lds, g, S, E, tid); __syncthreads(); }
#if TAIL_REMAP
    int TL = -1; bool tail_u = false;
    if (L == 0) { if (id == G_GM_IN) { TL = 0; tail_u = true; } else if (id == G_GM_OUT) { TL = 0; } else if (id == G_PEER_Q) { TL = 1; tail_u = true; } }
    else if (L == 1) { if (id == G_MLA_IN) { TL = 1; } else if (id == G_MLA_OUT) { TL = 2; tail_u = true; } else if (id == G_PEER_Q) { TL = 2; } }
    else if (L == 2) { if (id == G_DA_IN) { TL = 3; tail_u = true; } else if (id == G_DA_OUT) { TL = 3; } }
    if (TL >= 0) {
        const int units = (M / 256) * (N / 256), G = (int)gridDim.x, tail = units % G, c = (int)blockIdx.x;
        const float* src = (tail_u ? P->in[11] : P->in[12]) + (size_t)TL * 16384 * 2048; unsigned char* dst = ws + WS_PU + (size_t)TL * 16384 * PREC;
#else
#if TAIL_L3MOVE
    const bool l3u = (id == G_MLA_IN && L == 1), l3v = (id == G_DA_IN && L == 2), skip = (L == NLAYER - 2) && (id == G_DA_OUT || id == G_PEER_Q);
    const bool l0v = P0_NOV && (id == G_GM_IN && L == 0);
    const bool tail_u = !skip && ((id == G_GM_OUT || id == G_MLA_OUT || id == G_DA_OUT) || l3u), tail_v = !skip && ((id == G_PEER_Q) || l3v || l0v);
    const int TLx = (l3u || l3v) ? NLAYER - 1 : (l0v ? 0 : L + 1);
    if ((tail_u || tail_v) && TLx < NLAYER) {
        const int units = (M / 256) * (N / 256), G = (int)gridDim.x, tail = units % G, c = (int)blockIdx.x;
        const float* src = (tail_u ? P->in[11] : P->in[12]) + (size_t)TLx * 16384 * 2048; unsigned char* dst = ws + WS_PU + (size_t)TLx * 16384 * PREC;
#else
    const bool tail_u = (id == G_GM_OUT || id == G_MLA_OUT || id == G_DA_OUT), tail_v = (id == G_PEER_Q);
    if ((tail_u || tail_v) && L + 1 < NLAYER) {
        const int units = (M / 256) * (N / 256), G = (int)gridDim.x, tail = units % G, c = (int)blockIdx.x;
        const float* src = (tail_u ? P->in[11] : P->in[12]) + (size_t)(L + 1) * 16384 * 2048; unsigned char* dst = ws + WS_PU + (size_t)(L + 1) * 16384 * PREC;
#endif
#endif
        LAS float* scr = (LAS float*)(lds + wid * 16384);
        if (tail != 0 && c >= tail) cvt_table_fp6(src, dst, 16384, tail_u ? U_SCALE : V_SCALE, scr, lane, (c - tail) * NWAVES + wid, (G - tail) * NWAVES, tail_u ? 0 : 1);
        else if (tail == 0) {
#pragma unroll 1
            for (int rep = 0; rep < (PROBE_DUP == 18 ? 3 : 1); ++rep) cvt_table_fp6(src, dst, 16384, tail_u ? U_SCALE : V_SCALE, scr, lane, gw, NGW, tail_u ? 0 : 1); }
    }
}

__global__ void __launch_bounds__(NWAVES * 64, 2) mk_fwd(Params Pv) {
    extern __shared__ __attribute__((aligned(16))) unsigned char lds_g[];
    LAS unsigned char* lds = (LAS unsigned char*)lds_g;
    const int wv = __builtin_amdgcn_readfirstlane((int)threadIdx.x >> 6);
    const int tid = wv * 64 + lane_id_fresh();
    for (int u = tid; u < (LDS_BYTES - RING_BYTES) / 4; u += NWAVES * 64) ((LAS unsigned*)(lds + RING_BYTES))[u] = 0u;
    __syncthreads();
    const int lo = Pv.ph_lo, hi = Pv.ph_hi;
    unsigned* barw = (unsigned*)(Pv.ws + WS_CTL) + CW_BAR;
    XcdBarrier bar; bar.bar = barw; bar.x = 0; bar.st = nullptr;
    if (hi - lo > 1) bar = xcd_barrier_post(barw, (volatile LAS unsigned*)(lds + MISC_OFF) + 8, tid == 0);
    int ph = 0;
#ifndef SEL
#define SELP(k) true
#else
#define SELP(k) ((k) == SEL)
#endif
    enum { RUN_BASE = __COUNTER__ + 1 };
#define RUN(call) do { if (SELP(__COUNTER__ - RUN_BASE) && ph >= lo && ph < hi) { call; } if (ph >= lo && ph + 1 < hi) { xcd_barrier(bar, wv == 0 && lane_id_fresh() == 0); if (PROBE_DUP == 30) { xcd_barrier(bar, wv == 0 && lane_id_fresh() == 0); xcd_barrier(bar, wv == 0 && lane_id_fresh() == 0); } } ++ph; } while (0)
    RUN(ph_prologue(wv, lds));
    RUN(ph_modreduce(wv));
    RUN(ph_first(wv, lds));
#define LAYER(LL) do { constexpr int L = (LL); constexpr int kind = L % 3, jj = L / 3; constexpr int Mrows = (L == NLAYER - 1) ? ML : MT; \
        constexpr bool ctx_dead = (L == NLAYER - 2) && ((NLAYER - 1) % 3 == 0) && (kind != 0); constexpr int Mlive = ctx_dead ? ML : Mrows; \
        if (kind == 0) {                          \
            RUN(ph_gemm(wv, lds, G_GM_IN, L, Mrows)); \
            RUN(ph_vstats(wv, Mrows)); \
            RUN(ph_spatial(wv, lds, jj, Mrows)); \
            RUN(ph_gemm(wv, lds, G_GM_OUT, L, Mrows)); \
        } else if (kind == 1) {                   \
            RUN(ph_gemm(wv, lds, G_MLA_IN, L, Mrows)); \
            RUN(ph_mla_norm(wv)); \
            RUN(ph_gemm(wv, lds, G_MLA_UQ, L, Mrows); ph_gemm(wv, lds, G_MLA_UKV, L, Mrows)); \
            if (ROPE_TEST == 2) { RUN(ph_rope(wv, 0)); } \
            RUN(ph_attn_mla(wv, lds)); \
            RUN(ph_gemm(wv, lds, G_MLA_OUT, L, Mrows)); \
        } else {                                  \
            RUN(ph_gemm(wv, lds, G_DA_IN, L, Mrows); if (ROPE_TEST == 1) { __syncthreads(); } ); \
            if (ROPE_TEST == 1) { RUN(ph_rope(wv, 1)); } \
            RUN(ph_attn_da(wv, lds, L, !ctx_dead)); \
            RUN(ph_gemm(wv, lds, G_DA_OUT, L, Mlive)); \
        } \
        RUN(ph_postmix(wv, lds, L, Mlive));                \
        RUN(ph_gemm(wv, lds, G_PEER_Q, L, Mlive));    \
        RUN(ph_route(wv, lds, L, Mlive));             \
        RUN(ph_gather(wv, lds, L, Mlive));            \
    } while (0)
    LAYER(0); LAYER(1); LAYER(2); LAYER(3);
#undef LAYER
#undef RUN
}

extern "C" void kernel_launch(void* const* d_in, const int* in_sizes, int n_in, void* d_out, int out_size, void* d_ws, size_t ws_size, hipStream_t stream) {
    static int grid = 0;
    if (grid == 0) {
        if (n_in != 29 || in_sizes[0] != ML * DM || out_size != ML * DM || ws_size < WS_END) {
            fprintf(stderr, "kernel_launch: shape mismatch: n_in %d in0 %d out %d ws %zu (need %zu); nothing launched\n", n_in, n_in > 0 ? in_sizes[0] : -1, out_size, ws_size, (size_t)WS_END); grid = -1; return; }
        int dev = 0, cus = 0, per_cu = 0;
        if (hipGetDevice(&dev) != hipSuccess || hipDeviceGetAttribute(&cus, hipDeviceAttributeMultiprocessorCount, dev) != hipSuccess) { fprintf(stderr, "kernel_launch: device query failed\n"); grid = -1; return; }
        if (hipFuncSetAttribute((const void*)mk_fwd, hipFuncAttributeMaxDynamicSharedMemorySize, LDS_BYTES) != hipSuccess) { fprintf(stderr, "kernel_launch: hipFuncSetAttribute failed\n"); grid = -1; return; }
        if (hipOccupancyMaxActiveBlocksPerMultiprocessor(&per_cu, (const void*)mk_fwd, NWAVES * 64, LDS_BYTES) != hipSuccess || per_cu < 1)
            fprintf(stderr, "kernel_launch: note: occupancy query reports %d workgroups per CU\n", per_cu);
        (void)hipGetLastError();
        grid = cus;
    }
    if (grid < 0) return;
    if (hipMemsetAsync((char*)d_ws + WS_CTL, 0, CTL_ZERO_BYTES, stream) != hipSuccess) { fprintf(stderr, "kernel_launch: memset failed\n"); return; }
    Params p{};
    for (int i = 0; i < 29; ++i) p.in[i] = (const float*)d_in[i];
    p.out = (float*)d_out; p.ws = (unsigned char*)d_ws;
#if MK_ONE_LAUNCH
    p.ph_lo = 0; p.ph_hi = NPH;
    hipLaunchKernelGGL(mk_fwd, dim3(grid), dim3(NWAVES * 64), LDS_BYTES, stream, p);
#else
    for (int li = 0; li < NPH; ++li) { p.ph_lo = li; p.ph_hi = li + 1; hipLaunchKernelGGL(mk_fwd, dim3(grid), dim3(NWAVES * 64), LDS_BYTES, stream, p); }
#endif
    const hipError_t le = hipPeekAtLastError();
    if (le != hipSuccess) fprintf(stderr, "kernel_launch: launch failed: %s\n", hipGetErrorName(le));
}
```

```cpp
#include <hip/hip_runtime.h>
#include <cstdio>
#include <cstdint>
#ifndef MK_ONE_LAUNCH
#define MK_ONE_LAUNCH 1
#endif
__device__ __forceinline__ int launder_v(int v) { asm volatile("" : "+v"(v)); return v; }
__device__ __forceinline__ int lane_id_fresh() { unsigned m = ~0u; asm volatile("" : "+s"(m)); return (int)__builtin_amdgcn_mbcnt_hi(m, __builtin_amdgcn_mbcnt_lo(m, 0u)); }
#ifndef WT_STORES
#define WT_STORES 0
#endif
typedef unsigned wt_u32x4 __attribute__((ext_vector_type(4)));
__device__ __forceinline__ void st16_wt(void* p, wt_u32x4 v) {
#if WT_STORES
    asm volatile("global_store_dwordx4 %0, %1, off sc1\n\ts_nop 1" :: "v"(p), "v"(v) : "memory");
#else
    *(wt_u32x4*)p = v;
#endif
}
namespace pg8 {
#define PG8_LAS __attribute__((address_space(3)))
typedef unsigned short bf16_t;
typedef short bf16x8 __attribute__((ext_vector_type(8)));
typedef float f32x4 __attribute__((ext_vector_type(4)));
typedef unsigned u32x4 __attribute__((ext_vector_type(4)));
constexpr int BM = 256, BK = 64, HALF = 128, HTB = HALF * BK * 2  , STAGE_BYTES = 8 * HTB, NXCD = 8, WGM = 8;

__host__ __device__ __forceinline__ int lds_byte(int r, int c) { const int st = (r >> 4) * 2 + (c >> 5), rr = r & 15, cc = c & 31, ob = rr * 64 + cc * 2; return st * 1024 + (ob ^ (((ob >> 9) & 1) << 5)); }
__host__ __device__ __forceinline__ void stage_rc(int b, int& R, int& C) { const int st = b / 1024, sb = b % 1024, swz = sb ^ (((sb >> 9) & 1) << 5); R = (st >> 1) * 16 + swz / 64; C = (st & 1) * 32 + (swz % 64) / 2; }
__host__ __device__ __forceinline__ int perm32(int rho) { const int n = rho >> 4, i = rho & 15; return 8 * (i >> 2) + 4 * n + (i & 3); }

struct Unit { int pm, pn; };
struct Gemm { const bf16_t* A; const bf16_t* Bt; int M, N, K; };

struct StaticOrder {
    int nM, nN, nwg, G, c;
    __host__ __device__ void init(int M, int N, int G_, int c_) { nM = M / BM; nN = N / BM; nwg = nM * nN; G = G_; c = c_; }
    __host__ __device__ bool next(int i, Unit& u) const {
        const long L = (long)i * G + c; if (L >= nwg) return false;
        int wgid = (int)L; { const int q = nwg / NXCD, r = nwg % NXCD, xcd = wgid % NXCD, off = wgid / NXCD; wgid = (xcd < r ? xcd * (q + 1) : r * (q + 1) + (xcd - r) * q) + off; }
        const int nig = WGM * nN, gid = wgid / nig, fm = gid * WGM, gsz = (nM - fm) < WGM ? (nM - fm) : WGM;
        u.pm = fm + ((wgid % nig) % gsz); u.pn = (wgid % nig) / gsz; return true;
    }
    __device__ __forceinline__ void a_ready(const Unit&) const {}
    __device__ __forceinline__ void done(const Unit&) const {}
};

__device__ __forceinline__ unsigned cvt_pk_bf16(float lo, float hi) { unsigned r; asm volatile("v_cvt_pk_bf16_f32 %0, %1, %2" : "=v"(r) : "v"(lo), "v"(hi)); return r; }
typedef float f32x2 __attribute__((ext_vector_type(2)));
__device__ __forceinline__ f32x2 gelu_pk(f32x2 v) {
    const f32x2 av = __builtin_elementwise_abs(v), d = av * 0.2316418882f + 1.0f;
    f32x2 t; t.x = __builtin_amdgcn_rcpf(d.x); t.y = __builtin_amdgcn_rcpf(d.y);
    f32x2 q = t * 0.5307027145f + (-0.7265760135f); q = q * t + 0.7107068705f; q = q * t + (-0.142248368f); q = q * t + 0.127414796f; q = q * t;
    const f32x2 s = (v * v) * (-0.72134752044f);
    f32x2 e; e.x = __builtin_amdgcn_exp2f(s.x); e.y = __builtin_amdgcn_exp2f(s.y);
    const f32x2 m = v * (q * e), r = v - m;
    f32x2 o; o.x = v.x < 0.f ? m.x : r.x; o.y = v.y < 0.f ? m.y : r.y; return o;
}

template <int ACT  > struct EpiBf16 {
    static constexpr bool PERM = true, AFTER_DRAIN = false; static_assert(ACT == 0 || ACT == 1, "EpiBf16: ACT is 0 (none) or 1 (gelu_pk)");
    bf16_t* O; int ldc; const float* bias; int split_cols; size_t split_stride; float scale0;
    __device__ __forceinline__ void operator()(const f32x4 (&acc)[2][2][4][2], const Unit& u, int wr, int wc, int fr, int fq) const {
        const int row0 = u.pm * BM + wr * 64 + fr; int colt = u.pn * BM; bf16_t* base = O;
        float sc = 1.f; if (split_cols) { const int t = colt / split_cols; base += (size_t)t * split_stride; colt -= t * split_cols; if (t == 0) sc = scale0; }
        const int col0 = colt + wc * 32 + 8 * fq, bcol0 = u.pn * BM + wc * 32 + 8 * fq;
        f32x4 bv[2][2];
#pragma unroll
        for (int bj = 0; bj < 2; ++bj)
#pragma unroll
            for (int n = 0; n < 2; ++n) bv[bj][n] = bias ? *(const f32x4*)(bias + bcol0 + bj * HALF + 4 * n) : (f32x4){0.f, 0.f, 0.f, 0.f};
#pragma unroll
        for (int ai = 0; ai < 2; ++ai)
#pragma unroll
            for (int m = 0; m < 4; ++m) { bf16_t* rowp = base + (size_t)(row0 + ai * HALF + m * 16) * ldc + col0;
#pragma unroll
                for (int bj = 0; bj < 2; ++bj) { f32x4 v0 = acc[ai][bj][m][0] + bv[bj][0], v1 = acc[ai][bj][m][1] + bv[bj][1];
                    if (ACT == 1) { f32x2 a = gelu_pk((f32x2){v0[0], v0[1]}), b = gelu_pk((f32x2){v0[2], v0[3]}), c = gelu_pk((f32x2){v1[0], v1[1]}), d = gelu_pk((f32x2){v1[2], v1[3]});
                        v0 = (f32x4){a.x, a.y, b.x, b.y}; v1 = (f32x4){c.x, c.y, d.x, d.y}; }
                    v0 = v0 * sc; v1 = v1 * sc; u32x4 w; w.x = cvt_pk_bf16(v0[0], v0[1]); w.y = cvt_pk_bf16(v0[2], v0[3]); w.z = cvt_pk_bf16(v1[0], v1[1]); w.w = cvt_pk_bf16(v1[2], v1[3]);
                    *(u32x4*)(rowp + bj * HALF) = w; } }
    }
};
template <class Epi, class Sched, bool ALIGN_EPI = false, bool SP2 = false>
__device__ __forceinline__ void gemm_phase(PG8_LAS unsigned char* lds, const Gemm g, const Sched& S, const Epi& E, const int tid_in) {
    const int tid = launder_v(tid_in) & 511, wid = __builtin_amdgcn_readfirstlane(tid >> 6), lane = tid & 63, wr = wid >> 2, wc = wid & 3, fr = lane & 15, fq = lane >> 4;
    const int K = g.K, nt = K / BK;
    unsigned voffA[2], voffB[2];
#pragma unroll
    for (int i = 0; i < 2; ++i) { int R, C; stage_rc(tid * 16 + i * 8192, R, C); const int Rb = Epi::PERM ? ((R & ~31) + perm32(R & 31)) : R;
        voffA[i] = (unsigned)(R * K + C) * 2u; voffB[i] = (unsigned)(Rb * K + C) * 2u; }
    const size_t kstep = (size_t)(BK * 2);
    const size_t hstep = (size_t)HALF * K * 2;
    const size_t tstep = 2 * hstep;
    const unsigned ldsw = (unsigned)wid * 1024u;
    const int aoff = lds_byte(wr * 64 + fr, fq * 8), boff = lds_byte(wc * 32 + fr, fq * 8);
#define PG8_SA(b, h) (((b) * 2 + (h)) * HTB)
#define PG8_SB(b, h) ((4 + (b) * 2 + (h)) * HTB)
#define PG8_STAGE(bufoff, gbase, voff) do { _Pragma("unroll") for (int _i = 0; _i < 2; ++_i) \
        __builtin_amdgcn_global_load_lds((const unsigned*)((const char*)(gbase) + (voff)[_i]), (PG8_LAS unsigned*)(lds + (bufoff) + ldsw + _i * 8192), 16, 0, 0); } while (0)
#define PG8_LDA(dst, b, h) do { _Pragma("unroll") for (int m = 0; m < 4; ++m) _Pragma("unroll") for (int k = 0; k < 2; ++k) dst[m][k] = *(const PG8_LAS bf16x8*)(lds + PG8_SA(b, h) + aoff + m * 2048 + k * 1024); } while (0)
#define PG8_LDB(dst, b, h) do { _Pragma("unroll") for (int n = 0; n < 2; ++n) _Pragma("unroll") for (int k = 0; k < 2; ++k) dst[n][k] = *(const PG8_LAS bf16x8*)(lds + PG8_SB(b, h) + boff + n * 2048 + k * 1024); } while (0)
#define PG8_MMA(ai, bj, At, Bt) do { __builtin_amdgcn_s_setprio(1); _Pragma("unroll") for (int m = 0; m < 4; ++m) _Pragma("unroll") for (int n = 0; n < 2; ++n) _Pragma("unroll") for (int k = 0; k < 2; ++k) \
        acc[ai][bj][m][n] = __builtin_amdgcn_mfma_f32_16x16x32_bf16(Bt[n][k], At[m][k], acc[ai][bj][m][n], 0, 0, 0); __builtin_amdgcn_s_setprio(0); } while (0)
#define PG8_WAIT_V(n) asm volatile("s_waitcnt vmcnt(" #n ")" ::: "memory")
#define PG8_WAIT_L(n) asm volatile("s_waitcnt lgkmcnt(" #n ")" ::: "memory")
#define PG8_BAR __builtin_amdgcn_s_barrier()
#define PG8_SCHED __builtin_amdgcn_sched_barrier(0)
    Unit cur, nxt; int ui = 0;
    if (!S.next(0, cur)) return;
    f32x4 acc[2][2][4][2];
#pragma unroll
    for (int a = 0; a < 2; ++a)
#pragma unroll
        for (int b = 0; b < 2; ++b)
#pragma unroll
            for (int m = 0; m < 4; ++m)
#pragma unroll
                for (int n = 0; n < 2; ++n) acc[a][b][m][n] = (f32x4){0.f, 0.f, 0.f, 0.f};
    bf16x8 At[4][2], B0[2][2], B1[2][2];
    const char* cA = (const char*)g.A + (size_t)cur.pm * tstep; const char* cB = (const char*)g.Bt + (size_t)cur.pn * tstep;
    S.a_ready(cur);
    if constexpr (SP2) {
        PG8_STAGE(PG8_SB(0, 0), cB, voffB); PG8_STAGE(PG8_SB(0, 1), cB + hstep, voffB); PG8_STAGE(PG8_SA(0, 0), cA, voffA); PG8_STAGE(PG8_SA(0, 1), cA + hstep, voffA);
        if (wr == 1) PG8_BAR;
        PG8_WAIT_V(2); PG8_BAR;
        PG8_STAGE(PG8_SB(1, 0), cB + kstep, voffB); PG8_STAGE(PG8_SA(1, 0), cA + kstep, voffA); PG8_STAGE(PG8_SB(1, 1), cB + hstep + kstep, voffB);
        PG8_WAIT_V(6); PG8_BAR;
    } else {
        PG8_STAGE(PG8_SB(0, 0), cB, voffB); PG8_STAGE(PG8_SA(0, 0), cA, voffA); PG8_STAGE(PG8_SB(0, 1), cB + hstep, voffB); PG8_STAGE(PG8_SA(0, 1), cA + hstep, voffA);
        if (wr == 1) PG8_BAR;
        PG8_WAIT_V(4); PG8_BAR;
        PG8_STAGE(PG8_SB(1, 0), cB + kstep, voffB); PG8_STAGE(PG8_SA(1, 0), cA + kstep, voffA); PG8_STAGE(PG8_SB(1, 1), cB + hstep + kstep, voffB);
        PG8_WAIT_V(6); PG8_BAR;
    }
    for (;;) {
        const bool has_next = S.next(ui + 1, nxt);
        const char* nA = has_next ? (const char*)g.A + (size_t)nxt.pm * tstep : cA; const char* nB = has_next ? (const char*)g.Bt + (size_t)nxt.pn * tstep : cB;
        for (int t = 0; t < nt; t += 2) {
            const bool last = (t == nt - 2);
            const char* a1 = cA + (size_t)(t + 1) * kstep;
            const char* a2 = last ? nA : cA + (size_t)(t + 2) * kstep; const char* b2 = last ? nB : cB + (size_t)(t + 2) * kstep;
            const char* a3 = a2 + kstep; const char* b3 = b2 + kstep;
            if (last && has_next) S.a_ready(nxt);
            if constexpr (SP2) {
            PG8_LDB(B0, 0, 0); PG8_LDB(B1, 0, 1); PG8_SCHED; PG8_LDA(At, 0, 0); PG8_STAGE(PG8_SA(1, 1), a1 + hstep, voffA);
            PG8_WAIT_V(8); PG8_WAIT_L(0); PG8_BAR; PG8_MMA(0, 0, At, B0); PG8_MMA(0, 1, At, B1); PG8_BAR; PG8_SCHED;
            PG8_LDA(At, 0, 1); PG8_STAGE(PG8_SB(0, 0), b2, voffB); PG8_STAGE(PG8_SB(0, 1), b2 + hstep, voffB); PG8_STAGE(PG8_SA(0, 0), a2, voffA);
            PG8_WAIT_V(8); PG8_WAIT_L(0); PG8_BAR; PG8_MMA(1, 0, At, B0); PG8_MMA(1, 1, At, B1); PG8_BAR; PG8_SCHED;
            PG8_LDB(B0, 1, 0); PG8_LDB(B1, 1, 1); PG8_SCHED; PG8_LDA(At, 1, 0); PG8_STAGE(PG8_SA(0, 1), a2 + hstep, voffA);
            PG8_WAIT_V(8); PG8_WAIT_L(0); PG8_BAR; PG8_MMA(0, 0, At, B0); PG8_MMA(0, 1, At, B1); PG8_BAR; PG8_SCHED;
            PG8_LDA(At, 1, 1); PG8_STAGE(PG8_SB(1, 0), b3, voffB); PG8_STAGE(PG8_SB(1, 1), b3 + hstep, voffB); PG8_STAGE(PG8_SA(1, 0), a3, voffA);
            PG8_WAIT_V(8); PG8_WAIT_L(0); PG8_BAR; PG8_MMA(1, 0, At, B0); PG8_MMA(1, 1, At, B1); PG8_BAR; PG8_SCHED;
            } else {
            PG8_LDB(B0, 0, 0); PG8_SCHED; PG8_LDA(At, 0, 0); PG8_STAGE(PG8_SA(1, 1), a1 + hstep, voffA);
            PG8_WAIT_L(8); PG8_BAR; PG8_WAIT_L(0); PG8_MMA(0, 0, At, B0); PG8_BAR; PG8_SCHED;
            PG8_LDB(B1, 0, 1); PG8_STAGE(PG8_SB(0, 0), b2, voffB);
            PG8_BAR; PG8_WAIT_L(0); PG8_MMA(0, 1, At, B1); PG8_BAR;
            PG8_LDA(At, 0, 1); PG8_STAGE(PG8_SA(0, 0), a2, voffA);
            PG8_BAR; PG8_WAIT_L(0); PG8_MMA(1, 0, At, B0); PG8_BAR; PG8_SCHED;
            PG8_STAGE(PG8_SB(0, 1), b2 + hstep, voffB);
            PG8_WAIT_V(6); PG8_BAR; PG8_MMA(1, 1, At, B1); PG8_BAR;
            PG8_LDB(B0, 1, 0); PG8_SCHED; PG8_LDA(At, 1, 0); PG8_STAGE(PG8_SA(0, 1), a2 + hstep, voffA);
            PG8_WAIT_L(8); PG8_BAR; PG8_WAIT_L(0); PG8_MMA(0, 0, At, B0); PG8_BAR; PG8_SCHED;
            PG8_LDB(B1, 1, 1); PG8_STAGE(PG8_SB(1, 0), b3, voffB);
            PG8_BAR; PG8_WAIT_L(0); PG8_MMA(0, 1, At, B1); PG8_BAR;
            PG8_LDA(At, 1, 1); PG8_STAGE(PG8_SA(1, 0), a3, voffA);
            PG8_BAR; PG8_WAIT_L(0); PG8_MMA(1, 0, At, B0); PG8_BAR; PG8_SCHED;
            PG8_STAGE(PG8_SB(1, 1), b3 + hstep, voffB);
            PG8_WAIT_V(6); PG8_BAR; PG8_MMA(1, 1, At, B1); PG8_BAR;
            }
        }
        if constexpr (ALIGN_EPI) { if (wr == 0) PG8_BAR; }
        if constexpr (!Epi::AFTER_DRAIN) { E(acc, cur, wr, wc, fr, fq); S.done(cur); }
        if (!has_next) break;
#pragma unroll
        for (int a = 0; a < 2; ++a)
#pragma unroll
            for (int b = 0; b < 2; ++b)
#pragma unroll
                for (int m = 0; m < 4; ++m)
#pragma unroll
                    for (int n = 0; n < 2; ++n) acc[a][b][m][n] = (f32x4){0.f, 0.f, 0.f, 0.f};
        cur = nxt; cA = nA; cB = nB; ++ui;
        if constexpr (ALIGN_EPI) { if (wr == 1) PG8_BAR; }
    }
    PG8_WAIT_V(0);
    if constexpr (!ALIGN_EPI) { if (wr == 0) PG8_BAR; }
    PG8_BAR;
    if constexpr (Epi::AFTER_DRAIN) { E.fused(acc, cur, wr, wc, fr, fq, lds, wid, lane); S.done(cur); }
#undef PG8_SA
#undef PG8_SB
#undef PG8_STAGE
#undef PG8_LDA
#undef PG8_LDB
#undef PG8_MMA
#undef PG8_WAIT_V
#undef PG8_WAIT_L
#undef PG8_BAR
#undef PG8_SCHED
}
}

namespace pg8 {
__device__ __forceinline__ float gelu_tanh(float x) {
    const float t = x * (1.5957691216057308f + 0.07135481627f * x * x);
    const float e = __builtin_amdgcn_exp2f(-1.4426950408889634f * t);
    return x * __builtin_amdgcn_rcpf(1.0f + e);
}
template <int ACT> struct EpiT {
    static constexpr bool PERM = true, AFTER_DRAIN = false;
    bf16_t* O; int ldc;
    __device__ __forceinline__ void operator()(const f32x4 (&acc)[2][2][4][2], const Unit& u, int wr, int wc, int fr, int fq) const {
        const int row0 = u.pm * BM + wr * 64 + fr; const int col0 = u.pn * BM + wc * 32 + 8 * fq;
#pragma unroll
        for (int ai = 0; ai < 2; ++ai)
#pragma unroll
            for (int m = 0; m < 4; ++m) { bf16_t* rowp = O + (size_t)(row0 + ai * HALF + m * 16) * ldc + col0;
#pragma unroll
                for (int bj = 0; bj < 2; ++bj) { f32x4 v0 = acc[ai][bj][m][0], v1 = acc[ai][bj][m][1];
                    if (ACT == 2) { v0 = (f32x4){gelu_tanh(v0[0]), gelu_tanh(v0[1]), gelu_tanh(v0[2]), gelu_tanh(v0[3])}; v1 = (f32x4){gelu_tanh(v1[0]), gelu_tanh(v1[1]), gelu_tanh(v1[2]), gelu_tanh(v1[3])}; }
                    u32x4 w; w.x = cvt_pk_bf16(v0[0], v0[1]); w.y = cvt_pk_bf16(v0[2], v0[3]); w.z = cvt_pk_bf16(v1[0], v1[1]); w.w = cvt_pk_bf16(v1[2], v1[3]);
                    ::st16_wt(rowp + bj * HALF, w); } }
    }
};
struct EpiR {
    static constexpr bool PERM = true, AFTER_DRAIN = false;
    bf16_t* O; int ldc; int act; int rope; const float* ropet;
    __device__ __forceinline__ void operator()(const f32x4 (&acc)[2][2][4][2], const Unit& u, int wr, int wc, int fr, int fq) const {
        const int row0 = u.pm * BM + wr * 64 + fr; const int col0 = u.pn * BM + wc * 32 + 8 * fq;
        const bool rrows = rope != 0 && u.pm < 64;
#pragma unroll
        for (int ai = 0; ai < 2; ++ai)
#pragma unroll
            for (int m = 0; m < 4; ++m) { const int grow = row0 + ai * HALF + m * 16; bf16_t* rowp = O + (size_t)grow * ldc + col0;
#pragma unroll
                for (int bj = 0; bj < 2; ++bj) { f32x4 v0 = acc[ai][bj][m][0], v1 = acc[ai][bj][m][1];
                    if (act) { v0 = (f32x4){gelu_tanh(v0[0]), gelu_tanh(v0[1]), gelu_tanh(v0[2]), gelu_tanh(v0[3])}; v1 = (f32x4){gelu_tanh(v1[0]), gelu_tanh(v1[1]), gelu_tanh(v1[2]), gelu_tanh(v1[3])}; }
                    if (rrows) { const int blk = u.pn * 8 + bj * 4 + wc; const int b6 = blk % 6; const bool on = rope == 1 ? (blk < 128) : (b6 >= 4); const int half = rope == 1 ? (blk & 1) : (b6 - 4);
                        if (on) { const int t = grow & 8191; const int pos = half ? (t & 63) : (t >> 6);
                            const float* cp = ropet + pos * 16 + 8 * (fq & 1); const f32x4 c0 = *(const f32x4*)cp, c1 = *(const f32x4*)(cp + 4), s0 = *(const f32x4*)(cp + 2048), s1 = *(const f32x4*)(cp + 2052);
                            f32x4 p0, p1;
#pragma unroll
                            for (int i = 0; i < 4; ++i) { const float a_ = v0[i], b_ = v1[i];
                                const auto r0 = __builtin_amdgcn_permlane32_swap(__float_as_uint(a_), __float_as_uint(a_), false, false);
                                const auto r1 = __builtin_amdgcn_permlane32_swap(__float_as_uint(b_), __float_as_uint(b_), false, false);
                                const unsigned x0_ = (fq & 2) ? r0[0] : r0[1], x1_ = (fq & 2) ? r1[0] : r1[1]; p0[i] = __uint_as_float(x0_); p1[i] = __uint_as_float(x1_); }
                            if (fq & 2) { v0 = p0 * s0 + v0 * c0; v1 = p1 * s1 + v1 * c1; } else { v0 = v0 * c0 - p0 * s0; v1 = v1 * c1 - p1 * s1; } } }
                    u32x4 w; w.x = cvt_pk_bf16(v0[0], v0[1]); w.y = cvt_pk_bf16(v0[2], v0[3]); w.z = cvt_pk_bf16(v1[0], v1[1]); w.w = cvt_pk_bf16(v1[2], v1[3]);
                    ::st16_wt(rowp + bj * HALF, w); } }
    }
};
}

constexpr int DM = 2048, NBATCH = 2, SEQ = 8192, CTXL = 256;
constexpr int ML = NBATCH * SEQ;
constexpr int MC = NBATCH * CTXL;
constexpr int MT = ML + MC;
constexpr int NLAYER = 4;
constexpr float ALPHA = 1.6817928305074290f, LN_EPS = 1e-6f;
constexpr int NWAVES = 8;
constexpr float U_SCALE = 64.0f, V_SCALE = 4.0f;
constexpr int PROW = 1536;
#ifndef PEER_V4
#define PEER_V4 1
#endif
#ifndef PEER_U4
#define PEER_U4 1
#endif
constexpr int PREC = PEER_U4 ? 2048 : PEER_V4 ? 2560 : 2 * PROW;
constexpr int NPH = 35;

constexpr size_t MiB = 1ull << 20;
constexpr size_t WS_CTL = 0, CTL_ZERO_BYTES = 1 * MiB;
constexpr int    CW_BAR = 4096;
constexpr size_t WS_MOD = 128 * 1024;
constexpr size_t WS_VST = 1 * MiB;
constexpr size_t WS_ROPE = 1 * MiB + 160 * 1024;
constexpr size_t WS_MODP = 1 * MiB + 256 * 1024;
constexpr size_t WS_GMWIN = 6 * MiB;
constexpr size_t WS_GMWOUT = WS_GMWIN + 32 * MiB;
constexpr size_t WS_GMWS = WS_GMWOUT + 16 * MiB;
constexpr size_t WS_PWQ = WS_GMWS + 1 * MiB;
constexpr size_t WS_PK1 = WS_PWQ + 32 * MiB;
constexpr size_t WS_PK2 = WS_PK1 + 512 * 1024;
constexpr size_t WS_MLAIN = WS_PK1 + 1 * MiB;
constexpr size_t WS_MLAUQ = WS_MLAIN + 5 * MiB;
constexpr size_t WS_MLAUKV = WS_MLAUQ + 3 * MiB;
constexpr size_t WS_MLAOUT = WS_MLAUKV + 4 * MiB;
constexpr size_t WS_DAIN = WS_MLAOUT + 8 * MiB;
constexpr size_t WS_DAOUT = WS_DAIN + 24 * MiB;
constexpr size_t WS_PU = WS_DAOUT + 8 * MiB;
constexpr size_t WS_PV = WS_PU + 96 * MiB;
constexpr size_t WS_X = WS_PV + 96 * MiB;
constexpr size_t WS_H = WS_X + 66 * MiB;
constexpr size_t WS_G = WS_H + 66 * MiB;
constexpr size_t WS_Y = WS_G + 66 * MiB;
constexpr size_t WS_QP = WS_Y + 66 * MiB;
constexpr size_t WS_Z = WS_QP + 66 * MiB;
constexpr size_t WS_C = WS_Z + 198 * MiB;
constexpr size_t WS_CQN = WS_C + 42 * MiB;
constexpr size_t WS_CKVN = WS_CQN + 17 * MiB;
constexpr size_t WS_KR = WS_CKVN + 17 * MiB;
constexpr size_t WS_QM = WS_KR + 3 * MiB;
constexpr size_t WS_KV = WS_QM + 99 * MiB;
constexpr size_t WS_ROUTE = WS_KV + 132 * MiB;
constexpr size_t WS_END = WS_ROUTE + 17 * MiB;
static_assert((size_t)MT * DM * 2 == 66 * MiB, "row buffer size");

constexpr int RING_BYTES = 155648, MISC_OFF = RING_BYTES + 320, LDS_BYTES = 159744;

#define GAS __attribute__((address_space(1)))
#define LAS __attribute__((address_space(3)))
typedef unsigned short bf16;
typedef unsigned u32x4 __attribute__((ext_vector_type(4)));
typedef unsigned u32x2 __attribute__((ext_vector_type(2)));
typedef float f32x4 __attribute__((ext_vector_type(4)));
typedef float f32x16 __attribute__((ext_vector_type(16)));
typedef short bf16x8 __attribute__((ext_vector_type(8)));
typedef short s16x4 __attribute__((ext_vector_type(4)));
#define LDS_WAIT() asm volatile("s_waitcnt lgkmcnt(0)" ::: "memory")

__device__ __forceinline__ unsigned cvtpk(float lo, float hi) { unsigned r; asm("v_cvt_pk_bf16_f32 %0, %1, %2" : "=v"(r) : "v"(lo), "v"(hi)); return r; }
__device__ __forceinline__ float bflo(unsigned w) { return __uint_as_float(w << 16); }
__device__ __forceinline__ float bfhi(unsigned w) { return __uint_as_float(w & 0xffff0000u); }
__device__ __forceinline__ float bf1(bf16 b) { return __uint_as_float((unsigned)b << 16); }
__device__ __forceinline__ bf16 tobf1(float f) { return (bf16)(cvtpk(f, 0.f) & 0xffffu); }
#define DPP_F(v, ctrl) __int_as_float(__builtin_amdgcn_mov_dpp(__float_as_int(v), (ctrl), 0xF, 0xF, true))
__device__ __forceinline__ float row_sum16(float v) { v += DPP_F(v, 0xB1); v += DPP_F(v, 0x4E); v += DPP_F(v, 0x141); v += DPP_F(v, 0x140); return v; }
__device__ __forceinline__ float sum_xor16(float v) { const auto r = __builtin_amdgcn_permlane16_swap(__float_as_uint(v), __float_as_uint(v), false, false); return __uint_as_float(r[0]) + __uint_as_float(r[1]); }
__device__ __forceinline__ float sum_xor32(float v) { const auto r = __builtin_amdgcn_permlane32_swap(__float_as_uint(v), __float_as_uint(v), false, false); return __uint_as_float(r[0]) + __uint_as_float(r[1]); }
__device__ __forceinline__ float wave_sum(float v) { return sum_xor32(sum_xor16(row_sum16(v))); }
__device__ __forceinline__ float half_sum32(float v) { return sum_xor16(row_sum16(v)); }
__device__ __forceinline__ float lane_xor16(float v, int lane) { const auto r = __builtin_amdgcn_permlane16_swap(__float_as_uint(v), __float_as_uint(v), false, false); return __uint_as_float((lane & 16) ? r[0] : r[1]); }
__device__ __forceinline__ unsigned lane_xor32(unsigned v, int lane) { const auto r = __builtin_amdgcn_permlane32_swap(v, v, false, false); return (lane & 32) ? r[0] : r[1]; }
__device__ __forceinline__ float gelu_tanh(float x) { return pg8::gelu_tanh(x); }

__device__ __forceinline__ void load_row_bf16(const bf16* row, int lane, float (&v)[32]) {
#pragma unroll
    for (int j = 0; j < 4; ++j) { const u32x4 w = ((const u32x4*)row)[64 * j + lane];
        v[8 * j + 0] = bflo(w.x); v[8 * j + 1] = bfhi(w.x); v[8 * j + 2] = bflo(w.y); v[8 * j + 3] = bfhi(w.y);
        v[8 * j + 4] = bflo(w.z); v[8 * j + 5] = bfhi(w.z); v[8 * j + 6] = bflo(w.w); v[8 * j + 7] = bfhi(w.w); }
}
__device__ __forceinline__ void load_row_bf16_nt(const bf16* row, int lane, float (&v)[32]) {
#pragma unroll
    for (int j = 0; j < 4; ++j) { const u32x4 w = __builtin_nontemporal_load(&((const u32x4*)row)[64 * j + lane]);
        v[8 * j + 0] = bflo(w.x); v[8 * j + 1] = bfhi(w.x); v[8 * j + 2] = bflo(w.y); v[8 * j + 3] = bfhi(w.y);
        v[8 * j + 4] = bflo(w.z); v[8 * j + 5] = bfhi(w.z); v[8 * j + 6] = bflo(w.w); v[8 * j + 7] = bfhi(w.w); }
}
__device__ __forceinline__ void store_row_bf16(bf16* row, int lane, const float (&v)[32]) {
#pragma unroll
    for (int j = 0; j < 4; ++j) { u32x4 w; w.x = cvtpk(v[8 * j + 0], v[8 * j + 1]); w.y = cvtpk(v[8 * j + 2], v[8 * j + 3]); w.z = cvtpk(v[8 * j + 4], v[8 * j + 5]); w.w = cvtpk(v[8 * j + 6], v[8 * j + 7]);
        ((u32x4*)row)[64 * j + lane] = w; }
}
__device__ __forceinline__ void load_row_f32(const float* row, int lane, float (&v)[32]) {
#pragma unroll
    for (int j = 0; j < 4; ++j) { const f32x4 a = ((const f32x4*)row)[128 * j + 2 * lane], b = ((const f32x4*)row)[128 * j + 2 * lane + 1];
        v[8 * j + 0] = a.x; v[8 * j + 1] = a.y; v[8 * j + 2] = a.z; v[8 * j + 3] = a.w; v[8 * j + 4] = b.x; v[8 * j + 5] = b.y; v[8 * j + 6] = b.z; v[8 * j + 7] = b.w; }
}
__device__ __forceinline__ void load_row_f32_nt(const float* row, int lane, float (&v)[32]) {
#pragma unroll
    for (int j = 0; j < 4; ++j) { const f32x4 a = __builtin_nontemporal_load(&((const f32x4*)row)[128 * j + 2 * lane]), b = __builtin_nontemporal_load(&((const f32x4*)row)[128 * j + 2 * lane + 1]);
        v[8 * j + 0] = a.x; v[8 * j + 1] = a.y; v[8 * j + 2] = a.z; v[8 * j + 3] = a.w; v[8 * j + 4] = b.x; v[8 * j + 5] = b.y; v[8 * j + 6] = b.z; v[8 * j + 7] = b.w; }
}
__device__ __forceinline__ void store_row_f32(float* row, int lane, const float (&v)[32]) {
#pragma unroll
    for (int j = 0; j < 4; ++j) { ((f32x4*)row)[128 * j + 2 * lane] = (f32x4){v[8 * j + 0], v[8 * j + 1], v[8 * j + 2], v[8 * j + 3]};
        ((f32x4*)row)[128 * j + 2 * lane + 1] = (f32x4){v[8 * j + 4], v[8 * j + 5], v[8 * j + 6], v[8 * j + 7]}; }
}
__device__ __forceinline__ void load_row_bf16_b(const bf16* row, int lane, float (&v)[32]) {
#pragma unroll
    for (int j = 0; j < 4; ++j) { const u32x4 w = ((const u32x4*)row)[4 * lane + j];
        v[8 * j + 0] = bflo(w.x); v[8 * j + 1] = bfhi(w.x); v[8 * j + 2] = bflo(w.y); v[8 * j + 3] = bfhi(w.y);
        v[8 * j + 4] = bflo(w.z); v[8 * j + 5] = bfhi(w.z); v[8 * j + 6] = bflo(w.w); v[8 * j + 7] = bfhi(w.w); }
}
__device__ __forceinline__ void store_row_bf16_b(bf16* row, int lane, const float (&v)[32]) {
#pragma unroll
    for (int j = 0; j < 4; ++j) { u32x4 w; w.x = cvtpk(v[8 * j + 0], v[8 * j + 1]); w.y = cvtpk(v[8 * j + 2], v[8 * j + 3]); w.z = cvtpk(v[8 * j + 4], v[8 * j + 5]); w.w = cvtpk(v[8 * j + 6], v[8 * j + 7]);
        ((u32x4*)row)[4 * lane + j] = w; }
}
__device__ __forceinline__ void load_row_f32_b(const float* row, int lane, float (&v)[32]) {
#pragma unroll
    for (int q = 0; q < 8; ++q) { const f32x4 a = ((const f32x4*)row)[8 * lane + q];
        v[4 * q + 0] = a.x; v[4 * q + 1] = a.y; v[4 * q + 2] = a.z; v[4 * q + 3] = a.w; }
}
__device__ __forceinline__ void store_row_f32_b(float* row, int lane, const float (&v)[32]) {
#pragma unroll
    for (int q = 0; q < 8; ++q) ((f32x4*)row)[8 * lane + q] = (f32x4){v[4 * q + 0], v[4 * q + 1], v[4 * q + 2], v[4 * q + 3]};
}
__device__ __forceinline__ void store_row_f32_b_nt(float* row, int lane, const float (&v)[32]) {
#pragma unroll
    for (int q = 0; q < 8; ++q) __builtin_nontemporal_store((f32x4){v[4 * q + 0], v[4 * q + 1], v[4 * q + 2], v[4 * q + 3]}, &((f32x4*)row)[8 * lane + q]);
}
__device__ __forceinline__ void ln_stats(const float (&v)[32], float& mean, float& rstd) {
    float s = 0.f;
#pragma unroll
    for (int i = 0; i < 32; ++i) s += v[i];
    mean = wave_sum(s) * (1.0f / DM);
    float q = 0.f;
#pragma unroll
    for (int i = 0; i < 32; ++i) { const float d = v[i] - mean; q += d * d; }
    rstd = 1.0f / sqrtf(wave_sum(q) * (1.0f / DM) + LN_EPS);
}
template <bool LAYB>
__device__ __forceinline__ void finish_row(float (&z)[32], const float* lng, const float* lnb, bf16* Xrow, const float* sh, const float* sc, bf16* Hrow, float* Orow, int lane) {
    float mean, rstd; ln_stats(z, mean, rstd);
    { float g[32], b[32]; if (LAYB) { load_row_f32_b(lng, lane, g); load_row_f32_b(lnb, lane, b); } else { load_row_f32(lng, lane, g); load_row_f32(lnb, lane, b); }
#pragma unroll
      for (int i = 0; i < 32; ++i) z[i] = (z[i] - mean) * rstd * g[i] + b[i]; }
    if (Xrow) { if (LAYB) store_row_bf16_b(Xrow, lane, z); else store_row_bf16(Xrow, lane, z); }
    if (Orow) { if (LAYB) store_row_f32_b(Orow, lane, z); else store_row_f32(Orow, lane, z); }
    if (Hrow) {
        ln_stats(z, mean, rstd);
        float a[32], s[32]; if (LAYB) { load_row_f32_b(sc, lane, a); load_row_f32_b(sh, lane, s); } else { load_row_f32(sc, lane, a); load_row_f32(sh, lane, s); }
#pragma unroll
        for (int i = 0; i < 32; ++i) a[i] = (z[i] - mean) * rstd * (1.0f + a[i]) + s[i];
        if (LAYB) store_row_bf16_b(Hrow, lane, a); else store_row_bf16(Hrow, lane, a);
    }
}
__device__ __forceinline__ int row_slot(int row) { return row < ML ? (row >> 13) : 2; }

__device__ __forceinline__ unsigned f2bf_rne(float f) { unsigned u = __float_as_uint(f); return (u + 0x7fffu + ((u >> 16) & 1u)) >> 16; }
__device__ __forceinline__ unsigned pk2(float lo, float hi) { return f2bf_rne(lo) | (f2bf_rne(hi) << 16); }
#ifndef GEMV_PIPE
#define GEMV_PIPE 1
#endif
#ifndef NT_ACT
#define NT_ACT 0
#endif
#ifndef NT_STREAM
#define NT_STREAM 1
#endif
__device__ __forceinline__ void p0_transpose_item(const float* W, int K, int N, bf16* WT, LAS float* scr, int item, int lane) {
    const int nblk = N / 32, kb = item / nblk, nb = item % nblk, k0 = 64 * kb, n0 = 32 * nb;
    f32x4 t[8];
#pragma unroll
    for (int i = 0; i < 8; ++i) { const f32x4* p_ = (const f32x4*)(W + (size_t)(k0 + 8 * i + (lane >> 3)) * N + n0 + 4 * (lane & 7)); t[i] = NT_STREAM ? __builtin_nontemporal_load(p_) : *p_; }
#pragma unroll
    for (int i = 0; i < 8; ++i) { LAS float* d = scr + (8 * i + (lane >> 3)) * 33 + 4 * (lane & 7); d[0] = t[i].x; d[1] = t[i].y; d[2] = t[i].z; d[3] = t[i].w; }
    LDS_WAIT(); asm volatile("" ::: "memory");
    const int c = lane & 7;
#pragma unroll
    for (int j = 0; j < 4; ++j) { const int n = (lane >> 3) + 8 * j; const LAS float* s = scr + (8 * c) * 33 + n;
        u32x4 o; o.x = pk2(s[0 * 33], s[1 * 33]); o.y = pk2(s[2 * 33], s[3 * 33]); o.z = pk2(s[4 * 33], s[5 * 33]); o.w = pk2(s[6 * 33], s[7 * 33]);
        *(u32x4*)(WT + (size_t)(n0 + n) * K + k0 + 8 * c) = o; }
    LDS_WAIT(); asm volatile("" ::: "memory");
}
__device__ __forceinline__ void cvt_range(const float* src, bf16* dst, size_t n8, size_t gtid, size_t gthreads) {
#pragma unroll 4
    for (size_t i = gtid; i < n8; i += gthreads) { const f32x4 a = ((const f32x4*)src)[2 * i], b = ((const f32x4*)src)[2 * i + 1];
        u32x4 w; w.x = cvtpk(a.x, a.y); w.y = cvtpk(a.z, a.w); w.z = cvtpk(b.x, b.y); w.w = cvtpk(b.z, b.w); ((u32x4*)dst)[i] = w; }
}
__device__ __forceinline__ unsigned enc_e2m3(float x) {
    const unsigned sgn = (__float_as_uint(x) >> 26) & 32u;
    const float ax = fminf(fabsf(x), 7.5f);
    unsigned u = __float_as_uint(ax); u += 0x7FFFFu + ((u >> 20) & 1u);
    const unsigned cn = (u >> 20) - ((127u - 1u) << 3);
    const unsigned cs = (unsigned)__builtin_rintf(ax * 8.0f);
    return sgn | (ax < 1.0f ? cs : cn);
}
#ifndef EMU_FP4V
#define EMU_FP4V 0
#endif
#ifndef CVT_PIPE
#define CVT_PIPE 0
#endif
typedef float f32x2v __attribute__((ext_vector_type(2)));
typedef float f32x16v __attribute__((ext_vector_type(16)));
typedef float f32x32v __attribute__((ext_vector_type(32)));
typedef unsigned u32x6v __attribute__((ext_vector_type(6)));
__device__ __forceinline__ u32x6v pack_fp6_32(const float (&e)[32], bool interleaved) {
    f32x16v s0, s1;
    if (interleaved) {
#pragma unroll
        for (int i = 0; i < 16; ++i) { s0[i] = e[2 * i]; s1[i] = e[2 * i + 1]; }
    } else {
#pragma unroll
        for (int i = 0; i < 16; ++i) { s0[i] = e[i]; s1[i] = e[16 + i]; }
    }
    return __builtin_amdgcn_cvt_scalef32_2xpk16_fp6_f32(s0, s1, 1.0f);
}
__device__ __forceinline__ void cvt_table_fp6(const float* src, unsigned char* dst, int nrows, float scale, LAS float* scr  , int lane, int gw, int NGW, const int isv) {
    bool interleaved;
    {
        float t[32];
#pragma unroll
        for (int k = 0; k < 32; ++k) t[k] = k < 16 ? 0.125f * k : (k < 24 ? 2.0f + 0.25f * (k - 16) : 4.0f + 0.5f * (k - 24));
        float tt[32];
#pragma unroll
        for (int k = 0; k < 32; ++k) { tt[k] = t[k]; asm volatile("" : "+v"(tt[k])); }
        const u32x6v p = pack_fp6_32(tt, true);
        const f32x32v o = __builtin_amdgcn_cvt_scalef32_pk32_f32_fp6(p, 1.0f);
        interleaved = (o[1] == t[1]) && (o[2] == t[2]) && (o[17] == t[17]);
        interleaved = __all(interleaved);
    }
#if CVT_PIPE
    f32x4 nx[8];
    if (gw < nrows) { const f32x4* s4 = (const f32x4*)(src + (size_t)gw * 2048);
#pragma unroll
        for (int q = 0; q < 8; ++q) nx[q] = s4[64 * q + lane]; }
    for (int row = gw; row < nrows; row += NGW) {
        f32x4 cur[8];
#pragma unroll
        for (int q = 0; q < 8; ++q) cur[q] = nx[q];
        if (row + NGW < nrows) { const f32x4* s4 = (const f32x4*)(src + (size_t)(row + NGW) * 2048);
#pragma unroll
            for (int q = 0; q < 8; ++q) nx[q] = s4[64 * q + lane]; }
#pragma unroll
        for (int q = 0; q < 8; ++q) { const int s = 64 * q + lane; const f32x4 a = cur[q] * scale; *(LAS f32x4*)(scr + 4 * (s ^ ((s >> 4) & 7))) = a; }
#else
    bool fp4_swapped = false;
    if (PEER_V4) {
        float t0 = 1.0f, t1 = 2.0f; asm volatile("" : "+v"(t0), "+v"(t1));
        const unsigned pw = __builtin_amdgcn_cvt_scalef32_pk_fp4_f32(0u, t0, t1, 1.0f, 0);
        const f32x2v pr = __builtin_amdgcn_cvt_scalef32_pk_f32_fp4(pw, 1.0f, 0);
        fp4_swapped = !__all(pr[0] == 1.0f);
    }
    for (int row = gw; row < nrows; row += NGW) {
        const f32x4* s4 = (const f32x4*)(src + (size_t)row * 2048);
#pragma unroll
        for (int q = 0; q < 8; ++q) { const int s = 64 * q + lane; const f32x4 a = (NT_STREAM ? __builtin_nontemporal_load(&s4[s]) : s4[s]) * scale; *(LAS f32x4*)(scr + 4 * (s ^ ((s >> 4) & 7))) = a; }
#endif
        float e[32];
#pragma unroll
        for (int j = 0; j < 8; ++j) { const int s = 8 * lane + j; const f32x4 a = *(const LAS f32x4*)(scr + 4 * (s ^ ((s >> 4) & 7)));
            e[4 * j + 0] = __builtin_amdgcn_fmed3f(a.x, -7.5f, 7.5f); e[4 * j + 1] = __builtin_amdgcn_fmed3f(a.y, -7.5f, 7.5f); e[4 * j + 2] = __builtin_amdgcn_fmed3f(a.z, -7.5f, 7.5f); e[4 * j + 3] = __builtin_amdgcn_fmed3f(a.w, -7.5f, 7.5f); }
#if EMU_FP4V
        if (EMU_FP4V == 2 ? !isv : isv) {
#pragma unroll
            for (int i = 0; i < 32; ++i) { const float a = fabsf(e[i]); float q = a < 2.0f ? rintf(a * 2.0f) * 0.5f : (a < 4.0f ? rintf(a) : fminf(rintf(a * 0.5f) * 2.0f, 6.0f)); e[i] = copysignf(q, e[i]); }
        }
#endif
        unsigned char* rowp = dst + (size_t)row * PREC;
        if (PEER_V4 && (isv || PEER_U4)) {
            u32x4 w4;
#pragma unroll
            for (int w = 0; w < 4; ++w) { unsigned d = 0u; float x_[8];
#pragma unroll
                for (int i = 0; i < 8; i += 2) { const float x0 = __builtin_amdgcn_fmed3f(e[8 * w + i], -6.0f, 6.0f), x1 = __builtin_amdgcn_fmed3f(e[8 * w + i + 1], -6.0f, 6.0f); x_[i] = fp4_swapped ? x1 : x0; x_[i + 1] = fp4_swapped ? x0 : x1; }
                d = __builtin_amdgcn_cvt_scalef32_pk_fp4_f32(d, x_[0], x_[1], 1.0f, 0); d = __builtin_amdgcn_cvt_scalef32_pk_fp4_f32(d, x_[2], x_[3], 1.0f, 1);
                d = __builtin_amdgcn_cvt_scalef32_pk_fp4_f32(d, x_[4], x_[5], 1.0f, 2); d = __builtin_amdgcn_cvt_scalef32_pk_fp4_f32(d, x_[6], x_[7], 1.0f, 3);
                w4[w] = d; }
            *(u32x4*)(rowp + ((isv || !PEER_U4) ? 1024 : 0) + 16 * lane) = w4;
            continue;
        }
        const u32x6v p = pack_fp6_32(e, interleaved);
        *(u32x4*)(rowp + 1024 * isv + 16 * lane) = (u32x4){p[0], p[1], p[2], p[3]}; *(u32x2*)(rowp + 2048 + 512 * isv + 8 * lane) = (u32x2){p[4], p[5]};
    }
}
__device__ __forceinline__ float silu(float x) { return x / (1.0f + __expf(-x)); }

struct Params { const float* in[29]; float* out; unsigned char* ws; int ph_lo, ph_hi; };
typedef const __attribute__((address_space(4))) Params* CP;

#ifndef P0_NOV
#define P0_NOV 0
#endif
#ifndef TAIL_REMAP
#define TAIL_REMAP 0
#endif
__device__ __forceinline__ void p0_prologue(CP P, LAS unsigned char* lds, int tid, int lane, int wid, int gw, int NGW, const int parts = 7) {
    unsigned char* ws = P->ws;
    LAS float* scr = (LAS float*)(lds + wid * 16384);
    if (parts & 1) {
        constexpr int I_GMIN = (2048 / 64) * (4096 / 32), I_SQ = (2048 / 64) * (2048 / 32), I_MIN = (2048 / 64) * (1088 / 32), I_UQ = (512 / 64) * (3072 / 32), I_UKV = (512 / 64) * (4096 / 32), I_DIN = (2048 / 64) * (6144 / 32);
        constexpr int NIT = 2 * I_GMIN + 2 * I_SQ + 4 * I_SQ + I_MIN + I_UQ + I_UKV + I_SQ + I_DIN + I_SQ;
        for (int it = gw; it < NIT; it += NGW) {
            int r = it;
            if (r < 2 * I_GMIN) { const int j = r / I_GMIN; p0_transpose_item(P->in[13] + (size_t)j * 2048 * 4096, 2048, 4096, (bf16*)(ws + WS_GMWIN) + (size_t)j * 4096 * 2048, scr, r % I_GMIN, lane); continue; } r -= 2 * I_GMIN;
            if (r < 2 * I_SQ) { const int j = r / I_SQ; p0_transpose_item(P->in[18] + (size_t)j * 2048 * 2048, 2048, 2048, (bf16*)(ws + WS_GMWOUT) + (size_t)j * 2048 * 2048, scr, r % I_SQ, lane); continue; } r -= 2 * I_SQ;
            if (r < 4 * I_SQ) { const int j = r / I_SQ; p0_transpose_item(P->in[8] + (size_t)j * 2048 * 2048, 2048, 2048, (bf16*)(ws + WS_PWQ) + (size_t)j * 2048 * 2048, scr, r % I_SQ, lane); continue; } r -= 4 * I_SQ;
            if (r < I_MIN) { p0_transpose_item(P->in[19], 2048, 1088, (bf16*)(ws + WS_MLAIN), scr, r, lane); continue; } r -= I_MIN;
            if (r < I_UQ) { p0_transpose_item(P->in[22], 512, 3072, (bf16*)(ws + WS_MLAUQ), scr, r, lane); continue; } r -= I_UQ;
            if (r < I_UKV) { p0_transpose_item(P->in[23], 512, 4096, (bf16*)(ws + WS_MLAUKV), scr, r, lane); continue; } r -= I_UKV;
            if (r < I_SQ) { p0_transpose_item(P->in[24], 2048, 2048, (bf16*)(ws + WS_MLAOUT), scr, r, lane); continue; } r -= I_SQ;
            if (r < I_DIN) { p0_transpose_item(P->in[25], 2048, 6144, (bf16*)(ws + WS_DAIN), scr, r, lane); continue; } r -= I_DIN;
            p0_transpose_item(P->in[28], 2048, 2048, (bf16*)(ws + WS_DAOUT), scr, r, lane);
        }
    }
    const size_t gtid = (size_t)gw * 64 + lane, gthreads = (size_t)NGW * 64;
    if (parts & 2) {
    { u32x4* z = (u32x4*)((bf16*)(ws + WS_MLAIN) + (size_t)1088 * 2048); const size_t n = (size_t)192 * 2048 / 8;
      for (size_t i = gtid; i < n; i += gthreads) z[i] = (u32x4){0u, 0u, 0u, 0u}; }
    cvt_range(P->in[16], (bf16*)(ws + WS_GMWS), (size_t)2 * 16 * 128 * 128 / 8, gtid, gthreads);
    cvt_range(P->in[9], (bf16*)(ws + WS_PK1), (size_t)4 * 128 * 128 / 8, gtid, gthreads);
    cvt_range(P->in[10], (bf16*)(ws + WS_PK2), (size_t)4 * 128 * 128 / 8, gtid, gthreads);
#if !TAIL_REMAP
    cvt_table_fp6(P->in[11], ws + WS_PU, 16384, U_SCALE, scr, lane, gw, NGW, 0);
    if (!P0_NOV) cvt_table_fp6(P->in[12], ws + WS_PU, 16384, V_SCALE, scr, lane, gw, NGW, 1);
#endif
    if (gtid < 2048) { const int pos = (int)gtid >> 4, f = (int)gtid & 15; const float inv = powf(10000.0f, -(float)f * (1.0f / 16.0f)); float sn, cs; sincosf((float)pos * inv, &sn, &cs);
        float* rt = (float*)(ws + WS_ROPE); rt[gtid] = cs; rt[2048 + gtid] = sn; }
    }
    if (parts & 4) {
        const float* cv = P->in[1]; const float* cc = P->in[3]; const float* mw = P->in[4]; float* PART = (float*)(ws + WS_MODP);
        LAS float* S = (LAS float*)lds;
        __syncthreads();
        { float t_[12];
#pragma unroll
          for (int t = 0; t < 12; ++t) { const int i = tid + t * NWAVES * 64, sl = i >> 11, kk = i & 2047; t_[t] = sl == 0 ? cv[kk] : (sl == 1 ? cv[2048 + kk] : cc[kk]); }
#pragma unroll
          for (int t = 0; t < 12; ++t) S[tid + t * NWAVES * 64] = silu(t_[t]); }
        __syncthreads();
        for (int item = gw; item < 4 * 192 * 8; item += NGW) {
            const int ks = item & 7, r = item >> 3, L = r / 192, n = (r % 192) * 64 + lane;
            const float* W = mw + (size_t)L * 2048 * 12288 + (size_t)(ks * 256) * 12288 + n;
            float a0 = 0.f, a1 = 0.f, a2 = 0.f;
#if GEMV_PIPE
#define GV_LD(dst_, kb_) do { _Pragma("unroll") for (int t = 0; t < 32; ++t) dst_[t] = NT_STREAM ? __builtin_nontemporal_load(&W[(size_t)((kb_) + t) * 12288]) : W[(size_t)((kb_) + t) * 12288]; } while (0)
            float wa[32], wb[32];
            GV_LD(wa, 0);
#pragma unroll 1
            for (int kb = 0; kb < 256; kb += 64) {
                GV_LD(wb, kb + 32);
#pragma unroll
                for (int t = 0; t < 32; ++t) { const int kk = ks * 256 + kb + t; a0 += S[kk] * wa[t]; a1 += S[2048 + kk] * wa[t]; a2 += S[4096 + kk] * wa[t]; }
                if (kb + 64 < 256) GV_LD(wa, kb + 64);
#pragma unroll
                for (int t = 0; t < 32; ++t) { const int kk = ks * 256 + kb + 32 + t; a0 += S[kk] * wb[t]; a1 += S[2048 + kk] * wb[t]; a2 += S[4096 + kk] * wb[t]; }
            }
#undef GV_LD
#else
#pragma unroll 32
            for (int k = 0; k < 256; ++k) { const int kk = ks * 256 + k; const float s0 = S[kk], s1 = S[2048 + kk], s2 = S[4096 + kk];
                const float w = NT_STREAM ? __builtin_nontemporal_load(&W[(size_t)k * 12288]) : W[(size_t)k * 12288]; a0 += s0 * w; a1 += s1 * w; a2 += s2 * w; }
#endif
            float* o = PART + ((size_t)ks * 4 + L) * 3 * 12288 + n;
            o[0] = a0; o[12288] = a1; o[24576] = a2;
        }
    }
}
__device__ __forceinline__ void mod_reduce(CP P, int gw, int lane, int NGW) {
    const float* PART = (const float*)(P->ws + WS_MODP); float* MOD = (float*)(P->ws + WS_MOD); const float* mb = P->in[5];
    for (int i = gw * 64 + lane; i < 4 * 3 * 12288; i += NGW * 64) {
        const int L = i / (3 * 12288), n = i % 12288;
        float s = mb[(size_t)L * 12288 + n];
#pragma unroll
        for (int ks = 0; ks < 8; ++ks) s += PART[(size_t)ks * 4 * 3 * 12288 + i];
        MOD[i] = s;
    }
}

__device__ __forceinline__ void load_row_f32_l(const LAS float* row, int lane, float (&v)[32]) {
#pragma unroll
    for (int j = 0; j < 4; ++j) { const f32x4 a = ((const LAS f32x4*)row)[128 * j + 2 * lane], b = ((const LAS f32x4*)row)[128 * j + 2 * lane + 1];
        v[8 * j + 0] = a.x; v[8 * j + 1] = a.y; v[8 * j + 2] = a.z; v[8 * j + 3] = a.w; v[8 * j + 4] = b.x; v[8 * j + 5] = b.y; v[8 * j + 6] = b.z; v[8 * j + 7] = b.w; }
}
__device__ __forceinline__ void first_row_pass(CP P, LAS unsigned char* lds, int tid, int lane, int gw, int NGW) {
    const float* MOD = (const float*)(P->ws + WS_MOD); bf16* X = (bf16*)(P->ws + WS_X); bf16* H = (bf16*)(P->ws + WS_H);
    LAS float* V = (LAS float*)lds;
    __syncthreads();
    { f32x4 t_[6];
#pragma unroll
      for (int vec = 0; vec < 6; ++vec) t_[vec] = ((const f32x4*)(MOD + (size_t)(vec >> 1) * 12288 + (size_t)(vec & 1) * 2048))[tid];
#pragma unroll
      for (int vec = 0; vec < 6; ++vec) ((LAS f32x4*)V)[vec * 512 + tid] = t_[vec]; }
    __syncthreads();
    for (int row = gw; row < MT; row += NGW) {
        const float* src = row < ML ? P->in[0] + (size_t)row * DM : P->in[2] + (size_t)(row - ML) * DM;
        float v[32]; if (NT_STREAM > 1) load_row_f32_nt(src, lane, v); else load_row_f32(src, lane, v);
        store_row_bf16(X + (size_t)row * DM, lane, v);
        const LAS float* mod = V + row_slot(row) * 4096;
        float mean, rstd; ln_stats(v, mean, rstd);
        float a[32], s[32]; load_row_f32_l(mod + 2048, lane, a); load_row_f32_l(mod, lane, s);
#pragma unroll
        for (int i = 0; i < 32; ++i) a[i] = (v[i] - mean) * rstd * (1.0f + a[i]) + s[i];
        store_row_bf16(H + (size_t)row * DM, lane, a);
    }
}
#ifndef POSTMIX_LDS
#define POSTMIX_LDS 1
#endif
__device__ __forceinline__ void post_mixer_pass_lds(CP P, int L, int Mrows, LAS unsigned char* lds, int tid, int lane, int gw, int NGW) {
    const float* MOD = (const float*)(P->ws + WS_MOD); bf16* X = (bf16*)(P->ws + WS_X); bf16* H = (bf16*)(P->ws + WS_H); const bf16* Y = (const bf16*)(P->ws + WS_Y);
    const float* lng = P->in[6] + (size_t)(L * 2 + 0) * DM; const float* lnb = P->in[7] + (size_t)(L * 2 + 0) * DM;
    LAS float* V = (LAS float*)lds;
    __syncthreads();
    { f32x4 t_[11];
#pragma unroll
      for (int vec = 0; vec < 11; ++vec) { const float* src = vec == 0 ? lng : (vec == 1 ? lnb : MOD + (size_t)(L * 3 + (vec - 2) / 3) * 12288 + (size_t)(2 + (vec - 2) % 3) * 2048);
          t_[vec] = ((const f32x4*)src)[tid]; }
#pragma unroll
      for (int vec = 0; vec < 11; ++vec) ((LAS f32x4*)V)[vec * 512 + tid] = t_[vec]; }
    __syncthreads();
    for (int row = gw; row < Mrows; row += NGW) {
        const LAS float* mv = V + (2 + 3 * row_slot(row)) * 2048;
        float z[32], y[32]; if (NT_ACT) { load_row_bf16_nt(X + (size_t)row * DM, lane, z); load_row_bf16_nt(Y + (size_t)row * DM, lane, y); } else { load_row_bf16(X + (size_t)row * DM, lane, z); load_row_bf16(Y + (size_t)row * DM, lane, y); }
        { float g[32]; load_row_f32_l(mv, lane, g);
#pragma unroll
          for (int i = 0; i < 32; ++i) z[i] = ALPHA * z[i] + g[i] * y[i]; }
        float mean, rstd; ln_stats(z, mean, rstd);
        { float g[32], b[32]; load_row_f32_l(V, lane, g); load_row_f32_l(V + 2048, lane, b);
#pragma unroll
          for (int i = 0; i < 32; ++i) z[i] = (z[i] - mean) * rstd * g[i] + b[i]; }
        store_row_bf16(X + (size_t)row * DM, lane, z);
        ln_stats(z, mean, rstd);
        { float a[32], s_[32]; load_row_f32_l(mv + 2 * 2048, lane, a); load_row_f32_l(mv + 2048, lane, s_);
#pragma unroll
          for (int i = 0; i < 32; ++i) a[i] = (z[i] - mean) * rstd * (1.0f + a[i]) + s_[i];
          store_row_bf16(H + (size_t)row * DM, lane, a); }
    }
}
__device__ __forceinline__ void post_mixer_pass(CP P, int L, int Mrows, int lane, int gw, int NGW) {
    const float* MOD = (const float*)(P->ws + WS_MOD); bf16* X = (bf16*)(P->ws + WS_X); bf16* H = (bf16*)(P->ws + WS_H); const bf16* Y = (const bf16*)(P->ws + WS_Y);
    const float* lng = P->in[6] + (size_t)(L * 2 + 0) * DM; const float* lnb = P->in[7] + (size_t)(L * 2 + 0) * DM;
    for (int row = gw; row < Mrows; row += NGW) {
        const float* mod = MOD + (size_t)(L * 3 + row_slot(row)) * 12288;
        float z[32], y[32], g[32]; load_row_bf16(X + (size_t)row * DM, lane, z); load_row_bf16(Y + (size_t)row * DM, lane, y); load_row_f32(mod + 2 * 2048, lane, g);
#pragma unroll
        for (int i = 0; i < 32; ++i) z[i] = ALPHA * z[i] + g[i] * y[i];
        finish_row<false>(z, lng, lnb, X + (size_t)row * DM, mod + 3 * 2048, mod + 4 * 2048, H + (size_t)row * DM, nullptr, lane);
    }
}
__device__ __forceinline__ void vstats_pass(CP P, int Mrows, int lane, int gw, int NGW) {
    const bf16* Z = (const bf16*)(P->ws + WS_Z); float* VST = (float*)(P->ws + WS_VST);
    for (int row = gw; row < Mrows; row += NGW) {
        float v[32]; load_row_bf16(Z + (size_t)row * 4096 + 2048, lane, v);
        float mean, rstd; ln_stats(v, mean, rstd);
        if (lane == 0) { VST[2 * row] = mean; VST[2 * row + 1] = rstd; }
    }
}
#define XB_TMO      128
#define XB_XCNT(j)  (256  + 64 * (j))
#define XB_XSUB(j)  (1280 + 64 * (j))
#define XB_XGEN(j)  (2304 + 64 * (j))
#define XB_TOP      3328
#define XB_TOPGEN   3392
#define XCD_BAR_WORDS 3456
#define XB_SPIN_CAP (1u << 18)

__device__ __forceinline__ unsigned xb_ld(unsigned* p)              { return __hip_atomic_load(p, __ATOMIC_RELAXED, __HIP_MEMORY_SCOPE_AGENT); }
__device__ __forceinline__ unsigned xb_add(unsigned* p, unsigned v) { return __hip_atomic_fetch_add(p, v, __ATOMIC_RELAXED, __HIP_MEMORY_SCOPE_AGENT); }
__device__ __forceinline__ unsigned xb_xcc_id() { return (unsigned)__builtin_amdgcn_s_getreg((3 << 11) | 20) & 0xFu; }
#define XB_SPIN(cond, bar) do { unsigned _sp = 0; while (cond) { __builtin_amdgcn_s_sleep(1); \
    if ((++_sp & 255u) == 0u) { if (xb_ld(&(bar)[XB_TMO])) break; if (_sp > XB_SPIN_CAP) { atomicAdd(&(bar)[XB_TMO], 1u); break; } } } } while (0)

struct XcdBarrier {
    unsigned* bar; unsigned x;
    volatile LAS unsigned* st;
};

__device__ __forceinline__ XcdBarrier xcd_barrier_post(unsigned* bar, volatile LAS unsigned* st, const bool t0) {
    XcdBarrier b; b.bar = bar; b.x = xb_xcc_id(); b.st = st;
    if (t0) (void)xb_add(&bar[XB_XCNT(b.x)], 1u);
    return b;
}
__device__ __forceinline__ void xcd_barrier_complete(unsigned* bar, unsigned x, unsigned& nloc, unsigned& nx) {
    const unsigned G = gridDim.x * gridDim.y * gridDim.z;
    unsigned sum, cnt, mine, sp = 0u;
    for (;;) {
        sum = 0u; cnt = 0u; mine = 0u;
#pragma unroll
        for (unsigned j = 0; j < 16; ++j) { const unsigned c = xb_ld(&bar[XB_XCNT(j)]); sum += c; cnt += (c > 0u) ? 1u : 0u; mine = (j == x) ? c : mine; }
        if (sum == G) break;
        __builtin_amdgcn_s_sleep(1);
        if ((++sp & 255u) == 0u) { if (xb_ld(&bar[XB_TMO])) break; if (sp > XB_SPIN_CAP) { atomicAdd(&bar[XB_TMO], 1u); break; } }
    }
    nloc = mine > 0u ? mine : 1u; nx = cnt > 0u ? cnt : 1u;
}

__device__ __attribute__((noinline)) void xcd_barrier(const XcdBarrier b, const bool t0) {
    asm volatile("s_waitcnt vmcnt(0)" ::: "memory");
    __syncthreads();
    if (t0) {
        unsigned* bar = b.bar;
        __builtin_amdgcn_s_waitcnt(0);
        unsigned nloc = b.st[0], nx = b.st[1];
        if (nloc == 0u) { xcd_barrier_complete(bar, b.x, nloc, nx); b.st[0] = nloc; b.st[1] = nx; }
        const unsigned old = xb_add(&bar[XB_XSUB(b.x)], 1u);
        const unsigned gen = old / nloc;
        if (old + 1u == (gen + 1u) * nloc) {
            __builtin_amdgcn_fence(__ATOMIC_RELEASE, "agent");
            asm volatile("s_waitcnt vmcnt(0)" ::: "memory");
            const unsigned og = xb_add(&bar[XB_TOP], 1u);
            const unsigned tg = og / nx;
            if (og + 1u == (tg + 1u) * nx) xb_add(&bar[XB_TOPGEN], 1u);
            else XB_SPIN(xb_ld(&bar[XB_TOPGEN]) == tg, bar);
            __builtin_amdgcn_fence(__ATOMIC_ACQUIRE, "agent");
            xb_add(&bar[XB_XGEN(b.x)], 1u);
            asm volatile("s_waitcnt vmcnt(0)" ::: "memory");
        } else {
            XB_SPIN(xb_ld(&bar[XB_XGEN(b.x)]) == gen, bar);
            __builtin_amdgcn_fence(__ATOMIC_ACQUIRE, "agent");
            asm volatile("s_waitcnt vmcnt(0)" ::: "memory");
        }
    }
    __syncthreads();
}

#ifndef SPATIAL_PIPE
#define SPATIAL_PIPE 1
#endif
#if SPATIAL_PIPE
#ifndef SPATIAL_OTILE
#define SPATIAL_OTILE 0
#endif
struct SpReg { u32x4 w[4]; float mean, rstd; bf16x8 a[4]; bf16 uu[SPATIAL_OTILE ? 1 : 32]; u32x4 uq[4]; float bsv[4]; };
__device__ __forceinline__ void sp_load(SpReg& R, const bf16* Z, const float* VST, const bf16* WS, const float* bs, int u, int tid, int lane, int wid) {
    const int c = u >> 4, g = u & 15, fr = lane & 15, fq = lane >> 4;
    { const int q = tid >> 2, dq = (tid & 3) * 32; const int row = c * 128 + q;
      R.mean = VST[2 * row]; R.rstd = VST[2 * row + 1];
      const bf16* src = Z + (size_t)row * 4096 + 2048 + g * 128 + dq;
#pragma unroll
      for (int t = 0; t < 4; ++t) R.w[t] = *(const u32x4*)(src + 8 * t); }
    const bf16* wrow = WS + (size_t)g * 128 * 128 + (size_t)(16 * wid + fr) * 128 + 8 * fq;
#pragma unroll
    for (int ks = 0; ks < 4; ++ks) R.a[ks] = *(const bf16x8*)(wrow + 32 * ks);
#pragma unroll
    for (int r = 0; r < 4; ++r) R.bsv[r] = bs[g * 128 + 16 * wid + fq * 4 + r];
#if SPATIAL_OTILE
#pragma unroll
    for (int t = 0; t < 4; ++t) { const int ch = tid + 512 * t, p = ch >> 4, d8 = (ch & 15) * 8; R.uq[t] = *(const u32x4*)(Z + (size_t)(c * 128 + p) * 4096 + g * 128 + d8); }
    R.uu[0] = 0;
#else
#pragma unroll
    for (int nb = 0; nb < 8; ++nb)
#pragma unroll
        for (int r = 0; r < 4; ++r) { const int p = 16 * wid + fq * 4 + r, d = 16 * nb + fr; R.uu[nb * 4 + r] = Z[(size_t)(c * 128 + p) * 4096 + g * 128 + d]; }
#endif
}
__device__ __forceinline__ void spatial_phase(CP P, int j, int Mrows, LAS unsigned char* lds_, int tid, int lane, int wid) {
    const bf16* Z = (const bf16*)(P->ws + WS_Z); const float* VST = (const float*)(P->ws + WS_VST); bf16* Gb = (bf16*)(P->ws + WS_G);
    const bf16* WS = (const bf16*)(P->ws + WS_GMWS) + (size_t)j * 16 * 128 * 128;
    const float* lng = P->in[14] + (size_t)j * DM; const float* lnb = P->in[15] + (size_t)j * DM; const float* bs = P->in[17] + (size_t)j * 16 * 128;
    LAS bf16* Vt = (LAS bf16*)(LAS unsigned char*)lds_;
    constexpr int VP = 136;
    const int nunits = (Mrows / 128) * 16;
    LAS float* LNl = (LAS float*)(lds_ + 36864);
    __syncthreads();
    { const f32x4 t0_ = ((const f32x4*)lng)[tid], t1_ = ((const f32x4*)lnb)[tid]; ((LAS f32x4*)LNl)[tid] = t0_; ((LAS f32x4*)LNl)[512 + tid] = t1_; }
    LAS float* Ot = (LAS float*)(lds_ + 53248);
    (void)Ot;
    SpReg nx;
    if ((int)blockIdx.x < nunits) sp_load(nx, Z, VST, WS, bs, blockIdx.x, tid, lane, wid);
    for (int u = blockIdx.x; u < nunits; u += gridDim.x) {
        const int c = u >> 4, g = u & 15;
        const SpReg cur = nx;
        if (u + (int)gridDim.x < nunits) sp_load(nx, Z, VST, WS, bs, u + gridDim.x, tid, lane, wid);
        __syncthreads();
        {
            const int q = tid >> 2, dq = (tid & 3) * 32;
#pragma unroll
            for (int t = 0; t < 4; ++t) { const u32x4 w = cur.w[t];
                float v[8] = {bflo(w.x), bfhi(w.x), bflo(w.y), bfhi(w.y), bflo(w.z), bfhi(w.z), bflo(w.w), bfhi(w.w)};
                const LAS float* gp = LNl + g * 128 + dq + 8 * t; const LAS float* bp = LNl + 2048 + g * 128 + dq + 8 * t;
#pragma unroll
                for (int i = 0; i < 8; ++i) { const float vn = (v[i] - cur.mean) * cur.rstd * gp[i] + bp[i]; Vt[(dq + 8 * t + i) * VP + (q ^ ((tid & 3) << 4))] = tobf1(vn); } }
        }
        __syncthreads();
        const int fr = lane & 15, fq = lane >> 4;
#pragma unroll
        for (int nb = 0; nb < 8; ++nb) {
            f32x4 acc = {0.f, 0.f, 0.f, 0.f};
#pragma unroll
            for (int ks = 0; ks < 4; ++ks) { const bf16x8 b = *(const LAS bf16x8*)(Vt + (16 * nb + fr) * VP + 8 * ((4 * ks + fq) ^ ((nb >> 1) << 1)));
                acc = __builtin_amdgcn_mfma_f32_16x16x32_bf16(cur.a[ks], b, acc, 0, 0, 0); }
#if SPATIAL_OTILE
#pragma unroll
            for (int r = 0; r < 4; ++r) Ot[(16 * wid + fq * 4 + r) * 132 + 16 * nb + fr] = acc[r] + cur.bsv[r];
#else
#pragma unroll
            for (int r = 0; r < 4; ++r) { const int p = 16 * wid + fq * 4 + r, d = 16 * nb + fr; const size_t grow = (size_t)(c * 128 + p);
                const float sv = acc[r] + cur.bsv[r];
                const float uu = bf1(cur.uu[nb * 4 + r]);
                Gb[grow * 2048 + g * 128 + d] = tobf1(uu * sv); }
#endif
        }
#if SPATIAL_OTILE
        __syncthreads();
#pragma unroll
        for (int t = 0; t < 4; ++t) { const int ch = tid + 512 * t, p = ch >> 4, d8 = (ch & 15) * 8;
            const LAS f32x4* op = (const LAS f32x4*)(Ot + p * 132 + d8); const f32x4 s0 = op[0], s1 = op[1]; const u32x4 uw = cur.uq[t];
            u32x4 o; o.x = cvtpk(bflo(uw.x) * s0.x, bfhi(uw.x) * s0.y); o.y = cvtpk(bflo(uw.y) * s0.z, bfhi(uw.y) * s0.w); o.z = cvtpk(bflo(uw.z) * s1.x, bfhi(uw.z) * s1.y); o.w = cvtpk(bflo(uw.w) * s1.z, bfhi(uw.w) * s1.w);
            *(u32x4*)(Gb + (size_t)(c * 128 + p) * 2048 + g * 128 + d8) = o; }
#endif
    }
}
#else
__device__ __forceinline__ void spatial_phase(CP P, int j, int Mrows, LAS unsigned char* lds_, int tid, int lane, int wid) {
    const bf16* Z = (const bf16*)(P->ws + WS_Z); const float* VST = (const float*)(P->ws + WS_VST); bf16* Gb = (bf16*)(P->ws + WS_G);
    const bf16* WS = (const bf16*)(P->ws + WS_GMWS) + (size_t)j * 16 * 128 * 128;
    const float* lng = P->in[14] + (size_t)j * DM; const float* lnb = P->in[15] + (size_t)j * DM; const float* bs = P->in[17] + (size_t)j * 16 * 128;
    LAS bf16* Vt = (LAS bf16*)(LAS unsigned char*)lds_;
    constexpr int VP = 136;
    const int nunits = (Mrows / 128) * 16;
    for (int u = blockIdx.x; u < nunits; u += gridDim.x) {
        const int c = u >> 4, g = u & 15;
        __syncthreads();
        {
            const int q = tid >> 2, dq = (tid & 3) * 32; const int row = c * 128 + q;
            const float mean = VST[2 * row], rstd = VST[2 * row + 1];
            const bf16* src = Z + (size_t)row * 4096 + 2048 + g * 128 + dq;
#pragma unroll
            for (int t = 0; t < 4; ++t) { const u32x4 w = *(const u32x4*)(src + 8 * t);
                float v[8] = {bflo(w.x), bfhi(w.x), bflo(w.y), bfhi(w.y), bflo(w.z), bfhi(w.z), bflo(w.w), bfhi(w.w)};
                const float* gp = lng + g * 128 + dq + 8 * t; const float* bp = lnb + g * 128 + dq + 8 * t;
#pragma unroll
                for (int i = 0; i < 8; ++i) { const float vn = (v[i] - mean) * rstd * gp[i] + bp[i]; Vt[(dq + 8 * t + i) * VP + q] = tobf1(vn); } }
        }
        __syncthreads();
        const int fr = lane & 15, fq = lane >> 4;
        bf16x8 a[4];
        const bf16* wrow = WS + (size_t)g * 128 * 128 + (size_t)(16 * wid + fr) * 128 + 8 * fq;
#pragma unroll
        for (int ks = 0; ks < 4; ++ks) a[ks] = *(const bf16x8*)(wrow + 32 * ks);
#pragma unroll
        for (int nb = 0; nb < 8; ++nb) {
            f32x4 acc = {0.f, 0.f, 0.f, 0.f};
#pragma unroll
            for (int ks = 0; ks < 4; ++ks) { const bf16x8 b = *(const LAS bf16x8*)(Vt + (16 * nb + fr) * VP + 32 * ks + 8 * fq);
                acc = __builtin_amdgcn_mfma_f32_16x16x32_bf16(a[ks], b, acc, 0, 0, 0); }
#pragma unroll
            for (int r = 0; r < 4; ++r) { const int p = 16 * wid + fq * 4 + r, d = 16 * nb + fr; const size_t grow = (size_t)(c * 128 + p);
                const float sv = acc[r] + bs[g * 128 + p];
                const float uu = bf1(Z[grow * 4096 + g * 128 + d]);
                Gb[grow * 2048 + g * 128 + d] = tobf1(uu * sv); }
        }
    }
}
#endif

__device__ __forceinline__ void rope_cs(int row, int l, float& cs, float& sn) {
    const int t = row & (SEQ - 1); const int pos = (l & 32) ? (t & 63) : (t >> 6);
    const float inv = powf(10000.0f, -(float)(l & 15) * (1.0f / 16.0f));
    const float ang = (float)pos * inv; sincosf(ang, &sn, &cs);
}
__device__ __forceinline__ float rope_apply(float x, int l, float cs, float sn) {
    const float p = lane_xor16(x, l);
    return (l & 16) ? (p * sn + x * cs) : (x * cs - p * sn);
}
__device__ __forceinline__ void mla_norm_pass(CP P, int lane, int gw, int NGW) {
    const bf16* C = (const bf16*)(P->ws + WS_C); bf16* CQN = (bf16*)(P->ws + WS_CQN); bf16* CKVN = (bf16*)(P->ws + WS_CKVN); bf16* KR = (bf16*)(P->ws + WS_KR);
    const float* qn = P->in[20]; const float* kvn = P->in[21];
    for (int row = gw; row < MT; row += NGW) {
        const bf16* c = C + (size_t)row * 1280;
#pragma unroll
        for (int part = 0; part < 2; ++part) {
            const u32x4 w = *(const u32x4*)(c + part * 512 + 8 * lane);
            float v[8] = {bflo(w.x), bfhi(w.x), bflo(w.y), bfhi(w.y), bflo(w.z), bfhi(w.z), bflo(w.w), bfhi(w.w)};
            float ss = 0.f;
#pragma unroll
            for (int i = 0; i < 8; ++i) ss += v[i] * v[i];
            const float r = 1.0f / sqrtf(wave_sum(ss) * (1.0f / 512.0f) + LN_EPS);
            const float* nw = (part ? kvn : qn) + 8 * lane;
            u32x4 o; o.x = cvtpk(v[0] * r * nw[0], v[1] * r * nw[1]); o.y = cvtpk(v[2] * r * nw[2], v[3] * r * nw[3]); o.z = cvtpk(v[4] * r * nw[4], v[5] * r * nw[5]); o.w = cvtpk(v[6] * r * nw[6], v[7] * r * nw[7]);
            *(u32x4*)((part ? CKVN : CQN) + (size_t)row * 512 + 8 * lane) = o;
        }
        float x = bf1(c[1024 + lane]);
        if (row < ML) { float cs, sn; rope_cs(row, lane, cs, sn); x = rope_apply(x, lane, cs, sn); }
        KR[(size_t)row * 64 + lane] = tobf1(x);
    }
}
__device__ __forceinline__ void rope_pass(bf16* buf, int ld, int col0, int nchunks, int cstride, int lane, int gw, int NGW) {
    for (int row = gw; row < ML; row += NGW) {
        float cs, sn; rope_cs(row, lane, cs, sn);
        bf16* r = buf + (size_t)row * ld + col0 + lane;
#pragma unroll 4
        for (int k = 0; k < nchunks; ++k) { const float x = bf1(r[k * cstride]); r[k * cstride] = tobf1(rope_apply(x, lane, cs, sn)); }
    }
}

namespace att {
#ifndef ATT_RING3
#define ATT_RING3 0
#endif
#ifndef ATT_LDEARLY
#define ATT_LDEARLY 0
#endif
#ifndef ATT_FSMFIRST
#define ATT_FSMFIRST 0
#endif
#ifndef ATT_VROLL
#define ATT_VROLL 1
#endif
#ifndef ATT_VPRE0
#define ATT_VPRE0 1
#endif
#ifndef ATT_VPRE
#define ATT_VPRE 1
#endif
#ifndef ATT_LSUM
#define ATT_LSUM 1
#endif
#ifndef ATT_VSTCF
#define ATT_VSTCF 1
#endif
#ifndef ATT_DA_NQR
#define ATT_DA_NQR 4
#endif
#ifndef ATT_LEAN0
#define ATT_LEAN0 0
#endif
#ifndef ATT_LEAN
#define ATT_LEAN 1
#endif
#ifndef ATT_3STAGE
#define ATT_3STAGE 0
#endif
#ifndef ATT_QLATE
#define ATT_QLATE 1
#endif
#ifndef ATT_PRIO
#define ATT_PRIO 0
#endif
#ifndef ATT_KMAJOR
#define ATT_KMAJOR 0
#endif
#ifndef ATT_TRB
#define ATT_TRB 1
#endif
#ifndef ATT_STAGGER
#define ATT_STAGGER 0
#endif
#ifndef ATT_SDEPTH
#define ATT_SDEPTH(MODE) ((MODE) == 0 ? 1 : 1)
#endif
#ifndef ATT_PVPIPE
#define ATT_PVPIPE(MODE) ((MODE) == 1)
#endif
#define SBAR() __builtin_amdgcn_sched_barrier(0)
__device__ __forceinline__ int crow(int r, int hi) { return (r & 3) + 8 * (r >> 2) + 4 * hi; }
__device__ __forceinline__ unsigned cvtpkv(float lo, float hi) { unsigned r; asm volatile("v_cvt_pk_bf16_f32 %0, %1, %2" : "=v"(r) : "v"(lo), "v"(hi)); return r; }

__device__ __forceinline__ void partialSM(f32x16& p0, f32x16& p1, float& m_reg, float& mn, float& alpha, const float C, const float THRS) {
  float pmax = p0[0];
#pragma unroll
  for (int r = 1; r < 16; ++r) pmax = fmaxf(pmax, p0[r]);
#pragma unroll
  for (int r = 0; r < 16; ++r) pmax = fmaxf(pmax, p1[r]);
  { auto rr = __builtin_amdgcn_permlane32_swap(__float_as_uint(pmax), __float_as_uint(pmax), false, false);
    pmax = fmaxf(__uint_as_float(rr[0]), __uint_as_float(rr[1])); }
  if (__builtin_expect(__all(pmax - m_reg <= THRS), 1)) { mn = m_reg; alpha = 1.f; }
  else { mn = fmaxf(m_reg, pmax); alpha = __builtin_amdgcn_exp2f((m_reg - mn) * C); m_reg = mn; }
  const float mnC = -mn * C;
#pragma unroll
  for (int r = 0; r < 16; ++r) p0[r] = fmaf(p0[r], C, mnC);
#pragma unroll
  for (int r = 0; r < 16; ++r) p1[r] = fmaf(p1[r], C, mnC);
#pragma unroll
  for (int r = 0; r < 16; ++r) p0[r] = __builtin_amdgcn_exp2f(p0[r]);
}
__device__ __forceinline__ void finishSM(f32x16& p0, f32x16& p1, float alpha, float& l_reg, bf16x8& pa0, bf16x8& pa1, bf16x8& pa2, bf16x8& pa3) {
#pragma unroll
  for (int r = 0; r < 16; ++r) p1[r] = __builtin_amdgcn_exp2f(p1[r]);
  float ps = 0;
#pragma unroll
  for (int r = 0; r < 16; ++r) ps += p0[r];
#pragma unroll
  for (int r = 0; r < 16; ++r) ps += p1[r];
  { auto rr = __builtin_amdgcn_permlane32_swap(__float_as_uint(ps), __float_as_uint(ps), false, false);
    ps = __uint_as_float(rr[0]) + __uint_as_float(rr[1]); }
  l_reg = l_reg * alpha + ps;
#define PK4(P, BASE, OUT) do { unsigned a0 = cvtpkv(P[BASE + 0], P[BASE + 1]), a1 = cvtpkv(P[BASE + 2], P[BASE + 3]);   \
    unsigned b0 = cvtpkv(P[BASE + 4], P[BASE + 5]), b1 = cvtpkv(P[BASE + 6], P[BASE + 7]);                              \
    auto r0 = __builtin_amdgcn_permlane32_swap(a0, b0, false, false); auto r1 = __builtin_amdgcn_permlane32_swap(a1, b1, false, false); \
    u32x4 w = {r0[0], r1[0], r0[1], r1[1]}; OUT = *reinterpret_cast<bf16x8*>(&w); } while (0)
  PK4(p0, 0, pa0); PK4(p0, 8, pa1); PK4(p1, 0, pa2); PK4(p1, 8, pa3);
#undef PK4
}
__device__ __forceinline__ void partialSM_lean(f32x16& p0, f32x16& p1, f32x16& nm, float& alpha, const bool first) {
  constexpr float THR2 = 11.541560327111707f;
  float dmax = p0[0];
#pragma unroll
  for (int r = 1; r < 16; ++r) dmax = fmaxf(dmax, p0[r]);
#pragma unroll
  for (int r = 0; r < 16; ++r) dmax = fmaxf(dmax, p1[r]);
  { auto rr = __builtin_amdgcn_permlane32_swap(__float_as_uint(dmax), __float_as_uint(dmax), false, false);
    dmax = fmaxf(__uint_as_float(rr[0]), __uint_as_float(rr[1])); }
  alpha = 1.f;
  if (first || !__all(dmax <= THR2)) {
    const float delta = first ? dmax : (dmax > THR2 ? dmax : 0.f);
    if (!first) alpha = __builtin_amdgcn_exp2f(-delta);
#pragma unroll
    for (int r = 0; r < 16; ++r) { p0[r] -= delta; p1[r] -= delta; nm[r] -= delta; }
  }
#pragma unroll
  for (int r = 0; r < 16; ++r) p0[r] = __builtin_amdgcn_exp2f(p0[r]);
}
template <bool LS> __device__ __forceinline__ void finishSM_lean(f32x16& p0, f32x16& p1, bf16x8& pa0, bf16x8& pa1, bf16x8& pa2, bf16x8& pa3, float& lrun) {
#pragma unroll
  for (int r = 0; r < 16; ++r) p1[r] = __builtin_amdgcn_exp2f(p1[r]);
  if constexpr (LS) {
    typedef float f32x2_ __attribute__((ext_vector_type(2)));
    f32x2_ s0 = {p0[0], p0[1]}, s1 = {p1[0], p1[1]};
#pragma unroll
    for (int r = 2; r < 16; r += 2) { s0 += (f32x2_){p0[r], p0[r + 1]}; s1 += (f32x2_){p1[r], p1[r + 1]}; }
    s0 += s1; lrun += s0[0] + s0[1];
  }
#define PK4(P, BASE, OUT) do { unsigned a0 = cvtpkv(P[BASE + 0], P[BASE + 1]), a1 = cvtpkv(P[BASE + 2], P[BASE + 3]);   \
    unsigned b0 = cvtpkv(P[BASE + 4], P[BASE + 5]), b1 = cvtpkv(P[BASE + 6], P[BASE + 7]);                              \
    auto r0 = __builtin_amdgcn_permlane32_swap(a0, b0, false, false); auto r1 = __builtin_amdgcn_permlane32_swap(a1, b1, false, false); \
    u32x4 w = {r0[0], r1[0], r0[1], r1[1]}; OUT = *reinterpret_cast<bf16x8*>(&w); } while (0)
  PK4(p0, 0, pa0); PK4(p0, 8, pa1); PK4(p1, 0, pa2); PK4(p1, 8, pa3);
#undef PK4
}
__device__ __forceinline__ bf16x8 scale_bf16x8(bf16x8 v, float c) {
  const u32x4 w = *reinterpret_cast<u32x4*>(&v); u32x4 o;
  o.x = cvtpk(bflo(w.x) * c, bfhi(w.x) * c); o.y = cvtpk(bflo(w.y) * c, bfhi(w.y) * c); o.z = cvtpk(bflo(w.z) * c, bfhi(w.z) * c); o.w = cvtpk(bflo(w.w) * c, bfhi(w.w) * c);
  return *reinterpret_cast<bf16x8*>(&o);
}
template <int PITCH> __device__ __forceinline__ int kswz(int r) { return PITCH == 256 ? (r & 15) : ((r >> 1) & 7); }
template <int NQF, int NQR, int PITCH> __device__ __forceinline__ void qkt(f32x16& p0, f32x16& p1, const LAS char* Ks, int chunk0, const bf16x8* qr, const LAS char* ql, int r32, int hi, const f32x16 init = f32x16{}) {
  p0 = init; p1 = init;
  const int sw = kswz<PITCH>(r32);
#pragma unroll
  for (int d0 = 0; d0 < NQF; ++d0) { const int off = ((chunk0 + d0 * 2 + hi) ^ sw) * 16;
    const bf16x8 b0 = *(const LAS bf16x8*)(Ks + r32 * PITCH + off);
    const bf16x8 b1 = *(const LAS bf16x8*)(Ks + (32 + r32) * PITCH + off);
    const bf16x8 q = d0 < NQR ? qr[d0 < NQR ? d0 : 0] : *(const LAS bf16x8*)(ql + (d0 - NQR < 0 ? 0 : d0 - NQR) * 1024);
    p0 = __builtin_amdgcn_mfma_f32_32x32x16_bf16(b0, q, p0, 0, 0, 0);
    p1 = __builtin_amdgcn_mfma_f32_32x32x16_bf16(b1, q, p1, 0, 0, 0); }
}
__device__ __forceinline__ int v_st(int k, int c) { const int kk = (k & ~0xC) | ((k & 4) << 1) | ((k & 8) >> 1); return ((kk >> 3) * 4 + (c >> 5)) * 512 + ((kk & 7) * 32 + (c & 31)) * 2; }
__device__ __forceinline__ int v_rd_base(int lane) { return ((lane & 3) << 3) | (((lane >> 2) & 3) << 6) | (((lane >> 4) & 1) << 5) | (((lane >> 5) & 1) << 8); }
constexpr int v_rd_off(int d0, int ks, int half) { return d0 * 512 + ks * 4096 + half * 2048; }
template <int OFF> __device__ __forceinline__ s16x4 tr_read(int vb) {
  s16x4 r; asm volatile("ds_read_b64_tr_b16 %0, %1 offset:%2" : "=&v"(r) : "v"(vb), "i"(OFF) : "memory"); return r;
}
template <int D0> __device__ __forceinline__ void pv_one(f32x16& od, int vb, bf16x8 pa0, bf16x8 pa1, bf16x8 pa2, bf16x8 pa3) {
  const s16x4 l0 = tr_read<v_rd_off(D0, 0, 0)>(vb), h0 = tr_read<v_rd_off(D0, 0, 1)>(vb), l1 = tr_read<v_rd_off(D0, 1, 0)>(vb), h1 = tr_read<v_rd_off(D0, 1, 1)>(vb);
  const s16x4 l2 = tr_read<v_rd_off(D0, 2, 0)>(vb), h2 = tr_read<v_rd_off(D0, 2, 1)>(vb), l3 = tr_read<v_rd_off(D0, 3, 0)>(vb), h3 = tr_read<v_rd_off(D0, 3, 1)>(vb);
  asm volatile("s_waitcnt lgkmcnt(0)" ::: "memory"); SBAR();
#define PK(L, H) (bf16x8){L[0], L[1], L[2], L[3], H[0], H[1], H[2], H[3]}
  od = __builtin_amdgcn_mfma_f32_32x32x16_bf16(pa0, PK(l0, h0), od, 0, 0, 0);
  od = __builtin_amdgcn_mfma_f32_32x32x16_bf16(pa1, PK(l1, h1), od, 0, 0, 0);
  od = __builtin_amdgcn_mfma_f32_32x32x16_bf16(pa2, PK(l2, h2), od, 0, 0, 0);
  od = __builtin_amdgcn_mfma_f32_32x32x16_bf16(pa3, PK(l3, h3), od, 0, 0, 0);
#undef PK
}
__device__ __forceinline__ void pv_d0(f32x16* o, int vb, bf16x8 pa0, bf16x8 pa1, bf16x8 pa2, bf16x8 pa3) {
  pv_one<0>(o[0], vb, pa0, pa1, pa2, pa3); pv_one<1>(o[1], vb, pa0, pa1, pa2, pa3); pv_one<2>(o[2], vb, pa0, pa1, pa2, pa3); pv_one<3>(o[3], vb, pa0, pa1, pa2, pa3);
}
struct VHalf { s16x4 l0, h0, l1, h1; };
__device__ __forceinline__ void pv_d0_roll(f32x16* o, int vb, bf16x8 pa0, bf16x8 pa1, bf16x8 pa2, bf16x8 pa3, const VHalf& pre) {
#define PK(L, H) (bf16x8){L[0], L[1], L[2], L[3], H[0], H[1], H[2], H[3]}
#define HT(f) "+v"(f.l0), "+v"(f.h0), "+v"(f.l1), "+v"(f.h1)
  VHalf cur = pre;
  asm volatile("s_waitcnt lgkmcnt(0)" : HT(cur) :: "memory");
#define RBLK(D, LAST) do { s16x4 l2 = tr_read<v_rd_off(D, 2, 0)>(vb), h2 = tr_read<v_rd_off(D, 2, 1)>(vb), l3 = tr_read<v_rd_off(D, 3, 0)>(vb), h3 = tr_read<v_rd_off(D, 3, 1)>(vb); VHalf nx = cur; \
    if (!(LAST)) { nx.l0 = tr_read<v_rd_off((LAST) ? D : D + 1, 0, 0)>(vb); nx.h0 = tr_read<v_rd_off((LAST) ? D : D + 1, 0, 1)>(vb); nx.l1 = tr_read<v_rd_off((LAST) ? D : D + 1, 1, 0)>(vb); nx.h1 = tr_read<v_rd_off((LAST) ? D : D + 1, 1, 1)>(vb); } \
    if ((D) > 0) { if (LAST) asm volatile("s_waitcnt lgkmcnt(4)" : HT(cur) :: "memory"); else asm volatile("s_waitcnt lgkmcnt(8)" : HT(cur) :: "memory"); } \
    o[D] = __builtin_amdgcn_mfma_f32_32x32x16_bf16(pa0, PK(cur.l0, cur.h0), o[D], 0, 0, 0); o[D] = __builtin_amdgcn_mfma_f32_32x32x16_bf16(pa1, PK(cur.l1, cur.h1), o[D], 0, 0, 0); \
    if (LAST) asm volatile("s_waitcnt lgkmcnt(0)" : "+v"(l2), "+v"(h2), "+v"(l3), "+v"(h3) :: "memory"); else asm volatile("s_waitcnt lgkmcnt(4)" : "+v"(l2), "+v"(h2), "+v"(l3), "+v"(h3) :: "memory"); \
    o[D] = __builtin_amdgcn_mfma_f32_32x32x16_bf16(pa2, PK(l2, h2), o[D], 0, 0, 0); o[D] = __builtin_amdgcn_mfma_f32_32x32x16_bf16(pa3, PK(l3, h3), o[D], 0, 0, 0); \
    if (!(LAST)) cur = nx; } while (0)
  RBLK(0, false); RBLK(1, false); RBLK(2, false); RBLK(3, true);
#undef RBLK
#undef HT
#undef PK
}
__device__ __forceinline__ void pv_d0_pre(f32x16* o, int vb, bf16x8 pa0, bf16x8 pa1, bf16x8 pa2, bf16x8 pa3, const VHalf& pre) {
  { const s16x4 l2 = tr_read<v_rd_off(0, 2, 0)>(vb), h2 = tr_read<v_rd_off(0, 2, 1)>(vb), l3 = tr_read<v_rd_off(0, 3, 0)>(vb), h3 = tr_read<v_rd_off(0, 3, 1)>(vb);
#define PK(L, H) (bf16x8){L[0], L[1], L[2], L[3], H[0], H[1], H[2], H[3]}
    o[0] = __builtin_amdgcn_mfma_f32_32x32x16_bf16(pa0, PK(pre.l0, pre.h0), o[0], 0, 0, 0);
    o[0] = __builtin_amdgcn_mfma_f32_32x32x16_bf16(pa1, PK(pre.l1, pre.h1), o[0], 0, 0, 0);
    asm volatile("s_waitcnt lgkmcnt(0)" ::: "memory"); SBAR();
    o[0] = __builtin_amdgcn_mfma_f32_32x32x16_bf16(pa2, PK(l2, h2), o[0], 0, 0, 0);
    o[0] = __builtin_amdgcn_mfma_f32_32x32x16_bf16(pa3, PK(l3, h3), o[0], 0, 0, 0);
#undef PK
  }
  pv_one<1>(o[1], vb, pa0, pa1, pa2, pa3); pv_one<2>(o[2], vb, pa0, pa1, pa2, pa3); pv_one<3>(o[3], vb, pa0, pa1, pa2, pa3);
}
struct VFrag { s16x4 l0, h0, l1, h1, l2, h2, l3, h3; };
typedef short v4i16_t __attribute__((ext_vector_type(4)));
template <int OFF> __device__ __forceinline__ s16x4 tr_read_b(int vb) {
  return __builtin_bit_cast(s16x4, __builtin_amdgcn_ds_read_tr16_b64_v4i16((LAS v4i16_t*)(uintptr_t)(unsigned)(vb + OFF)));
}
template <int D0> __device__ __forceinline__ void tr8b(VFrag& f, int vb) {
  f.l0 = tr_read_b<v_rd_off(D0, 0, 0)>(vb); f.h0 = tr_read_b<v_rd_off(D0, 0, 1)>(vb); f.l1 = tr_read_b<v_rd_off(D0, 1, 0)>(vb); f.h1 = tr_read_b<v_rd_off(D0, 1, 1)>(vb);
  f.l2 = tr_read_b<v_rd_off(D0, 2, 0)>(vb); f.h2 = tr_read_b<v_rd_off(D0, 2, 1)>(vb); f.l3 = tr_read_b<v_rd_off(D0, 3, 0)>(vb); f.h3 = tr_read_b<v_rd_off(D0, 3, 1)>(vb);
}
template <int D0> __device__ __forceinline__ void tr8(VFrag& f, int vb) {
  f.l0 = tr_read<v_rd_off(D0, 0, 0)>(vb); f.h0 = tr_read<v_rd_off(D0, 0, 1)>(vb); f.l1 = tr_read<v_rd_off(D0, 1, 0)>(vb); f.h1 = tr_read<v_rd_off(D0, 1, 1)>(vb);
  f.l2 = tr_read<v_rd_off(D0, 2, 0)>(vb); f.h2 = tr_read<v_rd_off(D0, 2, 1)>(vb); f.l3 = tr_read<v_rd_off(D0, 3, 0)>(vb); f.h3 = tr_read<v_rd_off(D0, 3, 1)>(vb);
}
__device__ __forceinline__ void mfma4(f32x16& od, VFrag& f, bf16x8 pa0, bf16x8 pa1, bf16x8 pa2, bf16x8 pa3) {
#define PK(L, H) (bf16x8){L[0], L[1], L[2], L[3], H[0], H[1], H[2], H[3]}
  od = __builtin_amdgcn_mfma_f32_32x32x16_bf16(pa0, PK(f.l0, f.h0), od, 0, 0, 0);
  od = __builtin_amdgcn_mfma_f32_32x32x16_bf16(pa1, PK(f.l1, f.h1), od, 0, 0, 0);
  od = __builtin_amdgcn_mfma_f32_32x32x16_bf16(pa2, PK(f.l2, f.h2), od, 0, 0, 0);
  od = __builtin_amdgcn_mfma_f32_32x32x16_bf16(pa3, PK(f.l3, f.h3), od, 0, 0, 0);
#undef PK
}
#define VF_TIE(f) "+v"(f.l0), "+v"(f.h0), "+v"(f.l1), "+v"(f.h1), "+v"(f.l2), "+v"(f.h2), "+v"(f.l3), "+v"(f.h3)
__device__ __forceinline__ void pv_pipe(f32x16* o, int vb, bf16x8 pa0, bf16x8 pa1, bf16x8 pa2, bf16x8 pa3) {
  VFrag A, B;
  asm volatile("s_waitcnt lgkmcnt(0)" ::: "memory");
  tr8<0>(A, vb); tr8<1>(B, vb);
  asm volatile("s_waitcnt lgkmcnt(8)" : VF_TIE(A) :: "memory");
  mfma4(o[0], A, pa0, pa1, pa2, pa3);
  tr8<2>(A, vb);
  asm volatile("s_waitcnt lgkmcnt(8)" : VF_TIE(B) :: "memory");
  mfma4(o[1], B, pa0, pa1, pa2, pa3);
  tr8<3>(B, vb);
  asm volatile("s_waitcnt lgkmcnt(8)" : VF_TIE(A) :: "memory");
  mfma4(o[2], A, pa0, pa1, pa2, pa3);
  asm volatile("s_waitcnt lgkmcnt(0)" : VF_TIE(B) :: "memory");
  mfma4(o[3], B, pa0, pa1, pa2, pa3);
}
template <bool ONES = true> __device__ __forceinline__ void pv_psm_lean(f32x16* o, int vb, bf16x8 pa0, bf16x8 pa1, bf16x8 pa2, bf16x8 pa3, f32x16& p0, f32x16& p1, f32x16& nm, float& alpha) {
  constexpr float THR2 = 11.541560327111707f;
  const bf16x8 one8 = {0x3F80, 0x3F80, 0x3F80, 0x3F80, 0x3F80, 0x3F80, 0x3F80, 0x3F80};
  VFrag A, B;
  asm volatile("s_waitcnt lgkmcnt(0)" ::: "memory");
  tr8<0>(A, vb); tr8<1>(B, vb);
  asm volatile("s_waitcnt lgkmcnt(8)" : VF_TIE(A) :: "memory");
  mfma4(o[0], A, pa0, pa1, pa2, pa3);
  float dmax = p0[0];
#pragma unroll
  for (int r = 1; r < 16; ++r) dmax = fmaxf(dmax, p0[r]);
  tr8<2>(A, vb);
  asm volatile("s_waitcnt lgkmcnt(8)" : VF_TIE(B) :: "memory");
  mfma4(o[1], B, pa0, pa1, pa2, pa3);
#pragma unroll
  for (int r = 0; r < 16; ++r) dmax = fmaxf(dmax, p1[r]);
  { auto rr = __builtin_amdgcn_permlane32_swap(__float_as_uint(dmax), __float_as_uint(dmax), false, false);
    dmax = fmaxf(__uint_as_float(rr[0]), __uint_as_float(rr[1])); }
  alpha = 1.f;
  if (!__all(dmax <= THR2)) {
    const float delta = dmax > THR2 ? dmax : 0.f; alpha = __builtin_amdgcn_exp2f(-delta);
#pragma unroll
    for (int r = 0; r < 16; ++r) { p0[r] -= delta; p1[r] -= delta; nm[r] -= delta; }
  }
  tr8<3>(B, vb);
  asm volatile("s_waitcnt lgkmcnt(8)" : VF_TIE(A) :: "memory");
  mfma4(o[2], A, pa0, pa1, pa2, pa3);
#pragma unroll
  for (int r = 0; r < 8; ++r) p0[r] = __builtin_amdgcn_exp2f(p0[r]);
  asm volatile("s_waitcnt lgkmcnt(0)" : VF_TIE(B) :: "memory");
  mfma4(o[3], B, pa0, pa1, pa2, pa3);
#pragma unroll
  for (int r = 8; r < 16; ++r) p0[r] = __builtin_amdgcn_exp2f(p0[r]);
  if constexpr (ONES) { o[4] = __builtin_amdgcn_mfma_f32_32x32x16_bf16(pa0, one8, o[4], 0, 0, 0); o[4] = __builtin_amdgcn_mfma_f32_32x32x16_bf16(pa1, one8, o[4], 0, 0, 0);
  o[4] = __builtin_amdgcn_mfma_f32_32x32x16_bf16(pa2, one8, o[4], 0, 0, 0); o[4] = __builtin_amdgcn_mfma_f32_32x32x16_bf16(pa3, one8, o[4], 0, 0, 0); }
}
template <bool ONES = true, bool PRE = false> __device__ __forceinline__ void pv_psm_lean_b(f32x16* o, int vb, bf16x8 pa0, bf16x8 pa1, bf16x8 pa2, bf16x8 pa3, f32x16& p0, f32x16& p1, f32x16& nm, float& alpha, const VFrag* pre = nullptr) {
  constexpr float THR2 = 11.541560327111707f;
  const bf16x8 one8 = {0x3F80, 0x3F80, 0x3F80, 0x3F80, 0x3F80, 0x3F80, 0x3F80, 0x3F80};
  VFrag A, B;
  if constexpr (PRE) A = *pre; else tr8b<0>(A, vb);
  tr8b<1>(B, vb);
  mfma4(o[0], A, pa0, pa1, pa2, pa3);
  float dmax = p0[0];
#pragma unroll
  for (int r = 1; r < 16; ++r) dmax = fmaxf(dmax, p0[r]);
  tr8b<2>(A, vb);
  mfma4(o[1], B, pa0, pa1, pa2, pa3);
#pragma unroll
  for (int r = 0; r < 16; ++r) dmax = fmaxf(dmax, p1[r]);
  { auto rr = __builtin_amdgcn_permlane32_swap(__float_as_uint(dmax), __float_as_uint(dmax), false, false);
    dmax = fmaxf(__uint_as_float(rr[0]), __uint_as_float(rr[1])); }
  alpha = 1.f;
  if (!__all(dmax <= THR2)) {
    const float delta = dmax > THR2 ? dmax : 0.f; alpha = __builtin_amdgcn_exp2f(-delta);
#pragma unroll
    for (int r = 0; r < 16; ++r) { p0[r] -= delta; p1[r] -= delta; nm[r] -= delta; }
  }
  tr8b<3>(B, vb);
  mfma4(o[2], A, pa0, pa1, pa2, pa3);
#pragma unroll
  for (int r = 0; r < 8; ++r) p0[r] = __builtin_amdgcn_exp2f(p0[r]);
  mfma4(o[3], B, pa0, pa1, pa2, pa3);
#pragma unroll
  for (int r = 8; r < 16; ++r) p0[r] = __builtin_amdgcn_exp2f(p0[r]);
  if constexpr (ONES) { o[4] = __builtin_amdgcn_mfma_f32_32x32x16_bf16(pa0, one8, o[4], 0, 0, 0); o[4] = __builtin_amdgcn_mfma_f32_32x32x16_bf16(pa1, one8, o[4], 0, 0, 0);
  o[4] = __builtin_amdgcn_mfma_f32_32x32x16_bf16(pa2, one8, o[4], 0, 0, 0); o[4] = __builtin_amdgcn_mfma_f32_32x32x16_bf16(pa3, one8, o[4], 0, 0, 0); }
}
struct VStep { s16x4 l0, h0, l1, h1, l2, h2, l3, h3; };
template <int KS> __device__ __forceinline__ void trstep(VStep& f, int vb) {
  f.l0 = tr_read_b<v_rd_off(0, KS, 0)>(vb); f.h0 = tr_read_b<v_rd_off(0, KS, 1)>(vb); f.l1 = tr_read_b<v_rd_off(1, KS, 0)>(vb); f.h1 = tr_read_b<v_rd_off(1, KS, 1)>(vb);
  f.l2 = tr_read_b<v_rd_off(2, KS, 0)>(vb); f.h2 = tr_read_b<v_rd_off(2, KS, 1)>(vb); f.l3 = tr_read_b<v_rd_off(3, KS, 0)>(vb); f.h3 = tr_read_b<v_rd_off(3, KS, 1)>(vb);
}
__device__ __forceinline__ void mfma5(f32x16* o, const VStep& f, bf16x8 pa) {
  const bf16x8 one8 = {0x3F80, 0x3F80, 0x3F80, 0x3F80, 0x3F80, 0x3F80, 0x3F80, 0x3F80};
#define PK(L, H) (bf16x8){L[0], L[1], L[2], L[3], H[0], H[1], H[2], H[3]}
  o[0] = __builtin_amdgcn_mfma_f32_32x32x16_bf16(pa, PK(f.l0, f.h0), o[0], 0, 0, 0);
  o[1] = __builtin_amdgcn_mfma_f32_32x32x16_bf16(pa, PK(f.l1, f.h1), o[1], 0, 0, 0);
  o[2] = __builtin_amdgcn_mfma_f32_32x32x16_bf16(pa, PK(f.l2, f.h2), o[2], 0, 0, 0);
  o[3] = __builtin_amdgcn_mfma_f32_32x32x16_bf16(pa, PK(f.l3, f.h3), o[3], 0, 0, 0);
  o[4] = __builtin_amdgcn_mfma_f32_32x32x16_bf16(pa, one8, o[4], 0, 0, 0);
#undef PK
}
template <int BASE> __device__ __forceinline__ bf16x8 pk4e(const f32x16& P) {
  const float e0 = __builtin_amdgcn_exp2f(P[BASE + 0]), e1 = __builtin_amdgcn_exp2f(P[BASE + 1]), e2 = __builtin_amdgcn_exp2f(P[BASE + 2]), e3 = __builtin_amdgcn_exp2f(P[BASE + 3]);
  const float e4 = __builtin_amdgcn_exp2f(P[BASE + 4]), e5 = __builtin_amdgcn_exp2f(P[BASE + 5]), e6 = __builtin_amdgcn_exp2f(P[BASE + 6]), e7 = __builtin_amdgcn_exp2f(P[BASE + 7]);
  const unsigned a0 = cvtpk(e0, e1), a1 = cvtpk(e2, e3), b0 = cvtpk(e4, e5), b1 = cvtpk(e6, e7);
  const auto r0 = __builtin_amdgcn_permlane32_swap(a0, b0, false, false); const auto r1 = __builtin_amdgcn_permlane32_swap(a1, b1, false, false);
  u32x4 w = {r0[0], r1[0], r0[1], r1[1]}; return *reinterpret_cast<bf16x8*>(&w);
}
__device__ __forceinline__ float rowmax_lean(const f32x16& p0, const f32x16& p1) {
  float d = p0[0];
#pragma unroll
  for (int r = 1; r < 16; ++r) d = fmaxf(d, p0[r]);
#pragma unroll
  for (int r = 0; r < 16; ++r) d = fmaxf(d, p1[r]);
  const auto rr = __builtin_amdgcn_permlane32_swap(__float_as_uint(d), __float_as_uint(d), false, false);
  return fmaxf(__uint_as_float(rr[0]), __uint_as_float(rr[1]));
}
__device__ __forceinline__ void shift_lean(float dmax, f32x16& p0, f32x16& p1, f32x16& nm, float& alpha, const bool first) {
  constexpr float THR2 = 11.541560327111707f;
  alpha = 1.f;
  if (first || !__all(dmax <= THR2)) {
    const float delta = first ? dmax : (dmax > THR2 ? dmax : 0.f);
    if (!first) alpha = __builtin_amdgcn_exp2f(-delta);
#pragma unroll
    for (int r = 0; r < 16; ++r) { p0[r] -= delta; p1[r] -= delta; nm[r] -= delta; }
  }
}
#define SGB(mask, n) __builtin_amdgcn_sched_group_barrier((mask), (n), 0)
__device__ __forceinline__ bf16x8 ld8(const bf16* p) { return *reinterpret_cast<const bf16x8*>(p); }

template <int MODE, int ATTV = 0>
__device__ __forceinline__ void attn_unit(const bf16* __restrict__ Qrow0, int ldq, const bf16* __restrict__ Kb, const bf16* __restrict__ Vb, int ldk, const bf16* __restrict__ KRb,
                                          int b, int nct, int NT, bf16* __restrict__ Ob, float lam, const float* __restrict__ subln, float oscale, LAS unsigned char* lds_, const int tid_in) {
  constexpr bool LEAN = ((MODE == 1) && ATT_LEAN) || ((MODE == 0) && ATT_LEAN0); constexpr bool LSUM = LEAN && ATT_LSUM && (MODE == 1); constexpr int NQF = MODE == 0 ? 12 : 4, NQR = MODE == 0 ? 4 : ATT_DA_NQR, NOB = (LEAN && !(ATT_LSUM && MODE == 1)) ? 5 : 4, PITCH = MODE == 0 ? 384 : 256, SHM_V = 16384, SHM_K = 64 * PITCH, SDEPTH = ATT_SDEPTH(MODE); constexpr bool PVPIPE = ATT_PVPIPE(MODE);
  const float SCALE = MODE == 0 ? 0.07216878364870323f : 0.125f;
  const float C = SCALE * 1.4426950408889634f, THRS = 8.f / SCALE;
  if (ATT_PRIO) { if (__builtin_amdgcn_readfirstlane(tid_in >> 8) != 0) __builtin_amdgcn_s_setprio(1); }
  const int tid = launder_v(tid_in) & 511, wid = tid >> 6, lane = tid & 63, r32 = lane & 31, hi = lane >> 5;
  LAS char* lds = (LAS char*)(LAS unsigned char*)lds_;
  constexpr bool THREE = (MODE == 1) && ATT_3STAGE; constexpr bool RING3 = (MODE == 1) && ATT_RING3 && !THREE && (ATT_SDEPTH(MODE) == 1); constexpr int NSTG = (THREE || RING3) ? 3 : 2, STG = SHM_V + SHM_K, SCR0 = NSTG * STG;
#define VOFF(s) (!(THREE || RING3) ? (s) * SHM_V : (s) * STG)
#define KOFF(s) (!(THREE || RING3) ? 2 * SHM_V + (s) * SHM_K : (s) * STG + SHM_V)
  LAS char* V_lds = lds; LAS char* K_lds = lds;
  LAS float* wsf = (LAS float*)(lds + NSTG * (SHM_V + SHM_K)) + wid * 64; LAS float* li_l = wsf; LAS float* al_l = wsf + 32;
  const int wq = MODE == 0 ? wid : (wid & 3), sgrp = MODE == 0 ? 0 : (wid >> 2);
  float m_reg = -1e30f, l_reg = 0; f32x16 o[NOB] = {}; bf16x8 qr[NQR > 0 ? NQR : 1]; f32x16 nm = {};
  LAS char* ql = lds + SCR0 + 2048 + wid * (MODE == 0 ? 8192 : 4096) + lane * 16;
  const bf16* Qw = Qrow0 + (size_t)(wq * 32 + r32) * ldq + sgrp * 64 + hi * 8;
#define QLOADS() do { _Pragma("unroll") for (int d0 = 0; d0 < NQR; ++d0) { qr[d0] = ld8(Qw + d0 * 16); if (LEAN) qr[d0] = scale_bf16x8(qr[d0], C); } \
    _Pragma("unroll") for (int d0 = NQR; d0 < NQF; ++d0) { bf16x8 qv = ld8(Qw + d0 * 16); if (LEAN) qv = scale_bf16x8(qv, C); *(LAS bf16x8*)(ql + (d0 - NQR) * 1024) = qv; } } while (0)
  constexpr bool QLATE = ATT_QLATE && !((MODE == 1) && ATT_3STAGE) && !((MODE == 1) && ATT_LEAN && ATT_KMAJOR && (ATTV == 0));
  if (!QLATE) QLOADS();
  const int sr = tid >> 4, sc = (tid & 15) * 8;
  const int srv = ATT_VSTCF ? (tid >> 6) * 4 + ((tid >> 2) & 3) : sr, scv = ATT_VSTCF ? ((tid >> 4) & 3) * 32 + (tid & 3) * 8 : sc;
  const int vst0 = v_st(srv, scv), vst1 = v_st(32 + srv, scv);
  const int kst0 = sr * PITCH + (((tid & 15) ^ kswz<PITCH>(sr)) * 16), kst1 = kst0 + 32 * PITCH;
  const int rrow = tid >> 3, krs = rrow * PITCH + (((16 + (tid & 7)) ^ kswz<PITCH>(rrow)) * 16);
  const int chunk0 = sgrp * 8;
  const int vb0 = (int)(uintptr_t)V_lds + v_rd_base(lane);
  struct Slot { bf16x8 vs0, vs1, ks0, ks1, kr; } sr_[SDEPTH];
#define KROW(jt) ((jt) < nct ? (ML + b * CTXL + (jt) * 64) : (b * SEQ + ((jt) - nct) * 64))
#define SLOAD(i, jt) do { const int k0_ = KROW(jt); sr_[i].vs0 = ld8(Vb + (size_t)(k0_ + srv) * ldk + scv); sr_[i].vs1 = ld8(Vb + (size_t)(k0_ + 32 + srv) * ldk + scv); \
    sr_[i].ks0 = ld8(Kb + (size_t)(k0_ + sr) * ldk + sc); sr_[i].ks1 = ld8(Kb + (size_t)(k0_ + 32 + sr) * ldk + sc); \
    if (MODE == 0) sr_[i].kr = ld8(KRb + (size_t)(k0_ + rrow) * 64 + (tid & 7) * 8); } while (0)
#define SWRITE(bf, i) do { *(LAS bf16x8*)(V_lds + VOFF(bf) + vst0) = sr_[i].vs0; *(LAS bf16x8*)(V_lds + VOFF(bf) + vst1) = sr_[i].vs1; \
    *(LAS bf16x8*)(K_lds + KOFF(bf) + kst0) = sr_[i].ks0; *(LAS bf16x8*)(K_lds + KOFF(bf) + kst1) = sr_[i].ks1; \
    if (MODE == 0) *(LAS bf16x8*)(K_lds + KOFF(bf) + krs) = sr_[i].kr; } while (0)
#define SWAIT() do { if constexpr (SDEPTH == 2) asm volatile("s_waitcnt vmcnt(4)" ::: "memory"); else asm volatile("s_waitcnt vmcnt(0)" ::: "memory"); } while (0)
#define RESC(a) do { if (__any((a) < 1.f)) { if constexpr (LSUM) l_reg *= (a); if (hi == 0) al_l[r32] = (a); asm volatile("s_waitcnt lgkmcnt(0)" ::: "memory"); \
    _Pragma("unroll") for (int d = 0; d < NOB; ++d) _Pragma("unroll") for (int r = 0; r < 16; ++r) o[d][r] *= al_l[crow(r, hi)]; } } while (0)
#define PV(vb_) do { if constexpr (ATTV == 2) { o[0][0] += __uint_as_float((unsigned)pa0[0] + (unsigned)pa3[1]); } else if constexpr (PVPIPE) pv_pipe(o, (vb_), pa0, pa1, pa2, pa3); else pv_d0(o, (vb_), pa0, pa1, pa2, pa3); \
    if constexpr (LEAN && !LSUM) { const bf16x8 one8 = {0x3F80, 0x3F80, 0x3F80, 0x3F80, 0x3F80, 0x3F80, 0x3F80, 0x3F80};     \
        o[NOB - 1] = __builtin_amdgcn_mfma_f32_32x32x16_bf16(pa0, one8, o[NOB - 1], 0, 0, 0); o[NOB - 1] = __builtin_amdgcn_mfma_f32_32x32x16_bf16(pa1, one8, o[NOB - 1], 0, 0, 0); \
        o[NOB - 1] = __builtin_amdgcn_mfma_f32_32x32x16_bf16(pa2, one8, o[NOB - 1], 0, 0, 0); o[NOB - 1] = __builtin_amdgcn_mfma_f32_32x32x16_bf16(pa3, one8, o[NOB - 1], 0, 0, 0); } } while (0)
#define PSM(p0_, p1_, mn_, al_, first_) do { if constexpr (ATTV == 1) { al_ = 1.f; } else if constexpr (LEAN) partialSM_lean(p0_, p1_, nm, al_, first_); else partialSM(p0_, p1_, m_reg, mn_, al_, C, THRS); } while (0)
#define FSM(p0_, p1_, al_) do { if constexpr (ATTV == 1) { u32x4 w0_ = {__float_as_uint(p0_[0]), __float_as_uint(p0_[1]), __float_as_uint(p1_[0]), __float_as_uint(p1_[1])}; pa0 = pa1 = pa2 = pa3 = *reinterpret_cast<bf16x8*>(&w0_); } else if constexpr (LEAN) finishSM_lean<LSUM>(p0_, p1_, pa0, pa1, pa2, pa3, l_reg); else finishSM(p0_, p1_, al_, l_reg, pa0, pa1, pa2, pa3); } while (0)
#define QKT(p0_, p1_, Kp_) do { if constexpr (ATTV == 5) { p0_ = nm; p1_ = nm; p0_[0] += (float)r32; } else if constexpr (LEAN) qkt<NQF, NQR, PITCH>(p0_, p1_, Kp_, chunk0, qr, ql, r32, hi, nm); else qkt<NQF, NQR, PITCH>(p0_, p1_, Kp_, chunk0, qr, ql, r32, hi); } while (0)
  f32x16 pA0, pA1, pB0, pB1; float mnA, mnB, alA, alB; bf16x8 pa0, pa1, pa2, pa3;
  constexpr bool KMAJ = (MODE == 1) && LEAN && ATT_KMAJOR && (ATTV == 0) && !THREE;
  if constexpr (KMAJ) {
    VStep VA, VB;
#define KSTEPS(PC0, PC1, ALC, PP0, PP1, KC, VP, LD, DOQK) do { const int vb_ = vb0 + VOFF(VP); float dmx_ = 0.f; \
      SBAR(); \
      if (DOQK) QKT(PC0, PC1, K_lds + KOFF(KC)); \
      pa0 = pk4e<0>(PP0); trstep<0>(VA, vb_); \
      _Pragma("unroll") for (int i_ = 0; i_ < 8; ++i_) { SGB(0x008, 1); SGB(0x100, 3); SGB(0x002, 2); } \
      SBAR(); LD; SBAR(); \
      mfma5(o, VA, pa0); pa1 = pk4e<8>(PP0); trstep<1>(VB, vb_); \
      _Pragma("unroll") for (int i_ = 0; i_ < 5; ++i_) { SGB(0x008, 1); SGB(0x100, 2); SGB(0x002, 3); } \
      SBAR(); \
      mfma5(o, VB, pa1); pa2 = pk4e<0>(PP1); trstep<2>(VA, vb_); \
      _Pragma("unroll") for (int i_ = 0; i_ < 5; ++i_) { SGB(0x008, 1); SGB(0x100, 2); SGB(0x002, 3); } \
      SBAR(); \
      mfma5(o, VA, pa2); pa3 = pk4e<8>(PP1); trstep<3>(VB, vb_); \
      _Pragma("unroll") for (int i_ = 0; i_ < 5; ++i_) { SGB(0x008, 1); SGB(0x100, 2); SGB(0x002, 3); } \
      SBAR(); \
      mfma5(o, VB, pa3); if (DOQK) dmx_ = rowmax_lean(PC0, PC1); \
      _Pragma("unroll") for (int i_ = 0; i_ < 5; ++i_) { SGB(0x008, 1); SGB(0x002, 7); } \
      SBAR(); \
      if (DOQK) shift_lean(dmx_, PC0, PC1, nm, ALC, false); } while (0)
    SLOAD(0, 0); asm volatile("s_waitcnt vmcnt(0)" ::: "memory"); SWRITE(0, 0); __syncthreads();
    QKT(pA0, pA1, K_lds + KOFF(0)); shift_lean(rowmax_lean(pA0, pA1), pA0, pA1, nm, alA, true);
    SLOAD(0, 1); asm volatile("s_waitcnt vmcnt(0)" ::: "memory"); SWRITE(1, 0); __syncthreads();
    for (int j = 1; j + 1 < NT; j += 2) {
      KSTEPS(pB0, pB1, alB, pA0, pA1, 1, 0, SLOAD(0, j + 1), true);
      __syncthreads(); asm volatile("s_waitcnt vmcnt(0)" ::: "memory"); SWRITE(0, 0);
      RESC(alB); __syncthreads();
      KSTEPS(pA0, pA1, alA, pB0, pB1, 0, 1, SLOAD(0, j + 2), true);
      __syncthreads(); asm volatile("s_waitcnt vmcnt(0)" ::: "memory"); SWRITE(1, 0);
      RESC(alA); __syncthreads();
    }
    KSTEPS(pB0, pB1, alB, pA0, pA1, 1, 0, (void)0, true);
    __syncthreads(); RESC(alB);
    KSTEPS(pA0, pA1, alA, pB0, pB1, 0, 1, (void)0, false);
#undef KSTEPS
  } else if constexpr (!THREE) {
  constexpr int SE = 0, SO = SDEPTH - 1;
  SLOAD(SE, 0); if (QLATE) QLOADS(); asm volatile("s_waitcnt vmcnt(0)" ::: "memory"); SWRITE(0, SE);
  if constexpr (QLATE && SDEPTH == 1) SLOAD(SO, 1);
  __syncthreads();
  QKT(pA0, pA1, K_lds + KOFF(0)); PSM(pA0, pA1, mnA, alA, true);
  if constexpr (!(QLATE && SDEPTH == 1)) SLOAD(SO, 1);
  if constexpr (SDEPTH == 2) { if (2 < NT) SLOAD(SE, 2); }
  SWAIT(); SWRITE(1, SO); __syncthreads();
#define ILV() do { if constexpr (PVPIPE) { _Pragma("unroll") for (int i_ = 0; i_ < 20; ++i_) { __builtin_amdgcn_sched_group_barrier(0x008, 1, 0); __builtin_amdgcn_sched_group_barrier(0x002, 5, 0); } } } while (0)
#define LSLOAD(i, jt) do { if constexpr (ATTV != 3) SLOAD(i, jt); } while (0)
#define LSWRITE(bf, i) do { if constexpr (ATTV != 3) SWRITE(bf, i); } while (0)
#define LSWAIT() do { if constexpr (ATTV != 3) SWAIT(); } while (0)
#define LSYNC() do { if constexpr (ATTV != 4) __syncthreads(); } while (0)
#define HALFSTEP(PC0, PC1, MNC, ALC, PP0, PP1, ALP, KC, VP, LD) do { \
    if (!STAG || wid < 4) { \
      VFrag vpre_; VHalf vh_; SBAR(); if constexpr (VPRE) tr8b<0>(vpre_, vb0 + VOFF(VP)); \
      if constexpr (VPRE0) { vh_.l0 = tr_read_b<v_rd_off(0, 0, 0)>(vb0 + VOFF(VP)); vh_.h0 = tr_read_b<v_rd_off(0, 0, 1)>(vb0 + VOFF(VP)); vh_.l1 = tr_read_b<v_rd_off(0, 1, 0)>(vb0 + VOFF(VP)); vh_.h1 = tr_read_b<v_rd_off(0, 1, 1)>(vb0 + VOFF(VP)); } \
      if constexpr (ATT_LDEARLY) { LD; } \
      if constexpr (ATT_FSMFIRST) { FSM(PP0, PP1, ALP); QKT(PC0, PC1, K_lds + KOFF(KC)); } else { QKT(PC0, PC1, K_lds + KOFF(KC)); FSM(PP0, PP1, ALP); } SBAR(); \
      if constexpr (!ATT_LDEARLY) { LD; } SBAR(); \
      if constexpr (PVPIPE && LEAN && ATTV == 0) { if constexpr (VPRE) pv_psm_lean_b<!LSUM, true>(o, vb0 + VOFF(VP), pa0, pa1, pa2, pa3, PC0, PC1, nm, ALC, &vpre_); else if constexpr (ATT_TRB) pv_psm_lean_b<!LSUM>(o, vb0 + VOFF(VP), pa0, pa1, pa2, pa3, PC0, PC1, nm, ALC); else pv_psm_lean<!LSUM>(o, vb0 + VOFF(VP), pa0, pa1, pa2, pa3, PC0, PC1, nm, ALC); } else { if constexpr (VPRE0 && ATT_VROLL) pv_d0_roll(o, vb0 + VOFF(VP), pa0, pa1, pa2, pa3, vh_); else if constexpr (VPRE0) pv_d0_pre(o, vb0 + VOFF(VP), pa0, pa1, pa2, pa3, vh_); else PV(vb0 + VOFF(VP)); PSM(PC0, PC1, MNC, ALC, false); } \
    } else { \
      SBAR(); FSM(PP0, PP1, ALP); SBAR(); \
      LD; SBAR(); \
      PV(vb0 + VOFF(VP)); SBAR(); \
      QKT(PC0, PC1, K_lds + KOFF(KC)); SBAR(); \
      PSM(PC0, PC1, MNC, ALC, false); \
    } } while (0)
  constexpr bool STAG = (MODE == 1) && ATT_STAGGER && ATTV == 0;
  constexpr bool VPRE = ATT_VPRE && PVPIPE && LEAN && LSUM && ATT_TRB && (ATTV == 0);
  constexpr bool VPRE0 = ATT_VPRE0 && (MODE == 0) && !PVPIPE && !LEAN && (ATTV == 0);
  int sv = 0, sk = 1, sn = 2;
  if constexpr (RING3) {
    for (int j = 1; j + 1 < NT; j += 2) {
      HALFSTEP(pB0, pB1, mnB, alB, pA0, pA1, alA, sk, sv, LSLOAD(SO, j + 1));
      LSWAIT(); LSWRITE(sn, SE); RESC(alB); LSYNC();
      { const int t_ = sv; sv = sk; sk = sn; sn = t_; }
      HALFSTEP(pA0, pA1, mnA, alA, pB0, pB1, alB, sk, sv, LSLOAD(SE, j + 2));
      LSWAIT(); LSWRITE(sn, SO); RESC(alA); LSYNC();
      { const int t_ = sv; sv = sk; sk = sn; sn = t_; }
    }
  } else
  for (int j = 1; j + 1 < NT; j += 2) {
    HALFSTEP(pB0, pB1, mnB, alB, pA0, pA1, alA, 1, 0, LSLOAD(SO, j + SDEPTH));
    LSYNC(); LSWAIT(); LSWRITE(0, SE);
    RESC(alB); LSYNC();
    HALFSTEP(pA0, pA1, mnA, alA, pB0, pB1, alB, 0, 1, if (SDEPTH == 1 || j + 3 < NT) LSLOAD(SE, j + 1 + SDEPTH));
    LSYNC(); LSWAIT(); LSWRITE(1, SO);
    RESC(alA); LSYNC();
  }
#undef HALFSTEP
#undef ILV
#undef LSLOAD
#undef LSWRITE
#undef LSWAIT
#undef LSYNC
  SBAR(); QKT(pB0, pB1, K_lds + KOFF(RING3 ? sk : 1));
  FSM(pA0, pA1, alA); SBAR();
  PV(vb0 + VOFF(RING3 ? sv : 0)); PSM(pB0, pB1, mnB, alB, false);
  __syncthreads(); RESC(alB);
  FSM(pB0, pB1, alB); SBAR();
  PV(vb0 + VOFF(RING3 ? sk : 1));
  } else {
#define STEP(PC0, PC1, ALC, PP0, PP1, ALP, jj, SP, SC, SN) do { const int j_ = (jj); \
      if (j_ + 1 < NT) { asm volatile("s_waitcnt vmcnt(0)" ::: "memory"); SWRITE(SN, 0); if (j_ + 2 < NT) SLOAD(0, j_ + 2); } \
      SBAR(); QKT(PC0, PC1, K_lds + KOFF(SC)); FSM(PP0, PP1, ALP); SBAR(); \
      PV(vb0 + VOFF(SP)); PSM(PC0, PC1, mnA, ALC, false); \
      RESC(ALC); __syncthreads(); } while (0)
    SLOAD(0, 0); asm volatile("s_waitcnt vmcnt(0)" ::: "memory"); SWRITE(0, 0);
    SLOAD(0, 1); asm volatile("s_waitcnt vmcnt(0)" ::: "memory"); SWRITE(1, 0);
    SLOAD(0, 2); __syncthreads();
    QKT(pA0, pA1, K_lds + KOFF(0)); PSM(pA0, pA1, mnA, alA, true);
    STEP(pB0, pB1, alB, pA0, pA1, alA, 1, 0, 1, 2);
    int j = 2;
    for (; j + 5 < NT; j += 6) {
      STEP(pA0, pA1, alA, pB0, pB1, alB, j, 1, 2, 0);
      STEP(pB0, pB1, alB, pA0, pA1, alA, j + 1, 2, 0, 1);
      STEP(pA0, pA1, alA, pB0, pB1, alB, j + 2, 0, 1, 2);
      STEP(pB0, pB1, alB, pA0, pA1, alA, j + 3, 1, 2, 0);
      STEP(pA0, pA1, alA, pB0, pB1, alB, j + 4, 2, 0, 1);
      STEP(pB0, pB1, alB, pA0, pA1, alA, j + 5, 0, 1, 2);
    }
    if (j < NT) { STEP(pA0, pA1, alA, pB0, pB1, alB, j, 1, 2, 0); STEP(pB0, pB1, alB, pA0, pA1, alA, j + 1, 2, 0, 1); j += 2; }
    if (j < NT) { STEP(pA0, pA1, alA, pB0, pB1, alB, j, 0, 1, 2); STEP(pB0, pB1, alB, pA0, pA1, alA, j + 1, 1, 2, 0); j += 2; }
    FSM(pB0, pB1, alB); SBAR();
    { const int sl = (NT - 1) % 3; PV(vb0 + VOFF(sl)); }
#undef STEP
  }
  float rli[16];
  if constexpr (LEAN && !LSUM) {
#pragma unroll
    for (int r = 0; r < 16; ++r) rli[r] = __builtin_amdgcn_rcpf(o[NOB - 1][r]);
  } else {
    if constexpr (LSUM) l_reg += __uint_as_float(lane_xor32(__float_as_uint(l_reg), lane));
    if (hi == 0) li_l[r32] = l_reg; asm volatile("s_waitcnt lgkmcnt(0)" ::: "memory");
#pragma unroll
    for (int r = 0; r < 16; ++r) rli[r] = __builtin_amdgcn_rcpf(li_l[crow(r, hi)]);
  }
  bf16* Ow = Ob + (size_t)(wq * 32) * DM;
  if constexpr (MODE == 0) {
#pragma unroll
    for (int r = 0; r < 16; ++r) { const int orow = crow(r, hi);
#pragma unroll
      for (int d0 = 0; d0 < 4; ++d0) Ow[(size_t)orow * DM + d0 * 32 + r32] = tobf1(o[d0][r] * rli[r]); }
    __syncthreads();
  } else {
    LAS float* ex = (LAS float*)lds;
    __syncthreads();
    if (sgrp == 1) {
#pragma unroll
      for (int r = 0; r < 16; ++r)
#pragma unroll
        for (int d0 = 0; d0 < 4; ++d0) ex[(wq * 32 + crow(r, hi)) * 128 + d0 * 32 + r32] = o[d0][r] * rli[r];
    }
    __syncthreads();
    if (sgrp == 0) {
#pragma unroll
      for (int r = 0; r < 16; ++r) { const int orow = crow(r, hi); float dd[4]; float ss = 0.f;
#pragma unroll
        for (int d0 = 0; d0 < 4; ++d0) { dd[d0] = o[d0][r] * rli[r] - lam * ex[(wq * 32 + orow) * 128 + d0 * 32 + r32]; ss += dd[d0] * dd[d0]; }
        ss = half_sum32(ss);
        const float rs = oscale / sqrtf(ss * (1.0f / 128.0f) + LN_EPS);
#pragma unroll
        for (int d0 = 0; d0 < 4; ++d0) Ow[(size_t)orow * DM + d0 * 32 + r32] = tobf1(dd[d0] * rs * subln[d0 * 32 + r32]); }
    }
    __syncthreads();
  }
  if (ATT_PRIO) __builtin_amdgcn_s_setprio(0);
#undef VOFF
#undef KOFF
#undef PV
#undef PSM
#undef FSM
#undef QKT
#undef KROW
#undef SLOAD
#undef SWRITE
#undef SWAIT
#undef RESC
}
}

template <int ATTV = 0> __device__ __forceinline__ void mla_attn_phase(CP P, LAS unsigned char* lds, const int tid) {
    const bf16* QM = (const bf16*)(P->ws + WS_QM); const bf16* KV = (const bf16*)(P->ws + WS_KV); const bf16* KR = (const bf16*)(P->ws + WS_KR); bf16* Gb = (bf16*)(P->ws + WS_G);
    const int c = blockIdx.x, G = gridDim.x;
    for (int u = c; u < 1024 + 32; u += G) {
        int b, h, qrow0, NT;
        if (u < 1024) { const int i = u >> 8, cc = u & 255; const int bh = (cc & 7) + 8 * i, qb = cc >> 3; b = bh >> 4; h = bh & 15; qrow0 = b * SEQ + qb * 256; NT = 4 + 128; }
        else { const int bh = u - 1024; b = bh >> 4; h = bh & 15; qrow0 = ML + b * CTXL; NT = 4; }
        att::attn_unit<0, ATTV>(QM + (size_t)qrow0 * 3072 + h * 192, 3072, KV + h * 256, KV + h * 256 + 128, 4096, KR, b, 4, NT, Gb + (size_t)qrow0 * DM + h * 128, 0.f, nullptr, 1.f, lds, tid);
    }
}
template <int ATTV = 0>
__device__ __forceinline__ void da_attn_phase(CP P, float lam, float oscale, LAS unsigned char* lds, const int tid, const bool ctx_q, const int nt_cap = 0) {
    const bf16* Z = (const bf16*)(P->ws + WS_Z); bf16* Gb = (bf16*)(P->ws + WS_G); const float* subln = P->in[27];
    const int c = blockIdx.x, G = gridDim.x;
    for (int u = c; u < 2048 + (ctx_q ? 64 : 0); u += G) {
        int b, h, qrow0, NT;
        if (u < 2048) { const int i = u >> 8, cc = u & 255; const int bh = (cc & 7) + 8 * (i >> 1), qb = (cc >> 3) + 32 * (i & 1); b = bh >> 4; h = bh & 15; qrow0 = b * SEQ + qb * 128; NT = 4 + 128; }
        else { const int v = u - 2048; const int bh = v >> 1; b = bh >> 4; h = bh & 15; qrow0 = ML + b * CTXL + (v & 1) * 128; NT = 4; }
        if (nt_cap) NT = nt_cap;
        att::attn_unit<1, ATTV>(Z + (size_t)qrow0 * 6144 + h * 128, 6144, Z + 2048 + h * 128, Z + 4096 + h * 128, 6144, nullptr, b, 4, NT, Gb + (size_t)qrow0 * DM + h * 128, lam, subln, oscale, lds, tid);
    }
}

__device__ __forceinline__ unsigned f2ord(float f) { const unsigned u = __float_as_uint(f); return u ^ ((unsigned)((int)u >> 31) | 0x80000000u); }
__device__ __forceinline__ float ord2f(unsigned k) { return __uint_as_float((k & 0x80000000u) ? (k ^ 0x80000000u) : ~k); }
__device__ __forceinline__ void ce_desc(unsigned& a, unsigned& b) { const unsigned mx = a > b ? a : b, mn = a > b ? b : a; a = mx; b = mn; }
template <int N, bool DESC> __device__ __forceinline__ void bitonic_merge(unsigned* a) {
#pragma unroll
    for (int j = N / 2; j > 0; j >>= 1)
#pragma unroll
        for (int i = 0; i < N; ++i) { const int l = i ^ j; if (l > i) { if (DESC) ce_desc(a[i], a[l]); else ce_desc(a[l], a[i]); } }
}
template <int N, bool DESC> __device__ __forceinline__ void bitonic_sort(unsigned* a) {
#pragma unroll
    for (int k = 2; k <= N; k <<= 1)
#pragma unroll
        for (int j = k >> 1; j > 0; j >>= 1)
#pragma unroll
            for (int i = 0; i < N; ++i) { const int l = i ^ j; if (l > i) { const bool up = ((i & k) == 0); if (up == DESC) ce_desc(a[i], a[l]); else ce_desc(a[l], a[i]); } }
}
__device__ __forceinline__ void top16_of_64(unsigned (&a)[64]) {
    bitonic_sort<16, true>(a); bitonic_sort<16, false>(a + 16); bitonic_sort<16, true>(a + 32); bitonic_sort<16, false>(a + 48);
#pragma unroll
    for (int i = 0; i < 16; ++i) a[i] = a[i] > a[16 + i] ? a[i] : a[16 + i];
    bitonic_merge<16, true>(a);
#pragma unroll
    for (int i = 0; i < 16; ++i) a[32 + i] = a[32 + i] > a[48 + i] ? a[32 + i] : a[48 + i];
    bitonic_merge<16, false>(a + 32);
#pragma unroll
    for (int i = 0; i < 16; ++i) a[i] = a[i] > a[32 + i] ? a[i] : a[32 + i];
    bitonic_merge<16, true>(a);
}
template <int PASS> __device__ __forceinline__ void route_qload(const bf16* QP, int tok, int head, int hi, bf16x8 (&qf)[8]) {
    const bf16* qp = QP + (size_t)tok * DM + head * 256 + PASS * 128 + hi * 8;
#pragma unroll
    for (int ks = 0; ks < 8; ++ks) qf[ks] = NT_ACT ? __builtin_nontemporal_load((const bf16x8*)(qp + ks * 16)) : *(const bf16x8*)(qp + ks * 16);
}
template <int PASS> __device__ __forceinline__ void route_pass(const bf16x8 (&qf)[8], const LAS char* lds, int tok, int head, int r32, int hi, unsigned (&top)[16]) {
    f32x16 acc[4] = {};
    const LAS char* Kl = lds + PASS * 32768;
#pragma unroll
    for (int kb = 0; kb < 4; ++kb)
#pragma unroll
        for (int ks = 0; ks < 8; ++ks) { const bf16x8 a = *(const LAS bf16x8*)(Kl + (kb * 32 + r32) * 256 + (((ks * 2 + hi) ^ (r32 & 15)) * 16));
            acc[kb] = __builtin_amdgcn_mfma_f32_32x32x16_bf16(a, qf[ks], acc[kb], 0, 0, 0); }
    unsigned key[64]; const unsigned base = 127u - 4u * (unsigned)hi;
#pragma unroll
    for (int kb = 0; kb < 4; ++kb)
#pragma unroll
        for (int r = 0; r < 16; ++r) key[kb * 16 + r] = (f2ord(acc[kb][r]) & ~127u) | (base - (unsigned)(kb * 32 + (r & 3) + 8 * (r >> 2)));
    top16_of_64(key);
    unsigned pr[16];
#pragma unroll
    for (int i = 0; i < 16; ++i) pr[i] = lane_xor32(key[15 - i], hi << 5);
#pragma unroll
    for (int i = 0; i < 16; ++i) key[i] = key[i] > pr[i] ? key[i] : pr[i];
    bitonic_merge<16, true>(key);
#pragma unroll
    for (int i = 0; i < 16; ++i) top[i] = key[i];
}
#ifndef ROUTE_SORT
#define ROUTE_SORT 1
#endif
#define DPP_U(v, ctrl) ((unsigned)__builtin_amdgcn_mov_dpp((int)(v), (ctrl), 0xF, 0xF, true))
template <int J> __device__ __forceinline__ unsigned lane_xor_u(unsigned v, int lane) {
    if (J == 1) return DPP_U(v, 0xB1);
    if (J == 2) return DPP_U(v, 0x4E);
    if (J == 4) { const unsigned t = DPP_U(v, 0x141); return DPP_U(t, 0x1B); }
    if (J == 8) { const unsigned t = DPP_U(v, 0x140); return DPP_U(t, 0x141); }
    if (J == 16) { const auto r = __builtin_amdgcn_permlane16_swap(v, v, false, false); return (lane & 16) ? r[0] : r[1]; }
    return lane_xor32(v, lane);
}
template <int K, int J> __device__ __forceinline__ void sort128_stage(unsigned& a0, unsigned& a1, int lane) {
    if constexpr (J == 64) { const unsigned mn = a0 < a1 ? a0 : a1, mx = a0 < a1 ? a1 : a0; a0 = mn; a1 = mx; }
    else { const unsigned p0 = lane_xor_u<J>(a0, lane), p1 = lane_xor_u<J>(a1, lane);
        const bool lower = (lane & J) == 0;
        const bool asc0 = (K >= 64) ? true : ((lane & K) == 0), asc1 = (K == 128) ? true : (K == 64 ? false : ((lane & K) == 0));
        const unsigned mn0 = a0 < p0 ? a0 : p0, mx0 = a0 < p0 ? p0 : a0, mn1 = a1 < p1 ? a1 : p1, mx1 = a1 < p1 ? p1 : a1;
        a0 = (lower == asc0) ? mn0 : mx0; a1 = (lower == asc1) ? mn1 : mx1; }
    if constexpr (J > 1) sort128_stage<K, J / 2>(a0, a1, lane);
    else if constexpr (K < 128) sort128_stage<K * 2, K>(a0, a1, lane);
}
__device__ __forceinline__ void sort128_asc(unsigned& a0, unsigned& a1, int lane) { sort128_stage<2, 1>(a0, a1, lane); }
__device__ __forceinline__ void route_phase(CP P, int L, int Mrows, LAS unsigned char* lds_, int tid, int lane, int wid, int gw, int NGW) {
    const bf16* QP = (const bf16*)(P->ws + WS_QP); unsigned* ROUTE = (unsigned*)(P->ws + WS_ROUTE);
    LAS char* lds = (LAS char*)(LAS unsigned char*)lds_;
    __syncthreads();
    {
        const bf16* K1 = (const bf16*)(P->ws + WS_PK1) + (size_t)L * 128 * 128; const bf16* K2 = (const bf16*)(P->ws + WS_PK2) + (size_t)L * 128 * 128;
        u32x4 kw[8];
#pragma unroll
        for (int t = 0; t < 8; ++t) { const int c16 = tid + t * NWAVES * 64; const int mat = c16 >> 11, row = (c16 >> 4) & 127, ch = c16 & 15; kw[t] = *(const u32x4*)((mat ? K2 : K1) + row * 128 + ch * 8); }
#pragma unroll
        for (int t = 0; t < 8; ++t) { const int c16 = tid + t * NWAVES * 64; const int mat = c16 >> 11, row = (c16 >> 4) & 127, ch = c16 & 15; *(LAS u32x4*)(lds + mat * 32768 + row * 256 + ((ch ^ (row & 15)) * 16)) = kw[t]; }
    }
    __syncthreads();
    LAS unsigned* sc = (LAS unsigned*)(lds + 65536) + wid * 2048;
    const int r32 = lane & 31, hi = lane >> 5;
    for (int item = gw; item < Mrows / 4; item += NGW) {
        const int tok = item * 4 + (r32 >> 3), head = r32 & 7;
        unsigned top0[16], top1[16];
        { bf16x8 q0[8], q1[8]; route_qload<0>(QP, tok, head, hi, q0); route_qload<1>(QP, tok, head, hi, q1);
          route_pass<0>(q0, lds, tok, head, r32, hi, top0);
          route_pass<1>(q1, lds, tok, head, r32, hi, top1); }
        float v1[16], v2[16];
#pragma unroll
        for (int i = 0; i < 16; ++i) { v1[i] = ord2f(top0[i] & ~127u); v2[i] = ord2f(top1[i] & ~127u);
            sc[i * 64 + lane] = 127u - (top0[i] & 127u); sc[(16 + i) * 64 + lane] = 127u - (top1[i] & 127u); }
        unsigned ck[64]; int n = 0;
#pragma unroll
        for (int i = 0; i < 16; ++i)
#pragma unroll
            for (int j = 0; j < 16; ++j) if ((i + 1) * (j + 1) <= 16) { ck[n] = (f2ord(v1[i] + v2[j]) & ~255u) | (unsigned)(i * 16 + j); ++n; }
#pragma unroll
        for (int i = 50; i < 64; ++i) ck[i] = 0u;
        top16_of_64(ck);
        float ev[16]; float sum = 0.f; const float mx = ord2f(ck[0] & ~255u);
#pragma unroll
        for (int k = 0; k < 16; ++k) { ev[k] = __expf(ord2f(ck[k] & ~255u) - mx); sum += ev[k]; }
        const float inv = 1.0f / sum;
        unsigned ee[16];
#pragma unroll
        for (int k = 0; k < 16; ++k) { const unsigned pc = ck[k] & 255u; const unsigned i1 = sc[(pc >> 4) * 64 + lane], i2 = sc[(16 + (pc & 15u)) * 64 + lane]; ee[k] = i1 * 128u + i2; ev[k] *= inv; }
#if ROUTE_SORT
        { const int tq = r32 >> 3;
#pragma unroll
          for (int k = 0; k < 8; ++k) {
              const unsigned eL = ee[k], eH = ee[k + 8]; const float gL = ev[k], gH = ev[k + 8];
              sc[tq * 256 + head * 16 + hi * 8 + k] = hi ? eH : eL; sc[tq * 256 + 128 + head * 16 + hi * 8 + k] = __float_as_uint(hi ? gH : gL); }
#pragma unroll 1
          for (int t = 0; t < 4; ++t) {
              unsigned a0 = (sc[t * 256 + lane] << 7) | (unsigned)lane, a1 = (sc[t * 256 + 64 + lane] << 7) | (unsigned)(64 + lane);
              sort128_asc(a0, a1, lane);
              const unsigned g0 = sc[t * 256 + 128 + (a0 & 127u)], g1 = sc[t * 256 + 128 + (a1 & 127u)];
              u32x2* outp = (u32x2*)(ROUTE + (size_t)(item * 4 + t) * 256);
              outp[lane] = (u32x2){a0 >> 7, g0}; outp[64 + lane] = (u32x2){a1 >> 7, g1}; }
        }
#else
        u32x4* outp = (u32x4*)(ROUTE + ((size_t)tok * 128 + head * 16 + hi * 8) * 2);
#pragma unroll
        for (int k = 0; k < 8; k += 2) { u32x4 w;
            const unsigned eL0 = ee[k], eH0 = ee[k + 8], eL1 = ee[k + 1], eH1 = ee[k + 9]; const float gL0 = ev[k], gH0 = ev[k + 8], gL1 = ev[k + 1], gH1 = ev[k + 9];
            w.x = hi ? eH0 : eL0; w.y = __float_as_uint(hi ? gH0 : gL0); w.z = hi ? eH1 : eL1; w.w = __float_as_uint(hi ? gH1 : gL1);
            outp[k >> 1] = w; }
#endif
    }
}

typedef float f32x2 __attribute__((ext_vector_type(2)));
typedef float f32x32 __attribute__((ext_vector_type(32)));
typedef unsigned u32x6 __attribute__((ext_vector_type(6)));
typedef __bf16 bf16x32 __attribute__((ext_vector_type(32)));
typedef unsigned u32x16 __attribute__((ext_vector_type(16)));
typedef __bf16 bf16x2_t __attribute__((ext_vector_type(2)));
#ifndef GATHER_ZIGZAG
#define GATHER_ZIGZAG 0
#endif
#ifndef GATHER_PRE
#define GATHER_PRE 0
#endif
#ifndef GATHER_XEARLY
#define GATHER_XEARLY 1
#endif
#ifndef GATHER_SWP
#define GATHER_SWP 0
#endif
#ifndef GATHER_VECREG
#define GATHER_VECREG 1
#endif
#ifndef GATHER_MFMADOT
#define GATHER_MFMADOT 1
#endif
typedef short s16x4_t __attribute__((ext_vector_type(4)));
#ifndef GATHER_PAIRRED
#define GATHER_PAIRRED 1
#endif
#ifndef GATHER_EARLY
#define GATHER_EARLY 1
#endif
#ifndef GATHER_PACE
#define GATHER_PACE 0
#endif
#define XB_PACE(j) (XCD_BAR_WORDS + 64 * (j))
#ifndef GATHER_DEEP
#define GATHER_DEEP 0
#endif
constexpr int GS = GATHER_DEEP ? 8 : 6, GSLOT = GATHER_DEEP ? 2048 : 2 * PROW;
__device__ __forceinline__ void glds16(const void* gsrc, unsigned lds_dst) { unsigned keep;
  asm volatile("s_mov_b32 %0, m0\n\ts_mov_b32 m0, %2\n\ts_nop 0\n\tglobal_load_lds_dwordx4 %1, off\n\ts_mov_b32 m0, %0" : "=&s"(keep) : "v"(gsrc), "s"(lds_dst) : "memory"); }
template <int GMODE = 0>
__device__ __forceinline__ void gather_phase(CP P, int L, int Mrows, LAS unsigned char* lds, int wid, int lane_, int gw, int NGW, bool dry = false) {
    const unsigned char* UV = P->ws + WS_PU + (size_t)L * 16384 * PREC;
    const unsigned* ROUTE = (const unsigned*)(P->ws + WS_ROUTE); const float* MOD = (const float*)(P->ws + WS_MOD);
    bf16* X = (bf16*)(P->ws + WS_X); bf16* H = (bf16*)(P->ws + WS_H); bf16* Xo = dry ? (bf16*)(P->ws + WS_Y) : X; bf16* Ho = dry ? (bf16*)(P->ws + WS_G) : H;
    const float* lng = P->in[6] + (size_t)(L * 2 + 1) * DM; const float* lnb = P->in[7] + (size_t)(L * 2 + 1) * DM;
    const unsigned ring = (unsigned)(uintptr_t)lds + (unsigned)wid * (GS * GSLOT);
    const int nfull = (Mrows / NGW) * NGW, rem = Mrows - nfull; const bool can_coop = (rem * 4 == NGW);
    const int nround = nfull / NGW + (rem > 0 ? 1 : 0);
    const bool pace_ok = (rem == 0) || can_coop;
#define G_ROWOF(it_) ((can_coop && (it_) == nround - 1) ? (nfull + (int)blockIdx.x * 2 + (wid >> 2)) : (gw + (it_) * NGW))
    u32x2 nea = {0u, 0u}, neb = {0u, 0u}; u32x4 nh0 = {0u, 0u, 0u, 0u}, nh1 = nh0, nh2 = nh0, nh3 = nh0;
#define G_NTL(p_) (NT_STREAM > 1 ? __builtin_nontemporal_load(p_) : *(p_))
#define G_PREFETCH(rowN_, ln_) do { const int rn_ = (rowN_); nea = G_NTL(&((const u32x2*)(ROUTE + (size_t)rn_ * 256))[ln_]); neb = G_NTL(&((const u32x2*)(ROUTE + (size_t)rn_ * 256))[64 + (ln_)]); \
        const u32x4* hp_ = (const u32x4*)(H + (size_t)rn_ * DM) + 4 * (ln_); nh0 = G_NTL(hp_); nh1 = G_NTL(hp_ + 1); nh2 = G_NTL(hp_ + 2); nh3 = G_NTL(hp_ + 3); } while (0)
    if (nround > 0 && G_ROWOF(0) < Mrows) G_PREFETCH(G_ROWOF(0), launder_v(lane_));
#if GATHER_VECREG
    LAS unsigned* LNV = (LAS unsigned*)(lds + NWAVES * GS * GSLOT);
    { f32x2 t_[4];
#pragma unroll
      for (int t = 0; t < 4; ++t) { const int i = wid * 64 + lane_ + t * NWAVES * 64; t_[t] = *(const f32x2*)(((i >> 10) ? lnb : lng) + 2 * (i & 1023)); }
#pragma unroll
      for (int t = 0; t < 4; ++t) { const float x0_ = t_[t][0], x1_ = t_[t][1]; LNV[wid * 64 + lane_ + t * NWAVES * 64] = cvtpk(x0_, x1_); } }
    __syncthreads();
    unsigned mg[16], ms[16], mc[16]; int cur_slot = -1;
#pragma unroll
    for (int i = 0; i < 16; ++i) { mg[i] = 0u; ms[i] = 0u; mc[i] = 0u; }
#endif
    bool pre = false;
#pragma unroll 1
    for (int it = 0; it < nround; ++it) {
#if GATHER_PACE
        if (pace_ok && it > 0) {
            if (wid == 0 && lane_ == 0) { const unsigned nloc = ((volatile LAS unsigned*)(lds + MISC_OFF))[8];
                if (nloc != 0u) { unsigned* pc = (unsigned*)(P->ws + WS_CTL) + CW_BAR + XB_PACE(xb_xcc_id());
                    const unsigned old = xb_add(pc, 1u), tgt = (old / nloc + 1u) * nloc; unsigned sp = 0u;
                    while ((int)(xb_ld(pc) - tgt) < 0 && ++sp < 20000u) __builtin_amdgcn_s_sleep(1); } }
            __syncthreads();
        }
#endif
        const bool coop = can_coop && (it == nround - 1);
        int row = G_ROWOF(it), k0 = 0, kn = 128;
        if (coop) { k0 = (wid & 3) * 32; kn = k0 + 32; }
        else if (row >= Mrows) break;
        const int lane = launder_v(lane_);
        const u32x2 ea = nea, eb = neb;
        unsigned eax, eay, ebx, eby;
        unsigned hw[16] = {nh0.x, nh0.y, nh0.z, nh0.w, nh1.x, nh1.y, nh1.z, nh1.w, nh2.x, nh2.y, nh2.z, nh2.w, nh3.x, nh3.y, nh3.z, nh3.w};
        float y[32];
#pragma unroll
        for (int i = 0; i < 32; ++i) y[i] = 0.f;
        { unsigned e0 = ea.x, e1 = ea.y, e2 = eb.x, e3 = eb.y;
          asm volatile("" : "+v"(e0), "+v"(e1), "+v"(e2), "+v"(e3), "+v"(hw[0]), "+v"(hw[1]), "+v"(hw[2]), "+v"(hw[3]), "+v"(hw[4]), "+v"(hw[5]), "+v"(hw[6]), "+v"(hw[7]),
                       "+v"(hw[8]), "+v"(hw[9]), "+v"(hw[10]), "+v"(hw[11]), "+v"(hw[12]), "+v"(hw[13]), "+v"(hw[14]), "+v"(hw[15]) :: "memory");
          eax = e0; eay = e1; ebx = e2; eby = e3; }
        const unsigned rd_a = ring + 16u * (unsigned)lane, rd_b = ring + 2048u + 8u * (unsigned)lane;
        const bool rev = GATHER_ZIGZAG && ((it & 1) != 0);
        const int kflip = rev ? (k0 + kn - 1) : 0, ksign = rev ? -1 : 1;
#define G_ISSUE(k) do { const int k_ = (k), ke_ = kflip + ksign * k_; const unsigned e_ = (unsigned)__builtin_amdgcn_readlane((int)(ke_ < 64 ? eax : ebx), ke_ & 63); \
        const unsigned char* rp_ = UV + (size_t)e_ * PREC + 16 * lane; const unsigned sb_ = ring + (unsigned)(k_ % GS) * GSLOT; \
        if (GMODE == 3) { glds16(rp_, sb_); if (lane < 32) glds16(rp_ + 2048, sb_ + 2048); } \
        else if (GMODE != 2) { glds16(rp_, sb_); glds16(rp_ + 1024, sb_ + 1024); if (PEER_U4) {} else if (PEER_V4) { if (lane < 32) glds16(rp_ + 2048, sb_ + 2048); } else glds16(rp_ + 2048, sb_ + 2048); } else { asm volatile("" :: "v"(rp_), "s"(sb_)); } } while (0)
#if GATHER_EARLY
        if (it + 1 < nround && G_ROWOF(it + 1) < Mrows) G_PREFETCH(G_ROWOF(it + 1), lane);
        if (!pre) {
#pragma unroll
            for (int k = 0; k < GS; ++k) G_ISSUE(k0 + k); }
#else
#pragma unroll
        for (int k = 0; k < 4; ++k) G_ISSUE(k0 + k);
        if (it + 1 < nround && G_ROWOF(it + 1) < Mrows) G_PREFETCH(G_ROWOF(it + 1), lane);
#endif
#define G_READ(k, ua, ub, va, vb) do { const unsigned so_ = (unsigned)((k) % GS) * GSLOT; \
        if (PEER_U4) asm volatile("ds_read_b128 %0, %2\n\tds_read_b128 %1, %2 offset:1024" : "=&v"(ua), "=&v"(va) : "v"(rd_a + so_) : "memory"); \
        else if (PEER_V4) asm volatile("ds_read_b128 %0, %3\n\tds_read_b64 %1, %4\n\tds_read_b128 %2, %3 offset:1024" \
                     : "=&v"(ua), "=&v"(ub), "=&v"(va) : "v"(rd_a + so_), "v"(rd_b + so_) : "memory"); \
        else asm volatile("ds_read_b128 %0, %4\n\tds_read_b64 %1, %5\n\tds_read_b128 %2, %4 offset:1024\n\tds_read_b64 %3, %5 offset:512" \
                     : "=&v"(ua), "=&v"(ub), "=&v"(va), "=&v"(vb) : "v"(rd_a + so_), "v"(rd_b + so_) : "memory"); } while (0)
#if GATHER_XEARLY
        u32x4 xr0 = {0u, 0u, 0u, 0u}, xr1 = xr0, xr2 = xr0, xr3 = xr0;
#endif
#if GATHER_SWP
        static_assert(!GATHER_SWP || (PEER_U4 && PEER_V4 && GATHER_EARLY && GATHER_PAIRRED && GATHER_MFMADOT && !GATHER_DEEP && !GATHER_XEARLY && !GATHER_PRE), "GATHER_SWP: configuration");
#define SWP_FETCH(kk, uA, uB, vA, vB) do { const int kk_ = (kk); \
            if (kk_ + 4 < kn) asm volatile("s_waitcnt vmcnt(8)" ::: "memory"); else if (kk_ == kn - 4) asm volatile("s_waitcnt vmcnt(4)" ::: "memory"); else asm volatile("s_waitcnt vmcnt(0)" ::: "memory"); \
            u32x2 d0_ = {0u, 0u}, d1_ = {0u, 0u}; G_READ(kk_, uA, d0_, vA, d1_); G_READ(kk_ + 1, uB, d0_, vB, d1_); \
            asm volatile("s_waitcnt lgkmcnt(0)" : "+v"(uA), "+v"(vA), "+v"(uB), "+v"(vB) :: "memory"); \
            if (kk_ + GS < kn) { G_ISSUE(kk_ + GS); G_ISSUE(kk_ + GS + 1); } } while (0)
#define SWP_U4(dst_, src_, w_, b_) dst_[4 * (w_) + (b_)] = __builtin_bit_cast(unsigned, __builtin_amdgcn_cvt_scalef32_pk_bf16_fp4(src_[w_], 1.0f, b_))
#define SWP_UPART(kk, uA, uB, wA_, wB_) do { const int kk_ = (kk); u32x16 ubfA, ubfB; const unsigned uwA[4] = {uA.x, uA.y, uA.z, uA.w}, uwB[4] = {uB.x, uB.y, uB.z, uB.w}; \
            _Pragma("unroll") for (int w = 0; w < 4; ++w) { SWP_U4(ubfA, uwA, w, 0); SWP_U4(ubfA, uwA, w, 1); SWP_U4(ubfA, uwA, w, 2); SWP_U4(ubfA, uwA, w, 3); SWP_U4(ubfB, uwB, w, 0); SWP_U4(ubfB, uwB, w, 1); SWP_U4(ubfB, uwB, w, 2); SWP_U4(ubfB, uwB, w, 3); } \
            f32x4 dgA = {0.f, 0.f, 0.f, 0.f}, dgB = {0.f, 0.f, 0.f, 0.f}; \
            _Pragma("unroll") for (int q = 0; q < 16; q += 2) { const u32x2 hq_ = {hw[q], hw[q + 1]}, xa_ = {ubfA[q], ubfA[q + 1]}, xb_ = {ubfB[q], ubfB[q + 1]}; \
                dgA = __builtin_amdgcn_mfma_f32_4x4x4bf16_1k(__builtin_bit_cast(s16x4_t, xa_), __builtin_bit_cast(s16x4_t, hq_), dgA, 0, 0, 0); \
                dgB = __builtin_amdgcn_mfma_f32_4x4x4bf16_1k(__builtin_bit_cast(s16x4_t, xb_), __builtin_bit_cast(s16x4_t, hq_), dgB, 0, 0, 0); } \
            const float x0 = dgA[0], x1 = dgA[1], x2 = dgA[2], x3 = dgA[3], y0 = dgB[0], y1 = dgB[1], y2 = dgB[2], y3 = dgB[3]; \
            float a0 = DPP_F(x0, 0x00); a0 += DPP_F(x1, 0x55); a0 += DPP_F(x2, 0xAA); a0 += DPP_F(x3, 0xFF); \
            float b0 = DPP_F(y0, 0x00); b0 += DPP_F(y1, 0x55); b0 += DPP_F(y2, 0xAA); b0 += DPP_F(y3, 0xFF); \
            const auto sw = __builtin_amdgcn_permlane32_swap(__float_as_uint(a0), __float_as_uint(b0), false, false); \
            float c2 = __uint_as_float(sw[0]) + __uint_as_float(sw[1]); c2 += DPP_F(c2, 0x141); c2 += DPP_F(c2, 0x140); \
            const float d2 = sum_xor16(c2) * (1.0f / U_SCALE); const float g2 = gelu_tanh(d2) * (1.0f / V_SCALE); \
            const float gA = __uint_as_float((unsigned)__builtin_amdgcn_readlane((int)__float_as_uint(g2), 0)), gB = __uint_as_float((unsigned)__builtin_amdgcn_readlane((int)__float_as_uint(g2), 32)); \
            const int keA = kflip + ksign * kk_, keB = keA + ksign; const unsigned gsel = keA < 64 ? eay : eby; \
            wA_ = __uint_as_float((unsigned)__builtin_amdgcn_readlane((int)gsel, keA & 63)) * gA; wB_ = __uint_as_float((unsigned)__builtin_amdgcn_readlane((int)gsel, keB & 63)) * gB; } while (0)
#define SWP_V4(vwA, vwB, w_, b_, wA_, wB_) do { const f32x2 pA = __builtin_amdgcn_cvt_scalef32_pk_f32_fp4(vwA[w_], 1.0f, b_), pB = __builtin_amdgcn_cvt_scalef32_pk_f32_fp4(vwB[w_], 1.0f, b_); const int j = 4 * (w_) + (b_); \
            const float pa0 = pA[0], pa1 = pA[1], pb0 = pB[0], pb1 = pB[1]; y[2 * j] += wA_ * pa0; y[2 * j + 1] += wA_ * pa1; y[2 * j] += wB_ * pb0; y[2 * j + 1] += wB_ * pb1; } while (0)
#define SWP_VPART(vA, vB, wA_, wB_) do { const unsigned vwA[4] = {vA.x, vA.y, vA.z, vA.w}, vwB[4] = {vB.x, vB.y, vB.z, vB.w}; \
            _Pragma("unroll") for (int w = 0; w < 4; ++w) { SWP_V4(vwA, vwB, w, 0, wA_, wB_); SWP_V4(vwA, vwB, w, 1, wA_, wB_); SWP_V4(vwA, vwB, w, 2, wA_, wB_); SWP_V4(vwA, vwB, w, 3, wA_, wB_); } } while (0)
#define SWP_VCH(w_, qA_, qB_) do { SWP_V4(vwA, vwB, w_, 0, qA_, qB_); SWP_V4(vwA, vwB, w_, 1, qA_, qB_); SWP_V4(vwA, vwB, w_, 2, qA_, qB_); SWP_V4(vwA, vwB, w_, 3, qA_, qB_); } while (0)
#define SWP_MIX(kk, uA, uB, wA_, wB_, pvA, pvB, pwA_, pwB_) do { const int kk_ = (kk); u32x16 ubfA, ubfB; const unsigned uwA[4] = {uA.x, uA.y, uA.z, uA.w}, uwB[4] = {uB.x, uB.y, uB.z, uB.w}; \
            const unsigned vwA[4] = {pvA.x, pvA.y, pvA.z, pvA.w}, vwB[4] = {pvB.x, pvB.y, pvB.z, pvB.w}; \
            _Pragma("unroll") for (int w = 0; w < 4; ++w) { SWP_U4(ubfA, uwA, w, 0); SWP_U4(ubfA, uwA, w, 1); SWP_U4(ubfA, uwA, w, 2); SWP_U4(ubfA, uwA, w, 3); SWP_U4(ubfB, uwB, w, 0); SWP_U4(ubfB, uwB, w, 1); SWP_U4(ubfB, uwB, w, 2); SWP_U4(ubfB, uwB, w, 3); } \
            f32x4 dgA = {0.f, 0.f, 0.f, 0.f}, dgB = {0.f, 0.f, 0.f, 0.f}; \
            _Pragma("unroll") for (int q = 0; q < 16; q += 2) { const u32x2 hq_ = {hw[q], hw[q + 1]}, xa_ = {ubfA[q], ubfA[q + 1]}, xb_ = {ubfB[q], ubfB[q + 1]}; \
                dgA = __builtin_amdgcn_mfma_f32_4x4x4bf16_1k(__builtin_bit_cast(s16x4_t, xa_), __builtin_bit_cast(s16x4_t, hq_), dgA, 0, 0, 0); \
                dgB = __builtin_amdgcn_mfma_f32_4x4x4bf16_1k(__builtin_bit_cast(s16x4_t, xb_), __builtin_bit_cast(s16x4_t, hq_), dgB, 0, 0, 0); } \
            SWP_VCH(0, pwA_, pwB_); \
            const float x0 = dgA[0], x1 = dgA[1], x2 = dgA[2], x3 = dgA[3], y0 = dgB[0], y1 = dgB[1], y2 = dgB[2], y3 = dgB[3]; \
            float a0 = DPP_F(x0, 0x00); a0 += DPP_F(x1, 0x55); a0 += DPP_F(x2, 0xAA); a0 += DPP_F(x3, 0xFF); \
            float b0 = DPP_F(y0, 0x00); b0 += DPP_F(y1, 0x55); b0 += DPP_F(y2, 0xAA); b0 += DPP_F(y3, 0xFF); \
            SWP_VCH(1, pwA_, pwB_); \
            const auto sw = __builtin_amdgcn_permlane32_swap(__float_as_uint(a0), __float_as_uint(b0), false, false); \
            float c2 = __uint_as_float(sw[0]) + __uint_as_float(sw[1]); c2 += DPP_F(c2, 0x141); c2 += DPP_F(c2, 0x140); \
            float d2 = sum_xor16(c2) * (1.0f / U_SCALE); \
            SWP_VCH(2, pwA_, pwB_); \
            float g2 = gelu_tanh(d2) * (1.0f / V_SCALE); \
            SWP_VCH(3, pwA_, pwB_); \
            const float gA = __uint_as_float((unsigned)__builtin_amdgcn_readlane((int)__float_as_uint(g2), 0)), gB = __uint_as_float((unsigned)__builtin_amdgcn_readlane((int)__float_as_uint(g2), 32)); \
            const int keA = kflip + ksign * kk_, keB = keA + ksign; const unsigned gsel = keA < 64 ? eay : eby; \
            wA_ = __uint_as_float((unsigned)__builtin_amdgcn_readlane((int)gsel, keA & 63)) * gA; wB_ = __uint_as_float((unsigned)__builtin_amdgcn_readlane((int)gsel, keB & 63)) * gB; } while (0)
        if (GMODE == 0) {
            u32x4 cuA, cuB, cvA, cvB; float cwA, cwB;
            SWP_FETCH(k0, cuA, cuB, cvA, cvB); SWP_UPART(k0, cuA, cuB, cwA, cwB);
#pragma unroll 1
            for (int k = k0; k + 2 < kn; k += 2) {
                u32x4 nuA, nuB, nvA, nvB; float nwA, nwB;
                SWP_FETCH(k + 2, nuA, nuB, nvA, nvB);
                SWP_MIX(k + 2, nuA, nuB, nwA, nwB, cvA, cvB, cwA, cwB);
                cvA = nvA; cvB = nvB; cwA = nwA; cwB = nwB;
            }
            SWP_VPART(cvA, cvB, cwA, cwB);
        } else
#undef SWP_MIX
#undef SWP_VCH
#undef SWP_FETCH
#undef SWP_U4
#undef SWP_UPART
#undef SWP_V4
#undef SWP_VPART
#endif
#pragma unroll 1
        for (int k = k0; k < kn; k += 2) {
            if (GATHER_DEEP && k + 6 < kn) asm volatile("s_waitcnt vmcnt(12)" ::: "memory");
            else if (GATHER_DEEP && k == kn - 6) asm volatile("s_waitcnt vmcnt(8)" ::: "memory");
            else if (k + 4 < kn) { if (!GATHER_EARLY) { G_ISSUE(k + 4); G_ISSUE(k + 5); } if (GMODE == 3 || PEER_U4) asm volatile("s_waitcnt vmcnt(8)" ::: "memory"); else asm volatile("s_waitcnt vmcnt(12)" ::: "memory"); }
            else if (k == kn - 4) { if (GMODE == 3 || PEER_U4) asm volatile("s_waitcnt vmcnt(4)" ::: "memory"); else asm volatile("s_waitcnt vmcnt(6)" ::: "memory"); }
            else asm volatile("s_waitcnt vmcnt(0)" ::: "memory");
            u32x4 uaA, vaA, uaB, vaB; u32x2 ubA = {0u, 0u}, vbA = {0u, 0u}, ubB = {0u, 0u}, vbB = {0u, 0u};
            G_READ(k, uaA, ubA, vaA, vbA); G_READ(k + 1, uaB, ubB, vaB, vbB);
            asm volatile("s_waitcnt lgkmcnt(0)" : "+v"(uaA), "+v"(ubA), "+v"(vaA), "+v"(vbA), "+v"(uaB), "+v"(ubB), "+v"(vaB), "+v"(vbB) :: "memory");
#if GATHER_XEARLY
            if (k == kn - 4) { const u32x4* xp_ = (const u32x4*)(X + (size_t)row * DM) + 4 * lane; xr0 = xp_[0]; xr1 = xp_[1]; xr2 = xp_[2]; xr3 = xp_[3]; }
#endif
            if (GATHER_EARLY && k + GS < kn) { G_ISSUE(k + GS); G_ISSUE(k + GS + 1); }
            if (GMODE == 1 || GMODE == 3) continue;
#if PEER_U4
            u32x16 ubfA, ubfB;
            { const unsigned uwA[4] = {uaA.x, uaA.y, uaA.z, uaA.w}, uwB[4] = {uaB.x, uaB.y, uaB.z, uaB.w};
#pragma unroll
              for (int w = 0; w < 4; ++w) {
#define U4_CVT(b_) do { ubfA[4 * w + (b_)] = __builtin_bit_cast(unsigned, __builtin_amdgcn_cvt_scalef32_pk_bf16_fp4(uwA[w], 1.0f, b_)); ubfB[4 * w + (b_)] = __builtin_bit_cast(unsigned, __builtin_amdgcn_cvt_scalef32_pk_bf16_fp4(uwB[w], 1.0f, b_)); } while (0)
                  U4_CVT(0); U4_CVT(1); U4_CVT(2); U4_CVT(3);
#undef U4_CVT
              } }
#else
            const u32x6 u6A = {uaA.x, uaA.y, uaA.z, uaA.w, ubA.x, ubA.y}, u6B = {uaB.x, uaB.y, uaB.z, uaB.w, ubB.x, ubB.y};
            const u32x16 ubfA = __builtin_bit_cast(u32x16, __builtin_amdgcn_cvt_scalef32_pk32_bf16_fp6(u6A, 1.0f));
            const u32x16 ubfB = __builtin_bit_cast(u32x16, __builtin_amdgcn_cvt_scalef32_pk32_bf16_fp6(u6B, 1.0f));
#endif
#if GATHER_MFMADOT
            f32x4 dgA = {0.f, 0.f, 0.f, 0.f}, dgB = {0.f, 0.f, 0.f, 0.f};
#pragma unroll
            for (int q = 0; q < 16; q += 2) { const u32x2 hq_ = {hw[q], hw[q + 1]}, xa_ = {ubfA[q], ubfA[q + 1]}, xb_ = {ubfB[q], ubfB[q + 1]};
                dgA = __builtin_amdgcn_mfma_f32_4x4x4bf16_1k(__builtin_bit_cast(s16x4_t, xa_), __builtin_bit_cast(s16x4_t, hq_), dgA, 0, 0, 0);
                dgB = __builtin_amdgcn_mfma_f32_4x4x4bf16_1k(__builtin_bit_cast(s16x4_t, xb_), __builtin_bit_cast(s16x4_t, hq_), dgB, 0, 0, 0); }
            float a0, a1 = 0.f, b0, b1 = 0.f;
            { const float x0 = dgA[0], x1 = dgA[1], x2 = dgA[2], x3 = dgA[3], y0 = dgB[0], y1 = dgB[1], y2 = dgB[2], y3 = dgB[3];
              a0 = DPP_F(x0, 0x00); a0 += DPP_F(x1, 0x55); a0 += DPP_F(x2, 0xAA); a0 += DPP_F(x3, 0xFF);
              b0 = DPP_F(y0, 0x00); b0 += DPP_F(y1, 0x55); b0 += DPP_F(y2, 0xAA); b0 += DPP_F(y3, 0xFF); }
#else
            float a0 = 0.f, a1 = 0.f, b0 = 0.f, b1 = 0.f;
#pragma unroll
            for (int q = 0; q < 16; q += 2) { const unsigned h0_ = hw[q], h1_ = hw[q + 1], x0_ = ubfA[q], x1_ = ubfA[q + 1], z0_ = ubfB[q], z1_ = ubfB[q + 1];
                a0 = __builtin_amdgcn_fdot2_f32_bf16(__builtin_bit_cast(bf16x2_t, h0_), __builtin_bit_cast(bf16x2_t, x0_), a0, false);
                a1 = __builtin_amdgcn_fdot2_f32_bf16(__builtin_bit_cast(bf16x2_t, h1_), __builtin_bit_cast(bf16x2_t, x1_), a1, false);
                b0 = __builtin_amdgcn_fdot2_f32_bf16(__builtin_bit_cast(bf16x2_t, h0_), __builtin_bit_cast(bf16x2_t, z0_), b0, false);
                b1 = __builtin_amdgcn_fdot2_f32_bf16(__builtin_bit_cast(bf16x2_t, h1_), __builtin_bit_cast(bf16x2_t, z1_), b1, false); }
#endif
            const int keA = kflip + ksign * k, keB = keA + ksign;
            const unsigned gsel = keA < 64 ? eay : eby;
#if GATHER_PAIRRED
            float wA, wB;
            { const auto sw = __builtin_amdgcn_permlane32_swap(__float_as_uint(GATHER_MFMADOT ? a0 : a0 + a1), __float_as_uint(GATHER_MFMADOT ? b0 : b0 + b1), false, false);
#if GATHER_MFMADOT
              float c2 = __uint_as_float(sw[0]) + __uint_as_float(sw[1]); c2 += DPP_F(c2, 0x141); c2 += DPP_F(c2, 0x140);
              const float d2 = sum_xor16(c2) * (1.0f / U_SCALE);
#else
              const float d2 = half_sum32(__uint_as_float(sw[0]) + __uint_as_float(sw[1])) * (1.0f / U_SCALE);
#endif
              const float g2 = gelu_tanh(d2) * (1.0f / V_SCALE);
              const float gA = __uint_as_float((unsigned)__builtin_amdgcn_readlane((int)__float_as_uint(g2), 0)), gB = __uint_as_float((unsigned)__builtin_amdgcn_readlane((int)__float_as_uint(g2), 32));
              wA = __uint_as_float((unsigned)__builtin_amdgcn_readlane((int)gsel, keA & 63)) * gA; wB = __uint_as_float((unsigned)__builtin_amdgcn_readlane((int)gsel, keB & 63)) * gB; }
#else
            const float dA = wave_sum(a0 + a1) * (1.0f / U_SCALE), dB = wave_sum(b0 + b1) * (1.0f / U_SCALE);
            const float wA = __uint_as_float((unsigned)__builtin_amdgcn_readlane((int)gsel, keA & 63)) * gelu_tanh(dA) * (1.0f / V_SCALE);
            const float wB = __uint_as_float((unsigned)__builtin_amdgcn_readlane((int)gsel, keB & 63)) * gelu_tanh(dB) * (1.0f / V_SCALE);
#endif
#if PEER_V4
            { const unsigned vwA[4] = {vaA.x, vaA.y, vaA.z, vaA.w}, vwB[4] = {vaB.x, vaB.y, vaB.z, vaB.w};
#pragma unroll
              for (int w = 0; w < 4; ++w) {
#define V4_ACC(b_) do { const f32x2 pA = __builtin_amdgcn_cvt_scalef32_pk_f32_fp4(vwA[w], 1.0f, b_), pB = __builtin_amdgcn_cvt_scalef32_pk_f32_fp4(vwB[w], 1.0f, b_); const int j = 4 * w + (b_); \
                    const float pa0 = pA[0], pa1 = pA[1], pb0 = pB[0], pb1 = pB[1]; y[2 * j] += wA * pa0; y[2 * j + 1] += wA * pa1; y[2 * j] += wB * pb0; y[2 * j + 1] += wB * pb1; } while (0)
                  V4_ACC(0); V4_ACC(1); V4_ACC(2); V4_ACC(3);
#undef V4_ACC
              } }
#else
            const u32x6 v6A = {vaA.x, vaA.y, vaA.z, vaA.w, vbA.x, vbA.y};
            const f32x32 vfA = __builtin_amdgcn_cvt_scalef32_pk32_f32_fp6(v6A, 1.0f);
#pragma unroll
            for (int i = 0; i < 32; ++i) y[i] += wA * vfA[i];
            const u32x6 v6B = {vaB.x, vaB.y, vaB.z, vaB.w, vbB.x, vbB.y};
            const f32x32 vfB = __builtin_amdgcn_cvt_scalef32_pk32_f32_fp6(v6B, 1.0f);
#pragma unroll
            for (int i = 0; i < 32; ++i) y[i] += wB * vfB[i];
#endif
        }
#if GATHER_PRE
        pre = (it + 1 < nround) && (G_ROWOF(it + 1) < Mrows);
        if (pre) { unsigned n0 = nea.x, n2 = neb.x; asm volatile("" : "+v"(n0), "+v"(n2) :: "memory"); eax = n0; ebx = n2;
            const int k0n = (can_coop && (it + 1 == nround - 1)) ? (wid & 3) * 32 : 0;
#pragma unroll
            for (int k = 0; k < 6; ++k) G_ISSUE(k0n + k); }
#endif
#undef G_READ
#undef G_ISSUE
        if (coop) {
            LAS f32x4* mine = (LAS f32x4*)(lds + wid * (GS * GSLOT)) + lane * 8;
#pragma unroll
            for (int i = 0; i < 8; ++i) mine[i] = (f32x4){y[4 * i], y[4 * i + 1], y[4 * i + 2], y[4 * i + 3]};
            __syncthreads();
            if ((wid & 3) == 0) {
#pragma unroll
                for (int j = 1; j < 4; ++j) { const LAS f32x4* oth = (const LAS f32x4*)(lds + (wid + j) * (GS * GSLOT)) + lane * 8;
#pragma unroll
                    for (int i = 0; i < 8; ++i) { const f32x4 t = oth[i]; y[4 * i] += t.x; y[4 * i + 1] += t.y; y[4 * i + 2] += t.z; y[4 * i + 3] += t.w; } }
            }
            __syncthreads();
            if ((wid & 3) != 0) continue;
        }
        const int slot = row_slot(row);
        const float* mod = MOD + (size_t)(L * 3 + slot) * 12288;
        const int le = launder_v(lane);
#if GATHER_VECREG
        if (slot != cur_slot) { cur_slot = slot; float t_[32];
            load_row_f32_b(mod + 5 * 2048, le, t_);
#pragma unroll
            for (int i = 0; i < 16; ++i) mg[i] = cvtpk(t_[2 * i], t_[2 * i + 1]);
            if (L < NLAYER - 1) { const float* modn = MOD + (size_t)((L + 1) * 3 + slot) * 12288;
                load_row_f32_b(modn, le, t_);
#pragma unroll
                for (int i = 0; i < 16; ++i) ms[i] = cvtpk(t_[2 * i], t_[2 * i + 1]);
                load_row_f32_b(modn + 2048, le, t_);
#pragma unroll
                for (int i = 0; i < 16; ++i) mc[i] = cvtpk(t_[2 * i], t_[2 * i + 1]); } }
        { float xx[32];
#if GATHER_XEARLY
          { const unsigned xw_[16] = {xr0.x, xr0.y, xr0.z, xr0.w, xr1.x, xr1.y, xr1.z, xr1.w, xr2.x, xr2.y, xr2.z, xr2.w, xr3.x, xr3.y, xr3.z, xr3.w};
#pragma unroll
            for (int i = 0; i < 16; ++i) { xx[2 * i] = bflo(xw_[i]); xx[2 * i + 1] = bfhi(xw_[i]); } }
#else
          { const u32x4* xp_ = (const u32x4*)(X + (size_t)row * DM) + 4 * le;
#pragma unroll
            for (int j = 0; j < 4; ++j) { const u32x4 w = G_NTL(xp_ + j); xx[8 * j + 0] = bflo(w.x); xx[8 * j + 1] = bfhi(w.x); xx[8 * j + 2] = bflo(w.y); xx[8 * j + 3] = bfhi(w.y);
                xx[8 * j + 4] = bflo(w.z); xx[8 * j + 5] = bfhi(w.z); xx[8 * j + 6] = bflo(w.w); xx[8 * j + 7] = bfhi(w.w); } }
#endif
#pragma unroll
          for (int i = 0; i < 16; ++i) { y[2 * i] = ALPHA * xx[2 * i] + bflo(mg[i]) * y[2 * i]; y[2 * i + 1] = ALPHA * xx[2 * i + 1] + bfhi(mg[i]) * y[2 * i + 1]; } }
        { float mean, rstd; ln_stats(y, mean, rstd);
          const LAS u32x4* gp = (const LAS u32x4*)(LNV + le * 16); const LAS u32x4* bp = (const LAS u32x4*)(LNV + 1024 + le * 16);
#pragma unroll
          for (int q = 0; q < 4; ++q) { const u32x4 g4 = gp[q], b4 = bp[q]; const unsigned gw_[4] = {g4.x, g4.y, g4.z, g4.w}, bw_[4] = {b4.x, b4.y, b4.z, b4.w};
#pragma unroll
              for (int j = 0; j < 4; ++j) { const int i = 8 * q + 2 * j; y[i] = (y[i] - mean) * rstd * bflo(gw_[j]) + bflo(bw_[j]); y[i + 1] = (y[i + 1] - mean) * rstd * bfhi(gw_[j]) + bfhi(bw_[j]); } }
          if (L < NLAYER - 1) { store_row_bf16_b(Xo + (size_t)row * DM, le, y);
              ln_stats(y, mean, rstd); float a_[32];
#pragma unroll
              for (int i = 0; i < 16; ++i) { a_[2 * i] = (y[2 * i] - mean) * rstd * (1.0f + bflo(mc[i])) + bflo(ms[i]); a_[2 * i + 1] = (y[2 * i + 1] - mean) * rstd * (1.0f + bfhi(mc[i])) + bfhi(ms[i]); }
              store_row_bf16_b(Ho + (size_t)row * DM, le, a_); }
          else { if (NT_STREAM > 1) store_row_f32_b_nt(P->out + (size_t)row * DM, le, y); else store_row_f32_b(P->out + (size_t)row * DM, le, y); } }
        asm volatile("s_waitcnt vmcnt(0)" ::: "memory");
        continue;
#endif
        { float xx[32], gg[32]; load_row_bf16_b(X + (size_t)row * DM, le, xx); load_row_f32_b(mod + 5 * 2048, le, gg);
#pragma unroll
          for (int i = 0; i < 32; ++i) y[i] = ALPHA * xx[i] + gg[i] * y[i]; }
        if (L < NLAYER - 1) { const float* modn = MOD + (size_t)((L + 1) * 3 + slot) * 12288;
            finish_row<true>(y, lng, lnb, Xo + (size_t)row * DM, modn, modn + 2048, Ho + (size_t)row * DM, nullptr, le); }
        else finish_row<true>(y, lng, lnb, nullptr, nullptr, nullptr, nullptr, P->out + (size_t)row * DM, le);
        asm volatile("s_waitcnt vmcnt(0)" ::: "memory");
    }
#undef G_PREFETCH
#undef G_ROWOF
}

#ifndef ROPE_TEST
#define ROPE_TEST 0
#endif
#ifndef TAIL_L3MOVE
#define TAIL_L3MOVE 1
#endif
#ifndef PROBE_DUP
#define PROBE_DUP 0
#endif
#define NOINL __forceinline__
__device__ __forceinline__ CP launder_cp(CP p) { asm volatile("" : "+s"(p)); return p; }
#define GETP() launder_cp((CP)__builtin_amdgcn_kernarg_segment_ptr())
__device__ __forceinline__ int uni(int v) { return __builtin_amdgcn_readfirstlane(v); }
__device__ __forceinline__ LAS unsigned char* uni_lds(LAS unsigned char* p) { return (LAS unsigned char*)(unsigned)__builtin_amdgcn_readfirstlane((int)(unsigned)(uintptr_t)p); }
#define PH_IDS const int wid = uni(wv_), lane = launder_v(lane_id_fresh()) & 63, tid = (wid & 7) * 64 + lane; const int gw = blockIdx.x * NWAVES + wid, NGW = gridDim.x * NWAVES; (void)lane; (void)gw; (void)NGW; (void)tid;

__device__ NOINL void ph_prologue(int wv_, LAS unsigned char* lds_) { CP P = GETP(); LAS unsigned char* lds = uni_lds(lds_); PH_IDS p0_prologue(P, lds, tid, lane, wid, gw, NGW); if (PROBE_DUP == 5) p0_prologue(P, lds, tid, lane, wid, gw, NGW);
    if (PROBE_DUP >= 21 && PROBE_DUP <= 23) { __syncthreads(); p0_prologue(P, lds, tid, lane, wid, gw, NGW, 1 << (PROBE_DUP - 21 < 0 ? 0 : (PROBE_DUP - 21) & 3)); } }
__device__ NOINL void ph_modreduce(int wv_) { CP P = GETP(); PH_IDS mod_reduce(P, gw, lane, NGW); }
__device__ NOINL void ph_first(int wv_, LAS unsigned char* lds_) { CP P = GETP(); LAS unsigned char* lds = uni_lds(lds_); PH_IDS
#pragma unroll 1
    for (int rep = 0; rep < (PROBE_DUP == 6 ? 2 : 1); ++rep) first_row_pass(P, lds, tid, lane, gw, NGW); }
__device__ NOINL void ph_postmix(int wv_, LAS unsigned char* lds_, int L_, int M_) { CP P = GETP(); LAS unsigned char* lds = uni_lds(lds_); const int L = uni(L_), Mrows = uni(M_); PH_IDS
    if (POSTMIX_LDS) post_mixer_pass_lds(P, L, Mrows, lds, tid, lane, gw, NGW); else post_mixer_pass(P, L, Mrows, lane, gw, NGW); }
__device__ NOINL void ph_vstats(int wv_, int M_) { CP P = GETP(); const int Mrows = uni(M_); PH_IDS
#pragma unroll 1
    for (int rep = 0; rep < (PROBE_DUP == 6 ? 2 : 1); ++rep) vstats_pass(P, Mrows, lane, gw, NGW); }
__device__ NOINL void ph_spatial(int wv_, LAS unsigned char* lds_, int j_, int M_) { CP P = GETP(); LAS unsigned char* lds = uni_lds(lds_); const int j = uni(j_), Mrows = uni(M_); PH_IDS
#pragma unroll 1
    for (int rep = 0; rep < ((PROBE_DUP == 6 || PROBE_DUP == 19) ? 2 : 1); ++rep) spatial_phase(P, j, Mrows, lds, tid, lane, wid); }
__device__ NOINL void ph_mla_norm(int wv_) { CP P = GETP(); PH_IDS
#pragma unroll 1
    for (int rep = 0; rep < (PROBE_DUP == 6 ? 2 : 1); ++rep) mla_norm_pass(P, lane, gw, NGW); }
__device__ NOINL void ph_rope(int wv_, int which_) { CP P = GETP(); const int which = uni(which_); PH_IDS
    if (which == 0) rope_pass((bf16*)(P->ws + WS_QM), 3072, 128, 16, 192, lane, gw, NGW);
    else rope_pass((bf16*)(P->ws + WS_Z), 6144, 0, 64, 64, lane, gw, NGW); }
__device__ NOINL void ph_attn_mla(int wv_, LAS unsigned char* lds_) { CP P = GETP(); LAS unsigned char* lds = uni_lds(lds_); PH_IDS
    if (PROBE_DUP >= 41 && PROBE_DUP <= 45) { mla_attn_phase<PROBE_DUP >= 41 && PROBE_DUP <= 45 ? PROBE_DUP - 40 : 0>(P, lds, tid); __syncthreads(); }
    mla_attn_phase(P, lds, tid); if (PROBE_DUP == 2 || PROBE_DUP == 9) mla_attn_phase(P, lds, tid); }
__device__ NOINL void ph_attn_da(int wv_, LAS unsigned char* lds_, int L_, bool ctx_q) { CP P = GETP(); LAS unsigned char* lds = uni_lds(lds_); const int L = uni(L_); PH_IDS
    const float* lp = P->in[26];
    const float s01 = wave_sum(lp[lane] * lp[64 + lane]), s23 = wave_sum(lp[128 + lane] * lp[192 + lane]);
    const float lam_init = 0.8f - 0.6f * expf(-0.3f * (float)L);
    const float lam = expf(s01) - expf(s23) + lam_init;
    if (PROBE_DUP == 24) { da_attn_phase(P, lam, 1.0f - lam_init, lds, tid, ctx_q, 4); __syncthreads(); }
    if (PROBE_DUP == 25) { da_attn_phase(P, lam, 1.0f - lam_init, lds, tid, ctx_q, 2); __syncthreads(); }
    if (PROBE_DUP == 26) { da_attn_phase(P, lam, 1.0f - lam_init, lds, tid, ctx_q, 12); __syncthreads(); }
    if (!(PROBE_DUP >= 11 && PROBE_DUP <= 15)) da_attn_phase(P, lam, 1.0f - lam_init, lds, tid, ctx_q);
    if (PROBE_DUP == 2 || PROBE_DUP == 10) da_attn_phase(P, lam, 1.0f - lam_init, lds, tid, ctx_q);
    if (PROBE_DUP >= 11 && PROBE_DUP <= 15) { da_attn_phase<PROBE_DUP >= 11 && PROBE_DUP <= 15 ? PROBE_DUP - 10 : 0>(P, lam, 1.0f - lam_init, lds, tid, ctx_q); __syncthreads(); }
    if (PROBE_DUP >= 11 && PROBE_DUP <= 15) da_attn_phase(P, lam, 1.0f - lam_init, lds, tid, ctx_q); }
__device__ NOINL void ph_route(int wv_, LAS unsigned char* lds_, int L_, int M_) { CP P = GETP(); LAS unsigned char* lds = uni_lds(lds_); const int L = uni(L_), Mrows = uni(M_); PH_IDS
#pragma unroll 1
    for (int rep = 0; rep < (PROBE_DUP == 4 ? 2 : 1); ++rep) route_phase(P, L, Mrows, lds, tid, lane, wid, gw, NGW); }
__device__ NOINL void ph_gather(int wv_, LAS unsigned char* lds_, int L_, int M_) { CP P = GETP(); LAS unsigned char* lds = uni_lds(lds_); const int L = uni(L_), Mrows = uni(M_); PH_IDS
    if (PROBE_DUP == 3) { gather_phase<0>(P, L, Mrows, lds, wid, lane, gw, NGW, true); }
    if (PROBE_DUP == 7) { gather_phase<1>(P, L, Mrows, lds, wid, lane, gw, NGW, true); }
    if (PROBE_DUP == 17) { gather_phase<3>(P, L, Mrows, lds, wid, lane, gw, NGW, true); }
    if (PROBE_DUP == 8) { gather_phase<2>(P, L, Mrows, lds, wid, lane, gw, NGW, true); }
    gather_phase<0>(P, L, Mrows, lds, wid, lane, gw, NGW); }

enum GemmId { G_GM_IN = 0, G_GM_OUT, G_MLA_IN, G_MLA_UQ, G_MLA_UKV, G_MLA_OUT, G_DA_IN, G_DA_OUT, G_PEER_Q };
__device__ NOINL void ph_gemm(int wv_, LAS unsigned char* lds_, int id_, int L_, int M_) {
    CP P = GETP(); LAS unsigned char* lds = uni_lds(lds_); const int id = uni(id_), L = uni(L_), Mrows = uni(M_); PH_IDS
    unsigned char* ws = P->ws; const int jj = L / 3;
    size_t a = WS_H, b = 0, o = 0; int M = MT, N = 2048, K = 2048, act = 0, rope = 0;
    switch (id) {
        case G_GM_IN:   a = WS_H;    b = WS_GMWIN + (size_t)jj * 4096 * 2048 * 2;  o = WS_Z;  M = Mrows; N = 4096; K = 2048; act = 1; break;
        case G_GM_OUT:  a = WS_G;    b = WS_GMWOUT + (size_t)jj * 2048 * 2048 * 2; o = WS_Y;  M = Mrows; N = 2048; K = 2048; break;
        case G_MLA_IN:  a = WS_H;    b = WS_MLAIN;  o = WS_C;  N = 1280; K = 2048; break;
        case G_MLA_UQ:  a = WS_CQN;  b = WS_MLAUQ;  o = WS_QM; N = 3072; K = 512;  rope = (ROPE_TEST == 2) ? 0 : 2; break;
        case G_MLA_UKV: a = WS_CKVN; b = WS_MLAUKV; o = WS_KV; N = 4096; K = 512;  break;
        case G_MLA_OUT: a = WS_G;    b = WS_MLAOUT; o = WS_Y;  N = 2048; K = 2048; break;
        case G_DA_IN:   a = WS_H;    b = WS_DAIN;   o = WS_Z;  N = 6144; K = 2048; rope = (ROPE_TEST == 1) ? 0 : 1; break;
        case G_DA_OUT:  a = WS_G;    b = WS_DAOUT;  o = WS_Y;  M = Mrows; N = 2048; K = 2048; break;
        default:        a = WS_H;    b = WS_PWQ + (size_t)L * 2048 * 2048 * 2;     o = WS_QP; M = Mrows; N = 2048; K = 2048; break;
    }
    pg8::Gemm g{(const pg8::bf16_t*)(ws + a), (const pg8::bf16_t*)(ws + b), M, N, K}; pg8::StaticOrder S; S.init(M, N, (int)gridDim.x, id == G_MLA_UKV ? (int)gridDim.x - 1 - (int)blockIdx.x : (int)blockIdx.x);
    pg8::EpiR E{(pg8::bf16_t*)(ws + o), N, act, rope, (const float*)(ws + WS_ROPE)};
#pragma unroll 1
    for (int rep = 0; rep < ((PROBE_DUP == 1 || (PROBE_DUP == 31 && id == G_MLA_OUT) || (PROBE_DUP == 32 && id == G_DA_OUT)) ? 2 : 1); ++rep) { pg8::gemm_phase<pg8::EpiR, pg8::StaticOrder, true, true>((PG8_LAS unsigned char*)lds, g, S, E, tid); __syncthreads(); }
#if TAIL_REMAP
    int TL = -1; bool tail_u = false;
    if (L == 0) { if (id == G_GM_IN) { TL = 0; tail_u = true; } else if (id == G_GM_OUT) { TL = 0; } else if (id == G_PEER_Q) { TL = 1; tail_u = true; } }
    else if (L == 1) { if (id == G_MLA_IN) { TL = 1; } else if (id == G_MLA_OUT) { TL = 2; tail_u = true; } else if (id == G_PEER_Q) { TL = 2; } }
    else if (L == 2) { if (id == G_DA_IN) { TL = 3; tail_u = true; } else if (id == G_DA_OUT) { TL = 3; } }
    if (TL >= 0) {
        const int units = (M / 256) * (N / 256), G = (int)gridDim.x, tail = units % G, c = (int)blockIdx.x;
        const float* src = (tail_u ? P->in[11] : P->in[12]) + (size_t)TL * 16384 * 2048; unsigned char* dst = ws + WS_PU + (size_t)TL * 16384 * PREC;
#else
#if TAIL_L3MOVE
    const bool l3u = (id == G_MLA_IN && L == 1), l3v = (id == G_DA_IN && L == 2), skip = (L == NLAYER - 2) && (id == G_DA_OUT || id == G_PEER_Q);
    const bool l0v = P0_NOV && (id == G_GM_IN && L == 0);
    const bool tail_u = !skip && ((id == G_GM_OUT || id == G_MLA_OUT || id == G_DA_OUT) || l3u), tail_v = !skip && ((id == G_PEER_Q) || l3v || l0v);
    const int TLx = (l3u || l3v) ? NLAYER - 1 : (l0v ? 0 : L + 1);
    if ((tail_u || tail_v) && TLx < NLAYER) {
        const int units = (M / 256) * (N / 256), G = (int)gridDim.x, tail = units % G, c = (int)blockIdx.x;
        const float* src = (tail_u ? P->in[11] : P->in[12]) + (size_t)TLx * 16384 * 2048; unsigned char* dst = ws + WS_PU + (size_t)TLx * 16384 * PREC;
#else
    const bool tail_u = (id == G_GM_OUT || id == G_MLA_OUT || id == G_DA_OUT), tail_v = (id == G_PEER_Q);
    if ((tail_u || tail_v) && L + 1 < NLAYER) {
        const int units = (M / 256) * (N / 256), G = (int)gridDim.x, tail = units % G, c = (int)blockIdx.x;
        const float* src = (tail_u ? P->in[11] : P->in[12]) + (size_t)(L + 1) * 16384 * 2048; unsigned char* dst = ws + WS_PU + (size_t)(L + 1) * 16384 * PREC;
#endif
#endif
        LAS float* scr = (LAS float*)(lds + wid * 16384);
        if (tail != 0 && c >= tail) cvt_table_fp6(src, dst, 16384, tail_u ? U_SCALE : V_SCALE, scr, lane, (c - tail) * NWAVES + wid, (G - tail) * NWAVES, tail_u ? 0 : 1);
        else if (tail == 0) {
#pragma unroll 1
            for (int rep = 0; rep < (PROBE_DUP == 18 ? 3 : 1); ++rep) cvt_table_fp6(src, dst, 16384, tail_u ? U_SCALE : V_SCALE, scr, lane, gw, NGW, tail_u ? 0 : 1); }
    }
}

__global__ void __launch_bounds__(NWAVES * 64, 2) mk_fwd(Params Pv) {
    extern __shared__ __attribute__((aligned(16))) unsigned char lds_g[];
    LAS unsigned char* lds = (LAS unsigned char*)lds_g;
    const int wv = __builtin_amdgcn_readfirstlane((int)threadIdx.x >> 6);
    const int tid = wv * 64 + lane_id_fresh();
    for (int u = tid; u < (LDS_BYTES - RING_BYTES) / 4; u += NWAVES * 64) ((LAS unsigned*)(lds + RING_BYTES))[u] = 0u;
    __syncthreads();
    const int lo = Pv.ph_lo, hi = Pv.ph_hi;
    unsigned* barw = (unsigned*)(Pv.ws + WS_CTL) + CW_BAR;
    XcdBarrier bar; bar.bar = barw; bar.x = 0; bar.st = nullptr;
    if (hi - lo > 1) bar = xcd_barrier_post(barw, (volatile LAS unsigned*)(lds + MISC_OFF) + 8, tid == 0);
    int ph = 0;
#ifndef SEL
#define SELP(k) true
#else
#define SELP(k) ((k) == SEL)
#endif
    enum { RUN_BASE = __COUNTER__ + 1 };
#define RUN(call) do { if (SELP(__COUNTER__ - RUN_BASE) && ph >= lo && ph < hi) { call; } if (ph >= lo && ph + 1 < hi) { xcd_barrier(bar, wv == 0 && lane_id_fresh() == 0); if (PROBE_DUP == 30) { xcd_barrier(bar, wv == 0 && lane_id_fresh() == 0); xcd_barrier(bar, wv == 0 && lane_id_fresh() == 0); } } ++ph; } while (0)
    RUN(ph_prologue(wv, lds));
    RUN(ph_modreduce(wv));
    RUN(ph_first(wv, lds));
#define LAYER(LL) do { constexpr int L = (LL); constexpr int kind = L % 3, jj = L / 3; constexpr int Mrows = (L == NLAYER - 1) ? ML : MT; \
        constexpr bool ctx_dead = (L == NLAYER - 2) && ((NLAYER - 1) % 3 == 0) && (kind != 0); constexpr int Mlive = ctx_dead ? ML : Mrows; \
        if (kind == 0) {                          \
            RUN(ph_gemm(wv, lds, G_GM_IN, L, Mrows)); \
            RUN(ph_vstats(wv, Mrows)); \
            RUN(ph_spatial(wv, lds, jj, Mrows)); \
            RUN(ph_gemm(wv, lds, G_GM_OUT, L, Mrows)); \
        } else if (kind == 1) {                   \
            RUN(ph_gemm(wv, lds, G_MLA_IN, L, Mrows)); \
            RUN(ph_mla_norm(wv)); \
            RUN(ph_gemm(wv, lds, G_MLA_UQ, L, Mrows); ph_gemm(wv, lds, G_MLA_UKV, L, Mrows)); \
            if (ROPE_TEST == 2) { RUN(ph_rope(wv, 0)); } \
            RUN(ph_attn_mla(wv, lds)); \
            RUN(ph_gemm(wv, lds, G_MLA_OUT, L, Mrows)); \
        } else {                                  \
            RUN(ph_gemm(wv, lds, G_DA_IN, L, Mrows); if (ROPE_TEST == 1) { __syncthreads(); } ); \
            if (ROPE_TEST == 1) { RUN(ph_rope(wv, 1)); } \
            RUN(ph_attn_da(wv, lds, L, !ctx_dead)); \
            RUN(ph_gemm(wv, lds, G_DA_OUT, L, Mlive)); \
        } \
        RUN(ph_postmix(wv, lds, L, Mlive));                \
        RUN(ph_gemm(wv, lds, G_PEER_Q, L, Mlive));    \
        RUN(ph_route(wv, lds, L, Mlive));             \
        RUN(ph_gather(wv, lds, L, Mlive));            \
    } while (0)
    LAYER(0); LAYER(1); LAYER(2); LAYER(3);
#undef LAYER
#undef RUN
}

extern "C" void kernel_launch(void* const* d_in, const int* in_sizes, int n_in, void* d_out, int out_size, void* d_ws, size_t ws_size, hipStream_t stream) {
    static int grid = 0;
    if (grid == 0) {
        if (n_in != 29 || in_sizes[0] != ML * DM || out_size != ML * DM || ws_size < WS_END) {
            fprintf(stderr, "kernel_launch: shape mismatch: n_in %d in0 %d out %d ws %zu (need %zu); nothing launched\n", n_in, n_in > 0 ? in_sizes[0] : -1, out_size, ws_size, (size_t)WS_END); grid = -1; return; }
        int dev = 0, cus = 0, per_cu = 0;
        if (hipGetDevice(&dev) != hipSuccess || hipDeviceGetAttribute(&cus, hipDeviceAttributeMultiprocessorCount, dev) != hipSuccess) { fprintf(stderr, "kernel_launch: device query failed\n"); grid = -1; return; }
        if (hipFuncSetAttribute((const void*)mk_fwd, hipFuncAttributeMaxDynamicSharedMemorySize, LDS_BYTES) != hipSuccess) { fprintf(stderr, "kernel_launch: hipFuncSetAttribute failed\n"); grid = -1; return; }
        if (hipOccupancyMaxActiveBlocksPerMultiprocessor(&per_cu, (const void*)mk_fwd, NWAVES * 64, LDS_BYTES) != hipSuccess || per_cu < 1)
            fprintf(stderr, "kernel_launch: note: occupancy query reports %d workgroups per CU\n", per_cu);
        (void)hipGetLastError();
        grid = cus;
    }
    if (grid < 0) return;
    if (hipMemsetAsync((char*)d_ws + WS_CTL, 0, CTL_ZERO_BYTES, stream) != hipSuccess) { fprintf(stderr, "kernel_launch: memset failed\n"); return; }
    Params p{};
    for (int i = 0; i < 29; ++i) p.in[i] = (const float*)d_in[i];
    p.out = (float*)d_out; p.ws = (unsigned char*)d_ws;
#if MK_ONE_LAUNCH
    p.ph_lo = 0; p.ph_hi = NPH;
    hipLaunchKernelGGL(mk_fwd, dim3(grid), dim3(NWAVES * 64), LDS_BYTES, stream, p);
#else
    for (int li = 0; li < NPH; ++li) { p.ph_lo = li; p.ph_hi = li + 1; hipLaunchKernelGGL(mk_fwd, dim3(grid), dim3(NWAVES * 64), LDS_BYTES, stream, p); }
#endif
    const hipError_t le = hipPeekAtLastError();
    if (le != hipSuccess) fprintf(stderr, "kernel_launch: launch failed: %s\n", hipGetErrorName(le));
}
```
